# Optimizing an MI355X kernel written in HIP

```python
import math
import jax, jax.numpy as jnp
from jax import lax
import numpy as np

D_MODEL = 1024
BATCH = 4
SEQ = 8192
DEPTH = 4

MEM_LEN = 256
EPS = 1e-6
NEG = -1e30
MAX_POS_OFFSET = 4096

MLA_HEADS = 4
MLA_NOPE = 64
MLA_ROPE = 32
MLA_V = 64
MLA_Q_RANK = 192
MLA_KV_RANK = 128
MLA_OUT = MLA_HEADS * MLA_V
ROPE_THETA = 10000.0

LRU_WIDTH = 512
LRU_BLOCKS = 8
LRU_BLOCK = LRU_WIDTH // LRU_BLOCKS
CONV_W = 4
LRU_C = 8.0

DIFF_HEADS = 4
DIFF_DK = 32
DIFF_DV = 2 * DIFF_DK
DIFF_QK = DIFF_HEADS * 2 * DIFF_DK
DIFF_OUT = DIFF_HEADS * DIFF_DV

MIX_WIDTH = MLA_OUT + LRU_WIDTH + DIFF_OUT

IN_SPLITS = (
    MLA_Q_RANK,
    MLA_Q_RANK + MLA_KV_RANK,
    MLA_Q_RANK + MLA_KV_RANK + MLA_ROPE,
    MLA_Q_RANK + MLA_KV_RANK + MLA_ROPE + LRU_WIDTH,
    MLA_Q_RANK + MLA_KV_RANK + MLA_ROPE + 2 * LRU_WIDTH,
    MLA_Q_RANK + MLA_KV_RANK + MLA_ROPE + 2 * LRU_WIDTH + DIFF_QK,
    MLA_Q_RANK + MLA_KV_RANK + MLA_ROPE + 2 * LRU_WIDTH + 2 * DIFF_QK,
)
IN_WIDTH = MLA_Q_RANK + MLA_KV_RANK + MLA_ROPE + 2 * LRU_WIDTH + 2 * DIFF_QK + DIFF_OUT

N_BUCKETS = 32
MAX_DIST = 128

CROSS_HEADS = 4
CROSS_DH = D_MODEL // CROSS_HEADS

PEER_HEADS = 8
PEER_NKEYS = 128
PEER_EXPERTS = PEER_NKEYS * PEER_NKEYS
PEER_TOPK = 16
PEER_DQ = 128

Q_BLOCK = 128
TOKEN_BLOCK = 128

kernel_name = 'hybrid_mla_rglru_diffattn_peer'


def rmsnorm(x, g):
    x32 = x.astype(jnp.float32)
    y = x32 * lax.rsqrt(jnp.mean(x32 * x32, axis=-1, keepdims=True) + EPS)
    return (y * g.astype(jnp.float32)).astype(x.dtype)


def rope(x, pos):
    r = x.shape[-1]
    inv = ROPE_THETA ** (-jnp.arange(0, r, 2, dtype=jnp.float32) / r)
    ang = pos.astype(jnp.float32)[..., None] * inv
    if x.ndim == 4:
        ang = ang[:, :, None, :]
    cos, sin = jnp.cos(ang), jnp.sin(ang)
    x32 = x.astype(jnp.float32)
    x1, x2 = x32[..., : r // 2], x32[..., r // 2:]
    return jnp.concatenate([x1 * cos - x2 * sin, x1 * sin + x2 * cos], axis=-1).astype(x.dtype)


def t5_bucket(rel):
    n = jnp.maximum(-rel, 0)
    max_exact = N_BUCKETS // 2
    large = max_exact + (jnp.log(jnp.maximum(n, 1).astype(jnp.float32) / max_exact)
                         / math.log(MAX_DIST / max_exact) * (N_BUCKETS - max_exact)).astype(jnp.int32)
    large = jnp.minimum(large, N_BUCKETS - 1)
    return jnp.where(n < max_exact, n, large)


def causal_depthwise_conv(x, w, b):
    s = x.shape[1]
    xp = jnp.pad(x, ((0, 0), (CONV_W - 1, 0), (0, 0)))
    y = b
    for k in range(CONV_W):
        y = y + xp[:, k:k + s] * w[k]
    return y


def _linear_combine(c1, c2):
    a1, b1 = c1
    a2, b2 = c2
    return a1 * a2, a2 * b1 + b2


def rg_lru_branch(x_in, gate_in, conv_w, conv_b, w_a, b_a, w_x, b_x, lam):
    b, s, _ = x_in.shape
    xc = causal_depthwise_conv(x_in, conv_w, conv_b)
    xb = xc.reshape(b, s, LRU_BLOCKS, LRU_BLOCK)
    r = jax.nn.sigmoid(jnp.einsum('bsgi,gij->bsgj', xb, w_a) + b_a).reshape(b, s, LRU_WIDTH)
    i = jax.nn.sigmoid(jnp.einsum('bsgi,gij->bsgj', xb, w_x) + b_x).reshape(b, s, LRU_WIDTH)
    log_a = -LRU_C * r.astype(jnp.float32) * jax.nn.softplus(-lam.astype(jnp.float32))
    a = jnp.exp(log_a)
    u = jnp.sqrt(-jnp.expm1(2.0 * log_a)) * (i * xc).astype(jnp.float32)
    _, h = lax.associative_scan(_linear_combine, (a, u), axis=1)
    return h.astype(x_in.dtype) * jax.nn.gelu(gate_in, approximate=False)


def causal_block_attention(q_nope, q_rope, k_nope, k_rope, v_mla, q_d, k_d, v_d, positions, rel_bias, lam):
    b, s = positions.shape
    n_blocks = s // Q_BLOCK
    k_idx = jnp.arange(s)
    mla_scale = 1.0 / math.sqrt(MLA_NOPE + MLA_ROPE)
    diff_scale = 1.0 / math.sqrt(DIFF_DK)

    def one_block(blk):
        start = blk * Q_BLOCK
        sl = lambda t: lax.dynamic_slice_in_dim(t, start, Q_BLOCK, axis=1)
        q_idx = start + jnp.arange(Q_BLOCK)
        mask = k_idx[None, :] <= q_idx[:, None]
        s1 = (jnp.einsum('bqhd,bkhd->bhqk', sl(q_nope), k_nope)
              + jnp.einsum('bqhr,bkr->bhqk', sl(q_rope), k_rope)).astype(jnp.float32) * mla_scale
        p1 = jax.nn.softmax(jnp.where(mask, s1, NEG), axis=-1).astype(v_mla.dtype)
        o_mla = jnp.einsum('bhqk,bkhd->bqhd', p1, v_mla)
        rel = positions[:, None, :] - sl(positions)[:, :, None]
        bias = jnp.moveaxis(rel_bias[t5_bucket(rel)], -1, 1).astype(jnp.float32)
        s2 = jnp.einsum('bqhcd,bkhcd->bhcqk', sl(q_d), k_d).astype(jnp.float32) * diff_scale + bias[:, :, None]
        p2 = jax.nn.softmax(jnp.where(mask, s2, NEG), axis=-1)
        w = (p2[:, :, 0] - lam * p2[:, :, 1]).astype(v_d.dtype)
        o_diff = jnp.einsum('bhqk,bkhd->bqhd', w, v_d)
        return o_mla, o_diff

    o_mla, o_diff = lax.map(one_block, jnp.arange(n_blocks))
    o_mla = jnp.moveaxis(o_mla, 0, 1).reshape(b, s, MLA_HEADS, MLA_V)
    o_diff = jnp.moveaxis(o_diff, 0, 1).reshape(b, s, DIFF_HEADS, DIFF_DV)
    return o_mla, o_diff


def hybrid_mixer(h, positions, rel_bias, layer_idx, w_in, q_norm, w_uq, kv_norm, w_ukv,
                 conv_w, conv_b, w_a, b_a, w_x, b_x, lru_lambda, diff_lambda, diff_norm,
                 out_norm_mla, out_norm_lru, w_out):
    b, s, _ = h.shape
    c_q, c_kv, k_r, x_lru, g_lru, q_d, k_d, v_d = jnp.split(h @ w_in, IN_SPLITS, axis=-1)
    q = (rmsnorm(c_q, q_norm) @ w_uq).reshape(b, s, MLA_HEADS, MLA_NOPE + MLA_ROPE)
    q_nope, q_rope = q[..., :MLA_NOPE], rope(q[..., MLA_NOPE:], positions)
    kv = (rmsnorm(c_kv, kv_norm) @ w_ukv).reshape(b, s, MLA_HEADS, MLA_NOPE + MLA_V)
    k_nope, v_mla = kv[..., :MLA_NOPE], kv[..., MLA_NOPE:]
    k_rope = rope(k_r, positions)
    q_d = q_d.reshape(b, s, DIFF_HEADS, 2, DIFF_DK)
    k_d = k_d.reshape(b, s, DIFF_HEADS, 2, DIFF_DK)
    v_d = v_d.reshape(b, s, DIFF_HEADS, DIFF_DV)
    lam_init = 0.8 - 0.6 * math.exp(-0.3 * layer_idx)
    dl = diff_lambda.astype(jnp.float32)
    lam = jnp.exp(jnp.sum(dl[0] * dl[1])) - jnp.exp(jnp.sum(dl[2] * dl[3])) + lam_init
    o_mla, o_diff = causal_block_attention(q_nope, q_rope, k_nope, k_rope, v_mla,
                                           q_d, k_d, v_d, positions, rel_bias, lam)
    o_diff = (rmsnorm(o_diff, diff_norm) * (1.0 - lam_init)).reshape(b, s, DIFF_OUT)
    o_mla = rmsnorm(o_mla.reshape(b, s, MLA_OUT), out_norm_mla)
    o_lru = rmsnorm(rg_lru_branch(x_lru, g_lru, conv_w, conv_b, w_a, b_a, w_x, b_x, lru_lambda), out_norm_lru)
    y = jnp.concatenate([o_mla, o_lru, o_diff], axis=-1)
    return y @ w_out


def memory_cross_attention(h, mem_n, w_cq, w_ckv, w_co):
    b, s, d = h.shape
    m = mem_n.shape[1]
    q = (h @ w_cq).reshape(b, s, CROSS_HEADS, CROSS_DH)
    k, v = jnp.split(mem_n @ w_ckv, 2, axis=-1)
    k = k.reshape(b, m, CROSS_HEADS, CROSS_DH)
    v = v.reshape(b, m, CROSS_HEADS, CROSS_DH)
    sc = jnp.einsum('bshd,bmhd->bhsm', q, k).astype(jnp.float32) * (1.0 / math.sqrt(CROSS_DH))
    p = jax.nn.softmax(sc, axis=-1).astype(v.dtype)
    o = jnp.einsum('bhsm,bmhd->bshd', p, v).reshape(b, s, d)
    return o @ w_co


def peer_ffn(h, w_q, keys, u, v):
    b, s, d = h.shape
    q = (h @ w_q).reshape(b, s, PEER_HEADS, 2, PEER_DQ // 2)
    sc = jnp.einsum('bshcd,cnd->bshcn', q, keys).astype(jnp.float32)
    top_s, top_i = lax.top_k(sc, PEER_TOPK)
    cand = top_s[..., 0, :, None] + top_s[..., 1, None, :]
    best_s, best_c = lax.top_k(cand.reshape(b, s, PEER_HEADS, PEER_TOPK * PEER_TOPK), PEER_TOPK)
    ia = best_c // PEER_TOPK
    ib = best_c % PEER_TOPK
    experts = (jnp.take_along_axis(top_i[..., 0, :], ia, axis=-1) * PEER_NKEYS
               + jnp.take_along_axis(top_i[..., 1, :], ib, axis=-1))
    g = jax.nn.softmax(best_s, axis=-1).astype(h.dtype)
    n_blk = (b * s) // TOKEN_BLOCK
    hb = h.reshape(n_blk, TOKEN_BLOCK, d)
    eb = experts.reshape(n_blk, TOKEN_BLOCK, PEER_HEADS, PEER_TOPK)
    gb = g.reshape(n_blk, TOKEN_BLOCK, PEER_HEADS, PEER_TOPK)

    def block(args):
        xt, et, gt = args
        act = jax.nn.gelu(jnp.einsum('td,thkd->thk', xt, u[et]), approximate=False)
        return jnp.einsum('thk,thkd->td', gt * act, v[et])

    y = lax.map(block, (hb, eb, gb))
    return y.reshape(b, s, d)


def setup_inputs(seed: int = 0) -> dict:
    key = jax.random.key(seed)
    ks = jax.random.split(key, 40)
    f32 = jnp.float32
    L, D = DEPTH, D_MODEL

    def nrm(i, shape, scale):
        return jax.random.normal(ks[i], shape, f32) * scale

    def gain(i, shape):
        return 1.0 + 0.02 * jax.random.normal(ks[i], shape, f32)

    x = nrm(0, (BATCH, SEQ, D), 1.0)
    mem = nrm(1, (BATCH, MEM_LEN, D), 1.0)
    offset = jax.random.randint(ks[2], (BATCH, 1), 0, MAX_POS_OFFSET, dtype=jnp.int32)
    positions = offset + jnp.arange(SEQ, dtype=jnp.int32)[None, :]
    rel_bias = nrm(3, (N_BUCKETS, DIFF_HEADS), 0.2)
    norm_mix = gain(4, (L, D))
    w_in = nrm(5, (L, D, IN_WIDTH), D ** -0.5)
    mla_q_norm = gain(6, (L, MLA_Q_RANK))
    mla_w_uq = nrm(7, (L, MLA_Q_RANK, MLA_HEADS * (MLA_NOPE + MLA_ROPE)), MLA_Q_RANK ** -0.5)
    mla_kv_norm = gain(8, (L, MLA_KV_RANK))
    mla_w_ukv = nrm(9, (L, MLA_KV_RANK, MLA_HEADS * (MLA_NOPE + MLA_V)), MLA_KV_RANK ** -0.5)
    lru_conv_w = nrm(10, (L, CONV_W, LRU_WIDTH), CONV_W ** -0.5)
    lru_conv_b = nrm(11, (L, LRU_WIDTH), 0.01)
    lru_w_a = nrm(12, (L, LRU_BLOCKS, LRU_BLOCK, LRU_BLOCK), LRU_BLOCK ** -0.5)
    lru_b_a = nrm(13, (L, LRU_BLOCKS, LRU_BLOCK), 0.01)
    lru_w_x = nrm(14, (L, LRU_BLOCKS, LRU_BLOCK, LRU_BLOCK), LRU_BLOCK ** -0.5)
    lru_b_x = nrm(15, (L, LRU_BLOCKS, LRU_BLOCK), 0.01)
    a_pow = jax.random.uniform(ks[16], (L, LRU_WIDTH), f32, 0.9, 0.999)
    a0 = a_pow ** (1.0 / LRU_C)
    lru_lambda = jnp.log(a0) - jnp.log1p(-a0)
    diff_lambda = nrm(17, (L, 4, DIFF_DK), 0.1)
    diff_norm = gain(18, (L, DIFF_DV))
    out_norm_mla = gain(19, (L, MLA_OUT))
    out_norm_lru = gain(20, (L, LRU_WIDTH))
    w_out = nrm(21, (L, MIX_WIDTH, D), MIX_WIDTH ** -0.5)
    norm_cross = gain(22, (L, D))
    norm_mem = gain(23, (L, D))
    w_cq = nrm(24, (L, D, D), D ** -0.5)
    w_ckv = nrm(25, (L, D, 2 * D), D ** -0.5)
    w_co = nrm(26, (L, D, D), D ** -0.5)
    norm_ffn = gain(27, (L, D))
    peer_w_q = nrm(28, (L, D, PEER_HEADS * PEER_DQ), D ** -0.5)
    peer_keys = nrm(29, (L, 2, PEER_NKEYS, PEER_DQ // 2), (PEER_DQ // 2) ** -0.5)
    peer_u = nrm(30, (L, PEER_EXPERTS, D), D ** -0.5)
    peer_v = nrm(31, (L, PEER_EXPERTS, D), PEER_HEADS ** -0.5)
    norm_final = gain(32, (D,))
    return {'x': x, 'mem': mem, 'positions': positions, 'rel_bias': rel_bias,
            'norm_mix': norm_mix, 'w_in': w_in,
            'mla_q_norm': mla_q_norm, 'mla_w_uq': mla_w_uq, 'mla_kv_norm': mla_kv_norm, 'mla_w_ukv': mla_w_ukv,
            'lru_conv_w': lru_conv_w, 'lru_conv_b': lru_conv_b, 'lru_w_a': lru_w_a, 'lru_b_a': lru_b_a,
            'lru_w_x': lru_w_x, 'lru_b_x': lru_b_x, 'lru_lambda': lru_lambda,
            'diff_lambda': diff_lambda, 'diff_norm': diff_norm,
            'out_norm_mla': out_norm_mla, 'out_norm_lru': out_norm_lru, 'w_out': w_out,
            'norm_cross': norm_cross, 'norm_mem': norm_mem, 'w_cq': w_cq, 'w_ckv': w_ckv, 'w_co': w_co,
            'norm_ffn': norm_ffn, 'peer_w_q': peer_w_q, 'peer_keys': peer_keys,
            'peer_u': peer_u, 'peer_v': peer_v, 'norm_final': norm_final}


def reference(x, mem, positions, rel_bias, norm_mix, w_in, mla_q_norm, mla_w_uq, mla_kv_norm, mla_w_ukv,
              lru_conv_w, lru_conv_b, lru_w_a, lru_b_a, lru_w_x, lru_b_x, lru_lambda,
              diff_lambda, diff_norm, out_norm_mla, out_norm_lru, w_out,
              norm_cross, norm_mem, w_cq, w_ckv, w_co,
              norm_ffn, peer_w_q, peer_keys, peer_u, peer_v, norm_final):
    for l in range(DEPTH):
        h = rmsnorm(x, norm_mix[l])
        x = x + hybrid_mixer(h, positions, rel_bias, l, w_in[l], mla_q_norm[l], mla_w_uq[l],
                             mla_kv_norm[l], mla_w_ukv[l], lru_conv_w[l], lru_conv_b[l],
                             lru_w_a[l], lru_b_a[l], lru_w_x[l], lru_b_x[l], lru_lambda[l],
                             diff_lambda[l], diff_norm[l], out_norm_mla[l], out_norm_lru[l], w_out[l])
        h = rmsnorm(x, norm_cross[l])
        x = x + memory_cross_attention(h, rmsnorm(mem, norm_mem[l]), w_cq[l], w_ckv[l], w_co[l])
        h = rmsnorm(x, norm_ffn[l])
        x = x + peer_ffn(h, peer_w_q[l], peer_keys[l], peer_u[l], peer_v[l])
    return rmsnorm(x, norm_final)
```

```cpp
#include <hip/hip_runtime.h>
#include <cstdint>
#include <cstdio>
#include <cmath>

namespace {
constexpr int D = 1024, NB = 4, S = 8192, T = NB * S, L = 4, MEM = 256;
constexpr int INW = 2144;
constexpr int C_CQ = 0, C_CKV = 192, C_KR = 320, C_XL = 352, C_GL = 864, C_QD = 1376, C_KD = 1632, C_VD = 1888;
constexpr float EPS = 1e-6f;
constexpr int NEXP = 16384;

__global__ void k_copy4(const float4* __restrict__ a, float4* __restrict__ o, long n4) {
    long i = (long)blockIdx.x * blockDim.x + threadIdx.x;
    if (i < n4) o[i] = a[i];
}

__global__ __launch_bounds__(256) void k_rmsnorm(const float* in, const float* __restrict__ g, float* out, int Dn) {
    __shared__ float red[4];
    const long row = blockIdx.x;
    const float* x = in + row * Dn;
    float s = 0.f;
    for (int i = threadIdx.x; i < Dn; i += 256) { float v = x[i]; s += v * v; }
    for (int o = 32; o > 0; o >>= 1) s += __shfl_xor(s, o);
    if ((threadIdx.x & 63) == 0) red[threadIdx.x >> 6] = s;
    __syncthreads();
    s = red[0] + red[1] + red[2] + red[3];
    const float rs = rsqrtf(s / (float)Dn + EPS);
    for (int i = threadIdx.x; i < Dn; i += 256) out[row * Dn + i] = x[i] * rs * g[i];
}

struct GemmP { const float* A; const float* Bm; float* C; long lda, sbk, sbn, ldc; int M, N, K, nh; long aB, aH, bB, bH, cB, cH; float alpha; int acc; };
__global__ __launch_bounds__(256) void k_gemm(GemmP p) {
    __shared__ float As[16][128 + 4];
    __shared__ float Bs[16][128 + 4];
    const int tid = threadIdx.x, tx = tid & 15, ty = tid >> 4;
    const int zb = blockIdx.z / p.nh, zh = blockIdx.z % p.nh;
    const float* A = p.A + zb * p.aB + zh * p.aH + (long)blockIdx.y * 128 * p.lda;
    const float* Bm = p.Bm + zb * p.bB + zh * p.bH;
    float* C = p.C + zb * p.cB + zh * p.cH + (long)blockIdx.y * 128 * p.ldc;
    const int n0 = blockIdx.x * 128;
    float acc[8][8];
#pragma unroll
    for (int i = 0; i < 8; ++i)
#pragma unroll
        for (int j = 0; j < 8; ++j) acc[i][j] = 0.f;
    for (int k0 = 0; k0 < p.K; k0 += 16) {
#pragma unroll
        for (int r = 0; r < 2; ++r) {
            const int idx = tid + r * 256;
            const int m = idx >> 2, kq = (idx & 3) * 4;
            const float4 v = *(const float4*)(A + (long)m * p.lda + k0 + kq);
            As[kq + 0][m] = v.x; As[kq + 1][m] = v.y; As[kq + 2][m] = v.z; As[kq + 3][m] = v.w;
        }
#pragma unroll
        for (int r = 0; r < 8; ++r) {
            const int idx = tid + r * 256;
            int kk, nn;
            if (p.sbn == 1) { kk = idx >> 7; nn = idx & 127; } else { kk = idx & 15; nn = idx >> 4; }
            const int n = n0 + nn;
            Bs[kk][nn] = (n < p.N) ? Bm[(long)(k0 + kk) * p.sbk + (long)n * p.sbn] : 0.f;
        }
        __syncthreads();
#pragma unroll
        for (int kk = 0; kk < 16; ++kk) {
            float a[8], b[8];
#pragma unroll
            for (int i = 0; i < 4; ++i) { a[i] = As[kk][ty * 4 + i]; a[4 + i] = As[kk][64 + ty * 4 + i]; b[i] = Bs[kk][tx * 4 + i]; b[4 + i] = Bs[kk][64 + tx * 4 + i]; }
#pragma unroll
            for (int i = 0; i < 8; ++i)
#pragma unroll
                for (int j = 0; j < 8; ++j) acc[i][j] += a[i] * b[j];
        }
        __syncthreads();
    }
#pragma unroll
    for (int i = 0; i < 8; ++i) {
        const int m = (i < 4) ? ty * 4 + i : 64 + ty * 4 + (i - 4);
#pragma unroll
        for (int j = 0; j < 8; ++j) {
            const int n = n0 + ((j < 4) ? tx * 4 + j : 64 + tx * 4 + (j - 4));
            if (n < p.N) { float* c = C + (long)m * p.ldc + n; const float v = p.alpha * acc[i][j]; *c = p.acc ? (*c + v) : v; }
        }
    }
}

__global__ __launch_bounds__(128) void k_mla_pre(const float* __restrict__ proj, const int* __restrict__ pos, const float* __restrict__ qn, const float* __restrict__ wuq,
                                                  const float* __restrict__ kvn, const float* __restrict__ wukv, float* __restrict__ QM, float* __restrict__ KM, float* __restrict__ VM) {
    __shared__ float cq[192], ckv[128], qs[384], kvs[512], kr[32], red[2];
    const long t = blockIdx.x; const int tid = threadIdx.x;
    const float* pr = proj + t * INW;
    float s = 0.f;
    for (int i = tid; i < 192; i += 128) { float v = pr[C_CQ + i]; s += v * v; }
    for (int o = 32; o > 0; o >>= 1) s += __shfl_xor(s, o);
    if ((tid & 63) == 0) red[tid >> 6] = s;
    __syncthreads();
    float rs = rsqrtf((red[0] + red[1]) / 192.f + EPS);
    for (int i = tid; i < 192; i += 128) cq[i] = pr[C_CQ + i] * rs * qn[i];
    __syncthreads();
    s = 0.f;
    { float v = pr[C_CKV + tid]; s = v * v; }
    for (int o = 32; o > 0; o >>= 1) s += __shfl_xor(s, o);
    if ((tid & 63) == 0) red[tid >> 6] = s;
    __syncthreads();
    rs = rsqrtf((red[0] + red[1]) / 128.f + EPS);
    ckv[tid] = pr[C_CKV + tid] * rs * kvn[tid];
    if (tid < 32) kr[tid] = pr[C_KR + tid];
    __syncthreads();
    for (int j = tid; j < 384; j += 128) { float a = 0.f; for (int k = 0; k < 192; ++k) a += cq[k] * wuq[k * 384 + j]; qs[j] = a; }
    for (int j = tid; j < 512; j += 128) { float a = 0.f; for (int k = 0; k < 128; ++k) a += ckv[k] * wukv[k * 512 + j]; kvs[j] = a; }
    __syncthreads();
    const float fp = (float)pos[t];
    for (int idx = tid; idx < 4 * 96; idx += 128) {
        const int h = idx / 96, j = idx % 96;
        float qv, kv;
        if (j < 64) { qv = qs[h * 96 + j]; kv = kvs[h * 128 + j]; }
        else {
            const int r = j - 64, i = r & 15;
            const float inv = powf(10000.f, -(float)(2 * i) / 32.f);
            const float ang = fp * inv; const float c = cosf(ang), sn = sinf(ang);
            const float q1 = qs[h * 96 + 64 + i], q2 = qs[h * 96 + 80 + i], k1 = kr[i], k2 = kr[16 + i];
            if (r < 16) { qv = q1 * c - q2 * sn; kv = k1 * c - k2 * sn; } else { qv = q1 * sn + q2 * c; kv = k1 * sn + k2 * c; }
        }
        QM[(t * 4 + h) * 96 + j] = qv; KM[(t * 4 + h) * 96 + j] = kv;
    }
    for (int idx = tid; idx < 256; idx += 128) { const int h = idx >> 6, j = idx & 63; VM[(t * 4 + h) * 64 + j] = kvs[h * 128 + 64 + j]; }
}

__global__ __launch_bounds__(512) void k_lru_pre(const float* __restrict__ proj, const float* __restrict__ cw, const float* __restrict__ cb, const float* __restrict__ wa, const float* __restrict__ ba,
                                                  const float* __restrict__ wx, const float* __restrict__ bx, const float* __restrict__ lam, float* __restrict__ LA, float* __restrict__ LU) {
    __shared__ float xc[512];
    const long t = blockIdx.x; const int c = threadIdx.x; const int s = (int)(t % S);
    float y = cb[c];
#pragma unroll
    for (int k = 0; k < 4; ++k) { const int ts = s - 3 + k; if (ts >= 0) y += proj[(t - 3 + k) * INW + C_XL + c] * cw[k * 512 + c]; }
    xc[c] = y;
    __syncthreads();
    const int g = c >> 6, j = c & 63;
    float ra = ba[c], ri = bx[c];
    for (int i = 0; i < 64; ++i) { const float xv = xc[g * 64 + i]; ra += xv * wa[(g * 64 + i) * 64 + j]; ri += xv * wx[(g * 64 + i) * 64 + j]; }
    const float r = 1.f / (1.f + expf(-ra)), ig = 1.f / (1.f + expf(-ri));
    const float sp = log1pf(expf(-lam[c]));
    const float log_a = -8.0f * r * sp;
    const float a = expf(log_a);
    const float u = sqrtf(-expm1f(2.f * log_a)) * (ig * y);
    LA[t * 512 + c] = a; LU[t * 512 + c] = u;
}
__global__ __launch_bounds__(64) void k_lru_scan(const float* __restrict__ proj, const float* __restrict__ LA, float* __restrict__ LU) {
    const int id = blockIdx.x * 64 + threadIdx.x; const int b = id >> 9, c = id & 511;
    float h = 0.f;
    for (int s = 0; s < S; ++s) {
        const long t = (long)b * S + s;
        h = LA[t * 512 + c] * h + LU[t * 512 + c];
        const float gt = proj[t * INW + C_GL + c];
        LU[t * 512 + c] = h * (0.5f * gt * (1.f + erff(gt * 0.70710678118654752f)));
    }
}

__global__ __launch_bounds__(256) void k_attn_mla(const float* __restrict__ QM, const float* __restrict__ KM, const float* __restrict__ VM, float* __restrict__ OM) {
    __shared__ float Ks[64 * 96]; __shared__ float Vs[64 * 64];
    const int qb = blockIdx.x, h = blockIdx.y, b = blockIdx.z, tid = threadIdx.x;
    const int q = qb * 256 + tid; const long t = (long)b * S + q;
    const float scale = 0.10206207261596575f;
    float qr[96];
#pragma unroll
    for (int j = 0; j < 96; ++j) qr[j] = QM[(t * 4 + h) * 96 + j] * scale;
    float m = -1e30f, l = 0.f, o[64];
#pragma unroll
    for (int j = 0; j < 64; ++j) o[j] = 0.f;
    const int kend = (qb + 1) * 256;
    for (int k0 = 0; k0 < kend; k0 += 64) {
        __syncthreads();
        for (int i = tid; i < 64 * 96; i += 256) { const int kk = i / 96, j = i % 96; Ks[i] = KM[(((long)b * S + k0 + kk) * 4 + h) * 96 + j]; }
        for (int i = tid; i < 64 * 64; i += 256) { const int kk = i >> 6, j = i & 63; Vs[i] = VM[(((long)b * S + k0 + kk) * 4 + h) * 64 + j]; }
        __syncthreads();
        for (int kk = 0; kk < 64; ++kk) {
            if (k0 + kk <= q) {
                float s = 0.f;
#pragma unroll
                for (int j = 0; j < 96; ++j) s += qr[j] * Ks[kk * 96 + j];
                if (s > m) { const float corr = expf(m - s); l *= corr;
#pragma unroll
                    for (int j = 0; j < 64; ++j) o[j] *= corr;
                    m = s; }
                const float p = expf(s - m); l += p;
#pragma unroll
                for (int j = 0; j < 64; ++j) o[j] += p * Vs[kk * 64 + j];
            }
        }
    }
    const float il = 1.f / l;
#pragma unroll
    for (int j = 0; j < 64; ++j) OM[t * 256 + h * 64 + j] = o[j] * il;
}

__global__ __launch_bounds__(256) void k_attn_diff(const float* __restrict__ proj, const int* __restrict__ pos, const float* __restrict__ relb, const float* __restrict__ dnorm,
                                                   const float* __restrict__ dl, float lam_init, float* __restrict__ OD) {
    __shared__ float Ks[64 * 64]; __shared__ float Vs[64 * 64]; __shared__ int ps[64]; __shared__ float btab[129];
    const int qb = blockIdx.x, h = blockIdx.y, b = blockIdx.z, tid = threadIdx.x;
    const int q = qb * 256 + tid; const long t = (long)b * S + q;
    if (tid < 129) {
        const int n = tid; int bu;
        if (n < 16) bu = n; else { int lg = 16 + (int)(logf((float)n / 16.f) / logf(8.f) * 16.f); bu = lg < 31 ? lg : 31; }
        btab[tid] = relb[bu * 4 + h];
    }
    const float scale = 0.17677669529663687f;
    float lam;
    { float a = 0.f, c = 0.f; for (int j = 0; j < 32; ++j) { a += dl[j] * dl[32 + j]; c += dl[64 + j] * dl[96 + j]; } lam = expf(a) - expf(c) + lam_init; }
    float q1[32], q2[32];
#pragma unroll
    for (int j = 0; j < 32; ++j) { q1[j] = proj[t * INW + C_QD + h * 64 + j] * scale; q2[j] = proj[t * INW + C_QD + h * 64 + 32 + j] * scale; }
    const int pq = pos[t];
    float m1 = -1e30f, l1 = 0.f, m2 = -1e30f, l2 = 0.f, o1[64], o2[64];
#pragma unroll
    for (int j = 0; j < 64; ++j) { o1[j] = 0.f; o2[j] = 0.f; }
    const int kend = (qb + 1) * 256;
    for (int k0 = 0; k0 < kend; k0 += 64) {
        __syncthreads();
        for (int i = tid; i < 64 * 64; i += 256) { const int kk = i >> 6, j = i & 63; const long tk = (long)b * S + k0 + kk; Ks[i] = proj[tk * INW + C_KD + h * 64 + j]; Vs[i] = proj[tk * INW + C_VD + h * 64 + j]; }
        if (tid < 64) ps[tid] = pos[(long)b * S + k0 + tid];
        __syncthreads();
        for (int kk = 0; kk < 64; ++kk) {
            if (k0 + kk <= q) {
                int n = pq - ps[kk]; n = n < 0 ? 0 : (n > 128 ? 128 : n);
                const float bias = btab[n];
                float s1 = bias, s2 = bias;
#pragma unroll
                for (int j = 0; j < 32; ++j) { s1 += q1[j] * Ks[kk * 64 + j]; s2 += q2[j] * Ks[kk * 64 + 32 + j]; }
                if (s1 > m1) { const float corr = expf(m1 - s1); l1 *= corr;
#pragma unroll
                    for (int j = 0; j < 64; ++j) o1[j] *= corr;
                    m1 = s1; }
                if (s2 > m2) { const float corr = expf(m2 - s2); l2 *= corr;
#pragma unroll
                    for (int j = 0; j < 64; ++j) o2[j] *= corr;
                    m2 = s2; }
                const float p1 = expf(s1 - m1), p2 = expf(s2 - m2); l1 += p1; l2 += p2;
#pragma unroll
                for (int j = 0; j < 64; ++j) { const float v = Vs[kk * 64 + j]; o1[j] += p1 * v; o2[j] += p2 * v; }
            }
        }
    }
    const float i1 = 1.f / l1, i2 = lam / l2;
    float ss = 0.f;
#pragma unroll
    for (int j = 0; j < 64; ++j) { o1[j] = o1[j] * i1 - o2[j] * i2; ss += o1[j] * o1[j]; }
    const float rs = rsqrtf(ss / 64.f + EPS) * (1.f - lam_init);
#pragma unroll
    for (int j = 0; j < 64; ++j) OD[t * 256 + h * 64 + j] = o1[j] * rs * dnorm[j];
}

__global__ __launch_bounds__(256) void k_post(const float* __restrict__ OM, const float* __restrict__ H, const float* __restrict__ OD, const float* __restrict__ gm, const float* __restrict__ gl, float* __restrict__ Y) {
    __shared__ float red[8];
    const long t = blockIdx.x; const int tid = threadIdx.x;
    const float a = OM[t * 256 + tid], h0 = H[t * 512 + tid], h1 = H[t * 512 + 256 + tid];
    float s1 = a * a, s2 = h0 * h0 + h1 * h1;
    for (int o = 32; o > 0; o >>= 1) { s1 += __shfl_xor(s1, o); s2 += __shfl_xor(s2, o); }
    if ((tid & 63) == 0) { red[tid >> 6] = s1; red[4 + (tid >> 6)] = s2; }
    __syncthreads();
    const float r1 = rsqrtf((red[0] + red[1] + red[2] + red[3]) / 256.f + EPS), r2 = rsqrtf((red[4] + red[5] + red[6] + red[7]) / 512.f + EPS);
    Y[t * 1024 + tid] = a * r1 * gm[tid];
    Y[t * 1024 + 256 + tid] = h0 * r2 * gl[tid];
    Y[t * 1024 + 512 + tid] = h1 * r2 * gl[256 + tid];
    Y[t * 1024 + 768 + tid] = OD[t * 256 + tid];
}

__global__ __launch_bounds__(256) void k_softmax256(float* __restrict__ Sm, long rows) {
    const long row = (long)blockIdx.x * 4 + (threadIdx.x >> 6); const int lane = threadIdx.x & 63;
    if (row >= rows) return;
    float* r = Sm + row * 256;
    float v[4]; float m = -1e30f;
#pragma unroll
    for (int i = 0; i < 4; ++i) { v[i] = r[lane + 64 * i]; m = fmaxf(m, v[i]); }
    for (int o = 32; o > 0; o >>= 1) m = fmaxf(m, __shfl_xor(m, o));
    float s = 0.f;
#pragma unroll
    for (int i = 0; i < 4; ++i) { v[i] = expf(v[i] - m); s += v[i]; }
    for (int o = 32; o > 0; o >>= 1) s += __shfl_xor(s, o);
    const float is = 1.f / s;
#pragma unroll
    for (int i = 0; i < 4; ++i) r[lane + 64 * i] = v[i] * is;
}

__global__ __launch_bounds__(256) void k_route(const float* __restrict__ QP, const float* __restrict__ keys, int* __restrict__ EX, float* __restrict__ GW) {
    __shared__ float q[1024]; __shared__ float sc[16][128]; __shared__ float ts[16][16]; __shared__ int ti[16][16]; __shared__ float cand[8][256];
    const long t = blockIdx.x; const int tid = threadIdx.x;
    for (int i = tid; i < 1024; i += 256) q[i] = QP[t * 1024 + i];
    __syncthreads();
    for (int i = tid; i < 2048; i += 256) {
        const int li = i >> 7, n = i & 127, c = li & 1;
        const float* kp = keys + ((long)c * 128 + n) * 64; const float* qp = q + li * 64;
        float a = 0.f;
        for (int d = 0; d < 64; ++d) a += qp[d] * kp[d];
        sc[li][n] = a;
    }
    __syncthreads();
    if (tid < 16) {
        for (int r = 0; r < 16; ++r) {
            float best = -3.0e38f; int bi = 0;
            for (int n = 0; n < 128; ++n) { const float v = sc[tid][n]; if (v > best) { best = v; bi = n; } }
            ts[tid][r] = best; ti[tid][r] = bi; sc[tid][bi] = -3.0e38f;
        }
    }
    __syncthreads();
    for (int i = tid; i < 2048; i += 256) { const int h = i >> 8, ab = i & 255; cand[h][ab] = ts[h * 2][ab >> 4] + ts[h * 2 + 1][ab & 15]; }
    __syncthreads();
    if (tid < 8) {
        float bs[16]; int be[16];
        float mx = -3.0e38f;
#pragma unroll
        for (int r = 0; r < 16; ++r) {
            float best = -3.0e38f; int bi = 0;
            for (int n = 0; n < 256; ++n) { const float v = cand[tid][n]; if (v > best) { best = v; bi = n; } }
            cand[tid][bi] = -3.0e38f;
            bs[r] = best; be[r] = ti[tid * 2][bi >> 4] * 128 + ti[tid * 2 + 1][bi & 15];
            mx = fmaxf(mx, best);
        }
        float sum = 0.f;
#pragma unroll
        for (int r = 0; r < 16; ++r) { bs[r] = expf(bs[r] - mx); sum += bs[r]; }
        const float is = 1.f / sum;
#pragma unroll
        for (int r = 0; r < 16; ++r) { EX[t * 128 + tid * 16 + r] = be[r]; GW[t * 128 + tid * 16 + r] = bs[r] * is; }
    }
}

__global__ __launch_bounds__(256) void k_peer(const float* __restrict__ XN, const int* __restrict__ EX, const float* __restrict__ GW, const float* __restrict__ U, const float* __restrict__ V, float* __restrict__ X) {
    __shared__ float hs[1024]; __shared__ float w[128]; __shared__ int es[128];
    const long t = blockIdx.x; const int tid = threadIdx.x, wave = tid >> 6, lane = tid & 63;
    for (int i = tid; i < 1024; i += 256) hs[i] = XN[t * 1024 + i];
    if (tid < 128) es[tid] = EX[t * 128 + tid];
    __syncthreads();
    for (int j = wave; j < 128; j += 4) {
        const float* up = U + (long)es[j] * 1024;
        float a = 0.f;
        for (int i = lane; i < 1024; i += 64) a += hs[i] * up[i];
        for (int o = 32; o > 0; o >>= 1) a += __shfl_xor(a, o);
        if (lane == 0) w[j] = GW[t * 128 + j] * (0.5f * a * (1.f + erff(a * 0.70710678118654752f)));
    }
    __syncthreads();
    float o[4] = {0.f, 0.f, 0.f, 0.f};
    for (int j = 0; j < 128; ++j) {
        const float* vp = V + (long)es[j] * 1024; const float wj = w[j];
#pragma unroll
        for (int i = 0; i < 4; ++i) o[i] += wj * vp[tid + 256 * i];
    }
#pragma unroll
    for (int i = 0; i < 4; ++i) X[t * 1024 + tid + 256 * i] += o[i];
}

void gemm(hipStream_t st, const float* A, long lda, const float* Bm, long sbk, long sbn, float* C, long ldc, int M, int N, int K, float alpha, int acc,
          int batch = 1, int nh = 1, long aB = 0, long aH = 0, long bB = 0, long bH = 0, long cB = 0, long cH = 0) {
    GemmP p{}; p.A = A; p.Bm = Bm; p.C = C; p.lda = lda; p.sbk = sbk; p.sbn = sbn; p.ldc = ldc; p.M = M; p.N = N; p.K = K; p.nh = nh;
    p.aB = aB; p.aH = aH; p.bB = bB; p.bH = bH; p.cB = cB; p.cH = cH; p.alpha = alpha; p.acc = acc;
    hipLaunchKernelGGL(k_gemm, dim3((N + 127) / 128, M / 128, batch), dim3(256), 0, st, p);
}
}

extern "C" void kernel_launch(void* const* d_in, const int* in_sizes, int n_in, void* d_out, int out_size, void* d_ws, size_t ws_size, hipStream_t stream) {
    (void)in_sizes; (void)n_in; (void)out_size; (void)ws_size;
    const float* x_in = (const float*)d_in[0]; const float* mem = (const float*)d_in[1]; const int* pos = (const int*)d_in[2]; const float* relb = (const float*)d_in[3];
    const float* norm_mix = (const float*)d_in[4]; const float* w_in = (const float*)d_in[5]; const float* q_norm = (const float*)d_in[6]; const float* w_uq = (const float*)d_in[7];
    const float* kv_norm = (const float*)d_in[8]; const float* w_ukv = (const float*)d_in[9]; const float* conv_w = (const float*)d_in[10]; const float* conv_b = (const float*)d_in[11];
    const float* w_a = (const float*)d_in[12]; const float* b_a = (const float*)d_in[13]; const float* w_x = (const float*)d_in[14]; const float* b_x = (const float*)d_in[15];
    const float* lru_lam = (const float*)d_in[16]; const float* diff_lam = (const float*)d_in[17]; const float* diff_norm = (const float*)d_in[18];
    const float* onm = (const float*)d_in[19]; const float* onl = (const float*)d_in[20]; const float* w_out = (const float*)d_in[21];
    const float* norm_cross = (const float*)d_in[22]; const float* norm_mem = (const float*)d_in[23]; const float* w_cq = (const float*)d_in[24]; const float* w_ckv = (const float*)d_in[25];
    const float* w_co = (const float*)d_in[26]; const float* norm_ffn = (const float*)d_in[27]; const float* peer_wq = (const float*)d_in[28]; const float* peer_keys = (const float*)d_in[29];
    const float* peer_u = (const float*)d_in[30]; const float* peer_v = (const float*)d_in[31]; const float* norm_final = (const float*)d_in[32];
    float* X = (float*)d_out;
    float* ws = (float*)d_ws; size_t off = 0;
    auto take = [&](size_t n) { float* p = ws + off; off += (n + 63) & ~(size_t)63; return p; };
    float* XN = take((size_t)T * D); float* PROJ = take((size_t)T * INW);
    float* QM = take((size_t)T * 384); float* KM = take((size_t)T * 384); float* VM = take((size_t)T * 256);
    float* LA = take((size_t)T * 512); float* LU = take((size_t)T * 512);
    float* OM = take((size_t)T * 256); float* OD = take((size_t)T * 256); float* Y = take((size_t)T * D);
    float* MN = take((size_t)NB * MEM * D); float* KVC = take((size_t)NB * MEM * 2 * D);
    float* QC = PROJ;
    float* SC = QM;
    float* OC = Y;
    float* QP = PROJ; int* EX = (int*)take((size_t)T * 128); float* GW = take((size_t)T * 128);

    hipLaunchKernelGGL(k_copy4, dim3((T * D / 4 + 255) / 256), dim3(256), 0, stream, (const float4*)x_in, (float4*)X, (long)T * D / 4);
    for (int l = 0; l < L; ++l) {
        hipLaunchKernelGGL(k_rmsnorm, dim3(T), dim3(256), 0, stream, X, norm_mix + l * D, XN, D);
        gemm(stream, XN, D, w_in + (size_t)l * D * INW, INW, 1, PROJ, INW, T, INW, D, 1.f, 0);
        hipLaunchKernelGGL(k_mla_pre, dim3(T), dim3(128), 0, stream, PROJ, pos, q_norm + l * 192, w_uq + (size_t)l * 192 * 384, kv_norm + l * 128, w_ukv + (size_t)l * 128 * 512, QM, KM, VM);
        hipLaunchKernelGGL(k_lru_pre, dim3(T), dim3(512), 0, stream, PROJ, conv_w + l * 4 * 512, conv_b + l * 512, w_a + (size_t)l * 8 * 64 * 64, b_a + l * 512, w_x + (size_t)l * 8 * 64 * 64, b_x + l * 512, lru_lam + l * 512, LA, LU);
        hipLaunchKernelGGL(k_lru_scan, dim3(NB * 512 / 64), dim3(64), 0, stream, PROJ, LA, LU);
        hipLaunchKernelGGL(k_attn_mla, dim3(S / 256, 4, NB), dim3(256), 0, stream, QM, KM, VM, OM);
        const float lam_init = 0.8f - 0.6f * expf(-0.3f * (float)l);
        hipLaunchKernelGGL(k_attn_diff, dim3(S / 256, 4, NB), dim3(256), 0, stream, PROJ, pos, relb, diff_norm + l * 64, diff_lam + l * 128, lam_init, OD);
        hipLaunchKernelGGL(k_post, dim3(T), dim3(256), 0, stream, OM, LU, OD, onm + l * 256, onl + l * 512, Y);
        gemm(stream, Y, D, w_out + (size_t)l * D * D, D, 1, X, D, T, D, D, 1.f, 1);
        hipLaunchKernelGGL(k_rmsnorm, dim3(T), dim3(256), 0, stream, X, norm_cross + l * D, XN, D);
        hipLaunchKernelGGL(k_rmsnorm, dim3(NB * MEM), dim3(256), 0, stream, mem, norm_mem + l * D, MN, D);
        gemm(stream, MN, D, w_ckv + (size_t)l * D * 2 * D, 2 * D, 1, KVC, 2 * D, NB * MEM, 2 * D, D, 1.f, 0);
        gemm(stream, XN, D, w_cq + (size_t)l * D * D, D, 1, QC, D, T, D, D, 1.f, 0);
        gemm(stream, QC, D, KVC, 1, 2 * D, SC, 256, S, 256, 256, 1.f / 16.f, 0, NB * 4, 4, (long)S * D, 256, (long)MEM * 2 * D, 256, (long)4 * S * 256, (long)S * 256);
        hipLaunchKernelGGL(k_softmax256, dim3(T * 4 / 4), dim3(256), 0, stream, SC, (long)T * 4);
        gemm(stream, SC, 256, KVC + D, 2 * D, 1, OC, D, S, 256, 256, 1.f, 0, NB * 4, 4, (long)4 * S * 256, (long)S * 256, (long)MEM * 2 * D, 256, (long)S * D, 256);
        gemm(stream, OC, D, w_co + (size_t)l * D * D, D, 1, X, D, T, D, D, 1.f, 1);
        hipLaunchKernelGGL(k_rmsnorm, dim3(T), dim3(256), 0, stream, X, norm_ffn + l * D, XN, D);
        gemm(stream, XN, D, peer_wq + (size_t)l * D * D, D, 1, QP, D, T, D, D, 1.f, 0);
        hipLaunchKernelGGL(k_route, dim3(T), dim3(256), 0, stream, QP, peer_keys + (size_t)l * 2 * 128 * 64, EX, GW);
        hipLaunchKernelGGL(k_peer, dim3(T), dim3(256), 0, stream, XN, EX, GW, peer_u + (size_t)l * NEXP * D, peer_v + (size_t)l * NEXP * D, X);
    }
    hipLaunchKernelGGL(k_rmsnorm, dim3(T), dim3(256), 0, stream, X, norm_final, X, D);
}
```

```cpp
#include <hip/hip_runtime.h>
#include <cstdint>
#include <cstdio>
#include <cmath>

namespace {
constexpr int D = 1024, NB = 4, S = 8192, T = NB * S, L = 4, MEM = 256;
constexpr int INW = 2144;
constexpr int C_CQ = 0, C_CKV = 192, C_KR = 320, C_XL = 352, C_GL = 864, C_QD = 1376, C_KD = 1632, C_VD = 1888;
constexpr float EPS = 1e-6f;
constexpr int NEXP = 16384;

typedef unsigned short bf16_t;
__device__ __forceinline__ unsigned f2bf(float f) { unsigned u = __builtin_bit_cast(unsigned, f); return (u + 0x7fffu + ((u >> 16) & 1u)) >> 16; }
__device__ __forceinline__ float bf2f(unsigned short b) { return __builtin_bit_cast(float, (unsigned)b << 16); }
__global__ void k_f2bf(const float* __restrict__ a, bf16_t* __restrict__ o, long n) {
    long i = (long)blockIdx.x * blockDim.x + threadIdx.x;
    if (i < n) o[i] = (bf16_t)f2bf(a[i]);
}
__global__ void k_copy4(const float4* __restrict__ a, float4* __restrict__ o, long n4) {
    long i = (long)blockIdx.x * blockDim.x + threadIdx.x;
    if (i < n4) o[i] = a[i];
}

__global__ __launch_bounds__(256) void k_rmsnorm(const float* in, const float* __restrict__ g, float* out, bf16_t* outb, int Dn) {
    __shared__ float red[4];
    const long row = blockIdx.x;
    const float* x = in + row * Dn;
    float s = 0.f;
    for (int i = threadIdx.x; i < Dn; i += 256) { float v = x[i]; s += v * v; }
    for (int o = 32; o > 0; o >>= 1) s += __shfl_xor(s, o);
    if ((threadIdx.x & 63) == 0) red[threadIdx.x >> 6] = s;
    __syncthreads();
    s = red[0] + red[1] + red[2] + red[3];
    const float rs = rsqrtf(s / (float)Dn + EPS);
    for (int i = threadIdx.x; i < Dn; i += 256) { const float v = x[i] * rs * g[i]; if (out) out[row * Dn + i] = v; if (outb) outb[row * Dn + i] = (bf16_t)f2bf(v); }
}

struct GemmP { const float* A; const float* Bm; float* C; long lda, sbk, sbn, ldc; int M, N, K, nh; long aB, aH, bB, bH, cB, cH; float alpha; int acc; };
__global__ __launch_bounds__(256) void k_gemm(GemmP p) {
    __shared__ float As[16][128 + 4];
    __shared__ float Bs[16][128 + 4];
    const int tid = threadIdx.x, tx = tid & 15, ty = tid >> 4;
    const int zb = blockIdx.z / p.nh, zh = blockIdx.z % p.nh;
    const float* A = p.A + zb * p.aB + zh * p.aH + (long)blockIdx.y * 128 * p.lda;
    const float* Bm = p.Bm + zb * p.bB + zh * p.bH;
    float* C = p.C + zb * p.cB + zh * p.cH + (long)blockIdx.y * 128 * p.ldc;
    const int n0 = blockIdx.x * 128;
    float acc[8][8];
#pragma unroll
    for (int i = 0; i < 8; ++i)
#pragma unroll
        for (int j = 0; j < 8; ++j) acc[i][j] = 0.f;
    for (int k0 = 0; k0 < p.K; k0 += 16) {
#pragma unroll
        for (int r = 0; r < 2; ++r) {
            const int idx = tid + r * 256;
            const int m = idx >> 2, kq = (idx & 3) * 4;
            const float4 v = *(const float4*)(A + (long)m * p.lda + k0 + kq);
            As[kq + 0][m] = v.x; As[kq + 1][m] = v.y; As[kq + 2][m] = v.z; As[kq + 3][m] = v.w;
        }
#pragma unroll
        for (int r = 0; r < 8; ++r) {
            const int idx = tid + r * 256;
            int kk, nn;
            if (p.sbn == 1) { kk = idx >> 7; nn = idx & 127; } else { kk = idx & 15; nn = idx >> 4; }
            const int n = n0 + nn;
            Bs[kk][nn] = (n < p.N) ? Bm[(long)(k0 + kk) * p.sbk + (long)n * p.sbn] : 0.f;
        }
        __syncthreads();
#pragma unroll
        for (int kk = 0; kk < 16; ++kk) {
            float a[8], b[8];
#pragma unroll
            for (int i = 0; i < 4; ++i) { a[i] = As[kk][ty * 4 + i]; a[4 + i] = As[kk][64 + ty * 4 + i]; b[i] = Bs[kk][tx * 4 + i]; b[4 + i] = Bs[kk][64 + tx * 4 + i]; }
#pragma unroll
            for (int i = 0; i < 8; ++i)
#pragma unroll
                for (int j = 0; j < 8; ++j) acc[i][j] += a[i] * b[j];
        }
        __syncthreads();
    }
#pragma unroll
    for (int i = 0; i < 8; ++i) {
        const int m = (i < 4) ? ty * 4 + i : 64 + ty * 4 + (i - 4);
#pragma unroll
        for (int j = 0; j < 8; ++j) {
            const int n = n0 + ((j < 4) ? tx * 4 + j : 64 + tx * 4 + (j - 4));
            if (n < p.N) { float* c = C + (long)m * p.ldc + n; const float v = p.alpha * acc[i][j]; *c = p.acc ? (*c + v) : v; }
        }
    }
}

__global__ __launch_bounds__(128) void k_mla_pre(const float* __restrict__ proj, const int* __restrict__ pos, const float* __restrict__ qn, const float* __restrict__ wuq,
                                                  const float* __restrict__ kvn, const float* __restrict__ wukv, float* __restrict__ QM, float* __restrict__ KM, float* __restrict__ VM) {
    __shared__ float cq[192], ckv[128], qs[384], kvs[512], kr[32], red[2];
    const long t = blockIdx.x; const int tid = threadIdx.x;
    const float* pr = proj + t * INW;
    float s = 0.f;
    for (int i = tid; i < 192; i += 128) { float v = pr[C_CQ + i]; s += v * v; }
    for (int o = 32; o > 0; o >>= 1) s += __shfl_xor(s, o);
    if ((tid & 63) == 0) red[tid >> 6] = s;
    __syncthreads();
    float rs = rsqrtf((red[0] + red[1]) / 192.f + EPS);
    for (int i = tid; i < 192; i += 128) cq[i] = pr[C_CQ + i] * rs * qn[i];
    __syncthreads();
    s = 0.f;
    { float v = pr[C_CKV + tid]; s = v * v; }
    for (int o = 32; o > 0; o >>= 1) s += __shfl_xor(s, o);
    if ((tid & 63) == 0) red[tid >> 6] = s;
    __syncthreads();
    rs = rsqrtf((red[0] + red[1]) / 128.f + EPS);
    ckv[tid] = pr[C_CKV + tid] * rs * kvn[tid];
    if (tid < 32) kr[tid] = pr[C_KR + tid];
    __syncthreads();
    for (int j = tid; j < 384; j += 128) { float a = 0.f; for (int k = 0; k < 192; ++k) a += cq[k] * wuq[k * 384 + j]; qs[j] = a; }
    for (int j = tid; j < 512; j += 128) { float a = 0.f; for (int k = 0; k < 128; ++k) a += ckv[k] * wukv[k * 512 + j]; kvs[j] = a; }
    __syncthreads();
    const float fp = (float)pos[t];
    for (int idx = tid; idx < 4 * 96; idx += 128) {
        const int h = idx / 96, j = idx % 96;
        float qv, kv;
        if (j < 64) { qv = qs[h * 96 + j]; kv = kvs[h * 128 + j]; }
        else {
            const int r = j - 64, i = r & 15;
            const float inv = powf(10000.f, -(float)(2 * i) / 32.f);
            const float ang = fp * inv; const float c = cosf(ang), sn = sinf(ang);
            const float q1 = qs[h * 96 + 64 + i], q2 = qs[h * 96 + 80 + i], k1 = kr[i], k2 = kr[16 + i];
            if (r < 16) { qv = q1 * c - q2 * sn; kv = k1 * c - k2 * sn; } else { qv = q1 * sn + q2 * c; kv = k1 * sn + k2 * c; }
        }
        QM[(t * 4 + h) * 96 + j] = qv; KM[(t * 4 + h) * 96 + j] = kv;
    }
    for (int idx = tid; idx < 256; idx += 128) { const int h = idx >> 6, j = idx & 63; VM[(t * 4 + h) * 64 + j] = kvs[h * 128 + 64 + j]; }
}

__global__ __launch_bounds__(512) void k_lru_pre(const float* __restrict__ proj, const float* __restrict__ cw, const float* __restrict__ cb, const float* __restrict__ wa, const float* __restrict__ ba,
                                                  const float* __restrict__ wx, const float* __restrict__ bx, const float* __restrict__ lam, float* __restrict__ LA, float* __restrict__ LU) {
    __shared__ float xc[512];
    const long t = blockIdx.x; const int c = threadIdx.x; const int s = (int)(t % S);
    float y = cb[c];
#pragma unroll
    for (int k = 0; k < 4; ++k) { const int ts = s - 3 + k; if (ts >= 0) y += proj[(t - 3 + k) * INW + C_XL + c] * cw[k * 512 + c]; }
    xc[c] = y;
    __syncthreads();
    const int g = c >> 6, j = c & 63;
    float ra = ba[c], ri = bx[c];
    for (int i = 0; i < 64; ++i) { const float xv = xc[g * 64 + i]; ra += xv * wa[(g * 64 + i) * 64 + j]; ri += xv * wx[(g * 64 + i) * 64 + j]; }
    const float r = 1.f / (1.f + expf(-ra)), ig = 1.f / (1.f + expf(-ri));
    const float sp = log1pf(expf(-lam[c]));
    const float log_a = -8.0f * r * sp;
    const float a = expf(log_a);
    const float u = sqrtf(-expm1f(2.f * log_a)) * (ig * y);
    LA[t * 512 + c] = a; LU[t * 512 + c] = u;
}
__global__ __launch_bounds__(64) void k_lru_scan(const float* __restrict__ proj, const float* __restrict__ LA, float* __restrict__ LU) {
    const int id = blockIdx.x * 64 + threadIdx.x; const int b = id >> 9, c = id & 511;
    float h = 0.f;
    for (int s = 0; s < S; ++s) {
        const long t = (long)b * S + s;
        h = LA[t * 512 + c] * h + LU[t * 512 + c];
        const float gt = proj[t * INW + C_GL + c];
        LU[t * 512 + c] = h * (0.5f * gt * (1.f + erff(gt * 0.70710678118654752f)));
    }
}

__global__ __launch_bounds__(256) void k_attn_mla(const float* __restrict__ QM, const float* __restrict__ KM, const float* __restrict__ VM, float* __restrict__ OM) {
    __shared__ float Ks[64 * 96]; __shared__ float Vs[64 * 64];
    const int qb = blockIdx.x, h = blockIdx.y, b = blockIdx.z, tid = threadIdx.x;
    const int q = qb * 256 + tid; const long t = (long)b * S + q;
    const float scale = 0.10206207261596575f;
    float qr[96];
#pragma unroll
    for (int j = 0; j < 96; ++j) qr[j] = QM[(t * 4 + h) * 96 + j] * scale;
    float m = -1e30f, l = 0.f, o[64];
#pragma unroll
    for (int j = 0; j < 64; ++j) o[j] = 0.f;
    const int kend = (qb + 1) * 256;
    for (int k0 = 0; k0 < kend; k0 += 64) {
        __syncthreads();
        for (int i = tid; i < 64 * 96; i += 256) { const int kk = i / 96, j = i % 96; Ks[i] = KM[(((long)b * S + k0 + kk) * 4 + h) * 96 + j]; }
        for (int i = tid; i < 64 * 64; i += 256) { const int kk = i >> 6, j = i & 63; Vs[i] = VM[(((long)b * S + k0 + kk) * 4 + h) * 64 + j]; }
        __syncthreads();
        for (int kk = 0; kk < 64; ++kk) {
            if (k0 + kk <= q) {
                float s = 0.f;
#pragma unroll
                for (int j = 0; j < 96; ++j) s += qr[j] * Ks[kk * 96 + j];
                if (s > m) { const float corr = expf(m - s); l *= corr;
#pragma unroll
                    for (int j = 0; j < 64; ++j) o[j] *= corr;
                    m = s; }
                const float p = expf(s - m); l += p;
#pragma unroll
                for (int j = 0; j < 64; ++j) o[j] += p * Vs[kk * 64 + j];
            }
        }
    }
    const float il = 1.f / l;
#pragma unroll
    for (int j = 0; j < 64; ++j) OM[t * 256 + h * 64 + j] = o[j] * il;
}

__global__ __launch_bounds__(256) void k_attn_diff(const float* __restrict__ proj, const int* __restrict__ pos, const float* __restrict__ relb, const float* __restrict__ dnorm,
                                                   const float* __restrict__ dl, float lam_init, float* __restrict__ OD) {
    __shared__ float Ks[64 * 64]; __shared__ float Vs[64 * 64]; __shared__ int ps[64]; __shared__ float btab[129];
    const int qb = blockIdx.x, h = blockIdx.y, b = blockIdx.z, tid = threadIdx.x;
    const int q = qb * 256 + tid; const long t = (long)b * S + q;
    if (tid < 129) {
        const int n = tid; int bu;
        if (n < 16) bu = n; else { int lg = 16 + (int)(logf((float)n / 16.f) / logf(8.f) * 16.f); bu = lg < 31 ? lg : 31; }
        btab[tid] = relb[bu * 4 + h];
    }
    const float scale = 0.17677669529663687f;
    float lam;
    { float a = 0.f, c = 0.f; for (int j = 0; j < 32; ++j) { a += dl[j] * dl[32 + j]; c += dl[64 + j] * dl[96 + j]; } lam = expf(a) - expf(c) + lam_init; }
    float q1[32], q2[32];
#pragma unroll
    for (int j = 0; j < 32; ++j) { q1[j] = proj[t * INW + C_QD + h * 64 + j] * scale; q2[j] = proj[t * INW + C_QD + h * 64 + 32 + j] * scale; }
    const int pq = pos[t];
    float m1 = -1e30f, l1 = 0.f, m2 = -1e30f, l2 = 0.f, o1[64], o2[64];
#pragma unroll
    for (int j = 0; j < 64; ++j) { o1[j] = 0.f; o2[j] = 0.f; }
    const int kend = (qb + 1) * 256;
    for (int k0 = 0; k0 < kend; k0 += 64) {
        __syncthreads();
        for (int i = tid; i < 64 * 64; i += 256) { const int kk = i >> 6, j = i & 63; const long tk = (long)b * S + k0 + kk; Ks[i] = proj[tk * INW + C_KD + h * 64 + j]; Vs[i] = proj[tk * INW + C_VD + h * 64 + j]; }
        if (tid < 64) ps[tid] = pos[(long)b * S + k0 + tid];
        __syncthreads();
        for (int kk = 0; kk < 64; ++kk) {
            if (k0 + kk <= q) {
                int n = pq - ps[kk]; n = n < 0 ? 0 : (n > 128 ? 128 : n);
                const float bias = btab[n];
                float s1 = bias, s2 = bias;
#pragma unroll
                for (int j = 0; j < 32; ++j) { s1 += q1[j] * Ks[kk * 64 + j]; s2 += q2[j] * Ks[kk * 64 + 32 + j]; }
                if (s1 > m1) { const float corr = expf(m1 - s1); l1 *= corr;
#pragma unroll
                    for (int j = 0; j < 64; ++j) o1[j] *= corr;
                    m1 = s1; }
                if (s2 > m2) { const float corr = expf(m2 - s2); l2 *= corr;
#pragma unroll
                    for (int j = 0; j < 64; ++j) o2[j] *= corr;
                    m2 = s2; }
                const float p1 = expf(s1 - m1), p2 = expf(s2 - m2); l1 += p1; l2 += p2;
#pragma unroll
                for (int j = 0; j < 64; ++j) { const float v = Vs[kk * 64 + j]; o1[j] += p1 * v; o2[j] += p2 * v; }
            }
        }
    }
    const float i1 = 1.f / l1, i2 = lam / l2;
    float ss = 0.f;
#pragma unroll
    for (int j = 0; j < 64; ++j) { o1[j] = o1[j] * i1 - o2[j] * i2; ss += o1[j] * o1[j]; }
    const float rs = rsqrtf(ss / 64.f + EPS) * (1.f - lam_init);
#pragma unroll
    for (int j = 0; j < 64; ++j) OD[t * 256 + h * 64 + j] = o1[j] * rs * dnorm[j];
}

__global__ __launch_bounds__(256) void k_post(const float* __restrict__ OM, const float* __restrict__ H, const float* __restrict__ OD, const float* __restrict__ gm, const float* __restrict__ gl, bf16_t* __restrict__ Y) {
    __shared__ float red[8];
    const long t = blockIdx.x; const int tid = threadIdx.x;
    const float a = OM[t * 256 + tid], h0 = H[t * 512 + tid], h1 = H[t * 512 + 256 + tid];
    float s1 = a * a, s2 = h0 * h0 + h1 * h1;
    for (int o = 32; o > 0; o >>= 1) { s1 += __shfl_xor(s1, o); s2 += __shfl_xor(s2, o); }
    if ((tid & 63) == 0) { red[tid >> 6] = s1; red[4 + (tid >> 6)] = s2; }
    __syncthreads();
    const float r1 = rsqrtf((red[0] + red[1] + red[2] + red[3]) / 256.f + EPS), r2 = rsqrtf((red[4] + red[5] + red[6] + red[7]) / 512.f + EPS);
    Y[t * 1024 + tid] = (bf16_t)f2bf(a * r1 * gm[tid]);
    Y[t * 1024 + 256 + tid] = (bf16_t)f2bf(h0 * r2 * gl[tid]);
    Y[t * 1024 + 512 + tid] = (bf16_t)f2bf(h1 * r2 * gl[256 + tid]);
    Y[t * 1024 + 768 + tid] = (bf16_t)f2bf(OD[t * 256 + tid]);
}

__global__ __launch_bounds__(256) void k_softmax256(float* __restrict__ Sm, long rows) {
    const long row = (long)blockIdx.x * 4 + (threadIdx.x >> 6); const int lane = threadIdx.x & 63;
    if (row >= rows) return;
    float* r = Sm + row * 256;
    float v[4]; float m = -1e30f;
#pragma unroll
    for (int i = 0; i < 4; ++i) { v[i] = r[lane + 64 * i]; m = fmaxf(m, v[i]); }
    for (int o = 32; o > 0; o >>= 1) m = fmaxf(m, __shfl_xor(m, o));
    float s = 0.f;
#pragma unroll
    for (int i = 0; i < 4; ++i) { v[i] = expf(v[i] - m); s += v[i]; }
    for (int o = 32; o > 0; o >>= 1) s += __shfl_xor(s, o);
    const float is = 1.f / s;
#pragma unroll
    for (int i = 0; i < 4; ++i) r[lane + 64 * i] = v[i] * is;
}

__global__ __launch_bounds__(256) void k_route(const float* __restrict__ QP, const float* __restrict__ keys, int* __restrict__ EX, float* __restrict__ GW) {
    __shared__ float q[1024]; __shared__ float sc[16][128]; __shared__ float ts[16][16]; __shared__ int ti[16][16]; __shared__ float cand[8][256];
    const long t = blockIdx.x; const int tid = threadIdx.x;
    for (int i = tid; i < 1024; i += 256) q[i] = QP[t * 1024 + i];
    __syncthreads();
    for (int i = tid; i < 2048; i += 256) {
        const int li = i >> 7, n = i & 127, c = li & 1;
        const float* kp = keys + ((long)c * 128 + n) * 64; const float* qp = q + li * 64;
        float a = 0.f;
        for (int d = 0; d < 64; ++d) a += qp[d] * kp[d];
        sc[li][n] = a;
    }
    __syncthreads();
    if (tid < 16) {
        for (int r = 0; r < 16; ++r) {
            float best = -3.0e38f; int bi = 0;
            for (int n = 0; n < 128; ++n) { const float v = sc[tid][n]; if (v > best) { best = v; bi = n; } }
            ts[tid][r] = best; ti[tid][r] = bi; sc[tid][bi] = -3.0e38f;
        }
    }
    __syncthreads();
    for (int i = tid; i < 2048; i += 256) { const int h = i >> 8, ab = i & 255; cand[h][ab] = ts[h * 2][ab >> 4] + ts[h * 2 + 1][ab & 15]; }
    __syncthreads();
    if (tid < 8) {
        float bs[16]; int be[16];
        float mx = -3.0e38f;
#pragma unroll
        for (int r = 0; r < 16; ++r) {
            float best = -3.0e38f; int bi = 0;
            for (int n = 0; n < 256; ++n) { const float v = cand[tid][n]; if (v > best) { best = v; bi = n; } }
            cand[tid][bi] = -3.0e38f;
            bs[r] = best; be[r] = ti[tid * 2][bi >> 4] * 128 + ti[tid * 2 + 1][bi & 15];
            mx = fmaxf(mx, best);
        }
        float sum = 0.f;
#pragma unroll
        for (int r = 0; r < 16; ++r) { bs[r] = expf(bs[r] - mx); sum += bs[r]; }
        const float is = 1.f / sum;
#pragma unroll
        for (int r = 0; r < 16; ++r) { EX[t * 128 + tid * 16 + r] = be[r]; GW[t * 128 + tid * 16 + r] = bs[r] * is; }
    }
}

__global__ __launch_bounds__(256) void k_peer(const bf16_t* __restrict__ XN, const int* __restrict__ EX, const float* __restrict__ GW, const float* __restrict__ U, const float* __restrict__ V, float* __restrict__ X) {
    __shared__ float hs[1024]; __shared__ float w[128]; __shared__ int es[128];
    const long t = blockIdx.x; const int tid = threadIdx.x, wave = tid >> 6, lane = tid & 63;
    for (int i = tid; i < 1024; i += 256) hs[i] = bf2f(XN[t * 1024 + i]);
    if (tid < 128) es[tid] = EX[t * 128 + tid];
    __syncthreads();
    for (int j = wave; j < 128; j += 4) {
        const float* up = U + (long)es[j] * 1024;
        float a = 0.f;
        for (int i = lane; i < 1024; i += 64) a += hs[i] * up[i];
        for (int o = 32; o > 0; o >>= 1) a += __shfl_xor(a, o);
        if (lane == 0) w[j] = GW[t * 128 + j] * (0.5f * a * (1.f + erff(a * 0.70710678118654752f)));
    }
    __syncthreads();
    float o[4] = {0.f, 0.f, 0.f, 0.f};
    for (int j = 0; j < 128; ++j) {
        const float* vp = V + (long)es[j] * 1024; const float wj = w[j];
#pragma unroll
        for (int i = 0; i < 4; ++i) o[i] += wj * vp[tid + 256 * i];
    }
#pragma unroll
    for (int i = 0; i < 4; ++i) X[t * 1024 + tid + 256 * i] += o[i];
}

}

namespace pg8 {
#define PG8_LAS __attribute__((address_space(3)))
typedef unsigned short bf16_t;
typedef short bf16x8 __attribute__((ext_vector_type(8)));
typedef float f32x4 __attribute__((ext_vector_type(4)));
typedef unsigned u32x4 __attribute__((ext_vector_type(4)));
typedef unsigned u32x2 __attribute__((ext_vector_type(2)));
constexpr int BM = 256, BK = 64, HALF = 128, HTB = HALF * BK * 2, STAGE_BYTES = 8 * HTB, NXCD = 8, WGM = 8;
__host__ __device__ __forceinline__ int lds_byte(int r, int c) { const int st = (r >> 4) * 2 + (c >> 5), rr = r & 15, cc = c & 31, ob = rr * 64 + cc * 2; return st * 1024 + (ob ^ (((ob >> 9) & 1) << 5)); }
__host__ __device__ __forceinline__ void stage_rc(int b, int& R, int& C) { const int st = b / 1024, sb = b % 1024, swz = sb ^ (((sb >> 9) & 1) << 5); R = (st >> 1) * 16 + swz / 64; C = (st & 1) * 32 + (swz % 64) / 2; }
__host__ __device__ __forceinline__ int perm32(int rho) { const int n = rho >> 4, i = rho & 15; return 8 * (i >> 2) + 4 * n + (i & 3); }
struct Unit { int pm, pn; };
struct Gemm { const bf16_t* A; const bf16_t* Bt; int M, N, K, lda, ldb; };
struct StaticOrder {
    int nM, nN, nwg, G, c;
    __host__ __device__ void init(int M, int N, int G_, int c_) { nM = M / BM; nN = N / BM; nwg = nM * nN; G = G_; c = c_; }
    __host__ __device__ bool next(int i, Unit& u) const {
        const long L = (long)i * G + c; if (L >= nwg) return false;
        int wgid = (int)L; { const int q = nwg / NXCD, r = nwg % NXCD, xcd = wgid % NXCD, off = wgid / NXCD; wgid = (xcd < r ? xcd * (q + 1) : r * (q + 1) + (xcd - r) * q) + off; }
        const int nig = WGM * nN, gid = wgid / nig, fm = gid * WGM, gsz = (nM - fm) < WGM ? (nM - fm) : WGM;
        u.pm = fm + ((wgid % nig) % gsz); u.pn = (wgid % nig) / gsz; return true;
    }
    __device__ __forceinline__ void a_ready(const Unit&) const {}
    __device__ __forceinline__ void done(const Unit&) const {}
};
__device__ __forceinline__ unsigned cvt_pk_bf16(float lo, float hi) { unsigned r; asm volatile("v_cvt_pk_bf16_f32 %0, %1, %2" : "=v"(r) : "v"(lo), "v"(hi)); return r; }

struct EpiF32 {
    static constexpr bool PERM = false, AFTER_DRAIN = false;
    float* C; int ldc; int nvalid; int accum;
    __device__ __forceinline__ void operator()(const f32x4 (&acc)[2][2][4][2], const Unit& u, int wr, int wc, int fr, int fq) const {
#pragma unroll
        for (int ai = 0; ai < 2; ++ai)
#pragma unroll
            for (int m = 0; m < 4; ++m) { const size_t row = (size_t)u.pm * BM + ai * HALF + wr * 64 + m * 16 + fr;
#pragma unroll
                for (int bj = 0; bj < 2; ++bj)
#pragma unroll
                    for (int n = 0; n < 2; ++n) { const int col = u.pn * BM + bj * HALF + wc * 32 + n * 16 + 4 * fq;
                        if (col < nvalid) { float* p = C + row * ldc + col; f32x4 v = acc[ai][bj][m][n]; if (accum) v += *(const f32x4*)p; *(f32x4*)p = v; } } }
    }
};
struct EpiBf16 {
    static constexpr bool PERM = true, AFTER_DRAIN = false;
    bf16_t* O; int ldc; int nvalid;
    __device__ __forceinline__ void operator()(const f32x4 (&acc)[2][2][4][2], const Unit& u, int wr, int wc, int fr, int fq) const {
#pragma unroll
        for (int ai = 0; ai < 2; ++ai)
#pragma unroll
            for (int m = 0; m < 4; ++m) { const size_t row = (size_t)u.pm * BM + ai * HALF + wr * 64 + m * 16 + fr;
#pragma unroll
                for (int bj = 0; bj < 2; ++bj) { const int col = u.pn * BM + bj * HALF + wc * 32 + 8 * fq;
                    if (col < nvalid) { const f32x4 v0 = acc[ai][bj][m][0], v1 = acc[ai][bj][m][1]; u32x4 w; w.x = cvt_pk_bf16(v0[0], v0[1]); w.y = cvt_pk_bf16(v0[2], v0[3]); w.z = cvt_pk_bf16(v1[0], v1[1]); w.w = cvt_pk_bf16(v1[2], v1[3]);
                        *(u32x4*)(O + row * ldc + col) = w; } } }
    }
};
template <class Epi, class Sched, bool ALIGN_EPI = false, bool SP2 = false>
__device__ __forceinline__ void gemm_phase(PG8_LAS unsigned char* lds, const Gemm g, const Sched& S, const Epi& E) {
    const int tid = threadIdx.x, wid = __builtin_amdgcn_readfirstlane(tid >> 6), lane = tid & 63, wr = wid >> 2, wc = wid & 3, fr = lane & 15, fq = lane >> 4;
    const int K = g.K, nt = K / BK;
    unsigned voffA[2], voffB[2];
#pragma unroll
    for (int i = 0; i < 2; ++i) { int R, C; stage_rc(tid * 16 + i * 8192, R, C); const int Rb = Epi::PERM ? ((R & ~31) + perm32(R & 31)) : R;
        voffA[i] = (unsigned)(R * g.lda + C) * 2u; voffB[i] = (unsigned)(Rb * g.ldb + C) * 2u; }
    const size_t kstep = (size_t)(BK * 2);
    const size_t hstepA = (size_t)HALF * g.lda * 2, hstepB = (size_t)HALF * g.ldb * 2;
    const size_t tstepA = 2 * hstepA, tstepB = 2 * hstepB;
    const unsigned ldsw = (unsigned)wid * 1024u;
    const int aoff = lds_byte(wr * 64 + fr, fq * 8), boff = lds_byte(wc * 32 + fr, fq * 8);
#define PG8_SA(b, h) (((b) * 2 + (h)) * HTB)
#define PG8_SB(b, h) ((4 + (b) * 2 + (h)) * HTB)
#define PG8_STAGE(bufoff, gbase, voff) do { _Pragma("unroll") for (int _i = 0; _i < 2; ++_i) \
        __builtin_amdgcn_global_load_lds((const unsigned*)((const char*)(gbase) + (voff)[_i]), (PG8_LAS unsigned*)(lds + (bufoff) + ldsw + _i * 8192), 16, 0, 0); } while (0)
#define PG8_LDA(dst, b, h) do { _Pragma("unroll") for (int m = 0; m < 4; ++m) _Pragma("unroll") for (int k = 0; k < 2; ++k) dst[m][k] = *(const PG8_LAS bf16x8*)(lds + PG8_SA(b, h) + aoff + m * 2048 + k * 1024); } while (0)
#define PG8_LDB(dst, b, h) do { _Pragma("unroll") for (int n = 0; n < 2; ++n) _Pragma("unroll") for (int k = 0; k < 2; ++k) dst[n][k] = *(const PG8_LAS bf16x8*)(lds + PG8_SB(b, h) + boff + n * 2048 + k * 1024); } while (0)
#define PG8_MMA(ai, bj, At, Bt) do { __builtin_amdgcn_s_setprio(1); _Pragma("unroll") for (int m = 0; m < 4; ++m) _Pragma("unroll") for (int n = 0; n < 2; ++n) _Pragma("unroll") for (int k = 0; k < 2; ++k) \
        acc[ai][bj][m][n] = __builtin_amdgcn_mfma_f32_16x16x32_bf16(Bt[n][k], At[m][k], acc[ai][bj][m][n], 0, 0, 0); __builtin_amdgcn_s_setprio(0); } while (0)
#define PG8_WAIT_V(n) asm volatile("s_waitcnt vmcnt(" #n ")" ::: "memory")
#define PG8_WAIT_L(n) asm volatile("s_waitcnt lgkmcnt(" #n ")" ::: "memory")
#define PG8_BAR __builtin_amdgcn_s_barrier()
#define PG8_SCHED __builtin_amdgcn_sched_barrier(0)
    Unit cur, nxt; int ui = 0;
    if (!S.next(0, cur)) return;
    f32x4 acc[2][2][4][2];
#pragma unroll
    for (int a = 0; a < 2; ++a)
#pragma unroll
        for (int b = 0; b < 2; ++b)
#pragma unroll
            for (int m = 0; m < 4; ++m)
#pragma unroll
                for (int n = 0; n < 2; ++n) acc[a][b][m][n] = (f32x4){0.f, 0.f, 0.f, 0.f};
    bf16x8 At[4][2], B0[2][2], B1[2][2];
    const char* cA = (const char*)g.A + (size_t)cur.pm * tstepA; const char* cB = (const char*)g.Bt + (size_t)cur.pn * tstepB;
    S.a_ready(cur);
    if constexpr (SP2) {
        PG8_STAGE(PG8_SB(0, 0), cB, voffB); PG8_STAGE(PG8_SB(0, 1), cB + hstepB, voffB); PG8_STAGE(PG8_SA(0, 0), cA, voffA); PG8_STAGE(PG8_SA(0, 1), cA + hstepA, voffA);
        if (wr == 1) PG8_BAR;
        PG8_WAIT_V(2); PG8_BAR;
        PG8_STAGE(PG8_SB(1, 0), cB + kstep, voffB); PG8_STAGE(PG8_SA(1, 0), cA + kstep, voffA); PG8_STAGE(PG8_SB(1, 1), cB + hstepB + kstep, voffB);
        PG8_WAIT_V(6); PG8_BAR;
    } else {
        PG8_STAGE(PG8_SB(0, 0), cB, voffB); PG8_STAGE(PG8_SA(0, 0), cA, voffA); PG8_STAGE(PG8_SB(0, 1), cB + hstepB, voffB); PG8_STAGE(PG8_SA(0, 1), cA + hstepA, voffA);
        if (wr == 1) PG8_BAR;
        PG8_WAIT_V(4); PG8_BAR;
        PG8_STAGE(PG8_SB(1, 0), cB + kstep, voffB); PG8_STAGE(PG8_SA(1, 0), cA + kstep, voffA); PG8_STAGE(PG8_SB(1, 1), cB + hstepB + kstep, voffB);
        PG8_WAIT_V(6); PG8_BAR;
    }
    for (;;) {
        const bool has_next = S.next(ui + 1, nxt);
        const char* nA = has_next ? (const char*)g.A + (size_t)nxt.pm * tstepA : cA; const char* nB = has_next ? (const char*)g.Bt + (size_t)nxt.pn * tstepB : cB;
        for (int t = 0; t < nt; t += 2) {
            const bool last = (t == nt - 2);
            const char* a1 = cA + (size_t)(t + 1) * kstep;
            const char* a2 = last ? nA : cA + (size_t)(t + 2) * kstep; const char* b2 = last ? nB : cB + (size_t)(t + 2) * kstep;
            const char* a3 = a2 + kstep; const char* b3 = b2 + kstep;
            if (last && has_next) S.a_ready(nxt);
            if constexpr (SP2) {
            PG8_LDB(B0, 0, 0); PG8_LDB(B1, 0, 1); PG8_SCHED; PG8_LDA(At, 0, 0); PG8_STAGE(PG8_SA(1, 1), a1 + hstepA, voffA);
            PG8_WAIT_V(8); PG8_WAIT_L(0); PG8_BAR; PG8_MMA(0, 0, At, B0); PG8_MMA(0, 1, At, B1); PG8_BAR; PG8_SCHED;
            PG8_LDA(At, 0, 1); PG8_STAGE(PG8_SB(0, 0), b2, voffB); PG8_STAGE(PG8_SB(0, 1), b2 + hstepB, voffB); PG8_STAGE(PG8_SA(0, 0), a2, voffA);
            PG8_WAIT_V(8); PG8_WAIT_L(0); PG8_BAR; PG8_MMA(1, 0, At, B0); PG8_MMA(1, 1, At, B1); PG8_BAR; PG8_SCHED;
            PG8_LDB(B0, 1, 0); PG8_LDB(B1, 1, 1); PG8_SCHED; PG8_LDA(At, 1, 0); PG8_STAGE(PG8_SA(0, 1), a2 + hstepA, voffA);
            PG8_WAIT_V(8); PG8_WAIT_L(0); PG8_BAR; PG8_MMA(0, 0, At, B0); PG8_MMA(0, 1, At, B1); PG8_BAR; PG8_SCHED;
            PG8_LDA(At, 1, 1); PG8_STAGE(PG8_SB(1, 0), b3, voffB); PG8_STAGE(PG8_SB(1, 1), b3 + hstepB, voffB); PG8_STAGE(PG8_SA(1, 0), a3, voffA);
            PG8_WAIT_V(8); PG8_WAIT_L(0); PG8_BAR; PG8_MMA(1, 0, At, B0); PG8_MMA(1, 1, At, B1); PG8_BAR; PG8_SCHED;
            } else {
            PG8_LDB(B0, 0, 0); PG8_SCHED; PG8_LDA(At, 0, 0); PG8_STAGE(PG8_SA(1, 1), a1 + hstepA, voffA);
            PG8_WAIT_L(8); PG8_BAR; PG8_WAIT_L(0); PG8_MMA(0, 0, At, B0); PG8_BAR; PG8_SCHED;
            PG8_LDB(B1, 0, 1); PG8_STAGE(PG8_SB(0, 0), b2, voffB);
            PG8_BAR; PG8_WAIT_L(0); PG8_MMA(0, 1, At, B1); PG8_BAR;
            PG8_LDA(At, 0, 1); PG8_STAGE(PG8_SA(0, 0), a2, voffA);
            PG8_BAR; PG8_WAIT_L(0); PG8_MMA(1, 0, At, B0); PG8_BAR; PG8_SCHED;
            PG8_STAGE(PG8_SB(0, 1), b2 + hstepB, voffB);
            PG8_WAIT_V(6); PG8_BAR; PG8_MMA(1, 1, At, B1); PG8_BAR;
            PG8_LDB(B0, 1, 0); PG8_SCHED; PG8_LDA(At, 1, 0); PG8_STAGE(PG8_SA(0, 1), a2 + hstepA, voffA);
            PG8_WAIT_L(8); PG8_BAR; PG8_WAIT_L(0); PG8_MMA(0, 0, At, B0); PG8_BAR; PG8_SCHED;
            PG8_LDB(B1, 1, 1); PG8_STAGE(PG8_SB(1, 0), b3, voffB);
            PG8_BAR; PG8_WAIT_L(0); PG8_MMA(0, 1, At, B1); PG8_BAR;
            PG8_LDA(At, 1, 1); PG8_STAGE(PG8_SA(1, 0), a3, voffA);
            PG8_BAR; PG8_WAIT_L(0); PG8_MMA(1, 0, At, B0); PG8_BAR; PG8_SCHED;
            PG8_STAGE(PG8_SB(1, 1), b3 + hstepB, voffB);
            PG8_WAIT_V(6); PG8_BAR; PG8_MMA(1, 1, At, B1); PG8_BAR;
            }
        }
        if constexpr (ALIGN_EPI) { if (wr == 0) PG8_BAR; }
        if constexpr (!Epi::AFTER_DRAIN) { E(acc, cur, wr, wc, fr, fq); S.done(cur); }
        if (!has_next) break;
#pragma unroll
        for (int a = 0; a < 2; ++a)
#pragma unroll
            for (int b = 0; b < 2; ++b)
#pragma unroll
                for (int m = 0; m < 4; ++m)
#pragma unroll
                    for (int n = 0; n < 2; ++n) acc[a][b][m][n] = (f32x4){0.f, 0.f, 0.f, 0.f};
        cur = nxt; cA = nA; cB = nB; ++ui;
        if constexpr (ALIGN_EPI) { if (wr == 1) PG8_BAR; }
    }
    PG8_WAIT_V(0);
    if constexpr (!ALIGN_EPI) { if (wr == 0) PG8_BAR; }
    PG8_BAR;
    if constexpr (Epi::AFTER_DRAIN) { E.fused(acc, cur, wr, wc, fr, fq, lds, wid, lane); S.done(cur); }
#undef PG8_SA
#undef PG8_SB
#undef PG8_STAGE
#undef PG8_LDA
#undef PG8_LDB
#undef PG8_MMA
#undef PG8_WAIT_V
#undef PG8_WAIT_L
#undef PG8_BAR
#undef PG8_SCHED
}
}

namespace mk {
#define GAS __attribute__((address_space(1)))
#define LAS __attribute__((address_space(3)))
typedef unsigned short bf16;
typedef unsigned v4u __attribute__((ext_vector_type(4)));
typedef float f32x4 __attribute__((ext_vector_type(4)));
typedef GAS unsigned gu32;
#define LDS_WAIT() asm volatile("s_waitcnt lgkmcnt(0)" ::: "memory")
#define VM_WAIT() asm volatile("s_waitcnt vmcnt(0)" ::: "memory")
__device__ __forceinline__ unsigned f2bf_(float f) { unsigned u = __builtin_bit_cast(unsigned, f); return (u + 0x7fffu + ((u >> 16) & 1u)) >> 16; }
__device__ __forceinline__ unsigned pk2(float lo, float hi) { return f2bf_(lo) | (f2bf_(hi) << 16); }

constexpr int NWAVES = 8;
constexpr int D = 1024, NB = 4, S = 8192, T = NB * S, L = 4, MEM = 256, INW = 2144, INP = 2304;
constexpr size_t MiB = 1u << 20;
constexpr size_t WS_CTL = 0, CTL_ZERO_BYTES = 1 * MiB;
constexpr size_t WS_WIN = 1 * MiB, WS_WOUT = 19 * MiB, WS_WCQ = 27 * MiB, WS_WCO = 35 * MiB, WS_WPQ = 43 * MiB, WS_WCKV = 51 * MiB;
constexpr size_t WS_XNB = 68 * MiB, WS_YB = 132 * MiB, WS_MNB = 196 * MiB;
constexpr size_t WS_PROJ = 208 * MiB, WS_QKV = 476 * MiB, WS_LAU = 604 * MiB, WS_OMD = 732 * MiB, WS_KVC = 796 * MiB, WS_EXG = 804 * MiB, WS_END = 836 * MiB;
constexpr int CW_BAR = 4096;
constexpr int RING_OFF = 0, RING_BYTES = 131072, LDSCTL_OFF = RING_BYTES, MISC_OFF = LDSCTL_OFF + 320, LDS_BYTES = 147456;

#define XB_TMO      128
#define XB_XCNT(j)  (256  + 64 * (j))
#define XB_XSUB(j)  (1280 + 64 * (j))
#define XB_XGEN(j)  (2304 + 64 * (j))
#define XB_TOP      3328
#define XB_TOPGEN   3392
#define XCD_BAR_WORDS 3456
#define XB_SPIN_CAP (1u << 18)

__device__ __forceinline__ unsigned xb_ld(unsigned* p)              { return __hip_atomic_load(p, __ATOMIC_RELAXED, __HIP_MEMORY_SCOPE_AGENT); }
__device__ __forceinline__ unsigned xb_add(unsigned* p, unsigned v) { return __hip_atomic_fetch_add(p, v, __ATOMIC_RELAXED, __HIP_MEMORY_SCOPE_AGENT); }
__device__ __forceinline__ unsigned xb_xcc_id() { return (unsigned)__builtin_amdgcn_s_getreg((3 << 11) | 20) & 0xFu; }
#define XB_SPIN(cond, bar) do { unsigned _sp = 0; while (cond) { __builtin_amdgcn_s_sleep(1); \
    if ((++_sp & 255u) == 0u) { if (xb_ld(&(bar)[XB_TMO])) break; if (_sp > XB_SPIN_CAP) { atomicAdd(&(bar)[XB_TMO], 1u); break; } } } } while (0)

struct XcdBarrier {
    unsigned* bar; unsigned x;
    volatile LAS unsigned* st;
};

__device__ __forceinline__ XcdBarrier xcd_barrier_post(unsigned* bar, volatile LAS unsigned* st) {
    XcdBarrier b; b.bar = bar; b.x = xb_xcc_id(); b.st = st;
    if (threadIdx.x == 0) (void)xb_add(&bar[XB_XCNT(b.x)], 1u);
    return b;
}
__device__ __forceinline__ void xcd_barrier_complete(unsigned* bar, unsigned x, unsigned& nloc, unsigned& nx) {
    const unsigned G = gridDim.x * gridDim.y * gridDim.z;
    unsigned sum, cnt, mine, sp = 0u;
    for (;;) {
        sum = 0u; cnt = 0u; mine = 0u;
#pragma unroll
        for (unsigned j = 0; j < 16; ++j) { const unsigned c = xb_ld(&bar[XB_XCNT(j)]); sum += c; cnt += (c > 0u) ? 1u : 0u; mine = (j == x) ? c : mine; }
        if (sum == G) break;
        __builtin_amdgcn_s_sleep(1);
        if ((++sp & 255u) == 0u) { if (xb_ld(&bar[XB_TMO])) break; if (sp > XB_SPIN_CAP) { atomicAdd(&bar[XB_TMO], 1u); break; } }
    }
    nloc = mine > 0u ? mine : 1u; nx = cnt > 0u ? cnt : 1u;
}

__device__ __forceinline__ void xcd_barrier(const XcdBarrier& b) {
    asm volatile("s_waitcnt vmcnt(0)" ::: "memory");
    __syncthreads();
    if (threadIdx.x == 0) {
        unsigned* bar = b.bar;
        __builtin_amdgcn_s_waitcnt(0);
        unsigned nloc = b.st[0], nx = b.st[1];
        if (nloc == 0u) { xcd_barrier_complete(bar, b.x, nloc, nx); b.st[0] = nloc; b.st[1] = nx; }
        const unsigned old = xb_add(&bar[XB_XSUB(b.x)], 1u);
        const unsigned gen = old / nloc;
        if (old + 1u == (gen + 1u) * nloc) {
            __builtin_amdgcn_fence(__ATOMIC_RELEASE, "agent");
            asm volatile("s_waitcnt vmcnt(0)" ::: "memory");
            const unsigned og = xb_add(&bar[XB_TOP], 1u);
            const unsigned tg = og / nx;
            if (og + 1u == (tg + 1u) * nx) xb_add(&bar[XB_TOPGEN], 1u);
            else XB_SPIN(xb_ld(&bar[XB_TOPGEN]) == tg, bar);
            __builtin_amdgcn_fence(__ATOMIC_ACQUIRE, "agent");
            xb_add(&bar[XB_XGEN(b.x)], 1u);
            asm volatile("s_waitcnt vmcnt(0)" ::: "memory");
        } else {
            XB_SPIN(xb_ld(&bar[XB_XGEN(b.x)]) == gen, bar);
            __builtin_amdgcn_fence(__ATOMIC_ACQUIRE, "agent");
            asm volatile("s_waitcnt vmcnt(0)" ::: "memory");
        }
    }
    __syncthreads();
}

struct Args { const float* in[33]; float* out; unsigned char* ws; int ph_lo, ph_hi; };
template <class P> __device__ __forceinline__ P* opq(P* p) { asm volatile("" : "+s"(p)); return p; }
struct Frame { LAS unsigned char* lds; volatile LAS unsigned* MISC; gu32* ctl; int tid, lane, wave, G; };

__device__ __forceinline__ void transpose_item(const float* W, int ldw, int nsrc0, bf16* WT, int ldt, int rdst0, LAS float* scr, int kb, int nb, int lane, float scale) {
    const int k0 = 64 * kb, n0 = 32 * nb;
#pragma unroll 8
    for (int i = 0; i < 32; ++i) { const int kk = 2 * i + (lane >> 5); scr[kk * 33 + (lane & 31)] = W[(size_t)(k0 + kk) * ldw + nsrc0 + n0 + (lane & 31)] * scale; }
    LDS_WAIT(); asm volatile("" ::: "memory");
    const int c = lane & 7;
#pragma unroll
    for (int j = 0; j < 4; ++j) { const int n = (lane >> 3) + 8 * j; const LAS float* s = scr + (8 * c) * 33 + n;
        v4u o; o.x = pk2(s[0 * 33], s[1 * 33]); o.y = pk2(s[2 * 33], s[3 * 33]); o.z = pk2(s[4 * 33], s[5 * 33]); o.w = pk2(s[6 * 33], s[7 * 33]);
        *(GAS v4u*)(WT + (size_t)(rdst0 + n0 + n) * ldt + k0 + 8 * c) = o; }
    LDS_WAIT(); asm volatile("" ::: "memory");
}

__device__ __forceinline__ void p0_prologue(Frame& F, const Args& a) {
    LAS float* scr = (LAS float*)(F.lds + RING_OFF + F.wave * 16384);
    const int gw = blockIdx.x * NWAVES + F.wave, NGW = F.G * NWAVES;
    unsigned char* ws = a.ws;
    { const GAS f32x4* src = (const GAS f32x4*)a.in[0]; GAS f32x4* dst = (GAS f32x4*)a.out; const size_t n4 = (size_t)T * D / 4;
      for (size_t i = (size_t)blockIdx.x * (NWAVES * 64) + F.tid; i < n4; i += (size_t)F.G * NWAVES * 64) dst[i] = src[i]; }
    constexpr int I_IN = 16 * (INW / 32), I_SQ = 16 * 32, I_CKV = 16 * 64, I_L = I_IN + 4 * I_SQ + I_CKV;
    for (int it = gw; it < L * I_L; it += NGW) {
        const int l = it / I_L; int r = it % I_L;
        if (r < I_IN) { transpose_item(a.in[5] + (size_t)l * D * INW, INW, 0, (bf16*)(ws + WS_WIN) + (size_t)l * INP * D, D, 0, scr, r / (INW / 32), r % (INW / 32), F.lane, 1.f); continue; } r -= I_IN;
        if (r < I_SQ) { transpose_item(a.in[21] + (size_t)l * D * D, D, 0, (bf16*)(ws + WS_WOUT) + (size_t)l * D * D, D, 0, scr, r / 32, r % 32, F.lane, 1.f); continue; } r -= I_SQ;
        if (r < I_SQ) { transpose_item(a.in[24] + (size_t)l * D * D, D, 0, (bf16*)(ws + WS_WCQ) + (size_t)l * D * D, D, 0, scr, r / 32, r % 32, F.lane, 1.f); continue; } r -= I_SQ;
        if (r < I_SQ) { transpose_item(a.in[26] + (size_t)l * D * D, D, 0, (bf16*)(ws + WS_WCO) + (size_t)l * D * D, D, 0, scr, r / 32, r % 32, F.lane, 1.f); continue; } r -= I_SQ;
        if (r < I_SQ) { transpose_item(a.in[28] + (size_t)l * D * D, D, 0, (bf16*)(ws + WS_WPQ) + (size_t)l * D * D, D, 0, scr, r / 32, r % 32, F.lane, 1.f); continue; } r -= I_SQ;
        transpose_item(a.in[25] + (size_t)l * D * 2 * D, 2 * D, 0, (bf16*)(ws + WS_WCKV) + (size_t)l * 2 * D * D, D, 0, scr, r / 64, r % 64, F.lane, 1.f);
    }
    { constexpr int PADV = (INP - INW) * D / 8;
      for (int i = blockIdx.x * (NWAVES * 64) + F.tid; i < L * PADV; i += F.G * NWAVES * 64) { const int l = i / PADV, r = i % PADV;
          *((GAS v4u*)((bf16*)(ws + WS_WIN) + (size_t)l * INP * D + (size_t)INW * D) + r) = (v4u){0u, 0u, 0u, 0u}; } }
}

constexpr int NPL = 6;
__global__ void __launch_bounds__(NWAVES * 64, 2) fwd(Args args) {
    extern __shared__ __attribute__((aligned(16))) unsigned char lds[];
    Frame F;
    F.lds = (LAS unsigned char*)lds; F.MISC = (volatile LAS unsigned*)(F.lds + MISC_OFF);
    F.tid = threadIdx.x; F.lane = F.tid & 63; F.wave = __builtin_amdgcn_readfirstlane(F.tid >> 6); F.G = gridDim.x;
    unsigned char* ws = args.ws;
    F.ctl = (gu32*)(ws + WS_CTL);
    for (int u = F.tid; u < (LDS_BYTES - LDSCTL_OFF) / 4; u += NWAVES * 64) ((LAS unsigned*)(F.lds + LDSCTL_OFF))[u] = 0u;
    __syncthreads();
    XcdBarrier bar = xcd_barrier_post((unsigned*)(F.ctl + CW_BAR), F.MISC + 8);
    const int lo = args.ph_lo, hi = args.ph_hi;
#define IN(k) (lo <= (k) && (k) < hi)
#define SEAM(k) do { if (IN(k) && IN((k) + 1)) xcd_barrier(bar); } while (0)
    if (IN(0)) { p0_prologue(F, args); }
    SEAM(0);
    for (int l = 0; l < L; ++l) {
        const int pb = 1 + NPL * l;
        const bf16* XNB = (const bf16*)(ws + WS_XNB); const bf16* YB = (const bf16*)(ws + WS_YB);
        if (IN(pb + 0)) {
            pg8::Gemm g{opq(XNB), opq((const bf16*)(ws + WS_WIN) + (size_t)l * INP * D), T, INP, D, D, D}; pg8::StaticOrder So; So.init(T, INP, F.G, (int)blockIdx.x);
            pg8::EpiF32 E{opq((float*)(ws + WS_PROJ)), INW, INW, 0};
            pg8::gemm_phase<pg8::EpiF32, pg8::StaticOrder, true, true>(F.lds + RING_OFF, g, So, E);
        }
        SEAM(pb + 0);
        if (IN(pb + 1)) {
            pg8::Gemm g{opq(YB), opq((const bf16*)(ws + WS_WOUT) + (size_t)l * D * D), T, D, D, D, D}; pg8::StaticOrder So; So.init(T, D, F.G, (int)blockIdx.x);
            pg8::EpiF32 E{opq(args.out), D, D, 1};
            pg8::gemm_phase<pg8::EpiF32, pg8::StaticOrder, true, true>(F.lds + RING_OFF, g, So, E);
        }
        SEAM(pb + 1);
        if (IN(pb + 2)) {
            pg8::Gemm g{opq((const bf16*)(ws + WS_MNB)), opq((const bf16*)(ws + WS_WCKV) + (size_t)l * 2 * D * D), NB * MEM, 2 * D, D, D, D}; pg8::StaticOrder So; So.init(NB * MEM, 2 * D, F.G, (int)blockIdx.x);
            pg8::EpiF32 E{opq((float*)(ws + WS_KVC)), 2 * D, 2 * D, 0};
            pg8::gemm_phase<pg8::EpiF32, pg8::StaticOrder, true, true>(F.lds + RING_OFF, g, So, E);
        }
        SEAM(pb + 2);
        if (IN(pb + 3)) {
            pg8::Gemm g{opq(XNB), opq((const bf16*)(ws + WS_WCQ) + (size_t)l * D * D), T, D, D, D, D}; pg8::StaticOrder So; So.init(T, D, F.G, (int)blockIdx.x);
            pg8::EpiF32 E{opq((float*)(ws + WS_PROJ)), D, D, 0};
            pg8::gemm_phase<pg8::EpiF32, pg8::StaticOrder, true, true>(F.lds + RING_OFF, g, So, E);
        }
        SEAM(pb + 3);
        if (IN(pb + 4)) {
            pg8::Gemm g{opq(YB), opq((const bf16*)(ws + WS_WCO) + (size_t)l * D * D), T, D, D, D, D}; pg8::StaticOrder So; So.init(T, D, F.G, (int)blockIdx.x);
            pg8::EpiF32 E{opq(args.out), D, D, 1};
            pg8::gemm_phase<pg8::EpiF32, pg8::StaticOrder, true, true>(F.lds + RING_OFF, g, So, E);
        }
        SEAM(pb + 4);
        if (IN(pb + 5)) {
            pg8::Gemm g{opq(XNB), opq((const bf16*)(ws + WS_WPQ) + (size_t)l * D * D), T, D, D, D, D}; pg8::StaticOrder So; So.init(T, D, F.G, (int)blockIdx.x);
            pg8::EpiF32 E{opq((float*)(ws + WS_PROJ)), D, D, 0};
            pg8::gemm_phase<pg8::EpiF32, pg8::StaticOrder, true, true>(F.lds + RING_OFF, g, So, E);
        }
        SEAM(pb + 5);
    }
#undef IN
#undef SEAM
}
}
namespace {
void gemm(hipStream_t st, const float* A, long lda, const float* Bm, long sbk, long sbn, float* C, long ldc, int M, int N, int K, float alpha, int acc,
          int batch = 1, int nh = 1, long aB = 0, long aH = 0, long bB = 0, long bH = 0, long cB = 0, long cH = 0) {
    GemmP p{}; p.A = A; p.Bm = Bm; p.C = C; p.lda = lda; p.sbk = sbk; p.sbn = sbn; p.ldc = ldc; p.M = M; p.N = N; p.K = K; p.nh = nh;
    p.aB = aB; p.aH = aH; p.bB = bB; p.bH = bH; p.cB = cB; p.cH = cH; p.alpha = alpha; p.acc = acc;
    hipLaunchKernelGGL(k_gemm, dim3((N + 127) / 128, M / 128, batch), dim3(256), 0, st, p);
}
}

extern "C" void kernel_launch(void* const* d_in, const int* in_sizes, int n_in, void* d_out, int out_size, void* d_ws, size_t ws_size, hipStream_t stream) {
    (void)in_sizes; (void)out_size;
    static int grid = 0;
    if (grid == 0) {
        int dev = 0, cus = 0, per_cu = 0;
        if (n_in != 33 || ws_size < mk::WS_END) { fprintf(stderr, "kernel_launch: unexpected n_in %d / ws_size %zu\n", n_in, ws_size); grid = -1; return; }
        if (hipGetDevice(&dev) != hipSuccess || hipDeviceGetAttribute(&cus, hipDeviceAttributeMultiprocessorCount, dev) != hipSuccess) { grid = -1; return; }
        if (hipFuncSetAttribute((const void*)mk::fwd, hipFuncAttributeMaxDynamicSharedMemorySize, mk::LDS_BYTES) != hipSuccess) { fprintf(stderr, "kernel_launch: hipFuncSetAttribute failed\n"); grid = -1; return; }
        if (hipOccupancyMaxActiveBlocksPerMultiprocessor(&per_cu, (const void*)mk::fwd, mk::NWAVES * 64, mk::LDS_BYTES) != hipSuccess || per_cu < 1) fprintf(stderr, "kernel_launch: occupancy query says %d\n", per_cu);
        (void)hipGetLastError();
        grid = cus;
    }
    if (grid < 0) return;
    const float* mem = (const float*)d_in[1]; const int* pos = (const int*)d_in[2]; const float* relb = (const float*)d_in[3];
    const float* norm_mix = (const float*)d_in[4]; const float* q_norm = (const float*)d_in[6]; const float* w_uq = (const float*)d_in[7];
    const float* kv_norm = (const float*)d_in[8]; const float* w_ukv = (const float*)d_in[9]; const float* conv_w = (const float*)d_in[10]; const float* conv_b = (const float*)d_in[11];
    const float* w_a = (const float*)d_in[12]; const float* b_a = (const float*)d_in[13]; const float* w_x = (const float*)d_in[14]; const float* b_x = (const float*)d_in[15];
    const float* lru_lam = (const float*)d_in[16]; const float* diff_lam = (const float*)d_in[17]; const float* diff_norm = (const float*)d_in[18];
    const float* onm = (const float*)d_in[19]; const float* onl = (const float*)d_in[20];
    const float* norm_cross = (const float*)d_in[22]; const float* norm_mem = (const float*)d_in[23];
    const float* norm_ffn = (const float*)d_in[27]; const float* peer_keys = (const float*)d_in[29];
    const float* peer_u = (const float*)d_in[30]; const float* peer_v = (const float*)d_in[31]; const float* norm_final = (const float*)d_in[32];
    float* X = (float*)d_out;
    unsigned char* ws = (unsigned char*)d_ws;
    bf16_t* XNB = (bf16_t*)(ws + mk::WS_XNB); bf16_t* YB = (bf16_t*)(ws + mk::WS_YB); bf16_t* MNB = (bf16_t*)(ws + mk::WS_MNB);
    float* PROJ = (float*)(ws + mk::WS_PROJ);
    float* QM = (float*)(ws + mk::WS_QKV); float* KM = QM + (size_t)T * 384; float* VM = KM + (size_t)T * 384;
    float* LA = (float*)(ws + mk::WS_LAU); float* LU = LA + (size_t)T * 512;
    float* OM = (float*)(ws + mk::WS_OMD); float* OD = OM + (size_t)T * 256;
    float* KVC = (float*)(ws + mk::WS_KVC); int* EX = (int*)(ws + mk::WS_EXG); float* GW = (float*)(ws + mk::WS_EXG) + (size_t)T * 128;
    float* QC = PROJ; float* SC = QM; float* OCF = LA; float* QP = PROJ;

    hipMemsetAsync(ws + mk::WS_CTL, 0, mk::CTL_ZERO_BYTES, stream);
    mk::Args a{};
    for (int i = 0; i < 33; ++i) a.in[i] = (const float*)d_in[i];
    a.out = X; a.ws = ws;
    auto run = [&](int lo, int hi) { a.ph_lo = lo; a.ph_hi = hi; hipLaunchKernelGGL(mk::fwd, dim3(grid), dim3(mk::NWAVES * 64), mk::LDS_BYTES, stream, a); };
    run(0, 1);
    for (int l = 0; l < L; ++l) {
        const int pb = 1 + mk::NPL * l;
        hipLaunchKernelGGL(k_rmsnorm, dim3(T), dim3(256), 0, stream, X, norm_mix + l * D, (float*)nullptr, XNB, D);
        run(pb + 0, pb + 1);
        hipLaunchKernelGGL(k_mla_pre, dim3(T), dim3(128), 0, stream, PROJ, pos, q_norm + l * 192, w_uq + (size_t)l * 192 * 384, kv_norm + l * 128, w_ukv + (size_t)l * 128 * 512, QM, KM, VM);
        hipLaunchKernelGGL(k_lru_pre, dim3(T), dim3(512), 0, stream, PROJ, conv_w + l * 4 * 512, conv_b + l * 512, w_a + (size_t)l * 8 * 64 * 64, b_a + l * 512, w_x + (size_t)l * 8 * 64 * 64, b_x + l * 512, lru_lam + l * 512, LA, LU);
        hipLaunchKernelGGL(k_lru_scan, dim3(NB * 512 / 64), dim3(64), 0, stream, PROJ, LA, LU);
        hipLaunchKernelGGL(k_attn_mla, dim3(S / 256, 4, NB), dim3(256), 0, stream, QM, KM, VM, OM);
        const float lam_init = 0.8f - 0.6f * expf(-0.3f * (float)l);
        hipLaunchKernelGGL(k_attn_diff, dim3(S / 256, 4, NB), dim3(256), 0, stream, PROJ, pos, relb, diff_norm + l * 64, diff_lam + l * 128, lam_init, OD);
        hipLaunchKernelGGL(k_post, dim3(T), dim3(256), 0, stream, OM, LU, OD, onm + l * 256, onl + l * 512, YB);
        run(pb + 1, pb + 2);
        hipLaunchKernelGGL(k_rmsnorm, dim3(T), dim3(256), 0, stream, X, norm_cross + l * D, (float*)nullptr, XNB, D);
        hipLaunchKernelGGL(k_rmsnorm, dim3(NB * MEM), dim3(256), 0, stream, mem, norm_mem + l * D, (float*)nullptr, MNB, D);
        run(pb + 2, pb + 3);
        run(pb + 3, pb + 4);
        gemm(stream, QC, D, KVC, 1, 2 * D, SC, 256, S, 256, 256, 1.f / 16.f, 0, NB * 4, 4, (long)S * D, 256, (long)MEM * 2 * D, 256, (long)4 * S * 256, (long)S * 256);
        hipLaunchKernelGGL(k_softmax256, dim3(T * 4 / 4), dim3(256), 0, stream, SC, (long)T * 4);
        gemm(stream, SC, 256, KVC + D, 2 * D, 1, OCF, D, S, 256, 256, 1.f, 0, NB * 4, 4, (long)4 * S * 256, (long)S * 256, (long)MEM * 2 * D, 256, (long)S * D, 256);
        hipLaunchKernelGGL(k_f2bf, dim3((unsigned)(((size_t)T * D + 255) / 256)), dim3(256), 0, stream, OCF, YB, (long)T * D);
        run(pb + 4, pb + 5);
        hipLaunchKernelGGL(k_rmsnorm, dim3(T), dim3(256), 0, stream, X, norm_ffn + l * D, (float*)nullptr, XNB, D);
        run(pb + 5, pb + 6);
        hipLaunchKernelGGL(k_route, dim3(T), dim3(256), 0, stream, QP, peer_keys + (size_t)l * 2 * 128 * 64, EX, GW);
        hipLaunchKernelGGL(k_peer, dim3(T), dim3(256), 0, stream, XNB, EX, GW, peer_u + (size_t)l * NEXP * D, peer_v + (size_t)l * NEXP * D, X);
    }
    hipLaunchKernelGGL(k_rmsnorm, dim3(T), dim3(256), 0, stream, X, norm_final, X, (bf16_t*)nullptr, D);
}
```

```cpp
#include <hip/hip_runtime.h>
#include <cstdint>
#include <cstdio>
#include <cmath>

namespace {
constexpr int D = 1024, NB = 4, S = 8192, T = NB * S, L = 4, MEM = 256;
constexpr int INW = 2144;
constexpr int C_CQ = 0, C_CKV = 192, C_KR = 320, C_XL = 352, C_GL = 864, C_QD = 1376, C_KD = 1632, C_VD = 1888;
constexpr float EPS = 1e-6f;
constexpr int NEXP = 16384;

typedef unsigned short bf16_t;
__device__ __forceinline__ unsigned f2bf(float f) { unsigned u = __builtin_bit_cast(unsigned, f); return (u + 0x7fffu + ((u >> 16) & 1u)) >> 16; }
__device__ __forceinline__ float bf2f(unsigned short b) { return __builtin_bit_cast(float, (unsigned)b << 16); }
__global__ void k_cvt(const float* __restrict__ src, long sld, bf16_t* __restrict__ dst, long dld, int ncols, long rows, float scale) {
    const long i = (long)blockIdx.x * blockDim.x + threadIdx.x;
    if (i < rows * ncols) { const long r = i / ncols; const int c = (int)(i % ncols); dst[r * dld + c] = (bf16_t)f2bf(src[r * sld + c] * scale); }
}
__global__ void k_f2bf(const float* __restrict__ a, bf16_t* __restrict__ o, long n) {
    long i = (long)blockIdx.x * blockDim.x + threadIdx.x;
    if (i < n) o[i] = (bf16_t)f2bf(a[i]);
}
__global__ void k_copy4(const float4* __restrict__ a, float4* __restrict__ o, long n4) {
    long i = (long)blockIdx.x * blockDim.x + threadIdx.x;
    if (i < n4) o[i] = a[i];
}

__global__ __launch_bounds__(256) void k_rmsnorm(const float* in, const float* __restrict__ g, float* out, bf16_t* outb, int Dn) {
    __shared__ float red[4];
    const long row = blockIdx.x;
    const float* x = in + row * Dn;
    float s = 0.f;
    for (int i = threadIdx.x; i < Dn; i += 256) { float v = x[i]; s += v * v; }
    for (int o = 32; o > 0; o >>= 1) s += __shfl_xor(s, o);
    if ((threadIdx.x & 63) == 0) red[threadIdx.x >> 6] = s;
    __syncthreads();
    s = red[0] + red[1] + red[2] + red[3];
    const float rs = rsqrtf(s / (float)Dn + EPS);
    for (int i = threadIdx.x; i < Dn; i += 256) { const float v = x[i] * rs * g[i]; if (out) out[row * Dn + i] = v; if (outb) outb[row * Dn + i] = (bf16_t)f2bf(v); }
}

struct GemmP { const float* A; const float* Bm; float* C; long lda, sbk, sbn, ldc; int M, N, K, nh; long aB, aH, bB, bH, cB, cH; float alpha; int acc; };
__global__ __launch_bounds__(256) void k_gemm(GemmP p) {
    __shared__ float As[16][128 + 4];
    __shared__ float Bs[16][128 + 4];
    const int tid = threadIdx.x, tx = tid & 15, ty = tid >> 4;
    const int zb = blockIdx.z / p.nh, zh = blockIdx.z % p.nh;
    const float* A = p.A + zb * p.aB + zh * p.aH + (long)blockIdx.y * 128 * p.lda;
    const float* Bm = p.Bm + zb * p.bB + zh * p.bH;
    float* C = p.C + zb * p.cB + zh * p.cH + (long)blockIdx.y * 128 * p.ldc;
    const int n0 = blockIdx.x * 128;
    float acc[8][8];
#pragma unroll
    for (int i = 0; i < 8; ++i)
#pragma unroll
        for (int j = 0; j < 8; ++j) acc[i][j] = 0.f;
    for (int k0 = 0; k0 < p.K; k0 += 16) {
#pragma unroll
        for (int r = 0; r < 2; ++r) {
            const int idx = tid + r * 256;
            const int m = idx >> 2, kq = (idx & 3) * 4;
            const float4 v = *(const float4*)(A + (long)m * p.lda + k0 + kq);
            As[kq + 0][m] = v.x; As[kq + 1][m] = v.y; As[kq + 2][m] = v.z; As[kq + 3][m] = v.w;
        }
#pragma unroll
        for (int r = 0; r < 8; ++r) {
            const int idx = tid + r * 256;
            int kk, nn;
            if (p.sbn == 1) { kk = idx >> 7; nn = idx & 127; } else { kk = idx & 15; nn = idx >> 4; }
            const int n = n0 + nn;
            Bs[kk][nn] = (n < p.N) ? Bm[(long)(k0 + kk) * p.sbk + (long)n * p.sbn] : 0.f;
        }
        __syncthreads();
#pragma unroll
        for (int kk = 0; kk < 16; ++kk) {
            float a[8], b[8];
#pragma unroll
            for (int i = 0; i < 4; ++i) { a[i] = As[kk][ty * 4 + i]; a[4 + i] = As[kk][64 + ty * 4 + i]; b[i] = Bs[kk][tx * 4 + i]; b[4 + i] = Bs[kk][64 + tx * 4 + i]; }
#pragma unroll
            for (int i = 0; i < 8; ++i)
#pragma unroll
                for (int j = 0; j < 8; ++j) acc[i][j] += a[i] * b[j];
        }
        __syncthreads();
    }
#pragma unroll
    for (int i = 0; i < 8; ++i) {
        const int m = (i < 4) ? ty * 4 + i : 64 + ty * 4 + (i - 4);
#pragma unroll
        for (int j = 0; j < 8; ++j) {
            const int n = n0 + ((j < 4) ? tx * 4 + j : 64 + tx * 4 + (j - 4));
            if (n < p.N) { float* c = C + (long)m * p.ldc + n; const float v = p.alpha * acc[i][j]; *c = p.acc ? (*c + v) : v; }
        }
    }
}

__global__ __launch_bounds__(128) void k_mla_pre(const float* __restrict__ proj, const int* __restrict__ pos, const float* __restrict__ qn, const float* __restrict__ wuq,
                                                  const float* __restrict__ kvn, const float* __restrict__ wukv, float* __restrict__ QM, float* __restrict__ KM, float* __restrict__ VM) {
    __shared__ float cq[192], ckv[128], qs[384], kvs[512], kr[32], red[2];
    const long t = blockIdx.x; const int tid = threadIdx.x;
    const float* pr = proj + t * INW;
    float s = 0.f;
    for (int i = tid; i < 192; i += 128) { float v = pr[C_CQ + i]; s += v * v; }
    for (int o = 32; o > 0; o >>= 1) s += __shfl_xor(s, o);
    if ((tid & 63) == 0) red[tid >> 6] = s;
    __syncthreads();
    float rs = rsqrtf((red[0] + red[1]) / 192.f + EPS);
    for (int i = tid; i < 192; i += 128) cq[i] = pr[C_CQ + i] * rs * qn[i];
    __syncthreads();
    s = 0.f;
    { float v = pr[C_CKV + tid]; s = v * v; }
    for (int o = 32; o > 0; o >>= 1) s += __shfl_xor(s, o);
    if ((tid & 63) == 0) red[tid >> 6] = s;
    __syncthreads();
    rs = rsqrtf((red[0] + red[1]) / 128.f + EPS);
    ckv[tid] = pr[C_CKV + tid] * rs * kvn[tid];
    if (tid < 32) kr[tid] = pr[C_KR + tid];
    __syncthreads();
    for (int j = tid; j < 384; j += 128) { float a = 0.f; for (int k = 0; k < 192; ++k) a += cq[k] * wuq[k * 384 + j]; qs[j] = a; }
    for (int j = tid; j < 512; j += 128) { float a = 0.f; for (int k = 0; k < 128; ++k) a += ckv[k] * wukv[k * 512 + j]; kvs[j] = a; }
    __syncthreads();
    const float fp = (float)pos[t];
    for (int idx = tid; idx < 4 * 96; idx += 128) {
        const int h = idx / 96, j = idx % 96;
        float qv, kv;
        if (j < 64) { qv = qs[h * 96 + j]; kv = kvs[h * 128 + j]; }
        else {
            const int r = j - 64, i = r & 15;
            const float inv = powf(10000.f, -(float)(2 * i) / 32.f);
            const float ang = fp * inv; const float c = cosf(ang), sn = sinf(ang);
            const float q1 = qs[h * 96 + 64 + i], q2 = qs[h * 96 + 80 + i], k1 = kr[i], k2 = kr[16 + i];
            if (r < 16) { qv = q1 * c - q2 * sn; kv = k1 * c - k2 * sn; } else { qv = q1 * sn + q2 * c; kv = k1 * sn + k2 * c; }
        }
        QM[(t * 4 + h) * 96 + j] = qv; KM[(t * 4 + h) * 96 + j] = kv;
    }
    for (int idx = tid; idx < 256; idx += 128) { const int h = idx >> 6, j = idx & 63; VM[(t * 4 + h) * 64 + j] = kvs[h * 128 + 64 + j]; }
}

__global__ __launch_bounds__(512) void k_lru_pre(const float* __restrict__ proj, const float* __restrict__ cw, const float* __restrict__ cb, const float* __restrict__ wa, const float* __restrict__ ba,
                                                  const float* __restrict__ wx, const float* __restrict__ bx, const float* __restrict__ lam, float* __restrict__ LA, float* __restrict__ LU) {
    __shared__ float xc[512];
    const long t = blockIdx.x; const int c = threadIdx.x; const int s = (int)(t % S);
    float y = cb[c];
#pragma unroll
    for (int k = 0; k < 4; ++k) { const int ts = s - 3 + k; if (ts >= 0) y += proj[(t - 3 + k) * INW + C_XL + c] * cw[k * 512 + c]; }
    xc[c] = y;
    __syncthreads();
    const int g = c >> 6, j = c & 63;
    float ra = ba[c], ri = bx[c];
    for (int i = 0; i < 64; ++i) { const float xv = xc[g * 64 + i]; ra += xv * wa[(g * 64 + i) * 64 + j]; ri += xv * wx[(g * 64 + i) * 64 + j]; }
    const float r = 1.f / (1.f + expf(-ra)), ig = 1.f / (1.f + expf(-ri));
    const float sp = log1pf(expf(-lam[c]));
    const float log_a = -8.0f * r * sp;
    const float a = expf(log_a);
    const float u = sqrtf(-expm1f(2.f * log_a)) * (ig * y);
    LA[t * 512 + c] = a; LU[t * 512 + c] = u;
}
__global__ __launch_bounds__(64) void k_lru_scan(const float* __restrict__ proj, const float* __restrict__ LA, float* __restrict__ LU) {
    const int id = blockIdx.x * 64 + threadIdx.x; const int b = id >> 9, c = id & 511;
    float h = 0.f;
    for (int s = 0; s < S; ++s) {
        const long t = (long)b * S + s;
        h = LA[t * 512 + c] * h + LU[t * 512 + c];
        const float gt = proj[t * INW + C_GL + c];
        LU[t * 512 + c] = h * (0.5f * gt * (1.f + erff(gt * 0.70710678118654752f)));
    }
}

__global__ __launch_bounds__(256) void k_attn_mla(const float* __restrict__ QM, const float* __restrict__ KM, const float* __restrict__ VM, float* __restrict__ OM) {
    __shared__ float Ks[64 * 96]; __shared__ float Vs[64 * 64];
    const int qb = blockIdx.x, h = blockIdx.y, b = blockIdx.z, tid = threadIdx.x;
    const int q = qb * 256 + tid; const long t = (long)b * S + q;
    const float scale = 0.10206207261596575f;
    float qr[96];
#pragma unroll
    for (int j = 0; j < 96; ++j) qr[j] = QM[(t * 4 + h) * 96 + j] * scale;
    float m = -1e30f, l = 0.f, o[64];
#pragma unroll
    for (int j = 0; j < 64; ++j) o[j] = 0.f;
    const int kend = (qb + 1) * 256;
    for (int k0 = 0; k0 < kend; k0 += 64) {
        __syncthreads();
        for (int i = tid; i < 64 * 96; i += 256) { const int kk = i / 96, j = i % 96; Ks[i] = KM[(((long)b * S + k0 + kk) * 4 + h) * 96 + j]; }
        for (int i = tid; i < 64 * 64; i += 256) { const int kk = i >> 6, j = i & 63; Vs[i] = VM[(((long)b * S + k0 + kk) * 4 + h) * 64 + j]; }
        __syncthreads();
        for (int kk = 0; kk < 64; ++kk) {
            if (k0 + kk <= q) {
                float s = 0.f;
#pragma unroll
                for (int j = 0; j < 96; ++j) s += qr[j] * Ks[kk * 96 + j];
                if (s > m) { const float corr = expf(m - s); l *= corr;
#pragma unroll
                    for (int j = 0; j < 64; ++j) o[j] *= corr;
                    m = s; }
                const float p = expf(s - m); l += p;
#pragma unroll
                for (int j = 0; j < 64; ++j) o[j] += p * Vs[kk * 64 + j];
            }
        }
    }
    const float il = 1.f / l;
#pragma unroll
    for (int j = 0; j < 64; ++j) OM[t * 256 + h * 64 + j] = o[j] * il;
}

__global__ __launch_bounds__(256) void k_attn_diff(const float* __restrict__ proj, const int* __restrict__ pos, const float* __restrict__ relb, const float* __restrict__ dnorm,
                                                   const float* __restrict__ dl, float lam_init, float* __restrict__ OD) {
    __shared__ float Ks[64 * 64]; __shared__ float Vs[64 * 64]; __shared__ int ps[64]; __shared__ float btab[129];
    const int qb = blockIdx.x, h = blockIdx.y, b = blockIdx.z, tid = threadIdx.x;
    const int q = qb * 256 + tid; const long t = (long)b * S + q;
    if (tid < 129) {
        const int n = tid; int bu;
        if (n < 16) bu = n; else { int lg = 16 + (int)(logf((float)n / 16.f) / logf(8.f) * 16.f); bu = lg < 31 ? lg : 31; }
        btab[tid] = relb[bu * 4 + h];
    }
    const float scale = 0.17677669529663687f;
    float lam;
    { float a = 0.f, c = 0.f; for (int j = 0; j < 32; ++j) { a += dl[j] * dl[32 + j]; c += dl[64 + j] * dl[96 + j]; } lam = expf(a) - expf(c) + lam_init; }
    float q1[32], q2[32];
#pragma unroll
    for (int j = 0; j < 32; ++j) { q1[j] = proj[t * INW + C_QD + h * 64 + j] * scale; q2[j] = proj[t * INW + C_QD + h * 64 + 32 + j] * scale; }
    const int pq = pos[t];
    float m1 = -1e30f, l1 = 0.f, m2 = -1e30f, l2 = 0.f, o1[64], o2[64];
#pragma unroll
    for (int j = 0; j < 64; ++j) { o1[j] = 0.f; o2[j] = 0.f; }
    const int kend = (qb + 1) * 256;
    for (int k0 = 0; k0 < kend; k0 += 64) {
        __syncthreads();
        for (int i = tid; i < 64 * 64; i += 256) { const int kk = i >> 6, j = i & 63; const long tk = (long)b * S + k0 + kk; Ks[i] = proj[tk * INW + C_KD + h * 64 + j]; Vs[i] = proj[tk * INW + C_VD + h * 64 + j]; }
        if (tid < 64) ps[tid] = pos[(long)b * S + k0 + tid];
        __syncthreads();
        for (int kk = 0; kk < 64; ++kk) {
            if (k0 + kk <= q) {
                int n = pq - ps[kk]; n = n < 0 ? 0 : (n > 128 ? 128 : n);
                const float bias = btab[n];
                float s1 = bias, s2 = bias;
#pragma unroll
                for (int j = 0; j < 32; ++j) { s1 += q1[j] * Ks[kk * 64 + j]; s2 += q2[j] * Ks[kk * 64 + 32 + j]; }
                if (s1 > m1) { const float corr = expf(m1 - s1); l1 *= corr;
#pragma unroll
                    for (int j = 0; j < 64; ++j) o1[j] *= corr;
                    m1 = s1; }
                if (s2 > m2) { const float corr = expf(m2 - s2); l2 *= corr;
#pragma unroll
                    for (int j = 0; j < 64; ++j) o2[j] *= corr;
                    m2 = s2; }
                const float p1 = expf(s1 - m1), p2 = expf(s2 - m2); l1 += p1; l2 += p2;
#pragma unroll
                for (int j = 0; j < 64; ++j) { const float v = Vs[kk * 64 + j]; o1[j] += p1 * v; o2[j] += p2 * v; }
            }
        }
    }
    const float i1 = 1.f / l1, i2 = lam / l2;
    float ss = 0.f;
#pragma unroll
    for (int j = 0; j < 64; ++j) { o1[j] = o1[j] * i1 - o2[j] * i2; ss += o1[j] * o1[j]; }
    const float rs = rsqrtf(ss / 64.f + EPS) * (1.f - lam_init);
#pragma unroll
    for (int j = 0; j < 64; ++j) OD[t * 256 + h * 64 + j] = o1[j] * rs * dnorm[j];
}

__global__ __launch_bounds__(256) void k_post(const float* __restrict__ OM, const float* __restrict__ H, const float* __restrict__ OD, const float* __restrict__ gm, const float* __restrict__ gl, bf16_t* __restrict__ Y) {
    __shared__ float red[8];
    const long t = blockIdx.x; const int tid = threadIdx.x;
    const float a = OM[t * 256 + tid], h0 = H[t * 512 + tid], h1 = H[t * 512 + 256 + tid];
    float s1 = a * a, s2 = h0 * h0 + h1 * h1;
    for (int o = 32; o > 0; o >>= 1) { s1 += __shfl_xor(s1, o); s2 += __shfl_xor(s2, o); }
    if ((tid & 63) == 0) { red[tid >> 6] = s1; red[4 + (tid >> 6)] = s2; }
    __syncthreads();
    const float r1 = rsqrtf((red[0] + red[1] + red[2] + red[3]) / 256.f + EPS), r2 = rsqrtf((red[4] + red[5] + red[6] + red[7]) / 512.f + EPS);
    Y[t * 1024 + tid] = (bf16_t)f2bf(a * r1 * gm[tid]);
    Y[t * 1024 + 256 + tid] = (bf16_t)f2bf(h0 * r2 * gl[tid]);
    Y[t * 1024 + 512 + tid] = (bf16_t)f2bf(h1 * r2 * gl[256 + tid]);
    Y[t * 1024 + 768 + tid] = (bf16_t)f2bf(OD[t * 256 + tid]);
}

__global__ __launch_bounds__(256) void k_softmax256(float* __restrict__ Sm, long rows) {
    const long row = (long)blockIdx.x * 4 + (threadIdx.x >> 6); const int lane = threadIdx.x & 63;
    if (row >= rows) return;
    float* r = Sm + row * 256;
    float v[4]; float m = -1e30f;
#pragma unroll
    for (int i = 0; i < 4; ++i) { v[i] = r[lane + 64 * i]; m = fmaxf(m, v[i]); }
    for (int o = 32; o > 0; o >>= 1) m = fmaxf(m, __shfl_xor(m, o));
    float s = 0.f;
#pragma unroll
    for (int i = 0; i < 4; ++i) { v[i] = expf(v[i] - m); s += v[i]; }
    for (int o = 32; o > 0; o >>= 1) s += __shfl_xor(s, o);
    const float is = 1.f / s;
#pragma unroll
    for (int i = 0; i < 4; ++i) r[lane + 64 * i] = v[i] * is;
}

__global__ __launch_bounds__(256) void k_route(const float* __restrict__ QP, const float* __restrict__ keys, int* __restrict__ EX, float* __restrict__ GW) {
    __shared__ float q[1024]; __shared__ float sc[16][128]; __shared__ float ts[16][16]; __shared__ int ti[16][16]; __shared__ float cand[8][256];
    const long t = blockIdx.x; const int tid = threadIdx.x;
    for (int i = tid; i < 1024; i += 256) q[i] = QP[t * 1024 + i];
    __syncthreads();
    for (int i = tid; i < 2048; i += 256) {
        const int li = i >> 7, n = i & 127, c = li & 1;
        const float* kp = keys + ((long)c * 128 + n) * 64; const float* qp = q + li * 64;
        float a = 0.f;
        for (int d = 0; d < 64; ++d) a += qp[d] * kp[d];
        sc[li][n] = a;
    }
    __syncthreads();
    if (tid < 16) {
        for (int r = 0; r < 16; ++r) {
            float best = -3.0e38f; int bi = 0;
            for (int n = 0; n < 128; ++n) { const float v = sc[tid][n]; if (v > best) { best = v; bi = n; } }
            ts[tid][r] = best; ti[tid][r] = bi; sc[tid][bi] = -3.0e38f;
        }
    }
    __syncthreads();
    for (int i = tid; i < 2048; i += 256) { const int h = i >> 8, ab = i & 255; cand[h][ab] = ts[h * 2][ab >> 4] + ts[h * 2 + 1][ab & 15]; }
    __syncthreads();
    if (tid < 8) {
        float bs[16]; int be[16];
        float mx = -3.0e38f;
#pragma unroll
        for (int r = 0; r < 16; ++r) {
            float best = -3.0e38f; int bi = 0;
            for (int n = 0; n < 256; ++n) { const float v = cand[tid][n]; if (v > best) { best = v; bi = n; } }
            cand[tid][bi] = -3.0e38f;
            bs[r] = best; be[r] = ti[tid * 2][bi >> 4] * 128 + ti[tid * 2 + 1][bi & 15];
            mx = fmaxf(mx, best);
        }
        float sum = 0.f;
#pragma unroll
        for (int r = 0; r < 16; ++r) { bs[r] = expf(bs[r] - mx); sum += bs[r]; }
        const float is = 1.f / sum;
#pragma unroll
        for (int r = 0; r < 16; ++r) { EX[t * 128 + tid * 16 + r] = be[r]; GW[t * 128 + tid * 16 + r] = bs[r] * is; }
    }
}

__global__ __launch_bounds__(256) void k_peer(const bf16_t* __restrict__ XN, const int* __restrict__ EX, const float* __restrict__ GW, const float* __restrict__ U, const float* __restrict__ V, float* __restrict__ X) {
    __shared__ float hs[1024]; __shared__ float w[128]; __shared__ int es[128];
    const long t = blockIdx.x; const int tid = threadIdx.x, wave = tid >> 6, lane = tid & 63;
    for (int i = tid; i < 1024; i += 256) hs[i] = bf2f(XN[t * 1024 + i]);
    if (tid < 128) es[tid] = EX[t * 128 + tid];
    __syncthreads();
    for (int j = wave; j < 128; j += 4) {
        const float* up = U + (long)es[j] * 1024;
        float a = 0.f;
        for (int i = lane; i < 1024; i += 64) a += hs[i] * up[i];
        for (int o = 32; o > 0; o >>= 1) a += __shfl_xor(a, o);
        if (lane == 0) w[j] = GW[t * 128 + j] * (0.5f * a * (1.f + erff(a * 0.70710678118654752f)));
    }
    __syncthreads();
    float o[4] = {0.f, 0.f, 0.f, 0.f};
    for (int j = 0; j < 128; ++j) {
        const float* vp = V + (long)es[j] * 1024; const float wj = w[j];
#pragma unroll
        for (int i = 0; i < 4; ++i) o[i] += wj * vp[tid + 256 * i];
    }
#pragma unroll
    for (int i = 0; i < 4; ++i) X[t * 1024 + tid + 256 * i] += o[i];
}

}

namespace pg8 {
#define PG8_LAS __attribute__((address_space(3)))
typedef unsigned short bf16_t;
typedef short bf16x8 __attribute__((ext_vector_type(8)));
typedef float f32x4 __attribute__((ext_vector_type(4)));
typedef unsigned u32x4 __attribute__((ext_vector_type(4)));
typedef unsigned u32x2 __attribute__((ext_vector_type(2)));
constexpr int BM = 256, BK = 64, HALF = 128, HTB = HALF * BK * 2, STAGE_BYTES = 8 * HTB, NXCD = 8, WGM = 8;
__host__ __device__ __forceinline__ int lds_byte(int r, int c) { const int st = (r >> 4) * 2 + (c >> 5), rr = r & 15, cc = c & 31, ob = rr * 64 + cc * 2; return st * 1024 + (ob ^ (((ob >> 9) & 1) << 5)); }
__host__ __device__ __forceinline__ void stage_rc(int b, int& R, int& C) { const int st = b / 1024, sb = b % 1024, swz = sb ^ (((sb >> 9) & 1) << 5); R = (st >> 1) * 16 + swz / 64; C = (st & 1) * 32 + (swz % 64) / 2; }
__host__ __device__ __forceinline__ int perm32(int rho) { const int n = rho >> 4, i = rho & 15; return 8 * (i >> 2) + 4 * n + (i & 3); }
struct Unit { int pm, pn; };
struct Gemm { const bf16_t* A; const bf16_t* Bt; int M, N, K, lda, ldb; };
struct StaticOrder {
    int nM, nN, nwg, G, c;
    __host__ __device__ void init(int M, int N, int G_, int c_) { nM = M / BM; nN = N / BM; nwg = nM * nN; G = G_; c = c_; }
    __host__ __device__ bool next(int i, Unit& u) const {
        const long L = (long)i * G + c; if (L >= nwg) return false;
        int wgid = (int)L; { const int q = nwg / NXCD, r = nwg % NXCD, xcd = wgid % NXCD, off = wgid / NXCD; wgid = (xcd < r ? xcd * (q + 1) : r * (q + 1) + (xcd - r) * q) + off; }
        const int nig = WGM * nN, gid = wgid / nig, fm = gid * WGM, gsz = (nM - fm) < WGM ? (nM - fm) : WGM;
        u.pm = fm + ((wgid % nig) % gsz); u.pn = (wgid % nig) / gsz; return true;
    }
    __device__ __forceinline__ void a_ready(const Unit&) const {}
    __device__ __forceinline__ void done(const Unit&) const {}
};
__device__ __forceinline__ unsigned cvt_pk_bf16(float lo, float hi) { unsigned r; asm volatile("v_cvt_pk_bf16_f32 %0, %1, %2" : "=v"(r) : "v"(lo), "v"(hi)); return r; }

struct EpiF32 {
    static constexpr bool PERM = false, AFTER_DRAIN = false;
    float* C; int ldc; int nvalid; int accum;
    __device__ __forceinline__ void operator()(const f32x4 (&acc)[2][2][4][2], const Unit& u, int wr, int wc, int fr, int fq) const {
#pragma unroll
        for (int ai = 0; ai < 2; ++ai)
#pragma unroll
            for (int m = 0; m < 4; ++m) { const size_t row = (size_t)u.pm * BM + ai * HALF + wr * 64 + m * 16 + fr;
#pragma unroll
                for (int bj = 0; bj < 2; ++bj)
#pragma unroll
                    for (int n = 0; n < 2; ++n) { const int col = u.pn * BM + bj * HALF + wc * 32 + n * 16 + 4 * fq;
                        if (col < nvalid) { float* p = C + row * ldc + col; f32x4 v = acc[ai][bj][m][n]; if (accum) v += *(const f32x4*)p; *(f32x4*)p = v; } } }
    }
};
struct EpiBf16 {
    static constexpr bool PERM = true, AFTER_DRAIN = false;
    bf16_t* O; int ldc; int nvalid;
    __device__ __forceinline__ void operator()(const f32x4 (&acc)[2][2][4][2], const Unit& u, int wr, int wc, int fr, int fq) const {
#pragma unroll
        for (int ai = 0; ai < 2; ++ai)
#pragma unroll
            for (int m = 0; m < 4; ++m) { const size_t row = (size_t)u.pm * BM + ai * HALF + wr * 64 + m * 16 + fr;
#pragma unroll
                for (int bj = 0; bj < 2; ++bj) { const int col = u.pn * BM + bj * HALF + wc * 32 + 8 * fq;
                    if (col < nvalid) { const f32x4 v0 = acc[ai][bj][m][0], v1 = acc[ai][bj][m][1]; u32x4 w; w.x = cvt_pk_bf16(v0[0], v0[1]); w.y = cvt_pk_bf16(v0[2], v0[3]); w.z = cvt_pk_bf16(v1[0], v1[1]); w.w = cvt_pk_bf16(v1[2], v1[3]);
                        *(u32x4*)(O + row * ldc + col) = w; } } }
    }
};
template <class Epi, class Sched, bool ALIGN_EPI = false, bool SP2 = false>
__device__ __forceinline__ void gemm_phase(PG8_LAS unsigned char* lds, const Gemm g, const Sched& S, const Epi& E) {
    int tid_ = threadIdx.x; asm volatile("" : "+v"(tid_));
    const int tid = tid_, wid = __builtin_amdgcn_readfirstlane(tid >> 6), lane = tid & 63, wr = wid >> 2, wc = wid & 3, fr = lane & 15, fq = lane >> 4;
    const int K = g.K, nt = K / BK;
    unsigned voffA[2], voffB[2];
#pragma unroll
    for (int i = 0; i < 2; ++i) { int R, C; stage_rc(tid * 16 + i * 8192, R, C); const int Rb = Epi::PERM ? ((R & ~31) + perm32(R & 31)) : R;
        voffA[i] = (unsigned)(R * g.lda + C) * 2u; voffB[i] = (unsigned)(Rb * g.ldb + C) * 2u; }
    const size_t kstep = (size_t)(BK * 2);
    const size_t hstepA = (size_t)HALF * g.lda * 2, hstepB = (size_t)HALF * g.ldb * 2;
    const size_t tstepA = 2 * hstepA, tstepB = 2 * hstepB;
    const unsigned ldsw = (unsigned)wid * 1024u;
    const int aoff = lds_byte(wr * 64 + fr, fq * 8), boff = lds_byte(wc * 32 + fr, fq * 8);
#define PG8_SA(b, h) (((b) * 2 + (h)) * HTB)
#define PG8_SB(b, h) ((4 + (b) * 2 + (h)) * HTB)
#define PG8_STAGE(bufoff, gbase, voff) do { _Pragma("unroll") for (int _i = 0; _i < 2; ++_i) \
        __builtin_amdgcn_global_load_lds((const unsigned*)((const char*)(gbase) + (voff)[_i]), (PG8_LAS unsigned*)(lds + (bufoff) + ldsw + _i * 8192), 16, 0, 0); } while (0)
#define PG8_LDA(dst, b, h) do { _Pragma("unroll") for (int m = 0; m < 4; ++m) _Pragma("unroll") for (int k = 0; k < 2; ++k) dst[m][k] = *(const PG8_LAS bf16x8*)(lds + PG8_SA(b, h) + aoff + m * 2048 + k * 1024); } while (0)
#define PG8_LDB(dst, b, h) do { _Pragma("unroll") for (int n = 0; n < 2; ++n) _Pragma("unroll") for (int k = 0; k < 2; ++k) dst[n][k] = *(const PG8_LAS bf16x8*)(lds + PG8_SB(b, h) + boff + n * 2048 + k * 1024); } while (0)
#define PG8_MMA(ai, bj, At, Bt) do { __builtin_amdgcn_s_setprio(1); _Pragma("unroll") for (int m = 0; m < 4; ++m) _Pragma("unroll") for (int n = 0; n < 2; ++n) _Pragma("unroll") for (int k = 0; k < 2; ++k) \
        acc[ai][bj][m][n] = __builtin_amdgcn_mfma_f32_16x16x32_bf16(Bt[n][k], At[m][k], acc[ai][bj][m][n], 0, 0, 0); __builtin_amdgcn_s_setprio(0); } while (0)
#define PG8_WAIT_V(n) asm volatile("s_waitcnt vmcnt(" #n ")" ::: "memory")
#define PG8_WAIT_L(n) asm volatile("s_waitcnt lgkmcnt(" #n ")" ::: "memory")
#define PG8_BAR __builtin_amdgcn_s_barrier()
#define PG8_SCHED __builtin_amdgcn_sched_barrier(0)
    Unit cur, nxt; int ui = 0;
    if (!S.next(0, cur)) return;
    f32x4 acc[2][2][4][2];
#pragma unroll
    for (int a = 0; a < 2; ++a)
#pragma unroll
        for (int b = 0; b < 2; ++b)
#pragma unroll
            for (int m = 0; m < 4; ++m)
#pragma unroll
                for (int n = 0; n < 2; ++n) acc[a][b][m][n] = (f32x4){0.f, 0.f, 0.f, 0.f};
    bf16x8 At[4][2], B0[2][2], B1[2][2];
    const char* cA = (const char*)g.A + (size_t)cur.pm * tstepA; const char* cB = (const char*)g.Bt + (size_t)cur.pn * tstepB;
    S.a_ready(cur);
    if constexpr (SP2) {
        PG8_STAGE(PG8_SB(0, 0), cB, voffB); PG8_STAGE(PG8_SB(0, 1), cB + hstepB, voffB); PG8_STAGE(PG8_SA(0, 0), cA, voffA); PG8_STAGE(PG8_SA(0, 1), cA + hstepA, voffA);
        if (wr == 1) PG8_BAR;
        PG8_WAIT_V(2); PG8_BAR;
        PG8_STAGE(PG8_SB(1, 0), cB + kstep, voffB); PG8_STAGE(PG8_SA(1, 0), cA + kstep, voffA); PG8_STAGE(PG8_SB(1, 1), cB + hstepB + kstep, voffB);
        PG8_WAIT_V(6); PG8_BAR;
    } else {
        PG8_STAGE(PG8_SB(0, 0), cB, voffB); PG8_STAGE(PG8_SA(0, 0), cA, voffA); PG8_STAGE(PG8_SB(0, 1), cB + hstepB, voffB); PG8_STAGE(PG8_SA(0, 1), cA + hstepA, voffA);
        if (wr == 1) PG8_BAR;
        PG8_WAIT_V(4); PG8_BAR;
        PG8_STAGE(PG8_SB(1, 0), cB + kstep, voffB); PG8_STAGE(PG8_SA(1, 0), cA + kstep, voffA); PG8_STAGE(PG8_SB(1, 1), cB + hstepB + kstep, voffB);
        PG8_WAIT_V(6); PG8_BAR;
    }
    for (;;) {
        const bool has_next = S.next(ui + 1, nxt);
        const char* nA = has_next ? (const char*)g.A + (size_t)nxt.pm * tstepA : cA; const char* nB = has_next ? (const char*)g.Bt + (size_t)nxt.pn * tstepB : cB;
        for (int t = 0; t < nt; t += 2) {
            const bool last = (t == nt - 2);
            const char* a1 = cA + (size_t)(t + 1) * kstep;
            const char* a2 = last ? nA : cA + (size_t)(t + 2) * kstep; const char* b2 = last ? nB : cB + (size_t)(t + 2) * kstep;
            const char* a3 = a2 + kstep; const char* b3 = b2 + kstep;
            if (last && has_next) S.a_ready(nxt);
            if constexpr (SP2) {
            PG8_LDB(B0, 0, 0); PG8_LDB(B1, 0, 1); PG8_SCHED; PG8_LDA(At, 0, 0); PG8_STAGE(PG8_SA(1, 1), a1 + hstepA, voffA);
            PG8_WAIT_V(8); PG8_WAIT_L(0); PG8_BAR; PG8_MMA(0, 0, At, B0); PG8_MMA(0, 1, At, B1); PG8_BAR; PG8_SCHED;
            PG8_LDA(At, 0, 1); PG8_STAGE(PG8_SB(0, 0), b2, voffB); PG8_STAGE(PG8_SB(0, 1), b2 + hstepB, voffB); PG8_STAGE(PG8_SA(0, 0), a2, voffA);
            PG8_WAIT_V(8); PG8_WAIT_L(0); PG8_BAR; PG8_MMA(1, 0, At, B0); PG8_MMA(1, 1, At, B1); PG8_BAR; PG8_SCHED;
            PG8_LDB(B0, 1, 0); PG8_LDB(B1, 1, 1); PG8_SCHED; PG8_LDA(At, 1, 0); PG8_STAGE(PG8_SA(0, 1), a2 + hstepA, voffA);
            PG8_WAIT_V(8); PG8_WAIT_L(0); PG8_BAR; PG8_MMA(0, 0, At, B0); PG8_MMA(0, 1, At, B1); PG8_BAR; PG8_SCHED;
            PG8_LDA(At, 1, 1); PG8_STAGE(PG8_SB(1, 0), b3, voffB); PG8_STAGE(PG8_SB(1, 1), b3 + hstepB, voffB); PG8_STAGE(PG8_SA(1, 0), a3, voffA);
            PG8_WAIT_V(8); PG8_WAIT_L(0); PG8_BAR; PG8_MMA(1, 0, At, B0); PG8_MMA(1, 1, At, B1); PG8_BAR; PG8_SCHED;
            } else {
            PG8_LDB(B0, 0, 0); PG8_SCHED; PG8_LDA(At, 0, 0); PG8_STAGE(PG8_SA(1, 1), a1 + hstepA, voffA);
            PG8_WAIT_L(8); PG8_BAR; PG8_WAIT_L(0); PG8_MMA(0, 0, At, B0); PG8_BAR; PG8_SCHED;
            PG8_LDB(B1, 0, 1); PG8_STAGE(PG8_SB(0, 0), b2, voffB);
            PG8_BAR; PG8_WAIT_L(0); PG8_MMA(0, 1, At, B1); PG8_BAR;
            PG8_LDA(At, 0, 1); PG8_STAGE(PG8_SA(0, 0), a2, voffA);
            PG8_BAR; PG8_WAIT_L(0); PG8_MMA(1, 0, At, B0); PG8_BAR; PG8_SCHED;
            PG8_STAGE(PG8_SB(0, 1), b2 + hstepB, voffB);
            PG8_WAIT_V(6); PG8_BAR; PG8_MMA(1, 1, At, B1); PG8_BAR;
            PG8_LDB(B0, 1, 0); PG8_SCHED; PG8_LDA(At, 1, 0); PG8_STAGE(PG8_SA(0, 1), a2 + hstepA, voffA);
            PG8_WAIT_L(8); PG8_BAR; PG8_WAIT_L(0); PG8_MMA(0, 0, At, B0); PG8_BAR; PG8_SCHED;
            PG8_LDB(B1, 1, 1); PG8_STAGE(PG8_SB(1, 0), b3, voffB);
            PG8_BAR; PG8_WAIT_L(0); PG8_MMA(0, 1, At, B1); PG8_BAR;
            PG8_LDA(At, 1, 1); PG8_STAGE(PG8_SA(1, 0), a3, voffA);
            PG8_BAR; PG8_WAIT_L(0); PG8_MMA(1, 0, At, B0); PG8_BAR; PG8_SCHED;
            PG8_STAGE(PG8_SB(1, 1), b3 + hstepB, voffB);
            PG8_WAIT_V(6); PG8_BAR; PG8_MMA(1, 1, At, B1); PG8_BAR;
            }
        }
        if constexpr (ALIGN_EPI) { if (wr == 0) PG8_BAR; }
        if constexpr (!Epi::AFTER_DRAIN) { E(acc, cur, wr, wc, fr, fq); S.done(cur); }
        if (!has_next) break;
#pragma unroll
        for (int a = 0; a < 2; ++a)
#pragma unroll
            for (int b = 0; b < 2; ++b)
#pragma unroll
                for (int m = 0; m < 4; ++m)
#pragma unroll
                    for (int n = 0; n < 2; ++n) acc[a][b][m][n] = (f32x4){0.f, 0.f, 0.f, 0.f};
        cur = nxt; cA = nA; cB = nB; ++ui;
        if constexpr (ALIGN_EPI) { if (wr == 1) PG8_BAR; }
    }
    PG8_WAIT_V(0);
    if constexpr (!ALIGN_EPI) { if (wr == 0) PG8_BAR; }
    PG8_BAR;
    if constexpr (Epi::AFTER_DRAIN) { E.fused(acc, cur, wr, wc, fr, fq, lds, wid, lane); S.done(cur); }
#undef PG8_SA
#undef PG8_SB
#undef PG8_STAGE
#undef PG8_LDA
#undef PG8_LDB
#undef PG8_MMA
#undef PG8_WAIT_V
#undef PG8_WAIT_L
#undef PG8_BAR
#undef PG8_SCHED
}
}

namespace mk {
#define GAS __attribute__((address_space(1)))
#define LAS __attribute__((address_space(3)))
typedef unsigned short bf16;
typedef unsigned v4u __attribute__((ext_vector_type(4)));
typedef float f32x4 __attribute__((ext_vector_type(4)));
typedef GAS unsigned gu32;
#define LDS_WAIT() asm volatile("s_waitcnt lgkmcnt(0)" ::: "memory")
#define VM_WAIT() asm volatile("s_waitcnt vmcnt(0)" ::: "memory")
__device__ __forceinline__ unsigned f2bf_(float f) { unsigned u = __builtin_bit_cast(unsigned, f); return (u + 0x7fffu + ((u >> 16) & 1u)) >> 16; }
__device__ __forceinline__ unsigned pk2(float lo, float hi) { return f2bf_(lo) | (f2bf_(hi) << 16); }

constexpr int NWAVES = 8;
constexpr int D = 1024, NB = 4, S = 8192, T = NB * S, L = 4, MEM = 256, INW = 2144, INP = 2304;
constexpr size_t MiB = 1u << 20;
constexpr size_t WS_CTL = 0, CTL_ZERO_BYTES = 1 * MiB;
constexpr size_t WS_WIN = 1 * MiB, WS_WOUT = 19 * MiB, WS_WCQ = 27 * MiB, WS_WCO = 35 * MiB, WS_WPQ = 43 * MiB, WS_WCKV = 51 * MiB;
constexpr size_t WS_XNB = 68 * MiB, WS_YB = 132 * MiB, WS_MNB = 196 * MiB;
constexpr size_t WS_PROJ = 208 * MiB, WS_QKV = 476 * MiB, WS_LAU = 604 * MiB, WS_OMD = 732 * MiB, WS_KVC = 796 * MiB, WS_EXG = 804 * MiB, WS_ATB = 836 * MiB, WS_END = 948 * MiB;
constexpr int CW_BAR = 4096;
constexpr int RING_OFF = 0, RING_BYTES = 131072, LDSCTL_OFF = RING_BYTES, MISC_OFF = LDSCTL_OFF + 320, LDS_BYTES = 147456;

#define XB_TMO      128
#define XB_XCNT(j)  (256  + 64 * (j))
#define XB_XSUB(j)  (1280 + 64 * (j))
#define XB_XGEN(j)  (2304 + 64 * (j))
#define XB_TOP      3328
#define XB_TOPGEN   3392
#define XCD_BAR_WORDS 3456
#define XB_SPIN_CAP (1u << 18)

__device__ __forceinline__ unsigned xb_ld(unsigned* p)              { return __hip_atomic_load(p, __ATOMIC_RELAXED, __HIP_MEMORY_SCOPE_AGENT); }
__device__ __forceinline__ unsigned xb_add(unsigned* p, unsigned v) { return __hip_atomic_fetch_add(p, v, __ATOMIC_RELAXED, __HIP_MEMORY_SCOPE_AGENT); }
__device__ __forceinline__ unsigned xb_xcc_id() { return (unsigned)__builtin_amdgcn_s_getreg((3 << 11) | 20) & 0xFu; }
#define XB_SPIN(cond, bar) do { unsigned _sp = 0; while (cond) { __builtin_amdgcn_s_sleep(1); \
    if ((++_sp & 255u) == 0u) { if (xb_ld(&(bar)[XB_TMO])) break; if (_sp > XB_SPIN_CAP) { atomicAdd(&(bar)[XB_TMO], 1u); break; } } } } while (0)

struct XcdBarrier {
    unsigned* bar; unsigned x;
    volatile LAS unsigned* st;
};

__device__ __forceinline__ XcdBarrier xcd_barrier_post(unsigned* bar, volatile LAS unsigned* st) {
    XcdBarrier b; b.bar = bar; b.x = xb_xcc_id(); b.st = st;
    if (threadIdx.x == 0) (void)xb_add(&bar[XB_XCNT(b.x)], 1u);
    return b;
}
__device__ __forceinline__ void xcd_barrier_complete(unsigned* bar, unsigned x, unsigned& nloc, unsigned& nx) {
    const unsigned G = gridDim.x * gridDim.y * gridDim.z;
    unsigned sum, cnt, mine, sp = 0u;
    for (;;) {
        sum = 0u; cnt = 0u; mine = 0u;
#pragma unroll
        for (unsigned j = 0; j < 16; ++j) { const unsigned c = xb_ld(&bar[XB_XCNT(j)]); sum += c; cnt += (c > 0u) ? 1u : 0u; mine = (j == x) ? c : mine; }
        if (sum == G) break;
        __builtin_amdgcn_s_sleep(1);
        if ((++sp & 255u) == 0u) { if (xb_ld(&bar[XB_TMO])) break; if (sp > XB_SPIN_CAP) { atomicAdd(&bar[XB_TMO], 1u); break; } }
    }
    nloc = mine > 0u ? mine : 1u; nx = cnt > 0u ? cnt : 1u;
}

__device__ __forceinline__ void xcd_barrier(const XcdBarrier& b) {
    asm volatile("s_waitcnt vmcnt(0)" ::: "memory");
    __syncthreads();
    if (threadIdx.x == 0) {
        unsigned* bar = b.bar;
        __builtin_amdgcn_s_waitcnt(0);
        unsigned nloc = b.st[0], nx = b.st[1];
        if (nloc == 0u) { xcd_barrier_complete(bar, b.x, nloc, nx); b.st[0] = nloc; b.st[1] = nx; }
        const unsigned old = xb_add(&bar[XB_XSUB(b.x)], 1u);
        const unsigned gen = old / nloc;
        if (old + 1u == (gen + 1u) * nloc) {
            __builtin_amdgcn_fence(__ATOMIC_RELEASE, "agent");
            asm volatile("s_waitcnt vmcnt(0)" ::: "memory");
            const unsigned og = xb_add(&bar[XB_TOP], 1u);
            const unsigned tg = og / nx;
            if (og + 1u == (tg + 1u) * nx) xb_add(&bar[XB_TOPGEN], 1u);
            else XB_SPIN(xb_ld(&bar[XB_TOPGEN]) == tg, bar);
            __builtin_amdgcn_fence(__ATOMIC_ACQUIRE, "agent");
            xb_add(&bar[XB_XGEN(b.x)], 1u);
            asm volatile("s_waitcnt vmcnt(0)" ::: "memory");
        } else {
            XB_SPIN(xb_ld(&bar[XB_XGEN(b.x)]) == gen, bar);
            __builtin_amdgcn_fence(__ATOMIC_ACQUIRE, "agent");
            asm volatile("s_waitcnt vmcnt(0)" ::: "memory");
        }
    }
    __syncthreads();
}

typedef short bf16x8 __attribute__((ext_vector_type(8)));
typedef short s16x4 __attribute__((ext_vector_type(4)));
typedef float f32x16 __attribute__((ext_vector_type(16)));
typedef unsigned u32x4 __attribute__((ext_vector_type(4)));
__device__ __forceinline__ int crow(int r, int hi) { return (r & 3) + 8 * (r >> 2) + 4 * hi; }
__device__ __forceinline__ unsigned cvtpk(float lo, float hi) { unsigned r; asm("v_cvt_pk_bf16_f32 %0, %1, %2" : "=v"(r) : "v"(lo), "v"(hi)); return r; }
__device__ __forceinline__ float swapmax(float m) { auto rr = __builtin_amdgcn_permlane32_swap(__float_as_uint(m), __float_as_uint(m), false, false); return fmaxf(__uint_as_float(rr[0]), __uint_as_float(rr[1])); }
__device__ __forceinline__ float swapadd(float m) { auto rr = __builtin_amdgcn_permlane32_swap(__float_as_uint(m), __float_as_uint(m), false, false); return __uint_as_float(rr[0]) + __uint_as_float(rr[1]); }
__device__ __forceinline__ s16x4 vtr(const LAS unsigned char* p) { return __builtin_bit_cast(s16x4, __builtin_amdgcn_ds_read_tr16_b64_v4i16((LAS s16x4*)p)); }
__device__ __forceinline__ bf16x8 pack8(const f32x16& p, int b) { u32x4 w; w.x = cvtpk(p[b], p[b + 1]); w.y = cvtpk(p[b + 2], p[b + 3]); w.z = cvtpk(p[b + 4], p[b + 5]); w.w = cvtpk(p[b + 6], p[b + 7]); return __builtin_bit_cast(bf16x8, w); }
__device__ __forceinline__ float max16(const f32x16& p) { float a = fmaxf(fmaxf(p[0], p[1]), fmaxf(p[2], p[3])), b = fmaxf(fmaxf(p[4], p[5]), fmaxf(p[6], p[7])), c = fmaxf(fmaxf(p[8], p[9]), fmaxf(p[10], p[11])), d = fmaxf(fmaxf(p[12], p[13]), fmaxf(p[14], p[15])); return fmaxf(fmaxf(a, b), fmaxf(c, d)); }

struct AttnP {
    const bf16* Q; const bf16* K; const bf16* V; int qp, kp, vp;
    float* O; int op;
    const int* pos; const float* relb; const float* dnorm; const float* dlam; float lam_init;
};
constexpr int AT_KB = 13312, AT_K0 = 0, AT_V0 = 2 * AT_KB, AT_VB = 8192, AT_POS = AT_V0 + 2 * AT_VB, AT_BT = AT_POS + 512, AT_DN = AT_BT + 528, AT_END = AT_DN + 256;

template <bool DIFF>
__device__ __forceinline__ void attn_unit(const AttnP& P, int b, int h, int qb, LAS unsigned char* lds, int tid, int wave, int lane) {
    asm volatile("" : "+v"(tid), "+v"(lane));
    constexpr int HW = DIFF ? 64 : 96;
    constexpr int CPK = HW / 8;
    constexpr int KP = DIFF ? 144 : 208;
    constexpr int NKS = DIFF ? 2 : 6;
    const int r32 = lane & 31, hi = lane >> 5;
    const size_t rowb = (size_t)b * S;
    const int q0w = qb * 256 + wave * 32, qi = q0w + r32;
    int pq = 0; float bias_far = 0.f;
    __syncthreads();
    if (DIFF) {
        pq = P.pos[rowb + qi];
        if (tid < 129) { const int n = tid; int bu; if (n < 16) bu = n; else { const int lg = 16 + (int)(logf((float)n / 16.f) / logf(8.f) * 16.f); bu = lg < 31 ? lg : 31; }
            ((LAS float*)(lds + AT_BT))[tid] = P.relb[bu * 4 + h] * 1.4426950408889634f; }
        if (tid >= 192 && tid < 256) ((LAS float*)(lds + AT_DN))[tid - 192] = P.dnorm[tid - 192];
    }
    int minq = pq;
    if (DIFF) { for (int o = 1; o < 64; o <<= 1) { const int v = __shfl_xor(minq, o); minq = v < minq ? v : minq; } }
    const int NT = 4 * (qb + 1);
    u32x4 kr0, kr1, vr; int pkr = 0;
    const int kc0 = tid, kc1 = tid + 512;
    const bf16* Kb = P.K + rowb * P.kp + h * HW; const bf16* Vb = P.V + rowb * P.vp + h * 64;
    auto gload = [&](int t) {
        const int k0 = 64 * t;
        { const int key = kc0 / CPK, part = kc0 % CPK; kr0 = *(const u32x4*)(Kb + (size_t)(k0 + key) * P.kp + part * 8); }
        if (!DIFF) { if (kc1 < 64 * CPK) { const int key = kc1 / CPK, part = kc1 % CPK; kr1 = *(const u32x4*)(Kb + (size_t)(k0 + key) * P.kp + part * 8); } }
        { const int key = tid >> 3, part = tid & 7; vr = *(const u32x4*)(Vb + (size_t)(k0 + key) * P.vp + part * 8); }
        if (DIFF) { if (tid < 64) pkr = P.pos[rowb + k0 + tid]; }
    };
    auto lstore = [&](int buf) {
        LAS unsigned char* kb_ = lds + AT_K0 + buf * AT_KB; LAS unsigned char* vb_ = lds + AT_V0 + buf * AT_VB;
        { const int key = kc0 / CPK, part = kc0 % CPK; *(LAS u32x4*)(kb_ + key * KP + part * 16) = kr0; }
        if (!DIFF) { if (kc1 < 64 * CPK) { const int key = kc1 / CPK, part = kc1 % CPK; *(LAS u32x4*)(kb_ + key * KP + part * 16) = kr1; } }
        { const int key = tid >> 3, part = tid & 7; *(LAS u32x4*)(vb_ + (part >> 2) * 4096 + (key >> 3) * 512 + (key & 7) * 64 + (part & 3) * 16) = vr; }
        if (DIFF) { if (tid < 64) ((LAS int*)(lds + AT_POS + buf * 256))[tid] = pkr; }
    };
    f32x16 osv[2];
#pragma unroll
    for (int d = 0; d < 2; ++d)
#pragma unroll
        for (int r = 0; r < 16; ++r) osv[d][r] = 0.f;
    float il = 0.f;
    f32x16 oA[2];
#pragma unroll 1
    for (int mp = 0; mp < (DIFF ? 2 : 1); ++mp) {
        bf16x8 qf[NKS];
        { const bf16* qrow = P.Q + (rowb + qi) * P.qp + h * HW + mp * 32;
#pragma unroll
          for (int s = 0; s < NKS; ++s) qf[s] = *(const bf16x8*)(qrow + 16 * s + 8 * hi); }
        __syncthreads();
        gload(0); lstore(0);
        if (NT > 1) gload(1);
        __syncthreads();
        if (DIFF) bias_far = ((LAS float*)(lds + AT_BT))[128];
        float m1 = -1e30f, l1 = 0.f;
#pragma unroll
        for (int d = 0; d < 2; ++d)
#pragma unroll
            for (int r = 0; r < 16; ++r) oA[d][r] = 0.f;
        for (int t = 0; t < NT; ++t) {
            const int buf = t & 1;
            if (t + 1 < NT) { lstore(buf ^ 1); if (t + 2 < NT) gload(t + 2); }
            const int k0 = 64 * t;
            if (k0 <= q0w + 31) {
                const LAS unsigned char* kb_ = lds + AT_K0 + buf * AT_KB + r32 * KP + hi * 16 + mp * 64;
                const LAS unsigned char* vb_ = lds + AT_V0 + buf * AT_VB + ((lane >> 4) & 1) * 32 + (lane & 3) * 8 + (4 * hi + ((lane & 15) >> 2)) * 64;
                const bool partial = (k0 + 63 > q0w);
                bool nearb = false;
                if (DIFF) {
                    int mk_ = ((LAS int*)(lds + AT_POS + buf * 256))[lane];
                    for (int o = 1; o < 64; o <<= 1) { const int v = __shfl_xor(mk_, o); mk_ = v > mk_ ? v : mk_; }
                    nearb = (minq - mk_) < 128;
                }
                const float init = (DIFF && !nearb) ? bias_far : 0.f;
                f32x16 pa, pb;
#pragma unroll
                for (int r = 0; r < 16; ++r) { pa[r] = init; pb[r] = init; }
#pragma unroll
                for (int s = 0; s < NKS; ++s) { const bf16x8 a0 = *(const LAS bf16x8*)(kb_ + s * 32), a1 = *(const LAS bf16x8*)(kb_ + 32 * KP + s * 32);
                    pa = __builtin_amdgcn_mfma_f32_32x32x16_bf16(a0, qf[s], pa, 0, 0, 0); pb = __builtin_amdgcn_mfma_f32_32x32x16_bf16(a1, qf[s], pb, 0, 0, 0); }
                if (DIFF) { if (nearb) {
                    const LAS int* pk = (const LAS int*)(lds + AT_POS + buf * 256); const LAS float* bt = (const LAS float*)(lds + AT_BT);
#pragma unroll
                    for (int r = 0; r < 16; ++r) { const int kk = crow(r, hi);
                        int n0 = pq - pk[kk], n1 = pq - pk[kk + 32]; n0 = n0 < 0 ? 0 : (n0 > 128 ? 128 : n0); n1 = n1 < 0 ? 0 : (n1 > 128 ? 128 : n1);
                        pa[r] += bt[n0]; pb[r] += bt[n1]; }
                } }
                if (partial) {
#pragma unroll
                    for (int r = 0; r < 16; ++r) { const int kk = k0 + crow(r, hi); if (kk > qi) pa[r] = -1e30f; if (kk + 32 > qi) pb[r] = -1e30f; }
                }
                const float mx = swapmax(fmaxf(max16(pa), max16(pb))); const float mn = fmaxf(m1, mx); const float al = __builtin_amdgcn_exp2f(m1 - mn); m1 = mn;
                float ls = 0.f;
#pragma unroll
                for (int r = 0; r < 16; ++r) { pa[r] = __builtin_amdgcn_exp2f(pa[r] - mn); pb[r] = __builtin_amdgcn_exp2f(pb[r] - mn); ls += pa[r] + pb[r]; }
                l1 = l1 * al + ls;
                bf16x8 pf[4];
                pf[0] = pack8(pa, 0); pf[1] = pack8(pa, 8); pf[2] = pack8(pb, 0); pf[3] = pack8(pb, 8);
#pragma unroll
                for (int d = 0; d < 2; ++d) {
#pragma unroll
                    for (int r = 0; r < 16; ++r) oA[d][r] *= al;
#pragma unroll
                    for (int s = 0; s < 4; ++s) { const s16x4 lo = vtr(vb_ + d * 4096 + s * 1024), hh = vtr(vb_ + d * 4096 + s * 1024 + 512);
                        const bf16x8 vf = (bf16x8){lo[0], lo[1], lo[2], lo[3], hh[0], hh[1], hh[2], hh[3]};
                        oA[d] = __builtin_amdgcn_mfma_f32_32x32x16_bf16(vf, pf[s], oA[d], 0, 0, 0); }
                }
            }
            __syncthreads();
        }
        il = 1.f / swapadd(l1);
        if (DIFF) { if (mp == 0) {
#pragma unroll
            for (int d = 0; d < 2; ++d)
#pragma unroll
                for (int r = 0; r < 16; ++r) osv[d][r] = oA[d][r] * il; } }
    }
    float* orow = P.O + (rowb + qi) * P.op + h * 64;
    if (!DIFF) {
#pragma unroll
        for (int d = 0; d < 2; ++d)
#pragma unroll
            for (int g = 0; g < 4; ++g) { f32x4 v = {oA[d][4 * g] * il, oA[d][4 * g + 1] * il, oA[d][4 * g + 2] * il, oA[d][4 * g + 3] * il}; *(f32x4*)(orow + 32 * d + 8 * g + 4 * hi) = v; }
    } else {
        float lam;
        { float a = P.dlam[r32] * P.dlam[32 + r32], c = P.dlam[64 + r32] * P.dlam[96 + r32];
          for (int o = 1; o < 32; o <<= 1) { a += __shfl_xor(a, o); c += __shfl_xor(c, o); }
          lam = expf(a) - expf(c) + P.lam_init; }
        const float i2 = lam * il;
        float ss = 0.f;
#pragma unroll
        for (int d = 0; d < 2; ++d)
#pragma unroll
            for (int r = 0; r < 16; ++r) { const float v = osv[d][r] - oA[d][r] * i2; oA[d][r] = v; ss += v * v; }
        ss = swapadd(ss);
        const float rs = rsqrtf(ss * (1.f / 64.f) + 1e-6f) * (1.f - P.lam_init);
        const LAS float* dn = (const LAS float*)(lds + AT_DN);
#pragma unroll
        for (int d = 0; d < 2; ++d)
#pragma unroll
            for (int g = 0; g < 4; ++g) { const int c = 32 * d + 8 * g + 4 * hi; const f32x4 gn = *(const LAS f32x4*)(dn + c);
                f32x4 v = {oA[d][4 * g] * rs * gn[0], oA[d][4 * g + 1] * rs * gn[1], oA[d][4 * g + 2] * rs * gn[2], oA[d][4 * g + 3] * rs * gn[3]}; *(f32x4*)(orow + c) = v; }
    }
}

__device__ __forceinline__ void attn_phase(const AttnP& PM, const AttnP& PD, LAS unsigned char* lds, int tid, int wave, int lane, int vcu, int G) {
    for (int i = vcu; i < 512; i += G) {
        const int kind = i >> 8, c = i & 255, bh = c >> 4, s = c & 15;
        if (kind == 0) {
#pragma unroll 1
            for (int k = 0; k < 2; ++k) attn_unit<false>(PM, bh >> 2, bh & 3, k ? 31 - s : s, lds, tid, wave, lane);
        } else {
#pragma unroll 1
            for (int k = 0; k < 2; ++k) attn_unit<true>(PD, bh >> 2, bh & 3, k ? 31 - s : s, lds, tid, wave, lane);
        }
    }
}

struct Args { const float* in[33]; float* out; unsigned char* ws; int ph_lo, ph_hi; };
template <class P> __device__ __forceinline__ P* opq(P* p) { asm volatile("" : "+s"(p)); return p; }
struct Frame { LAS unsigned char* lds; volatile LAS unsigned* MISC; gu32* ctl; int tid, lane, wave, G; };

__device__ __forceinline__ void transpose_item(const float* W, int ldw, int nsrc0, bf16* WT, int ldt, int rdst0, LAS float* scr, int kb, int nb, int lane, float scale) {
    const int k0 = 64 * kb, n0 = 32 * nb;
#pragma unroll 8
    for (int i = 0; i < 32; ++i) { const int kk = 2 * i + (lane >> 5); scr[kk * 33 + (lane & 31)] = W[(size_t)(k0 + kk) * ldw + nsrc0 + n0 + (lane & 31)] * scale; }
    LDS_WAIT(); asm volatile("" ::: "memory");
    const int c = lane & 7;
#pragma unroll
    for (int j = 0; j < 4; ++j) { const int n = (lane >> 3) + 8 * j; const LAS float* s = scr + (8 * c) * 33 + n;
        v4u o; o.x = pk2(s[0 * 33], s[1 * 33]); o.y = pk2(s[2 * 33], s[3 * 33]); o.z = pk2(s[4 * 33], s[5 * 33]); o.w = pk2(s[6 * 33], s[7 * 33]);
        *(GAS v4u*)(WT + (size_t)(rdst0 + n0 + n) * ldt + k0 + 8 * c) = o; }
    LDS_WAIT(); asm volatile("" ::: "memory");
}

__device__ __forceinline__ void p0_prologue(Frame& F, const Args& a) {
    LAS float* scr = (LAS float*)(F.lds + RING_OFF + F.wave * 16384);
    const int gw = blockIdx.x * NWAVES + F.wave, NGW = F.G * NWAVES;
    unsigned char* ws = a.ws;
    { const GAS f32x4* src = (const GAS f32x4*)a.in[0]; GAS f32x4* dst = (GAS f32x4*)a.out; const size_t n4 = (size_t)T * D / 4;
      for (size_t i = (size_t)blockIdx.x * (NWAVES * 64) + F.tid; i < n4; i += (size_t)F.G * NWAVES * 64) dst[i] = src[i]; }
    constexpr int I_IN = 16 * (INW / 32), I_SQ = 16 * 32, I_CKV = 16 * 64, I_L = I_IN + 4 * I_SQ + I_CKV;
    for (int it = gw; it < L * I_L; it += NGW) {
        const int l = it / I_L; int r = it % I_L;
        if (r < I_IN) { transpose_item(a.in[5] + (size_t)l * D * INW, INW, 0, (bf16*)(ws + WS_WIN) + (size_t)l * INP * D, D, 0, scr, r / (INW / 32), r % (INW / 32), F.lane, 1.f); continue; } r -= I_IN;
        if (r < I_SQ) { transpose_item(a.in[21] + (size_t)l * D * D, D, 0, (bf16*)(ws + WS_WOUT) + (size_t)l * D * D, D, 0, scr, r / 32, r % 32, F.lane, 1.f); continue; } r -= I_SQ;
        if (r < I_SQ) { transpose_item(a.in[24] + (size_t)l * D * D, D, 0, (bf16*)(ws + WS_WCQ) + (size_t)l * D * D, D, 0, scr, r / 32, r % 32, F.lane, 1.f); continue; } r -= I_SQ;
        if (r < I_SQ) { transpose_item(a.in[26] + (size_t)l * D * D, D, 0, (bf16*)(ws + WS_WCO) + (size_t)l * D * D, D, 0, scr, r / 32, r % 32, F.lane, 1.f); continue; } r -= I_SQ;
        if (r < I_SQ) { transpose_item(a.in[28] + (size_t)l * D * D, D, 0, (bf16*)(ws + WS_WPQ) + (size_t)l * D * D, D, 0, scr, r / 32, r % 32, F.lane, 1.f); continue; } r -= I_SQ;
        transpose_item(a.in[25] + (size_t)l * D * 2 * D, 2 * D, 0, (bf16*)(ws + WS_WCKV) + (size_t)l * 2 * D * D, D, 0, scr, r / 64, r % 64, F.lane, 1.f);
    }
    { constexpr int PADV = (INP - INW) * D / 8;
      for (int i = blockIdx.x * (NWAVES * 64) + F.tid; i < L * PADV; i += F.G * NWAVES * 64) { const int l = i / PADV, r = i % PADV;
          *((GAS v4u*)((bf16*)(ws + WS_WIN) + (size_t)l * INP * D + (size_t)INW * D) + r) = (v4u){0u, 0u, 0u, 0u}; } }
}

constexpr int NPL = 7;
__global__ void __launch_bounds__(NWAVES * 64, 2) fwd(Args args) {
    extern __shared__ __attribute__((aligned(16))) unsigned char lds[];
    Frame F;
    F.lds = (LAS unsigned char*)lds; F.MISC = (volatile LAS unsigned*)(F.lds + MISC_OFF);
    F.tid = threadIdx.x; F.lane = F.tid & 63; F.wave = __builtin_amdgcn_readfirstlane(F.tid >> 6); F.G = gridDim.x;
    unsigned char* ws = args.ws;
    F.ctl = (gu32*)(ws + WS_CTL);
    for (int u = F.tid; u < (LDS_BYTES - LDSCTL_OFF) / 4; u += NWAVES * 64) ((LAS unsigned*)(F.lds + LDSCTL_OFF))[u] = 0u;
    __syncthreads();
    XcdBarrier bar = xcd_barrier_post((unsigned*)(F.ctl + CW_BAR), F.MISC + 8);
    const int lo = args.ph_lo, hi = args.ph_hi;
#define IN(k) (lo <= (k) && (k) < hi)
#define SEAM(k) do { if (IN(k) && IN((k) + 1)) xcd_barrier(bar); } while (0)
    if (IN(0)) { p0_prologue(F, args); }
    SEAM(0);
    for (int l = 0; l < L; ++l) {
        const int pb = 1 + NPL * l;
        const bf16* XNB = (const bf16*)(ws + WS_XNB); const bf16* YB = (const bf16*)(ws + WS_YB);
        if (IN(pb + 0)) {
            pg8::Gemm g{opq(XNB), opq((const bf16*)(ws + WS_WIN) + (size_t)l * INP * D), T, INP, D, D, D}; pg8::StaticOrder So; So.init(T, INP, F.G, (int)blockIdx.x);
            pg8::EpiF32 E{opq((float*)(ws + WS_PROJ)), INW, INW, 0};
            pg8::gemm_phase<pg8::EpiF32, pg8::StaticOrder, true, true>(F.lds + RING_OFF, g, So, E);
        }
        SEAM(pb + 0);
        if (IN(pb + 1)) {
            pg8::Gemm g{opq(YB), opq((const bf16*)(ws + WS_WOUT) + (size_t)l * D * D), T, D, D, D, D}; pg8::StaticOrder So; So.init(T, D, F.G, (int)blockIdx.x);
            pg8::EpiF32 E{opq(args.out), D, D, 1};
            pg8::gemm_phase<pg8::EpiF32, pg8::StaticOrder, true, true>(F.lds + RING_OFF, g, So, E);
        }
        SEAM(pb + 1);
        if (IN(pb + 2)) {
            pg8::Gemm g{opq((const bf16*)(ws + WS_MNB)), opq((const bf16*)(ws + WS_WCKV) + (size_t)l * 2 * D * D), NB * MEM, 2 * D, D, D, D}; pg8::StaticOrder So; So.init(NB * MEM, 2 * D, F.G, (int)blockIdx.x);
            pg8::EpiF32 E{opq((float*)(ws + WS_KVC)), 2 * D, 2 * D, 0};
            pg8::gemm_phase<pg8::EpiF32, pg8::StaticOrder, true, true>(F.lds + RING_OFF, g, So, E);
        }
        SEAM(pb + 2);
        if (IN(pb + 3)) {
            pg8::Gemm g{opq(XNB), opq((const bf16*)(ws + WS_WCQ) + (size_t)l * D * D), T, D, D, D, D}; pg8::StaticOrder So; So.init(T, D, F.G, (int)blockIdx.x);
            pg8::EpiF32 E{opq((float*)(ws + WS_PROJ)), D, D, 0};
            pg8::gemm_phase<pg8::EpiF32, pg8::StaticOrder, true, true>(F.lds + RING_OFF, g, So, E);
        }
        SEAM(pb + 3);
        if (IN(pb + 4)) {
            pg8::Gemm g{opq(YB), opq((const bf16*)(ws + WS_WCO) + (size_t)l * D * D), T, D, D, D, D}; pg8::StaticOrder So; So.init(T, D, F.G, (int)blockIdx.x);
            pg8::EpiF32 E{opq(args.out), D, D, 1};
            pg8::gemm_phase<pg8::EpiF32, pg8::StaticOrder, true, true>(F.lds + RING_OFF, g, So, E);
        }
        SEAM(pb + 4);
        if (IN(pb + 5)) {
            pg8::Gemm g{opq(XNB), opq((const bf16*)(ws + WS_WPQ) + (size_t)l * D * D), T, D, D, D, D}; pg8::StaticOrder So; So.init(T, D, F.G, (int)blockIdx.x);
            pg8::EpiF32 E{opq((float*)(ws + WS_PROJ)), D, D, 0};
            pg8::gemm_phase<pg8::EpiF32, pg8::StaticOrder, true, true>(F.lds + RING_OFF, g, So, E);
        }
        SEAM(pb + 5);
        if (IN(pb + 6)) {
            const int vcu = (F.G % 8 == 0) ? ((int)blockIdx.x % 8) * (F.G / 8) + (int)blockIdx.x / 8 : (int)blockIdx.x;
            const float lam_init = 0.8f - 0.6f * expf(-0.3f * (float)l);
            bf16* AB = (bf16*)(ws + WS_ATB);
            AttnP PM{opq(AB), opq(AB + (size_t)T * 384), opq(AB + (size_t)T * 768), 384, 384, 256, opq((float*)(ws + WS_OMD)), 256, nullptr, nullptr, nullptr, nullptr, 0.f};
            AttnP PD{opq(AB + (size_t)T * 1024), opq(AB + (size_t)T * 1280), opq(AB + (size_t)T * 1536), 256, 256, 256, opq((float*)(ws + WS_OMD) + (size_t)T * 256), 256,
                     (const int*)args.in[2], args.in[3], args.in[18] + l * 64, args.in[17] + l * 128, lam_init};
            attn_phase(PM, PD, F.lds, F.tid, F.wave, F.lane, vcu, F.G);
        }
        SEAM(pb + 6);
    }
#undef IN
#undef SEAM
}
}
namespace {
void gemm(hipStream_t st, const float* A, long lda, const float* Bm, long sbk, long sbn, float* C, long ldc, int M, int N, int K, float alpha, int acc,
          int batch = 1, int nh = 1, long aB = 0, long aH = 0, long bB = 0, long bH = 0, long cB = 0, long cH = 0) {
    GemmP p{}; p.A = A; p.Bm = Bm; p.C = C; p.lda = lda; p.sbk = sbk; p.sbn = sbn; p.ldc = ldc; p.M = M; p.N = N; p.K = K; p.nh = nh;
    p.aB = aB; p.aH = aH; p.bB = bB; p.bH = bH; p.cB = cB; p.cH = cH; p.alpha = alpha; p.acc = acc;
    hipLaunchKernelGGL(k_gemm, dim3((N + 127) / 128, M / 128, batch), dim3(256), 0, st, p);
}
}

extern "C" void kernel_launch(void* const* d_in, const int* in_sizes, int n_in, void* d_out, int out_size, void* d_ws, size_t ws_size, hipStream_t stream) {
    (void)in_sizes; (void)out_size;
    static int grid = 0;
    if (grid == 0) {
        int dev = 0, cus = 0, per_cu = 0;
        if (n_in != 33 || ws_size < mk::WS_END) { fprintf(stderr, "kernel_launch: unexpected n_in %d / ws_size %zu\n", n_in, ws_size); grid = -1; return; }
        if (hipGetDevice(&dev) != hipSuccess || hipDeviceGetAttribute(&cus, hipDeviceAttributeMultiprocessorCount, dev) != hipSuccess) { grid = -1; return; }
        if (hipFuncSetAttribute((const void*)mk::fwd, hipFuncAttributeMaxDynamicSharedMemorySize, mk::LDS_BYTES) != hipSuccess) { fprintf(stderr, "kernel_launch: hipFuncSetAttribute failed\n"); grid = -1; return; }
        if (hipOccupancyMaxActiveBlocksPerMultiprocessor(&per_cu, (const void*)mk::fwd, mk::NWAVES * 64, mk::LDS_BYTES) != hipSuccess || per_cu < 1) fprintf(stderr, "kernel_launch: occupancy query says %d\n", per_cu);
        (void)hipGetLastError();
        grid = cus;
    }
    if (grid < 0) return;
    const float* mem = (const float*)d_in[1]; const int* pos = (const int*)d_in[2];
    const float* norm_mix = (const float*)d_in[4]; const float* q_norm = (const float*)d_in[6]; const float* w_uq = (const float*)d_in[7];
    const float* kv_norm = (const float*)d_in[8]; const float* w_ukv = (const float*)d_in[9]; const float* conv_w = (const float*)d_in[10]; const float* conv_b = (const float*)d_in[11];
    const float* w_a = (const float*)d_in[12]; const float* b_a = (const float*)d_in[13]; const float* w_x = (const float*)d_in[14]; const float* b_x = (const float*)d_in[15];
    const float* lru_lam = (const float*)d_in[16];
    const float* onm = (const float*)d_in[19]; const float* onl = (const float*)d_in[20];
    const float* norm_cross = (const float*)d_in[22]; const float* norm_mem = (const float*)d_in[23];
    const float* norm_ffn = (const float*)d_in[27]; const float* peer_keys = (const float*)d_in[29];
    const float* peer_u = (const float*)d_in[30]; const float* peer_v = (const float*)d_in[31]; const float* norm_final = (const float*)d_in[32];
    float* X = (float*)d_out;
    unsigned char* ws = (unsigned char*)d_ws;
    bf16_t* XNB = (bf16_t*)(ws + mk::WS_XNB); bf16_t* YB = (bf16_t*)(ws + mk::WS_YB); bf16_t* MNB = (bf16_t*)(ws + mk::WS_MNB);
    float* PROJ = (float*)(ws + mk::WS_PROJ);
    float* QM = (float*)(ws + mk::WS_QKV); float* KM = QM + (size_t)T * 384; float* VM = KM + (size_t)T * 384;
    float* LA = (float*)(ws + mk::WS_LAU); float* LU = LA + (size_t)T * 512;
    float* OM = (float*)(ws + mk::WS_OMD); float* OD = OM + (size_t)T * 256;
    float* KVC = (float*)(ws + mk::WS_KVC); int* EX = (int*)(ws + mk::WS_EXG); float* GW = (float*)(ws + mk::WS_EXG) + (size_t)T * 128;
    float* QC = PROJ; float* SC = QM; float* OCF = LA; float* QP = PROJ;

    hipMemsetAsync(ws + mk::WS_CTL, 0, mk::CTL_ZERO_BYTES, stream);
    mk::Args a{};
    for (int i = 0; i < 33; ++i) a.in[i] = (const float*)d_in[i];
    a.out = X; a.ws = ws;
    auto run = [&](int lo, int hi) { a.ph_lo = lo; a.ph_hi = hi; hipLaunchKernelGGL(mk::fwd, dim3(grid), dim3(mk::NWAVES * 64), mk::LDS_BYTES, stream, a); };
    run(0, 1);
    for (int l = 0; l < L; ++l) {
        const int pb = 1 + mk::NPL * l;
        hipLaunchKernelGGL(k_rmsnorm, dim3(T), dim3(256), 0, stream, X, norm_mix + l * D, (float*)nullptr, XNB, D);
        run(pb + 0, pb + 1);
        hipLaunchKernelGGL(k_mla_pre, dim3(T), dim3(128), 0, stream, PROJ, pos, q_norm + l * 192, w_uq + (size_t)l * 192 * 384, kv_norm + l * 128, w_ukv + (size_t)l * 128 * 512, QM, KM, VM);
        hipLaunchKernelGGL(k_lru_pre, dim3(T), dim3(512), 0, stream, PROJ, conv_w + l * 4 * 512, conv_b + l * 512, w_a + (size_t)l * 8 * 64 * 64, b_a + l * 512, w_x + (size_t)l * 8 * 64 * 64, b_x + l * 512, lru_lam + l * 512, LA, LU);
        hipLaunchKernelGGL(k_lru_scan, dim3(NB * 512 / 64), dim3(64), 0, stream, PROJ, LA, LU);
        {
            bf16_t* AB = (bf16_t*)(ws + mk::WS_ATB);
            auto cvt = [&](const float* src, long sld, bf16_t* dst, long dld, int ncols, float scale) {
                hipLaunchKernelGGL(k_cvt, dim3((unsigned)(((size_t)T * ncols + 255) / 256)), dim3(256), 0, stream, src, sld, dst, dld, ncols, (long)T, scale); };
            const float LOG2E = 1.4426950408889634f;
            cvt(QM, 384, AB, 384, 384, 0.10206207261596575f * LOG2E); cvt(KM, 384, AB + (size_t)T * 384, 384, 384, 1.f); cvt(VM, 256, AB + (size_t)T * 768, 256, 256, 1.f);
            cvt(PROJ + C_QD, INW, AB + (size_t)T * 1024, 256, 256, 0.17677669529663687f * LOG2E); cvt(PROJ + C_KD, INW, AB + (size_t)T * 1280, 256, 256, 1.f); cvt(PROJ + C_VD, INW, AB + (size_t)T * 1536, 256, 256, 1.f);
            run(pb + 6, pb + 7);
        }
        hipLaunchKernelGGL(k_post, dim3(T), dim3(256), 0, stream, OM, LU, OD, onm + l * 256, onl + l * 512, YB);
        run(pb + 1, pb + 2);
        hipLaunchKernelGGL(k_rmsnorm, dim3(T), dim3(256), 0, stream, X, norm_cross + l * D, (float*)nullptr, XNB, D);
        hipLaunchKernelGGL(k_rmsnorm, dim3(NB * MEM), dim3(256), 0, stream, mem, norm_mem + l * D, (float*)nullptr, MNB, D);
        run(pb + 2, pb + 3);
        run(pb + 3, pb + 4);
        gemm(stream, QC, D, KVC, 1, 2 * D, SC, 256, S, 256, 256, 1.f / 16.f, 0, NB * 4, 4, (long)S * D, 256, (long)MEM * 2 * D, 256, (long)4 * S * 256, (long)S * 256);
        hipLaunchKernelGGL(k_softmax256, dim3(T * 4 / 4), dim3(256), 0, stream, SC, (long)T * 4);
        gemm(stream, SC, 256, KVC + D, 2 * D, 1, OCF, D, S, 256, 256, 1.f, 0, NB * 4, 4, (long)4 * S * 256, (long)S * 256, (long)MEM * 2 * D, 256, (long)S * D, 256);
        hipLaunchKernelGGL(k_f2bf, dim3((unsigned)(((size_t)T * D + 255) / 256)), dim3(256), 0, stream, OCF, YB, (long)T * D);
        run(pb + 4, pb + 5);
        hipLaunchKernelGGL(k_rmsnorm, dim3(T), dim3(256), 0, stream, X, norm_ffn + l * D, (float*)nullptr, XNB, D);
        run(pb + 5, pb + 6);
        hipLaunchKernelGGL(k_route, dim3(T), dim3(256), 0, stream, QP, peer_keys + (size_t)l * 2 * 128 * 64, EX, GW);
        hipLaunchKernelGGL(k_peer, dim3(T), dim3(256), 0, stream, XNB, EX, GW, peer_u + (size_t)l * NEXP * D, peer_v + (size_t)l * NEXP * D, X);
    }
    hipLaunchKernelGGL(k_rmsnorm, dim3(T), dim3(256), 0, stream, X, norm_final, X, (bf16_t*)nullptr, D);
}
```

```cpp
#include <hip/hip_runtime.h>
#include <cstdint>
#include <cstdio>
#include <cmath>

namespace {
constexpr int D = 1024, NB = 4, S = 8192, T = NB * S, L = 4, MEM = 256;
constexpr int INW = 2144;
constexpr int C_CQ = 0, C_CKV = 192, C_KR = 320, C_XL = 352, C_GL = 864, C_QD = 1376, C_KD = 1632, C_VD = 1888;
constexpr float EPS = 1e-6f;
constexpr int NEXP = 16384;

typedef unsigned short bf16_t;
__device__ __forceinline__ unsigned f2bf(float f) { unsigned u = __builtin_bit_cast(unsigned, f); return (u + 0x7fffu + ((u >> 16) & 1u)) >> 16; }
__device__ __forceinline__ float bf2f(unsigned short b) { return __builtin_bit_cast(float, (unsigned)b << 16); }
__global__ void k_cvt(const float* __restrict__ src, long sld, bf16_t* __restrict__ dst, long dld, int ncols, long rows, float scale) {
    const long i = (long)blockIdx.x * blockDim.x + threadIdx.x;
    if (i < rows * ncols) { const long r = i / ncols; const int c = (int)(i % ncols); dst[r * dld + c] = (bf16_t)f2bf(src[r * sld + c] * scale); }
}
__global__ void k_bf2f(const bf16_t* __restrict__ a, float* __restrict__ o, long n) {
    long i = (long)blockIdx.x * blockDim.x + threadIdx.x;
    if (i < n) o[i] = bf2f(a[i]);
}
__global__ void k_f2bf(const float* __restrict__ a, bf16_t* __restrict__ o, long n) {
    long i = (long)blockIdx.x * blockDim.x + threadIdx.x;
    if (i < n) o[i] = (bf16_t)f2bf(a[i]);
}
__global__ void k_copy4(const float4* __restrict__ a, float4* __restrict__ o, long n4) {
    long i = (long)blockIdx.x * blockDim.x + threadIdx.x;
    if (i < n4) o[i] = a[i];
}

__global__ __launch_bounds__(256) void k_rmsnorm(const float* in, const float* __restrict__ g, float* out, bf16_t* outb, int Dn) {
    __shared__ float red[4];
    const long row = blockIdx.x;
    const float* x = in + row * Dn;
    float s = 0.f;
    for (int i = threadIdx.x; i < Dn; i += 256) { float v = x[i]; s += v * v; }
    for (int o = 32; o > 0; o >>= 1) s += __shfl_xor(s, o);
    if ((threadIdx.x & 63) == 0) red[threadIdx.x >> 6] = s;
    __syncthreads();
    s = red[0] + red[1] + red[2] + red[3];
    const float rs = rsqrtf(s / (float)Dn + EPS);
    for (int i = threadIdx.x; i < Dn; i += 256) { const float v = x[i] * rs * g[i]; if (out) out[row * Dn + i] = v; if (outb) outb[row * Dn + i] = (bf16_t)f2bf(v); }
}

struct GemmP { const float* A; const float* Bm; float* C; long lda, sbk, sbn, ldc; int M, N, K, nh; long aB, aH, bB, bH, cB, cH; float alpha; int acc; };
__global__ __launch_bounds__(256) void k_gemm(GemmP p) {
    __shared__ float As[16][128 + 4];
    __shared__ float Bs[16][128 + 4];
    const int tid = threadIdx.x, tx = tid & 15, ty = tid >> 4;
    const int zb = blockIdx.z / p.nh, zh = blockIdx.z % p.nh;
    const float* A = p.A + zb * p.aB + zh * p.aH + (long)blockIdx.y * 128 * p.lda;
    const float* Bm = p.Bm + zb * p.bB + zh * p.bH;
    float* C = p.C + zb * p.cB + zh * p.cH + (long)blockIdx.y * 128 * p.ldc;
    const int n0 = blockIdx.x * 128;
    float acc[8][8];
#pragma unroll
    for (int i = 0; i < 8; ++i)
#pragma unroll
        for (int j = 0; j < 8; ++j) acc[i][j] = 0.f;
    for (int k0 = 0; k0 < p.K; k0 += 16) {
#pragma unroll
        for (int r = 0; r < 2; ++r) {
            const int idx = tid + r * 256;
            const int m = idx >> 2, kq = (idx & 3) * 4;
            const float4 v = *(const float4*)(A + (long)m * p.lda + k0 + kq);
            As[kq + 0][m] = v.x; As[kq + 1][m] = v.y; As[kq + 2][m] = v.z; As[kq + 3][m] = v.w;
        }
#pragma unroll
        for (int r = 0; r < 8; ++r) {
            const int idx = tid + r * 256;
            int kk, nn;
            if (p.sbn == 1) { kk = idx >> 7; nn = idx & 127; } else { kk = idx & 15; nn = idx >> 4; }
            const int n = n0 + nn;
            Bs[kk][nn] = (n < p.N) ? Bm[(long)(k0 + kk) * p.sbk + (long)n * p.sbn] : 0.f;
        }
        __syncthreads();
#pragma unroll
        for (int kk = 0; kk < 16; ++kk) {
            float a[8], b[8];
#pragma unroll
            for (int i = 0; i < 4; ++i) { a[i] = As[kk][ty * 4 + i]; a[4 + i] = As[kk][64 + ty * 4 + i]; b[i] = Bs[kk][tx * 4 + i]; b[4 + i] = Bs[kk][64 + tx * 4 + i]; }
#pragma unroll
            for (int i = 0; i < 8; ++i)
#pragma unroll
                for (int j = 0; j < 8; ++j) acc[i][j] += a[i] * b[j];
        }
        __syncthreads();
    }
#pragma unroll
    for (int i = 0; i < 8; ++i) {
        const int m = (i < 4) ? ty * 4 + i : 64 + ty * 4 + (i - 4);
#pragma unroll
        for (int j = 0; j < 8; ++j) {
            const int n = n0 + ((j < 4) ? tx * 4 + j : 64 + tx * 4 + (j - 4));
            if (n < p.N) { float* c = C + (long)m * p.ldc + n; const float v = p.alpha * acc[i][j]; *c = p.acc ? (*c + v) : v; }
        }
    }
}

__global__ __launch_bounds__(128) void k_mla_pre(const float* __restrict__ proj, const int* __restrict__ pos, const float* __restrict__ qn, const float* __restrict__ wuq,
                                                  const float* __restrict__ kvn, const float* __restrict__ wukv, float* __restrict__ QM, float* __restrict__ KM, float* __restrict__ VM) {
    __shared__ float cq[192], ckv[128], qs[384], kvs[512], kr[32], red[2];
    const long t = blockIdx.x; const int tid = threadIdx.x;
    const float* pr = proj + t * INW;
    float s = 0.f;
    for (int i = tid; i < 192; i += 128) { float v = pr[C_CQ + i]; s += v * v; }
    for (int o = 32; o > 0; o >>= 1) s += __shfl_xor(s, o);
    if ((tid & 63) == 0) red[tid >> 6] = s;
    __syncthreads();
    float rs = rsqrtf((red[0] + red[1]) / 192.f + EPS);
    for (int i = tid; i < 192; i += 128) cq[i] = pr[C_CQ + i] * rs * qn[i];
    __syncthreads();
    s = 0.f;
    { float v = pr[C_CKV + tid]; s = v * v; }
    for (int o = 32; o > 0; o >>= 1) s += __shfl_xor(s, o);
    if ((tid & 63) == 0) red[tid >> 6] = s;
    __syncthreads();
    rs = rsqrtf((red[0] + red[1]) / 128.f + EPS);
    ckv[tid] = pr[C_CKV + tid] * rs * kvn[tid];
    if (tid < 32) kr[tid] = pr[C_KR + tid];
    __syncthreads();
    for (int j = tid; j < 384; j += 128) { float a = 0.f; for (int k = 0; k < 192; ++k) a += cq[k] * wuq[k * 384 + j]; qs[j] = a; }
    for (int j = tid; j < 512; j += 128) { float a = 0.f; for (int k = 0; k < 128; ++k) a += ckv[k] * wukv[k * 512 + j]; kvs[j] = a; }
    __syncthreads();
    const float fp = (float)pos[t];
    for (int idx = tid; idx < 4 * 96; idx += 128) {
        const int h = idx / 96, j = idx % 96;
        float qv, kv;
        if (j < 64) { qv = qs[h * 96 + j]; kv = kvs[h * 128 + j]; }
        else {
            const int r = j - 64, i = r & 15;
            const float inv = powf(10000.f, -(float)(2 * i) / 32.f);
            const float ang = fp * inv; const float c = cosf(ang), sn = sinf(ang);
            const float q1 = qs[h * 96 + 64 + i], q2 = qs[h * 96 + 80 + i], k1 = kr[i], k2 = kr[16 + i];
            if (r < 16) { qv = q1 * c - q2 * sn; kv = k1 * c - k2 * sn; } else { qv = q1 * sn + q2 * c; kv = k1 * sn + k2 * c; }
        }
        QM[(t * 4 + h) * 96 + j] = qv; KM[(t * 4 + h) * 96 + j] = kv;
    }
    for (int idx = tid; idx < 256; idx += 128) { const int h = idx >> 6, j = idx & 63; VM[(t * 4 + h) * 64 + j] = kvs[h * 128 + 64 + j]; }
}

__global__ __launch_bounds__(512) void k_lru_pre(const float* __restrict__ proj, const float* __restrict__ cw, const float* __restrict__ cb, const float* __restrict__ wa, const float* __restrict__ ba,
                                                  const float* __restrict__ wx, const float* __restrict__ bx, const float* __restrict__ lam, float* __restrict__ LA, float* __restrict__ LU) {
    __shared__ float xc[512];
    const long t = blockIdx.x; const int c = threadIdx.x; const int s = (int)(t % S);
    float y = cb[c];
#pragma unroll
    for (int k = 0; k < 4; ++k) { const int ts = s - 3 + k; if (ts >= 0) y += proj[(t - 3 + k) * INW + C_XL + c] * cw[k * 512 + c]; }
    xc[c] = y;
    __syncthreads();
    const int g = c >> 6, j = c & 63;
    float ra = ba[c], ri = bx[c];
    for (int i = 0; i < 64; ++i) { const float xv = xc[g * 64 + i]; ra += xv * wa[(g * 64 + i) * 64 + j]; ri += xv * wx[(g * 64 + i) * 64 + j]; }
    const float r = 1.f / (1.f + expf(-ra)), ig = 1.f / (1.f + expf(-ri));
    const float sp = log1pf(expf(-lam[c]));
    const float log_a = -8.0f * r * sp;
    const float a = expf(log_a);
    const float u = sqrtf(-expm1f(2.f * log_a)) * (ig * y);
    LA[t * 512 + c] = a; LU[t * 512 + c] = u;
}
__global__ __launch_bounds__(64) void k_lru_scan(const float* __restrict__ proj, const float* __restrict__ LA, float* __restrict__ LU) {
    const int id = blockIdx.x * 64 + threadIdx.x; const int b = id >> 9, c = id & 511;
    float h = 0.f;
    for (int s = 0; s < S; ++s) {
        const long t = (long)b * S + s;
        h = LA[t * 512 + c] * h + LU[t * 512 + c];
        const float gt = proj[t * INW + C_GL + c];
        LU[t * 512 + c] = h * (0.5f * gt * (1.f + erff(gt * 0.70710678118654752f)));
    }
}

__global__ __launch_bounds__(256) void k_attn_mla(const float* __restrict__ QM, const float* __restrict__ KM, const float* __restrict__ VM, float* __restrict__ OM) {
    __shared__ float Ks[64 * 96]; __shared__ float Vs[64 * 64];
    const int qb = blockIdx.x, h = blockIdx.y, b = blockIdx.z, tid = threadIdx.x;
    const int q = qb * 256 + tid; const long t = (long)b * S + q;
    const float scale = 0.10206207261596575f;
    float qr[96];
#pragma unroll
    for (int j = 0; j < 96; ++j) qr[j] = QM[(t * 4 + h) * 96 + j] * scale;
    float m = -1e30f, l = 0.f, o[64];
#pragma unroll
    for (int j = 0; j < 64; ++j) o[j] = 0.f;
    const int kend = (qb + 1) * 256;
    for (int k0 = 0; k0 < kend; k0 += 64) {
        __syncthreads();
        for (int i = tid; i < 64 * 96; i += 256) { const int kk = i / 96, j = i % 96; Ks[i] = KM[(((long)b * S + k0 + kk) * 4 + h) * 96 + j]; }
        for (int i = tid; i < 64 * 64; i += 256) { const int kk = i >> 6, j = i & 63; Vs[i] = VM[(((long)b * S + k0 + kk) * 4 + h) * 64 + j]; }
        __syncthreads();
        for (int kk = 0; kk < 64; ++kk) {
            if (k0 + kk <= q) {
                float s = 0.f;
#pragma unroll
                for (int j = 0; j < 96; ++j) s += qr[j] * Ks[kk * 96 + j];
                if (s > m) { const float corr = expf(m - s); l *= corr;
#pragma unroll
                    for (int j = 0; j < 64; ++j) o[j] *= corr;
                    m = s; }
                const float p = expf(s - m); l += p;
#pragma unroll
                for (int j = 0; j < 64; ++j) o[j] += p * Vs[kk * 64 + j];
            }
        }
    }
    const float il = 1.f / l;
#pragma unroll
    for (int j = 0; j < 64; ++j) OM[t * 256 + h * 64 + j] = o[j] * il;
}

__global__ __launch_bounds__(256) void k_attn_diff(const float* __restrict__ proj, const int* __restrict__ pos, const float* __restrict__ relb, const float* __restrict__ dnorm,
                                                   const float* __restrict__ dl, float lam_init, float* __restrict__ OD) {
    __shared__ float Ks[64 * 64]; __shared__ float Vs[64 * 64]; __shared__ int ps[64]; __shared__ float btab[129];
    const int qb = blockIdx.x, h = blockIdx.y, b = blockIdx.z, tid = threadIdx.x;
    const int q = qb * 256 + tid; const long t = (long)b * S + q;
    if (tid < 129) {
        const int n = tid; int bu;
        if (n < 16) bu = n; else { int lg = 16 + (int)(logf((float)n / 16.f) / logf(8.f) * 16.f); bu = lg < 31 ? lg : 31; }
        btab[tid] = relb[bu * 4 + h];
    }
    const float scale = 0.17677669529663687f;
    float lam;
    { float a = 0.f, c = 0.f; for (int j = 0; j < 32; ++j) { a += dl[j] * dl[32 + j]; c += dl[64 + j] * dl[96 + j]; } lam = expf(a) - expf(c) + lam_init; }
    float q1[32], q2[32];
#pragma unroll
    for (int j = 0; j < 32; ++j) { q1[j] = proj[t * INW + C_QD + h * 64 + j] * scale; q2[j] = proj[t * INW + C_QD + h * 64 + 32 + j] * scale; }
    const int pq = pos[t];
    float m1 = -1e30f, l1 = 0.f, m2 = -1e30f, l2 = 0.f, o1[64], o2[64];
#pragma unroll
    for (int j = 0; j < 64; ++j) { o1[j] = 0.f; o2[j] = 0.f; }
    const int kend = (qb + 1) * 256;
    for (int k0 = 0; k0 < kend; k0 += 64) {
        __syncthreads();
        for (int i = tid; i < 64 * 64; i += 256) { const int kk = i >> 6, j = i & 63; const long tk = (long)b * S + k0 + kk; Ks[i] = proj[tk * INW + C_KD + h * 64 + j]; Vs[i] = proj[tk * INW + C_VD + h * 64 + j]; }
        if (tid < 64) ps[tid] = pos[(long)b * S + k0 + tid];
        __syncthreads();
        for (int kk = 0; kk < 64; ++kk) {
            if (k0 + kk <= q) {
                int n = pq - ps[kk]; n = n < 0 ? 0 : (n > 128 ? 128 : n);
                const float bias = btab[n];
                float s1 = bias, s2 = bias;
#pragma unroll
                for (int j = 0; j < 32; ++j) { s1 += q1[j] * Ks[kk * 64 + j]; s2 += q2[j] * Ks[kk * 64 + 32 + j]; }
                if (s1 > m1) { const float corr = expf(m1 - s1); l1 *= corr;
#pragma unroll
                    for (int j = 0; j < 64; ++j) o1[j] *= corr;
                    m1 = s1; }
                if (s2 > m2) { const float corr = expf(m2 - s2); l2 *= corr;
#pragma unroll
                    for (int j = 0; j < 64; ++j) o2[j] *= corr;
                    m2 = s2; }
                const float p1 = expf(s1 - m1), p2 = expf(s2 - m2); l1 += p1; l2 += p2;
#pragma unroll
                for (int j = 0; j < 64; ++j) { const float v = Vs[kk * 64 + j]; o1[j] += p1 * v; o2[j] += p2 * v; }
            }
        }
    }
    const float i1 = 1.f / l1, i2 = lam / l2;
    float ss = 0.f;
#pragma unroll
    for (int j = 0; j < 64; ++j) { o1[j] = o1[j] * i1 - o2[j] * i2; ss += o1[j] * o1[j]; }
    const float rs = rsqrtf(ss / 64.f + EPS) * (1.f - lam_init);
#pragma unroll
    for (int j = 0; j < 64; ++j) OD[t * 256 + h * 64 + j] = o1[j] * rs * dnorm[j];
}

__global__ __launch_bounds__(256) void k_post(const float* __restrict__ OM, const float* __restrict__ H, const float* __restrict__ OD, const float* __restrict__ gm, const float* __restrict__ gl, bf16_t* __restrict__ Y) {
    __shared__ float red[8];
    const long t = blockIdx.x; const int tid = threadIdx.x;
    const float a = OM[t * 256 + tid], h0 = H[t * 512 + tid], h1 = H[t * 512 + 256 + tid];
    float s1 = a * a, s2 = h0 * h0 + h1 * h1;
    for (int o = 32; o > 0; o >>= 1) { s1 += __shfl_xor(s1, o); s2 += __shfl_xor(s2, o); }
    if ((tid & 63) == 0) { red[tid >> 6] = s1; red[4 + (tid >> 6)] = s2; }
    __syncthreads();
    const float r1 = rsqrtf((red[0] + red[1] + red[2] + red[3]) / 256.f + EPS), r2 = rsqrtf((red[4] + red[5] + red[6] + red[7]) / 512.f + EPS);
    Y[t * 1024 + tid] = (bf16_t)f2bf(a * r1 * gm[tid]);
    Y[t * 1024 + 256 + tid] = (bf16_t)f2bf(h0 * r2 * gl[tid]);
    Y[t * 1024 + 512 + tid] = (bf16_t)f2bf(h1 * r2 * gl[256 + tid]);
    Y[t * 1024 + 768 + tid] = (bf16_t)f2bf(OD[t * 256 + tid]);
}

__global__ __launch_bounds__(256) void k_softmax256(float* __restrict__ Sm, long rows) {
    const long row = (long)blockIdx.x * 4 + (threadIdx.x >> 6); const int lane = threadIdx.x & 63;
    if (row >= rows) return;
    float* r = Sm + row * 256;
    float v[4]; float m = -1e30f;
#pragma unroll
    for (int i = 0; i < 4; ++i) { v[i] = r[lane + 64 * i]; m = fmaxf(m, v[i]); }
    for (int o = 32; o > 0; o >>= 1) m = fmaxf(m, __shfl_xor(m, o));
    float s = 0.f;
#pragma unroll
    for (int i = 0; i < 4; ++i) { v[i] = expf(v[i] - m); s += v[i]; }
    for (int o = 32; o > 0; o >>= 1) s += __shfl_xor(s, o);
    const float is = 1.f / s;
#pragma unroll
    for (int i = 0; i < 4; ++i) r[lane + 64 * i] = v[i] * is;
}

__global__ __launch_bounds__(256) void k_route(const float* __restrict__ QP, const float* __restrict__ keys, int* __restrict__ EX, float* __restrict__ GW) {
    __shared__ float q[1024]; __shared__ float sc[16][128]; __shared__ float ts[16][16]; __shared__ int ti[16][16]; __shared__ float cand[8][256];
    const long t = blockIdx.x; const int tid = threadIdx.x;
    for (int i = tid; i < 1024; i += 256) q[i] = QP[t * 1024 + i];
    __syncthreads();
    for (int i = tid; i < 2048; i += 256) {
        const int li = i >> 7, n = i & 127, c = li & 1;
        const float* kp = keys + ((long)c * 128 + n) * 64; const float* qp = q + li * 64;
        float a = 0.f;
        for (int d = 0; d < 64; ++d) a += qp[d] * kp[d];
        sc[li][n] = a;
    }
    __syncthreads();
    if (tid < 16) {
        for (int r = 0; r < 16; ++r) {
            float best = -3.0e38f; int bi = 0;
            for (int n = 0; n < 128; ++n) { const float v = sc[tid][n]; if (v > best) { best = v; bi = n; } }
            ts[tid][r] = best; ti[tid][r] = bi; sc[tid][bi] = -3.0e38f;
        }
    }
    __syncthreads();
    for (int i = tid; i < 2048; i += 256) { const int h = i >> 8, ab = i & 255; cand[h][ab] = ts[h * 2][ab >> 4] + ts[h * 2 + 1][ab & 15]; }
    __syncthreads();
    if (tid < 8) {
        float bs[16]; int be[16];
        float mx = -3.0e38f;
#pragma unroll
        for (int r = 0; r < 16; ++r) {
            float best = -3.0e38f; int bi = 0;
            for (int n = 0; n < 256; ++n) { const float v = cand[tid][n]; if (v > best) { best = v; bi = n; } }
            cand[tid][bi] = -3.0e38f;
            bs[r] = best; be[r] = ti[tid * 2][bi >> 4] * 128 + ti[tid * 2 + 1][bi & 15];
            mx = fmaxf(mx, best);
        }
        float sum = 0.f;
#pragma unroll
        for (int r = 0; r < 16; ++r) { bs[r] = expf(bs[r] - mx); sum += bs[r]; }
        const float is = 1.f / sum;
#pragma unroll
        for (int r = 0; r < 16; ++r) { EX[t * 128 + tid * 16 + r] = be[r]; GW[t * 128 + tid * 16 + r] = bs[r] * is; }
    }
}

__global__ __launch_bounds__(256) void k_peer(const bf16_t* __restrict__ XN, const int* __restrict__ EX, const float* __restrict__ GW, const float* __restrict__ U, const float* __restrict__ V, float* __restrict__ X) {
    __shared__ float hs[1024]; __shared__ float w[128]; __shared__ int es[128];
    const long t = blockIdx.x; const int tid = threadIdx.x, wave = tid >> 6, lane = tid & 63;
    for (int i = tid; i < 1024; i += 256) hs[i] = bf2f(XN[t * 1024 + i]);
    if (tid < 128) es[tid] = EX[t * 128 + tid];
    __syncthreads();
    for (int j = wave; j < 128; j += 4) {
        const float* up = U + (long)es[j] * 1024;
        float a = 0.f;
        for (int i = lane; i < 1024; i += 64) a += hs[i] * up[i];
        for (int o = 32; o > 0; o >>= 1) a += __shfl_xor(a, o);
        if (lane == 0) w[j] = GW[t * 128 + j] * (0.5f * a * (1.f + erff(a * 0.70710678118654752f)));
    }
    __syncthreads();
    float o[4] = {0.f, 0.f, 0.f, 0.f};
    for (int j = 0; j < 128; ++j) {
        const float* vp = V + (long)es[j] * 1024; const float wj = w[j];
#pragma unroll
        for (int i = 0; i < 4; ++i) o[i] += wj * vp[tid + 256 * i];
    }
#pragma unroll
    for (int i = 0; i < 4; ++i) X[t * 1024 + tid + 256 * i] += o[i];
}

}

namespace pg8 {
#define PG8_LAS __attribute__((address_space(3)))
typedef unsigned short bf16_t;
typedef short bf16x8 __attribute__((ext_vector_type(8)));
typedef float f32x4 __attribute__((ext_vector_type(4)));
typedef unsigned u32x4 __attribute__((ext_vector_type(4)));
typedef unsigned u32x2 __attribute__((ext_vector_type(2)));
constexpr int BM = 256, BK = 64, HALF = 128, HTB = HALF * BK * 2, STAGE_BYTES = 8 * HTB, NXCD = 8, WGM = 8;
__host__ __device__ __forceinline__ int lds_byte(int r, int c) { const int st = (r >> 4) * 2 + (c >> 5), rr = r & 15, cc = c & 31, ob = rr * 64 + cc * 2; return st * 1024 + (ob ^ (((ob >> 9) & 1) << 5)); }
__host__ __device__ __forceinline__ void stage_rc(int b, int& R, int& C) { const int st = b / 1024, sb = b % 1024, swz = sb ^ (((sb >> 9) & 1) << 5); R = (st >> 1) * 16 + swz / 64; C = (st & 1) * 32 + (swz % 64) / 2; }
__host__ __device__ __forceinline__ int perm32(int rho) { const int n = rho >> 4, i = rho & 15; return 8 * (i >> 2) + 4 * n + (i & 3); }
struct Unit { int pm, pn; };
struct Gemm { const bf16_t* A; const bf16_t* Bt; int M, N, K, lda, ldb; };
struct StaticOrder {
    int nM, nN, nwg, G, c;
    __host__ __device__ void init(int M, int N, int G_, int c_) { nM = M / BM; nN = N / BM; nwg = nM * nN; G = G_; c = c_; }
    __host__ __device__ bool next(int i, Unit& u) const {
        const long L = (long)i * G + c; if (L >= nwg) return false;
        int wgid = (int)L; { const int q = nwg / NXCD, r = nwg % NXCD, xcd = wgid % NXCD, off = wgid / NXCD; wgid = (xcd < r ? xcd * (q + 1) : r * (q + 1) + (xcd - r) * q) + off; }
        const int nig = WGM * nN, gid = wgid / nig, fm = gid * WGM, gsz = (nM - fm) < WGM ? (nM - fm) : WGM;
        u.pm = fm + ((wgid % nig) % gsz); u.pn = (wgid % nig) / gsz; return true;
    }
    __device__ __forceinline__ void a_ready(const Unit&) const {}
    __device__ __forceinline__ void done(const Unit&) const {}
};
__device__ __forceinline__ unsigned cvt_pk_bf16(float lo, float hi) { unsigned r; asm volatile("v_cvt_pk_bf16_f32 %0, %1, %2" : "=v"(r) : "v"(lo), "v"(hi)); return r; }

struct EpiF32 {
    static constexpr bool PERM = false, AFTER_DRAIN = false;
    float* C; int ldc; int nvalid; int accum;
    __device__ __forceinline__ void operator()(const f32x4 (&acc)[2][2][4][2], const Unit& u, int wr, int wc, int fr, int fq) const {
        asm volatile("" : "+v"(fr), "+v"(fq));
#pragma unroll
        for (int ai = 0; ai < 2; ++ai)
#pragma unroll
            for (int m = 0; m < 4; ++m) { const size_t row = (size_t)u.pm * BM + ai * HALF + wr * 64 + m * 16 + fr;
#pragma unroll
                for (int bj = 0; bj < 2; ++bj)
#pragma unroll
                    for (int n = 0; n < 2; ++n) { const int col = u.pn * BM + bj * HALF + wc * 32 + n * 16 + 4 * fq;
                        if (col < nvalid) { float* p = C + row * ldc + col; f32x4 v = acc[ai][bj][m][n]; if (accum) v += *(const f32x4*)p; *(f32x4*)p = v; } } }
    }
};
struct EpiBf16 {
    static constexpr bool PERM = true, AFTER_DRAIN = false;
    bf16_t* O; int ldc; int nvalid;
    __device__ __forceinline__ void operator()(const f32x4 (&acc)[2][2][4][2], const Unit& u, int wr, int wc, int fr, int fq) const {
        asm volatile("" : "+v"(fr), "+v"(fq));
#pragma unroll
        for (int ai = 0; ai < 2; ++ai)
#pragma unroll
            for (int m = 0; m < 4; ++m) { const size_t row = (size_t)u.pm * BM + ai * HALF + wr * 64 + m * 16 + fr;
#pragma unroll
                for (int bj = 0; bj < 2; ++bj) { const int col = u.pn * BM + bj * HALF + wc * 32 + 8 * fq;
                    if (col < nvalid) { const f32x4 v0 = acc[ai][bj][m][0], v1 = acc[ai][bj][m][1]; u32x4 w; w.x = cvt_pk_bf16(v0[0], v0[1]); w.y = cvt_pk_bf16(v0[2], v0[3]); w.z = cvt_pk_bf16(v1[0], v1[1]); w.w = cvt_pk_bf16(v1[2], v1[3]);
                        *(u32x4*)(O + row * ldc + col) = w; } } }
    }
};
struct EpiUp {
    static constexpr bool PERM = true, AFTER_DRAIN = false;
    bf16_t* O; bf16_t* O2; int ldc; int nvalid; const float* rs; int rsi; int mode;
    __device__ __forceinline__ void operator()(const f32x4 (&acc)[2][2][4][2], const Unit& u, int wr, int wc, int fr, int fq) const {
        asm volatile("" : "+v"(fr), "+v"(fq));
#pragma unroll
        for (int ai = 0; ai < 2; ++ai)
#pragma unroll
            for (int m = 0; m < 4; ++m) { const size_t row = (size_t)u.pm * BM + ai * HALF + wr * 64 + m * 16 + fr; const float s = rs[2 * row + rsi];
#pragma unroll
                for (int bj = 0; bj < 2; ++bj) { const int col = u.pn * BM + bj * HALF + wc * 32 + 8 * fq;
                    if (col < nvalid) { const f32x4 v0 = acc[ai][bj][m][0] * s, v1 = acc[ai][bj][m][1] * s; u32x4 w; w.x = cvt_pk_bf16(v0[0], v0[1]); w.y = cvt_pk_bf16(v0[2], v0[3]); w.z = cvt_pk_bf16(v1[0], v1[1]); w.w = cvt_pk_bf16(v1[2], v1[3]);
                        bf16_t* dst;
                        if (mode == 0) dst = O + row * ldc + col;
                        else { const int h = col >> 7, j = col & 127; dst = (j < 64) ? O + row * 384 + h * 96 + j : O2 + row * 256 + h * 64 + (j - 64); }
                        *(u32x4*)dst = w; } } }
    }
};
template <class Epi, class Sched, bool ALIGN_EPI = false, bool SP2 = false>
__device__ __forceinline__ void gemm_phase(PG8_LAS unsigned char* lds, const Gemm g, const Sched& S, const Epi& E, int wave_id) {
    int tid_ = (wave_id << 6) | (int)__builtin_amdgcn_mbcnt_hi(~0u, __builtin_amdgcn_mbcnt_lo(~0u, 0u)); asm volatile("" : "+v"(tid_));
    const int tid = tid_, wid = __builtin_amdgcn_readfirstlane(tid >> 6), lane = tid & 63, wr = wid >> 2, wc = wid & 3, fr = lane & 15, fq = lane >> 4;
    const int K = g.K, nt = K / BK;
    unsigned voffA[2], voffB[2];
#pragma unroll
    for (int i = 0; i < 2; ++i) { int R, C; stage_rc(tid * 16 + i * 8192, R, C); const int Rb = Epi::PERM ? ((R & ~31) + perm32(R & 31)) : R;
        voffA[i] = (unsigned)(R * g.lda + C) * 2u; voffB[i] = (unsigned)(Rb * g.ldb + C) * 2u; }
    const size_t kstep = (size_t)(BK * 2);
    const size_t hstepA = (size_t)HALF * g.lda * 2, hstepB = (size_t)HALF * g.ldb * 2;
    const size_t tstepA = 2 * hstepA, tstepB = 2 * hstepB;
    const unsigned ldsw = (unsigned)wid * 1024u;
    const int aoff = lds_byte(wr * 64 + fr, fq * 8), boff = lds_byte(wc * 32 + fr, fq * 8);
#define PG8_SA(b, h) (((b) * 2 + (h)) * HTB)
#define PG8_SB(b, h) ((4 + (b) * 2 + (h)) * HTB)
#define PG8_STAGE(bufoff, gbase, voff) do { _Pragma("unroll") for (int _i = 0; _i < 2; ++_i) \
        __builtin_amdgcn_global_load_lds((const unsigned*)((const char*)(gbase) + (voff)[_i]), (PG8_LAS unsigned*)(lds + (bufoff) + ldsw + _i * 8192), 16, 0, 0); } while (0)
#define PG8_LDA(dst, b, h) do { _Pragma("unroll") for (int m = 0; m < 4; ++m) _Pragma("unroll") for (int k = 0; k < 2; ++k) dst[m][k] = *(const PG8_LAS bf16x8*)(lds + PG8_SA(b, h) + aoff + m * 2048 + k * 1024); } while (0)
#define PG8_LDB(dst, b, h) do { _Pragma("unroll") for (int n = 0; n < 2; ++n) _Pragma("unroll") for (int k = 0; k < 2; ++k) dst[n][k] = *(const PG8_LAS bf16x8*)(lds + PG8_SB(b, h) + boff + n * 2048 + k * 1024); } while (0)
#define PG8_MMA(ai, bj, At, Bt) do { __builtin_amdgcn_s_setprio(1); _Pragma("unroll") for (int m = 0; m < 4; ++m) _Pragma("unroll") for (int n = 0; n < 2; ++n) _Pragma("unroll") for (int k = 0; k < 2; ++k) \
        acc[ai][bj][m][n] = __builtin_amdgcn_mfma_f32_16x16x32_bf16(Bt[n][k], At[m][k], acc[ai][bj][m][n], 0, 0, 0); __builtin_amdgcn_s_setprio(0); } while (0)
#define PG8_WAIT_V(n) asm volatile("s_waitcnt vmcnt(" #n ")" ::: "memory")
#define PG8_WAIT_L(n) asm volatile("s_waitcnt lgkmcnt(" #n ")" ::: "memory")
#define PG8_BAR __builtin_amdgcn_s_barrier()
#define PG8_SCHED __builtin_amdgcn_sched_barrier(0)
    Unit cur, nxt; int ui = 0;
    if (!S.next(0, cur)) return;
    f32x4 acc[2][2][4][2];
#pragma unroll
    for (int a = 0; a < 2; ++a)
#pragma unroll
        for (int b = 0; b < 2; ++b)
#pragma unroll
            for (int m = 0; m < 4; ++m)
#pragma unroll
                for (int n = 0; n < 2; ++n) acc[a][b][m][n] = (f32x4){0.f, 0.f, 0.f, 0.f};
    bf16x8 At[4][2], B0[2][2], B1[2][2];
    const char* cA = (const char*)g.A + (size_t)cur.pm * tstepA; const char* cB = (const char*)g.Bt + (size_t)cur.pn * tstepB;
    S.a_ready(cur);
    if constexpr (SP2) {
        PG8_STAGE(PG8_SB(0, 0), cB, voffB); PG8_STAGE(PG8_SB(0, 1), cB + hstepB, voffB); PG8_STAGE(PG8_SA(0, 0), cA, voffA); PG8_STAGE(PG8_SA(0, 1), cA + hstepA, voffA);
        if (wr == 1) PG8_BAR;
        PG8_WAIT_V(2); PG8_BAR;
        PG8_STAGE(PG8_SB(1, 0), cB + kstep, voffB); PG8_STAGE(PG8_SA(1, 0), cA + kstep, voffA); PG8_STAGE(PG8_SB(1, 1), cB + hstepB + kstep, voffB);
        PG8_WAIT_V(6); PG8_BAR;
    } else {
        PG8_STAGE(PG8_SB(0, 0), cB, voffB); PG8_STAGE(PG8_SA(0, 0), cA, voffA); PG8_STAGE(PG8_SB(0, 1), cB + hstepB, voffB); PG8_STAGE(PG8_SA(0, 1), cA + hstepA, voffA);
        if (wr == 1) PG8_BAR;
        PG8_WAIT_V(4); PG8_BAR;
        PG8_STAGE(PG8_SB(1, 0), cB + kstep, voffB); PG8_STAGE(PG8_SA(1, 0), cA + kstep, voffA); PG8_STAGE(PG8_SB(1, 1), cB + hstepB + kstep, voffB);
        PG8_WAIT_V(6); PG8_BAR;
    }
    for (;;) {
        const bool has_next = S.next(ui + 1, nxt);
        const char* nA = has_next ? (const char*)g.A + (size_t)nxt.pm * tstepA : cA; const char* nB = has_next ? (const char*)g.Bt + (size_t)nxt.pn * tstepB : cB;
        for (int t = 0; t < nt; t += 2) {
            const bool last = (t == nt - 2);
            const char* a1 = cA + (size_t)(t + 1) * kstep;
            const char* a2 = last ? nA : cA + (size_t)(t + 2) * kstep; const char* b2 = last ? nB : cB + (size_t)(t + 2) * kstep;
            const char* a3 = a2 + kstep; const char* b3 = b2 + kstep;
            if (last && has_next) S.a_ready(nxt);
            if constexpr (SP2) {
            PG8_LDB(B0, 0, 0); PG8_LDB(B1, 0, 1); PG8_SCHED; PG8_LDA(At, 0, 0); PG8_STAGE(PG8_SA(1, 1), a1 + hstepA, voffA);
            PG8_WAIT_V(8); PG8_WAIT_L(0); PG8_BAR; PG8_MMA(0, 0, At, B0); PG8_MMA(0, 1, At, B1); PG8_BAR; PG8_SCHED;
            PG8_LDA(At, 0, 1); PG8_STAGE(PG8_SB(0, 0), b2, voffB); PG8_STAGE(PG8_SB(0, 1), b2 + hstepB, voffB); PG8_STAGE(PG8_SA(0, 0), a2, voffA);
            PG8_WAIT_V(8); PG8_WAIT_L(0); PG8_BAR; PG8_MMA(1, 0, At, B0); PG8_MMA(1, 1, At, B1); PG8_BAR; PG8_SCHED;
            PG8_LDB(B0, 1, 0); PG8_LDB(B1, 1, 1); PG8_SCHED; PG8_LDA(At, 1, 0); PG8_STAGE(PG8_SA(0, 1), a2 + hstepA, voffA);
            PG8_WAIT_V(8); PG8_WAIT_L(0); PG8_BAR; PG8_MMA(0, 0, At, B0); PG8_MMA(0, 1, At, B1); PG8_BAR; PG8_SCHED;
            PG8_LDA(At, 1, 1); PG8_STAGE(PG8_SB(1, 0), b3, voffB); PG8_STAGE(PG8_SB(1, 1), b3 + hstepB, voffB); PG8_STAGE(PG8_SA(1, 0), a3, voffA);
            PG8_WAIT_V(8); PG8_WAIT_L(0); PG8_BAR; PG8_MMA(1, 0, At, B0); PG8_MMA(1, 1, At, B1); PG8_BAR; PG8_SCHED;
            } else {
            PG8_LDB(B0, 0, 0); PG8_SCHED; PG8_LDA(At, 0, 0); PG8_STAGE(PG8_SA(1, 1), a1 + hstepA, voffA);
            PG8_WAIT_L(8); PG8_BAR; PG8_WAIT_L(0); PG8_MMA(0, 0, At, B0); PG8_BAR; PG8_SCHED;
            PG8_LDB(B1, 0, 1); PG8_STAGE(PG8_SB(0, 0), b2, voffB);
            PG8_BAR; PG8_WAIT_L(0); PG8_MMA(0, 1, At, B1); PG8_BAR;
            PG8_LDA(At, 0, 1); PG8_STAGE(PG8_SA(0, 0), a2, voffA);
            PG8_BAR; PG8_WAIT_L(0); PG8_MMA(1, 0, At, B0); PG8_BAR; PG8_SCHED;
            PG8_STAGE(PG8_SB(0, 1), b2 + hstepB, voffB);
            PG8_WAIT_V(6); PG8_BAR; PG8_MMA(1, 1, At, B1); PG8_BAR;
            PG8_LDB(B0, 1, 0); PG8_SCHED; PG8_LDA(At, 1, 0); PG8_STAGE(PG8_SA(0, 1), a2 + hstepA, voffA);
            PG8_WAIT_L(8); PG8_BAR; PG8_WAIT_L(0); PG8_MMA(0, 0, At, B0); PG8_BAR; PG8_SCHED;
            PG8_LDB(B1, 1, 1); PG8_STAGE(PG8_SB(1, 0), b3, voffB);
            PG8_BAR; PG8_WAIT_L(0); PG8_MMA(0, 1, At, B1); PG8_BAR;
            PG8_LDA(At, 1, 1); PG8_STAGE(PG8_SA(1, 0), a3, voffA);
            PG8_BAR; PG8_WAIT_L(0); PG8_MMA(1, 0, At, B0); PG8_BAR; PG8_SCHED;
            PG8_STAGE(PG8_SB(1, 1), b3 + hstepB, voffB);
            PG8_WAIT_V(6); PG8_BAR; PG8_MMA(1, 1, At, B1); PG8_BAR;
            }
        }
        if constexpr (ALIGN_EPI) { if (wr == 0) PG8_BAR; }
        if constexpr (!Epi::AFTER_DRAIN) { E(acc, cur, wr, wc, fr, fq); S.done(cur); }
        if (!has_next) break;
#pragma unroll
        for (int a = 0; a < 2; ++a)
#pragma unroll
            for (int b = 0; b < 2; ++b)
#pragma unroll
                for (int m = 0; m < 4; ++m)
#pragma unroll
                    for (int n = 0; n < 2; ++n) acc[a][b][m][n] = (f32x4){0.f, 0.f, 0.f, 0.f};
        cur = nxt; cA = nA; cB = nB; ++ui;
        if constexpr (ALIGN_EPI) { if (wr == 1) PG8_BAR; }
    }
    PG8_WAIT_V(0);
    if constexpr (!ALIGN_EPI) { if (wr == 0) PG8_BAR; }
    PG8_BAR;
    if constexpr (Epi::AFTER_DRAIN) { E.fused(acc, cur, wr, wc, fr, fq, lds, wid, lane); S.done(cur); }
#undef PG8_SA
#undef PG8_SB
#undef PG8_STAGE
#undef PG8_LDA
#undef PG8_LDB
#undef PG8_MMA
#undef PG8_WAIT_V
#undef PG8_WAIT_L
#undef PG8_BAR
#undef PG8_SCHED
}
}

namespace mk {
#define GAS __attribute__((address_space(1)))
#define LAS __attribute__((address_space(3)))
typedef unsigned short bf16;
typedef unsigned v4u __attribute__((ext_vector_type(4)));
typedef unsigned v2u __attribute__((ext_vector_type(2)));
typedef float f32x4 __attribute__((ext_vector_type(4)));
typedef GAS unsigned gu32;
#define LDS_WAIT() asm volatile("s_waitcnt lgkmcnt(0)" ::: "memory")
#define VM_WAIT() asm volatile("s_waitcnt vmcnt(0)" ::: "memory")
__device__ __forceinline__ unsigned f2bf_(float f) { unsigned u = __builtin_bit_cast(unsigned, f); return (u + 0x7fffu + ((u >> 16) & 1u)) >> 16; }
__device__ __forceinline__ unsigned pk2(float lo, float hi) { return f2bf_(lo) | (f2bf_(hi) << 16); }
__device__ __forceinline__ float bflo(unsigned w) { return __builtin_bit_cast(float, w << 16); }
__device__ __forceinline__ float bfhi(unsigned w) { return __builtin_bit_cast(float, w & 0xffff0000u); }

template <class P> __device__ __forceinline__ P* opq(P* p) { asm volatile("" : "+s"(p)); return p; }
__device__ __forceinline__ int opqi(int k) { asm volatile("" : "+s"(k)); return k; }
__device__ __forceinline__ float shx(float v, int o, int lane) { return __builtin_bit_cast(float, __builtin_amdgcn_ds_bpermute((lane ^ o) << 2, __builtin_bit_cast(int, v))); }
__device__ __forceinline__ int shxi(int v, int o, int lane) { return __builtin_amdgcn_ds_bpermute((lane ^ o) << 2, v); }
constexpr int NWAVES = 8;
constexpr int D = 1024, NB = 4, S = 8192, T = NB * S, L = 4, MEM = 256, INW = 2144, INP = 2304;
constexpr int PC_CQ = 0, PC_CKV = 256, PC_KR = 384, PC_XL = 512, PC_GL = 1024, PC_QD = 1536, PC_KD = 1792, PC_VD = 2048;
constexpr float LOG2E = 1.4426950408889634f;
constexpr size_t MiB = 1u << 20;
constexpr size_t WS_CTL = 0, CTL_ZERO_BYTES = 1 * MiB;
constexpr size_t WS_WIN = 1 * MiB, WS_WOUT = 19 * MiB, WS_WCQ = 27 * MiB, WS_WCO = 35 * MiB, WS_WPQ = 43 * MiB, WS_WCKV = 51 * MiB, WS_WUQ = 67 * MiB, WS_WUKV = 68 * MiB, WS_KEYS = 69 * MiB, WS_ROPE = 70 * MiB;
constexpr size_t WS_XNB = 76 * MiB, WS_YB = 140 * MiB, WS_PROJB = 204 * MiB, WS_QMB = 348 * MiB, WS_KMB = 372 * MiB, WS_VMB = 396 * MiB, WS_RS = 412 * MiB;
constexpr size_t WS_HLB = 413 * MiB, WS_ACB = 445 * MiB, WS_LSUM = 477 * MiB, WS_OMB = 478 * MiB, WS_MNB = 494 * MiB, WS_KVCB = 502 * MiB, WS_EX = 518 * MiB, WS_GW = 534 * MiB;
constexpr size_t WS_U16 = 550 * MiB, WS_V16 = 678 * MiB;
constexpr size_t WS_TQ = 550 * MiB, WS_TSC = 678 * MiB, WS_TOC = 806 * MiB, WS_TKVC = 934 * MiB, WS_END = 942 * MiB;
constexpr size_t WS_BTAB = WS_KEYS + 512 * 1024, WS_LAMS = WS_BTAB + 4096, WS_SP = WS_LAMS + 4096;
constexpr int CW_BAR = 4096;
constexpr int RING_OFF = 0, RING_BYTES = 131072, LDSCTL_OFF = RING_BYTES, MISC_OFF = LDSCTL_OFF + 320, LDS_BYTES = 147456;

#define XB_TMO      128
#define XB_XCNT(j)  (256  + 64 * (j))
#define XB_XSUB(j)  (1280 + 64 * (j))
#define XB_XGEN(j)  (2304 + 64 * (j))
#define XB_TOP      3328
#define XB_TOPGEN   3392
#define XCD_BAR_WORDS 3456
#define XB_SPIN_CAP (1u << 18)

__device__ __forceinline__ unsigned xb_ld(unsigned* p)              { return __hip_atomic_load(p, __ATOMIC_RELAXED, __HIP_MEMORY_SCOPE_AGENT); }
__device__ __forceinline__ unsigned xb_add(unsigned* p, unsigned v) { return __hip_atomic_fetch_add(p, v, __ATOMIC_RELAXED, __HIP_MEMORY_SCOPE_AGENT); }
__device__ __forceinline__ unsigned xb_xcc_id() { return (unsigned)__builtin_amdgcn_s_getreg((3 << 11) | 20) & 0xFu; }
#define XB_SPIN(cond, bar) do { unsigned _sp = 0; while (cond) { __builtin_amdgcn_s_sleep(1); \
    if ((++_sp & 255u) == 0u) { if (xb_ld(&(bar)[XB_TMO])) break; if (_sp > XB_SPIN_CAP) { atomicAdd(&(bar)[XB_TMO], 1u); break; } } } } while (0)

struct XcdBarrier {
    unsigned* bar; unsigned x;
    volatile LAS unsigned* st;
};

__device__ __forceinline__ XcdBarrier xcd_barrier_post(unsigned* bar, volatile LAS unsigned* st) {
    XcdBarrier b; b.bar = bar; b.x = xb_xcc_id(); b.st = st;
    if (threadIdx.x == 0) (void)xb_add(&bar[XB_XCNT(b.x)], 1u);
    return b;
}
__device__ __forceinline__ void xcd_barrier_complete(unsigned* bar, unsigned x, unsigned& nloc, unsigned& nx) {
    const unsigned G = gridDim.x * gridDim.y * gridDim.z;
    unsigned sum, cnt, mine, sp = 0u;
    for (;;) {
        sum = 0u; cnt = 0u; mine = 0u;
#pragma unroll
        for (unsigned j = 0; j < 16; ++j) { const unsigned c = xb_ld(&bar[XB_XCNT(j)]); sum += c; cnt += (c > 0u) ? 1u : 0u; mine = (j == x) ? c : mine; }
        if (sum == G) break;
        __builtin_amdgcn_s_sleep(1);
        if ((++sp & 255u) == 0u) { if (xb_ld(&bar[XB_TMO])) break; if (sp > XB_SPIN_CAP) { atomicAdd(&bar[XB_TMO], 1u); break; } }
    }
    nloc = mine > 0u ? mine : 1u; nx = cnt > 0u ? cnt : 1u;
}

__device__ __noinline__ void xcd_barrier_impl(unsigned* bar_, unsigned x_, volatile LAS unsigned* st_, int leader_) {
    XcdBarrier b; b.bar = bar_; b.x = x_; b.st = st_;
    asm volatile("s_waitcnt vmcnt(0)" ::: "memory");
    __syncthreads();
    if (leader_) {
        unsigned* bar = b.bar;
        __builtin_amdgcn_s_waitcnt(0);
        unsigned nloc = b.st[0], nx = b.st[1];
        if (nloc == 0u) { xcd_barrier_complete(bar, b.x, nloc, nx); b.st[0] = nloc; b.st[1] = nx; }
        const unsigned old = xb_add(&bar[XB_XSUB(b.x)], 1u);
        const unsigned gen = old / nloc;
        if (old + 1u == (gen + 1u) * nloc) {
            __builtin_amdgcn_fence(__ATOMIC_RELEASE, "agent");
            asm volatile("s_waitcnt vmcnt(0)" ::: "memory");
            const unsigned og = xb_add(&bar[XB_TOP], 1u);
            const unsigned tg = og / nx;
            if (og + 1u == (tg + 1u) * nx) xb_add(&bar[XB_TOPGEN], 1u);
            else XB_SPIN(xb_ld(&bar[XB_TOPGEN]) == tg, bar);
            __builtin_amdgcn_fence(__ATOMIC_ACQUIRE, "agent");
            xb_add(&bar[XB_XGEN(b.x)], 1u);
            asm volatile("s_waitcnt vmcnt(0)" ::: "memory");
        } else {
            XB_SPIN(xb_ld(&bar[XB_XGEN(b.x)]) == gen, bar);
            __builtin_amdgcn_fence(__ATOMIC_ACQUIRE, "agent");
            asm volatile("s_waitcnt vmcnt(0)" ::: "memory");
        }
    }
    __syncthreads();
}
__device__ __forceinline__ void xcd_barrier(const XcdBarrier& b, int leader) { xcd_barrier_impl(b.bar, b.x, b.st, leader); }


__device__ __forceinline__ float wave_sum(float v, int lane) {
#pragma unroll
    for (int o = 1; o < 64; o <<= 1) v += shx(v, o, lane);
    return v;
}
__device__ __forceinline__ float gelu_erf(float v) {
    const float av = __builtin_fabsf(v), t = __builtin_amdgcn_rcpf(av * 0.2316418882f + 1.0f);
    float q = t * 0.5307027145f + (-0.7265760135f); q = q * t + 0.7107068705f; q = q * t + (-0.142248368f); q = q * t + 0.127414796f; q = q * t;
    const float e = __builtin_amdgcn_exp2f((v * v) * (-0.72134752044f));
    const float m = v * (q * e);
    return v < 0.f ? m : v - m;
}

__device__ __forceinline__ void norm_phase(const float* X, const float* g, bf16* out, int rows, int gw, int NGW, int lane) {
    asm volatile("" : "+v"(lane));
    f32x4 gv[4];
#pragma unroll
    for (int j = 0; j < 4; ++j) gv[j] = ((const GAS f32x4*)g)[lane + 64 * j];
    for (int m = gw; m < rows; m += NGW) {
        const GAS f32x4* xr = (const GAS f32x4*)(X + (size_t)m * D) + lane;
        f32x4 v[4]; float s = 0.f;
#pragma unroll
        for (int j = 0; j < 4; ++j) { v[j] = xr[64 * j]; s += (v[j].x * v[j].x + v[j].y * v[j].y) + (v[j].z * v[j].z + v[j].w * v[j].w); }
        const float rs = rsqrtf(wave_sum(s, lane) * (1.f / D) + 1e-6f);
        GAS v2u* o8 = (GAS v2u*)(out + (size_t)m * D) + lane;
#pragma unroll
        for (int j = 0; j < 4; ++j) { v2u w; w.x = pk2(v[j].x * rs * gv[j].x, v[j].y * rs * gv[j].y); w.y = pk2(v[j].z * rs * gv[j].z, v[j].w * rs * gv[j].w); o8[64 * j] = w; }
    }
}
__device__ __forceinline__ void final_norm_phase(float* X, const float* g, int rows, int gw, int NGW, int lane) {
    asm volatile("" : "+v"(lane));
    for (int m = gw; m < rows; m += NGW) {
        GAS f32x4* xr = (GAS f32x4*)(X + (size_t)m * D) + lane;
        f32x4 v[4]; float s = 0.f;
#pragma unroll
        for (int j = 0; j < 4; ++j) { v[j] = xr[64 * j]; s += (v[j].x * v[j].x + v[j].y * v[j].y) + (v[j].z * v[j].z + v[j].w * v[j].w); }
        const float rs = rsqrtf(wave_sum(s, lane) * (1.f / D) + 1e-6f);
#pragma unroll
        for (int j = 0; j < 4; ++j) { const f32x4 gj = ((const GAS f32x4*)g)[lane + 64 * j]; xr[64 * j] = v[j] * rs * gj; }
    }
}

__device__ __forceinline__ void pre_phase(const bf16* PROJB, const float* ROPE, float* RS, bf16* KMB, int gw, int NGW, int lane) {
    asm volatile("" : "+v"(lane));
    for (int t = gw; t < T; t += NGW) {
        const bf16* pr = PROJB + (size_t)t * INP;
        float sq = 0.f, skv = 0.f;
        if (lane < 24) { const v4u w = *(const GAS v4u*)(pr + PC_CQ + 8 * lane);
            const float a0 = bflo(w.x), a1 = bfhi(w.x), a2 = bflo(w.y), a3 = bfhi(w.y), a4 = bflo(w.z), a5 = bfhi(w.z), a6 = bflo(w.w), a7 = bfhi(w.w);
            sq = (a0 * a0 + a1 * a1) + (a2 * a2 + a3 * a3) + (a4 * a4 + a5 * a5) + (a6 * a6 + a7 * a7); }
        else if (lane >= 32 && lane < 48) { const v4u w = *(const GAS v4u*)(pr + PC_CKV + 8 * (lane - 32));
            const float a0 = bflo(w.x), a1 = bfhi(w.x), a2 = bflo(w.y), a3 = bfhi(w.y), a4 = bflo(w.z), a5 = bfhi(w.z), a6 = bflo(w.w), a7 = bfhi(w.w);
            skv = (a0 * a0 + a1 * a1) + (a2 * a2 + a3 * a3) + (a4 * a4 + a5 * a5) + (a6 * a6 + a7 * a7); }
        sq = wave_sum(sq, lane); skv = wave_sum(skv, lane);
        if (lane == 0) { RS[2 * (size_t)t] = rsqrtf(sq * (1.f / 192.f) + 1e-6f); RS[2 * (size_t)t + 1] = rsqrtf(skv * (1.f / 128.f) + 1e-6f); }
        if (lane < 16) {
            const float x1 = __builtin_bit_cast(float, (unsigned)pr[PC_KR + lane] << 16), x2 = __builtin_bit_cast(float, (unsigned)pr[PC_KR + 16 + lane] << 16);
            const float c = ROPE[(size_t)t * 32 + lane], sn = ROPE[(size_t)t * 32 + 16 + lane];
            const bf16 y1 = (bf16)f2bf_(x1 * c - x2 * sn), y2 = (bf16)f2bf_(x1 * sn + x2 * c);
            bf16* kr = KMB + (size_t)t * 384 + 64 + lane;
#pragma unroll
            for (int h = 0; h < 4; ++h) { kr[h * 96] = y1; kr[h * 96 + 16] = y2; }
        }
    }
}

struct LruP { const bf16* PROJB; const float* cw; const float* cb; const float* wa; const float* ba; const float* wx; const float* bx; const float* sp; bf16* HL; bf16* AC; float* LSUM; };
constexpr int LR_XP = 260;
constexpr int LR_XC = 0, LR_WA = 64 * LR_XP * 4, LR_WX = LR_WA + 16384, LR_SUM = LR_WX + 16384, LR_END = LR_SUM + 4096;
__device__ __forceinline__ void lru_phase(const LruP& P, LAS unsigned char* lds, int tid, int wave, int lane, int vcu, int G) {
    asm volatile("" : "+v"(tid), "+v"(lane));
    LAS float* xc = (LAS float*)(lds + LR_XC); LAS float* WA = (LAS float*)(lds + LR_WA); LAS float* WX = (LAS float*)(lds + LR_WX); LAS float* SUM = (LAS float*)(lds + LR_SUM);
    for (int u = vcu; u < (T / 256) * 8; u += G) {
        const int tile = u >> 3, g = u & 7; const int t0 = tile * 256; const bool first = ((tile & 31) == 0);
        __syncthreads();
#pragma unroll
        for (int i = 0; i < 2; ++i) { const int idx = tid + 512 * i; ((LAS f32x4*)WA)[idx] = ((const GAS f32x4*)(P.wa + g * 4096))[idx]; ((LAS f32x4*)WX)[idx] = ((const GAS f32x4*)(P.wx + g * 4096))[idx]; }
#pragma unroll 1
        for (int it = tid; it < 2048; it += 512) {
            const int time = it & 255, cg = it >> 8; const int ch0 = 64 * g + 8 * cg;
            float y[8];
            { const f32x4 b0 = *(const GAS f32x4*)(P.cb + ch0), b1 = *(const GAS f32x4*)(P.cb + ch0 + 4); y[0] = b0.x; y[1] = b0.y; y[2] = b0.z; y[3] = b0.w; y[4] = b1.x; y[5] = b1.y; y[6] = b1.z; y[7] = b1.w; }
#pragma unroll
            for (int k = 0; k < 4; ++k) {
                if (!(first && time - 3 + k < 0)) {
                    const v4u w = *(const GAS v4u*)(P.PROJB + (size_t)(t0 + time - 3 + k) * INP + PC_XL + ch0);
                    const f32x4 c0 = *(const GAS f32x4*)(P.cw + k * 512 + ch0), c1 = *(const GAS f32x4*)(P.cw + k * 512 + ch0 + 4);
                    y[0] += bflo(w.x) * c0.x; y[1] += bfhi(w.x) * c0.y; y[2] += bflo(w.y) * c0.z; y[3] += bfhi(w.y) * c0.w;
                    y[4] += bflo(w.z) * c1.x; y[5] += bfhi(w.z) * c1.y; y[6] += bflo(w.w) * c1.z; y[7] += bfhi(w.w) * c1.w;
                }
            }
#pragma unroll
            for (int e = 0; e < 8; ++e) xc[(8 * cg + e) * LR_XP + time] = y[e];
        }
        __syncthreads();
        float aa[32], ax[32];
        { const float b_a = P.ba[64 * g + lane], b_x = P.bx[64 * g + lane];
#pragma unroll
          for (int j = 0; j < 32; ++j) { aa[j] = b_a; ax[j] = b_x; } }
#pragma unroll 2
        for (int ci = 0; ci < 64; ++ci) {
            const float wa_ = WA[ci * 64 + lane], wx_ = WX[ci * 64 + lane];
            const LAS f32x4* xr = (const LAS f32x4*)(xc + ci * LR_XP + 32 * wave);
#pragma unroll
            for (int q = 0; q < 8; ++q) { const f32x4 xv = xr[q];
                aa[4 * q] += xv.x * wa_; aa[4 * q + 1] += xv.y * wa_; aa[4 * q + 2] += xv.z * wa_; aa[4 * q + 3] += xv.w * wa_;
                ax[4 * q] += xv.x * wx_; ax[4 * q + 1] += xv.y * wx_; ax[4 * q + 2] += xv.z * wx_; ax[4 * q + 3] += xv.w * wx_; }
        }
        { const float sp = P.sp[64 * g + lane];
          const LAS f32x4* xo = (const LAS f32x4*)(xc + lane * LR_XP + 32 * wave);
          float hrun = 0.f, arun = 1.f;
#pragma unroll
          for (int q = 0; q < 8; ++q) { const f32x4 xv = xo[q];
#pragma unroll
              for (int e = 0; e < 4; ++e) { const int j = 4 * q + e;
                  const float r = __builtin_amdgcn_rcpf(1.f + __builtin_amdgcn_exp2f(-LOG2E * aa[j])), ig = __builtin_amdgcn_rcpf(1.f + __builtin_amdgcn_exp2f(-LOG2E * ax[j]));
                  const float la = -8.0f * r * sp; const float a = __builtin_amdgcn_exp2f(LOG2E * la);
                  const float uu = __builtin_amdgcn_sqrtf(fmaxf(1.f - a * a, 0.f)) * (ig * xv[e]);
                  hrun = a * hrun + uu; arun *= a; aa[j] = arun; ax[j] = hrun; } }
          SUM[(wave * 64 + lane) * 2] = arun; SUM[(wave * 64 + lane) * 2 + 1] = hrun; }
        __syncthreads();
        float ca = 1.f, chh = 0.f;
        for (int w = 0; w < wave; ++w) { const float aw = SUM[(w * 64 + lane) * 2], hw = SUM[(w * 64 + lane) * 2 + 1]; chh = aw * chh + hw; ca *= aw; }
        { bf16* hl = P.HL + (size_t)(t0 + 32 * wave) * 512 + 64 * g + lane; bf16* ac = P.AC + (size_t)(t0 + 32 * wave) * 512 + 64 * g + lane;
#pragma unroll
          for (int j = 0; j < 32; ++j) { const float hh = ax[j] + aa[j] * chh, acc = aa[j] * ca; hl[(size_t)j * 512] = (bf16)f2bf_(hh); ac[(size_t)j * 512] = (bf16)f2bf_(acc);
              if (j == 31 && wave == 7) { P.LSUM[((size_t)tile * 512 + 64 * g + lane) * 2] = acc; P.LSUM[((size_t)tile * 512 + 64 * g + lane) * 2 + 1] = hh; } } }
    }
}

struct PostP { const bf16* OMB; const bf16* HL; const bf16* AC; const float* LSUM; const bf16* PROJB; const float* gm; const float* gl; bf16* Y; };
__device__ __forceinline__ void post_phase(const PostP& P, LAS unsigned char* lds, int tid, int wave, int lane, int vcu, int G) {
    asm volatile("" : "+v"(tid), "+v"(lane));
    LAS float* hin = (LAS float*)lds;
    for (int u = vcu; u < T / 64; u += G) {
        const int t0 = u * 64, tile = t0 >> 8, tb = tile & ~31;
        __syncthreads();
        { float h = 0.f;
          for (int c = tb; c < tile; ++c) { const float a = P.LSUM[((size_t)c * 512 + tid) * 2], hh = P.LSUM[((size_t)c * 512 + tid) * 2 + 1]; h = a * h + hh; }
          hin[tid] = h; }
        __syncthreads();
        f32x4 hi0 = *(const LAS f32x4*)(hin + 8 * lane), hi1 = *(const LAS f32x4*)(hin + 8 * lane + 4);
        const f32x4 g0 = *(const GAS f32x4*)(P.gl + 8 * lane), g1 = *(const GAS f32x4*)(P.gl + 8 * lane + 4), gmv = *(const GAS f32x4*)(P.gm + 4 * lane);
#pragma unroll 2
        for (int i = 0; i < 8; ++i) {
            const size_t t = (size_t)t0 + 8 * wave + i;
            const v4u hw = *(const GAS v4u*)(P.HL + t * 512 + 8 * lane), aw = *(const GAS v4u*)(P.AC + t * 512 + 8 * lane), gw_ = *(const GAS v4u*)(P.PROJB + t * INP + PC_GL + 8 * lane);
            const v2u mw = *(const GAS v2u*)(P.OMB + t * 256 + 4 * lane);
            float o[8];
            o[0] = (bflo(hw.x) + bflo(aw.x) * hi0.x) * gelu_erf(bflo(gw_.x)); o[1] = (bfhi(hw.x) + bfhi(aw.x) * hi0.y) * gelu_erf(bfhi(gw_.x));
            o[2] = (bflo(hw.y) + bflo(aw.y) * hi0.z) * gelu_erf(bflo(gw_.y)); o[3] = (bfhi(hw.y) + bfhi(aw.y) * hi0.w) * gelu_erf(bfhi(gw_.y));
            o[4] = (bflo(hw.z) + bflo(aw.z) * hi1.x) * gelu_erf(bflo(gw_.z)); o[5] = (bfhi(hw.z) + bfhi(aw.z) * hi1.y) * gelu_erf(bfhi(gw_.z));
            o[6] = (bflo(hw.w) + bflo(aw.w) * hi1.z) * gelu_erf(bflo(gw_.w)); o[7] = (bfhi(hw.w) + bfhi(aw.w) * hi1.w) * gelu_erf(bfhi(gw_.w));
            float s2 = 0.f;
#pragma unroll
            for (int e = 0; e < 8; ++e) s2 += o[e] * o[e];
            const float m0 = bflo(mw.x), m1 = bfhi(mw.x), m2 = bflo(mw.y), m3 = bfhi(mw.y);
            float s1 = (m0 * m0 + m1 * m1) + (m2 * m2 + m3 * m3);
            s1 = wave_sum(s1, lane); s2 = wave_sum(s2, lane);
            const float r1 = rsqrtf(s1 * (1.f / 256.f) + 1e-6f), r2 = rsqrtf(s2 * (1.f / 512.f) + 1e-6f);
            bf16* yr = P.Y + t * 1024;
            { v2u w; w.x = pk2(m0 * r1 * gmv.x, m1 * r1 * gmv.y); w.y = pk2(m2 * r1 * gmv.z, m3 * r1 * gmv.w); *(GAS v2u*)(yr + 4 * lane) = w; }
            { v4u w; w.x = pk2(o[0] * r2 * g0.x, o[1] * r2 * g0.y); w.y = pk2(o[2] * r2 * g0.z, o[3] * r2 * g0.w); w.z = pk2(o[4] * r2 * g1.x, o[5] * r2 * g1.y); w.w = pk2(o[6] * r2 * g1.z, o[7] * r2 * g1.w);
              *(GAS v4u*)(yr + 256 + 8 * lane) = w; }
        }
    }
}

typedef short bf16x8 __attribute__((ext_vector_type(8)));
typedef short s16x4 __attribute__((ext_vector_type(4)));
typedef float f32x16 __attribute__((ext_vector_type(16)));
typedef unsigned u32x4 __attribute__((ext_vector_type(4)));
__device__ __forceinline__ int crow(int r, int hi) { return (r & 3) + 8 * (r >> 2) + 4 * hi; }
__device__ __forceinline__ unsigned cvtpk(float lo, float hi) { unsigned r; asm("v_cvt_pk_bf16_f32 %0, %1, %2" : "=v"(r) : "v"(lo), "v"(hi)); return r; }
__device__ __forceinline__ float swapmax(float m) { auto rr = __builtin_amdgcn_permlane32_swap(__float_as_uint(m), __float_as_uint(m), false, false); return fmaxf(__uint_as_float(rr[0]), __uint_as_float(rr[1])); }
__device__ __forceinline__ float swapadd(float m) { auto rr = __builtin_amdgcn_permlane32_swap(__float_as_uint(m), __float_as_uint(m), false, false); return __uint_as_float(rr[0]) + __uint_as_float(rr[1]); }
__device__ __forceinline__ s16x4 vtr(const LAS unsigned char* p) { return __builtin_bit_cast(s16x4, __builtin_amdgcn_ds_read_tr16_b64_v4i16((LAS s16x4*)p)); }
__device__ __forceinline__ bf16x8 pack8(const f32x16& p, int b) { u32x4 w; w.x = cvtpk(p[b], p[b + 1]); w.y = cvtpk(p[b + 2], p[b + 3]); w.z = cvtpk(p[b + 4], p[b + 5]); w.w = cvtpk(p[b + 6], p[b + 7]); return __builtin_bit_cast(bf16x8, w); }
__device__ __forceinline__ float max16(const f32x16& p) { float a = fmaxf(fmaxf(p[0], p[1]), fmaxf(p[2], p[3])), b = fmaxf(fmaxf(p[4], p[5]), fmaxf(p[6], p[7])), c = fmaxf(fmaxf(p[8], p[9]), fmaxf(p[10], p[11])), d = fmaxf(fmaxf(p[12], p[13]), fmaxf(p[14], p[15])); return fmaxf(fmaxf(a, b), fmaxf(c, d)); }

struct AttnP {
    const bf16* Q; const bf16* K; const bf16* V; int qp, kp, vp;
    bf16* O; int op;
    const float* rope;
    const int* pos; const float* btab; const float* dnorm; const float* lams;
};
constexpr int AT_KB = 13312, AT_K0 = 0, AT_V0 = 2 * AT_KB, AT_VB = 8192, AT_POS = AT_V0 + 2 * AT_VB, AT_BT = AT_POS + 512, AT_DN = AT_BT + 528, AT_END = AT_DN + 256;

template <bool DIFF>
__device__ __forceinline__ void attn_unit(const AttnP& P, int b, int h, int qb, LAS unsigned char* lds, int tid, int wave, int lane) {
    asm volatile("" : "+v"(tid), "+v"(lane));
    constexpr int HW = DIFF ? 64 : 96;
    constexpr int CPK = HW / 8;
    constexpr int KP = DIFF ? 144 : 208;
    constexpr int NKS = DIFF ? 2 : 6;
    const int r32 = lane & 31, hi = lane >> 5;
    const size_t rowb = (size_t)b * S;
    const int q0w = qb * 256 + wave * 32, qi = q0w + r32;
    int pq = 0; float bias_far = 0.f;
    __syncthreads();
    if (DIFF) {
        pq = P.pos[rowb + qi];
        if (tid < 129) ((LAS float*)(lds + AT_BT))[tid] = P.btab[h * 129 + tid];
        if (tid >= 192 && tid < 256) ((LAS float*)(lds + AT_DN))[tid - 192] = P.dnorm[tid - 192];
    }
    int minq = pq;
    if (DIFF) { for (int o = 1; o < 64; o <<= 1) { const int v = shxi(minq, o, lane); minq = v < minq ? v : minq; } }
    const int NT = 4 * (qb + 1);
    u32x4 kr0, kr1, vr; int pkr = 0;
    const int kc0 = tid, kc1 = tid + 512;
    const bf16* Kb = P.K + rowb * P.kp + h * HW; const bf16* Vb = P.V + rowb * P.vp + h * 64;
    auto gload = [&](int t) {
        const int k0 = 64 * t;
        { const int key = kc0 / CPK, part = kc0 % CPK; kr0 = *(const u32x4*)(Kb + (size_t)(k0 + key) * P.kp + part * 8); }
        if (!DIFF) { if (kc1 < 64 * CPK) { const int key = kc1 / CPK, part = kc1 % CPK; kr1 = *(const u32x4*)(Kb + (size_t)(k0 + key) * P.kp + part * 8); } }
        { const int key = tid >> 3, part = tid & 7; vr = *(const u32x4*)(Vb + (size_t)(k0 + key) * P.vp + part * 8); }
        if (DIFF) { if (tid < 64) pkr = P.pos[rowb + k0 + tid]; }
    };
    auto lstore = [&](int buf) {
        LAS unsigned char* kb_ = lds + AT_K0 + buf * AT_KB; LAS unsigned char* vb_ = lds + AT_V0 + buf * AT_VB;
        { const int key = kc0 / CPK, part = kc0 % CPK; *(LAS u32x4*)(kb_ + key * KP + part * 16) = kr0; }
        if (!DIFF) { if (kc1 < 64 * CPK) { const int key = kc1 / CPK, part = kc1 % CPK; *(LAS u32x4*)(kb_ + key * KP + part * 16) = kr1; } }
        { const int key = tid >> 3, part = tid & 7; *(LAS u32x4*)(vb_ + (part >> 2) * 4096 + (key >> 3) * 512 + (key & 7) * 64 + (part & 3) * 16) = vr; }
        if (DIFF) { if (tid < 64) ((LAS int*)(lds + AT_POS + buf * 256))[tid] = pkr; }
    };
    f32x16 osv[2];
#pragma unroll
    for (int d = 0; d < 2; ++d)
#pragma unroll
        for (int r = 0; r < 16; ++r) osv[d][r] = 0.f;
    float il = 0.f;
    f32x16 oA[2];
#pragma unroll 1
    for (int mp = 0; mp < (DIFF ? 2 : 1); ++mp) {
        bf16x8 qf[NKS];
        { const bf16* qrow = P.Q + (rowb + qi) * P.qp + h * HW + mp * 32;
#pragma unroll
          for (int s = 0; s < NKS; ++s) qf[s] = *(const bf16x8*)(qrow + 16 * s + 8 * hi);
          if (!DIFF) {
              const float* rp = P.rope + (rowb + qi) * 32 + 8 * hi;
              const f32x4 c0 = *(const f32x4*)rp, c1 = *(const f32x4*)(rp + 4), s0 = *(const f32x4*)(rp + 16), s1 = *(const f32x4*)(rp + 20);
              const u32x4 a = __builtin_bit_cast(u32x4, qf[NKS - 2]), bq = __builtin_bit_cast(u32x4, qf[NKS - 1]); u32x4 ra, rb;
#pragma unroll
              for (int w = 0; w < 4; ++w) { const float cl = w < 2 ? c0[2 * w] : c1[2 * w - 4], ch = w < 2 ? c0[2 * w + 1] : c1[2 * w - 3], sl = w < 2 ? s0[2 * w] : s1[2 * w - 4], sh = w < 2 ? s0[2 * w + 1] : s1[2 * w - 3];
                  const float x1l = bflo(a[w]), x1h = bfhi(a[w]), x2l = bflo(bq[w]), x2h = bfhi(bq[w]);
                  ra[w] = cvtpk(x1l * cl - x2l * sl, x1h * ch - x2h * sh); rb[w] = cvtpk(x1l * sl + x2l * cl, x1h * sh + x2h * ch); }
              qf[NKS - 2] = __builtin_bit_cast(bf16x8, ra); qf[NKS - 1] = __builtin_bit_cast(bf16x8, rb);
          } }
        __syncthreads();
        gload(0); lstore(0);
        if (NT > 1) gload(1);
        __syncthreads();
        if (DIFF) bias_far = ((LAS float*)(lds + AT_BT))[128];
        float m1 = -1e30f, l1 = 0.f;
#pragma unroll
        for (int d = 0; d < 2; ++d)
#pragma unroll
            for (int r = 0; r < 16; ++r) oA[d][r] = 0.f;
        for (int t = 0; t < NT; ++t) {
            const int buf = t & 1;
            if (t + 1 < NT) { lstore(buf ^ 1); if (t + 2 < NT) gload(t + 2); }
            const int k0 = 64 * t;
            if (k0 <= q0w + 31) {
                const LAS unsigned char* kb_ = lds + AT_K0 + buf * AT_KB + r32 * KP + hi * 16 + mp * 64;
                const LAS unsigned char* vb_ = lds + AT_V0 + buf * AT_VB + ((lane >> 4) & 1) * 32 + (lane & 3) * 8 + (4 * hi + ((lane & 15) >> 2)) * 64;
                const bool partial = (k0 + 63 > q0w);
                bool nearb = false;
                if (DIFF) {
                    int mk_ = ((LAS int*)(lds + AT_POS + buf * 256))[lane];
                    for (int o = 1; o < 64; o <<= 1) { const int v = shxi(mk_, o, lane); mk_ = v > mk_ ? v : mk_; }
                    nearb = (minq - mk_) < 128;
                }
                const float init = (DIFF && !nearb) ? bias_far : 0.f;
                f32x16 pa, pb;
#pragma unroll
                for (int r = 0; r < 16; ++r) { pa[r] = init; pb[r] = init; }
#pragma unroll
                for (int s = 0; s < NKS; ++s) { const bf16x8 a0 = *(const LAS bf16x8*)(kb_ + s * 32), a1 = *(const LAS bf16x8*)(kb_ + 32 * KP + s * 32);
                    pa = __builtin_amdgcn_mfma_f32_32x32x16_bf16(a0, qf[s], pa, 0, 0, 0); pb = __builtin_amdgcn_mfma_f32_32x32x16_bf16(a1, qf[s], pb, 0, 0, 0); }
                if (DIFF) { if (nearb) {
                    const LAS int* pk = (const LAS int*)(lds + AT_POS + buf * 256); const LAS float* bt = (const LAS float*)(lds + AT_BT);
#pragma unroll
                    for (int r = 0; r < 16; ++r) { const int kk = crow(r, hi);
                        int n0 = pq - pk[kk], n1 = pq - pk[kk + 32]; n0 = n0 < 0 ? 0 : (n0 > 128 ? 128 : n0); n1 = n1 < 0 ? 0 : (n1 > 128 ? 128 : n1);
                        pa[r] += bt[n0]; pb[r] += bt[n1]; }
                } }
                if (partial) {
#pragma unroll
                    for (int r = 0; r < 16; ++r) { const int kk = k0 + crow(r, hi); if (kk > qi) pa[r] = -1e30f; if (kk + 32 > qi) pb[r] = -1e30f; }
                }
                const float mx = swapmax(fmaxf(max16(pa), max16(pb))); const float mn = fmaxf(m1, mx); const float al = __builtin_amdgcn_exp2f(m1 - mn); m1 = mn;
                float ls = 0.f;
#pragma unroll
                for (int r = 0; r < 16; ++r) { pa[r] = __builtin_amdgcn_exp2f(pa[r] - mn); pb[r] = __builtin_amdgcn_exp2f(pb[r] - mn); ls += pa[r] + pb[r]; }
                l1 = l1 * al + ls;
                bf16x8 pf[4];
                pf[0] = pack8(pa, 0); pf[1] = pack8(pa, 8); pf[2] = pack8(pb, 0); pf[3] = pack8(pb, 8);
#pragma unroll
                for (int d = 0; d < 2; ++d) {
#pragma unroll
                    for (int r = 0; r < 16; ++r) oA[d][r] *= al;
#pragma unroll
                    for (int s = 0; s < 4; ++s) { const s16x4 lo = vtr(vb_ + d * 4096 + s * 1024), hh = vtr(vb_ + d * 4096 + s * 1024 + 512);
                        const bf16x8 vf = (bf16x8){lo[0], lo[1], lo[2], lo[3], hh[0], hh[1], hh[2], hh[3]};
                        oA[d] = __builtin_amdgcn_mfma_f32_32x32x16_bf16(vf, pf[s], oA[d], 0, 0, 0); }
                }
            }
            __syncthreads();
        }
        il = 1.f / swapadd(l1);
        if (DIFF) { if (mp == 0) {
#pragma unroll
            for (int d = 0; d < 2; ++d)
#pragma unroll
                for (int r = 0; r < 16; ++r) osv[d][r] = oA[d][r] * il; } }
    }
    bf16* orow = P.O + (rowb + qi) * P.op + h * 64;
    if (!DIFF) {
#pragma unroll
        for (int d = 0; d < 2; ++d)
#pragma unroll
            for (int g = 0; g < 4; ++g) { v2u v; v.x = cvtpk(oA[d][4 * g] * il, oA[d][4 * g + 1] * il); v.y = cvtpk(oA[d][4 * g + 2] * il, oA[d][4 * g + 3] * il); *(v2u*)(orow + 32 * d + 8 * g + 4 * hi) = v; }
    } else {
        const float lam = P.lams[0], lam_init = P.lams[1];
        const float i2 = lam * il;
        float ss = 0.f;
#pragma unroll
        for (int d = 0; d < 2; ++d)
#pragma unroll
            for (int r = 0; r < 16; ++r) { const float v = osv[d][r] - oA[d][r] * i2; oA[d][r] = v; ss += v * v; }
        ss = swapadd(ss);
        const float rs = __builtin_amdgcn_rsqf(ss * (1.f / 64.f) + 1e-6f) * (1.f - lam_init);
        const LAS float* dn = (const LAS float*)(lds + AT_DN);
#pragma unroll
        for (int d = 0; d < 2; ++d)
#pragma unroll
            for (int g = 0; g < 4; ++g) { const int c = 32 * d + 8 * g + 4 * hi; const f32x4 gn = *(const LAS f32x4*)(dn + c);
                v2u v; v.x = cvtpk(oA[d][4 * g] * rs * gn[0], oA[d][4 * g + 1] * rs * gn[1]); v.y = cvtpk(oA[d][4 * g + 2] * rs * gn[2], oA[d][4 * g + 3] * rs * gn[3]); *(v2u*)(orow + c) = v; }
    }
}

__device__ __forceinline__ void attn_phase(const AttnP& PM, const AttnP& PD, LAS unsigned char* lds, int tid, int wave, int lane, int vcu, int G) {
    for (int i = vcu; i < 512; i += G) {
        const int kind = i >> 8, c = i & 255, bh = c >> 4, s = c & 15;
        if (kind == 0) {
#pragma unroll 1
            for (int k = 0; k < 2; ++k) attn_unit<false>(PM, bh >> 2, bh & 3, k ? 31 - s : s, lds, tid, wave, lane);
        } else {
#pragma unroll 1
            for (int k = 0; k < 2; ++k) attn_unit<true>(PD, bh >> 2, bh & 3, k ? 31 - s : s, lds, tid, wave, lane);
        }
    }
}

struct Args { const float* in[33]; float* out; unsigned char* ws; int ph_lo, ph_hi; };
struct Frame { LAS unsigned char* lds; volatile LAS unsigned* MISC; gu32* ctl; int tid, lane, wave, G, vcu; };

__device__ __forceinline__ void transpose_item(const float* W, int ldw, int nsrc0, bf16* WT, int ldt, int rdst0, LAS float* scr, int kb, int nb, int lane, float scale, const float* kgain) {
    const int k0 = 64 * kb, n0 = 32 * nb;
#pragma unroll 8
    for (int i = 0; i < 32; ++i) { const int kk = 2 * i + (lane >> 5); const float gsc = kgain ? kgain[k0 + kk] * scale : scale; scr[kk * 33 + (lane & 31)] = W[(size_t)(k0 + kk) * ldw + nsrc0 + n0 + (lane & 31)] * gsc; }
    LDS_WAIT(); asm volatile("" ::: "memory");
    const int c = lane & 7;
#pragma unroll
    for (int j = 0; j < 4; ++j) { const int n = (lane >> 3) + 8 * j; const LAS float* s = scr + (8 * c) * 33 + n;
        v4u o; o.x = pk2(s[0 * 33], s[1 * 33]); o.y = pk2(s[2 * 33], s[3 * 33]); o.z = pk2(s[4 * 33], s[5 * 33]); o.w = pk2(s[6 * 33], s[7 * 33]);
        *(GAS v4u*)(WT + (size_t)(rdst0 + n0 + n) * ldt + k0 + 8 * c) = o; }
    LDS_WAIT(); asm volatile("" ::: "memory");
}
__device__ __forceinline__ void zero_rect(bf16* base, int ld, int row0, int nrows, int col0, int ncols, int gtid, int gthreads) {
    const int vpr = ncols / 8;
    for (int i = gtid; i < nrows * vpr; i += gthreads) { const int r = i / vpr, c = i % vpr; *(GAS v4u*)(base + (size_t)(row0 + r) * ld + col0 + 8 * c) = (v4u){0u, 0u, 0u, 0u}; }
}

__device__ __forceinline__ void p0_prologue(Frame& F, const Args& a) {
    LAS float* scr = (LAS float*)(F.lds + RING_OFF + F.wave * 16384);
    const int gw = blockIdx.x * NWAVES + F.wave, NGW = F.G * NWAVES;
    const int gtid = blockIdx.x * (NWAVES * 64) + F.tid, gthreads = F.G * NWAVES * 64;
    unsigned char* ws = a.ws;
    { const GAS f32x4* src = (const GAS f32x4*)a.in[0]; GAS f32x4* dst = (GAS f32x4*)a.out; const size_t n4 = (size_t)T * D / 4;
      for (size_t i = gtid; i < n4; i += (size_t)gthreads) dst[i] = src[i]; }
    constexpr int I_IN = 16 * (INW / 32), I_SQ = 16 * 32, I_CKV = 16 * 64, I_UQ = 3 * 12, I_UKV = 2 * 16, I_L = I_IN + 4 * I_SQ + I_CKV + I_UQ + I_UKV;
    for (int it = gw; it < L * I_L; it += NGW) {
        const int l = it / I_L; int r = it % I_L;
        if (r < I_IN) {
            const int kb = r / 67, nb = r % 67; int src, dst; float sc = 1.f;
            if (nb < 6) { src = 32 * nb; dst = src; } else if (nb < 11) { src = 32 * nb; dst = src + 64; } else { src = 32 * nb; dst = src + 160; if (nb >= 43 && nb < 51) sc = 0.17677669529663687f * LOG2E; }
            transpose_item(a.in[5] + (size_t)l * D * INW, INW, src, (bf16*)(ws + WS_WIN) + (size_t)l * INP * D, D, dst, scr, kb, 0, F.lane, sc, nullptr); continue; } r -= I_IN;
        if (r < I_SQ) { transpose_item(a.in[21] + (size_t)l * D * D, D, 0, (bf16*)(ws + WS_WOUT) + (size_t)l * D * D, D, 0, scr, r / 32, r % 32, F.lane, 1.f, nullptr); continue; } r -= I_SQ;
        if (r < I_SQ) { transpose_item(a.in[24] + (size_t)l * D * D, D, 0, (bf16*)(ws + WS_WCQ) + (size_t)l * D * D, D, 0, scr, r / 32, r % 32, F.lane, 1.f, nullptr); continue; } r -= I_SQ;
        if (r < I_SQ) { transpose_item(a.in[26] + (size_t)l * D * D, D, 0, (bf16*)(ws + WS_WCO) + (size_t)l * D * D, D, 0, scr, r / 32, r % 32, F.lane, 1.f, nullptr); continue; } r -= I_SQ;
        if (r < I_SQ) { transpose_item(a.in[28] + (size_t)l * D * D, D, 0, (bf16*)(ws + WS_WPQ) + (size_t)l * D * D, D, 0, scr, r / 32, r % 32, F.lane, 1.f, nullptr); continue; } r -= I_SQ;
        if (r < I_CKV) { transpose_item(a.in[25] + (size_t)l * D * 2 * D, 2 * D, 0, (bf16*)(ws + WS_WCKV) + (size_t)l * 2 * D * D, D, 0, scr, r / 64, r % 64, F.lane, 1.f, nullptr); continue; } r -= I_CKV;
        if (r < I_UQ) { transpose_item(a.in[7] + (size_t)l * 192 * 384, 384, 0, (bf16*)(ws + WS_WUQ) + (size_t)l * 512 * 256, 256, 0, scr, r / 12, r % 12, F.lane, 0.10206207261596575f * LOG2E, a.in[6] + l * 192); continue; } r -= I_UQ;
        transpose_item(a.in[9] + (size_t)l * 128 * 512, 512, 0, (bf16*)(ws + WS_WUKV) + (size_t)l * 512 * 256, 256, 0, scr, r / 16, r % 16, F.lane, 1.f, a.in[8] + l * 128);
    }
    for (int l = 0; l < L; ++l) {
        bf16* win = (bf16*)(ws + WS_WIN) + (size_t)l * INP * D; bf16* wuq = (bf16*)(ws + WS_WUQ) + (size_t)l * 512 * 256; bf16* wukv = (bf16*)(ws + WS_WUKV) + (size_t)l * 512 * 256;
        zero_rect(win, D, 192, 64, 0, D, gtid, gthreads); zero_rect(win, D, 416, 96, 0, D, gtid, gthreads);
        zero_rect(wuq, 256, 0, 384, 192, 64, gtid, gthreads); zero_rect(wuq, 256, 384, 128, 0, 256, gtid, gthreads);
        zero_rect(wukv, 256, 0, 512, 128, 128, gtid, gthreads);
    }
    { float* rope = (float*)(ws + WS_ROPE); const int* pos = (const int*)a.in[2];
      for (int i = gtid; i < T * 16; i += gthreads) { const int t = i >> 4, k = i & 15; const float inv = powf(10000.f, -(float)(2 * k) / 32.f); const float ang = (float)pos[t] * inv;
          rope[(size_t)t * 32 + k] = cosf(ang); rope[(size_t)t * 32 + 16 + k] = sinf(ang); } }
    { float* btab = (float*)(ws + WS_BTAB); float* lams = (float*)(ws + WS_LAMS); float* spt = (float*)(ws + WS_SP);
      for (int i = gtid; i < 4 * 129; i += gthreads) { const int h = i / 129, n = i % 129; int bu; if (n < 16) bu = n; else { const int lg = 16 + (int)(logf((float)n / 16.f) / logf(8.f) * 16.f); bu = lg < 31 ? lg : 31; }
          btab[i] = a.in[3][bu * 4 + h] * LOG2E; }
      for (int i = gtid; i < L; i += gthreads) { const float* dl = a.in[17] + i * 128; float s1 = 0.f, s2 = 0.f; for (int j = 0; j < 32; ++j) { s1 += dl[j] * dl[32 + j]; s2 += dl[64 + j] * dl[96 + j]; }
          const float li = 0.8f - 0.6f * expf(-0.3f * (float)i); lams[2 * i] = expf(s1) - expf(s2) + li; lams[2 * i + 1] = li; }
      for (int i = gtid; i < L * 512; i += gthreads) spt[i] = log1pf(expf(-a.in[16][i])); }
    for (int l = 0; l < L; ++l) norm_phase(a.in[1], a.in[23] + l * D, (bf16*)(ws + WS_MNB) + (size_t)l * NB * MEM * D, NB * MEM, gw, NGW, F.lane);
}

constexpr int NPL = 16, PH_FINAL = 2 + NPL * L;
__global__ void __launch_bounds__(NWAVES * 64, 2) fwd(Args args) {
    extern __shared__ __attribute__((aligned(16))) unsigned char lds[];
    Frame F;
    F.lds = (LAS unsigned char*)lds; F.MISC = (volatile LAS unsigned*)(F.lds + MISC_OFF);
    F.tid = threadIdx.x; F.lane = F.tid & 63; F.wave = __builtin_amdgcn_readfirstlane(F.tid >> 6); F.G = gridDim.x;
    F.vcu = (F.G % 8 == 0) ? ((int)blockIdx.x % 8) * (F.G / 8) + (int)blockIdx.x / 8 : (int)blockIdx.x;
    unsigned char* ws = args.ws;
    F.ctl = (gu32*)(opq(ws) + WS_CTL);
    for (int u = F.tid; u < (LDS_BYTES - LDSCTL_OFF) / 4; u += NWAVES * 64) ((LAS unsigned*)(F.lds + LDSCTL_OFF))[u] = 0u;
    __syncthreads();
    XcdBarrier bar = xcd_barrier_post((unsigned*)(F.ctl + CW_BAR), F.MISC + 8);
    const int lo = args.ph_lo, hi = args.ph_hi;
    const int gw = blockIdx.x * NWAVES + F.wave, NGW = F.G * NWAVES;
#define IN(k) (lo <= (k) && (k) < hi)
#define LANE_ ((int)__builtin_amdgcn_mbcnt_hi(~0u, __builtin_amdgcn_mbcnt_lo(~0u, 0u)))
#define TID_ ((opqi(F.wave) << 6) | LANE_)
#define SITE() const int G_ = opqi(F.G), wv_ = opqi(F.wave), vcu_ = opqi(F.vcu), gw_ = opqi(gw), NGW_ = opqi(NGW); (void)G_; (void)wv_; (void)vcu_; (void)gw_; (void)NGW_
#define SEAM(k) do { if (IN(k) && IN((k) + 1)) xcd_barrier(bar, (F.wave == 0 && __builtin_amdgcn_mbcnt_hi(~0u, __builtin_amdgcn_mbcnt_lo(~0u, 0u)) == 0u) ? 1 : 0); } while (0)
#define GEMM_SITE(EPI, Aptr, lda_, Bptr, ldb_, M_, N_, K_, cperm, ...) do { \
        pg8::Gemm g{opq(Aptr), opq(Bptr), M_, N_, K_, lda_, ldb_}; pg8::StaticOrder So; So.init(M_, N_, opqi(F.G), opqi(cperm)); pg8::EPI E{__VA_ARGS__}; \
        pg8::gemm_phase<pg8::EPI, pg8::StaticOrder, true, true>(F.lds + RING_OFF, g, So, E, opqi(F.wave)); } while (0)
    if (IN(0)) { p0_prologue(F, args); }
    SEAM(0);
    if (IN(1)) {
#pragma unroll 1
        for (int l = 0; l < L; ++l)
            GEMM_SITE(EpiBf16, (const bf16*)(opq(ws) + WS_MNB) + (size_t)l * NB * MEM * D, D, (const bf16*)(opq(ws) + WS_WCKV) + (size_t)l * 2 * D * D, D, NB * MEM, 2 * D, D, (int)((blockIdx.x + 64 * l) % F.G),
                      opq((bf16*)(opq(ws) + WS_KVCB) + (size_t)l * NB * MEM * 2 * D), 2 * D, 2 * D);
    }
    SEAM(1);
    for (int l = 0; l < L; ++l) {
        const int pb = 2 + NPL * l;
        const bf16* XNB = (const bf16*)(opq(ws) + WS_XNB); const bf16* YB = (const bf16*)(opq(ws) + WS_YB); bf16* PROJB = (bf16*)(opq(ws) + WS_PROJB);
        if (IN(pb + 0)) { SITE(); norm_phase(args.out, args.in[opqi(4)] + l * D, opq((bf16*)(opq(ws) + WS_XNB)), T, gw_, NGW_, LANE_); }
        SEAM(pb + 0);
        if (IN(pb + 1)) GEMM_SITE(EpiBf16, XNB, D, (const bf16*)(opq(ws) + WS_WIN) + (size_t)l * INP * D, D, T, INP, D, (int)blockIdx.x, opq(PROJB), INP, INP);
        SEAM(pb + 1);
        if (IN(pb + 2)) {
            SITE();
            pre_phase(opq((const bf16*)PROJB), opq((const float*)(opq(ws) + WS_ROPE)), opq((float*)(opq(ws) + WS_RS)), opq((bf16*)(opq(ws) + WS_KMB)), gw_, NGW_, LANE_);
            LruP LP{opq((const bf16*)PROJB), args.in[opqi(10)] + l * 4 * 512, args.in[opqi(11)] + l * 512, args.in[opqi(12)] + (size_t)l * 8 * 4096, args.in[opqi(13)] + l * 512, args.in[opqi(14)] + (size_t)l * 8 * 4096, args.in[opqi(15)] + l * 512,
                    (const float*)(opq(ws) + WS_SP) + l * 512, opq((bf16*)(opq(ws) + WS_HLB)), opq((bf16*)(opq(ws) + WS_ACB)), opq((float*)(opq(ws) + WS_LSUM))};
            lru_phase(LP, F.lds, TID_, wv_, LANE_, vcu_, G_);
        }
        SEAM(pb + 2);
        if (IN(pb + 3)) {
            GEMM_SITE(EpiUp, (const bf16*)PROJB + PC_CQ, INP, (const bf16*)(opq(ws) + WS_WUQ) + (size_t)l * 512 * 256, 256, T, 512, 256, (int)blockIdx.x,
                      opq((bf16*)(opq(ws) + WS_QMB)), nullptr, 384, 384, opq((const float*)(opq(ws) + WS_RS)), 0, 0);
            GEMM_SITE(EpiUp, (const bf16*)PROJB + PC_CKV, INP, (const bf16*)(opq(ws) + WS_WUKV) + (size_t)l * 512 * 256, 256, T, 512, 256, (int)blockIdx.x,
                      opq((bf16*)(opq(ws) + WS_KMB)), opq((bf16*)(opq(ws) + WS_VMB)), 0, 512, opq((const float*)(opq(ws) + WS_RS)), 1, 1);
        }
        SEAM(pb + 3);
        if (IN(pb + 4)) {
            SITE();
            AttnP PM{opq((const bf16*)(opq(ws) + WS_QMB)), opq((const bf16*)(opq(ws) + WS_KMB)), opq((const bf16*)(opq(ws) + WS_VMB)), 384, 384, 256, opq((bf16*)(opq(ws) + WS_OMB)), 256, opq((const float*)(opq(ws) + WS_ROPE)), nullptr, nullptr, nullptr, nullptr};
            AttnP PD{opq((const bf16*)PROJB + PC_QD), opq((const bf16*)PROJB + PC_KD), opq((const bf16*)PROJB + PC_VD), INP, INP, INP, opq((bf16*)(opq(ws) + WS_YB) + 768), 1024, nullptr,
                     (const int*)args.in[opqi(2)], (const float*)(opq(ws) + WS_BTAB), args.in[opqi(18)] + l * 64, (const float*)(opq(ws) + WS_LAMS) + 2 * l};
            attn_phase(PM, PD, F.lds, TID_, wv_, LANE_, vcu_, G_);
        }
        SEAM(pb + 4);
        if (IN(pb + 5)) {
            SITE();
            PostP PP{opq((const bf16*)(opq(ws) + WS_OMB)), opq((const bf16*)(opq(ws) + WS_HLB)), opq((const bf16*)(opq(ws) + WS_ACB)), opq((const float*)(opq(ws) + WS_LSUM)), opq((const bf16*)PROJB), args.in[opqi(19)] + l * 256, args.in[opqi(20)] + l * 512, opq((bf16*)(opq(ws) + WS_YB))};
            post_phase(PP, F.lds, TID_, wv_, LANE_, vcu_, G_);
        }
        SEAM(pb + 5);
        if (IN(pb + 6)) GEMM_SITE(EpiF32, YB, D, (const bf16*)(opq(ws) + WS_WOUT) + (size_t)l * D * D, D, T, D, D, (int)blockIdx.x, args.out, D, D, 1);
        SEAM(pb + 6);
        if (IN(pb + 7)) { SITE(); norm_phase(args.out, args.in[opqi(22)] + l * D, opq((bf16*)(opq(ws) + WS_XNB)), T, gw_, NGW_, LANE_); }
        SEAM(pb + 7);
        if (IN(pb + 8)) GEMM_SITE(EpiF32, XNB, D, (const bf16*)(opq(ws) + WS_WCQ) + (size_t)l * D * D, D, T, D, D, (int)blockIdx.x, opq((float*)(opq(ws) + WS_TQ)), D, D, 0);
        SEAM(pb + 8);
        if (IN(pb + 10)) GEMM_SITE(EpiF32, YB, D, (const bf16*)(opq(ws) + WS_WCO) + (size_t)l * D * D, D, T, D, D, (int)blockIdx.x, args.out, D, D, 1);
        SEAM(pb + 10);
        if (IN(pb + 11)) { SITE(); norm_phase(args.out, args.in[opqi(27)] + l * D, opq((bf16*)(opq(ws) + WS_XNB)), T, gw_, NGW_, LANE_); }
        SEAM(pb + 11);
        if (IN(pb + 12)) GEMM_SITE(EpiF32, XNB, D, (const bf16*)(opq(ws) + WS_WPQ) + (size_t)l * D * D, D, T, D, D, (int)blockIdx.x, opq((float*)(opq(ws) + WS_TQ)), D, D, 0);
        SEAM(pb + 12);
    }
    if (IN(PH_FINAL)) { SITE(); final_norm_phase(args.out, args.in[opqi(32)], T, gw_, NGW_, LANE_); }
#undef IN
#undef SEAM
#undef GEMM_SITE
}
}
namespace {
void gemm(hipStream_t st, const float* A, long lda, const float* Bm, long sbk, long sbn, float* C, long ldc, int M, int N, int K, float alpha, int acc,
          int batch = 1, int nh = 1, long aB = 0, long aH = 0, long bB = 0, long bH = 0, long cB = 0, long cH = 0) {
    GemmP p{}; p.A = A; p.Bm = Bm; p.C = C; p.lda = lda; p.sbk = sbk; p.sbn = sbn; p.ldc = ldc; p.M = M; p.N = N; p.K = K; p.nh = nh;
    p.aB = aB; p.aH = aH; p.bB = bB; p.bH = bH; p.cB = cB; p.cH = cH; p.alpha = alpha; p.acc = acc;
    hipLaunchKernelGGL(k_gemm, dim3((N + 127) / 128, M / 128, batch), dim3(256), 0, st, p);
}
}

extern "C" void kernel_launch(void* const* d_in, const int* in_sizes, int n_in, void* d_out, int out_size, void* d_ws, size_t ws_size, hipStream_t stream) {
    (void)in_sizes; (void)out_size;
    static int grid = 0;
    if (grid == 0) {
        int dev = 0, cus = 0, per_cu = 0;
        if (n_in != 33 || ws_size < mk::WS_END) { fprintf(stderr, "kernel_launch: unexpected n_in %d / ws_size %zu\n", n_in, ws_size); grid = -1; return; }
        if (hipGetDevice(&dev) != hipSuccess || hipDeviceGetAttribute(&cus, hipDeviceAttributeMultiprocessorCount, dev) != hipSuccess) { grid = -1; return; }
        if (hipFuncSetAttribute((const void*)mk::fwd, hipFuncAttributeMaxDynamicSharedMemorySize, mk::LDS_BYTES) != hipSuccess) { fprintf(stderr, "kernel_launch: hipFuncSetAttribute failed\n"); grid = -1; return; }
        if (hipOccupancyMaxActiveBlocksPerMultiprocessor(&per_cu, (const void*)mk::fwd, mk::NWAVES * 64, mk::LDS_BYTES) != hipSuccess || per_cu < 1) fprintf(stderr, "kernel_launch: occupancy query says %d\n", per_cu);
        (void)hipGetLastError();
        grid = cus;
    }
    if (grid < 0) return;
    const float* peer_keys = (const float*)d_in[29]; const float* peer_u = (const float*)d_in[30]; const float* peer_v = (const float*)d_in[31];
    float* X = (float*)d_out;
    unsigned char* ws = (unsigned char*)d_ws;
    bf16_t* XNB = (bf16_t*)(ws + mk::WS_XNB); bf16_t* YB = (bf16_t*)(ws + mk::WS_YB);
    float* TQ = (float*)(ws + mk::WS_TQ); float* SC = (float*)(ws + mk::WS_TSC); float* OCF = (float*)(ws + mk::WS_TOC); float* KVC = (float*)(ws + mk::WS_TKVC);
    int* EX = (int*)(ws + mk::WS_EX); float* GW = (float*)(ws + mk::WS_GW);

    (void)hipMemsetAsync(ws + mk::WS_CTL, 0, mk::CTL_ZERO_BYTES, stream);
    mk::Args a{};
    for (int i = 0; i < 33; ++i) a.in[i] = (const float*)d_in[i];
    a.out = X; a.ws = ws;
    auto run = [&](int lo, int hi) { a.ph_lo = lo; a.ph_hi = hi; hipLaunchKernelGGL(mk::fwd, dim3(grid), dim3(mk::NWAVES * 64), mk::LDS_BYTES, stream, a); };
    run(0, 1); run(1, 2);
    for (int l = 0; l < L; ++l) {
        const int pb = 2 + mk::NPL * l;
        for (int k = 0; k <= 8; ++k) run(pb + k, pb + k + 1);
        hipLaunchKernelGGL(k_bf2f, dim3((unsigned)(((size_t)NB * MEM * 2 * D + 255) / 256)), dim3(256), 0, stream, (const bf16_t*)(ws + mk::WS_KVCB) + (size_t)l * NB * MEM * 2 * D, KVC, (long)NB * MEM * 2 * D);
        gemm(stream, TQ, D, KVC, 1, 2 * D, SC, 256, S, 256, 256, 1.f / 16.f, 0, NB * 4, 4, (long)S * D, 256, (long)MEM * 2 * D, 256, (long)4 * S * 256, (long)S * 256);
        hipLaunchKernelGGL(k_softmax256, dim3(T * 4 / 4), dim3(256), 0, stream, SC, (long)T * 4);
        gemm(stream, SC, 256, KVC + D, 2 * D, 1, OCF, D, S, 256, 256, 1.f, 0, NB * 4, 4, (long)4 * S * 256, (long)S * 256, (long)MEM * 2 * D, 256, (long)S * D, 256);
        hipLaunchKernelGGL(k_f2bf, dim3((unsigned)(((size_t)T * D + 255) / 256)), dim3(256), 0, stream, OCF, YB, (long)T * D);
        run(pb + 10, pb + 11); run(pb + 11, pb + 12); run(pb + 12, pb + 13);
        hipLaunchKernelGGL(k_route, dim3(T), dim3(256), 0, stream, TQ, peer_keys + (size_t)l * 2 * 128 * 64, EX, GW);
        hipLaunchKernelGGL(k_peer, dim3(T), dim3(256), 0, stream, XNB, EX, GW, peer_u + (size_t)l * NEXP * D, peer_v + (size_t)l * NEXP * D, X);
    }
    run(mk::PH_FINAL, mk::PH_FINAL + 1);
}
```

```cpp
#include <hip/hip_runtime.h>
#include <cstdint>
#include <cstdio>
#include <cmath>

#ifndef MK_ONE_LAUNCH
#define MK_ONE_LAUNCH 1
#endif
#ifndef MK_NAIVE_PEER
#define MK_NAIVE_PEER 0
#endif
namespace pg8 {
#define PG8_LAS __attribute__((address_space(3)))
typedef unsigned short bf16_t;
typedef short bf16x8 __attribute__((ext_vector_type(8)));
typedef float f32x4 __attribute__((ext_vector_type(4)));
typedef unsigned u32x4 __attribute__((ext_vector_type(4)));
typedef unsigned u32x2 __attribute__((ext_vector_type(2)));
constexpr int BM = 256, BK = 64, HALF = 128, HTB = HALF * BK * 2, STAGE_BYTES = 8 * HTB, NXCD = 8, WGM = 8;
__host__ __device__ __forceinline__ int lds_byte(int r, int c) { const int st = (r >> 4) * 2 + (c >> 5), rr = r & 15, cc = c & 31, ob = rr * 64 + cc * 2; return st * 1024 + (ob ^ (((ob >> 9) & 1) << 5)); }
__host__ __device__ __forceinline__ void stage_rc(int b, int& R, int& C) { const int st = b / 1024, sb = b % 1024, swz = sb ^ (((sb >> 9) & 1) << 5); R = (st >> 1) * 16 + swz / 64; C = (st & 1) * 32 + (swz % 64) / 2; }
__host__ __device__ __forceinline__ int perm32(int rho) { const int n = rho >> 4, i = rho & 15; return 8 * (i >> 2) + 4 * n + (i & 3); }
__device__ __forceinline__ int pg8_lane_id() { int l; asm volatile("v_mbcnt_lo_u32_b32 %0, -1, 0\n\tv_mbcnt_hi_u32_b32 %0, -1, %0" : "=v"(l)); return l; }
struct Unit { int pm, pn; };
struct Gemm { const bf16_t* A; const bf16_t* Bt; int M, N, K, lda, ldb; };
struct StaticOrder {
    int nM, nN, nwg, G, c;
    __host__ __device__ void init(int M, int N, int G_, int c_) { nM = M / BM; nN = N / BM; nwg = nM * nN; G = G_; c = c_; }
    __host__ __device__ bool next(int i, Unit& u) const {
        const long L = (long)i * G + c; if (L >= nwg) return false;
        int wgid = (int)L; { const int q = nwg / NXCD, r = nwg % NXCD, xcd = wgid % NXCD, off = wgid / NXCD; wgid = (xcd < r ? xcd * (q + 1) : r * (q + 1) + (xcd - r) * q) + off; }
        const int nig = WGM * nN, gid = wgid / nig, fm = gid * WGM, gsz = (nM - fm) < WGM ? (nM - fm) : WGM;
        u.pm = fm + ((wgid % nig) % gsz); u.pn = (wgid % nig) / gsz; return true;
    }
    __device__ __forceinline__ void a_ready(const Unit&) const {}
    __device__ __forceinline__ void done(const Unit&) const {}
};
__device__ __forceinline__ unsigned cvt_pk_bf16(float lo, float hi) { unsigned r; asm volatile("v_cvt_pk_bf16_f32 %0, %1, %2" : "=v"(r) : "v"(lo), "v"(hi)); return r; }

struct EpiF32 {
    static constexpr bool PERM = false, AFTER_DRAIN = false;
    float* C; int ldc; int nvalid; int accum;
    __device__ __forceinline__ void operator()(const f32x4 (&acc)[2][2][4][2], const Unit& u, int wr, int wc, int fr, int fq) const {
        asm volatile("" : "+v"(fr), "+v"(fq));
#pragma unroll
        for (int ai = 0; ai < 2; ++ai)
#pragma unroll
            for (int m = 0; m < 4; ++m) { const size_t row = (size_t)u.pm * BM + ai * HALF + wr * 64 + m * 16 + fr;
#pragma unroll
                for (int bj = 0; bj < 2; ++bj)
#pragma unroll
                    for (int n = 0; n < 2; ++n) { const int col = u.pn * BM + bj * HALF + wc * 32 + n * 16 + 4 * fq;
                        if (col < nvalid) { float* p = C + row * ldc + col; f32x4 v = acc[ai][bj][m][n]; if (accum) v += *(const f32x4*)p; *(f32x4*)p = v; } } }
    }
};
struct EpiBf16 {
    static constexpr bool PERM = true, AFTER_DRAIN = false;
    bf16_t* O; int ldc; int nvalid;
    __device__ __forceinline__ void operator()(const f32x4 (&acc)[2][2][4][2], const Unit& u, int wr, int wc, int fr, int fq) const {
        asm volatile("" : "+v"(fr), "+v"(fq));
#pragma unroll
        for (int ai = 0; ai < 2; ++ai)
#pragma unroll
            for (int m = 0; m < 4; ++m) { const size_t row = (size_t)u.pm * BM + ai * HALF + wr * 64 + m * 16 + fr;
#pragma unroll
                for (int bj = 0; bj < 2; ++bj) { const int col = u.pn * BM + bj * HALF + wc * 32 + 8 * fq;
                    if (col < nvalid) { const f32x4 v0 = acc[ai][bj][m][0], v1 = acc[ai][bj][m][1]; u32x4 w; w.x = cvt_pk_bf16(v0[0], v0[1]); w.y = cvt_pk_bf16(v0[2], v0[3]); w.z = cvt_pk_bf16(v1[0], v1[1]); w.w = cvt_pk_bf16(v1[2], v1[3]);
                        *(u32x4*)(O + row * ldc + col) = w; } } }
    }
};
struct EpiUp {
    static constexpr bool PERM = true, AFTER_DRAIN = false;
    bf16_t* O; bf16_t* O2; int ldc; int nvalid; const float* rs; int rsi; int mode;
    __device__ __forceinline__ void operator()(const f32x4 (&acc)[2][2][4][2], const Unit& u, int wr, int wc, int fr, int fq) const {
        asm volatile("" : "+v"(fr), "+v"(fq));
#pragma unroll
        for (int ai = 0; ai < 2; ++ai)
#pragma unroll
            for (int m = 0; m < 4; ++m) { const size_t row = (size_t)u.pm * BM + ai * HALF + wr * 64 + m * 16 + fr; const float s = rs[2 * row + rsi];
#pragma unroll
                for (int bj = 0; bj < 2; ++bj) { const int col = u.pn * BM + bj * HALF + wc * 32 + 8 * fq;
                    if (col < nvalid) { const f32x4 v0 = acc[ai][bj][m][0] * s, v1 = acc[ai][bj][m][1] * s; u32x4 w; w.x = cvt_pk_bf16(v0[0], v0[1]); w.y = cvt_pk_bf16(v0[2], v0[3]); w.z = cvt_pk_bf16(v1[0], v1[1]); w.w = cvt_pk_bf16(v1[2], v1[3]);
                        bf16_t* dst;
                        if (mode == 0) dst = O + row * ldc + col;
                        else { const int h = col >> 7, j = col & 127; dst = (j < 64) ? O + row * 384 + h * 96 + j : O2 + row * 256 + h * 64 + (j - 64); }
                        *(u32x4*)dst = w; } } }
    }
};
template <class Epi, class Sched, bool ALIGN_EPI = false, bool SP2 = false>
__device__ __forceinline__ void gemm_phase(PG8_LAS unsigned char* lds, const Gemm g, const Sched& S, const Epi& E, int wave_id) {
    int tid_ = (wave_id << 6) | pg8_lane_id(); asm volatile("" : "+v"(tid_));
    const int tid = tid_, wid = __builtin_amdgcn_readfirstlane(tid >> 6), lane = tid & 63, wr = wid >> 2, wc = wid & 3, fr = lane & 15, fq = lane >> 4;
    const int K = g.K, nt = K / BK;
    unsigned voffA[2], voffB[2];
#pragma unroll
    for (int i = 0; i < 2; ++i) { int R, C; stage_rc(tid * 16 + i * 8192, R, C); const int Rb = Epi::PERM ? ((R & ~31) + perm32(R & 31)) : R;
        voffA[i] = (unsigned)(R * g.lda + C) * 2u; voffB[i] = (unsigned)(Rb * g.ldb + C) * 2u; }
    const size_t kstep = (size_t)(BK * 2);
    const size_t hstepA = (size_t)HALF * g.lda * 2, hstepB = (size_t)HALF * g.ldb * 2;
    const size_t tstepA = 2 * hstepA, tstepB = 2 * hstepB;
    const unsigned ldsw = (unsigned)wid * 1024u;
    const int aoff = lds_byte(wr * 64 + fr, fq * 8), boff = lds_byte(wc * 32 + fr, fq * 8);
#define PG8_SA(b, h) (((b) * 2 + (h)) * HTB)
#define PG8_SB(b, h) ((4 + (b) * 2 + (h)) * HTB)
#define PG8_STAGE(bufoff, gbase, voff) do { _Pragma("unroll") for (int _i = 0; _i < 2; ++_i) \
        __builtin_amdgcn_global_load_lds((const unsigned*)((const char*)(gbase) + (voff)[_i]), (PG8_LAS unsigned*)(lds + (bufoff) + ldsw + _i * 8192), 16, 0, 0); } while (0)
#define PG8_LDA(dst, b, h) do { _Pragma("unroll") for (int m = 0; m < 4; ++m) _Pragma("unroll") for (int k = 0; k < 2; ++k) dst[m][k] = *(const PG8_LAS bf16x8*)(lds + PG8_SA(b, h) + aoff + m * 2048 + k * 1024); } while (0)
#define PG8_LDB(dst, b, h) do { _Pragma("unroll") for (int n = 0; n < 2; ++n) _Pragma("unroll") for (int k = 0; k < 2; ++k) dst[n][k] = *(const PG8_LAS bf16x8*)(lds + PG8_SB(b, h) + boff + n * 2048 + k * 1024); } while (0)
#define PG8_MMA(ai, bj, At, Bt) do { __builtin_amdgcn_s_setprio(1); _Pragma("unroll") for (int m = 0; m < 4; ++m) _Pragma("unroll") for (int n = 0; n < 2; ++n) _Pragma("unroll") for (int k = 0; k < 2; ++k) \
        acc[ai][bj][m][n] = __builtin_amdgcn_mfma_f32_16x16x32_bf16(Bt[n][k], At[m][k], acc[ai][bj][m][n], 0, 0, 0); __builtin_amdgcn_s_setprio(0); } while (0)
#define PG8_WAIT_V(n) asm volatile("s_waitcnt vmcnt(" #n ")" ::: "memory")
#define PG8_WAIT_L(n) asm volatile("s_waitcnt lgkmcnt(" #n ")" ::: "memory")
#define PG8_BAR __builtin_amdgcn_s_barrier()
#define PG8_SCHED __builtin_amdgcn_sched_barrier(0)
    Unit cur, nxt; int ui = 0;
    if (!S.next(0, cur)) return;
    f32x4 acc[2][2][4][2];
#pragma unroll
    for (int a = 0; a < 2; ++a)
#pragma unroll
        for (int b = 0; b < 2; ++b)
#pragma unroll
            for (int m = 0; m < 4; ++m)
#pragma unroll
                for (int n = 0; n < 2; ++n) acc[a][b][m][n] = (f32x4){0.f, 0.f, 0.f, 0.f};
    bf16x8 At[4][2], B0[2][2], B1[2][2];
    const char* cA = (const char*)g.A + (size_t)cur.pm * tstepA; const char* cB = (const char*)g.Bt + (size_t)cur.pn * tstepB;
    S.a_ready(cur);
    if constexpr (SP2) {
        PG8_STAGE(PG8_SB(0, 0), cB, voffB); PG8_STAGE(PG8_SB(0, 1), cB + hstepB, voffB); PG8_STAGE(PG8_SA(0, 0), cA, voffA); PG8_STAGE(PG8_SA(0, 1), cA + hstepA, voffA);
        if (wr == 1) PG8_BAR;
        PG8_WAIT_V(2); PG8_BAR;
        PG8_STAGE(PG8_SB(1, 0), cB + kstep, voffB); PG8_STAGE(PG8_SA(1, 0), cA + kstep, voffA); PG8_STAGE(PG8_SB(1, 1), cB + hstepB + kstep, voffB);
        PG8_WAIT_V(6); PG8_BAR;
    } else {
        PG8_STAGE(PG8_SB(0, 0), cB, voffB); PG8_STAGE(PG8_SA(0, 0), cA, voffA); PG8_STAGE(PG8_SB(0, 1), cB + hstepB, voffB); PG8_STAGE(PG8_SA(0, 1), cA + hstepA, voffA);
        if (wr == 1) PG8_BAR;
        PG8_WAIT_V(4); PG8_BAR;
        PG8_STAGE(PG8_SB(1, 0), cB + kstep, voffB); PG8_STAGE(PG8_SA(1, 0), cA + kstep, voffA); PG8_STAGE(PG8_SB(1, 1), cB + hstepB + kstep, voffB);
        PG8_WAIT_V(6); PG8_BAR;
    }
    for (;;) {
        const bool has_next = S.next(ui + 1, nxt);
        const char* nA = has_next ? (const char*)g.A + (size_t)nxt.pm * tstepA : cA; const char* nB = has_next ? (const char*)g.Bt + (size_t)nxt.pn * tstepB : cB;
        for (int t = 0; t < nt; t += 2) {
            const bool last = (t == nt - 2);
            const char* a1 = cA + (size_t)(t + 1) * kstep;
            const char* a2 = last ? nA : cA + (size_t)(t + 2) * kstep; const char* b2 = last ? nB : cB + (size_t)(t + 2) * kstep;
            const char* a3 = a2 + kstep; const char* b3 = b2 + kstep;
            if (last && has_next) S.a_ready(nxt);
            if constexpr (SP2) {
            PG8_LDB(B0, 0, 0); PG8_LDB(B1, 0, 1); PG8_SCHED; PG8_LDA(At, 0, 0); PG8_STAGE(PG8_SA(1, 1), a1 + hstepA, voffA);
            PG8_WAIT_V(8); PG8_WAIT_L(0); PG8_BAR; PG8_MMA(0, 0, At, B0); PG8_MMA(0, 1, At, B1); PG8_BAR; PG8_SCHED;
            PG8_LDA(At, 0, 1); PG8_STAGE(PG8_SB(0, 0), b2, voffB); PG8_STAGE(PG8_SB(0, 1), b2 + hstepB, voffB); PG8_STAGE(PG8_SA(0, 0), a2, voffA);
            PG8_WAIT_V(8); PG8_WAIT_L(0); PG8_BAR; PG8_MMA(1, 0, At, B0); PG8_MMA(1, 1, At, B1); PG8_BAR; PG8_SCHED;
            PG8_LDB(B0, 1, 0); PG8_LDB(B1, 1, 1); PG8_SCHED; PG8_LDA(At, 1, 0); PG8_STAGE(PG8_SA(0, 1), a2 + hstepA, voffA);
            PG8_WAIT_V(8); PG8_WAIT_L(0); PG8_BAR; PG8_MMA(0, 0, At, B0); PG8_MMA(0, 1, At, B1); PG8_BAR; PG8_SCHED;
            PG8_LDA(At, 1, 1); PG8_STAGE(PG8_SB(1, 0), b3, voffB); PG8_STAGE(PG8_SB(1, 1), b3 + hstepB, voffB); PG8_STAGE(PG8_SA(1, 0), a3, voffA);
            PG8_WAIT_V(8); PG8_WAIT_L(0); PG8_BAR; PG8_MMA(1, 0, At, B0); PG8_MMA(1, 1, At, B1); PG8_BAR; PG8_SCHED;
            } else {
            PG8_LDB(B0, 0, 0); PG8_SCHED; PG8_LDA(At, 0, 0); PG8_STAGE(PG8_SA(1, 1), a1 + hstepA, voffA);
            PG8_WAIT_L(8); PG8_BAR; PG8_WAIT_L(0); PG8_MMA(0, 0, At, B0); PG8_BAR; PG8_SCHED;
            PG8_LDB(B1, 0, 1); PG8_STAGE(PG8_SB(0, 0), b2, voffB);
            PG8_BAR; PG8_WAIT_L(0); PG8_MMA(0, 1, At, B1); PG8_BAR;
            PG8_LDA(At, 0, 1); PG8_STAGE(PG8_SA(0, 0), a2, voffA);
            PG8_BAR; PG8_WAIT_L(0); PG8_MMA(1, 0, At, B0); PG8_BAR; PG8_SCHED;
            PG8_STAGE(PG8_SB(0, 1), b2 + hstepB, voffB);
            PG8_WAIT_V(6); PG8_BAR; PG8_MMA(1, 1, At, B1); PG8_BAR;
            PG8_LDB(B0, 1, 0); PG8_SCHED; PG8_LDA(At, 1, 0); PG8_STAGE(PG8_SA(0, 1), a2 + hstepA, voffA);
            PG8_WAIT_L(8); PG8_BAR; PG8_WAIT_L(0); PG8_MMA(0, 0, At, B0); PG8_BAR; PG8_SCHED;
            PG8_LDB(B1, 1, 1); PG8_STAGE(PG8_SB(1, 0), b3, voffB);
            PG8_BAR; PG8_WAIT_L(0); PG8_MMA(0, 1, At, B1); PG8_BAR;
            PG8_LDA(At, 1, 1); PG8_STAGE(PG8_SA(1, 0), a3, voffA);
            PG8_BAR; PG8_WAIT_L(0); PG8_MMA(1, 0, At, B0); PG8_BAR; PG8_SCHED;
            PG8_STAGE(PG8_SB(1, 1), b3 + hstepB, voffB);
            PG8_WAIT_V(6); PG8_BAR; PG8_MMA(1, 1, At, B1); PG8_BAR;
            }
        }
        if constexpr (ALIGN_EPI) { if (wr == 0) PG8_BAR; }
        if constexpr (!Epi::AFTER_DRAIN) { E(acc, cur, wr, wc, fr, fq); S.done(cur); }
        if (!has_next) break;
#pragma unroll
        for (int a = 0; a < 2; ++a)
#pragma unroll
            for (int b = 0; b < 2; ++b)
#pragma unroll
                for (int m = 0; m < 4; ++m)
#pragma unroll
                    for (int n = 0; n < 2; ++n) acc[a][b][m][n] = (f32x4){0.f, 0.f, 0.f, 0.f};
        cur = nxt; cA = nA; cB = nB; ++ui;
        if constexpr (ALIGN_EPI) { if (wr == 1) PG8_BAR; }
    }
    PG8_WAIT_V(0);
    if constexpr (!ALIGN_EPI) { if (wr == 0) PG8_BAR; }
    PG8_BAR;
    if constexpr (Epi::AFTER_DRAIN) { E.fused(acc, cur, wr, wc, fr, fq, lds, wid, lane); S.done(cur); }
#undef PG8_SA
#undef PG8_SB
#undef PG8_STAGE
#undef PG8_LDA
#undef PG8_LDB
#undef PG8_MMA
#undef PG8_WAIT_V
#undef PG8_WAIT_L
#undef PG8_BAR
#undef PG8_SCHED
}
}

namespace mk {
#define GAS __attribute__((address_space(1)))
#define LAS __attribute__((address_space(3)))
typedef unsigned short bf16;
typedef unsigned v4u __attribute__((ext_vector_type(4)));
typedef unsigned v2u __attribute__((ext_vector_type(2)));
typedef float f32x4 __attribute__((ext_vector_type(4)));
typedef GAS unsigned gu32;
#define LDS_WAIT() asm volatile("s_waitcnt lgkmcnt(0)" ::: "memory")
#define VM_WAIT() asm volatile("s_waitcnt vmcnt(0)" ::: "memory")
__device__ __forceinline__ unsigned f2bf_(float f) { unsigned u = __builtin_bit_cast(unsigned, f); return (u + 0x7fffu + ((u >> 16) & 1u)) >> 16; }
__device__ __forceinline__ unsigned pk2(float lo, float hi) { return f2bf_(lo) | (f2bf_(hi) << 16); }
__device__ __forceinline__ float bflo(unsigned w) { return __builtin_bit_cast(float, w << 16); }
__device__ __forceinline__ float bfhi(unsigned w) { return __builtin_bit_cast(float, w & 0xffff0000u); }

template <class P> __device__ __forceinline__ P* opq(P* p) { asm volatile("" : "+s"(p)); return p; }
__device__ __forceinline__ int opqi(int k) { asm volatile("" : "+s"(k)); return k; }
__device__ __forceinline__ float shx(float v, int o, int lane) { return __builtin_bit_cast(float, __builtin_amdgcn_ds_bpermute((lane ^ o) << 2, __builtin_bit_cast(int, v))); }
__device__ __forceinline__ int shxi(int v, int o, int lane) { return __builtin_amdgcn_ds_bpermute((lane ^ o) << 2, v); }
__device__ __forceinline__ int lane_id_v() { int l; asm volatile("v_mbcnt_lo_u32_b32 %0, -1, 0\n\tv_mbcnt_hi_u32_b32 %0, -1, %0" : "=v"(l)); return l; }
constexpr int NWAVES = 8;
constexpr int D = 1024, NB = 4, S = 8192, T = NB * S, L = 4, MEM = 256, INW = 2144, INP = 2304;
constexpr int PC_CQ = 0, PC_CKV = 256, PC_KR = 384, PC_XL = 512, PC_GL = 1024, PC_QD = 1536, PC_KD = 1792, PC_VD = 2048;
constexpr float LOG2E = 1.4426950408889634f;
constexpr size_t MiB = 1u << 20;
constexpr size_t WS_CTL = 0, CTL_ZERO_BYTES = 1 * MiB;
constexpr size_t WS_WIN = 1 * MiB, WS_WOUT = 19 * MiB, WS_WCQ = 27 * MiB, WS_WCO = 35 * MiB, WS_WPQ = 43 * MiB, WS_WCKV = 51 * MiB, WS_WUQ = 67 * MiB, WS_WUKV = 68 * MiB, WS_KEYS = 69 * MiB, WS_ROPE = 70 * MiB;
constexpr size_t WS_XNB = 76 * MiB, WS_YB = 140 * MiB, WS_PROJB = 204 * MiB, WS_QMB = 348 * MiB, WS_KMB = 372 * MiB, WS_VMB = 396 * MiB, WS_RS = 412 * MiB;
constexpr size_t WS_HLB = 413 * MiB, WS_ACB = 445 * MiB, WS_LSUM = 477 * MiB, WS_OMB = 478 * MiB, WS_MNB = 494 * MiB, WS_KVCB = 502 * MiB, WS_EX = 518 * MiB, WS_GW = 534 * MiB;
constexpr size_t WS_U16 = 550 * MiB, WS_V16 = 678 * MiB;
constexpr size_t WS_END = 806 * MiB;
constexpr size_t WS_BTAB = WS_KEYS + 512 * 1024, WS_LAMS = WS_BTAB + 4096, WS_SP = WS_LAMS + 4096;
constexpr int CW_BAR = 4096;
constexpr int RING_OFF = 0, RING_BYTES = 131072, LDSCTL_OFF = RING_BYTES, MISC_OFF = LDSCTL_OFF + 320, LDS_BYTES = 147456;

#define XB_TMO      128
#define XB_XCNT(j)  (256  + 64 * (j))
#define XB_XSUB(j)  (1280 + 64 * (j))
#define XB_XGEN(j)  (2304 + 64 * (j))
#define XB_TOP      3328
#define XB_TOPGEN   3392
#define XCD_BAR_WORDS 3456
#define XB_SPIN_CAP (1u << 18)

__device__ __forceinline__ unsigned xb_ld(unsigned* p)              { return __hip_atomic_load(p, __ATOMIC_RELAXED, __HIP_MEMORY_SCOPE_AGENT); }
__device__ __forceinline__ unsigned xb_add(unsigned* p, unsigned v) { return __hip_atomic_fetch_add(p, v, __ATOMIC_RELAXED, __HIP_MEMORY_SCOPE_AGENT); }
__device__ __forceinline__ unsigned xb_xcc_id() { return (unsigned)__builtin_amdgcn_s_getreg((3 << 11) | 20) & 0xFu; }
#define XB_SPIN(cond, bar) do { unsigned _sp = 0; while (cond) { __builtin_amdgcn_s_sleep(1); \
    if ((++_sp & 255u) == 0u) { if (xb_ld(&(bar)[XB_TMO])) break; if (_sp > XB_SPIN_CAP) { atomicAdd(&(bar)[XB_TMO], 1u); break; } } } } while (0)

struct XcdBarrier {
    unsigned* bar; unsigned x;
    volatile LAS unsigned* st;
};

__device__ __forceinline__ XcdBarrier xcd_barrier_post(unsigned* bar, volatile LAS unsigned* st) {
    XcdBarrier b; b.bar = bar; b.x = xb_xcc_id(); b.st = st;
    if (threadIdx.x == 0) (void)xb_add(&bar[XB_XCNT(b.x)], 1u);
    return b;
}
__device__ __forceinline__ void xcd_barrier_complete(unsigned* bar, unsigned x, unsigned& nloc, unsigned& nx) {
    const unsigned G = gridDim.x * gridDim.y * gridDim.z;
    unsigned sum, cnt, mine, sp = 0u;
    for (;;) {
        sum = 0u; cnt = 0u; mine = 0u;
#pragma unroll
        for (unsigned j = 0; j < 16; ++j) { const unsigned c = xb_ld(&bar[XB_XCNT(j)]); sum += c; cnt += (c > 0u) ? 1u : 0u; mine = (j == x) ? c : mine; }
        if (sum == G) break;
        __builtin_amdgcn_s_sleep(1);
        if ((++sp & 255u) == 0u) { if (xb_ld(&bar[XB_TMO])) break; if (sp > XB_SPIN_CAP) { atomicAdd(&bar[XB_TMO], 1u); break; } }
    }
    nloc = mine > 0u ? mine : 1u; nx = cnt > 0u ? cnt : 1u;
}

__device__ __noinline__ void xcd_barrier_impl(unsigned* bar_, unsigned x_, volatile LAS unsigned* st_, int leader_) {
    XcdBarrier b; b.bar = bar_; b.x = x_; b.st = st_;
    asm volatile("s_waitcnt vmcnt(0)" ::: "memory");
    __syncthreads();
    if (leader_) {
        unsigned* bar = b.bar;
        __builtin_amdgcn_s_waitcnt(0);
        unsigned nloc = b.st[0], nx = b.st[1];
        if (nloc == 0u) { xcd_barrier_complete(bar, b.x, nloc, nx); b.st[0] = nloc; b.st[1] = nx; }
        const unsigned old = xb_add(&bar[XB_XSUB(b.x)], 1u);
        const unsigned gen = old / nloc;
        if (old + 1u == (gen + 1u) * nloc) {
            __builtin_amdgcn_fence(__ATOMIC_RELEASE, "agent");
            asm volatile("s_waitcnt vmcnt(0)" ::: "memory");
            const unsigned og = xb_add(&bar[XB_TOP], 1u);
            const unsigned tg = og / nx;
            if (og + 1u == (tg + 1u) * nx) xb_add(&bar[XB_TOPGEN], 1u);
            else XB_SPIN(xb_ld(&bar[XB_TOPGEN]) == tg, bar);
            __builtin_amdgcn_fence(__ATOMIC_ACQUIRE, "agent");
            xb_add(&bar[XB_XGEN(b.x)], 1u);
            asm volatile("s_waitcnt vmcnt(0)" ::: "memory");
        } else {
            XB_SPIN(xb_ld(&bar[XB_XGEN(b.x)]) == gen, bar);
            __builtin_amdgcn_fence(__ATOMIC_ACQUIRE, "agent");
            asm volatile("s_waitcnt vmcnt(0)" ::: "memory");
        }
    }
    __syncthreads();
}
__device__ __forceinline__ void xcd_barrier(const XcdBarrier& b, int leader) { xcd_barrier_impl(b.bar, b.x, b.st, leader); }


__device__ __forceinline__ float wave_sum(float v, int lane) {
#pragma unroll
    for (int o = 1; o < 64; o <<= 1) v += shx(v, o, lane);
    return v;
}
__device__ __forceinline__ float gelu_erf(float v) {
    const float av = __builtin_fabsf(v), t = __builtin_amdgcn_rcpf(av * 0.2316418882f + 1.0f);
    float q = t * 0.5307027145f + (-0.7265760135f); q = q * t + 0.7107068705f; q = q * t + (-0.142248368f); q = q * t + 0.127414796f; q = q * t;
    const float e = __builtin_amdgcn_exp2f((v * v) * (-0.72134752044f));
    const float m = v * (q * e);
    return v < 0.f ? m : v - m;
}

__device__ __forceinline__ void norm_phase(const float* X, const float* g, bf16* out, int rows, int gw, int NGW, int lane) {
    asm volatile("" : "+v"(lane));
    f32x4 gv[4];
#pragma unroll
    for (int j = 0; j < 4; ++j) gv[j] = ((const GAS f32x4*)g)[lane + 64 * j];
    for (int m = gw; m < rows; m += NGW) {
        const GAS f32x4* xr = (const GAS f32x4*)(X + (size_t)m * D) + lane;
        f32x4 v[4]; float s = 0.f;
#pragma unroll
        for (int j = 0; j < 4; ++j) { v[j] = xr[64 * j]; s += (v[j].x * v[j].x + v[j].y * v[j].y) + (v[j].z * v[j].z + v[j].w * v[j].w); }
        const float rs = rsqrtf(wave_sum(s, lane) * (1.f / D) + 1e-6f);
        GAS v2u* o8 = (GAS v2u*)(out + (size_t)m * D) + lane;
#pragma unroll
        for (int j = 0; j < 4; ++j) { v2u w; w.x = pk2(v[j].x * rs * gv[j].x, v[j].y * rs * gv[j].y); w.y = pk2(v[j].z * rs * gv[j].z, v[j].w * rs * gv[j].w); o8[64 * j] = w; }
    }
}
__device__ __forceinline__ void final_norm_phase(float* X, const float* g, int rows, int gw, int NGW, int lane) {
    asm volatile("" : "+v"(lane));
    for (int m = gw; m < rows; m += NGW) {
        GAS f32x4* xr = (GAS f32x4*)(X + (size_t)m * D) + lane;
        f32x4 v[4]; float s = 0.f;
#pragma unroll
        for (int j = 0; j < 4; ++j) { v[j] = xr[64 * j]; s += (v[j].x * v[j].x + v[j].y * v[j].y) + (v[j].z * v[j].z + v[j].w * v[j].w); }
        const float rs = rsqrtf(wave_sum(s, lane) * (1.f / D) + 1e-6f);
#pragma unroll
        for (int j = 0; j < 4; ++j) { const f32x4 gj = ((const GAS f32x4*)g)[lane + 64 * j]; xr[64 * j] = v[j] * rs * gj; }
    }
}

__device__ __forceinline__ void pre_phase(const bf16* PROJB, const float* ROPE, float* RS, bf16* KMB, int gw, int NGW, int lane) {
    asm volatile("" : "+v"(lane));
    for (int t = gw; t < T; t += NGW) {
        const bf16* pr = PROJB + (size_t)t * INP;
        float sq = 0.f, skv = 0.f;
        if (lane < 24) { const v4u w = *(const GAS v4u*)(pr + PC_CQ + 8 * lane);
            const float a0 = bflo(w.x), a1 = bfhi(w.x), a2 = bflo(w.y), a3 = bfhi(w.y), a4 = bflo(w.z), a5 = bfhi(w.z), a6 = bflo(w.w), a7 = bfhi(w.w);
            sq = (a0 * a0 + a1 * a1) + (a2 * a2 + a3 * a3) + (a4 * a4 + a5 * a5) + (a6 * a6 + a7 * a7); }
        else if (lane >= 32 && lane < 48) { const v4u w = *(const GAS v4u*)(pr + PC_CKV + 8 * (lane - 32));
            const float a0 = bflo(w.x), a1 = bfhi(w.x), a2 = bflo(w.y), a3 = bfhi(w.y), a4 = bflo(w.z), a5 = bfhi(w.z), a6 = bflo(w.w), a7 = bfhi(w.w);
            skv = (a0 * a0 + a1 * a1) + (a2 * a2 + a3 * a3) + (a4 * a4 + a5 * a5) + (a6 * a6 + a7 * a7); }
        sq = wave_sum(sq, lane); skv = wave_sum(skv, lane);
        if (lane == 0) { RS[2 * (size_t)t] = rsqrtf(sq * (1.f / 192.f) + 1e-6f); RS[2 * (size_t)t + 1] = rsqrtf(skv * (1.f / 128.f) + 1e-6f); }
        if (lane < 16) {
            const float x1 = __builtin_bit_cast(float, (unsigned)pr[PC_KR + lane] << 16), x2 = __builtin_bit_cast(float, (unsigned)pr[PC_KR + 16 + lane] << 16);
            const float c = ROPE[(size_t)t * 32 + lane], sn = ROPE[(size_t)t * 32 + 16 + lane];
            const bf16 y1 = (bf16)f2bf_(x1 * c - x2 * sn), y2 = (bf16)f2bf_(x1 * sn + x2 * c);
            bf16* kr = KMB + (size_t)t * 384 + 64 + lane;
#pragma unroll
            for (int h = 0; h < 4; ++h) { kr[h * 96] = y1; kr[h * 96 + 16] = y2; }
        }
    }
}

struct LruP { const bf16* PROJB; const float* cw; const float* cb; const float* wa; const float* ba; const float* wx; const float* bx; const float* sp; bf16* HL; bf16* AC; float* LSUM; };
constexpr int LR_XP = 260;
constexpr int LR_XC = 0, LR_WA = 64 * LR_XP * 4, LR_WX = LR_WA + 16384, LR_SUM = LR_WX + 16384, LR_END = LR_SUM + 4096;
__device__ __forceinline__ void lru_phase(const LruP& P, LAS unsigned char* lds, int tid, int wave, int lane, int vcu, int G) {
    asm volatile("" : "+v"(tid), "+v"(lane));
    LAS float* xc = (LAS float*)(lds + LR_XC); LAS float* WA = (LAS float*)(lds + LR_WA); LAS float* WX = (LAS float*)(lds + LR_WX); LAS float* SUM = (LAS float*)(lds + LR_SUM);
    for (int u = vcu; u < (T / 256) * 8; u += G) {
        const int tile = u >> 3, g = u & 7; const int t0 = tile * 256; const bool first = ((tile & 31) == 0);
        __syncthreads();
#pragma unroll
        for (int i = 0; i < 2; ++i) { const int idx = tid + 512 * i; ((LAS f32x4*)WA)[idx] = ((const GAS f32x4*)(P.wa + g * 4096))[idx]; ((LAS f32x4*)WX)[idx] = ((const GAS f32x4*)(P.wx + g * 4096))[idx]; }
#pragma unroll 1
        for (int it = tid; it < 2048; it += 512) {
            const int time = it & 255, cg = it >> 8; const int ch0 = 64 * g + 8 * cg;
            float y[8];
            { const f32x4 b0 = *(const GAS f32x4*)(P.cb + ch0), b1 = *(const GAS f32x4*)(P.cb + ch0 + 4); y[0] = b0.x; y[1] = b0.y; y[2] = b0.z; y[3] = b0.w; y[4] = b1.x; y[5] = b1.y; y[6] = b1.z; y[7] = b1.w; }
#pragma unroll
            for (int k = 0; k < 4; ++k) {
                if (!(first && time - 3 + k < 0)) {
                    const v4u w = *(const GAS v4u*)(P.PROJB + (size_t)(t0 + time - 3 + k) * INP + PC_XL + ch0);
                    const f32x4 c0 = *(const GAS f32x4*)(P.cw + k * 512 + ch0), c1 = *(const GAS f32x4*)(P.cw + k * 512 + ch0 + 4);
                    y[0] += bflo(w.x) * c0.x; y[1] += bfhi(w.x) * c0.y; y[2] += bflo(w.y) * c0.z; y[3] += bfhi(w.y) * c0.w;
                    y[4] += bflo(w.z) * c1.x; y[5] += bfhi(w.z) * c1.y; y[6] += bflo(w.w) * c1.z; y[7] += bfhi(w.w) * c1.w;
                }
            }
#pragma unroll
            for (int e = 0; e < 8; ++e) xc[(8 * cg + e) * LR_XP + time] = y[e];
        }
        __syncthreads();
        float aa[32], ax[32];
        { const float b_a = P.ba[64 * g + lane], b_x = P.bx[64 * g + lane];
#pragma unroll
          for (int j = 0; j < 32; ++j) { aa[j] = b_a; ax[j] = b_x; } }
#pragma unroll 2
        for (int ci = 0; ci < 64; ++ci) {
            const float wa_ = WA[ci * 64 + lane], wx_ = WX[ci * 64 + lane];
            const LAS f32x4* xr = (const LAS f32x4*)(xc + ci * LR_XP + 32 * wave);
#pragma unroll
            for (int q = 0; q < 8; ++q) { const f32x4 xv = xr[q];
                aa[4 * q] += xv.x * wa_; aa[4 * q + 1] += xv.y * wa_; aa[4 * q + 2] += xv.z * wa_; aa[4 * q + 3] += xv.w * wa_;
                ax[4 * q] += xv.x * wx_; ax[4 * q + 1] += xv.y * wx_; ax[4 * q + 2] += xv.z * wx_; ax[4 * q + 3] += xv.w * wx_; }
        }
        { const float sp = P.sp[64 * g + lane];
          const LAS f32x4* xo = (const LAS f32x4*)(xc + lane * LR_XP + 32 * wave);
          float hrun = 0.f, arun = 1.f;
#pragma unroll
          for (int q = 0; q < 8; ++q) { const f32x4 xv = xo[q];
#pragma unroll
              for (int e = 0; e < 4; ++e) { const int j = 4 * q + e;
                  const float r = __builtin_amdgcn_rcpf(1.f + __builtin_amdgcn_exp2f(-LOG2E * aa[j])), ig = __builtin_amdgcn_rcpf(1.f + __builtin_amdgcn_exp2f(-LOG2E * ax[j]));
                  const float la = -8.0f * r * sp; const float a = __builtin_amdgcn_exp2f(LOG2E * la);
                  const float uu = __builtin_amdgcn_sqrtf(fmaxf(1.f - a * a, 0.f)) * (ig * xv[e]);
                  hrun = a * hrun + uu; arun *= a; aa[j] = arun; ax[j] = hrun; } }
          SUM[(wave * 64 + lane) * 2] = arun; SUM[(wave * 64 + lane) * 2 + 1] = hrun; }
        __syncthreads();
        float ca = 1.f, chh = 0.f;
        for (int w = 0; w < wave; ++w) { const float aw = SUM[(w * 64 + lane) * 2], hw = SUM[(w * 64 + lane) * 2 + 1]; chh = aw * chh + hw; ca *= aw; }
        { bf16* hl = P.HL + (size_t)(t0 + 32 * wave) * 512 + 64 * g + lane; bf16* ac = P.AC + (size_t)(t0 + 32 * wave) * 512 + 64 * g + lane;
#pragma unroll
          for (int j = 0; j < 32; ++j) { const float hh = ax[j] + aa[j] * chh, acc = aa[j] * ca; hl[(size_t)j * 512] = (bf16)f2bf_(hh); ac[(size_t)j * 512] = (bf16)f2bf_(acc);
              if (j == 31 && wave == 7) { P.LSUM[((size_t)tile * 512 + 64 * g + lane) * 2] = acc; P.LSUM[((size_t)tile * 512 + 64 * g + lane) * 2 + 1] = hh; } } }
    }
}

struct PostP { const bf16* OMB; const bf16* HL; const bf16* AC; const float* LSUM; const bf16* PROJB; const float* gm; const float* gl; bf16* Y; };
__device__ __forceinline__ void post_phase(const PostP& P, LAS unsigned char* lds, int tid, int wave, int lane, int vcu, int G) {
    asm volatile("" : "+v"(tid), "+v"(lane));
    LAS float* hin = (LAS float*)lds;
    for (int u = vcu; u < T / 64; u += G) {
        const int t0 = u * 64, tile = t0 >> 8, tb = tile & ~31;
        __syncthreads();
        { float h = 0.f;
          for (int c = tb; c < tile; ++c) { const float a = P.LSUM[((size_t)c * 512 + tid) * 2], hh = P.LSUM[((size_t)c * 512 + tid) * 2 + 1]; h = a * h + hh; }
          hin[tid] = h; }
        __syncthreads();
        f32x4 hi0 = *(const LAS f32x4*)(hin + 8 * lane), hi1 = *(const LAS f32x4*)(hin + 8 * lane + 4);
        const f32x4 g0 = *(const GAS f32x4*)(P.gl + 8 * lane), g1 = *(const GAS f32x4*)(P.gl + 8 * lane + 4), gmv = *(const GAS f32x4*)(P.gm + 4 * lane);
#pragma unroll 2
        for (int i = 0; i < 8; ++i) {
            const size_t t = (size_t)t0 + 8 * wave + i;
            const v4u hw = *(const GAS v4u*)(P.HL + t * 512 + 8 * lane), aw = *(const GAS v4u*)(P.AC + t * 512 + 8 * lane), gw_ = *(const GAS v4u*)(P.PROJB + t * INP + PC_GL + 8 * lane);
            const v2u mw = *(const GAS v2u*)(P.OMB + t * 256 + 4 * lane);
            float o[8];
            o[0] = (bflo(hw.x) + bflo(aw.x) * hi0.x) * gelu_erf(bflo(gw_.x)); o[1] = (bfhi(hw.x) + bfhi(aw.x) * hi0.y) * gelu_erf(bfhi(gw_.x));
            o[2] = (bflo(hw.y) + bflo(aw.y) * hi0.z) * gelu_erf(bflo(gw_.y)); o[3] = (bfhi(hw.y) + bfhi(aw.y) * hi0.w) * gelu_erf(bfhi(gw_.y));
            o[4] = (bflo(hw.z) + bflo(aw.z) * hi1.x) * gelu_erf(bflo(gw_.z)); o[5] = (bfhi(hw.z) + bfhi(aw.z) * hi1.y) * gelu_erf(bfhi(gw_.z));
            o[6] = (bflo(hw.w) + bflo(aw.w) * hi1.z) * gelu_erf(bflo(gw_.w)); o[7] = (bfhi(hw.w) + bfhi(aw.w) * hi1.w) * gelu_erf(bfhi(gw_.w));
            float s2 = 0.f;
#pragma unroll
            for (int e = 0; e < 8; ++e) s2 += o[e] * o[e];
            const float m0 = bflo(mw.x), m1 = bfhi(mw.x), m2 = bflo(mw.y), m3 = bfhi(mw.y);
            float s1 = (m0 * m0 + m1 * m1) + (m2 * m2 + m3 * m3);
            s1 = wave_sum(s1, lane); s2 = wave_sum(s2, lane);
            const float r1 = rsqrtf(s1 * (1.f / 256.f) + 1e-6f), r2 = rsqrtf(s2 * (1.f / 512.f) + 1e-6f);
            bf16* yr = P.Y + t * 1024;
            { v2u w; w.x = pk2(m0 * r1 * gmv.x, m1 * r1 * gmv.y); w.y = pk2(m2 * r1 * gmv.z, m3 * r1 * gmv.w); *(GAS v2u*)(yr + 4 * lane) = w; }
            { v4u w; w.x = pk2(o[0] * r2 * g0.x, o[1] * r2 * g0.y); w.y = pk2(o[2] * r2 * g0.z, o[3] * r2 * g0.w); w.z = pk2(o[4] * r2 * g1.x, o[5] * r2 * g1.y); w.w = pk2(o[6] * r2 * g1.z, o[7] * r2 * g1.w);
              *(GAS v4u*)(yr + 256 + 8 * lane) = w; }
        }
    }
}

typedef short bf16x8 __attribute__((ext_vector_type(8)));
typedef short s16x4 __attribute__((ext_vector_type(4)));
typedef float f32x16 __attribute__((ext_vector_type(16)));
typedef unsigned u32x4 __attribute__((ext_vector_type(4)));
__device__ __forceinline__ int crow(int r, int hi) { return (r & 3) + 8 * (r >> 2) + 4 * hi; }
typedef float f32x2_t __attribute__((ext_vector_type(2))); typedef __bf16 bf16x2_c __attribute__((ext_vector_type(2)));
__device__ __forceinline__ unsigned cvtpk(float lo, float hi) { f32x2_t v = {lo, hi}; bf16x2_c b = __builtin_convertvector(v, bf16x2_c); return __builtin_bit_cast(unsigned, b); }
__device__ __forceinline__ float swapmax(float m) { auto rr = __builtin_amdgcn_permlane32_swap(__float_as_uint(m), __float_as_uint(m), false, false); return fmaxf(__uint_as_float(rr[0]), __uint_as_float(rr[1])); }
__device__ __forceinline__ float swapadd(float m) { auto rr = __builtin_amdgcn_permlane32_swap(__float_as_uint(m), __float_as_uint(m), false, false); return __uint_as_float(rr[0]) + __uint_as_float(rr[1]); }
__device__ __forceinline__ s16x4 vtr(const LAS unsigned char* p) { return __builtin_bit_cast(s16x4, __builtin_amdgcn_ds_read_tr16_b64_v4i16((LAS s16x4*)p)); }
__device__ __forceinline__ bf16x8 pack8(const f32x16& p, int b) { u32x4 w; w.x = cvtpk(p[b], p[b + 1]); w.y = cvtpk(p[b + 2], p[b + 3]); w.z = cvtpk(p[b + 4], p[b + 5]); w.w = cvtpk(p[b + 6], p[b + 7]); return __builtin_bit_cast(bf16x8, w); }
__device__ __forceinline__ float max16(const f32x16& p) { float a = fmaxf(fmaxf(p[0], p[1]), fmaxf(p[2], p[3])), b = fmaxf(fmaxf(p[4], p[5]), fmaxf(p[6], p[7])), c = fmaxf(fmaxf(p[8], p[9]), fmaxf(p[10], p[11])), d = fmaxf(fmaxf(p[12], p[13]), fmaxf(p[14], p[15])); return fmaxf(fmaxf(a, b), fmaxf(c, d)); }

struct AttnP {
    const bf16* Q; const bf16* K; const bf16* V; int qp, kp, vp;
    bf16* O; int op;
    const float* rope;
    const int* pos; const float* btab; const float* dnorm; const float* lams;
};
template <int KIND> struct AK {
    static constexpr bool DIFF = KIND == 1, CROSS = KIND == 2;
    static constexpr int HW = KIND == 0 ? 96 : KIND == 1 ? 64 : 256;
    static constexpr int NKS = KIND == 0 ? 6 : KIND == 1 ? 2 : 16;
    static constexpr int KP = KIND == 0 ? 208 : KIND == 1 ? 144 : 528;
    static constexpr int ND = CROSS ? 4 : 2;
    static constexpr int CPK = HW / 8, KCH = (64 * CPK + 511) / 512;
    static constexpr int VCH = ND / 2;
    static constexpr int KB = 64 * KP, VB = ND * 4096;
    static constexpr int K0 = 0, V0 = 2 * KB, POS = V0 + 2 * VB, BT = POS + 512, DN = BT + 528, END = DN + 256;
};
static_assert(AK<2>::END <= RING_BYTES && AK<0>::END <= RING_BYTES, "attention LDS");

template <int KIND>
__device__ __forceinline__ void attn_unit(const AttnP& P, int b, int h, int qb, int dhalf, LAS unsigned char* lds, int tid, int wave, int lane) {
    asm volatile("" : "+v"(tid), "+v"(lane));
    typedef AK<KIND> C;
    constexpr bool DIFF = C::DIFF, CROSS = C::CROSS;
    constexpr int HW = C::HW, NKS = C::NKS, KP = C::KP, ND = C::ND, CPK = C::CPK, KCH = C::KCH, VCH = C::VCH;
    const int r32 = lane & 31, hi = lane >> 5;
    const size_t rowb = (size_t)b * S, rowk = CROSS ? (size_t)b * MEM : rowb;
    const int q0w = qb * 256 + wave * 32, qi = q0w + r32;
    int pq = 0; float bias_far = 0.f;
    __syncthreads();
    if (DIFF) {
        pq = P.pos[rowb + qi];
        if (tid < 129) ((LAS float*)(lds + C::BT))[tid] = P.btab[h * 129 + tid];
        if (tid >= 192 && tid < 256) ((LAS float*)(lds + C::DN))[tid - 192] = P.dnorm[tid - 192];
    }
    int minq = pq;
    if (DIFF) { for (int o = 1; o < 64; o <<= 1) { const int v = shxi(minq, o, lane); minq = v < minq ? v : minq; } }
    const int NT = CROSS ? MEM / 64 : 4 * (qb + 1);
    u32x4 kr[KCH], vr[VCH]; int pkr = 0;
    const bf16* Kb = P.K + rowk * P.kp + h * HW; const bf16* Vb = P.V + rowk * P.vp + (CROSS ? h * 256 + dhalf * 128 : h * 64);
    auto gload = [&](int t) {
        const int k0 = 64 * t;
#pragma unroll
        for (int i = 0; i < KCH; ++i) { const int c = tid + 512 * i; if (c < 64 * CPK) { const int key = c / CPK, part = c % CPK; kr[i] = *(const u32x4*)(Kb + (size_t)(k0 + key) * P.kp + part * 8); } }
#pragma unroll
        for (int i = 0; i < VCH; ++i) { const int c = tid + 512 * i; const int key = c / (4 * ND), part = c % (4 * ND); vr[i] = *(const u32x4*)(Vb + (size_t)(k0 + key) * P.vp + part * 8); }
        if (DIFF) { if (tid < 64) pkr = P.pos[rowb + k0 + tid]; }
    };
    auto lstore = [&](int buf) {
        LAS unsigned char* kb_ = lds + C::K0 + buf * C::KB; LAS unsigned char* vb_ = lds + C::V0 + buf * C::VB;
#pragma unroll
        for (int i = 0; i < KCH; ++i) { const int c = tid + 512 * i; if (c < 64 * CPK) { const int key = c / CPK, part = c % CPK; *(LAS u32x4*)(kb_ + key * KP + part * 16) = kr[i]; } }
#pragma unroll
        for (int i = 0; i < VCH; ++i) { const int c = tid + 512 * i; const int key = c / (4 * ND), part = c % (4 * ND); *(LAS u32x4*)(vb_ + (part >> 2) * 4096 + (key >> 3) * 512 + (key & 7) * 64 + (part & 3) * 16) = vr[i]; }
        if (DIFF) { if (tid < 64) ((LAS int*)(lds + C::POS + buf * 256))[tid] = pkr; }
    };
    f32x16 osv[2];
#pragma unroll
    for (int d = 0; d < 2; ++d)
#pragma unroll
        for (int r = 0; r < 16; ++r) osv[d][r] = 0.f;
    float il = 0.f;
    f32x16 oA[ND];
#pragma unroll 1
    for (int mp = 0; mp < (DIFF ? 2 : 1); ++mp) {
        bf16x8 qf[NKS];
        { const bf16* qrow = P.Q + (rowb + qi) * P.qp + h * HW + mp * 32;
#pragma unroll
          for (int s = 0; s < NKS; ++s) qf[s] = *(const bf16x8*)(qrow + 16 * s + 8 * hi);
          if (KIND == 0) {
              const float* rp = P.rope + (rowb + qi) * 32 + 8 * hi;
              const f32x4 c0 = *(const f32x4*)rp, c1 = *(const f32x4*)(rp + 4), s0 = *(const f32x4*)(rp + 16), s1 = *(const f32x4*)(rp + 20);
              const u32x4 a = __builtin_bit_cast(u32x4, qf[NKS - 2]), bq = __builtin_bit_cast(u32x4, qf[NKS - 1]); u32x4 ra, rb;
#pragma unroll
              for (int w = 0; w < 4; ++w) { const float cl = w < 2 ? c0[2 * w] : c1[2 * w - 4], ch = w < 2 ? c0[2 * w + 1] : c1[2 * w - 3], sl = w < 2 ? s0[2 * w] : s1[2 * w - 4], sh = w < 2 ? s0[2 * w + 1] : s1[2 * w - 3];
                  const float x1l = bflo(a[w]), x1h = bfhi(a[w]), x2l = bflo(bq[w]), x2h = bfhi(bq[w]);
                  ra[w] = cvtpk(x1l * cl - x2l * sl, x1h * ch - x2h * sh); rb[w] = cvtpk(x1l * sl + x2l * cl, x1h * sh + x2h * ch); }
              qf[NKS - 2] = __builtin_bit_cast(bf16x8, ra); qf[NKS - 1] = __builtin_bit_cast(bf16x8, rb);
          } }
        __syncthreads();
        gload(0); lstore(0);
        if (!CROSS) { if (NT > 1) gload(1); }
        __syncthreads();
        if (DIFF) bias_far = ((LAS float*)(lds + C::BT))[128];
        float m1 = -1e30f, l1 = 0.f;
#pragma unroll
        for (int d = 0; d < ND; ++d)
#pragma unroll
            for (int r = 0; r < 16; ++r) oA[d][r] = 0.f;
        for (int t = 0; t < NT; ++t) {
            const int buf = t & 1;
            if (!CROSS) { if (t + 1 < NT) { lstore(buf ^ 1); if (t + 2 < NT) gload(t + 2); } }
            const int k0 = 64 * t;
            if (CROSS || k0 <= q0w + 31) {
                const LAS unsigned char* kb_ = lds + C::K0 + buf * C::KB + r32 * KP + hi * 16 + mp * 64;
                const LAS unsigned char* vb_ = lds + C::V0 + buf * C::VB + ((lane >> 4) & 1) * 32 + (lane & 3) * 8 + (4 * hi + ((lane & 15) >> 2)) * 64;
                const bool partial = !CROSS && (k0 + 63 > q0w);
                bool nearb = false;
                if (DIFF) {
                    int mk_ = ((LAS int*)(lds + C::POS + buf * 256))[lane];
                    for (int o = 1; o < 64; o <<= 1) { const int v = shxi(mk_, o, lane); mk_ = v > mk_ ? v : mk_; }
                    nearb = (minq - mk_) < 128;
                }
                const float init = (DIFF && !nearb) ? bias_far : 0.f;
                f32x16 pa, pb;
#pragma unroll
                for (int r = 0; r < 16; ++r) { pa[r] = init; pb[r] = init; }
#pragma unroll
                for (int s = 0; s < NKS; ++s) { const bf16x8 a0 = *(const LAS bf16x8*)(kb_ + s * 32), a1 = *(const LAS bf16x8*)(kb_ + 32 * KP + s * 32);
                    pa = __builtin_amdgcn_mfma_f32_32x32x16_bf16(a0, qf[s], pa, 0, 0, 0); pb = __builtin_amdgcn_mfma_f32_32x32x16_bf16(a1, qf[s], pb, 0, 0, 0); }
                if (DIFF) { if (nearb) {
                    const LAS int* pk = (const LAS int*)(lds + C::POS + buf * 256); const LAS float* bt = (const LAS float*)(lds + C::BT);
#pragma unroll
                    for (int r = 0; r < 16; ++r) { const int kk = crow(r, hi);
                        int n0 = pq - pk[kk], n1 = pq - pk[kk + 32]; n0 = n0 < 0 ? 0 : (n0 > 128 ? 128 : n0); n1 = n1 < 0 ? 0 : (n1 > 128 ? 128 : n1);
                        pa[r] += bt[n0]; pb[r] += bt[n1]; }
                } }
                if (partial) {
#pragma unroll
                    for (int r = 0; r < 16; ++r) { const int kk = k0 + crow(r, hi); if (kk > qi) pa[r] = -1e30f; if (kk + 32 > qi) pb[r] = -1e30f; }
                }
                const float mx = swapmax(fmaxf(max16(pa), max16(pb))); const float mn = fmaxf(m1, mx); const float al = __builtin_amdgcn_exp2f(m1 - mn); m1 = mn;
                float ls = 0.f;
#pragma unroll
                for (int r = 0; r < 16; ++r) { pa[r] = __builtin_amdgcn_exp2f(pa[r] - mn); pb[r] = __builtin_amdgcn_exp2f(pb[r] - mn); ls += pa[r] + pb[r]; }
                l1 = l1 * al + ls;
                bf16x8 pf[4];
                pf[0] = pack8(pa, 0); pf[1] = pack8(pa, 8); pf[2] = pack8(pb, 0); pf[3] = pack8(pb, 8);
#pragma unroll
                for (int d = 0; d < ND; ++d) {
                    if (CROSS) __builtin_amdgcn_sched_barrier(0);
#pragma unroll
                    for (int r = 0; r < 16; ++r) oA[d][r] *= al;
#pragma unroll
                    for (int s = 0; s < 4; ++s) { const s16x4 lo = vtr(vb_ + d * 4096 + s * 1024), hh = vtr(vb_ + d * 4096 + s * 1024 + 512);
                        const bf16x8 vf = (bf16x8){lo[0], lo[1], lo[2], lo[3], hh[0], hh[1], hh[2], hh[3]};
                        oA[d] = __builtin_amdgcn_mfma_f32_32x32x16_bf16(vf, pf[s], oA[d], 0, 0, 0); }
                }
            }
            if (CROSS) { if (t + 1 < NT) { gload(t + 1); lstore(buf ^ 1); } }
            __syncthreads();
        }
        il = 1.f / swapadd(l1);
        if (DIFF) { if (mp == 0) {
#pragma unroll
            for (int d = 0; d < 2; ++d)
#pragma unroll
                for (int r = 0; r < 16; ++r) osv[d][r] = oA[d][r] * il; } }
    }
    bf16* orow = P.O + (rowb + qi) * P.op + (CROSS ? h * 256 + dhalf * 128 : h * 64);
    if (!DIFF) {
#pragma unroll
        for (int d = 0; d < ND; ++d)
#pragma unroll
            for (int g = 0; g < 4; ++g) { v2u v; v.x = cvtpk(oA[d][4 * g] * il, oA[d][4 * g + 1] * il); v.y = cvtpk(oA[d][4 * g + 2] * il, oA[d][4 * g + 3] * il); *(v2u*)(orow + 32 * d + 8 * g + 4 * hi) = v; }
    } else {
        const float lam = P.lams[0], lam_init = P.lams[1];
        const float i2 = lam * il;
        float ss = 0.f;
#pragma unroll
        for (int d = 0; d < 2; ++d)
#pragma unroll
            for (int r = 0; r < 16; ++r) { const float v = osv[d][r] - oA[d][r] * i2; oA[d][r] = v; ss += v * v; }
        ss = swapadd(ss);
        const float rs = __builtin_amdgcn_rsqf(ss * (1.f / 64.f) + 1e-6f) * (1.f - lam_init);
        const LAS float* dn = (const LAS float*)(lds + C::DN);
#pragma unroll
        for (int d = 0; d < 2; ++d)
#pragma unroll
            for (int g = 0; g < 4; ++g) { const int c = 32 * d + 8 * g + 4 * hi; const f32x4 gn = *(const LAS f32x4*)(dn + c);
                v2u v; v.x = cvtpk(oA[d][4 * g] * rs * gn[0], oA[d][4 * g + 1] * rs * gn[1]); v.y = cvtpk(oA[d][4 * g + 2] * rs * gn[2], oA[d][4 * g + 3] * rs * gn[3]); *(v2u*)(orow + c) = v; }
    }
}

__device__ __forceinline__ void attn_phase(const AttnP& PM, const AttnP& PD, LAS unsigned char* lds, int tid, int wave, int lane, int vcu, int G) {
    for (int i = vcu; i < 512; i += G) {
        const int kind = i >> 8, c = i & 255, bh = c >> 4, s = c & 15;
        if (kind == 0) {
#pragma unroll 1
            for (int k = 0; k < 2; ++k) attn_unit<0>(PM, bh >> 2, bh & 3, k ? 31 - s : s, 0, lds, tid, wave, lane);
        } else {
#pragma unroll 1
            for (int k = 0; k < 2; ++k) attn_unit<1>(PD, bh >> 2, bh & 3, k ? 31 - s : s, 0, lds, tid, wave, lane);
        }
    }
}
__device__ __forceinline__ void cross_phase(const AttnP& PC, LAS unsigned char* lds, int tid, int wave, int lane, int vcu, int G) {
#pragma unroll 1
    for (int i = vcu; i < 1024; i += G) { const int bh = i >> 6; attn_unit<2>(PC, bh >> 2, bh & 3, i & 31, (i >> 5) & 1, lds, tid, wave, lane); }
}

__device__ __forceinline__ float vmax2(float a, float b) { float r; asm("v_max_f32_e32 %0, %1, %2" : "=v"(r) : "v"(a), "v"(b)); return r; }
__device__ __forceinline__ float vmin2(float a, float b) { float r; asm("v_min_f32_e32 %0, %1, %2" : "=v"(r) : "v"(a), "v"(b)); return r; }
__device__ __forceinline__ void pad16(float (&a)[16]) {
    asm volatile("s_nop 1" : "+v"(a[0]), "+v"(a[1]), "+v"(a[2]), "+v"(a[3]), "+v"(a[4]), "+v"(a[5]), "+v"(a[6]), "+v"(a[7]), "+v"(a[8]), "+v"(a[9]), "+v"(a[10]), "+v"(a[11]), "+v"(a[12]), "+v"(a[13]), "+v"(a[14]), "+v"(a[15]));
}
__device__ __forceinline__ void sort16_desc(float (&a)[16]) {
#pragma unroll
    for (int k = 2; k <= 16; k <<= 1)
#pragma unroll
        for (int j = k >> 1; j > 0; j >>= 1)
#pragma unroll
            for (int i = 0; i < 16; ++i) { const int l = i ^ j; if (l > i) { const bool desc = ((i & k) == 0); const float hi_ = vmax2(a[i], a[l]), lo_ = vmin2(a[i], a[l]); a[i] = desc ? hi_ : lo_; a[l] = desc ? lo_ : hi_; } }
}
__device__ __forceinline__ void merge16_desc(float (&a)[16], const float (&b)[16]) {
#pragma unroll
    for (int i = 0; i < 16; ++i) a[i] = vmax2(a[i], b[15 - i]);
#pragma unroll
    for (int j = 8; j > 0; j >>= 1)
#pragma unroll
        for (int i = 0; i < 16; ++i) { const int l = i ^ j; if (l > i) { const float hi_ = vmax2(a[i], a[l]), lo_ = vmin2(a[i], a[l]); a[i] = hi_; a[l] = lo_; } }
}
__device__ __forceinline__ void top16_of_64(float (&g0)[16], float (&g1)[16], float (&g2)[16], float (&g3)[16]) {
    sort16_desc(g0); sort16_desc(g1); merge16_desc(g0, g1); sort16_desc(g2); sort16_desc(g3); merge16_desc(g2, g3); merge16_desc(g0, g2);
}
__device__ __forceinline__ float embed(float v, unsigned mask, unsigned id) { return __builtin_bit_cast(float, (__builtin_bit_cast(unsigned, v) & mask) | id); }
__device__ __forceinline__ float mkcand(float x, float y, unsigned id) { return embed(x + y, 0xFFFFFF00u, id); }

__device__ __forceinline__ void swap32(float& a, float& b) { asm volatile("v_nop\n\tv_nop\n\tv_permlane32_swap_b32 %0, %1" : "+v"(a), "+v"(b)); }
struct RouteP { const bf16* QP; const bf16* keys; int* EX; float* GW; };
constexpr int RT_KP = 144, RT_KEYS = 0, RT_SCR = 256 * RT_KP, RT_END = RT_SCR + 8 * 8192;
__device__ __forceinline__ void route_phase(const RouteP& P, LAS unsigned char* lds, int tid, int wave, int lane, int vcu, int G) {
    asm volatile("" : "+v"(tid), "+v"(lane));
    __syncthreads();
    for (int c = tid; c < 256 * 8; c += 512) { const int row = c >> 3, part = c & 7; *(LAS u32x4*)(lds + RT_KEYS + row * RT_KP + part * 16) = *(const u32x4*)(P.keys + row * 64 + part * 8); }
    __syncthreads();
    const int r32 = lane & 31, hi = lane >> 5;
    LAS int* scr = (LAS int*)(lds + RT_SCR + wave * 8192);
    for (int u = vcu; u < T / 32; u += G) {
        const size_t t = (size_t)u * 32 + r32; const int h = wave;
        float T2[2][16];
#pragma unroll
        for (int c = 0; c < 2; ++c) {
            bf16x8 qf[4];
            { const bf16* q = P.QP + t * 1024 + h * 128 + c * 64 + 8 * hi;
#pragma unroll
              for (int s = 0; s < 4; ++s) qf[s] = *(const bf16x8*)(q + 16 * s); }
            f32x16 sc[4];
#pragma unroll
            for (int m = 0; m < 4; ++m) {
#pragma unroll
                for (int r = 0; r < 16; ++r) sc[m][r] = 0.f;
#pragma unroll
                for (int s = 0; s < 4; ++s) { const bf16x8 a = *(const LAS bf16x8*)(lds + RT_KEYS + (c * 128 + 32 * m + r32) * RT_KP + s * 32 + hi * 16);
                    sc[m] = __builtin_amdgcn_mfma_f32_32x32x16_bf16(a, qf[s], sc[m], 0, 0, 0); }
            }
            float g0[16], g1[16], g2[16], g3[16];
            const unsigned h4 = 4u * (unsigned)hi;
#pragma unroll
            for (int r = 0; r < 16; ++r) { const unsigned kr_ = (unsigned)((r & 3) + 8 * (r >> 2));
                g0[r] = embed(sc[0][r], 0xFFFFFF80u, kr_ | h4); g1[r] = embed(sc[1][r], 0xFFFFFF80u, (32u + kr_) | h4); g2[r] = embed(sc[2][r], 0xFFFFFF80u, (64u + kr_) | h4); g3[r] = embed(sc[3][r], 0xFFFFFF80u, (96u + kr_) | h4); }
            top16_of_64(g0, g1, g2, g3);
            pad16(g0);
#pragma unroll
            for (int i = 0; i < 16; ++i) T2[c][i] = g0[i];
        }
        float A[16], Bv[16];
#pragma unroll
        for (int i = 0; i < 16; ++i) { A[i] = T2[0][i]; Bv[i] = T2[1][i]; swap32(A[i], Bv[i]); }
        merge16_desc(A, Bv);
        pad16(A);
        float T0[16], T1[16];
#pragma unroll
        for (int i = 0; i < 16; ++i) { T0[i] = A[i]; T1[i] = A[i]; swap32(T0[i], T1[i]); }
#pragma unroll
        for (int i = 0; i < 16; ++i) { scr[i * 64 + lane] = (int)(__builtin_bit_cast(unsigned, T0[i]) & 127u); scr[(16 + i) * 64 + lane] = (int)(__builtin_bit_cast(unsigned, T1[i]) & 127u);
            T0[i] = embed(T0[i], 0xFFFFFF80u, 0u); T1[i] = embed(T1[i], 0xFFFFFF80u, 0u); }
        float c0[16], c1[16], c2[16], c3[16];
        const float NINF = -__builtin_inff();
#pragma unroll
        for (int b = 0; b < 16; ++b) c0[b] = mkcand(T0[0], T1[b], (unsigned)b);
#pragma unroll
        for (int b = 0; b < 8; ++b) c1[b] = mkcand(T0[1], T1[b], 16u + b);
#pragma unroll
        for (int b = 0; b < 5; ++b) c1[8 + b] = mkcand(T0[2], T1[b], 32u + b);
#pragma unroll
        for (int b = 0; b < 3; ++b) c1[13 + b] = mkcand(T0[4], T1[b], 64u + b);
#pragma unroll
        for (int b = 0; b < 4; ++b) c2[b] = mkcand(T0[3], T1[b], 48u + b);
        c2[4] = mkcand(T0[5], T1[0], 80u); c2[5] = mkcand(T0[5], T1[1], 81u); c2[6] = mkcand(T0[6], T1[0], 96u); c2[7] = mkcand(T0[6], T1[1], 97u); c2[8] = mkcand(T0[7], T1[0], 112u); c2[9] = mkcand(T0[7], T1[1], 113u);
#pragma unroll
        for (int a = 8; a < 14; ++a) c2[10 + a - 8] = mkcand(T0[a], T1[0], 16u * a);
        c3[0] = mkcand(T0[14], T1[0], 224u); c3[1] = mkcand(T0[15], T1[0], 240u);
#pragma unroll
        for (int i = 2; i < 16; ++i) c3[i] = NINF;
        top16_of_64(c0, c1, c2, c3);
        pad16(c0);
        float gsum = 0.f, ge[16]; int ex[16];
        const float mtop = embed(c0[0], 0xFFFFFF00u, 0u);
#pragma unroll
        for (int i = 0; i < 16; ++i) { const unsigned bits = __builtin_bit_cast(unsigned, c0[i]); const int a = (bits >> 4) & 15, b = bits & 15;
            ge[i] = __builtin_amdgcn_exp2f((embed(c0[i], 0xFFFFFF00u, 0u) - mtop) * LOG2E); gsum += ge[i];
            ex[i] = scr[a * 64 + lane] * 128 + scr[(16 + b) * 64 + lane]; }
        const float ginv = __builtin_amdgcn_rcpf(gsum);
        if (hi == 0) { GAS v4u* d = (GAS v4u*)(P.EX + t * 128 + h * 16);
#pragma unroll
            for (int i = 0; i < 4; ++i) d[i] = (v4u){(unsigned)ex[4 * i], (unsigned)ex[4 * i + 1], (unsigned)ex[4 * i + 2], (unsigned)ex[4 * i + 3]}; }
        else { GAS f32x4* d = (GAS f32x4*)(P.GW + t * 128 + h * 16);
#pragma unroll
            for (int i = 0; i < 4; ++i) d[i] = (f32x4){ge[4 * i] * ginv, ge[4 * i + 1] * ginv, ge[4 * i + 2] * ginv, ge[4 * i + 3] * ginv}; }
    }
}

typedef __bf16 bf16x2_t __attribute__((ext_vector_type(2)));
__device__ __forceinline__ float dot2bf(unsigned a, unsigned b, float c) { return __builtin_amdgcn_fdot2_f32_bf16(__builtin_bit_cast(bf16x2_t, a), __builtin_bit_cast(bf16x2_t, b), c, false); }
__device__ __forceinline__ float wave_allsum(float v) {
    v += __builtin_bit_cast(float, __builtin_amdgcn_update_dpp(0, __builtin_bit_cast(int, v), 0xB1, 0xF, 0xF, true));
    v += __builtin_bit_cast(float, __builtin_amdgcn_update_dpp(0, __builtin_bit_cast(int, v), 0x4E, 0xF, 0xF, true));
    v += __builtin_bit_cast(float, __builtin_amdgcn_update_dpp(0, __builtin_bit_cast(int, v), 0x141, 0xF, 0xF, true));
    v += __builtin_bit_cast(float, __builtin_amdgcn_update_dpp(0, __builtin_bit_cast(int, v), 0x140, 0xF, 0xF, true));
    { float a = v, b = v; asm volatile("v_nop\n\tv_nop\n\tv_permlane16_swap_b32 %0, %1" : "+v"(a), "+v"(b)); v = a + b; }
    { float a = v, b = v; swap32(a, b); v = a + b; }
    return v;
}
struct PeerP { const bf16* XN; const int* EX; const float* GW; const bf16* U; const bf16* V; float* X; };
__device__ __forceinline__ void peer_phase(const PeerP& P, int gw, int NGW, int lane) {
    asm volatile("" : "+v"(lane));
    for (int t = gw; t < T; t += NGW) {
        const v4u h0 = *(const GAS v4u*)(P.XN + (size_t)t * 1024 + 8 * lane), h1 = *(const GAS v4u*)(P.XN + (size_t)t * 1024 + 512 + 8 * lane);
        float o[16];
#pragma unroll
        for (int i = 0; i < 16; ++i) o[i] = 0.f;
#pragma unroll 1
        for (int half = 0; half < 2; ++half) {
            const int ev = P.EX[(size_t)t * 128 + 64 * half + lane]; const float gv = P.GW[(size_t)t * 128 + 64 * half + lane];
#pragma unroll 4
            for (int j = 0; j < 64; ++j) {
                const int e = __builtin_amdgcn_readlane(ev, j); const float g = __builtin_bit_cast(float, __builtin_amdgcn_readlane(__builtin_bit_cast(int, gv), j));
                const bf16* ur = P.U + (size_t)e * 1024 + 8 * lane; const bf16* vr = P.V + (size_t)e * 1024 + 8 * lane;
                const v4u u0 = *(const GAS v4u*)ur, u1 = *(const GAS v4u*)(ur + 512), v0 = *(const GAS v4u*)vr, v1 = *(const GAS v4u*)(vr + 512);
                float p = dot2bf(u0.x, h0.x, 0.f); p = dot2bf(u0.y, h0.y, p); p = dot2bf(u0.z, h0.z, p); p = dot2bf(u0.w, h0.w, p);
                p = dot2bf(u1.x, h1.x, p); p = dot2bf(u1.y, h1.y, p); p = dot2bf(u1.z, h1.z, p); p = dot2bf(u1.w, h1.w, p);
                p = wave_allsum(p);
                const float w = g * gelu_erf(p);
                o[0] += w * bflo(v0.x); o[1] += w * bfhi(v0.x); o[2] += w * bflo(v0.y); o[3] += w * bfhi(v0.y); o[4] += w * bflo(v0.z); o[5] += w * bfhi(v0.z); o[6] += w * bflo(v0.w); o[7] += w * bfhi(v0.w);
                o[8] += w * bflo(v1.x); o[9] += w * bfhi(v1.x); o[10] += w * bflo(v1.y); o[11] += w * bfhi(v1.y); o[12] += w * bflo(v1.z); o[13] += w * bfhi(v1.z); o[14] += w * bflo(v1.w); o[15] += w * bfhi(v1.w);
            }
        }
        GAS f32x4* xr = (GAS f32x4*)(P.X + (size_t)t * 1024 + 8 * lane);
        xr[0] += (f32x4){o[0], o[1], o[2], o[3]}; xr[1] += (f32x4){o[4], o[5], o[6], o[7]};
        xr[128] += (f32x4){o[8], o[9], o[10], o[11]}; xr[129] += (f32x4){o[12], o[13], o[14], o[15]};
    }
}

struct Args { const float* in[33]; float* out; unsigned char* ws; int ph_lo, ph_hi; };
struct Frame { LAS unsigned char* lds; volatile LAS unsigned* MISC; gu32* ctl; int tid, lane, wave, G, vcu; };

__device__ __forceinline__ void transpose_item(const float* W, int ldw, int nsrc0, bf16* WT, int ldt, int rdst0, LAS float* scr, int kb, int nb, int lane, float scale, const float* kgain) {
    const int k0 = 64 * kb, n0 = 32 * nb;
#pragma unroll 8
    for (int i = 0; i < 32; ++i) { const int kk = 2 * i + (lane >> 5); const float gsc = kgain ? kgain[k0 + kk] * scale : scale; scr[kk * 33 + (lane & 31)] = W[(size_t)(k0 + kk) * ldw + nsrc0 + n0 + (lane & 31)] * gsc; }
    LDS_WAIT(); asm volatile("" ::: "memory");
    const int c = lane & 7;
#pragma unroll
    for (int j = 0; j < 4; ++j) { const int n = (lane >> 3) + 8 * j; const LAS float* s = scr + (8 * c) * 33 + n;
        v4u o; o.x = pk2(s[0 * 33], s[1 * 33]); o.y = pk2(s[2 * 33], s[3 * 33]); o.z = pk2(s[4 * 33], s[5 * 33]); o.w = pk2(s[6 * 33], s[7 * 33]);
        *(GAS v4u*)(WT + (size_t)(rdst0 + n0 + n) * ldt + k0 + 8 * c) = o; }
    LDS_WAIT(); asm volatile("" ::: "memory");
}
__device__ __forceinline__ void zero_rect(bf16* base, int ld, int row0, int nrows, int col0, int ncols, int gtid, int gthreads) {
    const int vpr = ncols / 8;
    for (int i = gtid; i < nrows * vpr; i += gthreads) { const int r = i / vpr, c = i % vpr; *(GAS v4u*)(base + (size_t)(row0 + r) * ld + col0 + 8 * c) = (v4u){0u, 0u, 0u, 0u}; }
}

__device__ __forceinline__ void p0_prologue(Frame& F, const Args& a) {
    LAS float* scr = (LAS float*)(F.lds + RING_OFF + F.wave * 16384);
    const int gw = blockIdx.x * NWAVES + F.wave, NGW = F.G * NWAVES;
    const int gtid = blockIdx.x * (NWAVES * 64) + F.tid, gthreads = F.G * NWAVES * 64;
    unsigned char* ws = a.ws;
    { const GAS f32x4* src = (const GAS f32x4*)a.in[0]; GAS f32x4* dst = (GAS f32x4*)a.out; const size_t n4 = (size_t)T * D / 4;
      for (size_t i = gtid; i < n4; i += (size_t)gthreads) dst[i] = src[i]; }
    constexpr int I_IN = 16 * (INW / 32), I_SQ = 16 * 32, I_CKV = 16 * 64, I_UQ = 3 * 12, I_UKV = 2 * 16, I_L = I_IN + 4 * I_SQ + I_CKV + I_UQ + I_UKV;
    for (int it = gw; it < L * I_L; it += NGW) {
        const int l = it / I_L; int r = it % I_L;
        if (r < I_IN) {
            const int kb = r / 67, nb = r % 67; int src, dst; float sc = 1.f;
            if (nb < 6) { src = 32 * nb; dst = src; } else if (nb < 11) { src = 32 * nb; dst = src + 64; } else { src = 32 * nb; dst = src + 160; if (nb >= 43 && nb < 51) sc = 0.17677669529663687f * LOG2E; }
            transpose_item(a.in[5] + (size_t)l * D * INW, INW, src, (bf16*)(ws + WS_WIN) + (size_t)l * INP * D, D, dst, scr, kb, 0, F.lane, sc, nullptr); continue; } r -= I_IN;
        if (r < I_SQ) { transpose_item(a.in[21] + (size_t)l * D * D, D, 0, (bf16*)(ws + WS_WOUT) + (size_t)l * D * D, D, 0, scr, r / 32, r % 32, F.lane, 1.f, nullptr); continue; } r -= I_SQ;
        if (r < I_SQ) { transpose_item(a.in[24] + (size_t)l * D * D, D, 0, (bf16*)(ws + WS_WCQ) + (size_t)l * D * D, D, 0, scr, r / 32, r % 32, F.lane, 0.0625f * LOG2E, nullptr); continue; } r -= I_SQ;
        if (r < I_SQ) { transpose_item(a.in[26] + (size_t)l * D * D, D, 0, (bf16*)(ws + WS_WCO) + (size_t)l * D * D, D, 0, scr, r / 32, r % 32, F.lane, 1.f, nullptr); continue; } r -= I_SQ;
        if (r < I_SQ) { transpose_item(a.in[28] + (size_t)l * D * D, D, 0, (bf16*)(ws + WS_WPQ) + (size_t)l * D * D, D, 0, scr, r / 32, r % 32, F.lane, 1.f, nullptr); continue; } r -= I_SQ;
        if (r < I_CKV) { transpose_item(a.in[25] + (size_t)l * D * 2 * D, 2 * D, 0, (bf16*)(ws + WS_WCKV) + (size_t)l * 2 * D * D, D, 0, scr, r / 64, r % 64, F.lane, 1.f, nullptr); continue; } r -= I_CKV;
        if (r < I_UQ) { transpose_item(a.in[7] + (size_t)l * 192 * 384, 384, 0, (bf16*)(ws + WS_WUQ) + (size_t)l * 512 * 256, 256, 0, scr, r / 12, r % 12, F.lane, 0.10206207261596575f * LOG2E, a.in[6] + l * 192); continue; } r -= I_UQ;
        transpose_item(a.in[9] + (size_t)l * 128 * 512, 512, 0, (bf16*)(ws + WS_WUKV) + (size_t)l * 512 * 256, 256, 0, scr, r / 16, r % 16, F.lane, 1.f, a.in[8] + l * 128);
    }
    for (int l = 0; l < L; ++l) {
        bf16* win = (bf16*)(ws + WS_WIN) + (size_t)l * INP * D; bf16* wuq = (bf16*)(ws + WS_WUQ) + (size_t)l * 512 * 256; bf16* wukv = (bf16*)(ws + WS_WUKV) + (size_t)l * 512 * 256;
        zero_rect(win, D, 192, 64, 0, D, gtid, gthreads); zero_rect(win, D, 416, 96, 0, D, gtid, gthreads);
        zero_rect(wuq, 256, 0, 384, 192, 64, gtid, gthreads); zero_rect(wuq, 256, 384, 128, 0, 256, gtid, gthreads);
        zero_rect(wukv, 256, 0, 512, 128, 128, gtid, gthreads);
    }
    { float* rope = (float*)(ws + WS_ROPE); const int* pos = (const int*)a.in[2];
      for (int i = gtid; i < T * 16; i += gthreads) { const int t = i >> 4, k = i & 15; const float inv = powf(10000.f, -(float)(2 * k) / 32.f); const float ang = (float)pos[t] * inv;
          rope[(size_t)t * 32 + k] = cosf(ang); rope[(size_t)t * 32 + 16 + k] = sinf(ang); } }
    { const GAS f32x4* ks = (const GAS f32x4*)a.in[29]; GAS v2u* kd = (GAS v2u*)(ws + WS_KEYS);
      for (int i = gtid; i < L * 2 * 128 * 64 / 4; i += gthreads) { const f32x4 v = ks[i]; v2u w; w.x = pk2(v.x, v.y); w.y = pk2(v.z, v.w); kd[i] = w; }
      const size_t n8 = (size_t)L * 16384 * 1024 / 8;
      const GAS f32x4* us = (const GAS f32x4*)a.in[30]; const GAS f32x4* vs = (const GAS f32x4*)a.in[31]; GAS v4u* ud = (GAS v4u*)(ws + WS_U16); GAS v4u* vd = (GAS v4u*)(ws + WS_V16);
      for (size_t i = gtid; i < n8; i += (size_t)gthreads) {
          const f32x4 a0 = us[2 * i], a1 = us[2 * i + 1], b0 = vs[2 * i], b1 = vs[2 * i + 1];
          v4u w; w.x = pk2(a0.x, a0.y); w.y = pk2(a0.z, a0.w); w.z = pk2(a1.x, a1.y); w.w = pk2(a1.z, a1.w); ud[i] = w;
          v4u z; z.x = pk2(b0.x, b0.y); z.y = pk2(b0.z, b0.w); z.z = pk2(b1.x, b1.y); z.w = pk2(b1.z, b1.w); vd[i] = z; } }
    { float* btab = (float*)(ws + WS_BTAB); float* lams = (float*)(ws + WS_LAMS); float* spt = (float*)(ws + WS_SP);
      for (int i = gtid; i < 4 * 129; i += gthreads) { const int h = i / 129, n = i % 129; int bu; if (n < 16) bu = n; else { const int lg = 16 + (int)(logf((float)n / 16.f) / logf(8.f) * 16.f); bu = lg < 31 ? lg : 31; }
          btab[i] = a.in[3][bu * 4 + h] * LOG2E; }
      for (int i = gtid; i < L; i += gthreads) { const float* dl = a.in[17] + i * 128; float s1 = 0.f, s2 = 0.f; for (int j = 0; j < 32; ++j) { s1 += dl[j] * dl[32 + j]; s2 += dl[64 + j] * dl[96 + j]; }
          const float li = 0.8f - 0.6f * expf(-0.3f * (float)i); lams[2 * i] = expf(s1) - expf(s2) + li; lams[2 * i + 1] = li; }
      for (int i = gtid; i < L * 512; i += gthreads) spt[i] = log1pf(expf(-a.in[16][i])); }
    for (int l = 0; l < L; ++l) norm_phase(a.in[1], a.in[23] + l * D, (bf16*)(ws + WS_MNB) + (size_t)l * NB * MEM * D, NB * MEM, gw, NGW, F.lane);
}

constexpr int NPL = 16, PH_FINAL = 2 + NPL * L;
__global__ void __launch_bounds__(NWAVES * 64, 2) fwd(Args args) {
    extern __shared__ __attribute__((aligned(16))) unsigned char lds[];
    Frame F;
    F.lds = (LAS unsigned char*)lds; F.MISC = (volatile LAS unsigned*)(F.lds + MISC_OFF);
    F.tid = threadIdx.x; F.lane = F.tid & 63; F.wave = __builtin_amdgcn_readfirstlane(F.tid >> 6); F.G = gridDim.x;
    F.vcu = (F.G % 8 == 0) ? ((int)blockIdx.x % 8) * (F.G / 8) + (int)blockIdx.x / 8 : (int)blockIdx.x;
    unsigned char* ws = args.ws;
    F.ctl = (gu32*)(opq(ws) + WS_CTL);
    for (int u = F.tid; u < (LDS_BYTES - LDSCTL_OFF) / 4; u += NWAVES * 64) ((LAS unsigned*)(F.lds + LDSCTL_OFF))[u] = 0u;
    __syncthreads();
    XcdBarrier bar = xcd_barrier_post((unsigned*)(F.ctl + CW_BAR), F.MISC + 8);
    const int lo = args.ph_lo, hi = args.ph_hi;
    const int gw = blockIdx.x * NWAVES + F.wave, NGW = F.G * NWAVES;
#define IN(k) (lo <= (k) && (k) < hi)
#define LANE_ (lane_id_v())
#define TID_ ((opqi(F.wave) << 6) | LANE_)
#define SITE() const int G_ = opqi(F.G), wv_ = opqi(F.wave), vcu_ = opqi(F.vcu), gw_ = opqi(gw), NGW_ = opqi(NGW); (void)G_; (void)wv_; (void)vcu_; (void)gw_; (void)NGW_
#define SEAM(k) do { if (IN(k) && IN((k) + 1)) xcd_barrier(bar, (F.wave == 0 && lane_id_v() == 0) ? 1 : 0); } while (0)
#define GEMM_SITE(EPI, Aptr, lda_, Bptr, ldb_, M_, N_, K_, cperm, ...) do { \
        pg8::Gemm g{opq(Aptr), opq(Bptr), M_, N_, K_, lda_, ldb_}; pg8::StaticOrder So; So.init(M_, N_, opqi(F.G), opqi(cperm)); pg8::EPI E{__VA_ARGS__}; \
        pg8::gemm_phase<pg8::EPI, pg8::StaticOrder, true, true>(F.lds + RING_OFF, g, So, E, opqi(F.wave)); } while (0)
    if (IN(0)) { p0_prologue(F, args); }
    SEAM(0);
    if (IN(1)) {
#pragma unroll 1
        for (int l = 0; l < L; ++l)
            GEMM_SITE(EpiBf16, (const bf16*)(opq(ws) + WS_MNB) + (size_t)l * NB * MEM * D, D, (const bf16*)(opq(ws) + WS_WCKV) + (size_t)l * 2 * D * D, D, NB * MEM, 2 * D, D, (int)((blockIdx.x + 64 * l) % F.G),
                      opq((bf16*)(opq(ws) + WS_KVCB) + (size_t)l * NB * MEM * 2 * D), 2 * D, 2 * D);
    }
    SEAM(1);
    for (int l = 0; l < L; ++l) {
        const int pb = 2 + NPL * l;
        const bf16* XNB = (const bf16*)(opq(ws) + WS_XNB); const bf16* YB = (const bf16*)(opq(ws) + WS_YB); bf16* PROJB = (bf16*)(opq(ws) + WS_PROJB);
        if (IN(pb + 0)) { SITE(); norm_phase(args.out, args.in[opqi(4)] + l * D, opq((bf16*)(opq(ws) + WS_XNB)), T, gw_, NGW_, LANE_); }
        SEAM(pb + 0);
        if (IN(pb + 1)) GEMM_SITE(EpiBf16, XNB, D, (const bf16*)(opq(ws) + WS_WIN) + (size_t)l * INP * D, D, T, INP, D, (int)blockIdx.x, opq(PROJB), INP, INP);
        SEAM(pb + 1);
        if (IN(pb + 2)) {
            SITE();
            pre_phase(opq((const bf16*)PROJB), opq((const float*)(opq(ws) + WS_ROPE)), opq((float*)(opq(ws) + WS_RS)), opq((bf16*)(opq(ws) + WS_KMB)), gw_, NGW_, LANE_);
            LruP LP{opq((const bf16*)PROJB), args.in[opqi(10)] + l * 4 * 512, args.in[opqi(11)] + l * 512, args.in[opqi(12)] + (size_t)l * 8 * 4096, args.in[opqi(13)] + l * 512, args.in[opqi(14)] + (size_t)l * 8 * 4096, args.in[opqi(15)] + l * 512,
                    (const float*)(opq(ws) + WS_SP) + l * 512, opq((bf16*)(opq(ws) + WS_HLB)), opq((bf16*)(opq(ws) + WS_ACB)), opq((float*)(opq(ws) + WS_LSUM))};
            lru_phase(LP, F.lds, TID_, wv_, LANE_, vcu_, G_);
        }
        SEAM(pb + 2);
        if (IN(pb + 3)) {
            GEMM_SITE(EpiUp, (const bf16*)PROJB + PC_CQ, INP, (const bf16*)(opq(ws) + WS_WUQ) + (size_t)l * 512 * 256, 256, T, 512, 256, (int)blockIdx.x,
                      opq((bf16*)(opq(ws) + WS_QMB)), nullptr, 384, 384, opq((const float*)(opq(ws) + WS_RS)), 0, 0);
            GEMM_SITE(EpiUp, (const bf16*)PROJB + PC_CKV, INP, (const bf16*)(opq(ws) + WS_WUKV) + (size_t)l * 512 * 256, 256, T, 512, 256, (int)blockIdx.x,
                      opq((bf16*)(opq(ws) + WS_KMB)), opq((bf16*)(opq(ws) + WS_VMB)), 0, 512, opq((const float*)(opq(ws) + WS_RS)), 1, 1);
        }
        SEAM(pb + 3);
        if (IN(pb + 4)) {
            SITE();
            AttnP PM{opq((const bf16*)(opq(ws) + WS_QMB)), opq((const bf16*)(opq(ws) + WS_KMB)), opq((const bf16*)(opq(ws) + WS_VMB)), 384, 384, 256, opq((bf16*)(opq(ws) + WS_OMB)), 256, opq((const float*)(opq(ws) + WS_ROPE)), nullptr, nullptr, nullptr, nullptr};
            AttnP PD{opq((const bf16*)PROJB + PC_QD), opq((const bf16*)PROJB + PC_KD), opq((const bf16*)PROJB + PC_VD), INP, INP, INP, opq((bf16*)(opq(ws) + WS_YB) + 768), 1024, nullptr,
                     (const int*)args.in[opqi(2)], (const float*)(opq(ws) + WS_BTAB), args.in[opqi(18)] + l * 64, (const float*)(opq(ws) + WS_LAMS) + 2 * l};
            attn_phase(PM, PD, F.lds, TID_, wv_, LANE_, vcu_, G_);
        }
        SEAM(pb + 4);
        if (IN(pb + 5)) {
            SITE();
            PostP PP{opq((const bf16*)(opq(ws) + WS_OMB)), opq((const bf16*)(opq(ws) + WS_HLB)), opq((const bf16*)(opq(ws) + WS_ACB)), opq((const float*)(opq(ws) + WS_LSUM)), opq((const bf16*)PROJB), args.in[opqi(19)] + l * 256, args.in[opqi(20)] + l * 512, opq((bf16*)(opq(ws) + WS_YB))};
            post_phase(PP, F.lds, TID_, wv_, LANE_, vcu_, G_);
        }
        SEAM(pb + 5);
        if (IN(pb + 6)) GEMM_SITE(EpiF32, YB, D, (const bf16*)(opq(ws) + WS_WOUT) + (size_t)l * D * D, D, T, D, D, (int)blockIdx.x, args.out, D, D, 1);
        SEAM(pb + 6);
        if (IN(pb + 7)) { SITE(); norm_phase(args.out, args.in[opqi(22)] + l * D, opq((bf16*)(opq(ws) + WS_XNB)), T, gw_, NGW_, LANE_); }
        SEAM(pb + 7);
        if (IN(pb + 8)) GEMM_SITE(EpiBf16, XNB, D, (const bf16*)(opq(ws) + WS_WCQ) + (size_t)l * D * D, D, T, D, D, (int)blockIdx.x, opq(PROJB), D, D);
        SEAM(pb + 8);
        if (IN(pb + 9)) {
            SITE();
            const bf16* kv = (const bf16*)(opq(ws) + WS_KVCB) + (size_t)l * NB * MEM * 2 * D;
            AttnP PC{opq((const bf16*)PROJB), opq(kv), opq(kv + D), 1024, 2 * D, 2 * D, opq((bf16*)(opq(ws) + WS_YB)), 1024, nullptr, nullptr, nullptr, nullptr, nullptr};
            cross_phase(PC, F.lds, TID_, wv_, LANE_, vcu_, G_);
        }
        SEAM(pb + 9);
        if (IN(pb + 10)) GEMM_SITE(EpiF32, YB, D, (const bf16*)(opq(ws) + WS_WCO) + (size_t)l * D * D, D, T, D, D, (int)blockIdx.x, args.out, D, D, 1);
        SEAM(pb + 10);
        if (IN(pb + 11)) { SITE(); norm_phase(args.out, args.in[opqi(27)] + l * D, opq((bf16*)(opq(ws) + WS_XNB)), T, gw_, NGW_, LANE_); }
        SEAM(pb + 11);
        if (IN(pb + 12)) GEMM_SITE(EpiBf16, XNB, D, (const bf16*)(opq(ws) + WS_WPQ) + (size_t)l * D * D, D, T, D, D, (int)blockIdx.x, opq(PROJB), D, D);
        SEAM(pb + 12);
        if (IN(pb + 13)) {
            SITE();
            RouteP RP{opq((const bf16*)PROJB), opq((const bf16*)(opq(ws) + WS_KEYS) + (size_t)l * 2 * 128 * 64), opq((int*)(opq(ws) + WS_EX)), opq((float*)(opq(ws) + WS_GW))};
            route_phase(RP, F.lds, TID_, wv_, LANE_, vcu_, G_);
        }
        SEAM(pb + 13);
        if (IN(pb + 14)) {
            SITE();
            PeerP EP{opq(XNB), opq((const int*)(opq(ws) + WS_EX)), opq((const float*)(opq(ws) + WS_GW)), opq((const bf16*)(opq(ws) + WS_U16) + (size_t)l * 16384 * 1024), opq((const bf16*)(opq(ws) + WS_V16) + (size_t)l * 16384 * 1024), args.out};
            peer_phase(EP, gw_, NGW_, LANE_);
        }
        SEAM(pb + 14);
    }
    if (IN(PH_FINAL)) { SITE(); final_norm_phase(args.out, args.in[opqi(32)], T, gw_, NGW_, LANE_); }
#undef IN
#undef SEAM
#undef GEMM_SITE
}
}
extern "C" void kernel_launch(void* const* d_in, const int* in_sizes, int n_in, void* d_out, int out_size, void* d_ws, size_t ws_size, hipStream_t stream) {
    (void)in_sizes; (void)out_size;
    static int grid = 0;
    if (grid == 0) {
        int dev = 0, cus = 0, per_cu = 0;
        if (n_in != 33 || ws_size < mk::WS_END) { fprintf(stderr, "kernel_launch: unexpected n_in %d / ws_size %zu\n", n_in, ws_size); grid = -1; return; }
        if (hipGetDevice(&dev) != hipSuccess || hipDeviceGetAttribute(&cus, hipDeviceAttributeMultiprocessorCount, dev) != hipSuccess) { grid = -1; return; }
        if (hipFuncSetAttribute((const void*)mk::fwd, hipFuncAttributeMaxDynamicSharedMemorySize, mk::LDS_BYTES) != hipSuccess) { fprintf(stderr, "kernel_launch: hipFuncSetAttribute failed\n"); grid = -1; return; }
        if (hipOccupancyMaxActiveBlocksPerMultiprocessor(&per_cu, (const void*)mk::fwd, mk::NWAVES * 64, mk::LDS_BYTES) != hipSuccess || per_cu < 1) fprintf(stderr, "kernel_launch: occupancy query says %d\n", per_cu);
        (void)hipGetLastError();
        grid = cus;
    }
    if (grid < 0) return;
    unsigned char* ws = (unsigned char*)d_ws;
    (void)hipMemsetAsync(ws + mk::WS_CTL, 0, mk::CTL_ZERO_BYTES, stream);
    mk::Args a{};
    for (int i = 0; i < 33; ++i) a.in[i] = (const float*)d_in[i];
    a.out = (float*)d_out; a.ws = ws;
    auto run = [&](int lo, int hi) { a.ph_lo = lo; a.ph_hi = hi; hipLaunchKernelGGL(mk::fwd, dim3(grid), dim3(mk::NWAVES * 64), mk::LDS_BYTES, stream, a); };
#if MK_ONE_LAUNCH
    run(0, mk::PH_FINAL + 1);
#else
    for (int p = 0; p <= mk::PH_FINAL; ++p) {
        const int k = (p - 2) % mk::NPL, l = (p - 2) / mk::NPL; if (p >= 2 && p < mk::PH_FINAL && k == 15) continue;
#if MK_NAIVE_PEER == 2
        if (p >= 2 && p < mk::PH_FINAL && k == 14) {
            hipLaunchKernelGGL(k_peer, dim3(T), dim3(256), 0, stream, (const bf16_t*)(ws + mk::WS_XNB), (const int*)(ws + mk::WS_EX), (const float*)(ws + mk::WS_GW), (const float*)d_in[30] + (size_t)l * NEXP * D, (const float*)d_in[31] + (size_t)l * NEXP * D, (float*)d_out);
            continue; }
#elif MK_NAIVE_PEER == 1
        if (p >= 2 && p < mk::PH_FINAL && k == 13) {
            float* TQ = (float*)(ws + (size_t)806 * mk::MiB);
            hipLaunchKernelGGL(k_bf2f, dim3((unsigned)(((size_t)T * D + 255) / 256)), dim3(256), 0, stream, (const bf16_t*)(ws + mk::WS_PROJB), TQ, (long)T * D);
            hipLaunchKernelGGL(k_route, dim3(T), dim3(256), 0, stream, TQ, (const float*)d_in[29] + (size_t)l * 2 * 128 * 64, (int*)(ws + mk::WS_EX), (float*)(ws + mk::WS_GW));
            hipLaunchKernelGGL(k_peer, dim3(T), dim3(256), 0, stream, (const bf16_t*)(ws + mk::WS_XNB), (const int*)(ws + mk::WS_EX), (const float*)(ws + mk::WS_GW), (const float*)d_in[30] + (size_t)l * NEXP * D, (const float*)d_in[31] + (size_t)l * NEXP * D, (float*)d_out);
            continue; }
        if (p >= 2 && p < mk::PH_FINAL && k == 14) continue;
#endif
        run(p, p + 1); }
#endif
}
```

```cpp
#include <hip/hip_runtime.h>
#include <cstdint>
#include <cstdio>
#include <cmath>

#ifndef MK_ONE_LAUNCH
#define MK_ONE_LAUNCH 1
#endif
#ifndef MK_NAIVE_PEER
#define MK_NAIVE_PEER 0
#endif
namespace pg8 {
#define PG8_LAS __attribute__((address_space(3)))
typedef unsigned short bf16_t;
typedef short bf16x8 __attribute__((ext_vector_type(8)));
typedef float f32x4 __attribute__((ext_vector_type(4)));
typedef unsigned u32x4 __attribute__((ext_vector_type(4)));
typedef unsigned u32x2 __attribute__((ext_vector_type(2)));
constexpr int BM = 256, BK = 64, HALF = 128, HTB = HALF * BK * 2, STAGE_BYTES = 8 * HTB, NXCD = 8, WGM = 8;
__host__ __device__ __forceinline__ int lds_byte(int r, int c) { const int st = (r >> 4) * 2 + (c >> 5), rr = r & 15, cc = c & 31, ob = rr * 64 + cc * 2; return st * 1024 + (ob ^ (((ob >> 9) & 1) << 5)); }
__host__ __device__ __forceinline__ void stage_rc(int b, int& R, int& C) { const int st = b / 1024, sb = b % 1024, swz = sb ^ (((sb >> 9) & 1) << 5); R = (st >> 1) * 16 + swz / 64; C = (st & 1) * 32 + (swz % 64) / 2; }
__host__ __device__ __forceinline__ int perm32(int rho) { const int n = rho >> 4, i = rho & 15; return 8 * (i >> 2) + 4 * n + (i & 3); }
__device__ __forceinline__ int pg8_lane_id() { int l; asm volatile("v_mbcnt_lo_u32_b32 %0, -1, 0\n\tv_mbcnt_hi_u32_b32 %0, -1, %0" : "=v"(l)); return l; }
struct Unit { int pm, pn; };
struct Gemm { const bf16_t* A; const bf16_t* Bt; int M, N, K, lda, ldb; };
struct StaticOrder {
    int nM, nN, nwg, G, c;
    __host__ __device__ void init(int M, int N, int G_, int c_) { nM = M / BM; nN = N / BM; nwg = nM * nN; G = G_; c = c_; }
    __host__ __device__ bool next(int i, Unit& u) const {
        const long L = (long)i * G + c; if (L >= nwg) return false;
        int wgid = (int)L; { const int q = nwg / NXCD, r = nwg % NXCD, xcd = wgid % NXCD, off = wgid / NXCD; wgid = (xcd < r ? xcd * (q + 1) : r * (q + 1) + (xcd - r) * q) + off; }
        const int nig = WGM * nN, gid = wgid / nig, fm = gid * WGM, gsz = (nM - fm) < WGM ? (nM - fm) : WGM;
        u.pm = fm + ((wgid % nig) % gsz); u.pn = (wgid % nig) / gsz; return true;
    }
    __device__ __forceinline__ void a_ready(const Unit&) const {}
    __device__ __forceinline__ void done(const Unit&) const {}
};
__device__ __forceinline__ unsigned cvt_pk_bf16(float lo, float hi) { unsigned r; asm volatile("v_cvt_pk_bf16_f32 %0, %1, %2" : "=v"(r) : "v"(lo), "v"(hi)); return r; }

struct EpiF32 {
    static constexpr bool PERM = false, AFTER_DRAIN = false;
    float* C; int ldc; int nvalid; int accum;
    __device__ __forceinline__ void operator()(const f32x4 (&acc)[2][2][4][2], const Unit& u, int wr, int wc, int fr, int fq) const {
        asm volatile("" : "+v"(fr), "+v"(fq));
#pragma unroll
        for (int ai = 0; ai < 2; ++ai)
#pragma unroll
            for (int m = 0; m < 4; ++m) { const size_t row = (size_t)u.pm * BM + ai * HALF + wr * 64 + m * 16 + fr;
#pragma unroll
                for (int bj = 0; bj < 2; ++bj)
#pragma unroll
                    for (int n = 0; n < 2; ++n) { const int col = u.pn * BM + bj * HALF + wc * 32 + n * 16 + 4 * fq;
                        if (col < nvalid) { float* p = C + row * ldc + col; f32x4 v = acc[ai][bj][m][n]; if (accum) v += *(const f32x4*)p; *(f32x4*)p = v; } } }
    }
};
struct EpiBf16 {
    static constexpr bool PERM = true, AFTER_DRAIN = false;
    bf16_t* O; int ldc; int nvalid;
    __device__ __forceinline__ void operator()(const f32x4 (&acc)[2][2][4][2], const Unit& u, int wr, int wc, int fr, int fq) const {
        asm volatile("" : "+v"(fr), "+v"(fq));
#pragma unroll
        for (int ai = 0; ai < 2; ++ai)
#pragma unroll
            for (int m = 0; m < 4; ++m) { const size_t row = (size_t)u.pm * BM + ai * HALF + wr * 64 + m * 16 + fr;
#pragma unroll
                for (int bj = 0; bj < 2; ++bj) { const int col = u.pn * BM + bj * HALF + wc * 32 + 8 * fq;
                    if (col < nvalid) { const f32x4 v0 = acc[ai][bj][m][0], v1 = acc[ai][bj][m][1]; u32x4 w; w.x = cvt_pk_bf16(v0[0], v0[1]); w.y = cvt_pk_bf16(v0[2], v0[3]); w.z = cvt_pk_bf16(v1[0], v1[1]); w.w = cvt_pk_bf16(v1[2], v1[3]);
                        *(u32x4*)(O + row * ldc + col) = w; } } }
    }
};
struct EpiUp {
    static constexpr bool PERM = true, AFTER_DRAIN = false;
    bf16_t* O; bf16_t* O2; int ldc; int nvalid; const float* rs; int rsi; int mode;
    __device__ __forceinline__ void operator()(const f32x4 (&acc)[2][2][4][2], const Unit& u, int wr, int wc, int fr, int fq) const {
        asm volatile("" : "+v"(fr), "+v"(fq));
#pragma unroll
        for (int ai = 0; ai < 2; ++ai)
#pragma unroll
            for (int m = 0; m < 4; ++m) { const size_t row = (size_t)u.pm * BM + ai * HALF + wr * 64 + m * 16 + fr; const float s = rs[2 * row + rsi];
#pragma unroll
                for (int bj = 0; bj < 2; ++bj) { const int col = u.pn * BM + bj * HALF + wc * 32 + 8 * fq;
                    if (col < nvalid) { const f32x4 v0 = acc[ai][bj][m][0] * s, v1 = acc[ai][bj][m][1] * s; u32x4 w; w.x = cvt_pk_bf16(v0[0], v0[1]); w.y = cvt_pk_bf16(v0[2], v0[3]); w.z = cvt_pk_bf16(v1[0], v1[1]); w.w = cvt_pk_bf16(v1[2], v1[3]);
                        bf16_t* dst;
                        if (mode == 0) dst = O + row * ldc + col;
                        else { const int h = col >> 7, j = col & 127; dst = (j < 64) ? O + row * 384 + h * 96 + j : O2 + row * 256 + h * 64 + (j - 64); }
                        *(u32x4*)dst = w; } } }
    }
};
template <class Epi, class Sched, bool ALIGN_EPI = false, bool SP2 = false>
__device__ __forceinline__ void gemm_phase(PG8_LAS unsigned char* lds, const Gemm g, const Sched& S, const Epi& E, int wave_id) {
    int tid_ = (wave_id << 6) | pg8_lane_id(); asm volatile("" : "+v"(tid_));
    const int tid = tid_, wid = __builtin_amdgcn_readfirstlane(tid >> 6), lane = tid & 63, wr = wid >> 2, wc = wid & 3, fr = lane & 15, fq = lane >> 4;
    const int K = g.K, nt = K / BK;
    unsigned voffA[2], voffB[2];
#pragma unroll
    for (int i = 0; i < 2; ++i) { int R, C; stage_rc(tid * 16 + i * 8192, R, C); const int Rb = Epi::PERM ? ((R & ~31) + perm32(R & 31)) : R;
        voffA[i] = (unsigned)(R * g.lda + C) * 2u; voffB[i] = (unsigned)(Rb * g.ldb + C) * 2u; }
    const size_t kstep = (size_t)(BK * 2);
    const size_t hstepA = (size_t)HALF * g.lda * 2, hstepB = (size_t)HALF * g.ldb * 2;
    const size_t tstepA = 2 * hstepA, tstepB = 2 * hstepB;
    const unsigned ldsw = (unsigned)wid * 1024u;
    const int aoff = lds_byte(wr * 64 + fr, fq * 8), boff = lds_byte(wc * 32 + fr, fq * 8);
#define PG8_SA(b, h) (((b) * 2 + (h)) * HTB)
#define PG8_SB(b, h) ((4 + (b) * 2 + (h)) * HTB)
#define PG8_STAGE(bufoff, gbase, voff) do { _Pragma("unroll") for (int _i = 0; _i < 2; ++_i) \
        __builtin_amdgcn_global_load_lds((const unsigned*)((const char*)(gbase) + (voff)[_i]), (PG8_LAS unsigned*)(lds + (bufoff) + ldsw + _i * 8192), 16, 0, 0); } while (0)
#define PG8_LDA(dst, b, h) do { _Pragma("unroll") for (int m = 0; m < 4; ++m) _Pragma("unroll") for (int k = 0; k < 2; ++k) dst[m][k] = *(const PG8_LAS bf16x8*)(lds + PG8_SA(b, h) + aoff + m * 2048 + k * 1024); } while (0)
#define PG8_LDB(dst, b, h) do { _Pragma("unroll") for (int n = 0; n < 2; ++n) _Pragma("unroll") for (int k = 0; k < 2; ++k) dst[n][k] = *(const PG8_LAS bf16x8*)(lds + PG8_SB(b, h) + boff + n * 2048 + k * 1024); } while (0)
#define PG8_MMA(ai, bj, At, Bt) do { __builtin_amdgcn_s_setprio(1); _Pragma("unroll") for (int m = 0; m < 4; ++m) _Pragma("unroll") for (int n = 0; n < 2; ++n) _Pragma("unroll") for (int k = 0; k < 2; ++k) \
        acc[ai][bj][m][n] = __builtin_amdgcn_mfma_f32_16x16x32_bf16(Bt[n][k], At[m][k], acc[ai][bj][m][n], 0, 0, 0); __builtin_amdgcn_s_setprio(0); } while (0)
#define PG8_WAIT_V(n) asm volatile("s_waitcnt vmcnt(" #n ")" ::: "memory")
#define PG8_WAIT_L(n) asm volatile("s_waitcnt lgkmcnt(" #n ")" ::: "memory")
#define PG8_BAR __builtin_amdgcn_s_barrier()
#define PG8_SCHED __builtin_amdgcn_sched_barrier(0)
    Unit cur, nxt; int ui = 0;
    if (!S.next(0, cur)) return;
    f32x4 acc[2][2][4][2];
#pragma unroll
    for (int a = 0; a < 2; ++a)
#pragma unroll
        for (int b = 0; b < 2; ++b)
#pragma unroll
            for (int m = 0; m < 4; ++m)
#pragma unroll
                for (int n = 0; n < 2; ++n) acc[a][b][m][n] = (f32x4){0.f, 0.f, 0.f, 0.f};
    bf16x8 At[4][2], B0[2][2], B1[2][2];
    const char* cA = (const char*)g.A + (size_t)cur.pm * tstepA; const char* cB = (const char*)g.Bt + (size_t)cur.pn * tstepB;
    S.a_ready(cur);
    if constexpr (SP2) {
        PG8_STAGE(PG8_SB(0, 0), cB, voffB); PG8_STAGE(PG8_SB(0, 1), cB + hstepB, voffB); PG8_STAGE(PG8_SA(0, 0), cA, voffA); PG8_STAGE(PG8_SA(0, 1), cA + hstepA, voffA);
        if (wr == 1) PG8_BAR;
        PG8_WAIT_V(2); PG8_BAR;
        PG8_STAGE(PG8_SB(1, 0), cB + kstep, voffB); PG8_STAGE(PG8_SA(1, 0), cA + kstep, voffA); PG8_STAGE(PG8_SB(1, 1), cB + hstepB + kstep, voffB);
        PG8_WAIT_V(6); PG8_BAR;
    } else {
        PG8_STAGE(PG8_SB(0, 0), cB, voffB); PG8_STAGE(PG8_SA(0, 0), cA, voffA); PG8_STAGE(PG8_SB(0, 1), cB + hstepB, voffB); PG8_STAGE(PG8_SA(0, 1), cA + hstepA, voffA);
        if (wr == 1) PG8_BAR;
        PG8_WAIT_V(4); PG8_BAR;
        PG8_STAGE(PG8_SB(1, 0), cB + kstep, voffB); PG8_STAGE(PG8_SA(1, 0), cA + kstep, voffA); PG8_STAGE(PG8_SB(1, 1), cB + hstepB + kstep, voffB);
        PG8_WAIT_V(6); PG8_BAR;
    }
    for (;;) {
        const bool has_next = S.next(ui + 1, nxt);
        const char* nA = has_next ? (const char*)g.A + (size_t)nxt.pm * tstepA : cA; const char* nB = has_next ? (const char*)g.Bt + (size_t)nxt.pn * tstepB : cB;
        for (int t = 0; t < nt; t += 2) {
            const bool last = (t == nt - 2);
            const char* a1 = cA + (size_t)(t + 1) * kstep;
            const char* a2 = last ? nA : cA + (size_t)(t + 2) * kstep; const char* b2 = last ? nB : cB + (size_t)(t + 2) * kstep;
            const char* a3 = a2 + kstep; const char* b3 = b2 + kstep;
            if (last && has_next) S.a_ready(nxt);
            if constexpr (SP2) {
            PG8_LDB(B0, 0, 0); PG8_LDB(B1, 0, 1); PG8_SCHED; PG8_LDA(At, 0, 0); PG8_STAGE(PG8_SA(1, 1), a1 + hstepA, voffA);
            PG8_WAIT_V(8); PG8_WAIT_L(0); PG8_BAR; PG8_MMA(0, 0, At, B0); PG8_MMA(0, 1, At, B1); PG8_BAR; PG8_SCHED;
            PG8_LDA(At, 0, 1); PG8_STAGE(PG8_SB(0, 0), b2, voffB); PG8_STAGE(PG8_SB(0, 1), b2 + hstepB, voffB); PG8_STAGE(PG8_SA(0, 0), a2, voffA);
            PG8_WAIT_V(8); PG8_WAIT_L(0); PG8_BAR; PG8_MMA(1, 0, At, B0); PG8_MMA(1, 1, At, B1); PG8_BAR; PG8_SCHED;
            PG8_LDB(B0, 1, 0); PG8_LDB(B1, 1, 1); PG8_SCHED; PG8_LDA(At, 1, 0); PG8_STAGE(PG8_SA(0, 1), a2 + hstepA, voffA);
            PG8_WAIT_V(8); PG8_WAIT_L(0); PG8_BAR; PG8_MMA(0, 0, At, B0); PG8_MMA(0, 1, At, B1); PG8_BAR; PG8_SCHED;
            PG8_LDA(At, 1, 1); PG8_STAGE(PG8_SB(1, 0), b3, voffB); PG8_STAGE(PG8_SB(1, 1), b3 + hstepB, voffB); PG8_STAGE(PG8_SA(1, 0), a3, voffA);
            PG8_WAIT_V(8); PG8_WAIT_L(0); PG8_BAR; PG8_MMA(1, 0, At, B0); PG8_MMA(1, 1, At, B1); PG8_BAR; PG8_SCHED;
            } else {
            PG8_LDB(B0, 0, 0); PG8_SCHED; PG8_LDA(At, 0, 0); PG8_STAGE(PG8_SA(1, 1), a1 + hstepA, voffA);
            PG8_WAIT_L(8); PG8_BAR; PG8_WAIT_L(0); PG8_MMA(0, 0, At, B0); PG8_BAR; PG8_SCHED;
            PG8_LDB(B1, 0, 1); PG8_STAGE(PG8_SB(0, 0), b2, voffB);
            PG8_BAR; PG8_WAIT_L(0); PG8_MMA(0, 1, At, B1); PG8_BAR;
            PG8_LDA(At, 0, 1); PG8_STAGE(PG8_SA(0, 0), a2, voffA);
            PG8_BAR; PG8_WAIT_L(0); PG8_MMA(1, 0, At, B0); PG8_BAR; PG8_SCHED;
            PG8_STAGE(PG8_SB(0, 1), b2 + hstepB, voffB);
            PG8_WAIT_V(6); PG8_BAR; PG8_MMA(1, 1, At, B1); PG8_BAR;
            PG8_LDB(B0, 1, 0); PG8_SCHED; PG8_LDA(At, 1, 0); PG8_STAGE(PG8_SA(0, 1), a2 + hstepA, voffA);
            PG8_WAIT_L(8); PG8_BAR; PG8_WAIT_L(0); PG8_MMA(0, 0, At, B0); PG8_BAR; PG8_SCHED;
            PG8_LDB(B1, 1, 1); PG8_STAGE(PG8_SB(1, 0), b3, voffB);
            PG8_BAR; PG8_WAIT_L(0); PG8_MMA(0, 1, At, B1); PG8_BAR;
            PG8_LDA(At, 1, 1); PG8_STAGE(PG8_SA(1, 0), a3, voffA);
            PG8_BAR; PG8_WAIT_L(0); PG8_MMA(1, 0, At, B0); PG8_BAR; PG8_SCHED;
            PG8_STAGE(PG8_SB(1, 1), b3 + hstepB, voffB);
            PG8_WAIT_V(6); PG8_BAR; PG8_MMA(1, 1, At, B1); PG8_BAR;
            }
        }
        if constexpr (ALIGN_EPI) { if (wr == 0) PG8_BAR; }
        if constexpr (!Epi::AFTER_DRAIN) { E(acc, cur, wr, wc, fr, fq); S.done(cur); }
        if (!has_next) break;
#pragma unroll
        for (int a = 0; a < 2; ++a)
#pragma unroll
            for (int b = 0; b < 2; ++b)
#pragma unroll
                for (int m = 0; m < 4; ++m)
#pragma unroll
                    for (int n = 0; n < 2; ++n) acc[a][b][m][n] = (f32x4){0.f, 0.f, 0.f, 0.f};
        cur = nxt; cA = nA; cB = nB; ++ui;
        if constexpr (ALIGN_EPI) { if (wr == 1) PG8_BAR; }
    }
    PG8_WAIT_V(0);
    if constexpr (!ALIGN_EPI) { if (wr == 0) PG8_BAR; }
    PG8_BAR;
    if constexpr (Epi::AFTER_DRAIN) { E.fused(acc, cur, wr, wc, fr, fq, lds, wid, lane); S.done(cur); }
#undef PG8_SA
#undef PG8_SB
#undef PG8_STAGE
#undef PG8_LDA
#undef PG8_LDB
#undef PG8_MMA
#undef PG8_WAIT_V
#undef PG8_WAIT_L
#undef PG8_BAR
#undef PG8_SCHED
}
}

namespace mk {
#define GAS __attribute__((address_space(1)))
#define LAS __attribute__((address_space(3)))
typedef unsigned short bf16;
typedef unsigned v4u __attribute__((ext_vector_type(4)));
typedef unsigned v2u __attribute__((ext_vector_type(2)));
typedef float f32x4 __attribute__((ext_vector_type(4)));
typedef GAS unsigned gu32;
#define LDS_WAIT() asm volatile("s_waitcnt lgkmcnt(0)" ::: "memory")
#define VM_WAIT() asm volatile("s_waitcnt vmcnt(0)" ::: "memory")
__device__ __forceinline__ unsigned f2bf_(float f) { unsigned u = __builtin_bit_cast(unsigned, f); return (u + 0x7fffu + ((u >> 16) & 1u)) >> 16; }
__device__ __forceinline__ unsigned pk2(float lo, float hi) { return f2bf_(lo) | (f2bf_(hi) << 16); }
__device__ __forceinline__ float bflo(unsigned w) { return __builtin_bit_cast(float, w << 16); }
__device__ __forceinline__ float bfhi(unsigned w) { return __builtin_bit_cast(float, w & 0xffff0000u); }

template <class P> __device__ __forceinline__ P* opq(P* p) { asm volatile("" : "+s"(p)); return p; }
__device__ __forceinline__ int opqi(int k) { asm volatile("" : "+s"(k)); return k; }
__device__ __forceinline__ float shx(float v, int o, int lane) { return __builtin_bit_cast(float, __builtin_amdgcn_ds_bpermute((lane ^ o) << 2, __builtin_bit_cast(int, v))); }
__device__ __forceinline__ int shxi(int v, int o, int lane) { return __builtin_amdgcn_ds_bpermute((lane ^ o) << 2, v); }
__device__ __forceinline__ int lane_id_v() { int l; asm volatile("v_mbcnt_lo_u32_b32 %0, -1, 0\n\tv_mbcnt_hi_u32_b32 %0, -1, %0" : "=v"(l)); return l; }
constexpr int NWAVES = 8;
constexpr int D = 1024, NB = 4, S = 8192, T = NB * S, L = 4, MEM = 256, INW = 2144, INP = 2304;
constexpr int PC_CQ = 0, PC_CKV = 256, PC_KR = 384, PC_XL = 512, PC_GL = 1024, PC_QD = 1536, PC_KD = 1792, PC_VD = 2048;
constexpr float LOG2E = 1.4426950408889634f;
constexpr size_t MiB = 1u << 20;
constexpr size_t WS_CTL = 0, CTL_ZERO_BYTES = 1 * MiB;
constexpr size_t WS_WIN = 1 * MiB, WS_WOUT = 19 * MiB, WS_WCQ = 27 * MiB, WS_WCO = 35 * MiB, WS_WPQ = 43 * MiB, WS_WCKV = 51 * MiB, WS_WUQ = 67 * MiB, WS_WUKV = 68 * MiB, WS_KEYS = 69 * MiB, WS_ROPE = 70 * MiB;
constexpr size_t WS_XNB = 76 * MiB, WS_YB = 140 * MiB, WS_PROJB = 204 * MiB, WS_QMB = 348 * MiB, WS_KMB = 372 * MiB, WS_VMB = 396 * MiB, WS_RS = 412 * MiB;
constexpr size_t WS_HLB = 413 * MiB, WS_ACB = 445 * MiB, WS_LSUM = 477 * MiB, WS_OMB = 478 * MiB, WS_MNB = 494 * MiB, WS_KVCB = 502 * MiB, WS_EX = 518 * MiB, WS_GW = 534 * MiB;
constexpr size_t WS_U8 = 550 * MiB, WS_V8 = 614 * MiB, WS_SU = 678 * MiB, WS_SV = 679 * MiB;
constexpr size_t WS_END = 680 * MiB;
constexpr size_t WS_BTAB = WS_KEYS + 512 * 1024, WS_LAMS = WS_BTAB + 4096, WS_SP = WS_LAMS + 4096;
constexpr int CW_BAR = 4096;
constexpr int RING_OFF = 0, RING_BYTES = 131072, LDSCTL_OFF = RING_BYTES, MISC_OFF = LDSCTL_OFF + 320, LDS_BYTES = 147456;

#define XB_TMO      128
#define XB_XCNT(j)  (256  + 64 * (j))
#define XB_XSUB(j)  (1280 + 64 * (j))
#define XB_XGEN(j)  (2304 + 64 * (j))
#define XB_TOP      3328
#define XB_TOPGEN   3392
#define XCD_BAR_WORDS 3456
#define XB_SPIN_CAP (1u << 18)

__device__ __forceinline__ unsigned xb_ld(unsigned* p)              { return __hip_atomic_load(p, __ATOMIC_RELAXED, __HIP_MEMORY_SCOPE_AGENT); }
__device__ __forceinline__ unsigned xb_add(unsigned* p, unsigned v) { return __hip_atomic_fetch_add(p, v, __ATOMIC_RELAXED, __HIP_MEMORY_SCOPE_AGENT); }
__device__ __forceinline__ unsigned xb_xcc_id() { return (unsigned)__builtin_amdgcn_s_getreg((3 << 11) | 20) & 0xFu; }
#define XB_SPIN(cond, bar) do { unsigned _sp = 0; while (cond) { __builtin_amdgcn_s_sleep(1); \
    if ((++_sp & 255u) == 0u) { if (xb_ld(&(bar)[XB_TMO])) break; if (_sp > XB_SPIN_CAP) { atomicAdd(&(bar)[XB_TMO], 1u); break; } } } } while (0)

struct XcdBarrier {
    unsigned* bar; unsigned x;
    volatile LAS unsigned* st;
};

__device__ __forceinline__ XcdBarrier xcd_barrier_post(unsigned* bar, volatile LAS unsigned* st) {
    XcdBarrier b; b.bar = bar; b.x = xb_xcc_id(); b.st = st;
    if (threadIdx.x == 0) (void)xb_add(&bar[XB_XCNT(b.x)], 1u);
    return b;
}
__device__ __forceinline__ void xcd_barrier_complete(unsigned* bar, unsigned x, unsigned& nloc, unsigned& nx) {
    const unsigned G = gridDim.x * gridDim.y * gridDim.z;
    unsigned sum, cnt, mine, sp = 0u;
    for (;;) {
        sum = 0u; cnt = 0u; mine = 0u;
#pragma unroll
        for (unsigned j = 0; j < 16; ++j) { const unsigned c = xb_ld(&bar[XB_XCNT(j)]); sum += c; cnt += (c > 0u) ? 1u : 0u; mine = (j == x) ? c : mine; }
        if (sum == G) break;
        __builtin_amdgcn_s_sleep(1);
        if ((++sp & 255u) == 0u) { if (xb_ld(&bar[XB_TMO])) break; if (sp > XB_SPIN_CAP) { atomicAdd(&bar[XB_TMO], 1u); break; } }
    }
    nloc = mine > 0u ? mine : 1u; nx = cnt > 0u ? cnt : 1u;
}

__device__ __noinline__ void xcd_barrier_impl(unsigned* bar_, unsigned x_, volatile LAS unsigned* st_, int leader_) {
    XcdBarrier b; b.bar = bar_; b.x = x_; b.st = st_;
    asm volatile("s_waitcnt vmcnt(0)" ::: "memory");
    __syncthreads();
    if (leader_) {
        unsigned* bar = b.bar;
        __builtin_amdgcn_s_waitcnt(0);
        unsigned nloc = b.st[0], nx = b.st[1];
        if (nloc == 0u) { xcd_barrier_complete(bar, b.x, nloc, nx); b.st[0] = nloc; b.st[1] = nx; }
        const unsigned old = xb_add(&bar[XB_XSUB(b.x)], 1u);
        const unsigned gen = old / nloc;
        if (old + 1u == (gen + 1u) * nloc) {
            __builtin_amdgcn_fence(__ATOMIC_RELEASE, "agent");
            asm volatile("s_waitcnt vmcnt(0)" ::: "memory");
            const unsigned og = xb_add(&bar[XB_TOP], 1u);
            const unsigned tg = og / nx;
            if (og + 1u == (tg + 1u) * nx) xb_add(&bar[XB_TOPGEN], 1u);
            else XB_SPIN(xb_ld(&bar[XB_TOPGEN]) == tg, bar);
            __builtin_amdgcn_fence(__ATOMIC_ACQUIRE, "agent");
            xb_add(&bar[XB_XGEN(b.x)], 1u);
            asm volatile("s_waitcnt vmcnt(0)" ::: "memory");
        } else {
            XB_SPIN(xb_ld(&bar[XB_XGEN(b.x)]) == gen, bar);
            __builtin_amdgcn_fence(__ATOMIC_ACQUIRE, "agent");
            asm volatile("s_waitcnt vmcnt(0)" ::: "memory");
        }
    }
    __syncthreads();
}
__device__ __forceinline__ void xcd_barrier(const XcdBarrier& b, int leader) { xcd_barrier_impl(b.bar, b.x, b.st, leader); }


__device__ __forceinline__ float wave_sum(float v, int lane) {
#pragma unroll
    for (int o = 1; o < 64; o <<= 1) v += shx(v, o, lane);
    return v;
}
__device__ __forceinline__ float gelu_erf(float v) {
    const float av = __builtin_fabsf(v), t = __builtin_amdgcn_rcpf(av * 0.2316418882f + 1.0f);
    float q = t * 0.5307027145f + (-0.7265760135f); q = q * t + 0.7107068705f; q = q * t + (-0.142248368f); q = q * t + 0.127414796f; q = q * t;
    const float e = __builtin_amdgcn_exp2f((v * v) * (-0.72134752044f));
    const float m = v * (q * e);
    return v < 0.f ? m : v - m;
}

__device__ __forceinline__ void norm_phase(const float* X, const float* g, bf16* out, int rows, int gw, int NGW, int lane) {
    asm volatile("" : "+v"(lane));
    f32x4 gv[4];
#pragma unroll
    for (int j = 0; j < 4; ++j) gv[j] = ((const GAS f32x4*)g)[lane + 64 * j];
    for (int m = gw; m < rows; m += NGW) {
        const GAS f32x4* xr = (const GAS f32x4*)(X + (size_t)m * D) + lane;
        f32x4 v[4]; float s = 0.f;
#pragma unroll
        for (int j = 0; j < 4; ++j) { v[j] = xr[64 * j]; s += (v[j].x * v[j].x + v[j].y * v[j].y) + (v[j].z * v[j].z + v[j].w * v[j].w); }
        const float rs = rsqrtf(wave_sum(s, lane) * (1.f / D) + 1e-6f);
        GAS v2u* o8 = (GAS v2u*)(out + (size_t)m * D) + lane;
#pragma unroll
        for (int j = 0; j < 4; ++j) { v2u w; w.x = pk2(v[j].x * rs * gv[j].x, v[j].y * rs * gv[j].y); w.y = pk2(v[j].z * rs * gv[j].z, v[j].w * rs * gv[j].w); o8[64 * j] = w; }
    }
}
__device__ __forceinline__ void final_norm_phase(float* X, const float* g, int rows, int gw, int NGW, int lane) {
    asm volatile("" : "+v"(lane));
    for (int m = gw; m < rows; m += NGW) {
        GAS f32x4* xr = (GAS f32x4*)(X + (size_t)m * D) + lane;
        f32x4 v[4]; float s = 0.f;
#pragma unroll
        for (int j = 0; j < 4; ++j) { v[j] = xr[64 * j]; s += (v[j].x * v[j].x + v[j].y * v[j].y) + (v[j].z * v[j].z + v[j].w * v[j].w); }
        const float rs = rsqrtf(wave_sum(s, lane) * (1.f / D) + 1e-6f);
#pragma unroll
        for (int j = 0; j < 4; ++j) { const f32x4 gj = ((const GAS f32x4*)g)[lane + 64 * j]; xr[64 * j] = v[j] * rs * gj; }
    }
}

__device__ __forceinline__ void pre_phase(const bf16* PROJB, const float* ROPE, float* RS, bf16* KMB, int gw, int NGW, int lane) {
    asm volatile("" : "+v"(lane));
    for (int t = gw; t < T; t += NGW) {
        const bf16* pr = PROJB + (size_t)t * INP;
        float sq = 0.f, skv = 0.f;
        if (lane < 24) { const v4u w = *(const GAS v4u*)(pr + PC_CQ + 8 * lane);
            const float a0 = bflo(w.x), a1 = bfhi(w.x), a2 = bflo(w.y), a3 = bfhi(w.y), a4 = bflo(w.z), a5 = bfhi(w.z), a6 = bflo(w.w), a7 = bfhi(w.w);
            sq = (a0 * a0 + a1 * a1) + (a2 * a2 + a3 * a3) + (a4 * a4 + a5 * a5) + (a6 * a6 + a7 * a7); }
        else if (lane >= 32 && lane < 48) { const v4u w = *(const GAS v4u*)(pr + PC_CKV + 8 * (lane - 32));
            const float a0 = bflo(w.x), a1 = bfhi(w.x), a2 = bflo(w.y), a3 = bfhi(w.y), a4 = bflo(w.z), a5 = bfhi(w.z), a6 = bflo(w.w), a7 = bfhi(w.w);
            skv = (a0 * a0 + a1 * a1) + (a2 * a2 + a3 * a3) + (a4 * a4 + a5 * a5) + (a6 * a6 + a7 * a7); }
        sq = wave_sum(sq, lane); skv = wave_sum(skv, lane);
        if (lane == 0) { RS[2 * (size_t)t] = rsqrtf(sq * (1.f / 192.f) + 1e-6f); RS[2 * (size_t)t + 1] = rsqrtf(skv * (1.f / 128.f) + 1e-6f); }
        if (lane < 16) {
            const float x1 = __builtin_bit_cast(float, (unsigned)pr[PC_KR + lane] << 16), x2 = __builtin_bit_cast(float, (unsigned)pr[PC_KR + 16 + lane] << 16);
            const float c = ROPE[(size_t)t * 32 + lane], sn = ROPE[(size_t)t * 32 + 16 + lane];
            const bf16 y1 = (bf16)f2bf_(x1 * c - x2 * sn), y2 = (bf16)f2bf_(x1 * sn + x2 * c);
            bf16* kr = KMB + (size_t)t * 384 + 64 + lane;
#pragma unroll
            for (int h = 0; h < 4; ++h) { kr[h * 96] = y1; kr[h * 96 + 16] = y2; }
        }
    }
}

struct LruP { const bf16* PROJB; const float* cw; const float* cb; const float* wa; const float* ba; const float* wx; const float* bx; const float* sp; bf16* HL; bf16* AC; float* LSUM; };
constexpr int LR_XP = 260;
constexpr int LR_XC = 0, LR_WA = 64 * LR_XP * 4, LR_WX = LR_WA + 16384, LR_SUM = LR_WX + 16384, LR_END = LR_SUM + 4096;
__device__ __forceinline__ void lru_phase(const LruP& P, LAS unsigned char* lds, int tid, int wave, int lane, int vcu, int G) {
    asm volatile("" : "+v"(tid), "+v"(lane));
    LAS float* xc = (LAS float*)(lds + LR_XC); LAS float* WA = (LAS float*)(lds + LR_WA); LAS float* WX = (LAS float*)(lds + LR_WX); LAS float* SUM = (LAS float*)(lds + LR_SUM);
    for (int u = vcu; u < (T / 256) * 8; u += G) {
        const int tile = u >> 3, g = u & 7; const int t0 = tile * 256; const bool first = ((tile & 31) == 0);
        __syncthreads();
#pragma unroll
        for (int i = 0; i < 2; ++i) { const int idx = tid + 512 * i; ((LAS f32x4*)WA)[idx] = ((const GAS f32x4*)(P.wa + g * 4096))[idx]; ((LAS f32x4*)WX)[idx] = ((const GAS f32x4*)(P.wx + g * 4096))[idx]; }
#pragma unroll 1
        for (int it = tid; it < 2048; it += 512) {
            const int time = it & 255, cg = it >> 8; const int ch0 = 64 * g + 8 * cg;
            float y[8];
            { const f32x4 b0 = *(const GAS f32x4*)(P.cb + ch0), b1 = *(const GAS f32x4*)(P.cb + ch0 + 4); y[0] = b0.x; y[1] = b0.y; y[2] = b0.z; y[3] = b0.w; y[4] = b1.x; y[5] = b1.y; y[6] = b1.z; y[7] = b1.w; }
#pragma unroll
            for (int k = 0; k < 4; ++k) {
                if (!(first && time - 3 + k < 0)) {
                    const v4u w = *(const GAS v4u*)(P.PROJB + (size_t)(t0 + time - 3 + k) * INP + PC_XL + ch0);
                    const f32x4 c0 = *(const GAS f32x4*)(P.cw + k * 512 + ch0), c1 = *(const GAS f32x4*)(P.cw + k * 512 + ch0 + 4);
                    y[0] += bflo(w.x) * c0.x; y[1] += bfhi(w.x) * c0.y; y[2] += bflo(w.y) * c0.z; y[3] += bfhi(w.y) * c0.w;
                    y[4] += bflo(w.z) * c1.x; y[5] += bfhi(w.z) * c1.y; y[6] += bflo(w.w) * c1.z; y[7] += bfhi(w.w) * c1.w;
                }
            }
#pragma unroll
            for (int e = 0; e < 8; ++e) xc[(8 * cg + e) * LR_XP + time] = y[e];
        }
        __syncthreads();
        float aa[32], ax[32];
        { const float b_a = P.ba[64 * g + lane], b_x = P.bx[64 * g + lane];
#pragma unroll
          for (int j = 0; j < 32; ++j) { aa[j] = b_a; ax[j] = b_x; } }
#pragma unroll 2
        for (int ci = 0; ci < 64; ++ci) {
            const float wa_ = WA[ci * 64 + lane], wx_ = WX[ci * 64 + lane];
            const LAS f32x4* xr = (const LAS f32x4*)(xc + ci * LR_XP + 32 * wave);
#pragma unroll
            for (int q = 0; q < 8; ++q) { const f32x4 xv = xr[q];
                aa[4 * q] += xv.x * wa_; aa[4 * q + 1] += xv.y * wa_; aa[4 * q + 2] += xv.z * wa_; aa[4 * q + 3] += xv.w * wa_;
                ax[4 * q] += xv.x * wx_; ax[4 * q + 1] += xv.y * wx_; ax[4 * q + 2] += xv.z * wx_; ax[4 * q + 3] += xv.w * wx_; }
        }
        { const float sp = P.sp[64 * g + lane];
          const LAS f32x4* xo = (const LAS f32x4*)(xc + lane * LR_XP + 32 * wave);
          float hrun = 0.f, arun = 1.f;
#pragma unroll
          for (int q = 0; q < 8; ++q) { const f32x4 xv = xo[q];
#pragma unroll
              for (int e = 0; e < 4; ++e) { const int j = 4 * q + e;
                  const float r = __builtin_amdgcn_rcpf(1.f + __builtin_amdgcn_exp2f(-LOG2E * aa[j])), ig = __builtin_amdgcn_rcpf(1.f + __builtin_amdgcn_exp2f(-LOG2E * ax[j]));
                  const float la = -8.0f * r * sp; const float a = __builtin_amdgcn_exp2f(LOG2E * la);
                  const float uu = __builtin_amdgcn_sqrtf(fmaxf(1.f - a * a, 0.f)) * (ig * xv[e]);
                  hrun = a * hrun + uu; arun *= a; aa[j] = arun; ax[j] = hrun; } }
          SUM[(wave * 64 + lane) * 2] = arun; SUM[(wave * 64 + lane) * 2 + 1] = hrun; }
        __syncthreads();
        float ca = 1.f, chh = 0.f;
        for (int w = 0; w < wave; ++w) { const float aw = SUM[(w * 64 + lane) * 2], hw = SUM[(w * 64 + lane) * 2 + 1]; chh = aw * chh + hw; ca *= aw; }
        { bf16* hl = P.HL + (size_t)(t0 + 32 * wave) * 512 + 64 * g + lane; bf16* ac = P.AC + (size_t)(t0 + 32 * wave) * 512 + 64 * g + lane;
#pragma unroll
          for (int j = 0; j < 32; ++j) { const float hh = ax[j] + aa[j] * chh, acc = aa[j] * ca; hl[(size_t)j * 512] = (bf16)f2bf_(hh); ac[(size_t)j * 512] = (bf16)f2bf_(acc);
              if (j == 31 && wave == 7) { P.LSUM[((size_t)tile * 512 + 64 * g + lane) * 2] = acc; P.LSUM[((size_t)tile * 512 + 64 * g + lane) * 2 + 1] = hh; } } }
    }
}

struct PostP { const bf16* OMB; const bf16* HL; const bf16* AC; const float* LSUM; const bf16* PROJB; const float* gm; const float* gl; bf16* Y; };
__device__ __forceinline__ void post_phase(const PostP& P, LAS unsigned char* lds, int tid, int wave, int lane, int vcu, int G) {
    asm volatile("" : "+v"(tid), "+v"(lane));
    LAS float* hin = (LAS float*)lds;
    for (int u = vcu; u < T / 64; u += G) {
        const int t0 = u * 64, tile = t0 >> 8, tb = tile & ~31;
        __syncthreads();
        { float h = 0.f;
          for (int c = tb; c < tile; ++c) { const float a = P.LSUM[((size_t)c * 512 + tid) * 2], hh = P.LSUM[((size_t)c * 512 + tid) * 2 + 1]; h = a * h + hh; }
          hin[tid] = h; }
        __syncthreads();
        f32x4 hi0 = *(const LAS f32x4*)(hin + 8 * lane), hi1 = *(const LAS f32x4*)(hin + 8 * lane + 4);
        const f32x4 g0 = *(const GAS f32x4*)(P.gl + 8 * lane), g1 = *(const GAS f32x4*)(P.gl + 8 * lane + 4), gmv = *(const GAS f32x4*)(P.gm + 4 * lane);
#pragma unroll 2
        for (int i = 0; i < 8; ++i) {
            const size_t t = (size_t)t0 + 8 * wave + i;
            const v4u hw = *(const GAS v4u*)(P.HL + t * 512 + 8 * lane), aw = *(const GAS v4u*)(P.AC + t * 512 + 8 * lane), gw_ = *(const GAS v4u*)(P.PROJB + t * INP + PC_GL + 8 * lane);
            const v2u mw = *(const GAS v2u*)(P.OMB + t * 256 + 4 * lane);
            float o[8];
            o[0] = (bflo(hw.x) + bflo(aw.x) * hi0.x) * gelu_erf(bflo(gw_.x)); o[1] = (bfhi(hw.x) + bfhi(aw.x) * hi0.y) * gelu_erf(bfhi(gw_.x));
            o[2] = (bflo(hw.y) + bflo(aw.y) * hi0.z) * gelu_erf(bflo(gw_.y)); o[3] = (bfhi(hw.y) + bfhi(aw.y) * hi0.w) * gelu_erf(bfhi(gw_.y));
            o[4] = (bflo(hw.z) + bflo(aw.z) * hi1.x) * gelu_erf(bflo(gw_.z)); o[5] = (bfhi(hw.z) + bfhi(aw.z) * hi1.y) * gelu_erf(bfhi(gw_.z));
            o[6] = (bflo(hw.w) + bflo(aw.w) * hi1.z) * gelu_erf(bflo(gw_.w)); o[7] = (bfhi(hw.w) + bfhi(aw.w) * hi1.w) * gelu_erf(bfhi(gw_.w));
            float s2 = 0.f;
#pragma unroll
            for (int e = 0; e < 8; ++e) s2 += o[e] * o[e];
            const float m0 = bflo(mw.x), m1 = bfhi(mw.x), m2 = bflo(mw.y), m3 = bfhi(mw.y);
            float s1 = (m0 * m0 + m1 * m1) + (m2 * m2 + m3 * m3);
            s1 = wave_sum(s1, lane); s2 = wave_sum(s2, lane);
            const float r1 = rsqrtf(s1 * (1.f / 256.f) + 1e-6f), r2 = rsqrtf(s2 * (1.f / 512.f) + 1e-6f);
            bf16* yr = P.Y + t * 1024;
            { v2u w; w.x = pk2(m0 * r1 * gmv.x, m1 * r1 * gmv.y); w.y = pk2(m2 * r1 * gmv.z, m3 * r1 * gmv.w); *(GAS v2u*)(yr + 4 * lane) = w; }
            { v4u w; w.x = pk2(o[0] * r2 * g0.x, o[1] * r2 * g0.y); w.y = pk2(o[2] * r2 * g0.z, o[3] * r2 * g0.w); w.z = pk2(o[4] * r2 * g1.x, o[5] * r2 * g1.y); w.w = pk2(o[6] * r2 * g1.z, o[7] * r2 * g1.w);
              *(GAS v4u*)(yr + 256 + 8 * lane) = w; }
        }
    }
}

typedef short bf16x8 __attribute__((ext_vector_type(8)));
typedef short s16x4 __attribute__((ext_vector_type(4)));
typedef float f32x16 __attribute__((ext_vector_type(16)));
typedef unsigned u32x4 __attribute__((ext_vector_type(4)));
__device__ __forceinline__ int crow(int r, int hi) { return (r & 3) + 8 * (r >> 2) + 4 * hi; }
typedef float f32x2_t __attribute__((ext_vector_type(2))); typedef __bf16 bf16x2_c __attribute__((ext_vector_type(2)));
__device__ __forceinline__ unsigned cvtpk(float lo, float hi) { f32x2_t v = {lo, hi}; bf16x2_c b = __builtin_convertvector(v, bf16x2_c); return __builtin_bit_cast(unsigned, b); }
__device__ __forceinline__ float swapmax(float m) { auto rr = __builtin_amdgcn_permlane32_swap(__float_as_uint(m), __float_as_uint(m), false, false); return fmaxf(__uint_as_float(rr[0]), __uint_as_float(rr[1])); }
__device__ __forceinline__ float swapadd(float m) { auto rr = __builtin_amdgcn_permlane32_swap(__float_as_uint(m), __float_as_uint(m), false, false); return __uint_as_float(rr[0]) + __uint_as_float(rr[1]); }
__device__ __forceinline__ s16x4 vtr(const LAS unsigned char* p) { return __builtin_bit_cast(s16x4, __builtin_amdgcn_ds_read_tr16_b64_v4i16((LAS s16x4*)p)); }
__device__ __forceinline__ bf16x8 pack8(const f32x16& p, int b) { u32x4 w; w.x = cvtpk(p[b], p[b + 1]); w.y = cvtpk(p[b + 2], p[b + 3]); w.z = cvtpk(p[b + 4], p[b + 5]); w.w = cvtpk(p[b + 6], p[b + 7]); return __builtin_bit_cast(bf16x8, w); }
__device__ __forceinline__ float max16(const f32x16& p) { float a = fmaxf(fmaxf(p[0], p[1]), fmaxf(p[2], p[3])), b = fmaxf(fmaxf(p[4], p[5]), fmaxf(p[6], p[7])), c = fmaxf(fmaxf(p[8], p[9]), fmaxf(p[10], p[11])), d = fmaxf(fmaxf(p[12], p[13]), fmaxf(p[14], p[15])); return fmaxf(fmaxf(a, b), fmaxf(c, d)); }

struct AttnP {
    const bf16* Q; const bf16* K; const bf16* V; int qp, kp, vp;
    bf16* O; int op;
    const float* rope;
    const int* pos; const float* btab; const float* dnorm; const float* lams;
};
template <int KIND> struct AK {
    static constexpr bool DIFF = KIND == 1, CROSS = KIND == 2;
    static constexpr int HW = KIND == 0 ? 96 : KIND == 1 ? 64 : 256;
    static constexpr int NKS = KIND == 0 ? 6 : KIND == 1 ? 2 : 16;
    static constexpr int KP = KIND == 0 ? 208 : KIND == 1 ? 144 : 528;
    static constexpr int ND = CROSS ? 4 : 2;
    static constexpr int CPK = HW / 8, KCH = (64 * CPK + 511) / 512;
    static constexpr int VCH = ND / 2;
    static constexpr int KB = 64 * KP, VB = ND * 4096;
    static constexpr int K0 = 0, V0 = 2 * KB, POS = V0 + 2 * VB, BT = POS + 512, DN = BT + 528, END = DN + 256;
};
static_assert(AK<2>::END <= RING_BYTES && AK<0>::END <= RING_BYTES, "attention LDS");

template <int KIND>
__device__ __forceinline__ void attn_unit(const AttnP& P, int b, int h, int qb, int dhalf, LAS unsigned char* lds, int tid, int wave, int lane) {
    asm volatile("" : "+v"(tid), "+v"(lane));
    typedef AK<KIND> C;
    constexpr bool DIFF = C::DIFF, CROSS = C::CROSS;
    constexpr int HW = C::HW, NKS = C::NKS, KP = C::KP, ND = C::ND, CPK = C::CPK, KCH = C::KCH, VCH = C::VCH;
    const int r32 = lane & 31, hi = lane >> 5;
    const size_t rowb = (size_t)b * S, rowk = CROSS ? (size_t)b * MEM : rowb;
    const int q0w = qb * 256 + wave * 32, qi = q0w + r32;
    int pq = 0; float bias_far = 0.f;
    __syncthreads();
    if (DIFF) {
        pq = P.pos[rowb + qi];
        if (tid < 129) ((LAS float*)(lds + C::BT))[tid] = P.btab[h * 129 + tid];
        if (tid >= 192 && tid < 256) ((LAS float*)(lds + C::DN))[tid - 192] = P.dnorm[tid - 192];
    }
    int minq = pq;
    if (DIFF) { for (int o = 1; o < 64; o <<= 1) { const int v = shxi(minq, o, lane); minq = v < minq ? v : minq; } }
    const int NT = CROSS ? MEM / 64 : 4 * (qb + 1);
    u32x4 kr[KCH], vr[VCH]; int pkr = 0;
    const bf16* Kb = P.K + rowk * P.kp + h * HW; const bf16* Vb = P.V + rowk * P.vp + (CROSS ? h * 256 + dhalf * 128 : h * 64);
    auto gload = [&](int t) {
        const int k0 = 64 * t;
#pragma unroll
        for (int i = 0; i < KCH; ++i) { const int c = tid + 512 * i; if (c < 64 * CPK) { const int key = c / CPK, part = c % CPK; kr[i] = *(const u32x4*)(Kb + (size_t)(k0 + key) * P.kp + part * 8); } }
#pragma unroll
        for (int i = 0; i < VCH; ++i) { const int c = tid + 512 * i; const int key = c / (4 * ND), part = c % (4 * ND); vr[i] = *(const u32x4*)(Vb + (size_t)(k0 + key) * P.vp + part * 8); }
        if (DIFF) { if (tid < 64) pkr = P.pos[rowb + k0 + tid]; }
    };
    auto lstore = [&](int buf) {
        LAS unsigned char* kb_ = lds + C::K0 + buf * C::KB; LAS unsigned char* vb_ = lds + C::V0 + buf * C::VB;
#pragma unroll
        for (int i = 0; i < KCH; ++i) { const int c = tid + 512 * i; if (c < 64 * CPK) { const int key = c / CPK, part = c % CPK; *(LAS u32x4*)(kb_ + key * KP + part * 16) = kr[i]; } }
#pragma unroll
        for (int i = 0; i < VCH; ++i) { const int c = tid + 512 * i; const int key = c / (4 * ND), part = c % (4 * ND); *(LAS u32x4*)(vb_ + (part >> 2) * 4096 + (key >> 3) * 512 + (key & 7) * 64 + (part & 3) * 16) = vr[i]; }
        if (DIFF) { if (tid < 64) ((LAS int*)(lds + C::POS + buf * 256))[tid] = pkr; }
    };
    f32x16 osv[2];
#pragma unroll
    for (int d = 0; d < 2; ++d)
#pragma unroll
        for (int r = 0; r < 16; ++r) osv[d][r] = 0.f;
    float il = 0.f;
    f32x16 oA[ND];
#pragma unroll 1
    for (int mp = 0; mp < (DIFF ? 2 : 1); ++mp) {
        bf16x8 qf[NKS];
        { const bf16* qrow = P.Q + (rowb + qi) * P.qp + h * HW + mp * 32;
#pragma unroll
          for (int s = 0; s < NKS; ++s) qf[s] = *(const bf16x8*)(qrow + 16 * s + 8 * hi);
          if (KIND == 0) {
              const float* rp = P.rope + (rowb + qi) * 32 + 8 * hi;
              const f32x4 c0 = *(const f32x4*)rp, c1 = *(const f32x4*)(rp + 4), s0 = *(const f32x4*)(rp + 16), s1 = *(const f32x4*)(rp + 20);
              const u32x4 a = __builtin_bit_cast(u32x4, qf[NKS - 2]), bq = __builtin_bit_cast(u32x4, qf[NKS - 1]); u32x4 ra, rb;
#pragma unroll
              for (int w = 0; w < 4; ++w) { const float cl = w < 2 ? c0[2 * w] : c1[2 * w - 4], ch = w < 2 ? c0[2 * w + 1] : c1[2 * w - 3], sl = w < 2 ? s0[2 * w] : s1[2 * w - 4], sh = w < 2 ? s0[2 * w + 1] : s1[2 * w - 3];
                  const float x1l = bflo(a[w]), x1h = bfhi(a[w]), x2l = bflo(bq[w]), x2h = bfhi(bq[w]);
                  ra[w] = cvtpk(x1l * cl - x2l * sl, x1h * ch - x2h * sh); rb[w] = cvtpk(x1l * sl + x2l * cl, x1h * sh + x2h * ch); }
              qf[NKS - 2] = __builtin_bit_cast(bf16x8, ra); qf[NKS - 1] = __builtin_bit_cast(bf16x8, rb);
          } }
        __syncthreads();
        gload(0); lstore(0);
        if (!CROSS) { if (NT > 1) gload(1); }
        __syncthreads();
        if (DIFF) bias_far = ((LAS float*)(lds + C::BT))[128];
        float m1 = -1e30f, l1 = 0.f;
#pragma unroll
        for (int d = 0; d < ND; ++d)
#pragma unroll
            for (int r = 0; r < 16; ++r) oA[d][r] = 0.f;
        for (int t = 0; t < NT; ++t) {
            const int buf = t & 1;
            if (!CROSS) { if (t + 1 < NT) { lstore(buf ^ 1); if (t + 2 < NT) gload(t + 2); } }
            const int k0 = 64 * t;
            if (CROSS || k0 <= q0w + 31) {
                const LAS unsigned char* kb_ = lds + C::K0 + buf * C::KB + r32 * KP + hi * 16 + mp * 64;
                const LAS unsigned char* vb_ = lds + C::V0 + buf * C::VB + ((lane >> 4) & 1) * 32 + (lane & 3) * 8 + (4 * hi + ((lane & 15) >> 2)) * 64;
                const bool partial = !CROSS && (k0 + 63 > q0w);
                bool nearb = false;
                if (DIFF) {
                    int mk_ = ((LAS int*)(lds + C::POS + buf * 256))[lane];
                    for (int o = 1; o < 64; o <<= 1) { const int v = shxi(mk_, o, lane); mk_ = v > mk_ ? v : mk_; }
                    nearb = (minq - mk_) < 128;
                }
                const float init = (DIFF && !nearb) ? bias_far : 0.f;
                f32x16 pa, pb;
#pragma unroll
                for (int r = 0; r < 16; ++r) { pa[r] = init; pb[r] = init; }
#pragma unroll
                for (int s = 0; s < NKS; ++s) { const bf16x8 a0 = *(const LAS bf16x8*)(kb_ + s * 32), a1 = *(const LAS bf16x8*)(kb_ + 32 * KP + s * 32);
                    pa = __builtin_amdgcn_mfma_f32_32x32x16_bf16(a0, qf[s], pa, 0, 0, 0); pb = __builtin_amdgcn_mfma_f32_32x32x16_bf16(a1, qf[s], pb, 0, 0, 0); }
                if (DIFF) { if (nearb) {
                    const LAS int* pk = (const LAS int*)(lds + C::POS + buf * 256); const LAS float* bt = (const LAS float*)(lds + C::BT);
#pragma unroll
                    for (int r = 0; r < 16; ++r) { const int kk = crow(r, hi);
                        int n0 = pq - pk[kk], n1 = pq - pk[kk + 32]; n0 = n0 < 0 ? 0 : (n0 > 128 ? 128 : n0); n1 = n1 < 0 ? 0 : (n1 > 128 ? 128 : n1);
                        pa[r] += bt[n0]; pb[r] += bt[n1]; }
                } }
                if (partial) {
#pragma unroll
                    for (int r = 0; r < 16; ++r) { const int kk = k0 + crow(r, hi); if (kk > qi) pa[r] = -1e30f; if (kk + 32 > qi) pb[r] = -1e30f; }
                }
                const float mx = swapmax(fmaxf(max16(pa), max16(pb))); const float mn = fmaxf(m1, mx); const float al = __builtin_amdgcn_exp2f(m1 - mn); m1 = mn;
                float ls = 0.f;
#pragma unroll
                for (int r = 0; r < 16; ++r) { pa[r] = __builtin_amdgcn_exp2f(pa[r] - mn); pb[r] = __builtin_amdgcn_exp2f(pb[r] - mn); ls += pa[r] + pb[r]; }
                l1 = l1 * al + ls;
                bf16x8 pf[4];
                pf[0] = pack8(pa, 0); pf[1] = pack8(pa, 8); pf[2] = pack8(pb, 0); pf[3] = pack8(pb, 8);
#pragma unroll
                for (int d = 0; d < ND; ++d) {
                    if (CROSS) __builtin_amdgcn_sched_barrier(0);
#pragma unroll
                    for (int r = 0; r < 16; ++r) oA[d][r] *= al;
#pragma unroll
                    for (int s = 0; s < 4; ++s) { const s16x4 lo = vtr(vb_ + d * 4096 + s * 1024), hh = vtr(vb_ + d * 4096 + s * 1024 + 512);
                        const bf16x8 vf = (bf16x8){lo[0], lo[1], lo[2], lo[3], hh[0], hh[1], hh[2], hh[3]};
                        oA[d] = __builtin_amdgcn_mfma_f32_32x32x16_bf16(vf, pf[s], oA[d], 0, 0, 0); }
                }
            }
            if (CROSS) { if (t + 1 < NT) { gload(t + 1); lstore(buf ^ 1); } }
            __syncthreads();
        }
        il = 1.f / swapadd(l1);
        if (DIFF) { if (mp == 0) {
#pragma unroll
            for (int d = 0; d < 2; ++d)
#pragma unroll
                for (int r = 0; r < 16; ++r) osv[d][r] = oA[d][r] * il; } }
    }
    bf16* orow = P.O + (rowb + qi) * P.op + (CROSS ? h * 256 + dhalf * 128 : h * 64);
    if (!DIFF) {
#pragma unroll
        for (int d = 0; d < ND; ++d)
#pragma unroll
            for (int g = 0; g < 4; ++g) { v2u v; v.x = cvtpk(oA[d][4 * g] * il, oA[d][4 * g + 1] * il); v.y = cvtpk(oA[d][4 * g + 2] * il, oA[d][4 * g + 3] * il); *(v2u*)(orow + 32 * d + 8 * g + 4 * hi) = v; }
    } else {
        const float lam = P.lams[0], lam_init = P.lams[1];
        const float i2 = lam * il;
        float ss = 0.f;
#pragma unroll
        for (int d = 0; d < 2; ++d)
#pragma unroll
            for (int r = 0; r < 16; ++r) { const float v = osv[d][r] - oA[d][r] * i2; oA[d][r] = v; ss += v * v; }
        ss = swapadd(ss);
        const float rs = __builtin_amdgcn_rsqf(ss * (1.f / 64.f) + 1e-6f) * (1.f - lam_init);
        const LAS float* dn = (const LAS float*)(lds + C::DN);
#pragma unroll
        for (int d = 0; d < 2; ++d)
#pragma unroll
            for (int g = 0; g < 4; ++g) { const int c = 32 * d + 8 * g + 4 * hi; const f32x4 gn = *(const LAS f32x4*)(dn + c);
                v2u v; v.x = cvtpk(oA[d][4 * g] * rs * gn[0], oA[d][4 * g + 1] * rs * gn[1]); v.y = cvtpk(oA[d][4 * g + 2] * rs * gn[2], oA[d][4 * g + 3] * rs * gn[3]); *(v2u*)(orow + c) = v; }
    }
}

__device__ __forceinline__ void attn_phase(const AttnP& PM, const AttnP& PD, LAS unsigned char* lds, int tid, int wave, int lane, int vcu, int G) {
    for (int i = vcu; i < 512; i += G) {
        const int kind = i >> 8, c = i & 255, bh = c >> 4, s = c & 15;
        if (kind == 0) {
#pragma unroll 1
            for (int k = 0; k < 2; ++k) attn_unit<0>(PM, bh >> 2, bh & 3, k ? 31 - s : s, 0, lds, tid, wave, lane);
        } else {
#pragma unroll 1
            for (int k = 0; k < 2; ++k) attn_unit<1>(PD, bh >> 2, bh & 3, k ? 31 - s : s, 0, lds, tid, wave, lane);
        }
    }
}
__device__ __forceinline__ void cross_phase(const AttnP& PC, LAS unsigned char* lds, int tid, int wave, int lane, int vcu, int G) {
#pragma unroll 1
    for (int i = vcu; i < 1024; i += G) { const int bh = i >> 6; attn_unit<2>(PC, bh >> 2, bh & 3, i & 31, (i >> 5) & 1, lds, tid, wave, lane); }
}

__device__ __forceinline__ float vmax2(float a, float b) { float r; asm("v_max_f32_e32 %0, %1, %2" : "=v"(r) : "v"(a), "v"(b)); return r; }
__device__ __forceinline__ float vmin2(float a, float b) { float r; asm("v_min_f32_e32 %0, %1, %2" : "=v"(r) : "v"(a), "v"(b)); return r; }
__device__ __forceinline__ void pad16(float (&a)[16]) {
    asm volatile("s_nop 1" : "+v"(a[0]), "+v"(a[1]), "+v"(a[2]), "+v"(a[3]), "+v"(a[4]), "+v"(a[5]), "+v"(a[6]), "+v"(a[7]), "+v"(a[8]), "+v"(a[9]), "+v"(a[10]), "+v"(a[11]), "+v"(a[12]), "+v"(a[13]), "+v"(a[14]), "+v"(a[15]));
}
__device__ __forceinline__ void sort16_desc(float (&a)[16]) {
#pragma unroll
    for (int k = 2; k <= 16; k <<= 1)
#pragma unroll
        for (int j = k >> 1; j > 0; j >>= 1)
#pragma unroll
            for (int i = 0; i < 16; ++i) { const int l = i ^ j; if (l > i) { const bool desc = ((i & k) == 0); const float hi_ = vmax2(a[i], a[l]), lo_ = vmin2(a[i], a[l]); a[i] = desc ? hi_ : lo_; a[l] = desc ? lo_ : hi_; } }
}
__device__ __forceinline__ void merge16_desc(float (&a)[16], const float (&b)[16]) {
#pragma unroll
    for (int i = 0; i < 16; ++i) a[i] = vmax2(a[i], b[15 - i]);
#pragma unroll
    for (int j = 8; j > 0; j >>= 1)
#pragma unroll
        for (int i = 0; i < 16; ++i) { const int l = i ^ j; if (l > i) { const float hi_ = vmax2(a[i], a[l]), lo_ = vmin2(a[i], a[l]); a[i] = hi_; a[l] = lo_; } }
}
__device__ __forceinline__ void top16_of_64(float (&g0)[16], float (&g1)[16], float (&g2)[16], float (&g3)[16]) {
    sort16_desc(g0); sort16_desc(g1); merge16_desc(g0, g1); sort16_desc(g2); sort16_desc(g3); merge16_desc(g2, g3); merge16_desc(g0, g2);
}
__device__ __forceinline__ float embed(float v, unsigned mask, unsigned id) { return __builtin_bit_cast(float, (__builtin_bit_cast(unsigned, v) & mask) | id); }
__device__ __forceinline__ float mkcand(float x, float y, unsigned id) { return embed(x + y, 0xFFFFFF00u, id); }

__device__ __forceinline__ void swap32(float& a, float& b) { asm volatile("v_nop\n\tv_nop\n\tv_permlane32_swap_b32 %0, %1" : "+v"(a), "+v"(b)); }
struct RouteP { const bf16* QP; const bf16* keys; int* EX; float* GW; };
constexpr int RT_KP = 144, RT_KEYS = 0, RT_SCR = 256 * RT_KP, RT_END = RT_SCR + 8 * 8192;
__device__ __forceinline__ void route_phase(const RouteP& P, LAS unsigned char* lds, int tid, int wave, int lane, int vcu, int G) {
    asm volatile("" : "+v"(tid), "+v"(lane));
    __syncthreads();
    for (int c = tid; c < 256 * 8; c += 512) { const int row = c >> 3, part = c & 7; *(LAS u32x4*)(lds + RT_KEYS + row * RT_KP + part * 16) = *(const u32x4*)(P.keys + row * 64 + part * 8); }
    __syncthreads();
    const int r32 = lane & 31, hi = lane >> 5;
    LAS int* scr = (LAS int*)(lds + RT_SCR + wave * 8192);
    for (int u = vcu; u < T / 32; u += G) {
        const size_t t = (size_t)u * 32 + r32; const int h = wave;
        float T2[2][16];
#pragma unroll
        for (int c = 0; c < 2; ++c) {
            bf16x8 qf[4];
            { const bf16* q = P.QP + t * 1024 + h * 128 + c * 64 + 8 * hi;
#pragma unroll
              for (int s = 0; s < 4; ++s) qf[s] = *(const bf16x8*)(q + 16 * s); }
            f32x16 sc[4];
#pragma unroll
            for (int m = 0; m < 4; ++m) {
#pragma unroll
                for (int r = 0; r < 16; ++r) sc[m][r] = 0.f;
#pragma unroll
                for (int s = 0; s < 4; ++s) { const bf16x8 a = *(const LAS bf16x8*)(lds + RT_KEYS + (c * 128 + 32 * m + r32) * RT_KP + s * 32 + hi * 16);
                    sc[m] = __builtin_amdgcn_mfma_f32_32x32x16_bf16(a, qf[s], sc[m], 0, 0, 0); }
            }
            float g0[16], g1[16], g2[16], g3[16];
            const unsigned h4 = 4u * (unsigned)hi;
#pragma unroll
            for (int r = 0; r < 16; ++r) { const unsigned kr_ = (unsigned)((r & 3) + 8 * (r >> 2));
                g0[r] = embed(sc[0][r], 0xFFFFFF80u, kr_ | h4); g1[r] = embed(sc[1][r], 0xFFFFFF80u, (32u + kr_) | h4); g2[r] = embed(sc[2][r], 0xFFFFFF80u, (64u + kr_) | h4); g3[r] = embed(sc[3][r], 0xFFFFFF80u, (96u + kr_) | h4); }
            top16_of_64(g0, g1, g2, g3);
            pad16(g0);
#pragma unroll
            for (int i = 0; i < 16; ++i) T2[c][i] = g0[i];
        }
        float A[16], Bv[16];
#pragma unroll
        for (int i = 0; i < 16; ++i) { A[i] = T2[0][i]; Bv[i] = T2[1][i]; swap32(A[i], Bv[i]); }
        merge16_desc(A, Bv);
        pad16(A);
        float T0[16], T1[16];
#pragma unroll
        for (int i = 0; i < 16; ++i) { T0[i] = A[i]; T1[i] = A[i]; swap32(T0[i], T1[i]); }
#pragma unroll
        for (int i = 0; i < 16; ++i) { scr[i * 64 + lane] = (int)(__builtin_bit_cast(unsigned, T0[i]) & 127u); scr[(16 + i) * 64 + lane] = (int)(__builtin_bit_cast(unsigned, T1[i]) & 127u);
            T0[i] = embed(T0[i], 0xFFFFFF80u, 0u); T1[i] = embed(T1[i], 0xFFFFFF80u, 0u); }
        float c0[16], c1[16], c2[16], c3[16];
        const float NINF = -__builtin_inff();
#pragma unroll
        for (int b = 0; b < 16; ++b) c0[b] = mkcand(T0[0], T1[b], (unsigned)b);
#pragma unroll
        for (int b = 0; b < 8; ++b) c1[b] = mkcand(T0[1], T1[b], 16u + b);
#pragma unroll
        for (int b = 0; b < 5; ++b) c1[8 + b] = mkcand(T0[2], T1[b], 32u + b);
#pragma unroll
        for (int b = 0; b < 3; ++b) c1[13 + b] = mkcand(T0[4], T1[b], 64u + b);
#pragma unroll
        for (int b = 0; b < 4; ++b) c2[b] = mkcand(T0[3], T1[b], 48u + b);
        c2[4] = mkcand(T0[5], T1[0], 80u); c2[5] = mkcand(T0[5], T1[1], 81u); c2[6] = mkcand(T0[6], T1[0], 96u); c2[7] = mkcand(T0[6], T1[1], 97u); c2[8] = mkcand(T0[7], T1[0], 112u); c2[9] = mkcand(T0[7], T1[1], 113u);
#pragma unroll
        for (int a = 8; a < 14; ++a) c2[10 + a - 8] = mkcand(T0[a], T1[0], 16u * a);
        c3[0] = mkcand(T0[14], T1[0], 224u); c3[1] = mkcand(T0[15], T1[0], 240u);
#pragma unroll
        for (int i = 2; i < 16; ++i) c3[i] = NINF;
        top16_of_64(c0, c1, c2, c3);
        pad16(c0);
        float gsum = 0.f, ge[16]; int ex[16];
        const float mtop = embed(c0[0], 0xFFFFFF00u, 0u);
#pragma unroll
        for (int i = 0; i < 16; ++i) { const unsigned bits = __builtin_bit_cast(unsigned, c0[i]); const int a = (bits >> 4) & 15, b = bits & 15;
            ge[i] = __builtin_amdgcn_exp2f((embed(c0[i], 0xFFFFFF00u, 0u) - mtop) * LOG2E); gsum += ge[i];
            ex[i] = scr[a * 64 + lane] * 128 + scr[(16 + b) * 64 + lane]; }
        const float ginv = __builtin_amdgcn_rcpf(gsum);
        if (hi == 0) { GAS v4u* d = (GAS v4u*)(P.EX + t * 128 + h * 16);
#pragma unroll
            for (int i = 0; i < 4; ++i) d[i] = (v4u){(unsigned)ex[4 * i], (unsigned)ex[4 * i + 1], (unsigned)ex[4 * i + 2], (unsigned)ex[4 * i + 3]}; }
        else { GAS f32x4* d = (GAS f32x4*)(P.GW + t * 128 + h * 16);
#pragma unroll
            for (int i = 0; i < 4; ++i) d[i] = (f32x4){ge[4 * i] * ginv, ge[4 * i + 1] * ginv, ge[4 * i + 2] * ginv, ge[4 * i + 3] * ginv}; }
    }
}

__device__ __forceinline__ int wave_allsum_i(int v) {
    v += __builtin_amdgcn_update_dpp(0, v, 0xB1, 0xF, 0xF, true);
    v += __builtin_amdgcn_update_dpp(0, v, 0x4E, 0xF, 0xF, true);
    v += __builtin_amdgcn_update_dpp(0, v, 0x141, 0xF, 0xF, true);
    v += __builtin_amdgcn_update_dpp(0, v, 0x140, 0xF, 0xF, true);
    { int a = v, b = v; asm volatile("v_nop\n\tv_nop\n\tv_permlane16_swap_b32 %0, %1" : "+v"(a), "+v"(b)); v = a + b; }
    { int a = v, b = v; asm volatile("v_nop\n\tv_nop\n\tv_permlane32_swap_b32 %0, %1" : "+v"(a), "+v"(b)); v = a + b; }
    return v;
}
__device__ __forceinline__ float wave_allmax(float v) {
    v = fmaxf(v, __builtin_bit_cast(float, __builtin_amdgcn_update_dpp(0, __builtin_bit_cast(int, v), 0xB1, 0xF, 0xF, true)));
    v = fmaxf(v, __builtin_bit_cast(float, __builtin_amdgcn_update_dpp(0, __builtin_bit_cast(int, v), 0x4E, 0xF, 0xF, true)));
    v = fmaxf(v, __builtin_bit_cast(float, __builtin_amdgcn_update_dpp(0, __builtin_bit_cast(int, v), 0x141, 0xF, 0xF, true)));
    v = fmaxf(v, __builtin_bit_cast(float, __builtin_amdgcn_update_dpp(0, __builtin_bit_cast(int, v), 0x140, 0xF, 0xF, true)));
    { float a = v, b = v; asm volatile("v_nop\n\tv_nop\n\tv_permlane16_swap_b32 %0, %1" : "+v"(a), "+v"(b)); v = fmaxf(a, b); }
    { float a = v, b = v; asm volatile("v_nop\n\tv_nop\n\tv_permlane32_swap_b32 %0, %1" : "+v"(a), "+v"(b)); v = fmaxf(a, b); }
    return v;
}
__device__ __forceinline__ unsigned q4(float a, float b, float c, float d, int off) {
    const int ia = (int)__builtin_rintf(a) + off, ib = (int)__builtin_rintf(b) + off, ic = (int)__builtin_rintf(c) + off, id = (int)__builtin_rintf(d) + off;
    return (unsigned)(ia & 255) | ((unsigned)(ib & 255) << 8) | ((unsigned)(ic & 255) << 16) | ((unsigned)(id & 255) << 24);
}
__device__ __forceinline__ void quant_row(const float* src, unsigned* dst, float* scale, int off, int lane) {
    const GAS f32x4* s = (const GAS f32x4*)src + 4 * lane; f32x4 v[4]; float m = 0.f;
#pragma unroll
    for (int i = 0; i < 4; ++i) { v[i] = s[i]; m = fmaxf(m, fmaxf(fmaxf(__builtin_fabsf(v[i].x), __builtin_fabsf(v[i].y)), fmaxf(__builtin_fabsf(v[i].z), __builtin_fabsf(v[i].w)))); }
    m = wave_allmax(m); const float inv = m > 0.f ? 127.f / m : 0.f;
    v4u w;
    w.x = q4(v[0].x * inv, v[0].y * inv, v[0].z * inv, v[0].w * inv, off); w.y = q4(v[1].x * inv, v[1].y * inv, v[1].z * inv, v[1].w * inv, off);
    w.z = q4(v[2].x * inv, v[2].y * inv, v[2].z * inv, v[2].w * inv, off); w.w = q4(v[3].x * inv, v[3].y * inv, v[3].z * inv, v[3].w * inv, off);
    *((GAS v4u*)dst + lane) = w;
    if (lane == 0) *scale = m * (1.f / 127.f);
}
struct PeerP { const bf16* XN; const int* EX; const float* GW; const unsigned char* U8; const unsigned char* V8; const float* SU; const float* SV; float* X; };
__device__ __forceinline__ void peer_phase(const PeerP& P, int gw, int NGW, int lane) {
    asm volatile("" : "+v"(lane));
    for (int t = gw; t < T; t += NGW) {
        unsigned hq[4]; float sh;
        { const v4u ha = *(const GAS v4u*)(P.XN + (size_t)t * 1024 + 16 * lane), hb = *(const GAS v4u*)(P.XN + (size_t)t * 1024 + 16 * lane + 8);
          float f[16] = {bflo(ha.x), bfhi(ha.x), bflo(ha.y), bfhi(ha.y), bflo(ha.z), bfhi(ha.z), bflo(ha.w), bfhi(ha.w), bflo(hb.x), bfhi(hb.x), bflo(hb.y), bfhi(hb.y), bflo(hb.z), bfhi(hb.z), bflo(hb.w), bfhi(hb.w)};
          float m = 0.f;
#pragma unroll
          for (int i = 0; i < 16; ++i) m = fmaxf(m, __builtin_fabsf(f[i]));
          m = wave_allmax(m); const float inv = m > 0.f ? 127.f / m : 0.f; sh = m * (1.f / 127.f);
#pragma unroll
          for (int i = 0; i < 4; ++i) hq[i] = q4(f[4 * i] * inv, f[4 * i + 1] * inv, f[4 * i + 2] * inv, f[4 * i + 3] * inv, 0); }
        float o[16], wsum = 0.f;
#pragma unroll
        for (int i = 0; i < 16; ++i) o[i] = 0.f;
#pragma unroll 1
        for (int half = 0; half < 2; ++half) {
            const int ev = P.EX[(size_t)t * 128 + 64 * half + lane]; const float gv = P.GW[(size_t)t * 128 + 64 * half + lane];
#pragma unroll 4
            for (int j = 0; j < 64; ++j) {
                const int e = __builtin_amdgcn_readlane(ev, j); const float g = __builtin_bit_cast(float, __builtin_amdgcn_readlane(__builtin_bit_cast(int, gv), j));
                const v4u uu = *(const GAS v4u*)(P.U8 + (size_t)e * 1024 + 16 * lane), vv = *(const GAS v4u*)(P.V8 + (size_t)e * 1024 + 16 * lane);
                const float su = P.SU[e], sv = P.SV[e];
                int p = __builtin_amdgcn_sdot4((int)uu.x, (int)hq[0], 0, false); p = __builtin_amdgcn_sdot4((int)uu.y, (int)hq[1], p, false); p = __builtin_amdgcn_sdot4((int)uu.z, (int)hq[2], p, false); p = __builtin_amdgcn_sdot4((int)uu.w, (int)hq[3], p, false);
                p = wave_allsum_i(p);
                const float w = g * gelu_erf((float)p * (sh * su)) * sv; wsum += w;
#pragma unroll
                for (int k = 0; k < 4; ++k) { const unsigned d = k == 0 ? vv.x : k == 1 ? vv.y : k == 2 ? vv.z : vv.w;
                    o[4 * k] += w * (float)(d & 255u); o[4 * k + 1] += w * (float)((d >> 8) & 255u); o[4 * k + 2] += w * (float)((d >> 16) & 255u); o[4 * k + 3] += w * (float)(d >> 24); }
            }
        }
        const float corr = 128.f * wsum;
        GAS f32x4* xr = (GAS f32x4*)(P.X + (size_t)t * 1024 + 16 * lane);
#pragma unroll
        for (int k = 0; k < 4; ++k) xr[k] += (f32x4){o[4 * k] - corr, o[4 * k + 1] - corr, o[4 * k + 2] - corr, o[4 * k + 3] - corr};
    }
}

struct Args { const float* in[33]; float* out; unsigned char* ws; int ph_lo, ph_hi; };
struct Frame { LAS unsigned char* lds; volatile LAS unsigned* MISC; gu32* ctl; int tid, lane, wave, G, vcu; };

__device__ __forceinline__ void transpose_item(const float* W, int ldw, int nsrc0, bf16* WT, int ldt, int rdst0, LAS float* scr, int kb, int nb, int lane, float scale, const float* kgain) {
    const int k0 = 64 * kb, n0 = 32 * nb;
#pragma unroll 8
    for (int i = 0; i < 32; ++i) { const int kk = 2 * i + (lane >> 5); const float gsc = kgain ? kgain[k0 + kk] * scale : scale; scr[kk * 33 + (lane & 31)] = W[(size_t)(k0 + kk) * ldw + nsrc0 + n0 + (lane & 31)] * gsc; }
    LDS_WAIT(); asm volatile("" ::: "memory");
    const int c = lane & 7;
#pragma unroll
    for (int j = 0; j < 4; ++j) { const int n = (lane >> 3) + 8 * j; const LAS float* s = scr + (8 * c) * 33 + n;
        v4u o; o.x = pk2(s[0 * 33], s[1 * 33]); o.y = pk2(s[2 * 33], s[3 * 33]); o.z = pk2(s[4 * 33], s[5 * 33]); o.w = pk2(s[6 * 33], s[7 * 33]);
        *(GAS v4u*)(WT + (size_t)(rdst0 + n0 + n) * ldt + k0 + 8 * c) = o; }
    LDS_WAIT(); asm volatile("" ::: "memory");
}
__device__ __forceinline__ void zero_rect(bf16* base, int ld, int row0, int nrows, int col0, int ncols, int gtid, int gthreads) {
    const int vpr = ncols / 8;
    for (int i = gtid; i < nrows * vpr; i += gthreads) { const int r = i / vpr, c = i % vpr; *(GAS v4u*)(base + (size_t)(row0 + r) * ld + col0 + 8 * c) = (v4u){0u, 0u, 0u, 0u}; }
}

__device__ __forceinline__ void p0_prologue(Frame& F, const Args& a) {
    LAS float* scr = (LAS float*)(F.lds + RING_OFF + F.wave * 16384);
    const int gw = blockIdx.x * NWAVES + F.wave, NGW = F.G * NWAVES;
    const int gtid = blockIdx.x * (NWAVES * 64) + F.tid, gthreads = F.G * NWAVES * 64;
    unsigned char* ws = a.ws;
    { const GAS f32x4* src = (const GAS f32x4*)a.in[0]; GAS f32x4* dst = (GAS f32x4*)a.out; const size_t n4 = (size_t)T * D / 4;
      for (size_t i = gtid; i < n4; i += (size_t)gthreads) dst[i] = src[i]; }
    constexpr int I_IN = 16 * (INW / 32), I_SQ = 16 * 32, I_CKV = 16 * 64, I_UQ = 3 * 12, I_UKV = 2 * 16, I_L = I_IN + 4 * I_SQ + I_CKV + I_UQ + I_UKV;
    for (int it = gw; it < L * I_L; it += NGW) {
        const int l = it / I_L; int r = it % I_L;
        if (r < I_IN) {
            const int kb = r / 67, nb = r % 67; int src, dst; float sc = 1.f;
            if (nb < 6) { src = 32 * nb; dst = src; } else if (nb < 11) { src = 32 * nb; dst = src + 64; } else { src = 32 * nb; dst = src + 160; if (nb >= 43 && nb < 51) sc = 0.17677669529663687f * LOG2E; }
            transpose_item(a.in[5] + (size_t)l * D * INW, INW, src, (bf16*)(ws + WS_WIN) + (size_t)l * INP * D, D, dst, scr, kb, 0, F.lane, sc, nullptr); continue; } r -= I_IN;
        if (r < I_SQ) { transpose_item(a.in[21] + (size_t)l * D * D, D, 0, (bf16*)(ws + WS_WOUT) + (size_t)l * D * D, D, 0, scr, r / 32, r % 32, F.lane, 1.f, nullptr); continue; } r -= I_SQ;
        if (r < I_SQ) { transpose_item(a.in[24] + (size_t)l * D * D, D, 0, (bf16*)(ws + WS_WCQ) + (size_t)l * D * D, D, 0, scr, r / 32, r % 32, F.lane, 0.0625f * LOG2E, nullptr); continue; } r -= I_SQ;
        if (r < I_SQ) { transpose_item(a.in[26] + (size_t)l * D * D, D, 0, (bf16*)(ws + WS_WCO) + (size_t)l * D * D, D, 0, scr, r / 32, r % 32, F.lane, 1.f, nullptr); continue; } r -= I_SQ;
        if (r < I_SQ) { transpose_item(a.in[28] + (size_t)l * D * D, D, 0, (bf16*)(ws + WS_WPQ) + (size_t)l * D * D, D, 0, scr, r / 32, r % 32, F.lane, 1.f, nullptr); continue; } r -= I_SQ;
        if (r < I_CKV) { transpose_item(a.in[25] + (size_t)l * D * 2 * D, 2 * D, 0, (bf16*)(ws + WS_WCKV) + (size_t)l * 2 * D * D, D, 0, scr, r / 64, r % 64, F.lane, 1.f, nullptr); continue; } r -= I_CKV;
        if (r < I_UQ) { transpose_item(a.in[7] + (size_t)l * 192 * 384, 384, 0, (bf16*)(ws + WS_WUQ) + (size_t)l * 512 * 256, 256, 0, scr, r / 12, r % 12, F.lane, 0.10206207261596575f * LOG2E, a.in[6] + l * 192); continue; } r -= I_UQ;
        transpose_item(a.in[9] + (size_t)l * 128 * 512, 512, 0, (bf16*)(ws + WS_WUKV) + (size_t)l * 512 * 256, 256, 0, scr, r / 16, r % 16, F.lane, 1.f, a.in[8] + l * 128);
    }
    for (int l = 0; l < L; ++l) {
        bf16* win = (bf16*)(ws + WS_WIN) + (size_t)l * INP * D; bf16* wuq = (bf16*)(ws + WS_WUQ) + (size_t)l * 512 * 256; bf16* wukv = (bf16*)(ws + WS_WUKV) + (size_t)l * 512 * 256;
        zero_rect(win, D, 192, 64, 0, D, gtid, gthreads); zero_rect(win, D, 416, 96, 0, D, gtid, gthreads);
        zero_rect(wuq, 256, 0, 384, 192, 64, gtid, gthreads); zero_rect(wuq, 256, 384, 128, 0, 256, gtid, gthreads);
        zero_rect(wukv, 256, 0, 512, 128, 128, gtid, gthreads);
    }
    { float* rope = (float*)(ws + WS_ROPE); const int* pos = (const int*)a.in[2];
      for (int i = gtid; i < T * 16; i += gthreads) { const int t = i >> 4, k = i & 15; const float inv = powf(10000.f, -(float)(2 * k) / 32.f); const float ang = (float)pos[t] * inv;
          rope[(size_t)t * 32 + k] = cosf(ang); rope[(size_t)t * 32 + 16 + k] = sinf(ang); } }
    { const GAS f32x4* ks = (const GAS f32x4*)a.in[29]; GAS v2u* kd = (GAS v2u*)(ws + WS_KEYS);
      for (int i = gtid; i < L * 2 * 128 * 64 / 4; i += gthreads) { const f32x4 v = ks[i]; v2u w; w.x = pk2(v.x, v.y); w.y = pk2(v.z, v.w); kd[i] = w; }
    }
    for (int r = gw; r < 2 * L * 16384; r += NGW) { const int tb = r / (L * 16384), rr = r % (L * 16384);
        quant_row(a.in[30 + tb] + (size_t)rr * 1024, (unsigned*)(ws + (tb ? WS_V8 : WS_U8) + (size_t)rr * 1024), (float*)(ws + (tb ? WS_SV : WS_SU)) + rr, tb ? 128 : 0, F.lane); }
    { float* btab = (float*)(ws + WS_BTAB); float* lams = (float*)(ws + WS_LAMS); float* spt = (float*)(ws + WS_SP);
      for (int i = gtid; i < 4 * 129; i += gthreads) { const int h = i / 129, n = i % 129; int bu; if (n < 16) bu = n; else { const int lg = 16 + (int)(logf((float)n / 16.f) / logf(8.f) * 16.f); bu = lg < 31 ? lg : 31; }
          btab[i] = a.in[3][bu * 4 + h] * LOG2E; }
      for (int i = gtid; i < L; i += gthreads) { const float* dl = a.in[17] + i * 128; float s1 = 0.f, s2 = 0.f; for (int j = 0; j < 32; ++j) { s1 += dl[j] * dl[32 + j]; s2 += dl[64 + j] * dl[96 + j]; }
          const float li = 0.8f - 0.6f * expf(-0.3f * (float)i); lams[2 * i] = expf(s1) - expf(s2) + li; lams[2 * i + 1] = li; }
      for (int i = gtid; i < L * 512; i += gthreads) spt[i] = log1pf(expf(-a.in[16][i])); }
    for (int l = 0; l < L; ++l) norm_phase(a.in[1], a.in[23] + l * D, (bf16*)(ws + WS_MNB) + (size_t)l * NB * MEM * D, NB * MEM, gw, NGW, F.lane);
}

constexpr int NPL = 16, PH_FINAL = 2 + NPL * L;
__global__ void __launch_bounds__(NWAVES * 64, 2) fwd(Args args) {
    extern __shared__ __attribute__((aligned(16))) unsigned char lds[];
    Frame F;
    F.lds = (LAS unsigned char*)lds; F.MISC = (volatile LAS unsigned*)(F.lds + MISC_OFF);
    F.tid = threadIdx.x; F.lane = F.tid & 63; F.wave = __builtin_amdgcn_readfirstlane(F.tid >> 6); F.G = gridDim.x;
    F.vcu = (F.G % 8 == 0) ? ((int)blockIdx.x % 8) * (F.G / 8) + (int)blockIdx.x / 8 : (int)blockIdx.x;
    unsigned char* ws = args.ws;
    F.ctl = (gu32*)(opq(ws) + WS_CTL);
    for (int u = F.tid; u < (LDS_BYTES - LDSCTL_OFF) / 4; u += NWAVES * 64) ((LAS unsigned*)(F.lds + LDSCTL_OFF))[u] = 0u;
    __syncthreads();
    XcdBarrier bar = xcd_barrier_post((unsigned*)(F.ctl + CW_BAR), F.MISC + 8);
    const int lo = args.ph_lo, hi = args.ph_hi;
    const int gw = blockIdx.x * NWAVES + F.wave, NGW = F.G * NWAVES;
#define IN(k) (lo <= (k) && (k) < hi)
#define LANE_ (lane_id_v())
#define TID_ ((opqi(F.wave) << 6) | LANE_)
#define SITE() const int G_ = opqi(F.G), wv_ = opqi(F.wave), vcu_ = opqi(F.vcu), gw_ = opqi(gw), NGW_ = opqi(NGW); (void)G_; (void)wv_; (void)vcu_; (void)gw_; (void)NGW_
#define SEAM(k) do { if (IN(k) && IN((k) + 1)) xcd_barrier(bar, (F.wave == 0 && lane_id_v() == 0) ? 1 : 0); } while (0)
#define GEMM_SITE(EPI, Aptr, lda_, Bptr, ldb_, M_, N_, K_, cperm, ...) do { \
        pg8::Gemm g{opq(Aptr), opq(Bptr), M_, N_, K_, lda_, ldb_}; pg8::StaticOrder So; So.init(M_, N_, opqi(F.G), opqi(cperm)); pg8::EPI E{__VA_ARGS__}; \
        pg8::gemm_phase<pg8::EPI, pg8::StaticOrder, true, true>(F.lds + RING_OFF, g, So, E, opqi(F.wave)); } while (0)
    if (IN(0)) { p0_prologue(F, args); }
    SEAM(0);
    if (IN(1)) {
#pragma unroll 1
        for (int l = 0; l < L; ++l)
            GEMM_SITE(EpiBf16, (const bf16*)(opq(ws) + WS_MNB) + (size_t)l * NB * MEM * D, D, (const bf16*)(opq(ws) + WS_WCKV) + (size_t)l * 2 * D * D, D, NB * MEM, 2 * D, D, (int)((blockIdx.x + 64 * l) % F.G),
                      opq((bf16*)(opq(ws) + WS_KVCB) + (size_t)l * NB * MEM * 2 * D), 2 * D, 2 * D);
    }
    SEAM(1);
    for (int l = 0; l < L; ++l) {
        const int pb = 2 + NPL * l;
        const bf16* XNB = (const bf16*)(opq(ws) + WS_XNB); const bf16* YB = (const bf16*)(opq(ws) + WS_YB); bf16* PROJB = (bf16*)(opq(ws) + WS_PROJB);
        if (IN(pb + 0)) { SITE(); norm_phase(args.out, args.in[opqi(4)] + l * D, opq((bf16*)(opq(ws) + WS_XNB)), T, gw_, NGW_, LANE_); }
        SEAM(pb + 0);
        if (IN(pb + 1)) GEMM_SITE(EpiBf16, XNB, D, (const bf16*)(opq(ws) + WS_WIN) + (size_t)l * INP * D, D, T, INP, D, (int)blockIdx.x, opq(PROJB), INP, INP);
        SEAM(pb + 1);
        if (IN(pb + 2)) {
            SITE();
            pre_phase(opq((const bf16*)PROJB), opq((const float*)(opq(ws) + WS_ROPE)), opq((float*)(opq(ws) + WS_RS)), opq((bf16*)(opq(ws) + WS_KMB)), gw_, NGW_, LANE_);
            LruP LP{opq((const bf16*)PROJB), args.in[opqi(10)] + l * 4 * 512, args.in[opqi(11)] + l * 512, args.in[opqi(12)] + (size_t)l * 8 * 4096, args.in[opqi(13)] + l * 512, args.in[opqi(14)] + (size_t)l * 8 * 4096, args.in[opqi(15)] + l * 512,
                    (const float*)(opq(ws) + WS_SP) + l * 512, opq((bf16*)(opq(ws) + WS_HLB)), opq((bf16*)(opq(ws) + WS_ACB)), opq((float*)(opq(ws) + WS_LSUM))};
            lru_phase(LP, F.lds, TID_, wv_, LANE_, vcu_, G_);
        }
        SEAM(pb + 2);
        if (IN(pb + 3)) {
            GEMM_SITE(EpiUp, (const bf16*)PROJB + PC_CQ, INP, (const bf16*)(opq(ws) + WS_WUQ) + (size_t)l * 512 * 256, 256, T, 512, 256, (int)blockIdx.x,
                      opq((bf16*)(opq(ws) + WS_QMB)), nullptr, 384, 384, opq((const float*)(opq(ws) + WS_RS)), 0, 0);
            GEMM_SITE(EpiUp, (const bf16*)PROJB + PC_CKV, INP, (const bf16*)(opq(ws) + WS_WUKV) + (size_t)l * 512 * 256, 256, T, 512, 256, (int)blockIdx.x,
                      opq((bf16*)(opq(ws) + WS_KMB)), opq((bf16*)(opq(ws) + WS_VMB)), 0, 512, opq((const float*)(opq(ws) + WS_RS)), 1, 1);
        }
        SEAM(pb + 3);
        if (IN(pb + 4)) {
            SITE();
            AttnP PM{opq((const bf16*)(opq(ws) + WS_QMB)), opq((const bf16*)(opq(ws) + WS_KMB)), opq((const bf16*)(opq(ws) + WS_VMB)), 384, 384, 256, opq((bf16*)(opq(ws) + WS_OMB)), 256, opq((const float*)(opq(ws) + WS_ROPE)), nullptr, nullptr, nullptr, nullptr};
            AttnP PD{opq((const bf16*)PROJB + PC_QD), opq((const bf16*)PROJB + PC_KD), opq((const bf16*)PROJB + PC_VD), INP, INP, INP, opq((bf16*)(opq(ws) + WS_YB) + 768), 1024, nullptr,
                     (const int*)args.in[opqi(2)], (const float*)(opq(ws) + WS_BTAB), args.in[opqi(18)] + l * 64, (const float*)(opq(ws) + WS_LAMS) + 2 * l};
            attn_phase(PM, PD, F.lds, TID_, wv_, LANE_, vcu_, G_);
        }
        SEAM(pb + 4);
        if (IN(pb + 5)) {
            SITE();
            PostP PP{opq((const bf16*)(opq(ws) + WS_OMB)), opq((const bf16*)(opq(ws) + WS_HLB)), opq((const bf16*)(opq(ws) + WS_ACB)), opq((const float*)(opq(ws) + WS_LSUM)), opq((const bf16*)PROJB), args.in[opqi(19)] + l * 256, args.in[opqi(20)] + l * 512, opq((bf16*)(opq(ws) + WS_YB))};
            post_phase(PP, F.lds, TID_, wv_, LANE_, vcu_, G_);
        }
        SEAM(pb + 5);
        if (IN(pb + 6)) GEMM_SITE(EpiF32, YB, D, (const bf16*)(opq(ws) + WS_WOUT) + (size_t)l * D * D, D, T, D, D, (int)blockIdx.x, args.out, D, D, 1);
        SEAM(pb + 6);
        if (IN(pb + 7)) { SITE(); norm_phase(args.out, args.in[opqi(22)] + l * D, opq((bf16*)(opq(ws) + WS_XNB)), T, gw_, NGW_, LANE_); }
        SEAM(pb + 7);
        if (IN(pb + 8)) GEMM_SITE(EpiBf16, XNB, D, (const bf16*)(opq(ws) + WS_WCQ) + (size_t)l * D * D, D, T, D, D, (int)blockIdx.x, opq(PROJB), D, D);
        SEAM(pb + 8);
        if (IN(pb + 9)) {
            SITE();
            const bf16* kv = (const bf16*)(opq(ws) + WS_KVCB) + (size_t)l * NB * MEM * 2 * D;
            AttnP PC{opq((const bf16*)PROJB), opq(kv), opq(kv + D), 1024, 2 * D, 2 * D, opq((bf16*)(opq(ws) + WS_YB)), 1024, nullptr, nullptr, nullptr, nullptr, nullptr};
            cross_phase(PC, F.lds, TID_, wv_, LANE_, vcu_, G_);
        }
        SEAM(pb + 9);
        if (IN(pb + 10)) GEMM_SITE(EpiF32, YB, D, (const bf16*)(opq(ws) + WS_WCO) + (size_t)l * D * D, D, T, D, D, (int)blockIdx.x, args.out, D, D, 1);
        SEAM(pb + 10);
        if (IN(pb + 11)) { SITE(); norm_phase(args.out, args.in[opqi(27)] + l * D, opq((bf16*)(opq(ws) + WS_XNB)), T, gw_, NGW_, LANE_); }
        SEAM(pb + 11);
        if (IN(pb + 12)) GEMM_SITE(EpiBf16, XNB, D, (const bf16*)(opq(ws) + WS_WPQ) + (size_t)l * D * D, D, T, D, D, (int)blockIdx.x, opq(PROJB), D, D);
        SEAM(pb + 12);
        if (IN(pb + 13)) {
            SITE();
            RouteP RP{opq((const bf16*)PROJB), opq((const bf16*)(opq(ws) + WS_KEYS) + (size_t)l * 2 * 128 * 64), opq((int*)(opq(ws) + WS_EX)), opq((float*)(opq(ws) + WS_GW))};
            route_phase(RP, F.lds, TID_, wv_, LANE_, vcu_, G_);
        }
        SEAM(pb + 13);
        if (IN(pb + 14)) {
            SITE();
            PeerP EP{opq(XNB), opq((const int*)(opq(ws) + WS_EX)), opq((const float*)(opq(ws) + WS_GW)), opq((const unsigned char*)(opq(ws) + WS_U8) + (size_t)l * 16384 * 1024), opq((const unsigned char*)(opq(ws) + WS_V8) + (size_t)l * 16384 * 1024), opq((const float*)(opq(ws) + WS_SU) + l * 16384), opq((const float*)(opq(ws) + WS_SV) + l * 16384), args.out};
            peer_phase(EP, gw_, NGW_, LANE_);
        }
        SEAM(pb + 14);
    }
    if (IN(PH_FINAL)) { SITE(); final_norm_phase(args.out, args.in[opqi(32)], T, gw_, NGW_, LANE_); }
#undef IN
#undef SEAM
#undef GEMM_SITE
}
}
extern "C" void kernel_launch(void* const* d_in, const int* in_sizes, int n_in, void* d_out, int out_size, void* d_ws, size_t ws_size, hipStream_t stream) {
    (void)in_sizes; (void)out_size;
    static int grid = 0;
    if (grid == 0) {
        int dev = 0, cus = 0, per_cu = 0;
        if (n_in != 33 || ws_size < mk::WS_END) { fprintf(stderr, "kernel_launch: unexpected n_in %d / ws_size %zu\n", n_in, ws_size); grid = -1; return; }
        if (hipGetDevice(&dev) != hipSuccess || hipDeviceGetAttribute(&cus, hipDeviceAttributeMultiprocessorCount, dev) != hipSuccess) { grid = -1; return; }
        if (hipFuncSetAttribute((const void*)mk::fwd, hipFuncAttributeMaxDynamicSharedMemorySize, mk::LDS_BYTES) != hipSuccess) { fprintf(stderr, "kernel_launch: hipFuncSetAttribute failed\n"); grid = -1; return; }
        if (hipOccupancyMaxActiveBlocksPerMultiprocessor(&per_cu, (const void*)mk::fwd, mk::NWAVES * 64, mk::LDS_BYTES) != hipSuccess || per_cu < 1) fprintf(stderr, "kernel_launch: occupancy query says %d\n", per_cu);
        (void)hipGetLastError();
        grid = cus;
    }
    if (grid < 0) return;
    unsigned char* ws = (unsigned char*)d_ws;
    (void)hipMemsetAsync(ws + mk::WS_CTL, 0, mk::CTL_ZERO_BYTES, stream);
    mk::Args a{};
    for (int i = 0; i < 33; ++i) a.in[i] = (const float*)d_in[i];
    a.out = (float*)d_out; a.ws = ws;
    auto run = [&](int lo, int hi) { a.ph_lo = lo; a.ph_hi = hi; hipLaunchKernelGGL(mk::fwd, dim3(grid), dim3(mk::NWAVES * 64), mk::LDS_BYTES, stream, a); };
#if MK_ONE_LAUNCH
    run(0, mk::PH_FINAL + 1);
#else
    for (int p = 0; p <= mk::PH_FINAL; ++p) {
        const int k = (p - 2) % mk::NPL, l = (p - 2) / mk::NPL; if (p >= 2 && p < mk::PH_FINAL && k == 15) continue;
#if MK_NAIVE_PEER == 2
        if (p >= 2 && p < mk::PH_FINAL && k == 14) {
            hipLaunchKernelGGL(k_peer, dim3(T), dim3(256), 0, stream, (const bf16_t*)(ws + mk::WS_XNB), (const int*)(ws + mk::WS_EX), (const float*)(ws + mk::WS_GW), (const float*)d_in[30] + (size_t)l * NEXP * D, (const float*)d_in[31] + (size_t)l * NEXP * D, (float*)d_out);
            continue; }
#elif MK_NAIVE_PEER == 1
        if (p >= 2 && p < mk::PH_FINAL && k == 13) {
            float* TQ = (float*)(ws + (size_t)806 * mk::MiB);
            hipLaunchKernelGGL(k_bf2f, dim3((unsigned)(((size_t)T * D + 255) / 256)), dim3(256), 0, stream, (const bf16_t*)(ws + mk::WS_PROJB), TQ, (long)T * D);
            hipLaunchKernelGGL(k_route, dim3(T), dim3(256), 0, stream, TQ, (const float*)d_in[29] + (size_t)l * 2 * 128 * 64, (int*)(ws + mk::WS_EX), (float*)(ws + mk::WS_GW));
            hipLaunchKernelGGL(k_peer, dim3(T), dim3(256), 0, stream, (const bf16_t*)(ws + mk::WS_XNB), (const int*)(ws + mk::WS_EX), (const float*)(ws + mk::WS_GW), (const float*)d_in[30] + (size_t)l * NEXP * D, (const float*)d_in[31] + (size_t)l * NEXP * D, (float*)d_out);
            continue; }
        if (p >= 2 && p < mk::PH_FINAL && k == 14) continue;
#endif
        run(p, p + 1); }
#endif
}
```

```cpp
#include <hip/hip_runtime.h>
#include <cstdint>
#include <cstdio>
#include <cmath>

#ifndef MK_ONE_LAUNCH
#define MK_ONE_LAUNCH 1
#endif
#ifndef MK_DUP
#define MK_DUP 0
#endif
#ifndef MK_NAIVE_PEER
#define MK_NAIVE_PEER 0
#endif
namespace pg8 {
#define PG8_LAS __attribute__((address_space(3)))
typedef unsigned short bf16_t;
typedef short bf16x8 __attribute__((ext_vector_type(8)));
typedef float f32x4 __attribute__((ext_vector_type(4)));
typedef unsigned u32x4 __attribute__((ext_vector_type(4)));
typedef unsigned u32x2 __attribute__((ext_vector_type(2)));
constexpr int BM = 256, BK = 64, HALF = 128, HTB = HALF * BK * 2, STAGE_BYTES = 8 * HTB, NXCD = 8, WGM = 8;
__host__ __device__ __forceinline__ int lds_byte(int r, int c) { const int st = (r >> 4) * 2 + (c >> 5), rr = r & 15, cc = c & 31, ob = rr * 64 + cc * 2; return st * 1024 + (ob ^ (((ob >> 9) & 1) << 5)); }
__host__ __device__ __forceinline__ void stage_rc(int b, int& R, int& C) { const int st = b / 1024, sb = b % 1024, swz = sb ^ (((sb >> 9) & 1) << 5); R = (st >> 1) * 16 + swz / 64; C = (st & 1) * 32 + (swz % 64) / 2; }
__host__ __device__ __forceinline__ int perm32(int rho) { const int n = rho >> 4, i = rho & 15; return 8 * (i >> 2) + 4 * n + (i & 3); }
__device__ __forceinline__ int pg8_lane_id() { int l; asm volatile("v_mbcnt_lo_u32_b32 %0, -1, 0\n\tv_mbcnt_hi_u32_b32 %0, -1, %0" : "=v"(l)); return l; }
struct Unit { int pm, pn; };
struct Gemm { const bf16_t* A; const bf16_t* Bt; int M, N, K, lda, ldb; };
struct StaticOrder {
    int nM, nN, nwg, G, c;
    __host__ __device__ void init(int M, int N, int G_, int c_) { nM = M / BM; nN = N / BM; nwg = nM * nN; G = G_; c = c_; }
    __host__ __device__ bool next(int i, Unit& u) const {
        const long L = (long)i * G + c; if (L >= nwg) return false;
        int wgid = (int)L; { const int q = nwg / NXCD, r = nwg % NXCD, xcd = wgid % NXCD, off = wgid / NXCD; wgid = (xcd < r ? xcd * (q + 1) : r * (q + 1) + (xcd - r) * q) + off; }
        const int nig = WGM * nN, gid = wgid / nig, fm = gid * WGM, gsz = (nM - fm) < WGM ? (nM - fm) : WGM;
        u.pm = fm + ((wgid % nig) % gsz); u.pn = (wgid % nig) / gsz; return true;
    }
    __device__ __forceinline__ void a_ready(const Unit&) const {}
    __device__ __forceinline__ void done(const Unit&) const {}
};
__device__ __forceinline__ unsigned cvt_pk_bf16(float lo, float hi) { unsigned r; asm volatile("v_cvt_pk_bf16_f32 %0, %1, %2" : "=v"(r) : "v"(lo), "v"(hi)); return r; }

struct EpiF32 {
    static constexpr bool PERM = false, AFTER_DRAIN = false;
    float* C; int ldc; int nvalid; int accum;
    __device__ __forceinline__ void operator()(const f32x4 (&acc)[2][2][4][2], const Unit& u, int wr, int wc, int fr, int fq) const {
        { const int l_ = pg8_lane_id(); fr = l_ & 15; fq = l_ >> 4; }
#pragma unroll
        for (int ai = 0; ai < 2; ++ai)
#pragma unroll
            for (int m = 0; m < 4; ++m) { const size_t row = (size_t)u.pm * BM + ai * HALF + wr * 64 + m * 16 + fr;
#pragma unroll
                for (int bj = 0; bj < 2; ++bj)
#pragma unroll
                    for (int n = 0; n < 2; ++n) { const int col = u.pn * BM + bj * HALF + wc * 32 + n * 16 + 4 * fq;
                        if (col < nvalid) { float* p = C + row * ldc + col; f32x4 v = acc[ai][bj][m][n]; if (accum) v += *(const f32x4*)p; *(f32x4*)p = v; } } }
    }
};
struct EpiBf16 {
    static constexpr bool PERM = true, AFTER_DRAIN = false;
    bf16_t* O; int ldc; int nvalid;
    __device__ __forceinline__ void operator()(const f32x4 (&acc)[2][2][4][2], const Unit& u, int wr, int wc, int fr, int fq) const {
        { const int l_ = pg8_lane_id(); fr = l_ & 15; fq = l_ >> 4; }
#pragma unroll
        for (int ai = 0; ai < 2; ++ai)
#pragma unroll
            for (int m = 0; m < 4; ++m) { const size_t row = (size_t)u.pm * BM + ai * HALF + wr * 64 + m * 16 + fr;
#pragma unroll
                for (int bj = 0; bj < 2; ++bj) { const int col = u.pn * BM + bj * HALF + wc * 32 + 8 * fq;
                    if (col < nvalid) { const f32x4 v0 = acc[ai][bj][m][0], v1 = acc[ai][bj][m][1]; u32x4 w; w.x = cvt_pk_bf16(v0[0], v0[1]); w.y = cvt_pk_bf16(v0[2], v0[3]); w.z = cvt_pk_bf16(v1[0], v1[1]); w.w = cvt_pk_bf16(v1[2], v1[3]);
                        *(u32x4*)(O + row * ldc + col) = w; } } }
    }
};
struct EpiUp {
    static constexpr bool PERM = true, AFTER_DRAIN = false;
    bf16_t* O; bf16_t* O2; int ldc; int nvalid; const float* rs; int rsi; int mode;
    __device__ __forceinline__ void operator()(const f32x4 (&acc)[2][2][4][2], const Unit& u, int wr, int wc, int fr, int fq) const {
        { const int l_ = pg8_lane_id(); fr = l_ & 15; fq = l_ >> 4; }
#pragma unroll
        for (int ai = 0; ai < 2; ++ai)
#pragma unroll
            for (int m = 0; m < 4; ++m) { const size_t row = (size_t)u.pm * BM + ai * HALF + wr * 64 + m * 16 + fr; const float s = rs[2 * row + rsi];
#pragma unroll
                for (int bj = 0; bj < 2; ++bj) { const int col = u.pn * BM + bj * HALF + wc * 32 + 8 * fq;
                    if (col < nvalid) { const f32x4 v0 = acc[ai][bj][m][0] * s, v1 = acc[ai][bj][m][1] * s; u32x4 w; w.x = cvt_pk_bf16(v0[0], v0[1]); w.y = cvt_pk_bf16(v0[2], v0[3]); w.z = cvt_pk_bf16(v1[0], v1[1]); w.w = cvt_pk_bf16(v1[2], v1[3]);
                        bf16_t* dst;
                        if (mode == 0) dst = O + row * ldc + col;
                        else { const int h = col >> 7, j = col & 127; dst = (j < 64) ? O + row * 384 + h * 96 + j : O2 + row * 256 + h * 64 + (j - 64); }
                        *(u32x4*)dst = w; } } }
    }
};
template <class Epi, class Sched, bool ALIGN_EPI = false, bool SP2 = false>
__device__ __forceinline__ void gemm_phase(PG8_LAS unsigned char* lds, const Gemm g, const Sched& S, const Epi& E, int wave_id) {
    int tid_ = (wave_id << 6) | pg8_lane_id(); asm volatile("" : "+v"(tid_));
    const int tid = tid_, wid = __builtin_amdgcn_readfirstlane(tid >> 6), lane = tid & 63, wr = wid >> 2, wc = wid & 3, fr = lane & 15, fq = lane >> 4;
    const int K = g.K, nt = K / BK;
    unsigned voffA[2], voffB[2];
#pragma unroll
    for (int i = 0; i < 2; ++i) { int R, C; stage_rc(tid * 16 + i * 8192, R, C); const int Rb = Epi::PERM ? ((R & ~31) + perm32(R & 31)) : R;
        voffA[i] = (unsigned)(R * g.lda + C) * 2u; voffB[i] = (unsigned)(Rb * g.ldb + C) * 2u; }
    const size_t kstep = (size_t)(BK * 2);
    const size_t hstepA = (size_t)HALF * g.lda * 2, hstepB = (size_t)HALF * g.ldb * 2;
    const size_t tstepA = 2 * hstepA, tstepB = 2 * hstepB;
    const unsigned ldsw = (unsigned)wid * 1024u;
    const int aoff = lds_byte(wr * 64 + fr, fq * 8), boff = lds_byte(wc * 32 + fr, fq * 8);
#define PG8_SA(b, h) (((b) * 2 + (h)) * HTB)
#define PG8_SB(b, h) ((4 + (b) * 2 + (h)) * HTB)
#define PG8_STAGE(bufoff, gbase, voff) do { _Pragma("unroll") for (int _i = 0; _i < 2; ++_i) \
        __builtin_amdgcn_global_load_lds((const unsigned*)((const char*)(gbase) + (voff)[_i]), (PG8_LAS unsigned*)(lds + (bufoff) + ldsw + _i * 8192), 16, 0, 0); } while (0)
#define PG8_LDA(dst, b, h) do { _Pragma("unroll") for (int m = 0; m < 4; ++m) _Pragma("unroll") for (int k = 0; k < 2; ++k) dst[m][k] = *(const PG8_LAS bf16x8*)(lds + PG8_SA(b, h) + aoff + m * 2048 + k * 1024); } while (0)
#define PG8_LDB(dst, b, h) do { _Pragma("unroll") for (int n = 0; n < 2; ++n) _Pragma("unroll") for (int k = 0; k < 2; ++k) dst[n][k] = *(const PG8_LAS bf16x8*)(lds + PG8_SB(b, h) + boff + n * 2048 + k * 1024); } while (0)
#define PG8_MMA(ai, bj, At, Bt) do { __builtin_amdgcn_s_setprio(1); _Pragma("unroll") for (int m = 0; m < 4; ++m) _Pragma("unroll") for (int n = 0; n < 2; ++n) _Pragma("unroll") for (int k = 0; k < 2; ++k) \
        acc[ai][bj][m][n] = __builtin_amdgcn_mfma_f32_16x16x32_bf16(Bt[n][k], At[m][k], acc[ai][bj][m][n], 0, 0, 0); __builtin_amdgcn_s_setprio(0); } while (0)
#define PG8_WAIT_V(n) asm volatile("s_waitcnt vmcnt(" #n ")" ::: "memory")
#define PG8_WAIT_L(n) asm volatile("s_waitcnt lgkmcnt(" #n ")" ::: "memory")
#define PG8_BAR __builtin_amdgcn_s_barrier()
#define PG8_SCHED __builtin_amdgcn_sched_barrier(0)
    Unit cur, nxt; int ui = 0;
    if (!S.next(0, cur)) return;
    f32x4 acc[2][2][4][2];
#pragma unroll
    for (int a = 0; a < 2; ++a)
#pragma unroll
        for (int b = 0; b < 2; ++b)
#pragma unroll
            for (int m = 0; m < 4; ++m)
#pragma unroll
                for (int n = 0; n < 2; ++n) acc[a][b][m][n] = (f32x4){0.f, 0.f, 0.f, 0.f};
    bf16x8 At[4][2], B0[2][2], B1[2][2];
    const char* cA = (const char*)g.A + (size_t)cur.pm * tstepA; const char* cB = (const char*)g.Bt + (size_t)cur.pn * tstepB;
    S.a_ready(cur);
    if constexpr (SP2) {
        PG8_STAGE(PG8_SB(0, 0), cB, voffB); PG8_STAGE(PG8_SB(0, 1), cB + hstepB, voffB); PG8_STAGE(PG8_SA(0, 0), cA, voffA); PG8_STAGE(PG8_SA(0, 1), cA + hstepA, voffA);
        if (wr == 1) PG8_BAR;
        PG8_WAIT_V(2); PG8_BAR;
        PG8_STAGE(PG8_SB(1, 0), cB + kstep, voffB); PG8_STAGE(PG8_SA(1, 0), cA + kstep, voffA); PG8_STAGE(PG8_SB(1, 1), cB + hstepB + kstep, voffB);
        PG8_WAIT_V(6); PG8_BAR;
    } else {
        PG8_STAGE(PG8_SB(0, 0), cB, voffB); PG8_STAGE(PG8_SA(0, 0), cA, voffA); PG8_STAGE(PG8_SB(0, 1), cB + hstepB, voffB); PG8_STAGE(PG8_SA(0, 1), cA + hstepA, voffA);
        if (wr == 1) PG8_BAR;
        PG8_WAIT_V(4); PG8_BAR;
        PG8_STAGE(PG8_SB(1, 0), cB + kstep, voffB); PG8_STAGE(PG8_SA(1, 0), cA + kstep, voffA); PG8_STAGE(PG8_SB(1, 1), cB + hstepB + kstep, voffB);
        PG8_WAIT_V(6); PG8_BAR;
    }
    for (;;) {
        const bool has_next = S.next(ui + 1, nxt);
        const char* nA = has_next ? (const char*)g.A + (size_t)nxt.pm * tstepA : cA; const char* nB = has_next ? (const char*)g.Bt + (size_t)nxt.pn * tstepB : cB;
        for (int t = 0; t < nt; t += 2) {
            const bool last = (t == nt - 2);
            const char* a1 = cA + (size_t)(t + 1) * kstep;
            const char* a2 = last ? nA : cA + (size_t)(t + 2) * kstep; const char* b2 = last ? nB : cB + (size_t)(t + 2) * kstep;
            const char* a3 = a2 + kstep; const char* b3 = b2 + kstep;
            if (last && has_next) S.a_ready(nxt);
            if constexpr (SP2) {
            PG8_LDB(B0, 0, 0); PG8_LDB(B1, 0, 1); PG8_SCHED; PG8_LDA(At, 0, 0); PG8_STAGE(PG8_SA(1, 1), a1 + hstepA, voffA);
            PG8_WAIT_V(8); PG8_WAIT_L(0); PG8_BAR; PG8_MMA(0, 0, At, B0); PG8_MMA(0, 1, At, B1); PG8_BAR; PG8_SCHED;
            PG8_LDA(At, 0, 1); PG8_STAGE(PG8_SB(0, 0), b2, voffB); PG8_STAGE(PG8_SB(0, 1), b2 + hstepB, voffB); PG8_STAGE(PG8_SA(0, 0), a2, voffA);
            PG8_WAIT_V(8); PG8_WAIT_L(0); PG8_BAR; PG8_MMA(1, 0, At, B0); PG8_MMA(1, 1, At, B1); PG8_BAR; PG8_SCHED;
            PG8_LDB(B0, 1, 0); PG8_LDB(B1, 1, 1); PG8_SCHED; PG8_LDA(At, 1, 0); PG8_STAGE(PG8_SA(0, 1), a2 + hstepA, voffA);
            PG8_WAIT_V(8); PG8_WAIT_L(0); PG8_BAR; PG8_MMA(0, 0, At, B0); PG8_MMA(0, 1, At, B1); PG8_BAR; PG8_SCHED;
            PG8_LDA(At, 1, 1); PG8_STAGE(PG8_SB(1, 0), b3, voffB); PG8_STAGE(PG8_SB(1, 1), b3 + hstepB, voffB); PG8_STAGE(PG8_SA(1, 0), a3, voffA);
            PG8_WAIT_V(8); PG8_WAIT_L(0); PG8_BAR; PG8_MMA(1, 0, At, B0); PG8_MMA(1, 1, At, B1); PG8_BAR; PG8_SCHED;
            } else {
            PG8_LDB(B0, 0, 0); PG8_SCHED; PG8_LDA(At, 0, 0); PG8_STAGE(PG8_SA(1, 1), a1 + hstepA, voffA);
            PG8_WAIT_L(8); PG8_BAR; PG8_WAIT_L(0); PG8_MMA(0, 0, At, B0); PG8_BAR; PG8_SCHED;
            PG8_LDB(B1, 0, 1); PG8_STAGE(PG8_SB(0, 0), b2, voffB);
            PG8_BAR; PG8_WAIT_L(0); PG8_MMA(0, 1, At, B1); PG8_BAR;
            PG8_LDA(At, 0, 1); PG8_STAGE(PG8_SA(0, 0), a2, voffA);
            PG8_BAR; PG8_WAIT_L(0); PG8_MMA(1, 0, At, B0); PG8_BAR; PG8_SCHED;
            PG8_STAGE(PG8_SB(0, 1), b2 + hstepB, voffB);
            PG8_WAIT_V(6); PG8_BAR; PG8_MMA(1, 1, At, B1); PG8_BAR;
            PG8_LDB(B0, 1, 0); PG8_SCHED; PG8_LDA(At, 1, 0); PG8_STAGE(PG8_SA(0, 1), a2 + hstepA, voffA);
            PG8_WAIT_L(8); PG8_BAR; PG8_WAIT_L(0); PG8_MMA(0, 0, At, B0); PG8_BAR; PG8_SCHED;
            PG8_LDB(B1, 1, 1); PG8_STAGE(PG8_SB(1, 0), b3, voffB);
            PG8_BAR; PG8_WAIT_L(0); PG8_MMA(0, 1, At, B1); PG8_BAR;
            PG8_LDA(At, 1, 1); PG8_STAGE(PG8_SA(1, 0), a3, voffA);
            PG8_BAR; PG8_WAIT_L(0); PG8_MMA(1, 0, At, B0); PG8_BAR; PG8_SCHED;
            PG8_STAGE(PG8_SB(1, 1), b3 + hstepB, voffB);
            PG8_WAIT_V(6); PG8_BAR; PG8_MMA(1, 1, At, B1); PG8_BAR;
            }
        }
        if constexpr (ALIGN_EPI) { if (wr == 0) PG8_BAR; }
        if constexpr (!Epi::AFTER_DRAIN) { E(acc, cur, wr, wc, fr, fq); S.done(cur); }
        if (!has_next) break;
#pragma unroll
        for (int a = 0; a < 2; ++a)
#pragma unroll
            for (int b = 0; b < 2; ++b)
#pragma unroll
                for (int m = 0; m < 4; ++m)
#pragma unroll
                    for (int n = 0; n < 2; ++n) acc[a][b][m][n] = (f32x4){0.f, 0.f, 0.f, 0.f};
        cur = nxt; cA = nA; cB = nB; ++ui;
        if constexpr (ALIGN_EPI) { if (wr == 1) PG8_BAR; }
    }
    PG8_WAIT_V(0);
    if constexpr (!ALIGN_EPI) { if (wr == 0) PG8_BAR; }
    PG8_BAR;
    if constexpr (Epi::AFTER_DRAIN) { E.fused(acc, cur, wr, wc, fr, fq, lds, wid, lane); S.done(cur); }
#undef PG8_SA
#undef PG8_SB
#undef PG8_STAGE
#undef PG8_LDA
#undef PG8_LDB
#undef PG8_MMA
#undef PG8_WAIT_V
#undef PG8_WAIT_L
#undef PG8_BAR
#undef PG8_SCHED
}
}

namespace mk {
#define GAS __attribute__((address_space(1)))
#define LAS __attribute__((address_space(3)))
typedef unsigned short bf16;
typedef unsigned v4u __attribute__((ext_vector_type(4)));
typedef unsigned v2u __attribute__((ext_vector_type(2)));
typedef float f32x4 __attribute__((ext_vector_type(4)));
typedef GAS unsigned gu32;
#define LDS_WAIT() asm volatile("s_waitcnt lgkmcnt(0)" ::: "memory")
#define VM_WAIT() asm volatile("s_waitcnt vmcnt(0)" ::: "memory")
__device__ __forceinline__ unsigned f2bf_(float f) { unsigned u = __builtin_bit_cast(unsigned, f); return (u + 0x7fffu + ((u >> 16) & 1u)) >> 16; }
__device__ __forceinline__ unsigned pk2(float lo, float hi) { return f2bf_(lo) | (f2bf_(hi) << 16); }
__device__ __forceinline__ float bflo(unsigned w) { return __builtin_bit_cast(float, w << 16); }
__device__ __forceinline__ float bfhi(unsigned w) { return __builtin_bit_cast(float, w & 0xffff0000u); }

template <class P> __device__ __forceinline__ P* opq(P* p) { asm volatile("" : "+s"(p)); return p; }
__device__ __forceinline__ int opqi(int k) { asm volatile("" : "+s"(k)); return k; }
__device__ __forceinline__ float shx(float v, int o, int lane) { return __builtin_bit_cast(float, __builtin_amdgcn_ds_bpermute((lane ^ o) << 2, __builtin_bit_cast(int, v))); }
__device__ __forceinline__ int shxi(int v, int o, int lane) { return __builtin_amdgcn_ds_bpermute((lane ^ o) << 2, v); }
__device__ __forceinline__ int lane_id_v() { int l; asm volatile("v_mbcnt_lo_u32_b32 %0, -1, 0\n\tv_mbcnt_hi_u32_b32 %0, -1, %0" : "=v"(l)); return l; }
constexpr int NWAVES = 8;
constexpr int D = 1024, NB = 4, S = 8192, T = NB * S, L = 4, MEM = 256, INW = 2144, INP = 2304;
constexpr int PC_CQ = 0, PC_CKV = 256, PC_KR = 384, PC_XL = 512, PC_GL = 1024, PC_QD = 1536, PC_KD = 1792, PC_VD = 2048;
constexpr float LOG2E = 1.4426950408889634f;
constexpr size_t MiB = 1u << 20;
constexpr size_t WS_CTL = 0, CTL_ZERO_BYTES = 1 * MiB;
constexpr size_t WS_WIN = 1 * MiB, WS_WOUT = 19 * MiB, WS_WCQ = 27 * MiB, WS_WCO = 35 * MiB, WS_WPQ = 43 * MiB, WS_WCKV = 51 * MiB, WS_WUQ = 67 * MiB, WS_WUKV = 68 * MiB, WS_KEYS = 69 * MiB, WS_ROPE = 70 * MiB;
constexpr size_t WS_XNB = 76 * MiB, WS_YB = 140 * MiB, WS_PROJB = 204 * MiB, WS_QMB = 348 * MiB, WS_KMB = 372 * MiB, WS_VMB = 396 * MiB, WS_RS = 412 * MiB;
constexpr size_t WS_HLB = 413 * MiB, WS_ACB = 445 * MiB, WS_LSUM = 477 * MiB, WS_OMB = 478 * MiB, WS_MNB = 494 * MiB, WS_KVCB = 502 * MiB, WS_EX = 518 * MiB, WS_GW = 534 * MiB;
constexpr size_t WS_U8 = 550 * MiB, WS_V8 = 614 * MiB, WS_SU = 678 * MiB, WS_SV = 679 * MiB;
constexpr size_t WS_HQ = 680 * MiB, WS_P = 712 * MiB, WS_SH = 728 * MiB, WS_W = 729 * MiB, WS_WS = 745 * MiB, WS_END = 746 * MiB;
constexpr size_t WS_BTAB = WS_KEYS + 512 * 1024, WS_LAMS = WS_BTAB + 4096, WS_SP = WS_LAMS + 4096;
constexpr int CW_BAR = 4096, CW_RANK = 8192;
constexpr int RING_OFF = 0, RING_BYTES = 131072, LDSCTL_OFF = RING_BYTES, MISC_OFF = LDSCTL_OFF + 320, LDS_BYTES = 147456;

#define XB_TMO      128
#define XB_XCNT(j)  (256  + 64 * (j))
#define XB_XSUB(j)  (1280 + 64 * (j))
#define XB_XGEN(j)  (2304 + 64 * (j))
#define XB_TOP      3328
#define XB_TOPGEN   3392
#define XCD_BAR_WORDS 3456
#define XB_SPIN_CAP (1u << 18)

__device__ __forceinline__ unsigned xb_ld(unsigned* p)              { return __hip_atomic_load(p, __ATOMIC_RELAXED, __HIP_MEMORY_SCOPE_AGENT); }
__device__ __forceinline__ unsigned xb_add(unsigned* p, unsigned v) { return __hip_atomic_fetch_add(p, v, __ATOMIC_RELAXED, __HIP_MEMORY_SCOPE_AGENT); }
__device__ __forceinline__ unsigned xb_xcc_id() { return (unsigned)__builtin_amdgcn_s_getreg((3 << 11) | 20) & 0xFu; }
#define XB_SPIN(cond, bar) do { unsigned _sp = 0; while (cond) { __builtin_amdgcn_s_sleep(1); \
    if ((++_sp & 255u) == 0u) { if (xb_ld(&(bar)[XB_TMO])) break; if (_sp > XB_SPIN_CAP) { atomicAdd(&(bar)[XB_TMO], 1u); break; } } } } while (0)

struct XcdBarrier {
    unsigned* bar; unsigned x;
    volatile LAS unsigned* st;
};

__device__ __forceinline__ XcdBarrier xcd_barrier_post(unsigned* bar, volatile LAS unsigned* st) {
    XcdBarrier b; b.bar = bar; b.x = xb_xcc_id(); b.st = st;
    if (threadIdx.x == 0) (void)xb_add(&bar[XB_XCNT(b.x)], 1u);
    return b;
}
__device__ __forceinline__ void xcd_barrier_complete(unsigned* bar, unsigned x, unsigned& nloc, unsigned& nx) {
    const unsigned G = gridDim.x * gridDim.y * gridDim.z;
    unsigned sum, cnt, mine, sp = 0u;
    for (;;) {
        sum = 0u; cnt = 0u; mine = 0u;
#pragma unroll
        for (unsigned j = 0; j < 16; ++j) { const unsigned c = xb_ld(&bar[XB_XCNT(j)]); sum += c; cnt += (c > 0u) ? 1u : 0u; mine = (j == x) ? c : mine; }
        if (sum == G) break;
        __builtin_amdgcn_s_sleep(1);
        if ((++sp & 255u) == 0u) { if (xb_ld(&bar[XB_TMO])) break; if (sp > XB_SPIN_CAP) { atomicAdd(&bar[XB_TMO], 1u); break; } }
    }
    nloc = mine > 0u ? mine : 1u; nx = cnt > 0u ? cnt : 1u;
}

__device__ __noinline__ void xcd_barrier_impl(unsigned* bar_, unsigned x_, volatile LAS unsigned* st_, int leader_) {
    XcdBarrier b; b.bar = bar_; b.x = x_; b.st = st_;
    asm volatile("s_waitcnt vmcnt(0)" ::: "memory");
    __syncthreads();
    if (leader_) {
        unsigned* bar = b.bar;
        __builtin_amdgcn_s_waitcnt(0);
        unsigned nloc = b.st[0], nx = b.st[1];
        if (nloc == 0u) { xcd_barrier_complete(bar, b.x, nloc, nx); b.st[0] = nloc; b.st[1] = nx; }
        const unsigned old = xb_add(&bar[XB_XSUB(b.x)], 1u);
        const unsigned gen = old / nloc;
        if (old + 1u == (gen + 1u) * nloc) {
            __builtin_amdgcn_fence(__ATOMIC_RELEASE, "agent");
            asm volatile("s_waitcnt vmcnt(0)" ::: "memory");
            const unsigned og = xb_add(&bar[XB_TOP], 1u);
            const unsigned tg = og / nx;
            if (og + 1u == (tg + 1u) * nx) xb_add(&bar[XB_TOPGEN], 1u);
            else XB_SPIN(xb_ld(&bar[XB_TOPGEN]) == tg, bar);
            __builtin_amdgcn_fence(__ATOMIC_ACQUIRE, "agent");
            xb_add(&bar[XB_XGEN(b.x)], 1u);
            asm volatile("s_waitcnt vmcnt(0)" ::: "memory");
        } else {
            XB_SPIN(xb_ld(&bar[XB_XGEN(b.x)]) == gen, bar);
            __builtin_amdgcn_fence(__ATOMIC_ACQUIRE, "agent");
            asm volatile("s_waitcnt vmcnt(0)" ::: "memory");
        }
    }
    __syncthreads();
}
__device__ __forceinline__ void xcd_barrier(const XcdBarrier& b, int leader) { xcd_barrier_impl(b.bar, b.x, b.st, leader); }


__device__ __forceinline__ float wave_sum(float v, int lane) {
#pragma unroll
    for (int o = 1; o < 64; o <<= 1) v += shx(v, o, lane);
    return v;
}
__device__ __forceinline__ float gelu_erf(float v) {
    const float av = __builtin_fabsf(v), t = __builtin_amdgcn_rcpf(av * 0.2316418882f + 1.0f);
    float q = t * 0.5307027145f + (-0.7265760135f); q = q * t + 0.7107068705f; q = q * t + (-0.142248368f); q = q * t + 0.127414796f; q = q * t;
    const float e = __builtin_amdgcn_exp2f((v * v) * (-0.72134752044f));
    const float m = v * (q * e);
    return v < 0.f ? m : v - m;
}

__device__ __forceinline__ void norm_phase(const float* X, const float* g, bf16* out, int rows, int gw, int NGW, int lane) {
    asm volatile("" : "+v"(lane));
    f32x4 gv[4];
#pragma unroll
    for (int j = 0; j < 4; ++j) gv[j] = ((const GAS f32x4*)g)[lane + 64 * j];
    for (int m = gw; m < rows; m += NGW) {
        const GAS f32x4* xr = (const GAS f32x4*)(X + (size_t)m * D) + lane;
        f32x4 v[4]; float s = 0.f;
#pragma unroll
        for (int j = 0; j < 4; ++j) { v[j] = xr[64 * j]; s += (v[j].x * v[j].x + v[j].y * v[j].y) + (v[j].z * v[j].z + v[j].w * v[j].w); }
        const float rs = rsqrtf(wave_sum(s, lane) * (1.f / D) + 1e-6f);
        GAS v2u* o8 = (GAS v2u*)(out + (size_t)m * D) + lane;
#pragma unroll
        for (int j = 0; j < 4; ++j) { v2u w; w.x = pk2(v[j].x * rs * gv[j].x, v[j].y * rs * gv[j].y); w.y = pk2(v[j].z * rs * gv[j].z, v[j].w * rs * gv[j].w); o8[64 * j] = w; }
    }
}
__device__ __forceinline__ void norm_q_phase(const float* X, const float* g, bf16* out, unsigned char* HQ, float* SH, int* Pz, int rows, int gw, int NGW, int lane) {
    asm volatile("" : "+v"(lane));
    f32x4 gv[4];
#pragma unroll
    for (int j = 0; j < 4; ++j) gv[j] = ((const GAS f32x4*)g)[lane + 64 * j];
    for (int m = gw; m < rows; m += NGW) {
        const GAS f32x4* xr = (const GAS f32x4*)(X + (size_t)m * D) + lane;
        f32x4 v[4]; float s = 0.f;
#pragma unroll
        for (int j = 0; j < 4; ++j) { v[j] = xr[64 * j]; s += (v[j].x * v[j].x + v[j].y * v[j].y) + (v[j].z * v[j].z + v[j].w * v[j].w); }
        const float rs = rsqrtf(wave_sum(s, lane) * (1.f / D) + 1e-6f);
        float mx = 0.f;
#pragma unroll
        for (int j = 0; j < 4; ++j) { v[j] = v[j] * rs * gv[j]; mx = fmaxf(mx, fmaxf(fmaxf(__builtin_fabsf(v[j].x), __builtin_fabsf(v[j].y)), fmaxf(__builtin_fabsf(v[j].z), __builtin_fabsf(v[j].w)))); }
#pragma unroll
        for (int o = 1; o < 64; o <<= 1) mx = fmaxf(mx, shx(mx, o, lane));
        const float inv = mx > 0.f ? 127.f / mx : 0.f;
        GAS v2u* o8 = (GAS v2u*)(out + (size_t)m * D) + lane; GAS unsigned* q4p = (GAS unsigned*)(HQ + (size_t)m * D) + lane;
#pragma unroll
        for (int j = 0; j < 4; ++j) { v2u w; w.x = pk2(v[j].x, v[j].y); w.y = pk2(v[j].z, v[j].w); o8[64 * j] = w;
            const int ia = (int)__builtin_rintf(v[j].x * inv), ib = (int)__builtin_rintf(v[j].y * inv), ic = (int)__builtin_rintf(v[j].z * inv), id = (int)__builtin_rintf(v[j].w * inv);
            q4p[64 * j] = (unsigned)(ia & 255) | ((unsigned)(ib & 255) << 8) | ((unsigned)(ic & 255) << 16) | ((unsigned)(id & 255) << 24); }
        if (lane == 0) SH[m] = mx * (1.f / 127.f);
        ((GAS int*)(Pz + (size_t)m * 128))[lane] = 0; ((GAS int*)(Pz + (size_t)m * 128))[lane + 64] = 0;
    }
}
__device__ __forceinline__ void final_norm_phase(float* X, const float* g, int rows, int gw, int NGW, int lane) {
    asm volatile("" : "+v"(lane));
    for (int m = gw; m < rows; m += NGW) {
        GAS f32x4* xr = (GAS f32x4*)(X + (size_t)m * D) + lane;
        f32x4 v[4]; float s = 0.f;
#pragma unroll
        for (int j = 0; j < 4; ++j) { v[j] = xr[64 * j]; s += (v[j].x * v[j].x + v[j].y * v[j].y) + (v[j].z * v[j].z + v[j].w * v[j].w); }
        const float rs = rsqrtf(wave_sum(s, lane) * (1.f / D) + 1e-6f);
#pragma unroll
        for (int j = 0; j < 4; ++j) { const f32x4 gj = ((const GAS f32x4*)g)[lane + 64 * j]; xr[64 * j] = v[j] * rs * gj; }
    }
}

__device__ __forceinline__ void pre_phase(const bf16* PROJB, const float* ROPE, float* RS, bf16* KMB, int gw, int NGW, int lane) {
    asm volatile("" : "+v"(lane));
    for (int t = gw; t < T; t += NGW) {
        const bf16* pr = PROJB + (size_t)t * INP;
        float sq = 0.f, skv = 0.f;
        if (lane < 24) { const v4u w = *(const GAS v4u*)(pr + PC_CQ + 8 * lane);
            const float a0 = bflo(w.x), a1 = bfhi(w.x), a2 = bflo(w.y), a3 = bfhi(w.y), a4 = bflo(w.z), a5 = bfhi(w.z), a6 = bflo(w.w), a7 = bfhi(w.w);
            sq = (a0 * a0 + a1 * a1) + (a2 * a2 + a3 * a3) + (a4 * a4 + a5 * a5) + (a6 * a6 + a7 * a7); }
        else if (lane >= 32 && lane < 48) { const v4u w = *(const GAS v4u*)(pr + PC_CKV + 8 * (lane - 32));
            const float a0 = bflo(w.x), a1 = bfhi(w.x), a2 = bflo(w.y), a3 = bfhi(w.y), a4 = bflo(w.z), a5 = bfhi(w.z), a6 = bflo(w.w), a7 = bfhi(w.w);
            skv = (a0 * a0 + a1 * a1) + (a2 * a2 + a3 * a3) + (a4 * a4 + a5 * a5) + (a6 * a6 + a7 * a7); }
        sq = wave_sum(sq, lane); skv = wave_sum(skv, lane);
        if (lane == 0) { RS[2 * (size_t)t] = rsqrtf(sq * (1.f / 192.f) + 1e-6f); RS[2 * (size_t)t + 1] = rsqrtf(skv * (1.f / 128.f) + 1e-6f); }
        if (lane < 16) {
            const float x1 = __builtin_bit_cast(float, (unsigned)pr[PC_KR + lane] << 16), x2 = __builtin_bit_cast(float, (unsigned)pr[PC_KR + 16 + lane] << 16);
            const float c = ROPE[(size_t)t * 32 + lane], sn = ROPE[(size_t)t * 32 + 16 + lane];
            const bf16 y1 = (bf16)f2bf_(x1 * c - x2 * sn), y2 = (bf16)f2bf_(x1 * sn + x2 * c);
            bf16* kr = KMB + (size_t)t * 384 + 64 + lane;
#pragma unroll
            for (int h = 0; h < 4; ++h) { kr[h * 96] = y1; kr[h * 96 + 16] = y2; }
        }
    }
}

struct LruP { const bf16* PROJB; const float* cw; const float* cb; const float* wa; const float* ba; const float* wx; const float* bx; const float* sp; bf16* HL; bf16* AC; float* LSUM; };
constexpr int LR_XP = 260;
constexpr int LR_XC = 0, LR_WA = 64 * LR_XP * 4, LR_WX = LR_WA + 16384, LR_SUM = LR_WX + 16384, LR_END = LR_SUM + 4096;
__device__ __forceinline__ void lru_phase(const LruP& P, LAS unsigned char* lds, int tid, int wave, int lane, int vcu, int G) {
    asm volatile("" : "+v"(tid), "+v"(lane));
    LAS float* xc = (LAS float*)(lds + LR_XC); LAS float* WA = (LAS float*)(lds + LR_WA); LAS float* WX = (LAS float*)(lds + LR_WX); LAS float* SUM = (LAS float*)(lds + LR_SUM);
    for (int u = vcu; u < (T / 256) * 8; u += G) {
        const int tile = u >> 3, g = u & 7; const int t0 = tile * 256; const bool first = ((tile & 31) == 0);
        __syncthreads();
#pragma unroll
        for (int i = 0; i < 2; ++i) { const int idx = tid + 512 * i; ((LAS f32x4*)WA)[idx] = ((const GAS f32x4*)(P.wa + g * 4096))[idx]; ((LAS f32x4*)WX)[idx] = ((const GAS f32x4*)(P.wx + g * 4096))[idx]; }
#pragma unroll 1
        for (int it = tid; it < 2048; it += 512) {
            const int time = it & 255, cg = it >> 8; const int ch0 = 64 * g + 8 * cg;
            float y[8];
            { const f32x4 b0 = *(const GAS f32x4*)(P.cb + ch0), b1 = *(const GAS f32x4*)(P.cb + ch0 + 4); y[0] = b0.x; y[1] = b0.y; y[2] = b0.z; y[3] = b0.w; y[4] = b1.x; y[5] = b1.y; y[6] = b1.z; y[7] = b1.w; }
#pragma unroll
            for (int k = 0; k < 4; ++k) {
                if (!(first && time - 3 + k < 0)) {
                    const v4u w = *(const GAS v4u*)(P.PROJB + (size_t)(t0 + time - 3 + k) * INP + PC_XL + ch0);
                    const f32x4 c0 = *(const GAS f32x4*)(P.cw + k * 512 + ch0), c1 = *(const GAS f32x4*)(P.cw + k * 512 + ch0 + 4);
                    y[0] += bflo(w.x) * c0.x; y[1] += bfhi(w.x) * c0.y; y[2] += bflo(w.y) * c0.z; y[3] += bfhi(w.y) * c0.w;
                    y[4] += bflo(w.z) * c1.x; y[5] += bfhi(w.z) * c1.y; y[6] += bflo(w.w) * c1.z; y[7] += bfhi(w.w) * c1.w;
                }
            }
#pragma unroll
            for (int e = 0; e < 8; ++e) xc[(8 * cg + e) * LR_XP + time] = y[e];
        }
        __syncthreads();
        float aa[32], ax[32];
        { const float b_a = P.ba[64 * g + lane], b_x = P.bx[64 * g + lane];
#pragma unroll
          for (int j = 0; j < 32; ++j) { aa[j] = b_a; ax[j] = b_x; } }
#pragma unroll 2
        for (int ci = 0; ci < 64; ++ci) {
            const float wa_ = WA[ci * 64 + lane], wx_ = WX[ci * 64 + lane];
            const LAS f32x4* xr = (const LAS f32x4*)(xc + ci * LR_XP + 32 * wave);
#pragma unroll
            for (int q = 0; q < 8; ++q) { const f32x4 xv = xr[q];
                aa[4 * q] += xv.x * wa_; aa[4 * q + 1] += xv.y * wa_; aa[4 * q + 2] += xv.z * wa_; aa[4 * q + 3] += xv.w * wa_;
                ax[4 * q] += xv.x * wx_; ax[4 * q + 1] += xv.y * wx_; ax[4 * q + 2] += xv.z * wx_; ax[4 * q + 3] += xv.w * wx_; }
        }
        { const float sp = P.sp[64 * g + lane];
          const LAS f32x4* xo = (const LAS f32x4*)(xc + lane * LR_XP + 32 * wave);
          float hrun = 0.f, arun = 1.f;
#pragma unroll
          for (int q = 0; q < 8; ++q) { const f32x4 xv = xo[q];
#pragma unroll
              for (int e = 0; e < 4; ++e) { const int j = 4 * q + e;
                  const float r = __builtin_amdgcn_rcpf(1.f + __builtin_amdgcn_exp2f(-LOG2E * aa[j])), ig = __builtin_amdgcn_rcpf(1.f + __builtin_amdgcn_exp2f(-LOG2E * ax[j]));
                  const float la = -8.0f * r * sp; const float a = __builtin_amdgcn_exp2f(LOG2E * la);
                  const float uu = __builtin_amdgcn_sqrtf(fmaxf(1.f - a * a, 0.f)) * (ig * xv[e]);
                  hrun = a * hrun + uu; arun *= a; aa[j] = arun; ax[j] = hrun; } }
          SUM[(wave * 64 + lane) * 2] = arun; SUM[(wave * 64 + lane) * 2 + 1] = hrun; }
        __syncthreads();
        float ca = 1.f, chh = 0.f;
        for (int w = 0; w < wave; ++w) { const float aw = SUM[(w * 64 + lane) * 2], hw = SUM[(w * 64 + lane) * 2 + 1]; chh = aw * chh + hw; ca *= aw; }
        { bf16* hl = P.HL + (size_t)(t0 + 32 * wave) * 512 + 64 * g + lane; bf16* ac = P.AC + (size_t)(t0 + 32 * wave) * 512 + 64 * g + lane;
#pragma unroll
          for (int j = 0; j < 32; ++j) { const float hh = ax[j] + aa[j] * chh, acc = aa[j] * ca; hl[(size_t)j * 512] = (bf16)f2bf_(hh); ac[(size_t)j * 512] = (bf16)f2bf_(acc);
              if (j == 31 && wave == 7) { P.LSUM[((size_t)tile * 512 + 64 * g + lane) * 2] = acc; P.LSUM[((size_t)tile * 512 + 64 * g + lane) * 2 + 1] = hh; } } }
    }
}

struct PostP { const bf16* OMB; const bf16* HL; const bf16* AC; const float* LSUM; const bf16* PROJB; const float* gm; const float* gl; bf16* Y; };
__device__ __forceinline__ void post_phase(const PostP& P, LAS unsigned char* lds, int tid, int wave, int lane, int vcu, int G) {
    asm volatile("" : "+v"(tid), "+v"(lane));
    LAS float* hin = (LAS float*)lds;
    for (int u = vcu; u < T / 64; u += G) {
        const int t0 = u * 64, tile = t0 >> 8, tb = tile & ~31;
        __syncthreads();
        { float h = 0.f;
          for (int c = tb; c < tile; ++c) { const float a = P.LSUM[((size_t)c * 512 + tid) * 2], hh = P.LSUM[((size_t)c * 512 + tid) * 2 + 1]; h = a * h + hh; }
          hin[tid] = h; }
        __syncthreads();
        f32x4 hi0 = *(const LAS f32x4*)(hin + 8 * lane), hi1 = *(const LAS f32x4*)(hin + 8 * lane + 4);
        const f32x4 g0 = *(const GAS f32x4*)(P.gl + 8 * lane), g1 = *(const GAS f32x4*)(P.gl + 8 * lane + 4), gmv = *(const GAS f32x4*)(P.gm + 4 * lane);
#pragma unroll 2
        for (int i = 0; i < 8; ++i) {
            const size_t t = (size_t)t0 + 8 * wave + i;
            const v4u hw = *(const GAS v4u*)(P.HL + t * 512 + 8 * lane), aw = *(const GAS v4u*)(P.AC + t * 512 + 8 * lane), gw_ = *(const GAS v4u*)(P.PROJB + t * INP + PC_GL + 8 * lane);
            const v2u mw = *(const GAS v2u*)(P.OMB + t * 256 + 4 * lane);
            float o[8];
            o[0] = (bflo(hw.x) + bflo(aw.x) * hi0.x) * gelu_erf(bflo(gw_.x)); o[1] = (bfhi(hw.x) + bfhi(aw.x) * hi0.y) * gelu_erf(bfhi(gw_.x));
            o[2] = (bflo(hw.y) + bflo(aw.y) * hi0.z) * gelu_erf(bflo(gw_.y)); o[3] = (bfhi(hw.y) + bfhi(aw.y) * hi0.w) * gelu_erf(bfhi(gw_.y));
            o[4] = (bflo(hw.z) + bflo(aw.z) * hi1.x) * gelu_erf(bflo(gw_.z)); o[5] = (bfhi(hw.z) + bfhi(aw.z) * hi1.y) * gelu_erf(bfhi(gw_.z));
            o[6] = (bflo(hw.w) + bflo(aw.w) * hi1.z) * gelu_erf(bflo(gw_.w)); o[7] = (bfhi(hw.w) + bfhi(aw.w) * hi1.w) * gelu_erf(bfhi(gw_.w));
            float s2 = 0.f;
#pragma unroll
            for (int e = 0; e < 8; ++e) s2 += o[e] * o[e];
            const float m0 = bflo(mw.x), m1 = bfhi(mw.x), m2 = bflo(mw.y), m3 = bfhi(mw.y);
            float s1 = (m0 * m0 + m1 * m1) + (m2 * m2 + m3 * m3);
            s1 = wave_sum(s1, lane); s2 = wave_sum(s2, lane);
            const float r1 = rsqrtf(s1 * (1.f / 256.f) + 1e-6f), r2 = rsqrtf(s2 * (1.f / 512.f) + 1e-6f);
            bf16* yr = P.Y + t * 1024;
            { v2u w; w.x = pk2(m0 * r1 * gmv.x, m1 * r1 * gmv.y); w.y = pk2(m2 * r1 * gmv.z, m3 * r1 * gmv.w); *(GAS v2u*)(yr + 4 * lane) = w; }
            { v4u w; w.x = pk2(o[0] * r2 * g0.x, o[1] * r2 * g0.y); w.y = pk2(o[2] * r2 * g0.z, o[3] * r2 * g0.w); w.z = pk2(o[4] * r2 * g1.x, o[5] * r2 * g1.y); w.w = pk2(o[6] * r2 * g1.z, o[7] * r2 * g1.w);
              *(GAS v4u*)(yr + 256 + 8 * lane) = w; }
        }
    }
}

typedef short bf16x8 __attribute__((ext_vector_type(8)));
typedef short s16x4 __attribute__((ext_vector_type(4)));
typedef float f32x16 __attribute__((ext_vector_type(16)));
typedef unsigned u32x4 __attribute__((ext_vector_type(4)));
__device__ __forceinline__ int crow(int r, int hi) { return (r & 3) + 8 * (r >> 2) + 4 * hi; }
typedef float f32x2_t __attribute__((ext_vector_type(2))); typedef __bf16 bf16x2_c __attribute__((ext_vector_type(2)));
__device__ __forceinline__ unsigned cvtpk(float lo, float hi) { f32x2_t v = {lo, hi}; bf16x2_c b = __builtin_convertvector(v, bf16x2_c); return __builtin_bit_cast(unsigned, b); }
__device__ __forceinline__ float swapmax(float m) { auto rr = __builtin_amdgcn_permlane32_swap(__float_as_uint(m), __float_as_uint(m), false, false); return fmaxf(__uint_as_float(rr[0]), __uint_as_float(rr[1])); }
__device__ __forceinline__ float swapadd(float m) { auto rr = __builtin_amdgcn_permlane32_swap(__float_as_uint(m), __float_as_uint(m), false, false); return __uint_as_float(rr[0]) + __uint_as_float(rr[1]); }
__device__ __forceinline__ s16x4 vtr(const LAS unsigned char* p) { return __builtin_bit_cast(s16x4, __builtin_amdgcn_ds_read_tr16_b64_v4i16((LAS s16x4*)p)); }
__device__ __forceinline__ bf16x8 pack8(const f32x16& p, int b) { u32x4 w; w.x = cvtpk(p[b], p[b + 1]); w.y = cvtpk(p[b + 2], p[b + 3]); w.z = cvtpk(p[b + 4], p[b + 5]); w.w = cvtpk(p[b + 6], p[b + 7]); return __builtin_bit_cast(bf16x8, w); }
__device__ __forceinline__ float max16(const f32x16& p) { float a = fmaxf(fmaxf(p[0], p[1]), fmaxf(p[2], p[3])), b = fmaxf(fmaxf(p[4], p[5]), fmaxf(p[6], p[7])), c = fmaxf(fmaxf(p[8], p[9]), fmaxf(p[10], p[11])), d = fmaxf(fmaxf(p[12], p[13]), fmaxf(p[14], p[15])); return fmaxf(fmaxf(a, b), fmaxf(c, d)); }

struct AttnP {
    const bf16* Q; const bf16* K; const bf16* V; int qp, kp, vp;
    bf16* O; int op;
    const float* rope;
    const int* pos; const float* btab; const float* dnorm; const float* lams;
};
template <int KIND> struct AK {
    static constexpr bool DIFF = KIND == 1, CROSS = KIND == 2;
    static constexpr int HW = KIND == 0 ? 96 : KIND == 1 ? 64 : 256;
    static constexpr int NKS = KIND == 0 ? 6 : KIND == 1 ? 2 : 16;
    static constexpr int KP = KIND == 0 ? 208 : KIND == 1 ? 144 : 528;
    static constexpr int ND = CROSS ? 4 : 2;
    static constexpr int CPK = HW / 8, KCH = (64 * CPK + 511) / 512;
    static constexpr int VCH = ND / 2;
    static constexpr int KB = 64 * KP, VB = ND * 4096;
    static constexpr int K0 = 0, V0 = 2 * KB, POS = V0 + 2 * VB, BT = POS + 512, DN = BT + 528, END = DN + 256;
};
static_assert(AK<2>::END <= RING_BYTES && AK<0>::END <= RING_BYTES, "attention LDS");

template <int KIND>
__device__ __forceinline__ void attn_unit(const AttnP& P, int b, int h, int qb, int dhalf, LAS unsigned char* lds, int tid, int wave, int lane) {
    asm volatile("" : "+v"(tid), "+v"(lane));
    typedef AK<KIND> C;
    constexpr bool DIFF = C::DIFF, CROSS = C::CROSS;
    constexpr int HW = C::HW, NKS = C::NKS, KP = C::KP, ND = C::ND, CPK = C::CPK, KCH = C::KCH, VCH = C::VCH;
    const int r32 = lane & 31, hi = lane >> 5;
    const size_t rowb = (size_t)b * S, rowk = CROSS ? (size_t)b * MEM : rowb;
    const int q0w = qb * 256 + wave * 32, qi = q0w + r32;
    int pq = 0; float bias_far = 0.f;
    __syncthreads();
    if (DIFF) {
        pq = P.pos[rowb + qi];
        if (tid < 129) ((LAS float*)(lds + C::BT))[tid] = P.btab[h * 129 + tid];
        if (tid >= 192 && tid < 256) ((LAS float*)(lds + C::DN))[tid - 192] = P.dnorm[tid - 192];
    }
    int minq = pq;
    if (DIFF) { for (int o = 1; o < 64; o <<= 1) { const int v = shxi(minq, o, lane); minq = v < minq ? v : minq; } }
    const int NT = CROSS ? MEM / 64 : 4 * (qb + 1);
    u32x4 kr[KCH], vr[VCH]; int pkr = 0;
    const bf16* Kb = P.K + rowk * P.kp + h * HW; const bf16* Vb = P.V + rowk * P.vp + (CROSS ? h * 256 + dhalf * 128 : h * 64);
    auto gload = [&](int t) {
        const int k0 = 64 * t;
#pragma unroll
        for (int i = 0; i < KCH; ++i) { const int c = tid + 512 * i; if (c < 64 * CPK) { const int key = c / CPK, part = c % CPK; kr[i] = *(const u32x4*)(Kb + (size_t)(k0 + key) * P.kp + part * 8); } }
#pragma unroll
        for (int i = 0; i < VCH; ++i) { const int c = tid + 512 * i; const int key = c / (4 * ND), part = c % (4 * ND); vr[i] = *(const u32x4*)(Vb + (size_t)(k0 + key) * P.vp + part * 8); }
        if (DIFF) { if (tid < 64) pkr = P.pos[rowb + k0 + tid]; }
    };
    auto lstore = [&](int buf) {
        LAS unsigned char* kb_ = lds + C::K0 + buf * C::KB; LAS unsigned char* vb_ = lds + C::V0 + buf * C::VB;
#pragma unroll
        for (int i = 0; i < KCH; ++i) { const int c = tid + 512 * i; if (c < 64 * CPK) { const int key = c / CPK, part = c % CPK; *(LAS u32x4*)(kb_ + key * KP + part * 16) = kr[i]; } }
#pragma unroll
        for (int i = 0; i < VCH; ++i) { const int c = tid + 512 * i; const int key = c / (4 * ND), part = c % (4 * ND); *(LAS u32x4*)(vb_ + (part >> 2) * 4096 + (key >> 3) * 512 + (key & 7) * 64 + (part & 3) * 16) = vr[i]; }
        if (DIFF) { if (tid < 64) ((LAS int*)(lds + C::POS + buf * 256))[tid] = pkr; }
    };
    f32x16 osv[2];
#pragma unroll
    for (int d = 0; d < 2; ++d)
#pragma unroll
        for (int r = 0; r < 16; ++r) osv[d][r] = 0.f;
    float il = 0.f;
    f32x16 oA[ND];
#pragma unroll 1
    for (int mp = 0; mp < (DIFF ? 2 : 1); ++mp) {
        bf16x8 qf[NKS];
        { const bf16* qrow = P.Q + (rowb + qi) * P.qp + h * HW + mp * 32;
#pragma unroll
          for (int s = 0; s < NKS; ++s) qf[s] = *(const bf16x8*)(qrow + 16 * s + 8 * hi);
          if (KIND == 0) {
              const float* rp = P.rope + (rowb + qi) * 32 + 8 * hi;
              const f32x4 c0 = *(const f32x4*)rp, c1 = *(const f32x4*)(rp + 4), s0 = *(const f32x4*)(rp + 16), s1 = *(const f32x4*)(rp + 20);
              const u32x4 a = __builtin_bit_cast(u32x4, qf[NKS - 2]), bq = __builtin_bit_cast(u32x4, qf[NKS - 1]); u32x4 ra, rb;
#pragma unroll
              for (int w = 0; w < 4; ++w) { const float cl = w < 2 ? c0[2 * w] : c1[2 * w - 4], ch = w < 2 ? c0[2 * w + 1] : c1[2 * w - 3], sl = w < 2 ? s0[2 * w] : s1[2 * w - 4], sh = w < 2 ? s0[2 * w + 1] : s1[2 * w - 3];
                  const float x1l = bflo(a[w]), x1h = bfhi(a[w]), x2l = bflo(bq[w]), x2h = bfhi(bq[w]);
                  ra[w] = cvtpk(x1l * cl - x2l * sl, x1h * ch - x2h * sh); rb[w] = cvtpk(x1l * sl + x2l * cl, x1h * sh + x2h * ch); }
              qf[NKS - 2] = __builtin_bit_cast(bf16x8, ra); qf[NKS - 1] = __builtin_bit_cast(bf16x8, rb);
          } }
        __syncthreads();
        gload(0); lstore(0);
        if (!CROSS) { if (NT > 1) gload(1); }
        __syncthreads();
        if (DIFF) bias_far = ((LAS float*)(lds + C::BT))[128];
        float m1 = -1e30f, l1 = 0.f;
#pragma unroll
        for (int d = 0; d < ND; ++d)
#pragma unroll
            for (int r = 0; r < 16; ++r) oA[d][r] = 0.f;
        for (int t = 0; t < NT; ++t) {
            const int buf = t & 1;
            if (!CROSS) { if (t + 1 < NT) { lstore(buf ^ 1); if (t + 2 < NT) gload(t + 2); } }
            const int k0 = 64 * t;
            if (CROSS || k0 <= q0w + 31) {
                const LAS unsigned char* kb_ = lds + C::K0 + buf * C::KB + r32 * KP + hi * 16 + mp * 64;
                const LAS unsigned char* vb_ = lds + C::V0 + buf * C::VB + ((lane >> 4) & 1) * 32 + (lane & 3) * 8 + (4 * hi + ((lane & 15) >> 2)) * 64;
                const bool partial = !CROSS && (k0 + 63 > q0w);
                bool nearb = false;
                if (DIFF) {
                    int mk_ = ((LAS int*)(lds + C::POS + buf * 256))[lane];
                    for (int o = 1; o < 64; o <<= 1) { const int v = shxi(mk_, o, lane); mk_ = v > mk_ ? v : mk_; }
                    nearb = (minq - mk_) < 128;
                }
                const float init = (DIFF && !nearb) ? bias_far : 0.f;
                f32x16 pa, pb;
#pragma unroll
                for (int r = 0; r < 16; ++r) { pa[r] = init; pb[r] = init; }
#pragma unroll
                for (int s = 0; s < NKS; ++s) { const bf16x8 a0 = *(const LAS bf16x8*)(kb_ + s * 32), a1 = *(const LAS bf16x8*)(kb_ + 32 * KP + s * 32);
                    pa = __builtin_amdgcn_mfma_f32_32x32x16_bf16(a0, qf[s], pa, 0, 0, 0); pb = __builtin_amdgcn_mfma_f32_32x32x16_bf16(a1, qf[s], pb, 0, 0, 0); }
                if (DIFF) { if (nearb) {
                    const LAS int* pk = (const LAS int*)(lds + C::POS + buf * 256); const LAS float* bt = (const LAS float*)(lds + C::BT);
#pragma unroll
                    for (int r = 0; r < 16; ++r) { const int kk = crow(r, hi);
                        int n0 = pq - pk[kk], n1 = pq - pk[kk + 32]; n0 = n0 < 0 ? 0 : (n0 > 128 ? 128 : n0); n1 = n1 < 0 ? 0 : (n1 > 128 ? 128 : n1);
                        pa[r] += bt[n0]; pb[r] += bt[n1]; }
                } }
                if (partial) {
#pragma unroll
                    for (int r = 0; r < 16; ++r) { const int kk = k0 + crow(r, hi); if (kk > qi) pa[r] = -1e30f; if (kk + 32 > qi) pb[r] = -1e30f; }
                }
                const float mx = swapmax(fmaxf(max16(pa), max16(pb))); const float mn = fmaxf(m1, mx); const float al = __builtin_amdgcn_exp2f(m1 - mn); m1 = mn;
                float ls = 0.f;
#pragma unroll
                for (int r = 0; r < 16; ++r) { pa[r] = __builtin_amdgcn_exp2f(pa[r] - mn); pb[r] = __builtin_amdgcn_exp2f(pb[r] - mn); ls += pa[r] + pb[r]; }
                l1 = l1 * al + ls;
                bf16x8 pf[4];
                pf[0] = pack8(pa, 0); pf[1] = pack8(pa, 8); pf[2] = pack8(pb, 0); pf[3] = pack8(pb, 8);
#pragma unroll
                for (int d = 0; d < ND; ++d) {
                    if (CROSS) __builtin_amdgcn_sched_barrier(0);
#pragma unroll
                    for (int r = 0; r < 16; ++r) oA[d][r] *= al;
#pragma unroll
                    for (int s = 0; s < 4; ++s) { const s16x4 lo = vtr(vb_ + d * 4096 + s * 1024), hh = vtr(vb_ + d * 4096 + s * 1024 + 512);
                        const bf16x8 vf = (bf16x8){lo[0], lo[1], lo[2], lo[3], hh[0], hh[1], hh[2], hh[3]};
                        oA[d] = __builtin_amdgcn_mfma_f32_32x32x16_bf16(vf, pf[s], oA[d], 0, 0, 0); }
                }
            }
            if (CROSS) { if (t + 1 < NT) { gload(t + 1); lstore(buf ^ 1); } }
            __syncthreads();
        }
        il = 1.f / swapadd(l1);
        if (DIFF) { if (mp == 0) {
#pragma unroll
            for (int d = 0; d < 2; ++d)
#pragma unroll
                for (int r = 0; r < 16; ++r) osv[d][r] = oA[d][r] * il; } }
    }
    bf16* orow = P.O + (rowb + qi) * P.op + (CROSS ? h * 256 + dhalf * 128 : h * 64);
    if (!DIFF) {
#pragma unroll
        for (int d = 0; d < ND; ++d)
#pragma unroll
            for (int g = 0; g < 4; ++g) { v2u v; v.x = cvtpk(oA[d][4 * g] * il, oA[d][4 * g + 1] * il); v.y = cvtpk(oA[d][4 * g + 2] * il, oA[d][4 * g + 3] * il); *(v2u*)(orow + 32 * d + 8 * g + 4 * hi) = v; }
    } else {
        const float lam = P.lams[0], lam_init = P.lams[1];
        const float i2 = lam * il;
        float ss = 0.f;
#pragma unroll
        for (int d = 0; d < 2; ++d)
#pragma unroll
            for (int r = 0; r < 16; ++r) { const float v = osv[d][r] - oA[d][r] * i2; oA[d][r] = v; ss += v * v; }
        ss = swapadd(ss);
        const float rs = __builtin_amdgcn_rsqf(ss * (1.f / 64.f) + 1e-6f) * (1.f - lam_init);
        const LAS float* dn = (const LAS float*)(lds + C::DN);
#pragma unroll
        for (int d = 0; d < 2; ++d)
#pragma unroll
            for (int g = 0; g < 4; ++g) { const int c = 32 * d + 8 * g + 4 * hi; const f32x4 gn = *(const LAS f32x4*)(dn + c);
                v2u v; v.x = cvtpk(oA[d][4 * g] * rs * gn[0], oA[d][4 * g + 1] * rs * gn[1]); v.y = cvtpk(oA[d][4 * g + 2] * rs * gn[2], oA[d][4 * g + 3] * rs * gn[3]); *(v2u*)(orow + c) = v; }
    }
}

__device__ __forceinline__ void attn_phase(const AttnP& PM, const AttnP& PD, LAS unsigned char* lds, int tid, int wave, int lane, int vcu, int G) {
    for (int i = vcu; i < 512; i += G) {
        const int kind = i >> 8, c = i & 255, bh = c >> 4, s = c & 15;
        if (kind == 0) {
#pragma unroll 1
            for (int k = 0; k < 2; ++k) attn_unit<0>(PM, bh >> 2, bh & 3, k ? 31 - s : s, 0, lds, tid, wave, lane);
        } else {
#pragma unroll 1
            for (int k = 0; k < 2; ++k) attn_unit<1>(PD, bh >> 2, bh & 3, k ? 31 - s : s, 0, lds, tid, wave, lane);
        }
    }
}
__device__ __forceinline__ void cross_phase(const AttnP& PC, LAS unsigned char* lds, int tid, int wave, int lane, int vcu, int G) {
#pragma unroll 1
    for (int i = vcu; i < 1024; i += G) { const int bh = i >> 6; attn_unit<2>(PC, bh >> 2, bh & 3, i & 31, (i >> 5) & 1, lds, tid, wave, lane); }
}

__device__ __forceinline__ float vmax2(float a, float b) { float r; asm("v_max_f32_e32 %0, %1, %2" : "=v"(r) : "v"(a), "v"(b)); return r; }
__device__ __forceinline__ float vmin2(float a, float b) { float r; asm("v_min_f32_e32 %0, %1, %2" : "=v"(r) : "v"(a), "v"(b)); return r; }
__device__ __forceinline__ void pad16(float (&a)[16]) {
    asm volatile("s_nop 1" : "+v"(a[0]), "+v"(a[1]), "+v"(a[2]), "+v"(a[3]), "+v"(a[4]), "+v"(a[5]), "+v"(a[6]), "+v"(a[7]), "+v"(a[8]), "+v"(a[9]), "+v"(a[10]), "+v"(a[11]), "+v"(a[12]), "+v"(a[13]), "+v"(a[14]), "+v"(a[15]));
}
__device__ __forceinline__ void sort16_desc(float (&a)[16]) {
#pragma unroll
    for (int k = 2; k <= 16; k <<= 1)
#pragma unroll
        for (int j = k >> 1; j > 0; j >>= 1)
#pragma unroll
            for (int i = 0; i < 16; ++i) { const int l = i ^ j; if (l > i) { const bool desc = ((i & k) == 0); const float hi_ = vmax2(a[i], a[l]), lo_ = vmin2(a[i], a[l]); a[i] = desc ? hi_ : lo_; a[l] = desc ? lo_ : hi_; } }
}
__device__ __forceinline__ void merge16_desc(float (&a)[16], const float (&b)[16]) {
#pragma unroll
    for (int i = 0; i < 16; ++i) a[i] = vmax2(a[i], b[15 - i]);
#pragma unroll
    for (int j = 8; j > 0; j >>= 1)
#pragma unroll
        for (int i = 0; i < 16; ++i) { const int l = i ^ j; if (l > i) { const float hi_ = vmax2(a[i], a[l]), lo_ = vmin2(a[i], a[l]); a[i] = hi_; a[l] = lo_; } }
}
__device__ __forceinline__ void top16_of_64(float (&g0)[16], float (&g1)[16], float (&g2)[16], float (&g3)[16]) {
    sort16_desc(g0); sort16_desc(g1); merge16_desc(g0, g1); sort16_desc(g2); sort16_desc(g3); merge16_desc(g2, g3); merge16_desc(g0, g2);
}
__device__ __forceinline__ float embed(float v, unsigned mask, unsigned id) { return __builtin_bit_cast(float, (__builtin_bit_cast(unsigned, v) & mask) | id); }
__device__ __forceinline__ float mkcand(float x, float y, unsigned id) { return embed(x + y, 0xFFFFFF00u, id); }

__device__ __forceinline__ void swap32(float& a, float& b) { asm volatile("v_nop\n\tv_nop\n\tv_permlane32_swap_b32 %0, %1" : "+v"(a), "+v"(b)); }
struct RouteP { const bf16* QP; const bf16* keys; int* EX; float* GW; };
constexpr int RT_KP = 144, RT_KEYS = 0, RT_SCR = 256 * RT_KP, RT_END = RT_SCR + 8 * 8192;
__device__ __forceinline__ void route_phase(const RouteP& P, LAS unsigned char* lds, int tid, int wave, int lane, int vcu, int G) {
    asm volatile("" : "+v"(tid), "+v"(lane));
    __syncthreads();
    for (int c = tid; c < 256 * 8; c += 512) { const int row = c >> 3, part = c & 7; *(LAS u32x4*)(lds + RT_KEYS + row * RT_KP + part * 16) = *(const u32x4*)(P.keys + row * 64 + part * 8); }
    __syncthreads();
    const int r32 = lane & 31, hi = lane >> 5;
    LAS int* scr = (LAS int*)(lds + RT_SCR + wave * 8192);
    for (int u = vcu; u < T / 32; u += G) {
        const size_t t = (size_t)u * 32 + r32; const int h = wave;
        float T2[2][16];
#pragma unroll
        for (int c = 0; c < 2; ++c) {
            bf16x8 qf[4];
            { const bf16* q = P.QP + t * 1024 + h * 128 + c * 64 + 8 * hi;
#pragma unroll
              for (int s = 0; s < 4; ++s) qf[s] = *(const bf16x8*)(q + 16 * s); }
            f32x16 sc[4];
#pragma unroll
            for (int m = 0; m < 4; ++m) {
#pragma unroll
                for (int r = 0; r < 16; ++r) sc[m][r] = 0.f;
#pragma unroll
                for (int s = 0; s < 4; ++s) { const bf16x8 a = *(const LAS bf16x8*)(lds + RT_KEYS + (c * 128 + 32 * m + r32) * RT_KP + s * 32 + hi * 16);
                    sc[m] = __builtin_amdgcn_mfma_f32_32x32x16_bf16(a, qf[s], sc[m], 0, 0, 0); }
            }
            float g0[16], g1[16], g2[16], g3[16];
            const unsigned h4 = 4u * (unsigned)hi;
#pragma unroll
            for (int r = 0; r < 16; ++r) { const unsigned kr_ = (unsigned)((r & 3) + 8 * (r >> 2));
                g0[r] = embed(sc[0][r], 0xFFFFFF80u, kr_ | h4); g1[r] = embed(sc[1][r], 0xFFFFFF80u, (32u + kr_) | h4); g2[r] = embed(sc[2][r], 0xFFFFFF80u, (64u + kr_) | h4); g3[r] = embed(sc[3][r], 0xFFFFFF80u, (96u + kr_) | h4); }
            top16_of_64(g0, g1, g2, g3);
            pad16(g0);
#pragma unroll
            for (int i = 0; i < 16; ++i) T2[c][i] = g0[i];
        }
        float A[16], Bv[16];
#pragma unroll
        for (int i = 0; i < 16; ++i) { A[i] = T2[0][i]; Bv[i] = T2[1][i]; swap32(A[i], Bv[i]); }
        merge16_desc(A, Bv);
        pad16(A);
        float T0[16], T1[16];
#pragma unroll
        for (int i = 0; i < 16; ++i) { T0[i] = A[i]; T1[i] = A[i]; swap32(T0[i], T1[i]); }
#pragma unroll
        for (int i = 0; i < 16; ++i) { scr[i * 64 + lane] = (int)(__builtin_bit_cast(unsigned, T0[i]) & 127u); scr[(16 + i) * 64 + lane] = (int)(__builtin_bit_cast(unsigned, T1[i]) & 127u);
            T0[i] = embed(T0[i], 0xFFFFFF80u, 0u); T1[i] = embed(T1[i], 0xFFFFFF80u, 0u); }
        float c0[16], c1[16], c2[16], c3[16];
        const float NINF = -__builtin_inff();
#pragma unroll
        for (int b = 0; b < 16; ++b) c0[b] = mkcand(T0[0], T1[b], (unsigned)b);
#pragma unroll
        for (int b = 0; b < 8; ++b) c1[b] = mkcand(T0[1], T1[b], 16u + b);
#pragma unroll
        for (int b = 0; b < 5; ++b) c1[8 + b] = mkcand(T0[2], T1[b], 32u + b);
#pragma unroll
        for (int b = 0; b < 3; ++b) c1[13 + b] = mkcand(T0[4], T1[b], 64u + b);
#pragma unroll
        for (int b = 0; b < 4; ++b) c2[b] = mkcand(T0[3], T1[b], 48u + b);
        c2[4] = mkcand(T0[5], T1[0], 80u); c2[5] = mkcand(T0[5], T1[1], 81u); c2[6] = mkcand(T0[6], T1[0], 96u); c2[7] = mkcand(T0[6], T1[1], 97u); c2[8] = mkcand(T0[7], T1[0], 112u); c2[9] = mkcand(T0[7], T1[1], 113u);
#pragma unroll
        for (int a = 8; a < 14; ++a) c2[10 + a - 8] = mkcand(T0[a], T1[0], 16u * a);
        c3[0] = mkcand(T0[14], T1[0], 224u); c3[1] = mkcand(T0[15], T1[0], 240u);
#pragma unroll
        for (int i = 2; i < 16; ++i) c3[i] = NINF;
        top16_of_64(c0, c1, c2, c3);
        pad16(c0);
        float gsum = 0.f, ge[16]; int ex[16];
        const float mtop = embed(c0[0], 0xFFFFFF00u, 0u);
#pragma unroll
        for (int i = 0; i < 16; ++i) { const unsigned bits = __builtin_bit_cast(unsigned, c0[i]); const int a = (bits >> 4) & 15, b = bits & 15;
            ge[i] = __builtin_amdgcn_exp2f((embed(c0[i], 0xFFFFFF00u, 0u) - mtop) * LOG2E); gsum += ge[i];
            ex[i] = scr[a * 64 + lane] * 128 + scr[(16 + b) * 64 + lane]; }
        const float ginv = __builtin_amdgcn_rcpf(gsum);
        if (hi == 0) { GAS v4u* d = (GAS v4u*)(P.EX + t * 128 + h * 16);
#pragma unroll
            for (int i = 0; i < 4; ++i) d[i] = (v4u){(unsigned)ex[4 * i], (unsigned)ex[4 * i + 1], (unsigned)ex[4 * i + 2], (unsigned)ex[4 * i + 3]}; }
        else { GAS f32x4* d = (GAS f32x4*)(P.GW + t * 128 + h * 16);
#pragma unroll
            for (int i = 0; i < 4; ++i) d[i] = (f32x4){ge[4 * i] * ginv, ge[4 * i + 1] * ginv, ge[4 * i + 2] * ginv, ge[4 * i + 3] * ginv}; }
    }
}

__device__ __forceinline__ int wave_allsum_i(int v) {
    v += __builtin_amdgcn_update_dpp(0, v, 0xB1, 0xF, 0xF, true);
    v += __builtin_amdgcn_update_dpp(0, v, 0x4E, 0xF, 0xF, true);
    v += __builtin_amdgcn_update_dpp(0, v, 0x141, 0xF, 0xF, true);
    v += __builtin_amdgcn_update_dpp(0, v, 0x140, 0xF, 0xF, true);
    { int a = v, b = v; asm volatile("v_nop\n\tv_nop\n\tv_permlane16_swap_b32 %0, %1" : "+v"(a), "+v"(b)); v = a + b; }
    { int a = v, b = v; asm volatile("v_nop\n\tv_nop\n\tv_permlane32_swap_b32 %0, %1" : "+v"(a), "+v"(b)); v = a + b; }
    return v;
}
__device__ __forceinline__ float wave_allsum(float v) {
    v += __builtin_bit_cast(float, __builtin_amdgcn_update_dpp(0, __builtin_bit_cast(int, v), 0xB1, 0xF, 0xF, true));
    v += __builtin_bit_cast(float, __builtin_amdgcn_update_dpp(0, __builtin_bit_cast(int, v), 0x4E, 0xF, 0xF, true));
    v += __builtin_bit_cast(float, __builtin_amdgcn_update_dpp(0, __builtin_bit_cast(int, v), 0x141, 0xF, 0xF, true));
    v += __builtin_bit_cast(float, __builtin_amdgcn_update_dpp(0, __builtin_bit_cast(int, v), 0x140, 0xF, 0xF, true));
    { float a = v, b = v; asm volatile("v_nop\n\tv_nop\n\tv_permlane16_swap_b32 %0, %1" : "+v"(a), "+v"(b)); v = a + b; }
    { float a = v, b = v; asm volatile("v_nop\n\tv_nop\n\tv_permlane32_swap_b32 %0, %1" : "+v"(a), "+v"(b)); v = a + b; }
    return v;
}
__device__ __forceinline__ float wave_allmax(float v) {
    v = fmaxf(v, __builtin_bit_cast(float, __builtin_amdgcn_update_dpp(0, __builtin_bit_cast(int, v), 0xB1, 0xF, 0xF, true)));
    v = fmaxf(v, __builtin_bit_cast(float, __builtin_amdgcn_update_dpp(0, __builtin_bit_cast(int, v), 0x4E, 0xF, 0xF, true)));
    v = fmaxf(v, __builtin_bit_cast(float, __builtin_amdgcn_update_dpp(0, __builtin_bit_cast(int, v), 0x141, 0xF, 0xF, true)));
    v = fmaxf(v, __builtin_bit_cast(float, __builtin_amdgcn_update_dpp(0, __builtin_bit_cast(int, v), 0x140, 0xF, 0xF, true)));
    { float a = v, b = v; asm volatile("v_nop\n\tv_nop\n\tv_permlane16_swap_b32 %0, %1" : "+v"(a), "+v"(b)); v = fmaxf(a, b); }
    { float a = v, b = v; asm volatile("v_nop\n\tv_nop\n\tv_permlane32_swap_b32 %0, %1" : "+v"(a), "+v"(b)); v = fmaxf(a, b); }
    return v;
}
__device__ __forceinline__ unsigned q4(float a, float b, float c, float d, int off) {
    const int ia = (int)__builtin_rintf(a) + off, ib = (int)__builtin_rintf(b) + off, ic = (int)__builtin_rintf(c) + off, id = (int)__builtin_rintf(d) + off;
    return (unsigned)(ia & 255) | ((unsigned)(ib & 255) << 8) | ((unsigned)(ic & 255) << 16) | ((unsigned)(id & 255) << 24);
}
__device__ __forceinline__ void quant_row(const float* src, unsigned* dst, float* scale, int off, int lane) {
    const GAS f32x4* s = (const GAS f32x4*)src + 4 * lane; f32x4 v[4]; float m = 0.f;
#pragma unroll
    for (int i = 0; i < 4; ++i) { v[i] = s[i]; m = fmaxf(m, fmaxf(fmaxf(__builtin_fabsf(v[i].x), __builtin_fabsf(v[i].y)), fmaxf(__builtin_fabsf(v[i].z), __builtin_fabsf(v[i].w)))); }
    m = wave_allmax(m); const float inv = m > 0.f ? 127.f / m : 0.f;
    v4u w;
    w.x = q4(v[0].x * inv, v[0].y * inv, v[0].z * inv, v[0].w * inv, off); w.y = q4(v[1].x * inv, v[1].y * inv, v[1].z * inv, v[1].w * inv, off);
    w.z = q4(v[2].x * inv, v[2].y * inv, v[2].z * inv, v[2].w * inv, off); w.w = q4(v[3].x * inv, v[3].y * inv, v[3].z * inv, v[3].w * inv, off);
    *((GAS v4u*)dst + lane) = w;
    if (lane == 0) *scale = m * (1.f / 127.f);
}
struct PeerS { int nslices_step, first_slice, nloc, rank; };
__device__ __forceinline__ PeerS peer_sched(const unsigned* rankw, int xcc, int rank) {
    int nx = 0, myidx = 0, nloc = 1;
    for (int j = 0; j < 16; ++j) { const int c = (int)__hip_atomic_load(rankw + 64 * j, __ATOMIC_RELAXED, __HIP_MEMORY_SCOPE_AGENT); if (c > 0) { if (j == xcc) { myidx = nx; nloc = c; } ++nx; } }
    PeerS s; s.nslices_step = nx > 0 ? nx : 1; s.first_slice = myidx; s.nloc = nloc; s.rank = rank; return s;
}
struct Peer1P { const unsigned char* HQ; const int* EX; const unsigned char* U8; int* P; };
__device__ __forceinline__ void peer_k1(const Peer1P& Q, const PeerS& sc, int wave, int lane) {
    asm volatile("" : "+v"(lane));
    const int g = lane >> 3, j = lane & 7;
    for (int s = sc.first_slice; s < 8; s += sc.nslices_step)
        for (int tile = sc.rank; tile < T / 64; tile += sc.nloc) {
            const size_t t0 = (size_t)tile * 64 + wave * 8;
            v4u hqn = *(const GAS v4u*)(Q.HQ + t0 * 1024 + 128 * s + 16 * j), exn[4];
#pragma unroll
            for (int i = 0; i < 4; ++i) exn[i] = *(const GAS v4u*)(Q.EX + t0 * 128 + 16 * g + 4 * i);
#pragma unroll 1
            for (int k = 0; k < 8; ++k) {
                const size_t t = t0 + k;
                const v4u hq = hqn; v4u ex[4];
#pragma unroll
                for (int i = 0; i < 4; ++i) ex[i] = exn[i];
                if (k + 1 < 8) {
                    hqn = *(const GAS v4u*)(Q.HQ + (t + 1) * 1024 + 128 * s + 16 * j);
#pragma unroll
                    for (int i = 0; i < 4; ++i) exn[i] = *(const GAS v4u*)(Q.EX + (t + 1) * 128 + 16 * g + 4 * i);
                }
                v4u uu[16];
#pragma unroll
                for (int i = 0; i < 16; ++i) { const unsigned e = (i & 3) == 0 ? ex[i >> 2].x : (i & 3) == 1 ? ex[i >> 2].y : (i & 3) == 2 ? ex[i >> 2].z : ex[i >> 2].w;
                    uu[i] = *(const GAS v4u*)(Q.U8 + (size_t)e * 1024 + 128 * s + 16 * j); }
                int lo = 0, hi = 0;
#pragma unroll
                for (int i = 0; i < 16; ++i) {
                    int p = __builtin_amdgcn_sdot4((int)uu[i].x, (int)hq.x, 0, false); p = __builtin_amdgcn_sdot4((int)uu[i].y, (int)hq.y, p, false); p = __builtin_amdgcn_sdot4((int)uu[i].z, (int)hq.z, p, false); p = __builtin_amdgcn_sdot4((int)uu[i].w, (int)hq.w, p, false);
                    p += __builtin_amdgcn_update_dpp(0, p, 0xB1, 0xF, 0xF, true); p += __builtin_amdgcn_update_dpp(0, p, 0x4E, 0xF, 0xF, true); p += __builtin_amdgcn_update_dpp(0, p, 0x141, 0xF, 0xF, true);
                    if (i < 8) lo = (j == i) ? p : lo; else hi = (j == i - 8) ? p : hi;
                }
                int* prow = Q.P + t * 128 + 16 * g + j;
                (void)__hip_atomic_fetch_add(prow, lo, __ATOMIC_RELAXED, __HIP_MEMORY_SCOPE_AGENT); (void)__hip_atomic_fetch_add(prow + 8, hi, __ATOMIC_RELAXED, __HIP_MEMORY_SCOPE_AGENT);
            }
        }
}
__device__ __forceinline__ void peer_w(const int* EX, const float* GW, const int* P, const float* SH, const float* SU, const float* SV, float* W, float* WS, int gw, int NGW, int lane) {
    asm volatile("" : "+v"(lane));
    for (int t = gw; t < T; t += NGW) {
        const float sh = SH[t]; float wsum = 0.f;
#pragma unroll
        for (int q = 0; q < 2; ++q) { const size_t idx = (size_t)t * 128 + lane + 64 * q; const int e = EX[idx];
            const float w = GW[idx] * gelu_erf((float)P[idx] * (sh * SU[e])) * SV[e]; W[idx] = w; wsum += w; }
        wsum = wave_allsum(wsum);
        if (lane == 0) WS[t] = wsum;
    }
}
struct Peer2P { const int* EX; const float* W; const float* WS; const unsigned char* V8; float* X; };
__device__ __forceinline__ void peer_k2(const Peer2P& Q, const PeerS& sc, int wave, int lane) {
    asm volatile("" : "+v"(lane));
    const int g = lane >> 3, j = lane & 7, hf = lane >> 5, rp = (lane >> 4) & 1;
    for (int s = sc.first_slice; s < 8; s += sc.nslices_step)
        for (int tile = sc.rank; tile < T / 64; tile += sc.nloc) {
            const size_t t0 = (size_t)tile * 64 + wave * 8;
            v4u exn[4]; f32x4 wn[4];
#pragma unroll
            for (int i = 0; i < 4; ++i) { exn[i] = *(const GAS v4u*)(Q.EX + t0 * 128 + 16 * g + 4 * i); wn[i] = *(const GAS f32x4*)(Q.W + t0 * 128 + 16 * g + 4 * i); }
#pragma unroll 1
            for (int k = 0; k < 8; ++k) {
                const size_t t = t0 + k;
                v4u ex[4]; f32x4 wv[4];
#pragma unroll
                for (int i = 0; i < 4; ++i) { ex[i] = exn[i]; wv[i] = wn[i]; }
                if (k + 1 < 8) {
#pragma unroll
                    for (int i = 0; i < 4; ++i) { exn[i] = *(const GAS v4u*)(Q.EX + (t + 1) * 128 + 16 * g + 4 * i); wn[i] = *(const GAS f32x4*)(Q.W + (t + 1) * 128 + 16 * g + 4 * i); }
                }
                const float wsum = Q.WS[t];
                GAS f32x4* xp = (GAS f32x4*)(Q.X + t * 1024 + 128 * s + 16 * j + 8 * hf + 4 * rp);
                const f32x4 xold = *xp;
                v4u vv[16];
#pragma unroll
                for (int i = 0; i < 16; ++i) { const unsigned e = (i & 3) == 0 ? ex[i >> 2].x : (i & 3) == 1 ? ex[i >> 2].y : (i & 3) == 2 ? ex[i >> 2].z : ex[i >> 2].w;
                    vv[i] = *(const GAS v4u*)(Q.V8 + (size_t)e * 1024 + 128 * s + 16 * j); }
                float acc[16];
#pragma unroll
                for (int i = 0; i < 16; ++i) acc[i] = 0.f;
#pragma unroll
                for (int i = 0; i < 16; ++i) { const float w = wv[i >> 2][i & 3];
#pragma unroll
                    for (int c = 0; c < 4; ++c) { const unsigned d = c == 0 ? vv[i].x : c == 1 ? vv[i].y : c == 2 ? vv[i].z : vv[i].w;
                        acc[4 * c] += w * (float)(d & 255u); acc[4 * c + 1] += w * (float)((d >> 8) & 255u); acc[4 * c + 2] += w * (float)((d >> 16) & 255u); acc[4 * c + 3] += w * (float)(d >> 24); }
                }
                float r8[8], r4[4];
#pragma unroll
                for (int m = 0; m < 8; ++m) { float a = acc[m], b = acc[m + 8]; swap32(a, b); r8[m] = a + b; }
#pragma unroll
                for (int n = 0; n < 4; ++n) { float a = r8[n], b = r8[n + 4]; asm volatile("v_nop\n\tv_nop\n\tv_permlane16_swap_b32 %0, %1" : "+v"(a), "+v"(b)); r4[n] = a + b; }
#pragma unroll
                for (int n = 0; n < 4; ++n) r4[n] += __builtin_bit_cast(float, __builtin_amdgcn_update_dpp(0, __builtin_bit_cast(int, r4[n]), 0x128, 0xF, 0xF, true));
                if ((lane & 8) == 0) { const float corr = 128.f * wsum; *xp = xold + (f32x4){r4[0] - corr, r4[1] - corr, r4[2] - corr, r4[3] - corr}; }
            }
        }
}

struct Args { const float* in[33]; float* out; unsigned char* ws; int ph_lo, ph_hi; };
struct Frame { LAS unsigned char* lds; volatile LAS unsigned* MISC; gu32* ctl; int tid, lane, wave, G, vcu, xcc, xrank; };

__device__ __forceinline__ void transpose_item(const float* W, int ldw, int nsrc0, bf16* WT, int ldt, int rdst0, LAS float* scr, int kb, int nb, int lane, float scale, const float* kgain) {
    const int k0 = 64 * kb, n0 = 32 * nb;
#pragma unroll 8
    for (int i = 0; i < 32; ++i) { const int kk = 2 * i + (lane >> 5); const float gsc = kgain ? kgain[k0 + kk] * scale : scale; scr[kk * 33 + (lane & 31)] = W[(size_t)(k0 + kk) * ldw + nsrc0 + n0 + (lane & 31)] * gsc; }
    LDS_WAIT(); asm volatile("" ::: "memory");
    const int c = lane & 7;
#pragma unroll
    for (int j = 0; j < 4; ++j) { const int n = (lane >> 3) + 8 * j; const LAS float* s = scr + (8 * c) * 33 + n;
        v4u o; o.x = pk2(s[0 * 33], s[1 * 33]); o.y = pk2(s[2 * 33], s[3 * 33]); o.z = pk2(s[4 * 33], s[5 * 33]); o.w = pk2(s[6 * 33], s[7 * 33]);
        *(GAS v4u*)(WT + (size_t)(rdst0 + n0 + n) * ldt + k0 + 8 * c) = o; }
    LDS_WAIT(); asm volatile("" ::: "memory");
}
__device__ __forceinline__ void zero_rect(bf16* base, int ld, int row0, int nrows, int col0, int ncols, int gtid, int gthreads) {
    const int vpr = ncols / 8;
    for (int i = gtid; i < nrows * vpr; i += gthreads) { const int r = i / vpr, c = i % vpr; *(GAS v4u*)(base + (size_t)(row0 + r) * ld + col0 + 8 * c) = (v4u){0u, 0u, 0u, 0u}; }
}

__device__ __forceinline__ void p0_prologue(Frame& F, const Args& a) {
    LAS float* scr = (LAS float*)(F.lds + RING_OFF + F.wave * 16384);
    const int gw = blockIdx.x * NWAVES + F.wave, NGW = F.G * NWAVES;
    const int gtid = blockIdx.x * (NWAVES * 64) + F.tid, gthreads = F.G * NWAVES * 64;
    unsigned char* ws = a.ws;
    { const GAS f32x4* src = (const GAS f32x4*)a.in[0]; GAS f32x4* dst = (GAS f32x4*)a.out; const size_t n4 = (size_t)T * D / 4;
      for (size_t i = gtid; i < n4; i += (size_t)gthreads) dst[i] = src[i]; }
    constexpr int I_IN = 16 * (INW / 32), I_SQ = 16 * 32, I_CKV = 16 * 64, I_UQ = 3 * 12, I_UKV = 2 * 16, I_L = I_IN + 4 * I_SQ + I_CKV + I_UQ + I_UKV;
    for (int it = gw; it < L * I_L; it += NGW) {
        const int l = it / I_L; int r = it % I_L;
        if (r < I_IN) {
            const int kb = r / 67, nb = r % 67; int src, dst; float sc = 1.f;
            if (nb < 6) { src = 32 * nb; dst = src; } else if (nb < 11) { src = 32 * nb; dst = src + 64; } else { src = 32 * nb; dst = src + 160; if (nb >= 43 && nb < 51) sc = 0.17677669529663687f * LOG2E; }
            transpose_item(a.in[5] + (size_t)l * D * INW, INW, src, (bf16*)(ws + WS_WIN) + (size_t)l * INP * D, D, dst, scr, kb, 0, F.lane, sc, nullptr); continue; } r -= I_IN;
        if (r < I_SQ) { transpose_item(a.in[21] + (size_t)l * D * D, D, 0, (bf16*)(ws + WS_WOUT) + (size_t)l * D * D, D, 0, scr, r / 32, r % 32, F.lane, 1.f, nullptr); continue; } r -= I_SQ;
        if (r < I_SQ) { transpose_item(a.in[24] + (size_t)l * D * D, D, 0, (bf16*)(ws + WS_WCQ) + (size_t)l * D * D, D, 0, scr, r / 32, r % 32, F.lane, 0.0625f * LOG2E, nullptr); continue; } r -= I_SQ;
        if (r < I_SQ) { transpose_item(a.in[26] + (size_t)l * D * D, D, 0, (bf16*)(ws + WS_WCO) + (size_t)l * D * D, D, 0, scr, r / 32, r % 32, F.lane, 1.f, nullptr); continue; } r -= I_SQ;
        if (r < I_SQ) { transpose_item(a.in[28] + (size_t)l * D * D, D, 0, (bf16*)(ws + WS_WPQ) + (size_t)l * D * D, D, 0, scr, r / 32, r % 32, F.lane, 1.f, nullptr); continue; } r -= I_SQ;
        if (r < I_CKV) { transpose_item(a.in[25] + (size_t)l * D * 2 * D, 2 * D, 0, (bf16*)(ws + WS_WCKV) + (size_t)l * 2 * D * D, D, 0, scr, r / 64, r % 64, F.lane, 1.f, nullptr); continue; } r -= I_CKV;
        if (r < I_UQ) { transpose_item(a.in[7] + (size_t)l * 192 * 384, 384, 0, (bf16*)(ws + WS_WUQ) + (size_t)l * 512 * 256, 256, 0, scr, r / 12, r % 12, F.lane, 0.10206207261596575f * LOG2E, a.in[6] + l * 192); continue; } r -= I_UQ;
        transpose_item(a.in[9] + (size_t)l * 128 * 512, 512, 0, (bf16*)(ws + WS_WUKV) + (size_t)l * 512 * 256, 256, 0, scr, r / 16, r % 16, F.lane, 1.f, a.in[8] + l * 128);
    }
    for (int l = 0; l < L; ++l) {
        bf16* win = (bf16*)(ws + WS_WIN) + (size_t)l * INP * D; bf16* wuq = (bf16*)(ws + WS_WUQ) + (size_t)l * 512 * 256; bf16* wukv = (bf16*)(ws + WS_WUKV) + (size_t)l * 512 * 256;
        zero_rect(win, D, 192, 64, 0, D, gtid, gthreads); zero_rect(win, D, 416, 96, 0, D, gtid, gthreads);
        zero_rect(wuq, 256, 0, 384, 192, 64, gtid, gthreads); zero_rect(wuq, 256, 384, 128, 0, 256, gtid, gthreads);
        zero_rect(wukv, 256, 0, 512, 128, 128, gtid, gthreads);
    }
    { float* rope = (float*)(ws + WS_ROPE); const int* pos = (const int*)a.in[2];
      for (int i = gtid; i < T * 16; i += gthreads) { const int t = i >> 4, k = i & 15; const float inv = powf(10000.f, -(float)(2 * k) / 32.f); const float ang = (float)pos[t] * inv;
          rope[(size_t)t * 32 + k] = cosf(ang); rope[(size_t)t * 32 + 16 + k] = sinf(ang); } }
    { const GAS f32x4* ks = (const GAS f32x4*)a.in[29]; GAS v2u* kd = (GAS v2u*)(ws + WS_KEYS);
      for (int i = gtid; i < L * 2 * 128 * 64 / 4; i += gthreads) { const f32x4 v = ks[i]; v2u w; w.x = pk2(v.x, v.y); w.y = pk2(v.z, v.w); kd[i] = w; }
    }
    for (int r = gw; r < 2 * L * 16384; r += NGW) { const int tb = r / (L * 16384), rr = r % (L * 16384);
        quant_row(a.in[30 + tb] + (size_t)rr * 1024, (unsigned*)(ws + (tb ? WS_V8 : WS_U8) + (size_t)rr * 1024), (float*)(ws + (tb ? WS_SV : WS_SU)) + rr, tb ? 128 : 0, F.lane); }
    { float* btab = (float*)(ws + WS_BTAB); float* lams = (float*)(ws + WS_LAMS); float* spt = (float*)(ws + WS_SP);
      for (int i = gtid; i < 4 * 129; i += gthreads) { const int h = i / 129, n = i % 129; int bu; if (n < 16) bu = n; else { const int lg = 16 + (int)(logf((float)n / 16.f) / logf(8.f) * 16.f); bu = lg < 31 ? lg : 31; }
          btab[i] = a.in[3][bu * 4 + h] * LOG2E; }
      for (int i = gtid; i < L; i += gthreads) { const float* dl = a.in[17] + i * 128; float s1 = 0.f, s2 = 0.f; for (int j = 0; j < 32; ++j) { s1 += dl[j] * dl[32 + j]; s2 += dl[64 + j] * dl[96 + j]; }
          const float li = 0.8f - 0.6f * expf(-0.3f * (float)i); lams[2 * i] = expf(s1) - expf(s2) + li; lams[2 * i + 1] = li; }
      for (int i = gtid; i < L * 512; i += gthreads) spt[i] = log1pf(expf(-a.in[16][i])); }
    for (int l = 0; l < L; ++l) norm_phase(a.in[1], a.in[23] + l * D, (bf16*)(ws + WS_MNB) + (size_t)l * NB * MEM * D, NB * MEM, gw, NGW, F.lane);
}

constexpr int NPL = 16, PH_FINAL = 2 + NPL * L;
__global__ void __launch_bounds__(NWAVES * 64, 2) fwd(Args args) {
    extern __shared__ __attribute__((aligned(16))) unsigned char lds[];
    Frame F;
    F.lds = (LAS unsigned char*)lds; F.MISC = (volatile LAS unsigned*)(F.lds + MISC_OFF);
    F.tid = threadIdx.x; F.lane = F.tid & 63; F.wave = __builtin_amdgcn_readfirstlane(F.tid >> 6); F.G = gridDim.x;
    F.vcu = (F.G % 8 == 0) ? ((int)blockIdx.x % 8) * (F.G / 8) + (int)blockIdx.x / 8 : (int)blockIdx.x;
    unsigned char* ws = args.ws;
    F.ctl = (gu32*)(opq(ws) + WS_CTL);
    for (int u = F.tid; u < (LDS_BYTES - LDSCTL_OFF) / 4; u += NWAVES * 64) ((LAS unsigned*)(F.lds + LDSCTL_OFF))[u] = 0u;
    __syncthreads();
    XcdBarrier bar = xcd_barrier_post((unsigned*)(F.ctl + CW_BAR), F.MISC + 8);
    F.xcc = (int)bar.x;
    if (F.tid == 0) F.MISC[12] = __hip_atomic_fetch_add((unsigned*)(F.ctl + CW_RANK) + 64 * bar.x, 1u, __ATOMIC_RELAXED, __HIP_MEMORY_SCOPE_AGENT);
    __syncthreads();
    F.xrank = __builtin_amdgcn_readfirstlane((int)F.MISC[12]);
    const int lo = args.ph_lo, hi = args.ph_hi;
    const int gw = blockIdx.x * NWAVES + F.wave, NGW = F.G * NWAVES;
#define IN(k) (lo <= (k) && (k) < hi)
#define LANE_ (lane_id_v())
#define TID_ ((opqi(F.wave) << 6) | LANE_)
#define SITE() const int G_ = opqi(F.G), wv_ = opqi(F.wave), vcu_ = opqi(F.vcu), gw_ = opqi(gw), NGW_ = opqi(NGW); (void)G_; (void)wv_; (void)vcu_; (void)gw_; (void)NGW_
#define SEAM(k) do { if (IN(k) && IN((k) + 1)) xcd_barrier(bar, (F.wave == 0 && lane_id_v() == 0) ? 1 : 0); } while (0)
#define GEMM_SITE(EPI, Aptr, lda_, Bptr, ldb_, M_, N_, K_, cperm, ...) do { \
        pg8::Gemm g{opq(Aptr), opq(Bptr), M_, N_, K_, lda_, ldb_}; pg8::StaticOrder So; So.init(M_, N_, opqi(F.G), opqi(cperm)); pg8::EPI E{__VA_ARGS__}; \
        pg8::gemm_phase<pg8::EPI, pg8::StaticOrder, true, true>(F.lds + RING_OFF, g, So, E, opqi(F.wave)); } while (0)
    if (IN(0)) { p0_prologue(F, args); }
    SEAM(0);
    if (IN(1)) {
#pragma unroll 1
        for (int l = 0; l < L; ++l)
            GEMM_SITE(EpiBf16, (const bf16*)(opq(ws) + WS_MNB) + (size_t)l * NB * MEM * D, D, (const bf16*)(opq(ws) + WS_WCKV) + (size_t)l * 2 * D * D, D, NB * MEM, 2 * D, D, (int)((blockIdx.x + 64 * l) % F.G),
                      opq((bf16*)(opq(ws) + WS_KVCB) + (size_t)l * NB * MEM * 2 * D), 2 * D, 2 * D);
    }
    SEAM(1);
    for (int l = 0; l < L; ++l) {
        const int pb = 2 + NPL * l;
        const bf16* XNB = (const bf16*)(opq(ws) + WS_XNB); const bf16* YB = (const bf16*)(opq(ws) + WS_YB); bf16* PROJB = (bf16*)(opq(ws) + WS_PROJB);
        if (IN(pb + 0)) { SITE(); norm_phase(args.out, args.in[opqi(4)] + l * D, opq((bf16*)(opq(ws) + WS_XNB)), T, gw_, NGW_, LANE_); }
        SEAM(pb + 0);
        if (IN(pb + 1)) GEMM_SITE(EpiBf16, XNB, D, (const bf16*)(opq(ws) + WS_WIN) + (size_t)l * INP * D, D, T, INP, D, (int)blockIdx.x, opq(PROJB), INP, INP);
        SEAM(pb + 1);
        if (IN(pb + 2)) {
            SITE();
            pre_phase(opq((const bf16*)PROJB), opq((const float*)(opq(ws) + WS_ROPE)), opq((float*)(opq(ws) + WS_RS)), opq((bf16*)(opq(ws) + WS_KMB)), gw_, NGW_, LANE_);
            LruP LP{opq((const bf16*)PROJB), args.in[opqi(10)] + l * 4 * 512, args.in[opqi(11)] + l * 512, args.in[opqi(12)] + (size_t)l * 8 * 4096, args.in[opqi(13)] + l * 512, args.in[opqi(14)] + (size_t)l * 8 * 4096, args.in[opqi(15)] + l * 512,
                    (const float*)(opq(ws) + WS_SP) + l * 512, opq((bf16*)(opq(ws) + WS_HLB)), opq((bf16*)(opq(ws) + WS_ACB)), opq((float*)(opq(ws) + WS_LSUM))};
            lru_phase(LP, F.lds, TID_, wv_, LANE_, vcu_, G_);
#if MK_DUP == 2
            lru_phase(LP, F.lds, TID_, wv_, LANE_, vcu_, G_);
#endif
        }
        SEAM(pb + 2);
        if (IN(pb + 3)) {
            GEMM_SITE(EpiUp, (const bf16*)PROJB + PC_CQ, INP, (const bf16*)(opq(ws) + WS_WUQ) + (size_t)l * 512 * 256, 256, T, 512, 256, (int)blockIdx.x,
                      opq((bf16*)(opq(ws) + WS_QMB)), nullptr, 384, 384, opq((const float*)(opq(ws) + WS_RS)), 0, 0);
            GEMM_SITE(EpiUp, (const bf16*)PROJB + PC_CKV, INP, (const bf16*)(opq(ws) + WS_WUKV) + (size_t)l * 512 * 256, 256, T, 512, 256, (int)blockIdx.x,
                      opq((bf16*)(opq(ws) + WS_KMB)), opq((bf16*)(opq(ws) + WS_VMB)), 0, 512, opq((const float*)(opq(ws) + WS_RS)), 1, 1);
        }
        SEAM(pb + 3);
        if (IN(pb + 4)) {
            SITE();
            AttnP PM{opq((const bf16*)(opq(ws) + WS_QMB)), opq((const bf16*)(opq(ws) + WS_KMB)), opq((const bf16*)(opq(ws) + WS_VMB)), 384, 384, 256, opq((bf16*)(opq(ws) + WS_OMB)), 256, opq((const float*)(opq(ws) + WS_ROPE)), nullptr, nullptr, nullptr, nullptr};
            AttnP PD{opq((const bf16*)PROJB + PC_QD), opq((const bf16*)PROJB + PC_KD), opq((const bf16*)PROJB + PC_VD), INP, INP, INP, opq((bf16*)(opq(ws) + WS_YB) + 768), 1024, nullptr,
                     (const int*)args.in[opqi(2)], (const float*)(opq(ws) + WS_BTAB), args.in[opqi(18)] + l * 64, (const float*)(opq(ws) + WS_LAMS) + 2 * l};
            attn_phase(PM, PD, F.lds, TID_, wv_, LANE_, vcu_, G_);
#if MK_DUP == 4
            __syncthreads(); attn_phase(PM, PD, F.lds, TID_, wv_, LANE_, vcu_, G_);
#endif
        }
        SEAM(pb + 4);
        if (IN(pb + 5)) {
            SITE();
            PostP PP{opq((const bf16*)(opq(ws) + WS_OMB)), opq((const bf16*)(opq(ws) + WS_HLB)), opq((const bf16*)(opq(ws) + WS_ACB)), opq((const float*)(opq(ws) + WS_LSUM)), opq((const bf16*)PROJB), args.in[opqi(19)] + l * 256, args.in[opqi(20)] + l * 512, opq((bf16*)(opq(ws) + WS_YB))};
            post_phase(PP, F.lds, TID_, wv_, LANE_, vcu_, G_);
        }
        SEAM(pb + 5);
        if (IN(pb + 6)) GEMM_SITE(EpiF32, YB, D, (const bf16*)(opq(ws) + WS_WOUT) + (size_t)l * D * D, D, T, D, D, (int)blockIdx.x, args.out, D, D, 1);
        SEAM(pb + 6);
        if (IN(pb + 7)) { SITE(); norm_phase(args.out, args.in[opqi(22)] + l * D, opq((bf16*)(opq(ws) + WS_XNB)), T, gw_, NGW_, LANE_); }
        SEAM(pb + 7);
        if (IN(pb + 8)) GEMM_SITE(EpiBf16, XNB, D, (const bf16*)(opq(ws) + WS_WCQ) + (size_t)l * D * D, D, T, D, D, (int)blockIdx.x, opq(PROJB), D, D);
        SEAM(pb + 8);
        if (IN(pb + 9)) {
            SITE();
            const bf16* kv = (const bf16*)(opq(ws) + WS_KVCB) + (size_t)l * NB * MEM * 2 * D;
            AttnP PC{opq((const bf16*)PROJB), opq(kv), opq(kv + D), 1024, 2 * D, 2 * D, opq((bf16*)(opq(ws) + WS_YB)), 1024, nullptr, nullptr, nullptr, nullptr, nullptr};
            cross_phase(PC, F.lds, TID_, wv_, LANE_, vcu_, G_);
#if MK_DUP == 9
            cross_phase(PC, F.lds, TID_, wv_, LANE_, vcu_, G_);
#endif
        }
        SEAM(pb + 9);
        if (IN(pb + 10)) GEMM_SITE(EpiF32, YB, D, (const bf16*)(opq(ws) + WS_WCO) + (size_t)l * D * D, D, T, D, D, (int)blockIdx.x, args.out, D, D, 1);
        SEAM(pb + 10);
        if (IN(pb + 11)) { SITE(); norm_q_phase(args.out, args.in[opqi(27)] + l * D, opq((bf16*)(opq(ws) + WS_XNB)), opq((unsigned char*)(opq(ws) + WS_HQ)), opq((float*)(opq(ws) + WS_SH)), opq((int*)(opq(ws) + WS_P)), T, gw_, NGW_, LANE_); }
        SEAM(pb + 11);
        if (IN(pb + 12)) GEMM_SITE(EpiBf16, XNB, D, (const bf16*)(opq(ws) + WS_WPQ) + (size_t)l * D * D, D, T, D, D, (int)blockIdx.x, opq(PROJB), D, D);
        SEAM(pb + 12);
        if (IN(pb + 13)) {
            SITE();
            RouteP RP{opq((const bf16*)PROJB), opq((const bf16*)(opq(ws) + WS_KEYS) + (size_t)l * 2 * 128 * 64), opq((int*)(opq(ws) + WS_EX)), opq((float*)(opq(ws) + WS_GW))};
            route_phase(RP, F.lds, TID_, wv_, LANE_, vcu_, G_);
#if MK_DUP == 13
            route_phase(RP, F.lds, TID_, wv_, LANE_, vcu_, G_);
#endif
        }
        SEAM(pb + 13);
        if (IN(pb + 14)) {
            SITE();
            const PeerS ps = peer_sched((const unsigned*)(F.ctl + CW_RANK), opqi(F.xcc), opqi(F.xrank));
            Peer1P Q1{opq((const unsigned char*)(opq(ws) + WS_HQ)), opq((const int*)(opq(ws) + WS_EX)), opq((const unsigned char*)(opq(ws) + WS_U8) + (size_t)l * 16384 * 1024), opq((int*)(opq(ws) + WS_P))};
            peer_k1(Q1, ps, wv_, LANE_);
        }
        SEAM(pb + 14);
        if (IN(pb + 15)) {
            SITE();
            peer_w(opq((const int*)(opq(ws) + WS_EX)), opq((const float*)(opq(ws) + WS_GW)), opq((const int*)(opq(ws) + WS_P)), opq((const float*)(opq(ws) + WS_SH)), opq((const float*)(opq(ws) + WS_SU) + l * 16384), opq((const float*)(opq(ws) + WS_SV) + l * 16384),
                   opq((float*)(opq(ws) + WS_W)), opq((float*)(opq(ws) + WS_WS)), gw_, NGW_, LANE_);
            xcd_barrier(bar, (F.wave == 0 && lane_id_v() == 0) ? 1 : 0);
            const PeerS ps = peer_sched((const unsigned*)(F.ctl + CW_RANK), opqi(F.xcc), opqi(F.xrank));
            Peer2P Q2{opq((const int*)(opq(ws) + WS_EX)), opq((const float*)(opq(ws) + WS_W)), opq((const float*)(opq(ws) + WS_WS)), opq((const unsigned char*)(opq(ws) + WS_V8) + (size_t)l * 16384 * 1024), args.out};
            peer_k2(Q2, ps, wv_, LANE_);
        }
        SEAM(pb + 15);
    }
    if (IN(PH_FINAL)) { SITE(); final_norm_phase(args.out, args.in[opqi(32)], T, gw_, NGW_, LANE_); }
#undef IN
#undef SEAM
#undef GEMM_SITE
}
}
extern "C" void kernel_launch(void* const* d_in, const int* in_sizes, int n_in, void* d_out, int out_size, void* d_ws, size_t ws_size, hipStream_t stream) {
    (void)in_sizes; (void)out_size;
    static int grid = 0;
    if (grid == 0) {
        int dev = 0, cus = 0, per_cu = 0;
        if (n_in != 33 || ws_size < mk::WS_END) { fprintf(stderr, "kernel_launch: unexpected n_in %d / ws_size %zu\n", n_in, ws_size); grid = -1; return; }
        if (hipGetDevice(&dev) != hipSuccess || hipDeviceGetAttribute(&cus, hipDeviceAttributeMultiprocessorCount, dev) != hipSuccess) { grid = -1; return; }
        if (hipFuncSetAttribute((const void*)mk::fwd, hipFuncAttributeMaxDynamicSharedMemorySize, mk::LDS_BYTES) != hipSuccess) { fprintf(stderr, "kernel_launch: hipFuncSetAttribute failed\n"); grid = -1; return; }
        if (hipOccupancyMaxActiveBlocksPerMultiprocessor(&per_cu, (const void*)mk::fwd, mk::NWAVES * 64, mk::LDS_BYTES) != hipSuccess || per_cu < 1) fprintf(stderr, "kernel_launch: occupancy query says %d\n", per_cu);
        (void)hipGetLastError();
        grid = cus;
    }
    if (grid < 0) return;
    unsigned char* ws = (unsigned char*)d_ws;
    (void)hipMemsetAsync(ws + mk::WS_CTL, 0, mk::CTL_ZERO_BYTES, stream);
    mk::Args a{};
    for (int i = 0; i < 33; ++i) a.in[i] = (const float*)d_in[i];
    a.out = (float*)d_out; a.ws = ws;
    auto run = [&](int lo, int hi) { a.ph_lo = lo; a.ph_hi = hi; hipLaunchKernelGGL(mk::fwd, dim3(grid), dim3(mk::NWAVES * 64), mk::LDS_BYTES, stream, a); };
#if MK_ONE_LAUNCH
    run(0, mk::PH_FINAL + 1);
#else
    for (int p = 0; p <= mk::PH_FINAL; ++p) {
        const int k = (p - 2) % mk::NPL, l = (p - 2) / mk::NPL;
#if MK_NAIVE_PEER == 2
        if (p >= 2 && p < mk::PH_FINAL && k == 14) {
            hipLaunchKernelGGL(k_peer, dim3(T), dim3(256), 0, stream, (const bf16_t*)(ws + mk::WS_XNB), (const int*)(ws + mk::WS_EX), (const float*)(ws + mk::WS_GW), (const float*)d_in[30] + (size_t)l * NEXP * D, (const float*)d_in[31] + (size_t)l * NEXP * D, (float*)d_out);
            continue; }
#elif MK_NAIVE_PEER == 1
        if (p >= 2 && p < mk::PH_FINAL && k == 13) {
            float* TQ = (float*)(ws + (size_t)806 * mk::MiB);
            hipLaunchKernelGGL(k_bf2f, dim3((unsigned)(((size_t)T * D + 255) / 256)), dim3(256), 0, stream, (const bf16_t*)(ws + mk::WS_PROJB), TQ, (long)T * D);
            hipLaunchKernelGGL(k_route, dim3(T), dim3(256), 0, stream, TQ, (const float*)d_in[29] + (size_t)l * 2 * 128 * 64, (int*)(ws + mk::WS_EX), (float*)(ws + mk::WS_GW));
            hipLaunchKernelGGL(k_peer, dim3(T), dim3(256), 0, stream, (const bf16_t*)(ws + mk::WS_XNB), (const int*)(ws + mk::WS_EX), (const float*)(ws + mk::WS_GW), (const float*)d_in[30] + (size_t)l * NEXP * D, (const float*)d_in[31] + (size_t)l * NEXP * D, (float*)d_out);
            continue; }
        if (p >= 2 && p < mk::PH_FINAL && k == 14) continue;
#endif
        run(p, p + 1); }
#endif
}
```

```cpp
#include <hip/hip_runtime.h>
#include <cstdint>
#include <cstdio>
#include <cmath>

#ifndef MK_ONE_LAUNCH
#define MK_ONE_LAUNCH 1
#endif
#ifndef MK_DUP
#define MK_DUP 0
#endif
#ifndef MK_NAIVE_PEER
#define MK_NAIVE_PEER 0
#endif
namespace pg8 {
#define PG8_LAS __attribute__((address_space(3)))
#ifndef GAS
#define GAS __attribute__((address_space(1)))
#endif
typedef unsigned short bf16_t;
typedef short bf16x8 __attribute__((ext_vector_type(8)));
typedef float f32x4 __attribute__((ext_vector_type(4)));
typedef unsigned u32x4 __attribute__((ext_vector_type(4)));
typedef unsigned u32x2 __attribute__((ext_vector_type(2)));
constexpr int BM = 256, BK = 64, HALF = 128, HTB = HALF * BK * 2, STAGE_BYTES = 8 * HTB, NXCD = 8, WGM = 8;
__host__ __device__ __forceinline__ int lds_byte(int r, int c) { const int st = (r >> 4) * 2 + (c >> 5), rr = r & 15, cc = c & 31, ob = rr * 64 + cc * 2; return st * 1024 + (ob ^ (((ob >> 9) & 1) << 5)); }
__host__ __device__ __forceinline__ void stage_rc(int b, int& R, int& C) { const int st = b / 1024, sb = b % 1024, swz = sb ^ (((sb >> 9) & 1) << 5); R = (st >> 1) * 16 + swz / 64; C = (st & 1) * 32 + (swz % 64) / 2; }
__host__ __device__ __forceinline__ int perm32(int rho) { const int n = rho >> 4, i = rho & 15; return 8 * (i >> 2) + 4 * n + (i & 3); }
__device__ __forceinline__ int pg8_lane_id() { int l; asm volatile("v_mbcnt_lo_u32_b32 %0, -1, 0\n\tv_mbcnt_hi_u32_b32 %0, -1, %0" : "=v"(l)); return l; }
struct Unit { int pm, pn; };
struct Gemm { const GAS bf16_t* A; const GAS bf16_t* Bt; int M, N, K, lda, ldb; };
struct StaticOrder {
    int nM, nN, nwg, G, c;
    __host__ __device__ void init(int M, int N, int G_, int c_) { nM = M / BM; nN = N / BM; nwg = nM * nN; G = G_; c = c_; }
    __host__ __device__ bool next(int i, Unit& u) const {
        const long L = (long)i * G + c; if (L >= nwg) return false;
        int wgid = (int)L; { const int q = nwg / NXCD, r = nwg % NXCD, xcd = wgid % NXCD, off = wgid / NXCD; wgid = (xcd < r ? xcd * (q + 1) : r * (q + 1) + (xcd - r) * q) + off; }
        const int nig = WGM * nN, gid = wgid / nig, fm = gid * WGM, gsz = (nM - fm) < WGM ? (nM - fm) : WGM;
        u.pm = fm + ((wgid % nig) % gsz); u.pn = (wgid % nig) / gsz; return true;
    }
    __device__ __forceinline__ void a_ready(const Unit&) const {}
    __device__ __forceinline__ void done(const Unit&) const {}
};
__device__ __forceinline__ unsigned cvt_pk_bf16(float lo, float hi) { unsigned r; asm volatile("v_cvt_pk_bf16_f32 %0, %1, %2" : "=v"(r) : "v"(lo), "v"(hi)); return r; }

struct EpiF32 {
    static constexpr bool PERM = false, AFTER_DRAIN = false;
    GAS float* C; int ldc; int nvalid; int accum;
    __device__ __forceinline__ void operator()(const f32x4 (&acc)[2][2][4][2], const Unit& u, int wr, int wc, int fr, int fq) const {
        { const int l_ = pg8_lane_id(); fr = l_ & 15; fq = l_ >> 4; }
#pragma unroll
        for (int ai = 0; ai < 2; ++ai)
#pragma unroll
            for (int m = 0; m < 4; ++m) { const size_t row = (size_t)u.pm * BM + ai * HALF + wr * 64 + m * 16 + fr;
#pragma unroll
                for (int bj = 0; bj < 2; ++bj)
#pragma unroll
                    for (int n = 0; n < 2; ++n) { const int col = u.pn * BM + bj * HALF + wc * 32 + n * 16 + 4 * fq;
                        if (col < nvalid) { GAS float* p = C + row * ldc + col; f32x4 v = acc[ai][bj][m][n]; if (accum) v += *(const GAS f32x4*)p; *(GAS f32x4*)p = v; } } }
    }
};
struct EpiBf16 {
    static constexpr bool PERM = true, AFTER_DRAIN = false;
    GAS bf16_t* O; int ldc; int nvalid;
    __device__ __forceinline__ void operator()(const f32x4 (&acc)[2][2][4][2], const Unit& u, int wr, int wc, int fr, int fq) const {
        { const int l_ = pg8_lane_id(); fr = l_ & 15; fq = l_ >> 4; }
#pragma unroll
        for (int ai = 0; ai < 2; ++ai)
#pragma unroll
            for (int m = 0; m < 4; ++m) { const size_t row = (size_t)u.pm * BM + ai * HALF + wr * 64 + m * 16 + fr;
#pragma unroll
                for (int bj = 0; bj < 2; ++bj) { const int col = u.pn * BM + bj * HALF + wc * 32 + 8 * fq;
                    if (col < nvalid) { const f32x4 v0 = acc[ai][bj][m][0], v1 = acc[ai][bj][m][1]; u32x4 w; w.x = cvt_pk_bf16(v0[0], v0[1]); w.y = cvt_pk_bf16(v0[2], v0[3]); w.z = cvt_pk_bf16(v1[0], v1[1]); w.w = cvt_pk_bf16(v1[2], v1[3]);
                        *(GAS u32x4*)(O + row * ldc + col) = w; } } }
    }
};
struct EpiUp {
    static constexpr bool PERM = true, AFTER_DRAIN = false;
    GAS bf16_t* O; GAS bf16_t* O2; int ldc; int nvalid; const GAS float* rs; int rsi; int mode;
    __device__ __forceinline__ void operator()(const f32x4 (&acc)[2][2][4][2], const Unit& u, int wr, int wc, int fr, int fq) const {
        { const int l_ = pg8_lane_id(); fr = l_ & 15; fq = l_ >> 4; }
#pragma unroll
        for (int ai = 0; ai < 2; ++ai)
#pragma unroll
            for (int m = 0; m < 4; ++m) { const size_t row = (size_t)u.pm * BM + ai * HALF + wr * 64 + m * 16 + fr; const float s = rs[2 * row + rsi];
#pragma unroll
                for (int bj = 0; bj < 2; ++bj) { const int col = u.pn * BM + bj * HALF + wc * 32 + 8 * fq;
                    if (col < nvalid) { const f32x4 v0 = acc[ai][bj][m][0] * s, v1 = acc[ai][bj][m][1] * s; u32x4 w; w.x = cvt_pk_bf16(v0[0], v0[1]); w.y = cvt_pk_bf16(v0[2], v0[3]); w.z = cvt_pk_bf16(v1[0], v1[1]); w.w = cvt_pk_bf16(v1[2], v1[3]);
                        GAS bf16_t* dst;
                        if (mode == 0) dst = O + row * ldc + col;
                        else { const int h = col >> 7, j = col & 127; dst = (j < 64) ? O + row * 384 + h * 96 + j : O2 + row * 256 + h * 64 + (j - 64); }
                        *(GAS u32x4*)dst = w; } } }
    }
};
template <class Epi, class Sched, bool ALIGN_EPI = false, bool SP2 = false>
__device__ __forceinline__ void gemm_phase(PG8_LAS unsigned char* lds, const Gemm g, const Sched& S, const Epi& E, int wave_id) {
    int tid_ = (wave_id << 6) | pg8_lane_id(); asm volatile("" : "+v"(tid_));
    const int tid = tid_, wid = __builtin_amdgcn_readfirstlane(tid >> 6), lane = tid & 63, wr = wid >> 2, wc = wid & 3, fr = lane & 15, fq = lane >> 4;
    const int K = g.K, nt = K / BK;
    unsigned voffA[2], voffB[2];
#pragma unroll
    for (int i = 0; i < 2; ++i) { int R, C; stage_rc(tid * 16 + i * 8192, R, C); const int Rb = Epi::PERM ? ((R & ~31) + perm32(R & 31)) : R;
        voffA[i] = (unsigned)(R * g.lda + C) * 2u; voffB[i] = (unsigned)(Rb * g.ldb + C) * 2u; }
    const size_t kstep = (size_t)(BK * 2);
    const size_t hstepA = (size_t)HALF * g.lda * 2, hstepB = (size_t)HALF * g.ldb * 2;
    const size_t tstepA = 2 * hstepA, tstepB = 2 * hstepB;
    const unsigned ldsw = (unsigned)wid * 1024u;
    const int aoff = lds_byte(wr * 64 + fr, fq * 8), boff = lds_byte(wc * 32 + fr, fq * 8);
#define PG8_SA(b, h) (((b) * 2 + (h)) * HTB)
#define PG8_SB(b, h) ((4 + (b) * 2 + (h)) * HTB)
#define PG8_STAGE(bufoff, gbase, voff) do { _Pragma("unroll") for (int _i = 0; _i < 2; ++_i) \
        __builtin_amdgcn_global_load_lds((const unsigned*)((const char*)(gbase) + (voff)[_i]), (PG8_LAS unsigned*)(lds + (bufoff) + ldsw + _i * 8192), 16, 0, 0); } while (0)
#define PG8_LDA(dst, b, h) do { _Pragma("unroll") for (int m = 0; m < 4; ++m) _Pragma("unroll") for (int k = 0; k < 2; ++k) dst[m][k] = *(const PG8_LAS bf16x8*)(lds + PG8_SA(b, h) + aoff + m * 2048 + k * 1024); } while (0)
#define PG8_LDB(dst, b, h) do { _Pragma("unroll") for (int n = 0; n < 2; ++n) _Pragma("unroll") for (int k = 0; k < 2; ++k) dst[n][k] = *(const PG8_LAS bf16x8*)(lds + PG8_SB(b, h) + boff + n * 2048 + k * 1024); } while (0)
#define PG8_MMA(ai, bj, At, Bt) do { __builtin_amdgcn_s_setprio(1); _Pragma("unroll") for (int m = 0; m < 4; ++m) _Pragma("unroll") for (int n = 0; n < 2; ++n) _Pragma("unroll") for (int k = 0; k < 2; ++k) \
        acc[ai][bj][m][n] = __builtin_amdgcn_mfma_f32_16x16x32_bf16(Bt[n][k], At[m][k], acc[ai][bj][m][n], 0, 0, 0); __builtin_amdgcn_s_setprio(0); } while (0)
#define PG8_WAIT_V(n) asm volatile("s_waitcnt vmcnt(" #n ")" ::: "memory")
#define PG8_WAIT_L(n) asm volatile("s_waitcnt lgkmcnt(" #n ")" ::: "memory")
#define PG8_BAR __builtin_amdgcn_s_barrier()
#define PG8_SCHED __builtin_amdgcn_sched_barrier(0)
    Unit cur, nxt; int ui = 0;
    if (!S.next(0, cur)) return;
    f32x4 acc[2][2][4][2];
#pragma unroll
    for (int a = 0; a < 2; ++a)
#pragma unroll
        for (int b = 0; b < 2; ++b)
#pragma unroll
            for (int m = 0; m < 4; ++m)
#pragma unroll
                for (int n = 0; n < 2; ++n) acc[a][b][m][n] = (f32x4){0.f, 0.f, 0.f, 0.f};
    bf16x8 At[4][2], B0[2][2], B1[2][2];
    const char* cA = (const char*)g.A + (size_t)cur.pm * tstepA; const char* cB = (const char*)g.Bt + (size_t)cur.pn * tstepB;
    S.a_ready(cur);
    if constexpr (SP2) {
        PG8_STAGE(PG8_SB(0, 0), cB, voffB); PG8_STAGE(PG8_SB(0, 1), cB + hstepB, voffB); PG8_STAGE(PG8_SA(0, 0), cA, voffA); PG8_STAGE(PG8_SA(0, 1), cA + hstepA, voffA);
        if (wr == 1) PG8_BAR;
        PG8_WAIT_V(2); PG8_BAR;
        PG8_STAGE(PG8_SB(1, 0), cB + kstep, voffB); PG8_STAGE(PG8_SA(1, 0), cA + kstep, voffA); PG8_STAGE(PG8_SB(1, 1), cB + hstepB + kstep, voffB);
        PG8_WAIT_V(6); PG8_BAR;
    } else {
        PG8_STAGE(PG8_SB(0, 0), cB, voffB); PG8_STAGE(PG8_SA(0, 0), cA, voffA); PG8_STAGE(PG8_SB(0, 1), cB + hstepB, voffB); PG8_STAGE(PG8_SA(0, 1), cA + hstepA, voffA);
        if (wr == 1) PG8_BAR;
        PG8_WAIT_V(4); PG8_BAR;
        PG8_STAGE(PG8_SB(1, 0), cB + kstep, voffB); PG8_STAGE(PG8_SA(1, 0), cA + kstep, voffA); PG8_STAGE(PG8_SB(1, 1), cB + hstepB + kstep, voffB);
        PG8_WAIT_V(6); PG8_BAR;
    }
    for (;;) {
        const bool has_next = S.next(ui + 1, nxt);
        const char* nA = has_next ? (const char*)g.A + (size_t)nxt.pm * tstepA : cA; const char* nB = has_next ? (const char*)g.Bt + (size_t)nxt.pn * tstepB : cB;
        for (int t = 0; t < nt; t += 2) {
            const bool last = (t == nt - 2);
            const char* a1 = cA + (size_t)(t + 1) * kstep;
            const char* a2 = last ? nA : cA + (size_t)(t + 2) * kstep; const char* b2 = last ? nB : cB + (size_t)(t + 2) * kstep;
            const char* a3 = a2 + kstep; const char* b3 = b2 + kstep;
            if (last && has_next) S.a_ready(nxt);
            if constexpr (SP2) {
            PG8_LDB(B0, 0, 0); PG8_LDB(B1, 0, 1); PG8_SCHED; PG8_LDA(At, 0, 0); PG8_STAGE(PG8_SA(1, 1), a1 + hstepA, voffA);
            PG8_WAIT_V(8); PG8_WAIT_L(0); PG8_BAR; PG8_MMA(0, 0, At, B0); PG8_MMA(0, 1, At, B1); PG8_BAR; PG8_SCHED;
            PG8_LDA(At, 0, 1); PG8_STAGE(PG8_SB(0, 0), b2, voffB); PG8_STAGE(PG8_SB(0, 1), b2 + hstepB, voffB); PG8_STAGE(PG8_SA(0, 0), a2, voffA);
            PG8_WAIT_V(8); PG8_WAIT_L(0); PG8_BAR; PG8_MMA(1, 0, At, B0); PG8_MMA(1, 1, At, B1); PG8_BAR; PG8_SCHED;
            PG8_LDB(B0, 1, 0); PG8_LDB(B1, 1, 1); PG8_SCHED; PG8_LDA(At, 1, 0); PG8_STAGE(PG8_SA(0, 1), a2 + hstepA, voffA);
            PG8_WAIT_V(8); PG8_WAIT_L(0); PG8_BAR; PG8_MMA(0, 0, At, B0); PG8_MMA(0, 1, At, B1); PG8_BAR; PG8_SCHED;
            PG8_LDA(At, 1, 1); PG8_STAGE(PG8_SB(1, 0), b3, voffB); PG8_STAGE(PG8_SB(1, 1), b3 + hstepB, voffB); PG8_STAGE(PG8_SA(1, 0), a3, voffA);
            PG8_WAIT_V(8); PG8_WAIT_L(0); PG8_BAR; PG8_MMA(1, 0, At, B0); PG8_MMA(1, 1, At, B1); PG8_BAR; PG8_SCHED;
            } else {
            PG8_LDB(B0, 0, 0); PG8_SCHED; PG8_LDA(At, 0, 0); PG8_STAGE(PG8_SA(1, 1), a1 + hstepA, voffA);
            PG8_WAIT_L(8); PG8_BAR; PG8_WAIT_L(0); PG8_MMA(0, 0, At, B0); PG8_BAR; PG8_SCHED;
            PG8_LDB(B1, 0, 1); PG8_STAGE(PG8_SB(0, 0), b2, voffB);
            PG8_BAR; PG8_WAIT_L(0); PG8_MMA(0, 1, At, B1); PG8_BAR;
            PG8_LDA(At, 0, 1); PG8_STAGE(PG8_SA(0, 0), a2, voffA);
            PG8_BAR; PG8_WAIT_L(0); PG8_MMA(1, 0, At, B0); PG8_BAR; PG8_SCHED;
            PG8_STAGE(PG8_SB(0, 1), b2 + hstepB, voffB);
            PG8_WAIT_V(6); PG8_BAR; PG8_MMA(1, 1, At, B1); PG8_BAR;
            PG8_LDB(B0, 1, 0); PG8_SCHED; PG8_LDA(At, 1, 0); PG8_STAGE(PG8_SA(0, 1), a2 + hstepA, voffA);
            PG8_WAIT_L(8); PG8_BAR; PG8_WAIT_L(0); PG8_MMA(0, 0, At, B0); PG8_BAR; PG8_SCHED;
            PG8_LDB(B1, 1, 1); PG8_STAGE(PG8_SB(1, 0), b3, voffB);
            PG8_BAR; PG8_WAIT_L(0); PG8_MMA(0, 1, At, B1); PG8_BAR;
            PG8_LDA(At, 1, 1); PG8_STAGE(PG8_SA(1, 0), a3, voffA);
            PG8_BAR; PG8_WAIT_L(0); PG8_MMA(1, 0, At, B0); PG8_BAR; PG8_SCHED;
            PG8_STAGE(PG8_SB(1, 1), b3 + hstepB, voffB);
            PG8_WAIT_V(6); PG8_BAR; PG8_MMA(1, 1, At, B1); PG8_BAR;
            }
        }
        if constexpr (ALIGN_EPI) { if (wr == 0) PG8_BAR; }
        if constexpr (!Epi::AFTER_DRAIN) { E(acc, cur, wr, wc, fr, fq); S.done(cur); }
        if (!has_next) break;
#pragma unroll
        for (int a = 0; a < 2; ++a)
#pragma unroll
            for (int b = 0; b < 2; ++b)
#pragma unroll
                for (int m = 0; m < 4; ++m)
#pragma unroll
                    for (int n = 0; n < 2; ++n) acc[a][b][m][n] = (f32x4){0.f, 0.f, 0.f, 0.f};
        cur = nxt; cA = nA; cB = nB; ++ui;
        if constexpr (ALIGN_EPI) { if (wr == 1) PG8_BAR; }
    }
    PG8_WAIT_V(0);
    if constexpr (!ALIGN_EPI) { if (wr == 0) PG8_BAR; }
    PG8_BAR;
    if constexpr (Epi::AFTER_DRAIN) { E.fused(acc, cur, wr, wc, fr, fq, lds, wid, lane); S.done(cur); }
#undef PG8_SA
#undef PG8_SB
#undef PG8_STAGE
#undef PG8_LDA
#undef PG8_LDB
#undef PG8_MMA
#undef PG8_WAIT_V
#undef PG8_WAIT_L
#undef PG8_BAR
#undef PG8_SCHED
}
}

namespace mk {
#ifndef GAS
#define GAS __attribute__((address_space(1)))
#endif
#define LAS __attribute__((address_space(3)))
typedef unsigned short bf16;
typedef unsigned v4u __attribute__((ext_vector_type(4)));
typedef unsigned v2u __attribute__((ext_vector_type(2)));
typedef float f32x4 __attribute__((ext_vector_type(4)));
typedef GAS unsigned gu32;
#define LDS_WAIT() asm volatile("s_waitcnt lgkmcnt(0)" ::: "memory")
#define VM_WAIT() asm volatile("s_waitcnt vmcnt(0)" ::: "memory")
__device__ __forceinline__ unsigned f2bf_(float f) { unsigned u = __builtin_bit_cast(unsigned, f); return (u + 0x7fffu + ((u >> 16) & 1u)) >> 16; }
__device__ __forceinline__ unsigned pk2(float lo, float hi) { return f2bf_(lo) | (f2bf_(hi) << 16); }
__device__ __forceinline__ float bflo(unsigned w) { return __builtin_bit_cast(float, w << 16); }
__device__ __forceinline__ float bfhi(unsigned w) { return __builtin_bit_cast(float, w & 0xffff0000u); }

template <class P> __device__ __forceinline__ P* opq(P* p) { asm volatile("" : "+s"(p)); return p; }
__device__ __forceinline__ int opqi(int k) { asm volatile("" : "+s"(k)); return k; }
__device__ __forceinline__ float shx(float v, int o, int lane) { return __builtin_bit_cast(float, __builtin_amdgcn_ds_bpermute((lane ^ o) << 2, __builtin_bit_cast(int, v))); }
__device__ __forceinline__ int shxi(int v, int o, int lane) { return __builtin_amdgcn_ds_bpermute((lane ^ o) << 2, v); }
__device__ __forceinline__ int lane_id_v() { int l; asm volatile("v_mbcnt_lo_u32_b32 %0, -1, 0\n\tv_mbcnt_hi_u32_b32 %0, -1, %0" : "=v"(l)); return l; }
constexpr int NWAVES = 8;
constexpr int D = 1024, NB = 4, S = 8192, T = NB * S, L = 4, MEM = 256, INW = 2144, INP = 2304;
constexpr int PC_CQ = 0, PC_CKV = 256, PC_KR = 384, PC_XL = 512, PC_GL = 1024, PC_QD = 1536, PC_KD = 1792, PC_VD = 2048;
constexpr float LOG2E = 1.4426950408889634f;
constexpr size_t MiB = 1u << 20;
constexpr size_t WS_CTL = 0, CTL_ZERO_BYTES = 1 * MiB;
constexpr size_t WS_WIN = 1 * MiB, WS_WOUT = 19 * MiB, WS_WCQ = 27 * MiB, WS_WCO = 35 * MiB, WS_WPQ = 43 * MiB, WS_WCKV = 51 * MiB, WS_WUQ = 67 * MiB, WS_WUKV = 68 * MiB, WS_KEYS = 69 * MiB, WS_ROPE = 70 * MiB;
constexpr size_t WS_XNB = 76 * MiB, WS_YB = 140 * MiB, WS_PROJB = 204 * MiB, WS_QMB = 348 * MiB, WS_KMB = 372 * MiB, WS_VMB = 396 * MiB, WS_RS = 412 * MiB;
constexpr size_t WS_HLB = 413 * MiB, WS_ACB = 445 * MiB, WS_LSUM = 477 * MiB, WS_OMB = 478 * MiB, WS_MNB = 494 * MiB, WS_KVCB = 502 * MiB, WS_EX = 518 * MiB, WS_GW = 534 * MiB;
constexpr size_t WS_U8 = 550 * MiB, WS_V8 = 614 * MiB, WS_SU = 678 * MiB, WS_SV = 679 * MiB;
constexpr size_t WS_HQ = 680 * MiB, WS_P = 712 * MiB, WS_SH = 728 * MiB, WS_W = 729 * MiB, WS_WS = 745 * MiB, WS_END = 746 * MiB;
constexpr size_t WS_BTAB = WS_KEYS + 512 * 1024, WS_LAMS = WS_BTAB + 4096, WS_SP = WS_LAMS + 4096;
constexpr int CW_BAR = 4096, CW_RANK = 8192;
constexpr int RING_OFF = 0, RING_BYTES = 131072, LDSCTL_OFF = RING_BYTES, MISC_OFF = LDSCTL_OFF + 320, LDS_BYTES = 147456;

#define XB_TMO      128
#define XB_XCNT(j)  (256  + 64 * (j))
#define XB_XSUB(j)  (1280 + 64 * (j))
#define XB_XGEN(j)  (2304 + 64 * (j))
#define XB_TOP      3328
#define XB_TOPGEN   3392
#define XCD_BAR_WORDS 3456
#define XB_SPIN_CAP (1u << 18)

__device__ __forceinline__ unsigned xb_ld(unsigned* p)              { return __hip_atomic_load(p, __ATOMIC_RELAXED, __HIP_MEMORY_SCOPE_AGENT); }
__device__ __forceinline__ unsigned xb_add(unsigned* p, unsigned v) { return __hip_atomic_fetch_add(p, v, __ATOMIC_RELAXED, __HIP_MEMORY_SCOPE_AGENT); }
__device__ __forceinline__ unsigned xb_xcc_id() { return (unsigned)__builtin_amdgcn_s_getreg((3 << 11) | 20) & 0xFu; }
#define XB_SPIN(cond, bar) do { unsigned _sp = 0; while (cond) { __builtin_amdgcn_s_sleep(1); \
    if ((++_sp & 255u) == 0u) { if (xb_ld(&(bar)[XB_TMO])) break; if (_sp > XB_SPIN_CAP) { atomicAdd(&(bar)[XB_TMO], 1u); break; } } } } while (0)

struct XcdBarrier {
    unsigned* bar; unsigned x;
    volatile LAS unsigned* st;
};

__device__ __forceinline__ XcdBarrier xcd_barrier_post(unsigned* bar, volatile LAS unsigned* st) {
    XcdBarrier b; b.bar = bar; b.x = xb_xcc_id(); b.st = st;
    if (threadIdx.x == 0) (void)xb_add(&bar[XB_XCNT(b.x)], 1u);
    return b;
}
__device__ __forceinline__ void xcd_barrier_complete(unsigned* bar, unsigned x, unsigned& nloc, unsigned& nx) {
    const unsigned G = gridDim.x * gridDim.y * gridDim.z;
    unsigned sum, cnt, mine, sp = 0u;
    for (;;) {
        sum = 0u; cnt = 0u; mine = 0u;
#pragma unroll
        for (unsigned j = 0; j < 16; ++j) { const unsigned c = xb_ld(&bar[XB_XCNT(j)]); sum += c; cnt += (c > 0u) ? 1u : 0u; mine = (j == x) ? c : mine; }
        if (sum == G) break;
        __builtin_amdgcn_s_sleep(1);
        if ((++sp & 255u) == 0u) { if (xb_ld(&bar[XB_TMO])) break; if (sp > XB_SPIN_CAP) { atomicAdd(&bar[XB_TMO], 1u); break; } }
    }
    nloc = mine > 0u ? mine : 1u; nx = cnt > 0u ? cnt : 1u;
}

__device__ __noinline__ void xcd_barrier_impl(unsigned* bar_, unsigned x_, volatile LAS unsigned* st_, int leader_) {
    XcdBarrier b; b.bar = bar_; b.x = x_; b.st = st_;
    asm volatile("s_waitcnt vmcnt(0)" ::: "memory");
    __syncthreads();
    if (leader_) {
        unsigned* bar = b.bar;
        __builtin_amdgcn_s_waitcnt(0);
        unsigned nloc = b.st[0], nx = b.st[1];
        if (nloc == 0u) { xcd_barrier_complete(bar, b.x, nloc, nx); b.st[0] = nloc; b.st[1] = nx; }
        const unsigned old = xb_add(&bar[XB_XSUB(b.x)], 1u);
        const unsigned gen = old / nloc;
        if (old + 1u == (gen + 1u) * nloc) {
            __builtin_amdgcn_fence(__ATOMIC_RELEASE, "agent");
            asm volatile("s_waitcnt vmcnt(0)" ::: "memory");
            const unsigned og = xb_add(&bar[XB_TOP], 1u);
            const unsigned tg = og / nx;
            if (og + 1u == (tg + 1u) * nx) xb_add(&bar[XB_TOPGEN], 1u);
            else XB_SPIN(xb_ld(&bar[XB_TOPGEN]) == tg, bar);
            __builtin_amdgcn_fence(__ATOMIC_ACQUIRE, "agent");
            xb_add(&bar[XB_XGEN(b.x)], 1u);
            asm volatile("s_waitcnt vmcnt(0)" ::: "memory");
        } else {
            XB_SPIN(xb_ld(&bar[XB_XGEN(b.x)]) == gen, bar);
            __builtin_amdgcn_fence(__ATOMIC_ACQUIRE, "agent");
            asm volatile("s_waitcnt vmcnt(0)" ::: "memory");
        }
    }
    __syncthreads();
}
__device__ __forceinline__ void xcd_barrier(const XcdBarrier& b, int leader) { xcd_barrier_impl(b.bar, b.x, b.st, leader); }


__device__ __forceinline__ float wave_sum(float v, int lane) {
#pragma unroll
    for (int o = 1; o < 64; o <<= 1) v += shx(v, o, lane);
    return v;
}
__device__ __forceinline__ float gelu_erf(float v) {
    const float av = __builtin_fabsf(v), t = __builtin_amdgcn_rcpf(av * 0.2316418882f + 1.0f);
    float q = t * 0.5307027145f + (-0.7265760135f); q = q * t + 0.7107068705f; q = q * t + (-0.142248368f); q = q * t + 0.127414796f; q = q * t;
    const float e = __builtin_amdgcn_exp2f((v * v) * (-0.72134752044f));
    const float m = v * (q * e);
    return v < 0.f ? m : v - m;
}

__device__ __forceinline__ void norm_phase(const GAS float* X, const GAS float* g, GAS bf16* out, int rows, int gw, int NGW, int lane) {
    asm volatile("" : "+v"(lane));
    f32x4 gv[4];
#pragma unroll
    for (int j = 0; j < 4; ++j) gv[j] = ((const GAS f32x4*)g)[lane + 64 * j];
    for (int m = gw; m < rows; m += NGW) {
        const GAS f32x4* xr = (const GAS f32x4*)(X + (size_t)m * D) + lane;
        f32x4 v[4]; float s = 0.f;
#pragma unroll
        for (int j = 0; j < 4; ++j) { v[j] = xr[64 * j]; s += (v[j].x * v[j].x + v[j].y * v[j].y) + (v[j].z * v[j].z + v[j].w * v[j].w); }
        const float rs = rsqrtf(wave_sum(s, lane) * (1.f / D) + 1e-6f);
        GAS v2u* o8 = (GAS v2u*)(out + (size_t)m * D) + lane;
#pragma unroll
        for (int j = 0; j < 4; ++j) { v2u w; w.x = pk2(v[j].x * rs * gv[j].x, v[j].y * rs * gv[j].y); w.y = pk2(v[j].z * rs * gv[j].z, v[j].w * rs * gv[j].w); o8[64 * j] = w; }
    }
}
__device__ __forceinline__ void norm_q_phase(const GAS float* X, const GAS float* g, GAS bf16* out, GAS unsigned GAS char* HQ, GAS float* SH, GAS int* Pz, int rows, int gw, int NGW, int lane) {
    asm volatile("" : "+v"(lane));
    f32x4 gv[4];
#pragma unroll
    for (int j = 0; j < 4; ++j) gv[j] = ((const GAS f32x4*)g)[lane + 64 * j];
    for (int m = gw; m < rows; m += NGW) {
        const GAS f32x4* xr = (const GAS f32x4*)(X + (size_t)m * D) + lane;
        f32x4 v[4]; float s = 0.f;
#pragma unroll
        for (int j = 0; j < 4; ++j) { v[j] = xr[64 * j]; s += (v[j].x * v[j].x + v[j].y * v[j].y) + (v[j].z * v[j].z + v[j].w * v[j].w); }
        const float rs = rsqrtf(wave_sum(s, lane) * (1.f / D) + 1e-6f);
        float mx = 0.f;
#pragma unroll
        for (int j = 0; j < 4; ++j) { v[j] = v[j] * rs * gv[j]; mx = fmaxf(mx, fmaxf(fmaxf(__builtin_fabsf(v[j].x), __builtin_fabsf(v[j].y)), fmaxf(__builtin_fabsf(v[j].z), __builtin_fabsf(v[j].w)))); }
#pragma unroll
        for (int o = 1; o < 64; o <<= 1) mx = fmaxf(mx, shx(mx, o, lane));
        const float inv = mx > 0.f ? 127.f / mx : 0.f;
        GAS v2u* o8 = (GAS v2u*)(out + (size_t)m * D) + lane; GAS unsigned* q4p = (GAS unsigned*)(HQ + (size_t)m * D) + lane;
#pragma unroll
        for (int j = 0; j < 4; ++j) { v2u w; w.x = pk2(v[j].x, v[j].y); w.y = pk2(v[j].z, v[j].w); o8[64 * j] = w;
            const int ia = (int)__builtin_rintf(v[j].x * inv), ib = (int)__builtin_rintf(v[j].y * inv), ic = (int)__builtin_rintf(v[j].z * inv), id = (int)__builtin_rintf(v[j].w * inv);
            q4p[64 * j] = (unsigned)(ia & 255) | ((unsigned)(ib & 255) << 8) | ((unsigned)(ic & 255) << 16) | ((unsigned)(id & 255) << 24); }
        if (lane == 0) SH[m] = mx * (1.f / 127.f);
        ((GAS int*)(Pz + (size_t)m * 128))[lane] = 0; ((GAS int*)(Pz + (size_t)m * 128))[lane + 64] = 0;
    }
}
__device__ __forceinline__ void final_norm_phase(GAS float* X, const GAS float* g, int rows, int gw, int NGW, int lane) {
    asm volatile("" : "+v"(lane));
    for (int m = gw; m < rows; m += NGW) {
        GAS f32x4* xr = (GAS f32x4*)(X + (size_t)m * D) + lane;
        f32x4 v[4]; float s = 0.f;
#pragma unroll
        for (int j = 0; j < 4; ++j) { v[j] = xr[64 * j]; s += (v[j].x * v[j].x + v[j].y * v[j].y) + (v[j].z * v[j].z + v[j].w * v[j].w); }
        const float rs = rsqrtf(wave_sum(s, lane) * (1.f / D) + 1e-6f);
#pragma unroll
        for (int j = 0; j < 4; ++j) { const f32x4 gj = ((const GAS f32x4*)g)[lane + 64 * j]; xr[64 * j] = v[j] * rs * gj; }
    }
}

__device__ __forceinline__ void pre_phase(const GAS bf16* PROJB, const GAS float* ROPE, GAS float* RS, GAS bf16* KMB, int gw, int NGW, int lane) {
    asm volatile("" : "+v"(lane));
    for (int t = gw; t < T; t += NGW) {
        const GAS bf16* pr = PROJB + (size_t)t * INP;
        float sq = 0.f, skv = 0.f;
        if (lane < 24) { const v4u w = *(const GAS v4u*)(pr + PC_CQ + 8 * lane);
            const float a0 = bflo(w.x), a1 = bfhi(w.x), a2 = bflo(w.y), a3 = bfhi(w.y), a4 = bflo(w.z), a5 = bfhi(w.z), a6 = bflo(w.w), a7 = bfhi(w.w);
            sq = (a0 * a0 + a1 * a1) + (a2 * a2 + a3 * a3) + (a4 * a4 + a5 * a5) + (a6 * a6 + a7 * a7); }
        else if (lane >= 32 && lane < 48) { const v4u w = *(const GAS v4u*)(pr + PC_CKV + 8 * (lane - 32));
            const float a0 = bflo(w.x), a1 = bfhi(w.x), a2 = bflo(w.y), a3 = bfhi(w.y), a4 = bflo(w.z), a5 = bfhi(w.z), a6 = bflo(w.w), a7 = bfhi(w.w);
            skv = (a0 * a0 + a1 * a1) + (a2 * a2 + a3 * a3) + (a4 * a4 + a5 * a5) + (a6 * a6 + a7 * a7); }
        sq = wave_sum(sq, lane); skv = wave_sum(skv, lane);
        if (lane == 0) { RS[2 * (size_t)t] = rsqrtf(sq * (1.f / 192.f) + 1e-6f); RS[2 * (size_t)t + 1] = rsqrtf(skv * (1.f / 128.f) + 1e-6f); }
        if (lane < 16) {
            const float x1 = __builtin_bit_cast(float, (unsigned)pr[PC_KR + lane] << 16), x2 = __builtin_bit_cast(float, (unsigned)pr[PC_KR + 16 + lane] << 16);
            const float c = ROPE[(size_t)t * 32 + lane], sn = ROPE[(size_t)t * 32 + 16 + lane];
            const bf16 y1 = (bf16)f2bf_(x1 * c - x2 * sn), y2 = (bf16)f2bf_(x1 * sn + x2 * c);
            GAS bf16* kr = KMB + (size_t)t * 384 + 64 + lane;
#pragma unroll
            for (int h = 0; h < 4; ++h) { kr[h * 96] = y1; kr[h * 96 + 16] = y2; }
        }
    }
}

struct LruP { const GAS bf16* PROJB; const GAS float* cw; const GAS float* cb; const GAS float* wa; const GAS float* ba; const GAS float* wx; const GAS float* bx; const GAS float* sp; GAS bf16* HL; GAS bf16* AC; GAS float* LSUM; };
constexpr int LR_XP = 260;
constexpr int LR_XC = 0, LR_WA = 64 * LR_XP * 4, LR_WX = LR_WA + 16384, LR_SUM = LR_WX + 16384, LR_END = LR_SUM + 4096;
__device__ __forceinline__ void lru_phase(const LruP& P, LAS unsigned char* lds, int tid, int wave, int lane, int vcu, int G) {
    asm volatile("" : "+v"(tid), "+v"(lane));
    LAS float* xc = (LAS float*)(lds + LR_XC); LAS float* WA = (LAS float*)(lds + LR_WA); LAS float* WX = (LAS float*)(lds + LR_WX); LAS float* SUM = (LAS float*)(lds + LR_SUM);
    for (int u = vcu; u < (T / 256) * 8; u += G) {
        const int tile = u >> 3, g = u & 7; const int t0 = tile * 256; const bool first = ((tile & 31) == 0);
        __syncthreads();
#pragma unroll
        for (int i = 0; i < 2; ++i) { const int idx = tid + 512 * i; ((LAS f32x4*)WA)[idx] = ((const GAS f32x4*)(P.wa + g * 4096))[idx]; ((LAS f32x4*)WX)[idx] = ((const GAS f32x4*)(P.wx + g * 4096))[idx]; }
#pragma unroll 1
        for (int it = tid; it < 2048; it += 512) {
            const int time = it & 255, cg = it >> 8; const int ch0 = 64 * g + 8 * cg;
            float y[8];
            { const f32x4 b0 = *(const GAS f32x4*)(P.cb + ch0), b1 = *(const GAS f32x4*)(P.cb + ch0 + 4); y[0] = b0.x; y[1] = b0.y; y[2] = b0.z; y[3] = b0.w; y[4] = b1.x; y[5] = b1.y; y[6] = b1.z; y[7] = b1.w; }
#pragma unroll
            for (int k = 0; k < 4; ++k) {
                if (!(first && time - 3 + k < 0)) {
                    const v4u w = *(const GAS v4u*)(P.PROJB + (size_t)(t0 + time - 3 + k) * INP + PC_XL + ch0);
                    const f32x4 c0 = *(const GAS f32x4*)(P.cw + k * 512 + ch0), c1 = *(const GAS f32x4*)(P.cw + k * 512 + ch0 + 4);
                    y[0] += bflo(w.x) * c0.x; y[1] += bfhi(w.x) * c0.y; y[2] += bflo(w.y) * c0.z; y[3] += bfhi(w.y) * c0.w;
                    y[4] += bflo(w.z) * c1.x; y[5] += bfhi(w.z) * c1.y; y[6] += bflo(w.w) * c1.z; y[7] += bfhi(w.w) * c1.w;
                }
            }
#pragma unroll
            for (int e = 0; e < 8; ++e) xc[(8 * cg + e) * LR_XP + time] = y[e];
        }
        __syncthreads();
        float aa[32], ax[32];
        { const float b_a = P.ba[64 * g + lane], b_x = P.bx[64 * g + lane];
#pragma unroll
          for (int j = 0; j < 32; ++j) { aa[j] = b_a; ax[j] = b_x; } }
#pragma unroll 2
        for (int ci = 0; ci < 64; ++ci) {
            const float wa_ = WA[ci * 64 + lane], wx_ = WX[ci * 64 + lane];
            const LAS f32x4* xr = (const LAS f32x4*)(xc + ci * LR_XP + 32 * wave);
#pragma unroll
            for (int q = 0; q < 8; ++q) { const f32x4 xv = xr[q];
                aa[4 * q] += xv.x * wa_; aa[4 * q + 1] += xv.y * wa_; aa[4 * q + 2] += xv.z * wa_; aa[4 * q + 3] += xv.w * wa_;
                ax[4 * q] += xv.x * wx_; ax[4 * q + 1] += xv.y * wx_; ax[4 * q + 2] += xv.z * wx_; ax[4 * q + 3] += xv.w * wx_; }
        }
        { const float sp = P.sp[64 * g + lane];
          const LAS f32x4* xo = (const LAS f32x4*)(xc + lane * LR_XP + 32 * wave);
          float hrun = 0.f, arun = 1.f;
#pragma unroll
          for (int q = 0; q < 8; ++q) { const f32x4 xv = xo[q];
#pragma unroll
              for (int e = 0; e < 4; ++e) { const int j = 4 * q + e;
                  const float r = __builtin_amdgcn_rcpf(1.f + __builtin_amdgcn_exp2f(-LOG2E * aa[j])), ig = __builtin_amdgcn_rcpf(1.f + __builtin_amdgcn_exp2f(-LOG2E * ax[j]));
                  const float la = -8.0f * r * sp; const float a = __builtin_amdgcn_exp2f(LOG2E * la);
                  const float uu = __builtin_amdgcn_sqrtf(fmaxf(1.f - a * a, 0.f)) * (ig * xv[e]);
                  hrun = a * hrun + uu; arun *= a; aa[j] = arun; ax[j] = hrun; } }
          SUM[(wave * 64 + lane) * 2] = arun; SUM[(wave * 64 + lane) * 2 + 1] = hrun; }
        __syncthreads();
        float ca = 1.f, chh = 0.f;
        for (int w = 0; w < wave; ++w) { const float aw = SUM[(w * 64 + lane) * 2], hw = SUM[(w * 64 + lane) * 2 + 1]; chh = aw * chh + hw; ca *= aw; }
        { GAS bf16* hl = P.HL + (size_t)(t0 + 32 * wave) * 512 + 64 * g + lane; GAS bf16* ac = P.AC + (size_t)(t0 + 32 * wave) * 512 + 64 * g + lane;
#pragma unroll
          for (int j = 0; j < 32; ++j) { const float hh = ax[j] + aa[j] * chh, acc = aa[j] * ca; hl[(size_t)j * 512] = (bf16)f2bf_(hh); ac[(size_t)j * 512] = (bf16)f2bf_(acc);
              if (j == 31 && wave == 7) { P.LSUM[((size_t)tile * 512 + 64 * g + lane) * 2] = acc; P.LSUM[((size_t)tile * 512 + 64 * g + lane) * 2 + 1] = hh; } } }
    }
}

struct PostP { const GAS bf16* OMB; const GAS bf16* HL; const GAS bf16* AC; const GAS float* LSUM; const GAS bf16* PROJB; const GAS float* gm; const GAS float* gl; GAS bf16* Y; };
__device__ __forceinline__ void post_phase(const PostP& P, LAS unsigned char* lds, int tid, int wave, int lane, int vcu, int G) {
    asm volatile("" : "+v"(tid), "+v"(lane));
    LAS float* hin = (LAS float*)lds;
    for (int u = vcu; u < T / 64; u += G) {
        const int t0 = u * 64, tile = t0 >> 8, tb = tile & ~31;
        __syncthreads();
        { float h = 0.f;
          for (int c = tb; c < tile; ++c) { const float a = P.LSUM[((size_t)c * 512 + tid) * 2], hh = P.LSUM[((size_t)c * 512 + tid) * 2 + 1]; h = a * h + hh; }
          hin[tid] = h; }
        __syncthreads();
        f32x4 hi0 = *(const LAS f32x4*)(hin + 8 * lane), hi1 = *(const LAS f32x4*)(hin + 8 * lane + 4);
        const f32x4 g0 = *(const GAS f32x4*)(P.gl + 8 * lane), g1 = *(const GAS f32x4*)(P.gl + 8 * lane + 4), gmv = *(const GAS f32x4*)(P.gm + 4 * lane);
#pragma unroll 2
        for (int i = 0; i < 8; ++i) {
            const size_t t = (size_t)t0 + 8 * wave + i;
            const v4u hw = *(const GAS v4u*)(P.HL + t * 512 + 8 * lane), aw = *(const GAS v4u*)(P.AC + t * 512 + 8 * lane), gw_ = *(const GAS v4u*)(P.PROJB + t * INP + PC_GL + 8 * lane);
            const v2u mw = *(const GAS v2u*)(P.OMB + t * 256 + 4 * lane);
            float o[8];
            o[0] = (bflo(hw.x) + bflo(aw.x) * hi0.x) * gelu_erf(bflo(gw_.x)); o[1] = (bfhi(hw.x) + bfhi(aw.x) * hi0.y) * gelu_erf(bfhi(gw_.x));
            o[2] = (bflo(hw.y) + bflo(aw.y) * hi0.z) * gelu_erf(bflo(gw_.y)); o[3] = (bfhi(hw.y) + bfhi(aw.y) * hi0.w) * gelu_erf(bfhi(gw_.y));
            o[4] = (bflo(hw.z) + bflo(aw.z) * hi1.x) * gelu_erf(bflo(gw_.z)); o[5] = (bfhi(hw.z) + bfhi(aw.z) * hi1.y) * gelu_erf(bfhi(gw_.z));
            o[6] = (bflo(hw.w) + bflo(aw.w) * hi1.z) * gelu_erf(bflo(gw_.w)); o[7] = (bfhi(hw.w) + bfhi(aw.w) * hi1.w) * gelu_erf(bfhi(gw_.w));
            float s2 = 0.f;
#pragma unroll
            for (int e = 0; e < 8; ++e) s2 += o[e] * o[e];
            const float m0 = bflo(mw.x), m1 = bfhi(mw.x), m2 = bflo(mw.y), m3 = bfhi(mw.y);
            float s1 = (m0 * m0 + m1 * m1) + (m2 * m2 + m3 * m3);
            s1 = wave_sum(s1, lane); s2 = wave_sum(s2, lane);
            const float r1 = rsqrtf(s1 * (1.f / 256.f) + 1e-6f), r2 = rsqrtf(s2 * (1.f / 512.f) + 1e-6f);
            GAS bf16* yr = P.Y + t * 1024;
            { v2u w; w.x = pk2(m0 * r1 * gmv.x, m1 * r1 * gmv.y); w.y = pk2(m2 * r1 * gmv.z, m3 * r1 * gmv.w); *(GAS v2u*)(yr + 4 * lane) = w; }
            { v4u w; w.x = pk2(o[0] * r2 * g0.x, o[1] * r2 * g0.y); w.y = pk2(o[2] * r2 * g0.z, o[3] * r2 * g0.w); w.z = pk2(o[4] * r2 * g1.x, o[5] * r2 * g1.y); w.w = pk2(o[6] * r2 * g1.z, o[7] * r2 * g1.w);
              *(GAS v4u*)(yr + 256 + 8 * lane) = w; }
        }
    }
}

#define TILE_BAR() asm volatile("s_waitcnt lgkmcnt(0)\n\ts_barrier" ::: "memory")
typedef short bf16x8 __attribute__((ext_vector_type(8)));
typedef short s16x4 __attribute__((ext_vector_type(4)));
typedef float f32x16 __attribute__((ext_vector_type(16)));
typedef unsigned u32x4 __attribute__((ext_vector_type(4)));
__device__ __forceinline__ int crow(int r, int hi) { return (r & 3) + 8 * (r >> 2) + 4 * hi; }
typedef float f32x2_t __attribute__((ext_vector_type(2))); typedef __bf16 bf16x2_c __attribute__((ext_vector_type(2)));
__device__ __forceinline__ unsigned cvtpk(float lo, float hi) { f32x2_t v = {lo, hi}; bf16x2_c b = __builtin_convertvector(v, bf16x2_c); return __builtin_bit_cast(unsigned, b); }
__device__ __forceinline__ float swapmax(float m) { auto rr = __builtin_amdgcn_permlane32_swap(__float_as_uint(m), __float_as_uint(m), false, false); return fmaxf(__uint_as_float(rr[0]), __uint_as_float(rr[1])); }
__device__ __forceinline__ float swapadd(float m) { auto rr = __builtin_amdgcn_permlane32_swap(__float_as_uint(m), __float_as_uint(m), false, false); return __uint_as_float(rr[0]) + __uint_as_float(rr[1]); }
__device__ __forceinline__ s16x4 vtr(const LAS unsigned char* p) { return __builtin_bit_cast(s16x4, __builtin_amdgcn_ds_read_tr16_b64_v4i16((LAS s16x4*)p)); }
__device__ __forceinline__ bf16x8 pack8(const f32x16& p, int b) { u32x4 w; w.x = cvtpk(p[b], p[b + 1]); w.y = cvtpk(p[b + 2], p[b + 3]); w.z = cvtpk(p[b + 4], p[b + 5]); w.w = cvtpk(p[b + 6], p[b + 7]); return __builtin_bit_cast(bf16x8, w); }
__device__ __forceinline__ float vmax3(float a, float b, float c) { float r; asm("v_max3_f32 %0, %1, %2, %3" : "=v"(r) : "v"(a), "v"(b), "v"(c)); return r; }
__device__ __forceinline__ float max32(const f32x16& p, const f32x16& q) {
    float a = vmax3(p[0], p[1], p[2]), b = vmax3(p[3], p[4], p[5]), c = vmax3(p[6], p[7], p[8]), d = vmax3(p[9], p[10], p[11]), e = vmax3(p[12], p[13], p[14]);
    float f = vmax3(q[0], q[1], q[2]), g = vmax3(q[3], q[4], q[5]), h = vmax3(q[6], q[7], q[8]), i = vmax3(q[9], q[10], q[11]), j = vmax3(q[12], q[13], q[14]);
    a = vmax3(a, b, c); d = vmax3(d, e, p[15]); f = vmax3(f, g, h); i = vmax3(i, j, q[15]);
    return vmax3(vmax3(a, d, f), i, i);
}
__device__ __forceinline__ float max16(const f32x16& p) { float a = fmaxf(fmaxf(p[0], p[1]), fmaxf(p[2], p[3])), b = fmaxf(fmaxf(p[4], p[5]), fmaxf(p[6], p[7])), c = fmaxf(fmaxf(p[8], p[9]), fmaxf(p[10], p[11])), d = fmaxf(fmaxf(p[12], p[13]), fmaxf(p[14], p[15])); return fmaxf(fmaxf(a, b), fmaxf(c, d)); }

struct AttnP {
    const GAS bf16* Q; const GAS bf16* K; const GAS bf16* V; int qp, kp, vp;
    GAS bf16* O; int op;
    const GAS float* rope;
    const GAS int* pos; const GAS float* btab; const GAS float* dnorm; const GAS float* lams;
};
template <int KIND> struct AK {
    static constexpr bool DIFF = KIND == 1, CROSS = KIND == 2;
    static constexpr int HW = KIND == 0 ? 96 : KIND == 1 ? 64 : 256;
    static constexpr int NKS = KIND == 0 ? 6 : KIND == 1 ? 2 : 16;
    static constexpr int KP = KIND == 0 ? 208 : KIND == 1 ? 144 : 528;
    static constexpr int ND = CROSS ? 4 : 2;
    static constexpr int CPK = HW / 8, KCH = (64 * CPK + 511) / 512;
    static constexpr int VCH = ND / 2;
    static constexpr int KB = 64 * KP, VB = ND * 4096;
    static constexpr int NBUF = CROSS ? 2 : 3;
    static constexpr int K0 = 0, V0 = NBUF * KB, POS = V0 + NBUF * VB, BT = POS + 1024, DN = BT + 528, END = DN + 256;
};
static_assert(AK<2>::END <= RING_BYTES && AK<0>::END <= RING_BYTES && AK<1>::END + 16 + 8 * 8192 <= RING_BYTES, "attention LDS");

template <int KIND, bool LEAD>
__device__ __forceinline__ void attn_unit(const AttnP& P, int b, int h, int qb, int dhalf, LAS unsigned char* lds, int tid, int wave, int lane) {
    lane = lane_id_v(); tid = (wave << 6) | lane;
    typedef AK<KIND> C;
    constexpr bool DIFF = C::DIFF, CROSS = C::CROSS;
    constexpr int HW = C::HW, NKS = C::NKS, KP = C::KP, ND = C::ND, CPK = C::CPK, KCH = C::KCH, VCH = C::VCH;
    const int r32 = lane & 31, hi = lane >> 5;
    const size_t rowb = (size_t)b * S, rowk = CROSS ? (size_t)b * MEM : rowb;
    const int q0w = qb * 256 + wave * 32, qi = q0w + r32;
    int pq = 0; float bias_far = 0.f;
    __syncthreads();
    if (DIFF) {
        pq = P.pos[rowb + qi];
        if (tid < 129) ((LAS float*)(lds + C::BT))[tid] = P.btab[h * 129 + tid];
        if (tid >= 192 && tid < 256) ((LAS float*)(lds + C::DN))[tid - 192] = P.dnorm[tid - 192];
    }
    int minq = pq;
    if (DIFF) { for (int o = 1; o < 64; o <<= 1) { const int v = shxi(minq, o, lane); minq = v < minq ? v : minq; } }
    const int NT = CROSS ? MEM / 64 : 4 * (qb + 1);
    u32x4 kr[KCH], vr[VCH]; int pkr = 0;
    u32x4 kr2[CROSS ? 1 : KCH], vr2[CROSS ? 1 : VCH]; int pkr2 = 0;
    const GAS bf16* Kb = P.K + rowk * P.kp + h * HW; const GAS bf16* Vb = P.V + rowk * P.vp + (CROSS ? h * 256 + dhalf * 128 : h * 64);
    const __amdgpu_buffer_rsrc_t rK = __builtin_amdgcn_make_buffer_rsrc((void*)Kb, 0, 0x7fffffff, 0x00020000), rV = __builtin_amdgcn_make_buffer_rsrc((void*)Vb, 0, 0x7fffffff, 0x00020000);
    const __amdgpu_buffer_rsrc_t rP = __builtin_amdgcn_make_buffer_rsrc((void*)(DIFF ? P.pos + rowb : (const GAS int*)Kb), 0, 0x7fffffff, 0x00020000);
    int kvo[KCH], vvo[VCH];
#pragma unroll
    for (int i = 0; i < KCH; ++i) { int c = tid + 512 * i; c = c < 64 * CPK ? c : tid; kvo[i] = ((c / CPK) * P.kp + (c % CPK) * 8) * 2; }
#pragma unroll
    for (int i = 0; i < VCH; ++i) { const int c = tid + 512 * i; vvo[i] = ((c / (4 * ND)) * P.vp + (c % (4 * ND)) * 8) * 2; }
    const int pvo = (tid & 63) * 4;
    auto gload = [&](int t) {
        const int ks = __builtin_amdgcn_readfirstlane(64 * t * P.kp * 2), vs = __builtin_amdgcn_readfirstlane(64 * t * P.vp * 2);
#pragma unroll
        for (int i = 0; i < KCH; ++i) kr[i] = __builtin_amdgcn_raw_buffer_load_b128(rK, kvo[i], ks, 0);
#pragma unroll
        for (int i = 0; i < VCH; ++i) vr[i] = __builtin_amdgcn_raw_buffer_load_b128(rV, vvo[i], vs, 0);
        if (DIFF) pkr = __builtin_amdgcn_raw_buffer_load_b32(rP, pvo, __builtin_amdgcn_readfirstlane(64 * t * 4), 0);
    };
    auto lstore = [&](int buf) {
        LAS unsigned char* kb_ = lds + C::K0 + buf * C::KB; LAS unsigned char* vb_ = lds + C::V0 + buf * C::VB;
#pragma unroll
        for (int i = 0; i < KCH; ++i) { int c = tid + 512 * i; c = c < 64 * CPK ? c : tid; const int key = c / CPK, part = c % CPK; *(LAS u32x4*)(kb_ + key * KP + part * 16) = kr[i]; }
#pragma unroll
        for (int i = 0; i < VCH; ++i) { const int c = tid + 512 * i; const int key = c / (4 * ND), part = c % (4 * ND); *(LAS u32x4*)(vb_ + (part >> 2) * 4096 + (key >> 3) * 512 + (key & 7) * 64 + (part & 3) * 16) = vr[i]; }
        if (DIFF) { ((LAS int*)(lds + C::POS + buf * 256))[tid & 63] = pkr; if (tid < 64) { int mk_ = pkr; for (int o = 1; o < 64; o <<= 1) { const int v = shxi(mk_, o, lane); mk_ = v > mk_ ? v : mk_; } if (tid == 0) ((LAS int*)(lds + C::POS + 768))[buf] = mk_; } }
    };
    auto gloadB = [&](int t) {
        const int ks = __builtin_amdgcn_readfirstlane(64 * t * P.kp * 2), vs = __builtin_amdgcn_readfirstlane(64 * t * P.vp * 2);
#pragma unroll
        for (int i = 0; i < (CROSS ? 1 : KCH); ++i) kr2[i] = __builtin_amdgcn_raw_buffer_load_b128(rK, kvo[i], ks, 0);
#pragma unroll
        for (int i = 0; i < (CROSS ? 1 : VCH); ++i) vr2[i] = __builtin_amdgcn_raw_buffer_load_b128(rV, vvo[i], vs, 0);
        if (DIFF) pkr2 = __builtin_amdgcn_raw_buffer_load_b32(rP, pvo, __builtin_amdgcn_readfirstlane(64 * t * 4), 0);
    };
    auto lstoreB = [&](int buf) {
        LAS unsigned char* kb_ = lds + C::K0 + buf * C::KB; LAS unsigned char* vb_ = lds + C::V0 + buf * C::VB;
#pragma unroll
        for (int i = 0; i < (CROSS ? 1 : KCH); ++i) { int c = tid + 512 * i; c = c < 64 * CPK ? c : tid; const int key = c / CPK, part = c % CPK; *(LAS u32x4*)(kb_ + key * KP + part * 16) = kr2[i]; }
#pragma unroll
        for (int i = 0; i < (CROSS ? 1 : VCH); ++i) { const int c = tid + 512 * i; const int key = c / (4 * ND), part = c % (4 * ND); *(LAS u32x4*)(vb_ + (part >> 2) * 4096 + (key >> 3) * 512 + (key & 7) * 64 + (part & 3) * 16) = vr2[i]; }
        if (DIFF) { ((LAS int*)(lds + C::POS + buf * 256))[tid & 63] = pkr2; if (tid < 64) { int mk_ = pkr2; for (int o = 1; o < 64; o <<= 1) { const int v = shxi(mk_, o, lane); mk_ = v > mk_ ? v : mk_; } if (tid == 0) ((LAS int*)(lds + C::POS + 768))[buf] = mk_; } }
    };
    LAS float* osv = (LAS float*)(lds + ((C::END + 15) & ~15)) + wave * 2048 + lane;
    float il = 0.f;
    f32x16 oA[ND];
#pragma unroll 1
    for (int mp = 0; mp < (DIFF ? 2 : 1); ++mp) {
        bf16x8 qf[NKS];
        { const GAS bf16* qrow = P.Q + (rowb + qi) * P.qp + h * HW + mp * 32;
#pragma unroll
          for (int s = 0; s < NKS; ++s) qf[s] = *(const GAS bf16x8*)(qrow + 16 * s + 8 * hi);
          if (KIND == 0) {
              const GAS float* rp = P.rope + (rowb + qi) * 32 + 8 * hi;
              const f32x4 c0 = *(const GAS f32x4*)rp, c1 = *(const GAS f32x4*)(rp + 4), s0 = *(const GAS f32x4*)(rp + 16), s1 = *(const GAS f32x4*)(rp + 20);
              const u32x4 a = __builtin_bit_cast(u32x4, qf[NKS - 2]), bq = __builtin_bit_cast(u32x4, qf[NKS - 1]); u32x4 ra, rb;
#pragma unroll
              for (int w = 0; w < 4; ++w) { const float cl = w < 2 ? c0[2 * w] : c1[2 * w - 4], ch = w < 2 ? c0[2 * w + 1] : c1[2 * w - 3], sl = w < 2 ? s0[2 * w] : s1[2 * w - 4], sh = w < 2 ? s0[2 * w + 1] : s1[2 * w - 3];
                  const float x1l = bflo(a[w]), x1h = bfhi(a[w]), x2l = bflo(bq[w]), x2h = bfhi(bq[w]);
                  ra[w] = cvtpk(x1l * cl - x2l * sl, x1h * ch - x2h * sh); rb[w] = cvtpk(x1l * sl + x2l * cl, x1h * sh + x2h * ch); }
              qf[NKS - 2] = __builtin_bit_cast(bf16x8, ra); qf[NKS - 1] = __builtin_bit_cast(bf16x8, rb);
          } }
        __syncthreads();
        float m1 = -1e30f, l1 = 0.f;
#pragma unroll
        for (int d = 0; d < ND; ++d)
#pragma unroll
            for (int r = 0; r < 16; ++r) oA[d][r] = 0.f;
        auto qk = [&](int sl, f32x16& sa, f32x16& sb, float init) {
            const LAS unsigned char* kb_ = lds + C::K0 + sl * C::KB + r32 * KP + hi * 16 + mp * 64;
#pragma unroll
            for (int r = 0; r < 16; ++r) { sa[r] = init; sb[r] = init; }
            constexpr int HB = CROSS ? 4 : (NKS > 3 ? 3 : NKS);
#pragma unroll
            for (int s0_ = 0; s0_ < NKS; s0_ += HB) {
                bf16x8 kfa[HB], kfb[HB];
#pragma unroll
                for (int s = 0; s < HB; ++s) { kfa[s] = *(const LAS bf16x8*)(kb_ + (s0_ + s) * 32); kfb[s] = *(const LAS bf16x8*)(kb_ + 32 * KP + (s0_ + s) * 32); }
                __builtin_amdgcn_sched_barrier(0);
#pragma unroll
                for (int s = 0; s < HB; ++s) { sa = __builtin_amdgcn_mfma_f32_32x32x16_bf16(kfa[s], qf[s0_ + s], sa, 0, 0, 0); sb = __builtin_amdgcn_mfma_f32_32x32x16_bf16(kfb[s], qf[s0_ + s], sb, 0, 0, 0); }
                __builtin_amdgcn_sched_barrier(0);
            }
        };
        auto isnear = [&](int sl) { bool nb = false;
            if (DIFF) { const int mk_ = __builtin_amdgcn_readfirstlane(((LAS int*)(lds + C::POS + 768))[sl]); nb = (minq - mk_) < 128; }
            return nb; };
        auto sm = [&](int t, int sl, f32x16& pa, f32x16& pb, bool nearb) -> float {
            const int k0 = 64 * t;
            if (DIFF) { if (nearb) {
                const LAS int* pk = (const LAS int*)(lds + C::POS + sl * 256); const LAS float* bt = (const LAS float*)(lds + C::BT);
#pragma unroll
                for (int r = 0; r < 16; ++r) { const int kk = crow(r, hi);
                    int n0 = pq - pk[kk], n1 = pq - pk[kk + 32]; n0 = n0 < 0 ? 0 : (n0 > 128 ? 128 : n0); n1 = n1 < 0 ? 0 : (n1 > 128 ? 128 : n1);
                    pa[r] += bt[n0]; pb[r] += bt[n1]; }
            } }
            if (!CROSS && k0 + 63 > q0w) {
#pragma unroll
                for (int r = 0; r < 16; ++r) { const int kk = k0 + crow(r, hi); if (kk > qi) pa[r] = -1e30f; if (kk + 32 > qi) pb[r] = -1e30f; }
            }
            asm volatile("s_nop 15\n\ts_nop 7" : "+v"(pa), "+v"(pb));
            float mn, al = 1.f;
            if (CROSS) { const float mx = swapmax(max32(pa, pb)); mn = fmaxf(m1, mx); al = __builtin_amdgcn_exp2f(m1 - mn); l1 *= al; }
            else { const float mx = swapmax(max32(pa, pb)); const bool up = mx > m1 + 8.0f; mn = up ? mx : m1;
                   if (__builtin_amdgcn_ballot_w64(up) != 0ull) { al = __builtin_amdgcn_exp2f(m1 - mn); l1 *= al; } }
            m1 = mn;
            float ls = 0.f;
#pragma unroll
            for (int r = 0; r < 16; ++r) { pa[r] = __builtin_amdgcn_exp2f(pa[r] - mn); pb[r] = __builtin_amdgcn_exp2f(pb[r] - mn); ls += pa[r] + pb[r]; }
            l1 += ls;
            return al;
        };
        auto pv = [&](int sl, const f32x16& pa, const f32x16& pb, float al) {
            const LAS unsigned char* vb_ = lds + C::V0 + sl * C::VB + ((lane >> 4) & 1) * 32 + (lane & 3) * 8 + (4 * hi + ((lane & 15) >> 2)) * 64;
            bf16x8 pf[4];
            pf[0] = pack8(pa, 0); pf[1] = pack8(pa, 8); pf[2] = pack8(pb, 0); pf[3] = pack8(pb, 8);
            const bool resc = CROSS ? true : (__builtin_amdgcn_ballot_w64(al != 1.0f) != 0ull);
            if (CROSS) {
#pragma unroll
                for (int d = 0; d < ND; ++d) {
                    __builtin_amdgcn_sched_barrier(0);
#pragma unroll
                    for (int r = 0; r < 16; ++r) oA[d][r] *= al;
                    bf16x8 vf[4];
#pragma unroll
                    for (int s = 0; s < 4; ++s) { const s16x4 lo = vtr(vb_ + d * 4096 + s * 1024), hh = vtr(vb_ + d * 4096 + s * 1024 + 512); vf[s] = (bf16x8){lo[0], lo[1], lo[2], lo[3], hh[0], hh[1], hh[2], hh[3]}; }
#pragma unroll
                    for (int s = 0; s < 4; ++s) oA[d] = __builtin_amdgcn_mfma_f32_32x32x16_bf16(vf[s], pf[s], oA[d], 0, 0, 0);
                }
            } else if (DIFF) {
                if (resc) {
#pragma unroll
                    for (int d = 0; d < 2; ++d)
#pragma unroll
                        for (int r = 0; r < 16; ++r) oA[d][r] *= al;
                }
#pragma unroll
                for (int d = 0; d < 2; ++d) {
                    bf16x8 vf[4];
#pragma unroll
                    for (int s = 0; s < 4; ++s) { const s16x4 lo = vtr(vb_ + d * 4096 + s * 1024), hh = vtr(vb_ + d * 4096 + s * 1024 + 512); vf[s] = (bf16x8){lo[0], lo[1], lo[2], lo[3], hh[0], hh[1], hh[2], hh[3]}; }
                    __builtin_amdgcn_sched_barrier(0);
#pragma unroll
                    for (int s = 0; s < 4; ++s) oA[d] = __builtin_amdgcn_mfma_f32_32x32x16_bf16(vf[s], pf[s], oA[d], 0, 0, 0);
                }
            } else {
                bf16x8 vf[2][4];
#pragma unroll
                for (int d = 0; d < 2; ++d)
#pragma unroll
                    for (int s = 0; s < 4; ++s) { const s16x4 lo = vtr(vb_ + d * 4096 + s * 1024), hh = vtr(vb_ + d * 4096 + s * 1024 + 512); vf[d][s] = (bf16x8){lo[0], lo[1], lo[2], lo[3], hh[0], hh[1], hh[2], hh[3]}; }
                if (resc) {
#pragma unroll
                    for (int d = 0; d < 2; ++d)
#pragma unroll
                        for (int r = 0; r < 16; ++r) oA[d][r] *= al;
                }
                __builtin_amdgcn_sched_barrier(0);
#pragma unroll
                for (int s = 0; s < 4; ++s)
#pragma unroll
                    for (int d = 0; d < 2; ++d) oA[d] = __builtin_amdgcn_mfma_f32_32x32x16_bf16(vf[d][s], pf[s], oA[d], 0, 0, 0);
            }
        };
        if (CROSS) {
            gload(0); lstore(0);
            __syncthreads();
            for (int t = 0; t < NT; ++t) {
                const int buf = t & 1;
                f32x16 pa, pb;
                qk(buf, pa, pb, 0.f);
                const float al = sm(t, buf, pa, pb, false);
                pv(buf, pa, pb, al);
                if (t + 1 < NT) { gload(t + 1); lstore(buf ^ 1); }
                TILE_BAR();
            }
        } else {
            gload(0); lstore(0); gload(1); lstore(1);
            gload(2); gloadB(3);
            __syncthreads();
            if (DIFF) bias_far = ((LAS float*)(lds + C::BT))[128];
            const int NTW = (q0w + 31) / 64 + 1;
            constexpr bool lead = LEAD;
            f32x16 ca, cb, na, nb; bool cnear = isnear(0), nnear = false; float cal = 1.f;
            qk(0, ca, cb, (DIFF && !cnear) ? bias_far : 0.f);
            if (lead) cal = sm(0, 0, ca, cb, cnear);
            int s0 = 0, s1 = 1, s2 = 2;
            auto period = [&](int t, f32x16& xa, f32x16& xb, bool& xnear, f32x16& ya, f32x16& yb, bool& ynear) {
                const bool have_next = (t + 1 < NTW);
                if (lead) {
                    if (have_next) { ynear = isnear(s1); qk(s1, ya, yb, (DIFF && !ynear) ? bias_far : 0.f); }
                    if (t < NTW) pv(s0, xa, xb, cal);
                    if (have_next) cal = sm(t + 1, s1, ya, yb, ynear);
                } else {
                    if (t < NTW) cal = sm(t, s0, xa, xb, xnear);
                    if (have_next) { ynear = isnear(s1); qk(s1, ya, yb, (DIFF && !ynear) ? bias_far : 0.f); }
                    if (t < NTW) pv(s0, xa, xb, cal);
                }
                { const int tmp = s0; s0 = s1; s1 = s2; s2 = tmp; }
            };
            int t = 0;
            for (; t + 5 < NT; t += 2) {
                lstore(s2); gload(t + 4);
                period(t, ca, cb, cnear, na, nb, nnear);
                TILE_BAR();
                lstoreB(s2); gloadB(t + 5);
                period(t + 1, na, nb, nnear, ca, cb, cnear);
                TILE_BAR();
            }
            for (; t < NT; t += 2) {
                if (t + 2 < NT) { lstore(s2); if (t + 4 < NT) gload(t + 4); }
                period(t, ca, cb, cnear, na, nb, nnear);
                TILE_BAR();
                if (t + 3 < NT) { lstoreB(s2); if (t + 5 < NT) gloadB(t + 5); }
                period(t + 1, na, nb, nnear, ca, cb, cnear);
                TILE_BAR();
            }
        }
        il = 1.f / swapadd(l1);
        if (DIFF) { if (mp == 0) {
#pragma unroll
            for (int d = 0; d < 2; ++d)
#pragma unroll
                for (int r = 0; r < 16; ++r) osv[(d * 16 + r) * 64] = oA[d][r] * il; } }
    }
    GAS bf16* orow = P.O + (rowb + qi) * P.op + (CROSS ? h * 256 + dhalf * 128 : h * 64);
    if (!DIFF) {
#pragma unroll
        for (int d = 0; d < ND; ++d)
#pragma unroll
            for (int g = 0; g < 4; ++g) { v2u v; v.x = cvtpk(oA[d][4 * g] * il, oA[d][4 * g + 1] * il); v.y = cvtpk(oA[d][4 * g + 2] * il, oA[d][4 * g + 3] * il); *(GAS v2u*)(orow + 32 * d + 8 * g + 4 * hi) = v; }
    } else {
        const float lam = P.lams[0], lam_init = P.lams[1];
        const float i2 = lam * il;
        float ss = 0.f;
#pragma unroll
        for (int d = 0; d < 2; ++d)
#pragma unroll
            for (int r = 0; r < 16; ++r) { const float v = osv[(d * 16 + r) * 64] - oA[d][r] * i2; oA[d][r] = v; ss += v * v; }
        ss = swapadd(ss);
        const float rs = __builtin_amdgcn_rsqf(ss * (1.f / 64.f) + 1e-6f) * (1.f - lam_init);
        const LAS float* dn = (const LAS float*)(lds + C::DN);
#pragma unroll
        for (int d = 0; d < 2; ++d)
#pragma unroll
            for (int g = 0; g < 4; ++g) { const int c = 32 * d + 8 * g + 4 * hi; const f32x4 gn = *(const LAS f32x4*)(dn + c);
                v2u v; v.x = cvtpk(oA[d][4 * g] * rs * gn[0], oA[d][4 * g + 1] * rs * gn[1]); v.y = cvtpk(oA[d][4 * g + 2] * rs * gn[2], oA[d][4 * g + 3] * rs * gn[3]); *(GAS v2u*)(orow + c) = v; }
    }
}

__device__ __forceinline__ void attn_phase(const AttnP& PM, const AttnP& PD, LAS unsigned char* lds, int tid, int wave, int lane, int vcu, int G) {
    for (int i = vcu; i < 512; i += G) {
        const int kind = i >> 8, c = i & 255, bh = c >> 4, s = c & 15;
        if (kind == 0) {
#pragma unroll 1
            for (int k = 0; k < 2; ++k) { if (wave < 4) attn_unit<0, true>(PM, bh >> 2, bh & 3, k ? 31 - s : s, 0, lds, tid, wave, lane); else attn_unit<0, false>(PM, bh >> 2, bh & 3, k ? 31 - s : s, 0, lds, tid, wave, lane); }
        } else {
#pragma unroll 1
            for (int k = 0; k < 2; ++k) { if (wave < 4) attn_unit<1, true>(PD, bh >> 2, bh & 3, k ? 31 - s : s, 0, lds, tid, wave, lane); else attn_unit<1, false>(PD, bh >> 2, bh & 3, k ? 31 - s : s, 0, lds, tid, wave, lane); }
        }
    }
}
__device__ __forceinline__ void cross_phase(const AttnP& PC, LAS unsigned char* lds, int tid, int wave, int lane, int vcu, int G) {
#pragma unroll 1
    for (int i = vcu; i < 1024; i += G) { const int bh = i >> 6; attn_unit<2, true>(PC, bh >> 2, bh & 3, i & 31, (i >> 5) & 1, lds, tid, wave, lane); }
}

__device__ __forceinline__ float vmax2(float a, float b) { float r; asm("v_max_f32_e32 %0, %1, %2" : "=v"(r) : "v"(a), "v"(b)); return r; }
__device__ __forceinline__ float vmin2(float a, float b) { float r; asm("v_min_f32_e32 %0, %1, %2" : "=v"(r) : "v"(a), "v"(b)); return r; }
__device__ __forceinline__ void pad16(float (&a)[16]) {
    asm volatile("s_nop 1" : "+v"(a[0]), "+v"(a[1]), "+v"(a[2]), "+v"(a[3]), "+v"(a[4]), "+v"(a[5]), "+v"(a[6]), "+v"(a[7]), "+v"(a[8]), "+v"(a[9]), "+v"(a[10]), "+v"(a[11]), "+v"(a[12]), "+v"(a[13]), "+v"(a[14]), "+v"(a[15]));
}
__device__ __forceinline__ void sort16_desc(float (&a)[16]) {
#pragma unroll
    for (int k = 2; k <= 16; k <<= 1)
#pragma unroll
        for (int j = k >> 1; j > 0; j >>= 1)
#pragma unroll
            for (int i = 0; i < 16; ++i) { const int l = i ^ j; if (l > i) { const bool desc = ((i & k) == 0); const float hi_ = vmax2(a[i], a[l]), lo_ = vmin2(a[i], a[l]); a[i] = desc ? hi_ : lo_; a[l] = desc ? lo_ : hi_; } }
}
__device__ __forceinline__ void merge16_desc(float (&a)[16], const float (&b)[16]) {
#pragma unroll
    for (int i = 0; i < 16; ++i) a[i] = vmax2(a[i], b[15 - i]);
#pragma unroll
    for (int j = 8; j > 0; j >>= 1)
#pragma unroll
        for (int i = 0; i < 16; ++i) { const int l = i ^ j; if (l > i) { const float hi_ = vmax2(a[i], a[l]), lo_ = vmin2(a[i], a[l]); a[i] = hi_; a[l] = lo_; } }
}
__device__ __forceinline__ void top16_of_64(float (&g0)[16], float (&g1)[16], float (&g2)[16], float (&g3)[16]) {
    sort16_desc(g0); sort16_desc(g1); merge16_desc(g0, g1); sort16_desc(g2); sort16_desc(g3); merge16_desc(g2, g3); merge16_desc(g0, g2);
}
__device__ __forceinline__ float embed(float v, unsigned mask, unsigned id) { return __builtin_bit_cast(float, (__builtin_bit_cast(unsigned, v) & mask) | id); }
__device__ __forceinline__ float mkcand(float x, float y, unsigned id) { return embed(x + y, 0xFFFFFF00u, id); }

__device__ __forceinline__ void swap32(float& a, float& b) { asm volatile("v_nop\n\tv_nop\n\tv_permlane32_swap_b32 %0, %1" : "+v"(a), "+v"(b)); }
struct RouteP { const GAS bf16* QP; const GAS bf16* keys; GAS int* EX; GAS float* GW; };
constexpr int RT_KP = 144, RT_KEYS = 0, RT_SCR = 256 * RT_KP, RT_END = RT_SCR + 8 * 8192;
__device__ __forceinline__ void route_phase(const RouteP& P, LAS unsigned char* lds, int tid, int wave, int lane, int vcu, int G) {
    asm volatile("" : "+v"(tid), "+v"(lane));
    __syncthreads();
    for (int c = tid; c < 256 * 8; c += 512) { const int row = c >> 3, part = c & 7; *(LAS u32x4*)(lds + RT_KEYS + row * RT_KP + part * 16) = *(const u32x4*)(P.keys + row * 64 + part * 8); }
    __syncthreads();
    const int r32 = lane & 31, hi = lane >> 5;
    LAS int* scr = (LAS int*)(lds + RT_SCR + wave * 8192);
    for (int u = vcu; u < T / 32; u += G) {
        const size_t t = (size_t)u * 32 + r32; const int h = wave;
        float T2[2][16];
#pragma unroll
        for (int c = 0; c < 2; ++c) {
            bf16x8 qf[4];
            { const GAS bf16* q = P.QP + t * 1024 + h * 128 + c * 64 + 8 * hi;
#pragma unroll
              for (int s = 0; s < 4; ++s) qf[s] = *(const GAS bf16x8*)(q + 16 * s); }
            f32x16 sc[4];
#pragma unroll
            for (int m = 0; m < 4; ++m) {
#pragma unroll
                for (int r = 0; r < 16; ++r) sc[m][r] = 0.f;
#pragma unroll
                for (int s = 0; s < 4; ++s) { const bf16x8 a = *(const LAS bf16x8*)(lds + RT_KEYS + (c * 128 + 32 * m + r32) * RT_KP + s * 32 + hi * 16);
                    sc[m] = __builtin_amdgcn_mfma_f32_32x32x16_bf16(a, qf[s], sc[m], 0, 0, 0); }
            }
            float g0[16], g1[16], g2[16], g3[16];
            const unsigned h4 = 4u * (unsigned)hi;
#pragma unroll
            for (int r = 0; r < 16; ++r) { const unsigned kr_ = (unsigned)((r & 3) + 8 * (r >> 2));
                g0[r] = embed(sc[0][r], 0xFFFFFF80u, kr_ | h4); g1[r] = embed(sc[1][r], 0xFFFFFF80u, (32u + kr_) | h4); g2[r] = embed(sc[2][r], 0xFFFFFF80u, (64u + kr_) | h4); g3[r] = embed(sc[3][r], 0xFFFFFF80u, (96u + kr_) | h4); }
            top16_of_64(g0, g1, g2, g3);
            pad16(g0);
#pragma unroll
            for (int i = 0; i < 16; ++i) T2[c][i] = g0[i];
        }
        float A[16], Bv[16];
#pragma unroll
        for (int i = 0; i < 16; ++i) { A[i] = T2[0][i]; Bv[i] = T2[1][i]; swap32(A[i], Bv[i]); }
        merge16_desc(A, Bv);
        pad16(A);
        float T0[16], T1[16];
#pragma unroll
        for (int i = 0; i < 16; ++i) { T0[i] = A[i]; T1[i] = A[i]; swap32(T0[i], T1[i]); }
#pragma unroll
        for (int i = 0; i < 16; ++i) { scr[i * 64 + lane] = (int)(__builtin_bit_cast(unsigned, T0[i]) & 127u); scr[(16 + i) * 64 + lane] = (int)(__builtin_bit_cast(unsigned, T1[i]) & 127u);
            T0[i] = embed(T0[i], 0xFFFFFF80u, 0u); T1[i] = embed(T1[i], 0xFFFFFF80u, 0u); }
        float c0[16], c1[16], c2[16], c3[16];
        const float NINF = -__builtin_inff();
#pragma unroll
        for (int b = 0; b < 16; ++b) c0[b] = mkcand(T0[0], T1[b], (unsigned)b);
#pragma unroll
        for (int b = 0; b < 8; ++b) c1[b] = mkcand(T0[1], T1[b], 16u + b);
#pragma unroll
        for (int b = 0; b < 5; ++b) c1[8 + b] = mkcand(T0[2], T1[b], 32u + b);
#pragma unroll
        for (int b = 0; b < 3; ++b) c1[13 + b] = mkcand(T0[4], T1[b], 64u + b);
#pragma unroll
        for (int b = 0; b < 4; ++b) c2[b] = mkcand(T0[3], T1[b], 48u + b);
        c2[4] = mkcand(T0[5], T1[0], 80u); c2[5] = mkcand(T0[5], T1[1], 81u); c2[6] = mkcand(T0[6], T1[0], 96u); c2[7] = mkcand(T0[6], T1[1], 97u); c2[8] = mkcand(T0[7], T1[0], 112u); c2[9] = mkcand(T0[7], T1[1], 113u);
#pragma unroll
        for (int a = 8; a < 14; ++a) c2[10 + a - 8] = mkcand(T0[a], T1[0], 16u * a);
        c3[0] = mkcand(T0[14], T1[0], 224u); c3[1] = mkcand(T0[15], T1[0], 240u);
#pragma unroll
        for (int i = 2; i < 16; ++i) c3[i] = NINF;
        top16_of_64(c0, c1, c2, c3);
        pad16(c0);
        float gsum = 0.f, ge[16]; int ex[16];
        const float mtop = embed(c0[0], 0xFFFFFF00u, 0u);
#pragma unroll
        for (int i = 0; i < 16; ++i) { const unsigned bits = __builtin_bit_cast(unsigned, c0[i]); const int a = (bits >> 4) & 15, b = bits & 15;
            ge[i] = __builtin_amdgcn_exp2f((embed(c0[i], 0xFFFFFF00u, 0u) - mtop) * LOG2E); gsum += ge[i];
            ex[i] = scr[a * 64 + lane] * 128 + scr[(16 + b) * 64 + lane]; }
        const float ginv = __builtin_amdgcn_rcpf(gsum);
        if (hi == 0) { GAS v4u* d = (GAS v4u*)(P.EX + t * 128 + h * 16);
#pragma unroll
            for (int i = 0; i < 4; ++i) d[i] = (v4u){(unsigned)ex[4 * i], (unsigned)ex[4 * i + 1], (unsigned)ex[4 * i + 2], (unsigned)ex[4 * i + 3]}; }
        else { GAS f32x4* d = (GAS f32x4*)(P.GW + t * 128 + h * 16);
#pragma unroll
            for (int i = 0; i < 4; ++i) d[i] = (f32x4){ge[4 * i] * ginv, ge[4 * i + 1] * ginv, ge[4 * i + 2] * ginv, ge[4 * i + 3] * ginv}; }
    }
}

__device__ __forceinline__ int wave_allsum_i(int v) {
    v += __builtin_amdgcn_update_dpp(0, v, 0xB1, 0xF, 0xF, true);
    v += __builtin_amdgcn_update_dpp(0, v, 0x4E, 0xF, 0xF, true);
    v += __builtin_amdgcn_update_dpp(0, v, 0x141, 0xF, 0xF, true);
    v += __builtin_amdgcn_update_dpp(0, v, 0x140, 0xF, 0xF, true);
    { int a = v, b = v; asm volatile("v_nop\n\tv_nop\n\tv_permlane16_swap_b32 %0, %1" : "+v"(a), "+v"(b)); v = a + b; }
    { int a = v, b = v; asm volatile("v_nop\n\tv_nop\n\tv_permlane32_swap_b32 %0, %1" : "+v"(a), "+v"(b)); v = a + b; }
    return v;
}
__device__ __forceinline__ float wave_allsum(float v) {
    v += __builtin_bit_cast(float, __builtin_amdgcn_update_dpp(0, __builtin_bit_cast(int, v), 0xB1, 0xF, 0xF, true));
    v += __builtin_bit_cast(float, __builtin_amdgcn_update_dpp(0, __builtin_bit_cast(int, v), 0x4E, 0xF, 0xF, true));
    v += __builtin_bit_cast(float, __builtin_amdgcn_update_dpp(0, __builtin_bit_cast(int, v), 0x141, 0xF, 0xF, true));
    v += __builtin_bit_cast(float, __builtin_amdgcn_update_dpp(0, __builtin_bit_cast(int, v), 0x140, 0xF, 0xF, true));
    { float a = v, b = v; asm volatile("v_nop\n\tv_nop\n\tv_permlane16_swap_b32 %0, %1" : "+v"(a), "+v"(b)); v = a + b; }
    { float a = v, b = v; asm volatile("v_nop\n\tv_nop\n\tv_permlane32_swap_b32 %0, %1" : "+v"(a), "+v"(b)); v = a + b; }
    return v;
}
__device__ __forceinline__ float wave_allmax(float v) {
    v = fmaxf(v, __builtin_bit_cast(float, __builtin_amdgcn_update_dpp(0, __builtin_bit_cast(int, v), 0xB1, 0xF, 0xF, true)));
    v = fmaxf(v, __builtin_bit_cast(float, __builtin_amdgcn_update_dpp(0, __builtin_bit_cast(int, v), 0x4E, 0xF, 0xF, true)));
    v = fmaxf(v, __builtin_bit_cast(float, __builtin_amdgcn_update_dpp(0, __builtin_bit_cast(int, v), 0x141, 0xF, 0xF, true)));
    v = fmaxf(v, __builtin_bit_cast(float, __builtin_amdgcn_update_dpp(0, __builtin_bit_cast(int, v), 0x140, 0xF, 0xF, true)));
    { float a = v, b = v; asm volatile("v_nop\n\tv_nop\n\tv_permlane16_swap_b32 %0, %1" : "+v"(a), "+v"(b)); v = fmaxf(a, b); }
    { float a = v, b = v; asm volatile("v_nop\n\tv_nop\n\tv_permlane32_swap_b32 %0, %1" : "+v"(a), "+v"(b)); v = fmaxf(a, b); }
    return v;
}
__device__ __forceinline__ unsigned q4(float a, float b, float c, float d, int off) {
    const int ia = (int)__builtin_rintf(a) + off, ib = (int)__builtin_rintf(b) + off, ic = (int)__builtin_rintf(c) + off, id = (int)__builtin_rintf(d) + off;
    return (unsigned)(ia & 255) | ((unsigned)(ib & 255) << 8) | ((unsigned)(ic & 255) << 16) | ((unsigned)(id & 255) << 24);
}
__device__ __forceinline__ void quant_row(const GAS float* src, GAS unsigned* dst, GAS float* scale, int off, int lane) {
    const GAS f32x4* s = (const GAS f32x4*)src + 4 * lane; f32x4 v[4]; float m = 0.f;
#pragma unroll
    for (int i = 0; i < 4; ++i) { v[i] = s[i]; m = fmaxf(m, fmaxf(fmaxf(__builtin_fabsf(v[i].x), __builtin_fabsf(v[i].y)), fmaxf(__builtin_fabsf(v[i].z), __builtin_fabsf(v[i].w)))); }
    m = wave_allmax(m); const float inv = m > 0.f ? 127.f / m : 0.f;
    v4u w;
    w.x = q4(v[0].x * inv, v[0].y * inv, v[0].z * inv, v[0].w * inv, off); w.y = q4(v[1].x * inv, v[1].y * inv, v[1].z * inv, v[1].w * inv, off);
    w.z = q4(v[2].x * inv, v[2].y * inv, v[2].z * inv, v[2].w * inv, off); w.w = q4(v[3].x * inv, v[3].y * inv, v[3].z * inv, v[3].w * inv, off);
    *((GAS v4u*)dst + lane) = w;
    if (lane == 0) *scale = m * (1.f / 127.f);
}
struct PeerS { int nslices_step, first_slice, nloc, rank; };
__device__ __forceinline__ PeerS peer_sched(const GAS unsigned* rankw, int xcc, int rank) {
    int nx = 0, myidx = 0, nloc = 1;
    for (int j = 0; j < 16; ++j) { const int c = (int)__hip_atomic_load(rankw + 64 * j, __ATOMIC_RELAXED, __HIP_MEMORY_SCOPE_AGENT); if (c > 0) { if (j == xcc) { myidx = nx; nloc = c; } ++nx; } }
    PeerS s; s.nslices_step = nx > 0 ? nx : 1; s.first_slice = myidx; s.nloc = nloc; s.rank = rank; return s;
}
struct Peer1P { const GAS unsigned GAS char* HQ; const GAS int* EX; const GAS unsigned GAS char* U8; GAS int* P; };
__device__ __forceinline__ void peer_k1(const Peer1P& Q, const PeerS& sc, int wave, int lane) {
    asm volatile("" : "+v"(lane));
    const int g = lane >> 3, j = lane & 7;
    for (int s = sc.first_slice; s < 8; s += sc.nslices_step)
        for (int tile = sc.rank; tile < T / 64; tile += sc.nloc) {
            const size_t t0 = (size_t)tile * 64 + wave * 8;
            v4u hqn = *(const GAS v4u*)(Q.HQ + t0 * 1024 + 128 * s + 16 * j), exn[4];
#pragma unroll
            for (int i = 0; i < 4; ++i) exn[i] = *(const GAS v4u*)(Q.EX + t0 * 128 + 16 * g + 4 * i);
#pragma unroll 1
            for (int k = 0; k < 8; ++k) {
                const size_t t = t0 + k;
                const v4u hq = hqn; v4u ex[4];
#pragma unroll
                for (int i = 0; i < 4; ++i) ex[i] = exn[i];
                if (k + 1 < 8) {
                    hqn = *(const GAS v4u*)(Q.HQ + (t + 1) * 1024 + 128 * s + 16 * j);
#pragma unroll
                    for (int i = 0; i < 4; ++i) exn[i] = *(const GAS v4u*)(Q.EX + (t + 1) * 128 + 16 * g + 4 * i);
                }
                v4u uu[16];
#pragma unroll
                for (int i = 0; i < 16; ++i) { const unsigned e = (i & 3) == 0 ? ex[i >> 2].x : (i & 3) == 1 ? ex[i >> 2].y : (i & 3) == 2 ? ex[i >> 2].z : ex[i >> 2].w;
                    uu[i] = *(const GAS v4u*)(Q.U8 + (size_t)e * 1024 + 128 * s + 16 * j); }
                int lo = 0, hi = 0;
#pragma unroll
                for (int i = 0; i < 16; ++i) {
                    int p = __builtin_amdgcn_sdot4((int)uu[i].x, (int)hq.x, 0, false); p = __builtin_amdgcn_sdot4((int)uu[i].y, (int)hq.y, p, false); p = __builtin_amdgcn_sdot4((int)uu[i].z, (int)hq.z, p, false); p = __builtin_amdgcn_sdot4((int)uu[i].w, (int)hq.w, p, false);
                    p += __builtin_amdgcn_update_dpp(0, p, 0xB1, 0xF, 0xF, true); p += __builtin_amdgcn_update_dpp(0, p, 0x4E, 0xF, 0xF, true); p += __builtin_amdgcn_update_dpp(0, p, 0x141, 0xF, 0xF, true);
                    if (i < 8) lo = (j == i) ? p : lo; else hi = (j == i - 8) ? p : hi;
                }
                GAS int* prow = Q.P + t * 128 + 16 * g + j;
                (void)__hip_atomic_fetch_add(prow, lo, __ATOMIC_RELAXED, __HIP_MEMORY_SCOPE_AGENT); (void)__hip_atomic_fetch_add(prow + 8, hi, __ATOMIC_RELAXED, __HIP_MEMORY_SCOPE_AGENT);
            }
        }
}
__device__ __forceinline__ void peer_w(const GAS int* EX, const GAS float* GW, const GAS int* P, const GAS float* SH, const GAS float* SU, const GAS float* SV, GAS signed char* WQ, GAS float* WSC, int gw, int NGW, int lane) {
    asm volatile("" : "+v"(lane));
    for (int t = gw; t < T; t += NGW) {
        const float sh = SH[t];
#pragma unroll
        for (int q = 0; q < 2; ++q) { const size_t idx = (size_t)t * 128 + lane + 64 * q; const int e = EX[idx];
            const float w = GW[idx] * gelu_erf((float)P[idx] * (sh * SU[e])) * SV[e];
            float m = __builtin_fabsf(w);
            m = fmaxf(m, __builtin_bit_cast(float, __builtin_amdgcn_update_dpp(0, __builtin_bit_cast(int, m), 0xB1, 0xF, 0xF, true)));
            m = fmaxf(m, __builtin_bit_cast(float, __builtin_amdgcn_update_dpp(0, __builtin_bit_cast(int, m), 0x4E, 0xF, 0xF, true)));
            m = fmaxf(m, __builtin_bit_cast(float, __builtin_amdgcn_update_dpp(0, __builtin_bit_cast(int, m), 0x141, 0xF, 0xF, true)));
            m = fmaxf(m, __builtin_bit_cast(float, __builtin_amdgcn_update_dpp(0, __builtin_bit_cast(int, m), 0x140, 0xF, 0xF, true)));
            const float inv = m > 0.f ? 127.f / m : 0.f;
            WQ[idx] = (signed char)(int)__builtin_rintf(w * inv);
            if ((lane & 15) == 0) WSC[(size_t)t * 8 + (lane >> 4) + 4 * q] = m * (1.f / 127.f); }
    }
}
__device__ __forceinline__ void tr4x4(unsigned r0, unsigned r1, unsigned r2, unsigned r3, unsigned (&t)[4]) {
    const unsigned x0 = __builtin_amdgcn_perm(r1, r0, 0x05010400u), x1 = __builtin_amdgcn_perm(r1, r0, 0x07030602u), y0 = __builtin_amdgcn_perm(r3, r2, 0x05010400u), y1 = __builtin_amdgcn_perm(r3, r2, 0x07030602u);
    t[0] = __builtin_amdgcn_perm(y0, x0, 0x05040100u); t[1] = __builtin_amdgcn_perm(y0, x0, 0x07060302u); t[2] = __builtin_amdgcn_perm(y1, x1, 0x05040100u); t[3] = __builtin_amdgcn_perm(y1, x1, 0x07060302u);
}
struct Peer2P { const GAS int* EX; const GAS signed char* WQ; const GAS float* WSC; const GAS unsigned char* V8; GAS float* X; };
__device__ __forceinline__ void peer_k2(const Peer2P& Q, const PeerS& sc, int wave, int lane) {
    asm volatile("" : "+v"(lane));
    const int g = lane >> 3, j = lane & 7, hf = lane >> 5, rp = (lane >> 4) & 1;
    for (int s = sc.first_slice; s < 8; s += sc.nslices_step)
        for (int tile = sc.rank; tile < T / 64; tile += sc.nloc) {
            const size_t t0 = (size_t)tile * 64 + wave * 8;
            v4u exn[4], wqn; float swn;
#pragma unroll
            for (int i = 0; i < 4; ++i) exn[i] = *(const GAS v4u*)(Q.EX + t0 * 128 + 16 * g + 4 * i);
            wqn = *(const GAS v4u*)(Q.WQ + t0 * 128 + 16 * g); swn = Q.WSC[t0 * 8 + g];
#pragma unroll 1
            for (int k = 0; k < 8; ++k) {
                const size_t t = t0 + k;
                v4u ex[4]; const v4u wq = wqn; const float sw = swn;
#pragma unroll
                for (int i = 0; i < 4; ++i) ex[i] = exn[i];
                if (k + 1 < 8) {
#pragma unroll
                    for (int i = 0; i < 4; ++i) exn[i] = *(const GAS v4u*)(Q.EX + (t + 1) * 128 + 16 * g + 4 * i);
                    wqn = *(const GAS v4u*)(Q.WQ + (t + 1) * 128 + 16 * g); swn = Q.WSC[(t + 1) * 8 + g];
                }
                GAS f32x4* xp = (GAS f32x4*)(Q.X + t * 1024 + 128 * s + 16 * j + 8 * hf + 4 * rp);
                const f32x4 xold = *xp;
                v4u vv[16];
#pragma unroll
                for (int i = 0; i < 16; ++i) { const unsigned e = (i & 3) == 0 ? ex[i >> 2].x : (i & 3) == 1 ? ex[i >> 2].y : (i & 3) == 2 ? ex[i >> 2].z : ex[i >> 2].w;
                    vv[i] = *(const GAS v4u*)(Q.V8 + (size_t)e * 1024 + 128 * s + 16 * j); }
                int ai[16];
#pragma unroll
                for (int i = 0; i < 16; ++i) ai[i] = 0;
#pragma unroll
                for (int q4_ = 0; q4_ < 4; ++q4_) {
                    const unsigned wq4 = q4_ == 0 ? wq.x : q4_ == 1 ? wq.y : q4_ == 2 ? wq.z : wq.w;
#pragma unroll
                    for (int c = 0; c < 4; ++c) { unsigned tt[4];
                        const v4u &a0 = vv[4 * q4_], &a1 = vv[4 * q4_ + 1], &a2 = vv[4 * q4_ + 2], &a3 = vv[4 * q4_ + 3];
                        tr4x4(c == 0 ? a0.x : c == 1 ? a0.y : c == 2 ? a0.z : a0.w, c == 0 ? a1.x : c == 1 ? a1.y : c == 2 ? a1.z : a1.w, c == 0 ? a2.x : c == 1 ? a2.y : c == 2 ? a2.z : a2.w, c == 0 ? a3.x : c == 1 ? a3.y : c == 2 ? a3.z : a3.w, tt);
#pragma unroll
                        for (int b = 0; b < 4; ++b) ai[4 * c + b] = __builtin_amdgcn_sdot4((int)tt[b], (int)wq4, ai[4 * c + b], false); }
                }
                float acc[16];
#pragma unroll
                for (int i = 0; i < 16; ++i) acc[i] = (float)ai[i] * sw;
                float r8[8], r4[4];
#pragma unroll
                for (int m = 0; m < 8; ++m) { float a = acc[m], b = acc[m + 8]; swap32(a, b); r8[m] = a + b; }
#pragma unroll
                for (int n = 0; n < 4; ++n) { float a = r8[n], b = r8[n + 4]; asm volatile("v_nop\n\tv_nop\n\tv_permlane16_swap_b32 %0, %1" : "+v"(a), "+v"(b)); r4[n] = a + b; }
#pragma unroll
                for (int n = 0; n < 4; ++n) r4[n] += __builtin_bit_cast(float, __builtin_amdgcn_update_dpp(0, __builtin_bit_cast(int, r4[n]), 0x128, 0xF, 0xF, true));
                if ((lane & 8) == 0) *xp = xold + (f32x4){r4[0], r4[1], r4[2], r4[3]};
            }
        }
}

struct Args { const float* in[33]; float* out; unsigned char* ws; int ph_lo, ph_hi; };
struct Frame { LAS unsigned char* lds; volatile LAS unsigned* MISC; gu32* ctl; int tid, lane, wave, G, vcu, xcc, xrank; };

__device__ __forceinline__ void transpose_item(const float* W, int ldw, int nsrc0, bf16* WT, int ldt, int rdst0, LAS float* scr, int kb, int nb, int lane, float scale, const float* kgain) {
    const int k0 = 64 * kb, n0 = 32 * nb;
#pragma unroll 8
    for (int i = 0; i < 32; ++i) { const int kk = 2 * i + (lane >> 5); const float gsc = kgain ? kgain[k0 + kk] * scale : scale; scr[kk * 33 + (lane & 31)] = W[(size_t)(k0 + kk) * ldw + nsrc0 + n0 + (lane & 31)] * gsc; }
    LDS_WAIT(); asm volatile("" ::: "memory");
    const int c = lane & 7;
#pragma unroll
    for (int j = 0; j < 4; ++j) { const int n = (lane >> 3) + 8 * j; const LAS float* s = scr + (8 * c) * 33 + n;
        v4u o; o.x = pk2(s[0 * 33], s[1 * 33]); o.y = pk2(s[2 * 33], s[3 * 33]); o.z = pk2(s[4 * 33], s[5 * 33]); o.w = pk2(s[6 * 33], s[7 * 33]);
        *(GAS v4u*)(WT + (size_t)(rdst0 + n0 + n) * ldt + k0 + 8 * c) = o; }
    LDS_WAIT(); asm volatile("" ::: "memory");
}
__device__ __forceinline__ void zero_rect(bf16* base, int ld, int row0, int nrows, int col0, int ncols, int gtid, int gthreads) {
    const int vpr = ncols / 8;
    for (int i = gtid; i < nrows * vpr; i += gthreads) { const int r = i / vpr, c = i % vpr; *(GAS v4u*)(base + (size_t)(row0 + r) * ld + col0 + 8 * c) = (v4u){0u, 0u, 0u, 0u}; }
}

__device__ __forceinline__ void p0_prologue(Frame& F, const Args& a) {
    LAS float* scr = (LAS float*)(F.lds + RING_OFF + F.wave * 16384);
    const int gw = blockIdx.x * NWAVES + F.wave, NGW = F.G * NWAVES;
    const int gtid = blockIdx.x * (NWAVES * 64) + F.tid, gthreads = F.G * NWAVES * 64;
    unsigned char* ws = a.ws;
    { const GAS f32x4* src = (const GAS f32x4*)a.in[0]; GAS f32x4* dst = (GAS f32x4*)a.out; const size_t n4 = (size_t)T * D / 4;
      for (size_t i = gtid; i < n4; i += (size_t)gthreads) dst[i] = src[i]; }
    constexpr int I_IN = 16 * (INW / 32), I_SQ = 16 * 32, I_CKV = 16 * 64, I_UQ = 3 * 12, I_UKV = 2 * 16, I_L = I_IN + 4 * I_SQ + I_CKV + I_UQ + I_UKV;
    for (int it = gw; it < L * I_L; it += NGW) {
        const int l = it / I_L; int r = it % I_L;
        if (r < I_IN) {
            const int kb = r / 67, nb = r % 67; int src, dst; float sc = 1.f;
            if (nb < 6) { src = 32 * nb; dst = src; } else if (nb < 11) { src = 32 * nb; dst = src + 64; } else { src = 32 * nb; dst = src + 160; if (nb >= 43 && nb < 51) sc = 0.17677669529663687f * LOG2E; }
            transpose_item(a.in[5] + (size_t)l * D * INW, INW, src, (bf16*)(ws + WS_WIN) + (size_t)l * INP * D, D, dst, scr, kb, 0, F.lane, sc, nullptr); continue; } r -= I_IN;
        if (r < I_SQ) { transpose_item(a.in[21] + (size_t)l * D * D, D, 0, (bf16*)(ws + WS_WOUT) + (size_t)l * D * D, D, 0, scr, r / 32, r % 32, F.lane, 1.f, nullptr); continue; } r -= I_SQ;
        if (r < I_SQ) { transpose_item(a.in[24] + (size_t)l * D * D, D, 0, (bf16*)(ws + WS_WCQ) + (size_t)l * D * D, D, 0, scr, r / 32, r % 32, F.lane, 0.0625f * LOG2E, nullptr); continue; } r -= I_SQ;
        if (r < I_SQ) { transpose_item(a.in[26] + (size_t)l * D * D, D, 0, (bf16*)(ws + WS_WCO) + (size_t)l * D * D, D, 0, scr, r / 32, r % 32, F.lane, 1.f, nullptr); continue; } r -= I_SQ;
        if (r < I_SQ) { transpose_item(a.in[28] + (size_t)l * D * D, D, 0, (bf16*)(ws + WS_WPQ) + (size_t)l * D * D, D, 0, scr, r / 32, r % 32, F.lane, 1.f, nullptr); continue; } r -= I_SQ;
        if (r < I_CKV) { transpose_item(a.in[25] + (size_t)l * D * 2 * D, 2 * D, 0, (bf16*)(ws + WS_WCKV) + (size_t)l * 2 * D * D, D, 0, scr, r / 64, r % 64, F.lane, 1.f, nullptr); continue; } r -= I_CKV;
        if (r < I_UQ) { transpose_item(a.in[7] + (size_t)l * 192 * 384, 384, 0, (bf16*)(ws + WS_WUQ) + (size_t)l * 512 * 256, 256, 0, scr, r / 12, r % 12, F.lane, 0.10206207261596575f * LOG2E, a.in[6] + l * 192); continue; } r -= I_UQ;
        transpose_item(a.in[9] + (size_t)l * 128 * 512, 512, 0, (bf16*)(ws + WS_WUKV) + (size_t)l * 512 * 256, 256, 0, scr, r / 16, r % 16, F.lane, 1.f, a.in[8] + l * 128);
    }
    for (int l = 0; l < L; ++l) {
        bf16* win = (bf16*)(ws + WS_WIN) + (size_t)l * INP * D; bf16* wuq = (bf16*)(ws + WS_WUQ) + (size_t)l * 512 * 256; bf16* wukv = (bf16*)(ws + WS_WUKV) + (size_t)l * 512 * 256;
        zero_rect(win, D, 192, 64, 0, D, gtid, gthreads); zero_rect(win, D, 416, 96, 0, D, gtid, gthreads);
        zero_rect(wuq, 256, 0, 384, 192, 64, gtid, gthreads); zero_rect(wuq, 256, 384, 128, 0, 256, gtid, gthreads);
        zero_rect(wukv, 256, 0, 512, 128, 128, gtid, gthreads);
    }
    { float* rope = (float*)(ws + WS_ROPE); const int* pos = (const int*)a.in[2];
      for (int i = gtid; i < T * 16; i += gthreads) { const int t = i >> 4, k = i & 15; const float inv = powf(10000.f, -(float)(2 * k) / 32.f); const float ang = (float)pos[t] * inv;
          rope[(size_t)t * 32 + k] = cosf(ang); rope[(size_t)t * 32 + 16 + k] = sinf(ang); } }
    { const GAS f32x4* ks = (const GAS f32x4*)a.in[29]; GAS v2u* kd = (GAS v2u*)(ws + WS_KEYS);
      for (int i = gtid; i < L * 2 * 128 * 64 / 4; i += gthreads) { const f32x4 v = ks[i]; v2u w; w.x = pk2(v.x, v.y); w.y = pk2(v.z, v.w); kd[i] = w; }
    }
    for (int r = gw; r < 2 * L * 16384; r += NGW) { const int tb = r / (L * 16384), rr = r % (L * 16384);
        quant_row((const GAS float*)a.in[30 + tb] + (size_t)rr * 1024, (GAS unsigned*)(ws + (tb ? WS_V8 : WS_U8) + (size_t)rr * 1024), (GAS float*)(ws + (tb ? WS_SV : WS_SU)) + rr, 0, F.lane); }
    { float* btab = (float*)(ws + WS_BTAB); float* lams = (float*)(ws + WS_LAMS); float* spt = (float*)(ws + WS_SP);
      for (int i = gtid; i < 4 * 129; i += gthreads) { const int h = i / 129, n = i % 129; int bu; if (n < 16) bu = n; else { const int lg = 16 + (int)(logf((float)n / 16.f) / logf(8.f) * 16.f); bu = lg < 31 ? lg : 31; }
          btab[i] = a.in[3][bu * 4 + h] * LOG2E; }
      for (int i = gtid; i < L; i += gthreads) { const float* dl = a.in[17] + i * 128; float s1 = 0.f, s2 = 0.f; for (int j = 0; j < 32; ++j) { s1 += dl[j] * dl[32 + j]; s2 += dl[64 + j] * dl[96 + j]; }
          const float li = 0.8f - 0.6f * expf(-0.3f * (float)i); lams[2 * i] = expf(s1) - expf(s2) + li; lams[2 * i + 1] = li; }
      for (int i = gtid; i < L * 512; i += gthreads) spt[i] = log1pf(expf(-a.in[16][i])); }
    for (int l = 0; l < L; ++l) norm_phase((const GAS float*)a.in[1], (const GAS float*)a.in[23] + l * D, (GAS bf16*)(ws + WS_MNB) + (size_t)l * NB * MEM * D, NB * MEM, gw, NGW, F.lane);
}

constexpr int NPL = 16, PH_FINAL = 2 + NPL * L;
__global__ void __launch_bounds__(NWAVES * 64, 2) fwd(Args args) {
    extern __shared__ __attribute__((aligned(16))) unsigned char lds[];
    Frame F;
    F.lds = (LAS unsigned char*)lds; F.MISC = (volatile LAS unsigned*)(F.lds + MISC_OFF);
    F.tid = threadIdx.x; F.lane = F.tid & 63; F.wave = __builtin_amdgcn_readfirstlane(F.tid >> 6); F.G = gridDim.x;
    F.vcu = (F.G % 8 == 0) ? ((int)blockIdx.x % 8) * (F.G / 8) + (int)blockIdx.x / 8 : (int)blockIdx.x;
    unsigned char* ws = args.ws;
    F.ctl = (gu32*)(opq(ws) + WS_CTL);
    for (int u = F.tid; u < (LDS_BYTES - LDSCTL_OFF) / 4; u += NWAVES * 64) ((LAS unsigned*)(F.lds + LDSCTL_OFF))[u] = 0u;
    __syncthreads();
    XcdBarrier bar = xcd_barrier_post((unsigned*)(F.ctl + CW_BAR), F.MISC + 8);
    F.xcc = (int)bar.x;
    if (F.tid == 0) F.MISC[12] = __hip_atomic_fetch_add((unsigned*)(F.ctl + CW_RANK) + 64 * bar.x, 1u, __ATOMIC_RELAXED, __HIP_MEMORY_SCOPE_AGENT);
    __syncthreads();
    F.xrank = __builtin_amdgcn_readfirstlane((int)F.MISC[12]);
    const int lo = args.ph_lo, hi = args.ph_hi;
    const int gw = blockIdx.x * NWAVES + F.wave, NGW = F.G * NWAVES;
#define IN(k) (lo <= (k) && (k) < hi)
#define LANE_ (lane_id_v())
#define TID_ ((opqi(F.wave) << 6) | LANE_)
#define SITE() const int G_ = opqi(F.G), wv_ = opqi(F.wave), vcu_ = opqi(F.vcu), gw_ = opqi(gw), NGW_ = opqi(NGW); (void)G_; (void)wv_; (void)vcu_; (void)gw_; (void)NGW_
#define SEAM(k) do { if (IN(k) && IN((k) + 1)) xcd_barrier(bar, (F.wave == 0 && lane_id_v() == 0) ? 1 : 0); } while (0)
#define GEMM_SITE(EPI, Aptr, lda_, Bptr, ldb_, M_, N_, K_, cperm, ...) do { \
        pg8::Gemm g{opq(Aptr), opq(Bptr), M_, N_, K_, lda_, ldb_}; pg8::StaticOrder So; So.init(M_, N_, opqi(F.G), opqi(cperm)); pg8::EPI E{__VA_ARGS__}; \
        pg8::gemm_phase<pg8::EPI, pg8::StaticOrder, true, true>(F.lds + RING_OFF, g, So, E, opqi(F.wave)); } while (0)
    if (IN(0)) { p0_prologue(F, args); }
    SEAM(0);
    if (IN(1)) {
#pragma unroll 1
        for (int l = 0; l < L; ++l)
            GEMM_SITE(EpiBf16, (const GAS bf16*)(opq(ws) + WS_MNB) + (size_t)l * NB * MEM * D, D, (const GAS bf16*)(opq(ws) + WS_WCKV) + (size_t)l * 2 * D * D, D, NB * MEM, 2 * D, D, (int)((blockIdx.x + 64 * l) % F.G),
                      opq((GAS bf16*)(opq(ws) + WS_KVCB) + (size_t)l * NB * MEM * 2 * D), 2 * D, 2 * D);
    }
    SEAM(1);
    for (int l = 0; l < L; ++l) {
        const int pb = 2 + NPL * l;
        const GAS bf16* XNB = (const GAS bf16*)(opq(ws) + WS_XNB); const GAS bf16* YB = (const GAS bf16*)(opq(ws) + WS_YB); GAS bf16* PROJB = (GAS bf16*)(opq(ws) + WS_PROJB);
        if (IN(pb + 0)) { SITE(); norm_phase((GAS float*)args.out, (const GAS float*)args.in[opqi(4)] + l * D, opq((GAS bf16*)(opq(ws) + WS_XNB)), T, gw_, NGW_, LANE_); }
        SEAM(pb + 0);
        if (IN(pb + 1)) GEMM_SITE(EpiBf16, XNB, D, (const GAS bf16*)(opq(ws) + WS_WIN) + (size_t)l * INP * D, D, T, INP, D, (int)blockIdx.x, opq(PROJB), INP, INP);
        SEAM(pb + 1);
        if (IN(pb + 2)) {
            SITE();
            pre_phase(opq((const GAS bf16*)PROJB), opq((const GAS float*)(opq(ws) + WS_ROPE)), opq((GAS float*)(opq(ws) + WS_RS)), opq((GAS bf16*)(opq(ws) + WS_KMB)), gw_, NGW_, LANE_);
            LruP LP{opq((const GAS bf16*)PROJB), (const GAS float*)args.in[opqi(10)] + l * 4 * 512, (const GAS float*)args.in[opqi(11)] + l * 512, (const GAS float*)args.in[opqi(12)] + (size_t)l * 8 * 4096, (const GAS float*)args.in[opqi(13)] + l * 512, (const GAS float*)args.in[opqi(14)] + (size_t)l * 8 * 4096, (const GAS float*)args.in[opqi(15)] + l * 512,
                    (const GAS float*)(opq(ws) + WS_SP) + l * 512, opq((GAS bf16*)(opq(ws) + WS_HLB)), opq((GAS bf16*)(opq(ws) + WS_ACB)), opq((GAS float*)(opq(ws) + WS_LSUM))};
            lru_phase(LP, F.lds, TID_, wv_, LANE_, vcu_, G_);
#if MK_DUP == 2
            lru_phase(LP, F.lds, TID_, wv_, LANE_, vcu_, G_);
#endif
        }
        SEAM(pb + 2);
        if (IN(pb + 3)) {
            GEMM_SITE(EpiUp, (const GAS bf16*)PROJB + PC_CQ, INP, (const GAS bf16*)(opq(ws) + WS_WUQ) + (size_t)l * 512 * 256, 256, T, 512, 256, (int)blockIdx.x,
                      opq((GAS bf16*)(opq(ws) + WS_QMB)), (GAS bf16*)nullptr, 384, 384, opq((const GAS float*)(opq(ws) + WS_RS)), 0, 0);
            GEMM_SITE(EpiUp, (const GAS bf16*)PROJB + PC_CKV, INP, (const GAS bf16*)(opq(ws) + WS_WUKV) + (size_t)l * 512 * 256, 256, T, 512, 256, (int)blockIdx.x,
                      opq((GAS bf16*)(opq(ws) + WS_KMB)), opq((GAS bf16*)(opq(ws) + WS_VMB)), 0, 512, opq((const GAS float*)(opq(ws) + WS_RS)), 1, 1);
        }
        SEAM(pb + 3);
        if (IN(pb + 4)) {
            SITE();
            AttnP PM{opq((const GAS bf16*)(opq(ws) + WS_QMB)), opq((const GAS bf16*)(opq(ws) + WS_KMB)), opq((const GAS bf16*)(opq(ws) + WS_VMB)), 384, 384, 256, opq((GAS bf16*)(opq(ws) + WS_OMB)), 256, opq((const GAS float*)(opq(ws) + WS_ROPE)), nullptr, nullptr, nullptr, nullptr};
            AttnP PD{opq((const GAS bf16*)PROJB + PC_QD), opq((const GAS bf16*)PROJB + PC_KD), opq((const GAS bf16*)PROJB + PC_VD), INP, INP, INP, opq((GAS bf16*)(opq(ws) + WS_YB) + 768), 1024, nullptr,
                     (const GAS int*)args.in[opqi(2)], (const GAS float*)(opq(ws) + WS_BTAB), (const GAS float*)args.in[opqi(18)] + l * 64, (const GAS float*)(opq(ws) + WS_LAMS) + 2 * l};
            attn_phase(PM, PD, F.lds, TID_, wv_, LANE_, vcu_, G_);
#if MK_DUP == 4
            __syncthreads(); attn_phase(PM, PD, F.lds, TID_, wv_, LANE_, vcu_, G_);
#endif
        }
        SEAM(pb + 4);
        if (IN(pb + 5)) {
            SITE();
            PostP PP{opq((const GAS bf16*)(opq(ws) + WS_OMB)), opq((const GAS bf16*)(opq(ws) + WS_HLB)), opq((const GAS bf16*)(opq(ws) + WS_ACB)), opq((const GAS float*)(opq(ws) + WS_LSUM)), opq((const GAS bf16*)PROJB), (const GAS float*)args.in[opqi(19)] + l * 256, (const GAS float*)args.in[opqi(20)] + l * 512, opq((GAS bf16*)(opq(ws) + WS_YB))};
            post_phase(PP, F.lds, TID_, wv_, LANE_, vcu_, G_);
        }
        SEAM(pb + 5);
        if (IN(pb + 6)) GEMM_SITE(EpiF32, YB, D, (const GAS bf16*)(opq(ws) + WS_WOUT) + (size_t)l * D * D, D, T, D, D, (int)blockIdx.x, opq((GAS float*)args.out), D, D, 1);
        SEAM(pb + 6);
        if (IN(pb + 7)) { SITE(); norm_phase((GAS float*)args.out, (const GAS float*)args.in[opqi(22)] + l * D, opq((GAS bf16*)(opq(ws) + WS_XNB)), T, gw_, NGW_, LANE_); }
        SEAM(pb + 7);
        if (IN(pb + 8)) GEMM_SITE(EpiBf16, XNB, D, (const GAS bf16*)(opq(ws) + WS_WCQ) + (size_t)l * D * D, D, T, D, D, (int)blockIdx.x, opq(PROJB), D, D);
        SEAM(pb + 8);
        if (IN(pb + 9)) {
            SITE();
            const GAS bf16* kv = (const GAS bf16*)(opq(ws) + WS_KVCB) + (size_t)l * NB * MEM * 2 * D;
            AttnP PC{opq((const GAS bf16*)PROJB), opq(kv), opq(kv + D), 1024, 2 * D, 2 * D, opq((GAS bf16*)(opq(ws) + WS_YB)), 1024, nullptr, nullptr, nullptr, nullptr, nullptr};
            cross_phase(PC, F.lds, TID_, wv_, LANE_, vcu_, G_);
#if MK_DUP == 9
            cross_phase(PC, F.lds, TID_, wv_, LANE_, vcu_, G_);
#endif
        }
        SEAM(pb + 9);
        if (IN(pb + 10)) GEMM_SITE(EpiF32, YB, D, (const GAS bf16*)(opq(ws) + WS_WCO) + (size_t)l * D * D, D, T, D, D, (int)blockIdx.x, opq((GAS float*)args.out), D, D, 1);
        SEAM(pb + 10);
        if (IN(pb + 11)) { SITE(); norm_q_phase((GAS float*)args.out, (const GAS float*)args.in[opqi(27)] + l * D, opq((GAS bf16*)(opq(ws) + WS_XNB)), opq((GAS unsigned char*)(opq(ws) + WS_HQ)), opq((GAS float*)(opq(ws) + WS_SH)), opq((GAS int*)(opq(ws) + WS_P)), T, gw_, NGW_, LANE_); }
        SEAM(pb + 11);
        if (IN(pb + 12)) GEMM_SITE(EpiBf16, XNB, D, (const GAS bf16*)(opq(ws) + WS_WPQ) + (size_t)l * D * D, D, T, D, D, (int)blockIdx.x, opq(PROJB), D, D);
        SEAM(pb + 12);
        if (IN(pb + 13)) {
            SITE();
            RouteP RP{opq((const GAS bf16*)PROJB), opq((const GAS bf16*)(opq(ws) + WS_KEYS) + (size_t)l * 2 * 128 * 64), opq((GAS int*)(opq(ws) + WS_EX)), opq((GAS float*)(opq(ws) + WS_GW))};
            route_phase(RP, F.lds, TID_, wv_, LANE_, vcu_, G_);
#if MK_DUP == 13
            route_phase(RP, F.lds, TID_, wv_, LANE_, vcu_, G_);
#endif
        }
        SEAM(pb + 13);
        if (IN(pb + 14)) {
            SITE();
            const PeerS ps = peer_sched((const GAS unsigned*)(F.ctl + CW_RANK), opqi(F.xcc), opqi(F.xrank));
            Peer1P Q1{opq((const GAS unsigned char*)(opq(ws) + WS_HQ)), opq((const GAS int*)(opq(ws) + WS_EX)), opq((const GAS unsigned char*)(opq(ws) + WS_U8) + (size_t)l * 16384 * 1024), opq((GAS int*)(opq(ws) + WS_P))};
            peer_k1(Q1, ps, wv_, LANE_);
#if MK_DUP == 141
            { Peer1P Q1b = Q1; Q1b.P = (GAS int*)(opq(ws) + WS_PROJB); peer_k1(Q1b, ps, wv_, LANE_); }
#endif
        }
        SEAM(pb + 14);
        if (IN(pb + 15)) {
            SITE();
            peer_w(opq((const GAS int*)(opq(ws) + WS_EX)), opq((const GAS float*)(opq(ws) + WS_GW)), opq((const GAS int*)(opq(ws) + WS_P)), opq((const GAS float*)(opq(ws) + WS_SH)), opq((const GAS float*)(opq(ws) + WS_SU) + l * 16384), opq((const GAS float*)(opq(ws) + WS_SV) + l * 16384),
                   opq((GAS signed char*)(opq(ws) + WS_W)), opq((GAS float*)(opq(ws) + WS_WS)), gw_, NGW_, LANE_);
            xcd_barrier(bar, (F.wave == 0 && lane_id_v() == 0) ? 1 : 0);
            const PeerS ps = peer_sched((const GAS unsigned*)(F.ctl + CW_RANK), opqi(F.xcc), opqi(F.xrank));
            Peer2P Q2{opq((const GAS int*)(opq(ws) + WS_EX)), opq((const GAS signed char*)(opq(ws) + WS_W)), opq((const GAS float*)(opq(ws) + WS_WS)), opq((const GAS unsigned char*)(opq(ws) + WS_V8) + (size_t)l * 16384 * 1024), (GAS float*)args.out};
            peer_k2(Q2, ps, wv_, LANE_);
#if MK_DUP == 151
            { Peer2P Q2b = Q2; Q2b.X = (GAS float*)(opq(ws) + WS_PROJB); peer_k2(Q2b, ps, wv_, LANE_); }
#endif
        }
        SEAM(pb + 15);
    }
    if (IN(PH_FINAL)) { SITE(); final_norm_phase((GAS float*)args.out, (const GAS float*)args.in[opqi(32)], T, gw_, NGW_, LANE_); }
#undef IN
#undef SEAM
#undef GEMM_SITE
}
}
extern "C" void kernel_launch(void* const* d_in, const int* in_sizes, int n_in, void* d_out, int out_size, void* d_ws, size_t ws_size, hipStream_t stream) {
    (void)in_sizes; (void)out_size;
    static int grid = 0;
    if (grid == 0) {
        int dev = 0, cus = 0, per_cu = 0;
        if (n_in != 33 || ws_size < mk::WS_END) { fprintf(stderr, "kernel_launch: unexpected n_in %d / ws_size %zu\n", n_in, ws_size); grid = -1; return; }
        if (hipGetDevice(&dev) != hipSuccess || hipDeviceGetAttribute(&cus, hipDeviceAttributeMultiprocessorCount, dev) != hipSuccess) { grid = -1; return; }
        if (hipFuncSetAttribute((const void*)mk::fwd, hipFuncAttributeMaxDynamicSharedMemorySize, mk::LDS_BYTES) != hipSuccess) { fprintf(stderr, "kernel_launch: hipFuncSetAttribute failed\n"); grid = -1; return; }
        if (hipOccupancyMaxActiveBlocksPerMultiprocessor(&per_cu, (const void*)mk::fwd, mk::NWAVES * 64, mk::LDS_BYTES) != hipSuccess || per_cu < 1) fprintf(stderr, "kernel_launch: occupancy query says %d\n", per_cu);
        (void)hipGetLastError();
        grid = cus;
    }
    if (grid < 0) return;
    unsigned char* ws = (unsigned char*)d_ws;
    (void)hipMemsetAsync(ws + mk::WS_CTL, 0, mk::CTL_ZERO_BYTES, stream);
    mk::Args a{};
    for (int i = 0; i < 33; ++i) a.in[i] = (const float*)d_in[i];
    a.out = (float*)d_out; a.ws = ws;
    auto run = [&](int lo, int hi) { a.ph_lo = lo; a.ph_hi = hi; hipLaunchKernelGGL(mk::fwd, dim3(grid), dim3(mk::NWAVES * 64), mk::LDS_BYTES, stream, a); };
#if MK_ONE_LAUNCH
    run(0, mk::PH_FINAL + 1);
#else
    for (int p = 0; p <= mk::PH_FINAL; ++p) {
        const int k = (p - 2) % mk::NPL, l = (p - 2) / mk::NPL;
#if MK_NAIVE_PEER == 2
        if (p >= 2 && p < mk::PH_FINAL && k == 14) {
            hipLaunchKernelGGL(k_peer, dim3(T), dim3(256), 0, stream, (const bf16_t*)(ws + mk::WS_XNB), (const int*)(ws + mk::WS_EX), (const float*)(ws + mk::WS_GW), (const float*)d_in[30] + (size_t)l * NEXP * D, (const float*)d_in[31] + (size_t)l * NEXP * D, (float*)d_out);
            continue; }
#elif MK_NAIVE_PEER == 1
        if (p >= 2 && p < mk::PH_FINAL && k == 13) {
            float* TQ = (float*)(ws + (size_t)806 * mk::MiB);
            hipLaunchKernelGGL(k_bf2f, dim3((unsigned)(((size_t)T * D + 255) / 256)), dim3(256), 0, stream, (const bf16_t*)(ws + mk::WS_PROJB), TQ, (long)T * D);
            hipLaunchKernelGGL(k_route, dim3(T), dim3(256), 0, stream, TQ, (const float*)d_in[29] + (size_t)l * 2 * 128 * 64, (int*)(ws + mk::WS_EX), (float*)(ws + mk::WS_GW));
            hipLaunchKernelGGL(k_peer, dim3(T), dim3(256), 0, stream, (const bf16_t*)(ws + mk::WS_XNB), (const int*)(ws + mk::WS_EX), (const float*)(ws + mk::WS_GW), (const float*)d_in[30] + (size_t)l * NEXP * D, (const float*)d_in[31] + (size_t)l * NEXP * D, (float*)d_out);
            continue; }
        if (p >= 2 && p < mk::PH_FINAL && k == 14) continue;
#endif
        run(p, p + 1); }
#endif
}
```

```cpp
#include <hip/hip_runtime.h>
#include <cstdint>
#include <cstdio>
#include <cmath>

#ifndef MK_ONE_LAUNCH
#define MK_ONE_LAUNCH 1
#endif
#ifndef MK_DUP
#define MK_DUP 0
#endif
#ifndef MK_NAIVE_PEER
#define MK_NAIVE_PEER 0
#endif
namespace pg8 {
#define PG8_LAS __attribute__((address_space(3)))
#ifndef GAS
#define GAS __attribute__((address_space(1)))
#endif
typedef unsigned short bf16_t;
typedef short bf16x8 __attribute__((ext_vector_type(8)));
typedef float f32x4 __attribute__((ext_vector_type(4)));
typedef unsigned u32x4 __attribute__((ext_vector_type(4)));
typedef unsigned u32x2 __attribute__((ext_vector_type(2)));
constexpr int BM = 256, BK = 64, HALF = 128, HTB = HALF * BK * 2, STAGE_BYTES = 8 * HTB, NXCD = 8, WGM = 8;
__host__ __device__ __forceinline__ int lds_byte(int r, int c) { const int st = (r >> 4) * 2 + (c >> 5), rr = r & 15, cc = c & 31, ob = rr * 64 + cc * 2; return st * 1024 + (ob ^ (((ob >> 9) & 1) << 5)); }
__host__ __device__ __forceinline__ void stage_rc(int b, int& R, int& C) { const int st = b / 1024, sb = b % 1024, swz = sb ^ (((sb >> 9) & 1) << 5); R = (st >> 1) * 16 + swz / 64; C = (st & 1) * 32 + (swz % 64) / 2; }
__host__ __device__ __forceinline__ int perm32(int rho) { const int n = rho >> 4, i = rho & 15; return 8 * (i >> 2) + 4 * n + (i & 3); }
__device__ __forceinline__ int pg8_lane_id() { int l; asm volatile("v_mbcnt_lo_u32_b32 %0, -1, 0\n\tv_mbcnt_hi_u32_b32 %0, -1, %0" : "=v"(l)); return l; }
struct Unit { int pm, pn; };
struct Gemm { const GAS bf16_t* A; const GAS bf16_t* Bt; int M, N, K, lda, ldb; };
struct StaticOrder {
    int nM, nN, nwg, G, c;
    __host__ __device__ void init(int M, int N, int G_, int c_) { nM = M / BM; nN = N / BM; nwg = nM * nN; G = G_; c = c_; }
    __host__ __device__ bool next(int i, Unit& u) const {
        const long L = (long)i * G + c; if (L >= nwg) return false;
        int wgid = (int)L; { const int q = nwg / NXCD, r = nwg % NXCD, xcd = wgid % NXCD, off = wgid / NXCD; wgid = (xcd < r ? xcd * (q + 1) : r * (q + 1) + (xcd - r) * q) + off; }
        const int nig = WGM * nN, gid = wgid / nig, fm = gid * WGM, gsz = (nM - fm) < WGM ? (nM - fm) : WGM;
        u.pm = fm + ((wgid % nig) % gsz); u.pn = (wgid % nig) / gsz; return true;
    }
    __device__ __forceinline__ void a_ready(const Unit&) const {}
    __device__ __forceinline__ void done(const Unit&) const {}
};
__device__ __forceinline__ unsigned cvt_pk_bf16(float lo, float hi) { unsigned r; asm volatile("v_cvt_pk_bf16_f32 %0, %1, %2" : "=v"(r) : "v"(lo), "v"(hi)); return r; }

struct EpiF32 {
    static constexpr bool PERM = false, AFTER_DRAIN = false;
    GAS float* C; int ldc; int nvalid; int accum;
    __device__ __forceinline__ void operator()(const f32x4 (&acc)[2][2][4][2], const Unit& u, int wr, int wc, int fr, int fq) const {
        { const int l_ = pg8_lane_id(); fr = l_ & 15; fq = l_ >> 4; }
#pragma unroll
        for (int ai = 0; ai < 2; ++ai)
#pragma unroll
            for (int m = 0; m < 4; ++m) { const size_t row = (size_t)u.pm * BM + ai * HALF + wr * 64 + m * 16 + fr;
#pragma unroll
                for (int bj = 0; bj < 2; ++bj)
#pragma unroll
                    for (int n = 0; n < 2; ++n) { const int col = u.pn * BM + bj * HALF + wc * 32 + n * 16 + 4 * fq;
                        if (col < nvalid) { GAS float* p = C + row * ldc + col; f32x4 v = acc[ai][bj][m][n]; if (accum) v += *(const GAS f32x4*)p; *(GAS f32x4*)p = v; } } }
    }
};
struct EpiBf16 {
    static constexpr bool PERM = true, AFTER_DRAIN = false;
    GAS bf16_t* O; int ldc; int nvalid;
    __device__ __forceinline__ void operator()(const f32x4 (&acc)[2][2][4][2], const Unit& u, int wr, int wc, int fr, int fq) const {
        { const int l_ = pg8_lane_id(); fr = l_ & 15; fq = l_ >> 4; }
#pragma unroll
        for (int ai = 0; ai < 2; ++ai)
#pragma unroll
            for (int m = 0; m < 4; ++m) { const size_t row = (size_t)u.pm * BM + ai * HALF + wr * 64 + m * 16 + fr;
#pragma unroll
                for (int bj = 0; bj < 2; ++bj) { const int col = u.pn * BM + bj * HALF + wc * 32 + 8 * fq;
                    if (col < nvalid) { const f32x4 v0 = acc[ai][bj][m][0], v1 = acc[ai][bj][m][1]; u32x4 w; w.x = cvt_pk_bf16(v0[0], v0[1]); w.y = cvt_pk_bf16(v0[2], v0[3]); w.z = cvt_pk_bf16(v1[0], v1[1]); w.w = cvt_pk_bf16(v1[2], v1[3]);
                        *(GAS u32x4*)(O + row * ldc + col) = w; } } }
    }
};
struct EpiUp {
    static constexpr bool PERM = true, AFTER_DRAIN = false;
    GAS bf16_t* O; GAS bf16_t* O2; int ldc; int nvalid; const GAS float* rs; int rsi; int mode;
    __device__ __forceinline__ void operator()(const f32x4 (&acc)[2][2][4][2], const Unit& u, int wr, int wc, int fr, int fq) const {
        { const int l_ = pg8_lane_id(); fr = l_ & 15; fq = l_ >> 4; }
#pragma unroll
        for (int ai = 0; ai < 2; ++ai)
#pragma unroll
            for (int m = 0; m < 4; ++m) { const size_t row = (size_t)u.pm * BM + ai * HALF + wr * 64 + m * 16 + fr; const float s = rs[2 * row + rsi];
#pragma unroll
                for (int bj = 0; bj < 2; ++bj) { const int col = u.pn * BM + bj * HALF + wc * 32 + 8 * fq;
                    if (col < nvalid) { const f32x4 v0 = acc[ai][bj][m][0] * s, v1 = acc[ai][bj][m][1] * s; u32x4 w; w.x = cvt_pk_bf16(v0[0], v0[1]); w.y = cvt_pk_bf16(v0[2], v0[3]); w.z = cvt_pk_bf16(v1[0], v1[1]); w.w = cvt_pk_bf16(v1[2], v1[3]);
                        GAS bf16_t* dst;
                        if (mode == 0) dst = O + row * ldc + col;
                        else { const int h = col >> 7, j = col & 127; dst = (j < 64) ? O + row * 384 + h * 96 + j : O2 + row * 256 + h * 64 + (j - 64); }
                        *(GAS u32x4*)dst = w; } } }
    }
};
template <class Epi, class Sched, bool ALIGN_EPI = false, bool SP2 = false>
__device__ __forceinline__ void gemm_phase(PG8_LAS unsigned char* lds, const Gemm g, const Sched& S, const Epi& E, int wave_id) {
    int tid_ = (wave_id << 6) | pg8_lane_id(); asm volatile("" : "+v"(tid_));
    const int tid = tid_, wid = __builtin_amdgcn_readfirstlane(tid >> 6), lane = tid & 63, wr = wid >> 2, wc = wid & 3, fr = lane & 15, fq = lane >> 4;
    const int K = g.K, nt = K / BK;
    unsigned voffA[2], voffB[2];
#pragma unroll
    for (int i = 0; i < 2; ++i) { int R, C; stage_rc(tid * 16 + i * 8192, R, C); const int Rb = Epi::PERM ? ((R & ~31) + perm32(R & 31)) : R;
        voffA[i] = (unsigned)(R * g.lda + C) * 2u; voffB[i] = (unsigned)(Rb * g.ldb + C) * 2u; }
    const size_t kstep = (size_t)(BK * 2);
    const size_t hstepA = (size_t)HALF * g.lda * 2, hstepB = (size_t)HALF * g.ldb * 2;
    const size_t tstepA = 2 * hstepA, tstepB = 2 * hstepB;
    const unsigned ldsw = (unsigned)wid * 1024u;
    const int aoff = lds_byte(wr * 64 + fr, fq * 8), boff = lds_byte(wc * 32 + fr, fq * 8);
#define PG8_SA(b, h) (((b) * 2 + (h)) * HTB)
#define PG8_SB(b, h) ((4 + (b) * 2 + (h)) * HTB)
#define PG8_STAGE(bufoff, gbase, voff) do { _Pragma("unroll") for (int _i = 0; _i < 2; ++_i) \
        __builtin_amdgcn_global_load_lds((const unsigned*)((const char*)(gbase) + (voff)[_i]), (PG8_LAS unsigned*)(lds + (bufoff) + ldsw + _i * 8192), 16, 0, 0); } while (0)
#define PG8_LDA(dst, b, h) do { _Pragma("unroll") for (int m = 0; m < 4; ++m) _Pragma("unroll") for (int k = 0; k < 2; ++k) dst[m][k] = *(const PG8_LAS bf16x8*)(lds + PG8_SA(b, h) + aoff + m * 2048 + k * 1024); } while (0)
#define PG8_LDB(dst, b, h) do { _Pragma("unroll") for (int n = 0; n < 2; ++n) _Pragma("unroll") for (int k = 0; k < 2; ++k) dst[n][k] = *(const PG8_LAS bf16x8*)(lds + PG8_SB(b, h) + boff + n * 2048 + k * 1024); } while (0)
#define PG8_MMA(ai, bj, At, Bt) do { __builtin_amdgcn_s_setprio(1); _Pragma("unroll") for (int m = 0; m < 4; ++m) _Pragma("unroll") for (int n = 0; n < 2; ++n) _Pragma("unroll") for (int k = 0; k < 2; ++k) \
        acc[ai][bj][m][n] = __builtin_amdgcn_mfma_f32_16x16x32_bf16(Bt[n][k], At[m][k], acc[ai][bj][m][n], 0, 0, 0); __builtin_amdgcn_s_setprio(0); } while (0)
#define PG8_WAIT_V(n) asm volatile("s_waitcnt vmcnt(" #n ")" ::: "memory")
#define PG8_WAIT_L(n) asm volatile("s_waitcnt lgkmcnt(" #n ")" ::: "memory")
#define PG8_BAR __builtin_amdgcn_s_barrier()
#define PG8_SCHED __builtin_amdgcn_sched_barrier(0)
    Unit cur, nxt; int ui = 0;
    if (!S.next(0, cur)) return;
    f32x4 acc[2][2][4][2];
#pragma unroll
    for (int a = 0; a < 2; ++a)
#pragma unroll
        for (int b = 0; b < 2; ++b)
#pragma unroll
            for (int m = 0; m < 4; ++m)
#pragma unroll
                for (int n = 0; n < 2; ++n) acc[a][b][m][n] = (f32x4){0.f, 0.f, 0.f, 0.f};
    bf16x8 At[4][2], B0[2][2], B1[2][2];
    const char* cA = (const char*)g.A + (size_t)cur.pm * tstepA; const char* cB = (const char*)g.Bt + (size_t)cur.pn * tstepB;
    S.a_ready(cur);
    if constexpr (SP2) {
        PG8_STAGE(PG8_SB(0, 0), cB, voffB); PG8_STAGE(PG8_SB(0, 1), cB + hstepB, voffB); PG8_STAGE(PG8_SA(0, 0), cA, voffA); PG8_STAGE(PG8_SA(0, 1), cA + hstepA, voffA);
        if (wr == 1) PG8_BAR;
        PG8_WAIT_V(2); PG8_BAR;
        PG8_STAGE(PG8_SB(1, 0), cB + kstep, voffB); PG8_STAGE(PG8_SA(1, 0), cA + kstep, voffA); PG8_STAGE(PG8_SB(1, 1), cB + hstepB + kstep, voffB);
        PG8_WAIT_V(6); PG8_BAR;
    } else {
        PG8_STAGE(PG8_SB(0, 0), cB, voffB); PG8_STAGE(PG8_SA(0, 0), cA, voffA); PG8_STAGE(PG8_SB(0, 1), cB + hstepB, voffB); PG8_STAGE(PG8_SA(0, 1), cA + hstepA, voffA);
        if (wr == 1) PG8_BAR;
        PG8_WAIT_V(4); PG8_BAR;
        PG8_STAGE(PG8_SB(1, 0), cB + kstep, voffB); PG8_STAGE(PG8_SA(1, 0), cA + kstep, voffA); PG8_STAGE(PG8_SB(1, 1), cB + hstepB + kstep, voffB);
        PG8_WAIT_V(6); PG8_BAR;
    }
    for (;;) {
        const bool has_next = S.next(ui + 1, nxt);
        const char* nA = has_next ? (const char*)g.A + (size_t)nxt.pm * tstepA : cA; const char* nB = has_next ? (const char*)g.Bt + (size_t)nxt.pn * tstepB : cB;
        for (int t = 0; t < nt; t += 2) {
            const bool last = (t == nt - 2);
            const char* a1 = cA + (size_t)(t + 1) * kstep;
            const char* a2 = last ? nA : cA + (size_t)(t + 2) * kstep; const char* b2 = last ? nB : cB + (size_t)(t + 2) * kstep;
            const char* a3 = a2 + kstep; const char* b3 = b2 + kstep;
            if (last && has_next) S.a_ready(nxt);
            if constexpr (SP2) {
            PG8_LDB(B0, 0, 0); PG8_LDB(B1, 0, 1); PG8_SCHED; PG8_LDA(At, 0, 0); PG8_STAGE(PG8_SA(1, 1), a1 + hstepA, voffA);
            PG8_WAIT_V(8); PG8_WAIT_L(0); PG8_BAR; PG8_MMA(0, 0, At, B0); PG8_MMA(0, 1, At, B1); PG8_BAR; PG8_SCHED;
            PG8_LDA(At, 0, 1); PG8_STAGE(PG8_SB(0, 0), b2, voffB); PG8_STAGE(PG8_SB(0, 1), b2 + hstepB, voffB); PG8_STAGE(PG8_SA(0, 0), a2, voffA);
            PG8_WAIT_V(8); PG8_WAIT_L(0); PG8_BAR; PG8_MMA(1, 0, At, B0); PG8_MMA(1, 1, At, B1); PG8_BAR; PG8_SCHED;
            PG8_LDB(B0, 1, 0); PG8_LDB(B1, 1, 1); PG8_SCHED; PG8_LDA(At, 1, 0); PG8_STAGE(PG8_SA(0, 1), a2 + hstepA, voffA);
            PG8_WAIT_V(8); PG8_WAIT_L(0); PG8_BAR; PG8_MMA(0, 0, At, B0); PG8_MMA(0, 1, At, B1); PG8_BAR; PG8_SCHED;
            PG8_LDA(At, 1, 1); PG8_STAGE(PG8_SB(1, 0), b3, voffB); PG8_STAGE(PG8_SB(1, 1), b3 + hstepB, voffB); PG8_STAGE(PG8_SA(1, 0), a3, voffA);
            PG8_WAIT_V(8); PG8_WAIT_L(0); PG8_BAR; PG8_MMA(1, 0, At, B0); PG8_MMA(1, 1, At, B1); PG8_BAR; PG8_SCHED;
            } else {
            PG8_LDB(B0, 0, 0); PG8_SCHED; PG8_LDA(At, 0, 0); PG8_STAGE(PG8_SA(1, 1), a1 + hstepA, voffA);
            PG8_WAIT_L(8); PG8_BAR; PG8_WAIT_L(0); PG8_MMA(0, 0, At, B0); PG8_BAR; PG8_SCHED;
            PG8_LDB(B1, 0, 1); PG8_STAGE(PG8_SB(0, 0), b2, voffB);
            PG8_BAR; PG8_WAIT_L(0); PG8_MMA(0, 1, At, B1); PG8_BAR;
            PG8_LDA(At, 0, 1); PG8_STAGE(PG8_SA(0, 0), a2, voffA);
            PG8_BAR; PG8_WAIT_L(0); PG8_MMA(1, 0, At, B0); PG8_BAR; PG8_SCHED;
            PG8_STAGE(PG8_SB(0, 1), b2 + hstepB, voffB);
            PG8_WAIT_V(6); PG8_BAR; PG8_MMA(1, 1, At, B1); PG8_BAR;
            PG8_LDB(B0, 1, 0); PG8_SCHED; PG8_LDA(At, 1, 0); PG8_STAGE(PG8_SA(0, 1), a2 + hstepA, voffA);
            PG8_WAIT_L(8); PG8_BAR; PG8_WAIT_L(0); PG8_MMA(0, 0, At, B0); PG8_BAR; PG8_SCHED;
            PG8_LDB(B1, 1, 1); PG8_STAGE(PG8_SB(1, 0), b3, voffB);
            PG8_BAR; PG8_WAIT_L(0); PG8_MMA(0, 1, At, B1); PG8_BAR;
            PG8_LDA(At, 1, 1); PG8_STAGE(PG8_SA(1, 0), a3, voffA);
            PG8_BAR; PG8_WAIT_L(0); PG8_MMA(1, 0, At, B0); PG8_BAR; PG8_SCHED;
            PG8_STAGE(PG8_SB(1, 1), b3 + hstepB, voffB);
            PG8_WAIT_V(6); PG8_BAR; PG8_MMA(1, 1, At, B1); PG8_BAR;
            }
        }
        if constexpr (ALIGN_EPI) { if (wr == 0) PG8_BAR; }
        if constexpr (!Epi::AFTER_DRAIN) { E(acc, cur, wr, wc, fr, fq); S.done(cur); }
        if (!has_next) break;
#pragma unroll
        for (int a = 0; a < 2; ++a)
#pragma unroll
            for (int b = 0; b < 2; ++b)
#pragma unroll
                for (int m = 0; m < 4; ++m)
#pragma unroll
                    for (int n = 0; n < 2; ++n) acc[a][b][m][n] = (f32x4){0.f, 0.f, 0.f, 0.f};
        cur = nxt; cA = nA; cB = nB; ++ui;
        if constexpr (ALIGN_EPI) { if (wr == 1) PG8_BAR; }
    }
    PG8_WAIT_V(0);
    if constexpr (!ALIGN_EPI) { if (wr == 0) PG8_BAR; }
    PG8_BAR;
    if constexpr (Epi::AFTER_DRAIN) { E.fused(acc, cur, wr, wc, fr, fq, lds, wid, lane); S.done(cur); }
#undef PG8_SA
#undef PG8_SB
#undef PG8_STAGE
#undef PG8_LDA
#undef PG8_LDB
#undef PG8_MMA
#undef PG8_WAIT_V
#undef PG8_WAIT_L
#undef PG8_BAR
#undef PG8_SCHED
}
}

namespace mk {
#ifndef GAS
#define GAS __attribute__((address_space(1)))
#endif
#define LAS __attribute__((address_space(3)))
typedef unsigned short bf16;
typedef unsigned v4u __attribute__((ext_vector_type(4)));
typedef unsigned v2u __attribute__((ext_vector_type(2)));
typedef float f32x4 __attribute__((ext_vector_type(4)));
typedef GAS unsigned gu32;
#define LDS_WAIT() asm volatile("s_waitcnt lgkmcnt(0)" ::: "memory")
#define VM_WAIT() asm volatile("s_waitcnt vmcnt(0)" ::: "memory")
__device__ __forceinline__ unsigned f2bf_(float f) { unsigned u = __builtin_bit_cast(unsigned, f); return (u + 0x7fffu + ((u >> 16) & 1u)) >> 16; }
__device__ __forceinline__ unsigned pk2(float lo, float hi) { return f2bf_(lo) | (f2bf_(hi) << 16); }
__device__ __forceinline__ float bflo(unsigned w) { return __builtin_bit_cast(float, w << 16); }
__device__ __forceinline__ float bfhi(unsigned w) { return __builtin_bit_cast(float, w & 0xffff0000u); }

template <class P> __device__ __forceinline__ P* opq(P* p) { asm volatile("" : "+s"(p)); return p; }
__device__ __forceinline__ int opqi(int k) { asm volatile("" : "+s"(k)); return k; }
__device__ __forceinline__ float shx(float v, int o, int lane) { return __builtin_bit_cast(float, __builtin_amdgcn_ds_bpermute((lane ^ o) << 2, __builtin_bit_cast(int, v))); }
__device__ __forceinline__ int shxi(int v, int o, int lane) { return __builtin_amdgcn_ds_bpermute((lane ^ o) << 2, v); }
__device__ __forceinline__ int lane_id_v() { int l; asm volatile("v_mbcnt_lo_u32_b32 %0, -1, 0\n\tv_mbcnt_hi_u32_b32 %0, -1, %0" : "=v"(l)); return l; }
constexpr int NWAVES = 8;
constexpr int D = 1024, NB = 4, S = 8192, T = NB * S, L = 4, MEM = 256, INW = 2144, INP = 2304;
constexpr int PC_CQ = 0, PC_CKV = 256, PC_KR = 384, PC_XL = 512, PC_GL = 1024, PC_QD = 1536, PC_KD = 1792, PC_VD = 2048;
constexpr float LOG2E = 1.4426950408889634f;
constexpr size_t MiB = 1u << 20;
constexpr size_t WS_CTL = 0, CTL_ZERO_BYTES = 1 * MiB;
constexpr size_t WS_WIN = 1 * MiB, WS_WOUT = 19 * MiB, WS_WCQ = 27 * MiB, WS_WCO = 35 * MiB, WS_WPQ = 43 * MiB, WS_WCKV = 51 * MiB, WS_WUQ = 67 * MiB, WS_WUKV = 68 * MiB, WS_KEYS = 69 * MiB, WS_ROPE = 70 * MiB;
constexpr size_t WS_XNB = 76 * MiB, WS_YB = 140 * MiB, WS_PROJB = 204 * MiB, WS_QMB = 348 * MiB, WS_KMB = 372 * MiB, WS_VMB = 396 * MiB, WS_RS = 412 * MiB;
constexpr size_t WS_HLB = 413 * MiB, WS_ACB = 445 * MiB, WS_LSUM = 477 * MiB, WS_OMB = 478 * MiB, WS_MNB = 494 * MiB, WS_KVCB = 502 * MiB, WS_EX = 518 * MiB, WS_GW = 534 * MiB;
constexpr size_t WS_U8 = 550 * MiB, WS_V8 = 614 * MiB, WS_SU = 678 * MiB, WS_SV = 679 * MiB;
constexpr size_t WS_HQ = 680 * MiB, WS_P = 712 * MiB, WS_SH = 728 * MiB, WS_W = 729 * MiB, WS_WS = 745 * MiB, WS_END = 746 * MiB;
constexpr size_t WS_BTAB = WS_KEYS + 512 * 1024, WS_LAMS = WS_BTAB + 4096, WS_SP = WS_LAMS + 4096;
constexpr int CW_BAR = 4096, CW_RANK = 8192;
constexpr int RING_OFF = 0, RING_BYTES = 155648, LDSCTL_OFF = RING_BYTES, MISC_OFF = LDSCTL_OFF + 320, LDS_BYTES = 163840;

#define XB_TMO      128
#define XB_XCNT(j)  (256  + 64 * (j))
#define XB_XSUB(j)  (1280 + 64 * (j))
#define XB_XGEN(j)  (2304 + 64 * (j))
#define XB_TOP      3328
#define XB_TOPGEN   3392
#define XCD_BAR_WORDS 3456
#define XB_SPIN_CAP (1u << 18)

__device__ __forceinline__ unsigned xb_ld(unsigned* p)              { return __hip_atomic_load(p, __ATOMIC_RELAXED, __HIP_MEMORY_SCOPE_AGENT); }
__device__ __forceinline__ unsigned xb_add(unsigned* p, unsigned v) { return __hip_atomic_fetch_add(p, v, __ATOMIC_RELAXED, __HIP_MEMORY_SCOPE_AGENT); }
__device__ __forceinline__ unsigned xb_xcc_id() { return (unsigned)__builtin_amdgcn_s_getreg((3 << 11) | 20) & 0xFu; }
#define XB_SPIN(cond, bar) do { unsigned _sp = 0; while (cond) { __builtin_amdgcn_s_sleep(1); \
    if ((++_sp & 255u) == 0u) { if (xb_ld(&(bar)[XB_TMO])) break; if (_sp > XB_SPIN_CAP) { atomicAdd(&(bar)[XB_TMO], 1u); break; } } } } while (0)

struct XcdBarrier {
    unsigned* bar; unsigned x;
    volatile LAS unsigned* st;
};

__device__ __forceinline__ XcdBarrier xcd_barrier_post(unsigned* bar, volatile LAS unsigned* st) {
    XcdBarrier b; b.bar = bar; b.x = xb_xcc_id(); b.st = st;
    if (threadIdx.x == 0) (void)xb_add(&bar[XB_XCNT(b.x)], 1u);
    return b;
}
__device__ __forceinline__ void xcd_barrier_complete(unsigned* bar, unsigned x, unsigned& nloc, unsigned& nx) {
    const unsigned G = gridDim.x * gridDim.y * gridDim.z;
    unsigned sum, cnt, mine, sp = 0u;
    for (;;) {
        sum = 0u; cnt = 0u; mine = 0u;
#pragma unroll
        for (unsigned j = 0; j < 16; ++j) { const unsigned c = xb_ld(&bar[XB_XCNT(j)]); sum += c; cnt += (c > 0u) ? 1u : 0u; mine = (j == x) ? c : mine; }
        if (sum == G) break;
        __builtin_amdgcn_s_sleep(1);
        if ((++sp & 255u) == 0u) { if (xb_ld(&bar[XB_TMO])) break; if (sp > XB_SPIN_CAP) { atomicAdd(&bar[XB_TMO], 1u); break; } }
    }
    nloc = mine > 0u ? mine : 1u; nx = cnt > 0u ? cnt : 1u;
}

__device__ __noinline__ void xcd_barrier_impl(unsigned* bar_, unsigned x_, volatile LAS unsigned* st_, int leader_) {
    XcdBarrier b; b.bar = bar_; b.x = x_; b.st = st_;
    asm volatile("s_waitcnt vmcnt(0)" ::: "memory");
    __syncthreads();
    if (leader_) {
        unsigned* bar = b.bar;
        __builtin_amdgcn_s_waitcnt(0);
        unsigned nloc = b.st[0], nx = b.st[1];
        if (nloc == 0u) { xcd_barrier_complete(bar, b.x, nloc, nx); b.st[0] = nloc; b.st[1] = nx; }
        const unsigned old = xb_add(&bar[XB_XSUB(b.x)], 1u);
        const unsigned gen = old / nloc;
        if (old + 1u == (gen + 1u) * nloc) {
            __builtin_amdgcn_fence(__ATOMIC_RELEASE, "agent");
            asm volatile("s_waitcnt vmcnt(0)" ::: "memory");
            const unsigned og = xb_add(&bar[XB_TOP], 1u);
            const unsigned tg = og / nx;
            if (og + 1u == (tg + 1u) * nx) xb_add(&bar[XB_TOPGEN], 1u);
            else XB_SPIN(xb_ld(&bar[XB_TOPGEN]) == tg, bar);
            __builtin_amdgcn_fence(__ATOMIC_ACQUIRE, "agent");
            xb_add(&bar[XB_XGEN(b.x)], 1u);
            asm volatile("s_waitcnt vmcnt(0)" ::: "memory");
        } else {
            XB_SPIN(xb_ld(&bar[XB_XGEN(b.x)]) == gen, bar);
            __builtin_amdgcn_fence(__ATOMIC_ACQUIRE, "agent");
            asm volatile("s_waitcnt vmcnt(0)" ::: "memory");
        }
    }
    __syncthreads();
}
__device__ __forceinline__ void xcd_barrier(const XcdBarrier& b, int leader) { xcd_barrier_impl(b.bar, b.x, b.st, leader); }


__device__ __forceinline__ float wave_sum(float v, int lane) {
#pragma unroll
    for (int o = 1; o < 64; o <<= 1) v += shx(v, o, lane);
    return v;
}
__device__ __forceinline__ float gelu_erf(float v) {
    const float av = __builtin_fabsf(v), t = __builtin_amdgcn_rcpf(av * 0.2316418882f + 1.0f);
    float q = t * 0.5307027145f + (-0.7265760135f); q = q * t + 0.7107068705f; q = q * t + (-0.142248368f); q = q * t + 0.127414796f; q = q * t;
    const float e = __builtin_amdgcn_exp2f((v * v) * (-0.72134752044f));
    const float m = v * (q * e);
    return v < 0.f ? m : v - m;
}

__device__ __forceinline__ void norm_phase(const GAS float* X, const GAS float* g, GAS bf16* out, int rows, int gw, int NGW, int lane) {
    asm volatile("" : "+v"(lane));
    f32x4 gv[4];
#pragma unroll
    for (int j = 0; j < 4; ++j) gv[j] = ((const GAS f32x4*)g)[lane + 64 * j];
    for (int m = gw; m < rows; m += NGW) {
        const GAS f32x4* xr = (const GAS f32x4*)(X + (size_t)m * D) + lane;
        f32x4 v[4]; float s = 0.f;
#pragma unroll
        for (int j = 0; j < 4; ++j) { v[j] = xr[64 * j]; s += (v[j].x * v[j].x + v[j].y * v[j].y) + (v[j].z * v[j].z + v[j].w * v[j].w); }
        const float rs = rsqrtf(wave_sum(s, lane) * (1.f / D) + 1e-6f);
        GAS v2u* o8 = (GAS v2u*)(out + (size_t)m * D) + lane;
#pragma unroll
        for (int j = 0; j < 4; ++j) { v2u w; w.x = pk2(v[j].x * rs * gv[j].x, v[j].y * rs * gv[j].y); w.y = pk2(v[j].z * rs * gv[j].z, v[j].w * rs * gv[j].w); o8[64 * j] = w; }
    }
}
__device__ __forceinline__ void norm_q_phase(const GAS float* X, const GAS float* g, GAS bf16* out, GAS unsigned GAS char* HQ, GAS float* SH, GAS int* Pz, int rows, int gw, int NGW, int lane) {
    asm volatile("" : "+v"(lane));
    f32x4 gv[4];
#pragma unroll
    for (int j = 0; j < 4; ++j) gv[j] = ((const GAS f32x4*)g)[lane + 64 * j];
    for (int m = gw; m < rows; m += NGW) {
        const GAS f32x4* xr = (const GAS f32x4*)(X + (size_t)m * D) + lane;
        f32x4 v[4]; float s = 0.f;
#pragma unroll
        for (int j = 0; j < 4; ++j) { v[j] = xr[64 * j]; s += (v[j].x * v[j].x + v[j].y * v[j].y) + (v[j].z * v[j].z + v[j].w * v[j].w); }
        const float rs = rsqrtf(wave_sum(s, lane) * (1.f / D) + 1e-6f);
        float mx = 0.f;
#pragma unroll
        for (int j = 0; j < 4; ++j) { v[j] = v[j] * rs * gv[j]; mx = fmaxf(mx, fmaxf(fmaxf(__builtin_fabsf(v[j].x), __builtin_fabsf(v[j].y)), fmaxf(__builtin_fabsf(v[j].z), __builtin_fabsf(v[j].w)))); }
#pragma unroll
        for (int o = 1; o < 64; o <<= 1) mx = fmaxf(mx, shx(mx, o, lane));
        const float inv = mx > 0.f ? 127.f / mx : 0.f;
        GAS v2u* o8 = (GAS v2u*)(out + (size_t)m * D) + lane; GAS unsigned* q4p = (GAS unsigned*)(HQ + (size_t)m * D) + lane;
#pragma unroll
        for (int j = 0; j < 4; ++j) { v2u w; w.x = pk2(v[j].x, v[j].y); w.y = pk2(v[j].z, v[j].w); o8[64 * j] = w;
            const int ia = (int)__builtin_rintf(v[j].x * inv), ib = (int)__builtin_rintf(v[j].y * inv), ic = (int)__builtin_rintf(v[j].z * inv), id = (int)__builtin_rintf(v[j].w * inv);
            q4p[64 * j] = (unsigned)(ia & 255) | ((unsigned)(ib & 255) << 8) | ((unsigned)(ic & 255) << 16) | ((unsigned)(id & 255) << 24); }
        if (lane == 0) SH[m] = mx * (1.f / 127.f);
        ((GAS int*)(Pz + (size_t)m * 128))[lane] = 0; ((GAS int*)(Pz + (size_t)m * 128))[lane + 64] = 0;
    }
}
__device__ __forceinline__ void final_norm_phase(GAS float* X, const GAS float* g, int rows, int gw, int NGW, int lane) {
    asm volatile("" : "+v"(lane));
    for (int m = gw; m < rows; m += NGW) {
        GAS f32x4* xr = (GAS f32x4*)(X + (size_t)m * D) + lane;
        f32x4 v[4]; float s = 0.f;
#pragma unroll
        for (int j = 0; j < 4; ++j) { v[j] = xr[64 * j]; s += (v[j].x * v[j].x + v[j].y * v[j].y) + (v[j].z * v[j].z + v[j].w * v[j].w); }
        const float rs = rsqrtf(wave_sum(s, lane) * (1.f / D) + 1e-6f);
#pragma unroll
        for (int j = 0; j < 4; ++j) { const f32x4 gj = ((const GAS f32x4*)g)[lane + 64 * j]; xr[64 * j] = v[j] * rs * gj; }
    }
}

__device__ __forceinline__ void pre_phase(const GAS bf16* PROJB, const GAS float* ROPE, GAS float* RS, GAS bf16* KMB, int gw, int NGW, int lane) {
    asm volatile("" : "+v"(lane));
    for (int t = gw; t < T; t += NGW) {
        const GAS bf16* pr = PROJB + (size_t)t * INP;
        float sq = 0.f, skv = 0.f;
        if (lane < 24) { const v4u w = *(const GAS v4u*)(pr + PC_CQ + 8 * lane);
            const float a0 = bflo(w.x), a1 = bfhi(w.x), a2 = bflo(w.y), a3 = bfhi(w.y), a4 = bflo(w.z), a5 = bfhi(w.z), a6 = bflo(w.w), a7 = bfhi(w.w);
            sq = (a0 * a0 + a1 * a1) + (a2 * a2 + a3 * a3) + (a4 * a4 + a5 * a5) + (a6 * a6 + a7 * a7); }
        else if (lane >= 32 && lane < 48) { const v4u w = *(const GAS v4u*)(pr + PC_CKV + 8 * (lane - 32));
            const float a0 = bflo(w.x), a1 = bfhi(w.x), a2 = bflo(w.y), a3 = bfhi(w.y), a4 = bflo(w.z), a5 = bfhi(w.z), a6 = bflo(w.w), a7 = bfhi(w.w);
            skv = (a0 * a0 + a1 * a1) + (a2 * a2 + a3 * a3) + (a4 * a4 + a5 * a5) + (a6 * a6 + a7 * a7); }
        sq = wave_sum(sq, lane); skv = wave_sum(skv, lane);
        if (lane == 0) { RS[2 * (size_t)t] = rsqrtf(sq * (1.f / 192.f) + 1e-6f); RS[2 * (size_t)t + 1] = rsqrtf(skv * (1.f / 128.f) + 1e-6f); }
        if (lane < 16) {
            const float x1 = __builtin_bit_cast(float, (unsigned)pr[PC_KR + lane] << 16), x2 = __builtin_bit_cast(float, (unsigned)pr[PC_KR + 16 + lane] << 16);
            const float c = ROPE[(size_t)t * 32 + lane], sn = ROPE[(size_t)t * 32 + 16 + lane];
            const bf16 y1 = (bf16)f2bf_(x1 * c - x2 * sn), y2 = (bf16)f2bf_(x1 * sn + x2 * c);
            GAS bf16* kr = KMB + (size_t)t * 384 + 64 + lane;
#pragma unroll
            for (int h = 0; h < 4; ++h) { kr[h * 96] = y1; kr[h * 96 + 16] = y2; }
        }
    }
}

struct LruP { const GAS bf16* PROJB; const GAS float* cw; const GAS float* cb; const GAS float* wa; const GAS float* ba; const GAS float* wx; const GAS float* bx; const GAS float* sp; GAS bf16* HL; GAS bf16* AC; GAS float* LSUM; };
constexpr int LR_XP = 260;
constexpr int LR_XC = 0, LR_WA = 64 * LR_XP * 4, LR_WX = LR_WA + 16384, LR_SUM = LR_WX + 16384, LR_END = LR_SUM + 4096;
__device__ __forceinline__ void lru_phase(const LruP& P, LAS unsigned char* lds, int tid, int wave, int lane, int vcu, int G) {
    asm volatile("" : "+v"(tid), "+v"(lane));
    LAS float* xc = (LAS float*)(lds + LR_XC); LAS float* WA = (LAS float*)(lds + LR_WA); LAS float* WX = (LAS float*)(lds + LR_WX); LAS float* SUM = (LAS float*)(lds + LR_SUM);
    for (int u = vcu; u < (T / 256) * 8; u += G) {
        const int tile = u >> 3, g = u & 7; const int t0 = tile * 256; const bool first = ((tile & 31) == 0);
        __syncthreads();
#pragma unroll
        for (int i = 0; i < 2; ++i) { const int idx = tid + 512 * i; ((LAS f32x4*)WA)[idx] = ((const GAS f32x4*)(P.wa + g * 4096))[idx]; ((LAS f32x4*)WX)[idx] = ((const GAS f32x4*)(P.wx + g * 4096))[idx]; }
#pragma unroll 1
        for (int it = tid; it < 2048; it += 512) {
            const int time = it & 255, cg = it >> 8; const int ch0 = 64 * g + 8 * cg;
            float y[8];
            { const f32x4 b0 = *(const GAS f32x4*)(P.cb + ch0), b1 = *(const GAS f32x4*)(P.cb + ch0 + 4); y[0] = b0.x; y[1] = b0.y; y[2] = b0.z; y[3] = b0.w; y[4] = b1.x; y[5] = b1.y; y[6] = b1.z; y[7] = b1.w; }
#pragma unroll
            for (int k = 0; k < 4; ++k) {
                if (!(first && time - 3 + k < 0)) {
                    const v4u w = *(const GAS v4u*)(P.PROJB + (size_t)(t0 + time - 3 + k) * INP + PC_XL + ch0);
                    const f32x4 c0 = *(const GAS f32x4*)(P.cw + k * 512 + ch0), c1 = *(const GAS f32x4*)(P.cw + k * 512 + ch0 + 4);
                    y[0] += bflo(w.x) * c0.x; y[1] += bfhi(w.x) * c0.y; y[2] += bflo(w.y) * c0.z; y[3] += bfhi(w.y) * c0.w;
                    y[4] += bflo(w.z) * c1.x; y[5] += bfhi(w.z) * c1.y; y[6] += bflo(w.w) * c1.z; y[7] += bfhi(w.w) * c1.w;
                }
            }
#pragma unroll
            for (int e = 0; e < 8; ++e) xc[(8 * cg + e) * LR_XP + time] = y[e];
        }
        __syncthreads();
        float aa[32], ax[32];
        { const float b_a = P.ba[64 * g + lane], b_x = P.bx[64 * g + lane];
#pragma unroll
          for (int j = 0; j < 32; ++j) { aa[j] = b_a; ax[j] = b_x; } }
#pragma unroll 2
        for (int ci = 0; ci < 64; ++ci) {
            const float wa_ = WA[ci * 64 + lane], wx_ = WX[ci * 64 + lane];
            const LAS f32x4* xr = (const LAS f32x4*)(xc + ci * LR_XP + 32 * wave);
#pragma unroll
            for (int q = 0; q < 8; ++q) { const f32x4 xv = xr[q];
                aa[4 * q] += xv.x * wa_; aa[4 * q + 1] += xv.y * wa_; aa[4 * q + 2] += xv.z * wa_; aa[4 * q + 3] += xv.w * wa_;
                ax[4 * q] += xv.x * wx_; ax[4 * q + 1] += xv.y * wx_; ax[4 * q + 2] += xv.z * wx_; ax[4 * q + 3] += xv.w * wx_; }
        }
        { const float sp = P.sp[64 * g + lane];
          const LAS f32x4* xo = (const LAS f32x4*)(xc + lane * LR_XP + 32 * wave);
          float hrun = 0.f, arun = 1.f;
#pragma unroll
          for (int q = 0; q < 8; ++q) { const f32x4 xv = xo[q];
#pragma unroll
              for (int e = 0; e < 4; ++e) { const int j = 4 * q + e;
                  const float r = __builtin_amdgcn_rcpf(1.f + __builtin_amdgcn_exp2f(-LOG2E * aa[j])), ig = __builtin_amdgcn_rcpf(1.f + __builtin_amdgcn_exp2f(-LOG2E * ax[j]));
                  const float la = -8.0f * r * sp; const float a = __builtin_amdgcn_exp2f(LOG2E * la);
                  const float uu = __builtin_amdgcn_sqrtf(fmaxf(1.f - a * a, 0.f)) * (ig * xv[e]);
                  hrun = a * hrun + uu; arun *= a; aa[j] = arun; ax[j] = hrun; } }
          SUM[(wave * 64 + lane) * 2] = arun; SUM[(wave * 64 + lane) * 2 + 1] = hrun; }
        __syncthreads();
        float ca = 1.f, chh = 0.f;
        for (int w = 0; w < wave; ++w) { const float aw = SUM[(w * 64 + lane) * 2], hw = SUM[(w * 64 + lane) * 2 + 1]; chh = aw * chh + hw; ca *= aw; }
        { GAS bf16* hl = P.HL + (size_t)(t0 + 32 * wave) * 512 + 64 * g + lane; GAS bf16* ac = P.AC + (size_t)(t0 + 32 * wave) * 512 + 64 * g + lane;
#pragma unroll
          for (int j = 0; j < 32; ++j) { const float hh = ax[j] + aa[j] * chh, acc = aa[j] * ca; hl[(size_t)j * 512] = (bf16)f2bf_(hh); ac[(size_t)j * 512] = (bf16)f2bf_(acc);
              if (j == 31 && wave == 7) { P.LSUM[((size_t)tile * 512 + 64 * g + lane) * 2] = acc; P.LSUM[((size_t)tile * 512 + 64 * g + lane) * 2 + 1] = hh; } } }
    }
}

struct PostP { const GAS bf16* OMB; const GAS bf16* HL; const GAS bf16* AC; const GAS float* LSUM; const GAS bf16* PROJB; const GAS float* gm; const GAS float* gl; GAS bf16* Y; };
__device__ __forceinline__ void post_phase(const PostP& P, LAS unsigned char* lds, int tid, int wave, int lane, int vcu, int G) {
    asm volatile("" : "+v"(tid), "+v"(lane));
    LAS float* hin = (LAS float*)lds;
    for (int u = vcu; u < T / 64; u += G) {
        const int t0 = u * 64, tile = t0 >> 8, tb = tile & ~31;
        __syncthreads();
        { float h = 0.f;
          for (int c = tb; c < tile; ++c) { const float a = P.LSUM[((size_t)c * 512 + tid) * 2], hh = P.LSUM[((size_t)c * 512 + tid) * 2 + 1]; h = a * h + hh; }
          hin[tid] = h; }
        __syncthreads();
        f32x4 hi0 = *(const LAS f32x4*)(hin + 8 * lane), hi1 = *(const LAS f32x4*)(hin + 8 * lane + 4);
        const f32x4 g0 = *(const GAS f32x4*)(P.gl + 8 * lane), g1 = *(const GAS f32x4*)(P.gl + 8 * lane + 4), gmv = *(const GAS f32x4*)(P.gm + 4 * lane);
#pragma unroll 2
        for (int i = 0; i < 8; ++i) {
            const size_t t = (size_t)t0 + 8 * wave + i;
            const v4u hw = *(const GAS v4u*)(P.HL + t * 512 + 8 * lane), aw = *(const GAS v4u*)(P.AC + t * 512 + 8 * lane), gw_ = *(const GAS v4u*)(P.PROJB + t * INP + PC_GL + 8 * lane);
            const v2u mw = *(const GAS v2u*)(P.OMB + t * 256 + 4 * lane);
            float o[8];
            o[0] = (bflo(hw.x) + bflo(aw.x) * hi0.x) * gelu_erf(bflo(gw_.x)); o[1] = (bfhi(hw.x) + bfhi(aw.x) * hi0.y) * gelu_erf(bfhi(gw_.x));
            o[2] = (bflo(hw.y) + bflo(aw.y) * hi0.z) * gelu_erf(bflo(gw_.y)); o[3] = (bfhi(hw.y) + bfhi(aw.y) * hi0.w) * gelu_erf(bfhi(gw_.y));
            o[4] = (bflo(hw.z) + bflo(aw.z) * hi1.x) * gelu_erf(bflo(gw_.z)); o[5] = (bfhi(hw.z) + bfhi(aw.z) * hi1.y) * gelu_erf(bfhi(gw_.z));
            o[6] = (bflo(hw.w) + bflo(aw.w) * hi1.z) * gelu_erf(bflo(gw_.w)); o[7] = (bfhi(hw.w) + bfhi(aw.w) * hi1.w) * gelu_erf(bfhi(gw_.w));
            float s2 = 0.f;
#pragma unroll
            for (int e = 0; e < 8; ++e) s2 += o[e] * o[e];
            const float m0 = bflo(mw.x), m1 = bfhi(mw.x), m2 = bflo(mw.y), m3 = bfhi(mw.y);
            float s1 = (m0 * m0 + m1 * m1) + (m2 * m2 + m3 * m3);
            s1 = wave_sum(s1, lane); s2 = wave_sum(s2, lane);
            const float r1 = rsqrtf(s1 * (1.f / 256.f) + 1e-6f), r2 = rsqrtf(s2 * (1.f / 512.f) + 1e-6f);
            GAS bf16* yr = P.Y + t * 1024;
            { v2u w; w.x = pk2(m0 * r1 * gmv.x, m1 * r1 * gmv.y); w.y = pk2(m2 * r1 * gmv.z, m3 * r1 * gmv.w); *(GAS v2u*)(yr + 4 * lane) = w; }
            { v4u w; w.x = pk2(o[0] * r2 * g0.x, o[1] * r2 * g0.y); w.y = pk2(o[2] * r2 * g0.z, o[3] * r2 * g0.w); w.z = pk2(o[4] * r2 * g1.x, o[5] * r2 * g1.y); w.w = pk2(o[6] * r2 * g1.z, o[7] * r2 * g1.w);
              *(GAS v4u*)(yr + 256 + 8 * lane) = w; }
        }
    }
}

#define TILE_BAR() asm volatile("s_waitcnt lgkmcnt(0)\n\ts_barrier" ::: "memory")
typedef short bf16x8 __attribute__((ext_vector_type(8)));
typedef short s16x4 __attribute__((ext_vector_type(4)));
typedef float f32x16 __attribute__((ext_vector_type(16)));
typedef unsigned u32x4 __attribute__((ext_vector_type(4)));
__device__ __forceinline__ int crow(int r, int hi) { return (r & 3) + 8 * (r >> 2) + 4 * hi; }
typedef float f32x2_t __attribute__((ext_vector_type(2))); typedef __bf16 bf16x2_c __attribute__((ext_vector_type(2)));
__device__ __forceinline__ unsigned cvtpk(float lo, float hi) { f32x2_t v = {lo, hi}; bf16x2_c b = __builtin_convertvector(v, bf16x2_c); return __builtin_bit_cast(unsigned, b); }
__device__ __forceinline__ float swapmax(float m) { auto rr = __builtin_amdgcn_permlane32_swap(__float_as_uint(m), __float_as_uint(m), false, false); return fmaxf(__uint_as_float(rr[0]), __uint_as_float(rr[1])); }
__device__ __forceinline__ float swapadd(float m) { auto rr = __builtin_amdgcn_permlane32_swap(__float_as_uint(m), __float_as_uint(m), false, false); return __uint_as_float(rr[0]) + __uint_as_float(rr[1]); }
__device__ __forceinline__ s16x4 vtr(const LAS unsigned char* p) { return __builtin_bit_cast(s16x4, __builtin_amdgcn_ds_read_tr16_b64_v4i16((LAS s16x4*)p)); }
__device__ __forceinline__ bf16x8 pack8(const f32x16& p, int b) { u32x4 w; w.x = cvtpk(p[b], p[b + 1]); w.y = cvtpk(p[b + 2], p[b + 3]); w.z = cvtpk(p[b + 4], p[b + 5]); w.w = cvtpk(p[b + 6], p[b + 7]); return __builtin_bit_cast(bf16x8, w); }
__device__ __forceinline__ float vmax3(float a, float b, float c) { float r; asm("v_max3_f32 %0, %1, %2, %3" : "=v"(r) : "v"(a), "v"(b), "v"(c)); return r; }
__device__ __forceinline__ float max32(const f32x16& p, const f32x16& q) {
    float a = vmax3(p[0], p[1], p[2]), b = vmax3(p[3], p[4], p[5]), c = vmax3(p[6], p[7], p[8]), d = vmax3(p[9], p[10], p[11]), e = vmax3(p[12], p[13], p[14]);
    float f = vmax3(q[0], q[1], q[2]), g = vmax3(q[3], q[4], q[5]), h = vmax3(q[6], q[7], q[8]), i = vmax3(q[9], q[10], q[11]), j = vmax3(q[12], q[13], q[14]);
    a = vmax3(a, b, c); d = vmax3(d, e, p[15]); f = vmax3(f, g, h); i = vmax3(i, j, q[15]);
    return vmax3(vmax3(a, d, f), i, i);
}
__device__ __forceinline__ float max16(const f32x16& p) { float a = fmaxf(fmaxf(p[0], p[1]), fmaxf(p[2], p[3])), b = fmaxf(fmaxf(p[4], p[5]), fmaxf(p[6], p[7])), c = fmaxf(fmaxf(p[8], p[9]), fmaxf(p[10], p[11])), d = fmaxf(fmaxf(p[12], p[13]), fmaxf(p[14], p[15])); return fmaxf(fmaxf(a, b), fmaxf(c, d)); }

struct AttnP {
    const GAS bf16* Q; const GAS bf16* K; const GAS bf16* V; int qp, kp, vp;
    GAS bf16* O; int op;
    const GAS float* rope;
    const GAS int* pos; const GAS float* btab; const GAS float* dnorm; const GAS float* lams;
};
template <int KIND> struct AK {
    static constexpr bool DIFF = KIND == 1, CROSS = KIND == 2;
    static constexpr int HW = KIND == 0 ? 96 : KIND == 1 ? 64 : 256;
    static constexpr int NKS = KIND == 0 ? 6 : KIND == 1 ? 2 : 16;
    static constexpr int KP = KIND == 0 ? 208 : KIND == 1 ? 144 : 528;
    static constexpr int ND = CROSS ? 4 : 2;
    static constexpr int CPK = HW / 8, KCH = (64 * CPK + 511) / 512;
    static constexpr int VCH = ND / 2;
    static constexpr int KB = 64 * KP, VB = ND * 4096;
    static constexpr int NBUF = CROSS ? 2 : 3;
    static constexpr int K0 = 0, V0 = NBUF * KB, POS = V0 + NBUF * VB, BT = POS + 1024, DN = BT + 528, END = DN + 256;
};
static_assert(AK<2>::END <= RING_BYTES && AK<0>::END <= RING_BYTES && AK<1>::END + 16 + 8 * 8192 <= RING_BYTES, "attention LDS");

template <int KIND, bool LEAD>
__device__ __forceinline__ void attn_unit(const AttnP& P, int b, int h, int qb, int dhalf, LAS unsigned char* lds, int tid, int wave, int lane) {
    lane = lane_id_v(); tid = (wave << 6) | lane;
    typedef AK<KIND> C;
    constexpr bool DIFF = C::DIFF, CROSS = C::CROSS;
    constexpr int HW = C::HW, NKS = C::NKS, KP = C::KP, ND = C::ND, CPK = C::CPK, KCH = C::KCH, VCH = C::VCH;
    const int r32 = lane & 31, hi = lane >> 5;
    const size_t rowb = (size_t)b * S, rowk = CROSS ? (size_t)b * MEM : rowb;
    const int q0w = qb * 256 + wave * 32, qi = q0w + r32;
    int pq = 0; float bias_far = 0.f;
    __syncthreads();
    if (DIFF) {
        pq = P.pos[rowb + qi];
        if (tid < 129) ((LAS float*)(lds + C::BT))[tid] = P.btab[h * 129 + tid];
        if (tid >= 192 && tid < 256) ((LAS float*)(lds + C::DN))[tid - 192] = P.dnorm[tid - 192];
    }
    int minq = pq;
    if (DIFF) { for (int o = 1; o < 64; o <<= 1) { const int v = shxi(minq, o, lane); minq = v < minq ? v : minq; } }
    const int NT = CROSS ? MEM / 64 : 4 * (qb + 1);
    u32x4 kr[KCH], vr[VCH]; int pkr = 0;
    u32x4 kr2[CROSS ? 1 : KCH], vr2[CROSS ? 1 : VCH]; int pkr2 = 0;
    const GAS bf16* Kb = P.K + rowk * P.kp + h * HW; const GAS bf16* Vb = P.V + rowk * P.vp + (CROSS ? h * 256 + dhalf * 128 : h * 64);
    const __amdgpu_buffer_rsrc_t rK = __builtin_amdgcn_make_buffer_rsrc((void*)Kb, 0, 0x7fffffff, 0x00020000), rV = __builtin_amdgcn_make_buffer_rsrc((void*)Vb, 0, 0x7fffffff, 0x00020000);
    const __amdgpu_buffer_rsrc_t rP = __builtin_amdgcn_make_buffer_rsrc((void*)(DIFF ? P.pos + rowb : (const GAS int*)Kb), 0, 0x7fffffff, 0x00020000);
    int kvo[KCH], vvo[VCH];
#pragma unroll
    for (int i = 0; i < KCH; ++i) { int c = tid + 512 * i; c = c < 64 * CPK ? c : tid; kvo[i] = ((c / CPK) * P.kp + (c % CPK) * 8) * 2; }
#pragma unroll
    for (int i = 0; i < VCH; ++i) { const int c = tid + 512 * i; vvo[i] = ((c / (4 * ND)) * P.vp + (c % (4 * ND)) * 8) * 2; }
    const int pvo = (tid & 63) * 4;
    auto gload = [&](int t) {
        const int ks = __builtin_amdgcn_readfirstlane(64 * t * P.kp * 2), vs = __builtin_amdgcn_readfirstlane(64 * t * P.vp * 2);
#pragma unroll
        for (int i = 0; i < KCH; ++i) kr[i] = __builtin_amdgcn_raw_buffer_load_b128(rK, kvo[i], ks, 0);
#pragma unroll
        for (int i = 0; i < VCH; ++i) vr[i] = __builtin_amdgcn_raw_buffer_load_b128(rV, vvo[i], vs, 0);
        if (DIFF) pkr = __builtin_amdgcn_raw_buffer_load_b32(rP, pvo, __builtin_amdgcn_readfirstlane(64 * t * 4), 0);
    };
    auto lstore = [&](int buf) {
        LAS unsigned char* kb_ = lds + C::K0 + buf * C::KB; LAS unsigned char* vb_ = lds + C::V0 + buf * C::VB;
#pragma unroll
        for (int i = 0; i < KCH; ++i) { int c = tid + 512 * i; c = c < 64 * CPK ? c : tid; const int key = c / CPK, part = c % CPK; *(LAS u32x4*)(kb_ + key * KP + part * 16) = kr[i]; }
#pragma unroll
        for (int i = 0; i < VCH; ++i) { const int c = tid + 512 * i; const int key = c / (4 * ND), part = c % (4 * ND); *(LAS u32x4*)(vb_ + (part >> 2) * 4096 + (key >> 3) * 512 + (key & 7) * 64 + (part & 3) * 16) = vr[i]; }
        if (DIFF) { ((LAS int*)(lds + C::POS + buf * 256))[tid & 63] = pkr; if (tid < 64) { int mk_ = pkr; for (int o = 1; o < 64; o <<= 1) { const int v = shxi(mk_, o, lane); mk_ = v > mk_ ? v : mk_; } if (tid == 0) ((LAS int*)(lds + C::POS + 768))[buf] = mk_; } }
    };
    auto gloadB = [&](int t) {
        const int ks = __builtin_amdgcn_readfirstlane(64 * t * P.kp * 2), vs = __builtin_amdgcn_readfirstlane(64 * t * P.vp * 2);
#pragma unroll
        for (int i = 0; i < (CROSS ? 1 : KCH); ++i) kr2[i] = __builtin_amdgcn_raw_buffer_load_b128(rK, kvo[i], ks, 0);
#pragma unroll
        for (int i = 0; i < (CROSS ? 1 : VCH); ++i) vr2[i] = __builtin_amdgcn_raw_buffer_load_b128(rV, vvo[i], vs, 0);
        if (DIFF) pkr2 = __builtin_amdgcn_raw_buffer_load_b32(rP, pvo, __builtin_amdgcn_readfirstlane(64 * t * 4), 0);
    };
    auto lstoreB = [&](int buf) {
        LAS unsigned char* kb_ = lds + C::K0 + buf * C::KB; LAS unsigned char* vb_ = lds + C::V0 + buf * C::VB;
#pragma unroll
        for (int i = 0; i < (CROSS ? 1 : KCH); ++i) { int c = tid + 512 * i; c = c < 64 * CPK ? c : tid; const int key = c / CPK, part = c % CPK; *(LAS u32x4*)(kb_ + key * KP + part * 16) = kr2[i]; }
#pragma unroll
        for (int i = 0; i < (CROSS ? 1 : VCH); ++i) { const int c = tid + 512 * i; const int key = c / (4 * ND), part = c % (4 * ND); *(LAS u32x4*)(vb_ + (part >> 2) * 4096 + (key >> 3) * 512 + (key & 7) * 64 + (part & 3) * 16) = vr2[i]; }
        if (DIFF) { ((LAS int*)(lds + C::POS + buf * 256))[tid & 63] = pkr2; if (tid < 64) { int mk_ = pkr2; for (int o = 1; o < 64; o <<= 1) { const int v = shxi(mk_, o, lane); mk_ = v > mk_ ? v : mk_; } if (tid == 0) ((LAS int*)(lds + C::POS + 768))[buf] = mk_; } }
    };
    LAS float* osv = (LAS float*)(lds + ((C::END + 15) & ~15)) + wave * 2048 + lane;
    float il = 0.f;
    f32x16 oA[ND];
#pragma unroll 1
    for (int mp = 0; mp < (DIFF ? 2 : 1); ++mp) {
        bf16x8 qf[NKS];
        { const GAS bf16* qrow = P.Q + (rowb + qi) * P.qp + h * HW + mp * 32;
#pragma unroll
          for (int s = 0; s < NKS; ++s) qf[s] = *(const GAS bf16x8*)(qrow + 16 * s + 8 * hi);
          if (KIND == 0) {
              const GAS float* rp = P.rope + (rowb + qi) * 32 + 8 * hi;
              const f32x4 c0 = *(const GAS f32x4*)rp, c1 = *(const GAS f32x4*)(rp + 4), s0 = *(const GAS f32x4*)(rp + 16), s1 = *(const GAS f32x4*)(rp + 20);
              const u32x4 a = __builtin_bit_cast(u32x4, qf[NKS - 2]), bq = __builtin_bit_cast(u32x4, qf[NKS - 1]); u32x4 ra, rb;
#pragma unroll
              for (int w = 0; w < 4; ++w) { const float cl = w < 2 ? c0[2 * w] : c1[2 * w - 4], ch = w < 2 ? c0[2 * w + 1] : c1[2 * w - 3], sl = w < 2 ? s0[2 * w] : s1[2 * w - 4], sh = w < 2 ? s0[2 * w + 1] : s1[2 * w - 3];
                  const float x1l = bflo(a[w]), x1h = bfhi(a[w]), x2l = bflo(bq[w]), x2h = bfhi(bq[w]);
                  ra[w] = cvtpk(x1l * cl - x2l * sl, x1h * ch - x2h * sh); rb[w] = cvtpk(x1l * sl + x2l * cl, x1h * sh + x2h * ch); }
              qf[NKS - 2] = __builtin_bit_cast(bf16x8, ra); qf[NKS - 1] = __builtin_bit_cast(bf16x8, rb);
          } }
        __syncthreads();
        float m1 = -1e30f, l1 = 0.f;
#pragma unroll
        for (int d = 0; d < ND; ++d)
#pragma unroll
            for (int r = 0; r < 16; ++r) oA[d][r] = 0.f;
        auto qk = [&](int sl, f32x16& sa, f32x16& sb, float init) {
            const LAS unsigned char* kb_ = lds + C::K0 + sl * C::KB + r32 * KP + hi * 16 + mp * 64;
#pragma unroll
            for (int r = 0; r < 16; ++r) { sa[r] = init; sb[r] = init; }
            constexpr int HB = CROSS ? 4 : (NKS > 3 ? 3 : NKS);
#pragma unroll
            for (int s0_ = 0; s0_ < NKS; s0_ += HB) {
                bf16x8 kfa[HB], kfb[HB];
#pragma unroll
                for (int s = 0; s < HB; ++s) { kfa[s] = *(const LAS bf16x8*)(kb_ + (s0_ + s) * 32); kfb[s] = *(const LAS bf16x8*)(kb_ + 32 * KP + (s0_ + s) * 32); }
                __builtin_amdgcn_sched_barrier(0);
#pragma unroll
                for (int s = 0; s < HB; ++s) { sa = __builtin_amdgcn_mfma_f32_32x32x16_bf16(kfa[s], qf[s0_ + s], sa, 0, 0, 0); sb = __builtin_amdgcn_mfma_f32_32x32x16_bf16(kfb[s], qf[s0_ + s], sb, 0, 0, 0); }
                __builtin_amdgcn_sched_barrier(0);
            }
        };
        auto isnear = [&](int sl) { bool nb = false;
            if (DIFF) { const int mk_ = __builtin_amdgcn_readfirstlane(((LAS int*)(lds + C::POS + 768))[sl]); nb = (minq - mk_) < 128; }
            return nb; };
        auto sm = [&](int t, int sl, f32x16& pa, f32x16& pb, bool nearb) -> float {
            const int k0 = 64 * t;
            if (DIFF) { if (nearb) {
                const LAS int* pk = (const LAS int*)(lds + C::POS + sl * 256); const LAS float* bt = (const LAS float*)(lds + C::BT);
#pragma unroll
                for (int r = 0; r < 16; ++r) { const int kk = crow(r, hi);
                    int n0 = pq - pk[kk], n1 = pq - pk[kk + 32]; n0 = n0 < 0 ? 0 : (n0 > 128 ? 128 : n0); n1 = n1 < 0 ? 0 : (n1 > 128 ? 128 : n1);
                    pa[r] += bt[n0]; pb[r] += bt[n1]; }
            } }
            if (!CROSS && k0 + 63 > q0w) {
#pragma unroll
                for (int r = 0; r < 16; ++r) { const int kk = k0 + crow(r, hi); if (kk > qi) pa[r] = -1e30f; if (kk + 32 > qi) pb[r] = -1e30f; }
            }
            asm volatile("s_nop 15\n\ts_nop 7" : "+v"(pa), "+v"(pb));
            float mn, al = 1.f;
            if (CROSS) { const float mx = swapmax(max32(pa, pb)); mn = fmaxf(m1, mx); al = __builtin_amdgcn_exp2f(m1 - mn); l1 *= al; }
            else { const float mx = swapmax(max32(pa, pb)); const bool up = mx > m1 + 8.0f; mn = up ? mx : m1;
                   if (__builtin_amdgcn_ballot_w64(up) != 0ull) { al = __builtin_amdgcn_exp2f(m1 - mn); l1 *= al; } }
            m1 = mn;
            float ls = 0.f;
#pragma unroll
            for (int r = 0; r < 16; ++r) { pa[r] = __builtin_amdgcn_exp2f(pa[r] - mn); pb[r] = __builtin_amdgcn_exp2f(pb[r] - mn); ls += pa[r] + pb[r]; }
            l1 += ls;
            return al;
        };
        auto pv = [&](int sl, const f32x16& pa, const f32x16& pb, float al) {
            const LAS unsigned char* vb_ = lds + C::V0 + sl * C::VB + ((lane >> 4) & 1) * 32 + (lane & 3) * 8 + (4 * hi + ((lane & 15) >> 2)) * 64;
            bf16x8 pf[4];
            pf[0] = pack8(pa, 0); pf[1] = pack8(pa, 8); pf[2] = pack8(pb, 0); pf[3] = pack8(pb, 8);
            const bool resc = CROSS ? true : (__builtin_amdgcn_ballot_w64(al != 1.0f) != 0ull);
            if (CROSS) {
#pragma unroll
                for (int d = 0; d < ND; ++d) {
                    __builtin_amdgcn_sched_barrier(0);
#pragma unroll
                    for (int r = 0; r < 16; ++r) oA[d][r] *= al;
                    bf16x8 vf[4];
#pragma unroll
                    for (int s = 0; s < 4; ++s) { const s16x4 lo = vtr(vb_ + d * 4096 + s * 1024), hh = vtr(vb_ + d * 4096 + s * 1024 + 512); vf[s] = (bf16x8){lo[0], lo[1], lo[2], lo[3], hh[0], hh[1], hh[2], hh[3]}; }
#pragma unroll
                    for (int s = 0; s < 4; ++s) oA[d] = __builtin_amdgcn_mfma_f32_32x32x16_bf16(vf[s], pf[s], oA[d], 0, 0, 0);
                }
            } else if (DIFF) {
                if (resc) {
#pragma unroll
                    for (int d = 0; d < 2; ++d)
#pragma unroll
                        for (int r = 0; r < 16; ++r) oA[d][r] *= al;
                }
#pragma unroll
                for (int d = 0; d < 2; ++d) {
                    bf16x8 vf[4];
#pragma unroll
                    for (int s = 0; s < 4; ++s) { const s16x4 lo = vtr(vb_ + d * 4096 + s * 1024), hh = vtr(vb_ + d * 4096 + s * 1024 + 512); vf[s] = (bf16x8){lo[0], lo[1], lo[2], lo[3], hh[0], hh[1], hh[2], hh[3]}; }
                    __builtin_amdgcn_sched_barrier(0);
#pragma unroll
                    for (int s = 0; s < 4; ++s) oA[d] = __builtin_amdgcn_mfma_f32_32x32x16_bf16(vf[s], pf[s], oA[d], 0, 0, 0);
                }
            } else {
                bf16x8 vf[2][4];
#pragma unroll
                for (int d = 0; d < 2; ++d)
#pragma unroll
                    for (int s = 0; s < 4; ++s) { const s16x4 lo = vtr(vb_ + d * 4096 + s * 1024), hh = vtr(vb_ + d * 4096 + s * 1024 + 512); vf[d][s] = (bf16x8){lo[0], lo[1], lo[2], lo[3], hh[0], hh[1], hh[2], hh[3]}; }
                if (resc) {
#pragma unroll
                    for (int d = 0; d < 2; ++d)
#pragma unroll
                        for (int r = 0; r < 16; ++r) oA[d][r] *= al;
                }
                __builtin_amdgcn_sched_barrier(0);
#pragma unroll
                for (int s = 0; s < 4; ++s)
#pragma unroll
                    for (int d = 0; d < 2; ++d) oA[d] = __builtin_amdgcn_mfma_f32_32x32x16_bf16(vf[d][s], pf[s], oA[d], 0, 0, 0);
            }
        };
        if (CROSS) {
            gload(0); lstore(0);
            __syncthreads();
            for (int t = 0; t < NT; ++t) {
                const int buf = t & 1;
                f32x16 pa, pb;
                qk(buf, pa, pb, 0.f);
                const float al = sm(t, buf, pa, pb, false);
                pv(buf, pa, pb, al);
                if (t + 1 < NT) { gload(t + 1); lstore(buf ^ 1); }
                TILE_BAR();
            }
        } else {
            gload(0); lstore(0); gload(1); lstore(1);
            gload(2); gloadB(3);
            __syncthreads();
            if (DIFF) bias_far = ((LAS float*)(lds + C::BT))[128];
            const int NTW = (q0w + 31) / 64 + 1;
            constexpr bool lead = LEAD;
            f32x16 ca, cb, na, nb; bool cnear = isnear(0), nnear = false; float cal = 1.f;
            qk(0, ca, cb, (DIFF && !cnear) ? bias_far : 0.f);
            if (lead) cal = sm(0, 0, ca, cb, cnear);
            int s0 = 0, s1 = 1, s2 = 2;
            auto period = [&](int t, f32x16& xa, f32x16& xb, bool& xnear, f32x16& ya, f32x16& yb, bool& ynear) {
                const bool have_next = (t + 1 < NTW);
                if (lead) {
                    if (have_next) { ynear = isnear(s1); qk(s1, ya, yb, (DIFF && !ynear) ? bias_far : 0.f); }
                    if (t < NTW) pv(s0, xa, xb, cal);
                    if (have_next) cal = sm(t + 1, s1, ya, yb, ynear);
                } else {
                    if (t < NTW) cal = sm(t, s0, xa, xb, xnear);
                    if (have_next) { ynear = isnear(s1); qk(s1, ya, yb, (DIFF && !ynear) ? bias_far : 0.f); }
                    if (t < NTW) pv(s0, xa, xb, cal);
                }
                { const int tmp = s0; s0 = s1; s1 = s2; s2 = tmp; }
            };
            int t = 0;
            for (; t + 5 < NT; t += 2) {
                lstore(s2); gload(t + 4);
                period(t, ca, cb, cnear, na, nb, nnear);
                TILE_BAR();
                lstoreB(s2); gloadB(t + 5);
                period(t + 1, na, nb, nnear, ca, cb, cnear);
                TILE_BAR();
            }
            for (; t < NT; t += 2) {
                if (t + 2 < NT) { lstore(s2); if (t + 4 < NT) gload(t + 4); }
                period(t, ca, cb, cnear, na, nb, nnear);
                TILE_BAR();
                if (t + 3 < NT) { lstoreB(s2); if (t + 5 < NT) gloadB(t + 5); }
                period(t + 1, na, nb, nnear, ca, cb, cnear);
                TILE_BAR();
            }
        }
        il = 1.f / swapadd(l1);
        if (DIFF) { if (mp == 0) {
#pragma unroll
            for (int d = 0; d < 2; ++d)
#pragma unroll
                for (int r = 0; r < 16; ++r) osv[(d * 16 + r) * 64] = oA[d][r] * il; } }
    }
    GAS bf16* orow = P.O + (rowb + qi) * P.op + (CROSS ? h * 256 + dhalf * 128 : h * 64);
    if (!DIFF) {
#pragma unroll
        for (int d = 0; d < ND; ++d)
#pragma unroll
            for (int g = 0; g < 4; ++g) { v2u v; v.x = cvtpk(oA[d][4 * g] * il, oA[d][4 * g + 1] * il); v.y = cvtpk(oA[d][4 * g + 2] * il, oA[d][4 * g + 3] * il); *(GAS v2u*)(orow + 32 * d + 8 * g + 4 * hi) = v; }
    } else {
        const float lam = P.lams[0], lam_init = P.lams[1];
        const float i2 = lam * il;
        float ss = 0.f;
#pragma unroll
        for (int d = 0; d < 2; ++d)
#pragma unroll
            for (int r = 0; r < 16; ++r) { const float v = osv[(d * 16 + r) * 64] - oA[d][r] * i2; oA[d][r] = v; ss += v * v; }
        ss = swapadd(ss);
        const float rs = __builtin_amdgcn_rsqf(ss * (1.f / 64.f) + 1e-6f) * (1.f - lam_init);
        const LAS float* dn = (const LAS float*)(lds + C::DN);
#pragma unroll
        for (int d = 0; d < 2; ++d)
#pragma unroll
            for (int g = 0; g < 4; ++g) { const int c = 32 * d + 8 * g + 4 * hi; const f32x4 gn = *(const LAS f32x4*)(dn + c);
                v2u v; v.x = cvtpk(oA[d][4 * g] * rs * gn[0], oA[d][4 * g + 1] * rs * gn[1]); v.y = cvtpk(oA[d][4 * g + 2] * rs * gn[2], oA[d][4 * g + 3] * rs * gn[3]); *(GAS v2u*)(orow + c) = v; }
    }
}

template <int KIND> struct AK2 {
    static constexpr bool DIFF = KIND == 1;
    static constexpr int HW = KIND == 0 ? 96 : 64, NKS = KIND == 0 ? 6 : 2, KP = KIND == 0 ? 208 : 144;
    static constexpr int CPK = HW / 8, KCH = (128 * CPK) / 512, VCH = 2;
    static constexpr int KB = 128 * KP, VB = 2 * 8192;
    static constexpr int K0 = 0, V0 = 2 * KB, POS = V0 + 2 * VB, PMX = POS + 1024, BT = PMX + 16, DN = BT + 528, OSV = (DN + 256 + 15) & ~15, END = OSV + (DIFF ? 8 * 8192 : 0);
};
static_assert(AK2<0>::END <= RING_BYTES && AK2<1>::END <= RING_BYTES, "attention LDS (128-key tiles)");
template <int KIND>
__device__ __forceinline__ void attn_unit2(const AttnP& P, int b, int h, int qb, LAS unsigned char* lds, int tid, int wave, int lane) {
    lane = lane_id_v(); tid = (wave << 6) | lane;
    typedef AK2<KIND> C;
    constexpr bool DIFF = C::DIFF;
    constexpr int HW = C::HW, NKS = C::NKS, KP = C::KP, CPK = C::CPK, KCH = C::KCH, VCH = C::VCH;
    const int r32 = lane & 31, hi = lane >> 5;
    const size_t rowb = (size_t)b * S;
    const int q0w = qb * 256 + wave * 32, qi = q0w + r32;
    int pq = 0; float bias_far = 0.f;
    __syncthreads();
    if (DIFF) {
        pq = P.pos[rowb + qi];
        if (tid < 129) ((LAS float*)(lds + C::BT))[tid] = P.btab[h * 129 + tid];
        if (tid >= 192 && tid < 256) ((LAS float*)(lds + C::DN))[tid - 192] = P.dnorm[tid - 192];
    }
    int minq = pq;
    if (DIFF) { for (int o = 1; o < 64; o <<= 1) { const int v = shxi(minq, o, lane); minq = v < minq ? v : minq; } }
    const int NT = 2 * (qb + 1);
    const GAS bf16* Kb = P.K + rowb * P.kp + h * HW; const GAS bf16* Vb = P.V + rowb * P.vp + h * 64;
    const __amdgpu_buffer_rsrc_t rK = __builtin_amdgcn_make_buffer_rsrc((void*)Kb, 0, 0x7fffffff, 0x00020000), rV = __builtin_amdgcn_make_buffer_rsrc((void*)Vb, 0, 0x7fffffff, 0x00020000);
    const __amdgpu_buffer_rsrc_t rP = __builtin_amdgcn_make_buffer_rsrc((void*)(DIFF ? P.pos + rowb : (const GAS int*)Kb), 0, 0x7fffffff, 0x00020000);
    int kvo[KCH], vvo[VCH], klo[KCH], vlo[VCH];
#pragma unroll
    for (int i = 0; i < KCH; ++i) { const int c = tid + 512 * i; kvo[i] = ((c / CPK) * P.kp + (c % CPK) * 8) * 2; klo[i] = (c / CPK) * KP + (c % CPK) * 16; }
#pragma unroll
    for (int i = 0; i < VCH; ++i) { const int c = tid + 512 * i; const int key = c >> 3, part = c & 7; vvo[i] = (key * P.vp + part * 8) * 2; vlo[i] = (part >> 2) * 8192 + (key >> 3) * 512 + (key & 7) * 64 + (part & 3) * 16; }
    const int pvo = (tid & 127) * 4;
    u32x4 kr[KCH], vr[VCH]; int pkr = 0;
    auto gload = [&](int t) {
        const int ks = __builtin_amdgcn_readfirstlane(128 * t * P.kp * 2), vs = __builtin_amdgcn_readfirstlane(128 * t * P.vp * 2);
#pragma unroll
        for (int i = 0; i < KCH; ++i) kr[i] = __builtin_amdgcn_raw_buffer_load_b128(rK, kvo[i], ks, 0);
#pragma unroll
        for (int i = 0; i < VCH; ++i) vr[i] = __builtin_amdgcn_raw_buffer_load_b128(rV, vvo[i], vs, 0);
        if (DIFF) pkr = __builtin_amdgcn_raw_buffer_load_b32(rP, pvo, __builtin_amdgcn_readfirstlane(128 * t * 4), 0);
    };
    auto lstore = [&](int buf) {
        LAS unsigned char* kb_ = lds + C::K0 + buf * C::KB; LAS unsigned char* vb_ = lds + C::V0 + buf * C::VB;
#pragma unroll
        for (int i = 0; i < KCH; ++i) *(LAS u32x4*)(kb_ + klo[i]) = kr[i];
#pragma unroll
        for (int i = 0; i < VCH; ++i) *(LAS u32x4*)(vb_ + vlo[i]) = vr[i];
        if (DIFF) { ((LAS int*)(lds + C::POS + buf * 512))[tid & 127] = pkr;
            if (tid < 128) { int mk_ = pkr; for (int o = 1; o < 64; o <<= 1) { const int v = shxi(mk_, o, lane); mk_ = v > mk_ ? v : mk_; } if (lane == 0) ((LAS int*)(lds + C::PMX))[buf * 2 + wave] = mk_; } }
    };
    LAS float* osv = (LAS float*)(lds + C::OSV) + wave * 2048 + lane;
    float il = 0.f;
    f32x16 oA[2];
#pragma unroll 1
    for (int mp = 0; mp < (DIFF ? 2 : 1); ++mp) {
        bf16x8 qf[NKS];
        { const GAS bf16* qrow = P.Q + (rowb + qi) * P.qp + h * HW + mp * 32;
#pragma unroll
          for (int s = 0; s < NKS; ++s) qf[s] = *(const GAS bf16x8*)(qrow + 16 * s + 8 * hi);
          if (KIND == 0) {
              const GAS float* rp = P.rope + (rowb + qi) * 32 + 8 * hi;
              const f32x4 c0 = *(const GAS f32x4*)rp, c1 = *(const GAS f32x4*)(rp + 4), s0 = *(const GAS f32x4*)(rp + 16), s1 = *(const GAS f32x4*)(rp + 20);
              const u32x4 a = __builtin_bit_cast(u32x4, qf[NKS - 2]), bq = __builtin_bit_cast(u32x4, qf[NKS - 1]); u32x4 ra, rb;
#pragma unroll
              for (int w = 0; w < 4; ++w) { const float cl = w < 2 ? c0[2 * w] : c1[2 * w - 4], ch = w < 2 ? c0[2 * w + 1] : c1[2 * w - 3], sl = w < 2 ? s0[2 * w] : s1[2 * w - 4], sh = w < 2 ? s0[2 * w + 1] : s1[2 * w - 3];
                  const float x1l = bflo(a[w]), x1h = bfhi(a[w]), x2l = bflo(bq[w]), x2h = bfhi(bq[w]);
                  ra[w] = cvtpk(x1l * cl - x2l * sl, x1h * ch - x2h * sh); rb[w] = cvtpk(x1l * sl + x2l * cl, x1h * sh + x2h * ch); }
              qf[NKS - 2] = __builtin_bit_cast(bf16x8, ra); qf[NKS - 1] = __builtin_bit_cast(bf16x8, rb);
          } }
        __syncthreads();
        float m1 = -1e30f, l1 = 0.f;
#pragma unroll
        for (int d = 0; d < 2; ++d)
#pragma unroll
            for (int r = 0; r < 16; ++r) oA[d][r] = 0.f;
        gload(0); lstore(0);
        if (NT > 1) gload(1);
        __syncthreads();
        if (DIFF) bias_far = ((LAS float*)(lds + C::BT))[128];
        const int NTW = (q0w + 31) / 128 + 1;
        auto compute = [&](int t, int buf) {
            const int k0 = 128 * t;
            const LAS unsigned char* kb_ = lds + C::K0 + buf * C::KB + r32 * KP + hi * 16 + mp * 64;
            const LAS unsigned char* vb_ = lds + C::V0 + buf * C::VB + ((lane >> 4) & 1) * 32 + (lane & 3) * 8 + (4 * hi + ((lane & 15) >> 2)) * 64;
            bool nearb = false;
            if (DIFF) { const LAS int* pm = (const LAS int*)(lds + C::PMX) + buf * 2; const int m0 = __builtin_amdgcn_readfirstlane(pm[0]), m1_ = __builtin_amdgcn_readfirstlane(pm[1]); nearb = (minq - (m0 > m1_ ? m0 : m1_)) < 128; }
            const float init = (DIFF && !nearb) ? bias_far : 0.f;
            f32x16 sc[4];
#pragma unroll
            for (int g = 0; g < 4; ++g)
#pragma unroll
                for (int r = 0; r < 16; ++r) sc[g][r] = init;
            constexpr int HB = NKS > 3 ? 3 : NKS;
#pragma unroll
            for (int s0_ = 0; s0_ < NKS; s0_ += HB) {
                bf16x8 kf[4][HB];
#pragma unroll
                for (int g = 0; g < 4; ++g)
#pragma unroll
                    for (int s = 0; s < HB; ++s) kf[g][s] = *(const LAS bf16x8*)(kb_ + 32 * g * KP + (s0_ + s) * 32);
                __builtin_amdgcn_sched_barrier(0);
#pragma unroll
                for (int s = 0; s < HB; ++s)
#pragma unroll
                    for (int g = 0; g < 4; ++g) sc[g] = __builtin_amdgcn_mfma_f32_32x32x16_bf16(kf[g][s], qf[s0_ + s], sc[g], 0, 0, 0);
                __builtin_amdgcn_sched_barrier(0);
            }
            if (DIFF) { if (nearb) {
                const LAS int* pk = (const LAS int*)(lds + C::POS + buf * 512); const LAS float* bt = (const LAS float*)(lds + C::BT);
#pragma unroll
                for (int g = 0; g < 4; ++g)
#pragma unroll
                    for (int r = 0; r < 16; ++r) { int n0 = pq - pk[32 * g + crow(r, hi)]; n0 = n0 < 0 ? 0 : (n0 > 128 ? 128 : n0); sc[g][r] += bt[n0]; }
            } }
            asm volatile("s_nop 15\n\ts_nop 7" : "+v"(sc[0]), "+v"(sc[1]), "+v"(sc[2]), "+v"(sc[3]));
            if (k0 + 127 > q0w) {
#pragma unroll
                for (int g = 0; g < 4; ++g)
#pragma unroll
                    for (int r = 0; r < 16; ++r) { if (k0 + 32 * g + crow(r, hi) > qi) sc[g][r] = -1e30f; }
            }
            const float mx = swapmax(vmax3(max32(sc[0], sc[1]), max32(sc[2], sc[3]), -1e30f)); const bool up = mx > m1 + 8.0f; const float mn = up ? mx : m1;
            float al = 1.f;
            if (__builtin_amdgcn_ballot_w64(up) != 0ull) { al = __builtin_amdgcn_exp2f(m1 - mn); l1 *= al; }
            m1 = mn;
            float ls = 0.f;
#pragma unroll
            for (int g = 0; g < 4; ++g)
#pragma unroll
                for (int r = 0; r < 16; ++r) { sc[g][r] = __builtin_amdgcn_exp2f(sc[g][r] - mn); ls += sc[g][r]; }
            l1 += ls;
            bf16x8 pf[8];
#pragma unroll
            for (int g = 0; g < 4; ++g) { pf[2 * g] = pack8(sc[g], 0); pf[2 * g + 1] = pack8(sc[g], 8); }
            if (__builtin_amdgcn_ballot_w64(al != 1.0f) != 0ull) {
#pragma unroll
                for (int d = 0; d < 2; ++d)
#pragma unroll
                    for (int r = 0; r < 16; ++r) oA[d][r] *= al;
            }
#pragma unroll
            for (int d = 0; d < 2; ++d) {
                bf16x8 vf[8];
#pragma unroll
                for (int s = 0; s < 8; ++s) { const s16x4 lo = vtr(vb_ + d * 8192 + s * 1024), hh = vtr(vb_ + d * 8192 + s * 1024 + 512); vf[s] = (bf16x8){lo[0], lo[1], lo[2], lo[3], hh[0], hh[1], hh[2], hh[3]}; }
                __builtin_amdgcn_sched_barrier(0);
#pragma unroll
                for (int s = 0; s < 8; ++s) oA[d] = __builtin_amdgcn_mfma_f32_32x32x16_bf16(vf[s], pf[s], oA[d], 0, 0, 0);
                __builtin_amdgcn_sched_barrier(0);
            }
        };
        int t = 0;
        for (; t + 2 < NT; ++t) {
            const int buf = t & 1;
            lstore(buf ^ 1); gload(t + 2);
            if (t < NTW) compute(t, buf);
            TILE_BAR();
        }
        for (; t < NT; ++t) {
            const int buf = t & 1;
            if (t + 1 < NT) lstore(buf ^ 1);
            if (t < NTW) compute(t, buf);
            TILE_BAR();
        }
        il = 1.f / swapadd(l1);
        if (DIFF) { if (mp == 0) {
#pragma unroll
            for (int d = 0; d < 2; ++d)
#pragma unroll
                for (int r = 0; r < 16; ++r) osv[(d * 16 + r) * 64] = oA[d][r] * il; } }
    }
    GAS bf16* orow = P.O + (rowb + qi) * P.op + h * 64;
    if (!DIFF) {
#pragma unroll
        for (int d = 0; d < 2; ++d)
#pragma unroll
            for (int g = 0; g < 4; ++g) { v2u v; v.x = cvtpk(oA[d][4 * g] * il, oA[d][4 * g + 1] * il); v.y = cvtpk(oA[d][4 * g + 2] * il, oA[d][4 * g + 3] * il); *(GAS v2u*)(orow + 32 * d + 8 * g + 4 * hi) = v; }
    } else {
        const float lam = P.lams[0], lam_init = P.lams[1];
        const float i2 = lam * il;
        float ss = 0.f;
#pragma unroll
        for (int d = 0; d < 2; ++d)
#pragma unroll
            for (int r = 0; r < 16; ++r) { const float v = osv[(d * 16 + r) * 64] - oA[d][r] * i2; oA[d][r] = v; ss += v * v; }
        ss = swapadd(ss);
        const float rs = __builtin_amdgcn_rsqf(ss * (1.f / 64.f) + 1e-6f) * (1.f - lam_init);
        const LAS float* dn = (const LAS float*)(lds + C::DN);
#pragma unroll
        for (int d = 0; d < 2; ++d)
#pragma unroll
            for (int g = 0; g < 4; ++g) { const int c = 32 * d + 8 * g + 4 * hi; const f32x4 gn = *(const LAS f32x4*)(dn + c);
                v2u v; v.x = cvtpk(oA[d][4 * g] * rs * gn[0], oA[d][4 * g + 1] * rs * gn[1]); v.y = cvtpk(oA[d][4 * g + 2] * rs * gn[2], oA[d][4 * g + 3] * rs * gn[3]); *(GAS v2u*)(orow + c) = v; }
    }
}

__device__ __forceinline__ void attn_phase(const AttnP& PM, const AttnP& PD, LAS unsigned char* lds, int tid, int wave, int lane, int vcu, int G, int only = -1) {
    for (int i = vcu; i < 512; i += G) {
        if (only >= 0 && (i >> 8) != only) continue;
        const int kind = i >> 8, c = i & 255, bh = c >> 4, s = c & 15;
        if (kind == 0) {
#pragma unroll 1
            for (int k = 0; k < 2; ++k) attn_unit2<0>(PM, bh >> 2, bh & 3, k ? 31 - s : s, lds, tid, wave, lane);
        } else {
#pragma unroll 1
            for (int k = 0; k < 2; ++k) attn_unit2<1>(PD, bh >> 2, bh & 3, k ? 31 - s : s, lds, tid, wave, lane);
        }
    }
}
__device__ __forceinline__ void cross_phase(const AttnP& PC, LAS unsigned char* lds, int tid, int wave, int lane, int vcu, int G) {
#pragma unroll 1
    for (int i = vcu; i < 1024; i += G) { const int bh = i >> 6; attn_unit<2, true>(PC, bh >> 2, bh & 3, i & 31, (i >> 5) & 1, lds, tid, wave, lane); }
}

__device__ __forceinline__ float vmax2(float a, float b) { float r; asm("v_max_f32_e32 %0, %1, %2" : "=v"(r) : "v"(a), "v"(b)); return r; }
__device__ __forceinline__ float vmin2(float a, float b) { float r; asm("v_min_f32_e32 %0, %1, %2" : "=v"(r) : "v"(a), "v"(b)); return r; }
__device__ __forceinline__ void pad16(float (&a)[16]) {
    asm volatile("s_nop 1" : "+v"(a[0]), "+v"(a[1]), "+v"(a[2]), "+v"(a[3]), "+v"(a[4]), "+v"(a[5]), "+v"(a[6]), "+v"(a[7]), "+v"(a[8]), "+v"(a[9]), "+v"(a[10]), "+v"(a[11]), "+v"(a[12]), "+v"(a[13]), "+v"(a[14]), "+v"(a[15]));
}
__device__ __forceinline__ void sort16_desc(float (&a)[16]) {
#pragma unroll
    for (int k = 2; k <= 16; k <<= 1)
#pragma unroll
        for (int j = k >> 1; j > 0; j >>= 1)
#pragma unroll
            for (int i = 0; i < 16; ++i) { const int l = i ^ j; if (l > i) { const bool desc = ((i & k) == 0); const float hi_ = vmax2(a[i], a[l]), lo_ = vmin2(a[i], a[l]); a[i] = desc ? hi_ : lo_; a[l] = desc ? lo_ : hi_; } }
}
__device__ __forceinline__ void merge16_desc(float (&a)[16], const float (&b)[16]) {
#pragma unroll
    for (int i = 0; i < 16; ++i) a[i] = vmax2(a[i], b[15 - i]);
#pragma unroll
    for (int j = 8; j > 0; j >>= 1)
#pragma unroll
        for (int i = 0; i < 16; ++i) { const int l = i ^ j; if (l > i) { const float hi_ = vmax2(a[i], a[l]), lo_ = vmin2(a[i], a[l]); a[i] = hi_; a[l] = lo_; } }
}
__device__ __forceinline__ void top16_of_64(float (&g0)[16], float (&g1)[16], float (&g2)[16], float (&g3)[16]) {
    sort16_desc(g0); sort16_desc(g1); merge16_desc(g0, g1); sort16_desc(g2); sort16_desc(g3); merge16_desc(g2, g3); merge16_desc(g0, g2);
}
__device__ __forceinline__ float embed(float v, unsigned mask, unsigned id) { return __builtin_bit_cast(float, (__builtin_bit_cast(unsigned, v) & mask) | id); }
__device__ __forceinline__ float mkcand(float x, float y, unsigned id) { return embed(x + y, 0xFFFFFF00u, id); }

__device__ __forceinline__ void swap32(float& a, float& b) { asm volatile("v_nop\n\tv_nop\n\tv_permlane32_swap_b32 %0, %1" : "+v"(a), "+v"(b)); }
struct RouteP { const GAS bf16* QP; const GAS bf16* keys; GAS int* EX; GAS float* GW; };
constexpr int RT_KP = 144, RT_KEYS = 0, RT_SCR = 256 * RT_KP, RT_END = RT_SCR + 8 * 8192;
__device__ __forceinline__ void route_phase(const RouteP& P, LAS unsigned char* lds, int tid, int wave, int lane, int vcu, int G) {
    asm volatile("" : "+v"(tid), "+v"(lane));
    __syncthreads();
    for (int c = tid; c < 256 * 8; c += 512) { const int row = c >> 3, part = c & 7; *(LAS u32x4*)(lds + RT_KEYS + row * RT_KP + part * 16) = *(const u32x4*)(P.keys + row * 64 + part * 8); }
    __syncthreads();
    const int r32 = lane & 31, hi = lane >> 5;
    LAS int* scr = (LAS int*)(lds + RT_SCR + wave * 8192);
    for (int u = vcu; u < T / 32; u += G) {
        const size_t t = (size_t)u * 32 + r32; const int h = wave;
        float T2[2][16];
#pragma unroll
        for (int c = 0; c < 2; ++c) {
            bf16x8 qf[4];
            { const GAS bf16* q = P.QP + t * 1024 + h * 128 + c * 64 + 8 * hi;
#pragma unroll
              for (int s = 0; s < 4; ++s) qf[s] = *(const GAS bf16x8*)(q + 16 * s); }
            f32x16 sc[4];
#pragma unroll
            for (int m = 0; m < 4; ++m) {
#pragma unroll
                for (int r = 0; r < 16; ++r) sc[m][r] = 0.f;
#pragma unroll
                for (int s = 0; s < 4; ++s) { const bf16x8 a = *(const LAS bf16x8*)(lds + RT_KEYS + (c * 128 + 32 * m + r32) * RT_KP + s * 32 + hi * 16);
                    sc[m] = __builtin_amdgcn_mfma_f32_32x32x16_bf16(a, qf[s], sc[m], 0, 0, 0); }
            }
            float g0[16], g1[16], g2[16], g3[16];
            const unsigned h4 = 4u * (unsigned)hi;
#pragma unroll
            for (int r = 0; r < 16; ++r) { const unsigned kr_ = (unsigned)((r & 3) + 8 * (r >> 2));
                g0[r] = embed(sc[0][r], 0xFFFFFF80u, kr_ | h4); g1[r] = embed(sc[1][r], 0xFFFFFF80u, (32u + kr_) | h4); g2[r] = embed(sc[2][r], 0xFFFFFF80u, (64u + kr_) | h4); g3[r] = embed(sc[3][r], 0xFFFFFF80u, (96u + kr_) | h4); }
            top16_of_64(g0, g1, g2, g3);
            pad16(g0);
#pragma unroll
            for (int i = 0; i < 16; ++i) T2[c][i] = g0[i];
        }
        float A[16], Bv[16];
#pragma unroll
        for (int i = 0; i < 16; ++i) { A[i] = T2[0][i]; Bv[i] = T2[1][i]; swap32(A[i], Bv[i]); }
        merge16_desc(A, Bv);
        pad16(A);
        float T0[16], T1[16];
#pragma unroll
        for (int i = 0; i < 16; ++i) { T0[i] = A[i]; T1[i] = A[i]; swap32(T0[i], T1[i]); }
#pragma unroll
        for (int i = 0; i < 16; ++i) { scr[i * 64 + lane] = (int)(__builtin_bit_cast(unsigned, T0[i]) & 127u); scr[(16 + i) * 64 + lane] = (int)(__builtin_bit_cast(unsigned, T1[i]) & 127u);
            T0[i] = embed(T0[i], 0xFFFFFF80u, 0u); T1[i] = embed(T1[i], 0xFFFFFF80u, 0u); }
        float c0[16], c1[16], c2[16], c3[16];
        const float NINF = -__builtin_inff();
#pragma unroll
        for (int b = 0; b < 16; ++b) c0[b] = mkcand(T0[0], T1[b], (unsigned)b);
#pragma unroll
        for (int b = 0; b < 8; ++b) c1[b] = mkcand(T0[1], T1[b], 16u + b);
#pragma unroll
        for (int b = 0; b < 5; ++b) c1[8 + b] = mkcand(T0[2], T1[b], 32u + b);
#pragma unroll
        for (int b = 0; b < 3; ++b) c1[13 + b] = mkcand(T0[4], T1[b], 64u + b);
#pragma unroll
        for (int b = 0; b < 4; ++b) c2[b] = mkcand(T0[3], T1[b], 48u + b);
        c2[4] = mkcand(T0[5], T1[0], 80u); c2[5] = mkcand(T0[5], T1[1], 81u); c2[6] = mkcand(T0[6], T1[0], 96u); c2[7] = mkcand(T0[6], T1[1], 97u); c2[8] = mkcand(T0[7], T1[0], 112u); c2[9] = mkcand(T0[7], T1[1], 113u);
#pragma unroll
        for (int a = 8; a < 14; ++a) c2[10 + a - 8] = mkcand(T0[a], T1[0], 16u * a);
        c3[0] = mkcand(T0[14], T1[0], 224u); c3[1] = mkcand(T0[15], T1[0], 240u);
#pragma unroll
        for (int i = 2; i < 16; ++i) c3[i] = NINF;
        top16_of_64(c0, c1, c2, c3);
        pad16(c0);
        float gsum = 0.f, ge[16]; int ex[16];
        const float mtop = embed(c0[0], 0xFFFFFF00u, 0u);
#pragma unroll
        for (int i = 0; i < 16; ++i) { const unsigned bits = __builtin_bit_cast(unsigned, c0[i]); const int a = (bits >> 4) & 15, b = bits & 15;
            ge[i] = __builtin_amdgcn_exp2f((embed(c0[i], 0xFFFFFF00u, 0u) - mtop) * LOG2E); gsum += ge[i];
            ex[i] = scr[a * 64 + lane] * 128 + scr[(16 + b) * 64 + lane]; }
        const float ginv = __builtin_amdgcn_rcpf(gsum);
        if (hi == 0) { GAS v4u* d = (GAS v4u*)(P.EX + t * 128 + h * 16);
#pragma unroll
            for (int i = 0; i < 4; ++i) d[i] = (v4u){(unsigned)ex[4 * i], (unsigned)ex[4 * i + 1], (unsigned)ex[4 * i + 2], (unsigned)ex[4 * i + 3]}; }
        else { GAS f32x4* d = (GAS f32x4*)(P.GW + t * 128 + h * 16);
#pragma unroll
            for (int i = 0; i < 4; ++i) d[i] = (f32x4){ge[4 * i] * ginv, ge[4 * i + 1] * ginv, ge[4 * i + 2] * ginv, ge[4 * i + 3] * ginv}; }
    }
}

__device__ __forceinline__ int wave_allsum_i(int v) {
    v += __builtin_amdgcn_update_dpp(0, v, 0xB1, 0xF, 0xF, true);
    v += __builtin_amdgcn_update_dpp(0, v, 0x4E, 0xF, 0xF, true);
    v += __builtin_amdgcn_update_dpp(0, v, 0x141, 0xF, 0xF, true);
    v += __builtin_amdgcn_update_dpp(0, v, 0x140, 0xF, 0xF, true);
    { int a = v, b = v; asm volatile("v_nop\n\tv_nop\n\tv_permlane16_swap_b32 %0, %1" : "+v"(a), "+v"(b)); v = a + b; }
    { int a = v, b = v; asm volatile("v_nop\n\tv_nop\n\tv_permlane32_swap_b32 %0, %1" : "+v"(a), "+v"(b)); v = a + b; }
    return v;
}
__device__ __forceinline__ float wave_allsum(float v) {
    v += __builtin_bit_cast(float, __builtin_amdgcn_update_dpp(0, __builtin_bit_cast(int, v), 0xB1, 0xF, 0xF, true));
    v += __builtin_bit_cast(float, __builtin_amdgcn_update_dpp(0, __builtin_bit_cast(int, v), 0x4E, 0xF, 0xF, true));
    v += __builtin_bit_cast(float, __builtin_amdgcn_update_dpp(0, __builtin_bit_cast(int, v), 0x141, 0xF, 0xF, true));
    v += __builtin_bit_cast(float, __builtin_amdgcn_update_dpp(0, __builtin_bit_cast(int, v), 0x140, 0xF, 0xF, true));
    { float a = v, b = v; asm volatile("v_nop\n\tv_nop\n\tv_permlane16_swap_b32 %0, %1" : "+v"(a), "+v"(b)); v = a + b; }
    { float a = v, b = v; asm volatile("v_nop\n\tv_nop\n\tv_permlane32_swap_b32 %0, %1" : "+v"(a), "+v"(b)); v = a + b; }
    return v;
}
__device__ __forceinline__ float wave_allmax(float v) {
    v = fmaxf(v, __builtin_bit_cast(float, __builtin_amdgcn_update_dpp(0, __builtin_bit_cast(int, v), 0xB1, 0xF, 0xF, true)));
    v = fmaxf(v, __builtin_bit_cast(float, __builtin_amdgcn_update_dpp(0, __builtin_bit_cast(int, v), 0x4E, 0xF, 0xF, true)));
    v = fmaxf(v, __builtin_bit_cast(float, __builtin_amdgcn_update_dpp(0, __builtin_bit_cast(int, v), 0x141, 0xF, 0xF, true)));
    v = fmaxf(v, __builtin_bit_cast(float, __builtin_amdgcn_update_dpp(0, __builtin_bit_cast(int, v), 0x140, 0xF, 0xF, true)));
    { float a = v, b = v; asm volatile("v_nop\n\tv_nop\n\tv_permlane16_swap_b32 %0, %1" : "+v"(a), "+v"(b)); v = fmaxf(a, b); }
    { float a = v, b = v; asm volatile("v_nop\n\tv_nop\n\tv_permlane32_swap_b32 %0, %1" : "+v"(a), "+v"(b)); v = fmaxf(a, b); }
    return v;
}
__device__ __forceinline__ unsigned q4(float a, float b, float c, float d, int off) {
    const int ia = (int)__builtin_rintf(a) + off, ib = (int)__builtin_rintf(b) + off, ic = (int)__builtin_rintf(c) + off, id = (int)__builtin_rintf(d) + off;
    return (unsigned)(ia & 255) | ((unsigned)(ib & 255) << 8) | ((unsigned)(ic & 255) << 16) | ((unsigned)(id & 255) << 24);
}
__device__ __forceinline__ void quant_row(const GAS float* src, GAS unsigned* dst, GAS float* scale, int off, int lane) {
    const GAS f32x4* s = (const GAS f32x4*)src + 4 * lane; f32x4 v[4]; float m = 0.f;
#pragma unroll
    for (int i = 0; i < 4; ++i) { v[i] = s[i]; m = fmaxf(m, fmaxf(fmaxf(__builtin_fabsf(v[i].x), __builtin_fabsf(v[i].y)), fmaxf(__builtin_fabsf(v[i].z), __builtin_fabsf(v[i].w)))); }
    m = wave_allmax(m); const float inv = m > 0.f ? 127.f / m : 0.f;
    v4u w;
    w.x = q4(v[0].x * inv, v[0].y * inv, v[0].z * inv, v[0].w * inv, off); w.y = q4(v[1].x * inv, v[1].y * inv, v[1].z * inv, v[1].w * inv, off);
    w.z = q4(v[2].x * inv, v[2].y * inv, v[2].z * inv, v[2].w * inv, off); w.w = q4(v[3].x * inv, v[3].y * inv, v[3].z * inv, v[3].w * inv, off);
    *((GAS v4u*)dst + lane) = w;
    if (lane == 0) *scale = m * (1.f / 127.f);
}
struct PeerS { int nslices_step, first_slice, nloc, rank; };
__device__ __forceinline__ PeerS peer_sched(const GAS unsigned* rankw, int xcc, int rank) {
    int nx = 0, myidx = 0, nloc = 1;
    for (int j = 0; j < 16; ++j) { const int c = (int)__hip_atomic_load(rankw + 64 * j, __ATOMIC_RELAXED, __HIP_MEMORY_SCOPE_AGENT); if (c > 0) { if (j == xcc) { myidx = nx; nloc = c; } ++nx; } }
    PeerS s; s.nslices_step = nx > 0 ? nx : 1; s.first_slice = myidx; s.nloc = nloc; s.rank = rank; return s;
}
struct Peer1P { const GAS unsigned GAS char* HQ; const GAS int* EX; const GAS unsigned GAS char* U8; GAS int* P; };
__device__ __forceinline__ void peer_k1(const Peer1P& Q, const PeerS& sc, int wave, int lane) {
    asm volatile("" : "+v"(lane));
    const int g = lane >> 3, j = lane & 7;
    for (int s = sc.first_slice; s < 8; s += sc.nslices_step)
        for (int tile = sc.rank; tile < T / 64; tile += sc.nloc) {
            const size_t t0 = (size_t)tile * 64 + wave * 8;
            v4u hqn = *(const GAS v4u*)(Q.HQ + t0 * 1024 + 128 * s + 16 * j), exn[4];
#pragma unroll
            for (int i = 0; i < 4; ++i) exn[i] = *(const GAS v4u*)(Q.EX + t0 * 128 + 16 * g + 4 * i);
#pragma unroll 1
            for (int k = 0; k < 8; ++k) {
                const size_t t = t0 + k;
                const v4u hq = hqn; v4u ex[4];
#pragma unroll
                for (int i = 0; i < 4; ++i) ex[i] = exn[i];
                if (k + 1 < 8) {
                    hqn = *(const GAS v4u*)(Q.HQ + (t + 1) * 1024 + 128 * s + 16 * j);
#pragma unroll
                    for (int i = 0; i < 4; ++i) exn[i] = *(const GAS v4u*)(Q.EX + (t + 1) * 128 + 16 * g + 4 * i);
                }
                v4u uu[16];
#pragma unroll
                for (int i = 0; i < 16; ++i) { const unsigned e = (i & 3) == 0 ? ex[i >> 2].x : (i & 3) == 1 ? ex[i >> 2].y : (i & 3) == 2 ? ex[i >> 2].z : ex[i >> 2].w;
                    uu[i] = *(const GAS v4u*)(Q.U8 + (size_t)e * 1024 + 128 * s + 16 * j); }
                int lo = 0, hi = 0;
#pragma unroll
                for (int i = 0; i < 16; ++i) {
                    int p = __builtin_amdgcn_sdot4((int)uu[i].x, (int)hq.x, 0, false); p = __builtin_amdgcn_sdot4((int)uu[i].y, (int)hq.y, p, false); p = __builtin_amdgcn_sdot4((int)uu[i].z, (int)hq.z, p, false); p = __builtin_amdgcn_sdot4((int)uu[i].w, (int)hq.w, p, false);
                    p += __builtin_amdgcn_update_dpp(0, p, 0xB1, 0xF, 0xF, true); p += __builtin_amdgcn_update_dpp(0, p, 0x4E, 0xF, 0xF, true); p += __builtin_amdgcn_update_dpp(0, p, 0x141, 0xF, 0xF, true);
                    if (i < 8) lo = (j == i) ? p : lo; else hi = (j == i - 8) ? p : hi;
                }
                GAS int* prow = Q.P + t * 128 + 16 * g + j;
                (void)__hip_atomic_fetch_add(prow, lo, __ATOMIC_RELAXED, __HIP_MEMORY_SCOPE_AGENT); (void)__hip_atomic_fetch_add(prow + 8, hi, __ATOMIC_RELAXED, __HIP_MEMORY_SCOPE_AGENT);
            }
        }
}
__device__ __forceinline__ void peer_w(const GAS int* EX, const GAS float* GW, const GAS int* P, const GAS float* SH, const GAS float* SU, const GAS float* SV, GAS signed char* WQ, GAS float* WSC, int gw, int NGW, int lane) {
    asm volatile("" : "+v"(lane));
    for (int t = gw; t < T; t += NGW) {
        const float sh = SH[t];
#pragma unroll
        for (int q = 0; q < 2; ++q) { const size_t idx = (size_t)t * 128 + lane + 64 * q; const int e = EX[idx];
            const float w = GW[idx] * gelu_erf((float)P[idx] * (sh * SU[e])) * SV[e];
            float m = __builtin_fabsf(w);
            m = fmaxf(m, __builtin_bit_cast(float, __builtin_amdgcn_update_dpp(0, __builtin_bit_cast(int, m), 0xB1, 0xF, 0xF, true)));
            m = fmaxf(m, __builtin_bit_cast(float, __builtin_amdgcn_update_dpp(0, __builtin_bit_cast(int, m), 0x4E, 0xF, 0xF, true)));
            m = fmaxf(m, __builtin_bit_cast(float, __builtin_amdgcn_update_dpp(0, __builtin_bit_cast(int, m), 0x141, 0xF, 0xF, true)));
            m = fmaxf(m, __builtin_bit_cast(float, __builtin_amdgcn_update_dpp(0, __builtin_bit_cast(int, m), 0x140, 0xF, 0xF, true)));
            const float inv = m > 0.f ? 127.f / m : 0.f;
            WQ[idx] = (signed char)(int)__builtin_rintf(w * inv);
            if ((lane & 15) == 0) WSC[(size_t)t * 8 + (lane >> 4) + 4 * q] = m * (1.f / 127.f); }
    }
}
__device__ __forceinline__ void tr4x4(unsigned r0, unsigned r1, unsigned r2, unsigned r3, unsigned (&t)[4]) {
    const unsigned x0 = __builtin_amdgcn_perm(r1, r0, 0x05010400u), x1 = __builtin_amdgcn_perm(r1, r0, 0x07030602u), y0 = __builtin_amdgcn_perm(r3, r2, 0x05010400u), y1 = __builtin_amdgcn_perm(r3, r2, 0x07030602u);
    t[0] = __builtin_amdgcn_perm(y0, x0, 0x05040100u); t[1] = __builtin_amdgcn_perm(y0, x0, 0x07060302u); t[2] = __builtin_amdgcn_perm(y1, x1, 0x05040100u); t[3] = __builtin_amdgcn_perm(y1, x1, 0x07060302u);
}
struct Peer2P { const GAS int* EX; const GAS signed char* WQ; const GAS float* WSC; const GAS unsigned char* V8; GAS float* X; };
__device__ __forceinline__ void peer_k2(const Peer2P& Q, const PeerS& sc, int wave, int lane) {
    asm volatile("" : "+v"(lane));
    const int g = lane >> 3, j = lane & 7, hf = lane >> 5, rp = (lane >> 4) & 1;
    for (int s = sc.first_slice; s < 8; s += sc.nslices_step)
        for (int tile = sc.rank; tile < T / 64; tile += sc.nloc) {
            const size_t t0 = (size_t)tile * 64 + wave * 8;
            v4u exn[4], wqn; float swn;
#pragma unroll
            for (int i = 0; i < 4; ++i) exn[i] = *(const GAS v4u*)(Q.EX + t0 * 128 + 16 * g + 4 * i);
            wqn = *(const GAS v4u*)(Q.WQ + t0 * 128 + 16 * g); swn = Q.WSC[t0 * 8 + g];
#pragma unroll 1
            for (int k = 0; k < 8; ++k) {
                const size_t t = t0 + k;
                v4u ex[4]; const v4u wq = wqn; const float sw = swn;
#pragma unroll
                for (int i = 0; i < 4; ++i) ex[i] = exn[i];
                if (k + 1 < 8) {
#pragma unroll
                    for (int i = 0; i < 4; ++i) exn[i] = *(const GAS v4u*)(Q.EX + (t + 1) * 128 + 16 * g + 4 * i);
                    wqn = *(const GAS v4u*)(Q.WQ + (t + 1) * 128 + 16 * g); swn = Q.WSC[(t + 1) * 8 + g];
                }
                GAS f32x4* xp = (GAS f32x4*)(Q.X + t * 1024 + 128 * s + 16 * j + 8 * hf + 4 * rp);
                const f32x4 xold = *xp;
                v4u vv[16];
#pragma unroll
                for (int i = 0; i < 16; ++i) { const unsigned e = (i & 3) == 0 ? ex[i >> 2].x : (i & 3) == 1 ? ex[i >> 2].y : (i & 3) == 2 ? ex[i >> 2].z : ex[i >> 2].w;
                    vv[i] = *(const GAS v4u*)(Q.V8 + (size_t)e * 1024 + 128 * s + 16 * j); }
                int ai[16];
#pragma unroll
                for (int i = 0; i < 16; ++i) ai[i] = 0;
#pragma unroll
                for (int q4_ = 0; q4_ < 4; ++q4_) {
                    const unsigned wq4 = q4_ == 0 ? wq.x : q4_ == 1 ? wq.y : q4_ == 2 ? wq.z : wq.w;
#pragma unroll
                    for (int c = 0; c < 4; ++c) { unsigned tt[4];
                        const v4u &a0 = vv[4 * q4_], &a1 = vv[4 * q4_ + 1], &a2 = vv[4 * q4_ + 2], &a3 = vv[4 * q4_ + 3];
                        tr4x4(c == 0 ? a0.x : c == 1 ? a0.y : c == 2 ? a0.z : a0.w, c == 0 ? a1.x : c == 1 ? a1.y : c == 2 ? a1.z : a1.w, c == 0 ? a2.x : c == 1 ? a2.y : c == 2 ? a2.z : a2.w, c == 0 ? a3.x : c == 1 ? a3.y : c == 2 ? a3.z : a3.w, tt);
#pragma unroll
                        for (int b = 0; b < 4; ++b) ai[4 * c + b] = __builtin_amdgcn_sdot4((int)tt[b], (int)wq4, ai[4 * c + b], false); }
                }
                float acc[16];
#pragma unroll
                for (int i = 0; i < 16; ++i) acc[i] = (float)ai[i] * sw;
                float r8[8], r4[4];
#pragma unroll
                for (int m = 0; m < 8; ++m) { float a = acc[m], b = acc[m + 8]; swap32(a, b); r8[m] = a + b; }
#pragma unroll
                for (int n = 0; n < 4; ++n) { float a = r8[n], b = r8[n + 4]; asm volatile("v_nop\n\tv_nop\n\tv_permlane16_swap_b32 %0, %1" : "+v"(a), "+v"(b)); r4[n] = a + b; }
#pragma unroll
                for (int n = 0; n < 4; ++n) r4[n] += __builtin_bit_cast(float, __builtin_amdgcn_update_dpp(0, __builtin_bit_cast(int, r4[n]), 0x128, 0xF, 0xF, true));
                if ((lane & 8) == 0) *xp = xold + (f32x4){r4[0], r4[1], r4[2], r4[3]};
            }
        }
}

struct Args { const float* in[33]; float* out; unsigned char* ws; int ph_lo, ph_hi; };
struct Frame { LAS unsigned char* lds; volatile LAS unsigned* MISC; gu32* ctl; int tid, lane, wave, G, vcu, xcc, xrank; };

__device__ __forceinline__ void transpose_item(const float* W, int ldw, int nsrc0, bf16* WT, int ldt, int rdst0, LAS float* scr, int kb, int nb, int lane, float scale, const float* kgain) {
    const int k0 = 64 * kb, n0 = 32 * nb;
#pragma unroll 8
    for (int i = 0; i < 32; ++i) { const int kk = 2 * i + (lane >> 5); const float gsc = kgain ? kgain[k0 + kk] * scale : scale; scr[kk * 33 + (lane & 31)] = W[(size_t)(k0 + kk) * ldw + nsrc0 + n0 + (lane & 31)] * gsc; }
    LDS_WAIT(); asm volatile("" ::: "memory");
    const int c = lane & 7;
#pragma unroll
    for (int j = 0; j < 4; ++j) { const int n = (lane >> 3) + 8 * j; const LAS float* s = scr + (8 * c) * 33 + n;
        v4u o; o.x = pk2(s[0 * 33], s[1 * 33]); o.y = pk2(s[2 * 33], s[3 * 33]); o.z = pk2(s[4 * 33], s[5 * 33]); o.w = pk2(s[6 * 33], s[7 * 33]);
        *(GAS v4u*)(WT + (size_t)(rdst0 + n0 + n) * ldt + k0 + 8 * c) = o; }
    LDS_WAIT(); asm volatile("" ::: "memory");
}
__device__ __forceinline__ void zero_rect(bf16* base, int ld, int row0, int nrows, int col0, int ncols, int gtid, int gthreads) {
    const int vpr = ncols / 8;
    for (int i = gtid; i < nrows * vpr; i += gthreads) { const int r = i / vpr, c = i % vpr; *(GAS v4u*)(base + (size_t)(row0 + r) * ld + col0 + 8 * c) = (v4u){0u, 0u, 0u, 0u}; }
}

__device__ __forceinline__ void p0_prologue(Frame& F, const Args& a) {
    LAS float* scr = (LAS float*)(F.lds + RING_OFF + F.wave * 16384);
    const int gw = blockIdx.x * NWAVES + F.wave, NGW = F.G * NWAVES;
    const int gtid = blockIdx.x * (NWAVES * 64) + F.tid, gthreads = F.G * NWAVES * 64;
    unsigned char* ws = a.ws;
    { const GAS f32x4* src = (const GAS f32x4*)a.in[0]; GAS f32x4* dst = (GAS f32x4*)a.out; const size_t n4 = (size_t)T * D / 4;
      for (size_t i = gtid; i < n4; i += (size_t)gthreads) dst[i] = src[i]; }
    constexpr int I_IN = 16 * (INW / 32), I_SQ = 16 * 32, I_CKV = 16 * 64, I_UQ = 3 * 12, I_UKV = 2 * 16, I_L = I_IN + 4 * I_SQ + I_CKV + I_UQ + I_UKV;
    for (int it = gw; it < L * I_L; it += NGW) {
        const int l = it / I_L; int r = it % I_L;
        if (r < I_IN) {
            const int kb = r / 67, nb = r % 67; int src, dst; float sc = 1.f;
            if (nb < 6) { src = 32 * nb; dst = src; } else if (nb < 11) { src = 32 * nb; dst = src + 64; } else { src = 32 * nb; dst = src + 160; if (nb >= 43 && nb < 51) sc = 0.17677669529663687f * LOG2E; }
            transpose_item(a.in[5] + (size_t)l * D * INW, INW, src, (bf16*)(ws + WS_WIN) + (size_t)l * INP * D, D, dst, scr, kb, 0, F.lane, sc, nullptr); continue; } r -= I_IN;
        if (r < I_SQ) { transpose_item(a.in[21] + (size_t)l * D * D, D, 0, (bf16*)(ws + WS_WOUT) + (size_t)l * D * D, D, 0, scr, r / 32, r % 32, F.lane, 1.f, nullptr); continue; } r -= I_SQ;
        if (r < I_SQ) { transpose_item(a.in[24] + (size_t)l * D * D, D, 0, (bf16*)(ws + WS_WCQ) + (size_t)l * D * D, D, 0, scr, r / 32, r % 32, F.lane, 0.0625f * LOG2E, nullptr); continue; } r -= I_SQ;
        if (r < I_SQ) { transpose_item(a.in[26] + (size_t)l * D * D, D, 0, (bf16*)(ws + WS_WCO) + (size_t)l * D * D, D, 0, scr, r / 32, r % 32, F.lane, 1.f, nullptr); continue; } r -= I_SQ;
        if (r < I_SQ) { transpose_item(a.in[28] + (size_t)l * D * D, D, 0, (bf16*)(ws + WS_WPQ) + (size_t)l * D * D, D, 0, scr, r / 32, r % 32, F.lane, 1.f, nullptr); continue; } r -= I_SQ;
        if (r < I_CKV) { transpose_item(a.in[25] + (size_t)l * D * 2 * D, 2 * D, 0, (bf16*)(ws + WS_WCKV) + (size_t)l * 2 * D * D, D, 0, scr, r / 64, r % 64, F.lane, 1.f, nullptr); continue; } r -= I_CKV;
        if (r < I_UQ) { transpose_item(a.in[7] + (size_t)l * 192 * 384, 384, 0, (bf16*)(ws + WS_WUQ) + (size_t)l * 512 * 256, 256, 0, scr, r / 12, r % 12, F.lane, 0.10206207261596575f * LOG2E, a.in[6] + l * 192); continue; } r -= I_UQ;
        transpose_item(a.in[9] + (size_t)l * 128 * 512, 512, 0, (bf16*)(ws + WS_WUKV) + (size_t)l * 512 * 256, 256, 0, scr, r / 16, r % 16, F.lane, 1.f, a.in[8] + l * 128);
    }
    for (int l = 0; l < L; ++l) {
        bf16* win = (bf16*)(ws + WS_WIN) + (size_t)l * INP * D; bf16* wuq = (bf16*)(ws + WS_WUQ) + (size_t)l * 512 * 256; bf16* wukv = (bf16*)(ws + WS_WUKV) + (size_t)l * 512 * 256;
        zero_rect(win, D, 192, 64, 0, D, gtid, gthreads); zero_rect(win, D, 416, 96, 0, D, gtid, gthreads);
        zero_rect(wuq, 256, 0, 384, 192, 64, gtid, gthreads); zero_rect(wuq, 256, 384, 128, 0, 256, gtid, gthreads);
        zero_rect(wukv, 256, 0, 512, 128, 128, gtid, gthreads);
    }
    { float* rope = (float*)(ws + WS_ROPE); const int* pos = (const int*)a.in[2];
      for (int i = gtid; i < T * 16; i += gthreads) { const int t = i >> 4, k = i & 15; const float inv = powf(10000.f, -(float)(2 * k) / 32.f); const float ang = (float)pos[t] * inv;
          rope[(size_t)t * 32 + k] = cosf(ang); rope[(size_t)t * 32 + 16 + k] = sinf(ang); } }
    { const GAS f32x4* ks = (const GAS f32x4*)a.in[29]; GAS v2u* kd = (GAS v2u*)(ws + WS_KEYS);
      for (int i = gtid; i < L * 2 * 128 * 64 / 4; i += gthreads) { const f32x4 v = ks[i]; v2u w; w.x = pk2(v.x, v.y); w.y = pk2(v.z, v.w); kd[i] = w; }
    }
    for (int r = gw; r < 2 * L * 16384; r += NGW) { const int tb = r / (L * 16384), rr = r % (L * 16384);
        quant_row((const GAS float*)a.in[30 + tb] + (size_t)rr * 1024, (GAS unsigned*)(ws + (tb ? WS_V8 : WS_U8) + (size_t)rr * 1024), (GAS float*)(ws + (tb ? WS_SV : WS_SU)) + rr, 0, F.lane); }
    { float* btab = (float*)(ws + WS_BTAB); float* lams = (float*)(ws + WS_LAMS); float* spt = (float*)(ws + WS_SP);
      for (int i = gtid; i < 4 * 129; i += gthreads) { const int h = i / 129, n = i % 129; int bu; if (n < 16) bu = n; else { const int lg = 16 + (int)(logf((float)n / 16.f) / logf(8.f) * 16.f); bu = lg < 31 ? lg : 31; }
          btab[i] = a.in[3][bu * 4 + h] * LOG2E; }
      for (int i = gtid; i < L; i += gthreads) { const float* dl = a.in[17] + i * 128; float s1 = 0.f, s2 = 0.f; for (int j = 0; j < 32; ++j) { s1 += dl[j] * dl[32 + j]; s2 += dl[64 + j] * dl[96 + j]; }
          const float li = 0.8f - 0.6f * expf(-0.3f * (float)i); lams[2 * i] = expf(s1) - expf(s2) + li; lams[2 * i + 1] = li; }
      for (int i = gtid; i < L * 512; i += gthreads) spt[i] = log1pf(expf(-a.in[16][i])); }
    for (int l = 0; l < L; ++l) norm_phase((const GAS float*)a.in[1], (const GAS float*)a.in[23] + l * D, (GAS bf16*)(ws + WS_MNB) + (size_t)l * NB * MEM * D, NB * MEM, gw, NGW, F.lane);
}

constexpr int NPL = 16, PH_FINAL = 2 + NPL * L;
__global__ void __launch_bounds__(NWAVES * 64, 2) fwd(Args args) {
    extern __shared__ __attribute__((aligned(16))) unsigned char lds[];
    Frame F;
    F.lds = (LAS unsigned char*)lds; F.MISC = (volatile LAS unsigned*)(F.lds + MISC_OFF);
    F.tid = threadIdx.x; F.lane = F.tid & 63; F.wave = __builtin_amdgcn_readfirstlane(F.tid >> 6); F.G = gridDim.x;
    F.vcu = (F.G % 8 == 0) ? ((int)blockIdx.x % 8) * (F.G / 8) + (int)blockIdx.x / 8 : (int)blockIdx.x;
    unsigned char* ws = args.ws;
    F.ctl = (gu32*)(opq(ws) + WS_CTL);
    for (int u = F.tid; u < (LDS_BYTES - LDSCTL_OFF) / 4; u += NWAVES * 64) ((LAS unsigned*)(F.lds + LDSCTL_OFF))[u] = 0u;
    __syncthreads();
    XcdBarrier bar = xcd_barrier_post((unsigned*)(F.ctl + CW_BAR), F.MISC + 8);
    F.xcc = (int)bar.x;
    if (F.tid == 0) F.MISC[12] = __hip_atomic_fetch_add((unsigned*)(F.ctl + CW_RANK) + 64 * bar.x, 1u, __ATOMIC_RELAXED, __HIP_MEMORY_SCOPE_AGENT);
    __syncthreads();
    F.xrank = __builtin_amdgcn_readfirstlane((int)F.MISC[12]);
    const int lo = args.ph_lo, hi = args.ph_hi;
    const int gw = blockIdx.x * NWAVES + F.wave, NGW = F.G * NWAVES;
#define IN(k) (lo <= (k) && (k) < hi)
#define LANE_ (lane_id_v())
#define TID_ ((opqi(F.wave) << 6) | LANE_)
#define SITE() const int G_ = opqi(F.G), wv_ = opqi(F.wave), vcu_ = opqi(F.vcu), gw_ = opqi(gw), NGW_ = opqi(NGW); (void)G_; (void)wv_; (void)vcu_; (void)gw_; (void)NGW_
#define SEAM(k) do { if (IN(k) && IN((k) + 1)) xcd_barrier(bar, (F.wave == 0 && lane_id_v() == 0) ? 1 : 0); } while (0)
#define GEMM_SITE(EPI, Aptr, lda_, Bptr, ldb_, M_, N_, K_, cperm, ...) do { \
        pg8::Gemm g{opq(Aptr), opq(Bptr), M_, N_, K_, lda_, ldb_}; pg8::StaticOrder So; So.init(M_, N_, opqi(F.G), opqi(cperm)); pg8::EPI E{__VA_ARGS__}; \
        pg8::gemm_phase<pg8::EPI, pg8::StaticOrder, true, true>(F.lds + RING_OFF, g, So, E, opqi(F.wave)); } while (0)
    if (IN(0)) { p0_prologue(F, args); }
    SEAM(0);
    if (IN(1)) {
#pragma unroll 1
        for (int l = 0; l < L; ++l)
            GEMM_SITE(EpiBf16, (const GAS bf16*)(opq(ws) + WS_MNB) + (size_t)l * NB * MEM * D, D, (const GAS bf16*)(opq(ws) + WS_WCKV) + (size_t)l * 2 * D * D, D, NB * MEM, 2 * D, D, (int)((blockIdx.x + 64 * l) % F.G),
                      opq((GAS bf16*)(opq(ws) + WS_KVCB) + (size_t)l * NB * MEM * 2 * D), 2 * D, 2 * D);
    }
    SEAM(1);
    for (int l = 0; l < L; ++l) {
        const int pb = 2 + NPL * l;
        const GAS bf16* XNB = (const GAS bf16*)(opq(ws) + WS_XNB); const GAS bf16* YB = (const GAS bf16*)(opq(ws) + WS_YB); GAS bf16* PROJB = (GAS bf16*)(opq(ws) + WS_PROJB);
        if (IN(pb + 0)) { SITE(); norm_phase((GAS float*)args.out, (const GAS float*)args.in[opqi(4)] + l * D, opq((GAS bf16*)(opq(ws) + WS_XNB)), T, gw_, NGW_, LANE_); }
        SEAM(pb + 0);
        if (IN(pb + 1)) GEMM_SITE(EpiBf16, XNB, D, (const GAS bf16*)(opq(ws) + WS_WIN) + (size_t)l * INP * D, D, T, INP, D, (int)blockIdx.x, opq(PROJB), INP, INP);
        SEAM(pb + 1);
        if (IN(pb + 2)) {
            SITE();
            pre_phase(opq((const GAS bf16*)PROJB), opq((const GAS float*)(opq(ws) + WS_ROPE)), opq((GAS float*)(opq(ws) + WS_RS)), opq((GAS bf16*)(opq(ws) + WS_KMB)), gw_, NGW_, LANE_);
            LruP LP{opq((const GAS bf16*)PROJB), (const GAS float*)args.in[opqi(10)] + l * 4 * 512, (const GAS float*)args.in[opqi(11)] + l * 512, (const GAS float*)args.in[opqi(12)] + (size_t)l * 8 * 4096, (const GAS float*)args.in[opqi(13)] + l * 512, (const GAS float*)args.in[opqi(14)] + (size_t)l * 8 * 4096, (const GAS float*)args.in[opqi(15)] + l * 512,
                    (const GAS float*)(opq(ws) + WS_SP) + l * 512, opq((GAS bf16*)(opq(ws) + WS_HLB)), opq((GAS bf16*)(opq(ws) + WS_ACB)), opq((GAS float*)(opq(ws) + WS_LSUM))};
            lru_phase(LP, F.lds, TID_, wv_, LANE_, vcu_, G_);
#if MK_DUP == 2
            lru_phase(LP, F.lds, TID_, wv_, LANE_, vcu_, G_);
#endif
        }
        SEAM(pb + 2);
        if (IN(pb + 3)) {
            GEMM_SITE(EpiUp, (const GAS bf16*)PROJB + PC_CQ, INP, (const GAS bf16*)(opq(ws) + WS_WUQ) + (size_t)l * 512 * 256, 256, T, 512, 256, (int)blockIdx.x,
                      opq((GAS bf16*)(opq(ws) + WS_QMB)), (GAS bf16*)nullptr, 384, 384, opq((const GAS float*)(opq(ws) + WS_RS)), 0, 0);
            GEMM_SITE(EpiUp, (const GAS bf16*)PROJB + PC_CKV, INP, (const GAS bf16*)(opq(ws) + WS_WUKV) + (size_t)l * 512 * 256, 256, T, 512, 256, (int)blockIdx.x,
                      opq((GAS bf16*)(opq(ws) + WS_KMB)), opq((GAS bf16*)(opq(ws) + WS_VMB)), 0, 512, opq((const GAS float*)(opq(ws) + WS_RS)), 1, 1);
        }
        SEAM(pb + 3);
        if (IN(pb + 4)) {
            SITE();
            AttnP PM{opq((const GAS bf16*)(opq(ws) + WS_QMB)), opq((const GAS bf16*)(opq(ws) + WS_KMB)), opq((const GAS bf16*)(opq(ws) + WS_VMB)), 384, 384, 256, opq((GAS bf16*)(opq(ws) + WS_OMB)), 256, opq((const GAS float*)(opq(ws) + WS_ROPE)), nullptr, nullptr, nullptr, nullptr};
            AttnP PD{opq((const GAS bf16*)PROJB + PC_QD), opq((const GAS bf16*)PROJB + PC_KD), opq((const GAS bf16*)PROJB + PC_VD), INP, INP, INP, opq((GAS bf16*)(opq(ws) + WS_YB) + 768), 1024, nullptr,
                     (const GAS int*)args.in[opqi(2)], (const GAS float*)(opq(ws) + WS_BTAB), (const GAS float*)args.in[opqi(18)] + l * 64, (const GAS float*)(opq(ws) + WS_LAMS) + 2 * l};
            attn_phase(PM, PD, F.lds, TID_, wv_, LANE_, vcu_, G_);
#if MK_DUP == 4
            __syncthreads(); attn_phase(PM, PD, F.lds, TID_, wv_, LANE_, vcu_, G_);
#elif MK_DUP == 40 || MK_DUP == 41
            __syncthreads(); attn_phase(PM, PD, F.lds, TID_, wv_, LANE_, vcu_, G_, MK_DUP - 40);
#endif
        }
        SEAM(pb + 4);
        if (IN(pb + 5)) {
            SITE();
            PostP PP{opq((const GAS bf16*)(opq(ws) + WS_OMB)), opq((const GAS bf16*)(opq(ws) + WS_HLB)), opq((const GAS bf16*)(opq(ws) + WS_ACB)), opq((const GAS float*)(opq(ws) + WS_LSUM)), opq((const GAS bf16*)PROJB), (const GAS float*)args.in[opqi(19)] + l * 256, (const GAS float*)args.in[opqi(20)] + l * 512, opq((GAS bf16*)(opq(ws) + WS_YB))};
            post_phase(PP, F.lds, TID_, wv_, LANE_, vcu_, G_);
        }
        SEAM(pb + 5);
        if (IN(pb + 6)) GEMM_SITE(EpiF32, YB, D, (const GAS bf16*)(opq(ws) + WS_WOUT) + (size_t)l * D * D, D, T, D, D, (int)blockIdx.x, opq((GAS float*)args.out), D, D, 1);
        SEAM(pb + 6);
        if (IN(pb + 7)) { SITE(); norm_phase((GAS float*)args.out, (const GAS float*)args.in[opqi(22)] + l * D, opq((GAS bf16*)(opq(ws) + WS_XNB)), T, gw_, NGW_, LANE_); }
        SEAM(pb + 7);
        if (IN(pb + 8)) GEMM_SITE(EpiBf16, XNB, D, (const GAS bf16*)(opq(ws) + WS_WCQ) + (size_t)l * D * D, D, T, D, D, (int)blockIdx.x, opq(PROJB), D, D);
        SEAM(pb + 8);
        if (IN(pb + 9)) {
            SITE();
            const GAS bf16* kv = (const GAS bf16*)(opq(ws) + WS_KVCB) + (size_t)l * NB * MEM * 2 * D;
            AttnP PC{opq((const GAS bf16*)PROJB), opq(kv), opq(kv + D), 1024, 2 * D, 2 * D, opq((GAS bf16*)(opq(ws) + WS_YB)), 1024, nullptr, nullptr, nullptr, nullptr, nullptr};
            cross_phase(PC, F.lds, TID_, wv_, LANE_, vcu_, G_);
#if MK_DUP == 9
            cross_phase(PC, F.lds, TID_, wv_, LANE_, vcu_, G_);
#endif
        }
        SEAM(pb + 9);
        if (IN(pb + 10)) GEMM_SITE(EpiF32, YB, D, (const GAS bf16*)(opq(ws) + WS_WCO) + (size_t)l * D * D, D, T, D, D, (int)blockIdx.x, opq((GAS float*)args.out), D, D, 1);
        SEAM(pb + 10);
        if (IN(pb + 11)) { SITE(); norm_q_phase((GAS float*)args.out, (const GAS float*)args.in[opqi(27)] + l * D, opq((GAS bf16*)(opq(ws) + WS_XNB)), opq((GAS unsigned char*)(opq(ws) + WS_HQ)), opq((GAS float*)(opq(ws) + WS_SH)), opq((GAS int*)(opq(ws) + WS_P)), T, gw_, NGW_, LANE_); }
        SEAM(pb + 11);
        if (IN(pb + 12)) GEMM_SITE(EpiBf16, XNB, D, (const GAS bf16*)(opq(ws) + WS_WPQ) + (size_t)l * D * D, D, T, D, D, (int)blockIdx.x, opq(PROJB), D, D);
        SEAM(pb + 12);
        if (IN(pb + 13)) {
            SITE();
            RouteP RP{opq((const GAS bf16*)PROJB), opq((const GAS bf16*)(opq(ws) + WS_KEYS) + (size_t)l * 2 * 128 * 64), opq((GAS int*)(opq(ws) + WS_EX)), opq((GAS float*)(opq(ws) + WS_GW))};
            route_phase(RP, F.lds, TID_, wv_, LANE_, vcu_, G_);
#if MK_DUP == 13
            route_phase(RP, F.lds, TID_, wv_, LANE_, vcu_, G_);
#endif
        }
        SEAM(pb + 13);
        if (IN(pb + 14)) {
            SITE();
            const PeerS ps = peer_sched((const GAS unsigned*)(F.ctl + CW_RANK), opqi(F.xcc), opqi(F.xrank));
            Peer1P Q1{opq((const GAS unsigned char*)(opq(ws) + WS_HQ)), opq((const GAS int*)(opq(ws) + WS_EX)), opq((const GAS unsigned char*)(opq(ws) + WS_U8) + (size_t)l * 16384 * 1024), opq((GAS int*)(opq(ws) + WS_P))};
            peer_k1(Q1, ps, wv_, LANE_);
#if MK_DUP == 141
            { Peer1P Q1b = Q1; Q1b.P = (GAS int*)(opq(ws) + WS_PROJB); peer_k1(Q1b, ps, wv_, LANE_); }
#endif
        }
        SEAM(pb + 14);
        if (IN(pb + 15)) {
            SITE();
            peer_w(opq((const GAS int*)(opq(ws) + WS_EX)), opq((const GAS float*)(opq(ws) + WS_GW)), opq((const GAS int*)(opq(ws) + WS_P)), opq((const GAS float*)(opq(ws) + WS_SH)), opq((const GAS float*)(opq(ws) + WS_SU) + l * 16384), opq((const GAS float*)(opq(ws) + WS_SV) + l * 16384),
                   opq((GAS signed char*)(opq(ws) + WS_W)), opq((GAS float*)(opq(ws) + WS_WS)), gw_, NGW_, LANE_);
            xcd_barrier(bar, (F.wave == 0 && lane_id_v() == 0) ? 1 : 0);
            const PeerS ps = peer_sched((const GAS unsigned*)(F.ctl + CW_RANK), opqi(F.xcc), opqi(F.xrank));
            Peer2P Q2{opq((const GAS int*)(opq(ws) + WS_EX)), opq((const GAS signed char*)(opq(ws) + WS_W)), opq((const GAS float*)(opq(ws) + WS_WS)), opq((const GAS unsigned char*)(opq(ws) + WS_V8) + (size_t)l * 16384 * 1024), (GAS float*)args.out};
            peer_k2(Q2, ps, wv_, LANE_);
#if MK_DUP == 151
            { Peer2P Q2b = Q2; Q2b.X = (GAS float*)(opq(ws) + WS_PROJB); peer_k2(Q2b, ps, wv_, LANE_); }
#endif
        }
        SEAM(pb + 15);
    }
    if (IN(PH_FINAL)) { SITE(); final_norm_phase((GAS float*)args.out, (const GAS float*)args.in[opqi(32)], T, gw_, NGW_, LANE_); }
#undef IN
#undef SEAM
#undef GEMM_SITE
}
}
extern "C" void kernel_launch(void* const* d_in, const int* in_sizes, int n_in, void* d_out, int out_size, void* d_ws, size_t ws_size, hipStream_t stream) {
    (void)in_sizes; (void)out_size;
    static int grid = 0;
    if (grid == 0) {
        int dev = 0, cus = 0, per_cu = 0;
        if (n_in != 33 || ws_size < mk::WS_END) { fprintf(stderr, "kernel_launch: unexpected n_in %d / ws_size %zu\n", n_in, ws_size); grid = -1; return; }
        if (hipGetDevice(&dev) != hipSuccess || hipDeviceGetAttribute(&cus, hipDeviceAttributeMultiprocessorCount, dev) != hipSuccess) { grid = -1; return; }
        if (hipFuncSetAttribute((const void*)mk::fwd, hipFuncAttributeMaxDynamicSharedMemorySize, mk::LDS_BYTES) != hipSuccess) { fprintf(stderr, "kernel_launch: hipFuncSetAttribute failed\n"); grid = -1; return; }
        if (hipOccupancyMaxActiveBlocksPerMultiprocessor(&per_cu, (const void*)mk::fwd, mk::NWAVES * 64, mk::LDS_BYTES) != hipSuccess || per_cu < 1) fprintf(stderr, "kernel_launch: occupancy query says %d\n", per_cu);
        (void)hipGetLastError();
        grid = cus;
    }
    if (grid < 0) return;
    unsigned char* ws = (unsigned char*)d_ws;
    (void)hipMemsetAsync(ws + mk::WS_CTL, 0, mk::CTL_ZERO_BYTES, stream);
    mk::Args a{};
    for (int i = 0; i < 33; ++i) a.in[i] = (const float*)d_in[i];
    a.out = (float*)d_out; a.ws = ws;
    auto run = [&](int lo, int hi) { a.ph_lo = lo; a.ph_hi = hi; hipLaunchKernelGGL(mk::fwd, dim3(grid), dim3(mk::NWAVES * 64), mk::LDS_BYTES, stream, a); };
#if MK_ONE_LAUNCH
    run(0, mk::PH_FINAL + 1);
#else
    for (int p = 0; p <= mk::PH_FINAL; ++p) {
        const int k = (p - 2) % mk::NPL, l = (p - 2) / mk::NPL;
#if MK_NAIVE_PEER == 2
        if (p >= 2 && p < mk::PH_FINAL && k == 14) {
            hipLaunchKernelGGL(k_peer, dim3(T), dim3(256), 0, stream, (const bf16_t*)(ws + mk::WS_XNB), (const int*)(ws + mk::WS_EX), (const float*)(ws + mk::WS_GW), (const float*)d_in[30] + (size_t)l * NEXP * D, (const float*)d_in[31] + (size_t)l * NEXP * D, (float*)d_out);
            continue; }
#elif MK_NAIVE_PEER == 1
        if (p >= 2 && p < mk::PH_FINAL && k == 13) {
            float* TQ = (float*)(ws + (size_t)806 * mk::MiB);
            hipLaunchKernelGGL(k_bf2f, dim3((unsigned)(((size_t)T * D + 255) / 256)), dim3(256), 0, stream, (const bf16_t*)(ws + mk::WS_PROJB), TQ, (long)T * D);
            hipLaunchKernelGGL(k_route, dim3(T), dim3(256), 0, stream, TQ, (const float*)d_in[29] + (size_t)l * 2 * 128 * 64, (int*)(ws + mk::WS_EX), (float*)(ws + mk::WS_GW));
            hipLaunchKernelGGL(k_peer, dim3(T), dim3(256), 0, stream, (const bf16_t*)(ws + mk::WS_XNB), (const int*)(ws + mk::WS_EX), (const float*)(ws + mk::WS_GW), (const float*)d_in[30] + (size_t)l * NEXP * D, (const float*)d_in[31] + (size_t)l * NEXP * D, (float*)d_out);
            continue; }
        if (p >= 2 && p < mk::PH_FINAL && k == 14) continue;
#endif
        run(p, p + 1); }
#endif
}
```

```cpp
#include <hip/hip_runtime.h>
#include <cstdint>
#include <cstdio>
#include <cmath>

#ifndef MK_ONE_LAUNCH
#define MK_ONE_LAUNCH 1
#endif
#ifndef MK_DUP
#define MK_DUP 0
#endif
#ifndef MK_NAIVE_PEER
#define MK_NAIVE_PEER 0
#endif
namespace pg8 {
#define PG8_LAS __attribute__((address_space(3)))
#ifndef GAS
#define GAS __attribute__((address_space(1)))
#endif
typedef unsigned short bf16_t;
typedef short bf16x8 __attribute__((ext_vector_type(8)));
typedef float f32x4 __attribute__((ext_vector_type(4)));
typedef unsigned u32x4 __attribute__((ext_vector_type(4)));
typedef unsigned u32x2 __attribute__((ext_vector_type(2)));
constexpr int BM = 256, BK = 64, HALF = 128, HTB = HALF * BK * 2, STAGE_BYTES = 8 * HTB, NXCD = 8, WGM = 8;
__host__ __device__ __forceinline__ int lds_byte(int r, int c) { const int st = (r >> 4) * 2 + (c >> 5), rr = r & 15, cc = c & 31, ob = rr * 64 + cc * 2; return st * 1024 + (ob ^ (((ob >> 9) & 1) << 5)); }
__host__ __device__ __forceinline__ void stage_rc(int b, int& R, int& C) { const int st = b / 1024, sb = b % 1024, swz = sb ^ (((sb >> 9) & 1) << 5); R = (st >> 1) * 16 + swz / 64; C = (st & 1) * 32 + (swz % 64) / 2; }
__host__ __device__ __forceinline__ int perm32(int rho) { const int n = rho >> 4, i = rho & 15; return 8 * (i >> 2) + 4 * n + (i & 3); }
__device__ __forceinline__ int pg8_lane_id() { int l; asm volatile("v_mbcnt_lo_u32_b32 %0, -1, 0\n\tv_mbcnt_hi_u32_b32 %0, -1, %0" : "=v"(l)); return l; }
struct Unit { int pm, pn; };
struct Gemm { const GAS bf16_t* A; const GAS bf16_t* Bt; int M, N, K, lda, ldb; };
struct StaticOrder {
    int nM, nN, nwg, G, c;
    __host__ __device__ void init(int M, int N, int G_, int c_) { nM = M / BM; nN = N / BM; nwg = nM * nN; G = G_; c = c_; }
    __host__ __device__ bool next(int i, Unit& u) const {
        const long L = (long)i * G + c; if (L >= nwg) return false;
        int wgid = (int)L; { const int q = nwg / NXCD, r = nwg % NXCD, xcd = wgid % NXCD, off = wgid / NXCD; wgid = (xcd < r ? xcd * (q + 1) : r * (q + 1) + (xcd - r) * q) + off; }
        const int nig = WGM * nN, gid = wgid / nig, fm = gid * WGM, gsz = (nM - fm) < WGM ? (nM - fm) : WGM;
        u.pm = fm + ((wgid % nig) % gsz); u.pn = (wgid % nig) / gsz; return true;
    }
    __device__ __forceinline__ void a_ready(const Unit&) const {}
    __device__ __forceinline__ void done(const Unit&) const {}
};
__device__ __forceinline__ unsigned cvt_pk_bf16(float lo, float hi) { unsigned r; asm volatile("v_cvt_pk_bf16_f32 %0, %1, %2" : "=v"(r) : "v"(lo), "v"(hi)); return r; }

struct EpiF32 {
    static constexpr bool PERM = false, AFTER_DRAIN = false;
    GAS float* C; int ldc; int nvalid; int accum;
    __device__ __forceinline__ void operator()(const f32x4 (&acc)[2][2][4][2], const Unit& u, int wr, int wc, int fr, int fq) const {
        { const int l_ = pg8_lane_id(); fr = l_ & 15; fq = l_ >> 4; }
#pragma unroll
        for (int ai = 0; ai < 2; ++ai)
#pragma unroll
            for (int m = 0; m < 4; ++m) { const size_t row = (size_t)u.pm * BM + ai * HALF + wr * 64 + m * 16 + fr;
#pragma unroll
                for (int bj = 0; bj < 2; ++bj)
#pragma unroll
                    for (int n = 0; n < 2; ++n) { const int col = u.pn * BM + bj * HALF + wc * 32 + n * 16 + 4 * fq;
                        if (col < nvalid) { GAS float* p = C + row * ldc + col; f32x4 v = acc[ai][bj][m][n]; if (accum) v += *(const GAS f32x4*)p; *(GAS f32x4*)p = v; } } }
    }
};
struct EpiBf16 {
    static constexpr bool PERM = true, AFTER_DRAIN = false;
    GAS bf16_t* O; int ldc; int nvalid; const GAS float* ssq; int np;
    __device__ __forceinline__ void operator()(const f32x4 (&acc)[2][2][4][2], const Unit& u, int wr, int wc, int fr, int fq) const {
        { const int l_ = pg8_lane_id(); fr = l_ & 15; fq = l_ >> 4; }
#pragma unroll
        for (int ai = 0; ai < 2; ++ai)
#pragma unroll
            for (int m = 0; m < 4; ++m) { const size_t row = (size_t)u.pm * BM + ai * HALF + wr * 64 + m * 16 + fr;
                float rs_ = 1.f;
                if (np > 0) { const GAS f32x4* sp = (const GAS f32x4*)(ssq + row * 16); f32x4 t = sp[0] + sp[1]; if (np > 8) t += sp[2] + sp[3]; rs_ = __builtin_amdgcn_rsqf(((t[0] + t[1]) + (t[2] + t[3])) * (1.f / 1024.f) + 1e-6f); }
#pragma unroll
                for (int bj = 0; bj < 2; ++bj) { const int col = u.pn * BM + bj * HALF + wc * 32 + 8 * fq;
                    if (col < nvalid) { const f32x4 v0 = acc[ai][bj][m][0] * rs_, v1 = acc[ai][bj][m][1] * rs_; u32x4 w; w.x = cvt_pk_bf16(v0[0], v0[1]); w.y = cvt_pk_bf16(v0[2], v0[3]); w.z = cvt_pk_bf16(v1[0], v1[1]); w.w = cvt_pk_bf16(v1[2], v1[3]);
                        *(GAS u32x4*)(O + row * ldc + col) = w; } } }
    }
};
struct EpiUp {
    static constexpr bool PERM = true, AFTER_DRAIN = false;
    GAS bf16_t* O; GAS bf16_t* O2; int ldc; int nvalid; const GAS float* rs; int rsi; int mode;
    __device__ __forceinline__ void operator()(const f32x4 (&acc)[2][2][4][2], const Unit& u, int wr, int wc, int fr, int fq) const {
        { const int l_ = pg8_lane_id(); fr = l_ & 15; fq = l_ >> 4; }
#pragma unroll
        for (int ai = 0; ai < 2; ++ai)
#pragma unroll
            for (int m = 0; m < 4; ++m) { const size_t row = (size_t)u.pm * BM + ai * HALF + wr * 64 + m * 16 + fr; const float s = rs[2 * row + rsi];
#pragma unroll
                for (int bj = 0; bj < 2; ++bj) { const int col = u.pn * BM + bj * HALF + wc * 32 + 8 * fq;
                    if (col < nvalid) { const f32x4 v0 = acc[ai][bj][m][0] * s, v1 = acc[ai][bj][m][1] * s; u32x4 w; w.x = cvt_pk_bf16(v0[0], v0[1]); w.y = cvt_pk_bf16(v0[2], v0[3]); w.z = cvt_pk_bf16(v1[0], v1[1]); w.w = cvt_pk_bf16(v1[2], v1[3]);
                        GAS bf16_t* dst;
                        if (mode == 0) dst = O + row * ldc + col;
                        else { const int h = col >> 7, j = col & 127; dst = (j < 64) ? O + row * 384 + h * 96 + j : O2 + row * 256 + h * 64 + (j - 64); }
                        *(GAS u32x4*)dst = w; } } }
    }
};

struct EpiRes {
    static constexpr bool PERM = false, AFTER_DRAIN = false;
    const GAS float* src; GAS float* dst; GAS bf16_t* XB; GAS float* SSQ;
    __device__ __forceinline__ void operator()(const f32x4 (&acc)[2][2][4][2], const Unit& u, int wr, int wc, int fr, int fq) const {
        { const int l_ = pg8_lane_id(); fr = l_ & 15; fq = l_ >> 4; }
#pragma unroll
        for (int ai = 0; ai < 2; ++ai)
#pragma unroll
            for (int m = 0; m < 4; ++m) { const size_t row = (size_t)u.pm * BM + ai * HALF + wr * 64 + m * 16 + fr; float ss = 0.f;
#pragma unroll
                for (int bj = 0; bj < 2; ++bj)
#pragma unroll
                    for (int n = 0; n < 2; ++n) { const size_t o = row * 1024 + u.pn * BM + bj * HALF + wc * 32 + n * 16 + 4 * fq;
                        const f32x4 v = acc[ai][bj][m][n] + *(const GAS f32x4*)(src + o); *(GAS f32x4*)(dst + o) = v;
                        u32x2 w; w.x = cvt_pk_bf16(v[0], v[1]); w.y = cvt_pk_bf16(v[2], v[3]); *(GAS u32x2*)(XB + o) = w;
                        ss += (v[0] * v[0] + v[1] * v[1]) + (v[2] * v[2] + v[3] * v[3]); }
                { float a = ss, b = ss; asm volatile("v_nop\n\tv_nop\n\tv_permlane16_swap_b32 %0, %1" : "+v"(a), "+v"(b)); ss = a + b; }
                { float a = ss, b = ss; asm volatile("v_nop\n\tv_nop\n\tv_permlane32_swap_b32 %0, %1" : "+v"(a), "+v"(b)); ss = a + b; }
                if (fq == 0) SSQ[row * 16 + 4 * u.pn + wc] = ss; }
    }
};
template <class Epi, class Sched, bool ALIGN_EPI = false, bool SP2 = false>
__device__ __forceinline__ void gemm_phase(PG8_LAS unsigned char* lds, const Gemm g, const Sched& S, const Epi& E, int wave_id) {
    int tid_ = (wave_id << 6) | pg8_lane_id(); asm volatile("" : "+v"(tid_));
    const int tid = tid_, wid = __builtin_amdgcn_readfirstlane(tid >> 6), lane = tid & 63, wr = wid >> 2, wc = wid & 3, fr = lane & 15, fq = lane >> 4;
    const int K = g.K, nt = K / BK;
    unsigned voffA[2], voffB[2];
#pragma unroll
    for (int i = 0; i < 2; ++i) { int R, C; stage_rc(tid * 16 + i * 8192, R, C); const int Rb = Epi::PERM ? ((R & ~31) + perm32(R & 31)) : R;
        voffA[i] = (unsigned)(R * g.lda + C) * 2u; voffB[i] = (unsigned)(Rb * g.ldb + C) * 2u; }
    const size_t kstep = (size_t)(BK * 2);
    const size_t hstepA = (size_t)HALF * g.lda * 2, hstepB = (size_t)HALF * g.ldb * 2;
    const size_t tstepA = 2 * hstepA, tstepB = 2 * hstepB;
    const unsigned ldsw = (unsigned)wid * 1024u;
    const int aoff = lds_byte(wr * 64 + fr, fq * 8), boff = lds_byte(wc * 32 + fr, fq * 8);
#define PG8_SA(b, h) (((b) * 2 + (h)) * HTB)
#define PG8_SB(b, h) ((4 + (b) * 2 + (h)) * HTB)
#define PG8_STAGE(bufoff, gbase, voff) do { _Pragma("unroll") for (int _i = 0; _i < 2; ++_i) \
        __builtin_amdgcn_global_load_lds((const unsigned*)((const char*)(gbase) + (voff)[_i]), (PG8_LAS unsigned*)(lds + (bufoff) + ldsw + _i * 8192), 16, 0, 0); } while (0)
#define PG8_LDA(dst, b, h) do { _Pragma("unroll") for (int m = 0; m < 4; ++m) _Pragma("unroll") for (int k = 0; k < 2; ++k) dst[m][k] = *(const PG8_LAS bf16x8*)(lds + PG8_SA(b, h) + aoff + m * 2048 + k * 1024); } while (0)
#define PG8_LDB(dst, b, h) do { _Pragma("unroll") for (int n = 0; n < 2; ++n) _Pragma("unroll") for (int k = 0; k < 2; ++k) dst[n][k] = *(const PG8_LAS bf16x8*)(lds + PG8_SB(b, h) + boff + n * 2048 + k * 1024); } while (0)
#define PG8_MMA(ai, bj, At, Bt) do { __builtin_amdgcn_s_setprio(1); _Pragma("unroll") for (int m = 0; m < 4; ++m) _Pragma("unroll") for (int n = 0; n < 2; ++n) _Pragma("unroll") for (int k = 0; k < 2; ++k) \
        acc[ai][bj][m][n] = __builtin_amdgcn_mfma_f32_16x16x32_bf16(Bt[n][k], At[m][k], acc[ai][bj][m][n], 0, 0, 0); __builtin_amdgcn_s_setprio(0); } while (0)
#define PG8_WAIT_V(n) asm volatile("s_waitcnt vmcnt(" #n ")" ::: "memory")
#define PG8_WAIT_L(n) asm volatile("s_waitcnt lgkmcnt(" #n ")" ::: "memory")
#define PG8_BAR __builtin_amdgcn_s_barrier()
#define PG8_SCHED __builtin_amdgcn_sched_barrier(0)
    Unit cur, nxt; int ui = 0;
    if (!S.next(0, cur)) return;
    f32x4 acc[2][2][4][2];
#pragma unroll
    for (int a = 0; a < 2; ++a)
#pragma unroll
        for (int b = 0; b < 2; ++b)
#pragma unroll
            for (int m = 0; m < 4; ++m)
#pragma unroll
                for (int n = 0; n < 2; ++n) acc[a][b][m][n] = (f32x4){0.f, 0.f, 0.f, 0.f};
    bf16x8 At[4][2], B0[2][2], B1[2][2];
    const char* cA = (const char*)g.A + (size_t)cur.pm * tstepA; const char* cB = (const char*)g.Bt + (size_t)cur.pn * tstepB;
    S.a_ready(cur);
    if constexpr (SP2) {
        PG8_STAGE(PG8_SB(0, 0), cB, voffB); PG8_STAGE(PG8_SB(0, 1), cB + hstepB, voffB); PG8_STAGE(PG8_SA(0, 0), cA, voffA); PG8_STAGE(PG8_SA(0, 1), cA + hstepA, voffA);
        if (wr == 1) PG8_BAR;
        PG8_WAIT_V(2); PG8_BAR;
        PG8_STAGE(PG8_SB(1, 0), cB + kstep, voffB); PG8_STAGE(PG8_SA(1, 0), cA + kstep, voffA); PG8_STAGE(PG8_SB(1, 1), cB + hstepB + kstep, voffB);
        PG8_WAIT_V(6); PG8_BAR;
    } else {
        PG8_STAGE(PG8_SB(0, 0), cB, voffB); PG8_STAGE(PG8_SA(0, 0), cA, voffA); PG8_STAGE(PG8_SB(0, 1), cB + hstepB, voffB); PG8_STAGE(PG8_SA(0, 1), cA + hstepA, voffA);
        if (wr == 1) PG8_BAR;
        PG8_WAIT_V(4); PG8_BAR;
        PG8_STAGE(PG8_SB(1, 0), cB + kstep, voffB); PG8_STAGE(PG8_SA(1, 0), cA + kstep, voffA); PG8_STAGE(PG8_SB(1, 1), cB + hstepB + kstep, voffB);
        PG8_WAIT_V(6); PG8_BAR;
    }
    for (;;) {
        const bool has_next = S.next(ui + 1, nxt);
        const char* nA = has_next ? (const char*)g.A + (size_t)nxt.pm * tstepA : cA; const char* nB = has_next ? (const char*)g.Bt + (size_t)nxt.pn * tstepB : cB;
        for (int t = 0; t < nt; t += 2) {
            const bool last = (t == nt - 2);
            const char* a1 = cA + (size_t)(t + 1) * kstep;
            const char* a2 = last ? nA : cA + (size_t)(t + 2) * kstep; const char* b2 = last ? nB : cB + (size_t)(t + 2) * kstep;
            const char* a3 = a2 + kstep; const char* b3 = b2 + kstep;
            if (last && has_next) S.a_ready(nxt);
            if constexpr (SP2) {
            PG8_LDB(B0, 0, 0); PG8_LDB(B1, 0, 1); PG8_SCHED; PG8_LDA(At, 0, 0); PG8_STAGE(PG8_SA(1, 1), a1 + hstepA, voffA);
            PG8_WAIT_V(8); PG8_WAIT_L(0); PG8_BAR; PG8_MMA(0, 0, At, B0); PG8_MMA(0, 1, At, B1); PG8_BAR; PG8_SCHED;
            PG8_LDA(At, 0, 1); PG8_STAGE(PG8_SB(0, 0), b2, voffB); PG8_STAGE(PG8_SB(0, 1), b2 + hstepB, voffB); PG8_STAGE(PG8_SA(0, 0), a2, voffA);
            PG8_WAIT_V(8); PG8_WAIT_L(0); PG8_BAR; PG8_MMA(1, 0, At, B0); PG8_MMA(1, 1, At, B1); PG8_BAR; PG8_SCHED;
            PG8_LDB(B0, 1, 0); PG8_LDB(B1, 1, 1); PG8_SCHED; PG8_LDA(At, 1, 0); PG8_STAGE(PG8_SA(0, 1), a2 + hstepA, voffA);
            PG8_WAIT_V(8); PG8_WAIT_L(0); PG8_BAR; PG8_MMA(0, 0, At, B0); PG8_MMA(0, 1, At, B1); PG8_BAR; PG8_SCHED;
            PG8_LDA(At, 1, 1); PG8_STAGE(PG8_SB(1, 0), b3, voffB); PG8_STAGE(PG8_SB(1, 1), b3 + hstepB, voffB); PG8_STAGE(PG8_SA(1, 0), a3, voffA);
            PG8_WAIT_V(8); PG8_WAIT_L(0); PG8_BAR; PG8_MMA(1, 0, At, B0); PG8_MMA(1, 1, At, B1); PG8_BAR; PG8_SCHED;
            } else {
            PG8_LDB(B0, 0, 0); PG8_SCHED; PG8_LDA(At, 0, 0); PG8_STAGE(PG8_SA(1, 1), a1 + hstepA, voffA);
            PG8_WAIT_L(8); PG8_BAR; PG8_WAIT_L(0); PG8_MMA(0, 0, At, B0); PG8_BAR; PG8_SCHED;
            PG8_LDB(B1, 0, 1); PG8_STAGE(PG8_SB(0, 0), b2, voffB);
            PG8_BAR; PG8_WAIT_L(0); PG8_MMA(0, 1, At, B1); PG8_BAR;
            PG8_LDA(At, 0, 1); PG8_STAGE(PG8_SA(0, 0), a2, voffA);
            PG8_BAR; PG8_WAIT_L(0); PG8_MMA(1, 0, At, B0); PG8_BAR; PG8_SCHED;
            PG8_STAGE(PG8_SB(0, 1), b2 + hstepB, voffB);
            PG8_WAIT_V(6); PG8_BAR; PG8_MMA(1, 1, At, B1); PG8_BAR;
            PG8_LDB(B0, 1, 0); PG8_SCHED; PG8_LDA(At, 1, 0); PG8_STAGE(PG8_SA(0, 1), a2 + hstepA, voffA);
            PG8_WAIT_L(8); PG8_BAR; PG8_WAIT_L(0); PG8_MMA(0, 0, At, B0); PG8_BAR; PG8_SCHED;
            PG8_LDB(B1, 1, 1); PG8_STAGE(PG8_SB(1, 0), b3, voffB);
            PG8_BAR; PG8_WAIT_L(0); PG8_MMA(0, 1, At, B1); PG8_BAR;
            PG8_LDA(At, 1, 1); PG8_STAGE(PG8_SA(1, 0), a3, voffA);
            PG8_BAR; PG8_WAIT_L(0); PG8_MMA(1, 0, At, B0); PG8_BAR; PG8_SCHED;
            PG8_STAGE(PG8_SB(1, 1), b3 + hstepB, voffB);
            PG8_WAIT_V(6); PG8_BAR; PG8_MMA(1, 1, At, B1); PG8_BAR;
            }
        }
        if constexpr (ALIGN_EPI) { if (wr == 0) PG8_BAR; }
        if constexpr (!Epi::AFTER_DRAIN) { E(acc, cur, wr, wc, fr, fq); S.done(cur); }
        if (!has_next) break;
#pragma unroll
        for (int a = 0; a < 2; ++a)
#pragma unroll
            for (int b = 0; b < 2; ++b)
#pragma unroll
                for (int m = 0; m < 4; ++m)
#pragma unroll
                    for (int n = 0; n < 2; ++n) acc[a][b][m][n] = (f32x4){0.f, 0.f, 0.f, 0.f};
        cur = nxt; cA = nA; cB = nB; ++ui;
        if constexpr (ALIGN_EPI) { if (wr == 1) PG8_BAR; }
    }
    PG8_WAIT_V(0);
    if constexpr (!ALIGN_EPI) { if (wr == 0) PG8_BAR; }
    PG8_BAR;
    if constexpr (Epi::AFTER_DRAIN) { E.fused(acc, cur, wr, wc, fr, fq, lds, wid, lane); S.done(cur); }
#undef PG8_SA
#undef PG8_SB
#undef PG8_STAGE
#undef PG8_LDA
#undef PG8_LDB
#undef PG8_MMA
#undef PG8_WAIT_V
#undef PG8_WAIT_L
#undef PG8_BAR
#undef PG8_SCHED
}
}

namespace mk {
#ifndef GAS
#define GAS __attribute__((address_space(1)))
#endif
#define LAS __attribute__((address_space(3)))
typedef unsigned short bf16;
typedef unsigned v4u __attribute__((ext_vector_type(4)));
typedef unsigned v2u __attribute__((ext_vector_type(2)));
typedef float f32x4 __attribute__((ext_vector_type(4)));
typedef GAS unsigned gu32;
#define LDS_WAIT() asm volatile("s_waitcnt lgkmcnt(0)" ::: "memory")
#define VM_WAIT() asm volatile("s_waitcnt vmcnt(0)" ::: "memory")
__device__ __forceinline__ unsigned f2bf_(float f) { unsigned u = __builtin_bit_cast(unsigned, f); return (u + 0x7fffu + ((u >> 16) & 1u)) >> 16; }
__device__ __forceinline__ unsigned pk2(float lo, float hi) { return f2bf_(lo) | (f2bf_(hi) << 16); }
__device__ __forceinline__ float bflo(unsigned w) { return __builtin_bit_cast(float, w << 16); }
__device__ __forceinline__ float bfhi(unsigned w) { return __builtin_bit_cast(float, w & 0xffff0000u); }

template <class P> __device__ __forceinline__ P* opq(P* p) { asm volatile("" : "+s"(p)); return p; }
__device__ __forceinline__ int opqi(int k) { asm volatile("" : "+s"(k)); return k; }
__device__ __forceinline__ float shx(float v, int o, int lane) { return __builtin_bit_cast(float, __builtin_amdgcn_ds_bpermute((lane ^ o) << 2, __builtin_bit_cast(int, v))); }
__device__ __forceinline__ int shxi(int v, int o, int lane) { return __builtin_amdgcn_ds_bpermute((lane ^ o) << 2, v); }
__device__ __forceinline__ int lane_id_v() { int l; asm volatile("v_mbcnt_lo_u32_b32 %0, -1, 0\n\tv_mbcnt_hi_u32_b32 %0, -1, %0" : "=v"(l)); return l; }
constexpr int NWAVES = 8;
constexpr int D = 1024, NB = 4, S = 8192, T = NB * S, L = 4, MEM = 256, INW = 2144, INP = 2304;
constexpr int PC_CQ = 0, PC_CKV = 256, PC_KR = 384, PC_XL = 512, PC_GL = 1024, PC_QD = 1536, PC_KD = 1792, PC_VD = 2048;
constexpr float LOG2E = 1.4426950408889634f;
constexpr size_t MiB = 1u << 20;
constexpr size_t WS_CTL = 0, CTL_ZERO_BYTES = 1 * MiB;
constexpr size_t WS_WIN = 1 * MiB, WS_WOUT = 19 * MiB, WS_WCQ = 27 * MiB, WS_WCO = 35 * MiB, WS_WPQ = 43 * MiB, WS_WCKV = 51 * MiB, WS_WUQ = 67 * MiB, WS_WUKV = 68 * MiB, WS_KEYS = 69 * MiB, WS_ROPE = 70 * MiB;
constexpr size_t WS_XNB = 76 * MiB, WS_YB = 140 * MiB, WS_PROJB = 204 * MiB, WS_QMB = 348 * MiB, WS_KMB = 372 * MiB, WS_VMB = 396 * MiB, WS_RS = 412 * MiB;
constexpr size_t WS_HLB = 413 * MiB, WS_ACB = 445 * MiB, WS_LSUM = 477 * MiB, WS_OMB = 478 * MiB, WS_MNB = 494 * MiB, WS_KVCB = 502 * MiB, WS_EX = 518 * MiB, WS_GW = 534 * MiB;
constexpr size_t WS_U8 = 550 * MiB, WS_V8 = 614 * MiB, WS_SU = 678 * MiB, WS_SV = 679 * MiB;
constexpr size_t WS_HQ = 680 * MiB, WS_P = 712 * MiB, WS_SH = 728 * MiB, WS_W = 729 * MiB, WS_WS = 745 * MiB, WS_SSQ = 746 * MiB, WS_END = 748 * MiB;
constexpr size_t WS_BTAB = WS_KEYS + 512 * 1024, WS_LAMS = WS_BTAB + 4096, WS_SP = WS_LAMS + 4096;
constexpr int CW_BAR = 4096, CW_RANK = 8192;
constexpr int RING_OFF = 0, RING_BYTES = 155648, LDSCTL_OFF = RING_BYTES, MISC_OFF = LDSCTL_OFF + 320, LDS_BYTES = 163840;

#define XB_TMO      128
#define XB_XCNT(j)  (256  + 64 * (j))
#define XB_XSUB(j)  (1280 + 64 * (j))
#define XB_XGEN(j)  (2304 + 64 * (j))
#define XB_TOP      3328
#define XB_TOPGEN   3392
#define XCD_BAR_WORDS 3456
#define XB_SPIN_CAP (1u << 18)

__device__ __forceinline__ unsigned xb_ld(unsigned* p)              { return __hip_atomic_load(p, __ATOMIC_RELAXED, __HIP_MEMORY_SCOPE_AGENT); }
__device__ __forceinline__ unsigned xb_add(unsigned* p, unsigned v) { return __hip_atomic_fetch_add(p, v, __ATOMIC_RELAXED, __HIP_MEMORY_SCOPE_AGENT); }
__device__ __forceinline__ unsigned xb_xcc_id() { return (unsigned)__builtin_amdgcn_s_getreg((3 << 11) | 20) & 0xFu; }
#define XB_SPIN(cond, bar) do { unsigned _sp = 0; while (cond) { __builtin_amdgcn_s_sleep(1); \
    if ((++_sp & 255u) == 0u) { if (xb_ld(&(bar)[XB_TMO])) break; if (_sp > XB_SPIN_CAP) { atomicAdd(&(bar)[XB_TMO], 1u); break; } } } } while (0)

struct XcdBarrier {
    unsigned* bar; unsigned x;
    volatile LAS unsigned* st;
};

__device__ __forceinline__ XcdBarrier xcd_barrier_post(unsigned* bar, volatile LAS unsigned* st) {
    XcdBarrier b; b.bar = bar; b.x = xb_xcc_id(); b.st = st;
    if (threadIdx.x == 0) (void)xb_add(&bar[XB_XCNT(b.x)], 1u);
    return b;
}
__device__ __forceinline__ void xcd_barrier_complete(unsigned* bar, unsigned x, unsigned& nloc, unsigned& nx) {
    const unsigned G = gridDim.x * gridDim.y * gridDim.z;
    unsigned sum, cnt, mine, sp = 0u;
    for (;;) {
        sum = 0u; cnt = 0u; mine = 0u;
#pragma unroll
        for (unsigned j = 0; j < 16; ++j) { const unsigned c = xb_ld(&bar[XB_XCNT(j)]); sum += c; cnt += (c > 0u) ? 1u : 0u; mine = (j == x) ? c : mine; }
        if (sum == G) break;
        __builtin_amdgcn_s_sleep(1);
        if ((++sp & 255u) == 0u) { if (xb_ld(&bar[XB_TMO])) break; if (sp > XB_SPIN_CAP) { atomicAdd(&bar[XB_TMO], 1u); break; } }
    }
    nloc = mine > 0u ? mine : 1u; nx = cnt > 0u ? cnt : 1u;
}

__device__ __noinline__ void xcd_barrier_impl(unsigned* bar_, unsigned x_, volatile LAS unsigned* st_, int leader_) {
    XcdBarrier b; b.bar = bar_; b.x = x_; b.st = st_;
    asm volatile("s_waitcnt vmcnt(0)" ::: "memory");
    __syncthreads();
    if (leader_) {
        unsigned* bar = b.bar;
        __builtin_amdgcn_s_waitcnt(0);
        unsigned nloc = b.st[0], nx = b.st[1];
        if (nloc == 0u) { xcd_barrier_complete(bar, b.x, nloc, nx); b.st[0] = nloc; b.st[1] = nx; }
        const unsigned old = xb_add(&bar[XB_XSUB(b.x)], 1u);
        const unsigned gen = old / nloc;
        if (old + 1u == (gen + 1u) * nloc) {
            __builtin_amdgcn_fence(__ATOMIC_RELEASE, "agent");
            asm volatile("s_waitcnt vmcnt(0)" ::: "memory");
            const unsigned og = xb_add(&bar[XB_TOP], 1u);
            const unsigned tg = og / nx;
            if (og + 1u == (tg + 1u) * nx) xb_add(&bar[XB_TOPGEN], 1u);
            else XB_SPIN(xb_ld(&bar[XB_TOPGEN]) == tg, bar);
            __builtin_amdgcn_fence(__ATOMIC_ACQUIRE, "agent");
            xb_add(&bar[XB_XGEN(b.x)], 1u);
            asm volatile("s_waitcnt vmcnt(0)" ::: "memory");
        } else {
            XB_SPIN(xb_ld(&bar[XB_XGEN(b.x)]) == gen, bar);
            __builtin_amdgcn_fence(__ATOMIC_ACQUIRE, "agent");
            asm volatile("s_waitcnt vmcnt(0)" ::: "memory");
        }
    }
    __syncthreads();
}
__device__ __forceinline__ void xcd_barrier(const XcdBarrier& b, int leader) { xcd_barrier_impl(b.bar, b.x, b.st, leader); }


__device__ __forceinline__ float wave_sum(float v, int lane) {
#pragma unroll
    for (int o = 1; o < 64; o <<= 1) v += shx(v, o, lane);
    return v;
}
__device__ __forceinline__ float gelu_erf(float v) {
    const float av = __builtin_fabsf(v), t = __builtin_amdgcn_rcpf(av * 0.2316418882f + 1.0f);
    float q = t * 0.5307027145f + (-0.7265760135f); q = q * t + 0.7107068705f; q = q * t + (-0.142248368f); q = q * t + 0.127414796f; q = q * t;
    const float e = __builtin_amdgcn_exp2f((v * v) * (-0.72134752044f));
    const float m = v * (q * e);
    return v < 0.f ? m : v - m;
}

__device__ __forceinline__ void norm_phase(const GAS float* X, const GAS float* g, GAS bf16* out, int rows, int gw, int NGW, int lane) {
    asm volatile("" : "+v"(lane));
    f32x4 gv[4];
#pragma unroll
    for (int j = 0; j < 4; ++j) gv[j] = ((const GAS f32x4*)g)[lane + 64 * j];
    for (int m = gw; m < rows; m += NGW) {
        const GAS f32x4* xr = (const GAS f32x4*)(X + (size_t)m * D) + lane;
        f32x4 v[4]; float s = 0.f;
#pragma unroll
        for (int j = 0; j < 4; ++j) { v[j] = xr[64 * j]; s += (v[j].x * v[j].x + v[j].y * v[j].y) + (v[j].z * v[j].z + v[j].w * v[j].w); }
        const float rs = rsqrtf(wave_sum(s, lane) * (1.f / D) + 1e-6f);
        GAS v2u* o8 = (GAS v2u*)(out + (size_t)m * D) + lane;
#pragma unroll
        for (int j = 0; j < 4; ++j) { v2u w; w.x = pk2(v[j].x * rs * gv[j].x, v[j].y * rs * gv[j].y); w.y = pk2(v[j].z * rs * gv[j].z, v[j].w * rs * gv[j].w); o8[64 * j] = w; }
    }
}
__device__ __forceinline__ void hq_phase(const GAS bf16* XB, const GAS float* SSQ, const GAS float* g, GAS unsigned char* HQ, GAS float* SH, GAS int* Pz, int gw, int NGW, int lane) {
    asm volatile("" : "+v"(lane));
    const GAS f32x4* gp = (const GAS f32x4*)g + 4 * lane; const f32x4 g0 = gp[0], g1 = gp[1], g2 = gp[2], g3 = gp[3];
    for (int m = gw; m < T; m += NGW) {
        const GAS f32x4* sp = (const GAS f32x4*)(SSQ + (size_t)m * 16); const f32x4 t = (sp[0] + sp[1]) + (sp[2] + sp[3]);
        const float rs = __builtin_amdgcn_rsqf(((t[0] + t[1]) + (t[2] + t[3])) * (1.f / 1024.f) + 1e-6f);
        const v4u a = *(const GAS v4u*)(XB + (size_t)m * D + 16 * lane), b = *(const GAS v4u*)(XB + (size_t)m * D + 16 * lane + 8);
        float f[16] = {bflo(a.x) * g0[0], bfhi(a.x) * g0[1], bflo(a.y) * g0[2], bfhi(a.y) * g0[3], bflo(a.z) * g1[0], bfhi(a.z) * g1[1], bflo(a.w) * g1[2], bfhi(a.w) * g1[3],
                       bflo(b.x) * g2[0], bfhi(b.x) * g2[1], bflo(b.y) * g2[2], bfhi(b.y) * g2[3], bflo(b.z) * g3[0], bfhi(b.z) * g3[1], bflo(b.w) * g3[2], bfhi(b.w) * g3[3]};
        float mx = 0.f;
#pragma unroll
        for (int i = 0; i < 16; ++i) { f[i] *= rs; mx = fmaxf(mx, __builtin_fabsf(f[i])); }
#pragma unroll
        for (int o = 1; o < 64; o <<= 1) mx = fmaxf(mx, shx(mx, o, lane));
        const float inv = mx > 0.f ? 127.f / mx : 0.f;
        v4u q;
#pragma unroll
        for (int i = 0; i < 4; ++i) { const int ia = (int)__builtin_rintf(f[4 * i] * inv), ib = (int)__builtin_rintf(f[4 * i + 1] * inv), ic = (int)__builtin_rintf(f[4 * i + 2] * inv), id = (int)__builtin_rintf(f[4 * i + 3] * inv);
            q[i] = (unsigned)(ia & 255) | ((unsigned)(ib & 255) << 8) | ((unsigned)(ic & 255) << 16) | ((unsigned)(id & 255) << 24); }
        *(GAS v4u*)(HQ + (size_t)m * D + 16 * lane) = q;
        if (lane == 0) SH[m] = mx * (1.f / 127.f);
        (Pz + (size_t)m * 128)[lane] = 0; (Pz + (size_t)m * 128)[lane + 64] = 0;
    }
}
__device__ __forceinline__ void x0_phase(const GAS float* X, GAS bf16* XB, GAS float* SSQ, int gw, int NGW, int lane) {
    asm volatile("" : "+v"(lane));
    for (int m = gw; m < T; m += NGW) {
        const GAS f32x4* xr = (const GAS f32x4*)(X + (size_t)m * D) + lane; GAS v2u* o8 = (GAS v2u*)(XB + (size_t)m * D) + lane;
        float s = 0.f;
#pragma unroll
        for (int j = 0; j < 4; ++j) { const f32x4 v = xr[64 * j]; s += (v.x * v.x + v.y * v.y) + (v.z * v.z + v.w * v.w); v2u w; w.x = pk2(v.x, v.y); w.y = pk2(v.z, v.w); o8[64 * j] = w; }
        s = wave_sum(s, lane);
        if (lane < 8) SSQ[(size_t)m * 16 + lane] = lane == 0 ? s : 0.f;
    }
}
__device__ __forceinline__ void final_norm_phase(GAS float* X, const GAS float* g, int rows, int gw, int NGW, int lane) {
    asm volatile("" : "+v"(lane));
    for (int m = gw; m < rows; m += NGW) {
        GAS f32x4* xr = (GAS f32x4*)(X + (size_t)m * D) + lane;
        f32x4 v[4]; float s = 0.f;
#pragma unroll
        for (int j = 0; j < 4; ++j) { v[j] = xr[64 * j]; s += (v[j].x * v[j].x + v[j].y * v[j].y) + (v[j].z * v[j].z + v[j].w * v[j].w); }
        const float rs = rsqrtf(wave_sum(s, lane) * (1.f / D) + 1e-6f);
#pragma unroll
        for (int j = 0; j < 4; ++j) { const f32x4 gj = ((const GAS f32x4*)g)[lane + 64 * j]; xr[64 * j] = v[j] * rs * gj; }
    }
}

__device__ __forceinline__ void pre_phase(const GAS bf16* PROJB, const GAS float* ROPE, GAS float* RS, GAS bf16* KMB, int gw, int NGW, int lane) {
    asm volatile("" : "+v"(lane));
    for (int t = gw; t < T; t += NGW) {
        const GAS bf16* pr = PROJB + (size_t)t * INP;
        float sq = 0.f, skv = 0.f;
        if (lane < 24) { const v4u w = *(const GAS v4u*)(pr + PC_CQ + 8 * lane);
            const float a0 = bflo(w.x), a1 = bfhi(w.x), a2 = bflo(w.y), a3 = bfhi(w.y), a4 = bflo(w.z), a5 = bfhi(w.z), a6 = bflo(w.w), a7 = bfhi(w.w);
            sq = (a0 * a0 + a1 * a1) + (a2 * a2 + a3 * a3) + (a4 * a4 + a5 * a5) + (a6 * a6 + a7 * a7); }
        else if (lane >= 32 && lane < 48) { const v4u w = *(const GAS v4u*)(pr + PC_CKV + 8 * (lane - 32));
            const float a0 = bflo(w.x), a1 = bfhi(w.x), a2 = bflo(w.y), a3 = bfhi(w.y), a4 = bflo(w.z), a5 = bfhi(w.z), a6 = bflo(w.w), a7 = bfhi(w.w);
            skv = (a0 * a0 + a1 * a1) + (a2 * a2 + a3 * a3) + (a4 * a4 + a5 * a5) + (a6 * a6 + a7 * a7); }
        sq = wave_sum(sq, lane); skv = wave_sum(skv, lane);
        if (lane == 0) { RS[2 * (size_t)t] = rsqrtf(sq * (1.f / 192.f) + 1e-6f); RS[2 * (size_t)t + 1] = rsqrtf(skv * (1.f / 128.f) + 1e-6f); }
        if (lane < 16) {
            const float x1 = __builtin_bit_cast(float, (unsigned)pr[PC_KR + lane] << 16), x2 = __builtin_bit_cast(float, (unsigned)pr[PC_KR + 16 + lane] << 16);
            const float c = ROPE[(size_t)t * 32 + lane], sn = ROPE[(size_t)t * 32 + 16 + lane];
            const bf16 y1 = (bf16)f2bf_(x1 * c - x2 * sn), y2 = (bf16)f2bf_(x1 * sn + x2 * c);
            GAS bf16* kr = KMB + (size_t)t * 384 + 64 + lane;
#pragma unroll
            for (int h = 0; h < 4; ++h) { kr[h * 96] = y1; kr[h * 96 + 16] = y2; }
        }
    }
}

struct LruP { const GAS bf16* PROJB; const GAS float* cw; const GAS float* cb; const GAS float* wa; const GAS float* ba; const GAS float* wx; const GAS float* bx; const GAS float* sp; GAS bf16* HL; GAS bf16* AC; GAS float* LSUM; };
constexpr int LR_XP = 260;
constexpr int LR_XC = 0, LR_WA = 64 * LR_XP * 4, LR_WX = LR_WA + 16384, LR_SUM = LR_WX + 16384, LR_END = LR_SUM + 4096;
__device__ __forceinline__ void lru_phase(const LruP& P, LAS unsigned char* lds, int tid, int wave, int lane, int vcu, int G) {
    asm volatile("" : "+v"(tid), "+v"(lane));
    LAS float* xc = (LAS float*)(lds + LR_XC); LAS float* WA = (LAS float*)(lds + LR_WA); LAS float* WX = (LAS float*)(lds + LR_WX); LAS float* SUM = (LAS float*)(lds + LR_SUM);
    for (int u = vcu; u < (T / 256) * 8; u += G) {
        const int tile = u >> 3, g = u & 7; const int t0 = tile * 256; const bool first = ((tile & 31) == 0);
        __syncthreads();
#pragma unroll
        for (int i = 0; i < 2; ++i) { const int idx = tid + 512 * i; ((LAS f32x4*)WA)[idx] = ((const GAS f32x4*)(P.wa + g * 4096))[idx]; ((LAS f32x4*)WX)[idx] = ((const GAS f32x4*)(P.wx + g * 4096))[idx]; }
#pragma unroll 1
        for (int it = tid; it < 2048; it += 512) {
            const int time = it & 255, cg = it >> 8; const int ch0 = 64 * g + 8 * cg;
            float y[8];
            { const f32x4 b0 = *(const GAS f32x4*)(P.cb + ch0), b1 = *(const GAS f32x4*)(P.cb + ch0 + 4); y[0] = b0.x; y[1] = b0.y; y[2] = b0.z; y[3] = b0.w; y[4] = b1.x; y[5] = b1.y; y[6] = b1.z; y[7] = b1.w; }
#pragma unroll
            for (int k = 0; k < 4; ++k) {
                if (!(first && time - 3 + k < 0)) {
                    const v4u w = *(const GAS v4u*)(P.PROJB + (size_t)(t0 + time - 3 + k) * INP + PC_XL + ch0);
                    const f32x4 c0 = *(const GAS f32x4*)(P.cw + k * 512 + ch0), c1 = *(const GAS f32x4*)(P.cw + k * 512 + ch0 + 4);
                    y[0] += bflo(w.x) * c0.x; y[1] += bfhi(w.x) * c0.y; y[2] += bflo(w.y) * c0.z; y[3] += bfhi(w.y) * c0.w;
                    y[4] += bflo(w.z) * c1.x; y[5] += bfhi(w.z) * c1.y; y[6] += bflo(w.w) * c1.z; y[7] += bfhi(w.w) * c1.w;
                }
            }
#pragma unroll
            for (int e = 0; e < 8; ++e) xc[(8 * cg + e) * LR_XP + time] = y[e];
        }
        __syncthreads();
        float aa[32], ax[32];
        { const float b_a = P.ba[64 * g + lane], b_x = P.bx[64 * g + lane];
#pragma unroll
          for (int j = 0; j < 32; ++j) { aa[j] = b_a; ax[j] = b_x; } }
#pragma unroll 2
        for (int ci = 0; ci < 64; ++ci) {
            const float wa_ = WA[ci * 64 + lane], wx_ = WX[ci * 64 + lane];
            const LAS f32x4* xr = (const LAS f32x4*)(xc + ci * LR_XP + 32 * wave);
#pragma unroll
            for (int q = 0; q < 8; ++q) { const f32x4 xv = xr[q];
                aa[4 * q] += xv.x * wa_; aa[4 * q + 1] += xv.y * wa_; aa[4 * q + 2] += xv.z * wa_; aa[4 * q + 3] += xv.w * wa_;
                ax[4 * q] += xv.x * wx_; ax[4 * q + 1] += xv.y * wx_; ax[4 * q + 2] += xv.z * wx_; ax[4 * q + 3] += xv.w * wx_; }
        }
        { const float sp = P.sp[64 * g + lane];
          const LAS f32x4* xo = (const LAS f32x4*)(xc + lane * LR_XP + 32 * wave);
          float hrun = 0.f, arun = 1.f;
#pragma unroll
          for (int q = 0; q < 8; ++q) { const f32x4 xv = xo[q];
#pragma unroll
              for (int e = 0; e < 4; ++e) { const int j = 4 * q + e;
                  const float r = __builtin_amdgcn_rcpf(1.f + __builtin_amdgcn_exp2f(-LOG2E * aa[j])), ig = __builtin_amdgcn_rcpf(1.f + __builtin_amdgcn_exp2f(-LOG2E * ax[j]));
                  const float la = -8.0f * r * sp; const float a = __builtin_amdgcn_exp2f(LOG2E * la);
                  const float uu = __builtin_amdgcn_sqrtf(fmaxf(1.f - a * a, 0.f)) * (ig * xv[e]);
                  hrun = a * hrun + uu; arun *= a; aa[j] = arun; ax[j] = hrun; } }
          SUM[(wave * 64 + lane) * 2] = arun; SUM[(wave * 64 + lane) * 2 + 1] = hrun; }
        __syncthreads();
        float ca = 1.f, chh = 0.f;
        for (int w = 0; w < wave; ++w) { const float aw = SUM[(w * 64 + lane) * 2], hw = SUM[(w * 64 + lane) * 2 + 1]; chh = aw * chh + hw; ca *= aw; }
        { GAS bf16* hl = P.HL + (size_t)(t0 + 32 * wave) * 512 + 64 * g + lane; GAS bf16* ac = P.AC + (size_t)(t0 + 32 * wave) * 512 + 64 * g + lane;
#pragma unroll
          for (int j = 0; j < 32; ++j) { const float hh = ax[j] + aa[j] * chh, acc = aa[j] * ca; hl[(size_t)j * 512] = (bf16)f2bf_(hh); ac[(size_t)j * 512] = (bf16)f2bf_(acc);
              if (j == 31 && wave == 7) { P.LSUM[((size_t)tile * 512 + 64 * g + lane) * 2] = acc; P.LSUM[((size_t)tile * 512 + 64 * g + lane) * 2 + 1] = hh; } } }
    }
}

struct PostP { const GAS bf16* OMB; const GAS bf16* HL; const GAS bf16* AC; const GAS float* LSUM; const GAS bf16* PROJB; const GAS float* gm; const GAS float* gl; GAS bf16* Y; };
__device__ __forceinline__ void post_phase(const PostP& P, LAS unsigned char* lds, int tid, int wave, int lane, int vcu, int G) {
    asm volatile("" : "+v"(tid), "+v"(lane));
    LAS float* hin = (LAS float*)lds;
    for (int u = vcu; u < T / 64; u += G) {
        const int t0 = u * 64, tile = t0 >> 8, tb = tile & ~31;
        __syncthreads();
        { float h = 0.f;
          for (int c = tb; c < tile; ++c) { const float a = P.LSUM[((size_t)c * 512 + tid) * 2], hh = P.LSUM[((size_t)c * 512 + tid) * 2 + 1]; h = a * h + hh; }
          hin[tid] = h; }
        __syncthreads();
        f32x4 hi0 = *(const LAS f32x4*)(hin + 8 * lane), hi1 = *(const LAS f32x4*)(hin + 8 * lane + 4);
        const f32x4 g0 = *(const GAS f32x4*)(P.gl + 8 * lane), g1 = *(const GAS f32x4*)(P.gl + 8 * lane + 4), gmv = *(const GAS f32x4*)(P.gm + 4 * lane);
#pragma unroll 2
        for (int i = 0; i < 8; ++i) {
            const size_t t = (size_t)t0 + 8 * wave + i;
            const v4u hw = *(const GAS v4u*)(P.HL + t * 512 + 8 * lane), aw = *(const GAS v4u*)(P.AC + t * 512 + 8 * lane), gw_ = *(const GAS v4u*)(P.PROJB + t * INP + PC_GL + 8 * lane);
            const v2u mw = *(const GAS v2u*)(P.OMB + t * 256 + 4 * lane);
            float o[8];
            o[0] = (bflo(hw.x) + bflo(aw.x) * hi0.x) * gelu_erf(bflo(gw_.x)); o[1] = (bfhi(hw.x) + bfhi(aw.x) * hi0.y) * gelu_erf(bfhi(gw_.x));
            o[2] = (bflo(hw.y) + bflo(aw.y) * hi0.z) * gelu_erf(bflo(gw_.y)); o[3] = (bfhi(hw.y) + bfhi(aw.y) * hi0.w) * gelu_erf(bfhi(gw_.y));
            o[4] = (bflo(hw.z) + bflo(aw.z) * hi1.x) * gelu_erf(bflo(gw_.z)); o[5] = (bfhi(hw.z) + bfhi(aw.z) * hi1.y) * gelu_erf(bfhi(gw_.z));
            o[6] = (bflo(hw.w) + bflo(aw.w) * hi1.z) * gelu_erf(bflo(gw_.w)); o[7] = (bfhi(hw.w) + bfhi(aw.w) * hi1.w) * gelu_erf(bfhi(gw_.w));
            float s2 = 0.f;
#pragma unroll
            for (int e = 0; e < 8; ++e) s2 += o[e] * o[e];
            const float m0 = bflo(mw.x), m1 = bfhi(mw.x), m2 = bflo(mw.y), m3 = bfhi(mw.y);
            float s1 = (m0 * m0 + m1 * m1) + (m2 * m2 + m3 * m3);
            s1 = wave_sum(s1, lane); s2 = wave_sum(s2, lane);
            const float r1 = rsqrtf(s1 * (1.f / 256.f) + 1e-6f), r2 = rsqrtf(s2 * (1.f / 512.f) + 1e-6f);
            GAS bf16* yr = P.Y + t * 1024;
            { v2u w; w.x = pk2(m0 * r1 * gmv.x, m1 * r1 * gmv.y); w.y = pk2(m2 * r1 * gmv.z, m3 * r1 * gmv.w); *(GAS v2u*)(yr + 4 * lane) = w; }
            { v4u w; w.x = pk2(o[0] * r2 * g0.x, o[1] * r2 * g0.y); w.y = pk2(o[2] * r2 * g0.z, o[3] * r2 * g0.w); w.z = pk2(o[4] * r2 * g1.x, o[5] * r2 * g1.y); w.w = pk2(o[6] * r2 * g1.z, o[7] * r2 * g1.w);
              *(GAS v4u*)(yr + 256 + 8 * lane) = w; }
        }
    }
}

#define TILE_BAR() asm volatile("s_waitcnt lgkmcnt(0)\n\ts_barrier" ::: "memory")
typedef short bf16x8 __attribute__((ext_vector_type(8)));
typedef short s16x4 __attribute__((ext_vector_type(4)));
typedef float f32x16 __attribute__((ext_vector_type(16)));
typedef unsigned u32x4 __attribute__((ext_vector_type(4)));
__device__ __forceinline__ int crow(int r, int hi) { return (r & 3) + 8 * (r >> 2) + 4 * hi; }
typedef float f32x2_t __attribute__((ext_vector_type(2))); typedef __bf16 bf16x2_c __attribute__((ext_vector_type(2)));
__device__ __forceinline__ unsigned cvtpk(float lo, float hi) { f32x2_t v = {lo, hi}; bf16x2_c b = __builtin_convertvector(v, bf16x2_c); return __builtin_bit_cast(unsigned, b); }
__device__ __forceinline__ float swapmax(float m) { auto rr = __builtin_amdgcn_permlane32_swap(__float_as_uint(m), __float_as_uint(m), false, false); return fmaxf(__uint_as_float(rr[0]), __uint_as_float(rr[1])); }
__device__ __forceinline__ float swapadd(float m) { auto rr = __builtin_amdgcn_permlane32_swap(__float_as_uint(m), __float_as_uint(m), false, false); return __uint_as_float(rr[0]) + __uint_as_float(rr[1]); }
__device__ __forceinline__ s16x4 vtr(const LAS unsigned char* p) { return __builtin_bit_cast(s16x4, __builtin_amdgcn_ds_read_tr16_b64_v4i16((LAS s16x4*)p)); }
__device__ __forceinline__ bf16x8 pack8(const f32x16& p, int b) { u32x4 w; w.x = cvtpk(p[b], p[b + 1]); w.y = cvtpk(p[b + 2], p[b + 3]); w.z = cvtpk(p[b + 4], p[b + 5]); w.w = cvtpk(p[b + 6], p[b + 7]); return __builtin_bit_cast(bf16x8, w); }
__device__ __forceinline__ float vmax3(float a, float b, float c) { float r; asm("v_max3_f32 %0, %1, %2, %3" : "=v"(r) : "v"(a), "v"(b), "v"(c)); return r; }
__device__ __forceinline__ float max32(const f32x16& p, const f32x16& q) {
    float a = vmax3(p[0], p[1], p[2]), b = vmax3(p[3], p[4], p[5]), c = vmax3(p[6], p[7], p[8]), d = vmax3(p[9], p[10], p[11]), e = vmax3(p[12], p[13], p[14]);
    float f = vmax3(q[0], q[1], q[2]), g = vmax3(q[3], q[4], q[5]), h = vmax3(q[6], q[7], q[8]), i = vmax3(q[9], q[10], q[11]), j = vmax3(q[12], q[13], q[14]);
    a = vmax3(a, b, c); d = vmax3(d, e, p[15]); f = vmax3(f, g, h); i = vmax3(i, j, q[15]);
    return vmax3(vmax3(a, d, f), i, i);
}
__device__ __forceinline__ float max16(const f32x16& p) { float a = fmaxf(fmaxf(p[0], p[1]), fmaxf(p[2], p[3])), b = fmaxf(fmaxf(p[4], p[5]), fmaxf(p[6], p[7])), c = fmaxf(fmaxf(p[8], p[9]), fmaxf(p[10], p[11])), d = fmaxf(fmaxf(p[12], p[13]), fmaxf(p[14], p[15])); return fmaxf(fmaxf(a, b), fmaxf(c, d)); }

struct AttnP {
    const GAS bf16* Q; const GAS bf16* K; const GAS bf16* V; int qp, kp, vp;
    GAS bf16* O; int op;
    const GAS float* rope;
    const GAS int* pos; const GAS float* btab; const GAS float* dnorm; const GAS float* lams;
};
template <int KIND> struct AK {
    static constexpr bool DIFF = KIND == 1, CROSS = KIND == 2;
    static constexpr int HW = KIND == 0 ? 96 : KIND == 1 ? 64 : 256;
    static constexpr int NKS = KIND == 0 ? 6 : KIND == 1 ? 2 : 16;
    static constexpr int KP = KIND == 0 ? 208 : KIND == 1 ? 144 : 528;
    static constexpr int ND = CROSS ? 4 : 2;
    static constexpr int CPK = HW / 8, KCH = (64 * CPK + 511) / 512;
    static constexpr int VCH = ND / 2;
    static constexpr int KB = 64 * KP, VB = ND * 4096;
    static constexpr int NBUF = CROSS ? 2 : 3;
    static constexpr int K0 = 0, V0 = NBUF * KB, POS = V0 + NBUF * VB, BT = POS + 1024, DN = BT + 528, END = DN + 256;
};
static_assert(AK<2>::END <= RING_BYTES && AK<0>::END <= RING_BYTES && AK<1>::END + 16 + 8 * 8192 <= RING_BYTES, "attention LDS");

template <int KIND, bool LEAD>
__device__ __forceinline__ void attn_unit(const AttnP& P, int b, int h, int qb, int dhalf, LAS unsigned char* lds, int tid, int wave, int lane) {
    lane = lane_id_v(); tid = (wave << 6) | lane;
    typedef AK<KIND> C;
    constexpr bool DIFF = C::DIFF, CROSS = C::CROSS;
    constexpr int HW = C::HW, NKS = C::NKS, KP = C::KP, ND = C::ND, CPK = C::CPK, KCH = C::KCH, VCH = C::VCH;
    const int r32 = lane & 31, hi = lane >> 5;
    const size_t rowb = (size_t)b * S, rowk = CROSS ? (size_t)b * MEM : rowb;
    const int q0w = qb * 256 + wave * 32, qi = q0w + r32;
    int pq = 0; float bias_far = 0.f;
    __syncthreads();
    if (DIFF) {
        pq = P.pos[rowb + qi];
        if (tid < 129) ((LAS float*)(lds + C::BT))[tid] = P.btab[h * 129 + tid];
        if (tid >= 192 && tid < 256) ((LAS float*)(lds + C::DN))[tid - 192] = P.dnorm[tid - 192];
    }
    int minq = pq;
    if (DIFF) { for (int o = 1; o < 64; o <<= 1) { const int v = shxi(minq, o, lane); minq = v < minq ? v : minq; } }
    const int NT = CROSS ? MEM / 64 : 4 * (qb + 1);
    u32x4 kr[KCH], vr[VCH]; int pkr = 0;
    u32x4 kr2[CROSS ? 1 : KCH], vr2[CROSS ? 1 : VCH]; int pkr2 = 0;
    const GAS bf16* Kb = P.K + rowk * P.kp + h * HW; const GAS bf16* Vb = P.V + rowk * P.vp + (CROSS ? h * 256 + dhalf * 128 : h * 64);
    const __amdgpu_buffer_rsrc_t rK = __builtin_amdgcn_make_buffer_rsrc((void*)Kb, 0, 0x7fffffff, 0x00020000), rV = __builtin_amdgcn_make_buffer_rsrc((void*)Vb, 0, 0x7fffffff, 0x00020000);
    const __amdgpu_buffer_rsrc_t rP = __builtin_amdgcn_make_buffer_rsrc((void*)(DIFF ? P.pos + rowb : (const GAS int*)Kb), 0, 0x7fffffff, 0x00020000);
    int kvo[KCH], vvo[VCH];
#pragma unroll
    for (int i = 0; i < KCH; ++i) { int c = tid + 512 * i; c = c < 64 * CPK ? c : tid; kvo[i] = ((c / CPK) * P.kp + (c % CPK) * 8) * 2; }
#pragma unroll
    for (int i = 0; i < VCH; ++i) { const int c = tid + 512 * i; vvo[i] = ((c / (4 * ND)) * P.vp + (c % (4 * ND)) * 8) * 2; }
    const int pvo = (tid & 63) * 4;
    auto gload = [&](int t) {
        const int ks = __builtin_amdgcn_readfirstlane(64 * t * P.kp * 2), vs = __builtin_amdgcn_readfirstlane(64 * t * P.vp * 2);
#pragma unroll
        for (int i = 0; i < KCH; ++i) kr[i] = __builtin_amdgcn_raw_buffer_load_b128(rK, kvo[i], ks, 0);
#pragma unroll
        for (int i = 0; i < VCH; ++i) vr[i] = __builtin_amdgcn_raw_buffer_load_b128(rV, vvo[i], vs, 0);
        if (DIFF) pkr = __builtin_amdgcn_raw_buffer_load_b32(rP, pvo, __builtin_amdgcn_readfirstlane(64 * t * 4), 0);
    };
    auto lstore = [&](int buf) {
        LAS unsigned char* kb_ = lds + C::K0 + buf * C::KB; LAS unsigned char* vb_ = lds + C::V0 + buf * C::VB;
#pragma unroll
        for (int i = 0; i < KCH; ++i) { int c = tid + 512 * i; c = c < 64 * CPK ? c : tid; const int key = c / CPK, part = c % CPK; *(LAS u32x4*)(kb_ + key * KP + part * 16) = kr[i]; }
#pragma unroll
        for (int i = 0; i < VCH; ++i) { const int c = tid + 512 * i; const int key = c / (4 * ND), part = c % (4 * ND); *(LAS u32x4*)(vb_ + (part >> 2) * 4096 + (key >> 3) * 512 + (key & 7) * 64 + (part & 3) * 16) = vr[i]; }
        if (DIFF) { ((LAS int*)(lds + C::POS + buf * 256))[tid & 63] = pkr; if (tid < 64) { int mk_ = pkr; for (int o = 1; o < 64; o <<= 1) { const int v = shxi(mk_, o, lane); mk_ = v > mk_ ? v : mk_; } if (tid == 0) ((LAS int*)(lds + C::POS + 768))[buf] = mk_; } }
    };
    auto gloadB = [&](int t) {
        const int ks = __builtin_amdgcn_readfirstlane(64 * t * P.kp * 2), vs = __builtin_amdgcn_readfirstlane(64 * t * P.vp * 2);
#pragma unroll
        for (int i = 0; i < (CROSS ? 1 : KCH); ++i) kr2[i] = __builtin_amdgcn_raw_buffer_load_b128(rK, kvo[i], ks, 0);
#pragma unroll
        for (int i = 0; i < (CROSS ? 1 : VCH); ++i) vr2[i] = __builtin_amdgcn_raw_buffer_load_b128(rV, vvo[i], vs, 0);
        if (DIFF) pkr2 = __builtin_amdgcn_raw_buffer_load_b32(rP, pvo, __builtin_amdgcn_readfirstlane(64 * t * 4), 0);
    };
    auto lstoreB = [&](int buf) {
        LAS unsigned char* kb_ = lds + C::K0 + buf * C::KB; LAS unsigned char* vb_ = lds + C::V0 + buf * C::VB;
#pragma unroll
        for (int i = 0; i < (CROSS ? 1 : KCH); ++i) { int c = tid + 512 * i; c = c < 64 * CPK ? c : tid; const int key = c / CPK, part = c % CPK; *(LAS u32x4*)(kb_ + key * KP + part * 16) = kr2[i]; }
#pragma unroll
        for (int i = 0; i < (CROSS ? 1 : VCH); ++i) { const int c = tid + 512 * i; const int key = c / (4 * ND), part = c % (4 * ND); *(LAS u32x4*)(vb_ + (part >> 2) * 4096 + (key >> 3) * 512 + (key & 7) * 64 + (part & 3) * 16) = vr2[i]; }
        if (DIFF) { ((LAS int*)(lds + C::POS + buf * 256))[tid & 63] = pkr2; if (tid < 64) { int mk_ = pkr2; for (int o = 1; o < 64; o <<= 1) { const int v = shxi(mk_, o, lane); mk_ = v > mk_ ? v : mk_; } if (tid == 0) ((LAS int*)(lds + C::POS + 768))[buf] = mk_; } }
    };
    LAS float* osv = (LAS float*)(lds + ((C::END + 15) & ~15)) + wave * 2048 + lane;
    float il = 0.f;
    f32x16 oA[ND];
#pragma unroll 1
    for (int mp = 0; mp < (DIFF ? 2 : 1); ++mp) {
        bf16x8 qf[NKS];
        { const GAS bf16* qrow = P.Q + (rowb + qi) * P.qp + h * HW + mp * 32;
#pragma unroll
          for (int s = 0; s < NKS; ++s) qf[s] = *(const GAS bf16x8*)(qrow + 16 * s + 8 * hi);
          if (KIND == 0) {
              const GAS float* rp = P.rope + (rowb + qi) * 32 + 8 * hi;
              const f32x4 c0 = *(const GAS f32x4*)rp, c1 = *(const GAS f32x4*)(rp + 4), s0 = *(const GAS f32x4*)(rp + 16), s1 = *(const GAS f32x4*)(rp + 20);
              const u32x4 a = __builtin_bit_cast(u32x4, qf[NKS - 2]), bq = __builtin_bit_cast(u32x4, qf[NKS - 1]); u32x4 ra, rb;
#pragma unroll
              for (int w = 0; w < 4; ++w) { const float cl = w < 2 ? c0[2 * w] : c1[2 * w - 4], ch = w < 2 ? c0[2 * w + 1] : c1[2 * w - 3], sl = w < 2 ? s0[2 * w] : s1[2 * w - 4], sh = w < 2 ? s0[2 * w + 1] : s1[2 * w - 3];
                  const float x1l = bflo(a[w]), x1h = bfhi(a[w]), x2l = bflo(bq[w]), x2h = bfhi(bq[w]);
                  ra[w] = cvtpk(x1l * cl - x2l * sl, x1h * ch - x2h * sh); rb[w] = cvtpk(x1l * sl + x2l * cl, x1h * sh + x2h * ch); }
              qf[NKS - 2] = __builtin_bit_cast(bf16x8, ra); qf[NKS - 1] = __builtin_bit_cast(bf16x8, rb);
          } }
        __syncthreads();
        float m1 = -1e30f, l1 = 0.f;
#pragma unroll
        for (int d = 0; d < ND; ++d)
#pragma unroll
            for (int r = 0; r < 16; ++r) oA[d][r] = 0.f;
        auto qk = [&](int sl, f32x16& sa, f32x16& sb, float init) {
            const LAS unsigned char* kb_ = lds + C::K0 + sl * C::KB + r32 * KP + hi * 16 + mp * 64;
#pragma unroll
            for (int r = 0; r < 16; ++r) { sa[r] = init; sb[r] = init; }
            constexpr int HB = CROSS ? 4 : (NKS > 3 ? 3 : NKS);
#pragma unroll
            for (int s0_ = 0; s0_ < NKS; s0_ += HB) {
                bf16x8 kfa[HB], kfb[HB];
#pragma unroll
                for (int s = 0; s < HB; ++s) { kfa[s] = *(const LAS bf16x8*)(kb_ + (s0_ + s) * 32); kfb[s] = *(const LAS bf16x8*)(kb_ + 32 * KP + (s0_ + s) * 32); }
                __builtin_amdgcn_sched_barrier(0);
#pragma unroll
                for (int s = 0; s < HB; ++s) { sa = __builtin_amdgcn_mfma_f32_32x32x16_bf16(kfa[s], qf[s0_ + s], sa, 0, 0, 0); sb = __builtin_amdgcn_mfma_f32_32x32x16_bf16(kfb[s], qf[s0_ + s], sb, 0, 0, 0); }
                __builtin_amdgcn_sched_barrier(0);
            }
        };
        auto isnear = [&](int sl) { bool nb = false;
            if (DIFF) { const int mk_ = __builtin_amdgcn_readfirstlane(((LAS int*)(lds + C::POS + 768))[sl]); nb = (minq - mk_) < 128; }
            return nb; };
        auto sm = [&](int t, int sl, f32x16& pa, f32x16& pb, bool nearb) -> float {
            const int k0 = 64 * t;
            if (DIFF) { if (nearb) {
                const LAS int* pk = (const LAS int*)(lds + C::POS + sl * 256); const LAS float* bt = (const LAS float*)(lds + C::BT);
#pragma unroll
                for (int r = 0; r < 16; ++r) { const int kk = crow(r, hi);
                    int n0 = pq - pk[kk], n1 = pq - pk[kk + 32]; n0 = n0 < 0 ? 0 : (n0 > 128 ? 128 : n0); n1 = n1 < 0 ? 0 : (n1 > 128 ? 128 : n1);
                    pa[r] += bt[n0]; pb[r] += bt[n1]; }
            } }
            if (!CROSS && k0 + 63 > q0w) {
#pragma unroll
                for (int r = 0; r < 16; ++r) { const int kk = k0 + crow(r, hi); if (kk > qi) pa[r] = -1e30f; if (kk + 32 > qi) pb[r] = -1e30f; }
            }
            asm volatile("s_nop 15\n\ts_nop 7" : "+v"(pa), "+v"(pb));
            float mn, al = 1.f;
            if (CROSS) { const float mx = swapmax(max32(pa, pb)); mn = fmaxf(m1, mx); al = __builtin_amdgcn_exp2f(m1 - mn); l1 *= al; }
            else { const float mx = swapmax(max32(pa, pb)); const bool up = mx > m1 + 8.0f; mn = up ? mx : m1;
                   if (__builtin_amdgcn_ballot_w64(up) != 0ull) { al = __builtin_amdgcn_exp2f(m1 - mn); l1 *= al; } }
            m1 = mn;
            float ls = 0.f;
#pragma unroll
            for (int r = 0; r < 16; ++r) { pa[r] = __builtin_amdgcn_exp2f(pa[r] - mn); pb[r] = __builtin_amdgcn_exp2f(pb[r] - mn); ls += pa[r] + pb[r]; }
            l1 += ls;
            return al;
        };
        auto pv = [&](int sl, const f32x16& pa, const f32x16& pb, float al) {
            const LAS unsigned char* vb_ = lds + C::V0 + sl * C::VB + ((lane >> 4) & 1) * 32 + (lane & 3) * 8 + (4 * hi + ((lane & 15) >> 2)) * 64;
            bf16x8 pf[4];
            pf[0] = pack8(pa, 0); pf[1] = pack8(pa, 8); pf[2] = pack8(pb, 0); pf[3] = pack8(pb, 8);
            const bool resc = CROSS ? true : (__builtin_amdgcn_ballot_w64(al != 1.0f) != 0ull);
            if (CROSS) {
#pragma unroll
                for (int d = 0; d < ND; ++d) {
                    __builtin_amdgcn_sched_barrier(0);
#pragma unroll
                    for (int r = 0; r < 16; ++r) oA[d][r] *= al;
                    bf16x8 vf[4];
#pragma unroll
                    for (int s = 0; s < 4; ++s) { const s16x4 lo = vtr(vb_ + d * 4096 + s * 1024), hh = vtr(vb_ + d * 4096 + s * 1024 + 512); vf[s] = (bf16x8){lo[0], lo[1], lo[2], lo[3], hh[0], hh[1], hh[2], hh[3]}; }
#pragma unroll
                    for (int s = 0; s < 4; ++s) oA[d] = __builtin_amdgcn_mfma_f32_32x32x16_bf16(vf[s], pf[s], oA[d], 0, 0, 0);
                }
            } else if (DIFF) {
                if (resc) {
#pragma unroll
                    for (int d = 0; d < 2; ++d)
#pragma unroll
                        for (int r = 0; r < 16; ++r) oA[d][r] *= al;
                }
#pragma unroll
                for (int d = 0; d < 2; ++d) {
                    bf16x8 vf[4];
#pragma unroll
                    for (int s = 0; s < 4; ++s) { const s16x4 lo = vtr(vb_ + d * 4096 + s * 1024), hh = vtr(vb_ + d * 4096 + s * 1024 + 512); vf[s] = (bf16x8){lo[0], lo[1], lo[2], lo[3], hh[0], hh[1], hh[2], hh[3]}; }
                    __builtin_amdgcn_sched_barrier(0);
#pragma unroll
                    for (int s = 0; s < 4; ++s) oA[d] = __builtin_amdgcn_mfma_f32_32x32x16_bf16(vf[s], pf[s], oA[d], 0, 0, 0);
                }
            } else {
                bf16x8 vf[2][4];
#pragma unroll
                for (int d = 0; d < 2; ++d)
#pragma unroll
                    for (int s = 0; s < 4; ++s) { const s16x4 lo = vtr(vb_ + d * 4096 + s * 1024), hh = vtr(vb_ + d * 4096 + s * 1024 + 512); vf[d][s] = (bf16x8){lo[0], lo[1], lo[2], lo[3], hh[0], hh[1], hh[2], hh[3]}; }
                if (resc) {
#pragma unroll
                    for (int d = 0; d < 2; ++d)
#pragma unroll
                        for (int r = 0; r < 16; ++r) oA[d][r] *= al;
                }
                __builtin_amdgcn_sched_barrier(0);
#pragma unroll
                for (int s = 0; s < 4; ++s)
#pragma unroll
                    for (int d = 0; d < 2; ++d) oA[d] = __builtin_amdgcn_mfma_f32_32x32x16_bf16(vf[d][s], pf[s], oA[d], 0, 0, 0);
            }
        };
        if (CROSS) {
            gload(0); lstore(0);
            __syncthreads();
            for (int t = 0; t < NT; ++t) {
                const int buf = t & 1;
                f32x16 pa, pb;
                qk(buf, pa, pb, 0.f);
                const float al = sm(t, buf, pa, pb, false);
                pv(buf, pa, pb, al);
                if (t + 1 < NT) { gload(t + 1); lstore(buf ^ 1); }
                TILE_BAR();
            }
        } else {
            gload(0); lstore(0); gload(1); lstore(1);
            gload(2); gloadB(3);
            __syncthreads();
            if (DIFF) bias_far = ((LAS float*)(lds + C::BT))[128];
            const int NTW = (q0w + 31) / 64 + 1;
            constexpr bool lead = LEAD;
            f32x16 ca, cb, na, nb; bool cnear = isnear(0), nnear = false; float cal = 1.f;
            qk(0, ca, cb, (DIFF && !cnear) ? bias_far : 0.f);
            if (lead) cal = sm(0, 0, ca, cb, cnear);
            int s0 = 0, s1 = 1, s2 = 2;
            auto period = [&](int t, f32x16& xa, f32x16& xb, bool& xnear, f32x16& ya, f32x16& yb, bool& ynear) {
                const bool have_next = (t + 1 < NTW);
                if (lead) {
                    if (have_next) { ynear = isnear(s1); qk(s1, ya, yb, (DIFF && !ynear) ? bias_far : 0.f); }
                    if (t < NTW) pv(s0, xa, xb, cal);
                    if (have_next) cal = sm(t + 1, s1, ya, yb, ynear);
                } else {
                    if (t < NTW) cal = sm(t, s0, xa, xb, xnear);
                    if (have_next) { ynear = isnear(s1); qk(s1, ya, yb, (DIFF && !ynear) ? bias_far : 0.f); }
                    if (t < NTW) pv(s0, xa, xb, cal);
                }
                { const int tmp = s0; s0 = s1; s1 = s2; s2 = tmp; }
            };
            int t = 0;
            for (; t + 5 < NT; t += 2) {
                lstore(s2); gload(t + 4);
                period(t, ca, cb, cnear, na, nb, nnear);
                TILE_BAR();
                lstoreB(s2); gloadB(t + 5);
                period(t + 1, na, nb, nnear, ca, cb, cnear);
                TILE_BAR();
            }
            for (; t < NT; t += 2) {
                if (t + 2 < NT) { lstore(s2); if (t + 4 < NT) gload(t + 4); }
                period(t, ca, cb, cnear, na, nb, nnear);
                TILE_BAR();
                if (t + 3 < NT) { lstoreB(s2); if (t + 5 < NT) gloadB(t + 5); }
                period(t + 1, na, nb, nnear, ca, cb, cnear);
                TILE_BAR();
            }
        }
        il = 1.f / swapadd(l1);
        if (DIFF) { if (mp == 0) {
#pragma unroll
            for (int d = 0; d < 2; ++d)
#pragma unroll
                for (int r = 0; r < 16; ++r) osv[(d * 16 + r) * 64] = oA[d][r] * il; } }
    }
    GAS bf16* orow = P.O + (rowb + qi) * P.op + (CROSS ? h * 256 + dhalf * 128 : h * 64);
    if (!DIFF) {
#pragma unroll
        for (int d = 0; d < ND; ++d)
#pragma unroll
            for (int g = 0; g < 4; ++g) { v2u v; v.x = cvtpk(oA[d][4 * g] * il, oA[d][4 * g + 1] * il); v.y = cvtpk(oA[d][4 * g + 2] * il, oA[d][4 * g + 3] * il); *(GAS v2u*)(orow + 32 * d + 8 * g + 4 * hi) = v; }
    } else {
        const float lam = P.lams[0], lam_init = P.lams[1];
        const float i2 = lam * il;
        float ss = 0.f;
#pragma unroll
        for (int d = 0; d < 2; ++d)
#pragma unroll
            for (int r = 0; r < 16; ++r) { const float v = osv[(d * 16 + r) * 64] - oA[d][r] * i2; oA[d][r] = v; ss += v * v; }
        ss = swapadd(ss);
        const float rs = __builtin_amdgcn_rsqf(ss * (1.f / 64.f) + 1e-6f) * (1.f - lam_init);
        const LAS float* dn = (const LAS float*)(lds + C::DN);
#pragma unroll
        for (int d = 0; d < 2; ++d)
#pragma unroll
            for (int g = 0; g < 4; ++g) { const int c = 32 * d + 8 * g + 4 * hi; const f32x4 gn = *(const LAS f32x4*)(dn + c);
                v2u v; v.x = cvtpk(oA[d][4 * g] * rs * gn[0], oA[d][4 * g + 1] * rs * gn[1]); v.y = cvtpk(oA[d][4 * g + 2] * rs * gn[2], oA[d][4 * g + 3] * rs * gn[3]); *(GAS v2u*)(orow + c) = v; }
    }
}

template <int KIND> struct AK2 {
    static constexpr bool DIFF = KIND == 1;
    static constexpr int HW = KIND == 0 ? 96 : 64, NKS = KIND == 0 ? 6 : 2, KP = KIND == 0 ? 208 : 144;
    static constexpr int CPK = HW / 8, KCH = (128 * CPK) / 512, VCH = 2;
    static constexpr int KB = 128 * KP, VB = 2 * 8192;
    static constexpr int K0 = 0, V0 = 2 * KB, POS = V0 + 2 * VB, PMX = POS + 1024, BT = PMX + 16, DN = BT + 528, OSV = (DN + 256 + 15) & ~15, END = OSV + (DIFF ? 8 * 8192 : 0);
};
static_assert(AK2<0>::END <= RING_BYTES && AK2<1>::END <= RING_BYTES, "attention LDS (128-key tiles)");
template <int KIND>
__device__ __forceinline__ void attn_unit2(const AttnP& P, int b, int h, int qb, LAS unsigned char* lds, int tid, int wave, int lane) {
    lane = lane_id_v(); tid = (wave << 6) | lane;
    typedef AK2<KIND> C;
    constexpr bool DIFF = C::DIFF;
    constexpr int HW = C::HW, NKS = C::NKS, KP = C::KP, CPK = C::CPK, KCH = C::KCH, VCH = C::VCH;
    const int r32 = lane & 31, hi = lane >> 5;
    const size_t rowb = (size_t)b * S;
    const int q0w = qb * 256 + wave * 32, qi = q0w + r32;
    int pq = 0; float bias_far = 0.f;
    __syncthreads();
    if (DIFF) {
        pq = P.pos[rowb + qi];
        if (tid < 129) ((LAS float*)(lds + C::BT))[tid] = P.btab[h * 129 + tid];
        if (tid >= 192 && tid < 256) ((LAS float*)(lds + C::DN))[tid - 192] = P.dnorm[tid - 192];
    }
    int minq = pq;
    if (DIFF) { for (int o = 1; o < 64; o <<= 1) { const int v = shxi(minq, o, lane); minq = v < minq ? v : minq; } }
    const int NT = 2 * (qb + 1);
    const GAS bf16* Kb = P.K + rowb * P.kp + h * HW; const GAS bf16* Vb = P.V + rowb * P.vp + h * 64;
    const __amdgpu_buffer_rsrc_t rK = __builtin_amdgcn_make_buffer_rsrc((void*)Kb, 0, 0x7fffffff, 0x00020000), rV = __builtin_amdgcn_make_buffer_rsrc((void*)Vb, 0, 0x7fffffff, 0x00020000);
    const __amdgpu_buffer_rsrc_t rP = __builtin_amdgcn_make_buffer_rsrc((void*)(DIFF ? P.pos + rowb : (const GAS int*)Kb), 0, 0x7fffffff, 0x00020000);
    int kvo[KCH], vvo[VCH], klo[KCH], vlo[VCH];
#pragma unroll
    for (int i = 0; i < KCH; ++i) { const int c = tid + 512 * i; kvo[i] = ((c / CPK) * P.kp + (c % CPK) * 8) * 2; klo[i] = (c / CPK) * KP + (c % CPK) * 16; }
#pragma unroll
    for (int i = 0; i < VCH; ++i) { const int c = tid + 512 * i; const int key = c >> 3, part = c & 7; vvo[i] = (key * P.vp + part * 8) * 2; vlo[i] = (part >> 2) * 8192 + (key >> 3) * 512 + (key & 7) * 64 + (part & 3) * 16; }
    const int pvo = (tid & 127) * 4;
    u32x4 kr[KCH], vr[VCH]; int pkr = 0;
    auto gload = [&](int t) {
        const int ks = __builtin_amdgcn_readfirstlane(128 * t * P.kp * 2), vs = __builtin_amdgcn_readfirstlane(128 * t * P.vp * 2);
#pragma unroll
        for (int i = 0; i < KCH; ++i) kr[i] = __builtin_amdgcn_raw_buffer_load_b128(rK, kvo[i], ks, 0);
#pragma unroll
        for (int i = 0; i < VCH; ++i) vr[i] = __builtin_amdgcn_raw_buffer_load_b128(rV, vvo[i], vs, 0);
        if (DIFF) pkr = __builtin_amdgcn_raw_buffer_load_b32(rP, pvo, __builtin_amdgcn_readfirstlane(128 * t * 4), 0);
    };
    auto lstore = [&](int buf) {
        LAS unsigned char* kb_ = lds + C::K0 + buf * C::KB; LAS unsigned char* vb_ = lds + C::V0 + buf * C::VB;
#pragma unroll
        for (int i = 0; i < KCH; ++i) *(LAS u32x4*)(kb_ + klo[i]) = kr[i];
#pragma unroll
        for (int i = 0; i < VCH; ++i) *(LAS u32x4*)(vb_ + vlo[i]) = vr[i];
        if (DIFF) { ((LAS int*)(lds + C::POS + buf * 512))[tid & 127] = pkr;
            if (tid < 128) { int mk_ = pkr; for (int o = 1; o < 64; o <<= 1) { const int v = shxi(mk_, o, lane); mk_ = v > mk_ ? v : mk_; } if (lane == 0) ((LAS int*)(lds + C::PMX))[buf * 2 + wave] = mk_; } }
    };
    LAS float* osv = (LAS float*)(lds + C::OSV) + wave * 2048 + lane;
    float il = 0.f;
    f32x16 oA[2];
#pragma unroll 1
    for (int mp = 0; mp < (DIFF ? 2 : 1); ++mp) {
        bf16x8 qf[NKS];
        { const GAS bf16* qrow = P.Q + (rowb + qi) * P.qp + h * HW + mp * 32;
#pragma unroll
          for (int s = 0; s < NKS; ++s) qf[s] = *(const GAS bf16x8*)(qrow + 16 * s + 8 * hi);
          if (KIND == 0) {
              const GAS float* rp = P.rope + (rowb + qi) * 32 + 8 * hi;
              const f32x4 c0 = *(const GAS f32x4*)rp, c1 = *(const GAS f32x4*)(rp + 4), s0 = *(const GAS f32x4*)(rp + 16), s1 = *(const GAS f32x4*)(rp + 20);
              const u32x4 a = __builtin_bit_cast(u32x4, qf[NKS - 2]), bq = __builtin_bit_cast(u32x4, qf[NKS - 1]); u32x4 ra, rb;
#pragma unroll
              for (int w = 0; w < 4; ++w) { const float cl = w < 2 ? c0[2 * w] : c1[2 * w - 4], ch = w < 2 ? c0[2 * w + 1] : c1[2 * w - 3], sl = w < 2 ? s0[2 * w] : s1[2 * w - 4], sh = w < 2 ? s0[2 * w + 1] : s1[2 * w - 3];
                  const float x1l = bflo(a[w]), x1h = bfhi(a[w]), x2l = bflo(bq[w]), x2h = bfhi(bq[w]);
                  ra[w] = cvtpk(x1l * cl - x2l * sl, x1h * ch - x2h * sh); rb[w] = cvtpk(x1l * sl + x2l * cl, x1h * sh + x2h * ch); }
              qf[NKS - 2] = __builtin_bit_cast(bf16x8, ra); qf[NKS - 1] = __builtin_bit_cast(bf16x8, rb);
          } }
        __syncthreads();
        float m1 = -1e30f, l1 = 0.f;
#pragma unroll
        for (int d = 0; d < 2; ++d)
#pragma unroll
            for (int r = 0; r < 16; ++r) oA[d][r] = 0.f;
        gload(0); lstore(0);
        if (NT > 1) gload(1);
        __syncthreads();
        if (DIFF) bias_far = ((LAS float*)(lds + C::BT))[128];
        const int NTW = (q0w + 31) / 128 + 1;
        auto compute = [&](int t, int buf) {
            const int k0 = 128 * t;
            const LAS unsigned char* kb_ = lds + C::K0 + buf * C::KB + r32 * KP + hi * 16 + mp * 64;
            const LAS unsigned char* vb_ = lds + C::V0 + buf * C::VB + ((lane >> 4) & 1) * 32 + (lane & 3) * 8 + (4 * hi + ((lane & 15) >> 2)) * 64;
            bool nearb = false;
            if (DIFF) { const LAS int* pm = (const LAS int*)(lds + C::PMX) + buf * 2; const int m0 = __builtin_amdgcn_readfirstlane(pm[0]), m1_ = __builtin_amdgcn_readfirstlane(pm[1]); nearb = (minq - (m0 > m1_ ? m0 : m1_)) < 128; }
            const float init = (DIFF && !nearb) ? bias_far : 0.f;
            f32x16 sc[4];
#pragma unroll
            for (int g = 0; g < 4; ++g)
#pragma unroll
                for (int r = 0; r < 16; ++r) sc[g][r] = init;
            constexpr int HB = NKS > 3 ? 3 : NKS;
#pragma unroll
            for (int s0_ = 0; s0_ < NKS; s0_ += HB) {
                bf16x8 kf[4][HB];
#pragma unroll
                for (int g = 0; g < 4; ++g)
#pragma unroll
                    for (int s = 0; s < HB; ++s) kf[g][s] = *(const LAS bf16x8*)(kb_ + 32 * g * KP + (s0_ + s) * 32);
                __builtin_amdgcn_sched_barrier(0);
#pragma unroll
                for (int s = 0; s < HB; ++s)
#pragma unroll
                    for (int g = 0; g < 4; ++g) sc[g] = __builtin_amdgcn_mfma_f32_32x32x16_bf16(kf[g][s], qf[s0_ + s], sc[g], 0, 0, 0);
                __builtin_amdgcn_sched_barrier(0);
            }
            if (DIFF) { if (nearb) {
                const LAS int* pk = (const LAS int*)(lds + C::POS + buf * 512); const LAS float* bt = (const LAS float*)(lds + C::BT);
#pragma unroll
                for (int g = 0; g < 4; ++g)
#pragma unroll
                    for (int r = 0; r < 16; ++r) { int n0 = pq - pk[32 * g + crow(r, hi)]; n0 = n0 < 0 ? 0 : (n0 > 128 ? 128 : n0); sc[g][r] += bt[n0]; }
            } }
            asm volatile("s_nop 15\n\ts_nop 7" : "+v"(sc[0]), "+v"(sc[1]), "+v"(sc[2]), "+v"(sc[3]));
            if (k0 + 127 > q0w) {
#pragma unroll
                for (int g = 0; g < 4; ++g)
#pragma unroll
                    for (int r = 0; r < 16; ++r) { if (k0 + 32 * g + crow(r, hi) > qi) sc[g][r] = -1e30f; }
            }
            const float mx = swapmax(vmax3(max32(sc[0], sc[1]), max32(sc[2], sc[3]), -1e30f)); const bool up = mx > m1 + 8.0f; const float mn = up ? mx : m1;
            float al = 1.f;
            if (__builtin_amdgcn_ballot_w64(up) != 0ull) { al = __builtin_amdgcn_exp2f(m1 - mn); l1 *= al; }
            m1 = mn;
            float ls = 0.f;
#pragma unroll
            for (int g = 0; g < 4; ++g)
#pragma unroll
                for (int r = 0; r < 16; ++r) { sc[g][r] = __builtin_amdgcn_exp2f(sc[g][r] - mn); ls += sc[g][r]; }
            l1 += ls;
            bf16x8 pf[8];
#pragma unroll
            for (int g = 0; g < 4; ++g) { pf[2 * g] = pack8(sc[g], 0); pf[2 * g + 1] = pack8(sc[g], 8); }
            if (__builtin_amdgcn_ballot_w64(al != 1.0f) != 0ull) {
#pragma unroll
                for (int d = 0; d < 2; ++d)
#pragma unroll
                    for (int r = 0; r < 16; ++r) oA[d][r] *= al;
            }
#pragma unroll
            for (int d = 0; d < 2; ++d) {
                bf16x8 vf[8];
#pragma unroll
                for (int s = 0; s < 8; ++s) { const s16x4 lo = vtr(vb_ + d * 8192 + s * 1024), hh = vtr(vb_ + d * 8192 + s * 1024 + 512); vf[s] = (bf16x8){lo[0], lo[1], lo[2], lo[3], hh[0], hh[1], hh[2], hh[3]}; }
                __builtin_amdgcn_sched_barrier(0);
#pragma unroll
                for (int s = 0; s < 8; ++s) oA[d] = __builtin_amdgcn_mfma_f32_32x32x16_bf16(vf[s], pf[s], oA[d], 0, 0, 0);
                __builtin_amdgcn_sched_barrier(0);
            }
        };
        int t = 0;
        for (; t + 2 < NT; ++t) {
            const int buf = t & 1;
            lstore(buf ^ 1); gload(t + 2);
            if (t < NTW) compute(t, buf);
            TILE_BAR();
        }
        for (; t < NT; ++t) {
            const int buf = t & 1;
            if (t + 1 < NT) lstore(buf ^ 1);
            if (t < NTW) compute(t, buf);
            TILE_BAR();
        }
        il = 1.f / swapadd(l1);
        if (DIFF) { if (mp == 0) {
#pragma unroll
            for (int d = 0; d < 2; ++d)
#pragma unroll
                for (int r = 0; r < 16; ++r) osv[(d * 16 + r) * 64] = oA[d][r] * il; } }
    }
    GAS bf16* orow = P.O + (rowb + qi) * P.op + h * 64;
    if (!DIFF) {
#pragma unroll
        for (int d = 0; d < 2; ++d)
#pragma unroll
            for (int g = 0; g < 4; ++g) { v2u v; v.x = cvtpk(oA[d][4 * g] * il, oA[d][4 * g + 1] * il); v.y = cvtpk(oA[d][4 * g + 2] * il, oA[d][4 * g + 3] * il); *(GAS v2u*)(orow + 32 * d + 8 * g + 4 * hi) = v; }
    } else {
        const float lam = P.lams[0], lam_init = P.lams[1];
        const float i2 = lam * il;
        float ss = 0.f;
#pragma unroll
        for (int d = 0; d < 2; ++d)
#pragma unroll
            for (int r = 0; r < 16; ++r) { const float v = osv[(d * 16 + r) * 64] - oA[d][r] * i2; oA[d][r] = v; ss += v * v; }
        ss = swapadd(ss);
        const float rs = __builtin_amdgcn_rsqf(ss * (1.f / 64.f) + 1e-6f) * (1.f - lam_init);
        const LAS float* dn = (const LAS float*)(lds + C::DN);
#pragma unroll
        for (int d = 0; d < 2; ++d)
#pragma unroll
            for (int g = 0; g < 4; ++g) { const int c = 32 * d + 8 * g + 4 * hi; const f32x4 gn = *(const LAS f32x4*)(dn + c);
                v2u v; v.x = cvtpk(oA[d][4 * g] * rs * gn[0], oA[d][4 * g + 1] * rs * gn[1]); v.y = cvtpk(oA[d][4 * g + 2] * rs * gn[2], oA[d][4 * g + 3] * rs * gn[3]); *(GAS v2u*)(orow + c) = v; }
    }
}

__device__ __forceinline__ void attn_phase(const AttnP& PM, const AttnP& PD, LAS unsigned char* lds, int tid, int wave, int lane, int vcu, int G, int only = -1) {
    for (int i = vcu; i < 512; i += G) {
        if (only >= 0 && (i >> 8) != only) continue;
        const int kind = i >> 8, c = i & 255, bh = c >> 4, s = c & 15;
        if (kind == 0) {
#pragma unroll 1
            for (int k = 0; k < 2; ++k) attn_unit2<0>(PM, bh >> 2, bh & 3, k ? 31 - s : s, lds, tid, wave, lane);
        } else {
#pragma unroll 1
            for (int k = 0; k < 2; ++k) attn_unit2<1>(PD, bh >> 2, bh & 3, k ? 31 - s : s, lds, tid, wave, lane);
        }
    }
}
__device__ __forceinline__ void cross_phase(const AttnP& PC, LAS unsigned char* lds, int tid, int wave, int lane, int vcu, int G) {
#pragma unroll 1
    for (int i = vcu; i < 1024; i += G) { const int bh = i >> 6; attn_unit<2, true>(PC, bh >> 2, bh & 3, i & 31, (i >> 5) & 1, lds, tid, wave, lane); }
}


__device__ __forceinline__ float vmax2(float a, float b) { float r; asm("v_max_f32_e32 %0, %1, %2" : "=v"(r) : "v"(a), "v"(b)); return r; }
__device__ __forceinline__ float vmin2(float a, float b) { float r; asm("v_min_f32_e32 %0, %1, %2" : "=v"(r) : "v"(a), "v"(b)); return r; }
__device__ __forceinline__ void pad16(float (&a)[16]) {
    asm volatile("s_nop 1" : "+v"(a[0]), "+v"(a[1]), "+v"(a[2]), "+v"(a[3]), "+v"(a[4]), "+v"(a[5]), "+v"(a[6]), "+v"(a[7]), "+v"(a[8]), "+v"(a[9]), "+v"(a[10]), "+v"(a[11]), "+v"(a[12]), "+v"(a[13]), "+v"(a[14]), "+v"(a[15]));
}
__device__ __forceinline__ void sort16_desc(float (&a)[16]) {
#pragma unroll
    for (int k = 2; k <= 16; k <<= 1)
#pragma unroll
        for (int j = k >> 1; j > 0; j >>= 1)
#pragma unroll
            for (int i = 0; i < 16; ++i) { const int l = i ^ j; if (l > i) { const bool desc = ((i & k) == 0); const float hi_ = vmax2(a[i], a[l]), lo_ = vmin2(a[i], a[l]); a[i] = desc ? hi_ : lo_; a[l] = desc ? lo_ : hi_; } }
}
__device__ __forceinline__ void merge16_desc(float (&a)[16], const float (&b)[16]) {
#pragma unroll
    for (int i = 0; i < 16; ++i) a[i] = vmax2(a[i], b[15 - i]);
#pragma unroll
    for (int j = 8; j > 0; j >>= 1)
#pragma unroll
        for (int i = 0; i < 16; ++i) { const int l = i ^ j; if (l > i) { const float hi_ = vmax2(a[i], a[l]), lo_ = vmin2(a[i], a[l]); a[i] = hi_; a[l] = lo_; } }
}
__device__ __forceinline__ void top16_of_64(float (&g0)[16], float (&g1)[16], float (&g2)[16], float (&g3)[16]) {
    sort16_desc(g0); sort16_desc(g1); merge16_desc(g0, g1); sort16_desc(g2); sort16_desc(g3); merge16_desc(g2, g3); merge16_desc(g0, g2);
}
__device__ __forceinline__ float embed(float v, unsigned mask, unsigned id) { return __builtin_bit_cast(float, (__builtin_bit_cast(unsigned, v) & mask) | id); }
__device__ __forceinline__ float mkcand(float x, float y, unsigned id) { return embed(x + y, 0xFFFFFF00u, id); }

__device__ __forceinline__ void swap32(float& a, float& b) { asm volatile("v_nop\n\tv_nop\n\tv_permlane32_swap_b32 %0, %1" : "+v"(a), "+v"(b)); }
struct RouteP { const GAS bf16* QP; const GAS bf16* keys; GAS int* EX; GAS float* GW; };
constexpr int RT_KP = 144, RT_KEYS = 0, RT_SCR = 256 * RT_KP, RT_END = RT_SCR + 8 * 8192;
__device__ __forceinline__ void route_phase(const RouteP& P, LAS unsigned char* lds, int tid, int wave, int lane, int vcu, int G) {
    asm volatile("" : "+v"(tid), "+v"(lane));
    __syncthreads();
    for (int c = tid; c < 256 * 8; c += 512) { const int row = c >> 3, part = c & 7; *(LAS u32x4*)(lds + RT_KEYS + row * RT_KP + part * 16) = *(const u32x4*)(P.keys + row * 64 + part * 8); }
    __syncthreads();
    const int r32 = lane & 31, hi = lane >> 5;
    LAS int* scr = (LAS int*)(lds + RT_SCR + wave * 8192);
    for (int u = vcu; u < T / 32; u += G) {
        const size_t t = (size_t)u * 32 + r32; const int h = wave;
        float T2[2][16];
#pragma unroll
        for (int c = 0; c < 2; ++c) {
            bf16x8 qf[4];
            { const GAS bf16* q = P.QP + t * 1024 + h * 128 + c * 64 + 8 * hi;
#pragma unroll
              for (int s = 0; s < 4; ++s) qf[s] = *(const GAS bf16x8*)(q + 16 * s); }
            f32x16 sc[4];
#pragma unroll
            for (int m = 0; m < 4; ++m) {
#pragma unroll
                for (int r = 0; r < 16; ++r) sc[m][r] = 0.f;
#pragma unroll
                for (int s = 0; s < 4; ++s) { const bf16x8 a = *(const LAS bf16x8*)(lds + RT_KEYS + (c * 128 + 32 * m + r32) * RT_KP + s * 32 + hi * 16);
                    sc[m] = __builtin_amdgcn_mfma_f32_32x32x16_bf16(a, qf[s], sc[m], 0, 0, 0); }
            }
            float g0[16], g1[16], g2[16], g3[16];
            const unsigned h4 = 4u * (unsigned)hi;
#pragma unroll
            for (int r = 0; r < 16; ++r) { const unsigned kr_ = (unsigned)((r & 3) + 8 * (r >> 2));
                g0[r] = embed(sc[0][r], 0xFFFFFF80u, kr_ | h4); g1[r] = embed(sc[1][r], 0xFFFFFF80u, (32u + kr_) | h4); g2[r] = embed(sc[2][r], 0xFFFFFF80u, (64u + kr_) | h4); g3[r] = embed(sc[3][r], 0xFFFFFF80u, (96u + kr_) | h4); }
            top16_of_64(g0, g1, g2, g3);
            pad16(g0);
#pragma unroll
            for (int i = 0; i < 16; ++i) T2[c][i] = g0[i];
        }
        float A[16], Bv[16];
#pragma unroll
        for (int i = 0; i < 16; ++i) { A[i] = T2[0][i]; Bv[i] = T2[1][i]; swap32(A[i], Bv[i]); }
        merge16_desc(A, Bv);
        pad16(A);
        float T0[16], T1[16];
#pragma unroll
        for (int i = 0; i < 16; ++i) { T0[i] = A[i]; T1[i] = A[i]; swap32(T0[i], T1[i]); }
#pragma unroll
        for (int i = 0; i < 16; ++i) { scr[i * 64 + lane] = (int)(__builtin_bit_cast(unsigned, T0[i]) & 127u); scr[(16 + i) * 64 + lane] = (int)(__builtin_bit_cast(unsigned, T1[i]) & 127u);
            T0[i] = embed(T0[i], 0xFFFFFF80u, 0u); T1[i] = embed(T1[i], 0xFFFFFF80u, 0u); }
        float c0[16], c1[16], c2[16], c3[16];
        const float NINF = -__builtin_inff();
#pragma unroll
        for (int b = 0; b < 16; ++b) c0[b] = mkcand(T0[0], T1[b], (unsigned)b);
#pragma unroll
        for (int b = 0; b < 8; ++b) c1[b] = mkcand(T0[1], T1[b], 16u + b);
#pragma unroll
        for (int b = 0; b < 5; ++b) c1[8 + b] = mkcand(T0[2], T1[b], 32u + b);
#pragma unroll
        for (int b = 0; b < 3; ++b) c1[13 + b] = mkcand(T0[4], T1[b], 64u + b);
#pragma unroll
        for (int b = 0; b < 4; ++b) c2[b] = mkcand(T0[3], T1[b], 48u + b);
        c2[4] = mkcand(T0[5], T1[0], 80u); c2[5] = mkcand(T0[5], T1[1], 81u); c2[6] = mkcand(T0[6], T1[0], 96u); c2[7] = mkcand(T0[6], T1[1], 97u); c2[8] = mkcand(T0[7], T1[0], 112u); c2[9] = mkcand(T0[7], T1[1], 113u);
#pragma unroll
        for (int a = 8; a < 14; ++a) c2[10 + a - 8] = mkcand(T0[a], T1[0], 16u * a);
        c3[0] = mkcand(T0[14], T1[0], 224u); c3[1] = mkcand(T0[15], T1[0], 240u);
#pragma unroll
        for (int i = 2; i < 16; ++i) c3[i] = NINF;
        top16_of_64(c0, c1, c2, c3);
        pad16(c0);
        float gsum = 0.f, ge[16]; int ex[16];
        const float mtop = embed(c0[0], 0xFFFFFF00u, 0u);
#pragma unroll
        for (int i = 0; i < 16; ++i) { const unsigned bits = __builtin_bit_cast(unsigned, c0[i]); const int a = (bits >> 4) & 15, b = bits & 15;
            ge[i] = __builtin_amdgcn_exp2f((embed(c0[i], 0xFFFFFF00u, 0u) - mtop) * LOG2E); gsum += ge[i];
            ex[i] = scr[a * 64 + lane] * 128 + scr[(16 + b) * 64 + lane]; }
        const float ginv = __builtin_amdgcn_rcpf(gsum);
        if (hi == 0) { GAS v4u* d = (GAS v4u*)(P.EX + t * 128 + h * 16);
#pragma unroll
            for (int i = 0; i < 4; ++i) d[i] = (v4u){(unsigned)ex[4 * i], (unsigned)ex[4 * i + 1], (unsigned)ex[4 * i + 2], (unsigned)ex[4 * i + 3]}; }
        else { GAS f32x4* d = (GAS f32x4*)(P.GW + t * 128 + h * 16);
#pragma unroll
            for (int i = 0; i < 4; ++i) d[i] = (f32x4){ge[4 * i] * ginv, ge[4 * i + 1] * ginv, ge[4 * i + 2] * ginv, ge[4 * i + 3] * ginv}; }
    }
}

__device__ __forceinline__ int wave_allsum_i(int v) {
    v += __builtin_amdgcn_update_dpp(0, v, 0xB1, 0xF, 0xF, true);
    v += __builtin_amdgcn_update_dpp(0, v, 0x4E, 0xF, 0xF, true);
    v += __builtin_amdgcn_update_dpp(0, v, 0x141, 0xF, 0xF, true);
    v += __builtin_amdgcn_update_dpp(0, v, 0x140, 0xF, 0xF, true);
    { int a = v, b = v; asm volatile("v_nop\n\tv_nop\n\tv_permlane16_swap_b32 %0, %1" : "+v"(a), "+v"(b)); v = a + b; }
    { int a = v, b = v; asm volatile("v_nop\n\tv_nop\n\tv_permlane32_swap_b32 %0, %1" : "+v"(a), "+v"(b)); v = a + b; }
    return v;
}
__device__ __forceinline__ float wave_allsum(float v) {
    v += __builtin_bit_cast(float, __builtin_amdgcn_update_dpp(0, __builtin_bit_cast(int, v), 0xB1, 0xF, 0xF, true));
    v += __builtin_bit_cast(float, __builtin_amdgcn_update_dpp(0, __builtin_bit_cast(int, v), 0x4E, 0xF, 0xF, true));
    v += __builtin_bit_cast(float, __builtin_amdgcn_update_dpp(0, __builtin_bit_cast(int, v), 0x141, 0xF, 0xF, true));
    v += __builtin_bit_cast(float, __builtin_amdgcn_update_dpp(0, __builtin_bit_cast(int, v), 0x140, 0xF, 0xF, true));
    { float a = v, b = v; asm volatile("v_nop\n\tv_nop\n\tv_permlane16_swap_b32 %0, %1" : "+v"(a), "+v"(b)); v = a + b; }
    { float a = v, b = v; asm volatile("v_nop\n\tv_nop\n\tv_permlane32_swap_b32 %0, %1" : "+v"(a), "+v"(b)); v = a + b; }
    return v;
}
__device__ __forceinline__ float wave_allmax(float v) {
    v = fmaxf(v, __builtin_bit_cast(float, __builtin_amdgcn_update_dpp(0, __builtin_bit_cast(int, v), 0xB1, 0xF, 0xF, true)));
    v = fmaxf(v, __builtin_bit_cast(float, __builtin_amdgcn_update_dpp(0, __builtin_bit_cast(int, v), 0x4E, 0xF, 0xF, true)));
    v = fmaxf(v, __builtin_bit_cast(float, __builtin_amdgcn_update_dpp(0, __builtin_bit_cast(int, v), 0x141, 0xF, 0xF, true)));
    v = fmaxf(v, __builtin_bit_cast(float, __builtin_amdgcn_update_dpp(0, __builtin_bit_cast(int, v), 0x140, 0xF, 0xF, true)));
    { float a = v, b = v; asm volatile("v_nop\n\tv_nop\n\tv_permlane16_swap_b32 %0, %1" : "+v"(a), "+v"(b)); v = fmaxf(a, b); }
    { float a = v, b = v; asm volatile("v_nop\n\tv_nop\n\tv_permlane32_swap_b32 %0, %1" : "+v"(a), "+v"(b)); v = fmaxf(a, b); }
    return v;
}
__device__ __forceinline__ unsigned q4(float a, float b, float c, float d, int off) {
    const int ia = (int)__builtin_rintf(a) + off, ib = (int)__builtin_rintf(b) + off, ic = (int)__builtin_rintf(c) + off, id = (int)__builtin_rintf(d) + off;
    return (unsigned)(ia & 255) | ((unsigned)(ib & 255) << 8) | ((unsigned)(ic & 255) << 16) | ((unsigned)(id & 255) << 24);
}
__device__ __forceinline__ void quant_row(const GAS float* src, GAS unsigned* dst, GAS float* scale, int off, int lane) {
    const GAS f32x4* s = (const GAS f32x4*)src + 4 * lane; f32x4 v[4]; float m = 0.f;
#pragma unroll
    for (int i = 0; i < 4; ++i) { v[i] = s[i]; m = fmaxf(m, fmaxf(fmaxf(__builtin_fabsf(v[i].x), __builtin_fabsf(v[i].y)), fmaxf(__builtin_fabsf(v[i].z), __builtin_fabsf(v[i].w)))); }
    m = wave_allmax(m); const float inv = m > 0.f ? 127.f / m : 0.f;
    v4u w;
    w.x = q4(v[0].x * inv, v[0].y * inv, v[0].z * inv, v[0].w * inv, off); w.y = q4(v[1].x * inv, v[1].y * inv, v[1].z * inv, v[1].w * inv, off);
    w.z = q4(v[2].x * inv, v[2].y * inv, v[2].z * inv, v[2].w * inv, off); w.w = q4(v[3].x * inv, v[3].y * inv, v[3].z * inv, v[3].w * inv, off);
    *((GAS v4u*)dst + lane) = w;
    if (lane == 0) *scale = m * (1.f / 127.f);
}
struct PeerS { int nslices_step, first_slice, nloc, rank; };
__device__ __forceinline__ PeerS peer_sched(const GAS unsigned* rankw, int xcc, int rank) {
    int nx = 0, myidx = 0, nloc = 1;
    for (int j = 0; j < 16; ++j) { const int c = (int)__hip_atomic_load(rankw + 64 * j, __ATOMIC_RELAXED, __HIP_MEMORY_SCOPE_AGENT); if (c > 0) { if (j == xcc) { myidx = nx; nloc = c; } ++nx; } }
    PeerS s; s.nslices_step = nx > 0 ? nx : 1; s.first_slice = myidx; s.nloc = nloc; s.rank = rank; return s;
}
struct Peer1P { const GAS unsigned GAS char* HQ; const GAS int* EX; const GAS unsigned GAS char* U8; GAS int* P; };
__device__ __forceinline__ void peer_k1(const Peer1P& Q, const PeerS& sc, int wave, int lane) {
    asm volatile("" : "+v"(lane));
    const int g = lane >> 3, j = lane & 7;
    for (int s = sc.first_slice; s < 8; s += sc.nslices_step)
        for (int tile = sc.rank; tile < T / 64; tile += sc.nloc) {
            const size_t t0 = (size_t)tile * 64 + wave * 8;
            v4u hqn = *(const GAS v4u*)(Q.HQ + t0 * 1024 + 128 * s + 16 * j), exn[4];
#pragma unroll
            for (int i = 0; i < 4; ++i) exn[i] = *(const GAS v4u*)(Q.EX + t0 * 128 + 16 * g + 4 * i);
#pragma unroll 1
            for (int k = 0; k < 8; ++k) {
                const size_t t = t0 + k;
                const v4u hq = hqn; v4u ex[4];
#pragma unroll
                for (int i = 0; i < 4; ++i) ex[i] = exn[i];
                if (k + 1 < 8) {
                    hqn = *(const GAS v4u*)(Q.HQ + (t + 1) * 1024 + 128 * s + 16 * j);
#pragma unroll
                    for (int i = 0; i < 4; ++i) exn[i] = *(const GAS v4u*)(Q.EX + (t + 1) * 128 + 16 * g + 4 * i);
                }
                v4u uu[16];
#pragma unroll
                for (int i = 0; i < 16; ++i) { const unsigned e = (i & 3) == 0 ? ex[i >> 2].x : (i & 3) == 1 ? ex[i >> 2].y : (i & 3) == 2 ? ex[i >> 2].z : ex[i >> 2].w;
                    uu[i] = *(const GAS v4u*)(Q.U8 + (size_t)e * 1024 + 128 * s + 16 * j); }
                int lo = 0, hi = 0;
#pragma unroll
                for (int i = 0; i < 16; ++i) {
                    int p = __builtin_amdgcn_sdot4((int)uu[i].x, (int)hq.x, 0, false); p = __builtin_amdgcn_sdot4((int)uu[i].y, (int)hq.y, p, false); p = __builtin_amdgcn_sdot4((int)uu[i].z, (int)hq.z, p, false); p = __builtin_amdgcn_sdot4((int)uu[i].w, (int)hq.w, p, false);
                    p += __builtin_amdgcn_update_dpp(0, p, 0xB1, 0xF, 0xF, true); p += __builtin_amdgcn_update_dpp(0, p, 0x4E, 0xF, 0xF, true); p += __builtin_amdgcn_update_dpp(0, p, 0x141, 0xF, 0xF, true);
                    if (i < 8) lo = (j == i) ? p : lo; else hi = (j == i - 8) ? p : hi;
                }
                GAS int* prow = Q.P + t * 128 + 16 * g + j;
                (void)__hip_atomic_fetch_add(prow, lo, __ATOMIC_RELAXED, __HIP_MEMORY_SCOPE_AGENT); (void)__hip_atomic_fetch_add(prow + 8, hi, __ATOMIC_RELAXED, __HIP_MEMORY_SCOPE_AGENT);
            }
        }
}
__device__ __forceinline__ void peer_w(const GAS int* EX, const GAS float* GW, const GAS int* P, const GAS float* SH, const GAS float* SU, const GAS float* SV, GAS signed char* WQ, GAS float* WSC, int gw, int NGW, int lane) {
    asm volatile("" : "+v"(lane));
    for (int t = gw; t < T; t += NGW) {
        const float sh = SH[t];
#pragma unroll
        for (int q = 0; q < 2; ++q) { const size_t idx = (size_t)t * 128 + lane + 64 * q; const int e = EX[idx];
            const float w = GW[idx] * gelu_erf((float)P[idx] * (sh * SU[e])) * SV[e];
            float m = __builtin_fabsf(w);
            m = fmaxf(m, __builtin_bit_cast(float, __builtin_amdgcn_update_dpp(0, __builtin_bit_cast(int, m), 0xB1, 0xF, 0xF, true)));
            m = fmaxf(m, __builtin_bit_cast(float, __builtin_amdgcn_update_dpp(0, __builtin_bit_cast(int, m), 0x4E, 0xF, 0xF, true)));
            m = fmaxf(m, __builtin_bit_cast(float, __builtin_amdgcn_update_dpp(0, __builtin_bit_cast(int, m), 0x141, 0xF, 0xF, true)));
            m = fmaxf(m, __builtin_bit_cast(float, __builtin_amdgcn_update_dpp(0, __builtin_bit_cast(int, m), 0x140, 0xF, 0xF, true)));
            const float inv = m > 0.f ? 127.f / m : 0.f;
            WQ[idx] = (signed char)(int)__builtin_rintf(w * inv);
            if ((lane & 15) == 0) WSC[(size_t)t * 8 + (lane >> 4) + 4 * q] = m * (1.f / 127.f); }
    }
}
__device__ __forceinline__ void tr4x4(unsigned r0, unsigned r1, unsigned r2, unsigned r3, unsigned (&t)[4]) {
    const unsigned x0 = __builtin_amdgcn_perm(r1, r0, 0x05010400u), x1 = __builtin_amdgcn_perm(r1, r0, 0x07030602u), y0 = __builtin_amdgcn_perm(r3, r2, 0x05010400u), y1 = __builtin_amdgcn_perm(r3, r2, 0x07030602u);
    t[0] = __builtin_amdgcn_perm(y0, x0, 0x05040100u); t[1] = __builtin_amdgcn_perm(y0, x0, 0x07060302u); t[2] = __builtin_amdgcn_perm(y1, x1, 0x05040100u); t[3] = __builtin_amdgcn_perm(y1, x1, 0x07060302u);
}
struct Peer2P { const GAS int* EX; const GAS signed char* WQ; const GAS float* WSC; const GAS unsigned char* V8; GAS float* X; GAS bf16* XB; GAS float* SSQ; };
__device__ __forceinline__ void peer_k2(const Peer2P& Q, const PeerS& sc, int wave, int lane) {
    asm volatile("" : "+v"(lane));
    const int g = lane >> 3, j = lane & 7, hf = lane >> 5, rp = (lane >> 4) & 1;
    for (int s = sc.first_slice; s < 8; s += sc.nslices_step)
        for (int tile = sc.rank; tile < T / 64; tile += sc.nloc) {
            const size_t t0 = (size_t)tile * 64 + wave * 8;
            v4u exn[4], wqn; float swn;
#pragma unroll
            for (int i = 0; i < 4; ++i) exn[i] = *(const GAS v4u*)(Q.EX + t0 * 128 + 16 * g + 4 * i);
            wqn = *(const GAS v4u*)(Q.WQ + t0 * 128 + 16 * g); swn = Q.WSC[t0 * 8 + g];
#pragma unroll 1
            for (int k = 0; k < 8; ++k) {
                const size_t t = t0 + k;
                v4u ex[4]; const v4u wq = wqn; const float sw = swn;
#pragma unroll
                for (int i = 0; i < 4; ++i) ex[i] = exn[i];
                if (k + 1 < 8) {
#pragma unroll
                    for (int i = 0; i < 4; ++i) exn[i] = *(const GAS v4u*)(Q.EX + (t + 1) * 128 + 16 * g + 4 * i);
                    wqn = *(const GAS v4u*)(Q.WQ + (t + 1) * 128 + 16 * g); swn = Q.WSC[(t + 1) * 8 + g];
                }
                GAS f32x4* xp = (GAS f32x4*)(Q.X + t * 1024 + 128 * s + 16 * j + 8 * hf + 4 * rp);
                const f32x4 xold = *xp;
                v4u vv[16];
#pragma unroll
                for (int i = 0; i < 16; ++i) { const unsigned e = (i & 3) == 0 ? ex[i >> 2].x : (i & 3) == 1 ? ex[i >> 2].y : (i & 3) == 2 ? ex[i >> 2].z : ex[i >> 2].w;
                    vv[i] = *(const GAS v4u*)(Q.V8 + (size_t)e * 1024 + 128 * s + 16 * j); }
                int ai[16];
#pragma unroll
                for (int i = 0; i < 16; ++i) ai[i] = 0;
#pragma unroll
                for (int q4_ = 0; q4_ < 4; ++q4_) {
                    const unsigned wq4 = q4_ == 0 ? wq.x : q4_ == 1 ? wq.y : q4_ == 2 ? wq.z : wq.w;
#pragma unroll
                    for (int c = 0; c < 4; ++c) { unsigned tt[4];
                        const v4u &a0 = vv[4 * q4_], &a1 = vv[4 * q4_ + 1], &a2 = vv[4 * q4_ + 2], &a3 = vv[4 * q4_ + 3];
                        tr4x4(c == 0 ? a0.x : c == 1 ? a0.y : c == 2 ? a0.z : a0.w, c == 0 ? a1.x : c == 1 ? a1.y : c == 2 ? a1.z : a1.w, c == 0 ? a2.x : c == 1 ? a2.y : c == 2 ? a2.z : a2.w, c == 0 ? a3.x : c == 1 ? a3.y : c == 2 ? a3.z : a3.w, tt);
#pragma unroll
                        for (int b = 0; b < 4; ++b) ai[4 * c + b] = __builtin_amdgcn_sdot4((int)tt[b], (int)wq4, ai[4 * c + b], false); }
                }
                float acc[16];
#pragma unroll
                for (int i = 0; i < 16; ++i) acc[i] = (float)ai[i] * sw;
                float r8[8], r4[4];
#pragma unroll
                for (int m = 0; m < 8; ++m) { float a = acc[m], b = acc[m + 8]; swap32(a, b); r8[m] = a + b; }
#pragma unroll
                for (int n = 0; n < 4; ++n) { float a = r8[n], b = r8[n + 4]; asm volatile("v_nop\n\tv_nop\n\tv_permlane16_swap_b32 %0, %1" : "+v"(a), "+v"(b)); r4[n] = a + b; }
#pragma unroll
                for (int n = 0; n < 4; ++n) r4[n] += __builtin_bit_cast(float, __builtin_amdgcn_update_dpp(0, __builtin_bit_cast(int, r4[n]), 0x128, 0xF, 0xF, true));
                const f32x4 xn = xold + (f32x4){r4[0], r4[1], r4[2], r4[3]};
                float ss = (lane & 8) == 0 ? (xn[0] * xn[0] + xn[1] * xn[1]) + (xn[2] * xn[2] + xn[3] * xn[3]) : 0.f;
                ss = wave_allsum(ss);
                if ((lane & 8) == 0) { *xp = xn; if (Q.XB) { v2u w; w.x = pk2(xn[0], xn[1]); w.y = pk2(xn[2], xn[3]); *(GAS v2u*)(Q.XB + t * 1024 + 128 * s + 16 * j + 8 * hf + 4 * rp) = w; } }
                if (Q.SSQ) { if (lane == 0) Q.SSQ[t * 16 + s] = ss; }
            }
        }
}

struct Args { const float* in[33]; float* out; unsigned char* ws; int ph_lo, ph_hi; };
struct Frame { LAS unsigned char* lds; volatile LAS unsigned* MISC; gu32* ctl; int tid, lane, wave, G, vcu, xcc, xrank; };

__device__ __forceinline__ void transpose_item(const float* W, int ldw, int nsrc0, bf16* WT, int ldt, int rdst0, LAS float* scr, int kb, int nb, int lane, float scale, const float* kgain) {
    const int k0 = 64 * kb, n0 = 32 * nb;
#pragma unroll 8
    for (int i = 0; i < 32; ++i) { const int kk = 2 * i + (lane >> 5); const float gsc = kgain ? kgain[k0 + kk] * scale : scale; scr[kk * 33 + (lane & 31)] = W[(size_t)(k0 + kk) * ldw + nsrc0 + n0 + (lane & 31)] * gsc; }
    LDS_WAIT(); asm volatile("" ::: "memory");
    const int c = lane & 7;
#pragma unroll
    for (int j = 0; j < 4; ++j) { const int n = (lane >> 3) + 8 * j; const LAS float* s = scr + (8 * c) * 33 + n;
        v4u o; o.x = pk2(s[0 * 33], s[1 * 33]); o.y = pk2(s[2 * 33], s[3 * 33]); o.z = pk2(s[4 * 33], s[5 * 33]); o.w = pk2(s[6 * 33], s[7 * 33]);
        *(GAS v4u*)(WT + (size_t)(rdst0 + n0 + n) * ldt + k0 + 8 * c) = o; }
    LDS_WAIT(); asm volatile("" ::: "memory");
}
__device__ __forceinline__ void zero_rect(bf16* base, int ld, int row0, int nrows, int col0, int ncols, int gtid, int gthreads) {
    const int vpr = ncols / 8;
    for (int i = gtid; i < nrows * vpr; i += gthreads) { const int r = i / vpr, c = i % vpr; *(GAS v4u*)(base + (size_t)(row0 + r) * ld + col0 + 8 * c) = (v4u){0u, 0u, 0u, 0u}; }
}

__device__ __forceinline__ void p0_prologue(Frame& F, const Args& a) {
    LAS float* scr = (LAS float*)(F.lds + RING_OFF + F.wave * 16384);
    const int gw = blockIdx.x * NWAVES + F.wave, NGW = F.G * NWAVES;
    const int gtid = blockIdx.x * (NWAVES * 64) + F.tid, gthreads = F.G * NWAVES * 64;
    unsigned char* ws = a.ws;
    x0_phase((const GAS float*)a.in[0], (GAS bf16*)(ws + WS_XNB), (GAS float*)(ws + WS_SSQ), gw, NGW, F.lane);
    constexpr int I_IN = 16 * (INW / 32), I_SQ = 16 * 32, I_CKV = 16 * 64, I_UQ = 3 * 12, I_UKV = 2 * 16, I_L = I_IN + 4 * I_SQ + I_CKV + I_UQ + I_UKV;
    for (int it = gw; it < L * I_L; it += NGW) {
        const int l = it / I_L; int r = it % I_L;
        if (r < I_IN) {
            const int kb = r / 67, nb = r % 67; int src, dst; float sc = 1.f;
            if (nb < 6) { src = 32 * nb; dst = src; } else if (nb < 11) { src = 32 * nb; dst = src + 64; } else { src = 32 * nb; dst = src + 160; if (nb >= 43 && nb < 51) sc = 0.17677669529663687f * LOG2E; }
            transpose_item(a.in[5] + (size_t)l * D * INW, INW, src, (bf16*)(ws + WS_WIN) + (size_t)l * INP * D, D, dst, scr, kb, 0, F.lane, sc, a.in[4] + l * D); continue; } r -= I_IN;
        if (r < I_SQ) { transpose_item(a.in[21] + (size_t)l * D * D, D, 0, (bf16*)(ws + WS_WOUT) + (size_t)l * D * D, D, 0, scr, r / 32, r % 32, F.lane, 1.f, nullptr); continue; } r -= I_SQ;
        if (r < I_SQ) { transpose_item(a.in[24] + (size_t)l * D * D, D, 0, (bf16*)(ws + WS_WCQ) + (size_t)l * D * D, D, 0, scr, r / 32, r % 32, F.lane, 0.0625f * LOG2E, a.in[22] + l * D); continue; } r -= I_SQ;
        if (r < I_SQ) { transpose_item(a.in[26] + (size_t)l * D * D, D, 0, (bf16*)(ws + WS_WCO) + (size_t)l * D * D, D, 0, scr, r / 32, r % 32, F.lane, 1.f, nullptr); continue; } r -= I_SQ;
        if (r < I_SQ) { transpose_item(a.in[28] + (size_t)l * D * D, D, 0, (bf16*)(ws + WS_WPQ) + (size_t)l * D * D, D, 0, scr, r / 32, r % 32, F.lane, 1.f, a.in[27] + l * D); continue; } r -= I_SQ;
        if (r < I_CKV) { transpose_item(a.in[25] + (size_t)l * D * 2 * D, 2 * D, 0, (bf16*)(ws + WS_WCKV) + (size_t)l * 2 * D * D, D, 0, scr, r / 64, r % 64, F.lane, 1.f, nullptr); continue; } r -= I_CKV;
        if (r < I_UQ) { transpose_item(a.in[7] + (size_t)l * 192 * 384, 384, 0, (bf16*)(ws + WS_WUQ) + (size_t)l * 512 * 256, 256, 0, scr, r / 12, r % 12, F.lane, 0.10206207261596575f * LOG2E, a.in[6] + l * 192); continue; } r -= I_UQ;
        transpose_item(a.in[9] + (size_t)l * 128 * 512, 512, 0, (bf16*)(ws + WS_WUKV) + (size_t)l * 512 * 256, 256, 0, scr, r / 16, r % 16, F.lane, 1.f, a.in[8] + l * 128);
    }
    for (int l = 0; l < L; ++l) {
        bf16* win = (bf16*)(ws + WS_WIN) + (size_t)l * INP * D; bf16* wuq = (bf16*)(ws + WS_WUQ) + (size_t)l * 512 * 256; bf16* wukv = (bf16*)(ws + WS_WUKV) + (size_t)l * 512 * 256;
        zero_rect(win, D, 192, 64, 0, D, gtid, gthreads); zero_rect(win, D, 416, 96, 0, D, gtid, gthreads);
        zero_rect(wuq, 256, 0, 384, 192, 64, gtid, gthreads); zero_rect(wuq, 256, 384, 128, 0, 256, gtid, gthreads);
        zero_rect(wukv, 256, 0, 512, 128, 128, gtid, gthreads);
    }
    { float* rope = (float*)(ws + WS_ROPE); const int* pos = (const int*)a.in[2];
      for (int i = gtid; i < T * 16; i += gthreads) { const int t = i >> 4, k = i & 15; const float inv = powf(10000.f, -(float)(2 * k) / 32.f); const float ang = (float)pos[t] * inv;
          rope[(size_t)t * 32 + k] = cosf(ang); rope[(size_t)t * 32 + 16 + k] = sinf(ang); } }
    { const GAS f32x4* ks = (const GAS f32x4*)a.in[29]; GAS v2u* kd = (GAS v2u*)(ws + WS_KEYS);
      for (int i = gtid; i < L * 2 * 128 * 64 / 4; i += gthreads) { const f32x4 v = ks[i]; v2u w; w.x = pk2(v.x, v.y); w.y = pk2(v.z, v.w); kd[i] = w; }
    }
    for (int r = gw; r < 2 * L * 16384; r += NGW) { const int tb = r / (L * 16384), rr = r % (L * 16384);
        quant_row((const GAS float*)a.in[30 + tb] + (size_t)rr * 1024, (GAS unsigned*)(ws + (tb ? WS_V8 : WS_U8) + (size_t)rr * 1024), (GAS float*)(ws + (tb ? WS_SV : WS_SU)) + rr, 0, F.lane); }
    { float* btab = (float*)(ws + WS_BTAB); float* lams = (float*)(ws + WS_LAMS); float* spt = (float*)(ws + WS_SP);
      for (int i = gtid; i < 4 * 129; i += gthreads) { const int h = i / 129, n = i % 129; int bu; if (n < 16) bu = n; else { const int lg = 16 + (int)(logf((float)n / 16.f) / logf(8.f) * 16.f); bu = lg < 31 ? lg : 31; }
          btab[i] = a.in[3][bu * 4 + h] * LOG2E; }
      for (int i = gtid; i < L; i += gthreads) { const float* dl = a.in[17] + i * 128; float s1 = 0.f, s2 = 0.f; for (int j = 0; j < 32; ++j) { s1 += dl[j] * dl[32 + j]; s2 += dl[64 + j] * dl[96 + j]; }
          const float li = 0.8f - 0.6f * expf(-0.3f * (float)i); lams[2 * i] = expf(s1) - expf(s2) + li; lams[2 * i + 1] = li; }
      for (int i = gtid; i < L * 512; i += gthreads) spt[i] = log1pf(expf(-a.in[16][i])); }
    for (int l = 0; l < L; ++l) norm_phase((const GAS float*)a.in[1], (const GAS float*)a.in[23] + l * D, (GAS bf16*)(ws + WS_MNB) + (size_t)l * NB * MEM * D, NB * MEM, gw, NGW, F.lane);
}

constexpr int NPL = 16, PH_FINAL = 2 + NPL * L;
__global__ void __launch_bounds__(NWAVES * 64, 2) fwd(Args args) {
    extern __shared__ __attribute__((aligned(16))) unsigned char lds[];
    Frame F;
    F.lds = (LAS unsigned char*)lds; F.MISC = (volatile LAS unsigned*)(F.lds + MISC_OFF);
    F.tid = threadIdx.x; F.lane = F.tid & 63; F.wave = __builtin_amdgcn_readfirstlane(F.tid >> 6); F.G = gridDim.x;
    F.vcu = (F.G % 8 == 0) ? ((int)blockIdx.x % 8) * (F.G / 8) + (int)blockIdx.x / 8 : (int)blockIdx.x;
    unsigned char* ws = args.ws;
    F.ctl = (gu32*)(opq(ws) + WS_CTL);
    for (int u = F.tid; u < (LDS_BYTES - LDSCTL_OFF) / 4; u += NWAVES * 64) ((LAS unsigned*)(F.lds + LDSCTL_OFF))[u] = 0u;
    __syncthreads();
    XcdBarrier bar = xcd_barrier_post((unsigned*)(F.ctl + CW_BAR), F.MISC + 8);
    F.xcc = (int)bar.x;
    if (F.tid == 0) F.MISC[12] = __hip_atomic_fetch_add((unsigned*)(F.ctl + CW_RANK) + 64 * bar.x, 1u, __ATOMIC_RELAXED, __HIP_MEMORY_SCOPE_AGENT);
    __syncthreads();
    F.xrank = __builtin_amdgcn_readfirstlane((int)F.MISC[12]);
    const int lo = args.ph_lo, hi = args.ph_hi;
    const int gw = blockIdx.x * NWAVES + F.wave, NGW = F.G * NWAVES;
#define IN(k) (lo <= (k) && (k) < hi)
#define LANE_ (lane_id_v())
#define TID_ ((opqi(F.wave) << 6) | LANE_)
#define SITE() const int G_ = opqi(F.G), wv_ = opqi(F.wave), vcu_ = opqi(F.vcu), gw_ = opqi(gw), NGW_ = opqi(NGW); (void)G_; (void)wv_; (void)vcu_; (void)gw_; (void)NGW_
#define SEAM(k) do { if (IN(k) && IN((k) + 1)) xcd_barrier(bar, (F.wave == 0 && lane_id_v() == 0) ? 1 : 0); } while (0)
#define GEMM_SITE(EPI, Aptr, lda_, Bptr, ldb_, M_, N_, K_, cperm, ...) do { \
        pg8::Gemm g{opq(Aptr), opq(Bptr), M_, N_, K_, lda_, ldb_}; pg8::StaticOrder So; So.init(M_, N_, opqi(F.G), opqi(cperm)); pg8::EPI E{__VA_ARGS__}; \
        pg8::gemm_phase<pg8::EPI, pg8::StaticOrder, true, true>(F.lds + RING_OFF, g, So, E, opqi(F.wave)); } while (0)
    if (IN(0)) { p0_prologue(F, args); }
    SEAM(0);
    if (IN(1)) {
#pragma unroll 1
        for (int l = 0; l < L; ++l)
            GEMM_SITE(EpiBf16, (const GAS bf16*)(opq(ws) + WS_MNB) + (size_t)l * NB * MEM * D, D, (const GAS bf16*)(opq(ws) + WS_WCKV) + (size_t)l * 2 * D * D, D, NB * MEM, 2 * D, D, (int)((blockIdx.x + 64 * l) % F.G),
                      opq((GAS bf16*)(opq(ws) + WS_KVCB) + (size_t)l * NB * MEM * 2 * D), 2 * D, 2 * D, (const GAS float*)nullptr, 0);
    }
    SEAM(1);
    for (int l = 0; l < L; ++l) {
        const int pb = 2 + NPL * l;
        const GAS bf16* XNB = (const GAS bf16*)(opq(ws) + WS_XNB); const GAS bf16* YB = (const GAS bf16*)(opq(ws) + WS_YB); GAS bf16* PROJB = (GAS bf16*)(opq(ws) + WS_PROJB);
        if (IN(pb + 1)) GEMM_SITE(EpiBf16, XNB, D, (const GAS bf16*)(opq(ws) + WS_WIN) + (size_t)l * INP * D, D, T, INP, D, (int)blockIdx.x, opq(PROJB), INP, INP, opq((const GAS float*)(opq(ws) + WS_SSQ)), 8);
        SEAM(pb + 1);
        if (IN(pb + 2)) {
            SITE();
            pre_phase(opq((const GAS bf16*)PROJB), opq((const GAS float*)(opq(ws) + WS_ROPE)), opq((GAS float*)(opq(ws) + WS_RS)), opq((GAS bf16*)(opq(ws) + WS_KMB)), gw_, NGW_, LANE_);
            LruP LP{opq((const GAS bf16*)PROJB), (const GAS float*)args.in[opqi(10)] + l * 4 * 512, (const GAS float*)args.in[opqi(11)] + l * 512, (const GAS float*)args.in[opqi(12)] + (size_t)l * 8 * 4096, (const GAS float*)args.in[opqi(13)] + l * 512, (const GAS float*)args.in[opqi(14)] + (size_t)l * 8 * 4096, (const GAS float*)args.in[opqi(15)] + l * 512,
                    (const GAS float*)(opq(ws) + WS_SP) + l * 512, opq((GAS bf16*)(opq(ws) + WS_HLB)), opq((GAS bf16*)(opq(ws) + WS_ACB)), opq((GAS float*)(opq(ws) + WS_LSUM))};
            lru_phase(LP, F.lds, TID_, wv_, LANE_, vcu_, G_);
#if MK_DUP == 2
            lru_phase(LP, F.lds, TID_, wv_, LANE_, vcu_, G_);
#endif
        }
        SEAM(pb + 2);
        if (IN(pb + 3)) {
            GEMM_SITE(EpiUp, (const GAS bf16*)PROJB + PC_CQ, INP, (const GAS bf16*)(opq(ws) + WS_WUQ) + (size_t)l * 512 * 256, 256, T, 512, 256, (int)blockIdx.x,
                      opq((GAS bf16*)(opq(ws) + WS_QMB)), (GAS bf16*)nullptr, 384, 384, opq((const GAS float*)(opq(ws) + WS_RS)), 0, 0);
            GEMM_SITE(EpiUp, (const GAS bf16*)PROJB + PC_CKV, INP, (const GAS bf16*)(opq(ws) + WS_WUKV) + (size_t)l * 512 * 256, 256, T, 512, 256, (int)blockIdx.x,
                      opq((GAS bf16*)(opq(ws) + WS_KMB)), opq((GAS bf16*)(opq(ws) + WS_VMB)), 0, 512, opq((const GAS float*)(opq(ws) + WS_RS)), 1, 1);
        }
        SEAM(pb + 3);
        if (IN(pb + 4)) {
            SITE();
            AttnP PM{opq((const GAS bf16*)(opq(ws) + WS_QMB)), opq((const GAS bf16*)(opq(ws) + WS_KMB)), opq((const GAS bf16*)(opq(ws) + WS_VMB)), 384, 384, 256, opq((GAS bf16*)(opq(ws) + WS_OMB)), 256, opq((const GAS float*)(opq(ws) + WS_ROPE)), nullptr, nullptr, nullptr, nullptr};
            AttnP PD{opq((const GAS bf16*)PROJB + PC_QD), opq((const GAS bf16*)PROJB + PC_KD), opq((const GAS bf16*)PROJB + PC_VD), INP, INP, INP, opq((GAS bf16*)(opq(ws) + WS_YB) + 768), 1024, nullptr,
                     (const GAS int*)args.in[opqi(2)], (const GAS float*)(opq(ws) + WS_BTAB), (const GAS float*)args.in[opqi(18)] + l * 64, (const GAS float*)(opq(ws) + WS_LAMS) + 2 * l};
            attn_phase(PM, PD, F.lds, TID_, wv_, LANE_, vcu_, G_);
#if MK_DUP == 4
            __syncthreads(); attn_phase(PM, PD, F.lds, TID_, wv_, LANE_, vcu_, G_);
#elif MK_DUP == 40 || MK_DUP == 41
            __syncthreads(); attn_phase(PM, PD, F.lds, TID_, wv_, LANE_, vcu_, G_, MK_DUP - 40);
#endif
        }
        SEAM(pb + 4);
        if (IN(pb + 5)) {
            SITE();
            PostP PP{opq((const GAS bf16*)(opq(ws) + WS_OMB)), opq((const GAS bf16*)(opq(ws) + WS_HLB)), opq((const GAS bf16*)(opq(ws) + WS_ACB)), opq((const GAS float*)(opq(ws) + WS_LSUM)), opq((const GAS bf16*)PROJB), (const GAS float*)args.in[opqi(19)] + l * 256, (const GAS float*)args.in[opqi(20)] + l * 512, opq((GAS bf16*)(opq(ws) + WS_YB))};
            post_phase(PP, F.lds, TID_, wv_, LANE_, vcu_, G_);
        }
        SEAM(pb + 5);
        if (IN(pb + 6)) GEMM_SITE(EpiRes, YB, D, (const GAS bf16*)(opq(ws) + WS_WOUT) + (size_t)l * D * D, D, T, D, D, (int)blockIdx.x, opq(l == 0 ? (const GAS float*)args.in[opqi(0)] : (const GAS float*)args.out), opq((GAS float*)args.out), opq((GAS bf16*)(opq(ws) + WS_XNB)), opq((GAS float*)(opq(ws) + WS_SSQ)));
        SEAM(pb + 6);
        if (IN(pb + 8)) GEMM_SITE(EpiBf16, XNB, D, (const GAS bf16*)(opq(ws) + WS_WCQ) + (size_t)l * D * D, D, T, D, D, (int)blockIdx.x, opq(PROJB), D, D, opq((const GAS float*)(opq(ws) + WS_SSQ)), 16);
        SEAM(pb + 8);
        if (IN(pb + 9)) {
            SITE();
            const GAS bf16* kv = (const GAS bf16*)(opq(ws) + WS_KVCB) + (size_t)l * NB * MEM * 2 * D;
            AttnP PC{opq((const GAS bf16*)PROJB), opq(kv), opq(kv + D), 1024, 2 * D, 2 * D, opq((GAS bf16*)(opq(ws) + WS_YB)), 1024, nullptr, nullptr, nullptr, nullptr, nullptr};
            cross_phase(PC, F.lds, TID_, wv_, LANE_, vcu_, G_);
#if MK_DUP == 9
            cross_phase(PC, F.lds, TID_, wv_, LANE_, vcu_, G_);
#endif
        }
        SEAM(pb + 9);
        if (IN(pb + 10)) GEMM_SITE(EpiRes, YB, D, (const GAS bf16*)(opq(ws) + WS_WCO) + (size_t)l * D * D, D, T, D, D, (int)blockIdx.x, opq((const GAS float*)args.out), opq((GAS float*)args.out), opq((GAS bf16*)(opq(ws) + WS_XNB)), opq((GAS float*)(opq(ws) + WS_SSQ)));
        SEAM(pb + 10);
        if (IN(pb + 12)) { GEMM_SITE(EpiBf16, XNB, D, (const GAS bf16*)(opq(ws) + WS_WPQ) + (size_t)l * D * D, D, T, D, D, (int)blockIdx.x, opq(PROJB), D, D, opq((const GAS float*)(opq(ws) + WS_SSQ)), 16);
            SITE(); hq_phase(opq(XNB), opq((const GAS float*)(opq(ws) + WS_SSQ)), (const GAS float*)args.in[opqi(27)] + l * D, opq((GAS unsigned char*)(opq(ws) + WS_HQ)), opq((GAS float*)(opq(ws) + WS_SH)), opq((GAS int*)(opq(ws) + WS_P)), gw_, NGW_, LANE_); }
        SEAM(pb + 12);
        if (IN(pb + 13)) {
            SITE();
            RouteP RP{opq((const GAS bf16*)PROJB), opq((const GAS bf16*)(opq(ws) + WS_KEYS) + (size_t)l * 2 * 128 * 64), opq((GAS int*)(opq(ws) + WS_EX)), opq((GAS float*)(opq(ws) + WS_GW))};
            route_phase(RP, F.lds, TID_, wv_, LANE_, vcu_, G_);
#if MK_DUP == 13
            route_phase(RP, F.lds, TID_, wv_, LANE_, vcu_, G_);
#endif
        }
        SEAM(pb + 13);
        if (IN(pb + 14)) {
            SITE();
            const PeerS ps = peer_sched((const GAS unsigned*)(F.ctl + CW_RANK), opqi(F.xcc), opqi(F.xrank));
            Peer1P Q1{opq((const GAS unsigned char*)(opq(ws) + WS_HQ)), opq((const GAS int*)(opq(ws) + WS_EX)), opq((const GAS unsigned char*)(opq(ws) + WS_U8) + (size_t)l * 16384 * 1024), opq((GAS int*)(opq(ws) + WS_P))};
            peer_k1(Q1, ps, wv_, LANE_);
#if MK_DUP == 141
            { Peer1P Q1b = Q1; Q1b.P = (GAS int*)(opq(ws) + WS_PROJB); peer_k1(Q1b, ps, wv_, LANE_); }
#endif
        }
        SEAM(pb + 14);
        if (IN(pb + 15)) {
            SITE();
            peer_w(opq((const GAS int*)(opq(ws) + WS_EX)), opq((const GAS float*)(opq(ws) + WS_GW)), opq((const GAS int*)(opq(ws) + WS_P)), opq((const GAS float*)(opq(ws) + WS_SH)), opq((const GAS float*)(opq(ws) + WS_SU) + l * 16384), opq((const GAS float*)(opq(ws) + WS_SV) + l * 16384),
                   opq((GAS signed char*)(opq(ws) + WS_W)), opq((GAS float*)(opq(ws) + WS_WS)), gw_, NGW_, LANE_);
            xcd_barrier(bar, (F.wave == 0 && lane_id_v() == 0) ? 1 : 0);
            const PeerS ps = peer_sched((const GAS unsigned*)(F.ctl + CW_RANK), opqi(F.xcc), opqi(F.xrank));
            Peer2P Q2{opq((const GAS int*)(opq(ws) + WS_EX)), opq((const GAS signed char*)(opq(ws) + WS_W)), opq((const GAS float*)(opq(ws) + WS_WS)), opq((const GAS unsigned char*)(opq(ws) + WS_V8) + (size_t)l * 16384 * 1024), (GAS float*)args.out, opq((GAS bf16*)(opq(ws) + WS_XNB)), opq((GAS float*)(opq(ws) + WS_SSQ))};
            peer_k2(Q2, ps, wv_, LANE_);
#if MK_DUP == 151
            { Peer2P Q2b = Q2; Q2b.X = (GAS float*)(opq(ws) + WS_PROJB); peer_k2(Q2b, ps, wv_, LANE_); }
#endif
        }
        SEAM(pb + 15);
    }
    if (IN(PH_FINAL)) { SITE(); final_norm_phase((GAS float*)args.out, (const GAS float*)args.in[opqi(32)], T, gw_, NGW_, LANE_); }
#undef IN
#undef SEAM
#undef GEMM_SITE
}
}
extern "C" void kernel_launch(void* const* d_in, const int* in_sizes, int n_in, void* d_out, int out_size, void* d_ws, size_t ws_size, hipStream_t stream) {
    (void)in_sizes; (void)out_size;
    static int grid = 0;
    if (grid == 0) {
        int dev = 0, cus = 0, per_cu = 0;
        if (n_in != 33 || ws_size < mk::WS_END) { fprintf(stderr, "kernel_launch: unexpected n_in %d / ws_size %zu\n", n_in, ws_size); grid = -1; return; }
        if (hipGetDevice(&dev) != hipSuccess || hipDeviceGetAttribute(&cus, hipDeviceAttributeMultiprocessorCount, dev) != hipSuccess) { grid = -1; return; }
        if (hipFuncSetAttribute((const void*)mk::fwd, hipFuncAttributeMaxDynamicSharedMemorySize, mk::LDS_BYTES) != hipSuccess) { fprintf(stderr, "kernel_launch: hipFuncSetAttribute failed\n"); grid = -1; return; }
        if (hipOccupancyMaxActiveBlocksPerMultiprocessor(&per_cu, (const void*)mk::fwd, mk::NWAVES * 64, mk::LDS_BYTES) != hipSuccess || per_cu < 1) fprintf(stderr, "kernel_launch: occupancy query says %d\n", per_cu);
        (void)hipGetLastError();
        grid = cus;
    }
    if (grid < 0) return;
    unsigned char* ws = (unsigned char*)d_ws;
    (void)hipMemsetAsync(ws + mk::WS_CTL, 0, mk::CTL_ZERO_BYTES, stream);
    mk::Args a{};
    for (int i = 0; i < 33; ++i) a.in[i] = (const float*)d_in[i];
    a.out = (float*)d_out; a.ws = ws;
    auto run = [&](int lo, int hi) { a.ph_lo = lo; a.ph_hi = hi; hipLaunchKernelGGL(mk::fwd, dim3(grid), dim3(mk::NWAVES * 64), mk::LDS_BYTES, stream, a); };
#if MK_ONE_LAUNCH
    run(0, mk::PH_FINAL + 1);
#else
    for (int p = 0; p <= mk::PH_FINAL; ++p) {
        const int k = (p - 2) % mk::NPL, l = (p - 2) / mk::NPL;
#if MK_NAIVE_PEER == 2
        if (p >= 2 && p < mk::PH_FINAL && k == 14) {
            hipLaunchKernelGGL(k_peer, dim3(T), dim3(256), 0, stream, (const bf16_t*)(ws + mk::WS_XNB), (const int*)(ws + mk::WS_EX), (const float*)(ws + mk::WS_GW), (const float*)d_in[30] + (size_t)l * NEXP * D, (const float*)d_in[31] + (size_t)l * NEXP * D, (float*)d_out);
            continue; }
#elif MK_NAIVE_PEER == 1
        if (p >= 2 && p < mk::PH_FINAL && k == 13) {
            float* TQ = (float*)(ws + (size_t)806 * mk::MiB);
            hipLaunchKernelGGL(k_bf2f, dim3((unsigned)(((size_t)T * D + 255) / 256)), dim3(256), 0, stream, (const bf16_t*)(ws + mk::WS_PROJB), TQ, (long)T * D);
            hipLaunchKernelGGL(k_route, dim3(T), dim3(256), 0, stream, TQ, (const float*)d_in[29] + (size_t)l * 2 * 128 * 64, (int*)(ws + mk::WS_EX), (float*)(ws + mk::WS_GW));
            hipLaunchKernelGGL(k_peer, dim3(T), dim3(256), 0, stream, (const bf16_t*)(ws + mk::WS_XNB), (const int*)(ws + mk::WS_EX), (const float*)(ws + mk::WS_GW), (const float*)d_in[30] + (size_t)l * NEXP * D, (const float*)d_in[31] + (size_t)l * NEXP * D, (float*)d_out);
            continue; }
        if (p >= 2 && p < mk::PH_FINAL && k == 14) continue;
#endif
        run(p, p + 1); }
#endif
}
```

```cpp
#include <hip/hip_runtime.h>
#include <cstdint>
#include <cstdio>
#include <cmath>

#ifndef MK_ONE_LAUNCH
#define MK_ONE_LAUNCH 1
#endif
#ifndef MK_DUP
#define MK_DUP 0
#endif
#ifndef MK_NAIVE_PEER
#define MK_NAIVE_PEER 0
#endif
namespace pg8 {
#define PG8_LAS __attribute__((address_space(3)))
#ifndef GAS
#define GAS __attribute__((address_space(1)))
#endif
typedef unsigned short bf16_t;
typedef short bf16x8 __attribute__((ext_vector_type(8)));
typedef float f32x4 __attribute__((ext_vector_type(4)));
typedef unsigned u32x4 __attribute__((ext_vector_type(4)));
typedef unsigned u32x2 __attribute__((ext_vector_type(2)));
constexpr int BM = 256, BK = 64, HALF = 128, HTB = HALF * BK * 2, STAGE_BYTES = 8 * HTB, NXCD = 8, WGM = 8;
__host__ __device__ __forceinline__ int lds_byte(int r, int c) { const int st = (r >> 4) * 2 + (c >> 5), rr = r & 15, cc = c & 31, ob = rr * 64 + cc * 2; return st * 1024 + (ob ^ (((ob >> 9) & 1) << 5)); }
__host__ __device__ __forceinline__ void stage_rc(int b, int& R, int& C) { const int st = b / 1024, sb = b % 1024, swz = sb ^ (((sb >> 9) & 1) << 5); R = (st >> 1) * 16 + swz / 64; C = (st & 1) * 32 + (swz % 64) / 2; }
__host__ __device__ __forceinline__ int perm32(int rho) { const int n = rho >> 4, i = rho & 15; return 8 * (i >> 2) + 4 * n + (i & 3); }
__device__ __forceinline__ int pg8_lane_id() { int l; asm volatile("v_mbcnt_lo_u32_b32 %0, -1, 0\n\tv_mbcnt_hi_u32_b32 %0, -1, %0" : "=v"(l)); return l; }
struct Unit { int pm, pn; };
struct Gemm { const GAS bf16_t* A; const GAS bf16_t* Bt; int M, N, K, lda, ldb; };
struct StaticOrder {
    int nM, nN, nwg, G, c;
    __host__ __device__ void init(int M, int N, int G_, int c_) { nM = M / BM; nN = N / BM; nwg = nM * nN; G = G_; c = c_; }
    __host__ __device__ bool next(int i, Unit& u) const {
        const long L = (long)i * G + c; if (L >= nwg) return false;
        int wgid = (int)L; { const int q = nwg / NXCD, r = nwg % NXCD, xcd = wgid % NXCD, off = wgid / NXCD; wgid = (xcd < r ? xcd * (q + 1) : r * (q + 1) + (xcd - r) * q) + off; }
        const int nig = WGM * nN, gid = wgid / nig, fm = gid * WGM, gsz = (nM - fm) < WGM ? (nM - fm) : WGM;
        u.pm = fm + ((wgid % nig) % gsz); u.pn = (wgid % nig) / gsz; return true;
    }
    __device__ __forceinline__ void a_ready(const Unit&) const {}
    __device__ __forceinline__ void done(const Unit&) const {}
};
__device__ __forceinline__ unsigned cvt_pk_bf16(float lo, float hi) { unsigned r; asm volatile("v_cvt_pk_bf16_f32 %0, %1, %2" : "=v"(r) : "v"(lo), "v"(hi)); return r; }

struct EpiF32 {
    static constexpr bool PERM = false, AFTER_DRAIN = false;
    GAS float* C; int ldc; int nvalid; int accum;
    __device__ __forceinline__ void operator()(const f32x4 (&acc)[2][2][4][2], const Unit& u, int wr, int wc, int fr, int fq) const {
        { const int l_ = pg8_lane_id(); fr = l_ & 15; fq = l_ >> 4; }
#pragma unroll
        for (int ai = 0; ai < 2; ++ai)
#pragma unroll
            for (int m = 0; m < 4; ++m) { const size_t row = (size_t)u.pm * BM + ai * HALF + wr * 64 + m * 16 + fr;
#pragma unroll
                for (int bj = 0; bj < 2; ++bj)
#pragma unroll
                    for (int n = 0; n < 2; ++n) { const int col = u.pn * BM + bj * HALF + wc * 32 + n * 16 + 4 * fq;
                        if (col < nvalid) { GAS float* p = C + row * ldc + col; f32x4 v = acc[ai][bj][m][n]; if (accum) v += *(const GAS f32x4*)p; *(GAS f32x4*)p = v; } } }
    }
};
struct EpiBf16 {
    static constexpr bool PERM = true, AFTER_DRAIN = false;
    GAS bf16_t* O; int ldc; int nvalid; const GAS float* ssq; int np;
    __device__ __forceinline__ void operator()(const f32x4 (&acc)[2][2][4][2], const Unit& u, int wr, int wc, int fr, int fq) const {
        { const int l_ = pg8_lane_id(); fr = l_ & 15; fq = l_ >> 4; }
#pragma unroll
        for (int ai = 0; ai < 2; ++ai)
#pragma unroll
            for (int m = 0; m < 4; ++m) { const size_t row = (size_t)u.pm * BM + ai * HALF + wr * 64 + m * 16 + fr;
                float rs_ = 1.f;
                if (np > 0) { const GAS f32x4* sp = (const GAS f32x4*)(ssq + row * 16); f32x4 t = sp[0] + sp[1]; if (np > 8) t += sp[2] + sp[3]; rs_ = __builtin_amdgcn_rsqf(((t[0] + t[1]) + (t[2] + t[3])) * (1.f / 1024.f) + 1e-6f); }
#pragma unroll
                for (int bj = 0; bj < 2; ++bj) { const int col = u.pn * BM + bj * HALF + wc * 32 + 8 * fq;
                    if (col < nvalid) { const f32x4 v0 = acc[ai][bj][m][0] * rs_, v1 = acc[ai][bj][m][1] * rs_; u32x4 w; w.x = cvt_pk_bf16(v0[0], v0[1]); w.y = cvt_pk_bf16(v0[2], v0[3]); w.z = cvt_pk_bf16(v1[0], v1[1]); w.w = cvt_pk_bf16(v1[2], v1[3]);
                        *(GAS u32x4*)(O + row * ldc + col) = w; } } }
    }
};
struct EpiUp {
    static constexpr bool PERM = true, AFTER_DRAIN = false;
    GAS bf16_t* O; GAS bf16_t* O2; int ldc; int nvalid; const GAS float* rs; int rsi; int mode;
    __device__ __forceinline__ void operator()(const f32x4 (&acc)[2][2][4][2], const Unit& u, int wr, int wc, int fr, int fq) const {
        { const int l_ = pg8_lane_id(); fr = l_ & 15; fq = l_ >> 4; }
#pragma unroll
        for (int ai = 0; ai < 2; ++ai)
#pragma unroll
            for (int m = 0; m < 4; ++m) { const size_t row = (size_t)u.pm * BM + ai * HALF + wr * 64 + m * 16 + fr; const float s = rs[2 * row + rsi];
#pragma unroll
                for (int bj = 0; bj < 2; ++bj) { const int col = u.pn * BM + bj * HALF + wc * 32 + 8 * fq;
                    if (col < nvalid) { const f32x4 v0 = acc[ai][bj][m][0] * s, v1 = acc[ai][bj][m][1] * s; u32x4 w; w.x = cvt_pk_bf16(v0[0], v0[1]); w.y = cvt_pk_bf16(v0[2], v0[3]); w.z = cvt_pk_bf16(v1[0], v1[1]); w.w = cvt_pk_bf16(v1[2], v1[3]);
                        GAS bf16_t* dst;
                        if (mode == 0) dst = O + row * ldc + col;
                        else { const int h = col >> 7, j = col & 127; dst = (j < 64) ? O + row * 384 + h * 96 + j : O2 + row * 256 + h * 64 + (j - 64); }
                        *(GAS u32x4*)dst = w; } } }
    }
};

struct EpiRes {
    static constexpr bool PERM = false, AFTER_DRAIN = false;
    const GAS float* src; GAS float* dst; GAS bf16_t* XB; GAS float* SSQ;
    __device__ __forceinline__ void operator()(const f32x4 (&acc)[2][2][4][2], const Unit& u, int wr, int wc, int fr, int fq) const {
        { const int l_ = pg8_lane_id(); fr = l_ & 15; fq = l_ >> 4; }
#pragma unroll
        for (int ai = 0; ai < 2; ++ai)
#pragma unroll
            for (int m = 0; m < 4; ++m) { const size_t row = (size_t)u.pm * BM + ai * HALF + wr * 64 + m * 16 + fr; float ss = 0.f;
#pragma unroll
                for (int bj = 0; bj < 2; ++bj)
#pragma unroll
                    for (int n = 0; n < 2; ++n) { const size_t o = row * 1024 + u.pn * BM + bj * HALF + wc * 32 + n * 16 + 4 * fq;
                        const f32x4 v = acc[ai][bj][m][n] + *(const GAS f32x4*)(src + o); *(GAS f32x4*)(dst + o) = v;
                        u32x2 w; w.x = cvt_pk_bf16(v[0], v[1]); w.y = cvt_pk_bf16(v[2], v[3]); *(GAS u32x2*)(XB + o) = w;
                        ss += (v[0] * v[0] + v[1] * v[1]) + (v[2] * v[2] + v[3] * v[3]); }
                { float a = ss, b = ss; asm volatile("v_nop\n\tv_nop\n\tv_permlane16_swap_b32 %0, %1" : "+v"(a), "+v"(b)); ss = a + b; }
                { float a = ss, b = ss; asm volatile("v_nop\n\tv_nop\n\tv_permlane32_swap_b32 %0, %1" : "+v"(a), "+v"(b)); ss = a + b; }
                if (fq == 0) SSQ[row * 16 + 4 * u.pn + wc] = ss; }
    }
};
template <class Epi, class Sched, bool ALIGN_EPI = false, bool SP2 = false>
__device__ __forceinline__ void gemm_phase(PG8_LAS unsigned char* lds, const Gemm g, const Sched& S, const Epi& E, int wave_id) {
    int tid_ = (wave_id << 6) | pg8_lane_id(); asm volatile("" : "+v"(tid_));
    const int tid = tid_, wid = __builtin_amdgcn_readfirstlane(tid >> 6), lane = tid & 63, wr = wid >> 2, wc = wid & 3, fr = lane & 15, fq = lane >> 4;
    const int K = g.K, nt = K / BK;
    unsigned voffA[2], voffB[2];
#pragma unroll
    for (int i = 0; i < 2; ++i) { int R, C; stage_rc(tid * 16 + i * 8192, R, C); const int Rb = Epi::PERM ? ((R & ~31) + perm32(R & 31)) : R;
        voffA[i] = (unsigned)(R * g.lda + C) * 2u; voffB[i] = (unsigned)(Rb * g.ldb + C) * 2u; }
    const size_t kstep = (size_t)(BK * 2);
    const size_t hstepA = (size_t)HALF * g.lda * 2, hstepB = (size_t)HALF * g.ldb * 2;
    const size_t tstepA = 2 * hstepA, tstepB = 2 * hstepB;
    const unsigned ldsw = (unsigned)wid * 1024u;
    const int aoff = lds_byte(wr * 64 + fr, fq * 8), boff = lds_byte(wc * 32 + fr, fq * 8);
#define PG8_SA(b, h) (((b) * 2 + (h)) * HTB)
#define PG8_SB(b, h) ((4 + (b) * 2 + (h)) * HTB)
#define PG8_STAGE(bufoff, gbase, voff) do { _Pragma("unroll") for (int _i = 0; _i < 2; ++_i) \
        __builtin_amdgcn_global_load_lds((const unsigned*)((const char*)(gbase) + (voff)[_i]), (PG8_LAS unsigned*)(lds + (bufoff) + ldsw + _i * 8192), 16, 0, 0); } while (0)
#define PG8_LDA(dst, b, h) do { _Pragma("unroll") for (int m = 0; m < 4; ++m) _Pragma("unroll") for (int k = 0; k < 2; ++k) dst[m][k] = *(const PG8_LAS bf16x8*)(lds + PG8_SA(b, h) + aoff + m * 2048 + k * 1024); } while (0)
#define PG8_LDB(dst, b, h) do { _Pragma("unroll") for (int n = 0; n < 2; ++n) _Pragma("unroll") for (int k = 0; k < 2; ++k) dst[n][k] = *(const PG8_LAS bf16x8*)(lds + PG8_SB(b, h) + boff + n * 2048 + k * 1024); } while (0)
#define PG8_MMA(ai, bj, At, Bt) do { __builtin_amdgcn_s_setprio(1); _Pragma("unroll") for (int m = 0; m < 4; ++m) _Pragma("unroll") for (int n = 0; n < 2; ++n) _Pragma("unroll") for (int k = 0; k < 2; ++k) \
        acc[ai][bj][m][n] = __builtin_amdgcn_mfma_f32_16x16x32_bf16(Bt[n][k], At[m][k], acc[ai][bj][m][n], 0, 0, 0); __builtin_amdgcn_s_setprio(0); } while (0)
#define PG8_WAIT_V(n) asm volatile("s_waitcnt vmcnt(" #n ")" ::: "memory")
#define PG8_WAIT_L(n) asm volatile("s_waitcnt lgkmcnt(" #n ")" ::: "memory")
#define PG8_BAR __builtin_amdgcn_s_barrier()
#define PG8_SCHED __builtin_amdgcn_sched_barrier(0)
    Unit cur, nxt; int ui = 0;
    if (!S.next(0, cur)) return;
    f32x4 acc[2][2][4][2];
#pragma unroll
    for (int a = 0; a < 2; ++a)
#pragma unroll
        for (int b = 0; b < 2; ++b)
#pragma unroll
            for (int m = 0; m < 4; ++m)
#pragma unroll
                for (int n = 0; n < 2; ++n) acc[a][b][m][n] = (f32x4){0.f, 0.f, 0.f, 0.f};
    bf16x8 At[4][2], B0[2][2], B1[2][2];
    const char* cA = (const char*)g.A + (size_t)cur.pm * tstepA; const char* cB = (const char*)g.Bt + (size_t)cur.pn * tstepB;
    S.a_ready(cur);
    if constexpr (SP2) {
        PG8_STAGE(PG8_SB(0, 0), cB, voffB); PG8_STAGE(PG8_SB(0, 1), cB + hstepB, voffB); PG8_STAGE(PG8_SA(0, 0), cA, voffA); PG8_STAGE(PG8_SA(0, 1), cA + hstepA, voffA);
        if (wr == 1) PG8_BAR;
        PG8_WAIT_V(2); PG8_BAR;
        PG8_STAGE(PG8_SB(1, 0), cB + kstep, voffB); PG8_STAGE(PG8_SA(1, 0), cA + kstep, voffA); PG8_STAGE(PG8_SB(1, 1), cB + hstepB + kstep, voffB);
        PG8_WAIT_V(6); PG8_BAR;
    } else {
        PG8_STAGE(PG8_SB(0, 0), cB, voffB); PG8_STAGE(PG8_SA(0, 0), cA, voffA); PG8_STAGE(PG8_SB(0, 1), cB + hstepB, voffB); PG8_STAGE(PG8_SA(0, 1), cA + hstepA, voffA);
        if (wr == 1) PG8_BAR;
        PG8_WAIT_V(4); PG8_BAR;
        PG8_STAGE(PG8_SB(1, 0), cB + kstep, voffB); PG8_STAGE(PG8_SA(1, 0), cA + kstep, voffA); PG8_STAGE(PG8_SB(1, 1), cB + hstepB + kstep, voffB);
        PG8_WAIT_V(6); PG8_BAR;
    }
    for (;;) {
        const bool has_next = S.next(ui + 1, nxt);
        const char* nA = has_next ? (const char*)g.A + (size_t)nxt.pm * tstepA : cA; const char* nB = has_next ? (const char*)g.Bt + (size_t)nxt.pn * tstepB : cB;
        for (int t = 0; t < nt; t += 2) {
            const bool last = (t == nt - 2);
            const char* a1 = cA + (size_t)(t + 1) * kstep;
            const char* a2 = last ? nA : cA + (size_t)(t + 2) * kstep; const char* b2 = last ? nB : cB + (size_t)(t + 2) * kstep;
            const char* a3 = a2 + kstep; const char* b3 = b2 + kstep;
            if (last && has_next) S.a_ready(nxt);
            if constexpr (SP2) {
            PG8_LDB(B0, 0, 0); PG8_LDB(B1, 0, 1); PG8_SCHED; PG8_LDA(At, 0, 0); PG8_STAGE(PG8_SA(1, 1), a1 + hstepA, voffA);
            PG8_WAIT_V(8); PG8_WAIT_L(0); PG8_BAR; PG8_MMA(0, 0, At, B0); PG8_MMA(0, 1, At, B1); PG8_BAR; PG8_SCHED;
            PG8_LDA(At, 0, 1); PG8_STAGE(PG8_SB(0, 0), b2, voffB); PG8_STAGE(PG8_SB(0, 1), b2 + hstepB, voffB); PG8_STAGE(PG8_SA(0, 0), a2, voffA);
            PG8_WAIT_V(8); PG8_WAIT_L(0); PG8_BAR; PG8_MMA(1, 0, At, B0); PG8_MMA(1, 1, At, B1); PG8_BAR; PG8_SCHED;
            PG8_LDB(B0, 1, 0); PG8_LDB(B1, 1, 1); PG8_SCHED; PG8_LDA(At, 1, 0); PG8_STAGE(PG8_SA(0, 1), a2 + hstepA, voffA);
            PG8_WAIT_V(8); PG8_WAIT_L(0); PG8_BAR; PG8_MMA(0, 0, At, B0); PG8_MMA(0, 1, At, B1); PG8_BAR; PG8_SCHED;
            PG8_LDA(At, 1, 1); PG8_STAGE(PG8_SB(1, 0), b3, voffB); PG8_STAGE(PG8_SB(1, 1), b3 + hstepB, voffB); PG8_STAGE(PG8_SA(1, 0), a3, voffA);
            PG8_WAIT_V(8); PG8_WAIT_L(0); PG8_BAR; PG8_MMA(1, 0, At, B0); PG8_MMA(1, 1, At, B1); PG8_BAR; PG8_SCHED;
            } else {
            PG8_LDB(B0, 0, 0); PG8_SCHED; PG8_LDA(At, 0, 0); PG8_STAGE(PG8_SA(1, 1), a1 + hstepA, voffA);
            PG8_WAIT_L(8); PG8_BAR; PG8_WAIT_L(0); PG8_MMA(0, 0, At, B0); PG8_BAR; PG8_SCHED;
            PG8_LDB(B1, 0, 1); PG8_STAGE(PG8_SB(0, 0), b2, voffB);
            PG8_BAR; PG8_WAIT_L(0); PG8_MMA(0, 1, At, B1); PG8_BAR;
            PG8_LDA(At, 0, 1); PG8_STAGE(PG8_SA(0, 0), a2, voffA);
            PG8_BAR; PG8_WAIT_L(0); PG8_MMA(1, 0, At, B0); PG8_BAR; PG8_SCHED;
            PG8_STAGE(PG8_SB(0, 1), b2 + hstepB, voffB);
            PG8_WAIT_V(6); PG8_BAR; PG8_MMA(1, 1, At, B1); PG8_BAR;
            PG8_LDB(B0, 1, 0); PG8_SCHED; PG8_LDA(At, 1, 0); PG8_STAGE(PG8_SA(0, 1), a2 + hstepA, voffA);
            PG8_WAIT_L(8); PG8_BAR; PG8_WAIT_L(0); PG8_MMA(0, 0, At, B0); PG8_BAR; PG8_SCHED;
            PG8_LDB(B1, 1, 1); PG8_STAGE(PG8_SB(1, 0), b3, voffB);
            PG8_BAR; PG8_WAIT_L(0); PG8_MMA(0, 1, At, B1); PG8_BAR;
            PG8_LDA(At, 1, 1); PG8_STAGE(PG8_SA(1, 0), a3, voffA);
            PG8_BAR; PG8_WAIT_L(0); PG8_MMA(1, 0, At, B0); PG8_BAR; PG8_SCHED;
            PG8_STAGE(PG8_SB(1, 1), b3 + hstepB, voffB);
            PG8_WAIT_V(6); PG8_BAR; PG8_MMA(1, 1, At, B1); PG8_BAR;
            }
        }
        if constexpr (ALIGN_EPI) { if (wr == 0) PG8_BAR; }
        if constexpr (!Epi::AFTER_DRAIN) { E(acc, cur, wr, wc, fr, fq); S.done(cur); }
        if (!has_next) break;
#pragma unroll
        for (int a = 0; a < 2; ++a)
#pragma unroll
            for (int b = 0; b < 2; ++b)
#pragma unroll
                for (int m = 0; m < 4; ++m)
#pragma unroll
                    for (int n = 0; n < 2; ++n) acc[a][b][m][n] = (f32x4){0.f, 0.f, 0.f, 0.f};
        cur = nxt; cA = nA; cB = nB; ++ui;
        if constexpr (ALIGN_EPI) { if (wr == 1) PG8_BAR; }
    }
    PG8_WAIT_V(0);
    if constexpr (!ALIGN_EPI) { if (wr == 0) PG8_BAR; }
    PG8_BAR;
    if constexpr (Epi::AFTER_DRAIN) { E.fused(acc, cur, wr, wc, fr, fq, lds, wid, lane); S.done(cur); }
#undef PG8_SA
#undef PG8_SB
#undef PG8_STAGE
#undef PG8_LDA
#undef PG8_LDB
#undef PG8_MMA
#undef PG8_WAIT_V
#undef PG8_WAIT_L
#undef PG8_BAR
#undef PG8_SCHED
}
}

namespace mk {
#ifndef GAS
#define GAS __attribute__((address_space(1)))
#endif
#define LAS __attribute__((address_space(3)))
typedef unsigned short bf16;
typedef unsigned v4u __attribute__((ext_vector_type(4)));
typedef unsigned v2u __attribute__((ext_vector_type(2)));
typedef float f32x4 __attribute__((ext_vector_type(4)));
typedef GAS unsigned gu32;
#define LDS_WAIT() asm volatile("s_waitcnt lgkmcnt(0)" ::: "memory")
#define VM_WAIT() asm volatile("s_waitcnt vmcnt(0)" ::: "memory")
__device__ __forceinline__ unsigned f2bf_(float f) { unsigned u = __builtin_bit_cast(unsigned, f); return (u + 0x7fffu + ((u >> 16) & 1u)) >> 16; }
__device__ __forceinline__ unsigned pk2(float lo, float hi) { return f2bf_(lo) | (f2bf_(hi) << 16); }
__device__ __forceinline__ float bflo(unsigned w) { return __builtin_bit_cast(float, w << 16); }
__device__ __forceinline__ float bfhi(unsigned w) { return __builtin_bit_cast(float, w & 0xffff0000u); }

template <class P> __device__ __forceinline__ P* opq(P* p) { asm volatile("" : "+s"(p)); return p; }
__device__ __forceinline__ int opqi(int k) { asm volatile("" : "+s"(k)); return k; }
__device__ __forceinline__ float shx(float v, int o, int lane) { return __builtin_bit_cast(float, __builtin_amdgcn_ds_bpermute((lane ^ o) << 2, __builtin_bit_cast(int, v))); }
__device__ __forceinline__ int shxi(int v, int o, int lane) { return __builtin_amdgcn_ds_bpermute((lane ^ o) << 2, v); }
__device__ __forceinline__ int lane_id_v() { int l; asm volatile("v_mbcnt_lo_u32_b32 %0, -1, 0\n\tv_mbcnt_hi_u32_b32 %0, -1, %0" : "=v"(l)); return l; }
constexpr int NWAVES = 8;
constexpr int D = 1024, NB = 4, S = 8192, T = NB * S, L = 4, MEM = 256, INW = 2144, INP = 2304;
constexpr int PC_CQ = 0, PC_CKV = 256, PC_KR = 384, PC_XL = 512, PC_GL = 1024, PC_QD = 1536, PC_KD = 1792, PC_VD = 2048;
constexpr float LOG2E = 1.4426950408889634f;
constexpr size_t MiB = 1u << 20;
constexpr size_t WS_CTL = 0, CTL_ZERO_BYTES = 1 * MiB;
constexpr size_t WS_WIN = 1 * MiB, WS_WOUT = 19 * MiB, WS_WCQ = 27 * MiB, WS_WCO = 35 * MiB, WS_WPQ = 43 * MiB, WS_WCKV = 51 * MiB, WS_WUQ = 67 * MiB, WS_WUKV = 68 * MiB, WS_KEYS = 69 * MiB, WS_ROPE = 70 * MiB;
constexpr size_t WS_XNB = 76 * MiB, WS_YB = 140 * MiB, WS_PROJB = 204 * MiB, WS_QMB = 348 * MiB, WS_KMB = 372 * MiB, WS_VMB = 396 * MiB, WS_RS = 412 * MiB;
constexpr size_t WS_HLB = 413 * MiB, WS_ACB = 445 * MiB, WS_LSUM = 477 * MiB, WS_OMB = 478 * MiB, WS_MNB = 494 * MiB, WS_KVCB = 502 * MiB, WS_EX = 518 * MiB, WS_GW = 534 * MiB;
constexpr size_t WS_U8 = 550 * MiB, WS_V8 = 614 * MiB, WS_SU = 678 * MiB, WS_SV = 679 * MiB;
constexpr size_t WS_HQ = 680 * MiB, WS_P = 712 * MiB, WS_SH = 728 * MiB, WS_W = 729 * MiB, WS_WS = 745 * MiB, WS_SSQ = 746 * MiB, WS_END = 748 * MiB;
constexpr size_t WS_BTAB = WS_KEYS + 512 * 1024, WS_LAMS = WS_BTAB + 4096, WS_SP = WS_LAMS + 4096;
constexpr int CW_BAR = 4096, CW_RANK = 8192;
constexpr int RING_OFF = 0, RING_BYTES = 155648, LDSCTL_OFF = RING_BYTES, MISC_OFF = LDSCTL_OFF + 320, LDS_BYTES = 163840;

#define XB_TMO      128
#define XB_XCNT(j)  (256  + 64 * (j))
#define XB_XSUB(j)  (1280 + 64 * (j))
#define XB_XGEN(j)  (2304 + 64 * (j))
#define XB_TOP      3328
#define XB_TOPGEN   3392
#define XCD_BAR_WORDS 3456
#define XB_SPIN_CAP (1u << 18)

__device__ __forceinline__ unsigned xb_ld(unsigned* p)              { return __hip_atomic_load(p, __ATOMIC_RELAXED, __HIP_MEMORY_SCOPE_AGENT); }
__device__ __forceinline__ unsigned xb_add(unsigned* p, unsigned v) { return __hip_atomic_fetch_add(p, v, __ATOMIC_RELAXED, __HIP_MEMORY_SCOPE_AGENT); }
__device__ __forceinline__ unsigned xb_xcc_id() { return (unsigned)__builtin_amdgcn_s_getreg((3 << 11) | 20) & 0xFu; }
#define XB_SPIN(cond, bar) do { unsigned _sp = 0; while (cond) { __builtin_amdgcn_s_sleep(1); \
    if ((++_sp & 255u) == 0u) { if (xb_ld(&(bar)[XB_TMO])) break; if (_sp > XB_SPIN_CAP) { atomicAdd(&(bar)[XB_TMO], 1u); break; } } } } while (0)

struct XcdBarrier {
    unsigned* bar; unsigned x;
    volatile LAS unsigned* st;
};

__device__ __forceinline__ XcdBarrier xcd_barrier_post(unsigned* bar, volatile LAS unsigned* st) {
    XcdBarrier b; b.bar = bar; b.x = xb_xcc_id(); b.st = st;
    if (threadIdx.x == 0) (void)xb_add(&bar[XB_XCNT(b.x)], 1u);
    return b;
}
__device__ __forceinline__ void xcd_barrier_complete(unsigned* bar, unsigned x, unsigned& nloc, unsigned& nx) {
    const unsigned G = gridDim.x * gridDim.y * gridDim.z;
    unsigned sum, cnt, mine, sp = 0u;
    for (;;) {
        sum = 0u; cnt = 0u; mine = 0u;
#pragma unroll
        for (unsigned j = 0; j < 16; ++j) { const unsigned c = xb_ld(&bar[XB_XCNT(j)]); sum += c; cnt += (c > 0u) ? 1u : 0u; mine = (j == x) ? c : mine; }
        if (sum == G) break;
        __builtin_amdgcn_s_sleep(1);
        if ((++sp & 255u) == 0u) { if (xb_ld(&bar[XB_TMO])) break; if (sp > XB_SPIN_CAP) { atomicAdd(&bar[XB_TMO], 1u); break; } }
    }
    nloc = mine > 0u ? mine : 1u; nx = cnt > 0u ? cnt : 1u;
}

__device__ __noinline__ void xcd_barrier_impl(unsigned* bar_, unsigned x_, volatile LAS unsigned* st_, int leader_) {
    XcdBarrier b; b.bar = bar_; b.x = x_; b.st = st_;
    asm volatile("s_waitcnt vmcnt(0)" ::: "memory");
    __syncthreads();
    if (leader_) {
        unsigned* bar = b.bar;
        __builtin_amdgcn_s_waitcnt(0);
        unsigned nloc = b.st[0], nx = b.st[1];
        if (nloc == 0u) { xcd_barrier_complete(bar, b.x, nloc, nx); b.st[0] = nloc; b.st[1] = nx; }
        const unsigned old = xb_add(&bar[XB_XSUB(b.x)], 1u);
        const unsigned gen = old / nloc;
        if (old + 1u == (gen + 1u) * nloc) {
            __builtin_amdgcn_fence(__ATOMIC_RELEASE, "agent");
            asm volatile("s_waitcnt vmcnt(0)" ::: "memory");
            const unsigned og = xb_add(&bar[XB_TOP], 1u);
            const unsigned tg = og / nx;
            if (og + 1u == (tg + 1u) * nx) xb_add(&bar[XB_TOPGEN], 1u);
            else XB_SPIN(xb_ld(&bar[XB_TOPGEN]) == tg, bar);
            __builtin_amdgcn_fence(__ATOMIC_ACQUIRE, "agent");
            xb_add(&bar[XB_XGEN(b.x)], 1u);
            asm volatile("s_waitcnt vmcnt(0)" ::: "memory");
        } else {
            XB_SPIN(xb_ld(&bar[XB_XGEN(b.x)]) == gen, bar);
            __builtin_amdgcn_fence(__ATOMIC_ACQUIRE, "agent");
            asm volatile("s_waitcnt vmcnt(0)" ::: "memory");
        }
    }
    __syncthreads();
}
__device__ __forceinline__ void xcd_barrier(const XcdBarrier& b, int leader) { xcd_barrier_impl(b.bar, b.x, b.st, leader); }


__device__ __forceinline__ float wave_sum(float v, int lane) {
#pragma unroll
    for (int o = 1; o < 64; o <<= 1) v += shx(v, o, lane);
    return v;
}
__device__ __forceinline__ float gelu_erf(float v) {
    const float av = __builtin_fabsf(v), t = __builtin_amdgcn_rcpf(av * 0.2316418882f + 1.0f);
    float q = t * 0.5307027145f + (-0.7265760135f); q = q * t + 0.7107068705f; q = q * t + (-0.142248368f); q = q * t + 0.127414796f; q = q * t;
    const float e = __builtin_amdgcn_exp2f((v * v) * (-0.72134752044f));
    const float m = v * (q * e);
    return v < 0.f ? m : v - m;
}

__device__ __forceinline__ void norm_phase(const GAS float* X, const GAS float* g, GAS bf16* out, int rows, int gw, int NGW, int lane) {
    asm volatile("" : "+v"(lane));
    f32x4 gv[4];
#pragma unroll
    for (int j = 0; j < 4; ++j) gv[j] = ((const GAS f32x4*)g)[lane + 64 * j];
    for (int m = gw; m < rows; m += NGW) {
        const GAS f32x4* xr = (const GAS f32x4*)(X + (size_t)m * D) + lane;
        f32x4 v[4]; float s = 0.f;
#pragma unroll
        for (int j = 0; j < 4; ++j) { v[j] = xr[64 * j]; s += (v[j].x * v[j].x + v[j].y * v[j].y) + (v[j].z * v[j].z + v[j].w * v[j].w); }
        const float rs = rsqrtf(wave_sum(s, lane) * (1.f / D) + 1e-6f);
        GAS v2u* o8 = (GAS v2u*)(out + (size_t)m * D) + lane;
#pragma unroll
        for (int j = 0; j < 4; ++j) { v2u w; w.x = pk2(v[j].x * rs * gv[j].x, v[j].y * rs * gv[j].y); w.y = pk2(v[j].z * rs * gv[j].z, v[j].w * rs * gv[j].w); o8[64 * j] = w; }
    }
}
__device__ __forceinline__ void hq_phase(const GAS bf16* XB, const GAS float* SSQ, const GAS float* g, GAS unsigned char* HQ, GAS float* SH, GAS int* Pz, int gw, int NGW, int lane) {
    asm volatile("" : "+v"(lane));
    const GAS f32x4* gp = (const GAS f32x4*)g + 4 * lane; const f32x4 g0 = gp[0], g1 = gp[1], g2 = gp[2], g3 = gp[3];
    for (int m = gw; m < T; m += NGW) {
        const GAS f32x4* sp = (const GAS f32x4*)(SSQ + (size_t)m * 16); const f32x4 t = (sp[0] + sp[1]) + (sp[2] + sp[3]);
        const float rs = __builtin_amdgcn_rsqf(((t[0] + t[1]) + (t[2] + t[3])) * (1.f / 1024.f) + 1e-6f);
        const v4u a = *(const GAS v4u*)(XB + (size_t)m * D + 16 * lane), b = *(const GAS v4u*)(XB + (size_t)m * D + 16 * lane + 8);
        float f[16] = {bflo(a.x) * g0[0], bfhi(a.x) * g0[1], bflo(a.y) * g0[2], bfhi(a.y) * g0[3], bflo(a.z) * g1[0], bfhi(a.z) * g1[1], bflo(a.w) * g1[2], bfhi(a.w) * g1[3],
                       bflo(b.x) * g2[0], bfhi(b.x) * g2[1], bflo(b.y) * g2[2], bfhi(b.y) * g2[3], bflo(b.z) * g3[0], bfhi(b.z) * g3[1], bflo(b.w) * g3[2], bfhi(b.w) * g3[3]};
        float mx = 0.f;
#pragma unroll
        for (int i = 0; i < 16; ++i) { f[i] *= rs; mx = fmaxf(mx, __builtin_fabsf(f[i])); }
#pragma unroll
        for (int o = 1; o < 64; o <<= 1) mx = fmaxf(mx, shx(mx, o, lane));
        const float inv = mx > 0.f ? 127.f / mx : 0.f;
        v4u q;
#pragma unroll
        for (int i = 0; i < 4; ++i) { const int ia = (int)__builtin_rintf(f[4 * i] * inv), ib = (int)__builtin_rintf(f[4 * i + 1] * inv), ic = (int)__builtin_rintf(f[4 * i + 2] * inv), id = (int)__builtin_rintf(f[4 * i + 3] * inv);
            q[i] = (unsigned)(ia & 255) | ((unsigned)(ib & 255) << 8) | ((unsigned)(ic & 255) << 16) | ((unsigned)(id & 255) << 24); }
        *(GAS v4u*)(HQ + (size_t)m * D + 16 * lane) = q;
        if (lane == 0) SH[m] = mx * (1.f / 127.f);
        (Pz + (size_t)m * 128)[lane] = 0; (Pz + (size_t)m * 128)[lane + 64] = 0;
    }
}
__device__ __forceinline__ void x0_phase(const GAS float* X, GAS bf16* XB, GAS float* SSQ, int gw, int NGW, int lane) {
    asm volatile("" : "+v"(lane));
    for (int m = gw; m < T; m += NGW) {
        const GAS f32x4* xr = (const GAS f32x4*)(X + (size_t)m * D) + lane; GAS v2u* o8 = (GAS v2u*)(XB + (size_t)m * D) + lane;
        float s = 0.f;
#pragma unroll
        for (int j = 0; j < 4; ++j) { const f32x4 v = xr[64 * j]; s += (v.x * v.x + v.y * v.y) + (v.z * v.z + v.w * v.w); v2u w; w.x = pk2(v.x, v.y); w.y = pk2(v.z, v.w); o8[64 * j] = w; }
        s = wave_sum(s, lane);
        if (lane < 8) SSQ[(size_t)m * 16 + lane] = lane == 0 ? s : 0.f;
    }
}
__device__ __forceinline__ void final_norm_phase(GAS float* X, const GAS float* g, int rows, int gw, int NGW, int lane) {
    asm volatile("" : "+v"(lane));
    for (int m = gw; m < rows; m += NGW) {
        GAS f32x4* xr = (GAS f32x4*)(X + (size_t)m * D) + lane;
        f32x4 v[4]; float s = 0.f;
#pragma unroll
        for (int j = 0; j < 4; ++j) { v[j] = xr[64 * j]; s += (v[j].x * v[j].x + v[j].y * v[j].y) + (v[j].z * v[j].z + v[j].w * v[j].w); }
        const float rs = rsqrtf(wave_sum(s, lane) * (1.f / D) + 1e-6f);
#pragma unroll
        for (int j = 0; j < 4; ++j) { const f32x4 gj = ((const GAS f32x4*)g)[lane + 64 * j]; xr[64 * j] = v[j] * rs * gj; }
    }
}

__device__ __forceinline__ void pre_phase(const GAS bf16* PROJB, const GAS float* ROPE, GAS float* RS, GAS bf16* KMB, int gw, int NGW, int lane) {
    asm volatile("" : "+v"(lane));
    for (int t = gw; t < T; t += NGW) {
        const GAS bf16* pr = PROJB + (size_t)t * INP;
        float sq = 0.f, skv = 0.f;
        if (lane < 24) { const v4u w = *(const GAS v4u*)(pr + PC_CQ + 8 * lane);
            const float a0 = bflo(w.x), a1 = bfhi(w.x), a2 = bflo(w.y), a3 = bfhi(w.y), a4 = bflo(w.z), a5 = bfhi(w.z), a6 = bflo(w.w), a7 = bfhi(w.w);
            sq = (a0 * a0 + a1 * a1) + (a2 * a2 + a3 * a3) + (a4 * a4 + a5 * a5) + (a6 * a6 + a7 * a7); }
        else if (lane >= 32 && lane < 48) { const v4u w = *(const GAS v4u*)(pr + PC_CKV + 8 * (lane - 32));
            const float a0 = bflo(w.x), a1 = bfhi(w.x), a2 = bflo(w.y), a3 = bfhi(w.y), a4 = bflo(w.z), a5 = bfhi(w.z), a6 = bflo(w.w), a7 = bfhi(w.w);
            skv = (a0 * a0 + a1 * a1) + (a2 * a2 + a3 * a3) + (a4 * a4 + a5 * a5) + (a6 * a6 + a7 * a7); }
        sq = wave_sum(sq, lane); skv = wave_sum(skv, lane);
        if (lane == 0) { RS[2 * (size_t)t] = rsqrtf(sq * (1.f / 192.f) + 1e-6f); RS[2 * (size_t)t + 1] = rsqrtf(skv * (1.f / 128.f) + 1e-6f); }
        if (lane < 16) {
            const float x1 = __builtin_bit_cast(float, (unsigned)pr[PC_KR + lane] << 16), x2 = __builtin_bit_cast(float, (unsigned)pr[PC_KR + 16 + lane] << 16);
            const float c = ROPE[(size_t)t * 32 + lane], sn = ROPE[(size_t)t * 32 + 16 + lane];
            const bf16 y1 = (bf16)f2bf_(x1 * c - x2 * sn), y2 = (bf16)f2bf_(x1 * sn + x2 * c);
            GAS bf16* kr = KMB + (size_t)t * 384 + 64 + lane;
#pragma unroll
            for (int h = 0; h < 4; ++h) { kr[h * 96] = y1; kr[h * 96 + 16] = y2; }
        }
    }
}

struct LruP { const GAS bf16* PROJB; const GAS float* cw; const GAS float* cb; const GAS float* wa; const GAS float* ba; const GAS float* wx; const GAS float* bx; const GAS float* sp; GAS bf16* HL; GAS bf16* AC; GAS float* LSUM; };
constexpr int LR_XP = 260;
constexpr int LR_XC = 0, LR_WA = 64 * LR_XP * 4, LR_WX = LR_WA + 16384, LR_SUM = LR_WX + 16384, LR_END = LR_SUM + 4096;
__device__ __forceinline__ void lru_phase(const LruP& P, LAS unsigned char* lds, int tid, int wave, int lane, int vcu, int G) {
    asm volatile("" : "+v"(tid), "+v"(lane));
    LAS float* xc = (LAS float*)(lds + LR_XC); LAS float* WA = (LAS float*)(lds + LR_WA); LAS float* WX = (LAS float*)(lds + LR_WX); LAS float* SUM = (LAS float*)(lds + LR_SUM);
    for (int u = vcu; u < (T / 256) * 8; u += G) {
        const int tile = u >> 3, g = u & 7; const int t0 = tile * 256; const bool first = ((tile & 31) == 0);
        __syncthreads();
#pragma unroll
        for (int i = 0; i < 2; ++i) { const int idx = tid + 512 * i; ((LAS f32x4*)WA)[idx] = ((const GAS f32x4*)(P.wa + g * 4096))[idx]; ((LAS f32x4*)WX)[idx] = ((const GAS f32x4*)(P.wx + g * 4096))[idx]; }
#pragma unroll 1
        for (int it = tid; it < 2048; it += 512) {
            const int time = it & 255, cg = it >> 8; const int ch0 = 64 * g + 8 * cg;
            float y[8];
            { const f32x4 b0 = *(const GAS f32x4*)(P.cb + ch0), b1 = *(const GAS f32x4*)(P.cb + ch0 + 4); y[0] = b0.x; y[1] = b0.y; y[2] = b0.z; y[3] = b0.w; y[4] = b1.x; y[5] = b1.y; y[6] = b1.z; y[7] = b1.w; }
#pragma unroll
            for (int k = 0; k < 4; ++k) {
                if (!(first && time - 3 + k < 0)) {
                    const v4u w = *(const GAS v4u*)(P.PROJB + (size_t)(t0 + time - 3 + k) * INP + PC_XL + ch0);
                    const f32x4 c0 = *(const GAS f32x4*)(P.cw + k * 512 + ch0), c1 = *(const GAS f32x4*)(P.cw + k * 512 + ch0 + 4);
                    y[0] += bflo(w.x) * c0.x; y[1] += bfhi(w.x) * c0.y; y[2] += bflo(w.y) * c0.z; y[3] += bfhi(w.y) * c0.w;
                    y[4] += bflo(w.z) * c1.x; y[5] += bfhi(w.z) * c1.y; y[6] += bflo(w.w) * c1.z; y[7] += bfhi(w.w) * c1.w;
                }
            }
#pragma unroll
            for (int e = 0; e < 8; ++e) xc[(8 * cg + e) * LR_XP + time] = y[e];
        }
        __syncthreads();
        float aa[32], ax[32];
        { const float b_a = P.ba[64 * g + lane], b_x = P.bx[64 * g + lane];
#pragma unroll
          for (int j = 0; j < 32; ++j) { aa[j] = b_a; ax[j] = b_x; } }
#pragma unroll 2
        for (int ci = 0; ci < 64; ++ci) {
            const float wa_ = WA[ci * 64 + lane], wx_ = WX[ci * 64 + lane];
            const LAS f32x4* xr = (const LAS f32x4*)(xc + ci * LR_XP + 32 * wave);
#pragma unroll
            for (int q = 0; q < 8; ++q) { const f32x4 xv = xr[q];
                aa[4 * q] += xv.x * wa_; aa[4 * q + 1] += xv.y * wa_; aa[4 * q + 2] += xv.z * wa_; aa[4 * q + 3] += xv.w * wa_;
                ax[4 * q] += xv.x * wx_; ax[4 * q + 1] += xv.y * wx_; ax[4 * q + 2] += xv.z * wx_; ax[4 * q + 3] += xv.w * wx_; }
        }
        { const float sp = P.sp[64 * g + lane];
          const LAS f32x4* xo = (const LAS f32x4*)(xc + lane * LR_XP + 32 * wave);
          float hrun = 0.f, arun = 1.f;
#pragma unroll
          for (int q = 0; q < 8; ++q) { const f32x4 xv = xo[q];
#pragma unroll
              for (int e = 0; e < 4; ++e) { const int j = 4 * q + e;
                  const float r = __builtin_amdgcn_rcpf(1.f + __builtin_amdgcn_exp2f(-LOG2E * aa[j])), ig = __builtin_amdgcn_rcpf(1.f + __builtin_amdgcn_exp2f(-LOG2E * ax[j]));
                  const float la = -8.0f * r * sp; const float a = __builtin_amdgcn_exp2f(LOG2E * la);
                  const float uu = __builtin_amdgcn_sqrtf(fmaxf(1.f - a * a, 0.f)) * (ig * xv[e]);
                  hrun = a * hrun + uu; arun *= a; aa[j] = arun; ax[j] = hrun; } }
          SUM[(wave * 64 + lane) * 2] = arun; SUM[(wave * 64 + lane) * 2 + 1] = hrun; }
        __syncthreads();
        float ca = 1.f, chh = 0.f;
        for (int w = 0; w < wave; ++w) { const float aw = SUM[(w * 64 + lane) * 2], hw = SUM[(w * 64 + lane) * 2 + 1]; chh = aw * chh + hw; ca *= aw; }
        { GAS bf16* hl = P.HL + (size_t)(t0 + 32 * wave) * 512 + 64 * g + lane; GAS bf16* ac = P.AC + (size_t)(t0 + 32 * wave) * 512 + 64 * g + lane;
#pragma unroll
          for (int j = 0; j < 32; ++j) { const float hh = ax[j] + aa[j] * chh, acc = aa[j] * ca; hl[(size_t)j * 512] = (bf16)f2bf_(hh); ac[(size_t)j * 512] = (bf16)f2bf_(acc);
              if (j == 31 && wave == 7) { P.LSUM[((size_t)tile * 512 + 64 * g + lane) * 2] = acc; P.LSUM[((size_t)tile * 512 + 64 * g + lane) * 2 + 1] = hh; } } }
    }
}

struct PostP { const GAS bf16* OMB; const GAS bf16* HL; const GAS bf16* AC; const GAS float* LSUM; const GAS bf16* PROJB; const GAS float* gm; const GAS float* gl; GAS bf16* Y; };
__device__ __forceinline__ void post_phase(const PostP& P, LAS unsigned char* lds, int tid, int wave, int lane, int vcu, int G) {
    asm volatile("" : "+v"(tid), "+v"(lane));
    LAS float* hin = (LAS float*)lds;
    for (int u = vcu; u < T / 64; u += G) {
        const int t0 = u * 64, tile = t0 >> 8, tb = tile & ~31;
        __syncthreads();
        { float h = 0.f;
          for (int c = tb; c < tile; ++c) { const float a = P.LSUM[((size_t)c * 512 + tid) * 2], hh = P.LSUM[((size_t)c * 512 + tid) * 2 + 1]; h = a * h + hh; }
          hin[tid] = h; }
        __syncthreads();
        f32x4 hi0 = *(const LAS f32x4*)(hin + 8 * lane), hi1 = *(const LAS f32x4*)(hin + 8 * lane + 4);
        const f32x4 g0 = *(const GAS f32x4*)(P.gl + 8 * lane), g1 = *(const GAS f32x4*)(P.gl + 8 * lane + 4), gmv = *(const GAS f32x4*)(P.gm + 4 * lane);
#pragma unroll 2
        for (int i = 0; i < 8; ++i) {
            const size_t t = (size_t)t0 + 8 * wave + i;
            const v4u hw = *(const GAS v4u*)(P.HL + t * 512 + 8 * lane), aw = *(const GAS v4u*)(P.AC + t * 512 + 8 * lane), gw_ = *(const GAS v4u*)(P.PROJB + t * INP + PC_GL + 8 * lane);
            const v2u mw = *(const GAS v2u*)(P.OMB + t * 256 + 4 * lane);
            float o[8];
            o[0] = (bflo(hw.x) + bflo(aw.x) * hi0.x) * gelu_erf(bflo(gw_.x)); o[1] = (bfhi(hw.x) + bfhi(aw.x) * hi0.y) * gelu_erf(bfhi(gw_.x));
            o[2] = (bflo(hw.y) + bflo(aw.y) * hi0.z) * gelu_erf(bflo(gw_.y)); o[3] = (bfhi(hw.y) + bfhi(aw.y) * hi0.w) * gelu_erf(bfhi(gw_.y));
            o[4] = (bflo(hw.z) + bflo(aw.z) * hi1.x) * gelu_erf(bflo(gw_.z)); o[5] = (bfhi(hw.z) + bfhi(aw.z) * hi1.y) * gelu_erf(bfhi(gw_.z));
            o[6] = (bflo(hw.w) + bflo(aw.w) * hi1.z) * gelu_erf(bflo(gw_.w)); o[7] = (bfhi(hw.w) + bfhi(aw.w) * hi1.w) * gelu_erf(bfhi(gw_.w));
            float s2 = 0.f;
#pragma unroll
            for (int e = 0; e < 8; ++e) s2 += o[e] * o[e];
            const float m0 = bflo(mw.x), m1 = bfhi(mw.x), m2 = bflo(mw.y), m3 = bfhi(mw.y);
            float s1 = (m0 * m0 + m1 * m1) + (m2 * m2 + m3 * m3);
            s1 = wave_sum(s1, lane); s2 = wave_sum(s2, lane);
            const float r1 = rsqrtf(s1 * (1.f / 256.f) + 1e-6f), r2 = rsqrtf(s2 * (1.f / 512.f) + 1e-6f);
            GAS bf16* yr = P.Y + t * 1024;
            { v2u w; w.x = pk2(m0 * r1 * gmv.x, m1 * r1 * gmv.y); w.y = pk2(m2 * r1 * gmv.z, m3 * r1 * gmv.w); *(GAS v2u*)(yr + 4 * lane) = w; }
            { v4u w; w.x = pk2(o[0] * r2 * g0.x, o[1] * r2 * g0.y); w.y = pk2(o[2] * r2 * g0.z, o[3] * r2 * g0.w); w.z = pk2(o[4] * r2 * g1.x, o[5] * r2 * g1.y); w.w = pk2(o[6] * r2 * g1.z, o[7] * r2 * g1.w);
              *(GAS v4u*)(yr + 256 + 8 * lane) = w; }
        }
    }
}

#define TILE_BAR() asm volatile("s_waitcnt lgkmcnt(0)\n\ts_barrier" ::: "memory")
typedef short bf16x8 __attribute__((ext_vector_type(8)));
typedef short s16x4 __attribute__((ext_vector_type(4)));
typedef float f32x16 __attribute__((ext_vector_type(16)));
typedef unsigned u32x4 __attribute__((ext_vector_type(4)));
__device__ __forceinline__ int crow(int r, int hi) { return (r & 3) + 8 * (r >> 2) + 4 * hi; }
typedef float f32x2_t __attribute__((ext_vector_type(2))); typedef __bf16 bf16x2_c __attribute__((ext_vector_type(2)));
__device__ __forceinline__ unsigned cvtpk(float lo, float hi) { f32x2_t v = {lo, hi}; bf16x2_c b = __builtin_convertvector(v, bf16x2_c); return __builtin_bit_cast(unsigned, b); }
__device__ __forceinline__ float swapmax(float m) { auto rr = __builtin_amdgcn_permlane32_swap(__float_as_uint(m), __float_as_uint(m), false, false); return fmaxf(__uint_as_float(rr[0]), __uint_as_float(rr[1])); }
__device__ __forceinline__ float swapadd(float m) { auto rr = __builtin_amdgcn_permlane32_swap(__float_as_uint(m), __float_as_uint(m), false, false); return __uint_as_float(rr[0]) + __uint_as_float(rr[1]); }
__device__ __forceinline__ s16x4 vtr(const LAS unsigned char* p) { return __builtin_bit_cast(s16x4, __builtin_amdgcn_ds_read_tr16_b64_v4i16((LAS s16x4*)p)); }
__device__ __forceinline__ bf16x8 pack8(const f32x16& p, int b) { u32x4 w; w.x = cvtpk(p[b], p[b + 1]); w.y = cvtpk(p[b + 2], p[b + 3]); w.z = cvtpk(p[b + 4], p[b + 5]); w.w = cvtpk(p[b + 6], p[b + 7]); return __builtin_bit_cast(bf16x8, w); }
__device__ __forceinline__ float vmax3(float a, float b, float c) { float r; asm("v_max3_f32 %0, %1, %2, %3" : "=v"(r) : "v"(a), "v"(b), "v"(c)); return r; }
__device__ __forceinline__ float max32(const f32x16& p, const f32x16& q) {
    float a = vmax3(p[0], p[1], p[2]), b = vmax3(p[3], p[4], p[5]), c = vmax3(p[6], p[7], p[8]), d = vmax3(p[9], p[10], p[11]), e = vmax3(p[12], p[13], p[14]);
    float f = vmax3(q[0], q[1], q[2]), g = vmax3(q[3], q[4], q[5]), h = vmax3(q[6], q[7], q[8]), i = vmax3(q[9], q[10], q[11]), j = vmax3(q[12], q[13], q[14]);
    a = vmax3(a, b, c); d = vmax3(d, e, p[15]); f = vmax3(f, g, h); i = vmax3(i, j, q[15]);
    return vmax3(vmax3(a, d, f), i, i);
}
__device__ __forceinline__ float max16(const f32x16& p) { float a = fmaxf(fmaxf(p[0], p[1]), fmaxf(p[2], p[3])), b = fmaxf(fmaxf(p[4], p[5]), fmaxf(p[6], p[7])), c = fmaxf(fmaxf(p[8], p[9]), fmaxf(p[10], p[11])), d = fmaxf(fmaxf(p[12], p[13]), fmaxf(p[14], p[15])); return fmaxf(fmaxf(a, b), fmaxf(c, d)); }

struct AttnP {
    const GAS bf16* Q; const GAS bf16* K; const GAS bf16* V; int qp, kp, vp;
    GAS bf16* O; int op;
    const GAS float* rope;
    const GAS int* pos; const GAS float* btab; const GAS float* dnorm; const GAS float* lams;
};
template <int KIND> struct AK {
    static constexpr bool DIFF = KIND == 1, CROSS = KIND == 2;
    static constexpr int HW = KIND == 0 ? 96 : KIND == 1 ? 64 : 256;
    static constexpr int NKS = KIND == 0 ? 6 : KIND == 1 ? 2 : 16;
    static constexpr int KP = KIND == 0 ? 208 : KIND == 1 ? 144 : 528;
    static constexpr int ND = CROSS ? 4 : 2;
    static constexpr int CPK = HW / 8, KCH = (64 * CPK + 511) / 512;
    static constexpr int VCH = ND / 2;
    static constexpr int KB = 64 * KP, VB = ND * 4096;
    static constexpr int NBUF = CROSS ? 2 : 3;
    static constexpr int K0 = 0, V0 = NBUF * KB, POS = V0 + NBUF * VB, BT = POS + 1024, DN = BT + 528, END = DN + 256;
};
static_assert(AK<2>::END <= RING_BYTES && AK<0>::END <= RING_BYTES && AK<1>::END + 16 + 8 * 8192 <= RING_BYTES, "attention LDS");

template <int KIND, bool LEAD>
__device__ __forceinline__ void attn_unit(const AttnP& P, int b, int h, int qb, int dhalf, LAS unsigned char* lds, int tid, int wave, int lane) {
    lane = lane_id_v(); tid = (wave << 6) | lane;
    typedef AK<KIND> C;
    constexpr bool DIFF = C::DIFF, CROSS = C::CROSS;
    constexpr int HW = C::HW, NKS = C::NKS, KP = C::KP, ND = C::ND, CPK = C::CPK, KCH = C::KCH, VCH = C::VCH;
    const int r32 = lane & 31, hi = lane >> 5;
    const size_t rowb = (size_t)b * S, rowk = CROSS ? (size_t)b * MEM : rowb;
    const int q0w = qb * 256 + wave * 32, qi = q0w + r32;
    int pq = 0; float bias_far = 0.f;
    __syncthreads();
    if (DIFF) {
        pq = P.pos[rowb + qi];
        if (tid < 129) ((LAS float*)(lds + C::BT))[tid] = P.btab[h * 129 + tid];
        if (tid >= 192 && tid < 256) ((LAS float*)(lds + C::DN))[tid - 192] = P.dnorm[tid - 192];
    }
    int minq = pq;
    if (DIFF) { for (int o = 1; o < 64; o <<= 1) { const int v = shxi(minq, o, lane); minq = v < minq ? v : minq; } }
    const int NT = CROSS ? MEM / 64 : 4 * (qb + 1);
    u32x4 kr[KCH], vr[VCH]; int pkr = 0;
    u32x4 kr2[CROSS ? 1 : KCH], vr2[CROSS ? 1 : VCH]; int pkr2 = 0;
    const GAS bf16* Kb = P.K + rowk * P.kp + h * HW; const GAS bf16* Vb = P.V + rowk * P.vp + (CROSS ? h * 256 + dhalf * 128 : h * 64);
    const __amdgpu_buffer_rsrc_t rK = __builtin_amdgcn_make_buffer_rsrc((void*)Kb, 0, 0x7fffffff, 0x00020000), rV = __builtin_amdgcn_make_buffer_rsrc((void*)Vb, 0, 0x7fffffff, 0x00020000);
    const __amdgpu_buffer_rsrc_t rP = __builtin_amdgcn_make_buffer_rsrc((void*)(DIFF ? P.pos + rowb : (const GAS int*)Kb), 0, 0x7fffffff, 0x00020000);
    int kvo[KCH], vvo[VCH];
#pragma unroll
    for (int i = 0; i < KCH; ++i) { int c = tid + 512 * i; c = c < 64 * CPK ? c : tid; kvo[i] = ((c / CPK) * P.kp + (c % CPK) * 8) * 2; }
#pragma unroll
    for (int i = 0; i < VCH; ++i) { const int c = tid + 512 * i; vvo[i] = ((c / (4 * ND)) * P.vp + (c % (4 * ND)) * 8) * 2; }
    const int pvo = (tid & 63) * 4;
    auto gload = [&](int t) {
        const int ks = __builtin_amdgcn_readfirstlane(64 * t * P.kp * 2), vs = __builtin_amdgcn_readfirstlane(64 * t * P.vp * 2);
#pragma unroll
        for (int i = 0; i < KCH; ++i) kr[i] = __builtin_amdgcn_raw_buffer_load_b128(rK, kvo[i], ks, 0);
#pragma unroll
        for (int i = 0; i < VCH; ++i) vr[i] = __builtin_amdgcn_raw_buffer_load_b128(rV, vvo[i], vs, 0);
        if (DIFF) pkr = __builtin_amdgcn_raw_buffer_load_b32(rP, pvo, __builtin_amdgcn_readfirstlane(64 * t * 4), 0);
    };
    auto lstore = [&](int buf) {
        LAS unsigned char* kb_ = lds + C::K0 + buf * C::KB; LAS unsigned char* vb_ = lds + C::V0 + buf * C::VB;
#pragma unroll
        for (int i = 0; i < KCH; ++i) { int c = tid + 512 * i; c = c < 64 * CPK ? c : tid; const int key = c / CPK, part = c % CPK; *(LAS u32x4*)(kb_ + key * KP + part * 16) = kr[i]; }
#pragma unroll
        for (int i = 0; i < VCH; ++i) { const int c = tid + 512 * i; const int key = c / (4 * ND), part = c % (4 * ND); *(LAS u32x4*)(vb_ + (part >> 2) * 4096 + (key >> 3) * 512 + (key & 7) * 64 + (part & 3) * 16) = vr[i]; }
        if (DIFF) { ((LAS int*)(lds + C::POS + buf * 256))[tid & 63] = pkr; if (tid < 64) { int mk_ = pkr; for (int o = 1; o < 64; o <<= 1) { const int v = shxi(mk_, o, lane); mk_ = v > mk_ ? v : mk_; } if (tid == 0) ((LAS int*)(lds + C::POS + 768))[buf] = mk_; } }
    };
    auto gloadB = [&](int t) {
        const int ks = __builtin_amdgcn_readfirstlane(64 * t * P.kp * 2), vs = __builtin_amdgcn_readfirstlane(64 * t * P.vp * 2);
#pragma unroll
        for (int i = 0; i < (CROSS ? 1 : KCH); ++i) kr2[i] = __builtin_amdgcn_raw_buffer_load_b128(rK, kvo[i], ks, 0);
#pragma unroll
        for (int i = 0; i < (CROSS ? 1 : VCH); ++i) vr2[i] = __builtin_amdgcn_raw_buffer_load_b128(rV, vvo[i], vs, 0);
        if (DIFF) pkr2 = __builtin_amdgcn_raw_buffer_load_b32(rP, pvo, __builtin_amdgcn_readfirstlane(64 * t * 4), 0);
    };
    auto lstoreB = [&](int buf) {
        LAS unsigned char* kb_ = lds + C::K0 + buf * C::KB; LAS unsigned char* vb_ = lds + C::V0 + buf * C::VB;
#pragma unroll
        for (int i = 0; i < (CROSS ? 1 : KCH); ++i) { int c = tid + 512 * i; c = c < 64 * CPK ? c : tid; const int key = c / CPK, part = c % CPK; *(LAS u32x4*)(kb_ + key * KP + part * 16) = kr2[i]; }
#pragma unroll
        for (int i = 0; i < (CROSS ? 1 : VCH); ++i) { const int c = tid + 512 * i; const int key = c / (4 * ND), part = c % (4 * ND); *(LAS u32x4*)(vb_ + (part >> 2) * 4096 + (key >> 3) * 512 + (key & 7) * 64 + (part & 3) * 16) = vr2[i]; }
        if (DIFF) { ((LAS int*)(lds + C::POS + buf * 256))[tid & 63] = pkr2; if (tid < 64) { int mk_ = pkr2; for (int o = 1; o < 64; o <<= 1) { const int v = shxi(mk_, o, lane); mk_ = v > mk_ ? v : mk_; } if (tid == 0) ((LAS int*)(lds + C::POS + 768))[buf] = mk_; } }
    };
    LAS float* osv = (LAS float*)(lds + ((C::END + 15) & ~15)) + wave * 2048 + lane;
    float il = 0.f;
    f32x16 oA[ND];
#pragma unroll 1
    for (int mp = 0; mp < (DIFF ? 2 : 1); ++mp) {
        bf16x8 qf[NKS];
        { const GAS bf16* qrow = P.Q + (rowb + qi) * P.qp + h * HW + mp * 32;
#pragma unroll
          for (int s = 0; s < NKS; ++s) qf[s] = *(const GAS bf16x8*)(qrow + 16 * s + 8 * hi);
          if (KIND == 0) {
              const GAS float* rp = P.rope + (rowb + qi) * 32 + 8 * hi;
              const f32x4 c0 = *(const GAS f32x4*)rp, c1 = *(const GAS f32x4*)(rp + 4), s0 = *(const GAS f32x4*)(rp + 16), s1 = *(const GAS f32x4*)(rp + 20);
              const u32x4 a = __builtin_bit_cast(u32x4, qf[NKS - 2]), bq = __builtin_bit_cast(u32x4, qf[NKS - 1]); u32x4 ra, rb;
#pragma unroll
              for (int w = 0; w < 4; ++w) { const float cl = w < 2 ? c0[2 * w] : c1[2 * w - 4], ch = w < 2 ? c0[2 * w + 1] : c1[2 * w - 3], sl = w < 2 ? s0[2 * w] : s1[2 * w - 4], sh = w < 2 ? s0[2 * w + 1] : s1[2 * w - 3];
                  const float x1l = bflo(a[w]), x1h = bfhi(a[w]), x2l = bflo(bq[w]), x2h = bfhi(bq[w]);
                  ra[w] = cvtpk(x1l * cl - x2l * sl, x1h * ch - x2h * sh); rb[w] = cvtpk(x1l * sl + x2l * cl, x1h * sh + x2h * ch); }
              qf[NKS - 2] = __builtin_bit_cast(bf16x8, ra); qf[NKS - 1] = __builtin_bit_cast(bf16x8, rb);
          } }
        __syncthreads();
        float m1 = -1e30f, l1 = 0.f;
#pragma unroll
        for (int d = 0; d < ND; ++d)
#pragma unroll
            for (int r = 0; r < 16; ++r) oA[d][r] = 0.f;
        auto qk = [&](int sl, f32x16& sa, f32x16& sb, float init) {
            const LAS unsigned char* kb_ = lds + C::K0 + sl * C::KB + r32 * KP + hi * 16 + mp * 64;
#pragma unroll
            for (int r = 0; r < 16; ++r) { sa[r] = init; sb[r] = init; }
            constexpr int HB = CROSS ? 4 : (NKS > 3 ? 3 : NKS);
#pragma unroll
            for (int s0_ = 0; s0_ < NKS; s0_ += HB) {
                bf16x8 kfa[HB], kfb[HB];
#pragma unroll
                for (int s = 0; s < HB; ++s) { kfa[s] = *(const LAS bf16x8*)(kb_ + (s0_ + s) * 32); kfb[s] = *(const LAS bf16x8*)(kb_ + 32 * KP + (s0_ + s) * 32); }
                __builtin_amdgcn_sched_barrier(0);
#pragma unroll
                for (int s = 0; s < HB; ++s) { sa = __builtin_amdgcn_mfma_f32_32x32x16_bf16(kfa[s], qf[s0_ + s], sa, 0, 0, 0); sb = __builtin_amdgcn_mfma_f32_32x32x16_bf16(kfb[s], qf[s0_ + s], sb, 0, 0, 0); }
                __builtin_amdgcn_sched_barrier(0);
            }
        };
        auto isnear = [&](int sl) { bool nb = false;
            if (DIFF) { const int mk_ = __builtin_amdgcn_readfirstlane(((LAS int*)(lds + C::POS + 768))[sl]); nb = (minq - mk_) < 128; }
            return nb; };
        auto sm = [&](int t, int sl, f32x16& pa, f32x16& pb, bool nearb) -> float {
            const int k0 = 64 * t;
            if (DIFF) { if (nearb) {
                const LAS int* pk = (const LAS int*)(lds + C::POS + sl * 256); const LAS float* bt = (const LAS float*)(lds + C::BT);
#pragma unroll
                for (int r = 0; r < 16; ++r) { const int kk = crow(r, hi);
                    int n0 = pq - pk[kk], n1 = pq - pk[kk + 32]; n0 = n0 < 0 ? 0 : (n0 > 128 ? 128 : n0); n1 = n1 < 0 ? 0 : (n1 > 128 ? 128 : n1);
                    pa[r] += bt[n0]; pb[r] += bt[n1]; }
            } }
            if (!CROSS && k0 + 63 > q0w) {
#pragma unroll
                for (int r = 0; r < 16; ++r) { const int kk = k0 + crow(r, hi); if (kk > qi) pa[r] = -1e30f; if (kk + 32 > qi) pb[r] = -1e30f; }
            }
            asm volatile("s_nop 15\n\ts_nop 7" : "+v"(pa), "+v"(pb));
            float mn, al = 1.f;
            if (CROSS) { const float mx = swapmax(max32(pa, pb)); mn = fmaxf(m1, mx); al = __builtin_amdgcn_exp2f(m1 - mn); l1 *= al; }
            else { const float mx = swapmax(max32(pa, pb)); const bool up = mx > m1 + 8.0f; mn = up ? mx : m1;
                   if (__builtin_amdgcn_ballot_w64(up) != 0ull) { al = __builtin_amdgcn_exp2f(m1 - mn); l1 *= al; } }
            m1 = mn;
            float ls = 0.f;
#pragma unroll
            for (int r = 0; r < 16; ++r) { pa[r] = __builtin_amdgcn_exp2f(pa[r] - mn); pb[r] = __builtin_amdgcn_exp2f(pb[r] - mn); ls += pa[r] + pb[r]; }
            l1 += ls;
            return al;
        };
        auto pv = [&](int sl, const f32x16& pa, const f32x16& pb, float al) {
            const LAS unsigned char* vb_ = lds + C::V0 + sl * C::VB + ((lane >> 4) & 1) * 32 + (lane & 3) * 8 + (4 * hi + ((lane & 15) >> 2)) * 64;
            bf16x8 pf[4];
            pf[0] = pack8(pa, 0); pf[1] = pack8(pa, 8); pf[2] = pack8(pb, 0); pf[3] = pack8(pb, 8);
            const bool resc = CROSS ? true : (__builtin_amdgcn_ballot_w64(al != 1.0f) != 0ull);
            if (CROSS) {
#pragma unroll
                for (int d = 0; d < ND; ++d) {
                    __builtin_amdgcn_sched_barrier(0);
#pragma unroll
                    for (int r = 0; r < 16; ++r) oA[d][r] *= al;
                    bf16x8 vf[4];
#pragma unroll
                    for (int s = 0; s < 4; ++s) { const s16x4 lo = vtr(vb_ + d * 4096 + s * 1024), hh = vtr(vb_ + d * 4096 + s * 1024 + 512); vf[s] = (bf16x8){lo[0], lo[1], lo[2], lo[3], hh[0], hh[1], hh[2], hh[3]}; }
#pragma unroll
                    for (int s = 0; s < 4; ++s) oA[d] = __builtin_amdgcn_mfma_f32_32x32x16_bf16(vf[s], pf[s], oA[d], 0, 0, 0);
                }
            } else if (DIFF) {
                if (resc) {
#pragma unroll
                    for (int d = 0; d < 2; ++d)
#pragma unroll
                        for (int r = 0; r < 16; ++r) oA[d][r] *= al;
                }
#pragma unroll
                for (int d = 0; d < 2; ++d) {
                    bf16x8 vf[4];
#pragma unroll
                    for (int s = 0; s < 4; ++s) { const s16x4 lo = vtr(vb_ + d * 4096 + s * 1024), hh = vtr(vb_ + d * 4096 + s * 1024 + 512); vf[s] = (bf16x8){lo[0], lo[1], lo[2], lo[3], hh[0], hh[1], hh[2], hh[3]}; }
                    __builtin_amdgcn_sched_barrier(0);
#pragma unroll
                    for (int s = 0; s < 4; ++s) oA[d] = __builtin_amdgcn_mfma_f32_32x32x16_bf16(vf[s], pf[s], oA[d], 0, 0, 0);
                }
            } else {
                bf16x8 vf[2][4];
#pragma unroll
                for (int d = 0; d < 2; ++d)
#pragma unroll
                    for (int s = 0; s < 4; ++s) { const s16x4 lo = vtr(vb_ + d * 4096 + s * 1024), hh = vtr(vb_ + d * 4096 + s * 1024 + 512); vf[d][s] = (bf16x8){lo[0], lo[1], lo[2], lo[3], hh[0], hh[1], hh[2], hh[3]}; }
                if (resc) {
#pragma unroll
                    for (int d = 0; d < 2; ++d)
#pragma unroll
                        for (int r = 0; r < 16; ++r) oA[d][r] *= al;
                }
                __builtin_amdgcn_sched_barrier(0);
#pragma unroll
                for (int s = 0; s < 4; ++s)
#pragma unroll
                    for (int d = 0; d < 2; ++d) oA[d] = __builtin_amdgcn_mfma_f32_32x32x16_bf16(vf[d][s], pf[s], oA[d], 0, 0, 0);
            }
        };
        if (CROSS) {
            gload(0); lstore(0);
            __syncthreads();
            for (int t = 0; t < NT; ++t) {
                const int buf = t & 1;
                f32x16 pa, pb;
                qk(buf, pa, pb, 0.f);
                const float al = sm(t, buf, pa, pb, false);
                pv(buf, pa, pb, al);
                if (t + 1 < NT) { gload(t + 1); lstore(buf ^ 1); }
                TILE_BAR();
            }
        } else {
            gload(0); lstore(0); gload(1); lstore(1);
            gload(2); gloadB(3);
            __syncthreads();
            if (DIFF) bias_far = ((LAS float*)(lds + C::BT))[128];
            const int NTW = (q0w + 31) / 64 + 1;
            constexpr bool lead = LEAD;
            f32x16 ca, cb, na, nb; bool cnear = isnear(0), nnear = false; float cal = 1.f;
            qk(0, ca, cb, (DIFF && !cnear) ? bias_far : 0.f);
            if (lead) cal = sm(0, 0, ca, cb, cnear);
            int s0 = 0, s1 = 1, s2 = 2;
            auto period = [&](int t, f32x16& xa, f32x16& xb, bool& xnear, f32x16& ya, f32x16& yb, bool& ynear) {
                const bool have_next = (t + 1 < NTW);
                if (lead) {
                    if (have_next) { ynear = isnear(s1); qk(s1, ya, yb, (DIFF && !ynear) ? bias_far : 0.f); }
                    if (t < NTW) pv(s0, xa, xb, cal);
                    if (have_next) cal = sm(t + 1, s1, ya, yb, ynear);
                } else {
                    if (t < NTW) cal = sm(t, s0, xa, xb, xnear);
                    if (have_next) { ynear = isnear(s1); qk(s1, ya, yb, (DIFF && !ynear) ? bias_far : 0.f); }
                    if (t < NTW) pv(s0, xa, xb, cal);
                }
                { const int tmp = s0; s0 = s1; s1 = s2; s2 = tmp; }
            };
            int t = 0;
            for (; t + 5 < NT; t += 2) {
                lstore(s2); gload(t + 4);
                period(t, ca, cb, cnear, na, nb, nnear);
                TILE_BAR();
                lstoreB(s2); gloadB(t + 5);
                period(t + 1, na, nb, nnear, ca, cb, cnear);
                TILE_BAR();
            }
            for (; t < NT; t += 2) {
                if (t + 2 < NT) { lstore(s2); if (t + 4 < NT) gload(t + 4); }
                period(t, ca, cb, cnear, na, nb, nnear);
                TILE_BAR();
                if (t + 3 < NT) { lstoreB(s2); if (t + 5 < NT) gloadB(t + 5); }
                period(t + 1, na, nb, nnear, ca, cb, cnear);
                TILE_BAR();
            }
        }
        il = 1.f / swapadd(l1);
        if (DIFF) { if (mp == 0) {
#pragma unroll
            for (int d = 0; d < 2; ++d)
#pragma unroll
                for (int r = 0; r < 16; ++r) osv[(d * 16 + r) * 64] = oA[d][r] * il; } }
    }
    GAS bf16* orow = P.O + (rowb + qi) * P.op + (CROSS ? h * 256 + dhalf * 128 : h * 64);
    if (!DIFF) {
#pragma unroll
        for (int d = 0; d < ND; ++d)
#pragma unroll
            for (int g = 0; g < 4; ++g) { v2u v; v.x = cvtpk(oA[d][4 * g] * il, oA[d][4 * g + 1] * il); v.y = cvtpk(oA[d][4 * g + 2] * il, oA[d][4 * g + 3] * il); *(GAS v2u*)(orow + 32 * d + 8 * g + 4 * hi) = v; }
    } else {
        const float lam = P.lams[0], lam_init = P.lams[1];
        const float i2 = lam * il;
        float ss = 0.f;
#pragma unroll
        for (int d = 0; d < 2; ++d)
#pragma unroll
            for (int r = 0; r < 16; ++r) { const float v = osv[(d * 16 + r) * 64] - oA[d][r] * i2; oA[d][r] = v; ss += v * v; }
        ss = swapadd(ss);
        const float rs = __builtin_amdgcn_rsqf(ss * (1.f / 64.f) + 1e-6f) * (1.f - lam_init);
        const LAS float* dn = (const LAS float*)(lds + C::DN);
#pragma unroll
        for (int d = 0; d < 2; ++d)
#pragma unroll
            for (int g = 0; g < 4; ++g) { const int c = 32 * d + 8 * g + 4 * hi; const f32x4 gn = *(const LAS f32x4*)(dn + c);
                v2u v; v.x = cvtpk(oA[d][4 * g] * rs * gn[0], oA[d][4 * g + 1] * rs * gn[1]); v.y = cvtpk(oA[d][4 * g + 2] * rs * gn[2], oA[d][4 * g + 3] * rs * gn[3]); *(GAS v2u*)(orow + c) = v; }
    }
}

template <int KIND> struct AK2 {
    static constexpr bool DIFF = KIND == 1;
    static constexpr int HW = KIND == 0 ? 96 : 64, NKS = KIND == 0 ? 6 : 2, KP = KIND == 0 ? 208 : 144;
    static constexpr int CPK = HW / 8, KCH = (128 * CPK) / 512, VCH = 2;
    static constexpr int KB = 128 * KP, VB = 2 * 8192;
    static constexpr int K0 = 0, V0 = 2 * KB, POS = V0 + 2 * VB, PMX = POS + 1024, BT = PMX + 16, DN = BT + 528, OSV = (DN + 256 + 15) & ~15, END = OSV + (DIFF ? 8 * 8192 : 0);
};
static_assert(AK2<0>::END <= RING_BYTES && AK2<1>::END <= RING_BYTES, "attention LDS (128-key tiles)");
template <int KIND>
__device__ __forceinline__ void attn_unit2(const AttnP& P, int b, int h, int qb, LAS unsigned char* lds, int tid, int wave, int lane) {
    lane = lane_id_v(); tid = (wave << 6) | lane;
    typedef AK2<KIND> C;
    constexpr bool DIFF = C::DIFF;
    constexpr int HW = C::HW, NKS = C::NKS, KP = C::KP, CPK = C::CPK, KCH = C::KCH, VCH = C::VCH;
    const int r32 = lane & 31, hi = lane >> 5;
    const size_t rowb = (size_t)b * S;
    const int q0w = qb * 256 + wave * 32, qi = q0w + r32;
    int pq = 0; float bias_far = 0.f;
    __syncthreads();
    if (DIFF) {
        pq = P.pos[rowb + qi];
        if (tid < 129) ((LAS float*)(lds + C::BT))[tid] = P.btab[h * 129 + tid];
        if (tid >= 192 && tid < 256) ((LAS float*)(lds + C::DN))[tid - 192] = P.dnorm[tid - 192];
    }
    int minq = pq;
    if (DIFF) { for (int o = 1; o < 64; o <<= 1) { const int v = shxi(minq, o, lane); minq = v < minq ? v : minq; } }
    const int NT = 2 * (qb + 1);
    const GAS bf16* Kb = P.K + rowb * P.kp + h * HW; const GAS bf16* Vb = P.V + rowb * P.vp + h * 64;
    const __amdgpu_buffer_rsrc_t rK = __builtin_amdgcn_make_buffer_rsrc((void*)Kb, 0, 0x7fffffff, 0x00020000), rV = __builtin_amdgcn_make_buffer_rsrc((void*)Vb, 0, 0x7fffffff, 0x00020000);
    const __amdgpu_buffer_rsrc_t rP = __builtin_amdgcn_make_buffer_rsrc((void*)(DIFF ? P.pos + rowb : (const GAS int*)Kb), 0, 0x7fffffff, 0x00020000);
    int kvo[KCH], vvo[VCH], klo[KCH], vlo[VCH];
#pragma unroll
    for (int i = 0; i < KCH; ++i) { const int c = tid + 512 * i; kvo[i] = ((c / CPK) * P.kp + (c % CPK) * 8) * 2; klo[i] = (c / CPK) * KP + (c % CPK) * 16; }
#pragma unroll
    for (int i = 0; i < VCH; ++i) { const int c = tid + 512 * i; const int key = c >> 3, part = c & 7; vvo[i] = (key * P.vp + part * 8) * 2; vlo[i] = (part >> 2) * 8192 + (key >> 3) * 512 + (key & 7) * 64 + (part & 3) * 16; }
    const int pvo = (tid & 127) * 4;
    u32x4 kr[KCH], vr[VCH]; int pkr = 0;
    auto gload = [&](int t) {
        const int ks = __builtin_amdgcn_readfirstlane(128 * t * P.kp * 2), vs = __builtin_amdgcn_readfirstlane(128 * t * P.vp * 2);
#pragma unroll
        for (int i = 0; i < KCH; ++i) kr[i] = __builtin_amdgcn_raw_buffer_load_b128(rK, kvo[i], ks, 0);
#pragma unroll
        for (int i = 0; i < VCH; ++i) vr[i] = __builtin_amdgcn_raw_buffer_load_b128(rV, vvo[i], vs, 0);
        if (DIFF) pkr = __builtin_amdgcn_raw_buffer_load_b32(rP, pvo, __builtin_amdgcn_readfirstlane(128 * t * 4), 0);
    };
    auto lstore = [&](int buf) {
        LAS unsigned char* kb_ = lds + C::K0 + buf * C::KB; LAS unsigned char* vb_ = lds + C::V0 + buf * C::VB;
#pragma unroll
        for (int i = 0; i < KCH; ++i) *(LAS u32x4*)(kb_ + klo[i]) = kr[i];
#pragma unroll
        for (int i = 0; i < VCH; ++i) *(LAS u32x4*)(vb_ + vlo[i]) = vr[i];
        if (DIFF) { ((LAS int*)(lds + C::POS + buf * 512))[tid & 127] = pkr;
            if (tid < 128) { int mk_ = pkr; for (int o = 1; o < 64; o <<= 1) { const int v = shxi(mk_, o, lane); mk_ = v > mk_ ? v : mk_; } if (lane == 0) ((LAS int*)(lds + C::PMX))[buf * 2 + wave] = mk_; } }
    };
    LAS float* osv = (LAS float*)(lds + C::OSV) + wave * 2048 + lane;
    float il = 0.f;
    f32x16 oA[2];
#pragma unroll 1
    for (int mp = 0; mp < (DIFF ? 2 : 1); ++mp) {
        bf16x8 qf[NKS];
        { const GAS bf16* qrow = P.Q + (rowb + qi) * P.qp + h * HW + mp * 32;
#pragma unroll
          for (int s = 0; s < NKS; ++s) qf[s] = *(const GAS bf16x8*)(qrow + 16 * s + 8 * hi);
          if (KIND == 0) {
              const GAS float* rp = P.rope + (rowb + qi) * 32 + 8 * hi;
              const f32x4 c0 = *(const GAS f32x4*)rp, c1 = *(const GAS f32x4*)(rp + 4), s0 = *(const GAS f32x4*)(rp + 16), s1 = *(const GAS f32x4*)(rp + 20);
              const u32x4 a = __builtin_bit_cast(u32x4, qf[NKS - 2]), bq = __builtin_bit_cast(u32x4, qf[NKS - 1]); u32x4 ra, rb;
#pragma unroll
              for (int w = 0; w < 4; ++w) { const float cl = w < 2 ? c0[2 * w] : c1[2 * w - 4], ch = w < 2 ? c0[2 * w + 1] : c1[2 * w - 3], sl = w < 2 ? s0[2 * w] : s1[2 * w - 4], sh = w < 2 ? s0[2 * w + 1] : s1[2 * w - 3];
                  const float x1l = bflo(a[w]), x1h = bfhi(a[w]), x2l = bflo(bq[w]), x2h = bfhi(bq[w]);
                  ra[w] = cvtpk(x1l * cl - x2l * sl, x1h * ch - x2h * sh); rb[w] = cvtpk(x1l * sl + x2l * cl, x1h * sh + x2h * ch); }
              qf[NKS - 2] = __builtin_bit_cast(bf16x8, ra); qf[NKS - 1] = __builtin_bit_cast(bf16x8, rb);
          } }
        __syncthreads();
        float m1 = 0.f, l1 = 0.f;
        f32x16 negm;
#pragma unroll
        for (int r = 0; r < 16; ++r) negm[r] = 0.f;
#pragma unroll
        for (int d = 0; d < 2; ++d)
#pragma unroll
            for (int r = 0; r < 16; ++r) oA[d][r] = 0.f;
        gload(0); lstore(0);
        if (NT > 1) gload(1);
        __syncthreads();
        if (DIFF) { bias_far = ((LAS float*)(lds + C::BT))[128];
#pragma unroll
            for (int r = 0; r < 16; ++r) negm[r] = bias_far; }
        const int NTW = (q0w + 31) / 128 + 1;
        auto compute = [&](int t, int buf) {
            const int k0 = 128 * t;
            const LAS unsigned char* kb_ = lds + C::K0 + buf * C::KB + r32 * KP + hi * 16 + mp * 64;
            const LAS unsigned char* vb_ = lds + C::V0 + buf * C::VB + ((lane >> 4) & 1) * 32 + (lane & 3) * 8 + (4 * hi + ((lane & 15) >> 2)) * 64;
            bool nearb = false;
            if (DIFF) { const LAS int* pm = (const LAS int*)(lds + C::PMX) + buf * 2; const int m0 = __builtin_amdgcn_readfirstlane(pm[0]), m1_ = __builtin_amdgcn_readfirstlane(pm[1]); nearb = (minq - (m0 > m1_ ? m0 : m1_)) < 128; }
            f32x16 sc[4];
            if (DIFF) { if (nearb) {
#pragma unroll
                for (int g = 0; g < 4; ++g)
#pragma unroll
                    for (int r = 0; r < 16; ++r) sc[g][r] = -m1; } }
            constexpr int HB = NKS > 3 ? 3 : NKS;
#pragma unroll
            for (int s0_ = 0; s0_ < NKS; s0_ += HB) {
                bf16x8 kf[4][HB];
#pragma unroll
                for (int g = 0; g < 4; ++g)
#pragma unroll
                    for (int s = 0; s < HB; ++s) kf[g][s] = *(const LAS bf16x8*)(kb_ + 32 * g * KP + (s0_ + s) * 32);
                __builtin_amdgcn_sched_barrier(0);
#pragma unroll
                for (int s = 0; s < HB; ++s)
#pragma unroll
                    for (int g = 0; g < 4; ++g) {
                        if (s0_ + s == 0 && !(DIFF && nearb)) sc[g] = __builtin_amdgcn_mfma_f32_32x32x16_bf16(kf[g][s], qf[s0_ + s], negm, 0, 0, 0);
                        else sc[g] = __builtin_amdgcn_mfma_f32_32x32x16_bf16(kf[g][s], qf[s0_ + s], sc[g], 0, 0, 0); }
                __builtin_amdgcn_sched_barrier(0);
            }
            if (DIFF) { if (nearb) {
                const LAS int* pk = (const LAS int*)(lds + C::POS + buf * 512); const LAS float* bt = (const LAS float*)(lds + C::BT);
#pragma unroll
                for (int g = 0; g < 4; ++g)
#pragma unroll
                    for (int r = 0; r < 16; ++r) { int n0 = pq - pk[32 * g + crow(r, hi)]; n0 = n0 < 0 ? 0 : (n0 > 128 ? 128 : n0); sc[g][r] += bt[n0]; }
            } }
            asm volatile("s_nop 15\n\ts_nop 7" : "+v"(sc[0]), "+v"(sc[1]), "+v"(sc[2]), "+v"(sc[3]));
            if (k0 + 127 > q0w) {
#pragma unroll
                for (int g = 0; g < 4; ++g)
#pragma unroll
                    for (int r = 0; r < 16; ++r) { if (k0 + 32 * g + crow(r, hi) > qi) sc[g][r] = -1e30f; }
            }
            const float mx = swapmax(vmax3(max32(sc[0], sc[1]), max32(sc[2], sc[3]), -1e30f));
            const bool up = (t == 0) || mx > 8.0f;
            float al = 1.f;
            if (__builtin_amdgcn_ballot_w64(up) != 0ull) {
                const float dl = up ? mx : 0.f; al = __builtin_amdgcn_exp2f(-dl); l1 *= al; m1 += dl;
#pragma unroll
                for (int r = 0; r < 16; ++r) negm[r] -= dl;
#pragma unroll
                for (int g = 0; g < 4; ++g)
#pragma unroll
                    for (int r = 0; r < 16; ++r) sc[g][r] -= dl;
            }
            float ls = 0.f;
#pragma unroll
            for (int g = 0; g < 4; ++g)
#pragma unroll
                for (int r = 0; r < 16; ++r) { sc[g][r] = __builtin_amdgcn_exp2f(sc[g][r]); ls += sc[g][r]; }
            l1 += ls;
            bf16x8 pf[8];
#pragma unroll
            for (int g = 0; g < 4; ++g) { pf[2 * g] = pack8(sc[g], 0); pf[2 * g + 1] = pack8(sc[g], 8); }
            if (__builtin_amdgcn_ballot_w64(al != 1.0f) != 0ull) {
#pragma unroll
                for (int d = 0; d < 2; ++d)
#pragma unroll
                    for (int r = 0; r < 16; ++r) oA[d][r] *= al;
            }
#pragma unroll
            for (int d = 0; d < 2; ++d) {
                bf16x8 vf[8];
#pragma unroll
                for (int s = 0; s < 8; ++s) { const s16x4 lo = vtr(vb_ + d * 8192 + s * 1024), hh = vtr(vb_ + d * 8192 + s * 1024 + 512); vf[s] = (bf16x8){lo[0], lo[1], lo[2], lo[3], hh[0], hh[1], hh[2], hh[3]}; }
                __builtin_amdgcn_sched_barrier(0);
#pragma unroll
                for (int s = 0; s < 8; ++s) oA[d] = __builtin_amdgcn_mfma_f32_32x32x16_bf16(vf[s], pf[s], oA[d], 0, 0, 0);
                __builtin_amdgcn_sched_barrier(0);
            }
        };
        int t = 0;
        for (; t + 2 < NT; ++t) {
            const int buf = t & 1;
            lstore(buf ^ 1); gload(t + 2);
            if (t < NTW) compute(t, buf);
            TILE_BAR();
        }
        for (; t < NT; ++t) {
            const int buf = t & 1;
            if (t + 1 < NT) lstore(buf ^ 1);
            if (t < NTW) compute(t, buf);
            TILE_BAR();
        }
        il = 1.f / swapadd(l1);
        if (DIFF) { if (mp == 0) {
#pragma unroll
            for (int d = 0; d < 2; ++d)
#pragma unroll
                for (int r = 0; r < 16; ++r) osv[(d * 16 + r) * 64] = oA[d][r] * il; } }
    }
    GAS bf16* orow = P.O + (rowb + qi) * P.op + h * 64;
    if (!DIFF) {
#pragma unroll
        for (int d = 0; d < 2; ++d)
#pragma unroll
            for (int g = 0; g < 4; ++g) { v2u v; v.x = cvtpk(oA[d][4 * g] * il, oA[d][4 * g + 1] * il); v.y = cvtpk(oA[d][4 * g + 2] * il, oA[d][4 * g + 3] * il); *(GAS v2u*)(orow + 32 * d + 8 * g + 4 * hi) = v; }
    } else {
        const float lam = P.lams[0], lam_init = P.lams[1];
        const float i2 = lam * il;
        float ss = 0.f;
#pragma unroll
        for (int d = 0; d < 2; ++d)
#pragma unroll
            for (int r = 0; r < 16; ++r) { const float v = osv[(d * 16 + r) * 64] - oA[d][r] * i2; oA[d][r] = v; ss += v * v; }
        ss = swapadd(ss);
        const float rs = __builtin_amdgcn_rsqf(ss * (1.f / 64.f) + 1e-6f) * (1.f - lam_init);
        const LAS float* dn = (const LAS float*)(lds + C::DN);
#pragma unroll
        for (int d = 0; d < 2; ++d)
#pragma unroll
            for (int g = 0; g < 4; ++g) { const int c = 32 * d + 8 * g + 4 * hi; const f32x4 gn = *(const LAS f32x4*)(dn + c);
                v2u v; v.x = cvtpk(oA[d][4 * g] * rs * gn[0], oA[d][4 * g + 1] * rs * gn[1]); v.y = cvtpk(oA[d][4 * g + 2] * rs * gn[2], oA[d][4 * g + 3] * rs * gn[3]); *(GAS v2u*)(orow + c) = v; }
    }
}

__device__ __forceinline__ void attn_phase(const AttnP& PM, const AttnP& PD, LAS unsigned char* lds, int tid, int wave, int lane, int vcu, int G, int only = -1) {
    for (int i = vcu; i < 512; i += G) {
        if (only >= 0 && (i >> 8) != only) continue;
        const int kind = i >> 8, c = i & 255, bh = c >> 4, s = c & 15;
        if (kind == 0) {
#pragma unroll 1
            for (int k = 0; k < 2; ++k) attn_unit2<0>(PM, bh >> 2, bh & 3, k ? 31 - s : s, lds, tid, wave, lane);
        } else {
#pragma unroll 1
            for (int k = 0; k < 2; ++k) attn_unit2<1>(PD, bh >> 2, bh & 3, k ? 31 - s : s, lds, tid, wave, lane);
        }
    }
}
__device__ __forceinline__ void cross_phase(const AttnP& PC, LAS unsigned char* lds, int tid, int wave, int lane, int vcu, int G) {
#pragma unroll 1
    for (int i = vcu; i < 1024; i += G) { const int bh = i >> 6; attn_unit<2, true>(PC, bh >> 2, bh & 3, i & 31, (i >> 5) & 1, lds, tid, wave, lane); }
}


__device__ __forceinline__ float vmax2(float a, float b) { float r; asm("v_max_f32_e32 %0, %1, %2" : "=v"(r) : "v"(a), "v"(b)); return r; }
__device__ __forceinline__ float vmin2(float a, float b) { float r; asm("v_min_f32_e32 %0, %1, %2" : "=v"(r) : "v"(a), "v"(b)); return r; }
__device__ __forceinline__ void pad16(float (&a)[16]) {
    asm volatile("s_nop 1" : "+v"(a[0]), "+v"(a[1]), "+v"(a[2]), "+v"(a[3]), "+v"(a[4]), "+v"(a[5]), "+v"(a[6]), "+v"(a[7]), "+v"(a[8]), "+v"(a[9]), "+v"(a[10]), "+v"(a[11]), "+v"(a[12]), "+v"(a[13]), "+v"(a[14]), "+v"(a[15]));
}
__device__ __forceinline__ void sort16_desc(float (&a)[16]) {
#pragma unroll
    for (int k = 2; k <= 16; k <<= 1)
#pragma unroll
        for (int j = k >> 1; j > 0; j >>= 1)
#pragma unroll
            for (int i = 0; i < 16; ++i) { const int l = i ^ j; if (l > i) { const bool desc = ((i & k) == 0); const float hi_ = vmax2(a[i], a[l]), lo_ = vmin2(a[i], a[l]); a[i] = desc ? hi_ : lo_; a[l] = desc ? lo_ : hi_; } }
}
__device__ __forceinline__ void merge16_desc(float (&a)[16], const float (&b)[16]) {
#pragma unroll
    for (int i = 0; i < 16; ++i) a[i] = vmax2(a[i], b[15 - i]);
#pragma unroll
    for (int j = 8; j > 0; j >>= 1)
#pragma unroll
        for (int i = 0; i < 16; ++i) { const int l = i ^ j; if (l > i) { const float hi_ = vmax2(a[i], a[l]), lo_ = vmin2(a[i], a[l]); a[i] = hi_; a[l] = lo_; } }
}
__device__ __forceinline__ void top16_of_64(float (&g0)[16], float (&g1)[16], float (&g2)[16], float (&g3)[16]) {
    sort16_desc(g0); sort16_desc(g1); merge16_desc(g0, g1); sort16_desc(g2); sort16_desc(g3); merge16_desc(g2, g3); merge16_desc(g0, g2);
}
__device__ __forceinline__ float embed(float v, unsigned mask, unsigned id) { return __builtin_bit_cast(float, (__builtin_bit_cast(unsigned, v) & mask) | id); }
__device__ __forceinline__ float mkcand(float x, float y, unsigned id) { return embed(x + y, 0xFFFFFF00u, id); }

__device__ __forceinline__ void swap32(float& a, float& b) { asm volatile("v_nop\n\tv_nop\n\tv_permlane32_swap_b32 %0, %1" : "+v"(a), "+v"(b)); }
struct RouteP { const GAS bf16* QP; const GAS bf16* keys; GAS int* EX; GAS float* GW; };
constexpr int RT_KP = 144, RT_KEYS = 0, RT_SCR = 256 * RT_KP, RT_END = RT_SCR + 8 * 8192;
__device__ __forceinline__ void route_phase(const RouteP& P, LAS unsigned char* lds, int tid, int wave, int lane, int vcu, int G) {
    asm volatile("" : "+v"(tid), "+v"(lane));
    __syncthreads();
    for (int c = tid; c < 256 * 8; c += 512) { const int row = c >> 3, part = c & 7; *(LAS u32x4*)(lds + RT_KEYS + row * RT_KP + part * 16) = *(const u32x4*)(P.keys + row * 64 + part * 8); }
    __syncthreads();
    const int r32 = lane & 31, hi = lane >> 5;
    LAS int* scr = (LAS int*)(lds + RT_SCR + wave * 8192);
    for (int u = vcu; u < T / 32; u += G) {
        const size_t t = (size_t)u * 32 + r32; const int h = wave;
        float T2[2][16];
#pragma unroll
        for (int c = 0; c < 2; ++c) {
            bf16x8 qf[4];
            { const GAS bf16* q = P.QP + t * 1024 + h * 128 + c * 64 + 8 * hi;
#pragma unroll
              for (int s = 0; s < 4; ++s) qf[s] = *(const GAS bf16x8*)(q + 16 * s); }
            f32x16 sc[4];
#pragma unroll
            for (int m = 0; m < 4; ++m) {
#pragma unroll
                for (int r = 0; r < 16; ++r) sc[m][r] = 0.f;
#pragma unroll
                for (int s = 0; s < 4; ++s) { const bf16x8 a = *(const LAS bf16x8*)(lds + RT_KEYS + (c * 128 + 32 * m + r32) * RT_KP + s * 32 + hi * 16);
                    sc[m] = __builtin_amdgcn_mfma_f32_32x32x16_bf16(a, qf[s], sc[m], 0, 0, 0); }
            }
            float g0[16], g1[16], g2[16], g3[16];
            const unsigned h4 = 4u * (unsigned)hi;
#pragma unroll
            for (int r = 0; r < 16; ++r) { const unsigned kr_ = (unsigned)((r & 3) + 8 * (r >> 2));
                g0[r] = embed(sc[0][r], 0xFFFFFF80u, kr_ | h4); g1[r] = embed(sc[1][r], 0xFFFFFF80u, (32u + kr_) | h4); g2[r] = embed(sc[2][r], 0xFFFFFF80u, (64u + kr_) | h4); g3[r] = embed(sc[3][r], 0xFFFFFF80u, (96u + kr_) | h4); }
            top16_of_64(g0, g1, g2, g3);
            pad16(g0);
#pragma unroll
            for (int i = 0; i < 16; ++i) T2[c][i] = g0[i];
        }
        float A[16], Bv[16];
#pragma unroll
        for (int i = 0; i < 16; ++i) { A[i] = T2[0][i]; Bv[i] = T2[1][i]; swap32(A[i], Bv[i]); }
        merge16_desc(A, Bv);
        pad16(A);
        float T0[16], T1[16];
#pragma unroll
        for (int i = 0; i < 16; ++i) { T0[i] = A[i]; T1[i] = A[i]; swap32(T0[i], T1[i]); }
#pragma unroll
        for (int i = 0; i < 16; ++i) { scr[i * 64 + lane] = (int)(__builtin_bit_cast(unsigned, T0[i]) & 127u); scr[(16 + i) * 64 + lane] = (int)(__builtin_bit_cast(unsigned, T1[i]) & 127u);
            T0[i] = embed(T0[i], 0xFFFFFF80u, 0u); T1[i] = embed(T1[i], 0xFFFFFF80u, 0u); }
        float c0[16], c1[16], c2[16], c3[16];
        const float NINF = -__builtin_inff();
#pragma unroll
        for (int b = 0; b < 16; ++b) c0[b] = mkcand(T0[0], T1[b], (unsigned)b);
#pragma unroll
        for (int b = 0; b < 8; ++b) c1[b] = mkcand(T0[1], T1[b], 16u + b);
#pragma unroll
        for (int b = 0; b < 5; ++b) c1[8 + b] = mkcand(T0[2], T1[b], 32u + b);
#pragma unroll
        for (int b = 0; b < 3; ++b) c1[13 + b] = mkcand(T0[4], T1[b], 64u + b);
#pragma unroll
        for (int b = 0; b < 4; ++b) c2[b] = mkcand(T0[3], T1[b], 48u + b);
        c2[4] = mkcand(T0[5], T1[0], 80u); c2[5] = mkcand(T0[5], T1[1], 81u); c2[6] = mkcand(T0[6], T1[0], 96u); c2[7] = mkcand(T0[6], T1[1], 97u); c2[8] = mkcand(T0[7], T1[0], 112u); c2[9] = mkcand(T0[7], T1[1], 113u);
#pragma unroll
        for (int a = 8; a < 14; ++a) c2[10 + a - 8] = mkcand(T0[a], T1[0], 16u * a);
        c3[0] = mkcand(T0[14], T1[0], 224u); c3[1] = mkcand(T0[15], T1[0], 240u);
#pragma unroll
        for (int i = 2; i < 16; ++i) c3[i] = NINF;
        top16_of_64(c0, c1, c2, c3);
        pad16(c0);
        float gsum = 0.f, ge[16]; int ex[16];
        const float mtop = embed(c0[0], 0xFFFFFF00u, 0u);
#pragma unroll
        for (int i = 0; i < 16; ++i) { const unsigned bits = __builtin_bit_cast(unsigned, c0[i]); const int a = (bits >> 4) & 15, b = bits & 15;
            ge[i] = __builtin_amdgcn_exp2f((embed(c0[i], 0xFFFFFF00u, 0u) - mtop) * LOG2E); gsum += ge[i];
            ex[i] = scr[a * 64 + lane] * 128 + scr[(16 + b) * 64 + lane]; }
        const float ginv = __builtin_amdgcn_rcpf(gsum);
        if (hi == 0) { GAS v4u* d = (GAS v4u*)(P.EX + t * 128 + h * 16);
#pragma unroll
            for (int i = 0; i < 4; ++i) d[i] = (v4u){(unsigned)ex[4 * i], (unsigned)ex[4 * i + 1], (unsigned)ex[4 * i + 2], (unsigned)ex[4 * i + 3]}; }
        else { GAS f32x4* d = (GAS f32x4*)(P.GW + t * 128 + h * 16);
#pragma unroll
            for (int i = 0; i < 4; ++i) d[i] = (f32x4){ge[4 * i] * ginv, ge[4 * i + 1] * ginv, ge[4 * i + 2] * ginv, ge[4 * i + 3] * ginv}; }
    }
}

__device__ __forceinline__ int wave_allsum_i(int v) {
    v += __builtin_amdgcn_update_dpp(0, v, 0xB1, 0xF, 0xF, true);
    v += __builtin_amdgcn_update_dpp(0, v, 0x4E, 0xF, 0xF, true);
    v += __builtin_amdgcn_update_dpp(0, v, 0x141, 0xF, 0xF, true);
    v += __builtin_amdgcn_update_dpp(0, v, 0x140, 0xF, 0xF, true);
    { int a = v, b = v; asm volatile("v_nop\n\tv_nop\n\tv_permlane16_swap_b32 %0, %1" : "+v"(a), "+v"(b)); v = a + b; }
    { int a = v, b = v; asm volatile("v_nop\n\tv_nop\n\tv_permlane32_swap_b32 %0, %1" : "+v"(a), "+v"(b)); v = a + b; }
    return v;
}
__device__ __forceinline__ float wave_allsum(float v) {
    v += __builtin_bit_cast(float, __builtin_amdgcn_update_dpp(0, __builtin_bit_cast(int, v), 0xB1, 0xF, 0xF, true));
    v += __builtin_bit_cast(float, __builtin_amdgcn_update_dpp(0, __builtin_bit_cast(int, v), 0x4E, 0xF, 0xF, true));
    v += __builtin_bit_cast(float, __builtin_amdgcn_update_dpp(0, __builtin_bit_cast(int, v), 0x141, 0xF, 0xF, true));
    v += __builtin_bit_cast(float, __builtin_amdgcn_update_dpp(0, __builtin_bit_cast(int, v), 0x140, 0xF, 0xF, true));
    { float a = v, b = v; asm volatile("v_nop\n\tv_nop\n\tv_permlane16_swap_b32 %0, %1" : "+v"(a), "+v"(b)); v = a + b; }
    { float a = v, b = v; asm volatile("v_nop\n\tv_nop\n\tv_permlane32_swap_b32 %0, %1" : "+v"(a), "+v"(b)); v = a + b; }
    return v;
}
__device__ __forceinline__ float wave_allmax(float v) {
    v = fmaxf(v, __builtin_bit_cast(float, __builtin_amdgcn_update_dpp(0, __builtin_bit_cast(int, v), 0xB1, 0xF, 0xF, true)));
    v = fmaxf(v, __builtin_bit_cast(float, __builtin_amdgcn_update_dpp(0, __builtin_bit_cast(int, v), 0x4E, 0xF, 0xF, true)));
    v = fmaxf(v, __builtin_bit_cast(float, __builtin_amdgcn_update_dpp(0, __builtin_bit_cast(int, v), 0x141, 0xF, 0xF, true)));
    v = fmaxf(v, __builtin_bit_cast(float, __builtin_amdgcn_update_dpp(0, __builtin_bit_cast(int, v), 0x140, 0xF, 0xF, true)));
    { float a = v, b = v; asm volatile("v_nop\n\tv_nop\n\tv_permlane16_swap_b32 %0, %1" : "+v"(a), "+v"(b)); v = fmaxf(a, b); }
    { float a = v, b = v; asm volatile("v_nop\n\tv_nop\n\tv_permlane32_swap_b32 %0, %1" : "+v"(a), "+v"(b)); v = fmaxf(a, b); }
    return v;
}
__device__ __forceinline__ unsigned q4(float a, float b, float c, float d, int off) {
    const int ia = (int)__builtin_rintf(a) + off, ib = (int)__builtin_rintf(b) + off, ic = (int)__builtin_rintf(c) + off, id = (int)__builtin_rintf(d) + off;
    return (unsigned)(ia & 255) | ((unsigned)(ib & 255) << 8) | ((unsigned)(ic & 255) << 16) | ((unsigned)(id & 255) << 24);
}
__device__ __forceinline__ void quant_row(const GAS float* src, GAS unsigned* dst, GAS float* scale, int off, int lane) {
    const GAS f32x4* s = (const GAS f32x4*)src + 4 * lane; f32x4 v[4]; float m = 0.f;
#pragma unroll
    for (int i = 0; i < 4; ++i) { v[i] = s[i]; m = fmaxf(m, fmaxf(fmaxf(__builtin_fabsf(v[i].x), __builtin_fabsf(v[i].y)), fmaxf(__builtin_fabsf(v[i].z), __builtin_fabsf(v[i].w)))); }
    m = wave_allmax(m); const float inv = m > 0.f ? 127.f / m : 0.f;
    v4u w;
    w.x = q4(v[0].x * inv, v[0].y * inv, v[0].z * inv, v[0].w * inv, off); w.y = q4(v[1].x * inv, v[1].y * inv, v[1].z * inv, v[1].w * inv, off);
    w.z = q4(v[2].x * inv, v[2].y * inv, v[2].z * inv, v[2].w * inv, off); w.w = q4(v[3].x * inv, v[3].y * inv, v[3].z * inv, v[3].w * inv, off);
    *((GAS v4u*)dst + lane) = w;
    if (lane == 0) *scale = m * (1.f / 127.f);
}
struct PeerS { int nslices_step, first_slice, nloc, rank; };
__device__ __forceinline__ PeerS peer_sched(const GAS unsigned* rankw, int xcc, int rank) {
    int nx = 0, myidx = 0, nloc = 1;
    for (int j = 0; j < 16; ++j) { const int c = (int)__hip_atomic_load(rankw + 64 * j, __ATOMIC_RELAXED, __HIP_MEMORY_SCOPE_AGENT); if (c > 0) { if (j == xcc) { myidx = nx; nloc = c; } ++nx; } }
    PeerS s; s.nslices_step = nx > 0 ? nx : 1; s.first_slice = myidx; s.nloc = nloc; s.rank = rank; return s;
}
struct Peer1P { const GAS unsigned GAS char* HQ; const GAS int* EX; const GAS unsigned GAS char* U8; GAS int* P; };
__device__ __forceinline__ void peer_k1(const Peer1P& Q, const PeerS& sc, int wave, int lane) {
    asm volatile("" : "+v"(lane));
    const int g = lane >> 3, j = lane & 7;
    for (int s = sc.first_slice; s < 8; s += sc.nslices_step)
        for (int tile = sc.rank; tile < T / 64; tile += sc.nloc) {
            const size_t t0 = (size_t)tile * 64 + wave * 8;
            v4u hqn = *(const GAS v4u*)(Q.HQ + t0 * 1024 + 128 * s + 16 * j), exn[4];
#pragma unroll
            for (int i = 0; i < 4; ++i) exn[i] = *(const GAS v4u*)(Q.EX + t0 * 128 + 16 * g + 4 * i);
#pragma unroll 1
            for (int k = 0; k < 8; ++k) {
                const size_t t = t0 + k;
                const v4u hq = hqn; v4u ex[4];
#pragma unroll
                for (int i = 0; i < 4; ++i) ex[i] = exn[i];
                if (k + 1 < 8) {
                    hqn = *(const GAS v4u*)(Q.HQ + (t + 1) * 1024 + 128 * s + 16 * j);
#pragma unroll
                    for (int i = 0; i < 4; ++i) exn[i] = *(const GAS v4u*)(Q.EX + (t + 1) * 128 + 16 * g + 4 * i);
                }
                v4u uu[16];
#pragma unroll
                for (int i = 0; i < 16; ++i) { const unsigned e = (i & 3) == 0 ? ex[i >> 2].x : (i & 3) == 1 ? ex[i >> 2].y : (i & 3) == 2 ? ex[i >> 2].z : ex[i >> 2].w;
                    uu[i] = *(const GAS v4u*)(Q.U8 + (size_t)e * 1024 + 128 * s + 16 * j); }
                int lo = 0, hi = 0;
#pragma unroll
                for (int i = 0; i < 16; ++i) {
                    int p = __builtin_amdgcn_sdot4((int)uu[i].x, (int)hq.x, 0, false); p = __builtin_amdgcn_sdot4((int)uu[i].y, (int)hq.y, p, false); p = __builtin_amdgcn_sdot4((int)uu[i].z, (int)hq.z, p, false); p = __builtin_amdgcn_sdot4((int)uu[i].w, (int)hq.w, p, false);
                    p += __builtin_amdgcn_update_dpp(0, p, 0xB1, 0xF, 0xF, true); p += __builtin_amdgcn_update_dpp(0, p, 0x4E, 0xF, 0xF, true); p += __builtin_amdgcn_update_dpp(0, p, 0x141, 0xF, 0xF, true);
                    if (i < 8) lo = (j == i) ? p : lo; else hi = (j == i - 8) ? p : hi;
                }
                GAS int* prow = Q.P + t * 128 + 16 * g + j;
                (void)__hip_atomic_fetch_add(prow, lo, __ATOMIC_RELAXED, __HIP_MEMORY_SCOPE_AGENT); (void)__hip_atomic_fetch_add(prow + 8, hi, __ATOMIC_RELAXED, __HIP_MEMORY_SCOPE_AGENT);
            }
        }
}
__device__ __forceinline__ void peer_w(const GAS int* EX, const GAS float* GW, const GAS int* P, const GAS float* SH, const GAS float* SU, const GAS float* SV, GAS signed char* WQ, GAS float* WSC, int gw, int NGW, int lane) {
    asm volatile("" : "+v"(lane));
    for (int t = gw; t < T; t += NGW) {
        const float sh = SH[t];
#pragma unroll
        for (int q = 0; q < 2; ++q) { const size_t idx = (size_t)t * 128 + lane + 64 * q; const int e = EX[idx];
            const float w = GW[idx] * gelu_erf((float)P[idx] * (sh * SU[e])) * SV[e];
            float m = __builtin_fabsf(w);
            m = fmaxf(m, __builtin_bit_cast(float, __builtin_amdgcn_update_dpp(0, __builtin_bit_cast(int, m), 0xB1, 0xF, 0xF, true)));
            m = fmaxf(m, __builtin_bit_cast(float, __builtin_amdgcn_update_dpp(0, __builtin_bit_cast(int, m), 0x4E, 0xF, 0xF, true)));
            m = fmaxf(m, __builtin_bit_cast(float, __builtin_amdgcn_update_dpp(0, __builtin_bit_cast(int, m), 0x141, 0xF, 0xF, true)));
            m = fmaxf(m, __builtin_bit_cast(float, __builtin_amdgcn_update_dpp(0, __builtin_bit_cast(int, m), 0x140, 0xF, 0xF, true)));
            const float inv = m > 0.f ? 127.f / m : 0.f;
            WQ[idx] = (signed char)(int)__builtin_rintf(w * inv);
            if ((lane & 15) == 0) WSC[(size_t)t * 8 + (lane >> 4) + 4 * q] = m * (1.f / 127.f); }
    }
}
__device__ __forceinline__ void tr4x4(unsigned r0, unsigned r1, unsigned r2, unsigned r3, unsigned (&t)[4]) {
    const unsigned x0 = __builtin_amdgcn_perm(r1, r0, 0x05010400u), x1 = __builtin_amdgcn_perm(r1, r0, 0x07030602u), y0 = __builtin_amdgcn_perm(r3, r2, 0x05010400u), y1 = __builtin_amdgcn_perm(r3, r2, 0x07030602u);
    t[0] = __builtin_amdgcn_perm(y0, x0, 0x05040100u); t[1] = __builtin_amdgcn_perm(y0, x0, 0x07060302u); t[2] = __builtin_amdgcn_perm(y1, x1, 0x05040100u); t[3] = __builtin_amdgcn_perm(y1, x1, 0x07060302u);
}
struct Peer2P { const GAS int* EX; const GAS signed char* WQ; const GAS float* WSC; const GAS unsigned char* V8; GAS float* X; GAS bf16* XB; GAS float* SSQ; };
__device__ __forceinline__ void peer_k2(const Peer2P& Q, const PeerS& sc, int wave, int lane) {
    asm volatile("" : "+v"(lane));
    const int g = lane >> 3, j = lane & 7, hf = lane >> 5, rp = (lane >> 4) & 1;
    for (int s = sc.first_slice; s < 8; s += sc.nslices_step)
        for (int tile = sc.rank; tile < T / 64; tile += sc.nloc) {
            const size_t t0 = (size_t)tile * 64 + wave * 8;
            v4u exn[4], wqn; float swn;
#pragma unroll
            for (int i = 0; i < 4; ++i) exn[i] = *(const GAS v4u*)(Q.EX + t0 * 128 + 16 * g + 4 * i);
            wqn = *(const GAS v4u*)(Q.WQ + t0 * 128 + 16 * g); swn = Q.WSC[t0 * 8 + g];
#pragma unroll 1
            for (int k = 0; k < 8; ++k) {
                const size_t t = t0 + k;
                v4u ex[4]; const v4u wq = wqn; const float sw = swn;
#pragma unroll
                for (int i = 0; i < 4; ++i) ex[i] = exn[i];
                if (k + 1 < 8) {
#pragma unroll
                    for (int i = 0; i < 4; ++i) exn[i] = *(const GAS v4u*)(Q.EX + (t + 1) * 128 + 16 * g + 4 * i);
                    wqn = *(const GAS v4u*)(Q.WQ + (t + 1) * 128 + 16 * g); swn = Q.WSC[(t + 1) * 8 + g];
                }
                GAS f32x4* xp = (GAS f32x4*)(Q.X + t * 1024 + 128 * s + 16 * j + 8 * hf + 4 * rp);
                const f32x4 xold = *xp;
                v4u vv[16];
#pragma unroll
                for (int i = 0; i < 16; ++i) { const unsigned e = (i & 3) == 0 ? ex[i >> 2].x : (i & 3) == 1 ? ex[i >> 2].y : (i & 3) == 2 ? ex[i >> 2].z : ex[i >> 2].w;
                    vv[i] = *(const GAS v4u*)(Q.V8 + (size_t)e * 1024 + 128 * s + 16 * j); }
                int ai[16];
#pragma unroll
                for (int i = 0; i < 16; ++i) ai[i] = 0;
#pragma unroll
                for (int q4_ = 0; q4_ < 4; ++q4_) {
                    const unsigned wq4 = q4_ == 0 ? wq.x : q4_ == 1 ? wq.y : q4_ == 2 ? wq.z : wq.w;
#pragma unroll
                    for (int c = 0; c < 4; ++c) { unsigned tt[4];
                        const v4u &a0 = vv[4 * q4_], &a1 = vv[4 * q4_ + 1], &a2 = vv[4 * q4_ + 2], &a3 = vv[4 * q4_ + 3];
                        tr4x4(c == 0 ? a0.x : c == 1 ? a0.y : c == 2 ? a0.z : a0.w, c == 0 ? a1.x : c == 1 ? a1.y : c == 2 ? a1.z : a1.w, c == 0 ? a2.x : c == 1 ? a2.y : c == 2 ? a2.z : a2.w, c == 0 ? a3.x : c == 1 ? a3.y : c == 2 ? a3.z : a3.w, tt);
#pragma unroll
                        for (int b = 0; b < 4; ++b) ai[4 * c + b] = __builtin_amdgcn_sdot4((int)tt[b], (int)wq4, ai[4 * c + b], false); }
                }
                float acc[16];
#pragma unroll
                for (int i = 0; i < 16; ++i) acc[i] = (float)ai[i] * sw;
                float r8[8], r4[4];
#pragma unroll
                for (int m = 0; m < 8; ++m) { float a = acc[m], b = acc[m + 8]; swap32(a, b); r8[m] = a + b; }
#pragma unroll
                for (int n = 0; n < 4; ++n) { float a = r8[n], b = r8[n + 4]; asm volatile("v_nop\n\tv_nop\n\tv_permlane16_swap_b32 %0, %1" : "+v"(a), "+v"(b)); r4[n] = a + b; }
#pragma unroll
                for (int n = 0; n < 4; ++n) r4[n] += __builtin_bit_cast(float, __builtin_amdgcn_update_dpp(0, __builtin_bit_cast(int, r4[n]), 0x128, 0xF, 0xF, true));
                const f32x4 xn = xold + (f32x4){r4[0], r4[1], r4[2], r4[3]};
                float ss = (lane & 8) == 0 ? (xn[0] * xn[0] + xn[1] * xn[1]) + (xn[2] * xn[2] + xn[3] * xn[3]) : 0.f;
                ss = wave_allsum(ss);
                if ((lane & 8) == 0) { *xp = xn; if (Q.XB) { v2u w; w.x = pk2(xn[0], xn[1]); w.y = pk2(xn[2], xn[3]); *(GAS v2u*)(Q.XB + t * 1024 + 128 * s + 16 * j + 8 * hf + 4 * rp) = w; } }
                if (Q.SSQ) { if (lane == 0) Q.SSQ[t * 16 + s] = ss; }
            }
        }
}

struct Args { const float* in[33]; float* out; unsigned char* ws; int ph_lo, ph_hi; };
struct Frame { LAS unsigned char* lds; volatile LAS unsigned* MISC; gu32* ctl; int tid, lane, wave, G, vcu, xcc, xrank; };

__device__ __forceinline__ void transpose_item(const float* W, int ldw, int nsrc0, bf16* WT, int ldt, int rdst0, LAS float* scr, int kb, int nb, int lane, float scale, const float* kgain) {
    const int k0 = 64 * kb, n0 = 32 * nb;
#pragma unroll 8
    for (int i = 0; i < 32; ++i) { const int kk = 2 * i + (lane >> 5); const float gsc = kgain ? kgain[k0 + kk] * scale : scale; scr[kk * 33 + (lane & 31)] = W[(size_t)(k0 + kk) * ldw + nsrc0 + n0 + (lane & 31)] * gsc; }
    LDS_WAIT(); asm volatile("" ::: "memory");
    const int c = lane & 7;
#pragma unroll
    for (int j = 0; j < 4; ++j) { const int n = (lane >> 3) + 8 * j; const LAS float* s = scr + (8 * c) * 33 + n;
        v4u o; o.x = pk2(s[0 * 33], s[1 * 33]); o.y = pk2(s[2 * 33], s[3 * 33]); o.z = pk2(s[4 * 33], s[5 * 33]); o.w = pk2(s[6 * 33], s[7 * 33]);
        *(GAS v4u*)(WT + (size_t)(rdst0 + n0 + n) * ldt + k0 + 8 * c) = o; }
    LDS_WAIT(); asm volatile("" ::: "memory");
}
__device__ __forceinline__ void zero_rect(bf16* base, int ld, int row0, int nrows, int col0, int ncols, int gtid, int gthreads) {
    const int vpr = ncols / 8;
    for (int i = gtid; i < nrows * vpr; i += gthreads) { const int r = i / vpr, c = i % vpr; *(GAS v4u*)(base + (size_t)(row0 + r) * ld + col0 + 8 * c) = (v4u){0u, 0u, 0u, 0u}; }
}

__device__ __forceinline__ void p0_prologue(Frame& F, const Args& a) {
    LAS float* scr = (LAS float*)(F.lds + RING_OFF + F.wave * 16384);
    const int gw = blockIdx.x * NWAVES + F.wave, NGW = F.G * NWAVES;
    const int gtid = blockIdx.x * (NWAVES * 64) + F.tid, gthreads = F.G * NWAVES * 64;
    unsigned char* ws = a.ws;
    x0_phase((const GAS float*)a.in[0], (GAS bf16*)(ws + WS_XNB), (GAS float*)(ws + WS_SSQ), gw, NGW, F.lane);
    constexpr int I_IN = 16 * (INW / 32), I_SQ = 16 * 32, I_CKV = 16 * 64, I_UQ = 3 * 12, I_UKV = 2 * 16, I_L = I_IN + 4 * I_SQ + I_CKV + I_UQ + I_UKV;
    for (int it = gw; it < L * I_L; it += NGW) {
        const int l = it / I_L; int r = it % I_L;
        if (r < I_IN) {
            const int kb = r / 67, nb = r % 67; int src, dst; float sc = 1.f;
            if (nb < 6) { src = 32 * nb; dst = src; } else if (nb < 11) { src = 32 * nb; dst = src + 64; } else { src = 32 * nb; dst = src + 160; if (nb >= 43 && nb < 51) sc = 0.17677669529663687f * LOG2E; }
            transpose_item(a.in[5] + (size_t)l * D * INW, INW, src, (bf16*)(ws + WS_WIN) + (size_t)l * INP * D, D, dst, scr, kb, 0, F.lane, sc, a.in[4] + l * D); continue; } r -= I_IN;
        if (r < I_SQ) { transpose_item(a.in[21] + (size_t)l * D * D, D, 0, (bf16*)(ws + WS_WOUT) + (size_t)l * D * D, D, 0, scr, r / 32, r % 32, F.lane, 1.f, nullptr); continue; } r -= I_SQ;
        if (r < I_SQ) { transpose_item(a.in[24] + (size_t)l * D * D, D, 0, (bf16*)(ws + WS_WCQ) + (size_t)l * D * D, D, 0, scr, r / 32, r % 32, F.lane, 0.0625f * LOG2E, a.in[22] + l * D); continue; } r -= I_SQ;
        if (r < I_SQ) { transpose_item(a.in[26] + (size_t)l * D * D, D, 0, (bf16*)(ws + WS_WCO) + (size_t)l * D * D, D, 0, scr, r / 32, r % 32, F.lane, 1.f, nullptr); continue; } r -= I_SQ;
        if (r < I_SQ) { transpose_item(a.in[28] + (size_t)l * D * D, D, 0, (bf16*)(ws + WS_WPQ) + (size_t)l * D * D, D, 0, scr, r / 32, r % 32, F.lane, 1.f, a.in[27] + l * D); continue; } r -= I_SQ;
        if (r < I_CKV) { transpose_item(a.in[25] + (size_t)l * D * 2 * D, 2 * D, 0, (bf16*)(ws + WS_WCKV) + (size_t)l * 2 * D * D, D, 0, scr, r / 64, r % 64, F.lane, 1.f, nullptr); continue; } r -= I_CKV;
        if (r < I_UQ) { transpose_item(a.in[7] + (size_t)l * 192 * 384, 384, 0, (bf16*)(ws + WS_WUQ) + (size_t)l * 512 * 256, 256, 0, scr, r / 12, r % 12, F.lane, 0.10206207261596575f * LOG2E, a.in[6] + l * 192); continue; } r -= I_UQ;
        transpose_item(a.in[9] + (size_t)l * 128 * 512, 512, 0, (bf16*)(ws + WS_WUKV) + (size_t)l * 512 * 256, 256, 0, scr, r / 16, r % 16, F.lane, 1.f, a.in[8] + l * 128);
    }
    for (int l = 0; l < L; ++l) {
        bf16* win = (bf16*)(ws + WS_WIN) + (size_t)l * INP * D; bf16* wuq = (bf16*)(ws + WS_WUQ) + (size_t)l * 512 * 256; bf16* wukv = (bf16*)(ws + WS_WUKV) + (size_t)l * 512 * 256;
        zero_rect(win, D, 192, 64, 0, D, gtid, gthreads); zero_rect(win, D, 416, 96, 0, D, gtid, gthreads);
        zero_rect(wuq, 256, 0, 384, 192, 64, gtid, gthreads); zero_rect(wuq, 256, 384, 128, 0, 256, gtid, gthreads);
        zero_rect(wukv, 256, 0, 512, 128, 128, gtid, gthreads);
    }
    { float* rope = (float*)(ws + WS_ROPE); const int* pos = (const int*)a.in[2];
      for (int i = gtid; i < T * 16; i += gthreads) { const int t = i >> 4, k = i & 15; const float inv = powf(10000.f, -(float)(2 * k) / 32.f); const float ang = (float)pos[t] * inv;
          rope[(size_t)t * 32 + k] = cosf(ang); rope[(size_t)t * 32 + 16 + k] = sinf(ang); } }
    { const GAS f32x4* ks = (const GAS f32x4*)a.in[29]; GAS v2u* kd = (GAS v2u*)(ws + WS_KEYS);
      for (int i = gtid; i < L * 2 * 128 * 64 / 4; i += gthreads) { const f32x4 v = ks[i]; v2u w; w.x = pk2(v.x, v.y); w.y = pk2(v.z, v.w); kd[i] = w; }
    }
    for (int r = gw; r < 2 * L * 16384; r += NGW) { const int tb = r / (L * 16384), rr = r % (L * 16384);
        quant_row((const GAS float*)a.in[30 + tb] + (size_t)rr * 1024, (GAS unsigned*)(ws + (tb ? WS_V8 : WS_U8) + (size_t)rr * 1024), (GAS float*)(ws + (tb ? WS_SV : WS_SU)) + rr, 0, F.lane); }
    { float* btab = (float*)(ws + WS_BTAB); float* lams = (float*)(ws + WS_LAMS); float* spt = (float*)(ws + WS_SP);
      for (int i = gtid; i < 4 * 129; i += gthreads) { const int h = i / 129, n = i % 129; int bu; if (n < 16) bu = n; else { const int lg = 16 + (int)(logf((float)n / 16.f) / logf(8.f) * 16.f); bu = lg < 31 ? lg : 31; }
          btab[i] = a.in[3][bu * 4 + h] * LOG2E; }
      for (int i = gtid; i < L; i += gthreads) { const float* dl = a.in[17] + i * 128; float s1 = 0.f, s2 = 0.f; for (int j = 0; j < 32; ++j) { s1 += dl[j] * dl[32 + j]; s2 += dl[64 + j] * dl[96 + j]; }
          const float li = 0.8f - 0.6f * expf(-0.3f * (float)i); lams[2 * i] = expf(s1) - expf(s2) + li; lams[2 * i + 1] = li; }
      for (int i = gtid; i < L * 512; i += gthreads) spt[i] = log1pf(expf(-a.in[16][i])); }
    for (int l = 0; l < L; ++l) norm_phase((const GAS float*)a.in[1], (const GAS float*)a.in[23] + l * D, (GAS bf16*)(ws + WS_MNB) + (size_t)l * NB * MEM * D, NB * MEM, gw, NGW, F.lane);
}

constexpr int NPL = 16, PH_FINAL = 2 + NPL * L;
__global__ void __launch_bounds__(NWAVES * 64, 2) fwd(Args args) {
    extern __shared__ __attribute__((aligned(16))) unsigned char lds[];
    Frame F;
    F.lds = (LAS unsigned char*)lds; F.MISC = (volatile LAS unsigned*)(F.lds + MISC_OFF);
    F.tid = threadIdx.x; F.lane = F.tid & 63; F.wave = __builtin_amdgcn_readfirstlane(F.tid >> 6); F.G = gridDim.x;
    F.vcu = (F.G % 8 == 0) ? ((int)blockIdx.x % 8) * (F.G / 8) + (int)blockIdx.x / 8 : (int)blockIdx.x;
    unsigned char* ws = args.ws;
    F.ctl = (gu32*)(opq(ws) + WS_CTL);
    for (int u = F.tid; u < (LDS_BYTES - LDSCTL_OFF) / 4; u += NWAVES * 64) ((LAS unsigned*)(F.lds + LDSCTL_OFF))[u] = 0u;
    __syncthreads();
    XcdBarrier bar = xcd_barrier_post((unsigned*)(F.ctl + CW_BAR), F.MISC + 8);
    F.xcc = (int)bar.x;
    if (F.tid == 0) F.MISC[12] = __hip_atomic_fetch_add((unsigned*)(F.ctl + CW_RANK) + 64 * bar.x, 1u, __ATOMIC_RELAXED, __HIP_MEMORY_SCOPE_AGENT);
    __syncthreads();
    F.xrank = __builtin_amdgcn_readfirstlane((int)F.MISC[12]);
    const int lo = args.ph_lo, hi = args.ph_hi;
    const int gw = blockIdx.x * NWAVES + F.wave, NGW = F.G * NWAVES;
#define IN(k) (lo <= (k) && (k) < hi)
#define LANE_ (lane_id_v())
#define TID_ ((opqi(F.wave) << 6) | LANE_)
#define SITE() const int G_ = opqi(F.G), wv_ = opqi(F.wave), vcu_ = opqi(F.vcu), gw_ = opqi(gw), NGW_ = opqi(NGW); (void)G_; (void)wv_; (void)vcu_; (void)gw_; (void)NGW_
#define SEAM(k) do { if (IN(k) && IN((k) + 1)) xcd_barrier(bar, (F.wave == 0 && lane_id_v() == 0) ? 1 : 0); } while (0)
#define GEMM_SITE(EPI, Aptr, lda_, Bptr, ldb_, M_, N_, K_, cperm, ...) do { \
        pg8::Gemm g{opq(Aptr), opq(Bptr), M_, N_, K_, lda_, ldb_}; pg8::StaticOrder So; So.init(M_, N_, opqi(F.G), opqi(cperm)); pg8::EPI E{__VA_ARGS__}; \
        pg8::gemm_phase<pg8::EPI, pg8::StaticOrder, true, true>(F.lds + RING_OFF, g, So, E, opqi(F.wave)); } while (0)
    if (IN(0)) { p0_prologue(F, args); }
    SEAM(0);
    if (IN(1)) {
#pragma unroll 1
        for (int l = 0; l < L; ++l)
            GEMM_SITE(EpiBf16, (const GAS bf16*)(opq(ws) + WS_MNB) + (size_t)l * NB * MEM * D, D, (const GAS bf16*)(opq(ws) + WS_WCKV) + (size_t)l * 2 * D * D, D, NB * MEM, 2 * D, D, (int)((blockIdx.x + 64 * l) % F.G),
                      opq((GAS bf16*)(opq(ws) + WS_KVCB) + (size_t)l * NB * MEM * 2 * D), 2 * D, 2 * D, (const GAS float*)nullptr, 0);
    }
    SEAM(1);
    for (int l = 0; l < L; ++l) {
        const int pb = 2 + NPL * l;
        const GAS bf16* XNB = (const GAS bf16*)(opq(ws) + WS_XNB); const GAS bf16* YB = (const GAS bf16*)(opq(ws) + WS_YB); GAS bf16* PROJB = (GAS bf16*)(opq(ws) + WS_PROJB);
        if (IN(pb + 1)) GEMM_SITE(EpiBf16, XNB, D, (const GAS bf16*)(opq(ws) + WS_WIN) + (size_t)l * INP * D, D, T, INP, D, (int)blockIdx.x, opq(PROJB), INP, INP, opq((const GAS float*)(opq(ws) + WS_SSQ)), 8);
        SEAM(pb + 1);
        if (IN(pb + 2)) {
            SITE();
            pre_phase(opq((const GAS bf16*)PROJB), opq((const GAS float*)(opq(ws) + WS_ROPE)), opq((GAS float*)(opq(ws) + WS_RS)), opq((GAS bf16*)(opq(ws) + WS_KMB)), gw_, NGW_, LANE_);
            LruP LP{opq((const GAS bf16*)PROJB), (const GAS float*)args.in[opqi(10)] + l * 4 * 512, (const GAS float*)args.in[opqi(11)] + l * 512, (const GAS float*)args.in[opqi(12)] + (size_t)l * 8 * 4096, (const GAS float*)args.in[opqi(13)] + l * 512, (const GAS float*)args.in[opqi(14)] + (size_t)l * 8 * 4096, (const GAS float*)args.in[opqi(15)] + l * 512,
                    (const GAS float*)(opq(ws) + WS_SP) + l * 512, opq((GAS bf16*)(opq(ws) + WS_HLB)), opq((GAS bf16*)(opq(ws) + WS_ACB)), opq((GAS float*)(opq(ws) + WS_LSUM))};
            lru_phase(LP, F.lds, TID_, wv_, LANE_, vcu_, G_);
#if MK_DUP == 2
            lru_phase(LP, F.lds, TID_, wv_, LANE_, vcu_, G_);
#endif
        }
        SEAM(pb + 2);
        if (IN(pb + 3)) {
            GEMM_SITE(EpiUp, (const GAS bf16*)PROJB + PC_CQ, INP, (const GAS bf16*)(opq(ws) + WS_WUQ) + (size_t)l * 512 * 256, 256, T, 512, 256, (int)blockIdx.x,
                      opq((GAS bf16*)(opq(ws) + WS_QMB)), (GAS bf16*)nullptr, 384, 384, opq((const GAS float*)(opq(ws) + WS_RS)), 0, 0);
            GEMM_SITE(EpiUp, (const GAS bf16*)PROJB + PC_CKV, INP, (const GAS bf16*)(opq(ws) + WS_WUKV) + (size_t)l * 512 * 256, 256, T, 512, 256, (int)blockIdx.x,
                      opq((GAS bf16*)(opq(ws) + WS_KMB)), opq((GAS bf16*)(opq(ws) + WS_VMB)), 0, 512, opq((const GAS float*)(opq(ws) + WS_RS)), 1, 1);
        }
        SEAM(pb + 3);
        if (IN(pb + 4)) {
            SITE();
            AttnP PM{opq((const GAS bf16*)(opq(ws) + WS_QMB)), opq((const GAS bf16*)(opq(ws) + WS_KMB)), opq((const GAS bf16*)(opq(ws) + WS_VMB)), 384, 384, 256, opq((GAS bf16*)(opq(ws) + WS_OMB)), 256, opq((const GAS float*)(opq(ws) + WS_ROPE)), nullptr, nullptr, nullptr, nullptr};
            AttnP PD{opq((const GAS bf16*)PROJB + PC_QD), opq((const GAS bf16*)PROJB + PC_KD), opq((const GAS bf16*)PROJB + PC_VD), INP, INP, INP, opq((GAS bf16*)(opq(ws) + WS_YB) + 768), 1024, nullptr,
                     (const GAS int*)args.in[opqi(2)], (const GAS float*)(opq(ws) + WS_BTAB), (const GAS float*)args.in[opqi(18)] + l * 64, (const GAS float*)(opq(ws) + WS_LAMS) + 2 * l};
            attn_phase(PM, PD, F.lds, TID_, wv_, LANE_, vcu_, G_);
#if MK_DUP == 4
            __syncthreads(); attn_phase(PM, PD, F.lds, TID_, wv_, LANE_, vcu_, G_);
#elif MK_DUP == 40 || MK_DUP == 41
            __syncthreads(); attn_phase(PM, PD, F.lds, TID_, wv_, LANE_, vcu_, G_, MK_DUP - 40);
#endif
        }
        SEAM(pb + 4);
        if (IN(pb + 5)) {
            SITE();
            PostP PP{opq((const GAS bf16*)(opq(ws) + WS_OMB)), opq((const GAS bf16*)(opq(ws) + WS_HLB)), opq((const GAS bf16*)(opq(ws) + WS_ACB)), opq((const GAS float*)(opq(ws) + WS_LSUM)), opq((const GAS bf16*)PROJB), (const GAS float*)args.in[opqi(19)] + l * 256, (const GAS float*)args.in[opqi(20)] + l * 512, opq((GAS bf16*)(opq(ws) + WS_YB))};
            post_phase(PP, F.lds, TID_, wv_, LANE_, vcu_, G_);
        }
        SEAM(pb + 5);
        if (IN(pb + 6)) GEMM_SITE(EpiRes, YB, D, (const GAS bf16*)(opq(ws) + WS_WOUT) + (size_t)l * D * D, D, T, D, D, (int)blockIdx.x, opq(l == 0 ? (const GAS float*)args.in[opqi(0)] : (const GAS float*)args.out), opq((GAS float*)args.out), opq((GAS bf16*)(opq(ws) + WS_XNB)), opq((GAS float*)(opq(ws) + WS_SSQ)));
        SEAM(pb + 6);
        if (IN(pb + 8)) GEMM_SITE(EpiBf16, XNB, D, (const GAS bf16*)(opq(ws) + WS_WCQ) + (size_t)l * D * D, D, T, D, D, (int)blockIdx.x, opq(PROJB), D, D, opq((const GAS float*)(opq(ws) + WS_SSQ)), 16);
        SEAM(pb + 8);
        if (IN(pb + 9)) {
            SITE();
            const GAS bf16* kv = (const GAS bf16*)(opq(ws) + WS_KVCB) + (size_t)l * NB * MEM * 2 * D;
            AttnP PC{opq((const GAS bf16*)PROJB), opq(kv), opq(kv + D), 1024, 2 * D, 2 * D, opq((GAS bf16*)(opq(ws) + WS_YB)), 1024, nullptr, nullptr, nullptr, nullptr, nullptr};
            cross_phase(PC, F.lds, TID_, wv_, LANE_, vcu_, G_);
#if MK_DUP == 9
            cross_phase(PC, F.lds, TID_, wv_, LANE_, vcu_, G_);
#endif
        }
        SEAM(pb + 9);
        if (IN(pb + 10)) GEMM_SITE(EpiRes, YB, D, (const GAS bf16*)(opq(ws) + WS_WCO) + (size_t)l * D * D, D, T, D, D, (int)blockIdx.x, opq((const GAS float*)args.out), opq((GAS float*)args.out), opq((GAS bf16*)(opq(ws) + WS_XNB)), opq((GAS float*)(opq(ws) + WS_SSQ)));
        SEAM(pb + 10);
        if (IN(pb + 12)) { GEMM_SITE(EpiBf16, XNB, D, (const GAS bf16*)(opq(ws) + WS_WPQ) + (size_t)l * D * D, D, T, D, D, (int)blockIdx.x, opq(PROJB), D, D, opq((const GAS float*)(opq(ws) + WS_SSQ)), 16);
            SITE(); hq_phase(opq(XNB), opq((const GAS float*)(opq(ws) + WS_SSQ)), (const GAS float*)args.in[opqi(27)] + l * D, opq((GAS unsigned char*)(opq(ws) + WS_HQ)), opq((GAS float*)(opq(ws) + WS_SH)), opq((GAS int*)(opq(ws) + WS_P)), gw_, NGW_, LANE_); }
        SEAM(pb + 12);
        if (IN(pb + 13)) {
            SITE();
            RouteP RP{opq((const GAS bf16*)PROJB), opq((const GAS bf16*)(opq(ws) + WS_KEYS) + (size_t)l * 2 * 128 * 64), opq((GAS int*)(opq(ws) + WS_EX)), opq((GAS float*)(opq(ws) + WS_GW))};
            route_phase(RP, F.lds, TID_, wv_, LANE_, vcu_, G_);
#if MK_DUP == 13
            route_phase(RP, F.lds, TID_, wv_, LANE_, vcu_, G_);
#endif
        }
        SEAM(pb + 13);
        if (IN(pb + 14)) {
            SITE();
            const PeerS ps = peer_sched((const GAS unsigned*)(F.ctl + CW_RANK), opqi(F.xcc), opqi(F.xrank));
            Peer1P Q1{opq((const GAS unsigned char*)(opq(ws) + WS_HQ)), opq((const GAS int*)(opq(ws) + WS_EX)), opq((const GAS unsigned char*)(opq(ws) + WS_U8) + (size_t)l * 16384 * 1024), opq((GAS int*)(opq(ws) + WS_P))};
            peer_k1(Q1, ps, wv_, LANE_);
#if MK_DUP == 141
            { Peer1P Q1b = Q1; Q1b.P = (GAS int*)(opq(ws) + WS_PROJB); peer_k1(Q1b, ps, wv_, LANE_); }
#endif
        }
        SEAM(pb + 14);
        if (IN(pb + 15)) {
            SITE();
            peer_w(opq((const GAS int*)(opq(ws) + WS_EX)), opq((const GAS float*)(opq(ws) + WS_GW)), opq((const GAS int*)(opq(ws) + WS_P)), opq((const GAS float*)(opq(ws) + WS_SH)), opq((const GAS float*)(opq(ws) + WS_SU) + l * 16384), opq((const GAS float*)(opq(ws) + WS_SV) + l * 16384),
                   opq((GAS signed char*)(opq(ws) + WS_W)), opq((GAS float*)(opq(ws) + WS_WS)), gw_, NGW_, LANE_);
            xcd_barrier(bar, (F.wave == 0 && lane_id_v() == 0) ? 1 : 0);
            const PeerS ps = peer_sched((const GAS unsigned*)(F.ctl + CW_RANK), opqi(F.xcc), opqi(F.xrank));
            Peer2P Q2{opq((const GAS int*)(opq(ws) + WS_EX)), opq((const GAS signed char*)(opq(ws) + WS_W)), opq((const GAS float*)(opq(ws) + WS_WS)), opq((const GAS unsigned char*)(opq(ws) + WS_V8) + (size_t)l * 16384 * 1024), (GAS float*)args.out, opq((GAS bf16*)(opq(ws) + WS_XNB)), opq((GAS float*)(opq(ws) + WS_SSQ))};
            peer_k2(Q2, ps, wv_, LANE_);
#if MK_DUP == 151
            { Peer2P Q2b = Q2; Q2b.X = (GAS float*)(opq(ws) + WS_PROJB); peer_k2(Q2b, ps, wv_, LANE_); }
#endif
        }
        SEAM(pb + 15);
    }
    if (IN(PH_FINAL)) { SITE(); final_norm_phase((GAS float*)args.out, (const GAS float*)args.in[opqi(32)], T, gw_, NGW_, LANE_); }
#undef IN
#undef SEAM
#undef GEMM_SITE
}
}
extern "C" void kernel_launch(void* const* d_in, const int* in_sizes, int n_in, void* d_out, int out_size, void* d_ws, size_t ws_size, hipStream_t stream) {
    (void)in_sizes; (void)out_size;
    static int grid = 0;
    if (grid == 0) {
        int dev = 0, cus = 0, per_cu = 0;
        if (n_in != 33 || ws_size < mk::WS_END) { fprintf(stderr, "kernel_launch: unexpected n_in %d / ws_size %zu\n", n_in, ws_size); grid = -1; return; }
        if (hipGetDevice(&dev) != hipSuccess || hipDeviceGetAttribute(&cus, hipDeviceAttributeMultiprocessorCount, dev) != hipSuccess) { grid = -1; return; }
        if (hipFuncSetAttribute((const void*)mk::fwd, hipFuncAttributeMaxDynamicSharedMemorySize, mk::LDS_BYTES) != hipSuccess) { fprintf(stderr, "kernel_launch: hipFuncSetAttribute failed\n"); grid = -1; return; }
        if (hipOccupancyMaxActiveBlocksPerMultiprocessor(&per_cu, (const void*)mk::fwd, mk::NWAVES * 64, mk::LDS_BYTES) != hipSuccess || per_cu < 1) fprintf(stderr, "kernel_launch: occupancy query says %d\n", per_cu);
        (void)hipGetLastError();
        grid = cus;
    }
    if (grid < 0) return;
    unsigned char* ws = (unsigned char*)d_ws;
    (void)hipMemsetAsync(ws + mk::WS_CTL, 0, mk::CTL_ZERO_BYTES, stream);
    mk::Args a{};
    for (int i = 0; i < 33; ++i) a.in[i] = (const float*)d_in[i];
    a.out = (float*)d_out; a.ws = ws;
    auto run = [&](int lo, int hi) { a.ph_lo = lo; a.ph_hi = hi; hipLaunchKernelGGL(mk::fwd, dim3(grid), dim3(mk::NWAVES * 64), mk::LDS_BYTES, stream, a); };
#if MK_ONE_LAUNCH
    run(0, mk::PH_FINAL + 1);
#else
    for (int p = 0; p <= mk::PH_FINAL; ++p) {
        const int k = (p - 2) % mk::NPL, l = (p - 2) / mk::NPL;
#if MK_NAIVE_PEER == 2
        if (p >= 2 && p < mk::PH_FINAL && k == 14) {
            hipLaunchKernelGGL(k_peer, dim3(T), dim3(256), 0, stream, (const bf16_t*)(ws + mk::WS_XNB), (const int*)(ws + mk::WS_EX), (const float*)(ws + mk::WS_GW), (const float*)d_in[30] + (size_t)l * NEXP * D, (const float*)d_in[31] + (size_t)l * NEXP * D, (float*)d_out);
            continue; }
#elif MK_NAIVE_PEER == 1
        if (p >= 2 && p < mk::PH_FINAL && k == 13) {
            float* TQ = (float*)(ws + (size_t)806 * mk::MiB);
            hipLaunchKernelGGL(k_bf2f, dim3((unsigned)(((size_t)T * D + 255) / 256)), dim3(256), 0, stream, (const bf16_t*)(ws + mk::WS_PROJB), TQ, (long)T * D);
            hipLaunchKernelGGL(k_route, dim3(T), dim3(256), 0, stream, TQ, (const float*)d_in[29] + (size_t)l * 2 * 128 * 64, (int*)(ws + mk::WS_EX), (float*)(ws + mk::WS_GW));
            hipLaunchKernelGGL(k_peer, dim3(T), dim3(256), 0, stream, (const bf16_t*)(ws + mk::WS_XNB), (const int*)(ws + mk::WS_EX), (const float*)(ws + mk::WS_GW), (const float*)d_in[30] + (size_t)l * NEXP * D, (const float*)d_in[31] + (size_t)l * NEXP * D, (float*)d_out);
            continue; }
        if (p >= 2 && p < mk::PH_FINAL && k == 14) continue;
#endif
        run(p, p + 1); }
#endif
}
```

```cpp
#include <hip/hip_runtime.h>
#include <cstdint>
#include <cstdio>
#include <cmath>

#ifndef MK_ONE_LAUNCH
#define MK_ONE_LAUNCH 1
#endif
#ifndef MK_DUP
#define MK_DUP 0
#endif
#ifndef MK_NAIVE_PEER
#define MK_NAIVE_PEER 0
#endif
namespace pg8 {
#define PG8_LAS __attribute__((address_space(3)))
#ifndef GAS
#define GAS __attribute__((address_space(1)))
#endif
typedef unsigned short bf16_t;
typedef short bf16x8 __attribute__((ext_vector_type(8)));
typedef float f32x4 __attribute__((ext_vector_type(4)));
typedef unsigned u32x4 __attribute__((ext_vector_type(4)));
typedef unsigned u32x2 __attribute__((ext_vector_type(2)));
constexpr int BM = 256, BK = 64, HALF = 128, HTB = HALF * BK * 2, STAGE_BYTES = 8 * HTB, NXCD = 8, WGM = 8;
__host__ __device__ __forceinline__ int lds_byte(int r, int c) { const int st = (r >> 4) * 2 + (c >> 5), rr = r & 15, cc = c & 31, ob = rr * 64 + cc * 2; return st * 1024 + (ob ^ (((ob >> 9) & 1) << 5)); }
__host__ __device__ __forceinline__ void stage_rc(int b, int& R, int& C) { const int st = b / 1024, sb = b % 1024, swz = sb ^ (((sb >> 9) & 1) << 5); R = (st >> 1) * 16 + swz / 64; C = (st & 1) * 32 + (swz % 64) / 2; }
__host__ __device__ __forceinline__ int perm32(int rho) { const int n = rho >> 4, i = rho & 15; return 8 * (i >> 2) + 4 * n + (i & 3); }
__device__ __forceinline__ int pg8_lane_id() { int l; asm volatile("v_mbcnt_lo_u32_b32 %0, -1, 0\n\tv_mbcnt_hi_u32_b32 %0, -1, %0" : "=v"(l)); return l; }
struct Unit { int pm, pn; };
struct Gemm { const GAS bf16_t* A; const GAS bf16_t* Bt; int M, N, K, lda, ldb; };
struct StaticOrder {
    int nM, nN, nwg, G, c;
    __host__ __device__ void init(int M, int N, int G_, int c_) { nM = M / BM; nN = N / BM; nwg = nM * nN; G = G_; c = c_; }
    __host__ __device__ bool next(int i, Unit& u) const {
        const long L = (long)i * G + c; if (L >= nwg) return false;
        int wgid = (int)L; { const int q = nwg / NXCD, r = nwg % NXCD, xcd = wgid % NXCD, off = wgid / NXCD; wgid = (xcd < r ? xcd * (q + 1) : r * (q + 1) + (xcd - r) * q) + off; }
        const int nig = WGM * nN, gid = wgid / nig, fm = gid * WGM, gsz = (nM - fm) < WGM ? (nM - fm) : WGM;
        u.pm = fm + ((wgid % nig) % gsz); u.pn = (wgid % nig) / gsz; return true;
    }
    __device__ __forceinline__ void a_ready(const Unit&) const {}
    __device__ __forceinline__ void done(const Unit&) const {}
};
__device__ __forceinline__ unsigned cvt_pk_bf16(float lo, float hi) { unsigned r; asm volatile("v_cvt_pk_bf16_f32 %0, %1, %2" : "=v"(r) : "v"(lo), "v"(hi)); return r; }

struct EpiF32 {
    static constexpr bool PERM = false, AFTER_DRAIN = false;
    GAS float* C; int ldc; int nvalid; int accum;
    __device__ __forceinline__ void operator()(const f32x4 (&acc)[2][2][4][2], const Unit& u, int wr, int wc, int fr, int fq) const {
        { const int l_ = pg8_lane_id(); fr = l_ & 15; fq = l_ >> 4; }
#pragma unroll
        for (int ai = 0; ai < 2; ++ai)
#pragma unroll
            for (int m = 0; m < 4; ++m) { const size_t row = (size_t)u.pm * BM + ai * HALF + wr * 64 + m * 16 + fr;
#pragma unroll
                for (int bj = 0; bj < 2; ++bj)
#pragma unroll
                    for (int n = 0; n < 2; ++n) { const int col = u.pn * BM + bj * HALF + wc * 32 + n * 16 + 4 * fq;
                        if (col < nvalid) { GAS float* p = C + row * ldc + col; f32x4 v = acc[ai][bj][m][n]; if (accum) v += *(const GAS f32x4*)p; *(GAS f32x4*)p = v; } } }
    }
};
struct EpiBf16 {
    static constexpr bool PERM = true, AFTER_DRAIN = false;
    GAS bf16_t* O; int ldc; int nvalid; const GAS float* ssq; int np;
    __device__ __forceinline__ void operator()(const f32x4 (&acc)[2][2][4][2], const Unit& u, int wr, int wc, int fr, int fq) const {
        { const int l_ = pg8_lane_id(); fr = l_ & 15; fq = l_ >> 4; }
#pragma unroll
        for (int ai = 0; ai < 2; ++ai)
#pragma unroll
            for (int m = 0; m < 4; ++m) { const size_t row = (size_t)u.pm * BM + ai * HALF + wr * 64 + m * 16 + fr;
                float rs_ = 1.f;
                if (np > 0) { const GAS f32x4* sp = (const GAS f32x4*)(ssq + row * 16); f32x4 t = sp[0] + sp[1]; if (np > 8) t += sp[2] + sp[3]; rs_ = __builtin_amdgcn_rsqf(((t[0] + t[1]) + (t[2] + t[3])) * (1.f / 1024.f) + 1e-6f); }
#pragma unroll
                for (int bj = 0; bj < 2; ++bj) { const int col = u.pn * BM + bj * HALF + wc * 32 + 8 * fq;
                    if (col < nvalid) { const f32x4 v0 = acc[ai][bj][m][0] * rs_, v1 = acc[ai][bj][m][1] * rs_; u32x4 w; w.x = cvt_pk_bf16(v0[0], v0[1]); w.y = cvt_pk_bf16(v0[2], v0[3]); w.z = cvt_pk_bf16(v1[0], v1[1]); w.w = cvt_pk_bf16(v1[2], v1[3]);
                        *(GAS u32x4*)(O + row * ldc + col) = w; } } }
    }
};
struct EpiUp {
    static constexpr bool PERM = true, AFTER_DRAIN = false;
    GAS bf16_t* O; GAS bf16_t* O2; int ldc; int nvalid; const GAS float* rs; int rsi; int mode;
    __device__ __forceinline__ void operator()(const f32x4 (&acc)[2][2][4][2], const Unit& u, int wr, int wc, int fr, int fq) const {
        { const int l_ = pg8_lane_id(); fr = l_ & 15; fq = l_ >> 4; }
#pragma unroll
        for (int ai = 0; ai < 2; ++ai)
#pragma unroll
            for (int m = 0; m < 4; ++m) { const size_t row = (size_t)u.pm * BM + ai * HALF + wr * 64 + m * 16 + fr; const float s = rs[2 * row + rsi];
#pragma unroll
                for (int bj = 0; bj < 2; ++bj) { const int col = u.pn * BM + bj * HALF + wc * 32 + 8 * fq;
                    if (col < nvalid) { const f32x4 v0 = acc[ai][bj][m][0] * s, v1 = acc[ai][bj][m][1] * s; u32x4 w; w.x = cvt_pk_bf16(v0[0], v0[1]); w.y = cvt_pk_bf16(v0[2], v0[3]); w.z = cvt_pk_bf16(v1[0], v1[1]); w.w = cvt_pk_bf16(v1[2], v1[3]);
                        GAS bf16_t* dst;
                        if (mode == 0) dst = O + row * ldc + col;
                        else { const int h = col >> 7, j = col & 127; dst = (j < 64) ? O + row * 384 + h * 96 + j : O2 + row * 256 + h * 64 + (j - 64); }
                        *(GAS u32x4*)dst = w; } } }
    }
};

struct EpiRes {
    static constexpr bool PERM = false, AFTER_DRAIN = false;
    const GAS float* src; GAS float* dst; GAS bf16_t* XB; GAS float* SSQ;
    __device__ __forceinline__ void operator()(const f32x4 (&acc)[2][2][4][2], const Unit& u, int wr, int wc, int fr, int fq) const {
        { const int l_ = pg8_lane_id(); fr = l_ & 15; fq = l_ >> 4; }
#pragma unroll
        for (int ai = 0; ai < 2; ++ai)
#pragma unroll
            for (int m = 0; m < 4; ++m) { const size_t row = (size_t)u.pm * BM + ai * HALF + wr * 64 + m * 16 + fr; float ss = 0.f;
#pragma unroll
                for (int bj = 0; bj < 2; ++bj)
#pragma unroll
                    for (int n = 0; n < 2; ++n) { const size_t o = row * 1024 + u.pn * BM + bj * HALF + wc * 32 + n * 16 + 4 * fq;
                        const f32x4 v = acc[ai][bj][m][n] + *(const GAS f32x4*)(src + o); *(GAS f32x4*)(dst + o) = v;
                        u32x2 w; w.x = cvt_pk_bf16(v[0], v[1]); w.y = cvt_pk_bf16(v[2], v[3]); *(GAS u32x2*)(XB + o) = w;
                        ss += (v[0] * v[0] + v[1] * v[1]) + (v[2] * v[2] + v[3] * v[3]); }
                { float a = ss, b = ss; asm volatile("v_nop\n\tv_nop\n\tv_permlane16_swap_b32 %0, %1" : "+v"(a), "+v"(b)); ss = a + b; }
                { float a = ss, b = ss; asm volatile("v_nop\n\tv_nop\n\tv_permlane32_swap_b32 %0, %1" : "+v"(a), "+v"(b)); ss = a + b; }
                if (fq == 0) SSQ[row * 16 + 4 * u.pn + wc] = ss; }
    }
};
template <class Epi, class Sched, bool ALIGN_EPI = false, bool SP2 = false>
__device__ __forceinline__ void gemm_phase(PG8_LAS unsigned char* lds, const Gemm g, const Sched& S, const Epi& E, int wave_id) {
    int tid_ = (wave_id << 6) | pg8_lane_id(); asm volatile("" : "+v"(tid_));
    const int tid = tid_, wid = __builtin_amdgcn_readfirstlane(tid >> 6), lane = tid & 63, wr = wid >> 2, wc = wid & 3, fr = lane & 15, fq = lane >> 4;
    const int K = g.K, nt = K / BK;
    unsigned voffA[2], voffB[2];
#pragma unroll
    for (int i = 0; i < 2; ++i) { int R, C; stage_rc(tid * 16 + i * 8192, R, C); const int Rb = Epi::PERM ? ((R & ~31) + perm32(R & 31)) : R;
        voffA[i] = (unsigned)(R * g.lda + C) * 2u; voffB[i] = (unsigned)(Rb * g.ldb + C) * 2u; }
    const size_t kstep = (size_t)(BK * 2);
    const size_t hstepA = (size_t)HALF * g.lda * 2, hstepB = (size_t)HALF * g.ldb * 2;
    const size_t tstepA = 2 * hstepA, tstepB = 2 * hstepB;
    const unsigned ldsw = (unsigned)wid * 1024u;
    const int aoff = lds_byte(wr * 64 + fr, fq * 8), boff = lds_byte(wc * 32 + fr, fq * 8);
#define PG8_SA(b, h) (((b) * 2 + (h)) * HTB)
#define PG8_SB(b, h) ((4 + (b) * 2 + (h)) * HTB)
#define PG8_STAGE(bufoff, gbase, voff) do { _Pragma("unroll") for (int _i = 0; _i < 2; ++_i) \
        __builtin_amdgcn_global_load_lds((const unsigned*)((const char*)(gbase) + (voff)[_i]), (PG8_LAS unsigned*)(lds + (bufoff) + ldsw + _i * 8192), 16, 0, 0); } while (0)
#define PG8_LDA(dst, b, h) do { _Pragma("unroll") for (int m = 0; m < 4; ++m) _Pragma("unroll") for (int k = 0; k < 2; ++k) dst[m][k] = *(const PG8_LAS bf16x8*)(lds + PG8_SA(b, h) + aoff + m * 2048 + k * 1024); } while (0)
#define PG8_LDB(dst, b, h) do { _Pragma("unroll") for (int n = 0; n < 2; ++n) _Pragma("unroll") for (int k = 0; k < 2; ++k) dst[n][k] = *(const PG8_LAS bf16x8*)(lds + PG8_SB(b, h) + boff + n * 2048 + k * 1024); } while (0)
#define PG8_MMA(ai, bj, At, Bt) do { __builtin_amdgcn_s_setprio(1); _Pragma("unroll") for (int m = 0; m < 4; ++m) _Pragma("unroll") for (int n = 0; n < 2; ++n) _Pragma("unroll") for (int k = 0; k < 2; ++k) \
        acc[ai][bj][m][n] = __builtin_amdgcn_mfma_f32_16x16x32_bf16(Bt[n][k], At[m][k], acc[ai][bj][m][n], 0, 0, 0); __builtin_amdgcn_s_setprio(0); } while (0)
#define PG8_WAIT_V(n) asm volatile("s_waitcnt vmcnt(" #n ")" ::: "memory")
#define PG8_WAIT_L(n) asm volatile("s_waitcnt lgkmcnt(" #n ")" ::: "memory")
#define PG8_BAR __builtin_amdgcn_s_barrier()
#define PG8_SCHED __builtin_amdgcn_sched_barrier(0)
    Unit cur, nxt; int ui = 0;
    if (!S.next(0, cur)) return;
    f32x4 acc[2][2][4][2];
#pragma unroll
    for (int a = 0; a < 2; ++a)
#pragma unroll
        for (int b = 0; b < 2; ++b)
#pragma unroll
            for (int m = 0; m < 4; ++m)
#pragma unroll
                for (int n = 0; n < 2; ++n) acc[a][b][m][n] = (f32x4){0.f, 0.f, 0.f, 0.f};
    bf16x8 At[4][2], B0[2][2], B1[2][2];
    const char* cA = (const char*)g.A + (size_t)cur.pm * tstepA; const char* cB = (const char*)g.Bt + (size_t)cur.pn * tstepB;
    S.a_ready(cur);
    if constexpr (SP2) {
        PG8_STAGE(PG8_SB(0, 0), cB, voffB); PG8_STAGE(PG8_SB(0, 1), cB + hstepB, voffB); PG8_STAGE(PG8_SA(0, 0), cA, voffA); PG8_STAGE(PG8_SA(0, 1), cA + hstepA, voffA);
        if (wr == 1) PG8_BAR;
        PG8_WAIT_V(2); PG8_BAR;
        PG8_STAGE(PG8_SB(1, 0), cB + kstep, voffB); PG8_STAGE(PG8_SA(1, 0), cA + kstep, voffA); PG8_STAGE(PG8_SB(1, 1), cB + hstepB + kstep, voffB);
        PG8_WAIT_V(6); PG8_BAR;
    } else {
        PG8_STAGE(PG8_SB(0, 0), cB, voffB); PG8_STAGE(PG8_SA(0, 0), cA, voffA); PG8_STAGE(PG8_SB(0, 1), cB + hstepB, voffB); PG8_STAGE(PG8_SA(0, 1), cA + hstepA, voffA);
        if (wr == 1) PG8_BAR;
        PG8_WAIT_V(4); PG8_BAR;
        PG8_STAGE(PG8_SB(1, 0), cB + kstep, voffB); PG8_STAGE(PG8_SA(1, 0), cA + kstep, voffA); PG8_STAGE(PG8_SB(1, 1), cB + hstepB + kstep, voffB);
        PG8_WAIT_V(6); PG8_BAR;
    }
    for (;;) {
        const bool has_next = S.next(ui + 1, nxt);
        const char* nA = has_next ? (const char*)g.A + (size_t)nxt.pm * tstepA : cA; const char* nB = has_next ? (const char*)g.Bt + (size_t)nxt.pn * tstepB : cB;
        for (int t = 0; t < nt; t += 2) {
            const bool last = (t == nt - 2);
            const char* a1 = cA + (size_t)(t + 1) * kstep;
            const char* a2 = last ? nA : cA + (size_t)(t + 2) * kstep; const char* b2 = last ? nB : cB + (size_t)(t + 2) * kstep;
            const char* a3 = a2 + kstep; const char* b3 = b2 + kstep;
            if (last && has_next) S.a_ready(nxt);
            if constexpr (SP2) {
            PG8_LDB(B0, 0, 0); PG8_LDB(B1, 0, 1); PG8_SCHED; PG8_LDA(At, 0, 0); PG8_STAGE(PG8_SA(1, 1), a1 + hstepA, voffA);
            PG8_WAIT_V(8); PG8_WAIT_L(0); PG8_BAR; PG8_MMA(0, 0, At, B0); PG8_MMA(0, 1, At, B1); PG8_BAR; PG8_SCHED;
            PG8_LDA(At, 0, 1); PG8_STAGE(PG8_SB(0, 0), b2, voffB); PG8_STAGE(PG8_SB(0, 1), b2 + hstepB, voffB); PG8_STAGE(PG8_SA(0, 0), a2, voffA);
            PG8_WAIT_V(8); PG8_WAIT_L(0); PG8_BAR; PG8_MMA(1, 0, At, B0); PG8_MMA(1, 1, At, B1); PG8_BAR; PG8_SCHED;
            PG8_LDB(B0, 1, 0); PG8_LDB(B1, 1, 1); PG8_SCHED; PG8_LDA(At, 1, 0); PG8_STAGE(PG8_SA(0, 1), a2 + hstepA, voffA);
            PG8_WAIT_V(8); PG8_WAIT_L(0); PG8_BAR; PG8_MMA(0, 0, At, B0); PG8_MMA(0, 1, At, B1); PG8_BAR; PG8_SCHED;
            PG8_LDA(At, 1, 1); PG8_STAGE(PG8_SB(1, 0), b3, voffB); PG8_STAGE(PG8_SB(1, 1), b3 + hstepB, voffB); PG8_STAGE(PG8_SA(1, 0), a3, voffA);
            PG8_WAIT_V(8); PG8_WAIT_L(0); PG8_BAR; PG8_MMA(1, 0, At, B0); PG8_MMA(1, 1, At, B1); PG8_BAR; PG8_SCHED;
            } else {
            PG8_LDB(B0, 0, 0); PG8_SCHED; PG8_LDA(At, 0, 0); PG8_STAGE(PG8_SA(1, 1), a1 + hstepA, voffA);
            PG8_WAIT_L(8); PG8_BAR; PG8_WAIT_L(0); PG8_MMA(0, 0, At, B0); PG8_BAR; PG8_SCHED;
            PG8_LDB(B1, 0, 1); PG8_STAGE(PG8_SB(0, 0), b2, voffB);
            PG8_BAR; PG8_WAIT_L(0); PG8_MMA(0, 1, At, B1); PG8_BAR;
            PG8_LDA(At, 0, 1); PG8_STAGE(PG8_SA(0, 0), a2, voffA);
            PG8_BAR; PG8_WAIT_L(0); PG8_MMA(1, 0, At, B0); PG8_BAR; PG8_SCHED;
            PG8_STAGE(PG8_SB(0, 1), b2 + hstepB, voffB);
            PG8_WAIT_V(6); PG8_BAR; PG8_MMA(1, 1, At, B1); PG8_BAR;
            PG8_LDB(B0, 1, 0); PG8_SCHED; PG8_LDA(At, 1, 0); PG8_STAGE(PG8_SA(0, 1), a2 + hstepA, voffA);
            PG8_WAIT_L(8); PG8_BAR; PG8_WAIT_L(0); PG8_MMA(0, 0, At, B0); PG8_BAR; PG8_SCHED;
            PG8_LDB(B1, 1, 1); PG8_STAGE(PG8_SB(1, 0), b3, voffB);
            PG8_BAR; PG8_WAIT_L(0); PG8_MMA(0, 1, At, B1); PG8_BAR;
            PG8_LDA(At, 1, 1); PG8_STAGE(PG8_SA(1, 0), a3, voffA);
            PG8_BAR; PG8_WAIT_L(0); PG8_MMA(1, 0, At, B0); PG8_BAR; PG8_SCHED;
            PG8_STAGE(PG8_SB(1, 1), b3 + hstepB, voffB);
            PG8_WAIT_V(6); PG8_BAR; PG8_MMA(1, 1, At, B1); PG8_BAR;
            }
        }
        if constexpr (ALIGN_EPI) { if (wr == 0) PG8_BAR; }
        if constexpr (!Epi::AFTER_DRAIN) { E(acc, cur, wr, wc, fr, fq); S.done(cur); }
        if (!has_next) break;
#pragma unroll
        for (int a = 0; a < 2; ++a)
#pragma unroll
            for (int b = 0; b < 2; ++b)
#pragma unroll
                for (int m = 0; m < 4; ++m)
#pragma unroll
                    for (int n = 0; n < 2; ++n) acc[a][b][m][n] = (f32x4){0.f, 0.f, 0.f, 0.f};
        cur = nxt; cA = nA; cB = nB; ++ui;
        if constexpr (ALIGN_EPI) { if (wr == 1) PG8_BAR; }
    }
    PG8_WAIT_V(0);
    if constexpr (!ALIGN_EPI) { if (wr == 0) PG8_BAR; }
    PG8_BAR;
    if constexpr (Epi::AFTER_DRAIN) { E.fused(acc, cur, wr, wc, fr, fq, lds, wid, lane); S.done(cur); }
#undef PG8_SA
#undef PG8_SB
#undef PG8_STAGE
#undef PG8_LDA
#undef PG8_LDB
#undef PG8_MMA
#undef PG8_WAIT_V
#undef PG8_WAIT_L
#undef PG8_BAR
#undef PG8_SCHED
}
}

namespace mk {
#ifndef GAS
#define GAS __attribute__((address_space(1)))
#endif
#define LAS __attribute__((address_space(3)))
typedef unsigned short bf16;
typedef unsigned v4u __attribute__((ext_vector_type(4)));
typedef unsigned v2u __attribute__((ext_vector_type(2)));
typedef float f32x4 __attribute__((ext_vector_type(4)));
typedef GAS unsigned gu32;
#define LDS_WAIT() asm volatile("s_waitcnt lgkmcnt(0)" ::: "memory")
#define VM_WAIT() asm volatile("s_waitcnt vmcnt(0)" ::: "memory")
__device__ __forceinline__ unsigned f2bf_(float f) { unsigned u = __builtin_bit_cast(unsigned, f); return (u + 0x7fffu + ((u >> 16) & 1u)) >> 16; }
__device__ __forceinline__ unsigned pk2(float lo, float hi) { return f2bf_(lo) | (f2bf_(hi) << 16); }
__device__ __forceinline__ float bflo(unsigned w) { return __builtin_bit_cast(float, w << 16); }
__device__ __forceinline__ float bfhi(unsigned w) { return __builtin_bit_cast(float, w & 0xffff0000u); }

template <class P> __device__ __forceinline__ P* opq(P* p) { asm volatile("" : "+s"(p)); return p; }
__device__ __forceinline__ int opqi(int k) { asm volatile("" : "+s"(k)); return k; }
__device__ __forceinline__ float shx(float v, int o, int lane) { return __builtin_bit_cast(float, __builtin_amdgcn_ds_bpermute((lane ^ o) << 2, __builtin_bit_cast(int, v))); }
__device__ __forceinline__ int shxi(int v, int o, int lane) { return __builtin_amdgcn_ds_bpermute((lane ^ o) << 2, v); }
__device__ __forceinline__ int lane_id_v() { int l; asm volatile("v_mbcnt_lo_u32_b32 %0, -1, 0\n\tv_mbcnt_hi_u32_b32 %0, -1, %0" : "=v"(l)); return l; }
constexpr int NWAVES = 8;
constexpr int D = 1024, NB = 4, S = 8192, T = NB * S, L = 4, MEM = 256, INW = 2144, INP = 2304;
constexpr int PC_CQ = 0, PC_CKV = 256, PC_KR = 384, PC_XL = 512, PC_GL = 1024, PC_QD = 1536, PC_KD = 1792, PC_VD = 2048;
constexpr float LOG2E = 1.4426950408889634f;
constexpr size_t MiB = 1u << 20;
constexpr size_t WS_CTL = 0, CTL_ZERO_BYTES = 1 * MiB;
constexpr size_t WS_WIN = 1 * MiB, WS_WOUT = 19 * MiB, WS_WCQ = 27 * MiB, WS_WCO = 35 * MiB, WS_WPQ = 43 * MiB, WS_WCKV = 51 * MiB, WS_WUQ = 67 * MiB, WS_WUKV = 68 * MiB, WS_KEYS = 69 * MiB, WS_ROPE = 70 * MiB;
constexpr size_t WS_XNB = 76 * MiB, WS_YB = 140 * MiB, WS_PROJB = 204 * MiB, WS_QMB = 348 * MiB, WS_KMB = 372 * MiB, WS_VMB = 396 * MiB, WS_RS = 412 * MiB;
constexpr size_t WS_HLB = 413 * MiB, WS_ACB = 445 * MiB, WS_LSUM = 477 * MiB, WS_OMB = 478 * MiB, WS_MNB = 494 * MiB, WS_KVCB = 502 * MiB, WS_EX = 518 * MiB, WS_GW = 534 * MiB;
constexpr size_t WS_U8 = 550 * MiB, WS_V8 = 614 * MiB, WS_SU = 678 * MiB, WS_SV = 679 * MiB;
constexpr size_t WS_HQ = 680 * MiB, WS_P = 712 * MiB, WS_SH = 728 * MiB, WS_W = 729 * MiB, WS_WS = 745 * MiB, WS_SSQ = 746 * MiB, WS_END = 748 * MiB;
constexpr size_t WS_WAT = 74 * MiB;
constexpr size_t WS_BTAB = WS_KEYS + 512 * 1024, WS_LAMS = WS_BTAB + 4096, WS_SP = WS_LAMS + 4096;
constexpr int CW_BAR = 4096, CW_RANK = 8192;
constexpr int RING_OFF = 0, RING_BYTES = 155648, LDSCTL_OFF = RING_BYTES, MISC_OFF = LDSCTL_OFF + 320, LDS_BYTES = 163840;

#define XB_TMO      128
#define XB_XCNT(j)  (256  + 64 * (j))
#define XB_XSUB(j)  (1280 + 64 * (j))
#define XB_XGEN(j)  (2304 + 64 * (j))
#define XB_TOP      3328
#define XB_TOPGEN   3392
#define XCD_BAR_WORDS 3456
#define XB_SPIN_CAP (1u << 18)

__device__ __forceinline__ unsigned xb_ld(unsigned* p)              { return __hip_atomic_load(p, __ATOMIC_RELAXED, __HIP_MEMORY_SCOPE_AGENT); }
__device__ __forceinline__ unsigned xb_add(unsigned* p, unsigned v) { return __hip_atomic_fetch_add(p, v, __ATOMIC_RELAXED, __HIP_MEMORY_SCOPE_AGENT); }
__device__ __forceinline__ unsigned xb_xcc_id() { return (unsigned)__builtin_amdgcn_s_getreg((3 << 11) | 20) & 0xFu; }
#define XB_SPIN(cond, bar) do { unsigned _sp = 0; while (cond) { __builtin_amdgcn_s_sleep(1); \
    if ((++_sp & 255u) == 0u) { if (xb_ld(&(bar)[XB_TMO])) break; if (_sp > XB_SPIN_CAP) { atomicAdd(&(bar)[XB_TMO], 1u); break; } } } } while (0)

struct XcdBarrier {
    unsigned* bar; unsigned x;
    volatile LAS unsigned* st;
};

__device__ __forceinline__ XcdBarrier xcd_barrier_post(unsigned* bar, volatile LAS unsigned* st) {
    XcdBarrier b; b.bar = bar; b.x = xb_xcc_id(); b.st = st;
    if (threadIdx.x == 0) (void)xb_add(&bar[XB_XCNT(b.x)], 1u);
    return b;
}
__device__ __forceinline__ void xcd_barrier_complete(unsigned* bar, unsigned x, unsigned& nloc, unsigned& nx) {
    const unsigned G = gridDim.x * gridDim.y * gridDim.z;
    unsigned sum, cnt, mine, sp = 0u;
    for (;;) {
        sum = 0u; cnt = 0u; mine = 0u;
#pragma unroll
        for (unsigned j = 0; j < 16; ++j) { const unsigned c = xb_ld(&bar[XB_XCNT(j)]); sum += c; cnt += (c > 0u) ? 1u : 0u; mine = (j == x) ? c : mine; }
        if (sum == G) break;
        __builtin_amdgcn_s_sleep(1);
        if ((++sp & 255u) == 0u) { if (xb_ld(&bar[XB_TMO])) break; if (sp > XB_SPIN_CAP) { atomicAdd(&bar[XB_TMO], 1u); break; } }
    }
    nloc = mine > 0u ? mine : 1u; nx = cnt > 0u ? cnt : 1u;
}

__device__ __noinline__ void xcd_barrier_impl(unsigned* bar_, unsigned x_, volatile LAS unsigned* st_, int leader_) {
    XcdBarrier b; b.bar = bar_; b.x = x_; b.st = st_;
    asm volatile("s_waitcnt vmcnt(0)" ::: "memory");
    __syncthreads();
    if (leader_) {
        unsigned* bar = b.bar;
        __builtin_amdgcn_s_waitcnt(0);
        unsigned nloc = b.st[0], nx = b.st[1];
        if (nloc == 0u) { xcd_barrier_complete(bar, b.x, nloc, nx); b.st[0] = nloc; b.st[1] = nx; }
        const unsigned old = xb_add(&bar[XB_XSUB(b.x)], 1u);
        const unsigned gen = old / nloc;
        if (old + 1u == (gen + 1u) * nloc) {
            __builtin_amdgcn_fence(__ATOMIC_RELEASE, "agent");
            asm volatile("s_waitcnt vmcnt(0)" ::: "memory");
            const unsigned og = xb_add(&bar[XB_TOP], 1u);
            const unsigned tg = og / nx;
            if (og + 1u == (tg + 1u) * nx) xb_add(&bar[XB_TOPGEN], 1u);
            else XB_SPIN(xb_ld(&bar[XB_TOPGEN]) == tg, bar);
            __builtin_amdgcn_fence(__ATOMIC_ACQUIRE, "agent");
            xb_add(&bar[XB_XGEN(b.x)], 1u);
            asm volatile("s_waitcnt vmcnt(0)" ::: "memory");
        } else {
            XB_SPIN(xb_ld(&bar[XB_XGEN(b.x)]) == gen, bar);
            __builtin_amdgcn_fence(__ATOMIC_ACQUIRE, "agent");
            asm volatile("s_waitcnt vmcnt(0)" ::: "memory");
        }
    }
    __syncthreads();
}
__device__ __forceinline__ void xcd_barrier(const XcdBarrier& b, int leader) { xcd_barrier_impl(b.bar, b.x, b.st, leader); }


__device__ __forceinline__ float wave_sum(float v, int lane) {
#pragma unroll
    for (int o = 1; o < 64; o <<= 1) v += shx(v, o, lane);
    return v;
}
__device__ __forceinline__ float gelu_erf(float v) {
    const float av = __builtin_fabsf(v), t = __builtin_amdgcn_rcpf(av * 0.2316418882f + 1.0f);
    float q = t * 0.5307027145f + (-0.7265760135f); q = q * t + 0.7107068705f; q = q * t + (-0.142248368f); q = q * t + 0.127414796f; q = q * t;
    const float e = __builtin_amdgcn_exp2f((v * v) * (-0.72134752044f));
    const float m = v * (q * e);
    return v < 0.f ? m : v - m;
}

__device__ __forceinline__ void norm_phase(const GAS float* X, const GAS float* g, GAS bf16* out, int rows, int gw, int NGW, int lane) {
    asm volatile("" : "+v"(lane));
    f32x4 gv[4];
#pragma unroll
    for (int j = 0; j < 4; ++j) gv[j] = ((const GAS f32x4*)g)[lane + 64 * j];
    for (int m = gw; m < rows; m += NGW) {
        const GAS f32x4* xr = (const GAS f32x4*)(X + (size_t)m * D) + lane;
        f32x4 v[4]; float s = 0.f;
#pragma unroll
        for (int j = 0; j < 4; ++j) { v[j] = xr[64 * j]; s += (v[j].x * v[j].x + v[j].y * v[j].y) + (v[j].z * v[j].z + v[j].w * v[j].w); }
        const float rs = rsqrtf(wave_sum(s, lane) * (1.f / D) + 1e-6f);
        GAS v2u* o8 = (GAS v2u*)(out + (size_t)m * D) + lane;
#pragma unroll
        for (int j = 0; j < 4; ++j) { v2u w; w.x = pk2(v[j].x * rs * gv[j].x, v[j].y * rs * gv[j].y); w.y = pk2(v[j].z * rs * gv[j].z, v[j].w * rs * gv[j].w); o8[64 * j] = w; }
    }
}
__device__ __forceinline__ void hq_phase(const GAS bf16* XB, const GAS float* SSQ, const GAS float* g, GAS unsigned char* HQ, GAS float* SH, GAS int* Pz, int gw, int NGW, int lane) {
    asm volatile("" : "+v"(lane));
    const GAS f32x4* gp = (const GAS f32x4*)g + 4 * lane; const f32x4 g0 = gp[0], g1 = gp[1], g2 = gp[2], g3 = gp[3];
    for (int m = gw; m < T; m += NGW) {
        const GAS f32x4* sp = (const GAS f32x4*)(SSQ + (size_t)m * 16); const f32x4 t = (sp[0] + sp[1]) + (sp[2] + sp[3]);
        const float rs = __builtin_amdgcn_rsqf(((t[0] + t[1]) + (t[2] + t[3])) * (1.f / 1024.f) + 1e-6f);
        const v4u a = *(const GAS v4u*)(XB + (size_t)m * D + 16 * lane), b = *(const GAS v4u*)(XB + (size_t)m * D + 16 * lane + 8);
        float f[16] = {bflo(a.x) * g0[0], bfhi(a.x) * g0[1], bflo(a.y) * g0[2], bfhi(a.y) * g0[3], bflo(a.z) * g1[0], bfhi(a.z) * g1[1], bflo(a.w) * g1[2], bfhi(a.w) * g1[3],
                       bflo(b.x) * g2[0], bfhi(b.x) * g2[1], bflo(b.y) * g2[2], bfhi(b.y) * g2[3], bflo(b.z) * g3[0], bfhi(b.z) * g3[1], bflo(b.w) * g3[2], bfhi(b.w) * g3[3]};
        float mx = 0.f;
#pragma unroll
        for (int i = 0; i < 16; ++i) { f[i] *= rs; mx = fmaxf(mx, __builtin_fabsf(f[i])); }
#pragma unroll
        for (int o = 1; o < 64; o <<= 1) mx = fmaxf(mx, shx(mx, o, lane));
        const float inv = mx > 0.f ? 127.f / mx : 0.f;
        v4u q;
#pragma unroll
        for (int i = 0; i < 4; ++i) { const int ia = (int)__builtin_rintf(f[4 * i] * inv), ib = (int)__builtin_rintf(f[4 * i + 1] * inv), ic = (int)__builtin_rintf(f[4 * i + 2] * inv), id = (int)__builtin_rintf(f[4 * i + 3] * inv);
            q[i] = (unsigned)(ia & 255) | ((unsigned)(ib & 255) << 8) | ((unsigned)(ic & 255) << 16) | ((unsigned)(id & 255) << 24); }
        *(GAS v4u*)(HQ + (size_t)m * D + 16 * lane) = q;
        if (lane == 0) SH[m] = mx * (1.f / 127.f);
        (Pz + (size_t)m * 128)[lane] = 0; (Pz + (size_t)m * 128)[lane + 64] = 0;
    }
}
__device__ __forceinline__ void x0_phase(const GAS float* X, GAS bf16* XB, GAS float* SSQ, int gw, int NGW, int lane) {
    asm volatile("" : "+v"(lane));
    for (int m = gw; m < T; m += NGW) {
        const GAS f32x4* xr = (const GAS f32x4*)(X + (size_t)m * D) + lane; GAS v2u* o8 = (GAS v2u*)(XB + (size_t)m * D) + lane;
        float s = 0.f;
#pragma unroll
        for (int j = 0; j < 4; ++j) { const f32x4 v = xr[64 * j]; s += (v.x * v.x + v.y * v.y) + (v.z * v.z + v.w * v.w); v2u w; w.x = pk2(v.x, v.y); w.y = pk2(v.z, v.w); o8[64 * j] = w; }
        s = wave_sum(s, lane);
        if (lane < 8) SSQ[(size_t)m * 16 + lane] = lane == 0 ? s : 0.f;
    }
}
__device__ __forceinline__ void final_norm_phase(GAS float* X, const GAS float* g, int rows, int gw, int NGW, int lane) {
    asm volatile("" : "+v"(lane));
    for (int m = gw; m < rows; m += NGW) {
        GAS f32x4* xr = (GAS f32x4*)(X + (size_t)m * D) + lane;
        f32x4 v[4]; float s = 0.f;
#pragma unroll
        for (int j = 0; j < 4; ++j) { v[j] = xr[64 * j]; s += (v[j].x * v[j].x + v[j].y * v[j].y) + (v[j].z * v[j].z + v[j].w * v[j].w); }
        const float rs = rsqrtf(wave_sum(s, lane) * (1.f / D) + 1e-6f);
#pragma unroll
        for (int j = 0; j < 4; ++j) { const f32x4 gj = ((const GAS f32x4*)g)[lane + 64 * j]; xr[64 * j] = v[j] * rs * gj; }
    }
}

__device__ __forceinline__ void pre_phase(const GAS bf16* PROJB, const GAS float* ROPE, GAS float* RS, GAS bf16* KMB, int gw, int NGW, int lane) {
    asm volatile("" : "+v"(lane));
    for (int t = gw; t < T; t += NGW) {
        const GAS bf16* pr = PROJB + (size_t)t * INP;
        float sq = 0.f, skv = 0.f;
        if (lane < 24) { const v4u w = *(const GAS v4u*)(pr + PC_CQ + 8 * lane);
            const float a0 = bflo(w.x), a1 = bfhi(w.x), a2 = bflo(w.y), a3 = bfhi(w.y), a4 = bflo(w.z), a5 = bfhi(w.z), a6 = bflo(w.w), a7 = bfhi(w.w);
            sq = (a0 * a0 + a1 * a1) + (a2 * a2 + a3 * a3) + (a4 * a4 + a5 * a5) + (a6 * a6 + a7 * a7); }
        else if (lane >= 32 && lane < 48) { const v4u w = *(const GAS v4u*)(pr + PC_CKV + 8 * (lane - 32));
            const float a0 = bflo(w.x), a1 = bfhi(w.x), a2 = bflo(w.y), a3 = bfhi(w.y), a4 = bflo(w.z), a5 = bfhi(w.z), a6 = bflo(w.w), a7 = bfhi(w.w);
            skv = (a0 * a0 + a1 * a1) + (a2 * a2 + a3 * a3) + (a4 * a4 + a5 * a5) + (a6 * a6 + a7 * a7); }
        sq = wave_sum(sq, lane); skv = wave_sum(skv, lane);
        if (lane == 0) { RS[2 * (size_t)t] = rsqrtf(sq * (1.f / 192.f) + 1e-6f); RS[2 * (size_t)t + 1] = rsqrtf(skv * (1.f / 128.f) + 1e-6f); }
        if (lane < 16) {
            const float x1 = __builtin_bit_cast(float, (unsigned)pr[PC_KR + lane] << 16), x2 = __builtin_bit_cast(float, (unsigned)pr[PC_KR + 16 + lane] << 16);
            const float c = ROPE[(size_t)t * 32 + lane], sn = ROPE[(size_t)t * 32 + 16 + lane];
            const bf16 y1 = (bf16)f2bf_(x1 * c - x2 * sn), y2 = (bf16)f2bf_(x1 * sn + x2 * c);
            GAS bf16* kr = KMB + (size_t)t * 384 + 64 + lane;
#pragma unroll
            for (int h = 0; h < 4; ++h) { kr[h * 96] = y1; kr[h * 96 + 16] = y2; }
        }
    }
}

typedef short lr_bf16x8 __attribute__((ext_vector_type(8)));
typedef float lr_f32x16 __attribute__((ext_vector_type(16)));
__device__ __forceinline__ void lr_swap32(float& a, float& b) { asm volatile("v_nop\n\tv_nop\n\tv_permlane32_swap_b32 %0, %1" : "+v"(a), "+v"(b)); }
constexpr int LR_XR = 0, LR_CW = LR_XR + 37376, LR_XA = LR_CW + 1280, LR_WT = LR_XA + 256 * 144, LR_SUM = LR_WT + 2 * 64 * 144, LR_END = LR_SUM + 4096;
struct LruP { const GAS bf16* PROJB; const GAS float* cw; const GAS float* cb; const GAS bf16* wat; const GAS float* ba; const GAS float* bx; const GAS float* sp; GAS unsigned* HA; GAS float* LSUM; };
__device__ __forceinline__ void lru_phase(const LruP& P, LAS unsigned char* lds, int tid, int wave, int lane, int vcu, int G) {
    asm volatile("" : "+v"(tid), "+v"(lane));
    LAS float* SUM = (LAS float*)(lds + LR_SUM);
    for (int u = vcu; u < (T / 256) * 8; u += G) {
        const int tile = u >> 3, g = u & 7; const int t0 = tile * 256; const bool first = ((tile & 31) == 0);
        __syncthreads();
        { v4u wt_[2], xr_[5];
#pragma unroll
          for (int i = 0; i < 2; ++i) { const int idx = tid + 512 * i; wt_[i] = ((const GAS v4u*)(P.wat + (size_t)g * 2 * 4096))[idx]; }
#pragma unroll
          for (int i = 0; i < 5; ++i) { const int idx = tid + 512 * i, row = idx >> 3, part = idx & 7; const bool ok = (idx < 259 * 8) && !(first && row < 3);
              const int trow = ok ? t0 - 3 + row : t0;
              xr_[i] = *(const GAS v4u*)(P.PROJB + (size_t)trow * INP + PC_XL + 64 * g + 8 * part); if (!ok) xr_[i] = v4u{0u, 0u, 0u, 0u}; }
          float cwv = 0.f; if (tid < 320) cwv = (tid < 256) ? P.cw[(tid >> 6) * 512 + 64 * g + (tid & 63)] : P.cb[64 * g + (tid - 256)];
#pragma unroll
          for (int i = 0; i < 2; ++i) { const int idx = tid + 512 * i; *(LAS v4u*)(lds + LR_WT + (idx >> 9) * 9216 + ((idx >> 3) & 63) * 144 + (idx & 7) * 16) = wt_[i]; }
#pragma unroll
          for (int i = 0; i < 5; ++i) { const int idx = tid + 512 * i, row = idx >> 3, part = idx & 7; if (idx < 259 * 8) *(LAS v4u*)(lds + LR_XR + row * 144 + 16 * part) = xr_[i]; }
          if (tid < 320) ((LAS float*)(lds + LR_CW))[tid] = cwv; }
        __syncthreads();
        { float cwr[4][8], cbr[8];
#pragma unroll
          for (int k = 0; k < 4; ++k) { const f32x4 c0 = *(const LAS f32x4*)(lds + LR_CW + (k * 64 + 8 * wave) * 4), c1 = *(const LAS f32x4*)(lds + LR_CW + (k * 64 + 8 * wave + 4) * 4);
              cwr[k][0] = c0.x; cwr[k][1] = c0.y; cwr[k][2] = c0.z; cwr[k][3] = c0.w; cwr[k][4] = c1.x; cwr[k][5] = c1.y; cwr[k][6] = c1.z; cwr[k][7] = c1.w; }
          { const f32x4 c0 = *(const LAS f32x4*)(lds + LR_CW + (256 + 8 * wave) * 4), c1 = *(const LAS f32x4*)(lds + LR_CW + (256 + 8 * wave + 4) * 4);
            cbr[0] = c0.x; cbr[1] = c0.y; cbr[2] = c0.z; cbr[3] = c0.w; cbr[4] = c1.x; cbr[5] = c1.y; cbr[6] = c1.z; cbr[7] = c1.w; }
#pragma unroll
          for (int it_ = 0; it_ < 4; ++it_) { const int time = lane + 64 * it_;
              float y[8];
#pragma unroll
              for (int e = 0; e < 8; ++e) y[e] = cbr[e];
#pragma unroll
              for (int k = 0; k < 4; ++k) { const v4u w = *(const LAS v4u*)(lds + LR_XR + (time + k) * 144 + 16 * wave);
                  y[0] += bflo(w.x) * cwr[k][0]; y[1] += bfhi(w.x) * cwr[k][1]; y[2] += bflo(w.y) * cwr[k][2]; y[3] += bfhi(w.y) * cwr[k][3];
                  y[4] += bflo(w.z) * cwr[k][4]; y[5] += bfhi(w.z) * cwr[k][5]; y[6] += bflo(w.w) * cwr[k][6]; y[7] += bfhi(w.w) * cwr[k][7]; }
              v4u o; o.x = pk2(y[0], y[1]); o.y = pk2(y[2], y[3]); o.z = pk2(y[4], y[5]); o.w = pk2(y[6], y[7]);
              *(LAS v4u*)(lds + LR_XA + time * 144 + 16 * wave) = o; } }
        __syncthreads();
        const int r32 = lane & 31, hi = lane >> 5;
        lr_f32x16 acc[2][2];
#pragma unroll
        for (int nt = 0; nt < 2; ++nt) { const float b_a = P.ba[64 * g + 32 * nt + r32], b_x = P.bx[64 * g + 32 * nt + r32];
#pragma unroll
            for (int r = 0; r < 16; ++r) { acc[0][nt][r] = b_a; acc[1][nt][r] = b_x; } }
        { lr_bf16x8 af[4];
#pragma unroll
          for (int s_ = 0; s_ < 4; ++s_) af[s_] = *(const LAS lr_bf16x8*)(lds + LR_XA + (32 * wave + r32) * 144 + (16 * s_ + 8 * hi) * 2);
#pragma unroll
          for (int gt = 0; gt < 2; ++gt)
#pragma unroll
              for (int nt = 0; nt < 2; ++nt)
#pragma unroll
                  for (int s_ = 0; s_ < 4; ++s_) { const lr_bf16x8 bfr = *(const LAS lr_bf16x8*)(lds + LR_WT + gt * 9216 + (32 * nt + r32) * 144 + (16 * s_ + 8 * hi) * 2);
                      acc[gt][nt] = __builtin_amdgcn_mfma_f32_32x32x16_bf16(af[s_], bfr, acc[gt][nt], 0, 0, 0); } }
#pragma unroll
        for (int nt = 0; nt < 2; ++nt) { const float sp = P.sp[64 * g + 32 * nt + r32];
            float sa_[4], sh_[4];
#pragma unroll
            for (int q = 0; q < 4; ++q) { float hrun = 0.f, arun = 1.f;
#pragma unroll
                for (int e = 0; e < 4; ++e) { const int r = 4 * q + e, tl = 8 * q + 4 * hi + e;
                    const float xv = __builtin_bit_cast(float, (unsigned)*(const LAS unsigned short*)(lds + LR_XA + (32 * wave + tl) * 144 + (32 * nt + r32) * 2) << 16);
                    const float rg = __builtin_amdgcn_rcpf(1.f + __builtin_amdgcn_exp2f(-LOG2E * acc[0][nt][r])), ig = __builtin_amdgcn_rcpf(1.f + __builtin_amdgcn_exp2f(-LOG2E * acc[1][nt][r]));
                    const float la = -8.0f * rg * sp; const float a_ = __builtin_amdgcn_exp2f(LOG2E * la);
                    const float uu = __builtin_amdgcn_sqrtf(fmaxf(1.f - a_ * a_, 0.f)) * (ig * xv);
                    hrun = a_ * hrun + uu; arun *= a_; acc[0][nt][r] = arun; acc[1][nt][r] = hrun; }
                sa_[q] = arun; sh_[q] = hrun; }
            float runA = 1.f, runH = 0.f;
#pragma unroll
            for (int q = 0; q < 4; ++q) { float a0 = sa_[q], a1 = sa_[q], h0 = sh_[q], h1 = sh_[q]; lr_swap32(a0, a1); lr_swap32(h0, h1);
                const float midA = runA * a0, midH = a0 * runH + h0;
                const float inA = hi ? midA : runA, inH = hi ? midH : runH;
                runA = midA * a1; runH = a1 * midH + h1;
#pragma unroll
                for (int e = 0; e < 4; ++e) { const int r = 4 * q + e; acc[1][nt][r] += acc[0][nt][r] * inH; acc[0][nt][r] *= inA; } }
            if (hi == 0) { SUM[(wave * 64 + 32 * nt + r32) * 2] = runA; SUM[(wave * 64 + 32 * nt + r32) * 2 + 1] = runH; } }
        __syncthreads();
#pragma unroll
        for (int nt = 0; nt < 2; ++nt) { const int cl = 32 * nt + r32;
            float ca = 1.f, chh = 0.f;
            for (int w = 0; w < wave; ++w) { const float aw = SUM[(w * 64 + cl) * 2], hw = SUM[(w * 64 + cl) * 2 + 1]; chh = aw * chh + hw; ca *= aw; }
            GAS unsigned* ha = P.HA + (size_t)(t0 + 32 * wave + 4 * hi) * 512 + 64 * g + cl;
#pragma unroll
            for (int r = 0; r < 16; ++r) { const float hh = acc[1][nt][r] + acc[0][nt][r] * chh, ac_ = acc[0][nt][r] * ca; ha[(size_t)((r & 3) + 8 * (r >> 2)) * 512] = pk2(hh, ac_);
                if (r == 15 && wave == 7 && hi == 1) { P.LSUM[((size_t)tile * 512 + 64 * g + cl) * 2] = ac_; P.LSUM[((size_t)tile * 512 + 64 * g + cl) * 2 + 1] = hh; } } }
    }
}

struct PostP { const GAS bf16* OMB; const GAS unsigned* HA; const GAS float* LSUM; const GAS bf16* PROJB; const GAS float* gm; const GAS float* gl; GAS bf16* Y; };
__device__ __forceinline__ void post_phase(const PostP& P, LAS unsigned char* lds, int tid, int wave, int lane, int vcu, int G) {
    asm volatile("" : "+v"(tid), "+v"(lane));
    LAS float* hin = (LAS float*)lds;
    for (int u = vcu; u < T / 64; u += G) {
        const int t0 = u * 64, tile = t0 >> 8, tb = tile & ~31;
        __syncthreads();
        { float h = 0.f;
          for (int c = tb; c < tile; ++c) { const float a = P.LSUM[((size_t)c * 512 + tid) * 2], hh = P.LSUM[((size_t)c * 512 + tid) * 2 + 1]; h = a * h + hh; }
          hin[tid] = h; }
        __syncthreads();
        f32x4 hi0 = *(const LAS f32x4*)(hin + 8 * lane), hi1 = *(const LAS f32x4*)(hin + 8 * lane + 4);
        const f32x4 g0 = *(const GAS f32x4*)(P.gl + 8 * lane), g1 = *(const GAS f32x4*)(P.gl + 8 * lane + 4), gmv = *(const GAS f32x4*)(P.gm + 4 * lane);
#pragma unroll 2
        for (int i = 0; i < 8; ++i) {
            const size_t t = (size_t)t0 + 8 * wave + i;
            const v4u p0 = *(const GAS v4u*)(P.HA + t * 512 + 8 * lane), p1 = *(const GAS v4u*)(P.HA + t * 512 + 8 * lane + 4), gw_ = *(const GAS v4u*)(P.PROJB + t * INP + PC_GL + 8 * lane);
            const v2u mw = *(const GAS v2u*)(P.OMB + t * 256 + 4 * lane);
            float o[8];
            o[0] = (bflo(p0.x) + bfhi(p0.x) * hi0.x) * gelu_erf(bflo(gw_.x)); o[1] = (bflo(p0.y) + bfhi(p0.y) * hi0.y) * gelu_erf(bfhi(gw_.x));
            o[2] = (bflo(p0.z) + bfhi(p0.z) * hi0.z) * gelu_erf(bflo(gw_.y)); o[3] = (bflo(p0.w) + bfhi(p0.w) * hi0.w) * gelu_erf(bfhi(gw_.y));
            o[4] = (bflo(p1.x) + bfhi(p1.x) * hi1.x) * gelu_erf(bflo(gw_.z)); o[5] = (bflo(p1.y) + bfhi(p1.y) * hi1.y) * gelu_erf(bfhi(gw_.z));
            o[6] = (bflo(p1.z) + bfhi(p1.z) * hi1.z) * gelu_erf(bflo(gw_.w)); o[7] = (bflo(p1.w) + bfhi(p1.w) * hi1.w) * gelu_erf(bfhi(gw_.w));
            float s2 = 0.f;
#pragma unroll
            for (int e = 0; e < 8; ++e) s2 += o[e] * o[e];
            const float m0 = bflo(mw.x), m1 = bfhi(mw.x), m2 = bflo(mw.y), m3 = bfhi(mw.y);
            float s1 = (m0 * m0 + m1 * m1) + (m2 * m2 + m3 * m3);
            s1 = wave_sum(s1, lane); s2 = wave_sum(s2, lane);
            const float r1 = rsqrtf(s1 * (1.f / 256.f) + 1e-6f), r2 = rsqrtf(s2 * (1.f / 512.f) + 1e-6f);
            GAS bf16* yr = P.Y + t * 1024;
            { v2u w; w.x = pk2(m0 * r1 * gmv.x, m1 * r1 * gmv.y); w.y = pk2(m2 * r1 * gmv.z, m3 * r1 * gmv.w); *(GAS v2u*)(yr + 4 * lane) = w; }
            { v4u w; w.x = pk2(o[0] * r2 * g0.x, o[1] * r2 * g0.y); w.y = pk2(o[2] * r2 * g0.z, o[3] * r2 * g0.w); w.z = pk2(o[4] * r2 * g1.x, o[5] * r2 * g1.y); w.w = pk2(o[6] * r2 * g1.z, o[7] * r2 * g1.w);
              *(GAS v4u*)(yr + 256 + 8 * lane) = w; }
        }
    }
}

#define TILE_BAR() asm volatile("s_waitcnt lgkmcnt(0)\n\ts_barrier" ::: "memory")
typedef short bf16x8 __attribute__((ext_vector_type(8)));
typedef short s16x4 __attribute__((ext_vector_type(4)));
typedef float f32x16 __attribute__((ext_vector_type(16)));
typedef unsigned u32x4 __attribute__((ext_vector_type(4)));
__device__ __forceinline__ int crow(int r, int hi) { return (r & 3) + 8 * (r >> 2) + 4 * hi; }
typedef float f32x2_t __attribute__((ext_vector_type(2))); typedef __bf16 bf16x2_c __attribute__((ext_vector_type(2)));
__device__ __forceinline__ unsigned cvtpk(float lo, float hi) { f32x2_t v = {lo, hi}; bf16x2_c b = __builtin_convertvector(v, bf16x2_c); return __builtin_bit_cast(unsigned, b); }
__device__ __forceinline__ float swapmax(float m) { auto rr = __builtin_amdgcn_permlane32_swap(__float_as_uint(m), __float_as_uint(m), false, false); return fmaxf(__uint_as_float(rr[0]), __uint_as_float(rr[1])); }
__device__ __forceinline__ float swapadd(float m) { auto rr = __builtin_amdgcn_permlane32_swap(__float_as_uint(m), __float_as_uint(m), false, false); return __uint_as_float(rr[0]) + __uint_as_float(rr[1]); }
__device__ __forceinline__ s16x4 vtr(const LAS unsigned char* p) { return __builtin_bit_cast(s16x4, __builtin_amdgcn_ds_read_tr16_b64_v4i16((LAS s16x4*)p)); }
__device__ __forceinline__ bf16x8 pack8(const f32x16& p, int b) { u32x4 w; w.x = cvtpk(p[b], p[b + 1]); w.y = cvtpk(p[b + 2], p[b + 3]); w.z = cvtpk(p[b + 4], p[b + 5]); w.w = cvtpk(p[b + 6], p[b + 7]); return __builtin_bit_cast(bf16x8, w); }
__device__ __forceinline__ float vmax3(float a, float b, float c) { float r; asm("v_max3_f32 %0, %1, %2, %3" : "=v"(r) : "v"(a), "v"(b), "v"(c)); return r; }
__device__ __forceinline__ float max32(const f32x16& p, const f32x16& q) {
    float a = vmax3(p[0], p[1], p[2]), b = vmax3(p[3], p[4], p[5]), c = vmax3(p[6], p[7], p[8]), d = vmax3(p[9], p[10], p[11]), e = vmax3(p[12], p[13], p[14]);
    float f = vmax3(q[0], q[1], q[2]), g = vmax3(q[3], q[4], q[5]), h = vmax3(q[6], q[7], q[8]), i = vmax3(q[9], q[10], q[11]), j = vmax3(q[12], q[13], q[14]);
    a = vmax3(a, b, c); d = vmax3(d, e, p[15]); f = vmax3(f, g, h); i = vmax3(i, j, q[15]);
    return vmax3(vmax3(a, d, f), i, i);
}
__device__ __forceinline__ float max16(const f32x16& p) { float a = fmaxf(fmaxf(p[0], p[1]), fmaxf(p[2], p[3])), b = fmaxf(fmaxf(p[4], p[5]), fmaxf(p[6], p[7])), c = fmaxf(fmaxf(p[8], p[9]), fmaxf(p[10], p[11])), d = fmaxf(fmaxf(p[12], p[13]), fmaxf(p[14], p[15])); return fmaxf(fmaxf(a, b), fmaxf(c, d)); }

struct AttnP {
    const GAS bf16* Q; const GAS bf16* K; const GAS bf16* V; int qp, kp, vp;
    GAS bf16* O; int op;
    const GAS float* rope;
    const GAS int* pos; const GAS float* btab; const GAS float* dnorm; const GAS float* lams;
};
template <int KIND> struct AK {
    static constexpr bool DIFF = KIND == 1, CROSS = KIND == 2;
    static constexpr int HW = KIND == 0 ? 96 : KIND == 1 ? 64 : 256;
    static constexpr int NKS = KIND == 0 ? 6 : KIND == 1 ? 2 : 16;
    static constexpr int KP = KIND == 0 ? 208 : KIND == 1 ? 144 : 528;
    static constexpr int ND = CROSS ? 4 : 2;
    static constexpr int CPK = HW / 8, KCH = (64 * CPK + 511) / 512;
    static constexpr int VCH = ND / 2;
    static constexpr int KB = 64 * KP, VB = ND * 4096;
    static constexpr int NBUF = CROSS ? 2 : 3;
    static constexpr int K0 = 0, V0 = NBUF * KB, POS = V0 + NBUF * VB, BT = POS + 1024, DN = BT + 528, END = DN + 256;
};
static_assert(AK<2>::END <= RING_BYTES && AK<0>::END <= RING_BYTES && AK<1>::END + 16 + 8 * 8192 <= RING_BYTES, "attention LDS");

template <int KIND, bool LEAD>
__device__ __forceinline__ void attn_unit(const AttnP& P, int b, int h, int qb, int dhalf, LAS unsigned char* lds, int tid, int wave, int lane) {
    lane = lane_id_v(); tid = (wave << 6) | lane;
    typedef AK<KIND> C;
    constexpr bool DIFF = C::DIFF, CROSS = C::CROSS;
    constexpr int HW = C::HW, NKS = C::NKS, KP = C::KP, ND = C::ND, CPK = C::CPK, KCH = C::KCH, VCH = C::VCH;
    const int r32 = lane & 31, hi = lane >> 5;
    const size_t rowb = (size_t)b * S, rowk = CROSS ? (size_t)b * MEM : rowb;
    const int q0w = qb * 256 + wave * 32, qi = q0w + r32;
    int pq = 0; float bias_far = 0.f;
    __syncthreads();
    if (DIFF) {
        pq = P.pos[rowb + qi];
        if (tid < 129) ((LAS float*)(lds + C::BT))[tid] = P.btab[h * 129 + tid];
        if (tid >= 192 && tid < 256) ((LAS float*)(lds + C::DN))[tid - 192] = P.dnorm[tid - 192];
    }
    int minq = pq;
    if (DIFF) { for (int o = 1; o < 64; o <<= 1) { const int v = shxi(minq, o, lane); minq = v < minq ? v : minq; } }
    const int NT = CROSS ? MEM / 64 : 4 * (qb + 1);
    u32x4 kr[KCH], vr[VCH]; int pkr = 0;
    u32x4 kr2[CROSS ? 1 : KCH], vr2[CROSS ? 1 : VCH]; int pkr2 = 0;
    const GAS bf16* Kb = P.K + rowk * P.kp + h * HW; const GAS bf16* Vb = P.V + rowk * P.vp + (CROSS ? h * 256 + dhalf * 128 : h * 64);
    const __amdgpu_buffer_rsrc_t rK = __builtin_amdgcn_make_buffer_rsrc((void*)Kb, 0, 0x7fffffff, 0x00020000), rV = __builtin_amdgcn_make_buffer_rsrc((void*)Vb, 0, 0x7fffffff, 0x00020000);
    const __amdgpu_buffer_rsrc_t rP = __builtin_amdgcn_make_buffer_rsrc((void*)(DIFF ? P.pos + rowb : (const GAS int*)Kb), 0, 0x7fffffff, 0x00020000);
    int kvo[KCH], vvo[VCH];
#pragma unroll
    for (int i = 0; i < KCH; ++i) { int c = tid + 512 * i; c = c < 64 * CPK ? c : tid; kvo[i] = ((c / CPK) * P.kp + (c % CPK) * 8) * 2; }
#pragma unroll
    for (int i = 0; i < VCH; ++i) { const int c = tid + 512 * i; vvo[i] = ((c / (4 * ND)) * P.vp + (c % (4 * ND)) * 8) * 2; }
    const int pvo = (tid & 63) * 4;
    auto gload = [&](int t) {
        const int ks = __builtin_amdgcn_readfirstlane(64 * t * P.kp * 2), vs = __builtin_amdgcn_readfirstlane(64 * t * P.vp * 2);
#pragma unroll
        for (int i = 0; i < KCH; ++i) kr[i] = __builtin_amdgcn_raw_buffer_load_b128(rK, kvo[i], ks, 0);
#pragma unroll
        for (int i = 0; i < VCH; ++i) vr[i] = __builtin_amdgcn_raw_buffer_load_b128(rV, vvo[i], vs, 0);
        if (DIFF) pkr = __builtin_amdgcn_raw_buffer_load_b32(rP, pvo, __builtin_amdgcn_readfirstlane(64 * t * 4), 0);
    };
    auto lstore = [&](int buf) {
        LAS unsigned char* kb_ = lds + C::K0 + buf * C::KB; LAS unsigned char* vb_ = lds + C::V0 + buf * C::VB;
#pragma unroll
        for (int i = 0; i < KCH; ++i) { int c = tid + 512 * i; c = c < 64 * CPK ? c : tid; const int key = c / CPK, part = c % CPK; *(LAS u32x4*)(kb_ + key * KP + part * 16) = kr[i]; }
#pragma unroll
        for (int i = 0; i < VCH; ++i) { const int c = tid + 512 * i; const int key = c / (4 * ND), part = c % (4 * ND); *(LAS u32x4*)(vb_ + (part >> 2) * 4096 + (key >> 3) * 512 + (key & 7) * 64 + (part & 3) * 16) = vr[i]; }
        if (DIFF) { ((LAS int*)(lds + C::POS + buf * 256))[tid & 63] = pkr; if (tid < 64) { int mk_ = pkr; for (int o = 1; o < 64; o <<= 1) { const int v = shxi(mk_, o, lane); mk_ = v > mk_ ? v : mk_; } if (tid == 0) ((LAS int*)(lds + C::POS + 768))[buf] = mk_; } }
    };
    auto gloadB = [&](int t) {
        const int ks = __builtin_amdgcn_readfirstlane(64 * t * P.kp * 2), vs = __builtin_amdgcn_readfirstlane(64 * t * P.vp * 2);
#pragma unroll
        for (int i = 0; i < (CROSS ? 1 : KCH); ++i) kr2[i] = __builtin_amdgcn_raw_buffer_load_b128(rK, kvo[i], ks, 0);
#pragma unroll
        for (int i = 0; i < (CROSS ? 1 : VCH); ++i) vr2[i] = __builtin_amdgcn_raw_buffer_load_b128(rV, vvo[i], vs, 0);
        if (DIFF) pkr2 = __builtin_amdgcn_raw_buffer_load_b32(rP, pvo, __builtin_amdgcn_readfirstlane(64 * t * 4), 0);
    };
    auto lstoreB = [&](int buf) {
        LAS unsigned char* kb_ = lds + C::K0 + buf * C::KB; LAS unsigned char* vb_ = lds + C::V0 + buf * C::VB;
#pragma unroll
        for (int i = 0; i < (CROSS ? 1 : KCH); ++i) { int c = tid + 512 * i; c = c < 64 * CPK ? c : tid; const int key = c / CPK, part = c % CPK; *(LAS u32x4*)(kb_ + key * KP + part * 16) = kr2[i]; }
#pragma unroll
        for (int i = 0; i < (CROSS ? 1 : VCH); ++i) { const int c = tid + 512 * i; const int key = c / (4 * ND), part = c % (4 * ND); *(LAS u32x4*)(vb_ + (part >> 2) * 4096 + (key >> 3) * 512 + (key & 7) * 64 + (part & 3) * 16) = vr2[i]; }
        if (DIFF) { ((LAS int*)(lds + C::POS + buf * 256))[tid & 63] = pkr2; if (tid < 64) { int mk_ = pkr2; for (int o = 1; o < 64; o <<= 1) { const int v = shxi(mk_, o, lane); mk_ = v > mk_ ? v : mk_; } if (tid == 0) ((LAS int*)(lds + C::POS + 768))[buf] = mk_; } }
    };
    LAS float* osv = (LAS float*)(lds + ((C::END + 15) & ~15)) + wave * 2048 + lane;
    float il = 0.f;
    f32x16 oA[ND];
#pragma unroll 1
    for (int mp = 0; mp < (DIFF ? 2 : 1); ++mp) {
        bf16x8 qf[NKS];
        { const GAS bf16* qrow = P.Q + (rowb + qi) * P.qp + h * HW + mp * 32;
#pragma unroll
          for (int s = 0; s < NKS; ++s) qf[s] = *(const GAS bf16x8*)(qrow + 16 * s + 8 * hi);
          if (KIND == 0) {
              const GAS float* rp = P.rope + (rowb + qi) * 32 + 8 * hi;
              const f32x4 c0 = *(const GAS f32x4*)rp, c1 = *(const GAS f32x4*)(rp + 4), s0 = *(const GAS f32x4*)(rp + 16), s1 = *(const GAS f32x4*)(rp + 20);
              const u32x4 a = __builtin_bit_cast(u32x4, qf[NKS - 2]), bq = __builtin_bit_cast(u32x4, qf[NKS - 1]); u32x4 ra, rb;
#pragma unroll
              for (int w = 0; w < 4; ++w) { const float cl = w < 2 ? c0[2 * w] : c1[2 * w - 4], ch = w < 2 ? c0[2 * w + 1] : c1[2 * w - 3], sl = w < 2 ? s0[2 * w] : s1[2 * w - 4], sh = w < 2 ? s0[2 * w + 1] : s1[2 * w - 3];
                  const float x1l = bflo(a[w]), x1h = bfhi(a[w]), x2l = bflo(bq[w]), x2h = bfhi(bq[w]);
                  ra[w] = cvtpk(x1l * cl - x2l * sl, x1h * ch - x2h * sh); rb[w] = cvtpk(x1l * sl + x2l * cl, x1h * sh + x2h * ch); }
              qf[NKS - 2] = __builtin_bit_cast(bf16x8, ra); qf[NKS - 1] = __builtin_bit_cast(bf16x8, rb);
          } }
        __syncthreads();
        float m1 = -1e30f, l1 = 0.f;
#pragma unroll
        for (int d = 0; d < ND; ++d)
#pragma unroll
            for (int r = 0; r < 16; ++r) oA[d][r] = 0.f;
        auto qk = [&](int sl, f32x16& sa, f32x16& sb, float init) {
            const LAS unsigned char* kb_ = lds + C::K0 + sl * C::KB + r32 * KP + hi * 16 + mp * 64;
#pragma unroll
            for (int r = 0; r < 16; ++r) { sa[r] = init; sb[r] = init; }
            constexpr int HB = CROSS ? 4 : (NKS > 3 ? 3 : NKS);
#pragma unroll
            for (int s0_ = 0; s0_ < NKS; s0_ += HB) {
                bf16x8 kfa[HB], kfb[HB];
#pragma unroll
                for (int s = 0; s < HB; ++s) { kfa[s] = *(const LAS bf16x8*)(kb_ + (s0_ + s) * 32); kfb[s] = *(const LAS bf16x8*)(kb_ + 32 * KP + (s0_ + s) * 32); }
                __builtin_amdgcn_sched_barrier(0);
#pragma unroll
                for (int s = 0; s < HB; ++s) { sa = __builtin_amdgcn_mfma_f32_32x32x16_bf16(kfa[s], qf[s0_ + s], sa, 0, 0, 0); sb = __builtin_amdgcn_mfma_f32_32x32x16_bf16(kfb[s], qf[s0_ + s], sb, 0, 0, 0); }
                __builtin_amdgcn_sched_barrier(0);
            }
        };
        auto isnear = [&](int sl) { bool nb = false;
            if (DIFF) { const int mk_ = __builtin_amdgcn_readfirstlane(((LAS int*)(lds + C::POS + 768))[sl]); nb = (minq - mk_) < 128; }
            return nb; };
        auto sm = [&](int t, int sl, f32x16& pa, f32x16& pb, bool nearb) -> float {
            const int k0 = 64 * t;
            if (DIFF) { if (nearb) {
                const LAS int* pk = (const LAS int*)(lds + C::POS + sl * 256); const LAS float* bt = (const LAS float*)(lds + C::BT);
#pragma unroll
                for (int r = 0; r < 16; ++r) { const int kk = crow(r, hi);
                    int n0 = pq - pk[kk], n1 = pq - pk[kk + 32]; n0 = n0 < 0 ? 0 : (n0 > 128 ? 128 : n0); n1 = n1 < 0 ? 0 : (n1 > 128 ? 128 : n1);
                    pa[r] += bt[n0]; pb[r] += bt[n1]; }
            } }
            if (!CROSS && k0 + 63 > q0w) {
#pragma unroll
                for (int r = 0; r < 16; ++r) { const int kk = k0 + crow(r, hi); if (kk > qi) pa[r] = -1e30f; if (kk + 32 > qi) pb[r] = -1e30f; }
            }
            asm volatile("s_nop 15\n\ts_nop 7" : "+v"(pa), "+v"(pb));
            float mn, al = 1.f;
            if (CROSS) { const float mx = swapmax(max32(pa, pb)); mn = fmaxf(m1, mx); al = __builtin_amdgcn_exp2f(m1 - mn); l1 *= al; }
            else { const float mx = swapmax(max32(pa, pb)); const bool up = mx > m1 + 8.0f; mn = up ? mx : m1;
                   if (__builtin_amdgcn_ballot_w64(up) != 0ull) { al = __builtin_amdgcn_exp2f(m1 - mn); l1 *= al; } }
            m1 = mn;
            float ls = 0.f;
#pragma unroll
            for (int r = 0; r < 16; ++r) { pa[r] = __builtin_amdgcn_exp2f(pa[r] - mn); pb[r] = __builtin_amdgcn_exp2f(pb[r] - mn); ls += pa[r] + pb[r]; }
            l1 += ls;
            return al;
        };
        auto pv = [&](int sl, const f32x16& pa, const f32x16& pb, float al) {
            const LAS unsigned char* vb_ = lds + C::V0 + sl * C::VB + ((lane >> 4) & 1) * 32 + (lane & 3) * 8 + (4 * hi + ((lane & 15) >> 2)) * 64;
            bf16x8 pf[4];
            pf[0] = pack8(pa, 0); pf[1] = pack8(pa, 8); pf[2] = pack8(pb, 0); pf[3] = pack8(pb, 8);
            const bool resc = CROSS ? true : (__builtin_amdgcn_ballot_w64(al != 1.0f) != 0ull);
            if (CROSS) {
#pragma unroll
                for (int d = 0; d < ND; ++d) {
                    __builtin_amdgcn_sched_barrier(0);
#pragma unroll
                    for (int r = 0; r < 16; ++r) oA[d][r] *= al;
                    bf16x8 vf[4];
#pragma unroll
                    for (int s = 0; s < 4; ++s) { const s16x4 lo = vtr(vb_ + d * 4096 + s * 1024), hh = vtr(vb_ + d * 4096 + s * 1024 + 512); vf[s] = (bf16x8){lo[0], lo[1], lo[2], lo[3], hh[0], hh[1], hh[2], hh[3]}; }
#pragma unroll
                    for (int s = 0; s < 4; ++s) oA[d] = __builtin_amdgcn_mfma_f32_32x32x16_bf16(vf[s], pf[s], oA[d], 0, 0, 0);
                }
            } else if (DIFF) {
                if (resc) {
#pragma unroll
                    for (int d = 0; d < 2; ++d)
#pragma unroll
                        for (int r = 0; r < 16; ++r) oA[d][r] *= al;
                }
#pragma unroll
                for (int d = 0; d < 2; ++d) {
                    bf16x8 vf[4];
#pragma unroll
                    for (int s = 0; s < 4; ++s) { const s16x4 lo = vtr(vb_ + d * 4096 + s * 1024), hh = vtr(vb_ + d * 4096 + s * 1024 + 512); vf[s] = (bf16x8){lo[0], lo[1], lo[2], lo[3], hh[0], hh[1], hh[2], hh[3]}; }
                    __builtin_amdgcn_sched_barrier(0);
#pragma unroll
                    for (int s = 0; s < 4; ++s) oA[d] = __builtin_amdgcn_mfma_f32_32x32x16_bf16(vf[s], pf[s], oA[d], 0, 0, 0);
                }
            } else {
                bf16x8 vf[2][4];
#pragma unroll
                for (int d = 0; d < 2; ++d)
#pragma unroll
                    for (int s = 0; s < 4; ++s) { const s16x4 lo = vtr(vb_ + d * 4096 + s * 1024), hh = vtr(vb_ + d * 4096 + s * 1024 + 512); vf[d][s] = (bf16x8){lo[0], lo[1], lo[2], lo[3], hh[0], hh[1], hh[2], hh[3]}; }
                if (resc) {
#pragma unroll
                    for (int d = 0; d < 2; ++d)
#pragma unroll
                        for (int r = 0; r < 16; ++r) oA[d][r] *= al;
                }
                __builtin_amdgcn_sched_barrier(0);
#pragma unroll
                for (int s = 0; s < 4; ++s)
#pragma unroll
                    for (int d = 0; d < 2; ++d) oA[d] = __builtin_amdgcn_mfma_f32_32x32x16_bf16(vf[d][s], pf[s], oA[d], 0, 0, 0);
            }
        };
        if (CROSS) {
            gload(0); lstore(0);
            __syncthreads();
            for (int t = 0; t < NT; ++t) {
                const int buf = t & 1;
                f32x16 pa, pb;
                qk(buf, pa, pb, 0.f);
                const float al = sm(t, buf, pa, pb, false);
                pv(buf, pa, pb, al);
                if (t + 1 < NT) { gload(t + 1); lstore(buf ^ 1); }
                TILE_BAR();
            }
        } else {
            gload(0); lstore(0); gload(1); lstore(1);
            gload(2); gloadB(3);
            __syncthreads();
            if (DIFF) bias_far = ((LAS float*)(lds + C::BT))[128];
            const int NTW = (q0w + 31) / 64 + 1;
            constexpr bool lead = LEAD;
            f32x16 ca, cb, na, nb; bool cnear = isnear(0), nnear = false; float cal = 1.f;
            qk(0, ca, cb, (DIFF && !cnear) ? bias_far : 0.f);
            if (lead) cal = sm(0, 0, ca, cb, cnear);
            int s0 = 0, s1 = 1, s2 = 2;
            auto period = [&](int t, f32x16& xa, f32x16& xb, bool& xnear, f32x16& ya, f32x16& yb, bool& ynear) {
                const bool have_next = (t + 1 < NTW);
                if (lead) {
                    if (have_next) { ynear = isnear(s1); qk(s1, ya, yb, (DIFF && !ynear) ? bias_far : 0.f); }
                    if (t < NTW) pv(s0, xa, xb, cal);
                    if (have_next) cal = sm(t + 1, s1, ya, yb, ynear);
                } else {
                    if (t < NTW) cal = sm(t, s0, xa, xb, xnear);
                    if (have_next) { ynear = isnear(s1); qk(s1, ya, yb, (DIFF && !ynear) ? bias_far : 0.f); }
                    if (t < NTW) pv(s0, xa, xb, cal);
                }
                { const int tmp = s0; s0 = s1; s1 = s2; s2 = tmp; }
            };
            int t = 0;
            for (; t + 5 < NT; t += 2) {
                lstore(s2); gload(t + 4);
                period(t, ca, cb, cnear, na, nb, nnear);
                TILE_BAR();
                lstoreB(s2); gloadB(t + 5);
                period(t + 1, na, nb, nnear, ca, cb, cnear);
                TILE_BAR();
            }
            for (; t < NT; t += 2) {
                if (t + 2 < NT) { lstore(s2); if (t + 4 < NT) gload(t + 4); }
                period(t, ca, cb, cnear, na, nb, nnear);
                TILE_BAR();
                if (t + 3 < NT) { lstoreB(s2); if (t + 5 < NT) gloadB(t + 5); }
                period(t + 1, na, nb, nnear, ca, cb, cnear);
                TILE_BAR();
            }
        }
        il = 1.f / swapadd(l1);
        if (DIFF) { if (mp == 0) {
#pragma unroll
            for (int d = 0; d < 2; ++d)
#pragma unroll
                for (int r = 0; r < 16; ++r) osv[(d * 16 + r) * 64] = oA[d][r] * il; } }
    }
    GAS bf16* orow = P.O + (rowb + qi) * P.op + (CROSS ? h * 256 + dhalf * 128 : h * 64);
    if (!DIFF) {
#pragma unroll
        for (int d = 0; d < ND; ++d)
#pragma unroll
            for (int g = 0; g < 4; ++g) { v2u v; v.x = cvtpk(oA[d][4 * g] * il, oA[d][4 * g + 1] * il); v.y = cvtpk(oA[d][4 * g + 2] * il, oA[d][4 * g + 3] * il); *(GAS v2u*)(orow + 32 * d + 8 * g + 4 * hi) = v; }
    } else {
        const float lam = P.lams[0], lam_init = P.lams[1];
        const float i2 = lam * il;
        float ss = 0.f;
#pragma unroll
        for (int d = 0; d < 2; ++d)
#pragma unroll
            for (int r = 0; r < 16; ++r) { const float v = osv[(d * 16 + r) * 64] - oA[d][r] * i2; oA[d][r] = v; ss += v * v; }
        ss = swapadd(ss);
        const float rs = __builtin_amdgcn_rsqf(ss * (1.f / 64.f) + 1e-6f) * (1.f - lam_init);
        const LAS float* dn = (const LAS float*)(lds + C::DN);
#pragma unroll
        for (int d = 0; d < 2; ++d)
#pragma unroll
            for (int g = 0; g < 4; ++g) { const int c = 32 * d + 8 * g + 4 * hi; const f32x4 gn = *(const LAS f32x4*)(dn + c);
                v2u v; v.x = cvtpk(oA[d][4 * g] * rs * gn[0], oA[d][4 * g + 1] * rs * gn[1]); v.y = cvtpk(oA[d][4 * g + 2] * rs * gn[2], oA[d][4 * g + 3] * rs * gn[3]); *(GAS v2u*)(orow + c) = v; }
    }
}

template <int KIND> struct AK2 {
    static constexpr bool DIFF = KIND == 1;
    static constexpr int HW = KIND == 0 ? 96 : 64, NKS = KIND == 0 ? 6 : 2, KP = KIND == 0 ? 208 : 144;
    static constexpr int CPK = HW / 8, KCH = (128 * CPK) / 512, VCH = 2;
    static constexpr int KB = 128 * KP, VB = 2 * 8192;
    static constexpr int K0 = 0, V0 = 2 * KB, POS = V0 + 2 * VB, PMX = POS + 1024, BT = PMX + 16, DN = BT + 528, OSV = (DN + 256 + 15) & ~15, END = OSV + (DIFF ? 8 * 8192 : 0);
};
static_assert(AK2<0>::END <= RING_BYTES && AK2<1>::END <= RING_BYTES, "attention LDS (128-key tiles)");
template <int KIND>
__device__ __forceinline__ void attn_unit2(const AttnP& P, int b, int h, int qb, LAS unsigned char* lds, int tid, int wave, int lane) {
    lane = lane_id_v(); tid = (wave << 6) | lane;
    typedef AK2<KIND> C;
    constexpr bool DIFF = C::DIFF;
    constexpr int HW = C::HW, NKS = C::NKS, KP = C::KP, CPK = C::CPK, KCH = C::KCH, VCH = C::VCH;
    const int r32 = lane & 31, hi = lane >> 5;
    const size_t rowb = (size_t)b * S;
    const int q0w = qb * 256 + wave * 32, qi = q0w + r32;
    int pq = 0; float bias_far = 0.f;
    __syncthreads();
    if (DIFF) {
        pq = P.pos[rowb + qi];
        if (tid < 129) ((LAS float*)(lds + C::BT))[tid] = P.btab[h * 129 + tid];
        if (tid >= 192 && tid < 256) ((LAS float*)(lds + C::DN))[tid - 192] = P.dnorm[tid - 192];
    }
    int minq = pq;
    if (DIFF) { for (int o = 1; o < 64; o <<= 1) { const int v = shxi(minq, o, lane); minq = v < minq ? v : minq; } }
    const int NT = 2 * (qb + 1);
    const GAS bf16* Kb = P.K + rowb * P.kp + h * HW; const GAS bf16* Vb = P.V + rowb * P.vp + h * 64;
    const __amdgpu_buffer_rsrc_t rK = __builtin_amdgcn_make_buffer_rsrc((void*)Kb, 0, 0x7fffffff, 0x00020000), rV = __builtin_amdgcn_make_buffer_rsrc((void*)Vb, 0, 0x7fffffff, 0x00020000);
    const __amdgpu_buffer_rsrc_t rP = __builtin_amdgcn_make_buffer_rsrc((void*)(DIFF ? P.pos + rowb : (const GAS int*)Kb), 0, 0x7fffffff, 0x00020000);
    int kvo[KCH], vvo[VCH], klo[KCH], vlo[VCH];
#pragma unroll
    for (int i = 0; i < KCH; ++i) { const int c = tid + 512 * i; kvo[i] = ((c / CPK) * P.kp + (c % CPK) * 8) * 2; klo[i] = (c / CPK) * KP + (c % CPK) * 16; }
#pragma unroll
    for (int i = 0; i < VCH; ++i) { const int c = tid + 512 * i; const int key = c >> 3, part = c & 7; vvo[i] = (key * P.vp + part * 8) * 2; vlo[i] = (part >> 2) * 8192 + (key >> 3) * 512 + (key & 7) * 64 + (part & 3) * 16; }
    const int pvo = (tid & 127) * 4;
    u32x4 kr[KCH], vr[VCH]; int pkr = 0;
    auto gload = [&](int t) {
        const int ks = __builtin_amdgcn_readfirstlane(128 * t * P.kp * 2), vs = __builtin_amdgcn_readfirstlane(128 * t * P.vp * 2);
#pragma unroll
        for (int i = 0; i < KCH; ++i) kr[i] = __builtin_amdgcn_raw_buffer_load_b128(rK, kvo[i], ks, 0);
#pragma unroll
        for (int i = 0; i < VCH; ++i) vr[i] = __builtin_amdgcn_raw_buffer_load_b128(rV, vvo[i], vs, 0);
        if (DIFF) pkr = __builtin_amdgcn_raw_buffer_load_b32(rP, pvo, __builtin_amdgcn_readfirstlane(128 * t * 4), 0);
    };
    auto lstore = [&](int buf) {
        LAS unsigned char* kb_ = lds + C::K0 + buf * C::KB; LAS unsigned char* vb_ = lds + C::V0 + buf * C::VB;
#pragma unroll
        for (int i = 0; i < KCH; ++i) *(LAS u32x4*)(kb_ + klo[i]) = kr[i];
#pragma unroll
        for (int i = 0; i < VCH; ++i) *(LAS u32x4*)(vb_ + vlo[i]) = vr[i];
        if (DIFF) { ((LAS int*)(lds + C::POS + buf * 512))[tid & 127] = pkr;
            if (tid < 128) { int mk_ = pkr; for (int o = 1; o < 64; o <<= 1) { const int v = shxi(mk_, o, lane); mk_ = v > mk_ ? v : mk_; } if (lane == 0) ((LAS int*)(lds + C::PMX))[buf * 2 + wave] = mk_; } }
    };
    LAS float* osv = (LAS float*)(lds + C::OSV) + wave * 2048 + lane;
    float il = 0.f;
    f32x16 oA[2];
#pragma unroll 1
    for (int mp = 0; mp < (DIFF ? 2 : 1); ++mp) {
        bf16x8 qf[NKS];
        { const GAS bf16* qrow = P.Q + (rowb + qi) * P.qp + h * HW + mp * 32;
#pragma unroll
          for (int s = 0; s < NKS; ++s) qf[s] = *(const GAS bf16x8*)(qrow + 16 * s + 8 * hi);
          if (KIND == 0) {
              const GAS float* rp = P.rope + (rowb + qi) * 32 + 8 * hi;
              const f32x4 c0 = *(const GAS f32x4*)rp, c1 = *(const GAS f32x4*)(rp + 4), s0 = *(const GAS f32x4*)(rp + 16), s1 = *(const GAS f32x4*)(rp + 20);
              const u32x4 a = __builtin_bit_cast(u32x4, qf[NKS - 2]), bq = __builtin_bit_cast(u32x4, qf[NKS - 1]); u32x4 ra, rb;
#pragma unroll
              for (int w = 0; w < 4; ++w) { const float cl = w < 2 ? c0[2 * w] : c1[2 * w - 4], ch = w < 2 ? c0[2 * w + 1] : c1[2 * w - 3], sl = w < 2 ? s0[2 * w] : s1[2 * w - 4], sh = w < 2 ? s0[2 * w + 1] : s1[2 * w - 3];
                  const float x1l = bflo(a[w]), x1h = bfhi(a[w]), x2l = bflo(bq[w]), x2h = bfhi(bq[w]);
                  ra[w] = cvtpk(x1l * cl - x2l * sl, x1h * ch - x2h * sh); rb[w] = cvtpk(x1l * sl + x2l * cl, x1h * sh + x2h * ch); }
              qf[NKS - 2] = __builtin_bit_cast(bf16x8, ra); qf[NKS - 1] = __builtin_bit_cast(bf16x8, rb);
          } }
        __syncthreads();
        float m1 = 0.f, l1 = 0.f;
        f32x16 negm;
#pragma unroll
        for (int r = 0; r < 16; ++r) negm[r] = 0.f;
#pragma unroll
        for (int d = 0; d < 2; ++d)
#pragma unroll
            for (int r = 0; r < 16; ++r) oA[d][r] = 0.f;
        gload(0); lstore(0);
        if (NT > 1) gload(1);
        __syncthreads();
        if (DIFF) { bias_far = ((LAS float*)(lds + C::BT))[128];
#pragma unroll
            for (int r = 0; r < 16; ++r) negm[r] = bias_far; }
        const int NTW = (q0w + 31) / 128 + 1;
        auto compute = [&](int t, int buf) {
            const int k0 = 128 * t;
            const LAS unsigned char* kb_ = lds + C::K0 + buf * C::KB + r32 * KP + hi * 16 + mp * 64;
            const LAS unsigned char* vb_ = lds + C::V0 + buf * C::VB + ((lane >> 4) & 1) * 32 + (lane & 3) * 8 + (4 * hi + ((lane & 15) >> 2)) * 64;
            bool nearb = false;
            if (DIFF) { const LAS int* pm = (const LAS int*)(lds + C::PMX) + buf * 2; const int m0 = __builtin_amdgcn_readfirstlane(pm[0]), m1_ = __builtin_amdgcn_readfirstlane(pm[1]); nearb = (minq - (m0 > m1_ ? m0 : m1_)) < 128; }
            f32x16 sc[4];
            if (DIFF) { if (nearb) {
#pragma unroll
                for (int g = 0; g < 4; ++g)
#pragma unroll
                    for (int r = 0; r < 16; ++r) sc[g][r] = -m1; } }
            constexpr int HB = NKS > 3 ? 3 : NKS;
#pragma unroll
            for (int s0_ = 0; s0_ < NKS; s0_ += HB) {
                bf16x8 kf[4][HB];
#pragma unroll
                for (int g = 0; g < 4; ++g)
#pragma unroll
                    for (int s = 0; s < HB; ++s) kf[g][s] = *(const LAS bf16x8*)(kb_ + 32 * g * KP + (s0_ + s) * 32);
                __builtin_amdgcn_sched_barrier(0);
#pragma unroll
                for (int s = 0; s < HB; ++s)
#pragma unroll
                    for (int g = 0; g < 4; ++g) {
                        if (s0_ + s == 0 && !(DIFF && nearb)) sc[g] = __builtin_amdgcn_mfma_f32_32x32x16_bf16(kf[g][s], qf[s0_ + s], negm, 0, 0, 0);
                        else sc[g] = __builtin_amdgcn_mfma_f32_32x32x16_bf16(kf[g][s], qf[s0_ + s], sc[g], 0, 0, 0); }
                __builtin_amdgcn_sched_barrier(0);
            }
            if (DIFF) { if (nearb) {
                const LAS int* pk = (const LAS int*)(lds + C::POS + buf * 512); const LAS float* bt = (const LAS float*)(lds + C::BT);
#pragma unroll
                for (int g = 0; g < 4; ++g)
#pragma unroll
                    for (int r = 0; r < 16; ++r) { int n0 = pq - pk[32 * g + crow(r, hi)]; n0 = n0 < 0 ? 0 : (n0 > 128 ? 128 : n0); sc[g][r] += bt[n0]; }
            } }
            asm volatile("s_nop 15\n\ts_nop 7" : "+v"(sc[0]), "+v"(sc[1]), "+v"(sc[2]), "+v"(sc[3]));
            if (k0 + 127 > q0w) {
#pragma unroll
                for (int g = 0; g < 4; ++g)
#pragma unroll
                    for (int r = 0; r < 16; ++r) { if (k0 + 32 * g + crow(r, hi) > qi) sc[g][r] = -1e30f; }
            }
            const float mx = swapmax(vmax3(max32(sc[0], sc[1]), max32(sc[2], sc[3]), -1e30f));
            const bool up = (t == 0) || mx > 8.0f;
            float al = 1.f;
            if (__builtin_amdgcn_ballot_w64(up) != 0ull) {
                const float dl = up ? mx : 0.f; al = __builtin_amdgcn_exp2f(-dl); l1 *= al; m1 += dl;
#pragma unroll
                for (int r = 0; r < 16; ++r) negm[r] -= dl;
#pragma unroll
                for (int g = 0; g < 4; ++g)
#pragma unroll
                    for (int r = 0; r < 16; ++r) sc[g][r] -= dl;
            }
            float ls = 0.f;
#pragma unroll
            for (int g = 0; g < 4; ++g)
#pragma unroll
                for (int r = 0; r < 16; ++r) { sc[g][r] = __builtin_amdgcn_exp2f(sc[g][r]); ls += sc[g][r]; }
            l1 += ls;
            bf16x8 pf[8];
#pragma unroll
            for (int g = 0; g < 4; ++g) { pf[2 * g] = pack8(sc[g], 0); pf[2 * g + 1] = pack8(sc[g], 8); }
            if (__builtin_amdgcn_ballot_w64(al != 1.0f) != 0ull) {
#pragma unroll
                for (int d = 0; d < 2; ++d)
#pragma unroll
                    for (int r = 0; r < 16; ++r) oA[d][r] *= al;
            }
#pragma unroll
            for (int d = 0; d < 2; ++d) {
                bf16x8 vf[8];
#pragma unroll
                for (int s = 0; s < 8; ++s) { const s16x4 lo = vtr(vb_ + d * 8192 + s * 1024), hh = vtr(vb_ + d * 8192 + s * 1024 + 512); vf[s] = (bf16x8){lo[0], lo[1], lo[2], lo[3], hh[0], hh[1], hh[2], hh[3]}; }
                __builtin_amdgcn_sched_barrier(0);
#pragma unroll
                for (int s = 0; s < 8; ++s) oA[d] = __builtin_amdgcn_mfma_f32_32x32x16_bf16(vf[s], pf[s], oA[d], 0, 0, 0);
                __builtin_amdgcn_sched_barrier(0);
            }
        };
        int t = 0;
        for (; t + 2 < NT; ++t) {
            const int buf = t & 1;
            lstore(buf ^ 1); gload(t + 2);
            if (t < NTW) compute(t, buf);
            TILE_BAR();
        }
        for (; t < NT; ++t) {
            const int buf = t & 1;
            if (t + 1 < NT) lstore(buf ^ 1);
            if (t < NTW) compute(t, buf);
            TILE_BAR();
        }
        il = 1.f / swapadd(l1);
        if (DIFF) { if (mp == 0) {
#pragma unroll
            for (int d = 0; d < 2; ++d)
#pragma unroll
                for (int r = 0; r < 16; ++r) osv[(d * 16 + r) * 64] = oA[d][r] * il; } }
    }
    GAS bf16* orow = P.O + (rowb + qi) * P.op + h * 64;
    if (!DIFF) {
#pragma unroll
        for (int d = 0; d < 2; ++d)
#pragma unroll
            for (int g = 0; g < 4; ++g) { v2u v; v.x = cvtpk(oA[d][4 * g] * il, oA[d][4 * g + 1] * il); v.y = cvtpk(oA[d][4 * g + 2] * il, oA[d][4 * g + 3] * il); *(GAS v2u*)(orow + 32 * d + 8 * g + 4 * hi) = v; }
    } else {
        const float lam = P.lams[0], lam_init = P.lams[1];
        const float i2 = lam * il;
        float ss = 0.f;
#pragma unroll
        for (int d = 0; d < 2; ++d)
#pragma unroll
            for (int r = 0; r < 16; ++r) { const float v = osv[(d * 16 + r) * 64] - oA[d][r] * i2; oA[d][r] = v; ss += v * v; }
        ss = swapadd(ss);
        const float rs = __builtin_amdgcn_rsqf(ss * (1.f / 64.f) + 1e-6f) * (1.f - lam_init);
        const LAS float* dn = (const LAS float*)(lds + C::DN);
#pragma unroll
        for (int d = 0; d < 2; ++d)
#pragma unroll
            for (int g = 0; g < 4; ++g) { const int c = 32 * d + 8 * g + 4 * hi; const f32x4 gn = *(const LAS f32x4*)(dn + c);
                v2u v; v.x = cvtpk(oA[d][4 * g] * rs * gn[0], oA[d][4 * g + 1] * rs * gn[1]); v.y = cvtpk(oA[d][4 * g + 2] * rs * gn[2], oA[d][4 * g + 3] * rs * gn[3]); *(GAS v2u*)(orow + c) = v; }
    }
}

__device__ __forceinline__ void attn_phase(const AttnP& PM, const AttnP& PD, LAS unsigned char* lds, int tid, int wave, int lane, int vcu, int G, int only = -1) {
    for (int i = vcu; i < 512; i += G) {
        if (only >= 0 && (i >> 8) != only) continue;
        const int kind = i >> 8, c = i & 255, bh = c >> 4, s = c & 15;
        if (kind == 0) {
#pragma unroll 1
            for (int k = 0; k < 2; ++k) attn_unit2<0>(PM, bh >> 2, bh & 3, k ? 31 - s : s, lds, tid, wave, lane);
        } else {
#pragma unroll 1
            for (int k = 0; k < 2; ++k) attn_unit2<1>(PD, bh >> 2, bh & 3, k ? 31 - s : s, lds, tid, wave, lane);
        }
    }
}
__device__ __forceinline__ void cross_phase(const AttnP& PC, LAS unsigned char* lds, int tid, int wave, int lane, int vcu, int G) {
#pragma unroll 1
    for (int i = vcu; i < 1024; i += G) { const int bh = i >> 6; attn_unit<2, true>(PC, bh >> 2, bh & 3, i & 31, (i >> 5) & 1, lds, tid, wave, lane); }
}


__device__ __forceinline__ float vmax2(float a, float b) { float r; asm("v_max_f32_e32 %0, %1, %2" : "=v"(r) : "v"(a), "v"(b)); return r; }
__device__ __forceinline__ float vmin2(float a, float b) { float r; asm("v_min_f32_e32 %0, %1, %2" : "=v"(r) : "v"(a), "v"(b)); return r; }
__device__ __forceinline__ void pad16(float (&a)[16]) {
    asm volatile("s_nop 1" : "+v"(a[0]), "+v"(a[1]), "+v"(a[2]), "+v"(a[3]), "+v"(a[4]), "+v"(a[5]), "+v"(a[6]), "+v"(a[7]), "+v"(a[8]), "+v"(a[9]), "+v"(a[10]), "+v"(a[11]), "+v"(a[12]), "+v"(a[13]), "+v"(a[14]), "+v"(a[15]));
}
__device__ __forceinline__ void sort16_desc(float (&a)[16]) {
#pragma unroll
    for (int k = 2; k <= 16; k <<= 1)
#pragma unroll
        for (int j = k >> 1; j > 0; j >>= 1)
#pragma unroll
            for (int i = 0; i < 16; ++i) { const int l = i ^ j; if (l > i) { const bool desc = ((i & k) == 0); const float hi_ = vmax2(a[i], a[l]), lo_ = vmin2(a[i], a[l]); a[i] = desc ? hi_ : lo_; a[l] = desc ? lo_ : hi_; } }
}
__device__ __forceinline__ void merge16_desc(float (&a)[16], const float (&b)[16]) {
#pragma unroll
    for (int i = 0; i < 16; ++i) a[i] = vmax2(a[i], b[15 - i]);
#pragma unroll
    for (int j = 8; j > 0; j >>= 1)
#pragma unroll
        for (int i = 0; i < 16; ++i) { const int l = i ^ j; if (l > i) { const float hi_ = vmax2(a[i], a[l]), lo_ = vmin2(a[i], a[l]); a[i] = hi_; a[l] = lo_; } }
}
__device__ __forceinline__ void top16_of_64(float (&g0)[16], float (&g1)[16], float (&g2)[16], float (&g3)[16]) {
    sort16_desc(g0); sort16_desc(g1); merge16_desc(g0, g1); sort16_desc(g2); sort16_desc(g3); merge16_desc(g2, g3); merge16_desc(g0, g2);
}
__device__ __forceinline__ float embed(float v, unsigned mask, unsigned id) { return __builtin_bit_cast(float, (__builtin_bit_cast(unsigned, v) & mask) | id); }
__device__ __forceinline__ float mkcand(float x, float y, unsigned id) { return embed(x + y, 0xFFFFFF00u, id); }

__device__ __forceinline__ void swap32(float& a, float& b) { asm volatile("v_nop\n\tv_nop\n\tv_permlane32_swap_b32 %0, %1" : "+v"(a), "+v"(b)); }
struct RouteP { const GAS bf16* QP; const GAS bf16* keys; GAS int* EX; GAS float* GW; };
constexpr int RT_KP = 144, RT_KEYS = 0, RT_SCR = 256 * RT_KP, RT_END = RT_SCR + 8 * 8192;
__device__ __forceinline__ void route_phase(const RouteP& P, LAS unsigned char* lds, int tid, int wave, int lane, int vcu, int G) {
    asm volatile("" : "+v"(tid), "+v"(lane));
    __syncthreads();
    for (int c = tid; c < 256 * 8; c += 512) { const int row = c >> 3, part = c & 7; *(LAS u32x4*)(lds + RT_KEYS + row * RT_KP + part * 16) = *(const u32x4*)(P.keys + row * 64 + part * 8); }
    __syncthreads();
    const int r32 = lane & 31, hi = lane >> 5;
    LAS int* scr = (LAS int*)(lds + RT_SCR + wave * 8192);
    for (int u = vcu; u < T / 32; u += G) {
        const size_t t = (size_t)u * 32 + r32; const int h = wave;
        float T2[2][16];
#pragma unroll
        for (int c = 0; c < 2; ++c) {
            bf16x8 qf[4];
            { const GAS bf16* q = P.QP + t * 1024 + h * 128 + c * 64 + 8 * hi;
#pragma unroll
              for (int s = 0; s < 4; ++s) qf[s] = *(const GAS bf16x8*)(q + 16 * s); }
            f32x16 sc[4];
#pragma unroll
            for (int m = 0; m < 4; ++m) {
#pragma unroll
                for (int r = 0; r < 16; ++r) sc[m][r] = 0.f;
#pragma unroll
                for (int s = 0; s < 4; ++s) { const bf16x8 a = *(const LAS bf16x8*)(lds + RT_KEYS + (c * 128 + 32 * m + r32) * RT_KP + s * 32 + hi * 16);
                    sc[m] = __builtin_amdgcn_mfma_f32_32x32x16_bf16(a, qf[s], sc[m], 0, 0, 0); }
            }
            float g0[16], g1[16], g2[16], g3[16];
            const unsigned h4 = 4u * (unsigned)hi;
#pragma unroll
            for (int r = 0; r < 16; ++r) { const unsigned kr_ = (unsigned)((r & 3) + 8 * (r >> 2));
                g0[r] = embed(sc[0][r], 0xFFFFFF80u, kr_ | h4); g1[r] = embed(sc[1][r], 0xFFFFFF80u, (32u + kr_) | h4); g2[r] = embed(sc[2][r], 0xFFFFFF80u, (64u + kr_) | h4); g3[r] = embed(sc[3][r], 0xFFFFFF80u, (96u + kr_) | h4); }
            top16_of_64(g0, g1, g2, g3);
            pad16(g0);
#pragma unroll
            for (int i = 0; i < 16; ++i) T2[c][i] = g0[i];
        }
        float A[16], Bv[16];
#pragma unroll
        for (int i = 0; i < 16; ++i) { A[i] = T2[0][i]; Bv[i] = T2[1][i]; swap32(A[i], Bv[i]); }
        merge16_desc(A, Bv);
        pad16(A);
        float T0[16], T1[16];
#pragma unroll
        for (int i = 0; i < 16; ++i) { T0[i] = A[i]; T1[i] = A[i]; swap32(T0[i], T1[i]); }
#pragma unroll
        for (int i = 0; i < 16; ++i) { scr[i * 64 + lane] = (int)(__builtin_bit_cast(unsigned, T0[i]) & 127u); scr[(16 + i) * 64 + lane] = (int)(__builtin_bit_cast(unsigned, T1[i]) & 127u);
            T0[i] = embed(T0[i], 0xFFFFFF80u, 0u); T1[i] = embed(T1[i], 0xFFFFFF80u, 0u); }
        float c0[16], c1[16], c2[16], c3[16];
        const float NINF = -__builtin_inff();
#pragma unroll
        for (int b = 0; b < 16; ++b) c0[b] = mkcand(T0[0], T1[b], (unsigned)b);
#pragma unroll
        for (int b = 0; b < 8; ++b) c1[b] = mkcand(T0[1], T1[b], 16u + b);
#pragma unroll
        for (int b = 0; b < 5; ++b) c1[8 + b] = mkcand(T0[2], T1[b], 32u + b);
#pragma unroll
        for (int b = 0; b < 3; ++b) c1[13 + b] = mkcand(T0[4], T1[b], 64u + b);
#pragma unroll
        for (int b = 0; b < 4; ++b) c2[b] = mkcand(T0[3], T1[b], 48u + b);
        c2[4] = mkcand(T0[5], T1[0], 80u); c2[5] = mkcand(T0[5], T1[1], 81u); c2[6] = mkcand(T0[6], T1[0], 96u); c2[7] = mkcand(T0[6], T1[1], 97u); c2[8] = mkcand(T0[7], T1[0], 112u); c2[9] = mkcand(T0[7], T1[1], 113u);
#pragma unroll
        for (int a = 8; a < 14; ++a) c2[10 + a - 8] = mkcand(T0[a], T1[0], 16u * a);
        c3[0] = mkcand(T0[14], T1[0], 224u); c3[1] = mkcand(T0[15], T1[0], 240u);
#pragma unroll
        for (int i = 2; i < 16; ++i) c3[i] = NINF;
        top16_of_64(c0, c1, c2, c3);
        pad16(c0);
        float gsum = 0.f, ge[16]; int ex[16];
        const float mtop = embed(c0[0], 0xFFFFFF00u, 0u);
#pragma unroll
        for (int i = 0; i < 16; ++i) { const unsigned bits = __builtin_bit_cast(unsigned, c0[i]); const int a = (bits >> 4) & 15, b = bits & 15;
            ge[i] = __builtin_amdgcn_exp2f((embed(c0[i], 0xFFFFFF00u, 0u) - mtop) * LOG2E); gsum += ge[i];
            ex[i] = scr[a * 64 + lane] * 128 + scr[(16 + b) * 64 + lane]; }
        const float ginv = __builtin_amdgcn_rcpf(gsum);
        if (hi == 0) { GAS v4u* d = (GAS v4u*)(P.EX + t * 128 + h * 16);
#pragma unroll
            for (int i = 0; i < 4; ++i) d[i] = (v4u){(unsigned)ex[4 * i], (unsigned)ex[4 * i + 1], (unsigned)ex[4 * i + 2], (unsigned)ex[4 * i + 3]}; }
        else { GAS f32x4* d = (GAS f32x4*)(P.GW + t * 128 + h * 16);
#pragma unroll
            for (int i = 0; i < 4; ++i) d[i] = (f32x4){ge[4 * i] * ginv, ge[4 * i + 1] * ginv, ge[4 * i + 2] * ginv, ge[4 * i + 3] * ginv}; }
    }
}

__device__ __forceinline__ int wave_allsum_i(int v) {
    v += __builtin_amdgcn_update_dpp(0, v, 0xB1, 0xF, 0xF, true);
    v += __builtin_amdgcn_update_dpp(0, v, 0x4E, 0xF, 0xF, true);
    v += __builtin_amdgcn_update_dpp(0, v, 0x141, 0xF, 0xF, true);
    v += __builtin_amdgcn_update_dpp(0, v, 0x140, 0xF, 0xF, true);
    { int a = v, b = v; asm volatile("v_nop\n\tv_nop\n\tv_permlane16_swap_b32 %0, %1" : "+v"(a), "+v"(b)); v = a + b; }
    { int a = v, b = v; asm volatile("v_nop\n\tv_nop\n\tv_permlane32_swap_b32 %0, %1" : "+v"(a), "+v"(b)); v = a + b; }
    return v;
}
__device__ __forceinline__ float wave_allsum(float v) {
    v += __builtin_bit_cast(float, __builtin_amdgcn_update_dpp(0, __builtin_bit_cast(int, v), 0xB1, 0xF, 0xF, true));
    v += __builtin_bit_cast(float, __builtin_amdgcn_update_dpp(0, __builtin_bit_cast(int, v), 0x4E, 0xF, 0xF, true));
    v += __builtin_bit_cast(float, __builtin_amdgcn_update_dpp(0, __builtin_bit_cast(int, v), 0x141, 0xF, 0xF, true));
    v += __builtin_bit_cast(float, __builtin_amdgcn_update_dpp(0, __builtin_bit_cast(int, v), 0x140, 0xF, 0xF, true));
    { float a = v, b = v; asm volatile("v_nop\n\tv_nop\n\tv_permlane16_swap_b32 %0, %1" : "+v"(a), "+v"(b)); v = a + b; }
    { float a = v, b = v; asm volatile("v_nop\n\tv_nop\n\tv_permlane32_swap_b32 %0, %1" : "+v"(a), "+v"(b)); v = a + b; }
    return v;
}
__device__ __forceinline__ float wave_allmax(float v) {
    v = fmaxf(v, __builtin_bit_cast(float, __builtin_amdgcn_update_dpp(0, __builtin_bit_cast(int, v), 0xB1, 0xF, 0xF, true)));
    v = fmaxf(v, __builtin_bit_cast(float, __builtin_amdgcn_update_dpp(0, __builtin_bit_cast(int, v), 0x4E, 0xF, 0xF, true)));
    v = fmaxf(v, __builtin_bit_cast(float, __builtin_amdgcn_update_dpp(0, __builtin_bit_cast(int, v), 0x141, 0xF, 0xF, true)));
    v = fmaxf(v, __builtin_bit_cast(float, __builtin_amdgcn_update_dpp(0, __builtin_bit_cast(int, v), 0x140, 0xF, 0xF, true)));
    { float a = v, b = v; asm volatile("v_nop\n\tv_nop\n\tv_permlane16_swap_b32 %0, %1" : "+v"(a), "+v"(b)); v = fmaxf(a, b); }
    { float a = v, b = v; asm volatile("v_nop\n\tv_nop\n\tv_permlane32_swap_b32 %0, %1" : "+v"(a), "+v"(b)); v = fmaxf(a, b); }
    return v;
}
__device__ __forceinline__ unsigned q4(float a, float b, float c, float d, int off) {
    const int ia = (int)__builtin_rintf(a) + off, ib = (int)__builtin_rintf(b) + off, ic = (int)__builtin_rintf(c) + off, id = (int)__builtin_rintf(d) + off;
    return (unsigned)(ia & 255) | ((unsigned)(ib & 255) << 8) | ((unsigned)(ic & 255) << 16) | ((unsigned)(id & 255) << 24);
}
__device__ __forceinline__ void quant_row(const GAS float* src, GAS unsigned* dst, GAS float* scale, int off, int lane) {
    const GAS f32x4* s = (const GAS f32x4*)src + 4 * lane; f32x4 v[4]; float m = 0.f;
#pragma unroll
    for (int i = 0; i < 4; ++i) { v[i] = s[i]; m = fmaxf(m, fmaxf(fmaxf(__builtin_fabsf(v[i].x), __builtin_fabsf(v[i].y)), fmaxf(__builtin_fabsf(v[i].z), __builtin_fabsf(v[i].w)))); }
    m = wave_allmax(m); const float inv = m > 0.f ? 127.f / m : 0.f;
    v4u w;
    w.x = q4(v[0].x * inv, v[0].y * inv, v[0].z * inv, v[0].w * inv, off); w.y = q4(v[1].x * inv, v[1].y * inv, v[1].z * inv, v[1].w * inv, off);
    w.z = q4(v[2].x * inv, v[2].y * inv, v[2].z * inv, v[2].w * inv, off); w.w = q4(v[3].x * inv, v[3].y * inv, v[3].z * inv, v[3].w * inv, off);
    *((GAS v4u*)dst + lane) = w;
    if (lane == 0) *scale = m * (1.f / 127.f);
}
struct PeerS { int nslices_step, first_slice, nloc, rank; };
__device__ __forceinline__ PeerS peer_sched(const GAS unsigned* rankw, int xcc, int rank) {
    int nx = 0, myidx = 0, nloc = 1;
    for (int j = 0; j < 16; ++j) { const int c = (int)__hip_atomic_load(rankw + 64 * j, __ATOMIC_RELAXED, __HIP_MEMORY_SCOPE_AGENT); if (c > 0) { if (j == xcc) { myidx = nx; nloc = c; } ++nx; } }
    PeerS s; s.nslices_step = nx > 0 ? nx : 1; s.first_slice = myidx; s.nloc = nloc; s.rank = rank; return s;
}
struct Peer1P { const GAS unsigned GAS char* HQ; const GAS int* EX; const GAS unsigned GAS char* U8; GAS int* P; };
__device__ __forceinline__ void peer_k1(const Peer1P& Q, const PeerS& sc, int wave, int lane) {
    asm volatile("" : "+v"(lane));
    const int g = lane >> 3, j = lane & 7;
    for (int s = sc.first_slice; s < 8; s += sc.nslices_step)
        for (int tile = sc.rank; tile < T / 64; tile += sc.nloc) {
            const size_t t0 = (size_t)tile * 64 + wave * 8;
            v4u hqn = *(const GAS v4u*)(Q.HQ + t0 * 1024 + 128 * s + 16 * j), exn[4];
#pragma unroll
            for (int i = 0; i < 4; ++i) exn[i] = *(const GAS v4u*)(Q.EX + t0 * 128 + 16 * g + 4 * i);
#pragma unroll 1
            for (int k = 0; k < 8; ++k) {
                const size_t t = t0 + k;
                const v4u hq = hqn; v4u ex[4];
#pragma unroll
                for (int i = 0; i < 4; ++i) ex[i] = exn[i];
                if (k + 1 < 8) {
                    hqn = *(const GAS v4u*)(Q.HQ + (t + 1) * 1024 + 128 * s + 16 * j);
#pragma unroll
                    for (int i = 0; i < 4; ++i) exn[i] = *(const GAS v4u*)(Q.EX + (t + 1) * 128 + 16 * g + 4 * i);
                }
                v4u uu[16];
#pragma unroll
                for (int i = 0; i < 16; ++i) { const unsigned e = (i & 3) == 0 ? ex[i >> 2].x : (i & 3) == 1 ? ex[i >> 2].y : (i & 3) == 2 ? ex[i >> 2].z : ex[i >> 2].w;
                    uu[i] = *(const GAS v4u*)(Q.U8 + (size_t)e * 1024 + 128 * s + 16 * j); }
                int lo = 0, hi = 0;
#pragma unroll
                for (int i = 0; i < 16; ++i) {
                    int p = __builtin_amdgcn_sdot4((int)uu[i].x, (int)hq.x, 0, false); p = __builtin_amdgcn_sdot4((int)uu[i].y, (int)hq.y, p, false); p = __builtin_amdgcn_sdot4((int)uu[i].z, (int)hq.z, p, false); p = __builtin_amdgcn_sdot4((int)uu[i].w, (int)hq.w, p, false);
                    p += __builtin_amdgcn_update_dpp(0, p, 0xB1, 0xF, 0xF, true); p += __builtin_amdgcn_update_dpp(0, p, 0x4E, 0xF, 0xF, true); p += __builtin_amdgcn_update_dpp(0, p, 0x141, 0xF, 0xF, true);
                    if (i < 8) lo = (j == i) ? p : lo; else hi = (j == i - 8) ? p : hi;
                }
                GAS int* prow = Q.P + t * 128 + 16 * g + j;
                (void)__hip_atomic_fetch_add(prow, lo, __ATOMIC_RELAXED, __HIP_MEMORY_SCOPE_AGENT); (void)__hip_atomic_fetch_add(prow + 8, hi, __ATOMIC_RELAXED, __HIP_MEMORY_SCOPE_AGENT);
            }
        }
}
__device__ __forceinline__ void peer_w(const GAS int* EX, const GAS float* GW, const GAS int* P, const GAS float* SH, const GAS float* SU, const GAS float* SV, GAS signed char* WQ, GAS float* WSC, int gw, int NGW, int lane) {
    asm volatile("" : "+v"(lane));
    for (int t = gw; t < T; t += NGW) {
        const float sh = SH[t];
#pragma unroll
        for (int q = 0; q < 2; ++q) { const size_t idx = (size_t)t * 128 + lane + 64 * q; const int e = EX[idx];
            const float w = GW[idx] * gelu_erf((float)P[idx] * (sh * SU[e])) * SV[e];
            float m = __builtin_fabsf(w);
            m = fmaxf(m, __builtin_bit_cast(float, __builtin_amdgcn_update_dpp(0, __builtin_bit_cast(int, m), 0xB1, 0xF, 0xF, true)));
            m = fmaxf(m, __builtin_bit_cast(float, __builtin_amdgcn_update_dpp(0, __builtin_bit_cast(int, m), 0x4E, 0xF, 0xF, true)));
            m = fmaxf(m, __builtin_bit_cast(float, __builtin_amdgcn_update_dpp(0, __builtin_bit_cast(int, m), 0x141, 0xF, 0xF, true)));
            m = fmaxf(m, __builtin_bit_cast(float, __builtin_amdgcn_update_dpp(0, __builtin_bit_cast(int, m), 0x140, 0xF, 0xF, true)));
            const float inv = m > 0.f ? 127.f / m : 0.f;
            WQ[idx] = (signed char)(int)__builtin_rintf(w * inv);
            if ((lane & 15) == 0) WSC[(size_t)t * 8 + (lane >> 4) + 4 * q] = m * (1.f / 127.f); }
    }
}
__device__ __forceinline__ void tr4x4(unsigned r0, unsigned r1, unsigned r2, unsigned r3, unsigned (&t)[4]) {
    const unsigned x0 = __builtin_amdgcn_perm(r1, r0, 0x05010400u), x1 = __builtin_amdgcn_perm(r1, r0, 0x07030602u), y0 = __builtin_amdgcn_perm(r3, r2, 0x05010400u), y1 = __builtin_amdgcn_perm(r3, r2, 0x07030602u);
    t[0] = __builtin_amdgcn_perm(y0, x0, 0x05040100u); t[1] = __builtin_amdgcn_perm(y0, x0, 0x07060302u); t[2] = __builtin_amdgcn_perm(y1, x1, 0x05040100u); t[3] = __builtin_amdgcn_perm(y1, x1, 0x07060302u);
}
struct Peer2P { const GAS int* EX; const GAS signed char* WQ; const GAS float* WSC; const GAS unsigned char* V8; GAS float* X; GAS bf16* XB; GAS float* SSQ; };
__device__ __forceinline__ void peer_k2(const Peer2P& Q, const PeerS& sc, int wave, int lane) {
    asm volatile("" : "+v"(lane));
    const int g = lane >> 3, j = lane & 7, hf = lane >> 5, rp = (lane >> 4) & 1;
    for (int s = sc.first_slice; s < 8; s += sc.nslices_step)
        for (int tile = sc.rank; tile < T / 64; tile += sc.nloc) {
            const size_t t0 = (size_t)tile * 64 + wave * 8;
            v4u exn[4], wqn; float swn;
#pragma unroll
            for (int i = 0; i < 4; ++i) exn[i] = *(const GAS v4u*)(Q.EX + t0 * 128 + 16 * g + 4 * i);
            wqn = *(const GAS v4u*)(Q.WQ + t0 * 128 + 16 * g); swn = Q.WSC[t0 * 8 + g];
#pragma unroll 1
            for (int k = 0; k < 8; ++k) {
                const size_t t = t0 + k;
                v4u ex[4]; const v4u wq = wqn; const float sw = swn;
#pragma unroll
                for (int i = 0; i < 4; ++i) ex[i] = exn[i];
                if (k + 1 < 8) {
#pragma unroll
                    for (int i = 0; i < 4; ++i) exn[i] = *(const GAS v4u*)(Q.EX + (t + 1) * 128 + 16 * g + 4 * i);
                    wqn = *(const GAS v4u*)(Q.WQ + (t + 1) * 128 + 16 * g); swn = Q.WSC[(t + 1) * 8 + g];
                }
                GAS f32x4* xp = (GAS f32x4*)(Q.X + t * 1024 + 128 * s + 16 * j + 8 * hf + 4 * rp);
                const f32x4 xold = *xp;
                v4u vv[16];
#pragma unroll
                for (int i = 0; i < 16; ++i) { const unsigned e = (i & 3) == 0 ? ex[i >> 2].x : (i & 3) == 1 ? ex[i >> 2].y : (i & 3) == 2 ? ex[i >> 2].z : ex[i >> 2].w;
                    vv[i] = *(const GAS v4u*)(Q.V8 + (size_t)e * 1024 + 128 * s + 16 * j); }
                int ai[16];
#pragma unroll
                for (int i = 0; i < 16; ++i) ai[i] = 0;
#pragma unroll
                for (int q4_ = 0; q4_ < 4; ++q4_) {
                    const unsigned wq4 = q4_ == 0 ? wq.x : q4_ == 1 ? wq.y : q4_ == 2 ? wq.z : wq.w;
#pragma unroll
                    for (int c = 0; c < 4; ++c) { unsigned tt[4];
                        const v4u &a0 = vv[4 * q4_], &a1 = vv[4 * q4_ + 1], &a2 = vv[4 * q4_ + 2], &a3 = vv[4 * q4_ + 3];
                        tr4x4(c == 0 ? a0.x : c == 1 ? a0.y : c == 2 ? a0.z : a0.w, c == 0 ? a1.x : c == 1 ? a1.y : c == 2 ? a1.z : a1.w, c == 0 ? a2.x : c == 1 ? a2.y : c == 2 ? a2.z : a2.w, c == 0 ? a3.x : c == 1 ? a3.y : c == 2 ? a3.z : a3.w, tt);
#pragma unroll
                        for (int b = 0; b < 4; ++b) ai[4 * c + b] = __builtin_amdgcn_sdot4((int)tt[b], (int)wq4, ai[4 * c + b], false); }
                }
                float acc[16];
#pragma unroll
                for (int i = 0; i < 16; ++i) acc[i] = (float)ai[i] * sw;
                float r8[8], r4[4];
#pragma unroll
                for (int m = 0; m < 8; ++m) { float a = acc[m], b = acc[m + 8]; swap32(a, b); r8[m] = a + b; }
#pragma unroll
                for (int n = 0; n < 4; ++n) { float a = r8[n], b = r8[n + 4]; asm volatile("v_nop\n\tv_nop\n\tv_permlane16_swap_b32 %0, %1" : "+v"(a), "+v"(b)); r4[n] = a + b; }
#pragma unroll
                for (int n = 0; n < 4; ++n) r4[n] += __builtin_bit_cast(float, __builtin_amdgcn_update_dpp(0, __builtin_bit_cast(int, r4[n]), 0x128, 0xF, 0xF, true));
                const f32x4 xn = xold + (f32x4){r4[0], r4[1], r4[2], r4[3]};
                float ss = (lane & 8) == 0 ? (xn[0] * xn[0] + xn[1] * xn[1]) + (xn[2] * xn[2] + xn[3] * xn[3]) : 0.f;
                ss = wave_allsum(ss);
                if ((lane & 8) == 0) { *xp = xn; if (Q.XB) { v2u w; w.x = pk2(xn[0], xn[1]); w.y = pk2(xn[2], xn[3]); *(GAS v2u*)(Q.XB + t * 1024 + 128 * s + 16 * j + 8 * hf + 4 * rp) = w; } }
                if (Q.SSQ) { if (lane == 0) Q.SSQ[t * 16 + s] = ss; }
            }
        }
}

struct Args { const float* in[33]; float* out; unsigned char* ws; int ph_lo, ph_hi; };
struct Frame { LAS unsigned char* lds; volatile LAS unsigned* MISC; gu32* ctl; int tid, lane, wave, G, vcu, xcc, xrank; };

__device__ __forceinline__ void transpose_item(const float* W, int ldw, int nsrc0, bf16* WT, int ldt, int rdst0, LAS float* scr, int kb, int nb, int lane, float scale, const float* kgain) {
    const int k0 = 64 * kb, n0 = 32 * nb;
#pragma unroll 8
    for (int i = 0; i < 32; ++i) { const int kk = 2 * i + (lane >> 5); const float gsc = kgain ? kgain[k0 + kk] * scale : scale; scr[kk * 33 + (lane & 31)] = W[(size_t)(k0 + kk) * ldw + nsrc0 + n0 + (lane & 31)] * gsc; }
    LDS_WAIT(); asm volatile("" ::: "memory");
    const int c = lane & 7;
#pragma unroll
    for (int j = 0; j < 4; ++j) { const int n = (lane >> 3) + 8 * j; const LAS float* s = scr + (8 * c) * 33 + n;
        v4u o; o.x = pk2(s[0 * 33], s[1 * 33]); o.y = pk2(s[2 * 33], s[3 * 33]); o.z = pk2(s[4 * 33], s[5 * 33]); o.w = pk2(s[6 * 33], s[7 * 33]);
        *(GAS v4u*)(WT + (size_t)(rdst0 + n0 + n) * ldt + k0 + 8 * c) = o; }
    LDS_WAIT(); asm volatile("" ::: "memory");
}
__device__ __forceinline__ void zero_rect(bf16* base, int ld, int row0, int nrows, int col0, int ncols, int gtid, int gthreads) {
    const int vpr = ncols / 8;
    for (int i = gtid; i < nrows * vpr; i += gthreads) { const int r = i / vpr, c = i % vpr; *(GAS v4u*)(base + (size_t)(row0 + r) * ld + col0 + 8 * c) = (v4u){0u, 0u, 0u, 0u}; }
}

__device__ __forceinline__ void p0_prologue(Frame& F, const Args& a) {
    LAS float* scr = (LAS float*)(F.lds + RING_OFF + F.wave * 16384);
    const int gw = blockIdx.x * NWAVES + F.wave, NGW = F.G * NWAVES;
    const int gtid = blockIdx.x * (NWAVES * 64) + F.tid, gthreads = F.G * NWAVES * 64;
    unsigned char* ws = a.ws;
    x0_phase((const GAS float*)a.in[0], (GAS bf16*)(ws + WS_XNB), (GAS float*)(ws + WS_SSQ), gw, NGW, F.lane);
    constexpr int I_IN = 16 * (INW / 32), I_SQ = 16 * 32, I_CKV = 16 * 64, I_UQ = 3 * 12, I_UKV = 2 * 16, I_L = I_IN + 4 * I_SQ + I_CKV + I_UQ + I_UKV;
    for (int it = gw; it < L * I_L; it += NGW) {
        const int l = it / I_L; int r = it % I_L;
        if (r < I_IN) {
            const int kb = r / 67, nb = r % 67; int src, dst; float sc = 1.f;
            if (nb < 6) { src = 32 * nb; dst = src; } else if (nb < 11) { src = 32 * nb; dst = src + 64; } else { src = 32 * nb; dst = src + 160; if (nb >= 43 && nb < 51) sc = 0.17677669529663687f * LOG2E; }
            transpose_item(a.in[5] + (size_t)l * D * INW, INW, src, (bf16*)(ws + WS_WIN) + (size_t)l * INP * D, D, dst, scr, kb, 0, F.lane, sc, a.in[4] + l * D); continue; } r -= I_IN;
        if (r < I_SQ) { transpose_item(a.in[21] + (size_t)l * D * D, D, 0, (bf16*)(ws + WS_WOUT) + (size_t)l * D * D, D, 0, scr, r / 32, r % 32, F.lane, 1.f, nullptr); continue; } r -= I_SQ;
        if (r < I_SQ) { transpose_item(a.in[24] + (size_t)l * D * D, D, 0, (bf16*)(ws + WS_WCQ) + (size_t)l * D * D, D, 0, scr, r / 32, r % 32, F.lane, 0.0625f * LOG2E, a.in[22] + l * D); continue; } r -= I_SQ;
        if (r < I_SQ) { transpose_item(a.in[26] + (size_t)l * D * D, D, 0, (bf16*)(ws + WS_WCO) + (size_t)l * D * D, D, 0, scr, r / 32, r % 32, F.lane, 1.f, nullptr); continue; } r -= I_SQ;
        if (r < I_SQ) { transpose_item(a.in[28] + (size_t)l * D * D, D, 0, (bf16*)(ws + WS_WPQ) + (size_t)l * D * D, D, 0, scr, r / 32, r % 32, F.lane, 1.f, a.in[27] + l * D); continue; } r -= I_SQ;
        if (r < I_CKV) { transpose_item(a.in[25] + (size_t)l * D * 2 * D, 2 * D, 0, (bf16*)(ws + WS_WCKV) + (size_t)l * 2 * D * D, D, 0, scr, r / 64, r % 64, F.lane, 1.f, nullptr); continue; } r -= I_CKV;
        if (r < I_UQ) { transpose_item(a.in[7] + (size_t)l * 192 * 384, 384, 0, (bf16*)(ws + WS_WUQ) + (size_t)l * 512 * 256, 256, 0, scr, r / 12, r % 12, F.lane, 0.10206207261596575f * LOG2E, a.in[6] + l * 192); continue; } r -= I_UQ;
        transpose_item(a.in[9] + (size_t)l * 128 * 512, 512, 0, (bf16*)(ws + WS_WUKV) + (size_t)l * 512 * 256, 256, 0, scr, r / 16, r % 16, F.lane, 1.f, a.in[8] + l * 128);
    }
    for (int l = 0; l < L; ++l) {
        bf16* win = (bf16*)(ws + WS_WIN) + (size_t)l * INP * D; bf16* wuq = (bf16*)(ws + WS_WUQ) + (size_t)l * 512 * 256; bf16* wukv = (bf16*)(ws + WS_WUKV) + (size_t)l * 512 * 256;
        zero_rect(win, D, 192, 64, 0, D, gtid, gthreads); zero_rect(win, D, 416, 96, 0, D, gtid, gthreads);
        zero_rect(wuq, 256, 0, 384, 192, 64, gtid, gthreads); zero_rect(wuq, 256, 384, 128, 0, 256, gtid, gthreads);
        zero_rect(wukv, 256, 0, 512, 128, 128, gtid, gthreads);
    }
    { float* rope = (float*)(ws + WS_ROPE); const int* pos = (const int*)a.in[2];
      for (int i = gtid; i < T * 16; i += gthreads) { const int t = i >> 4, k = i & 15; const float inv = powf(10000.f, -(float)(2 * k) / 32.f); const float ang = (float)pos[t] * inv;
          rope[(size_t)t * 32 + k] = cosf(ang); rope[(size_t)t * 32 + 16 + k] = sinf(ang); } }
    { const GAS f32x4* ks = (const GAS f32x4*)a.in[29]; GAS v2u* kd = (GAS v2u*)(ws + WS_KEYS);
      for (int i = gtid; i < L * 2 * 128 * 64 / 4; i += gthreads) { const f32x4 v = ks[i]; v2u w; w.x = pk2(v.x, v.y); w.y = pk2(v.z, v.w); kd[i] = w; }
    }
    for (int r = gw; r < 2 * L * 16384; r += NGW) { const int tb = r / (L * 16384), rr = r % (L * 16384);
        quant_row((const GAS float*)a.in[30 + tb] + (size_t)rr * 1024, (GAS unsigned*)(ws + (tb ? WS_V8 : WS_U8) + (size_t)rr * 1024), (GAS float*)(ws + (tb ? WS_SV : WS_SU)) + rr, 0, F.lane); }
    { float* btab = (float*)(ws + WS_BTAB); float* lams = (float*)(ws + WS_LAMS); float* spt = (float*)(ws + WS_SP);
      for (int i = gtid; i < 4 * 129; i += gthreads) { const int h = i / 129, n = i % 129; int bu; if (n < 16) bu = n; else { const int lg = 16 + (int)(logf((float)n / 16.f) / logf(8.f) * 16.f); bu = lg < 31 ? lg : 31; }
          btab[i] = a.in[3][bu * 4 + h] * LOG2E; }
      for (int i = gtid; i < L; i += gthreads) { const float* dl = a.in[17] + i * 128; float s1 = 0.f, s2 = 0.f; for (int j = 0; j < 32; ++j) { s1 += dl[j] * dl[32 + j]; s2 += dl[64 + j] * dl[96 + j]; }
          const float li = 0.8f - 0.6f * expf(-0.3f * (float)i); lams[2 * i] = expf(s1) - expf(s2) + li; lams[2 * i + 1] = li; }
      for (int i = gtid; i < L * 512; i += gthreads) spt[i] = log1pf(expf(-a.in[16][i])); }
    { GAS bf16* wat = (GAS bf16*)(ws + WS_WAT);
      for (int i = gtid; i < L * 8 * 2 * 4096; i += gthreads) { const int in_ = i & 63, out_ = (i >> 6) & 63, gate = (i >> 12) & 1, lg = i >> 13;
          wat[i] = (bf16)f2bf_(a.in[gate ? 14 : 12][(size_t)lg * 4096 + in_ * 64 + out_]); } }
    for (int l = 0; l < L; ++l) norm_phase((const GAS float*)a.in[1], (const GAS float*)a.in[23] + l * D, (GAS bf16*)(ws + WS_MNB) + (size_t)l * NB * MEM * D, NB * MEM, gw, NGW, F.lane);
}

constexpr int NPL = 16, PH_FINAL = 2 + NPL * L;
__global__ void __launch_bounds__(NWAVES * 64, 2) fwd(Args args) {
    extern __shared__ __attribute__((aligned(16))) unsigned char lds[];
    Frame F;
    F.lds = (LAS unsigned char*)lds; F.MISC = (volatile LAS unsigned*)(F.lds + MISC_OFF);
    F.tid = threadIdx.x; F.lane = F.tid & 63; F.wave = __builtin_amdgcn_readfirstlane(F.tid >> 6); F.G = gridDim.x;
    F.vcu = (F.G % 8 == 0) ? ((int)blockIdx.x % 8) * (F.G / 8) + (int)blockIdx.x / 8 : (int)blockIdx.x;
    unsigned char* ws = args.ws;
    F.ctl = (gu32*)(opq(ws) + WS_CTL);
    for (int u = F.tid; u < (LDS_BYTES - LDSCTL_OFF) / 4; u += NWAVES * 64) ((LAS unsigned*)(F.lds + LDSCTL_OFF))[u] = 0u;
    __syncthreads();
    XcdBarrier bar = xcd_barrier_post((unsigned*)(F.ctl + CW_BAR), F.MISC + 8);
    F.xcc = (int)bar.x;
    if (F.tid == 0) F.MISC[12] = __hip_atomic_fetch_add((unsigned*)(F.ctl + CW_RANK) + 64 * bar.x, 1u, __ATOMIC_RELAXED, __HIP_MEMORY_SCOPE_AGENT);
    __syncthreads();
    F.xrank = __builtin_amdgcn_readfirstlane((int)F.MISC[12]);
    const int lo = args.ph_lo, hi = args.ph_hi;
    const int gw = blockIdx.x * NWAVES + F.wave, NGW = F.G * NWAVES;
#define IN(k) (lo <= (k) && (k) < hi)
#define LANE_ (lane_id_v())
#define TID_ ((opqi(F.wave) << 6) | LANE_)
#define SITE() const int G_ = opqi(F.G), wv_ = opqi(F.wave), vcu_ = opqi(F.vcu), gw_ = opqi(gw), NGW_ = opqi(NGW); (void)G_; (void)wv_; (void)vcu_; (void)gw_; (void)NGW_
#define SEAM(k) do { if (IN(k) && IN((k) + 1)) xcd_barrier(bar, (F.wave == 0 && lane_id_v() == 0) ? 1 : 0); } while (0)
#define GEMM_SITE(EPI, Aptr, lda_, Bptr, ldb_, M_, N_, K_, cperm, ...) do { \
        pg8::Gemm g{opq(Aptr), opq(Bptr), M_, N_, K_, lda_, ldb_}; pg8::StaticOrder So; So.init(M_, N_, opqi(F.G), opqi(cperm)); pg8::EPI E{__VA_ARGS__}; \
        pg8::gemm_phase<pg8::EPI, pg8::StaticOrder, true, true>(F.lds + RING_OFF, g, So, E, opqi(F.wave)); } while (0)
    if (IN(0)) { p0_prologue(F, args); }
    SEAM(0);
    if (IN(1)) {
#pragma unroll 1
        for (int l = 0; l < L; ++l)
            GEMM_SITE(EpiBf16, (const GAS bf16*)(opq(ws) + WS_MNB) + (size_t)l * NB * MEM * D, D, (const GAS bf16*)(opq(ws) + WS_WCKV) + (size_t)l * 2 * D * D, D, NB * MEM, 2 * D, D, (int)((blockIdx.x + 64 * l) % F.G),
                      opq((GAS bf16*)(opq(ws) + WS_KVCB) + (size_t)l * NB * MEM * 2 * D), 2 * D, 2 * D, (const GAS float*)nullptr, 0);
    }
    SEAM(1);
    for (int l = 0; l < L; ++l) {
        const int pb = 2 + NPL * l;
        const GAS bf16* XNB = (const GAS bf16*)(opq(ws) + WS_XNB); const GAS bf16* YB = (const GAS bf16*)(opq(ws) + WS_YB); GAS bf16* PROJB = (GAS bf16*)(opq(ws) + WS_PROJB);
        if (IN(pb + 1)) GEMM_SITE(EpiBf16, XNB, D, (const GAS bf16*)(opq(ws) + WS_WIN) + (size_t)l * INP * D, D, T, INP, D, (int)blockIdx.x, opq(PROJB), INP, INP, opq((const GAS float*)(opq(ws) + WS_SSQ)), 8);
#if MK_DUP == 1
        if (IN(pb + 1)) GEMM_SITE(EpiBf16, XNB, D, (const GAS bf16*)(opq(ws) + WS_WIN) + (size_t)l * INP * D, D, T, INP, D, (int)blockIdx.x, opq(PROJB), INP, INP, opq((const GAS float*)(opq(ws) + WS_SSQ)), 8);
#endif
        SEAM(pb + 1);
        if (IN(pb + 2)) {
            SITE();
            pre_phase(opq((const GAS bf16*)PROJB), opq((const GAS float*)(opq(ws) + WS_ROPE)), opq((GAS float*)(opq(ws) + WS_RS)), opq((GAS bf16*)(opq(ws) + WS_KMB)), gw_, NGW_, LANE_);
            LruP LP{opq((const GAS bf16*)PROJB), (const GAS float*)args.in[opqi(10)] + l * 4 * 512, (const GAS float*)args.in[opqi(11)] + l * 512, opq((const GAS bf16*)(opq(ws) + WS_WAT)) + (size_t)l * 8 * 2 * 4096, (const GAS float*)args.in[opqi(13)] + l * 512, (const GAS float*)args.in[opqi(15)] + l * 512,
                    (const GAS float*)(opq(ws) + WS_SP) + l * 512, opq((GAS unsigned*)(opq(ws) + WS_HLB)), opq((GAS float*)(opq(ws) + WS_LSUM))};
            lru_phase(LP, F.lds, TID_, wv_, LANE_, vcu_, G_);
#if MK_DUP == 2
            lru_phase(LP, F.lds, TID_, wv_, LANE_, vcu_, G_);
#endif
        }
        SEAM(pb + 2);
        if (IN(pb + 3)) {
            GEMM_SITE(EpiUp, (const GAS bf16*)PROJB + PC_CQ, INP, (const GAS bf16*)(opq(ws) + WS_WUQ) + (size_t)l * 512 * 256, 256, T, 512, 256, (int)blockIdx.x,
                      opq((GAS bf16*)(opq(ws) + WS_QMB)), (GAS bf16*)nullptr, 384, 384, opq((const GAS float*)(opq(ws) + WS_RS)), 0, 0);
            GEMM_SITE(EpiUp, (const GAS bf16*)PROJB + PC_CKV, INP, (const GAS bf16*)(opq(ws) + WS_WUKV) + (size_t)l * 512 * 256, 256, T, 512, 256, (int)blockIdx.x,
                      opq((GAS bf16*)(opq(ws) + WS_KMB)), opq((GAS bf16*)(opq(ws) + WS_VMB)), 0, 512, opq((const GAS float*)(opq(ws) + WS_RS)), 1, 1);
        }
        SEAM(pb + 3);
        if (IN(pb + 4)) {
            SITE();
            AttnP PM{opq((const GAS bf16*)(opq(ws) + WS_QMB)), opq((const GAS bf16*)(opq(ws) + WS_KMB)), opq((const GAS bf16*)(opq(ws) + WS_VMB)), 384, 384, 256, opq((GAS bf16*)(opq(ws) + WS_OMB)), 256, opq((const GAS float*)(opq(ws) + WS_ROPE)), nullptr, nullptr, nullptr, nullptr};
            AttnP PD{opq((const GAS bf16*)PROJB + PC_QD), opq((const GAS bf16*)PROJB + PC_KD), opq((const GAS bf16*)PROJB + PC_VD), INP, INP, INP, opq((GAS bf16*)(opq(ws) + WS_YB) + 768), 1024, nullptr,
                     (const GAS int*)args.in[opqi(2)], (const GAS float*)(opq(ws) + WS_BTAB), (const GAS float*)args.in[opqi(18)] + l * 64, (const GAS float*)(opq(ws) + WS_LAMS) + 2 * l};
            attn_phase(PM, PD, F.lds, TID_, wv_, LANE_, vcu_, G_);
#if MK_DUP == 4
            __syncthreads(); attn_phase(PM, PD, F.lds, TID_, wv_, LANE_, vcu_, G_);
#elif MK_DUP == 40 || MK_DUP == 41
            __syncthreads(); attn_phase(PM, PD, F.lds, TID_, wv_, LANE_, vcu_, G_, MK_DUP - 40);
#endif
        }
        SEAM(pb + 4);
        if (IN(pb + 5)) {
            SITE();
            PostP PP{opq((const GAS bf16*)(opq(ws) + WS_OMB)), opq((const GAS unsigned*)(opq(ws) + WS_HLB)), opq((const GAS float*)(opq(ws) + WS_LSUM)), opq((const GAS bf16*)PROJB), (const GAS float*)args.in[opqi(19)] + l * 256, (const GAS float*)args.in[opqi(20)] + l * 512, opq((GAS bf16*)(opq(ws) + WS_YB))};
            post_phase(PP, F.lds, TID_, wv_, LANE_, vcu_, G_);
        }
        SEAM(pb + 5);
        if (IN(pb + 6)) GEMM_SITE(EpiRes, YB, D, (const GAS bf16*)(opq(ws) + WS_WOUT) + (size_t)l * D * D, D, T, D, D, (int)blockIdx.x, opq(l == 0 ? (const GAS float*)args.in[opqi(0)] : (const GAS float*)args.out), opq((GAS float*)args.out), opq((GAS bf16*)(opq(ws) + WS_XNB)), opq((GAS float*)(opq(ws) + WS_SSQ)));
        SEAM(pb + 6);
        if (IN(pb + 8)) GEMM_SITE(EpiBf16, XNB, D, (const GAS bf16*)(opq(ws) + WS_WCQ) + (size_t)l * D * D, D, T, D, D, (int)blockIdx.x, opq(PROJB), D, D, opq((const GAS float*)(opq(ws) + WS_SSQ)), 16);
#if MK_DUP == 8
        if (IN(pb + 8)) GEMM_SITE(EpiBf16, XNB, D, (const GAS bf16*)(opq(ws) + WS_WCQ) + (size_t)l * D * D, D, T, D, D, (int)blockIdx.x, opq(PROJB), D, D, opq((const GAS float*)(opq(ws) + WS_SSQ)), 16);
#endif
        SEAM(pb + 8);
        if (IN(pb + 9)) {
            SITE();
            const GAS bf16* kv = (const GAS bf16*)(opq(ws) + WS_KVCB) + (size_t)l * NB * MEM * 2 * D;
            AttnP PC{opq((const GAS bf16*)PROJB), opq(kv), opq(kv + D), 1024, 2 * D, 2 * D, opq((GAS bf16*)(opq(ws) + WS_YB)), 1024, nullptr, nullptr, nullptr, nullptr, nullptr};
            cross_phase(PC, F.lds, TID_, wv_, LANE_, vcu_, G_);
#if MK_DUP == 9
            cross_phase(PC, F.lds, TID_, wv_, LANE_, vcu_, G_);
#endif
        }
        SEAM(pb + 9);
        if (IN(pb + 10)) GEMM_SITE(EpiRes, YB, D, (const GAS bf16*)(opq(ws) + WS_WCO) + (size_t)l * D * D, D, T, D, D, (int)blockIdx.x, opq((const GAS float*)args.out), opq((GAS float*)args.out), opq((GAS bf16*)(opq(ws) + WS_XNB)), opq((GAS float*)(opq(ws) + WS_SSQ)));
        SEAM(pb + 10);
        if (IN(pb + 12)) { GEMM_SITE(EpiBf16, XNB, D, (const GAS bf16*)(opq(ws) + WS_WPQ) + (size_t)l * D * D, D, T, D, D, (int)blockIdx.x, opq(PROJB), D, D, opq((const GAS float*)(opq(ws) + WS_SSQ)), 16);
            SITE(); hq_phase(opq(XNB), opq((const GAS float*)(opq(ws) + WS_SSQ)), (const GAS float*)args.in[opqi(27)] + l * D, opq((GAS unsigned char*)(opq(ws) + WS_HQ)), opq((GAS float*)(opq(ws) + WS_SH)), opq((GAS int*)(opq(ws) + WS_P)), gw_, NGW_, LANE_); }
        SEAM(pb + 12);
        if (IN(pb + 13)) {
            SITE();
            RouteP RP{opq((const GAS bf16*)PROJB), opq((const GAS bf16*)(opq(ws) + WS_KEYS) + (size_t)l * 2 * 128 * 64), opq((GAS int*)(opq(ws) + WS_EX)), opq((GAS float*)(opq(ws) + WS_GW))};
            route_phase(RP, F.lds, TID_, wv_, LANE_, vcu_, G_);
#if MK_DUP == 13
            route_phase(RP, F.lds, TID_, wv_, LANE_, vcu_, G_);
#endif
        }
        SEAM(pb + 13);
        if (IN(pb + 14)) {
            SITE();
            const PeerS ps = peer_sched((const GAS unsigned*)(F.ctl + CW_RANK), opqi(F.xcc), opqi(F.xrank));
            Peer1P Q1{opq((const GAS unsigned char*)(opq(ws) + WS_HQ)), opq((const GAS int*)(opq(ws) + WS_EX)), opq((const GAS unsigned char*)(opq(ws) + WS_U8) + (size_t)l * 16384 * 1024), opq((GAS int*)(opq(ws) + WS_P))};
            peer_k1(Q1, ps, wv_, LANE_);
#if MK_DUP == 141
            { Peer1P Q1b = Q1; Q1b.P = (GAS int*)(opq(ws) + WS_PROJB); peer_k1(Q1b, ps, wv_, LANE_); }
#endif
        }
        SEAM(pb + 14);
        if (IN(pb + 15)) {
            SITE();
            peer_w(opq((const GAS int*)(opq(ws) + WS_EX)), opq((const GAS float*)(opq(ws) + WS_GW)), opq((const GAS int*)(opq(ws) + WS_P)), opq((const GAS float*)(opq(ws) + WS_SH)), opq((const GAS float*)(opq(ws) + WS_SU) + l * 16384), opq((const GAS float*)(opq(ws) + WS_SV) + l * 16384),
                   opq((GAS signed char*)(opq(ws) + WS_W)), opq((GAS float*)(opq(ws) + WS_WS)), gw_, NGW_, LANE_);
            xcd_barrier(bar, (F.wave == 0 && lane_id_v() == 0) ? 1 : 0);
            const PeerS ps = peer_sched((const GAS unsigned*)(F.ctl + CW_RANK), opqi(F.xcc), opqi(F.xrank));
            Peer2P Q2{opq((const GAS int*)(opq(ws) + WS_EX)), opq((const GAS signed char*)(opq(ws) + WS_W)), opq((const GAS float*)(opq(ws) + WS_WS)), opq((const GAS unsigned char*)(opq(ws) + WS_V8) + (size_t)l * 16384 * 1024), (GAS float*)args.out, opq((GAS bf16*)(opq(ws) + WS_XNB)), opq((GAS float*)(opq(ws) + WS_SSQ))};
            peer_k2(Q2, ps, wv_, LANE_);
#if MK_DUP == 151
            { Peer2P Q2b = Q2; Q2b.X = (GAS float*)(opq(ws) + WS_PROJB); peer_k2(Q2b, ps, wv_, LANE_); }
#endif
        }
        SEAM(pb + 15);
    }
    if (IN(PH_FINAL)) { SITE(); final_norm_phase((GAS float*)args.out, (const GAS float*)args.in[opqi(32)], T, gw_, NGW_, LANE_); }
#undef IN
#undef SEAM
#undef GEMM_SITE
}
}
extern "C" void kernel_launch(void* const* d_in, const int* in_sizes, int n_in, void* d_out, int out_size, void* d_ws, size_t ws_size, hipStream_t stream) {
    (void)in_sizes; (void)out_size;
    static int grid = 0;
    if (grid == 0) {
        int dev = 0, cus = 0, per_cu = 0;
        if (n_in != 33 || ws_size < mk::WS_END) { fprintf(stderr, "kernel_launch: unexpected n_in %d / ws_size %zu\n", n_in, ws_size); grid = -1; return; }
        if (hipGetDevice(&dev) != hipSuccess || hipDeviceGetAttribute(&cus, hipDeviceAttributeMultiprocessorCount, dev) != hipSuccess) { grid = -1; return; }
        if (hipFuncSetAttribute((const void*)mk::fwd, hipFuncAttributeMaxDynamicSharedMemorySize, mk::LDS_BYTES) != hipSuccess) { fprintf(stderr, "kernel_launch: hipFuncSetAttribute failed\n"); grid = -1; return; }
        if (hipOccupancyMaxActiveBlocksPerMultiprocessor(&per_cu, (const void*)mk::fwd, mk::NWAVES * 64, mk::LDS_BYTES) != hipSuccess || per_cu < 1) fprintf(stderr, "kernel_launch: occupancy query says %d\n", per_cu);
        (void)hipGetLastError();
        grid = cus;
    }
    if (grid < 0) return;
    unsigned char* ws = (unsigned char*)d_ws;
    (void)hipMemsetAsync(ws + mk::WS_CTL, 0, mk::CTL_ZERO_BYTES, stream);
    mk::Args a{};
    for (int i = 0; i < 33; ++i) a.in[i] = (const float*)d_in[i];
    a.out = (float*)d_out; a.ws = ws;
    auto run = [&](int lo, int hi) { a.ph_lo = lo; a.ph_hi = hi; hipLaunchKernelGGL(mk::fwd, dim3(grid), dim3(mk::NWAVES * 64), mk::LDS_BYTES, stream, a); };
#if MK_ONE_LAUNCH
    run(0, mk::PH_FINAL + 1);
#else
    for (int p = 0; p <= mk::PH_FINAL; ++p) {
        const int k = (p - 2) % mk::NPL, l = (p - 2) / mk::NPL;
#if MK_NAIVE_PEER == 2
        if (p >= 2 && p < mk::PH_FINAL && k == 14) {
            hipLaunchKernelGGL(k_peer, dim3(T), dim3(256), 0, stream, (const bf16_t*)(ws + mk::WS_XNB), (const int*)(ws + mk::WS_EX), (const float*)(ws + mk::WS_GW), (const float*)d_in[30] + (size_t)l * NEXP * D, (const float*)d_in[31] + (size_t)l * NEXP * D, (float*)d_out);
            continue; }
#elif MK_NAIVE_PEER == 1
        if (p >= 2 && p < mk::PH_FINAL && k == 13) {
            float* TQ = (float*)(ws + (size_t)806 * mk::MiB);
            hipLaunchKernelGGL(k_bf2f, dim3((unsigned)(((size_t)T * D + 255) / 256)), dim3(256), 0, stream, (const bf16_t*)(ws + mk::WS_PROJB), TQ, (long)T * D);
            hipLaunchKernelGGL(k_route, dim3(T), dim3(256), 0, stream, TQ, (const float*)d_in[29] + (size_t)l * 2 * 128 * 64, (int*)(ws + mk::WS_EX), (float*)(ws + mk::WS_GW));
            hipLaunchKernelGGL(k_peer, dim3(T), dim3(256), 0, stream, (const bf16_t*)(ws + mk::WS_XNB), (const int*)(ws + mk::WS_EX), (const float*)(ws + mk::WS_GW), (const float*)d_in[30] + (size_t)l * NEXP * D, (const float*)d_in[31] + (size_t)l * NEXP * D, (float*)d_out);
            continue; }
        if (p >= 2 && p < mk::PH_FINAL && k == 14) continue;
#endif
        run(p, p + 1); }
#endif
}
```

```cpp
#include <hip/hip_runtime.h>
#include <cstdint>
#include <cstdio>
#include <cmath>

#ifndef MK_ONE_LAUNCH
#define MK_ONE_LAUNCH 1
#endif
#ifndef MK_DUP
#define MK_DUP 0
#endif
#ifndef MK_NAIVE_PEER
#define MK_NAIVE_PEER 0
#endif
namespace pg8 {
#define PG8_LAS __attribute__((address_space(3)))
#ifndef GAS
#define GAS __attribute__((address_space(1)))
#endif
typedef unsigned short bf16_t;
typedef short bf16x8 __attribute__((ext_vector_type(8)));
typedef float f32x4 __attribute__((ext_vector_type(4)));
typedef unsigned u32x4 __attribute__((ext_vector_type(4)));
typedef unsigned u32x2 __attribute__((ext_vector_type(2)));
constexpr int BM = 256, BK = 64, HALF = 128, HTB = HALF * BK * 2, STAGE_BYTES = 8 * HTB, NXCD = 8, WGM = 8;
__host__ __device__ __forceinline__ int lds_byte(int r, int c) { const int st = (r >> 4) * 2 + (c >> 5), rr = r & 15, cc = c & 31, ob = rr * 64 + cc * 2; return st * 1024 + (ob ^ (((ob >> 9) & 1) << 5)); }
__host__ __device__ __forceinline__ void stage_rc(int b, int& R, int& C) { const int st = b / 1024, sb = b % 1024, swz = sb ^ (((sb >> 9) & 1) << 5); R = (st >> 1) * 16 + swz / 64; C = (st & 1) * 32 + (swz % 64) / 2; }
__host__ __device__ __forceinline__ int perm32(int rho) { const int n = rho >> 4, i = rho & 15; return 8 * (i >> 2) + 4 * n + (i & 3); }
__device__ __forceinline__ int pg8_lane_id() { int l; asm volatile("v_mbcnt_lo_u32_b32 %0, -1, 0\n\tv_mbcnt_hi_u32_b32 %0, -1, %0" : "=v"(l)); return l; }
struct Unit { int pm, pn; };
struct Gemm { const GAS bf16_t* A; const GAS bf16_t* Bt; int M, N, K, lda, ldb; };
struct StaticOrder {
    int nM, nN, nwg, G, c;
    __host__ __device__ void init(int M, int N, int G_, int c_) { nM = M / BM; nN = N / BM; nwg = nM * nN; G = G_; c = c_; }
    __host__ __device__ bool next(int i, Unit& u) const {
        const long L = (long)i * G + c; if (L >= nwg) return false;
        int wgid = (int)L; { const int q = nwg / NXCD, r = nwg % NXCD, xcd = wgid % NXCD, off = wgid / NXCD; wgid = (xcd < r ? xcd * (q + 1) : r * (q + 1) + (xcd - r) * q) + off; }
        const int nig = WGM * nN, gid = wgid / nig, fm = gid * WGM, gsz = (nM - fm) < WGM ? (nM - fm) : WGM;
        u.pm = fm + ((wgid % nig) % gsz); u.pn = (wgid % nig) / gsz; return true;
    }
    __device__ __forceinline__ void a_ready(const Unit&) const {}
    __device__ __forceinline__ void done(const Unit&) const {}
};
__device__ __forceinline__ unsigned cvt_pk_bf16(float lo, float hi) { unsigned r; asm volatile("v_cvt_pk_bf16_f32 %0, %1, %2" : "=v"(r) : "v"(lo), "v"(hi)); return r; }

struct EpiF32 {
    static constexpr bool PERM = false, AFTER_DRAIN = false;
    GAS float* C; int ldc; int nvalid; int accum;
    __device__ __forceinline__ void operator()(const f32x4 (&acc)[2][2][4][2], const Unit& u, int wr, int wc, int fr, int fq) const {
        { const int l_ = pg8_lane_id(); fr = l_ & 15; fq = l_ >> 4; }
#pragma unroll
        for (int ai = 0; ai < 2; ++ai)
#pragma unroll
            for (int m = 0; m < 4; ++m) { const size_t row = (size_t)u.pm * BM + ai * HALF + wr * 64 + m * 16 + fr;
#pragma unroll
                for (int bj = 0; bj < 2; ++bj)
#pragma unroll
                    for (int n = 0; n < 2; ++n) { const int col = u.pn * BM + bj * HALF + wc * 32 + n * 16 + 4 * fq;
                        if (col < nvalid) { GAS float* p = C + row * ldc + col; f32x4 v = acc[ai][bj][m][n]; if (accum) v += *(const GAS f32x4*)p; *(GAS f32x4*)p = v; } } }
    }
};
struct EpiBf16 {
    static constexpr bool PERM = true, AFTER_DRAIN = false;
    GAS bf16_t* O; int ldc; int nvalid; const GAS float* ssq; int np;
    __device__ __forceinline__ void operator()(const f32x4 (&acc)[2][2][4][2], const Unit& u, int wr, int wc, int fr, int fq) const {
        { const int l_ = pg8_lane_id(); fr = l_ & 15; fq = l_ >> 4; }
#pragma unroll
        for (int ai = 0; ai < 2; ++ai)
#pragma unroll
            for (int m = 0; m < 4; ++m) { const size_t row = (size_t)u.pm * BM + ai * HALF + wr * 64 + m * 16 + fr;
                float rs_ = 1.f;
                if (np > 0) { const GAS f32x4* sp = (const GAS f32x4*)(ssq + row * 16); f32x4 t = sp[0] + sp[1]; if (np > 8) t += sp[2] + sp[3]; rs_ = __builtin_amdgcn_rsqf(((t[0] + t[1]) + (t[2] + t[3])) * (1.f / 1024.f) + 1e-6f); }
#pragma unroll
                for (int bj = 0; bj < 2; ++bj) { const int col = u.pn * BM + bj * HALF + wc * 32 + 8 * fq;
                    if (col < nvalid) { const f32x4 v0 = acc[ai][bj][m][0] * rs_, v1 = acc[ai][bj][m][1] * rs_; u32x4 w; w.x = cvt_pk_bf16(v0[0], v0[1]); w.y = cvt_pk_bf16(v0[2], v0[3]); w.z = cvt_pk_bf16(v1[0], v1[1]); w.w = cvt_pk_bf16(v1[2], v1[3]);
                        *(GAS u32x4*)(O + row * ldc + col) = w; } } }
    }
};
struct EpiUp {
    static constexpr bool PERM = true, AFTER_DRAIN = false;
    GAS bf16_t* O; GAS bf16_t* O2; int ldc; int nvalid; const GAS float* rs; int rsi; int mode;
    __device__ __forceinline__ void operator()(const f32x4 (&acc)[2][2][4][2], const Unit& u, int wr, int wc, int fr, int fq) const {
        { const int l_ = pg8_lane_id(); fr = l_ & 15; fq = l_ >> 4; }
#pragma unroll
        for (int ai = 0; ai < 2; ++ai)
#pragma unroll
            for (int m = 0; m < 4; ++m) { const size_t row = (size_t)u.pm * BM + ai * HALF + wr * 64 + m * 16 + fr; const float s = rs[2 * row + rsi];
#pragma unroll
                for (int bj = 0; bj < 2; ++bj) { const int col = u.pn * BM + bj * HALF + wc * 32 + 8 * fq;
                    if (col < nvalid) { const f32x4 v0 = acc[ai][bj][m][0] * s, v1 = acc[ai][bj][m][1] * s; u32x4 w; w.x = cvt_pk_bf16(v0[0], v0[1]); w.y = cvt_pk_bf16(v0[2], v0[3]); w.z = cvt_pk_bf16(v1[0], v1[1]); w.w = cvt_pk_bf16(v1[2], v1[3]);
                        GAS bf16_t* dst;
                        if (mode == 0) dst = O + row * ldc + col;
                        else { const int h = col >> 7, j = col & 127; dst = (j < 64) ? O + row * 384 + h * 96 + j : O2 + row * 256 + h * 64 + (j - 64); }
                        *(GAS u32x4*)dst = w; } } }
    }
};

struct EpiRes {
    static constexpr bool PERM = true, AFTER_DRAIN = false;
    GAS bf16_t* XB; GAS float* SSQ;
    __device__ __forceinline__ void operator()(const f32x4 (&acc)[2][2][4][2], const Unit& u, int wr, int wc, int fr, int fq) const {
        { const int l_ = pg8_lane_id(); fr = l_ & 15; fq = l_ >> 4; }
#pragma unroll
        for (int ai = 0; ai < 2; ++ai)
#pragma unroll
            for (int m = 0; m < 4; ++m) { const size_t row = (size_t)u.pm * BM + ai * HALF + wr * 64 + m * 16 + fr; float ss = 0.f;
#pragma unroll
                for (int bj = 0; bj < 2; ++bj) { GAS u32x4* p = (GAS u32x4*)(XB + row * 1024 + u.pn * BM + bj * HALF + wc * 32 + 8 * fq);
                    const u32x4 o = *p; const f32x4 v0 = acc[ai][bj][m][0], v1 = acc[ai][bj][m][1];
                    u32x4 w;
                    w.x = cvt_pk_bf16(__builtin_bit_cast(float, o.x << 16) + v0[0], __builtin_bit_cast(float, o.x & 0xffff0000u) + v0[1]);
                    w.y = cvt_pk_bf16(__builtin_bit_cast(float, o.y << 16) + v0[2], __builtin_bit_cast(float, o.y & 0xffff0000u) + v0[3]);
                    w.z = cvt_pk_bf16(__builtin_bit_cast(float, o.z << 16) + v1[0], __builtin_bit_cast(float, o.z & 0xffff0000u) + v1[1]);
                    w.w = cvt_pk_bf16(__builtin_bit_cast(float, o.w << 16) + v1[2], __builtin_bit_cast(float, o.w & 0xffff0000u) + v1[3]);
                    *p = w;
#pragma unroll
                    for (int e = 0; e < 4; ++e) { const float a = __builtin_bit_cast(float, w[e] << 16), b = __builtin_bit_cast(float, w[e] & 0xffff0000u); ss += a * a + b * b; } }
                { float a = ss, b = ss; asm volatile("v_nop\n\tv_nop\n\tv_permlane16_swap_b32 %0, %1" : "+v"(a), "+v"(b)); ss = a + b; }
                { float a = ss, b = ss; asm volatile("v_nop\n\tv_nop\n\tv_permlane32_swap_b32 %0, %1" : "+v"(a), "+v"(b)); ss = a + b; }
                if (fq == 0) SSQ[row * 16 + 4 * u.pn + wc] = ss; }
    }
};
template <class Epi, class Sched, bool ALIGN_EPI = false, bool SP2 = false>
__device__ __forceinline__ void gemm_phase(PG8_LAS unsigned char* lds, const Gemm g, const Sched& S, const Epi& E, int wave_id) {
    int tid_ = (wave_id << 6) | pg8_lane_id(); asm volatile("" : "+v"(tid_));
    const int tid = tid_, wid = __builtin_amdgcn_readfirstlane(tid >> 6), lane = tid & 63, wr = wid >> 2, wc = wid & 3, fr = lane & 15, fq = lane >> 4;
    const int K = g.K, nt = K / BK;
    unsigned voffA[2], voffB[2];
#pragma unroll
    for (int i = 0; i < 2; ++i) { int R, C; stage_rc(tid * 16 + i * 8192, R, C); const int Rb = Epi::PERM ? ((R & ~31) + perm32(R & 31)) : R;
        voffA[i] = (unsigned)(R * g.lda + C) * 2u; voffB[i] = (unsigned)(Rb * g.ldb + C) * 2u; }
    const size_t kstep = (size_t)(BK * 2);
    const size_t hstepA = (size_t)HALF * g.lda * 2, hstepB = (size_t)HALF * g.ldb * 2;
    const size_t tstepA = 2 * hstepA, tstepB = 2 * hstepB;
    const unsigned ldsw = (unsigned)wid * 1024u;
    const int aoff = lds_byte(wr * 64 + fr, fq * 8), boff = lds_byte(wc * 32 + fr, fq * 8);
#define PG8_SA(b, h) (((b) * 2 + (h)) * HTB)
#define PG8_SB(b, h) ((4 + (b) * 2 + (h)) * HTB)
#define PG8_STAGE(bufoff, gbase, voff) do { _Pragma("unroll") for (int _i = 0; _i < 2; ++_i) \
        __builtin_amdgcn_global_load_lds((const unsigned*)((const char*)(gbase) + (voff)[_i]), (PG8_LAS unsigned*)(lds + (bufoff) + ldsw + _i * 8192), 16, 0, 0); } while (0)
#define PG8_LDA(dst, b, h) do { _Pragma("unroll") for (int m = 0; m < 4; ++m) _Pragma("unroll") for (int k = 0; k < 2; ++k) dst[m][k] = *(const PG8_LAS bf16x8*)(lds + PG8_SA(b, h) + aoff + m * 2048 + k * 1024); } while (0)
#define PG8_LDB(dst, b, h) do { _Pragma("unroll") for (int n = 0; n < 2; ++n) _Pragma("unroll") for (int k = 0; k < 2; ++k) dst[n][k] = *(const PG8_LAS bf16x8*)(lds + PG8_SB(b, h) + boff + n * 2048 + k * 1024); } while (0)
#define PG8_MMA(ai, bj, At, Bt) do { __builtin_amdgcn_s_setprio(1); _Pragma("unroll") for (int m = 0; m < 4; ++m) _Pragma("unroll") for (int n = 0; n < 2; ++n) _Pragma("unroll") for (int k = 0; k < 2; ++k) \
        acc[ai][bj][m][n] = __builtin_amdgcn_mfma_f32_16x16x32_bf16(Bt[n][k], At[m][k], acc[ai][bj][m][n], 0, 0, 0); __builtin_amdgcn_s_setprio(0); } while (0)
#define PG8_WAIT_V(n) asm volatile("s_waitcnt vmcnt(" #n ")" ::: "memory")
#define PG8_WAIT_L(n) asm volatile("s_waitcnt lgkmcnt(" #n ")" ::: "memory")
#define PG8_BAR __builtin_amdgcn_s_barrier()
#define PG8_SCHED __builtin_amdgcn_sched_barrier(0)
    Unit cur, nxt; int ui = 0;
    if (!S.next(0, cur)) return;
    f32x4 acc[2][2][4][2];
#pragma unroll
    for (int a = 0; a < 2; ++a)
#pragma unroll
        for (int b = 0; b < 2; ++b)
#pragma unroll
            for (int m = 0; m < 4; ++m)
#pragma unroll
                for (int n = 0; n < 2; ++n) acc[a][b][m][n] = (f32x4){0.f, 0.f, 0.f, 0.f};
    bf16x8 At[4][2], B0[2][2], B1[2][2];
    const char* cA = (const char*)g.A + (size_t)cur.pm * tstepA; const char* cB = (const char*)g.Bt + (size_t)cur.pn * tstepB;
    S.a_ready(cur);
    if constexpr (SP2) {
        PG8_STAGE(PG8_SB(0, 0), cB, voffB); PG8_STAGE(PG8_SB(0, 1), cB + hstepB, voffB); PG8_STAGE(PG8_SA(0, 0), cA, voffA); PG8_STAGE(PG8_SA(0, 1), cA + hstepA, voffA);
        if (wr == 1) PG8_BAR;
        PG8_WAIT_V(2); PG8_BAR;
        PG8_STAGE(PG8_SB(1, 0), cB + kstep, voffB); PG8_STAGE(PG8_SA(1, 0), cA + kstep, voffA); PG8_STAGE(PG8_SB(1, 1), cB + hstepB + kstep, voffB);
        PG8_WAIT_V(6); PG8_BAR;
    } else {
        PG8_STAGE(PG8_SB(0, 0), cB, voffB); PG8_STAGE(PG8_SA(0, 0), cA, voffA); PG8_STAGE(PG8_SB(0, 1), cB + hstepB, voffB); PG8_STAGE(PG8_SA(0, 1), cA + hstepA, voffA);
        if (wr == 1) PG8_BAR;
        PG8_WAIT_V(4); PG8_BAR;
        PG8_STAGE(PG8_SB(1, 0), cB + kstep, voffB); PG8_STAGE(PG8_SA(1, 0), cA + kstep, voffA); PG8_STAGE(PG8_SB(1, 1), cB + hstepB + kstep, voffB);
        PG8_WAIT_V(6); PG8_BAR;
    }
    for (;;) {
        const bool has_next = S.next(ui + 1, nxt);
        const char* nA = has_next ? (const char*)g.A + (size_t)nxt.pm * tstepA : cA; const char* nB = has_next ? (const char*)g.Bt + (size_t)nxt.pn * tstepB : cB;
        for (int t = 0; t < nt; t += 2) {
            const bool last = (t == nt - 2);
            const char* a1 = cA + (size_t)(t + 1) * kstep;
            const char* a2 = last ? nA : cA + (size_t)(t + 2) * kstep; const char* b2 = last ? nB : cB + (size_t)(t + 2) * kstep;
            const char* a3 = a2 + kstep; const char* b3 = b2 + kstep;
            if (last && has_next) S.a_ready(nxt);
            if constexpr (SP2) {
            PG8_LDB(B0, 0, 0); PG8_LDB(B1, 0, 1); PG8_SCHED; PG8_LDA(At, 0, 0); PG8_STAGE(PG8_SA(1, 1), a1 + hstepA, voffA);
            PG8_WAIT_V(8); PG8_WAIT_L(0); PG8_BAR; PG8_MMA(0, 0, At, B0); PG8_MMA(0, 1, At, B1); PG8_BAR; PG8_SCHED;
            PG8_LDA(At, 0, 1); PG8_STAGE(PG8_SB(0, 0), b2, voffB); PG8_STAGE(PG8_SB(0, 1), b2 + hstepB, voffB); PG8_STAGE(PG8_SA(0, 0), a2, voffA);
            PG8_WAIT_V(8); PG8_WAIT_L(0); PG8_BAR; PG8_MMA(1, 0, At, B0); PG8_MMA(1, 1, At, B1); PG8_BAR; PG8_SCHED;
            PG8_LDB(B0, 1, 0); PG8_LDB(B1, 1, 1); PG8_SCHED; PG8_LDA(At, 1, 0); PG8_STAGE(PG8_SA(0, 1), a2 + hstepA, voffA);
            PG8_WAIT_V(8); PG8_WAIT_L(0); PG8_BAR; PG8_MMA(0, 0, At, B0); PG8_MMA(0, 1, At, B1); PG8_BAR; PG8_SCHED;
            PG8_LDA(At, 1, 1); PG8_STAGE(PG8_SB(1, 0), b3, voffB); PG8_STAGE(PG8_SB(1, 1), b3 + hstepB, voffB); PG8_STAGE(PG8_SA(1, 0), a3, voffA);
            PG8_WAIT_V(8); PG8_WAIT_L(0); PG8_BAR; PG8_MMA(1, 0, At, B0); PG8_MMA(1, 1, At, B1); PG8_BAR; PG8_SCHED;
            } else {
            PG8_LDB(B0, 0, 0); PG8_SCHED; PG8_LDA(At, 0, 0); PG8_STAGE(PG8_SA(1, 1), a1 + hstepA, voffA);
            PG8_WAIT_L(8); PG8_BAR; PG8_WAIT_L(0); PG8_MMA(0, 0, At, B0); PG8_BAR; PG8_SCHED;
            PG8_LDB(B1, 0, 1); PG8_STAGE(PG8_SB(0, 0), b2, voffB);
            PG8_BAR; PG8_WAIT_L(0); PG8_MMA(0, 1, At, B1); PG8_BAR;
            PG8_LDA(At, 0, 1); PG8_STAGE(PG8_SA(0, 0), a2, voffA);
            PG8_BAR; PG8_WAIT_L(0); PG8_MMA(1, 0, At, B0); PG8_BAR; PG8_SCHED;
            PG8_STAGE(PG8_SB(0, 1), b2 + hstepB, voffB);
            PG8_WAIT_V(6); PG8_BAR; PG8_MMA(1, 1, At, B1); PG8_BAR;
            PG8_LDB(B0, 1, 0); PG8_SCHED; PG8_LDA(At, 1, 0); PG8_STAGE(PG8_SA(0, 1), a2 + hstepA, voffA);
            PG8_WAIT_L(8); PG8_BAR; PG8_WAIT_L(0); PG8_MMA(0, 0, At, B0); PG8_BAR; PG8_SCHED;
            PG8_LDB(B1, 1, 1); PG8_STAGE(PG8_SB(1, 0), b3, voffB);
            PG8_BAR; PG8_WAIT_L(0); PG8_MMA(0, 1, At, B1); PG8_BAR;
            PG8_LDA(At, 1, 1); PG8_STAGE(PG8_SA(1, 0), a3, voffA);
            PG8_BAR; PG8_WAIT_L(0); PG8_MMA(1, 0, At, B0); PG8_BAR; PG8_SCHED;
            PG8_STAGE(PG8_SB(1, 1), b3 + hstepB, voffB);
            PG8_WAIT_V(6); PG8_BAR; PG8_MMA(1, 1, At, B1); PG8_BAR;
            }
        }
        if constexpr (ALIGN_EPI) { if (wr == 0) PG8_BAR; }
        if constexpr (!Epi::AFTER_DRAIN) { E(acc, cur, wr, wc, fr, fq); S.done(cur); }
        if (!has_next) break;
#pragma unroll
        for (int a = 0; a < 2; ++a)
#pragma unroll
            for (int b = 0; b < 2; ++b)
#pragma unroll
                for (int m = 0; m < 4; ++m)
#pragma unroll
                    for (int n = 0; n < 2; ++n) acc[a][b][m][n] = (f32x4){0.f, 0.f, 0.f, 0.f};
        cur = nxt; cA = nA; cB = nB; ++ui;
        if constexpr (ALIGN_EPI) { if (wr == 1) PG8_BAR; }
    }
    PG8_WAIT_V(0);
    if constexpr (!ALIGN_EPI) { if (wr == 0) PG8_BAR; }
    PG8_BAR;
    if constexpr (Epi::AFTER_DRAIN) { E.fused(acc, cur, wr, wc, fr, fq, lds, wid, lane); S.done(cur); }
#undef PG8_SA
#undef PG8_SB
#undef PG8_STAGE
#undef PG8_LDA
#undef PG8_LDB
#undef PG8_MMA
#undef PG8_WAIT_V
#undef PG8_WAIT_L
#undef PG8_BAR
#undef PG8_SCHED
}
}

namespace mk {
#ifndef GAS
#define GAS __attribute__((address_space(1)))
#endif
#define LAS __attribute__((address_space(3)))
typedef unsigned short bf16;
typedef unsigned v4u __attribute__((ext_vector_type(4)));
typedef unsigned v2u __attribute__((ext_vector_type(2)));
typedef float f32x4 __attribute__((ext_vector_type(4)));
typedef GAS unsigned gu32;
#define LDS_WAIT() asm volatile("s_waitcnt lgkmcnt(0)" ::: "memory")
#define VM_WAIT() asm volatile("s_waitcnt vmcnt(0)" ::: "memory")
__device__ __forceinline__ unsigned f2bf_(float f) { unsigned u = __builtin_bit_cast(unsigned, f); return (u + 0x7fffu + ((u >> 16) & 1u)) >> 16; }
__device__ __forceinline__ unsigned pk2(float lo, float hi) { return f2bf_(lo) | (f2bf_(hi) << 16); }
__device__ __forceinline__ float bflo(unsigned w) { return __builtin_bit_cast(float, w << 16); }
__device__ __forceinline__ float bfhi(unsigned w) { return __builtin_bit_cast(float, w & 0xffff0000u); }

template <class P> __device__ __forceinline__ P* opq(P* p) { asm volatile("" : "+s"(p)); return p; }
__device__ __forceinline__ int opqi(int k) { asm volatile("" : "+s"(k)); return k; }
__device__ __forceinline__ float shx(float v, int o, int lane) { return __builtin_bit_cast(float, __builtin_amdgcn_ds_bpermute((lane ^ o) << 2, __builtin_bit_cast(int, v))); }
__device__ __forceinline__ int shxi(int v, int o, int lane) { return __builtin_amdgcn_ds_bpermute((lane ^ o) << 2, v); }
__device__ __forceinline__ int lane_id_v() { int l; asm volatile("v_mbcnt_lo_u32_b32 %0, -1, 0\n\tv_mbcnt_hi_u32_b32 %0, -1, %0" : "=v"(l)); return l; }
constexpr int NWAVES = 8;
constexpr int D = 1024, NB = 4, S = 8192, T = NB * S, L = 4, MEM = 256, INW = 2144, INP = 2304;
constexpr int PC_CQ = 0, PC_CKV = 256, PC_KR = 384, PC_XL = 512, PC_GL = 1024, PC_QD = 1536, PC_KD = 1792, PC_VD = 2048;
constexpr float LOG2E = 1.4426950408889634f;
constexpr size_t MiB = 1u << 20;
constexpr size_t WS_CTL = 0, CTL_ZERO_BYTES = 1 * MiB;
constexpr size_t WS_WIN = 1 * MiB, WS_WOUT = 19 * MiB, WS_WCQ = 27 * MiB, WS_WCO = 35 * MiB, WS_WPQ = 43 * MiB, WS_WCKV = 51 * MiB, WS_WUQ = 67 * MiB, WS_WUKV = 68 * MiB, WS_KEYS = 69 * MiB, WS_ROPE = 70 * MiB;
constexpr size_t WS_XNB = 76 * MiB, WS_YB = 140 * MiB, WS_PROJB = 204 * MiB, WS_QMB = 348 * MiB, WS_KMB = 372 * MiB, WS_VMB = 396 * MiB, WS_RS = 412 * MiB;
constexpr size_t WS_HLB = 413 * MiB, WS_ACB = 445 * MiB, WS_LSUM = 477 * MiB, WS_OMB = 478 * MiB, WS_MNB = 494 * MiB, WS_KVCB = 502 * MiB, WS_EX = 518 * MiB, WS_GW = 534 * MiB;
constexpr size_t WS_U8 = 550 * MiB, WS_V8 = 614 * MiB, WS_SU = 678 * MiB, WS_SV = 679 * MiB;
constexpr size_t WS_HQ = 680 * MiB, WS_P = 712 * MiB, WS_SH = 728 * MiB, WS_W = 729 * MiB, WS_WS = 745 * MiB, WS_SSQ = 746 * MiB, WS_END = 748 * MiB;
constexpr size_t WS_WAT = 74 * MiB;
constexpr size_t WS_BTAB = WS_KEYS + 512 * 1024, WS_LAMS = WS_BTAB + 4096, WS_SP = WS_LAMS + 4096;
constexpr int CW_BAR = 4096, CW_RANK = 8192;
constexpr int RING_OFF = 0, RING_BYTES = 155648, LDSCTL_OFF = RING_BYTES, MISC_OFF = LDSCTL_OFF + 320, LDS_BYTES = 163840;

#define XB_TMO      128
#define XB_XCNT(j)  (256  + 64 * (j))
#define XB_XSUB(j)  (1280 + 64 * (j))
#define XB_XGEN(j)  (2304 + 64 * (j))
#define XB_TOP      3328
#define XB_TOPGEN   3392
#define XCD_BAR_WORDS 3456
#define XB_SPIN_CAP (1u << 18)

__device__ __forceinline__ unsigned xb_ld(unsigned* p)              { return __hip_atomic_load(p, __ATOMIC_RELAXED, __HIP_MEMORY_SCOPE_AGENT); }
__device__ __forceinline__ unsigned xb_add(unsigned* p, unsigned v) { return __hip_atomic_fetch_add(p, v, __ATOMIC_RELAXED, __HIP_MEMORY_SCOPE_AGENT); }
__device__ __forceinline__ unsigned xb_xcc_id() { return (unsigned)__builtin_amdgcn_s_getreg((3 << 11) | 20) & 0xFu; }
#define XB_SPIN(cond, bar) do { unsigned _sp = 0; while (cond) { __builtin_amdgcn_s_sleep(1); \
    if ((++_sp & 255u) == 0u) { if (xb_ld(&(bar)[XB_TMO])) break; if (_sp > XB_SPIN_CAP) { atomicAdd(&(bar)[XB_TMO], 1u); break; } } } } while (0)

struct XcdBarrier {
    unsigned* bar; unsigned x;
    volatile LAS unsigned* st;
};

__device__ __forceinline__ XcdBarrier xcd_barrier_post(unsigned* bar, volatile LAS unsigned* st) {
    XcdBarrier b; b.bar = bar; b.x = xb_xcc_id(); b.st = st;
    if (threadIdx.x == 0) (void)xb_add(&bar[XB_XCNT(b.x)], 1u);
    return b;
}
__device__ __forceinline__ void xcd_barrier_complete(unsigned* bar, unsigned x, unsigned& nloc, unsigned& nx) {
    const unsigned G = gridDim.x * gridDim.y * gridDim.z;
    unsigned sum, cnt, mine, sp = 0u;
    for (;;) {
        sum = 0u; cnt = 0u; mine = 0u;
#pragma unroll
        for (unsigned j = 0; j < 16; ++j) { const unsigned c = xb_ld(&bar[XB_XCNT(j)]); sum += c; cnt += (c > 0u) ? 1u : 0u; mine = (j == x) ? c : mine; }
        if (sum == G) break;
        __builtin_amdgcn_s_sleep(1);
        if ((++sp & 255u) == 0u) { if (xb_ld(&bar[XB_TMO])) break; if (sp > XB_SPIN_CAP) { atomicAdd(&bar[XB_TMO], 1u); break; } }
    }
    nloc = mine > 0u ? mine : 1u; nx = cnt > 0u ? cnt : 1u;
}

__device__ __noinline__ void xcd_barrier_impl(unsigned* bar_, unsigned x_, volatile LAS unsigned* st_, int leader_) {
    XcdBarrier b; b.bar = bar_; b.x = x_; b.st = st_;
    asm volatile("s_waitcnt vmcnt(0)" ::: "memory");
    __syncthreads();
    if (leader_) {
        unsigned* bar = b.bar;
        __builtin_amdgcn_s_waitcnt(0);
        unsigned nloc = b.st[0], nx = b.st[1];
        if (nloc == 0u) { xcd_barrier_complete(bar, b.x, nloc, nx); b.st[0] = nloc; b.st[1] = nx; }
        const unsigned old = xb_add(&bar[XB_XSUB(b.x)], 1u);
        const unsigned gen = old / nloc;
        if (old + 1u == (gen + 1u) * nloc) {
            __builtin_amdgcn_fence(__ATOMIC_RELEASE, "agent");
            asm volatile("s_waitcnt vmcnt(0)" ::: "memory");
            const unsigned og = xb_add(&bar[XB_TOP], 1u);
            const unsigned tg = og / nx;
            if (og + 1u == (tg + 1u) * nx) xb_add(&bar[XB_TOPGEN], 1u);
            else XB_SPIN(xb_ld(&bar[XB_TOPGEN]) == tg, bar);
            __builtin_amdgcn_fence(__ATOMIC_ACQUIRE, "agent");
            xb_add(&bar[XB_XGEN(b.x)], 1u);
            asm volatile("s_waitcnt vmcnt(0)" ::: "memory");
        } else {
            XB_SPIN(xb_ld(&bar[XB_XGEN(b.x)]) == gen, bar);
            __builtin_amdgcn_fence(__ATOMIC_ACQUIRE, "agent");
            asm volatile("s_waitcnt vmcnt(0)" ::: "memory");
        }
    }
    __syncthreads();
}
__device__ __forceinline__ void xcd_barrier(const XcdBarrier& b, int leader) { xcd_barrier_impl(b.bar, b.x, b.st, leader); }


__device__ __forceinline__ float wave_sum(float v, int lane) {
#pragma unroll
    for (int o = 1; o < 64; o <<= 1) v += shx(v, o, lane);
    return v;
}
__device__ __forceinline__ float gelu_erf(float v) {
    const float av = __builtin_fabsf(v), t = __builtin_amdgcn_rcpf(av * 0.2316418882f + 1.0f);
    float q = t * 0.5307027145f + (-0.7265760135f); q = q * t + 0.7107068705f; q = q * t + (-0.142248368f); q = q * t + 0.127414796f; q = q * t;
    const float e = __builtin_amdgcn_exp2f((v * v) * (-0.72134752044f));
    const float m = v * (q * e);
    return v < 0.f ? m : v - m;
}

__device__ __forceinline__ void norm_phase(const GAS float* X, const GAS float* g, GAS bf16* out, int rows, int gw, int NGW, int lane) {
    asm volatile("" : "+v"(lane));
    f32x4 gv[4];
#pragma unroll
    for (int j = 0; j < 4; ++j) gv[j] = ((const GAS f32x4*)g)[lane + 64 * j];
    for (int m = gw; m < rows; m += NGW) {
        const GAS f32x4* xr = (const GAS f32x4*)(X + (size_t)m * D) + lane;
        f32x4 v[4]; float s = 0.f;
#pragma unroll
        for (int j = 0; j < 4; ++j) { v[j] = xr[64 * j]; s += (v[j].x * v[j].x + v[j].y * v[j].y) + (v[j].z * v[j].z + v[j].w * v[j].w); }
        const float rs = rsqrtf(wave_sum(s, lane) * (1.f / D) + 1e-6f);
        GAS v2u* o8 = (GAS v2u*)(out + (size_t)m * D) + lane;
#pragma unroll
        for (int j = 0; j < 4; ++j) { v2u w; w.x = pk2(v[j].x * rs * gv[j].x, v[j].y * rs * gv[j].y); w.y = pk2(v[j].z * rs * gv[j].z, v[j].w * rs * gv[j].w); o8[64 * j] = w; }
    }
}
__device__ __forceinline__ void hq_phase(const GAS bf16* XB, const GAS float* SSQ, const GAS float* g, GAS unsigned char* HQ, GAS float* SH, GAS int* Pz, int gw, int NGW, int lane) {
    asm volatile("" : "+v"(lane));
    const GAS f32x4* gp = (const GAS f32x4*)g + 4 * lane; const f32x4 g0 = gp[0], g1 = gp[1], g2 = gp[2], g3 = gp[3];
    for (int m = gw; m < T; m += NGW) {
        const GAS f32x4* sp = (const GAS f32x4*)(SSQ + (size_t)m * 16); const f32x4 t = (sp[0] + sp[1]) + (sp[2] + sp[3]);
        const float rs = __builtin_amdgcn_rsqf(((t[0] + t[1]) + (t[2] + t[3])) * (1.f / 1024.f) + 1e-6f);
        const v4u a = *(const GAS v4u*)(XB + (size_t)m * D + 16 * lane), b = *(const GAS v4u*)(XB + (size_t)m * D + 16 * lane + 8);
        float f[16] = {bflo(a.x) * g0[0], bfhi(a.x) * g0[1], bflo(a.y) * g0[2], bfhi(a.y) * g0[3], bflo(a.z) * g1[0], bfhi(a.z) * g1[1], bflo(a.w) * g1[2], bfhi(a.w) * g1[3],
                       bflo(b.x) * g2[0], bfhi(b.x) * g2[1], bflo(b.y) * g2[2], bfhi(b.y) * g2[3], bflo(b.z) * g3[0], bfhi(b.z) * g3[1], bflo(b.w) * g3[2], bfhi(b.w) * g3[3]};
        float mx = 0.f;
#pragma unroll
        for (int i = 0; i < 16; ++i) { f[i] *= rs; mx = fmaxf(mx, __builtin_fabsf(f[i])); }
#pragma unroll
        for (int o = 1; o < 64; o <<= 1) mx = fmaxf(mx, shx(mx, o, lane));
        const float inv = mx > 0.f ? 127.f / mx : 0.f;
        v4u q;
#pragma unroll
        for (int i = 0; i < 4; ++i) { const int ia = (int)__builtin_rintf(f[4 * i] * inv), ib = (int)__builtin_rintf(f[4 * i + 1] * inv), ic = (int)__builtin_rintf(f[4 * i + 2] * inv), id = (int)__builtin_rintf(f[4 * i + 3] * inv);
            q[i] = (unsigned)(ia & 255) | ((unsigned)(ib & 255) << 8) | ((unsigned)(ic & 255) << 16) | ((unsigned)(id & 255) << 24); }
        *(GAS v4u*)(HQ + (size_t)m * D + 16 * lane) = q;
        if (lane == 0) SH[m] = mx * (1.f / 127.f);
        (Pz + (size_t)m * 128)[lane] = 0; (Pz + (size_t)m * 128)[lane + 64] = 0;
    }
}
__device__ __forceinline__ void x0_phase(const GAS float* X, GAS bf16* XB, GAS float* SSQ, int gw, int NGW, int lane) {
    asm volatile("" : "+v"(lane));
    for (int m = gw; m < T; m += NGW) {
        const GAS f32x4* xr = (const GAS f32x4*)(X + (size_t)m * D) + lane; GAS v2u* o8 = (GAS v2u*)(XB + (size_t)m * D) + lane;
        float s = 0.f;
#pragma unroll
        for (int j = 0; j < 4; ++j) { const f32x4 v = xr[64 * j]; s += (v.x * v.x + v.y * v.y) + (v.z * v.z + v.w * v.w); v2u w; w.x = pk2(v.x, v.y); w.y = pk2(v.z, v.w); o8[64 * j] = w; }
        s = wave_sum(s, lane);
        if (lane < 8) SSQ[(size_t)m * 16 + lane] = lane == 0 ? s : 0.f;
    }
}
__device__ __forceinline__ void final_norm_phase(const GAS bf16* XB, GAS float* O, const GAS float* g, int rows, int gw, int NGW, int lane) {
    asm volatile("" : "+v"(lane));
    for (int m = gw; m < rows; m += NGW) {
        const GAS v4u* xr = (const GAS v4u*)(XB + (size_t)m * D) + lane;
        v4u v[2]; float s = 0.f;
#pragma unroll
        for (int j = 0; j < 2; ++j) { v[j] = xr[64 * j];
#pragma unroll
            for (int e = 0; e < 4; ++e) { const float a = bflo(v[j][e]), b = bfhi(v[j][e]); s += a * a + b * b; } }
        const float rs = rsqrtf(wave_sum(s, lane) * (1.f / D) + 1e-6f);
#pragma unroll
        for (int j = 0; j < 2; ++j) { const int c = 8 * (lane + 64 * j); const f32x4 g0 = *(const GAS f32x4*)(g + c), g1 = *(const GAS f32x4*)(g + c + 4);
            f32x4 o0, o1; o0.x = bflo(v[j].x) * rs * g0.x; o0.y = bfhi(v[j].x) * rs * g0.y; o0.z = bflo(v[j].y) * rs * g0.z; o0.w = bfhi(v[j].y) * rs * g0.w;
            o1.x = bflo(v[j].z) * rs * g1.x; o1.y = bfhi(v[j].z) * rs * g1.y; o1.z = bflo(v[j].w) * rs * g1.z; o1.w = bfhi(v[j].w) * rs * g1.w;
            *(GAS f32x4*)(O + (size_t)m * D + c) = o0; *(GAS f32x4*)(O + (size_t)m * D + c + 4) = o1; }
    }
}

__device__ __forceinline__ void pre_phase(const GAS bf16* PROJB, const GAS float* ROPE, GAS float* RS, GAS bf16* KMB, int gw, int NGW, int lane) {
    asm volatile("" : "+v"(lane));
    for (int t = gw; t < T; t += NGW) {
        const GAS bf16* pr = PROJB + (size_t)t * INP;
        float sq = 0.f, skv = 0.f;
        if (lane < 24) { const v4u w = *(const GAS v4u*)(pr + PC_CQ + 8 * lane);
            const float a0 = bflo(w.x), a1 = bfhi(w.x), a2 = bflo(w.y), a3 = bfhi(w.y), a4 = bflo(w.z), a5 = bfhi(w.z), a6 = bflo(w.w), a7 = bfhi(w.w);
            sq = (a0 * a0 + a1 * a1) + (a2 * a2 + a3 * a3) + (a4 * a4 + a5 * a5) + (a6 * a6 + a7 * a7); }
        else if (lane >= 32 && lane < 48) { const v4u w = *(const GAS v4u*)(pr + PC_CKV + 8 * (lane - 32));
            const float a0 = bflo(w.x), a1 = bfhi(w.x), a2 = bflo(w.y), a3 = bfhi(w.y), a4 = bflo(w.z), a5 = bfhi(w.z), a6 = bflo(w.w), a7 = bfhi(w.w);
            skv = (a0 * a0 + a1 * a1) + (a2 * a2 + a3 * a3) + (a4 * a4 + a5 * a5) + (a6 * a6 + a7 * a7); }
        sq = wave_sum(sq, lane); skv = wave_sum(skv, lane);
        if (lane == 0) { RS[2 * (size_t)t] = rsqrtf(sq * (1.f / 192.f) + 1e-6f); RS[2 * (size_t)t + 1] = rsqrtf(skv * (1.f / 128.f) + 1e-6f); }
        if (lane < 16) {
            const float x1 = __builtin_bit_cast(float, (unsigned)pr[PC_KR + lane] << 16), x2 = __builtin_bit_cast(float, (unsigned)pr[PC_KR + 16 + lane] << 16);
            const float c = ROPE[(size_t)t * 32 + lane], sn = ROPE[(size_t)t * 32 + 16 + lane];
            const bf16 y1 = (bf16)f2bf_(x1 * c - x2 * sn), y2 = (bf16)f2bf_(x1 * sn + x2 * c);
            GAS bf16* kr = KMB + (size_t)t * 384 + 64 + lane;
#pragma unroll
            for (int h = 0; h < 4; ++h) { kr[h * 96] = y1; kr[h * 96 + 16] = y2; }
        }
    }
}

typedef short lr_bf16x8 __attribute__((ext_vector_type(8)));
typedef float lr_f32x16 __attribute__((ext_vector_type(16)));
__device__ __forceinline__ void lr_swap32(float& a, float& b) { asm volatile("v_nop\n\tv_nop\n\tv_permlane32_swap_b32 %0, %1" : "+v"(a), "+v"(b)); }
constexpr int LR_XR = 0, LR_CW = LR_XR + 37376, LR_XA = LR_CW + 1280, LR_WT = LR_XA + 256 * 144, LR_SUM = LR_WT + 2 * 64 * 144, LR_END = LR_SUM + 4096;
struct LruP { const GAS bf16* PROJB; const GAS float* cw; const GAS float* cb; const GAS bf16* wat; const GAS float* ba; const GAS float* bx; const GAS float* sp; GAS unsigned* HA; GAS float* LSUM; };
__device__ __forceinline__ void lru_phase(const LruP& P, LAS unsigned char* lds, int tid, int wave, int lane, int vcu, int G) {
    asm volatile("" : "+v"(tid), "+v"(lane));
    LAS float* SUM = (LAS float*)(lds + LR_SUM);
    for (int u = vcu; u < (T / 256) * 8; u += G) {
        const int tile = u >> 3, g = u & 7; const int t0 = tile * 256; const bool first = ((tile & 31) == 0);
        __syncthreads();
        { v4u wt_[2], xr_[5];
#pragma unroll
          for (int i = 0; i < 2; ++i) { const int idx = tid + 512 * i; wt_[i] = ((const GAS v4u*)(P.wat + (size_t)g * 2 * 4096))[idx]; }
#pragma unroll
          for (int i = 0; i < 5; ++i) { const int idx = tid + 512 * i, row = idx >> 3, part = idx & 7; const bool ok = (idx < 259 * 8) && !(first && row < 3);
              const int trow = ok ? t0 - 3 + row : t0;
              xr_[i] = *(const GAS v4u*)(P.PROJB + (size_t)trow * INP + PC_XL + 64 * g + 8 * part); if (!ok) xr_[i] = v4u{0u, 0u, 0u, 0u}; }
          float cwv = 0.f; if (tid < 320) cwv = (tid < 256) ? P.cw[(tid >> 6) * 512 + 64 * g + (tid & 63)] : P.cb[64 * g + (tid - 256)];
#pragma unroll
          for (int i = 0; i < 2; ++i) { const int idx = tid + 512 * i; *(LAS v4u*)(lds + LR_WT + (idx >> 9) * 9216 + ((idx >> 3) & 63) * 144 + (idx & 7) * 16) = wt_[i]; }
#pragma unroll
          for (int i = 0; i < 5; ++i) { const int idx = tid + 512 * i, row = idx >> 3, part = idx & 7; if (idx < 259 * 8) *(LAS v4u*)(lds + LR_XR + row * 144 + 16 * part) = xr_[i]; }
          if (tid < 320) ((LAS float*)(lds + LR_CW))[tid] = cwv; }
        __syncthreads();
        { float cwr[4][8], cbr[8];
#pragma unroll
          for (int k = 0; k < 4; ++k) { const f32x4 c0 = *(const LAS f32x4*)(lds + LR_CW + (k * 64 + 8 * wave) * 4), c1 = *(const LAS f32x4*)(lds + LR_CW + (k * 64 + 8 * wave + 4) * 4);
              cwr[k][0] = c0.x; cwr[k][1] = c0.y; cwr[k][2] = c0.z; cwr[k][3] = c0.w; cwr[k][4] = c1.x; cwr[k][5] = c1.y; cwr[k][6] = c1.z; cwr[k][7] = c1.w; }
          { const f32x4 c0 = *(const LAS f32x4*)(lds + LR_CW + (256 + 8 * wave) * 4), c1 = *(const LAS f32x4*)(lds + LR_CW + (256 + 8 * wave + 4) * 4);
            cbr[0] = c0.x; cbr[1] = c0.y; cbr[2] = c0.z; cbr[3] = c0.w; cbr[4] = c1.x; cbr[5] = c1.y; cbr[6] = c1.z; cbr[7] = c1.w; }
#pragma unroll
          for (int it_ = 0; it_ < 4; ++it_) { const int time = lane + 64 * it_;
              float y[8];
#pragma unroll
              for (int e = 0; e < 8; ++e) y[e] = cbr[e];
#pragma unroll
              for (int k = 0; k < 4; ++k) { const v4u w = *(const LAS v4u*)(lds + LR_XR + (time + k) * 144 + 16 * wave);
                  y[0] += bflo(w.x) * cwr[k][0]; y[1] += bfhi(w.x) * cwr[k][1]; y[2] += bflo(w.y) * cwr[k][2]; y[3] += bfhi(w.y) * cwr[k][3];
                  y[4] += bflo(w.z) * cwr[k][4]; y[5] += bfhi(w.z) * cwr[k][5]; y[6] += bflo(w.w) * cwr[k][6]; y[7] += bfhi(w.w) * cwr[k][7]; }
              v4u o; o.x = pk2(y[0], y[1]); o.y = pk2(y[2], y[3]); o.z = pk2(y[4], y[5]); o.w = pk2(y[6], y[7]);
              *(LAS v4u*)(lds + LR_XA + time * 144 + 16 * wave) = o; } }
        __syncthreads();
        const int r32 = lane & 31, hi = lane >> 5;
        lr_f32x16 acc[2][2];
#pragma unroll
        for (int nt = 0; nt < 2; ++nt) { const float b_a = P.ba[64 * g + 32 * nt + r32], b_x = P.bx[64 * g + 32 * nt + r32];
#pragma unroll
            for (int r = 0; r < 16; ++r) { acc[0][nt][r] = b_a; acc[1][nt][r] = b_x; } }
        { lr_bf16x8 af[4];
#pragma unroll
          for (int s_ = 0; s_ < 4; ++s_) af[s_] = *(const LAS lr_bf16x8*)(lds + LR_XA + (32 * wave + r32) * 144 + (16 * s_ + 8 * hi) * 2);
#pragma unroll
          for (int gt = 0; gt < 2; ++gt)
#pragma unroll
              for (int nt = 0; nt < 2; ++nt)
#pragma unroll
                  for (int s_ = 0; s_ < 4; ++s_) { const lr_bf16x8 bfr = *(const LAS lr_bf16x8*)(lds + LR_WT + gt * 9216 + (32 * nt + r32) * 144 + (16 * s_ + 8 * hi) * 2);
                      acc[gt][nt] = __builtin_amdgcn_mfma_f32_32x32x16_bf16(af[s_], bfr, acc[gt][nt], 0, 0, 0); } }
#pragma unroll
        for (int nt = 0; nt < 2; ++nt) { const float sp = P.sp[64 * g + 32 * nt + r32];
            float sa_[4], sh_[4];
#pragma unroll
            for (int q = 0; q < 4; ++q) { float hrun = 0.f, arun = 1.f;
#pragma unroll
                for (int e = 0; e < 4; ++e) { const int r = 4 * q + e, tl = 8 * q + 4 * hi + e;
                    const float xv = __builtin_bit_cast(float, (unsigned)*(const LAS unsigned short*)(lds + LR_XA + (32 * wave + tl) * 144 + (32 * nt + r32) * 2) << 16);
                    const float rg = __builtin_amdgcn_rcpf(1.f + __builtin_amdgcn_exp2f(-LOG2E * acc[0][nt][r])), ig = __builtin_amdgcn_rcpf(1.f + __builtin_amdgcn_exp2f(-LOG2E * acc[1][nt][r]));
                    const float la = -8.0f * rg * sp; const float a_ = __builtin_amdgcn_exp2f(LOG2E * la);
                    const float uu = __builtin_amdgcn_sqrtf(fmaxf(1.f - a_ * a_, 0.f)) * (ig * xv);
                    hrun = a_ * hrun + uu; arun *= a_; acc[0][nt][r] = arun; acc[1][nt][r] = hrun; }
                sa_[q] = arun; sh_[q] = hrun; }
            float runA = 1.f, runH = 0.f;
#pragma unroll
            for (int q = 0; q < 4; ++q) { float a0 = sa_[q], a1 = sa_[q], h0 = sh_[q], h1 = sh_[q]; lr_swap32(a0, a1); lr_swap32(h0, h1);
                const float midA = runA * a0, midH = a0 * runH + h0;
                const float inA = hi ? midA : runA, inH = hi ? midH : runH;
                runA = midA * a1; runH = a1 * midH + h1;
#pragma unroll
                for (int e = 0; e < 4; ++e) { const int r = 4 * q + e; acc[1][nt][r] += acc[0][nt][r] * inH; acc[0][nt][r] *= inA; } }
            if (hi == 0) { SUM[(wave * 64 + 32 * nt + r32) * 2] = runA; SUM[(wave * 64 + 32 * nt + r32) * 2 + 1] = runH; } }
        __syncthreads();
#pragma unroll
        for (int nt = 0; nt < 2; ++nt) { const int cl = 32 * nt + r32;
            float ca = 1.f, chh = 0.f;
            for (int w = 0; w < wave; ++w) { const float aw = SUM[(w * 64 + cl) * 2], hw = SUM[(w * 64 + cl) * 2 + 1]; chh = aw * chh + hw; ca *= aw; }
            GAS unsigned* ha = P.HA + (size_t)(t0 + 32 * wave + 4 * hi) * 512 + 64 * g + cl;
#pragma unroll
            for (int r = 0; r < 16; ++r) { const float hh = acc[1][nt][r] + acc[0][nt][r] * chh, ac_ = acc[0][nt][r] * ca; ha[(size_t)((r & 3) + 8 * (r >> 2)) * 512] = pk2(hh, ac_);
                if (r == 15 && wave == 7 && hi == 1) { P.LSUM[((size_t)tile * 512 + 64 * g + cl) * 2] = ac_; P.LSUM[((size_t)tile * 512 + 64 * g + cl) * 2 + 1] = hh; } } }
    }
}

struct PostP { const GAS bf16* OMB; const GAS unsigned* HA; const GAS float* LSUM; const GAS bf16* PROJB; const GAS float* gm; const GAS float* gl; GAS bf16* Y; };
__device__ __forceinline__ void post_phase(const PostP& P, LAS unsigned char* lds, int tid, int wave, int lane, int vcu, int G) {
    asm volatile("" : "+v"(tid), "+v"(lane));
    LAS float* hin = (LAS float*)lds;
    for (int u = vcu; u < T / 64; u += G) {
        const int t0 = u * 64, tile = t0 >> 8, tb = tile & ~31;
        __syncthreads();
        { float h = 0.f;
          for (int c = tb; c < tile; ++c) { const float a = P.LSUM[((size_t)c * 512 + tid) * 2], hh = P.LSUM[((size_t)c * 512 + tid) * 2 + 1]; h = a * h + hh; }
          hin[tid] = h; }
        __syncthreads();
        f32x4 hi0 = *(const LAS f32x4*)(hin + 8 * lane), hi1 = *(const LAS f32x4*)(hin + 8 * lane + 4);
        const f32x4 g0 = *(const GAS f32x4*)(P.gl + 8 * lane), g1 = *(const GAS f32x4*)(P.gl + 8 * lane + 4), gmv = *(const GAS f32x4*)(P.gm + 4 * lane);
#pragma unroll 2
        for (int i = 0; i < 8; ++i) {
            const size_t t = (size_t)t0 + 8 * wave + i;
            const v4u p0 = *(const GAS v4u*)(P.HA + t * 512 + 8 * lane), p1 = *(const GAS v4u*)(P.HA + t * 512 + 8 * lane + 4), gw_ = *(const GAS v4u*)(P.PROJB + t * INP + PC_GL + 8 * lane);
            const v2u mw = *(const GAS v2u*)(P.OMB + t * 256 + 4 * lane);
            float o[8];
            o[0] = (bflo(p0.x) + bfhi(p0.x) * hi0.x) * gelu_erf(bflo(gw_.x)); o[1] = (bflo(p0.y) + bfhi(p0.y) * hi0.y) * gelu_erf(bfhi(gw_.x));
            o[2] = (bflo(p0.z) + bfhi(p0.z) * hi0.z) * gelu_erf(bflo(gw_.y)); o[3] = (bflo(p0.w) + bfhi(p0.w) * hi0.w) * gelu_erf(bfhi(gw_.y));
            o[4] = (bflo(p1.x) + bfhi(p1.x) * hi1.x) * gelu_erf(bflo(gw_.z)); o[5] = (bflo(p1.y) + bfhi(p1.y) * hi1.y) * gelu_erf(bfhi(gw_.z));
            o[6] = (bflo(p1.z) + bfhi(p1.z) * hi1.z) * gelu_erf(bflo(gw_.w)); o[7] = (bflo(p1.w) + bfhi(p1.w) * hi1.w) * gelu_erf(bfhi(gw_.w));
            float s2 = 0.f;
#pragma unroll
            for (int e = 0; e < 8; ++e) s2 += o[e] * o[e];
            const float m0 = bflo(mw.x), m1 = bfhi(mw.x), m2 = bflo(mw.y), m3 = bfhi(mw.y);
            float s1 = (m0 * m0 + m1 * m1) + (m2 * m2 + m3 * m3);
            s1 = wave_sum(s1, lane); s2 = wave_sum(s2, lane);
            const float r1 = rsqrtf(s1 * (1.f / 256.f) + 1e-6f), r2 = rsqrtf(s2 * (1.f / 512.f) + 1e-6f);
            GAS bf16* yr = P.Y + t * 1024;
            { v2u w; w.x = pk2(m0 * r1 * gmv.x, m1 * r1 * gmv.y); w.y = pk2(m2 * r1 * gmv.z, m3 * r1 * gmv.w); *(GAS v2u*)(yr + 4 * lane) = w; }
            { v4u w; w.x = pk2(o[0] * r2 * g0.x, o[1] * r2 * g0.y); w.y = pk2(o[2] * r2 * g0.z, o[3] * r2 * g0.w); w.z = pk2(o[4] * r2 * g1.x, o[5] * r2 * g1.y); w.w = pk2(o[6] * r2 * g1.z, o[7] * r2 * g1.w);
              *(GAS v4u*)(yr + 256 + 8 * lane) = w; }
        }
    }
}

#define TILE_BAR() asm volatile("s_waitcnt lgkmcnt(0)\n\ts_barrier" ::: "memory")
typedef short bf16x8 __attribute__((ext_vector_type(8)));
typedef short s16x4 __attribute__((ext_vector_type(4)));
typedef float f32x16 __attribute__((ext_vector_type(16)));
typedef unsigned u32x4 __attribute__((ext_vector_type(4)));
__device__ __forceinline__ int crow(int r, int hi) { return (r & 3) + 8 * (r >> 2) + 4 * hi; }
typedef float f32x2_t __attribute__((ext_vector_type(2))); typedef __bf16 bf16x2_c __attribute__((ext_vector_type(2)));
__device__ __forceinline__ unsigned cvtpk(float lo, float hi) { f32x2_t v = {lo, hi}; bf16x2_c b = __builtin_convertvector(v, bf16x2_c); return __builtin_bit_cast(unsigned, b); }
__device__ __forceinline__ float swapmax(float m) { auto rr = __builtin_amdgcn_permlane32_swap(__float_as_uint(m), __float_as_uint(m), false, false); return fmaxf(__uint_as_float(rr[0]), __uint_as_float(rr[1])); }
__device__ __forceinline__ float swapadd(float m) { auto rr = __builtin_amdgcn_permlane32_swap(__float_as_uint(m), __float_as_uint(m), false, false); return __uint_as_float(rr[0]) + __uint_as_float(rr[1]); }
__device__ __forceinline__ s16x4 vtr(const LAS unsigned char* p) { return __builtin_bit_cast(s16x4, __builtin_amdgcn_ds_read_tr16_b64_v4i16((LAS s16x4*)p)); }
__device__ __forceinline__ bf16x8 pack8(const f32x16& p, int b) { u32x4 w; w.x = cvtpk(p[b], p[b + 1]); w.y = cvtpk(p[b + 2], p[b + 3]); w.z = cvtpk(p[b + 4], p[b + 5]); w.w = cvtpk(p[b + 6], p[b + 7]); return __builtin_bit_cast(bf16x8, w); }
__device__ __forceinline__ float vmax3(float a, float b, float c) { float r; asm("v_max3_f32 %0, %1, %2, %3" : "=v"(r) : "v"(a), "v"(b), "v"(c)); return r; }
__device__ __forceinline__ float max32(const f32x16& p, const f32x16& q) {
    float a = vmax3(p[0], p[1], p[2]), b = vmax3(p[3], p[4], p[5]), c = vmax3(p[6], p[7], p[8]), d = vmax3(p[9], p[10], p[11]), e = vmax3(p[12], p[13], p[14]);
    float f = vmax3(q[0], q[1], q[2]), g = vmax3(q[3], q[4], q[5]), h = vmax3(q[6], q[7], q[8]), i = vmax3(q[9], q[10], q[11]), j = vmax3(q[12], q[13], q[14]);
    a = vmax3(a, b, c); d = vmax3(d, e, p[15]); f = vmax3(f, g, h); i = vmax3(i, j, q[15]);
    return vmax3(vmax3(a, d, f), i, i);
}
__device__ __forceinline__ float max16(const f32x16& p) { float a = fmaxf(fmaxf(p[0], p[1]), fmaxf(p[2], p[3])), b = fmaxf(fmaxf(p[4], p[5]), fmaxf(p[6], p[7])), c = fmaxf(fmaxf(p[8], p[9]), fmaxf(p[10], p[11])), d = fmaxf(fmaxf(p[12], p[13]), fmaxf(p[14], p[15])); return fmaxf(fmaxf(a, b), fmaxf(c, d)); }

struct AttnP {
    const GAS bf16* Q; const GAS bf16* K; const GAS bf16* V; int qp, kp, vp;
    GAS bf16* O; int op;
    const GAS float* rope;
    const GAS int* pos; const GAS float* btab; const GAS float* dnorm; const GAS float* lams;
};
template <int KIND> struct AK {
    static constexpr bool DIFF = KIND == 1, CROSS = KIND == 2;
    static constexpr int HW = KIND == 0 ? 96 : KIND == 1 ? 64 : 256;
    static constexpr int NKS = KIND == 0 ? 6 : KIND == 1 ? 2 : 16;
    static constexpr int KP = KIND == 0 ? 208 : KIND == 1 ? 144 : 528;
    static constexpr int ND = CROSS ? 4 : 2;
    static constexpr int CPK = HW / 8, KCH = (64 * CPK + 511) / 512;
    static constexpr int VCH = ND / 2;
    static constexpr int KB = 64 * KP, VB = ND * 4096;
    static constexpr int NBUF = CROSS ? 2 : 3;
    static constexpr int K0 = 0, V0 = NBUF * KB, POS = V0 + NBUF * VB, BT = POS + 1024, DN = BT + 528, END = DN + 256;
};
static_assert(AK<2>::END <= RING_BYTES && AK<0>::END <= RING_BYTES && AK<1>::END + 16 + 8 * 8192 <= RING_BYTES, "attention LDS");

template <int KIND, bool LEAD>
__device__ __forceinline__ void attn_unit(const AttnP& P, int b, int h, int qb, int dhalf, LAS unsigned char* lds, int tid, int wave, int lane) {
    lane = lane_id_v(); tid = (wave << 6) | lane;
    typedef AK<KIND> C;
    constexpr bool DIFF = C::DIFF, CROSS = C::CROSS;
    constexpr int HW = C::HW, NKS = C::NKS, KP = C::KP, ND = C::ND, CPK = C::CPK, KCH = C::KCH, VCH = C::VCH;
    const int r32 = lane & 31, hi = lane >> 5;
    const size_t rowb = (size_t)b * S, rowk = CROSS ? (size_t)b * MEM : rowb;
    const int q0w = qb * 256 + wave * 32, qi = q0w + r32;
    int pq = 0; float bias_far = 0.f;
    __syncthreads();
    if (DIFF) {
        pq = P.pos[rowb + qi];
        if (tid < 129) ((LAS float*)(lds + C::BT))[tid] = P.btab[h * 129 + tid];
        if (tid >= 192 && tid < 256) ((LAS float*)(lds + C::DN))[tid - 192] = P.dnorm[tid - 192];
    }
    int minq = pq;
    if (DIFF) { for (int o = 1; o < 64; o <<= 1) { const int v = shxi(minq, o, lane); minq = v < minq ? v : minq; } }
    const int NT = CROSS ? MEM / 64 : 4 * (qb + 1);
    u32x4 kr[KCH], vr[VCH]; int pkr = 0;
    u32x4 kr2[CROSS ? 1 : KCH], vr2[CROSS ? 1 : VCH]; int pkr2 = 0;
    const GAS bf16* Kb = P.K + rowk * P.kp + h * HW; const GAS bf16* Vb = P.V + rowk * P.vp + (CROSS ? h * 256 + dhalf * 128 : h * 64);
    const __amdgpu_buffer_rsrc_t rK = __builtin_amdgcn_make_buffer_rsrc((void*)Kb, 0, 0x7fffffff, 0x00020000), rV = __builtin_amdgcn_make_buffer_rsrc((void*)Vb, 0, 0x7fffffff, 0x00020000);
    const __amdgpu_buffer_rsrc_t rP = __builtin_amdgcn_make_buffer_rsrc((void*)(DIFF ? P.pos + rowb : (const GAS int*)Kb), 0, 0x7fffffff, 0x00020000);
    int kvo[KCH], vvo[VCH];
#pragma unroll
    for (int i = 0; i < KCH; ++i) { int c = tid + 512 * i; c = c < 64 * CPK ? c : tid; kvo[i] = ((c / CPK) * P.kp + (c % CPK) * 8) * 2; }
#pragma unroll
    for (int i = 0; i < VCH; ++i) { const int c = tid + 512 * i; vvo[i] = ((c / (4 * ND)) * P.vp + (c % (4 * ND)) * 8) * 2; }
    const int pvo = (tid & 63) * 4;
    auto gload = [&](int t) {
        const int ks = __builtin_amdgcn_readfirstlane(64 * t * P.kp * 2), vs = __builtin_amdgcn_readfirstlane(64 * t * P.vp * 2);
#pragma unroll
        for (int i = 0; i < KCH; ++i) kr[i] = __builtin_amdgcn_raw_buffer_load_b128(rK, kvo[i], ks, 0);
#pragma unroll
        for (int i = 0; i < VCH; ++i) vr[i] = __builtin_amdgcn_raw_buffer_load_b128(rV, vvo[i], vs, 0);
        if (DIFF) pkr = __builtin_amdgcn_raw_buffer_load_b32(rP, pvo, __builtin_amdgcn_readfirstlane(64 * t * 4), 0);
    };
    auto lstore = [&](int buf) {
        LAS unsigned char* kb_ = lds + C::K0 + buf * C::KB; LAS unsigned char* vb_ = lds + C::V0 + buf * C::VB;
#pragma unroll
        for (int i = 0; i < KCH; ++i) { int c = tid + 512 * i; c = c < 64 * CPK ? c : tid; const int key = c / CPK, part = c % CPK; *(LAS u32x4*)(kb_ + key * KP + part * 16) = kr[i]; }
#pragma unroll
        for (int i = 0; i < VCH; ++i) { const int c = tid + 512 * i; const int key = c / (4 * ND), part = c % (4 * ND); *(LAS u32x4*)(vb_ + (part >> 2) * 4096 + (key >> 3) * 512 + (key & 7) * 64 + (part & 3) * 16) = vr[i]; }
        if (DIFF) { ((LAS int*)(lds + C::POS + buf * 256))[tid & 63] = pkr; if (tid < 64) { int mk_ = pkr; for (int o = 1; o < 64; o <<= 1) { const int v = shxi(mk_, o, lane); mk_ = v > mk_ ? v : mk_; } if (tid == 0) ((LAS int*)(lds + C::POS + 768))[buf] = mk_; } }
    };
    auto gloadB = [&](int t) {
        const int ks = __builtin_amdgcn_readfirstlane(64 * t * P.kp * 2), vs = __builtin_amdgcn_readfirstlane(64 * t * P.vp * 2);
#pragma unroll
        for (int i = 0; i < (CROSS ? 1 : KCH); ++i) kr2[i] = __builtin_amdgcn_raw_buffer_load_b128(rK, kvo[i], ks, 0);
#pragma unroll
        for (int i = 0; i < (CROSS ? 1 : VCH); ++i) vr2[i] = __builtin_amdgcn_raw_buffer_load_b128(rV, vvo[i], vs, 0);
        if (DIFF) pkr2 = __builtin_amdgcn_raw_buffer_load_b32(rP, pvo, __builtin_amdgcn_readfirstlane(64 * t * 4), 0);
    };
    auto lstoreB = [&](int buf) {
        LAS unsigned char* kb_ = lds + C::K0 + buf * C::KB; LAS unsigned char* vb_ = lds + C::V0 + buf * C::VB;
#pragma unroll
        for (int i = 0; i < (CROSS ? 1 : KCH); ++i) { int c = tid + 512 * i; c = c < 64 * CPK ? c : tid; const int key = c / CPK, part = c % CPK; *(LAS u32x4*)(kb_ + key * KP + part * 16) = kr2[i]; }
#pragma unroll
        for (int i = 0; i < (CROSS ? 1 : VCH); ++i) { const int c = tid + 512 * i; const int key = c / (4 * ND), part = c % (4 * ND); *(LAS u32x4*)(vb_ + (part >> 2) * 4096 + (key >> 3) * 512 + (key & 7) * 64 + (part & 3) * 16) = vr2[i]; }
        if (DIFF) { ((LAS int*)(lds + C::POS + buf * 256))[tid & 63] = pkr2; if (tid < 64) { int mk_ = pkr2; for (int o = 1; o < 64; o <<= 1) { const int v = shxi(mk_, o, lane); mk_ = v > mk_ ? v : mk_; } if (tid == 0) ((LAS int*)(lds + C::POS + 768))[buf] = mk_; } }
    };
    LAS float* osv = (LAS float*)(lds + ((C::END + 15) & ~15)) + wave * 2048 + lane;
    float il = 0.f;
    f32x16 oA[ND];
#pragma unroll 1
    for (int mp = 0; mp < (DIFF ? 2 : 1); ++mp) {
        bf16x8 qf[NKS];
        { const GAS bf16* qrow = P.Q + (rowb + qi) * P.qp + h * HW + mp * 32;
#pragma unroll
          for (int s = 0; s < NKS; ++s) qf[s] = *(const GAS bf16x8*)(qrow + 16 * s + 8 * hi);
          if (KIND == 0) {
              const GAS float* rp = P.rope + (rowb + qi) * 32 + 8 * hi;
              const f32x4 c0 = *(const GAS f32x4*)rp, c1 = *(const GAS f32x4*)(rp + 4), s0 = *(const GAS f32x4*)(rp + 16), s1 = *(const GAS f32x4*)(rp + 20);
              const u32x4 a = __builtin_bit_cast(u32x4, qf[NKS - 2]), bq = __builtin_bit_cast(u32x4, qf[NKS - 1]); u32x4 ra, rb;
#pragma unroll
              for (int w = 0; w < 4; ++w) { const float cl = w < 2 ? c0[2 * w] : c1[2 * w - 4], ch = w < 2 ? c0[2 * w + 1] : c1[2 * w - 3], sl = w < 2 ? s0[2 * w] : s1[2 * w - 4], sh = w < 2 ? s0[2 * w + 1] : s1[2 * w - 3];
                  const float x1l = bflo(a[w]), x1h = bfhi(a[w]), x2l = bflo(bq[w]), x2h = bfhi(bq[w]);
                  ra[w] = cvtpk(x1l * cl - x2l * sl, x1h * ch - x2h * sh); rb[w] = cvtpk(x1l * sl + x2l * cl, x1h * sh + x2h * ch); }
              qf[NKS - 2] = __builtin_bit_cast(bf16x8, ra); qf[NKS - 1] = __builtin_bit_cast(bf16x8, rb);
          } }
        __syncthreads();
        float m1 = -1e30f, l1 = 0.f;
#pragma unroll
        for (int d = 0; d < ND; ++d)
#pragma unroll
            for (int r = 0; r < 16; ++r) oA[d][r] = 0.f;
        auto qk = [&](int sl, f32x16& sa, f32x16& sb, float init) {
            const LAS unsigned char* kb_ = lds + C::K0 + sl * C::KB + r32 * KP + hi * 16 + mp * 64;
#pragma unroll
            for (int r = 0; r < 16; ++r) { sa[r] = init; sb[r] = init; }
            constexpr int HB = CROSS ? 4 : (NKS > 3 ? 3 : NKS);
#pragma unroll
            for (int s0_ = 0; s0_ < NKS; s0_ += HB) {
                bf16x8 kfa[HB], kfb[HB];
#pragma unroll
                for (int s = 0; s < HB; ++s) { kfa[s] = *(const LAS bf16x8*)(kb_ + (s0_ + s) * 32); kfb[s] = *(const LAS bf16x8*)(kb_ + 32 * KP + (s0_ + s) * 32); }
                __builtin_amdgcn_sched_barrier(0);
#pragma unroll
                for (int s = 0; s < HB; ++s) { sa = __builtin_amdgcn_mfma_f32_32x32x16_bf16(kfa[s], qf[s0_ + s], sa, 0, 0, 0); sb = __builtin_amdgcn_mfma_f32_32x32x16_bf16(kfb[s], qf[s0_ + s], sb, 0, 0, 0); }
                __builtin_amdgcn_sched_barrier(0);
            }
        };
        auto isnear = [&](int sl) { bool nb = false;
            if (DIFF) { const int mk_ = __builtin_amdgcn_readfirstlane(((LAS int*)(lds + C::POS + 768))[sl]); nb = (minq - mk_) < 128; }
            return nb; };
        auto sm = [&](int t, int sl, f32x16& pa, f32x16& pb, bool nearb) -> float {
            const int k0 = 64 * t;
            if (DIFF) { if (nearb) {
                const LAS int* pk = (const LAS int*)(lds + C::POS + sl * 256); const LAS float* bt = (const LAS float*)(lds + C::BT);
#pragma unroll
                for (int r = 0; r < 16; ++r) { const int kk = crow(r, hi);
                    int n0 = pq - pk[kk], n1 = pq - pk[kk + 32]; n0 = n0 < 0 ? 0 : (n0 > 128 ? 128 : n0); n1 = n1 < 0 ? 0 : (n1 > 128 ? 128 : n1);
                    pa[r] += bt[n0]; pb[r] += bt[n1]; }
            } }
            if (!CROSS && k0 + 63 > q0w) {
#pragma unroll
                for (int r = 0; r < 16; ++r) { const int kk = k0 + crow(r, hi); if (kk > qi) pa[r] = -1e30f; if (kk + 32 > qi) pb[r] = -1e30f; }
            }
            asm volatile("s_nop 15\n\ts_nop 7" : "+v"(pa), "+v"(pb));
            float mn, al = 1.f;
            if (CROSS) { const float mx = swapmax(max32(pa, pb)); mn = fmaxf(m1, mx); al = __builtin_amdgcn_exp2f(m1 - mn); l1 *= al; }
            else { const float mx = swapmax(max32(pa, pb)); const bool up = mx > m1 + 8.0f; mn = up ? mx : m1;
                   if (__builtin_amdgcn_ballot_w64(up) != 0ull) { al = __builtin_amdgcn_exp2f(m1 - mn); l1 *= al; } }
            m1 = mn;
            float ls = 0.f;
#pragma unroll
            for (int r = 0; r < 16; ++r) { pa[r] = __builtin_amdgcn_exp2f(pa[r] - mn); pb[r] = __builtin_amdgcn_exp2f(pb[r] - mn); ls += pa[r] + pb[r]; }
            l1 += ls;
            return al;
        };
        auto pv = [&](int sl, const f32x16& pa, const f32x16& pb, float al) {
            const LAS unsigned char* vb_ = lds + C::V0 + sl * C::VB + ((lane >> 4) & 1) * 32 + (lane & 3) * 8 + (4 * hi + ((lane & 15) >> 2)) * 64;
            bf16x8 pf[4];
            pf[0] = pack8(pa, 0); pf[1] = pack8(pa, 8); pf[2] = pack8(pb, 0); pf[3] = pack8(pb, 8);
            const bool resc = CROSS ? true : (__builtin_amdgcn_ballot_w64(al != 1.0f) != 0ull);
            if (CROSS) {
#pragma unroll
                for (int d = 0; d < ND; ++d) {
                    __builtin_amdgcn_sched_barrier(0);
#pragma unroll
                    for (int r = 0; r < 16; ++r) oA[d][r] *= al;
                    bf16x8 vf[4];
#pragma unroll
                    for (int s = 0; s < 4; ++s) { const s16x4 lo = vtr(vb_ + d * 4096 + s * 1024), hh = vtr(vb_ + d * 4096 + s * 1024 + 512); vf[s] = (bf16x8){lo[0], lo[1], lo[2], lo[3], hh[0], hh[1], hh[2], hh[3]}; }
#pragma unroll
                    for (int s = 0; s < 4; ++s) oA[d] = __builtin_amdgcn_mfma_f32_32x32x16_bf16(vf[s], pf[s], oA[d], 0, 0, 0);
                }
            } else if (DIFF) {
                if (resc) {
#pragma unroll
                    for (int d = 0; d < 2; ++d)
#pragma unroll
                        for (int r = 0; r < 16; ++r) oA[d][r] *= al;
                }
#pragma unroll
                for (int d = 0; d < 2; ++d) {
                    bf16x8 vf[4];
#pragma unroll
                    for (int s = 0; s < 4; ++s) { const s16x4 lo = vtr(vb_ + d * 4096 + s * 1024), hh = vtr(vb_ + d * 4096 + s * 1024 + 512); vf[s] = (bf16x8){lo[0], lo[1], lo[2], lo[3], hh[0], hh[1], hh[2], hh[3]}; }
                    __builtin_amdgcn_sched_barrier(0);
#pragma unroll
                    for (int s = 0; s < 4; ++s) oA[d] = __builtin_amdgcn_mfma_f32_32x32x16_bf16(vf[s], pf[s], oA[d], 0, 0, 0);
                }
            } else {
                bf16x8 vf[2][4];
#pragma unroll
                for (int d = 0; d < 2; ++d)
#pragma unroll
                    for (int s = 0; s < 4; ++s) { const s16x4 lo = vtr(vb_ + d * 4096 + s * 1024), hh = vtr(vb_ + d * 4096 + s * 1024 + 512); vf[d][s] = (bf16x8){lo[0], lo[1], lo[2], lo[3], hh[0], hh[1], hh[2], hh[3]}; }
                if (resc) {
#pragma unroll
                    for (int d = 0; d < 2; ++d)
#pragma unroll
                        for (int r = 0; r < 16; ++r) oA[d][r] *= al;
                }
                __builtin_amdgcn_sched_barrier(0);
#pragma unroll
                for (int s = 0; s < 4; ++s)
#pragma unroll
                    for (int d = 0; d < 2; ++d) oA[d] = __builtin_amdgcn_mfma_f32_32x32x16_bf16(vf[d][s], pf[s], oA[d], 0, 0, 0);
            }
        };
        if (CROSS) {
            gload(0); lstore(0);
            __syncthreads();
            for (int t = 0; t < NT; ++t) {
                const int buf = t & 1;
                f32x16 pa, pb;
                qk(buf, pa, pb, 0.f);
                const float al = sm(t, buf, pa, pb, false);
                pv(buf, pa, pb, al);
                if (t + 1 < NT) { gload(t + 1); lstore(buf ^ 1); }
                TILE_BAR();
            }
        } else {
            gload(0); lstore(0); gload(1); lstore(1);
            gload(2); gloadB(3);
            __syncthreads();
            if (DIFF) bias_far = ((LAS float*)(lds + C::BT))[128];
            const int NTW = (q0w + 31) / 64 + 1;
            constexpr bool lead = LEAD;
            f32x16 ca, cb, na, nb; bool cnear = isnear(0), nnear = false; float cal = 1.f;
            qk(0, ca, cb, (DIFF && !cnear) ? bias_far : 0.f);
            if (lead) cal = sm(0, 0, ca, cb, cnear);
            int s0 = 0, s1 = 1, s2 = 2;
            auto period = [&](int t, f32x16& xa, f32x16& xb, bool& xnear, f32x16& ya, f32x16& yb, bool& ynear) {
                const bool have_next = (t + 1 < NTW);
                if (lead) {
                    if (have_next) { ynear = isnear(s1); qk(s1, ya, yb, (DIFF && !ynear) ? bias_far : 0.f); }
                    if (t < NTW) pv(s0, xa, xb, cal);
                    if (have_next) cal = sm(t + 1, s1, ya, yb, ynear);
                } else {
                    if (t < NTW) cal = sm(t, s0, xa, xb, xnear);
                    if (have_next) { ynear = isnear(s1); qk(s1, ya, yb, (DIFF && !ynear) ? bias_far : 0.f); }
                    if (t < NTW) pv(s0, xa, xb, cal);
                }
                { const int tmp = s0; s0 = s1; s1 = s2; s2 = tmp; }
            };
            int t = 0;
            for (; t + 5 < NT; t += 2) {
                lstore(s2); gload(t + 4);
                period(t, ca, cb, cnear, na, nb, nnear);
                TILE_BAR();
                lstoreB(s2); gloadB(t + 5);
                period(t + 1, na, nb, nnear, ca, cb, cnear);
                TILE_BAR();
            }
            for (; t < NT; t += 2) {
                if (t + 2 < NT) { lstore(s2); if (t + 4 < NT) gload(t + 4); }
                period(t, ca, cb, cnear, na, nb, nnear);
                TILE_BAR();
                if (t + 3 < NT) { lstoreB(s2); if (t + 5 < NT) gloadB(t + 5); }
                period(t + 1, na, nb, nnear, ca, cb, cnear);
                TILE_BAR();
            }
        }
        il = 1.f / swapadd(l1);
        if (DIFF) { if (mp == 0) {
#pragma unroll
            for (int d = 0; d < 2; ++d)
#pragma unroll
                for (int r = 0; r < 16; ++r) osv[(d * 16 + r) * 64] = oA[d][r] * il; } }
    }
    GAS bf16* orow = P.O + (rowb + qi) * P.op + (CROSS ? h * 256 + dhalf * 128 : h * 64);
    if (!DIFF) {
#pragma unroll
        for (int d = 0; d < ND; ++d)
#pragma unroll
            for (int g = 0; g < 4; ++g) { v2u v; v.x = cvtpk(oA[d][4 * g] * il, oA[d][4 * g + 1] * il); v.y = cvtpk(oA[d][4 * g + 2] * il, oA[d][4 * g + 3] * il); *(GAS v2u*)(orow + 32 * d + 8 * g + 4 * hi) = v; }
    } else {
        const float lam = P.lams[0], lam_init = P.lams[1];
        const float i2 = lam * il;
        float ss = 0.f;
#pragma unroll
        for (int d = 0; d < 2; ++d)
#pragma unroll
            for (int r = 0; r < 16; ++r) { const float v = osv[(d * 16 + r) * 64] - oA[d][r] * i2; oA[d][r] = v; ss += v * v; }
        ss = swapadd(ss);
        const float rs = __builtin_amdgcn_rsqf(ss * (1.f / 64.f) + 1e-6f) * (1.f - lam_init);
        const LAS float* dn = (const LAS float*)(lds + C::DN);
#pragma unroll
        for (int d = 0; d < 2; ++d)
#pragma unroll
            for (int g = 0; g < 4; ++g) { const int c = 32 * d + 8 * g + 4 * hi; const f32x4 gn = *(const LAS f32x4*)(dn + c);
                v2u v; v.x = cvtpk(oA[d][4 * g] * rs * gn[0], oA[d][4 * g + 1] * rs * gn[1]); v.y = cvtpk(oA[d][4 * g + 2] * rs * gn[2], oA[d][4 * g + 3] * rs * gn[3]); *(GAS v2u*)(orow + c) = v; }
    }
}

template <int KIND> struct AK2 {
    static constexpr bool DIFF = KIND == 1;
    static constexpr int HW = KIND == 0 ? 96 : 64, NKS = KIND == 0 ? 6 : 2, KP = KIND == 0 ? 208 : 144;
    static constexpr int CPK = HW / 8, KCH = (128 * CPK) / 512, VCH = 2;
    static constexpr int KB = 128 * KP, VB = 2 * 8192;
    static constexpr int K0 = 0, V0 = 2 * KB, POS = V0 + 2 * VB, PMX = POS + 1024, BT = PMX + 16, DN = BT + 528, OSV = (DN + 256 + 15) & ~15, END = OSV + (DIFF ? 8 * 8192 : 0);
};
static_assert(AK2<0>::END <= RING_BYTES && AK2<1>::END <= RING_BYTES, "attention LDS (128-key tiles)");
template <int KIND>
__device__ __forceinline__ void attn_unit2(const AttnP& P, int b, int h, int qb, LAS unsigned char* lds, int tid, int wave, int lane) {
    lane = lane_id_v(); tid = (wave << 6) | lane;
    typedef AK2<KIND> C;
    constexpr bool DIFF = C::DIFF;
    constexpr int HW = C::HW, NKS = C::NKS, KP = C::KP, CPK = C::CPK, KCH = C::KCH, VCH = C::VCH;
    const int r32 = lane & 31, hi = lane >> 5;
    const size_t rowb = (size_t)b * S;
    const int q0w = qb * 256 + wave * 32, qi = q0w + r32;
    int pq = 0; float bias_far = 0.f;
    __syncthreads();
    if (DIFF) {
        pq = P.pos[rowb + qi];
        if (tid < 129) ((LAS float*)(lds + C::BT))[tid] = P.btab[h * 129 + tid];
        if (tid >= 192 && tid < 256) ((LAS float*)(lds + C::DN))[tid - 192] = P.dnorm[tid - 192];
    }
    int minq = pq;
    if (DIFF) { for (int o = 1; o < 64; o <<= 1) { const int v = shxi(minq, o, lane); minq = v < minq ? v : minq; } }
    const int NT = 2 * (qb + 1);
    const GAS bf16* Kb = P.K + rowb * P.kp + h * HW; const GAS bf16* Vb = P.V + rowb * P.vp + h * 64;
    const __amdgpu_buffer_rsrc_t rK = __builtin_amdgcn_make_buffer_rsrc((void*)Kb, 0, 0x7fffffff, 0x00020000), rV = __builtin_amdgcn_make_buffer_rsrc((void*)Vb, 0, 0x7fffffff, 0x00020000);
    const __amdgpu_buffer_rsrc_t rP = __builtin_amdgcn_make_buffer_rsrc((void*)(DIFF ? P.pos + rowb : (const GAS int*)Kb), 0, 0x7fffffff, 0x00020000);
    int kvo[KCH], vvo[VCH], klo[KCH], vlo[VCH];
#pragma unroll
    for (int i = 0; i < KCH; ++i) { const int c = tid + 512 * i; kvo[i] = ((c / CPK) * P.kp + (c % CPK) * 8) * 2; klo[i] = (c / CPK) * KP + (c % CPK) * 16; }
#pragma unroll
    for (int i = 0; i < VCH; ++i) { const int c = tid + 512 * i; const int key = c >> 3, part = c & 7; vvo[i] = (key * P.vp + part * 8) * 2; vlo[i] = (part >> 2) * 8192 + (key >> 3) * 512 + (key & 7) * 64 + (part & 3) * 16; }
    const int pvo = (tid & 127) * 4;
    u32x4 kr[KCH], vr[VCH]; int pkr = 0;
    auto gload = [&](int t) {
        const int ks = __builtin_amdgcn_readfirstlane(128 * t * P.kp * 2), vs = __builtin_amdgcn_readfirstlane(128 * t * P.vp * 2);
#pragma unroll
        for (int i = 0; i < KCH; ++i) kr[i] = __builtin_amdgcn_raw_buffer_load_b128(rK, kvo[i], ks, 0);
#pragma unroll
        for (int i = 0; i < VCH; ++i) vr[i] = __builtin_amdgcn_raw_buffer_load_b128(rV, vvo[i], vs, 0);
        if (DIFF) pkr = __builtin_amdgcn_raw_buffer_load_b32(rP, pvo, __builtin_amdgcn_readfirstlane(128 * t * 4), 0);
    };
    auto lstore = [&](int buf) {
        LAS unsigned char* kb_ = lds + C::K0 + buf * C::KB; LAS unsigned char* vb_ = lds + C::V0 + buf * C::VB;
#pragma unroll
        for (int i = 0; i < KCH; ++i) *(LAS u32x4*)(kb_ + klo[i]) = kr[i];
#pragma unroll
        for (int i = 0; i < VCH; ++i) *(LAS u32x4*)(vb_ + vlo[i]) = vr[i];
        if (DIFF) { ((LAS int*)(lds + C::POS + buf * 512))[tid & 127] = pkr;
            if (tid < 128) { int mk_ = pkr; for (int o = 1; o < 64; o <<= 1) { const int v = shxi(mk_, o, lane); mk_ = v > mk_ ? v : mk_; } if (lane == 0) ((LAS int*)(lds + C::PMX))[buf * 2 + wave] = mk_; } }
    };
    LAS float* osv = (LAS float*)(lds + C::OSV) + wave * 2048 + lane;
    float il = 0.f;
    f32x16 oA[2];
#pragma unroll 1
    for (int mp = 0; mp < (DIFF ? 2 : 1); ++mp) {
        bf16x8 qf[NKS];
        { const GAS bf16* qrow = P.Q + (rowb + qi) * P.qp + h * HW + mp * 32;
#pragma unroll
          for (int s = 0; s < NKS; ++s) qf[s] = *(const GAS bf16x8*)(qrow + 16 * s + 8 * hi);
          if (KIND == 0) {
              const GAS float* rp = P.rope + (rowb + qi) * 32 + 8 * hi;
              const f32x4 c0 = *(const GAS f32x4*)rp, c1 = *(const GAS f32x4*)(rp + 4), s0 = *(const GAS f32x4*)(rp + 16), s1 = *(const GAS f32x4*)(rp + 20);
              const u32x4 a = __builtin_bit_cast(u32x4, qf[NKS - 2]), bq = __builtin_bit_cast(u32x4, qf[NKS - 1]); u32x4 ra, rb;
#pragma unroll
              for (int w = 0; w < 4; ++w) { const float cl = w < 2 ? c0[2 * w] : c1[2 * w - 4], ch = w < 2 ? c0[2 * w + 1] : c1[2 * w - 3], sl = w < 2 ? s0[2 * w] : s1[2 * w - 4], sh = w < 2 ? s0[2 * w + 1] : s1[2 * w - 3];
                  const float x1l = bflo(a[w]), x1h = bfhi(a[w]), x2l = bflo(bq[w]), x2h = bfhi(bq[w]);
                  ra[w] = cvtpk(x1l * cl - x2l * sl, x1h * ch - x2h * sh); rb[w] = cvtpk(x1l * sl + x2l * cl, x1h * sh + x2h * ch); }
              qf[NKS - 2] = __builtin_bit_cast(bf16x8, ra); qf[NKS - 1] = __builtin_bit_cast(bf16x8, rb);
          } }
        __syncthreads();
        float m1 = 0.f, l1 = 0.f;
        f32x16 negm;
#pragma unroll
        for (int r = 0; r < 16; ++r) negm[r] = 0.f;
#pragma unroll
        for (int d = 0; d < 2; ++d)
#pragma unroll
            for (int r = 0; r < 16; ++r) oA[d][r] = 0.f;
        gload(0); lstore(0);
        if (NT > 1) gload(1);
        __syncthreads();
        if (DIFF) { bias_far = ((LAS float*)(lds + C::BT))[128];
#pragma unroll
            for (int r = 0; r < 16; ++r) negm[r] = bias_far; }
        const int NTW = (q0w + 31) / 128 + 1;
        auto compute = [&](int t, int buf) {
            const int k0 = 128 * t;
            const LAS unsigned char* kb_ = lds + C::K0 + buf * C::KB + r32 * KP + hi * 16 + mp * 64;
            const LAS unsigned char* vb_ = lds + C::V0 + buf * C::VB + ((lane >> 4) & 1) * 32 + (lane & 3) * 8 + (4 * hi + ((lane & 15) >> 2)) * 64;
            bool nearb = false;
            if (DIFF) { const LAS int* pm = (const LAS int*)(lds + C::PMX) + buf * 2; const int m0 = __builtin_amdgcn_readfirstlane(pm[0]), m1_ = __builtin_amdgcn_readfirstlane(pm[1]); nearb = (minq - (m0 > m1_ ? m0 : m1_)) < 128; }
            f32x16 sc[4];
            if (DIFF) { if (nearb) {
#pragma unroll
                for (int g = 0; g < 4; ++g)
#pragma unroll
                    for (int r = 0; r < 16; ++r) sc[g][r] = -m1; } }
            constexpr int HB = NKS > 3 ? 3 : NKS;
#pragma unroll
            for (int s0_ = 0; s0_ < NKS; s0_ += HB) {
                bf16x8 kf[4][HB];
#pragma unroll
                for (int g = 0; g < 4; ++g)
#pragma unroll
                    for (int s = 0; s < HB; ++s) kf[g][s] = *(const LAS bf16x8*)(kb_ + 32 * g * KP + (s0_ + s) * 32);
                __builtin_amdgcn_sched_barrier(0);
#pragma unroll
                for (int s = 0; s < HB; ++s)
#pragma unroll
                    for (int g = 0; g < 4; ++g) {
                        if (s0_ + s == 0 && !(DIFF && nearb)) sc[g] = __builtin_amdgcn_mfma_f32_32x32x16_bf16(kf[g][s], qf[s0_ + s], negm, 0, 0, 0);
                        else sc[g] = __builtin_amdgcn_mfma_f32_32x32x16_bf16(kf[g][s], qf[s0_ + s], sc[g], 0, 0, 0); }
                __builtin_amdgcn_sched_barrier(0);
            }
            if (DIFF) { if (nearb) {
                const LAS int* pk = (const LAS int*)(lds + C::POS + buf * 512); const LAS float* bt = (const LAS float*)(lds + C::BT);
#pragma unroll
                for (int g = 0; g < 4; ++g)
#pragma unroll
                    for (int r = 0; r < 16; ++r) { int n0 = pq - pk[32 * g + crow(r, hi)]; n0 = n0 < 0 ? 0 : (n0 > 128 ? 128 : n0); sc[g][r] += bt[n0]; }
            } }
            asm volatile("s_nop 15\n\ts_nop 7" : "+v"(sc[0]), "+v"(sc[1]), "+v"(sc[2]), "+v"(sc[3]));
            if (k0 + 127 > q0w) {
#pragma unroll
                for (int g = 0; g < 4; ++g)
#pragma unroll
                    for (int r = 0; r < 16; ++r) { if (k0 + 32 * g + crow(r, hi) > qi) sc[g][r] = -1e30f; }
            }
            const float mx = swapmax(vmax3(max32(sc[0], sc[1]), max32(sc[2], sc[3]), -1e30f));
            const bool up = (t == 0) || mx > 8.0f;
            float al = 1.f;
            if (__builtin_amdgcn_ballot_w64(up) != 0ull) {
                const float dl = up ? mx : 0.f; al = __builtin_amdgcn_exp2f(-dl); l1 *= al; m1 += dl;
#pragma unroll
                for (int r = 0; r < 16; ++r) negm[r] -= dl;
#pragma unroll
                for (int g = 0; g < 4; ++g)
#pragma unroll
                    for (int r = 0; r < 16; ++r) sc[g][r] -= dl;
            }
            float ls = 0.f;
#pragma unroll
            for (int g = 0; g < 4; ++g)
#pragma unroll
                for (int r = 0; r < 16; ++r) { sc[g][r] = __builtin_amdgcn_exp2f(sc[g][r]); ls += sc[g][r]; }
            l1 += ls;
            bf16x8 pf[8];
#pragma unroll
            for (int g = 0; g < 4; ++g) { pf[2 * g] = pack8(sc[g], 0); pf[2 * g + 1] = pack8(sc[g], 8); }
            if (__builtin_amdgcn_ballot_w64(al != 1.0f) != 0ull) {
#pragma unroll
                for (int d = 0; d < 2; ++d)
#pragma unroll
                    for (int r = 0; r < 16; ++r) oA[d][r] *= al;
            }
#pragma unroll
            for (int d = 0; d < 2; ++d) {
                bf16x8 vf[8];
#pragma unroll
                for (int s = 0; s < 8; ++s) { const s16x4 lo = vtr(vb_ + d * 8192 + s * 1024), hh = vtr(vb_ + d * 8192 + s * 1024 + 512); vf[s] = (bf16x8){lo[0], lo[1], lo[2], lo[3], hh[0], hh[1], hh[2], hh[3]}; }
                __builtin_amdgcn_sched_barrier(0);
#pragma unroll
                for (int s = 0; s < 8; ++s) oA[d] = __builtin_amdgcn_mfma_f32_32x32x16_bf16(vf[s], pf[s], oA[d], 0, 0, 0);
                __builtin_amdgcn_sched_barrier(0);
            }
        };
        int t = 0;
        for (; t + 2 < NT; ++t) {
            const int buf = t & 1;
            lstore(buf ^ 1); gload(t + 2);
            if (t < NTW) compute(t, buf);
            TILE_BAR();
        }
        for (; t < NT; ++t) {
            const int buf = t & 1;
            if (t + 1 < NT) lstore(buf ^ 1);
            if (t < NTW) compute(t, buf);
            TILE_BAR();
        }
        il = 1.f / swapadd(l1);
        if (DIFF) { if (mp == 0) {
#pragma unroll
            for (int d = 0; d < 2; ++d)
#pragma unroll
                for (int r = 0; r < 16; ++r) osv[(d * 16 + r) * 64] = oA[d][r] * il; } }
    }
    GAS bf16* orow = P.O + (rowb + qi) * P.op + h * 64;
    if (!DIFF) {
#pragma unroll
        for (int d = 0; d < 2; ++d)
#pragma unroll
            for (int g = 0; g < 4; ++g) { v2u v; v.x = cvtpk(oA[d][4 * g] * il, oA[d][4 * g + 1] * il); v.y = cvtpk(oA[d][4 * g + 2] * il, oA[d][4 * g + 3] * il); *(GAS v2u*)(orow + 32 * d + 8 * g + 4 * hi) = v; }
    } else {
        const float lam = P.lams[0], lam_init = P.lams[1];
        const float i2 = lam * il;
        float ss = 0.f;
#pragma unroll
        for (int d = 0; d < 2; ++d)
#pragma unroll
            for (int r = 0; r < 16; ++r) { const float v = osv[(d * 16 + r) * 64] - oA[d][r] * i2; oA[d][r] = v; ss += v * v; }
        ss = swapadd(ss);
        const float rs = __builtin_amdgcn_rsqf(ss * (1.f / 64.f) + 1e-6f) * (1.f - lam_init);
        const LAS float* dn = (const LAS float*)(lds + C::DN);
#pragma unroll
        for (int d = 0; d < 2; ++d)
#pragma unroll
            for (int g = 0; g < 4; ++g) { const int c = 32 * d + 8 * g + 4 * hi; const f32x4 gn = *(const LAS f32x4*)(dn + c);
                v2u v; v.x = cvtpk(oA[d][4 * g] * rs * gn[0], oA[d][4 * g + 1] * rs * gn[1]); v.y = cvtpk(oA[d][4 * g + 2] * rs * gn[2], oA[d][4 * g + 3] * rs * gn[3]); *(GAS v2u*)(orow + c) = v; }
    }
}

__device__ __forceinline__ void attn_phase(const AttnP& PM, const AttnP& PD, LAS unsigned char* lds, int tid, int wave, int lane, int vcu, int G, int only = -1) {
    for (int i = vcu; i < 512; i += G) {
        if (only >= 0 && (i >> 8) != only) continue;
        const int kind = i >> 8, c = i & 255, bh = c >> 4, s = c & 15;
        if (kind == 0) {
#pragma unroll 1
            for (int k = 0; k < 2; ++k) attn_unit2<0>(PM, bh >> 2, bh & 3, k ? 31 - s : s, lds, tid, wave, lane);
        } else {
#pragma unroll 1
            for (int k = 0; k < 2; ++k) attn_unit2<1>(PD, bh >> 2, bh & 3, k ? 31 - s : s, lds, tid, wave, lane);
        }
    }
}
__device__ __forceinline__ void cross_phase(const AttnP& PC, LAS unsigned char* lds, int tid, int wave, int lane, int vcu, int G) {
#pragma unroll 1
    for (int i = vcu; i < 1024; i += G) { const int bh = i >> 6; attn_unit<2, true>(PC, bh >> 2, bh & 3, i & 31, (i >> 5) & 1, lds, tid, wave, lane); }
}


__device__ __forceinline__ float vmax2(float a, float b) { float r; asm("v_max_f32_e32 %0, %1, %2" : "=v"(r) : "v"(a), "v"(b)); return r; }
__device__ __forceinline__ float vmin2(float a, float b) { float r; asm("v_min_f32_e32 %0, %1, %2" : "=v"(r) : "v"(a), "v"(b)); return r; }
__device__ __forceinline__ void pad16(float (&a)[16]) {
    asm volatile("s_nop 1" : "+v"(a[0]), "+v"(a[1]), "+v"(a[2]), "+v"(a[3]), "+v"(a[4]), "+v"(a[5]), "+v"(a[6]), "+v"(a[7]), "+v"(a[8]), "+v"(a[9]), "+v"(a[10]), "+v"(a[11]), "+v"(a[12]), "+v"(a[13]), "+v"(a[14]), "+v"(a[15]));
}
__device__ __forceinline__ void sort16_desc(float (&a)[16]) {
#pragma unroll
    for (int k = 2; k <= 16; k <<= 1)
#pragma unroll
        for (int j = k >> 1; j > 0; j >>= 1)
#pragma unroll
            for (int i = 0; i < 16; ++i) { const int l = i ^ j; if (l > i) { const bool desc = ((i & k) == 0); const float hi_ = vmax2(a[i], a[l]), lo_ = vmin2(a[i], a[l]); a[i] = desc ? hi_ : lo_; a[l] = desc ? lo_ : hi_; } }
}
__device__ __forceinline__ void merge16_desc(float (&a)[16], const float (&b)[16]) {
#pragma unroll
    for (int i = 0; i < 16; ++i) a[i] = vmax2(a[i], b[15 - i]);
#pragma unroll
    for (int j = 8; j > 0; j >>= 1)
#pragma unroll
        for (int i = 0; i < 16; ++i) { const int l = i ^ j; if (l > i) { const float hi_ = vmax2(a[i], a[l]), lo_ = vmin2(a[i], a[l]); a[i] = hi_; a[l] = lo_; } }
}
__device__ __forceinline__ void top16_of_64(float (&g0)[16], float (&g1)[16], float (&g2)[16], float (&g3)[16]) {
    sort16_desc(g0); sort16_desc(g1); merge16_desc(g0, g1); sort16_desc(g2); sort16_desc(g3); merge16_desc(g2, g3); merge16_desc(g0, g2);
}
__device__ __forceinline__ float embed(float v, unsigned mask, unsigned id) { return __builtin_bit_cast(float, (__builtin_bit_cast(unsigned, v) & mask) | id); }
__device__ __forceinline__ float mkcand(float x, float y, unsigned id) { return embed(x + y, 0xFFFFFF00u, id); }

__device__ __forceinline__ void swap32(float& a, float& b) { asm volatile("v_nop\n\tv_nop\n\tv_permlane32_swap_b32 %0, %1" : "+v"(a), "+v"(b)); }
struct RouteP { const GAS bf16* QP; const GAS bf16* keys; GAS int* EX; GAS float* GW; };
constexpr int RT_KP = 144, RT_KEYS = 0, RT_SCR = 256 * RT_KP, RT_END = RT_SCR + 8 * 8192;
__device__ __forceinline__ void route_phase(const RouteP& P, LAS unsigned char* lds, int tid, int wave, int lane, int vcu, int G) {
    asm volatile("" : "+v"(tid), "+v"(lane));
    __syncthreads();
    for (int c = tid; c < 256 * 8; c += 512) { const int row = c >> 3, part = c & 7; *(LAS u32x4*)(lds + RT_KEYS + row * RT_KP + part * 16) = *(const u32x4*)(P.keys + row * 64 + part * 8); }
    __syncthreads();
    const int r32 = lane & 31, hi = lane >> 5;
    LAS int* scr = (LAS int*)(lds + RT_SCR + wave * 8192);
    for (int u = vcu; u < T / 32; u += G) {
        const size_t t = (size_t)u * 32 + r32; const int h = wave;
        float T2[2][16];
#pragma unroll
        for (int c = 0; c < 2; ++c) {
            bf16x8 qf[4];
            { const GAS bf16* q = P.QP + t * 1024 + h * 128 + c * 64 + 8 * hi;
#pragma unroll
              for (int s = 0; s < 4; ++s) qf[s] = *(const GAS bf16x8*)(q + 16 * s); }
            f32x16 sc[4];
#pragma unroll
            for (int m = 0; m < 4; ++m) {
#pragma unroll
                for (int r = 0; r < 16; ++r) sc[m][r] = 0.f;
#pragma unroll
                for (int s = 0; s < 4; ++s) { const bf16x8 a = *(const LAS bf16x8*)(lds + RT_KEYS + (c * 128 + 32 * m + r32) * RT_KP + s * 32 + hi * 16);
                    sc[m] = __builtin_amdgcn_mfma_f32_32x32x16_bf16(a, qf[s], sc[m], 0, 0, 0); }
            }
            float g0[16], g1[16], g2[16], g3[16];
            const unsigned h4 = 4u * (unsigned)hi;
#pragma unroll
            for (int r = 0; r < 16; ++r) { const unsigned kr_ = (unsigned)((r & 3) + 8 * (r >> 2));
                g0[r] = embed(sc[0][r], 0xFFFFFF80u, kr_ | h4); g1[r] = embed(sc[1][r], 0xFFFFFF80u, (32u + kr_) | h4); g2[r] = embed(sc[2][r], 0xFFFFFF80u, (64u + kr_) | h4); g3[r] = embed(sc[3][r], 0xFFFFFF80u, (96u + kr_) | h4); }
            top16_of_64(g0, g1, g2, g3);
            pad16(g0);
#pragma unroll
            for (int i = 0; i < 16; ++i) T2[c][i] = g0[i];
        }
        float A[16], Bv[16];
#pragma unroll
        for (int i = 0; i < 16; ++i) { A[i] = T2[0][i]; Bv[i] = T2[1][i]; swap32(A[i], Bv[i]); }
        merge16_desc(A, Bv);
        pad16(A);
        float T0[16], T1[16];
#pragma unroll
        for (int i = 0; i < 16; ++i) { T0[i] = A[i]; T1[i] = A[i]; swap32(T0[i], T1[i]); }
#pragma unroll
        for (int i = 0; i < 16; ++i) { scr[i * 64 + lane] = (int)(__builtin_bit_cast(unsigned, T0[i]) & 127u); scr[(16 + i) * 64 + lane] = (int)(__builtin_bit_cast(unsigned, T1[i]) & 127u);
            T0[i] = embed(T0[i], 0xFFFFFF80u, 0u); T1[i] = embed(T1[i], 0xFFFFFF80u, 0u); }
        float c0[16], c1[16], c2[16], c3[16];
        const float NINF = -__builtin_inff();
#pragma unroll
        for (int b = 0; b < 16; ++b) c0[b] = mkcand(T0[0], T1[b], (unsigned)b);
#pragma unroll
        for (int b = 0; b < 8; ++b) c1[b] = mkcand(T0[1], T1[b], 16u + b);
#pragma unroll
        for (int b = 0; b < 5; ++b) c1[8 + b] = mkcand(T0[2], T1[b], 32u + b);
#pragma unroll
        for (int b = 0; b < 3; ++b) c1[13 + b] = mkcand(T0[4], T1[b], 64u + b);
#pragma unroll
        for (int b = 0; b < 4; ++b) c2[b] = mkcand(T0[3], T1[b], 48u + b);
        c2[4] = mkcand(T0[5], T1[0], 80u); c2[5] = mkcand(T0[5], T1[1], 81u); c2[6] = mkcand(T0[6], T1[0], 96u); c2[7] = mkcand(T0[6], T1[1], 97u); c2[8] = mkcand(T0[7], T1[0], 112u); c2[9] = mkcand(T0[7], T1[1], 113u);
#pragma unroll
        for (int a = 8; a < 14; ++a) c2[10 + a - 8] = mkcand(T0[a], T1[0], 16u * a);
        c3[0] = mkcand(T0[14], T1[0], 224u); c3[1] = mkcand(T0[15], T1[0], 240u);
#pragma unroll
        for (int i = 2; i < 16; ++i) c3[i] = NINF;
        top16_of_64(c0, c1, c2, c3);
        pad16(c0);
        float gsum = 0.f, ge[16]; int ex[16];
        const float mtop = embed(c0[0], 0xFFFFFF00u, 0u);
#pragma unroll
        for (int i = 0; i < 16; ++i) { const unsigned bits = __builtin_bit_cast(unsigned, c0[i]); const int a = (bits >> 4) & 15, b = bits & 15;
            ge[i] = __builtin_amdgcn_exp2f((embed(c0[i], 0xFFFFFF00u, 0u) - mtop) * LOG2E); gsum += ge[i];
            ex[i] = scr[a * 64 + lane] * 128 + scr[(16 + b) * 64 + lane]; }
        const float ginv = __builtin_amdgcn_rcpf(gsum);
        if (hi == 0) { GAS v4u* d = (GAS v4u*)(P.EX + t * 128 + h * 16);
#pragma unroll
            for (int i = 0; i < 4; ++i) d[i] = (v4u){(unsigned)ex[4 * i], (unsigned)ex[4 * i + 1], (unsigned)ex[4 * i + 2], (unsigned)ex[4 * i + 3]}; }
        else { GAS f32x4* d = (GAS f32x4*)(P.GW + t * 128 + h * 16);
#pragma unroll
            for (int i = 0; i < 4; ++i) d[i] = (f32x4){ge[4 * i] * ginv, ge[4 * i + 1] * ginv, ge[4 * i + 2] * ginv, ge[4 * i + 3] * ginv}; }
    }
}

__device__ __forceinline__ int wave_allsum_i(int v) {
    v += __builtin_amdgcn_update_dpp(0, v, 0xB1, 0xF, 0xF, true);
    v += __builtin_amdgcn_update_dpp(0, v, 0x4E, 0xF, 0xF, true);
    v += __builtin_amdgcn_update_dpp(0, v, 0x141, 0xF, 0xF, true);
    v += __builtin_amdgcn_update_dpp(0, v, 0x140, 0xF, 0xF, true);
    { int a = v, b = v; asm volatile("v_nop\n\tv_nop\n\tv_permlane16_swap_b32 %0, %1" : "+v"(a), "+v"(b)); v = a + b; }
    { int a = v, b = v; asm volatile("v_nop\n\tv_nop\n\tv_permlane32_swap_b32 %0, %1" : "+v"(a), "+v"(b)); v = a + b; }
    return v;
}
__device__ __forceinline__ float wave_allsum(float v) {
    v += __builtin_bit_cast(float, __builtin_amdgcn_update_dpp(0, __builtin_bit_cast(int, v), 0xB1, 0xF, 0xF, true));
    v += __builtin_bit_cast(float, __builtin_amdgcn_update_dpp(0, __builtin_bit_cast(int, v), 0x4E, 0xF, 0xF, true));
    v += __builtin_bit_cast(float, __builtin_amdgcn_update_dpp(0, __builtin_bit_cast(int, v), 0x141, 0xF, 0xF, true));
    v += __builtin_bit_cast(float, __builtin_amdgcn_update_dpp(0, __builtin_bit_cast(int, v), 0x140, 0xF, 0xF, true));
    { float a = v, b = v; asm volatile("v_nop\n\tv_nop\n\tv_permlane16_swap_b32 %0, %1" : "+v"(a), "+v"(b)); v = a + b; }
    { float a = v, b = v; asm volatile("v_nop\n\tv_nop\n\tv_permlane32_swap_b32 %0, %1" : "+v"(a), "+v"(b)); v = a + b; }
    return v;
}
__device__ __forceinline__ float wave_allmax(float v) {
    v = fmaxf(v, __builtin_bit_cast(float, __builtin_amdgcn_update_dpp(0, __builtin_bit_cast(int, v), 0xB1, 0xF, 0xF, true)));
    v = fmaxf(v, __builtin_bit_cast(float, __builtin_amdgcn_update_dpp(0, __builtin_bit_cast(int, v), 0x4E, 0xF, 0xF, true)));
    v = fmaxf(v, __builtin_bit_cast(float, __builtin_amdgcn_update_dpp(0, __builtin_bit_cast(int, v), 0x141, 0xF, 0xF, true)));
    v = fmaxf(v, __builtin_bit_cast(float, __builtin_amdgcn_update_dpp(0, __builtin_bit_cast(int, v), 0x140, 0xF, 0xF, true)));
    { float a = v, b = v; asm volatile("v_nop\n\tv_nop\n\tv_permlane16_swap_b32 %0, %1" : "+v"(a), "+v"(b)); v = fmaxf(a, b); }
    { float a = v, b = v; asm volatile("v_nop\n\tv_nop\n\tv_permlane32_swap_b32 %0, %1" : "+v"(a), "+v"(b)); v = fmaxf(a, b); }
    return v;
}
__device__ __forceinline__ unsigned q4(float a, float b, float c, float d, int off) {
    const int ia = (int)__builtin_rintf(a) + off, ib = (int)__builtin_rintf(b) + off, ic = (int)__builtin_rintf(c) + off, id = (int)__builtin_rintf(d) + off;
    return (unsigned)(ia & 255) | ((unsigned)(ib & 255) << 8) | ((unsigned)(ic & 255) << 16) | ((unsigned)(id & 255) << 24);
}
__device__ __forceinline__ void quant_row(const GAS float* src, GAS unsigned* dst, GAS float* scale, int off, int lane) {
    const GAS f32x4* s = (const GAS f32x4*)src + 4 * lane; f32x4 v[4]; float m = 0.f;
#pragma unroll
    for (int i = 0; i < 4; ++i) { v[i] = s[i]; m = fmaxf(m, fmaxf(fmaxf(__builtin_fabsf(v[i].x), __builtin_fabsf(v[i].y)), fmaxf(__builtin_fabsf(v[i].z), __builtin_fabsf(v[i].w)))); }
    m = wave_allmax(m); const float inv = m > 0.f ? 127.f / m : 0.f;
    v4u w;
    w.x = q4(v[0].x * inv, v[0].y * inv, v[0].z * inv, v[0].w * inv, off); w.y = q4(v[1].x * inv, v[1].y * inv, v[1].z * inv, v[1].w * inv, off);
    w.z = q4(v[2].x * inv, v[2].y * inv, v[2].z * inv, v[2].w * inv, off); w.w = q4(v[3].x * inv, v[3].y * inv, v[3].z * inv, v[3].w * inv, off);
    *((GAS v4u*)dst + lane) = w;
    if (lane == 0) *scale = m * (1.f / 127.f);
}
struct PeerS { int nslices_step, first_slice, nloc, rank; };
__device__ __forceinline__ PeerS peer_sched(const GAS unsigned* rankw, int xcc, int rank) {
    int nx = 0, myidx = 0, nloc = 1;
    for (int j = 0; j < 16; ++j) { const int c = (int)__hip_atomic_load(rankw + 64 * j, __ATOMIC_RELAXED, __HIP_MEMORY_SCOPE_AGENT); if (c > 0) { if (j == xcc) { myidx = nx; nloc = c; } ++nx; } }
    PeerS s; s.nslices_step = nx > 0 ? nx : 1; s.first_slice = myidx; s.nloc = nloc; s.rank = rank; return s;
}
struct Peer1P { const GAS unsigned GAS char* HQ; const GAS int* EX; const GAS unsigned GAS char* U8; GAS int* P; };
__device__ __forceinline__ void peer_k1(const Peer1P& Q, const PeerS& sc, int wave, int lane) {
    asm volatile("" : "+v"(lane));
    const int g = lane >> 3, j = lane & 7;
    for (int s = sc.first_slice; s < 8; s += sc.nslices_step)
        for (int tile = sc.rank; tile < T / 64; tile += sc.nloc) {
            const size_t t0 = (size_t)tile * 64 + wave * 8;
            v4u hqn = *(const GAS v4u*)(Q.HQ + t0 * 1024 + 128 * s + 16 * j), exn[4];
#pragma unroll
            for (int i = 0; i < 4; ++i) exn[i] = *(const GAS v4u*)(Q.EX + t0 * 128 + 16 * g + 4 * i);
#pragma unroll 1
            for (int k = 0; k < 8; ++k) {
                const size_t t = t0 + k;
                const v4u hq = hqn; v4u ex[4];
#pragma unroll
                for (int i = 0; i < 4; ++i) ex[i] = exn[i];
                if (k + 1 < 8) {
                    hqn = *(const GAS v4u*)(Q.HQ + (t + 1) * 1024 + 128 * s + 16 * j);
#pragma unroll
                    for (int i = 0; i < 4; ++i) exn[i] = *(const GAS v4u*)(Q.EX + (t + 1) * 128 + 16 * g + 4 * i);
                }
                v4u uu[16];
#pragma unroll
                for (int i = 0; i < 16; ++i) { const unsigned e = (i & 3) == 0 ? ex[i >> 2].x : (i & 3) == 1 ? ex[i >> 2].y : (i & 3) == 2 ? ex[i >> 2].z : ex[i >> 2].w;
                    uu[i] = *(const GAS v4u*)(Q.U8 + (size_t)e * 1024 + 128 * s + 16 * j); }
                int lo = 0, hi = 0;
#pragma unroll
                for (int i = 0; i < 16; ++i) {
                    int p = __builtin_amdgcn_sdot4((int)uu[i].x, (int)hq.x, 0, false); p = __builtin_amdgcn_sdot4((int)uu[i].y, (int)hq.y, p, false); p = __builtin_amdgcn_sdot4((int)uu[i].z, (int)hq.z, p, false); p = __builtin_amdgcn_sdot4((int)uu[i].w, (int)hq.w, p, false);
                    p += __builtin_amdgcn_update_dpp(0, p, 0xB1, 0xF, 0xF, true); p += __builtin_amdgcn_update_dpp(0, p, 0x4E, 0xF, 0xF, true); p += __builtin_amdgcn_update_dpp(0, p, 0x141, 0xF, 0xF, true);
                    if (i < 8) lo = (j == i) ? p : lo; else hi = (j == i - 8) ? p : hi;
                }
                GAS int* prow = Q.P + t * 128 + 16 * g + j;
                (void)__hip_atomic_fetch_add(prow, lo, __ATOMIC_RELAXED, __HIP_MEMORY_SCOPE_AGENT); (void)__hip_atomic_fetch_add(prow + 8, hi, __ATOMIC_RELAXED, __HIP_MEMORY_SCOPE_AGENT);
            }
        }
}
__device__ __forceinline__ void peer_w(const GAS int* EX, const GAS float* GW, const GAS int* P, const GAS float* SH, const GAS float* SU, const GAS float* SV, GAS signed char* WQ, GAS float* WSC, int gw, int NGW, int lane) {
    asm volatile("" : "+v"(lane));
    for (int t = gw; t < T; t += NGW) {
        const float sh = SH[t];
#pragma unroll
        for (int q = 0; q < 2; ++q) { const size_t idx = (size_t)t * 128 + lane + 64 * q; const int e = EX[idx];
            const float w = GW[idx] * gelu_erf((float)P[idx] * (sh * SU[e])) * SV[e];
            float m = __builtin_fabsf(w);
            m = fmaxf(m, __builtin_bit_cast(float, __builtin_amdgcn_update_dpp(0, __builtin_bit_cast(int, m), 0xB1, 0xF, 0xF, true)));
            m = fmaxf(m, __builtin_bit_cast(float, __builtin_amdgcn_update_dpp(0, __builtin_bit_cast(int, m), 0x4E, 0xF, 0xF, true)));
            m = fmaxf(m, __builtin_bit_cast(float, __builtin_amdgcn_update_dpp(0, __builtin_bit_cast(int, m), 0x141, 0xF, 0xF, true)));
            m = fmaxf(m, __builtin_bit_cast(float, __builtin_amdgcn_update_dpp(0, __builtin_bit_cast(int, m), 0x140, 0xF, 0xF, true)));
            const float inv = m > 0.f ? 127.f / m : 0.f;
            WQ[idx] = (signed char)(int)__builtin_rintf(w * inv);
            if ((lane & 15) == 0) WSC[(size_t)t * 8 + (lane >> 4) + 4 * q] = m * (1.f / 127.f); }
    }
}
__device__ __forceinline__ void tr4x4(unsigned r0, unsigned r1, unsigned r2, unsigned r3, unsigned (&t)[4]) {
    const unsigned x0 = __builtin_amdgcn_perm(r1, r0, 0x05010400u), x1 = __builtin_amdgcn_perm(r1, r0, 0x07030602u), y0 = __builtin_amdgcn_perm(r3, r2, 0x05010400u), y1 = __builtin_amdgcn_perm(r3, r2, 0x07030602u);
    t[0] = __builtin_amdgcn_perm(y0, x0, 0x05040100u); t[1] = __builtin_amdgcn_perm(y0, x0, 0x07060302u); t[2] = __builtin_amdgcn_perm(y1, x1, 0x05040100u); t[3] = __builtin_amdgcn_perm(y1, x1, 0x07060302u);
}
struct Peer2P { const GAS int* EX; const GAS signed char* WQ; const GAS float* WSC; const GAS unsigned char* V8; GAS bf16* XB; GAS float* SSQ; };
__device__ __forceinline__ void peer_k2(const Peer2P& Q, const PeerS& sc, int wave, int lane) {
    asm volatile("" : "+v"(lane));
    const int g = lane >> 3, j = lane & 7, hf = lane >> 5, rp = (lane >> 4) & 1;
    for (int s = sc.first_slice; s < 8; s += sc.nslices_step)
        for (int tile = sc.rank; tile < T / 64; tile += sc.nloc) {
            const size_t t0 = (size_t)tile * 64 + wave * 8;
            v4u exn[4], wqn; float swn;
#pragma unroll
            for (int i = 0; i < 4; ++i) exn[i] = *(const GAS v4u*)(Q.EX + t0 * 128 + 16 * g + 4 * i);
            wqn = *(const GAS v4u*)(Q.WQ + t0 * 128 + 16 * g); swn = Q.WSC[t0 * 8 + g];
#pragma unroll 1
            for (int k = 0; k < 8; ++k) {
                const size_t t = t0 + k;
                v4u ex[4]; const v4u wq = wqn; const float sw = swn;
#pragma unroll
                for (int i = 0; i < 4; ++i) ex[i] = exn[i];
                if (k + 1 < 8) {
#pragma unroll
                    for (int i = 0; i < 4; ++i) exn[i] = *(const GAS v4u*)(Q.EX + (t + 1) * 128 + 16 * g + 4 * i);
                    wqn = *(const GAS v4u*)(Q.WQ + (t + 1) * 128 + 16 * g); swn = Q.WSC[(t + 1) * 8 + g];
                }
                GAS v2u* xp = (GAS v2u*)(Q.XB + t * 1024 + 128 * s + 16 * j + 8 * hf + 4 * rp);
                const v2u xold = *xp;
                v4u vv[16];
#pragma unroll
                for (int i = 0; i < 16; ++i) { const unsigned e = (i & 3) == 0 ? ex[i >> 2].x : (i & 3) == 1 ? ex[i >> 2].y : (i & 3) == 2 ? ex[i >> 2].z : ex[i >> 2].w;
                    vv[i] = *(const GAS v4u*)(Q.V8 + (size_t)e * 1024 + 128 * s + 16 * j); }
                int ai[16];
#pragma unroll
                for (int i = 0; i < 16; ++i) ai[i] = 0;
#pragma unroll
                for (int q4_ = 0; q4_ < 4; ++q4_) {
                    const unsigned wq4 = q4_ == 0 ? wq.x : q4_ == 1 ? wq.y : q4_ == 2 ? wq.z : wq.w;
#pragma unroll
                    for (int c = 0; c < 4; ++c) { unsigned tt[4];
                        const v4u &a0 = vv[4 * q4_], &a1 = vv[4 * q4_ + 1], &a2 = vv[4 * q4_ + 2], &a3 = vv[4 * q4_ + 3];
                        tr4x4(c == 0 ? a0.x : c == 1 ? a0.y : c == 2 ? a0.z : a0.w, c == 0 ? a1.x : c == 1 ? a1.y : c == 2 ? a1.z : a1.w, c == 0 ? a2.x : c == 1 ? a2.y : c == 2 ? a2.z : a2.w, c == 0 ? a3.x : c == 1 ? a3.y : c == 2 ? a3.z : a3.w, tt);
#pragma unroll
                        for (int b = 0; b < 4; ++b) ai[4 * c + b] = __builtin_amdgcn_sdot4((int)tt[b], (int)wq4, ai[4 * c + b], false); }
                }
                float acc[16];
#pragma unroll
                for (int i = 0; i < 16; ++i) acc[i] = (float)ai[i] * sw;
                float r8[8], r4[4];
#pragma unroll
                for (int m = 0; m < 8; ++m) { float a = acc[m], b = acc[m + 8]; swap32(a, b); r8[m] = a + b; }
#pragma unroll
                for (int n = 0; n < 4; ++n) { float a = r8[n], b = r8[n + 4]; asm volatile("v_nop\n\tv_nop\n\tv_permlane16_swap_b32 %0, %1" : "+v"(a), "+v"(b)); r4[n] = a + b; }
#pragma unroll
                for (int n = 0; n < 4; ++n) r4[n] += __builtin_bit_cast(float, __builtin_amdgcn_update_dpp(0, __builtin_bit_cast(int, r4[n]), 0x128, 0xF, 0xF, true));
                v2u xw; xw.x = pk2(bflo(xold.x) + r4[0], bfhi(xold.x) + r4[1]); xw.y = pk2(bflo(xold.y) + r4[2], bfhi(xold.y) + r4[3]);
                float ss = 0.f;
                if ((lane & 8) == 0) { const float x0 = bflo(xw.x), x1 = bfhi(xw.x), x2 = bflo(xw.y), x3 = bfhi(xw.y); ss = (x0 * x0 + x1 * x1) + (x2 * x2 + x3 * x3); *xp = xw; }
                ss = wave_allsum(ss);
                if (Q.SSQ) { if (lane == 0) Q.SSQ[t * 16 + s] = ss; }
            }
        }
}

struct Args { const float* in[33]; float* out; unsigned char* ws; int ph_lo, ph_hi; };
struct Frame { LAS unsigned char* lds; volatile LAS unsigned* MISC; gu32* ctl; int tid, lane, wave, G, vcu, xcc, xrank; };

__device__ __forceinline__ void transpose_item(const float* W, int ldw, int nsrc0, bf16* WT, int ldt, int rdst0, LAS float* scr, int kb, int nb, int lane, float scale, const float* kgain) {
    const int k0 = 64 * kb, n0 = 32 * nb;
#pragma unroll 8
    for (int i = 0; i < 32; ++i) { const int kk = 2 * i + (lane >> 5); const float gsc = kgain ? kgain[k0 + kk] * scale : scale; scr[kk * 33 + (lane & 31)] = W[(size_t)(k0 + kk) * ldw + nsrc0 + n0 + (lane & 31)] * gsc; }
    LDS_WAIT(); asm volatile("" ::: "memory");
    const int c = lane & 7;
#pragma unroll
    for (int j = 0; j < 4; ++j) { const int n = (lane >> 3) + 8 * j; const LAS float* s = scr + (8 * c) * 33 + n;
        v4u o; o.x = pk2(s[0 * 33], s[1 * 33]); o.y = pk2(s[2 * 33], s[3 * 33]); o.z = pk2(s[4 * 33], s[5 * 33]); o.w = pk2(s[6 * 33], s[7 * 33]);
        *(GAS v4u*)(WT + (size_t)(rdst0 + n0 + n) * ldt + k0 + 8 * c) = o; }
    LDS_WAIT(); asm volatile("" ::: "memory");
}
__device__ __forceinline__ void zero_rect(bf16* base, int ld, int row0, int nrows, int col0, int ncols, int gtid, int gthreads) {
    const int vpr = ncols / 8;
    for (int i = gtid; i < nrows * vpr; i += gthreads) { const int r = i / vpr, c = i % vpr; *(GAS v4u*)(base + (size_t)(row0 + r) * ld + col0 + 8 * c) = (v4u){0u, 0u, 0u, 0u}; }
}

__device__ __forceinline__ void p0_prologue(Frame& F, const Args& a) {
    LAS float* scr = (LAS float*)(F.lds + RING_OFF + F.wave * 16384);
    const int gw = blockIdx.x * NWAVES + F.wave, NGW = F.G * NWAVES;
    const int gtid = blockIdx.x * (NWAVES * 64) + F.tid, gthreads = F.G * NWAVES * 64;
    unsigned char* ws = a.ws;
    x0_phase((const GAS float*)a.in[0], (GAS bf16*)(ws + WS_XNB), (GAS float*)(ws + WS_SSQ), gw, NGW, F.lane);
    constexpr int I_IN = 16 * (INW / 32), I_SQ = 16 * 32, I_CKV = 16 * 64, I_UQ = 3 * 12, I_UKV = 2 * 16, I_L = I_IN + 4 * I_SQ + I_CKV + I_UQ + I_UKV;
    for (int it = gw; it < L * I_L; it += NGW) {
        const int l = it / I_L; int r = it % I_L;
        if (r < I_IN) {
            const int kb = r / 67, nb = r % 67; int src, dst; float sc = 1.f;
            if (nb < 6) { src = 32 * nb; dst = src; } else if (nb < 11) { src = 32 * nb; dst = src + 64; } else { src = 32 * nb; dst = src + 160; if (nb >= 43 && nb < 51) sc = 0.17677669529663687f * LOG2E; }
            transpose_item(a.in[5] + (size_t)l * D * INW, INW, src, (bf16*)(ws + WS_WIN) + (size_t)l * INP * D, D, dst, scr, kb, 0, F.lane, sc, a.in[4] + l * D); continue; } r -= I_IN;
        if (r < I_SQ) { transpose_item(a.in[21] + (size_t)l * D * D, D, 0, (bf16*)(ws + WS_WOUT) + (size_t)l * D * D, D, 0, scr, r / 32, r % 32, F.lane, 1.f, nullptr); continue; } r -= I_SQ;
        if (r < I_SQ) { transpose_item(a.in[24] + (size_t)l * D * D, D, 0, (bf16*)(ws + WS_WCQ) + (size_t)l * D * D, D, 0, scr, r / 32, r % 32, F.lane, 0.0625f * LOG2E, a.in[22] + l * D); continue; } r -= I_SQ;
        if (r < I_SQ) { transpose_item(a.in[26] + (size_t)l * D * D, D, 0, (bf16*)(ws + WS_WCO) + (size_t)l * D * D, D, 0, scr, r / 32, r % 32, F.lane, 1.f, nullptr); continue; } r -= I_SQ;
        if (r < I_SQ) { transpose_item(a.in[28] + (size_t)l * D * D, D, 0, (bf16*)(ws + WS_WPQ) + (size_t)l * D * D, D, 0, scr, r / 32, r % 32, F.lane, 1.f, a.in[27] + l * D); continue; } r -= I_SQ;
        if (r < I_CKV) { transpose_item(a.in[25] + (size_t)l * D * 2 * D, 2 * D, 0, (bf16*)(ws + WS_WCKV) + (size_t)l * 2 * D * D, D, 0, scr, r / 64, r % 64, F.lane, 1.f, nullptr); continue; } r -= I_CKV;
        if (r < I_UQ) { transpose_item(a.in[7] + (size_t)l * 192 * 384, 384, 0, (bf16*)(ws + WS_WUQ) + (size_t)l * 512 * 256, 256, 0, scr, r / 12, r % 12, F.lane, 0.10206207261596575f * LOG2E, a.in[6] + l * 192); continue; } r -= I_UQ;
        transpose_item(a.in[9] + (size_t)l * 128 * 512, 512, 0, (bf16*)(ws + WS_WUKV) + (size_t)l * 512 * 256, 256, 0, scr, r / 16, r % 16, F.lane, 1.f, a.in[8] + l * 128);
    }
    for (int l = 0; l < L; ++l) {
        bf16* win = (bf16*)(ws + WS_WIN) + (size_t)l * INP * D; bf16* wuq = (bf16*)(ws + WS_WUQ) + (size_t)l * 512 * 256; bf16* wukv = (bf16*)(ws + WS_WUKV) + (size_t)l * 512 * 256;
        zero_rect(win, D, 192, 64, 0, D, gtid, gthreads); zero_rect(win, D, 416, 96, 0, D, gtid, gthreads);
        zero_rect(wuq, 256, 0, 384, 192, 64, gtid, gthreads); zero_rect(wuq, 256, 384, 128, 0, 256, gtid, gthreads);
        zero_rect(wukv, 256, 0, 512, 128, 128, gtid, gthreads);
    }
    { float* rope = (float*)(ws + WS_ROPE); const int* pos = (const int*)a.in[2];
      for (int i = gtid; i < T * 16; i += gthreads) { const int t = i >> 4, k = i & 15; const float inv = powf(10000.f, -(float)(2 * k) / 32.f); const float ang = (float)pos[t] * inv;
          rope[(size_t)t * 32 + k] = cosf(ang); rope[(size_t)t * 32 + 16 + k] = sinf(ang); } }
    { const GAS f32x4* ks = (const GAS f32x4*)a.in[29]; GAS v2u* kd = (GAS v2u*)(ws + WS_KEYS);
      for (int i = gtid; i < L * 2 * 128 * 64 / 4; i += gthreads) { const f32x4 v = ks[i]; v2u w; w.x = pk2(v.x, v.y); w.y = pk2(v.z, v.w); kd[i] = w; }
    }
    for (int r = gw; r < 2 * L * 16384; r += NGW) { const int tb = r / (L * 16384), rr = r % (L * 16384);
        quant_row((const GAS float*)a.in[30 + tb] + (size_t)rr * 1024, (GAS unsigned*)(ws + (tb ? WS_V8 : WS_U8) + (size_t)rr * 1024), (GAS float*)(ws + (tb ? WS_SV : WS_SU)) + rr, 0, F.lane); }
    { float* btab = (float*)(ws + WS_BTAB); float* lams = (float*)(ws + WS_LAMS); float* spt = (float*)(ws + WS_SP);
      for (int i = gtid; i < 4 * 129; i += gthreads) { const int h = i / 129, n = i % 129; int bu; if (n < 16) bu = n; else { const int lg = 16 + (int)(logf((float)n / 16.f) / logf(8.f) * 16.f); bu = lg < 31 ? lg : 31; }
          btab[i] = a.in[3][bu * 4 + h] * LOG2E; }
      for (int i = gtid; i < L; i += gthreads) { const float* dl = a.in[17] + i * 128; float s1 = 0.f, s2 = 0.f; for (int j = 0; j < 32; ++j) { s1 += dl[j] * dl[32 + j]; s2 += dl[64 + j] * dl[96 + j]; }
          const float li = 0.8f - 0.6f * expf(-0.3f * (float)i); lams[2 * i] = expf(s1) - expf(s2) + li; lams[2 * i + 1] = li; }
      for (int i = gtid; i < L * 512; i += gthreads) spt[i] = log1pf(expf(-a.in[16][i])); }
    { GAS bf16* wat = (GAS bf16*)(ws + WS_WAT);
      for (int i = gtid; i < L * 8 * 2 * 4096; i += gthreads) { const int in_ = i & 63, out_ = (i >> 6) & 63, gate = (i >> 12) & 1, lg = i >> 13;
          wat[i] = (bf16)f2bf_(a.in[gate ? 14 : 12][(size_t)lg * 4096 + in_ * 64 + out_]); } }
    for (int l = 0; l < L; ++l) norm_phase((const GAS float*)a.in[1], (const GAS float*)a.in[23] + l * D, (GAS bf16*)(ws + WS_MNB) + (size_t)l * NB * MEM * D, NB * MEM, gw, NGW, F.lane);
}

constexpr int NPL = 16, PH_FINAL = 2 + NPL * L;
__global__ void __launch_bounds__(NWAVES * 64, 2) fwd(Args args) {
    extern __shared__ __attribute__((aligned(16))) unsigned char lds[];
    Frame F;
    F.lds = (LAS unsigned char*)lds; F.MISC = (volatile LAS unsigned*)(F.lds + MISC_OFF);
    F.tid = threadIdx.x; F.lane = F.tid & 63; F.wave = __builtin_amdgcn_readfirstlane(F.tid >> 6); F.G = gridDim.x;
    F.vcu = (F.G % 8 == 0) ? ((int)blockIdx.x % 8) * (F.G / 8) + (int)blockIdx.x / 8 : (int)blockIdx.x;
    unsigned char* ws = args.ws;
    F.ctl = (gu32*)(opq(ws) + WS_CTL);
    for (int u = F.tid; u < (LDS_BYTES - LDSCTL_OFF) / 4; u += NWAVES * 64) ((LAS unsigned*)(F.lds + LDSCTL_OFF))[u] = 0u;
    __syncthreads();
    XcdBarrier bar = xcd_barrier_post((unsigned*)(F.ctl + CW_BAR), F.MISC + 8);
    F.xcc = (int)bar.x;
    if (F.tid == 0) F.MISC[12] = __hip_atomic_fetch_add((unsigned*)(F.ctl + CW_RANK) + 64 * bar.x, 1u, __ATOMIC_RELAXED, __HIP_MEMORY_SCOPE_AGENT);
    __syncthreads();
    F.xrank = __builtin_amdgcn_readfirstlane((int)F.MISC[12]);
    const int lo = args.ph_lo, hi = args.ph_hi;
    const int gw = blockIdx.x * NWAVES + F.wave, NGW = F.G * NWAVES;
#define IN(k) (lo <= (k) && (k) < hi)
#define LANE_ (lane_id_v())
#define TID_ ((opqi(F.wave) << 6) | LANE_)
#define SITE() const int G_ = opqi(F.G), wv_ = opqi(F.wave), vcu_ = opqi(F.vcu), gw_ = opqi(gw), NGW_ = opqi(NGW); (void)G_; (void)wv_; (void)vcu_; (void)gw_; (void)NGW_
#if MK_DUP == 99
#define SEAM(k) do { if (IN(k) && IN((k) + 1)) { xcd_barrier(bar, (F.wave == 0 && lane_id_v() == 0) ? 1 : 0); xcd_barrier(bar, (F.wave == 0 && lane_id_v() == 0) ? 1 : 0); } } while (0)
#else
#define SEAM(k) do { if (IN(k) && IN((k) + 1)) xcd_barrier(bar, (F.wave == 0 && lane_id_v() == 0) ? 1 : 0); } while (0)
#endif
#define GEMM_SITE(EPI, Aptr, lda_, Bptr, ldb_, M_, N_, K_, cperm, ...) do { \
        pg8::Gemm g{opq(Aptr), opq(Bptr), M_, N_, K_, lda_, ldb_}; pg8::StaticOrder So; So.init(M_, N_, opqi(F.G), opqi(cperm)); pg8::EPI E{__VA_ARGS__}; \
        pg8::gemm_phase<pg8::EPI, pg8::StaticOrder, true, true>(F.lds + RING_OFF, g, So, E, opqi(F.wave)); } while (0)
    if (IN(0)) { p0_prologue(F, args); }
    SEAM(0);
    if (IN(1)) {
#pragma unroll 1
        for (int l = 0; l < L; ++l)
            GEMM_SITE(EpiBf16, (const GAS bf16*)(opq(ws) + WS_MNB) + (size_t)l * NB * MEM * D, D, (const GAS bf16*)(opq(ws) + WS_WCKV) + (size_t)l * 2 * D * D, D, NB * MEM, 2 * D, D, (int)((blockIdx.x + 64 * l) % F.G),
                      opq((GAS bf16*)(opq(ws) + WS_KVCB) + (size_t)l * NB * MEM * 2 * D), 2 * D, 2 * D, (const GAS float*)nullptr, 0);
    }
    SEAM(1);
    for (int l = 0; l < L; ++l) {
        const int pb = 2 + NPL * l;
        const GAS bf16* XNB = (const GAS bf16*)(opq(ws) + WS_XNB); const GAS bf16* YB = (const GAS bf16*)(opq(ws) + WS_YB); GAS bf16* PROJB = (GAS bf16*)(opq(ws) + WS_PROJB);
        if (IN(pb + 1)) GEMM_SITE(EpiBf16, XNB, D, (const GAS bf16*)(opq(ws) + WS_WIN) + (size_t)l * INP * D, D, T, INP, D, (int)blockIdx.x, opq(PROJB), INP, INP, opq((const GAS float*)(opq(ws) + WS_SSQ)), 8);
#if MK_DUP == 1
        if (IN(pb + 1)) GEMM_SITE(EpiBf16, XNB, D, (const GAS bf16*)(opq(ws) + WS_WIN) + (size_t)l * INP * D, D, T, INP, D, (int)blockIdx.x, opq(PROJB), INP, INP, opq((const GAS float*)(opq(ws) + WS_SSQ)), 8);
#endif
        SEAM(pb + 1);
        if (IN(pb + 2)) {
            SITE();
            pre_phase(opq((const GAS bf16*)PROJB), opq((const GAS float*)(opq(ws) + WS_ROPE)), opq((GAS float*)(opq(ws) + WS_RS)), opq((GAS bf16*)(opq(ws) + WS_KMB)), gw_, NGW_, LANE_);
#if MK_DUP == 21
            pre_phase(opq((const GAS bf16*)PROJB), opq((const GAS float*)(opq(ws) + WS_ROPE)), opq((GAS float*)(opq(ws) + WS_RS)), opq((GAS bf16*)(opq(ws) + WS_KMB)), gw_, NGW_, LANE_);
#endif
            LruP LP{opq((const GAS bf16*)PROJB), (const GAS float*)args.in[opqi(10)] + l * 4 * 512, (const GAS float*)args.in[opqi(11)] + l * 512, opq((const GAS bf16*)(opq(ws) + WS_WAT)) + (size_t)l * 8 * 2 * 4096, (const GAS float*)args.in[opqi(13)] + l * 512, (const GAS float*)args.in[opqi(15)] + l * 512,
                    (const GAS float*)(opq(ws) + WS_SP) + l * 512, opq((GAS unsigned*)(opq(ws) + WS_HLB)), opq((GAS float*)(opq(ws) + WS_LSUM))};
            lru_phase(LP, F.lds, TID_, wv_, LANE_, vcu_, G_);
#if MK_DUP == 2
            lru_phase(LP, F.lds, TID_, wv_, LANE_, vcu_, G_);
#endif
        }
        SEAM(pb + 2);
        if (IN(pb + 3)) {
            GEMM_SITE(EpiUp, (const GAS bf16*)PROJB + PC_CQ, INP, (const GAS bf16*)(opq(ws) + WS_WUQ) + (size_t)l * 512 * 256, 256, T, 512, 256, (int)blockIdx.x,
                      opq((GAS bf16*)(opq(ws) + WS_QMB)), (GAS bf16*)nullptr, 384, 384, opq((const GAS float*)(opq(ws) + WS_RS)), 0, 0);
            GEMM_SITE(EpiUp, (const GAS bf16*)PROJB + PC_CKV, INP, (const GAS bf16*)(opq(ws) + WS_WUKV) + (size_t)l * 512 * 256, 256, T, 512, 256, (int)blockIdx.x,
                      opq((GAS bf16*)(opq(ws) + WS_KMB)), opq((GAS bf16*)(opq(ws) + WS_VMB)), 0, 512, opq((const GAS float*)(opq(ws) + WS_RS)), 1, 1);
        }
        SEAM(pb + 3);
        if (IN(pb + 4)) {
            SITE();
            AttnP PM{opq((const GAS bf16*)(opq(ws) + WS_QMB)), opq((const GAS bf16*)(opq(ws) + WS_KMB)), opq((const GAS bf16*)(opq(ws) + WS_VMB)), 384, 384, 256, opq((GAS bf16*)(opq(ws) + WS_OMB)), 256, opq((const GAS float*)(opq(ws) + WS_ROPE)), nullptr, nullptr, nullptr, nullptr};
            AttnP PD{opq((const GAS bf16*)PROJB + PC_QD), opq((const GAS bf16*)PROJB + PC_KD), opq((const GAS bf16*)PROJB + PC_VD), INP, INP, INP, opq((GAS bf16*)(opq(ws) + WS_YB) + 768), 1024, nullptr,
                     (const GAS int*)args.in[opqi(2)], (const GAS float*)(opq(ws) + WS_BTAB), (const GAS float*)args.in[opqi(18)] + l * 64, (const GAS float*)(opq(ws) + WS_LAMS) + 2 * l};
            attn_phase(PM, PD, F.lds, TID_, wv_, LANE_, vcu_, G_);
#if MK_DUP == 4
            __syncthreads(); attn_phase(PM, PD, F.lds, TID_, wv_, LANE_, vcu_, G_);
#elif MK_DUP == 40 || MK_DUP == 41
            __syncthreads(); attn_phase(PM, PD, F.lds, TID_, wv_, LANE_, vcu_, G_, MK_DUP - 40);
#endif
        }
        SEAM(pb + 4);
        if (IN(pb + 5)) {
            SITE();
            PostP PP{opq((const GAS bf16*)(opq(ws) + WS_OMB)), opq((const GAS unsigned*)(opq(ws) + WS_HLB)), opq((const GAS float*)(opq(ws) + WS_LSUM)), opq((const GAS bf16*)PROJB), (const GAS float*)args.in[opqi(19)] + l * 256, (const GAS float*)args.in[opqi(20)] + l * 512, opq((GAS bf16*)(opq(ws) + WS_YB))};
            post_phase(PP, F.lds, TID_, wv_, LANE_, vcu_, G_);
#if MK_DUP == 5
            __syncthreads(); post_phase(PP, F.lds, TID_, wv_, LANE_, vcu_, G_);
#endif
        }
        SEAM(pb + 5);
        if (IN(pb + 6)) GEMM_SITE(EpiRes, YB, D, (const GAS bf16*)(opq(ws) + WS_WOUT) + (size_t)l * D * D, D, T, D, D, (int)blockIdx.x, opq((GAS bf16*)(opq(ws) + WS_XNB)), opq((GAS float*)(opq(ws) + WS_SSQ)));
#if MK_DUP == 6
        if (IN(pb + 6)) GEMM_SITE(EpiRes, YB, D, (const GAS bf16*)(opq(ws) + WS_WOUT) + (size_t)l * D * D, D, T, D, D, (int)blockIdx.x, opq((GAS bf16*)(opq(ws) + WS_HLB)), opq((GAS float*)(opq(ws) + WS_OMB)));
#endif
        SEAM(pb + 6);
        if (IN(pb + 8)) GEMM_SITE(EpiBf16, XNB, D, (const GAS bf16*)(opq(ws) + WS_WCQ) + (size_t)l * D * D, D, T, D, D, (int)blockIdx.x, opq(PROJB), D, D, opq((const GAS float*)(opq(ws) + WS_SSQ)), 16);
#if MK_DUP == 8
        if (IN(pb + 8)) GEMM_SITE(EpiBf16, XNB, D, (const GAS bf16*)(opq(ws) + WS_WCQ) + (size_t)l * D * D, D, T, D, D, (int)blockIdx.x, opq(PROJB), D, D, opq((const GAS float*)(opq(ws) + WS_SSQ)), 16);
#endif
        SEAM(pb + 8);
        if (IN(pb + 9)) {
            SITE();
            const GAS bf16* kv = (const GAS bf16*)(opq(ws) + WS_KVCB) + (size_t)l * NB * MEM * 2 * D;
            AttnP PC{opq((const GAS bf16*)PROJB), opq(kv), opq(kv + D), 1024, 2 * D, 2 * D, opq((GAS bf16*)(opq(ws) + WS_YB)), 1024, nullptr, nullptr, nullptr, nullptr, nullptr};
            cross_phase(PC, F.lds, TID_, wv_, LANE_, vcu_, G_);
#if MK_DUP == 9
            cross_phase(PC, F.lds, TID_, wv_, LANE_, vcu_, G_);
#endif
        }
        SEAM(pb + 9);
        if (IN(pb + 10)) GEMM_SITE(EpiRes, YB, D, (const GAS bf16*)(opq(ws) + WS_WCO) + (size_t)l * D * D, D, T, D, D, (int)blockIdx.x, opq((GAS bf16*)(opq(ws) + WS_XNB)), opq((GAS float*)(opq(ws) + WS_SSQ)));
        SEAM(pb + 10);
        if (IN(pb + 12)) { GEMM_SITE(EpiBf16, XNB, D, (const GAS bf16*)(opq(ws) + WS_WPQ) + (size_t)l * D * D, D, T, D, D, (int)blockIdx.x, opq(PROJB), D, D, opq((const GAS float*)(opq(ws) + WS_SSQ)), 16);
            SITE(); hq_phase(opq(XNB), opq((const GAS float*)(opq(ws) + WS_SSQ)), (const GAS float*)args.in[opqi(27)] + l * D, opq((GAS unsigned char*)(opq(ws) + WS_HQ)), opq((GAS float*)(opq(ws) + WS_SH)), opq((GAS int*)(opq(ws) + WS_P)), gw_, NGW_, LANE_);
#if MK_DUP == 12
            hq_phase(opq(XNB), opq((const GAS float*)(opq(ws) + WS_SSQ)), (const GAS float*)args.in[opqi(27)] + l * D, opq((GAS unsigned char*)(opq(ws) + WS_HQ)), opq((GAS float*)(opq(ws) + WS_SH)), opq((GAS int*)(opq(ws) + WS_P)), gw_, NGW_, LANE_);
#endif
            }
        SEAM(pb + 12);
        if (IN(pb + 13)) {
            SITE();
            RouteP RP{opq((const GAS bf16*)PROJB), opq((const GAS bf16*)(opq(ws) + WS_KEYS) + (size_t)l * 2 * 128 * 64), opq((GAS int*)(opq(ws) + WS_EX)), opq((GAS float*)(opq(ws) + WS_GW))};
            route_phase(RP, F.lds, TID_, wv_, LANE_, vcu_, G_);
#if MK_DUP == 13
            route_phase(RP, F.lds, TID_, wv_, LANE_, vcu_, G_);
#endif
        }
        SEAM(pb + 13);
        if (IN(pb + 14)) {
            SITE();
            const PeerS ps = peer_sched((const GAS unsigned*)(F.ctl + CW_RANK), opqi(F.xcc), opqi(F.xrank));
            Peer1P Q1{opq((const GAS unsigned char*)(opq(ws) + WS_HQ)), opq((const GAS int*)(opq(ws) + WS_EX)), opq((const GAS unsigned char*)(opq(ws) + WS_U8) + (size_t)l * 16384 * 1024), opq((GAS int*)(opq(ws) + WS_P))};
            peer_k1(Q1, ps, wv_, LANE_);
#if MK_DUP == 141
            { Peer1P Q1b = Q1; Q1b.P = (GAS int*)(opq(ws) + WS_PROJB); peer_k1(Q1b, ps, wv_, LANE_); }
#endif
        }
        SEAM(pb + 14);
        if (IN(pb + 15)) {
            SITE();
            peer_w(opq((const GAS int*)(opq(ws) + WS_EX)), opq((const GAS float*)(opq(ws) + WS_GW)), opq((const GAS int*)(opq(ws) + WS_P)), opq((const GAS float*)(opq(ws) + WS_SH)), opq((const GAS float*)(opq(ws) + WS_SU) + l * 16384), opq((const GAS float*)(opq(ws) + WS_SV) + l * 16384),
                   opq((GAS signed char*)(opq(ws) + WS_W)), opq((GAS float*)(opq(ws) + WS_WS)), gw_, NGW_, LANE_);
            xcd_barrier(bar, (F.wave == 0 && lane_id_v() == 0) ? 1 : 0);
            const PeerS ps = peer_sched((const GAS unsigned*)(F.ctl + CW_RANK), opqi(F.xcc), opqi(F.xrank));
            Peer2P Q2{opq((const GAS int*)(opq(ws) + WS_EX)), opq((const GAS signed char*)(opq(ws) + WS_W)), opq((const GAS float*)(opq(ws) + WS_WS)), opq((const GAS unsigned char*)(opq(ws) + WS_V8) + (size_t)l * 16384 * 1024), opq((GAS bf16*)(opq(ws) + WS_XNB)), opq((GAS float*)(opq(ws) + WS_SSQ))};
            peer_k2(Q2, ps, wv_, LANE_);
#if MK_DUP == 151
            { Peer2P Q2b = Q2; Q2b.XB = (GAS bf16*)(opq(ws) + WS_HLB); Q2b.SSQ = (GAS float*)(opq(ws) + WS_OMB); peer_k2(Q2b, ps, wv_, LANE_); }
#endif
        }
        SEAM(pb + 15);
    }
    if (IN(PH_FINAL)) { SITE(); final_norm_phase(opq((const GAS bf16*)(opq(ws) + WS_XNB)), (GAS float*)args.out, (const GAS float*)args.in[opqi(32)], T, gw_, NGW_, LANE_); }
#undef IN
#undef SEAM
#undef GEMM_SITE
}
}
extern "C" void kernel_launch(void* const* d_in, const int* in_sizes, int n_in, void* d_out, int out_size, void* d_ws, size_t ws_size, hipStream_t stream) {
    (void)in_sizes; (void)out_size;
    static int grid = 0;
    if (grid == 0) {
        int dev = 0, cus = 0, per_cu = 0;
        if (n_in != 33 || ws_size < mk::WS_END) { fprintf(stderr, "kernel_launch: unexpected n_in %d / ws_size %zu\n", n_in, ws_size); grid = -1; return; }
        if (hipGetDevice(&dev) != hipSuccess || hipDeviceGetAttribute(&cus, hipDeviceAttributeMultiprocessorCount, dev) != hipSuccess) { grid = -1; return; }
        if (hipFuncSetAttribute((const void*)mk::fwd, hipFuncAttributeMaxDynamicSharedMemorySize, mk::LDS_BYTES) != hipSuccess) { fprintf(stderr, "kernel_launch: hipFuncSetAttribute failed\n"); grid = -1; return; }
        if (hipOccupancyMaxActiveBlocksPerMultiprocessor(&per_cu, (const void*)mk::fwd, mk::NWAVES * 64, mk::LDS_BYTES) != hipSuccess || per_cu < 1) fprintf(stderr, "kernel_launch: occupancy query says %d\n", per_cu);
        (void)hipGetLastError();
        grid = cus;
    }
    if (grid < 0) return;
    unsigned char* ws = (unsigned char*)d_ws;
    (void)hipMemsetAsync(ws + mk::WS_CTL, 0, mk::CTL_ZERO_BYTES, stream);
    mk::Args a{};
    for (int i = 0; i < 33; ++i) a.in[i] = (const float*)d_in[i];
    a.out = (float*)d_out; a.ws = ws;
    auto run = [&](int lo, int hi) { a.ph_lo = lo; a.ph_hi = hi; hipLaunchKernelGGL(mk::fwd, dim3(grid), dim3(mk::NWAVES * 64), mk::LDS_BYTES, stream, a); };
#if MK_ONE_LAUNCH
    run(0, mk::PH_FINAL + 1);
#else
    for (int p = 0; p <= mk::PH_FINAL; ++p) {
        const int k = (p - 2) % mk::NPL, l = (p - 2) / mk::NPL;
#if MK_NAIVE_PEER == 2
        if (p >= 2 && p < mk::PH_FINAL && k == 14) {
            hipLaunchKernelGGL(k_peer, dim3(T), dim3(256), 0, stream, (const bf16_t*)(ws + mk::WS_XNB), (const int*)(ws + mk::WS_EX), (const float*)(ws + mk::WS_GW), (const float*)d_in[30] + (size_t)l * NEXP * D, (const float*)d_in[31] + (size_t)l * NEXP * D, (float*)d_out);
            continue; }
#elif MK_NAIVE_PEER == 1
        if (p >= 2 && p < mk::PH_FINAL && k == 13) {
            float* TQ = (float*)(ws + (size_t)806 * mk::MiB);
            hipLaunchKernelGGL(k_bf2f, dim3((unsigned)(((size_t)T * D + 255) / 256)), dim3(256), 0, stream, (const bf16_t*)(ws + mk::WS_PROJB), TQ, (long)T * D);
            hipLaunchKernelGGL(k_route, dim3(T), dim3(256), 0, stream, TQ, (const float*)d_in[29] + (size_t)l * 2 * 128 * 64, (int*)(ws + mk::WS_EX), (float*)(ws + mk::WS_GW));
            hipLaunchKernelGGL(k_peer, dim3(T), dim3(256), 0, stream, (const bf16_t*)(ws + mk::WS_XNB), (const int*)(ws + mk::WS_EX), (const float*)(ws + mk::WS_GW), (const float*)d_in[30] + (size_t)l * NEXP * D, (const float*)d_in[31] + (size_t)l * NEXP * D, (float*)d_out);
            continue; }
        if (p >= 2 && p < mk::PH_FINAL && k == 14) continue;
#endif
        run(p, p + 1); }
#endif
}
```

```cpp
#include <hip/hip_runtime.h>
#include <cstdint>
#include <cstdio>
#include <cmath>

#ifndef MK_ONE_LAUNCH
#define MK_ONE_LAUNCH 1
#endif
#ifndef MK_DUP
#define MK_DUP 0
#endif
#ifndef MK_NAIVE_PEER
#define MK_NAIVE_PEER 0
#endif
namespace pg8 {
#define PG8_LAS __attribute__((address_space(3)))
#ifndef GAS
#define GAS __attribute__((address_space(1)))
#endif
typedef unsigned short bf16_t;
typedef short bf16x8 __attribute__((ext_vector_type(8)));
typedef float f32x4 __attribute__((ext_vector_type(4)));
typedef unsigned u32x4 __attribute__((ext_vector_type(4)));
typedef unsigned u32x2 __attribute__((ext_vector_type(2)));
constexpr int BM = 256, BK = 64, HALF = 128, HTB = HALF * BK * 2, STAGE_BYTES = 8 * HTB, NXCD = 8, WGM = 8;
__host__ __device__ __forceinline__ int lds_byte(int r, int c) { const int st = (r >> 4) * 2 + (c >> 5), rr = r & 15, cc = c & 31, ob = rr * 64 + cc * 2; return st * 1024 + (ob ^ (((ob >> 9) & 1) << 5)); }
__host__ __device__ __forceinline__ void stage_rc(int b, int& R, int& C) { const int st = b / 1024, sb = b % 1024, swz = sb ^ (((sb >> 9) & 1) << 5); R = (st >> 1) * 16 + swz / 64; C = (st & 1) * 32 + (swz % 64) / 2; }
__host__ __device__ __forceinline__ int perm32(int rho) { const int n = rho >> 4, i = rho & 15; return 8 * (i >> 2) + 4 * n + (i & 3); }
__device__ __forceinline__ int pg8_lane_id() { int l; asm volatile("v_mbcnt_lo_u32_b32 %0, -1, 0\n\tv_mbcnt_hi_u32_b32 %0, -1, %0" : "=v"(l)); return l; }
struct Unit { int pm, pn; };
struct Gemm { const GAS bf16_t* A; const GAS bf16_t* Bt; int M, N, K, lda, ldb; };
struct StaticOrder {
    int nM, nN, nwg, G, c;
    __host__ __device__ void init(int M, int N, int G_, int c_) { nM = M / BM; nN = N / BM; nwg = nM * nN; G = G_; c = c_; }
    __host__ __device__ bool next(int i, Unit& u) const {
        const long L = (long)i * G + c; if (L >= nwg) return false;
        int wgid = (int)L; { const int q = nwg / NXCD, r = nwg % NXCD, xcd = wgid % NXCD, off = wgid / NXCD; wgid = (xcd < r ? xcd * (q + 1) : r * (q + 1) + (xcd - r) * q) + off; }
        const int nig = WGM * nN, gid = wgid / nig, fm = gid * WGM, gsz = (nM - fm) < WGM ? (nM - fm) : WGM;
        u.pm = fm + ((wgid % nig) % gsz); u.pn = (wgid % nig) / gsz; return true;
    }
    __device__ __forceinline__ void a_ready(const Unit&) const {}
    __device__ __forceinline__ void done(const Unit&) const {}
};
__device__ __forceinline__ unsigned cvt_pk_bf16(float lo, float hi) { unsigned r; asm volatile("v_cvt_pk_bf16_f32 %0, %1, %2" : "=v"(r) : "v"(lo), "v"(hi)); return r; }

struct EpiF32 {
    static constexpr bool PERM = false, AFTER_DRAIN = false;
    GAS float* C; int ldc; int nvalid; int accum;
    __device__ __forceinline__ void operator()(const f32x4 (&acc)[2][2][4][2], const Unit& u, int wr, int wc, int fr, int fq) const {
        { const int l_ = pg8_lane_id(); fr = l_ & 15; fq = l_ >> 4; }
#pragma unroll
        for (int ai = 0; ai < 2; ++ai)
#pragma unroll
            for (int m = 0; m < 4; ++m) { const size_t row = (size_t)u.pm * BM + ai * HALF + wr * 64 + m * 16 + fr;
#pragma unroll
                for (int bj = 0; bj < 2; ++bj)
#pragma unroll
                    for (int n = 0; n < 2; ++n) { const int col = u.pn * BM + bj * HALF + wc * 32 + n * 16 + 4 * fq;
                        if (col < nvalid) { GAS float* p = C + row * ldc + col; f32x4 v = acc[ai][bj][m][n]; if (accum) v += *(const GAS f32x4*)p; *(GAS f32x4*)p = v; } } }
    }
};
struct EpiBf16 {
    static constexpr bool PERM = true, AFTER_DRAIN = false;
    GAS bf16_t* O; int ldc; int nvalid; const GAS float* ssq; int np;
    __device__ __forceinline__ void operator()(const f32x4 (&acc)[2][2][4][2], const Unit& u, int wr, int wc, int fr, int fq) const {
        { const int l_ = pg8_lane_id(); fr = l_ & 15; fq = l_ >> 4; }
#pragma unroll
        for (int ai = 0; ai < 2; ++ai)
#pragma unroll
            for (int m = 0; m < 4; ++m) { const size_t row = (size_t)u.pm * BM + ai * HALF + wr * 64 + m * 16 + fr;
                float rs_ = 1.f;
                if (np > 0) { const GAS f32x4* sp = (const GAS f32x4*)(ssq + row * 16); f32x4 t = sp[0] + sp[1]; if (np > 8) t += sp[2] + sp[3]; rs_ = __builtin_amdgcn_rsqf(((t[0] + t[1]) + (t[2] + t[3])) * (1.f / 1024.f) + 1e-6f); }
#pragma unroll
                for (int bj = 0; bj < 2; ++bj) { const int col = u.pn * BM + bj * HALF + wc * 32 + 8 * fq;
                    if (col < nvalid) { const f32x4 v0 = acc[ai][bj][m][0] * rs_, v1 = acc[ai][bj][m][1] * rs_; u32x4 w; w.x = cvt_pk_bf16(v0[0], v0[1]); w.y = cvt_pk_bf16(v0[2], v0[3]); w.z = cvt_pk_bf16(v1[0], v1[1]); w.w = cvt_pk_bf16(v1[2], v1[3]);
                        *(GAS u32x4*)(O + row * ldc + col) = w; } } }
    }
};
struct EpiUp {
    static constexpr bool PERM = true, AFTER_DRAIN = false;
    GAS bf16_t* O; GAS bf16_t* O2; int ldc; int nvalid; const GAS float* rs; int rsi; int mode;
    __device__ __forceinline__ void operator()(const f32x4 (&acc)[2][2][4][2], const Unit& u, int wr, int wc, int fr, int fq) const {
        { const int l_ = pg8_lane_id(); fr = l_ & 15; fq = l_ >> 4; }
#pragma unroll
        for (int ai = 0; ai < 2; ++ai)
#pragma unroll
            for (int m = 0; m < 4; ++m) { const size_t row = (size_t)u.pm * BM + ai * HALF + wr * 64 + m * 16 + fr; const float s = rs[2 * row + rsi];
#pragma unroll
                for (int bj = 0; bj < 2; ++bj) { const int col = u.pn * BM + bj * HALF + wc * 32 + 8 * fq;
                    if (col < nvalid) { const f32x4 v0 = acc[ai][bj][m][0] * s, v1 = acc[ai][bj][m][1] * s; u32x4 w; w.x = cvt_pk_bf16(v0[0], v0[1]); w.y = cvt_pk_bf16(v0[2], v0[3]); w.z = cvt_pk_bf16(v1[0], v1[1]); w.w = cvt_pk_bf16(v1[2], v1[3]);
                        GAS bf16_t* dst;
                        if (mode == 0) dst = O + row * ldc + col;
                        else { const int h = col >> 7, j = col & 127; dst = (j < 64) ? O + row * 384 + h * 96 + j : O2 + row * 256 + h * 64 + (j - 64); }
                        *(GAS u32x4*)dst = w; } } }
    }
};

struct EpiRes {
    static constexpr bool PERM = true, AFTER_DRAIN = false;
    GAS bf16_t* XB; GAS float* SSQ;
    __device__ __forceinline__ void operator()(const f32x4 (&acc)[2][2][4][2], const Unit& u, int wr, int wc, int fr, int fq) const {
        { const int l_ = pg8_lane_id(); fr = l_ & 15; fq = l_ >> 4; }
#pragma unroll
        for (int ai = 0; ai < 2; ++ai)
#pragma unroll
            for (int m = 0; m < 4; ++m) { const size_t row = (size_t)u.pm * BM + ai * HALF + wr * 64 + m * 16 + fr; float ss = 0.f;
#pragma unroll
                for (int bj = 0; bj < 2; ++bj) { GAS u32x4* p = (GAS u32x4*)(XB + row * 1024 + u.pn * BM + bj * HALF + wc * 32 + 8 * fq);
                    const u32x4 o = *p; const f32x4 v0 = acc[ai][bj][m][0], v1 = acc[ai][bj][m][1];
                    u32x4 w;
                    w.x = cvt_pk_bf16(__builtin_bit_cast(float, o.x << 16) + v0[0], __builtin_bit_cast(float, o.x & 0xffff0000u) + v0[1]);
                    w.y = cvt_pk_bf16(__builtin_bit_cast(float, o.y << 16) + v0[2], __builtin_bit_cast(float, o.y & 0xffff0000u) + v0[3]);
                    w.z = cvt_pk_bf16(__builtin_bit_cast(float, o.z << 16) + v1[0], __builtin_bit_cast(float, o.z & 0xffff0000u) + v1[1]);
                    w.w = cvt_pk_bf16(__builtin_bit_cast(float, o.w << 16) + v1[2], __builtin_bit_cast(float, o.w & 0xffff0000u) + v1[3]);
                    *p = w;
#pragma unroll
                    for (int e = 0; e < 4; ++e) { const float a = __builtin_bit_cast(float, w[e] << 16), b = __builtin_bit_cast(float, w[e] & 0xffff0000u); ss += a * a + b * b; } }
                { float a = ss, b = ss; asm volatile("v_nop\n\tv_nop\n\tv_permlane16_swap_b32 %0, %1" : "+v"(a), "+v"(b)); ss = a + b; }
                { float a = ss, b = ss; asm volatile("v_nop\n\tv_nop\n\tv_permlane32_swap_b32 %0, %1" : "+v"(a), "+v"(b)); ss = a + b; }
                if (fq == 0) SSQ[row * 16 + 4 * u.pn + wc] = ss; }
    }
};
template <class Epi, class Sched, bool ALIGN_EPI = false, bool SP2 = false>
__device__ __forceinline__ void gemm_phase(PG8_LAS unsigned char* lds, const Gemm g, const Sched& S, const Epi& E, int wave_id) {
    int tid_ = (wave_id << 6) | pg8_lane_id(); asm volatile("" : "+v"(tid_));
    const int tid = tid_, wid = __builtin_amdgcn_readfirstlane(tid >> 6), lane = tid & 63, wr = wid >> 2, wc = wid & 3, fr = lane & 15, fq = lane >> 4;
    const int K = g.K, nt = K / BK;
    unsigned voffA[2], voffB[2];
#pragma unroll
    for (int i = 0; i < 2; ++i) { int R, C; stage_rc(tid * 16 + i * 8192, R, C); const int Rb = Epi::PERM ? ((R & ~31) + perm32(R & 31)) : R;
        voffA[i] = (unsigned)(R * g.lda + C) * 2u; voffB[i] = (unsigned)(Rb * g.ldb + C) * 2u; }
    const size_t kstep = (size_t)(BK * 2);
    const size_t hstepA = (size_t)HALF * g.lda * 2, hstepB = (size_t)HALF * g.ldb * 2;
    const size_t tstepA = 2 * hstepA, tstepB = 2 * hstepB;
    const unsigned ldsw = (unsigned)wid * 1024u;
    const int aoff = lds_byte(wr * 64 + fr, fq * 8), boff = lds_byte(wc * 32 + fr, fq * 8);
#define PG8_SA(b, h) (((b) * 2 + (h)) * HTB)
#define PG8_SB(b, h) ((4 + (b) * 2 + (h)) * HTB)
#define PG8_STAGE(bufoff, gbase, voff) do { _Pragma("unroll") for (int _i = 0; _i < 2; ++_i) \
        __builtin_amdgcn_global_load_lds((const unsigned*)((const char*)(gbase) + (voff)[_i]), (PG8_LAS unsigned*)(lds + (bufoff) + ldsw + _i * 8192), 16, 0, 0); } while (0)
#define PG8_LDA(dst, b, h) do { _Pragma("unroll") for (int m = 0; m < 4; ++m) _Pragma("unroll") for (int k = 0; k < 2; ++k) dst[m][k] = *(const PG8_LAS bf16x8*)(lds + PG8_SA(b, h) + aoff + m * 2048 + k * 1024); } while (0)
#define PG8_LDB(dst, b, h) do { _Pragma("unroll") for (int n = 0; n < 2; ++n) _Pragma("unroll") for (int k = 0; k < 2; ++k) dst[n][k] = *(const PG8_LAS bf16x8*)(lds + PG8_SB(b, h) + boff + n * 2048 + k * 1024); } while (0)
#define PG8_MMA(ai, bj, At, Bt) do { __builtin_amdgcn_s_setprio(1); _Pragma("unroll") for (int m = 0; m < 4; ++m) _Pragma("unroll") for (int n = 0; n < 2; ++n) _Pragma("unroll") for (int k = 0; k < 2; ++k) \
        acc[ai][bj][m][n] = __builtin_amdgcn_mfma_f32_16x16x32_bf16(Bt[n][k], At[m][k], acc[ai][bj][m][n], 0, 0, 0); __builtin_amdgcn_s_setprio(0); } while (0)
#define PG8_WAIT_V(n) asm volatile("s_waitcnt vmcnt(" #n ")" ::: "memory")
#define PG8_WAIT_L(n) asm volatile("s_waitcnt lgkmcnt(" #n ")" ::: "memory")
#define PG8_BAR __builtin_amdgcn_s_barrier()
#define PG8_SCHED __builtin_amdgcn_sched_barrier(0)
    Unit cur, nxt; int ui = 0;
    if (!S.next(0, cur)) return;
    f32x4 acc[2][2][4][2];
#pragma unroll
    for (int a = 0; a < 2; ++a)
#pragma unroll
        for (int b = 0; b < 2; ++b)
#pragma unroll
            for (int m = 0; m < 4; ++m)
#pragma unroll
                for (int n = 0; n < 2; ++n) acc[a][b][m][n] = (f32x4){0.f, 0.f, 0.f, 0.f};
    bf16x8 At[4][2], B0[2][2], B1[2][2];
    const char* cA = (const char*)g.A + (size_t)cur.pm * tstepA; const char* cB = (const char*)g.Bt + (size_t)cur.pn * tstepB;
    S.a_ready(cur);
    if constexpr (SP2) {
        PG8_STAGE(PG8_SB(0, 0), cB, voffB); PG8_STAGE(PG8_SB(0, 1), cB + hstepB, voffB); PG8_STAGE(PG8_SA(0, 0), cA, voffA); PG8_STAGE(PG8_SA(0, 1), cA + hstepA, voffA);
        if (wr == 1) PG8_BAR;
        PG8_WAIT_V(2); PG8_BAR;
        PG8_STAGE(PG8_SB(1, 0), cB + kstep, voffB); PG8_STAGE(PG8_SA(1, 0), cA + kstep, voffA); PG8_STAGE(PG8_SB(1, 1), cB + hstepB + kstep, voffB);
        PG8_WAIT_V(6); PG8_BAR;
    } else {
        PG8_STAGE(PG8_SB(0, 0), cB, voffB); PG8_STAGE(PG8_SA(0, 0), cA, voffA); PG8_STAGE(PG8_SB(0, 1), cB + hstepB, voffB); PG8_STAGE(PG8_SA(0, 1), cA + hstepA, voffA);
        if (wr == 1) PG8_BAR;
        PG8_WAIT_V(4); PG8_BAR;
        PG8_STAGE(PG8_SB(1, 0), cB + kstep, voffB); PG8_STAGE(PG8_SA(1, 0), cA + kstep, voffA); PG8_STAGE(PG8_SB(1, 1), cB + hstepB + kstep, voffB);
        PG8_WAIT_V(6); PG8_BAR;
    }
    for (;;) {
        const bool has_next = S.next(ui + 1, nxt);
        const char* nA = has_next ? (const char*)g.A + (size_t)nxt.pm * tstepA : cA; const char* nB = has_next ? (const char*)g.Bt + (size_t)nxt.pn * tstepB : cB;
        for (int t = 0; t < nt; t += 2) {
            const bool last = (t == nt - 2);
            const char* a1 = cA + (size_t)(t + 1) * kstep;
            const char* a2 = last ? nA : cA + (size_t)(t + 2) * kstep; const char* b2 = last ? nB : cB + (size_t)(t + 2) * kstep;
            const char* a3 = a2 + kstep; const char* b3 = b2 + kstep;
            if (last && has_next) S.a_ready(nxt);
            if constexpr (SP2) {
            PG8_LDB(B0, 0, 0); PG8_LDB(B1, 0, 1); PG8_SCHED; PG8_LDA(At, 0, 0); PG8_STAGE(PG8_SA(1, 1), a1 + hstepA, voffA);
            PG8_WAIT_V(8); PG8_WAIT_L(0); PG8_BAR; PG8_MMA(0, 0, At, B0); PG8_MMA(0, 1, At, B1); PG8_BAR; PG8_SCHED;
            PG8_LDA(At, 0, 1); PG8_STAGE(PG8_SB(0, 0), b2, voffB); PG8_STAGE(PG8_SB(0, 1), b2 + hstepB, voffB); PG8_STAGE(PG8_SA(0, 0), a2, voffA);
            PG8_WAIT_V(8); PG8_WAIT_L(0); PG8_BAR; PG8_MMA(1, 0, At, B0); PG8_MMA(1, 1, At, B1); PG8_BAR; PG8_SCHED;
            PG8_LDB(B0, 1, 0); PG8_LDB(B1, 1, 1); PG8_SCHED; PG8_LDA(At, 1, 0); PG8_STAGE(PG8_SA(0, 1), a2 + hstepA, voffA);
            PG8_WAIT_V(8); PG8_WAIT_L(0); PG8_BAR; PG8_MMA(0, 0, At, B0); PG8_MMA(0, 1, At, B1); PG8_BAR; PG8_SCHED;
            PG8_LDA(At, 1, 1); PG8_STAGE(PG8_SB(1, 0), b3, voffB); PG8_STAGE(PG8_SB(1, 1), b3 + hstepB, voffB); PG8_STAGE(PG8_SA(1, 0), a3, voffA);
            PG8_WAIT_V(8); PG8_WAIT_L(0); PG8_BAR; PG8_MMA(1, 0, At, B0); PG8_MMA(1, 1, At, B1); PG8_BAR; PG8_SCHED;
            } else {
            PG8_LDB(B0, 0, 0); PG8_SCHED; PG8_LDA(At, 0, 0); PG8_STAGE(PG8_SA(1, 1), a1 + hstepA, voffA);
            PG8_WAIT_L(8); PG8_BAR; PG8_WAIT_L(0); PG8_MMA(0, 0, At, B0); PG8_BAR; PG8_SCHED;
            PG8_LDB(B1, 0, 1); PG8_STAGE(PG8_SB(0, 0), b2, voffB);
            PG8_BAR; PG8_WAIT_L(0); PG8_MMA(0, 1, At, B1); PG8_BAR;
            PG8_LDA(At, 0, 1); PG8_STAGE(PG8_SA(0, 0), a2, voffA);
            PG8_BAR; PG8_WAIT_L(0); PG8_MMA(1, 0, At, B0); PG8_BAR; PG8_SCHED;
            PG8_STAGE(PG8_SB(0, 1), b2 + hstepB, voffB);
            PG8_WAIT_V(6); PG8_BAR; PG8_MMA(1, 1, At, B1); PG8_BAR;
            PG8_LDB(B0, 1, 0); PG8_SCHED; PG8_LDA(At, 1, 0); PG8_STAGE(PG8_SA(0, 1), a2 + hstepA, voffA);
            PG8_WAIT_L(8); PG8_BAR; PG8_WAIT_L(0); PG8_MMA(0, 0, At, B0); PG8_BAR; PG8_SCHED;
            PG8_LDB(B1, 1, 1); PG8_STAGE(PG8_SB(1, 0), b3, voffB);
            PG8_BAR; PG8_WAIT_L(0); PG8_MMA(0, 1, At, B1); PG8_BAR;
            PG8_LDA(At, 1, 1); PG8_STAGE(PG8_SA(1, 0), a3, voffA);
            PG8_BAR; PG8_WAIT_L(0); PG8_MMA(1, 0, At, B0); PG8_BAR; PG8_SCHED;
            PG8_STAGE(PG8_SB(1, 1), b3 + hstepB, voffB);
            PG8_WAIT_V(6); PG8_BAR; PG8_MMA(1, 1, At, B1); PG8_BAR;
            }
        }
        if constexpr (ALIGN_EPI) { if (wr == 0) PG8_BAR; }
        if constexpr (!Epi::AFTER_DRAIN) { E(acc, cur, wr, wc, fr, fq); S.done(cur); }
        if (!has_next) break;
#pragma unroll
        for (int a = 0; a < 2; ++a)
#pragma unroll
            for (int b = 0; b < 2; ++b)
#pragma unroll
                for (int m = 0; m < 4; ++m)
#pragma unroll
                    for (int n = 0; n < 2; ++n) acc[a][b][m][n] = (f32x4){0.f, 0.f, 0.f, 0.f};
        cur = nxt; cA = nA; cB = nB; ++ui;
        if constexpr (ALIGN_EPI) { if (wr == 1) PG8_BAR; }
    }
    PG8_WAIT_V(0);
    if constexpr (!ALIGN_EPI) { if (wr == 0) PG8_BAR; }
    PG8_BAR;
    if constexpr (Epi::AFTER_DRAIN) { E.fused(acc, cur, wr, wc, fr, fq, lds, wid, lane); S.done(cur); }
#undef PG8_SA
#undef PG8_SB
#undef PG8_STAGE
#undef PG8_LDA
#undef PG8_LDB
#undef PG8_MMA
#undef PG8_WAIT_V
#undef PG8_WAIT_L
#undef PG8_BAR
#undef PG8_SCHED
}
}

namespace mk {
#ifndef GAS
#define GAS __attribute__((address_space(1)))
#endif
#define LAS __attribute__((address_space(3)))
typedef unsigned short bf16;
typedef unsigned v4u __attribute__((ext_vector_type(4)));
typedef unsigned v2u __attribute__((ext_vector_type(2)));
typedef float f32x4 __attribute__((ext_vector_type(4)));
typedef GAS unsigned gu32;
#define LDS_WAIT() asm volatile("s_waitcnt lgkmcnt(0)" ::: "memory")
#define VM_WAIT() asm volatile("s_waitcnt vmcnt(0)" ::: "memory")
__device__ __forceinline__ unsigned f2bf_(float f) { unsigned u = __builtin_bit_cast(unsigned, f); return (u + 0x7fffu + ((u >> 16) & 1u)) >> 16; }
__device__ __forceinline__ unsigned pk2(float lo, float hi) { return f2bf_(lo) | (f2bf_(hi) << 16); }
__device__ __forceinline__ float bflo(unsigned w) { return __builtin_bit_cast(float, w << 16); }
__device__ __forceinline__ float bfhi(unsigned w) { return __builtin_bit_cast(float, w & 0xffff0000u); }

template <class P> __device__ __forceinline__ P* opq(P* p) { asm volatile("" : "+s"(p)); return p; }
__device__ __forceinline__ int opqi(int k) { asm volatile("" : "+s"(k)); return k; }
__device__ __forceinline__ float shx(float v, int o, int lane) { return __builtin_bit_cast(float, __builtin_amdgcn_ds_bpermute((lane ^ o) << 2, __builtin_bit_cast(int, v))); }
__device__ __forceinline__ int shxi(int v, int o, int lane) { return __builtin_amdgcn_ds_bpermute((lane ^ o) << 2, v); }
__device__ __forceinline__ int lane_id_v() { int l; asm volatile("v_mbcnt_lo_u32_b32 %0, -1, 0\n\tv_mbcnt_hi_u32_b32 %0, -1, %0" : "=v"(l)); return l; }
constexpr int NWAVES = 8;
constexpr int D = 1024, NB = 4, S = 8192, T = NB * S, L = 4, MEM = 256, INW = 2144, INP = 2304;
constexpr int PC_CQ = 0, PC_CKV = 256, PC_KR = 384, PC_XL = 512, PC_GL = 1024, PC_QD = 1536, PC_KD = 1792, PC_VD = 2048;
constexpr float LOG2E = 1.4426950408889634f;
constexpr size_t MiB = 1u << 20;
constexpr size_t WS_CTL = 0, CTL_ZERO_BYTES = 1 * MiB;
constexpr size_t WS_WIN = 1 * MiB, WS_WOUT = 19 * MiB, WS_WCQ = 27 * MiB, WS_WCO = 35 * MiB, WS_WPQ = 43 * MiB, WS_WCKV = 51 * MiB, WS_WUQ = 67 * MiB, WS_WUKV = 68 * MiB, WS_KEYS = 69 * MiB, WS_ROPE = 70 * MiB;
constexpr size_t WS_XNB = 76 * MiB, WS_YB = 140 * MiB, WS_PROJB = 204 * MiB, WS_QMB = 348 * MiB, WS_KMB = 372 * MiB, WS_VMB = 396 * MiB, WS_RS = 412 * MiB;
constexpr size_t WS_HLB = 413 * MiB, WS_ACB = 445 * MiB, WS_LSUM = 477 * MiB, WS_OMB = 478 * MiB, WS_MNB = 494 * MiB, WS_KVCB = 502 * MiB, WS_EX = 518 * MiB, WS_GW = 534 * MiB;
constexpr size_t WS_U8 = 550 * MiB, WS_V8 = 614 * MiB, WS_SU = 678 * MiB, WS_SV = 679 * MiB;
constexpr size_t WS_HQ = 680 * MiB, WS_P = 712 * MiB, WS_SH = 728 * MiB, WS_W = 729 * MiB, WS_WS = 745 * MiB, WS_SSQ = 746 * MiB, WS_END = 748 * MiB;
constexpr size_t WS_WAT = 74 * MiB;
constexpr size_t WS_BTAB = WS_KEYS + 512 * 1024, WS_LAMS = WS_BTAB + 4096, WS_SP = WS_LAMS + 4096;
constexpr int CW_BAR = 4096, CW_RANK = 8192;
constexpr int RING_OFF = 0, RING_BYTES = 155648, LDSCTL_OFF = RING_BYTES, MISC_OFF = LDSCTL_OFF + 320, LDS_BYTES = 163840;

#define XB_TMO      128
#define XB_XCNT(j)  (256  + 64 * (j))
#define XB_XSUB(j)  (1280 + 64 * (j))
#define XB_XGEN(j)  (2304 + 64 * (j))
#define XB_TOP      3328
#define XB_TOPGEN   3392
#define XCD_BAR_WORDS 3456
#define XB_SPIN_CAP (1u << 18)

__device__ __forceinline__ unsigned xb_ld(unsigned* p)              { return __hip_atomic_load(p, __ATOMIC_RELAXED, __HIP_MEMORY_SCOPE_AGENT); }
__device__ __forceinline__ unsigned xb_add(unsigned* p, unsigned v) { return __hip_atomic_fetch_add(p, v, __ATOMIC_RELAXED, __HIP_MEMORY_SCOPE_AGENT); }
__device__ __forceinline__ unsigned xb_xcc_id() { return (unsigned)__builtin_amdgcn_s_getreg((3 << 11) | 20) & 0xFu; }
#define XB_SPIN(cond, bar) do { unsigned _sp = 0; while (cond) { __builtin_amdgcn_s_sleep(1); \
    if ((++_sp & 255u) == 0u) { if (xb_ld(&(bar)[XB_TMO])) break; if (_sp > XB_SPIN_CAP) { atomicAdd(&(bar)[XB_TMO], 1u); break; } } } } while (0)

struct XcdBarrier {
    unsigned* bar; unsigned x;
    volatile LAS unsigned* st;
};

__device__ __forceinline__ XcdBarrier xcd_barrier_post(unsigned* bar, volatile LAS unsigned* st) {
    XcdBarrier b; b.bar = bar; b.x = xb_xcc_id(); b.st = st;
    if (threadIdx.x == 0) (void)xb_add(&bar[XB_XCNT(b.x)], 1u);
    return b;
}
__device__ __forceinline__ void xcd_barrier_complete(unsigned* bar, unsigned x, unsigned& nloc, unsigned& nx) {
    const unsigned G = gridDim.x * gridDim.y * gridDim.z;
    unsigned sum, cnt, mine, sp = 0u;
    for (;;) {
        sum = 0u; cnt = 0u; mine = 0u;
#pragma unroll
        for (unsigned j = 0; j < 16; ++j) { const unsigned c = xb_ld(&bar[XB_XCNT(j)]); sum += c; cnt += (c > 0u) ? 1u : 0u; mine = (j == x) ? c : mine; }
        if (sum == G) break;
        __builtin_amdgcn_s_sleep(1);
        if ((++sp & 255u) == 0u) { if (xb_ld(&bar[XB_TMO])) break; if (sp > XB_SPIN_CAP) { atomicAdd(&bar[XB_TMO], 1u); break; } }
    }
    nloc = mine > 0u ? mine : 1u; nx = cnt > 0u ? cnt : 1u;
}

__device__ __noinline__ void xcd_barrier_impl(unsigned* bar_, unsigned x_, volatile LAS unsigned* st_, int leader_) {
    XcdBarrier b; b.bar = bar_; b.x = x_; b.st = st_;
    asm volatile("s_waitcnt vmcnt(0)" ::: "memory");
    __syncthreads();
    if (leader_) {
        unsigned* bar = b.bar;
        __builtin_amdgcn_s_waitcnt(0);
        unsigned nloc = b.st[0], nx = b.st[1];
        if (nloc == 0u) { xcd_barrier_complete(bar, b.x, nloc, nx); b.st[0] = nloc; b.st[1] = nx; }
        const unsigned old = xb_add(&bar[XB_XSUB(b.x)], 1u);
        const unsigned gen = old / nloc;
        if (old + 1u == (gen + 1u) * nloc) {
            __builtin_amdgcn_fence(__ATOMIC_RELEASE, "agent");
            asm volatile("s_waitcnt vmcnt(0)" ::: "memory");
            const unsigned og = xb_add(&bar[XB_TOP], 1u);
            const unsigned tg = og / nx;
            if (og + 1u == (tg + 1u) * nx) xb_add(&bar[XB_TOPGEN], 1u);
            else XB_SPIN(xb_ld(&bar[XB_TOPGEN]) == tg, bar);
            __builtin_amdgcn_fence(__ATOMIC_ACQUIRE, "agent");
            xb_add(&bar[XB_XGEN(b.x)], 1u);
            asm volatile("s_waitcnt vmcnt(0)" ::: "memory");
        } else {
            XB_SPIN(xb_ld(&bar[XB_XGEN(b.x)]) == gen, bar);
            __builtin_amdgcn_fence(__ATOMIC_ACQUIRE, "agent");
            asm volatile("s_waitcnt vmcnt(0)" ::: "memory");
        }
    }
    __syncthreads();
}
__device__ __forceinline__ void xcd_barrier(const XcdBarrier& b, int leader) { xcd_barrier_impl(b.bar, b.x, b.st, leader); }


__device__ __forceinline__ float wave_sum(float v, int lane) {
#pragma unroll
    for (int o = 1; o < 64; o <<= 1) v += shx(v, o, lane);
    return v;
}
__device__ __forceinline__ float gelu_erf(float v) {
    const float av = __builtin_fabsf(v), t = __builtin_amdgcn_rcpf(av * 0.2316418882f + 1.0f);
    float q = t * 0.5307027145f + (-0.7265760135f); q = q * t + 0.7107068705f; q = q * t + (-0.142248368f); q = q * t + 0.127414796f; q = q * t;
    const float e = __builtin_amdgcn_exp2f((v * v) * (-0.72134752044f));
    const float m = v * (q * e);
    return v < 0.f ? m : v - m;
}

__device__ __forceinline__ void norm_phase(const GAS float* X, const GAS float* g, GAS bf16* out, int rows, int gw, int NGW, int lane) {
    asm volatile("" : "+v"(lane));
    f32x4 gv[4];
#pragma unroll
    for (int j = 0; j < 4; ++j) gv[j] = ((const GAS f32x4*)g)[lane + 64 * j];
    for (int m = gw; m < rows; m += NGW) {
        const GAS f32x4* xr = (const GAS f32x4*)(X + (size_t)m * D) + lane;
        f32x4 v[4]; float s = 0.f;
#pragma unroll
        for (int j = 0; j < 4; ++j) { v[j] = xr[64 * j]; s += (v[j].x * v[j].x + v[j].y * v[j].y) + (v[j].z * v[j].z + v[j].w * v[j].w); }
        const float rs = rsqrtf(wave_sum(s, lane) * (1.f / D) + 1e-6f);
        GAS v2u* o8 = (GAS v2u*)(out + (size_t)m * D) + lane;
#pragma unroll
        for (int j = 0; j < 4; ++j) { v2u w; w.x = pk2(v[j].x * rs * gv[j].x, v[j].y * rs * gv[j].y); w.y = pk2(v[j].z * rs * gv[j].z, v[j].w * rs * gv[j].w); o8[64 * j] = w; }
    }
}
__device__ __forceinline__ void hq_phase(const GAS bf16* XB, const GAS float* SSQ, const GAS float* g, GAS unsigned char* HQ, GAS float* SH, GAS int* Pz, int gw, int NGW, int lane) {
    asm volatile("" : "+v"(lane));
    const GAS f32x4* gp = (const GAS f32x4*)g + 4 * lane; const f32x4 g0 = gp[0], g1 = gp[1], g2 = gp[2], g3 = gp[3];
    for (int m = gw; m < T; m += NGW) {
        const GAS f32x4* sp = (const GAS f32x4*)(SSQ + (size_t)m * 16); const f32x4 t = (sp[0] + sp[1]) + (sp[2] + sp[3]);
        const float rs = __builtin_amdgcn_rsqf(((t[0] + t[1]) + (t[2] + t[3])) * (1.f / 1024.f) + 1e-6f);
        const v4u a = *(const GAS v4u*)(XB + (size_t)m * D + 16 * lane), b = *(const GAS v4u*)(XB + (size_t)m * D + 16 * lane + 8);
        float f[16] = {bflo(a.x) * g0[0], bfhi(a.x) * g0[1], bflo(a.y) * g0[2], bfhi(a.y) * g0[3], bflo(a.z) * g1[0], bfhi(a.z) * g1[1], bflo(a.w) * g1[2], bfhi(a.w) * g1[3],
                       bflo(b.x) * g2[0], bfhi(b.x) * g2[1], bflo(b.y) * g2[2], bfhi(b.y) * g2[3], bflo(b.z) * g3[0], bfhi(b.z) * g3[1], bflo(b.w) * g3[2], bfhi(b.w) * g3[3]};
        float mx = 0.f;
#pragma unroll
        for (int i = 0; i < 16; ++i) { f[i] *= rs; mx = fmaxf(mx, __builtin_fabsf(f[i])); }
#pragma unroll
        for (int o = 1; o < 64; o <<= 1) mx = fmaxf(mx, shx(mx, o, lane));
        const float inv = mx > 0.f ? 127.f / mx : 0.f;
        v4u q;
#pragma unroll
        for (int i = 0; i < 4; ++i) { const int ia = (int)__builtin_rintf(f[4 * i] * inv), ib = (int)__builtin_rintf(f[4 * i + 1] * inv), ic = (int)__builtin_rintf(f[4 * i + 2] * inv), id = (int)__builtin_rintf(f[4 * i + 3] * inv);
            q[i] = (unsigned)(ia & 255) | ((unsigned)(ib & 255) << 8) | ((unsigned)(ic & 255) << 16) | ((unsigned)(id & 255) << 24); }
        *(GAS v4u*)(HQ + (size_t)m * D + 16 * lane) = q;
        if (lane == 0) SH[m] = mx * (1.f / 127.f);
        (Pz + (size_t)m * 128)[lane] = 0; (Pz + (size_t)m * 128)[lane + 64] = 0;
    }
}
__device__ __forceinline__ void x0_phase(const GAS float* X, GAS bf16* XB, GAS float* SSQ, int gw, int NGW, int lane) {
    asm volatile("" : "+v"(lane));
    for (int m = gw; m < T; m += NGW) {
        const GAS f32x4* xr = (const GAS f32x4*)(X + (size_t)m * D) + lane; GAS v2u* o8 = (GAS v2u*)(XB + (size_t)m * D) + lane;
        float s = 0.f;
#pragma unroll
        for (int j = 0; j < 4; ++j) { const f32x4 v = xr[64 * j]; s += (v.x * v.x + v.y * v.y) + (v.z * v.z + v.w * v.w); v2u w; w.x = pk2(v.x, v.y); w.y = pk2(v.z, v.w); o8[64 * j] = w; }
        s = wave_sum(s, lane);
        if (lane < 8) SSQ[(size_t)m * 16 + lane] = lane == 0 ? s : 0.f;
    }
}
__device__ __forceinline__ void final_norm_phase(const GAS bf16* XB, GAS float* O, const GAS float* g, int rows, int gw, int NGW, int lane) {
    asm volatile("" : "+v"(lane));
    for (int m = gw; m < rows; m += NGW) {
        const GAS v4u* xr = (const GAS v4u*)(XB + (size_t)m * D) + lane;
        v4u v[2]; float s = 0.f;
#pragma unroll
        for (int j = 0; j < 2; ++j) { v[j] = xr[64 * j];
#pragma unroll
            for (int e = 0; e < 4; ++e) { const float a = bflo(v[j][e]), b = bfhi(v[j][e]); s += a * a + b * b; } }
        const float rs = rsqrtf(wave_sum(s, lane) * (1.f / D) + 1e-6f);
#pragma unroll
        for (int j = 0; j < 2; ++j) { const int c = 8 * (lane + 64 * j); const f32x4 g0 = *(const GAS f32x4*)(g + c), g1 = *(const GAS f32x4*)(g + c + 4);
            f32x4 o0, o1; o0.x = bflo(v[j].x) * rs * g0.x; o0.y = bfhi(v[j].x) * rs * g0.y; o0.z = bflo(v[j].y) * rs * g0.z; o0.w = bfhi(v[j].y) * rs * g0.w;
            o1.x = bflo(v[j].z) * rs * g1.x; o1.y = bfhi(v[j].z) * rs * g1.y; o1.z = bflo(v[j].w) * rs * g1.z; o1.w = bfhi(v[j].w) * rs * g1.w;
            *(GAS f32x4*)(O + (size_t)m * D + c) = o0; *(GAS f32x4*)(O + (size_t)m * D + c + 4) = o1; }
    }
}

__device__ __forceinline__ void pre_phase(const GAS bf16* PROJB, const GAS float* ROPE, GAS float* RS, GAS bf16* KMB, int gw, int NGW, int lane) {
    asm volatile("" : "+v"(lane));
    for (int t = gw; t < T; t += NGW) {
        const GAS bf16* pr = PROJB + (size_t)t * INP;
        float sq = 0.f, skv = 0.f;
        if (lane < 24) { const v4u w = *(const GAS v4u*)(pr + PC_CQ + 8 * lane);
            const float a0 = bflo(w.x), a1 = bfhi(w.x), a2 = bflo(w.y), a3 = bfhi(w.y), a4 = bflo(w.z), a5 = bfhi(w.z), a6 = bflo(w.w), a7 = bfhi(w.w);
            sq = (a0 * a0 + a1 * a1) + (a2 * a2 + a3 * a3) + (a4 * a4 + a5 * a5) + (a6 * a6 + a7 * a7); }
        else if (lane >= 32 && lane < 48) { const v4u w = *(const GAS v4u*)(pr + PC_CKV + 8 * (lane - 32));
            const float a0 = bflo(w.x), a1 = bfhi(w.x), a2 = bflo(w.y), a3 = bfhi(w.y), a4 = bflo(w.z), a5 = bfhi(w.z), a6 = bflo(w.w), a7 = bfhi(w.w);
            skv = (a0 * a0 + a1 * a1) + (a2 * a2 + a3 * a3) + (a4 * a4 + a5 * a5) + (a6 * a6 + a7 * a7); }
        sq = wave_sum(sq, lane); skv = wave_sum(skv, lane);
        if (lane == 0) { RS[2 * (size_t)t] = rsqrtf(sq * (1.f / 192.f) + 1e-6f); RS[2 * (size_t)t + 1] = rsqrtf(skv * (1.f / 128.f) + 1e-6f); }
        if (lane < 16) {
            const float x1 = __builtin_bit_cast(float, (unsigned)pr[PC_KR + lane] << 16), x2 = __builtin_bit_cast(float, (unsigned)pr[PC_KR + 16 + lane] << 16);
            const float c = ROPE[(size_t)t * 32 + lane], sn = ROPE[(size_t)t * 32 + 16 + lane];
            const bf16 y1 = (bf16)f2bf_(x1 * c - x2 * sn), y2 = (bf16)f2bf_(x1 * sn + x2 * c);
            GAS bf16* kr = KMB + (size_t)t * 384 + 64 + lane;
#pragma unroll
            for (int h = 0; h < 4; ++h) { kr[h * 96] = y1; kr[h * 96 + 16] = y2; }
        }
    }
}

typedef short lr_bf16x8 __attribute__((ext_vector_type(8)));
typedef float lr_f32x16 __attribute__((ext_vector_type(16)));
__device__ __forceinline__ void lr_swap32(float& a, float& b) { asm volatile("v_nop\n\tv_nop\n\tv_permlane32_swap_b32 %0, %1" : "+v"(a), "+v"(b)); }
constexpr int LR_XR = 0, LR_CW = LR_XR + 37376, LR_XA = LR_CW + 1280, LR_WT = LR_XA + 256 * 144, LR_SUM = LR_WT + 2 * 64 * 144, LR_END = LR_SUM + 4096;
struct LruP { const GAS bf16* PROJB; const GAS float* cw; const GAS float* cb; const GAS bf16* wat; const GAS float* ba; const GAS float* bx; const GAS float* sp; GAS unsigned* HA; GAS float* LSUM; };
__device__ __forceinline__ void lru_phase(const LruP& P, LAS unsigned char* lds, int tid, int wave, int lane, int vcu, int G) {
    asm volatile("" : "+v"(tid), "+v"(lane));
    LAS float* SUM = (LAS float*)(lds + LR_SUM);
    for (int u = vcu; u < (T / 256) * 8; u += G) {
        const int tile = u >> 3, g = u & 7; const int t0 = tile * 256; const bool first = ((tile & 31) == 0);
        __syncthreads();
        { v4u wt_[2], xr_[5];
#pragma unroll
          for (int i = 0; i < 2; ++i) { const int idx = tid + 512 * i; wt_[i] = ((const GAS v4u*)(P.wat + (size_t)g * 2 * 4096))[idx]; }
#pragma unroll
          for (int i = 0; i < 5; ++i) { const int idx = tid + 512 * i, row = idx >> 3, part = idx & 7; const bool ok = (idx < 259 * 8) && !(first && row < 3);
              const int trow = ok ? t0 - 3 + row : t0;
              xr_[i] = *(const GAS v4u*)(P.PROJB + (size_t)trow * INP + PC_XL + 64 * g + 8 * part); if (!ok) xr_[i] = v4u{0u, 0u, 0u, 0u}; }
          float cwv = 0.f; if (tid < 320) cwv = (tid < 256) ? P.cw[(tid >> 6) * 512 + 64 * g + (tid & 63)] : P.cb[64 * g + (tid - 256)];
#pragma unroll
          for (int i = 0; i < 2; ++i) { const int idx = tid + 512 * i; *(LAS v4u*)(lds + LR_WT + (idx >> 9) * 9216 + ((idx >> 3) & 63) * 144 + (idx & 7) * 16) = wt_[i]; }
#pragma unroll
          for (int i = 0; i < 5; ++i) { const int idx = tid + 512 * i, row = idx >> 3, part = idx & 7; if (idx < 259 * 8) *(LAS v4u*)(lds + LR_XR + row * 144 + 16 * part) = xr_[i]; }
          if (tid < 320) ((LAS float*)(lds + LR_CW))[tid] = cwv; }
        __syncthreads();
        { float cwr[4][8], cbr[8];
#pragma unroll
          for (int k = 0; k < 4; ++k) { const f32x4 c0 = *(const LAS f32x4*)(lds + LR_CW + (k * 64 + 8 * wave) * 4), c1 = *(const LAS f32x4*)(lds + LR_CW + (k * 64 + 8 * wave + 4) * 4);
              cwr[k][0] = c0.x; cwr[k][1] = c0.y; cwr[k][2] = c0.z; cwr[k][3] = c0.w; cwr[k][4] = c1.x; cwr[k][5] = c1.y; cwr[k][6] = c1.z; cwr[k][7] = c1.w; }
          { const f32x4 c0 = *(const LAS f32x4*)(lds + LR_CW + (256 + 8 * wave) * 4), c1 = *(const LAS f32x4*)(lds + LR_CW + (256 + 8 * wave + 4) * 4);
            cbr[0] = c0.x; cbr[1] = c0.y; cbr[2] = c0.z; cbr[3] = c0.w; cbr[4] = c1.x; cbr[5] = c1.y; cbr[6] = c1.z; cbr[7] = c1.w; }
#pragma unroll
          for (int it_ = 0; it_ < 4; ++it_) { const int time = lane + 64 * it_;
              float y[8];
#pragma unroll
              for (int e = 0; e < 8; ++e) y[e] = cbr[e];
#pragma unroll
              for (int k = 0; k < 4; ++k) { const v4u w = *(const LAS v4u*)(lds + LR_XR + (time + k) * 144 + 16 * wave);
                  y[0] += bflo(w.x) * cwr[k][0]; y[1] += bfhi(w.x) * cwr[k][1]; y[2] += bflo(w.y) * cwr[k][2]; y[3] += bfhi(w.y) * cwr[k][3];
                  y[4] += bflo(w.z) * cwr[k][4]; y[5] += bfhi(w.z) * cwr[k][5]; y[6] += bflo(w.w) * cwr[k][6]; y[7] += bfhi(w.w) * cwr[k][7]; }
              v4u o; o.x = pk2(y[0], y[1]); o.y = pk2(y[2], y[3]); o.z = pk2(y[4], y[5]); o.w = pk2(y[6], y[7]);
              *(LAS v4u*)(lds + LR_XA + time * 144 + 16 * wave) = o; } }
        __syncthreads();
        const int r32 = lane & 31, hi = lane >> 5;
        lr_f32x16 acc[2][2];
#pragma unroll
        for (int nt = 0; nt < 2; ++nt) { const float b_a = P.ba[64 * g + 32 * nt + r32], b_x = P.bx[64 * g + 32 * nt + r32];
#pragma unroll
            for (int r = 0; r < 16; ++r) { acc[0][nt][r] = b_a; acc[1][nt][r] = b_x; } }
        { lr_bf16x8 af[4];
#pragma unroll
          for (int s_ = 0; s_ < 4; ++s_) af[s_] = *(const LAS lr_bf16x8*)(lds + LR_XA + (32 * wave + r32) * 144 + (16 * s_ + 8 * hi) * 2);
#pragma unroll
          for (int gt = 0; gt < 2; ++gt)
#pragma unroll
              for (int nt = 0; nt < 2; ++nt)
#pragma unroll
                  for (int s_ = 0; s_ < 4; ++s_) { const lr_bf16x8 bfr = *(const LAS lr_bf16x8*)(lds + LR_WT + gt * 9216 + (32 * nt + r32) * 144 + (16 * s_ + 8 * hi) * 2);
                      acc[gt][nt] = __builtin_amdgcn_mfma_f32_32x32x16_bf16(af[s_], bfr, acc[gt][nt], 0, 0, 0); } }
#pragma unroll
        for (int nt = 0; nt < 2; ++nt) { const float sp = P.sp[64 * g + 32 * nt + r32];
            float sa_[4], sh_[4];
#pragma unroll
            for (int q = 0; q < 4; ++q) { float hrun = 0.f, arun = 1.f;
#pragma unroll
                for (int e = 0; e < 4; ++e) { const int r = 4 * q + e, tl = 8 * q + 4 * hi + e;
                    const float xv = __builtin_bit_cast(float, (unsigned)*(const LAS unsigned short*)(lds + LR_XA + (32 * wave + tl) * 144 + (32 * nt + r32) * 2) << 16);
                    const float rg = __builtin_amdgcn_rcpf(1.f + __builtin_amdgcn_exp2f(-LOG2E * acc[0][nt][r])), ig = __builtin_amdgcn_rcpf(1.f + __builtin_amdgcn_exp2f(-LOG2E * acc[1][nt][r]));
                    const float la = -8.0f * rg * sp; const float a_ = __builtin_amdgcn_exp2f(LOG2E * la);
                    const float uu = __builtin_amdgcn_sqrtf(fmaxf(1.f - a_ * a_, 0.f)) * (ig * xv);
                    hrun = a_ * hrun + uu; arun *= a_; acc[0][nt][r] = arun; acc[1][nt][r] = hrun; }
                sa_[q] = arun; sh_[q] = hrun; }
            float runA = 1.f, runH = 0.f;
#pragma unroll
            for (int q = 0; q < 4; ++q) { float a0 = sa_[q], a1 = sa_[q], h0 = sh_[q], h1 = sh_[q]; lr_swap32(a0, a1); lr_swap32(h0, h1);
                const float midA = runA * a0, midH = a0 * runH + h0;
                const float inA = hi ? midA : runA, inH = hi ? midH : runH;
                runA = midA * a1; runH = a1 * midH + h1;
#pragma unroll
                for (int e = 0; e < 4; ++e) { const int r = 4 * q + e; acc[1][nt][r] += acc[0][nt][r] * inH; acc[0][nt][r] *= inA; } }
            if (hi == 0) { SUM[(wave * 64 + 32 * nt + r32) * 2] = runA; SUM[(wave * 64 + 32 * nt + r32) * 2 + 1] = runH; } }
        __syncthreads();
#pragma unroll
        for (int nt = 0; nt < 2; ++nt) { const int cl = 32 * nt + r32;
            float ca = 1.f, chh = 0.f;
            for (int w = 0; w < wave; ++w) { const float aw = SUM[(w * 64 + cl) * 2], hw = SUM[(w * 64 + cl) * 2 + 1]; chh = aw * chh + hw; ca *= aw; }
            GAS unsigned* ha = P.HA + (size_t)(t0 + 32 * wave + 4 * hi) * 512 + 64 * g + cl;
#pragma unroll
            for (int r = 0; r < 16; ++r) { const float hh = acc[1][nt][r] + acc[0][nt][r] * chh, ac_ = acc[0][nt][r] * ca; ha[(size_t)((r & 3) + 8 * (r >> 2)) * 512] = pk2(hh, ac_);
                if (r == 15 && wave == 7 && hi == 1) { P.LSUM[((size_t)tile * 512 + 64 * g + cl) * 2] = ac_; P.LSUM[((size_t)tile * 512 + 64 * g + cl) * 2 + 1] = hh; } } }
    }
}

struct PostP { const GAS bf16* OMB; const GAS unsigned* HA; const GAS float* LSUM; const GAS bf16* PROJB; const GAS float* gm; const GAS float* gl; GAS bf16* Y; };
__device__ __forceinline__ void post_phase(const PostP& P, LAS unsigned char* lds, int tid, int wave, int lane, int vcu, int G) {
    asm volatile("" : "+v"(tid), "+v"(lane));
    LAS float* hin = (LAS float*)lds;
    for (int u = vcu; u < T / 64; u += G) {
        const int t0 = u * 64, tile = t0 >> 8, tb = tile & ~31;
        __syncthreads();
        { float h = 0.f;
          for (int c = tb; c < tile; ++c) { const float a = P.LSUM[((size_t)c * 512 + tid) * 2], hh = P.LSUM[((size_t)c * 512 + tid) * 2 + 1]; h = a * h + hh; }
          hin[tid] = h; }
        __syncthreads();
        f32x4 hi0 = *(const LAS f32x4*)(hin + 8 * lane), hi1 = *(const LAS f32x4*)(hin + 8 * lane + 4);
        const f32x4 g0 = *(const GAS f32x4*)(P.gl + 8 * lane), g1 = *(const GAS f32x4*)(P.gl + 8 * lane + 4), gmv = *(const GAS f32x4*)(P.gm + 4 * lane);
#pragma unroll 2
        for (int i = 0; i < 8; ++i) {
            const size_t t = (size_t)t0 + 8 * wave + i;
            const v4u p0 = *(const GAS v4u*)(P.HA + t * 512 + 8 * lane), p1 = *(const GAS v4u*)(P.HA + t * 512 + 8 * lane + 4), gw_ = *(const GAS v4u*)(P.PROJB + t * INP + PC_GL + 8 * lane);
            const v2u mw = *(const GAS v2u*)(P.OMB + t * 256 + 4 * lane);
            float o[8];
            o[0] = (bflo(p0.x) + bfhi(p0.x) * hi0.x) * gelu_erf(bflo(gw_.x)); o[1] = (bflo(p0.y) + bfhi(p0.y) * hi0.y) * gelu_erf(bfhi(gw_.x));
            o[2] = (bflo(p0.z) + bfhi(p0.z) * hi0.z) * gelu_erf(bflo(gw_.y)); o[3] = (bflo(p0.w) + bfhi(p0.w) * hi0.w) * gelu_erf(bfhi(gw_.y));
            o[4] = (bflo(p1.x) + bfhi(p1.x) * hi1.x) * gelu_erf(bflo(gw_.z)); o[5] = (bflo(p1.y) + bfhi(p1.y) * hi1.y) * gelu_erf(bfhi(gw_.z));
            o[6] = (bflo(p1.z) + bfhi(p1.z) * hi1.z) * gelu_erf(bflo(gw_.w)); o[7] = (bflo(p1.w) + bfhi(p1.w) * hi1.w) * gelu_erf(bfhi(gw_.w));
            float s2 = 0.f;
#pragma unroll
            for (int e = 0; e < 8; ++e) s2 += o[e] * o[e];
            const float m0 = bflo(mw.x), m1 = bfhi(mw.x), m2 = bflo(mw.y), m3 = bfhi(mw.y);
            float s1 = (m0 * m0 + m1 * m1) + (m2 * m2 + m3 * m3);
            s1 = wave_sum(s1, lane); s2 = wave_sum(s2, lane);
            const float r1 = rsqrtf(s1 * (1.f / 256.f) + 1e-6f), r2 = rsqrtf(s2 * (1.f / 512.f) + 1e-6f);
            GAS bf16* yr = P.Y + t * 1024;
            { v2u w; w.x = pk2(m0 * r1 * gmv.x, m1 * r1 * gmv.y); w.y = pk2(m2 * r1 * gmv.z, m3 * r1 * gmv.w); *(GAS v2u*)(yr + 4 * lane) = w; }
            { v4u w; w.x = pk2(o[0] * r2 * g0.x, o[1] * r2 * g0.y); w.y = pk2(o[2] * r2 * g0.z, o[3] * r2 * g0.w); w.z = pk2(o[4] * r2 * g1.x, o[5] * r2 * g1.y); w.w = pk2(o[6] * r2 * g1.z, o[7] * r2 * g1.w);
              *(GAS v4u*)(yr + 256 + 8 * lane) = w; }
        }
    }
}

#define TILE_BAR() asm volatile("s_waitcnt lgkmcnt(0)\n\ts_barrier" ::: "memory")
typedef short bf16x8 __attribute__((ext_vector_type(8)));
typedef short s16x4 __attribute__((ext_vector_type(4)));
typedef float f32x16 __attribute__((ext_vector_type(16)));
typedef unsigned u32x4 __attribute__((ext_vector_type(4)));
__device__ __forceinline__ int crow(int r, int hi) { return (r & 3) + 8 * (r >> 2) + 4 * hi; }
typedef float f32x2_t __attribute__((ext_vector_type(2))); typedef __bf16 bf16x2_c __attribute__((ext_vector_type(2)));
__device__ __forceinline__ unsigned cvtpk(float lo, float hi) { f32x2_t v = {lo, hi}; bf16x2_c b = __builtin_convertvector(v, bf16x2_c); return __builtin_bit_cast(unsigned, b); }
__device__ __forceinline__ float swapmax(float m) { auto rr = __builtin_amdgcn_permlane32_swap(__float_as_uint(m), __float_as_uint(m), false, false); return fmaxf(__uint_as_float(rr[0]), __uint_as_float(rr[1])); }
__device__ __forceinline__ float swapadd(float m) { auto rr = __builtin_amdgcn_permlane32_swap(__float_as_uint(m), __float_as_uint(m), false, false); return __uint_as_float(rr[0]) + __uint_as_float(rr[1]); }
__device__ __forceinline__ s16x4 vtr(const LAS unsigned char* p) { return __builtin_bit_cast(s16x4, __builtin_amdgcn_ds_read_tr16_b64_v4i16((LAS s16x4*)p)); }
__device__ __forceinline__ bf16x8 pack8(const f32x16& p, int b) { u32x4 w; w.x = cvtpk(p[b], p[b + 1]); w.y = cvtpk(p[b + 2], p[b + 3]); w.z = cvtpk(p[b + 4], p[b + 5]); w.w = cvtpk(p[b + 6], p[b + 7]); return __builtin_bit_cast(bf16x8, w); }
__device__ __forceinline__ float vmax3(float a, float b, float c) { float r; asm("v_max3_f32 %0, %1, %2, %3" : "=v"(r) : "v"(a), "v"(b), "v"(c)); return r; }
__device__ __forceinline__ float max32(const f32x16& p, const f32x16& q) {
    float a = vmax3(p[0], p[1], p[2]), b = vmax3(p[3], p[4], p[5]), c = vmax3(p[6], p[7], p[8]), d = vmax3(p[9], p[10], p[11]), e = vmax3(p[12], p[13], p[14]);
    float f = vmax3(q[0], q[1], q[2]), g = vmax3(q[3], q[4], q[5]), h = vmax3(q[6], q[7], q[8]), i = vmax3(q[9], q[10], q[11]), j = vmax3(q[12], q[13], q[14]);
    a = vmax3(a, b, c); d = vmax3(d, e, p[15]); f = vmax3(f, g, h); i = vmax3(i, j, q[15]);
    return vmax3(vmax3(a, d, f), i, i);
}
__device__ __forceinline__ float max16(const f32x16& p) { float a = fmaxf(fmaxf(p[0], p[1]), fmaxf(p[2], p[3])), b = fmaxf(fmaxf(p[4], p[5]), fmaxf(p[6], p[7])), c = fmaxf(fmaxf(p[8], p[9]), fmaxf(p[10], p[11])), d = fmaxf(fmaxf(p[12], p[13]), fmaxf(p[14], p[15])); return fmaxf(fmaxf(a, b), fmaxf(c, d)); }

struct AttnP {
    const GAS bf16* Q; const GAS bf16* K; const GAS bf16* V; int qp, kp, vp;
    GAS bf16* O; int op;
    const GAS float* rope;
    const GAS int* pos; const GAS float* btab; const GAS float* dnorm; const GAS float* lams;
};
template <int KIND> struct AK {
    static constexpr bool DIFF = KIND == 1, CROSS = KIND == 2;
    static constexpr int HW = KIND == 0 ? 96 : KIND == 1 ? 64 : 256;
    static constexpr int NKS = KIND == 0 ? 6 : KIND == 1 ? 2 : 16;
    static constexpr int KP = KIND == 0 ? 208 : KIND == 1 ? 144 : 528;
    static constexpr int ND = CROSS ? 4 : 2;
    static constexpr int CPK = HW / 8, KCH = (64 * CPK + 511) / 512;
    static constexpr int VCH = ND / 2;
    static constexpr int KB = 64 * KP, VB = ND * 4096;
    static constexpr int NBUF = CROSS ? 2 : 3;
    static constexpr int K0 = 0, V0 = NBUF * KB, POS = V0 + NBUF * VB, BT = POS + 1024, DN = BT + 528, END = DN + 256;
};
static_assert(AK<2>::END <= RING_BYTES && AK<0>::END <= RING_BYTES && AK<1>::END + 16 + 8 * 8192 <= RING_BYTES, "attention LDS");

template <int KIND, bool LEAD>
__device__ __forceinline__ void attn_unit(const AttnP& P, int b, int h, int qb, int dhalf, LAS unsigned char* lds, int tid, int wave, int lane) {
    lane = lane_id_v(); tid = (wave << 6) | lane;
    typedef AK<KIND> C;
    constexpr bool DIFF = C::DIFF, CROSS = C::CROSS;
    constexpr int HW = C::HW, NKS = C::NKS, KP = C::KP, ND = C::ND, CPK = C::CPK, KCH = C::KCH, VCH = C::VCH;
    const int r32 = lane & 31, hi = lane >> 5;
    const size_t rowb = (size_t)b * S, rowk = CROSS ? (size_t)b * MEM : rowb;
    const int q0w = qb * 256 + wave * 32, qi = q0w + r32;
    int pq = 0; float bias_far = 0.f;
    __syncthreads();
    if (DIFF) {
        pq = P.pos[rowb + qi];
        if (tid < 129) ((LAS float*)(lds + C::BT))[tid] = P.btab[h * 129 + tid];
        if (tid >= 192 && tid < 256) ((LAS float*)(lds + C::DN))[tid - 192] = P.dnorm[tid - 192];
    }
    int minq = pq;
    if (DIFF) { for (int o = 1; o < 64; o <<= 1) { const int v = shxi(minq, o, lane); minq = v < minq ? v : minq; } }
    const int NT = CROSS ? MEM / 64 : 4 * (qb + 1);
    u32x4 kr[KCH], vr[VCH]; int pkr = 0;
    u32x4 kr2[CROSS ? 1 : KCH], vr2[CROSS ? 1 : VCH]; int pkr2 = 0;
    const GAS bf16* Kb = P.K + rowk * P.kp + h * HW; const GAS bf16* Vb = P.V + rowk * P.vp + (CROSS ? h * 256 + dhalf * 128 : h * 64);
    const __amdgpu_buffer_rsrc_t rK = __builtin_amdgcn_make_buffer_rsrc((void*)Kb, 0, 0x7fffffff, 0x00020000), rV = __builtin_amdgcn_make_buffer_rsrc((void*)Vb, 0, 0x7fffffff, 0x00020000);
    const __amdgpu_buffer_rsrc_t rP = __builtin_amdgcn_make_buffer_rsrc((void*)(DIFF ? P.pos + rowb : (const GAS int*)Kb), 0, 0x7fffffff, 0x00020000);
    int kvo[KCH], vvo[VCH];
#pragma unroll
    for (int i = 0; i < KCH; ++i) { int c = tid + 512 * i; c = c < 64 * CPK ? c : tid; kvo[i] = ((c / CPK) * P.kp + (c % CPK) * 8) * 2; }
#pragma unroll
    for (int i = 0; i < VCH; ++i) { const int c = tid + 512 * i; vvo[i] = ((c / (4 * ND)) * P.vp + (c % (4 * ND)) * 8) * 2; }
    const int pvo = (tid & 63) * 4;
    auto gload = [&](int t) {
        const int ks = __builtin_amdgcn_readfirstlane(64 * t * P.kp * 2), vs = __builtin_amdgcn_readfirstlane(64 * t * P.vp * 2);
#pragma unroll
        for (int i = 0; i < KCH; ++i) kr[i] = __builtin_amdgcn_raw_buffer_load_b128(rK, kvo[i], ks, 0);
#pragma unroll
        for (int i = 0; i < VCH; ++i) vr[i] = __builtin_amdgcn_raw_buffer_load_b128(rV, vvo[i], vs, 0);
        if (DIFF) pkr = __builtin_amdgcn_raw_buffer_load_b32(rP, pvo, __builtin_amdgcn_readfirstlane(64 * t * 4), 0);
    };
    auto lstore = [&](int buf) {
        LAS unsigned char* kb_ = lds + C::K0 + buf * C::KB; LAS unsigned char* vb_ = lds + C::V0 + buf * C::VB;
#pragma unroll
        for (int i = 0; i < KCH; ++i) { int c = tid + 512 * i; c = c < 64 * CPK ? c : tid; const int key = c / CPK, part = c % CPK; *(LAS u32x4*)(kb_ + key * KP + part * 16) = kr[i]; }
#pragma unroll
        for (int i = 0; i < VCH; ++i) { const int c = tid + 512 * i; const int key = c / (4 * ND), part = c % (4 * ND); *(LAS u32x4*)(vb_ + (part >> 2) * 4096 + (key >> 3) * 512 + (key & 7) * 64 + (part & 3) * 16) = vr[i]; }
        if (DIFF) { ((LAS int*)(lds + C::POS + buf * 256))[tid & 63] = pkr; if (tid < 64) { int mk_ = pkr; for (int o = 1; o < 64; o <<= 1) { const int v = shxi(mk_, o, lane); mk_ = v > mk_ ? v : mk_; } if (tid == 0) ((LAS int*)(lds + C::POS + 768))[buf] = mk_; } }
    };
    auto gloadB = [&](int t) {
        const int ks = __builtin_amdgcn_readfirstlane(64 * t * P.kp * 2), vs = __builtin_amdgcn_readfirstlane(64 * t * P.vp * 2);
#pragma unroll
        for (int i = 0; i < (CROSS ? 1 : KCH); ++i) kr2[i] = __builtin_amdgcn_raw_buffer_load_b128(rK, kvo[i], ks, 0);
#pragma unroll
        for (int i = 0; i < (CROSS ? 1 : VCH); ++i) vr2[i] = __builtin_amdgcn_raw_buffer_load_b128(rV, vvo[i], vs, 0);
        if (DIFF) pkr2 = __builtin_amdgcn_raw_buffer_load_b32(rP, pvo, __builtin_amdgcn_readfirstlane(64 * t * 4), 0);
    };
    auto lstoreB = [&](int buf) {
        LAS unsigned char* kb_ = lds + C::K0 + buf * C::KB; LAS unsigned char* vb_ = lds + C::V0 + buf * C::VB;
#pragma unroll
        for (int i = 0; i < (CROSS ? 1 : KCH); ++i) { int c = tid + 512 * i; c = c < 64 * CPK ? c : tid; const int key = c / CPK, part = c % CPK; *(LAS u32x4*)(kb_ + key * KP + part * 16) = kr2[i]; }
#pragma unroll
        for (int i = 0; i < (CROSS ? 1 : VCH); ++i) { const int c = tid + 512 * i; const int key = c / (4 * ND), part = c % (4 * ND); *(LAS u32x4*)(vb_ + (part >> 2) * 4096 + (key >> 3) * 512 + (key & 7) * 64 + (part & 3) * 16) = vr2[i]; }
        if (DIFF) { ((LAS int*)(lds + C::POS + buf * 256))[tid & 63] = pkr2; if (tid < 64) { int mk_ = pkr2; for (int o = 1; o < 64; o <<= 1) { const int v = shxi(mk_, o, lane); mk_ = v > mk_ ? v : mk_; } if (tid == 0) ((LAS int*)(lds + C::POS + 768))[buf] = mk_; } }
    };
    LAS float* osv = (LAS float*)(lds + ((C::END + 15) & ~15)) + wave * 2048 + lane;
    float il = 0.f;
    f32x16 oA[ND];
#pragma unroll 1
    for (int mp = 0; mp < (DIFF ? 2 : 1); ++mp) {
        bf16x8 qf[NKS];
        { const GAS bf16* qrow = P.Q + (rowb + qi) * P.qp + h * HW + mp * 32;
#pragma unroll
          for (int s = 0; s < NKS; ++s) qf[s] = *(const GAS bf16x8*)(qrow + 16 * s + 8 * hi);
          if (KIND == 0) {
              const GAS float* rp = P.rope + (rowb + qi) * 32 + 8 * hi;
              const f32x4 c0 = *(const GAS f32x4*)rp, c1 = *(const GAS f32x4*)(rp + 4), s0 = *(const GAS f32x4*)(rp + 16), s1 = *(const GAS f32x4*)(rp + 20);
              const u32x4 a = __builtin_bit_cast(u32x4, qf[NKS - 2]), bq = __builtin_bit_cast(u32x4, qf[NKS - 1]); u32x4 ra, rb;
#pragma unroll
              for (int w = 0; w < 4; ++w) { const float cl = w < 2 ? c0[2 * w] : c1[2 * w - 4], ch = w < 2 ? c0[2 * w + 1] : c1[2 * w - 3], sl = w < 2 ? s0[2 * w] : s1[2 * w - 4], sh = w < 2 ? s0[2 * w + 1] : s1[2 * w - 3];
                  const float x1l = bflo(a[w]), x1h = bfhi(a[w]), x2l = bflo(bq[w]), x2h = bfhi(bq[w]);
                  ra[w] = cvtpk(x1l * cl - x2l * sl, x1h * ch - x2h * sh); rb[w] = cvtpk(x1l * sl + x2l * cl, x1h * sh + x2h * ch); }
              qf[NKS - 2] = __builtin_bit_cast(bf16x8, ra); qf[NKS - 1] = __builtin_bit_cast(bf16x8, rb);
          } }
        __syncthreads();
        float m1 = -1e30f, l1 = 0.f;
#pragma unroll
        for (int d = 0; d < ND; ++d)
#pragma unroll
            for (int r = 0; r < 16; ++r) oA[d][r] = 0.f;
        auto qk = [&](int sl, f32x16& sa, f32x16& sb, float init) {
            const LAS unsigned char* kb_ = lds + C::K0 + sl * C::KB + r32 * KP + hi * 16 + mp * 64;
#pragma unroll
            for (int r = 0; r < 16; ++r) { sa[r] = init; sb[r] = init; }
            constexpr int HB = CROSS ? 4 : (NKS > 3 ? 3 : NKS);
#pragma unroll
            for (int s0_ = 0; s0_ < NKS; s0_ += HB) {
                bf16x8 kfa[HB], kfb[HB];
#pragma unroll
                for (int s = 0; s < HB; ++s) { kfa[s] = *(const LAS bf16x8*)(kb_ + (s0_ + s) * 32); kfb[s] = *(const LAS bf16x8*)(kb_ + 32 * KP + (s0_ + s) * 32); }
                __builtin_amdgcn_sched_barrier(0);
#pragma unroll
                for (int s = 0; s < HB; ++s) { sa = __builtin_amdgcn_mfma_f32_32x32x16_bf16(kfa[s], qf[s0_ + s], sa, 0, 0, 0); sb = __builtin_amdgcn_mfma_f32_32x32x16_bf16(kfb[s], qf[s0_ + s], sb, 0, 0, 0); }
                __builtin_amdgcn_sched_barrier(0);
            }
        };
        auto isnear = [&](int sl) { bool nb = false;
            if (DIFF) { const int mk_ = __builtin_amdgcn_readfirstlane(((LAS int*)(lds + C::POS + 768))[sl]); nb = (minq - mk_) < 128; }
            return nb; };
        auto sm = [&](int t, int sl, f32x16& pa, f32x16& pb, bool nearb) -> float {
            const int k0 = 64 * t;
            if (DIFF) { if (nearb) {
                const LAS int* pk = (const LAS int*)(lds + C::POS + sl * 256); const LAS float* bt = (const LAS float*)(lds + C::BT);
#pragma unroll
                for (int r = 0; r < 16; ++r) { const int kk = crow(r, hi);
                    int n0 = pq - pk[kk], n1 = pq - pk[kk + 32]; n0 = n0 < 0 ? 0 : (n0 > 128 ? 128 : n0); n1 = n1 < 0 ? 0 : (n1 > 128 ? 128 : n1);
                    pa[r] += bt[n0]; pb[r] += bt[n1]; }
            } }
            if (!CROSS && k0 + 63 > q0w) {
#pragma unroll
                for (int r = 0; r < 16; ++r) { const int kk = k0 + crow(r, hi); if (kk > qi) pa[r] = -1e30f; if (kk + 32 > qi) pb[r] = -1e30f; }
            }
            asm volatile("s_nop 15\n\ts_nop 7" : "+v"(pa), "+v"(pb));
            float mn, al = 1.f;
            if (CROSS) { const float mx = swapmax(max32(pa, pb)); mn = fmaxf(m1, mx); al = __builtin_amdgcn_exp2f(m1 - mn); l1 *= al; }
            else { const float mx = swapmax(max32(pa, pb)); const bool up = mx > m1 + 8.0f; mn = up ? mx : m1;
                   if (__builtin_amdgcn_ballot_w64(up) != 0ull) { al = __builtin_amdgcn_exp2f(m1 - mn); l1 *= al; } }
            m1 = mn;
            float ls = 0.f;
#pragma unroll
            for (int r = 0; r < 16; ++r) { pa[r] = __builtin_amdgcn_exp2f(pa[r] - mn); pb[r] = __builtin_amdgcn_exp2f(pb[r] - mn); ls += pa[r] + pb[r]; }
            l1 += ls;
            return al;
        };
        auto pv = [&](int sl, const f32x16& pa, const f32x16& pb, float al) {
            const LAS unsigned char* vb_ = lds + C::V0 + sl * C::VB + ((lane >> 4) & 1) * 32 + (lane & 3) * 8 + (4 * hi + ((lane & 15) >> 2)) * 64;
            bf16x8 pf[4];
            pf[0] = pack8(pa, 0); pf[1] = pack8(pa, 8); pf[2] = pack8(pb, 0); pf[3] = pack8(pb, 8);
            const bool resc = CROSS ? true : (__builtin_amdgcn_ballot_w64(al != 1.0f) != 0ull);
            if (CROSS) {
#pragma unroll
                for (int d = 0; d < ND; ++d) {
                    __builtin_amdgcn_sched_barrier(0);
#pragma unroll
                    for (int r = 0; r < 16; ++r) oA[d][r] *= al;
                    bf16x8 vf[4];
#pragma unroll
                    for (int s = 0; s < 4; ++s) { const s16x4 lo = vtr(vb_ + d * 4096 + s * 1024), hh = vtr(vb_ + d * 4096 + s * 1024 + 512); vf[s] = (bf16x8){lo[0], lo[1], lo[2], lo[3], hh[0], hh[1], hh[2], hh[3]}; }
#pragma unroll
                    for (int s = 0; s < 4; ++s) oA[d] = __builtin_amdgcn_mfma_f32_32x32x16_bf16(vf[s], pf[s], oA[d], 0, 0, 0);
                }
            } else if (DIFF) {
                if (resc) {
#pragma unroll
                    for (int d = 0; d < 2; ++d)
#pragma unroll
                        for (int r = 0; r < 16; ++r) oA[d][r] *= al;
                }
#pragma unroll
                for (int d = 0; d < 2; ++d) {
                    bf16x8 vf[4];
#pragma unroll
                    for (int s = 0; s < 4; ++s) { const s16x4 lo = vtr(vb_ + d * 4096 + s * 1024), hh = vtr(vb_ + d * 4096 + s * 1024 + 512); vf[s] = (bf16x8){lo[0], lo[1], lo[2], lo[3], hh[0], hh[1], hh[2], hh[3]}; }
                    __builtin_amdgcn_sched_barrier(0);
#pragma unroll
                    for (int s = 0; s < 4; ++s) oA[d] = __builtin_amdgcn_mfma_f32_32x32x16_bf16(vf[s], pf[s], oA[d], 0, 0, 0);
                }
            } else {
                bf16x8 vf[2][4];
#pragma unroll
                for (int d = 0; d < 2; ++d)
#pragma unroll
                    for (int s = 0; s < 4; ++s) { const s16x4 lo = vtr(vb_ + d * 4096 + s * 1024), hh = vtr(vb_ + d * 4096 + s * 1024 + 512); vf[d][s] = (bf16x8){lo[0], lo[1], lo[2], lo[3], hh[0], hh[1], hh[2], hh[3]}; }
                if (resc) {
#pragma unroll
                    for (int d = 0; d < 2; ++d)
#pragma unroll
                        for (int r = 0; r < 16; ++r) oA[d][r] *= al;
                }
                __builtin_amdgcn_sched_barrier(0);
#pragma unroll
                for (int s = 0; s < 4; ++s)
#pragma unroll
                    for (int d = 0; d < 2; ++d) oA[d] = __builtin_amdgcn_mfma_f32_32x32x16_bf16(vf[d][s], pf[s], oA[d], 0, 0, 0);
            }
        };
        if (CROSS) {
            gload(0); lstore(0);
            __syncthreads();
            for (int t = 0; t < NT; ++t) {
                const int buf = t & 1;
                f32x16 pa, pb;
                qk(buf, pa, pb, 0.f);
                const float al = sm(t, buf, pa, pb, false);
                pv(buf, pa, pb, al);
                if (t + 1 < NT) { gload(t + 1); lstore(buf ^ 1); }
                TILE_BAR();
            }
        } else {
            gload(0); lstore(0); gload(1); lstore(1);
            gload(2); gloadB(3);
            __syncthreads();
            if (DIFF) bias_far = ((LAS float*)(lds + C::BT))[128];
            const int NTW = (q0w + 31) / 64 + 1;
            constexpr bool lead = LEAD;
            f32x16 ca, cb, na, nb; bool cnear = isnear(0), nnear = false; float cal = 1.f;
            qk(0, ca, cb, (DIFF && !cnear) ? bias_far : 0.f);
            if (lead) cal = sm(0, 0, ca, cb, cnear);
            int s0 = 0, s1 = 1, s2 = 2;
            auto period = [&](int t, f32x16& xa, f32x16& xb, bool& xnear, f32x16& ya, f32x16& yb, bool& ynear) {
                const bool have_next = (t + 1 < NTW);
                if (lead) {
                    if (have_next) { ynear = isnear(s1); qk(s1, ya, yb, (DIFF && !ynear) ? bias_far : 0.f); }
                    if (t < NTW) pv(s0, xa, xb, cal);
                    if (have_next) cal = sm(t + 1, s1, ya, yb, ynear);
                } else {
                    if (t < NTW) cal = sm(t, s0, xa, xb, xnear);
                    if (have_next) { ynear = isnear(s1); qk(s1, ya, yb, (DIFF && !ynear) ? bias_far : 0.f); }
                    if (t < NTW) pv(s0, xa, xb, cal);
                }
                { const int tmp = s0; s0 = s1; s1 = s2; s2 = tmp; }
            };
            int t = 0;
            for (; t + 5 < NT; t += 2) {
                lstore(s2); gload(t + 4);
                period(t, ca, cb, cnear, na, nb, nnear);
                TILE_BAR();
                lstoreB(s2); gloadB(t + 5);
                period(t + 1, na, nb, nnear, ca, cb, cnear);
                TILE_BAR();
            }
            for (; t < NT; t += 2) {
                if (t + 2 < NT) { lstore(s2); if (t + 4 < NT) gload(t + 4); }
                period(t, ca, cb, cnear, na, nb, nnear);
                TILE_BAR();
                if (t + 3 < NT) { lstoreB(s2); if (t + 5 < NT) gloadB(t + 5); }
                period(t + 1, na, nb, nnear, ca, cb, cnear);
                TILE_BAR();
            }
        }
        il = 1.f / swapadd(l1);
        if (DIFF) { if (mp == 0) {
#pragma unroll
            for (int d = 0; d < 2; ++d)
#pragma unroll
                for (int r = 0; r < 16; ++r) osv[(d * 16 + r) * 64] = oA[d][r] * il; } }
    }
    GAS bf16* orow = P.O + (rowb + qi) * P.op + (CROSS ? h * 256 + dhalf * 128 : h * 64);
    if (!DIFF) {
#pragma unroll
        for (int d = 0; d < ND; ++d)
#pragma unroll
            for (int g = 0; g < 4; ++g) { v2u v; v.x = cvtpk(oA[d][4 * g] * il, oA[d][4 * g + 1] * il); v.y = cvtpk(oA[d][4 * g + 2] * il, oA[d][4 * g + 3] * il); *(GAS v2u*)(orow + 32 * d + 8 * g + 4 * hi) = v; }
    } else {
        const float lam = P.lams[0], lam_init = P.lams[1];
        const float i2 = lam * il;
        float ss = 0.f;
#pragma unroll
        for (int d = 0; d < 2; ++d)
#pragma unroll
            for (int r = 0; r < 16; ++r) { const float v = osv[(d * 16 + r) * 64] - oA[d][r] * i2; oA[d][r] = v; ss += v * v; }
        ss = swapadd(ss);
        const float rs = __builtin_amdgcn_rsqf(ss * (1.f / 64.f) + 1e-6f) * (1.f - lam_init);
        const LAS float* dn = (const LAS float*)(lds + C::DN);
#pragma unroll
        for (int d = 0; d < 2; ++d)
#pragma unroll
            for (int g = 0; g < 4; ++g) { const int c = 32 * d + 8 * g + 4 * hi; const f32x4 gn = *(const LAS f32x4*)(dn + c);
                v2u v; v.x = cvtpk(oA[d][4 * g] * rs * gn[0], oA[d][4 * g + 1] * rs * gn[1]); v.y = cvtpk(oA[d][4 * g + 2] * rs * gn[2], oA[d][4 * g + 3] * rs * gn[3]); *(GAS v2u*)(orow + c) = v; }
    }
}

template <int KIND> struct AK2 {
    static constexpr bool DIFF = KIND == 1;
    static constexpr int HW = KIND == 0 ? 96 : 64, NKS = KIND == 0 ? 6 : 2, KP = KIND == 0 ? 208 : 144;
    static constexpr int CPK = HW / 8, KCH = (128 * CPK) / 512, VCH = 2;
    static constexpr int KB = 128 * KP, VB = 2 * 8192;
    static constexpr int K0 = 0, V0 = 2 * KB, POS = V0 + 2 * VB, PMX = POS + 1024, BT = PMX + 16, DN = BT + 528, OSV = (DN + 256 + 15) & ~15, END = OSV + (DIFF ? 8 * 8192 : 0);
};
static_assert(AK2<0>::END <= RING_BYTES && AK2<1>::END <= RING_BYTES, "attention LDS (128-key tiles)");
template <int KIND>
__device__ __forceinline__ void attn_unit2(const AttnP& P, int b, int h, int qb, LAS unsigned char* lds, int tid, int wave, int lane) {
    lane = lane_id_v(); tid = (wave << 6) | lane;
    typedef AK2<KIND> C;
    constexpr bool DIFF = C::DIFF;
    constexpr int HW = C::HW, NKS = C::NKS, KP = C::KP, CPK = C::CPK, KCH = C::KCH, VCH = C::VCH;
    const int r32 = lane & 31, hi = lane >> 5;
    const size_t rowb = (size_t)b * S;
    const int q0w = qb * 256 + wave * 32, qi = q0w + r32;
    int pq = 0; float bias_far = 0.f;
    __syncthreads();
    if (DIFF) {
        pq = P.pos[rowb + qi];
        if (tid < 129) ((LAS float*)(lds + C::BT))[tid] = P.btab[h * 129 + tid];
        if (tid >= 192 && tid < 256) ((LAS float*)(lds + C::DN))[tid - 192] = P.dnorm[tid - 192];
    }
    int minq = pq;
    if (DIFF) { for (int o = 1; o < 64; o <<= 1) { const int v = shxi(minq, o, lane); minq = v < minq ? v : minq; } }
    const int NT = 2 * (qb + 1);
    const GAS bf16* Kb = P.K + rowb * P.kp + h * HW; const GAS bf16* Vb = P.V + rowb * P.vp + h * 64;
    const __amdgpu_buffer_rsrc_t rK = __builtin_amdgcn_make_buffer_rsrc((void*)Kb, 0, 0x7fffffff, 0x00020000), rV = __builtin_amdgcn_make_buffer_rsrc((void*)Vb, 0, 0x7fffffff, 0x00020000);
    const __amdgpu_buffer_rsrc_t rP = __builtin_amdgcn_make_buffer_rsrc((void*)(DIFF ? P.pos + rowb : (const GAS int*)Kb), 0, 0x7fffffff, 0x00020000);
    int kvo[KCH], vvo[VCH], klo[KCH], vlo[VCH];
#pragma unroll
    for (int i = 0; i < KCH; ++i) { const int c = tid + 512 * i; kvo[i] = ((c / CPK) * P.kp + (c % CPK) * 8) * 2; klo[i] = (c / CPK) * KP + (c % CPK) * 16; }
#pragma unroll
    for (int i = 0; i < VCH; ++i) { const int c = tid + 512 * i; const int key = c >> 3, part = c & 7; vvo[i] = (key * P.vp + part * 8) * 2; vlo[i] = (part >> 2) * 8192 + (key >> 3) * 512 + (key & 7) * 64 + (part & 3) * 16; }
    const int pvo = (tid & 127) * 4;
    u32x4 kr[KCH], vr[VCH]; int pkr = 0;
    auto gload = [&](int t) {
        const int ks = __builtin_amdgcn_readfirstlane(128 * t * P.kp * 2), vs = __builtin_amdgcn_readfirstlane(128 * t * P.vp * 2);
#pragma unroll
        for (int i = 0; i < KCH; ++i) kr[i] = __builtin_amdgcn_raw_buffer_load_b128(rK, kvo[i], ks, 0);
#pragma unroll
        for (int i = 0; i < VCH; ++i) vr[i] = __builtin_amdgcn_raw_buffer_load_b128(rV, vvo[i], vs, 0);
        if (DIFF) pkr = __builtin_amdgcn_raw_buffer_load_b32(rP, pvo, __builtin_amdgcn_readfirstlane(128 * t * 4), 0);
    };
    auto lstore = [&](int buf) {
        LAS unsigned char* kb_ = lds + C::K0 + buf * C::KB; LAS unsigned char* vb_ = lds + C::V0 + buf * C::VB;
#pragma unroll
        for (int i = 0; i < KCH; ++i) *(LAS u32x4*)(kb_ + klo[i]) = kr[i];
#pragma unroll
        for (int i = 0; i < VCH; ++i) *(LAS u32x4*)(vb_ + vlo[i]) = vr[i];
        if (DIFF) { ((LAS int*)(lds + C::POS + buf * 512))[tid & 127] = pkr;
            if (tid < 128) { int mk_ = pkr; for (int o = 1; o < 64; o <<= 1) { const int v = shxi(mk_, o, lane); mk_ = v > mk_ ? v : mk_; } if (lane == 0) ((LAS int*)(lds + C::PMX))[buf * 2 + wave] = mk_; } }
    };
    LAS float* osv = (LAS float*)(lds + C::OSV) + wave * 2048 + lane;
    float il = 0.f;
    f32x16 oA[2];
#pragma unroll 1
    for (int mp = 0; mp < (DIFF ? 2 : 1); ++mp) {
        bf16x8 qf[NKS];
        { const GAS bf16* qrow = P.Q + (rowb + qi) * P.qp + h * HW + mp * 32;
#pragma unroll
          for (int s = 0; s < NKS; ++s) qf[s] = *(const GAS bf16x8*)(qrow + 16 * s + 8 * hi);
          if (KIND == 0) {
              const GAS float* rp = P.rope + (rowb + qi) * 32 + 8 * hi;
              const f32x4 c0 = *(const GAS f32x4*)rp, c1 = *(const GAS f32x4*)(rp + 4), s0 = *(const GAS f32x4*)(rp + 16), s1 = *(const GAS f32x4*)(rp + 20);
              const u32x4 a = __builtin_bit_cast(u32x4, qf[NKS - 2]), bq = __builtin_bit_cast(u32x4, qf[NKS - 1]); u32x4 ra, rb;
#pragma unroll
              for (int w = 0; w < 4; ++w) { const float cl = w < 2 ? c0[2 * w] : c1[2 * w - 4], ch = w < 2 ? c0[2 * w + 1] : c1[2 * w - 3], sl = w < 2 ? s0[2 * w] : s1[2 * w - 4], sh = w < 2 ? s0[2 * w + 1] : s1[2 * w - 3];
                  const float x1l = bflo(a[w]), x1h = bfhi(a[w]), x2l = bflo(bq[w]), x2h = bfhi(bq[w]);
                  ra[w] = cvtpk(x1l * cl - x2l * sl, x1h * ch - x2h * sh); rb[w] = cvtpk(x1l * sl + x2l * cl, x1h * sh + x2h * ch); }
              qf[NKS - 2] = __builtin_bit_cast(bf16x8, ra); qf[NKS - 1] = __builtin_bit_cast(bf16x8, rb);
          } }
        __syncthreads();
        float m1 = 0.f, l1 = 0.f;
        f32x16 negm;
#pragma unroll
        for (int r = 0; r < 16; ++r) negm[r] = 0.f;
#pragma unroll
        for (int d = 0; d < 2; ++d)
#pragma unroll
            for (int r = 0; r < 16; ++r) oA[d][r] = 0.f;
        gload(0); lstore(0);
        if (NT > 1) gload(1);
        __syncthreads();
        if (DIFF) { bias_far = ((LAS float*)(lds + C::BT))[128];
#pragma unroll
            for (int r = 0; r < 16; ++r) negm[r] = bias_far; }
        const int NTW = (q0w + 31) / 128 + 1;
        auto compute = [&](int t, int buf) {
            const int k0 = 128 * t;
            const LAS unsigned char* kb_ = lds + C::K0 + buf * C::KB + r32 * KP + hi * 16 + mp * 64;
            const LAS unsigned char* vb_ = lds + C::V0 + buf * C::VB + ((lane >> 4) & 1) * 32 + (lane & 3) * 8 + (4 * hi + ((lane & 15) >> 2)) * 64;
            bool nearb = false;
            if (DIFF) { const LAS int* pm = (const LAS int*)(lds + C::PMX) + buf * 2; const int m0 = __builtin_amdgcn_readfirstlane(pm[0]), m1_ = __builtin_amdgcn_readfirstlane(pm[1]); nearb = (minq - (m0 > m1_ ? m0 : m1_)) < 128; }
            f32x16 sc[4];
            if (DIFF) { if (nearb) {
#pragma unroll
                for (int g = 0; g < 4; ++g)
#pragma unroll
                    for (int r = 0; r < 16; ++r) sc[g][r] = -m1; } }
            constexpr int HB = NKS > 3 ? 3 : NKS;
#pragma unroll
            for (int s0_ = 0; s0_ < NKS; s0_ += HB) {
                bf16x8 kf[4][HB];
#pragma unroll
                for (int g = 0; g < 4; ++g)
#pragma unroll
                    for (int s = 0; s < HB; ++s) kf[g][s] = *(const LAS bf16x8*)(kb_ + 32 * g * KP + (s0_ + s) * 32);
                __builtin_amdgcn_sched_barrier(0);
#pragma unroll
                for (int s = 0; s < HB; ++s)
#pragma unroll
                    for (int g = 0; g < 4; ++g) {
                        if (s0_ + s == 0 && !(DIFF && nearb)) sc[g] = __builtin_amdgcn_mfma_f32_32x32x16_bf16(kf[g][s], qf[s0_ + s], negm, 0, 0, 0);
                        else sc[g] = __builtin_amdgcn_mfma_f32_32x32x16_bf16(kf[g][s], qf[s0_ + s], sc[g], 0, 0, 0); }
                __builtin_amdgcn_sched_barrier(0);
            }
            if (DIFF) { if (nearb) {
                const LAS int* pk = (const LAS int*)(lds + C::POS + buf * 512); const LAS float* bt = (const LAS float*)(lds + C::BT);
#pragma unroll
                for (int g = 0; g < 4; ++g)
#pragma unroll
                    for (int r = 0; r < 16; ++r) { int n0 = pq - pk[32 * g + crow(r, hi)]; n0 = n0 < 0 ? 0 : (n0 > 128 ? 128 : n0); sc[g][r] += bt[n0]; }
            } }
            asm volatile("s_nop 15\n\ts_nop 7" : "+v"(sc[0]), "+v"(sc[1]), "+v"(sc[2]), "+v"(sc[3]));
            if (k0 + 127 > q0w) {
#pragma unroll
                for (int g = 0; g < 4; ++g)
#pragma unroll
                    for (int r = 0; r < 16; ++r) { if (k0 + 32 * g + crow(r, hi) > qi) sc[g][r] = -1e30f; }
            }
            const float mx = swapmax(vmax3(max32(sc[0], sc[1]), max32(sc[2], sc[3]), -1e30f));
            const bool up = (t == 0) || mx > 8.0f;
            float al = 1.f;
            if (__builtin_amdgcn_ballot_w64(up) != 0ull) {
                const float dl = up ? mx : 0.f; al = __builtin_amdgcn_exp2f(-dl); l1 *= al; m1 += dl;
#pragma unroll
                for (int r = 0; r < 16; ++r) negm[r] -= dl;
#pragma unroll
                for (int g = 0; g < 4; ++g)
#pragma unroll
                    for (int r = 0; r < 16; ++r) sc[g][r] -= dl;
            }
            float ls = 0.f;
#pragma unroll
            for (int g = 0; g < 4; ++g)
#pragma unroll
                for (int r = 0; r < 16; ++r) { sc[g][r] = __builtin_amdgcn_exp2f(sc[g][r]); ls += sc[g][r]; }
            l1 += ls;
            bf16x8 pf[8];
#pragma unroll
            for (int g = 0; g < 4; ++g) { pf[2 * g] = pack8(sc[g], 0); pf[2 * g + 1] = pack8(sc[g], 8); }
            if (__builtin_amdgcn_ballot_w64(al != 1.0f) != 0ull) {
#pragma unroll
                for (int d = 0; d < 2; ++d)
#pragma unroll
                    for (int r = 0; r < 16; ++r) oA[d][r] *= al;
            }
#pragma unroll
            for (int d = 0; d < 2; ++d) {
                bf16x8 vf[8];
#pragma unroll
                for (int s = 0; s < 8; ++s) { const s16x4 lo = vtr(vb_ + d * 8192 + s * 1024), hh = vtr(vb_ + d * 8192 + s * 1024 + 512); vf[s] = (bf16x8){lo[0], lo[1], lo[2], lo[3], hh[0], hh[1], hh[2], hh[3]}; }
                __builtin_amdgcn_sched_barrier(0);
#pragma unroll
                for (int s = 0; s < 8; ++s) oA[d] = __builtin_amdgcn_mfma_f32_32x32x16_bf16(vf[s], pf[s], oA[d], 0, 0, 0);
                __builtin_amdgcn_sched_barrier(0);
            }
        };
        int t = 0;
        for (; t + 2 < NT; ++t) {
            const int buf = t & 1;
            lstore(buf ^ 1); gload(t + 2);
            if (t < NTW) compute(t, buf);
            TILE_BAR();
        }
        for (; t < NT; ++t) {
            const int buf = t & 1;
            if (t + 1 < NT) lstore(buf ^ 1);
            if (t < NTW) compute(t, buf);
            TILE_BAR();
        }
        il = 1.f / swapadd(l1);
        if (DIFF) { if (mp == 0) {
#pragma unroll
            for (int d = 0; d < 2; ++d)
#pragma unroll
                for (int r = 0; r < 16; ++r) osv[(d * 16 + r) * 64] = oA[d][r] * il; } }
    }
    GAS bf16* orow = P.O + (rowb + qi) * P.op + h * 64;
    if (!DIFF) {
#pragma unroll
        for (int d = 0; d < 2; ++d)
#pragma unroll
            for (int g = 0; g < 4; ++g) { v2u v; v.x = cvtpk(oA[d][4 * g] * il, oA[d][4 * g + 1] * il); v.y = cvtpk(oA[d][4 * g + 2] * il, oA[d][4 * g + 3] * il); *(GAS v2u*)(orow + 32 * d + 8 * g + 4 * hi) = v; }
    } else {
        const float lam = P.lams[0], lam_init = P.lams[1];
        const float i2 = lam * il;
        float ss = 0.f;
#pragma unroll
        for (int d = 0; d < 2; ++d)
#pragma unroll
            for (int r = 0; r < 16; ++r) { const float v = osv[(d * 16 + r) * 64] - oA[d][r] * i2; oA[d][r] = v; ss += v * v; }
        ss = swapadd(ss);
        const float rs = __builtin_amdgcn_rsqf(ss * (1.f / 64.f) + 1e-6f) * (1.f - lam_init);
        const LAS float* dn = (const LAS float*)(lds + C::DN);
#pragma unroll
        for (int d = 0; d < 2; ++d)
#pragma unroll
            for (int g = 0; g < 4; ++g) { const int c = 32 * d + 8 * g + 4 * hi; const f32x4 gn = *(const LAS f32x4*)(dn + c);
                v2u v; v.x = cvtpk(oA[d][4 * g] * rs * gn[0], oA[d][4 * g + 1] * rs * gn[1]); v.y = cvtpk(oA[d][4 * g + 2] * rs * gn[2], oA[d][4 * g + 3] * rs * gn[3]); *(GAS v2u*)(orow + c) = v; }
    }
}

__device__ __forceinline__ void attn_phase(const AttnP& PM, const AttnP& PD, LAS unsigned char* lds, int tid, int wave, int lane, int vcu, int G, int only = -1) {
    for (int i = vcu; i < 512; i += G) {
        if (only >= 0 && (i >> 8) != only) continue;
        const int kind = i >> 8, c = i & 255, bh = c >> 4, s = c & 15;
        if (kind == 0) {
#pragma unroll 1
            for (int k = 0; k < 2; ++k) attn_unit2<0>(PM, bh >> 2, bh & 3, k ? 31 - s : s, lds, tid, wave, lane);
        } else {
#pragma unroll 1
            for (int k = 0; k < 2; ++k) attn_unit2<1>(PD, bh >> 2, bh & 3, k ? 31 - s : s, lds, tid, wave, lane);
        }
    }
}
__device__ __forceinline__ float cx_max16(const f32x16& p) { return fmaxf(fmaxf(fmaxf(fmaxf(p[0], p[1]), fmaxf(p[2], p[3])), fmaxf(fmaxf(p[4], p[5]), fmaxf(p[6], p[7]))), fmaxf(fmaxf(fmaxf(p[8], p[9]), fmaxf(p[10], p[11])), fmaxf(fmaxf(p[12], p[13]), fmaxf(p[14], p[15])))); }
__device__ __forceinline__ void cross_unit2(const AttnP& P, int b, int h, int qb, LAS unsigned char* lds, int wave) {
    const int lane = lane_id_v(), tid = (wave << 6) | lane;
    constexpr int KP = 528;
    const int r32 = lane & 31, hi = lane >> 5;
    const size_t rowb = (size_t)b * S, rowk = (size_t)b * MEM;
    const int qi = qb * 256 + wave * 32 + r32;
    const GAS bf16* Kb = P.K + rowk * P.kp + h * 256; const GAS bf16* Vb = P.V + rowk * P.vp + h * 256;
    const __amdgpu_buffer_rsrc_t rK = __builtin_amdgcn_make_buffer_rsrc((void*)Kb, 0, 0x7fffffff, 0x00020000), rV = __builtin_amdgcn_make_buffer_rsrc((void*)Vb, 0, 0x7fffffff, 0x00020000);
    const GAS bf16* qrow = P.Q + (rowb + qi) * P.qp + h * 256 + 8 * hi;
    bf16x8 qf[4];
#pragma unroll
    for (int s = 0; s < 4; ++s) qf[s] = *(const GAS bf16x8*)(qrow + 16 * s);
    __syncthreads();
#pragma unroll
    for (int hb = 0; hb < 2; ++hb) { u32x4 st[8];
#pragma unroll
        for (int i = 0; i < 8; ++i) { const int c = tid + 512 * (8 * hb + i); st[i] = __builtin_amdgcn_raw_buffer_load_b128(rK, ((c >> 5) * P.kp + (c & 31) * 8) * 2, 0, 0); }
#pragma unroll
        for (int i = 0; i < 8; ++i) { const int c = tid + 512 * (8 * hb + i); *(LAS u32x4*)(lds + (c >> 5) * KP + (c & 31) * 16) = st[i]; } }
    __syncthreads();
    f32x16 sc[8];
#pragma unroll
    for (int g = 0; g < 8; ++g)
#pragma unroll
        for (int r = 0; r < 16; ++r) sc[g][r] = 0.f;
    const LAS unsigned char* kb_ = lds + r32 * KP + hi * 16;
#pragma unroll
    for (int c = 0; c < 4; ++c) {
        bf16x8 qn[4];
        if (c + 1 < 4) {
#pragma unroll
            for (int s = 0; s < 4; ++s) qn[s] = *(const GAS bf16x8*)(qrow + 64 * (c + 1) + 16 * s); }
#pragma unroll
        for (int g = 0; g < 8; ++g) { bf16x8 kf[4];
#pragma unroll
            for (int s = 0; s < 4; ++s) kf[s] = *(const LAS bf16x8*)(kb_ + 32 * g * KP + (4 * c + s) * 32);
#pragma unroll
            for (int s = 0; s < 4; ++s) sc[g] = __builtin_amdgcn_mfma_f32_32x32x16_bf16(kf[s], qf[s], sc[g], 0, 0, 0); }
        if (c + 1 < 4) {
#pragma unroll
            for (int s = 0; s < 4; ++s) qf[s] = qn[s]; }
    }
    float m = fmaxf(fmaxf(fmaxf(cx_max16(sc[0]), cx_max16(sc[1])), fmaxf(cx_max16(sc[2]), cx_max16(sc[3]))), fmaxf(fmaxf(cx_max16(sc[4]), cx_max16(sc[5])), fmaxf(cx_max16(sc[6]), cx_max16(sc[7]))));
    m = swapmax(m);
    float l = 0.f;
    bf16x8 pf[16];
#pragma unroll
    for (int g = 0; g < 8; ++g) {
#pragma unroll
        for (int r = 0; r < 16; ++r) { sc[g][r] = __builtin_amdgcn_exp2f(sc[g][r] - m); l += sc[g][r]; }
        pf[2 * g] = pack8(sc[g], 0); pf[2 * g + 1] = pack8(sc[g], 8); }
    const float il = 1.f / swapadd(l);
    __syncthreads();
#pragma unroll
    for (int hb = 0; hb < 2; ++hb) { u32x4 st[8];
#pragma unroll
        for (int i = 0; i < 8; ++i) { const int c = tid + 512 * (8 * hb + i); const int sub = c & 3, key = (c >> 2) & 255, dt = c >> 10; st[i] = __builtin_amdgcn_raw_buffer_load_b128(rV, (key * P.vp + dt * 32 + sub * 8) * 2, 0, 0); }
#pragma unroll
        for (int i = 0; i < 8; ++i) { const int c = tid + 512 * (8 * hb + i); const int sub = c & 3, key = (c >> 2) & 255, dt = c >> 10; *(LAS u32x4*)(lds + dt * 16384 + (key >> 3) * 512 + (key & 7) * 64 + sub * 16) = st[i]; } }
    __syncthreads();
    const LAS unsigned char* vb_ = lds + ((lane >> 4) & 1) * 32 + (lane & 3) * 8 + (4 * hi + ((lane & 15) >> 2)) * 64;
    GAS bf16* orow = P.O + (rowb + qi) * P.op + h * 256;
#pragma unroll 1
    for (int dh = 0; dh < 2; ++dh) {
        f32x16 oA[4];
#pragma unroll
        for (int d = 0; d < 4; ++d)
#pragma unroll
            for (int r = 0; r < 16; ++r) oA[d][r] = 0.f;
#pragma unroll
        for (int d = 0; d < 4; ++d) {
#pragma unroll
            for (int sb = 0; sb < 2; ++sb) { bf16x8 vf[8];
#pragma unroll
                for (int s = 0; s < 8; ++s) { const s16x4 lo = vtr(vb_ + (4 * dh + d) * 16384 + (8 * sb + s) * 1024), hh = vtr(vb_ + (4 * dh + d) * 16384 + (8 * sb + s) * 1024 + 512); vf[s] = (bf16x8){lo[0], lo[1], lo[2], lo[3], hh[0], hh[1], hh[2], hh[3]}; }
#pragma unroll
                for (int s = 0; s < 8; ++s) oA[d] = __builtin_amdgcn_mfma_f32_32x32x16_bf16(vf[s], pf[8 * sb + s], oA[d], 0, 0, 0); } }
#pragma unroll
        for (int d = 0; d < 4; ++d)
#pragma unroll
            for (int g = 0; g < 4; ++g) { v2u v; v.x = cvtpk(oA[d][4 * g] * il, oA[d][4 * g + 1] * il); v.y = cvtpk(oA[d][4 * g + 2] * il, oA[d][4 * g + 3] * il); *(GAS v2u*)(orow + 128 * dh + 32 * d + 8 * g + 4 * hi) = v; }
    }
}
__device__ __forceinline__ void cross_phase(const AttnP& PC, LAS unsigned char* lds, int tid, int wave, int lane, int vcu, int G) {
#pragma unroll 1
    for (int i = vcu; i < 512; i += G) { const int bh = i >> 5; cross_unit2(PC, bh >> 2, bh & 3, i & 31, lds, wave); }
}


__device__ __forceinline__ float vmax2(float a, float b) { float r; asm("v_max_f32_e32 %0, %1, %2" : "=v"(r) : "v"(a), "v"(b)); return r; }
__device__ __forceinline__ float vmin2(float a, float b) { float r; asm("v_min_f32_e32 %0, %1, %2" : "=v"(r) : "v"(a), "v"(b)); return r; }
__device__ __forceinline__ void pad16(float (&a)[16]) {
    asm volatile("s_nop 1" : "+v"(a[0]), "+v"(a[1]), "+v"(a[2]), "+v"(a[3]), "+v"(a[4]), "+v"(a[5]), "+v"(a[6]), "+v"(a[7]), "+v"(a[8]), "+v"(a[9]), "+v"(a[10]), "+v"(a[11]), "+v"(a[12]), "+v"(a[13]), "+v"(a[14]), "+v"(a[15]));
}
__device__ __forceinline__ void sort16_desc(float (&a)[16]) {
#pragma unroll
    for (int k = 2; k <= 16; k <<= 1)
#pragma unroll
        for (int j = k >> 1; j > 0; j >>= 1)
#pragma unroll
            for (int i = 0; i < 16; ++i) { const int l = i ^ j; if (l > i) { const bool desc = ((i & k) == 0); const float hi_ = vmax2(a[i], a[l]), lo_ = vmin2(a[i], a[l]); a[i] = desc ? hi_ : lo_; a[l] = desc ? lo_ : hi_; } }
}
__device__ __forceinline__ void merge16_desc(float (&a)[16], const float (&b)[16]) {
#pragma unroll
    for (int i = 0; i < 16; ++i) a[i] = vmax2(a[i], b[15 - i]);
#pragma unroll
    for (int j = 8; j > 0; j >>= 1)
#pragma unroll
        for (int i = 0; i < 16; ++i) { const int l = i ^ j; if (l > i) { const float hi_ = vmax2(a[i], a[l]), lo_ = vmin2(a[i], a[l]); a[i] = hi_; a[l] = lo_; } }
}
__device__ __forceinline__ void top16_of_64(float (&g0)[16], float (&g1)[16], float (&g2)[16], float (&g3)[16]) {
    sort16_desc(g0); sort16_desc(g1); merge16_desc(g0, g1); sort16_desc(g2); sort16_desc(g3); merge16_desc(g2, g3); merge16_desc(g0, g2);
}
__device__ __forceinline__ float embed(float v, unsigned mask, unsigned id) { return __builtin_bit_cast(float, (__builtin_bit_cast(unsigned, v) & mask) | id); }
__device__ __forceinline__ float mkcand(float x, float y, unsigned id) { return embed(x + y, 0xFFFFFF00u, id); }

__device__ __forceinline__ void swap32(float& a, float& b) { asm volatile("v_nop\n\tv_nop\n\tv_permlane32_swap_b32 %0, %1" : "+v"(a), "+v"(b)); }
struct RouteP { const GAS bf16* QP; const GAS bf16* keys; GAS int* EX; GAS float* GW; };
constexpr int RT_KP = 144, RT_KEYS = 0, RT_SCR = 256 * RT_KP, RT_END = RT_SCR + 8 * 8192;
__device__ __forceinline__ void route_phase(const RouteP& P, LAS unsigned char* lds, int tid, int wave, int lane, int vcu, int G) {
    asm volatile("" : "+v"(tid), "+v"(lane));
    __syncthreads();
    for (int c = tid; c < 256 * 8; c += 512) { const int row = c >> 3, part = c & 7; *(LAS u32x4*)(lds + RT_KEYS + row * RT_KP + part * 16) = *(const u32x4*)(P.keys + row * 64 + part * 8); }
    __syncthreads();
    const int r32 = lane & 31, hi = lane >> 5;
    LAS int* scr = (LAS int*)(lds + RT_SCR + wave * 8192);
    for (int u = vcu; u < T / 32; u += G) {
        const size_t t = (size_t)u * 32 + r32; const int h = wave;
        float T2[2][16];
#pragma unroll
        for (int c = 0; c < 2; ++c) {
            bf16x8 qf[4];
            { const GAS bf16* q = P.QP + t * 1024 + h * 128 + c * 64 + 8 * hi;
#pragma unroll
              for (int s = 0; s < 4; ++s) qf[s] = *(const GAS bf16x8*)(q + 16 * s); }
            f32x16 sc[4];
#pragma unroll
            for (int m = 0; m < 4; ++m) {
#pragma unroll
                for (int r = 0; r < 16; ++r) sc[m][r] = 0.f;
#pragma unroll
                for (int s = 0; s < 4; ++s) { const bf16x8 a = *(const LAS bf16x8*)(lds + RT_KEYS + (c * 128 + 32 * m + r32) * RT_KP + s * 32 + hi * 16);
                    sc[m] = __builtin_amdgcn_mfma_f32_32x32x16_bf16(a, qf[s], sc[m], 0, 0, 0); }
            }
            float g0[16], g1[16], g2[16], g3[16];
            const unsigned h4 = 4u * (unsigned)hi;
#pragma unroll
            for (int r = 0; r < 16; ++r) { const unsigned kr_ = (unsigned)((r & 3) + 8 * (r >> 2));
                g0[r] = embed(sc[0][r], 0xFFFFFF80u, kr_ | h4); g1[r] = embed(sc[1][r], 0xFFFFFF80u, (32u + kr_) | h4); g2[r] = embed(sc[2][r], 0xFFFFFF80u, (64u + kr_) | h4); g3[r] = embed(sc[3][r], 0xFFFFFF80u, (96u + kr_) | h4); }
            top16_of_64(g0, g1, g2, g3);
            pad16(g0);
#pragma unroll
            for (int i = 0; i < 16; ++i) T2[c][i] = g0[i];
        }
        float A[16], Bv[16];
#pragma unroll
        for (int i = 0; i < 16; ++i) { A[i] = T2[0][i]; Bv[i] = T2[1][i]; swap32(A[i], Bv[i]); }
        merge16_desc(A, Bv);
        pad16(A);
        float T0[16], T1[16];
#pragma unroll
        for (int i = 0; i < 16; ++i) { T0[i] = A[i]; T1[i] = A[i]; swap32(T0[i], T1[i]); }
#pragma unroll
        for (int i = 0; i < 16; ++i) { scr[i * 64 + lane] = (int)(__builtin_bit_cast(unsigned, T0[i]) & 127u); scr[(16 + i) * 64 + lane] = (int)(__builtin_bit_cast(unsigned, T1[i]) & 127u);
            T0[i] = embed(T0[i], 0xFFFFFF80u, 0u); T1[i] = embed(T1[i], 0xFFFFFF80u, 0u); }
        float c0[16], c1[16], c2[16], c3[16];
        const float NINF = -__builtin_inff();
#pragma unroll
        for (int b = 0; b < 16; ++b) c0[b] = mkcand(T0[0], T1[b], (unsigned)b);
#pragma unroll
        for (int b = 0; b < 8; ++b) c1[b] = mkcand(T0[1], T1[b], 16u + b);
#pragma unroll
        for (int b = 0; b < 5; ++b) c1[8 + b] = mkcand(T0[2], T1[b], 32u + b);
#pragma unroll
        for (int b = 0; b < 3; ++b) c1[13 + b] = mkcand(T0[4], T1[b], 64u + b);
#pragma unroll
        for (int b = 0; b < 4; ++b) c2[b] = mkcand(T0[3], T1[b], 48u + b);
        c2[4] = mkcand(T0[5], T1[0], 80u); c2[5] = mkcand(T0[5], T1[1], 81u); c2[6] = mkcand(T0[6], T1[0], 96u); c2[7] = mkcand(T0[6], T1[1], 97u); c2[8] = mkcand(T0[7], T1[0], 112u); c2[9] = mkcand(T0[7], T1[1], 113u);
#pragma unroll
        for (int a = 8; a < 14; ++a) c2[10 + a - 8] = mkcand(T0[a], T1[0], 16u * a);
        c3[0] = mkcand(T0[14], T1[0], 224u); c3[1] = mkcand(T0[15], T1[0], 240u);
#pragma unroll
        for (int i = 2; i < 16; ++i) c3[i] = NINF;
        top16_of_64(c0, c1, c2, c3);
        pad16(c0);
        float gsum = 0.f, ge[16]; int ex[16];
        const float mtop = embed(c0[0], 0xFFFFFF00u, 0u);
#pragma unroll
        for (int i = 0; i < 16; ++i) { const unsigned bits = __builtin_bit_cast(unsigned, c0[i]); const int a = (bits >> 4) & 15, b = bits & 15;
            ge[i] = __builtin_amdgcn_exp2f((embed(c0[i], 0xFFFFFF00u, 0u) - mtop) * LOG2E); gsum += ge[i];
            ex[i] = scr[a * 64 + lane] * 128 + scr[(16 + b) * 64 + lane]; }
        const float ginv = __builtin_amdgcn_rcpf(gsum);
        if (hi == 0) { GAS v4u* d = (GAS v4u*)(P.EX + t * 128 + h * 16);
#pragma unroll
            for (int i = 0; i < 4; ++i) d[i] = (v4u){(unsigned)ex[4 * i], (unsigned)ex[4 * i + 1], (unsigned)ex[4 * i + 2], (unsigned)ex[4 * i + 3]}; }
        else { GAS f32x4* d = (GAS f32x4*)(P.GW + t * 128 + h * 16);
#pragma unroll
            for (int i = 0; i < 4; ++i) d[i] = (f32x4){ge[4 * i] * ginv, ge[4 * i + 1] * ginv, ge[4 * i + 2] * ginv, ge[4 * i + 3] * ginv}; }
    }
}

__device__ __forceinline__ int wave_allsum_i(int v) {
    v += __builtin_amdgcn_update_dpp(0, v, 0xB1, 0xF, 0xF, true);
    v += __builtin_amdgcn_update_dpp(0, v, 0x4E, 0xF, 0xF, true);
    v += __builtin_amdgcn_update_dpp(0, v, 0x141, 0xF, 0xF, true);
    v += __builtin_amdgcn_update_dpp(0, v, 0x140, 0xF, 0xF, true);
    { int a = v, b = v; asm volatile("v_nop\n\tv_nop\n\tv_permlane16_swap_b32 %0, %1" : "+v"(a), "+v"(b)); v = a + b; }
    { int a = v, b = v; asm volatile("v_nop\n\tv_nop\n\tv_permlane32_swap_b32 %0, %1" : "+v"(a), "+v"(b)); v = a + b; }
    return v;
}
__device__ __forceinline__ float wave_allsum(float v) {
    v += __builtin_bit_cast(float, __builtin_amdgcn_update_dpp(0, __builtin_bit_cast(int, v), 0xB1, 0xF, 0xF, true));
    v += __builtin_bit_cast(float, __builtin_amdgcn_update_dpp(0, __builtin_bit_cast(int, v), 0x4E, 0xF, 0xF, true));
    v += __builtin_bit_cast(float, __builtin_amdgcn_update_dpp(0, __builtin_bit_cast(int, v), 0x141, 0xF, 0xF, true));
    v += __builtin_bit_cast(float, __builtin_amdgcn_update_dpp(0, __builtin_bit_cast(int, v), 0x140, 0xF, 0xF, true));
    { float a = v, b = v; asm volatile("v_nop\n\tv_nop\n\tv_permlane16_swap_b32 %0, %1" : "+v"(a), "+v"(b)); v = a + b; }
    { float a = v, b = v; asm volatile("v_nop\n\tv_nop\n\tv_permlane32_swap_b32 %0, %1" : "+v"(a), "+v"(b)); v = a + b; }
    return v;
}
__device__ __forceinline__ float wave_allmax(float v) {
    v = fmaxf(v, __builtin_bit_cast(float, __builtin_amdgcn_update_dpp(0, __builtin_bit_cast(int, v), 0xB1, 0xF, 0xF, true)));
    v = fmaxf(v, __builtin_bit_cast(float, __builtin_amdgcn_update_dpp(0, __builtin_bit_cast(int, v), 0x4E, 0xF, 0xF, true)));
    v = fmaxf(v, __builtin_bit_cast(float, __builtin_amdgcn_update_dpp(0, __builtin_bit_cast(int, v), 0x141, 0xF, 0xF, true)));
    v = fmaxf(v, __builtin_bit_cast(float, __builtin_amdgcn_update_dpp(0, __builtin_bit_cast(int, v), 0x140, 0xF, 0xF, true)));
    { float a = v, b = v; asm volatile("v_nop\n\tv_nop\n\tv_permlane16_swap_b32 %0, %1" : "+v"(a), "+v"(b)); v = fmaxf(a, b); }
    { float a = v, b = v; asm volatile("v_nop\n\tv_nop\n\tv_permlane32_swap_b32 %0, %1" : "+v"(a), "+v"(b)); v = fmaxf(a, b); }
    return v;
}
__device__ __forceinline__ unsigned q4(float a, float b, float c, float d, int off) {
    const int ia = (int)__builtin_rintf(a) + off, ib = (int)__builtin_rintf(b) + off, ic = (int)__builtin_rintf(c) + off, id = (int)__builtin_rintf(d) + off;
    return (unsigned)(ia & 255) | ((unsigned)(ib & 255) << 8) | ((unsigned)(ic & 255) << 16) | ((unsigned)(id & 255) << 24);
}
__device__ __forceinline__ void quant_row(const GAS float* src, GAS unsigned* dst, GAS float* scale, int off, int lane) {
    const GAS f32x4* s = (const GAS f32x4*)src + 4 * lane; f32x4 v[4]; float m = 0.f;
#pragma unroll
    for (int i = 0; i < 4; ++i) { v[i] = s[i]; m = fmaxf(m, fmaxf(fmaxf(__builtin_fabsf(v[i].x), __builtin_fabsf(v[i].y)), fmaxf(__builtin_fabsf(v[i].z), __builtin_fabsf(v[i].w)))); }
    m = wave_allmax(m); const float inv = m > 0.f ? 127.f / m : 0.f;
    v4u w;
    w.x = q4(v[0].x * inv, v[0].y * inv, v[0].z * inv, v[0].w * inv, off); w.y = q4(v[1].x * inv, v[1].y * inv, v[1].z * inv, v[1].w * inv, off);
    w.z = q4(v[2].x * inv, v[2].y * inv, v[2].z * inv, v[2].w * inv, off); w.w = q4(v[3].x * inv, v[3].y * inv, v[3].z * inv, v[3].w * inv, off);
    *((GAS v4u*)dst + lane) = w;
    if (lane == 0) *scale = m * (1.f / 127.f);
}
struct PeerS { int nslices_step, first_slice, nloc, rank; };
__device__ __forceinline__ PeerS peer_sched(const GAS unsigned* rankw, int xcc, int rank) {
    int nx = 0, myidx = 0, nloc = 1;
    for (int j = 0; j < 16; ++j) { const int c = (int)__hip_atomic_load(rankw + 64 * j, __ATOMIC_RELAXED, __HIP_MEMORY_SCOPE_AGENT); if (c > 0) { if (j == xcc) { myidx = nx; nloc = c; } ++nx; } }
    PeerS s; s.nslices_step = nx > 0 ? nx : 1; s.first_slice = myidx; s.nloc = nloc; s.rank = rank; return s;
}
struct Peer1P { const GAS unsigned GAS char* HQ; const GAS int* EX; const GAS unsigned GAS char* U8; GAS int* P; };
__device__ __forceinline__ void peer_k1(const Peer1P& Q, const PeerS& sc, int wave, int lane) {
    asm volatile("" : "+v"(lane));
    const int g = lane >> 3, j = lane & 7;
    for (int s = sc.first_slice; s < 8; s += sc.nslices_step)
        for (int tile = sc.rank; tile < T / 64; tile += sc.nloc) {
            const size_t t0 = (size_t)tile * 64 + wave * 8;
            v4u hqn = *(const GAS v4u*)(Q.HQ + t0 * 1024 + 128 * s + 16 * j), exn[4];
#pragma unroll
            for (int i = 0; i < 4; ++i) exn[i] = *(const GAS v4u*)(Q.EX + t0 * 128 + 16 * g + 4 * i);
#pragma unroll 1
            for (int k = 0; k < 8; ++k) {
                const size_t t = t0 + k;
                const v4u hq = hqn; v4u ex[4];
#pragma unroll
                for (int i = 0; i < 4; ++i) ex[i] = exn[i];
                if (k + 1 < 8) {
                    hqn = *(const GAS v4u*)(Q.HQ + (t + 1) * 1024 + 128 * s + 16 * j);
#pragma unroll
                    for (int i = 0; i < 4; ++i) exn[i] = *(const GAS v4u*)(Q.EX + (t + 1) * 128 + 16 * g + 4 * i);
                }
                v4u uu[16];
#pragma unroll
                for (int i = 0; i < 16; ++i) { const unsigned e = (i & 3) == 0 ? ex[i >> 2].x : (i & 3) == 1 ? ex[i >> 2].y : (i & 3) == 2 ? ex[i >> 2].z : ex[i >> 2].w;
                    uu[i] = *(const GAS v4u*)(Q.U8 + (size_t)e * 1024 + 128 * s + 16 * j); }
                int lo = 0, hi = 0;
#pragma unroll
                for (int i = 0; i < 16; ++i) {
                    int p = __builtin_amdgcn_sdot4((int)uu[i].x, (int)hq.x, 0, false); p = __builtin_amdgcn_sdot4((int)uu[i].y, (int)hq.y, p, false); p = __builtin_amdgcn_sdot4((int)uu[i].z, (int)hq.z, p, false); p = __builtin_amdgcn_sdot4((int)uu[i].w, (int)hq.w, p, false);
                    p += __builtin_amdgcn_update_dpp(0, p, 0xB1, 0xF, 0xF, true); p += __builtin_amdgcn_update_dpp(0, p, 0x4E, 0xF, 0xF, true); p += __builtin_amdgcn_update_dpp(0, p, 0x141, 0xF, 0xF, true);
                    if (i < 8) lo = (j == i) ? p : lo; else hi = (j == i - 8) ? p : hi;
                }
                GAS int* prow = Q.P + t * 128 + 16 * g + j;
                (void)__hip_atomic_fetch_add(prow, lo, __ATOMIC_RELAXED, __HIP_MEMORY_SCOPE_AGENT); (void)__hip_atomic_fetch_add(prow + 8, hi, __ATOMIC_RELAXED, __HIP_MEMORY_SCOPE_AGENT);
            }
        }
}
__device__ __forceinline__ void peer_w(const GAS int* EX, const GAS float* GW, const GAS int* P, const GAS float* SH, const GAS float* SU, const GAS float* SV, GAS signed char* WQ, GAS float* WSC, int gw, int NGW, int lane) {
    asm volatile("" : "+v"(lane));
    for (int t = gw; t < T; t += NGW) {
        const float sh = SH[t];
#pragma unroll
        for (int q = 0; q < 2; ++q) { const size_t idx = (size_t)t * 128 + lane + 64 * q; const int e = EX[idx];
            const float w = GW[idx] * gelu_erf((float)P[idx] * (sh * SU[e])) * SV[e];
            float m = __builtin_fabsf(w);
            m = fmaxf(m, __builtin_bit_cast(float, __builtin_amdgcn_update_dpp(0, __builtin_bit_cast(int, m), 0xB1, 0xF, 0xF, true)));
            m = fmaxf(m, __builtin_bit_cast(float, __builtin_amdgcn_update_dpp(0, __builtin_bit_cast(int, m), 0x4E, 0xF, 0xF, true)));
            m = fmaxf(m, __builtin_bit_cast(float, __builtin_amdgcn_update_dpp(0, __builtin_bit_cast(int, m), 0x141, 0xF, 0xF, true)));
            m = fmaxf(m, __builtin_bit_cast(float, __builtin_amdgcn_update_dpp(0, __builtin_bit_cast(int, m), 0x140, 0xF, 0xF, true)));
            const float inv = m > 0.f ? 127.f / m : 0.f;
            WQ[idx] = (signed char)(int)__builtin_rintf(w * inv);
            if ((lane & 15) == 0) WSC[(size_t)t * 8 + (lane >> 4) + 4 * q] = m * (1.f / 127.f); }
    }
}
__device__ __forceinline__ void tr4x4(unsigned r0, unsigned r1, unsigned r2, unsigned r3, unsigned (&t)[4]) {
    const unsigned x0 = __builtin_amdgcn_perm(r1, r0, 0x05010400u), x1 = __builtin_amdgcn_perm(r1, r0, 0x07030602u), y0 = __builtin_amdgcn_perm(r3, r2, 0x05010400u), y1 = __builtin_amdgcn_perm(r3, r2, 0x07030602u);
    t[0] = __builtin_amdgcn_perm(y0, x0, 0x05040100u); t[1] = __builtin_amdgcn_perm(y0, x0, 0x07060302u); t[2] = __builtin_amdgcn_perm(y1, x1, 0x05040100u); t[3] = __builtin_amdgcn_perm(y1, x1, 0x07060302u);
}
struct Peer2P { const GAS int* EX; const GAS signed char* WQ; const GAS float* WSC; const GAS unsigned char* V8; GAS bf16* XB; GAS float* SSQ; };
__device__ __forceinline__ void peer_k2(const Peer2P& Q, const PeerS& sc, int wave, int lane) {
    asm volatile("" : "+v"(lane));
    const int g = lane >> 3, j = lane & 7, hf = lane >> 5, rp = (lane >> 4) & 1;
    for (int s = sc.first_slice; s < 8; s += sc.nslices_step)
        for (int tile = sc.rank; tile < T / 64; tile += sc.nloc) {
            const size_t t0 = (size_t)tile * 64 + wave * 8;
            v4u exn[4], wqn; float swn;
#pragma unroll
            for (int i = 0; i < 4; ++i) exn[i] = *(const GAS v4u*)(Q.EX + t0 * 128 + 16 * g + 4 * i);
            wqn = *(const GAS v4u*)(Q.WQ + t0 * 128 + 16 * g); swn = Q.WSC[t0 * 8 + g];
#pragma unroll 1
            for (int k = 0; k < 8; ++k) {
                const size_t t = t0 + k;
                v4u ex[4]; const v4u wq = wqn; const float sw = swn;
#pragma unroll
                for (int i = 0; i < 4; ++i) ex[i] = exn[i];
                if (k + 1 < 8) {
#pragma unroll
                    for (int i = 0; i < 4; ++i) exn[i] = *(const GAS v4u*)(Q.EX + (t + 1) * 128 + 16 * g + 4 * i);
                    wqn = *(const GAS v4u*)(Q.WQ + (t + 1) * 128 + 16 * g); swn = Q.WSC[(t + 1) * 8 + g];
                }
                GAS v2u* xp = (GAS v2u*)(Q.XB + t * 1024 + 128 * s + 16 * j + 8 * hf + 4 * rp);
                const v2u xold = *xp;
                v4u vv[16];
#pragma unroll
                for (int i = 0; i < 16; ++i) { const unsigned e = (i & 3) == 0 ? ex[i >> 2].x : (i & 3) == 1 ? ex[i >> 2].y : (i & 3) == 2 ? ex[i >> 2].z : ex[i >> 2].w;
                    vv[i] = *(const GAS v4u*)(Q.V8 + (size_t)e * 1024 + 128 * s + 16 * j); }
                int ai[16];
#pragma unroll
                for (int i = 0; i < 16; ++i) ai[i] = 0;
#pragma unroll
                for (int q4_ = 0; q4_ < 4; ++q4_) {
                    const unsigned wq4 = q4_ == 0 ? wq.x : q4_ == 1 ? wq.y : q4_ == 2 ? wq.z : wq.w;
#pragma unroll
                    for (int c = 0; c < 4; ++c) { unsigned tt[4];
                        const v4u &a0 = vv[4 * q4_], &a1 = vv[4 * q4_ + 1], &a2 = vv[4 * q4_ + 2], &a3 = vv[4 * q4_ + 3];
                        tr4x4(c == 0 ? a0.x : c == 1 ? a0.y : c == 2 ? a0.z : a0.w, c == 0 ? a1.x : c == 1 ? a1.y : c == 2 ? a1.z : a1.w, c == 0 ? a2.x : c == 1 ? a2.y : c == 2 ? a2.z : a2.w, c == 0 ? a3.x : c == 1 ? a3.y : c == 2 ? a3.z : a3.w, tt);
#pragma unroll
                        for (int b = 0; b < 4; ++b) ai[4 * c + b] = __builtin_amdgcn_sdot4((int)tt[b], (int)wq4, ai[4 * c + b], false); }
                }
                float acc[16];
#pragma unroll
                for (int i = 0; i < 16; ++i) acc[i] = (float)ai[i] * sw;
                float r8[8], r4[4];
#pragma unroll
                for (int m = 0; m < 8; ++m) { float a = acc[m], b = acc[m + 8]; swap32(a, b); r8[m] = a + b; }
#pragma unroll
                for (int n = 0; n < 4; ++n) { float a = r8[n], b = r8[n + 4]; asm volatile("v_nop\n\tv_nop\n\tv_permlane16_swap_b32 %0, %1" : "+v"(a), "+v"(b)); r4[n] = a + b; }
#pragma unroll
                for (int n = 0; n < 4; ++n) r4[n] += __builtin_bit_cast(float, __builtin_amdgcn_update_dpp(0, __builtin_bit_cast(int, r4[n]), 0x128, 0xF, 0xF, true));
                v2u xw; xw.x = pk2(bflo(xold.x) + r4[0], bfhi(xold.x) + r4[1]); xw.y = pk2(bflo(xold.y) + r4[2], bfhi(xold.y) + r4[3]);
                float ss = 0.f;
                if ((lane & 8) == 0) { const float x0 = bflo(xw.x), x1 = bfhi(xw.x), x2 = bflo(xw.y), x3 = bfhi(xw.y); ss = (x0 * x0 + x1 * x1) + (x2 * x2 + x3 * x3); *xp = xw; }
                ss = wave_allsum(ss);
                if (Q.SSQ) { if (lane == 0) Q.SSQ[t * 16 + s] = ss; }
            }
        }
}

struct Args { const float* in[33]; float* out; unsigned char* ws; int ph_lo, ph_hi; };
struct Frame { LAS unsigned char* lds; volatile LAS unsigned* MISC; gu32* ctl; int tid, lane, wave, G, vcu, xcc, xrank; };

__device__ __forceinline__ void transpose_item(const float* W, int ldw, int nsrc0, bf16* WT, int ldt, int rdst0, LAS float* scr, int kb, int nb, int lane, float scale, const float* kgain) {
    const int k0 = 64 * kb, n0 = 32 * nb;
#pragma unroll 8
    for (int i = 0; i < 32; ++i) { const int kk = 2 * i + (lane >> 5); const float gsc = kgain ? kgain[k0 + kk] * scale : scale; scr[kk * 33 + (lane & 31)] = W[(size_t)(k0 + kk) * ldw + nsrc0 + n0 + (lane & 31)] * gsc; }
    LDS_WAIT(); asm volatile("" ::: "memory");
    const int c = lane & 7;
#pragma unroll
    for (int j = 0; j < 4; ++j) { const int n = (lane >> 3) + 8 * j; const LAS float* s = scr + (8 * c) * 33 + n;
        v4u o; o.x = pk2(s[0 * 33], s[1 * 33]); o.y = pk2(s[2 * 33], s[3 * 33]); o.z = pk2(s[4 * 33], s[5 * 33]); o.w = pk2(s[6 * 33], s[7 * 33]);
        *(GAS v4u*)(WT + (size_t)(rdst0 + n0 + n) * ldt + k0 + 8 * c) = o; }
    LDS_WAIT(); asm volatile("" ::: "memory");
}
__device__ __forceinline__ void zero_rect(bf16* base, int ld, int row0, int nrows, int col0, int ncols, int gtid, int gthreads) {
    const int vpr = ncols / 8;
    for (int i = gtid; i < nrows * vpr; i += gthreads) { const int r = i / vpr, c = i % vpr; *(GAS v4u*)(base + (size_t)(row0 + r) * ld + col0 + 8 * c) = (v4u){0u, 0u, 0u, 0u}; }
}

__device__ __forceinline__ void p0_prologue(Frame& F, const Args& a) {
    LAS float* scr = (LAS float*)(F.lds + RING_OFF + F.wave * 16384);
    const int gw = blockIdx.x * NWAVES + F.wave, NGW = F.G * NWAVES;
    const int gtid = blockIdx.x * (NWAVES * 64) + F.tid, gthreads = F.G * NWAVES * 64;
    unsigned char* ws = a.ws;
    x0_phase((const GAS float*)a.in[0], (GAS bf16*)(ws + WS_XNB), (GAS float*)(ws + WS_SSQ), gw, NGW, F.lane);
    constexpr int I_IN = 16 * (INW / 32), I_SQ = 16 * 32, I_CKV = 16 * 64, I_UQ = 3 * 12, I_UKV = 2 * 16, I_L = I_IN + 4 * I_SQ + I_CKV + I_UQ + I_UKV;
    for (int it = gw; it < L * I_L; it += NGW) {
        const int l = it / I_L; int r = it % I_L;
        if (r < I_IN) {
            const int kb = r / 67, nb = r % 67; int src, dst; float sc = 1.f;
            if (nb < 6) { src = 32 * nb; dst = src; } else if (nb < 11) { src = 32 * nb; dst = src + 64; } else { src = 32 * nb; dst = src + 160; if (nb >= 43 && nb < 51) sc = 0.17677669529663687f * LOG2E; }
            transpose_item(a.in[5] + (size_t)l * D * INW, INW, src, (bf16*)(ws + WS_WIN) + (size_t)l * INP * D, D, dst, scr, kb, 0, F.lane, sc, a.in[4] + l * D); continue; } r -= I_IN;
        if (r < I_SQ) { transpose_item(a.in[21] + (size_t)l * D * D, D, 0, (bf16*)(ws + WS_WOUT) + (size_t)l * D * D, D, 0, scr, r / 32, r % 32, F.lane, 1.f, nullptr); continue; } r -= I_SQ;
        if (r < I_SQ) { transpose_item(a.in[24] + (size_t)l * D * D, D, 0, (bf16*)(ws + WS_WCQ) + (size_t)l * D * D, D, 0, scr, r / 32, r % 32, F.lane, 0.0625f * LOG2E, a.in[22] + l * D); continue; } r -= I_SQ;
        if (r < I_SQ) { transpose_item(a.in[26] + (size_t)l * D * D, D, 0, (bf16*)(ws + WS_WCO) + (size_t)l * D * D, D, 0, scr, r / 32, r % 32, F.lane, 1.f, nullptr); continue; } r -= I_SQ;
        if (r < I_SQ) { transpose_item(a.in[28] + (size_t)l * D * D, D, 0, (bf16*)(ws + WS_WPQ) + (size_t)l * D * D, D, 0, scr, r / 32, r % 32, F.lane, 1.f, a.in[27] + l * D); continue; } r -= I_SQ;
        if (r < I_CKV) { transpose_item(a.in[25] + (size_t)l * D * 2 * D, 2 * D, 0, (bf16*)(ws + WS_WCKV) + (size_t)l * 2 * D * D, D, 0, scr, r / 64, r % 64, F.lane, 1.f, nullptr); continue; } r -= I_CKV;
        if (r < I_UQ) { transpose_item(a.in[7] + (size_t)l * 192 * 384, 384, 0, (bf16*)(ws + WS_WUQ) + (size_t)l * 512 * 256, 256, 0, scr, r / 12, r % 12, F.lane, 0.10206207261596575f * LOG2E, a.in[6] + l * 192); continue; } r -= I_UQ;
        transpose_item(a.in[9] + (size_t)l * 128 * 512, 512, 0, (bf16*)(ws + WS_WUKV) + (size_t)l * 512 * 256, 256, 0, scr, r / 16, r % 16, F.lane, 1.f, a.in[8] + l * 128);
    }
    for (int l = 0; l < L; ++l) {
        bf16* win = (bf16*)(ws + WS_WIN) + (size_t)l * INP * D; bf16* wuq = (bf16*)(ws + WS_WUQ) + (size_t)l * 512 * 256; bf16* wukv = (bf16*)(ws + WS_WUKV) + (size_t)l * 512 * 256;
        zero_rect(win, D, 192, 64, 0, D, gtid, gthreads); zero_rect(win, D, 416, 96, 0, D, gtid, gthreads);
        zero_rect(wuq, 256, 0, 384, 192, 64, gtid, gthreads); zero_rect(wuq, 256, 384, 128, 0, 256, gtid, gthreads);
        zero_rect(wukv, 256, 0, 512, 128, 128, gtid, gthreads);
    }
    { float* rope = (float*)(ws + WS_ROPE); const int* pos = (const int*)a.in[2];
      for (int i = gtid; i < T * 16; i += gthreads) { const int t = i >> 4, k = i & 15; const float inv = powf(10000.f, -(float)(2 * k) / 32.f); const float ang = (float)pos[t] * inv;
          rope[(size_t)t * 32 + k] = cosf(ang); rope[(size_t)t * 32 + 16 + k] = sinf(ang); } }
    { const GAS f32x4* ks = (const GAS f32x4*)a.in[29]; GAS v2u* kd = (GAS v2u*)(ws + WS_KEYS);
      for (int i = gtid; i < L * 2 * 128 * 64 / 4; i += gthreads) { const f32x4 v = ks[i]; v2u w; w.x = pk2(v.x, v.y); w.y = pk2(v.z, v.w); kd[i] = w; }
    }
    for (int r = gw; r < 2 * L * 16384; r += NGW) { const int tb = r / (L * 16384), rr = r % (L * 16384);
        quant_row((const GAS float*)a.in[30 + tb] + (size_t)rr * 1024, (GAS unsigned*)(ws + (tb ? WS_V8 : WS_U8) + (size_t)rr * 1024), (GAS float*)(ws + (tb ? WS_SV : WS_SU)) + rr, 0, F.lane); }
    { float* btab = (float*)(ws + WS_BTAB); float* lams = (float*)(ws + WS_LAMS); float* spt = (float*)(ws + WS_SP);
      for (int i = gtid; i < 4 * 129; i += gthreads) { const int h = i / 129, n = i % 129; int bu; if (n < 16) bu = n; else { const int lg = 16 + (int)(logf((float)n / 16.f) / logf(8.f) * 16.f); bu = lg < 31 ? lg : 31; }
          btab[i] = a.in[3][bu * 4 + h] * LOG2E; }
      for (int i = gtid; i < L; i += gthreads) { const float* dl = a.in[17] + i * 128; float s1 = 0.f, s2 = 0.f; for (int j = 0; j < 32; ++j) { s1 += dl[j] * dl[32 + j]; s2 += dl[64 + j] * dl[96 + j]; }
          const float li = 0.8f - 0.6f * expf(-0.3f * (float)i); lams[2 * i] = expf(s1) - expf(s2) + li; lams[2 * i + 1] = li; }
      for (int i = gtid; i < L * 512; i += gthreads) spt[i] = log1pf(expf(-a.in[16][i])); }
    { GAS bf16* wat = (GAS bf16*)(ws + WS_WAT);
      for (int i = gtid; i < L * 8 * 2 * 4096; i += gthreads) { const int in_ = i & 63, out_ = (i >> 6) & 63, gate = (i >> 12) & 1, lg = i >> 13;
          wat[i] = (bf16)f2bf_(a.in[gate ? 14 : 12][(size_t)lg * 4096 + in_ * 64 + out_]); } }
    for (int l = 0; l < L; ++l) norm_phase((const GAS float*)a.in[1], (const GAS float*)a.in[23] + l * D, (GAS bf16*)(ws + WS_MNB) + (size_t)l * NB * MEM * D, NB * MEM, gw, NGW, F.lane);
}

constexpr int NPL = 16, PH_FINAL = 2 + NPL * L;
__global__ void __launch_bounds__(NWAVES * 64, 2) fwd(Args args) {
    extern __shared__ __attribute__((aligned(16))) unsigned char lds[];
    Frame F;
    F.lds = (LAS unsigned char*)lds; F.MISC = (volatile LAS unsigned*)(F.lds + MISC_OFF);
    F.tid = threadIdx.x; F.lane = F.tid & 63; F.wave = __builtin_amdgcn_readfirstlane(F.tid >> 6); F.G = gridDim.x;
    F.vcu = (F.G % 8 == 0) ? ((int)blockIdx.x % 8) * (F.G / 8) + (int)blockIdx.x / 8 : (int)blockIdx.x;
    unsigned char* ws = args.ws;
    F.ctl = (gu32*)(opq(ws) + WS_CTL);
    for (int u = F.tid; u < (LDS_BYTES - LDSCTL_OFF) / 4; u += NWAVES * 64) ((LAS unsigned*)(F.lds + LDSCTL_OFF))[u] = 0u;
    __syncthreads();
    XcdBarrier bar = xcd_barrier_post((unsigned*)(F.ctl + CW_BAR), F.MISC + 8);
    F.xcc = (int)bar.x;
    if (F.tid == 0) F.MISC[12] = __hip_atomic_fetch_add((unsigned*)(F.ctl + CW_RANK) + 64 * bar.x, 1u, __ATOMIC_RELAXED, __HIP_MEMORY_SCOPE_AGENT);
    __syncthreads();
    F.xrank = __builtin_amdgcn_readfirstlane((int)F.MISC[12]);
    const int lo = args.ph_lo, hi = args.ph_hi;
    const int gw = blockIdx.x * NWAVES + F.wave, NGW = F.G * NWAVES;
#define IN(k) (lo <= (k) && (k) < hi)
#define LANE_ (lane_id_v())
#define TID_ ((opqi(F.wave) << 6) | LANE_)
#define SITE() const int G_ = opqi(F.G), wv_ = opqi(F.wave), vcu_ = opqi(F.vcu), gw_ = opqi(gw), NGW_ = opqi(NGW); (void)G_; (void)wv_; (void)vcu_; (void)gw_; (void)NGW_
#if MK_DUP == 99
#define SEAM(k) do { if (IN(k) && IN((k) + 1)) { xcd_barrier(bar, (F.wave == 0 && lane_id_v() == 0) ? 1 : 0); xcd_barrier(bar, (F.wave == 0 && lane_id_v() == 0) ? 1 : 0); } } while (0)
#else
#define SEAM(k) do { if (IN(k) && IN((k) + 1)) xcd_barrier(bar, (F.wave == 0 && lane_id_v() == 0) ? 1 : 0); } while (0)
#endif
#define GEMM_SITE(EPI, Aptr, lda_, Bptr, ldb_, M_, N_, K_, cperm, ...) do { \
        pg8::Gemm g{opq(Aptr), opq(Bptr), M_, N_, K_, lda_, ldb_}; pg8::StaticOrder So; So.init(M_, N_, opqi(F.G), opqi(cperm)); pg8::EPI E{__VA_ARGS__}; \
        pg8::gemm_phase<pg8::EPI, pg8::StaticOrder, true, true>(F.lds + RING_OFF, g, So, E, opqi(F.wave)); } while (0)
    if (IN(0)) { p0_prologue(F, args); }
    SEAM(0);
    if (IN(1)) {
#pragma unroll 1
        for (int l = 0; l < L; ++l)
            GEMM_SITE(EpiBf16, (const GAS bf16*)(opq(ws) + WS_MNB) + (size_t)l * NB * MEM * D, D, (const GAS bf16*)(opq(ws) + WS_WCKV) + (size_t)l * 2 * D * D, D, NB * MEM, 2 * D, D, (int)((blockIdx.x + 64 * l) % F.G),
                      opq((GAS bf16*)(opq(ws) + WS_KVCB) + (size_t)l * NB * MEM * 2 * D), 2 * D, 2 * D, (const GAS float*)nullptr, 0);
    }
    SEAM(1);
    for (int l = 0; l < L; ++l) {
        const int pb = 2 + NPL * l;
        const GAS bf16* XNB = (const GAS bf16*)(opq(ws) + WS_XNB); const GAS bf16* YB = (const GAS bf16*)(opq(ws) + WS_YB); GAS bf16* PROJB = (GAS bf16*)(opq(ws) + WS_PROJB);
        if (IN(pb + 1)) GEMM_SITE(EpiBf16, XNB, D, (const GAS bf16*)(opq(ws) + WS_WIN) + (size_t)l * INP * D, D, T, INP, D, (int)blockIdx.x, opq(PROJB), INP, INP, opq((const GAS float*)(opq(ws) + WS_SSQ)), 8);
#if MK_DUP == 1
        if (IN(pb + 1)) GEMM_SITE(EpiBf16, XNB, D, (const GAS bf16*)(opq(ws) + WS_WIN) + (size_t)l * INP * D, D, T, INP, D, (int)blockIdx.x, opq(PROJB), INP, INP, opq((const GAS float*)(opq(ws) + WS_SSQ)), 8);
#endif
        SEAM(pb + 1);
        if (IN(pb + 2)) {
            SITE();
            pre_phase(opq((const GAS bf16*)PROJB), opq((const GAS float*)(opq(ws) + WS_ROPE)), opq((GAS float*)(opq(ws) + WS_RS)), opq((GAS bf16*)(opq(ws) + WS_KMB)), gw_, NGW_, LANE_);
#if MK_DUP == 21
            pre_phase(opq((const GAS bf16*)PROJB), opq((const GAS float*)(opq(ws) + WS_ROPE)), opq((GAS float*)(opq(ws) + WS_RS)), opq((GAS bf16*)(opq(ws) + WS_KMB)), gw_, NGW_, LANE_);
#endif
            LruP LP{opq((const GAS bf16*)PROJB), (const GAS float*)args.in[opqi(10)] + l * 4 * 512, (const GAS float*)args.in[opqi(11)] + l * 512, opq((const GAS bf16*)(opq(ws) + WS_WAT)) + (size_t)l * 8 * 2 * 4096, (const GAS float*)args.in[opqi(13)] + l * 512, (const GAS float*)args.in[opqi(15)] + l * 512,
                    (const GAS float*)(opq(ws) + WS_SP) + l * 512, opq((GAS unsigned*)(opq(ws) + WS_HLB)), opq((GAS float*)(opq(ws) + WS_LSUM))};
            lru_phase(LP, F.lds, TID_, wv_, LANE_, vcu_, G_);
#if MK_DUP == 2
            lru_phase(LP, F.lds, TID_, wv_, LANE_, vcu_, G_);
#endif
        }
        SEAM(pb + 2);
        if (IN(pb + 3)) {
            GEMM_SITE(EpiUp, (const GAS bf16*)PROJB + PC_CQ, INP, (const GAS bf16*)(opq(ws) + WS_WUQ) + (size_t)l * 512 * 256, 256, T, 512, 256, (int)blockIdx.x,
                      opq((GAS bf16*)(opq(ws) + WS_QMB)), (GAS bf16*)nullptr, 384, 384, opq((const GAS float*)(opq(ws) + WS_RS)), 0, 0);
            GEMM_SITE(EpiUp, (const GAS bf16*)PROJB + PC_CKV, INP, (const GAS bf16*)(opq(ws) + WS_WUKV) + (size_t)l * 512 * 256, 256, T, 512, 256, (int)blockIdx.x,
                      opq((GAS bf16*)(opq(ws) + WS_KMB)), opq((GAS bf16*)(opq(ws) + WS_VMB)), 0, 512, opq((const GAS float*)(opq(ws) + WS_RS)), 1, 1);
        }
        SEAM(pb + 3);
        if (IN(pb + 4)) {
            SITE();
            AttnP PM{opq((const GAS bf16*)(opq(ws) + WS_QMB)), opq((const GAS bf16*)(opq(ws) + WS_KMB)), opq((const GAS bf16*)(opq(ws) + WS_VMB)), 384, 384, 256, opq((GAS bf16*)(opq(ws) + WS_OMB)), 256, opq((const GAS float*)(opq(ws) + WS_ROPE)), nullptr, nullptr, nullptr, nullptr};
            AttnP PD{opq((const GAS bf16*)PROJB + PC_QD), opq((const GAS bf16*)PROJB + PC_KD), opq((const GAS bf16*)PROJB + PC_VD), INP, INP, INP, opq((GAS bf16*)(opq(ws) + WS_YB) + 768), 1024, nullptr,
                     (const GAS int*)args.in[opqi(2)], (const GAS float*)(opq(ws) + WS_BTAB), (const GAS float*)args.in[opqi(18)] + l * 64, (const GAS float*)(opq(ws) + WS_LAMS) + 2 * l};
            attn_phase(PM, PD, F.lds, TID_, wv_, LANE_, vcu_, G_);
#if MK_DUP == 4
            __syncthreads(); attn_phase(PM, PD, F.lds, TID_, wv_, LANE_, vcu_, G_);
#elif MK_DUP == 40 || MK_DUP == 41
            __syncthreads(); attn_phase(PM, PD, F.lds, TID_, wv_, LANE_, vcu_, G_, MK_DUP - 40);
#endif
        }
        SEAM(pb + 4);
        if (IN(pb + 5)) {
            SITE();
            PostP PP{opq((const GAS bf16*)(opq(ws) + WS_OMB)), opq((const GAS unsigned*)(opq(ws) + WS_HLB)), opq((const GAS float*)(opq(ws) + WS_LSUM)), opq((const GAS bf16*)PROJB), (const GAS float*)args.in[opqi(19)] + l * 256, (const GAS float*)args.in[opqi(20)] + l * 512, opq((GAS bf16*)(opq(ws) + WS_YB))};
            post_phase(PP, F.lds, TID_, wv_, LANE_, vcu_, G_);
#if MK_DUP == 5
            __syncthreads(); post_phase(PP, F.lds, TID_, wv_, LANE_, vcu_, G_);
#endif
        }
        SEAM(pb + 5);
        if (IN(pb + 6)) GEMM_SITE(EpiRes, YB, D, (const GAS bf16*)(opq(ws) + WS_WOUT) + (size_t)l * D * D, D, T, D, D, (int)blockIdx.x, opq((GAS bf16*)(opq(ws) + WS_XNB)), opq((GAS float*)(opq(ws) + WS_SSQ)));
#if MK_DUP == 6
        if (IN(pb + 6)) GEMM_SITE(EpiRes, YB, D, (const GAS bf16*)(opq(ws) + WS_WOUT) + (size_t)l * D * D, D, T, D, D, (int)blockIdx.x, opq((GAS bf16*)(opq(ws) + WS_HLB)), opq((GAS float*)(opq(ws) + WS_OMB)));
#endif
        SEAM(pb + 6);
        if (IN(pb + 8)) GEMM_SITE(EpiBf16, XNB, D, (const GAS bf16*)(opq(ws) + WS_WCQ) + (size_t)l * D * D, D, T, D, D, (int)blockIdx.x, opq(PROJB), D, D, opq((const GAS float*)(opq(ws) + WS_SSQ)), 16);
#if MK_DUP == 8
        if (IN(pb + 8)) GEMM_SITE(EpiBf16, XNB, D, (const GAS bf16*)(opq(ws) + WS_WCQ) + (size_t)l * D * D, D, T, D, D, (int)blockIdx.x, opq(PROJB), D, D, opq((const GAS float*)(opq(ws) + WS_SSQ)), 16);
#endif
        SEAM(pb + 8);
        if (IN(pb + 9)) {
            SITE();
            const GAS bf16* kv = (const GAS bf16*)(opq(ws) + WS_KVCB) + (size_t)l * NB * MEM * 2 * D;
            AttnP PC{opq((const GAS bf16*)PROJB), opq(kv), opq(kv + D), 1024, 2 * D, 2 * D, opq((GAS bf16*)(opq(ws) + WS_YB)), 1024, nullptr, nullptr, nullptr, nullptr, nullptr};
            cross_phase(PC, F.lds, TID_, wv_, LANE_, vcu_, G_);
#if MK_DUP == 9
            cross_phase(PC, F.lds, TID_, wv_, LANE_, vcu_, G_);
#endif
        }
        SEAM(pb + 9);
        if (IN(pb + 10)) GEMM_SITE(EpiRes, YB, D, (const GAS bf16*)(opq(ws) + WS_WCO) + (size_t)l * D * D, D, T, D, D, (int)blockIdx.x, opq((GAS bf16*)(opq(ws) + WS_XNB)), opq((GAS float*)(opq(ws) + WS_SSQ)));
        SEAM(pb + 10);
        if (IN(pb + 12)) { GEMM_SITE(EpiBf16, XNB, D, (const GAS bf16*)(opq(ws) + WS_WPQ) + (size_t)l * D * D, D, T, D, D, (int)blockIdx.x, opq(PROJB), D, D, opq((const GAS float*)(opq(ws) + WS_SSQ)), 16);
            SITE(); hq_phase(opq(XNB), opq((const GAS float*)(opq(ws) + WS_SSQ)), (const GAS float*)args.in[opqi(27)] + l * D, opq((GAS unsigned char*)(opq(ws) + WS_HQ)), opq((GAS float*)(opq(ws) + WS_SH)), opq((GAS int*)(opq(ws) + WS_P)), gw_, NGW_, LANE_);
#if MK_DUP == 12
            hq_phase(opq(XNB), opq((const GAS float*)(opq(ws) + WS_SSQ)), (const GAS float*)args.in[opqi(27)] + l * D, opq((GAS unsigned char*)(opq(ws) + WS_HQ)), opq((GAS float*)(opq(ws) + WS_SH)), opq((GAS int*)(opq(ws) + WS_P)), gw_, NGW_, LANE_);
#endif
            }
        SEAM(pb + 12);
        if (IN(pb + 13)) {
            SITE();
            RouteP RP{opq((const GAS bf16*)PROJB), opq((const GAS bf16*)(opq(ws) + WS_KEYS) + (size_t)l * 2 * 128 * 64), opq((GAS int*)(opq(ws) + WS_EX)), opq((GAS float*)(opq(ws) + WS_GW))};
            route_phase(RP, F.lds, TID_, wv_, LANE_, vcu_, G_);
#if MK_DUP == 13
            route_phase(RP, F.lds, TID_, wv_, LANE_, vcu_, G_);
#endif
        }
        SEAM(pb + 13);
        if (IN(pb + 14)) {
            SITE();
            const PeerS ps = peer_sched((const GAS unsigned*)(F.ctl + CW_RANK), opqi(F.xcc), opqi(F.xrank));
            Peer1P Q1{opq((const GAS unsigned char*)(opq(ws) + WS_HQ)), opq((const GAS int*)(opq(ws) + WS_EX)), opq((const GAS unsigned char*)(opq(ws) + WS_U8) + (size_t)l * 16384 * 1024), opq((GAS int*)(opq(ws) + WS_P))};
            peer_k1(Q1, ps, wv_, LANE_);
#if MK_DUP == 141
            { Peer1P Q1b = Q1; Q1b.P = (GAS int*)(opq(ws) + WS_PROJB); peer_k1(Q1b, ps, wv_, LANE_); }
#endif
        }
        SEAM(pb + 14);
        if (IN(pb + 15)) {
            SITE();
            peer_w(opq((const GAS int*)(opq(ws) + WS_EX)), opq((const GAS float*)(opq(ws) + WS_GW)), opq((const GAS int*)(opq(ws) + WS_P)), opq((const GAS float*)(opq(ws) + WS_SH)), opq((const GAS float*)(opq(ws) + WS_SU) + l * 16384), opq((const GAS float*)(opq(ws) + WS_SV) + l * 16384),
                   opq((GAS signed char*)(opq(ws) + WS_W)), opq((GAS float*)(opq(ws) + WS_WS)), gw_, NGW_, LANE_);
            xcd_barrier(bar, (F.wave == 0 && lane_id_v() == 0) ? 1 : 0);
            const PeerS ps = peer_sched((const GAS unsigned*)(F.ctl + CW_RANK), opqi(F.xcc), opqi(F.xrank));
            Peer2P Q2{opq((const GAS int*)(opq(ws) + WS_EX)), opq((const GAS signed char*)(opq(ws) + WS_W)), opq((const GAS float*)(opq(ws) + WS_WS)), opq((const GAS unsigned char*)(opq(ws) + WS_V8) + (size_t)l * 16384 * 1024), opq((GAS bf16*)(opq(ws) + WS_XNB)), opq((GAS float*)(opq(ws) + WS_SSQ))};
            peer_k2(Q2, ps, wv_, LANE_);
#if MK_DUP == 151
            { Peer2P Q2b = Q2; Q2b.XB = (GAS bf16*)(opq(ws) + WS_HLB); Q2b.SSQ = (GAS float*)(opq(ws) + WS_OMB); peer_k2(Q2b, ps, wv_, LANE_); }
#endif
        }
        SEAM(pb + 15);
    }
    if (IN(PH_FINAL)) { SITE(); final_norm_phase(opq((const GAS bf16*)(opq(ws) + WS_XNB)), (GAS float*)args.out, (const GAS float*)args.in[opqi(32)], T, gw_, NGW_, LANE_); }
#undef IN
#undef SEAM
#undef GEMM_SITE
}
}
extern "C" void kernel_launch(void* const* d_in, const int* in_sizes, int n_in, void* d_out, int out_size, void* d_ws, size_t ws_size, hipStream_t stream) {
    (void)in_sizes; (void)out_size;
    static int grid = 0;
    if (grid == 0) {
        int dev = 0, cus = 0, per_cu = 0;
        if (n_in != 33 || ws_size < mk::WS_END) { fprintf(stderr, "kernel_launch: unexpected n_in %d / ws_size %zu\n", n_in, ws_size); grid = -1; return; }
        if (hipGetDevice(&dev) != hipSuccess || hipDeviceGetAttribute(&cus, hipDeviceAttributeMultiprocessorCount, dev) != hipSuccess) { grid = -1; return; }
        if (hipFuncSetAttribute((const void*)mk::fwd, hipFuncAttributeMaxDynamicSharedMemorySize, mk::LDS_BYTES) != hipSuccess) { fprintf(stderr, "kernel_launch: hipFuncSetAttribute failed\n"); grid = -1; return; }
        if (hipOccupancyMaxActiveBlocksPerMultiprocessor(&per_cu, (const void*)mk::fwd, mk::NWAVES * 64, mk::LDS_BYTES) != hipSuccess || per_cu < 1) fprintf(stderr, "kernel_launch: occupancy query says %d\n", per_cu);
        (void)hipGetLastError();
        grid = cus;
    }
    if (grid < 0) return;
    unsigned char* ws = (unsigned char*)d_ws;
    (void)hipMemsetAsync(ws + mk::WS_CTL, 0, mk::CTL_ZERO_BYTES, stream);
    mk::Args a{};
    for (int i = 0; i < 33; ++i) a.in[i] = (const float*)d_in[i];
    a.out = (float*)d_out; a.ws = ws;
    auto run = [&](int lo, int hi) { a.ph_lo = lo; a.ph_hi = hi; hipLaunchKernelGGL(mk::fwd, dim3(grid), dim3(mk::NWAVES * 64), mk::LDS_BYTES, stream, a); };
#if MK_ONE_LAUNCH
    run(0, mk::PH_FINAL + 1);
#else
    for (int p = 0; p <= mk::PH_FINAL; ++p) {
        const int k = (p - 2) % mk::NPL, l = (p - 2) / mk::NPL;
#if MK_NAIVE_PEER == 2
        if (p >= 2 && p < mk::PH_FINAL && k == 14) {
            hipLaunchKernelGGL(k_peer, dim3(T), dim3(256), 0, stream, (const bf16_t*)(ws + mk::WS_XNB), (const int*)(ws + mk::WS_EX), (const float*)(ws + mk::WS_GW), (const float*)d_in[30] + (size_t)l * NEXP * D, (const float*)d_in[31] + (size_t)l * NEXP * D, (float*)d_out);
            continue; }
#elif MK_NAIVE_PEER == 1
        if (p >= 2 && p < mk::PH_FINAL && k == 13) {
            float* TQ = (float*)(ws + (size_t)806 * mk::MiB);
            hipLaunchKernelGGL(k_bf2f, dim3((unsigned)(((size_t)T * D + 255) / 256)), dim3(256), 0, stream, (const bf16_t*)(ws + mk::WS_PROJB), TQ, (long)T * D);
            hipLaunchKernelGGL(k_route, dim3(T), dim3(256), 0, stream, TQ, (const float*)d_in[29] + (size_t)l * 2 * 128 * 64, (int*)(ws + mk::WS_EX), (float*)(ws + mk::WS_GW));
            hipLaunchKernelGGL(k_peer, dim3(T), dim3(256), 0, stream, (const bf16_t*)(ws + mk::WS_XNB), (const int*)(ws + mk::WS_EX), (const float*)(ws + mk::WS_GW), (const float*)d_in[30] + (size_t)l * NEXP * D, (const float*)d_in[31] + (size_t)l * NEXP * D, (float*)d_out);
            continue; }
        if (p >= 2 && p < mk::PH_FINAL && k == 14) continue;
#endif
        run(p, p + 1); }
#endif
}
```

```cpp
#include <hip/hip_runtime.h>
#include <cstdint>
#include <cstdio>
#include <cmath>

#ifndef MK_ONE_LAUNCH
#define MK_ONE_LAUNCH 1
#endif
#ifndef MK_DUP
#define MK_DUP 0
#endif
#ifndef MK_NAIVE_PEER
#define MK_NAIVE_PEER 0
#endif
namespace pg8 {
#define PG8_LAS __attribute__((address_space(3)))
#ifndef GAS
#define GAS __attribute__((address_space(1)))
#endif
typedef unsigned short bf16_t;
typedef short bf16x8 __attribute__((ext_vector_type(8)));
typedef float f32x4 __attribute__((ext_vector_type(4)));
typedef unsigned u32x4 __attribute__((ext_vector_type(4)));
typedef unsigned u32x2 __attribute__((ext_vector_type(2)));
constexpr int BM = 256, BK = 64, HALF = 128, HTB = HALF * BK * 2, STAGE_BYTES = 8 * HTB, NXCD = 8, WGM = 8;
__host__ __device__ __forceinline__ int lds_byte(int r, int c) { const int st = (r >> 4) * 2 + (c >> 5), rr = r & 15, cc = c & 31, ob = rr * 64 + cc * 2; return st * 1024 + (ob ^ (((ob >> 9) & 1) << 5)); }
__host__ __device__ __forceinline__ void stage_rc(int b, int& R, int& C) { const int st = b / 1024, sb = b % 1024, swz = sb ^ (((sb >> 9) & 1) << 5); R = (st >> 1) * 16 + swz / 64; C = (st & 1) * 32 + (swz % 64) / 2; }
__host__ __device__ __forceinline__ int perm32(int rho) { const int n = rho >> 4, i = rho & 15; return 8 * (i >> 2) + 4 * n + (i & 3); }
__device__ __forceinline__ int pg8_lane_id() { int l; asm volatile("v_mbcnt_lo_u32_b32 %0, -1, 0\n\tv_mbcnt_hi_u32_b32 %0, -1, %0" : "=v"(l)); return l; }
struct Unit { int pm, pn; };
struct Gemm { const GAS bf16_t* A; const GAS bf16_t* Bt; int M, N, K, lda, ldb; };
struct StaticOrder {
    int nM, nN, nwg, G, c;
    __host__ __device__ void init(int M, int N, int G_, int c_) { nM = M / BM; nN = N / BM; nwg = nM * nN; G = G_; c = c_; }
    __host__ __device__ bool next(int i, Unit& u) const {
        const long L = (long)i * G + c; if (L >= nwg) return false;
        int wgid = (int)L; { const int q = nwg / NXCD, r = nwg % NXCD, xcd = wgid % NXCD, off = wgid / NXCD; wgid = (xcd < r ? xcd * (q + 1) : r * (q + 1) + (xcd - r) * q) + off; }
        const int nig = WGM * nN, gid = wgid / nig, fm = gid * WGM, gsz = (nM - fm) < WGM ? (nM - fm) : WGM;
        u.pm = fm + ((wgid % nig) % gsz); u.pn = (wgid % nig) / gsz; return true;
    }
    __device__ __forceinline__ void a_ready(const Unit&) const {}
    __device__ __forceinline__ void done(const Unit&) const {}
};
__device__ __forceinline__ unsigned cvt_pk_bf16(float lo, float hi) { unsigned r; asm volatile("v_cvt_pk_bf16_f32 %0, %1, %2" : "=v"(r) : "v"(lo), "v"(hi)); return r; }

struct EpiF32 {
    static constexpr bool PERM = false, AFTER_DRAIN = false;
    GAS float* C; int ldc; int nvalid; int accum;
    __device__ __forceinline__ void operator()(const f32x4 (&acc)[2][2][4][2], const Unit& u, int wr, int wc, int fr, int fq) const {
        { const int l_ = pg8_lane_id(); fr = l_ & 15; fq = l_ >> 4; }
#pragma unroll
        for (int ai = 0; ai < 2; ++ai)
#pragma unroll
            for (int m = 0; m < 4; ++m) { const size_t row = (size_t)u.pm * BM + ai * HALF + wr * 64 + m * 16 + fr;
#pragma unroll
                for (int bj = 0; bj < 2; ++bj)
#pragma unroll
                    for (int n = 0; n < 2; ++n) { const int col = u.pn * BM + bj * HALF + wc * 32 + n * 16 + 4 * fq;
                        if (col < nvalid) { GAS float* p = C + row * ldc + col; f32x4 v = acc[ai][bj][m][n]; if (accum) v += *(const GAS f32x4*)p; *(GAS f32x4*)p = v; } } }
    }
};
struct EpiBf16 {
    static constexpr bool PERM = true, AFTER_DRAIN = false;
    GAS bf16_t* O; int ldc; int nvalid; const GAS float* ssq; int np;
    __device__ __forceinline__ void operator()(const f32x4 (&acc)[2][2][4][2], const Unit& u, int wr, int wc, int fr, int fq) const {
        { const int l_ = pg8_lane_id(); fr = l_ & 15; fq = l_ >> 4; }
#pragma unroll
        for (int ai = 0; ai < 2; ++ai)
#pragma unroll
            for (int m = 0; m < 4; ++m) { const size_t row = (size_t)u.pm * BM + ai * HALF + wr * 64 + m * 16 + fr;
                float rs_ = 1.f;
                if (np > 0) { const GAS f32x4* sp = (const GAS f32x4*)(ssq + row * 16); f32x4 t = sp[0] + sp[1]; if (np > 8) t += sp[2] + sp[3]; rs_ = __builtin_amdgcn_rsqf(((t[0] + t[1]) + (t[2] + t[3])) * (1.f / 1024.f) + 1e-6f); }
#pragma unroll
                for (int bj = 0; bj < 2; ++bj) { const int col = u.pn * BM + bj * HALF + wc * 32 + 8 * fq;
                    if (col < nvalid) { const f32x4 v0 = acc[ai][bj][m][0] * rs_, v1 = acc[ai][bj][m][1] * rs_; u32x4 w; w.x = cvt_pk_bf16(v0[0], v0[1]); w.y = cvt_pk_bf16(v0[2], v0[3]); w.z = cvt_pk_bf16(v1[0], v1[1]); w.w = cvt_pk_bf16(v1[2], v1[3]);
                        *(GAS u32x4*)(O + row * ldc + col) = w; } } }
    }
};
struct EpiUp {
    static constexpr bool PERM = true, AFTER_DRAIN = false;
    GAS bf16_t* O; GAS bf16_t* O2; int ldc; int nvalid; const GAS float* rs; int rsi; int mode;
    __device__ __forceinline__ void operator()(const f32x4 (&acc)[2][2][4][2], const Unit& u, int wr, int wc, int fr, int fq) const {
        { const int l_ = pg8_lane_id(); fr = l_ & 15; fq = l_ >> 4; }
#pragma unroll
        for (int ai = 0; ai < 2; ++ai)
#pragma unroll
            for (int m = 0; m < 4; ++m) { const size_t row = (size_t)u.pm * BM + ai * HALF + wr * 64 + m * 16 + fr; const float s = rs[2 * row + rsi];
#pragma unroll
                for (int bj = 0; bj < 2; ++bj) { const int col = u.pn * BM + bj * HALF + wc * 32 + 8 * fq;
                    if (col < nvalid) { const f32x4 v0 = acc[ai][bj][m][0] * s, v1 = acc[ai][bj][m][1] * s; u32x4 w; w.x = cvt_pk_bf16(v0[0], v0[1]); w.y = cvt_pk_bf16(v0[2], v0[3]); w.z = cvt_pk_bf16(v1[0], v1[1]); w.w = cvt_pk_bf16(v1[2], v1[3]);
                        GAS bf16_t* dst;
                        if (mode == 0) dst = O + row * ldc + col;
                        else { const int h = col >> 7, j = col & 127; dst = (j < 64) ? O + row * 384 + h * 96 + j : O2 + row * 256 + h * 64 + (j - 64); }
                        *(GAS u32x4*)dst = w; } } }
    }
};

struct EpiRes {
    static constexpr bool PERM = true, AFTER_DRAIN = false;
    GAS bf16_t* XB; GAS float* SSQ;
    __device__ __forceinline__ void operator()(const f32x4 (&acc)[2][2][4][2], const Unit& u, int wr, int wc, int fr, int fq) const {
        { const int l_ = pg8_lane_id(); fr = l_ & 15; fq = l_ >> 4; }
#pragma unroll
        for (int ai = 0; ai < 2; ++ai)
#pragma unroll
            for (int m = 0; m < 4; ++m) { const size_t row = (size_t)u.pm * BM + ai * HALF + wr * 64 + m * 16 + fr; float ss = 0.f;
#pragma unroll
                for (int bj = 0; bj < 2; ++bj) { GAS u32x4* p = (GAS u32x4*)(XB + row * 1024 + u.pn * BM + bj * HALF + wc * 32 + 8 * fq);
                    const u32x4 o = *p; const f32x4 v0 = acc[ai][bj][m][0], v1 = acc[ai][bj][m][1];
                    u32x4 w;
                    w.x = cvt_pk_bf16(__builtin_bit_cast(float, o.x << 16) + v0[0], __builtin_bit_cast(float, o.x & 0xffff0000u) + v0[1]);
                    w.y = cvt_pk_bf16(__builtin_bit_cast(float, o.y << 16) + v0[2], __builtin_bit_cast(float, o.y & 0xffff0000u) + v0[3]);
                    w.z = cvt_pk_bf16(__builtin_bit_cast(float, o.z << 16) + v1[0], __builtin_bit_cast(float, o.z & 0xffff0000u) + v1[1]);
                    w.w = cvt_pk_bf16(__builtin_bit_cast(float, o.w << 16) + v1[2], __builtin_bit_cast(float, o.w & 0xffff0000u) + v1[3]);
                    *p = w;
#pragma unroll
                    for (int e = 0; e < 4; ++e) { const float a = __builtin_bit_cast(float, w[e] << 16), b = __builtin_bit_cast(float, w[e] & 0xffff0000u); ss += a * a + b * b; } }
                { float a = ss, b = ss; asm volatile("v_nop\n\tv_nop\n\tv_permlane16_swap_b32 %0, %1" : "+v"(a), "+v"(b)); ss = a + b; }
                { float a = ss, b = ss; asm volatile("v_nop\n\tv_nop\n\tv_permlane32_swap_b32 %0, %1" : "+v"(a), "+v"(b)); ss = a + b; }
                if (fq == 0) SSQ[row * 16 + 4 * u.pn + wc] = ss; }
    }
};
template <class Epi, class Sched, bool ALIGN_EPI = false, bool SP2 = false>
__device__ __forceinline__ void gemm_phase(PG8_LAS unsigned char* lds, const Gemm g, const Sched& S, const Epi& E, int wave_id) {
    int tid_ = (wave_id << 6) | pg8_lane_id(); asm volatile("" : "+v"(tid_));
    const int tid = tid_, wid = __builtin_amdgcn_readfirstlane(tid >> 6), lane = tid & 63, wr = wid >> 2, wc = wid & 3, fr = lane & 15, fq = lane >> 4;
    const int K = g.K, nt = K / BK;
    unsigned voffA[2], voffB[2];
#pragma unroll
    for (int i = 0; i < 2; ++i) { int R, C; stage_rc(tid * 16 + i * 8192, R, C); const int Rb = Epi::PERM ? ((R & ~31) + perm32(R & 31)) : R;
        voffA[i] = (unsigned)(R * g.lda + C) * 2u; voffB[i] = (unsigned)(Rb * g.ldb + C) * 2u; }
    const size_t kstep = (size_t)(BK * 2);
    const size_t hstepA = (size_t)HALF * g.lda * 2, hstepB = (size_t)HALF * g.ldb * 2;
    const size_t tstepA = 2 * hstepA, tstepB = 2 * hstepB;
    const unsigned ldsw = (unsigned)wid * 1024u;
    const int aoff = lds_byte(wr * 64 + fr, fq * 8), boff = lds_byte(wc * 32 + fr, fq * 8);
#define PG8_SA(b, h) (((b) * 2 + (h)) * HTB)
#define PG8_SB(b, h) ((4 + (b) * 2 + (h)) * HTB)
#define PG8_STAGE(bufoff, gbase, voff) do { _Pragma("unroll") for (int _i = 0; _i < 2; ++_i) \
        __builtin_amdgcn_global_load_lds((const unsigned*)((const char*)(gbase) + (voff)[_i]), (PG8_LAS unsigned*)(lds + (bufoff) + ldsw + _i * 8192), 16, 0, 0); } while (0)
#define PG8_LDA(dst, b, h) do { _Pragma("unroll") for (int m = 0; m < 4; ++m) _Pragma("unroll") for (int k = 0; k < 2; ++k) dst[m][k] = *(const PG8_LAS bf16x8*)(lds + PG8_SA(b, h) + aoff + m * 2048 + k * 1024); } while (0)
#define PG8_LDB(dst, b, h) do { _Pragma("unroll") for (int n = 0; n < 2; ++n) _Pragma("unroll") for (int k = 0; k < 2; ++k) dst[n][k] = *(const PG8_LAS bf16x8*)(lds + PG8_SB(b, h) + boff + n * 2048 + k * 1024); } while (0)
#define PG8_MMA(ai, bj, At, Bt) do { __builtin_amdgcn_s_setprio(1); _Pragma("unroll") for (int m = 0; m < 4; ++m) _Pragma("unroll") for (int n = 0; n < 2; ++n) _Pragma("unroll") for (int k = 0; k < 2; ++k) \
        acc[ai][bj][m][n] = __builtin_amdgcn_mfma_f32_16x16x32_bf16(Bt[n][k], At[m][k], acc[ai][bj][m][n], 0, 0, 0); __builtin_amdgcn_s_setprio(0); } while (0)
#define PG8_WAIT_V(n) asm volatile("s_waitcnt vmcnt(" #n ")" ::: "memory")
#define PG8_WAIT_L(n) asm volatile("s_waitcnt lgkmcnt(" #n ")" ::: "memory")
#define PG8_BAR __builtin_amdgcn_s_barrier()
#define PG8_SCHED __builtin_amdgcn_sched_barrier(0)
    Unit cur, nxt; int ui = 0;
    if (!S.next(0, cur)) return;
    f32x4 acc[2][2][4][2];
#pragma unroll
    for (int a = 0; a < 2; ++a)
#pragma unroll
        for (int b = 0; b < 2; ++b)
#pragma unroll
            for (int m = 0; m < 4; ++m)
#pragma unroll
                for (int n = 0; n < 2; ++n) acc[a][b][m][n] = (f32x4){0.f, 0.f, 0.f, 0.f};
    bf16x8 At[4][2], B0[2][2], B1[2][2];
    const char* cA = (const char*)g.A + (size_t)cur.pm * tstepA; const char* cB = (const char*)g.Bt + (size_t)cur.pn * tstepB;
    S.a_ready(cur);
    if constexpr (SP2) {
        PG8_STAGE(PG8_SB(0, 0), cB, voffB); PG8_STAGE(PG8_SB(0, 1), cB + hstepB, voffB); PG8_STAGE(PG8_SA(0, 0), cA, voffA); PG8_STAGE(PG8_SA(0, 1), cA + hstepA, voffA);
        if (wr == 1) PG8_BAR;
        PG8_WAIT_V(2); PG8_BAR;
        PG8_STAGE(PG8_SB(1, 0), cB + kstep, voffB); PG8_STAGE(PG8_SA(1, 0), cA + kstep, voffA); PG8_STAGE(PG8_SB(1, 1), cB + hstepB + kstep, voffB);
        PG8_WAIT_V(6); PG8_BAR;
    } else {
        PG8_STAGE(PG8_SB(0, 0), cB, voffB); PG8_STAGE(PG8_SA(0, 0), cA, voffA); PG8_STAGE(PG8_SB(0, 1), cB + hstepB, voffB); PG8_STAGE(PG8_SA(0, 1), cA + hstepA, voffA);
        if (wr == 1) PG8_BAR;
        PG8_WAIT_V(4); PG8_BAR;
        PG8_STAGE(PG8_SB(1, 0), cB + kstep, voffB); PG8_STAGE(PG8_SA(1, 0), cA + kstep, voffA); PG8_STAGE(PG8_SB(1, 1), cB + hstepB + kstep, voffB);
        PG8_WAIT_V(6); PG8_BAR;
    }
    for (;;) {
        const bool has_next = S.next(ui + 1, nxt);
        const char* nA = has_next ? (const char*)g.A + (size_t)nxt.pm * tstepA : cA; const char* nB = has_next ? (const char*)g.Bt + (size_t)nxt.pn * tstepB : cB;
        for (int t = 0; t < nt; t += 2) {
            const bool last = (t == nt - 2);
            const char* a1 = cA + (size_t)(t + 1) * kstep;
            const char* a2 = last ? nA : cA + (size_t)(t + 2) * kstep; const char* b2 = last ? nB : cB + (size_t)(t + 2) * kstep;
            const char* a3 = a2 + kstep; const char* b3 = b2 + kstep;
            if (last && has_next) S.a_ready(nxt);
            if constexpr (SP2) {
            PG8_LDB(B0, 0, 0); PG8_LDB(B1, 0, 1); PG8_SCHED; PG8_LDA(At, 0, 0); PG8_STAGE(PG8_SA(1, 1), a1 + hstepA, voffA);
            PG8_WAIT_V(8); PG8_WAIT_L(0); PG8_BAR; PG8_MMA(0, 0, At, B0); PG8_MMA(0, 1, At, B1); PG8_BAR; PG8_SCHED;
            PG8_LDA(At, 0, 1); PG8_STAGE(PG8_SB(0, 0), b2, voffB); PG8_STAGE(PG8_SB(0, 1), b2 + hstepB, voffB); PG8_STAGE(PG8_SA(0, 0), a2, voffA);
            PG8_WAIT_V(8); PG8_WAIT_L(0); PG8_BAR; PG8_MMA(1, 0, At, B0); PG8_MMA(1, 1, At, B1); PG8_BAR; PG8_SCHED;
            PG8_LDB(B0, 1, 0); PG8_LDB(B1, 1, 1); PG8_SCHED; PG8_LDA(At, 1, 0); PG8_STAGE(PG8_SA(0, 1), a2 + hstepA, voffA);
            PG8_WAIT_V(8); PG8_WAIT_L(0); PG8_BAR; PG8_MMA(0, 0, At, B0); PG8_MMA(0, 1, At, B1); PG8_BAR; PG8_SCHED;
            PG8_LDA(At, 1, 1); PG8_STAGE(PG8_SB(1, 0), b3, voffB); PG8_STAGE(PG8_SB(1, 1), b3 + hstepB, voffB); PG8_STAGE(PG8_SA(1, 0), a3, voffA);
            PG8_WAIT_V(8); PG8_WAIT_L(0); PG8_BAR; PG8_MMA(1, 0, At, B0); PG8_MMA(1, 1, At, B1); PG8_BAR; PG8_SCHED;
            } else {
            PG8_LDB(B0, 0, 0); PG8_SCHED; PG8_LDA(At, 0, 0); PG8_STAGE(PG8_SA(1, 1), a1 + hstepA, voffA);
            PG8_WAIT_L(8); PG8_BAR; PG8_WAIT_L(0); PG8_MMA(0, 0, At, B0); PG8_BAR; PG8_SCHED;
            PG8_LDB(B1, 0, 1); PG8_STAGE(PG8_SB(0, 0), b2, voffB);
            PG8_BAR; PG8_WAIT_L(0); PG8_MMA(0, 1, At, B1); PG8_BAR;
            PG8_LDA(At, 0, 1); PG8_STAGE(PG8_SA(0, 0), a2, voffA);
            PG8_BAR; PG8_WAIT_L(0); PG8_MMA(1, 0, At, B0); PG8_BAR; PG8_SCHED;
            PG8_STAGE(PG8_SB(0, 1), b2 + hstepB, voffB);
            PG8_WAIT_V(6); PG8_BAR; PG8_MMA(1, 1, At, B1); PG8_BAR;
            PG8_LDB(B0, 1, 0); PG8_SCHED; PG8_LDA(At, 1, 0); PG8_STAGE(PG8_SA(0, 1), a2 + hstepA, voffA);
            PG8_WAIT_L(8); PG8_BAR; PG8_WAIT_L(0); PG8_MMA(0, 0, At, B0); PG8_BAR; PG8_SCHED;
            PG8_LDB(B1, 1, 1); PG8_STAGE(PG8_SB(1, 0), b3, voffB);
            PG8_BAR; PG8_WAIT_L(0); PG8_MMA(0, 1, At, B1); PG8_BAR;
            PG8_LDA(At, 1, 1); PG8_STAGE(PG8_SA(1, 0), a3, voffA);
            PG8_BAR; PG8_WAIT_L(0); PG8_MMA(1, 0, At, B0); PG8_BAR; PG8_SCHED;
            PG8_STAGE(PG8_SB(1, 1), b3 + hstepB, voffB);
            PG8_WAIT_V(6); PG8_BAR; PG8_MMA(1, 1, At, B1); PG8_BAR;
            }
        }
        if constexpr (ALIGN_EPI) { if (wr == 0) PG8_BAR; }
        if constexpr (!Epi::AFTER_DRAIN) { E(acc, cur, wr, wc, fr, fq); S.done(cur); }
        if (!has_next) break;
#pragma unroll
        for (int a = 0; a < 2; ++a)
#pragma unroll
            for (int b = 0; b < 2; ++b)
#pragma unroll
                for (int m = 0; m < 4; ++m)
#pragma unroll
                    for (int n = 0; n < 2; ++n) acc[a][b][m][n] = (f32x4){0.f, 0.f, 0.f, 0.f};
        cur = nxt; cA = nA; cB = nB; ++ui;
        if constexpr (ALIGN_EPI) { if (wr == 1) PG8_BAR; }
    }
    PG8_WAIT_V(0);
    if constexpr (!ALIGN_EPI) { if (wr == 0) PG8_BAR; }
    PG8_BAR;
    if constexpr (Epi::AFTER_DRAIN) { E.fused(acc, cur, wr, wc, fr, fq, lds, wid, lane); S.done(cur); }
#undef PG8_SA
#undef PG8_SB
#undef PG8_STAGE
#undef PG8_LDA
#undef PG8_LDB
#undef PG8_MMA
#undef PG8_WAIT_V
#undef PG8_WAIT_L
#undef PG8_BAR
#undef PG8_SCHED
}
}

namespace mk {
#ifndef GAS
#define GAS __attribute__((address_space(1)))
#endif
#define LAS __attribute__((address_space(3)))
typedef unsigned short bf16;
typedef unsigned v4u __attribute__((ext_vector_type(4)));
typedef unsigned v2u __attribute__((ext_vector_type(2)));
typedef float f32x4 __attribute__((ext_vector_type(4)));
typedef GAS unsigned gu32;
#define LDS_WAIT() asm volatile("s_waitcnt lgkmcnt(0)" ::: "memory")
#define VM_WAIT() asm volatile("s_waitcnt vmcnt(0)" ::: "memory")
__device__ __forceinline__ unsigned f2bf_(float f) { unsigned u = __builtin_bit_cast(unsigned, f); return (u + 0x7fffu + ((u >> 16) & 1u)) >> 16; }
__device__ __forceinline__ unsigned pk2(float lo, float hi) { return f2bf_(lo) | (f2bf_(hi) << 16); }
__device__ __forceinline__ float bflo(unsigned w) { return __builtin_bit_cast(float, w << 16); }
__device__ __forceinline__ float bfhi(unsigned w) { return __builtin_bit_cast(float, w & 0xffff0000u); }

template <class P> __device__ __forceinline__ P* opq(P* p) { asm volatile("" : "+s"(p)); return p; }
__device__ __forceinline__ int opqi(int k) { asm volatile("" : "+s"(k)); return k; }
__device__ __forceinline__ float shx(float v, int o, int lane) { return __builtin_bit_cast(float, __builtin_amdgcn_ds_bpermute((lane ^ o) << 2, __builtin_bit_cast(int, v))); }
__device__ __forceinline__ int shxi(int v, int o, int lane) { return __builtin_amdgcn_ds_bpermute((lane ^ o) << 2, v); }
__device__ __forceinline__ int lane_id_v() { int l; asm volatile("v_mbcnt_lo_u32_b32 %0, -1, 0\n\tv_mbcnt_hi_u32_b32 %0, -1, %0" : "=v"(l)); return l; }
constexpr int NWAVES = 8;
constexpr int D = 1024, NB = 4, S = 8192, T = NB * S, L = 4, MEM = 256, INW = 2144, INP = 2304;
constexpr int PC_CQ = 0, PC_CKV = 256, PC_KR = 384, PC_XL = 512, PC_GL = 1024, PC_QD = 1536, PC_KD = 1792, PC_VD = 2048;
constexpr float LOG2E = 1.4426950408889634f;
constexpr size_t MiB = 1u << 20;
constexpr size_t WS_CTL = 0, CTL_ZERO_BYTES = 1 * MiB;
constexpr size_t WS_WIN = 1 * MiB, WS_WOUT = 19 * MiB, WS_WCQ = 27 * MiB, WS_WCO = 35 * MiB, WS_WPQ = 43 * MiB, WS_WCKV = 51 * MiB, WS_WUQ = 67 * MiB, WS_WUKV = 68 * MiB, WS_KEYS = 69 * MiB, WS_ROPE = 70 * MiB;
constexpr size_t WS_XNB = 76 * MiB, WS_YB = 140 * MiB, WS_PROJB = 204 * MiB, WS_QMB = 348 * MiB, WS_KMB = 372 * MiB, WS_VMB = 396 * MiB, WS_RS = 412 * MiB;
constexpr size_t WS_HLB = 413 * MiB, WS_ACB = 445 * MiB, WS_LSUM = 477 * MiB, WS_OMB = 478 * MiB, WS_MNB = 494 * MiB, WS_KVCB = 502 * MiB, WS_EX = 518 * MiB, WS_GW = 534 * MiB;
constexpr size_t WS_U8 = 550 * MiB, WS_V8 = 614 * MiB, WS_SU = 678 * MiB, WS_SV = 679 * MiB;
constexpr size_t WS_HQ = 680 * MiB, WS_P = 712 * MiB, WS_SH = 728 * MiB, WS_W = 729 * MiB, WS_WS = 745 * MiB, WS_SSQ = 746 * MiB, WS_END = 748 * MiB;
constexpr size_t WS_WAT = 74 * MiB;
constexpr size_t WS_BTAB = WS_KEYS + 512 * 1024, WS_LAMS = WS_BTAB + 4096, WS_SP = WS_LAMS + 4096;
constexpr int CW_BAR = 4096, CW_RANK = 8192;
constexpr int RING_OFF = 0, RING_BYTES = 155648, LDSCTL_OFF = RING_BYTES, MISC_OFF = LDSCTL_OFF + 320, LDS_BYTES = 163840;

#define XB_TMO      128
#define XB_XCNT(j)  (256  + 64 * (j))
#define XB_XSUB(j)  (1280 + 64 * (j))
#define XB_XGEN(j)  (2304 + 64 * (j))
#define XB_TOP      3328
#define XB_TOPGEN   3392
#define XCD_BAR_WORDS 3456
#define XB_SPIN_CAP (1u << 18)

__device__ __forceinline__ unsigned xb_ld(unsigned* p)              { return __hip_atomic_load(p, __ATOMIC_RELAXED, __HIP_MEMORY_SCOPE_AGENT); }
__device__ __forceinline__ unsigned xb_add(unsigned* p, unsigned v) { return __hip_atomic_fetch_add(p, v, __ATOMIC_RELAXED, __HIP_MEMORY_SCOPE_AGENT); }
__device__ __forceinline__ unsigned xb_xcc_id() { return (unsigned)__builtin_amdgcn_s_getreg((3 << 11) | 20) & 0xFu; }
#define XB_SPIN(cond, bar) do { unsigned _sp = 0; while (cond) { __builtin_amdgcn_s_sleep(1); \
    if ((++_sp & 255u) == 0u) { if (xb_ld(&(bar)[XB_TMO])) break; if (_sp > XB_SPIN_CAP) { atomicAdd(&(bar)[XB_TMO], 1u); break; } } } } while (0)

struct XcdBarrier {
    unsigned* bar; unsigned x;
    volatile LAS unsigned* st;
};

__device__ __forceinline__ XcdBarrier xcd_barrier_post(unsigned* bar, volatile LAS unsigned* st) {
    XcdBarrier b; b.bar = bar; b.x = xb_xcc_id(); b.st = st;
    if (threadIdx.x == 0) (void)xb_add(&bar[XB_XCNT(b.x)], 1u);
    return b;
}
__device__ __forceinline__ void xcd_barrier_complete(unsigned* bar, unsigned x, unsigned& nloc, unsigned& nx) {
    const unsigned G = gridDim.x * gridDim.y * gridDim.z;
    unsigned sum, cnt, mine, sp = 0u;
    for (;;) {
        sum = 0u; cnt = 0u; mine = 0u;
#pragma unroll
        for (unsigned j = 0; j < 16; ++j) { const unsigned c = xb_ld(&bar[XB_XCNT(j)]); sum += c; cnt += (c > 0u) ? 1u : 0u; mine = (j == x) ? c : mine; }
        if (sum == G) break;
        __builtin_amdgcn_s_sleep(1);
        if ((++sp & 255u) == 0u) { if (xb_ld(&bar[XB_TMO])) break; if (sp > XB_SPIN_CAP) { atomicAdd(&bar[XB_TMO], 1u); break; } }
    }
    nloc = mine > 0u ? mine : 1u; nx = cnt > 0u ? cnt : 1u;
}

__device__ __noinline__ void xcd_barrier_impl(unsigned* bar_, unsigned x_, volatile LAS unsigned* st_, int leader_) {
    XcdBarrier b; b.bar = bar_; b.x = x_; b.st = st_;
    asm volatile("s_waitcnt vmcnt(0)" ::: "memory");
    __syncthreads();
    if (leader_) {
        unsigned* bar = b.bar;
        __builtin_amdgcn_s_waitcnt(0);
        unsigned nloc = b.st[0], nx = b.st[1];
        if (nloc == 0u) { xcd_barrier_complete(bar, b.x, nloc, nx); b.st[0] = nloc; b.st[1] = nx; }
        const unsigned old = xb_add(&bar[XB_XSUB(b.x)], 1u);
        const unsigned gen = old / nloc;
        if (old + 1u == (gen + 1u) * nloc) {
            __builtin_amdgcn_fence(__ATOMIC_RELEASE, "agent");
            asm volatile("s_waitcnt vmcnt(0)" ::: "memory");
            const unsigned og = xb_add(&bar[XB_TOP], 1u);
            const unsigned tg = og / nx;
            if (og + 1u == (tg + 1u) * nx) xb_add(&bar[XB_TOPGEN], 1u);
            else XB_SPIN(xb_ld(&bar[XB_TOPGEN]) == tg, bar);
            __builtin_amdgcn_fence(__ATOMIC_ACQUIRE, "agent");
            xb_add(&bar[XB_XGEN(b.x)], 1u);
            asm volatile("s_waitcnt vmcnt(0)" ::: "memory");
        } else {
            XB_SPIN(xb_ld(&bar[XB_XGEN(b.x)]) == gen, bar);
            __builtin_amdgcn_fence(__ATOMIC_ACQUIRE, "agent");
            asm volatile("s_waitcnt vmcnt(0)" ::: "memory");
        }
    }
    __syncthreads();
}
__device__ __forceinline__ void xcd_barrier(const XcdBarrier& b, int leader) { xcd_barrier_impl(b.bar, b.x, b.st, leader); }


__device__ __forceinline__ float wave_sum(float v, int lane) {
#pragma unroll
    for (int o = 1; o < 64; o <<= 1) v += shx(v, o, lane);
    return v;
}
__device__ __forceinline__ float gelu_erf(float v) {
    const float av = __builtin_fabsf(v), t = __builtin_amdgcn_rcpf(av * 0.2316418882f + 1.0f);
    float q = t * 0.5307027145f + (-0.7265760135f); q = q * t + 0.7107068705f; q = q * t + (-0.142248368f); q = q * t + 0.127414796f; q = q * t;
    const float e = __builtin_amdgcn_exp2f((v * v) * (-0.72134752044f));
    const float m = v * (q * e);
    return v < 0.f ? m : v - m;
}

__device__ __forceinline__ void norm_phase(const GAS float* X, const GAS float* g, GAS bf16* out, int rows, int gw, int NGW, int lane) {
    asm volatile("" : "+v"(lane));
    f32x4 gv[4];
#pragma unroll
    for (int j = 0; j < 4; ++j) gv[j] = ((const GAS f32x4*)g)[lane + 64 * j];
    for (int m = gw; m < rows; m += NGW) {
        const GAS f32x4* xr = (const GAS f32x4*)(X + (size_t)m * D) + lane;
        f32x4 v[4]; float s = 0.f;
#pragma unroll
        for (int j = 0; j < 4; ++j) { v[j] = xr[64 * j]; s += (v[j].x * v[j].x + v[j].y * v[j].y) + (v[j].z * v[j].z + v[j].w * v[j].w); }
        const float rs = rsqrtf(wave_sum(s, lane) * (1.f / D) + 1e-6f);
        GAS v2u* o8 = (GAS v2u*)(out + (size_t)m * D) + lane;
#pragma unroll
        for (int j = 0; j < 4; ++j) { v2u w; w.x = pk2(v[j].x * rs * gv[j].x, v[j].y * rs * gv[j].y); w.y = pk2(v[j].z * rs * gv[j].z, v[j].w * rs * gv[j].w); o8[64 * j] = w; }
    }
}
__device__ __forceinline__ void hq_phase(const GAS bf16* XB, const GAS float* SSQ, const GAS float* g, GAS unsigned char* HQ, GAS float* SH, GAS int* Pz, int gw, int NGW, int lane) {
    asm volatile("" : "+v"(lane));
    const GAS f32x4* gp = (const GAS f32x4*)g + 4 * lane; const f32x4 g0 = gp[0], g1 = gp[1], g2 = gp[2], g3 = gp[3];
    for (int m = gw; m < T; m += NGW) {
        const GAS f32x4* sp = (const GAS f32x4*)(SSQ + (size_t)m * 16); const f32x4 t = (sp[0] + sp[1]) + (sp[2] + sp[3]);
        const float rs = __builtin_amdgcn_rsqf(((t[0] + t[1]) + (t[2] + t[3])) * (1.f / 1024.f) + 1e-6f);
        const v4u a = *(const GAS v4u*)(XB + (size_t)m * D + 16 * lane), b = *(const GAS v4u*)(XB + (size_t)m * D + 16 * lane + 8);
        float f[16] = {bflo(a.x) * g0[0], bfhi(a.x) * g0[1], bflo(a.y) * g0[2], bfhi(a.y) * g0[3], bflo(a.z) * g1[0], bfhi(a.z) * g1[1], bflo(a.w) * g1[2], bfhi(a.w) * g1[3],
                       bflo(b.x) * g2[0], bfhi(b.x) * g2[1], bflo(b.y) * g2[2], bfhi(b.y) * g2[3], bflo(b.z) * g3[0], bfhi(b.z) * g3[1], bflo(b.w) * g3[2], bfhi(b.w) * g3[3]};
        float mx = 0.f;
#pragma unroll
        for (int i = 0; i < 16; ++i) { f[i] *= rs; mx = fmaxf(mx, __builtin_fabsf(f[i])); }
#pragma unroll
        for (int o = 1; o < 64; o <<= 1) mx = fmaxf(mx, shx(mx, o, lane));
        const float inv = mx > 0.f ? 127.f / mx : 0.f;
        v4u q;
#pragma unroll
        for (int i = 0; i < 4; ++i) { const int ia = (int)__builtin_rintf(f[4 * i] * inv), ib = (int)__builtin_rintf(f[4 * i + 1] * inv), ic = (int)__builtin_rintf(f[4 * i + 2] * inv), id = (int)__builtin_rintf(f[4 * i + 3] * inv);
            q[i] = (unsigned)(ia & 255) | ((unsigned)(ib & 255) << 8) | ((unsigned)(ic & 255) << 16) | ((unsigned)(id & 255) << 24); }
        *(GAS v4u*)(HQ + (size_t)m * D + 16 * lane) = q;
        if (lane == 0) SH[m] = mx * (1.f / 127.f);
        (Pz + (size_t)m * 128)[lane] = 0; (Pz + (size_t)m * 128)[lane + 64] = 0;
    }
}
__device__ __forceinline__ void x0_phase(const GAS float* X, GAS bf16* XB, GAS float* SSQ, int gw, int NGW, int lane) {
    asm volatile("" : "+v"(lane));
    for (int m = gw; m < T; m += NGW) {
        const GAS f32x4* xr = (const GAS f32x4*)(X + (size_t)m * D) + lane; GAS v2u* o8 = (GAS v2u*)(XB + (size_t)m * D) + lane;
        float s = 0.f;
#pragma unroll
        for (int j = 0; j < 4; ++j) { const f32x4 v = xr[64 * j]; s += (v.x * v.x + v.y * v.y) + (v.z * v.z + v.w * v.w); v2u w; w.x = pk2(v.x, v.y); w.y = pk2(v.z, v.w); o8[64 * j] = w; }
        s = wave_sum(s, lane);
        if (lane < 8) SSQ[(size_t)m * 16 + lane] = lane == 0 ? s : 0.f;
    }
}
__device__ __forceinline__ void final_norm_phase(const GAS bf16* XB, GAS float* O, const GAS float* g, int rows, int gw, int NGW, int lane) {
    asm volatile("" : "+v"(lane));
    for (int m = gw; m < rows; m += NGW) {
        const GAS v4u* xr = (const GAS v4u*)(XB + (size_t)m * D) + lane;
        v4u v[2]; float s = 0.f;
#pragma unroll
        for (int j = 0; j < 2; ++j) { v[j] = xr[64 * j];
#pragma unroll
            for (int e = 0; e < 4; ++e) { const float a = bflo(v[j][e]), b = bfhi(v[j][e]); s += a * a + b * b; } }
        const float rs = rsqrtf(wave_sum(s, lane) * (1.f / D) + 1e-6f);
#pragma unroll
        for (int j = 0; j < 2; ++j) { const int c = 8 * (lane + 64 * j); const f32x4 g0 = *(const GAS f32x4*)(g + c), g1 = *(const GAS f32x4*)(g + c + 4);
            f32x4 o0, o1; o0.x = bflo(v[j].x) * rs * g0.x; o0.y = bfhi(v[j].x) * rs * g0.y; o0.z = bflo(v[j].y) * rs * g0.z; o0.w = bfhi(v[j].y) * rs * g0.w;
            o1.x = bflo(v[j].z) * rs * g1.x; o1.y = bfhi(v[j].z) * rs * g1.y; o1.z = bflo(v[j].w) * rs * g1.z; o1.w = bfhi(v[j].w) * rs * g1.w;
            *(GAS f32x4*)(O + (size_t)m * D + c) = o0; *(GAS f32x4*)(O + (size_t)m * D + c + 4) = o1; }
    }
}

__device__ __forceinline__ void pre_phase(const GAS bf16* PROJB, const GAS float* ROPE, GAS float* RS, GAS bf16* KMB, int gw, int NGW, int lane) {
    asm volatile("" : "+v"(lane));
    for (int t = gw; t < T; t += NGW) {
        const GAS bf16* pr = PROJB + (size_t)t * INP;
        float sq = 0.f, skv = 0.f;
        if (lane < 24) { const v4u w = *(const GAS v4u*)(pr + PC_CQ + 8 * lane);
            const float a0 = bflo(w.x), a1 = bfhi(w.x), a2 = bflo(w.y), a3 = bfhi(w.y), a4 = bflo(w.z), a5 = bfhi(w.z), a6 = bflo(w.w), a7 = bfhi(w.w);
            sq = (a0 * a0 + a1 * a1) + (a2 * a2 + a3 * a3) + (a4 * a4 + a5 * a5) + (a6 * a6 + a7 * a7); }
        else if (lane >= 32 && lane < 48) { const v4u w = *(const GAS v4u*)(pr + PC_CKV + 8 * (lane - 32));
            const float a0 = bflo(w.x), a1 = bfhi(w.x), a2 = bflo(w.y), a3 = bfhi(w.y), a4 = bflo(w.z), a5 = bfhi(w.z), a6 = bflo(w.w), a7 = bfhi(w.w);
            skv = (a0 * a0 + a1 * a1) + (a2 * a2 + a3 * a3) + (a4 * a4 + a5 * a5) + (a6 * a6 + a7 * a7); }
        sq = wave_sum(sq, lane); skv = wave_sum(skv, lane);
        if (lane == 0) { RS[2 * (size_t)t] = rsqrtf(sq * (1.f / 192.f) + 1e-6f); RS[2 * (size_t)t + 1] = rsqrtf(skv * (1.f / 128.f) + 1e-6f); }
        if (lane < 16) {
            const float x1 = __builtin_bit_cast(float, (unsigned)pr[PC_KR + lane] << 16), x2 = __builtin_bit_cast(float, (unsigned)pr[PC_KR + 16 + lane] << 16);
            const float c = ROPE[(size_t)t * 32 + lane], sn = ROPE[(size_t)t * 32 + 16 + lane];
            const bf16 y1 = (bf16)f2bf_(x1 * c - x2 * sn), y2 = (bf16)f2bf_(x1 * sn + x2 * c);
            GAS bf16* kr = KMB + (size_t)t * 384 + 64 + lane;
#pragma unroll
            for (int h = 0; h < 4; ++h) { kr[h * 96] = y1; kr[h * 96 + 16] = y2; }
        }
    }
}

typedef short lr_bf16x8 __attribute__((ext_vector_type(8)));
typedef float lr_f32x16 __attribute__((ext_vector_type(16)));
__device__ __forceinline__ void lr_swap32(float& a, float& b) { asm volatile("v_nop\n\tv_nop\n\tv_permlane32_swap_b32 %0, %1" : "+v"(a), "+v"(b)); }
constexpr int LR_XR = 0, LR_CW = LR_XR + 37376, LR_XA = LR_CW + 1280, LR_WT = LR_XA + 256 * 144, LR_SUM = LR_WT + 2 * 64 * 144, LR_END = LR_SUM + 4096;
struct LruP { const GAS bf16* PROJB; const GAS float* cw; const GAS float* cb; const GAS bf16* wat; const GAS float* ba; const GAS float* bx; const GAS float* sp; GAS unsigned* HA; GAS float* LSUM; };
__device__ __forceinline__ void lru_phase(const LruP& P, LAS unsigned char* lds, int tid, int wave, int lane, int vcu, int G) {
    asm volatile("" : "+v"(tid), "+v"(lane));
    LAS float* SUM = (LAS float*)(lds + LR_SUM);
    for (int u = vcu; u < (T / 256) * 8; u += G) {
        const int tile = u >> 3, g = u & 7; const int t0 = tile * 256; const bool first = ((tile & 31) == 0);
        __syncthreads();
        { v4u wt_[2], xr_[5];
#pragma unroll
          for (int i = 0; i < 2; ++i) { const int idx = tid + 512 * i; wt_[i] = ((const GAS v4u*)(P.wat + (size_t)g * 2 * 4096))[idx]; }
#pragma unroll
          for (int i = 0; i < 5; ++i) { const int idx = tid + 512 * i, row = idx >> 3, part = idx & 7; const bool ok = (idx < 259 * 8) && !(first && row < 3);
              const int trow = ok ? t0 - 3 + row : t0;
              xr_[i] = *(const GAS v4u*)(P.PROJB + (size_t)trow * INP + PC_XL + 64 * g + 8 * part); if (!ok) xr_[i] = v4u{0u, 0u, 0u, 0u}; }
          float cwv = 0.f; if (tid < 320) cwv = (tid < 256) ? P.cw[(tid >> 6) * 512 + 64 * g + (tid & 63)] : P.cb[64 * g + (tid - 256)];
#pragma unroll
          for (int i = 0; i < 2; ++i) { const int idx = tid + 512 * i; *(LAS v4u*)(lds + LR_WT + (idx >> 9) * 9216 + ((idx >> 3) & 63) * 144 + (idx & 7) * 16) = wt_[i]; }
#pragma unroll
          for (int i = 0; i < 5; ++i) { const int idx = tid + 512 * i, row = idx >> 3, part = idx & 7; if (idx < 259 * 8) *(LAS v4u*)(lds + LR_XR + row * 144 + 16 * part) = xr_[i]; }
          if (tid < 320) ((LAS float*)(lds + LR_CW))[tid] = cwv; }
        __syncthreads();
        { float cwr[4][8], cbr[8];
#pragma unroll
          for (int k = 0; k < 4; ++k) { const f32x4 c0 = *(const LAS f32x4*)(lds + LR_CW + (k * 64 + 8 * wave) * 4), c1 = *(const LAS f32x4*)(lds + LR_CW + (k * 64 + 8 * wave + 4) * 4);
              cwr[k][0] = c0.x; cwr[k][1] = c0.y; cwr[k][2] = c0.z; cwr[k][3] = c0.w; cwr[k][4] = c1.x; cwr[k][5] = c1.y; cwr[k][6] = c1.z; cwr[k][7] = c1.w; }
          { const f32x4 c0 = *(const LAS f32x4*)(lds + LR_CW + (256 + 8 * wave) * 4), c1 = *(const LAS f32x4*)(lds + LR_CW + (256 + 8 * wave + 4) * 4);
            cbr[0] = c0.x; cbr[1] = c0.y; cbr[2] = c0.z; cbr[3] = c0.w; cbr[4] = c1.x; cbr[5] = c1.y; cbr[6] = c1.z; cbr[7] = c1.w; }
#pragma unroll
          for (int it_ = 0; it_ < 4; ++it_) { const int time = lane + 64 * it_;
              float y[8];
#pragma unroll
              for (int e = 0; e < 8; ++e) y[e] = cbr[e];
#pragma unroll
              for (int k = 0; k < 4; ++k) { const v4u w = *(const LAS v4u*)(lds + LR_XR + (time + k) * 144 + 16 * wave);
                  y[0] += bflo(w.x) * cwr[k][0]; y[1] += bfhi(w.x) * cwr[k][1]; y[2] += bflo(w.y) * cwr[k][2]; y[3] += bfhi(w.y) * cwr[k][3];
                  y[4] += bflo(w.z) * cwr[k][4]; y[5] += bfhi(w.z) * cwr[k][5]; y[6] += bflo(w.w) * cwr[k][6]; y[7] += bfhi(w.w) * cwr[k][7]; }
              v4u o; o.x = pk2(y[0], y[1]); o.y = pk2(y[2], y[3]); o.z = pk2(y[4], y[5]); o.w = pk2(y[6], y[7]);
              *(LAS v4u*)(lds + LR_XA + time * 144 + 16 * wave) = o; } }
        __syncthreads();
        const int r32 = lane & 31, hi = lane >> 5;
        lr_f32x16 acc[2][2];
#pragma unroll
        for (int nt = 0; nt < 2; ++nt) { const float b_a = P.ba[64 * g + 32 * nt + r32], b_x = P.bx[64 * g + 32 * nt + r32];
#pragma unroll
            for (int r = 0; r < 16; ++r) { acc[0][nt][r] = b_a; acc[1][nt][r] = b_x; } }
        { lr_bf16x8 af[4];
#pragma unroll
          for (int s_ = 0; s_ < 4; ++s_) af[s_] = *(const LAS lr_bf16x8*)(lds + LR_XA + (32 * wave + r32) * 144 + (16 * s_ + 8 * hi) * 2);
#pragma unroll
          for (int gt = 0; gt < 2; ++gt)
#pragma unroll
              for (int nt = 0; nt < 2; ++nt)
#pragma unroll
                  for (int s_ = 0; s_ < 4; ++s_) { const lr_bf16x8 bfr = *(const LAS lr_bf16x8*)(lds + LR_WT + gt * 9216 + (32 * nt + r32) * 144 + (16 * s_ + 8 * hi) * 2);
                      acc[gt][nt] = __builtin_amdgcn_mfma_f32_32x32x16_bf16(af[s_], bfr, acc[gt][nt], 0, 0, 0); } }
#pragma unroll
        for (int nt = 0; nt < 2; ++nt) { const float sp = P.sp[64 * g + 32 * nt + r32];
            float sa_[4], sh_[4];
#pragma unroll
            for (int q = 0; q < 4; ++q) { float hrun = 0.f, arun = 1.f;
#pragma unroll
                for (int e = 0; e < 4; ++e) { const int r = 4 * q + e, tl = 8 * q + 4 * hi + e;
                    const float xv = __builtin_bit_cast(float, (unsigned)*(const LAS unsigned short*)(lds + LR_XA + (32 * wave + tl) * 144 + (32 * nt + r32) * 2) << 16);
                    const float rg = __builtin_amdgcn_rcpf(1.f + __builtin_amdgcn_exp2f(-LOG2E * acc[0][nt][r])), ig = __builtin_amdgcn_rcpf(1.f + __builtin_amdgcn_exp2f(-LOG2E * acc[1][nt][r]));
                    const float la = -8.0f * rg * sp; const float a_ = __builtin_amdgcn_exp2f(LOG2E * la);
                    const float uu = __builtin_amdgcn_sqrtf(fmaxf(1.f - a_ * a_, 0.f)) * (ig * xv);
                    hrun = a_ * hrun + uu; arun *= a_; acc[0][nt][r] = arun; acc[1][nt][r] = hrun; }
                sa_[q] = arun; sh_[q] = hrun; }
            float runA = 1.f, runH = 0.f;
#pragma unroll
            for (int q = 0; q < 4; ++q) { float a0 = sa_[q], a1 = sa_[q], h0 = sh_[q], h1 = sh_[q]; lr_swap32(a0, a1); lr_swap32(h0, h1);
                const float midA = runA * a0, midH = a0 * runH + h0;
                const float inA = hi ? midA : runA, inH = hi ? midH : runH;
                runA = midA * a1; runH = a1 * midH + h1;
#pragma unroll
                for (int e = 0; e < 4; ++e) { const int r = 4 * q + e; acc[1][nt][r] += acc[0][nt][r] * inH; acc[0][nt][r] *= inA; } }
            if (hi == 0) { SUM[(wave * 64 + 32 * nt + r32) * 2] = runA; SUM[(wave * 64 + 32 * nt + r32) * 2 + 1] = runH; } }
        __syncthreads();
#pragma unroll
        for (int nt = 0; nt < 2; ++nt) { const int cl = 32 * nt + r32;
            float ca = 1.f, chh = 0.f;
            for (int w = 0; w < wave; ++w) { const float aw = SUM[(w * 64 + cl) * 2], hw = SUM[(w * 64 + cl) * 2 + 1]; chh = aw * chh + hw; ca *= aw; }
            GAS unsigned* ha = P.HA + (size_t)(t0 + 32 * wave + 4 * hi) * 512 + 64 * g + cl;
#pragma unroll
            for (int r = 0; r < 16; ++r) { const float hh = acc[1][nt][r] + acc[0][nt][r] * chh, ac_ = acc[0][nt][r] * ca; ha[(size_t)((r & 3) + 8 * (r >> 2)) * 512] = pk2(hh, ac_);
                if (r == 15 && wave == 7 && hi == 1) { P.LSUM[((size_t)tile * 512 + 64 * g + cl) * 2] = ac_; P.LSUM[((size_t)tile * 512 + 64 * g + cl) * 2 + 1] = hh; } } }
    }
}

struct PostP { const GAS bf16* OMB; const GAS unsigned* HA; const GAS float* LSUM; const GAS bf16* PROJB; const GAS float* gm; const GAS float* gl; GAS bf16* Y; };
__device__ __forceinline__ void post_phase(const PostP& P, LAS unsigned char* lds, int tid, int wave, int lane, int vcu, int G) {
    asm volatile("" : "+v"(tid), "+v"(lane));
    LAS float* hin = (LAS float*)lds;
    for (int u = vcu; u < T / 64; u += G) {
        const int t0 = u * 64, tile = t0 >> 8, tb = tile & ~31;
        __syncthreads();
        { float h = 0.f;
          for (int c = tb; c < tile; ++c) { const float a = P.LSUM[((size_t)c * 512 + tid) * 2], hh = P.LSUM[((size_t)c * 512 + tid) * 2 + 1]; h = a * h + hh; }
          hin[tid] = h; }
        __syncthreads();
        f32x4 hi0 = *(const LAS f32x4*)(hin + 8 * lane), hi1 = *(const LAS f32x4*)(hin + 8 * lane + 4);
        const f32x4 g0 = *(const GAS f32x4*)(P.gl + 8 * lane), g1 = *(const GAS f32x4*)(P.gl + 8 * lane + 4), gmv = *(const GAS f32x4*)(P.gm + 4 * lane);
#pragma unroll 2
        for (int i = 0; i < 8; ++i) {
            const size_t t = (size_t)t0 + 8 * wave + i;
            const v4u p0 = *(const GAS v4u*)(P.HA + t * 512 + 8 * lane), p1 = *(const GAS v4u*)(P.HA + t * 512 + 8 * lane + 4), gw_ = *(const GAS v4u*)(P.PROJB + t * INP + PC_GL + 8 * lane);
            const v2u mw = *(const GAS v2u*)(P.OMB + t * 256 + 4 * lane);
            float o[8];
            o[0] = (bflo(p0.x) + bfhi(p0.x) * hi0.x) * gelu_erf(bflo(gw_.x)); o[1] = (bflo(p0.y) + bfhi(p0.y) * hi0.y) * gelu_erf(bfhi(gw_.x));
            o[2] = (bflo(p0.z) + bfhi(p0.z) * hi0.z) * gelu_erf(bflo(gw_.y)); o[3] = (bflo(p0.w) + bfhi(p0.w) * hi0.w) * gelu_erf(bfhi(gw_.y));
            o[4] = (bflo(p1.x) + bfhi(p1.x) * hi1.x) * gelu_erf(bflo(gw_.z)); o[5] = (bflo(p1.y) + bfhi(p1.y) * hi1.y) * gelu_erf(bfhi(gw_.z));
            o[6] = (bflo(p1.z) + bfhi(p1.z) * hi1.z) * gelu_erf(bflo(gw_.w)); o[7] = (bflo(p1.w) + bfhi(p1.w) * hi1.w) * gelu_erf(bfhi(gw_.w));
            float s2 = 0.f;
#pragma unroll
            for (int e = 0; e < 8; ++e) s2 += o[e] * o[e];
            const float m0 = bflo(mw.x), m1 = bfhi(mw.x), m2 = bflo(mw.y), m3 = bfhi(mw.y);
            float s1 = (m0 * m0 + m1 * m1) + (m2 * m2 + m3 * m3);
            s1 = wave_sum(s1, lane); s2 = wave_sum(s2, lane);
            const float r1 = rsqrtf(s1 * (1.f / 256.f) + 1e-6f), r2 = rsqrtf(s2 * (1.f / 512.f) + 1e-6f);
            GAS bf16* yr = P.Y + t * 1024;
            { v2u w; w.x = pk2(m0 * r1 * gmv.x, m1 * r1 * gmv.y); w.y = pk2(m2 * r1 * gmv.z, m3 * r1 * gmv.w); *(GAS v2u*)(yr + 4 * lane) = w; }
            { v4u w; w.x = pk2(o[0] * r2 * g0.x, o[1] * r2 * g0.y); w.y = pk2(o[2] * r2 * g0.z, o[3] * r2 * g0.w); w.z = pk2(o[4] * r2 * g1.x, o[5] * r2 * g1.y); w.w = pk2(o[6] * r2 * g1.z, o[7] * r2 * g1.w);
              *(GAS v4u*)(yr + 256 + 8 * lane) = w; }
        }
    }
}

#define TILE_BAR() asm volatile("s_waitcnt lgkmcnt(0)\n\ts_barrier" ::: "memory")
typedef short bf16x8 __attribute__((ext_vector_type(8)));
typedef short s16x4 __attribute__((ext_vector_type(4)));
typedef float f32x16 __attribute__((ext_vector_type(16)));
typedef unsigned u32x4 __attribute__((ext_vector_type(4)));
__device__ __forceinline__ int crow(int r, int hi) { return (r & 3) + 8 * (r >> 2) + 4 * hi; }
typedef float f32x2_t __attribute__((ext_vector_type(2))); typedef __bf16 bf16x2_c __attribute__((ext_vector_type(2)));
__device__ __forceinline__ unsigned cvtpk(float lo, float hi) { f32x2_t v = {lo, hi}; bf16x2_c b = __builtin_convertvector(v, bf16x2_c); return __builtin_bit_cast(unsigned, b); }
__device__ __forceinline__ float swapmax(float m) { auto rr = __builtin_amdgcn_permlane32_swap(__float_as_uint(m), __float_as_uint(m), false, false); return fmaxf(__uint_as_float(rr[0]), __uint_as_float(rr[1])); }
__device__ __forceinline__ float swapadd(float m) { auto rr = __builtin_amdgcn_permlane32_swap(__float_as_uint(m), __float_as_uint(m), false, false); return __uint_as_float(rr[0]) + __uint_as_float(rr[1]); }
__device__ __forceinline__ s16x4 vtr(const LAS unsigned char* p) { return __builtin_bit_cast(s16x4, __builtin_amdgcn_ds_read_tr16_b64_v4i16((LAS s16x4*)p)); }
__device__ __forceinline__ bf16x8 pack8(const f32x16& p, int b) { u32x4 w; w.x = cvtpk(p[b], p[b + 1]); w.y = cvtpk(p[b + 2], p[b + 3]); w.z = cvtpk(p[b + 4], p[b + 5]); w.w = cvtpk(p[b + 6], p[b + 7]); return __builtin_bit_cast(bf16x8, w); }
__device__ __forceinline__ float vmax3(float a, float b, float c) { float r; asm("v_max3_f32 %0, %1, %2, %3" : "=v"(r) : "v"(a), "v"(b), "v"(c)); return r; }
__device__ __forceinline__ float max32(const f32x16& p, const f32x16& q) {
    float a = vmax3(p[0], p[1], p[2]), b = vmax3(p[3], p[4], p[5]), c = vmax3(p[6], p[7], p[8]), d = vmax3(p[9], p[10], p[11]), e = vmax3(p[12], p[13], p[14]);
    float f = vmax3(q[0], q[1], q[2]), g = vmax3(q[3], q[4], q[5]), h = vmax3(q[6], q[7], q[8]), i = vmax3(q[9], q[10], q[11]), j = vmax3(q[12], q[13], q[14]);
    a = vmax3(a, b, c); d = vmax3(d, e, p[15]); f = vmax3(f, g, h); i = vmax3(i, j, q[15]);
    return vmax3(vmax3(a, d, f), i, i);
}
__device__ __forceinline__ float max16(const f32x16& p) { float a = fmaxf(fmaxf(p[0], p[1]), fmaxf(p[2], p[3])), b = fmaxf(fmaxf(p[4], p[5]), fmaxf(p[6], p[7])), c = fmaxf(fmaxf(p[8], p[9]), fmaxf(p[10], p[11])), d = fmaxf(fmaxf(p[12], p[13]), fmaxf(p[14], p[15])); return fmaxf(fmaxf(a, b), fmaxf(c, d)); }

struct AttnP {
    const GAS bf16* Q; const GAS bf16* K; const GAS bf16* V; int qp, kp, vp;
    GAS bf16* O; int op;
    const GAS float* rope;
    const GAS int* pos; const GAS float* btab; const GAS float* dnorm; const GAS float* lams;
};
template <int KIND> struct AK {
    static constexpr bool DIFF = KIND == 1, CROSS = KIND == 2;
    static constexpr int HW = KIND == 0 ? 96 : KIND == 1 ? 64 : 256;
    static constexpr int NKS = KIND == 0 ? 6 : KIND == 1 ? 2 : 16;
    static constexpr int KP = KIND == 0 ? 208 : KIND == 1 ? 144 : 528;
    static constexpr int ND = CROSS ? 4 : 2;
    static constexpr int CPK = HW / 8, KCH = (64 * CPK + 511) / 512;
    static constexpr int VCH = ND / 2;
    static constexpr int KB = 64 * KP, VB = ND * 4096;
    static constexpr int NBUF = CROSS ? 2 : 3;
    static constexpr int K0 = 0, V0 = NBUF * KB, POS = V0 + NBUF * VB, BT = POS + 1024, DN = BT + 528, END = DN + 256;
};
static_assert(AK<2>::END <= RING_BYTES && AK<0>::END <= RING_BYTES && AK<1>::END + 16 + 8 * 8192 <= RING_BYTES, "attention LDS");

template <int KIND, bool LEAD>
__device__ __forceinline__ void attn_unit(const AttnP& P, int b, int h, int qb, int dhalf, LAS unsigned char* lds, int tid, int wave, int lane) {
    lane = lane_id_v(); tid = (wave << 6) | lane;
    typedef AK<KIND> C;
    constexpr bool DIFF = C::DIFF, CROSS = C::CROSS;
    constexpr int HW = C::HW, NKS = C::NKS, KP = C::KP, ND = C::ND, CPK = C::CPK, KCH = C::KCH, VCH = C::VCH;
    const int r32 = lane & 31, hi = lane >> 5;
    const size_t rowb = (size_t)b * S, rowk = CROSS ? (size_t)b * MEM : rowb;
    const int q0w = qb * 256 + wave * 32, qi = q0w + r32;
    int pq = 0; float bias_far = 0.f;
    __syncthreads();
    if (DIFF) {
        pq = P.pos[rowb + qi];
        if (tid < 129) ((LAS float*)(lds + C::BT))[tid] = P.btab[h * 129 + tid];
        if (tid >= 192 && tid < 256) ((LAS float*)(lds + C::DN))[tid - 192] = P.dnorm[tid - 192];
    }
    int minq = pq;
    if (DIFF) { for (int o = 1; o < 64; o <<= 1) { const int v = shxi(minq, o, lane); minq = v < minq ? v : minq; } }
    const int NT = CROSS ? MEM / 64 : 4 * (qb + 1);
    u32x4 kr[KCH], vr[VCH]; int pkr = 0;
    u32x4 kr2[CROSS ? 1 : KCH], vr2[CROSS ? 1 : VCH]; int pkr2 = 0;
    const GAS bf16* Kb = P.K + rowk * P.kp + h * HW; const GAS bf16* Vb = P.V + rowk * P.vp + (CROSS ? h * 256 + dhalf * 128 : h * 64);
    const __amdgpu_buffer_rsrc_t rK = __builtin_amdgcn_make_buffer_rsrc((void*)Kb, 0, 0x7fffffff, 0x00020000), rV = __builtin_amdgcn_make_buffer_rsrc((void*)Vb, 0, 0x7fffffff, 0x00020000);
    const __amdgpu_buffer_rsrc_t rP = __builtin_amdgcn_make_buffer_rsrc((void*)(DIFF ? P.pos + rowb : (const GAS int*)Kb), 0, 0x7fffffff, 0x00020000);
    int kvo[KCH], vvo[VCH];
#pragma unroll
    for (int i = 0; i < KCH; ++i) { int c = tid + 512 * i; c = c < 64 * CPK ? c : tid; kvo[i] = ((c / CPK) * P.kp + (c % CPK) * 8) * 2; }
#pragma unroll
    for (int i = 0; i < VCH; ++i) { const int c = tid + 512 * i; vvo[i] = ((c / (4 * ND)) * P.vp + (c % (4 * ND)) * 8) * 2; }
    const int pvo = (tid & 63) * 4;
    auto gload = [&](int t) {
        const int ks = __builtin_amdgcn_readfirstlane(64 * t * P.kp * 2), vs = __builtin_amdgcn_readfirstlane(64 * t * P.vp * 2);
#pragma unroll
        for (int i = 0; i < KCH; ++i) kr[i] = __builtin_amdgcn_raw_buffer_load_b128(rK, kvo[i], ks, 0);
#pragma unroll
        for (int i = 0; i < VCH; ++i) vr[i] = __builtin_amdgcn_raw_buffer_load_b128(rV, vvo[i], vs, 0);
        if (DIFF) pkr = __builtin_amdgcn_raw_buffer_load_b32(rP, pvo, __builtin_amdgcn_readfirstlane(64 * t * 4), 0);
    };
    auto lstore = [&](int buf) {
        LAS unsigned char* kb_ = lds + C::K0 + buf * C::KB; LAS unsigned char* vb_ = lds + C::V0 + buf * C::VB;
#pragma unroll
        for (int i = 0; i < KCH; ++i) { int c = tid + 512 * i; c = c < 64 * CPK ? c : tid; const int key = c / CPK, part = c % CPK; *(LAS u32x4*)(kb_ + key * KP + part * 16) = kr[i]; }
#pragma unroll
        for (int i = 0; i < VCH; ++i) { const int c = tid + 512 * i; const int key = c / (4 * ND), part = c % (4 * ND); *(LAS u32x4*)(vb_ + (part >> 2) * 4096 + (key >> 3) * 512 + (key & 7) * 64 + (part & 3) * 16) = vr[i]; }
        if (DIFF) { ((LAS int*)(lds + C::POS + buf * 256))[tid & 63] = pkr; if (tid < 64) { int mk_ = pkr; for (int o = 1; o < 64; o <<= 1) { const int v = shxi(mk_, o, lane); mk_ = v > mk_ ? v : mk_; } if (tid == 0) ((LAS int*)(lds + C::POS + 768))[buf] = mk_; } }
    };
    auto gloadB = [&](int t) {
        const int ks = __builtin_amdgcn_readfirstlane(64 * t * P.kp * 2), vs = __builtin_amdgcn_readfirstlane(64 * t * P.vp * 2);
#pragma unroll
        for (int i = 0; i < (CROSS ? 1 : KCH); ++i) kr2[i] = __builtin_amdgcn_raw_buffer_load_b128(rK, kvo[i], ks, 0);
#pragma unroll
        for (int i = 0; i < (CROSS ? 1 : VCH); ++i) vr2[i] = __builtin_amdgcn_raw_buffer_load_b128(rV, vvo[i], vs, 0);
        if (DIFF) pkr2 = __builtin_amdgcn_raw_buffer_load_b32(rP, pvo, __builtin_amdgcn_readfirstlane(64 * t * 4), 0);
    };
    auto lstoreB = [&](int buf) {
        LAS unsigned char* kb_ = lds + C::K0 + buf * C::KB; LAS unsigned char* vb_ = lds + C::V0 + buf * C::VB;
#pragma unroll
        for (int i = 0; i < (CROSS ? 1 : KCH); ++i) { int c = tid + 512 * i; c = c < 64 * CPK ? c : tid; const int key = c / CPK, part = c % CPK; *(LAS u32x4*)(kb_ + key * KP + part * 16) = kr2[i]; }
#pragma unroll
        for (int i = 0; i < (CROSS ? 1 : VCH); ++i) { const int c = tid + 512 * i; const int key = c / (4 * ND), part = c % (4 * ND); *(LAS u32x4*)(vb_ + (part >> 2) * 4096 + (key >> 3) * 512 + (key & 7) * 64 + (part & 3) * 16) = vr2[i]; }
        if (DIFF) { ((LAS int*)(lds + C::POS + buf * 256))[tid & 63] = pkr2; if (tid < 64) { int mk_ = pkr2; for (int o = 1; o < 64; o <<= 1) { const int v = shxi(mk_, o, lane); mk_ = v > mk_ ? v : mk_; } if (tid == 0) ((LAS int*)(lds + C::POS + 768))[buf] = mk_; } }
    };
    LAS float* osv = (LAS float*)(lds + ((C::END + 15) & ~15)) + wave * 2048 + lane;
    float il = 0.f;
    f32x16 oA[ND];
#pragma unroll 1
    for (int mp = 0; mp < (DIFF ? 2 : 1); ++mp) {
        bf16x8 qf[NKS];
        { const GAS bf16* qrow = P.Q + (rowb + qi) * P.qp + h * HW + mp * 32;
#pragma unroll
          for (int s = 0; s < NKS; ++s) qf[s] = *(const GAS bf16x8*)(qrow + 16 * s + 8 * hi);
          if (KIND == 0) {
              const GAS float* rp = P.rope + (rowb + qi) * 32 + 8 * hi;
              const f32x4 c0 = *(const GAS f32x4*)rp, c1 = *(const GAS f32x4*)(rp + 4), s0 = *(const GAS f32x4*)(rp + 16), s1 = *(const GAS f32x4*)(rp + 20);
              const u32x4 a = __builtin_bit_cast(u32x4, qf[NKS - 2]), bq = __builtin_bit_cast(u32x4, qf[NKS - 1]); u32x4 ra, rb;
#pragma unroll
              for (int w = 0; w < 4; ++w) { const float cl = w < 2 ? c0[2 * w] : c1[2 * w - 4], ch = w < 2 ? c0[2 * w + 1] : c1[2 * w - 3], sl = w < 2 ? s0[2 * w] : s1[2 * w - 4], sh = w < 2 ? s0[2 * w + 1] : s1[2 * w - 3];
                  const float x1l = bflo(a[w]), x1h = bfhi(a[w]), x2l = bflo(bq[w]), x2h = bfhi(bq[w]);
                  ra[w] = cvtpk(x1l * cl - x2l * sl, x1h * ch - x2h * sh); rb[w] = cvtpk(x1l * sl + x2l * cl, x1h * sh + x2h * ch); }
              qf[NKS - 2] = __builtin_bit_cast(bf16x8, ra); qf[NKS - 1] = __builtin_bit_cast(bf16x8, rb);
          } }
        __syncthreads();
        float m1 = -1e30f, l1 = 0.f;
#pragma unroll
        for (int d = 0; d < ND; ++d)
#pragma unroll
            for (int r = 0; r < 16; ++r) oA[d][r] = 0.f;
        auto qk = [&](int sl, f32x16& sa, f32x16& sb, float init) {
            const LAS unsigned char* kb_ = lds + C::K0 + sl * C::KB + r32 * KP + hi * 16 + mp * 64;
#pragma unroll
            for (int r = 0; r < 16; ++r) { sa[r] = init; sb[r] = init; }
            constexpr int HB = CROSS ? 4 : (NKS > 3 ? 3 : NKS);
#pragma unroll
            for (int s0_ = 0; s0_ < NKS; s0_ += HB) {
                bf16x8 kfa[HB], kfb[HB];
#pragma unroll
                for (int s = 0; s < HB; ++s) { kfa[s] = *(const LAS bf16x8*)(kb_ + (s0_ + s) * 32); kfb[s] = *(const LAS bf16x8*)(kb_ + 32 * KP + (s0_ + s) * 32); }
                __builtin_amdgcn_sched_barrier(0);
#pragma unroll
                for (int s = 0; s < HB; ++s) { sa = __builtin_amdgcn_mfma_f32_32x32x16_bf16(kfa[s], qf[s0_ + s], sa, 0, 0, 0); sb = __builtin_amdgcn_mfma_f32_32x32x16_bf16(kfb[s], qf[s0_ + s], sb, 0, 0, 0); }
                __builtin_amdgcn_sched_barrier(0);
            }
        };
        auto isnear = [&](int sl) { bool nb = false;
            if (DIFF) { const int mk_ = __builtin_amdgcn_readfirstlane(((LAS int*)(lds + C::POS + 768))[sl]); nb = (minq - mk_) < 128; }
            return nb; };
        auto sm = [&](int t, int sl, f32x16& pa, f32x16& pb, bool nearb) -> float {
            const int k0 = 64 * t;
            if (DIFF) { if (nearb) {
                const LAS int* pk = (const LAS int*)(lds + C::POS + sl * 256); const LAS float* bt = (const LAS float*)(lds + C::BT);
#pragma unroll
                for (int r = 0; r < 16; ++r) { const int kk = crow(r, hi);
                    int n0 = pq - pk[kk], n1 = pq - pk[kk + 32]; n0 = n0 < 0 ? 0 : (n0 > 128 ? 128 : n0); n1 = n1 < 0 ? 0 : (n1 > 128 ? 128 : n1);
                    pa[r] += bt[n0]; pb[r] += bt[n1]; }
            } }
            if (!CROSS && k0 + 63 > q0w) {
#pragma unroll
                for (int r = 0; r < 16; ++r) { const int kk = k0 + crow(r, hi); if (kk > qi) pa[r] = -1e30f; if (kk + 32 > qi) pb[r] = -1e30f; }
            }
            asm volatile("s_nop 15\n\ts_nop 7" : "+v"(pa), "+v"(pb));
            float mn, al = 1.f;
            if (CROSS) { const float mx = swapmax(max32(pa, pb)); mn = fmaxf(m1, mx); al = __builtin_amdgcn_exp2f(m1 - mn); l1 *= al; }
            else { const float mx = swapmax(max32(pa, pb)); const bool up = mx > m1 + 8.0f; mn = up ? mx : m1;
                   if (__builtin_amdgcn_ballot_w64(up) != 0ull) { al = __builtin_amdgcn_exp2f(m1 - mn); l1 *= al; } }
            m1 = mn;
            float ls = 0.f;
#pragma unroll
            for (int r = 0; r < 16; ++r) { pa[r] = __builtin_amdgcn_exp2f(pa[r] - mn); pb[r] = __builtin_amdgcn_exp2f(pb[r] - mn); ls += pa[r] + pb[r]; }
            l1 += ls;
            return al;
        };
        auto pv = [&](int sl, const f32x16& pa, const f32x16& pb, float al) {
            const LAS unsigned char* vb_ = lds + C::V0 + sl * C::VB + ((lane >> 4) & 1) * 32 + (lane & 3) * 8 + (4 * hi + ((lane & 15) >> 2)) * 64;
            bf16x8 pf[4];
            pf[0] = pack8(pa, 0); pf[1] = pack8(pa, 8); pf[2] = pack8(pb, 0); pf[3] = pack8(pb, 8);
            const bool resc = CROSS ? true : (__builtin_amdgcn_ballot_w64(al != 1.0f) != 0ull);
            if (CROSS) {
#pragma unroll
                for (int d = 0; d < ND; ++d) {
                    __builtin_amdgcn_sched_barrier(0);
#pragma unroll
                    for (int r = 0; r < 16; ++r) oA[d][r] *= al;
                    bf16x8 vf[4];
#pragma unroll
                    for (int s = 0; s < 4; ++s) { const s16x4 lo = vtr(vb_ + d * 4096 + s * 1024), hh = vtr(vb_ + d * 4096 + s * 1024 + 512); vf[s] = (bf16x8){lo[0], lo[1], lo[2], lo[3], hh[0], hh[1], hh[2], hh[3]}; }
#pragma unroll
                    for (int s = 0; s < 4; ++s) oA[d] = __builtin_amdgcn_mfma_f32_32x32x16_bf16(vf[s], pf[s], oA[d], 0, 0, 0);
                }
            } else if (DIFF) {
                if (resc) {
#pragma unroll
                    for (int d = 0; d < 2; ++d)
#pragma unroll
                        for (int r = 0; r < 16; ++r) oA[d][r] *= al;
                }
#pragma unroll
                for (int d = 0; d < 2; ++d) {
                    bf16x8 vf[4];
#pragma unroll
                    for (int s = 0; s < 4; ++s) { const s16x4 lo = vtr(vb_ + d * 4096 + s * 1024), hh = vtr(vb_ + d * 4096 + s * 1024 + 512); vf[s] = (bf16x8){lo[0], lo[1], lo[2], lo[3], hh[0], hh[1], hh[2], hh[3]}; }
                    __builtin_amdgcn_sched_barrier(0);
#pragma unroll
                    for (int s = 0; s < 4; ++s) oA[d] = __builtin_amdgcn_mfma_f32_32x32x16_bf16(vf[s], pf[s], oA[d], 0, 0, 0);
                }
            } else {
                bf16x8 vf[2][4];
#pragma unroll
                for (int d = 0; d < 2; ++d)
#pragma unroll
                    for (int s = 0; s < 4; ++s) { const s16x4 lo = vtr(vb_ + d * 4096 + s * 1024), hh = vtr(vb_ + d * 4096 + s * 1024 + 512); vf[d][s] = (bf16x8){lo[0], lo[1], lo[2], lo[3], hh[0], hh[1], hh[2], hh[3]}; }
                if (resc) {
#pragma unroll
                    for (int d = 0; d < 2; ++d)
#pragma unroll
                        for (int r = 0; r < 16; ++r) oA[d][r] *= al;
                }
                __builtin_amdgcn_sched_barrier(0);
#pragma unroll
                for (int s = 0; s < 4; ++s)
#pragma unroll
                    for (int d = 0; d < 2; ++d) oA[d] = __builtin_amdgcn_mfma_f32_32x32x16_bf16(vf[d][s], pf[s], oA[d], 0, 0, 0);
            }
        };
        if (CROSS) {
            gload(0); lstore(0);
            __syncthreads();
            for (int t = 0; t < NT; ++t) {
                const int buf = t & 1;
                f32x16 pa, pb;
                qk(buf, pa, pb, 0.f);
                const float al = sm(t, buf, pa, pb, false);
                pv(buf, pa, pb, al);
                if (t + 1 < NT) { gload(t + 1); lstore(buf ^ 1); }
                TILE_BAR();
            }
        } else {
            gload(0); lstore(0); gload(1); lstore(1);
            gload(2); gloadB(3);
            __syncthreads();
            if (DIFF) bias_far = ((LAS float*)(lds + C::BT))[128];
            const int NTW = (q0w + 31) / 64 + 1;
            constexpr bool lead = LEAD;
            f32x16 ca, cb, na, nb; bool cnear = isnear(0), nnear = false; float cal = 1.f;
            qk(0, ca, cb, (DIFF && !cnear) ? bias_far : 0.f);
            if (lead) cal = sm(0, 0, ca, cb, cnear);
            int s0 = 0, s1 = 1, s2 = 2;
            auto period = [&](int t, f32x16& xa, f32x16& xb, bool& xnear, f32x16& ya, f32x16& yb, bool& ynear) {
                const bool have_next = (t + 1 < NTW);
                if (lead) {
                    if (have_next) { ynear = isnear(s1); qk(s1, ya, yb, (DIFF && !ynear) ? bias_far : 0.f); }
                    if (t < NTW) pv(s0, xa, xb, cal);
                    if (have_next) cal = sm(t + 1, s1, ya, yb, ynear);
                } else {
                    if (t < NTW) cal = sm(t, s0, xa, xb, xnear);
                    if (have_next) { ynear = isnear(s1); qk(s1, ya, yb, (DIFF && !ynear) ? bias_far : 0.f); }
                    if (t < NTW) pv(s0, xa, xb, cal);
                }
                { const int tmp = s0; s0 = s1; s1 = s2; s2 = tmp; }
            };
            int t = 0;
            for (; t + 5 < NT; t += 2) {
                lstore(s2); gload(t + 4);
                period(t, ca, cb, cnear, na, nb, nnear);
                TILE_BAR();
                lstoreB(s2); gloadB(t + 5);
                period(t + 1, na, nb, nnear, ca, cb, cnear);
                TILE_BAR();
            }
            for (; t < NT; t += 2) {
                if (t + 2 < NT) { lstore(s2); if (t + 4 < NT) gload(t + 4); }
                period(t, ca, cb, cnear, na, nb, nnear);
                TILE_BAR();
                if (t + 3 < NT) { lstoreB(s2); if (t + 5 < NT) gloadB(t + 5); }
                period(t + 1, na, nb, nnear, ca, cb, cnear);
                TILE_BAR();
            }
        }
        il = 1.f / swapadd(l1);
        if (DIFF) { if (mp == 0) {
#pragma unroll
            for (int d = 0; d < 2; ++d)
#pragma unroll
                for (int r = 0; r < 16; ++r) osv[(d * 16 + r) * 64] = oA[d][r] * il; } }
    }
    GAS bf16* orow = P.O + (rowb + qi) * P.op + (CROSS ? h * 256 + dhalf * 128 : h * 64);
    if (!DIFF) {
#pragma unroll
        for (int d = 0; d < ND; ++d)
#pragma unroll
            for (int g = 0; g < 4; ++g) { v2u v; v.x = cvtpk(oA[d][4 * g] * il, oA[d][4 * g + 1] * il); v.y = cvtpk(oA[d][4 * g + 2] * il, oA[d][4 * g + 3] * il); *(GAS v2u*)(orow + 32 * d + 8 * g + 4 * hi) = v; }
    } else {
        const float lam = P.lams[0], lam_init = P.lams[1];
        const float i2 = lam * il;
        float ss = 0.f;
#pragma unroll
        for (int d = 0; d < 2; ++d)
#pragma unroll
            for (int r = 0; r < 16; ++r) { const float v = osv[(d * 16 + r) * 64] - oA[d][r] * i2; oA[d][r] = v; ss += v * v; }
        ss = swapadd(ss);
        const float rs = __builtin_amdgcn_rsqf(ss * (1.f / 64.f) + 1e-6f) * (1.f - lam_init);
        const LAS float* dn = (const LAS float*)(lds + C::DN);
#pragma unroll
        for (int d = 0; d < 2; ++d)
#pragma unroll
            for (int g = 0; g < 4; ++g) { const int c = 32 * d + 8 * g + 4 * hi; const f32x4 gn = *(const LAS f32x4*)(dn + c);
                v2u v; v.x = cvtpk(oA[d][4 * g] * rs * gn[0], oA[d][4 * g + 1] * rs * gn[1]); v.y = cvtpk(oA[d][4 * g + 2] * rs * gn[2], oA[d][4 * g + 3] * rs * gn[3]); *(GAS v2u*)(orow + c) = v; }
    }
}

__device__ __forceinline__ int wave_max_i(int v) {
    { const int o = __builtin_amdgcn_update_dpp(0, v, 0xB1, 0xF, 0xF, true); v = o > v ? o : v; }
    { const int o = __builtin_amdgcn_update_dpp(0, v, 0x4E, 0xF, 0xF, true); v = o > v ? o : v; }
    { const int o = __builtin_amdgcn_update_dpp(0, v, 0x141, 0xF, 0xF, true); v = o > v ? o : v; }
    { const int o = __builtin_amdgcn_update_dpp(0, v, 0x140, 0xF, 0xF, true); v = o > v ? o : v; }
    { int a = v, b = v; asm volatile("v_nop\n\tv_nop\n\tv_permlane16_swap_b32 %0, %1" : "+v"(a), "+v"(b)); v = a > b ? a : b; }
    { int a = v, b = v; asm volatile("v_nop\n\tv_nop\n\tv_permlane32_swap_b32 %0, %1" : "+v"(a), "+v"(b)); v = a > b ? a : b; }
    return v;
}
template <int KIND> struct AK2 {
    static constexpr bool DIFF = KIND == 1;
    static constexpr int HW = KIND == 0 ? 96 : 64, NKS = KIND == 0 ? 6 : 2, KP = KIND == 0 ? 208 : 144;
    static constexpr int CPK = HW / 8, KCH = (128 * CPK) / 512, VCH = 2;
    static constexpr int KB = 128 * KP, VB = 2 * 8192;
    static constexpr int K0 = 0, V0 = 2 * KB, POS = V0 + 2 * VB, PMX = POS + 1024, BT = PMX + 16, DN = BT + 528, OSV = (DN + 256 + 15) & ~15, END = OSV + (DIFF ? 8 * 8192 : 0);
};
static_assert(AK2<0>::END <= RING_BYTES && AK2<1>::END <= RING_BYTES, "attention LDS (128-key tiles)");
template <int KIND>
__device__ __forceinline__ void attn_unit2(const AttnP& P, int b, int h, int qb, LAS unsigned char* lds, int tid, int wave, int lane) {
    lane = lane_id_v(); tid = (wave << 6) | lane;
    typedef AK2<KIND> C;
    constexpr bool DIFF = C::DIFF;
    constexpr int HW = C::HW, NKS = C::NKS, KP = C::KP, CPK = C::CPK, KCH = C::KCH, VCH = C::VCH;
    const int r32 = lane & 31, hi = lane >> 5;
    const size_t rowb = (size_t)b * S;
    const int q0w = qb * 256 + wave * 32, qi = q0w + r32;
    int pq = 0; float bias_far = 0.f;
    __syncthreads();
    if (DIFF) {
        pq = P.pos[rowb + qi];
        if (tid < 129) ((LAS float*)(lds + C::BT))[tid] = P.btab[h * 129 + tid];
        if (tid >= 192 && tid < 256) ((LAS float*)(lds + C::DN))[tid - 192] = P.dnorm[tid - 192];
    }
    int minq = pq;
    if (DIFF) minq = __builtin_amdgcn_readfirstlane(-wave_max_i(-pq));
    const int NT = 2 * (qb + 1);
    const GAS bf16* Kb = P.K + rowb * P.kp + h * HW; const GAS bf16* Vb = P.V + rowb * P.vp + h * 64;
    const __amdgpu_buffer_rsrc_t rK = __builtin_amdgcn_make_buffer_rsrc((void*)Kb, 0, 0x7fffffff, 0x00020000), rV = __builtin_amdgcn_make_buffer_rsrc((void*)Vb, 0, 0x7fffffff, 0x00020000);
    const __amdgpu_buffer_rsrc_t rP = __builtin_amdgcn_make_buffer_rsrc((void*)(DIFF ? P.pos + rowb : (const GAS int*)Kb), 0, 0x7fffffff, 0x00020000);
    int kvo[KCH], vvo[VCH], klo[KCH], vlo[VCH];
#pragma unroll
    for (int i = 0; i < KCH; ++i) { const int c = tid + 512 * i; kvo[i] = ((c / CPK) * P.kp + (c % CPK) * 8) * 2; klo[i] = (c / CPK) * KP + (c % CPK) * 16; }
#pragma unroll
    for (int i = 0; i < VCH; ++i) { const int c = tid + 512 * i; const int key = c >> 3, part = c & 7; vvo[i] = (key * P.vp + part * 8) * 2; vlo[i] = (part >> 2) * 8192 + (key >> 3) * 512 + (key & 7) * 64 + (part & 3) * 16; }
    const int pvo = (tid & 127) * 4;
    u32x4 kr[KCH], vr[VCH]; int pkr = 0;
    auto gload = [&](int t) {
        const int ks = __builtin_amdgcn_readfirstlane(128 * t * P.kp * 2), vs = __builtin_amdgcn_readfirstlane(128 * t * P.vp * 2);
#pragma unroll
        for (int i = 0; i < KCH; ++i) kr[i] = __builtin_amdgcn_raw_buffer_load_b128(rK, kvo[i], ks, 0);
#pragma unroll
        for (int i = 0; i < VCH; ++i) vr[i] = __builtin_amdgcn_raw_buffer_load_b128(rV, vvo[i], vs, 0);
        if (DIFF) pkr = __builtin_amdgcn_raw_buffer_load_b32(rP, pvo, __builtin_amdgcn_readfirstlane(128 * t * 4), 0);
    };
    auto lstore = [&](int buf) {
        LAS unsigned char* kb_ = lds + C::K0 + buf * C::KB; LAS unsigned char* vb_ = lds + C::V0 + buf * C::VB;
#pragma unroll
        for (int i = 0; i < KCH; ++i) *(LAS u32x4*)(kb_ + klo[i]) = kr[i];
#pragma unroll
        for (int i = 0; i < VCH; ++i) *(LAS u32x4*)(vb_ + vlo[i]) = vr[i];
        if (DIFF) { ((LAS int*)(lds + C::POS + buf * 512))[tid & 127] = pkr;
            if (tid < 128) { const int mk_ = wave_max_i(pkr); if (lane == 0) ((LAS int*)(lds + C::PMX))[buf * 2 + wave] = mk_; } }
    };
    LAS float* osv = (LAS float*)(lds + C::OSV) + wave * 2048 + lane;
    float il = 0.f;
    f32x16 oA[2];
#pragma unroll 1
    for (int mp = 0; mp < (DIFF ? 2 : 1); ++mp) {
        bf16x8 qf[NKS];
        { const GAS bf16* qrow = P.Q + (rowb + qi) * P.qp + h * HW + mp * 32;
#pragma unroll
          for (int s = 0; s < NKS; ++s) qf[s] = *(const GAS bf16x8*)(qrow + 16 * s + 8 * hi);
          if (KIND == 0) {
              const GAS float* rp = P.rope + (rowb + qi) * 32 + 8 * hi;
              const f32x4 c0 = *(const GAS f32x4*)rp, c1 = *(const GAS f32x4*)(rp + 4), s0 = *(const GAS f32x4*)(rp + 16), s1 = *(const GAS f32x4*)(rp + 20);
              const u32x4 a = __builtin_bit_cast(u32x4, qf[NKS - 2]), bq = __builtin_bit_cast(u32x4, qf[NKS - 1]); u32x4 ra, rb;
#pragma unroll
              for (int w = 0; w < 4; ++w) { const float cl = w < 2 ? c0[2 * w] : c1[2 * w - 4], ch = w < 2 ? c0[2 * w + 1] : c1[2 * w - 3], sl = w < 2 ? s0[2 * w] : s1[2 * w - 4], sh = w < 2 ? s0[2 * w + 1] : s1[2 * w - 3];
                  const float x1l = bflo(a[w]), x1h = bfhi(a[w]), x2l = bflo(bq[w]), x2h = bfhi(bq[w]);
                  ra[w] = cvtpk(x1l * cl - x2l * sl, x1h * ch - x2h * sh); rb[w] = cvtpk(x1l * sl + x2l * cl, x1h * sh + x2h * ch); }
              qf[NKS - 2] = __builtin_bit_cast(bf16x8, ra); qf[NKS - 1] = __builtin_bit_cast(bf16x8, rb);
          } }
        __syncthreads();
        float m1 = 0.f, l1 = 0.f;
        f32x16 negm;
#pragma unroll
        for (int r = 0; r < 16; ++r) negm[r] = 0.f;
#pragma unroll
        for (int d = 0; d < 2; ++d)
#pragma unroll
            for (int r = 0; r < 16; ++r) oA[d][r] = 0.f;
        gload(0); lstore(0);
        if (NT > 1) gload(1);
        __syncthreads();
        if (DIFF) { bias_far = ((LAS float*)(lds + C::BT))[128];
#pragma unroll
            for (int r = 0; r < 16; ++r) negm[r] = bias_far; }
        const int NTW = (q0w + 31) / 128 + 1;
        auto compute = [&](int t, int buf) {
            const int k0 = 128 * t;
            const LAS unsigned char* kb_ = lds + C::K0 + buf * C::KB + r32 * KP + hi * 16 + mp * 64;
            const LAS unsigned char* vb_ = lds + C::V0 + buf * C::VB + ((lane >> 4) & 1) * 32 + (lane & 3) * 8 + (4 * hi + ((lane & 15) >> 2)) * 64;
            bool nearb = false;
            if (DIFF) { const LAS int* pm = (const LAS int*)(lds + C::PMX) + buf * 2; const int m0 = __builtin_amdgcn_readfirstlane(pm[0]), m1_ = __builtin_amdgcn_readfirstlane(pm[1]); nearb = (minq - (m0 > m1_ ? m0 : m1_)) < 128; }
            f32x16 sc[4];
            if (DIFF) { if (nearb) {
#pragma unroll
                for (int g = 0; g < 4; ++g)
#pragma unroll
                    for (int r = 0; r < 16; ++r) sc[g][r] = -m1; } }
            constexpr int HB = NKS > 3 ? 3 : NKS;
#pragma unroll
            for (int s0_ = 0; s0_ < NKS; s0_ += HB) {
                bf16x8 kf[4][HB];
#pragma unroll
                for (int g = 0; g < 4; ++g)
#pragma unroll
                    for (int s = 0; s < HB; ++s) kf[g][s] = *(const LAS bf16x8*)(kb_ + 32 * g * KP + (s0_ + s) * 32);
                __builtin_amdgcn_sched_barrier(0);
#pragma unroll
                for (int s = 0; s < HB; ++s)
#pragma unroll
                    for (int g = 0; g < 4; ++g) {
                        if (s0_ + s == 0 && !(DIFF && nearb)) sc[g] = __builtin_amdgcn_mfma_f32_32x32x16_bf16(kf[g][s], qf[s0_ + s], negm, 0, 0, 0);
                        else sc[g] = __builtin_amdgcn_mfma_f32_32x32x16_bf16(kf[g][s], qf[s0_ + s], sc[g], 0, 0, 0); }
                __builtin_amdgcn_sched_barrier(0);
            }
            if (DIFF) { if (nearb) {
                const LAS int* pk = (const LAS int*)(lds + C::POS + buf * 512); const LAS float* bt = (const LAS float*)(lds + C::BT);
#pragma unroll
                for (int g = 0; g < 4; ++g)
#pragma unroll
                    for (int r = 0; r < 16; ++r) { int n0 = pq - pk[32 * g + crow(r, hi)]; n0 = n0 < 0 ? 0 : (n0 > 128 ? 128 : n0); sc[g][r] += bt[n0]; }
            } }
            asm volatile("s_nop 15\n\ts_nop 7" : "+v"(sc[0]), "+v"(sc[1]), "+v"(sc[2]), "+v"(sc[3]));
            if (k0 + 127 > q0w) {
#pragma unroll
                for (int g = 0; g < 4; ++g)
#pragma unroll
                    for (int r = 0; r < 16; ++r) { if (k0 + 32 * g + crow(r, hi) > qi) sc[g][r] = -1e30f; }
            }
            const float mx = swapmax(vmax3(max32(sc[0], sc[1]), max32(sc[2], sc[3]), -1e30f));
            const bool up = (t == 0) || mx > 8.0f;
            float al = 1.f;
            if (__builtin_amdgcn_ballot_w64(up) != 0ull) {
                const float dl = up ? mx : 0.f; al = __builtin_amdgcn_exp2f(-dl); l1 *= al; m1 += dl;
#pragma unroll
                for (int r = 0; r < 16; ++r) negm[r] -= dl;
#pragma unroll
                for (int g = 0; g < 4; ++g)
#pragma unroll
                    for (int r = 0; r < 16; ++r) sc[g][r] -= dl;
            }
            float ls = 0.f;
#pragma unroll
            for (int g = 0; g < 4; ++g)
#pragma unroll
                for (int r = 0; r < 16; ++r) { sc[g][r] = __builtin_amdgcn_exp2f(sc[g][r]); ls += sc[g][r]; }
            l1 += ls;
            bf16x8 pf[8];
#pragma unroll
            for (int g = 0; g < 4; ++g) { pf[2 * g] = pack8(sc[g], 0); pf[2 * g + 1] = pack8(sc[g], 8); }
            if (__builtin_amdgcn_ballot_w64(al != 1.0f) != 0ull) {
#pragma unroll
                for (int d = 0; d < 2; ++d)
#pragma unroll
                    for (int r = 0; r < 16; ++r) oA[d][r] *= al;
            }
#pragma unroll
            for (int d = 0; d < 2; ++d) {
                bf16x8 vf[8];
#pragma unroll
                for (int s = 0; s < 8; ++s) { const s16x4 lo = vtr(vb_ + d * 8192 + s * 1024), hh = vtr(vb_ + d * 8192 + s * 1024 + 512); vf[s] = (bf16x8){lo[0], lo[1], lo[2], lo[3], hh[0], hh[1], hh[2], hh[3]}; }
                __builtin_amdgcn_sched_barrier(0);
#pragma unroll
                for (int s = 0; s < 8; ++s) oA[d] = __builtin_amdgcn_mfma_f32_32x32x16_bf16(vf[s], pf[s], oA[d], 0, 0, 0);
                __builtin_amdgcn_sched_barrier(0);
            }
        };
        int t = 0;
        for (; t + 2 < NT; ++t) {
            const int buf = t & 1;
            if (t < NTW) compute(t, buf);
            lstore(buf ^ 1); gload(t + 2);
            TILE_BAR();
        }
        for (; t < NT; ++t) {
            const int buf = t & 1;
            if (t < NTW) compute(t, buf);
            if (t + 1 < NT) lstore(buf ^ 1);
            TILE_BAR();
        }
        il = 1.f / swapadd(l1);
        if (DIFF) { if (mp == 0) {
#pragma unroll
            for (int d = 0; d < 2; ++d)
#pragma unroll
                for (int r = 0; r < 16; ++r) osv[(d * 16 + r) * 64] = oA[d][r] * il; } }
    }
    GAS bf16* orow = P.O + (rowb + qi) * P.op + h * 64;
    if (!DIFF) {
#pragma unroll
        for (int d = 0; d < 2; ++d)
#pragma unroll
            for (int g = 0; g < 4; ++g) { v2u v; v.x = cvtpk(oA[d][4 * g] * il, oA[d][4 * g + 1] * il); v.y = cvtpk(oA[d][4 * g + 2] * il, oA[d][4 * g + 3] * il); *(GAS v2u*)(orow + 32 * d + 8 * g + 4 * hi) = v; }
    } else {
        const float lam = P.lams[0], lam_init = P.lams[1];
        const float i2 = lam * il;
        float ss = 0.f;
#pragma unroll
        for (int d = 0; d < 2; ++d)
#pragma unroll
            for (int r = 0; r < 16; ++r) { const float v = osv[(d * 16 + r) * 64] - oA[d][r] * i2; oA[d][r] = v; ss += v * v; }
        ss = swapadd(ss);
        const float rs = __builtin_amdgcn_rsqf(ss * (1.f / 64.f) + 1e-6f) * (1.f - lam_init);
        const LAS float* dn = (const LAS float*)(lds + C::DN);
#pragma unroll
        for (int d = 0; d < 2; ++d)
#pragma unroll
            for (int g = 0; g < 4; ++g) { const int c = 32 * d + 8 * g + 4 * hi; const f32x4 gn = *(const LAS f32x4*)(dn + c);
                v2u v; v.x = cvtpk(oA[d][4 * g] * rs * gn[0], oA[d][4 * g + 1] * rs * gn[1]); v.y = cvtpk(oA[d][4 * g + 2] * rs * gn[2], oA[d][4 * g + 3] * rs * gn[3]); *(GAS v2u*)(orow + c) = v; }
    }
}

__device__ __forceinline__ void attn_phase(const AttnP& PM, const AttnP& PD, LAS unsigned char* lds, int tid, int wave, int lane, int vcu, int G, int only = -1) {
    for (int i = vcu; i < 512; i += G) {
        if (only >= 0 && (i >> 8) != only) continue;
        const int kind = i >> 8, c = i & 255, bh = c >> 4, s = c & 15;
        if (kind == 0) {
#pragma unroll 1
            for (int k = 0; k < 2; ++k) attn_unit2<0>(PM, bh >> 2, bh & 3, k ? 31 - s : s, lds, tid, wave, lane);
        } else {
#pragma unroll 1
            for (int k = 0; k < 2; ++k) attn_unit2<1>(PD, bh >> 2, bh & 3, k ? 31 - s : s, lds, tid, wave, lane);
        }
    }
}
__device__ __forceinline__ float cx_max16(const f32x16& p) { return fmaxf(fmaxf(fmaxf(fmaxf(p[0], p[1]), fmaxf(p[2], p[3])), fmaxf(fmaxf(p[4], p[5]), fmaxf(p[6], p[7]))), fmaxf(fmaxf(fmaxf(p[8], p[9]), fmaxf(p[10], p[11])), fmaxf(fmaxf(p[12], p[13]), fmaxf(p[14], p[15])))); }
__device__ __forceinline__ void cross_unit2(const AttnP& P, int b, int h, int qb, LAS unsigned char* lds, int wave) {
    const int lane = lane_id_v(), tid = (wave << 6) | lane;
    constexpr int KP = 528;
    const int r32 = lane & 31, hi = lane >> 5;
    const size_t rowb = (size_t)b * S, rowk = (size_t)b * MEM;
    const int qi = qb * 256 + wave * 32 + r32;
    const GAS bf16* Kb = P.K + rowk * P.kp + h * 256; const GAS bf16* Vb = P.V + rowk * P.vp + h * 256;
    const __amdgpu_buffer_rsrc_t rK = __builtin_amdgcn_make_buffer_rsrc((void*)Kb, 0, 0x7fffffff, 0x00020000), rV = __builtin_amdgcn_make_buffer_rsrc((void*)Vb, 0, 0x7fffffff, 0x00020000);
    const GAS bf16* qrow = P.Q + (rowb + qi) * P.qp + h * 256 + 8 * hi;
    bf16x8 qf[4];
#pragma unroll
    for (int s = 0; s < 4; ++s) qf[s] = *(const GAS bf16x8*)(qrow + 16 * s);
    { u32x4 st[16];
#pragma unroll
      for (int i = 0; i < 16; ++i) { const int c = tid + 512 * i; st[i] = __builtin_amdgcn_raw_buffer_load_b128(rK, ((c >> 5) * P.kp + (c & 31) * 8) * 2, 0, 0); }
      TILE_BAR();
#pragma unroll
      for (int i = 0; i < 16; ++i) { const int c = tid + 512 * i; *(LAS u32x4*)(lds + (c >> 5) * KP + (c & 31) * 16) = st[i]; } }
    __syncthreads();
    f32x16 sc[8];
#pragma unroll
    for (int g = 0; g < 8; ++g)
#pragma unroll
        for (int r = 0; r < 16; ++r) sc[g][r] = 0.f;
    const LAS unsigned char* kb_ = lds + r32 * KP + hi * 16;
#pragma unroll
    for (int c = 0; c < 4; ++c) {
        bf16x8 qn[4];
        if (c + 1 < 4) {
#pragma unroll
            for (int s = 0; s < 4; ++s) qn[s] = *(const GAS bf16x8*)(qrow + 64 * (c + 1) + 16 * s); }
#pragma unroll
        for (int g = 0; g < 8; ++g) { bf16x8 kf[4];
#pragma unroll
            for (int s = 0; s < 4; ++s) kf[s] = *(const LAS bf16x8*)(kb_ + 32 * g * KP + (4 * c + s) * 32);
#pragma unroll
            for (int s = 0; s < 4; ++s) sc[g] = __builtin_amdgcn_mfma_f32_32x32x16_bf16(kf[s], qf[s], sc[g], 0, 0, 0); }
        if (c + 1 < 4) {
#pragma unroll
            for (int s = 0; s < 4; ++s) qf[s] = qn[s]; }
    }
    float m = fmaxf(fmaxf(fmaxf(cx_max16(sc[0]), cx_max16(sc[1])), fmaxf(cx_max16(sc[2]), cx_max16(sc[3]))), fmaxf(fmaxf(cx_max16(sc[4]), cx_max16(sc[5])), fmaxf(cx_max16(sc[6]), cx_max16(sc[7]))));
    m = swapmax(m);
    float l = 0.f;
    bf16x8 pf[16];
#pragma unroll
    for (int g = 0; g < 8; ++g) {
#pragma unroll
        for (int r = 0; r < 16; ++r) { sc[g][r] = __builtin_amdgcn_exp2f(sc[g][r] - m); l += sc[g][r]; }
        pf[2 * g] = pack8(sc[g], 0); pf[2 * g + 1] = pack8(sc[g], 8); }
    const float il = 1.f / swapadd(l);
    { u32x4 st[16];
#pragma unroll
      for (int i = 0; i < 16; ++i) { const int c = tid + 512 * i; const int sub = c & 3, key = (c >> 2) & 255, dt = c >> 10; st[i] = __builtin_amdgcn_raw_buffer_load_b128(rV, (key * P.vp + dt * 32 + sub * 8) * 2, 0, 0); }
      TILE_BAR();
#pragma unroll
      for (int i = 0; i < 16; ++i) { const int c = tid + 512 * i; const int sub = c & 3, key = (c >> 2) & 255, dt = c >> 10; *(LAS u32x4*)(lds + dt * 16384 + (key >> 3) * 512 + (key & 7) * 64 + sub * 16) = st[i]; } }
    __syncthreads();
    const LAS unsigned char* vb_ = lds + ((lane >> 4) & 1) * 32 + (lane & 3) * 8 + (4 * hi + ((lane & 15) >> 2)) * 64;
    GAS bf16* orow = P.O + (rowb + qi) * P.op + h * 256;
#pragma unroll 1
    for (int dh = 0; dh < 2; ++dh) {
        f32x16 oA[4];
#pragma unroll
        for (int d = 0; d < 4; ++d)
#pragma unroll
            for (int r = 0; r < 16; ++r) oA[d][r] = 0.f;
#pragma unroll
        for (int d = 0; d < 4; ++d) {
#pragma unroll
            for (int sb = 0; sb < 2; ++sb) { bf16x8 vf[8];
#pragma unroll
                for (int s = 0; s < 8; ++s) { const s16x4 lo = vtr(vb_ + (4 * dh + d) * 16384 + (8 * sb + s) * 1024), hh = vtr(vb_ + (4 * dh + d) * 16384 + (8 * sb + s) * 1024 + 512); vf[s] = (bf16x8){lo[0], lo[1], lo[2], lo[3], hh[0], hh[1], hh[2], hh[3]}; }
#pragma unroll
                for (int s = 0; s < 8; ++s) oA[d] = __builtin_amdgcn_mfma_f32_32x32x16_bf16(vf[s], pf[8 * sb + s], oA[d], 0, 0, 0); } }
#pragma unroll
        for (int d = 0; d < 4; ++d)
#pragma unroll
            for (int g = 0; g < 4; ++g) { v2u v; v.x = cvtpk(oA[d][4 * g] * il, oA[d][4 * g + 1] * il); v.y = cvtpk(oA[d][4 * g + 2] * il, oA[d][4 * g + 3] * il); *(GAS v2u*)(orow + 128 * dh + 32 * d + 8 * g + 4 * hi) = v; }
    }
}
__device__ __forceinline__ void cross_phase(const AttnP& PC, LAS unsigned char* lds, int tid, int wave, int lane, int vcu, int G) {
#pragma unroll 1
    for (int i = vcu; i < 512; i += G) { const int bh = i >> 5; cross_unit2(PC, bh >> 2, bh & 3, i & 31, lds, wave); }
}


__device__ __forceinline__ float vmax2(float a, float b) { float r; asm("v_max_f32_e32 %0, %1, %2" : "=v"(r) : "v"(a), "v"(b)); return r; }
__device__ __forceinline__ float vmin2(float a, float b) { float r; asm("v_min_f32_e32 %0, %1, %2" : "=v"(r) : "v"(a), "v"(b)); return r; }
__device__ __forceinline__ void pad16(float (&a)[16]) {
    asm volatile("s_nop 1" : "+v"(a[0]), "+v"(a[1]), "+v"(a[2]), "+v"(a[3]), "+v"(a[4]), "+v"(a[5]), "+v"(a[6]), "+v"(a[7]), "+v"(a[8]), "+v"(a[9]), "+v"(a[10]), "+v"(a[11]), "+v"(a[12]), "+v"(a[13]), "+v"(a[14]), "+v"(a[15]));
}
__device__ __forceinline__ void sort16_desc(float (&a)[16]) {
#pragma unroll
    for (int k = 2; k <= 16; k <<= 1)
#pragma unroll
        for (int j = k >> 1; j > 0; j >>= 1)
#pragma unroll
            for (int i = 0; i < 16; ++i) { const int l = i ^ j; if (l > i) { const bool desc = ((i & k) == 0); const float hi_ = vmax2(a[i], a[l]), lo_ = vmin2(a[i], a[l]); a[i] = desc ? hi_ : lo_; a[l] = desc ? lo_ : hi_; } }
}
__device__ __forceinline__ void merge16_desc(float (&a)[16], const float (&b)[16]) {
#pragma unroll
    for (int i = 0; i < 16; ++i) a[i] = vmax2(a[i], b[15 - i]);
#pragma unroll
    for (int j = 8; j > 0; j >>= 1)
#pragma unroll
        for (int i = 0; i < 16; ++i) { const int l = i ^ j; if (l > i) { const float hi_ = vmax2(a[i], a[l]), lo_ = vmin2(a[i], a[l]); a[i] = hi_; a[l] = lo_; } }
}
__device__ __forceinline__ void top16_of_64(float (&g0)[16], float (&g1)[16], float (&g2)[16], float (&g3)[16]) {
    sort16_desc(g0); sort16_desc(g1); merge16_desc(g0, g1); sort16_desc(g2); sort16_desc(g3); merge16_desc(g2, g3); merge16_desc(g0, g2);
}
__device__ __forceinline__ float embed(float v, unsigned mask, unsigned id) { return __builtin_bit_cast(float, (__builtin_bit_cast(unsigned, v) & mask) | id); }
__device__ __forceinline__ float mkcand(float x, float y, unsigned id) { return embed(x + y, 0xFFFFFF00u, id); }

__device__ __forceinline__ void swap32(float& a, float& b) { asm volatile("v_nop\n\tv_nop\n\tv_permlane32_swap_b32 %0, %1" : "+v"(a), "+v"(b)); }
struct RouteP { const GAS bf16* QP; const GAS bf16* keys; GAS int* EX; GAS float* GW; };
constexpr int RT_KP = 144, RT_KEYS = 0, RT_SCR = 256 * RT_KP, RT_END = RT_SCR + 8 * 8192;
__device__ __forceinline__ void route_phase(const RouteP& P, LAS unsigned char* lds, int tid, int wave, int lane, int vcu, int G) {
    asm volatile("" : "+v"(tid), "+v"(lane));
    __syncthreads();
    for (int c = tid; c < 256 * 8; c += 512) { const int row = c >> 3, part = c & 7; *(LAS u32x4*)(lds + RT_KEYS + row * RT_KP + part * 16) = *(const u32x4*)(P.keys + row * 64 + part * 8); }
    __syncthreads();
    const int r32 = lane & 31, hi = lane >> 5;
    LAS int* scr = (LAS int*)(lds + RT_SCR + wave * 8192);
    for (int u = vcu; u < T / 32; u += G) {
        const size_t t = (size_t)u * 32 + r32; const int h = wave;
        float T2[2][16];
#pragma unroll
        for (int c = 0; c < 2; ++c) {
            bf16x8 qf[4];
            { const GAS bf16* q = P.QP + t * 1024 + h * 128 + c * 64 + 8 * hi;
#pragma unroll
              for (int s = 0; s < 4; ++s) qf[s] = *(const GAS bf16x8*)(q + 16 * s); }
            f32x16 sc[4];
#pragma unroll
            for (int m = 0; m < 4; ++m) {
#pragma unroll
                for (int r = 0; r < 16; ++r) sc[m][r] = 0.f;
#pragma unroll
                for (int s = 0; s < 4; ++s) { const bf16x8 a = *(const LAS bf16x8*)(lds + RT_KEYS + (c * 128 + 32 * m + r32) * RT_KP + s * 32 + hi * 16);
                    sc[m] = __builtin_amdgcn_mfma_f32_32x32x16_bf16(a, qf[s], sc[m], 0, 0, 0); }
            }
            float g0[16], g1[16], g2[16], g3[16];
            const unsigned h4 = 4u * (unsigned)hi;
#pragma unroll
            for (int r = 0; r < 16; ++r) { const unsigned kr_ = (unsigned)((r & 3) + 8 * (r >> 2));
                g0[r] = embed(sc[0][r], 0xFFFFFF80u, kr_ | h4); g1[r] = embed(sc[1][r], 0xFFFFFF80u, (32u + kr_) | h4); g2[r] = embed(sc[2][r], 0xFFFFFF80u, (64u + kr_) | h4); g3[r] = embed(sc[3][r], 0xFFFFFF80u, (96u + kr_) | h4); }
            top16_of_64(g0, g1, g2, g3);
            pad16(g0);
#pragma unroll
            for (int i = 0; i < 16; ++i) T2[c][i] = g0[i];
        }
        float A[16], Bv[16];
#pragma unroll
        for (int i = 0; i < 16; ++i) { A[i] = T2[0][i]; Bv[i] = T2[1][i]; swap32(A[i], Bv[i]); }
        merge16_desc(A, Bv);
        pad16(A);
        float T0[16], T1[16];
#pragma unroll
        for (int i = 0; i < 16; ++i) { T0[i] = A[i]; T1[i] = A[i]; swap32(T0[i], T1[i]); }
#pragma unroll
        for (int i = 0; i < 16; ++i) { scr[i * 64 + lane] = (int)(__builtin_bit_cast(unsigned, T0[i]) & 127u); scr[(16 + i) * 64 + lane] = (int)(__builtin_bit_cast(unsigned, T1[i]) & 127u);
            T0[i] = embed(T0[i], 0xFFFFFF80u, 0u); T1[i] = embed(T1[i], 0xFFFFFF80u, 0u); }
        float c0[16], c1[16], c2[16], c3[16];
        const float NINF = -__builtin_inff();
#pragma unroll
        for (int b = 0; b < 16; ++b) c0[b] = mkcand(T0[0], T1[b], (unsigned)b);
#pragma unroll
        for (int b = 0; b < 8; ++b) c1[b] = mkcand(T0[1], T1[b], 16u + b);
#pragma unroll
        for (int b = 0; b < 5; ++b) c1[8 + b] = mkcand(T0[2], T1[b], 32u + b);
#pragma unroll
        for (int b = 0; b < 3; ++b) c1[13 + b] = mkcand(T0[4], T1[b], 64u + b);
#pragma unroll
        for (int b = 0; b < 4; ++b) c2[b] = mkcand(T0[3], T1[b], 48u + b);
        c2[4] = mkcand(T0[5], T1[0], 80u); c2[5] = mkcand(T0[5], T1[1], 81u); c2[6] = mkcand(T0[6], T1[0], 96u); c2[7] = mkcand(T0[6], T1[1], 97u); c2[8] = mkcand(T0[7], T1[0], 112u); c2[9] = mkcand(T0[7], T1[1], 113u);
#pragma unroll
        for (int a = 8; a < 14; ++a) c2[10 + a - 8] = mkcand(T0[a], T1[0], 16u * a);
        c3[0] = mkcand(T0[14], T1[0], 224u); c3[1] = mkcand(T0[15], T1[0], 240u);
#pragma unroll
        for (int i = 2; i < 16; ++i) c3[i] = NINF;
        top16_of_64(c0, c1, c2, c3);
        pad16(c0);
        float gsum = 0.f, ge[16]; int ex[16];
        const float mtop = embed(c0[0], 0xFFFFFF00u, 0u);
#pragma unroll
        for (int i = 0; i < 16; ++i) { const unsigned bits = __builtin_bit_cast(unsigned, c0[i]); const int a = (bits >> 4) & 15, b = bits & 15;
            ge[i] = __builtin_amdgcn_exp2f((embed(c0[i], 0xFFFFFF00u, 0u) - mtop) * LOG2E); gsum += ge[i];
            ex[i] = scr[a * 64 + lane] * 128 + scr[(16 + b) * 64 + lane]; }
        const float ginv = __builtin_amdgcn_rcpf(gsum);
        if (hi == 0) { GAS v4u* d = (GAS v4u*)(P.EX + t * 128 + h * 16);
#pragma unroll
            for (int i = 0; i < 4; ++i) d[i] = (v4u){(unsigned)ex[4 * i], (unsigned)ex[4 * i + 1], (unsigned)ex[4 * i + 2], (unsigned)ex[4 * i + 3]}; }
        else { GAS f32x4* d = (GAS f32x4*)(P.GW + t * 128 + h * 16);
#pragma unroll
            for (int i = 0; i < 4; ++i) d[i] = (f32x4){ge[4 * i] * ginv, ge[4 * i + 1] * ginv, ge[4 * i + 2] * ginv, ge[4 * i + 3] * ginv}; }
    }
}

__device__ __forceinline__ int wave_allsum_i(int v) {
    v += __builtin_amdgcn_update_dpp(0, v, 0xB1, 0xF, 0xF, true);
    v += __builtin_amdgcn_update_dpp(0, v, 0x4E, 0xF, 0xF, true);
    v += __builtin_amdgcn_update_dpp(0, v, 0x141, 0xF, 0xF, true);
    v += __builtin_amdgcn_update_dpp(0, v, 0x140, 0xF, 0xF, true);
    { int a = v, b = v; asm volatile("v_nop\n\tv_nop\n\tv_permlane16_swap_b32 %0, %1" : "+v"(a), "+v"(b)); v = a + b; }
    { int a = v, b = v; asm volatile("v_nop\n\tv_nop\n\tv_permlane32_swap_b32 %0, %1" : "+v"(a), "+v"(b)); v = a + b; }
    return v;
}
__device__ __forceinline__ float wave_allsum(float v) {
    v += __builtin_bit_cast(float, __builtin_amdgcn_update_dpp(0, __builtin_bit_cast(int, v), 0xB1, 0xF, 0xF, true));
    v += __builtin_bit_cast(float, __builtin_amdgcn_update_dpp(0, __builtin_bit_cast(int, v), 0x4E, 0xF, 0xF, true));
    v += __builtin_bit_cast(float, __builtin_amdgcn_update_dpp(0, __builtin_bit_cast(int, v), 0x141, 0xF, 0xF, true));
    v += __builtin_bit_cast(float, __builtin_amdgcn_update_dpp(0, __builtin_bit_cast(int, v), 0x140, 0xF, 0xF, true));
    { float a = v, b = v; asm volatile("v_nop\n\tv_nop\n\tv_permlane16_swap_b32 %0, %1" : "+v"(a), "+v"(b)); v = a + b; }
    { float a = v, b = v; asm volatile("v_nop\n\tv_nop\n\tv_permlane32_swap_b32 %0, %1" : "+v"(a), "+v"(b)); v = a + b; }
    return v;
}
__device__ __forceinline__ float wave_allmax(float v) {
    v = fmaxf(v, __builtin_bit_cast(float, __builtin_amdgcn_update_dpp(0, __builtin_bit_cast(int, v), 0xB1, 0xF, 0xF, true)));
    v = fmaxf(v, __builtin_bit_cast(float, __builtin_amdgcn_update_dpp(0, __builtin_bit_cast(int, v), 0x4E, 0xF, 0xF, true)));
    v = fmaxf(v, __builtin_bit_cast(float, __builtin_amdgcn_update_dpp(0, __builtin_bit_cast(int, v), 0x141, 0xF, 0xF, true)));
    v = fmaxf(v, __builtin_bit_cast(float, __builtin_amdgcn_update_dpp(0, __builtin_bit_cast(int, v), 0x140, 0xF, 0xF, true)));
    { float a = v, b = v; asm volatile("v_nop\n\tv_nop\n\tv_permlane16_swap_b32 %0, %1" : "+v"(a), "+v"(b)); v = fmaxf(a, b); }
    { float a = v, b = v; asm volatile("v_nop\n\tv_nop\n\tv_permlane32_swap_b32 %0, %1" : "+v"(a), "+v"(b)); v = fmaxf(a, b); }
    return v;
}
__device__ __forceinline__ unsigned q4(float a, float b, float c, float d, int off) {
    const int ia = (int)__builtin_rintf(a) + off, ib = (int)__builtin_rintf(b) + off, ic = (int)__builtin_rintf(c) + off, id = (int)__builtin_rintf(d) + off;
    return (unsigned)(ia & 255) | ((unsigned)(ib & 255) << 8) | ((unsigned)(ic & 255) << 16) | ((unsigned)(id & 255) << 24);
}
__device__ __forceinline__ void quant_row(const GAS float* src, GAS unsigned* dst, GAS float* scale, int off, int lane) {
    const GAS f32x4* s = (const GAS f32x4*)src + 4 * lane; f32x4 v[4]; float m = 0.f;
#pragma unroll
    for (int i = 0; i < 4; ++i) { v[i] = s[i]; m = fmaxf(m, fmaxf(fmaxf(__builtin_fabsf(v[i].x), __builtin_fabsf(v[i].y)), fmaxf(__builtin_fabsf(v[i].z), __builtin_fabsf(v[i].w)))); }
    m = wave_allmax(m); const float inv = m > 0.f ? 127.f / m : 0.f;
    v4u w;
    w.x = q4(v[0].x * inv, v[0].y * inv, v[0].z * inv, v[0].w * inv, off); w.y = q4(v[1].x * inv, v[1].y * inv, v[1].z * inv, v[1].w * inv, off);
    w.z = q4(v[2].x * inv, v[2].y * inv, v[2].z * inv, v[2].w * inv, off); w.w = q4(v[3].x * inv, v[3].y * inv, v[3].z * inv, v[3].w * inv, off);
    *((GAS v4u*)dst + lane) = w;
    if (lane == 0) *scale = m * (1.f / 127.f);
}
struct PeerS { int nslices_step, first_slice, nloc, rank; };
__device__ __forceinline__ PeerS peer_sched(const GAS unsigned* rankw, int xcc, int rank) {
    int nx = 0, myidx = 0, nloc = 1;
    for (int j = 0; j < 16; ++j) { const int c = (int)__hip_atomic_load(rankw + 64 * j, __ATOMIC_RELAXED, __HIP_MEMORY_SCOPE_AGENT); if (c > 0) { if (j == xcc) { myidx = nx; nloc = c; } ++nx; } }
    PeerS s; s.nslices_step = nx > 0 ? nx : 1; s.first_slice = myidx; s.nloc = nloc; s.rank = rank; return s;
}
struct Peer1P { const GAS unsigned GAS char* HQ; const GAS int* EX; const GAS unsigned GAS char* U8; GAS int* P; };
__device__ __forceinline__ void peer_k1(const Peer1P& Q, const PeerS& sc, int wave, int lane) {
    asm volatile("" : "+v"(lane));
    const int g = lane >> 3, j = lane & 7;
    for (int s = sc.first_slice; s < 8; s += sc.nslices_step)
        for (int tile = sc.rank; tile < T / 64; tile += sc.nloc) {
            const size_t t0 = (size_t)tile * 64 + wave * 8;
            v4u hqn = *(const GAS v4u*)(Q.HQ + t0 * 1024 + 128 * s + 16 * j), exn[4];
#pragma unroll
            for (int i = 0; i < 4; ++i) exn[i] = *(const GAS v4u*)(Q.EX + t0 * 128 + 16 * g + 4 * i);
#pragma unroll 1
            for (int k = 0; k < 8; ++k) {
                const size_t t = t0 + k;
                const v4u hq = hqn; v4u ex[4];
#pragma unroll
                for (int i = 0; i < 4; ++i) ex[i] = exn[i];
                if (k + 1 < 8) {
                    hqn = *(const GAS v4u*)(Q.HQ + (t + 1) * 1024 + 128 * s + 16 * j);
#pragma unroll
                    for (int i = 0; i < 4; ++i) exn[i] = *(const GAS v4u*)(Q.EX + (t + 1) * 128 + 16 * g + 4 * i);
                }
                v4u uu[16];
#pragma unroll
                for (int i = 0; i < 16; ++i) { const unsigned e = (i & 3) == 0 ? ex[i >> 2].x : (i & 3) == 1 ? ex[i >> 2].y : (i & 3) == 2 ? ex[i >> 2].z : ex[i >> 2].w;
                    uu[i] = *(const GAS v4u*)(Q.U8 + (size_t)e * 1024 + 128 * s + 16 * j); }
                int lo = 0, hi = 0;
#pragma unroll
                for (int i = 0; i < 16; ++i) {
                    int p = __builtin_amdgcn_sdot4((int)uu[i].x, (int)hq.x, 0, false); p = __builtin_amdgcn_sdot4((int)uu[i].y, (int)hq.y, p, false); p = __builtin_amdgcn_sdot4((int)uu[i].z, (int)hq.z, p, false); p = __builtin_amdgcn_sdot4((int)uu[i].w, (int)hq.w, p, false);
                    p += __builtin_amdgcn_update_dpp(0, p, 0xB1, 0xF, 0xF, true); p += __builtin_amdgcn_update_dpp(0, p, 0x4E, 0xF, 0xF, true); p += __builtin_amdgcn_update_dpp(0, p, 0x141, 0xF, 0xF, true);
                    if (i < 8) lo = (j == i) ? p : lo; else hi = (j == i - 8) ? p : hi;
                }
                GAS int* prow = Q.P + t * 128 + 16 * g + j;
                (void)__hip_atomic_fetch_add(prow, lo, __ATOMIC_RELAXED, __HIP_MEMORY_SCOPE_AGENT); (void)__hip_atomic_fetch_add(prow + 8, hi, __ATOMIC_RELAXED, __HIP_MEMORY_SCOPE_AGENT);
            }
        }
}
__device__ __forceinline__ void peer_w(const GAS int* EX, const GAS float* GW, const GAS int* P, const GAS float* SH, const GAS float* SU, const GAS float* SV, GAS signed char* WQ, GAS float* WSC, int gw, int NGW, int lane) {
    asm volatile("" : "+v"(lane));
    for (int t = gw; t < T; t += NGW) {
        const float sh = SH[t];
#pragma unroll
        for (int q = 0; q < 2; ++q) { const size_t idx = (size_t)t * 128 + lane + 64 * q; const int e = EX[idx];
            const float w = GW[idx] * gelu_erf((float)P[idx] * (sh * SU[e])) * SV[e];
            float m = __builtin_fabsf(w);
            m = fmaxf(m, __builtin_bit_cast(float, __builtin_amdgcn_update_dpp(0, __builtin_bit_cast(int, m), 0xB1, 0xF, 0xF, true)));
            m = fmaxf(m, __builtin_bit_cast(float, __builtin_amdgcn_update_dpp(0, __builtin_bit_cast(int, m), 0x4E, 0xF, 0xF, true)));
            m = fmaxf(m, __builtin_bit_cast(float, __builtin_amdgcn_update_dpp(0, __builtin_bit_cast(int, m), 0x141, 0xF, 0xF, true)));
            m = fmaxf(m, __builtin_bit_cast(float, __builtin_amdgcn_update_dpp(0, __builtin_bit_cast(int, m), 0x140, 0xF, 0xF, true)));
            const float inv = m > 0.f ? 127.f / m : 0.f;
            WQ[idx] = (signed char)(int)__builtin_rintf(w * inv);
            if ((lane & 15) == 0) WSC[(size_t)t * 8 + (lane >> 4) + 4 * q] = m * (1.f / 127.f); }
    }
}
__device__ __forceinline__ void tr4x4(unsigned r0, unsigned r1, unsigned r2, unsigned r3, unsigned (&t)[4]) {
    const unsigned x0 = __builtin_amdgcn_perm(r1, r0, 0x05010400u), x1 = __builtin_amdgcn_perm(r1, r0, 0x07030602u), y0 = __builtin_amdgcn_perm(r3, r2, 0x05010400u), y1 = __builtin_amdgcn_perm(r3, r2, 0x07030602u);
    t[0] = __builtin_amdgcn_perm(y0, x0, 0x05040100u); t[1] = __builtin_amdgcn_perm(y0, x0, 0x07060302u); t[2] = __builtin_amdgcn_perm(y1, x1, 0x05040100u); t[3] = __builtin_amdgcn_perm(y1, x1, 0x07060302u);
}
struct Peer2P { const GAS int* EX; const GAS signed char* WQ; const GAS float* WSC; const GAS unsigned char* V8; GAS bf16* XB; GAS float* SSQ; };
__device__ __forceinline__ void peer_k2(const Peer2P& Q, const PeerS& sc, int wave, int lane) {
    asm volatile("" : "+v"(lane));
    const int g = lane >> 3, j = lane & 7, hf = lane >> 5, rp = (lane >> 4) & 1;
    for (int s = sc.first_slice; s < 8; s += sc.nslices_step)
        for (int tile = sc.rank; tile < T / 64; tile += sc.nloc) {
            const size_t t0 = (size_t)tile * 64 + wave * 8;
            v4u exn[4], wqn; float swn;
#pragma unroll
            for (int i = 0; i < 4; ++i) exn[i] = *(const GAS v4u*)(Q.EX + t0 * 128 + 16 * g + 4 * i);
            wqn = *(const GAS v4u*)(Q.WQ + t0 * 128 + 16 * g); swn = Q.WSC[t0 * 8 + g];
#pragma unroll 1
            for (int k = 0; k < 8; ++k) {
                const size_t t = t0 + k;
                v4u ex[4]; const v4u wq = wqn; const float sw = swn;
#pragma unroll
                for (int i = 0; i < 4; ++i) ex[i] = exn[i];
                if (k + 1 < 8) {
#pragma unroll
                    for (int i = 0; i < 4; ++i) exn[i] = *(const GAS v4u*)(Q.EX + (t + 1) * 128 + 16 * g + 4 * i);
                    wqn = *(const GAS v4u*)(Q.WQ + (t + 1) * 128 + 16 * g); swn = Q.WSC[(t + 1) * 8 + g];
                }
                GAS v2u* xp = (GAS v2u*)(Q.XB + t * 1024 + 128 * s + 16 * j + 8 * hf + 4 * rp);
                const v2u xold = *xp;
                v4u vv[16];
#pragma unroll
                for (int i = 0; i < 16; ++i) { const unsigned e = (i & 3) == 0 ? ex[i >> 2].x : (i & 3) == 1 ? ex[i >> 2].y : (i & 3) == 2 ? ex[i >> 2].z : ex[i >> 2].w;
                    vv[i] = *(const GAS v4u*)(Q.V8 + (size_t)e * 1024 + 128 * s + 16 * j); }
                int ai[16];
#pragma unroll
                for (int i = 0; i < 16; ++i) ai[i] = 0;
#pragma unroll
                for (int q4_ = 0; q4_ < 4; ++q4_) {
                    const unsigned wq4 = q4_ == 0 ? wq.x : q4_ == 1 ? wq.y : q4_ == 2 ? wq.z : wq.w;
#pragma unroll
                    for (int c = 0; c < 4; ++c) { unsigned tt[4];
                        const v4u &a0 = vv[4 * q4_], &a1 = vv[4 * q4_ + 1], &a2 = vv[4 * q4_ + 2], &a3 = vv[4 * q4_ + 3];
                        tr4x4(c == 0 ? a0.x : c == 1 ? a0.y : c == 2 ? a0.z : a0.w, c == 0 ? a1.x : c == 1 ? a1.y : c == 2 ? a1.z : a1.w, c == 0 ? a2.x : c == 1 ? a2.y : c == 2 ? a2.z : a2.w, c == 0 ? a3.x : c == 1 ? a3.y : c == 2 ? a3.z : a3.w, tt);
#pragma unroll
                        for (int b = 0; b < 4; ++b) ai[4 * c + b] = __builtin_amdgcn_sdot4((int)tt[b], (int)wq4, ai[4 * c + b], false); }
                }
                float acc[16];
#pragma unroll
                for (int i = 0; i < 16; ++i) acc[i] = (float)ai[i] * sw;
                float r8[8], r4[4];
#pragma unroll
                for (int m = 0; m < 8; ++m) { float a = acc[m], b = acc[m + 8]; swap32(a, b); r8[m] = a + b; }
#pragma unroll
                for (int n = 0; n < 4; ++n) { float a = r8[n], b = r8[n + 4]; asm volatile("v_nop\n\tv_nop\n\tv_permlane16_swap_b32 %0, %1" : "+v"(a), "+v"(b)); r4[n] = a + b; }
#pragma unroll
                for (int n = 0; n < 4; ++n) r4[n] += __builtin_bit_cast(float, __builtin_amdgcn_update_dpp(0, __builtin_bit_cast(int, r4[n]), 0x128, 0xF, 0xF, true));
                v2u xw; xw.x = pk2(bflo(xold.x) + r4[0], bfhi(xold.x) + r4[1]); xw.y = pk2(bflo(xold.y) + r4[2], bfhi(xold.y) + r4[3]);
                float ss = 0.f;
                if ((lane & 8) == 0) { const float x0 = bflo(xw.x), x1 = bfhi(xw.x), x2 = bflo(xw.y), x3 = bfhi(xw.y); ss = (x0 * x0 + x1 * x1) + (x2 * x2 + x3 * x3); *xp = xw; }
                ss = wave_allsum(ss);
                if (Q.SSQ) { if (lane == 0) Q.SSQ[t * 16 + s] = ss; }
            }
        }
}

struct Args { const float* in[33]; float* out; unsigned char* ws; int ph_lo, ph_hi; };
struct Frame { LAS unsigned char* lds; volatile LAS unsigned* MISC; gu32* ctl; int tid, lane, wave, G, vcu, xcc, xrank; };

__device__ __forceinline__ void transpose_item(const float* W, int ldw, int nsrc0, bf16* WT, int ldt, int rdst0, LAS float* scr, int kb, int nb, int lane, float scale, const float* kgain) {
    const int k0 = 64 * kb, n0 = 32 * nb;
#pragma unroll 8
    for (int i = 0; i < 32; ++i) { const int kk = 2 * i + (lane >> 5); const float gsc = kgain ? kgain[k0 + kk] * scale : scale; scr[kk * 33 + (lane & 31)] = W[(size_t)(k0 + kk) * ldw + nsrc0 + n0 + (lane & 31)] * gsc; }
    LDS_WAIT(); asm volatile("" ::: "memory");
    const int c = lane & 7;
#pragma unroll
    for (int j = 0; j < 4; ++j) { const int n = (lane >> 3) + 8 * j; const LAS float* s = scr + (8 * c) * 33 + n;
        v4u o; o.x = pk2(s[0 * 33], s[1 * 33]); o.y = pk2(s[2 * 33], s[3 * 33]); o.z = pk2(s[4 * 33], s[5 * 33]); o.w = pk2(s[6 * 33], s[7 * 33]);
        *(GAS v4u*)(WT + (size_t)(rdst0 + n0 + n) * ldt + k0 + 8 * c) = o; }
    LDS_WAIT(); asm volatile("" ::: "memory");
}
__device__ __forceinline__ void zero_rect(bf16* base, int ld, int row0, int nrows, int col0, int ncols, int gtid, int gthreads) {
    const int vpr = ncols / 8;
    for (int i = gtid; i < nrows * vpr; i += gthreads) { const int r = i / vpr, c = i % vpr; *(GAS v4u*)(base + (size_t)(row0 + r) * ld + col0 + 8 * c) = (v4u){0u, 0u, 0u, 0u}; }
}

__device__ __forceinline__ void p0_prologue(Frame& F, const Args& a) {
    LAS float* scr = (LAS float*)(F.lds + RING_OFF + F.wave * 16384);
    const int gw = blockIdx.x * NWAVES + F.wave, NGW = F.G * NWAVES;
    const int gtid = blockIdx.x * (NWAVES * 64) + F.tid, gthreads = F.G * NWAVES * 64;
    unsigned char* ws = a.ws;
    x0_phase((const GAS float*)a.in[0], (GAS bf16*)(ws + WS_XNB), (GAS float*)(ws + WS_SSQ), gw, NGW, F.lane);
    constexpr int I_IN = 16 * (INW / 32), I_SQ = 16 * 32, I_CKV = 16 * 64, I_UQ = 3 * 12, I_UKV = 2 * 16, I_L = I_IN + 4 * I_SQ + I_CKV + I_UQ + I_UKV;
    for (int it = gw; it < L * I_L; it += NGW) {
        const int l = it / I_L; int r = it % I_L;
        if (r < I_IN) {
            const int kb = r / 67, nb = r % 67; int src, dst; float sc = 1.f;
            if (nb < 6) { src = 32 * nb; dst = src; } else if (nb < 11) { src = 32 * nb; dst = src + 64; } else { src = 32 * nb; dst = src + 160; if (nb >= 43 && nb < 51) sc = 0.17677669529663687f * LOG2E; }
            transpose_item(a.in[5] + (size_t)l * D * INW, INW, src, (bf16*)(ws + WS_WIN) + (size_t)l * INP * D, D, dst, scr, kb, 0, F.lane, sc, a.in[4] + l * D); continue; } r -= I_IN;
        if (r < I_SQ) { transpose_item(a.in[21] + (size_t)l * D * D, D, 0, (bf16*)(ws + WS_WOUT) + (size_t)l * D * D, D, 0, scr, r / 32, r % 32, F.lane, 1.f, nullptr); continue; } r -= I_SQ;
        if (r < I_SQ) { transpose_item(a.in[24] + (size_t)l * D * D, D, 0, (bf16*)(ws + WS_WCQ) + (size_t)l * D * D, D, 0, scr, r / 32, r % 32, F.lane, 0.0625f * LOG2E, a.in[22] + l * D); continue; } r -= I_SQ;
        if (r < I_SQ) { transpose_item(a.in[26] + (size_t)l * D * D, D, 0, (bf16*)(ws + WS_WCO) + (size_t)l * D * D, D, 0, scr, r / 32, r % 32, F.lane, 1.f, nullptr); continue; } r -= I_SQ;
        if (r < I_SQ) { transpose_item(a.in[28] + (size_t)l * D * D, D, 0, (bf16*)(ws + WS_WPQ) + (size_t)l * D * D, D, 0, scr, r / 32, r % 32, F.lane, 1.f, a.in[27] + l * D); continue; } r -= I_SQ;
        if (r < I_CKV) { transpose_item(a.in[25] + (size_t)l * D * 2 * D, 2 * D, 0, (bf16*)(ws + WS_WCKV) + (size_t)l * 2 * D * D, D, 0, scr, r / 64, r % 64, F.lane, 1.f, nullptr); continue; } r -= I_CKV;
        if (r < I_UQ) { transpose_item(a.in[7] + (size_t)l * 192 * 384, 384, 0, (bf16*)(ws + WS_WUQ) + (size_t)l * 512 * 256, 256, 0, scr, r / 12, r % 12, F.lane, 0.10206207261596575f * LOG2E, a.in[6] + l * 192); continue; } r -= I_UQ;
        transpose_item(a.in[9] + (size_t)l * 128 * 512, 512, 0, (bf16*)(ws + WS_WUKV) + (size_t)l * 512 * 256, 256, 0, scr, r / 16, r % 16, F.lane, 1.f, a.in[8] + l * 128);
    }
    for (int l = 0; l < L; ++l) {
        bf16* win = (bf16*)(ws + WS_WIN) + (size_t)l * INP * D; bf16* wuq = (bf16*)(ws + WS_WUQ) + (size_t)l * 512 * 256; bf16* wukv = (bf16*)(ws + WS_WUKV) + (size_t)l * 512 * 256;
        zero_rect(win, D, 192, 64, 0, D, gtid, gthreads); zero_rect(win, D, 416, 96, 0, D, gtid, gthreads);
        zero_rect(wuq, 256, 0, 384, 192, 64, gtid, gthreads); zero_rect(wuq, 256, 384, 128, 0, 256, gtid, gthreads);
        zero_rect(wukv, 256, 0, 512, 128, 128, gtid, gthreads);
    }
    { float* rope = (float*)(ws + WS_ROPE); const int* pos = (const int*)a.in[2];
      for (int i = gtid; i < T * 16; i += gthreads) { const int t = i >> 4, k = i & 15; const float inv = powf(10000.f, -(float)(2 * k) / 32.f); const float ang = (float)pos[t] * inv;
          rope[(size_t)t * 32 + k] = cosf(ang); rope[(size_t)t * 32 + 16 + k] = sinf(ang); } }
    { const GAS f32x4* ks = (const GAS f32x4*)a.in[29]; GAS v2u* kd = (GAS v2u*)(ws + WS_KEYS);
      for (int i = gtid; i < L * 2 * 128 * 64 / 4; i += gthreads) { const f32x4 v = ks[i]; v2u w; w.x = pk2(v.x, v.y); w.y = pk2(v.z, v.w); kd[i] = w; }
    }
    for (int r = gw; r < 2 * L * 16384; r += NGW) { const int tb = r / (L * 16384), rr = r % (L * 16384);
        quant_row((const GAS float*)a.in[30 + tb] + (size_t)rr * 1024, (GAS unsigned*)(ws + (tb ? WS_V8 : WS_U8) + (size_t)rr * 1024), (GAS float*)(ws + (tb ? WS_SV : WS_SU)) + rr, 0, F.lane); }
    { float* btab = (float*)(ws + WS_BTAB); float* lams = (float*)(ws + WS_LAMS); float* spt = (float*)(ws + WS_SP);
      for (int i = gtid; i < 4 * 129; i += gthreads) { const int h = i / 129, n = i % 129; int bu; if (n < 16) bu = n; else { const int lg = 16 + (int)(logf((float)n / 16.f) / logf(8.f) * 16.f); bu = lg < 31 ? lg : 31; }
          btab[i] = a.in[3][bu * 4 + h] * LOG2E; }
      for (int i = gtid; i < L; i += gthreads) { const float* dl = a.in[17] + i * 128; float s1 = 0.f, s2 = 0.f; for (int j = 0; j < 32; ++j) { s1 += dl[j] * dl[32 + j]; s2 += dl[64 + j] * dl[96 + j]; }
          const float li = 0.8f - 0.6f * expf(-0.3f * (float)i); lams[2 * i] = expf(s1) - expf(s2) + li; lams[2 * i + 1] = li; }
      for (int i = gtid; i < L * 512; i += gthreads) spt[i] = log1pf(expf(-a.in[16][i])); }
    { GAS bf16* wat = (GAS bf16*)(ws + WS_WAT);
      for (int i = gtid; i < L * 8 * 2 * 4096; i += gthreads) { const int in_ = i & 63, out_ = (i >> 6) & 63, gate = (i >> 12) & 1, lg = i >> 13;
          wat[i] = (bf16)f2bf_(a.in[gate ? 14 : 12][(size_t)lg * 4096 + in_ * 64 + out_]); } }
    for (int l = 0; l < L; ++l) norm_phase((const GAS float*)a.in[1], (const GAS float*)a.in[23] + l * D, (GAS bf16*)(ws + WS_MNB) + (size_t)l * NB * MEM * D, NB * MEM, gw, NGW, F.lane);
}

constexpr int NPL = 16, PH_FINAL = 2 + NPL * L;
__global__ void __launch_bounds__(NWAVES * 64, 2) fwd(Args args) {
    extern __shared__ __attribute__((aligned(16))) unsigned char lds[];
    Frame F;
    F.lds = (LAS unsigned char*)lds; F.MISC = (volatile LAS unsigned*)(F.lds + MISC_OFF);
    F.tid = threadIdx.x; F.lane = F.tid & 63; F.wave = __builtin_amdgcn_readfirstlane(F.tid >> 6); F.G = gridDim.x;
    F.vcu = (F.G % 8 == 0) ? ((int)blockIdx.x % 8) * (F.G / 8) + (int)blockIdx.x / 8 : (int)blockIdx.x;
    unsigned char* ws = args.ws;
    F.ctl = (gu32*)(opq(ws) + WS_CTL);
    for (int u = F.tid; u < (LDS_BYTES - LDSCTL_OFF) / 4; u += NWAVES * 64) ((LAS unsigned*)(F.lds + LDSCTL_OFF))[u] = 0u;
    __syncthreads();
    XcdBarrier bar = xcd_barrier_post((unsigned*)(F.ctl + CW_BAR), F.MISC + 8);
    F.xcc = (int)bar.x;
    if (F.tid == 0) F.MISC[12] = __hip_atomic_fetch_add((unsigned*)(F.ctl + CW_RANK) + 64 * bar.x, 1u, __ATOMIC_RELAXED, __HIP_MEMORY_SCOPE_AGENT);
    __syncthreads();
    F.xrank = __builtin_amdgcn_readfirstlane((int)F.MISC[12]);
    const int lo = args.ph_lo, hi = args.ph_hi;
    const int gw = blockIdx.x * NWAVES + F.wave, NGW = F.G * NWAVES;
#define IN(k) (lo <= (k) && (k) < hi)
#define LANE_ (lane_id_v())
#define TID_ ((opqi(F.wave) << 6) | LANE_)
#define SITE() const int G_ = opqi(F.G), wv_ = opqi(F.wave), vcu_ = opqi(F.vcu), gw_ = opqi(gw), NGW_ = opqi(NGW); (void)G_; (void)wv_; (void)vcu_; (void)gw_; (void)NGW_
#if MK_DUP == 99
#define SEAM(k) do { if (IN(k) && IN((k) + 1)) { xcd_barrier(bar, (F.wave == 0 && lane_id_v() == 0) ? 1 : 0); xcd_barrier(bar, (F.wave == 0 && lane_id_v() == 0) ? 1 : 0); } } while (0)
#else
#define SEAM(k) do { if (IN(k) && IN((k) + 1)) xcd_barrier(bar, (F.wave == 0 && lane_id_v() == 0) ? 1 : 0); } while (0)
#endif
#define GEMM_SITE(EPI, Aptr, lda_, Bptr, ldb_, M_, N_, K_, cperm, ...) do { \
        pg8::Gemm g{opq(Aptr), opq(Bptr), M_, N_, K_, lda_, ldb_}; pg8::StaticOrder So; So.init(M_, N_, opqi(F.G), opqi(cperm)); pg8::EPI E{__VA_ARGS__}; \
        pg8::gemm_phase<pg8::EPI, pg8::StaticOrder, true, true>(F.lds + RING_OFF, g, So, E, opqi(F.wave)); } while (0)
    if (IN(0)) { p0_prologue(F, args); }
    SEAM(0);
    if (IN(1)) {
#pragma unroll 1
        for (int l = 0; l < L; ++l)
            GEMM_SITE(EpiBf16, (const GAS bf16*)(opq(ws) + WS_MNB) + (size_t)l * NB * MEM * D, D, (const GAS bf16*)(opq(ws) + WS_WCKV) + (size_t)l * 2 * D * D, D, NB * MEM, 2 * D, D, (int)((blockIdx.x + 64 * l) % F.G),
                      opq((GAS bf16*)(opq(ws) + WS_KVCB) + (size_t)l * NB * MEM * 2 * D), 2 * D, 2 * D, (const GAS float*)nullptr, 0);
    }
    SEAM(1);
    for (int l = 0; l < L; ++l) {
        const int pb = 2 + NPL * l;
        const GAS bf16* XNB = (const GAS bf16*)(opq(ws) + WS_XNB); const GAS bf16* YB = (const GAS bf16*)(opq(ws) + WS_YB); GAS bf16* PROJB = (GAS bf16*)(opq(ws) + WS_PROJB);
        if (IN(pb + 1)) GEMM_SITE(EpiBf16, XNB, D, (const GAS bf16*)(opq(ws) + WS_WIN) + (size_t)l * INP * D, D, T, INP, D, (int)blockIdx.x, opq(PROJB), INP, INP, opq((const GAS float*)(opq(ws) + WS_SSQ)), 8);
#if MK_DUP == 1
        if (IN(pb + 1)) GEMM_SITE(EpiBf16, XNB, D, (const GAS bf16*)(opq(ws) + WS_WIN) + (size_t)l * INP * D, D, T, INP, D, (int)blockIdx.x, opq(PROJB), INP, INP, opq((const GAS float*)(opq(ws) + WS_SSQ)), 8);
#endif
        SEAM(pb + 1);
        if (IN(pb + 2)) {
            SITE();
            pre_phase(opq((const GAS bf16*)PROJB), opq((const GAS float*)(opq(ws) + WS_ROPE)), opq((GAS float*)(opq(ws) + WS_RS)), opq((GAS bf16*)(opq(ws) + WS_KMB)), gw_, NGW_, LANE_);
#if MK_DUP == 21
            pre_phase(opq((const GAS bf16*)PROJB), opq((const GAS float*)(opq(ws) + WS_ROPE)), opq((GAS float*)(opq(ws) + WS_RS)), opq((GAS bf16*)(opq(ws) + WS_KMB)), gw_, NGW_, LANE_);
#endif
            LruP LP{opq((const GAS bf16*)PROJB), (const GAS float*)args.in[opqi(10)] + l * 4 * 512, (const GAS float*)args.in[opqi(11)] + l * 512, opq((const GAS bf16*)(opq(ws) + WS_WAT)) + (size_t)l * 8 * 2 * 4096, (const GAS float*)args.in[opqi(13)] + l * 512, (const GAS float*)args.in[opqi(15)] + l * 512,
                    (const GAS float*)(opq(ws) + WS_SP) + l * 512, opq((GAS unsigned*)(opq(ws) + WS_HLB)), opq((GAS float*)(opq(ws) + WS_LSUM))};
            lru_phase(LP, F.lds, TID_, wv_, LANE_, vcu_, G_);
#if MK_DUP == 2
            lru_phase(LP, F.lds, TID_, wv_, LANE_, vcu_, G_);
#endif
        }
        SEAM(pb + 2);
        if (IN(pb + 3)) {
            GEMM_SITE(EpiUp, (const GAS bf16*)PROJB + PC_CQ, INP, (const GAS bf16*)(opq(ws) + WS_WUQ) + (size_t)l * 512 * 256, 256, T, 512, 256, (int)blockIdx.x,
                      opq((GAS bf16*)(opq(ws) + WS_QMB)), (GAS bf16*)nullptr, 384, 384, opq((const GAS float*)(opq(ws) + WS_RS)), 0, 0);
            GEMM_SITE(EpiUp, (const GAS bf16*)PROJB + PC_CKV, INP, (const GAS bf16*)(opq(ws) + WS_WUKV) + (size_t)l * 512 * 256, 256, T, 512, 256, (int)blockIdx.x,
                      opq((GAS bf16*)(opq(ws) + WS_KMB)), opq((GAS bf16*)(opq(ws) + WS_VMB)), 0, 512, opq((const GAS float*)(opq(ws) + WS_RS)), 1, 1);
#if MK_DUP == 3
            GEMM_SITE(EpiUp, (const GAS bf16*)PROJB + PC_CQ, INP, (const GAS bf16*)(opq(ws) + WS_WUQ) + (size_t)l * 512 * 256, 256, T, 512, 256, (int)blockIdx.x,
                      opq((GAS bf16*)(opq(ws) + WS_QMB)), (GAS bf16*)nullptr, 384, 384, opq((const GAS float*)(opq(ws) + WS_RS)), 0, 0);
            GEMM_SITE(EpiUp, (const GAS bf16*)PROJB + PC_CKV, INP, (const GAS bf16*)(opq(ws) + WS_WUKV) + (size_t)l * 512 * 256, 256, T, 512, 256, (int)blockIdx.x,
                      opq((GAS bf16*)(opq(ws) + WS_KMB)), opq((GAS bf16*)(opq(ws) + WS_VMB)), 0, 512, opq((const GAS float*)(opq(ws) + WS_RS)), 1, 1);
#endif
        }
        SEAM(pb + 3);
        if (IN(pb + 4)) {
            SITE();
            AttnP PM{opq((const GAS bf16*)(opq(ws) + WS_QMB)), opq((const GAS bf16*)(opq(ws) + WS_KMB)), opq((const GAS bf16*)(opq(ws) + WS_VMB)), 384, 384, 256, opq((GAS bf16*)(opq(ws) + WS_OMB)), 256, opq((const GAS float*)(opq(ws) + WS_ROPE)), nullptr, nullptr, nullptr, nullptr};
            AttnP PD{opq((const GAS bf16*)PROJB + PC_QD), opq((const GAS bf16*)PROJB + PC_KD), opq((const GAS bf16*)PROJB + PC_VD), INP, INP, INP, opq((GAS bf16*)(opq(ws) + WS_YB) + 768), 1024, nullptr,
                     (const GAS int*)args.in[opqi(2)], (const GAS float*)(opq(ws) + WS_BTAB), (const GAS float*)args.in[opqi(18)] + l * 64, (const GAS float*)(opq(ws) + WS_LAMS) + 2 * l};
            attn_phase(PM, PD, F.lds, TID_, wv_, LANE_, vcu_, G_);
#if MK_DUP == 4
            __syncthreads(); attn_phase(PM, PD, F.lds, TID_, wv_, LANE_, vcu_, G_);
#elif MK_DUP == 40 || MK_DUP == 41
            __syncthreads(); attn_phase(PM, PD, F.lds, TID_, wv_, LANE_, vcu_, G_, MK_DUP - 40);
#endif
        }
        SEAM(pb + 4);
        if (IN(pb + 5)) {
            SITE();
            PostP PP{opq((const GAS bf16*)(opq(ws) + WS_OMB)), opq((const GAS unsigned*)(opq(ws) + WS_HLB)), opq((const GAS float*)(opq(ws) + WS_LSUM)), opq((const GAS bf16*)PROJB), (const GAS float*)args.in[opqi(19)] + l * 256, (const GAS float*)args.in[opqi(20)] + l * 512, opq((GAS bf16*)(opq(ws) + WS_YB))};
            post_phase(PP, F.lds, TID_, wv_, LANE_, vcu_, G_);
#if MK_DUP == 5
            __syncthreads(); post_phase(PP, F.lds, TID_, wv_, LANE_, vcu_, G_);
#endif
        }
        SEAM(pb + 5);
        if (IN(pb + 6)) GEMM_SITE(EpiRes, YB, D, (const GAS bf16*)(opq(ws) + WS_WOUT) + (size_t)l * D * D, D, T, D, D, (int)blockIdx.x, opq((GAS bf16*)(opq(ws) + WS_XNB)), opq((GAS float*)(opq(ws) + WS_SSQ)));
#if MK_DUP == 6
        if (IN(pb + 6)) GEMM_SITE(EpiRes, YB, D, (const GAS bf16*)(opq(ws) + WS_WOUT) + (size_t)l * D * D, D, T, D, D, (int)blockIdx.x, opq((GAS bf16*)(opq(ws) + WS_HLB)), opq((GAS float*)(opq(ws) + WS_OMB)));
#endif
        SEAM(pb + 6);
        if (IN(pb + 8)) GEMM_SITE(EpiBf16, XNB, D, (const GAS bf16*)(opq(ws) + WS_WCQ) + (size_t)l * D * D, D, T, D, D, (int)blockIdx.x, opq(PROJB), D, D, opq((const GAS float*)(opq(ws) + WS_SSQ)), 16);
#if MK_DUP == 8
        if (IN(pb + 8)) GEMM_SITE(EpiBf16, XNB, D, (const GAS bf16*)(opq(ws) + WS_WCQ) + (size_t)l * D * D, D, T, D, D, (int)blockIdx.x, opq(PROJB), D, D, opq((const GAS float*)(opq(ws) + WS_SSQ)), 16);
#endif
        SEAM(pb + 8);
        if (IN(pb + 9)) {
            SITE();
            const GAS bf16* kv = (const GAS bf16*)(opq(ws) + WS_KVCB) + (size_t)l * NB * MEM * 2 * D;
            AttnP PC{opq((const GAS bf16*)PROJB), opq(kv), opq(kv + D), 1024, 2 * D, 2 * D, opq((GAS bf16*)(opq(ws) + WS_YB)), 1024, nullptr, nullptr, nullptr, nullptr, nullptr};
            cross_phase(PC, F.lds, TID_, wv_, LANE_, vcu_, G_);
#if MK_DUP == 9
            cross_phase(PC, F.lds, TID_, wv_, LANE_, vcu_, G_);
#endif
        }
        SEAM(pb + 9);
        if (IN(pb + 10)) GEMM_SITE(EpiRes, YB, D, (const GAS bf16*)(opq(ws) + WS_WCO) + (size_t)l * D * D, D, T, D, D, (int)blockIdx.x, opq((GAS bf16*)(opq(ws) + WS_XNB)), opq((GAS float*)(opq(ws) + WS_SSQ)));
        SEAM(pb + 10);
        if (IN(pb + 12)) { GEMM_SITE(EpiBf16, XNB, D, (const GAS bf16*)(opq(ws) + WS_WPQ) + (size_t)l * D * D, D, T, D, D, (int)blockIdx.x, opq(PROJB), D, D, opq((const GAS float*)(opq(ws) + WS_SSQ)), 16);
            SITE(); hq_phase(opq(XNB), opq((const GAS float*)(opq(ws) + WS_SSQ)), (const GAS float*)args.in[opqi(27)] + l * D, opq((GAS unsigned char*)(opq(ws) + WS_HQ)), opq((GAS float*)(opq(ws) + WS_SH)), opq((GAS int*)(opq(ws) + WS_P)), gw_, NGW_, LANE_);
#if MK_DUP == 12
            hq_phase(opq(XNB), opq((const GAS float*)(opq(ws) + WS_SSQ)), (const GAS float*)args.in[opqi(27)] + l * D, opq((GAS unsigned char*)(opq(ws) + WS_HQ)), opq((GAS float*)(opq(ws) + WS_SH)), opq((GAS int*)(opq(ws) + WS_P)), gw_, NGW_, LANE_);
#endif
            }
        SEAM(pb + 12);
        if (IN(pb + 13)) {
            SITE();
            RouteP RP{opq((const GAS bf16*)PROJB), opq((const GAS bf16*)(opq(ws) + WS_KEYS) + (size_t)l * 2 * 128 * 64), opq((GAS int*)(opq(ws) + WS_EX)), opq((GAS float*)(opq(ws) + WS_GW))};
            route_phase(RP, F.lds, TID_, wv_, LANE_, vcu_, G_);
#if MK_DUP == 13
            route_phase(RP, F.lds, TID_, wv_, LANE_, vcu_, G_);
#endif
        }
        SEAM(pb + 13);
        if (IN(pb + 14)) {
            SITE();
            const PeerS ps = peer_sched((const GAS unsigned*)(F.ctl + CW_RANK), opqi(F.xcc), opqi(F.xrank));
            Peer1P Q1{opq((const GAS unsigned char*)(opq(ws) + WS_HQ)), opq((const GAS int*)(opq(ws) + WS_EX)), opq((const GAS unsigned char*)(opq(ws) + WS_U8) + (size_t)l * 16384 * 1024), opq((GAS int*)(opq(ws) + WS_P))};
            peer_k1(Q1, ps, wv_, LANE_);
#if MK_DUP == 141
            { Peer1P Q1b = Q1; Q1b.P = (GAS int*)(opq(ws) + WS_PROJB); peer_k1(Q1b, ps, wv_, LANE_); }
#endif
        }
        SEAM(pb + 14);
        if (IN(pb + 15)) {
            SITE();
            peer_w(opq((const GAS int*)(opq(ws) + WS_EX)), opq((const GAS float*)(opq(ws) + WS_GW)), opq((const GAS int*)(opq(ws) + WS_P)), opq((const GAS float*)(opq(ws) + WS_SH)), opq((const GAS float*)(opq(ws) + WS_SU) + l * 16384), opq((const GAS float*)(opq(ws) + WS_SV) + l * 16384),
                   opq((GAS signed char*)(opq(ws) + WS_W)), opq((GAS float*)(opq(ws) + WS_WS)), gw_, NGW_, LANE_);
            xcd_barrier(bar, (F.wave == 0 && lane_id_v() == 0) ? 1 : 0);
            const PeerS ps = peer_sched((const GAS unsigned*)(F.ctl + CW_RANK), opqi(F.xcc), opqi(F.xrank));
            Peer2P Q2{opq((const GAS int*)(opq(ws) + WS_EX)), opq((const GAS signed char*)(opq(ws) + WS_W)), opq((const GAS float*)(opq(ws) + WS_WS)), opq((const GAS unsigned char*)(opq(ws) + WS_V8) + (size_t)l * 16384 * 1024), opq((GAS bf16*)(opq(ws) + WS_XNB)), opq((GAS float*)(opq(ws) + WS_SSQ))};
            peer_k2(Q2, ps, wv_, LANE_);
#if MK_DUP == 151
            { Peer2P Q2b = Q2; Q2b.XB = (GAS bf16*)(opq(ws) + WS_HLB); Q2b.SSQ = (GAS float*)(opq(ws) + WS_OMB); peer_k2(Q2b, ps, wv_, LANE_); }
#endif
        }
        SEAM(pb + 15);
    }
    if (IN(PH_FINAL)) { SITE(); final_norm_phase(opq((const GAS bf16*)(opq(ws) + WS_XNB)), (GAS float*)args.out, (const GAS float*)args.in[opqi(32)], T, gw_, NGW_, LANE_); }
#undef IN
#undef SEAM
#undef GEMM_SITE
}
}
extern "C" void kernel_launch(void* const* d_in, const int* in_sizes, int n_in, void* d_out, int out_size, void* d_ws, size_t ws_size, hipStream_t stream) {
    (void)in_sizes; (void)out_size;
    static int grid = 0;
    if (grid == 0) {
        int dev = 0, cus = 0, per_cu = 0;
        if (n_in != 33 || ws_size < mk::WS_END) { fprintf(stderr, "kernel_launch: unexpected n_in %d / ws_size %zu\n", n_in, ws_size); grid = -1; return; }
        if (hipGetDevice(&dev) != hipSuccess || hipDeviceGetAttribute(&cus, hipDeviceAttributeMultiprocessorCount, dev) != hipSuccess) { grid = -1; return; }
        if (hipFuncSetAttribute((const void*)mk::fwd, hipFuncAttributeMaxDynamicSharedMemorySize, mk::LDS_BYTES) != hipSuccess) { fprintf(stderr, "kernel_launch: hipFuncSetAttribute failed\n"); grid = -1; return; }
        if (hipOccupancyMaxActiveBlocksPerMultiprocessor(&per_cu, (const void*)mk::fwd, mk::NWAVES * 64, mk::LDS_BYTES) != hipSuccess || per_cu < 1) fprintf(stderr, "kernel_launch: occupancy query says %d\n", per_cu);
        (void)hipGetLastError();
        grid = cus;
    }
    if (grid < 0) return;
    unsigned char* ws = (unsigned char*)d_ws;
    (void)hipMemsetAsync(ws + mk::WS_CTL, 0, mk::CTL_ZERO_BYTES, stream);
    mk::Args a{};
    for (int i = 0; i < 33; ++i) a.in[i] = (const float*)d_in[i];
    a.out = (float*)d_out; a.ws = ws;
    auto run = [&](int lo, int hi) { a.ph_lo = lo; a.ph_hi = hi; hipLaunchKernelGGL(mk::fwd, dim3(grid), dim3(mk::NWAVES * 64), mk::LDS_BYTES, stream, a); };
#if MK_ONE_LAUNCH
    run(0, mk::PH_FINAL + 1);
#else
    for (int p = 0; p <= mk::PH_FINAL; ++p) {
        const int k = (p - 2) % mk::NPL, l = (p - 2) / mk::NPL;
#if MK_NAIVE_PEER == 2
        if (p >= 2 && p < mk::PH_FINAL && k == 14) {
            hipLaunchKernelGGL(k_peer, dim3(T), dim3(256), 0, stream, (const bf16_t*)(ws + mk::WS_XNB), (const int*)(ws + mk::WS_EX), (const float*)(ws + mk::WS_GW), (const float*)d_in[30] + (size_t)l * NEXP * D, (const float*)d_in[31] + (size_t)l * NEXP * D, (float*)d_out);
            continue; }
#elif MK_NAIVE_PEER == 1
        if (p >= 2 && p < mk::PH_FINAL && k == 13) {
            float* TQ = (float*)(ws + (size_t)806 * mk::MiB);
            hipLaunchKernelGGL(k_bf2f, dim3((unsigned)(((size_t)T * D + 255) / 256)), dim3(256), 0, stream, (const bf16_t*)(ws + mk::WS_PROJB), TQ, (long)T * D);
            hipLaunchKernelGGL(k_route, dim3(T), dim3(256), 0, stream, TQ, (const float*)d_in[29] + (size_t)l * 2 * 128 * 64, (int*)(ws + mk::WS_EX), (float*)(ws + mk::WS_GW));
            hipLaunchKernelGGL(k_peer, dim3(T), dim3(256), 0, stream, (const bf16_t*)(ws + mk::WS_XNB), (const int*)(ws + mk::WS_EX), (const float*)(ws + mk::WS_GW), (const float*)d_in[30] + (size_t)l * NEXP * D, (const float*)d_in[31] + (size_t)l * NEXP * D, (float*)d_out);
            continue; }
        if (p >= 2 && p < mk::PH_FINAL && k == 14) continue;
#endif
        run(p, p + 1); }
#endif
}
```

```cpp
#include <hip/hip_runtime.h>
#include <cstdint>
#include <cstdio>
#include <cmath>

#ifndef MK_ONE_LAUNCH
#define MK_ONE_LAUNCH 1
#endif
#ifndef MK_DUP
#define MK_DUP 0
#endif
#ifndef MK_NAIVE_PEER
#define MK_NAIVE_PEER 0
#endif
namespace pg8 {
#define PG8_LAS __attribute__((address_space(3)))
#ifndef GAS
#define GAS __attribute__((address_space(1)))
#endif
typedef unsigned short bf16_t;
typedef short bf16x8 __attribute__((ext_vector_type(8)));
typedef float f32x4 __attribute__((ext_vector_type(4)));
typedef unsigned u32x4 __attribute__((ext_vector_type(4)));
typedef unsigned u32x2 __attribute__((ext_vector_type(2)));
constexpr int BM = 256, BK = 64, HALF = 128, HTB = HALF * BK * 2, STAGE_BYTES = 8 * HTB, NXCD = 8, WGM = 8;
__host__ __device__ __forceinline__ int lds_byte(int r, int c) { const int st = (r >> 4) * 2 + (c >> 5), rr = r & 15, cc = c & 31, ob = rr * 64 + cc * 2; return st * 1024 + (ob ^ (((ob >> 9) & 1) << 5)); }
__host__ __device__ __forceinline__ void stage_rc(int b, int& R, int& C) { const int st = b / 1024, sb = b % 1024, swz = sb ^ (((sb >> 9) & 1) << 5); R = (st >> 1) * 16 + swz / 64; C = (st & 1) * 32 + (swz % 64) / 2; }
__host__ __device__ __forceinline__ int perm32(int rho) { const int n = rho >> 4, i = rho & 15; return 8 * (i >> 2) + 4 * n + (i & 3); }
__device__ __forceinline__ int pg8_lane_id() { int l; asm volatile("v_mbcnt_lo_u32_b32 %0, -1, 0\n\tv_mbcnt_hi_u32_b32 %0, -1, %0" : "=v"(l)); return l; }
struct Unit { int pm, pn; };
struct Gemm { const GAS bf16_t* A; const GAS bf16_t* Bt; int M, N, K, lda, ldb; };
struct StaticOrder {
    int nM, nN, nwg, G, c;
    __host__ __device__ void init(int M, int N, int G_, int c_) { nM = M / BM; nN = N / BM; nwg = nM * nN; G = G_; c = c_; }
    __host__ __device__ bool next(int i, Unit& u) const {
        const long L = (long)i * G + c; if (L >= nwg) return false;
        int wgid = (int)L; { const int q = nwg / NXCD, r = nwg % NXCD, xcd = wgid % NXCD, off = wgid / NXCD; wgid = (xcd < r ? xcd * (q + 1) : r * (q + 1) + (xcd - r) * q) + off; }
        const int nig = WGM * nN, gid = wgid / nig, fm = gid * WGM, gsz = (nM - fm) < WGM ? (nM - fm) : WGM;
        u.pm = fm + ((wgid % nig) % gsz); u.pn = (wgid % nig) / gsz; return true;
    }
    __device__ __forceinline__ void a_ready(const Unit&) const {}
    __device__ __forceinline__ void done(const Unit&) const {}
};
__device__ __forceinline__ unsigned cvt_pk_bf16(float lo, float hi) { unsigned r; asm volatile("v_cvt_pk_bf16_f32 %0, %1, %2" : "=v"(r) : "v"(lo), "v"(hi)); return r; }

struct EpiF32 {
    static constexpr bool PERM = false, AFTER_DRAIN = false;
    GAS float* C; int ldc; int nvalid; int accum;
    __device__ __forceinline__ void operator()(const f32x4 (&acc)[2][2][4][2], const Unit& u, int wr, int wc, int fr, int fq) const {
        { const int l_ = pg8_lane_id(); fr = l_ & 15; fq = l_ >> 4; }
#pragma unroll
        for (int ai = 0; ai < 2; ++ai)
#pragma unroll
            for (int m = 0; m < 4; ++m) { const size_t row = (size_t)u.pm * BM + ai * HALF + wr * 64 + m * 16 + fr;
#pragma unroll
                for (int bj = 0; bj < 2; ++bj)
#pragma unroll
                    for (int n = 0; n < 2; ++n) { const int col = u.pn * BM + bj * HALF + wc * 32 + n * 16 + 4 * fq;
                        if (col < nvalid) { GAS float* p = C + row * ldc + col; f32x4 v = acc[ai][bj][m][n]; if (accum) v += *(const GAS f32x4*)p; *(GAS f32x4*)p = v; } } }
    }
};
struct EpiBf16 {
    static constexpr bool PERM = true, AFTER_DRAIN = false;
    GAS bf16_t* O; int ldc; int nvalid; const GAS float* ssq; int np;
    __device__ __forceinline__ void operator()(const f32x4 (&acc)[2][2][4][2], const Unit& u, int wr, int wc, int fr, int fq) const {
        { const int l_ = pg8_lane_id(); fr = l_ & 15; fq = l_ >> 4; }
#pragma unroll
        for (int ai = 0; ai < 2; ++ai)
#pragma unroll
            for (int m = 0; m < 4; ++m) { const size_t row = (size_t)u.pm * BM + ai * HALF + wr * 64 + m * 16 + fr;
                float rs_ = 1.f;
                if (np > 0) { const GAS f32x4* sp = (const GAS f32x4*)(ssq + row * 16); f32x4 t = sp[0] + sp[1]; if (np > 8) t += sp[2] + sp[3]; rs_ = __builtin_amdgcn_rsqf(((t[0] + t[1]) + (t[2] + t[3])) * (1.f / 1024.f) + 1e-6f); }
#pragma unroll
                for (int bj = 0; bj < 2; ++bj) { const int col = u.pn * BM + bj * HALF + wc * 32 + 8 * fq;
                    if (col < nvalid) { const f32x4 v0 = acc[ai][bj][m][0] * rs_, v1 = acc[ai][bj][m][1] * rs_; u32x4 w; w.x = cvt_pk_bf16(v0[0], v0[1]); w.y = cvt_pk_bf16(v0[2], v0[3]); w.z = cvt_pk_bf16(v1[0], v1[1]); w.w = cvt_pk_bf16(v1[2], v1[3]);
                        *(GAS u32x4*)(O + row * ldc + col) = w; } } }
    }
};
struct EpiUp {
    static constexpr bool PERM = true, AFTER_DRAIN = false;
    GAS bf16_t* O; GAS bf16_t* O2; int ldc; int nvalid; const GAS float* rs; int rsi; int mode;
    __device__ __forceinline__ void operator()(const f32x4 (&acc)[2][2][4][2], const Unit& u, int wr, int wc, int fr, int fq) const {
        { const int l_ = pg8_lane_id(); fr = l_ & 15; fq = l_ >> 4; }
#pragma unroll
        for (int ai = 0; ai < 2; ++ai)
#pragma unroll
            for (int m = 0; m < 4; ++m) { const size_t row = (size_t)u.pm * BM + ai * HALF + wr * 64 + m * 16 + fr; const float s = rs[2 * row + rsi];
#pragma unroll
                for (int bj = 0; bj < 2; ++bj) { const int col = u.pn * BM + bj * HALF + wc * 32 + 8 * fq;
                    if (col < nvalid) { const f32x4 v0 = acc[ai][bj][m][0] * s, v1 = acc[ai][bj][m][1] * s; u32x4 w; w.x = cvt_pk_bf16(v0[0], v0[1]); w.y = cvt_pk_bf16(v0[2], v0[3]); w.z = cvt_pk_bf16(v1[0], v1[1]); w.w = cvt_pk_bf16(v1[2], v1[3]);
                        GAS bf16_t* dst;
                        if (mode == 0) dst = O + row * ldc + col;
                        else { const int h = col >> 7, j = col & 127; dst = (j < 64) ? O + row * 384 + h * 96 + j : O2 + row * 256 + h * 64 + (j - 64); }
                        *(GAS u32x4*)dst = w; } } }
    }
};

struct EpiRes {
    static constexpr bool PERM = true, AFTER_DRAIN = false;
    GAS bf16_t* XB; GAS float* SSQ;
    __device__ __forceinline__ void operator()(const f32x4 (&acc)[2][2][4][2], const Unit& u, int wr, int wc, int fr, int fq) const {
        { const int l_ = pg8_lane_id(); fr = l_ & 15; fq = l_ >> 4; }
#pragma unroll
        for (int ai = 0; ai < 2; ++ai)
#pragma unroll
            for (int m = 0; m < 4; ++m) { const size_t row = (size_t)u.pm * BM + ai * HALF + wr * 64 + m * 16 + fr; float ss = 0.f;
#pragma unroll
                for (int bj = 0; bj < 2; ++bj) { GAS u32x4* p = (GAS u32x4*)(XB + row * 1024 + u.pn * BM + bj * HALF + wc * 32 + 8 * fq);
                    const u32x4 o = *p; const f32x4 v0 = acc[ai][bj][m][0], v1 = acc[ai][bj][m][1];
                    u32x4 w;
                    w.x = cvt_pk_bf16(__builtin_bit_cast(float, o.x << 16) + v0[0], __builtin_bit_cast(float, o.x & 0xffff0000u) + v0[1]);
                    w.y = cvt_pk_bf16(__builtin_bit_cast(float, o.y << 16) + v0[2], __builtin_bit_cast(float, o.y & 0xffff0000u) + v0[3]);
                    w.z = cvt_pk_bf16(__builtin_bit_cast(float, o.z << 16) + v1[0], __builtin_bit_cast(float, o.z & 0xffff0000u) + v1[1]);
                    w.w = cvt_pk_bf16(__builtin_bit_cast(float, o.w << 16) + v1[2], __builtin_bit_cast(float, o.w & 0xffff0000u) + v1[3]);
                    *p = w;
#pragma unroll
                    for (int e = 0; e < 4; ++e) { const float a = __builtin_bit_cast(float, w[e] << 16), b = __builtin_bit_cast(float, w[e] & 0xffff0000u); ss += a * a + b * b; } }
                { float a = ss, b = ss; asm volatile("v_nop\n\tv_nop\n\tv_permlane16_swap_b32 %0, %1" : "+v"(a), "+v"(b)); ss = a + b; }
                { float a = ss, b = ss; asm volatile("v_nop\n\tv_nop\n\tv_permlane32_swap_b32 %0, %1" : "+v"(a), "+v"(b)); ss = a + b; }
                if (fq == 0) SSQ[row * 16 + 4 * u.pn + wc] = ss; }
    }
};
template <class Epi, class Sched, bool ALIGN_EPI = false, bool SP2 = false>
__device__ __forceinline__ void gemm_phase(PG8_LAS unsigned char* lds, const Gemm g, const Sched& S, const Epi& E, int wave_id) {
    int tid_ = (wave_id << 6) | pg8_lane_id(); asm volatile("" : "+v"(tid_));
    const int tid = tid_, wid = __builtin_amdgcn_readfirstlane(tid >> 6), lane = tid & 63, wr = wid >> 2, wc = wid & 3, fr = lane & 15, fq = lane >> 4;
    const int K = g.K, nt = K / BK;
    unsigned voffA[2], voffB[2];
#pragma unroll
    for (int i = 0; i < 2; ++i) { int R, C; stage_rc(tid * 16 + i * 8192, R, C); const int Rb = Epi::PERM ? ((R & ~31) + perm32(R & 31)) : R;
        voffA[i] = (unsigned)(R * g.lda + C) * 2u; voffB[i] = (unsigned)(Rb * g.ldb + C) * 2u; }
    const size_t kstep = (size_t)(BK * 2);
    const size_t hstepA = (size_t)HALF * g.lda * 2, hstepB = (size_t)HALF * g.ldb * 2;
    const size_t tstepA = 2 * hstepA, tstepB = 2 * hstepB;
    const unsigned ldsw = (unsigned)wid * 1024u;
    const int aoff = lds_byte(wr * 64 + fr, fq * 8), boff = lds_byte(wc * 32 + fr, fq * 8);
#define PG8_SA(b, h) (((b) * 2 + (h)) * HTB)
#define PG8_SB(b, h) ((4 + (b) * 2 + (h)) * HTB)
#define PG8_STAGE(bufoff, gbase, voff) do { _Pragma("unroll") for (int _i = 0; _i < 2; ++_i) \
        __builtin_amdgcn_global_load_lds((const unsigned*)((const char*)(gbase) + (voff)[_i]), (PG8_LAS unsigned*)(lds + (bufoff) + ldsw + _i * 8192), 16, 0, 0); } while (0)
#define PG8_LDA(dst, b, h) do { _Pragma("unroll") for (int m = 0; m < 4; ++m) _Pragma("unroll") for (int k = 0; k < 2; ++k) dst[m][k] = *(const PG8_LAS bf16x8*)(lds + PG8_SA(b, h) + aoff + m * 2048 + k * 1024); } while (0)
#define PG8_LDB(dst, b, h) do { _Pragma("unroll") for (int n = 0; n < 2; ++n) _Pragma("unroll") for (int k = 0; k < 2; ++k) dst[n][k] = *(const PG8_LAS bf16x8*)(lds + PG8_SB(b, h) + boff + n * 2048 + k * 1024); } while (0)
#define PG8_MMA(ai, bj, At, Bt) do { __builtin_amdgcn_s_setprio(1); _Pragma("unroll") for (int m = 0; m < 4; ++m) _Pragma("unroll") for (int n = 0; n < 2; ++n) _Pragma("unroll") for (int k = 0; k < 2; ++k) \
        acc[ai][bj][m][n] = __builtin_amdgcn_mfma_f32_16x16x32_bf16(Bt[n][k], At[m][k], acc[ai][bj][m][n], 0, 0, 0); __builtin_amdgcn_s_setprio(0); } while (0)
#define PG8_WAIT_V(n) asm volatile("s_waitcnt vmcnt(" #n ")" ::: "memory")
#define PG8_WAIT_L(n) asm volatile("s_waitcnt lgkmcnt(" #n ")" ::: "memory")
#define PG8_BAR __builtin_amdgcn_s_barrier()
#define PG8_SCHED __builtin_amdgcn_sched_barrier(0)
    Unit cur, nxt; int ui = 0;
    if (!S.next(0, cur)) return;
    f32x4 acc[2][2][4][2];
#pragma unroll
    for (int a = 0; a < 2; ++a)
#pragma unroll
        for (int b = 0; b < 2; ++b)
#pragma unroll
            for (int m = 0; m < 4; ++m)
#pragma unroll
                for (int n = 0; n < 2; ++n) acc[a][b][m][n] = (f32x4){0.f, 0.f, 0.f, 0.f};
    bf16x8 At[4][2], B0[2][2], B1[2][2];
    const char* cA = (const char*)g.A + (size_t)cur.pm * tstepA; const char* cB = (const char*)g.Bt + (size_t)cur.pn * tstepB;
    S.a_ready(cur);
    if constexpr (SP2) {
        PG8_STAGE(PG8_SB(0, 0), cB, voffB); PG8_STAGE(PG8_SB(0, 1), cB + hstepB, voffB); PG8_STAGE(PG8_SA(0, 0), cA, voffA); PG8_STAGE(PG8_SA(0, 1), cA + hstepA, voffA);
        if (wr == 1) PG8_BAR;
        PG8_WAIT_V(2); PG8_BAR;
        PG8_STAGE(PG8_SB(1, 0), cB + kstep, voffB); PG8_STAGE(PG8_SA(1, 0), cA + kstep, voffA); PG8_STAGE(PG8_SB(1, 1), cB + hstepB + kstep, voffB);
        PG8_WAIT_V(6); PG8_BAR;
    } else {
        PG8_STAGE(PG8_SB(0, 0), cB, voffB); PG8_STAGE(PG8_SA(0, 0), cA, voffA); PG8_STAGE(PG8_SB(0, 1), cB + hstepB, voffB); PG8_STAGE(PG8_SA(0, 1), cA + hstepA, voffA);
        if (wr == 1) PG8_BAR;
        PG8_WAIT_V(4); PG8_BAR;
        PG8_STAGE(PG8_SB(1, 0), cB + kstep, voffB); PG8_STAGE(PG8_SA(1, 0), cA + kstep, voffA); PG8_STAGE(PG8_SB(1, 1), cB + hstepB + kstep, voffB);
        PG8_WAIT_V(6); PG8_BAR;
    }
    for (;;) {
        const bool has_next = S.next(ui + 1, nxt);
        const char* nA = has_next ? (const char*)g.A + (size_t)nxt.pm * tstepA : cA; const char* nB = has_next ? (const char*)g.Bt + (size_t)nxt.pn * tstepB : cB;
        for (int t = 0; t < nt; t += 2) {
            const bool last = (t == nt - 2);
            const char* a1 = cA + (size_t)(t + 1) * kstep;
            const char* a2 = last ? nA : cA + (size_t)(t + 2) * kstep; const char* b2 = last ? nB : cB + (size_t)(t + 2) * kstep;
            const char* a3 = a2 + kstep; const char* b3 = b2 + kstep;
            if (last && has_next) S.a_ready(nxt);
            if constexpr (SP2) {
            PG8_LDB(B0, 0, 0); PG8_LDB(B1, 0, 1); PG8_SCHED; PG8_LDA(At, 0, 0); PG8_STAGE(PG8_SA(1, 1), a1 + hstepA, voffA);
            PG8_WAIT_V(8); PG8_WAIT_L(0); PG8_BAR; PG8_MMA(0, 0, At, B0); PG8_MMA(0, 1, At, B1); PG8_BAR; PG8_SCHED;
            PG8_LDA(At, 0, 1); PG8_STAGE(PG8_SB(0, 0), b2, voffB); PG8_STAGE(PG8_SB(0, 1), b2 + hstepB, voffB); PG8_STAGE(PG8_SA(0, 0), a2, voffA);
            PG8_WAIT_V(8); PG8_WAIT_L(0); PG8_BAR; PG8_MMA(1, 0, At, B0); PG8_MMA(1, 1, At, B1); PG8_BAR; PG8_SCHED;
            PG8_LDB(B0, 1, 0); PG8_LDB(B1, 1, 1); PG8_SCHED; PG8_LDA(At, 1, 0); PG8_STAGE(PG8_SA(0, 1), a2 + hstepA, voffA);
            PG8_WAIT_V(8); PG8_WAIT_L(0); PG8_BAR; PG8_MMA(0, 0, At, B0); PG8_MMA(0, 1, At, B1); PG8_BAR; PG8_SCHED;
            PG8_LDA(At, 1, 1); PG8_STAGE(PG8_SB(1, 0), b3, voffB); PG8_STAGE(PG8_SB(1, 1), b3 + hstepB, voffB); PG8_STAGE(PG8_SA(1, 0), a3, voffA);
            PG8_WAIT_V(8); PG8_WAIT_L(0); PG8_BAR; PG8_MMA(1, 0, At, B0); PG8_MMA(1, 1, At, B1); PG8_BAR; PG8_SCHED;
            } else {
            PG8_LDB(B0, 0, 0); PG8_SCHED; PG8_LDA(At, 0, 0); PG8_STAGE(PG8_SA(1, 1), a1 + hstepA, voffA);
            PG8_WAIT_L(8); PG8_BAR; PG8_WAIT_L(0); PG8_MMA(0, 0, At, B0); PG8_BAR; PG8_SCHED;
            PG8_LDB(B1, 0, 1); PG8_STAGE(PG8_SB(0, 0), b2, voffB);
            PG8_BAR; PG8_WAIT_L(0); PG8_MMA(0, 1, At, B1); PG8_BAR;
            PG8_LDA(At, 0, 1); PG8_STAGE(PG8_SA(0, 0), a2, voffA);
            PG8_BAR; PG8_WAIT_L(0); PG8_MMA(1, 0, At, B0); PG8_BAR; PG8_SCHED;
            PG8_STAGE(PG8_SB(0, 1), b2 + hstepB, voffB);
            PG8_WAIT_V(6); PG8_BAR; PG8_MMA(1, 1, At, B1); PG8_BAR;
            PG8_LDB(B0, 1, 0); PG8_SCHED; PG8_LDA(At, 1, 0); PG8_STAGE(PG8_SA(0, 1), a2 + hstepA, voffA);
            PG8_WAIT_L(8); PG8_BAR; PG8_WAIT_L(0); PG8_MMA(0, 0, At, B0); PG8_BAR; PG8_SCHED;
            PG8_LDB(B1, 1, 1); PG8_STAGE(PG8_SB(1, 0), b3, voffB);
            PG8_BAR; PG8_WAIT_L(0); PG8_MMA(0, 1, At, B1); PG8_BAR;
            PG8_LDA(At, 1, 1); PG8_STAGE(PG8_SA(1, 0), a3, voffA);
            PG8_BAR; PG8_WAIT_L(0); PG8_MMA(1, 0, At, B0); PG8_BAR; PG8_SCHED;
            PG8_STAGE(PG8_SB(1, 1), b3 + hstepB, voffB);
            PG8_WAIT_V(6); PG8_BAR; PG8_MMA(1, 1, At, B1); PG8_BAR;
            }
        }
        if constexpr (ALIGN_EPI) { if (wr == 0) PG8_BAR; }
        if constexpr (!Epi::AFTER_DRAIN) { E(acc, cur, wr, wc, fr, fq); S.done(cur); }
        if (!has_next) break;
#pragma unroll
        for (int a = 0; a < 2; ++a)
#pragma unroll
            for (int b = 0; b < 2; ++b)
#pragma unroll
                for (int m = 0; m < 4; ++m)
#pragma unroll
                    for (int n = 0; n < 2; ++n) acc[a][b][m][n] = (f32x4){0.f, 0.f, 0.f, 0.f};
        cur = nxt; cA = nA; cB = nB; ++ui;
        if constexpr (ALIGN_EPI) { if (wr == 1) PG8_BAR; }
    }
    PG8_WAIT_V(0);
    if constexpr (!ALIGN_EPI) { if (wr == 0) PG8_BAR; }
    PG8_BAR;
    if constexpr (Epi::AFTER_DRAIN) { E.fused(acc, cur, wr, wc, fr, fq, lds, wid, lane); S.done(cur); }
#undef PG8_SA
#undef PG8_SB
#undef PG8_STAGE
#undef PG8_LDA
#undef PG8_LDB
#undef PG8_MMA
#undef PG8_WAIT_V
#undef PG8_WAIT_L
#undef PG8_BAR
#undef PG8_SCHED
}
}

namespace mk {
#ifndef GAS
#define GAS __attribute__((address_space(1)))
#endif
#define LAS __attribute__((address_space(3)))
typedef unsigned short bf16;
typedef unsigned v4u __attribute__((ext_vector_type(4)));
typedef unsigned v2u __attribute__((ext_vector_type(2)));
typedef float f32x4 __attribute__((ext_vector_type(4)));
typedef GAS unsigned gu32;
#define LDS_WAIT() asm volatile("s_waitcnt lgkmcnt(0)" ::: "memory")
#define VM_WAIT() asm volatile("s_waitcnt vmcnt(0)" ::: "memory")
__device__ __forceinline__ unsigned f2bf_(float f) { unsigned u = __builtin_bit_cast(unsigned, f); return (u + 0x7fffu + ((u >> 16) & 1u)) >> 16; }
__device__ __forceinline__ unsigned pk2(float lo, float hi) { return f2bf_(lo) | (f2bf_(hi) << 16); }
__device__ __forceinline__ float bflo(unsigned w) { return __builtin_bit_cast(float, w << 16); }
__device__ __forceinline__ float bfhi(unsigned w) { return __builtin_bit_cast(float, w & 0xffff0000u); }

template <class P> __device__ __forceinline__ P* opq(P* p) { asm volatile("" : "+s"(p)); return p; }
__device__ __forceinline__ int opqi(int k) { asm volatile("" : "+s"(k)); return k; }
__device__ __forceinline__ float shx(float v, int o, int lane) { return __builtin_bit_cast(float, __builtin_amdgcn_ds_bpermute((lane ^ o) << 2, __builtin_bit_cast(int, v))); }
__device__ __forceinline__ int shxi(int v, int o, int lane) { return __builtin_amdgcn_ds_bpermute((lane ^ o) << 2, v); }
__device__ __forceinline__ int lane_id_v() { int l; asm volatile("v_mbcnt_lo_u32_b32 %0, -1, 0\n\tv_mbcnt_hi_u32_b32 %0, -1, %0" : "=v"(l)); return l; }
constexpr int NWAVES = 8;
constexpr int D = 1024, NB = 4, S = 8192, T = NB * S, L = 4, MEM = 256, INW = 2144, INP = 2304;
constexpr int PC_CQ = 0, PC_CKV = 256, PC_KR = 384, PC_XL = 512, PC_GL = 1024, PC_QD = 1536, PC_KD = 1792, PC_VD = 2048;
constexpr float LOG2E = 1.4426950408889634f;
constexpr size_t MiB = 1u << 20;
constexpr size_t WS_CTL = 0, CTL_ZERO_BYTES = 1 * MiB;
constexpr size_t WS_WIN = 1 * MiB, WS_WOUT = 19 * MiB, WS_WCQ = 27 * MiB, WS_WCO = 35 * MiB, WS_WPQ = 43 * MiB, WS_WCKV = 51 * MiB, WS_WUQ = 67 * MiB, WS_WUKV = 68 * MiB, WS_KEYS = 69 * MiB, WS_ROPE = 70 * MiB;
constexpr size_t WS_XNB = 76 * MiB, WS_YB = 140 * MiB, WS_PROJB = 204 * MiB, WS_QMB = 348 * MiB, WS_KMB = 372 * MiB, WS_VMB = 396 * MiB, WS_RS = 412 * MiB;
constexpr size_t WS_HLB = 413 * MiB, WS_ACB = 445 * MiB, WS_LSUM = 477 * MiB, WS_OMB = 478 * MiB, WS_MNB = 494 * MiB, WS_KVCB = 502 * MiB, WS_EX = 518 * MiB, WS_GW = 534 * MiB;
constexpr size_t WS_U8 = 550 * MiB, WS_V8 = 614 * MiB, WS_SU = 678 * MiB, WS_SV = 679 * MiB;
constexpr size_t WS_HQ = 680 * MiB, WS_P = 712 * MiB, WS_SH = 728 * MiB, WS_W = 729 * MiB, WS_WS = 745 * MiB, WS_SSQ = 746 * MiB, WS_END = 748 * MiB;
constexpr size_t WS_WAT = 74 * MiB;
constexpr size_t WS_BTAB = WS_KEYS + 512 * 1024, WS_LAMS = WS_BTAB + 4096, WS_SP = WS_LAMS + 4096;
constexpr int CW_BAR = 4096, CW_RANK = 8192;
constexpr int RING_OFF = 0, RING_BYTES = 155648, LDSCTL_OFF = RING_BYTES, MISC_OFF = LDSCTL_OFF + 320, LDS_BYTES = 163840;

#define XB_TMO      128
#define XB_XCNT(j)  (256  + 64 * (j))
#define XB_XSUB(j)  (1280 + 64 * (j))
#define XB_XGEN(j)  (2304 + 64 * (j))
#define XB_TOP      3328
#define XB_TOPGEN   3392
#define XCD_BAR_WORDS 3456
#define XB_SPIN_CAP (1u << 18)

__device__ __forceinline__ unsigned xb_ld(unsigned* p)              { return __hip_atomic_load(p, __ATOMIC_RELAXED, __HIP_MEMORY_SCOPE_AGENT); }
__device__ __forceinline__ unsigned xb_add(unsigned* p, unsigned v) { return __hip_atomic_fetch_add(p, v, __ATOMIC_RELAXED, __HIP_MEMORY_SCOPE_AGENT); }
__device__ __forceinline__ unsigned xb_xcc_id() { return (unsigned)__builtin_amdgcn_s_getreg((3 << 11) | 20) & 0xFu; }
#define XB_SPIN(cond, bar) do { unsigned _sp = 0; while (cond) { __builtin_amdgcn_s_sleep(1); \
    if ((++_sp & 255u) == 0u) { if (xb_ld(&(bar)[XB_TMO])) break; if (_sp > XB_SPIN_CAP) { atomicAdd(&(bar)[XB_TMO], 1u); break; } } } } while (0)

struct XcdBarrier {
    unsigned* bar; unsigned x;
    volatile LAS unsigned* st;
};

__device__ __forceinline__ XcdBarrier xcd_barrier_post(unsigned* bar, volatile LAS unsigned* st) {
    XcdBarrier b; b.bar = bar; b.x = xb_xcc_id(); b.st = st;
    if (threadIdx.x == 0) (void)xb_add(&bar[XB_XCNT(b.x)], 1u);
    return b;
}
__device__ __forceinline__ void xcd_barrier_complete(unsigned* bar, unsigned x, unsigned& nloc, unsigned& nx) {
    const unsigned G = gridDim.x * gridDim.y * gridDim.z;
    unsigned sum, cnt, mine, sp = 0u;
    for (;;) {
        sum = 0u; cnt = 0u; mine = 0u;
#pragma unroll
        for (unsigned j = 0; j < 16; ++j) { const unsigned c = xb_ld(&bar[XB_XCNT(j)]); sum += c; cnt += (c > 0u) ? 1u : 0u; mine = (j == x) ? c : mine; }
        if (sum == G) break;
        __builtin_amdgcn_s_sleep(1);
        if ((++sp & 255u) == 0u) { if (xb_ld(&bar[XB_TMO])) break; if (sp > XB_SPIN_CAP) { atomicAdd(&bar[XB_TMO], 1u); break; } }
    }
    nloc = mine > 0u ? mine : 1u; nx = cnt > 0u ? cnt : 1u;
}

__device__ __noinline__ void xcd_barrier_impl(unsigned* bar_, unsigned x_, volatile LAS unsigned* st_, int leader_) {
    XcdBarrier b; b.bar = bar_; b.x = x_; b.st = st_;
    asm volatile("s_waitcnt vmcnt(0)" ::: "memory");
    __syncthreads();
    if (leader_) {
        unsigned* bar = b.bar;
        __builtin_amdgcn_s_waitcnt(0);
        unsigned nloc = b.st[0], nx = b.st[1];
        if (nloc == 0u) { xcd_barrier_complete(bar, b.x, nloc, nx); b.st[0] = nloc; b.st[1] = nx; }
        const unsigned old = xb_add(&bar[XB_XSUB(b.x)], 1u);
        const unsigned gen = old / nloc;
        if (old + 1u == (gen + 1u) * nloc) {
            __builtin_amdgcn_fence(__ATOMIC_RELEASE, "agent");
            asm volatile("s_waitcnt vmcnt(0)" ::: "memory");
            const unsigned og = xb_add(&bar[XB_TOP], 1u);
            const unsigned tg = og / nx;
            if (og + 1u == (tg + 1u) * nx) xb_add(&bar[XB_TOPGEN], 1u);
            else XB_SPIN(xb_ld(&bar[XB_TOPGEN]) == tg, bar);
            __builtin_amdgcn_fence(__ATOMIC_ACQUIRE, "agent");
            xb_add(&bar[XB_XGEN(b.x)], 1u);
            asm volatile("s_waitcnt vmcnt(0)" ::: "memory");
        } else {
            XB_SPIN(xb_ld(&bar[XB_XGEN(b.x)]) == gen, bar);
            __builtin_amdgcn_fence(__ATOMIC_ACQUIRE, "agent");
            asm volatile("s_waitcnt vmcnt(0)" ::: "memory");
        }
    }
    __syncthreads();
}
__device__ __forceinline__ void xcd_barrier(const XcdBarrier& b, int leader) { xcd_barrier_impl(b.bar, b.x, b.st, leader); }


__device__ __forceinline__ float wave_sum(float v, int lane) {
    (void)lane;
    v += __builtin_bit_cast(float, __builtin_amdgcn_update_dpp(0, __builtin_bit_cast(int, v), 0xB1, 0xF, 0xF, true));
    v += __builtin_bit_cast(float, __builtin_amdgcn_update_dpp(0, __builtin_bit_cast(int, v), 0x4E, 0xF, 0xF, true));
    v += __builtin_bit_cast(float, __builtin_amdgcn_update_dpp(0, __builtin_bit_cast(int, v), 0x141, 0xF, 0xF, true));
    v += __builtin_bit_cast(float, __builtin_amdgcn_update_dpp(0, __builtin_bit_cast(int, v), 0x140, 0xF, 0xF, true));
    { float a = v, b = v; asm volatile("v_nop\n\tv_nop\n\tv_permlane16_swap_b32 %0, %1" : "+v"(a), "+v"(b)); v = a + b; }
    { float a = v, b = v; asm volatile("v_nop\n\tv_nop\n\tv_permlane32_swap_b32 %0, %1" : "+v"(a), "+v"(b)); v = a + b; }
    return v;
}
__device__ __forceinline__ float wave_max(float v) {
    v = fmaxf(v, __builtin_bit_cast(float, __builtin_amdgcn_update_dpp(0, __builtin_bit_cast(int, v), 0xB1, 0xF, 0xF, true)));
    v = fmaxf(v, __builtin_bit_cast(float, __builtin_amdgcn_update_dpp(0, __builtin_bit_cast(int, v), 0x4E, 0xF, 0xF, true)));
    v = fmaxf(v, __builtin_bit_cast(float, __builtin_amdgcn_update_dpp(0, __builtin_bit_cast(int, v), 0x141, 0xF, 0xF, true)));
    v = fmaxf(v, __builtin_bit_cast(float, __builtin_amdgcn_update_dpp(0, __builtin_bit_cast(int, v), 0x140, 0xF, 0xF, true)));
    { float a = v, b = v; asm volatile("v_nop\n\tv_nop\n\tv_permlane16_swap_b32 %0, %1" : "+v"(a), "+v"(b)); v = fmaxf(a, b); }
    { float a = v, b = v; asm volatile("v_nop\n\tv_nop\n\tv_permlane32_swap_b32 %0, %1" : "+v"(a), "+v"(b)); v = fmaxf(a, b); }
    return v;
}
__device__ __forceinline__ float gelu_erf(float v) {
    const float av = __builtin_fabsf(v), t = __builtin_amdgcn_rcpf(av * 0.2316418882f + 1.0f);
    float q = t * 0.5307027145f + (-0.7265760135f); q = q * t + 0.7107068705f; q = q * t + (-0.142248368f); q = q * t + 0.127414796f; q = q * t;
    const float e = __builtin_amdgcn_exp2f((v * v) * (-0.72134752044f));
    const float m = v * (q * e);
    return v < 0.f ? m : v - m;
}

__device__ __forceinline__ void norm_phase(const GAS float* X, const GAS float* g, GAS bf16* out, int rows, int gw, int NGW, int lane) {
    asm volatile("" : "+v"(lane));
    f32x4 gv[4];
#pragma unroll
    for (int j = 0; j < 4; ++j) gv[j] = ((const GAS f32x4*)g)[lane + 64 * j];
    for (int m = gw; m < rows; m += NGW) {
        const GAS f32x4* xr = (const GAS f32x4*)(X + (size_t)m * D) + lane;
        f32x4 v[4]; float s = 0.f;
#pragma unroll
        for (int j = 0; j < 4; ++j) { v[j] = xr[64 * j]; s += (v[j].x * v[j].x + v[j].y * v[j].y) + (v[j].z * v[j].z + v[j].w * v[j].w); }
        const float rs = rsqrtf(wave_sum(s, lane) * (1.f / D) + 1e-6f);
        GAS v2u* o8 = (GAS v2u*)(out + (size_t)m * D) + lane;
#pragma unroll
        for (int j = 0; j < 4; ++j) { v2u w; w.x = pk2(v[j].x * rs * gv[j].x, v[j].y * rs * gv[j].y); w.y = pk2(v[j].z * rs * gv[j].z, v[j].w * rs * gv[j].w); o8[64 * j] = w; }
    }
}
__device__ __forceinline__ void hq_phase(const GAS bf16* XB, const GAS float* SSQ, const GAS float* g, GAS unsigned char* HQ, GAS float* SH, GAS int* Pz, int gw, int NGW, int lane) {
    asm volatile("" : "+v"(lane));
    const GAS f32x4* gp = (const GAS f32x4*)g + 4 * lane; const f32x4 g0 = gp[0], g1 = gp[1], g2 = gp[2], g3 = gp[3];
    for (int m = gw; m < T; m += NGW) {
        const GAS f32x4* sp = (const GAS f32x4*)(SSQ + (size_t)m * 16); const f32x4 t = (sp[0] + sp[1]) + (sp[2] + sp[3]);
        const float rs = __builtin_amdgcn_rsqf(((t[0] + t[1]) + (t[2] + t[3])) * (1.f / 1024.f) + 1e-6f);
        const v4u a = *(const GAS v4u*)(XB + (size_t)m * D + 16 * lane), b = *(const GAS v4u*)(XB + (size_t)m * D + 16 * lane + 8);
        float f[16] = {bflo(a.x) * g0[0], bfhi(a.x) * g0[1], bflo(a.y) * g0[2], bfhi(a.y) * g0[3], bflo(a.z) * g1[0], bfhi(a.z) * g1[1], bflo(a.w) * g1[2], bfhi(a.w) * g1[3],
                       bflo(b.x) * g2[0], bfhi(b.x) * g2[1], bflo(b.y) * g2[2], bfhi(b.y) * g2[3], bflo(b.z) * g3[0], bfhi(b.z) * g3[1], bflo(b.w) * g3[2], bfhi(b.w) * g3[3]};
        float mx = 0.f;
#pragma unroll
        for (int i = 0; i < 16; ++i) { f[i] *= rs; mx = fmaxf(mx, __builtin_fabsf(f[i])); }
        mx = wave_max(mx);
        const float inv = mx > 0.f ? 127.f / mx : 0.f;
        v4u q;
#pragma unroll
        for (int i = 0; i < 4; ++i) { const int ia = (int)__builtin_rintf(f[4 * i] * inv), ib = (int)__builtin_rintf(f[4 * i + 1] * inv), ic = (int)__builtin_rintf(f[4 * i + 2] * inv), id = (int)__builtin_rintf(f[4 * i + 3] * inv);
            q[i] = (unsigned)(ia & 255) | ((unsigned)(ib & 255) << 8) | ((unsigned)(ic & 255) << 16) | ((unsigned)(id & 255) << 24); }
        *(GAS v4u*)(HQ + (size_t)m * D + 16 * lane) = q;
        if (lane == 0) SH[m] = mx * (1.f / 127.f);
        (Pz + (size_t)m * 128)[lane] = 0; (Pz + (size_t)m * 128)[lane + 64] = 0;
    }
}
__device__ __forceinline__ void x0_phase(const GAS float* X, GAS bf16* XB, GAS float* SSQ, int gw, int NGW, int lane) {
    asm volatile("" : "+v"(lane));
    for (int m = gw; m < T; m += NGW) {
        const GAS f32x4* xr = (const GAS f32x4*)(X + (size_t)m * D) + lane; GAS v2u* o8 = (GAS v2u*)(XB + (size_t)m * D) + lane;
        float s = 0.f;
#pragma unroll
        for (int j = 0; j < 4; ++j) { const f32x4 v = xr[64 * j]; s += (v.x * v.x + v.y * v.y) + (v.z * v.z + v.w * v.w); v2u w; w.x = pk2(v.x, v.y); w.y = pk2(v.z, v.w); o8[64 * j] = w; }
        s = wave_sum(s, lane);
        if (lane < 8) SSQ[(size_t)m * 16 + lane] = lane == 0 ? s : 0.f;
    }
}
__device__ __forceinline__ void final_norm_phase(const GAS bf16* XB, GAS float* O, const GAS float* g, int rows, int gw, int NGW, int lane) {
    asm volatile("" : "+v"(lane));
    for (int m = gw; m < rows; m += NGW) {
        const GAS v4u* xr = (const GAS v4u*)(XB + (size_t)m * D) + lane;
        v4u v[2]; float s = 0.f;
#pragma unroll
        for (int j = 0; j < 2; ++j) { v[j] = xr[64 * j];
#pragma unroll
            for (int e = 0; e < 4; ++e) { const float a = bflo(v[j][e]), b = bfhi(v[j][e]); s += a * a + b * b; } }
        const float rs = rsqrtf(wave_sum(s, lane) * (1.f / D) + 1e-6f);
#pragma unroll
        for (int j = 0; j < 2; ++j) { const int c = 8 * (lane + 64 * j); const f32x4 g0 = *(const GAS f32x4*)(g + c), g1 = *(const GAS f32x4*)(g + c + 4);
            f32x4 o0, o1; o0.x = bflo(v[j].x) * rs * g0.x; o0.y = bfhi(v[j].x) * rs * g0.y; o0.z = bflo(v[j].y) * rs * g0.z; o0.w = bfhi(v[j].y) * rs * g0.w;
            o1.x = bflo(v[j].z) * rs * g1.x; o1.y = bfhi(v[j].z) * rs * g1.y; o1.z = bflo(v[j].w) * rs * g1.z; o1.w = bfhi(v[j].w) * rs * g1.w;
            *(GAS f32x4*)(O + (size_t)m * D + c) = o0; *(GAS f32x4*)(O + (size_t)m * D + c + 4) = o1; }
    }
}

__device__ __forceinline__ float row16_sum(float v) {
    v += __builtin_bit_cast(float, __builtin_amdgcn_update_dpp(0, __builtin_bit_cast(int, v), 0xB1, 0xF, 0xF, true));
    v += __builtin_bit_cast(float, __builtin_amdgcn_update_dpp(0, __builtin_bit_cast(int, v), 0x4E, 0xF, 0xF, true));
    v += __builtin_bit_cast(float, __builtin_amdgcn_update_dpp(0, __builtin_bit_cast(int, v), 0x141, 0xF, 0xF, true));
    v += __builtin_bit_cast(float, __builtin_amdgcn_update_dpp(0, __builtin_bit_cast(int, v), 0x140, 0xF, 0xF, true));
    return v;
}
__device__ __forceinline__ float sq8(const v4u w) { const float a0 = bflo(w.x), a1 = bfhi(w.x), a2 = bflo(w.y), a3 = bfhi(w.y), a4 = bflo(w.z), a5 = bfhi(w.z), a6 = bflo(w.w), a7 = bfhi(w.w);
    return (a0 * a0 + a1 * a1) + (a2 * a2 + a3 * a3) + (a4 * a4 + a5 * a5) + (a6 * a6 + a7 * a7); }
__device__ __forceinline__ void pre_phase(const GAS bf16* PROJB, const GAS float* ROPE, GAS float* RS, GAS bf16* KMB, int gw, int NGW, int lane) {
    asm volatile("" : "+v"(lane));
    const int q = lane >> 4, sub = lane & 15;
    for (int t0 = gw * 4; t0 < T; t0 += NGW * 4) {
        const size_t t = (size_t)t0 + q;
        const GAS bf16* pr = PROJB + t * INP;
        const v4u w0 = *(const GAS v4u*)(pr + PC_CQ + 8 * sub), w1 = *(const GAS v4u*)(pr + PC_CQ + 8 * (16 + (sub & 7))), w2 = *(const GAS v4u*)(pr + PC_CKV + 8 * sub);
        const float x1 = __builtin_bit_cast(float, (unsigned)pr[PC_KR + sub] << 16), x2 = __builtin_bit_cast(float, (unsigned)pr[PC_KR + 16 + sub] << 16);
        const float c = ROPE[t * 32 + sub], sn = ROPE[t * 32 + 16 + sub];
        const float sq = row16_sum(sq8(w0) + (sub < 8 ? sq8(w1) : 0.f)), skv = row16_sum(sq8(w2));
        if (sub == 0) { RS[2 * t] = rsqrtf(sq * (1.f / 192.f) + 1e-6f); RS[2 * t + 1] = rsqrtf(skv * (1.f / 128.f) + 1e-6f); }
        const bf16 y1 = (bf16)f2bf_(x1 * c - x2 * sn), y2 = (bf16)f2bf_(x1 * sn + x2 * c);
        GAS bf16* kr = KMB + t * 384 + 64 + sub;
#pragma unroll
        for (int h = 0; h < 4; ++h) { kr[h * 96] = y1; kr[h * 96 + 16] = y2; }
    }
}

typedef short lr_bf16x8 __attribute__((ext_vector_type(8)));
typedef float lr_f32x16 __attribute__((ext_vector_type(16)));
__device__ __forceinline__ void lr_swap32(float& a, float& b) { asm volatile("v_nop\n\tv_nop\n\tv_permlane32_swap_b32 %0, %1" : "+v"(a), "+v"(b)); }
constexpr int LR_XR = 0, LR_CW = LR_XR + 37376, LR_XA = LR_CW + 1280, LR_WT = LR_XA + 256 * 144, LR_SUM = LR_WT + 2 * 64 * 144, LR_END = LR_SUM + 4096;
struct LruP { const GAS bf16* PROJB; const GAS float* cw; const GAS float* cb; const GAS bf16* wat; const GAS float* ba; const GAS float* bx; const GAS float* sp; GAS unsigned* HA; GAS float* LSUM; };
__device__ __forceinline__ void lru_phase(const LruP& P, LAS unsigned char* lds, int tid, int wave, int lane, int vcu, int G) {
    asm volatile("" : "+v"(tid), "+v"(lane));
    LAS float* SUM = (LAS float*)(lds + LR_SUM);
    for (int u = vcu; u < (T / 256) * 8; u += G) {
        const int tile = u >> 3, g = u & 7; const int t0 = tile * 256; const bool first = ((tile & 31) == 0);
        __syncthreads();
        { v4u wt_[2], xr_[5];
#pragma unroll
          for (int i = 0; i < 2; ++i) { const int idx = tid + 512 * i; wt_[i] = ((const GAS v4u*)(P.wat + (size_t)g * 2 * 4096))[idx]; }
#pragma unroll
          for (int i = 0; i < 5; ++i) { const int idx = tid + 512 * i, row = idx >> 3, part = idx & 7; const bool ok = (idx < 259 * 8) && !(first && row < 3);
              const int trow = ok ? t0 - 3 + row : t0;
              xr_[i] = *(const GAS v4u*)(P.PROJB + (size_t)trow * INP + PC_XL + 64 * g + 8 * part); if (!ok) xr_[i] = v4u{0u, 0u, 0u, 0u}; }
          float cwv = 0.f; if (tid < 320) cwv = (tid < 256) ? P.cw[(tid >> 6) * 512 + 64 * g + (tid & 63)] : P.cb[64 * g + (tid - 256)];
#pragma unroll
          for (int i = 0; i < 2; ++i) { const int idx = tid + 512 * i; *(LAS v4u*)(lds + LR_WT + (idx >> 9) * 9216 + ((idx >> 3) & 63) * 144 + (idx & 7) * 16) = wt_[i]; }
#pragma unroll
          for (int i = 0; i < 5; ++i) { const int idx = tid + 512 * i, row = idx >> 3, part = idx & 7; if (idx < 259 * 8) *(LAS v4u*)(lds + LR_XR + row * 144 + 16 * part) = xr_[i]; }
          if (tid < 320) ((LAS float*)(lds + LR_CW))[tid] = cwv; }
        __syncthreads();
        { float cwr[4][8], cbr[8];
#pragma unroll
          for (int k = 0; k < 4; ++k) { const f32x4 c0 = *(const LAS f32x4*)(lds + LR_CW + (k * 64 + 8 * wave) * 4), c1 = *(const LAS f32x4*)(lds + LR_CW + (k * 64 + 8 * wave + 4) * 4);
              cwr[k][0] = c0.x; cwr[k][1] = c0.y; cwr[k][2] = c0.z; cwr[k][3] = c0.w; cwr[k][4] = c1.x; cwr[k][5] = c1.y; cwr[k][6] = c1.z; cwr[k][7] = c1.w; }
          { const f32x4 c0 = *(const LAS f32x4*)(lds + LR_CW + (256 + 8 * wave) * 4), c1 = *(const LAS f32x4*)(lds + LR_CW + (256 + 8 * wave + 4) * 4);
            cbr[0] = c0.x; cbr[1] = c0.y; cbr[2] = c0.z; cbr[3] = c0.w; cbr[4] = c1.x; cbr[5] = c1.y; cbr[6] = c1.z; cbr[7] = c1.w; }
#pragma unroll
          for (int it_ = 0; it_ < 4; ++it_) { const int time = lane + 64 * it_;
              float y[8];
#pragma unroll
              for (int e = 0; e < 8; ++e) y[e] = cbr[e];
#pragma unroll
              for (int k = 0; k < 4; ++k) { const v4u w = *(const LAS v4u*)(lds + LR_XR + (time + k) * 144 + 16 * wave);
                  y[0] += bflo(w.x) * cwr[k][0]; y[1] += bfhi(w.x) * cwr[k][1]; y[2] += bflo(w.y) * cwr[k][2]; y[3] += bfhi(w.y) * cwr[k][3];
                  y[4] += bflo(w.z) * cwr[k][4]; y[5] += bfhi(w.z) * cwr[k][5]; y[6] += bflo(w.w) * cwr[k][6]; y[7] += bfhi(w.w) * cwr[k][7]; }
              v4u o; o.x = pk2(y[0], y[1]); o.y = pk2(y[2], y[3]); o.z = pk2(y[4], y[5]); o.w = pk2(y[6], y[7]);
              *(LAS v4u*)(lds + LR_XA + time * 144 + 16 * wave) = o; } }
        __syncthreads();
        const int r32 = lane & 31, hi = lane >> 5;
        lr_f32x16 acc[2][2];
#pragma unroll
        for (int nt = 0; nt < 2; ++nt) { const float b_a = P.ba[64 * g + 32 * nt + r32], b_x = P.bx[64 * g + 32 * nt + r32];
#pragma unroll
            for (int r = 0; r < 16; ++r) { acc[0][nt][r] = b_a; acc[1][nt][r] = b_x; } }
        { lr_bf16x8 af[4];
#pragma unroll
          for (int s_ = 0; s_ < 4; ++s_) af[s_] = *(const LAS lr_bf16x8*)(lds + LR_XA + (32 * wave + r32) * 144 + (16 * s_ + 8 * hi) * 2);
#pragma unroll
          for (int gt = 0; gt < 2; ++gt)
#pragma unroll
              for (int nt = 0; nt < 2; ++nt)
#pragma unroll
                  for (int s_ = 0; s_ < 4; ++s_) { const lr_bf16x8 bfr = *(const LAS lr_bf16x8*)(lds + LR_WT + gt * 9216 + (32 * nt + r32) * 144 + (16 * s_ + 8 * hi) * 2);
                      acc[gt][nt] = __builtin_amdgcn_mfma_f32_32x32x16_bf16(af[s_], bfr, acc[gt][nt], 0, 0, 0); } }
#pragma unroll
        for (int nt = 0; nt < 2; ++nt) { const float sp = P.sp[64 * g + 32 * nt + r32];
            float sa_[4], sh_[4];
#pragma unroll
            for (int q = 0; q < 4; ++q) { float hrun = 0.f, arun = 1.f;
#pragma unroll
                for (int e = 0; e < 4; ++e) { const int r = 4 * q + e, tl = 8 * q + 4 * hi + e;
                    const float xv = __builtin_bit_cast(float, (unsigned)*(const LAS unsigned short*)(lds + LR_XA + (32 * wave + tl) * 144 + (32 * nt + r32) * 2) << 16);
                    const float rg = __builtin_amdgcn_rcpf(1.f + __builtin_amdgcn_exp2f(-LOG2E * acc[0][nt][r])), ig = __builtin_amdgcn_rcpf(1.f + __builtin_amdgcn_exp2f(-LOG2E * acc[1][nt][r]));
                    const float la = -8.0f * rg * sp; const float a_ = __builtin_amdgcn_exp2f(LOG2E * la);
                    const float uu = __builtin_amdgcn_sqrtf(fmaxf(1.f - a_ * a_, 0.f)) * (ig * xv);
                    hrun = a_ * hrun + uu; arun *= a_; acc[0][nt][r] = arun; acc[1][nt][r] = hrun; }
                sa_[q] = arun; sh_[q] = hrun; }
            float runA = 1.f, runH = 0.f;
#pragma unroll
            for (int q = 0; q < 4; ++q) { float a0 = sa_[q], a1 = sa_[q], h0 = sh_[q], h1 = sh_[q]; lr_swap32(a0, a1); lr_swap32(h0, h1);
                const float midA = runA * a0, midH = a0 * runH + h0;
                const float inA = hi ? midA : runA, inH = hi ? midH : runH;
                runA = midA * a1; runH = a1 * midH + h1;
#pragma unroll
                for (int e = 0; e < 4; ++e) { const int r = 4 * q + e; acc[1][nt][r] += acc[0][nt][r] * inH; acc[0][nt][r] *= inA; } }
            if (hi == 0) { SUM[(wave * 64 + 32 * nt + r32) * 2] = runA; SUM[(wave * 64 + 32 * nt + r32) * 2 + 1] = runH; } }
        __syncthreads();
#pragma unroll
        for (int nt = 0; nt < 2; ++nt) { const int cl = 32 * nt + r32;
            float ca = 1.f, chh = 0.f;
            for (int w = 0; w < wave; ++w) { const float aw = SUM[(w * 64 + cl) * 2], hw = SUM[(w * 64 + cl) * 2 + 1]; chh = aw * chh + hw; ca *= aw; }
            GAS unsigned* ha = P.HA + (size_t)(t0 + 32 * wave + 4 * hi) * 512 + 64 * g + cl;
#pragma unroll
            for (int r = 0; r < 16; ++r) { const float hh = acc[1][nt][r] + acc[0][nt][r] * chh, ac_ = acc[0][nt][r] * ca; ha[(size_t)((r & 3) + 8 * (r >> 2)) * 512] = pk2(hh, ac_);
                if (r == 15 && wave == 7 && hi == 1) { P.LSUM[((size_t)tile * 512 + 64 * g + cl) * 2] = ac_; P.LSUM[((size_t)tile * 512 + 64 * g + cl) * 2 + 1] = hh; } } }
    }
}

struct PostP { const GAS bf16* OMB; const GAS unsigned* HA; const GAS float* LSUM; const GAS bf16* PROJB; const GAS float* gm; const GAS float* gl; GAS bf16* Y; };
__device__ __forceinline__ void post_phase(const PostP& P, LAS unsigned char* lds, int tid, int wave, int lane, int vcu, int G) {
    asm volatile("" : "+v"(tid), "+v"(lane));
    LAS float* hin = (LAS float*)lds;
    for (int u = vcu; u < T / 64; u += G) {
        const int t0 = u * 64, tile = t0 >> 8, tb = tile & ~31;
        __syncthreads();
        { float h = 0.f;
          for (int c = tb; c < tile; ++c) { const float a = P.LSUM[((size_t)c * 512 + tid) * 2], hh = P.LSUM[((size_t)c * 512 + tid) * 2 + 1]; h = a * h + hh; }
          hin[tid] = h; }
        __syncthreads();
        f32x4 hi0 = *(const LAS f32x4*)(hin + 8 * lane), hi1 = *(const LAS f32x4*)(hin + 8 * lane + 4);
        const f32x4 g0 = *(const GAS f32x4*)(P.gl + 8 * lane), g1 = *(const GAS f32x4*)(P.gl + 8 * lane + 4), gmv = *(const GAS f32x4*)(P.gm + 4 * lane);
#pragma unroll 2
        for (int i = 0; i < 8; ++i) {
            const size_t t = (size_t)t0 + 8 * wave + i;
            const v4u p0 = *(const GAS v4u*)(P.HA + t * 512 + 8 * lane), p1 = *(const GAS v4u*)(P.HA + t * 512 + 8 * lane + 4), gw_ = *(const GAS v4u*)(P.PROJB + t * INP + PC_GL + 8 * lane);
            const v2u mw = *(const GAS v2u*)(P.OMB + t * 256 + 4 * lane);
            float o[8];
            o[0] = (bflo(p0.x) + bfhi(p0.x) * hi0.x) * gelu_erf(bflo(gw_.x)); o[1] = (bflo(p0.y) + bfhi(p0.y) * hi0.y) * gelu_erf(bfhi(gw_.x));
            o[2] = (bflo(p0.z) + bfhi(p0.z) * hi0.z) * gelu_erf(bflo(gw_.y)); o[3] = (bflo(p0.w) + bfhi(p0.w) * hi0.w) * gelu_erf(bfhi(gw_.y));
            o[4] = (bflo(p1.x) + bfhi(p1.x) * hi1.x) * gelu_erf(bflo(gw_.z)); o[5] = (bflo(p1.y) + bfhi(p1.y) * hi1.y) * gelu_erf(bfhi(gw_.z));
            o[6] = (bflo(p1.z) + bfhi(p1.z) * hi1.z) * gelu_erf(bflo(gw_.w)); o[7] = (bflo(p1.w) + bfhi(p1.w) * hi1.w) * gelu_erf(bfhi(gw_.w));
            float s2 = 0.f;
#pragma unroll
            for (int e = 0; e < 8; ++e) s2 += o[e] * o[e];
            const float m0 = bflo(mw.x), m1 = bfhi(mw.x), m2 = bflo(mw.y), m3 = bfhi(mw.y);
            float s1 = (m0 * m0 + m1 * m1) + (m2 * m2 + m3 * m3);
            s1 = wave_sum(s1, lane); s2 = wave_sum(s2, lane);
            const float r1 = rsqrtf(s1 * (1.f / 256.f) + 1e-6f), r2 = rsqrtf(s2 * (1.f / 512.f) + 1e-6f);
            GAS bf16* yr = P.Y + t * 1024;
            { v2u w; w.x = pk2(m0 * r1 * gmv.x, m1 * r1 * gmv.y); w.y = pk2(m2 * r1 * gmv.z, m3 * r1 * gmv.w); *(GAS v2u*)(yr + 4 * lane) = w; }
            { v4u w; w.x = pk2(o[0] * r2 * g0.x, o[1] * r2 * g0.y); w.y = pk2(o[2] * r2 * g0.z, o[3] * r2 * g0.w); w.z = pk2(o[4] * r2 * g1.x, o[5] * r2 * g1.y); w.w = pk2(o[6] * r2 * g1.z, o[7] * r2 * g1.w);
              *(GAS v4u*)(yr + 256 + 8 * lane) = w; }
        }
    }
}

#define TILE_BAR() asm volatile("s_waitcnt lgkmcnt(0)\n\ts_barrier" ::: "memory")
typedef short bf16x8 __attribute__((ext_vector_type(8)));
typedef short s16x4 __attribute__((ext_vector_type(4)));
typedef float f32x16 __attribute__((ext_vector_type(16)));
typedef unsigned u32x4 __attribute__((ext_vector_type(4)));
__device__ __forceinline__ int crow(int r, int hi) { return (r & 3) + 8 * (r >> 2) + 4 * hi; }
typedef float f32x2_t __attribute__((ext_vector_type(2))); typedef __bf16 bf16x2_c __attribute__((ext_vector_type(2)));
__device__ __forceinline__ unsigned cvtpk(float lo, float hi) { f32x2_t v = {lo, hi}; bf16x2_c b = __builtin_convertvector(v, bf16x2_c); return __builtin_bit_cast(unsigned, b); }
__device__ __forceinline__ float swapmax(float m) { auto rr = __builtin_amdgcn_permlane32_swap(__float_as_uint(m), __float_as_uint(m), false, false); return fmaxf(__uint_as_float(rr[0]), __uint_as_float(rr[1])); }
__device__ __forceinline__ float swapadd(float m) { auto rr = __builtin_amdgcn_permlane32_swap(__float_as_uint(m), __float_as_uint(m), false, false); return __uint_as_float(rr[0]) + __uint_as_float(rr[1]); }
__device__ __forceinline__ s16x4 vtr(const LAS unsigned char* p) { return __builtin_bit_cast(s16x4, __builtin_amdgcn_ds_read_tr16_b64_v4i16((LAS s16x4*)p)); }
__device__ __forceinline__ bf16x8 pack8(const f32x16& p, int b) { u32x4 w; w.x = cvtpk(p[b], p[b + 1]); w.y = cvtpk(p[b + 2], p[b + 3]); w.z = cvtpk(p[b + 4], p[b + 5]); w.w = cvtpk(p[b + 6], p[b + 7]); return __builtin_bit_cast(bf16x8, w); }
__device__ __forceinline__ float vmax3(float a, float b, float c) { float r; asm("v_max3_f32 %0, %1, %2, %3" : "=v"(r) : "v"(a), "v"(b), "v"(c)); return r; }
__device__ __forceinline__ float max32(const f32x16& p, const f32x16& q) {
    float a = vmax3(p[0], p[1], p[2]), b = vmax3(p[3], p[4], p[5]), c = vmax3(p[6], p[7], p[8]), d = vmax3(p[9], p[10], p[11]), e = vmax3(p[12], p[13], p[14]);
    float f = vmax3(q[0], q[1], q[2]), g = vmax3(q[3], q[4], q[5]), h = vmax3(q[6], q[7], q[8]), i = vmax3(q[9], q[10], q[11]), j = vmax3(q[12], q[13], q[14]);
    a = vmax3(a, b, c); d = vmax3(d, e, p[15]); f = vmax3(f, g, h); i = vmax3(i, j, q[15]);
    return vmax3(vmax3(a, d, f), i, i);
}
__device__ __forceinline__ float max16(const f32x16& p) { float a = fmaxf(fmaxf(p[0], p[1]), fmaxf(p[2], p[3])), b = fmaxf(fmaxf(p[4], p[5]), fmaxf(p[6], p[7])), c = fmaxf(fmaxf(p[8], p[9]), fmaxf(p[10], p[11])), d = fmaxf(fmaxf(p[12], p[13]), fmaxf(p[14], p[15])); return fmaxf(fmaxf(a, b), fmaxf(c, d)); }

struct AttnP {
    const GAS bf16* Q; const GAS bf16* K; const GAS bf16* V; int qp, kp, vp;
    GAS bf16* O; int op;
    const GAS float* rope;
    const GAS int* pos; const GAS float* btab; const GAS float* dnorm; const GAS float* lams;
};
template <int KIND> struct AK {
    static constexpr bool DIFF = KIND == 1, CROSS = KIND == 2;
    static constexpr int HW = KIND == 0 ? 96 : KIND == 1 ? 64 : 256;
    static constexpr int NKS = KIND == 0 ? 6 : KIND == 1 ? 2 : 16;
    static constexpr int KP = KIND == 0 ? 208 : KIND == 1 ? 144 : 528;
    static constexpr int ND = CROSS ? 4 : 2;
    static constexpr int CPK = HW / 8, KCH = (64 * CPK + 511) / 512;
    static constexpr int VCH = ND / 2;
    static constexpr int KB = 64 * KP, VB = ND * 4096;
    static constexpr int NBUF = CROSS ? 2 : 3;
    static constexpr int K0 = 0, V0 = NBUF * KB, POS = V0 + NBUF * VB, BT = POS + 1024, DN = BT + 528, END = DN + 256;
};
static_assert(AK<2>::END <= RING_BYTES && AK<0>::END <= RING_BYTES && AK<1>::END + 16 + 8 * 8192 <= RING_BYTES, "attention LDS");

template <int KIND, bool LEAD>
__device__ __forceinline__ void attn_unit(const AttnP& P, int b, int h, int qb, int dhalf, LAS unsigned char* lds, int tid, int wave, int lane) {
    lane = lane_id_v(); tid = (wave << 6) | lane;
    typedef AK<KIND> C;
    constexpr bool DIFF = C::DIFF, CROSS = C::CROSS;
    constexpr int HW = C::HW, NKS = C::NKS, KP = C::KP, ND = C::ND, CPK = C::CPK, KCH = C::KCH, VCH = C::VCH;
    const int r32 = lane & 31, hi = lane >> 5;
    const size_t rowb = (size_t)b * S, rowk = CROSS ? (size_t)b * MEM : rowb;
    const int q0w = qb * 256 + wave * 32, qi = q0w + r32;
    int pq = 0; float bias_far = 0.f;
    __syncthreads();
    if (DIFF) {
        pq = P.pos[rowb + qi];
        if (tid < 129) ((LAS float*)(lds + C::BT))[tid] = P.btab[h * 129 + tid];
        if (tid >= 192 && tid < 256) ((LAS float*)(lds + C::DN))[tid - 192] = P.dnorm[tid - 192];
    }
    int minq = pq;
    if (DIFF) { for (int o = 1; o < 64; o <<= 1) { const int v = shxi(minq, o, lane); minq = v < minq ? v : minq; } }
    const int NT = CROSS ? MEM / 64 : 4 * (qb + 1);
    u32x4 kr[KCH], vr[VCH]; int pkr = 0;
    u32x4 kr2[CROSS ? 1 : KCH], vr2[CROSS ? 1 : VCH]; int pkr2 = 0;
    const GAS bf16* Kb = P.K + rowk * P.kp + h * HW; const GAS bf16* Vb = P.V + rowk * P.vp + (CROSS ? h * 256 + dhalf * 128 : h * 64);
    const __amdgpu_buffer_rsrc_t rK = __builtin_amdgcn_make_buffer_rsrc((void*)Kb, 0, 0x7fffffff, 0x00020000), rV = __builtin_amdgcn_make_buffer_rsrc((void*)Vb, 0, 0x7fffffff, 0x00020000);
    const __amdgpu_buffer_rsrc_t rP = __builtin_amdgcn_make_buffer_rsrc((void*)(DIFF ? P.pos + rowb : (const GAS int*)Kb), 0, 0x7fffffff, 0x00020000);
    int kvo[KCH], vvo[VCH];
#pragma unroll
    for (int i = 0; i < KCH; ++i) { int c = tid + 512 * i; c = c < 64 * CPK ? c : tid; kvo[i] = ((c / CPK) * P.kp + (c % CPK) * 8) * 2; }
#pragma unroll
    for (int i = 0; i < VCH; ++i) { const int c = tid + 512 * i; vvo[i] = ((c / (4 * ND)) * P.vp + (c % (4 * ND)) * 8) * 2; }
    const int pvo = (tid & 63) * 4;
    auto gload = [&](int t) {
        const int ks = __builtin_amdgcn_readfirstlane(64 * t * P.kp * 2), vs = __builtin_amdgcn_readfirstlane(64 * t * P.vp * 2);
#pragma unroll
        for (int i = 0; i < KCH; ++i) kr[i] = __builtin_amdgcn_raw_buffer_load_b128(rK, kvo[i], ks, 0);
#pragma unroll
        for (int i = 0; i < VCH; ++i) vr[i] = __builtin_amdgcn_raw_buffer_load_b128(rV, vvo[i], vs, 0);
        if (DIFF) pkr = __builtin_amdgcn_raw_buffer_load_b32(rP, pvo, __builtin_amdgcn_readfirstlane(64 * t * 4), 0);
    };
    auto lstore = [&](int buf) {
        LAS unsigned char* kb_ = lds + C::K0 + buf * C::KB; LAS unsigned char* vb_ = lds + C::V0 + buf * C::VB;
#pragma unroll
        for (int i = 0; i < KCH; ++i) { int c = tid + 512 * i; c = c < 64 * CPK ? c : tid; const int key = c / CPK, part = c % CPK; *(LAS u32x4*)(kb_ + key * KP + part * 16) = kr[i]; }
#pragma unroll
        for (int i = 0; i < VCH; ++i) { const int c = tid + 512 * i; const int key = c / (4 * ND), part = c % (4 * ND); *(LAS u32x4*)(vb_ + (part >> 2) * 4096 + (key >> 3) * 512 + (key & 7) * 64 + (part & 3) * 16) = vr[i]; }
        if (DIFF) { ((LAS int*)(lds + C::POS + buf * 256))[tid & 63] = pkr; if (tid < 64) { int mk_ = pkr; for (int o = 1; o < 64; o <<= 1) { const int v = shxi(mk_, o, lane); mk_ = v > mk_ ? v : mk_; } if (tid == 0) ((LAS int*)(lds + C::POS + 768))[buf] = mk_; } }
    };
    auto gloadB = [&](int t) {
        const int ks = __builtin_amdgcn_readfirstlane(64 * t * P.kp * 2), vs = __builtin_amdgcn_readfirstlane(64 * t * P.vp * 2);
#pragma unroll
        for (int i = 0; i < (CROSS ? 1 : KCH); ++i) kr2[i] = __builtin_amdgcn_raw_buffer_load_b128(rK, kvo[i], ks, 0);
#pragma unroll
        for (int i = 0; i < (CROSS ? 1 : VCH); ++i) vr2[i] = __builtin_amdgcn_raw_buffer_load_b128(rV, vvo[i], vs, 0);
        if (DIFF) pkr2 = __builtin_amdgcn_raw_buffer_load_b32(rP, pvo, __builtin_amdgcn_readfirstlane(64 * t * 4), 0);
    };
    auto lstoreB = [&](int buf) {
        LAS unsigned char* kb_ = lds + C::K0 + buf * C::KB; LAS unsigned char* vb_ = lds + C::V0 + buf * C::VB;
#pragma unroll
        for (int i = 0; i < (CROSS ? 1 : KCH); ++i) { int c = tid + 512 * i; c = c < 64 * CPK ? c : tid; const int key = c / CPK, part = c % CPK; *(LAS u32x4*)(kb_ + key * KP + part * 16) = kr2[i]; }
#pragma unroll
        for (int i = 0; i < (CROSS ? 1 : VCH); ++i) { const int c = tid + 512 * i; const int key = c / (4 * ND), part = c % (4 * ND); *(LAS u32x4*)(vb_ + (part >> 2) * 4096 + (key >> 3) * 512 + (key & 7) * 64 + (part & 3) * 16) = vr2[i]; }
        if (DIFF) { ((LAS int*)(lds + C::POS + buf * 256))[tid & 63] = pkr2; if (tid < 64) { int mk_ = pkr2; for (int o = 1; o < 64; o <<= 1) { const int v = shxi(mk_, o, lane); mk_ = v > mk_ ? v : mk_; } if (tid == 0) ((LAS int*)(lds + C::POS + 768))[buf] = mk_; } }
    };
    LAS float* osv = (LAS float*)(lds + ((C::END + 15) & ~15)) + wave * 2048 + lane;
    float il = 0.f;
    f32x16 oA[ND];
#pragma unroll 1
    for (int mp = 0; mp < (DIFF ? 2 : 1); ++mp) {
        bf16x8 qf[NKS];
        { const GAS bf16* qrow = P.Q + (rowb + qi) * P.qp + h * HW + mp * 32;
#pragma unroll
          for (int s = 0; s < NKS; ++s) qf[s] = *(const GAS bf16x8*)(qrow + 16 * s + 8 * hi);
          if (KIND == 0) {
              const GAS float* rp = P.rope + (rowb + qi) * 32 + 8 * hi;
              const f32x4 c0 = *(const GAS f32x4*)rp, c1 = *(const GAS f32x4*)(rp + 4), s0 = *(const GAS f32x4*)(rp + 16), s1 = *(const GAS f32x4*)(rp + 20);
              const u32x4 a = __builtin_bit_cast(u32x4, qf[NKS - 2]), bq = __builtin_bit_cast(u32x4, qf[NKS - 1]); u32x4 ra, rb;
#pragma unroll
              for (int w = 0; w < 4; ++w) { const float cl = w < 2 ? c0[2 * w] : c1[2 * w - 4], ch = w < 2 ? c0[2 * w + 1] : c1[2 * w - 3], sl = w < 2 ? s0[2 * w] : s1[2 * w - 4], sh = w < 2 ? s0[2 * w + 1] : s1[2 * w - 3];
                  const float x1l = bflo(a[w]), x1h = bfhi(a[w]), x2l = bflo(bq[w]), x2h = bfhi(bq[w]);
                  ra[w] = cvtpk(x1l * cl - x2l * sl, x1h * ch - x2h * sh); rb[w] = cvtpk(x1l * sl + x2l * cl, x1h * sh + x2h * ch); }
              qf[NKS - 2] = __builtin_bit_cast(bf16x8, ra); qf[NKS - 1] = __builtin_bit_cast(bf16x8, rb);
          } }
        __syncthreads();
        float m1 = -1e30f, l1 = 0.f;
#pragma unroll
        for (int d = 0; d < ND; ++d)
#pragma unroll
            for (int r = 0; r < 16; ++r) oA[d][r] = 0.f;
        auto qk = [&](int sl, f32x16& sa, f32x16& sb, float init) {
            const LAS unsigned char* kb_ = lds + C::K0 + sl * C::KB + r32 * KP + hi * 16 + mp * 64;
#pragma unroll
            for (int r = 0; r < 16; ++r) { sa[r] = init; sb[r] = init; }
            constexpr int HB = CROSS ? 4 : (NKS > 3 ? 3 : NKS);
#pragma unroll
            for (int s0_ = 0; s0_ < NKS; s0_ += HB) {
                bf16x8 kfa[HB], kfb[HB];
#pragma unroll
                for (int s = 0; s < HB; ++s) { kfa[s] = *(const LAS bf16x8*)(kb_ + (s0_ + s) * 32); kfb[s] = *(const LAS bf16x8*)(kb_ + 32 * KP + (s0_ + s) * 32); }
                __builtin_amdgcn_sched_barrier(0);
#pragma unroll
                for (int s = 0; s < HB; ++s) { sa = __builtin_amdgcn_mfma_f32_32x32x16_bf16(kfa[s], qf[s0_ + s], sa, 0, 0, 0); sb = __builtin_amdgcn_mfma_f32_32x32x16_bf16(kfb[s], qf[s0_ + s], sb, 0, 0, 0); }
                __builtin_amdgcn_sched_barrier(0);
            }
        };
        auto isnear = [&](int sl) { bool nb = false;
            if (DIFF) { const int mk_ = __builtin_amdgcn_readfirstlane(((LAS int*)(lds + C::POS + 768))[sl]); nb = (minq - mk_) < 128; }
            return nb; };
        auto sm = [&](int t, int sl, f32x16& pa, f32x16& pb, bool nearb) -> float {
            const int k0 = 64 * t;
            if (DIFF) { if (nearb) {
                const LAS int* pk = (const LAS int*)(lds + C::POS + sl * 256); const LAS float* bt = (const LAS float*)(lds + C::BT);
#pragma unroll
                for (int r = 0; r < 16; ++r) { const int kk = crow(r, hi);
                    int n0 = pq - pk[kk], n1 = pq - pk[kk + 32]; n0 = n0 < 0 ? 0 : (n0 > 128 ? 128 : n0); n1 = n1 < 0 ? 0 : (n1 > 128 ? 128 : n1);
                    pa[r] += bt[n0]; pb[r] += bt[n1]; }
            } }
            if (!CROSS && k0 + 63 > q0w) {
#pragma unroll
                for (int r = 0; r < 16; ++r) { const int kk = k0 + crow(r, hi); if (kk > qi) pa[r] = -1e30f; if (kk + 32 > qi) pb[r] = -1e30f; }
            }
            asm volatile("s_nop 15\n\ts_nop 7" : "+v"(pa), "+v"(pb));
            float mn, al = 1.f;
            if (CROSS) { const float mx = swapmax(max32(pa, pb)); mn = fmaxf(m1, mx); al = __builtin_amdgcn_exp2f(m1 - mn); l1 *= al; }
            else { const float mx = swapmax(max32(pa, pb)); const bool up = mx > m1 + 8.0f; mn = up ? mx : m1;
                   if (__builtin_amdgcn_ballot_w64(up) != 0ull) { al = __builtin_amdgcn_exp2f(m1 - mn); l1 *= al; } }
            m1 = mn;
            float ls = 0.f;
#pragma unroll
            for (int r = 0; r < 16; ++r) { pa[r] = __builtin_amdgcn_exp2f(pa[r] - mn); pb[r] = __builtin_amdgcn_exp2f(pb[r] - mn); ls += pa[r] + pb[r]; }
            l1 += ls;
            return al;
        };
        auto pv = [&](int sl, const f32x16& pa, const f32x16& pb, float al) {
            const LAS unsigned char* vb_ = lds + C::V0 + sl * C::VB + ((lane >> 4) & 1) * 32 + (lane & 3) * 8 + (4 * hi + ((lane & 15) >> 2)) * 64;
            bf16x8 pf[4];
            pf[0] = pack8(pa, 0); pf[1] = pack8(pa, 8); pf[2] = pack8(pb, 0); pf[3] = pack8(pb, 8);
            const bool resc = CROSS ? true : (__builtin_amdgcn_ballot_w64(al != 1.0f) != 0ull);
            if (CROSS) {
#pragma unroll
                for (int d = 0; d < ND; ++d) {
                    __builtin_amdgcn_sched_barrier(0);
#pragma unroll
                    for (int r = 0; r < 16; ++r) oA[d][r] *= al;
                    bf16x8 vf[4];
#pragma unroll
                    for (int s = 0; s < 4; ++s) { const s16x4 lo = vtr(vb_ + d * 4096 + s * 1024), hh = vtr(vb_ + d * 4096 + s * 1024 + 512); vf[s] = (bf16x8){lo[0], lo[1], lo[2], lo[3], hh[0], hh[1], hh[2], hh[3]}; }
#pragma unroll
                    for (int s = 0; s < 4; ++s) oA[d] = __builtin_amdgcn_mfma_f32_32x32x16_bf16(vf[s], pf[s], oA[d], 0, 0, 0);
                }
            } else if (DIFF) {
                if (resc) {
#pragma unroll
                    for (int d = 0; d < 2; ++d)
#pragma unroll
                        for (int r = 0; r < 16; ++r) oA[d][r] *= al;
                }
#pragma unroll
                for (int d = 0; d < 2; ++d) {
                    bf16x8 vf[4];
#pragma unroll
                    for (int s = 0; s < 4; ++s) { const s16x4 lo = vtr(vb_ + d * 4096 + s * 1024), hh = vtr(vb_ + d * 4096 + s * 1024 + 512); vf[s] = (bf16x8){lo[0], lo[1], lo[2], lo[3], hh[0], hh[1], hh[2], hh[3]}; }
                    __builtin_amdgcn_sched_barrier(0);
#pragma unroll
                    for (int s = 0; s < 4; ++s) oA[d] = __builtin_amdgcn_mfma_f32_32x32x16_bf16(vf[s], pf[s], oA[d], 0, 0, 0);
                }
            } else {
                bf16x8 vf[2][4];
#pragma unroll
                for (int d = 0; d < 2; ++d)
#pragma unroll
                    for (int s = 0; s < 4; ++s) { const s16x4 lo = vtr(vb_ + d * 4096 + s * 1024), hh = vtr(vb_ + d * 4096 + s * 1024 + 512); vf[d][s] = (bf16x8){lo[0], lo[1], lo[2], lo[3], hh[0], hh[1], hh[2], hh[3]}; }
                if (resc) {
#pragma unroll
                    for (int d = 0; d < 2; ++d)
#pragma unroll
                        for (int r = 0; r < 16; ++r) oA[d][r] *= al;
                }
                __builtin_amdgcn_sched_barrier(0);
#pragma unroll
                for (int s = 0; s < 4; ++s)
#pragma unroll
                    for (int d = 0; d < 2; ++d) oA[d] = __builtin_amdgcn_mfma_f32_32x32x16_bf16(vf[d][s], pf[s], oA[d], 0, 0, 0);
            }
        };
        if (CROSS) {
            gload(0); lstore(0);
            __syncthreads();
            for (int t = 0; t < NT; ++t) {
                const int buf = t & 1;
                f32x16 pa, pb;
                qk(buf, pa, pb, 0.f);
                const float al = sm(t, buf, pa, pb, false);
                pv(buf, pa, pb, al);
                if (t + 1 < NT) { gload(t + 1); lstore(buf ^ 1); }
                TILE_BAR();
            }
        } else {
            gload(0); lstore(0); gload(1); lstore(1);
            gload(2); gloadB(3);
            __syncthreads();
            if (DIFF) bias_far = ((LAS float*)(lds + C::BT))[128];
            const int NTW = (q0w + 31) / 64 + 1;
            constexpr bool lead = LEAD;
            f32x16 ca, cb, na, nb; bool cnear = isnear(0), nnear = false; float cal = 1.f;
            qk(0, ca, cb, (DIFF && !cnear) ? bias_far : 0.f);
            if (lead) cal = sm(0, 0, ca, cb, cnear);
            int s0 = 0, s1 = 1, s2 = 2;
            auto period = [&](int t, f32x16& xa, f32x16& xb, bool& xnear, f32x16& ya, f32x16& yb, bool& ynear) {
                const bool have_next = (t + 1 < NTW);
                if (lead) {
                    if (have_next) { ynear = isnear(s1); qk(s1, ya, yb, (DIFF && !ynear) ? bias_far : 0.f); }
                    if (t < NTW) pv(s0, xa, xb, cal);
                    if (have_next) cal = sm(t + 1, s1, ya, yb, ynear);
                } else {
                    if (t < NTW) cal = sm(t, s0, xa, xb, xnear);
                    if (have_next) { ynear = isnear(s1); qk(s1, ya, yb, (DIFF && !ynear) ? bias_far : 0.f); }
                    if (t < NTW) pv(s0, xa, xb, cal);
                }
                { const int tmp = s0; s0 = s1; s1 = s2; s2 = tmp; }
            };
            int t = 0;
            for (; t + 5 < NT; t += 2) {
                lstore(s2); gload(t + 4);
                period(t, ca, cb, cnear, na, nb, nnear);
                TILE_BAR();
                lstoreB(s2); gloadB(t + 5);
                period(t + 1, na, nb, nnear, ca, cb, cnear);
                TILE_BAR();
            }
            for (; t < NT; t += 2) {
                if (t + 2 < NT) { lstore(s2); if (t + 4 < NT) gload(t + 4); }
                period(t, ca, cb, cnear, na, nb, nnear);
                TILE_BAR();
                if (t + 3 < NT) { lstoreB(s2); if (t + 5 < NT) gloadB(t + 5); }
                period(t + 1, na, nb, nnear, ca, cb, cnear);
                TILE_BAR();
            }
        }
        il = 1.f / swapadd(l1);
        if (DIFF) { if (mp == 0) {
#pragma unroll
            for (int d = 0; d < 2; ++d)
#pragma unroll
                for (int r = 0; r < 16; ++r) osv[(d * 16 + r) * 64] = oA[d][r] * il; } }
    }
    GAS bf16* orow = P.O + (rowb + qi) * P.op + (CROSS ? h * 256 + dhalf * 128 : h * 64);
    if (!DIFF) {
#pragma unroll
        for (int d = 0; d < ND; ++d)
#pragma unroll
            for (int g = 0; g < 4; ++g) { v2u v; v.x = cvtpk(oA[d][4 * g] * il, oA[d][4 * g + 1] * il); v.y = cvtpk(oA[d][4 * g + 2] * il, oA[d][4 * g + 3] * il); *(GAS v2u*)(orow + 32 * d + 8 * g + 4 * hi) = v; }
    } else {
        const float lam = P.lams[0], lam_init = P.lams[1];
        const float i2 = lam * il;
        float ss = 0.f;
#pragma unroll
        for (int d = 0; d < 2; ++d)
#pragma unroll
            for (int r = 0; r < 16; ++r) { const float v = osv[(d * 16 + r) * 64] - oA[d][r] * i2; oA[d][r] = v; ss += v * v; }
        ss = swapadd(ss);
        const float rs = __builtin_amdgcn_rsqf(ss * (1.f / 64.f) + 1e-6f) * (1.f - lam_init);
        const LAS float* dn = (const LAS float*)(lds + C::DN);
#pragma unroll
        for (int d = 0; d < 2; ++d)
#pragma unroll
            for (int g = 0; g < 4; ++g) { const int c = 32 * d + 8 * g + 4 * hi; const f32x4 gn = *(const LAS f32x4*)(dn + c);
                v2u v; v.x = cvtpk(oA[d][4 * g] * rs * gn[0], oA[d][4 * g + 1] * rs * gn[1]); v.y = cvtpk(oA[d][4 * g + 2] * rs * gn[2], oA[d][4 * g + 3] * rs * gn[3]); *(GAS v2u*)(orow + c) = v; }
    }
}

__device__ __forceinline__ int wave_max_i(int v) {
    { const int o = __builtin_amdgcn_update_dpp(0, v, 0xB1, 0xF, 0xF, true); v = o > v ? o : v; }
    { const int o = __builtin_amdgcn_update_dpp(0, v, 0x4E, 0xF, 0xF, true); v = o > v ? o : v; }
    { const int o = __builtin_amdgcn_update_dpp(0, v, 0x141, 0xF, 0xF, true); v = o > v ? o : v; }
    { const int o = __builtin_amdgcn_update_dpp(0, v, 0x140, 0xF, 0xF, true); v = o > v ? o : v; }
    { int a = v, b = v; asm volatile("v_nop\n\tv_nop\n\tv_permlane16_swap_b32 %0, %1" : "+v"(a), "+v"(b)); v = a > b ? a : b; }
    { int a = v, b = v; asm volatile("v_nop\n\tv_nop\n\tv_permlane32_swap_b32 %0, %1" : "+v"(a), "+v"(b)); v = a > b ? a : b; }
    return v;
}
template <int KIND> struct AK2 {
    static constexpr bool DIFF = KIND == 1;
    static constexpr int HW = KIND == 0 ? 96 : 64, NKS = KIND == 0 ? 6 : 2, KP = KIND == 0 ? 208 : 144;
    static constexpr int CPK = HW / 8, KCH = (128 * CPK) / 512, VCH = 2;
    static constexpr int KB = 128 * KP, VB = 2 * 8192;
    static constexpr int K0 = 0, V0 = 2 * KB, POS = V0 + 2 * VB, PMX = POS + 1024, BT = PMX + 16, DN = BT + 528, OSV = (DN + 256 + 15) & ~15, END = OSV + (DIFF ? 8 * 8192 : 0);
};
static_assert(AK2<0>::END <= RING_BYTES && AK2<1>::END <= RING_BYTES, "attention LDS (128-key tiles)");
template <int KIND>
__device__ __forceinline__ void attn_unit2(const AttnP& P, int b, int h, int qb, LAS unsigned char* lds, int tid, int wave, int lane) {
    lane = lane_id_v(); tid = (wave << 6) | lane;
    typedef AK2<KIND> C;
    constexpr bool DIFF = C::DIFF;
    constexpr int HW = C::HW, NKS = C::NKS, KP = C::KP, CPK = C::CPK, KCH = C::KCH, VCH = C::VCH;
    const int r32 = lane & 31, hi = lane >> 5;
    const size_t rowb = (size_t)b * S;
    const int q0w = qb * 256 + wave * 32, qi = q0w + r32;
    int pq = 0; float bias_far = 0.f;
    __syncthreads();
    if (DIFF) {
        pq = P.pos[rowb + qi];
        if (tid < 129) ((LAS float*)(lds + C::BT))[tid] = P.btab[h * 129 + tid];
        if (tid >= 192 && tid < 256) ((LAS float*)(lds + C::DN))[tid - 192] = P.dnorm[tid - 192];
    }
    int minq = pq;
    if (DIFF) minq = __builtin_amdgcn_readfirstlane(-wave_max_i(-pq));
    const int NT = 2 * (qb + 1);
    const GAS bf16* Kb = P.K + rowb * P.kp + h * HW; const GAS bf16* Vb = P.V + rowb * P.vp + h * 64;
    const __amdgpu_buffer_rsrc_t rK = __builtin_amdgcn_make_buffer_rsrc((void*)Kb, 0, 0x7fffffff, 0x00020000), rV = __builtin_amdgcn_make_buffer_rsrc((void*)Vb, 0, 0x7fffffff, 0x00020000);
    const __amdgpu_buffer_rsrc_t rP = __builtin_amdgcn_make_buffer_rsrc((void*)(DIFF ? P.pos + rowb : (const GAS int*)Kb), 0, 0x7fffffff, 0x00020000);
    int kvo[KCH], vvo[VCH], klo[KCH], vlo[VCH];
#pragma unroll
    for (int i = 0; i < KCH; ++i) { const int c = tid + 512 * i; kvo[i] = ((c / CPK) * P.kp + (c % CPK) * 8) * 2; klo[i] = (c / CPK) * KP + (c % CPK) * 16; }
#pragma unroll
    for (int i = 0; i < VCH; ++i) { const int c = tid + 512 * i; const int key = c >> 3, part = c & 7; vvo[i] = (key * P.vp + part * 8) * 2; vlo[i] = (part >> 2) * 8192 + (key >> 3) * 512 + (key & 7) * 64 + (part & 3) * 16; }
    const int pvo = (tid & 127) * 4;
    u32x4 kr[KCH], vr[VCH]; int pkr = 0;
    auto gload = [&](int t) {
        const int ks = __builtin_amdgcn_readfirstlane(128 * t * P.kp * 2), vs = __builtin_amdgcn_readfirstlane(128 * t * P.vp * 2);
#pragma unroll
        for (int i = 0; i < KCH; ++i) kr[i] = __builtin_amdgcn_raw_buffer_load_b128(rK, kvo[i], ks, 0);
#pragma unroll
        for (int i = 0; i < VCH; ++i) vr[i] = __builtin_amdgcn_raw_buffer_load_b128(rV, vvo[i], vs, 0);
        if (DIFF) pkr = __builtin_amdgcn_raw_buffer_load_b32(rP, pvo, __builtin_amdgcn_readfirstlane(128 * t * 4), 0);
    };
    auto lstore = [&](int buf) {
        LAS unsigned char* kb_ = lds + C::K0 + buf * C::KB; LAS unsigned char* vb_ = lds + C::V0 + buf * C::VB;
#pragma unroll
        for (int i = 0; i < KCH; ++i) *(LAS u32x4*)(kb_ + klo[i]) = kr[i];
#pragma unroll
        for (int i = 0; i < VCH; ++i) *(LAS u32x4*)(vb_ + vlo[i]) = vr[i];
        if (DIFF) { ((LAS int*)(lds + C::POS + buf * 512))[tid & 127] = pkr;
            if (tid < 128) { const int mk_ = wave_max_i(pkr); if (lane == 0) ((LAS int*)(lds + C::PMX))[buf * 2 + wave] = mk_; } }
    };
    LAS float* osv = (LAS float*)(lds + C::OSV) + wave * 2048 + lane;
    float il = 0.f;
    f32x16 oA[2];
#pragma unroll 1
    for (int mp = 0; mp < (DIFF ? 2 : 1); ++mp) {
        bf16x8 qf[NKS];
        { const GAS bf16* qrow = P.Q + (rowb + qi) * P.qp + h * HW + mp * 32;
#pragma unroll
          for (int s = 0; s < NKS; ++s) qf[s] = *(const GAS bf16x8*)(qrow + 16 * s + 8 * hi);
          if (KIND == 0) {
              const GAS float* rp = P.rope + (rowb + qi) * 32 + 8 * hi;
              const f32x4 c0 = *(const GAS f32x4*)rp, c1 = *(const GAS f32x4*)(rp + 4), s0 = *(const GAS f32x4*)(rp + 16), s1 = *(const GAS f32x4*)(rp + 20);
              const u32x4 a = __builtin_bit_cast(u32x4, qf[NKS - 2]), bq = __builtin_bit_cast(u32x4, qf[NKS - 1]); u32x4 ra, rb;
#pragma unroll
              for (int w = 0; w < 4; ++w) { const float cl = w < 2 ? c0[2 * w] : c1[2 * w - 4], ch = w < 2 ? c0[2 * w + 1] : c1[2 * w - 3], sl = w < 2 ? s0[2 * w] : s1[2 * w - 4], sh = w < 2 ? s0[2 * w + 1] : s1[2 * w - 3];
                  const float x1l = bflo(a[w]), x1h = bfhi(a[w]), x2l = bflo(bq[w]), x2h = bfhi(bq[w]);
                  ra[w] = cvtpk(x1l * cl - x2l * sl, x1h * ch - x2h * sh); rb[w] = cvtpk(x1l * sl + x2l * cl, x1h * sh + x2h * ch); }
              qf[NKS - 2] = __builtin_bit_cast(bf16x8, ra); qf[NKS - 1] = __builtin_bit_cast(bf16x8, rb);
          } }
        __syncthreads();
        float m1 = 0.f, l1 = 0.f;
        f32x16 negm;
#pragma unroll
        for (int r = 0; r < 16; ++r) negm[r] = 0.f;
#pragma unroll
        for (int d = 0; d < 2; ++d)
#pragma unroll
            for (int r = 0; r < 16; ++r) oA[d][r] = 0.f;
        gload(0); lstore(0);
        if (NT > 1) gload(1);
        __syncthreads();
        if (DIFF) { bias_far = ((LAS float*)(lds + C::BT))[128];
#pragma unroll
            for (int r = 0; r < 16; ++r) negm[r] = bias_far; }
        const int NTW = (q0w + 31) / 128 + 1;
        auto compute = [&](int t, int buf) {
            const int k0 = 128 * t;
            const LAS unsigned char* kb_ = lds + C::K0 + buf * C::KB + r32 * KP + hi * 16 + mp * 64;
            const LAS unsigned char* vb_ = lds + C::V0 + buf * C::VB + ((lane >> 4) & 1) * 32 + (lane & 3) * 8 + (4 * hi + ((lane & 15) >> 2)) * 64;
            bool nearb = false;
            if (DIFF) { const LAS int* pm = (const LAS int*)(lds + C::PMX) + buf * 2; const int m0 = __builtin_amdgcn_readfirstlane(pm[0]), m1_ = __builtin_amdgcn_readfirstlane(pm[1]); nearb = (minq - (m0 > m1_ ? m0 : m1_)) < 128; }
            f32x16 sc[4];
            if (DIFF) { if (nearb) {
#pragma unroll
                for (int g = 0; g < 4; ++g)
#pragma unroll
                    for (int r = 0; r < 16; ++r) sc[g][r] = -m1; } }
            constexpr int HB = NKS > 3 ? 3 : NKS;
#pragma unroll
            for (int s0_ = 0; s0_ < NKS; s0_ += HB) {
                bf16x8 kf[4][HB];
#pragma unroll
                for (int g = 0; g < 4; ++g)
#pragma unroll
                    for (int s = 0; s < HB; ++s) kf[g][s] = *(const LAS bf16x8*)(kb_ + 32 * g * KP + (s0_ + s) * 32);
                __builtin_amdgcn_sched_barrier(0);
#pragma unroll
                for (int s = 0; s < HB; ++s)
#pragma unroll
                    for (int g = 0; g < 4; ++g) {
                        if (s0_ + s == 0 && !(DIFF && nearb)) sc[g] = __builtin_amdgcn_mfma_f32_32x32x16_bf16(kf[g][s], qf[s0_ + s], negm, 0, 0, 0);
                        else sc[g] = __builtin_amdgcn_mfma_f32_32x32x16_bf16(kf[g][s], qf[s0_ + s], sc[g], 0, 0, 0); }
                __builtin_amdgcn_sched_barrier(0);
            }
            if (DIFF) { if (nearb) {
                const LAS int* pk = (const LAS int*)(lds + C::POS + buf * 512); const LAS float* bt = (const LAS float*)(lds + C::BT);
#pragma unroll
                for (int g = 0; g < 4; ++g)
#pragma unroll
                    for (int r = 0; r < 16; ++r) { int n0 = pq - pk[32 * g + crow(r, hi)]; n0 = n0 < 0 ? 0 : (n0 > 128 ? 128 : n0); sc[g][r] += bt[n0]; }
            } }
            asm volatile("s_nop 15\n\ts_nop 7" : "+v"(sc[0]), "+v"(sc[1]), "+v"(sc[2]), "+v"(sc[3]));
            if (k0 + 127 > q0w) {
#pragma unroll
                for (int g = 0; g < 4; ++g)
#pragma unroll
                    for (int r = 0; r < 16; ++r) { if (k0 + 32 * g + crow(r, hi) > qi) sc[g][r] = -1e30f; }
            }
            const float mx = swapmax(vmax3(max32(sc[0], sc[1]), max32(sc[2], sc[3]), -1e30f));
            const bool up = (t == 0) || mx > 8.0f;
            float al = 1.f;
            if (__builtin_amdgcn_ballot_w64(up) != 0ull) {
                const float dl = up ? mx : 0.f; al = __builtin_amdgcn_exp2f(-dl); l1 *= al; m1 += dl;
#pragma unroll
                for (int r = 0; r < 16; ++r) negm[r] -= dl;
#pragma unroll
                for (int g = 0; g < 4; ++g)
#pragma unroll
                    for (int r = 0; r < 16; ++r) sc[g][r] -= dl;
            }
            float ls = 0.f;
#pragma unroll
            for (int g = 0; g < 4; ++g)
#pragma unroll
                for (int r = 0; r < 16; ++r) { sc[g][r] = __builtin_amdgcn_exp2f(sc[g][r]); ls += sc[g][r]; }
            l1 += ls;
            bf16x8 pf[8];
#pragma unroll
            for (int g = 0; g < 4; ++g) { pf[2 * g] = pack8(sc[g], 0); pf[2 * g + 1] = pack8(sc[g], 8); }
            if (__builtin_amdgcn_ballot_w64(al != 1.0f) != 0ull) {
#pragma unroll
                for (int d = 0; d < 2; ++d)
#pragma unroll
                    for (int r = 0; r < 16; ++r) oA[d][r] *= al;
            }
#pragma unroll
            for (int d = 0; d < 2; ++d) {
                bf16x8 vf[8];
#pragma unroll
                for (int s = 0; s < 8; ++s) { const s16x4 lo = vtr(vb_ + d * 8192 + s * 1024), hh = vtr(vb_ + d * 8192 + s * 1024 + 512); vf[s] = (bf16x8){lo[0], lo[1], lo[2], lo[3], hh[0], hh[1], hh[2], hh[3]}; }
                __builtin_amdgcn_sched_barrier(0);
#pragma unroll
                for (int s = 0; s < 8; ++s) oA[d] = __builtin_amdgcn_mfma_f32_32x32x16_bf16(vf[s], pf[s], oA[d], 0, 0, 0);
                __builtin_amdgcn_sched_barrier(0);
            }
        };
        int t = 0;
        for (; t + 2 < NT; ++t) {
            const int buf = t & 1;
            if (t < NTW) compute(t, buf);
            lstore(buf ^ 1); gload(t + 2);
            TILE_BAR();
        }
        for (; t < NT; ++t) {
            const int buf = t & 1;
            if (t < NTW) compute(t, buf);
            if (t + 1 < NT) lstore(buf ^ 1);
            TILE_BAR();
        }
        il = 1.f / swapadd(l1);
        if (DIFF) { if (mp == 0) {
#pragma unroll
            for (int d = 0; d < 2; ++d)
#pragma unroll
                for (int r = 0; r < 16; ++r) osv[(d * 16 + r) * 64] = oA[d][r] * il; } }
    }
    GAS bf16* orow = P.O + (rowb + qi) * P.op + h * 64;
    if (!DIFF) {
#pragma unroll
        for (int d = 0; d < 2; ++d)
#pragma unroll
            for (int g = 0; g < 4; ++g) { v2u v; v.x = cvtpk(oA[d][4 * g] * il, oA[d][4 * g + 1] * il); v.y = cvtpk(oA[d][4 * g + 2] * il, oA[d][4 * g + 3] * il); *(GAS v2u*)(orow + 32 * d + 8 * g + 4 * hi) = v; }
    } else {
        const float lam = P.lams[0], lam_init = P.lams[1];
        const float i2 = lam * il;
        float ss = 0.f;
#pragma unroll
        for (int d = 0; d < 2; ++d)
#pragma unroll
            for (int r = 0; r < 16; ++r) { const float v = osv[(d * 16 + r) * 64] - oA[d][r] * i2; oA[d][r] = v; ss += v * v; }
        ss = swapadd(ss);
        const float rs = __builtin_amdgcn_rsqf(ss * (1.f / 64.f) + 1e-6f) * (1.f - lam_init);
        const LAS float* dn = (const LAS float*)(lds + C::DN);
#pragma unroll
        for (int d = 0; d < 2; ++d)
#pragma unroll
            for (int g = 0; g < 4; ++g) { const int c = 32 * d + 8 * g + 4 * hi; const f32x4 gn = *(const LAS f32x4*)(dn + c);
                v2u v; v.x = cvtpk(oA[d][4 * g] * rs * gn[0], oA[d][4 * g + 1] * rs * gn[1]); v.y = cvtpk(oA[d][4 * g + 2] * rs * gn[2], oA[d][4 * g + 3] * rs * gn[3]); *(GAS v2u*)(orow + c) = v; }
    }
}

__device__ __forceinline__ void attn_phase(const AttnP& PM, const AttnP& PD, LAS unsigned char* lds, int tid, int wave, int lane, int vcu, int G, int only = -1) {
    for (int i = vcu; i < 512; i += G) {
        if (only >= 0 && (i >> 8) != only) continue;
        const int kind = i >> 8, c = i & 255, bh = c >> 4, s = c & 15;
        if (kind == 0) {
#pragma unroll 1
            for (int k = 0; k < 2; ++k) attn_unit2<0>(PM, bh >> 2, bh & 3, k ? 31 - s : s, lds, tid, wave, lane);
        } else {
#pragma unroll 1
            for (int k = 0; k < 2; ++k) attn_unit2<1>(PD, bh >> 2, bh & 3, k ? 31 - s : s, lds, tid, wave, lane);
        }
    }
}
__device__ __forceinline__ float cx_max16(const f32x16& p) { return fmaxf(fmaxf(fmaxf(fmaxf(p[0], p[1]), fmaxf(p[2], p[3])), fmaxf(fmaxf(p[4], p[5]), fmaxf(p[6], p[7]))), fmaxf(fmaxf(fmaxf(p[8], p[9]), fmaxf(p[10], p[11])), fmaxf(fmaxf(p[12], p[13]), fmaxf(p[14], p[15])))); }
__device__ __forceinline__ void cross_unit2(const AttnP& P, int b, int h, int qb, LAS unsigned char* lds, int wave) {
    const int lane = lane_id_v(), tid = (wave << 6) | lane;
    constexpr int KP = 528;
    const int r32 = lane & 31, hi = lane >> 5;
    const size_t rowb = (size_t)b * S, rowk = (size_t)b * MEM;
    const int qi = qb * 256 + wave * 32 + r32;
    const GAS bf16* Kb = P.K + rowk * P.kp + h * 256; const GAS bf16* Vb = P.V + rowk * P.vp + h * 256;
    const __amdgpu_buffer_rsrc_t rK = __builtin_amdgcn_make_buffer_rsrc((void*)Kb, 0, 0x7fffffff, 0x00020000), rV = __builtin_amdgcn_make_buffer_rsrc((void*)Vb, 0, 0x7fffffff, 0x00020000);
    const GAS bf16* qrow = P.Q + (rowb + qi) * P.qp + h * 256 + 8 * hi;
    bf16x8 qf[4];
#pragma unroll
    for (int s = 0; s < 4; ++s) qf[s] = *(const GAS bf16x8*)(qrow + 16 * s);
    { u32x4 st[16];
#pragma unroll
      for (int i = 0; i < 16; ++i) { const int c = tid + 512 * i; st[i] = __builtin_amdgcn_raw_buffer_load_b128(rK, ((c >> 5) * P.kp + (c & 31) * 8) * 2, 0, 0); }
      TILE_BAR();
#pragma unroll
      for (int i = 0; i < 16; ++i) { const int c = tid + 512 * i; *(LAS u32x4*)(lds + (c >> 5) * KP + (c & 31) * 16) = st[i]; } }
    __syncthreads();
    f32x16 sc[8];
#pragma unroll
    for (int g = 0; g < 8; ++g)
#pragma unroll
        for (int r = 0; r < 16; ++r) sc[g][r] = 0.f;
    const LAS unsigned char* kb_ = lds + r32 * KP + hi * 16;
#pragma unroll
    for (int c = 0; c < 4; ++c) {
        bf16x8 qn[4];
        if (c + 1 < 4) {
#pragma unroll
            for (int s = 0; s < 4; ++s) qn[s] = *(const GAS bf16x8*)(qrow + 64 * (c + 1) + 16 * s); }
#pragma unroll
        for (int g = 0; g < 8; ++g) { bf16x8 kf[4];
#pragma unroll
            for (int s = 0; s < 4; ++s) kf[s] = *(const LAS bf16x8*)(kb_ + 32 * g * KP + (4 * c + s) * 32);
#pragma unroll
            for (int s = 0; s < 4; ++s) sc[g] = __builtin_amdgcn_mfma_f32_32x32x16_bf16(kf[s], qf[s], sc[g], 0, 0, 0); }
        if (c + 1 < 4) {
#pragma unroll
            for (int s = 0; s < 4; ++s) qf[s] = qn[s]; }
    }
    float m = fmaxf(fmaxf(fmaxf(cx_max16(sc[0]), cx_max16(sc[1])), fmaxf(cx_max16(sc[2]), cx_max16(sc[3]))), fmaxf(fmaxf(cx_max16(sc[4]), cx_max16(sc[5])), fmaxf(cx_max16(sc[6]), cx_max16(sc[7]))));
    m = swapmax(m);
    float l = 0.f;
    bf16x8 pf[16];
#pragma unroll
    for (int g = 0; g < 8; ++g) {
#pragma unroll
        for (int r = 0; r < 16; ++r) { sc[g][r] = __builtin_amdgcn_exp2f(sc[g][r] - m); l += sc[g][r]; }
        pf[2 * g] = pack8(sc[g], 0); pf[2 * g + 1] = pack8(sc[g], 8); }
    const float il = 1.f / swapadd(l);
    { u32x4 st[16];
#pragma unroll
      for (int i = 0; i < 16; ++i) { const int c = tid + 512 * i; const int sub = c & 3, key = (c >> 2) & 255, dt = c >> 10; st[i] = __builtin_amdgcn_raw_buffer_load_b128(rV, (key * P.vp + dt * 32 + sub * 8) * 2, 0, 0); }
      TILE_BAR();
#pragma unroll
      for (int i = 0; i < 16; ++i) { const int c = tid + 512 * i; const int sub = c & 3, key = (c >> 2) & 255, dt = c >> 10; *(LAS u32x4*)(lds + dt * 16384 + (key >> 3) * 512 + (key & 7) * 64 + sub * 16) = st[i]; } }
    __syncthreads();
    const LAS unsigned char* vb_ = lds + ((lane >> 4) & 1) * 32 + (lane & 3) * 8 + (4 * hi + ((lane & 15) >> 2)) * 64;
    GAS bf16* orow = P.O + (rowb + qi) * P.op + h * 256;
#pragma unroll 1
    for (int dh = 0; dh < 2; ++dh) {
        f32x16 oA[4];
#pragma unroll
        for (int d = 0; d < 4; ++d)
#pragma unroll
            for (int r = 0; r < 16; ++r) oA[d][r] = 0.f;
#pragma unroll
        for (int d = 0; d < 4; ++d) {
#pragma unroll
            for (int sb = 0; sb < 2; ++sb) { bf16x8 vf[8];
#pragma unroll
                for (int s = 0; s < 8; ++s) { const s16x4 lo = vtr(vb_ + (4 * dh + d) * 16384 + (8 * sb + s) * 1024), hh = vtr(vb_ + (4 * dh + d) * 16384 + (8 * sb + s) * 1024 + 512); vf[s] = (bf16x8){lo[0], lo[1], lo[2], lo[3], hh[0], hh[1], hh[2], hh[3]}; }
#pragma unroll
                for (int s = 0; s < 8; ++s) oA[d] = __builtin_amdgcn_mfma_f32_32x32x16_bf16(vf[s], pf[8 * sb + s], oA[d], 0, 0, 0); } }
#pragma unroll
        for (int d = 0; d < 4; ++d)
#pragma unroll
            for (int g = 0; g < 4; ++g) { v2u v; v.x = cvtpk(oA[d][4 * g] * il, oA[d][4 * g + 1] * il); v.y = cvtpk(oA[d][4 * g + 2] * il, oA[d][4 * g + 3] * il); *(GAS v2u*)(orow + 128 * dh + 32 * d + 8 * g + 4 * hi) = v; }
    }
}
__device__ __forceinline__ void cross_phase(const AttnP& PC, LAS unsigned char* lds, int tid, int wave, int lane, int vcu, int G) {
#pragma unroll 1
    for (int i = vcu; i < 512; i += G) { const int bh = i >> 5; cross_unit2(PC, bh >> 2, bh & 3, i & 31, lds, wave); }
}


__device__ __forceinline__ float vmax2(float a, float b) { float r; asm("v_max_f32_e32 %0, %1, %2" : "=v"(r) : "v"(a), "v"(b)); return r; }
__device__ __forceinline__ float vmin2(float a, float b) { float r; asm("v_min_f32_e32 %0, %1, %2" : "=v"(r) : "v"(a), "v"(b)); return r; }
__device__ __forceinline__ void pad16(float (&a)[16]) {
    asm volatile("s_nop 1" : "+v"(a[0]), "+v"(a[1]), "+v"(a[2]), "+v"(a[3]), "+v"(a[4]), "+v"(a[5]), "+v"(a[6]), "+v"(a[7]), "+v"(a[8]), "+v"(a[9]), "+v"(a[10]), "+v"(a[11]), "+v"(a[12]), "+v"(a[13]), "+v"(a[14]), "+v"(a[15]));
}
__device__ __forceinline__ void sort16_desc(float (&a)[16]) {
#pragma unroll
    for (int k = 2; k <= 16; k <<= 1)
#pragma unroll
        for (int j = k >> 1; j > 0; j >>= 1)
#pragma unroll
            for (int i = 0; i < 16; ++i) { const int l = i ^ j; if (l > i) { const bool desc = ((i & k) == 0); const float hi_ = vmax2(a[i], a[l]), lo_ = vmin2(a[i], a[l]); a[i] = desc ? hi_ : lo_; a[l] = desc ? lo_ : hi_; } }
}
__device__ __forceinline__ void merge16_desc(float (&a)[16], const float (&b)[16]) {
#pragma unroll
    for (int i = 0; i < 16; ++i) a[i] = vmax2(a[i], b[15 - i]);
#pragma unroll
    for (int j = 8; j > 0; j >>= 1)
#pragma unroll
        for (int i = 0; i < 16; ++i) { const int l = i ^ j; if (l > i) { const float hi_ = vmax2(a[i], a[l]), lo_ = vmin2(a[i], a[l]); a[i] = hi_; a[l] = lo_; } }
}
__device__ __forceinline__ void top16_of_64(float (&g0)[16], float (&g1)[16], float (&g2)[16], float (&g3)[16]) {
    sort16_desc(g0); sort16_desc(g1); merge16_desc(g0, g1); sort16_desc(g2); sort16_desc(g3); merge16_desc(g2, g3); merge16_desc(g0, g2);
}
__device__ __forceinline__ float embed(float v, unsigned mask, unsigned id) { return __builtin_bit_cast(float, (__builtin_bit_cast(unsigned, v) & mask) | id); }
__device__ __forceinline__ float mkcand(float x, float y, unsigned id) { return embed(x + y, 0xFFFFFF00u, id); }

__device__ __forceinline__ void swap32(float& a, float& b) { asm volatile("v_nop\n\tv_nop\n\tv_permlane32_swap_b32 %0, %1" : "+v"(a), "+v"(b)); }
struct RouteP { const GAS bf16* QP; const GAS bf16* keys; GAS int* EX; GAS float* GW; };
constexpr int RT_KP = 144, RT_KEYS = 0, RT_SCR = 256 * RT_KP, RT_END = RT_SCR + 8 * 8192;
__device__ __forceinline__ void route_phase(const RouteP& P, LAS unsigned char* lds, int tid, int wave, int lane, int vcu, int G) {
    asm volatile("" : "+v"(tid), "+v"(lane));
    __syncthreads();
    for (int c = tid; c < 256 * 8; c += 512) { const int row = c >> 3, part = c & 7; *(LAS u32x4*)(lds + RT_KEYS + row * RT_KP + part * 16) = *(const u32x4*)(P.keys + row * 64 + part * 8); }
    __syncthreads();
    const int r32 = lane & 31, hi = lane >> 5;
    LAS int* scr = (LAS int*)(lds + RT_SCR + wave * 8192);
    for (int u = vcu; u < T / 32; u += G) {
        const size_t t = (size_t)u * 32 + r32; const int h = wave;
        float T2[2][16];
#pragma unroll
        for (int c = 0; c < 2; ++c) {
            bf16x8 qf[4];
            { const GAS bf16* q = P.QP + t * 1024 + h * 128 + c * 64 + 8 * hi;
#pragma unroll
              for (int s = 0; s < 4; ++s) qf[s] = *(const GAS bf16x8*)(q + 16 * s); }
            f32x16 sc[4];
#pragma unroll
            for (int m = 0; m < 4; ++m) {
#pragma unroll
                for (int r = 0; r < 16; ++r) sc[m][r] = 0.f;
#pragma unroll
                for (int s = 0; s < 4; ++s) { const bf16x8 a = *(const LAS bf16x8*)(lds + RT_KEYS + (c * 128 + 32 * m + r32) * RT_KP + s * 32 + hi * 16);
                    sc[m] = __builtin_amdgcn_mfma_f32_32x32x16_bf16(a, qf[s], sc[m], 0, 0, 0); }
            }
            float g0[16], g1[16], g2[16], g3[16];
            const unsigned h4 = 4u * (unsigned)hi;
#pragma unroll
            for (int r = 0; r < 16; ++r) { const unsigned kr_ = (unsigned)((r & 3) + 8 * (r >> 2));
                g0[r] = embed(sc[0][r], 0xFFFFFF80u, kr_ | h4); g1[r] = embed(sc[1][r], 0xFFFFFF80u, (32u + kr_) | h4); g2[r] = embed(sc[2][r], 0xFFFFFF80u, (64u + kr_) | h4); g3[r] = embed(sc[3][r], 0xFFFFFF80u, (96u + kr_) | h4); }
            top16_of_64(g0, g1, g2, g3);
            pad16(g0);
#pragma unroll
            for (int i = 0; i < 16; ++i) T2[c][i] = g0[i];
        }
        float A[16], Bv[16];
#pragma unroll
        for (int i = 0; i < 16; ++i) { A[i] = T2[0][i]; Bv[i] = T2[1][i]; swap32(A[i], Bv[i]); }
        merge16_desc(A, Bv);
        pad16(A);
        float T0[16], T1[16];
#pragma unroll
        for (int i = 0; i < 16; ++i) { T0[i] = A[i]; T1[i] = A[i]; swap32(T0[i], T1[i]); }
#pragma unroll
        for (int i = 0; i < 16; ++i) { scr[i * 64 + lane] = (int)(__builtin_bit_cast(unsigned, T0[i]) & 127u); scr[(16 + i) * 64 + lane] = (int)(__builtin_bit_cast(unsigned, T1[i]) & 127u);
            T0[i] = embed(T0[i], 0xFFFFFF80u, 0u); T1[i] = embed(T1[i], 0xFFFFFF80u, 0u); }
        float c0[16], c1[16], c2[16], c3[16];
        const float NINF = -__builtin_inff();
#pragma unroll
        for (int b = 0; b < 16; ++b) c0[b] = mkcand(T0[0], T1[b], (unsigned)b);
#pragma unroll
        for (int b = 0; b < 8; ++b) c1[b] = mkcand(T0[1], T1[b], 16u + b);
#pragma unroll
        for (int b = 0; b < 5; ++b) c1[8 + b] = mkcand(T0[2], T1[b], 32u + b);
#pragma unroll
        for (int b = 0; b < 3; ++b) c1[13 + b] = mkcand(T0[4], T1[b], 64u + b);
#pragma unroll
        for (int b = 0; b < 4; ++b) c2[b] = mkcand(T0[3], T1[b], 48u + b);
        c2[4] = mkcand(T0[5], T1[0], 80u); c2[5] = mkcand(T0[5], T1[1], 81u); c2[6] = mkcand(T0[6], T1[0], 96u); c2[7] = mkcand(T0[6], T1[1], 97u); c2[8] = mkcand(T0[7], T1[0], 112u); c2[9] = mkcand(T0[7], T1[1], 113u);
#pragma unroll
        for (int a = 8; a < 14; ++a) c2[10 + a - 8] = mkcand(T0[a], T1[0], 16u * a);
        c3[0] = mkcand(T0[14], T1[0], 224u); c3[1] = mkcand(T0[15], T1[0], 240u);
#pragma unroll
        for (int i = 2; i < 16; ++i) c3[i] = NINF;
        top16_of_64(c0, c1, c2, c3);
        pad16(c0);
        float gsum = 0.f, ge[16]; int ex[16];
        const float mtop = embed(c0[0], 0xFFFFFF00u, 0u);
#pragma unroll
        for (int i = 0; i < 16; ++i) { const unsigned bits = __builtin_bit_cast(unsigned, c0[i]); const int a = (bits >> 4) & 15, b = bits & 15;
            ge[i] = __builtin_amdgcn_exp2f((embed(c0[i], 0xFFFFFF00u, 0u) - mtop) * LOG2E); gsum += ge[i];
            ex[i] = scr[a * 64 + lane] * 128 + scr[(16 + b) * 64 + lane]; }
        const float ginv = __builtin_amdgcn_rcpf(gsum);
        if (hi == 0) { GAS v4u* d = (GAS v4u*)(P.EX + t * 128 + h * 16);
#pragma unroll
            for (int i = 0; i < 4; ++i) d[i] = (v4u){(unsigned)ex[4 * i], (unsigned)ex[4 * i + 1], (unsigned)ex[4 * i + 2], (unsigned)ex[4 * i + 3]}; }
        else { GAS f32x4* d = (GAS f32x4*)(P.GW + t * 128 + h * 16);
#pragma unroll
            for (int i = 0; i < 4; ++i) d[i] = (f32x4){ge[4 * i] * ginv, ge[4 * i + 1] * ginv, ge[4 * i + 2] * ginv, ge[4 * i + 3] * ginv}; }
    }
}

__device__ __forceinline__ int wave_allsum_i(int v) {
    v += __builtin_amdgcn_update_dpp(0, v, 0xB1, 0xF, 0xF, true);
    v += __builtin_amdgcn_update_dpp(0, v, 0x4E, 0xF, 0xF, true);
    v += __builtin_amdgcn_update_dpp(0, v, 0x141, 0xF, 0xF, true);
    v += __builtin_amdgcn_update_dpp(0, v, 0x140, 0xF, 0xF, true);
    { int a = v, b = v; asm volatile("v_nop\n\tv_nop\n\tv_permlane16_swap_b32 %0, %1" : "+v"(a), "+v"(b)); v = a + b; }
    { int a = v, b = v; asm volatile("v_nop\n\tv_nop\n\tv_permlane32_swap_b32 %0, %1" : "+v"(a), "+v"(b)); v = a + b; }
    return v;
}
__device__ __forceinline__ float wave_allsum(float v) {
    v += __builtin_bit_cast(float, __builtin_amdgcn_update_dpp(0, __builtin_bit_cast(int, v), 0xB1, 0xF, 0xF, true));
    v += __builtin_bit_cast(float, __builtin_amdgcn_update_dpp(0, __builtin_bit_cast(int, v), 0x4E, 0xF, 0xF, true));
    v += __builtin_bit_cast(float, __builtin_amdgcn_update_dpp(0, __builtin_bit_cast(int, v), 0x141, 0xF, 0xF, true));
    v += __builtin_bit_cast(float, __builtin_amdgcn_update_dpp(0, __builtin_bit_cast(int, v), 0x140, 0xF, 0xF, true));
    { float a = v, b = v; asm volatile("v_nop\n\tv_nop\n\tv_permlane16_swap_b32 %0, %1" : "+v"(a), "+v"(b)); v = a + b; }
    { float a = v, b = v; asm volatile("v_nop\n\tv_nop\n\tv_permlane32_swap_b32 %0, %1" : "+v"(a), "+v"(b)); v = a + b; }
    return v;
}
__device__ __forceinline__ float wave_allmax(float v) {
    v = fmaxf(v, __builtin_bit_cast(float, __builtin_amdgcn_update_dpp(0, __builtin_bit_cast(int, v), 0xB1, 0xF, 0xF, true)));
    v = fmaxf(v, __builtin_bit_cast(float, __builtin_amdgcn_update_dpp(0, __builtin_bit_cast(int, v), 0x4E, 0xF, 0xF, true)));
    v = fmaxf(v, __builtin_bit_cast(float, __builtin_amdgcn_update_dpp(0, __builtin_bit_cast(int, v), 0x141, 0xF, 0xF, true)));
    v = fmaxf(v, __builtin_bit_cast(float, __builtin_amdgcn_update_dpp(0, __builtin_bit_cast(int, v), 0x140, 0xF, 0xF, true)));
    { float a = v, b = v; asm volatile("v_nop\n\tv_nop\n\tv_permlane16_swap_b32 %0, %1" : "+v"(a), "+v"(b)); v = fmaxf(a, b); }
    { float a = v, b = v; asm volatile("v_nop\n\tv_nop\n\tv_permlane32_swap_b32 %0, %1" : "+v"(a), "+v"(b)); v = fmaxf(a, b); }
    return v;
}
__device__ __forceinline__ unsigned q4(float a, float b, float c, float d, int off) {
    const int ia = (int)__builtin_rintf(a) + off, ib = (int)__builtin_rintf(b) + off, ic = (int)__builtin_rintf(c) + off, id = (int)__builtin_rintf(d) + off;
    return (unsigned)(ia & 255) | ((unsigned)(ib & 255) << 8) | ((unsigned)(ic & 255) << 16) | ((unsigned)(id & 255) << 24);
}
__device__ __forceinline__ void quant_row(const GAS float* src, GAS unsigned* dst, GAS float* scale, int off, int lane) {
    const GAS f32x4* s = (const GAS f32x4*)src + 4 * lane; f32x4 v[4]; float m = 0.f;
#pragma unroll
    for (int i = 0; i < 4; ++i) { v[i] = s[i]; m = fmaxf(m, fmaxf(fmaxf(__builtin_fabsf(v[i].x), __builtin_fabsf(v[i].y)), fmaxf(__builtin_fabsf(v[i].z), __builtin_fabsf(v[i].w)))); }
    m = wave_allmax(m); const float inv = m > 0.f ? 127.f / m : 0.f;
    v4u w;
    w.x = q4(v[0].x * inv, v[0].y * inv, v[0].z * inv, v[0].w * inv, off); w.y = q4(v[1].x * inv, v[1].y * inv, v[1].z * inv, v[1].w * inv, off);
    w.z = q4(v[2].x * inv, v[2].y * inv, v[2].z * inv, v[2].w * inv, off); w.w = q4(v[3].x * inv, v[3].y * inv, v[3].z * inv, v[3].w * inv, off);
    *((GAS v4u*)dst + lane) = w;
    if (lane == 0) *scale = m * (1.f / 127.f);
}
struct PeerS { int nslices_step, first_slice, nloc, rank; };
__device__ __forceinline__ PeerS peer_sched(const GAS unsigned* rankw, int xcc, int rank) {
    int nx = 0, myidx = 0, nloc = 1;
    for (int j = 0; j < 16; ++j) { const int c = (int)__hip_atomic_load(rankw + 64 * j, __ATOMIC_RELAXED, __HIP_MEMORY_SCOPE_AGENT); if (c > 0) { if (j == xcc) { myidx = nx; nloc = c; } ++nx; } }
    PeerS s; s.nslices_step = nx > 0 ? nx : 1; s.first_slice = myidx; s.nloc = nloc; s.rank = rank; return s;
}
struct Peer1P { const GAS unsigned GAS char* HQ; const GAS int* EX; const GAS unsigned GAS char* U8; GAS int* P; };
__device__ __forceinline__ void peer_k1(const Peer1P& Q, const PeerS& sc, int wave, int lane) {
    asm volatile("" : "+v"(lane));
    const int g = lane >> 3, j = lane & 7;
    for (int s = sc.first_slice; s < 8; s += sc.nslices_step)
        for (int tile = sc.rank; tile < T / 64; tile += sc.nloc) {
            const size_t t0 = (size_t)tile * 64 + wave * 8;
            v4u hqn = *(const GAS v4u*)(Q.HQ + t0 * 1024 + 128 * s + 16 * j), exn[4];
#pragma unroll
            for (int i = 0; i < 4; ++i) exn[i] = *(const GAS v4u*)(Q.EX + t0 * 128 + 16 * g + 4 * i);
#pragma unroll 1
            for (int k = 0; k < 8; ++k) {
                const size_t t = t0 + k;
                const v4u hq = hqn; v4u ex[4];
#pragma unroll
                for (int i = 0; i < 4; ++i) ex[i] = exn[i];
                if (k + 1 < 8) {
                    hqn = *(const GAS v4u*)(Q.HQ + (t + 1) * 1024 + 128 * s + 16 * j);
#pragma unroll
                    for (int i = 0; i < 4; ++i) exn[i] = *(const GAS v4u*)(Q.EX + (t + 1) * 128 + 16 * g + 4 * i);
                }
                v4u uu[16];
#pragma unroll
                for (int i = 0; i < 16; ++i) { const unsigned e = (i & 3) == 0 ? ex[i >> 2].x : (i & 3) == 1 ? ex[i >> 2].y : (i & 3) == 2 ? ex[i >> 2].z : ex[i >> 2].w;
                    uu[i] = *(const GAS v4u*)(Q.U8 + (size_t)e * 1024 + 128 * s + 16 * j); }
                int lo = 0, hi = 0;
#pragma unroll
                for (int i = 0; i < 16; ++i) {
                    int p = __builtin_amdgcn_sdot4((int)uu[i].x, (int)hq.x, 0, false); p = __builtin_amdgcn_sdot4((int)uu[i].y, (int)hq.y, p, false); p = __builtin_amdgcn_sdot4((int)uu[i].z, (int)hq.z, p, false); p = __builtin_amdgcn_sdot4((int)uu[i].w, (int)hq.w, p, false);
                    p += __builtin_amdgcn_update_dpp(0, p, 0xB1, 0xF, 0xF, true); p += __builtin_amdgcn_update_dpp(0, p, 0x4E, 0xF, 0xF, true); p += __builtin_amdgcn_update_dpp(0, p, 0x141, 0xF, 0xF, true);
                    if (i < 8) lo = (j == i) ? p : lo; else hi = (j == i - 8) ? p : hi;
                }
                GAS int* prow = Q.P + t * 128 + 16 * g + j;
                (void)__hip_atomic_fetch_add(prow, lo, __ATOMIC_RELAXED, __HIP_MEMORY_SCOPE_AGENT); (void)__hip_atomic_fetch_add(prow + 8, hi, __ATOMIC_RELAXED, __HIP_MEMORY_SCOPE_AGENT);
            }
        }
}
__device__ __forceinline__ void peer_w(const GAS int* EX, const GAS float* GW, const GAS int* P, const GAS float* SH, const GAS float* SU, const GAS float* SV, GAS signed char* WQ, GAS float* WSC, int gw, int NGW, int lane) {
    asm volatile("" : "+v"(lane));
    for (int t = gw; t < T; t += NGW) {
        const float sh = SH[t];
#pragma unroll
        for (int q = 0; q < 2; ++q) { const size_t idx = (size_t)t * 128 + lane + 64 * q; const int e = EX[idx];
            const float w = GW[idx] * gelu_erf((float)P[idx] * (sh * SU[e])) * SV[e];
            float m = __builtin_fabsf(w);
            m = fmaxf(m, __builtin_bit_cast(float, __builtin_amdgcn_update_dpp(0, __builtin_bit_cast(int, m), 0xB1, 0xF, 0xF, true)));
            m = fmaxf(m, __builtin_bit_cast(float, __builtin_amdgcn_update_dpp(0, __builtin_bit_cast(int, m), 0x4E, 0xF, 0xF, true)));
            m = fmaxf(m, __builtin_bit_cast(float, __builtin_amdgcn_update_dpp(0, __builtin_bit_cast(int, m), 0x141, 0xF, 0xF, true)));
            m = fmaxf(m, __builtin_bit_cast(float, __builtin_amdgcn_update_dpp(0, __builtin_bit_cast(int, m), 0x140, 0xF, 0xF, true)));
            const float inv = m > 0.f ? 127.f / m : 0.f;
            WQ[idx] = (signed char)(int)__builtin_rintf(w * inv);
            if ((lane & 15) == 0) WSC[(size_t)t * 8 + (lane >> 4) + 4 * q] = m * (1.f / 127.f); }
    }
}
__device__ __forceinline__ void tr4x4(unsigned r0, unsigned r1, unsigned r2, unsigned r3, unsigned (&t)[4]) {
    const unsigned x0 = __builtin_amdgcn_perm(r1, r0, 0x05010400u), x1 = __builtin_amdgcn_perm(r1, r0, 0x07030602u), y0 = __builtin_amdgcn_perm(r3, r2, 0x05010400u), y1 = __builtin_amdgcn_perm(r3, r2, 0x07030602u);
    t[0] = __builtin_amdgcn_perm(y0, x0, 0x05040100u); t[1] = __builtin_amdgcn_perm(y0, x0, 0x07060302u); t[2] = __builtin_amdgcn_perm(y1, x1, 0x05040100u); t[3] = __builtin_amdgcn_perm(y1, x1, 0x07060302u);
}
struct Peer2P { const GAS int* EX; const GAS signed char* WQ; const GAS float* WSC; const GAS unsigned char* V8; GAS bf16* XB; GAS float* SSQ; };
__device__ __forceinline__ void peer_k2(const Peer2P& Q, const PeerS& sc, int wave, int lane) {
    asm volatile("" : "+v"(lane));
    const int g = lane >> 3, j = lane & 7, hf = lane >> 5, rp = (lane >> 4) & 1;
    for (int s = sc.first_slice; s < 8; s += sc.nslices_step)
        for (int tile = sc.rank; tile < T / 64; tile += sc.nloc) {
            const size_t t0 = (size_t)tile * 64 + wave * 8;
            v4u exn[4], wqn; float swn;
#pragma unroll
            for (int i = 0; i < 4; ++i) exn[i] = *(const GAS v4u*)(Q.EX + t0 * 128 + 16 * g + 4 * i);
            wqn = *(const GAS v4u*)(Q.WQ + t0 * 128 + 16 * g); swn = Q.WSC[t0 * 8 + g];
#pragma unroll 1
            for (int k = 0; k < 8; ++k) {
                const size_t t = t0 + k;
                v4u ex[4]; const v4u wq = wqn; const float sw = swn;
#pragma unroll
                for (int i = 0; i < 4; ++i) ex[i] = exn[i];
                if (k + 1 < 8) {
#pragma unroll
                    for (int i = 0; i < 4; ++i) exn[i] = *(const GAS v4u*)(Q.EX + (t + 1) * 128 + 16 * g + 4 * i);
                    wqn = *(const GAS v4u*)(Q.WQ + (t + 1) * 128 + 16 * g); swn = Q.WSC[(t + 1) * 8 + g];
                }
                GAS v2u* xp = (GAS v2u*)(Q.XB + t * 1024 + 128 * s + 16 * j + 8 * hf + 4 * rp);
                const v2u xold = *xp;
                v4u vv[16];
#pragma unroll
                for (int i = 0; i < 16; ++i) { const unsigned e = (i & 3) == 0 ? ex[i >> 2].x : (i & 3) == 1 ? ex[i >> 2].y : (i & 3) == 2 ? ex[i >> 2].z : ex[i >> 2].w;
                    vv[i] = *(const GAS v4u*)(Q.V8 + (size_t)e * 1024 + 128 * s + 16 * j); }
                int ai[16];
#pragma unroll
                for (int i = 0; i < 16; ++i) ai[i] = 0;
#pragma unroll
                for (int q4_ = 0; q4_ < 4; ++q4_) {
                    const unsigned wq4 = q4_ == 0 ? wq.x : q4_ == 1 ? wq.y : q4_ == 2 ? wq.z : wq.w;
#pragma unroll
                    for (int c = 0; c < 4; ++c) { unsigned tt[4];
                        const v4u &a0 = vv[4 * q4_], &a1 = vv[4 * q4_ + 1], &a2 = vv[4 * q4_ + 2], &a3 = vv[4 * q4_ + 3];
                        tr4x4(c == 0 ? a0.x : c == 1 ? a0.y : c == 2 ? a0.z : a0.w, c == 0 ? a1.x : c == 1 ? a1.y : c == 2 ? a1.z : a1.w, c == 0 ? a2.x : c == 1 ? a2.y : c == 2 ? a2.z : a2.w, c == 0 ? a3.x : c == 1 ? a3.y : c == 2 ? a3.z : a3.w, tt);
#pragma unroll
                        for (int b = 0; b < 4; ++b) ai[4 * c + b] = __builtin_amdgcn_sdot4((int)tt[b], (int)wq4, ai[4 * c + b], false); }
                }
                float acc[16];
#pragma unroll
                for (int i = 0; i < 16; ++i) acc[i] = (float)ai[i] * sw;
                float r8[8], r4[4];
#pragma unroll
                for (int m = 0; m < 8; ++m) { float a = acc[m], b = acc[m + 8]; swap32(a, b); r8[m] = a + b; }
#pragma unroll
                for (int n = 0; n < 4; ++n) { float a = r8[n], b = r8[n + 4]; asm volatile("v_nop\n\tv_nop\n\tv_permlane16_swap_b32 %0, %1" : "+v"(a), "+v"(b)); r4[n] = a + b; }
#pragma unroll
                for (int n = 0; n < 4; ++n) r4[n] += __builtin_bit_cast(float, __builtin_amdgcn_update_dpp(0, __builtin_bit_cast(int, r4[n]), 0x128, 0xF, 0xF, true));
                v2u xw; xw.x = pk2(bflo(xold.x) + r4[0], bfhi(xold.x) + r4[1]); xw.y = pk2(bflo(xold.y) + r4[2], bfhi(xold.y) + r4[3]);
                float ss = 0.f;
                if ((lane & 8) == 0) { const float x0 = bflo(xw.x), x1 = bfhi(xw.x), x2 = bflo(xw.y), x3 = bfhi(xw.y); ss = (x0 * x0 + x1 * x1) + (x2 * x2 + x3 * x3); *xp = xw; }
                ss = wave_allsum(ss);
                if (Q.SSQ) { if (lane == 0) Q.SSQ[t * 16 + s] = ss; }
            }
        }
}

struct Args { const float* in[33]; float* out; unsigned char* ws; int ph_lo, ph_hi; };
struct Frame { LAS unsigned char* lds; volatile LAS unsigned* MISC; gu32* ctl; int tid, lane, wave, G, vcu, xcc, xrank; };

__device__ __forceinline__ void transpose_item(const float* W, int ldw, int nsrc0, bf16* WT, int ldt, int rdst0, LAS float* scr, int kb, int nb, int lane, float scale, const float* kgain) {
    const int k0 = 64 * kb, n0 = 32 * nb;
#pragma unroll 8
    for (int i = 0; i < 32; ++i) { const int kk = 2 * i + (lane >> 5); const float gsc = kgain ? kgain[k0 + kk] * scale : scale; scr[kk * 33 + (lane & 31)] = W[(size_t)(k0 + kk) * ldw + nsrc0 + n0 + (lane & 31)] * gsc; }
    LDS_WAIT(); asm volatile("" ::: "memory");
    const int c = lane & 7;
#pragma unroll
    for (int j = 0; j < 4; ++j) { const int n = (lane >> 3) + 8 * j; const LAS float* s = scr + (8 * c) * 33 + n;
        v4u o; o.x = pk2(s[0 * 33], s[1 * 33]); o.y = pk2(s[2 * 33], s[3 * 33]); o.z = pk2(s[4 * 33], s[5 * 33]); o.w = pk2(s[6 * 33], s[7 * 33]);
        *(GAS v4u*)(WT + (size_t)(rdst0 + n0 + n) * ldt + k0 + 8 * c) = o; }
    LDS_WAIT(); asm volatile("" ::: "memory");
}
__device__ __forceinline__ void zero_rect(bf16* base, int ld, int row0, int nrows, int col0, int ncols, int gtid, int gthreads) {
    const int vpr = ncols / 8;
    for (int i = gtid; i < nrows * vpr; i += gthreads) { const int r = i / vpr, c = i % vpr; *(GAS v4u*)(base + (size_t)(row0 + r) * ld + col0 + 8 * c) = (v4u){0u, 0u, 0u, 0u}; }
}

__device__ __forceinline__ void p0_prologue(Frame& F, const Args& a) {
    LAS float* scr = (LAS float*)(F.lds + RING_OFF + F.wave * 16384);
    const int gw = blockIdx.x * NWAVES + F.wave, NGW = F.G * NWAVES;
    const int gtid = blockIdx.x * (NWAVES * 64) + F.tid, gthreads = F.G * NWAVES * 64;
    unsigned char* ws = a.ws;
    x0_phase((const GAS float*)a.in[0], (GAS bf16*)(ws + WS_XNB), (GAS float*)(ws + WS_SSQ), gw, NGW, F.lane);
    constexpr int I_IN = 16 * (INW / 32), I_SQ = 16 * 32, I_CKV = 16 * 64, I_UQ = 3 * 12, I_UKV = 2 * 16, I_L = I_IN + 4 * I_SQ + I_CKV + I_UQ + I_UKV;
    for (int it = gw; it < L * I_L; it += NGW) {
        const int l = it / I_L; int r = it % I_L;
        if (r < I_IN) {
            const int kb = r / 67, nb = r % 67; int src, dst; float sc = 1.f;
            if (nb < 6) { src = 32 * nb; dst = src; } else if (nb < 11) { src = 32 * nb; dst = src + 64; } else { src = 32 * nb; dst = src + 160; if (nb >= 43 && nb < 51) sc = 0.17677669529663687f * LOG2E; }
            transpose_item(a.in[5] + (size_t)l * D * INW, INW, src, (bf16*)(ws + WS_WIN) + (size_t)l * INP * D, D, dst, scr, kb, 0, F.lane, sc, a.in[4] + l * D); continue; } r -= I_IN;
        if (r < I_SQ) { transpose_item(a.in[21] + (size_t)l * D * D, D, 0, (bf16*)(ws + WS_WOUT) + (size_t)l * D * D, D, 0, scr, r / 32, r % 32, F.lane, 1.f, nullptr); continue; } r -= I_SQ;
        if (r < I_SQ) { transpose_item(a.in[24] + (size_t)l * D * D, D, 0, (bf16*)(ws + WS_WCQ) + (size_t)l * D * D, D, 0, scr, r / 32, r % 32, F.lane, 0.0625f * LOG2E, a.in[22] + l * D); continue; } r -= I_SQ;
        if (r < I_SQ) { transpose_item(a.in[26] + (size_t)l * D * D, D, 0, (bf16*)(ws + WS_WCO) + (size_t)l * D * D, D, 0, scr, r / 32, r % 32, F.lane, 1.f, nullptr); continue; } r -= I_SQ;
        if (r < I_SQ) { transpose_item(a.in[28] + (size_t)l * D * D, D, 0, (bf16*)(ws + WS_WPQ) + (size_t)l * D * D, D, 0, scr, r / 32, r % 32, F.lane, 1.f, a.in[27] + l * D); continue; } r -= I_SQ;
        if (r < I_CKV) { transpose_item(a.in[25] + (size_t)l * D * 2 * D, 2 * D, 0, (bf16*)(ws + WS_WCKV) + (size_t)l * 2 * D * D, D, 0, scr, r / 64, r % 64, F.lane, 1.f, nullptr); continue; } r -= I_CKV;
        if (r < I_UQ) { transpose_item(a.in[7] + (size_t)l * 192 * 384, 384, 0, (bf16*)(ws + WS_WUQ) + (size_t)l * 512 * 256, 256, 0, scr, r / 12, r % 12, F.lane, 0.10206207261596575f * LOG2E, a.in[6] + l * 192); continue; } r -= I_UQ;
        transpose_item(a.in[9] + (size_t)l * 128 * 512, 512, 0, (bf16*)(ws + WS_WUKV) + (size_t)l * 512 * 256, 256, 0, scr, r / 16, r % 16, F.lane, 1.f, a.in[8] + l * 128);
    }
    for (int l = 0; l < L; ++l) {
        bf16* win = (bf16*)(ws + WS_WIN) + (size_t)l * INP * D; bf16* wuq = (bf16*)(ws + WS_WUQ) + (size_t)l * 512 * 256; bf16* wukv = (bf16*)(ws + WS_WUKV) + (size_t)l * 512 * 256;
        zero_rect(win, D, 192, 64, 0, D, gtid, gthreads); zero_rect(win, D, 416, 96, 0, D, gtid, gthreads);
        zero_rect(wuq, 256, 0, 384, 192, 64, gtid, gthreads); zero_rect(wuq, 256, 384, 128, 0, 256, gtid, gthreads);
        zero_rect(wukv, 256, 0, 512, 128, 128, gtid, gthreads);
    }
    { float* rope = (float*)(ws + WS_ROPE); const int* pos = (const int*)a.in[2];
      for (int i = gtid; i < T * 16; i += gthreads) { const int t = i >> 4, k = i & 15; const float inv = powf(10000.f, -(float)(2 * k) / 32.f); const float ang = (float)pos[t] * inv;
          rope[(size_t)t * 32 + k] = cosf(ang); rope[(size_t)t * 32 + 16 + k] = sinf(ang); } }
    { const GAS f32x4* ks = (const GAS f32x4*)a.in[29]; GAS v2u* kd = (GAS v2u*)(ws + WS_KEYS);
      for (int i = gtid; i < L * 2 * 128 * 64 / 4; i += gthreads) { const f32x4 v = ks[i]; v2u w; w.x = pk2(v.x, v.y); w.y = pk2(v.z, v.w); kd[i] = w; }
    }
    for (int r = gw; r < 2 * L * 16384; r += NGW) { const int tb = r / (L * 16384), rr = r % (L * 16384);
        quant_row((const GAS float*)a.in[30 + tb] + (size_t)rr * 1024, (GAS unsigned*)(ws + (tb ? WS_V8 : WS_U8) + (size_t)rr * 1024), (GAS float*)(ws + (tb ? WS_SV : WS_SU)) + rr, 0, F.lane); }
    { float* btab = (float*)(ws + WS_BTAB); float* lams = (float*)(ws + WS_LAMS); float* spt = (float*)(ws + WS_SP);
      for (int i = gtid; i < 4 * 129; i += gthreads) { const int h = i / 129, n = i % 129; int bu; if (n < 16) bu = n; else { const int lg = 16 + (int)(logf((float)n / 16.f) / logf(8.f) * 16.f); bu = lg < 31 ? lg : 31; }
          btab[i] = a.in[3][bu * 4 + h] * LOG2E; }
      for (int i = gtid; i < L; i += gthreads) { const float* dl = a.in[17] + i * 128; float s1 = 0.f, s2 = 0.f; for (int j = 0; j < 32; ++j) { s1 += dl[j] * dl[32 + j]; s2 += dl[64 + j] * dl[96 + j]; }
          const float li = 0.8f - 0.6f * expf(-0.3f * (float)i); lams[2 * i] = expf(s1) - expf(s2) + li; lams[2 * i + 1] = li; }
      for (int i = gtid; i < L * 512; i += gthreads) spt[i] = log1pf(expf(-a.in[16][i])); }
    { GAS bf16* wat = (GAS bf16*)(ws + WS_WAT);
      for (int i = gtid; i < L * 8 * 2 * 4096; i += gthreads) { const int in_ = i & 63, out_ = (i >> 6) & 63, gate = (i >> 12) & 1, lg = i >> 13;
          wat[i] = (bf16)f2bf_(a.in[gate ? 14 : 12][(size_t)lg * 4096 + in_ * 64 + out_]); } }
    for (int l = 0; l < L; ++l) norm_phase((const GAS float*)a.in[1], (const GAS float*)a.in[23] + l * D, (GAS bf16*)(ws + WS_MNB) + (size_t)l * NB * MEM * D, NB * MEM, gw, NGW, F.lane);
}

constexpr int NPL = 16, PH_FINAL = 2 + NPL * L;
__global__ void __launch_bounds__(NWAVES * 64, 2) fwd(Args args) {
    extern __shared__ __attribute__((aligned(16))) unsigned char lds[];
    Frame F;
    F.lds = (LAS unsigned char*)lds; F.MISC = (volatile LAS unsigned*)(F.lds + MISC_OFF);
    F.tid = threadIdx.x; F.lane = F.tid & 63; F.wave = __builtin_amdgcn_readfirstlane(F.tid >> 6); F.G = gridDim.x;
    F.vcu = (F.G % 8 == 0) ? ((int)blockIdx.x % 8) * (F.G / 8) + (int)blockIdx.x / 8 : (int)blockIdx.x;
    unsigned char* ws = args.ws;
    F.ctl = (gu32*)(opq(ws) + WS_CTL);
    for (int u = F.tid; u < (LDS_BYTES - LDSCTL_OFF) / 4; u += NWAVES * 64) ((LAS unsigned*)(F.lds + LDSCTL_OFF))[u] = 0u;
    __syncthreads();
    XcdBarrier bar = xcd_barrier_post((unsigned*)(F.ctl + CW_BAR), F.MISC + 8);
    F.xcc = (int)bar.x;
    if (F.tid == 0) F.MISC[12] = __hip_atomic_fetch_add((unsigned*)(F.ctl + CW_RANK) + 64 * bar.x, 1u, __ATOMIC_RELAXED, __HIP_MEMORY_SCOPE_AGENT);
    __syncthreads();
    F.xrank = __builtin_amdgcn_readfirstlane((int)F.MISC[12]);
    const int lo = args.ph_lo, hi = args.ph_hi;
    const int gw = blockIdx.x * NWAVES + F.wave, NGW = F.G * NWAVES;
#define IN(k) (lo <= (k) && (k) < hi)
#define LANE_ (lane_id_v())
#define TID_ ((opqi(F.wave) << 6) | LANE_)
#define SITE() const int G_ = opqi(F.G), wv_ = opqi(F.wave), vcu_ = opqi(F.vcu), gw_ = opqi(gw), NGW_ = opqi(NGW); (void)G_; (void)wv_; (void)vcu_; (void)gw_; (void)NGW_
#if MK_DUP == 99
#define SEAM(k) do { if (IN(k) && IN((k) + 1)) { xcd_barrier(bar, (F.wave == 0 && lane_id_v() == 0) ? 1 : 0); xcd_barrier(bar, (F.wave == 0 && lane_id_v() == 0) ? 1 : 0); } } while (0)
#else
#define SEAM(k) do { if (IN(k) && IN((k) + 1)) xcd_barrier(bar, (F.wave == 0 && lane_id_v() == 0) ? 1 : 0); } while (0)
#endif
#define GEMM_SITE(EPI, Aptr, lda_, Bptr, ldb_, M_, N_, K_, cperm, ...) do { \
        pg8::Gemm g{opq(Aptr), opq(Bptr), M_, N_, K_, lda_, ldb_}; pg8::StaticOrder So; So.init(M_, N_, opqi(F.G), opqi(cperm)); pg8::EPI E{__VA_ARGS__}; \
        pg8::gemm_phase<pg8::EPI, pg8::StaticOrder, true, true>(F.lds + RING_OFF, g, So, E, opqi(F.wave)); } while (0)
    if (IN(0)) { p0_prologue(F, args); }
    SEAM(0);
    if (IN(1)) {
#pragma unroll 1
        for (int l = 0; l < L; ++l)
            GEMM_SITE(EpiBf16, (const GAS bf16*)(opq(ws) + WS_MNB) + (size_t)l * NB * MEM * D, D, (const GAS bf16*)(opq(ws) + WS_WCKV) + (size_t)l * 2 * D * D, D, NB * MEM, 2 * D, D, (int)((blockIdx.x + 64 * l) % F.G),
                      opq((GAS bf16*)(opq(ws) + WS_KVCB) + (size_t)l * NB * MEM * 2 * D), 2 * D, 2 * D, (const GAS float*)nullptr, 0);
    }
    SEAM(1);
    for (int l = 0; l < L; ++l) {
        const int pb = 2 + NPL * l;
        const GAS bf16* XNB = (const GAS bf16*)(opq(ws) + WS_XNB); const GAS bf16* YB = (const GAS bf16*)(opq(ws) + WS_YB); GAS bf16* PROJB = (GAS bf16*)(opq(ws) + WS_PROJB);
        if (IN(pb + 1)) GEMM_SITE(EpiBf16, XNB, D, (const GAS bf16*)(opq(ws) + WS_WIN) + (size_t)l * INP * D, D, T, INP, D, (int)blockIdx.x, opq(PROJB), INP, INP, opq((const GAS float*)(opq(ws) + WS_SSQ)), 8);
#if MK_DUP == 1
        if (IN(pb + 1)) GEMM_SITE(EpiBf16, XNB, D, (const GAS bf16*)(opq(ws) + WS_WIN) + (size_t)l * INP * D, D, T, INP, D, (int)blockIdx.x, opq(PROJB), INP, INP, opq((const GAS float*)(opq(ws) + WS_SSQ)), 8);
#endif
        SEAM(pb + 1);
        if (IN(pb + 2)) {
            SITE();
            pre_phase(opq((const GAS bf16*)PROJB), opq((const GAS float*)(opq(ws) + WS_ROPE)), opq((GAS float*)(opq(ws) + WS_RS)), opq((GAS bf16*)(opq(ws) + WS_KMB)), gw_, NGW_, LANE_);
#if MK_DUP == 21
            pre_phase(opq((const GAS bf16*)PROJB), opq((const GAS float*)(opq(ws) + WS_ROPE)), opq((GAS float*)(opq(ws) + WS_RS)), opq((GAS bf16*)(opq(ws) + WS_KMB)), gw_, NGW_, LANE_);
#endif
            LruP LP{opq((const GAS bf16*)PROJB), (const GAS float*)args.in[opqi(10)] + l * 4 * 512, (const GAS float*)args.in[opqi(11)] + l * 512, opq((const GAS bf16*)(opq(ws) + WS_WAT)) + (size_t)l * 8 * 2 * 4096, (const GAS float*)args.in[opqi(13)] + l * 512, (const GAS float*)args.in[opqi(15)] + l * 512,
                    (const GAS float*)(opq(ws) + WS_SP) + l * 512, opq((GAS unsigned*)(opq(ws) + WS_HLB)), opq((GAS float*)(opq(ws) + WS_LSUM))};
            lru_phase(LP, F.lds, TID_, wv_, LANE_, vcu_, G_);
#if MK_DUP == 2
            lru_phase(LP, F.lds, TID_, wv_, LANE_, vcu_, G_);
#endif
        }
        SEAM(pb + 2);
        if (IN(pb + 3)) {
            GEMM_SITE(EpiUp, (const GAS bf16*)PROJB + PC_CQ, INP, (const GAS bf16*)(opq(ws) + WS_WUQ) + (size_t)l * 512 * 256, 256, T, 512, 256, (int)blockIdx.x,
                      opq((GAS bf16*)(opq(ws) + WS_QMB)), (GAS bf16*)nullptr, 384, 384, opq((const GAS float*)(opq(ws) + WS_RS)), 0, 0);
            GEMM_SITE(EpiUp, (const GAS bf16*)PROJB + PC_CKV, INP, (const GAS bf16*)(opq(ws) + WS_WUKV) + (size_t)l * 512 * 256, 256, T, 512, 256, (int)blockIdx.x,
                      opq((GAS bf16*)(opq(ws) + WS_KMB)), opq((GAS bf16*)(opq(ws) + WS_VMB)), 0, 512, opq((const GAS float*)(opq(ws) + WS_RS)), 1, 1);
#if MK_DUP == 3
            GEMM_SITE(EpiUp, (const GAS bf16*)PROJB + PC_CQ, INP, (const GAS bf16*)(opq(ws) + WS_WUQ) + (size_t)l * 512 * 256, 256, T, 512, 256, (int)blockIdx.x,
                      opq((GAS bf16*)(opq(ws) + WS_QMB)), (GAS bf16*)nullptr, 384, 384, opq((const GAS float*)(opq(ws) + WS_RS)), 0, 0);
            GEMM_SITE(EpiUp, (const GAS bf16*)PROJB + PC_CKV, INP, (const GAS bf16*)(opq(ws) + WS_WUKV) + (size_t)l * 512 * 256, 256, T, 512, 256, (int)blockIdx.x,
                      opq((GAS bf16*)(opq(ws) + WS_KMB)), opq((GAS bf16*)(opq(ws) + WS_VMB)), 0, 512, opq((const GAS float*)(opq(ws) + WS_RS)), 1, 1);
#endif
        }
        SEAM(pb + 3);
        if (IN(pb + 4)) {
            SITE();
            AttnP PM{opq((const GAS bf16*)(opq(ws) + WS_QMB)), opq((const GAS bf16*)(opq(ws) + WS_KMB)), opq((const GAS bf16*)(opq(ws) + WS_VMB)), 384, 384, 256, opq((GAS bf16*)(opq(ws) + WS_OMB)), 256, opq((const GAS float*)(opq(ws) + WS_ROPE)), nullptr, nullptr, nullptr, nullptr};
            AttnP PD{opq((const GAS bf16*)PROJB + PC_QD), opq((const GAS bf16*)PROJB + PC_KD), opq((const GAS bf16*)PROJB + PC_VD), INP, INP, INP, opq((GAS bf16*)(opq(ws) + WS_YB) + 768), 1024, nullptr,
                     (const GAS int*)args.in[opqi(2)], (const GAS float*)(opq(ws) + WS_BTAB), (const GAS float*)args.in[opqi(18)] + l * 64, (const GAS float*)(opq(ws) + WS_LAMS) + 2 * l};
            attn_phase(PM, PD, F.lds, TID_, wv_, LANE_, vcu_, G_);
#if MK_DUP == 4
            __syncthreads(); attn_phase(PM, PD, F.lds, TID_, wv_, LANE_, vcu_, G_);
#elif MK_DUP == 40 || MK_DUP == 41
            __syncthreads(); attn_phase(PM, PD, F.lds, TID_, wv_, LANE_, vcu_, G_, MK_DUP - 40);
#endif
        }
        SEAM(pb + 4);
        if (IN(pb + 5)) {
            SITE();
            PostP PP{opq((const GAS bf16*)(opq(ws) + WS_OMB)), opq((const GAS unsigned*)(opq(ws) + WS_HLB)), opq((const GAS float*)(opq(ws) + WS_LSUM)), opq((const GAS bf16*)PROJB), (const GAS float*)args.in[opqi(19)] + l * 256, (const GAS float*)args.in[opqi(20)] + l * 512, opq((GAS bf16*)(opq(ws) + WS_YB))};
            post_phase(PP, F.lds, TID_, wv_, LANE_, vcu_, G_);
#if MK_DUP == 5
            __syncthreads(); post_phase(PP, F.lds, TID_, wv_, LANE_, vcu_, G_);
#endif
        }
        SEAM(pb + 5);
        if (IN(pb + 6)) GEMM_SITE(EpiRes, YB, D, (const GAS bf16*)(opq(ws) + WS_WOUT) + (size_t)l * D * D, D, T, D, D, (int)blockIdx.x, opq((GAS bf16*)(opq(ws) + WS_XNB)), opq((GAS float*)(opq(ws) + WS_SSQ)));
#if MK_DUP == 6
        if (IN(pb + 6)) GEMM_SITE(EpiRes, YB, D, (const GAS bf16*)(opq(ws) + WS_WOUT) + (size_t)l * D * D, D, T, D, D, (int)blockIdx.x, opq((GAS bf16*)(opq(ws) + WS_HLB)), opq((GAS float*)(opq(ws) + WS_OMB)));
#endif
        SEAM(pb + 6);
        if (IN(pb + 8)) GEMM_SITE(EpiBf16, XNB, D, (const GAS bf16*)(opq(ws) + WS_WCQ) + (size_t)l * D * D, D, T, D, D, (int)blockIdx.x, opq(PROJB), D, D, opq((const GAS float*)(opq(ws) + WS_SSQ)), 16);
#if MK_DUP == 8
        if (IN(pb + 8)) GEMM_SITE(EpiBf16, XNB, D, (const GAS bf16*)(opq(ws) + WS_WCQ) + (size_t)l * D * D, D, T, D, D, (int)blockIdx.x, opq(PROJB), D, D, opq((const GAS float*)(opq(ws) + WS_SSQ)), 16);
#endif
        SEAM(pb + 8);
        if (IN(pb + 9)) {
            SITE();
            const GAS bf16* kv = (const GAS bf16*)(opq(ws) + WS_KVCB) + (size_t)l * NB * MEM * 2 * D;
            AttnP PC{opq((const GAS bf16*)PROJB), opq(kv), opq(kv + D), 1024, 2 * D, 2 * D, opq((GAS bf16*)(opq(ws) + WS_YB)), 1024, nullptr, nullptr, nullptr, nullptr, nullptr};
            cross_phase(PC, F.lds, TID_, wv_, LANE_, vcu_, G_);
#if MK_DUP == 9
            cross_phase(PC, F.lds, TID_, wv_, LANE_, vcu_, G_);
#endif
        }
        SEAM(pb + 9);
        if (IN(pb + 10)) GEMM_SITE(EpiRes, YB, D, (const GAS bf16*)(opq(ws) + WS_WCO) + (size_t)l * D * D, D, T, D, D, (int)blockIdx.x, opq((GAS bf16*)(opq(ws) + WS_XNB)), opq((GAS float*)(opq(ws) + WS_SSQ)));
        SEAM(pb + 10);
        if (IN(pb + 12)) { GEMM_SITE(EpiBf16, XNB, D, (const GAS bf16*)(opq(ws) + WS_WPQ) + (size_t)l * D * D, D, T, D, D, (int)blockIdx.x, opq(PROJB), D, D, opq((const GAS float*)(opq(ws) + WS_SSQ)), 16);
            SITE(); hq_phase(opq(XNB), opq((const GAS float*)(opq(ws) + WS_SSQ)), (const GAS float*)args.in[opqi(27)] + l * D, opq((GAS unsigned char*)(opq(ws) + WS_HQ)), opq((GAS float*)(opq(ws) + WS_SH)), opq((GAS int*)(opq(ws) + WS_P)), gw_, NGW_, LANE_);
#if MK_DUP == 12
            hq_phase(opq(XNB), opq((const GAS float*)(opq(ws) + WS_SSQ)), (const GAS float*)args.in[opqi(27)] + l * D, opq((GAS unsigned char*)(opq(ws) + WS_HQ)), opq((GAS float*)(opq(ws) + WS_SH)), opq((GAS int*)(opq(ws) + WS_P)), gw_, NGW_, LANE_);
#endif
            }
        SEAM(pb + 12);
        if (IN(pb + 13)) {
            SITE();
            RouteP RP{opq((const GAS bf16*)PROJB), opq((const GAS bf16*)(opq(ws) + WS_KEYS) + (size_t)l * 2 * 128 * 64), opq((GAS int*)(opq(ws) + WS_EX)), opq((GAS float*)(opq(ws) + WS_GW))};
            route_phase(RP, F.lds, TID_, wv_, LANE_, vcu_, G_);
#if MK_DUP == 13
            route_phase(RP, F.lds, TID_, wv_, LANE_, vcu_, G_);
#endif
        }
        SEAM(pb + 13);
        if (IN(pb + 14)) {
            SITE();
            const PeerS ps = peer_sched((const GAS unsigned*)(F.ctl + CW_RANK), opqi(F.xcc), opqi(F.xrank));
            Peer1P Q1{opq((const GAS unsigned char*)(opq(ws) + WS_HQ)), opq((const GAS int*)(opq(ws) + WS_EX)), opq((const GAS unsigned char*)(opq(ws) + WS_U8) + (size_t)l * 16384 * 1024), opq((GAS int*)(opq(ws) + WS_P))};
            peer_k1(Q1, ps, wv_, LANE_);
#if MK_DUP == 141
            { Peer1P Q1b = Q1; Q1b.P = (GAS int*)(opq(ws) + WS_PROJB); peer_k1(Q1b, ps, wv_, LANE_); }
#endif
        }
        SEAM(pb + 14);
        if (IN(pb + 15)) {
            SITE();
            peer_w(opq((const GAS int*)(opq(ws) + WS_EX)), opq((const GAS float*)(opq(ws) + WS_GW)), opq((const GAS int*)(opq(ws) + WS_P)), opq((const GAS float*)(opq(ws) + WS_SH)), opq((const GAS float*)(opq(ws) + WS_SU) + l * 16384), opq((const GAS float*)(opq(ws) + WS_SV) + l * 16384),
                   opq((GAS signed char*)(opq(ws) + WS_W)), opq((GAS float*)(opq(ws) + WS_WS)), gw_, NGW_, LANE_);
            xcd_barrier(bar, (F.wave == 0 && lane_id_v() == 0) ? 1 : 0);
            const PeerS ps = peer_sched((const GAS unsigned*)(F.ctl + CW_RANK), opqi(F.xcc), opqi(F.xrank));
            Peer2P Q2{opq((const GAS int*)(opq(ws) + WS_EX)), opq((const GAS signed char*)(opq(ws) + WS_W)), opq((const GAS float*)(opq(ws) + WS_WS)), opq((const GAS unsigned char*)(opq(ws) + WS_V8) + (size_t)l * 16384 * 1024), opq((GAS bf16*)(opq(ws) + WS_XNB)), opq((GAS float*)(opq(ws) + WS_SSQ))};
            peer_k2(Q2, ps, wv_, LANE_);
#if MK_DUP == 151
            { Peer2P Q2b = Q2; Q2b.XB = (GAS bf16*)(opq(ws) + WS_HLB); Q2b.SSQ = (GAS float*)(opq(ws) + WS_OMB); peer_k2(Q2b, ps, wv_, LANE_); }
#endif
        }
        SEAM(pb + 15);
    }
    if (IN(PH_FINAL)) { SITE(); final_norm_phase(opq((const GAS bf16*)(opq(ws) + WS_XNB)), (GAS float*)args.out, (const GAS float*)args.in[opqi(32)], T, gw_, NGW_, LANE_); }
#undef IN
#undef SEAM
#undef GEMM_SITE
}
}
extern "C" void kernel_launch(void* const* d_in, const int* in_sizes, int n_in, void* d_out, int out_size, void* d_ws, size_t ws_size, hipStream_t stream) {
    (void)in_sizes; (void)out_size;
    static int grid = 0;
    if (grid == 0) {
        int dev = 0, cus = 0, per_cu = 0;
        if (n_in != 33 || ws_size < mk::WS_END) { fprintf(stderr, "kernel_launch: unexpected n_in %d / ws_size %zu\n", n_in, ws_size); grid = -1; return; }
        if (hipGetDevice(&dev) != hipSuccess || hipDeviceGetAttribute(&cus, hipDeviceAttributeMultiprocessorCount, dev) != hipSuccess) { grid = -1; return; }
        if (hipFuncSetAttribute((const void*)mk::fwd, hipFuncAttributeMaxDynamicSharedMemorySize, mk::LDS_BYTES) != hipSuccess) { fprintf(stderr, "kernel_launch: hipFuncSetAttribute failed\n"); grid = -1; return; }
        if (hipOccupancyMaxActiveBlocksPerMultiprocessor(&per_cu, (const void*)mk::fwd, mk::NWAVES * 64, mk::LDS_BYTES) != hipSuccess || per_cu < 1) fprintf(stderr, "kernel_launch: occupancy query says %d\n", per_cu);
        (void)hipGetLastError();
        grid = cus;
    }
    if (grid < 0) return;
    unsigned char* ws = (unsigned char*)d_ws;
    (void)hipMemsetAsync(ws + mk::WS_CTL, 0, mk::CTL_ZERO_BYTES, stream);
    mk::Args a{};
    for (int i = 0; i < 33; ++i) a.in[i] = (const float*)d_in[i];
    a.out = (float*)d_out; a.ws = ws;
    auto run = [&](int lo, int hi) { a.ph_lo = lo; a.ph_hi = hi; hipLaunchKernelGGL(mk::fwd, dim3(grid), dim3(mk::NWAVES * 64), mk::LDS_BYTES, stream, a); };
#if MK_ONE_LAUNCH
    run(0, mk::PH_FINAL + 1);
#else
    for (int p = 0; p <= mk::PH_FINAL; ++p) {
        const int k = (p - 2) % mk::NPL, l = (p - 2) / mk::NPL;
#if MK_NAIVE_PEER == 2
        if (p >= 2 && p < mk::PH_FINAL && k == 14) {
            hipLaunchKernelGGL(k_peer, dim3(T), dim3(256), 0, stream, (const bf16_t*)(ws + mk::WS_XNB), (const int*)(ws + mk::WS_EX), (const float*)(ws + mk::WS_GW), (const float*)d_in[30] + (size_t)l * NEXP * D, (const float*)d_in[31] + (size_t)l * NEXP * D, (float*)d_out);
            continue; }
#elif MK_NAIVE_PEER == 1
        if (p >= 2 && p < mk::PH_FINAL && k == 13) {
            float* TQ = (float*)(ws + (size_t)806 * mk::MiB);
            hipLaunchKernelGGL(k_bf2f, dim3((unsigned)(((size_t)T * D + 255) / 256)), dim3(256), 0, stream, (const bf16_t*)(ws + mk::WS_PROJB), TQ, (long)T * D);
            hipLaunchKernelGGL(k_route, dim3(T), dim3(256), 0, stream, TQ, (const float*)d_in[29] + (size_t)l * 2 * 128 * 64, (int*)(ws + mk::WS_EX), (float*)(ws + mk::WS_GW));
            hipLaunchKernelGGL(k_peer, dim3(T), dim3(256), 0, stream, (const bf16_t*)(ws + mk::WS_XNB), (const int*)(ws + mk::WS_EX), (const float*)(ws + mk::WS_GW), (const float*)d_in[30] + (size_t)l * NEXP * D, (const float*)d_in[31] + (size_t)l * NEXP * D, (float*)d_out);
            continue; }
        if (p >= 2 && p < mk::PH_FINAL && k == 14) continue;
#endif
        run(p, p + 1); }
#endif
}
```

```cpp
#include <hip/hip_runtime.h>
#include <cstdint>
#include <cstdio>
#include <cmath>

#ifndef MK_ONE_LAUNCH
#define MK_ONE_LAUNCH 1
#endif
#ifndef MK_DUP
#define MK_DUP 0
#endif
#ifndef MK_NAIVE_PEER
#define MK_NAIVE_PEER 0
#endif
namespace pg8 {
#define PG8_LAS __attribute__((address_space(3)))
#ifndef GAS
#define GAS __attribute__((address_space(1)))
#endif
typedef unsigned short bf16_t;
typedef short bf16x8 __attribute__((ext_vector_type(8)));
typedef float f32x4 __attribute__((ext_vector_type(4)));
typedef unsigned u32x4 __attribute__((ext_vector_type(4)));
typedef unsigned u32x2 __attribute__((ext_vector_type(2)));
constexpr int BM = 256, BK = 64, HALF = 128, HTB = HALF * BK * 2, STAGE_BYTES = 8 * HTB, NXCD = 8, WGM = 8;
__host__ __device__ __forceinline__ int lds_byte(int r, int c) { const int st = (r >> 4) * 2 + (c >> 5), rr = r & 15, cc = c & 31, ob = rr * 64 + cc * 2; return st * 1024 + (ob ^ (((ob >> 9) & 1) << 5)); }
__host__ __device__ __forceinline__ void stage_rc(int b, int& R, int& C) { const int st = b / 1024, sb = b % 1024, swz = sb ^ (((sb >> 9) & 1) << 5); R = (st >> 1) * 16 + swz / 64; C = (st & 1) * 32 + (swz % 64) / 2; }
__host__ __device__ __forceinline__ int perm32(int rho) { const int n = rho >> 4, i = rho & 15; return 8 * (i >> 2) + 4 * n + (i & 3); }
__device__ __forceinline__ int pg8_lane_id() { int l; asm volatile("v_mbcnt_lo_u32_b32 %0, -1, 0\n\tv_mbcnt_hi_u32_b32 %0, -1, %0" : "=v"(l)); return l; }
struct Unit { int pm, pn; };
struct Gemm { const GAS bf16_t* A; const GAS bf16_t* Bt; int M, N, K, lda, ldb; };
struct StaticOrder {
    int nM, nN, nwg, G, c;
    __host__ __device__ void init(int M, int N, int G_, int c_) { nM = M / BM; nN = N / BM; nwg = nM * nN; G = G_; c = c_; }
    __host__ __device__ bool next(int i, Unit& u) const {
        const long L = (long)i * G + c; if (L >= nwg) return false;
        int wgid = (int)L; { const int q = nwg / NXCD, r = nwg % NXCD, xcd = wgid % NXCD, off = wgid / NXCD; wgid = (xcd < r ? xcd * (q + 1) : r * (q + 1) + (xcd - r) * q) + off; }
        const int nig = WGM * nN, gid = wgid / nig, fm = gid * WGM, gsz = (nM - fm) < WGM ? (nM - fm) : WGM;
        u.pm = fm + ((wgid % nig) % gsz); u.pn = (wgid % nig) / gsz; return true;
    }
    __device__ __forceinline__ void a_ready(const Unit&) const {}
    __device__ __forceinline__ void done(const Unit&) const {}
};
__device__ __forceinline__ unsigned cvt_pk_bf16(float lo, float hi) { unsigned r; asm volatile("v_cvt_pk_bf16_f32 %0, %1, %2" : "=v"(r) : "v"(lo), "v"(hi)); return r; }

struct EpiF32 {
    static constexpr bool PERM = false, AFTER_DRAIN = false;
    GAS float* C; int ldc; int nvalid; int accum;
    __device__ __forceinline__ void operator()(const f32x4 (&acc)[2][2][4][2], const Unit& u, int wr, int wc, int fr, int fq) const {
        { const int l_ = pg8_lane_id(); fr = l_ & 15; fq = l_ >> 4; }
#pragma unroll
        for (int ai = 0; ai < 2; ++ai)
#pragma unroll
            for (int m = 0; m < 4; ++m) { const size_t row = (size_t)u.pm * BM + ai * HALF + wr * 64 + m * 16 + fr;
#pragma unroll
                for (int bj = 0; bj < 2; ++bj)
#pragma unroll
                    for (int n = 0; n < 2; ++n) { const int col = u.pn * BM + bj * HALF + wc * 32 + n * 16 + 4 * fq;
                        if (col < nvalid) { GAS float* p = C + row * ldc + col; f32x4 v = acc[ai][bj][m][n]; if (accum) v += *(const GAS f32x4*)p; *(GAS f32x4*)p = v; } } }
    }
};
struct EpiBf16 {
    static constexpr bool PERM = true, AFTER_DRAIN = false;
    GAS bf16_t* O; int ldc; int nvalid; const GAS float* ssq; int np;
    __device__ __forceinline__ void operator()(const f32x4 (&acc)[2][2][4][2], const Unit& u, int wr, int wc, int fr, int fq) const {
        { const int l_ = pg8_lane_id(); fr = l_ & 15; fq = l_ >> 4; }
#pragma unroll
        for (int ai = 0; ai < 2; ++ai)
#pragma unroll
            for (int m = 0; m < 4; ++m) { const size_t row = (size_t)u.pm * BM + ai * HALF + wr * 64 + m * 16 + fr;
                float rs_ = 1.f;
                if (np > 0) { const GAS f32x4* sp = (const GAS f32x4*)(ssq + row * 16); f32x4 t = sp[0] + sp[1]; if (np > 8) t += sp[2] + sp[3]; rs_ = __builtin_amdgcn_rsqf(((t[0] + t[1]) + (t[2] + t[3])) * (1.f / 1024.f) + 1e-6f); }
#pragma unroll
                for (int bj = 0; bj < 2; ++bj) { const int col = u.pn * BM + bj * HALF + wc * 32 + 8 * fq;
                    if (col < nvalid) { const f32x4 v0 = acc[ai][bj][m][0] * rs_, v1 = acc[ai][bj][m][1] * rs_; u32x4 w; w.x = cvt_pk_bf16(v0[0], v0[1]); w.y = cvt_pk_bf16(v0[2], v0[3]); w.z = cvt_pk_bf16(v1[0], v1[1]); w.w = cvt_pk_bf16(v1[2], v1[3]);
                        *(GAS u32x4*)(O + row * ldc + col) = w; } } }
    }
};
struct EpiUp {
    static constexpr bool PERM = true, AFTER_DRAIN = false;
    GAS bf16_t* O; GAS bf16_t* O2; int ldc; int nvalid; const GAS float* rs; int rsi; int mode;
    __device__ __forceinline__ void operator()(const f32x4 (&acc)[2][2][4][2], const Unit& u, int wr, int wc, int fr, int fq) const {
        { const int l_ = pg8_lane_id(); fr = l_ & 15; fq = l_ >> 4; }
#pragma unroll
        for (int ai = 0; ai < 2; ++ai)
#pragma unroll
            for (int m = 0; m < 4; ++m) { const size_t row = (size_t)u.pm * BM + ai * HALF + wr * 64 + m * 16 + fr; const float s = rs[2 * row + rsi];
#pragma unroll
                for (int bj = 0; bj < 2; ++bj) { const int col = u.pn * BM + bj * HALF + wc * 32 + 8 * fq;
                    if (col < nvalid) { const f32x4 v0 = acc[ai][bj][m][0] * s, v1 = acc[ai][bj][m][1] * s; u32x4 w; w.x = cvt_pk_bf16(v0[0], v0[1]); w.y = cvt_pk_bf16(v0[2], v0[3]); w.z = cvt_pk_bf16(v1[0], v1[1]); w.w = cvt_pk_bf16(v1[2], v1[3]);
                        GAS bf16_t* dst;
                        if (mode == 0) dst = O + row * ldc + col;
                        else { const int h = col >> 7, j = col & 127; dst = (j < 64) ? O + row * 384 + h * 96 + j : O2 + row * 256 + h * 64 + (j - 64); }
                        *(GAS u32x4*)dst = w; } } }
    }
};

struct EpiRes {
    static constexpr bool PERM = true, AFTER_DRAIN = false;
    GAS bf16_t* XB; GAS float* SSQ;
    __device__ __forceinline__ void operator()(const f32x4 (&acc)[2][2][4][2], const Unit& u, int wr, int wc, int fr, int fq) const {
        { const int l_ = pg8_lane_id(); fr = l_ & 15; fq = l_ >> 4; }
#pragma unroll
        for (int ai = 0; ai < 2; ++ai)
#pragma unroll
            for (int m = 0; m < 4; ++m) { const size_t row = (size_t)u.pm * BM + ai * HALF + wr * 64 + m * 16 + fr; float ss = 0.f;
#pragma unroll
                for (int bj = 0; bj < 2; ++bj) { GAS u32x4* p = (GAS u32x4*)(XB + row * 1024 + u.pn * BM + bj * HALF + wc * 32 + 8 * fq);
                    const u32x4 o = *p; const f32x4 v0 = acc[ai][bj][m][0], v1 = acc[ai][bj][m][1];
                    u32x4 w;
                    w.x = cvt_pk_bf16(__builtin_bit_cast(float, o.x << 16) + v0[0], __builtin_bit_cast(float, o.x & 0xffff0000u) + v0[1]);
                    w.y = cvt_pk_bf16(__builtin_bit_cast(float, o.y << 16) + v0[2], __builtin_bit_cast(float, o.y & 0xffff0000u) + v0[3]);
                    w.z = cvt_pk_bf16(__builtin_bit_cast(float, o.z << 16) + v1[0], __builtin_bit_cast(float, o.z & 0xffff0000u) + v1[1]);
                    w.w = cvt_pk_bf16(__builtin_bit_cast(float, o.w << 16) + v1[2], __builtin_bit_cast(float, o.w & 0xffff0000u) + v1[3]);
                    *p = w;
#pragma unroll
                    for (int e = 0; e < 4; ++e) { const float a = __builtin_bit_cast(float, w[e] << 16), b = __builtin_bit_cast(float, w[e] & 0xffff0000u); ss += a * a + b * b; } }
                { float a = ss, b = ss; asm volatile("v_nop\n\tv_nop\n\tv_permlane16_swap_b32 %0, %1" : "+v"(a), "+v"(b)); ss = a + b; }
                { float a = ss, b = ss; asm volatile("v_nop\n\tv_nop\n\tv_permlane32_swap_b32 %0, %1" : "+v"(a), "+v"(b)); ss = a + b; }
                if (fq == 0) SSQ[row * 16 + 4 * u.pn + wc] = ss; }
    }
};
template <class Epi, class Sched, bool ALIGN_EPI = false, bool SP2 = false>
__device__ __forceinline__ void gemm_phase(PG8_LAS unsigned char* lds, const Gemm g, const Sched& S, const Epi& E, int wave_id) {
    int tid_ = (wave_id << 6) | pg8_lane_id(); asm volatile("" : "+v"(tid_));
    const int tid = tid_, wid = __builtin_amdgcn_readfirstlane(tid >> 6), lane = tid & 63, wr = wid >> 2, wc = wid & 3, fr = lane & 15, fq = lane >> 4;
    const int K = g.K, nt = K / BK;
    unsigned voffA[2], voffB[2];
#pragma unroll
    for (int i = 0; i < 2; ++i) { int R, C; stage_rc(tid * 16 + i * 8192, R, C); const int Rb = Epi::PERM ? ((R & ~31) + perm32(R & 31)) : R;
        voffA[i] = (unsigned)(R * g.lda + C) * 2u; voffB[i] = (unsigned)(Rb * g.ldb + C) * 2u; }
    const size_t kstep = (size_t)(BK * 2);
    const size_t hstepA = (size_t)HALF * g.lda * 2, hstepB = (size_t)HALF * g.ldb * 2;
    const size_t tstepA = 2 * hstepA, tstepB = 2 * hstepB;
    const unsigned ldsw = (unsigned)wid * 1024u;
    const int aoff = lds_byte(wr * 64 + fr, fq * 8), boff = lds_byte(wc * 32 + fr, fq * 8);
#define PG8_SA(b, h) (((b) * 2 + (h)) * HTB)
#define PG8_SB(b, h) ((4 + (b) * 2 + (h)) * HTB)
#define PG8_STAGE(bufoff, gbase, voff) do { _Pragma("unroll") for (int _i = 0; _i < 2; ++_i) \
        __builtin_amdgcn_global_load_lds((const unsigned*)((const char*)(gbase) + (voff)[_i]), (PG8_LAS unsigned*)(lds + (bufoff) + ldsw + _i * 8192), 16, 0, 0); } while (0)
#define PG8_LDA(dst, b, h) do { _Pragma("unroll") for (int m = 0; m < 4; ++m) _Pragma("unroll") for (int k = 0; k < 2; ++k) dst[m][k] = *(const PG8_LAS bf16x8*)(lds + PG8_SA(b, h) + aoff + m * 2048 + k * 1024); } while (0)
#define PG8_LDB(dst, b, h) do { _Pragma("unroll") for (int n = 0; n < 2; ++n) _Pragma("unroll") for (int k = 0; k < 2; ++k) dst[n][k] = *(const PG8_LAS bf16x8*)(lds + PG8_SB(b, h) + boff + n * 2048 + k * 1024); } while (0)
#define PG8_MMA(ai, bj, At, Bt) do { __builtin_amdgcn_s_setprio(1); _Pragma("unroll") for (int m = 0; m < 4; ++m) _Pragma("unroll") for (int n = 0; n < 2; ++n) _Pragma("unroll") for (int k = 0; k < 2; ++k) \
        acc[ai][bj][m][n] = __builtin_amdgcn_mfma_f32_16x16x32_bf16(Bt[n][k], At[m][k], acc[ai][bj][m][n], 0, 0, 0); __builtin_amdgcn_s_setprio(0); } while (0)
#define PG8_WAIT_V(n) asm volatile("s_waitcnt vmcnt(" #n ")" ::: "memory")
#define PG8_WAIT_L(n) asm volatile("s_waitcnt lgkmcnt(" #n ")" ::: "memory")
#define PG8_BAR __builtin_amdgcn_s_barrier()
#define PG8_SCHED __builtin_amdgcn_sched_barrier(0)
    Unit cur, nxt; int ui = 0;
    if (!S.next(0, cur)) return;
    f32x4 acc[2][2][4][2];
#pragma unroll
    for (int a = 0; a < 2; ++a)
#pragma unroll
        for (int b = 0; b < 2; ++b)
#pragma unroll
            for (int m = 0; m < 4; ++m)
#pragma unroll
                for (int n = 0; n < 2; ++n) acc[a][b][m][n] = (f32x4){0.f, 0.f, 0.f, 0.f};
    bf16x8 At[4][2], B0[2][2], B1[2][2];
    const char* cA = (const char*)g.A + (size_t)cur.pm * tstepA; const char* cB = (const char*)g.Bt + (size_t)cur.pn * tstepB;
    S.a_ready(cur);
    if constexpr (SP2) {
        PG8_STAGE(PG8_SB(0, 0), cB, voffB); PG8_STAGE(PG8_SB(0, 1), cB + hstepB, voffB); PG8_STAGE(PG8_SA(0, 0), cA, voffA); PG8_STAGE(PG8_SA(0, 1), cA + hstepA, voffA);
        if (wr == 1) PG8_BAR;
        PG8_WAIT_V(2); PG8_BAR;
        PG8_STAGE(PG8_SB(1, 0), cB + kstep, voffB); PG8_STAGE(PG8_SA(1, 0), cA + kstep, voffA); PG8_STAGE(PG8_SB(1, 1), cB + hstepB + kstep, voffB);
        PG8_WAIT_V(6); PG8_BAR;
    } else {
        PG8_STAGE(PG8_SB(0, 0), cB, voffB); PG8_STAGE(PG8_SA(0, 0), cA, voffA); PG8_STAGE(PG8_SB(0, 1), cB + hstepB, voffB); PG8_STAGE(PG8_SA(0, 1), cA + hstepA, voffA);
        if (wr == 1) PG8_BAR;
        PG8_WAIT_V(4); PG8_BAR;
        PG8_STAGE(PG8_SB(1, 0), cB + kstep, voffB); PG8_STAGE(PG8_SA(1, 0), cA + kstep, voffA); PG8_STAGE(PG8_SB(1, 1), cB + hstepB + kstep, voffB);
        PG8_WAIT_V(6); PG8_BAR;
    }
    for (;;) {
        const bool has_next = S.next(ui + 1, nxt);
        const char* nA = has_next ? (const char*)g.A + (size_t)nxt.pm * tstepA : cA; const char* nB = has_next ? (const char*)g.Bt + (size_t)nxt.pn * tstepB : cB;
        for (int t = 0; t < nt; t += 2) {
            const bool last = (t == nt - 2);
            const char* a1 = cA + (size_t)(t + 1) * kstep;
            const char* a2 = last ? nA : cA + (size_t)(t + 2) * kstep; const char* b2 = last ? nB : cB + (size_t)(t + 2) * kstep;
            const char* a3 = a2 + kstep; const char* b3 = b2 + kstep;
            if (last && has_next) S.a_ready(nxt);
            if constexpr (SP2) {
            PG8_LDB(B0, 0, 0); PG8_LDB(B1, 0, 1); PG8_SCHED; PG8_LDA(At, 0, 0); PG8_STAGE(PG8_SA(1, 1), a1 + hstepA, voffA);
            PG8_WAIT_V(8); PG8_WAIT_L(0); PG8_BAR; PG8_MMA(0, 0, At, B0); PG8_MMA(0, 1, At, B1); PG8_BAR; PG8_SCHED;
            PG8_LDA(At, 0, 1); PG8_STAGE(PG8_SB(0, 0), b2, voffB); PG8_STAGE(PG8_SB(0, 1), b2 + hstepB, voffB); PG8_STAGE(PG8_SA(0, 0), a2, voffA);
            PG8_WAIT_V(8); PG8_WAIT_L(0); PG8_BAR; PG8_MMA(1, 0, At, B0); PG8_MMA(1, 1, At, B1); PG8_BAR; PG8_SCHED;
            PG8_LDB(B0, 1, 0); PG8_LDB(B1, 1, 1); PG8_SCHED; PG8_LDA(At, 1, 0); PG8_STAGE(PG8_SA(0, 1), a2 + hstepA, voffA);
            PG8_WAIT_V(8); PG8_WAIT_L(0); PG8_BAR; PG8_MMA(0, 0, At, B0); PG8_MMA(0, 1, At, B1); PG8_BAR; PG8_SCHED;
            PG8_LDA(At, 1, 1); PG8_STAGE(PG8_SB(1, 0), b3, voffB); PG8_STAGE(PG8_SB(1, 1), b3 + hstepB, voffB); PG8_STAGE(PG8_SA(1, 0), a3, voffA);
            PG8_WAIT_V(8); PG8_WAIT_L(0); PG8_BAR; PG8_MMA(1, 0, At, B0); PG8_MMA(1, 1, At, B1); PG8_BAR; PG8_SCHED;
            } else {
            PG8_LDB(B0, 0, 0); PG8_SCHED; PG8_LDA(At, 0, 0); PG8_STAGE(PG8_SA(1, 1), a1 + hstepA, voffA);
            PG8_WAIT_L(8); PG8_BAR; PG8_WAIT_L(0); PG8_MMA(0, 0, At, B0); PG8_BAR; PG8_SCHED;
            PG8_LDB(B1, 0, 1); PG8_STAGE(PG8_SB(0, 0), b2, voffB);
            PG8_BAR; PG8_WAIT_L(0); PG8_MMA(0, 1, At, B1); PG8_BAR;
            PG8_LDA(At, 0, 1); PG8_STAGE(PG8_SA(0, 0), a2, voffA);
            PG8_BAR; PG8_WAIT_L(0); PG8_MMA(1, 0, At, B0); PG8_BAR; PG8_SCHED;
            PG8_STAGE(PG8_SB(0, 1), b2 + hstepB, voffB);
            PG8_WAIT_V(6); PG8_BAR; PG8_MMA(1, 1, At, B1); PG8_BAR;
            PG8_LDB(B0, 1, 0); PG8_SCHED; PG8_LDA(At, 1, 0); PG8_STAGE(PG8_SA(0, 1), a2 + hstepA, voffA);
            PG8_WAIT_L(8); PG8_BAR; PG8_WAIT_L(0); PG8_MMA(0, 0, At, B0); PG8_BAR; PG8_SCHED;
            PG8_LDB(B1, 1, 1); PG8_STAGE(PG8_SB(1, 0), b3, voffB);
            PG8_BAR; PG8_WAIT_L(0); PG8_MMA(0, 1, At, B1); PG8_BAR;
            PG8_LDA(At, 1, 1); PG8_STAGE(PG8_SA(1, 0), a3, voffA);
            PG8_BAR; PG8_WAIT_L(0); PG8_MMA(1, 0, At, B0); PG8_BAR; PG8_SCHED;
            PG8_STAGE(PG8_SB(1, 1), b3 + hstepB, voffB);
            PG8_WAIT_V(6); PG8_BAR; PG8_MMA(1, 1, At, B1); PG8_BAR;
            }
        }
        if constexpr (ALIGN_EPI) { if (wr == 0) PG8_BAR; }
        if constexpr (!Epi::AFTER_DRAIN) { E(acc, cur, wr, wc, fr, fq); S.done(cur); }
        if (!has_next) break;
#pragma unroll
        for (int a = 0; a < 2; ++a)
#pragma unroll
            for (int b = 0; b < 2; ++b)
#pragma unroll
                for (int m = 0; m < 4; ++m)
#pragma unroll
                    for (int n = 0; n < 2; ++n) acc[a][b][m][n] = (f32x4){0.f, 0.f, 0.f, 0.f};
        cur = nxt; cA = nA; cB = nB; ++ui;
        if constexpr (ALIGN_EPI) { if (wr == 1) PG8_BAR; }
    }
    PG8_WAIT_V(0);
    if constexpr (!ALIGN_EPI) { if (wr == 0) PG8_BAR; }
    PG8_BAR;
    if constexpr (Epi::AFTER_DRAIN) { E.fused(acc, cur, wr, wc, fr, fq, lds, wid, lane); S.done(cur); }
#undef PG8_SA
#undef PG8_SB
#undef PG8_STAGE
#undef PG8_LDA
#undef PG8_LDB
#undef PG8_MMA
#undef PG8_WAIT_V
#undef PG8_WAIT_L
#undef PG8_BAR
#undef PG8_SCHED
}
}

namespace mk {
#ifndef GAS
#define GAS __attribute__((address_space(1)))
#endif
#define LAS __attribute__((address_space(3)))
typedef unsigned short bf16;
typedef unsigned v4u __attribute__((ext_vector_type(4)));
typedef unsigned v2u __attribute__((ext_vector_type(2)));
typedef float f32x4 __attribute__((ext_vector_type(4)));
typedef GAS unsigned gu32;
#define LDS_WAIT() asm volatile("s_waitcnt lgkmcnt(0)" ::: "memory")
#define VM_WAIT() asm volatile("s_waitcnt vmcnt(0)" ::: "memory")
__device__ __forceinline__ unsigned f2bf_(float f) { unsigned u = __builtin_bit_cast(unsigned, f); return (u + 0x7fffu + ((u >> 16) & 1u)) >> 16; }
__device__ __forceinline__ unsigned pk2(float lo, float hi) { return f2bf_(lo) | (f2bf_(hi) << 16); }
__device__ __forceinline__ float bflo(unsigned w) { return __builtin_bit_cast(float, w << 16); }
__device__ __forceinline__ float bfhi(unsigned w) { return __builtin_bit_cast(float, w & 0xffff0000u); }

template <class P> __device__ __forceinline__ P* opq(P* p) { asm volatile("" : "+s"(p)); return p; }
__device__ __forceinline__ int opqi(int k) { asm volatile("" : "+s"(k)); return k; }
__device__ __forceinline__ float shx(float v, int o, int lane) { return __builtin_bit_cast(float, __builtin_amdgcn_ds_bpermute((lane ^ o) << 2, __builtin_bit_cast(int, v))); }
__device__ __forceinline__ int shxi(int v, int o, int lane) { return __builtin_amdgcn_ds_bpermute((lane ^ o) << 2, v); }
__device__ __forceinline__ int lane_id_v() { int l; asm volatile("v_mbcnt_lo_u32_b32 %0, -1, 0\n\tv_mbcnt_hi_u32_b32 %0, -1, %0" : "=v"(l)); return l; }
constexpr int NWAVES = 8;
constexpr int D = 1024, NB = 4, S = 8192, T = NB * S, L = 4, MEM = 256, INW = 2144, INP = 2304;
constexpr int PC_CQ = 0, PC_CKV = 256, PC_KR = 384, PC_XL = 512, PC_GL = 1024, PC_QD = 1536, PC_KD = 1792, PC_VD = 2048;
constexpr float LOG2E = 1.4426950408889634f;
constexpr size_t MiB = 1u << 20;
constexpr size_t WS_CTL = 0, CTL_ZERO_BYTES = 1 * MiB;
constexpr size_t WS_WIN = 1 * MiB, WS_WOUT = 19 * MiB, WS_WCQ = 27 * MiB, WS_WCO = 35 * MiB, WS_WPQ = 43 * MiB, WS_WCKV = 51 * MiB, WS_WUQ = 67 * MiB, WS_WUKV = 68 * MiB, WS_KEYS = 69 * MiB, WS_ROPE = 70 * MiB;
constexpr size_t WS_XNB = 76 * MiB, WS_YB = 140 * MiB, WS_PROJB = 204 * MiB, WS_QMB = 348 * MiB, WS_KMB = 372 * MiB, WS_VMB = 396 * MiB, WS_RS = 412 * MiB;
constexpr size_t WS_HLB = 413 * MiB, WS_ACB = 445 * MiB, WS_LSUM = 477 * MiB, WS_OMB = 478 * MiB, WS_MNB = 494 * MiB, WS_KVCB = 502 * MiB, WS_EX = 518 * MiB, WS_GW = 534 * MiB;
constexpr size_t WS_U8 = 550 * MiB, WS_V8 = 614 * MiB, WS_SU = 678 * MiB, WS_SV = 679 * MiB;
constexpr size_t WS_HQ = 680 * MiB, WS_P = 712 * MiB, WS_SH = 728 * MiB, WS_W = 729 * MiB, WS_WS = 745 * MiB, WS_SSQ = 746 * MiB, WS_END = 748 * MiB;
constexpr size_t WS_WAT = 74 * MiB;
constexpr size_t WS_BTAB = WS_KEYS + 512 * 1024, WS_LAMS = WS_BTAB + 4096, WS_SP = WS_LAMS + 4096;
constexpr int CW_BAR = 4096, CW_RANK = 8192;
constexpr int RING_OFF = 0, RING_BYTES = 155648, LDSCTL_OFF = RING_BYTES, MISC_OFF = LDSCTL_OFF + 320, LDS_BYTES = 163840;

#define XB_TMO      128
#define XB_XCNT(j)  (256  + 64 * (j))
#define XB_XSUB(j)  (1280 + 64 * (j))
#define XB_XGEN(j)  (2304 + 64 * (j))
#define XB_TOP      3328
#define XB_TOPGEN   3392
#define XCD_BAR_WORDS 3456
#define XB_SPIN_CAP (1u << 18)

__device__ __forceinline__ unsigned xb_ld(unsigned* p)              { return __hip_atomic_load(p, __ATOMIC_RELAXED, __HIP_MEMORY_SCOPE_AGENT); }
__device__ __forceinline__ unsigned xb_add(unsigned* p, unsigned v) { return __hip_atomic_fetch_add(p, v, __ATOMIC_RELAXED, __HIP_MEMORY_SCOPE_AGENT); }
__device__ __forceinline__ unsigned xb_xcc_id() { return (unsigned)__builtin_amdgcn_s_getreg((3 << 11) | 20) & 0xFu; }
#define XB_SPIN(cond, bar) do { unsigned _sp = 0; while (cond) { __builtin_amdgcn_s_sleep(1); \
    if ((++_sp & 255u) == 0u) { if (xb_ld(&(bar)[XB_TMO])) break; if (_sp > XB_SPIN_CAP) { atomicAdd(&(bar)[XB_TMO], 1u); break; } } } } while (0)

struct XcdBarrier {
    unsigned* bar; unsigned x;
    volatile LAS unsigned* st;
};

__device__ __forceinline__ XcdBarrier xcd_barrier_post(unsigned* bar, volatile LAS unsigned* st) {
    XcdBarrier b; b.bar = bar; b.x = xb_xcc_id(); b.st = st;
    if (threadIdx.x == 0) (void)xb_add(&bar[XB_XCNT(b.x)], 1u);
    return b;
}
__device__ __forceinline__ void xcd_barrier_complete(unsigned* bar, unsigned x, unsigned& nloc, unsigned& nx) {
    const unsigned G = gridDim.x * gridDim.y * gridDim.z;
    unsigned sum, cnt, mine, sp = 0u;
    for (;;) {
        sum = 0u; cnt = 0u; mine = 0u;
#pragma unroll
        for (unsigned j = 0; j < 16; ++j) { const unsigned c = xb_ld(&bar[XB_XCNT(j)]); sum += c; cnt += (c > 0u) ? 1u : 0u; mine = (j == x) ? c : mine; }
        if (sum == G) break;
        __builtin_amdgcn_s_sleep(1);
        if ((++sp & 255u) == 0u) { if (xb_ld(&bar[XB_TMO])) break; if (sp > XB_SPIN_CAP) { atomicAdd(&bar[XB_TMO], 1u); break; } }
    }
    nloc = mine > 0u ? mine : 1u; nx = cnt > 0u ? cnt : 1u;
}

__device__ __noinline__ void xcd_barrier_impl(unsigned* bar_, unsigned x_, volatile LAS unsigned* st_, int leader_) {
    XcdBarrier b; b.bar = bar_; b.x = x_; b.st = st_;
    asm volatile("s_waitcnt vmcnt(0)" ::: "memory");
    __syncthreads();
    if (leader_) {
        unsigned* bar = b.bar;
        __builtin_amdgcn_s_waitcnt(0);
        unsigned nloc = b.st[0], nx = b.st[1];
        if (nloc == 0u) { xcd_barrier_complete(bar, b.x, nloc, nx); b.st[0] = nloc; b.st[1] = nx; }
        const unsigned old = xb_add(&bar[XB_XSUB(b.x)], 1u);
        const unsigned gen = old / nloc;
        if (old + 1u == (gen + 1u) * nloc) {
            __builtin_amdgcn_fence(__ATOMIC_RELEASE, "agent");
            asm volatile("s_waitcnt vmcnt(0)" ::: "memory");
            const unsigned og = xb_add(&bar[XB_TOP], 1u);
            const unsigned tg = og / nx;
            if (og + 1u == (tg + 1u) * nx) xb_add(&bar[XB_TOPGEN], 1u);
            else XB_SPIN(xb_ld(&bar[XB_TOPGEN]) == tg, bar);
            __builtin_amdgcn_fence(__ATOMIC_ACQUIRE, "agent");
            xb_add(&bar[XB_XGEN(b.x)], 1u);
            asm volatile("s_waitcnt vmcnt(0)" ::: "memory");
        } else {
            XB_SPIN(xb_ld(&bar[XB_XGEN(b.x)]) == gen, bar);
            __builtin_amdgcn_fence(__ATOMIC_ACQUIRE, "agent");
            asm volatile("s_waitcnt vmcnt(0)" ::: "memory");
        }
    }
    __syncthreads();
}
__device__ __forceinline__ void xcd_barrier(const XcdBarrier& b, int leader) { xcd_barrier_impl(b.bar, b.x, b.st, leader); }


__device__ __forceinline__ float wave_sum(float v, int lane) {
    (void)lane;
    v += __builtin_bit_cast(float, __builtin_amdgcn_update_dpp(0, __builtin_bit_cast(int, v), 0xB1, 0xF, 0xF, true));
    v += __builtin_bit_cast(float, __builtin_amdgcn_update_dpp(0, __builtin_bit_cast(int, v), 0x4E, 0xF, 0xF, true));
    v += __builtin_bit_cast(float, __builtin_amdgcn_update_dpp(0, __builtin_bit_cast(int, v), 0x141, 0xF, 0xF, true));
    v += __builtin_bit_cast(float, __builtin_amdgcn_update_dpp(0, __builtin_bit_cast(int, v), 0x140, 0xF, 0xF, true));
    { float a = v, b = v; asm volatile("v_nop\n\tv_nop\n\tv_permlane16_swap_b32 %0, %1" : "+v"(a), "+v"(b)); v = a + b; }
    { float a = v, b = v; asm volatile("v_nop\n\tv_nop\n\tv_permlane32_swap_b32 %0, %1" : "+v"(a), "+v"(b)); v = a + b; }
    return v;
}
__device__ __forceinline__ float wave_max(float v) {
    v = fmaxf(v, __builtin_bit_cast(float, __builtin_amdgcn_update_dpp(0, __builtin_bit_cast(int, v), 0xB1, 0xF, 0xF, true)));
    v = fmaxf(v, __builtin_bit_cast(float, __builtin_amdgcn_update_dpp(0, __builtin_bit_cast(int, v), 0x4E, 0xF, 0xF, true)));
    v = fmaxf(v, __builtin_bit_cast(float, __builtin_amdgcn_update_dpp(0, __builtin_bit_cast(int, v), 0x141, 0xF, 0xF, true)));
    v = fmaxf(v, __builtin_bit_cast(float, __builtin_amdgcn_update_dpp(0, __builtin_bit_cast(int, v), 0x140, 0xF, 0xF, true)));
    { float a = v, b = v; asm volatile("v_nop\n\tv_nop\n\tv_permlane16_swap_b32 %0, %1" : "+v"(a), "+v"(b)); v = fmaxf(a, b); }
    { float a = v, b = v; asm volatile("v_nop\n\tv_nop\n\tv_permlane32_swap_b32 %0, %1" : "+v"(a), "+v"(b)); v = fmaxf(a, b); }
    return v;
}
__device__ __forceinline__ float gelu_erf(float v) {
    const float av = __builtin_fabsf(v), t = __builtin_amdgcn_rcpf(av * 0.2316418882f + 1.0f);
    float q = t * 0.5307027145f + (-0.7265760135f); q = q * t + 0.7107068705f; q = q * t + (-0.142248368f); q = q * t + 0.127414796f; q = q * t;
    const float e = __builtin_amdgcn_exp2f((v * v) * (-0.72134752044f));
    const float m = v * (q * e);
    return v < 0.f ? m : v - m;
}

__device__ __forceinline__ void norm_phase(const GAS float* X, const GAS float* g, GAS bf16* out, int rows, int gw, int NGW, int lane) {
    asm volatile("" : "+v"(lane));
    f32x4 gv[4];
#pragma unroll
    for (int j = 0; j < 4; ++j) gv[j] = ((const GAS f32x4*)g)[lane + 64 * j];
    for (int m = gw; m < rows; m += NGW) {
        const GAS f32x4* xr = (const GAS f32x4*)(X + (size_t)m * D) + lane;
        f32x4 v[4]; float s = 0.f;
#pragma unroll
        for (int j = 0; j < 4; ++j) { v[j] = xr[64 * j]; s += (v[j].x * v[j].x + v[j].y * v[j].y) + (v[j].z * v[j].z + v[j].w * v[j].w); }
        const float rs = rsqrtf(wave_sum(s, lane) * (1.f / D) + 1e-6f);
        GAS v2u* o8 = (GAS v2u*)(out + (size_t)m * D) + lane;
#pragma unroll
        for (int j = 0; j < 4; ++j) { v2u w; w.x = pk2(v[j].x * rs * gv[j].x, v[j].y * rs * gv[j].y); w.y = pk2(v[j].z * rs * gv[j].z, v[j].w * rs * gv[j].w); o8[64 * j] = w; }
    }
}
__device__ __forceinline__ void hq_phase(const GAS bf16* XB, const GAS float* SSQ, const GAS float* g, GAS unsigned char* HQ, GAS float* SH, GAS int* Pz, int gw, int NGW, int lane) {
    asm volatile("" : "+v"(lane));
    const GAS f32x4* gp = (const GAS f32x4*)g + 4 * lane; const f32x4 g0 = gp[0], g1 = gp[1], g2 = gp[2], g3 = gp[3];
    for (int m = gw; m < T; m += NGW) {
        const GAS f32x4* sp = (const GAS f32x4*)(SSQ + (size_t)m * 16); const f32x4 t = (sp[0] + sp[1]) + (sp[2] + sp[3]);
        const float rs = __builtin_amdgcn_rsqf(((t[0] + t[1]) + (t[2] + t[3])) * (1.f / 1024.f) + 1e-6f);
        const v4u a = *(const GAS v4u*)(XB + (size_t)m * D + 16 * lane), b = *(const GAS v4u*)(XB + (size_t)m * D + 16 * lane + 8);
        float f[16] = {bflo(a.x) * g0[0], bfhi(a.x) * g0[1], bflo(a.y) * g0[2], bfhi(a.y) * g0[3], bflo(a.z) * g1[0], bfhi(a.z) * g1[1], bflo(a.w) * g1[2], bfhi(a.w) * g1[3],
                       bflo(b.x) * g2[0], bfhi(b.x) * g2[1], bflo(b.y) * g2[2], bfhi(b.y) * g2[3], bflo(b.z) * g3[0], bfhi(b.z) * g3[1], bflo(b.w) * g3[2], bfhi(b.w) * g3[3]};
        float mx = 0.f;
#pragma unroll
        for (int i = 0; i < 16; ++i) { f[i] *= rs; mx = fmaxf(mx, __builtin_fabsf(f[i])); }
        mx = wave_max(mx);
        const float inv = mx > 0.f ? 127.f / mx : 0.f;
        v4u q;
#pragma unroll
        for (int i = 0; i < 4; ++i) { const int ia = (int)__builtin_rintf(f[4 * i] * inv), ib = (int)__builtin_rintf(f[4 * i + 1] * inv), ic = (int)__builtin_rintf(f[4 * i + 2] * inv), id = (int)__builtin_rintf(f[4 * i + 3] * inv);
            q[i] = (unsigned)(ia & 255) | ((unsigned)(ib & 255) << 8) | ((unsigned)(ic & 255) << 16) | ((unsigned)(id & 255) << 24); }
        *(GAS v4u*)(HQ + (size_t)m * D + 16 * lane) = q;
        if (lane == 0) SH[m] = mx * (1.f / 127.f);
        (Pz + (size_t)m * 128)[lane] = 0; (Pz + (size_t)m * 128)[lane + 64] = 0;
    }
}
__device__ __forceinline__ void x0_phase(const GAS float* X, GAS bf16* XB, GAS float* SSQ, int gw, int NGW, int lane) {
    asm volatile("" : "+v"(lane));
    for (int m = gw; m < T; m += NGW) {
        const GAS f32x4* xr = (const GAS f32x4*)(X + (size_t)m * D) + lane; GAS v2u* o8 = (GAS v2u*)(XB + (size_t)m * D) + lane;
        float s = 0.f;
#pragma unroll
        for (int j = 0; j < 4; ++j) { const f32x4 v = xr[64 * j]; s += (v.x * v.x + v.y * v.y) + (v.z * v.z + v.w * v.w); v2u w; w.x = pk2(v.x, v.y); w.y = pk2(v.z, v.w); o8[64 * j] = w; }
        s = wave_sum(s, lane);
        if (lane < 8) SSQ[(size_t)m * 16 + lane] = lane == 0 ? s : 0.f;
    }
}
__device__ __forceinline__ void final_norm_phase(const GAS bf16* XB, GAS float* O, const GAS float* g, int rows, int gw, int NGW, int lane) {
    asm volatile("" : "+v"(lane));
    for (int m = gw; m < rows; m += NGW) {
        const GAS v4u* xr = (const GAS v4u*)(XB + (size_t)m * D) + lane;
        v4u v[2]; float s = 0.f;
#pragma unroll
        for (int j = 0; j < 2; ++j) { v[j] = xr[64 * j];
#pragma unroll
            for (int e = 0; e < 4; ++e) { const float a = bflo(v[j][e]), b = bfhi(v[j][e]); s += a * a + b * b; } }
        const float rs = rsqrtf(wave_sum(s, lane) * (1.f / D) + 1e-6f);
#pragma unroll
        for (int j = 0; j < 2; ++j) { const int c = 8 * (lane + 64 * j); const f32x4 g0 = *(const GAS f32x4*)(g + c), g1 = *(const GAS f32x4*)(g + c + 4);
            f32x4 o0, o1; o0.x = bflo(v[j].x) * rs * g0.x; o0.y = bfhi(v[j].x) * rs * g0.y; o0.z = bflo(v[j].y) * rs * g0.z; o0.w = bfhi(v[j].y) * rs * g0.w;
            o1.x = bflo(v[j].z) * rs * g1.x; o1.y = bfhi(v[j].z) * rs * g1.y; o1.z = bflo(v[j].w) * rs * g1.z; o1.w = bfhi(v[j].w) * rs * g1.w;
            *(GAS f32x4*)(O + (size_t)m * D + c) = o0; *(GAS f32x4*)(O + (size_t)m * D + c + 4) = o1; }
    }
}

__device__ __forceinline__ float row16_sum(float v) {
    v += __builtin_bit_cast(float, __builtin_amdgcn_update_dpp(0, __builtin_bit_cast(int, v), 0xB1, 0xF, 0xF, true));
    v += __builtin_bit_cast(float, __builtin_amdgcn_update_dpp(0, __builtin_bit_cast(int, v), 0x4E, 0xF, 0xF, true));
    v += __builtin_bit_cast(float, __builtin_amdgcn_update_dpp(0, __builtin_bit_cast(int, v), 0x141, 0xF, 0xF, true));
    v += __builtin_bit_cast(float, __builtin_amdgcn_update_dpp(0, __builtin_bit_cast(int, v), 0x140, 0xF, 0xF, true));
    return v;
}
__device__ __forceinline__ float sq8(const v4u w) { const float a0 = bflo(w.x), a1 = bfhi(w.x), a2 = bflo(w.y), a3 = bfhi(w.y), a4 = bflo(w.z), a5 = bfhi(w.z), a6 = bflo(w.w), a7 = bfhi(w.w);
    return (a0 * a0 + a1 * a1) + (a2 * a2 + a3 * a3) + (a4 * a4 + a5 * a5) + (a6 * a6 + a7 * a7); }
__device__ __forceinline__ void pre_phase(const GAS bf16* PROJB, const GAS float* ROPE, GAS float* RS, GAS bf16* KMB, int gw, int NGW, int lane) {
    asm volatile("" : "+v"(lane));
    const int q = lane >> 4, sub = lane & 15;
    for (int t0 = gw * 4; t0 < T; t0 += NGW * 4) {
        const size_t t = (size_t)t0 + q;
        const GAS bf16* pr = PROJB + t * INP;
        const v4u w0 = *(const GAS v4u*)(pr + PC_CQ + 8 * sub), w1 = *(const GAS v4u*)(pr + PC_CQ + 8 * (16 + (sub & 7))), w2 = *(const GAS v4u*)(pr + PC_CKV + 8 * sub);
        const float x1 = __builtin_bit_cast(float, (unsigned)pr[PC_KR + sub] << 16), x2 = __builtin_bit_cast(float, (unsigned)pr[PC_KR + 16 + sub] << 16);
        const float c = ROPE[t * 32 + sub], sn = ROPE[t * 32 + 16 + sub];
        const float sq = row16_sum(sq8(w0) + (sub < 8 ? sq8(w1) : 0.f)), skv = row16_sum(sq8(w2));
        if (sub == 0) { RS[2 * t] = rsqrtf(sq * (1.f / 192.f) + 1e-6f); RS[2 * t + 1] = rsqrtf(skv * (1.f / 128.f) + 1e-6f); }
        const bf16 y1 = (bf16)f2bf_(x1 * c - x2 * sn), y2 = (bf16)f2bf_(x1 * sn + x2 * c);
        GAS bf16* kr = KMB + t * 384 + 64 + sub;
#pragma unroll
        for (int h = 0; h < 4; ++h) { kr[h * 96] = y1; kr[h * 96 + 16] = y2; }
    }
}

typedef short lr_bf16x8 __attribute__((ext_vector_type(8)));
typedef float lr_f32x16 __attribute__((ext_vector_type(16)));
__device__ __forceinline__ void lr_swap32(float& a, float& b) { asm volatile("v_nop\n\tv_nop\n\tv_permlane32_swap_b32 %0, %1" : "+v"(a), "+v"(b)); }
constexpr int LR_XR = 0, LR_CW = LR_XR + 37376, LR_XA = LR_CW + 1280, LR_WT = LR_XA + 256 * 144, LR_SUM = LR_WT + 2 * 64 * 144, LR_END = LR_SUM + 4096;
struct LruP { const GAS bf16* PROJB; const GAS float* cw; const GAS float* cb; const GAS bf16* wat; const GAS float* ba; const GAS float* bx; const GAS float* sp; GAS unsigned* HA; GAS float* LSUM; };
__device__ __forceinline__ void lru_phase(const LruP& P, LAS unsigned char* lds, int tid, int wave, int lane, int vcu, int G) {
    asm volatile("" : "+v"(tid), "+v"(lane));
    LAS float* SUM = (LAS float*)(lds + LR_SUM);
    for (int u = vcu; u < (T / 256) * 8; u += G) {
        const int tile = u >> 3, g = u & 7; const int t0 = tile * 256; const bool first = ((tile & 31) == 0);
        __syncthreads();
        { v4u wt_[2], xr_[5];
#pragma unroll
          for (int i = 0; i < 2; ++i) { const int idx = tid + 512 * i; wt_[i] = ((const GAS v4u*)(P.wat + (size_t)g * 2 * 4096))[idx]; }
#pragma unroll
          for (int i = 0; i < 5; ++i) { const int idx = tid + 512 * i, row = idx >> 3, part = idx & 7; const bool ok = (idx < 259 * 8) && !(first && row < 3);
              const int trow = ok ? t0 - 3 + row : t0;
              xr_[i] = *(const GAS v4u*)(P.PROJB + (size_t)trow * INP + PC_XL + 64 * g + 8 * part); if (!ok) xr_[i] = v4u{0u, 0u, 0u, 0u}; }
          float cwv = 0.f; if (tid < 320) cwv = (tid < 256) ? P.cw[(tid >> 6) * 512 + 64 * g + (tid & 63)] : P.cb[64 * g + (tid - 256)];
#pragma unroll
          for (int i = 0; i < 2; ++i) { const int idx = tid + 512 * i; *(LAS v4u*)(lds + LR_WT + (idx >> 9) * 9216 + ((idx >> 3) & 63) * 144 + (idx & 7) * 16) = wt_[i]; }
#pragma unroll
          for (int i = 0; i < 5; ++i) { const int idx = tid + 512 * i, row = idx >> 3, part = idx & 7; if (idx < 259 * 8) *(LAS v4u*)(lds + LR_XR + row * 144 + 16 * part) = xr_[i]; }
          if (tid < 320) ((LAS float*)(lds + LR_CW))[tid] = cwv; }
        __syncthreads();
        { float cwr[4][8], cbr[8];
#pragma unroll
          for (int k = 0; k < 4; ++k) { const f32x4 c0 = *(const LAS f32x4*)(lds + LR_CW + (k * 64 + 8 * wave) * 4), c1 = *(const LAS f32x4*)(lds + LR_CW + (k * 64 + 8 * wave + 4) * 4);
              cwr[k][0] = c0.x; cwr[k][1] = c0.y; cwr[k][2] = c0.z; cwr[k][3] = c0.w; cwr[k][4] = c1.x; cwr[k][5] = c1.y; cwr[k][6] = c1.z; cwr[k][7] = c1.w; }
          { const f32x4 c0 = *(const LAS f32x4*)(lds + LR_CW + (256 + 8 * wave) * 4), c1 = *(const LAS f32x4*)(lds + LR_CW + (256 + 8 * wave + 4) * 4);
            cbr[0] = c0.x; cbr[1] = c0.y; cbr[2] = c0.z; cbr[3] = c0.w; cbr[4] = c1.x; cbr[5] = c1.y; cbr[6] = c1.z; cbr[7] = c1.w; }
#pragma unroll
          for (int it_ = 0; it_ < 4; ++it_) { const int time = lane + 64 * it_;
              float y[8];
#pragma unroll
              for (int e = 0; e < 8; ++e) y[e] = cbr[e];
#pragma unroll
              for (int k = 0; k < 4; ++k) { const v4u w = *(const LAS v4u*)(lds + LR_XR + (time + k) * 144 + 16 * wave);
                  y[0] += bflo(w.x) * cwr[k][0]; y[1] += bfhi(w.x) * cwr[k][1]; y[2] += bflo(w.y) * cwr[k][2]; y[3] += bfhi(w.y) * cwr[k][3];
                  y[4] += bflo(w.z) * cwr[k][4]; y[5] += bfhi(w.z) * cwr[k][5]; y[6] += bflo(w.w) * cwr[k][6]; y[7] += bfhi(w.w) * cwr[k][7]; }
              v4u o; o.x = pk2(y[0], y[1]); o.y = pk2(y[2], y[3]); o.z = pk2(y[4], y[5]); o.w = pk2(y[6], y[7]);
              *(LAS v4u*)(lds + LR_XA + time * 144 + 16 * wave) = o; } }
        __syncthreads();
        const int r32 = lane & 31, hi = lane >> 5;
        lr_f32x16 acc[2][2];
#pragma unroll
        for (int nt = 0; nt < 2; ++nt) { const float b_a = P.ba[64 * g + 32 * nt + r32], b_x = P.bx[64 * g + 32 * nt + r32];
#pragma unroll
            for (int r = 0; r < 16; ++r) { acc[0][nt][r] = b_a; acc[1][nt][r] = b_x; } }
        { lr_bf16x8 af[4];
#pragma unroll
          for (int s_ = 0; s_ < 4; ++s_) af[s_] = *(const LAS lr_bf16x8*)(lds + LR_XA + (32 * wave + r32) * 144 + (16 * s_ + 8 * hi) * 2);
#pragma unroll
          for (int gt = 0; gt < 2; ++gt)
#pragma unroll
              for (int nt = 0; nt < 2; ++nt)
#pragma unroll
                  for (int s_ = 0; s_ < 4; ++s_) { const lr_bf16x8 bfr = *(const LAS lr_bf16x8*)(lds + LR_WT + gt * 9216 + (32 * nt + r32) * 144 + (16 * s_ + 8 * hi) * 2);
                      acc[gt][nt] = __builtin_amdgcn_mfma_f32_32x32x16_bf16(af[s_], bfr, acc[gt][nt], 0, 0, 0); } }
#pragma unroll
        for (int nt = 0; nt < 2; ++nt) { const float sp = P.sp[64 * g + 32 * nt + r32];
            float sa_[4], sh_[4];
#pragma unroll
            for (int q = 0; q < 4; ++q) { float hrun = 0.f, arun = 1.f;
#pragma unroll
                for (int e = 0; e < 4; ++e) { const int r = 4 * q + e, tl = 8 * q + 4 * hi + e;
                    const float xv = __builtin_bit_cast(float, (unsigned)*(const LAS unsigned short*)(lds + LR_XA + (32 * wave + tl) * 144 + (32 * nt + r32) * 2) << 16);
                    const float rg = __builtin_amdgcn_rcpf(1.f + __builtin_amdgcn_exp2f(-LOG2E * acc[0][nt][r])), ig = __builtin_amdgcn_rcpf(1.f + __builtin_amdgcn_exp2f(-LOG2E * acc[1][nt][r]));
                    const float la = -8.0f * rg * sp; const float a_ = __builtin_amdgcn_exp2f(LOG2E * la);
                    const float uu = __builtin_amdgcn_sqrtf(fmaxf(1.f - a_ * a_, 0.f)) * (ig * xv);
                    hrun = a_ * hrun + uu; arun *= a_; acc[0][nt][r] = arun; acc[1][nt][r] = hrun; }
                sa_[q] = arun; sh_[q] = hrun; }
            float runA = 1.f, runH = 0.f;
#pragma unroll
            for (int q = 0; q < 4; ++q) { float a0 = sa_[q], a1 = sa_[q], h0 = sh_[q], h1 = sh_[q]; lr_swap32(a0, a1); lr_swap32(h0, h1);
                const float midA = runA * a0, midH = a0 * runH + h0;
                const float inA = hi ? midA : runA, inH = hi ? midH : runH;
                runA = midA * a1; runH = a1 * midH + h1;
#pragma unroll
                for (int e = 0; e < 4; ++e) { const int r = 4 * q + e; acc[1][nt][r] += acc[0][nt][r] * inH; acc[0][nt][r] *= inA; } }
            if (hi == 0) { SUM[(wave * 64 + 32 * nt + r32) * 2] = runA; SUM[(wave * 64 + 32 * nt + r32) * 2 + 1] = runH; } }
        __syncthreads();
#pragma unroll
        for (int nt = 0; nt < 2; ++nt) { const int cl = 32 * nt + r32;
            float ca = 1.f, chh = 0.f;
            for (int w = 0; w < wave; ++w) { const float aw = SUM[(w * 64 + cl) * 2], hw = SUM[(w * 64 + cl) * 2 + 1]; chh = aw * chh + hw; ca *= aw; }
            GAS unsigned* ha = P.HA + (size_t)(t0 + 32 * wave + 4 * hi) * 512 + 64 * g + cl;
#pragma unroll
            for (int r = 0; r < 16; ++r) { const float hh = acc[1][nt][r] + acc[0][nt][r] * chh, ac_ = acc[0][nt][r] * ca; ha[(size_t)((r & 3) + 8 * (r >> 2)) * 512] = pk2(hh, ac_);
                if (r == 15 && wave == 7 && hi == 1) { P.LSUM[((size_t)tile * 512 + 64 * g + cl) * 2] = ac_; P.LSUM[((size_t)tile * 512 + 64 * g + cl) * 2 + 1] = hh; } } }
    }
}

struct PostP { const GAS bf16* OMB; const GAS unsigned* HA; const GAS float* LSUM; const GAS bf16* PROJB; const GAS float* gm; const GAS float* gl; GAS bf16* Y; };
__device__ __forceinline__ void post_phase(const PostP& P, LAS unsigned char* lds, int tid, int wave, int lane, int vcu, int G) {
    asm volatile("" : "+v"(tid), "+v"(lane));
    LAS float* hin = (LAS float*)lds;
    for (int u = vcu; u < T / 64; u += G) {
        const int t0 = u * 64, tile = t0 >> 8, tb = tile & ~31;
        __syncthreads();
        { float h = 0.f;
          for (int c0 = tb; c0 < tile; c0 += 8) {
              float av_[8], hv_[8];
#pragma unroll
              for (int i = 0; i < 8; ++i) { const int c = (c0 + i < tile) ? (c0 + i) : tb; av_[i] = P.LSUM[((size_t)c * 512 + tid) * 2]; hv_[i] = P.LSUM[((size_t)c * 512 + tid) * 2 + 1]; }
#pragma unroll
              for (int i = 0; i < 8; ++i) { if (c0 + i < tile) h = av_[i] * h + hv_[i]; } }
          hin[tid] = h; }
        __syncthreads();
        f32x4 hi0 = *(const LAS f32x4*)(hin + 8 * lane), hi1 = *(const LAS f32x4*)(hin + 8 * lane + 4);
        const f32x4 g0 = *(const GAS f32x4*)(P.gl + 8 * lane), g1 = *(const GAS f32x4*)(P.gl + 8 * lane + 4), gmv = *(const GAS f32x4*)(P.gm + 4 * lane);
#pragma unroll 2
        for (int i = 0; i < 8; ++i) {
            const size_t t = (size_t)t0 + 8 * wave + i;
            const v4u p0 = *(const GAS v4u*)(P.HA + t * 512 + 8 * lane), p1 = *(const GAS v4u*)(P.HA + t * 512 + 8 * lane + 4), gw_ = *(const GAS v4u*)(P.PROJB + t * INP + PC_GL + 8 * lane);
            const v2u mw = *(const GAS v2u*)(P.OMB + t * 256 + 4 * lane);
            float o[8];
            o[0] = (bflo(p0.x) + bfhi(p0.x) * hi0.x) * gelu_erf(bflo(gw_.x)); o[1] = (bflo(p0.y) + bfhi(p0.y) * hi0.y) * gelu_erf(bfhi(gw_.x));
            o[2] = (bflo(p0.z) + bfhi(p0.z) * hi0.z) * gelu_erf(bflo(gw_.y)); o[3] = (bflo(p0.w) + bfhi(p0.w) * hi0.w) * gelu_erf(bfhi(gw_.y));
            o[4] = (bflo(p1.x) + bfhi(p1.x) * hi1.x) * gelu_erf(bflo(gw_.z)); o[5] = (bflo(p1.y) + bfhi(p1.y) * hi1.y) * gelu_erf(bfhi(gw_.z));
            o[6] = (bflo(p1.z) + bfhi(p1.z) * hi1.z) * gelu_erf(bflo(gw_.w)); o[7] = (bflo(p1.w) + bfhi(p1.w) * hi1.w) * gelu_erf(bfhi(gw_.w));
            float s2 = 0.f;
#pragma unroll
            for (int e = 0; e < 8; ++e) s2 += o[e] * o[e];
            const float m0 = bflo(mw.x), m1 = bfhi(mw.x), m2 = bflo(mw.y), m3 = bfhi(mw.y);
            float s1 = (m0 * m0 + m1 * m1) + (m2 * m2 + m3 * m3);
            s1 = wave_sum(s1, lane); s2 = wave_sum(s2, lane);
            const float r1 = rsqrtf(s1 * (1.f / 256.f) + 1e-6f), r2 = rsqrtf(s2 * (1.f / 512.f) + 1e-6f);
            GAS bf16* yr = P.Y + t * 1024;
            { v2u w; w.x = pk2(m0 * r1 * gmv.x, m1 * r1 * gmv.y); w.y = pk2(m2 * r1 * gmv.z, m3 * r1 * gmv.w); *(GAS v2u*)(yr + 4 * lane) = w; }
            { v4u w; w.x = pk2(o[0] * r2 * g0.x, o[1] * r2 * g0.y); w.y = pk2(o[2] * r2 * g0.z, o[3] * r2 * g0.w); w.z = pk2(o[4] * r2 * g1.x, o[5] * r2 * g1.y); w.w = pk2(o[6] * r2 * g1.z, o[7] * r2 * g1.w);
              *(GAS v4u*)(yr + 256 + 8 * lane) = w; }
        }
    }
}

#define TILE_BAR() asm volatile("s_waitcnt lgkmcnt(0)\n\ts_barrier" ::: "memory")
typedef short bf16x8 __attribute__((ext_vector_type(8)));
typedef short s16x4 __attribute__((ext_vector_type(4)));
typedef float f32x16 __attribute__((ext_vector_type(16)));
typedef unsigned u32x4 __attribute__((ext_vector_type(4)));
__device__ __forceinline__ int crow(int r, int hi) { return (r & 3) + 8 * (r >> 2) + 4 * hi; }
typedef float f32x2_t __attribute__((ext_vector_type(2))); typedef __bf16 bf16x2_c __attribute__((ext_vector_type(2)));
__device__ __forceinline__ unsigned cvtpk(float lo, float hi) { f32x2_t v = {lo, hi}; bf16x2_c b = __builtin_convertvector(v, bf16x2_c); return __builtin_bit_cast(unsigned, b); }
__device__ __forceinline__ float swapmax(float m) { auto rr = __builtin_amdgcn_permlane32_swap(__float_as_uint(m), __float_as_uint(m), false, false); return fmaxf(__uint_as_float(rr[0]), __uint_as_float(rr[1])); }
__device__ __forceinline__ float swapadd(float m) { auto rr = __builtin_amdgcn_permlane32_swap(__float_as_uint(m), __float_as_uint(m), false, false); return __uint_as_float(rr[0]) + __uint_as_float(rr[1]); }
__device__ __forceinline__ s16x4 vtr(const LAS unsigned char* p) { return __builtin_bit_cast(s16x4, __builtin_amdgcn_ds_read_tr16_b64_v4i16((LAS s16x4*)p)); }
__device__ __forceinline__ bf16x8 pack8(const f32x16& p, int b) { u32x4 w; w.x = cvtpk(p[b], p[b + 1]); w.y = cvtpk(p[b + 2], p[b + 3]); w.z = cvtpk(p[b + 4], p[b + 5]); w.w = cvtpk(p[b + 6], p[b + 7]); return __builtin_bit_cast(bf16x8, w); }
__device__ __forceinline__ float vmax3(float a, float b, float c) { float r; asm("v_max3_f32 %0, %1, %2, %3" : "=v"(r) : "v"(a), "v"(b), "v"(c)); return r; }
__device__ __forceinline__ float max32(const f32x16& p, const f32x16& q) {
    float a = vmax3(p[0], p[1], p[2]), b = vmax3(p[3], p[4], p[5]), c = vmax3(p[6], p[7], p[8]), d = vmax3(p[9], p[10], p[11]), e = vmax3(p[12], p[13], p[14]);
    float f = vmax3(q[0], q[1], q[2]), g = vmax3(q[3], q[4], q[5]), h = vmax3(q[6], q[7], q[8]), i = vmax3(q[9], q[10], q[11]), j = vmax3(q[12], q[13], q[14]);
    a = vmax3(a, b, c); d = vmax3(d, e, p[15]); f = vmax3(f, g, h); i = vmax3(i, j, q[15]);
    return vmax3(vmax3(a, d, f), i, i);
}
__device__ __forceinline__ float max16(const f32x16& p) { float a = fmaxf(fmaxf(p[0], p[1]), fmaxf(p[2], p[3])), b = fmaxf(fmaxf(p[4], p[5]), fmaxf(p[6], p[7])), c = fmaxf(fmaxf(p[8], p[9]), fmaxf(p[10], p[11])), d = fmaxf(fmaxf(p[12], p[13]), fmaxf(p[14], p[15])); return fmaxf(fmaxf(a, b), fmaxf(c, d)); }

struct AttnP {
    const GAS bf16* Q; const GAS bf16* K; const GAS bf16* V; int qp, kp, vp;
    GAS bf16* O; int op;
    const GAS float* rope;
    const GAS int* pos; const GAS float* btab; const GAS float* dnorm; const GAS float* lams;
};
template <int KIND> struct AK {
    static constexpr bool DIFF = KIND == 1, CROSS = KIND == 2;
    static constexpr int HW = KIND == 0 ? 96 : KIND == 1 ? 64 : 256;
    static constexpr int NKS = KIND == 0 ? 6 : KIND == 1 ? 2 : 16;
    static constexpr int KP = KIND == 0 ? 208 : KIND == 1 ? 144 : 528;
    static constexpr int ND = CROSS ? 4 : 2;
    static constexpr int CPK = HW / 8, KCH = (64 * CPK + 511) / 512;
    static constexpr int VCH = ND / 2;
    static constexpr int KB = 64 * KP, VB = ND * 4096;
    static constexpr int NBUF = CROSS ? 2 : 3;
    static constexpr int K0 = 0, V0 = NBUF * KB, POS = V0 + NBUF * VB, BT = POS + 1024, DN = BT + 528, END = DN + 256;
};
static_assert(AK<2>::END <= RING_BYTES && AK<0>::END <= RING_BYTES && AK<1>::END + 16 + 8 * 8192 <= RING_BYTES, "attention LDS");

template <int KIND, bool LEAD>
__device__ __forceinline__ void attn_unit(const AttnP& P, int b, int h, int qb, int dhalf, LAS unsigned char* lds, int tid, int wave, int lane) {
    lane = lane_id_v(); tid = (wave << 6) | lane;
    typedef AK<KIND> C;
    constexpr bool DIFF = C::DIFF, CROSS = C::CROSS;
    constexpr int HW = C::HW, NKS = C::NKS, KP = C::KP, ND = C::ND, CPK = C::CPK, KCH = C::KCH, VCH = C::VCH;
    const int r32 = lane & 31, hi = lane >> 5;
    const size_t rowb = (size_t)b * S, rowk = CROSS ? (size_t)b * MEM : rowb;
    const int q0w = qb * 256 + wave * 32, qi = q0w + r32;
    int pq = 0; float bias_far = 0.f;
    __syncthreads();
    if (DIFF) {
        pq = P.pos[rowb + qi];
        if (tid < 129) ((LAS float*)(lds + C::BT))[tid] = P.btab[h * 129 + tid];
        if (tid >= 192 && tid < 256) ((LAS float*)(lds + C::DN))[tid - 192] = P.dnorm[tid - 192];
    }
    int minq = pq;
    if (DIFF) { for (int o = 1; o < 64; o <<= 1) { const int v = shxi(minq, o, lane); minq = v < minq ? v : minq; } }
    const int NT = CROSS ? MEM / 64 : 4 * (qb + 1);
    u32x4 kr[KCH], vr[VCH]; int pkr = 0;
    u32x4 kr2[CROSS ? 1 : KCH], vr2[CROSS ? 1 : VCH]; int pkr2 = 0;
    const GAS bf16* Kb = P.K + rowk * P.kp + h * HW; const GAS bf16* Vb = P.V + rowk * P.vp + (CROSS ? h * 256 + dhalf * 128 : h * 64);
    const __amdgpu_buffer_rsrc_t rK = __builtin_amdgcn_make_buffer_rsrc((void*)Kb, 0, 0x7fffffff, 0x00020000), rV = __builtin_amdgcn_make_buffer_rsrc((void*)Vb, 0, 0x7fffffff, 0x00020000);
    const __amdgpu_buffer_rsrc_t rP = __builtin_amdgcn_make_buffer_rsrc((void*)(DIFF ? P.pos + rowb : (const GAS int*)Kb), 0, 0x7fffffff, 0x00020000);
    int kvo[KCH], vvo[VCH];
#pragma unroll
    for (int i = 0; i < KCH; ++i) { int c = tid + 512 * i; c = c < 64 * CPK ? c : tid; kvo[i] = ((c / CPK) * P.kp + (c % CPK) * 8) * 2; }
#pragma unroll
    for (int i = 0; i < VCH; ++i) { const int c = tid + 512 * i; vvo[i] = ((c / (4 * ND)) * P.vp + (c % (4 * ND)) * 8) * 2; }
    const int pvo = (tid & 63) * 4;
    auto gload = [&](int t) {
        const int ks = __builtin_amdgcn_readfirstlane(64 * t * P.kp * 2), vs = __builtin_amdgcn_readfirstlane(64 * t * P.vp * 2);
#pragma unroll
        for (int i = 0; i < KCH; ++i) kr[i] = __builtin_amdgcn_raw_buffer_load_b128(rK, kvo[i], ks, 0);
#pragma unroll
        for (int i = 0; i < VCH; ++i) vr[i] = __builtin_amdgcn_raw_buffer_load_b128(rV, vvo[i], vs, 0);
        if (DIFF) pkr = __builtin_amdgcn_raw_buffer_load_b32(rP, pvo, __builtin_amdgcn_readfirstlane(64 * t * 4), 0);
    };
    auto lstore = [&](int buf) {
        LAS unsigned char* kb_ = lds + C::K0 + buf * C::KB; LAS unsigned char* vb_ = lds + C::V0 + buf * C::VB;
#pragma unroll
        for (int i = 0; i < KCH; ++i) { int c = tid + 512 * i; c = c < 64 * CPK ? c : tid; const int key = c / CPK, part = c % CPK; *(LAS u32x4*)(kb_ + key * KP + part * 16) = kr[i]; }
#pragma unroll
        for (int i = 0; i < VCH; ++i) { const int c = tid + 512 * i; const int key = c / (4 * ND), part = c % (4 * ND); *(LAS u32x4*)(vb_ + (part >> 2) * 4096 + (key >> 3) * 512 + (key & 7) * 64 + (part & 3) * 16) = vr[i]; }
        if (DIFF) { ((LAS int*)(lds + C::POS + buf * 256))[tid & 63] = pkr; if (tid < 64) { int mk_ = pkr; for (int o = 1; o < 64; o <<= 1) { const int v = shxi(mk_, o, lane); mk_ = v > mk_ ? v : mk_; } if (tid == 0) ((LAS int*)(lds + C::POS + 768))[buf] = mk_; } }
    };
    auto gloadB = [&](int t) {
        const int ks = __builtin_amdgcn_readfirstlane(64 * t * P.kp * 2), vs = __builtin_amdgcn_readfirstlane(64 * t * P.vp * 2);
#pragma unroll
        for (int i = 0; i < (CROSS ? 1 : KCH); ++i) kr2[i] = __builtin_amdgcn_raw_buffer_load_b128(rK, kvo[i], ks, 0);
#pragma unroll
        for (int i = 0; i < (CROSS ? 1 : VCH); ++i) vr2[i] = __builtin_amdgcn_raw_buffer_load_b128(rV, vvo[i], vs, 0);
        if (DIFF) pkr2 = __builtin_amdgcn_raw_buffer_load_b32(rP, pvo, __builtin_amdgcn_readfirstlane(64 * t * 4), 0);
    };
    auto lstoreB = [&](int buf) {
        LAS unsigned char* kb_ = lds + C::K0 + buf * C::KB; LAS unsigned char* vb_ = lds + C::V0 + buf * C::VB;
#pragma unroll
        for (int i = 0; i < (CROSS ? 1 : KCH); ++i) { int c = tid + 512 * i; c = c < 64 * CPK ? c : tid; const int key = c / CPK, part = c % CPK; *(LAS u32x4*)(kb_ + key * KP + part * 16) = kr2[i]; }
#pragma unroll
        for (int i = 0; i < (CROSS ? 1 : VCH); ++i) { const int c = tid + 512 * i; const int key = c / (4 * ND), part = c % (4 * ND); *(LAS u32x4*)(vb_ + (part >> 2) * 4096 + (key >> 3) * 512 + (key & 7) * 64 + (part & 3) * 16) = vr2[i]; }
        if (DIFF) { ((LAS int*)(lds + C::POS + buf * 256))[tid & 63] = pkr2; if (tid < 64) { int mk_ = pkr2; for (int o = 1; o < 64; o <<= 1) { const int v = shxi(mk_, o, lane); mk_ = v > mk_ ? v : mk_; } if (tid == 0) ((LAS int*)(lds + C::POS + 768))[buf] = mk_; } }
    };
    LAS float* osv = (LAS float*)(lds + ((C::END + 15) & ~15)) + wave * 2048 + lane;
    float il = 0.f;
    f32x16 oA[ND];
#pragma unroll 1
    for (int mp = 0; mp < (DIFF ? 2 : 1); ++mp) {
        bf16x8 qf[NKS];
        { const GAS bf16* qrow = P.Q + (rowb + qi) * P.qp + h * HW + mp * 32;
#pragma unroll
          for (int s = 0; s < NKS; ++s) qf[s] = *(const GAS bf16x8*)(qrow + 16 * s + 8 * hi);
          if (KIND == 0) {
              const GAS float* rp = P.rope + (rowb + qi) * 32 + 8 * hi;
              const f32x4 c0 = *(const GAS f32x4*)rp, c1 = *(const GAS f32x4*)(rp + 4), s0 = *(const GAS f32x4*)(rp + 16), s1 = *(const GAS f32x4*)(rp + 20);
              const u32x4 a = __builtin_bit_cast(u32x4, qf[NKS - 2]), bq = __builtin_bit_cast(u32x4, qf[NKS - 1]); u32x4 ra, rb;
#pragma unroll
              for (int w = 0; w < 4; ++w) { const float cl = w < 2 ? c0[2 * w] : c1[2 * w - 4], ch = w < 2 ? c0[2 * w + 1] : c1[2 * w - 3], sl = w < 2 ? s0[2 * w] : s1[2 * w - 4], sh = w < 2 ? s0[2 * w + 1] : s1[2 * w - 3];
                  const float x1l = bflo(a[w]), x1h = bfhi(a[w]), x2l = bflo(bq[w]), x2h = bfhi(bq[w]);
                  ra[w] = cvtpk(x1l * cl - x2l * sl, x1h * ch - x2h * sh); rb[w] = cvtpk(x1l * sl + x2l * cl, x1h * sh + x2h * ch); }
              qf[NKS - 2] = __builtin_bit_cast(bf16x8, ra); qf[NKS - 1] = __builtin_bit_cast(bf16x8, rb);
          } }
        __syncthreads();
        float m1 = -1e30f, l1 = 0.f;
#pragma unroll
        for (int d = 0; d < ND; ++d)
#pragma unroll
            for (int r = 0; r < 16; ++r) oA[d][r] = 0.f;
        auto qk = [&](int sl, f32x16& sa, f32x16& sb, float init) {
            const LAS unsigned char* kb_ = lds + C::K0 + sl * C::KB + r32 * KP + hi * 16 + mp * 64;
#pragma unroll
            for (int r = 0; r < 16; ++r) { sa[r] = init; sb[r] = init; }
            constexpr int HB = CROSS ? 4 : (NKS > 3 ? 3 : NKS);
#pragma unroll
            for (int s0_ = 0; s0_ < NKS; s0_ += HB) {
                bf16x8 kfa[HB], kfb[HB];
#pragma unroll
                for (int s = 0; s < HB; ++s) { kfa[s] = *(const LAS bf16x8*)(kb_ + (s0_ + s) * 32); kfb[s] = *(const LAS bf16x8*)(kb_ + 32 * KP + (s0_ + s) * 32); }
                __builtin_amdgcn_sched_barrier(0);
#pragma unroll
                for (int s = 0; s < HB; ++s) { sa = __builtin_amdgcn_mfma_f32_32x32x16_bf16(kfa[s], qf[s0_ + s], sa, 0, 0, 0); sb = __builtin_amdgcn_mfma_f32_32x32x16_bf16(kfb[s], qf[s0_ + s], sb, 0, 0, 0); }
                __builtin_amdgcn_sched_barrier(0);
            }
        };
        auto isnear = [&](int sl) { bool nb = false;
            if (DIFF) { const int mk_ = __builtin_amdgcn_readfirstlane(((LAS int*)(lds + C::POS + 768))[sl]); nb = (minq - mk_) < 128; }
            return nb; };
        auto sm = [&](int t, int sl, f32x16& pa, f32x16& pb, bool nearb) -> float {
            const int k0 = 64 * t;
            if (DIFF) { if (nearb) {
                const LAS int* pk = (const LAS int*)(lds + C::POS + sl * 256); const LAS float* bt = (const LAS float*)(lds + C::BT);
#pragma unroll
                for (int r = 0; r < 16; ++r) { const int kk = crow(r, hi);
                    int n0 = pq - pk[kk], n1 = pq - pk[kk + 32]; n0 = n0 < 0 ? 0 : (n0 > 128 ? 128 : n0); n1 = n1 < 0 ? 0 : (n1 > 128 ? 128 : n1);
                    pa[r] += bt[n0]; pb[r] += bt[n1]; }
            } }
            if (!CROSS && k0 + 63 > q0w) {
#pragma unroll
                for (int r = 0; r < 16; ++r) { const int kk = k0 + crow(r, hi); if (kk > qi) pa[r] = -1e30f; if (kk + 32 > qi) pb[r] = -1e30f; }
            }
            asm volatile("s_nop 15\n\ts_nop 7" : "+v"(pa), "+v"(pb));
            float mn, al = 1.f;
            if (CROSS) { const float mx = swapmax(max32(pa, pb)); mn = fmaxf(m1, mx); al = __builtin_amdgcn_exp2f(m1 - mn); l1 *= al; }
            else { const float mx = swapmax(max32(pa, pb)); const bool up = mx > m1 + 8.0f; mn = up ? mx : m1;
                   if (__builtin_amdgcn_ballot_w64(up) != 0ull) { al = __builtin_amdgcn_exp2f(m1 - mn); l1 *= al; } }
            m1 = mn;
            float ls = 0.f;
#pragma unroll
            for (int r = 0; r < 16; ++r) { pa[r] = __builtin_amdgcn_exp2f(pa[r] - mn); pb[r] = __builtin_amdgcn_exp2f(pb[r] - mn); ls += pa[r] + pb[r]; }
            l1 += ls;
            return al;
        };
        auto pv = [&](int sl, const f32x16& pa, const f32x16& pb, float al) {
            const LAS unsigned char* vb_ = lds + C::V0 + sl * C::VB + ((lane >> 4) & 1) * 32 + (lane & 3) * 8 + (4 * hi + ((lane & 15) >> 2)) * 64;
            bf16x8 pf[4];
            pf[0] = pack8(pa, 0); pf[1] = pack8(pa, 8); pf[2] = pack8(pb, 0); pf[3] = pack8(pb, 8);
            const bool resc = CROSS ? true : (__builtin_amdgcn_ballot_w64(al != 1.0f) != 0ull);
            if (CROSS) {
#pragma unroll
                for (int d = 0; d < ND; ++d) {
                    __builtin_amdgcn_sched_barrier(0);
#pragma unroll
                    for (int r = 0; r < 16; ++r) oA[d][r] *= al;
                    bf16x8 vf[4];
#pragma unroll
                    for (int s = 0; s < 4; ++s) { const s16x4 lo = vtr(vb_ + d * 4096 + s * 1024), hh = vtr(vb_ + d * 4096 + s * 1024 + 512); vf[s] = (bf16x8){lo[0], lo[1], lo[2], lo[3], hh[0], hh[1], hh[2], hh[3]}; }
#pragma unroll
                    for (int s = 0; s < 4; ++s) oA[d] = __builtin_amdgcn_mfma_f32_32x32x16_bf16(vf[s], pf[s], oA[d], 0, 0, 0);
                }
            } else if (DIFF) {
                if (resc) {
#pragma unroll
                    for (int d = 0; d < 2; ++d)
#pragma unroll
                        for (int r = 0; r < 16; ++r) oA[d][r] *= al;
                }
#pragma unroll
                for (int d = 0; d < 2; ++d) {
                    bf16x8 vf[4];
#pragma unroll
                    for (int s = 0; s < 4; ++s) { const s16x4 lo = vtr(vb_ + d * 4096 + s * 1024), hh = vtr(vb_ + d * 4096 + s * 1024 + 512); vf[s] = (bf16x8){lo[0], lo[1], lo[2], lo[3], hh[0], hh[1], hh[2], hh[3]}; }
                    __builtin_amdgcn_sched_barrier(0);
#pragma unroll
                    for (int s = 0; s < 4; ++s) oA[d] = __builtin_amdgcn_mfma_f32_32x32x16_bf16(vf[s], pf[s], oA[d], 0, 0, 0);
                }
            } else {
                bf16x8 vf[2][4];
#pragma unroll
                for (int d = 0; d < 2; ++d)
#pragma unroll
                    for (int s = 0; s < 4; ++s) { const s16x4 lo = vtr(vb_ + d * 4096 + s * 1024), hh = vtr(vb_ + d * 4096 + s * 1024 + 512); vf[d][s] = (bf16x8){lo[0], lo[1], lo[2], lo[3], hh[0], hh[1], hh[2], hh[3]}; }
                if (resc) {
#pragma unroll
                    for (int d = 0; d < 2; ++d)
#pragma unroll
                        for (int r = 0; r < 16; ++r) oA[d][r] *= al;
                }
                __builtin_amdgcn_sched_barrier(0);
#pragma unroll
                for (int s = 0; s < 4; ++s)
#pragma unroll
                    for (int d = 0; d < 2; ++d) oA[d] = __builtin_amdgcn_mfma_f32_32x32x16_bf16(vf[d][s], pf[s], oA[d], 0, 0, 0);
            }
        };
        if (CROSS) {
            gload(0); lstore(0);
            __syncthreads();
            for (int t = 0; t < NT; ++t) {
                const int buf = t & 1;
                f32x16 pa, pb;
                qk(buf, pa, pb, 0.f);
                const float al = sm(t, buf, pa, pb, false);
                pv(buf, pa, pb, al);
                if (t + 1 < NT) { gload(t + 1); lstore(buf ^ 1); }
                TILE_BAR();
            }
        } else {
            gload(0); lstore(0); gload(1); lstore(1);
            gload(2); gloadB(3);
            __syncthreads();
            if (DIFF) bias_far = ((LAS float*)(lds + C::BT))[128];
            const int NTW = (q0w + 31) / 64 + 1;
            constexpr bool lead = LEAD;
            f32x16 ca, cb, na, nb; bool cnear = isnear(0), nnear = false; float cal = 1.f;
            qk(0, ca, cb, (DIFF && !cnear) ? bias_far : 0.f);
            if (lead) cal = sm(0, 0, ca, cb, cnear);
            int s0 = 0, s1 = 1, s2 = 2;
            auto period = [&](int t, f32x16& xa, f32x16& xb, bool& xnear, f32x16& ya, f32x16& yb, bool& ynear) {
                const bool have_next = (t + 1 < NTW);
                if (lead) {
                    if (have_next) { ynear = isnear(s1); qk(s1, ya, yb, (DIFF && !ynear) ? bias_far : 0.f); }
                    if (t < NTW) pv(s0, xa, xb, cal);
                    if (have_next) cal = sm(t + 1, s1, ya, yb, ynear);
                } else {
                    if (t < NTW) cal = sm(t, s0, xa, xb, xnear);
                    if (have_next) { ynear = isnear(s1); qk(s1, ya, yb, (DIFF && !ynear) ? bias_far : 0.f); }
                    if (t < NTW) pv(s0, xa, xb, cal);
                }
                { const int tmp = s0; s0 = s1; s1 = s2; s2 = tmp; }
            };
            int t = 0;
            for (; t + 5 < NT; t += 2) {
                lstore(s2); gload(t + 4);
                period(t, ca, cb, cnear, na, nb, nnear);
                TILE_BAR();
                lstoreB(s2); gloadB(t + 5);
                period(t + 1, na, nb, nnear, ca, cb, cnear);
                TILE_BAR();
            }
            for (; t < NT; t += 2) {
                if (t + 2 < NT) { lstore(s2); if (t + 4 < NT) gload(t + 4); }
                period(t, ca, cb, cnear, na, nb, nnear);
                TILE_BAR();
                if (t + 3 < NT) { lstoreB(s2); if (t + 5 < NT) gloadB(t + 5); }
                period(t + 1, na, nb, nnear, ca, cb, cnear);
                TILE_BAR();
            }
        }
        il = 1.f / swapadd(l1);
        if (DIFF) { if (mp == 0) {
#pragma unroll
            for (int d = 0; d < 2; ++d)
#pragma unroll
                for (int r = 0; r < 16; ++r) osv[(d * 16 + r) * 64] = oA[d][r] * il; } }
    }
    GAS bf16* orow = P.O + (rowb + qi) * P.op + (CROSS ? h * 256 + dhalf * 128 : h * 64);
    if (!DIFF) {
#pragma unroll
        for (int d = 0; d < ND; ++d)
#pragma unroll
            for (int g = 0; g < 4; ++g) { v2u v; v.x = cvtpk(oA[d][4 * g] * il, oA[d][4 * g + 1] * il); v.y = cvtpk(oA[d][4 * g + 2] * il, oA[d][4 * g + 3] * il); *(GAS v2u*)(orow + 32 * d + 8 * g + 4 * hi) = v; }
    } else {
        const float lam = P.lams[0], lam_init = P.lams[1];
        const float i2 = lam * il;
        float ss = 0.f;
#pragma unroll
        for (int d = 0; d < 2; ++d)
#pragma unroll
            for (int r = 0; r < 16; ++r) { const float v = osv[(d * 16 + r) * 64] - oA[d][r] * i2; oA[d][r] = v; ss += v * v; }
        ss = swapadd(ss);
        const float rs = __builtin_amdgcn_rsqf(ss * (1.f / 64.f) + 1e-6f) * (1.f - lam_init);
        const LAS float* dn = (const LAS float*)(lds + C::DN);
#pragma unroll
        for (int d = 0; d < 2; ++d)
#pragma unroll
            for (int g = 0; g < 4; ++g) { const int c = 32 * d + 8 * g + 4 * hi; const f32x4 gn = *(const LAS f32x4*)(dn + c);
                v2u v; v.x = cvtpk(oA[d][4 * g] * rs * gn[0], oA[d][4 * g + 1] * rs * gn[1]); v.y = cvtpk(oA[d][4 * g + 2] * rs * gn[2], oA[d][4 * g + 3] * rs * gn[3]); *(GAS v2u*)(orow + c) = v; }
    }
}

__device__ __forceinline__ int wave_max_i(int v) {
    { const int o = __builtin_amdgcn_update_dpp(0, v, 0xB1, 0xF, 0xF, true); v = o > v ? o : v; }
    { const int o = __builtin_amdgcn_update_dpp(0, v, 0x4E, 0xF, 0xF, true); v = o > v ? o : v; }
    { const int o = __builtin_amdgcn_update_dpp(0, v, 0x141, 0xF, 0xF, true); v = o > v ? o : v; }
    { const int o = __builtin_amdgcn_update_dpp(0, v, 0x140, 0xF, 0xF, true); v = o > v ? o : v; }
    { int a = v, b = v; asm volatile("v_nop\n\tv_nop\n\tv_permlane16_swap_b32 %0, %1" : "+v"(a), "+v"(b)); v = a > b ? a : b; }
    { int a = v, b = v; asm volatile("v_nop\n\tv_nop\n\tv_permlane32_swap_b32 %0, %1" : "+v"(a), "+v"(b)); v = a > b ? a : b; }
    return v;
}
template <int KIND> struct AK2 {
    static constexpr bool DIFF = KIND == 1;
    static constexpr int HW = KIND == 0 ? 96 : 64, NKS = KIND == 0 ? 6 : 2, KP = KIND == 0 ? 208 : 144;
    static constexpr int CPK = HW / 8, KCH = (128 * CPK) / 512, VCH = 2;
    static constexpr int KB = 128 * KP, VB = 2 * 8192;
    static constexpr int K0 = 0, V0 = 2 * KB, POS = V0 + 2 * VB, PMX = POS + 1024, BT = PMX + 16, DN = BT + 528, OSV = (DN + 256 + 15) & ~15, END = OSV + (DIFF ? 8 * 8192 : 0);
};
static_assert(AK2<0>::END <= RING_BYTES && AK2<1>::END <= RING_BYTES, "attention LDS (128-key tiles)");
template <int KIND>
__device__ __forceinline__ void attn_unit2(const AttnP& P, int b, int h, int qb, LAS unsigned char* lds, int tid, int wave, int lane) {
    lane = lane_id_v(); tid = (wave << 6) | lane;
    typedef AK2<KIND> C;
    constexpr bool DIFF = C::DIFF;
    constexpr int HW = C::HW, NKS = C::NKS, KP = C::KP, CPK = C::CPK, KCH = C::KCH, VCH = C::VCH;
    const int r32 = lane & 31, hi = lane >> 5;
    const size_t rowb = (size_t)b * S;
    const int q0w = qb * 256 + wave * 32, qi = q0w + r32;
    int pq = 0; float bias_far = 0.f;
    __syncthreads();
    if (DIFF) {
        pq = P.pos[rowb + qi];
        if (tid < 129) ((LAS float*)(lds + C::BT))[tid] = P.btab[h * 129 + tid];
        if (tid >= 192 && tid < 256) ((LAS float*)(lds + C::DN))[tid - 192] = P.dnorm[tid - 192];
    }
    int minq = pq;
    if (DIFF) minq = __builtin_amdgcn_readfirstlane(-wave_max_i(-pq));
    const int NT = 2 * (qb + 1);
    const GAS bf16* Kb = P.K + rowb * P.kp + h * HW; const GAS bf16* Vb = P.V + rowb * P.vp + h * 64;
    const __amdgpu_buffer_rsrc_t rK = __builtin_amdgcn_make_buffer_rsrc((void*)Kb, 0, 0x7fffffff, 0x00020000), rV = __builtin_amdgcn_make_buffer_rsrc((void*)Vb, 0, 0x7fffffff, 0x00020000);
    const __amdgpu_buffer_rsrc_t rP = __builtin_amdgcn_make_buffer_rsrc((void*)(DIFF ? P.pos + rowb : (const GAS int*)Kb), 0, 0x7fffffff, 0x00020000);
    int kvo[KCH], vvo[VCH], klo[KCH], vlo[VCH];
#pragma unroll
    for (int i = 0; i < KCH; ++i) { const int c = tid + 512 * i; kvo[i] = ((c / CPK) * P.kp + (c % CPK) * 8) * 2; klo[i] = (c / CPK) * KP + (c % CPK) * 16; }
#pragma unroll
    for (int i = 0; i < VCH; ++i) { const int c = tid + 512 * i; const int key = c >> 3, part = c & 7; vvo[i] = (key * P.vp + part * 8) * 2; vlo[i] = (part >> 2) * 8192 + (key >> 3) * 512 + (key & 7) * 64 + (part & 3) * 16; }
    const int pvo = (tid & 127) * 4;
    u32x4 kr[KCH], vr[VCH]; int pkr = 0;
    auto gload = [&](int t) {
        const int ks = __builtin_amdgcn_readfirstlane(128 * t * P.kp * 2), vs = __builtin_amdgcn_readfirstlane(128 * t * P.vp * 2);
#pragma unroll
        for (int i = 0; i < KCH; ++i) kr[i] = __builtin_amdgcn_raw_buffer_load_b128(rK, kvo[i], ks, 0);
#pragma unroll
        for (int i = 0; i < VCH; ++i) vr[i] = __builtin_amdgcn_raw_buffer_load_b128(rV, vvo[i], vs, 0);
        if (DIFF) pkr = __builtin_amdgcn_raw_buffer_load_b32(rP, pvo, __builtin_amdgcn_readfirstlane(128 * t * 4), 0);
    };
    auto lstore = [&](int buf) {
        LAS unsigned char* kb_ = lds + C::K0 + buf * C::KB; LAS unsigned char* vb_ = lds + C::V0 + buf * C::VB;
#pragma unroll
        for (int i = 0; i < KCH; ++i) *(LAS u32x4*)(kb_ + klo[i]) = kr[i];
#pragma unroll
        for (int i = 0; i < VCH; ++i) *(LAS u32x4*)(vb_ + vlo[i]) = vr[i];
        if (DIFF) { ((LAS int*)(lds + C::POS + buf * 512))[tid & 127] = pkr;
            if (tid < 128) { const int mk_ = wave_max_i(pkr); if (lane == 0) ((LAS int*)(lds + C::PMX))[buf * 2 + wave] = mk_; } }
    };
    LAS float* osv = (LAS float*)(lds + C::OSV) + wave * 2048 + lane;
    float il = 0.f;
    f32x16 oA[2];
#pragma unroll 1
    for (int mp = 0; mp < (DIFF ? 2 : 1); ++mp) {
        bf16x8 qf[NKS];
        { const GAS bf16* qrow = P.Q + (rowb + qi) * P.qp + h * HW + mp * 32;
#pragma unroll
          for (int s = 0; s < NKS; ++s) qf[s] = *(const GAS bf16x8*)(qrow + 16 * s + 8 * hi);
          if (KIND == 0) {
              const GAS float* rp = P.rope + (rowb + qi) * 32 + 8 * hi;
              const f32x4 c0 = *(const GAS f32x4*)rp, c1 = *(const GAS f32x4*)(rp + 4), s0 = *(const GAS f32x4*)(rp + 16), s1 = *(const GAS f32x4*)(rp + 20);
              const u32x4 a = __builtin_bit_cast(u32x4, qf[NKS - 2]), bq = __builtin_bit_cast(u32x4, qf[NKS - 1]); u32x4 ra, rb;
#pragma unroll
              for (int w = 0; w < 4; ++w) { const float cl = w < 2 ? c0[2 * w] : c1[2 * w - 4], ch = w < 2 ? c0[2 * w + 1] : c1[2 * w - 3], sl = w < 2 ? s0[2 * w] : s1[2 * w - 4], sh = w < 2 ? s0[2 * w + 1] : s1[2 * w - 3];
                  const float x1l = bflo(a[w]), x1h = bfhi(a[w]), x2l = bflo(bq[w]), x2h = bfhi(bq[w]);
                  ra[w] = cvtpk(x1l * cl - x2l * sl, x1h * ch - x2h * sh); rb[w] = cvtpk(x1l * sl + x2l * cl, x1h * sh + x2h * ch); }
              qf[NKS - 2] = __builtin_bit_cast(bf16x8, ra); qf[NKS - 1] = __builtin_bit_cast(bf16x8, rb);
          } }
        __syncthreads();
        float m1 = 0.f, l1 = 0.f;
        f32x16 negm;
#pragma unroll
        for (int r = 0; r < 16; ++r) negm[r] = 0.f;
#pragma unroll
        for (int d = 0; d < 2; ++d)
#pragma unroll
            for (int r = 0; r < 16; ++r) oA[d][r] = 0.f;
        gload(0); lstore(0);
        if (NT > 1) gload(1);
        __syncthreads();
        if (DIFF) { bias_far = ((LAS float*)(lds + C::BT))[128];
#pragma unroll
            for (int r = 0; r < 16; ++r) negm[r] = bias_far; }
        const int NTW = (q0w + 31) / 128 + 1;
        auto compute = [&](int t, int buf) {
            const int k0 = 128 * t;
            const LAS unsigned char* kb_ = lds + C::K0 + buf * C::KB + r32 * KP + hi * 16 + mp * 64;
            const LAS unsigned char* vb_ = lds + C::V0 + buf * C::VB + ((lane >> 4) & 1) * 32 + (lane & 3) * 8 + (4 * hi + ((lane & 15) >> 2)) * 64;
            bool nearb = false;
            if (DIFF) { const LAS int* pm = (const LAS int*)(lds + C::PMX) + buf * 2; const int m0 = __builtin_amdgcn_readfirstlane(pm[0]), m1_ = __builtin_amdgcn_readfirstlane(pm[1]); nearb = (minq - (m0 > m1_ ? m0 : m1_)) < 128; }
            f32x16 sc[4];
            if (DIFF) { if (nearb) {
#pragma unroll
                for (int g = 0; g < 4; ++g)
#pragma unroll
                    for (int r = 0; r < 16; ++r) sc[g][r] = -m1; } }
            constexpr int HB = NKS > 3 ? 3 : NKS;
#pragma unroll
            for (int s0_ = 0; s0_ < NKS; s0_ += HB) {
                bf16x8 kf[4][HB];
#pragma unroll
                for (int g = 0; g < 4; ++g)
#pragma unroll
                    for (int s = 0; s < HB; ++s) kf[g][s] = *(const LAS bf16x8*)(kb_ + 32 * g * KP + (s0_ + s) * 32);
                __builtin_amdgcn_sched_barrier(0);
#pragma unroll
                for (int s = 0; s < HB; ++s)
#pragma unroll
                    for (int g = 0; g < 4; ++g) {
                        if (s0_ + s == 0 && !(DIFF && nearb)) sc[g] = __builtin_amdgcn_mfma_f32_32x32x16_bf16(kf[g][s], qf[s0_ + s], negm, 0, 0, 0);
                        else sc[g] = __builtin_amdgcn_mfma_f32_32x32x16_bf16(kf[g][s], qf[s0_ + s], sc[g], 0, 0, 0); }
                __builtin_amdgcn_sched_barrier(0);
            }
            if (DIFF) { if (nearb) {
                const LAS int* pk = (const LAS int*)(lds + C::POS + buf * 512); const LAS float* bt = (const LAS float*)(lds + C::BT);
#pragma unroll
                for (int g = 0; g < 4; ++g)
#pragma unroll
                    for (int r = 0; r < 16; ++r) { int n0 = pq - pk[32 * g + crow(r, hi)]; n0 = n0 < 0 ? 0 : (n0 > 128 ? 128 : n0); sc[g][r] += bt[n0]; }
            } }
            asm volatile("s_nop 15\n\ts_nop 7" : "+v"(sc[0]), "+v"(sc[1]), "+v"(sc[2]), "+v"(sc[3]));
            if (k0 + 127 > q0w) {
#pragma unroll
                for (int g = 0; g < 4; ++g)
#pragma unroll
                    for (int r = 0; r < 16; ++r) { if (k0 + 32 * g + crow(r, hi) > qi) sc[g][r] = -1e30f; }
            }
            const float mx = swapmax(vmax3(max32(sc[0], sc[1]), max32(sc[2], sc[3]), -1e30f));
            const bool up = (t == 0) || mx > 8.0f;
            float al = 1.f;
            if (__builtin_amdgcn_ballot_w64(up) != 0ull) {
                const float dl = up ? mx : 0.f; al = __builtin_amdgcn_exp2f(-dl); l1 *= al; m1 += dl;
#pragma unroll
                for (int r = 0; r < 16; ++r) negm[r] -= dl;
#pragma unroll
                for (int g = 0; g < 4; ++g)
#pragma unroll
                    for (int r = 0; r < 16; ++r) sc[g][r] -= dl;
            }
            float ls = 0.f;
#pragma unroll
            for (int g = 0; g < 4; ++g)
#pragma unroll
                for (int r = 0; r < 16; ++r) { sc[g][r] = __builtin_amdgcn_exp2f(sc[g][r]); ls += sc[g][r]; }
            l1 += ls;
            bf16x8 pf[8];
#pragma unroll
            for (int g = 0; g < 4; ++g) { pf[2 * g] = pack8(sc[g], 0); pf[2 * g + 1] = pack8(sc[g], 8); }
            if (__builtin_amdgcn_ballot_w64(al != 1.0f) != 0ull) {
#pragma unroll
                for (int d = 0; d < 2; ++d)
#pragma unroll
                    for (int r = 0; r < 16; ++r) oA[d][r] *= al;
            }
#pragma unroll
            for (int d = 0; d < 2; ++d) {
                bf16x8 vf[8];
#pragma unroll
                for (int s = 0; s < 8; ++s) { const s16x4 lo = vtr(vb_ + d * 8192 + s * 1024), hh = vtr(vb_ + d * 8192 + s * 1024 + 512); vf[s] = (bf16x8){lo[0], lo[1], lo[2], lo[3], hh[0], hh[1], hh[2], hh[3]}; }
                __builtin_amdgcn_sched_barrier(0);
#pragma unroll
                for (int s = 0; s < 8; ++s) oA[d] = __builtin_amdgcn_mfma_f32_32x32x16_bf16(vf[s], pf[s], oA[d], 0, 0, 0);
                __builtin_amdgcn_sched_barrier(0);
            }
        };
        int t = 0;
        for (; t + 2 < NT; ++t) {
            const int buf = t & 1;
            if (t < NTW) compute(t, buf);
            lstore(buf ^ 1); gload(t + 2);
            TILE_BAR();
        }
        for (; t < NT; ++t) {
            const int buf = t & 1;
            if (t < NTW) compute(t, buf);
            if (t + 1 < NT) lstore(buf ^ 1);
            TILE_BAR();
        }
        il = 1.f / swapadd(l1);
        if (DIFF) { if (mp == 0) {
#pragma unroll
            for (int d = 0; d < 2; ++d)
#pragma unroll
                for (int r = 0; r < 16; ++r) osv[(d * 16 + r) * 64] = oA[d][r] * il; } }
    }
    GAS bf16* orow = P.O + (rowb + qi) * P.op + h * 64;
    if (!DIFF) {
#pragma unroll
        for (int d = 0; d < 2; ++d)
#pragma unroll
            for (int g = 0; g < 4; ++g) { v2u v; v.x = cvtpk(oA[d][4 * g] * il, oA[d][4 * g + 1] * il); v.y = cvtpk(oA[d][4 * g + 2] * il, oA[d][4 * g + 3] * il); *(GAS v2u*)(orow + 32 * d + 8 * g + 4 * hi) = v; }
    } else {
        const float lam = P.lams[0], lam_init = P.lams[1];
        const float i2 = lam * il;
        float ss = 0.f;
#pragma unroll
        for (int d = 0; d < 2; ++d)
#pragma unroll
            for (int r = 0; r < 16; ++r) { const float v = osv[(d * 16 + r) * 64] - oA[d][r] * i2; oA[d][r] = v; ss += v * v; }
        ss = swapadd(ss);
        const float rs = __builtin_amdgcn_rsqf(ss * (1.f / 64.f) + 1e-6f) * (1.f - lam_init);
        const LAS float* dn = (const LAS float*)(lds + C::DN);
#pragma unroll
        for (int d = 0; d < 2; ++d)
#pragma unroll
            for (int g = 0; g < 4; ++g) { const int c = 32 * d + 8 * g + 4 * hi; const f32x4 gn = *(const LAS f32x4*)(dn + c);
                v2u v; v.x = cvtpk(oA[d][4 * g] * rs * gn[0], oA[d][4 * g + 1] * rs * gn[1]); v.y = cvtpk(oA[d][4 * g + 2] * rs * gn[2], oA[d][4 * g + 3] * rs * gn[3]); *(GAS v2u*)(orow + c) = v; }
    }
}

__device__ __forceinline__ void attn_phase(const AttnP& PM, const AttnP& PD, LAS unsigned char* lds, int tid, int wave, int lane, int vcu, int G, int only = -1) {
    for (int i = vcu; i < 512; i += G) {
        if (only >= 0 && (i >> 8) != only) continue;
        const int kind = i >> 8, c = i & 255, bh = c >> 4, s = c & 15;
        if (kind == 0) {
#pragma unroll 1
            for (int k = 0; k < 2; ++k) attn_unit2<0>(PM, bh >> 2, bh & 3, k ? 31 - s : s, lds, tid, wave, lane);
        } else {
#pragma unroll 1
            for (int k = 0; k < 2; ++k) attn_unit2<1>(PD, bh >> 2, bh & 3, k ? 31 - s : s, lds, tid, wave, lane);
        }
    }
}
__device__ __forceinline__ float cx_max16(const f32x16& p) { return fmaxf(fmaxf(fmaxf(fmaxf(p[0], p[1]), fmaxf(p[2], p[3])), fmaxf(fmaxf(p[4], p[5]), fmaxf(p[6], p[7]))), fmaxf(fmaxf(fmaxf(p[8], p[9]), fmaxf(p[10], p[11])), fmaxf(fmaxf(p[12], p[13]), fmaxf(p[14], p[15])))); }
__device__ __forceinline__ void cross_unit2(const AttnP& P, int b, int h, int qb, LAS unsigned char* lds, int wave) {
    const int lane = lane_id_v(), tid = (wave << 6) | lane;
    constexpr int KP = 528;
    const int r32 = lane & 31, hi = lane >> 5;
    const size_t rowb = (size_t)b * S, rowk = (size_t)b * MEM;
    const int qi = qb * 256 + wave * 32 + r32;
    const GAS bf16* Kb = P.K + rowk * P.kp + h * 256; const GAS bf16* Vb = P.V + rowk * P.vp + h * 256;
    const __amdgpu_buffer_rsrc_t rK = __builtin_amdgcn_make_buffer_rsrc((void*)Kb, 0, 0x7fffffff, 0x00020000), rV = __builtin_amdgcn_make_buffer_rsrc((void*)Vb, 0, 0x7fffffff, 0x00020000);
    const GAS bf16* qrow = P.Q + (rowb + qi) * P.qp + h * 256 + 8 * hi;
    bf16x8 qf[4];
#pragma unroll
    for (int s = 0; s < 4; ++s) qf[s] = *(const GAS bf16x8*)(qrow + 16 * s);
    { u32x4 st[16];
#pragma unroll
      for (int i = 0; i < 16; ++i) { const int c = tid + 512 * i; st[i] = __builtin_amdgcn_raw_buffer_load_b128(rK, ((c >> 5) * P.kp + (c & 31) * 8) * 2, 0, 0); }
      TILE_BAR();
#pragma unroll
      for (int i = 0; i < 16; ++i) { const int c = tid + 512 * i; *(LAS u32x4*)(lds + (c >> 5) * KP + (c & 31) * 16) = st[i]; } }
    __syncthreads();
    f32x16 sc[8];
#pragma unroll
    for (int g = 0; g < 8; ++g)
#pragma unroll
        for (int r = 0; r < 16; ++r) sc[g][r] = 0.f;
    const LAS unsigned char* kb_ = lds + r32 * KP + hi * 16;
#pragma unroll
    for (int c = 0; c < 4; ++c) {
        bf16x8 qn[4];
        if (c + 1 < 4) {
#pragma unroll
            for (int s = 0; s < 4; ++s) qn[s] = *(const GAS bf16x8*)(qrow + 64 * (c + 1) + 16 * s); }
#pragma unroll
        for (int g = 0; g < 8; ++g) { bf16x8 kf[4];
#pragma unroll
            for (int s = 0; s < 4; ++s) kf[s] = *(const LAS bf16x8*)(kb_ + 32 * g * KP + (4 * c + s) * 32);
#pragma unroll
            for (int s = 0; s < 4; ++s) sc[g] = __builtin_amdgcn_mfma_f32_32x32x16_bf16(kf[s], qf[s], sc[g], 0, 0, 0); }
        if (c + 1 < 4) {
#pragma unroll
            for (int s = 0; s < 4; ++s) qf[s] = qn[s]; }
    }
    float m = fmaxf(fmaxf(fmaxf(cx_max16(sc[0]), cx_max16(sc[1])), fmaxf(cx_max16(sc[2]), cx_max16(sc[3]))), fmaxf(fmaxf(cx_max16(sc[4]), cx_max16(sc[5])), fmaxf(cx_max16(sc[6]), cx_max16(sc[7]))));
    m = swapmax(m);
    float l = 0.f;
    bf16x8 pf[16];
#pragma unroll
    for (int g = 0; g < 8; ++g) {
#pragma unroll
        for (int r = 0; r < 16; ++r) { sc[g][r] = __builtin_amdgcn_exp2f(sc[g][r] - m); l += sc[g][r]; }
        pf[2 * g] = pack8(sc[g], 0); pf[2 * g + 1] = pack8(sc[g], 8); }
    const float il = 1.f / swapadd(l);
    { u32x4 st[16];
#pragma unroll
      for (int i = 0; i < 16; ++i) { const int c = tid + 512 * i; const int sub = c & 3, key = (c >> 2) & 255, dt = c >> 10; st[i] = __builtin_amdgcn_raw_buffer_load_b128(rV, (key * P.vp + dt * 32 + sub * 8) * 2, 0, 0); }
      TILE_BAR();
#pragma unroll
      for (int i = 0; i < 16; ++i) { const int c = tid + 512 * i; const int sub = c & 3, key = (c >> 2) & 255, dt = c >> 10; *(LAS u32x4*)(lds + dt * 16384 + (key >> 3) * 512 + (key & 7) * 64 + sub * 16) = st[i]; } }
    __syncthreads();
    const LAS unsigned char* vb_ = lds + ((lane >> 4) & 1) * 32 + (lane & 3) * 8 + (4 * hi + ((lane & 15) >> 2)) * 64;
    GAS bf16* orow = P.O + (rowb + qi) * P.op + h * 256;
#pragma unroll 1
    for (int dh = 0; dh < 2; ++dh) {
        f32x16 oA[4];
#pragma unroll
        for (int d = 0; d < 4; ++d)
#pragma unroll
            for (int r = 0; r < 16; ++r) oA[d][r] = 0.f;
#pragma unroll
        for (int d = 0; d < 4; ++d) {
#pragma unroll
            for (int sb = 0; sb < 2; ++sb) { bf16x8 vf[8];
#pragma unroll
                for (int s = 0; s < 8; ++s) { const s16x4 lo = vtr(vb_ + (4 * dh + d) * 16384 + (8 * sb + s) * 1024), hh = vtr(vb_ + (4 * dh + d) * 16384 + (8 * sb + s) * 1024 + 512); vf[s] = (bf16x8){lo[0], lo[1], lo[2], lo[3], hh[0], hh[1], hh[2], hh[3]}; }
#pragma unroll
                for (int s = 0; s < 8; ++s) oA[d] = __builtin_amdgcn_mfma_f32_32x32x16_bf16(vf[s], pf[8 * sb + s], oA[d], 0, 0, 0); } }
#pragma unroll
        for (int d = 0; d < 4; ++d)
#pragma unroll
            for (int g = 0; g < 4; ++g) { v2u v; v.x = cvtpk(oA[d][4 * g] * il, oA[d][4 * g + 1] * il); v.y = cvtpk(oA[d][4 * g + 2] * il, oA[d][4 * g + 3] * il); *(GAS v2u*)(orow + 128 * dh + 32 * d + 8 * g + 4 * hi) = v; }
    }
}
__device__ __forceinline__ void cross_phase(const AttnP& PC, LAS unsigned char* lds, int tid, int wave, int lane, int vcu, int G) {
#pragma unroll 1
    for (int i = vcu; i < 512; i += G) { const int bh = i >> 5; cross_unit2(PC, bh >> 2, bh & 3, i & 31, lds, wave); }
}


__device__ __forceinline__ float vmax2(float a, float b) { float r; asm("v_max_f32_e32 %0, %1, %2" : "=v"(r) : "v"(a), "v"(b)); return r; }
__device__ __forceinline__ float vmin2(float a, float b) { float r; asm("v_min_f32_e32 %0, %1, %2" : "=v"(r) : "v"(a), "v"(b)); return r; }
__device__ __forceinline__ void pad16(float (&a)[16]) {
    asm volatile("s_nop 1" : "+v"(a[0]), "+v"(a[1]), "+v"(a[2]), "+v"(a[3]), "+v"(a[4]), "+v"(a[5]), "+v"(a[6]), "+v"(a[7]), "+v"(a[8]), "+v"(a[9]), "+v"(a[10]), "+v"(a[11]), "+v"(a[12]), "+v"(a[13]), "+v"(a[14]), "+v"(a[15]));
}
__device__ __forceinline__ void sort16_desc(float (&a)[16]) {
#pragma unroll
    for (int k = 2; k <= 16; k <<= 1)
#pragma unroll
        for (int j = k >> 1; j > 0; j >>= 1)
#pragma unroll
            for (int i = 0; i < 16; ++i) { const int l = i ^ j; if (l > i) { const bool desc = ((i & k) == 0); const float hi_ = vmax2(a[i], a[l]), lo_ = vmin2(a[i], a[l]); a[i] = desc ? hi_ : lo_; a[l] = desc ? lo_ : hi_; } }
}
__device__ __forceinline__ void merge16_desc(float (&a)[16], const float (&b)[16]) {
#pragma unroll
    for (int i = 0; i < 16; ++i) a[i] = vmax2(a[i], b[15 - i]);
#pragma unroll
    for (int j = 8; j > 0; j >>= 1)
#pragma unroll
        for (int i = 0; i < 16; ++i) { const int l = i ^ j; if (l > i) { const float hi_ = vmax2(a[i], a[l]), lo_ = vmin2(a[i], a[l]); a[i] = hi_; a[l] = lo_; } }
}
__device__ __forceinline__ void top16_of_64(float (&g0)[16], float (&g1)[16], float (&g2)[16], float (&g3)[16]) {
    sort16_desc(g0); sort16_desc(g1); merge16_desc(g0, g1); sort16_desc(g2); sort16_desc(g3); merge16_desc(g2, g3); merge16_desc(g0, g2);
}
__device__ __forceinline__ float embed(float v, unsigned mask, unsigned id) { return __builtin_bit_cast(float, (__builtin_bit_cast(unsigned, v) & mask) | id); }
__device__ __forceinline__ float mkcand(float x, float y, unsigned id) { return embed(x + y, 0xFFFFFF00u, id); }

__device__ __forceinline__ void swap32(float& a, float& b) { asm volatile("v_nop\n\tv_nop\n\tv_permlane32_swap_b32 %0, %1" : "+v"(a), "+v"(b)); }
struct RouteP { const GAS bf16* QP; const GAS bf16* keys; GAS int* EX; GAS float* GW; };
constexpr int RT_KP = 144, RT_KEYS = 0, RT_SCR = 256 * RT_KP, RT_END = RT_SCR + 8 * 8192;
__device__ __forceinline__ void route_phase(const RouteP& P, LAS unsigned char* lds, int tid, int wave, int lane, int vcu, int G) {
    asm volatile("" : "+v"(tid), "+v"(lane));
    __syncthreads();
    for (int c = tid; c < 256 * 8; c += 512) { const int row = c >> 3, part = c & 7; *(LAS u32x4*)(lds + RT_KEYS + row * RT_KP + part * 16) = *(const u32x4*)(P.keys + row * 64 + part * 8); }
    __syncthreads();
    const int r32 = lane & 31, hi = lane >> 5;
    LAS int* scr = (LAS int*)(lds + RT_SCR + wave * 8192);
    for (int u = vcu; u < T / 32; u += G) {
        const size_t t = (size_t)u * 32 + r32; const int h = wave;
        float T2[2][16];
#pragma unroll
        for (int c = 0; c < 2; ++c) {
            bf16x8 qf[4];
            { const GAS bf16* q = P.QP + t * 1024 + h * 128 + c * 64 + 8 * hi;
#pragma unroll
              for (int s = 0; s < 4; ++s) qf[s] = *(const GAS bf16x8*)(q + 16 * s); }
            f32x16 sc[4];
#pragma unroll
            for (int m = 0; m < 4; ++m) {
#pragma unroll
                for (int r = 0; r < 16; ++r) sc[m][r] = 0.f;
#pragma unroll
                for (int s = 0; s < 4; ++s) { const bf16x8 a = *(const LAS bf16x8*)(lds + RT_KEYS + (c * 128 + 32 * m + r32) * RT_KP + s * 32 + hi * 16);
                    sc[m] = __builtin_amdgcn_mfma_f32_32x32x16_bf16(a, qf[s], sc[m], 0, 0, 0); }
            }
            float g0[16], g1[16], g2[16], g3[16];
            const unsigned h4 = 4u * (unsigned)hi;
#pragma unroll
            for (int r = 0; r < 16; ++r) { const unsigned kr_ = (unsigned)((r & 3) + 8 * (r >> 2));
                g0[r] = embed(sc[0][r], 0xFFFFFF80u, kr_ | h4); g1[r] = embed(sc[1][r], 0xFFFFFF80u, (32u + kr_) | h4); g2[r] = embed(sc[2][r], 0xFFFFFF80u, (64u + kr_) | h4); g3[r] = embed(sc[3][r], 0xFFFFFF80u, (96u + kr_) | h4); }
            top16_of_64(g0, g1, g2, g3);
            pad16(g0);
#pragma unroll
            for (int i = 0; i < 16; ++i) T2[c][i] = g0[i];
        }
        float A[16], Bv[16];
#pragma unroll
        for (int i = 0; i < 16; ++i) { A[i] = T2[0][i]; Bv[i] = T2[1][i]; swap32(A[i], Bv[i]); }
        merge16_desc(A, Bv);
        pad16(A);
        float T0[16], T1[16];
#pragma unroll
        for (int i = 0; i < 16; ++i) { T0[i] = A[i]; T1[i] = A[i]; swap32(T0[i], T1[i]); }
#pragma unroll
        for (int i = 0; i < 16; ++i) { scr[i * 64 + lane] = (int)(__builtin_bit_cast(unsigned, T0[i]) & 127u); scr[(16 + i) * 64 + lane] = (int)(__builtin_bit_cast(unsigned, T1[i]) & 127u);
            T0[i] = embed(T0[i], 0xFFFFFF80u, 0u); T1[i] = embed(T1[i], 0xFFFFFF80u, 0u); }
        float c0[16], c1[16], c2[16], c3[16];
        const float NINF = -__builtin_inff();
#pragma unroll
        for (int b = 0; b < 16; ++b) c0[b] = mkcand(T0[0], T1[b], (unsigned)b);
#pragma unroll
        for (int b = 0; b < 8; ++b) c1[b] = mkcand(T0[1], T1[b], 16u + b);
#pragma unroll
        for (int b = 0; b < 5; ++b) c1[8 + b] = mkcand(T0[2], T1[b], 32u + b);
#pragma unroll
        for (int b = 0; b < 3; ++b) c1[13 + b] = mkcand(T0[4], T1[b], 64u + b);
#pragma unroll
        for (int b = 0; b < 4; ++b) c2[b] = mkcand(T0[3], T1[b], 48u + b);
        c2[4] = mkcand(T0[5], T1[0], 80u); c2[5] = mkcand(T0[5], T1[1], 81u); c2[6] = mkcand(T0[6], T1[0], 96u); c2[7] = mkcand(T0[6], T1[1], 97u); c2[8] = mkcand(T0[7], T1[0], 112u); c2[9] = mkcand(T0[7], T1[1], 113u);
#pragma unroll
        for (int a = 8; a < 14; ++a) c2[10 + a - 8] = mkcand(T0[a], T1[0], 16u * a);
        c3[0] = mkcand(T0[14], T1[0], 224u); c3[1] = mkcand(T0[15], T1[0], 240u);
#pragma unroll
        for (int i = 2; i < 16; ++i) c3[i] = NINF;
        top16_of_64(c0, c1, c2, c3);
        pad16(c0);
        float gsum = 0.f, ge[16]; int ex[16];
        const float mtop = embed(c0[0], 0xFFFFFF00u, 0u);
#pragma unroll
        for (int i = 0; i < 16; ++i) { const unsigned bits = __builtin_bit_cast(unsigned, c0[i]); const int a = (bits >> 4) & 15, b = bits & 15;
            ge[i] = __builtin_amdgcn_exp2f((embed(c0[i], 0xFFFFFF00u, 0u) - mtop) * LOG2E); gsum += ge[i];
            ex[i] = scr[a * 64 + lane] * 128 + scr[(16 + b) * 64 + lane]; }
        const float ginv = __builtin_amdgcn_rcpf(gsum);
        if (hi == 0) { GAS v4u* d = (GAS v4u*)(P.EX + t * 128 + h * 16);
#pragma unroll
            for (int i = 0; i < 4; ++i) d[i] = (v4u){(unsigned)ex[4 * i], (unsigned)ex[4 * i + 1], (unsigned)ex[4 * i + 2], (unsigned)ex[4 * i + 3]}; }
        else { GAS f32x4* d = (GAS f32x4*)(P.GW + t * 128 + h * 16);
#pragma unroll
            for (int i = 0; i < 4; ++i) d[i] = (f32x4){ge[4 * i] * ginv, ge[4 * i + 1] * ginv, ge[4 * i + 2] * ginv, ge[4 * i + 3] * ginv}; }
    }
}

__device__ __forceinline__ int wave_allsum_i(int v) {
    v += __builtin_amdgcn_update_dpp(0, v, 0xB1, 0xF, 0xF, true);
    v += __builtin_amdgcn_update_dpp(0, v, 0x4E, 0xF, 0xF, true);
    v += __builtin_amdgcn_update_dpp(0, v, 0x141, 0xF, 0xF, true);
    v += __builtin_amdgcn_update_dpp(0, v, 0x140, 0xF, 0xF, true);
    { int a = v, b = v; asm volatile("v_nop\n\tv_nop\n\tv_permlane16_swap_b32 %0, %1" : "+v"(a), "+v"(b)); v = a + b; }
    { int a = v, b = v; asm volatile("v_nop\n\tv_nop\n\tv_permlane32_swap_b32 %0, %1" : "+v"(a), "+v"(b)); v = a + b; }
    return v;
}
__device__ __forceinline__ float wave_allsum(float v) {
    v += __builtin_bit_cast(float, __builtin_amdgcn_update_dpp(0, __builtin_bit_cast(int, v), 0xB1, 0xF, 0xF, true));
    v += __builtin_bit_cast(float, __builtin_amdgcn_update_dpp(0, __builtin_bit_cast(int, v), 0x4E, 0xF, 0xF, true));
    v += __builtin_bit_cast(float, __builtin_amdgcn_update_dpp(0, __builtin_bit_cast(int, v), 0x141, 0xF, 0xF, true));
    v += __builtin_bit_cast(float, __builtin_amdgcn_update_dpp(0, __builtin_bit_cast(int, v), 0x140, 0xF, 0xF, true));
    { float a = v, b = v; asm volatile("v_nop\n\tv_nop\n\tv_permlane16_swap_b32 %0, %1" : "+v"(a), "+v"(b)); v = a + b; }
    { float a = v, b = v; asm volatile("v_nop\n\tv_nop\n\tv_permlane32_swap_b32 %0, %1" : "+v"(a), "+v"(b)); v = a + b; }
    return v;
}
__device__ __forceinline__ float wave_allmax(float v) {
    v = fmaxf(v, __builtin_bit_cast(float, __builtin_amdgcn_update_dpp(0, __builtin_bit_cast(int, v), 0xB1, 0xF, 0xF, true)));
    v = fmaxf(v, __builtin_bit_cast(float, __builtin_amdgcn_update_dpp(0, __builtin_bit_cast(int, v), 0x4E, 0xF, 0xF, true)));
    v = fmaxf(v, __builtin_bit_cast(float, __builtin_amdgcn_update_dpp(0, __builtin_bit_cast(int, v), 0x141, 0xF, 0xF, true)));
    v = fmaxf(v, __builtin_bit_cast(float, __builtin_amdgcn_update_dpp(0, __builtin_bit_cast(int, v), 0x140, 0xF, 0xF, true)));
    { float a = v, b = v; asm volatile("v_nop\n\tv_nop\n\tv_permlane16_swap_b32 %0, %1" : "+v"(a), "+v"(b)); v = fmaxf(a, b); }
    { float a = v, b = v; asm volatile("v_nop\n\tv_nop\n\tv_permlane32_swap_b32 %0, %1" : "+v"(a), "+v"(b)); v = fmaxf(a, b); }
    return v;
}
__device__ __forceinline__ unsigned q4(float a, float b, float c, float d, int off) {
    const int ia = (int)__builtin_rintf(a) + off, ib = (int)__builtin_rintf(b) + off, ic = (int)__builtin_rintf(c) + off, id = (int)__builtin_rintf(d) + off;
    return (unsigned)(ia & 255) | ((unsigned)(ib & 255) << 8) | ((unsigned)(ic & 255) << 16) | ((unsigned)(id & 255) << 24);
}
__device__ __forceinline__ void quant_row(const GAS float* src, GAS unsigned* dst, GAS float* scale, int off, int lane) {
    const GAS f32x4* s = (const GAS f32x4*)src + 4 * lane; f32x4 v[4]; float m = 0.f;
#pragma unroll
    for (int i = 0; i < 4; ++i) { v[i] = s[i]; m = fmaxf(m, fmaxf(fmaxf(__builtin_fabsf(v[i].x), __builtin_fabsf(v[i].y)), fmaxf(__builtin_fabsf(v[i].z), __builtin_fabsf(v[i].w)))); }
    m = wave_allmax(m); const float inv = m > 0.f ? 127.f / m : 0.f;
    v4u w;
    w.x = q4(v[0].x * inv, v[0].y * inv, v[0].z * inv, v[0].w * inv, off); w.y = q4(v[1].x * inv, v[1].y * inv, v[1].z * inv, v[1].w * inv, off);
    w.z = q4(v[2].x * inv, v[2].y * inv, v[2].z * inv, v[2].w * inv, off); w.w = q4(v[3].x * inv, v[3].y * inv, v[3].z * inv, v[3].w * inv, off);
    *((GAS v4u*)dst + lane) = w;
    if (lane == 0) *scale = m * (1.f / 127.f);
}
struct PeerS { int nslices_step, first_slice, nloc, rank; };
__device__ __forceinline__ PeerS peer_sched(const GAS unsigned* rankw, int xcc, int rank) {
    int nx = 0, myidx = 0, nloc = 1;
    for (int j = 0; j < 16; ++j) { const int c = (int)__hip_atomic_load(rankw + 64 * j, __ATOMIC_RELAXED, __HIP_MEMORY_SCOPE_AGENT); if (c > 0) { if (j == xcc) { myidx = nx; nloc = c; } ++nx; } }
    PeerS s; s.nslices_step = nx > 0 ? nx : 1; s.first_slice = myidx; s.nloc = nloc; s.rank = rank; return s;
}
struct Peer1P { const GAS unsigned GAS char* HQ; const GAS int* EX; const GAS unsigned GAS char* U8; GAS int* P; };
__device__ __forceinline__ void peer_k1(const Peer1P& Q, const PeerS& sc, int wave, int lane) {
    asm volatile("" : "+v"(lane));
    const int g = lane >> 3, j = lane & 7;
    for (int s = sc.first_slice; s < 8; s += sc.nslices_step)
        for (int tile = sc.rank; tile < T / 64; tile += sc.nloc) {
            const size_t t0 = (size_t)tile * 64 + wave * 8;
            v4u hqn = *(const GAS v4u*)(Q.HQ + t0 * 1024 + 128 * s + 16 * j), exn[4];
#pragma unroll
            for (int i = 0; i < 4; ++i) exn[i] = *(const GAS v4u*)(Q.EX + t0 * 128 + 16 * g + 4 * i);
#pragma unroll 1
            for (int k = 0; k < 8; ++k) {
                const size_t t = t0 + k;
                const v4u hq = hqn; v4u ex[4];
#pragma unroll
                for (int i = 0; i < 4; ++i) ex[i] = exn[i];
                if (k + 1 < 8) {
                    hqn = *(const GAS v4u*)(Q.HQ + (t + 1) * 1024 + 128 * s + 16 * j);
#pragma unroll
                    for (int i = 0; i < 4; ++i) exn[i] = *(const GAS v4u*)(Q.EX + (t + 1) * 128 + 16 * g + 4 * i);
                }
                v4u uu[16];
#pragma unroll
                for (int i = 0; i < 16; ++i) { const unsigned e = (i & 3) == 0 ? ex[i >> 2].x : (i & 3) == 1 ? ex[i >> 2].y : (i & 3) == 2 ? ex[i >> 2].z : ex[i >> 2].w;
                    uu[i] = *(const GAS v4u*)(Q.U8 + (size_t)e * 1024 + 128 * s + 16 * j); }
                int lo = 0, hi = 0;
#pragma unroll
                for (int i = 0; i < 16; ++i) {
                    int p = __builtin_amdgcn_sdot4((int)uu[i].x, (int)hq.x, 0, false); p = __builtin_amdgcn_sdot4((int)uu[i].y, (int)hq.y, p, false); p = __builtin_amdgcn_sdot4((int)uu[i].z, (int)hq.z, p, false); p = __builtin_amdgcn_sdot4((int)uu[i].w, (int)hq.w, p, false);
                    p += __builtin_amdgcn_update_dpp(0, p, 0xB1, 0xF, 0xF, true); p += __builtin_amdgcn_update_dpp(0, p, 0x4E, 0xF, 0xF, true); p += __builtin_amdgcn_update_dpp(0, p, 0x141, 0xF, 0xF, true);
                    if (i < 8) lo = (j == i) ? p : lo; else hi = (j == i - 8) ? p : hi;
                }
                GAS int* prow = Q.P + t * 128 + 16 * g + j;
                (void)__hip_atomic_fetch_add(prow, lo, __ATOMIC_RELAXED, __HIP_MEMORY_SCOPE_AGENT); (void)__hip_atomic_fetch_add(prow + 8, hi, __ATOMIC_RELAXED, __HIP_MEMORY_SCOPE_AGENT);
            }
        }
}
__device__ __forceinline__ void peer_w(const GAS int* EX, const GAS float* GW, const GAS int* P, const GAS float* SH, const GAS float* SU, const GAS float* SV, GAS signed char* WQ, GAS float* WSC, int gw, int NGW, int lane) {
    asm volatile("" : "+v"(lane));
    for (int t = gw; t < T; t += NGW) {
        const float sh = SH[t];
#pragma unroll
        for (int q = 0; q < 2; ++q) { const size_t idx = (size_t)t * 128 + lane + 64 * q; const int e = EX[idx];
            const float w = GW[idx] * gelu_erf((float)P[idx] * (sh * SU[e])) * SV[e];
            float m = __builtin_fabsf(w);
            m = fmaxf(m, __builtin_bit_cast(float, __builtin_amdgcn_update_dpp(0, __builtin_bit_cast(int, m), 0xB1, 0xF, 0xF, true)));
            m = fmaxf(m, __builtin_bit_cast(float, __builtin_amdgcn_update_dpp(0, __builtin_bit_cast(int, m), 0x4E, 0xF, 0xF, true)));
            m = fmaxf(m, __builtin_bit_cast(float, __builtin_amdgcn_update_dpp(0, __builtin_bit_cast(int, m), 0x141, 0xF, 0xF, true)));
            m = fmaxf(m, __builtin_bit_cast(float, __builtin_amdgcn_update_dpp(0, __builtin_bit_cast(int, m), 0x140, 0xF, 0xF, true)));
            const float inv = m > 0.f ? 127.f / m : 0.f;
            WQ[idx] = (signed char)(int)__builtin_rintf(w * inv);
            if ((lane & 15) == 0) WSC[(size_t)t * 8 + (lane >> 4) + 4 * q] = m * (1.f / 127.f); }
    }
}
__device__ __forceinline__ void tr4x4(unsigned r0, unsigned r1, unsigned r2, unsigned r3, unsigned (&t)[4]) {
    const unsigned x0 = __builtin_amdgcn_perm(r1, r0, 0x05010400u), x1 = __builtin_amdgcn_perm(r1, r0, 0x07030602u), y0 = __builtin_amdgcn_perm(r3, r2, 0x05010400u), y1 = __builtin_amdgcn_perm(r3, r2, 0x07030602u);
    t[0] = __builtin_amdgcn_perm(y0, x0, 0x05040100u); t[1] = __builtin_amdgcn_perm(y0, x0, 0x07060302u); t[2] = __builtin_amdgcn_perm(y1, x1, 0x05040100u); t[3] = __builtin_amdgcn_perm(y1, x1, 0x07060302u);
}
struct Peer2P { const GAS int* EX; const GAS signed char* WQ; const GAS float* WSC; const GAS unsigned char* V8; GAS bf16* XB; GAS float* SSQ; };
__device__ __forceinline__ void peer_k2(const Peer2P& Q, const PeerS& sc, int wave, int lane) {
    asm volatile("" : "+v"(lane));
    const int g = lane >> 3, j = lane & 7, hf = lane >> 5, rp = (lane >> 4) & 1;
    for (int s = sc.first_slice; s < 8; s += sc.nslices_step)
        for (int tile = sc.rank; tile < T / 64; tile += sc.nloc) {
            const size_t t0 = (size_t)tile * 64 + wave * 8;
            v4u exn[4], wqn; float swn;
#pragma unroll
            for (int i = 0; i < 4; ++i) exn[i] = *(const GAS v4u*)(Q.EX + t0 * 128 + 16 * g + 4 * i);
            wqn = *(const GAS v4u*)(Q.WQ + t0 * 128 + 16 * g); swn = Q.WSC[t0 * 8 + g];
#pragma unroll 1
            for (int k = 0; k < 8; ++k) {
                const size_t t = t0 + k;
                v4u ex[4]; const v4u wq = wqn; const float sw = swn;
#pragma unroll
                for (int i = 0; i < 4; ++i) ex[i] = exn[i];
                if (k + 1 < 8) {
#pragma unroll
                    for (int i = 0; i < 4; ++i) exn[i] = *(const GAS v4u*)(Q.EX + (t + 1) * 128 + 16 * g + 4 * i);
                    wqn = *(const GAS v4u*)(Q.WQ + (t + 1) * 128 + 16 * g); swn = Q.WSC[(t + 1) * 8 + g];
                }
                GAS v2u* xp = (GAS v2u*)(Q.XB + t * 1024 + 128 * s + 16 * j + 8 * hf + 4 * rp);
                const v2u xold = *xp;
                v4u vv[16];
#pragma unroll
                for (int i = 0; i < 16; ++i) { const unsigned e = (i & 3) == 0 ? ex[i >> 2].x : (i & 3) == 1 ? ex[i >> 2].y : (i & 3) == 2 ? ex[i >> 2].z : ex[i >> 2].w;
                    vv[i] = *(const GAS v4u*)(Q.V8 + (size_t)e * 1024 + 128 * s + 16 * j); }
                int ai[16];
#pragma unroll
                for (int i = 0; i < 16; ++i) ai[i] = 0;
#pragma unroll
                for (int q4_ = 0; q4_ < 4; ++q4_) {
                    const unsigned wq4 = q4_ == 0 ? wq.x : q4_ == 1 ? wq.y : q4_ == 2 ? wq.z : wq.w;
#pragma unroll
                    for (int c = 0; c < 4; ++c) { unsigned tt[4];
                        const v4u &a0 = vv[4 * q4_], &a1 = vv[4 * q4_ + 1], &a2 = vv[4 * q4_ + 2], &a3 = vv[4 * q4_ + 3];
                        tr4x4(c == 0 ? a0.x : c == 1 ? a0.y : c == 2 ? a0.z : a0.w, c == 0 ? a1.x : c == 1 ? a1.y : c == 2 ? a1.z : a1.w, c == 0 ? a2.x : c == 1 ? a2.y : c == 2 ? a2.z : a2.w, c == 0 ? a3.x : c == 1 ? a3.y : c == 2 ? a3.z : a3.w, tt);
#pragma unroll
                        for (int b = 0; b < 4; ++b) ai[4 * c + b] = __builtin_amdgcn_sdot4((int)tt[b], (int)wq4, ai[4 * c + b], false); }
                }
                float acc[16];
#pragma unroll
                for (int i = 0; i < 16; ++i) acc[i] = (float)ai[i] * sw;
                float r8[8], r4[4];
#pragma unroll
                for (int m = 0; m < 8; ++m) { float a = acc[m], b = acc[m + 8]; swap32(a, b); r8[m] = a + b; }
#pragma unroll
                for (int n = 0; n < 4; ++n) { float a = r8[n], b = r8[n + 4]; asm volatile("v_nop\n\tv_nop\n\tv_permlane16_swap_b32 %0, %1" : "+v"(a), "+v"(b)); r4[n] = a + b; }
#pragma unroll
                for (int n = 0; n < 4; ++n) r4[n] += __builtin_bit_cast(float, __builtin_amdgcn_update_dpp(0, __builtin_bit_cast(int, r4[n]), 0x128, 0xF, 0xF, true));
                v2u xw; xw.x = pk2(bflo(xold.x) + r4[0], bfhi(xold.x) + r4[1]); xw.y = pk2(bflo(xold.y) + r4[2], bfhi(xold.y) + r4[3]);
                float ss = 0.f;
                if ((lane & 8) == 0) { const float x0 = bflo(xw.x), x1 = bfhi(xw.x), x2 = bflo(xw.y), x3 = bfhi(xw.y); ss = (x0 * x0 + x1 * x1) + (x2 * x2 + x3 * x3); *xp = xw; }
                ss = wave_allsum(ss);
                if (Q.SSQ) { if (lane == 0) Q.SSQ[t * 16 + s] = ss; }
            }
        }
}

struct Args { const float* in[33]; float* out; unsigned char* ws; int ph_lo, ph_hi; };
struct Frame { LAS unsigned char* lds; volatile LAS unsigned* MISC; gu32* ctl; int tid, lane, wave, G, vcu, xcc, xrank; };

__device__ __forceinline__ void transpose_item(const float* W, int ldw, int nsrc0, bf16* WT, int ldt, int rdst0, LAS float* scr, int kb, int nb, int lane, float scale, const float* kgain) {
    const int k0 = 64 * kb, n0 = 32 * nb;
#pragma unroll 8
    for (int i = 0; i < 32; ++i) { const int kk = 2 * i + (lane >> 5); const float gsc = kgain ? kgain[k0 + kk] * scale : scale; scr[kk * 33 + (lane & 31)] = W[(size_t)(k0 + kk) * ldw + nsrc0 + n0 + (lane & 31)] * gsc; }
    LDS_WAIT(); asm volatile("" ::: "memory");
    const int c = lane & 7;
#pragma unroll
    for (int j = 0; j < 4; ++j) { const int n = (lane >> 3) + 8 * j; const LAS float* s = scr + (8 * c) * 33 + n;
        v4u o; o.x = pk2(s[0 * 33], s[1 * 33]); o.y = pk2(s[2 * 33], s[3 * 33]); o.z = pk2(s[4 * 33], s[5 * 33]); o.w = pk2(s[6 * 33], s[7 * 33]);
        *(GAS v4u*)(WT + (size_t)(rdst0 + n0 + n) * ldt + k0 + 8 * c) = o; }
    LDS_WAIT(); asm volatile("" ::: "memory");
}
__device__ __forceinline__ void zero_rect(bf16* base, int ld, int row0, int nrows, int col0, int ncols, int gtid, int gthreads) {
    const int vpr = ncols / 8;
    for (int i = gtid; i < nrows * vpr; i += gthreads) { const int r = i / vpr, c = i % vpr; *(GAS v4u*)(base + (size_t)(row0 + r) * ld + col0 + 8 * c) = (v4u){0u, 0u, 0u, 0u}; }
}

__device__ __forceinline__ void p0_prologue(Frame& F, const Args& a) {
    LAS float* scr = (LAS float*)(F.lds + RING_OFF + F.wave * 16384);
    const int gw = blockIdx.x * NWAVES + F.wave, NGW = F.G * NWAVES;
    const int gtid = blockIdx.x * (NWAVES * 64) + F.tid, gthreads = F.G * NWAVES * 64;
    unsigned char* ws = a.ws;
    x0_phase((const GAS float*)a.in[0], (GAS bf16*)(ws + WS_XNB), (GAS float*)(ws + WS_SSQ), gw, NGW, F.lane);
    constexpr int I_IN = 16 * (INW / 32), I_SQ = 16 * 32, I_CKV = 16 * 64, I_UQ = 3 * 12, I_UKV = 2 * 16, I_L = I_IN + 4 * I_SQ + I_CKV + I_UQ + I_UKV;
    for (int it = gw; it < L * I_L; it += NGW) {
        const int l = it / I_L; int r = it % I_L;
        if (r < I_IN) {
            const int kb = r / 67, nb = r % 67; int src, dst; float sc = 1.f;
            if (nb < 6) { src = 32 * nb; dst = src; } else if (nb < 11) { src = 32 * nb; dst = src + 64; } else { src = 32 * nb; dst = src + 160; if (nb >= 43 && nb < 51) sc = 0.17677669529663687f * LOG2E; }
            transpose_item(a.in[5] + (size_t)l * D * INW, INW, src, (bf16*)(ws + WS_WIN) + (size_t)l * INP * D, D, dst, scr, kb, 0, F.lane, sc, a.in[4] + l * D); continue; } r -= I_IN;
        if (r < I_SQ) { transpose_item(a.in[21] + (size_t)l * D * D, D, 0, (bf16*)(ws + WS_WOUT) + (size_t)l * D * D, D, 0, scr, r / 32, r % 32, F.lane, 1.f, nullptr); continue; } r -= I_SQ;
        if (r < I_SQ) { transpose_item(a.in[24] + (size_t)l * D * D, D, 0, (bf16*)(ws + WS_WCQ) + (size_t)l * D * D, D, 0, scr, r / 32, r % 32, F.lane, 0.0625f * LOG2E, a.in[22] + l * D); continue; } r -= I_SQ;
        if (r < I_SQ) { transpose_item(a.in[26] + (size_t)l * D * D, D, 0, (bf16*)(ws + WS_WCO) + (size_t)l * D * D, D, 0, scr, r / 32, r % 32, F.lane, 1.f, nullptr); continue; } r -= I_SQ;
        if (r < I_SQ) { transpose_item(a.in[28] + (size_t)l * D * D, D, 0, (bf16*)(ws + WS_WPQ) + (size_t)l * D * D, D, 0, scr, r / 32, r % 32, F.lane, 1.f, a.in[27] + l * D); continue; } r -= I_SQ;
        if (r < I_CKV) { transpose_item(a.in[25] + (size_t)l * D * 2 * D, 2 * D, 0, (bf16*)(ws + WS_WCKV) + (size_t)l * 2 * D * D, D, 0, scr, r / 64, r % 64, F.lane, 1.f, nullptr); continue; } r -= I_CKV;
        if (r < I_UQ) { transpose_item(a.in[7] + (size_t)l * 192 * 384, 384, 0, (bf16*)(ws + WS_WUQ) + (size_t)l * 512 * 256, 256, 0, scr, r / 12, r % 12, F.lane, 0.10206207261596575f * LOG2E, a.in[6] + l * 192); continue; } r -= I_UQ;
        transpose_item(a.in[9] + (size_t)l * 128 * 512, 512, 0, (bf16*)(ws + WS_WUKV) + (size_t)l * 512 * 256, 256, 0, scr, r / 16, r % 16, F.lane, 1.f, a.in[8] + l * 128);
    }
    for (int l = 0; l < L; ++l) {
        bf16* win = (bf16*)(ws + WS_WIN) + (size_t)l * INP * D; bf16* wuq = (bf16*)(ws + WS_WUQ) + (size_t)l * 512 * 256; bf16* wukv = (bf16*)(ws + WS_WUKV) + (size_t)l * 512 * 256;
        zero_rect(win, D, 192, 64, 0, D, gtid, gthreads); zero_rect(win, D, 416, 96, 0, D, gtid, gthreads);
        zero_rect(wuq, 256, 0, 384, 192, 64, gtid, gthreads); zero_rect(wuq, 256, 384, 128, 0, 256, gtid, gthreads);
        zero_rect(wukv, 256, 0, 512, 128, 128, gtid, gthreads);
    }
    { float* rope = (float*)(ws + WS_ROPE); const int* pos = (const int*)a.in[2];
      for (int i = gtid; i < T * 16; i += gthreads) { const int t = i >> 4, k = i & 15; const float inv = powf(10000.f, -(float)(2 * k) / 32.f); const float ang = (float)pos[t] * inv;
          rope[(size_t)t * 32 + k] = cosf(ang); rope[(size_t)t * 32 + 16 + k] = sinf(ang); } }
    { const GAS f32x4* ks = (const GAS f32x4*)a.in[29]; GAS v2u* kd = (GAS v2u*)(ws + WS_KEYS);
      for (int i = gtid; i < L * 2 * 128 * 64 / 4; i += gthreads) { const f32x4 v = ks[i]; v2u w; w.x = pk2(v.x, v.y); w.y = pk2(v.z, v.w); kd[i] = w; }
    }
    for (int r = gw; r < 2 * L * 16384; r += NGW) { const int tb = r / (L * 16384), rr = r % (L * 16384);
        quant_row((const GAS float*)a.in[30 + tb] + (size_t)rr * 1024, (GAS unsigned*)(ws + (tb ? WS_V8 : WS_U8) + (size_t)rr * 1024), (GAS float*)(ws + (tb ? WS_SV : WS_SU)) + rr, 0, F.lane); }
    { float* btab = (float*)(ws + WS_BTAB); float* lams = (float*)(ws + WS_LAMS); float* spt = (float*)(ws + WS_SP);
      for (int i = gtid; i < 4 * 129; i += gthreads) { const int h = i / 129, n = i % 129; int bu; if (n < 16) bu = n; else { const int lg = 16 + (int)(logf((float)n / 16.f) / logf(8.f) * 16.f); bu = lg < 31 ? lg : 31; }
          btab[i] = a.in[3][bu * 4 + h] * LOG2E; }
      for (int i = gtid; i < L; i += gthreads) { const float* dl = a.in[17] + i * 128; float s1 = 0.f, s2 = 0.f; for (int j = 0; j < 32; ++j) { s1 += dl[j] * dl[32 + j]; s2 += dl[64 + j] * dl[96 + j]; }
          const float li = 0.8f - 0.6f * expf(-0.3f * (float)i); lams[2 * i] = expf(s1) - expf(s2) + li; lams[2 * i + 1] = li; }
      for (int i = gtid; i < L * 512; i += gthreads) spt[i] = log1pf(expf(-a.in[16][i])); }
    { GAS bf16* wat = (GAS bf16*)(ws + WS_WAT);
      for (int i = gtid; i < L * 8 * 2 * 4096; i += gthreads) { const int in_ = i & 63, out_ = (i >> 6) & 63, gate = (i >> 12) & 1, lg = i >> 13;
          wat[i] = (bf16)f2bf_(a.in[gate ? 14 : 12][(size_t)lg * 4096 + in_ * 64 + out_]); } }
    for (int l = 0; l < L; ++l) norm_phase((const GAS float*)a.in[1], (const GAS float*)a.in[23] + l * D, (GAS bf16*)(ws + WS_MNB) + (size_t)l * NB * MEM * D, NB * MEM, gw, NGW, F.lane);
}

constexpr int NPL = 16, PH_FINAL = 2 + NPL * L;
__global__ void __launch_bounds__(NWAVES * 64, 2) fwd(Args args) {
    extern __shared__ __attribute__((aligned(16))) unsigned char lds[];
    Frame F;
    F.lds = (LAS unsigned char*)lds; F.MISC = (volatile LAS unsigned*)(F.lds + MISC_OFF);
    F.tid = threadIdx.x; F.lane = F.tid & 63; F.wave = __builtin_amdgcn_readfirstlane(F.tid >> 6); F.G = gridDim.x;
    F.vcu = (F.G % 8 == 0) ? ((int)blockIdx.x % 8) * (F.G / 8) + (int)blockIdx.x / 8 : (int)blockIdx.x;
    unsigned char* ws = args.ws;
    F.ctl = (gu32*)(opq(ws) + WS_CTL);
    for (int u = F.tid; u < (LDS_BYTES - LDSCTL_OFF) / 4; u += NWAVES * 64) ((LAS unsigned*)(F.lds + LDSCTL_OFF))[u] = 0u;
    __syncthreads();
    XcdBarrier bar = xcd_barrier_post((unsigned*)(F.ctl + CW_BAR), F.MISC + 8);
    F.xcc = (int)bar.x;
    if (F.tid == 0) F.MISC[12] = __hip_atomic_fetch_add((unsigned*)(F.ctl + CW_RANK) + 64 * bar.x, 1u, __ATOMIC_RELAXED, __HIP_MEMORY_SCOPE_AGENT);
    __syncthreads();
    F.xrank = __builtin_amdgcn_readfirstlane((int)F.MISC[12]);
    const int lo = args.ph_lo, hi = args.ph_hi;
    const int gw = blockIdx.x * NWAVES + F.wave, NGW = F.G * NWAVES;
#define IN(k) (lo <= (k) && (k) < hi)
#define LANE_ (lane_id_v())
#define TID_ ((opqi(F.wave) << 6) | LANE_)
#define SITE() const int G_ = opqi(F.G), wv_ = opqi(F.wave), vcu_ = opqi(F.vcu), gw_ = opqi(gw), NGW_ = opqi(NGW); (void)G_; (void)wv_; (void)vcu_; (void)gw_; (void)NGW_
#if MK_DUP == 99
#define SEAM(k) do { if (IN(k) && IN((k) + 1)) { xcd_barrier(bar, (F.wave == 0 && lane_id_v() == 0) ? 1 : 0); xcd_barrier(bar, (F.wave == 0 && lane_id_v() == 0) ? 1 : 0); } } while (0)
#else
#define SEAM(k) do { if (IN(k) && IN((k) + 1)) xcd_barrier(bar, (F.wave == 0 && lane_id_v() == 0) ? 1 : 0); } while (0)
#endif
#define GEMM_SITE(EPI, Aptr, lda_, Bptr, ldb_, M_, N_, K_, cperm, ...) do { \
        pg8::Gemm g{opq(Aptr), opq(Bptr), M_, N_, K_, lda_, ldb_}; pg8::StaticOrder So; So.init(M_, N_, opqi(F.G), opqi(cperm)); pg8::EPI E{__VA_ARGS__}; \
        pg8::gemm_phase<pg8::EPI, pg8::StaticOrder, true, true>(F.lds + RING_OFF, g, So, E, opqi(F.wave)); } while (0)
    if (IN(0)) { p0_prologue(F, args); }
    SEAM(0);
    if (IN(1)) {
#pragma unroll 1
        for (int l = 0; l < L; ++l)
            GEMM_SITE(EpiBf16, (const GAS bf16*)(opq(ws) + WS_MNB) + (size_t)l * NB * MEM * D, D, (const GAS bf16*)(opq(ws) + WS_WCKV) + (size_t)l * 2 * D * D, D, NB * MEM, 2 * D, D, (int)((blockIdx.x + 64 * l) % F.G),
                      opq((GAS bf16*)(opq(ws) + WS_KVCB) + (size_t)l * NB * MEM * 2 * D), 2 * D, 2 * D, (const GAS float*)nullptr, 0);
    }
    SEAM(1);
    for (int l = 0; l < L; ++l) {
        const int pb = 2 + NPL * l;
        const GAS bf16* XNB = (const GAS bf16*)(opq(ws) + WS_XNB); const GAS bf16* YB = (const GAS bf16*)(opq(ws) + WS_YB); GAS bf16* PROJB = (GAS bf16*)(opq(ws) + WS_PROJB);
        if (IN(pb + 1)) GEMM_SITE(EpiBf16, XNB, D, (const GAS bf16*)(opq(ws) + WS_WIN) + (size_t)l * INP * D, D, T, INP, D, (int)blockIdx.x, opq(PROJB), INP, INP, opq((const GAS float*)(opq(ws) + WS_SSQ)), 8);
#if MK_DUP == 1
        if (IN(pb + 1)) GEMM_SITE(EpiBf16, XNB, D, (const GAS bf16*)(opq(ws) + WS_WIN) + (size_t)l * INP * D, D, T, INP, D, (int)blockIdx.x, opq(PROJB), INP, INP, opq((const GAS float*)(opq(ws) + WS_SSQ)), 8);
#endif
        SEAM(pb + 1);
        if (IN(pb + 2)) {
            SITE();
            pre_phase(opq((const GAS bf16*)PROJB), opq((const GAS float*)(opq(ws) + WS_ROPE)), opq((GAS float*)(opq(ws) + WS_RS)), opq((GAS bf16*)(opq(ws) + WS_KMB)), gw_, NGW_, LANE_);
#if MK_DUP == 21
            pre_phase(opq((const GAS bf16*)PROJB), opq((const GAS float*)(opq(ws) + WS_ROPE)), opq((GAS float*)(opq(ws) + WS_RS)), opq((GAS bf16*)(opq(ws) + WS_KMB)), gw_, NGW_, LANE_);
#endif
            LruP LP{opq((const GAS bf16*)PROJB), (const GAS float*)args.in[opqi(10)] + l * 4 * 512, (const GAS float*)args.in[opqi(11)] + l * 512, opq((const GAS bf16*)(opq(ws) + WS_WAT)) + (size_t)l * 8 * 2 * 4096, (const GAS float*)args.in[opqi(13)] + l * 512, (const GAS float*)args.in[opqi(15)] + l * 512,
                    (const GAS float*)(opq(ws) + WS_SP) + l * 512, opq((GAS unsigned*)(opq(ws) + WS_HLB)), opq((GAS float*)(opq(ws) + WS_LSUM))};
            lru_phase(LP, F.lds, TID_, wv_, LANE_, vcu_, G_);
#if MK_DUP == 2
            lru_phase(LP, F.lds, TID_, wv_, LANE_, vcu_, G_);
#endif
        }
        SEAM(pb + 2);
        if (IN(pb + 3)) {
            GEMM_SITE(EpiUp, (const GAS bf16*)PROJB + PC_CQ, INP, (const GAS bf16*)(opq(ws) + WS_WUQ) + (size_t)l * 512 * 256, 256, T, 512, 256, (int)blockIdx.x,
                      opq((GAS bf16*)(opq(ws) + WS_QMB)), (GAS bf16*)nullptr, 384, 384, opq((const GAS float*)(opq(ws) + WS_RS)), 0, 0);
            GEMM_SITE(EpiUp, (const GAS bf16*)PROJB + PC_CKV, INP, (const GAS bf16*)(opq(ws) + WS_WUKV) + (size_t)l * 512 * 256, 256, T, 512, 256, (int)blockIdx.x,
                      opq((GAS bf16*)(opq(ws) + WS_KMB)), opq((GAS bf16*)(opq(ws) + WS_VMB)), 0, 512, opq((const GAS float*)(opq(ws) + WS_RS)), 1, 1);
#if MK_DUP == 3
            GEMM_SITE(EpiUp, (const GAS bf16*)PROJB + PC_CQ, INP, (const GAS bf16*)(opq(ws) + WS_WUQ) + (size_t)l * 512 * 256, 256, T, 512, 256, (int)blockIdx.x,
                      opq((GAS bf16*)(opq(ws) + WS_QMB)), (GAS bf16*)nullptr, 384, 384, opq((const GAS float*)(opq(ws) + WS_RS)), 0, 0);
            GEMM_SITE(EpiUp, (const GAS bf16*)PROJB + PC_CKV, INP, (const GAS bf16*)(opq(ws) + WS_WUKV) + (size_t)l * 512 * 256, 256, T, 512, 256, (int)blockIdx.x,
                      opq((GAS bf16*)(opq(ws) + WS_KMB)), opq((GAS bf16*)(opq(ws) + WS_VMB)), 0, 512, opq((const GAS float*)(opq(ws) + WS_RS)), 1, 1);
#endif
        }
        SEAM(pb + 3);
        if (IN(pb + 4)) {
            SITE();
            AttnP PM{opq((const GAS bf16*)(opq(ws) + WS_QMB)), opq((const GAS bf16*)(opq(ws) + WS_KMB)), opq((const GAS bf16*)(opq(ws) + WS_VMB)), 384, 384, 256, opq((GAS bf16*)(opq(ws) + WS_OMB)), 256, opq((const GAS float*)(opq(ws) + WS_ROPE)), nullptr, nullptr, nullptr, nullptr};
            AttnP PD{opq((const GAS bf16*)PROJB + PC_QD), opq((const GAS bf16*)PROJB + PC_KD), opq((const GAS bf16*)PROJB + PC_VD), INP, INP, INP, opq((GAS bf16*)(opq(ws) + WS_YB) + 768), 1024, nullptr,
                     (const GAS int*)args.in[opqi(2)], (const GAS float*)(opq(ws) + WS_BTAB), (const GAS float*)args.in[opqi(18)] + l * 64, (const GAS float*)(opq(ws) + WS_LAMS) + 2 * l};
            attn_phase(PM, PD, F.lds, TID_, wv_, LANE_, vcu_, G_);
#if MK_DUP == 4
            __syncthreads(); attn_phase(PM, PD, F.lds, TID_, wv_, LANE_, vcu_, G_);
#elif MK_DUP == 40 || MK_DUP == 41
            __syncthreads(); attn_phase(PM, PD, F.lds, TID_, wv_, LANE_, vcu_, G_, MK_DUP - 40);
#endif
        }
        SEAM(pb + 4);
        if (IN(pb + 5)) {
            SITE();
            PostP PP{opq((const GAS bf16*)(opq(ws) + WS_OMB)), opq((const GAS unsigned*)(opq(ws) + WS_HLB)), opq((const GAS float*)(opq(ws) + WS_LSUM)), opq((const GAS bf16*)PROJB), (const GAS float*)args.in[opqi(19)] + l * 256, (const GAS float*)args.in[opqi(20)] + l * 512, opq((GAS bf16*)(opq(ws) + WS_YB))};
            post_phase(PP, F.lds, TID_, wv_, LANE_, vcu_, G_);
#if MK_DUP == 5
            __syncthreads(); post_phase(PP, F.lds, TID_, wv_, LANE_, vcu_, G_);
#endif
        }
        SEAM(pb + 5);
        if (IN(pb + 6)) GEMM_SITE(EpiRes, YB, D, (const GAS bf16*)(opq(ws) + WS_WOUT) + (size_t)l * D * D, D, T, D, D, (int)blockIdx.x, opq((GAS bf16*)(opq(ws) + WS_XNB)), opq((GAS float*)(opq(ws) + WS_SSQ)));
#if MK_DUP == 6
        if (IN(pb + 6)) GEMM_SITE(EpiRes, YB, D, (const GAS bf16*)(opq(ws) + WS_WOUT) + (size_t)l * D * D, D, T, D, D, (int)blockIdx.x, opq((GAS bf16*)(opq(ws) + WS_HLB)), opq((GAS float*)(opq(ws) + WS_OMB)));
#endif
        SEAM(pb + 6);
        if (IN(pb + 8)) GEMM_SITE(EpiBf16, XNB, D, (const GAS bf16*)(opq(ws) + WS_WCQ) + (size_t)l * D * D, D, T, D, D, (int)blockIdx.x, opq(PROJB), D, D, opq((const GAS float*)(opq(ws) + WS_SSQ)), 16);
#if MK_DUP == 8
        if (IN(pb + 8)) GEMM_SITE(EpiBf16, XNB, D, (const GAS bf16*)(opq(ws) + WS_WCQ) + (size_t)l * D * D, D, T, D, D, (int)blockIdx.x, opq(PROJB), D, D, opq((const GAS float*)(opq(ws) + WS_SSQ)), 16);
#endif
        SEAM(pb + 8);
        if (IN(pb + 9)) {
            SITE();
            const GAS bf16* kv = (const GAS bf16*)(opq(ws) + WS_KVCB) + (size_t)l * NB * MEM * 2 * D;
            AttnP PC{opq((const GAS bf16*)PROJB), opq(kv), opq(kv + D), 1024, 2 * D, 2 * D, opq((GAS bf16*)(opq(ws) + WS_YB)), 1024, nullptr, nullptr, nullptr, nullptr, nullptr};
            cross_phase(PC, F.lds, TID_, wv_, LANE_, vcu_, G_);
#if MK_DUP == 9
            cross_phase(PC, F.lds, TID_, wv_, LANE_, vcu_, G_);
#endif
        }
        SEAM(pb + 9);
        if (IN(pb + 10)) GEMM_SITE(EpiRes, YB, D, (const GAS bf16*)(opq(ws) + WS_WCO) + (size_t)l * D * D, D, T, D, D, (int)blockIdx.x, opq((GAS bf16*)(opq(ws) + WS_XNB)), opq((GAS float*)(opq(ws) + WS_SSQ)));
        SEAM(pb + 10);
        if (IN(pb + 12)) { GEMM_SITE(EpiBf16, XNB, D, (const GAS bf16*)(opq(ws) + WS_WPQ) + (size_t)l * D * D, D, T, D, D, (int)blockIdx.x, opq(PROJB), D, D, opq((const GAS float*)(opq(ws) + WS_SSQ)), 16);
            SITE(); hq_phase(opq(XNB), opq((const GAS float*)(opq(ws) + WS_SSQ)), (const GAS float*)args.in[opqi(27)] + l * D, opq((GAS unsigned char*)(opq(ws) + WS_HQ)), opq((GAS float*)(opq(ws) + WS_SH)), opq((GAS int*)(opq(ws) + WS_P)), gw_, NGW_, LANE_);
#if MK_DUP == 12
            hq_phase(opq(XNB), opq((const GAS float*)(opq(ws) + WS_SSQ)), (const GAS float*)args.in[opqi(27)] + l * D, opq((GAS unsigned char*)(opq(ws) + WS_HQ)), opq((GAS float*)(opq(ws) + WS_SH)), opq((GAS int*)(opq(ws) + WS_P)), gw_, NGW_, LANE_);
#endif
            }
        SEAM(pb + 12);
        if (IN(pb + 13)) {
            SITE();
            RouteP RP{opq((const GAS bf16*)PROJB), opq((const GAS bf16*)(opq(ws) + WS_KEYS) + (size_t)l * 2 * 128 * 64), opq((GAS int*)(opq(ws) + WS_EX)), opq((GAS float*)(opq(ws) + WS_GW))};
            route_phase(RP, F.lds, TID_, wv_, LANE_, vcu_, G_);
#if MK_DUP == 13
            route_phase(RP, F.lds, TID_, wv_, LANE_, vcu_, G_);
#endif
        }
        SEAM(pb + 13);
        if (IN(pb + 14)) {
            SITE();
            const PeerS ps = peer_sched((const GAS unsigned*)(F.ctl + CW_RANK), opqi(F.xcc), opqi(F.xrank));
            Peer1P Q1{opq((const GAS unsigned char*)(opq(ws) + WS_HQ)), opq((const GAS int*)(opq(ws) + WS_EX)), opq((const GAS unsigned char*)(opq(ws) + WS_U8) + (size_t)l * 16384 * 1024), opq((GAS int*)(opq(ws) + WS_P))};
            peer_k1(Q1, ps, wv_, LANE_);
#if MK_DUP == 141
            { Peer1P Q1b = Q1; Q1b.P = (GAS int*)(opq(ws) + WS_PROJB); peer_k1(Q1b, ps, wv_, LANE_); }
#endif
        }
        SEAM(pb + 14);
        if (IN(pb + 15)) {
            SITE();
            peer_w(opq((const GAS int*)(opq(ws) + WS_EX)), opq((const GAS float*)(opq(ws) + WS_GW)), opq((const GAS int*)(opq(ws) + WS_P)), opq((const GAS float*)(opq(ws) + WS_SH)), opq((const GAS float*)(opq(ws) + WS_SU) + l * 16384), opq((const GAS float*)(opq(ws) + WS_SV) + l * 16384),
                   opq((GAS signed char*)(opq(ws) + WS_W)), opq((GAS float*)(opq(ws) + WS_WS)), gw_, NGW_, LANE_);
            xcd_barrier(bar, (F.wave == 0 && lane_id_v() == 0) ? 1 : 0);
            const PeerS ps = peer_sched((const GAS unsigned*)(F.ctl + CW_RANK), opqi(F.xcc), opqi(F.xrank));
            Peer2P Q2{opq((const GAS int*)(opq(ws) + WS_EX)), opq((const GAS signed char*)(opq(ws) + WS_W)), opq((const GAS float*)(opq(ws) + WS_WS)), opq((const GAS unsigned char*)(opq(ws) + WS_V8) + (size_t)l * 16384 * 1024), opq((GAS bf16*)(opq(ws) + WS_XNB)), opq((GAS float*)(opq(ws) + WS_SSQ))};
            peer_k2(Q2, ps, wv_, LANE_);
#if MK_DUP == 151
            { Peer2P Q2b = Q2; Q2b.XB = (GAS bf16*)(opq(ws) + WS_HLB); Q2b.SSQ = (GAS float*)(opq(ws) + WS_OMB); peer_k2(Q2b, ps, wv_, LANE_); }
#endif
        }
        SEAM(pb + 15);
    }
    if (IN(PH_FINAL)) { SITE(); final_norm_phase(opq((const GAS bf16*)(opq(ws) + WS_XNB)), (GAS float*)args.out, (const GAS float*)args.in[opqi(32)], T, gw_, NGW_, LANE_); }
#undef IN
#undef SEAM
#undef GEMM_SITE
}
}
extern "C" void kernel_launch(void* const* d_in, const int* in_sizes, int n_in, void* d_out, int out_size, void* d_ws, size_t ws_size, hipStream_t stream) {
    (void)in_sizes; (void)out_size;
    static int grid = 0;
    if (grid == 0) {
        int dev = 0, cus = 0, per_cu = 0;
        if (n_in != 33 || ws_size < mk::WS_END) { fprintf(stderr, "kernel_launch: unexpected n_in %d / ws_size %zu\n", n_in, ws_size); grid = -1; return; }
        if (hipGetDevice(&dev) != hipSuccess || hipDeviceGetAttribute(&cus, hipDeviceAttributeMultiprocessorCount, dev) != hipSuccess) { grid = -1; return; }
        if (hipFuncSetAttribute((const void*)mk::fwd, hipFuncAttributeMaxDynamicSharedMemorySize, mk::LDS_BYTES) != hipSuccess) { fprintf(stderr, "kernel_launch: hipFuncSetAttribute failed\n"); grid = -1; return; }
        if (hipOccupancyMaxActiveBlocksPerMultiprocessor(&per_cu, (const void*)mk::fwd, mk::NWAVES * 64, mk::LDS_BYTES) != hipSuccess || per_cu < 1) fprintf(stderr, "kernel_launch: occupancy query says %d\n", per_cu);
        (void)hipGetLastError();
        grid = cus;
    }
    if (grid < 0) return;
    unsigned char* ws = (unsigned char*)d_ws;
    (void)hipMemsetAsync(ws + mk::WS_CTL, 0, mk::CTL_ZERO_BYTES, stream);
    mk::Args a{};
    for (int i = 0; i < 33; ++i) a.in[i] = (const float*)d_in[i];
    a.out = (float*)d_out; a.ws = ws;
    auto run = [&](int lo, int hi) { a.ph_lo = lo; a.ph_hi = hi; hipLaunchKernelGGL(mk::fwd, dim3(grid), dim3(mk::NWAVES * 64), mk::LDS_BYTES, stream, a); };
#if MK_ONE_LAUNCH
    run(0, mk::PH_FINAL + 1);
#else
    for (int p = 0; p <= mk::PH_FINAL; ++p) {
        const int k = (p - 2) % mk::NPL, l = (p - 2) / mk::NPL;
#if MK_NAIVE_PEER == 2
        if (p >= 2 && p < mk::PH_FINAL && k == 14) {
            hipLaunchKernelGGL(k_peer, dim3(T), dim3(256), 0, stream, (const bf16_t*)(ws + mk::WS_XNB), (const int*)(ws + mk::WS_EX), (const float*)(ws + mk::WS_GW), (const float*)d_in[30] + (size_t)l * NEXP * D, (const float*)d_in[31] + (size_t)l * NEXP * D, (float*)d_out);
            continue; }
#elif MK_NAIVE_PEER == 1
        if (p >= 2 && p < mk::PH_FINAL && k == 13) {
            float* TQ = (float*)(ws + (size_t)806 * mk::MiB);
            hipLaunchKernelGGL(k_bf2f, dim3((unsigned)(((size_t)T * D + 255) / 256)), dim3(256), 0, stream, (const bf16_t*)(ws + mk::WS_PROJB), TQ, (long)T * D);
            hipLaunchKernelGGL(k_route, dim3(T), dim3(256), 0, stream, TQ, (const float*)d_in[29] + (size_t)l * 2 * 128 * 64, (int*)(ws + mk::WS_EX), (float*)(ws + mk::WS_GW));
            hipLaunchKernelGGL(k_peer, dim3(T), dim3(256), 0, stream, (const bf16_t*)(ws + mk::WS_XNB), (const int*)(ws + mk::WS_EX), (const float*)(ws + mk::WS_GW), (const float*)d_in[30] + (size_t)l * NEXP * D, (const float*)d_in[31] + (size_t)l * NEXP * D, (float*)d_out);
            continue; }
        if (p >= 2 && p < mk::PH_FINAL && k == 14) continue;
#endif
        run(p, p + 1); }
#endif
}
```

```cpp
#include <hip/hip_runtime.h>
#include <cstdint>
#include <cstdio>
#include <cmath>

#ifndef MK_ONE_LAUNCH
#define MK_ONE_LAUNCH 1
#endif
#ifndef MK_DUP
#define MK_DUP 0
#endif
#ifndef MK_NAIVE_PEER
#define MK_NAIVE_PEER 0
#endif
namespace pg8 {
#define PG8_LAS __attribute__((address_space(3)))
#ifndef GAS
#define GAS __attribute__((address_space(1)))
#endif
typedef unsigned short bf16_t;
typedef short bf16x8 __attribute__((ext_vector_type(8)));
typedef float f32x4 __attribute__((ext_vector_type(4)));
typedef unsigned u32x4 __attribute__((ext_vector_type(4)));
typedef unsigned u32x2 __attribute__((ext_vector_type(2)));
constexpr int BM = 256, BK = 64, HALF = 128, HTB = HALF * BK * 2, STAGE_BYTES = 8 * HTB, NXCD = 8, WGM = 8;
__host__ __device__ __forceinline__ int lds_byte(int r, int c) { const int st = (r >> 4) * 2 + (c >> 5), rr = r & 15, cc = c & 31, ob = rr * 64 + cc * 2; return st * 1024 + (ob ^ (((ob >> 9) & 1) << 5)); }
__host__ __device__ __forceinline__ void stage_rc(int b, int& R, int& C) { const int st = b / 1024, sb = b % 1024, swz = sb ^ (((sb >> 9) & 1) << 5); R = (st >> 1) * 16 + swz / 64; C = (st & 1) * 32 + (swz % 64) / 2; }
__host__ __device__ __forceinline__ int perm32(int rho) { const int n = rho >> 4, i = rho & 15; return 8 * (i >> 2) + 4 * n + (i & 3); }
__device__ __forceinline__ int pg8_lane_id() { int l; asm volatile("v_mbcnt_lo_u32_b32 %0, -1, 0\n\tv_mbcnt_hi_u32_b32 %0, -1, %0" : "=v"(l)); return l; }
struct Unit { int pm, pn; };
struct Gemm { const GAS bf16_t* A; const GAS bf16_t* Bt; int M, N, K, lda, ldb; };
struct StaticOrder {
    int nM, nN, nwg, G, c;
    __host__ __device__ void init(int M, int N, int G_, int c_) { nM = M / BM; nN = N / BM; nwg = nM * nN; G = G_; c = c_; }
    __host__ __device__ bool next(int i, Unit& u) const {
        const long L = (long)i * G + c; if (L >= nwg) return false;
        int wgid = (int)L; { const int q = nwg / NXCD, r = nwg % NXCD, xcd = wgid % NXCD, off = wgid / NXCD; wgid = (xcd < r ? xcd * (q + 1) : r * (q + 1) + (xcd - r) * q) + off; }
        const int nig = WGM * nN, gid = wgid / nig, fm = gid * WGM, gsz = (nM - fm) < WGM ? (nM - fm) : WGM;
        u.pm = fm + ((wgid % nig) % gsz); u.pn = (wgid % nig) / gsz; return true;
    }
    __device__ __forceinline__ void a_ready(const Unit&) const {}
    __device__ __forceinline__ void done(const Unit&) const {}
};
__device__ __forceinline__ unsigned cvt_pk_bf16(float lo, float hi) { unsigned r; asm volatile("v_cvt_pk_bf16_f32 %0, %1, %2" : "=v"(r) : "v"(lo), "v"(hi)); return r; }

struct EpiF32 {
    static constexpr bool PERM = false, AFTER_DRAIN = false;
    GAS float* C; int ldc; int nvalid; int accum;
    __device__ __forceinline__ void operator()(const f32x4 (&acc)[2][2][4][2], const Unit& u, int wr, int wc, int fr, int fq) const {
        { const int l_ = pg8_lane_id(); fr = l_ & 15; fq = l_ >> 4; }
#pragma unroll
        for (int ai = 0; ai < 2; ++ai)
#pragma unroll
            for (int m = 0; m < 4; ++m) { const size_t row = (size_t)u.pm * BM + ai * HALF + wr * 64 + m * 16 + fr;
#pragma unroll
                for (int bj = 0; bj < 2; ++bj)
#pragma unroll
                    for (int n = 0; n < 2; ++n) { const int col = u.pn * BM + bj * HALF + wc * 32 + n * 16 + 4 * fq;
                        if (col < nvalid) { GAS float* p = C + row * ldc + col; f32x4 v = acc[ai][bj][m][n]; if (accum) v += *(const GAS f32x4*)p; *(GAS f32x4*)p = v; } } }
    }
};
struct EpiBf16 {
    static constexpr bool PERM = true, AFTER_DRAIN = false;
    GAS bf16_t* O; int ldc; int nvalid; const GAS float* ssq; int np;
    __device__ __forceinline__ void operator()(const f32x4 (&acc)[2][2][4][2], const Unit& u, int wr, int wc, int fr, int fq) const {
        { const int l_ = pg8_lane_id(); fr = l_ & 15; fq = l_ >> 4; }
#pragma unroll
        for (int ai = 0; ai < 2; ++ai)
#pragma unroll
            for (int m = 0; m < 4; ++m) { const size_t row = (size_t)u.pm * BM + ai * HALF + wr * 64 + m * 16 + fr;
                float rs_ = 1.f;
                if (np > 0) { const GAS f32x4* sp = (const GAS f32x4*)(ssq + row * 16); f32x4 t = sp[0] + sp[1]; if (np > 8) t += sp[2] + sp[3]; rs_ = __builtin_amdgcn_rsqf(((t[0] + t[1]) + (t[2] + t[3])) * (1.f / 1024.f) + 1e-6f); }
#pragma unroll
                for (int bj = 0; bj < 2; ++bj) { const int col = u.pn * BM + bj * HALF + wc * 32 + 8 * fq;
                    if (col < nvalid) { const f32x4 v0 = acc[ai][bj][m][0] * rs_, v1 = acc[ai][bj][m][1] * rs_; u32x4 w; w.x = cvt_pk_bf16(v0[0], v0[1]); w.y = cvt_pk_bf16(v0[2], v0[3]); w.z = cvt_pk_bf16(v1[0], v1[1]); w.w = cvt_pk_bf16(v1[2], v1[3]);
                        *(GAS u32x4*)(O + row * ldc + col) = w; } } }
    }
};
struct EpiUp {
    static constexpr bool PERM = true, AFTER_DRAIN = false;
    GAS bf16_t* O; GAS bf16_t* O2; int ldc; int nvalid; const GAS float* rs; int rsi; int mode;
    __device__ __forceinline__ void operator()(const f32x4 (&acc)[2][2][4][2], const Unit& u, int wr, int wc, int fr, int fq) const {
        { const int l_ = pg8_lane_id(); fr = l_ & 15; fq = l_ >> 4; }
#pragma unroll
        for (int ai = 0; ai < 2; ++ai)
#pragma unroll
            for (int m = 0; m < 4; ++m) { const size_t row = (size_t)u.pm * BM + ai * HALF + wr * 64 + m * 16 + fr; const float s = rs[2 * row + rsi];
#pragma unroll
                for (int bj = 0; bj < 2; ++bj) { const int col = u.pn * BM + bj * HALF + wc * 32 + 8 * fq;
                    if (col < nvalid) { const f32x4 v0 = acc[ai][bj][m][0] * s, v1 = acc[ai][bj][m][1] * s; u32x4 w; w.x = cvt_pk_bf16(v0[0], v0[1]); w.y = cvt_pk_bf16(v0[2], v0[3]); w.z = cvt_pk_bf16(v1[0], v1[1]); w.w = cvt_pk_bf16(v1[2], v1[3]);
                        GAS bf16_t* dst;
                        if (mode == 0) dst = O + row * ldc + col;
                        else { const int h = col >> 7, j = col & 127; dst = (j < 64) ? O + row * 384 + h * 96 + j : O2 + row * 256 + h * 64 + (j - 64); }
                        *(GAS u32x4*)dst = w; } } }
    }
};

struct EpiRes {
    static constexpr bool PERM = true, AFTER_DRAIN = false;
    GAS bf16_t* XB; GAS float* SSQ;
    __device__ __forceinline__ void operator()(const f32x4 (&acc)[2][2][4][2], const Unit& u, int wr, int wc, int fr, int fq) const {
        { const int l_ = pg8_lane_id(); fr = l_ & 15; fq = l_ >> 4; }
#pragma unroll
        for (int ai = 0; ai < 2; ++ai)
#pragma unroll
            for (int m = 0; m < 4; ++m) { const size_t row = (size_t)u.pm * BM + ai * HALF + wr * 64 + m * 16 + fr; float ss = 0.f;
#pragma unroll
                for (int bj = 0; bj < 2; ++bj) { GAS u32x4* p = (GAS u32x4*)(XB + row * 1024 + u.pn * BM + bj * HALF + wc * 32 + 8 * fq);
                    const u32x4 o = *p; const f32x4 v0 = acc[ai][bj][m][0], v1 = acc[ai][bj][m][1];
                    u32x4 w;
                    w.x = cvt_pk_bf16(__builtin_bit_cast(float, o.x << 16) + v0[0], __builtin_bit_cast(float, o.x & 0xffff0000u) + v0[1]);
                    w.y = cvt_pk_bf16(__builtin_bit_cast(float, o.y << 16) + v0[2], __builtin_bit_cast(float, o.y & 0xffff0000u) + v0[3]);
                    w.z = cvt_pk_bf16(__builtin_bit_cast(float, o.z << 16) + v1[0], __builtin_bit_cast(float, o.z & 0xffff0000u) + v1[1]);
                    w.w = cvt_pk_bf16(__builtin_bit_cast(float, o.w << 16) + v1[2], __builtin_bit_cast(float, o.w & 0xffff0000u) + v1[3]);
                    *p = w;
#pragma unroll
                    for (int e = 0; e < 4; ++e) { const float a = __builtin_bit_cast(float, w[e] << 16), b = __builtin_bit_cast(float, w[e] & 0xffff0000u); ss += a * a + b * b; } }
                { float a = ss, b = ss; asm volatile("v_nop\n\tv_nop\n\tv_permlane16_swap_b32 %0, %1" : "+v"(a), "+v"(b)); ss = a + b; }
                { float a = ss, b = ss; asm volatile("v_nop\n\tv_nop\n\tv_permlane32_swap_b32 %0, %1" : "+v"(a), "+v"(b)); ss = a + b; }
                if (fq == 0) SSQ[row * 16 + 4 * u.pn + wc] = ss; }
    }
};
template <class Epi, class Sched, bool ALIGN_EPI = false, bool SP2 = false>
__device__ __forceinline__ void gemm_phase(PG8_LAS unsigned char* lds, const Gemm g, const Sched& S, const Epi& E, int wave_id) {
    int tid_ = (wave_id << 6) | pg8_lane_id(); asm volatile("" : "+v"(tid_));
    const int tid = tid_, wid = __builtin_amdgcn_readfirstlane(tid >> 6), lane = tid & 63, wr = wid >> 2, wc = wid & 3, fr = lane & 15, fq = lane >> 4;
    const int K = g.K, nt = K / BK;
    unsigned voffA[2], voffB[2];
#pragma unroll
    for (int i = 0; i < 2; ++i) { int R, C; stage_rc(tid * 16 + i * 8192, R, C); const int Rb = Epi::PERM ? ((R & ~31) + perm32(R & 31)) : R;
        voffA[i] = (unsigned)(R * g.lda + C) * 2u; voffB[i] = (unsigned)(Rb * g.ldb + C) * 2u; }
    const size_t kstep = (size_t)(BK * 2);
    const size_t hstepA = (size_t)HALF * g.lda * 2, hstepB = (size_t)HALF * g.ldb * 2;
    const size_t tstepA = 2 * hstepA, tstepB = 2 * hstepB;
    const unsigned ldsw = (unsigned)wid * 1024u;
    const int aoff = lds_byte(wr * 64 + fr, fq * 8), boff = lds_byte(wc * 32 + fr, fq * 8);
#define PG8_SA(b, h) (((b) * 2 + (h)) * HTB)
#define PG8_SB(b, h) ((4 + (b) * 2 + (h)) * HTB)
#define PG8_STAGE(bufoff, gbase, voff) do { _Pragma("unroll") for (int _i = 0; _i < 2; ++_i) \
        __builtin_amdgcn_global_load_lds((const unsigned*)((const char*)(gbase) + (voff)[_i]), (PG8_LAS unsigned*)(lds + (bufoff) + ldsw + _i * 8192), 16, 0, 0); } while (0)
#define PG8_LDA(dst, b, h) do { _Pragma("unroll") for (int m = 0; m < 4; ++m) _Pragma("unroll") for (int k = 0; k < 2; ++k) dst[m][k] = *(const PG8_LAS bf16x8*)(lds + PG8_SA(b, h) + aoff + m * 2048 + k * 1024); } while (0)
#define PG8_LDB(dst, b, h) do { _Pragma("unroll") for (int n = 0; n < 2; ++n) _Pragma("unroll") for (int k = 0; k < 2; ++k) dst[n][k] = *(const PG8_LAS bf16x8*)(lds + PG8_SB(b, h) + boff + n * 2048 + k * 1024); } while (0)
#define PG8_MMA(ai, bj, At, Bt) do { __builtin_amdgcn_s_setprio(1); _Pragma("unroll") for (int m = 0; m < 4; ++m) _Pragma("unroll") for (int n = 0; n < 2; ++n) _Pragma("unroll") for (int k = 0; k < 2; ++k) \
        acc[ai][bj][m][n] = __builtin_amdgcn_mfma_f32_16x16x32_bf16(Bt[n][k], At[m][k], acc[ai][bj][m][n], 0, 0, 0); __builtin_amdgcn_s_setprio(0); } while (0)
#define PG8_WAIT_V(n) asm volatile("s_waitcnt vmcnt(" #n ")" ::: "memory")
#define PG8_WAIT_L(n) asm volatile("s_waitcnt lgkmcnt(" #n ")" ::: "memory")
#define PG8_BAR __builtin_amdgcn_s_barrier()
#define PG8_SCHED __builtin_amdgcn_sched_barrier(0)
    Unit cur, nxt; int ui = 0;
    if (!S.next(0, cur)) return;
    f32x4 acc[2][2][4][2];
#pragma unroll
    for (int a = 0; a < 2; ++a)
#pragma unroll
        for (int b = 0; b < 2; ++b)
#pragma unroll
            for (int m = 0; m < 4; ++m)
#pragma unroll
                for (int n = 0; n < 2; ++n) acc[a][b][m][n] = (f32x4){0.f, 0.f, 0.f, 0.f};
    bf16x8 At[4][2], B0[2][2], B1[2][2];
    const char* cA = (const char*)g.A + (size_t)cur.pm * tstepA; const char* cB = (const char*)g.Bt + (size_t)cur.pn * tstepB;
    S.a_ready(cur);
    if constexpr (SP2) {
        PG8_STAGE(PG8_SB(0, 0), cB, voffB); PG8_STAGE(PG8_SB(0, 1), cB + hstepB, voffB); PG8_STAGE(PG8_SA(0, 0), cA, voffA); PG8_STAGE(PG8_SA(0, 1), cA + hstepA, voffA);
        if (wr == 1) PG8_BAR;
        PG8_WAIT_V(2); PG8_BAR;
        PG8_STAGE(PG8_SB(1, 0), cB + kstep, voffB); PG8_STAGE(PG8_SA(1, 0), cA + kstep, voffA); PG8_STAGE(PG8_SB(1, 1), cB + hstepB + kstep, voffB);
        PG8_WAIT_V(6); PG8_BAR;
    } else {
        PG8_STAGE(PG8_SB(0, 0), cB, voffB); PG8_STAGE(PG8_SA(0, 0), cA, voffA); PG8_STAGE(PG8_SB(0, 1), cB + hstepB, voffB); PG8_STAGE(PG8_SA(0, 1), cA + hstepA, voffA);
        if (wr == 1) PG8_BAR;
        PG8_WAIT_V(4); PG8_BAR;
        PG8_STAGE(PG8_SB(1, 0), cB + kstep, voffB); PG8_STAGE(PG8_SA(1, 0), cA + kstep, voffA); PG8_STAGE(PG8_SB(1, 1), cB + hstepB + kstep, voffB);
        PG8_WAIT_V(6); PG8_BAR;
    }
    for (;;) {
        const bool has_next = S.next(ui + 1, nxt);
        const char* nA = has_next ? (const char*)g.A + (size_t)nxt.pm * tstepA : cA; const char* nB = has_next ? (const char*)g.Bt + (size_t)nxt.pn * tstepB : cB;
        for (int t = 0; t < nt; t += 2) {
            const bool last = (t == nt - 2);
            const char* a1 = cA + (size_t)(t + 1) * kstep;
            const char* a2 = last ? nA : cA + (size_t)(t + 2) * kstep; const char* b2 = last ? nB : cB + (size_t)(t + 2) * kstep;
            const char* a3 = a2 + kstep; const char* b3 = b2 + kstep;
            if (last && has_next) S.a_ready(nxt);
            if constexpr (SP2) {
            PG8_LDB(B0, 0, 0); PG8_LDB(B1, 0, 1); PG8_SCHED; PG8_LDA(At, 0, 0); PG8_STAGE(PG8_SA(1, 1), a1 + hstepA, voffA);
            PG8_WAIT_V(8); PG8_WAIT_L(0); PG8_BAR; PG8_MMA(0, 0, At, B0); PG8_MMA(0, 1, At, B1); PG8_BAR; PG8_SCHED;
            PG8_LDA(At, 0, 1); PG8_STAGE(PG8_SB(0, 0), b2, voffB); PG8_STAGE(PG8_SB(0, 1), b2 + hstepB, voffB); PG8_STAGE(PG8_SA(0, 0), a2, voffA);
            PG8_WAIT_V(8); PG8_WAIT_L(0); PG8_BAR; PG8_MMA(1, 0, At, B0); PG8_MMA(1, 1, At, B1); PG8_BAR; PG8_SCHED;
            PG8_LDB(B0, 1, 0); PG8_LDB(B1, 1, 1); PG8_SCHED; PG8_LDA(At, 1, 0); PG8_STAGE(PG8_SA(0, 1), a2 + hstepA, voffA);
            PG8_WAIT_V(8); PG8_WAIT_L(0); PG8_BAR; PG8_MMA(0, 0, At, B0); PG8_MMA(0, 1, At, B1); PG8_BAR; PG8_SCHED;
            PG8_LDA(At, 1, 1); PG8_STAGE(PG8_SB(1, 0), b3, voffB); PG8_STAGE(PG8_SB(1, 1), b3 + hstepB, voffB); PG8_STAGE(PG8_SA(1, 0), a3, voffA);
            PG8_WAIT_V(8); PG8_WAIT_L(0); PG8_BAR; PG8_MMA(1, 0, At, B0); PG8_MMA(1, 1, At, B1); PG8_BAR; PG8_SCHED;
            } else {
            PG8_LDB(B0, 0, 0); PG8_SCHED; PG8_LDA(At, 0, 0); PG8_STAGE(PG8_SA(1, 1), a1 + hstepA, voffA);
            PG8_WAIT_L(8); PG8_BAR; PG8_WAIT_L(0); PG8_MMA(0, 0, At, B0); PG8_BAR; PG8_SCHED;
            PG8_LDB(B1, 0, 1); PG8_STAGE(PG8_SB(0, 0), b2, voffB);
            PG8_BAR; PG8_WAIT_L(0); PG8_MMA(0, 1, At, B1); PG8_BAR;
            PG8_LDA(At, 0, 1); PG8_STAGE(PG8_SA(0, 0), a2, voffA);
            PG8_BAR; PG8_WAIT_L(0); PG8_MMA(1, 0, At, B0); PG8_BAR; PG8_SCHED;
            PG8_STAGE(PG8_SB(0, 1), b2 + hstepB, voffB);
            PG8_WAIT_V(6); PG8_BAR; PG8_MMA(1, 1, At, B1); PG8_BAR;
            PG8_LDB(B0, 1, 0); PG8_SCHED; PG8_LDA(At, 1, 0); PG8_STAGE(PG8_SA(0, 1), a2 + hstepA, voffA);
            PG8_WAIT_L(8); PG8_BAR; PG8_WAIT_L(0); PG8_MMA(0, 0, At, B0); PG8_BAR; PG8_SCHED;
            PG8_LDB(B1, 1, 1); PG8_STAGE(PG8_SB(1, 0), b3, voffB);
            PG8_BAR; PG8_WAIT_L(0); PG8_MMA(0, 1, At, B1); PG8_BAR;
            PG8_LDA(At, 1, 1); PG8_STAGE(PG8_SA(1, 0), a3, voffA);
            PG8_BAR; PG8_WAIT_L(0); PG8_MMA(1, 0, At, B0); PG8_BAR; PG8_SCHED;
            PG8_STAGE(PG8_SB(1, 1), b3 + hstepB, voffB);
            PG8_WAIT_V(6); PG8_BAR; PG8_MMA(1, 1, At, B1); PG8_BAR;
            }
        }
        if constexpr (ALIGN_EPI) { if (wr == 0) PG8_BAR; }
        if constexpr (!Epi::AFTER_DRAIN) { E(acc, cur, wr, wc, fr, fq); S.done(cur); }
        if (!has_next) break;
#pragma unroll
        for (int a = 0; a < 2; ++a)
#pragma unroll
            for (int b = 0; b < 2; ++b)
#pragma unroll
                for (int m = 0; m < 4; ++m)
#pragma unroll
                    for (int n = 0; n < 2; ++n) acc[a][b][m][n] = (f32x4){0.f, 0.f, 0.f, 0.f};
        cur = nxt; cA = nA; cB = nB; ++ui;
        if constexpr (ALIGN_EPI) { if (wr == 1) PG8_BAR; }
    }
    PG8_WAIT_V(0);
    if constexpr (!ALIGN_EPI) { if (wr == 0) PG8_BAR; }
    PG8_BAR;
    if constexpr (Epi::AFTER_DRAIN) { E.fused(acc, cur, wr, wc, fr, fq, lds, wid, lane); S.done(cur); }
#undef PG8_SA
#undef PG8_SB
#undef PG8_STAGE
#undef PG8_LDA
#undef PG8_LDB
#undef PG8_MMA
#undef PG8_WAIT_V
#undef PG8_WAIT_L
#undef PG8_BAR
#undef PG8_SCHED
}
}

namespace mk {
#ifndef GAS
#define GAS __attribute__((address_space(1)))
#endif
#define LAS __attribute__((address_space(3)))
typedef unsigned short bf16;
typedef unsigned v4u __attribute__((ext_vector_type(4)));
typedef unsigned v2u __attribute__((ext_vector_type(2)));
typedef float f32x4 __attribute__((ext_vector_type(4)));
typedef GAS unsigned gu32;
#define LDS_WAIT() asm volatile("s_waitcnt lgkmcnt(0)" ::: "memory")
#define VM_WAIT() asm volatile("s_waitcnt vmcnt(0)" ::: "memory")
__device__ __forceinline__ unsigned f2bf_(float f) { unsigned u = __builtin_bit_cast(unsigned, f); return (u + 0x7fffu + ((u >> 16) & 1u)) >> 16; }
__device__ __forceinline__ unsigned pk2(float lo, float hi) { return f2bf_(lo) | (f2bf_(hi) << 16); }
__device__ __forceinline__ float bflo(unsigned w) { return __builtin_bit_cast(float, w << 16); }
__device__ __forceinline__ float bfhi(unsigned w) { return __builtin_bit_cast(float, w & 0xffff0000u); }

template <class P> __device__ __forceinline__ P* opq(P* p) { asm volatile("" : "+s"(p)); return p; }
__device__ __forceinline__ int opqi(int k) { asm volatile("" : "+s"(k)); return k; }
__device__ __forceinline__ float shx(float v, int o, int lane) { return __builtin_bit_cast(float, __builtin_amdgcn_ds_bpermute((lane ^ o) << 2, __builtin_bit_cast(int, v))); }
__device__ __forceinline__ int shxi(int v, int o, int lane) { return __builtin_amdgcn_ds_bpermute((lane ^ o) << 2, v); }
__device__ __forceinline__ int lane_id_v() { int l; asm volatile("v_mbcnt_lo_u32_b32 %0, -1, 0\n\tv_mbcnt_hi_u32_b32 %0, -1, %0" : "=v"(l)); return l; }
constexpr int NWAVES = 8;
constexpr int D = 1024, NB = 4, S = 8192, T = NB * S, L = 4, MEM = 256, INW = 2144, INP = 2304;
constexpr int PC_CQ = 0, PC_CKV = 256, PC_KR = 384, PC_XL = 512, PC_GL = 1024, PC_QD = 1536, PC_KD = 1792, PC_VD = 2048;
constexpr float LOG2E = 1.4426950408889634f;
constexpr size_t MiB = 1u << 20;
constexpr size_t WS_CTL = 0, CTL_ZERO_BYTES = 1 * MiB;
constexpr size_t WS_WIN = 1 * MiB, WS_WOUT = 19 * MiB, WS_WCQ = 27 * MiB, WS_WCO = 35 * MiB, WS_WPQ = 43 * MiB, WS_WCKV = 51 * MiB, WS_WUQ = 67 * MiB, WS_WUKV = 68 * MiB, WS_KEYS = 69 * MiB, WS_ROPE = 70 * MiB;
constexpr size_t WS_XNB = 76 * MiB, WS_YB = 140 * MiB, WS_PROJB = 204 * MiB, WS_QMB = 348 * MiB, WS_KMB = 372 * MiB, WS_VMB = 396 * MiB, WS_RS = 412 * MiB;
constexpr size_t WS_HLB = 413 * MiB, WS_ACB = 445 * MiB, WS_LSUM = 477 * MiB, WS_OMB = 478 * MiB, WS_MNB = 494 * MiB, WS_KVCB = 502 * MiB, WS_EX = 518 * MiB, WS_GW = 534 * MiB;
constexpr size_t WS_U8 = 550 * MiB, WS_V8 = 614 * MiB, WS_SU = 678 * MiB, WS_SV = 679 * MiB;
constexpr size_t WS_HQ = 680 * MiB, WS_P = 712 * MiB, WS_SH = 728 * MiB, WS_W = 729 * MiB, WS_WS = 745 * MiB, WS_SSQ = 746 * MiB, WS_END = 748 * MiB;
constexpr size_t WS_WAT = 74 * MiB;
constexpr size_t WS_BTAB = WS_KEYS + 512 * 1024, WS_LAMS = WS_BTAB + 4096, WS_SP = WS_LAMS + 4096;
constexpr int CW_BAR = 4096, CW_RANK = 8192;
constexpr int RING_OFF = 0, RING_BYTES = 155648, LDSCTL_OFF = RING_BYTES, MISC_OFF = LDSCTL_OFF + 320, LDS_BYTES = 163840;

#define XB_TMO      128
#define XB_XCNT(j)  (256  + 64 * (j))
#define XB_XSUB(j)  (1280 + 64 * (j))
#define XB_XGEN(j)  (2304 + 64 * (j))
#define XB_TOP      3328
#define XB_TOPGEN   3392
#define XCD_BAR_WORDS 3456
#define XB_SPIN_CAP (1u << 18)

__device__ __forceinline__ unsigned xb_ld(unsigned* p)              { return __hip_atomic_load(p, __ATOMIC_RELAXED, __HIP_MEMORY_SCOPE_AGENT); }
__device__ __forceinline__ unsigned xb_add(unsigned* p, unsigned v) { return __hip_atomic_fetch_add(p, v, __ATOMIC_RELAXED, __HIP_MEMORY_SCOPE_AGENT); }
__device__ __forceinline__ unsigned xb_xcc_id() { return (unsigned)__builtin_amdgcn_s_getreg((3 << 11) | 20) & 0xFu; }
#define XB_SPIN(cond, bar) do { unsigned _sp = 0; while (cond) { __builtin_amdgcn_s_sleep(1); \
    if ((++_sp & 255u) == 0u) { if (xb_ld(&(bar)[XB_TMO])) break; if (_sp > XB_SPIN_CAP) { atomicAdd(&(bar)[XB_TMO], 1u); break; } } } } while (0)

struct XcdBarrier {
    unsigned* bar; unsigned x;
    volatile LAS unsigned* st;
};

__device__ __forceinline__ XcdBarrier xcd_barrier_post(unsigned* bar, volatile LAS unsigned* st) {
    XcdBarrier b; b.bar = bar; b.x = xb_xcc_id(); b.st = st;
    if (threadIdx.x == 0) (void)xb_add(&bar[XB_XCNT(b.x)], 1u);
    return b;
}
__device__ __forceinline__ void xcd_barrier_complete(unsigned* bar, unsigned x, unsigned& nloc, unsigned& nx) {
    const unsigned G = gridDim.x * gridDim.y * gridDim.z;
    unsigned sum, cnt, mine, sp = 0u;
    for (;;) {
        sum = 0u; cnt = 0u; mine = 0u;
#pragma unroll
        for (unsigned j = 0; j < 16; ++j) { const unsigned c = xb_ld(&bar[XB_XCNT(j)]); sum += c; cnt += (c > 0u) ? 1u : 0u; mine = (j == x) ? c : mine; }
        if (sum == G) break;
        __builtin_amdgcn_s_sleep(1);
        if ((++sp & 255u) == 0u) { if (xb_ld(&bar[XB_TMO])) break; if (sp > XB_SPIN_CAP) { atomicAdd(&bar[XB_TMO], 1u); break; } }
    }
    nloc = mine > 0u ? mine : 1u; nx = cnt > 0u ? cnt : 1u;
}

__device__ __noinline__ void xcd_barrier_impl(unsigned* bar_, unsigned x_, volatile LAS unsigned* st_, int leader_) {
    XcdBarrier b; b.bar = bar_; b.x = x_; b.st = st_;
    asm volatile("s_waitcnt vmcnt(0)" ::: "memory");
    __syncthreads();
    if (leader_) {
        unsigned* bar = b.bar;
        __builtin_amdgcn_s_waitcnt(0);
        unsigned nloc = b.st[0], nx = b.st[1];
        if (nloc == 0u) { xcd_barrier_complete(bar, b.x, nloc, nx); b.st[0] = nloc; b.st[1] = nx; }
        const unsigned old = xb_add(&bar[XB_XSUB(b.x)], 1u);
        const unsigned gen = old / nloc;
        if (old + 1u == (gen + 1u) * nloc) {
            __builtin_amdgcn_fence(__ATOMIC_RELEASE, "agent");
            asm volatile("s_waitcnt vmcnt(0)" ::: "memory");
            const unsigned og = xb_add(&bar[XB_TOP], 1u);
            const unsigned tg = og / nx;
            if (og + 1u == (tg + 1u) * nx) xb_add(&bar[XB_TOPGEN], 1u);
            else XB_SPIN(xb_ld(&bar[XB_TOPGEN]) == tg, bar);
            __builtin_amdgcn_fence(__ATOMIC_ACQUIRE, "agent");
            xb_add(&bar[XB_XGEN(b.x)], 1u);
            asm volatile("s_waitcnt vmcnt(0)" ::: "memory");
        } else {
            XB_SPIN(xb_ld(&bar[XB_XGEN(b.x)]) == gen, bar);
            __builtin_amdgcn_fence(__ATOMIC_ACQUIRE, "agent");
            asm volatile("s_waitcnt vmcnt(0)" ::: "memory");
        }
    }
    __syncthreads();
}
__device__ __forceinline__ void xcd_barrier(const XcdBarrier& b, int leader) { xcd_barrier_impl(b.bar, b.x, b.st, leader); }


__device__ __forceinline__ float wave_sum(float v, int lane) {
    (void)lane;
    v += __builtin_bit_cast(float, __builtin_amdgcn_update_dpp(0, __builtin_bit_cast(int, v), 0xB1, 0xF, 0xF, true));
    v += __builtin_bit_cast(float, __builtin_amdgcn_update_dpp(0, __builtin_bit_cast(int, v), 0x4E, 0xF, 0xF, true));
    v += __builtin_bit_cast(float, __builtin_amdgcn_update_dpp(0, __builtin_bit_cast(int, v), 0x141, 0xF, 0xF, true));
    v += __builtin_bit_cast(float, __builtin_amdgcn_update_dpp(0, __builtin_bit_cast(int, v), 0x140, 0xF, 0xF, true));
    { float a = v, b = v; asm volatile("v_nop\n\tv_nop\n\tv_permlane16_swap_b32 %0, %1" : "+v"(a), "+v"(b)); v = a + b; }
    { float a = v, b = v; asm volatile("v_nop\n\tv_nop\n\tv_permlane32_swap_b32 %0, %1" : "+v"(a), "+v"(b)); v = a + b; }
    return v;
}
__device__ __forceinline__ float wave_max(float v) {
    v = fmaxf(v, __builtin_bit_cast(float, __builtin_amdgcn_update_dpp(0, __builtin_bit_cast(int, v), 0xB1, 0xF, 0xF, true)));
    v = fmaxf(v, __builtin_bit_cast(float, __builtin_amdgcn_update_dpp(0, __builtin_bit_cast(int, v), 0x4E, 0xF, 0xF, true)));
    v = fmaxf(v, __builtin_bit_cast(float, __builtin_amdgcn_update_dpp(0, __builtin_bit_cast(int, v), 0x141, 0xF, 0xF, true)));
    v = fmaxf(v, __builtin_bit_cast(float, __builtin_amdgcn_update_dpp(0, __builtin_bit_cast(int, v), 0x140, 0xF, 0xF, true)));
    { float a = v, b = v; asm volatile("v_nop\n\tv_nop\n\tv_permlane16_swap_b32 %0, %1" : "+v"(a), "+v"(b)); v = fmaxf(a, b); }
    { float a = v, b = v; asm volatile("v_nop\n\tv_nop\n\tv_permlane32_swap_b32 %0, %1" : "+v"(a), "+v"(b)); v = fmaxf(a, b); }
    return v;
}
__device__ __forceinline__ float gelu_erf(float v) {
    const float av = __builtin_fabsf(v), t = __builtin_amdgcn_rcpf(av * 0.2316418882f + 1.0f);
    float q = t * 0.5307027145f + (-0.7265760135f); q = q * t + 0.7107068705f; q = q * t + (-0.142248368f); q = q * t + 0.127414796f; q = q * t;
    const float e = __builtin_amdgcn_exp2f((v * v) * (-0.72134752044f));
    const float m = v * (q * e);
    return v < 0.f ? m : v - m;
}

__device__ __forceinline__ void norm_phase(const GAS float* X, const GAS float* g, GAS bf16* out, int rows, int gw, int NGW, int lane) {
    asm volatile("" : "+v"(lane));
    f32x4 gv[4];
#pragma unroll
    for (int j = 0; j < 4; ++j) gv[j] = ((const GAS f32x4*)g)[lane + 64 * j];
    for (int m = gw; m < rows; m += NGW) {
        const GAS f32x4* xr = (const GAS f32x4*)(X + (size_t)m * D) + lane;
        f32x4 v[4]; float s = 0.f;
#pragma unroll
        for (int j = 0; j < 4; ++j) { v[j] = xr[64 * j]; s += (v[j].x * v[j].x + v[j].y * v[j].y) + (v[j].z * v[j].z + v[j].w * v[j].w); }
        const float rs = rsqrtf(wave_sum(s, lane) * (1.f / D) + 1e-6f);
        GAS v2u* o8 = (GAS v2u*)(out + (size_t)m * D) + lane;
#pragma unroll
        for (int j = 0; j < 4; ++j) { v2u w; w.x = pk2(v[j].x * rs * gv[j].x, v[j].y * rs * gv[j].y); w.y = pk2(v[j].z * rs * gv[j].z, v[j].w * rs * gv[j].w); o8[64 * j] = w; }
    }
}
__device__ __forceinline__ void hq_phase(const GAS bf16* XB, const GAS float* SSQ, const GAS float* g, GAS unsigned char* HQ, GAS float* SH, GAS int* Pz, int gw, int NGW, int lane) {
    asm volatile("" : "+v"(lane));
    const GAS f32x4* gp = (const GAS f32x4*)g + 4 * lane; const f32x4 g0 = gp[0], g1 = gp[1], g2 = gp[2], g3 = gp[3];
    for (int m = gw; m < T; m += NGW) {
        const GAS f32x4* sp = (const GAS f32x4*)(SSQ + (size_t)m * 16); const f32x4 t = (sp[0] + sp[1]) + (sp[2] + sp[3]);
        const float rs = __builtin_amdgcn_rsqf(((t[0] + t[1]) + (t[2] + t[3])) * (1.f / 1024.f) + 1e-6f);
        const v4u a = *(const GAS v4u*)(XB + (size_t)m * D + 16 * lane), b = *(const GAS v4u*)(XB + (size_t)m * D + 16 * lane + 8);
        float f[16] = {bflo(a.x) * g0[0], bfhi(a.x) * g0[1], bflo(a.y) * g0[2], bfhi(a.y) * g0[3], bflo(a.z) * g1[0], bfhi(a.z) * g1[1], bflo(a.w) * g1[2], bfhi(a.w) * g1[3],
                       bflo(b.x) * g2[0], bfhi(b.x) * g2[1], bflo(b.y) * g2[2], bfhi(b.y) * g2[3], bflo(b.z) * g3[0], bfhi(b.z) * g3[1], bflo(b.w) * g3[2], bfhi(b.w) * g3[3]};
        float mx = 0.f;
#pragma unroll
        for (int i = 0; i < 16; ++i) { f[i] *= rs; mx = fmaxf(mx, __builtin_fabsf(f[i])); }
        mx = wave_max(mx);
        const float inv = mx > 0.f ? 127.f / mx : 0.f;
        v4u q;
#pragma unroll
        for (int i = 0; i < 4; ++i) { const int ia = (int)__builtin_rintf(f[4 * i] * inv), ib = (int)__builtin_rintf(f[4 * i + 1] * inv), ic = (int)__builtin_rintf(f[4 * i + 2] * inv), id = (int)__builtin_rintf(f[4 * i + 3] * inv);
            q[i] = (unsigned)(ia & 255) | ((unsigned)(ib & 255) << 8) | ((unsigned)(ic & 255) << 16) | ((unsigned)(id & 255) << 24); }
        *(GAS v4u*)(HQ + (size_t)m * D + 16 * lane) = q;
        if (lane == 0) SH[m] = mx * (1.f / 127.f);
        (Pz + (size_t)m * 128)[lane] = 0; (Pz + (size_t)m * 128)[lane + 64] = 0;
    }
}
__device__ __forceinline__ void x0_phase(const GAS float* X, GAS bf16* XB, GAS float* SSQ, int gw, int NGW, int lane) {
    asm volatile("" : "+v"(lane));
    for (int m = gw; m < T; m += NGW) {
        const GAS f32x4* xr = (const GAS f32x4*)(X + (size_t)m * D) + lane; GAS v2u* o8 = (GAS v2u*)(XB + (size_t)m * D) + lane;
        float s = 0.f;
#pragma unroll
        for (int j = 0; j < 4; ++j) { const f32x4 v = xr[64 * j]; s += (v.x * v.x + v.y * v.y) + (v.z * v.z + v.w * v.w); v2u w; w.x = pk2(v.x, v.y); w.y = pk2(v.z, v.w); o8[64 * j] = w; }
        s = wave_sum(s, lane);
        if (lane < 8) SSQ[(size_t)m * 16 + lane] = lane == 0 ? s : 0.f;
    }
}
__device__ __forceinline__ void final_norm_phase(const GAS bf16* XB, GAS float* O, const GAS float* g, int rows, int gw, int NGW, int lane) {
    asm volatile("" : "+v"(lane));
    for (int m = gw; m < rows; m += NGW) {
        const GAS v4u* xr = (const GAS v4u*)(XB + (size_t)m * D) + lane;
        v4u v[2]; float s = 0.f;
#pragma unroll
        for (int j = 0; j < 2; ++j) { v[j] = xr[64 * j];
#pragma unroll
            for (int e = 0; e < 4; ++e) { const float a = bflo(v[j][e]), b = bfhi(v[j][e]); s += a * a + b * b; } }
        const float rs = rsqrtf(wave_sum(s, lane) * (1.f / D) + 1e-6f);
#pragma unroll
        for (int j = 0; j < 2; ++j) { const int c = 8 * (lane + 64 * j); const f32x4 g0 = *(const GAS f32x4*)(g + c), g1 = *(const GAS f32x4*)(g + c + 4);
            f32x4 o0, o1; o0.x = bflo(v[j].x) * rs * g0.x; o0.y = bfhi(v[j].x) * rs * g0.y; o0.z = bflo(v[j].y) * rs * g0.z; o0.w = bfhi(v[j].y) * rs * g0.w;
            o1.x = bflo(v[j].z) * rs * g1.x; o1.y = bfhi(v[j].z) * rs * g1.y; o1.z = bflo(v[j].w) * rs * g1.z; o1.w = bfhi(v[j].w) * rs * g1.w;
            *(GAS f32x4*)(O + (size_t)m * D + c) = o0; *(GAS f32x4*)(O + (size_t)m * D + c + 4) = o1; }
    }
}

__device__ __forceinline__ float row16_sum(float v) {
    v += __builtin_bit_cast(float, __builtin_amdgcn_update_dpp(0, __builtin_bit_cast(int, v), 0xB1, 0xF, 0xF, true));
    v += __builtin_bit_cast(float, __builtin_amdgcn_update_dpp(0, __builtin_bit_cast(int, v), 0x4E, 0xF, 0xF, true));
    v += __builtin_bit_cast(float, __builtin_amdgcn_update_dpp(0, __builtin_bit_cast(int, v), 0x141, 0xF, 0xF, true));
    v += __builtin_bit_cast(float, __builtin_amdgcn_update_dpp(0, __builtin_bit_cast(int, v), 0x140, 0xF, 0xF, true));
    return v;
}
__device__ __forceinline__ float sq8(const v4u w) { const float a0 = bflo(w.x), a1 = bfhi(w.x), a2 = bflo(w.y), a3 = bfhi(w.y), a4 = bflo(w.z), a5 = bfhi(w.z), a6 = bflo(w.w), a7 = bfhi(w.w);
    return (a0 * a0 + a1 * a1) + (a2 * a2 + a3 * a3) + (a4 * a4 + a5 * a5) + (a6 * a6 + a7 * a7); }
__device__ __forceinline__ void pre_phase(const GAS bf16* PROJB, const GAS float* ROPE, GAS float* RS, GAS bf16* KMB, int gw, int NGW, int lane) {
    asm volatile("" : "+v"(lane));
    const int q = lane >> 4, sub = lane & 15;
    for (int t0 = gw * 4; t0 < T; t0 += NGW * 4) {
        const size_t t = (size_t)t0 + q;
        const GAS bf16* pr = PROJB + t * INP;
        const v4u w0 = *(const GAS v4u*)(pr + PC_CQ + 8 * sub), w1 = *(const GAS v4u*)(pr + PC_CQ + 8 * (16 + (sub & 7))), w2 = *(const GAS v4u*)(pr + PC_CKV + 8 * sub);
        const float x1 = __builtin_bit_cast(float, (unsigned)pr[PC_KR + sub] << 16), x2 = __builtin_bit_cast(float, (unsigned)pr[PC_KR + 16 + sub] << 16);
        const float c = ROPE[t * 32 + sub], sn = ROPE[t * 32 + 16 + sub];
        const float sq = row16_sum(sq8(w0) + (sub < 8 ? sq8(w1) : 0.f)), skv = row16_sum(sq8(w2));
        if (sub == 0) { RS[2 * t] = rsqrtf(sq * (1.f / 192.f) + 1e-6f); RS[2 * t + 1] = rsqrtf(skv * (1.f / 128.f) + 1e-6f); }
        const bf16 y1 = (bf16)f2bf_(x1 * c - x2 * sn), y2 = (bf16)f2bf_(x1 * sn + x2 * c);
        GAS bf16* kr = KMB + t * 384 + 64 + sub;
#pragma unroll
        for (int h = 0; h < 4; ++h) { kr[h * 96] = y1; kr[h * 96 + 16] = y2; }
    }
}

typedef short lr_bf16x8 __attribute__((ext_vector_type(8)));
typedef float lr_f32x16 __attribute__((ext_vector_type(16)));
__device__ __forceinline__ void lr_swap32(float& a, float& b) { asm volatile("v_nop\n\tv_nop\n\tv_permlane32_swap_b32 %0, %1" : "+v"(a), "+v"(b)); }
constexpr int LR_XR = 0, LR_CW = LR_XR + 37376, LR_XA = LR_CW + 1280, LR_WT = LR_XA + 256 * 144, LR_SUM = LR_WT + 2 * 64 * 144, LR_END = LR_SUM + 4096;
struct LruP { const GAS bf16* PROJB; const GAS float* cw; const GAS float* cb; const GAS bf16* wat; const GAS float* ba; const GAS float* bx; const GAS float* sp; GAS unsigned* HA; GAS float* LSUM; };
__device__ __forceinline__ void lru_phase(const LruP& P, LAS unsigned char* lds, int tid, int wave, int lane, int vcu, int G) {
    asm volatile("" : "+v"(tid), "+v"(lane));
    LAS float* SUM = (LAS float*)(lds + LR_SUM);
    for (int u = vcu; u < (T / 256) * 8; u += G) {
        const int tile = u >> 3, g = u & 7; const int t0 = tile * 256; const bool first = ((tile & 31) == 0);
        __syncthreads();
        float ba_[2], bx_[2], sp_[2];
#pragma unroll
        for (int nt = 0; nt < 2; ++nt) { const int ch = 64 * g + 32 * nt + (lane & 31); ba_[nt] = P.ba[ch]; bx_[nt] = P.bx[ch]; sp_[nt] = P.sp[ch]; }
        { v4u wt_[2], xr_[5];
#pragma unroll
          for (int i = 0; i < 2; ++i) { const int idx = tid + 512 * i; wt_[i] = ((const GAS v4u*)(P.wat + (size_t)g * 2 * 4096))[idx]; }
#pragma unroll
          for (int i = 0; i < 5; ++i) { const int idx = tid + 512 * i, row = idx >> 3, part = idx & 7; const bool ok = (idx < 259 * 8) && !(first && row < 3);
              const int trow = ok ? t0 - 3 + row : t0;
              xr_[i] = *(const GAS v4u*)(P.PROJB + (size_t)trow * INP + PC_XL + 64 * g + 8 * part); if (!ok) xr_[i] = v4u{0u, 0u, 0u, 0u}; }
          float cwv = 0.f; if (tid < 320) cwv = (tid < 256) ? P.cw[(tid >> 6) * 512 + 64 * g + (tid & 63)] : P.cb[64 * g + (tid - 256)];
#pragma unroll
          for (int i = 0; i < 2; ++i) { const int idx = tid + 512 * i; *(LAS v4u*)(lds + LR_WT + (idx >> 9) * 9216 + ((idx >> 3) & 63) * 144 + (idx & 7) * 16) = wt_[i]; }
#pragma unroll
          for (int i = 0; i < 5; ++i) { const int idx = tid + 512 * i, row = idx >> 3, part = idx & 7; if (idx < 259 * 8) *(LAS v4u*)(lds + LR_XR + row * 144 + 16 * part) = xr_[i]; }
          if (tid < 320) ((LAS float*)(lds + LR_CW))[tid] = cwv; }
        __syncthreads();
        { float cwr[4][8], cbr[8];
#pragma unroll
          for (int k = 0; k < 4; ++k) { const f32x4 c0 = *(const LAS f32x4*)(lds + LR_CW + (k * 64 + 8 * wave) * 4), c1 = *(const LAS f32x4*)(lds + LR_CW + (k * 64 + 8 * wave + 4) * 4);
              cwr[k][0] = c0.x; cwr[k][1] = c0.y; cwr[k][2] = c0.z; cwr[k][3] = c0.w; cwr[k][4] = c1.x; cwr[k][5] = c1.y; cwr[k][6] = c1.z; cwr[k][7] = c1.w; }
          { const f32x4 c0 = *(const LAS f32x4*)(lds + LR_CW + (256 + 8 * wave) * 4), c1 = *(const LAS f32x4*)(lds + LR_CW + (256 + 8 * wave + 4) * 4);
            cbr[0] = c0.x; cbr[1] = c0.y; cbr[2] = c0.z; cbr[3] = c0.w; cbr[4] = c1.x; cbr[5] = c1.y; cbr[6] = c1.z; cbr[7] = c1.w; }
#pragma unroll
          for (int it_ = 0; it_ < 4; ++it_) { const int time = lane + 64 * it_;
              float y[8];
#pragma unroll
              for (int e = 0; e < 8; ++e) y[e] = cbr[e];
#pragma unroll
              for (int k = 0; k < 4; ++k) { const v4u w = *(const LAS v4u*)(lds + LR_XR + (time + k) * 144 + 16 * wave);
                  y[0] += bflo(w.x) * cwr[k][0]; y[1] += bfhi(w.x) * cwr[k][1]; y[2] += bflo(w.y) * cwr[k][2]; y[3] += bfhi(w.y) * cwr[k][3];
                  y[4] += bflo(w.z) * cwr[k][4]; y[5] += bfhi(w.z) * cwr[k][5]; y[6] += bflo(w.w) * cwr[k][6]; y[7] += bfhi(w.w) * cwr[k][7]; }
              v4u o; o.x = pk2(y[0], y[1]); o.y = pk2(y[2], y[3]); o.z = pk2(y[4], y[5]); o.w = pk2(y[6], y[7]);
              *(LAS v4u*)(lds + LR_XA + time * 144 + 16 * wave) = o; } }
        __syncthreads();
        const int r32 = lane & 31, hi = lane >> 5;
        lr_f32x16 acc[2][2];
#pragma unroll
        for (int nt = 0; nt < 2; ++nt) { const float b_a = ba_[nt], b_x = bx_[nt];
#pragma unroll
            for (int r = 0; r < 16; ++r) { acc[0][nt][r] = b_a; acc[1][nt][r] = b_x; } }
        { lr_bf16x8 af[4];
#pragma unroll
          for (int s_ = 0; s_ < 4; ++s_) af[s_] = *(const LAS lr_bf16x8*)(lds + LR_XA + (32 * wave + r32) * 144 + (16 * s_ + 8 * hi) * 2);
#pragma unroll
          for (int gt = 0; gt < 2; ++gt)
#pragma unroll
              for (int nt = 0; nt < 2; ++nt)
#pragma unroll
                  for (int s_ = 0; s_ < 4; ++s_) { const lr_bf16x8 bfr = *(const LAS lr_bf16x8*)(lds + LR_WT + gt * 9216 + (32 * nt + r32) * 144 + (16 * s_ + 8 * hi) * 2);
                      acc[gt][nt] = __builtin_amdgcn_mfma_f32_32x32x16_bf16(af[s_], bfr, acc[gt][nt], 0, 0, 0); } }
#pragma unroll
        for (int nt = 0; nt < 2; ++nt) { const float sp = sp_[nt];
            float sa_[4], sh_[4];
#pragma unroll
            for (int q = 0; q < 4; ++q) { float hrun = 0.f, arun = 1.f;
#pragma unroll
                for (int e = 0; e < 4; ++e) { const int r = 4 * q + e, tl = 8 * q + 4 * hi + e;
                    const float xv = __builtin_bit_cast(float, (unsigned)*(const LAS unsigned short*)(lds + LR_XA + (32 * wave + tl) * 144 + (32 * nt + r32) * 2) << 16);
                    const float rg = __builtin_amdgcn_rcpf(1.f + __builtin_amdgcn_exp2f(-LOG2E * acc[0][nt][r])), ig = __builtin_amdgcn_rcpf(1.f + __builtin_amdgcn_exp2f(-LOG2E * acc[1][nt][r]));
                    const float la = -8.0f * rg * sp; const float a_ = __builtin_amdgcn_exp2f(LOG2E * la);
                    const float uu = __builtin_amdgcn_sqrtf(fmaxf(1.f - a_ * a_, 0.f)) * (ig * xv);
                    hrun = a_ * hrun + uu; arun *= a_; acc[0][nt][r] = arun; acc[1][nt][r] = hrun; }
                sa_[q] = arun; sh_[q] = hrun; }
            float runA = 1.f, runH = 0.f;
#pragma unroll
            for (int q = 0; q < 4; ++q) { float a0 = sa_[q], a1 = sa_[q], h0 = sh_[q], h1 = sh_[q]; lr_swap32(a0, a1); lr_swap32(h0, h1);
                const float midA = runA * a0, midH = a0 * runH + h0;
                const float inA = hi ? midA : runA, inH = hi ? midH : runH;
                runA = midA * a1; runH = a1 * midH + h1;
#pragma unroll
                for (int e = 0; e < 4; ++e) { const int r = 4 * q + e; acc[1][nt][r] += acc[0][nt][r] * inH; acc[0][nt][r] *= inA; } }
            if (hi == 0) { SUM[(wave * 64 + 32 * nt + r32) * 2] = runA; SUM[(wave * 64 + 32 * nt + r32) * 2 + 1] = runH; } }
        __syncthreads();
#pragma unroll
        for (int nt = 0; nt < 2; ++nt) { const int cl = 32 * nt + r32;
            float ca = 1.f, chh = 0.f;
            for (int w = 0; w < wave; ++w) { const float aw = SUM[(w * 64 + cl) * 2], hw = SUM[(w * 64 + cl) * 2 + 1]; chh = aw * chh + hw; ca *= aw; }
            GAS unsigned* ha = P.HA + (size_t)(t0 + 32 * wave + 4 * hi) * 512 + 64 * g + cl;
#pragma unroll
            for (int r = 0; r < 16; ++r) { const float hh = acc[1][nt][r] + acc[0][nt][r] * chh, ac_ = acc[0][nt][r] * ca; ha[(size_t)((r & 3) + 8 * (r >> 2)) * 512] = pk2(hh, ac_);
                if (r == 15 && wave == 7 && hi == 1) { P.LSUM[((size_t)tile * 512 + 64 * g + cl) * 2] = ac_; P.LSUM[((size_t)tile * 512 + 64 * g + cl) * 2 + 1] = hh; } } }
    }
}

struct PostP { const GAS bf16* OMB; const GAS unsigned* HA; const GAS float* LSUM; const GAS bf16* PROJB; const GAS float* gm; const GAS float* gl; GAS bf16* Y; };
__device__ __forceinline__ void post_phase(const PostP& P, LAS unsigned char* lds, int tid, int wave, int lane, int vcu, int G) {
    asm volatile("" : "+v"(tid), "+v"(lane));
    LAS float* hin = (LAS float*)lds;
    for (int u = vcu; u < T / 64; u += G) {
        const int t0 = u * 64, tile = t0 >> 8, tb = tile & ~31;
        __syncthreads();
        { float h = 0.f;
          for (int c0 = tb; c0 < tile; c0 += 8) {
              float av_[8], hv_[8];
#pragma unroll
              for (int i = 0; i < 8; ++i) { const int c = (c0 + i < tile) ? (c0 + i) : tb; av_[i] = P.LSUM[((size_t)c * 512 + tid) * 2]; hv_[i] = P.LSUM[((size_t)c * 512 + tid) * 2 + 1]; }
#pragma unroll
              for (int i = 0; i < 8; ++i) { if (c0 + i < tile) h = av_[i] * h + hv_[i]; } }
          hin[tid] = h; }
        __syncthreads();
        f32x4 hi0 = *(const LAS f32x4*)(hin + 8 * lane), hi1 = *(const LAS f32x4*)(hin + 8 * lane + 4);
        const f32x4 g0 = *(const GAS f32x4*)(P.gl + 8 * lane), g1 = *(const GAS f32x4*)(P.gl + 8 * lane + 4), gmv = *(const GAS f32x4*)(P.gm + 4 * lane);
#pragma unroll 2
        for (int i = 0; i < 8; ++i) {
            const size_t t = (size_t)t0 + 8 * wave + i;
            const v4u p0 = *(const GAS v4u*)(P.HA + t * 512 + 8 * lane), p1 = *(const GAS v4u*)(P.HA + t * 512 + 8 * lane + 4), gw_ = *(const GAS v4u*)(P.PROJB + t * INP + PC_GL + 8 * lane);
            const v2u mw = *(const GAS v2u*)(P.OMB + t * 256 + 4 * lane);
            float o[8];
            o[0] = (bflo(p0.x) + bfhi(p0.x) * hi0.x) * gelu_erf(bflo(gw_.x)); o[1] = (bflo(p0.y) + bfhi(p0.y) * hi0.y) * gelu_erf(bfhi(gw_.x));
            o[2] = (bflo(p0.z) + bfhi(p0.z) * hi0.z) * gelu_erf(bflo(gw_.y)); o[3] = (bflo(p0.w) + bfhi(p0.w) * hi0.w) * gelu_erf(bfhi(gw_.y));
            o[4] = (bflo(p1.x) + bfhi(p1.x) * hi1.x) * gelu_erf(bflo(gw_.z)); o[5] = (bflo(p1.y) + bfhi(p1.y) * hi1.y) * gelu_erf(bfhi(gw_.z));
            o[6] = (bflo(p1.z) + bfhi(p1.z) * hi1.z) * gelu_erf(bflo(gw_.w)); o[7] = (bflo(p1.w) + bfhi(p1.w) * hi1.w) * gelu_erf(bfhi(gw_.w));
            float s2 = 0.f;
#pragma unroll
            for (int e = 0; e < 8; ++e) s2 += o[e] * o[e];
            const float m0 = bflo(mw.x), m1 = bfhi(mw.x), m2 = bflo(mw.y), m3 = bfhi(mw.y);
            float s1 = (m0 * m0 + m1 * m1) + (m2 * m2 + m3 * m3);
            s1 = wave_sum(s1, lane); s2 = wave_sum(s2, lane);
            const float r1 = rsqrtf(s1 * (1.f / 256.f) + 1e-6f), r2 = rsqrtf(s2 * (1.f / 512.f) + 1e-6f);
            GAS bf16* yr = P.Y + t * 1024;
            { v2u w; w.x = pk2(m0 * r1 * gmv.x, m1 * r1 * gmv.y); w.y = pk2(m2 * r1 * gmv.z, m3 * r1 * gmv.w); *(GAS v2u*)(yr + 4 * lane) = w; }
            { v4u w; w.x = pk2(o[0] * r2 * g0.x, o[1] * r2 * g0.y); w.y = pk2(o[2] * r2 * g0.z, o[3] * r2 * g0.w); w.z = pk2(o[4] * r2 * g1.x, o[5] * r2 * g1.y); w.w = pk2(o[6] * r2 * g1.z, o[7] * r2 * g1.w);
              *(GAS v4u*)(yr + 256 + 8 * lane) = w; }
        }
    }
}

#define TILE_BAR() asm volatile("s_waitcnt lgkmcnt(0)\n\ts_barrier" ::: "memory")
typedef short bf16x8 __attribute__((ext_vector_type(8)));
typedef short s16x4 __attribute__((ext_vector_type(4)));
typedef float f32x16 __attribute__((ext_vector_type(16)));
typedef unsigned u32x4 __attribute__((ext_vector_type(4)));
__device__ __forceinline__ int crow(int r, int hi) { return (r & 3) + 8 * (r >> 2) + 4 * hi; }
typedef float f32x2_t __attribute__((ext_vector_type(2))); typedef __bf16 bf16x2_c __attribute__((ext_vector_type(2)));
__device__ __forceinline__ unsigned cvtpk(float lo, float hi) { f32x2_t v = {lo, hi}; bf16x2_c b = __builtin_convertvector(v, bf16x2_c); return __builtin_bit_cast(unsigned, b); }
__device__ __forceinline__ float swapmax(float m) { auto rr = __builtin_amdgcn_permlane32_swap(__float_as_uint(m), __float_as_uint(m), false, false); return fmaxf(__uint_as_float(rr[0]), __uint_as_float(rr[1])); }
__device__ __forceinline__ float swapadd(float m) { auto rr = __builtin_amdgcn_permlane32_swap(__float_as_uint(m), __float_as_uint(m), false, false); return __uint_as_float(rr[0]) + __uint_as_float(rr[1]); }
__device__ __forceinline__ s16x4 vtr(const LAS unsigned char* p) { return __builtin_bit_cast(s16x4, __builtin_amdgcn_ds_read_tr16_b64_v4i16((LAS s16x4*)p)); }
__device__ __forceinline__ bf16x8 pack8(const f32x16& p, int b) { u32x4 w; w.x = cvtpk(p[b], p[b + 1]); w.y = cvtpk(p[b + 2], p[b + 3]); w.z = cvtpk(p[b + 4], p[b + 5]); w.w = cvtpk(p[b + 6], p[b + 7]); return __builtin_bit_cast(bf16x8, w); }
__device__ __forceinline__ float vmax3(float a, float b, float c) { float r; asm("v_max3_f32 %0, %1, %2, %3" : "=v"(r) : "v"(a), "v"(b), "v"(c)); return r; }
__device__ __forceinline__ float max32(const f32x16& p, const f32x16& q) {
    float a = vmax3(p[0], p[1], p[2]), b = vmax3(p[3], p[4], p[5]), c = vmax3(p[6], p[7], p[8]), d = vmax3(p[9], p[10], p[11]), e = vmax3(p[12], p[13], p[14]);
    float f = vmax3(q[0], q[1], q[2]), g = vmax3(q[3], q[4], q[5]), h = vmax3(q[6], q[7], q[8]), i = vmax3(q[9], q[10], q[11]), j = vmax3(q[12], q[13], q[14]);
    a = vmax3(a, b, c); d = vmax3(d, e, p[15]); f = vmax3(f, g, h); i = vmax3(i, j, q[15]);
    return vmax3(vmax3(a, d, f), i, i);
}
__device__ __forceinline__ float max16(const f32x16& p) { float a = fmaxf(fmaxf(p[0], p[1]), fmaxf(p[2], p[3])), b = fmaxf(fmaxf(p[4], p[5]), fmaxf(p[6], p[7])), c = fmaxf(fmaxf(p[8], p[9]), fmaxf(p[10], p[11])), d = fmaxf(fmaxf(p[12], p[13]), fmaxf(p[14], p[15])); return fmaxf(fmaxf(a, b), fmaxf(c, d)); }

struct AttnP {
    const GAS bf16* Q; const GAS bf16* K; const GAS bf16* V; int qp, kp, vp;
    GAS bf16* O; int op;
    const GAS float* rope;
    const GAS int* pos; const GAS float* btab; const GAS float* dnorm; const GAS float* lams;
};
template <int KIND> struct AK {
    static constexpr bool DIFF = KIND == 1, CROSS = KIND == 2;
    static constexpr int HW = KIND == 0 ? 96 : KIND == 1 ? 64 : 256;
    static constexpr int NKS = KIND == 0 ? 6 : KIND == 1 ? 2 : 16;
    static constexpr int KP = KIND == 0 ? 208 : KIND == 1 ? 144 : 528;
    static constexpr int ND = CROSS ? 4 : 2;
    static constexpr int CPK = HW / 8, KCH = (64 * CPK + 511) / 512;
    static constexpr int VCH = ND / 2;
    static constexpr int KB = 64 * KP, VB = ND * 4096;
    static constexpr int NBUF = CROSS ? 2 : 3;
    static constexpr int K0 = 0, V0 = NBUF * KB, POS = V0 + NBUF * VB, BT = POS + 1024, DN = BT + 528, END = DN + 256;
};
static_assert(AK<2>::END <= RING_BYTES && AK<0>::END <= RING_BYTES && AK<1>::END + 16 + 8 * 8192 <= RING_BYTES, "attention LDS");

template <int KIND, bool LEAD>
__device__ __forceinline__ void attn_unit(const AttnP& P, int b, int h, int qb, int dhalf, LAS unsigned char* lds, int tid, int wave, int lane) {
    lane = lane_id_v(); tid = (wave << 6) | lane;
    typedef AK<KIND> C;
    constexpr bool DIFF = C::DIFF, CROSS = C::CROSS;
    constexpr int HW = C::HW, NKS = C::NKS, KP = C::KP, ND = C::ND, CPK = C::CPK, KCH = C::KCH, VCH = C::VCH;
    const int r32 = lane & 31, hi = lane >> 5;
    const size_t rowb = (size_t)b * S, rowk = CROSS ? (size_t)b * MEM : rowb;
    const int q0w = qb * 256 + wave * 32, qi = q0w + r32;
    int pq = 0; float bias_far = 0.f;
    __syncthreads();
    if (DIFF) {
        pq = P.pos[rowb + qi];
        if (tid < 129) ((LAS float*)(lds + C::BT))[tid] = P.btab[h * 129 + tid];
        if (tid >= 192 && tid < 256) ((LAS float*)(lds + C::DN))[tid - 192] = P.dnorm[tid - 192];
    }
    int minq = pq;
    if (DIFF) { for (int o = 1; o < 64; o <<= 1) { const int v = shxi(minq, o, lane); minq = v < minq ? v : minq; } }
    const int NT = CROSS ? MEM / 64 : 4 * (qb + 1);
    u32x4 kr[KCH], vr[VCH]; int pkr = 0;
    u32x4 kr2[CROSS ? 1 : KCH], vr2[CROSS ? 1 : VCH]; int pkr2 = 0;
    const GAS bf16* Kb = P.K + rowk * P.kp + h * HW; const GAS bf16* Vb = P.V + rowk * P.vp + (CROSS ? h * 256 + dhalf * 128 : h * 64);
    const __amdgpu_buffer_rsrc_t rK = __builtin_amdgcn_make_buffer_rsrc((void*)Kb, 0, 0x7fffffff, 0x00020000), rV = __builtin_amdgcn_make_buffer_rsrc((void*)Vb, 0, 0x7fffffff, 0x00020000);
    const __amdgpu_buffer_rsrc_t rP = __builtin_amdgcn_make_buffer_rsrc((void*)(DIFF ? P.pos + rowb : (const GAS int*)Kb), 0, 0x7fffffff, 0x00020000);
    int kvo[KCH], vvo[VCH];
#pragma unroll
    for (int i = 0; i < KCH; ++i) { int c = tid + 512 * i; c = c < 64 * CPK ? c : tid; kvo[i] = ((c / CPK) * P.kp + (c % CPK) * 8) * 2; }
#pragma unroll
    for (int i = 0; i < VCH; ++i) { const int c = tid + 512 * i; vvo[i] = ((c / (4 * ND)) * P.vp + (c % (4 * ND)) * 8) * 2; }
    const int pvo = (tid & 63) * 4;
    auto gload = [&](int t) {
        const int ks = __builtin_amdgcn_readfirstlane(64 * t * P.kp * 2), vs = __builtin_amdgcn_readfirstlane(64 * t * P.vp * 2);
#pragma unroll
        for (int i = 0; i < KCH; ++i) kr[i] = __builtin_amdgcn_raw_buffer_load_b128(rK, kvo[i], ks, 0);
#pragma unroll
        for (int i = 0; i < VCH; ++i) vr[i] = __builtin_amdgcn_raw_buffer_load_b128(rV, vvo[i], vs, 0);
        if (DIFF) pkr = __builtin_amdgcn_raw_buffer_load_b32(rP, pvo, __builtin_amdgcn_readfirstlane(64 * t * 4), 0);
    };
    auto lstore = [&](int buf) {
        LAS unsigned char* kb_ = lds + C::K0 + buf * C::KB; LAS unsigned char* vb_ = lds + C::V0 + buf * C::VB;
#pragma unroll
        for (int i = 0; i < KCH; ++i) { int c = tid + 512 * i; c = c < 64 * CPK ? c : tid; const int key = c / CPK, part = c % CPK; *(LAS u32x4*)(kb_ + key * KP + part * 16) = kr[i]; }
#pragma unroll
        for (int i = 0; i < VCH; ++i) { const int c = tid + 512 * i; const int key = c / (4 * ND), part = c % (4 * ND); *(LAS u32x4*)(vb_ + (part >> 2) * 4096 + (key >> 3) * 512 + (key & 7) * 64 + (part & 3) * 16) = vr[i]; }
        if (DIFF) { ((LAS int*)(lds + C::POS + buf * 256))[tid & 63] = pkr; if (tid < 64) { int mk_ = pkr; for (int o = 1; o < 64; o <<= 1) { const int v = shxi(mk_, o, lane); mk_ = v > mk_ ? v : mk_; } if (tid == 0) ((LAS int*)(lds + C::POS + 768))[buf] = mk_; } }
    };
    auto gloadB = [&](int t) {
        const int ks = __builtin_amdgcn_readfirstlane(64 * t * P.kp * 2), vs = __builtin_amdgcn_readfirstlane(64 * t * P.vp * 2);
#pragma unroll
        for (int i = 0; i < (CROSS ? 1 : KCH); ++i) kr2[i] = __builtin_amdgcn_raw_buffer_load_b128(rK, kvo[i], ks, 0);
#pragma unroll
        for (int i = 0; i < (CROSS ? 1 : VCH); ++i) vr2[i] = __builtin_amdgcn_raw_buffer_load_b128(rV, vvo[i], vs, 0);
        if (DIFF) pkr2 = __builtin_amdgcn_raw_buffer_load_b32(rP, pvo, __builtin_amdgcn_readfirstlane(64 * t * 4), 0);
    };
    auto lstoreB = [&](int buf) {
        LAS unsigned char* kb_ = lds + C::K0 + buf * C::KB; LAS unsigned char* vb_ = lds + C::V0 + buf * C::VB;
#pragma unroll
        for (int i = 0; i < (CROSS ? 1 : KCH); ++i) { int c = tid + 512 * i; c = c < 64 * CPK ? c : tid; const int key = c / CPK, part = c % CPK; *(LAS u32x4*)(kb_ + key * KP + part * 16) = kr2[i]; }
#pragma unroll
        for (int i = 0; i < (CROSS ? 1 : VCH); ++i) { const int c = tid + 512 * i; const int key = c / (4 * ND), part = c % (4 * ND); *(LAS u32x4*)(vb_ + (part >> 2) * 4096 + (key >> 3) * 512 + (key & 7) * 64 + (part & 3) * 16) = vr2[i]; }
        if (DIFF) { ((LAS int*)(lds + C::POS + buf * 256))[tid & 63] = pkr2; if (tid < 64) { int mk_ = pkr2; for (int o = 1; o < 64; o <<= 1) { const int v = shxi(mk_, o, lane); mk_ = v > mk_ ? v : mk_; } if (tid == 0) ((LAS int*)(lds + C::POS + 768))[buf] = mk_; } }
    };
    LAS float* osv = (LAS float*)(lds + ((C::END + 15) & ~15)) + wave * 2048 + lane;
    float il = 0.f;
    f32x16 oA[ND];
#pragma unroll 1
    for (int mp = 0; mp < (DIFF ? 2 : 1); ++mp) {
        bf16x8 qf[NKS];
        { const GAS bf16* qrow = P.Q + (rowb + qi) * P.qp + h * HW + mp * 32;
#pragma unroll
          for (int s = 0; s < NKS; ++s) qf[s] = *(const GAS bf16x8*)(qrow + 16 * s + 8 * hi);
          if (KIND == 0) {
              const GAS float* rp = P.rope + (rowb + qi) * 32 + 8 * hi;
              const f32x4 c0 = *(const GAS f32x4*)rp, c1 = *(const GAS f32x4*)(rp + 4), s0 = *(const GAS f32x4*)(rp + 16), s1 = *(const GAS f32x4*)(rp + 20);
              const u32x4 a = __builtin_bit_cast(u32x4, qf[NKS - 2]), bq = __builtin_bit_cast(u32x4, qf[NKS - 1]); u32x4 ra, rb;
#pragma unroll
              for (int w = 0; w < 4; ++w) { const float cl = w < 2 ? c0[2 * w] : c1[2 * w - 4], ch = w < 2 ? c0[2 * w + 1] : c1[2 * w - 3], sl = w < 2 ? s0[2 * w] : s1[2 * w - 4], sh = w < 2 ? s0[2 * w + 1] : s1[2 * w - 3];
                  const float x1l = bflo(a[w]), x1h = bfhi(a[w]), x2l = bflo(bq[w]), x2h = bfhi(bq[w]);
                  ra[w] = cvtpk(x1l * cl - x2l * sl, x1h * ch - x2h * sh); rb[w] = cvtpk(x1l * sl + x2l * cl, x1h * sh + x2h * ch); }
              qf[NKS - 2] = __builtin_bit_cast(bf16x8, ra); qf[NKS - 1] = __builtin_bit_cast(bf16x8, rb);
          } }
        __syncthreads();
        float m1 = -1e30f, l1 = 0.f;
#pragma unroll
        for (int d = 0; d < ND; ++d)
#pragma unroll
            for (int r = 0; r < 16; ++r) oA[d][r] = 0.f;
        auto qk = [&](int sl, f32x16& sa, f32x16& sb, float init) {
            const LAS unsigned char* kb_ = lds + C::K0 + sl * C::KB + r32 * KP + hi * 16 + mp * 64;
#pragma unroll
            for (int r = 0; r < 16; ++r) { sa[r] = init; sb[r] = init; }
            constexpr int HB = CROSS ? 4 : (NKS > 3 ? 3 : NKS);
#pragma unroll
            for (int s0_ = 0; s0_ < NKS; s0_ += HB) {
                bf16x8 kfa[HB], kfb[HB];
#pragma unroll
                for (int s = 0; s < HB; ++s) { kfa[s] = *(const LAS bf16x8*)(kb_ + (s0_ + s) * 32); kfb[s] = *(const LAS bf16x8*)(kb_ + 32 * KP + (s0_ + s) * 32); }
                __builtin_amdgcn_sched_barrier(0);
#pragma unroll
                for (int s = 0; s < HB; ++s) { sa = __builtin_amdgcn_mfma_f32_32x32x16_bf16(kfa[s], qf[s0_ + s], sa, 0, 0, 0); sb = __builtin_amdgcn_mfma_f32_32x32x16_bf16(kfb[s], qf[s0_ + s], sb, 0, 0, 0); }
                __builtin_amdgcn_sched_barrier(0);
            }
        };
        auto isnear = [&](int sl) { bool nb = false;
            if (DIFF) { const int mk_ = __builtin_amdgcn_readfirstlane(((LAS int*)(lds + C::POS + 768))[sl]); nb = (minq - mk_) < 128; }
            return nb; };
        auto sm = [&](int t, int sl, f32x16& pa, f32x16& pb, bool nearb) -> float {
            const int k0 = 64 * t;
            if (DIFF) { if (nearb) {
                const LAS int* pk = (const LAS int*)(lds + C::POS + sl * 256); const LAS float* bt = (const LAS float*)(lds + C::BT);
#pragma unroll
                for (int r = 0; r < 16; ++r) { const int kk = crow(r, hi);
                    int n0 = pq - pk[kk], n1 = pq - pk[kk + 32]; n0 = n0 < 0 ? 0 : (n0 > 128 ? 128 : n0); n1 = n1 < 0 ? 0 : (n1 > 128 ? 128 : n1);
                    pa[r] += bt[n0]; pb[r] += bt[n1]; }
            } }
            if (!CROSS && k0 + 63 > q0w) {
#pragma unroll
                for (int r = 0; r < 16; ++r) { const int kk = k0 + crow(r, hi); if (kk > qi) pa[r] = -1e30f; if (kk + 32 > qi) pb[r] = -1e30f; }
            }
            asm volatile("s_nop 15\n\ts_nop 7" : "+v"(pa), "+v"(pb));
            float mn, al = 1.f;
            if (CROSS) { const float mx = swapmax(max32(pa, pb)); mn = fmaxf(m1, mx); al = __builtin_amdgcn_exp2f(m1 - mn); l1 *= al; }
            else { const float mx = swapmax(max32(pa, pb)); const bool up = mx > m1 + 8.0f; mn = up ? mx : m1;
                   if (__builtin_amdgcn_ballot_w64(up) != 0ull) { al = __builtin_amdgcn_exp2f(m1 - mn); l1 *= al; } }
            m1 = mn;
            float ls = 0.f;
#pragma unroll
            for (int r = 0; r < 16; ++r) { pa[r] = __builtin_amdgcn_exp2f(pa[r] - mn); pb[r] = __builtin_amdgcn_exp2f(pb[r] - mn); ls += pa[r] + pb[r]; }
            l1 += ls;
            return al;
        };
        auto pv = [&](int sl, const f32x16& pa, const f32x16& pb, float al) {
            const LAS unsigned char* vb_ = lds + C::V0 + sl * C::VB + ((lane >> 4) & 1) * 32 + (lane & 3) * 8 + (4 * hi + ((lane & 15) >> 2)) * 64;
            bf16x8 pf[4];
            pf[0] = pack8(pa, 0); pf[1] = pack8(pa, 8); pf[2] = pack8(pb, 0); pf[3] = pack8(pb, 8);
            const bool resc = CROSS ? true : (__builtin_amdgcn_ballot_w64(al != 1.0f) != 0ull);
            if (CROSS) {
#pragma unroll
                for (int d = 0; d < ND; ++d) {
                    __builtin_amdgcn_sched_barrier(0);
#pragma unroll
                    for (int r = 0; r < 16; ++r) oA[d][r] *= al;
                    bf16x8 vf[4];
#pragma unroll
                    for (int s = 0; s < 4; ++s) { const s16x4 lo = vtr(vb_ + d * 4096 + s * 1024), hh = vtr(vb_ + d * 4096 + s * 1024 + 512); vf[s] = (bf16x8){lo[0], lo[1], lo[2], lo[3], hh[0], hh[1], hh[2], hh[3]}; }
#pragma unroll
                    for (int s = 0; s < 4; ++s) oA[d] = __builtin_amdgcn_mfma_f32_32x32x16_bf16(vf[s], pf[s], oA[d], 0, 0, 0);
                }
            } else if (DIFF) {
                if (resc) {
#pragma unroll
                    for (int d = 0; d < 2; ++d)
#pragma unroll
                        for (int r = 0; r < 16; ++r) oA[d][r] *= al;
                }
#pragma unroll
                for (int d = 0; d < 2; ++d) {
                    bf16x8 vf[4];
#pragma unroll
                    for (int s = 0; s < 4; ++s) { const s16x4 lo = vtr(vb_ + d * 4096 + s * 1024), hh = vtr(vb_ + d * 4096 + s * 1024 + 512); vf[s] = (bf16x8){lo[0], lo[1], lo[2], lo[3], hh[0], hh[1], hh[2], hh[3]}; }
                    __builtin_amdgcn_sched_barrier(0);
#pragma unroll
                    for (int s = 0; s < 4; ++s) oA[d] = __builtin_amdgcn_mfma_f32_32x32x16_bf16(vf[s], pf[s], oA[d], 0, 0, 0);
                }
            } else {
                bf16x8 vf[2][4];
#pragma unroll
                for (int d = 0; d < 2; ++d)
#pragma unroll
                    for (int s = 0; s < 4; ++s) { const s16x4 lo = vtr(vb_ + d * 4096 + s * 1024), hh = vtr(vb_ + d * 4096 + s * 1024 + 512); vf[d][s] = (bf16x8){lo[0], lo[1], lo[2], lo[3], hh[0], hh[1], hh[2], hh[3]}; }
                if (resc) {
#pragma unroll
                    for (int d = 0; d < 2; ++d)
#pragma unroll
                        for (int r = 0; r < 16; ++r) oA[d][r] *= al;
                }
                __builtin_amdgcn_sched_barrier(0);
#pragma unroll
                for (int s = 0; s < 4; ++s)
#pragma unroll
                    for (int d = 0; d < 2; ++d) oA[d] = __builtin_amdgcn_mfma_f32_32x32x16_bf16(vf[d][s], pf[s], oA[d], 0, 0, 0);
            }
        };
        if (CROSS) {
            gload(0); lstore(0);
            __syncthreads();
            for (int t = 0; t < NT; ++t) {
                const int buf = t & 1;
                f32x16 pa, pb;
                qk(buf, pa, pb, 0.f);
                const float al = sm(t, buf, pa, pb, false);
                pv(buf, pa, pb, al);
                if (t + 1 < NT) { gload(t + 1); lstore(buf ^ 1); }
                TILE_BAR();
            }
        } else {
            gload(0); lstore(0); gload(1); lstore(1);
            gload(2); gloadB(3);
            __syncthreads();
            if (DIFF) bias_far = ((LAS float*)(lds + C::BT))[128];
            const int NTW = (q0w + 31) / 64 + 1;
            constexpr bool lead = LEAD;
            f32x16 ca, cb, na, nb; bool cnear = isnear(0), nnear = false; float cal = 1.f;
            qk(0, ca, cb, (DIFF && !cnear) ? bias_far : 0.f);
            if (lead) cal = sm(0, 0, ca, cb, cnear);
            int s0 = 0, s1 = 1, s2 = 2;
            auto period = [&](int t, f32x16& xa, f32x16& xb, bool& xnear, f32x16& ya, f32x16& yb, bool& ynear) {
                const bool have_next = (t + 1 < NTW);
                if (lead) {
                    if (have_next) { ynear = isnear(s1); qk(s1, ya, yb, (DIFF && !ynear) ? bias_far : 0.f); }
                    if (t < NTW) pv(s0, xa, xb, cal);
                    if (have_next) cal = sm(t + 1, s1, ya, yb, ynear);
                } else {
                    if (t < NTW) cal = sm(t, s0, xa, xb, xnear);
                    if (have_next) { ynear = isnear(s1); qk(s1, ya, yb, (DIFF && !ynear) ? bias_far : 0.f); }
                    if (t < NTW) pv(s0, xa, xb, cal);
                }
                { const int tmp = s0; s0 = s1; s1 = s2; s2 = tmp; }
            };
            int t = 0;
            for (; t + 5 < NT; t += 2) {
                lstore(s2); gload(t + 4);
                period(t, ca, cb, cnear, na, nb, nnear);
                TILE_BAR();
                lstoreB(s2); gloadB(t + 5);
                period(t + 1, na, nb, nnear, ca, cb, cnear);
                TILE_BAR();
            }
            for (; t < NT; t += 2) {
                if (t + 2 < NT) { lstore(s2); if (t + 4 < NT) gload(t + 4); }
                period(t, ca, cb, cnear, na, nb, nnear);
                TILE_BAR();
                if (t + 3 < NT) { lstoreB(s2); if (t + 5 < NT) gloadB(t + 5); }
                period(t + 1, na, nb, nnear, ca, cb, cnear);
                TILE_BAR();
            }
        }
        il = 1.f / swapadd(l1);
        if (DIFF) { if (mp == 0) {
#pragma unroll
            for (int d = 0; d < 2; ++d)
#pragma unroll
                for (int r = 0; r < 16; ++r) osv[(d * 16 + r) * 64] = oA[d][r] * il; } }
    }
    GAS bf16* orow = P.O + (rowb + qi) * P.op + (CROSS ? h * 256 + dhalf * 128 : h * 64);
    if (!DIFF) {
#pragma unroll
        for (int d = 0; d < ND; ++d)
#pragma unroll
            for (int g = 0; g < 4; ++g) { v2u v; v.x = cvtpk(oA[d][4 * g] * il, oA[d][4 * g + 1] * il); v.y = cvtpk(oA[d][4 * g + 2] * il, oA[d][4 * g + 3] * il); *(GAS v2u*)(orow + 32 * d + 8 * g + 4 * hi) = v; }
    } else {
        const float lam = P.lams[0], lam_init = P.lams[1];
        const float i2 = lam * il;
        float ss = 0.f;
#pragma unroll
        for (int d = 0; d < 2; ++d)
#pragma unroll
            for (int r = 0; r < 16; ++r) { const float v = osv[(d * 16 + r) * 64] - oA[d][r] * i2; oA[d][r] = v; ss += v * v; }
        ss = swapadd(ss);
        const float rs = __builtin_amdgcn_rsqf(ss * (1.f / 64.f) + 1e-6f) * (1.f - lam_init);
        const LAS float* dn = (const LAS float*)(lds + C::DN);
#pragma unroll
        for (int d = 0; d < 2; ++d)
#pragma unroll
            for (int g = 0; g < 4; ++g) { const int c = 32 * d + 8 * g + 4 * hi; const f32x4 gn = *(const LAS f32x4*)(dn + c);
                v2u v; v.x = cvtpk(oA[d][4 * g] * rs * gn[0], oA[d][4 * g + 1] * rs * gn[1]); v.y = cvtpk(oA[d][4 * g + 2] * rs * gn[2], oA[d][4 * g + 3] * rs * gn[3]); *(GAS v2u*)(orow + c) = v; }
    }
}

__device__ __forceinline__ int wave_max_i(int v) {
    { const int o = __builtin_amdgcn_update_dpp(0, v, 0xB1, 0xF, 0xF, true); v = o > v ? o : v; }
    { const int o = __builtin_amdgcn_update_dpp(0, v, 0x4E, 0xF, 0xF, true); v = o > v ? o : v; }
    { const int o = __builtin_amdgcn_update_dpp(0, v, 0x141, 0xF, 0xF, true); v = o > v ? o : v; }
    { const int o = __builtin_amdgcn_update_dpp(0, v, 0x140, 0xF, 0xF, true); v = o > v ? o : v; }
    { int a = v, b = v; asm volatile("v_nop\n\tv_nop\n\tv_permlane16_swap_b32 %0, %1" : "+v"(a), "+v"(b)); v = a > b ? a : b; }
    { int a = v, b = v; asm volatile("v_nop\n\tv_nop\n\tv_permlane32_swap_b32 %0, %1" : "+v"(a), "+v"(b)); v = a > b ? a : b; }
    return v;
}
template <int KIND> struct AK2 {
    static constexpr bool DIFF = KIND == 1;
    static constexpr int HW = KIND == 0 ? 96 : 64, NKS = KIND == 0 ? 6 : 2, KP = KIND == 0 ? 208 : 144;
    static constexpr int CPK = HW / 8, KCH = (128 * CPK) / 512, VCH = 2;
    static constexpr int KB = 128 * KP, VB = 2 * 8192;
    static constexpr int K0 = 0, V0 = 2 * KB, POS = V0 + 2 * VB, PMX = POS + 1024, BT = PMX + 16, DN = BT + 528, OSV = (DN + 256 + 15) & ~15, END = OSV + (DIFF ? 8 * 8192 : 0);
};
static_assert(AK2<0>::END <= RING_BYTES && AK2<1>::END <= RING_BYTES, "attention LDS (128-key tiles)");
template <int KIND>
__device__ __forceinline__ void attn_unit2(const AttnP& P, int b, int h, int qb, LAS unsigned char* lds, int tid, int wave, int lane) {
    lane = lane_id_v(); tid = (wave << 6) | lane;
    typedef AK2<KIND> C;
    constexpr bool DIFF = C::DIFF;
    constexpr int HW = C::HW, NKS = C::NKS, KP = C::KP, CPK = C::CPK, KCH = C::KCH, VCH = C::VCH;
    const int r32 = lane & 31, hi = lane >> 5;
    const size_t rowb = (size_t)b * S;
    const int q0w = qb * 256 + wave * 32, qi = q0w + r32;
    int pq = 0; float bias_far = 0.f;
    __syncthreads();
    if (DIFF) {
        pq = P.pos[rowb + qi];
        if (tid < 129) ((LAS float*)(lds + C::BT))[tid] = P.btab[h * 129 + tid];
        if (tid >= 192 && tid < 256) ((LAS float*)(lds + C::DN))[tid - 192] = P.dnorm[tid - 192];
    }
    int minq = pq;
    if (DIFF) minq = __builtin_amdgcn_readfirstlane(-wave_max_i(-pq));
    const int NT = 2 * (qb + 1);
    const GAS bf16* Kb = P.K + rowb * P.kp + h * HW; const GAS bf16* Vb = P.V + rowb * P.vp + h * 64;
    const __amdgpu_buffer_rsrc_t rK = __builtin_amdgcn_make_buffer_rsrc((void*)Kb, 0, 0x7fffffff, 0x00020000), rV = __builtin_amdgcn_make_buffer_rsrc((void*)Vb, 0, 0x7fffffff, 0x00020000);
    const __amdgpu_buffer_rsrc_t rP = __builtin_amdgcn_make_buffer_rsrc((void*)(DIFF ? P.pos + rowb : (const GAS int*)Kb), 0, 0x7fffffff, 0x00020000);
    int kvo[KCH], vvo[VCH], klo[KCH], vlo[VCH];
#pragma unroll
    for (int i = 0; i < KCH; ++i) { const int c = tid + 512 * i; kvo[i] = ((c / CPK) * P.kp + (c % CPK) * 8) * 2; klo[i] = (c / CPK) * KP + (c % CPK) * 16; }
#pragma unroll
    for (int i = 0; i < VCH; ++i) { const int c = tid + 512 * i; const int key = c >> 3, part = c & 7; vvo[i] = (key * P.vp + part * 8) * 2; vlo[i] = (part >> 2) * 8192 + (key >> 3) * 512 + (key & 7) * 64 + (part & 3) * 16; }
    const int pvo = (tid & 127) * 4;
    u32x4 kr[KCH], vr[VCH]; int pkr = 0;
    auto gload = [&](int t) {
        const int ks = __builtin_amdgcn_readfirstlane(128 * t * P.kp * 2), vs = __builtin_amdgcn_readfirstlane(128 * t * P.vp * 2);
#pragma unroll
        for (int i = 0; i < KCH; ++i) kr[i] = __builtin_amdgcn_raw_buffer_load_b128(rK, kvo[i], ks, 0);
#pragma unroll
        for (int i = 0; i < VCH; ++i) vr[i] = __builtin_amdgcn_raw_buffer_load_b128(rV, vvo[i], vs, 0);
        if (DIFF) pkr = __builtin_amdgcn_raw_buffer_load_b32(rP, pvo, __builtin_amdgcn_readfirstlane(128 * t * 4), 0);
    };
    auto lstore = [&](int buf) {
        LAS unsigned char* kb_ = lds + C::K0 + buf * C::KB; LAS unsigned char* vb_ = lds + C::V0 + buf * C::VB;
#pragma unroll
        for (int i = 0; i < KCH; ++i) *(LAS u32x4*)(kb_ + klo[i]) = kr[i];
#pragma unroll
        for (int i = 0; i < VCH; ++i) *(LAS u32x4*)(vb_ + vlo[i]) = vr[i];
        if (DIFF) { ((LAS int*)(lds + C::POS + buf * 512))[tid & 127] = pkr;
            if (tid < 128) { const int mk_ = wave_max_i(pkr); if (lane == 0) ((LAS int*)(lds + C::PMX))[buf * 2 + wave] = mk_; } }
    };
    LAS float* osv = (LAS float*)(lds + C::OSV) + wave * 2048 + lane;
    float il = 0.f;
    f32x16 oA[2];
#pragma unroll 1
    for (int mp = 0; mp < (DIFF ? 2 : 1); ++mp) {
        bf16x8 qf[NKS];
        { const GAS bf16* qrow = P.Q + (rowb + qi) * P.qp + h * HW + mp * 32;
#pragma unroll
          for (int s = 0; s < NKS; ++s) qf[s] = *(const GAS bf16x8*)(qrow + 16 * s + 8 * hi);
          if (KIND == 0) {
              const GAS float* rp = P.rope + (rowb + qi) * 32 + 8 * hi;
              const f32x4 c0 = *(const GAS f32x4*)rp, c1 = *(const GAS f32x4*)(rp + 4), s0 = *(const GAS f32x4*)(rp + 16), s1 = *(const GAS f32x4*)(rp + 20);
              const u32x4 a = __builtin_bit_cast(u32x4, qf[NKS - 2]), bq = __builtin_bit_cast(u32x4, qf[NKS - 1]); u32x4 ra, rb;
#pragma unroll
              for (int w = 0; w < 4; ++w) { const float cl = w < 2 ? c0[2 * w] : c1[2 * w - 4], ch = w < 2 ? c0[2 * w + 1] : c1[2 * w - 3], sl = w < 2 ? s0[2 * w] : s1[2 * w - 4], sh = w < 2 ? s0[2 * w + 1] : s1[2 * w - 3];
                  const float x1l = bflo(a[w]), x1h = bfhi(a[w]), x2l = bflo(bq[w]), x2h = bfhi(bq[w]);
                  ra[w] = cvtpk(x1l * cl - x2l * sl, x1h * ch - x2h * sh); rb[w] = cvtpk(x1l * sl + x2l * cl, x1h * sh + x2h * ch); }
              qf[NKS - 2] = __builtin_bit_cast(bf16x8, ra); qf[NKS - 1] = __builtin_bit_cast(bf16x8, rb);
          } }
        __syncthreads();
        float m1 = 0.f, l1 = 0.f;
        f32x16 negm;
#pragma unroll
        for (int r = 0; r < 16; ++r) negm[r] = 0.f;
#pragma unroll
        for (int d = 0; d < 2; ++d)
#pragma unroll
            for (int r = 0; r < 16; ++r) oA[d][r] = 0.f;
        gload(0); lstore(0);
        if (NT > 1) gload(1);
        __syncthreads();
        if (DIFF) { bias_far = ((LAS float*)(lds + C::BT))[128];
#pragma unroll
            for (int r = 0; r < 16; ++r) negm[r] = bias_far; }
        const int NTW = (q0w + 31) / 128 + 1;
        auto compute = [&](int t, int buf) {
            const int k0 = 128 * t;
            const LAS unsigned char* kb_ = lds + C::K0 + buf * C::KB + r32 * KP + hi * 16 + mp * 64;
            const LAS unsigned char* vb_ = lds + C::V0 + buf * C::VB + ((lane >> 4) & 1) * 32 + (lane & 3) * 8 + (4 * hi + ((lane & 15) >> 2)) * 64;
            bool nearb = false;
            if (DIFF) { const LAS int* pm = (const LAS int*)(lds + C::PMX) + buf * 2; const int m0 = __builtin_amdgcn_readfirstlane(pm[0]), m1_ = __builtin_amdgcn_readfirstlane(pm[1]); nearb = (minq - (m0 > m1_ ? m0 : m1_)) < 128; }
            f32x16 sc[4];
            if (DIFF) { if (nearb) {
#pragma unroll
                for (int g = 0; g < 4; ++g)
#pragma unroll
                    for (int r = 0; r < 16; ++r) sc[g][r] = -m1; } }
            constexpr int HB = NKS > 3 ? 3 : NKS;
#pragma unroll
            for (int s0_ = 0; s0_ < NKS; s0_ += HB) {
                bf16x8 kf[4][HB];
#pragma unroll
                for (int g = 0; g < 4; ++g)
#pragma unroll
                    for (int s = 0; s < HB; ++s) kf[g][s] = *(const LAS bf16x8*)(kb_ + 32 * g * KP + (s0_ + s) * 32);
                __builtin_amdgcn_sched_barrier(0);
#pragma unroll
                for (int s = 0; s < HB; ++s)
#pragma unroll
                    for (int g = 0; g < 4; ++g) {
                        if (s0_ + s == 0 && !(DIFF && nearb)) sc[g] = __builtin_amdgcn_mfma_f32_32x32x16_bf16(kf[g][s], qf[s0_ + s], negm, 0, 0, 0);
                        else sc[g] = __builtin_amdgcn_mfma_f32_32x32x16_bf16(kf[g][s], qf[s0_ + s], sc[g], 0, 0, 0); }
                __builtin_amdgcn_sched_barrier(0);
            }
            if (DIFF) { if (nearb) {
                const LAS int* pk = (const LAS int*)(lds + C::POS + buf * 512); const LAS float* bt = (const LAS float*)(lds + C::BT);
#pragma unroll
                for (int g = 0; g < 4; ++g)
#pragma unroll
                    for (int r = 0; r < 16; ++r) { int n0 = pq - pk[32 * g + crow(r, hi)]; n0 = n0 < 0 ? 0 : (n0 > 128 ? 128 : n0); sc[g][r] += bt[n0]; }
            } }
            asm volatile("s_nop 15\n\ts_nop 7" : "+v"(sc[0]), "+v"(sc[1]), "+v"(sc[2]), "+v"(sc[3]));
            if (k0 + 127 > q0w) {
#pragma unroll
                for (int g = 0; g < 4; ++g)
#pragma unroll
                    for (int r = 0; r < 16; ++r) { if (k0 + 32 * g + crow(r, hi) > qi) sc[g][r] = -1e30f; }
            }
            const float mx = swapmax(vmax3(max32(sc[0], sc[1]), max32(sc[2], sc[3]), -1e30f));
            const bool up = (t == 0) || mx > 8.0f;
            float al = 1.f;
            if (__builtin_amdgcn_ballot_w64(up) != 0ull) {
                const float dl = up ? mx : 0.f; al = __builtin_amdgcn_exp2f(-dl); l1 *= al; m1 += dl;
#pragma unroll
                for (int r = 0; r < 16; ++r) negm[r] -= dl;
#pragma unroll
                for (int g = 0; g < 4; ++g)
#pragma unroll
                    for (int r = 0; r < 16; ++r) sc[g][r] -= dl;
            }
            float ls = 0.f;
#pragma unroll
            for (int g = 0; g < 4; ++g)
#pragma unroll
                for (int r = 0; r < 16; ++r) { sc[g][r] = __builtin_amdgcn_exp2f(sc[g][r]); ls += sc[g][r]; }
            l1 += ls;
            bf16x8 pf[8];
#pragma unroll
            for (int g = 0; g < 4; ++g) { pf[2 * g] = pack8(sc[g], 0); pf[2 * g + 1] = pack8(sc[g], 8); }
            if (__builtin_amdgcn_ballot_w64(al != 1.0f) != 0ull) {
#pragma unroll
                for (int d = 0; d < 2; ++d)
#pragma unroll
                    for (int r = 0; r < 16; ++r) oA[d][r] *= al;
            }
#pragma unroll
            for (int d = 0; d < 2; ++d) {
                bf16x8 vf[8];
#pragma unroll
                for (int s = 0; s < 8; ++s) { const s16x4 lo = vtr(vb_ + d * 8192 + s * 1024), hh = vtr(vb_ + d * 8192 + s * 1024 + 512); vf[s] = (bf16x8){lo[0], lo[1], lo[2], lo[3], hh[0], hh[1], hh[2], hh[3]}; }
                __builtin_amdgcn_sched_barrier(0);
#pragma unroll
                for (int s = 0; s < 8; ++s) oA[d] = __builtin_amdgcn_mfma_f32_32x32x16_bf16(vf[s], pf[s], oA[d], 0, 0, 0);
                __builtin_amdgcn_sched_barrier(0);
            }
        };
        int t = 0;
        for (; t + 2 < NT; ++t) {
            const int buf = t & 1;
            if (t < NTW) compute(t, buf);
            lstore(buf ^ 1); gload(t + 2);
            TILE_BAR();
        }
        for (; t < NT; ++t) {
            const int buf = t & 1;
            if (t < NTW) compute(t, buf);
            if (t + 1 < NT) lstore(buf ^ 1);
            TILE_BAR();
        }
        il = 1.f / swapadd(l1);
        if (DIFF) { if (mp == 0) {
#pragma unroll
            for (int d = 0; d < 2; ++d)
#pragma unroll
                for (int r = 0; r < 16; ++r) osv[(d * 16 + r) * 64] = oA[d][r] * il; } }
    }
    GAS bf16* orow = P.O + (rowb + qi) * P.op + h * 64;
    if (!DIFF) {
#pragma unroll
        for (int d = 0; d < 2; ++d)
#pragma unroll
            for (int g = 0; g < 4; ++g) { v2u v; v.x = cvtpk(oA[d][4 * g] * il, oA[d][4 * g + 1] * il); v.y = cvtpk(oA[d][4 * g + 2] * il, oA[d][4 * g + 3] * il); *(GAS v2u*)(orow + 32 * d + 8 * g + 4 * hi) = v; }
    } else {
        const float lam = P.lams[0], lam_init = P.lams[1];
        const float i2 = lam * il;
        float ss = 0.f;
#pragma unroll
        for (int d = 0; d < 2; ++d)
#pragma unroll
            for (int r = 0; r < 16; ++r) { const float v = osv[(d * 16 + r) * 64] - oA[d][r] * i2; oA[d][r] = v; ss += v * v; }
        ss = swapadd(ss);
        const float rs = __builtin_amdgcn_rsqf(ss * (1.f / 64.f) + 1e-6f) * (1.f - lam_init);
        const LAS float* dn = (const LAS float*)(lds + C::DN);
#pragma unroll
        for (int d = 0; d < 2; ++d)
#pragma unroll
            for (int g = 0; g < 4; ++g) { const int c = 32 * d + 8 * g + 4 * hi; const f32x4 gn = *(const LAS f32x4*)(dn + c);
                v2u v; v.x = cvtpk(oA[d][4 * g] * rs * gn[0], oA[d][4 * g + 1] * rs * gn[1]); v.y = cvtpk(oA[d][4 * g + 2] * rs * gn[2], oA[d][4 * g + 3] * rs * gn[3]); *(GAS v2u*)(orow + c) = v; }
    }
}

__device__ __forceinline__ void attn_phase(const AttnP& PM, const AttnP& PD, LAS unsigned char* lds, int tid, int wave, int lane, int vcu, int G, int only = -1) {
    for (int i = vcu; i < 512; i += G) {
        if (only >= 0 && (i >> 8) != only) continue;
        const int kind = i >> 8, c = i & 255, bh = c >> 4, s = c & 15;
        if (kind == 0) {
#pragma unroll 1
            for (int k = 0; k < 2; ++k) attn_unit2<0>(PM, bh >> 2, bh & 3, k ? 31 - s : s, lds, tid, wave, lane);
        } else {
#pragma unroll 1
            for (int k = 0; k < 2; ++k) attn_unit2<1>(PD, bh >> 2, bh & 3, k ? 31 - s : s, lds, tid, wave, lane);
        }
    }
}
__device__ __forceinline__ float cx_max16(const f32x16& p) { return fmaxf(fmaxf(fmaxf(fmaxf(p[0], p[1]), fmaxf(p[2], p[3])), fmaxf(fmaxf(p[4], p[5]), fmaxf(p[6], p[7]))), fmaxf(fmaxf(fmaxf(p[8], p[9]), fmaxf(p[10], p[11])), fmaxf(fmaxf(p[12], p[13]), fmaxf(p[14], p[15])))); }
__device__ __forceinline__ void cross_unit2(const AttnP& P, int b, int h, int qb, LAS unsigned char* lds, int wave) {
    const int lane = lane_id_v(), tid = (wave << 6) | lane;
    constexpr int KP = 528;
    const int r32 = lane & 31, hi = lane >> 5;
    const size_t rowb = (size_t)b * S, rowk = (size_t)b * MEM;
    const int qi = qb * 256 + wave * 32 + r32;
    const GAS bf16* Kb = P.K + rowk * P.kp + h * 256; const GAS bf16* Vb = P.V + rowk * P.vp + h * 256;
    const __amdgpu_buffer_rsrc_t rK = __builtin_amdgcn_make_buffer_rsrc((void*)Kb, 0, 0x7fffffff, 0x00020000), rV = __builtin_amdgcn_make_buffer_rsrc((void*)Vb, 0, 0x7fffffff, 0x00020000);
    const GAS bf16* qrow = P.Q + (rowb + qi) * P.qp + h * 256 + 8 * hi;
    bf16x8 qf[4];
#pragma unroll
    for (int s = 0; s < 4; ++s) qf[s] = *(const GAS bf16x8*)(qrow + 16 * s);
    { u32x4 st[16];
#pragma unroll
      for (int i = 0; i < 16; ++i) { const int c = tid + 512 * i; st[i] = __builtin_amdgcn_raw_buffer_load_b128(rK, ((c >> 5) * P.kp + (c & 31) * 8) * 2, 0, 0); }
      TILE_BAR();
#pragma unroll
      for (int i = 0; i < 16; ++i) { const int c = tid + 512 * i; *(LAS u32x4*)(lds + (c >> 5) * KP + (c & 31) * 16) = st[i]; } }
    __syncthreads();
    f32x16 sc[8];
#pragma unroll
    for (int g = 0; g < 8; ++g)
#pragma unroll
        for (int r = 0; r < 16; ++r) sc[g][r] = 0.f;
    const LAS unsigned char* kb_ = lds + r32 * KP + hi * 16;
#pragma unroll
    for (int c = 0; c < 4; ++c) {
        bf16x8 qn[4];
        if (c + 1 < 4) {
#pragma unroll
            for (int s = 0; s < 4; ++s) qn[s] = *(const GAS bf16x8*)(qrow + 64 * (c + 1) + 16 * s); }
#pragma unroll
        for (int g = 0; g < 8; ++g) { bf16x8 kf[4];
#pragma unroll
            for (int s = 0; s < 4; ++s) kf[s] = *(const LAS bf16x8*)(kb_ + 32 * g * KP + (4 * c + s) * 32);
#pragma unroll
            for (int s = 0; s < 4; ++s) sc[g] = __builtin_amdgcn_mfma_f32_32x32x16_bf16(kf[s], qf[s], sc[g], 0, 0, 0); }
        if (c + 1 < 4) {
#pragma unroll
            for (int s = 0; s < 4; ++s) qf[s] = qn[s]; }
    }
    float m = fmaxf(fmaxf(fmaxf(cx_max16(sc[0]), cx_max16(sc[1])), fmaxf(cx_max16(sc[2]), cx_max16(sc[3]))), fmaxf(fmaxf(cx_max16(sc[4]), cx_max16(sc[5])), fmaxf(cx_max16(sc[6]), cx_max16(sc[7]))));
    m = swapmax(m);
    float l = 0.f;
    bf16x8 pf[16];
#pragma unroll
    for (int g = 0; g < 8; ++g) {
#pragma unroll
        for (int r = 0; r < 16; ++r) { sc[g][r] = __builtin_amdgcn_exp2f(sc[g][r] - m); l += sc[g][r]; }
        pf[2 * g] = pack8(sc[g], 0); pf[2 * g + 1] = pack8(sc[g], 8); }
    const float il = 1.f / swapadd(l);
    { u32x4 st[16];
#pragma unroll
      for (int i = 0; i < 16; ++i) { const int c = tid + 512 * i; const int sub = c & 3, key = (c >> 2) & 255, dt = c >> 10; st[i] = __builtin_amdgcn_raw_buffer_load_b128(rV, (key * P.vp + dt * 32 + sub * 8) * 2, 0, 0); }
      TILE_BAR();
#pragma unroll
      for (int i = 0; i < 16; ++i) { const int c = tid + 512 * i; const int sub = c & 3, key = (c >> 2) & 255, dt = c >> 10; *(LAS u32x4*)(lds + dt * 16384 + (key >> 3) * 512 + (key & 7) * 64 + sub * 16) = st[i]; } }
    __syncthreads();
    const LAS unsigned char* vb_ = lds + ((lane >> 4) & 1) * 32 + (lane & 3) * 8 + (4 * hi + ((lane & 15) >> 2)) * 64;
    GAS bf16* orow = P.O + (rowb + qi) * P.op + h * 256;
#pragma unroll 1
    for (int dh = 0; dh < 2; ++dh) {
        f32x16 oA[4];
#pragma unroll
        for (int d = 0; d < 4; ++d)
#pragma unroll
            for (int r = 0; r < 16; ++r) oA[d][r] = 0.f;
#pragma unroll
        for (int d = 0; d < 4; ++d) {
#pragma unroll
            for (int sb = 0; sb < 2; ++sb) { bf16x8 vf[8];
#pragma unroll
                for (int s = 0; s < 8; ++s) { const s16x4 lo = vtr(vb_ + (4 * dh + d) * 16384 + (8 * sb + s) * 1024), hh = vtr(vb_ + (4 * dh + d) * 16384 + (8 * sb + s) * 1024 + 512); vf[s] = (bf16x8){lo[0], lo[1], lo[2], lo[3], hh[0], hh[1], hh[2], hh[3]}; }
#pragma unroll
                for (int s = 0; s < 8; ++s) oA[d] = __builtin_amdgcn_mfma_f32_32x32x16_bf16(vf[s], pf[8 * sb + s], oA[d], 0, 0, 0); } }
#pragma unroll
        for (int d = 0; d < 4; ++d)
#pragma unroll
            for (int g = 0; g < 4; ++g) { v2u v; v.x = cvtpk(oA[d][4 * g] * il, oA[d][4 * g + 1] * il); v.y = cvtpk(oA[d][4 * g + 2] * il, oA[d][4 * g + 3] * il); *(GAS v2u*)(orow + 128 * dh + 32 * d + 8 * g + 4 * hi) = v; }
    }
}
__device__ __forceinline__ void cross_phase(const AttnP& PC, LAS unsigned char* lds, int tid, int wave, int lane, int vcu, int G) {
#pragma unroll 1
    for (int i = vcu; i < 512; i += G) { const int bh = i >> 5; cross_unit2(PC, bh >> 2, bh & 3, i & 31, lds, wave); }
}


__device__ __forceinline__ float vmax2(float a, float b) { float r; asm("v_max_f32_e32 %0, %1, %2" : "=v"(r) : "v"(a), "v"(b)); return r; }
__device__ __forceinline__ float vmin2(float a, float b) { float r; asm("v_min_f32_e32 %0, %1, %2" : "=v"(r) : "v"(a), "v"(b)); return r; }
__device__ __forceinline__ void pad16(float (&a)[16]) {
    asm volatile("s_nop 1" : "+v"(a[0]), "+v"(a[1]), "+v"(a[2]), "+v"(a[3]), "+v"(a[4]), "+v"(a[5]), "+v"(a[6]), "+v"(a[7]), "+v"(a[8]), "+v"(a[9]), "+v"(a[10]), "+v"(a[11]), "+v"(a[12]), "+v"(a[13]), "+v"(a[14]), "+v"(a[15]));
}
__device__ __forceinline__ void sort16_desc(float (&a)[16]) {
#pragma unroll
    for (int k = 2; k <= 16; k <<= 1)
#pragma unroll
        for (int j = k >> 1; j > 0; j >>= 1)
#pragma unroll
            for (int i = 0; i < 16; ++i) { const int l = i ^ j; if (l > i) { const bool desc = ((i & k) == 0); const float hi_ = vmax2(a[i], a[l]), lo_ = vmin2(a[i], a[l]); a[i] = desc ? hi_ : lo_; a[l] = desc ? lo_ : hi_; } }
}
__device__ __forceinline__ void merge16_desc(float (&a)[16], const float (&b)[16]) {
#pragma unroll
    for (int i = 0; i < 16; ++i) a[i] = vmax2(a[i], b[15 - i]);
#pragma unroll
    for (int j = 8; j > 0; j >>= 1)
#pragma unroll
        for (int i = 0; i < 16; ++i) { const int l = i ^ j; if (l > i) { const float hi_ = vmax2(a[i], a[l]), lo_ = vmin2(a[i], a[l]); a[i] = hi_; a[l] = lo_; } }
}
__device__ __forceinline__ void top16_of_64(float (&g0)[16], float (&g1)[16], float (&g2)[16], float (&g3)[16]) {
    sort16_desc(g0); sort16_desc(g1); merge16_desc(g0, g1); sort16_desc(g2); sort16_desc(g3); merge16_desc(g2, g3); merge16_desc(g0, g2);
}
__device__ __forceinline__ float embed(float v, unsigned mask, unsigned id) { return __builtin_bit_cast(float, (__builtin_bit_cast(unsigned, v) & mask) | id); }
__device__ __forceinline__ float mkcand(float x, float y, unsigned id) { return embed(x + y, 0xFFFFFF00u, id); }

__device__ __forceinline__ void swap32(float& a, float& b) { asm volatile("v_nop\n\tv_nop\n\tv_permlane32_swap_b32 %0, %1" : "+v"(a), "+v"(b)); }
struct RouteP { const GAS bf16* QP; const GAS bf16* keys; GAS int* EX; GAS float* GW; };
constexpr int RT_KP = 144, RT_KEYS = 0, RT_SCR = 256 * RT_KP, RT_END = RT_SCR + 8 * 8192;
__device__ __forceinline__ void route_phase(const RouteP& P, LAS unsigned char* lds, int tid, int wave, int lane, int vcu, int G) {
    asm volatile("" : "+v"(tid), "+v"(lane));
    __syncthreads();
    for (int c = tid; c < 256 * 8; c += 512) { const int row = c >> 3, part = c & 7; *(LAS u32x4*)(lds + RT_KEYS + row * RT_KP + part * 16) = *(const u32x4*)(P.keys + row * 64 + part * 8); }
    __syncthreads();
    const int r32 = lane & 31, hi = lane >> 5;
    LAS int* scr = (LAS int*)(lds + RT_SCR + wave * 8192);
    for (int u = vcu; u < T / 32; u += G) {
        const size_t t = (size_t)u * 32 + r32; const int h = wave;
        float T2[2][16];
#pragma unroll
        for (int c = 0; c < 2; ++c) {
            bf16x8 qf[4];
            { const GAS bf16* q = P.QP + t * 1024 + h * 128 + c * 64 + 8 * hi;
#pragma unroll
              for (int s = 0; s < 4; ++s) qf[s] = *(const GAS bf16x8*)(q + 16 * s); }
            f32x16 sc[4];
#pragma unroll
            for (int m = 0; m < 4; ++m) {
#pragma unroll
                for (int r = 0; r < 16; ++r) sc[m][r] = 0.f;
#pragma unroll
                for (int s = 0; s < 4; ++s) { const bf16x8 a = *(const LAS bf16x8*)(lds + RT_KEYS + (c * 128 + 32 * m + r32) * RT_KP + s * 32 + hi * 16);
                    sc[m] = __builtin_amdgcn_mfma_f32_32x32x16_bf16(a, qf[s], sc[m], 0, 0, 0); }
            }
            float g0[16], g1[16], g2[16], g3[16];
            const unsigned h4 = 4u * (unsigned)hi;
#pragma unroll
            for (int r = 0; r < 16; ++r) { const unsigned kr_ = (unsigned)((r & 3) + 8 * (r >> 2));
                g0[r] = embed(sc[0][r], 0xFFFFFF80u, kr_ | h4); g1[r] = embed(sc[1][r], 0xFFFFFF80u, (32u + kr_) | h4); g2[r] = embed(sc[2][r], 0xFFFFFF80u, (64u + kr_) | h4); g3[r] = embed(sc[3][r], 0xFFFFFF80u, (96u + kr_) | h4); }
            top16_of_64(g0, g1, g2, g3);
            pad16(g0);
#pragma unroll
            for (int i = 0; i < 16; ++i) T2[c][i] = g0[i];
        }
        float A[16], Bv[16];
#pragma unroll
        for (int i = 0; i < 16; ++i) { A[i] = T2[0][i]; Bv[i] = T2[1][i]; swap32(A[i], Bv[i]); }
        merge16_desc(A, Bv);
        pad16(A);
        float T0[16], T1[16];
#pragma unroll
        for (int i = 0; i < 16; ++i) { T0[i] = A[i]; T1[i] = A[i]; swap32(T0[i], T1[i]); }
#pragma unroll
        for (int i = 0; i < 16; ++i) { scr[i * 64 + lane] = (int)(__builtin_bit_cast(unsigned, T0[i]) & 127u); scr[(16 + i) * 64 + lane] = (int)(__builtin_bit_cast(unsigned, T1[i]) & 127u);
            T0[i] = embed(T0[i], 0xFFFFFF80u, 0u); T1[i] = embed(T1[i], 0xFFFFFF80u, 0u); }
        float c0[16], c1[16], c2[16], c3[16];
        const float NINF = -__builtin_inff();
#pragma unroll
        for (int b = 0; b < 16; ++b) c0[b] = mkcand(T0[0], T1[b], (unsigned)b);
#pragma unroll
        for (int b = 0; b < 8; ++b) c1[b] = mkcand(T0[1], T1[b], 16u + b);
#pragma unroll
        for (int b = 0; b < 5; ++b) c1[8 + b] = mkcand(T0[2], T1[b], 32u + b);
#pragma unroll
        for (int b = 0; b < 3; ++b) c1[13 + b] = mkcand(T0[4], T1[b], 64u + b);
#pragma unroll
        for (int b = 0; b < 4; ++b) c2[b] = mkcand(T0[3], T1[b], 48u + b);
        c2[4] = mkcand(T0[5], T1[0], 80u); c2[5] = mkcand(T0[5], T1[1], 81u); c2[6] = mkcand(T0[6], T1[0], 96u); c2[7] = mkcand(T0[6], T1[1], 97u); c2[8] = mkcand(T0[7], T1[0], 112u); c2[9] = mkcand(T0[7], T1[1], 113u);
#pragma unroll
        for (int a = 8; a < 14; ++a) c2[10 + a - 8] = mkcand(T0[a], T1[0], 16u * a);
        c3[0] = mkcand(T0[14], T1[0], 224u); c3[1] = mkcand(T0[15], T1[0], 240u);
#pragma unroll
        for (int i = 2; i < 16; ++i) c3[i] = NINF;
        top16_of_64(c0, c1, c2, c3);
        pad16(c0);
        float gsum = 0.f, ge[16]; int ex[16];
        const float mtop = embed(c0[0], 0xFFFFFF00u, 0u);
#pragma unroll
        for (int i = 0; i < 16; ++i) { const unsigned bits = __builtin_bit_cast(unsigned, c0[i]); const int a = (bits >> 4) & 15, b = bits & 15;
            ge[i] = __builtin_amdgcn_exp2f((embed(c0[i], 0xFFFFFF00u, 0u) - mtop) * LOG2E); gsum += ge[i];
            ex[i] = scr[a * 64 + lane] * 128 + scr[(16 + b) * 64 + lane]; }
        const float ginv = __builtin_amdgcn_rcpf(gsum);
        if (hi == 0) { GAS v4u* d = (GAS v4u*)(P.EX + t * 128 + h * 16);
#pragma unroll
            for (int i = 0; i < 4; ++i) d[i] = (v4u){(unsigned)ex[4 * i], (unsigned)ex[4 * i + 1], (unsigned)ex[4 * i + 2], (unsigned)ex[4 * i + 3]}; }
        else { GAS f32x4* d = (GAS f32x4*)(P.GW + t * 128 + h * 16);
#pragma unroll
            for (int i = 0; i < 4; ++i) d[i] = (f32x4){ge[4 * i] * ginv, ge[4 * i + 1] * ginv, ge[4 * i + 2] * ginv, ge[4 * i + 3] * ginv}; }
    }
}

__device__ __forceinline__ int wave_allsum_i(int v) {
    v += __builtin_amdgcn_update_dpp(0, v, 0xB1, 0xF, 0xF, true);
    v += __builtin_amdgcn_update_dpp(0, v, 0x4E, 0xF, 0xF, true);
    v += __builtin_amdgcn_update_dpp(0, v, 0x141, 0xF, 0xF, true);
    v += __builtin_amdgcn_update_dpp(0, v, 0x140, 0xF, 0xF, true);
    { int a = v, b = v; asm volatile("v_nop\n\tv_nop\n\tv_permlane16_swap_b32 %0, %1" : "+v"(a), "+v"(b)); v = a + b; }
    { int a = v, b = v; asm volatile("v_nop\n\tv_nop\n\tv_permlane32_swap_b32 %0, %1" : "+v"(a), "+v"(b)); v = a + b; }
    return v;
}
__device__ __forceinline__ float wave_allsum(float v) {
    v += __builtin_bit_cast(float, __builtin_amdgcn_update_dpp(0, __builtin_bit_cast(int, v), 0xB1, 0xF, 0xF, true));
    v += __builtin_bit_cast(float, __builtin_amdgcn_update_dpp(0, __builtin_bit_cast(int, v), 0x4E, 0xF, 0xF, true));
    v += __builtin_bit_cast(float, __builtin_amdgcn_update_dpp(0, __builtin_bit_cast(int, v), 0x141, 0xF, 0xF, true));
    v += __builtin_bit_cast(float, __builtin_amdgcn_update_dpp(0, __builtin_bit_cast(int, v), 0x140, 0xF, 0xF, true));
    { float a = v, b = v; asm volatile("v_nop\n\tv_nop\n\tv_permlane16_swap_b32 %0, %1" : "+v"(a), "+v"(b)); v = a + b; }
    { float a = v, b = v; asm volatile("v_nop\n\tv_nop\n\tv_permlane32_swap_b32 %0, %1" : "+v"(a), "+v"(b)); v = a + b; }
    return v;
}
__device__ __forceinline__ float wave_allmax(float v) {
    v = fmaxf(v, __builtin_bit_cast(float, __builtin_amdgcn_update_dpp(0, __builtin_bit_cast(int, v), 0xB1, 0xF, 0xF, true)));
    v = fmaxf(v, __builtin_bit_cast(float, __builtin_amdgcn_update_dpp(0, __builtin_bit_cast(int, v), 0x4E, 0xF, 0xF, true)));
    v = fmaxf(v, __builtin_bit_cast(float, __builtin_amdgcn_update_dpp(0, __builtin_bit_cast(int, v), 0x141, 0xF, 0xF, true)));
    v = fmaxf(v, __builtin_bit_cast(float, __builtin_amdgcn_update_dpp(0, __builtin_bit_cast(int, v), 0x140, 0xF, 0xF, true)));
    { float a = v, b = v; asm volatile("v_nop\n\tv_nop\n\tv_permlane16_swap_b32 %0, %1" : "+v"(a), "+v"(b)); v = fmaxf(a, b); }
    { float a = v, b = v; asm volatile("v_nop\n\tv_nop\n\tv_permlane32_swap_b32 %0, %1" : "+v"(a), "+v"(b)); v = fmaxf(a, b); }
    return v;
}
__device__ __forceinline__ unsigned q4(float a, float b, float c, float d, int off) {
    const int ia = (int)__builtin_rintf(a) + off, ib = (int)__builtin_rintf(b) + off, ic = (int)__builtin_rintf(c) + off, id = (int)__builtin_rintf(d) + off;
    return (unsigned)(ia & 255) | ((unsigned)(ib & 255) << 8) | ((unsigned)(ic & 255) << 16) | ((unsigned)(id & 255) << 24);
}
__device__ __forceinline__ void quant_row(const GAS float* src, GAS unsigned* dst, GAS float* scale, int off, int lane) {
    const GAS f32x4* s = (const GAS f32x4*)src + 4 * lane; f32x4 v[4]; float m = 0.f;
#pragma unroll
    for (int i = 0; i < 4; ++i) { v[i] = s[i]; m = fmaxf(m, fmaxf(fmaxf(__builtin_fabsf(v[i].x), __builtin_fabsf(v[i].y)), fmaxf(__builtin_fabsf(v[i].z), __builtin_fabsf(v[i].w)))); }
    m = wave_allmax(m); const float inv = m > 0.f ? 127.f / m : 0.f;
    v4u w;
    w.x = q4(v[0].x * inv, v[0].y * inv, v[0].z * inv, v[0].w * inv, off); w.y = q4(v[1].x * inv, v[1].y * inv, v[1].z * inv, v[1].w * inv, off);
    w.z = q4(v[2].x * inv, v[2].y * inv, v[2].z * inv, v[2].w * inv, off); w.w = q4(v[3].x * inv, v[3].y * inv, v[3].z * inv, v[3].w * inv, off);
    *((GAS v4u*)dst + lane) = w;
    if (lane == 0) *scale = m * (1.f / 127.f);
}
struct PeerS { int nslices_step, first_slice, nloc, rank; };
__device__ __forceinline__ PeerS peer_sched(const GAS unsigned* rankw, int xcc, int rank) {
    const int lane = lane_id_v();
    const int c = lane < 16 ? (int)__hip_atomic_load(rankw + 64 * lane, __ATOMIC_RELAXED, __HIP_MEMORY_SCOPE_AGENT) : 0;
    const unsigned long long m = __builtin_amdgcn_ballot_w64(c > 0);
    const int nx = __builtin_popcountll(m), myidx = __builtin_popcountll(m & ((1ull << xcc) - 1ull));
    const int cm = __builtin_amdgcn_readlane(c, xcc);
    PeerS s; s.nslices_step = nx > 0 ? nx : 1; s.first_slice = myidx; s.nloc = cm > 0 ? cm : 1; s.rank = rank; return s;
}
struct Peer1P { const GAS unsigned GAS char* HQ; const GAS int* EX; const GAS unsigned GAS char* U8; GAS int* P; };
__device__ __forceinline__ void peer_k1(const Peer1P& Q, const PeerS& sc, int wave, int lane) {
    asm volatile("" : "+v"(lane));
    const int g = lane >> 3, j = lane & 7;
    for (int s = sc.first_slice; s < 8; s += sc.nslices_step)
        for (int tile = sc.rank; tile < T / 64; tile += sc.nloc) {
            const size_t t0 = (size_t)tile * 64 + wave * 8;
            v4u hqn = *(const GAS v4u*)(Q.HQ + t0 * 1024 + 128 * s + 16 * j), exn[4];
#pragma unroll
            for (int i = 0; i < 4; ++i) exn[i] = *(const GAS v4u*)(Q.EX + t0 * 128 + 16 * g + 4 * i);
#pragma unroll 1
            for (int k = 0; k < 8; ++k) {
                const size_t t = t0 + k;
                const v4u hq = hqn; v4u ex[4];
#pragma unroll
                for (int i = 0; i < 4; ++i) ex[i] = exn[i];
                if (k + 1 < 8) {
                    hqn = *(const GAS v4u*)(Q.HQ + (t + 1) * 1024 + 128 * s + 16 * j);
#pragma unroll
                    for (int i = 0; i < 4; ++i) exn[i] = *(const GAS v4u*)(Q.EX + (t + 1) * 128 + 16 * g + 4 * i);
                }
                v4u uu[16];
#pragma unroll
                for (int i = 0; i < 16; ++i) { const unsigned e = (i & 3) == 0 ? ex[i >> 2].x : (i & 3) == 1 ? ex[i >> 2].y : (i & 3) == 2 ? ex[i >> 2].z : ex[i >> 2].w;
                    uu[i] = *(const GAS v4u*)(Q.U8 + (size_t)e * 1024 + 128 * s + 16 * j); }
                int lo = 0, hi = 0;
#pragma unroll
                for (int i = 0; i < 16; ++i) {
                    int p = __builtin_amdgcn_sdot4((int)uu[i].x, (int)hq.x, 0, false); p = __builtin_amdgcn_sdot4((int)uu[i].y, (int)hq.y, p, false); p = __builtin_amdgcn_sdot4((int)uu[i].z, (int)hq.z, p, false); p = __builtin_amdgcn_sdot4((int)uu[i].w, (int)hq.w, p, false);
                    p += __builtin_amdgcn_update_dpp(0, p, 0xB1, 0xF, 0xF, true); p += __builtin_amdgcn_update_dpp(0, p, 0x4E, 0xF, 0xF, true); p += __builtin_amdgcn_update_dpp(0, p, 0x141, 0xF, 0xF, true);
                    if (i < 8) lo = (j == i) ? p : lo; else hi = (j == i - 8) ? p : hi;
                }
                GAS int* prow = Q.P + t * 128 + 16 * g + j;
                (void)__hip_atomic_fetch_add(prow, lo, __ATOMIC_RELAXED, __HIP_MEMORY_SCOPE_AGENT); (void)__hip_atomic_fetch_add(prow + 8, hi, __ATOMIC_RELAXED, __HIP_MEMORY_SCOPE_AGENT);
            }
        }
}
__device__ __forceinline__ void peer_w(const GAS int* EX, const GAS float* GW, const GAS int* P, const GAS float* SH, const GAS float* SU, const GAS float* SV, GAS signed char* WQ, GAS float* WSC, int gw, int NGW, int lane) {
    asm volatile("" : "+v"(lane));
    for (int t = gw; t < T; t += NGW) {
        const float sh = SH[t];
#pragma unroll
        for (int q = 0; q < 2; ++q) { const size_t idx = (size_t)t * 128 + lane + 64 * q; const int e = EX[idx];
            const float w = GW[idx] * gelu_erf((float)P[idx] * (sh * SU[e])) * SV[e];
            float m = __builtin_fabsf(w);
            m = fmaxf(m, __builtin_bit_cast(float, __builtin_amdgcn_update_dpp(0, __builtin_bit_cast(int, m), 0xB1, 0xF, 0xF, true)));
            m = fmaxf(m, __builtin_bit_cast(float, __builtin_amdgcn_update_dpp(0, __builtin_bit_cast(int, m), 0x4E, 0xF, 0xF, true)));
            m = fmaxf(m, __builtin_bit_cast(float, __builtin_amdgcn_update_dpp(0, __builtin_bit_cast(int, m), 0x141, 0xF, 0xF, true)));
            m = fmaxf(m, __builtin_bit_cast(float, __builtin_amdgcn_update_dpp(0, __builtin_bit_cast(int, m), 0x140, 0xF, 0xF, true)));
            const float inv = m > 0.f ? 127.f / m : 0.f;
            WQ[idx] = (signed char)(int)__builtin_rintf(w * inv);
            if ((lane & 15) == 0) WSC[(size_t)t * 8 + (lane >> 4) + 4 * q] = m * (1.f / 127.f); }
    }
}
__device__ __forceinline__ void tr4x4(unsigned r0, unsigned r1, unsigned r2, unsigned r3, unsigned (&t)[4]) {
    const unsigned x0 = __builtin_amdgcn_perm(r1, r0, 0x05010400u), x1 = __builtin_amdgcn_perm(r1, r0, 0x07030602u), y0 = __builtin_amdgcn_perm(r3, r2, 0x05010400u), y1 = __builtin_amdgcn_perm(r3, r2, 0x07030602u);
    t[0] = __builtin_amdgcn_perm(y0, x0, 0x05040100u); t[1] = __builtin_amdgcn_perm(y0, x0, 0x07060302u); t[2] = __builtin_amdgcn_perm(y1, x1, 0x05040100u); t[3] = __builtin_amdgcn_perm(y1, x1, 0x07060302u);
}
struct Peer2P { const GAS int* EX; const GAS signed char* WQ; const GAS float* WSC; const GAS unsigned char* V8; GAS bf16* XB; GAS float* SSQ; };
__device__ __forceinline__ void peer_k2(const Peer2P& Q, const PeerS& sc, int wave, int lane) {
    asm volatile("" : "+v"(lane));
    const int g = lane >> 3, j = lane & 7, hf = lane >> 5, rp = (lane >> 4) & 1;
    for (int s = sc.first_slice; s < 8; s += sc.nslices_step)
        for (int tile = sc.rank; tile < T / 64; tile += sc.nloc) {
            const size_t t0 = (size_t)tile * 64 + wave * 8;
            v4u exn[4], wqn; float swn;
#pragma unroll
            for (int i = 0; i < 4; ++i) exn[i] = *(const GAS v4u*)(Q.EX + t0 * 128 + 16 * g + 4 * i);
            wqn = *(const GAS v4u*)(Q.WQ + t0 * 128 + 16 * g); swn = Q.WSC[t0 * 8 + g];
#pragma unroll 1
            for (int k = 0; k < 8; ++k) {
                const size_t t = t0 + k;
                v4u ex[4]; const v4u wq = wqn; const float sw = swn;
#pragma unroll
                for (int i = 0; i < 4; ++i) ex[i] = exn[i];
                if (k + 1 < 8) {
#pragma unroll
                    for (int i = 0; i < 4; ++i) exn[i] = *(const GAS v4u*)(Q.EX + (t + 1) * 128 + 16 * g + 4 * i);
                    wqn = *(const GAS v4u*)(Q.WQ + (t + 1) * 128 + 16 * g); swn = Q.WSC[(t + 1) * 8 + g];
                }
                GAS v2u* xp = (GAS v2u*)(Q.XB + t * 1024 + 128 * s + 16 * j + 8 * hf + 4 * rp);
                const v2u xold = *xp;
                v4u vv[16];
#pragma unroll
                for (int i = 0; i < 16; ++i) { const unsigned e = (i & 3) == 0 ? ex[i >> 2].x : (i & 3) == 1 ? ex[i >> 2].y : (i & 3) == 2 ? ex[i >> 2].z : ex[i >> 2].w;
                    vv[i] = *(const GAS v4u*)(Q.V8 + (size_t)e * 1024 + 128 * s + 16 * j); }
                int ai[16];
#pragma unroll
                for (int i = 0; i < 16; ++i) ai[i] = 0;
#pragma unroll
                for (int q4_ = 0; q4_ < 4; ++q4_) {
                    const unsigned wq4 = q4_ == 0 ? wq.x : q4_ == 1 ? wq.y : q4_ == 2 ? wq.z : wq.w;
#pragma unroll
                    for (int c = 0; c < 4; ++c) { unsigned tt[4];
                        const v4u &a0 = vv[4 * q4_], &a1 = vv[4 * q4_ + 1], &a2 = vv[4 * q4_ + 2], &a3 = vv[4 * q4_ + 3];
                        tr4x4(c == 0 ? a0.x : c == 1 ? a0.y : c == 2 ? a0.z : a0.w, c == 0 ? a1.x : c == 1 ? a1.y : c == 2 ? a1.z : a1.w, c == 0 ? a2.x : c == 1 ? a2.y : c == 2 ? a2.z : a2.w, c == 0 ? a3.x : c == 1 ? a3.y : c == 2 ? a3.z : a3.w, tt);
#pragma unroll
                        for (int b = 0; b < 4; ++b) ai[4 * c + b] = __builtin_amdgcn_sdot4((int)tt[b], (int)wq4, ai[4 * c + b], false); }
                }
                float acc[16];
#pragma unroll
                for (int i = 0; i < 16; ++i) acc[i] = (float)ai[i] * sw;
                float r8[8], r4[4];
#pragma unroll
                for (int m = 0; m < 8; ++m) { float a = acc[m], b = acc[m + 8]; swap32(a, b); r8[m] = a + b; }
#pragma unroll
                for (int n = 0; n < 4; ++n) { float a = r8[n], b = r8[n + 4]; asm volatile("v_nop\n\tv_nop\n\tv_permlane16_swap_b32 %0, %1" : "+v"(a), "+v"(b)); r4[n] = a + b; }
#pragma unroll
                for (int n = 0; n < 4; ++n) r4[n] += __builtin_bit_cast(float, __builtin_amdgcn_update_dpp(0, __builtin_bit_cast(int, r4[n]), 0x128, 0xF, 0xF, true));
                v2u xw; xw.x = pk2(bflo(xold.x) + r4[0], bfhi(xold.x) + r4[1]); xw.y = pk2(bflo(xold.y) + r4[2], bfhi(xold.y) + r4[3]);
                float ss = 0.f;
                if ((lane & 8) == 0) { const float x0 = bflo(xw.x), x1 = bfhi(xw.x), x2 = bflo(xw.y), x3 = bfhi(xw.y); ss = (x0 * x0 + x1 * x1) + (x2 * x2 + x3 * x3); *xp = xw; }
                ss = wave_allsum(ss);
                if (Q.SSQ) { if (lane == 0) Q.SSQ[t * 16 + s] = ss; }
            }
        }
}

struct Args { const float* in[33]; float* out; unsigned char* ws; int ph_lo, ph_hi; };
struct Frame { LAS unsigned char* lds; volatile LAS unsigned* MISC; gu32* ctl; int tid, lane, wave, G, vcu, xcc, xrank; };

__device__ __forceinline__ void transpose_item(const float* W, int ldw, int nsrc0, bf16* WT, int ldt, int rdst0, LAS float* scr, int kb, int nb, int lane, float scale, const float* kgain) {
    const int k0 = 64 * kb, n0 = 32 * nb;
#pragma unroll 8
    for (int i = 0; i < 32; ++i) { const int kk = 2 * i + (lane >> 5); const float gsc = kgain ? kgain[k0 + kk] * scale : scale; scr[kk * 33 + (lane & 31)] = W[(size_t)(k0 + kk) * ldw + nsrc0 + n0 + (lane & 31)] * gsc; }
    LDS_WAIT(); asm volatile("" ::: "memory");
    const int c = lane & 7;
#pragma unroll
    for (int j = 0; j < 4; ++j) { const int n = (lane >> 3) + 8 * j; const LAS float* s = scr + (8 * c) * 33 + n;
        v4u o; o.x = pk2(s[0 * 33], s[1 * 33]); o.y = pk2(s[2 * 33], s[3 * 33]); o.z = pk2(s[4 * 33], s[5 * 33]); o.w = pk2(s[6 * 33], s[7 * 33]);
        *(GAS v4u*)(WT + (size_t)(rdst0 + n0 + n) * ldt + k0 + 8 * c) = o; }
    LDS_WAIT(); asm volatile("" ::: "memory");
}
__device__ __forceinline__ void zero_rect(bf16* base, int ld, int row0, int nrows, int col0, int ncols, int gtid, int gthreads) {
    const int vpr = ncols / 8;
    for (int i = gtid; i < nrows * vpr; i += gthreads) { const int r = i / vpr, c = i % vpr; *(GAS v4u*)(base + (size_t)(row0 + r) * ld + col0 + 8 * c) = (v4u){0u, 0u, 0u, 0u}; }
}

__device__ __forceinline__ void p0_prologue(Frame& F, const Args& a) {
    LAS float* scr = (LAS float*)(F.lds + RING_OFF + F.wave * 16384);
    const int gw = blockIdx.x * NWAVES + F.wave, NGW = F.G * NWAVES;
    const int gtid = blockIdx.x * (NWAVES * 64) + F.tid, gthreads = F.G * NWAVES * 64;
    unsigned char* ws = a.ws;
    x0_phase((const GAS float*)a.in[0], (GAS bf16*)(ws + WS_XNB), (GAS float*)(ws + WS_SSQ), gw, NGW, F.lane);
    constexpr int I_IN = 16 * (INW / 32), I_SQ = 16 * 32, I_CKV = 16 * 64, I_UQ = 3 * 12, I_UKV = 2 * 16, I_L = I_IN + 4 * I_SQ + I_CKV + I_UQ + I_UKV;
    for (int it = gw; it < L * I_L; it += NGW) {
        const int l = it / I_L; int r = it % I_L;
        if (r < I_IN) {
            const int kb = r / 67, nb = r % 67; int src, dst; float sc = 1.f;
            if (nb < 6) { src = 32 * nb; dst = src; } else if (nb < 11) { src = 32 * nb; dst = src + 64; } else { src = 32 * nb; dst = src + 160; if (nb >= 43 && nb < 51) sc = 0.17677669529663687f * LOG2E; }
            transpose_item(a.in[5] + (size_t)l * D * INW, INW, src, (bf16*)(ws + WS_WIN) + (size_t)l * INP * D, D, dst, scr, kb, 0, F.lane, sc, a.in[4] + l * D); continue; } r -= I_IN;
        if (r < I_SQ) { transpose_item(a.in[21] + (size_t)l * D * D, D, 0, (bf16*)(ws + WS_WOUT) + (size_t)l * D * D, D, 0, scr, r / 32, r % 32, F.lane, 1.f, nullptr); continue; } r -= I_SQ;
        if (r < I_SQ) { transpose_item(a.in[24] + (size_t)l * D * D, D, 0, (bf16*)(ws + WS_WCQ) + (size_t)l * D * D, D, 0, scr, r / 32, r % 32, F.lane, 0.0625f * LOG2E, a.in[22] + l * D); continue; } r -= I_SQ;
        if (r < I_SQ) { transpose_item(a.in[26] + (size_t)l * D * D, D, 0, (bf16*)(ws + WS_WCO) + (size_t)l * D * D, D, 0, scr, r / 32, r % 32, F.lane, 1.f, nullptr); continue; } r -= I_SQ;
        if (r < I_SQ) { transpose_item(a.in[28] + (size_t)l * D * D, D, 0, (bf16*)(ws + WS_WPQ) + (size_t)l * D * D, D, 0, scr, r / 32, r % 32, F.lane, 1.f, a.in[27] + l * D); continue; } r -= I_SQ;
        if (r < I_CKV) { transpose_item(a.in[25] + (size_t)l * D * 2 * D, 2 * D, 0, (bf16*)(ws + WS_WCKV) + (size_t)l * 2 * D * D, D, 0, scr, r / 64, r % 64, F.lane, 1.f, nullptr); continue; } r -= I_CKV;
        if (r < I_UQ) { transpose_item(a.in[7] + (size_t)l * 192 * 384, 384, 0, (bf16*)(ws + WS_WUQ) + (size_t)l * 512 * 256, 256, 0, scr, r / 12, r % 12, F.lane, 0.10206207261596575f * LOG2E, a.in[6] + l * 192); continue; } r -= I_UQ;
        transpose_item(a.in[9] + (size_t)l * 128 * 512, 512, 0, (bf16*)(ws + WS_WUKV) + (size_t)l * 512 * 256, 256, 0, scr, r / 16, r % 16, F.lane, 1.f, a.in[8] + l * 128);
    }
    for (int l = 0; l < L; ++l) {
        bf16* win = (bf16*)(ws + WS_WIN) + (size_t)l * INP * D; bf16* wuq = (bf16*)(ws + WS_WUQ) + (size_t)l * 512 * 256; bf16* wukv = (bf16*)(ws + WS_WUKV) + (size_t)l * 512 * 256;
        zero_rect(win, D, 192, 64, 0, D, gtid, gthreads); zero_rect(win, D, 416, 96, 0, D, gtid, gthreads);
        zero_rect(wuq, 256, 0, 384, 192, 64, gtid, gthreads); zero_rect(wuq, 256, 384, 128, 0, 256, gtid, gthreads);
        zero_rect(wukv, 256, 0, 512, 128, 128, gtid, gthreads);
    }
    { float* rope = (float*)(ws + WS_ROPE); const int* pos = (const int*)a.in[2];
      for (int i = gtid; i < T * 16; i += gthreads) { const int t = i >> 4, k = i & 15; const float inv = powf(10000.f, -(float)(2 * k) / 32.f); const float ang = (float)pos[t] * inv;
          rope[(size_t)t * 32 + k] = cosf(ang); rope[(size_t)t * 32 + 16 + k] = sinf(ang); } }
    { const GAS f32x4* ks = (const GAS f32x4*)a.in[29]; GAS v2u* kd = (GAS v2u*)(ws + WS_KEYS);
      for (int i = gtid; i < L * 2 * 128 * 64 / 4; i += gthreads) { const f32x4 v = ks[i]; v2u w; w.x = pk2(v.x, v.y); w.y = pk2(v.z, v.w); kd[i] = w; }
    }
    for (int r = gw; r < 2 * L * 16384; r += NGW) { const int tb = r / (L * 16384), rr = r % (L * 16384);
        quant_row((const GAS float*)a.in[30 + tb] + (size_t)rr * 1024, (GAS unsigned*)(ws + (tb ? WS_V8 : WS_U8) + (size_t)rr * 1024), (GAS float*)(ws + (tb ? WS_SV : WS_SU)) + rr, 0, F.lane); }
    { float* btab = (float*)(ws + WS_BTAB); float* lams = (float*)(ws + WS_LAMS); float* spt = (float*)(ws + WS_SP);
      for (int i = gtid; i < 4 * 129; i += gthreads) { const int h = i / 129, n = i % 129; int bu; if (n < 16) bu = n; else { const int lg = 16 + (int)(logf((float)n / 16.f) / logf(8.f) * 16.f); bu = lg < 31 ? lg : 31; }
          btab[i] = a.in[3][bu * 4 + h] * LOG2E; }
      for (int i = gtid; i < L; i += gthreads) { const float* dl = a.in[17] + i * 128; float s1 = 0.f, s2 = 0.f; for (int j = 0; j < 32; ++j) { s1 += dl[j] * dl[32 + j]; s2 += dl[64 + j] * dl[96 + j]; }
          const float li = 0.8f - 0.6f * expf(-0.3f * (float)i); lams[2 * i] = expf(s1) - expf(s2) + li; lams[2 * i + 1] = li; }
      for (int i = gtid; i < L * 512; i += gthreads) spt[i] = log1pf(expf(-a.in[16][i])); }
    { GAS bf16* wat = (GAS bf16*)(ws + WS_WAT);
      for (int i = gtid; i < L * 8 * 2 * 4096; i += gthreads) { const int in_ = i & 63, out_ = (i >> 6) & 63, gate = (i >> 12) & 1, lg = i >> 13;
          wat[i] = (bf16)f2bf_(a.in[gate ? 14 : 12][(size_t)lg * 4096 + in_ * 64 + out_]); } }
    for (int l = 0; l < L; ++l) norm_phase((const GAS float*)a.in[1], (const GAS float*)a.in[23] + l * D, (GAS bf16*)(ws + WS_MNB) + (size_t)l * NB * MEM * D, NB * MEM, gw, NGW, F.lane);
}

constexpr int NPL = 16, PH_FINAL = 2 + NPL * L;
__global__ void __launch_bounds__(NWAVES * 64, 2) fwd(Args args) {
    extern __shared__ __attribute__((aligned(16))) unsigned char lds[];
    Frame F;
    F.lds = (LAS unsigned char*)lds; F.MISC = (volatile LAS unsigned*)(F.lds + MISC_OFF);
    F.tid = threadIdx.x; F.lane = F.tid & 63; F.wave = __builtin_amdgcn_readfirstlane(F.tid >> 6); F.G = gridDim.x;
    F.vcu = (F.G % 8 == 0) ? ((int)blockIdx.x % 8) * (F.G / 8) + (int)blockIdx.x / 8 : (int)blockIdx.x;
    unsigned char* ws = args.ws;
    F.ctl = (gu32*)(opq(ws) + WS_CTL);
    for (int u = F.tid; u < (LDS_BYTES - LDSCTL_OFF) / 4; u += NWAVES * 64) ((LAS unsigned*)(F.lds + LDSCTL_OFF))[u] = 0u;
    __syncthreads();
    XcdBarrier bar = xcd_barrier_post((unsigned*)(F.ctl + CW_BAR), F.MISC + 8);
    F.xcc = (int)bar.x;
    if (F.tid == 0) F.MISC[12] = __hip_atomic_fetch_add((unsigned*)(F.ctl + CW_RANK) + 64 * bar.x, 1u, __ATOMIC_RELAXED, __HIP_MEMORY_SCOPE_AGENT);
    __syncthreads();
    F.xrank = __builtin_amdgcn_readfirstlane((int)F.MISC[12]);
    const int lo = args.ph_lo, hi = args.ph_hi;
    const int gw = blockIdx.x * NWAVES + F.wave, NGW = F.G * NWAVES;
#define IN(k) (lo <= (k) && (k) < hi)
#define LANE_ (lane_id_v())
#define TID_ ((opqi(F.wave) << 6) | LANE_)
#define SITE() const int G_ = opqi(F.G), wv_ = opqi(F.wave), vcu_ = opqi(F.vcu), gw_ = opqi(gw), NGW_ = opqi(NGW); (void)G_; (void)wv_; (void)vcu_; (void)gw_; (void)NGW_
#if MK_DUP == 99
#define SEAM(k) do { if (IN(k) && IN((k) + 1)) { xcd_barrier(bar, (F.wave == 0 && lane_id_v() == 0) ? 1 : 0); xcd_barrier(bar, (F.wave == 0 && lane_id_v() == 0) ? 1 : 0); } } while (0)
#else
#define SEAM(k) do { if (IN(k) && IN((k) + 1)) xcd_barrier(bar, (F.wave == 0 && lane_id_v() == 0) ? 1 : 0); } while (0)
#endif
#define GEMM_SITE(EPI, Aptr, lda_, Bptr, ldb_, M_, N_, K_, cperm, ...) do { \
        pg8::Gemm g{opq(Aptr), opq(Bptr), M_, N_, K_, lda_, ldb_}; pg8::StaticOrder So; So.init(M_, N_, opqi(F.G), opqi(cperm)); pg8::EPI E{__VA_ARGS__}; \
        pg8::gemm_phase<pg8::EPI, pg8::StaticOrder, true, true>(F.lds + RING_OFF, g, So, E, opqi(F.wave)); } while (0)
    if (IN(0)) { p0_prologue(F, args); }
    SEAM(0);
    if (IN(1)) {
#pragma unroll 1
        for (int l = 0; l < L; ++l)
            GEMM_SITE(EpiBf16, (const GAS bf16*)(opq(ws) + WS_MNB) + (size_t)l * NB * MEM * D, D, (const GAS bf16*)(opq(ws) + WS_WCKV) + (size_t)l * 2 * D * D, D, NB * MEM, 2 * D, D, (int)((blockIdx.x + 64 * l) % F.G),
                      opq((GAS bf16*)(opq(ws) + WS_KVCB) + (size_t)l * NB * MEM * 2 * D), 2 * D, 2 * D, (const GAS float*)nullptr, 0);
    }
    SEAM(1);
    for (int l = 0; l < L; ++l) {
        const int pb = 2 + NPL * l;
        const GAS bf16* XNB = (const GAS bf16*)(opq(ws) + WS_XNB); const GAS bf16* YB = (const GAS bf16*)(opq(ws) + WS_YB); GAS bf16* PROJB = (GAS bf16*)(opq(ws) + WS_PROJB);
        if (IN(pb + 1)) GEMM_SITE(EpiBf16, XNB, D, (const GAS bf16*)(opq(ws) + WS_WIN) + (size_t)l * INP * D, D, T, INP, D, (int)blockIdx.x, opq(PROJB), INP, INP, opq((const GAS float*)(opq(ws) + WS_SSQ)), 8);
#if MK_DUP == 1
        if (IN(pb + 1)) GEMM_SITE(EpiBf16, XNB, D, (const GAS bf16*)(opq(ws) + WS_WIN) + (size_t)l * INP * D, D, T, INP, D, (int)blockIdx.x, opq(PROJB), INP, INP, opq((const GAS float*)(opq(ws) + WS_SSQ)), 8);
#endif
        SEAM(pb + 1);
        if (IN(pb + 2)) {
            SITE();
            pre_phase(opq((const GAS bf16*)PROJB), opq((const GAS float*)(opq(ws) + WS_ROPE)), opq((GAS float*)(opq(ws) + WS_RS)), opq((GAS bf16*)(opq(ws) + WS_KMB)), gw_, NGW_, LANE_);
#if MK_DUP == 21
            pre_phase(opq((const GAS bf16*)PROJB), opq((const GAS float*)(opq(ws) + WS_ROPE)), opq((GAS float*)(opq(ws) + WS_RS)), opq((GAS bf16*)(opq(ws) + WS_KMB)), gw_, NGW_, LANE_);
#endif
            LruP LP{opq((const GAS bf16*)PROJB), (const GAS float*)args.in[opqi(10)] + l * 4 * 512, (const GAS float*)args.in[opqi(11)] + l * 512, opq((const GAS bf16*)(opq(ws) + WS_WAT)) + (size_t)l * 8 * 2 * 4096, (const GAS float*)args.in[opqi(13)] + l * 512, (const GAS float*)args.in[opqi(15)] + l * 512,
                    (const GAS float*)(opq(ws) + WS_SP) + l * 512, opq((GAS unsigned*)(opq(ws) + WS_HLB)), opq((GAS float*)(opq(ws) + WS_LSUM))};
            lru_phase(LP, F.lds, TID_, wv_, LANE_, vcu_, G_);
#if MK_DUP == 2
            lru_phase(LP, F.lds, TID_, wv_, LANE_, vcu_, G_);
#endif
        }
        SEAM(pb + 2);
        if (IN(pb + 3)) {
            GEMM_SITE(EpiUp, (const GAS bf16*)PROJB + PC_CQ, INP, (const GAS bf16*)(opq(ws) + WS_WUQ) + (size_t)l * 512 * 256, 256, T, 512, 256, (int)blockIdx.x,
                      opq((GAS bf16*)(opq(ws) + WS_QMB)), (GAS bf16*)nullptr, 384, 384, opq((const GAS float*)(opq(ws) + WS_RS)), 0, 0);
            GEMM_SITE(EpiUp, (const GAS bf16*)PROJB + PC_CKV, INP, (const GAS bf16*)(opq(ws) + WS_WUKV) + (size_t)l * 512 * 256, 256, T, 512, 256, (int)blockIdx.x,
                      opq((GAS bf16*)(opq(ws) + WS_KMB)), opq((GAS bf16*)(opq(ws) + WS_VMB)), 0, 512, opq((const GAS float*)(opq(ws) + WS_RS)), 1, 1);
#if MK_DUP == 3
            GEMM_SITE(EpiUp, (const GAS bf16*)PROJB + PC_CQ, INP, (const GAS bf16*)(opq(ws) + WS_WUQ) + (size_t)l * 512 * 256, 256, T, 512, 256, (int)blockIdx.x,
                      opq((GAS bf16*)(opq(ws) + WS_QMB)), (GAS bf16*)nullptr, 384, 384, opq((const GAS float*)(opq(ws) + WS_RS)), 0, 0);
            GEMM_SITE(EpiUp, (const GAS bf16*)PROJB + PC_CKV, INP, (const GAS bf16*)(opq(ws) + WS_WUKV) + (size_t)l * 512 * 256, 256, T, 512, 256, (int)blockIdx.x,
                      opq((GAS bf16*)(opq(ws) + WS_KMB)), opq((GAS bf16*)(opq(ws) + WS_VMB)), 0, 512, opq((const GAS float*)(opq(ws) + WS_RS)), 1, 1);
#endif
        }
        SEAM(pb + 3);
        if (IN(pb + 4)) {
            SITE();
            AttnP PM{opq((const GAS bf16*)(opq(ws) + WS_QMB)), opq((const GAS bf16*)(opq(ws) + WS_KMB)), opq((const GAS bf16*)(opq(ws) + WS_VMB)), 384, 384, 256, opq((GAS bf16*)(opq(ws) + WS_OMB)), 256, opq((const GAS float*)(opq(ws) + WS_ROPE)), nullptr, nullptr, nullptr, nullptr};
            AttnP PD{opq((const GAS bf16*)PROJB + PC_QD), opq((const GAS bf16*)PROJB + PC_KD), opq((const GAS bf16*)PROJB + PC_VD), INP, INP, INP, opq((GAS bf16*)(opq(ws) + WS_YB) + 768), 1024, nullptr,
                     (const GAS int*)args.in[opqi(2)], (const GAS float*)(opq(ws) + WS_BTAB), (const GAS float*)args.in[opqi(18)] + l * 64, (const GAS float*)(opq(ws) + WS_LAMS) + 2 * l};
            attn_phase(PM, PD, F.lds, TID_, wv_, LANE_, vcu_, G_);
#if MK_DUP == 4
            __syncthreads(); attn_phase(PM, PD, F.lds, TID_, wv_, LANE_, vcu_, G_);
#elif MK_DUP == 40 || MK_DUP == 41
            __syncthreads(); attn_phase(PM, PD, F.lds, TID_, wv_, LANE_, vcu_, G_, MK_DUP - 40);
#endif
        }
        SEAM(pb + 4);
        if (IN(pb + 5)) {
            SITE();
            PostP PP{opq((const GAS bf16*)(opq(ws) + WS_OMB)), opq((const GAS unsigned*)(opq(ws) + WS_HLB)), opq((const GAS float*)(opq(ws) + WS_LSUM)), opq((const GAS bf16*)PROJB), (const GAS float*)args.in[opqi(19)] + l * 256, (const GAS float*)args.in[opqi(20)] + l * 512, opq((GAS bf16*)(opq(ws) + WS_YB))};
            post_phase(PP, F.lds, TID_, wv_, LANE_, vcu_, G_);
#if MK_DUP == 5
            __syncthreads(); post_phase(PP, F.lds, TID_, wv_, LANE_, vcu_, G_);
#endif
        }
        SEAM(pb + 5);
        if (IN(pb + 6)) GEMM_SITE(EpiRes, YB, D, (const GAS bf16*)(opq(ws) + WS_WOUT) + (size_t)l * D * D, D, T, D, D, (int)blockIdx.x, opq((GAS bf16*)(opq(ws) + WS_XNB)), opq((GAS float*)(opq(ws) + WS_SSQ)));
#if MK_DUP == 6
        if (IN(pb + 6)) GEMM_SITE(EpiRes, YB, D, (const GAS bf16*)(opq(ws) + WS_WOUT) + (size_t)l * D * D, D, T, D, D, (int)blockIdx.x, opq((GAS bf16*)(opq(ws) + WS_HLB)), opq((GAS float*)(opq(ws) + WS_OMB)));
#endif
        SEAM(pb + 6);
        if (IN(pb + 8)) GEMM_SITE(EpiBf16, XNB, D, (const GAS bf16*)(opq(ws) + WS_WCQ) + (size_t)l * D * D, D, T, D, D, (int)blockIdx.x, opq(PROJB), D, D, opq((const GAS float*)(opq(ws) + WS_SSQ)), 16);
#if MK_DUP == 8
        if (IN(pb + 8)) GEMM_SITE(EpiBf16, XNB, D, (const GAS bf16*)(opq(ws) + WS_WCQ) + (size_t)l * D * D, D, T, D, D, (int)blockIdx.x, opq(PROJB), D, D, opq((const GAS float*)(opq(ws) + WS_SSQ)), 16);
#endif
        SEAM(pb + 8);
        if (IN(pb + 9)) {
            SITE();
            const GAS bf16* kv = (const GAS bf16*)(opq(ws) + WS_KVCB) + (size_t)l * NB * MEM * 2 * D;
            AttnP PC{opq((const GAS bf16*)PROJB), opq(kv), opq(kv + D), 1024, 2 * D, 2 * D, opq((GAS bf16*)(opq(ws) + WS_YB)), 1024, nullptr, nullptr, nullptr, nullptr, nullptr};
            cross_phase(PC, F.lds, TID_, wv_, LANE_, vcu_, G_);
#if MK_DUP == 9
            cross_phase(PC, F.lds, TID_, wv_, LANE_, vcu_, G_);
#endif
        }
        SEAM(pb + 9);
        if (IN(pb + 10)) GEMM_SITE(EpiRes, YB, D, (const GAS bf16*)(opq(ws) + WS_WCO) + (size_t)l * D * D, D, T, D, D, (int)blockIdx.x, opq((GAS bf16*)(opq(ws) + WS_XNB)), opq((GAS float*)(opq(ws) + WS_SSQ)));
        SEAM(pb + 10);
        if (IN(pb + 12)) { GEMM_SITE(EpiBf16, XNB, D, (const GAS bf16*)(opq(ws) + WS_WPQ) + (size_t)l * D * D, D, T, D, D, (int)blockIdx.x, opq(PROJB), D, D, opq((const GAS float*)(opq(ws) + WS_SSQ)), 16);
            SITE(); hq_phase(opq(XNB), opq((const GAS float*)(opq(ws) + WS_SSQ)), (const GAS float*)args.in[opqi(27)] + l * D, opq((GAS unsigned char*)(opq(ws) + WS_HQ)), opq((GAS float*)(opq(ws) + WS_SH)), opq((GAS int*)(opq(ws) + WS_P)), gw_, NGW_, LANE_);
#if MK_DUP == 12
            hq_phase(opq(XNB), opq((const GAS float*)(opq(ws) + WS_SSQ)), (const GAS float*)args.in[opqi(27)] + l * D, opq((GAS unsigned char*)(opq(ws) + WS_HQ)), opq((GAS float*)(opq(ws) + WS_SH)), opq((GAS int*)(opq(ws) + WS_P)), gw_, NGW_, LANE_);
#endif
            }
        SEAM(pb + 12);
        if (IN(pb + 13)) {
            SITE();
            RouteP RP{opq((const GAS bf16*)PROJB), opq((const GAS bf16*)(opq(ws) + WS_KEYS) + (size_t)l * 2 * 128 * 64), opq((GAS int*)(opq(ws) + WS_EX)), opq((GAS float*)(opq(ws) + WS_GW))};
            route_phase(RP, F.lds, TID_, wv_, LANE_, vcu_, G_);
#if MK_DUP == 13
            route_phase(RP, F.lds, TID_, wv_, LANE_, vcu_, G_);
#endif
        }
        SEAM(pb + 13);
        if (IN(pb + 14)) {
            SITE();
            const PeerS ps = peer_sched((const GAS unsigned*)(F.ctl + CW_RANK), opqi(F.xcc), opqi(F.xrank));
            Peer1P Q1{opq((const GAS unsigned char*)(opq(ws) + WS_HQ)), opq((const GAS int*)(opq(ws) + WS_EX)), opq((const GAS unsigned char*)(opq(ws) + WS_U8) + (size_t)l * 16384 * 1024), opq((GAS int*)(opq(ws) + WS_P))};
            peer_k1(Q1, ps, wv_, LANE_);
#if MK_DUP == 141
            { Peer1P Q1b = Q1; Q1b.P = (GAS int*)(opq(ws) + WS_PROJB); peer_k1(Q1b, ps, wv_, LANE_); }
#endif
        }
        SEAM(pb + 14);
        if (IN(pb + 15)) {
            SITE();
            peer_w(opq((const GAS int*)(opq(ws) + WS_EX)), opq((const GAS float*)(opq(ws) + WS_GW)), opq((const GAS int*)(opq(ws) + WS_P)), opq((const GAS float*)(opq(ws) + WS_SH)), opq((const GAS float*)(opq(ws) + WS_SU) + l * 16384), opq((const GAS float*)(opq(ws) + WS_SV) + l * 16384),
                   opq((GAS signed char*)(opq(ws) + WS_W)), opq((GAS float*)(opq(ws) + WS_WS)), gw_, NGW_, LANE_);
            xcd_barrier(bar, (F.wave == 0 && lane_id_v() == 0) ? 1 : 0);
            const PeerS ps = peer_sched((const GAS unsigned*)(F.ctl + CW_RANK), opqi(F.xcc), opqi(F.xrank));
            Peer2P Q2{opq((const GAS int*)(opq(ws) + WS_EX)), opq((const GAS signed char*)(opq(ws) + WS_W)), opq((const GAS float*)(opq(ws) + WS_WS)), opq((const GAS unsigned char*)(opq(ws) + WS_V8) + (size_t)l * 16384 * 1024), opq((GAS bf16*)(opq(ws) + WS_XNB)), opq((GAS float*)(opq(ws) + WS_SSQ))};
            peer_k2(Q2, ps, wv_, LANE_);
#if MK_DUP == 151
            { Peer2P Q2b = Q2; Q2b.XB = (GAS bf16*)(opq(ws) + WS_HLB); Q2b.SSQ = (GAS float*)(opq(ws) + WS_OMB); peer_k2(Q2b, ps, wv_, LANE_); }
#endif
        }
        SEAM(pb + 15);
    }
    if (IN(PH_FINAL)) { SITE(); final_norm_phase(opq((const GAS bf16*)(opq(ws) + WS_XNB)), (GAS float*)args.out, (const GAS float*)args.in[opqi(32)], T, gw_, NGW_, LANE_); }
#undef IN
#undef SEAM
#undef GEMM_SITE
}
}
extern "C" void kernel_launch(void* const* d_in, const int* in_sizes, int n_in, void* d_out, int out_size, void* d_ws, size_t ws_size, hipStream_t stream) {
    (void)in_sizes; (void)out_size;
    static int grid = 0;
    if (grid == 0) {
        int dev = 0, cus = 0, per_cu = 0;
        if (n_in != 33 || ws_size < mk::WS_END) { fprintf(stderr, "kernel_launch: unexpected n_in %d / ws_size %zu\n", n_in, ws_size); grid = -1; return; }
        if (hipGetDevice(&dev) != hipSuccess || hipDeviceGetAttribute(&cus, hipDeviceAttributeMultiprocessorCount, dev) != hipSuccess) { grid = -1; return; }
        if (hipFuncSetAttribute((const void*)mk::fwd, hipFuncAttributeMaxDynamicSharedMemorySize, mk::LDS_BYTES) != hipSuccess) { fprintf(stderr, "kernel_launch: hipFuncSetAttribute failed\n"); grid = -1; return; }
        if (hipOccupancyMaxActiveBlocksPerMultiprocessor(&per_cu, (const void*)mk::fwd, mk::NWAVES * 64, mk::LDS_BYTES) != hipSuccess || per_cu < 1) fprintf(stderr, "kernel_launch: occupancy query says %d\n", per_cu);
        (void)hipGetLastError();
        grid = cus;
    }
    if (grid < 0) return;
    unsigned char* ws = (unsigned char*)d_ws;
    (void)hipMemsetAsync(ws + mk::WS_CTL, 0, mk::CTL_ZERO_BYTES, stream);
    mk::Args a{};
    for (int i = 0; i < 33; ++i) a.in[i] = (const float*)d_in[i];
    a.out = (float*)d_out; a.ws = ws;
    auto run = [&](int lo, int hi) { a.ph_lo = lo; a.ph_hi = hi; hipLaunchKernelGGL(mk::fwd, dim3(grid), dim3(mk::NWAVES * 64), mk::LDS_BYTES, stream, a); };
#if MK_ONE_LAUNCH
    run(0, mk::PH_FINAL + 1);
#else
    for (int p = 0; p <= mk::PH_FINAL; ++p) {
        const int k = (p - 2) % mk::NPL, l = (p - 2) / mk::NPL;
#if MK_NAIVE_PEER == 2
        if (p >= 2 && p < mk::PH_FINAL && k == 14) {
            hipLaunchKernelGGL(k_peer, dim3(T), dim3(256), 0, stream, (const bf16_t*)(ws + mk::WS_XNB), (const int*)(ws + mk::WS_EX), (const float*)(ws + mk::WS_GW), (const float*)d_in[30] + (size_t)l * NEXP * D, (const float*)d_in[31] + (size_t)l * NEXP * D, (float*)d_out);
            continue; }
#elif MK_NAIVE_PEER == 1
        if (p >= 2 && p < mk::PH_FINAL && k == 13) {
            float* TQ = (float*)(ws + (size_t)806 * mk::MiB);
            hipLaunchKernelGGL(k_bf2f, dim3((unsigned)(((size_t)T * D + 255) / 256)), dim3(256), 0, stream, (const bf16_t*)(ws + mk::WS_PROJB), TQ, (long)T * D);
            hipLaunchKernelGGL(k_route, dim3(T), dim3(256), 0, stream, TQ, (const float*)d_in[29] + (size_t)l * 2 * 128 * 64, (int*)(ws + mk::WS_EX), (float*)(ws + mk::WS_GW));
            hipLaunchKernelGGL(k_peer, dim3(T), dim3(256), 0, stream, (const bf16_t*)(ws + mk::WS_XNB), (const int*)(ws + mk::WS_EX), (const float*)(ws + mk::WS_GW), (const float*)d_in[30] + (size_t)l * NEXP * D, (const float*)d_in[31] + (size_t)l * NEXP * D, (float*)d_out);
            continue; }
        if (p >= 2 && p < mk::PH_FINAL && k == 14) continue;
#endif
        run(p, p + 1); }
#endif
}
```

```cpp
#include <hip/hip_runtime.h>
#include <cstdint>
#include <cstdio>
#include <cmath>

#ifndef MK_ONE_LAUNCH
#define MK_ONE_LAUNCH 1
#endif
#ifndef MK_DUP
#define MK_DUP 0
#endif
#ifndef MK_NAIVE_PEER
#define MK_NAIVE_PEER 0
#endif
namespace pg8 {
#define PG8_LAS __attribute__((address_space(3)))
#ifndef GAS
#define GAS __attribute__((address_space(1)))
#endif
typedef unsigned short bf16_t;
typedef short bf16x8 __attribute__((ext_vector_type(8)));
typedef float f32x4 __attribute__((ext_vector_type(4)));
typedef unsigned u32x4 __attribute__((ext_vector_type(4)));
typedef unsigned u32x2 __attribute__((ext_vector_type(2)));
constexpr int BM = 256, BK = 64, HALF = 128, HTB = HALF * BK * 2, STAGE_BYTES = 8 * HTB, NXCD = 8, WGM = 8;
__host__ __device__ __forceinline__ int lds_byte(int r, int c) { const int st = (r >> 4) * 2 + (c >> 5), rr = r & 15, cc = c & 31, ob = rr * 64 + cc * 2; return st * 1024 + (ob ^ (((ob >> 9) & 1) << 5)); }
__host__ __device__ __forceinline__ void stage_rc(int b, int& R, int& C) { const int st = b / 1024, sb = b % 1024, swz = sb ^ (((sb >> 9) & 1) << 5); R = (st >> 1) * 16 + swz / 64; C = (st & 1) * 32 + (swz % 64) / 2; }
__host__ __device__ __forceinline__ int perm32(int rho) { const int n = rho >> 4, i = rho & 15; return 8 * (i >> 2) + 4 * n + (i & 3); }
__device__ __forceinline__ int pg8_lane_id() { int l; asm volatile("v_mbcnt_lo_u32_b32 %0, -1, 0\n\tv_mbcnt_hi_u32_b32 %0, -1, %0" : "=v"(l)); return l; }
struct Unit { int pm, pn; };
struct Gemm { const GAS bf16_t* A; const GAS bf16_t* Bt; int M, N, K, lda, ldb; };
struct StaticOrder {
    int nM, nN, nwg, G, c;
    __host__ __device__ void init(int M, int N, int G_, int c_) { nM = M / BM; nN = N / BM; nwg = nM * nN; G = G_; c = c_; }
    __host__ __device__ bool next(int i, Unit& u) const {
        const long L = (long)i * G + c; if (L >= nwg) return false;
        int wgid = (int)L; { const int q = nwg / NXCD, r = nwg % NXCD, xcd = wgid % NXCD, off = wgid / NXCD; wgid = (xcd < r ? xcd * (q + 1) : r * (q + 1) + (xcd - r) * q) + off; }
        const int nig = WGM * nN, gid = wgid / nig, fm = gid * WGM, gsz = (nM - fm) < WGM ? (nM - fm) : WGM;
        u.pm = fm + ((wgid % nig) % gsz); u.pn = (wgid % nig) / gsz; return true;
    }
    __device__ __forceinline__ void a_ready(const Unit&) const {}
    __device__ __forceinline__ void done(const Unit&) const {}
};
__device__ __forceinline__ unsigned cvt_pk_bf16(float lo, float hi) { unsigned r; asm volatile("v_cvt_pk_bf16_f32 %0, %1, %2" : "=v"(r) : "v"(lo), "v"(hi)); return r; }

struct EpiF32 {
    static constexpr bool PERM = false, AFTER_DRAIN = false;
    GAS float* C; int ldc; int nvalid; int accum;
    __device__ __forceinline__ void operator()(const f32x4 (&acc)[2][2][4][2], const Unit& u, int wr, int wc, int fr, int fq) const {
        { const int l_ = pg8_lane_id(); fr = l_ & 15; fq = l_ >> 4; }
#pragma unroll
        for (int ai = 0; ai < 2; ++ai)
#pragma unroll
            for (int m = 0; m < 4; ++m) { const size_t row = (size_t)u.pm * BM + ai * HALF + wr * 64 + m * 16 + fr;
#pragma unroll
                for (int bj = 0; bj < 2; ++bj)
#pragma unroll
                    for (int n = 0; n < 2; ++n) { const int col = u.pn * BM + bj * HALF + wc * 32 + n * 16 + 4 * fq;
                        if (col < nvalid) { GAS float* p = C + row * ldc + col; f32x4 v = acc[ai][bj][m][n]; if (accum) v += *(const GAS f32x4*)p; *(GAS f32x4*)p = v; } } }
    }
};
struct EpiBf16 {
    static constexpr bool PERM = true, AFTER_DRAIN = false;
    GAS bf16_t* O; int ldc; int nvalid; const GAS float* ssq; int np;
    __device__ __forceinline__ void operator()(const f32x4 (&acc)[2][2][4][2], const Unit& u, int wr, int wc, int fr, int fq) const {
        { const int l_ = pg8_lane_id(); fr = l_ & 15; fq = l_ >> 4; }
#pragma unroll
        for (int ai = 0; ai < 2; ++ai)
#pragma unroll
            for (int m = 0; m < 4; ++m) { const size_t row = (size_t)u.pm * BM + ai * HALF + wr * 64 + m * 16 + fr;
                float rs_ = 1.f;
                if (np > 0) { const GAS f32x4* sp = (const GAS f32x4*)(ssq + row * 16); f32x4 t = sp[0] + sp[1]; if (np > 8) t += sp[2] + sp[3]; rs_ = __builtin_amdgcn_rsqf(((t[0] + t[1]) + (t[2] + t[3])) * (1.f / 1024.f) + 1e-6f); }
#pragma unroll
                for (int bj = 0; bj < 2; ++bj) { const int col = u.pn * BM + bj * HALF + wc * 32 + 8 * fq;
                    if (col < nvalid) { const f32x4 v0 = acc[ai][bj][m][0] * rs_, v1 = acc[ai][bj][m][1] * rs_; u32x4 w; w.x = cvt_pk_bf16(v0[0], v0[1]); w.y = cvt_pk_bf16(v0[2], v0[3]); w.z = cvt_pk_bf16(v1[0], v1[1]); w.w = cvt_pk_bf16(v1[2], v1[3]);
                        *(GAS u32x4*)(O + row * ldc + col) = w; } } }
    }
};
struct EpiUp {
    static constexpr bool PERM = true, AFTER_DRAIN = false;
    GAS bf16_t* O; GAS bf16_t* O2; int ldc; int nvalid; const GAS float* rs; int rsi; int mode;
    __device__ __forceinline__ void operator()(const f32x4 (&acc)[2][2][4][2], const Unit& u, int wr, int wc, int fr, int fq) const {
        { const int l_ = pg8_lane_id(); fr = l_ & 15; fq = l_ >> 4; }
#pragma unroll
        for (int ai = 0; ai < 2; ++ai)
#pragma unroll
            for (int m = 0; m < 4; ++m) { const size_t row = (size_t)u.pm * BM + ai * HALF + wr * 64 + m * 16 + fr; const float s = rs[2 * row + rsi];
#pragma unroll
                for (int bj = 0; bj < 2; ++bj) { const int col = u.pn * BM + bj * HALF + wc * 32 + 8 * fq;
                    if (col < nvalid) { const f32x4 v0 = acc[ai][bj][m][0] * s, v1 = acc[ai][bj][m][1] * s; u32x4 w; w.x = cvt_pk_bf16(v0[0], v0[1]); w.y = cvt_pk_bf16(v0[2], v0[3]); w.z = cvt_pk_bf16(v1[0], v1[1]); w.w = cvt_pk_bf16(v1[2], v1[3]);
                        GAS bf16_t* dst;
                        if (mode == 0) dst = O + row * ldc + col;
                        else { const int h = col >> 7, j = col & 127; dst = (j < 64) ? O + row * 384 + h * 96 + j : O2 + row * 256 + h * 64 + (j - 64); }
                        *(GAS u32x4*)dst = w; } } }
    }
};

struct EpiRes {
    static constexpr bool PERM = true, AFTER_DRAIN = false;
    GAS bf16_t* XB; GAS float* SSQ;
    __device__ __forceinline__ void operator()(const f32x4 (&acc)[2][2][4][2], const Unit& u, int wr, int wc, int fr, int fq) const {
        { const int l_ = pg8_lane_id(); fr = l_ & 15; fq = l_ >> 4; }
#pragma unroll
        for (int ai = 0; ai < 2; ++ai)
#pragma unroll
            for (int m = 0; m < 4; ++m) { const size_t row = (size_t)u.pm * BM + ai * HALF + wr * 64 + m * 16 + fr; float ss = 0.f;
#pragma unroll
                for (int bj = 0; bj < 2; ++bj) { GAS u32x4* p = (GAS u32x4*)(XB + row * 1024 + u.pn * BM + bj * HALF + wc * 32 + 8 * fq);
                    const u32x4 o = *p; const f32x4 v0 = acc[ai][bj][m][0], v1 = acc[ai][bj][m][1];
                    u32x4 w;
                    w.x = cvt_pk_bf16(__builtin_bit_cast(float, o.x << 16) + v0[0], __builtin_bit_cast(float, o.x & 0xffff0000u) + v0[1]);
                    w.y = cvt_pk_bf16(__builtin_bit_cast(float, o.y << 16) + v0[2], __builtin_bit_cast(float, o.y & 0xffff0000u) + v0[3]);
                    w.z = cvt_pk_bf16(__builtin_bit_cast(float, o.z << 16) + v1[0], __builtin_bit_cast(float, o.z & 0xffff0000u) + v1[1]);
                    w.w = cvt_pk_bf16(__builtin_bit_cast(float, o.w << 16) + v1[2], __builtin_bit_cast(float, o.w & 0xffff0000u) + v1[3]);
                    *p = w;
#pragma unroll
                    for (int e = 0; e < 4; ++e) { const float a = __builtin_bit_cast(float, w[e] << 16), b = __builtin_bit_cast(float, w[e] & 0xffff0000u); ss += a * a + b * b; } }
                { float a = ss, b = ss; asm volatile("v_nop\n\tv_nop\n\tv_permlane16_swap_b32 %0, %1" : "+v"(a), "+v"(b)); ss = a + b; }
                { float a = ss, b = ss; asm volatile("v_nop\n\tv_nop\n\tv_permlane32_swap_b32 %0, %1" : "+v"(a), "+v"(b)); ss = a + b; }
                if (fq == 0) SSQ[row * 16 + 4 * u.pn + wc] = ss; }
    }
};
template <class Epi, class Sched, bool ALIGN_EPI = false, bool SP2 = false>
__device__ __forceinline__ void gemm_phase(PG8_LAS unsigned char* lds, const Gemm g, const Sched& S, const Epi& E, int wave_id) {
    int tid_ = (wave_id << 6) | pg8_lane_id(); asm volatile("" : "+v"(tid_));
    const int tid = tid_, wid = __builtin_amdgcn_readfirstlane(tid >> 6), lane = tid & 63, wr = wid >> 2, wc = wid & 3, fr = lane & 15, fq = lane >> 4;
    const int K = g.K, nt = K / BK;
    unsigned voffA[2], voffB[2];
#pragma unroll
    for (int i = 0; i < 2; ++i) { int R, C; stage_rc(tid * 16 + i * 8192, R, C); const int Rb = Epi::PERM ? ((R & ~31) + perm32(R & 31)) : R;
        voffA[i] = (unsigned)(R * g.lda + C) * 2u; voffB[i] = (unsigned)(Rb * g.ldb + C) * 2u; }
    const size_t kstep = (size_t)(BK * 2);
    const size_t hstepA = (size_t)HALF * g.lda * 2, hstepB = (size_t)HALF * g.ldb * 2;
    const size_t tstepA = 2 * hstepA, tstepB = 2 * hstepB;
    const unsigned ldsw = (unsigned)wid * 1024u;
    const int aoff = lds_byte(wr * 64 + fr, fq * 8), boff = lds_byte(wc * 32 + fr, fq * 8);
#define PG8_SA(b, h) (((b) * 2 + (h)) * HTB)
#define PG8_SB(b, h) ((4 + (b) * 2 + (h)) * HTB)
#define PG8_STAGE(bufoff, gbase, voff) do { _Pragma("unroll") for (int _i = 0; _i < 2; ++_i) \
        __builtin_amdgcn_global_load_lds((const unsigned*)((const char*)(gbase) + (voff)[_i]), (PG8_LAS unsigned*)(lds + (bufoff) + ldsw + _i * 8192), 16, 0, 0); } while (0)
#define PG8_LDA(dst, b, h) do { _Pragma("unroll") for (int m = 0; m < 4; ++m) _Pragma("unroll") for (int k = 0; k < 2; ++k) dst[m][k] = *(const PG8_LAS bf16x8*)(lds + PG8_SA(b, h) + aoff + m * 2048 + k * 1024); } while (0)
#define PG8_LDB(dst, b, h) do { _Pragma("unroll") for (int n = 0; n < 2; ++n) _Pragma("unroll") for (int k = 0; k < 2; ++k) dst[n][k] = *(const PG8_LAS bf16x8*)(lds + PG8_SB(b, h) + boff + n * 2048 + k * 1024); } while (0)
#define PG8_MMA(ai, bj, At, Bt) do { __builtin_amdgcn_s_setprio(1); _Pragma("unroll") for (int m = 0; m < 4; ++m) _Pragma("unroll") for (int n = 0; n < 2; ++n) _Pragma("unroll") for (int k = 0; k < 2; ++k) \
        acc[ai][bj][m][n] = __builtin_amdgcn_mfma_f32_16x16x32_bf16(Bt[n][k], At[m][k], acc[ai][bj][m][n], 0, 0, 0); __builtin_amdgcn_s_setprio(0); } while (0)
#define PG8_WAIT_V(n) asm volatile("s_waitcnt vmcnt(" #n ")" ::: "memory")
#define PG8_WAIT_L(n) asm volatile("s_waitcnt lgkmcnt(" #n ")" ::: "memory")
#define PG8_BAR __builtin_amdgcn_s_barrier()
#define PG8_SCHED __builtin_amdgcn_sched_barrier(0)
    Unit cur, nxt; int ui = 0;
    if (!S.next(0, cur)) return;
    f32x4 acc[2][2][4][2];
#pragma unroll
    for (int a = 0; a < 2; ++a)
#pragma unroll
        for (int b = 0; b < 2; ++b)
#pragma unroll
            for (int m = 0; m < 4; ++m)
#pragma unroll
                for (int n = 0; n < 2; ++n) acc[a][b][m][n] = (f32x4){0.f, 0.f, 0.f, 0.f};
    bf16x8 At[4][2], B0[2][2], B1[2][2];
    const char* cA = (const char*)g.A + (size_t)cur.pm * tstepA; const char* cB = (const char*)g.Bt + (size_t)cur.pn * tstepB;
    S.a_ready(cur);
    if constexpr (SP2) {
        PG8_STAGE(PG8_SB(0, 0), cB, voffB); PG8_STAGE(PG8_SB(0, 1), cB + hstepB, voffB); PG8_STAGE(PG8_SA(0, 0), cA, voffA); PG8_STAGE(PG8_SA(0, 1), cA + hstepA, voffA);
        if (wr == 1) PG8_BAR;
        PG8_WAIT_V(2); PG8_BAR;
        PG8_STAGE(PG8_SB(1, 0), cB + kstep, voffB); PG8_STAGE(PG8_SA(1, 0), cA + kstep, voffA); PG8_STAGE(PG8_SB(1, 1), cB + hstepB + kstep, voffB);
        PG8_WAIT_V(6); PG8_BAR;
    } else {
        PG8_STAGE(PG8_SB(0, 0), cB, voffB); PG8_STAGE(PG8_SA(0, 0), cA, voffA); PG8_STAGE(PG8_SB(0, 1), cB + hstepB, voffB); PG8_STAGE(PG8_SA(0, 1), cA + hstepA, voffA);
        if (wr == 1) PG8_BAR;
        PG8_WAIT_V(4); PG8_BAR;
        PG8_STAGE(PG8_SB(1, 0), cB + kstep, voffB); PG8_STAGE(PG8_SA(1, 0), cA + kstep, voffA); PG8_STAGE(PG8_SB(1, 1), cB + hstepB + kstep, voffB);
        PG8_WAIT_V(6); PG8_BAR;
    }
    for (;;) {
        const bool has_next = S.next(ui + 1, nxt);
        const char* nA = has_next ? (const char*)g.A + (size_t)nxt.pm * tstepA : cA; const char* nB = has_next ? (const char*)g.Bt + (size_t)nxt.pn * tstepB : cB;
        for (int t = 0; t < nt; t += 2) {
            const bool last = (t == nt - 2);
            const char* a1 = cA + (size_t)(t + 1) * kstep;
            const char* a2 = last ? nA : cA + (size_t)(t + 2) * kstep; const char* b2 = last ? nB : cB + (size_t)(t + 2) * kstep;
            const char* a3 = a2 + kstep; const char* b3 = b2 + kstep;
            if (last && has_next) S.a_ready(nxt);
            if constexpr (SP2) {
            PG8_LDB(B0, 0, 0); PG8_LDB(B1, 0, 1); PG8_SCHED; PG8_LDA(At, 0, 0); PG8_STAGE(PG8_SA(1, 1), a1 + hstepA, voffA);
            PG8_WAIT_V(8); PG8_WAIT_L(0); PG8_BAR; PG8_MMA(0, 0, At, B0); PG8_MMA(0, 1, At, B1); PG8_BAR; PG8_SCHED;
            PG8_LDA(At, 0, 1); PG8_STAGE(PG8_SB(0, 0), b2, voffB); PG8_STAGE(PG8_SB(0, 1), b2 + hstepB, voffB); PG8_STAGE(PG8_SA(0, 0), a2, voffA);
            PG8_WAIT_V(8); PG8_WAIT_L(0); PG8_BAR; PG8_MMA(1, 0, At, B0); PG8_MMA(1, 1, At, B1); PG8_BAR; PG8_SCHED;
            PG8_LDB(B0, 1, 0); PG8_LDB(B1, 1, 1); PG8_SCHED; PG8_LDA(At, 1, 0); PG8_STAGE(PG8_SA(0, 1), a2 + hstepA, voffA);
            PG8_WAIT_V(8); PG8_WAIT_L(0); PG8_BAR; PG8_MMA(0, 0, At, B0); PG8_MMA(0, 1, At, B1); PG8_BAR; PG8_SCHED;
            PG8_LDA(At, 1, 1); PG8_STAGE(PG8_SB(1, 0), b3, voffB); PG8_STAGE(PG8_SB(1, 1), b3 + hstepB, voffB); PG8_STAGE(PG8_SA(1, 0), a3, voffA);
            PG8_WAIT_V(8); PG8_WAIT_L(0); PG8_BAR; PG8_MMA(1, 0, At, B0); PG8_MMA(1, 1, At, B1); PG8_BAR; PG8_SCHED;
            } else {
            PG8_LDB(B0, 0, 0); PG8_SCHED; PG8_LDA(At, 0, 0); PG8_STAGE(PG8_SA(1, 1), a1 + hstepA, voffA);
            PG8_WAIT_L(8); PG8_BAR; PG8_WAIT_L(0); PG8_MMA(0, 0, At, B0); PG8_BAR; PG8_SCHED;
            PG8_LDB(B1, 0, 1); PG8_STAGE(PG8_SB(0, 0), b2, voffB);
            PG8_BAR; PG8_WAIT_L(0); PG8_MMA(0, 1, At, B1); PG8_BAR;
            PG8_LDA(At, 0, 1); PG8_STAGE(PG8_SA(0, 0), a2, voffA);
            PG8_BAR; PG8_WAIT_L(0); PG8_MMA(1, 0, At, B0); PG8_BAR; PG8_SCHED;
            PG8_STAGE(PG8_SB(0, 1), b2 + hstepB, voffB);
            PG8_WAIT_V(6); PG8_BAR; PG8_MMA(1, 1, At, B1); PG8_BAR;
            PG8_LDB(B0, 1, 0); PG8_SCHED; PG8_LDA(At, 1, 0); PG8_STAGE(PG8_SA(0, 1), a2 + hstepA, voffA);
            PG8_WAIT_L(8); PG8_BAR; PG8_WAIT_L(0); PG8_MMA(0, 0, At, B0); PG8_BAR; PG8_SCHED;
            PG8_LDB(B1, 1, 1); PG8_STAGE(PG8_SB(1, 0), b3, voffB);
            PG8_BAR; PG8_WAIT_L(0); PG8_MMA(0, 1, At, B1); PG8_BAR;
            PG8_LDA(At, 1, 1); PG8_STAGE(PG8_SA(1, 0), a3, voffA);
            PG8_BAR; PG8_WAIT_L(0); PG8_MMA(1, 0, At, B0); PG8_BAR; PG8_SCHED;
            PG8_STAGE(PG8_SB(1, 1), b3 + hstepB, voffB);
            PG8_WAIT_V(6); PG8_BAR; PG8_MMA(1, 1, At, B1); PG8_BAR;
            }
        }
        if constexpr (ALIGN_EPI) { if (wr == 0) PG8_BAR; }
        if constexpr (!Epi::AFTER_DRAIN) { E(acc, cur, wr, wc, fr, fq); S.done(cur); }
        if (!has_next) break;
#pragma unroll
        for (int a = 0; a < 2; ++a)
#pragma unroll
            for (int b = 0; b < 2; ++b)
#pragma unroll
                for (int m = 0; m < 4; ++m)
#pragma unroll
                    for (int n = 0; n < 2; ++n) acc[a][b][m][n] = (f32x4){0.f, 0.f, 0.f, 0.f};
        cur = nxt; cA = nA; cB = nB; ++ui;
        if constexpr (ALIGN_EPI) { if (wr == 1) PG8_BAR; }
    }
    PG8_WAIT_V(0);
    if constexpr (!ALIGN_EPI) { if (wr == 0) PG8_BAR; }
    PG8_BAR;
    if constexpr (Epi::AFTER_DRAIN) { E.fused(acc, cur, wr, wc, fr, fq, lds, wid, lane); S.done(cur); }
#undef PG8_SA
#undef PG8_SB
#undef PG8_STAGE
#undef PG8_LDA
#undef PG8_LDB
#undef PG8_MMA
#undef PG8_WAIT_V
#undef PG8_WAIT_L
#undef PG8_BAR
#undef PG8_SCHED
}
}

namespace mk {
#ifndef GAS
#define GAS __attribute__((address_space(1)))
#endif
#define LAS __attribute__((address_space(3)))
typedef unsigned short bf16;
typedef unsigned v4u __attribute__((ext_vector_type(4)));
typedef unsigned v2u __attribute__((ext_vector_type(2)));
typedef float f32x4 __attribute__((ext_vector_type(4)));
typedef GAS unsigned gu32;
#define LDS_WAIT() asm volatile("s_waitcnt lgkmcnt(0)" ::: "memory")
#define VM_WAIT() asm volatile("s_waitcnt vmcnt(0)" ::: "memory")
__device__ __forceinline__ unsigned f2bf_(float f) { unsigned u = __builtin_bit_cast(unsigned, f); return (u + 0x7fffu + ((u >> 16) & 1u)) >> 16; }
__device__ __forceinline__ unsigned pk2(float lo, float hi) { return f2bf_(lo) | (f2bf_(hi) << 16); }
__device__ __forceinline__ float bflo(unsigned w) { return __builtin_bit_cast(float, w << 16); }
__device__ __forceinline__ float bfhi(unsigned w) { return __builtin_bit_cast(float, w & 0xffff0000u); }

template <class P> __device__ __forceinline__ P* opq(P* p) { asm volatile("" : "+s"(p)); return p; }
__device__ __forceinline__ int opqi(int k) { asm volatile("" : "+s"(k)); return k; }
__device__ __forceinline__ float shx(float v, int o, int lane) { return __builtin_bit_cast(float, __builtin_amdgcn_ds_bpermute((lane ^ o) << 2, __builtin_bit_cast(int, v))); }
__device__ __forceinline__ int shxi(int v, int o, int lane) { return __builtin_amdgcn_ds_bpermute((lane ^ o) << 2, v); }
__device__ __forceinline__ int lane_id_v() { int l; asm volatile("v_mbcnt_lo_u32_b32 %0, -1, 0\n\tv_mbcnt_hi_u32_b32 %0, -1, %0" : "=v"(l)); return l; }
constexpr int NWAVES = 8;
constexpr int D = 1024, NB = 4, S = 8192, T = NB * S, L = 4, MEM = 256, INW = 2144, INP = 2304;
constexpr int PC_CQ = 0, PC_CKV = 256, PC_KR = 384, PC_XL = 512, PC_GL = 1024, PC_QD = 1536, PC_KD = 1792, PC_VD = 2048;
constexpr float LOG2E = 1.4426950408889634f;
constexpr size_t MiB = 1u << 20;
constexpr size_t WS_CTL = 0, CTL_ZERO_BYTES = 1 * MiB;
constexpr size_t WS_WIN = 1 * MiB, WS_WOUT = 19 * MiB, WS_WCQ = 27 * MiB, WS_WCO = 35 * MiB, WS_WPQ = 43 * MiB, WS_WCKV = 51 * MiB, WS_WUQ = 67 * MiB, WS_WUKV = 68 * MiB, WS_KEYS = 69 * MiB, WS_ROPE = 70 * MiB;
constexpr size_t WS_XNB = 76 * MiB, WS_YB = 140 * MiB, WS_PROJB = 204 * MiB, WS_QMB = 348 * MiB, WS_KMB = 372 * MiB, WS_VMB = 396 * MiB, WS_RS = 412 * MiB;
constexpr size_t WS_HLB = 413 * MiB, WS_ACB = 445 * MiB, WS_LSUM = 477 * MiB, WS_OMB = 478 * MiB, WS_MNB = 494 * MiB, WS_KVCB = 502 * MiB, WS_EX = 518 * MiB, WS_GW = 534 * MiB;
constexpr size_t WS_U8 = 550 * MiB, WS_V8 = 614 * MiB, WS_SU = 678 * MiB, WS_SV = 679 * MiB;
constexpr size_t WS_HQ = 680 * MiB, WS_P = 712 * MiB, WS_SH = 728 * MiB, WS_W = 729 * MiB, WS_WS = 745 * MiB, WS_SSQ = 746 * MiB, WS_END = 748 * MiB;
constexpr size_t WS_WAT = 74 * MiB;
constexpr size_t WS_BTAB = WS_KEYS + 512 * 1024, WS_LAMS = WS_BTAB + 4096, WS_SP = WS_LAMS + 4096;
constexpr int CW_BAR = 4096, CW_RANK = 8192;
constexpr int RING_OFF = 0, RING_BYTES = 155648, LDSCTL_OFF = RING_BYTES, MISC_OFF = LDSCTL_OFF + 320, LDS_BYTES = 163840;

#define XB_TMO      128
#define XB_XCNT(j)  (256  + 64 * (j))
#define XB_XSUB(j)  (1280 + 64 * (j))
#define XB_XGEN(j)  (2304 + 64 * (j))
#define XB_TOP      3328
#define XB_TOPGEN   3392
#define XCD_BAR_WORDS 3456
#define XB_SPIN_CAP (1u << 18)

__device__ __forceinline__ unsigned xb_ld(unsigned* p)              { return __hip_atomic_load(p, __ATOMIC_RELAXED, __HIP_MEMORY_SCOPE_AGENT); }
__device__ __forceinline__ unsigned xb_add(unsigned* p, unsigned v) { return __hip_atomic_fetch_add(p, v, __ATOMIC_RELAXED, __HIP_MEMORY_SCOPE_AGENT); }
__device__ __forceinline__ unsigned xb_xcc_id() { return (unsigned)__builtin_amdgcn_s_getreg((3 << 11) | 20) & 0xFu; }
#define XB_SPIN(cond, bar) do { unsigned _sp = 0; while (cond) { __builtin_amdgcn_s_sleep(1); \
    if ((++_sp & 255u) == 0u) { if (xb_ld(&(bar)[XB_TMO])) break; if (_sp > XB_SPIN_CAP) { atomicAdd(&(bar)[XB_TMO], 1u); break; } } } } while (0)

struct XcdBarrier {
    unsigned* bar; unsigned x;
    volatile LAS unsigned* st;
};

__device__ __forceinline__ XcdBarrier xcd_barrier_post(unsigned* bar, volatile LAS unsigned* st) {
    XcdBarrier b; b.bar = bar; b.x = xb_xcc_id(); b.st = st;
    if (threadIdx.x == 0) (void)xb_add(&bar[XB_XCNT(b.x)], 1u);
    return b;
}
__device__ __forceinline__ void xcd_barrier_complete(unsigned* bar, unsigned x, unsigned& nloc, unsigned& nx) {
    const unsigned G = gridDim.x * gridDim.y * gridDim.z;
    unsigned sum, cnt, mine, sp = 0u;
    for (;;) {
        sum = 0u; cnt = 0u; mine = 0u;
#pragma unroll
        for (unsigned j = 0; j < 16; ++j) { const unsigned c = xb_ld(&bar[XB_XCNT(j)]); sum += c; cnt += (c > 0u) ? 1u : 0u; mine = (j == x) ? c : mine; }
        if (sum == G) break;
        __builtin_amdgcn_s_sleep(1);
        if ((++sp & 255u) == 0u) { if (xb_ld(&bar[XB_TMO])) break; if (sp > XB_SPIN_CAP) { atomicAdd(&bar[XB_TMO], 1u); break; } }
    }
    nloc = mine > 0u ? mine : 1u; nx = cnt > 0u ? cnt : 1u;
}

__device__ __noinline__ void xcd_barrier_impl(unsigned* bar_, unsigned x_, volatile LAS unsigned* st_, int leader_) {
    XcdBarrier b; b.bar = bar_; b.x = x_; b.st = st_;
    asm volatile("s_waitcnt vmcnt(0)" ::: "memory");
    __syncthreads();
    if (leader_) {
        unsigned* bar = b.bar;
        __builtin_amdgcn_s_waitcnt(0);
        unsigned nloc = b.st[0], nx = b.st[1];
        if (nloc == 0u) { xcd_barrier_complete(bar, b.x, nloc, nx); b.st[0] = nloc; b.st[1] = nx; }
        const unsigned old = xb_add(&bar[XB_XSUB(b.x)], 1u);
        const unsigned gen = old / nloc;
        if (old + 1u == (gen + 1u) * nloc) {
            __builtin_amdgcn_fence(__ATOMIC_RELEASE, "agent");
            asm volatile("s_waitcnt vmcnt(0)" ::: "memory");
            const unsigned og = xb_add(&bar[XB_TOP], 1u);
            const unsigned tg = og / nx;
            if (og + 1u == (tg + 1u) * nx) xb_add(&bar[XB_TOPGEN], 1u);
            else XB_SPIN(xb_ld(&bar[XB_TOPGEN]) == tg, bar);
            __builtin_amdgcn_fence(__ATOMIC_ACQUIRE, "agent");
            xb_add(&bar[XB_XGEN(b.x)], 1u);
            asm volatile("s_waitcnt vmcnt(0)" ::: "memory");
        } else {
            XB_SPIN(xb_ld(&bar[XB_XGEN(b.x)]) == gen, bar);
            __builtin_amdgcn_fence(__ATOMIC_ACQUIRE, "agent");
            asm volatile("s_waitcnt vmcnt(0)" ::: "memory");
        }
    }
    __syncthreads();
}
__device__ __forceinline__ void xcd_barrier(const XcdBarrier& b, int leader) { xcd_barrier_impl(b.bar, b.x, b.st, leader); }


__device__ __forceinline__ float wave_sum(float v, int lane) {
    (void)lane;
    v += __builtin_bit_cast(float, __builtin_amdgcn_update_dpp(0, __builtin_bit_cast(int, v), 0xB1, 0xF, 0xF, true));
    v += __builtin_bit_cast(float, __builtin_amdgcn_update_dpp(0, __builtin_bit_cast(int, v), 0x4E, 0xF, 0xF, true));
    v += __builtin_bit_cast(float, __builtin_amdgcn_update_dpp(0, __builtin_bit_cast(int, v), 0x141, 0xF, 0xF, true));
    v += __builtin_bit_cast(float, __builtin_amdgcn_update_dpp(0, __builtin_bit_cast(int, v), 0x140, 0xF, 0xF, true));
    { float a = v, b = v; asm volatile("v_nop\n\tv_nop\n\tv_permlane16_swap_b32 %0, %1" : "+v"(a), "+v"(b)); v = a + b; }
    { float a = v, b = v; asm volatile("v_nop\n\tv_nop\n\tv_permlane32_swap_b32 %0, %1" : "+v"(a), "+v"(b)); v = a + b; }
    return v;
}
__device__ __forceinline__ float wave_max(float v) {
    v = fmaxf(v, __builtin_bit_cast(float, __builtin_amdgcn_update_dpp(0, __builtin_bit_cast(int, v), 0xB1, 0xF, 0xF, true)));
    v = fmaxf(v, __builtin_bit_cast(float, __builtin_amdgcn_update_dpp(0, __builtin_bit_cast(int, v), 0x4E, 0xF, 0xF, true)));
    v = fmaxf(v, __builtin_bit_cast(float, __builtin_amdgcn_update_dpp(0, __builtin_bit_cast(int, v), 0x141, 0xF, 0xF, true)));
    v = fmaxf(v, __builtin_bit_cast(float, __builtin_amdgcn_update_dpp(0, __builtin_bit_cast(int, v), 0x140, 0xF, 0xF, true)));
    { float a = v, b = v; asm volatile("v_nop\n\tv_nop\n\tv_permlane16_swap_b32 %0, %1" : "+v"(a), "+v"(b)); v = fmaxf(a, b); }
    { float a = v, b = v; asm volatile("v_nop\n\tv_nop\n\tv_permlane32_swap_b32 %0, %1" : "+v"(a), "+v"(b)); v = fmaxf(a, b); }
    return v;
}
__device__ __forceinline__ float gelu_erf(float v) {
    const float av = __builtin_fabsf(v), t = __builtin_amdgcn_rcpf(av * 0.2316418882f + 1.0f);
    float q = t * 0.5307027145f + (-0.7265760135f); q = q * t + 0.7107068705f; q = q * t + (-0.142248368f); q = q * t + 0.127414796f; q = q * t;
    const float e = __builtin_amdgcn_exp2f((v * v) * (-0.72134752044f));
    const float m = v * (q * e);
    return v < 0.f ? m : v - m;
}

__device__ __forceinline__ void norm_phase(const GAS float* X, const GAS float* g, GAS bf16* out, int rows, int gw, int NGW, int lane) {
    asm volatile("" : "+v"(lane));
    f32x4 gv[4];
#pragma unroll
    for (int j = 0; j < 4; ++j) gv[j] = ((const GAS f32x4*)g)[lane + 64 * j];
    for (int m = gw; m < rows; m += NGW) {
        const GAS f32x4* xr = (const GAS f32x4*)(X + (size_t)m * D) + lane;
        f32x4 v[4]; float s = 0.f;
#pragma unroll
        for (int j = 0; j < 4; ++j) { v[j] = xr[64 * j]; s += (v[j].x * v[j].x + v[j].y * v[j].y) + (v[j].z * v[j].z + v[j].w * v[j].w); }
        const float rs = rsqrtf(wave_sum(s, lane) * (1.f / D) + 1e-6f);
        GAS v2u* o8 = (GAS v2u*)(out + (size_t)m * D) + lane;
#pragma unroll
        for (int j = 0; j < 4; ++j) { v2u w; w.x = pk2(v[j].x * rs * gv[j].x, v[j].y * rs * gv[j].y); w.y = pk2(v[j].z * rs * gv[j].z, v[j].w * rs * gv[j].w); o8[64 * j] = w; }
    }
}
__device__ __forceinline__ void hq_phase(const GAS bf16* XB, const GAS float* SSQ, const GAS float* g, GAS unsigned char* HQ, GAS float* SH, GAS int* Pz, int gw, int NGW, int lane) {
    asm volatile("" : "+v"(lane));
    const GAS f32x4* gp = (const GAS f32x4*)g + 4 * lane; const f32x4 g0 = gp[0], g1 = gp[1], g2 = gp[2], g3 = gp[3];
    for (int m = gw; m < T; m += NGW) {
        const GAS f32x4* sp = (const GAS f32x4*)(SSQ + (size_t)m * 16); const f32x4 t = (sp[0] + sp[1]) + (sp[2] + sp[3]);
        const float rs = __builtin_amdgcn_rsqf(((t[0] + t[1]) + (t[2] + t[3])) * (1.f / 1024.f) + 1e-6f);
        const v4u a = *(const GAS v4u*)(XB + (size_t)m * D + 16 * lane), b = *(const GAS v4u*)(XB + (size_t)m * D + 16 * lane + 8);
        float f[16] = {bflo(a.x) * g0[0], bfhi(a.x) * g0[1], bflo(a.y) * g0[2], bfhi(a.y) * g0[3], bflo(a.z) * g1[0], bfhi(a.z) * g1[1], bflo(a.w) * g1[2], bfhi(a.w) * g1[3],
                       bflo(b.x) * g2[0], bfhi(b.x) * g2[1], bflo(b.y) * g2[2], bfhi(b.y) * g2[3], bflo(b.z) * g3[0], bfhi(b.z) * g3[1], bflo(b.w) * g3[2], bfhi(b.w) * g3[3]};
        float mx = 0.f;
#pragma unroll
        for (int i = 0; i < 16; ++i) { f[i] *= rs; mx = fmaxf(mx, __builtin_fabsf(f[i])); }
        mx = wave_max(mx);
        const float inv = mx > 0.f ? 127.f / mx : 0.f;
        v4u q;
#pragma unroll
        for (int i = 0; i < 4; ++i) { const int ia = (int)__builtin_rintf(f[4 * i] * inv), ib = (int)__builtin_rintf(f[4 * i + 1] * inv), ic = (int)__builtin_rintf(f[4 * i + 2] * inv), id = (int)__builtin_rintf(f[4 * i + 3] * inv);
            q[i] = (unsigned)(ia & 255) | ((unsigned)(ib & 255) << 8) | ((unsigned)(ic & 255) << 16) | ((unsigned)(id & 255) << 24); }
        *(GAS v4u*)(HQ + (size_t)m * D + 16 * lane) = q;
        if (lane == 0) SH[m] = mx * (1.f / 127.f);
        (Pz + (size_t)m * 128)[lane] = 0; (Pz + (size_t)m * 128)[lane + 64] = 0;
    }
}
__device__ __forceinline__ void x0_phase(const GAS float* X, GAS bf16* XB, GAS float* SSQ, int gw, int NGW, int lane) {
    asm volatile("" : "+v"(lane));
    for (int m = gw; m < T; m += NGW) {
        const GAS f32x4* xr = (const GAS f32x4*)(X + (size_t)m * D) + lane; GAS v2u* o8 = (GAS v2u*)(XB + (size_t)m * D) + lane;
        float s = 0.f;
#pragma unroll
        for (int j = 0; j < 4; ++j) { const f32x4 v = xr[64 * j]; s += (v.x * v.x + v.y * v.y) + (v.z * v.z + v.w * v.w); v2u w; w.x = pk2(v.x, v.y); w.y = pk2(v.z, v.w); o8[64 * j] = w; }
        s = wave_sum(s, lane);
        if (lane < 8) SSQ[(size_t)m * 16 + lane] = lane == 0 ? s : 0.f;
    }
}
__device__ __forceinline__ void final_norm_phase(const GAS bf16* XB, GAS float* O, const GAS float* g, int rows, int gw, int NGW, int lane) {
    asm volatile("" : "+v"(lane));
    for (int m = gw; m < rows; m += NGW) {
        const GAS v4u* xr = (const GAS v4u*)(XB + (size_t)m * D) + lane;
        v4u v[2]; float s = 0.f;
#pragma unroll
        for (int j = 0; j < 2; ++j) { v[j] = xr[64 * j];
#pragma unroll
            for (int e = 0; e < 4; ++e) { const float a = bflo(v[j][e]), b = bfhi(v[j][e]); s += a * a + b * b; } }
        const float rs = rsqrtf(wave_sum(s, lane) * (1.f / D) + 1e-6f);
#pragma unroll
        for (int j = 0; j < 2; ++j) { const int c = 8 * (lane + 64 * j); const f32x4 g0 = *(const GAS f32x4*)(g + c), g1 = *(const GAS f32x4*)(g + c + 4);
            f32x4 o0, o1; o0.x = bflo(v[j].x) * rs * g0.x; o0.y = bfhi(v[j].x) * rs * g0.y; o0.z = bflo(v[j].y) * rs * g0.z; o0.w = bfhi(v[j].y) * rs * g0.w;
            o1.x = bflo(v[j].z) * rs * g1.x; o1.y = bfhi(v[j].z) * rs * g1.y; o1.z = bflo(v[j].w) * rs * g1.z; o1.w = bfhi(v[j].w) * rs * g1.w;
            *(GAS f32x4*)(O + (size_t)m * D + c) = o0; *(GAS f32x4*)(O + (size_t)m * D + c + 4) = o1; }
    }
}

__device__ __forceinline__ float row16_sum(float v) {
    v += __builtin_bit_cast(float, __builtin_amdgcn_update_dpp(0, __builtin_bit_cast(int, v), 0xB1, 0xF, 0xF, true));
    v += __builtin_bit_cast(float, __builtin_amdgcn_update_dpp(0, __builtin_bit_cast(int, v), 0x4E, 0xF, 0xF, true));
    v += __builtin_bit_cast(float, __builtin_amdgcn_update_dpp(0, __builtin_bit_cast(int, v), 0x141, 0xF, 0xF, true));
    v += __builtin_bit_cast(float, __builtin_amdgcn_update_dpp(0, __builtin_bit_cast(int, v), 0x140, 0xF, 0xF, true));
    return v;
}
__device__ __forceinline__ float sq8(const v4u w) { const float a0 = bflo(w.x), a1 = bfhi(w.x), a2 = bflo(w.y), a3 = bfhi(w.y), a4 = bflo(w.z), a5 = bfhi(w.z), a6 = bflo(w.w), a7 = bfhi(w.w);
    return (a0 * a0 + a1 * a1) + (a2 * a2 + a3 * a3) + (a4 * a4 + a5 * a5) + (a6 * a6 + a7 * a7); }
__device__ __forceinline__ void pre_phase(const GAS bf16* PROJB, const GAS float* ROPE, GAS float* RS, GAS bf16* KMB, int gw, int NGW, int lane) {
    asm volatile("" : "+v"(lane));
    const int q = lane >> 4, sub = lane & 15;
    for (int t0 = gw * 4; t0 < T; t0 += NGW * 4) {
        const size_t t = (size_t)t0 + q;
        const GAS bf16* pr = PROJB + t * INP;
        const v4u w0 = *(const GAS v4u*)(pr + PC_CQ + 8 * sub), w1 = *(const GAS v4u*)(pr + PC_CQ + 8 * (16 + (sub & 7))), w2 = *(const GAS v4u*)(pr + PC_CKV + 8 * sub);
        const float x1 = __builtin_bit_cast(float, (unsigned)pr[PC_KR + sub] << 16), x2 = __builtin_bit_cast(float, (unsigned)pr[PC_KR + 16 + sub] << 16);
        const float c = ROPE[t * 32 + sub], sn = ROPE[t * 32 + 16 + sub];
        const float sq = row16_sum(sq8(w0) + (sub < 8 ? sq8(w1) : 0.f)), skv = row16_sum(sq8(w2));
        if (sub == 0) { RS[2 * t] = rsqrtf(sq * (1.f / 192.f) + 1e-6f); RS[2 * t + 1] = rsqrtf(skv * (1.f / 128.f) + 1e-6f); }
        const bf16 y1 = (bf16)f2bf_(x1 * c - x2 * sn), y2 = (bf16)f2bf_(x1 * sn + x2 * c);
        GAS bf16* kr = KMB + t * 384 + 64 + sub;
#pragma unroll
        for (int h = 0; h < 4; ++h) { kr[h * 96] = y1; kr[h * 96 + 16] = y2; }
    }
}

typedef short lr_bf16x8 __attribute__((ext_vector_type(8)));
typedef float lr_f32x16 __attribute__((ext_vector_type(16)));
__device__ __forceinline__ void lr_swap32(float& a, float& b) { asm volatile("v_nop\n\tv_nop\n\tv_permlane32_swap_b32 %0, %1" : "+v"(a), "+v"(b)); }
constexpr int LR_XR = 0, LR_CW = LR_XR + 37376, LR_XA = LR_CW + 1280, LR_WT = LR_XA + 256 * 144, LR_SUM = LR_WT + 2 * 64 * 144, LR_END = LR_SUM + 4096;
struct LruP { const GAS bf16* PROJB; const GAS float* cw; const GAS float* cb; const GAS bf16* wat; const GAS float* ba; const GAS float* bx; const GAS float* sp; GAS unsigned* HA; GAS float* LSUM; };
__device__ __forceinline__ void lru_phase(const LruP& P, LAS unsigned char* lds, int tid, int wave, int lane, int vcu, int G) {
    asm volatile("" : "+v"(tid), "+v"(lane));
    LAS float* SUM = (LAS float*)(lds + LR_SUM);
    for (int u = vcu; u < (T / 256) * 8; u += G) {
        const int tile = u >> 3, g = u & 7; const int t0 = tile * 256; const bool first = ((tile & 31) == 0);
        __syncthreads();
        float ba_[2], bx_[2], sp_[2];
#pragma unroll
        for (int nt = 0; nt < 2; ++nt) { const int ch = 64 * g + 32 * nt + (lane & 31); ba_[nt] = P.ba[ch]; bx_[nt] = P.bx[ch]; sp_[nt] = P.sp[ch]; }
        { v4u wt_[2], xr_[5];
#pragma unroll
          for (int i = 0; i < 2; ++i) { const int idx = tid + 512 * i; wt_[i] = ((const GAS v4u*)(P.wat + (size_t)g * 2 * 4096))[idx]; }
#pragma unroll
          for (int i = 0; i < 5; ++i) { const int idx = tid + 512 * i, row = idx >> 3, part = idx & 7; const bool ok = (idx < 259 * 8) && !(first && row < 3);
              const int trow = ok ? t0 - 3 + row : t0;
              xr_[i] = *(const GAS v4u*)(P.PROJB + (size_t)trow * INP + PC_XL + 64 * g + 8 * part); if (!ok) xr_[i] = v4u{0u, 0u, 0u, 0u}; }
          float cwv = 0.f; if (tid < 320) cwv = (tid < 256) ? P.cw[(tid >> 6) * 512 + 64 * g + (tid & 63)] : P.cb[64 * g + (tid - 256)];
#pragma unroll
          for (int i = 0; i < 2; ++i) { const int idx = tid + 512 * i; *(LAS v4u*)(lds + LR_WT + (idx >> 9) * 9216 + ((idx >> 3) & 63) * 144 + (idx & 7) * 16) = wt_[i]; }
#pragma unroll
          for (int i = 0; i < 5; ++i) { const int idx = tid + 512 * i, row = idx >> 3, part = idx & 7; if (idx < 259 * 8) *(LAS v4u*)(lds + LR_XR + row * 144 + 16 * part) = xr_[i]; }
          if (tid < 320) ((LAS float*)(lds + LR_CW))[tid] = cwv; }
        __syncthreads();
        { float cwr[4][8], cbr[8];
#pragma unroll
          for (int k = 0; k < 4; ++k) { const f32x4 c0 = *(const LAS f32x4*)(lds + LR_CW + (k * 64 + 8 * wave) * 4), c1 = *(const LAS f32x4*)(lds + LR_CW + (k * 64 + 8 * wave + 4) * 4);
              cwr[k][0] = c0.x; cwr[k][1] = c0.y; cwr[k][2] = c0.z; cwr[k][3] = c0.w; cwr[k][4] = c1.x; cwr[k][5] = c1.y; cwr[k][6] = c1.z; cwr[k][7] = c1.w; }
          { const f32x4 c0 = *(const LAS f32x4*)(lds + LR_CW + (256 + 8 * wave) * 4), c1 = *(const LAS f32x4*)(lds + LR_CW + (256 + 8 * wave + 4) * 4);
            cbr[0] = c0.x; cbr[1] = c0.y; cbr[2] = c0.z; cbr[3] = c0.w; cbr[4] = c1.x; cbr[5] = c1.y; cbr[6] = c1.z; cbr[7] = c1.w; }
#pragma unroll
          for (int it_ = 0; it_ < 4; ++it_) { const int time = lane + 64 * it_;
              float y[8];
#pragma unroll
              for (int e = 0; e < 8; ++e) y[e] = cbr[e];
#pragma unroll
              for (int k = 0; k < 4; ++k) { const v4u w = *(const LAS v4u*)(lds + LR_XR + (time + k) * 144 + 16 * wave);
                  y[0] += bflo(w.x) * cwr[k][0]; y[1] += bfhi(w.x) * cwr[k][1]; y[2] += bflo(w.y) * cwr[k][2]; y[3] += bfhi(w.y) * cwr[k][3];
                  y[4] += bflo(w.z) * cwr[k][4]; y[5] += bfhi(w.z) * cwr[k][5]; y[6] += bflo(w.w) * cwr[k][6]; y[7] += bfhi(w.w) * cwr[k][7]; }
              v4u o; o.x = pk2(y[0], y[1]); o.y = pk2(y[2], y[3]); o.z = pk2(y[4], y[5]); o.w = pk2(y[6], y[7]);
              *(LAS v4u*)(lds + LR_XA + time * 144 + 16 * wave) = o; } }
        __syncthreads();
        const int r32 = lane & 31, hi = lane >> 5;
        lr_f32x16 acc[2][2];
#pragma unroll
        for (int nt = 0; nt < 2; ++nt) { const float b_a = ba_[nt], b_x = bx_[nt];
#pragma unroll
            for (int r = 0; r < 16; ++r) { acc[0][nt][r] = b_a; acc[1][nt][r] = b_x; } }
        { lr_bf16x8 af[4];
#pragma unroll
          for (int s_ = 0; s_ < 4; ++s_) af[s_] = *(const LAS lr_bf16x8*)(lds + LR_XA + (32 * wave + r32) * 144 + (16 * s_ + 8 * hi) * 2);
#pragma unroll
          for (int gt = 0; gt < 2; ++gt)
#pragma unroll
              for (int nt = 0; nt < 2; ++nt)
#pragma unroll
                  for (int s_ = 0; s_ < 4; ++s_) { const lr_bf16x8 bfr = *(const LAS lr_bf16x8*)(lds + LR_WT + gt * 9216 + (32 * nt + r32) * 144 + (16 * s_ + 8 * hi) * 2);
                      acc[gt][nt] = __builtin_amdgcn_mfma_f32_32x32x16_bf16(af[s_], bfr, acc[gt][nt], 0, 0, 0); } }
#pragma unroll
        for (int nt = 0; nt < 2; ++nt) { const float sp = sp_[nt];
            float sa_[4], sh_[4];
#pragma unroll
            for (int q = 0; q < 4; ++q) { float hrun = 0.f, arun = 1.f;
#pragma unroll
                for (int e = 0; e < 4; ++e) { const int r = 4 * q + e, tl = 8 * q + 4 * hi + e;
                    const float xv = __builtin_bit_cast(float, (unsigned)*(const LAS unsigned short*)(lds + LR_XA + (32 * wave + tl) * 144 + (32 * nt + r32) * 2) << 16);
                    const float rg = __builtin_amdgcn_rcpf(1.f + __builtin_amdgcn_exp2f(-LOG2E * acc[0][nt][r])), ig = __builtin_amdgcn_rcpf(1.f + __builtin_amdgcn_exp2f(-LOG2E * acc[1][nt][r]));
                    const float la = -8.0f * rg * sp; const float a_ = __builtin_amdgcn_exp2f(LOG2E * la);
                    const float uu = __builtin_amdgcn_sqrtf(fmaxf(1.f - a_ * a_, 0.f)) * (ig * xv);
                    hrun = a_ * hrun + uu; arun *= a_; acc[0][nt][r] = arun; acc[1][nt][r] = hrun; }
                sa_[q] = arun; sh_[q] = hrun; }
            float runA = 1.f, runH = 0.f;
#pragma unroll
            for (int q = 0; q < 4; ++q) { float a0 = sa_[q], a1 = sa_[q], h0 = sh_[q], h1 = sh_[q]; lr_swap32(a0, a1); lr_swap32(h0, h1);
                const float midA = runA * a0, midH = a0 * runH + h0;
                const float inA = hi ? midA : runA, inH = hi ? midH : runH;
                runA = midA * a1; runH = a1 * midH + h1;
#pragma unroll
                for (int e = 0; e < 4; ++e) { const int r = 4 * q + e; acc[1][nt][r] += acc[0][nt][r] * inH; acc[0][nt][r] *= inA; } }
            if (hi == 0) { SUM[(wave * 64 + 32 * nt + r32) * 2] = runA; SUM[(wave * 64 + 32 * nt + r32) * 2 + 1] = runH; } }
        __syncthreads();
#pragma unroll
        for (int nt = 0; nt < 2; ++nt) { const int cl = 32 * nt + r32;
            float ca = 1.f, chh = 0.f;
            for (int w = 0; w < wave; ++w) { const float aw = SUM[(w * 64 + cl) * 2], hw = SUM[(w * 64 + cl) * 2 + 1]; chh = aw * chh + hw; ca *= aw; }
            GAS unsigned* ha = P.HA + (size_t)(t0 + 32 * wave + 4 * hi) * 512 + 64 * g + cl;
#pragma unroll
            for (int r = 0; r < 16; ++r) { const float hh = acc[1][nt][r] + acc[0][nt][r] * chh, ac_ = acc[0][nt][r] * ca; ha[(size_t)((r & 3) + 8 * (r >> 2)) * 512] = pk2(hh, ac_);
                if (r == 15 && wave == 7 && hi == 1) { P.LSUM[((size_t)tile * 512 + 64 * g + cl) * 2] = ac_; P.LSUM[((size_t)tile * 512 + 64 * g + cl) * 2 + 1] = hh; } } }
    }
}

struct PostP { const GAS bf16* OMB; const GAS unsigned* HA; const GAS float* LSUM; const GAS bf16* PROJB; const GAS float* gm; const GAS float* gl; GAS bf16* Y; };
__device__ __forceinline__ void post_phase(const PostP& P, LAS unsigned char* lds, int tid, int wave, int lane, int vcu, int G) {
    asm volatile("" : "+v"(tid), "+v"(lane));
    LAS float* hin = (LAS float*)lds;
    for (int u = vcu; u < T / 64; u += G) {
        const int t0 = u * 64, tile = t0 >> 8, tb = tile & ~31;
        __syncthreads();
        { float h = 0.f;
          for (int c0 = tb; c0 < tile; c0 += 8) {
              float av_[8], hv_[8];
#pragma unroll
              for (int i = 0; i < 8; ++i) { const int c = (c0 + i < tile) ? (c0 + i) : tb; av_[i] = P.LSUM[((size_t)c * 512 + tid) * 2]; hv_[i] = P.LSUM[((size_t)c * 512 + tid) * 2 + 1]; }
#pragma unroll
              for (int i = 0; i < 8; ++i) { if (c0 + i < tile) h = av_[i] * h + hv_[i]; } }
          hin[tid] = h; }
        __syncthreads();
        f32x4 hi0 = *(const LAS f32x4*)(hin + 8 * lane), hi1 = *(const LAS f32x4*)(hin + 8 * lane + 4);
        const f32x4 g0 = *(const GAS f32x4*)(P.gl + 8 * lane), g1 = *(const GAS f32x4*)(P.gl + 8 * lane + 4), gmv = *(const GAS f32x4*)(P.gm + 4 * lane);
#pragma unroll 2
        for (int i = 0; i < 8; ++i) {
            const size_t t = (size_t)t0 + 8 * wave + i;
            const v4u p0 = *(const GAS v4u*)(P.HA + t * 512 + 8 * lane), p1 = *(const GAS v4u*)(P.HA + t * 512 + 8 * lane + 4), gw_ = *(const GAS v4u*)(P.PROJB + t * INP + PC_GL + 8 * lane);
            const v2u mw = *(const GAS v2u*)(P.OMB + t * 256 + 4 * lane);
            float o[8];
            o[0] = (bflo(p0.x) + bfhi(p0.x) * hi0.x) * gelu_erf(bflo(gw_.x)); o[1] = (bflo(p0.y) + bfhi(p0.y) * hi0.y) * gelu_erf(bfhi(gw_.x));
            o[2] = (bflo(p0.z) + bfhi(p0.z) * hi0.z) * gelu_erf(bflo(gw_.y)); o[3] = (bflo(p0.w) + bfhi(p0.w) * hi0.w) * gelu_erf(bfhi(gw_.y));
            o[4] = (bflo(p1.x) + bfhi(p1.x) * hi1.x) * gelu_erf(bflo(gw_.z)); o[5] = (bflo(p1.y) + bfhi(p1.y) * hi1.y) * gelu_erf(bfhi(gw_.z));
            o[6] = (bflo(p1.z) + bfhi(p1.z) * hi1.z) * gelu_erf(bflo(gw_.w)); o[7] = (bflo(p1.w) + bfhi(p1.w) * hi1.w) * gelu_erf(bfhi(gw_.w));
            float s2 = 0.f;
#pragma unroll
            for (int e = 0; e < 8; ++e) s2 += o[e] * o[e];
            const float m0 = bflo(mw.x), m1 = bfhi(mw.x), m2 = bflo(mw.y), m3 = bfhi(mw.y);
            float s1 = (m0 * m0 + m1 * m1) + (m2 * m2 + m3 * m3);
            s1 = wave_sum(s1, lane); s2 = wave_sum(s2, lane);
            const float r1 = rsqrtf(s1 * (1.f / 256.f) + 1e-6f), r2 = rsqrtf(s2 * (1.f / 512.f) + 1e-6f);
            GAS bf16* yr = P.Y + t * 1024;
            { v2u w; w.x = pk2(m0 * r1 * gmv.x, m1 * r1 * gmv.y); w.y = pk2(m2 * r1 * gmv.z, m3 * r1 * gmv.w); *(GAS v2u*)(yr + 4 * lane) = w; }
            { v4u w; w.x = pk2(o[0] * r2 * g0.x, o[1] * r2 * g0.y); w.y = pk2(o[2] * r2 * g0.z, o[3] * r2 * g0.w); w.z = pk2(o[4] * r2 * g1.x, o[5] * r2 * g1.y); w.w = pk2(o[6] * r2 * g1.z, o[7] * r2 * g1.w);
              *(GAS v4u*)(yr + 256 + 8 * lane) = w; }
        }
    }
}

#define TILE_BAR() asm volatile("s_waitcnt lgkmcnt(0)\n\ts_barrier" ::: "memory")
typedef short bf16x8 __attribute__((ext_vector_type(8)));
typedef short s16x4 __attribute__((ext_vector_type(4)));
typedef float f32x16 __attribute__((ext_vector_type(16)));
typedef unsigned u32x4 __attribute__((ext_vector_type(4)));
__device__ __forceinline__ int crow(int r, int hi) { return (r & 3) + 8 * (r >> 2) + 4 * hi; }
typedef float f32x2_t __attribute__((ext_vector_type(2))); typedef __bf16 bf16x2_c __attribute__((ext_vector_type(2)));
__device__ __forceinline__ unsigned cvtpk(float lo, float hi) { f32x2_t v = {lo, hi}; bf16x2_c b = __builtin_convertvector(v, bf16x2_c); return __builtin_bit_cast(unsigned, b); }
__device__ __forceinline__ float swapmax(float m) { auto rr = __builtin_amdgcn_permlane32_swap(__float_as_uint(m), __float_as_uint(m), false, false); return fmaxf(__uint_as_float(rr[0]), __uint_as_float(rr[1])); }
__device__ __forceinline__ float swapadd(float m) { auto rr = __builtin_amdgcn_permlane32_swap(__float_as_uint(m), __float_as_uint(m), false, false); return __uint_as_float(rr[0]) + __uint_as_float(rr[1]); }
__device__ __forceinline__ s16x4 vtr(const LAS unsigned char* p) { return __builtin_bit_cast(s16x4, __builtin_amdgcn_ds_read_tr16_b64_v4i16((LAS s16x4*)p)); }
__device__ __forceinline__ bf16x8 pack8(const f32x16& p, int b) { u32x4 w; w.x = cvtpk(p[b], p[b + 1]); w.y = cvtpk(p[b + 2], p[b + 3]); w.z = cvtpk(p[b + 4], p[b + 5]); w.w = cvtpk(p[b + 6], p[b + 7]); return __builtin_bit_cast(bf16x8, w); }
__device__ __forceinline__ float vmax3(float a, float b, float c) { float r; asm("v_max3_f32 %0, %1, %2, %3" : "=v"(r) : "v"(a), "v"(b), "v"(c)); return r; }
__device__ __forceinline__ float max32(const f32x16& p, const f32x16& q) {
    float a = vmax3(p[0], p[1], p[2]), b = vmax3(p[3], p[4], p[5]), c = vmax3(p[6], p[7], p[8]), d = vmax3(p[9], p[10], p[11]), e = vmax3(p[12], p[13], p[14]);
    float f = vmax3(q[0], q[1], q[2]), g = vmax3(q[3], q[4], q[5]), h = vmax3(q[6], q[7], q[8]), i = vmax3(q[9], q[10], q[11]), j = vmax3(q[12], q[13], q[14]);
    a = vmax3(a, b, c); d = vmax3(d, e, p[15]); f = vmax3(f, g, h); i = vmax3(i, j, q[15]);
    return vmax3(vmax3(a, d, f), i, i);
}
__device__ __forceinline__ float max16(const f32x16& p) { float a = fmaxf(fmaxf(p[0], p[1]), fmaxf(p[2], p[3])), b = fmaxf(fmaxf(p[4], p[5]), fmaxf(p[6], p[7])), c = fmaxf(fmaxf(p[8], p[9]), fmaxf(p[10], p[11])), d = fmaxf(fmaxf(p[12], p[13]), fmaxf(p[14], p[15])); return fmaxf(fmaxf(a, b), fmaxf(c, d)); }

struct AttnP {
    const GAS bf16* Q; const GAS bf16* K; const GAS bf16* V; int qp, kp, vp;
    GAS bf16* O; int op;
    const GAS float* rope;
    const GAS int* pos; const GAS float* btab; const GAS float* dnorm; const GAS float* lams;
};
template <int KIND> struct AK {
    static constexpr bool DIFF = KIND == 1, CROSS = KIND == 2;
    static constexpr int HW = KIND == 0 ? 96 : KIND == 1 ? 64 : 256;
    static constexpr int NKS = KIND == 0 ? 6 : KIND == 1 ? 2 : 16;
    static constexpr int KP = KIND == 0 ? 208 : KIND == 1 ? 144 : 528;
    static constexpr int ND = CROSS ? 4 : 2;
    static constexpr int CPK = HW / 8, KCH = (64 * CPK + 511) / 512;
    static constexpr int VCH = ND / 2;
    static constexpr int KB = 64 * KP, VB = ND * 4096;
    static constexpr int NBUF = CROSS ? 2 : 3;
    static constexpr int K0 = 0, V0 = NBUF * KB, POS = V0 + NBUF * VB, BT = POS + 1024, DN = BT + 528, END = DN + 256;
};
static_assert(AK<2>::END <= RING_BYTES && AK<0>::END <= RING_BYTES && AK<1>::END + 16 + 8 * 8192 <= RING_BYTES, "attention LDS");

template <int KIND, bool LEAD>
__device__ __forceinline__ void attn_unit(const AttnP& P, int b, int h, int qb, int dhalf, LAS unsigned char* lds, int tid, int wave, int lane) {
    lane = lane_id_v(); tid = (wave << 6) | lane;
    typedef AK<KIND> C;
    constexpr bool DIFF = C::DIFF, CROSS = C::CROSS;
    constexpr int HW = C::HW, NKS = C::NKS, KP = C::KP, ND = C::ND, CPK = C::CPK, KCH = C::KCH, VCH = C::VCH;
    const int r32 = lane & 31, hi = lane >> 5;
    const size_t rowb = (size_t)b * S, rowk = CROSS ? (size_t)b * MEM : rowb;
    const int q0w = qb * 256 + wave * 32, qi = q0w + r32;
    int pq = 0; float bias_far = 0.f;
    __syncthreads();
    if (DIFF) {
        pq = P.pos[rowb + qi];
        if (tid < 129) ((LAS float*)(lds + C::BT))[tid] = P.btab[h * 129 + tid];
        if (tid >= 192 && tid < 256) ((LAS float*)(lds + C::DN))[tid - 192] = P.dnorm[tid - 192];
    }
    int minq = pq;
    if (DIFF) { for (int o = 1; o < 64; o <<= 1) { const int v = shxi(minq, o, lane); minq = v < minq ? v : minq; } }
    const int NT = CROSS ? MEM / 64 : 4 * (qb + 1);
    u32x4 kr[KCH], vr[VCH]; int pkr = 0;
    u32x4 kr2[CROSS ? 1 : KCH], vr2[CROSS ? 1 : VCH]; int pkr2 = 0;
    const GAS bf16* Kb = P.K + rowk * P.kp + h * HW; const GAS bf16* Vb = P.V + rowk * P.vp + (CROSS ? h * 256 + dhalf * 128 : h * 64);
    const __amdgpu_buffer_rsrc_t rK = __builtin_amdgcn_make_buffer_rsrc((void*)Kb, 0, 0x7fffffff, 0x00020000), rV = __builtin_amdgcn_make_buffer_rsrc((void*)Vb, 0, 0x7fffffff, 0x00020000);
    const __amdgpu_buffer_rsrc_t rP = __builtin_amdgcn_make_buffer_rsrc((void*)(DIFF ? P.pos + rowb : (const GAS int*)Kb), 0, 0x7fffffff, 0x00020000);
    int kvo[KCH], vvo[VCH];
#pragma unroll
    for (int i = 0; i < KCH; ++i) { int c = tid + 512 * i; c = c < 64 * CPK ? c : tid; kvo[i] = ((c / CPK) * P.kp + (c % CPK) * 8) * 2; }
#pragma unroll
    for (int i = 0; i < VCH; ++i) { const int c = tid + 512 * i; vvo[i] = ((c / (4 * ND)) * P.vp + (c % (4 * ND)) * 8) * 2; }
    const int pvo = (tid & 63) * 4;
    auto gload = [&](int t) {
        const int ks = __builtin_amdgcn_readfirstlane(64 * t * P.kp * 2), vs = __builtin_amdgcn_readfirstlane(64 * t * P.vp * 2);
#pragma unroll
        for (int i = 0; i < KCH; ++i) kr[i] = __builtin_amdgcn_raw_buffer_load_b128(rK, kvo[i], ks, 0);
#pragma unroll
        for (int i = 0; i < VCH; ++i) vr[i] = __builtin_amdgcn_raw_buffer_load_b128(rV, vvo[i], vs, 0);
        if (DIFF) pkr = __builtin_amdgcn_raw_buffer_load_b32(rP, pvo, __builtin_amdgcn_readfirstlane(64 * t * 4), 0);
    };
    auto lstore = [&](int buf) {
        LAS unsigned char* kb_ = lds + C::K0 + buf * C::KB; LAS unsigned char* vb_ = lds + C::V0 + buf * C::VB;
#pragma unroll
        for (int i = 0; i < KCH; ++i) { int c = tid + 512 * i; c = c < 64 * CPK ? c : tid; const int key = c / CPK, part = c % CPK; *(LAS u32x4*)(kb_ + key * KP + part * 16) = kr[i]; }
#pragma unroll
        for (int i = 0; i < VCH; ++i) { const int c = tid + 512 * i; const int key = c / (4 * ND), part = c % (4 * ND); *(LAS u32x4*)(vb_ + (part >> 2) * 4096 + (key >> 3) * 512 + (key & 7) * 64 + (part & 3) * 16) = vr[i]; }
        if (DIFF) { ((LAS int*)(lds + C::POS + buf * 256))[tid & 63] = pkr; if (tid < 64) { int mk_ = pkr; for (int o = 1; o < 64; o <<= 1) { const int v = shxi(mk_, o, lane); mk_ = v > mk_ ? v : mk_; } if (tid == 0) ((LAS int*)(lds + C::POS + 768))[buf] = mk_; } }
    };
    auto gloadB = [&](int t) {
        const int ks = __builtin_amdgcn_readfirstlane(64 * t * P.kp * 2), vs = __builtin_amdgcn_readfirstlane(64 * t * P.vp * 2);
#pragma unroll
        for (int i = 0; i < (CROSS ? 1 : KCH); ++i) kr2[i] = __builtin_amdgcn_raw_buffer_load_b128(rK, kvo[i], ks, 0);
#pragma unroll
        for (int i = 0; i < (CROSS ? 1 : VCH); ++i) vr2[i] = __builtin_amdgcn_raw_buffer_load_b128(rV, vvo[i], vs, 0);
        if (DIFF) pkr2 = __builtin_amdgcn_raw_buffer_load_b32(rP, pvo, __builtin_amdgcn_readfirstlane(64 * t * 4), 0);
    };
    auto lstoreB = [&](int buf) {
        LAS unsigned char* kb_ = lds + C::K0 + buf * C::KB; LAS unsigned char* vb_ = lds + C::V0 + buf * C::VB;
#pragma unroll
        for (int i = 0; i < (CROSS ? 1 : KCH); ++i) { int c = tid + 512 * i; c = c < 64 * CPK ? c : tid; const int key = c / CPK, part = c % CPK; *(LAS u32x4*)(kb_ + key * KP + part * 16) = kr2[i]; }
#pragma unroll
        for (int i = 0; i < (CROSS ? 1 : VCH); ++i) { const int c = tid + 512 * i; const int key = c / (4 * ND), part = c % (4 * ND); *(LAS u32x4*)(vb_ + (part >> 2) * 4096 + (key >> 3) * 512 + (key & 7) * 64 + (part & 3) * 16) = vr2[i]; }
        if (DIFF) { ((LAS int*)(lds + C::POS + buf * 256))[tid & 63] = pkr2; if (tid < 64) { int mk_ = pkr2; for (int o = 1; o < 64; o <<= 1) { const int v = shxi(mk_, o, lane); mk_ = v > mk_ ? v : mk_; } if (tid == 0) ((LAS int*)(lds + C::POS + 768))[buf] = mk_; } }
    };
    LAS float* osv = (LAS float*)(lds + ((C::END + 15) & ~15)) + wave * 2048 + lane;
    float il = 0.f;
    f32x16 oA[ND];
#pragma unroll 1
    for (int mp = 0; mp < (DIFF ? 2 : 1); ++mp) {
        bf16x8 qf[NKS];
        { const GAS bf16* qrow = P.Q + (rowb + qi) * P.qp + h * HW + mp * 32;
#pragma unroll
          for (int s = 0; s < NKS; ++s) qf[s] = *(const GAS bf16x8*)(qrow + 16 * s + 8 * hi);
          if (KIND == 0) {
              const GAS float* rp = P.rope + (rowb + qi) * 32 + 8 * hi;
              const f32x4 c0 = *(const GAS f32x4*)rp, c1 = *(const GAS f32x4*)(rp + 4), s0 = *(const GAS f32x4*)(rp + 16), s1 = *(const GAS f32x4*)(rp + 20);
              const u32x4 a = __builtin_bit_cast(u32x4, qf[NKS - 2]), bq = __builtin_bit_cast(u32x4, qf[NKS - 1]); u32x4 ra, rb;
#pragma unroll
              for (int w = 0; w < 4; ++w) { const float cl = w < 2 ? c0[2 * w] : c1[2 * w - 4], ch = w < 2 ? c0[2 * w + 1] : c1[2 * w - 3], sl = w < 2 ? s0[2 * w] : s1[2 * w - 4], sh = w < 2 ? s0[2 * w + 1] : s1[2 * w - 3];
                  const float x1l = bflo(a[w]), x1h = bfhi(a[w]), x2l = bflo(bq[w]), x2h = bfhi(bq[w]);
                  ra[w] = cvtpk(x1l * cl - x2l * sl, x1h * ch - x2h * sh); rb[w] = cvtpk(x1l * sl + x2l * cl, x1h * sh + x2h * ch); }
              qf[NKS - 2] = __builtin_bit_cast(bf16x8, ra); qf[NKS - 1] = __builtin_bit_cast(bf16x8, rb);
          } }
        __syncthreads();
        float m1 = -1e30f, l1 = 0.f;
#pragma unroll
        for (int d = 0; d < ND; ++d)
#pragma unroll
            for (int r = 0; r < 16; ++r) oA[d][r] = 0.f;
        auto qk = [&](int sl, f32x16& sa, f32x16& sb, float init) {
            const LAS unsigned char* kb_ = lds + C::K0 + sl * C::KB + r32 * KP + hi * 16 + mp * 64;
#pragma unroll
            for (int r = 0; r < 16; ++r) { sa[r] = init; sb[r] = init; }
            constexpr int HB = CROSS ? 4 : (NKS > 3 ? 3 : NKS);
#pragma unroll
            for (int s0_ = 0; s0_ < NKS; s0_ += HB) {
                bf16x8 kfa[HB], kfb[HB];
#pragma unroll
                for (int s = 0; s < HB; ++s) { kfa[s] = *(const LAS bf16x8*)(kb_ + (s0_ + s) * 32); kfb[s] = *(const LAS bf16x8*)(kb_ + 32 * KP + (s0_ + s) * 32); }
                __builtin_amdgcn_sched_barrier(0);
#pragma unroll
                for (int s = 0; s < HB; ++s) { sa = __builtin_amdgcn_mfma_f32_32x32x16_bf16(kfa[s], qf[s0_ + s], sa, 0, 0, 0); sb = __builtin_amdgcn_mfma_f32_32x32x16_bf16(kfb[s], qf[s0_ + s], sb, 0, 0, 0); }
                __builtin_amdgcn_sched_barrier(0);
            }
        };
        auto isnear = [&](int sl) { bool nb = false;
            if (DIFF) { const int mk_ = __builtin_amdgcn_readfirstlane(((LAS int*)(lds + C::POS + 768))[sl]); nb = (minq - mk_) < 128; }
            return nb; };
        auto sm = [&](int t, int sl, f32x16& pa, f32x16& pb, bool nearb) -> float {
            const int k0 = 64 * t;
            if (DIFF) { if (nearb) {
                const LAS int* pk = (const LAS int*)(lds + C::POS + sl * 256); const LAS float* bt = (const LAS float*)(lds + C::BT);
#pragma unroll
                for (int r = 0; r < 16; ++r) { const int kk = crow(r, hi);
                    int n0 = pq - pk[kk], n1 = pq - pk[kk + 32]; n0 = n0 < 0 ? 0 : (n0 > 128 ? 128 : n0); n1 = n1 < 0 ? 0 : (n1 > 128 ? 128 : n1);
                    pa[r] += bt[n0]; pb[r] += bt[n1]; }
            } }
            if (!CROSS && k0 + 63 > q0w) {
#pragma unroll
                for (int r = 0; r < 16; ++r) { const int kk = k0 + crow(r, hi); if (kk > qi) pa[r] = -1e30f; if (kk + 32 > qi) pb[r] = -1e30f; }
            }
            asm volatile("s_nop 15\n\ts_nop 7" : "+v"(pa), "+v"(pb));
            float mn, al = 1.f;
            if (CROSS) { const float mx = swapmax(max32(pa, pb)); mn = fmaxf(m1, mx); al = __builtin_amdgcn_exp2f(m1 - mn); l1 *= al; }
            else { const float mx = swapmax(max32(pa, pb)); const bool up = mx > m1 + 8.0f; mn = up ? mx : m1;
                   if (__builtin_amdgcn_ballot_w64(up) != 0ull) { al = __builtin_amdgcn_exp2f(m1 - mn); l1 *= al; } }
            m1 = mn;
            float ls = 0.f;
#pragma unroll
            for (int r = 0; r < 16; ++r) { pa[r] = __builtin_amdgcn_exp2f(pa[r] - mn); pb[r] = __builtin_amdgcn_exp2f(pb[r] - mn); ls += pa[r] + pb[r]; }
            l1 += ls;
            return al;
        };
        auto pv = [&](int sl, const f32x16& pa, const f32x16& pb, float al) {
            const LAS unsigned char* vb_ = lds + C::V0 + sl * C::VB + ((lane >> 4) & 1) * 32 + (lane & 3) * 8 + (4 * hi + ((lane & 15) >> 2)) * 64;
            bf16x8 pf[4];
            pf[0] = pack8(pa, 0); pf[1] = pack8(pa, 8); pf[2] = pack8(pb, 0); pf[3] = pack8(pb, 8);
            const bool resc = CROSS ? true : (__builtin_amdgcn_ballot_w64(al != 1.0f) != 0ull);
            if (CROSS) {
#pragma unroll
                for (int d = 0; d < ND; ++d) {
                    __builtin_amdgcn_sched_barrier(0);
#pragma unroll
                    for (int r = 0; r < 16; ++r) oA[d][r] *= al;
                    bf16x8 vf[4];
#pragma unroll
                    for (int s = 0; s < 4; ++s) { const s16x4 lo = vtr(vb_ + d * 4096 + s * 1024), hh = vtr(vb_ + d * 4096 + s * 1024 + 512); vf[s] = (bf16x8){lo[0], lo[1], lo[2], lo[3], hh[0], hh[1], hh[2], hh[3]}; }
#pragma unroll
                    for (int s = 0; s < 4; ++s) oA[d] = __builtin_amdgcn_mfma_f32_32x32x16_bf16(vf[s], pf[s], oA[d], 0, 0, 0);
                }
            } else if (DIFF) {
                if (resc) {
#pragma unroll
                    for (int d = 0; d < 2; ++d)
#pragma unroll
                        for (int r = 0; r < 16; ++r) oA[d][r] *= al;
                }
#pragma unroll
                for (int d = 0; d < 2; ++d) {
                    bf16x8 vf[4];
#pragma unroll
                    for (int s = 0; s < 4; ++s) { const s16x4 lo = vtr(vb_ + d * 4096 + s * 1024), hh = vtr(vb_ + d * 4096 + s * 1024 + 512); vf[s] = (bf16x8){lo[0], lo[1], lo[2], lo[3], hh[0], hh[1], hh[2], hh[3]}; }
                    __builtin_amdgcn_sched_barrier(0);
#pragma unroll
                    for (int s = 0; s < 4; ++s) oA[d] = __builtin_amdgcn_mfma_f32_32x32x16_bf16(vf[s], pf[s], oA[d], 0, 0, 0);
                }
            } else {
                bf16x8 vf[2][4];
#pragma unroll
                for (int d = 0; d < 2; ++d)
#pragma unroll
                    for (int s = 0; s < 4; ++s) { const s16x4 lo = vtr(vb_ + d * 4096 + s * 1024), hh = vtr(vb_ + d * 4096 + s * 1024 + 512); vf[d][s] = (bf16x8){lo[0], lo[1], lo[2], lo[3], hh[0], hh[1], hh[2], hh[3]}; }
                if (resc) {
#pragma unroll
                    for (int d = 0; d < 2; ++d)
#pragma unroll
                        for (int r = 0; r < 16; ++r) oA[d][r] *= al;
                }
                __builtin_amdgcn_sched_barrier(0);
#pragma unroll
                for (int s = 0; s < 4; ++s)
#pragma unroll
                    for (int d = 0; d < 2; ++d) oA[d] = __builtin_amdgcn_mfma_f32_32x32x16_bf16(vf[d][s], pf[s], oA[d], 0, 0, 0);
            }
        };
        if (CROSS) {
            gload(0); lstore(0);
            __syncthreads();
            for (int t = 0; t < NT; ++t) {
                const int buf = t & 1;
                f32x16 pa, pb;
                qk(buf, pa, pb, 0.f);
                const float al = sm(t, buf, pa, pb, false);
                pv(buf, pa, pb, al);
                if (t + 1 < NT) { gload(t + 1); lstore(buf ^ 1); }
                TILE_BAR();
            }
        } else {
            gload(0); lstore(0); gload(1); lstore(1);
            gload(2); gloadB(3);
            __syncthreads();
            if (DIFF) bias_far = ((LAS float*)(lds + C::BT))[128];
            const int NTW = (q0w + 31) / 64 + 1;
            constexpr bool lead = LEAD;
            f32x16 ca, cb, na, nb; bool cnear = isnear(0), nnear = false; float cal = 1.f;
            qk(0, ca, cb, (DIFF && !cnear) ? bias_far : 0.f);
            if (lead) cal = sm(0, 0, ca, cb, cnear);
            int s0 = 0, s1 = 1, s2 = 2;
            auto period = [&](int t, f32x16& xa, f32x16& xb, bool& xnear, f32x16& ya, f32x16& yb, bool& ynear) {
                const bool have_next = (t + 1 < NTW);
                if (lead) {
                    if (have_next) { ynear = isnear(s1); qk(s1, ya, yb, (DIFF && !ynear) ? bias_far : 0.f); }
                    if (t < NTW) pv(s0, xa, xb, cal);
                    if (have_next) cal = sm(t + 1, s1, ya, yb, ynear);
                } else {
                    if (t < NTW) cal = sm(t, s0, xa, xb, xnear);
                    if (have_next) { ynear = isnear(s1); qk(s1, ya, yb, (DIFF && !ynear) ? bias_far : 0.f); }
                    if (t < NTW) pv(s0, xa, xb, cal);
                }
                { const int tmp = s0; s0 = s1; s1 = s2; s2 = tmp; }
            };
            int t = 0;
            for (; t + 5 < NT; t += 2) {
                lstore(s2); gload(t + 4);
                period(t, ca, cb, cnear, na, nb, nnear);
                TILE_BAR();
                lstoreB(s2); gloadB(t + 5);
                period(t + 1, na, nb, nnear, ca, cb, cnear);
                TILE_BAR();
            }
            for (; t < NT; t += 2) {
                if (t + 2 < NT) { lstore(s2); if (t + 4 < NT) gload(t + 4); }
                period(t, ca, cb, cnear, na, nb, nnear);
                TILE_BAR();
                if (t + 3 < NT) { lstoreB(s2); if (t + 5 < NT) gloadB(t + 5); }
                period(t + 1, na, nb, nnear, ca, cb, cnear);
                TILE_BAR();
            }
        }
        il = 1.f / swapadd(l1);
        if (DIFF) { if (mp == 0) {
#pragma unroll
            for (int d = 0; d < 2; ++d)
#pragma unroll
                for (int r = 0; r < 16; ++r) osv[(d * 16 + r) * 64] = oA[d][r] * il; } }
    }
    GAS bf16* orow = P.O + (rowb + qi) * P.op + (CROSS ? h * 256 + dhalf * 128 : h * 64);
    if (!DIFF) {
#pragma unroll
        for (int d = 0; d < ND; ++d)
#pragma unroll
            for (int g = 0; g < 4; ++g) { v2u v; v.x = cvtpk(oA[d][4 * g] * il, oA[d][4 * g + 1] * il); v.y = cvtpk(oA[d][4 * g + 2] * il, oA[d][4 * g + 3] * il); *(GAS v2u*)(orow + 32 * d + 8 * g + 4 * hi) = v; }
    } else {
        const float lam = P.lams[0], lam_init = P.lams[1];
        const float i2 = lam * il;
        float ss = 0.f;
#pragma unroll
        for (int d = 0; d < 2; ++d)
#pragma unroll
            for (int r = 0; r < 16; ++r) { const float v = osv[(d * 16 + r) * 64] - oA[d][r] * i2; oA[d][r] = v; ss += v * v; }
        ss = swapadd(ss);
        const float rs = __builtin_amdgcn_rsqf(ss * (1.f / 64.f) + 1e-6f) * (1.f - lam_init);
        const LAS float* dn = (const LAS float*)(lds + C::DN);
#pragma unroll
        for (int d = 0; d < 2; ++d)
#pragma unroll
            for (int g = 0; g < 4; ++g) { const int c = 32 * d + 8 * g + 4 * hi; const f32x4 gn = *(const LAS f32x4*)(dn + c);
                v2u v; v.x = cvtpk(oA[d][4 * g] * rs * gn[0], oA[d][4 * g + 1] * rs * gn[1]); v.y = cvtpk(oA[d][4 * g + 2] * rs * gn[2], oA[d][4 * g + 3] * rs * gn[3]); *(GAS v2u*)(orow + c) = v; }
    }
}

__device__ __forceinline__ int wave_max_i(int v) {
    { const int o = __builtin_amdgcn_update_dpp(0, v, 0xB1, 0xF, 0xF, true); v = o > v ? o : v; }
    { const int o = __builtin_amdgcn_update_dpp(0, v, 0x4E, 0xF, 0xF, true); v = o > v ? o : v; }
    { const int o = __builtin_amdgcn_update_dpp(0, v, 0x141, 0xF, 0xF, true); v = o > v ? o : v; }
    { const int o = __builtin_amdgcn_update_dpp(0, v, 0x140, 0xF, 0xF, true); v = o > v ? o : v; }
    { int a = v, b = v; asm volatile("v_nop\n\tv_nop\n\tv_permlane16_swap_b32 %0, %1" : "+v"(a), "+v"(b)); v = a > b ? a : b; }
    { int a = v, b = v; asm volatile("v_nop\n\tv_nop\n\tv_permlane32_swap_b32 %0, %1" : "+v"(a), "+v"(b)); v = a > b ? a : b; }
    return v;
}
template <int KIND> struct AK2 {
    static constexpr bool DIFF = KIND == 1;
    static constexpr int HW = KIND == 0 ? 96 : 64, NKS = KIND == 0 ? 6 : 2, KP = KIND == 0 ? 208 : 144;
    static constexpr int CPK = HW / 8, KCH = (128 * CPK) / 512, VCH = 2;
    static constexpr int KB = 128 * KP, VB = 2 * 8192;
    static constexpr int K0 = 0, V0 = 2 * KB, POS = V0 + 2 * VB, PMX = POS + 1024, BT = PMX + 16, DN = BT + 528, OSV = (DN + 256 + 15) & ~15, END = OSV + (DIFF ? 8 * 8192 : 0);
};
static_assert(AK2<0>::END <= RING_BYTES && AK2<1>::END <= RING_BYTES, "attention LDS (128-key tiles)");
template <int KIND>
__device__ __forceinline__ void attn_unit2(const AttnP& P, int b, int h, int qb, LAS unsigned char* lds, int tid, int wave, int lane) {
    lane = lane_id_v(); tid = (wave << 6) | lane;
    typedef AK2<KIND> C;
    constexpr bool DIFF = C::DIFF;
    constexpr int HW = C::HW, NKS = C::NKS, KP = C::KP, CPK = C::CPK, KCH = C::KCH, VCH = C::VCH;
    const int r32 = lane & 31, hi = lane >> 5;
    const size_t rowb = (size_t)b * S;
    const int q0w = qb * 256 + wave * 32, qi = q0w + r32;
    int pq = 0; float bias_far = 0.f;
    __syncthreads();
    if (DIFF) {
        pq = P.pos[rowb + qi];
        if (tid < 129) ((LAS float*)(lds + C::BT))[tid] = P.btab[h * 129 + tid];
        if (tid >= 192 && tid < 256) ((LAS float*)(lds + C::DN))[tid - 192] = P.dnorm[tid - 192];
    }
    int minq = pq;
    if (DIFF) minq = __builtin_amdgcn_readfirstlane(-wave_max_i(-pq));
    const int NT = 2 * (qb + 1);
    const GAS bf16* Kb = P.K + rowb * P.kp + h * HW; const GAS bf16* Vb = P.V + rowb * P.vp + h * 64;
    const __amdgpu_buffer_rsrc_t rK = __builtin_amdgcn_make_buffer_rsrc((void*)Kb, 0, 0x7fffffff, 0x00020000), rV = __builtin_amdgcn_make_buffer_rsrc((void*)Vb, 0, 0x7fffffff, 0x00020000);
    const __amdgpu_buffer_rsrc_t rP = __builtin_amdgcn_make_buffer_rsrc((void*)(DIFF ? P.pos + rowb : (const GAS int*)Kb), 0, 0x7fffffff, 0x00020000);
    int kvo[KCH], vvo[VCH], klo[KCH], vlo[VCH];
#pragma unroll
    for (int i = 0; i < KCH; ++i) { const int c = tid + 512 * i; kvo[i] = ((c / CPK) * P.kp + (c % CPK) * 8) * 2; klo[i] = (c / CPK) * KP + (c % CPK) * 16; }
#pragma unroll
    for (int i = 0; i < VCH; ++i) { const int c = tid + 512 * i; const int key = c >> 3, part = c & 7; vvo[i] = (key * P.vp + part * 8) * 2; vlo[i] = (part >> 2) * 8192 + (key >> 3) * 512 + (key & 7) * 64 + (part & 3) * 16; }
    const int pvo = (tid & 127) * 4;
    u32x4 kr[KCH], vr[VCH]; int pkr = 0;
    auto gload = [&](int t) {
        const int ks = __builtin_amdgcn_readfirstlane(128 * t * P.kp * 2), vs = __builtin_amdgcn_readfirstlane(128 * t * P.vp * 2);
#pragma unroll
        for (int i = 0; i < KCH; ++i) kr[i] = __builtin_amdgcn_raw_buffer_load_b128(rK, kvo[i], ks, 0);
#pragma unroll
        for (int i = 0; i < VCH; ++i) vr[i] = __builtin_amdgcn_raw_buffer_load_b128(rV, vvo[i], vs, 0);
        if (DIFF) pkr = __builtin_amdgcn_raw_buffer_load_b32(rP, pvo, __builtin_amdgcn_readfirstlane(128 * t * 4), 0);
    };
    auto lstore = [&](int buf) {
        LAS unsigned char* kb_ = lds + C::K0 + buf * C::KB; LAS unsigned char* vb_ = lds + C::V0 + buf * C::VB;
#pragma unroll
        for (int i = 0; i < KCH; ++i) *(LAS u32x4*)(kb_ + klo[i]) = kr[i];
#pragma unroll
        for (int i = 0; i < VCH; ++i) *(LAS u32x4*)(vb_ + vlo[i]) = vr[i];
        if (DIFF) { ((LAS int*)(lds + C::POS + buf * 512))[tid & 127] = pkr;
            if (tid < 128) { const int mk_ = wave_max_i(pkr); if (lane == 0) ((LAS int*)(lds + C::PMX))[buf * 2 + wave] = mk_; } }
    };
    LAS float* osv = (LAS float*)(lds + C::OSV) + wave * 2048 + lane;
    float il = 0.f;
    f32x16 oA[2];
#pragma unroll 1
    for (int mp = 0; mp < (DIFF ? 2 : 1); ++mp) {
        bf16x8 qf[NKS];
        { const GAS bf16* qrow = P.Q + (rowb + qi) * P.qp + h * HW + mp * 32;
#pragma unroll
          for (int s = 0; s < NKS; ++s) qf[s] = *(const GAS bf16x8*)(qrow + 16 * s + 8 * hi);
          if (KIND == 0) {
              const GAS float* rp = P.rope + (rowb + qi) * 32 + 8 * hi;
              const f32x4 c0 = *(const GAS f32x4*)rp, c1 = *(const GAS f32x4*)(rp + 4), s0 = *(const GAS f32x4*)(rp + 16), s1 = *(const GAS f32x4*)(rp + 20);
              const u32x4 a = __builtin_bit_cast(u32x4, qf[NKS - 2]), bq = __builtin_bit_cast(u32x4, qf[NKS - 1]); u32x4 ra, rb;
#pragma unroll
              for (int w = 0; w < 4; ++w) { const float cl = w < 2 ? c0[2 * w] : c1[2 * w - 4], ch = w < 2 ? c0[2 * w + 1] : c1[2 * w - 3], sl = w < 2 ? s0[2 * w] : s1[2 * w - 4], sh = w < 2 ? s0[2 * w + 1] : s1[2 * w - 3];
                  const float x1l = bflo(a[w]), x1h = bfhi(a[w]), x2l = bflo(bq[w]), x2h = bfhi(bq[w]);
                  ra[w] = cvtpk(x1l * cl - x2l * sl, x1h * ch - x2h * sh); rb[w] = cvtpk(x1l * sl + x2l * cl, x1h * sh + x2h * ch); }
              qf[NKS - 2] = __builtin_bit_cast(bf16x8, ra); qf[NKS - 1] = __builtin_bit_cast(bf16x8, rb);
          } }
        __syncthreads();
        float m1 = 0.f, l1 = 0.f;
        f32x16 negm;
#pragma unroll
        for (int r = 0; r < 16; ++r) negm[r] = 0.f;
#pragma unroll
        for (int d = 0; d < 2; ++d)
#pragma unroll
            for (int r = 0; r < 16; ++r) oA[d][r] = 0.f;
        gload(0); lstore(0);
        if (NT > 1) gload(1);
        __syncthreads();
        if (DIFF) { bias_far = ((LAS float*)(lds + C::BT))[128];
#pragma unroll
            for (int r = 0; r < 16; ++r) negm[r] = bias_far; }
        const int NTW = (q0w + 31) / 128 + 1;
        auto compute = [&](int t, int buf) {
            const int k0 = 128 * t;
            const LAS unsigned char* kb_ = lds + C::K0 + buf * C::KB + r32 * KP + hi * 16 + mp * 64;
            const LAS unsigned char* vb_ = lds + C::V0 + buf * C::VB + ((lane >> 4) & 1) * 32 + (lane & 3) * 8 + (4 * hi + ((lane & 15) >> 2)) * 64;
            bool nearb = false;
            if (DIFF) { const LAS int* pm = (const LAS int*)(lds + C::PMX) + buf * 2; const int m0 = __builtin_amdgcn_readfirstlane(pm[0]), m1_ = __builtin_amdgcn_readfirstlane(pm[1]); nearb = (minq - (m0 > m1_ ? m0 : m1_)) < 128; }
            f32x16 sc[4];
            if (DIFF) { if (nearb) {
#pragma unroll
                for (int g = 0; g < 4; ++g)
#pragma unroll
                    for (int r = 0; r < 16; ++r) sc[g][r] = -m1; } }
            constexpr int HB = NKS > 3 ? 3 : NKS;
#pragma unroll
            for (int s0_ = 0; s0_ < NKS; s0_ += HB) {
                bf16x8 kf[4][HB];
#pragma unroll
                for (int g = 0; g < 4; ++g)
#pragma unroll
                    for (int s = 0; s < HB; ++s) kf[g][s] = *(const LAS bf16x8*)(kb_ + 32 * g * KP + (s0_ + s) * 32);
                __builtin_amdgcn_sched_barrier(0);
#pragma unroll
                for (int s = 0; s < HB; ++s)
#pragma unroll
                    for (int g = 0; g < 4; ++g) {
                        if (s0_ + s == 0 && !(DIFF && nearb)) sc[g] = __builtin_amdgcn_mfma_f32_32x32x16_bf16(kf[g][s], qf[s0_ + s], negm, 0, 0, 0);
                        else sc[g] = __builtin_amdgcn_mfma_f32_32x32x16_bf16(kf[g][s], qf[s0_ + s], sc[g], 0, 0, 0); }
                __builtin_amdgcn_sched_barrier(0);
            }
            if (DIFF) { if (nearb) {
                const LAS int* pk = (const LAS int*)(lds + C::POS + buf * 512); const LAS float* bt = (const LAS float*)(lds + C::BT);
#pragma unroll
                for (int g = 0; g < 4; ++g)
#pragma unroll
                    for (int r = 0; r < 16; ++r) { int n0 = pq - pk[32 * g + crow(r, hi)]; n0 = n0 < 0 ? 0 : (n0 > 128 ? 128 : n0); sc[g][r] += bt[n0]; }
            } }
            asm volatile("s_nop 15\n\ts_nop 7" : "+v"(sc[0]), "+v"(sc[1]), "+v"(sc[2]), "+v"(sc[3]));
            if (k0 + 127 > q0w) {
#pragma unroll
                for (int g = 0; g < 4; ++g)
#pragma unroll
                    for (int r = 0; r < 16; ++r) { if (k0 + 32 * g + crow(r, hi) > qi) sc[g][r] = -1e30f; }
            }
            const float mx = swapmax(vmax3(max32(sc[0], sc[1]), max32(sc[2], sc[3]), -1e30f));
            const bool up = (t == 0) || mx > 8.0f;
            float al = 1.f;
            if (__builtin_amdgcn_ballot_w64(up) != 0ull) {
                const float dl = up ? mx : 0.f; al = __builtin_amdgcn_exp2f(-dl); l1 *= al; m1 += dl;
#pragma unroll
                for (int r = 0; r < 16; ++r) negm[r] -= dl;
#pragma unroll
                for (int g = 0; g < 4; ++g)
#pragma unroll
                    for (int r = 0; r < 16; ++r) sc[g][r] -= dl;
            }
            float ls = 0.f;
#pragma unroll
            for (int g = 0; g < 4; ++g)
#pragma unroll
                for (int r = 0; r < 16; ++r) { sc[g][r] = __builtin_amdgcn_exp2f(sc[g][r]); ls += sc[g][r]; }
            l1 += ls;
            bf16x8 pf[8];
#pragma unroll
            for (int g = 0; g < 4; ++g) { pf[2 * g] = pack8(sc[g], 0); pf[2 * g + 1] = pack8(sc[g], 8); }
            if (__builtin_amdgcn_ballot_w64(al != 1.0f) != 0ull) {
#pragma unroll
                for (int d = 0; d < 2; ++d)
#pragma unroll
                    for (int r = 0; r < 16; ++r) oA[d][r] *= al;
            }
#pragma unroll
            for (int d = 0; d < 2; ++d) {
                bf16x8 vf[8];
#pragma unroll
                for (int s = 0; s < 8; ++s) { const s16x4 lo = vtr(vb_ + d * 8192 + s * 1024), hh = vtr(vb_ + d * 8192 + s * 1024 + 512); vf[s] = (bf16x8){lo[0], lo[1], lo[2], lo[3], hh[0], hh[1], hh[2], hh[3]}; }
                __builtin_amdgcn_sched_barrier(0);
#pragma unroll
                for (int s = 0; s < 8; ++s) oA[d] = __builtin_amdgcn_mfma_f32_32x32x16_bf16(vf[s], pf[s], oA[d], 0, 0, 0);
                __builtin_amdgcn_sched_barrier(0);
            }
        };
        int t = 0;
        for (; t + 2 < NT; ++t) {
            const int buf = t & 1;
            if (t < NTW) compute(t, buf);
            lstore(buf ^ 1); gload(t + 2);
            TILE_BAR();
        }
        for (; t < NT; ++t) {
            const int buf = t & 1;
            if (t < NTW) compute(t, buf);
            if (t + 1 < NT) lstore(buf ^ 1);
            TILE_BAR();
        }
        il = 1.f / swapadd(l1);
        if (DIFF) { if (mp == 0) {
#pragma unroll
            for (int d = 0; d < 2; ++d)
#pragma unroll
                for (int r = 0; r < 16; ++r) osv[(d * 16 + r) * 64] = oA[d][r] * il; } }
    }
    GAS bf16* orow = P.O + (rowb + qi) * P.op + h * 64;
    if (!DIFF) {
#pragma unroll
        for (int d = 0; d < 2; ++d)
#pragma unroll
            for (int g = 0; g < 4; ++g) { v2u v; v.x = cvtpk(oA[d][4 * g] * il, oA[d][4 * g + 1] * il); v.y = cvtpk(oA[d][4 * g + 2] * il, oA[d][4 * g + 3] * il); *(GAS v2u*)(orow + 32 * d + 8 * g + 4 * hi) = v; }
    } else {
        const float lam = P.lams[0], lam_init = P.lams[1];
        const float i2 = lam * il;
        float ss = 0.f;
#pragma unroll
        for (int d = 0; d < 2; ++d)
#pragma unroll
            for (int r = 0; r < 16; ++r) { const float v = osv[(d * 16 + r) * 64] - oA[d][r] * i2; oA[d][r] = v; ss += v * v; }
        ss = swapadd(ss);
        const float rs = __builtin_amdgcn_rsqf(ss * (1.f / 64.f) + 1e-6f) * (1.f - lam_init);
        const LAS float* dn = (const LAS float*)(lds + C::DN);
#pragma unroll
        for (int d = 0; d < 2; ++d)
#pragma unroll
            for (int g = 0; g < 4; ++g) { const int c = 32 * d + 8 * g + 4 * hi; const f32x4 gn = *(const LAS f32x4*)(dn + c);
                v2u v; v.x = cvtpk(oA[d][4 * g] * rs * gn[0], oA[d][4 * g + 1] * rs * gn[1]); v.y = cvtpk(oA[d][4 * g + 2] * rs * gn[2], oA[d][4 * g + 3] * rs * gn[3]); *(GAS v2u*)(orow + c) = v; }
    }
}

__device__ __forceinline__ void attn_phase(const AttnP& PM, const AttnP& PD, LAS unsigned char* lds, int tid, int wave, int lane, int vcu, int G, int only = -1) {
    for (int i = vcu; i < 512; i += G) {
        if (only >= 0 && (i >> 8) != only) continue;
        const int kind = i >> 8, c = i & 255, bh = c >> 4, s = c & 15;
        if (kind == 0) {
#pragma unroll 1
            for (int k = 0; k < 2; ++k) attn_unit2<0>(PM, bh >> 2, bh & 3, k ? 31 - s : s, lds, tid, wave, lane);
        } else {
#pragma unroll 1
            for (int k = 0; k < 2; ++k) attn_unit2<1>(PD, bh >> 2, bh & 3, k ? 31 - s : s, lds, tid, wave, lane);
        }
    }
}
__device__ __forceinline__ float cx_max16(const f32x16& p) { return fmaxf(fmaxf(fmaxf(fmaxf(p[0], p[1]), fmaxf(p[2], p[3])), fmaxf(fmaxf(p[4], p[5]), fmaxf(p[6], p[7]))), fmaxf(fmaxf(fmaxf(p[8], p[9]), fmaxf(p[10], p[11])), fmaxf(fmaxf(p[12], p[13]), fmaxf(p[14], p[15])))); }
__device__ __forceinline__ void cross_unit2(const AttnP& P, int b, int h, int qb, LAS unsigned char* lds, int wave) {
    const int lane = lane_id_v(), tid = (wave << 6) | lane;
    constexpr int KP = 528;
    const int r32 = lane & 31, hi = lane >> 5;
    const size_t rowb = (size_t)b * S, rowk = (size_t)b * MEM;
    const int qi = qb * 256 + wave * 32 + r32;
    const GAS bf16* Kb = P.K + rowk * P.kp + h * 256; const GAS bf16* Vb = P.V + rowk * P.vp + h * 256;
    const __amdgpu_buffer_rsrc_t rK = __builtin_amdgcn_make_buffer_rsrc((void*)Kb, 0, 0x7fffffff, 0x00020000), rV = __builtin_amdgcn_make_buffer_rsrc((void*)Vb, 0, 0x7fffffff, 0x00020000);
    const GAS bf16* qrow = P.Q + (rowb + qi) * P.qp + h * 256 + 8 * hi;
    bf16x8 qf[4];
#pragma unroll
    for (int s = 0; s < 4; ++s) qf[s] = *(const GAS bf16x8*)(qrow + 16 * s);
    { u32x4 st[16];
#pragma unroll
      for (int i = 0; i < 16; ++i) { const int c = tid + 512 * i; st[i] = __builtin_amdgcn_raw_buffer_load_b128(rK, ((c >> 5) * P.kp + (c & 31) * 8) * 2, 0, 0); }
      TILE_BAR();
#pragma unroll
      for (int i = 0; i < 16; ++i) { const int c = tid + 512 * i; *(LAS u32x4*)(lds + (c >> 5) * KP + (c & 31) * 16) = st[i]; } }
    __syncthreads();
    f32x16 sc[8];
#pragma unroll
    for (int g = 0; g < 8; ++g)
#pragma unroll
        for (int r = 0; r < 16; ++r) sc[g][r] = 0.f;
    const LAS unsigned char* kb_ = lds + r32 * KP + hi * 16;
#pragma unroll
    for (int c = 0; c < 4; ++c) {
        bf16x8 qn[4];
        if (c + 1 < 4) {
#pragma unroll
            for (int s = 0; s < 4; ++s) qn[s] = *(const GAS bf16x8*)(qrow + 64 * (c + 1) + 16 * s); }
#pragma unroll
        for (int g = 0; g < 8; ++g) { bf16x8 kf[4];
#pragma unroll
            for (int s = 0; s < 4; ++s) kf[s] = *(const LAS bf16x8*)(kb_ + 32 * g * KP + (4 * c + s) * 32);
#pragma unroll
            for (int s = 0; s < 4; ++s) sc[g] = __builtin_amdgcn_mfma_f32_32x32x16_bf16(kf[s], qf[s], sc[g], 0, 0, 0); }
        if (c + 1 < 4) {
#pragma unroll
            for (int s = 0; s < 4; ++s) qf[s] = qn[s]; }
    }
    float m = fmaxf(fmaxf(fmaxf(cx_max16(sc[0]), cx_max16(sc[1])), fmaxf(cx_max16(sc[2]), cx_max16(sc[3]))), fmaxf(fmaxf(cx_max16(sc[4]), cx_max16(sc[5])), fmaxf(cx_max16(sc[6]), cx_max16(sc[7]))));
    m = swapmax(m);
    float l = 0.f;
    bf16x8 pf[16];
#pragma unroll
    for (int g = 0; g < 8; ++g) {
#pragma unroll
        for (int r = 0; r < 16; ++r) { sc[g][r] = __builtin_amdgcn_exp2f(sc[g][r] - m); l += sc[g][r]; }
        pf[2 * g] = pack8(sc[g], 0); pf[2 * g + 1] = pack8(sc[g], 8); }
    const float il = 1.f / swapadd(l);
    { u32x4 st[16];
#pragma unroll
      for (int i = 0; i < 16; ++i) { const int c = tid + 512 * i; const int sub = c & 3, key = (c >> 2) & 255, dt = c >> 10; st[i] = __builtin_amdgcn_raw_buffer_load_b128(rV, (key * P.vp + dt * 32 + sub * 8) * 2, 0, 0); }
      TILE_BAR();
#pragma unroll
      for (int i = 0; i < 16; ++i) { const int c = tid + 512 * i; const int sub = c & 3, key = (c >> 2) & 255, dt = c >> 10; *(LAS u32x4*)(lds + dt * 16384 + (key >> 3) * 512 + (key & 7) * 64 + sub * 16) = st[i]; } }
    __syncthreads();
    const LAS unsigned char* vb_ = lds + ((lane >> 4) & 1) * 32 + (lane & 3) * 8 + (4 * hi + ((lane & 15) >> 2)) * 64;
    GAS bf16* orow = P.O + (rowb + qi) * P.op + h * 256;
#pragma unroll 1
    for (int dh = 0; dh < 2; ++dh) {
        f32x16 oA[4];
#pragma unroll
        for (int d = 0; d < 4; ++d)
#pragma unroll
            for (int r = 0; r < 16; ++r) oA[d][r] = 0.f;
#pragma unroll
        for (int d = 0; d < 4; ++d) {
#pragma unroll
            for (int sb = 0; sb < 2; ++sb) { bf16x8 vf[8];
#pragma unroll
                for (int s = 0; s < 8; ++s) { const s16x4 lo = vtr(vb_ + (4 * dh + d) * 16384 + (8 * sb + s) * 1024), hh = vtr(vb_ + (4 * dh + d) * 16384 + (8 * sb + s) * 1024 + 512); vf[s] = (bf16x8){lo[0], lo[1], lo[2], lo[3], hh[0], hh[1], hh[2], hh[3]}; }
#pragma unroll
                for (int s = 0; s < 8; ++s) oA[d] = __builtin_amdgcn_mfma_f32_32x32x16_bf16(vf[s], pf[8 * sb + s], oA[d], 0, 0, 0); } }
#pragma unroll
        for (int d = 0; d < 4; ++d)
#pragma unroll
            for (int g = 0; g < 4; ++g) { v2u v; v.x = cvtpk(oA[d][4 * g] * il, oA[d][4 * g + 1] * il); v.y = cvtpk(oA[d][4 * g + 2] * il, oA[d][4 * g + 3] * il); *(GAS v2u*)(orow + 128 * dh + 32 * d + 8 * g + 4 * hi) = v; }
    }
}
__device__ __forceinline__ void cross_phase(const AttnP& PC, LAS unsigned char* lds, int tid, int wave, int lane, int vcu, int G) {
#pragma unroll 1
    for (int i = vcu; i < 512; i += G) { const int bh = i >> 5; cross_unit2(PC, bh >> 2, bh & 3, i & 31, lds, wave); }
}


__device__ __forceinline__ float vmax2(float a, float b) { float r; asm("v_max_f32_e32 %0, %1, %2" : "=v"(r) : "v"(a), "v"(b)); return r; }
__device__ __forceinline__ float vmin2(float a, float b) { float r; asm("v_min_f32_e32 %0, %1, %2" : "=v"(r) : "v"(a), "v"(b)); return r; }
__device__ __forceinline__ void pad16(float (&a)[16]) {
    asm volatile("s_nop 1" : "+v"(a[0]), "+v"(a[1]), "+v"(a[2]), "+v"(a[3]), "+v"(a[4]), "+v"(a[5]), "+v"(a[6]), "+v"(a[7]), "+v"(a[8]), "+v"(a[9]), "+v"(a[10]), "+v"(a[11]), "+v"(a[12]), "+v"(a[13]), "+v"(a[14]), "+v"(a[15]));
}
__device__ __forceinline__ void sort16_desc(float (&a)[16]) {
#pragma unroll
    for (int k = 2; k <= 16; k <<= 1)
#pragma unroll
        for (int j = k >> 1; j > 0; j >>= 1)
#pragma unroll
            for (int i = 0; i < 16; ++i) { const int l = i ^ j; if (l > i) { const bool desc = ((i & k) == 0); const float hi_ = vmax2(a[i], a[l]), lo_ = vmin2(a[i], a[l]); a[i] = desc ? hi_ : lo_; a[l] = desc ? lo_ : hi_; } }
}
__device__ __forceinline__ void merge16_desc(float (&a)[16], const float (&b)[16]) {
#pragma unroll
    for (int i = 0; i < 16; ++i) a[i] = vmax2(a[i], b[15 - i]);
#pragma unroll
    for (int j = 8; j > 0; j >>= 1)
#pragma unroll
        for (int i = 0; i < 16; ++i) { const int l = i ^ j; if (l > i) { const float hi_ = vmax2(a[i], a[l]), lo_ = vmin2(a[i], a[l]); a[i] = hi_; a[l] = lo_; } }
}
__device__ __forceinline__ void top16_of_64(float (&g0)[16], float (&g1)[16], float (&g2)[16], float (&g3)[16]) {
    sort16_desc(g0); sort16_desc(g1); merge16_desc(g0, g1); sort16_desc(g2); sort16_desc(g3); merge16_desc(g2, g3); merge16_desc(g0, g2);
}
__device__ __forceinline__ float embed(float v, unsigned mask, unsigned id) { return __builtin_bit_cast(float, (__builtin_bit_cast(unsigned, v) & mask) | id); }
__device__ __forceinline__ float mkcand(float x, float y, unsigned id) { return embed(x + y, 0xFFFFFF00u, id); }

__device__ __forceinline__ void swap32(float& a, float& b) { asm volatile("v_nop\n\tv_nop\n\tv_permlane32_swap_b32 %0, %1" : "+v"(a), "+v"(b)); }
struct RouteP { const GAS bf16* QP; const GAS bf16* keys; GAS int* EX; GAS float* GW; };
constexpr int RT_KP = 144, RT_KEYS = 0, RT_SCR = 256 * RT_KP, RT_END = RT_SCR + 8 * 8192;
__device__ __forceinline__ void route_phase(const RouteP& P, LAS unsigned char* lds, int tid, int wave, int lane, int vcu, int G) {
    asm volatile("" : "+v"(tid), "+v"(lane));
    __syncthreads();
    for (int c = tid; c < 256 * 8; c += 512) { const int row = c >> 3, part = c & 7; *(LAS u32x4*)(lds + RT_KEYS + row * RT_KP + part * 16) = *(const u32x4*)(P.keys + row * 64 + part * 8); }
    __syncthreads();
    const int r32 = lane & 31, hi = lane >> 5;
    LAS int* scr = (LAS int*)(lds + RT_SCR + wave * 8192);
    for (int u = vcu; u < T / 32; u += G) {
        const size_t t = (size_t)u * 32 + r32; const int h = wave;
        float T2[2][16];
#pragma unroll
        for (int c = 0; c < 2; ++c) {
            bf16x8 qf[4];
            { const GAS bf16* q = P.QP + t * 1024 + h * 128 + c * 64 + 8 * hi;
#pragma unroll
              for (int s = 0; s < 4; ++s) qf[s] = *(const GAS bf16x8*)(q + 16 * s); }
            f32x16 sc[4];
#pragma unroll
            for (int m = 0; m < 4; ++m) {
#pragma unroll
                for (int r = 0; r < 16; ++r) sc[m][r] = 0.f;
#pragma unroll
                for (int s = 0; s < 4; ++s) { const bf16x8 a = *(const LAS bf16x8*)(lds + RT_KEYS + (c * 128 + 32 * m + r32) * RT_KP + s * 32 + hi * 16);
                    sc[m] = __builtin_amdgcn_mfma_f32_32x32x16_bf16(a, qf[s], sc[m], 0, 0, 0); }
            }
            float g0[16], g1[16], g2[16], g3[16];
            const unsigned h4 = 4u * (unsigned)hi;
#pragma unroll
            for (int r = 0; r < 16; ++r) { const unsigned kr_ = (unsigned)((r & 3) + 8 * (r >> 2));
                g0[r] = embed(sc[0][r], 0xFFFFFF80u, kr_ | h4); g1[r] = embed(sc[1][r], 0xFFFFFF80u, (32u + kr_) | h4); g2[r] = embed(sc[2][r], 0xFFFFFF80u, (64u + kr_) | h4); g3[r] = embed(sc[3][r], 0xFFFFFF80u, (96u + kr_) | h4); }
            top16_of_64(g0, g1, g2, g3);
            pad16(g0);
#pragma unroll
            for (int i = 0; i < 16; ++i) T2[c][i] = g0[i];
        }
        float A[16], Bv[16];
#pragma unroll
        for (int i = 0; i < 16; ++i) { A[i] = T2[0][i]; Bv[i] = T2[1][i]; swap32(A[i], Bv[i]); }
        merge16_desc(A, Bv);
        pad16(A);
        float T0[16], T1[16];
#pragma unroll
        for (int i = 0; i < 16; ++i) { T0[i] = A[i]; T1[i] = A[i]; swap32(T0[i], T1[i]); }
#pragma unroll
        for (int i = 0; i < 16; ++i) { scr[i * 64 + lane] = (int)(__builtin_bit_cast(unsigned, T0[i]) & 127u); scr[(16 + i) * 64 + lane] = (int)(__builtin_bit_cast(unsigned, T1[i]) & 127u);
            T0[i] = embed(T0[i], 0xFFFFFF80u, 0u); T1[i] = embed(T1[i], 0xFFFFFF80u, 0u); }
        float c0[16], c1[16], c2[16], c3[16];
        const float NINF = -__builtin_inff();
#pragma unroll
        for (int b = 0; b < 16; ++b) c0[b] = mkcand(T0[0], T1[b], (unsigned)b);
#pragma unroll
        for (int b = 0; b < 8; ++b) c1[b] = mkcand(T0[1], T1[b], 16u + b);
#pragma unroll
        for (int b = 0; b < 5; ++b) c1[8 + b] = mkcand(T0[2], T1[b], 32u + b);
#pragma unroll
        for (int b = 0; b < 3; ++b) c1[13 + b] = mkcand(T0[4], T1[b], 64u + b);
#pragma unroll
        for (int b = 0; b < 4; ++b) c2[b] = mkcand(T0[3], T1[b], 48u + b);
        c2[4] = mkcand(T0[5], T1[0], 80u); c2[5] = mkcand(T0[5], T1[1], 81u); c2[6] = mkcand(T0[6], T1[0], 96u); c2[7] = mkcand(T0[6], T1[1], 97u); c2[8] = mkcand(T0[7], T1[0], 112u); c2[9] = mkcand(T0[7], T1[1], 113u);
#pragma unroll
        for (int a = 8; a < 14; ++a) c2[10 + a - 8] = mkcand(T0[a], T1[0], 16u * a);
        c3[0] = mkcand(T0[14], T1[0], 224u); c3[1] = mkcand(T0[15], T1[0], 240u);
#pragma unroll
        for (int i = 2; i < 16; ++i) c3[i] = NINF;
        top16_of_64(c0, c1, c2, c3);
        pad16(c0);
        float gsum = 0.f, ge[16]; int ex[16];
        const float mtop = embed(c0[0], 0xFFFFFF00u, 0u);
#pragma unroll
        for (int i = 0; i < 16; ++i) { const unsigned bits = __builtin_bit_cast(unsigned, c0[i]); const int a = (bits >> 4) & 15, b = bits & 15;
            ge[i] = __builtin_amdgcn_exp2f((embed(c0[i], 0xFFFFFF00u, 0u) - mtop) * LOG2E); gsum += ge[i];
            ex[i] = scr[a * 64 + lane] * 128 + scr[(16 + b) * 64 + lane]; }
        const float ginv = __builtin_amdgcn_rcpf(gsum);
        if (hi == 0) { GAS unsigned short* d = (GAS unsigned short*)P.EX + t * 128 + h * 16;
#pragma unroll
            for (int i = 0; i < 16; ++i) d[i] = (unsigned short)ex[i]; }
        else { GAS f32x4* d = (GAS f32x4*)(P.GW + t * 128 + h * 16);
#pragma unroll
            for (int i = 0; i < 4; ++i) d[i] = (f32x4){ge[4 * i] * ginv, ge[4 * i + 1] * ginv, ge[4 * i + 2] * ginv, ge[4 * i + 3] * ginv}; }
    }
}

__device__ __forceinline__ int wave_allsum_i(int v) {
    v += __builtin_amdgcn_update_dpp(0, v, 0xB1, 0xF, 0xF, true);
    v += __builtin_amdgcn_update_dpp(0, v, 0x4E, 0xF, 0xF, true);
    v += __builtin_amdgcn_update_dpp(0, v, 0x141, 0xF, 0xF, true);
    v += __builtin_amdgcn_update_dpp(0, v, 0x140, 0xF, 0xF, true);
    { int a = v, b = v; asm volatile("v_nop\n\tv_nop\n\tv_permlane16_swap_b32 %0, %1" : "+v"(a), "+v"(b)); v = a + b; }
    { int a = v, b = v; asm volatile("v_nop\n\tv_nop\n\tv_permlane32_swap_b32 %0, %1" : "+v"(a), "+v"(b)); v = a + b; }
    return v;
}
__device__ __forceinline__ float wave_allsum(float v) {
    v += __builtin_bit_cast(float, __builtin_amdgcn_update_dpp(0, __builtin_bit_cast(int, v), 0xB1, 0xF, 0xF, true));
    v += __builtin_bit_cast(float, __builtin_amdgcn_update_dpp(0, __builtin_bit_cast(int, v), 0x4E, 0xF, 0xF, true));
    v += __builtin_bit_cast(float, __builtin_amdgcn_update_dpp(0, __builtin_bit_cast(int, v), 0x141, 0xF, 0xF, true));
    v += __builtin_bit_cast(float, __builtin_amdgcn_update_dpp(0, __builtin_bit_cast(int, v), 0x140, 0xF, 0xF, true));
    { float a = v, b = v; asm volatile("v_nop\n\tv_nop\n\tv_permlane16_swap_b32 %0, %1" : "+v"(a), "+v"(b)); v = a + b; }
    { float a = v, b = v; asm volatile("v_nop\n\tv_nop\n\tv_permlane32_swap_b32 %0, %1" : "+v"(a), "+v"(b)); v = a + b; }
    return v;
}
__device__ __forceinline__ float wave_allmax(float v) {
    v = fmaxf(v, __builtin_bit_cast(float, __builtin_amdgcn_update_dpp(0, __builtin_bit_cast(int, v), 0xB1, 0xF, 0xF, true)));
    v = fmaxf(v, __builtin_bit_cast(float, __builtin_amdgcn_update_dpp(0, __builtin_bit_cast(int, v), 0x4E, 0xF, 0xF, true)));
    v = fmaxf(v, __builtin_bit_cast(float, __builtin_amdgcn_update_dpp(0, __builtin_bit_cast(int, v), 0x141, 0xF, 0xF, true)));
    v = fmaxf(v, __builtin_bit_cast(float, __builtin_amdgcn_update_dpp(0, __builtin_bit_cast(int, v), 0x140, 0xF, 0xF, true)));
    { float a = v, b = v; asm volatile("v_nop\n\tv_nop\n\tv_permlane16_swap_b32 %0, %1" : "+v"(a), "+v"(b)); v = fmaxf(a, b); }
    { float a = v, b = v; asm volatile("v_nop\n\tv_nop\n\tv_permlane32_swap_b32 %0, %1" : "+v"(a), "+v"(b)); v = fmaxf(a, b); }
    return v;
}
__device__ __forceinline__ unsigned q4(float a, float b, float c, float d, int off) {
    const int ia = (int)__builtin_rintf(a) + off, ib = (int)__builtin_rintf(b) + off, ic = (int)__builtin_rintf(c) + off, id = (int)__builtin_rintf(d) + off;
    return (unsigned)(ia & 255) | ((unsigned)(ib & 255) << 8) | ((unsigned)(ic & 255) << 16) | ((unsigned)(id & 255) << 24);
}
__device__ __forceinline__ void quant_row(const GAS float* src, GAS unsigned* dst, GAS float* scale, int off, int lane) {
    const GAS f32x4* s = (const GAS f32x4*)src + 4 * lane; f32x4 v[4]; float m = 0.f;
#pragma unroll
    for (int i = 0; i < 4; ++i) { v[i] = s[i]; m = fmaxf(m, fmaxf(fmaxf(__builtin_fabsf(v[i].x), __builtin_fabsf(v[i].y)), fmaxf(__builtin_fabsf(v[i].z), __builtin_fabsf(v[i].w)))); }
    m = wave_allmax(m); const float inv = m > 0.f ? 127.f / m : 0.f;
    v4u w;
    w.x = q4(v[0].x * inv, v[0].y * inv, v[0].z * inv, v[0].w * inv, off); w.y = q4(v[1].x * inv, v[1].y * inv, v[1].z * inv, v[1].w * inv, off);
    w.z = q4(v[2].x * inv, v[2].y * inv, v[2].z * inv, v[2].w * inv, off); w.w = q4(v[3].x * inv, v[3].y * inv, v[3].z * inv, v[3].w * inv, off);
    *((GAS v4u*)dst + lane) = w;
    if (lane == 0) *scale = m * (1.f / 127.f);
}
struct PeerS { int nslices_step, first_slice, nloc, rank; };
__device__ __forceinline__ PeerS peer_sched(const GAS unsigned* rankw, int xcc, int rank) {
    const int lane = lane_id_v();
    const int c = lane < 16 ? (int)__hip_atomic_load(rankw + 64 * lane, __ATOMIC_RELAXED, __HIP_MEMORY_SCOPE_AGENT) : 0;
    const unsigned long long m = __builtin_amdgcn_ballot_w64(c > 0);
    const int nx = __builtin_popcountll(m), myidx = __builtin_popcountll(m & ((1ull << xcc) - 1ull));
    const int cm = __builtin_amdgcn_readlane(c, xcc);
    PeerS s; s.nslices_step = nx > 0 ? nx : 1; s.first_slice = myidx; s.nloc = cm > 0 ? cm : 1; s.rank = rank; return s;
}
struct Peer1P { const GAS unsigned GAS char* HQ; const GAS int* EX; const GAS unsigned GAS char* U8; GAS int* P; };
__device__ __forceinline__ void peer_k1(const Peer1P& Q, const PeerS& sc, int wave, int lane) {
    asm volatile("" : "+v"(lane));
    const int g = lane >> 3, j = lane & 7;
    for (int s = sc.first_slice; s < 8; s += sc.nslices_step)
        for (int tile = sc.rank; tile < T / 64; tile += sc.nloc) {
            const size_t t0 = (size_t)tile * 64 + wave * 8;
            v4u hqn = *(const GAS v4u*)(Q.HQ + t0 * 1024 + 128 * s + 16 * j), exn[2];
#pragma unroll
            for (int i = 0; i < 2; ++i) exn[i] = *(const GAS v4u*)(Q.EX + t0 * 64 + 8 * g + 4 * i);
#pragma unroll 1
            for (int k = 0; k < 8; ++k) {
                const size_t t = t0 + k;
                const v4u hq = hqn; v4u ex[2];
#pragma unroll
                for (int i = 0; i < 2; ++i) ex[i] = exn[i];
                if (k + 1 < 8) {
                    hqn = *(const GAS v4u*)(Q.HQ + (t + 1) * 1024 + 128 * s + 16 * j);
#pragma unroll
                    for (int i = 0; i < 2; ++i) exn[i] = *(const GAS v4u*)(Q.EX + (t + 1) * 64 + 8 * g + 4 * i);
                }
                v4u uu[16]; const GAS unsigned char* ubase_ = Q.U8 + 128 * s + 16 * j;
#pragma unroll
                for (int i = 0; i < 16; ++i) { const unsigned ew = ((i >> 1) & 3) == 0 ? ex[i >> 3].x : ((i >> 1) & 3) == 1 ? ex[i >> 3].y : ((i >> 1) & 3) == 2 ? ex[i >> 3].z : ex[i >> 3].w; unsigned e; if (i & 1) asm("v_lshrrev_b32 %0, 16, %1" : "=v"(e) : "v"(ew)); else asm("v_and_b32 %0, 0xffff, %1" : "=v"(e) : "v"(ew));
                    uu[i] = *(const GAS v4u*)(ubase_ + (e << 10)); }
                int lo = 0, hi = 0;
#pragma unroll
                for (int i = 0; i < 16; ++i) {
                    int p = __builtin_amdgcn_sdot4((int)uu[i].x, (int)hq.x, 0, false); p = __builtin_amdgcn_sdot4((int)uu[i].y, (int)hq.y, p, false); p = __builtin_amdgcn_sdot4((int)uu[i].z, (int)hq.z, p, false); p = __builtin_amdgcn_sdot4((int)uu[i].w, (int)hq.w, p, false);
                    p += __builtin_amdgcn_update_dpp(0, p, 0xB1, 0xF, 0xF, true); p += __builtin_amdgcn_update_dpp(0, p, 0x4E, 0xF, 0xF, true); p += __builtin_amdgcn_update_dpp(0, p, 0x141, 0xF, 0xF, true);
                    if (i < 8) lo = (j == i) ? p : lo; else hi = (j == i - 8) ? p : hi;
                }
                GAS int* prow = Q.P + t * 128 + 16 * g + j;
                (void)__hip_atomic_fetch_add(prow, lo, __ATOMIC_RELAXED, __HIP_MEMORY_SCOPE_AGENT); (void)__hip_atomic_fetch_add(prow + 8, hi, __ATOMIC_RELAXED, __HIP_MEMORY_SCOPE_AGENT);
            }
        }
}
__device__ __forceinline__ void peer_w(const GAS int* EX, const GAS float* GW, const GAS int* P, const GAS float* SH, const GAS float* SU, const GAS float* SV, GAS signed char* WQ, GAS float* WSC, int gw, int NGW, int lane) {
    asm volatile("" : "+v"(lane));
    for (int t = gw; t < T; t += NGW) {
        const float sh = SH[t];
#pragma unroll
        for (int q = 0; q < 2; ++q) { const size_t idx = (size_t)t * 128 + lane + 64 * q; const int e = (int)((const GAS unsigned short*)EX)[idx];
            const float w = GW[idx] * gelu_erf((float)P[idx] * (sh * SU[e])) * SV[e];
            float m = __builtin_fabsf(w);
            m = fmaxf(m, __builtin_bit_cast(float, __builtin_amdgcn_update_dpp(0, __builtin_bit_cast(int, m), 0xB1, 0xF, 0xF, true)));
            m = fmaxf(m, __builtin_bit_cast(float, __builtin_amdgcn_update_dpp(0, __builtin_bit_cast(int, m), 0x4E, 0xF, 0xF, true)));
            m = fmaxf(m, __builtin_bit_cast(float, __builtin_amdgcn_update_dpp(0, __builtin_bit_cast(int, m), 0x141, 0xF, 0xF, true)));
            m = fmaxf(m, __builtin_bit_cast(float, __builtin_amdgcn_update_dpp(0, __builtin_bit_cast(int, m), 0x140, 0xF, 0xF, true)));
            const float inv = m > 0.f ? 127.f / m : 0.f;
            WQ[idx] = (signed char)(int)__builtin_rintf(w * inv);
            if ((lane & 15) == 0) WSC[(size_t)t * 8 + (lane >> 4) + 4 * q] = m * (1.f / 127.f); }
    }
}
__device__ __forceinline__ void tr4x4(unsigned r0, unsigned r1, unsigned r2, unsigned r3, unsigned (&t)[4]) {
    const unsigned x0 = __builtin_amdgcn_perm(r1, r0, 0x05010400u), x1 = __builtin_amdgcn_perm(r1, r0, 0x07030602u), y0 = __builtin_amdgcn_perm(r3, r2, 0x05010400u), y1 = __builtin_amdgcn_perm(r3, r2, 0x07030602u);
    t[0] = __builtin_amdgcn_perm(y0, x0, 0x05040100u); t[1] = __builtin_amdgcn_perm(y0, x0, 0x07060302u); t[2] = __builtin_amdgcn_perm(y1, x1, 0x05040100u); t[3] = __builtin_amdgcn_perm(y1, x1, 0x07060302u);
}
struct Peer2P { const GAS int* EX; const GAS signed char* WQ; const GAS float* WSC; const GAS unsigned char* V8; GAS bf16* XB; GAS float* SSQ; };
__device__ __forceinline__ void peer_k2(const Peer2P& Q, const PeerS& sc, int wave, int lane) {
    asm volatile("" : "+v"(lane));
    const int g = lane >> 3, j = lane & 7, hf = lane >> 5, rp = (lane >> 4) & 1;
    for (int s = sc.first_slice; s < 8; s += sc.nslices_step)
        for (int tile = sc.rank; tile < T / 64; tile += sc.nloc) {
            const size_t t0 = (size_t)tile * 64 + wave * 8;
            v4u exn[2], wqn; float swn;
#pragma unroll
            for (int i = 0; i < 2; ++i) exn[i] = *(const GAS v4u*)(Q.EX + t0 * 64 + 8 * g + 4 * i);
            wqn = *(const GAS v4u*)(Q.WQ + t0 * 128 + 16 * g); swn = Q.WSC[t0 * 8 + g];
#pragma unroll 1
            for (int k = 0; k < 8; ++k) {
                const size_t t = t0 + k;
                v4u ex[2]; const v4u wq = wqn; const float sw = swn;
#pragma unroll
                for (int i = 0; i < 2; ++i) ex[i] = exn[i];
                if (k + 1 < 8) {
#pragma unroll
                    for (int i = 0; i < 2; ++i) exn[i] = *(const GAS v4u*)(Q.EX + (t + 1) * 64 + 8 * g + 4 * i);
                    wqn = *(const GAS v4u*)(Q.WQ + (t + 1) * 128 + 16 * g); swn = Q.WSC[(t + 1) * 8 + g];
                }
                GAS v2u* xp = (GAS v2u*)(Q.XB + t * 1024 + 128 * s + 16 * j + 8 * hf + 4 * rp);
                const v2u xold = *xp;
                v4u vv[16]; const GAS unsigned char* vbase_ = Q.V8 + 128 * s + 16 * j;
#pragma unroll
                for (int i = 0; i < 16; ++i) { const unsigned ew = ((i >> 1) & 3) == 0 ? ex[i >> 3].x : ((i >> 1) & 3) == 1 ? ex[i >> 3].y : ((i >> 1) & 3) == 2 ? ex[i >> 3].z : ex[i >> 3].w; unsigned e; if (i & 1) asm("v_lshrrev_b32 %0, 16, %1" : "=v"(e) : "v"(ew)); else asm("v_and_b32 %0, 0xffff, %1" : "=v"(e) : "v"(ew));
                    vv[i] = *(const GAS v4u*)(vbase_ + (e << 10)); }
                int ai[16];
#pragma unroll
                for (int i = 0; i < 16; ++i) ai[i] = 0;
#pragma unroll
                for (int q4_ = 0; q4_ < 4; ++q4_) {
                    const unsigned wq4 = q4_ == 0 ? wq.x : q4_ == 1 ? wq.y : q4_ == 2 ? wq.z : wq.w;
#pragma unroll
                    for (int c = 0; c < 4; ++c) { unsigned tt[4];
                        const v4u &a0 = vv[4 * q4_], &a1 = vv[4 * q4_ + 1], &a2 = vv[4 * q4_ + 2], &a3 = vv[4 * q4_ + 3];
                        tr4x4(c == 0 ? a0.x : c == 1 ? a0.y : c == 2 ? a0.z : a0.w, c == 0 ? a1.x : c == 1 ? a1.y : c == 2 ? a1.z : a1.w, c == 0 ? a2.x : c == 1 ? a2.y : c == 2 ? a2.z : a2.w, c == 0 ? a3.x : c == 1 ? a3.y : c == 2 ? a3.z : a3.w, tt);
#pragma unroll
                        for (int b = 0; b < 4; ++b) ai[4 * c + b] = __builtin_amdgcn_sdot4((int)tt[b], (int)wq4, ai[4 * c + b], false); }
                }
                float acc[16];
#pragma unroll
                for (int i = 0; i < 16; ++i) acc[i] = (float)ai[i] * sw;
                float r8[8], r4[4];
#pragma unroll
                for (int m = 0; m < 8; ++m) { float a = acc[m], b = acc[m + 8]; swap32(a, b); r8[m] = a + b; }
#pragma unroll
                for (int n = 0; n < 4; ++n) { float a = r8[n], b = r8[n + 4]; asm volatile("v_nop\n\tv_nop\n\tv_permlane16_swap_b32 %0, %1" : "+v"(a), "+v"(b)); r4[n] = a + b; }
#pragma unroll
                for (int n = 0; n < 4; ++n) r4[n] += __builtin_bit_cast(float, __builtin_amdgcn_update_dpp(0, __builtin_bit_cast(int, r4[n]), 0x128, 0xF, 0xF, true));
                v2u xw; xw.x = pk2(bflo(xold.x) + r4[0], bfhi(xold.x) + r4[1]); xw.y = pk2(bflo(xold.y) + r4[2], bfhi(xold.y) + r4[3]);
                float ss = 0.f;
                if ((lane & 8) == 0) { const float x0 = bflo(xw.x), x1 = bfhi(xw.x), x2 = bflo(xw.y), x3 = bfhi(xw.y); ss = (x0 * x0 + x1 * x1) + (x2 * x2 + x3 * x3); *xp = xw; }
                ss = wave_allsum(ss);
                if (Q.SSQ) { if (lane == 0) Q.SSQ[t * 16 + s] = ss; }
            }
        }
}

struct Args { const float* in[33]; float* out; unsigned char* ws; int ph_lo, ph_hi; };
struct Frame { LAS unsigned char* lds; volatile LAS unsigned* MISC; gu32* ctl; int tid, lane, wave, G, vcu, xcc, xrank; };

__device__ __forceinline__ void transpose_item(const float* W, int ldw, int nsrc0, bf16* WT, int ldt, int rdst0, LAS float* scr, int kb, int nb, int lane, float scale, const float* kgain) {
    const int k0 = 64 * kb, n0 = 32 * nb;
#pragma unroll 8
    for (int i = 0; i < 32; ++i) { const int kk = 2 * i + (lane >> 5); const float gsc = kgain ? kgain[k0 + kk] * scale : scale; scr[kk * 33 + (lane & 31)] = W[(size_t)(k0 + kk) * ldw + nsrc0 + n0 + (lane & 31)] * gsc; }
    LDS_WAIT(); asm volatile("" ::: "memory");
    const int c = lane & 7;
#pragma unroll
    for (int j = 0; j < 4; ++j) { const int n = (lane >> 3) + 8 * j; const LAS float* s = scr + (8 * c) * 33 + n;
        v4u o; o.x = pk2(s[0 * 33], s[1 * 33]); o.y = pk2(s[2 * 33], s[3 * 33]); o.z = pk2(s[4 * 33], s[5 * 33]); o.w = pk2(s[6 * 33], s[7 * 33]);
        *(GAS v4u*)(WT + (size_t)(rdst0 + n0 + n) * ldt + k0 + 8 * c) = o; }
    LDS_WAIT(); asm volatile("" ::: "memory");
}
__device__ __forceinline__ void zero_rect(bf16* base, int ld, int row0, int nrows, int col0, int ncols, int gtid, int gthreads) {
    const int vpr = ncols / 8;
    for (int i = gtid; i < nrows * vpr; i += gthreads) { const int r = i / vpr, c = i % vpr; *(GAS v4u*)(base + (size_t)(row0 + r) * ld + col0 + 8 * c) = (v4u){0u, 0u, 0u, 0u}; }
}

__device__ __forceinline__ void p0_prologue(Frame& F, const Args& a) {
    LAS float* scr = (LAS float*)(F.lds + RING_OFF + F.wave * 16384);
    const int gw = blockIdx.x * NWAVES + F.wave, NGW = F.G * NWAVES;
    const int gtid = blockIdx.x * (NWAVES * 64) + F.tid, gthreads = F.G * NWAVES * 64;
    unsigned char* ws = a.ws;
    x0_phase((const GAS float*)a.in[0], (GAS bf16*)(ws + WS_XNB), (GAS float*)(ws + WS_SSQ), gw, NGW, F.lane);
    constexpr int I_IN = 16 * (INW / 32), I_SQ = 16 * 32, I_CKV = 16 * 64, I_UQ = 3 * 12, I_UKV = 2 * 16, I_L = I_IN + 4 * I_SQ + I_CKV + I_UQ + I_UKV;
    for (int it = gw; it < L * I_L; it += NGW) {
        const int l = it / I_L; int r = it % I_L;
        if (r < I_IN) {
            const int kb = r / 67, nb = r % 67; int src, dst; float sc = 1.f;
            if (nb < 6) { src = 32 * nb; dst = src; } else if (nb < 11) { src = 32 * nb; dst = src + 64; } else { src = 32 * nb; dst = src + 160; if (nb >= 43 && nb < 51) sc = 0.17677669529663687f * LOG2E; }
            transpose_item(a.in[5] + (size_t)l * D * INW, INW, src, (bf16*)(ws + WS_WIN) + (size_t)l * INP * D, D, dst, scr, kb, 0, F.lane, sc, a.in[4] + l * D); continue; } r -= I_IN;
        if (r < I_SQ) { transpose_item(a.in[21] + (size_t)l * D * D, D, 0, (bf16*)(ws + WS_WOUT) + (size_t)l * D * D, D, 0, scr, r / 32, r % 32, F.lane, 1.f, nullptr); continue; } r -= I_SQ;
        if (r < I_SQ) { transpose_item(a.in[24] + (size_t)l * D * D, D, 0, (bf16*)(ws + WS_WCQ) + (size_t)l * D * D, D, 0, scr, r / 32, r % 32, F.lane, 0.0625f * LOG2E, a.in[22] + l * D); continue; } r -= I_SQ;
        if (r < I_SQ) { transpose_item(a.in[26] + (size_t)l * D * D, D, 0, (bf16*)(ws + WS_WCO) + (size_t)l * D * D, D, 0, scr, r / 32, r % 32, F.lane, 1.f, nullptr); continue; } r -= I_SQ;
        if (r < I_SQ) { transpose_item(a.in[28] + (size_t)l * D * D, D, 0, (bf16*)(ws + WS_WPQ) + (size_t)l * D * D, D, 0, scr, r / 32, r % 32, F.lane, 1.f, a.in[27] + l * D); continue; } r -= I_SQ;
        if (r < I_CKV) { transpose_item(a.in[25] + (size_t)l * D * 2 * D, 2 * D, 0, (bf16*)(ws + WS_WCKV) + (size_t)l * 2 * D * D, D, 0, scr, r / 64, r % 64, F.lane, 1.f, nullptr); continue; } r -= I_CKV;
        if (r < I_UQ) { transpose_item(a.in[7] + (size_t)l * 192 * 384, 384, 0, (bf16*)(ws + WS_WUQ) + (size_t)l * 512 * 256, 256, 0, scr, r / 12, r % 12, F.lane, 0.10206207261596575f * LOG2E, a.in[6] + l * 192); continue; } r -= I_UQ;
        transpose_item(a.in[9] + (size_t)l * 128 * 512, 512, 0, (bf16*)(ws + WS_WUKV) + (size_t)l * 512 * 256, 256, 0, scr, r / 16, r % 16, F.lane, 1.f, a.in[8] + l * 128);
    }
    for (int l = 0; l < L; ++l) {
        bf16* win = (bf16*)(ws + WS_WIN) + (size_t)l * INP * D; bf16* wuq = (bf16*)(ws + WS_WUQ) + (size_t)l * 512 * 256; bf16* wukv = (bf16*)(ws + WS_WUKV) + (size_t)l * 512 * 256;
        zero_rect(win, D, 192, 64, 0, D, gtid, gthreads); zero_rect(win, D, 416, 96, 0, D, gtid, gthreads);
        zero_rect(wuq, 256, 0, 384, 192, 64, gtid, gthreads); zero_rect(wuq, 256, 384, 128, 0, 256, gtid, gthreads);
        zero_rect(wukv, 256, 0, 512, 128, 128, gtid, gthreads);
    }
    { float* rope = (float*)(ws + WS_ROPE); const int* pos = (const int*)a.in[2];
      for (int i = gtid; i < T * 16; i += gthreads) { const int t = i >> 4, k = i & 15; const float inv = powf(10000.f, -(float)(2 * k) / 32.f); const float ang = (float)pos[t] * inv;
          rope[(size_t)t * 32 + k] = cosf(ang); rope[(size_t)t * 32 + 16 + k] = sinf(ang); } }
    { const GAS f32x4* ks = (const GAS f32x4*)a.in[29]; GAS v2u* kd = (GAS v2u*)(ws + WS_KEYS);
      for (int i = gtid; i < L * 2 * 128 * 64 / 4; i += gthreads) { const f32x4 v = ks[i]; v2u w; w.x = pk2(v.x, v.y); w.y = pk2(v.z, v.w); kd[i] = w; }
    }
    for (int r = gw; r < 2 * L * 16384; r += NGW) { const int tb = r / (L * 16384), rr = r % (L * 16384);
        quant_row((const GAS float*)a.in[30 + tb] + (size_t)rr * 1024, (GAS unsigned*)(ws + (tb ? WS_V8 : WS_U8) + (size_t)rr * 1024), (GAS float*)(ws + (tb ? WS_SV : WS_SU)) + rr, 0, F.lane); }
    { float* btab = (float*)(ws + WS_BTAB); float* lams = (float*)(ws + WS_LAMS); float* spt = (float*)(ws + WS_SP);
      for (int i = gtid; i < 4 * 129; i += gthreads) { const int h = i / 129, n = i % 129; int bu; if (n < 16) bu = n; else { const int lg = 16 + (int)(logf((float)n / 16.f) / logf(8.f) * 16.f); bu = lg < 31 ? lg : 31; }
          btab[i] = a.in[3][bu * 4 + h] * LOG2E; }
      for (int i = gtid; i < L; i += gthreads) { const float* dl = a.in[17] + i * 128; float s1 = 0.f, s2 = 0.f; for (int j = 0; j < 32; ++j) { s1 += dl[j] * dl[32 + j]; s2 += dl[64 + j] * dl[96 + j]; }
          const float li = 0.8f - 0.6f * expf(-0.3f * (float)i); lams[2 * i] = expf(s1) - expf(s2) + li; lams[2 * i + 1] = li; }
      for (int i = gtid; i < L * 512; i += gthreads) spt[i] = log1pf(expf(-a.in[16][i])); }
    { GAS bf16* wat = (GAS bf16*)(ws + WS_WAT);
      for (int i = gtid; i < L * 8 * 2 * 4096; i += gthreads) { const int in_ = i & 63, out_ = (i >> 6) & 63, gate = (i >> 12) & 1, lg = i >> 13;
          wat[i] = (bf16)f2bf_(a.in[gate ? 14 : 12][(size_t)lg * 4096 + in_ * 64 + out_]); } }
    for (int l = 0; l < L; ++l) norm_phase((const GAS float*)a.in[1], (const GAS float*)a.in[23] + l * D, (GAS bf16*)(ws + WS_MNB) + (size_t)l * NB * MEM * D, NB * MEM, gw, NGW, F.lane);
}

constexpr int NPL = 16, PH_FINAL = 2 + NPL * L;
__global__ void __launch_bounds__(NWAVES * 64, 2) fwd(Args args) {
    extern __shared__ __attribute__((aligned(16))) unsigned char lds[];
    Frame F;
    F.lds = (LAS unsigned char*)lds; F.MISC = (volatile LAS unsigned*)(F.lds + MISC_OFF);
    F.tid = threadIdx.x; F.lane = F.tid & 63; F.wave = __builtin_amdgcn_readfirstlane(F.tid >> 6); F.G = gridDim.x;
    F.vcu = (F.G % 8 == 0) ? ((int)blockIdx.x % 8) * (F.G / 8) + (int)blockIdx.x / 8 : (int)blockIdx.x;
    unsigned char* ws = args.ws;
    F.ctl = (gu32*)(opq(ws) + WS_CTL);
    for (int u = F.tid; u < (LDS_BYTES - LDSCTL_OFF) / 4; u += NWAVES * 64) ((LAS unsigned*)(F.lds + LDSCTL_OFF))[u] = 0u;
    __syncthreads();
    XcdBarrier bar = xcd_barrier_post((unsigned*)(F.ctl + CW_BAR), F.MISC + 8);
    F.xcc = (int)bar.x;
    if (F.tid == 0) F.MISC[12] = __hip_atomic_fetch_add((unsigned*)(F.ctl + CW_RANK) + 64 * bar.x, 1u, __ATOMIC_RELAXED, __HIP_MEMORY_SCOPE_AGENT);
    __syncthreads();
    F.xrank = __builtin_amdgcn_readfirstlane((int)F.MISC[12]);
    const int lo = args.ph_lo, hi = args.ph_hi;
    const int gw = blockIdx.x * NWAVES + F.wave, NGW = F.G * NWAVES;
#define IN(k) (lo <= (k) && (k) < hi)
#define LANE_ (lane_id_v())
#define TID_ ((opqi(F.wave) << 6) | LANE_)
#define SITE() const int G_ = opqi(F.G), wv_ = opqi(F.wave), vcu_ = opqi(F.vcu), gw_ = opqi(gw), NGW_ = opqi(NGW); (void)G_; (void)wv_; (void)vcu_; (void)gw_; (void)NGW_
#if MK_DUP == 99
#define SEAM(k) do { if (IN(k) && IN((k) + 1)) { xcd_barrier(bar, (F.wave == 0 && lane_id_v() == 0) ? 1 : 0); xcd_barrier(bar, (F.wave == 0 && lane_id_v() == 0) ? 1 : 0); } } while (0)
#else
#define SEAM(k) do { if (IN(k) && IN((k) + 1)) xcd_barrier(bar, (F.wave == 0 && lane_id_v() == 0) ? 1 : 0); } while (0)
#endif
#define GEMM_SITE(EPI, Aptr, lda_, Bptr, ldb_, M_, N_, K_, cperm, ...) do { \
        pg8::Gemm g{opq(Aptr), opq(Bptr), M_, N_, K_, lda_, ldb_}; pg8::StaticOrder So; So.init(M_, N_, opqi(F.G), opqi(cperm)); pg8::EPI E{__VA_ARGS__}; \
        pg8::gemm_phase<pg8::EPI, pg8::StaticOrder, true, true>(F.lds + RING_OFF, g, So, E, opqi(F.wave)); } while (0)
    if (IN(0)) { p0_prologue(F, args); }
    SEAM(0);
    if (IN(1)) {
#pragma unroll 1
        for (int l = 0; l < L; ++l)
            GEMM_SITE(EpiBf16, (const GAS bf16*)(opq(ws) + WS_MNB) + (size_t)l * NB * MEM * D, D, (const GAS bf16*)(opq(ws) + WS_WCKV) + (size_t)l * 2 * D * D, D, NB * MEM, 2 * D, D, (int)((blockIdx.x + 64 * l) % F.G),
                      opq((GAS bf16*)(opq(ws) + WS_KVCB) + (size_t)l * NB * MEM * 2 * D), 2 * D, 2 * D, (const GAS float*)nullptr, 0);
    }
    SEAM(1);
    for (int l = 0; l < L; ++l) {
        const int pb = 2 + NPL * l;
        const GAS bf16* XNB = (const GAS bf16*)(opq(ws) + WS_XNB); const GAS bf16* YB = (const GAS bf16*)(opq(ws) + WS_YB); GAS bf16* PROJB = (GAS bf16*)(opq(ws) + WS_PROJB);
        if (IN(pb + 1)) GEMM_SITE(EpiBf16, XNB, D, (const GAS bf16*)(opq(ws) + WS_WIN) + (size_t)l * INP * D, D, T, INP, D, (int)blockIdx.x, opq(PROJB), INP, INP, opq((const GAS float*)(opq(ws) + WS_SSQ)), 8);
#if MK_DUP == 1
        if (IN(pb + 1)) GEMM_SITE(EpiBf16, XNB, D, (const GAS bf16*)(opq(ws) + WS_WIN) + (size_t)l * INP * D, D, T, INP, D, (int)blockIdx.x, opq(PROJB), INP, INP, opq((const GAS float*)(opq(ws) + WS_SSQ)), 8);
#endif
        SEAM(pb + 1);
        if (IN(pb + 2)) {
            SITE();
            pre_phase(opq((const GAS bf16*)PROJB), opq((const GAS float*)(opq(ws) + WS_ROPE)), opq((GAS float*)(opq(ws) + WS_RS)), opq((GAS bf16*)(opq(ws) + WS_KMB)), gw_, NGW_, LANE_);
#if MK_DUP == 21
            pre_phase(opq((const GAS bf16*)PROJB), opq((const GAS float*)(opq(ws) + WS_ROPE)), opq((GAS float*)(opq(ws) + WS_RS)), opq((GAS bf16*)(opq(ws) + WS_KMB)), gw_, NGW_, LANE_);
#endif
            LruP LP{opq((const GAS bf16*)PROJB), (const GAS float*)args.in[opqi(10)] + l * 4 * 512, (const GAS float*)args.in[opqi(11)] + l * 512, opq((const GAS bf16*)(opq(ws) + WS_WAT)) + (size_t)l * 8 * 2 * 4096, (const GAS float*)args.in[opqi(13)] + l * 512, (const GAS float*)args.in[opqi(15)] + l * 512,
                    (const GAS float*)(opq(ws) + WS_SP) + l * 512, opq((GAS unsigned*)(opq(ws) + WS_HLB)), opq((GAS float*)(opq(ws) + WS_LSUM))};
            lru_phase(LP, F.lds, TID_, wv_, LANE_, vcu_, G_);
#if MK_DUP == 2
            lru_phase(LP, F.lds, TID_, wv_, LANE_, vcu_, G_);
#endif
        }
        SEAM(pb + 2);
        if (IN(pb + 3)) {
            GEMM_SITE(EpiUp, (const GAS bf16*)PROJB + PC_CQ, INP, (const GAS bf16*)(opq(ws) + WS_WUQ) + (size_t)l * 512 * 256, 256, T, 512, 256, (int)blockIdx.x,
                      opq((GAS bf16*)(opq(ws) + WS_QMB)), (GAS bf16*)nullptr, 384, 384, opq((const GAS float*)(opq(ws) + WS_RS)), 0, 0);
            GEMM_SITE(EpiUp, (const GAS bf16*)PROJB + PC_CKV, INP, (const GAS bf16*)(opq(ws) + WS_WUKV) + (size_t)l * 512 * 256, 256, T, 512, 256, (int)blockIdx.x,
                      opq((GAS bf16*)(opq(ws) + WS_KMB)), opq((GAS bf16*)(opq(ws) + WS_VMB)), 0, 512, opq((const GAS float*)(opq(ws) + WS_RS)), 1, 1);
#if MK_DUP == 3
            GEMM_SITE(EpiUp, (const GAS bf16*)PROJB + PC_CQ, INP, (const GAS bf16*)(opq(ws) + WS_WUQ) + (size_t)l * 512 * 256, 256, T, 512, 256, (int)blockIdx.x,
                      opq((GAS bf16*)(opq(ws) + WS_QMB)), (GAS bf16*)nullptr, 384, 384, opq((const GAS float*)(opq(ws) + WS_RS)), 0, 0);
            GEMM_SITE(EpiUp, (const GAS bf16*)PROJB + PC_CKV, INP, (const GAS bf16*)(opq(ws) + WS_WUKV) + (size_t)l * 512 * 256, 256, T, 512, 256, (int)blockIdx.x,
                      opq((GAS bf16*)(opq(ws) + WS_KMB)), opq((GAS bf16*)(opq(ws) + WS_VMB)), 0, 512, opq((const GAS float*)(opq(ws) + WS_RS)), 1, 1);
#endif
        }
        SEAM(pb + 3);
        if (IN(pb + 4)) {
            SITE();
            AttnP PM{opq((const GAS bf16*)(opq(ws) + WS_QMB)), opq((const GAS bf16*)(opq(ws) + WS_KMB)), opq((const GAS bf16*)(opq(ws) + WS_VMB)), 384, 384, 256, opq((GAS bf16*)(opq(ws) + WS_OMB)), 256, opq((const GAS float*)(opq(ws) + WS_ROPE)), nullptr, nullptr, nullptr, nullptr};
            AttnP PD{opq((const GAS bf16*)PROJB + PC_QD), opq((const GAS bf16*)PROJB + PC_KD), opq((const GAS bf16*)PROJB + PC_VD), INP, INP, INP, opq((GAS bf16*)(opq(ws) + WS_YB) + 768), 1024, nullptr,
                     (const GAS int*)args.in[opqi(2)], (const GAS float*)(opq(ws) + WS_BTAB), (const GAS float*)args.in[opqi(18)] + l * 64, (const GAS float*)(opq(ws) + WS_LAMS) + 2 * l};
            attn_phase(PM, PD, F.lds, TID_, wv_, LANE_, vcu_, G_);
#if MK_DUP == 4
            __syncthreads(); attn_phase(PM, PD, F.lds, TID_, wv_, LANE_, vcu_, G_);
#elif MK_DUP == 40 || MK_DUP == 41
            __syncthreads(); attn_phase(PM, PD, F.lds, TID_, wv_, LANE_, vcu_, G_, MK_DUP - 40);
#endif
        }
        SEAM(pb + 4);
        if (IN(pb + 5)) {
            SITE();
            PostP PP{opq((const GAS bf16*)(opq(ws) + WS_OMB)), opq((const GAS unsigned*)(opq(ws) + WS_HLB)), opq((const GAS float*)(opq(ws) + WS_LSUM)), opq((const GAS bf16*)PROJB), (const GAS float*)args.in[opqi(19)] + l * 256, (const GAS float*)args.in[opqi(20)] + l * 512, opq((GAS bf16*)(opq(ws) + WS_YB))};
            post_phase(PP, F.lds, TID_, wv_, LANE_, vcu_, G_);
#if MK_DUP == 5
            __syncthreads(); post_phase(PP, F.lds, TID_, wv_, LANE_, vcu_, G_);
#endif
        }
        SEAM(pb + 5);
        if (IN(pb + 6)) GEMM_SITE(EpiRes, YB, D, (const GAS bf16*)(opq(ws) + WS_WOUT) + (size_t)l * D * D, D, T, D, D, (int)blockIdx.x, opq((GAS bf16*)(opq(ws) + WS_XNB)), opq((GAS float*)(opq(ws) + WS_SSQ)));
#if MK_DUP == 6
        if (IN(pb + 6)) GEMM_SITE(EpiRes, YB, D, (const GAS bf16*)(opq(ws) + WS_WOUT) + (size_t)l * D * D, D, T, D, D, (int)blockIdx.x, opq((GAS bf16*)(opq(ws) + WS_HLB)), opq((GAS float*)(opq(ws) + WS_OMB)));
#endif
        SEAM(pb + 6);
        if (IN(pb + 8)) GEMM_SITE(EpiBf16, XNB, D, (const GAS bf16*)(opq(ws) + WS_WCQ) + (size_t)l * D * D, D, T, D, D, (int)blockIdx.x, opq(PROJB), D, D, opq((const GAS float*)(opq(ws) + WS_SSQ)), 16);
#if MK_DUP == 8
        if (IN(pb + 8)) GEMM_SITE(EpiBf16, XNB, D, (const GAS bf16*)(opq(ws) + WS_WCQ) + (size_t)l * D * D, D, T, D, D, (int)blockIdx.x, opq(PROJB), D, D, opq((const GAS float*)(opq(ws) + WS_SSQ)), 16);
#endif
        SEAM(pb + 8);
        if (IN(pb + 9)) {
            SITE();
            const GAS bf16* kv = (const GAS bf16*)(opq(ws) + WS_KVCB) + (size_t)l * NB * MEM * 2 * D;
            AttnP PC{opq((const GAS bf16*)PROJB), opq(kv), opq(kv + D), 1024, 2 * D, 2 * D, opq((GAS bf16*)(opq(ws) + WS_YB)), 1024, nullptr, nullptr, nullptr, nullptr, nullptr};
            cross_phase(PC, F.lds, TID_, wv_, LANE_, vcu_, G_);
#if MK_DUP == 9
            cross_phase(PC, F.lds, TID_, wv_, LANE_, vcu_, G_);
#endif
        }
        SEAM(pb + 9);
        if (IN(pb + 10)) GEMM_SITE(EpiRes, YB, D, (const GAS bf16*)(opq(ws) + WS_WCO) + (size_t)l * D * D, D, T, D, D, (int)blockIdx.x, opq((GAS bf16*)(opq(ws) + WS_XNB)), opq((GAS float*)(opq(ws) + WS_SSQ)));
        SEAM(pb + 10);
        if (IN(pb + 12)) { GEMM_SITE(EpiBf16, XNB, D, (const GAS bf16*)(opq(ws) + WS_WPQ) + (size_t)l * D * D, D, T, D, D, (int)blockIdx.x, opq(PROJB), D, D, opq((const GAS float*)(opq(ws) + WS_SSQ)), 16);
            SITE(); hq_phase(opq(XNB), opq((const GAS float*)(opq(ws) + WS_SSQ)), (const GAS float*)args.in[opqi(27)] + l * D, opq((GAS unsigned char*)(opq(ws) + WS_HQ)), opq((GAS float*)(opq(ws) + WS_SH)), opq((GAS int*)(opq(ws) + WS_P)), gw_, NGW_, LANE_);
#if MK_DUP == 12
            hq_phase(opq(XNB), opq((const GAS float*)(opq(ws) + WS_SSQ)), (const GAS float*)args.in[opqi(27)] + l * D, opq((GAS unsigned char*)(opq(ws) + WS_HQ)), opq((GAS float*)(opq(ws) + WS_SH)), opq((GAS int*)(opq(ws) + WS_P)), gw_, NGW_, LANE_);
#endif
            }
        SEAM(pb + 12);
        if (IN(pb + 13)) {
            SITE();
            RouteP RP{opq((const GAS bf16*)PROJB), opq((const GAS bf16*)(opq(ws) + WS_KEYS) + (size_t)l * 2 * 128 * 64), opq((GAS int*)(opq(ws) + WS_EX)), opq((GAS float*)(opq(ws) + WS_GW))};
            route_phase(RP, F.lds, TID_, wv_, LANE_, vcu_, G_);
#if MK_DUP == 13
            route_phase(RP, F.lds, TID_, wv_, LANE_, vcu_, G_);
#endif
        }
        SEAM(pb + 13);
        if (IN(pb + 14)) {
            SITE();
            const PeerS ps = peer_sched((const GAS unsigned*)(F.ctl + CW_RANK), opqi(F.xcc), opqi(F.xrank));
            Peer1P Q1{opq((const GAS unsigned char*)(opq(ws) + WS_HQ)), opq((const GAS int*)(opq(ws) + WS_EX)), opq((const GAS unsigned char*)(opq(ws) + WS_U8) + (size_t)l * 16384 * 1024), opq((GAS int*)(opq(ws) + WS_P))};
            peer_k1(Q1, ps, wv_, LANE_);
#if MK_DUP == 141
            { Peer1P Q1b = Q1; Q1b.P = (GAS int*)(opq(ws) + WS_PROJB); peer_k1(Q1b, ps, wv_, LANE_); }
#endif
        }
        SEAM(pb + 14);
        if (IN(pb + 15)) {
            SITE();
            peer_w(opq((const GAS int*)(opq(ws) + WS_EX)), opq((const GAS float*)(opq(ws) + WS_GW)), opq((const GAS int*)(opq(ws) + WS_P)), opq((const GAS float*)(opq(ws) + WS_SH)), opq((const GAS float*)(opq(ws) + WS_SU) + l * 16384), opq((const GAS float*)(opq(ws) + WS_SV) + l * 16384),
                   opq((GAS signed char*)(opq(ws) + WS_W)), opq((GAS float*)(opq(ws) + WS_WS)), gw_, NGW_, LANE_);
#if MK_DUP == 150
            peer_w(opq((const GAS int*)(opq(ws) + WS_EX)), opq((const GAS float*)(opq(ws) + WS_GW)), opq((const GAS int*)(opq(ws) + WS_P)), opq((const GAS float*)(opq(ws) + WS_SH)), opq((const GAS float*)(opq(ws) + WS_SU) + l * 16384), opq((const GAS float*)(opq(ws) + WS_SV) + l * 16384),
                   opq((GAS signed char*)(opq(ws) + WS_W)), opq((GAS float*)(opq(ws) + WS_WS)), gw_, NGW_, LANE_);
#endif
            xcd_barrier(bar, (F.wave == 0 && lane_id_v() == 0) ? 1 : 0);
            const PeerS ps = peer_sched((const GAS unsigned*)(F.ctl + CW_RANK), opqi(F.xcc), opqi(F.xrank));
            Peer2P Q2{opq((const GAS int*)(opq(ws) + WS_EX)), opq((const GAS signed char*)(opq(ws) + WS_W)), opq((const GAS float*)(opq(ws) + WS_WS)), opq((const GAS unsigned char*)(opq(ws) + WS_V8) + (size_t)l * 16384 * 1024), opq((GAS bf16*)(opq(ws) + WS_XNB)), opq((GAS float*)(opq(ws) + WS_SSQ))};
            peer_k2(Q2, ps, wv_, LANE_);
#if MK_DUP == 151
            { Peer2P Q2b = Q2; Q2b.XB = (GAS bf16*)(opq(ws) + WS_HLB); Q2b.SSQ = (GAS float*)(opq(ws) + WS_OMB); peer_k2(Q2b, ps, wv_, LANE_); }
#endif
        }
        SEAM(pb + 15);
    }
    if (IN(PH_FINAL)) { SITE(); final_norm_phase(opq((const GAS bf16*)(opq(ws) + WS_XNB)), (GAS float*)args.out, (const GAS float*)args.in[opqi(32)], T, gw_, NGW_, LANE_); }
#undef IN
#undef SEAM
#undef GEMM_SITE
}
}
extern "C" void kernel_launch(void* const* d_in, const int* in_sizes, int n_in, void* d_out, int out_size, void* d_ws, size_t ws_size, hipStream_t stream) {
    (void)in_sizes; (void)out_size;
    static int grid = 0;
    if (grid == 0) {
        int dev = 0, cus = 0, per_cu = 0;
        if (n_in != 33 || ws_size < mk::WS_END) { fprintf(stderr, "kernel_launch: unexpected n_in %d / ws_size %zu\n", n_in, ws_size); grid = -1; return; }
        if (hipGetDevice(&dev) != hipSuccess || hipDeviceGetAttribute(&cus, hipDeviceAttributeMultiprocessorCount, dev) != hipSuccess) { grid = -1; return; }
        if (hipFuncSetAttribute((const void*)mk::fwd, hipFuncAttributeMaxDynamicSharedMemorySize, mk::LDS_BYTES) != hipSuccess) { fprintf(stderr, "kernel_launch: hipFuncSetAttribute failed\n"); grid = -1; return; }
        if (hipOccupancyMaxActiveBlocksPerMultiprocessor(&per_cu, (const void*)mk::fwd, mk::NWAVES * 64, mk::LDS_BYTES) != hipSuccess || per_cu < 1) fprintf(stderr, "kernel_launch: occupancy query says %d\n", per_cu);
        (void)hipGetLastError();
        grid = cus;
    }
    if (grid < 0) return;
    unsigned char* ws = (unsigned char*)d_ws;
    (void)hipMemsetAsync(ws + mk::WS_CTL, 0, mk::CTL_ZERO_BYTES, stream);
    mk::Args a{};
    for (int i = 0; i < 33; ++i) a.in[i] = (const float*)d_in[i];
    a.out = (float*)d_out; a.ws = ws;
    auto run = [&](int lo, int hi) { a.ph_lo = lo; a.ph_hi = hi; hipLaunchKernelGGL(mk::fwd, dim3(grid), dim3(mk::NWAVES * 64), mk::LDS_BYTES, stream, a); };
#if MK_ONE_LAUNCH
    run(0, mk::PH_FINAL + 1);
#else
    for (int p = 0; p <= mk::PH_FINAL; ++p) {
        const int k = (p - 2) % mk::NPL, l = (p - 2) / mk::NPL;
#if MK_NAIVE_PEER == 2
        if (p >= 2 && p < mk::PH_FINAL && k == 14) {
            hipLaunchKernelGGL(k_peer, dim3(T), dim3(256), 0, stream, (const bf16_t*)(ws + mk::WS_XNB), (const int*)(ws + mk::WS_EX), (const float*)(ws + mk::WS_GW), (const float*)d_in[30] + (size_t)l * NEXP * D, (const float*)d_in[31] + (size_t)l * NEXP * D, (float*)d_out);
            continue; }
#elif MK_NAIVE_PEER == 1
        if (p >= 2 && p < mk::PH_FINAL && k == 13) {
            float* TQ = (float*)(ws + (size_t)806 * mk::MiB);
            hipLaunchKernelGGL(k_bf2f, dim3((unsigned)(((size_t)T * D + 255) / 256)), dim3(256), 0, stream, (const bf16_t*)(ws + mk::WS_PROJB), TQ, (long)T * D);
            hipLaunchKernelGGL(k_route, dim3(T), dim3(256), 0, stream, TQ, (const float*)d_in[29] + (size_t)l * 2 * 128 * 64, (int*)(ws + mk::WS_EX), (float*)(ws + mk::WS_GW));
            hipLaunchKernelGGL(k_peer, dim3(T), dim3(256), 0, stream, (const bf16_t*)(ws + mk::WS_XNB), (const int*)(ws + mk::WS_EX), (const float*)(ws + mk::WS_GW), (const float*)d_in[30] + (size_t)l * NEXP * D, (const float*)d_in[31] + (size_t)l * NEXP * D, (float*)d_out);
            continue; }
        if (p >= 2 && p < mk::PH_FINAL && k == 14) continue;
#endif
        run(p, p + 1); }
#endif
}
```

```cpp
#include <hip/hip_runtime.h>
#include <cstdint>
#include <cstdio>
#include <cmath>

#ifndef MK_ONE_LAUNCH
#define MK_ONE_LAUNCH 1
#endif
#ifndef MK_DUP
#define MK_DUP 0
#endif
#ifndef MK_NAIVE_PEER
#define MK_NAIVE_PEER 0
#endif
namespace pg8 {
#define PG8_LAS __attribute__((address_space(3)))
#ifndef GAS
#define GAS __attribute__((address_space(1)))
#endif
typedef unsigned short bf16_t;
typedef short bf16x8 __attribute__((ext_vector_type(8)));
typedef float f32x4 __attribute__((ext_vector_type(4)));
typedef unsigned u32x4 __attribute__((ext_vector_type(4)));
typedef unsigned u32x2 __attribute__((ext_vector_type(2)));
constexpr int BM = 256, BK = 64, HALF = 128, HTB = HALF * BK * 2, STAGE_BYTES = 8 * HTB, NXCD = 8, WGM = 8;
__host__ __device__ __forceinline__ int lds_byte(int r, int c) { const int st = (r >> 4) * 2 + (c >> 5), rr = r & 15, cc = c & 31, ob = rr * 64 + cc * 2; return st * 1024 + (ob ^ (((ob >> 9) & 1) << 5)); }
__host__ __device__ __forceinline__ void stage_rc(int b, int& R, int& C) { const int st = b / 1024, sb = b % 1024, swz = sb ^ (((sb >> 9) & 1) << 5); R = (st >> 1) * 16 + swz / 64; C = (st & 1) * 32 + (swz % 64) / 2; }
__host__ __device__ __forceinline__ int perm32(int rho) { const int n = rho >> 4, i = rho & 15; return 8 * (i >> 2) + 4 * n + (i & 3); }
__device__ __forceinline__ int pg8_lane_id() { int l; asm volatile("v_mbcnt_lo_u32_b32 %0, -1, 0\n\tv_mbcnt_hi_u32_b32 %0, -1, %0" : "=v"(l)); return l; }
struct Unit { int pm, pn; };
struct Gemm { const GAS bf16_t* A; const GAS bf16_t* Bt; int M, N, K, lda, ldb; };
struct StaticOrder {
    int nM, nN, nwg, G, c;
    __host__ __device__ void init(int M, int N, int G_, int c_) { nM = M / BM; nN = N / BM; nwg = nM * nN; G = G_; c = c_; }
    __host__ __device__ bool next(int i, Unit& u) const {
        const long L = (long)i * G + c; if (L >= nwg) return false;
        int wgid = (int)L; { const int q = nwg / NXCD, r = nwg % NXCD, xcd = wgid % NXCD, off = wgid / NXCD; wgid = (xcd < r ? xcd * (q + 1) : r * (q + 1) + (xcd - r) * q) + off; }
        const int nig = WGM * nN, gid = wgid / nig, fm = gid * WGM, gsz = (nM - fm) < WGM ? (nM - fm) : WGM;
        u.pm = fm + ((wgid % nig) % gsz); u.pn = (wgid % nig) / gsz; return true;
    }
    __device__ __forceinline__ void a_ready(const Unit&) const {}
    __device__ __forceinline__ void done(const Unit&) const {}
};
__device__ __forceinline__ unsigned cvt_pk_bf16(float lo, float hi) { unsigned r; asm volatile("v_cvt_pk_bf16_f32 %0, %1, %2" : "=v"(r) : "v"(lo), "v"(hi)); return r; }

struct EpiF32 {
    static constexpr bool PERM = false, AFTER_DRAIN = false;
    GAS float* C; int ldc; int nvalid; int accum;
    __device__ __forceinline__ void operator()(const f32x4 (&acc)[2][2][4][2], const Unit& u, int wr, int wc, int fr, int fq) const {
        { const int l_ = pg8_lane_id(); fr = l_ & 15; fq = l_ >> 4; }
#pragma unroll
        for (int ai = 0; ai < 2; ++ai)
#pragma unroll
            for (int m = 0; m < 4; ++m) { const size_t row = (size_t)u.pm * BM + ai * HALF + wr * 64 + m * 16 + fr;
#pragma unroll
                for (int bj = 0; bj < 2; ++bj)
#pragma unroll
                    for (int n = 0; n < 2; ++n) { const int col = u.pn * BM + bj * HALF + wc * 32 + n * 16 + 4 * fq;
                        if (col < nvalid) { GAS float* p = C + row * ldc + col; f32x4 v = acc[ai][bj][m][n]; if (accum) v += *(const GAS f32x4*)p; *(GAS f32x4*)p = v; } } }
    }
};
struct EpiBf16 {
    static constexpr bool PERM = true, AFTER_DRAIN = false;
    GAS bf16_t* O; int ldc; int nvalid; const GAS float* ssq; int np;
    __device__ __forceinline__ void operator()(const f32x4 (&acc)[2][2][4][2], const Unit& u, int wr, int wc, int fr, int fq) const {
        { const int l_ = pg8_lane_id(); fr = l_ & 15; fq = l_ >> 4; }
#pragma unroll
        for (int ai = 0; ai < 2; ++ai)
#pragma unroll
            for (int m = 0; m < 4; ++m) { const size_t row = (size_t)u.pm * BM + ai * HALF + wr * 64 + m * 16 + fr;
                float rs_ = 1.f;
                if (np > 0) { const GAS f32x4* sp = (const GAS f32x4*)(ssq + row * 16); f32x4 t = sp[0] + sp[1]; if (np > 8) t += sp[2] + sp[3]; rs_ = __builtin_amdgcn_rsqf(((t[0] + t[1]) + (t[2] + t[3])) * (1.f / 1024.f) + 1e-6f); }
#pragma unroll
                for (int bj = 0; bj < 2; ++bj) { const int col = u.pn * BM + bj * HALF + wc * 32 + 8 * fq;
                    if (col < nvalid) { const f32x4 v0 = acc[ai][bj][m][0] * rs_, v1 = acc[ai][bj][m][1] * rs_; u32x4 w; w.x = cvt_pk_bf16(v0[0], v0[1]); w.y = cvt_pk_bf16(v0[2], v0[3]); w.z = cvt_pk_bf16(v1[0], v1[1]); w.w = cvt_pk_bf16(v1[2], v1[3]);
                        *(GAS u32x4*)(O + row * ldc + col) = w; } } }
    }
};
struct EpiUp {
    static constexpr bool PERM = true, AFTER_DRAIN = false;
    GAS bf16_t* O; GAS bf16_t* O2; int ldc; int nvalid; const GAS float* rs; int rsi; int mode;
    __device__ __forceinline__ void operator()(const f32x4 (&acc)[2][2][4][2], const Unit& u, int wr, int wc, int fr, int fq) const {
        { const int l_ = pg8_lane_id(); fr = l_ & 15; fq = l_ >> 4; }
#pragma unroll
        for (int ai = 0; ai < 2; ++ai)
#pragma unroll
            for (int m = 0; m < 4; ++m) { const size_t row = (size_t)u.pm * BM + ai * HALF + wr * 64 + m * 16 + fr; const float s = rs[2 * row + rsi];
#pragma unroll
                for (int bj = 0; bj < 2; ++bj) { const int col = u.pn * BM + bj * HALF + wc * 32 + 8 * fq;
                    if (col < nvalid) { const f32x4 v0 = acc[ai][bj][m][0] * s, v1 = acc[ai][bj][m][1] * s; u32x4 w; w.x = cvt_pk_bf16(v0[0], v0[1]); w.y = cvt_pk_bf16(v0[2], v0[3]); w.z = cvt_pk_bf16(v1[0], v1[1]); w.w = cvt_pk_bf16(v1[2], v1[3]);
                        GAS bf16_t* dst;
                        if (mode == 0) dst = O + row * ldc + col;
                        else { const int h = col >> 7, j = col & 127; dst = (j < 64) ? O + row * 384 + h * 96 + j : O2 + row * 256 + h * 64 + (j - 64); }
                        *(GAS u32x4*)dst = w; } } }
    }
};

struct EpiRes {
    static constexpr bool PERM = true, AFTER_DRAIN = false;
    GAS bf16_t* XB; GAS float* SSQ;
    __device__ __forceinline__ void operator()(const f32x4 (&acc)[2][2][4][2], const Unit& u, int wr, int wc, int fr, int fq) const {
        { const int l_ = pg8_lane_id(); fr = l_ & 15; fq = l_ >> 4; }
#pragma unroll
        for (int ai = 0; ai < 2; ++ai)
#pragma unroll
            for (int m = 0; m < 4; ++m) { const size_t row = (size_t)u.pm * BM + ai * HALF + wr * 64 + m * 16 + fr; float ss = 0.f;
#pragma unroll
                for (int bj = 0; bj < 2; ++bj) { GAS u32x4* p = (GAS u32x4*)(XB + row * 1024 + u.pn * BM + bj * HALF + wc * 32 + 8 * fq);
                    const u32x4 o = *p; const f32x4 v0 = acc[ai][bj][m][0], v1 = acc[ai][bj][m][1];
                    u32x4 w;
                    w.x = cvt_pk_bf16(__builtin_bit_cast(float, o.x << 16) + v0[0], __builtin_bit_cast(float, o.x & 0xffff0000u) + v0[1]);
                    w.y = cvt_pk_bf16(__builtin_bit_cast(float, o.y << 16) + v0[2], __builtin_bit_cast(float, o.y & 0xffff0000u) + v0[3]);
                    w.z = cvt_pk_bf16(__builtin_bit_cast(float, o.z << 16) + v1[0], __builtin_bit_cast(float, o.z & 0xffff0000u) + v1[1]);
                    w.w = cvt_pk_bf16(__builtin_bit_cast(float, o.w << 16) + v1[2], __builtin_bit_cast(float, o.w & 0xffff0000u) + v1[3]);
                    *p = w;
#pragma unroll
                    for (int e = 0; e < 4; ++e) { const float a = __builtin_bit_cast(float, w[e] << 16), b = __builtin_bit_cast(float, w[e] & 0xffff0000u); ss += a * a + b * b; } }
                { float a = ss, b = ss; asm volatile("v_nop\n\tv_nop\n\tv_permlane16_swap_b32 %0, %1" : "+v"(a), "+v"(b)); ss = a + b; }
                { float a = ss, b = ss; asm volatile("v_nop\n\tv_nop\n\tv_permlane32_swap_b32 %0, %1" : "+v"(a), "+v"(b)); ss = a + b; }
                if (fq == 0) SSQ[row * 16 + 4 * u.pn + wc] = ss; }
    }
};
template <class Epi, class Sched, bool ALIGN_EPI = false, bool SP2 = false>
__device__ __forceinline__ void gemm_phase(PG8_LAS unsigned char* lds, const Gemm g, const Sched& S, const Epi& E, int wave_id) {
    int tid_ = (wave_id << 6) | pg8_lane_id(); asm volatile("" : "+v"(tid_));
    const int tid = tid_, wid = __builtin_amdgcn_readfirstlane(tid >> 6), lane = tid & 63, wr = wid >> 2, wc = wid & 3, fr = lane & 15, fq = lane >> 4;
    const int K = g.K, nt = K / BK;
    unsigned voffA[2], voffB[2];
#pragma unroll
    for (int i = 0; i < 2; ++i) { int R, C; stage_rc(tid * 16 + i * 8192, R, C); const int Rb = Epi::PERM ? ((R & ~31) + perm32(R & 31)) : R;
        voffA[i] = (unsigned)(R * g.lda + C) * 2u; voffB[i] = (unsigned)(Rb * g.ldb + C) * 2u; }
    const size_t kstep = (size_t)(BK * 2);
    const size_t hstepA = (size_t)HALF * g.lda * 2, hstepB = (size_t)HALF * g.ldb * 2;
    const size_t tstepA = 2 * hstepA, tstepB = 2 * hstepB;
    const unsigned ldsw = (unsigned)wid * 1024u;
    const int aoff = lds_byte(wr * 64 + fr, fq * 8), boff = lds_byte(wc * 32 + fr, fq * 8);
#define PG8_SA(b, h) (((b) * 2 + (h)) * HTB)
#define PG8_SB(b, h) ((4 + (b) * 2 + (h)) * HTB)
#define PG8_STAGE(bufoff, gbase, voff) do { _Pragma("unroll") for (int _i = 0; _i < 2; ++_i) \
        __builtin_amdgcn_global_load_lds((const unsigned*)((const char*)(gbase) + (voff)[_i]), (PG8_LAS unsigned*)(lds + (bufoff) + ldsw + _i * 8192), 16, 0, 0); } while (0)
#define PG8_LDA(dst, b, h) do { _Pragma("unroll") for (int m = 0; m < 4; ++m) _Pragma("unroll") for (int k = 0; k < 2; ++k) dst[m][k] = *(const PG8_LAS bf16x8*)(lds + PG8_SA(b, h) + aoff + m * 2048 + k * 1024); } while (0)
#define PG8_LDB(dst, b, h) do { _Pragma("unroll") for (int n = 0; n < 2; ++n) _Pragma("unroll") for (int k = 0; k < 2; ++k) dst[n][k] = *(const PG8_LAS bf16x8*)(lds + PG8_SB(b, h) + boff + n * 2048 + k * 1024); } while (0)
#define PG8_MMA(ai, bj, At, Bt) do { __builtin_amdgcn_s_setprio(1); _Pragma("unroll") for (int m = 0; m < 4; ++m) _Pragma("unroll") for (int n = 0; n < 2; ++n) _Pragma("unroll") for (int k = 0; k < 2; ++k) \
        acc[ai][bj][m][n] = __builtin_amdgcn_mfma_f32_16x16x32_bf16(Bt[n][k], At[m][k], acc[ai][bj][m][n], 0, 0, 0); __builtin_amdgcn_s_setprio(0); } while (0)
#define PG8_WAIT_V(n) asm volatile("s_waitcnt vmcnt(" #n ")" ::: "memory")
#define PG8_WAIT_L(n) asm volatile("s_waitcnt lgkmcnt(" #n ")" ::: "memory")
#define PG8_BAR __builtin_amdgcn_s_barrier()
#define PG8_SCHED __builtin_amdgcn_sched_barrier(0)
    Unit cur, nxt; int ui = 0;
    if (!S.next(0, cur)) return;
    f32x4 acc[2][2][4][2];
#pragma unroll
    for (int a = 0; a < 2; ++a)
#pragma unroll
        for (int b = 0; b < 2; ++b)
#pragma unroll
            for (int m = 0; m < 4; ++m)
#pragma unroll
                for (int n = 0; n < 2; ++n) acc[a][b][m][n] = (f32x4){0.f, 0.f, 0.f, 0.f};
    bf16x8 At[4][2], B0[2][2], B1[2][2];
    const char* cA = (const char*)g.A + (size_t)cur.pm * tstepA; const char* cB = (const char*)g.Bt + (size_t)cur.pn * tstepB;
    S.a_ready(cur);
    if constexpr (SP2) {
        PG8_STAGE(PG8_SB(0, 0), cB, voffB); PG8_STAGE(PG8_SB(0, 1), cB + hstepB, voffB); PG8_STAGE(PG8_SA(0, 0), cA, voffA); PG8_STAGE(PG8_SA(0, 1), cA + hstepA, voffA);
        if (wr == 1) PG8_BAR;
        PG8_WAIT_V(2); PG8_BAR;
        PG8_STAGE(PG8_SB(1, 0), cB + kstep, voffB); PG8_STAGE(PG8_SA(1, 0), cA + kstep, voffA); PG8_STAGE(PG8_SB(1, 1), cB + hstepB + kstep, voffB);
        PG8_WAIT_V(6); PG8_BAR;
    } else {
        PG8_STAGE(PG8_SB(0, 0), cB, voffB); PG8_STAGE(PG8_SA(0, 0), cA, voffA); PG8_STAGE(PG8_SB(0, 1), cB + hstepB, voffB); PG8_STAGE(PG8_SA(0, 1), cA + hstepA, voffA);
        if (wr == 1) PG8_BAR;
        PG8_WAIT_V(4); PG8_BAR;
        PG8_STAGE(PG8_SB(1, 0), cB + kstep, voffB); PG8_STAGE(PG8_SA(1, 0), cA + kstep, voffA); PG8_STAGE(PG8_SB(1, 1), cB + hstepB + kstep, voffB);
        PG8_WAIT_V(6); PG8_BAR;
    }
    for (;;) {
        const bool has_next = S.next(ui + 1, nxt);
        const char* nA = has_next ? (const char*)g.A + (size_t)nxt.pm * tstepA : cA; const char* nB = has_next ? (const char*)g.Bt + (size_t)nxt.pn * tstepB : cB;
        for (int t = 0; t < nt; t += 2) {
            const bool last = (t == nt - 2);
            const char* a1 = cA + (size_t)(t + 1) * kstep;
            const char* a2 = last ? nA : cA + (size_t)(t + 2) * kstep; const char* b2 = last ? nB : cB + (size_t)(t + 2) * kstep;
            const char* a3 = a2 + kstep; const char* b3 = b2 + kstep;
            if (last && has_next) S.a_ready(nxt);
            if constexpr (SP2) {
            PG8_LDB(B0, 0, 0); PG8_LDB(B1, 0, 1); PG8_SCHED; PG8_LDA(At, 0, 0); PG8_STAGE(PG8_SA(1, 1), a1 + hstepA, voffA);
            PG8_WAIT_V(8); PG8_WAIT_L(0); PG8_BAR; PG8_MMA(0, 0, At, B0); PG8_MMA(0, 1, At, B1); PG8_BAR; PG8_SCHED;
            PG8_LDA(At, 0, 1); PG8_STAGE(PG8_SB(0, 0), b2, voffB); PG8_STAGE(PG8_SB(0, 1), b2 + hstepB, voffB); PG8_STAGE(PG8_SA(0, 0), a2, voffA);
            PG8_WAIT_V(8); PG8_WAIT_L(0); PG8_BAR; PG8_MMA(1, 0, At, B0); PG8_MMA(1, 1, At, B1); PG8_BAR; PG8_SCHED;
            PG8_LDB(B0, 1, 0); PG8_LDB(B1, 1, 1); PG8_SCHED; PG8_LDA(At, 1, 0); PG8_STAGE(PG8_SA(0, 1), a2 + hstepA, voffA);
            PG8_WAIT_V(8); PG8_WAIT_L(0); PG8_BAR; PG8_MMA(0, 0, At, B0); PG8_MMA(0, 1, At, B1); PG8_BAR; PG8_SCHED;
            PG8_LDA(At, 1, 1); PG8_STAGE(PG8_SB(1, 0), b3, voffB); PG8_STAGE(PG8_SB(1, 1), b3 + hstepB, voffB); PG8_STAGE(PG8_SA(1, 0), a3, voffA);
            PG8_WAIT_V(8); PG8_WAIT_L(0); PG8_BAR; PG8_MMA(1, 0, At, B0); PG8_MMA(1, 1, At, B1); PG8_BAR; PG8_SCHED;
            } else {
            PG8_LDB(B0, 0, 0); PG8_SCHED; PG8_LDA(At, 0, 0); PG8_STAGE(PG8_SA(1, 1), a1 + hstepA, voffA);
            PG8_WAIT_L(8); PG8_BAR; PG8_WAIT_L(0); PG8_MMA(0, 0, At, B0); PG8_BAR; PG8_SCHED;
            PG8_LDB(B1, 0, 1); PG8_STAGE(PG8_SB(0, 0), b2, voffB);
            PG8_BAR; PG8_WAIT_L(0); PG8_MMA(0, 1, At, B1); PG8_BAR;
            PG8_LDA(At, 0, 1); PG8_STAGE(PG8_SA(0, 0), a2, voffA);
            PG8_BAR; PG8_WAIT_L(0); PG8_MMA(1, 0, At, B0); PG8_BAR; PG8_SCHED;
            PG8_STAGE(PG8_SB(0, 1), b2 + hstepB, voffB);
            PG8_WAIT_V(6); PG8_BAR; PG8_MMA(1, 1, At, B1); PG8_BAR;
            PG8_LDB(B0, 1, 0); PG8_SCHED; PG8_LDA(At, 1, 0); PG8_STAGE(PG8_SA(0, 1), a2 + hstepA, voffA);
            PG8_WAIT_L(8); PG8_BAR; PG8_WAIT_L(0); PG8_MMA(0, 0, At, B0); PG8_BAR; PG8_SCHED;
            PG8_LDB(B1, 1, 1); PG8_STAGE(PG8_SB(1, 0), b3, voffB);
            PG8_BAR; PG8_WAIT_L(0); PG8_MMA(0, 1, At, B1); PG8_BAR;
            PG8_LDA(At, 1, 1); PG8_STAGE(PG8_SA(1, 0), a3, voffA);
            PG8_BAR; PG8_WAIT_L(0); PG8_MMA(1, 0, At, B0); PG8_BAR; PG8_SCHED;
            PG8_STAGE(PG8_SB(1, 1), b3 + hstepB, voffB);
            PG8_WAIT_V(6); PG8_BAR; PG8_MMA(1, 1, At, B1); PG8_BAR;
            }
        }
        if constexpr (ALIGN_EPI) { if (wr == 0) PG8_BAR; }
        if constexpr (!Epi::AFTER_DRAIN) { E(acc, cur, wr, wc, fr, fq); S.done(cur); }
        if (!has_next) break;
#pragma unroll
        for (int a = 0; a < 2; ++a)
#pragma unroll
            for (int b = 0; b < 2; ++b)
#pragma unroll
                for (int m = 0; m < 4; ++m)
#pragma unroll
                    for (int n = 0; n < 2; ++n) acc[a][b][m][n] = (f32x4){0.f, 0.f, 0.f, 0.f};
        cur = nxt; cA = nA; cB = nB; ++ui;
        if constexpr (ALIGN_EPI) { if (wr == 1) PG8_BAR; }
    }
    PG8_WAIT_V(0);
    if constexpr (!ALIGN_EPI) { if (wr == 0) PG8_BAR; }
    PG8_BAR;
    if constexpr (Epi::AFTER_DRAIN) { E.fused(acc, cur, wr, wc, fr, fq, lds, wid, lane); S.done(cur); }
#undef PG8_SA
#undef PG8_SB
#undef PG8_STAGE
#undef PG8_LDA
#undef PG8_LDB
#undef PG8_MMA
#undef PG8_WAIT_V
#undef PG8_WAIT_L
#undef PG8_BAR
#undef PG8_SCHED
}
}

namespace mk {
#ifndef GAS
#define GAS __attribute__((address_space(1)))
#endif
#define LAS __attribute__((address_space(3)))
typedef unsigned short bf16;
typedef unsigned v4u __attribute__((ext_vector_type(4)));
typedef unsigned v2u __attribute__((ext_vector_type(2)));
typedef float f32x4 __attribute__((ext_vector_type(4)));
typedef GAS unsigned gu32;
#define LDS_WAIT() asm volatile("s_waitcnt lgkmcnt(0)" ::: "memory")
#define VM_WAIT() asm volatile("s_waitcnt vmcnt(0)" ::: "memory")
__device__ __forceinline__ unsigned f2bf_(float f) { unsigned u = __builtin_bit_cast(unsigned, f); return (u + 0x7fffu + ((u >> 16) & 1u)) >> 16; }
__device__ __forceinline__ unsigned pk2(float lo, float hi) { return f2bf_(lo) | (f2bf_(hi) << 16); }
__device__ __forceinline__ float bflo(unsigned w) { return __builtin_bit_cast(float, w << 16); }
__device__ __forceinline__ float bfhi(unsigned w) { return __builtin_bit_cast(float, w & 0xffff0000u); }

template <class P> __device__ __forceinline__ P* opq(P* p) { asm volatile("" : "+s"(p)); return p; }
__device__ __forceinline__ int opqi(int k) { asm volatile("" : "+s"(k)); return k; }
__device__ __forceinline__ float shx(float v, int o, int lane) { return __builtin_bit_cast(float, __builtin_amdgcn_ds_bpermute((lane ^ o) << 2, __builtin_bit_cast(int, v))); }
__device__ __forceinline__ int shxi(int v, int o, int lane) { return __builtin_amdgcn_ds_bpermute((lane ^ o) << 2, v); }
__device__ __forceinline__ int lane_id_v() { int l; asm volatile("v_mbcnt_lo_u32_b32 %0, -1, 0\n\tv_mbcnt_hi_u32_b32 %0, -1, %0" : "=v"(l)); return l; }
constexpr int NWAVES = 8;
constexpr int D = 1024, NB = 4, S = 8192, T = NB * S, L = 4, MEM = 256, INW = 2144, INP = 2304;
constexpr int PC_CQ = 0, PC_CKV = 256, PC_KR = 384, PC_XL = 512, PC_GL = 1024, PC_QD = 1536, PC_KD = 1792, PC_VD = 2048;
constexpr float LOG2E = 1.4426950408889634f;
constexpr size_t MiB = 1u << 20;
constexpr size_t WS_CTL = 0, CTL_ZERO_BYTES = 1 * MiB;
constexpr size_t WS_WIN = 1 * MiB, WS_WOUT = 19 * MiB, WS_WCQ = 27 * MiB, WS_WCO = 35 * MiB, WS_WPQ = 43 * MiB, WS_WCKV = 51 * MiB, WS_WUQ = 67 * MiB, WS_WUKV = 68 * MiB, WS_KEYS = 69 * MiB, WS_ROPE = 70 * MiB;
constexpr size_t WS_XNB = 76 * MiB, WS_YB = 140 * MiB, WS_PROJB = 204 * MiB, WS_QMB = 348 * MiB, WS_KMB = 372 * MiB, WS_VMB = 396 * MiB, WS_RS = 412 * MiB;
constexpr size_t WS_HLB = 413 * MiB, WS_ACB = 445 * MiB, WS_LSUM = 477 * MiB, WS_OMB = 478 * MiB, WS_MNB = 494 * MiB, WS_KVCB = 502 * MiB, WS_EX = 518 * MiB, WS_GW = 534 * MiB;
constexpr size_t WS_U8 = 550 * MiB, WS_V8 = 614 * MiB, WS_SU = 678 * MiB, WS_SV = 679 * MiB;
constexpr size_t WS_HQ = 680 * MiB, WS_P = 712 * MiB, WS_SH = 728 * MiB, WS_W = 729 * MiB, WS_WS = 745 * MiB, WS_SSQ = 746 * MiB, WS_END = 748 * MiB;
constexpr size_t WS_WAT = 74 * MiB;
constexpr size_t WS_BTAB = WS_KEYS + 512 * 1024, WS_LAMS = WS_BTAB + 4096, WS_SP = WS_LAMS + 4096;
constexpr int CW_BAR = 4096, CW_RANK = 8192;
constexpr int RING_OFF = 0, RING_BYTES = 155648, LDSCTL_OFF = RING_BYTES, MISC_OFF = LDSCTL_OFF + 320, LDS_BYTES = 163840;

#define XB_TMO      128
#define XB_XCNT(j)  (256  + 64 * (j))
#define XB_XSUB(j)  (1280 + 64 * (j))
#define XB_XGEN(j)  (2304 + 64 * (j))
#define XB_TOP      3328
#define XB_TOPGEN   3392
#define XCD_BAR_WORDS 3456
#define XB_SPIN_CAP (1u << 18)

__device__ __forceinline__ unsigned xb_ld(unsigned* p)              { return __hip_atomic_load(p, __ATOMIC_RELAXED, __HIP_MEMORY_SCOPE_AGENT); }
__device__ __forceinline__ unsigned xb_add(unsigned* p, unsigned v) { return __hip_atomic_fetch_add(p, v, __ATOMIC_RELAXED, __HIP_MEMORY_SCOPE_AGENT); }
__device__ __forceinline__ unsigned xb_xcc_id() { return (unsigned)__builtin_amdgcn_s_getreg((3 << 11) | 20) & 0xFu; }
#define XB_SPIN(cond, bar) do { unsigned _sp = 0; while (cond) { __builtin_amdgcn_s_sleep(1); \
    if ((++_sp & 255u) == 0u) { if (xb_ld(&(bar)[XB_TMO])) break; if (_sp > XB_SPIN_CAP) { atomicAdd(&(bar)[XB_TMO], 1u); break; } } } } while (0)

struct XcdBarrier {
    unsigned* bar; unsigned x;
    volatile LAS unsigned* st;
};

__device__ __forceinline__ XcdBarrier xcd_barrier_post(unsigned* bar, volatile LAS unsigned* st) {
    XcdBarrier b; b.bar = bar; b.x = xb_xcc_id(); b.st = st;
    if (threadIdx.x == 0) (void)xb_add(&bar[XB_XCNT(b.x)], 1u);
    return b;
}
__device__ __forceinline__ void xcd_barrier_complete(unsigned* bar, unsigned x, unsigned& nloc, unsigned& nx) {
    const unsigned G = gridDim.x * gridDim.y * gridDim.z;
    unsigned sum, cnt, mine, sp = 0u;
    for (;;) {
        sum = 0u; cnt = 0u; mine = 0u;
#pragma unroll
        for (unsigned j = 0; j < 16; ++j) { const unsigned c = xb_ld(&bar[XB_XCNT(j)]); sum += c; cnt += (c > 0u) ? 1u : 0u; mine = (j == x) ? c : mine; }
        if (sum == G) break;
        __builtin_amdgcn_s_sleep(1);
        if ((++sp & 255u) == 0u) { if (xb_ld(&bar[XB_TMO])) break; if (sp > XB_SPIN_CAP) { atomicAdd(&bar[XB_TMO], 1u); break; } }
    }
    nloc = mine > 0u ? mine : 1u; nx = cnt > 0u ? cnt : 1u;
}

__device__ __noinline__ void xcd_barrier_impl(unsigned* bar_, unsigned x_, volatile LAS unsigned* st_, int leader_) {
    XcdBarrier b; b.bar = bar_; b.x = x_; b.st = st_;
    asm volatile("s_waitcnt vmcnt(0)" ::: "memory");
    __syncthreads();
    if (leader_) {
        unsigned* bar = b.bar;
        __builtin_amdgcn_s_waitcnt(0);
        unsigned nloc = b.st[0], nx = b.st[1];
        if (nloc == 0u) { xcd_barrier_complete(bar, b.x, nloc, nx); b.st[0] = nloc; b.st[1] = nx; }
        const unsigned old = xb_add(&bar[XB_XSUB(b.x)], 1u);
        const unsigned gen = old / nloc;
        if (old + 1u == (gen + 1u) * nloc) {
            __builtin_amdgcn_fence(__ATOMIC_RELEASE, "agent");
            asm volatile("s_waitcnt vmcnt(0)" ::: "memory");
            const unsigned og = xb_add(&bar[XB_TOP], 1u);
            const unsigned tg = og / nx;
            if (og + 1u == (tg + 1u) * nx) xb_add(&bar[XB_TOPGEN], 1u);
            else XB_SPIN(xb_ld(&bar[XB_TOPGEN]) == tg, bar);
            __builtin_amdgcn_fence(__ATOMIC_ACQUIRE, "agent");
            xb_add(&bar[XB_XGEN(b.x)], 1u);
            asm volatile("s_waitcnt vmcnt(0)" ::: "memory");
        } else {
            XB_SPIN(xb_ld(&bar[XB_XGEN(b.x)]) == gen, bar);
            __builtin_amdgcn_fence(__ATOMIC_ACQUIRE, "agent");
            asm volatile("s_waitcnt vmcnt(0)" ::: "memory");
        }
    }
    __syncthreads();
}
__device__ __forceinline__ void xcd_barrier(const XcdBarrier& b, int leader) { xcd_barrier_impl(b.bar, b.x, b.st, leader); }


__device__ __forceinline__ float wave_sum(float v, int lane) {
    (void)lane;
    v += __builtin_bit_cast(float, __builtin_amdgcn_update_dpp(0, __builtin_bit_cast(int, v), 0xB1, 0xF, 0xF, true));
    v += __builtin_bit_cast(float, __builtin_amdgcn_update_dpp(0, __builtin_bit_cast(int, v), 0x4E, 0xF, 0xF, true));
    v += __builtin_bit_cast(float, __builtin_amdgcn_update_dpp(0, __builtin_bit_cast(int, v), 0x141, 0xF, 0xF, true));
    v += __builtin_bit_cast(float, __builtin_amdgcn_update_dpp(0, __builtin_bit_cast(int, v), 0x140, 0xF, 0xF, true));
    { float a = v, b = v; asm volatile("v_nop\n\tv_nop\n\tv_permlane16_swap_b32 %0, %1" : "+v"(a), "+v"(b)); v = a + b; }
    { float a = v, b = v; asm volatile("v_nop\n\tv_nop\n\tv_permlane32_swap_b32 %0, %1" : "+v"(a), "+v"(b)); v = a + b; }
    return v;
}
__device__ __forceinline__ float wave_max(float v) {
    v = fmaxf(v, __builtin_bit_cast(float, __builtin_amdgcn_update_dpp(0, __builtin_bit_cast(int, v), 0xB1, 0xF, 0xF, true)));
    v = fmaxf(v, __builtin_bit_cast(float, __builtin_amdgcn_update_dpp(0, __builtin_bit_cast(int, v), 0x4E, 0xF, 0xF, true)));
    v = fmaxf(v, __builtin_bit_cast(float, __builtin_amdgcn_update_dpp(0, __builtin_bit_cast(int, v), 0x141, 0xF, 0xF, true)));
    v = fmaxf(v, __builtin_bit_cast(float, __builtin_amdgcn_update_dpp(0, __builtin_bit_cast(int, v), 0x140, 0xF, 0xF, true)));
    { float a = v, b = v; asm volatile("v_nop\n\tv_nop\n\tv_permlane16_swap_b32 %0, %1" : "+v"(a), "+v"(b)); v = fmaxf(a, b); }
    { float a = v, b = v; asm volatile("v_nop\n\tv_nop\n\tv_permlane32_swap_b32 %0, %1" : "+v"(a), "+v"(b)); v = fmaxf(a, b); }
    return v;
}
__device__ __forceinline__ float gelu_erf(float v) {
    const float av = __builtin_fabsf(v), t = __builtin_amdgcn_rcpf(av * 0.2316418882f + 1.0f);
    float q = t * 0.5307027145f + (-0.7265760135f); q = q * t + 0.7107068705f; q = q * t + (-0.142248368f); q = q * t + 0.127414796f; q = q * t;
    const float e = __builtin_amdgcn_exp2f((v * v) * (-0.72134752044f));
    const float m = v * (q * e);
    return v < 0.f ? m : v - m;
}

__device__ __forceinline__ void norm_phase(const GAS float* X, const GAS float* g, GAS bf16* out, int rows, int gw, int NGW, int lane) {
    asm volatile("" : "+v"(lane));
    f32x4 gv[4];
#pragma unroll
    for (int j = 0; j < 4; ++j) gv[j] = ((const GAS f32x4*)g)[lane + 64 * j];
    for (int m = gw; m < rows; m += NGW) {
        const GAS f32x4* xr = (const GAS f32x4*)(X + (size_t)m * D) + lane;
        f32x4 v[4]; float s = 0.f;
#pragma unroll
        for (int j = 0; j < 4; ++j) { v[j] = xr[64 * j]; s += (v[j].x * v[j].x + v[j].y * v[j].y) + (v[j].z * v[j].z + v[j].w * v[j].w); }
        const float rs = rsqrtf(wave_sum(s, lane) * (1.f / D) + 1e-6f);
        GAS v2u* o8 = (GAS v2u*)(out + (size_t)m * D) + lane;
#pragma unroll
        for (int j = 0; j < 4; ++j) { v2u w; w.x = pk2(v[j].x * rs * gv[j].x, v[j].y * rs * gv[j].y); w.y = pk2(v[j].z * rs * gv[j].z, v[j].w * rs * gv[j].w); o8[64 * j] = w; }
    }
}
__device__ __forceinline__ void hq_phase(const GAS bf16* XB, const GAS float* SSQ, const GAS float* g, GAS unsigned char* HQ, GAS float* SH, GAS int* Pz, int gw, int NGW, int lane) {
    asm volatile("" : "+v"(lane));
    const GAS f32x4* gp = (const GAS f32x4*)g + 4 * lane; const f32x4 g0 = gp[0], g1 = gp[1], g2 = gp[2], g3 = gp[3];
    for (int m = gw; m < T; m += NGW) {
        const GAS f32x4* sp = (const GAS f32x4*)(SSQ + (size_t)m * 16); const f32x4 t = (sp[0] + sp[1]) + (sp[2] + sp[3]);
        const float rs = __builtin_amdgcn_rsqf(((t[0] + t[1]) + (t[2] + t[3])) * (1.f / 1024.f) + 1e-6f);
        const v4u a = *(const GAS v4u*)(XB + (size_t)m * D + 16 * lane), b = *(const GAS v4u*)(XB + (size_t)m * D + 16 * lane + 8);
        float f[16] = {bflo(a.x) * g0[0], bfhi(a.x) * g0[1], bflo(a.y) * g0[2], bfhi(a.y) * g0[3], bflo(a.z) * g1[0], bfhi(a.z) * g1[1], bflo(a.w) * g1[2], bfhi(a.w) * g1[3],
                       bflo(b.x) * g2[0], bfhi(b.x) * g2[1], bflo(b.y) * g2[2], bfhi(b.y) * g2[3], bflo(b.z) * g3[0], bfhi(b.z) * g3[1], bflo(b.w) * g3[2], bfhi(b.w) * g3[3]};
        float mx = 0.f;
#pragma unroll
        for (int i = 0; i < 16; ++i) { f[i] *= rs; mx = fmaxf(mx, __builtin_fabsf(f[i])); }
        mx = wave_max(mx);
        const float inv = mx > 0.f ? 127.f / mx : 0.f;
        v4u q;
#pragma unroll
        for (int i = 0; i < 4; ++i) { const int ia = (int)__builtin_rintf(f[4 * i] * inv), ib = (int)__builtin_rintf(f[4 * i + 1] * inv), ic = (int)__builtin_rintf(f[4 * i + 2] * inv), id = (int)__builtin_rintf(f[4 * i + 3] * inv);
            q[i] = (unsigned)(ia & 255) | ((unsigned)(ib & 255) << 8) | ((unsigned)(ic & 255) << 16) | ((unsigned)(id & 255) << 24); }
        *(GAS v4u*)(HQ + (size_t)m * D + 16 * lane) = q;
        if (lane == 0) SH[m] = mx * (1.f / 127.f);
    }
}
__device__ __forceinline__ void x0_phase(const GAS float* X, GAS bf16* XB, GAS float* SSQ, int gw, int NGW, int lane) {
    asm volatile("" : "+v"(lane));
    for (int m = gw; m < T; m += NGW) {
        const GAS f32x4* xr = (const GAS f32x4*)(X + (size_t)m * D) + lane; GAS v2u* o8 = (GAS v2u*)(XB + (size_t)m * D) + lane;
        float s = 0.f;
#pragma unroll
        for (int j = 0; j < 4; ++j) { const f32x4 v = xr[64 * j]; s += (v.x * v.x + v.y * v.y) + (v.z * v.z + v.w * v.w); v2u w; w.x = pk2(v.x, v.y); w.y = pk2(v.z, v.w); o8[64 * j] = w; }
        s = wave_sum(s, lane);
        if (lane < 8) SSQ[(size_t)m * 16 + lane] = lane == 0 ? s : 0.f;
    }
}
__device__ __forceinline__ void final_norm_phase(const GAS bf16* XB, GAS float* O, const GAS float* g, int rows, int gw, int NGW, int lane) {
    asm volatile("" : "+v"(lane));
    for (int m = gw; m < rows; m += NGW) {
        const GAS v4u* xr = (const GAS v4u*)(XB + (size_t)m * D) + lane;
        v4u v[2]; float s = 0.f;
#pragma unroll
        for (int j = 0; j < 2; ++j) { v[j] = xr[64 * j];
#pragma unroll
            for (int e = 0; e < 4; ++e) { const float a = bflo(v[j][e]), b = bfhi(v[j][e]); s += a * a + b * b; } }
        const float rs = rsqrtf(wave_sum(s, lane) * (1.f / D) + 1e-6f);
#pragma unroll
        for (int j = 0; j < 2; ++j) { const int c = 8 * (lane + 64 * j); const f32x4 g0 = *(const GAS f32x4*)(g + c), g1 = *(const GAS f32x4*)(g + c + 4);
            f32x4 o0, o1; o0.x = bflo(v[j].x) * rs * g0.x; o0.y = bfhi(v[j].x) * rs * g0.y; o0.z = bflo(v[j].y) * rs * g0.z; o0.w = bfhi(v[j].y) * rs * g0.w;
            o1.x = bflo(v[j].z) * rs * g1.x; o1.y = bfhi(v[j].z) * rs * g1.y; o1.z = bflo(v[j].w) * rs * g1.z; o1.w = bfhi(v[j].w) * rs * g1.w;
            *(GAS f32x4*)(O + (size_t)m * D + c) = o0; *(GAS f32x4*)(O + (size_t)m * D + c + 4) = o1; }
    }
}

__device__ __forceinline__ float row16_sum(float v) {
    v += __builtin_bit_cast(float, __builtin_amdgcn_update_dpp(0, __builtin_bit_cast(int, v), 0xB1, 0xF, 0xF, true));
    v += __builtin_bit_cast(float, __builtin_amdgcn_update_dpp(0, __builtin_bit_cast(int, v), 0x4E, 0xF, 0xF, true));
    v += __builtin_bit_cast(float, __builtin_amdgcn_update_dpp(0, __builtin_bit_cast(int, v), 0x141, 0xF, 0xF, true));
    v += __builtin_bit_cast(float, __builtin_amdgcn_update_dpp(0, __builtin_bit_cast(int, v), 0x140, 0xF, 0xF, true));
    return v;
}
__device__ __forceinline__ float sq8(const v4u w) { const float a0 = bflo(w.x), a1 = bfhi(w.x), a2 = bflo(w.y), a3 = bfhi(w.y), a4 = bflo(w.z), a5 = bfhi(w.z), a6 = bflo(w.w), a7 = bfhi(w.w);
    return (a0 * a0 + a1 * a1) + (a2 * a2 + a3 * a3) + (a4 * a4 + a5 * a5) + (a6 * a6 + a7 * a7); }
__device__ __forceinline__ void pre_phase(const GAS bf16* PROJB, const GAS float* ROPE, GAS float* RS, GAS bf16* KMB, int gw, int NGW, int lane) {
    asm volatile("" : "+v"(lane));
    const int q = lane >> 4, sub = lane & 15;
    for (int t0 = gw * 4; t0 < T; t0 += NGW * 4) {
        const size_t t = (size_t)t0 + q;
        const GAS bf16* pr = PROJB + t * INP;
        const v4u w0 = *(const GAS v4u*)(pr + PC_CQ + 8 * sub), w1 = *(const GAS v4u*)(pr + PC_CQ + 8 * (16 + (sub & 7))), w2 = *(const GAS v4u*)(pr + PC_CKV + 8 * sub);
        const float x1 = __builtin_bit_cast(float, (unsigned)pr[PC_KR + sub] << 16), x2 = __builtin_bit_cast(float, (unsigned)pr[PC_KR + 16 + sub] << 16);
        const float c = ROPE[t * 32 + sub], sn = ROPE[t * 32 + 16 + sub];
        const float sq = row16_sum(sq8(w0) + (sub < 8 ? sq8(w1) : 0.f)), skv = row16_sum(sq8(w2));
        if (sub == 0) { RS[2 * t] = rsqrtf(sq * (1.f / 192.f) + 1e-6f); RS[2 * t + 1] = rsqrtf(skv * (1.f / 128.f) + 1e-6f); }
        const bf16 y1 = (bf16)f2bf_(x1 * c - x2 * sn), y2 = (bf16)f2bf_(x1 * sn + x2 * c);
        GAS bf16* kr = KMB + t * 384 + 64 + sub;
#pragma unroll
        for (int h = 0; h < 4; ++h) { kr[h * 96] = y1; kr[h * 96 + 16] = y2; }
    }
}

typedef short lr_bf16x8 __attribute__((ext_vector_type(8)));
typedef float lr_f32x16 __attribute__((ext_vector_type(16)));
__device__ __forceinline__ void lr_swap32(float& a, float& b) { asm volatile("v_nop\n\tv_nop\n\tv_permlane32_swap_b32 %0, %1" : "+v"(a), "+v"(b)); }
constexpr int LR_XR = 0, LR_CW = LR_XR + 37376, LR_XA = LR_CW + 1280, LR_WT = LR_XA + 256 * 144, LR_SUM = LR_WT + 2 * 64 * 144, LR_END = LR_SUM + 4096;
struct LruP { const GAS bf16* PROJB; const GAS float* cw; const GAS float* cb; const GAS bf16* wat; const GAS float* ba; const GAS float* bx; const GAS float* sp; GAS unsigned* HA; GAS float* LSUM; };
__device__ __forceinline__ void lru_phase(const LruP& P, LAS unsigned char* lds, int tid, int wave, int lane, int vcu, int G) {
    asm volatile("" : "+v"(tid), "+v"(lane));
    LAS float* SUM = (LAS float*)(lds + LR_SUM);
    for (int u = vcu; u < (T / 256) * 8; u += G) {
        const int tile = u >> 3, g = u & 7; const int t0 = tile * 256; const bool first = ((tile & 31) == 0);
        __syncthreads();
        float ba_[2], bx_[2], sp_[2];
#pragma unroll
        for (int nt = 0; nt < 2; ++nt) { const int ch = 64 * g + 32 * nt + (lane & 31); ba_[nt] = P.ba[ch]; bx_[nt] = P.bx[ch]; sp_[nt] = P.sp[ch]; }
        { v4u wt_[2], xr_[5];
#pragma unroll
          for (int i = 0; i < 2; ++i) { const int idx = tid + 512 * i; wt_[i] = ((const GAS v4u*)(P.wat + (size_t)g * 2 * 4096))[idx]; }
#pragma unroll
          for (int i = 0; i < 5; ++i) { const int idx = tid + 512 * i, row = idx >> 3, part = idx & 7; const bool ok = (idx < 259 * 8) && !(first && row < 3);
              const int trow = ok ? t0 - 3 + row : t0;
              xr_[i] = *(const GAS v4u*)(P.PROJB + (size_t)trow * INP + PC_XL + 64 * g + 8 * part); if (!ok) xr_[i] = v4u{0u, 0u, 0u, 0u}; }
          float cwv = 0.f; if (tid < 320) cwv = (tid < 256) ? P.cw[(tid >> 6) * 512 + 64 * g + (tid & 63)] : P.cb[64 * g + (tid - 256)];
#pragma unroll
          for (int i = 0; i < 2; ++i) { const int idx = tid + 512 * i; *(LAS v4u*)(lds + LR_WT + (idx >> 9) * 9216 + ((idx >> 3) & 63) * 144 + (idx & 7) * 16) = wt_[i]; }
#pragma unroll
          for (int i = 0; i < 5; ++i) { const int idx = tid + 512 * i, row = idx >> 3, part = idx & 7; if (idx < 259 * 8) *(LAS v4u*)(lds + LR_XR + row * 144 + 16 * part) = xr_[i]; }
          if (tid < 320) ((LAS float*)(lds + LR_CW))[tid] = cwv; }
        __syncthreads();
        { float cwr[4][8], cbr[8];
#pragma unroll
          for (int k = 0; k < 4; ++k) { const f32x4 c0 = *(const LAS f32x4*)(lds + LR_CW + (k * 64 + 8 * wave) * 4), c1 = *(const LAS f32x4*)(lds + LR_CW + (k * 64 + 8 * wave + 4) * 4);
              cwr[k][0] = c0.x; cwr[k][1] = c0.y; cwr[k][2] = c0.z; cwr[k][3] = c0.w; cwr[k][4] = c1.x; cwr[k][5] = c1.y; cwr[k][6] = c1.z; cwr[k][7] = c1.w; }
          { const f32x4 c0 = *(const LAS f32x4*)(lds + LR_CW + (256 + 8 * wave) * 4), c1 = *(const LAS f32x4*)(lds + LR_CW + (256 + 8 * wave + 4) * 4);
            cbr[0] = c0.x; cbr[1] = c0.y; cbr[2] = c0.z; cbr[3] = c0.w; cbr[4] = c1.x; cbr[5] = c1.y; cbr[6] = c1.z; cbr[7] = c1.w; }
#pragma unroll
          for (int it_ = 0; it_ < 4; ++it_) { const int time = lane + 64 * it_;
              float y[8];
#pragma unroll
              for (int e = 0; e < 8; ++e) y[e] = cbr[e];
#pragma unroll
              for (int k = 0; k < 4; ++k) { const v4u w = *(const LAS v4u*)(lds + LR_XR + (time + k) * 144 + 16 * wave);
                  y[0] += bflo(w.x) * cwr[k][0]; y[1] += bfhi(w.x) * cwr[k][1]; y[2] += bflo(w.y) * cwr[k][2]; y[3] += bfhi(w.y) * cwr[k][3];
                  y[4] += bflo(w.z) * cwr[k][4]; y[5] += bfhi(w.z) * cwr[k][5]; y[6] += bflo(w.w) * cwr[k][6]; y[7] += bfhi(w.w) * cwr[k][7]; }
              v4u o; o.x = pk2(y[0], y[1]); o.y = pk2(y[2], y[3]); o.z = pk2(y[4], y[5]); o.w = pk2(y[6], y[7]);
              *(LAS v4u*)(lds + LR_XA + time * 144 + 16 * wave) = o; } }
        __syncthreads();
        const int r32 = lane & 31, hi = lane >> 5;
        lr_f32x16 acc[2][2];
#pragma unroll
        for (int nt = 0; nt < 2; ++nt) { const float b_a = ba_[nt], b_x = bx_[nt];
#pragma unroll
            for (int r = 0; r < 16; ++r) { acc[0][nt][r] = b_a; acc[1][nt][r] = b_x; } }
        { lr_bf16x8 af[4];
#pragma unroll
          for (int s_ = 0; s_ < 4; ++s_) af[s_] = *(const LAS lr_bf16x8*)(lds + LR_XA + (32 * wave + r32) * 144 + (16 * s_ + 8 * hi) * 2);
#pragma unroll
          for (int gt = 0; gt < 2; ++gt)
#pragma unroll
              for (int nt = 0; nt < 2; ++nt)
#pragma unroll
                  for (int s_ = 0; s_ < 4; ++s_) { const lr_bf16x8 bfr = *(const LAS lr_bf16x8*)(lds + LR_WT + gt * 9216 + (32 * nt + r32) * 144 + (16 * s_ + 8 * hi) * 2);
                      acc[gt][nt] = __builtin_amdgcn_mfma_f32_32x32x16_bf16(af[s_], bfr, acc[gt][nt], 0, 0, 0); } }
#pragma unroll
        for (int nt = 0; nt < 2; ++nt) { const float sp = sp_[nt];
            float sa_[4], sh_[4];
#pragma unroll
            for (int q = 0; q < 4; ++q) { float hrun = 0.f, arun = 1.f;
#pragma unroll
                for (int e = 0; e < 4; ++e) { const int r = 4 * q + e, tl = 8 * q + 4 * hi + e;
                    const float xv = __builtin_bit_cast(float, (unsigned)*(const LAS unsigned short*)(lds + LR_XA + (32 * wave + tl) * 144 + (32 * nt + r32) * 2) << 16);
                    const float rg = __builtin_amdgcn_rcpf(1.f + __builtin_amdgcn_exp2f(-LOG2E * acc[0][nt][r])), ig = __builtin_amdgcn_rcpf(1.f + __builtin_amdgcn_exp2f(-LOG2E * acc[1][nt][r]));
                    const float la = -8.0f * rg * sp; const float a_ = __builtin_amdgcn_exp2f(LOG2E * la);
                    const float uu = __builtin_amdgcn_sqrtf(fmaxf(1.f - a_ * a_, 0.f)) * (ig * xv);
                    hrun = a_ * hrun + uu; arun *= a_; acc[0][nt][r] = arun; acc[1][nt][r] = hrun; }
                sa_[q] = arun; sh_[q] = hrun; }
            float runA = 1.f, runH = 0.f;
#pragma unroll
            for (int q = 0; q < 4; ++q) { float a0 = sa_[q], a1 = sa_[q], h0 = sh_[q], h1 = sh_[q]; lr_swap32(a0, a1); lr_swap32(h0, h1);
                const float midA = runA * a0, midH = a0 * runH + h0;
                const float inA = hi ? midA : runA, inH = hi ? midH : runH;
                runA = midA * a1; runH = a1 * midH + h1;
#pragma unroll
                for (int e = 0; e < 4; ++e) { const int r = 4 * q + e; acc[1][nt][r] += acc[0][nt][r] * inH; acc[0][nt][r] *= inA; } }
            if (hi == 0) { SUM[(wave * 64 + 32 * nt + r32) * 2] = runA; SUM[(wave * 64 + 32 * nt + r32) * 2 + 1] = runH; } }
        __syncthreads();
#pragma unroll
        for (int nt = 0; nt < 2; ++nt) { const int cl = 32 * nt + r32;
            float ca = 1.f, chh = 0.f;
            for (int w = 0; w < wave; ++w) { const float aw = SUM[(w * 64 + cl) * 2], hw = SUM[(w * 64 + cl) * 2 + 1]; chh = aw * chh + hw; ca *= aw; }
            GAS unsigned* ha = P.HA + (size_t)(t0 + 32 * wave + 4 * hi) * 512 + 64 * g + cl;
#pragma unroll
            for (int r = 0; r < 16; ++r) { const float hh = acc[1][nt][r] + acc[0][nt][r] * chh, ac_ = acc[0][nt][r] * ca; ha[(size_t)((r & 3) + 8 * (r >> 2)) * 512] = pk2(hh, ac_);
                if (r == 15 && wave == 7 && hi == 1) { P.LSUM[((size_t)tile * 512 + 64 * g + cl) * 2] = ac_; P.LSUM[((size_t)tile * 512 + 64 * g + cl) * 2 + 1] = hh; } } }
    }
}

struct PostP { const GAS bf16* OMB; const GAS unsigned* HA; const GAS float* LSUM; const GAS bf16* PROJB; const GAS float* gm; const GAS float* gl; GAS bf16* Y; };
__device__ __forceinline__ void post_phase(const PostP& P, LAS unsigned char* lds, int tid, int wave, int lane, int vcu, int G) {
    asm volatile("" : "+v"(tid), "+v"(lane));
    LAS float* hin = (LAS float*)lds;
    for (int u = vcu; u < T / 64; u += G) {
        const int t0 = u * 64, tile = t0 >> 8, tb = tile & ~31;
        __syncthreads();
        { float h = 0.f;
          for (int c0 = tb; c0 < tile; c0 += 8) {
              float av_[8], hv_[8];
#pragma unroll
              for (int i = 0; i < 8; ++i) { const int c = (c0 + i < tile) ? (c0 + i) : tb; av_[i] = P.LSUM[((size_t)c * 512 + tid) * 2]; hv_[i] = P.LSUM[((size_t)c * 512 + tid) * 2 + 1]; }
#pragma unroll
              for (int i = 0; i < 8; ++i) { if (c0 + i < tile) h = av_[i] * h + hv_[i]; } }
          hin[tid] = h; }
        __syncthreads();
        f32x4 hi0 = *(const LAS f32x4*)(hin + 8 * lane), hi1 = *(const LAS f32x4*)(hin + 8 * lane + 4);
        const f32x4 g0 = *(const GAS f32x4*)(P.gl + 8 * lane), g1 = *(const GAS f32x4*)(P.gl + 8 * lane + 4), gmv = *(const GAS f32x4*)(P.gm + 4 * lane);
#pragma unroll 2
        for (int i = 0; i < 8; ++i) {
            const size_t t = (size_t)t0 + 8 * wave + i;
            const v4u p0 = *(const GAS v4u*)(P.HA + t * 512 + 8 * lane), p1 = *(const GAS v4u*)(P.HA + t * 512 + 8 * lane + 4), gw_ = *(const GAS v4u*)(P.PROJB + t * INP + PC_GL + 8 * lane);
            const v2u mw = *(const GAS v2u*)(P.OMB + t * 256 + 4 * lane);
            float o[8];
            o[0] = (bflo(p0.x) + bfhi(p0.x) * hi0.x) * gelu_erf(bflo(gw_.x)); o[1] = (bflo(p0.y) + bfhi(p0.y) * hi0.y) * gelu_erf(bfhi(gw_.x));
            o[2] = (bflo(p0.z) + bfhi(p0.z) * hi0.z) * gelu_erf(bflo(gw_.y)); o[3] = (bflo(p0.w) + bfhi(p0.w) * hi0.w) * gelu_erf(bfhi(gw_.y));
            o[4] = (bflo(p1.x) + bfhi(p1.x) * hi1.x) * gelu_erf(bflo(gw_.z)); o[5] = (bflo(p1.y) + bfhi(p1.y) * hi1.y) * gelu_erf(bfhi(gw_.z));
            o[6] = (bflo(p1.z) + bfhi(p1.z) * hi1.z) * gelu_erf(bflo(gw_.w)); o[7] = (bflo(p1.w) + bfhi(p1.w) * hi1.w) * gelu_erf(bfhi(gw_.w));
            float s2 = 0.f;
#pragma unroll
            for (int e = 0; e < 8; ++e) s2 += o[e] * o[e];
            const float m0 = bflo(mw.x), m1 = bfhi(mw.x), m2 = bflo(mw.y), m3 = bfhi(mw.y);
            float s1 = (m0 * m0 + m1 * m1) + (m2 * m2 + m3 * m3);
            s1 = wave_sum(s1, lane); s2 = wave_sum(s2, lane);
            const float r1 = rsqrtf(s1 * (1.f / 256.f) + 1e-6f), r2 = rsqrtf(s2 * (1.f / 512.f) + 1e-6f);
            GAS bf16* yr = P.Y + t * 1024;
            { v2u w; w.x = pk2(m0 * r1 * gmv.x, m1 * r1 * gmv.y); w.y = pk2(m2 * r1 * gmv.z, m3 * r1 * gmv.w); *(GAS v2u*)(yr + 4 * lane) = w; }
            { v4u w; w.x = pk2(o[0] * r2 * g0.x, o[1] * r2 * g0.y); w.y = pk2(o[2] * r2 * g0.z, o[3] * r2 * g0.w); w.z = pk2(o[4] * r2 * g1.x, o[5] * r2 * g1.y); w.w = pk2(o[6] * r2 * g1.z, o[7] * r2 * g1.w);
              *(GAS v4u*)(yr + 256 + 8 * lane) = w; }
        }
    }
}

#define TILE_BAR() asm volatile("s_waitcnt lgkmcnt(0)\n\ts_barrier" ::: "memory")
typedef short bf16x8 __attribute__((ext_vector_type(8)));
typedef short s16x4 __attribute__((ext_vector_type(4)));
typedef float f32x16 __attribute__((ext_vector_type(16)));
typedef unsigned u32x4 __attribute__((ext_vector_type(4)));
__device__ __forceinline__ int crow(int r, int hi) { return (r & 3) + 8 * (r >> 2) + 4 * hi; }
typedef float f32x2_t __attribute__((ext_vector_type(2))); typedef __bf16 bf16x2_c __attribute__((ext_vector_type(2)));
__device__ __forceinline__ unsigned cvtpk(float lo, float hi) { f32x2_t v = {lo, hi}; bf16x2_c b = __builtin_convertvector(v, bf16x2_c); return __builtin_bit_cast(unsigned, b); }
__device__ __forceinline__ float swapmax(float m) { auto rr = __builtin_amdgcn_permlane32_swap(__float_as_uint(m), __float_as_uint(m), false, false); return fmaxf(__uint_as_float(rr[0]), __uint_as_float(rr[1])); }
__device__ __forceinline__ float swapadd(float m) { auto rr = __builtin_amdgcn_permlane32_swap(__float_as_uint(m), __float_as_uint(m), false, false); return __uint_as_float(rr[0]) + __uint_as_float(rr[1]); }
__device__ __forceinline__ s16x4 vtr(const LAS unsigned char* p) { return __builtin_bit_cast(s16x4, __builtin_amdgcn_ds_read_tr16_b64_v4i16((LAS s16x4*)p)); }
__device__ __forceinline__ bf16x8 pack8(const f32x16& p, int b) { u32x4 w; w.x = cvtpk(p[b], p[b + 1]); w.y = cvtpk(p[b + 2], p[b + 3]); w.z = cvtpk(p[b + 4], p[b + 5]); w.w = cvtpk(p[b + 6], p[b + 7]); return __builtin_bit_cast(bf16x8, w); }
__device__ __forceinline__ float vmax3(float a, float b, float c) { float r; asm("v_max3_f32 %0, %1, %2, %3" : "=v"(r) : "v"(a), "v"(b), "v"(c)); return r; }
__device__ __forceinline__ float max32(const f32x16& p, const f32x16& q) {
    float a = vmax3(p[0], p[1], p[2]), b = vmax3(p[3], p[4], p[5]), c = vmax3(p[6], p[7], p[8]), d = vmax3(p[9], p[10], p[11]), e = vmax3(p[12], p[13], p[14]);
    float f = vmax3(q[0], q[1], q[2]), g = vmax3(q[3], q[4], q[5]), h = vmax3(q[6], q[7], q[8]), i = vmax3(q[9], q[10], q[11]), j = vmax3(q[12], q[13], q[14]);
    a = vmax3(a, b, c); d = vmax3(d, e, p[15]); f = vmax3(f, g, h); i = vmax3(i, j, q[15]);
    return vmax3(vmax3(a, d, f), i, i);
}
__device__ __forceinline__ float max16(const f32x16& p) { float a = fmaxf(fmaxf(p[0], p[1]), fmaxf(p[2], p[3])), b = fmaxf(fmaxf(p[4], p[5]), fmaxf(p[6], p[7])), c = fmaxf(fmaxf(p[8], p[9]), fmaxf(p[10], p[11])), d = fmaxf(fmaxf(p[12], p[13]), fmaxf(p[14], p[15])); return fmaxf(fmaxf(a, b), fmaxf(c, d)); }

struct AttnP {
    const GAS bf16* Q; const GAS bf16* K; const GAS bf16* V; int qp, kp, vp;
    GAS bf16* O; int op;
    const GAS float* rope;
    const GAS int* pos; const GAS float* btab; const GAS float* dnorm; const GAS float* lams;
};
template <int KIND> struct AK {
    static constexpr bool DIFF = KIND == 1, CROSS = KIND == 2;
    static constexpr int HW = KIND == 0 ? 96 : KIND == 1 ? 64 : 256;
    static constexpr int NKS = KIND == 0 ? 6 : KIND == 1 ? 2 : 16;
    static constexpr int KP = KIND == 0 ? 208 : KIND == 1 ? 144 : 528;
    static constexpr int ND = CROSS ? 4 : 2;
    static constexpr int CPK = HW / 8, KCH = (64 * CPK + 511) / 512;
    static constexpr int VCH = ND / 2;
    static constexpr int KB = 64 * KP, VB = ND * 4096;
    static constexpr int NBUF = CROSS ? 2 : 3;
    static constexpr int K0 = 0, V0 = NBUF * KB, POS = V0 + NBUF * VB, BT = POS + 1024, DN = BT + 528, END = DN + 256;
};
static_assert(AK<2>::END <= RING_BYTES && AK<0>::END <= RING_BYTES && AK<1>::END + 16 + 8 * 8192 <= RING_BYTES, "attention LDS");

template <int KIND, bool LEAD>
__device__ __forceinline__ void attn_unit(const AttnP& P, int b, int h, int qb, int dhalf, LAS unsigned char* lds, int tid, int wave, int lane) {
    lane = lane_id_v(); tid = (wave << 6) | lane;
    typedef AK<KIND> C;
    constexpr bool DIFF = C::DIFF, CROSS = C::CROSS;
    constexpr int HW = C::HW, NKS = C::NKS, KP = C::KP, ND = C::ND, CPK = C::CPK, KCH = C::KCH, VCH = C::VCH;
    const int r32 = lane & 31, hi = lane >> 5;
    const size_t rowb = (size_t)b * S, rowk = CROSS ? (size_t)b * MEM : rowb;
    const int q0w = qb * 256 + wave * 32, qi = q0w + r32;
    int pq = 0; float bias_far = 0.f;
    __syncthreads();
    if (DIFF) {
        pq = P.pos[rowb + qi];
        if (tid < 129) ((LAS float*)(lds + C::BT))[tid] = P.btab[h * 129 + tid];
        if (tid >= 192 && tid < 256) ((LAS float*)(lds + C::DN))[tid - 192] = P.dnorm[tid - 192];
    }
    int minq = pq;
    if (DIFF) { for (int o = 1; o < 64; o <<= 1) { const int v = shxi(minq, o, lane); minq = v < minq ? v : minq; } }
    const int NT = CROSS ? MEM / 64 : 4 * (qb + 1);
    u32x4 kr[KCH], vr[VCH]; int pkr = 0;
    u32x4 kr2[CROSS ? 1 : KCH], vr2[CROSS ? 1 : VCH]; int pkr2 = 0;
    const GAS bf16* Kb = P.K + rowk * P.kp + h * HW; const GAS bf16* Vb = P.V + rowk * P.vp + (CROSS ? h * 256 + dhalf * 128 : h * 64);
    const __amdgpu_buffer_rsrc_t rK = __builtin_amdgcn_make_buffer_rsrc((void*)Kb, 0, 0x7fffffff, 0x00020000), rV = __builtin_amdgcn_make_buffer_rsrc((void*)Vb, 0, 0x7fffffff, 0x00020000);
    const __amdgpu_buffer_rsrc_t rP = __builtin_amdgcn_make_buffer_rsrc((void*)(DIFF ? P.pos + rowb : (const GAS int*)Kb), 0, 0x7fffffff, 0x00020000);
    int kvo[KCH], vvo[VCH];
#pragma unroll
    for (int i = 0; i < KCH; ++i) { int c = tid + 512 * i; c = c < 64 * CPK ? c : tid; kvo[i] = ((c / CPK) * P.kp + (c % CPK) * 8) * 2; }
#pragma unroll
    for (int i = 0; i < VCH; ++i) { const int c = tid + 512 * i; vvo[i] = ((c / (4 * ND)) * P.vp + (c % (4 * ND)) * 8) * 2; }
    const int pvo = (tid & 63) * 4;
    auto gload = [&](int t) {
        const int ks = __builtin_amdgcn_readfirstlane(64 * t * P.kp * 2), vs = __builtin_amdgcn_readfirstlane(64 * t * P.vp * 2);
#pragma unroll
        for (int i = 0; i < KCH; ++i) kr[i] = __builtin_amdgcn_raw_buffer_load_b128(rK, kvo[i], ks, 0);
#pragma unroll
        for (int i = 0; i < VCH; ++i) vr[i] = __builtin_amdgcn_raw_buffer_load_b128(rV, vvo[i], vs, 0);
        if (DIFF) pkr = __builtin_amdgcn_raw_buffer_load_b32(rP, pvo, __builtin_amdgcn_readfirstlane(64 * t * 4), 0);
    };
    auto lstore = [&](int buf) {
        LAS unsigned char* kb_ = lds + C::K0 + buf * C::KB; LAS unsigned char* vb_ = lds + C::V0 + buf * C::VB;
#pragma unroll
        for (int i = 0; i < KCH; ++i) { int c = tid + 512 * i; c = c < 64 * CPK ? c : tid; const int key = c / CPK, part = c % CPK; *(LAS u32x4*)(kb_ + key * KP + part * 16) = kr[i]; }
#pragma unroll
        for (int i = 0; i < VCH; ++i) { const int c = tid + 512 * i; const int key = c / (4 * ND), part = c % (4 * ND); *(LAS u32x4*)(vb_ + (part >> 2) * 4096 + (key >> 3) * 512 + (key & 7) * 64 + (part & 3) * 16) = vr[i]; }
        if (DIFF) { ((LAS int*)(lds + C::POS + buf * 256))[tid & 63] = pkr; if (tid < 64) { int mk_ = pkr; for (int o = 1; o < 64; o <<= 1) { const int v = shxi(mk_, o, lane); mk_ = v > mk_ ? v : mk_; } if (tid == 0) ((LAS int*)(lds + C::POS + 768))[buf] = mk_; } }
    };
    auto gloadB = [&](int t) {
        const int ks = __builtin_amdgcn_readfirstlane(64 * t * P.kp * 2), vs = __builtin_amdgcn_readfirstlane(64 * t * P.vp * 2);
#pragma unroll
        for (int i = 0; i < (CROSS ? 1 : KCH); ++i) kr2[i] = __builtin_amdgcn_raw_buffer_load_b128(rK, kvo[i], ks, 0);
#pragma unroll
        for (int i = 0; i < (CROSS ? 1 : VCH); ++i) vr2[i] = __builtin_amdgcn_raw_buffer_load_b128(rV, vvo[i], vs, 0);
        if (DIFF) pkr2 = __builtin_amdgcn_raw_buffer_load_b32(rP, pvo, __builtin_amdgcn_readfirstlane(64 * t * 4), 0);
    };
    auto lstoreB = [&](int buf) {
        LAS unsigned char* kb_ = lds + C::K0 + buf * C::KB; LAS unsigned char* vb_ = lds + C::V0 + buf * C::VB;
#pragma unroll
        for (int i = 0; i < (CROSS ? 1 : KCH); ++i) { int c = tid + 512 * i; c = c < 64 * CPK ? c : tid; const int key = c / CPK, part = c % CPK; *(LAS u32x4*)(kb_ + key * KP + part * 16) = kr2[i]; }
#pragma unroll
        for (int i = 0; i < (CROSS ? 1 : VCH); ++i) { const int c = tid + 512 * i; const int key = c / (4 * ND), part = c % (4 * ND); *(LAS u32x4*)(vb_ + (part >> 2) * 4096 + (key >> 3) * 512 + (key & 7) * 64 + (part & 3) * 16) = vr2[i]; }
        if (DIFF) { ((LAS int*)(lds + C::POS + buf * 256))[tid & 63] = pkr2; if (tid < 64) { int mk_ = pkr2; for (int o = 1; o < 64; o <<= 1) { const int v = shxi(mk_, o, lane); mk_ = v > mk_ ? v : mk_; } if (tid == 0) ((LAS int*)(lds + C::POS + 768))[buf] = mk_; } }
    };
    LAS float* osv = (LAS float*)(lds + ((C::END + 15) & ~15)) + wave * 2048 + lane;
    float il = 0.f;
    f32x16 oA[ND];
#pragma unroll 1
    for (int mp = 0; mp < (DIFF ? 2 : 1); ++mp) {
        bf16x8 qf[NKS];
        { const GAS bf16* qrow = P.Q + (rowb + qi) * P.qp + h * HW + mp * 32;
#pragma unroll
          for (int s = 0; s < NKS; ++s) qf[s] = *(const GAS bf16x8*)(qrow + 16 * s + 8 * hi);
          if (KIND == 0) {
              const GAS float* rp = P.rope + (rowb + qi) * 32 + 8 * hi;
              const f32x4 c0 = *(const GAS f32x4*)rp, c1 = *(const GAS f32x4*)(rp + 4), s0 = *(const GAS f32x4*)(rp + 16), s1 = *(const GAS f32x4*)(rp + 20);
              const u32x4 a = __builtin_bit_cast(u32x4, qf[NKS - 2]), bq = __builtin_bit_cast(u32x4, qf[NKS - 1]); u32x4 ra, rb;
#pragma unroll
              for (int w = 0; w < 4; ++w) { const float cl = w < 2 ? c0[2 * w] : c1[2 * w - 4], ch = w < 2 ? c0[2 * w + 1] : c1[2 * w - 3], sl = w < 2 ? s0[2 * w] : s1[2 * w - 4], sh = w < 2 ? s0[2 * w + 1] : s1[2 * w - 3];
                  const float x1l = bflo(a[w]), x1h = bfhi(a[w]), x2l = bflo(bq[w]), x2h = bfhi(bq[w]);
                  ra[w] = cvtpk(x1l * cl - x2l * sl, x1h * ch - x2h * sh); rb[w] = cvtpk(x1l * sl + x2l * cl, x1h * sh + x2h * ch); }
              qf[NKS - 2] = __builtin_bit_cast(bf16x8, ra); qf[NKS - 1] = __builtin_bit_cast(bf16x8, rb);
          } }
        __syncthreads();
        float m1 = -1e30f, l1 = 0.f;
#pragma unroll
        for (int d = 0; d < ND; ++d)
#pragma unroll
            for (int r = 0; r < 16; ++r) oA[d][r] = 0.f;
        auto qk = [&](int sl, f32x16& sa, f32x16& sb, float init) {
            const LAS unsigned char* kb_ = lds + C::K0 + sl * C::KB + r32 * KP + hi * 16 + mp * 64;
#pragma unroll
            for (int r = 0; r < 16; ++r) { sa[r] = init; sb[r] = init; }
            constexpr int HB = CROSS ? 4 : (NKS > 3 ? 3 : NKS);
#pragma unroll
            for (int s0_ = 0; s0_ < NKS; s0_ += HB) {
                bf16x8 kfa[HB], kfb[HB];
#pragma unroll
                for (int s = 0; s < HB; ++s) { kfa[s] = *(const LAS bf16x8*)(kb_ + (s0_ + s) * 32); kfb[s] = *(const LAS bf16x8*)(kb_ + 32 * KP + (s0_ + s) * 32); }
                __builtin_amdgcn_sched_barrier(0);
#pragma unroll
                for (int s = 0; s < HB; ++s) { sa = __builtin_amdgcn_mfma_f32_32x32x16_bf16(kfa[s], qf[s0_ + s], sa, 0, 0, 0); sb = __builtin_amdgcn_mfma_f32_32x32x16_bf16(kfb[s], qf[s0_ + s], sb, 0, 0, 0); }
                __builtin_amdgcn_sched_barrier(0);
            }
        };
        auto isnear = [&](int sl) { bool nb = false;
            if (DIFF) { const int mk_ = __builtin_amdgcn_readfirstlane(((LAS int*)(lds + C::POS + 768))[sl]); nb = (minq - mk_) < 128; }
            return nb; };
        auto sm = [&](int t, int sl, f32x16& pa, f32x16& pb, bool nearb) -> float {
            const int k0 = 64 * t;
            if (DIFF) { if (nearb) {
                const LAS int* pk = (const LAS int*)(lds + C::POS + sl * 256); const LAS float* bt = (const LAS float*)(lds + C::BT);
#pragma unroll
                for (int r = 0; r < 16; ++r) { const int kk = crow(r, hi);
                    int n0 = pq - pk[kk], n1 = pq - pk[kk + 32]; n0 = n0 < 0 ? 0 : (n0 > 128 ? 128 : n0); n1 = n1 < 0 ? 0 : (n1 > 128 ? 128 : n1);
                    pa[r] += bt[n0]; pb[r] += bt[n1]; }
            } }
            if (!CROSS && k0 + 63 > q0w) {
#pragma unroll
                for (int r = 0; r < 16; ++r) { const int kk = k0 + crow(r, hi); if (kk > qi) pa[r] = -1e30f; if (kk + 32 > qi) pb[r] = -1e30f; }
            }
            asm volatile("s_nop 15\n\ts_nop 7" : "+v"(pa), "+v"(pb));
            float mn, al = 1.f;
            if (CROSS) { const float mx = swapmax(max32(pa, pb)); mn = fmaxf(m1, mx); al = __builtin_amdgcn_exp2f(m1 - mn); l1 *= al; }
            else { const float mx = swapmax(max32(pa, pb)); const bool up = mx > m1 + 8.0f; mn = up ? mx : m1;
                   if (__builtin_amdgcn_ballot_w64(up) != 0ull) { al = __builtin_amdgcn_exp2f(m1 - mn); l1 *= al; } }
            m1 = mn;
            float ls = 0.f;
#pragma unroll
            for (int r = 0; r < 16; ++r) { pa[r] = __builtin_amdgcn_exp2f(pa[r] - mn); pb[r] = __builtin_amdgcn_exp2f(pb[r] - mn); ls += pa[r] + pb[r]; }
            l1 += ls;
            return al;
        };
        auto pv = [&](int sl, const f32x16& pa, const f32x16& pb, float al) {
            const LAS unsigned char* vb_ = lds + C::V0 + sl * C::VB + ((lane >> 4) & 1) * 32 + (lane & 3) * 8 + (4 * hi + ((lane & 15) >> 2)) * 64;
            bf16x8 pf[4];
            pf[0] = pack8(pa, 0); pf[1] = pack8(pa, 8); pf[2] = pack8(pb, 0); pf[3] = pack8(pb, 8);
            const bool resc = CROSS ? true : (__builtin_amdgcn_ballot_w64(al != 1.0f) != 0ull);
            if (CROSS) {
#pragma unroll
                for (int d = 0; d < ND; ++d) {
                    __builtin_amdgcn_sched_barrier(0);
#pragma unroll
                    for (int r = 0; r < 16; ++r) oA[d][r] *= al;
                    bf16x8 vf[4];
#pragma unroll
                    for (int s = 0; s < 4; ++s) { const s16x4 lo = vtr(vb_ + d * 4096 + s * 1024), hh = vtr(vb_ + d * 4096 + s * 1024 + 512); vf[s] = (bf16x8){lo[0], lo[1], lo[2], lo[3], hh[0], hh[1], hh[2], hh[3]}; }
#pragma unroll
                    for (int s = 0; s < 4; ++s) oA[d] = __builtin_amdgcn_mfma_f32_32x32x16_bf16(vf[s], pf[s], oA[d], 0, 0, 0);
                }
            } else if (DIFF) {
                if (resc) {
#pragma unroll
                    for (int d = 0; d < 2; ++d)
#pragma unroll
                        for (int r = 0; r < 16; ++r) oA[d][r] *= al;
                }
#pragma unroll
                for (int d = 0; d < 2; ++d) {
                    bf16x8 vf[4];
#pragma unroll
                    for (int s = 0; s < 4; ++s) { const s16x4 lo = vtr(vb_ + d * 4096 + s * 1024), hh = vtr(vb_ + d * 4096 + s * 1024 + 512); vf[s] = (bf16x8){lo[0], lo[1], lo[2], lo[3], hh[0], hh[1], hh[2], hh[3]}; }
                    __builtin_amdgcn_sched_barrier(0);
#pragma unroll
                    for (int s = 0; s < 4; ++s) oA[d] = __builtin_amdgcn_mfma_f32_32x32x16_bf16(vf[s], pf[s], oA[d], 0, 0, 0);
                }
            } else {
                bf16x8 vf[2][4];
#pragma unroll
                for (int d = 0; d < 2; ++d)
#pragma unroll
                    for (int s = 0; s < 4; ++s) { const s16x4 lo = vtr(vb_ + d * 4096 + s * 1024), hh = vtr(vb_ + d * 4096 + s * 1024 + 512); vf[d][s] = (bf16x8){lo[0], lo[1], lo[2], lo[3], hh[0], hh[1], hh[2], hh[3]}; }
                if (resc) {
#pragma unroll
                    for (int d = 0; d < 2; ++d)
#pragma unroll
                        for (int r = 0; r < 16; ++r) oA[d][r] *= al;
                }
                __builtin_amdgcn_sched_barrier(0);
#pragma unroll
                for (int s = 0; s < 4; ++s)
#pragma unroll
                    for (int d = 0; d < 2; ++d) oA[d] = __builtin_amdgcn_mfma_f32_32x32x16_bf16(vf[d][s], pf[s], oA[d], 0, 0, 0);
            }
        };
        if (CROSS) {
            gload(0); lstore(0);
            __syncthreads();
            for (int t = 0; t < NT; ++t) {
                const int buf = t & 1;
                f32x16 pa, pb;
                qk(buf, pa, pb, 0.f);
                const float al = sm(t, buf, pa, pb, false);
                pv(buf, pa, pb, al);
                if (t + 1 < NT) { gload(t + 1); lstore(buf ^ 1); }
                TILE_BAR();
            }
        } else {
            gload(0); lstore(0); gload(1); lstore(1);
            gload(2); gloadB(3);
            __syncthreads();
            if (DIFF) bias_far = ((LAS float*)(lds + C::BT))[128];
            const int NTW = (q0w + 31) / 64 + 1;
            constexpr bool lead = LEAD;
            f32x16 ca, cb, na, nb; bool cnear = isnear(0), nnear = false; float cal = 1.f;
            qk(0, ca, cb, (DIFF && !cnear) ? bias_far : 0.f);
            if (lead) cal = sm(0, 0, ca, cb, cnear);
            int s0 = 0, s1 = 1, s2 = 2;
            auto period = [&](int t, f32x16& xa, f32x16& xb, bool& xnear, f32x16& ya, f32x16& yb, bool& ynear) {
                const bool have_next = (t + 1 < NTW);
                if (lead) {
                    if (have_next) { ynear = isnear(s1); qk(s1, ya, yb, (DIFF && !ynear) ? bias_far : 0.f); }
                    if (t < NTW) pv(s0, xa, xb, cal);
                    if (have_next) cal = sm(t + 1, s1, ya, yb, ynear);
                } else {
                    if (t < NTW) cal = sm(t, s0, xa, xb, xnear);
                    if (have_next) { ynear = isnear(s1); qk(s1, ya, yb, (DIFF && !ynear) ? bias_far : 0.f); }
                    if (t < NTW) pv(s0, xa, xb, cal);
                }
                { const int tmp = s0; s0 = s1; s1 = s2; s2 = tmp; }
            };
            int t = 0;
            for (; t + 5 < NT; t += 2) {
                lstore(s2); gload(t + 4);
                period(t, ca, cb, cnear, na, nb, nnear);
                TILE_BAR();
                lstoreB(s2); gloadB(t + 5);
                period(t + 1, na, nb, nnear, ca, cb, cnear);
                TILE_BAR();
            }
            for (; t < NT; t += 2) {
                if (t + 2 < NT) { lstore(s2); if (t + 4 < NT) gload(t + 4); }
                period(t, ca, cb, cnear, na, nb, nnear);
                TILE_BAR();
                if (t + 3 < NT) { lstoreB(s2); if (t + 5 < NT) gloadB(t + 5); }
                period(t + 1, na, nb, nnear, ca, cb, cnear);
                TILE_BAR();
            }
        }
        il = 1.f / swapadd(l1);
        if (DIFF) { if (mp == 0) {
#pragma unroll
            for (int d = 0; d < 2; ++d)
#pragma unroll
                for (int r = 0; r < 16; ++r) osv[(d * 16 + r) * 64] = oA[d][r] * il; } }
    }
    GAS bf16* orow = P.O + (rowb + qi) * P.op + (CROSS ? h * 256 + dhalf * 128 : h * 64);
    if (!DIFF) {
#pragma unroll
        for (int d = 0; d < ND; ++d)
#pragma unroll
            for (int g = 0; g < 4; ++g) { v2u v; v.x = cvtpk(oA[d][4 * g] * il, oA[d][4 * g + 1] * il); v.y = cvtpk(oA[d][4 * g + 2] * il, oA[d][4 * g + 3] * il); *(GAS v2u*)(orow + 32 * d + 8 * g + 4 * hi) = v; }
    } else {
        const float lam = P.lams[0], lam_init = P.lams[1];
        const float i2 = lam * il;
        float ss = 0.f;
#pragma unroll
        for (int d = 0; d < 2; ++d)
#pragma unroll
            for (int r = 0; r < 16; ++r) { const float v = osv[(d * 16 + r) * 64] - oA[d][r] * i2; oA[d][r] = v; ss += v * v; }
        ss = swapadd(ss);
        const float rs = __builtin_amdgcn_rsqf(ss * (1.f / 64.f) + 1e-6f) * (1.f - lam_init);
        const LAS float* dn = (const LAS float*)(lds + C::DN);
#pragma unroll
        for (int d = 0; d < 2; ++d)
#pragma unroll
            for (int g = 0; g < 4; ++g) { const int c = 32 * d + 8 * g + 4 * hi; const f32x4 gn = *(const LAS f32x4*)(dn + c);
                v2u v; v.x = cvtpk(oA[d][4 * g] * rs * gn[0], oA[d][4 * g + 1] * rs * gn[1]); v.y = cvtpk(oA[d][4 * g + 2] * rs * gn[2], oA[d][4 * g + 3] * rs * gn[3]); *(GAS v2u*)(orow + c) = v; }
    }
}

__device__ __forceinline__ int wave_max_i(int v) {
    { const int o = __builtin_amdgcn_update_dpp(0, v, 0xB1, 0xF, 0xF, true); v = o > v ? o : v; }
    { const int o = __builtin_amdgcn_update_dpp(0, v, 0x4E, 0xF, 0xF, true); v = o > v ? o : v; }
    { const int o = __builtin_amdgcn_update_dpp(0, v, 0x141, 0xF, 0xF, true); v = o > v ? o : v; }
    { const int o = __builtin_amdgcn_update_dpp(0, v, 0x140, 0xF, 0xF, true); v = o > v ? o : v; }
    { int a = v, b = v; asm volatile("v_nop\n\tv_nop\n\tv_permlane16_swap_b32 %0, %1" : "+v"(a), "+v"(b)); v = a > b ? a : b; }
    { int a = v, b = v; asm volatile("v_nop\n\tv_nop\n\tv_permlane32_swap_b32 %0, %1" : "+v"(a), "+v"(b)); v = a > b ? a : b; }
    return v;
}
template <int KIND> struct AK2 {
    static constexpr bool DIFF = KIND == 1;
    static constexpr int HW = KIND == 0 ? 96 : 64, NKS = KIND == 0 ? 6 : 2, KP = KIND == 0 ? 208 : 144;
    static constexpr int CPK = HW / 8, KCH = (128 * CPK) / 512, VCH = 2;
    static constexpr int KB = 128 * KP, VB = 2 * 8192;
    static constexpr int K0 = 0, V0 = 2 * KB, POS = V0 + 2 * VB, PMX = POS + 1024, BT = PMX + 16, DN = BT + 528, OSV = (DN + 256 + 15) & ~15, END = OSV + (DIFF ? 8 * 8192 : 0);
};
static_assert(AK2<0>::END <= RING_BYTES && AK2<1>::END <= RING_BYTES, "attention LDS (128-key tiles)");
template <int KIND>
__device__ __forceinline__ void attn_unit2(const AttnP& P, int b, int h, int qb, LAS unsigned char* lds, int tid, int wave, int lane) {
    lane = lane_id_v(); tid = (wave << 6) | lane;
    typedef AK2<KIND> C;
    constexpr bool DIFF = C::DIFF;
    constexpr int HW = C::HW, NKS = C::NKS, KP = C::KP, CPK = C::CPK, KCH = C::KCH, VCH = C::VCH;
    const int r32 = lane & 31, hi = lane >> 5;
    const size_t rowb = (size_t)b * S;
    const int q0w = qb * 256 + wave * 32, qi = q0w + r32;
    int pq = 0; float bias_far = 0.f;
    __syncthreads();
    if (DIFF) {
        pq = P.pos[rowb + qi];
        if (tid < 129) ((LAS float*)(lds + C::BT))[tid] = P.btab[h * 129 + tid];
        if (tid >= 192 && tid < 256) ((LAS float*)(lds + C::DN))[tid - 192] = P.dnorm[tid - 192];
    }
    int minq = pq;
    if (DIFF) minq = __builtin_amdgcn_readfirstlane(-wave_max_i(-pq));
    const int NT = 2 * (qb + 1);
    const GAS bf16* Kb = P.K + rowb * P.kp + h * HW; const GAS bf16* Vb = P.V + rowb * P.vp + h * 64;
    const __amdgpu_buffer_rsrc_t rK = __builtin_amdgcn_make_buffer_rsrc((void*)Kb, 0, 0x7fffffff, 0x00020000), rV = __builtin_amdgcn_make_buffer_rsrc((void*)Vb, 0, 0x7fffffff, 0x00020000);
    const __amdgpu_buffer_rsrc_t rP = __builtin_amdgcn_make_buffer_rsrc((void*)(DIFF ? P.pos + rowb : (const GAS int*)Kb), 0, 0x7fffffff, 0x00020000);
    int kvo[KCH], vvo[VCH], klo[KCH], vlo[VCH];
#pragma unroll
    for (int i = 0; i < KCH; ++i) { const int c = tid + 512 * i; kvo[i] = ((c / CPK) * P.kp + (c % CPK) * 8) * 2; klo[i] = (c / CPK) * KP + (c % CPK) * 16; }
#pragma unroll
    for (int i = 0; i < VCH; ++i) { const int c = tid + 512 * i; const int key = c >> 3, part = c & 7; vvo[i] = (key * P.vp + part * 8) * 2; vlo[i] = (part >> 2) * 8192 + (key >> 3) * 512 + (key & 7) * 64 + (part & 3) * 16; }
    const int pvo = (tid & 127) * 4;
    u32x4 kr[KCH], vr[VCH]; int pkr = 0;
    auto gload = [&](int t) {
        const int ks = __builtin_amdgcn_readfirstlane(128 * t * P.kp * 2), vs = __builtin_amdgcn_readfirstlane(128 * t * P.vp * 2);
#pragma unroll
        for (int i = 0; i < KCH; ++i) kr[i] = __builtin_amdgcn_raw_buffer_load_b128(rK, kvo[i], ks, 0);
#pragma unroll
        for (int i = 0; i < VCH; ++i) vr[i] = __builtin_amdgcn_raw_buffer_load_b128(rV, vvo[i], vs, 0);
        if (DIFF) pkr = __builtin_amdgcn_raw_buffer_load_b32(rP, pvo, __builtin_amdgcn_readfirstlane(128 * t * 4), 0);
    };
    auto lstore = [&](int buf) {
        LAS unsigned char* kb_ = lds + C::K0 + buf * C::KB; LAS unsigned char* vb_ = lds + C::V0 + buf * C::VB;
#pragma unroll
        for (int i = 0; i < KCH; ++i) *(LAS u32x4*)(kb_ + klo[i]) = kr[i];
#pragma unroll
        for (int i = 0; i < VCH; ++i) *(LAS u32x4*)(vb_ + vlo[i]) = vr[i];
        if (DIFF) { ((LAS int*)(lds + C::POS + buf * 512))[tid & 127] = pkr;
            if (tid < 128) { const int mk_ = wave_max_i(pkr); if (lane == 0) ((LAS int*)(lds + C::PMX))[buf * 2 + wave] = mk_; } }
    };
    LAS float* osv = (LAS float*)(lds + C::OSV) + wave * 2048 + lane;
    float il = 0.f;
    f32x16 oA[2];
#pragma unroll 1
    for (int mp = 0; mp < (DIFF ? 2 : 1); ++mp) {
        bf16x8 qf[NKS];
        { const GAS bf16* qrow = P.Q + (rowb + qi) * P.qp + h * HW + mp * 32;
#pragma unroll
          for (int s = 0; s < NKS; ++s) qf[s] = *(const GAS bf16x8*)(qrow + 16 * s + 8 * hi);
          if (KIND == 0) {
              const GAS float* rp = P.rope + (rowb + qi) * 32 + 8 * hi;
              const f32x4 c0 = *(const GAS f32x4*)rp, c1 = *(const GAS f32x4*)(rp + 4), s0 = *(const GAS f32x4*)(rp + 16), s1 = *(const GAS f32x4*)(rp + 20);
              const u32x4 a = __builtin_bit_cast(u32x4, qf[NKS - 2]), bq = __builtin_bit_cast(u32x4, qf[NKS - 1]); u32x4 ra, rb;
#pragma unroll
              for (int w = 0; w < 4; ++w) { const float cl = w < 2 ? c0[2 * w] : c1[2 * w - 4], ch = w < 2 ? c0[2 * w + 1] : c1[2 * w - 3], sl = w < 2 ? s0[2 * w] : s1[2 * w - 4], sh = w < 2 ? s0[2 * w + 1] : s1[2 * w - 3];
                  const float x1l = bflo(a[w]), x1h = bfhi(a[w]), x2l = bflo(bq[w]), x2h = bfhi(bq[w]);
                  ra[w] = cvtpk(x1l * cl - x2l * sl, x1h * ch - x2h * sh); rb[w] = cvtpk(x1l * sl + x2l * cl, x1h * sh + x2h * ch); }
              qf[NKS - 2] = __builtin_bit_cast(bf16x8, ra); qf[NKS - 1] = __builtin_bit_cast(bf16x8, rb);
          } }
        __syncthreads();
        float m1 = 0.f, l1 = 0.f;
        f32x16 negm;
#pragma unroll
        for (int r = 0; r < 16; ++r) negm[r] = 0.f;
#pragma unroll
        for (int d = 0; d < 2; ++d)
#pragma unroll
            for (int r = 0; r < 16; ++r) oA[d][r] = 0.f;
        gload(0); lstore(0);
        if (NT > 1) gload(1);
        __syncthreads();
        if (DIFF) { bias_far = ((LAS float*)(lds + C::BT))[128];
#pragma unroll
            for (int r = 0; r < 16; ++r) negm[r] = bias_far; }
        const int NTW = (q0w + 31) / 128 + 1;
        auto compute = [&](int t, int buf) {
            const int k0 = 128 * t;
            const LAS unsigned char* kb_ = lds + C::K0 + buf * C::KB + r32 * KP + hi * 16 + mp * 64;
            const LAS unsigned char* vb_ = lds + C::V0 + buf * C::VB + ((lane >> 4) & 1) * 32 + (lane & 3) * 8 + (4 * hi + ((lane & 15) >> 2)) * 64;
            bool nearb = false;
            if (DIFF) { const LAS int* pm = (const LAS int*)(lds + C::PMX) + buf * 2; const int m0 = __builtin_amdgcn_readfirstlane(pm[0]), m1_ = __builtin_amdgcn_readfirstlane(pm[1]); nearb = (minq - (m0 > m1_ ? m0 : m1_)) < 128; }
            f32x16 sc[4];
            if (DIFF) { if (nearb) {
#pragma unroll
                for (int g = 0; g < 4; ++g)
#pragma unroll
                    for (int r = 0; r < 16; ++r) sc[g][r] = -m1; } }
            constexpr int HB = NKS > 3 ? 3 : NKS;
#pragma unroll
            for (int s0_ = 0; s0_ < NKS; s0_ += HB) {
                bf16x8 kf[4][HB];
#pragma unroll
                for (int g = 0; g < 4; ++g)
#pragma unroll
                    for (int s = 0; s < HB; ++s) kf[g][s] = *(const LAS bf16x8*)(kb_ + 32 * g * KP + (s0_ + s) * 32);
                __builtin_amdgcn_sched_barrier(0);
#pragma unroll
                for (int s = 0; s < HB; ++s)
#pragma unroll
                    for (int g = 0; g < 4; ++g) {
                        if (s0_ + s == 0 && !(DIFF && nearb)) sc[g] = __builtin_amdgcn_mfma_f32_32x32x16_bf16(kf[g][s], qf[s0_ + s], negm, 0, 0, 0);
                        else sc[g] = __builtin_amdgcn_mfma_f32_32x32x16_bf16(kf[g][s], qf[s0_ + s], sc[g], 0, 0, 0); }
                __builtin_amdgcn_sched_barrier(0);
            }
            if (DIFF) { if (nearb) {
                const LAS int* pk = (const LAS int*)(lds + C::POS + buf * 512); const LAS float* bt = (const LAS float*)(lds + C::BT);
#pragma unroll
                for (int g = 0; g < 4; ++g)
#pragma unroll
                    for (int r = 0; r < 16; ++r) { int n0 = pq - pk[32 * g + crow(r, hi)]; n0 = n0 < 0 ? 0 : (n0 > 128 ? 128 : n0); sc[g][r] += bt[n0]; }
            } }
            asm volatile("s_nop 15\n\ts_nop 7" : "+v"(sc[0]), "+v"(sc[1]), "+v"(sc[2]), "+v"(sc[3]));
            if (k0 + 127 > q0w) {
#pragma unroll
                for (int g = 0; g < 4; ++g)
#pragma unroll
                    for (int r = 0; r < 16; ++r) { if (k0 + 32 * g + crow(r, hi) > qi) sc[g][r] = -1e30f; }
            }
            const float mx = swapmax(vmax3(max32(sc[0], sc[1]), max32(sc[2], sc[3]), -1e30f));
            const bool up = (t == 0) || mx > 8.0f;
            float al = 1.f;
            if (__builtin_amdgcn_ballot_w64(up) != 0ull) {
                const float dl = up ? mx : 0.f; al = __builtin_amdgcn_exp2f(-dl); l1 *= al; m1 += dl;
#pragma unroll
                for (int r = 0; r < 16; ++r) negm[r] -= dl;
#pragma unroll
                for (int g = 0; g < 4; ++g)
#pragma unroll
                    for (int r = 0; r < 16; ++r) sc[g][r] -= dl;
            }
            float ls = 0.f;
#pragma unroll
            for (int g = 0; g < 4; ++g)
#pragma unroll
                for (int r = 0; r < 16; ++r) { sc[g][r] = __builtin_amdgcn_exp2f(sc[g][r]); ls += sc[g][r]; }
            l1 += ls;
            bf16x8 pf[8];
#pragma unroll
            for (int g = 0; g < 4; ++g) { pf[2 * g] = pack8(sc[g], 0); pf[2 * g + 1] = pack8(sc[g], 8); }
            if (__builtin_amdgcn_ballot_w64(al != 1.0f) != 0ull) {
#pragma unroll
                for (int d = 0; d < 2; ++d)
#pragma unroll
                    for (int r = 0; r < 16; ++r) oA[d][r] *= al;
            }
#pragma unroll
            for (int d = 0; d < 2; ++d) {
                bf16x8 vf[8];
#pragma unroll
                for (int s = 0; s < 8; ++s) { const s16x4 lo = vtr(vb_ + d * 8192 + s * 1024), hh = vtr(vb_ + d * 8192 + s * 1024 + 512); vf[s] = (bf16x8){lo[0], lo[1], lo[2], lo[3], hh[0], hh[1], hh[2], hh[3]}; }
                __builtin_amdgcn_sched_barrier(0);
#pragma unroll
                for (int s = 0; s < 8; ++s) oA[d] = __builtin_amdgcn_mfma_f32_32x32x16_bf16(vf[s], pf[s], oA[d], 0, 0, 0);
                __builtin_amdgcn_sched_barrier(0);
            }
        };
        int t = 0;
        for (; t + 2 < NT; ++t) {
            const int buf = t & 1;
            if (t < NTW) compute(t, buf);
            lstore(buf ^ 1); gload(t + 2);
            TILE_BAR();
        }
        for (; t < NT; ++t) {
            const int buf = t & 1;
            if (t < NTW) compute(t, buf);
            if (t + 1 < NT) lstore(buf ^ 1);
            TILE_BAR();
        }
        il = 1.f / swapadd(l1);
        if (DIFF) { if (mp == 0) {
#pragma unroll
            for (int d = 0; d < 2; ++d)
#pragma unroll
                for (int r = 0; r < 16; ++r) osv[(d * 16 + r) * 64] = oA[d][r] * il; } }
    }
    GAS bf16* orow = P.O + (rowb + qi) * P.op + h * 64;
    if (!DIFF) {
#pragma unroll
        for (int d = 0; d < 2; ++d)
#pragma unroll
            for (int g = 0; g < 4; ++g) { v2u v; v.x = cvtpk(oA[d][4 * g] * il, oA[d][4 * g + 1] * il); v.y = cvtpk(oA[d][4 * g + 2] * il, oA[d][4 * g + 3] * il); *(GAS v2u*)(orow + 32 * d + 8 * g + 4 * hi) = v; }
    } else {
        const float lam = P.lams[0], lam_init = P.lams[1];
        const float i2 = lam * il;
        float ss = 0.f;
#pragma unroll
        for (int d = 0; d < 2; ++d)
#pragma unroll
            for (int r = 0; r < 16; ++r) { const float v = osv[(d * 16 + r) * 64] - oA[d][r] * i2; oA[d][r] = v; ss += v * v; }
        ss = swapadd(ss);
        const float rs = __builtin_amdgcn_rsqf(ss * (1.f / 64.f) + 1e-6f) * (1.f - lam_init);
        const LAS float* dn = (const LAS float*)(lds + C::DN);
#pragma unroll
        for (int d = 0; d < 2; ++d)
#pragma unroll
            for (int g = 0; g < 4; ++g) { const int c = 32 * d + 8 * g + 4 * hi; const f32x4 gn = *(const LAS f32x4*)(dn + c);
                v2u v; v.x = cvtpk(oA[d][4 * g] * rs * gn[0], oA[d][4 * g + 1] * rs * gn[1]); v.y = cvtpk(oA[d][4 * g + 2] * rs * gn[2], oA[d][4 * g + 3] * rs * gn[3]); *(GAS v2u*)(orow + c) = v; }
    }
}

__device__ __forceinline__ void attn_phase(const AttnP& PM, const AttnP& PD, LAS unsigned char* lds, int tid, int wave, int lane, int vcu, int G, int only = -1) {
    for (int i = vcu; i < 512; i += G) {
        if (only >= 0 && (i >> 8) != only) continue;
        const int kind = i >> 8, c = i & 255, bh = c >> 4, s = c & 15;
        if (kind == 0) {
#pragma unroll 1
            for (int k = 0; k < 2; ++k) attn_unit2<0>(PM, bh >> 2, bh & 3, k ? 31 - s : s, lds, tid, wave, lane);
        } else {
#pragma unroll 1
            for (int k = 0; k < 2; ++k) attn_unit2<1>(PD, bh >> 2, bh & 3, k ? 31 - s : s, lds, tid, wave, lane);
        }
    }
}
__device__ __forceinline__ float cx_max16(const f32x16& p) { return fmaxf(fmaxf(fmaxf(fmaxf(p[0], p[1]), fmaxf(p[2], p[3])), fmaxf(fmaxf(p[4], p[5]), fmaxf(p[6], p[7]))), fmaxf(fmaxf(fmaxf(p[8], p[9]), fmaxf(p[10], p[11])), fmaxf(fmaxf(p[12], p[13]), fmaxf(p[14], p[15])))); }
__device__ __forceinline__ void cross_unit2(const AttnP& P, int b, int h, int qb, LAS unsigned char* lds, int wave) {
    const int lane = lane_id_v(), tid = (wave << 6) | lane;
    constexpr int KP = 528;
    const int r32 = lane & 31, hi = lane >> 5;
    const size_t rowb = (size_t)b * S, rowk = (size_t)b * MEM;
    const int qi = qb * 256 + wave * 32 + r32;
    const GAS bf16* Kb = P.K + rowk * P.kp + h * 256; const GAS bf16* Vb = P.V + rowk * P.vp + h * 256;
    const __amdgpu_buffer_rsrc_t rK = __builtin_amdgcn_make_buffer_rsrc((void*)Kb, 0, 0x7fffffff, 0x00020000), rV = __builtin_amdgcn_make_buffer_rsrc((void*)Vb, 0, 0x7fffffff, 0x00020000);
    const GAS bf16* qrow = P.Q + (rowb + qi) * P.qp + h * 256 + 8 * hi;
    bf16x8 qf[4];
#pragma unroll
    for (int s = 0; s < 4; ++s) qf[s] = *(const GAS bf16x8*)(qrow + 16 * s);
    { u32x4 st[16];
#pragma unroll
      for (int i = 0; i < 16; ++i) { const int c = tid + 512 * i; st[i] = __builtin_amdgcn_raw_buffer_load_b128(rK, ((c >> 5) * P.kp + (c & 31) * 8) * 2, 0, 0); }
      TILE_BAR();
#pragma unroll
      for (int i = 0; i < 16; ++i) { const int c = tid + 512 * i; *(LAS u32x4*)(lds + (c >> 5) * KP + (c & 31) * 16) = st[i]; } }
    __syncthreads();
    f32x16 sc[8];
#pragma unroll
    for (int g = 0; g < 8; ++g)
#pragma unroll
        for (int r = 0; r < 16; ++r) sc[g][r] = 0.f;
    const LAS unsigned char* kb_ = lds + r32 * KP + hi * 16;
#pragma unroll
    for (int c = 0; c < 4; ++c) {
        bf16x8 qn[4];
        if (c + 1 < 4) {
#pragma unroll
            for (int s = 0; s < 4; ++s) qn[s] = *(const GAS bf16x8*)(qrow + 64 * (c + 1) + 16 * s); }
#pragma unroll
        for (int g = 0; g < 8; ++g) { bf16x8 kf[4];
#pragma unroll
            for (int s = 0; s < 4; ++s) kf[s] = *(const LAS bf16x8*)(kb_ + 32 * g * KP + (4 * c + s) * 32);
#pragma unroll
            for (int s = 0; s < 4; ++s) sc[g] = __builtin_amdgcn_mfma_f32_32x32x16_bf16(kf[s], qf[s], sc[g], 0, 0, 0); }
        if (c + 1 < 4) {
#pragma unroll
            for (int s = 0; s < 4; ++s) qf[s] = qn[s]; }
    }
    float m = fmaxf(fmaxf(fmaxf(cx_max16(sc[0]), cx_max16(sc[1])), fmaxf(cx_max16(sc[2]), cx_max16(sc[3]))), fmaxf(fmaxf(cx_max16(sc[4]), cx_max16(sc[5])), fmaxf(cx_max16(sc[6]), cx_max16(sc[7]))));
    m = swapmax(m);
    float l = 0.f;
    bf16x8 pf[16];
#pragma unroll
    for (int g = 0; g < 8; ++g) {
#pragma unroll
        for (int r = 0; r < 16; ++r) { sc[g][r] = __builtin_amdgcn_exp2f(sc[g][r] - m); l += sc[g][r]; }
        pf[2 * g] = pack8(sc[g], 0); pf[2 * g + 1] = pack8(sc[g], 8); }
    const float il = 1.f / swapadd(l);
    { u32x4 st[16];
#pragma unroll
      for (int i = 0; i < 16; ++i) { const int c = tid + 512 * i; const int sub = c & 3, key = (c >> 2) & 255, dt = c >> 10; st[i] = __builtin_amdgcn_raw_buffer_load_b128(rV, (key * P.vp + dt * 32 + sub * 8) * 2, 0, 0); }
      TILE_BAR();
#pragma unroll
      for (int i = 0; i < 16; ++i) { const int c = tid + 512 * i; const int sub = c & 3, key = (c >> 2) & 255, dt = c >> 10; *(LAS u32x4*)(lds + dt * 16384 + (key >> 3) * 512 + (key & 7) * 64 + sub * 16) = st[i]; } }
    __syncthreads();
    const LAS unsigned char* vb_ = lds + ((lane >> 4) & 1) * 32 + (lane & 3) * 8 + (4 * hi + ((lane & 15) >> 2)) * 64;
    GAS bf16* orow = P.O + (rowb + qi) * P.op + h * 256;
#pragma unroll 1
    for (int dh = 0; dh < 2; ++dh) {
        f32x16 oA[4];
#pragma unroll
        for (int d = 0; d < 4; ++d)
#pragma unroll
            for (int r = 0; r < 16; ++r) oA[d][r] = 0.f;
#pragma unroll
        for (int d = 0; d < 4; ++d) {
#pragma unroll
            for (int sb = 0; sb < 2; ++sb) { bf16x8 vf[8];
#pragma unroll
                for (int s = 0; s < 8; ++s) { const s16x4 lo = vtr(vb_ + (4 * dh + d) * 16384 + (8 * sb + s) * 1024), hh = vtr(vb_ + (4 * dh + d) * 16384 + (8 * sb + s) * 1024 + 512); vf[s] = (bf16x8){lo[0], lo[1], lo[2], lo[3], hh[0], hh[1], hh[2], hh[3]}; }
#pragma unroll
                for (int s = 0; s < 8; ++s) oA[d] = __builtin_amdgcn_mfma_f32_32x32x16_bf16(vf[s], pf[8 * sb + s], oA[d], 0, 0, 0); } }
#pragma unroll
        for (int d = 0; d < 4; ++d)
#pragma unroll
            for (int g = 0; g < 4; ++g) { v2u v; v.x = cvtpk(oA[d][4 * g] * il, oA[d][4 * g + 1] * il); v.y = cvtpk(oA[d][4 * g + 2] * il, oA[d][4 * g + 3] * il); *(GAS v2u*)(orow + 128 * dh + 32 * d + 8 * g + 4 * hi) = v; }
    }
}
__device__ __forceinline__ void cross_phase(const AttnP& PC, LAS unsigned char* lds, int tid, int wave, int lane, int vcu, int G) {
#pragma unroll 1
    for (int i = vcu; i < 512; i += G) { const int bh = i >> 5; cross_unit2(PC, bh >> 2, bh & 3, i & 31, lds, wave); }
}


__device__ __forceinline__ float vmax2(float a, float b) { float r; asm("v_max_f32_e32 %0, %1, %2" : "=v"(r) : "v"(a), "v"(b)); return r; }
__device__ __forceinline__ float vmin2(float a, float b) { float r; asm("v_min_f32_e32 %0, %1, %2" : "=v"(r) : "v"(a), "v"(b)); return r; }
__device__ __forceinline__ void pad16(float (&a)[16]) {
    asm volatile("s_nop 1" : "+v"(a[0]), "+v"(a[1]), "+v"(a[2]), "+v"(a[3]), "+v"(a[4]), "+v"(a[5]), "+v"(a[6]), "+v"(a[7]), "+v"(a[8]), "+v"(a[9]), "+v"(a[10]), "+v"(a[11]), "+v"(a[12]), "+v"(a[13]), "+v"(a[14]), "+v"(a[15]));
}
__device__ __forceinline__ void sort16_desc(float (&a)[16]) {
#pragma unroll
    for (int k = 2; k <= 16; k <<= 1)
#pragma unroll
        for (int j = k >> 1; j > 0; j >>= 1)
#pragma unroll
            for (int i = 0; i < 16; ++i) { const int l = i ^ j; if (l > i) { const bool desc = ((i & k) == 0); const float hi_ = vmax2(a[i], a[l]), lo_ = vmin2(a[i], a[l]); a[i] = desc ? hi_ : lo_; a[l] = desc ? lo_ : hi_; } }
}
__device__ __forceinline__ void merge16_desc(float (&a)[16], const float (&b)[16]) {
#pragma unroll
    for (int i = 0; i < 16; ++i) a[i] = vmax2(a[i], b[15 - i]);
#pragma unroll
    for (int j = 8; j > 0; j >>= 1)
#pragma unroll
        for (int i = 0; i < 16; ++i) { const int l = i ^ j; if (l > i) { const float hi_ = vmax2(a[i], a[l]), lo_ = vmin2(a[i], a[l]); a[i] = hi_; a[l] = lo_; } }
}
__device__ __forceinline__ void top16_of_64(float (&g0)[16], float (&g1)[16], float (&g2)[16], float (&g3)[16]) {
    sort16_desc(g0); sort16_desc(g1); merge16_desc(g0, g1); sort16_desc(g2); sort16_desc(g3); merge16_desc(g2, g3); merge16_desc(g0, g2);
}
__device__ __forceinline__ float embed(float v, unsigned mask, unsigned id) { return __builtin_bit_cast(float, (__builtin_bit_cast(unsigned, v) & mask) | id); }
__device__ __forceinline__ float mkcand(float x, float y, unsigned id) { return embed(x + y, 0xFFFFFF00u, id); }

__device__ __forceinline__ void swap32(float& a, float& b) { asm volatile("v_nop\n\tv_nop\n\tv_permlane32_swap_b32 %0, %1" : "+v"(a), "+v"(b)); }
struct RouteP { const GAS bf16* QP; const GAS bf16* keys; GAS int* EX; GAS float* GW; };
constexpr int RT_KP = 144, RT_KEYS = 0, RT_SCR = 256 * RT_KP, RT_END = RT_SCR + 8 * 8192;
__device__ __forceinline__ void route_phase(const RouteP& P, LAS unsigned char* lds, int tid, int wave, int lane, int vcu, int G) {
    asm volatile("" : "+v"(tid), "+v"(lane));
    __syncthreads();
    for (int c = tid; c < 256 * 8; c += 512) { const int row = c >> 3, part = c & 7; *(LAS u32x4*)(lds + RT_KEYS + row * RT_KP + part * 16) = *(const u32x4*)(P.keys + row * 64 + part * 8); }
    __syncthreads();
    const int r32 = lane & 31, hi = lane >> 5;
    LAS int* scr = (LAS int*)(lds + RT_SCR + wave * 8192);
    for (int u = vcu; u < T / 32; u += G) {
        const size_t t = (size_t)u * 32 + r32; const int h = wave;
        float T2[2][16];
#pragma unroll
        for (int c = 0; c < 2; ++c) {
            bf16x8 qf[4];
            { const GAS bf16* q = P.QP + t * 1024 + h * 128 + c * 64 + 8 * hi;
#pragma unroll
              for (int s = 0; s < 4; ++s) qf[s] = *(const GAS bf16x8*)(q + 16 * s); }
            f32x16 sc[4];
#pragma unroll
            for (int m = 0; m < 4; ++m) {
#pragma unroll
                for (int r = 0; r < 16; ++r) sc[m][r] = 0.f;
#pragma unroll
                for (int s = 0; s < 4; ++s) { const bf16x8 a = *(const LAS bf16x8*)(lds + RT_KEYS + (c * 128 + 32 * m + r32) * RT_KP + s * 32 + hi * 16);
                    sc[m] = __builtin_amdgcn_mfma_f32_32x32x16_bf16(a, qf[s], sc[m], 0, 0, 0); }
            }
            float g0[16], g1[16], g2[16], g3[16];
            const unsigned h4 = 4u * (unsigned)hi;
#pragma unroll
            for (int r = 0; r < 16; ++r) { const unsigned kr_ = (unsigned)((r & 3) + 8 * (r >> 2));
                g0[r] = embed(sc[0][r], 0xFFFFFF80u, kr_ | h4); g1[r] = embed(sc[1][r], 0xFFFFFF80u, (32u + kr_) | h4); g2[r] = embed(sc[2][r], 0xFFFFFF80u, (64u + kr_) | h4); g3[r] = embed(sc[3][r], 0xFFFFFF80u, (96u + kr_) | h4); }
            top16_of_64(g0, g1, g2, g3);
            pad16(g0);
#pragma unroll
            for (int i = 0; i < 16; ++i) T2[c][i] = g0[i];
        }
        float A[16], Bv[16];
#pragma unroll
        for (int i = 0; i < 16; ++i) { A[i] = T2[0][i]; Bv[i] = T2[1][i]; swap32(A[i], Bv[i]); }
        merge16_desc(A, Bv);
        pad16(A);
        float T0[16], T1[16];
#pragma unroll
        for (int i = 0; i < 16; ++i) { T0[i] = A[i]; T1[i] = A[i]; swap32(T0[i], T1[i]); }
#pragma unroll
        for (int i = 0; i < 16; ++i) { scr[i * 64 + lane] = (int)(__builtin_bit_cast(unsigned, T0[i]) & 127u); scr[(16 + i) * 64 + lane] = (int)(__builtin_bit_cast(unsigned, T1[i]) & 127u);
            T0[i] = embed(T0[i], 0xFFFFFF80u, 0u); T1[i] = embed(T1[i], 0xFFFFFF80u, 0u); }
        float c0[16], c1[16], c2[16], c3[16];
        const float NINF = -__builtin_inff();
#pragma unroll
        for (int b = 0; b < 16; ++b) c0[b] = mkcand(T0[0], T1[b], (unsigned)b);
#pragma unroll
        for (int b = 0; b < 8; ++b) c1[b] = mkcand(T0[1], T1[b], 16u + b);
#pragma unroll
        for (int b = 0; b < 5; ++b) c1[8 + b] = mkcand(T0[2], T1[b], 32u + b);
#pragma unroll
        for (int b = 0; b < 3; ++b) c1[13 + b] = mkcand(T0[4], T1[b], 64u + b);
#pragma unroll
        for (int b = 0; b < 4; ++b) c2[b] = mkcand(T0[3], T1[b], 48u + b);
        c2[4] = mkcand(T0[5], T1[0], 80u); c2[5] = mkcand(T0[5], T1[1], 81u); c2[6] = mkcand(T0[6], T1[0], 96u); c2[7] = mkcand(T0[6], T1[1], 97u); c2[8] = mkcand(T0[7], T1[0], 112u); c2[9] = mkcand(T0[7], T1[1], 113u);
#pragma unroll
        for (int a = 8; a < 14; ++a) c2[10 + a - 8] = mkcand(T0[a], T1[0], 16u * a);
        c3[0] = mkcand(T0[14], T1[0], 224u); c3[1] = mkcand(T0[15], T1[0], 240u);
#pragma unroll
        for (int i = 2; i < 16; ++i) c3[i] = NINF;
        top16_of_64(c0, c1, c2, c3);
        pad16(c0);
        float gsum = 0.f, ge[16]; int ex[16];
        const float mtop = embed(c0[0], 0xFFFFFF00u, 0u);
#pragma unroll
        for (int i = 0; i < 16; ++i) { const unsigned bits = __builtin_bit_cast(unsigned, c0[i]); const int a = (bits >> 4) & 15, b = bits & 15;
            ge[i] = __builtin_amdgcn_exp2f((embed(c0[i], 0xFFFFFF00u, 0u) - mtop) * LOG2E); gsum += ge[i];
            ex[i] = scr[a * 64 + lane] * 128 + scr[(16 + b) * 64 + lane]; }
        const float ginv = __builtin_amdgcn_rcpf(gsum);
        if (hi == 0) { GAS unsigned short* d = (GAS unsigned short*)P.EX + t * 128 + h * 16;
#pragma unroll
            for (int i = 0; i < 16; ++i) d[i] = (unsigned short)ex[i]; }
        else { GAS f32x4* d = (GAS f32x4*)(P.GW + t * 128 + h * 16);
#pragma unroll
            for (int i = 0; i < 4; ++i) d[i] = (f32x4){ge[4 * i] * ginv, ge[4 * i + 1] * ginv, ge[4 * i + 2] * ginv, ge[4 * i + 3] * ginv}; }
    }
}

__device__ __forceinline__ int wave_allsum_i(int v) {
    v += __builtin_amdgcn_update_dpp(0, v, 0xB1, 0xF, 0xF, true);
    v += __builtin_amdgcn_update_dpp(0, v, 0x4E, 0xF, 0xF, true);
    v += __builtin_amdgcn_update_dpp(0, v, 0x141, 0xF, 0xF, true);
    v += __builtin_amdgcn_update_dpp(0, v, 0x140, 0xF, 0xF, true);
    { int a = v, b = v; asm volatile("v_nop\n\tv_nop\n\tv_permlane16_swap_b32 %0, %1" : "+v"(a), "+v"(b)); v = a + b; }
    { int a = v, b = v; asm volatile("v_nop\n\tv_nop\n\tv_permlane32_swap_b32 %0, %1" : "+v"(a), "+v"(b)); v = a + b; }
    return v;
}
__device__ __forceinline__ float wave_allsum(float v) {
    v += __builtin_bit_cast(float, __builtin_amdgcn_update_dpp(0, __builtin_bit_cast(int, v), 0xB1, 0xF, 0xF, true));
    v += __builtin_bit_cast(float, __builtin_amdgcn_update_dpp(0, __builtin_bit_cast(int, v), 0x4E, 0xF, 0xF, true));
    v += __builtin_bit_cast(float, __builtin_amdgcn_update_dpp(0, __builtin_bit_cast(int, v), 0x141, 0xF, 0xF, true));
    v += __builtin_bit_cast(float, __builtin_amdgcn_update_dpp(0, __builtin_bit_cast(int, v), 0x140, 0xF, 0xF, true));
    { float a = v, b = v; asm volatile("v_nop\n\tv_nop\n\tv_permlane16_swap_b32 %0, %1" : "+v"(a), "+v"(b)); v = a + b; }
    { float a = v, b = v; asm volatile("v_nop\n\tv_nop\n\tv_permlane32_swap_b32 %0, %1" : "+v"(a), "+v"(b)); v = a + b; }
    return v;
}
__device__ __forceinline__ float wave_allmax(float v) {
    v = fmaxf(v, __builtin_bit_cast(float, __builtin_amdgcn_update_dpp(0, __builtin_bit_cast(int, v), 0xB1, 0xF, 0xF, true)));
    v = fmaxf(v, __builtin_bit_cast(float, __builtin_amdgcn_update_dpp(0, __builtin_bit_cast(int, v), 0x4E, 0xF, 0xF, true)));
    v = fmaxf(v, __builtin_bit_cast(float, __builtin_amdgcn_update_dpp(0, __builtin_bit_cast(int, v), 0x141, 0xF, 0xF, true)));
    v = fmaxf(v, __builtin_bit_cast(float, __builtin_amdgcn_update_dpp(0, __builtin_bit_cast(int, v), 0x140, 0xF, 0xF, true)));
    { float a = v, b = v; asm volatile("v_nop\n\tv_nop\n\tv_permlane16_swap_b32 %0, %1" : "+v"(a), "+v"(b)); v = fmaxf(a, b); }
    { float a = v, b = v; asm volatile("v_nop\n\tv_nop\n\tv_permlane32_swap_b32 %0, %1" : "+v"(a), "+v"(b)); v = fmaxf(a, b); }
    return v;
}
__device__ __forceinline__ unsigned q4(float a, float b, float c, float d, int off) {
    const int ia = (int)__builtin_rintf(a) + off, ib = (int)__builtin_rintf(b) + off, ic = (int)__builtin_rintf(c) + off, id = (int)__builtin_rintf(d) + off;
    return (unsigned)(ia & 255) | ((unsigned)(ib & 255) << 8) | ((unsigned)(ic & 255) << 16) | ((unsigned)(id & 255) << 24);
}
__device__ __forceinline__ void quant_row(const GAS float* src, GAS unsigned* dst, GAS float* scale, int off, int lane) {
    const GAS f32x4* s = (const GAS f32x4*)src + 4 * lane; f32x4 v[4]; float m = 0.f;
#pragma unroll
    for (int i = 0; i < 4; ++i) { v[i] = s[i]; m = fmaxf(m, fmaxf(fmaxf(__builtin_fabsf(v[i].x), __builtin_fabsf(v[i].y)), fmaxf(__builtin_fabsf(v[i].z), __builtin_fabsf(v[i].w)))); }
    m = wave_allmax(m); const float inv = m > 0.f ? 127.f / m : 0.f;
    v4u w;
    w.x = q4(v[0].x * inv, v[0].y * inv, v[0].z * inv, v[0].w * inv, off); w.y = q4(v[1].x * inv, v[1].y * inv, v[1].z * inv, v[1].w * inv, off);
    w.z = q4(v[2].x * inv, v[2].y * inv, v[2].z * inv, v[2].w * inv, off); w.w = q4(v[3].x * inv, v[3].y * inv, v[3].z * inv, v[3].w * inv, off);
    *((GAS v4u*)dst + lane) = w;
    if (lane == 0) *scale = m * (1.f / 127.f);
}
struct PeerS { int nslices_step, first_slice, nloc, rank; };
__device__ __forceinline__ PeerS peer_sched(const GAS unsigned* rankw, int xcc, int rank) {
    const int lane = lane_id_v();
    const int c = lane < 16 ? (int)__hip_atomic_load(rankw + 64 * lane, __ATOMIC_RELAXED, __HIP_MEMORY_SCOPE_AGENT) : 0;
    const unsigned long long m = __builtin_amdgcn_ballot_w64(c > 0);
    const int nx = __builtin_popcountll(m), myidx = __builtin_popcountll(m & ((1ull << xcc) - 1ull));
    const int cm = __builtin_amdgcn_readlane(c, xcc);
    PeerS s; s.nslices_step = nx > 0 ? nx : 1; s.first_slice = myidx; s.nloc = cm > 0 ? cm : 1; s.rank = rank; return s;
}
struct Peer1P { const GAS unsigned GAS char* HQ; const GAS int* EX; const GAS unsigned GAS char* U8; GAS int* P; };
__device__ __forceinline__ void peer_k1(const Peer1P& Q, const PeerS& sc, int wave, int lane) {
    asm volatile("" : "+v"(lane));
    const int g = lane >> 3, j = lane & 7;
    for (int s = sc.first_slice; s < 8; s += sc.nslices_step)
        for (int tile = sc.rank; tile < T / 64; tile += sc.nloc) {
            const size_t t0 = (size_t)tile * 64 + wave * 8;
            v4u hqn = *(const GAS v4u*)(Q.HQ + t0 * 1024 + 128 * s + 16 * j), exn[2];
#pragma unroll
            for (int i = 0; i < 2; ++i) exn[i] = *(const GAS v4u*)(Q.EX + t0 * 64 + 8 * g + 4 * i);
#pragma unroll 1
            for (int k = 0; k < 8; ++k) {
                const size_t t = t0 + k;
                const v4u hq = hqn; v4u ex[2];
#pragma unroll
                for (int i = 0; i < 2; ++i) ex[i] = exn[i];
                if (k + 1 < 8) {
                    hqn = *(const GAS v4u*)(Q.HQ + (t + 1) * 1024 + 128 * s + 16 * j);
#pragma unroll
                    for (int i = 0; i < 2; ++i) exn[i] = *(const GAS v4u*)(Q.EX + (t + 1) * 64 + 8 * g + 4 * i);
                }
                v4u uu[16]; const GAS unsigned char* ubase_ = Q.U8 + 128 * s + 16 * j;
#pragma unroll
                for (int i = 0; i < 16; ++i) { const unsigned ew = ((i >> 1) & 3) == 0 ? ex[i >> 3].x : ((i >> 1) & 3) == 1 ? ex[i >> 3].y : ((i >> 1) & 3) == 2 ? ex[i >> 3].z : ex[i >> 3].w; unsigned e; if (i & 1) asm("v_lshrrev_b32 %0, 16, %1" : "=v"(e) : "v"(ew)); else asm("v_and_b32 %0, 0xffff, %1" : "=v"(e) : "v"(ew));
                    uu[i] = *(const GAS v4u*)(ubase_ + (e << 10)); }
                int lo = 0, hi = 0;
#pragma unroll
                for (int i = 0; i < 16; ++i) {
                    int p = __builtin_amdgcn_sdot4((int)uu[i].x, (int)hq.x, 0, false); p = __builtin_amdgcn_sdot4((int)uu[i].y, (int)hq.y, p, false); p = __builtin_amdgcn_sdot4((int)uu[i].z, (int)hq.z, p, false); p = __builtin_amdgcn_sdot4((int)uu[i].w, (int)hq.w, p, false);
                    p += __builtin_amdgcn_update_dpp(0, p, 0xB1, 0xF, 0xF, true); p += __builtin_amdgcn_update_dpp(0, p, 0x4E, 0xF, 0xF, true); p += __builtin_amdgcn_update_dpp(0, p, 0x141, 0xF, 0xF, true);
                    if (i < 8) lo = (j == i) ? p : lo; else hi = (j == i - 8) ? p : hi;
                }
                Q.P[(t * 8 + s) * 64 + 8 * g + j] = (int)__builtin_amdgcn_perm((unsigned)((hi + 32) >> 6), (unsigned)((lo + 32) >> 6), 0x05040100u);
            }
        }
}
__device__ __forceinline__ void peer_w(const GAS int* EX, const GAS float* GW, const GAS int* P, const GAS float* SH, const GAS float* SU, const GAS float* SV, GAS signed char* WQ, GAS float* WSC, int gw, int NGW, int lane) {
    asm volatile("" : "+v"(lane));
    for (int t = gw; t < T; t += NGW) {
        const float sh = SH[t];
#pragma unroll
        for (int q = 0; q < 2; ++q) { const size_t idx = (size_t)t * 128 + lane + 64 * q; const int e = (int)((const GAS unsigned short*)EX)[idx];
            const int slot_ = lane + 64 * q, pix_ = (slot_ >> 4) * 8 + (slot_ & 7), hsel_ = (slot_ >> 3) & 1;
            int pd = 0;
#pragma unroll
            for (int sl = 0; sl < 8; ++sl) { const int pw_ = P[((size_t)t * 8 + sl) * 64 + pix_]; pd += hsel_ ? (pw_ >> 16) : (int)(short)(pw_ & 0xffff); }
            const float w = GW[idx] * gelu_erf((float)pd * (64.f * sh * SU[e])) * SV[e];
            float m = __builtin_fabsf(w);
            m = fmaxf(m, __builtin_bit_cast(float, __builtin_amdgcn_update_dpp(0, __builtin_bit_cast(int, m), 0xB1, 0xF, 0xF, true)));
            m = fmaxf(m, __builtin_bit_cast(float, __builtin_amdgcn_update_dpp(0, __builtin_bit_cast(int, m), 0x4E, 0xF, 0xF, true)));
            m = fmaxf(m, __builtin_bit_cast(float, __builtin_amdgcn_update_dpp(0, __builtin_bit_cast(int, m), 0x141, 0xF, 0xF, true)));
            m = fmaxf(m, __builtin_bit_cast(float, __builtin_amdgcn_update_dpp(0, __builtin_bit_cast(int, m), 0x140, 0xF, 0xF, true)));
            const float inv = m > 0.f ? 127.f / m : 0.f;
            WQ[idx] = (signed char)(int)__builtin_rintf(w * inv);
            if ((lane & 15) == 0) WSC[(size_t)t * 8 + (lane >> 4) + 4 * q] = m * (1.f / 127.f); }
    }
}
__device__ __forceinline__ void tr4x4(unsigned r0, unsigned r1, unsigned r2, unsigned r3, unsigned (&t)[4]) {
    const unsigned x0 = __builtin_amdgcn_perm(r1, r0, 0x05010400u), x1 = __builtin_amdgcn_perm(r1, r0, 0x07030602u), y0 = __builtin_amdgcn_perm(r3, r2, 0x05010400u), y1 = __builtin_amdgcn_perm(r3, r2, 0x07030602u);
    t[0] = __builtin_amdgcn_perm(y0, x0, 0x05040100u); t[1] = __builtin_amdgcn_perm(y0, x0, 0x07060302u); t[2] = __builtin_amdgcn_perm(y1, x1, 0x05040100u); t[3] = __builtin_amdgcn_perm(y1, x1, 0x07060302u);
}
struct Peer2P { const GAS int* EX; const GAS signed char* WQ; const GAS float* WSC; const GAS unsigned char* V8; GAS bf16* XB; GAS float* SSQ; };
__device__ __forceinline__ void peer_k2(const Peer2P& Q, const PeerS& sc, int wave, int lane) {
    asm volatile("" : "+v"(lane));
    const int g = lane >> 3, j = lane & 7, hf = lane >> 5, rp = (lane >> 4) & 1;
    for (int s = sc.first_slice; s < 8; s += sc.nslices_step)
        for (int tile = sc.rank; tile < T / 64; tile += sc.nloc) {
            const size_t t0 = (size_t)tile * 64 + wave * 8;
            v4u exn[2], wqn; float swn;
#pragma unroll
            for (int i = 0; i < 2; ++i) exn[i] = *(const GAS v4u*)(Q.EX + t0 * 64 + 8 * g + 4 * i);
            wqn = *(const GAS v4u*)(Q.WQ + t0 * 128 + 16 * g); swn = Q.WSC[t0 * 8 + g];
#pragma unroll 1
            for (int k = 0; k < 8; ++k) {
                const size_t t = t0 + k;
                v4u ex[2]; const v4u wq = wqn; const float sw = swn;
#pragma unroll
                for (int i = 0; i < 2; ++i) ex[i] = exn[i];
                if (k + 1 < 8) {
#pragma unroll
                    for (int i = 0; i < 2; ++i) exn[i] = *(const GAS v4u*)(Q.EX + (t + 1) * 64 + 8 * g + 4 * i);
                    wqn = *(const GAS v4u*)(Q.WQ + (t + 1) * 128 + 16 * g); swn = Q.WSC[(t + 1) * 8 + g];
                }
                GAS v2u* xp = (GAS v2u*)(Q.XB + t * 1024 + 128 * s + 16 * j + 8 * hf + 4 * rp);
                const v2u xold = *xp;
                v4u vv[16]; const GAS unsigned char* vbase_ = Q.V8 + 128 * s + 16 * j;
#pragma unroll
                for (int i = 0; i < 16; ++i) { const unsigned ew = ((i >> 1) & 3) == 0 ? ex[i >> 3].x : ((i >> 1) & 3) == 1 ? ex[i >> 3].y : ((i >> 1) & 3) == 2 ? ex[i >> 3].z : ex[i >> 3].w; unsigned e; if (i & 1) asm("v_lshrrev_b32 %0, 16, %1" : "=v"(e) : "v"(ew)); else asm("v_and_b32 %0, 0xffff, %1" : "=v"(e) : "v"(ew));
                    vv[i] = *(const GAS v4u*)(vbase_ + (e << 10)); }
                int ai[16];
#pragma unroll
                for (int i = 0; i < 16; ++i) ai[i] = 0;
#pragma unroll
                for (int q4_ = 0; q4_ < 4; ++q4_) {
                    const unsigned wq4 = q4_ == 0 ? wq.x : q4_ == 1 ? wq.y : q4_ == 2 ? wq.z : wq.w;
#pragma unroll
                    for (int c = 0; c < 4; ++c) { unsigned tt[4];
                        const v4u &a0 = vv[4 * q4_], &a1 = vv[4 * q4_ + 1], &a2 = vv[4 * q4_ + 2], &a3 = vv[4 * q4_ + 3];
                        tr4x4(c == 0 ? a0.x : c == 1 ? a0.y : c == 2 ? a0.z : a0.w, c == 0 ? a1.x : c == 1 ? a1.y : c == 2 ? a1.z : a1.w, c == 0 ? a2.x : c == 1 ? a2.y : c == 2 ? a2.z : a2.w, c == 0 ? a3.x : c == 1 ? a3.y : c == 2 ? a3.z : a3.w, tt);
#pragma unroll
                        for (int b = 0; b < 4; ++b) ai[4 * c + b] = __builtin_amdgcn_sdot4((int)tt[b], (int)wq4, ai[4 * c + b], false); }
                }
                float acc[16];
#pragma unroll
                for (int i = 0; i < 16; ++i) acc[i] = (float)ai[i] * sw;
                float r8[8], r4[4];
#pragma unroll
                for (int m = 0; m < 8; ++m) { float a = acc[m], b = acc[m + 8]; swap32(a, b); r8[m] = a + b; }
#pragma unroll
                for (int n = 0; n < 4; ++n) { float a = r8[n], b = r8[n + 4]; asm volatile("v_nop\n\tv_nop\n\tv_permlane16_swap_b32 %0, %1" : "+v"(a), "+v"(b)); r4[n] = a + b; }
#pragma unroll
                for (int n = 0; n < 4; ++n) r4[n] += __builtin_bit_cast(float, __builtin_amdgcn_update_dpp(0, __builtin_bit_cast(int, r4[n]), 0x128, 0xF, 0xF, true));
                v2u xw; xw.x = pk2(bflo(xold.x) + r4[0], bfhi(xold.x) + r4[1]); xw.y = pk2(bflo(xold.y) + r4[2], bfhi(xold.y) + r4[3]);
                float ss = 0.f;
                if ((lane & 8) == 0) { const float x0 = bflo(xw.x), x1 = bfhi(xw.x), x2 = bflo(xw.y), x3 = bfhi(xw.y); ss = (x0 * x0 + x1 * x1) + (x2 * x2 + x3 * x3); *xp = xw; }
                ss = wave_allsum(ss);
                if (Q.SSQ) { if (lane == 0) Q.SSQ[t * 16 + s] = ss; }
            }
        }
}

struct Args { const float* in[33]; float* out; unsigned char* ws; int ph_lo, ph_hi; };
struct Frame { LAS unsigned char* lds; volatile LAS unsigned* MISC; gu32* ctl; int tid, lane, wave, G, vcu, xcc, xrank; };

__device__ __forceinline__ void transpose_item(const float* W, int ldw, int nsrc0, bf16* WT, int ldt, int rdst0, LAS float* scr, int kb, int nb, int lane, float scale, const float* kgain) {
    const int k0 = 64 * kb, n0 = 32 * nb;
#pragma unroll 8
    for (int i = 0; i < 32; ++i) { const int kk = 2 * i + (lane >> 5); const float gsc = kgain ? kgain[k0 + kk] * scale : scale; scr[kk * 33 + (lane & 31)] = W[(size_t)(k0 + kk) * ldw + nsrc0 + n0 + (lane & 31)] * gsc; }
    LDS_WAIT(); asm volatile("" ::: "memory");
    const int c = lane & 7;
#pragma unroll
    for (int j = 0; j < 4; ++j) { const int n = (lane >> 3) + 8 * j; const LAS float* s = scr + (8 * c) * 33 + n;
        v4u o; o.x = pk2(s[0 * 33], s[1 * 33]); o.y = pk2(s[2 * 33], s[3 * 33]); o.z = pk2(s[4 * 33], s[5 * 33]); o.w = pk2(s[6 * 33], s[7 * 33]);
        *(GAS v4u*)(WT + (size_t)(rdst0 + n0 + n) * ldt + k0 + 8 * c) = o; }
    LDS_WAIT(); asm volatile("" ::: "memory");
}
__device__ __forceinline__ void zero_rect(bf16* base, int ld, int row0, int nrows, int col0, int ncols, int gtid, int gthreads) {
    const int vpr = ncols / 8;
    for (int i = gtid; i < nrows * vpr; i += gthreads) { const int r = i / vpr, c = i % vpr; *(GAS v4u*)(base + (size_t)(row0 + r) * ld + col0 + 8 * c) = (v4u){0u, 0u, 0u, 0u}; }
}

__device__ __forceinline__ void p0_prologue(Frame& F, const Args& a) {
    LAS float* scr = (LAS float*)(F.lds + RING_OFF + F.wave * 16384);
    const int gw = blockIdx.x * NWAVES + F.wave, NGW = F.G * NWAVES;
    const int gtid = blockIdx.x * (NWAVES * 64) + F.tid, gthreads = F.G * NWAVES * 64;
    unsigned char* ws = a.ws;
    x0_phase((const GAS float*)a.in[0], (GAS bf16*)(ws + WS_XNB), (GAS float*)(ws + WS_SSQ), gw, NGW, F.lane);
    constexpr int I_IN = 16 * (INW / 32), I_SQ = 16 * 32, I_CKV = 16 * 64, I_UQ = 3 * 12, I_UKV = 2 * 16, I_L = I_IN + 4 * I_SQ + I_CKV + I_UQ + I_UKV;
    for (int it = gw; it < L * I_L; it += NGW) {
        const int l = it / I_L; int r = it % I_L;
        if (r < I_IN) {
            const int kb = r / 67, nb = r % 67; int src, dst; float sc = 1.f;
            if (nb < 6) { src = 32 * nb; dst = src; } else if (nb < 11) { src = 32 * nb; dst = src + 64; } else { src = 32 * nb; dst = src + 160; if (nb >= 43 && nb < 51) sc = 0.17677669529663687f * LOG2E; }
            transpose_item(a.in[5] + (size_t)l * D * INW, INW, src, (bf16*)(ws + WS_WIN) + (size_t)l * INP * D, D, dst, scr, kb, 0, F.lane, sc, a.in[4] + l * D); continue; } r -= I_IN;
        if (r < I_SQ) { transpose_item(a.in[21] + (size_t)l * D * D, D, 0, (bf16*)(ws + WS_WOUT) + (size_t)l * D * D, D, 0, scr, r / 32, r % 32, F.lane, 1.f, nullptr); continue; } r -= I_SQ;
        if (r < I_SQ) { transpose_item(a.in[24] + (size_t)l * D * D, D, 0, (bf16*)(ws + WS_WCQ) + (size_t)l * D * D, D, 0, scr, r / 32, r % 32, F.lane, 0.0625f * LOG2E, a.in[22] + l * D); continue; } r -= I_SQ;
        if (r < I_SQ) { transpose_item(a.in[26] + (size_t)l * D * D, D, 0, (bf16*)(ws + WS_WCO) + (size_t)l * D * D, D, 0, scr, r / 32, r % 32, F.lane, 1.f, nullptr); continue; } r -= I_SQ;
        if (r < I_SQ) { transpose_item(a.in[28] + (size_t)l * D * D, D, 0, (bf16*)(ws + WS_WPQ) + (size_t)l * D * D, D, 0, scr, r / 32, r % 32, F.lane, 1.f, a.in[27] + l * D); continue; } r -= I_SQ;
        if (r < I_CKV) { transpose_item(a.in[25] + (size_t)l * D * 2 * D, 2 * D, 0, (bf16*)(ws + WS_WCKV) + (size_t)l * 2 * D * D, D, 0, scr, r / 64, r % 64, F.lane, 1.f, nullptr); continue; } r -= I_CKV;
        if (r < I_UQ) { transpose_item(a.in[7] + (size_t)l * 192 * 384, 384, 0, (bf16*)(ws + WS_WUQ) + (size_t)l * 512 * 256, 256, 0, scr, r / 12, r % 12, F.lane, 0.10206207261596575f * LOG2E, a.in[6] + l * 192); continue; } r -= I_UQ;
        transpose_item(a.in[9] + (size_t)l * 128 * 512, 512, 0, (bf16*)(ws + WS_WUKV) + (size_t)l * 512 * 256, 256, 0, scr, r / 16, r % 16, F.lane, 1.f, a.in[8] + l * 128);
    }
    for (int l = 0; l < L; ++l) {
        bf16* win = (bf16*)(ws + WS_WIN) + (size_t)l * INP * D; bf16* wuq = (bf16*)(ws + WS_WUQ) + (size_t)l * 512 * 256; bf16* wukv = (bf16*)(ws + WS_WUKV) + (size_t)l * 512 * 256;
        zero_rect(win, D, 192, 64, 0, D, gtid, gthreads); zero_rect(win, D, 416, 96, 0, D, gtid, gthreads);
        zero_rect(wuq, 256, 0, 384, 192, 64, gtid, gthreads); zero_rect(wuq, 256, 384, 128, 0, 256, gtid, gthreads);
        zero_rect(wukv, 256, 0, 512, 128, 128, gtid, gthreads);
    }
    { float* rope = (float*)(ws + WS_ROPE); const int* pos = (const int*)a.in[2];
      for (int i = gtid; i < T * 16; i += gthreads) { const int t = i >> 4, k = i & 15; const float inv = powf(10000.f, -(float)(2 * k) / 32.f); const float ang = (float)pos[t] * inv;
          rope[(size_t)t * 32 + k] = cosf(ang); rope[(size_t)t * 32 + 16 + k] = sinf(ang); } }
    { const GAS f32x4* ks = (const GAS f32x4*)a.in[29]; GAS v2u* kd = (GAS v2u*)(ws + WS_KEYS);
      for (int i = gtid; i < L * 2 * 128 * 64 / 4; i += gthreads) { const f32x4 v = ks[i]; v2u w; w.x = pk2(v.x, v.y); w.y = pk2(v.z, v.w); kd[i] = w; }
    }
    for (int r = gw; r < 2 * L * 16384; r += NGW) { const int tb = r / (L * 16384), rr = r % (L * 16384);
        quant_row((const GAS float*)a.in[30 + tb] + (size_t)rr * 1024, (GAS unsigned*)(ws + (tb ? WS_V8 : WS_U8) + (size_t)rr * 1024), (GAS float*)(ws + (tb ? WS_SV : WS_SU)) + rr, 0, F.lane); }
    { float* btab = (float*)(ws + WS_BTAB); float* lams = (float*)(ws + WS_LAMS); float* spt = (float*)(ws + WS_SP);
      for (int i = gtid; i < 4 * 129; i += gthreads) { const int h = i / 129, n = i % 129; int bu; if (n < 16) bu = n; else { const int lg = 16 + (int)(logf((float)n / 16.f) / logf(8.f) * 16.f); bu = lg < 31 ? lg : 31; }
          btab[i] = a.in[3][bu * 4 + h] * LOG2E; }
      for (int i = gtid; i < L; i += gthreads) { const float* dl = a.in[17] + i * 128; float s1 = 0.f, s2 = 0.f; for (int j = 0; j < 32; ++j) { s1 += dl[j] * dl[32 + j]; s2 += dl[64 + j] * dl[96 + j]; }
          const float li = 0.8f - 0.6f * expf(-0.3f * (float)i); lams[2 * i] = expf(s1) - expf(s2) + li; lams[2 * i + 1] = li; }
      for (int i = gtid; i < L * 512; i += gthreads) spt[i] = log1pf(expf(-a.in[16][i])); }
    { GAS bf16* wat = (GAS bf16*)(ws + WS_WAT);
      for (int i = gtid; i < L * 8 * 2 * 4096; i += gthreads) { const int in_ = i & 63, out_ = (i >> 6) & 63, gate = (i >> 12) & 1, lg = i >> 13;
          wat[i] = (bf16)f2bf_(a.in[gate ? 14 : 12][(size_t)lg * 4096 + in_ * 64 + out_]); } }
    for (int l = 0; l < L; ++l) norm_phase((const GAS float*)a.in[1], (const GAS float*)a.in[23] + l * D, (GAS bf16*)(ws + WS_MNB) + (size_t)l * NB * MEM * D, NB * MEM, gw, NGW, F.lane);
}

constexpr int NPL = 16, PH_FINAL = 2 + NPL * L;
__global__ void __launch_bounds__(NWAVES * 64, 2) fwd(Args args) {
    extern __shared__ __attribute__((aligned(16))) unsigned char lds[];
    Frame F;
    F.lds = (LAS unsigned char*)lds; F.MISC = (volatile LAS unsigned*)(F.lds + MISC_OFF);
    F.tid = threadIdx.x; F.lane = F.tid & 63; F.wave = __builtin_amdgcn_readfirstlane(F.tid >> 6); F.G = gridDim.x;
    F.vcu = (F.G % 8 == 0) ? ((int)blockIdx.x % 8) * (F.G / 8) + (int)blockIdx.x / 8 : (int)blockIdx.x;
    unsigned char* ws = args.ws;
    F.ctl = (gu32*)(opq(ws) + WS_CTL);
    for (int u = F.tid; u < (LDS_BYTES - LDSCTL_OFF) / 4; u += NWAVES * 64) ((LAS unsigned*)(F.lds + LDSCTL_OFF))[u] = 0u;
    __syncthreads();
    XcdBarrier bar = xcd_barrier_post((unsigned*)(F.ctl + CW_BAR), F.MISC + 8);
    F.xcc = (int)bar.x;
    if (F.tid == 0) F.MISC[12] = __hip_atomic_fetch_add((unsigned*)(F.ctl + CW_RANK) + 64 * bar.x, 1u, __ATOMIC_RELAXED, __HIP_MEMORY_SCOPE_AGENT);
    __syncthreads();
    F.xrank = __builtin_amdgcn_readfirstlane((int)F.MISC[12]);
    const int lo = args.ph_lo, hi = args.ph_hi;
    const int gw = blockIdx.x * NWAVES + F.wave, NGW = F.G * NWAVES;
#define IN(k) (lo <= (k) && (k) < hi)
#define LANE_ (lane_id_v())
#define TID_ ((opqi(F.wave) << 6) | LANE_)
#define SITE() const int G_ = opqi(F.G), wv_ = opqi(F.wave), vcu_ = opqi(F.vcu), gw_ = opqi(gw), NGW_ = opqi(NGW); (void)G_; (void)wv_; (void)vcu_; (void)gw_; (void)NGW_
#if MK_DUP == 99
#define SEAM(k) do { if (IN(k) && IN((k) + 1)) { xcd_barrier(bar, (F.wave == 0 && lane_id_v() == 0) ? 1 : 0); xcd_barrier(bar, (F.wave == 0 && lane_id_v() == 0) ? 1 : 0); } } while (0)
#else
#define SEAM(k) do { if (IN(k) && IN((k) + 1)) xcd_barrier(bar, (F.wave == 0 && lane_id_v() == 0) ? 1 : 0); } while (0)
#endif
#define GEMM_SITE(EPI, Aptr, lda_, Bptr, ldb_, M_, N_, K_, cperm, ...) do { \
        pg8::Gemm g{opq(Aptr), opq(Bptr), M_, N_, K_, lda_, ldb_}; pg8::StaticOrder So; So.init(M_, N_, opqi(F.G), opqi(cperm)); pg8::EPI E{__VA_ARGS__}; \
        pg8::gemm_phase<pg8::EPI, pg8::StaticOrder, true, true>(F.lds + RING_OFF, g, So, E, opqi(F.wave)); } while (0)
    if (IN(0)) { p0_prologue(F, args); }
    SEAM(0);
    if (IN(1)) {
#pragma unroll 1
        for (int l = 0; l < L; ++l)
            GEMM_SITE(EpiBf16, (const GAS bf16*)(opq(ws) + WS_MNB) + (size_t)l * NB * MEM * D, D, (const GAS bf16*)(opq(ws) + WS_WCKV) + (size_t)l * 2 * D * D, D, NB * MEM, 2 * D, D, (int)((blockIdx.x + 64 * l) % F.G),
                      opq((GAS bf16*)(opq(ws) + WS_KVCB) + (size_t)l * NB * MEM * 2 * D), 2 * D, 2 * D, (const GAS float*)nullptr, 0);
    }
    SEAM(1);
    for (int l = 0; l < L; ++l) {
        const int pb = 2 + NPL * l;
        const GAS bf16* XNB = (const GAS bf16*)(opq(ws) + WS_XNB); const GAS bf16* YB = (const GAS bf16*)(opq(ws) + WS_YB); GAS bf16* PROJB = (GAS bf16*)(opq(ws) + WS_PROJB);
        if (IN(pb + 1)) GEMM_SITE(EpiBf16, XNB, D, (const GAS bf16*)(opq(ws) + WS_WIN) + (size_t)l * INP * D, D, T, INP, D, (int)blockIdx.x, opq(PROJB), INP, INP, opq((const GAS float*)(opq(ws) + WS_SSQ)), 8);
#if MK_DUP == 1
        if (IN(pb + 1)) GEMM_SITE(EpiBf16, XNB, D, (const GAS bf16*)(opq(ws) + WS_WIN) + (size_t)l * INP * D, D, T, INP, D, (int)blockIdx.x, opq(PROJB), INP, INP, opq((const GAS float*)(opq(ws) + WS_SSQ)), 8);
#endif
        SEAM(pb + 1);
        if (IN(pb + 2)) {
            SITE();
            pre_phase(opq((const GAS bf16*)PROJB), opq((const GAS float*)(opq(ws) + WS_ROPE)), opq((GAS float*)(opq(ws) + WS_RS)), opq((GAS bf16*)(opq(ws) + WS_KMB)), gw_, NGW_, LANE_);
#if MK_DUP == 21
            pre_phase(opq((const GAS bf16*)PROJB), opq((const GAS float*)(opq(ws) + WS_ROPE)), opq((GAS float*)(opq(ws) + WS_RS)), opq((GAS bf16*)(opq(ws) + WS_KMB)), gw_, NGW_, LANE_);
#endif
            LruP LP{opq((const GAS bf16*)PROJB), (const GAS float*)args.in[opqi(10)] + l * 4 * 512, (const GAS float*)args.in[opqi(11)] + l * 512, opq((const GAS bf16*)(opq(ws) + WS_WAT)) + (size_t)l * 8 * 2 * 4096, (const GAS float*)args.in[opqi(13)] + l * 512, (const GAS float*)args.in[opqi(15)] + l * 512,
                    (const GAS float*)(opq(ws) + WS_SP) + l * 512, opq((GAS unsigned*)(opq(ws) + WS_HLB)), opq((GAS float*)(opq(ws) + WS_LSUM))};
            lru_phase(LP, F.lds, TID_, wv_, LANE_, vcu_, G_);
#if MK_DUP == 2
            lru_phase(LP, F.lds, TID_, wv_, LANE_, vcu_, G_);
#endif
        }
        SEAM(pb + 2);
        if (IN(pb + 3)) {
            GEMM_SITE(EpiUp, (const GAS bf16*)PROJB + PC_CQ, INP, (const GAS bf16*)(opq(ws) + WS_WUQ) + (size_t)l * 512 * 256, 256, T, 512, 256, (int)blockIdx.x,
                      opq((GAS bf16*)(opq(ws) + WS_QMB)), (GAS bf16*)nullptr, 384, 384, opq((const GAS float*)(opq(ws) + WS_RS)), 0, 0);
            GEMM_SITE(EpiUp, (const GAS bf16*)PROJB + PC_CKV, INP, (const GAS bf16*)(opq(ws) + WS_WUKV) + (size_t)l * 512 * 256, 256, T, 512, 256, (int)blockIdx.x,
                      opq((GAS bf16*)(opq(ws) + WS_KMB)), opq((GAS bf16*)(opq(ws) + WS_VMB)), 0, 512, opq((const GAS float*)(opq(ws) + WS_RS)), 1, 1);
#if MK_DUP == 3
            GEMM_SITE(EpiUp, (const GAS bf16*)PROJB + PC_CQ, INP, (const GAS bf16*)(opq(ws) + WS_WUQ) + (size_t)l * 512 * 256, 256, T, 512, 256, (int)blockIdx.x,
                      opq((GAS bf16*)(opq(ws) + WS_QMB)), (GAS bf16*)nullptr, 384, 384, opq((const GAS float*)(opq(ws) + WS_RS)), 0, 0);
            GEMM_SITE(EpiUp, (const GAS bf16*)PROJB + PC_CKV, INP, (const GAS bf16*)(opq(ws) + WS_WUKV) + (size_t)l * 512 * 256, 256, T, 512, 256, (int)blockIdx.x,
                      opq((GAS bf16*)(opq(ws) + WS_KMB)), opq((GAS bf16*)(opq(ws) + WS_VMB)), 0, 512, opq((const GAS float*)(opq(ws) + WS_RS)), 1, 1);
#endif
        }
        SEAM(pb + 3);
        if (IN(pb + 4)) {
            SITE();
            AttnP PM{opq((const GAS bf16*)(opq(ws) + WS_QMB)), opq((const GAS bf16*)(opq(ws) + WS_KMB)), opq((const GAS bf16*)(opq(ws) + WS_VMB)), 384, 384, 256, opq((GAS bf16*)(opq(ws) + WS_OMB)), 256, opq((const GAS float*)(opq(ws) + WS_ROPE)), nullptr, nullptr, nullptr, nullptr};
            AttnP PD{opq((const GAS bf16*)PROJB + PC_QD), opq((const GAS bf16*)PROJB + PC_KD), opq((const GAS bf16*)PROJB + PC_VD), INP, INP, INP, opq((GAS bf16*)(opq(ws) + WS_YB) + 768), 1024, nullptr,
                     (const GAS int*)args.in[opqi(2)], (const GAS float*)(opq(ws) + WS_BTAB), (const GAS float*)args.in[opqi(18)] + l * 64, (const GAS float*)(opq(ws) + WS_LAMS) + 2 * l};
            attn_phase(PM, PD, F.lds, TID_, wv_, LANE_, vcu_, G_);
#if MK_DUP == 4
            __syncthreads(); attn_phase(PM, PD, F.lds, TID_, wv_, LANE_, vcu_, G_);
#elif MK_DUP == 40 || MK_DUP == 41
            __syncthreads(); attn_phase(PM, PD, F.lds, TID_, wv_, LANE_, vcu_, G_, MK_DUP - 40);
#endif
        }
        SEAM(pb + 4);
        if (IN(pb + 5)) {
            SITE();
            PostP PP{opq((const GAS bf16*)(opq(ws) + WS_OMB)), opq((const GAS unsigned*)(opq(ws) + WS_HLB)), opq((const GAS float*)(opq(ws) + WS_LSUM)), opq((const GAS bf16*)PROJB), (const GAS float*)args.in[opqi(19)] + l * 256, (const GAS float*)args.in[opqi(20)] + l * 512, opq((GAS bf16*)(opq(ws) + WS_YB))};
            post_phase(PP, F.lds, TID_, wv_, LANE_, vcu_, G_);
#if MK_DUP == 5
            __syncthreads(); post_phase(PP, F.lds, TID_, wv_, LANE_, vcu_, G_);
#endif
        }
        SEAM(pb + 5);
        if (IN(pb + 6)) GEMM_SITE(EpiRes, YB, D, (const GAS bf16*)(opq(ws) + WS_WOUT) + (size_t)l * D * D, D, T, D, D, (int)blockIdx.x, opq((GAS bf16*)(opq(ws) + WS_XNB)), opq((GAS float*)(opq(ws) + WS_SSQ)));
#if MK_DUP == 6
        if (IN(pb + 6)) GEMM_SITE(EpiRes, YB, D, (const GAS bf16*)(opq(ws) + WS_WOUT) + (size_t)l * D * D, D, T, D, D, (int)blockIdx.x, opq((GAS bf16*)(opq(ws) + WS_HLB)), opq((GAS float*)(opq(ws) + WS_OMB)));
#endif
        SEAM(pb + 6);
        if (IN(pb + 8)) GEMM_SITE(EpiBf16, XNB, D, (const GAS bf16*)(opq(ws) + WS_WCQ) + (size_t)l * D * D, D, T, D, D, (int)blockIdx.x, opq(PROJB), D, D, opq((const GAS float*)(opq(ws) + WS_SSQ)), 16);
#if MK_DUP == 8
        if (IN(pb + 8)) GEMM_SITE(EpiBf16, XNB, D, (const GAS bf16*)(opq(ws) + WS_WCQ) + (size_t)l * D * D, D, T, D, D, (int)blockIdx.x, opq(PROJB), D, D, opq((const GAS float*)(opq(ws) + WS_SSQ)), 16);
#endif
        SEAM(pb + 8);
        if (IN(pb + 9)) {
            SITE();
            const GAS bf16* kv = (const GAS bf16*)(opq(ws) + WS_KVCB) + (size_t)l * NB * MEM * 2 * D;
            AttnP PC{opq((const GAS bf16*)PROJB), opq(kv), opq(kv + D), 1024, 2 * D, 2 * D, opq((GAS bf16*)(opq(ws) + WS_YB)), 1024, nullptr, nullptr, nullptr, nullptr, nullptr};
            cross_phase(PC, F.lds, TID_, wv_, LANE_, vcu_, G_);
#if MK_DUP == 9
            cross_phase(PC, F.lds, TID_, wv_, LANE_, vcu_, G_);
#endif
        }
        SEAM(pb + 9);
        if (IN(pb + 10)) GEMM_SITE(EpiRes, YB, D, (const GAS bf16*)(opq(ws) + WS_WCO) + (size_t)l * D * D, D, T, D, D, (int)blockIdx.x, opq((GAS bf16*)(opq(ws) + WS_XNB)), opq((GAS float*)(opq(ws) + WS_SSQ)));
        SEAM(pb + 10);
        if (IN(pb + 12)) { GEMM_SITE(EpiBf16, XNB, D, (const GAS bf16*)(opq(ws) + WS_WPQ) + (size_t)l * D * D, D, T, D, D, (int)blockIdx.x, opq(PROJB), D, D, opq((const GAS float*)(opq(ws) + WS_SSQ)), 16);
            SITE(); hq_phase(opq(XNB), opq((const GAS float*)(opq(ws) + WS_SSQ)), (const GAS float*)args.in[opqi(27)] + l * D, opq((GAS unsigned char*)(opq(ws) + WS_HQ)), opq((GAS float*)(opq(ws) + WS_SH)), opq((GAS int*)(opq(ws) + WS_P)), gw_, NGW_, LANE_);
#if MK_DUP == 12
            hq_phase(opq(XNB), opq((const GAS float*)(opq(ws) + WS_SSQ)), (const GAS float*)args.in[opqi(27)] + l * D, opq((GAS unsigned char*)(opq(ws) + WS_HQ)), opq((GAS float*)(opq(ws) + WS_SH)), opq((GAS int*)(opq(ws) + WS_P)), gw_, NGW_, LANE_);
#endif
            }
        SEAM(pb + 12);
        if (IN(pb + 13)) {
            SITE();
            RouteP RP{opq((const GAS bf16*)PROJB), opq((const GAS bf16*)(opq(ws) + WS_KEYS) + (size_t)l * 2 * 128 * 64), opq((GAS int*)(opq(ws) + WS_EX)), opq((GAS float*)(opq(ws) + WS_GW))};
            route_phase(RP, F.lds, TID_, wv_, LANE_, vcu_, G_);
#if MK_DUP == 13
            route_phase(RP, F.lds, TID_, wv_, LANE_, vcu_, G_);
#endif
        }
        SEAM(pb + 13);
        if (IN(pb + 14)) {
            SITE();
            const PeerS ps = peer_sched((const GAS unsigned*)(F.ctl + CW_RANK), opqi(F.xcc), opqi(F.xrank));
            Peer1P Q1{opq((const GAS unsigned char*)(opq(ws) + WS_HQ)), opq((const GAS int*)(opq(ws) + WS_EX)), opq((const GAS unsigned char*)(opq(ws) + WS_U8) + (size_t)l * 16384 * 1024), opq((GAS int*)(opq(ws) + WS_PROJB))};
            peer_k1(Q1, ps, wv_, LANE_);
#if MK_DUP == 141
            { Peer1P Q1b = Q1; Q1b.P = (GAS int*)(opq(ws) + WS_HLB); peer_k1(Q1b, ps, wv_, LANE_); }
#endif
        }
        SEAM(pb + 14);
        if (IN(pb + 15)) {
            SITE();
            peer_w(opq((const GAS int*)(opq(ws) + WS_EX)), opq((const GAS float*)(opq(ws) + WS_GW)), opq((const GAS int*)(opq(ws) + WS_PROJB)), opq((const GAS float*)(opq(ws) + WS_SH)), opq((const GAS float*)(opq(ws) + WS_SU) + l * 16384), opq((const GAS float*)(opq(ws) + WS_SV) + l * 16384),
                   opq((GAS signed char*)(opq(ws) + WS_W)), opq((GAS float*)(opq(ws) + WS_WS)), gw_, NGW_, LANE_);
#if MK_DUP == 150
            peer_w(opq((const GAS int*)(opq(ws) + WS_EX)), opq((const GAS float*)(opq(ws) + WS_GW)), opq((const GAS int*)(opq(ws) + WS_PROJB)), opq((const GAS float*)(opq(ws) + WS_SH)), opq((const GAS float*)(opq(ws) + WS_SU) + l * 16384), opq((const GAS float*)(opq(ws) + WS_SV) + l * 16384),
                   opq((GAS signed char*)(opq(ws) + WS_W)), opq((GAS float*)(opq(ws) + WS_WS)), gw_, NGW_, LANE_);
#endif
            xcd_barrier(bar, (F.wave == 0 && lane_id_v() == 0) ? 1 : 0);
            const PeerS ps = peer_sched((const GAS unsigned*)(F.ctl + CW_RANK), opqi(F.xcc), opqi(F.xrank));
            Peer2P Q2{opq((const GAS int*)(opq(ws) + WS_EX)), opq((const GAS signed char*)(opq(ws) + WS_W)), opq((const GAS float*)(opq(ws) + WS_WS)), opq((const GAS unsigned char*)(opq(ws) + WS_V8) + (size_t)l * 16384 * 1024), opq((GAS bf16*)(opq(ws) + WS_XNB)), opq((GAS float*)(opq(ws) + WS_SSQ))};
            peer_k2(Q2, ps, wv_, LANE_);
#if MK_DUP == 151
            { Peer2P Q2b = Q2; Q2b.XB = (GAS bf16*)(opq(ws) + WS_HLB); Q2b.SSQ = (GAS float*)(opq(ws) + WS_OMB); peer_k2(Q2b, ps, wv_, LANE_); }
#endif
        }
        SEAM(pb + 15);
    }
    if (IN(PH_FINAL)) { SITE(); final_norm_phase(opq((const GAS bf16*)(opq(ws) + WS_XNB)), (GAS float*)args.out, (const GAS float*)args.in[opqi(32)], T, gw_, NGW_, LANE_); }
#undef IN
#undef SEAM
#undef GEMM_SITE
}
}
extern "C" void kernel_launch(void* const* d_in, const int* in_sizes, int n_in, void* d_out, int out_size, void* d_ws, size_t ws_size, hipStream_t stream) {
    (void)in_sizes; (void)out_size;
    static int grid = 0;
    if (grid == 0) {
        int dev = 0, cus = 0, per_cu = 0;
        if (n_in != 33 || ws_size < mk::WS_END) { fprintf(stderr, "kernel_launch: unexpected n_in %d / ws_size %zu\n", n_in, ws_size); grid = -1; return; }
        if (hipGetDevice(&dev) != hipSuccess || hipDeviceGetAttribute(&cus, hipDeviceAttributeMultiprocessorCount, dev) != hipSuccess) { grid = -1; return; }
        if (hipFuncSetAttribute((const void*)mk::fwd, hipFuncAttributeMaxDynamicSharedMemorySize, mk::LDS_BYTES) != hipSuccess) { fprintf(stderr, "kernel_launch: hipFuncSetAttribute failed\n"); grid = -1; return; }
        if (hipOccupancyMaxActiveBlocksPerMultiprocessor(&per_cu, (const void*)mk::fwd, mk::NWAVES * 64, mk::LDS_BYTES) != hipSuccess || per_cu < 1) fprintf(stderr, "kernel_launch: occupancy query says %d\n", per_cu);
        (void)hipGetLastError();
        grid = cus;
    }
    if (grid < 0) return;
    unsigned char* ws = (unsigned char*)d_ws;
    (void)hipMemsetAsync(ws + mk::WS_CTL, 0, mk::CTL_ZERO_BYTES, stream);
    mk::Args a{};
    for (int i = 0; i < 33; ++i) a.in[i] = (const float*)d_in[i];
    a.out = (float*)d_out; a.ws = ws;
    auto run = [&](int lo, int hi) { a.ph_lo = lo; a.ph_hi = hi; hipLaunchKernelGGL(mk::fwd, dim3(grid), dim3(mk::NWAVES * 64), mk::LDS_BYTES, stream, a); };
#if MK_ONE_LAUNCH
    run(0, mk::PH_FINAL + 1);
#else
    for (int p = 0; p <= mk::PH_FINAL; ++p) {
        const int k = (p - 2) % mk::NPL, l = (p - 2) / mk::NPL;
#if MK_NAIVE_PEER == 2
        if (p >= 2 && p < mk::PH_FINAL && k == 14) {
            hipLaunchKernelGGL(k_peer, dim3(T), dim3(256), 0, stream, (const bf16_t*)(ws + mk::WS_XNB), (const int*)(ws + mk::WS_EX), (const float*)(ws + mk::WS_GW), (const float*)d_in[30] + (size_t)l * NEXP * D, (const float*)d_in[31] + (size_t)l * NEXP * D, (float*)d_out);
            continue; }
#elif MK_NAIVE_PEER == 1
        if (p >= 2 && p < mk::PH_FINAL && k == 13) {
            float* TQ = (float*)(ws + (size_t)806 * mk::MiB);
            hipLaunchKernelGGL(k_bf2f, dim3((unsigned)(((size_t)T * D + 255) / 256)), dim3(256), 0, stream, (const bf16_t*)(ws + mk::WS_PROJB), TQ, (long)T * D);
            hipLaunchKernelGGL(k_route, dim3(T), dim3(256), 0, stream, TQ, (const float*)d_in[29] + (size_t)l * 2 * 128 * 64, (int*)(ws + mk::WS_EX), (float*)(ws + mk::WS_GW));
            hipLaunchKernelGGL(k_peer, dim3(T), dim3(256), 0, stream, (const bf16_t*)(ws + mk::WS_XNB), (const int*)(ws + mk::WS_EX), (const float*)(ws + mk::WS_GW), (const float*)d_in[30] + (size_t)l * NEXP * D, (const float*)d_in[31] + (size_t)l * NEXP * D, (float*)d_out);
            continue; }
        if (p >= 2 && p < mk::PH_FINAL && k == 14) continue;
#endif
        run(p, p + 1); }
#endif
}
```

```cpp
#include <hip/hip_runtime.h>
#include <cstdint>
#include <cstdio>
#include <cmath>

#ifndef MK_ONE_LAUNCH
#define MK_ONE_LAUNCH 1
#endif
#ifndef MK_DUP
#define MK_DUP 0
#endif
#ifndef MK_NAIVE_PEER
#define MK_NAIVE_PEER 0
#endif
namespace pg8 {
#define PG8_LAS __attribute__((address_space(3)))
#ifndef GAS
#define GAS __attribute__((address_space(1)))
#endif
typedef unsigned short bf16_t;
typedef short bf16x8 __attribute__((ext_vector_type(8)));
typedef float f32x4 __attribute__((ext_vector_type(4)));
typedef unsigned u32x4 __attribute__((ext_vector_type(4)));
typedef unsigned u32x2 __attribute__((ext_vector_type(2)));
constexpr int BM = 256, BK = 64, HALF = 128, HTB = HALF * BK * 2, STAGE_BYTES = 8 * HTB, NXCD = 8, WGM = 8;
__host__ __device__ __forceinline__ int lds_byte(int r, int c) { const int st = (r >> 4) * 2 + (c >> 5), rr = r & 15, cc = c & 31, ob = rr * 64 + cc * 2; return st * 1024 + (ob ^ (((ob >> 9) & 1) << 5)); }
__host__ __device__ __forceinline__ void stage_rc(int b, int& R, int& C) { const int st = b / 1024, sb = b % 1024, swz = sb ^ (((sb >> 9) & 1) << 5); R = (st >> 1) * 16 + swz / 64; C = (st & 1) * 32 + (swz % 64) / 2; }
__host__ __device__ __forceinline__ int perm32(int rho) { const int n = rho >> 4, i = rho & 15; return 8 * (i >> 2) + 4 * n + (i & 3); }
__device__ __forceinline__ int pg8_lane_id() { int l; asm volatile("v_mbcnt_lo_u32_b32 %0, -1, 0\n\tv_mbcnt_hi_u32_b32 %0, -1, %0" : "=v"(l)); return l; }
struct Unit { int pm, pn; };
struct Gemm { const GAS bf16_t* A; const GAS bf16_t* Bt; int M, N, K, lda, ldb; };
struct StaticOrder {
    int nM, nN, nwg, G, c;
    __host__ __device__ void init(int M, int N, int G_, int c_) { nM = M / BM; nN = N / BM; nwg = nM * nN; G = G_; c = c_; }
    __host__ __device__ bool next(int i, Unit& u) const {
        const long L = (long)i * G + c; if (L >= nwg) return false;
        int wgid = (int)L; { const int q = nwg / NXCD, r = nwg % NXCD, xcd = wgid % NXCD, off = wgid / NXCD; wgid = (xcd < r ? xcd * (q + 1) : r * (q + 1) + (xcd - r) * q) + off; }
        const int nig = WGM * nN, gid = wgid / nig, fm = gid * WGM, gsz = (nM - fm) < WGM ? (nM - fm) : WGM;
        u.pm = fm + ((wgid % nig) % gsz); u.pn = (wgid % nig) / gsz; return true;
    }
    __device__ __forceinline__ void a_ready(const Unit&) const {}
    __device__ __forceinline__ void done(const Unit&) const {}
};
__device__ __forceinline__ unsigned cvt_pk_bf16(float lo, float hi) { unsigned r; asm volatile("v_cvt_pk_bf16_f32 %0, %1, %2" : "=v"(r) : "v"(lo), "v"(hi)); return r; }

struct EpiF32 {
    static constexpr bool PERM = false, AFTER_DRAIN = false;
    GAS float* C; int ldc; int nvalid; int accum;
    __device__ __forceinline__ void operator()(const f32x4 (&acc)[2][2][4][2], const Unit& u, int wr, int wc, int fr, int fq) const {
        { const int l_ = pg8_lane_id(); fr = l_ & 15; fq = l_ >> 4; }
#pragma unroll
        for (int ai = 0; ai < 2; ++ai)
#pragma unroll
            for (int m = 0; m < 4; ++m) { const size_t row = (size_t)u.pm * BM + ai * HALF + wr * 64 + m * 16 + fr;
#pragma unroll
                for (int bj = 0; bj < 2; ++bj)
#pragma unroll
                    for (int n = 0; n < 2; ++n) { const int col = u.pn * BM + bj * HALF + wc * 32 + n * 16 + 4 * fq;
                        if (col < nvalid) { GAS float* p = C + row * ldc + col; f32x4 v = acc[ai][bj][m][n]; if (accum) v += *(const GAS f32x4*)p; *(GAS f32x4*)p = v; } } }
    }
};
struct EpiBf16 {
    static constexpr bool PERM = true, AFTER_DRAIN = false;
    GAS bf16_t* O; int ldc; int nvalid; const GAS float* ssq; int np;
    __device__ __forceinline__ void operator()(const f32x4 (&acc)[2][2][4][2], const Unit& u, int wr, int wc, int fr, int fq) const {
        { const int l_ = pg8_lane_id(); fr = l_ & 15; fq = l_ >> 4; }
#pragma unroll
        for (int ai = 0; ai < 2; ++ai)
#pragma unroll
            for (int m = 0; m < 4; ++m) { const size_t row = (size_t)u.pm * BM + ai * HALF + wr * 64 + m * 16 + fr;
                float rs_ = 1.f;
                if (np > 0) { const GAS f32x4* sp = (const GAS f32x4*)(ssq + row * 16); f32x4 t = sp[0] + sp[1]; if (np > 8) t += sp[2] + sp[3]; rs_ = __builtin_amdgcn_rsqf(((t[0] + t[1]) + (t[2] + t[3])) * (1.f / 1024.f) + 1e-6f); }
#pragma unroll
                for (int bj = 0; bj < 2; ++bj) { const int col = u.pn * BM + bj * HALF + wc * 32 + 8 * fq;
                    if (col < nvalid) { const f32x4 v0 = acc[ai][bj][m][0] * rs_, v1 = acc[ai][bj][m][1] * rs_; u32x4 w; w.x = cvt_pk_bf16(v0[0], v0[1]); w.y = cvt_pk_bf16(v0[2], v0[3]); w.z = cvt_pk_bf16(v1[0], v1[1]); w.w = cvt_pk_bf16(v1[2], v1[3]);
                        *(GAS u32x4*)(O + row * ldc + col) = w; } } }
    }
};
struct EpiUp {
    static constexpr bool PERM = true, AFTER_DRAIN = false;
    GAS bf16_t* O; GAS bf16_t* O2; int ldc; int nvalid; const GAS float* rs; int rsi; int mode;
    __device__ __forceinline__ void operator()(const f32x4 (&acc)[2][2][4][2], const Unit& u, int wr, int wc, int fr, int fq) const {
        { const int l_ = pg8_lane_id(); fr = l_ & 15; fq = l_ >> 4; }
#pragma unroll
        for (int ai = 0; ai < 2; ++ai)
#pragma unroll
            for (int m = 0; m < 4; ++m) { const size_t row = (size_t)u.pm * BM + ai * HALF + wr * 64 + m * 16 + fr; const float s = rs[2 * row + rsi];
#pragma unroll
                for (int bj = 0; bj < 2; ++bj) { const int col = u.pn * BM + bj * HALF + wc * 32 + 8 * fq;
                    if (col < nvalid) { const f32x4 v0 = acc[ai][bj][m][0] * s, v1 = acc[ai][bj][m][1] * s; u32x4 w; w.x = cvt_pk_bf16(v0[0], v0[1]); w.y = cvt_pk_bf16(v0[2], v0[3]); w.z = cvt_pk_bf16(v1[0], v1[1]); w.w = cvt_pk_bf16(v1[2], v1[3]);
                        GAS bf16_t* dst;
                        if (mode == 0) dst = O + row * ldc + col;
                        else { const int h = col >> 7, j = col & 127; dst = (j < 64) ? O + row * 384 + h * 96 + j : O2 + row * 256 + h * 64 + (j - 64); }
                        *(GAS u32x4*)dst = w; } } }
    }
};

struct EpiRes {
    static constexpr bool PERM = true, AFTER_DRAIN = false;
    GAS bf16_t* XB; GAS float* SSQ;
    __device__ __forceinline__ void operator()(const f32x4 (&acc)[2][2][4][2], const Unit& u, int wr, int wc, int fr, int fq) const {
        { const int l_ = pg8_lane_id(); fr = l_ & 15; fq = l_ >> 4; }
#pragma unroll
        for (int ai = 0; ai < 2; ++ai)
#pragma unroll
            for (int m = 0; m < 4; ++m) { const size_t row = (size_t)u.pm * BM + ai * HALF + wr * 64 + m * 16 + fr; float ss = 0.f;
#pragma unroll
                for (int bj = 0; bj < 2; ++bj) { GAS u32x4* p = (GAS u32x4*)(XB + row * 1024 + u.pn * BM + bj * HALF + wc * 32 + 8 * fq);
                    const u32x4 o = *p; const f32x4 v0 = acc[ai][bj][m][0], v1 = acc[ai][bj][m][1];
                    u32x4 w;
                    w.x = cvt_pk_bf16(__builtin_bit_cast(float, o.x << 16) + v0[0], __builtin_bit_cast(float, o.x & 0xffff0000u) + v0[1]);
                    w.y = cvt_pk_bf16(__builtin_bit_cast(float, o.y << 16) + v0[2], __builtin_bit_cast(float, o.y & 0xffff0000u) + v0[3]);
                    w.z = cvt_pk_bf16(__builtin_bit_cast(float, o.z << 16) + v1[0], __builtin_bit_cast(float, o.z & 0xffff0000u) + v1[1]);
                    w.w = cvt_pk_bf16(__builtin_bit_cast(float, o.w << 16) + v1[2], __builtin_bit_cast(float, o.w & 0xffff0000u) + v1[3]);
                    *p = w;
#pragma unroll
                    for (int e = 0; e < 4; ++e) { const float a = __builtin_bit_cast(float, w[e] << 16), b = __builtin_bit_cast(float, w[e] & 0xffff0000u); ss += a * a + b * b; } }
                { float a = ss, b = ss; asm volatile("v_nop\n\tv_nop\n\tv_permlane16_swap_b32 %0, %1" : "+v"(a), "+v"(b)); ss = a + b; }
                { float a = ss, b = ss; asm volatile("v_nop\n\tv_nop\n\tv_permlane32_swap_b32 %0, %1" : "+v"(a), "+v"(b)); ss = a + b; }
                if (fq == 0) SSQ[row * 16 + 4 * u.pn + wc] = ss; }
    }
};
template <class Epi, class Sched, bool ALIGN_EPI = false, bool SP2 = false>
__device__ __forceinline__ void gemm_phase(PG8_LAS unsigned char* lds, const Gemm g, const Sched& S, const Epi& E, int wave_id) {
    int tid_ = (wave_id << 6) | pg8_lane_id(); asm volatile("" : "+v"(tid_));
    const int tid = tid_, wid = __builtin_amdgcn_readfirstlane(tid >> 6), lane = tid & 63, wr = wid >> 2, wc = wid & 3, fr = lane & 15, fq = lane >> 4;
    const int K = g.K, nt = K / BK;
    unsigned voffA[2], voffB[2];
#pragma unroll
    for (int i = 0; i < 2; ++i) { int R, C; stage_rc(tid * 16 + i * 8192, R, C); const int Rb = Epi::PERM ? ((R & ~31) + perm32(R & 31)) : R;
        voffA[i] = (unsigned)(R * g.lda + C) * 2u; voffB[i] = (unsigned)(Rb * g.ldb + C) * 2u; }
    const size_t kstep = (size_t)(BK * 2);
    const size_t hstepA = (size_t)HALF * g.lda * 2, hstepB = (size_t)HALF * g.ldb * 2;
    const size_t tstepA = 2 * hstepA, tstepB = 2 * hstepB;
    const unsigned ldsw = (unsigned)wid * 1024u;
    const int aoff = lds_byte(wr * 64 + fr, fq * 8), boff = lds_byte(wc * 32 + fr, fq * 8);
#define PG8_SA(b, h) (((b) * 2 + (h)) * HTB)
#define PG8_SB(b, h) ((4 + (b) * 2 + (h)) * HTB)
#define PG8_STAGE(bufoff, gbase, voff) do { _Pragma("unroll") for (int _i = 0; _i < 2; ++_i) \
        __builtin_amdgcn_global_load_lds((const unsigned*)((const char*)(gbase) + (voff)[_i]), (PG8_LAS unsigned*)(lds + (bufoff) + ldsw + _i * 8192), 16, 0, 0); } while (0)
#define PG8_LDA(dst, b, h) do { _Pragma("unroll") for (int m = 0; m < 4; ++m) _Pragma("unroll") for (int k = 0; k < 2; ++k) dst[m][k] = *(const PG8_LAS bf16x8*)(lds + PG8_SA(b, h) + aoff + m * 2048 + k * 1024); } while (0)
#define PG8_LDB(dst, b, h) do { _Pragma("unroll") for (int n = 0; n < 2; ++n) _Pragma("unroll") for (int k = 0; k < 2; ++k) dst[n][k] = *(const PG8_LAS bf16x8*)(lds + PG8_SB(b, h) + boff + n * 2048 + k * 1024); } while (0)
#define PG8_MMA(ai, bj, At, Bt) do { __builtin_amdgcn_s_setprio(1); _Pragma("unroll") for (int m = 0; m < 4; ++m) _Pragma("unroll") for (int n = 0; n < 2; ++n) _Pragma("unroll") for (int k = 0; k < 2; ++k) \
        acc[ai][bj][m][n] = __builtin_amdgcn_mfma_f32_16x16x32_bf16(Bt[n][k], At[m][k], acc[ai][bj][m][n], 0, 0, 0); __builtin_amdgcn_s_setprio(0); } while (0)
#define PG8_WAIT_V(n) asm volatile("s_waitcnt vmcnt(" #n ")" ::: "memory")
#define PG8_WAIT_L(n) asm volatile("s_waitcnt lgkmcnt(" #n ")" ::: "memory")
#define PG8_BAR __builtin_amdgcn_s_barrier()
#define PG8_SCHED __builtin_amdgcn_sched_barrier(0)
    Unit cur, nxt; int ui = 0;
    if (!S.next(0, cur)) return;
    f32x4 acc[2][2][4][2];
#pragma unroll
    for (int a = 0; a < 2; ++a)
#pragma unroll
        for (int b = 0; b < 2; ++b)
#pragma unroll
            for (int m = 0; m < 4; ++m)
#pragma unroll
                for (int n = 0; n < 2; ++n) acc[a][b][m][n] = (f32x4){0.f, 0.f, 0.f, 0.f};
    bf16x8 At[4][2], B0[2][2], B1[2][2];
    const char* cA = (const char*)g.A + (size_t)cur.pm * tstepA; const char* cB = (const char*)g.Bt + (size_t)cur.pn * tstepB;
    S.a_ready(cur);
    if constexpr (SP2) {
        PG8_STAGE(PG8_SB(0, 0), cB, voffB); PG8_STAGE(PG8_SB(0, 1), cB + hstepB, voffB); PG8_STAGE(PG8_SA(0, 0), cA, voffA); PG8_STAGE(PG8_SA(0, 1), cA + hstepA, voffA);
        if (wr == 1) PG8_BAR;
        PG8_WAIT_V(2); PG8_BAR;
        PG8_STAGE(PG8_SB(1, 0), cB + kstep, voffB); PG8_STAGE(PG8_SA(1, 0), cA + kstep, voffA); PG8_STAGE(PG8_SB(1, 1), cB + hstepB + kstep, voffB);
        PG8_WAIT_V(6); PG8_BAR;
    } else {
        PG8_STAGE(PG8_SB(0, 0), cB, voffB); PG8_STAGE(PG8_SA(0, 0), cA, voffA); PG8_STAGE(PG8_SB(0, 1), cB + hstepB, voffB); PG8_STAGE(PG8_SA(0, 1), cA + hstepA, voffA);
        if (wr == 1) PG8_BAR;
        PG8_WAIT_V(4); PG8_BAR;
        PG8_STAGE(PG8_SB(1, 0), cB + kstep, voffB); PG8_STAGE(PG8_SA(1, 0), cA + kstep, voffA); PG8_STAGE(PG8_SB(1, 1), cB + hstepB + kstep, voffB);
        PG8_WAIT_V(6); PG8_BAR;
    }
    for (;;) {
        const bool has_next = S.next(ui + 1, nxt);
        const char* nA = has_next ? (const char*)g.A + (size_t)nxt.pm * tstepA : cA; const char* nB = has_next ? (const char*)g.Bt + (size_t)nxt.pn * tstepB : cB;
        for (int t = 0; t < nt; t += 2) {
            const bool last = (t == nt - 2);
            const char* a1 = cA + (size_t)(t + 1) * kstep;
            const char* a2 = last ? nA : cA + (size_t)(t + 2) * kstep; const char* b2 = last ? nB : cB + (size_t)(t + 2) * kstep;
            const char* a3 = a2 + kstep; const char* b3 = b2 + kstep;
            if (last && has_next) S.a_ready(nxt);
            if constexpr (SP2) {
            PG8_LDB(B0, 0, 0); PG8_LDB(B1, 0, 1); PG8_SCHED; PG8_LDA(At, 0, 0); PG8_STAGE(PG8_SA(1, 1), a1 + hstepA, voffA);
            PG8_WAIT_V(8); PG8_WAIT_L(0); PG8_BAR; PG8_MMA(0, 0, At, B0); PG8_MMA(0, 1, At, B1); PG8_BAR; PG8_SCHED;
            PG8_LDA(At, 0, 1); PG8_STAGE(PG8_SB(0, 0), b2, voffB); PG8_STAGE(PG8_SB(0, 1), b2 + hstepB, voffB); PG8_STAGE(PG8_SA(0, 0), a2, voffA);
            PG8_WAIT_V(8); PG8_WAIT_L(0); PG8_BAR; PG8_MMA(1, 0, At, B0); PG8_MMA(1, 1, At, B1); PG8_BAR; PG8_SCHED;
            PG8_LDB(B0, 1, 0); PG8_LDB(B1, 1, 1); PG8_SCHED; PG8_LDA(At, 1, 0); PG8_STAGE(PG8_SA(0, 1), a2 + hstepA, voffA);
            PG8_WAIT_V(8); PG8_WAIT_L(0); PG8_BAR; PG8_MMA(0, 0, At, B0); PG8_MMA(0, 1, At, B1); PG8_BAR; PG8_SCHED;
            PG8_LDA(At, 1, 1); PG8_STAGE(PG8_SB(1, 0), b3, voffB); PG8_STAGE(PG8_SB(1, 1), b3 + hstepB, voffB); PG8_STAGE(PG8_SA(1, 0), a3, voffA);
            PG8_WAIT_V(8); PG8_WAIT_L(0); PG8_BAR; PG8_MMA(1, 0, At, B0); PG8_MMA(1, 1, At, B1); PG8_BAR; PG8_SCHED;
            } else {
            PG8_LDB(B0, 0, 0); PG8_SCHED; PG8_LDA(At, 0, 0); PG8_STAGE(PG8_SA(1, 1), a1 + hstepA, voffA);
            PG8_WAIT_L(8); PG8_BAR; PG8_WAIT_L(0); PG8_MMA(0, 0, At, B0); PG8_BAR; PG8_SCHED;
            PG8_LDB(B1, 0, 1); PG8_STAGE(PG8_SB(0, 0), b2, voffB);
            PG8_BAR; PG8_WAIT_L(0); PG8_MMA(0, 1, At, B1); PG8_BAR;
            PG8_LDA(At, 0, 1); PG8_STAGE(PG8_SA(0, 0), a2, voffA);
            PG8_BAR; PG8_WAIT_L(0); PG8_MMA(1, 0, At, B0); PG8_BAR; PG8_SCHED;
            PG8_STAGE(PG8_SB(0, 1), b2 + hstepB, voffB);
            PG8_WAIT_V(6); PG8_BAR; PG8_MMA(1, 1, At, B1); PG8_BAR;
            PG8_LDB(B0, 1, 0); PG8_SCHED; PG8_LDA(At, 1, 0); PG8_STAGE(PG8_SA(0, 1), a2 + hstepA, voffA);
            PG8_WAIT_L(8); PG8_BAR; PG8_WAIT_L(0); PG8_MMA(0, 0, At, B0); PG8_BAR; PG8_SCHED;
            PG8_LDB(B1, 1, 1); PG8_STAGE(PG8_SB(1, 0), b3, voffB);
            PG8_BAR; PG8_WAIT_L(0); PG8_MMA(0, 1, At, B1); PG8_BAR;
            PG8_LDA(At, 1, 1); PG8_STAGE(PG8_SA(1, 0), a3, voffA);
            PG8_BAR; PG8_WAIT_L(0); PG8_MMA(1, 0, At, B0); PG8_BAR; PG8_SCHED;
            PG8_STAGE(PG8_SB(1, 1), b3 + hstepB, voffB);
            PG8_WAIT_V(6); PG8_BAR; PG8_MMA(1, 1, At, B1); PG8_BAR;
            }
        }
        if constexpr (ALIGN_EPI) { if (wr == 0) PG8_BAR; }
        if constexpr (!Epi::AFTER_DRAIN) { E(acc, cur, wr, wc, fr, fq); S.done(cur); }
        if (!has_next) break;
#pragma unroll
        for (int a = 0; a < 2; ++a)
#pragma unroll
            for (int b = 0; b < 2; ++b)
#pragma unroll
                for (int m = 0; m < 4; ++m)
#pragma unroll
                    for (int n = 0; n < 2; ++n) acc[a][b][m][n] = (f32x4){0.f, 0.f, 0.f, 0.f};
        cur = nxt; cA = nA; cB = nB; ++ui;
        if constexpr (ALIGN_EPI) { if (wr == 1) PG8_BAR; }
    }
    PG8_WAIT_V(0);
    if constexpr (!ALIGN_EPI) { if (wr == 0) PG8_BAR; }
    PG8_BAR;
    if constexpr (Epi::AFTER_DRAIN) { E.fused(acc, cur, wr, wc, fr, fq, lds, wid, lane); S.done(cur); }
#undef PG8_SA
#undef PG8_SB
#undef PG8_STAGE
#undef PG8_LDA
#undef PG8_LDB
#undef PG8_MMA
#undef PG8_WAIT_V
#undef PG8_WAIT_L
#undef PG8_BAR
#undef PG8_SCHED
}
}

namespace mk {
#ifndef GAS
#define GAS __attribute__((address_space(1)))
#endif
#define LAS __attribute__((address_space(3)))
typedef unsigned short bf16;
typedef unsigned v4u __attribute__((ext_vector_type(4)));
typedef unsigned v2u __attribute__((ext_vector_type(2)));
typedef float f32x4 __attribute__((ext_vector_type(4)));
typedef GAS unsigned gu32;
#define LDS_WAIT() asm volatile("s_waitcnt lgkmcnt(0)" ::: "memory")
#define VM_WAIT() asm volatile("s_waitcnt vmcnt(0)" ::: "memory")
__device__ __forceinline__ unsigned f2bf_(float f) { unsigned u = __builtin_bit_cast(unsigned, f); return (u + 0x7fffu + ((u >> 16) & 1u)) >> 16; }
__device__ __forceinline__ unsigned pk2(float lo, float hi) { return f2bf_(lo) | (f2bf_(hi) << 16); }
__device__ __forceinline__ float bflo(unsigned w) { return __builtin_bit_cast(float, w << 16); }
__device__ __forceinline__ float bfhi(unsigned w) { return __builtin_bit_cast(float, w & 0xffff0000u); }

template <class P> __device__ __forceinline__ P* opq(P* p) { asm volatile("" : "+s"(p)); return p; }
__device__ __forceinline__ int opqi(int k) { asm volatile("" : "+s"(k)); return k; }
__device__ __forceinline__ float shx(float v, int o, int lane) { return __builtin_bit_cast(float, __builtin_amdgcn_ds_bpermute((lane ^ o) << 2, __builtin_bit_cast(int, v))); }
__device__ __forceinline__ int shxi(int v, int o, int lane) { return __builtin_amdgcn_ds_bpermute((lane ^ o) << 2, v); }
__device__ __forceinline__ int lane_id_v() { int l; asm volatile("v_mbcnt_lo_u32_b32 %0, -1, 0\n\tv_mbcnt_hi_u32_b32 %0, -1, %0" : "=v"(l)); return l; }
constexpr int NWAVES = 8;
constexpr int D = 1024, NB = 4, S = 8192, T = NB * S, L = 4, MEM = 256, INW = 2144, INP = 2304;
constexpr int PC_CQ = 0, PC_CKV = 256, PC_KR = 384, PC_XL = 512, PC_GL = 1024, PC_QD = 1536, PC_KD = 1792, PC_VD = 2048;
constexpr float LOG2E = 1.4426950408889634f;
constexpr size_t MiB = 1u << 20;
constexpr size_t WS_CTL = 0, CTL_ZERO_BYTES = 1 * MiB;
constexpr size_t WS_WIN = 1 * MiB, WS_WOUT = 19 * MiB, WS_WCQ = 27 * MiB, WS_WCO = 35 * MiB, WS_WPQ = 43 * MiB, WS_WCKV = 51 * MiB, WS_WUQ = 67 * MiB, WS_WUKV = 68 * MiB, WS_KEYS = 69 * MiB, WS_ROPE = 70 * MiB;
constexpr size_t WS_XNB = 76 * MiB, WS_YB = 140 * MiB, WS_PROJB = 204 * MiB, WS_QMB = 348 * MiB, WS_KMB = 372 * MiB, WS_VMB = 396 * MiB, WS_RS = 412 * MiB;
constexpr size_t WS_HLB = 413 * MiB, WS_ACB = 445 * MiB, WS_LSUM = 477 * MiB, WS_OMB = 478 * MiB, WS_MNB = 494 * MiB, WS_KVCB = 502 * MiB, WS_EX = 518 * MiB, WS_GW = 534 * MiB;
constexpr size_t WS_U8 = 550 * MiB, WS_V8 = 614 * MiB, WS_SU = 678 * MiB, WS_SV = 679 * MiB;
constexpr size_t WS_HQ = 680 * MiB, WS_P = 712 * MiB, WS_SH = 728 * MiB, WS_W = 729 * MiB, WS_WS = 745 * MiB, WS_SSQ = 746 * MiB, WS_END = 748 * MiB;
constexpr size_t WS_WAT = 74 * MiB;
constexpr size_t WS_BTAB = WS_KEYS + 512 * 1024, WS_LAMS = WS_BTAB + 4096, WS_SP = WS_LAMS + 4096;
constexpr int CW_BAR = 4096, CW_RANK = 8192;
constexpr int RING_OFF = 0, RING_BYTES = 155648, LDSCTL_OFF = RING_BYTES, MISC_OFF = LDSCTL_OFF + 320, LDS_BYTES = 163840;

#define XB_TMO      128
#define XB_XCNT(j)  (256  + 64 * (j))
#define XB_XSUB(j)  (1280 + 64 * (j))
#define XB_XGEN(j)  (2304 + 64 * (j))
#define XB_TOP      3328
#define XB_TOPGEN   3392
#define XCD_BAR_WORDS 3456
#define XB_SPIN_CAP (1u << 18)

__device__ __forceinline__ unsigned xb_ld(unsigned* p)              { return __hip_atomic_load(p, __ATOMIC_RELAXED, __HIP_MEMORY_SCOPE_AGENT); }
__device__ __forceinline__ unsigned xb_add(unsigned* p, unsigned v) { return __hip_atomic_fetch_add(p, v, __ATOMIC_RELAXED, __HIP_MEMORY_SCOPE_AGENT); }
__device__ __forceinline__ unsigned xb_xcc_id() { return (unsigned)__builtin_amdgcn_s_getreg((3 << 11) | 20) & 0xFu; }
#define XB_SPIN(cond, bar) do { unsigned _sp = 0; while (cond) { __builtin_amdgcn_s_sleep(1); \
    if ((++_sp & 255u) == 0u) { if (xb_ld(&(bar)[XB_TMO])) break; if (_sp > XB_SPIN_CAP) { atomicAdd(&(bar)[XB_TMO], 1u); break; } } } } while (0)

struct XcdBarrier {
    unsigned* bar; unsigned x;
    volatile LAS unsigned* st;
};

__device__ __forceinline__ XcdBarrier xcd_barrier_post(unsigned* bar, volatile LAS unsigned* st) {
    XcdBarrier b; b.bar = bar; b.x = xb_xcc_id(); b.st = st;
    if (threadIdx.x == 0) (void)xb_add(&bar[XB_XCNT(b.x)], 1u);
    return b;
}
__device__ __forceinline__ void xcd_barrier_complete(unsigned* bar, unsigned x, unsigned& nloc, unsigned& nx) {
    const unsigned G = gridDim.x * gridDim.y * gridDim.z;
    unsigned sum, cnt, mine, sp = 0u;
    for (;;) {
        sum = 0u; cnt = 0u; mine = 0u;
#pragma unroll
        for (unsigned j = 0; j < 16; ++j) { const unsigned c = xb_ld(&bar[XB_XCNT(j)]); sum += c; cnt += (c > 0u) ? 1u : 0u; mine = (j == x) ? c : mine; }
        if (sum == G) break;
        __builtin_amdgcn_s_sleep(1);
        if ((++sp & 255u) == 0u) { if (xb_ld(&bar[XB_TMO])) break; if (sp > XB_SPIN_CAP) { atomicAdd(&bar[XB_TMO], 1u); break; } }
    }
    nloc = mine > 0u ? mine : 1u; nx = cnt > 0u ? cnt : 1u;
}

__device__ __noinline__ void xcd_barrier_impl(unsigned* bar_, unsigned x_, volatile LAS unsigned* st_, int leader_) {
    XcdBarrier b; b.bar = bar_; b.x = x_; b.st = st_;
    asm volatile("s_waitcnt vmcnt(0)" ::: "memory");
    __syncthreads();
    if (leader_) {
        unsigned* bar = b.bar;
        __builtin_amdgcn_s_waitcnt(0);
        unsigned nloc = b.st[0], nx = b.st[1];
        if (nloc == 0u) { xcd_barrier_complete(bar, b.x, nloc, nx); b.st[0] = nloc; b.st[1] = nx; }
        const unsigned old = xb_add(&bar[XB_XSUB(b.x)], 1u);
        const unsigned gen = old / nloc;
        if (old + 1u == (gen + 1u) * nloc) {
            __builtin_amdgcn_fence(__ATOMIC_RELEASE, "agent");
            asm volatile("s_waitcnt vmcnt(0)" ::: "memory");
            const unsigned og = xb_add(&bar[XB_TOP], 1u);
            const unsigned tg = og / nx;
            if (og + 1u == (tg + 1u) * nx) xb_add(&bar[XB_TOPGEN], 1u);
            else XB_SPIN(xb_ld(&bar[XB_TOPGEN]) == tg, bar);
            __builtin_amdgcn_fence(__ATOMIC_ACQUIRE, "agent");
            xb_add(&bar[XB_XGEN(b.x)], 1u);
            asm volatile("s_waitcnt vmcnt(0)" ::: "memory");
        } else {
            XB_SPIN(xb_ld(&bar[XB_XGEN(b.x)]) == gen, bar);
            __builtin_amdgcn_fence(__ATOMIC_ACQUIRE, "agent");
            asm volatile("s_waitcnt vmcnt(0)" ::: "memory");
        }
    }
    __syncthreads();
}
__device__ __forceinline__ void xcd_barrier(const XcdBarrier& b, int leader) { xcd_barrier_impl(b.bar, b.x, b.st, leader); }


__device__ __forceinline__ float wave_sum(float v, int lane) {
    (void)lane;
    v += __builtin_bit_cast(float, __builtin_amdgcn_update_dpp(0, __builtin_bit_cast(int, v), 0xB1, 0xF, 0xF, true));
    v += __builtin_bit_cast(float, __builtin_amdgcn_update_dpp(0, __builtin_bit_cast(int, v), 0x4E, 0xF, 0xF, true));
    v += __builtin_bit_cast(float, __builtin_amdgcn_update_dpp(0, __builtin_bit_cast(int, v), 0x141, 0xF, 0xF, true));
    v += __builtin_bit_cast(float, __builtin_amdgcn_update_dpp(0, __builtin_bit_cast(int, v), 0x140, 0xF, 0xF, true));
    { float a = v, b = v; asm volatile("v_nop\n\tv_nop\n\tv_permlane16_swap_b32 %0, %1" : "+v"(a), "+v"(b)); v = a + b; }
    { float a = v, b = v; asm volatile("v_nop\n\tv_nop\n\tv_permlane32_swap_b32 %0, %1" : "+v"(a), "+v"(b)); v = a + b; }
    return v;
}
__device__ __forceinline__ float wave_max(float v) {
    v = fmaxf(v, __builtin_bit_cast(float, __builtin_amdgcn_update_dpp(0, __builtin_bit_cast(int, v), 0xB1, 0xF, 0xF, true)));
    v = fmaxf(v, __builtin_bit_cast(float, __builtin_amdgcn_update_dpp(0, __builtin_bit_cast(int, v), 0x4E, 0xF, 0xF, true)));
    v = fmaxf(v, __builtin_bit_cast(float, __builtin_amdgcn_update_dpp(0, __builtin_bit_cast(int, v), 0x141, 0xF, 0xF, true)));
    v = fmaxf(v, __builtin_bit_cast(float, __builtin_amdgcn_update_dpp(0, __builtin_bit_cast(int, v), 0x140, 0xF, 0xF, true)));
    { float a = v, b = v; asm volatile("v_nop\n\tv_nop\n\tv_permlane16_swap_b32 %0, %1" : "+v"(a), "+v"(b)); v = fmaxf(a, b); }
    { float a = v, b = v; asm volatile("v_nop\n\tv_nop\n\tv_permlane32_swap_b32 %0, %1" : "+v"(a), "+v"(b)); v = fmaxf(a, b); }
    return v;
}
__device__ __forceinline__ float gelu_erf(float v) {
    const float av = __builtin_fabsf(v), t = __builtin_amdgcn_rcpf(av * 0.2316418882f + 1.0f);
    float q = t * 0.5307027145f + (-0.7265760135f); q = q * t + 0.7107068705f; q = q * t + (-0.142248368f); q = q * t + 0.127414796f; q = q * t;
    const float e = __builtin_amdgcn_exp2f((v * v) * (-0.72134752044f));
    const float m = v * (q * e);
    return v < 0.f ? m : v - m;
}

__device__ __forceinline__ void norm_phase(const GAS float* X, const GAS float* g, GAS bf16* out, int rows, int gw, int NGW, int lane) {
    asm volatile("" : "+v"(lane));
    f32x4 gv[4];
#pragma unroll
    for (int j = 0; j < 4; ++j) gv[j] = ((const GAS f32x4*)g)[lane + 64 * j];
    for (int m = gw; m < rows; m += NGW) {
        const GAS f32x4* xr = (const GAS f32x4*)(X + (size_t)m * D) + lane;
        f32x4 v[4]; float s = 0.f;
#pragma unroll
        for (int j = 0; j < 4; ++j) { v[j] = xr[64 * j]; s += (v[j].x * v[j].x + v[j].y * v[j].y) + (v[j].z * v[j].z + v[j].w * v[j].w); }
        const float rs = rsqrtf(wave_sum(s, lane) * (1.f / D) + 1e-6f);
        GAS v2u* o8 = (GAS v2u*)(out + (size_t)m * D) + lane;
#pragma unroll
        for (int j = 0; j < 4; ++j) { v2u w; w.x = pk2(v[j].x * rs * gv[j].x, v[j].y * rs * gv[j].y); w.y = pk2(v[j].z * rs * gv[j].z, v[j].w * rs * gv[j].w); o8[64 * j] = w; }
    }
}
__device__ __forceinline__ void hq_phase(const GAS bf16* XB, const GAS float* SSQ, const GAS float* g, GAS unsigned char* HQ, GAS float* SH, GAS int* Pz, int gw, int NGW, int lane) {
    asm volatile("" : "+v"(lane));
    const GAS f32x4* gp = (const GAS f32x4*)g + 4 * lane; const f32x4 g0 = gp[0], g1 = gp[1], g2 = gp[2], g3 = gp[3];
    for (int m = gw; m < T; m += NGW) {
        const GAS f32x4* sp = (const GAS f32x4*)(SSQ + (size_t)m * 16); const f32x4 t = (sp[0] + sp[1]) + (sp[2] + sp[3]);
        const float rs = __builtin_amdgcn_rsqf(((t[0] + t[1]) + (t[2] + t[3])) * (1.f / 1024.f) + 1e-6f);
        const v4u a = *(const GAS v4u*)(XB + (size_t)m * D + 16 * lane), b = *(const GAS v4u*)(XB + (size_t)m * D + 16 * lane + 8);
        float f[16] = {bflo(a.x) * g0[0], bfhi(a.x) * g0[1], bflo(a.y) * g0[2], bfhi(a.y) * g0[3], bflo(a.z) * g1[0], bfhi(a.z) * g1[1], bflo(a.w) * g1[2], bfhi(a.w) * g1[3],
                       bflo(b.x) * g2[0], bfhi(b.x) * g2[1], bflo(b.y) * g2[2], bfhi(b.y) * g2[3], bflo(b.z) * g3[0], bfhi(b.z) * g3[1], bflo(b.w) * g3[2], bfhi(b.w) * g3[3]};
        float mx = 0.f;
#pragma unroll
        for (int i = 0; i < 16; ++i) { f[i] *= rs; mx = fmaxf(mx, __builtin_fabsf(f[i])); }
        mx = wave_max(mx);
        const float inv = mx > 0.f ? 127.f / mx : 0.f;
        v4u q;
#pragma unroll
        for (int i = 0; i < 4; ++i) { const int ia = (int)__builtin_rintf(f[4 * i] * inv), ib = (int)__builtin_rintf(f[4 * i + 1] * inv), ic = (int)__builtin_rintf(f[4 * i + 2] * inv), id = (int)__builtin_rintf(f[4 * i + 3] * inv);
            q[i] = (unsigned)(ia & 255) | ((unsigned)(ib & 255) << 8) | ((unsigned)(ic & 255) << 16) | ((unsigned)(id & 255) << 24); }
        *(GAS v4u*)(HQ + (size_t)m * D + 16 * lane) = q;
        if (lane == 0) SH[m] = mx * (1.f / 127.f);
    }
}
__device__ __forceinline__ void x0_phase(const GAS float* X, GAS bf16* XB, GAS float* SSQ, int gw, int NGW, int lane) {
    asm volatile("" : "+v"(lane));
    for (int m = gw; m < T; m += NGW) {
        const GAS f32x4* xr = (const GAS f32x4*)(X + (size_t)m * D) + lane; GAS v2u* o8 = (GAS v2u*)(XB + (size_t)m * D) + lane;
        float s = 0.f;
#pragma unroll
        for (int j = 0; j < 4; ++j) { const f32x4 v = xr[64 * j]; s += (v.x * v.x + v.y * v.y) + (v.z * v.z + v.w * v.w); v2u w; w.x = pk2(v.x, v.y); w.y = pk2(v.z, v.w); o8[64 * j] = w; }
        s = wave_sum(s, lane);
        if (lane < 8) SSQ[(size_t)m * 16 + lane] = lane == 0 ? s : 0.f;
    }
}
__device__ __forceinline__ void final_norm_phase(const GAS bf16* XB, GAS float* O, const GAS float* g, int rows, int gw, int NGW, int lane) {
    asm volatile("" : "+v"(lane));
    for (int m = gw; m < rows; m += NGW) {
        const GAS v4u* xr = (const GAS v4u*)(XB + (size_t)m * D) + lane;
        v4u v[2]; float s = 0.f;
#pragma unroll
        for (int j = 0; j < 2; ++j) { v[j] = xr[64 * j];
#pragma unroll
            for (int e = 0; e < 4; ++e) { const float a = bflo(v[j][e]), b = bfhi(v[j][e]); s += a * a + b * b; } }
        const float rs = rsqrtf(wave_sum(s, lane) * (1.f / D) + 1e-6f);
#pragma unroll
        for (int j = 0; j < 2; ++j) { const int c = 8 * (lane + 64 * j); const f32x4 g0 = *(const GAS f32x4*)(g + c), g1 = *(const GAS f32x4*)(g + c + 4);
            f32x4 o0, o1; o0.x = bflo(v[j].x) * rs * g0.x; o0.y = bfhi(v[j].x) * rs * g0.y; o0.z = bflo(v[j].y) * rs * g0.z; o0.w = bfhi(v[j].y) * rs * g0.w;
            o1.x = bflo(v[j].z) * rs * g1.x; o1.y = bfhi(v[j].z) * rs * g1.y; o1.z = bflo(v[j].w) * rs * g1.z; o1.w = bfhi(v[j].w) * rs * g1.w;
            *(GAS f32x4*)(O + (size_t)m * D + c) = o0; *(GAS f32x4*)(O + (size_t)m * D + c + 4) = o1; }
    }
}

__device__ __forceinline__ float row16_sum(float v) {
    v += __builtin_bit_cast(float, __builtin_amdgcn_update_dpp(0, __builtin_bit_cast(int, v), 0xB1, 0xF, 0xF, true));
    v += __builtin_bit_cast(float, __builtin_amdgcn_update_dpp(0, __builtin_bit_cast(int, v), 0x4E, 0xF, 0xF, true));
    v += __builtin_bit_cast(float, __builtin_amdgcn_update_dpp(0, __builtin_bit_cast(int, v), 0x141, 0xF, 0xF, true));
    v += __builtin_bit_cast(float, __builtin_amdgcn_update_dpp(0, __builtin_bit_cast(int, v), 0x140, 0xF, 0xF, true));
    return v;
}
__device__ __forceinline__ float sq8(const v4u w) { const float a0 = bflo(w.x), a1 = bfhi(w.x), a2 = bflo(w.y), a3 = bfhi(w.y), a4 = bflo(w.z), a5 = bfhi(w.z), a6 = bflo(w.w), a7 = bfhi(w.w);
    return (a0 * a0 + a1 * a1) + (a2 * a2 + a3 * a3) + (a4 * a4 + a5 * a5) + (a6 * a6 + a7 * a7); }
__device__ __forceinline__ void pre_phase(const GAS bf16* PROJB, const GAS float* ROPE, GAS float* RS, GAS bf16* KMB, int gw, int NGW, int lane) {
    asm volatile("" : "+v"(lane));
    const int q = lane >> 4, sub = lane & 15;
    for (int t0 = gw * 4; t0 < T; t0 += NGW * 4) {
        const size_t t = (size_t)t0 + q;
        const GAS bf16* pr = PROJB + t * INP;
        const v4u w0 = *(const GAS v4u*)(pr + PC_CQ + 8 * sub), w1 = *(const GAS v4u*)(pr + PC_CQ + 8 * (16 + (sub & 7))), w2 = *(const GAS v4u*)(pr + PC_CKV + 8 * sub);
        const float x1 = __builtin_bit_cast(float, (unsigned)pr[PC_KR + sub] << 16), x2 = __builtin_bit_cast(float, (unsigned)pr[PC_KR + 16 + sub] << 16);
        const float c = ROPE[t * 32 + sub], sn = ROPE[t * 32 + 16 + sub];
        const float sq = row16_sum(sq8(w0) + (sub < 8 ? sq8(w1) : 0.f)), skv = row16_sum(sq8(w2));
        if (sub == 0) { RS[2 * t] = rsqrtf(sq * (1.f / 192.f) + 1e-6f); RS[2 * t + 1] = rsqrtf(skv * (1.f / 128.f) + 1e-6f); }
        const bf16 y1 = (bf16)f2bf_(x1 * c - x2 * sn), y2 = (bf16)f2bf_(x1 * sn + x2 * c);
        GAS bf16* kr = KMB + t * 384 + 64 + sub;
#pragma unroll
        for (int h = 0; h < 4; ++h) { kr[h * 96] = y1; kr[h * 96 + 16] = y2; }
    }
}

typedef short lr_bf16x8 __attribute__((ext_vector_type(8)));
typedef float lr_f32x16 __attribute__((ext_vector_type(16)));
__device__ __forceinline__ void lr_swap32(float& a, float& b) { asm volatile("v_nop\n\tv_nop\n\tv_permlane32_swap_b32 %0, %1" : "+v"(a), "+v"(b)); }
constexpr int LR_XR = 0, LR_CW = LR_XR + 37376, LR_XA = LR_CW + 1280, LR_WT = LR_XA + 256 * 144, LR_SUM = LR_WT + 2 * 64 * 144, LR_END = LR_SUM + 4096;
struct LruP { const GAS bf16* PROJB; const GAS float* cw; const GAS float* cb; const GAS bf16* wat; const GAS float* ba; const GAS float* bx; const GAS float* sp; GAS unsigned* HA; GAS float* LSUM; };
__device__ __forceinline__ void lru_phase(const LruP& P, LAS unsigned char* lds, int tid, int wave, int lane, int vcu, int G) {
    asm volatile("" : "+v"(tid), "+v"(lane));
    LAS float* SUM = (LAS float*)(lds + LR_SUM);
    for (int u = vcu; u < (T / 256) * 8; u += G) {
        const int tile = u >> 3, g = u & 7; const int t0 = tile * 256; const bool first = ((tile & 31) == 0);
        __syncthreads();
        float ba_[2], bx_[2], sp_[2];
#pragma unroll
        for (int nt = 0; nt < 2; ++nt) { const int ch = 64 * g + 32 * nt + (lane & 31); ba_[nt] = P.ba[ch]; bx_[nt] = P.bx[ch]; sp_[nt] = P.sp[ch]; }
        { v4u wt_[2], xr_[5];
#pragma unroll
          for (int i = 0; i < 2; ++i) { const int idx = tid + 512 * i; wt_[i] = ((const GAS v4u*)(P.wat + (size_t)g * 2 * 4096))[idx]; }
#pragma unroll
          for (int i = 0; i < 5; ++i) { const int idx = tid + 512 * i, row = idx >> 3, part = idx & 7; const bool ok = (idx < 259 * 8) && !(first && row < 3);
              const int trow = ok ? t0 - 3 + row : t0;
              xr_[i] = *(const GAS v4u*)(P.PROJB + (size_t)trow * INP + PC_XL + 64 * g + 8 * part); if (!ok) xr_[i] = v4u{0u, 0u, 0u, 0u}; }
          float cwv = 0.f; if (tid < 320) cwv = (tid < 256) ? P.cw[(tid >> 6) * 512 + 64 * g + (tid & 63)] : P.cb[64 * g + (tid - 256)];
#pragma unroll
          for (int i = 0; i < 2; ++i) { const int idx = tid + 512 * i; *(LAS v4u*)(lds + LR_WT + (idx >> 9) * 9216 + ((idx >> 3) & 63) * 144 + (idx & 7) * 16) = wt_[i]; }
#pragma unroll
          for (int i = 0; i < 5; ++i) { const int idx = tid + 512 * i, row = idx >> 3, part = idx & 7; if (idx < 259 * 8) *(LAS v4u*)(lds + LR_XR + row * 144 + 16 * part) = xr_[i]; }
          if (tid < 320) ((LAS float*)(lds + LR_CW))[tid] = cwv; }
        __syncthreads();
        { float cwr[4][8], cbr[8];
#pragma unroll
          for (int k = 0; k < 4; ++k) { const f32x4 c0 = *(const LAS f32x4*)(lds + LR_CW + (k * 64 + 8 * wave) * 4), c1 = *(const LAS f32x4*)(lds + LR_CW + (k * 64 + 8 * wave + 4) * 4);
              cwr[k][0] = c0.x; cwr[k][1] = c0.y; cwr[k][2] = c0.z; cwr[k][3] = c0.w; cwr[k][4] = c1.x; cwr[k][5] = c1.y; cwr[k][6] = c1.z; cwr[k][7] = c1.w; }
          { const f32x4 c0 = *(const LAS f32x4*)(lds + LR_CW + (256 + 8 * wave) * 4), c1 = *(const LAS f32x4*)(lds + LR_CW + (256 + 8 * wave + 4) * 4);
            cbr[0] = c0.x; cbr[1] = c0.y; cbr[2] = c0.z; cbr[3] = c0.w; cbr[4] = c1.x; cbr[5] = c1.y; cbr[6] = c1.z; cbr[7] = c1.w; }
#pragma unroll
          for (int it_ = 0; it_ < 4; ++it_) { const int time = lane + 64 * it_;
              float y[8];
#pragma unroll
              for (int e = 0; e < 8; ++e) y[e] = cbr[e];
#pragma unroll
              for (int k = 0; k < 4; ++k) { const v4u w = *(const LAS v4u*)(lds + LR_XR + (time + k) * 144 + 16 * wave);
                  y[0] += bflo(w.x) * cwr[k][0]; y[1] += bfhi(w.x) * cwr[k][1]; y[2] += bflo(w.y) * cwr[k][2]; y[3] += bfhi(w.y) * cwr[k][3];
                  y[4] += bflo(w.z) * cwr[k][4]; y[5] += bfhi(w.z) * cwr[k][5]; y[6] += bflo(w.w) * cwr[k][6]; y[7] += bfhi(w.w) * cwr[k][7]; }
              v4u o; o.x = pk2(y[0], y[1]); o.y = pk2(y[2], y[3]); o.z = pk2(y[4], y[5]); o.w = pk2(y[6], y[7]);
              *(LAS v4u*)(lds + LR_XA + time * 144 + 16 * wave) = o; } }
        __syncthreads();
        const int r32 = lane & 31, hi = lane >> 5;
        lr_f32x16 acc[2][2];
#pragma unroll
        for (int nt = 0; nt < 2; ++nt) { const float b_a = ba_[nt], b_x = bx_[nt];
#pragma unroll
            for (int r = 0; r < 16; ++r) { acc[0][nt][r] = b_a; acc[1][nt][r] = b_x; } }
        { lr_bf16x8 af[4];
#pragma unroll
          for (int s_ = 0; s_ < 4; ++s_) af[s_] = *(const LAS lr_bf16x8*)(lds + LR_XA + (32 * wave + r32) * 144 + (16 * s_ + 8 * hi) * 2);
#pragma unroll
          for (int gt = 0; gt < 2; ++gt)
#pragma unroll
              for (int nt = 0; nt < 2; ++nt)
#pragma unroll
                  for (int s_ = 0; s_ < 4; ++s_) { const lr_bf16x8 bfr = *(const LAS lr_bf16x8*)(lds + LR_WT + gt * 9216 + (32 * nt + r32) * 144 + (16 * s_ + 8 * hi) * 2);
                      acc[gt][nt] = __builtin_amdgcn_mfma_f32_32x32x16_bf16(af[s_], bfr, acc[gt][nt], 0, 0, 0); } }
#pragma unroll
        for (int nt = 0; nt < 2; ++nt) { const float sp = sp_[nt];
            float sa_[4], sh_[4];
#pragma unroll
            for (int q = 0; q < 4; ++q) { float hrun = 0.f, arun = 1.f;
#pragma unroll
                for (int e = 0; e < 4; ++e) { const int r = 4 * q + e, tl = 8 * q + 4 * hi + e;
                    const float xv = __builtin_bit_cast(float, (unsigned)*(const LAS unsigned short*)(lds + LR_XA + (32 * wave + tl) * 144 + (32 * nt + r32) * 2) << 16);
                    const float rg = __builtin_amdgcn_rcpf(1.f + __builtin_amdgcn_exp2f(-LOG2E * acc[0][nt][r])), ig = __builtin_amdgcn_rcpf(1.f + __builtin_amdgcn_exp2f(-LOG2E * acc[1][nt][r]));
                    const float la = -8.0f * rg * sp; const float a_ = __builtin_amdgcn_exp2f(LOG2E * la);
                    const float uu = __builtin_amdgcn_sqrtf(fmaxf(1.f - a_ * a_, 0.f)) * (ig * xv);
                    hrun = a_ * hrun + uu; arun *= a_; acc[0][nt][r] = arun; acc[1][nt][r] = hrun; }
                sa_[q] = arun; sh_[q] = hrun; }
            float runA = 1.f, runH = 0.f;
#pragma unroll
            for (int q = 0; q < 4; ++q) { float a0 = sa_[q], a1 = sa_[q], h0 = sh_[q], h1 = sh_[q]; lr_swap32(a0, a1); lr_swap32(h0, h1);
                const float midA = runA * a0, midH = a0 * runH + h0;
                const float inA = hi ? midA : runA, inH = hi ? midH : runH;
                runA = midA * a1; runH = a1 * midH + h1;
#pragma unroll
                for (int e = 0; e < 4; ++e) { const int r = 4 * q + e; acc[1][nt][r] += acc[0][nt][r] * inH; acc[0][nt][r] *= inA; } }
            if (hi == 0) { SUM[(wave * 64 + 32 * nt + r32) * 2] = runA; SUM[(wave * 64 + 32 * nt + r32) * 2 + 1] = runH; } }
        __syncthreads();
#pragma unroll
        for (int nt = 0; nt < 2; ++nt) { const int cl = 32 * nt + r32;
            float ca = 1.f, chh = 0.f;
            for (int w = 0; w < wave; ++w) { const float aw = SUM[(w * 64 + cl) * 2], hw = SUM[(w * 64 + cl) * 2 + 1]; chh = aw * chh + hw; ca *= aw; }
            GAS unsigned* ha = P.HA + (size_t)(t0 + 32 * wave + 4 * hi) * 512 + 64 * g + cl;
#pragma unroll
            for (int r = 0; r < 16; ++r) { const float hh = acc[1][nt][r] + acc[0][nt][r] * chh, ac_ = acc[0][nt][r] * ca; ha[(size_t)((r & 3) + 8 * (r >> 2)) * 512] = pk2(hh, ac_);
                if (r == 15 && wave == 7 && hi == 1) { P.LSUM[((size_t)tile * 512 + 64 * g + cl) * 2] = ac_; P.LSUM[((size_t)tile * 512 + 64 * g + cl) * 2 + 1] = hh; } } }
    }
}

struct PostP { const GAS bf16* OMB; const GAS unsigned* HA; const GAS float* LSUM; const GAS bf16* PROJB; const GAS float* gm; const GAS float* gl; GAS bf16* Y; };
__device__ __forceinline__ void post_phase(const PostP& P, LAS unsigned char* lds, int tid, int wave, int lane, int vcu, int G) {
    asm volatile("" : "+v"(tid), "+v"(lane));
    LAS float* hin = (LAS float*)lds;
    for (int u = vcu; u < T / 64; u += G) {
        const int t0 = u * 64, tile = t0 >> 8, tb = tile & ~31;
        __syncthreads();
        { float h = 0.f;
          for (int c0 = tb; c0 < tile; c0 += 8) {
              float av_[8], hv_[8];
#pragma unroll
              for (int i = 0; i < 8; ++i) { const int c = (c0 + i < tile) ? (c0 + i) : tb; av_[i] = P.LSUM[((size_t)c * 512 + tid) * 2]; hv_[i] = P.LSUM[((size_t)c * 512 + tid) * 2 + 1]; }
#pragma unroll
              for (int i = 0; i < 8; ++i) { if (c0 + i < tile) h = av_[i] * h + hv_[i]; } }
          hin[tid] = h; }
        __syncthreads();
        f32x4 hi0 = *(const LAS f32x4*)(hin + 8 * lane), hi1 = *(const LAS f32x4*)(hin + 8 * lane + 4);
        const f32x4 g0 = *(const GAS f32x4*)(P.gl + 8 * lane), g1 = *(const GAS f32x4*)(P.gl + 8 * lane + 4), gmv = *(const GAS f32x4*)(P.gm + 4 * lane);
#pragma unroll 2
        for (int i = 0; i < 8; ++i) {
            const size_t t = (size_t)t0 + 8 * wave + i;
            const v4u p0 = *(const GAS v4u*)(P.HA + t * 512 + 8 * lane), p1 = *(const GAS v4u*)(P.HA + t * 512 + 8 * lane + 4), gw_ = *(const GAS v4u*)(P.PROJB + t * INP + PC_GL + 8 * lane);
            const v2u mw = *(const GAS v2u*)(P.OMB + t * 256 + 4 * lane);
            float o[8];
            o[0] = (bflo(p0.x) + bfhi(p0.x) * hi0.x) * gelu_erf(bflo(gw_.x)); o[1] = (bflo(p0.y) + bfhi(p0.y) * hi0.y) * gelu_erf(bfhi(gw_.x));
            o[2] = (bflo(p0.z) + bfhi(p0.z) * hi0.z) * gelu_erf(bflo(gw_.y)); o[3] = (bflo(p0.w) + bfhi(p0.w) * hi0.w) * gelu_erf(bfhi(gw_.y));
            o[4] = (bflo(p1.x) + bfhi(p1.x) * hi1.x) * gelu_erf(bflo(gw_.z)); o[5] = (bflo(p1.y) + bfhi(p1.y) * hi1.y) * gelu_erf(bfhi(gw_.z));
            o[6] = (bflo(p1.z) + bfhi(p1.z) * hi1.z) * gelu_erf(bflo(gw_.w)); o[7] = (bflo(p1.w) + bfhi(p1.w) * hi1.w) * gelu_erf(bfhi(gw_.w));
            float s2 = 0.f;
#pragma unroll
            for (int e = 0; e < 8; ++e) s2 += o[e] * o[e];
            const float m0 = bflo(mw.x), m1 = bfhi(mw.x), m2 = bflo(mw.y), m3 = bfhi(mw.y);
            float s1 = (m0 * m0 + m1 * m1) + (m2 * m2 + m3 * m3);
            s1 = wave_sum(s1, lane); s2 = wave_sum(s2, lane);
            const float r1 = rsqrtf(s1 * (1.f / 256.f) + 1e-6f), r2 = rsqrtf(s2 * (1.f / 512.f) + 1e-6f);
            GAS bf16* yr = P.Y + t * 1024;
            { v2u w; w.x = pk2(m0 * r1 * gmv.x, m1 * r1 * gmv.y); w.y = pk2(m2 * r1 * gmv.z, m3 * r1 * gmv.w); *(GAS v2u*)(yr + 4 * lane) = w; }
            { v4u w; w.x = pk2(o[0] * r2 * g0.x, o[1] * r2 * g0.y); w.y = pk2(o[2] * r2 * g0.z, o[3] * r2 * g0.w); w.z = pk2(o[4] * r2 * g1.x, o[5] * r2 * g1.y); w.w = pk2(o[6] * r2 * g1.z, o[7] * r2 * g1.w);
              *(GAS v4u*)(yr + 256 + 8 * lane) = w; }
        }
    }
}

#define TILE_BAR() asm volatile("s_waitcnt lgkmcnt(0)\n\ts_barrier" ::: "memory")
typedef short bf16x8 __attribute__((ext_vector_type(8)));
typedef short s16x4 __attribute__((ext_vector_type(4)));
typedef float f32x16 __attribute__((ext_vector_type(16)));
typedef unsigned u32x4 __attribute__((ext_vector_type(4)));
__device__ __forceinline__ int crow(int r, int hi) { return (r & 3) + 8 * (r >> 2) + 4 * hi; }
typedef float f32x2_t __attribute__((ext_vector_type(2))); typedef __bf16 bf16x2_c __attribute__((ext_vector_type(2)));
__device__ __forceinline__ unsigned cvtpk(float lo, float hi) { f32x2_t v = {lo, hi}; bf16x2_c b = __builtin_convertvector(v, bf16x2_c); return __builtin_bit_cast(unsigned, b); }
__device__ __forceinline__ float swapmax(float m) { auto rr = __builtin_amdgcn_permlane32_swap(__float_as_uint(m), __float_as_uint(m), false, false); return fmaxf(__uint_as_float(rr[0]), __uint_as_float(rr[1])); }
__device__ __forceinline__ float swapadd(float m) { auto rr = __builtin_amdgcn_permlane32_swap(__float_as_uint(m), __float_as_uint(m), false, false); return __uint_as_float(rr[0]) + __uint_as_float(rr[1]); }
__device__ __forceinline__ s16x4 vtr(const LAS unsigned char* p) { return __builtin_bit_cast(s16x4, __builtin_amdgcn_ds_read_tr16_b64_v4i16((LAS s16x4*)p)); }
__device__ __forceinline__ bf16x8 pack8(const f32x16& p, int b) { u32x4 w; w.x = cvtpk(p[b], p[b + 1]); w.y = cvtpk(p[b + 2], p[b + 3]); w.z = cvtpk(p[b + 4], p[b + 5]); w.w = cvtpk(p[b + 6], p[b + 7]); return __builtin_bit_cast(bf16x8, w); }
__device__ __forceinline__ float vmax3(float a, float b, float c) { float r; asm("v_max3_f32 %0, %1, %2, %3" : "=v"(r) : "v"(a), "v"(b), "v"(c)); return r; }
__device__ __forceinline__ float max32(const f32x16& p, const f32x16& q) {
    float a = vmax3(p[0], p[1], p[2]), b = vmax3(p[3], p[4], p[5]), c = vmax3(p[6], p[7], p[8]), d = vmax3(p[9], p[10], p[11]), e = vmax3(p[12], p[13], p[14]);
    float f = vmax3(q[0], q[1], q[2]), g = vmax3(q[3], q[4], q[5]), h = vmax3(q[6], q[7], q[8]), i = vmax3(q[9], q[10], q[11]), j = vmax3(q[12], q[13], q[14]);
    a = vmax3(a, b, c); d = vmax3(d, e, p[15]); f = vmax3(f, g, h); i = vmax3(i, j, q[15]);
    return vmax3(vmax3(a, d, f), i, i);
}
__device__ __forceinline__ float max16(const f32x16& p) { float a = fmaxf(fmaxf(p[0], p[1]), fmaxf(p[2], p[3])), b = fmaxf(fmaxf(p[4], p[5]), fmaxf(p[6], p[7])), c = fmaxf(fmaxf(p[8], p[9]), fmaxf(p[10], p[11])), d = fmaxf(fmaxf(p[12], p[13]), fmaxf(p[14], p[15])); return fmaxf(fmaxf(a, b), fmaxf(c, d)); }

struct AttnP {
    const GAS bf16* Q; const GAS bf16* K; const GAS bf16* V; int qp, kp, vp;
    GAS bf16* O; int op;
    const GAS float* rope;
    const GAS int* pos; const GAS float* btab; const GAS float* dnorm; const GAS float* lams;
};
template <int KIND> struct AK {
    static constexpr bool DIFF = KIND == 1, CROSS = KIND == 2;
    static constexpr int HW = KIND == 0 ? 96 : KIND == 1 ? 64 : 256;
    static constexpr int NKS = KIND == 0 ? 6 : KIND == 1 ? 2 : 16;
    static constexpr int KP = KIND == 0 ? 208 : KIND == 1 ? 144 : 528;
    static constexpr int ND = CROSS ? 4 : 2;
    static constexpr int CPK = HW / 8, KCH = (64 * CPK + 511) / 512;
    static constexpr int VCH = ND / 2;
    static constexpr int KB = 64 * KP, VB = ND * 4096;
    static constexpr int NBUF = CROSS ? 2 : 3;
    static constexpr int K0 = 0, V0 = NBUF * KB, POS = V0 + NBUF * VB, BT = POS + 1024, DN = BT + 528, END = DN + 256;
};
static_assert(AK<2>::END <= RING_BYTES && AK<0>::END <= RING_BYTES && AK<1>::END + 16 + 8 * 8192 <= RING_BYTES, "attention LDS");

template <int KIND, bool LEAD>
__device__ __forceinline__ void attn_unit(const AttnP& P, int b, int h, int qb, int dhalf, LAS unsigned char* lds, int tid, int wave, int lane) {
    lane = lane_id_v(); tid = (wave << 6) | lane;
    typedef AK<KIND> C;
    constexpr bool DIFF = C::DIFF, CROSS = C::CROSS;
    constexpr int HW = C::HW, NKS = C::NKS, KP = C::KP, ND = C::ND, CPK = C::CPK, KCH = C::KCH, VCH = C::VCH;
    const int r32 = lane & 31, hi = lane >> 5;
    const size_t rowb = (size_t)b * S, rowk = CROSS ? (size_t)b * MEM : rowb;
    const int q0w = qb * 256 + wave * 32, qi = q0w + r32;
    int pq = 0; float bias_far = 0.f;
    __syncthreads();
    if (DIFF) {
        pq = P.pos[rowb + qi];
        if (tid < 129) ((LAS float*)(lds + C::BT))[tid] = P.btab[h * 129 + tid];
        if (tid >= 192 && tid < 256) ((LAS float*)(lds + C::DN))[tid - 192] = P.dnorm[tid - 192];
    }
    int minq = pq;
    if (DIFF) { for (int o = 1; o < 64; o <<= 1) { const int v = shxi(minq, o, lane); minq = v < minq ? v : minq; } }
    const int NT = CROSS ? MEM / 64 : 4 * (qb + 1);
    u32x4 kr[KCH], vr[VCH]; int pkr = 0;
    u32x4 kr2[CROSS ? 1 : KCH], vr2[CROSS ? 1 : VCH]; int pkr2 = 0;
    const GAS bf16* Kb = P.K + rowk * P.kp + h * HW; const GAS bf16* Vb = P.V + rowk * P.vp + (CROSS ? h * 256 + dhalf * 128 : h * 64);
    const __amdgpu_buffer_rsrc_t rK = __builtin_amdgcn_make_buffer_rsrc((void*)Kb, 0, 0x7fffffff, 0x00020000), rV = __builtin_amdgcn_make_buffer_rsrc((void*)Vb, 0, 0x7fffffff, 0x00020000);
    const __amdgpu_buffer_rsrc_t rP = __builtin_amdgcn_make_buffer_rsrc((void*)(DIFF ? P.pos + rowb : (const GAS int*)Kb), 0, 0x7fffffff, 0x00020000);
    int kvo[KCH], vvo[VCH];
#pragma unroll
    for (int i = 0; i < KCH; ++i) { int c = tid + 512 * i; c = c < 64 * CPK ? c : tid; kvo[i] = ((c / CPK) * P.kp + (c % CPK) * 8) * 2; }
#pragma unroll
    for (int i = 0; i < VCH; ++i) { const int c = tid + 512 * i; vvo[i] = ((c / (4 * ND)) * P.vp + (c % (4 * ND)) * 8) * 2; }
    const int pvo = (tid & 63) * 4;
    auto gload = [&](int t) {
        const int ks = __builtin_amdgcn_readfirstlane(64 * t * P.kp * 2), vs = __builtin_amdgcn_readfirstlane(64 * t * P.vp * 2);
#pragma unroll
        for (int i = 0; i < KCH; ++i) kr[i] = __builtin_amdgcn_raw_buffer_load_b128(rK, kvo[i], ks, 0);
#pragma unroll
        for (int i = 0; i < VCH; ++i) vr[i] = __builtin_amdgcn_raw_buffer_load_b128(rV, vvo[i], vs, 0);
        if (DIFF) pkr = __builtin_amdgcn_raw_buffer_load_b32(rP, pvo, __builtin_amdgcn_readfirstlane(64 * t * 4), 0);
    };
    auto lstore = [&](int buf) {
        LAS unsigned char* kb_ = lds + C::K0 + buf * C::KB; LAS unsigned char* vb_ = lds + C::V0 + buf * C::VB;
#pragma unroll
        for (int i = 0; i < KCH; ++i) { int c = tid + 512 * i; c = c < 64 * CPK ? c : tid; const int key = c / CPK, part = c % CPK; *(LAS u32x4*)(kb_ + key * KP + part * 16) = kr[i]; }
#pragma unroll
        for (int i = 0; i < VCH; ++i) { const int c = tid + 512 * i; const int key = c / (4 * ND), part = c % (4 * ND); *(LAS u32x4*)(vb_ + (part >> 2) * 4096 + (key >> 3) * 512 + (key & 7) * 64 + (part & 3) * 16) = vr[i]; }
        if (DIFF) { ((LAS int*)(lds + C::POS + buf * 256))[tid & 63] = pkr; if (tid < 64) { int mk_ = pkr; for (int o = 1; o < 64; o <<= 1) { const int v = shxi(mk_, o, lane); mk_ = v > mk_ ? v : mk_; } if (tid == 0) ((LAS int*)(lds + C::POS + 768))[buf] = mk_; } }
    };
    auto gloadB = [&](int t) {
        const int ks = __builtin_amdgcn_readfirstlane(64 * t * P.kp * 2), vs = __builtin_amdgcn_readfirstlane(64 * t * P.vp * 2);
#pragma unroll
        for (int i = 0; i < (CROSS ? 1 : KCH); ++i) kr2[i] = __builtin_amdgcn_raw_buffer_load_b128(rK, kvo[i], ks, 0);
#pragma unroll
        for (int i = 0; i < (CROSS ? 1 : VCH); ++i) vr2[i] = __builtin_amdgcn_raw_buffer_load_b128(rV, vvo[i], vs, 0);
        if (DIFF) pkr2 = __builtin_amdgcn_raw_buffer_load_b32(rP, pvo, __builtin_amdgcn_readfirstlane(64 * t * 4), 0);
    };
    auto lstoreB = [&](int buf) {
        LAS unsigned char* kb_ = lds + C::K0 + buf * C::KB; LAS unsigned char* vb_ = lds + C::V0 + buf * C::VB;
#pragma unroll
        for (int i = 0; i < (CROSS ? 1 : KCH); ++i) { int c = tid + 512 * i; c = c < 64 * CPK ? c : tid; const int key = c / CPK, part = c % CPK; *(LAS u32x4*)(kb_ + key * KP + part * 16) = kr2[i]; }
#pragma unroll
        for (int i = 0; i < (CROSS ? 1 : VCH); ++i) { const int c = tid + 512 * i; const int key = c / (4 * ND), part = c % (4 * ND); *(LAS u32x4*)(vb_ + (part >> 2) * 4096 + (key >> 3) * 512 + (key & 7) * 64 + (part & 3) * 16) = vr2[i]; }
        if (DIFF) { ((LAS int*)(lds + C::POS + buf * 256))[tid & 63] = pkr2; if (tid < 64) { int mk_ = pkr2; for (int o = 1; o < 64; o <<= 1) { const int v = shxi(mk_, o, lane); mk_ = v > mk_ ? v : mk_; } if (tid == 0) ((LAS int*)(lds + C::POS + 768))[buf] = mk_; } }
    };
    LAS float* osv = (LAS float*)(lds + ((C::END + 15) & ~15)) + wave * 2048 + lane;
    float il = 0.f;
    f32x16 oA[ND];
#pragma unroll 1
    for (int mp = 0; mp < (DIFF ? 2 : 1); ++mp) {
        bf16x8 qf[NKS];
        { const GAS bf16* qrow = P.Q + (rowb + qi) * P.qp + h * HW + mp * 32;
#pragma unroll
          for (int s = 0; s < NKS; ++s) qf[s] = *(const GAS bf16x8*)(qrow + 16 * s + 8 * hi);
          if (KIND == 0) {
              const GAS float* rp = P.rope + (rowb + qi) * 32 + 8 * hi;
              const f32x4 c0 = *(const GAS f32x4*)rp, c1 = *(const GAS f32x4*)(rp + 4), s0 = *(const GAS f32x4*)(rp + 16), s1 = *(const GAS f32x4*)(rp + 20);
              const u32x4 a = __builtin_bit_cast(u32x4, qf[NKS - 2]), bq = __builtin_bit_cast(u32x4, qf[NKS - 1]); u32x4 ra, rb;
#pragma unroll
              for (int w = 0; w < 4; ++w) { const float cl = w < 2 ? c0[2 * w] : c1[2 * w - 4], ch = w < 2 ? c0[2 * w + 1] : c1[2 * w - 3], sl = w < 2 ? s0[2 * w] : s1[2 * w - 4], sh = w < 2 ? s0[2 * w + 1] : s1[2 * w - 3];
                  const float x1l = bflo(a[w]), x1h = bfhi(a[w]), x2l = bflo(bq[w]), x2h = bfhi(bq[w]);
                  ra[w] = cvtpk(x1l * cl - x2l * sl, x1h * ch - x2h * sh); rb[w] = cvtpk(x1l * sl + x2l * cl, x1h * sh + x2h * ch); }
              qf[NKS - 2] = __builtin_bit_cast(bf16x8, ra); qf[NKS - 1] = __builtin_bit_cast(bf16x8, rb);
          } }
        __syncthreads();
        float m1 = -1e30f, l1 = 0.f;
#pragma unroll
        for (int d = 0; d < ND; ++d)
#pragma unroll
            for (int r = 0; r < 16; ++r) oA[d][r] = 0.f;
        auto qk = [&](int sl, f32x16& sa, f32x16& sb, float init) {
            const LAS unsigned char* kb_ = lds + C::K0 + sl * C::KB + r32 * KP + hi * 16 + mp * 64;
#pragma unroll
            for (int r = 0; r < 16; ++r) { sa[r] = init; sb[r] = init; }
            constexpr int HB = CROSS ? 4 : (NKS > 3 ? 3 : NKS);
#pragma unroll
            for (int s0_ = 0; s0_ < NKS; s0_ += HB) {
                bf16x8 kfa[HB], kfb[HB];
#pragma unroll
                for (int s = 0; s < HB; ++s) { kfa[s] = *(const LAS bf16x8*)(kb_ + (s0_ + s) * 32); kfb[s] = *(const LAS bf16x8*)(kb_ + 32 * KP + (s0_ + s) * 32); }
                __builtin_amdgcn_sched_barrier(0);
#pragma unroll
                for (int s = 0; s < HB; ++s) { sa = __builtin_amdgcn_mfma_f32_32x32x16_bf16(kfa[s], qf[s0_ + s], sa, 0, 0, 0); sb = __builtin_amdgcn_mfma_f32_32x32x16_bf16(kfb[s], qf[s0_ + s], sb, 0, 0, 0); }
                __builtin_amdgcn_sched_barrier(0);
            }
        };
        auto isnear = [&](int sl) { bool nb = false;
            if (DIFF) { const int mk_ = __builtin_amdgcn_readfirstlane(((LAS int*)(lds + C::POS + 768))[sl]); nb = (minq - mk_) < 128; }
            return nb; };
        auto sm = [&](int t, int sl, f32x16& pa, f32x16& pb, bool nearb) -> float {
            const int k0 = 64 * t;
            if (DIFF) { if (nearb) {
                const LAS int* pk = (const LAS int*)(lds + C::POS + sl * 256); const LAS float* bt = (const LAS float*)(lds + C::BT);
#pragma unroll
                for (int r = 0; r < 16; ++r) { const int kk = crow(r, hi);
                    int n0 = pq - pk[kk], n1 = pq - pk[kk + 32]; n0 = n0 < 0 ? 0 : (n0 > 128 ? 128 : n0); n1 = n1 < 0 ? 0 : (n1 > 128 ? 128 : n1);
                    pa[r] += bt[n0]; pb[r] += bt[n1]; }
            } }
            if (!CROSS && k0 + 63 > q0w) {
#pragma unroll
                for (int r = 0; r < 16; ++r) { const int kk = k0 + crow(r, hi); if (kk > qi) pa[r] = -1e30f; if (kk + 32 > qi) pb[r] = -1e30f; }
            }
            asm volatile("s_nop 15\n\ts_nop 7" : "+v"(pa), "+v"(pb));
            float mn, al = 1.f;
            if (CROSS) { const float mx = swapmax(max32(pa, pb)); mn = fmaxf(m1, mx); al = __builtin_amdgcn_exp2f(m1 - mn); l1 *= al; }
            else { const float mx = swapmax(max32(pa, pb)); const bool up = mx > m1 + 8.0f; mn = up ? mx : m1;
                   if (__builtin_amdgcn_ballot_w64(up) != 0ull) { al = __builtin_amdgcn_exp2f(m1 - mn); l1 *= al; } }
            m1 = mn;
            float ls = 0.f;
#pragma unroll
            for (int r = 0; r < 16; ++r) { pa[r] = __builtin_amdgcn_exp2f(pa[r] - mn); pb[r] = __builtin_amdgcn_exp2f(pb[r] - mn); ls += pa[r] + pb[r]; }
            l1 += ls;
            return al;
        };
        auto pv = [&](int sl, const f32x16& pa, const f32x16& pb, float al) {
            const LAS unsigned char* vb_ = lds + C::V0 + sl * C::VB + ((lane >> 4) & 1) * 32 + (lane & 3) * 8 + (4 * hi + ((lane & 15) >> 2)) * 64;
            bf16x8 pf[4];
            pf[0] = pack8(pa, 0); pf[1] = pack8(pa, 8); pf[2] = pack8(pb, 0); pf[3] = pack8(pb, 8);
            const bool resc = CROSS ? true : (__builtin_amdgcn_ballot_w64(al != 1.0f) != 0ull);
            if (CROSS) {
#pragma unroll
                for (int d = 0; d < ND; ++d) {
                    __builtin_amdgcn_sched_barrier(0);
#pragma unroll
                    for (int r = 0; r < 16; ++r) oA[d][r] *= al;
                    bf16x8 vf[4];
#pragma unroll
                    for (int s = 0; s < 4; ++s) { const s16x4 lo = vtr(vb_ + d * 4096 + s * 1024), hh = vtr(vb_ + d * 4096 + s * 1024 + 512); vf[s] = (bf16x8){lo[0], lo[1], lo[2], lo[3], hh[0], hh[1], hh[2], hh[3]}; }
#pragma unroll
                    for (int s = 0; s < 4; ++s) oA[d] = __builtin_amdgcn_mfma_f32_32x32x16_bf16(vf[s], pf[s], oA[d], 0, 0, 0);
                }
            } else if (DIFF) {
                if (resc) {
#pragma unroll
                    for (int d = 0; d < 2; ++d)
#pragma unroll
                        for (int r = 0; r < 16; ++r) oA[d][r] *= al;
                }
#pragma unroll
                for (int d = 0; d < 2; ++d) {
                    bf16x8 vf[4];
#pragma unroll
                    for (int s = 0; s < 4; ++s) { const s16x4 lo = vtr(vb_ + d * 4096 + s * 1024), hh = vtr(vb_ + d * 4096 + s * 1024 + 512); vf[s] = (bf16x8){lo[0], lo[1], lo[2], lo[3], hh[0], hh[1], hh[2], hh[3]}; }
                    __builtin_amdgcn_sched_barrier(0);
#pragma unroll
                    for (int s = 0; s < 4; ++s) oA[d] = __builtin_amdgcn_mfma_f32_32x32x16_bf16(vf[s], pf[s], oA[d], 0, 0, 0);
                }
            } else {
                bf16x8 vf[2][4];
#pragma unroll
                for (int d = 0; d < 2; ++d)
#pragma unroll
                    for (int s = 0; s < 4; ++s) { const s16x4 lo = vtr(vb_ + d * 4096 + s * 1024), hh = vtr(vb_ + d * 4096 + s * 1024 + 512); vf[d][s] = (bf16x8){lo[0], lo[1], lo[2], lo[3], hh[0], hh[1], hh[2], hh[3]}; }
                if (resc) {
#pragma unroll
                    for (int d = 0; d < 2; ++d)
#pragma unroll
                        for (int r = 0; r < 16; ++r) oA[d][r] *= al;
                }
                __builtin_amdgcn_sched_barrier(0);
#pragma unroll
                for (int s = 0; s < 4; ++s)
#pragma unroll
                    for (int d = 0; d < 2; ++d) oA[d] = __builtin_amdgcn_mfma_f32_32x32x16_bf16(vf[d][s], pf[s], oA[d], 0, 0, 0);
            }
        };
        if (CROSS) {
            gload(0); lstore(0);
            __syncthreads();
            for (int t = 0; t < NT; ++t) {
                const int buf = t & 1;
                f32x16 pa, pb;
                qk(buf, pa, pb, 0.f);
                const float al = sm(t, buf, pa, pb, false);
                pv(buf, pa, pb, al);
                if (t + 1 < NT) { gload(t + 1); lstore(buf ^ 1); }
                TILE_BAR();
            }
        } else {
            gload(0); lstore(0); gload(1); lstore(1);
            gload(2); gloadB(3);
            __syncthreads();
            if (DIFF) bias_far = ((LAS float*)(lds + C::BT))[128];
            const int NTW = (q0w + 31) / 64 + 1;
            constexpr bool lead = LEAD;
            f32x16 ca, cb, na, nb; bool cnear = isnear(0), nnear = false; float cal = 1.f;
            qk(0, ca, cb, (DIFF && !cnear) ? bias_far : 0.f);
            if (lead) cal = sm(0, 0, ca, cb, cnear);
            int s0 = 0, s1 = 1, s2 = 2;
            auto period = [&](int t, f32x16& xa, f32x16& xb, bool& xnear, f32x16& ya, f32x16& yb, bool& ynear) {
                const bool have_next = (t + 1 < NTW);
                if (lead) {
                    if (have_next) { ynear = isnear(s1); qk(s1, ya, yb, (DIFF && !ynear) ? bias_far : 0.f); }
                    if (t < NTW) pv(s0, xa, xb, cal);
                    if (have_next) cal = sm(t + 1, s1, ya, yb, ynear);
                } else {
                    if (t < NTW) cal = sm(t, s0, xa, xb, xnear);
                    if (have_next) { ynear = isnear(s1); qk(s1, ya, yb, (DIFF && !ynear) ? bias_far : 0.f); }
                    if (t < NTW) pv(s0, xa, xb, cal);
                }
                { const int tmp = s0; s0 = s1; s1 = s2; s2 = tmp; }
            };
            int t = 0;
            for (; t + 5 < NT; t += 2) {
                lstore(s2); gload(t + 4);
                period(t, ca, cb, cnear, na, nb, nnear);
                TILE_BAR();
                lstoreB(s2); gloadB(t + 5);
                period(t + 1, na, nb, nnear, ca, cb, cnear);
                TILE_BAR();
            }
            for (; t < NT; t += 2) {
                if (t + 2 < NT) { lstore(s2); if (t + 4 < NT) gload(t + 4); }
                period(t, ca, cb, cnear, na, nb, nnear);
                TILE_BAR();
                if (t + 3 < NT) { lstoreB(s2); if (t + 5 < NT) gloadB(t + 5); }
                period(t + 1, na, nb, nnear, ca, cb, cnear);
                TILE_BAR();
            }
        }
        il = 1.f / swapadd(l1);
        if (DIFF) { if (mp == 0) {
#pragma unroll
            for (int d = 0; d < 2; ++d)
#pragma unroll
                for (int r = 0; r < 16; ++r) osv[(d * 16 + r) * 64] = oA[d][r] * il; } }
    }
    GAS bf16* orow = P.O + (rowb + qi) * P.op + (CROSS ? h * 256 + dhalf * 128 : h * 64);
    if (!DIFF) {
#pragma unroll
        for (int d = 0; d < ND; ++d)
#pragma unroll
            for (int g = 0; g < 4; ++g) { v2u v; v.x = cvtpk(oA[d][4 * g] * il, oA[d][4 * g + 1] * il); v.y = cvtpk(oA[d][4 * g + 2] * il, oA[d][4 * g + 3] * il); *(GAS v2u*)(orow + 32 * d + 8 * g + 4 * hi) = v; }
    } else {
        const float lam = P.lams[0], lam_init = P.lams[1];
        const float i2 = lam * il;
        float ss = 0.f;
#pragma unroll
        for (int d = 0; d < 2; ++d)
#pragma unroll
            for (int r = 0; r < 16; ++r) { const float v = osv[(d * 16 + r) * 64] - oA[d][r] * i2; oA[d][r] = v; ss += v * v; }
        ss = swapadd(ss);
        const float rs = __builtin_amdgcn_rsqf(ss * (1.f / 64.f) + 1e-6f) * (1.f - lam_init);
        const LAS float* dn = (const LAS float*)(lds + C::DN);
#pragma unroll
        for (int d = 0; d < 2; ++d)
#pragma unroll
            for (int g = 0; g < 4; ++g) { const int c = 32 * d + 8 * g + 4 * hi; const f32x4 gn = *(const LAS f32x4*)(dn + c);
                v2u v; v.x = cvtpk(oA[d][4 * g] * rs * gn[0], oA[d][4 * g + 1] * rs * gn[1]); v.y = cvtpk(oA[d][4 * g + 2] * rs * gn[2], oA[d][4 * g + 3] * rs * gn[3]); *(GAS v2u*)(orow + c) = v; }
    }
}

__device__ __forceinline__ int wave_max_i(int v) {
    { const int o = __builtin_amdgcn_update_dpp(0, v, 0xB1, 0xF, 0xF, true); v = o > v ? o : v; }
    { const int o = __builtin_amdgcn_update_dpp(0, v, 0x4E, 0xF, 0xF, true); v = o > v ? o : v; }
    { const int o = __builtin_amdgcn_update_dpp(0, v, 0x141, 0xF, 0xF, true); v = o > v ? o : v; }
    { const int o = __builtin_amdgcn_update_dpp(0, v, 0x140, 0xF, 0xF, true); v = o > v ? o : v; }
    { int a = v, b = v; asm volatile("v_nop\n\tv_nop\n\tv_permlane16_swap_b32 %0, %1" : "+v"(a), "+v"(b)); v = a > b ? a : b; }
    { int a = v, b = v; asm volatile("v_nop\n\tv_nop\n\tv_permlane32_swap_b32 %0, %1" : "+v"(a), "+v"(b)); v = a > b ? a : b; }
    return v;
}
template <int KIND> struct AK2 {
    static constexpr bool DIFF = KIND == 1;
    static constexpr int HW = KIND == 0 ? 96 : 64, NKS = KIND == 0 ? 6 : 2, KP = KIND == 0 ? 208 : 144;
    static constexpr int CPK = HW / 8, KCH = (128 * CPK) / 512, VCH = 2;
    static constexpr int KB = 128 * KP, VB = 2 * 8192;
    static constexpr int K0 = 0, V0 = 2 * KB, POS = V0 + 2 * VB, PMX = POS + 1024, BT = PMX + 16, DN = BT + 528, OSV = (DN + 256 + 15) & ~15, END = OSV + (DIFF ? 8 * 8192 : 0);
};
static_assert(AK2<0>::END <= RING_BYTES && AK2<1>::END <= RING_BYTES, "attention LDS (128-key tiles)");
template <int KIND>
__device__ __forceinline__ void attn_unit2(const AttnP& P, int b, int h, int qb, LAS unsigned char* lds, int tid, int wave, int lane) {
    lane = lane_id_v(); tid = (wave << 6) | lane;
    typedef AK2<KIND> C;
    constexpr bool DIFF = C::DIFF;
    constexpr int HW = C::HW, NKS = C::NKS, KP = C::KP, CPK = C::CPK, KCH = C::KCH, VCH = C::VCH;
    const int r32 = lane & 31, hi = lane >> 5;
    const size_t rowb = (size_t)b * S;
    const int q0w = qb * 256 + wave * 32, qi = q0w + r32;
    int pq = 0; float bias_far = 0.f;
    __syncthreads();
    if (DIFF) {
        pq = P.pos[rowb + qi];
        if (tid < 129) ((LAS float*)(lds + C::BT))[tid] = P.btab[h * 129 + tid];
        if (tid >= 192 && tid < 256) ((LAS float*)(lds + C::DN))[tid - 192] = P.dnorm[tid - 192];
    }
    int minq = pq;
    if (DIFF) minq = __builtin_amdgcn_readfirstlane(-wave_max_i(-pq));
    const int NT = 2 * (qb + 1);
    const GAS bf16* Kb = P.K + rowb * P.kp + h * HW; const GAS bf16* Vb = P.V + rowb * P.vp + h * 64;
    const __amdgpu_buffer_rsrc_t rK = __builtin_amdgcn_make_buffer_rsrc((void*)Kb, 0, 0x7fffffff, 0x00020000), rV = __builtin_amdgcn_make_buffer_rsrc((void*)Vb, 0, 0x7fffffff, 0x00020000);
    const __amdgpu_buffer_rsrc_t rP = __builtin_amdgcn_make_buffer_rsrc((void*)(DIFF ? P.pos + rowb : (const GAS int*)Kb), 0, 0x7fffffff, 0x00020000);
    int kvo[KCH], vvo[VCH], klo[KCH], vlo[VCH];
#pragma unroll
    for (int i = 0; i < KCH; ++i) { const int c = tid + 512 * i; kvo[i] = ((c / CPK) * P.kp + (c % CPK) * 8) * 2; klo[i] = (c / CPK) * KP + (c % CPK) * 16; }
#pragma unroll
    for (int i = 0; i < VCH; ++i) { const int c = tid + 512 * i; const int key = c >> 3, part = c & 7; vvo[i] = (key * P.vp + part * 8) * 2; vlo[i] = (part >> 2) * 8192 + (key >> 3) * 512 + (key & 7) * 64 + (part & 3) * 16; }
    const int pvo = (tid & 127) * 4;
    u32x4 kr[KCH], vr[VCH]; int pkr = 0;
    auto gload = [&](int t) {
        const int ks = __builtin_amdgcn_readfirstlane(128 * t * P.kp * 2), vs = __builtin_amdgcn_readfirstlane(128 * t * P.vp * 2);
#pragma unroll
        for (int i = 0; i < KCH; ++i) kr[i] = __builtin_amdgcn_raw_buffer_load_b128(rK, kvo[i], ks, 0);
#pragma unroll
        for (int i = 0; i < VCH; ++i) vr[i] = __builtin_amdgcn_raw_buffer_load_b128(rV, vvo[i], vs, 0);
        if (DIFF) pkr = __builtin_amdgcn_raw_buffer_load_b32(rP, pvo, __builtin_amdgcn_readfirstlane(128 * t * 4), 0);
    };
    auto lstore = [&](int buf) {
        LAS unsigned char* kb_ = lds + C::K0 + buf * C::KB; LAS unsigned char* vb_ = lds + C::V0 + buf * C::VB;
#pragma unroll
        for (int i = 0; i < KCH; ++i) *(LAS u32x4*)(kb_ + klo[i]) = kr[i];
#pragma unroll
        for (int i = 0; i < VCH; ++i) *(LAS u32x4*)(vb_ + vlo[i]) = vr[i];
        if (DIFF) { ((LAS int*)(lds + C::POS + buf * 512))[tid & 127] = pkr;
            if (tid < 128) { const int mk_ = wave_max_i(pkr); if (lane == 0) ((LAS int*)(lds + C::PMX))[buf * 2 + wave] = mk_; } }
    };
    LAS float* osv = (LAS float*)(lds + C::OSV) + wave * 2048 + lane;
    float il = 0.f;
    f32x16 oA[2];
#pragma unroll 1
    for (int mp = 0; mp < (DIFF ? 2 : 1); ++mp) {
        bf16x8 qf[NKS];
        { const GAS bf16* qrow = P.Q + (rowb + qi) * P.qp + h * HW + mp * 32;
#pragma unroll
          for (int s = 0; s < NKS; ++s) qf[s] = *(const GAS bf16x8*)(qrow + 16 * s + 8 * hi);
          if (KIND == 0) {
              const GAS float* rp = P.rope + (rowb + qi) * 32 + 8 * hi;
              const f32x4 c0 = *(const GAS f32x4*)rp, c1 = *(const GAS f32x4*)(rp + 4), s0 = *(const GAS f32x4*)(rp + 16), s1 = *(const GAS f32x4*)(rp + 20);
              const u32x4 a = __builtin_bit_cast(u32x4, qf[NKS - 2]), bq = __builtin_bit_cast(u32x4, qf[NKS - 1]); u32x4 ra, rb;
#pragma unroll
              for (int w = 0; w < 4; ++w) { const float cl = w < 2 ? c0[2 * w] : c1[2 * w - 4], ch = w < 2 ? c0[2 * w + 1] : c1[2 * w - 3], sl = w < 2 ? s0[2 * w] : s1[2 * w - 4], sh = w < 2 ? s0[2 * w + 1] : s1[2 * w - 3];
                  const float x1l = bflo(a[w]), x1h = bfhi(a[w]), x2l = bflo(bq[w]), x2h = bfhi(bq[w]);
                  ra[w] = cvtpk(x1l * cl - x2l * sl, x1h * ch - x2h * sh); rb[w] = cvtpk(x1l * sl + x2l * cl, x1h * sh + x2h * ch); }
              qf[NKS - 2] = __builtin_bit_cast(bf16x8, ra); qf[NKS - 1] = __builtin_bit_cast(bf16x8, rb);
          } }
        __syncthreads();
        float m1 = 0.f, l1 = 0.f;
        f32x16 negm;
#pragma unroll
        for (int r = 0; r < 16; ++r) negm[r] = 0.f;
#pragma unroll
        for (int d = 0; d < 2; ++d)
#pragma unroll
            for (int r = 0; r < 16; ++r) oA[d][r] = 0.f;
        gload(0); lstore(0);
        if (NT > 1) gload(1);
        __syncthreads();
        if (DIFF) { bias_far = ((LAS float*)(lds + C::BT))[128];
#pragma unroll
            for (int r = 0; r < 16; ++r) negm[r] = bias_far; }
        const int NTW = (q0w + 31) / 128 + 1;
        auto compute = [&](int t, int buf) {
            const int k0 = 128 * t;
            const LAS unsigned char* kb_ = lds + C::K0 + buf * C::KB + r32 * KP + hi * 16 + mp * 64;
            const LAS unsigned char* vb_ = lds + C::V0 + buf * C::VB + ((lane >> 4) & 1) * 32 + (lane & 3) * 8 + (4 * hi + ((lane & 15) >> 2)) * 64;
            bool nearb = false;
            if (DIFF) { const LAS int* pm = (const LAS int*)(lds + C::PMX) + buf * 2; const int m0 = __builtin_amdgcn_readfirstlane(pm[0]), m1_ = __builtin_amdgcn_readfirstlane(pm[1]); nearb = (minq - (m0 > m1_ ? m0 : m1_)) < 128; }
            f32x16 sc[4];
            if (DIFF) { if (nearb) {
#pragma unroll
                for (int g = 0; g < 4; ++g)
#pragma unroll
                    for (int r = 0; r < 16; ++r) sc[g][r] = -m1; } }
            constexpr int HB = NKS > 3 ? 3 : NKS;
#pragma unroll
            for (int s0_ = 0; s0_ < NKS; s0_ += HB) {
                bf16x8 kf[4][HB];
#pragma unroll
                for (int g = 0; g < 4; ++g)
#pragma unroll
                    for (int s = 0; s < HB; ++s) kf[g][s] = *(const LAS bf16x8*)(kb_ + 32 * g * KP + (s0_ + s) * 32);
                __builtin_amdgcn_sched_barrier(0);
#pragma unroll
                for (int s = 0; s < HB; ++s)
#pragma unroll
                    for (int g = 0; g < 4; ++g) {
                        if (s0_ + s == 0 && !(DIFF && nearb)) sc[g] = __builtin_amdgcn_mfma_f32_32x32x16_bf16(kf[g][s], qf[s0_ + s], negm, 0, 0, 0);
                        else sc[g] = __builtin_amdgcn_mfma_f32_32x32x16_bf16(kf[g][s], qf[s0_ + s], sc[g], 0, 0, 0); }
                __builtin_amdgcn_sched_barrier(0);
            }
            if (DIFF) { if (nearb) {
                const LAS int* pk = (const LAS int*)(lds + C::POS + buf * 512); const LAS float* bt = (const LAS float*)(lds + C::BT);
#pragma unroll
                for (int g = 0; g < 4; ++g)
#pragma unroll
                    for (int r = 0; r < 16; ++r) { int n0 = pq - pk[32 * g + crow(r, hi)]; n0 = n0 < 0 ? 0 : (n0 > 128 ? 128 : n0); sc[g][r] += bt[n0]; }
            } }
            asm volatile("s_nop 15\n\ts_nop 7" : "+v"(sc[0]), "+v"(sc[1]), "+v"(sc[2]), "+v"(sc[3]));
            if (k0 + 127 > q0w) {
#pragma unroll
                for (int g = 0; g < 4; ++g)
#pragma unroll
                    for (int r = 0; r < 16; ++r) { if (k0 + 32 * g + crow(r, hi) > qi) sc[g][r] = -1e30f; }
            }
            const float mx = swapmax(vmax3(max32(sc[0], sc[1]), max32(sc[2], sc[3]), -1e30f));
            const bool up = (t == 0) || mx > 8.0f;
            float al = 1.f;
            if (__builtin_amdgcn_ballot_w64(up) != 0ull) {
                const float dl = up ? mx : 0.f; al = __builtin_amdgcn_exp2f(-dl); l1 *= al; m1 += dl;
#pragma unroll
                for (int r = 0; r < 16; ++r) negm[r] -= dl;
#pragma unroll
                for (int g = 0; g < 4; ++g)
#pragma unroll
                    for (int r = 0; r < 16; ++r) sc[g][r] -= dl;
            }
            float ls = 0.f;
#pragma unroll
            for (int g = 0; g < 4; ++g)
#pragma unroll
                for (int r = 0; r < 16; ++r) { sc[g][r] = __builtin_amdgcn_exp2f(sc[g][r]); ls += sc[g][r]; }
            l1 += ls;
            bf16x8 pf[8];
#pragma unroll
            for (int g = 0; g < 4; ++g) { pf[2 * g] = pack8(sc[g], 0); pf[2 * g + 1] = pack8(sc[g], 8); }
            if (__builtin_amdgcn_ballot_w64(al != 1.0f) != 0ull) {
#pragma unroll
                for (int d = 0; d < 2; ++d)
#pragma unroll
                    for (int r = 0; r < 16; ++r) oA[d][r] *= al;
            }
#pragma unroll
            for (int d = 0; d < 2; ++d) {
                bf16x8 vf[8];
#pragma unroll
                for (int s = 0; s < 8; ++s) { const s16x4 lo = vtr(vb_ + d * 8192 + s * 1024), hh = vtr(vb_ + d * 8192 + s * 1024 + 512); vf[s] = (bf16x8){lo[0], lo[1], lo[2], lo[3], hh[0], hh[1], hh[2], hh[3]}; }
                __builtin_amdgcn_sched_barrier(0);
#pragma unroll
                for (int s = 0; s < 8; ++s) oA[d] = __builtin_amdgcn_mfma_f32_32x32x16_bf16(vf[s], pf[s], oA[d], 0, 0, 0);
                __builtin_amdgcn_sched_barrier(0);
            }
        };
        int t = 0;
        for (; t + 2 < NT; ++t) {
            const int buf = t & 1;
            if (t < NTW) compute(t, buf);
            lstore(buf ^ 1); gload(t + 2);
            TILE_BAR();
        }
        for (; t < NT; ++t) {
            const int buf = t & 1;
            if (t < NTW) compute(t, buf);
            if (t + 1 < NT) lstore(buf ^ 1);
            TILE_BAR();
        }
        il = 1.f / swapadd(l1);
        if (DIFF) { if (mp == 0) {
#pragma unroll
            for (int d = 0; d < 2; ++d)
#pragma unroll
                for (int r = 0; r < 16; ++r) osv[(d * 16 + r) * 64] = oA[d][r] * il; } }
    }
    GAS bf16* orow = P.O + (rowb + qi) * P.op + h * 64;
    if (!DIFF) {
#pragma unroll
        for (int d = 0; d < 2; ++d)
#pragma unroll
            for (int g = 0; g < 4; ++g) { v2u v; v.x = cvtpk(oA[d][4 * g] * il, oA[d][4 * g + 1] * il); v.y = cvtpk(oA[d][4 * g + 2] * il, oA[d][4 * g + 3] * il); *(GAS v2u*)(orow + 32 * d + 8 * g + 4 * hi) = v; }
    } else {
        const float lam = P.lams[0], lam_init = P.lams[1];
        const float i2 = lam * il;
        float ss = 0.f;
#pragma unroll
        for (int d = 0; d < 2; ++d)
#pragma unroll
            for (int r = 0; r < 16; ++r) { const float v = osv[(d * 16 + r) * 64] - oA[d][r] * i2; oA[d][r] = v; ss += v * v; }
        ss = swapadd(ss);
        const float rs = __builtin_amdgcn_rsqf(ss * (1.f / 64.f) + 1e-6f) * (1.f - lam_init);
        const LAS float* dn = (const LAS float*)(lds + C::DN);
#pragma unroll
        for (int d = 0; d < 2; ++d)
#pragma unroll
            for (int g = 0; g < 4; ++g) { const int c = 32 * d + 8 * g + 4 * hi; const f32x4 gn = *(const LAS f32x4*)(dn + c);
                v2u v; v.x = cvtpk(oA[d][4 * g] * rs * gn[0], oA[d][4 * g + 1] * rs * gn[1]); v.y = cvtpk(oA[d][4 * g + 2] * rs * gn[2], oA[d][4 * g + 3] * rs * gn[3]); *(GAS v2u*)(orow + c) = v; }
    }
}

__device__ __forceinline__ void attn_phase(const AttnP& PM, const AttnP& PD, LAS unsigned char* lds, int tid, int wave, int lane, int vcu, int G, int only = -1) {
    for (int i = vcu; i < 512; i += G) {
        if (only >= 0 && (i >> 8) != only) continue;
        const int kind = i >> 8, c = i & 255, bh = c >> 4, s = c & 15;
        if (kind == 0) {
#pragma unroll 1
            for (int k = 0; k < 2; ++k) attn_unit2<0>(PM, bh >> 2, bh & 3, k ? 31 - s : s, lds, tid, wave, lane);
        } else {
#pragma unroll 1
            for (int k = 0; k < 2; ++k) attn_unit2<1>(PD, bh >> 2, bh & 3, k ? 31 - s : s, lds, tid, wave, lane);
        }
    }
}
__device__ __forceinline__ float cx_max16(const f32x16& p) { return fmaxf(fmaxf(fmaxf(fmaxf(p[0], p[1]), fmaxf(p[2], p[3])), fmaxf(fmaxf(p[4], p[5]), fmaxf(p[6], p[7]))), fmaxf(fmaxf(fmaxf(p[8], p[9]), fmaxf(p[10], p[11])), fmaxf(fmaxf(p[12], p[13]), fmaxf(p[14], p[15])))); }
__device__ __forceinline__ void cross_unit2(const AttnP& P, int b, int h, int qb, LAS unsigned char* lds, int wave) {
    const int lane = lane_id_v(), tid = (wave << 6) | lane;
    constexpr int KP = 528;
    const int r32 = lane & 31, hi = lane >> 5;
    const size_t rowb = (size_t)b * S, rowk = (size_t)b * MEM;
    const int qi = qb * 256 + wave * 32 + r32;
    const GAS bf16* Kb = P.K + rowk * P.kp + h * 256; const GAS bf16* Vb = P.V + rowk * P.vp + h * 256;
    const __amdgpu_buffer_rsrc_t rK = __builtin_amdgcn_make_buffer_rsrc((void*)Kb, 0, 0x7fffffff, 0x00020000), rV = __builtin_amdgcn_make_buffer_rsrc((void*)Vb, 0, 0x7fffffff, 0x00020000);
    const GAS bf16* qrow = P.Q + (rowb + qi) * P.qp + h * 256 + 8 * hi;
    bf16x8 qf[4];
#pragma unroll
    for (int s = 0; s < 4; ++s) qf[s] = *(const GAS bf16x8*)(qrow + 16 * s);
    { u32x4 st[16];
#pragma unroll
      for (int i = 0; i < 16; ++i) { const int c = tid + 512 * i; st[i] = __builtin_amdgcn_raw_buffer_load_b128(rK, ((c >> 5) * P.kp + (c & 31) * 8) * 2, 0, 0); }
      TILE_BAR();
#pragma unroll
      for (int i = 0; i < 16; ++i) { const int c = tid + 512 * i; *(LAS u32x4*)(lds + (c >> 5) * KP + (c & 31) * 16) = st[i]; } }
    __syncthreads();
    f32x16 sc[8];
#pragma unroll
    for (int g = 0; g < 8; ++g)
#pragma unroll
        for (int r = 0; r < 16; ++r) sc[g][r] = 0.f;
    const LAS unsigned char* kb_ = lds + r32 * KP + hi * 16;
#pragma unroll
    for (int c = 0; c < 4; ++c) {
        bf16x8 qn[4];
        if (c + 1 < 4) {
#pragma unroll
            for (int s = 0; s < 4; ++s) qn[s] = *(const GAS bf16x8*)(qrow + 64 * (c + 1) + 16 * s); }
#pragma unroll
        for (int g = 0; g < 8; ++g) { bf16x8 kf[4];
#pragma unroll
            for (int s = 0; s < 4; ++s) kf[s] = *(const LAS bf16x8*)(kb_ + 32 * g * KP + (4 * c + s) * 32);
#pragma unroll
            for (int s = 0; s < 4; ++s) sc[g] = __builtin_amdgcn_mfma_f32_32x32x16_bf16(kf[s], qf[s], sc[g], 0, 0, 0); }
        if (c + 1 < 4) {
#pragma unroll
            for (int s = 0; s < 4; ++s) qf[s] = qn[s]; }
    }
    float m = fmaxf(fmaxf(fmaxf(cx_max16(sc[0]), cx_max16(sc[1])), fmaxf(cx_max16(sc[2]), cx_max16(sc[3]))), fmaxf(fmaxf(cx_max16(sc[4]), cx_max16(sc[5])), fmaxf(cx_max16(sc[6]), cx_max16(sc[7]))));
    m = swapmax(m);
    float l = 0.f;
    bf16x8 pf[16];
#pragma unroll
    for (int g = 0; g < 8; ++g) {
#pragma unroll
        for (int r = 0; r < 16; ++r) { sc[g][r] = __builtin_amdgcn_exp2f(sc[g][r] - m); l += sc[g][r]; }
        pf[2 * g] = pack8(sc[g], 0); pf[2 * g + 1] = pack8(sc[g], 8); }
    const float il = 1.f / swapadd(l);
    { u32x4 st[16];
#pragma unroll
      for (int i = 0; i < 16; ++i) { const int c = tid + 512 * i; const int sub = c & 3, key = (c >> 2) & 255, dt = c >> 10; st[i] = __builtin_amdgcn_raw_buffer_load_b128(rV, (key * P.vp + dt * 32 + sub * 8) * 2, 0, 0); }
      TILE_BAR();
#pragma unroll
      for (int i = 0; i < 16; ++i) { const int c = tid + 512 * i; const int sub = c & 3, key = (c >> 2) & 255, dt = c >> 10; *(LAS u32x4*)(lds + dt * 16384 + (key >> 3) * 512 + (key & 7) * 64 + sub * 16) = st[i]; } }
    __syncthreads();
    const LAS unsigned char* vb_ = lds + ((lane >> 4) & 1) * 32 + (lane & 3) * 8 + (4 * hi + ((lane & 15) >> 2)) * 64;
    GAS bf16* orow = P.O + (rowb + qi) * P.op + h * 256;
#pragma unroll 1
    for (int dh = 0; dh < 2; ++dh) {
        f32x16 oA[4];
#pragma unroll
        for (int d = 0; d < 4; ++d)
#pragma unroll
            for (int r = 0; r < 16; ++r) oA[d][r] = 0.f;
#pragma unroll
        for (int d = 0; d < 4; ++d) {
#pragma unroll
            for (int sb = 0; sb < 2; ++sb) { bf16x8 vf[8];
#pragma unroll
                for (int s = 0; s < 8; ++s) { const s16x4 lo = vtr(vb_ + (4 * dh + d) * 16384 + (8 * sb + s) * 1024), hh = vtr(vb_ + (4 * dh + d) * 16384 + (8 * sb + s) * 1024 + 512); vf[s] = (bf16x8){lo[0], lo[1], lo[2], lo[3], hh[0], hh[1], hh[2], hh[3]}; }
#pragma unroll
                for (int s = 0; s < 8; ++s) oA[d] = __builtin_amdgcn_mfma_f32_32x32x16_bf16(vf[s], pf[8 * sb + s], oA[d], 0, 0, 0); } }
#pragma unroll
        for (int d = 0; d < 4; ++d)
#pragma unroll
            for (int g = 0; g < 4; ++g) { v2u v; v.x = cvtpk(oA[d][4 * g] * il, oA[d][4 * g + 1] * il); v.y = cvtpk(oA[d][4 * g + 2] * il, oA[d][4 * g + 3] * il); *(GAS v2u*)(orow + 128 * dh + 32 * d + 8 * g + 4 * hi) = v; }
    }
}
__device__ __forceinline__ void cross_phase(const AttnP& PC, LAS unsigned char* lds, int tid, int wave, int lane, int vcu, int G) {
#pragma unroll 1
    for (int i = vcu; i < 512; i += G) { const int bh = i >> 5; cross_unit2(PC, bh >> 2, bh & 3, i & 31, lds, wave); }
}


__device__ __forceinline__ float vmax2(float a, float b) { float r; asm("v_max_f32_e32 %0, %1, %2" : "=v"(r) : "v"(a), "v"(b)); return r; }
__device__ __forceinline__ float vmin2(float a, float b) { float r; asm("v_min_f32_e32 %0, %1, %2" : "=v"(r) : "v"(a), "v"(b)); return r; }
__device__ __forceinline__ void pad16(float (&a)[16]) {
    asm volatile("s_nop 1" : "+v"(a[0]), "+v"(a[1]), "+v"(a[2]), "+v"(a[3]), "+v"(a[4]), "+v"(a[5]), "+v"(a[6]), "+v"(a[7]), "+v"(a[8]), "+v"(a[9]), "+v"(a[10]), "+v"(a[11]), "+v"(a[12]), "+v"(a[13]), "+v"(a[14]), "+v"(a[15]));
}
__device__ __forceinline__ void sort16_desc(float (&a)[16]) {
#pragma unroll
    for (int k = 2; k <= 16; k <<= 1)
#pragma unroll
        for (int j = k >> 1; j > 0; j >>= 1)
#pragma unroll
            for (int i = 0; i < 16; ++i) { const int l = i ^ j; if (l > i) { const bool desc = ((i & k) == 0); const float hi_ = vmax2(a[i], a[l]), lo_ = vmin2(a[i], a[l]); a[i] = desc ? hi_ : lo_; a[l] = desc ? lo_ : hi_; } }
}
__device__ __forceinline__ void merge16_desc(float (&a)[16], const float (&b)[16]) {
#pragma unroll
    for (int i = 0; i < 16; ++i) a[i] = vmax2(a[i], b[15 - i]);
#pragma unroll
    for (int j = 8; j > 0; j >>= 1)
#pragma unroll
        for (int i = 0; i < 16; ++i) { const int l = i ^ j; if (l > i) { const float hi_ = vmax2(a[i], a[l]), lo_ = vmin2(a[i], a[l]); a[i] = hi_; a[l] = lo_; } }
}
__device__ __forceinline__ void top16_of_64(float (&g0)[16], float (&g1)[16], float (&g2)[16], float (&g3)[16]) {
    sort16_desc(g0); sort16_desc(g1); merge16_desc(g0, g1); sort16_desc(g2); sort16_desc(g3); merge16_desc(g2, g3); merge16_desc(g0, g2);
}
__device__ __forceinline__ float embed(float v, unsigned mask, unsigned id) { return __builtin_bit_cast(float, (__builtin_bit_cast(unsigned, v) & mask) | id); }
__device__ __forceinline__ float mkcand(float x, float y, unsigned id) { return embed(x + y, 0xFFFFFF00u, id); }

__device__ __forceinline__ void swap32(float& a, float& b) { asm volatile("v_nop\n\tv_nop\n\tv_permlane32_swap_b32 %0, %1" : "+v"(a), "+v"(b)); }
struct RouteP { const GAS bf16* QP; const GAS bf16* keys; GAS int* EX; GAS float* GW; };
constexpr int RT_KP = 144, RT_KEYS = 0, RT_SCR = 256 * RT_KP, RT_END = RT_SCR + 8 * 8192;
__device__ __forceinline__ void route_phase(const RouteP& P, LAS unsigned char* lds, int tid, int wave, int lane, int vcu, int G) {
    asm volatile("" : "+v"(tid), "+v"(lane));
    __syncthreads();
    for (int c = tid; c < 256 * 8; c += 512) { const int row = c >> 3, part = c & 7; *(LAS u32x4*)(lds + RT_KEYS + row * RT_KP + part * 16) = *(const u32x4*)(P.keys + row * 64 + part * 8); }
    __syncthreads();
    const int r32 = lane & 31, hi = lane >> 5;
    LAS int* scr = (LAS int*)(lds + RT_SCR + wave * 8192);
    for (int u = vcu; u < T / 32; u += G) {
        const size_t t = (size_t)u * 32 + r32; const int h = wave;
        float T2[2][16];
#pragma unroll
        for (int c = 0; c < 2; ++c) {
            bf16x8 qf[4];
            { const GAS bf16* q = P.QP + t * 1024 + h * 128 + c * 64 + 8 * hi;
#pragma unroll
              for (int s = 0; s < 4; ++s) qf[s] = *(const GAS bf16x8*)(q + 16 * s); }
            f32x16 sc[4];
#pragma unroll
            for (int m = 0; m < 4; ++m) {
#pragma unroll
                for (int r = 0; r < 16; ++r) sc[m][r] = 0.f;
#pragma unroll
                for (int s = 0; s < 4; ++s) { const bf16x8 a = *(const LAS bf16x8*)(lds + RT_KEYS + (c * 128 + 32 * m + r32) * RT_KP + s * 32 + hi * 16);
                    sc[m] = __builtin_amdgcn_mfma_f32_32x32x16_bf16(a, qf[s], sc[m], 0, 0, 0); }
            }
            float g0[16], g1[16], g2[16], g3[16];
            const unsigned h4 = 4u * (unsigned)hi;
#pragma unroll
            for (int r = 0; r < 16; ++r) { const unsigned kr_ = (unsigned)((r & 3) + 8 * (r >> 2));
                g0[r] = embed(sc[0][r], 0xFFFFFF80u, kr_ | h4); g1[r] = embed(sc[1][r], 0xFFFFFF80u, (32u + kr_) | h4); g2[r] = embed(sc[2][r], 0xFFFFFF80u, (64u + kr_) | h4); g3[r] = embed(sc[3][r], 0xFFFFFF80u, (96u + kr_) | h4); }
            top16_of_64(g0, g1, g2, g3);
            pad16(g0);
#pragma unroll
            for (int i = 0; i < 16; ++i) T2[c][i] = g0[i];
        }
        float A[16], Bv[16];
#pragma unroll
        for (int i = 0; i < 16; ++i) { A[i] = T2[0][i]; Bv[i] = T2[1][i]; swap32(A[i], Bv[i]); }
        merge16_desc(A, Bv);
        pad16(A);
        float T0[16], T1[16];
#pragma unroll
        for (int i = 0; i < 16; ++i) { T0[i] = A[i]; T1[i] = A[i]; swap32(T0[i], T1[i]); }
#pragma unroll
        for (int i = 0; i < 16; ++i) { scr[i * 64 + lane] = (int)(__builtin_bit_cast(unsigned, T0[i]) & 127u); scr[(16 + i) * 64 + lane] = (int)(__builtin_bit_cast(unsigned, T1[i]) & 127u);
            T0[i] = embed(T0[i], 0xFFFFFF80u, 0u); T1[i] = embed(T1[i], 0xFFFFFF80u, 0u); }
        float c0[16], c1[16], c2[16], c3[16];
        const float NINF = -__builtin_inff();
#pragma unroll
        for (int b = 0; b < 16; ++b) c0[b] = mkcand(T0[0], T1[b], (unsigned)b);
#pragma unroll
        for (int b = 0; b < 8; ++b) c1[b] = mkcand(T0[1], T1[b], 16u + b);
#pragma unroll
        for (int b = 0; b < 5; ++b) c1[8 + b] = mkcand(T0[2], T1[b], 32u + b);
#pragma unroll
        for (int b = 0; b < 3; ++b) c1[13 + b] = mkcand(T0[4], T1[b], 64u + b);
#pragma unroll
        for (int b = 0; b < 4; ++b) c2[b] = mkcand(T0[3], T1[b], 48u + b);
        c2[4] = mkcand(T0[5], T1[0], 80u); c2[5] = mkcand(T0[5], T1[1], 81u); c2[6] = mkcand(T0[6], T1[0], 96u); c2[7] = mkcand(T0[6], T1[1], 97u); c2[8] = mkcand(T0[7], T1[0], 112u); c2[9] = mkcand(T0[7], T1[1], 113u);
#pragma unroll
        for (int a = 8; a < 14; ++a) c2[10 + a - 8] = mkcand(T0[a], T1[0], 16u * a);
        c3[0] = mkcand(T0[14], T1[0], 224u); c3[1] = mkcand(T0[15], T1[0], 240u);
#pragma unroll
        for (int i = 2; i < 16; ++i) c3[i] = NINF;
        top16_of_64(c0, c1, c2, c3);
        pad16(c0);
        float gsum = 0.f, ge[16]; int ex[16];
        const float mtop = embed(c0[0], 0xFFFFFF00u, 0u);
#pragma unroll
        for (int i = 0; i < 16; ++i) { const unsigned bits = __builtin_bit_cast(unsigned, c0[i]); const int a = (bits >> 4) & 15, b = bits & 15;
            ge[i] = __builtin_amdgcn_exp2f((embed(c0[i], 0xFFFFFF00u, 0u) - mtop) * LOG2E); gsum += ge[i];
            ex[i] = scr[a * 64 + lane] * 128 + scr[(16 + b) * 64 + lane]; }
        const float ginv = __builtin_amdgcn_rcpf(gsum);
        if (hi == 0) { GAS unsigned short* d = (GAS unsigned short*)P.EX + t * 128 + h * 16;
#pragma unroll
            for (int i = 0; i < 16; ++i) d[i] = (unsigned short)ex[i]; }
        else { GAS f32x4* d = (GAS f32x4*)(P.GW + t * 128 + h * 16);
#pragma unroll
            for (int i = 0; i < 4; ++i) d[i] = (f32x4){ge[4 * i] * ginv, ge[4 * i + 1] * ginv, ge[4 * i + 2] * ginv, ge[4 * i + 3] * ginv}; }
    }
}

__device__ __forceinline__ int wave_allsum_i(int v) {
    v += __builtin_amdgcn_update_dpp(0, v, 0xB1, 0xF, 0xF, true);
    v += __builtin_amdgcn_update_dpp(0, v, 0x4E, 0xF, 0xF, true);
    v += __builtin_amdgcn_update_dpp(0, v, 0x141, 0xF, 0xF, true);
    v += __builtin_amdgcn_update_dpp(0, v, 0x140, 0xF, 0xF, true);
    { int a = v, b = v; asm volatile("v_nop\n\tv_nop\n\tv_permlane16_swap_b32 %0, %1" : "+v"(a), "+v"(b)); v = a + b; }
    { int a = v, b = v; asm volatile("v_nop\n\tv_nop\n\tv_permlane32_swap_b32 %0, %1" : "+v"(a), "+v"(b)); v = a + b; }
    return v;
}
__device__ __forceinline__ float wave_allsum(float v) {
    v += __builtin_bit_cast(float, __builtin_amdgcn_update_dpp(0, __builtin_bit_cast(int, v), 0xB1, 0xF, 0xF, true));
    v += __builtin_bit_cast(float, __builtin_amdgcn_update_dpp(0, __builtin_bit_cast(int, v), 0x4E, 0xF, 0xF, true));
    v += __builtin_bit_cast(float, __builtin_amdgcn_update_dpp(0, __builtin_bit_cast(int, v), 0x141, 0xF, 0xF, true));
    v += __builtin_bit_cast(float, __builtin_amdgcn_update_dpp(0, __builtin_bit_cast(int, v), 0x140, 0xF, 0xF, true));
    { float a = v, b = v; asm volatile("v_nop\n\tv_nop\n\tv_permlane16_swap_b32 %0, %1" : "+v"(a), "+v"(b)); v = a + b; }
    { float a = v, b = v; asm volatile("v_nop\n\tv_nop\n\tv_permlane32_swap_b32 %0, %1" : "+v"(a), "+v"(b)); v = a + b; }
    return v;
}
__device__ __forceinline__ float wave_allmax(float v) {
    v = fmaxf(v, __builtin_bit_cast(float, __builtin_amdgcn_update_dpp(0, __builtin_bit_cast(int, v), 0xB1, 0xF, 0xF, true)));
    v = fmaxf(v, __builtin_bit_cast(float, __builtin_amdgcn_update_dpp(0, __builtin_bit_cast(int, v), 0x4E, 0xF, 0xF, true)));
    v = fmaxf(v, __builtin_bit_cast(float, __builtin_amdgcn_update_dpp(0, __builtin_bit_cast(int, v), 0x141, 0xF, 0xF, true)));
    v = fmaxf(v, __builtin_bit_cast(float, __builtin_amdgcn_update_dpp(0, __builtin_bit_cast(int, v), 0x140, 0xF, 0xF, true)));
    { float a = v, b = v; asm volatile("v_nop\n\tv_nop\n\tv_permlane16_swap_b32 %0, %1" : "+v"(a), "+v"(b)); v = fmaxf(a, b); }
    { float a = v, b = v; asm volatile("v_nop\n\tv_nop\n\tv_permlane32_swap_b32 %0, %1" : "+v"(a), "+v"(b)); v = fmaxf(a, b); }
    return v;
}
__device__ __forceinline__ unsigned q4(float a, float b, float c, float d, int off) {
    const int ia = (int)__builtin_rintf(a) + off, ib = (int)__builtin_rintf(b) + off, ic = (int)__builtin_rintf(c) + off, id = (int)__builtin_rintf(d) + off;
    return (unsigned)(ia & 255) | ((unsigned)(ib & 255) << 8) | ((unsigned)(ic & 255) << 16) | ((unsigned)(id & 255) << 24);
}
__device__ __forceinline__ void quant_row(const GAS float* src, GAS unsigned* dst, GAS float* scale, int off, int lane) {
    const GAS f32x4* s = (const GAS f32x4*)src + 4 * lane; f32x4 v[4]; float m = 0.f;
#pragma unroll
    for (int i = 0; i < 4; ++i) { v[i] = s[i]; m = fmaxf(m, fmaxf(fmaxf(__builtin_fabsf(v[i].x), __builtin_fabsf(v[i].y)), fmaxf(__builtin_fabsf(v[i].z), __builtin_fabsf(v[i].w)))); }
    m = wave_allmax(m); const float inv = m > 0.f ? 127.f / m : 0.f;
    v4u w;
    w.x = q4(v[0].x * inv, v[0].y * inv, v[0].z * inv, v[0].w * inv, off); w.y = q4(v[1].x * inv, v[1].y * inv, v[1].z * inv, v[1].w * inv, off);
    w.z = q4(v[2].x * inv, v[2].y * inv, v[2].z * inv, v[2].w * inv, off); w.w = q4(v[3].x * inv, v[3].y * inv, v[3].z * inv, v[3].w * inv, off);
    *((GAS v4u*)dst + lane) = w;
    if (lane == 0) *scale = m * (1.f / 127.f);
}
struct PeerS { int nslices_step, first_slice, nloc, rank; };
__device__ __forceinline__ PeerS peer_sched(const GAS unsigned* rankw, int xcc, int rank) {
    const int lane = lane_id_v();
    const int c = lane < 16 ? (int)__hip_atomic_load(rankw + 64 * lane, __ATOMIC_RELAXED, __HIP_MEMORY_SCOPE_AGENT) : 0;
    const unsigned long long m = __builtin_amdgcn_ballot_w64(c > 0);
    const int nx = __builtin_popcountll(m), myidx = __builtin_popcountll(m & ((1ull << xcc) - 1ull));
    const int cm = __builtin_amdgcn_readlane(c, xcc);
    PeerS s; s.nslices_step = nx > 0 ? nx : 1; s.first_slice = myidx; s.nloc = cm > 0 ? cm : 1; s.rank = rank; return s;
}
struct Peer1P { const GAS unsigned GAS char* HQ; const GAS int* EX; const GAS unsigned GAS char* U8; GAS int* P; };
__device__ __forceinline__ void peer_k1(const Peer1P& Q, const PeerS& sc, int wave, int lane) {
    asm volatile("" : "+v"(lane));
    const int g = lane >> 3, j = lane & 7;
    const __amdgpu_buffer_rsrc_t rU = __builtin_amdgcn_make_buffer_rsrc((void*)Q.U8, 0, 0x7fffffff, 0x00020000);
    for (int s = sc.first_slice; s < 8; s += sc.nslices_step)
        for (int tile = sc.rank; tile < T / 64; tile += sc.nloc) {
            const int soff_ = __builtin_amdgcn_readfirstlane(128 * s);
            const size_t t0 = (size_t)tile * 64 + wave * 8;
            v4u hqn = *(const GAS v4u*)(Q.HQ + t0 * 1024 + 128 * s + 16 * j), exn[2];
#pragma unroll
            for (int i = 0; i < 2; ++i) exn[i] = *(const GAS v4u*)(Q.EX + t0 * 64 + 8 * g + 4 * i);
#pragma unroll 1
            for (int k = 0; k < 8; ++k) {
                const size_t t = t0 + k;
                const v4u hq = hqn; v4u ex[2];
#pragma unroll
                for (int i = 0; i < 2; ++i) ex[i] = exn[i];
                if (k + 1 < 8) {
                    hqn = *(const GAS v4u*)(Q.HQ + (t + 1) * 1024 + 128 * s + 16 * j);
#pragma unroll
                    for (int i = 0; i < 2; ++i) exn[i] = *(const GAS v4u*)(Q.EX + (t + 1) * 64 + 8 * g + 4 * i);
                }
                v4u uu[16];
#pragma unroll
                for (int i = 0; i < 16; ++i) { const unsigned ew = ((i >> 1) & 3) == 0 ? ex[i >> 3].x : ((i >> 1) & 3) == 1 ? ex[i >> 3].y : ((i >> 1) & 3) == 2 ? ex[i >> 3].z : ex[i >> 3].w; unsigned e; if (i & 1) asm("v_lshrrev_b32 %0, 16, %1" : "=v"(e) : "v"(ew)); else asm("v_and_b32 %0, 0xffff, %1" : "=v"(e) : "v"(ew));
                    uu[i] = __builtin_bit_cast(v4u, __builtin_amdgcn_raw_buffer_load_b128(rU, (int)((e << 10) + 16u * (unsigned)j), soff_, 0)); }
                int lo = 0, hi = 0;
#pragma unroll
                for (int i = 0; i < 16; ++i) {
                    int p = __builtin_amdgcn_sdot4((int)uu[i].x, (int)hq.x, 0, false); p = __builtin_amdgcn_sdot4((int)uu[i].y, (int)hq.y, p, false); p = __builtin_amdgcn_sdot4((int)uu[i].z, (int)hq.z, p, false); p = __builtin_amdgcn_sdot4((int)uu[i].w, (int)hq.w, p, false);
                    p += __builtin_amdgcn_update_dpp(0, p, 0xB1, 0xF, 0xF, true); p += __builtin_amdgcn_update_dpp(0, p, 0x4E, 0xF, 0xF, true); p += __builtin_amdgcn_update_dpp(0, p, 0x141, 0xF, 0xF, true);
                    if (i < 8) lo = (j == i) ? p : lo; else hi = (j == i - 8) ? p : hi;
                }
                Q.P[(t * 8 + s) * 64 + 8 * g + j] = (int)__builtin_amdgcn_perm((unsigned)((hi + 32) >> 6), (unsigned)((lo + 32) >> 6), 0x05040100u);
            }
        }
}
__device__ __forceinline__ void peer_w(const GAS int* EX, const GAS float* GW, const GAS int* P, const GAS float* SH, const GAS float* SU, const GAS float* SV, GAS signed char* WQ, GAS float* WSC, int gw, int NGW, int lane) {
    asm volatile("" : "+v"(lane));
    for (int t = gw; t < T; t += NGW) {
        const float sh = SH[t];
#pragma unroll
        for (int q = 0; q < 2; ++q) { const size_t idx = (size_t)t * 128 + lane + 64 * q; const int e = (int)((const GAS unsigned short*)EX)[idx];
            const int slot_ = lane + 64 * q, pix_ = (slot_ >> 4) * 8 + (slot_ & 7), hsel_ = (slot_ >> 3) & 1;
            int pd = 0;
#pragma unroll
            for (int sl = 0; sl < 8; ++sl) { const int pw_ = P[((size_t)t * 8 + sl) * 64 + pix_]; pd += hsel_ ? (pw_ >> 16) : (int)(short)(pw_ & 0xffff); }
            const float w = GW[idx] * gelu_erf((float)pd * (64.f * sh * SU[e])) * SV[e];
            float m = __builtin_fabsf(w);
            m = fmaxf(m, __builtin_bit_cast(float, __builtin_amdgcn_update_dpp(0, __builtin_bit_cast(int, m), 0xB1, 0xF, 0xF, true)));
            m = fmaxf(m, __builtin_bit_cast(float, __builtin_amdgcn_update_dpp(0, __builtin_bit_cast(int, m), 0x4E, 0xF, 0xF, true)));
            m = fmaxf(m, __builtin_bit_cast(float, __builtin_amdgcn_update_dpp(0, __builtin_bit_cast(int, m), 0x141, 0xF, 0xF, true)));
            m = fmaxf(m, __builtin_bit_cast(float, __builtin_amdgcn_update_dpp(0, __builtin_bit_cast(int, m), 0x140, 0xF, 0xF, true)));
            const float inv = m > 0.f ? 127.f / m : 0.f;
            WQ[idx] = (signed char)(int)__builtin_rintf(w * inv);
            if ((lane & 15) == 0) WSC[(size_t)t * 8 + (lane >> 4) + 4 * q] = m * (1.f / 127.f); }
    }
}
__device__ __forceinline__ void tr4x4(unsigned r0, unsigned r1, unsigned r2, unsigned r3, unsigned (&t)[4]) {
    const unsigned x0 = __builtin_amdgcn_perm(r1, r0, 0x05010400u), x1 = __builtin_amdgcn_perm(r1, r0, 0x07030602u), y0 = __builtin_amdgcn_perm(r3, r2, 0x05010400u), y1 = __builtin_amdgcn_perm(r3, r2, 0x07030602u);
    t[0] = __builtin_amdgcn_perm(y0, x0, 0x05040100u); t[1] = __builtin_amdgcn_perm(y0, x0, 0x07060302u); t[2] = __builtin_amdgcn_perm(y1, x1, 0x05040100u); t[3] = __builtin_amdgcn_perm(y1, x1, 0x07060302u);
}
struct Peer2P { const GAS int* EX; const GAS signed char* WQ; const GAS float* WSC; const GAS unsigned char* V8; GAS bf16* XB; GAS float* SSQ; };
__device__ __forceinline__ void peer_k2(const Peer2P& Q, const PeerS& sc, int wave, int lane) {
    asm volatile("" : "+v"(lane));
    const int g = lane >> 3, j = lane & 7, hf = lane >> 5, rp = (lane >> 4) & 1;
    const __amdgpu_buffer_rsrc_t rV = __builtin_amdgcn_make_buffer_rsrc((void*)Q.V8, 0, 0x7fffffff, 0x00020000);
    for (int s = sc.first_slice; s < 8; s += sc.nslices_step)
        for (int tile = sc.rank; tile < T / 64; tile += sc.nloc) {
            const int soff_ = __builtin_amdgcn_readfirstlane(128 * s);
            const size_t t0 = (size_t)tile * 64 + wave * 8;
            v4u exn[2], wqn; float swn;
#pragma unroll
            for (int i = 0; i < 2; ++i) exn[i] = *(const GAS v4u*)(Q.EX + t0 * 64 + 8 * g + 4 * i);
            wqn = *(const GAS v4u*)(Q.WQ + t0 * 128 + 16 * g); swn = Q.WSC[t0 * 8 + g];
#pragma unroll 1
            for (int k = 0; k < 8; ++k) {
                const size_t t = t0 + k;
                v4u ex[2]; const v4u wq = wqn; const float sw = swn;
#pragma unroll
                for (int i = 0; i < 2; ++i) ex[i] = exn[i];
                if (k + 1 < 8) {
#pragma unroll
                    for (int i = 0; i < 2; ++i) exn[i] = *(const GAS v4u*)(Q.EX + (t + 1) * 64 + 8 * g + 4 * i);
                    wqn = *(const GAS v4u*)(Q.WQ + (t + 1) * 128 + 16 * g); swn = Q.WSC[(t + 1) * 8 + g];
                }
                GAS v2u* xp = (GAS v2u*)(Q.XB + t * 1024 + 128 * s + 16 * j + 8 * hf + 4 * rp);
                const v2u xold = *xp;
                v4u vv[16];
#pragma unroll
                for (int i = 0; i < 16; ++i) { const unsigned ew = ((i >> 1) & 3) == 0 ? ex[i >> 3].x : ((i >> 1) & 3) == 1 ? ex[i >> 3].y : ((i >> 1) & 3) == 2 ? ex[i >> 3].z : ex[i >> 3].w; unsigned e; if (i & 1) asm("v_lshrrev_b32 %0, 16, %1" : "=v"(e) : "v"(ew)); else asm("v_and_b32 %0, 0xffff, %1" : "=v"(e) : "v"(ew));
                    vv[i] = __builtin_bit_cast(v4u, __builtin_amdgcn_raw_buffer_load_b128(rV, (int)((e << 10) + 16u * (unsigned)j), soff_, 0)); }
                int ai[16];
#pragma unroll
                for (int i = 0; i < 16; ++i) ai[i] = 0;
#pragma unroll
                for (int q4_ = 0; q4_ < 4; ++q4_) {
                    const unsigned wq4 = q4_ == 0 ? wq.x : q4_ == 1 ? wq.y : q4_ == 2 ? wq.z : wq.w;
#pragma unroll
                    for (int c = 0; c < 4; ++c) { unsigned tt[4];
                        const v4u &a0 = vv[4 * q4_], &a1 = vv[4 * q4_ + 1], &a2 = vv[4 * q4_ + 2], &a3 = vv[4 * q4_ + 3];
                        tr4x4(c == 0 ? a0.x : c == 1 ? a0.y : c == 2 ? a0.z : a0.w, c == 0 ? a1.x : c == 1 ? a1.y : c == 2 ? a1.z : a1.w, c == 0 ? a2.x : c == 1 ? a2.y : c == 2 ? a2.z : a2.w, c == 0 ? a3.x : c == 1 ? a3.y : c == 2 ? a3.z : a3.w, tt);
#pragma unroll
                        for (int b = 0; b < 4; ++b) ai[4 * c + b] = __builtin_amdgcn_sdot4((int)tt[b], (int)wq4, ai[4 * c + b], false); }
                }
                float acc[16];
#pragma unroll
                for (int i = 0; i < 16; ++i) acc[i] = (float)ai[i] * sw;
                float r8[8], r4[4];
#pragma unroll
                for (int m = 0; m < 8; ++m) { float a = acc[m], b = acc[m + 8]; swap32(a, b); r8[m] = a + b; }
#pragma unroll
                for (int n = 0; n < 4; ++n) { float a = r8[n], b = r8[n + 4]; asm volatile("v_nop\n\tv_nop\n\tv_permlane16_swap_b32 %0, %1" : "+v"(a), "+v"(b)); r4[n] = a + b; }
#pragma unroll
                for (int n = 0; n < 4; ++n) r4[n] += __builtin_bit_cast(float, __builtin_amdgcn_update_dpp(0, __builtin_bit_cast(int, r4[n]), 0x128, 0xF, 0xF, true));
                v2u xw; xw.x = pk2(bflo(xold.x) + r4[0], bfhi(xold.x) + r4[1]); xw.y = pk2(bflo(xold.y) + r4[2], bfhi(xold.y) + r4[3]);
                float ss = 0.f;
                if ((lane & 8) == 0) { const float x0 = bflo(xw.x), x1 = bfhi(xw.x), x2 = bflo(xw.y), x3 = bfhi(xw.y); ss = (x0 * x0 + x1 * x1) + (x2 * x2 + x3 * x3); *xp = xw; }
                ss = wave_allsum(ss);
                if (Q.SSQ) { if (lane == 0) Q.SSQ[t * 16 + s] = ss; }
            }
        }
}

struct Args { const float* in[33]; float* out; unsigned char* ws; int ph_lo, ph_hi; };
struct Frame { LAS unsigned char* lds; volatile LAS unsigned* MISC; gu32* ctl; int tid, lane, wave, G, vcu, xcc, xrank; };

__device__ __forceinline__ void transpose_item(const float* W, int ldw, int nsrc0, bf16* WT, int ldt, int rdst0, LAS float* scr, int kb, int nb, int lane, float scale, const float* kgain) {
    const int k0 = 64 * kb, n0 = 32 * nb;
#pragma unroll 8
    for (int i = 0; i < 32; ++i) { const int kk = 2 * i + (lane >> 5); const float gsc = kgain ? kgain[k0 + kk] * scale : scale; scr[kk * 33 + (lane & 31)] = W[(size_t)(k0 + kk) * ldw + nsrc0 + n0 + (lane & 31)] * gsc; }
    LDS_WAIT(); asm volatile("" ::: "memory");
    const int c = lane & 7;
#pragma unroll
    for (int j = 0; j < 4; ++j) { const int n = (lane >> 3) + 8 * j; const LAS float* s = scr + (8 * c) * 33 + n;
        v4u o; o.x = pk2(s[0 * 33], s[1 * 33]); o.y = pk2(s[2 * 33], s[3 * 33]); o.z = pk2(s[4 * 33], s[5 * 33]); o.w = pk2(s[6 * 33], s[7 * 33]);
        *(GAS v4u*)(WT + (size_t)(rdst0 + n0 + n) * ldt + k0 + 8 * c) = o; }
    LDS_WAIT(); asm volatile("" ::: "memory");
}
__device__ __forceinline__ void zero_rect(bf16* base, int ld, int row0, int nrows, int col0, int ncols, int gtid, int gthreads) {
    const int vpr = ncols / 8;
    for (int i = gtid; i < nrows * vpr; i += gthreads) { const int r = i / vpr, c = i % vpr; *(GAS v4u*)(base + (size_t)(row0 + r) * ld + col0 + 8 * c) = (v4u){0u, 0u, 0u, 0u}; }
}

__device__ __forceinline__ void p0_prologue(Frame& F, const Args& a) {
    LAS float* scr = (LAS float*)(F.lds + RING_OFF + F.wave * 16384);
    const int gw = blockIdx.x * NWAVES + F.wave, NGW = F.G * NWAVES;
    const int gtid = blockIdx.x * (NWAVES * 64) + F.tid, gthreads = F.G * NWAVES * 64;
    unsigned char* ws = a.ws;
    x0_phase((const GAS float*)a.in[0], (GAS bf16*)(ws + WS_XNB), (GAS float*)(ws + WS_SSQ), gw, NGW, F.lane);
    constexpr int I_IN = 16 * (INW / 32), I_SQ = 16 * 32, I_CKV = 16 * 64, I_UQ = 3 * 12, I_UKV = 2 * 16, I_L = I_IN + 4 * I_SQ + I_CKV + I_UQ + I_UKV;
    for (int it = gw; it < L * I_L; it += NGW) {
        const int l = it / I_L; int r = it % I_L;
        if (r < I_IN) {
            const int kb = r / 67, nb = r % 67; int src, dst; float sc = 1.f;
            if (nb < 6) { src = 32 * nb; dst = src; } else if (nb < 11) { src = 32 * nb; dst = src + 64; } else { src = 32 * nb; dst = src + 160; if (nb >= 43 && nb < 51) sc = 0.17677669529663687f * LOG2E; }
            transpose_item(a.in[5] + (size_t)l * D * INW, INW, src, (bf16*)(ws + WS_WIN) + (size_t)l * INP * D, D, dst, scr, kb, 0, F.lane, sc, a.in[4] + l * D); continue; } r -= I_IN;
        if (r < I_SQ) { transpose_item(a.in[21] + (size_t)l * D * D, D, 0, (bf16*)(ws + WS_WOUT) + (size_t)l * D * D, D, 0, scr, r / 32, r % 32, F.lane, 1.f, nullptr); continue; } r -= I_SQ;
        if (r < I_SQ) { transpose_item(a.in[24] + (size_t)l * D * D, D, 0, (bf16*)(ws + WS_WCQ) + (size_t)l * D * D, D, 0, scr, r / 32, r % 32, F.lane, 0.0625f * LOG2E, a.in[22] + l * D); continue; } r -= I_SQ;
        if (r < I_SQ) { transpose_item(a.in[26] + (size_t)l * D * D, D, 0, (bf16*)(ws + WS_WCO) + (size_t)l * D * D, D, 0, scr, r / 32, r % 32, F.lane, 1.f, nullptr); continue; } r -= I_SQ;
        if (r < I_SQ) { transpose_item(a.in[28] + (size_t)l * D * D, D, 0, (bf16*)(ws + WS_WPQ) + (size_t)l * D * D, D, 0, scr, r / 32, r % 32, F.lane, 1.f, a.in[27] + l * D); continue; } r -= I_SQ;
        if (r < I_CKV) { transpose_item(a.in[25] + (size_t)l * D * 2 * D, 2 * D, 0, (bf16*)(ws + WS_WCKV) + (size_t)l * 2 * D * D, D, 0, scr, r / 64, r % 64, F.lane, 1.f, nullptr); continue; } r -= I_CKV;
        if (r < I_UQ) { transpose_item(a.in[7] + (size_t)l * 192 * 384, 384, 0, (bf16*)(ws + WS_WUQ) + (size_t)l * 512 * 256, 256, 0, scr, r / 12, r % 12, F.lane, 0.10206207261596575f * LOG2E, a.in[6] + l * 192); continue; } r -= I_UQ;
        transpose_item(a.in[9] + (size_t)l * 128 * 512, 512, 0, (bf16*)(ws + WS_WUKV) + (size_t)l * 512 * 256, 256, 0, scr, r / 16, r % 16, F.lane, 1.f, a.in[8] + l * 128);
    }
    for (int l = 0; l < L; ++l) {
        bf16* win = (bf16*)(ws + WS_WIN) + (size_t)l * INP * D; bf16* wuq = (bf16*)(ws + WS_WUQ) + (size_t)l * 512 * 256; bf16* wukv = (bf16*)(ws + WS_WUKV) + (size_t)l * 512 * 256;
        zero_rect(win, D, 192, 64, 0, D, gtid, gthreads); zero_rect(win, D, 416, 96, 0, D, gtid, gthreads);
        zero_rect(wuq, 256, 0, 384, 192, 64, gtid, gthreads); zero_rect(wuq, 256, 384, 128, 0, 256, gtid, gthreads);
        zero_rect(wukv, 256, 0, 512, 128, 128, gtid, gthreads);
    }
    { float* rope = (float*)(ws + WS_ROPE); const int* pos = (const int*)a.in[2];
      for (int i = gtid; i < T * 16; i += gthreads) { const int t = i >> 4, k = i & 15; const float inv = powf(10000.f, -(float)(2 * k) / 32.f); const float ang = (float)pos[t] * inv;
          rope[(size_t)t * 32 + k] = cosf(ang); rope[(size_t)t * 32 + 16 + k] = sinf(ang); } }
    { const GAS f32x4* ks = (const GAS f32x4*)a.in[29]; GAS v2u* kd = (GAS v2u*)(ws + WS_KEYS);
      for (int i = gtid; i < L * 2 * 128 * 64 / 4; i += gthreads) { const f32x4 v = ks[i]; v2u w; w.x = pk2(v.x, v.y); w.y = pk2(v.z, v.w); kd[i] = w; }
    }
    for (int r = gw; r < 2 * L * 16384; r += NGW) { const int tb = r / (L * 16384), rr = r % (L * 16384);
        quant_row((const GAS float*)a.in[30 + tb] + (size_t)rr * 1024, (GAS unsigned*)(ws + (tb ? WS_V8 : WS_U8) + (size_t)rr * 1024), (GAS float*)(ws + (tb ? WS_SV : WS_SU)) + rr, 0, F.lane); }
    { float* btab = (float*)(ws + WS_BTAB); float* lams = (float*)(ws + WS_LAMS); float* spt = (float*)(ws + WS_SP);
      for (int i = gtid; i < 4 * 129; i += gthreads) { const int h = i / 129, n = i % 129; int bu; if (n < 16) bu = n; else { const int lg = 16 + (int)(logf((float)n / 16.f) / logf(8.f) * 16.f); bu = lg < 31 ? lg : 31; }
          btab[i] = a.in[3][bu * 4 + h] * LOG2E; }
      for (int i = gtid; i < L; i += gthreads) { const float* dl = a.in[17] + i * 128; float s1 = 0.f, s2 = 0.f; for (int j = 0; j < 32; ++j) { s1 += dl[j] * dl[32 + j]; s2 += dl[64 + j] * dl[96 + j]; }
          const float li = 0.8f - 0.6f * expf(-0.3f * (float)i); lams[2 * i] = expf(s1) - expf(s2) + li; lams[2 * i + 1] = li; }
      for (int i = gtid; i < L * 512; i += gthreads) spt[i] = log1pf(expf(-a.in[16][i])); }
    { GAS bf16* wat = (GAS bf16*)(ws + WS_WAT);
      for (int i = gtid; i < L * 8 * 2 * 4096; i += gthreads) { const int in_ = i & 63, out_ = (i >> 6) & 63, gate = (i >> 12) & 1, lg = i >> 13;
          wat[i] = (bf16)f2bf_(a.in[gate ? 14 : 12][(size_t)lg * 4096 + in_ * 64 + out_]); } }
    for (int l = 0; l < L; ++l) norm_phase((const GAS float*)a.in[1], (const GAS float*)a.in[23] + l * D, (GAS bf16*)(ws + WS_MNB) + (size_t)l * NB * MEM * D, NB * MEM, gw, NGW, F.lane);
}

constexpr int NPL = 16, PH_FINAL = 2 + NPL * L;
__global__ void __launch_bounds__(NWAVES * 64, 2) fwd(Args args) {
    extern __shared__ __attribute__((aligned(16))) unsigned char lds[];
    Frame F;
    F.lds = (LAS unsigned char*)lds; F.MISC = (volatile LAS unsigned*)(F.lds + MISC_OFF);
    F.tid = threadIdx.x; F.lane = F.tid & 63; F.wave = __builtin_amdgcn_readfirstlane(F.tid >> 6); F.G = gridDim.x;
    F.vcu = (F.G % 8 == 0) ? ((int)blockIdx.x % 8) * (F.G / 8) + (int)blockIdx.x / 8 : (int)blockIdx.x;
    unsigned char* ws = args.ws;
    F.ctl = (gu32*)(opq(ws) + WS_CTL);
    for (int u = F.tid; u < (LDS_BYTES - LDSCTL_OFF) / 4; u += NWAVES * 64) ((LAS unsigned*)(F.lds + LDSCTL_OFF))[u] = 0u;
    __syncthreads();
    XcdBarrier bar = xcd_barrier_post((unsigned*)(F.ctl + CW_BAR), F.MISC + 8);
    F.xcc = (int)bar.x;
    if (F.tid == 0) F.MISC[12] = __hip_atomic_fetch_add((unsigned*)(F.ctl + CW_RANK) + 64 * bar.x, 1u, __ATOMIC_RELAXED, __HIP_MEMORY_SCOPE_AGENT);
    __syncthreads();
    F.xrank = __builtin_amdgcn_readfirstlane((int)F.MISC[12]);
    const int lo = args.ph_lo, hi = args.ph_hi;
    const int gw = blockIdx.x * NWAVES + F.wave, NGW = F.G * NWAVES;
#define IN(k) (lo <= (k) && (k) < hi)
#define LANE_ (lane_id_v())
#define TID_ ((opqi(F.wave) << 6) | LANE_)
#define SITE() const int G_ = opqi(F.G), wv_ = opqi(F.wave), vcu_ = opqi(F.vcu), gw_ = opqi(gw), NGW_ = opqi(NGW); (void)G_; (void)wv_; (void)vcu_; (void)gw_; (void)NGW_
#if MK_DUP == 99
#define SEAM(k) do { if (IN(k) && IN((k) + 1)) { xcd_barrier(bar, (F.wave == 0 && lane_id_v() == 0) ? 1 : 0); xcd_barrier(bar, (F.wave == 0 && lane_id_v() == 0) ? 1 : 0); } } while (0)
#else
#define SEAM(k) do { if (IN(k) && IN((k) + 1)) xcd_barrier(bar, (F.wave == 0 && lane_id_v() == 0) ? 1 : 0); } while (0)
#endif
#define GEMM_SITE(EPI, Aptr, lda_, Bptr, ldb_, M_, N_, K_, cperm, ...) do { \
        pg8::Gemm g{opq(Aptr), opq(Bptr), M_, N_, K_, lda_, ldb_}; pg8::StaticOrder So; So.init(M_, N_, opqi(F.G), opqi(cperm)); pg8::EPI E{__VA_ARGS__}; \
        pg8::gemm_phase<pg8::EPI, pg8::StaticOrder, true, true>(F.lds + RING_OFF, g, So, E, opqi(F.wave)); } while (0)
    if (IN(0)) { p0_prologue(F, args); }
    SEAM(0);
    if (IN(1)) {
#pragma unroll 1
        for (int l = 0; l < L; ++l)
            GEMM_SITE(EpiBf16, (const GAS bf16*)(opq(ws) + WS_MNB) + (size_t)l * NB * MEM * D, D, (const GAS bf16*)(opq(ws) + WS_WCKV) + (size_t)l * 2 * D * D, D, NB * MEM, 2 * D, D, (int)((blockIdx.x + 64 * l) % F.G),
                      opq((GAS bf16*)(opq(ws) + WS_KVCB) + (size_t)l * NB * MEM * 2 * D), 2 * D, 2 * D, (const GAS float*)nullptr, 0);
    }
    SEAM(1);
    for (int l = 0; l < L; ++l) {
        const int pb = 2 + NPL * l;
        const GAS bf16* XNB = (const GAS bf16*)(opq(ws) + WS_XNB); const GAS bf16* YB = (const GAS bf16*)(opq(ws) + WS_YB); GAS bf16* PROJB = (GAS bf16*)(opq(ws) + WS_PROJB);
        if (IN(pb + 1)) GEMM_SITE(EpiBf16, XNB, D, (const GAS bf16*)(opq(ws) + WS_WIN) + (size_t)l * INP * D, D, T, INP, D, (int)blockIdx.x, opq(PROJB), INP, INP, opq((const GAS float*)(opq(ws) + WS_SSQ)), 8);
#if MK_DUP == 1
        if (IN(pb + 1)) GEMM_SITE(EpiBf16, XNB, D, (const GAS bf16*)(opq(ws) + WS_WIN) + (size_t)l * INP * D, D, T, INP, D, (int)blockIdx.x, opq(PROJB), INP, INP, opq((const GAS float*)(opq(ws) + WS_SSQ)), 8);
#endif
        SEAM(pb + 1);
        if (IN(pb + 2)) {
            SITE();
            pre_phase(opq((const GAS bf16*)PROJB), opq((const GAS float*)(opq(ws) + WS_ROPE)), opq((GAS float*)(opq(ws) + WS_RS)), opq((GAS bf16*)(opq(ws) + WS_KMB)), gw_, NGW_, LANE_);
#if MK_DUP == 21
            pre_phase(opq((const GAS bf16*)PROJB), opq((const GAS float*)(opq(ws) + WS_ROPE)), opq((GAS float*)(opq(ws) + WS_RS)), opq((GAS bf16*)(opq(ws) + WS_KMB)), gw_, NGW_, LANE_);
#endif
            LruP LP{opq((const GAS bf16*)PROJB), (const GAS float*)args.in[opqi(10)] + l * 4 * 512, (const GAS float*)args.in[opqi(11)] + l * 512, opq((const GAS bf16*)(opq(ws) + WS_WAT)) + (size_t)l * 8 * 2 * 4096, (const GAS float*)args.in[opqi(13)] + l * 512, (const GAS float*)args.in[opqi(15)] + l * 512,
                    (const GAS float*)(opq(ws) + WS_SP) + l * 512, opq((GAS unsigned*)(opq(ws) + WS_HLB)), opq((GAS float*)(opq(ws) + WS_LSUM))};
            lru_phase(LP, F.lds, TID_, wv_, LANE_, vcu_, G_);
#if MK_DUP == 2
            lru_phase(LP, F.lds, TID_, wv_, LANE_, vcu_, G_);
#endif
        }
        SEAM(pb + 2);
        if (IN(pb + 3)) {
            GEMM_SITE(EpiUp, (const GAS bf16*)PROJB + PC_CQ, INP, (const GAS bf16*)(opq(ws) + WS_WUQ) + (size_t)l * 512 * 256, 256, T, 512, 256, (int)blockIdx.x,
                      opq((GAS bf16*)(opq(ws) + WS_QMB)), (GAS bf16*)nullptr, 384, 384, opq((const GAS float*)(opq(ws) + WS_RS)), 0, 0);
            GEMM_SITE(EpiUp, (const GAS bf16*)PROJB + PC_CKV, INP, (const GAS bf16*)(opq(ws) + WS_WUKV) + (size_t)l * 512 * 256, 256, T, 512, 256, (int)blockIdx.x,
                      opq((GAS bf16*)(opq(ws) + WS_KMB)), opq((GAS bf16*)(opq(ws) + WS_VMB)), 0, 512, opq((const GAS float*)(opq(ws) + WS_RS)), 1, 1);
#if MK_DUP == 3
            GEMM_SITE(EpiUp, (const GAS bf16*)PROJB + PC_CQ, INP, (const GAS bf16*)(opq(ws) + WS_WUQ) + (size_t)l * 512 * 256, 256, T, 512, 256, (int)blockIdx.x,
                      opq((GAS bf16*)(opq(ws) + WS_QMB)), (GAS bf16*)nullptr, 384, 384, opq((const GAS float*)(opq(ws) + WS_RS)), 0, 0);
            GEMM_SITE(EpiUp, (const GAS bf16*)PROJB + PC_CKV, INP, (const GAS bf16*)(opq(ws) + WS_WUKV) + (size_t)l * 512 * 256, 256, T, 512, 256, (int)blockIdx.x,
                      opq((GAS bf16*)(opq(ws) + WS_KMB)), opq((GAS bf16*)(opq(ws) + WS_VMB)), 0, 512, opq((const GAS float*)(opq(ws) + WS_RS)), 1, 1);
#endif
        }
        SEAM(pb + 3);
        if (IN(pb + 4)) {
            SITE();
            AttnP PM{opq((const GAS bf16*)(opq(ws) + WS_QMB)), opq((const GAS bf16*)(opq(ws) + WS_KMB)), opq((const GAS bf16*)(opq(ws) + WS_VMB)), 384, 384, 256, opq((GAS bf16*)(opq(ws) + WS_OMB)), 256, opq((const GAS float*)(opq(ws) + WS_ROPE)), nullptr, nullptr, nullptr, nullptr};
            AttnP PD{opq((const GAS bf16*)PROJB + PC_QD), opq((const GAS bf16*)PROJB + PC_KD), opq((const GAS bf16*)PROJB + PC_VD), INP, INP, INP, opq((GAS bf16*)(opq(ws) + WS_YB) + 768), 1024, nullptr,
                     (const GAS int*)args.in[opqi(2)], (const GAS float*)(opq(ws) + WS_BTAB), (const GAS float*)args.in[opqi(18)] + l * 64, (const GAS float*)(opq(ws) + WS_LAMS) + 2 * l};
            attn_phase(PM, PD, F.lds, TID_, wv_, LANE_, vcu_, G_);
#if MK_DUP == 4
            __syncthreads(); attn_phase(PM, PD, F.lds, TID_, wv_, LANE_, vcu_, G_);
#elif MK_DUP == 40 || MK_DUP == 41
            __syncthreads(); attn_phase(PM, PD, F.lds, TID_, wv_, LANE_, vcu_, G_, MK_DUP - 40);
#endif
        }
        SEAM(pb + 4);
        if (IN(pb + 5)) {
            SITE();
            PostP PP{opq((const GAS bf16*)(opq(ws) + WS_OMB)), opq((const GAS unsigned*)(opq(ws) + WS_HLB)), opq((const GAS float*)(opq(ws) + WS_LSUM)), opq((const GAS bf16*)PROJB), (const GAS float*)args.in[opqi(19)] + l * 256, (const GAS float*)args.in[opqi(20)] + l * 512, opq((GAS bf16*)(opq(ws) + WS_YB))};
            post_phase(PP, F.lds, TID_, wv_, LANE_, vcu_, G_);
#if MK_DUP == 5
            __syncthreads(); post_phase(PP, F.lds, TID_, wv_, LANE_, vcu_, G_);
#endif
        }
        SEAM(pb + 5);
        if (IN(pb + 6)) GEMM_SITE(EpiRes, YB, D, (const GAS bf16*)(opq(ws) + WS_WOUT) + (size_t)l * D * D, D, T, D, D, (int)blockIdx.x, opq((GAS bf16*)(opq(ws) + WS_XNB)), opq((GAS float*)(opq(ws) + WS_SSQ)));
#if MK_DUP == 6
        if (IN(pb + 6)) GEMM_SITE(EpiRes, YB, D, (const GAS bf16*)(opq(ws) + WS_WOUT) + (size_t)l * D * D, D, T, D, D, (int)blockIdx.x, opq((GAS bf16*)(opq(ws) + WS_HLB)), opq((GAS float*)(opq(ws) + WS_OMB)));
#endif
        SEAM(pb + 6);
        if (IN(pb + 8)) GEMM_SITE(EpiBf16, XNB, D, (const GAS bf16*)(opq(ws) + WS_WCQ) + (size_t)l * D * D, D, T, D, D, (int)blockIdx.x, opq(PROJB), D, D, opq((const GAS float*)(opq(ws) + WS_SSQ)), 16);
#if MK_DUP == 8
        if (IN(pb + 8)) GEMM_SITE(EpiBf16, XNB, D, (const GAS bf16*)(opq(ws) + WS_WCQ) + (size_t)l * D * D, D, T, D, D, (int)blockIdx.x, opq(PROJB), D, D, opq((const GAS float*)(opq(ws) + WS_SSQ)), 16);
#endif
        SEAM(pb + 8);
        if (IN(pb + 9)) {
            SITE();
            const GAS bf16* kv = (const GAS bf16*)(opq(ws) + WS_KVCB) + (size_t)l * NB * MEM * 2 * D;
            AttnP PC{opq((const GAS bf16*)PROJB), opq(kv), opq(kv + D), 1024, 2 * D, 2 * D, opq((GAS bf16*)(opq(ws) + WS_YB)), 1024, nullptr, nullptr, nullptr, nullptr, nullptr};
            cross_phase(PC, F.lds, TID_, wv_, LANE_, vcu_, G_);
#if MK_DUP == 9
            cross_phase(PC, F.lds, TID_, wv_, LANE_, vcu_, G_);
#endif
        }
        SEAM(pb + 9);
        if (IN(pb + 10)) GEMM_SITE(EpiRes, YB, D, (const GAS bf16*)(opq(ws) + WS_WCO) + (size_t)l * D * D, D, T, D, D, (int)blockIdx.x, opq((GAS bf16*)(opq(ws) + WS_XNB)), opq((GAS float*)(opq(ws) + WS_SSQ)));
        SEAM(pb + 10);
        if (IN(pb + 12)) { GEMM_SITE(EpiBf16, XNB, D, (const GAS bf16*)(opq(ws) + WS_WPQ) + (size_t)l * D * D, D, T, D, D, (int)blockIdx.x, opq(PROJB), D, D, opq((const GAS float*)(opq(ws) + WS_SSQ)), 16);
            SITE(); hq_phase(opq(XNB), opq((const GAS float*)(opq(ws) + WS_SSQ)), (const GAS float*)args.in[opqi(27)] + l * D, opq((GAS unsigned char*)(opq(ws) + WS_HQ)), opq((GAS float*)(opq(ws) + WS_SH)), opq((GAS int*)(opq(ws) + WS_P)), gw_, NGW_, LANE_);
#if MK_DUP == 12
            hq_phase(opq(XNB), opq((const GAS float*)(opq(ws) + WS_SSQ)), (const GAS float*)args.in[opqi(27)] + l * D, opq((GAS unsigned char*)(opq(ws) + WS_HQ)), opq((GAS float*)(opq(ws) + WS_SH)), opq((GAS int*)(opq(ws) + WS_P)), gw_, NGW_, LANE_);
#endif
            }
        SEAM(pb + 12);
        if (IN(pb + 13)) {
            SITE();
            RouteP RP{opq((const GAS bf16*)PROJB), opq((const GAS bf16*)(opq(ws) + WS_KEYS) + (size_t)l * 2 * 128 * 64), opq((GAS int*)(opq(ws) + WS_EX)), opq((GAS float*)(opq(ws) + WS_GW))};
            route_phase(RP, F.lds, TID_, wv_, LANE_, vcu_, G_);
#if MK_DUP == 13
            route_phase(RP, F.lds, TID_, wv_, LANE_, vcu_, G_);
#endif
        }
        SEAM(pb + 13);
        if (IN(pb + 14)) {
            SITE();
            const PeerS ps = peer_sched((const GAS unsigned*)(F.ctl + CW_RANK), opqi(F.xcc), opqi(F.xrank));
            Peer1P Q1{opq((const GAS unsigned char*)(opq(ws) + WS_HQ)), opq((const GAS int*)(opq(ws) + WS_EX)), opq((const GAS unsigned char*)(opq(ws) + WS_U8) + (size_t)l * 16384 * 1024), opq((GAS int*)(opq(ws) + WS_PROJB))};
            peer_k1(Q1, ps, wv_, LANE_);
#if MK_DUP == 141
            { Peer1P Q1b = Q1; Q1b.P = (GAS int*)(opq(ws) + WS_HLB); peer_k1(Q1b, ps, wv_, LANE_); }
#endif
        }
        SEAM(pb + 14);
        if (IN(pb + 15)) {
            SITE();
            peer_w(opq((const GAS int*)(opq(ws) + WS_EX)), opq((const GAS float*)(opq(ws) + WS_GW)), opq((const GAS int*)(opq(ws) + WS_PROJB)), opq((const GAS float*)(opq(ws) + WS_SH)), opq((const GAS float*)(opq(ws) + WS_SU) + l * 16384), opq((const GAS float*)(opq(ws) + WS_SV) + l * 16384),
                   opq((GAS signed char*)(opq(ws) + WS_W)), opq((GAS float*)(opq(ws) + WS_WS)), gw_, NGW_, LANE_);
#if MK_DUP == 150
            peer_w(opq((const GAS int*)(opq(ws) + WS_EX)), opq((const GAS float*)(opq(ws) + WS_GW)), opq((const GAS int*)(opq(ws) + WS_PROJB)), opq((const GAS float*)(opq(ws) + WS_SH)), opq((const GAS float*)(opq(ws) + WS_SU) + l * 16384), opq((const GAS float*)(opq(ws) + WS_SV) + l * 16384),
                   opq((GAS signed char*)(opq(ws) + WS_W)), opq((GAS float*)(opq(ws) + WS_WS)), gw_, NGW_, LANE_);
#endif
            xcd_barrier(bar, (F.wave == 0 && lane_id_v() == 0) ? 1 : 0);
            const PeerS ps = peer_sched((const GAS unsigned*)(F.ctl + CW_RANK), opqi(F.xcc), opqi(F.xrank));
            Peer2P Q2{opq((const GAS int*)(opq(ws) + WS_EX)), opq((const GAS signed char*)(opq(ws) + WS_W)), opq((const GAS float*)(opq(ws) + WS_WS)), opq((const GAS unsigned char*)(opq(ws) + WS_V8) + (size_t)l * 16384 * 1024), opq((GAS bf16*)(opq(ws) + WS_XNB)), opq((GAS float*)(opq(ws) + WS_SSQ))};
            peer_k2(Q2, ps, wv_, LANE_);
#if MK_DUP == 151
            { Peer2P Q2b = Q2; Q2b.XB = (GAS bf16*)(opq(ws) + WS_HLB); Q2b.SSQ = (GAS float*)(opq(ws) + WS_OMB); peer_k2(Q2b, ps, wv_, LANE_); }
#endif
        }
        SEAM(pb + 15);
    }
    if (IN(PH_FINAL)) { SITE(); final_norm_phase(opq((const GAS bf16*)(opq(ws) + WS_XNB)), (GAS float*)args.out, (const GAS float*)args.in[opqi(32)], T, gw_, NGW_, LANE_); }
#undef IN
#undef SEAM
#undef GEMM_SITE
}
}
extern "C" void kernel_launch(void* const* d_in, const int* in_sizes, int n_in, void* d_out, int out_size, void* d_ws, size_t ws_size, hipStream_t stream) {
    (void)in_sizes; (void)out_size;
    static int grid = 0;
    if (grid == 0) {
        int dev = 0, cus = 0, per_cu = 0;
        if (n_in != 33 || ws_size < mk::WS_END) { fprintf(stderr, "kernel_launch: unexpected n_in %d / ws_size %zu\n", n_in, ws_size); grid = -1; return; }
        if (hipGetDevice(&dev) != hipSuccess || hipDeviceGetAttribute(&cus, hipDeviceAttributeMultiprocessorCount, dev) != hipSuccess) { grid = -1; return; }
        if (hipFuncSetAttribute((const void*)mk::fwd, hipFuncAttributeMaxDynamicSharedMemorySize, mk::LDS_BYTES) != hipSuccess) { fprintf(stderr, "kernel_launch: hipFuncSetAttribute failed\n"); grid = -1; return; }
        if (hipOccupancyMaxActiveBlocksPerMultiprocessor(&per_cu, (const void*)mk::fwd, mk::NWAVES * 64, mk::LDS_BYTES) != hipSuccess || per_cu < 1) fprintf(stderr, "kernel_launch: occupancy query says %d\n", per_cu);
        (void)hipGetLastError();
        grid = cus;
    }
    if (grid < 0) return;
    unsigned char* ws = (unsigned char*)d_ws;
    (void)hipMemsetAsync(ws + mk::WS_CTL, 0, mk::CTL_ZERO_BYTES, stream);
    mk::Args a{};
    for (int i = 0; i < 33; ++i) a.in[i] = (const float*)d_in[i];
    a.out = (float*)d_out; a.ws = ws;
    auto run = [&](int lo, int hi) { a.ph_lo = lo; a.ph_hi = hi; hipLaunchKernelGGL(mk::fwd, dim3(grid), dim3(mk::NWAVES * 64), mk::LDS_BYTES, stream, a); };
#if MK_ONE_LAUNCH
    run(0, mk::PH_FINAL + 1);
#else
    for (int p = 0; p <= mk::PH_FINAL; ++p) {
        const int k = (p - 2) % mk::NPL, l = (p - 2) / mk::NPL;
#if MK_NAIVE_PEER == 2
        if (p >= 2 && p < mk::PH_FINAL && k == 14) {
            hipLaunchKernelGGL(k_peer, dim3(T), dim3(256), 0, stream, (const bf16_t*)(ws + mk::WS_XNB), (const int*)(ws + mk::WS_EX), (const float*)(ws + mk::WS_GW), (const float*)d_in[30] + (size_t)l * NEXP * D, (const float*)d_in[31] + (size_t)l * NEXP * D, (float*)d_out);
            continue; }
#elif MK_NAIVE_PEER == 1
        if (p >= 2 && p < mk::PH_FINAL && k == 13) {
            float* TQ = (float*)(ws + (size_t)806 * mk::MiB);
            hipLaunchKernelGGL(k_bf2f, dim3((unsigned)(((size_t)T * D + 255) / 256)), dim3(256), 0, stream, (const bf16_t*)(ws + mk::WS_PROJB), TQ, (long)T * D);
            hipLaunchKernelGGL(k_route, dim3(T), dim3(256), 0, stream, TQ, (const float*)d_in[29] + (size_t)l * 2 * 128 * 64, (int*)(ws + mk::WS_EX), (float*)(ws + mk::WS_GW));
            hipLaunchKernelGGL(k_peer, dim3(T), dim3(256), 0, stream, (const bf16_t*)(ws + mk::WS_XNB), (const int*)(ws + mk::WS_EX), (const float*)(ws + mk::WS_GW), (const float*)d_in[30] + (size_t)l * NEXP * D, (const float*)d_in[31] + (size_t)l * NEXP * D, (float*)d_out);
            continue; }
        if (p >= 2 && p < mk::PH_FINAL && k == 14) continue;
#endif
        run(p, p + 1); }
#endif
}
```

```cpp
#include <hip/hip_runtime.h>
#include <cstdint>
#include <cstdio>
#include <cmath>

#ifndef MK_ONE_LAUNCH
#define MK_ONE_LAUNCH 1
#endif
#ifndef MK_DUP
#define MK_DUP 0
#endif
#ifndef MK_NAIVE_PEER
#define MK_NAIVE_PEER 0
#endif
namespace pg8 {
#define PG8_LAS __attribute__((address_space(3)))
#ifndef GAS
#define GAS __attribute__((address_space(1)))
#endif
typedef unsigned short bf16_t;
typedef short bf16x8 __attribute__((ext_vector_type(8)));
typedef float f32x4 __attribute__((ext_vector_type(4)));
typedef unsigned u32x4 __attribute__((ext_vector_type(4)));
typedef unsigned u32x2 __attribute__((ext_vector_type(2)));
constexpr int BM = 256, BK = 64, HALF = 128, HTB = HALF * BK * 2, STAGE_BYTES = 8 * HTB, NXCD = 8, WGM = 8;
__host__ __device__ __forceinline__ int lds_byte(int r, int c) { const int st = (r >> 4) * 2 + (c >> 5), rr = r & 15, cc = c & 31, ob = rr * 64 + cc * 2; return st * 1024 + (ob ^ (((ob >> 9) & 1) << 5)); }
__host__ __device__ __forceinline__ void stage_rc(int b, int& R, int& C) { const int st = b / 1024, sb = b % 1024, swz = sb ^ (((sb >> 9) & 1) << 5); R = (st >> 1) * 16 + swz / 64; C = (st & 1) * 32 + (swz % 64) / 2; }
__host__ __device__ __forceinline__ int perm32(int rho) { const int n = rho >> 4, i = rho & 15; return 8 * (i >> 2) + 4 * n + (i & 3); }
__device__ __forceinline__ int pg8_lane_id() { int l; asm volatile("v_mbcnt_lo_u32_b32 %0, -1, 0\n\tv_mbcnt_hi_u32_b32 %0, -1, %0" : "=v"(l)); return l; }
struct Unit { int pm, pn; };
struct Gemm { const GAS bf16_t* A; const GAS bf16_t* Bt; int M, N, K, lda, ldb; };
struct StaticOrder {
    int nM, nN, nwg, G, c;
    __host__ __device__ void init(int M, int N, int G_, int c_) { nM = M / BM; nN = N / BM; nwg = nM * nN; G = G_; c = c_; }
    __host__ __device__ bool next(int i, Unit& u) const {
        const long L = (long)i * G + c; if (L >= nwg) return false;
        int wgid = (int)L; { const int q = nwg / NXCD, r = nwg % NXCD, xcd = wgid % NXCD, off = wgid / NXCD; wgid = (xcd < r ? xcd * (q + 1) : r * (q + 1) + (xcd - r) * q) + off; }
        const int nig = WGM * nN, gid = wgid / nig, fm = gid * WGM, gsz = (nM - fm) < WGM ? (nM - fm) : WGM;
        u.pm = fm + ((wgid % nig) % gsz); u.pn = (wgid % nig) / gsz; return true;
    }
    __device__ __forceinline__ void a_ready(const Unit&) const {}
    __device__ __forceinline__ void done(const Unit&) const {}
};
__device__ __forceinline__ unsigned cvt_pk_bf16(float lo, float hi) { unsigned r; asm volatile("v_cvt_pk_bf16_f32 %0, %1, %2" : "=v"(r) : "v"(lo), "v"(hi)); return r; }

struct EpiF32 {
    static constexpr bool PERM = false, AFTER_DRAIN = false;
    GAS float* C; int ldc; int nvalid; int accum;
    __device__ __forceinline__ void operator()(const f32x4 (&acc)[2][2][4][2], const Unit& u, int wr, int wc, int fr, int fq) const {
        { const int l_ = pg8_lane_id(); fr = l_ & 15; fq = l_ >> 4; }
#pragma unroll
        for (int ai = 0; ai < 2; ++ai)
#pragma unroll
            for (int m = 0; m < 4; ++m) { const size_t row = (size_t)u.pm * BM + ai * HALF + wr * 64 + m * 16 + fr;
#pragma unroll
                for (int bj = 0; bj < 2; ++bj)
#pragma unroll
                    for (int n = 0; n < 2; ++n) { const int col = u.pn * BM + bj * HALF + wc * 32 + n * 16 + 4 * fq;
                        if (col < nvalid) { GAS float* p = C + row * ldc + col; f32x4 v = acc[ai][bj][m][n]; if (accum) v += *(const GAS f32x4*)p; *(GAS f32x4*)p = v; } } }
    }
};
struct EpiBf16 {
    static constexpr bool PERM = true, AFTER_DRAIN = false;
    GAS bf16_t* O; int ldc; int nvalid; const GAS float* ssq; int np;
    __device__ __forceinline__ void operator()(const f32x4 (&acc)[2][2][4][2], const Unit& u, int wr, int wc, int fr, int fq) const {
        { const int l_ = pg8_lane_id(); fr = l_ & 15; fq = l_ >> 4; }
#pragma unroll
        for (int ai = 0; ai < 2; ++ai)
#pragma unroll
            for (int m = 0; m < 4; ++m) { const size_t row = (size_t)u.pm * BM + ai * HALF + wr * 64 + m * 16 + fr;
                float rs_ = 1.f;
                if (np > 0) { const GAS f32x4* sp = (const GAS f32x4*)(ssq + row * 16); f32x4 t = sp[0] + sp[1]; if (np > 8) t += sp[2] + sp[3]; rs_ = __builtin_amdgcn_rsqf(((t[0] + t[1]) + (t[2] + t[3])) * (1.f / 1024.f) + 1e-6f); }
#pragma unroll
                for (int bj = 0; bj < 2; ++bj) { const int col = u.pn * BM + bj * HALF + wc * 32 + 8 * fq;
                    if (col < nvalid) { const f32x4 v0 = acc[ai][bj][m][0] * rs_, v1 = acc[ai][bj][m][1] * rs_; u32x4 w; w.x = cvt_pk_bf16(v0[0], v0[1]); w.y = cvt_pk_bf16(v0[2], v0[3]); w.z = cvt_pk_bf16(v1[0], v1[1]); w.w = cvt_pk_bf16(v1[2], v1[3]);
                        *(GAS u32x4*)(O + row * ldc + col) = w; } } }
    }
};
struct EpiUp {
    static constexpr bool PERM = true, AFTER_DRAIN = false;
    GAS bf16_t* O; GAS bf16_t* O2; int ldc; int nvalid; const GAS float* rs; int rsi; int mode;
    __device__ __forceinline__ void operator()(const f32x4 (&acc)[2][2][4][2], const Unit& u, int wr, int wc, int fr, int fq) const {
        { const int l_ = pg8_lane_id(); fr = l_ & 15; fq = l_ >> 4; }
#pragma unroll
        for (int ai = 0; ai < 2; ++ai)
#pragma unroll
            for (int m = 0; m < 4; ++m) { const size_t row = (size_t)u.pm * BM + ai * HALF + wr * 64 + m * 16 + fr; const float s = rs[2 * row + rsi];
#pragma unroll
                for (int bj = 0; bj < 2; ++bj) { const int col = u.pn * BM + bj * HALF + wc * 32 + 8 * fq;
                    if (col < nvalid) { const f32x4 v0 = acc[ai][bj][m][0] * s, v1 = acc[ai][bj][m][1] * s; u32x4 w; w.x = cvt_pk_bf16(v0[0], v0[1]); w.y = cvt_pk_bf16(v0[2], v0[3]); w.z = cvt_pk_bf16(v1[0], v1[1]); w.w = cvt_pk_bf16(v1[2], v1[3]);
                        GAS bf16_t* dst;
                        if (mode == 0) dst = O + row * ldc + col;
                        else { const int h = col >> 7, j = col & 127; dst = (j < 64) ? O + row * 384 + h * 96 + j : O2 + row * 256 + h * 64 + (j - 64); }
                        *(GAS u32x4*)dst = w; } } }
    }
};

struct EpiRes {
    static constexpr bool PERM = true, AFTER_DRAIN = false;
    GAS bf16_t* XB; GAS float* SSQ;
    __device__ __forceinline__ void operator()(const f32x4 (&acc)[2][2][4][2], const Unit& u, int wr, int wc, int fr, int fq) const {
        { const int l_ = pg8_lane_id(); fr = l_ & 15; fq = l_ >> 4; }
#pragma unroll
        for (int ai = 0; ai < 2; ++ai)
#pragma unroll
            for (int m = 0; m < 4; ++m) { const size_t row = (size_t)u.pm * BM + ai * HALF + wr * 64 + m * 16 + fr; float ss = 0.f;
#pragma unroll
                for (int bj = 0; bj < 2; ++bj) { GAS u32x4* p = (GAS u32x4*)(XB + row * 1024 + u.pn * BM + bj * HALF + wc * 32 + 8 * fq);
                    const u32x4 o = *p; const f32x4 v0 = acc[ai][bj][m][0], v1 = acc[ai][bj][m][1];
                    u32x4 w;
                    w.x = cvt_pk_bf16(__builtin_bit_cast(float, o.x << 16) + v0[0], __builtin_bit_cast(float, o.x & 0xffff0000u) + v0[1]);
                    w.y = cvt_pk_bf16(__builtin_bit_cast(float, o.y << 16) + v0[2], __builtin_bit_cast(float, o.y & 0xffff0000u) + v0[3]);
                    w.z = cvt_pk_bf16(__builtin_bit_cast(float, o.z << 16) + v1[0], __builtin_bit_cast(float, o.z & 0xffff0000u) + v1[1]);
                    w.w = cvt_pk_bf16(__builtin_bit_cast(float, o.w << 16) + v1[2], __builtin_bit_cast(float, o.w & 0xffff0000u) + v1[3]);
                    *p = w;
#pragma unroll
                    for (int e = 0; e < 4; ++e) { const float a = __builtin_bit_cast(float, w[e] << 16), b = __builtin_bit_cast(float, w[e] & 0xffff0000u); ss += a * a + b * b; } }
                { float a = ss, b = ss; asm volatile("v_nop\n\tv_nop\n\tv_permlane16_swap_b32 %0, %1" : "+v"(a), "+v"(b)); ss = a + b; }
                { float a = ss, b = ss; asm volatile("v_nop\n\tv_nop\n\tv_permlane32_swap_b32 %0, %1" : "+v"(a), "+v"(b)); ss = a + b; }
                if (fq == 0) SSQ[row * 16 + 4 * u.pn + wc] = ss; }
    }
};
template <class Epi, class Sched, bool ALIGN_EPI = false, bool SP2 = false>
__device__ __forceinline__ void gemm_phase(PG8_LAS unsigned char* lds, const Gemm g, const Sched& S, const Epi& E, int wave_id) {
    int tid_ = (wave_id << 6) | pg8_lane_id(); asm volatile("" : "+v"(tid_));
    const int tid = tid_, wid = __builtin_amdgcn_readfirstlane(tid >> 6), lane = tid & 63, wr = wid >> 2, wc = wid & 3, fr = lane & 15, fq = lane >> 4;
    const int K = g.K, nt = K / BK;
    unsigned voffA[2], voffB[2];
#pragma unroll
    for (int i = 0; i < 2; ++i) { int R, C; stage_rc(tid * 16 + i * 8192, R, C); const int Rb = Epi::PERM ? ((R & ~31) + perm32(R & 31)) : R;
        voffA[i] = (unsigned)(R * g.lda + C) * 2u; voffB[i] = (unsigned)(Rb * g.ldb + C) * 2u; }
    const size_t kstep = (size_t)(BK * 2);
    const size_t hstepA = (size_t)HALF * g.lda * 2, hstepB = (size_t)HALF * g.ldb * 2;
    const size_t tstepA = 2 * hstepA, tstepB = 2 * hstepB;
    const unsigned ldsw = (unsigned)wid * 1024u;
    const int aoff = lds_byte(wr * 64 + fr, fq * 8), boff = lds_byte(wc * 32 + fr, fq * 8);
#define PG8_SA(b, h) (((b) * 2 + (h)) * HTB)
#define PG8_SB(b, h) ((4 + (b) * 2 + (h)) * HTB)
#define PG8_STAGE(bufoff, gbase, voff) do { _Pragma("unroll") for (int _i = 0; _i < 2; ++_i) \
        __builtin_amdgcn_global_load_lds((const unsigned*)((const char*)(gbase) + (voff)[_i]), (PG8_LAS unsigned*)(lds + (bufoff) + ldsw + _i * 8192), 16, 0, 0); } while (0)
#define PG8_LDA(dst, b, h) do { _Pragma("unroll") for (int m = 0; m < 4; ++m) _Pragma("unroll") for (int k = 0; k < 2; ++k) dst[m][k] = *(const PG8_LAS bf16x8*)(lds + PG8_SA(b, h) + aoff + m * 2048 + k * 1024); } while (0)
#define PG8_LDB(dst, b, h) do { _Pragma("unroll") for (int n = 0; n < 2; ++n) _Pragma("unroll") for (int k = 0; k < 2; ++k) dst[n][k] = *(const PG8_LAS bf16x8*)(lds + PG8_SB(b, h) + boff + n * 2048 + k * 1024); } while (0)
#define PG8_MMA(ai, bj, At, Bt) do { __builtin_amdgcn_s_setprio(1); _Pragma("unroll") for (int m = 0; m < 4; ++m) _Pragma("unroll") for (int n = 0; n < 2; ++n) _Pragma("unroll") for (int k = 0; k < 2; ++k) \
        acc[ai][bj][m][n] = __builtin_amdgcn_mfma_f32_16x16x32_bf16(Bt[n][k], At[m][k], acc[ai][bj][m][n], 0, 0, 0); __builtin_amdgcn_s_setprio(0); } while (0)
#define PG8_WAIT_V(n) asm volatile("s_waitcnt vmcnt(" #n ")" ::: "memory")
#define PG8_WAIT_L(n) asm volatile("s_waitcnt lgkmcnt(" #n ")" ::: "memory")
#define PG8_BAR __builtin_amdgcn_s_barrier()
#define PG8_SCHED __builtin_amdgcn_sched_barrier(0)
    Unit cur, nxt; int ui = 0;
    if (!S.next(0, cur)) return;
    f32x4 acc[2][2][4][2];
#pragma unroll
    for (int a = 0; a < 2; ++a)
#pragma unroll
        for (int b = 0; b < 2; ++b)
#pragma unroll
            for (int m = 0; m < 4; ++m)
#pragma unroll
                for (int n = 0; n < 2; ++n) acc[a][b][m][n] = (f32x4){0.f, 0.f, 0.f, 0.f};
    bf16x8 At[4][2], B0[2][2], B1[2][2];
    const char* cA = (const char*)g.A + (size_t)cur.pm * tstepA; const char* cB = (const char*)g.Bt + (size_t)cur.pn * tstepB;
    S.a_ready(cur);
    if constexpr (SP2) {
        PG8_STAGE(PG8_SB(0, 0), cB, voffB); PG8_STAGE(PG8_SB(0, 1), cB + hstepB, voffB); PG8_STAGE(PG8_SA(0, 0), cA, voffA); PG8_STAGE(PG8_SA(0, 1), cA + hstepA, voffA);
        if (wr == 1) PG8_BAR;
        PG8_WAIT_V(2); PG8_BAR;
        PG8_STAGE(PG8_SB(1, 0), cB + kstep, voffB); PG8_STAGE(PG8_SA(1, 0), cA + kstep, voffA); PG8_STAGE(PG8_SB(1, 1), cB + hstepB + kstep, voffB);
        PG8_WAIT_V(6); PG8_BAR;
    } else {
        PG8_STAGE(PG8_SB(0, 0), cB, voffB); PG8_STAGE(PG8_SA(0, 0), cA, voffA); PG8_STAGE(PG8_SB(0, 1), cB + hstepB, voffB); PG8_STAGE(PG8_SA(0, 1), cA + hstepA, voffA);
        if (wr == 1) PG8_BAR;
        PG8_WAIT_V(4); PG8_BAR;
        PG8_STAGE(PG8_SB(1, 0), cB + kstep, voffB); PG8_STAGE(PG8_SA(1, 0), cA + kstep, voffA); PG8_STAGE(PG8_SB(1, 1), cB + hstepB + kstep, voffB);
        PG8_WAIT_V(6); PG8_BAR;
    }
    for (;;) {
        const bool has_next = S.next(ui + 1, nxt);
        const char* nA = has_next ? (const char*)g.A + (size_t)nxt.pm * tstepA : cA; const char* nB = has_next ? (const char*)g.Bt + (size_t)nxt.pn * tstepB : cB;
        for (int t = 0; t < nt; t += 2) {
            const bool last = (t == nt - 2);
            const char* a1 = cA + (size_t)(t + 1) * kstep;
            const char* a2 = last ? nA : cA + (size_t)(t + 2) * kstep; const char* b2 = last ? nB : cB + (size_t)(t + 2) * kstep;
            const char* a3 = a2 + kstep; const char* b3 = b2 + kstep;
            if (last && has_next) S.a_ready(nxt);
            if constexpr (SP2) {
            PG8_LDB(B0, 0, 0); PG8_LDB(B1, 0, 1); PG8_SCHED; PG8_LDA(At, 0, 0); PG8_STAGE(PG8_SA(1, 1), a1 + hstepA, voffA);
            PG8_WAIT_V(8); PG8_WAIT_L(0); PG8_BAR; PG8_MMA(0, 0, At, B0); PG8_MMA(0, 1, At, B1); PG8_BAR; PG8_SCHED;
            PG8_LDA(At, 0, 1); PG8_STAGE(PG8_SB(0, 0), b2, voffB); PG8_STAGE(PG8_SB(0, 1), b2 + hstepB, voffB); PG8_STAGE(PG8_SA(0, 0), a2, voffA);
            PG8_WAIT_V(8); PG8_WAIT_L(0); PG8_BAR; PG8_MMA(1, 0, At, B0); PG8_MMA(1, 1, At, B1); PG8_BAR; PG8_SCHED;
            PG8_LDB(B0, 1, 0); PG8_LDB(B1, 1, 1); PG8_SCHED; PG8_LDA(At, 1, 0); PG8_STAGE(PG8_SA(0, 1), a2 + hstepA, voffA);
            PG8_WAIT_V(8); PG8_WAIT_L(0); PG8_BAR; PG8_MMA(0, 0, At, B0); PG8_MMA(0, 1, At, B1); PG8_BAR; PG8_SCHED;
            PG8_LDA(At, 1, 1); PG8_STAGE(PG8_SB(1, 0), b3, voffB); PG8_STAGE(PG8_SB(1, 1), b3 + hstepB, voffB); PG8_STAGE(PG8_SA(1, 0), a3, voffA);
            PG8_WAIT_V(8); PG8_WAIT_L(0); PG8_BAR; PG8_MMA(1, 0, At, B0); PG8_MMA(1, 1, At, B1); PG8_BAR; PG8_SCHED;
            } else {
            PG8_LDB(B0, 0, 0); PG8_SCHED; PG8_LDA(At, 0, 0); PG8_STAGE(PG8_SA(1, 1), a1 + hstepA, voffA);
            PG8_WAIT_L(8); PG8_BAR; PG8_WAIT_L(0); PG8_MMA(0, 0, At, B0); PG8_BAR; PG8_SCHED;
            PG8_LDB(B1, 0, 1); PG8_STAGE(PG8_SB(0, 0), b2, voffB);
            PG8_BAR; PG8_WAIT_L(0); PG8_MMA(0, 1, At, B1); PG8_BAR;
            PG8_LDA(At, 0, 1); PG8_STAGE(PG8_SA(0, 0), a2, voffA);
            PG8_BAR; PG8_WAIT_L(0); PG8_MMA(1, 0, At, B0); PG8_BAR; PG8_SCHED;
            PG8_STAGE(PG8_SB(0, 1), b2 + hstepB, voffB);
            PG8_WAIT_V(6); PG8_BAR; PG8_MMA(1, 1, At, B1); PG8_BAR;
            PG8_LDB(B0, 1, 0); PG8_SCHED; PG8_LDA(At, 1, 0); PG8_STAGE(PG8_SA(0, 1), a2 + hstepA, voffA);
            PG8_WAIT_L(8); PG8_BAR; PG8_WAIT_L(0); PG8_MMA(0, 0, At, B0); PG8_BAR; PG8_SCHED;
            PG8_LDB(B1, 1, 1); PG8_STAGE(PG8_SB(1, 0), b3, voffB);
            PG8_BAR; PG8_WAIT_L(0); PG8_MMA(0, 1, At, B1); PG8_BAR;
            PG8_LDA(At, 1, 1); PG8_STAGE(PG8_SA(1, 0), a3, voffA);
            PG8_BAR; PG8_WAIT_L(0); PG8_MMA(1, 0, At, B0); PG8_BAR; PG8_SCHED;
            PG8_STAGE(PG8_SB(1, 1), b3 + hstepB, voffB);
            PG8_WAIT_V(6); PG8_BAR; PG8_MMA(1, 1, At, B1); PG8_BAR;
            }
        }
        if constexpr (ALIGN_EPI) { if (wr == 0) PG8_BAR; }
        if constexpr (!Epi::AFTER_DRAIN) { E(acc, cur, wr, wc, fr, fq); S.done(cur); }
        if (!has_next) break;
#pragma unroll
        for (int a = 0; a < 2; ++a)
#pragma unroll
            for (int b = 0; b < 2; ++b)
#pragma unroll
                for (int m = 0; m < 4; ++m)
#pragma unroll
                    for (int n = 0; n < 2; ++n) acc[a][b][m][n] = (f32x4){0.f, 0.f, 0.f, 0.f};
        cur = nxt; cA = nA; cB = nB; ++ui;
        if constexpr (ALIGN_EPI) { if (wr == 1) PG8_BAR; }
    }
    PG8_WAIT_V(0);
    if constexpr (!ALIGN_EPI) { if (wr == 0) PG8_BAR; }
    PG8_BAR;
    if constexpr (Epi::AFTER_DRAIN) { E.fused(acc, cur, wr, wc, fr, fq, lds, wid, lane); S.done(cur); }
#undef PG8_SA
#undef PG8_SB
#undef PG8_STAGE
#undef PG8_LDA
#undef PG8_LDB
#undef PG8_MMA
#undef PG8_WAIT_V
#undef PG8_WAIT_L
#undef PG8_BAR
#undef PG8_SCHED
}
}

namespace mk {
#ifndef GAS
#define GAS __attribute__((address_space(1)))
#endif
#define LAS __attribute__((address_space(3)))
typedef unsigned short bf16;
typedef unsigned v4u __attribute__((ext_vector_type(4)));
typedef unsigned v2u __attribute__((ext_vector_type(2)));
typedef float f32x4 __attribute__((ext_vector_type(4)));
typedef GAS unsigned gu32;
#define LDS_WAIT() asm volatile("s_waitcnt lgkmcnt(0)" ::: "memory")
#define VM_WAIT() asm volatile("s_waitcnt vmcnt(0)" ::: "memory")
__device__ __forceinline__ unsigned f2bf_(float f) { unsigned u = __builtin_bit_cast(unsigned, f); return (u + 0x7fffu + ((u >> 16) & 1u)) >> 16; }
__device__ __forceinline__ unsigned pk2(float lo, float hi) { return f2bf_(lo) | (f2bf_(hi) << 16); }
__device__ __forceinline__ float bflo(unsigned w) { return __builtin_bit_cast(float, w << 16); }
__device__ __forceinline__ float bfhi(unsigned w) { return __builtin_bit_cast(float, w & 0xffff0000u); }

template <class P> __device__ __forceinline__ P* opq(P* p) { asm volatile("" : "+s"(p)); return p; }
__device__ __forceinline__ int opqi(int k) { asm volatile("" : "+s"(k)); return k; }
__device__ __forceinline__ float shx(float v, int o, int lane) { return __builtin_bit_cast(float, __builtin_amdgcn_ds_bpermute((lane ^ o) << 2, __builtin_bit_cast(int, v))); }
__device__ __forceinline__ int shxi(int v, int o, int lane) { return __builtin_amdgcn_ds_bpermute((lane ^ o) << 2, v); }
__device__ __forceinline__ int lane_id_v() { int l; asm volatile("v_mbcnt_lo_u32_b32 %0, -1, 0\n\tv_mbcnt_hi_u32_b32 %0, -1, %0" : "=v"(l)); return l; }
constexpr int NWAVES = 8;
constexpr int D = 1024, NB = 4, S = 8192, T = NB * S, L = 4, MEM = 256, INW = 2144, INP = 2304;
constexpr int PC_CQ = 0, PC_CKV = 256, PC_KR = 384, PC_XL = 512, PC_GL = 1024, PC_QD = 1536, PC_KD = 1792, PC_VD = 2048;
constexpr float LOG2E = 1.4426950408889634f;
constexpr size_t MiB = 1u << 20;
constexpr size_t WS_CTL = 0, CTL_ZERO_BYTES = 1 * MiB;
constexpr size_t WS_WIN = 1 * MiB, WS_WOUT = 19 * MiB, WS_WCQ = 27 * MiB, WS_WCO = 35 * MiB, WS_WPQ = 43 * MiB, WS_WCKV = 51 * MiB, WS_WUQ = 67 * MiB, WS_WUKV = 68 * MiB, WS_KEYS = 69 * MiB, WS_ROPE = 70 * MiB;
constexpr size_t WS_XNB = 76 * MiB, WS_YB = 140 * MiB, WS_PROJB = 204 * MiB, WS_QMB = 348 * MiB, WS_KMB = 372 * MiB, WS_VMB = 396 * MiB, WS_RS = 412 * MiB;
constexpr size_t WS_HLB = 413 * MiB, WS_ACB = 445 * MiB, WS_LSUM = 477 * MiB, WS_OMB = 478 * MiB, WS_MNB = 494 * MiB, WS_KVCB = 502 * MiB, WS_EX = 518 * MiB, WS_GW = 534 * MiB;
constexpr size_t WS_U8 = 550 * MiB, WS_V8 = 614 * MiB, WS_SU = 678 * MiB, WS_SV = 679 * MiB;
constexpr size_t WS_HQ = 680 * MiB, WS_P = 712 * MiB, WS_SH = 728 * MiB, WS_W = 729 * MiB, WS_WS = 745 * MiB, WS_SSQ = 746 * MiB, WS_END = 748 * MiB;
constexpr size_t WS_WAT = 74 * MiB;
constexpr size_t WS_BTAB = WS_KEYS + 512 * 1024, WS_LAMS = WS_BTAB + 4096, WS_SP = WS_LAMS + 4096;
constexpr int CW_BAR = 4096, CW_RANK = 8192;
constexpr int RING_OFF = 0, RING_BYTES = 155648, LDSCTL_OFF = RING_BYTES, MISC_OFF = LDSCTL_OFF + 320, LDS_BYTES = 163840;

#define XB_TMO      128
#define XB_XCNT(j)  (256  + 64 * (j))
#define XB_XSUB(j)  (1280 + 64 * (j))
#define XB_XGEN(j)  (2304 + 64 * (j))
#define XB_TOP      3328
#define XB_TOPGEN   3392
#define XCD_BAR_WORDS 3456
#define XB_SPIN_CAP (1u << 18)

__device__ __forceinline__ unsigned xb_ld(unsigned* p)              { return __hip_atomic_load(p, __ATOMIC_RELAXED, __HIP_MEMORY_SCOPE_AGENT); }
__device__ __forceinline__ unsigned xb_add(unsigned* p, unsigned v) { return __hip_atomic_fetch_add(p, v, __ATOMIC_RELAXED, __HIP_MEMORY_SCOPE_AGENT); }
__device__ __forceinline__ unsigned xb_xcc_id() { return (unsigned)__builtin_amdgcn_s_getreg((3 << 11) | 20) & 0xFu; }
#define XB_SPIN(cond, bar) do { unsigned _sp = 0; while (cond) { __builtin_amdgcn_s_sleep(1); \
    if ((++_sp & 255u) == 0u) { if (xb_ld(&(bar)[XB_TMO])) break; if (_sp > XB_SPIN_CAP) { atomicAdd(&(bar)[XB_TMO], 1u); break; } } } } while (0)

struct XcdBarrier {
    unsigned* bar; unsigned x;
    volatile LAS unsigned* st;
};

__device__ __forceinline__ XcdBarrier xcd_barrier_post(unsigned* bar, volatile LAS unsigned* st) {
    XcdBarrier b; b.bar = bar; b.x = xb_xcc_id(); b.st = st;
    if (threadIdx.x == 0) (void)xb_add(&bar[XB_XCNT(b.x)], 1u);
    return b;
}
__device__ __forceinline__ void xcd_barrier_complete(unsigned* bar, unsigned x, unsigned& nloc, unsigned& nx) {
    const unsigned G = gridDim.x * gridDim.y * gridDim.z;
    unsigned sum, cnt, mine, sp = 0u;
    for (;;) {
        sum = 0u; cnt = 0u; mine = 0u;
#pragma unroll
        for (unsigned j = 0; j < 16; ++j) { const unsigned c = xb_ld(&bar[XB_XCNT(j)]); sum += c; cnt += (c > 0u) ? 1u : 0u; mine = (j == x) ? c : mine; }
        if (sum == G) break;
        __builtin_amdgcn_s_sleep(1);
        if ((++sp & 255u) == 0u) { if (xb_ld(&bar[XB_TMO])) break; if (sp > XB_SPIN_CAP) { atomicAdd(&bar[XB_TMO], 1u); break; } }
    }
    nloc = mine > 0u ? mine : 1u; nx = cnt > 0u ? cnt : 1u;
}

__device__ __noinline__ void xcd_barrier_impl(unsigned* bar_, unsigned x_, volatile LAS unsigned* st_, int leader_) {
    XcdBarrier b; b.bar = bar_; b.x = x_; b.st = st_;
    asm volatile("s_waitcnt vmcnt(0)" ::: "memory");
    __syncthreads();
    if (leader_) {
        unsigned* bar = b.bar;
        __builtin_amdgcn_s_waitcnt(0);
        unsigned nloc = b.st[0], nx = b.st[1];
        if (nloc == 0u) { xcd_barrier_complete(bar, b.x, nloc, nx); b.st[0] = nloc; b.st[1] = nx; }
        const unsigned old = xb_add(&bar[XB_XSUB(b.x)], 1u);
        const unsigned gen = old / nloc;
        if (old + 1u == (gen + 1u) * nloc) {
            __builtin_amdgcn_fence(__ATOMIC_RELEASE, "agent");
            asm volatile("s_waitcnt vmcnt(0)" ::: "memory");
            const unsigned og = xb_add(&bar[XB_TOP], 1u);
            const unsigned tg = og / nx;
            if (og + 1u == (tg + 1u) * nx) xb_add(&bar[XB_TOPGEN], 1u);
            else XB_SPIN(xb_ld(&bar[XB_TOPGEN]) == tg, bar);
            __builtin_amdgcn_fence(__ATOMIC_ACQUIRE, "agent");
            xb_add(&bar[XB_XGEN(b.x)], 1u);
            asm volatile("s_waitcnt vmcnt(0)" ::: "memory");
        } else {
            XB_SPIN(xb_ld(&bar[XB_XGEN(b.x)]) == gen, bar);
            __builtin_amdgcn_fence(__ATOMIC_ACQUIRE, "agent");
            asm volatile("s_waitcnt vmcnt(0)" ::: "memory");
        }
    }
    __syncthreads();
}
__device__ __forceinline__ void xcd_barrier(const XcdBarrier& b, int leader) { xcd_barrier_impl(b.bar, b.x, b.st, leader); }


__device__ __forceinline__ float wave_sum(float v, int lane) {
    (void)lane;
    v += __builtin_bit_cast(float, __builtin_amdgcn_update_dpp(0, __builtin_bit_cast(int, v), 0xB1, 0xF, 0xF, true));
    v += __builtin_bit_cast(float, __builtin_amdgcn_update_dpp(0, __builtin_bit_cast(int, v), 0x4E, 0xF, 0xF, true));
    v += __builtin_bit_cast(float, __builtin_amdgcn_update_dpp(0, __builtin_bit_cast(int, v), 0x141, 0xF, 0xF, true));
    v += __builtin_bit_cast(float, __builtin_amdgcn_update_dpp(0, __builtin_bit_cast(int, v), 0x140, 0xF, 0xF, true));
    { float a = v, b = v; asm volatile("v_nop\n\tv_nop\n\tv_permlane16_swap_b32 %0, %1" : "+v"(a), "+v"(b)); v = a + b; }
    { float a = v, b = v; asm volatile("v_nop\n\tv_nop\n\tv_permlane32_swap_b32 %0, %1" : "+v"(a), "+v"(b)); v = a + b; }
    return v;
}
__device__ __forceinline__ float wave_max(float v) {
    v = fmaxf(v, __builtin_bit_cast(float, __builtin_amdgcn_update_dpp(0, __builtin_bit_cast(int, v), 0xB1, 0xF, 0xF, true)));
    v = fmaxf(v, __builtin_bit_cast(float, __builtin_amdgcn_update_dpp(0, __builtin_bit_cast(int, v), 0x4E, 0xF, 0xF, true)));
    v = fmaxf(v, __builtin_bit_cast(float, __builtin_amdgcn_update_dpp(0, __builtin_bit_cast(int, v), 0x141, 0xF, 0xF, true)));
    v = fmaxf(v, __builtin_bit_cast(float, __builtin_amdgcn_update_dpp(0, __builtin_bit_cast(int, v), 0x140, 0xF, 0xF, true)));
    { float a = v, b = v; asm volatile("v_nop\n\tv_nop\n\tv_permlane16_swap_b32 %0, %1" : "+v"(a), "+v"(b)); v = fmaxf(a, b); }
    { float a = v, b = v; asm volatile("v_nop\n\tv_nop\n\tv_permlane32_swap_b32 %0, %1" : "+v"(a), "+v"(b)); v = fmaxf(a, b); }
    return v;
}
__device__ __forceinline__ float gelu_erf(float v) {
    const float av = __builtin_fabsf(v), t = __builtin_amdgcn_rcpf(av * 0.2316418882f + 1.0f);
    float q = t * 0.5307027145f + (-0.7265760135f); q = q * t + 0.7107068705f; q = q * t + (-0.142248368f); q = q * t + 0.127414796f; q = q * t;
    const float e = __builtin_amdgcn_exp2f((v * v) * (-0.72134752044f));
    const float m = v * (q * e);
    return v < 0.f ? m : v - m;
}

__device__ __forceinline__ void norm_phase(const GAS float* X, const GAS float* g, GAS bf16* out, int rows, int gw, int NGW, int lane) {
    asm volatile("" : "+v"(lane));
    f32x4 gv[4];
#pragma unroll
    for (int j = 0; j < 4; ++j) gv[j] = ((const GAS f32x4*)g)[lane + 64 * j];
    for (int m = gw; m < rows; m += NGW) {
        const GAS f32x4* xr = (const GAS f32x4*)(X + (size_t)m * D) + lane;
        f32x4 v[4]; float s = 0.f;
#pragma unroll
        for (int j = 0; j < 4; ++j) { v[j] = xr[64 * j]; s += (v[j].x * v[j].x + v[j].y * v[j].y) + (v[j].z * v[j].z + v[j].w * v[j].w); }
        const float rs = rsqrtf(wave_sum(s, lane) * (1.f / D) + 1e-6f);
        GAS v2u* o8 = (GAS v2u*)(out + (size_t)m * D) + lane;
#pragma unroll
        for (int j = 0; j < 4; ++j) { v2u w; w.x = pk2(v[j].x * rs * gv[j].x, v[j].y * rs * gv[j].y); w.y = pk2(v[j].z * rs * gv[j].z, v[j].w * rs * gv[j].w); o8[64 * j] = w; }
    }
}
__device__ __forceinline__ void hq_phase(const GAS bf16* XB, const GAS float* SSQ, const GAS float* g, GAS unsigned char* HQ, GAS float* SH, GAS int* Pz, int gw, int NGW, int lane) {
    asm volatile("" : "+v"(lane));
    const GAS f32x4* gp = (const GAS f32x4*)g + 4 * lane; const f32x4 g0 = gp[0], g1 = gp[1], g2 = gp[2], g3 = gp[3];
    for (int m = gw; m < T; m += NGW) {
        const GAS f32x4* sp = (const GAS f32x4*)(SSQ + (size_t)m * 16); const f32x4 t = (sp[0] + sp[1]) + (sp[2] + sp[3]);
        const float rs = __builtin_amdgcn_rsqf(((t[0] + t[1]) + (t[2] + t[3])) * (1.f / 1024.f) + 1e-6f);
        const v4u a = *(const GAS v4u*)(XB + (size_t)m * D + 16 * lane), b = *(const GAS v4u*)(XB + (size_t)m * D + 16 * lane + 8);
        float f[16] = {bflo(a.x) * g0[0], bfhi(a.x) * g0[1], bflo(a.y) * g0[2], bfhi(a.y) * g0[3], bflo(a.z) * g1[0], bfhi(a.z) * g1[1], bflo(a.w) * g1[2], bfhi(a.w) * g1[3],
                       bflo(b.x) * g2[0], bfhi(b.x) * g2[1], bflo(b.y) * g2[2], bfhi(b.y) * g2[3], bflo(b.z) * g3[0], bfhi(b.z) * g3[1], bflo(b.w) * g3[2], bfhi(b.w) * g3[3]};
        float mx = 0.f;
#pragma unroll
        for (int i = 0; i < 16; ++i) { f[i] *= rs; mx = fmaxf(mx, __builtin_fabsf(f[i])); }
        mx = wave_max(mx);
        const float inv = mx > 0.f ? 127.f / mx : 0.f;
        v4u q;
#pragma unroll
        for (int i = 0; i < 4; ++i) { const int ia = (int)__builtin_rintf(f[4 * i] * inv), ib = (int)__builtin_rintf(f[4 * i + 1] * inv), ic = (int)__builtin_rintf(f[4 * i + 2] * inv), id = (int)__builtin_rintf(f[4 * i + 3] * inv);
            q[i] = (unsigned)(ia & 255) | ((unsigned)(ib & 255) << 8) | ((unsigned)(ic & 255) << 16) | ((unsigned)(id & 255) << 24); }
        *(GAS v4u*)(HQ + (size_t)m * D + 16 * lane) = q;
        if (lane == 0) SH[m] = mx * (1.f / 127.f);
    }
}
__device__ __forceinline__ void x0_phase(const GAS float* X, GAS bf16* XB, GAS float* SSQ, int gw, int NGW, int lane) {
    asm volatile("" : "+v"(lane));
    for (int m = gw; m < T; m += NGW) {
        const GAS f32x4* xr = (const GAS f32x4*)(X + (size_t)m * D) + lane; GAS v2u* o8 = (GAS v2u*)(XB + (size_t)m * D) + lane;
        float s = 0.f;
#pragma unroll
        for (int j = 0; j < 4; ++j) { const f32x4 v = xr[64 * j]; s += (v.x * v.x + v.y * v.y) + (v.z * v.z + v.w * v.w); v2u w; w.x = pk2(v.x, v.y); w.y = pk2(v.z, v.w); o8[64 * j] = w; }
        s = wave_sum(s, lane);
        if (lane < 8) SSQ[(size_t)m * 16 + lane] = lane == 0 ? s : 0.f;
    }
}
__device__ __forceinline__ void final_norm_phase(const GAS bf16* XB, GAS float* O, const GAS float* g, int rows, int gw, int NGW, int lane) {
    asm volatile("" : "+v"(lane));
    for (int m = gw; m < rows; m += NGW) {
        const GAS v4u* xr = (const GAS v4u*)(XB + (size_t)m * D) + lane;
        v4u v[2]; float s = 0.f;
#pragma unroll
        for (int j = 0; j < 2; ++j) { v[j] = xr[64 * j];
#pragma unroll
            for (int e = 0; e < 4; ++e) { const float a = bflo(v[j][e]), b = bfhi(v[j][e]); s += a * a + b * b; } }
        const float rs = rsqrtf(wave_sum(s, lane) * (1.f / D) + 1e-6f);
#pragma unroll
        for (int j = 0; j < 2; ++j) { const int c = 8 * (lane + 64 * j); const f32x4 g0 = *(const GAS f32x4*)(g + c), g1 = *(const GAS f32x4*)(g + c + 4);
            f32x4 o0, o1; o0.x = bflo(v[j].x) * rs * g0.x; o0.y = bfhi(v[j].x) * rs * g0.y; o0.z = bflo(v[j].y) * rs * g0.z; o0.w = bfhi(v[j].y) * rs * g0.w;
            o1.x = bflo(v[j].z) * rs * g1.x; o1.y = bfhi(v[j].z) * rs * g1.y; o1.z = bflo(v[j].w) * rs * g1.z; o1.w = bfhi(v[j].w) * rs * g1.w;
            *(GAS f32x4*)(O + (size_t)m * D + c) = o0; *(GAS f32x4*)(O + (size_t)m * D + c + 4) = o1; }
    }
}

__device__ __forceinline__ float row16_sum(float v) {
    v += __builtin_bit_cast(float, __builtin_amdgcn_update_dpp(0, __builtin_bit_cast(int, v), 0xB1, 0xF, 0xF, true));
    v += __builtin_bit_cast(float, __builtin_amdgcn_update_dpp(0, __builtin_bit_cast(int, v), 0x4E, 0xF, 0xF, true));
    v += __builtin_bit_cast(float, __builtin_amdgcn_update_dpp(0, __builtin_bit_cast(int, v), 0x141, 0xF, 0xF, true));
    v += __builtin_bit_cast(float, __builtin_amdgcn_update_dpp(0, __builtin_bit_cast(int, v), 0x140, 0xF, 0xF, true));
    return v;
}
__device__ __forceinline__ float sq8(const v4u w) { const float a0 = bflo(w.x), a1 = bfhi(w.x), a2 = bflo(w.y), a3 = bfhi(w.y), a4 = bflo(w.z), a5 = bfhi(w.z), a6 = bflo(w.w), a7 = bfhi(w.w);
    return (a0 * a0 + a1 * a1) + (a2 * a2 + a3 * a3) + (a4 * a4 + a5 * a5) + (a6 * a6 + a7 * a7); }
__device__ __forceinline__ void pre_phase(const GAS bf16* PROJB, const GAS float* ROPE, GAS float* RS, GAS bf16* KMB, int gw, int NGW, int lane) {
    asm volatile("" : "+v"(lane));
    const int q = lane >> 4, sub = lane & 15;
    for (int t0 = gw * 4; t0 < T; t0 += NGW * 4) {
        const size_t t = (size_t)t0 + q;
        const GAS bf16* pr = PROJB + t * INP;
        const v4u w0 = *(const GAS v4u*)(pr + PC_CQ + 8 * sub), w1 = *(const GAS v4u*)(pr + PC_CQ + 8 * (16 + (sub & 7))), w2 = *(const GAS v4u*)(pr + PC_CKV + 8 * sub);
        const float x1 = __builtin_bit_cast(float, (unsigned)pr[PC_KR + sub] << 16), x2 = __builtin_bit_cast(float, (unsigned)pr[PC_KR + 16 + sub] << 16);
        const float c = ROPE[t * 32 + sub], sn = ROPE[t * 32 + 16 + sub];
        const float sq = row16_sum(sq8(w0) + (sub < 8 ? sq8(w1) : 0.f)), skv = row16_sum(sq8(w2));
        if (sub == 0) { RS[2 * t] = rsqrtf(sq * (1.f / 192.f) + 1e-6f); RS[2 * t + 1] = rsqrtf(skv * (1.f / 128.f) + 1e-6f); }
        const bf16 y1 = (bf16)f2bf_(x1 * c - x2 * sn), y2 = (bf16)f2bf_(x1 * sn + x2 * c);
        GAS bf16* kr = KMB + t * 384 + 64 + sub;
#pragma unroll
        for (int h = 0; h < 4; ++h) { kr[h * 96] = y1; kr[h * 96 + 16] = y2; }
    }
}

typedef short lr_bf16x8 __attribute__((ext_vector_type(8)));
typedef float lr_f32x16 __attribute__((ext_vector_type(16)));
__device__ __forceinline__ void lr_swap32(float& a, float& b) { asm volatile("v_nop\n\tv_nop\n\tv_permlane32_swap_b32 %0, %1" : "+v"(a), "+v"(b)); }
constexpr int LR_XR = 0, LR_CW = LR_XR + 37376, LR_XA = LR_CW + 1280, LR_WT = LR_XA + 256 * 144, LR_SUM = LR_WT + 2 * 64 * 144, LR_END = LR_SUM + 4096;
struct LruP { const GAS bf16* PROJB; const GAS float* cw; const GAS float* cb; const GAS bf16* wat; const GAS float* ba; const GAS float* bx; const GAS float* sp; GAS unsigned* HA; GAS float* LSUM; };
__device__ __forceinline__ void lru_phase(const LruP& P, LAS unsigned char* lds, int tid, int wave, int lane, int vcu, int G) {
    asm volatile("" : "+v"(tid), "+v"(lane));
    LAS float* SUM = (LAS float*)(lds + LR_SUM);
    for (int u = vcu; u < (T / 256) * 8; u += G) {
        const int tile = u >> 3, g = u & 7; const int t0 = tile * 256; const bool first = ((tile & 31) == 0);
        __syncthreads();
        float ba_[2], bx_[2], sp_[2];
#pragma unroll
        for (int nt = 0; nt < 2; ++nt) { const int ch = 64 * g + 32 * nt + (lane & 31); ba_[nt] = P.ba[ch]; bx_[nt] = P.bx[ch]; sp_[nt] = P.sp[ch]; }
        { v4u wt_[2], xr_[5];
#pragma unroll
          for (int i = 0; i < 2; ++i) { const int idx = tid + 512 * i; wt_[i] = ((const GAS v4u*)(P.wat + (size_t)g * 2 * 4096))[idx]; }
#pragma unroll
          for (int i = 0; i < 5; ++i) { const int idx = tid + 512 * i, row = idx >> 3, part = idx & 7; const bool ok = (idx < 259 * 8) && !(first && row < 3);
              const int trow = ok ? t0 - 3 + row : t0;
              xr_[i] = *(const GAS v4u*)(P.PROJB + (size_t)trow * INP + PC_XL + 64 * g + 8 * part); if (!ok) xr_[i] = v4u{0u, 0u, 0u, 0u}; }
          float cwv = 0.f; if (tid < 320) cwv = (tid < 256) ? P.cw[(tid >> 6) * 512 + 64 * g + (tid & 63)] : P.cb[64 * g + (tid - 256)];
#pragma unroll
          for (int i = 0; i < 2; ++i) { const int idx = tid + 512 * i; *(LAS v4u*)(lds + LR_WT + (idx >> 9) * 9216 + ((idx >> 3) & 63) * 144 + (idx & 7) * 16) = wt_[i]; }
#pragma unroll
          for (int i = 0; i < 5; ++i) { const int idx = tid + 512 * i, row = idx >> 3, part = idx & 7; if (idx < 259 * 8) *(LAS v4u*)(lds + LR_XR + row * 144 + 16 * part) = xr_[i]; }
          if (tid < 320) ((LAS float*)(lds + LR_CW))[tid] = cwv; }
        __syncthreads();
        { float cwr[4][8], cbr[8];
#pragma unroll
          for (int k = 0; k < 4; ++k) { const f32x4 c0 = *(const LAS f32x4*)(lds + LR_CW + (k * 64 + 8 * wave) * 4), c1 = *(const LAS f32x4*)(lds + LR_CW + (k * 64 + 8 * wave + 4) * 4);
              cwr[k][0] = c0.x; cwr[k][1] = c0.y; cwr[k][2] = c0.z; cwr[k][3] = c0.w; cwr[k][4] = c1.x; cwr[k][5] = c1.y; cwr[k][6] = c1.z; cwr[k][7] = c1.w; }
          { const f32x4 c0 = *(const LAS f32x4*)(lds + LR_CW + (256 + 8 * wave) * 4), c1 = *(const LAS f32x4*)(lds + LR_CW + (256 + 8 * wave + 4) * 4);
            cbr[0] = c0.x; cbr[1] = c0.y; cbr[2] = c0.z; cbr[3] = c0.w; cbr[4] = c1.x; cbr[5] = c1.y; cbr[6] = c1.z; cbr[7] = c1.w; }
#pragma unroll
          for (int it_ = 0; it_ < 4; ++it_) { const int time = lane + 64 * it_;
              float y[8];
#pragma unroll
              for (int e = 0; e < 8; ++e) y[e] = cbr[e];
#pragma unroll
              for (int k = 0; k < 4; ++k) { const v4u w = *(const LAS v4u*)(lds + LR_XR + (time + k) * 144 + 16 * wave);
                  y[0] += bflo(w.x) * cwr[k][0]; y[1] += bfhi(w.x) * cwr[k][1]; y[2] += bflo(w.y) * cwr[k][2]; y[3] += bfhi(w.y) * cwr[k][3];
                  y[4] += bflo(w.z) * cwr[k][4]; y[5] += bfhi(w.z) * cwr[k][5]; y[6] += bflo(w.w) * cwr[k][6]; y[7] += bfhi(w.w) * cwr[k][7]; }
              v4u o; o.x = pk2(y[0], y[1]); o.y = pk2(y[2], y[3]); o.z = pk2(y[4], y[5]); o.w = pk2(y[6], y[7]);
              *(LAS v4u*)(lds + LR_XA + time * 144 + 16 * wave) = o; } }
        __syncthreads();
        const int r32 = lane & 31, hi = lane >> 5;
        lr_f32x16 acc[2][2];
#pragma unroll
        for (int nt = 0; nt < 2; ++nt) { const float b_a = ba_[nt], b_x = bx_[nt];
#pragma unroll
            for (int r = 0; r < 16; ++r) { acc[0][nt][r] = b_a; acc[1][nt][r] = b_x; } }
        { lr_bf16x8 af[4];
#pragma unroll
          for (int s_ = 0; s_ < 4; ++s_) af[s_] = *(const LAS lr_bf16x8*)(lds + LR_XA + (32 * wave + r32) * 144 + (16 * s_ + 8 * hi) * 2);
#pragma unroll
          for (int gt = 0; gt < 2; ++gt)
#pragma unroll
              for (int nt = 0; nt < 2; ++nt)
#pragma unroll
                  for (int s_ = 0; s_ < 4; ++s_) { const lr_bf16x8 bfr = *(const LAS lr_bf16x8*)(lds + LR_WT + gt * 9216 + (32 * nt + r32) * 144 + (16 * s_ + 8 * hi) * 2);
                      acc[gt][nt] = __builtin_amdgcn_mfma_f32_32x32x16_bf16(af[s_], bfr, acc[gt][nt], 0, 0, 0); } }
#pragma unroll
        for (int nt = 0; nt < 2; ++nt) { const float sp = sp_[nt];
            float sa_[4], sh_[4];
#pragma unroll
            for (int q = 0; q < 4; ++q) { float hrun = 0.f, arun = 1.f;
#pragma unroll
                for (int e = 0; e < 4; ++e) { const int r = 4 * q + e, tl = 8 * q + 4 * hi + e;
                    const float xv = __builtin_bit_cast(float, (unsigned)*(const LAS unsigned short*)(lds + LR_XA + (32 * wave + tl) * 144 + (32 * nt + r32) * 2) << 16);
                    const float rg = __builtin_amdgcn_rcpf(1.f + __builtin_amdgcn_exp2f(-LOG2E * acc[0][nt][r])), ig = __builtin_amdgcn_rcpf(1.f + __builtin_amdgcn_exp2f(-LOG2E * acc[1][nt][r]));
                    const float la = -8.0f * rg * sp; const float a_ = __builtin_amdgcn_exp2f(LOG2E * la);
                    const float uu = __builtin_amdgcn_sqrtf(fmaxf(1.f - a_ * a_, 0.f)) * (ig * xv);
                    hrun = a_ * hrun + uu; arun *= a_; acc[0][nt][r] = arun; acc[1][nt][r] = hrun; }
                sa_[q] = arun; sh_[q] = hrun; }
            float runA = 1.f, runH = 0.f;
#pragma unroll
            for (int q = 0; q < 4; ++q) { float a0 = sa_[q], a1 = sa_[q], h0 = sh_[q], h1 = sh_[q]; lr_swap32(a0, a1); lr_swap32(h0, h1);
                const float midA = runA * a0, midH = a0 * runH + h0;
                const float inA = hi ? midA : runA, inH = hi ? midH : runH;
                runA = midA * a1; runH = a1 * midH + h1;
#pragma unroll
                for (int e = 0; e < 4; ++e) { const int r = 4 * q + e; acc[1][nt][r] += acc[0][nt][r] * inH; acc[0][nt][r] *= inA; } }
            if (hi == 0) { SUM[(wave * 64 + 32 * nt + r32) * 2] = runA; SUM[(wave * 64 + 32 * nt + r32) * 2 + 1] = runH; } }
        __syncthreads();
#pragma unroll
        for (int nt = 0; nt < 2; ++nt) { const int cl = 32 * nt + r32;
            float ca = 1.f, chh = 0.f;
            for (int w = 0; w < wave; ++w) { const float aw = SUM[(w * 64 + cl) * 2], hw = SUM[(w * 64 + cl) * 2 + 1]; chh = aw * chh + hw; ca *= aw; }
            GAS unsigned* ha = P.HA + (size_t)(t0 + 32 * wave + 4 * hi) * 512 + 64 * g + cl;
#pragma unroll
            for (int r = 0; r < 16; ++r) { const float hh = acc[1][nt][r] + acc[0][nt][r] * chh, ac_ = acc[0][nt][r] * ca; ha[(size_t)((r & 3) + 8 * (r >> 2)) * 512] = pk2(hh, ac_);
                if (r == 15 && wave == 7 && hi == 1) { P.LSUM[((size_t)tile * 512 + 64 * g + cl) * 2] = ac_; P.LSUM[((size_t)tile * 512 + 64 * g + cl) * 2 + 1] = hh; } } }
    }
}

struct PostP { const GAS bf16* OMB; const GAS unsigned* HA; const GAS float* LSUM; const GAS bf16* PROJB; const GAS float* gm; const GAS float* gl; GAS bf16* Y; };
__device__ __forceinline__ void post_phase(const PostP& P, LAS unsigned char* lds, int tid, int wave, int lane, int vcu, int G) {
    asm volatile("" : "+v"(tid), "+v"(lane));
    LAS float* hin = (LAS float*)lds;
    for (int u = vcu; u < T / 64; u += G) {
        const int t0 = u * 64, tile = t0 >> 8, tb = tile & ~31;
        __syncthreads();
        { float h = 0.f;
          for (int c0 = tb; c0 < tile; c0 += 8) {
              float av_[8], hv_[8];
#pragma unroll
              for (int i = 0; i < 8; ++i) { const int c = (c0 + i < tile) ? (c0 + i) : tb; av_[i] = P.LSUM[((size_t)c * 512 + tid) * 2]; hv_[i] = P.LSUM[((size_t)c * 512 + tid) * 2 + 1]; }
#pragma unroll
              for (int i = 0; i < 8; ++i) { if (c0 + i < tile) h = av_[i] * h + hv_[i]; } }
          hin[tid] = h; }
        __syncthreads();
        f32x4 hi0 = *(const LAS f32x4*)(hin + 8 * lane), hi1 = *(const LAS f32x4*)(hin + 8 * lane + 4);
        const f32x4 g0 = *(const GAS f32x4*)(P.gl + 8 * lane), g1 = *(const GAS f32x4*)(P.gl + 8 * lane + 4), gmv = *(const GAS f32x4*)(P.gm + 4 * lane);
#pragma unroll 2
        for (int i = 0; i < 8; ++i) {
            const size_t t = (size_t)t0 + 8 * wave + i;
            const v4u p0 = *(const GAS v4u*)(P.HA + t * 512 + 8 * lane), p1 = *(const GAS v4u*)(P.HA + t * 512 + 8 * lane + 4), gw_ = *(const GAS v4u*)(P.PROJB + t * INP + PC_GL + 8 * lane);
            const v2u mw = *(const GAS v2u*)(P.OMB + t * 256 + 4 * lane);
            float o[8];
            o[0] = (bflo(p0.x) + bfhi(p0.x) * hi0.x) * gelu_erf(bflo(gw_.x)); o[1] = (bflo(p0.y) + bfhi(p0.y) * hi0.y) * gelu_erf(bfhi(gw_.x));
            o[2] = (bflo(p0.z) + bfhi(p0.z) * hi0.z) * gelu_erf(bflo(gw_.y)); o[3] = (bflo(p0.w) + bfhi(p0.w) * hi0.w) * gelu_erf(bfhi(gw_.y));
            o[4] = (bflo(p1.x) + bfhi(p1.x) * hi1.x) * gelu_erf(bflo(gw_.z)); o[5] = (bflo(p1.y) + bfhi(p1.y) * hi1.y) * gelu_erf(bfhi(gw_.z));
            o[6] = (bflo(p1.z) + bfhi(p1.z) * hi1.z) * gelu_erf(bflo(gw_.w)); o[7] = (bflo(p1.w) + bfhi(p1.w) * hi1.w) * gelu_erf(bfhi(gw_.w));
            float s2 = 0.f;
#pragma unroll
            for (int e = 0; e < 8; ++e) s2 += o[e] * o[e];
            const float m0 = bflo(mw.x), m1 = bfhi(mw.x), m2 = bflo(mw.y), m3 = bfhi(mw.y);
            float s1 = (m0 * m0 + m1 * m1) + (m2 * m2 + m3 * m3);
            s1 = wave_sum(s1, lane); s2 = wave_sum(s2, lane);
            const float r1 = rsqrtf(s1 * (1.f / 256.f) + 1e-6f), r2 = rsqrtf(s2 * (1.f / 512.f) + 1e-6f);
            GAS bf16* yr = P.Y + t * 1024;
            { v2u w; w.x = pk2(m0 * r1 * gmv.x, m1 * r1 * gmv.y); w.y = pk2(m2 * r1 * gmv.z, m3 * r1 * gmv.w); *(GAS v2u*)(yr + 4 * lane) = w; }
            { v4u w; w.x = pk2(o[0] * r2 * g0.x, o[1] * r2 * g0.y); w.y = pk2(o[2] * r2 * g0.z, o[3] * r2 * g0.w); w.z = pk2(o[4] * r2 * g1.x, o[5] * r2 * g1.y); w.w = pk2(o[6] * r2 * g1.z, o[7] * r2 * g1.w);
              *(GAS v4u*)(yr + 256 + 8 * lane) = w; }
        }
    }
}

#define TILE_BAR() asm volatile("s_waitcnt lgkmcnt(0)\n\ts_barrier" ::: "memory")
typedef short bf16x8 __attribute__((ext_vector_type(8)));
typedef short s16x4 __attribute__((ext_vector_type(4)));
typedef float f32x16 __attribute__((ext_vector_type(16)));
typedef unsigned u32x4 __attribute__((ext_vector_type(4)));
__device__ __forceinline__ int crow(int r, int hi) { return (r & 3) + 8 * (r >> 2) + 4 * hi; }
typedef float f32x2_t __attribute__((ext_vector_type(2))); typedef __bf16 bf16x2_c __attribute__((ext_vector_type(2)));
__device__ __forceinline__ unsigned cvtpk(float lo, float hi) { f32x2_t v = {lo, hi}; bf16x2_c b = __builtin_convertvector(v, bf16x2_c); return __builtin_bit_cast(unsigned, b); }
__device__ __forceinline__ float swapmax(float m) { auto rr = __builtin_amdgcn_permlane32_swap(__float_as_uint(m), __float_as_uint(m), false, false); return fmaxf(__uint_as_float(rr[0]), __uint_as_float(rr[1])); }
__device__ __forceinline__ float swapadd(float m) { auto rr = __builtin_amdgcn_permlane32_swap(__float_as_uint(m), __float_as_uint(m), false, false); return __uint_as_float(rr[0]) + __uint_as_float(rr[1]); }
__device__ __forceinline__ s16x4 vtr(const LAS unsigned char* p) { return __builtin_bit_cast(s16x4, __builtin_amdgcn_ds_read_tr16_b64_v4i16((LAS s16x4*)p)); }
__device__ __forceinline__ bf16x8 pack8(const f32x16& p, int b) { u32x4 w; w.x = cvtpk(p[b], p[b + 1]); w.y = cvtpk(p[b + 2], p[b + 3]); w.z = cvtpk(p[b + 4], p[b + 5]); w.w = cvtpk(p[b + 6], p[b + 7]); return __builtin_bit_cast(bf16x8, w); }
__device__ __forceinline__ float vmax3(float a, float b, float c) { float r; asm("v_max3_f32 %0, %1, %2, %3" : "=v"(r) : "v"(a), "v"(b), "v"(c)); return r; }
__device__ __forceinline__ float max32(const f32x16& p, const f32x16& q) {
    float a = vmax3(p[0], p[1], p[2]), b = vmax3(p[3], p[4], p[5]), c = vmax3(p[6], p[7], p[8]), d = vmax3(p[9], p[10], p[11]), e = vmax3(p[12], p[13], p[14]);
    float f = vmax3(q[0], q[1], q[2]), g = vmax3(q[3], q[4], q[5]), h = vmax3(q[6], q[7], q[8]), i = vmax3(q[9], q[10], q[11]), j = vmax3(q[12], q[13], q[14]);
    a = vmax3(a, b, c); d = vmax3(d, e, p[15]); f = vmax3(f, g, h); i = vmax3(i, j, q[15]);
    return vmax3(vmax3(a, d, f), i, i);
}
__device__ __forceinline__ float max16(const f32x16& p) { float a = fmaxf(fmaxf(p[0], p[1]), fmaxf(p[2], p[3])), b = fmaxf(fmaxf(p[4], p[5]), fmaxf(p[6], p[7])), c = fmaxf(fmaxf(p[8], p[9]), fmaxf(p[10], p[11])), d = fmaxf(fmaxf(p[12], p[13]), fmaxf(p[14], p[15])); return fmaxf(fmaxf(a, b), fmaxf(c, d)); }

struct AttnP {
    const GAS bf16* Q; const GAS bf16* K; const GAS bf16* V; int qp, kp, vp;
    GAS bf16* O; int op;
    const GAS float* rope;
    const GAS int* pos; const GAS float* btab; const GAS float* dnorm; const GAS float* lams;
};
template <int KIND> struct AK {
    static constexpr bool DIFF = KIND == 1, CROSS = KIND == 2;
    static constexpr int HW = KIND == 0 ? 96 : KIND == 1 ? 64 : 256;
    static constexpr int NKS = KIND == 0 ? 6 : KIND == 1 ? 2 : 16;
    static constexpr int KP = KIND == 0 ? 208 : KIND == 1 ? 144 : 528;
    static constexpr int ND = CROSS ? 4 : 2;
    static constexpr int CPK = HW / 8, KCH = (64 * CPK + 511) / 512;
    static constexpr int VCH = ND / 2;
    static constexpr int KB = 64 * KP, VB = ND * 4096;
    static constexpr int NBUF = CROSS ? 2 : 3;
    static constexpr int K0 = 0, V0 = NBUF * KB, POS = V0 + NBUF * VB, BT = POS + 1024, DN = BT + 528, END = DN + 256;
};
static_assert(AK<2>::END <= RING_BYTES && AK<0>::END <= RING_BYTES && AK<1>::END + 16 + 8 * 8192 <= RING_BYTES, "attention LDS");

template <int KIND, bool LEAD>
__device__ __forceinline__ void attn_unit(const AttnP& P, int b, int h, int qb, int dhalf, LAS unsigned char* lds, int tid, int wave, int lane) {
    lane = lane_id_v(); tid = (wave << 6) | lane;
    typedef AK<KIND> C;
    constexpr bool DIFF = C::DIFF, CROSS = C::CROSS;
    constexpr int HW = C::HW, NKS = C::NKS, KP = C::KP, ND = C::ND, CPK = C::CPK, KCH = C::KCH, VCH = C::VCH;
    const int r32 = lane & 31, hi = lane >> 5;
    const size_t rowb = (size_t)b * S, rowk = CROSS ? (size_t)b * MEM : rowb;
    const int q0w = qb * 256 + wave * 32, qi = q0w + r32;
    int pq = 0; float bias_far = 0.f;
    __syncthreads();
    if (DIFF) {
        pq = P.pos[rowb + qi];
        if (tid < 129) ((LAS float*)(lds + C::BT))[tid] = P.btab[h * 129 + tid];
        if (tid >= 192 && tid < 256) ((LAS float*)(lds + C::DN))[tid - 192] = P.dnorm[tid - 192];
    }
    int minq = pq;
    if (DIFF) { for (int o = 1; o < 64; o <<= 1) { const int v = shxi(minq, o, lane); minq = v < minq ? v : minq; } }
    const int NT = CROSS ? MEM / 64 : 4 * (qb + 1);
    u32x4 kr[KCH], vr[VCH]; int pkr = 0;
    u32x4 kr2[CROSS ? 1 : KCH], vr2[CROSS ? 1 : VCH]; int pkr2 = 0;
    const GAS bf16* Kb = P.K + rowk * P.kp + h * HW; const GAS bf16* Vb = P.V + rowk * P.vp + (CROSS ? h * 256 + dhalf * 128 : h * 64);
    const __amdgpu_buffer_rsrc_t rK = __builtin_amdgcn_make_buffer_rsrc((void*)Kb, 0, 0x7fffffff, 0x00020000), rV = __builtin_amdgcn_make_buffer_rsrc((void*)Vb, 0, 0x7fffffff, 0x00020000);
    const __amdgpu_buffer_rsrc_t rP = __builtin_amdgcn_make_buffer_rsrc((void*)(DIFF ? P.pos + rowb : (const GAS int*)Kb), 0, 0x7fffffff, 0x00020000);
    int kvo[KCH], vvo[VCH];
#pragma unroll
    for (int i = 0; i < KCH; ++i) { int c = tid + 512 * i; c = c < 64 * CPK ? c : tid; kvo[i] = ((c / CPK) * P.kp + (c % CPK) * 8) * 2; }
#pragma unroll
    for (int i = 0; i < VCH; ++i) { const int c = tid + 512 * i; vvo[i] = ((c / (4 * ND)) * P.vp + (c % (4 * ND)) * 8) * 2; }
    const int pvo = (tid & 63) * 4;
    auto gload = [&](int t) {
        const int ks = __builtin_amdgcn_readfirstlane(64 * t * P.kp * 2), vs = __builtin_amdgcn_readfirstlane(64 * t * P.vp * 2);
#pragma unroll
        for (int i = 0; i < KCH; ++i) kr[i] = __builtin_amdgcn_raw_buffer_load_b128(rK, kvo[i], ks, 0);
#pragma unroll
        for (int i = 0; i < VCH; ++i) vr[i] = __builtin_amdgcn_raw_buffer_load_b128(rV, vvo[i], vs, 0);
        if (DIFF) pkr = __builtin_amdgcn_raw_buffer_load_b32(rP, pvo, __builtin_amdgcn_readfirstlane(64 * t * 4), 0);
    };
    auto lstore = [&](int buf) {
        LAS unsigned char* kb_ = lds + C::K0 + buf * C::KB; LAS unsigned char* vb_ = lds + C::V0 + buf * C::VB;
#pragma unroll
        for (int i = 0; i < KCH; ++i) { int c = tid + 512 * i; c = c < 64 * CPK ? c : tid; const int key = c / CPK, part = c % CPK; *(LAS u32x4*)(kb_ + key * KP + part * 16) = kr[i]; }
#pragma unroll
        for (int i = 0; i < VCH; ++i) { const int c = tid + 512 * i; const int key = c / (4 * ND), part = c % (4 * ND); *(LAS u32x4*)(vb_ + (part >> 2) * 4096 + (key >> 3) * 512 + (key & 7) * 64 + (part & 3) * 16) = vr[i]; }
        if (DIFF) { ((LAS int*)(lds + C::POS + buf * 256))[tid & 63] = pkr; if (tid < 64) { int mk_ = pkr; for (int o = 1; o < 64; o <<= 1) { const int v = shxi(mk_, o, lane); mk_ = v > mk_ ? v : mk_; } if (tid == 0) ((LAS int*)(lds + C::POS + 768))[buf] = mk_; } }
    };
    auto gloadB = [&](int t) {
        const int ks = __builtin_amdgcn_readfirstlane(64 * t * P.kp * 2), vs = __builtin_amdgcn_readfirstlane(64 * t * P.vp * 2);
#pragma unroll
        for (int i = 0; i < (CROSS ? 1 : KCH); ++i) kr2[i] = __builtin_amdgcn_raw_buffer_load_b128(rK, kvo[i], ks, 0);
#pragma unroll
        for (int i = 0; i < (CROSS ? 1 : VCH); ++i) vr2[i] = __builtin_amdgcn_raw_buffer_load_b128(rV, vvo[i], vs, 0);
        if (DIFF) pkr2 = __builtin_amdgcn_raw_buffer_load_b32(rP, pvo, __builtin_amdgcn_readfirstlane(64 * t * 4), 0);
    };
    auto lstoreB = [&](int buf) {
        LAS unsigned char* kb_ = lds + C::K0 + buf * C::KB; LAS unsigned char* vb_ = lds + C::V0 + buf * C::VB;
#pragma unroll
        for (int i = 0; i < (CROSS ? 1 : KCH); ++i) { int c = tid + 512 * i; c = c < 64 * CPK ? c : tid; const int key = c / CPK, part = c % CPK; *(LAS u32x4*)(kb_ + key * KP + part * 16) = kr2[i]; }
#pragma unroll
        for (int i = 0; i < (CROSS ? 1 : VCH); ++i) { const int c = tid + 512 * i; const int key = c / (4 * ND), part = c % (4 * ND); *(LAS u32x4*)(vb_ + (part >> 2) * 4096 + (key >> 3) * 512 + (key & 7) * 64 + (part & 3) * 16) = vr2[i]; }
        if (DIFF) { ((LAS int*)(lds + C::POS + buf * 256))[tid & 63] = pkr2; if (tid < 64) { int mk_ = pkr2; for (int o = 1; o < 64; o <<= 1) { const int v = shxi(mk_, o, lane); mk_ = v > mk_ ? v : mk_; } if (tid == 0) ((LAS int*)(lds + C::POS + 768))[buf] = mk_; } }
    };
    LAS float* osv = (LAS float*)(lds + ((C::END + 15) & ~15)) + wave * 2048 + lane;
    float il = 0.f;
    f32x16 oA[ND];
#pragma unroll 1
    for (int mp = 0; mp < (DIFF ? 2 : 1); ++mp) {
        bf16x8 qf[NKS];
        { const GAS bf16* qrow = P.Q + (rowb + qi) * P.qp + h * HW + mp * 32;
#pragma unroll
          for (int s = 0; s < NKS; ++s) qf[s] = *(const GAS bf16x8*)(qrow + 16 * s + 8 * hi);
          if (KIND == 0) {
              const GAS float* rp = P.rope + (rowb + qi) * 32 + 8 * hi;
              const f32x4 c0 = *(const GAS f32x4*)rp, c1 = *(const GAS f32x4*)(rp + 4), s0 = *(const GAS f32x4*)(rp + 16), s1 = *(const GAS f32x4*)(rp + 20);
              const u32x4 a = __builtin_bit_cast(u32x4, qf[NKS - 2]), bq = __builtin_bit_cast(u32x4, qf[NKS - 1]); u32x4 ra, rb;
#pragma unroll
              for (int w = 0; w < 4; ++w) { const float cl = w < 2 ? c0[2 * w] : c1[2 * w - 4], ch = w < 2 ? c0[2 * w + 1] : c1[2 * w - 3], sl = w < 2 ? s0[2 * w] : s1[2 * w - 4], sh = w < 2 ? s0[2 * w + 1] : s1[2 * w - 3];
                  const float x1l = bflo(a[w]), x1h = bfhi(a[w]), x2l = bflo(bq[w]), x2h = bfhi(bq[w]);
                  ra[w] = cvtpk(x1l * cl - x2l * sl, x1h * ch - x2h * sh); rb[w] = cvtpk(x1l * sl + x2l * cl, x1h * sh + x2h * ch); }
              qf[NKS - 2] = __builtin_bit_cast(bf16x8, ra); qf[NKS - 1] = __builtin_bit_cast(bf16x8, rb);
          } }
        __syncthreads();
        float m1 = -1e30f, l1 = 0.f;
#pragma unroll
        for (int d = 0; d < ND; ++d)
#pragma unroll
            for (int r = 0; r < 16; ++r) oA[d][r] = 0.f;
        auto qk = [&](int sl, f32x16& sa, f32x16& sb, float init) {
            const LAS unsigned char* kb_ = lds + C::K0 + sl * C::KB + r32 * KP + hi * 16 + mp * 64;
#pragma unroll
            for (int r = 0; r < 16; ++r) { sa[r] = init; sb[r] = init; }
            constexpr int HB = CROSS ? 4 : (NKS > 3 ? 3 : NKS);
#pragma unroll
            for (int s0_ = 0; s0_ < NKS; s0_ += HB) {
                bf16x8 kfa[HB], kfb[HB];
#pragma unroll
                for (int s = 0; s < HB; ++s) { kfa[s] = *(const LAS bf16x8*)(kb_ + (s0_ + s) * 32); kfb[s] = *(const LAS bf16x8*)(kb_ + 32 * KP + (s0_ + s) * 32); }
                __builtin_amdgcn_sched_barrier(0);
#pragma unroll
                for (int s = 0; s < HB; ++s) { sa = __builtin_amdgcn_mfma_f32_32x32x16_bf16(kfa[s], qf[s0_ + s], sa, 0, 0, 0); sb = __builtin_amdgcn_mfma_f32_32x32x16_bf16(kfb[s], qf[s0_ + s], sb, 0, 0, 0); }
                __builtin_amdgcn_sched_barrier(0);
            }
        };
        auto isnear = [&](int sl) { bool nb = false;
            if (DIFF) { const int mk_ = __builtin_amdgcn_readfirstlane(((LAS int*)(lds + C::POS + 768))[sl]); nb = (minq - mk_) < 128; }
            return nb; };
        auto sm = [&](int t, int sl, f32x16& pa, f32x16& pb, bool nearb) -> float {
            const int k0 = 64 * t;
            if (DIFF) { if (nearb) {
                const LAS int* pk = (const LAS int*)(lds + C::POS + sl * 256); const LAS float* bt = (const LAS float*)(lds + C::BT);
#pragma unroll
                for (int r = 0; r < 16; ++r) { const int kk = crow(r, hi);
                    int n0 = pq - pk[kk], n1 = pq - pk[kk + 32]; n0 = n0 < 0 ? 0 : (n0 > 128 ? 128 : n0); n1 = n1 < 0 ? 0 : (n1 > 128 ? 128 : n1);
                    pa[r] += bt[n0]; pb[r] += bt[n1]; }
            } }
            if (!CROSS && k0 + 63 > q0w) {
#pragma unroll
                for (int r = 0; r < 16; ++r) { const int kk = k0 + crow(r, hi); if (kk > qi) pa[r] = -1e30f; if (kk + 32 > qi) pb[r] = -1e30f; }
            }
            asm volatile("s_nop 15\n\ts_nop 7" : "+v"(pa), "+v"(pb));
            float mn, al = 1.f;
            if (CROSS) { const float mx = swapmax(max32(pa, pb)); mn = fmaxf(m1, mx); al = __builtin_amdgcn_exp2f(m1 - mn); l1 *= al; }
            else { const float mx = swapmax(max32(pa, pb)); const bool up = mx > m1 + 8.0f; mn = up ? mx : m1;
                   if (__builtin_amdgcn_ballot_w64(up) != 0ull) { al = __builtin_amdgcn_exp2f(m1 - mn); l1 *= al; } }
            m1 = mn;
            float ls = 0.f;
#pragma unroll
            for (int r = 0; r < 16; ++r) { pa[r] = __builtin_amdgcn_exp2f(pa[r] - mn); pb[r] = __builtin_amdgcn_exp2f(pb[r] - mn); ls += pa[r] + pb[r]; }
            l1 += ls;
            return al;
        };
        auto pv = [&](int sl, const f32x16& pa, const f32x16& pb, float al) {
            const LAS unsigned char* vb_ = lds + C::V0 + sl * C::VB + ((lane >> 4) & 1) * 32 + (lane & 3) * 8 + (4 * hi + ((lane & 15) >> 2)) * 64;
            bf16x8 pf[4];
            pf[0] = pack8(pa, 0); pf[1] = pack8(pa, 8); pf[2] = pack8(pb, 0); pf[3] = pack8(pb, 8);
            const bool resc = CROSS ? true : (__builtin_amdgcn_ballot_w64(al != 1.0f) != 0ull);
            if (CROSS) {
#pragma unroll
                for (int d = 0; d < ND; ++d) {
                    __builtin_amdgcn_sched_barrier(0);
#pragma unroll
                    for (int r = 0; r < 16; ++r) oA[d][r] *= al;
                    bf16x8 vf[4];
#pragma unroll
                    for (int s = 0; s < 4; ++s) { const s16x4 lo = vtr(vb_ + d * 4096 + s * 1024), hh = vtr(vb_ + d * 4096 + s * 1024 + 512); vf[s] = (bf16x8){lo[0], lo[1], lo[2], lo[3], hh[0], hh[1], hh[2], hh[3]}; }
#pragma unroll
                    for (int s = 0; s < 4; ++s) oA[d] = __builtin_amdgcn_mfma_f32_32x32x16_bf16(vf[s], pf[s], oA[d], 0, 0, 0);
                }
            } else if (DIFF) {
                if (resc) {
#pragma unroll
                    for (int d = 0; d < 2; ++d)
#pragma unroll
                        for (int r = 0; r < 16; ++r) oA[d][r] *= al;
                }
#pragma unroll
                for (int d = 0; d < 2; ++d) {
                    bf16x8 vf[4];
#pragma unroll
                    for (int s = 0; s < 4; ++s) { const s16x4 lo = vtr(vb_ + d * 4096 + s * 1024), hh = vtr(vb_ + d * 4096 + s * 1024 + 512); vf[s] = (bf16x8){lo[0], lo[1], lo[2], lo[3], hh[0], hh[1], hh[2], hh[3]}; }
                    __builtin_amdgcn_sched_barrier(0);
#pragma unroll
                    for (int s = 0; s < 4; ++s) oA[d] = __builtin_amdgcn_mfma_f32_32x32x16_bf16(vf[s], pf[s], oA[d], 0, 0, 0);
                }
            } else {
                bf16x8 vf[2][4];
#pragma unroll
                for (int d = 0; d < 2; ++d)
#pragma unroll
                    for (int s = 0; s < 4; ++s) { const s16x4 lo = vtr(vb_ + d * 4096 + s * 1024), hh = vtr(vb_ + d * 4096 + s * 1024 + 512); vf[d][s] = (bf16x8){lo[0], lo[1], lo[2], lo[3], hh[0], hh[1], hh[2], hh[3]}; }
                if (resc) {
#pragma unroll
                    for (int d = 0; d < 2; ++d)
#pragma unroll
                        for (int r = 0; r < 16; ++r) oA[d][r] *= al;
                }
                __builtin_amdgcn_sched_barrier(0);
#pragma unroll
                for (int s = 0; s < 4; ++s)
#pragma unroll
                    for (int d = 0; d < 2; ++d) oA[d] = __builtin_amdgcn_mfma_f32_32x32x16_bf16(vf[d][s], pf[s], oA[d], 0, 0, 0);
            }
        };
        if (CROSS) {
            gload(0); lstore(0);
            __syncthreads();
            for (int t = 0; t < NT; ++t) {
                const int buf = t & 1;
                f32x16 pa, pb;
                qk(buf, pa, pb, 0.f);
                const float al = sm(t, buf, pa, pb, false);
                pv(buf, pa, pb, al);
                if (t + 1 < NT) { gload(t + 1); lstore(buf ^ 1); }
                TILE_BAR();
            }
        } else {
            gload(0); lstore(0); gload(1); lstore(1);
            gload(2); gloadB(3);
            __syncthreads();
            if (DIFF) bias_far = ((LAS float*)(lds + C::BT))[128];
            const int NTW = (q0w + 31) / 64 + 1;
            constexpr bool lead = LEAD;
            f32x16 ca, cb, na, nb; bool cnear = isnear(0), nnear = false; float cal = 1.f;
            qk(0, ca, cb, (DIFF && !cnear) ? bias_far : 0.f);
            if (lead) cal = sm(0, 0, ca, cb, cnear);
            int s0 = 0, s1 = 1, s2 = 2;
            auto period = [&](int t, f32x16& xa, f32x16& xb, bool& xnear, f32x16& ya, f32x16& yb, bool& ynear) {
                const bool have_next = (t + 1 < NTW);
                if (lead) {
                    if (have_next) { ynear = isnear(s1); qk(s1, ya, yb, (DIFF && !ynear) ? bias_far : 0.f); }
                    if (t < NTW) pv(s0, xa, xb, cal);
                    if (have_next) cal = sm(t + 1, s1, ya, yb, ynear);
                } else {
                    if (t < NTW) cal = sm(t, s0, xa, xb, xnear);
                    if (have_next) { ynear = isnear(s1); qk(s1, ya, yb, (DIFF && !ynear) ? bias_far : 0.f); }
                    if (t < NTW) pv(s0, xa, xb, cal);
                }
                { const int tmp = s0; s0 = s1; s1 = s2; s2 = tmp; }
            };
            int t = 0;
            for (; t + 5 < NT; t += 2) {
                lstore(s2); gload(t + 4);
                period(t, ca, cb, cnear, na, nb, nnear);
                TILE_BAR();
                lstoreB(s2); gloadB(t + 5);
                period(t + 1, na, nb, nnear, ca, cb, cnear);
                TILE_BAR();
            }
            for (; t < NT; t += 2) {
                if (t + 2 < NT) { lstore(s2); if (t + 4 < NT) gload(t + 4); }
                period(t, ca, cb, cnear, na, nb, nnear);
                TILE_BAR();
                if (t + 3 < NT) { lstoreB(s2); if (t + 5 < NT) gloadB(t + 5); }
                period(t + 1, na, nb, nnear, ca, cb, cnear);
                TILE_BAR();
            }
        }
        il = 1.f / swapadd(l1);
        if (DIFF) { if (mp == 0) {
#pragma unroll
            for (int d = 0; d < 2; ++d)
#pragma unroll
                for (int r = 0; r < 16; ++r) osv[(d * 16 + r) * 64] = oA[d][r] * il; } }
    }
    GAS bf16* orow = P.O + (rowb + qi) * P.op + (CROSS ? h * 256 + dhalf * 128 : h * 64);
    if (!DIFF) {
#pragma unroll
        for (int d = 0; d < ND; ++d)
#pragma unroll
            for (int g = 0; g < 4; ++g) { v2u v; v.x = cvtpk(oA[d][4 * g] * il, oA[d][4 * g + 1] * il); v.y = cvtpk(oA[d][4 * g + 2] * il, oA[d][4 * g + 3] * il); *(GAS v2u*)(orow + 32 * d + 8 * g + 4 * hi) = v; }
    } else {
        const float lam = P.lams[0], lam_init = P.lams[1];
        const float i2 = lam * il;
        float ss = 0.f;
#pragma unroll
        for (int d = 0; d < 2; ++d)
#pragma unroll
            for (int r = 0; r < 16; ++r) { const float v = osv[(d * 16 + r) * 64] - oA[d][r] * i2; oA[d][r] = v; ss += v * v; }
        ss = swapadd(ss);
        const float rs = __builtin_amdgcn_rsqf(ss * (1.f / 64.f) + 1e-6f) * (1.f - lam_init);
        const LAS float* dn = (const LAS float*)(lds + C::DN);
#pragma unroll
        for (int d = 0; d < 2; ++d)
#pragma unroll
            for (int g = 0; g < 4; ++g) { const int c = 32 * d + 8 * g + 4 * hi; const f32x4 gn = *(const LAS f32x4*)(dn + c);
                v2u v; v.x = cvtpk(oA[d][4 * g] * rs * gn[0], oA[d][4 * g + 1] * rs * gn[1]); v.y = cvtpk(oA[d][4 * g + 2] * rs * gn[2], oA[d][4 * g + 3] * rs * gn[3]); *(GAS v2u*)(orow + c) = v; }
    }
}

__device__ __forceinline__ int wave_max_i(int v) {
    { const int o = __builtin_amdgcn_update_dpp(0, v, 0xB1, 0xF, 0xF, true); v = o > v ? o : v; }
    { const int o = __builtin_amdgcn_update_dpp(0, v, 0x4E, 0xF, 0xF, true); v = o > v ? o : v; }
    { const int o = __builtin_amdgcn_update_dpp(0, v, 0x141, 0xF, 0xF, true); v = o > v ? o : v; }
    { const int o = __builtin_amdgcn_update_dpp(0, v, 0x140, 0xF, 0xF, true); v = o > v ? o : v; }
    { int a = v, b = v; asm volatile("v_nop\n\tv_nop\n\tv_permlane16_swap_b32 %0, %1" : "+v"(a), "+v"(b)); v = a > b ? a : b; }
    { int a = v, b = v; asm volatile("v_nop\n\tv_nop\n\tv_permlane32_swap_b32 %0, %1" : "+v"(a), "+v"(b)); v = a > b ? a : b; }
    return v;
}
template <int KIND> struct AK2 {
    static constexpr bool DIFF = KIND == 1;
    static constexpr int HW = KIND == 0 ? 96 : 64, NKS = KIND == 0 ? 6 : 2, KP = KIND == 0 ? 208 : 144;
    static constexpr int CPK = HW / 8, KCH = (128 * CPK) / 512, VCH = 2;
    static constexpr int KB = 128 * KP, VB = 2 * 8192;
    static constexpr int K0 = 0, V0 = 2 * KB, POS = V0 + 2 * VB, PMX = POS + 1024, BT = PMX + 16, DN = BT + 528, OSV = (DN + 256 + 15) & ~15, END = OSV + (DIFF ? 8 * 8192 : 0);
};
static_assert(AK2<0>::END <= RING_BYTES && AK2<1>::END <= RING_BYTES, "attention LDS (128-key tiles)");
template <int KIND>
__device__ __forceinline__ void attn_unit2(const AttnP& P, int b, int h, int qb, LAS unsigned char* lds, int tid, int wave, int lane) {
    lane = lane_id_v(); tid = (wave << 6) | lane;
    typedef AK2<KIND> C;
    constexpr bool DIFF = C::DIFF;
    constexpr int HW = C::HW, NKS = C::NKS, KP = C::KP, CPK = C::CPK, KCH = C::KCH, VCH = C::VCH;
    const int r32 = lane & 31, hi = lane >> 5;
    const size_t rowb = (size_t)b * S;
    const int q0w = qb * 256 + wave * 32, qi = q0w + r32;
    int pq = 0; float bias_far = 0.f;
    __syncthreads();
    if (DIFF) {
        pq = P.pos[rowb + qi];
        if (tid < 129) ((LAS float*)(lds + C::BT))[tid] = P.btab[h * 129 + tid];
        if (tid >= 192 && tid < 256) ((LAS float*)(lds + C::DN))[tid - 192] = P.dnorm[tid - 192];
    }
    int minq = pq;
    if (DIFF) minq = __builtin_amdgcn_readfirstlane(-wave_max_i(-pq));
    const int NT = 2 * (qb + 1);
    const GAS bf16* Kb = P.K + rowb * P.kp + h * HW; const GAS bf16* Vb = P.V + rowb * P.vp + h * 64;
    const __amdgpu_buffer_rsrc_t rK = __builtin_amdgcn_make_buffer_rsrc((void*)Kb, 0, 0x7fffffff, 0x00020000), rV = __builtin_amdgcn_make_buffer_rsrc((void*)Vb, 0, 0x7fffffff, 0x00020000);
    const __amdgpu_buffer_rsrc_t rP = __builtin_amdgcn_make_buffer_rsrc((void*)(DIFF ? P.pos + rowb : (const GAS int*)Kb), 0, 0x7fffffff, 0x00020000);
    int kvo[KCH], vvo[VCH], klo[KCH], vlo[VCH];
#pragma unroll
    for (int i = 0; i < KCH; ++i) { const int c = tid + 512 * i; kvo[i] = ((c / CPK) * P.kp + (c % CPK) * 8) * 2; klo[i] = (c / CPK) * KP + (c % CPK) * 16; }
#pragma unroll
    for (int i = 0; i < VCH; ++i) { const int c = tid + 512 * i; const int key = c >> 3, part = c & 7; vvo[i] = (key * P.vp + part * 8) * 2; vlo[i] = (part >> 2) * 8192 + (key >> 3) * 512 + (key & 7) * 64 + (part & 3) * 16; }
    const int pvo = (tid & 127) * 4;
    u32x4 kr[KCH], vr[VCH]; int pkr = 0;
    auto gload = [&](int t) {
        const int ks = __builtin_amdgcn_readfirstlane(128 * t * P.kp * 2), vs = __builtin_amdgcn_readfirstlane(128 * t * P.vp * 2);
#pragma unroll
        for (int i = 0; i < KCH; ++i) kr[i] = __builtin_amdgcn_raw_buffer_load_b128(rK, kvo[i], ks, 0);
#pragma unroll
        for (int i = 0; i < VCH; ++i) vr[i] = __builtin_amdgcn_raw_buffer_load_b128(rV, vvo[i], vs, 0);
        if (DIFF) pkr = __builtin_amdgcn_raw_buffer_load_b32(rP, pvo, __builtin_amdgcn_readfirstlane(128 * t * 4), 0);
    };
    auto lstore = [&](int buf) {
        LAS unsigned char* kb_ = lds + C::K0 + buf * C::KB; LAS unsigned char* vb_ = lds + C::V0 + buf * C::VB;
#pragma unroll
        for (int i = 0; i < KCH; ++i) *(LAS u32x4*)(kb_ + klo[i]) = kr[i];
#pragma unroll
        for (int i = 0; i < VCH; ++i) *(LAS u32x4*)(vb_ + vlo[i]) = vr[i];
        if (DIFF) { ((LAS int*)(lds + C::POS + buf * 512))[tid & 127] = pkr;
            if (tid < 128) { const int mk_ = wave_max_i(pkr); if (lane == 0) ((LAS int*)(lds + C::PMX))[buf * 2 + wave] = mk_; } }
    };
    LAS float* osv = (LAS float*)(lds + C::OSV) + wave * 2048 + lane;
    float il = 0.f;
    f32x16 oA[2];
#pragma unroll 1
    for (int mp = 0; mp < (DIFF ? 2 : 1); ++mp) {
        bf16x8 qf[NKS];
        { const GAS bf16* qrow = P.Q + (rowb + qi) * P.qp + h * HW + mp * 32;
#pragma unroll
          for (int s = 0; s < NKS; ++s) qf[s] = *(const GAS bf16x8*)(qrow + 16 * s + 8 * hi);
          if (KIND == 0) {
              const GAS float* rp = P.rope + (rowb + qi) * 32 + 8 * hi;
              const f32x4 c0 = *(const GAS f32x4*)rp, c1 = *(const GAS f32x4*)(rp + 4), s0 = *(const GAS f32x4*)(rp + 16), s1 = *(const GAS f32x4*)(rp + 20);
              const u32x4 a = __builtin_bit_cast(u32x4, qf[NKS - 2]), bq = __builtin_bit_cast(u32x4, qf[NKS - 1]); u32x4 ra, rb;
#pragma unroll
              for (int w = 0; w < 4; ++w) { const float cl = w < 2 ? c0[2 * w] : c1[2 * w - 4], ch = w < 2 ? c0[2 * w + 1] : c1[2 * w - 3], sl = w < 2 ? s0[2 * w] : s1[2 * w - 4], sh = w < 2 ? s0[2 * w + 1] : s1[2 * w - 3];
                  const float x1l = bflo(a[w]), x1h = bfhi(a[w]), x2l = bflo(bq[w]), x2h = bfhi(bq[w]);
                  ra[w] = cvtpk(x1l * cl - x2l * sl, x1h * ch - x2h * sh); rb[w] = cvtpk(x1l * sl + x2l * cl, x1h * sh + x2h * ch); }
              qf[NKS - 2] = __builtin_bit_cast(bf16x8, ra); qf[NKS - 1] = __builtin_bit_cast(bf16x8, rb);
          } }
        __syncthreads();
        float m1 = 0.f, l1 = 0.f;
        f32x16 negm;
#pragma unroll
        for (int r = 0; r < 16; ++r) negm[r] = 0.f;
#pragma unroll
        for (int d = 0; d < 2; ++d)
#pragma unroll
            for (int r = 0; r < 16; ++r) oA[d][r] = 0.f;
        gload(0); lstore(0);
        if (NT > 1) gload(1);
        __syncthreads();
        if (DIFF) { bias_far = ((LAS float*)(lds + C::BT))[128];
#pragma unroll
            for (int r = 0; r < 16; ++r) negm[r] = bias_far; }
        const int NTW = (q0w + 31) / 128 + 1;
        auto compute = [&](int t, int buf) {
            const int k0 = 128 * t;
            const LAS unsigned char* kb_ = lds + C::K0 + buf * C::KB + r32 * KP + hi * 16 + mp * 64;
            const LAS unsigned char* vb_ = lds + C::V0 + buf * C::VB + ((lane >> 4) & 1) * 32 + (lane & 3) * 8 + (4 * hi + ((lane & 15) >> 2)) * 64;
            bool nearb = false;
            if (DIFF) { const LAS int* pm = (const LAS int*)(lds + C::PMX) + buf * 2; const int m0 = __builtin_amdgcn_readfirstlane(pm[0]), m1_ = __builtin_amdgcn_readfirstlane(pm[1]); nearb = (minq - (m0 > m1_ ? m0 : m1_)) < 128; }
            f32x16 sc[4];
            if (DIFF) { if (nearb) {
#pragma unroll
                for (int g = 0; g < 4; ++g)
#pragma unroll
                    for (int r = 0; r < 16; ++r) sc[g][r] = -m1; } }
            constexpr int HB = NKS > 3 ? 3 : NKS;
#pragma unroll
            for (int s0_ = 0; s0_ < NKS; s0_ += HB) {
                bf16x8 kf[4][HB];
#pragma unroll
                for (int g = 0; g < 4; ++g)
#pragma unroll
                    for (int s = 0; s < HB; ++s) kf[g][s] = *(const LAS bf16x8*)(kb_ + 32 * g * KP + (s0_ + s) * 32);
                __builtin_amdgcn_sched_barrier(0);
#pragma unroll
                for (int s = 0; s < HB; ++s)
#pragma unroll
                    for (int g = 0; g < 4; ++g) {
                        if (s0_ + s == 0 && !(DIFF && nearb)) sc[g] = __builtin_amdgcn_mfma_f32_32x32x16_bf16(kf[g][s], qf[s0_ + s], negm, 0, 0, 0);
                        else sc[g] = __builtin_amdgcn_mfma_f32_32x32x16_bf16(kf[g][s], qf[s0_ + s], sc[g], 0, 0, 0); }
                __builtin_amdgcn_sched_barrier(0);
            }
            if (DIFF) { if (nearb) {
                const LAS int* pk = (const LAS int*)(lds + C::POS + buf * 512); const LAS float* bt = (const LAS float*)(lds + C::BT);
#pragma unroll
                for (int g = 0; g < 4; ++g)
#pragma unroll
                    for (int r = 0; r < 16; ++r) { int n0 = pq - pk[32 * g + crow(r, hi)]; n0 = n0 < 0 ? 0 : (n0 > 128 ? 128 : n0); sc[g][r] += bt[n0]; }
            } }
            asm volatile("s_nop 15\n\ts_nop 7" : "+v"(sc[0]), "+v"(sc[1]), "+v"(sc[2]), "+v"(sc[3]));
            if (k0 + 127 > q0w) {
#pragma unroll
                for (int g = 0; g < 4; ++g)
#pragma unroll
                    for (int r = 0; r < 16; ++r) { if (k0 + 32 * g + crow(r, hi) > qi) sc[g][r] = -1e30f; }
            }
            const float mx = swapmax(vmax3(max32(sc[0], sc[1]), max32(sc[2], sc[3]), -1e30f));
            const bool up = (t == 0) || mx > 8.0f;
            float al = 1.f;
            if (__builtin_amdgcn_ballot_w64(up) != 0ull) {
                const float dl = up ? mx : 0.f; al = __builtin_amdgcn_exp2f(-dl); l1 *= al; m1 += dl;
#pragma unroll
                for (int r = 0; r < 16; ++r) negm[r] -= dl;
#pragma unroll
                for (int g = 0; g < 4; ++g)
#pragma unroll
                    for (int r = 0; r < 16; ++r) sc[g][r] -= dl;
            }
            float ls = 0.f;
#pragma unroll
            for (int g = 0; g < 4; ++g)
#pragma unroll
                for (int r = 0; r < 16; ++r) { sc[g][r] = __builtin_amdgcn_exp2f(sc[g][r]); ls += sc[g][r]; }
            l1 += ls;
            bf16x8 pf[8];
#pragma unroll
            for (int g = 0; g < 4; ++g) { pf[2 * g] = pack8(sc[g], 0); pf[2 * g + 1] = pack8(sc[g], 8); }
            if (__builtin_amdgcn_ballot_w64(al != 1.0f) != 0ull) {
#pragma unroll
                for (int d = 0; d < 2; ++d)
#pragma unroll
                    for (int r = 0; r < 16; ++r) oA[d][r] *= al;
            }
#pragma unroll
            for (int d = 0; d < 2; ++d) {
                bf16x8 vf[8];
#pragma unroll
                for (int s = 0; s < 8; ++s) { const s16x4 lo = vtr(vb_ + d * 8192 + s * 1024), hh = vtr(vb_ + d * 8192 + s * 1024 + 512); vf[s] = (bf16x8){lo[0], lo[1], lo[2], lo[3], hh[0], hh[1], hh[2], hh[3]}; }
                __builtin_amdgcn_sched_barrier(0);
#pragma unroll
                for (int s = 0; s < 8; ++s) oA[d] = __builtin_amdgcn_mfma_f32_32x32x16_bf16(vf[s], pf[s], oA[d], 0, 0, 0);
                __builtin_amdgcn_sched_barrier(0);
            }
        };
        int t = 0;
        for (; t + 2 < NT; ++t) {
            const int buf = t & 1;
            if (t < NTW) compute(t, buf);
            lstore(buf ^ 1); gload(t + 2);
            TILE_BAR();
        }
        for (; t < NT; ++t) {
            const int buf = t & 1;
            if (t < NTW) compute(t, buf);
            if (t + 1 < NT) lstore(buf ^ 1);
            TILE_BAR();
        }
        il = 1.f / swapadd(l1);
        if (DIFF) { if (mp == 0) {
#pragma unroll
            for (int d = 0; d < 2; ++d)
#pragma unroll
                for (int r = 0; r < 16; ++r) osv[(d * 16 + r) * 64] = oA[d][r] * il; } }
    }
    GAS bf16* orow = P.O + (rowb + qi) * P.op + h * 64;
    if (!DIFF) {
#pragma unroll
        for (int d = 0; d < 2; ++d)
#pragma unroll
            for (int g = 0; g < 4; ++g) { v2u v; v.x = cvtpk(oA[d][4 * g] * il, oA[d][4 * g + 1] * il); v.y = cvtpk(oA[d][4 * g + 2] * il, oA[d][4 * g + 3] * il); *(GAS v2u*)(orow + 32 * d + 8 * g + 4 * hi) = v; }
    } else {
        const float lam = P.lams[0], lam_init = P.lams[1];
        const float i2 = lam * il;
        float ss = 0.f;
#pragma unroll
        for (int d = 0; d < 2; ++d)
#pragma unroll
            for (int r = 0; r < 16; ++r) { const float v = osv[(d * 16 + r) * 64] - oA[d][r] * i2; oA[d][r] = v; ss += v * v; }
        ss = swapadd(ss);
        const float rs = __builtin_amdgcn_rsqf(ss * (1.f / 64.f) + 1e-6f) * (1.f - lam_init);
        const LAS float* dn = (const LAS float*)(lds + C::DN);
#pragma unroll
        for (int d = 0; d < 2; ++d)
#pragma unroll
            for (int g = 0; g < 4; ++g) { const int c = 32 * d + 8 * g + 4 * hi; const f32x4 gn = *(const LAS f32x4*)(dn + c);
                v2u v; v.x = cvtpk(oA[d][4 * g] * rs * gn[0], oA[d][4 * g + 1] * rs * gn[1]); v.y = cvtpk(oA[d][4 * g + 2] * rs * gn[2], oA[d][4 * g + 3] * rs * gn[3]); *(GAS v2u*)(orow + c) = v; }
    }
}

__device__ __forceinline__ void attn_phase(const AttnP& PM, const AttnP& PD, LAS unsigned char* lds, int tid, int wave, int lane, int vcu, int G, int only = -1) {
    for (int i = vcu; i < 512; i += G) {
        if (only >= 0 && (i >> 8) != only) continue;
        const int kind = i >> 8, c = i & 255, bh = c >> 4, s = c & 15;
        if (kind == 0) {
#pragma unroll 1
            for (int k = 0; k < 2; ++k) attn_unit2<0>(PM, bh >> 2, bh & 3, k ? 31 - s : s, lds, tid, wave, lane);
        } else {
#pragma unroll 1
            for (int k = 0; k < 2; ++k) attn_unit2<1>(PD, bh >> 2, bh & 3, k ? 31 - s : s, lds, tid, wave, lane);
        }
    }
}
__device__ __forceinline__ float cx_max16(const f32x16& p) { return fmaxf(fmaxf(fmaxf(fmaxf(p[0], p[1]), fmaxf(p[2], p[3])), fmaxf(fmaxf(p[4], p[5]), fmaxf(p[6], p[7]))), fmaxf(fmaxf(fmaxf(p[8], p[9]), fmaxf(p[10], p[11])), fmaxf(fmaxf(p[12], p[13]), fmaxf(p[14], p[15])))); }
__device__ __forceinline__ void cross_unit2(const AttnP& P, int b, int h, int qb, LAS unsigned char* lds, int wave) {
    const int lane = lane_id_v(), tid = (wave << 6) | lane;
    constexpr int KP = 528;
    const int r32 = lane & 31, hi = lane >> 5;
    const size_t rowb = (size_t)b * S, rowk = (size_t)b * MEM;
    const int qi = qb * 256 + wave * 32 + r32;
    const GAS bf16* Kb = P.K + rowk * P.kp + h * 256; const GAS bf16* Vb = P.V + rowk * P.vp + h * 256;
    const __amdgpu_buffer_rsrc_t rK = __builtin_amdgcn_make_buffer_rsrc((void*)Kb, 0, 0x7fffffff, 0x00020000), rV = __builtin_amdgcn_make_buffer_rsrc((void*)Vb, 0, 0x7fffffff, 0x00020000);
    const GAS bf16* qrow = P.Q + (rowb + qi) * P.qp + h * 256 + 8 * hi;
    bf16x8 qf[4];
#pragma unroll
    for (int s = 0; s < 4; ++s) qf[s] = *(const GAS bf16x8*)(qrow + 16 * s);
    { u32x4 st[16];
#pragma unroll
      for (int i = 0; i < 16; ++i) { const int c = tid + 512 * i; st[i] = __builtin_amdgcn_raw_buffer_load_b128(rK, ((c >> 5) * P.kp + (c & 31) * 8) * 2, 0, 0); }
      TILE_BAR();
#pragma unroll
      for (int i = 0; i < 16; ++i) { const int c = tid + 512 * i; *(LAS u32x4*)(lds + (c >> 5) * KP + (c & 31) * 16) = st[i]; } }
    __syncthreads();
    f32x16 sc[8];
#pragma unroll
    for (int g = 0; g < 8; ++g)
#pragma unroll
        for (int r = 0; r < 16; ++r) sc[g][r] = 0.f;
    const LAS unsigned char* kb_ = lds + r32 * KP + hi * 16;
#pragma unroll
    for (int c = 0; c < 4; ++c) {
        bf16x8 qn[4];
        if (c + 1 < 4) {
#pragma unroll
            for (int s = 0; s < 4; ++s) qn[s] = *(const GAS bf16x8*)(qrow + 64 * (c + 1) + 16 * s); }
#pragma unroll
        for (int g = 0; g < 8; ++g) { bf16x8 kf[4];
#pragma unroll
            for (int s = 0; s < 4; ++s) kf[s] = *(const LAS bf16x8*)(kb_ + 32 * g * KP + (4 * c + s) * 32);
#pragma unroll
            for (int s = 0; s < 4; ++s) sc[g] = __builtin_amdgcn_mfma_f32_32x32x16_bf16(kf[s], qf[s], sc[g], 0, 0, 0); }
        if (c + 1 < 4) {
#pragma unroll
            for (int s = 0; s < 4; ++s) qf[s] = qn[s]; }
    }
    float m = fmaxf(fmaxf(fmaxf(cx_max16(sc[0]), cx_max16(sc[1])), fmaxf(cx_max16(sc[2]), cx_max16(sc[3]))), fmaxf(fmaxf(cx_max16(sc[4]), cx_max16(sc[5])), fmaxf(cx_max16(sc[6]), cx_max16(sc[7]))));
    m = swapmax(m);
    float l = 0.f;
    bf16x8 pf[16];
#pragma unroll
    for (int g = 0; g < 8; ++g) {
#pragma unroll
        for (int r = 0; r < 16; ++r) { sc[g][r] = __builtin_amdgcn_exp2f(sc[g][r] - m); l += sc[g][r]; }
        pf[2 * g] = pack8(sc[g], 0); pf[2 * g + 1] = pack8(sc[g], 8); }
    const float il = 1.f / swapadd(l);
    { u32x4 st[16];
#pragma unroll
      for (int i = 0; i < 16; ++i) { const int c = tid + 512 * i; const int sub = c & 3, key = (c >> 2) & 255, dt = c >> 10; st[i] = __builtin_amdgcn_raw_buffer_load_b128(rV, (key * P.vp + dt * 32 + sub * 8) * 2, 0, 0); }
      TILE_BAR();
#pragma unroll
      for (int i = 0; i < 16; ++i) { const int c = tid + 512 * i; const int sub = c & 3, key = (c >> 2) & 255, dt = c >> 10; *(LAS u32x4*)(lds + dt * 16384 + (key >> 3) * 512 + (key & 7) * 64 + sub * 16) = st[i]; } }
    __syncthreads();
    const LAS unsigned char* vb_ = lds + ((lane >> 4) & 1) * 32 + (lane & 3) * 8 + (4 * hi + ((lane & 15) >> 2)) * 64;
    GAS bf16* orow = P.O + (rowb + qi) * P.op + h * 256;
#pragma unroll 1
    for (int dh = 0; dh < 2; ++dh) {
        f32x16 oA[4];
#pragma unroll
        for (int d = 0; d < 4; ++d)
#pragma unroll
            for (int r = 0; r < 16; ++r) oA[d][r] = 0.f;
#pragma unroll
        for (int d = 0; d < 4; ++d) {
#pragma unroll
            for (int sb = 0; sb < 2; ++sb) { bf16x8 vf[8];
#pragma unroll
                for (int s = 0; s < 8; ++s) { const s16x4 lo = vtr(vb_ + (4 * dh + d) * 16384 + (8 * sb + s) * 1024), hh = vtr(vb_ + (4 * dh + d) * 16384 + (8 * sb + s) * 1024 + 512); vf[s] = (bf16x8){lo[0], lo[1], lo[2], lo[3], hh[0], hh[1], hh[2], hh[3]}; }
#pragma unroll
                for (int s = 0; s < 8; ++s) oA[d] = __builtin_amdgcn_mfma_f32_32x32x16_bf16(vf[s], pf[8 * sb + s], oA[d], 0, 0, 0); } }
#pragma unroll
        for (int d = 0; d < 4; ++d)
#pragma unroll
            for (int g = 0; g < 4; ++g) { v2u v; v.x = cvtpk(oA[d][4 * g] * il, oA[d][4 * g + 1] * il); v.y = cvtpk(oA[d][4 * g + 2] * il, oA[d][4 * g + 3] * il); *(GAS v2u*)(orow + 128 * dh + 32 * d + 8 * g + 4 * hi) = v; }
    }
}
__device__ __forceinline__ void cross_phase(const AttnP& PC, LAS unsigned char* lds, int tid, int wave, int lane, int vcu, int G) {
#pragma unroll 1
    for (int i = vcu; i < 512; i += G) { const int bh = i >> 5; cross_unit2(PC, bh >> 2, bh & 3, i & 31, lds, wave); }
}


__device__ __forceinline__ float vmax2(float a, float b) { float r; asm("v_max_f32_e32 %0, %1, %2" : "=v"(r) : "v"(a), "v"(b)); return r; }
__device__ __forceinline__ float vmin2(float a, float b) { float r; asm("v_min_f32_e32 %0, %1, %2" : "=v"(r) : "v"(a), "v"(b)); return r; }
__device__ __forceinline__ void pad16(float (&a)[16]) {
    asm volatile("s_nop 1" : "+v"(a[0]), "+v"(a[1]), "+v"(a[2]), "+v"(a[3]), "+v"(a[4]), "+v"(a[5]), "+v"(a[6]), "+v"(a[7]), "+v"(a[8]), "+v"(a[9]), "+v"(a[10]), "+v"(a[11]), "+v"(a[12]), "+v"(a[13]), "+v"(a[14]), "+v"(a[15]));
}
__device__ __forceinline__ void sort16_desc(float (&a)[16]) {
#pragma unroll
    for (int k = 2; k <= 16; k <<= 1)
#pragma unroll
        for (int j = k >> 1; j > 0; j >>= 1)
#pragma unroll
            for (int i = 0; i < 16; ++i) { const int l = i ^ j; if (l > i) { const bool desc = ((i & k) == 0); const float hi_ = vmax2(a[i], a[l]), lo_ = vmin2(a[i], a[l]); a[i] = desc ? hi_ : lo_; a[l] = desc ? lo_ : hi_; } }
}
__device__ __forceinline__ void merge16_desc(float (&a)[16], const float (&b)[16]) {
#pragma unroll
    for (int i = 0; i < 16; ++i) a[i] = vmax2(a[i], b[15 - i]);
#pragma unroll
    for (int j = 8; j > 0; j >>= 1)
#pragma unroll
        for (int i = 0; i < 16; ++i) { const int l = i ^ j; if (l > i) { const float hi_ = vmax2(a[i], a[l]), lo_ = vmin2(a[i], a[l]); a[i] = hi_; a[l] = lo_; } }
}
__device__ __forceinline__ void top16_of_64(float (&g0)[16], float (&g1)[16], float (&g2)[16], float (&g3)[16]) {
    sort16_desc(g0); sort16_desc(g1); merge16_desc(g0, g1); sort16_desc(g2); sort16_desc(g3); merge16_desc(g2, g3); merge16_desc(g0, g2);
}
__device__ __forceinline__ float embed(float v, unsigned mask, unsigned id) { return __builtin_bit_cast(float, (__builtin_bit_cast(unsigned, v) & mask) | id); }
__device__ __forceinline__ float mkcand(float x, float y, unsigned id) { return embed(x + y, 0xFFFFFF00u, id); }

__device__ __forceinline__ void swap32(float& a, float& b) { asm volatile("v_nop\n\tv_nop\n\tv_permlane32_swap_b32 %0, %1" : "+v"(a), "+v"(b)); }
struct RouteP { const GAS bf16* QP; const GAS bf16* keys; GAS int* EX; GAS float* GW; };
constexpr int RT_KP = 144, RT_KEYS = 0, RT_SCR = 256 * RT_KP, RT_END = RT_SCR + 8 * 8192;
__device__ __forceinline__ void route_phase(const RouteP& P, LAS unsigned char* lds, int tid, int wave, int lane, int vcu, int G) {
    asm volatile("" : "+v"(tid), "+v"(lane));
    __syncthreads();
    for (int c = tid; c < 256 * 8; c += 512) { const int row = c >> 3, part = c & 7; *(LAS u32x4*)(lds + RT_KEYS + row * RT_KP + part * 16) = *(const u32x4*)(P.keys + row * 64 + part * 8); }
    __syncthreads();
    const int r32 = lane & 31, hi = lane >> 5;
    LAS int* scr = (LAS int*)(lds + RT_SCR + wave * 8192);
    for (int u = vcu; u < T / 32; u += G) {
        const size_t t = (size_t)u * 32 + r32; const int h = wave;
        float T2[2][16];
#pragma unroll
        for (int c = 0; c < 2; ++c) {
            bf16x8 qf[4];
            { const GAS bf16* q = P.QP + t * 1024 + h * 128 + c * 64 + 8 * hi;
#pragma unroll
              for (int s = 0; s < 4; ++s) qf[s] = *(const GAS bf16x8*)(q + 16 * s); }
            f32x16 sc[4];
#pragma unroll
            for (int m = 0; m < 4; ++m) {
#pragma unroll
                for (int r = 0; r < 16; ++r) sc[m][r] = 0.f;
#pragma unroll
                for (int s = 0; s < 4; ++s) { const bf16x8 a = *(const LAS bf16x8*)(lds + RT_KEYS + (c * 128 + 32 * m + r32) * RT_KP + s * 32 + hi * 16);
                    sc[m] = __builtin_amdgcn_mfma_f32_32x32x16_bf16(a, qf[s], sc[m], 0, 0, 0); }
            }
            float g0[16], g1[16], g2[16], g3[16];
            const unsigned h4 = 4u * (unsigned)hi;
#pragma unroll
            for (int r = 0; r < 16; ++r) { const unsigned kr_ = (unsigned)((r & 3) + 8 * (r >> 2));
                g0[r] = embed(sc[0][r], 0xFFFFFF80u, kr_ | h4); g1[r] = embed(sc[1][r], 0xFFFFFF80u, (32u + kr_) | h4); g2[r] = embed(sc[2][r], 0xFFFFFF80u, (64u + kr_) | h4); g3[r] = embed(sc[3][r], 0xFFFFFF80u, (96u + kr_) | h4); }
            top16_of_64(g0, g1, g2, g3);
            pad16(g0);
#pragma unroll
            for (int i = 0; i < 16; ++i) T2[c][i] = g0[i];
        }
        float A[16], Bv[16];
#pragma unroll
        for (int i = 0; i < 16; ++i) { A[i] = T2[0][i]; Bv[i] = T2[1][i]; swap32(A[i], Bv[i]); }
        merge16_desc(A, Bv);
        pad16(A);
        float T0[16], T1[16];
#pragma unroll
        for (int i = 0; i < 16; ++i) { T0[i] = A[i]; T1[i] = A[i]; swap32(T0[i], T1[i]); }
#pragma unroll
        for (int i = 0; i < 16; ++i) { scr[i * 64 + lane] = (int)(__builtin_bit_cast(unsigned, T0[i]) & 127u); scr[(16 + i) * 64 + lane] = (int)(__builtin_bit_cast(unsigned, T1[i]) & 127u);
            T0[i] = embed(T0[i], 0xFFFFFF80u, 0u); T1[i] = embed(T1[i], 0xFFFFFF80u, 0u); }
        float c0[16], c1[16], c2[16], c3[16];
        const float NINF = -__builtin_inff();
#pragma unroll
        for (int b = 0; b < 16; ++b) c0[b] = mkcand(T0[0], T1[b], (unsigned)b);
#pragma unroll
        for (int b = 0; b < 8; ++b) c1[b] = mkcand(T0[1], T1[b], 16u + b);
#pragma unroll
        for (int b = 0; b < 5; ++b) c1[8 + b] = mkcand(T0[2], T1[b], 32u + b);
#pragma unroll
        for (int b = 0; b < 3; ++b) c1[13 + b] = mkcand(T0[4], T1[b], 64u + b);
#pragma unroll
        for (int b = 0; b < 4; ++b) c2[b] = mkcand(T0[3], T1[b], 48u + b);
        c2[4] = mkcand(T0[5], T1[0], 80u); c2[5] = mkcand(T0[5], T1[1], 81u); c2[6] = mkcand(T0[6], T1[0], 96u); c2[7] = mkcand(T0[6], T1[1], 97u); c2[8] = mkcand(T0[7], T1[0], 112u); c2[9] = mkcand(T0[7], T1[1], 113u);
#pragma unroll
        for (int a = 8; a < 14; ++a) c2[10 + a - 8] = mkcand(T0[a], T1[0], 16u * a);
        c3[0] = mkcand(T0[14], T1[0], 224u); c3[1] = mkcand(T0[15], T1[0], 240u);
#pragma unroll
        for (int i = 2; i < 16; ++i) c3[i] = NINF;
        top16_of_64(c0, c1, c2, c3);
        pad16(c0);
        float gsum = 0.f, ge[16]; int ex[16];
        const float mtop = embed(c0[0], 0xFFFFFF00u, 0u);
#pragma unroll
        for (int i = 0; i < 16; ++i) { const unsigned bits = __builtin_bit_cast(unsigned, c0[i]); const int a = (bits >> 4) & 15, b = bits & 15;
            ge[i] = __builtin_amdgcn_exp2f((embed(c0[i], 0xFFFFFF00u, 0u) - mtop) * LOG2E); gsum += ge[i];
            ex[i] = scr[a * 64 + lane] * 128 + scr[(16 + b) * 64 + lane]; }
        const float ginv = __builtin_amdgcn_rcpf(gsum);
        if (hi == 0) { GAS unsigned short* d = (GAS unsigned short*)P.EX + t * 128 + h * 16;
#pragma unroll
            for (int i = 0; i < 16; ++i) d[i] = (unsigned short)ex[i]; }
        else { GAS f32x4* d = (GAS f32x4*)(P.GW + t * 128 + h * 16);
#pragma unroll
            for (int i = 0; i < 4; ++i) d[i] = (f32x4){ge[4 * i] * ginv, ge[4 * i + 1] * ginv, ge[4 * i + 2] * ginv, ge[4 * i + 3] * ginv}; }
    }
}

__device__ __forceinline__ int wave_allsum_i(int v) {
    v += __builtin_amdgcn_update_dpp(0, v, 0xB1, 0xF, 0xF, true);
    v += __builtin_amdgcn_update_dpp(0, v, 0x4E, 0xF, 0xF, true);
    v += __builtin_amdgcn_update_dpp(0, v, 0x141, 0xF, 0xF, true);
    v += __builtin_amdgcn_update_dpp(0, v, 0x140, 0xF, 0xF, true);
    { int a = v, b = v; asm volatile("v_nop\n\tv_nop\n\tv_permlane16_swap_b32 %0, %1" : "+v"(a), "+v"(b)); v = a + b; }
    { int a = v, b = v; asm volatile("v_nop\n\tv_nop\n\tv_permlane32_swap_b32 %0, %1" : "+v"(a), "+v"(b)); v = a + b; }
    return v;
}
__device__ __forceinline__ float wave_allsum(float v) {
    v += __builtin_bit_cast(float, __builtin_amdgcn_update_dpp(0, __builtin_bit_cast(int, v), 0xB1, 0xF, 0xF, true));
    v += __builtin_bit_cast(float, __builtin_amdgcn_update_dpp(0, __builtin_bit_cast(int, v), 0x4E, 0xF, 0xF, true));
    v += __builtin_bit_cast(float, __builtin_amdgcn_update_dpp(0, __builtin_bit_cast(int, v), 0x141, 0xF, 0xF, true));
    v += __builtin_bit_cast(float, __builtin_amdgcn_update_dpp(0, __builtin_bit_cast(int, v), 0x140, 0xF, 0xF, true));
    { float a = v, b = v; asm volatile("v_nop\n\tv_nop\n\tv_permlane16_swap_b32 %0, %1" : "+v"(a), "+v"(b)); v = a + b; }
    { float a = v, b = v; asm volatile("v_nop\n\tv_nop\n\tv_permlane32_swap_b32 %0, %1" : "+v"(a), "+v"(b)); v = a + b; }
    return v;
}
__device__ __forceinline__ float wave_allmax(float v) {
    v = fmaxf(v, __builtin_bit_cast(float, __builtin_amdgcn_update_dpp(0, __builtin_bit_cast(int, v), 0xB1, 0xF, 0xF, true)));
    v = fmaxf(v, __builtin_bit_cast(float, __builtin_amdgcn_update_dpp(0, __builtin_bit_cast(int, v), 0x4E, 0xF, 0xF, true)));
    v = fmaxf(v, __builtin_bit_cast(float, __builtin_amdgcn_update_dpp(0, __builtin_bit_cast(int, v), 0x141, 0xF, 0xF, true)));
    v = fmaxf(v, __builtin_bit_cast(float, __builtin_amdgcn_update_dpp(0, __builtin_bit_cast(int, v), 0x140, 0xF, 0xF, true)));
    { float a = v, b = v; asm volatile("v_nop\n\tv_nop\n\tv_permlane16_swap_b32 %0, %1" : "+v"(a), "+v"(b)); v = fmaxf(a, b); }
    { float a = v, b = v; asm volatile("v_nop\n\tv_nop\n\tv_permlane32_swap_b32 %0, %1" : "+v"(a), "+v"(b)); v = fmaxf(a, b); }
    return v;
}
__device__ __forceinline__ unsigned q4(float a, float b, float c, float d, int off) {
    const int ia = (int)__builtin_rintf(a) + off, ib = (int)__builtin_rintf(b) + off, ic = (int)__builtin_rintf(c) + off, id = (int)__builtin_rintf(d) + off;
    return (unsigned)(ia & 255) | ((unsigned)(ib & 255) << 8) | ((unsigned)(ic & 255) << 16) | ((unsigned)(id & 255) << 24);
}
__device__ __forceinline__ void quant_row(const GAS float* src, GAS unsigned* dst, GAS float* scale, int off, int lane) {
    const GAS f32x4* s = (const GAS f32x4*)src + 4 * lane; f32x4 v[4]; float m = 0.f;
#pragma unroll
    for (int i = 0; i < 4; ++i) { v[i] = s[i]; m = fmaxf(m, fmaxf(fmaxf(__builtin_fabsf(v[i].x), __builtin_fabsf(v[i].y)), fmaxf(__builtin_fabsf(v[i].z), __builtin_fabsf(v[i].w)))); }
    m = wave_allmax(m); const float inv = m > 0.f ? 127.f / m : 0.f;
    v4u w;
    w.x = q4(v[0].x * inv, v[0].y * inv, v[0].z * inv, v[0].w * inv, off); w.y = q4(v[1].x * inv, v[1].y * inv, v[1].z * inv, v[1].w * inv, off);
    w.z = q4(v[2].x * inv, v[2].y * inv, v[2].z * inv, v[2].w * inv, off); w.w = q4(v[3].x * inv, v[3].y * inv, v[3].z * inv, v[3].w * inv, off);
    *((GAS v4u*)dst + lane) = w;
    if (lane == 0) *scale = m * (1.f / 127.f);
}
struct PeerS { int nslices_step, first_slice, nloc, rank; };
__device__ __forceinline__ PeerS peer_sched(const GAS unsigned* rankw, int xcc, int rank) {
    const int lane = lane_id_v();
    const int c = lane < 16 ? (int)__hip_atomic_load(rankw + 64 * lane, __ATOMIC_RELAXED, __HIP_MEMORY_SCOPE_AGENT) : 0;
    const unsigned long long m = __builtin_amdgcn_ballot_w64(c > 0);
    const int nx = __builtin_popcountll(m), myidx = __builtin_popcountll(m & ((1ull << xcc) - 1ull));
    const int cm = __builtin_amdgcn_readlane(c, xcc);
    PeerS s; s.nslices_step = nx > 0 ? nx : 1; s.first_slice = myidx; s.nloc = cm > 0 ? cm : 1; s.rank = rank; return s;
}
struct Peer1P { const GAS unsigned GAS char* HQ; const GAS int* EX; const GAS unsigned GAS char* U8; GAS int* P; };
__device__ __forceinline__ void peer_k1(const Peer1P& Q, const PeerS& sc, int wave, int lane) {
    asm volatile("" : "+v"(lane));
    const int g = lane >> 3, j = lane & 7;
    const __amdgpu_buffer_rsrc_t rU = __builtin_amdgcn_make_buffer_rsrc((void*)Q.U8, 0, 0x7fffffff, 0x00020000);
    for (int s = sc.first_slice; s < 8; s += sc.nslices_step)
        for (int tile = sc.rank; tile < T / 64; tile += sc.nloc) {
            const int soff_ = __builtin_amdgcn_readfirstlane(128 * s);
            const size_t t0 = (size_t)tile * 64 + wave * 8;
            v4u hqn = *(const GAS v4u*)(Q.HQ + t0 * 1024 + 128 * s + 16 * j), exn[2];
#pragma unroll
            for (int i = 0; i < 2; ++i) exn[i] = *(const GAS v4u*)(Q.EX + t0 * 64 + 8 * g + 4 * i);
#pragma unroll 1
            for (int k = 0; k < 8; ++k) {
                const size_t t = t0 + k;
                const v4u hq = hqn; v4u ex[2];
#pragma unroll
                for (int i = 0; i < 2; ++i) ex[i] = exn[i];
                if (k + 1 < 8) {
                    hqn = *(const GAS v4u*)(Q.HQ + (t + 1) * 1024 + 128 * s + 16 * j);
#pragma unroll
                    for (int i = 0; i < 2; ++i) exn[i] = *(const GAS v4u*)(Q.EX + (t + 1) * 64 + 8 * g + 4 * i);
                }
                v4u uu[16];
#pragma unroll
                for (int i = 0; i < 16; ++i) { const unsigned ew = ((i >> 1) & 3) == 0 ? ex[i >> 3].x : ((i >> 1) & 3) == 1 ? ex[i >> 3].y : ((i >> 1) & 3) == 2 ? ex[i >> 3].z : ex[i >> 3].w; unsigned e; if (i & 1) asm("v_lshrrev_b32 %0, 16, %1" : "=v"(e) : "v"(ew)); else asm("v_and_b32 %0, 0xffff, %1" : "=v"(e) : "v"(ew));
                    uu[i] = __builtin_bit_cast(v4u, __builtin_amdgcn_raw_buffer_load_b128(rU, (int)((e << 10) + 16u * (unsigned)j), soff_, 0)); }
                int lo = 0, hi = 0;
#pragma unroll
                for (int i = 0; i < 16; ++i) {
                    int p = __builtin_amdgcn_sdot4((int)uu[i].x, (int)hq.x, 0, false); p = __builtin_amdgcn_sdot4((int)uu[i].y, (int)hq.y, p, false); p = __builtin_amdgcn_sdot4((int)uu[i].z, (int)hq.z, p, false); p = __builtin_amdgcn_sdot4((int)uu[i].w, (int)hq.w, p, false);
                    p += __builtin_amdgcn_update_dpp(0, p, 0xB1, 0xF, 0xF, true); p += __builtin_amdgcn_update_dpp(0, p, 0x4E, 0xF, 0xF, true); p += __builtin_amdgcn_update_dpp(0, p, 0x141, 0xF, 0xF, true);
                    if (i < 8) lo = (j == i) ? p : lo; else hi = (j == i - 8) ? p : hi;
                }
                Q.P[(t * 8 + s) * 64 + 8 * g + j] = (int)__builtin_amdgcn_perm((unsigned)((hi + 32) >> 6), (unsigned)((lo + 32) >> 6), 0x05040100u);
            }
        }
}
__device__ __forceinline__ void peer_w(const GAS int* EX, const GAS float* GW, const GAS int* P, const GAS float* SH, const GAS float* SU, const GAS float* SV, GAS signed char* WQ, GAS float* WSC, int gw, int NGW, int lane) {
    asm volatile("" : "+v"(lane));
    for (int t = gw; t < T; t += NGW) {
        const float sh = SH[t];
#pragma unroll
        for (int q = 0; q < 2; ++q) { const size_t idx = (size_t)t * 128 + lane + 64 * q; const int e = (int)((const GAS unsigned short*)EX)[idx];
            const int slot_ = lane + 64 * q, pix_ = (slot_ >> 4) * 8 + (slot_ & 7), hsel_ = (slot_ >> 3) & 1;
            int pd = 0;
#pragma unroll
            for (int sl = 0; sl < 8; ++sl) { const int pw_ = P[((size_t)t * 8 + sl) * 64 + pix_]; pd += hsel_ ? (pw_ >> 16) : (int)(short)(pw_ & 0xffff); }
            const float w = GW[idx] * gelu_erf((float)pd * (64.f * sh * SU[e])) * SV[e];
            float m = __builtin_fabsf(w);
            m = fmaxf(m, __builtin_bit_cast(float, __builtin_amdgcn_update_dpp(0, __builtin_bit_cast(int, m), 0xB1, 0xF, 0xF, true)));
            m = fmaxf(m, __builtin_bit_cast(float, __builtin_amdgcn_update_dpp(0, __builtin_bit_cast(int, m), 0x4E, 0xF, 0xF, true)));
            m = fmaxf(m, __builtin_bit_cast(float, __builtin_amdgcn_update_dpp(0, __builtin_bit_cast(int, m), 0x141, 0xF, 0xF, true)));
            m = fmaxf(m, __builtin_bit_cast(float, __builtin_amdgcn_update_dpp(0, __builtin_bit_cast(int, m), 0x140, 0xF, 0xF, true)));
            const float inv = m > 0.f ? 127.f / m : 0.f;
            WQ[idx] = (signed char)(int)__builtin_rintf(w * inv);
            if ((lane & 15) == 0) WSC[(size_t)t * 8 + (lane >> 4) + 4 * q] = m * (1.f / 127.f); }
    }
}
__device__ __forceinline__ void tr4x4(unsigned r0, unsigned r1, unsigned r2, unsigned r3, unsigned (&t)[4]) {
    const unsigned x0 = __builtin_amdgcn_perm(r1, r0, 0x05010400u), x1 = __builtin_amdgcn_perm(r1, r0, 0x07030602u), y0 = __builtin_amdgcn_perm(r3, r2, 0x05010400u), y1 = __builtin_amdgcn_perm(r3, r2, 0x07030602u);
    t[0] = __builtin_amdgcn_perm(y0, x0, 0x05040100u); t[1] = __builtin_amdgcn_perm(y0, x0, 0x07060302u); t[2] = __builtin_amdgcn_perm(y1, x1, 0x05040100u); t[3] = __builtin_amdgcn_perm(y1, x1, 0x07060302u);
}
struct Peer2P { const GAS int* EX; const GAS signed char* WQ; const GAS float* WSC; const GAS unsigned char* V8; GAS bf16* XB; GAS float* SSQ; };
__device__ __forceinline__ void peer_k2(const Peer2P& Q, const PeerS& sc, int wave, int lane) {
    asm volatile("" : "+v"(lane));
    const int g = lane >> 3, j = lane & 7, hf = lane >> 5, rp = (lane >> 4) & 1;
    const __amdgpu_buffer_rsrc_t rV = __builtin_amdgcn_make_buffer_rsrc((void*)Q.V8, 0, 0x7fffffff, 0x00020000);
    for (int s = sc.first_slice; s < 8; s += sc.nslices_step)
        for (int tile = sc.rank; tile < T / 64; tile += sc.nloc) {
            const int soff_ = __builtin_amdgcn_readfirstlane(128 * s);
            const size_t t0 = (size_t)tile * 64 + wave * 8;
            v4u exn[2], wqn; float swn;
#pragma unroll
            for (int i = 0; i < 2; ++i) exn[i] = *(const GAS v4u*)(Q.EX + t0 * 64 + 8 * g + 4 * i);
            wqn = *(const GAS v4u*)(Q.WQ + t0 * 128 + 16 * g); swn = Q.WSC[t0 * 8 + g];
#pragma unroll 1
            for (int k = 0; k < 8; ++k) {
                const size_t t = t0 + k;
                v4u ex[2]; const v4u wq = wqn; const float sw = swn;
#pragma unroll
                for (int i = 0; i < 2; ++i) ex[i] = exn[i];
                if (k + 1 < 8) {
#pragma unroll
                    for (int i = 0; i < 2; ++i) exn[i] = *(const GAS v4u*)(Q.EX + (t + 1) * 64 + 8 * g + 4 * i);
                    wqn = *(const GAS v4u*)(Q.WQ + (t + 1) * 128 + 16 * g); swn = Q.WSC[(t + 1) * 8 + g];
                }
                GAS v2u* xp = (GAS v2u*)(Q.XB + t * 1024 + 128 * s + 16 * j + 8 * hf + 4 * rp);
                const v2u xold = *xp;
                v4u vv[16];
#pragma unroll
                for (int i = 0; i < 16; ++i) { const unsigned ew = ((i >> 1) & 3) == 0 ? ex[i >> 3].x : ((i >> 1) & 3) == 1 ? ex[i >> 3].y : ((i >> 1) & 3) == 2 ? ex[i >> 3].z : ex[i >> 3].w; unsigned e; if (i & 1) asm("v_lshrrev_b32 %0, 16, %1" : "=v"(e) : "v"(ew)); else asm("v_and_b32 %0, 0xffff, %1" : "=v"(e) : "v"(ew));
                    vv[i] = __builtin_bit_cast(v4u, __builtin_amdgcn_raw_buffer_load_b128(rV, (int)((e << 10) + 16u * (unsigned)j), soff_, 0)); }
                int ai[16];
#pragma unroll
                for (int i = 0; i < 16; ++i) ai[i] = 0;
#pragma unroll
                for (int q4_ = 0; q4_ < 4; ++q4_) {
                    const unsigned wq4 = q4_ == 0 ? wq.x : q4_ == 1 ? wq.y : q4_ == 2 ? wq.z : wq.w;
#pragma unroll
                    for (int c = 0; c < 4; ++c) { unsigned tt[4];
                        const v4u &a0 = vv[4 * q4_], &a1 = vv[4 * q4_ + 1], &a2 = vv[4 * q4_ + 2], &a3 = vv[4 * q4_ + 3];
                        tr4x4(c == 0 ? a0.x : c == 1 ? a0.y : c == 2 ? a0.z : a0.w, c == 0 ? a1.x : c == 1 ? a1.y : c == 2 ? a1.z : a1.w, c == 0 ? a2.x : c == 1 ? a2.y : c == 2 ? a2.z : a2.w, c == 0 ? a3.x : c == 1 ? a3.y : c == 2 ? a3.z : a3.w, tt);
#pragma unroll
                        for (int b = 0; b < 4; ++b) ai[4 * c + b] = __builtin_amdgcn_sdot4((int)tt[b], (int)wq4, ai[4 * c + b], false); }
                }
                float acc[16];
#pragma unroll
                for (int i = 0; i < 16; ++i) acc[i] = (float)ai[i] * sw;
                float r8[8], r4[4];
#pragma unroll
                for (int m = 0; m < 8; ++m) { float a = acc[m], b = acc[m + 8]; swap32(a, b); r8[m] = a + b; }
#pragma unroll
                for (int n = 0; n < 4; ++n) { float a = r8[n], b = r8[n + 4]; asm volatile("v_nop\n\tv_nop\n\tv_permlane16_swap_b32 %0, %1" : "+v"(a), "+v"(b)); r4[n] = a + b; }
#pragma unroll
                for (int n = 0; n < 4; ++n) r4[n] += __builtin_bit_cast(float, __builtin_amdgcn_update_dpp(0, __builtin_bit_cast(int, r4[n]), 0x128, 0xF, 0xF, true));
                v2u xw; xw.x = pk2(bflo(xold.x) + r4[0], bfhi(xold.x) + r4[1]); xw.y = pk2(bflo(xold.y) + r4[2], bfhi(xold.y) + r4[3]);
                float ss = 0.f;
                if ((lane & 8) == 0) { const float x0 = bflo(xw.x), x1 = bfhi(xw.x), x2 = bflo(xw.y), x3 = bfhi(xw.y); ss = (x0 * x0 + x1 * x1) + (x2 * x2 + x3 * x3); *xp = xw; }
                ss = wave_allsum(ss);
                if (Q.SSQ) { if (lane == 0) Q.SSQ[t * 16 + s] = ss; }
            }
        }
}

struct Args { const float* in[33]; float* out; unsigned char* ws; int ph_lo, ph_hi; };
struct Frame { LAS unsigned char* lds; volatile LAS unsigned* MISC; gu32* ctl; int tid, lane, wave, G, vcu, xcc, xrank; };

__device__ __forceinline__ void transpose_item(const float* W, int ldw, int nsrc0, bf16* WT, int ldt, int rdst0, LAS float* scr, int kb, int nb, int lane, float scale, const float* kgain) {
    const int k0 = 64 * kb, n0 = 32 * nb;
#pragma unroll 8
    for (int i = 0; i < 32; ++i) { const int kk = 2 * i + (lane >> 5); const float gsc = kgain ? kgain[k0 + kk] * scale : scale; scr[kk * 33 + (lane & 31)] = W[(size_t)(k0 + kk) * ldw + nsrc0 + n0 + (lane & 31)] * gsc; }
    LDS_WAIT(); asm volatile("" ::: "memory");
    const int c = lane & 7;
#pragma unroll
    for (int j = 0; j < 4; ++j) { const int n = (lane >> 3) + 8 * j; const LAS float* s = scr + (8 * c) * 33 + n;
        v4u o; o.x = pk2(s[0 * 33], s[1 * 33]); o.y = pk2(s[2 * 33], s[3 * 33]); o.z = pk2(s[4 * 33], s[5 * 33]); o.w = pk2(s[6 * 33], s[7 * 33]);
        *(GAS v4u*)(WT + (size_t)(rdst0 + n0 + n) * ldt + k0 + 8 * c) = o; }
    LDS_WAIT(); asm volatile("" ::: "memory");
}
__device__ __forceinline__ void zero_rect(bf16* base, int ld, int row0, int nrows, int col0, int ncols, int gtid, int gthreads) {
    const int vpr = ncols / 8;
    for (int i = gtid; i < nrows * vpr; i += gthreads) { const int r = i / vpr, c = i % vpr; *(GAS v4u*)(base + (size_t)(row0 + r) * ld + col0 + 8 * c) = (v4u){0u, 0u, 0u, 0u}; }
}

__device__ __forceinline__ void p0_prologue(Frame& F, const Args& a) {
    LAS float* scr = (LAS float*)(F.lds + RING_OFF + F.wave * 16384);
    const int gw = blockIdx.x * NWAVES + F.wave, NGW = F.G * NWAVES;
    const int gtid = blockIdx.x * (NWAVES * 64) + F.tid, gthreads = F.G * NWAVES * 64;
    unsigned char* ws = a.ws;
    x0_phase((const GAS float*)a.in[0], (GAS bf16*)(ws + WS_XNB), (GAS float*)(ws + WS_SSQ), gw, NGW, F.lane);
    constexpr int I_IN = 16 * (INW / 32), I_SQ = 16 * 32, I_CKV = 16 * 64, I_UQ = 3 * 12, I_UKV = 2 * 16, I_L = I_IN + 4 * I_SQ + I_CKV + I_UQ + I_UKV;
    for (int it = gw; it < L * I_L; it += NGW) {
        const int l = it / I_L; int r = it % I_L;
        if (r < I_IN) {
            const int kb = r / 67, nb = r % 67; int src, dst; float sc = 1.f;
            if (nb < 6) { src = 32 * nb; dst = src; } else if (nb < 11) { src = 32 * nb; dst = src + 64; } else { src = 32 * nb; dst = src + 160; if (nb >= 43 && nb < 51) sc = 0.17677669529663687f * LOG2E; }
            transpose_item(a.in[5] + (size_t)l * D * INW, INW, src, (bf16*)(ws + WS_WIN) + (size_t)l * INP * D, D, dst, scr, kb, 0, F.lane, sc, a.in[4] + l * D); continue; } r -= I_IN;
        if (r < I_SQ) { transpose_item(a.in[21] + (size_t)l * D * D, D, 0, (bf16*)(ws + WS_WOUT) + (size_t)l * D * D, D, 0, scr, r / 32, r % 32, F.lane, 1.f, nullptr); continue; } r -= I_SQ;
        if (r < I_SQ) { transpose_item(a.in[24] + (size_t)l * D * D, D, 0, (bf16*)(ws + WS_WCQ) + (size_t)l * D * D, D, 0, scr, r / 32, r % 32, F.lane, 0.0625f * LOG2E, a.in[22] + l * D); continue; } r -= I_SQ;
        if (r < I_SQ) { transpose_item(a.in[26] + (size_t)l * D * D, D, 0, (bf16*)(ws + WS_WCO) + (size_t)l * D * D, D, 0, scr, r / 32, r % 32, F.lane, 1.f, nullptr); continue; } r -= I_SQ;
        if (r < I_SQ) { transpose_item(a.in[28] + (size_t)l * D * D, D, 0, (bf16*)(ws + WS_WPQ) + (size_t)l * D * D, D, 0, scr, r / 32, r % 32, F.lane, 1.f, a.in[27] + l * D); continue; } r -= I_SQ;
        if (r < I_CKV) { transpose_item(a.in[25] + (size_t)l * D * 2 * D, 2 * D, 0, (bf16*)(ws + WS_WCKV) + (size_t)l * 2 * D * D, D, 0, scr, r / 64, r % 64, F.lane, 1.f, nullptr); continue; } r -= I_CKV;
        if (r < I_UQ) { transpose_item(a.in[7] + (size_t)l * 192 * 384, 384, 0, (bf16*)(ws + WS_WUQ) + (size_t)l * 512 * 256, 256, 0, scr, r / 12, r % 12, F.lane, 0.10206207261596575f * LOG2E, a.in[6] + l * 192); continue; } r -= I_UQ;
        transpose_item(a.in[9] + (size_t)l * 128 * 512, 512, 0, (bf16*)(ws + WS_WUKV) + (size_t)l * 512 * 256, 256, 0, scr, r / 16, r % 16, F.lane, 1.f, a.in[8] + l * 128);
    }
    for (int l = 0; l < L; ++l) {
        bf16* win = (bf16*)(ws + WS_WIN) + (size_t)l * INP * D; bf16* wuq = (bf16*)(ws + WS_WUQ) + (size_t)l * 512 * 256; bf16* wukv = (bf16*)(ws + WS_WUKV) + (size_t)l * 512 * 256;
        zero_rect(win, D, 192, 64, 0, D, gtid, gthreads); zero_rect(win, D, 416, 96, 0, D, gtid, gthreads);
        zero_rect(wuq, 256, 0, 384, 192, 64, gtid, gthreads); zero_rect(wuq, 256, 384, 128, 0, 256, gtid, gthreads);
        zero_rect(wukv, 256, 0, 512, 128, 128, gtid, gthreads);
    }
    { float* rope = (float*)(ws + WS_ROPE); const int* pos = (const int*)a.in[2];
      for (int i = gtid; i < T * 16; i += gthreads) { const int t = i >> 4, k = i & 15; const float inv = powf(10000.f, -(float)(2 * k) / 32.f); const float ang = (float)pos[t] * inv;
          rope[(size_t)t * 32 + k] = cosf(ang); rope[(size_t)t * 32 + 16 + k] = sinf(ang); } }
    { const GAS f32x4* ks = (const GAS f32x4*)a.in[29]; GAS v2u* kd = (GAS v2u*)(ws + WS_KEYS);
      for (int i = gtid; i < L * 2 * 128 * 64 / 4; i += gthreads) { const f32x4 v = ks[i]; v2u w; w.x = pk2(v.x, v.y); w.y = pk2(v.z, v.w); kd[i] = w; }
    }
    for (int r = gw; r < 2 * L * 16384; r += NGW) { const int tb = r / (L * 16384), rr = r % (L * 16384);
        quant_row((const GAS float*)a.in[30 + tb] + (size_t)rr * 1024, (GAS unsigned*)(ws + (tb ? WS_V8 : WS_U8) + (size_t)rr * 1024), (GAS float*)(ws + (tb ? WS_SV : WS_SU)) + rr, 0, F.lane); }
    { float* btab = (float*)(ws + WS_BTAB); float* lams = (float*)(ws + WS_LAMS); float* spt = (float*)(ws + WS_SP);
      for (int i = gtid; i < 4 * 129; i += gthreads) { const int h = i / 129, n = i % 129; int bu; if (n < 16) bu = n; else { const int lg = 16 + (int)(logf((float)n / 16.f) / logf(8.f) * 16.f); bu = lg < 31 ? lg : 31; }
          btab[i] = a.in[3][bu * 4 + h] * LOG2E; }
      for (int i = gtid; i < L; i += gthreads) { const float* dl = a.in[17] + i * 128; float s1 = 0.f, s2 = 0.f; for (int j = 0; j < 32; ++j) { s1 += dl[j] * dl[32 + j]; s2 += dl[64 + j] * dl[96 + j]; }
          const float li = 0.8f - 0.6f * expf(-0.3f * (float)i); lams[2 * i] = expf(s1) - expf(s2) + li; lams[2 * i + 1] = li; }
      for (int i = gtid; i < L * 512; i += gthreads) spt[i] = log1pf(expf(-a.in[16][i])); }
    { GAS bf16* wat = (GAS bf16*)(ws + WS_WAT);
      for (int i = gtid; i < L * 8 * 2 * 4096; i += gthreads) { const int in_ = i & 63, out_ = (i >> 6) & 63, gate = (i >> 12) & 1, lg = i >> 13;
          wat[i] = (bf16)f2bf_(a.in[gate ? 14 : 12][(size_t)lg * 4096 + in_ * 64 + out_]); } }
    for (int l = 0; l < L; ++l) norm_phase((const GAS float*)a.in[1], (const GAS float*)a.in[23] + l * D, (GAS bf16*)(ws + WS_MNB) + (size_t)l * NB * MEM * D, NB * MEM, gw, NGW, F.lane);
}

constexpr int NPL = 16, PH_FINAL = 2 + NPL * L;
__global__ void __launch_bounds__(NWAVES * 64, 2) fwd(Args args) {
    extern __shared__ __attribute__((aligned(16))) unsigned char lds[];
    Frame F;
    F.lds = (LAS unsigned char*)lds; F.MISC = (volatile LAS unsigned*)(F.lds + MISC_OFF);
    F.tid = threadIdx.x; F.lane = F.tid & 63; F.wave = __builtin_amdgcn_readfirstlane(F.tid >> 6); F.G = gridDim.x;
    F.vcu = (F.G % 8 == 0) ? ((int)blockIdx.x % 8) * (F.G / 8) + (int)blockIdx.x / 8 : (int)blockIdx.x;
    unsigned char* ws = args.ws;
    F.ctl = (gu32*)(opq(ws) + WS_CTL);
    for (int u = F.tid; u < (LDS_BYTES - LDSCTL_OFF) / 4; u += NWAVES * 64) ((LAS unsigned*)(F.lds + LDSCTL_OFF))[u] = 0u;
    __syncthreads();
    XcdBarrier bar = xcd_barrier_post((unsigned*)(F.ctl + CW_BAR), F.MISC + 8);
    F.xcc = (int)bar.x;
    if (F.tid == 0) F.MISC[12] = __hip_atomic_fetch_add((unsigned*)(F.ctl + CW_RANK) + 64 * bar.x, 1u, __ATOMIC_RELAXED, __HIP_MEMORY_SCOPE_AGENT);
    __syncthreads();
    F.xrank = __builtin_amdgcn_readfirstlane((int)F.MISC[12]);
    const int lo = args.ph_lo, hi = args.ph_hi;
    const int gw = blockIdx.x * NWAVES + F.wave, NGW = F.G * NWAVES;
#define IN(k) (lo <= (k) && (k) < hi)
#define LANE_ (lane_id_v())
#define TID_ ((opqi(F.wave) << 6) | LANE_)
#define SITE() const int G_ = opqi(F.G), wv_ = opqi(F.wave), vcu_ = opqi(F.vcu), gw_ = opqi(gw), NGW_ = opqi(NGW); (void)G_; (void)wv_; (void)vcu_; (void)gw_; (void)NGW_
#if MK_DUP == 99
#define SEAM(k) do { if (IN(k) && IN((k) + 1)) { xcd_barrier(bar, (F.wave == 0 && lane_id_v() == 0) ? 1 : 0); xcd_barrier(bar, (F.wave == 0 && lane_id_v() == 0) ? 1 : 0); } } while (0)
#else
#define SEAM(k) do { if (IN(k) && IN((k) + 1)) xcd_barrier(bar, (F.wave == 0 && lane_id_v() == 0) ? 1 : 0); } while (0)
#endif
#define GEMM_SITE(EPI, Aptr, lda_, Bptr, ldb_, M_, N_, K_, cperm, ...) do { \
        pg8::Gemm g{opq(Aptr), opq(Bptr), M_, N_, K_, lda_, ldb_}; pg8::StaticOrder So; So.init(M_, N_, opqi(F.G), opqi(cperm)); pg8::EPI E{__VA_ARGS__}; \
        pg8::gemm_phase<pg8::EPI, pg8::StaticOrder, true, true>(F.lds + RING_OFF, g, So, E, opqi(F.wave)); } while (0)
    if (IN(0)) { p0_prologue(F, args); }
    SEAM(0);
    if (IN(1)) {
#pragma unroll 1
        for (int l = 0; l < L; ++l)
            GEMM_SITE(EpiBf16, (const GAS bf16*)(opq(ws) + WS_MNB) + (size_t)l * NB * MEM * D, D, (const GAS bf16*)(opq(ws) + WS_WCKV) + (size_t)l * 2 * D * D, D, NB * MEM, 2 * D, D, (int)((blockIdx.x + 64 * l) % F.G),
                      opq((GAS bf16*)(opq(ws) + WS_KVCB) + (size_t)l * NB * MEM * 2 * D), 2 * D, 2 * D, (const GAS float*)nullptr, 0);
    }
    SEAM(1);
    for (int l = 0; l < L; ++l) {
        const int pb = 2 + NPL * l;
        const GAS bf16* XNB = (const GAS bf16*)(opq(ws) + WS_XNB); const GAS bf16* YB = (const GAS bf16*)(opq(ws) + WS_YB); GAS bf16* PROJB = (GAS bf16*)(opq(ws) + WS_PROJB);
        if (IN(pb + 1)) GEMM_SITE(EpiBf16, XNB, D, (const GAS bf16*)(opq(ws) + WS_WIN) + (size_t)l * INP * D, D, T, INP, D, (int)blockIdx.x, opq(PROJB), INP, INP, opq((const GAS float*)(opq(ws) + WS_SSQ)), 8);
#if MK_DUP == 1
        if (IN(pb + 1)) GEMM_SITE(EpiBf16, XNB, D, (const GAS bf16*)(opq(ws) + WS_WIN) + (size_t)l * INP * D, D, T, INP, D, (int)blockIdx.x, opq(PROJB), INP, INP, opq((const GAS float*)(opq(ws) + WS_SSQ)), 8);
#endif
        SEAM(pb + 1);
        if (IN(pb + 2)) {
            SITE();
            pre_phase(opq((const GAS bf16*)PROJB), opq((const GAS float*)(opq(ws) + WS_ROPE)), opq((GAS float*)(opq(ws) + WS_RS)), opq((GAS bf16*)(opq(ws) + WS_KMB)), gw_, NGW_, LANE_);
#if MK_DUP == 21
            pre_phase(opq((const GAS bf16*)PROJB), opq((const GAS float*)(opq(ws) + WS_ROPE)), opq((GAS float*)(opq(ws) + WS_RS)), opq((GAS bf16*)(opq(ws) + WS_KMB)), gw_, NGW_, LANE_);
#endif
            LruP LP{opq((const GAS bf16*)PROJB), (const GAS float*)args.in[opqi(10)] + l * 4 * 512, (const GAS float*)args.in[opqi(11)] + l * 512, opq((const GAS bf16*)(opq(ws) + WS_WAT)) + (size_t)l * 8 * 2 * 4096, (const GAS float*)args.in[opqi(13)] + l * 512, (const GAS float*)args.in[opqi(15)] + l * 512,
                    (const GAS float*)(opq(ws) + WS_SP) + l * 512, opq((GAS unsigned*)(opq(ws) + WS_HLB)), opq((GAS float*)(opq(ws) + WS_LSUM))};
            lru_phase(LP, F.lds, TID_, wv_, LANE_, vcu_, G_);
#if MK_DUP == 2
            lru_phase(LP, F.lds, TID_, wv_, LANE_, vcu_, G_);
#endif
        }
        SEAM(pb + 2);
        if (IN(pb + 3)) {
            GEMM_SITE(EpiUp, (const GAS bf16*)PROJB + PC_CQ, INP, (const GAS bf16*)(opq(ws) + WS_WUQ) + (size_t)l * 512 * 256, 256, T, 512, 256, (int)blockIdx.x,
                      opq((GAS bf16*)(opq(ws) + WS_QMB)), (GAS bf16*)nullptr, 384, 384, opq((const GAS float*)(opq(ws) + WS_RS)), 0, 0);
            GEMM_SITE(EpiUp, (const GAS bf16*)PROJB + PC_CKV, INP, (const GAS bf16*)(opq(ws) + WS_WUKV) + (size_t)l * 512 * 256, 256, T, 512, 256, (int)blockIdx.x,
                      opq((GAS bf16*)(opq(ws) + WS_KMB)), opq((GAS bf16*)(opq(ws) + WS_VMB)), 0, 512, opq((const GAS float*)(opq(ws) + WS_RS)), 1, 1);
#if MK_DUP == 3
            GEMM_SITE(EpiUp, (const GAS bf16*)PROJB + PC_CQ, INP, (const GAS bf16*)(opq(ws) + WS_WUQ) + (size_t)l * 512 * 256, 256, T, 512, 256, (int)blockIdx.x,
                      opq((GAS bf16*)(opq(ws) + WS_QMB)), (GAS bf16*)nullptr, 384, 384, opq((const GAS float*)(opq(ws) + WS_RS)), 0, 0);
            GEMM_SITE(EpiUp, (const GAS bf16*)PROJB + PC_CKV, INP, (const GAS bf16*)(opq(ws) + WS_WUKV) + (size_t)l * 512 * 256, 256, T, 512, 256, (int)blockIdx.x,
                      opq((GAS bf16*)(opq(ws) + WS_KMB)), opq((GAS bf16*)(opq(ws) + WS_VMB)), 0, 512, opq((const GAS float*)(opq(ws) + WS_RS)), 1, 1);
#endif
        }
        SEAM(pb + 3);
        if (IN(pb + 4)) {
            SITE();
            AttnP PM{opq((const GAS bf16*)(opq(ws) + WS_QMB)), opq((const GAS bf16*)(opq(ws) + WS_KMB)), opq((const GAS bf16*)(opq(ws) + WS_VMB)), 384, 384, 256, opq((GAS bf16*)(opq(ws) + WS_OMB)), 256, opq((const GAS float*)(opq(ws) + WS_ROPE)), nullptr, nullptr, nullptr, nullptr};
            AttnP PD{opq((const GAS bf16*)PROJB + PC_QD), opq((const GAS bf16*)PROJB + PC_KD), opq((const GAS bf16*)PROJB + PC_VD), INP, INP, INP, opq((GAS bf16*)(opq(ws) + WS_YB) + 768), 1024, nullptr,
                     (const GAS int*)args.in[opqi(2)], (const GAS float*)(opq(ws) + WS_BTAB), (const GAS float*)args.in[opqi(18)] + l * 64, (const GAS float*)(opq(ws) + WS_LAMS) + 2 * l};
            attn_phase(PM, PD, F.lds, TID_, wv_, LANE_, vcu_, G_);
#if MK_DUP == 4
            __syncthreads(); attn_phase(PM, PD, F.lds, TID_, wv_, LANE_, vcu_, G_);
#elif MK_DUP == 40 || MK_DUP == 41
            __syncthreads(); attn_phase(PM, PD, F.lds, TID_, wv_, LANE_, vcu_, G_, MK_DUP - 40);
#endif
        }
        SEAM(pb + 4);
        if (IN(pb + 5)) {
            SITE();
            PostP PP{opq((const GAS bf16*)(opq(ws) + WS_OMB)), opq((const GAS unsigned*)(opq(ws) + WS_HLB)), opq((const GAS float*)(opq(ws) + WS_LSUM)), opq((const GAS bf16*)PROJB), (const GAS float*)args.in[opqi(19)] + l * 256, (const GAS float*)args.in[opqi(20)] + l * 512, opq((GAS bf16*)(opq(ws) + WS_YB))};
            post_phase(PP, F.lds, TID_, wv_, LANE_, vcu_, G_);
#if MK_DUP == 5
            __syncthreads(); post_phase(PP, F.lds, TID_, wv_, LANE_, vcu_, G_);
#endif
        }
        SEAM(pb + 5);
        if (IN(pb + 6)) GEMM_SITE(EpiRes, YB, D, (const GAS bf16*)(opq(ws) + WS_WOUT) + (size_t)l * D * D, D, T, D, D, (int)blockIdx.x, opq((GAS bf16*)(opq(ws) + WS_XNB)), opq((GAS float*)(opq(ws) + WS_SSQ)));
#if MK_DUP == 6
        if (IN(pb + 6)) GEMM_SITE(EpiRes, YB, D, (const GAS bf16*)(opq(ws) + WS_WOUT) + (size_t)l * D * D, D, T, D, D, (int)blockIdx.x, opq((GAS bf16*)(opq(ws) + WS_HLB)), opq((GAS float*)(opq(ws) + WS_OMB)));
#endif
        SEAM(pb + 6);
        if (IN(pb + 8)) GEMM_SITE(EpiBf16, XNB, D, (const GAS bf16*)(opq(ws) + WS_WCQ) + (size_t)l * D * D, D, T, D, D, (int)blockIdx.x, opq(PROJB), D, D, opq((const GAS float*)(opq(ws) + WS_SSQ)), 16);
#if MK_DUP == 8
        if (IN(pb + 8)) GEMM_SITE(EpiBf16, XNB, D, (const GAS bf16*)(opq(ws) + WS_WCQ) + (size_t)l * D * D, D, T, D, D, (int)blockIdx.x, opq(PROJB), D, D, opq((const GAS float*)(opq(ws) + WS_SSQ)), 16);
#endif
        SEAM(pb + 8);
        if (IN(pb + 9)) {
            SITE();
            const GAS bf16* kv = (const GAS bf16*)(opq(ws) + WS_KVCB) + (size_t)l * NB * MEM * 2 * D;
            AttnP PC{opq((const GAS bf16*)PROJB), opq(kv), opq(kv + D), 1024, 2 * D, 2 * D, opq((GAS bf16*)(opq(ws) + WS_YB)), 1024, nullptr, nullptr, nullptr, nullptr, nullptr};
            cross_phase(PC, F.lds, TID_, wv_, LANE_, vcu_, G_);
#if MK_DUP == 9
            cross_phase(PC, F.lds, TID_, wv_, LANE_, vcu_, G_);
#endif
        }
        SEAM(pb + 9);
        if (IN(pb + 10)) GEMM_SITE(EpiRes, YB, D, (const GAS bf16*)(opq(ws) + WS_WCO) + (size_t)l * D * D, D, T, D, D, (int)blockIdx.x, opq((GAS bf16*)(opq(ws) + WS_XNB)), opq((GAS float*)(opq(ws) + WS_SSQ)));
        SEAM(pb + 10);
        if (IN(pb + 12)) { GEMM_SITE(EpiBf16, XNB, D, (const GAS bf16*)(opq(ws) + WS_WPQ) + (size_t)l * D * D, D, T, D, D, (int)blockIdx.x, opq(PROJB), D, D, opq((const GAS float*)(opq(ws) + WS_SSQ)), 16);
#if MK_DUP == 12
            hq_phase(opq(XNB), opq((const GAS float*)(opq(ws) + WS_SSQ)), (const GAS float*)args.in[opqi(27)] + l * D, opq((GAS unsigned char*)(opq(ws) + WS_HQ)), opq((GAS float*)(opq(ws) + WS_SH)), opq((GAS int*)(opq(ws) + WS_P)), gw_, NGW_, LANE_);
#endif
            }
        SEAM(pb + 12);
        if (IN(pb + 13)) {
            SITE();
            RouteP RP{opq((const GAS bf16*)PROJB), opq((const GAS bf16*)(opq(ws) + WS_KEYS) + (size_t)l * 2 * 128 * 64), opq((GAS int*)(opq(ws) + WS_EX)), opq((GAS float*)(opq(ws) + WS_GW))};
            route_phase(RP, F.lds, TID_, wv_, LANE_, vcu_, G_);
            hq_phase(opq(XNB), opq((const GAS float*)(opq(ws) + WS_SSQ)), (const GAS float*)args.in[opqi(27)] + l * D, opq((GAS unsigned char*)(opq(ws) + WS_HQ)), opq((GAS float*)(opq(ws) + WS_SH)), opq((GAS int*)(opq(ws) + WS_P)), gw_, NGW_, LANE_);
#if MK_DUP == 13
            route_phase(RP, F.lds, TID_, wv_, LANE_, vcu_, G_);
#endif
        }
        SEAM(pb + 13);
        if (IN(pb + 14)) {
            SITE();
            const PeerS ps = peer_sched((const GAS unsigned*)(F.ctl + CW_RANK), opqi(F.xcc), opqi(F.xrank));
            Peer1P Q1{opq((const GAS unsigned char*)(opq(ws) + WS_HQ)), opq((const GAS int*)(opq(ws) + WS_EX)), opq((const GAS unsigned char*)(opq(ws) + WS_U8) + (size_t)l * 16384 * 1024), opq((GAS int*)(opq(ws) + WS_PROJB))};
            peer_k1(Q1, ps, wv_, LANE_);
#if MK_DUP == 141
            { Peer1P Q1b = Q1; Q1b.P = (GAS int*)(opq(ws) + WS_HLB); peer_k1(Q1b, ps, wv_, LANE_); }
#endif
        }
        SEAM(pb + 14);
        if (IN(pb + 15)) {
            SITE();
            peer_w(opq((const GAS int*)(opq(ws) + WS_EX)), opq((const GAS float*)(opq(ws) + WS_GW)), opq((const GAS int*)(opq(ws) + WS_PROJB)), opq((const GAS float*)(opq(ws) + WS_SH)), opq((const GAS float*)(opq(ws) + WS_SU) + l * 16384), opq((const GAS float*)(opq(ws) + WS_SV) + l * 16384),
                   opq((GAS signed char*)(opq(ws) + WS_W)), opq((GAS float*)(opq(ws) + WS_WS)), gw_, NGW_, LANE_);
#if MK_DUP == 150
            peer_w(opq((const GAS int*)(opq(ws) + WS_EX)), opq((const GAS float*)(opq(ws) + WS_GW)), opq((const GAS int*)(opq(ws) + WS_PROJB)), opq((const GAS float*)(opq(ws) + WS_SH)), opq((const GAS float*)(opq(ws) + WS_SU) + l * 16384), opq((const GAS float*)(opq(ws) + WS_SV) + l * 16384),
                   opq((GAS signed char*)(opq(ws) + WS_W)), opq((GAS float*)(opq(ws) + WS_WS)), gw_, NGW_, LANE_);
#endif
            xcd_barrier(bar, (F.wave == 0 && lane_id_v() == 0) ? 1 : 0);
            const PeerS ps = peer_sched((const GAS unsigned*)(F.ctl + CW_RANK), opqi(F.xcc), opqi(F.xrank));
            Peer2P Q2{opq((const GAS int*)(opq(ws) + WS_EX)), opq((const GAS signed char*)(opq(ws) + WS_W)), opq((const GAS float*)(opq(ws) + WS_WS)), opq((const GAS unsigned char*)(opq(ws) + WS_V8) + (size_t)l * 16384 * 1024), opq((GAS bf16*)(opq(ws) + WS_XNB)), opq((GAS float*)(opq(ws) + WS_SSQ))};
            peer_k2(Q2, ps, wv_, LANE_);
#if MK_DUP == 151
            { Peer2P Q2b = Q2; Q2b.XB = (GAS bf16*)(opq(ws) + WS_HLB); Q2b.SSQ = (GAS float*)(opq(ws) + WS_OMB); peer_k2(Q2b, ps, wv_, LANE_); }
#endif
        }
        SEAM(pb + 15);
    }
    if (IN(PH_FINAL)) { SITE(); final_norm_phase(opq((const GAS bf16*)(opq(ws) + WS_XNB)), (GAS float*)args.out, (const GAS float*)args.in[opqi(32)], T, gw_, NGW_, LANE_); }
#undef IN
#undef SEAM
#undef GEMM_SITE
}
}
extern "C" void kernel_launch(void* const* d_in, const int* in_sizes, int n_in, void* d_out, int out_size, void* d_ws, size_t ws_size, hipStream_t stream) {
    (void)in_sizes; (void)out_size;
    static int grid = 0;
    if (grid == 0) {
        int dev = 0, cus = 0, per_cu = 0;
        if (n_in != 33 || ws_size < mk::WS_END) { fprintf(stderr, "kernel_launch: unexpected n_in %d / ws_size %zu\n", n_in, ws_size); grid = -1; return; }
        if (hipGetDevice(&dev) != hipSuccess || hipDeviceGetAttribute(&cus, hipDeviceAttributeMultiprocessorCount, dev) != hipSuccess) { grid = -1; return; }
        if (hipFuncSetAttribute((const void*)mk::fwd, hipFuncAttributeMaxDynamicSharedMemorySize, mk::LDS_BYTES) != hipSuccess) { fprintf(stderr, "kernel_launch: hipFuncSetAttribute failed\n"); grid = -1; return; }
        if (hipOccupancyMaxActiveBlocksPerMultiprocessor(&per_cu, (const void*)mk::fwd, mk::NWAVES * 64, mk::LDS_BYTES) != hipSuccess || per_cu < 1) fprintf(stderr, "kernel_launch: occupancy query says %d\n", per_cu);
        (void)hipGetLastError();
        grid = cus;
    }
    if (grid < 0) return;
    unsigned char* ws = (unsigned char*)d_ws;
    (void)hipMemsetAsync(ws + mk::WS_CTL, 0, mk::CTL_ZERO_BYTES, stream);
    mk::Args a{};
    for (int i = 0; i < 33; ++i) a.in[i] = (const float*)d_in[i];
    a.out = (float*)d_out; a.ws = ws;
    auto run = [&](int lo, int hi) { a.ph_lo = lo; a.ph_hi = hi; hipLaunchKernelGGL(mk::fwd, dim3(grid), dim3(mk::NWAVES * 64), mk::LDS_BYTES, stream, a); };
#if MK_ONE_LAUNCH
    run(0, mk::PH_FINAL + 1);
#else
    for (int p = 0; p <= mk::PH_FINAL; ++p) {
        const int k = (p - 2) % mk::NPL, l = (p - 2) / mk::NPL;
#if MK_NAIVE_PEER == 2
        if (p >= 2 && p < mk::PH_FINAL && k == 14) {
            hipLaunchKernelGGL(k_peer, dim3(T), dim3(256), 0, stream, (const bf16_t*)(ws + mk::WS_XNB), (const int*)(ws + mk::WS_EX), (const float*)(ws + mk::WS_GW), (const float*)d_in[30] + (size_t)l * NEXP * D, (const float*)d_in[31] + (size_t)l * NEXP * D, (float*)d_out);
            continue; }
#elif MK_NAIVE_PEER == 1
        if (p >= 2 && p < mk::PH_FINAL && k == 13) {
            float* TQ = (float*)(ws + (size_t)806 * mk::MiB);
            hipLaunchKernelGGL(k_bf2f, dim3((unsigned)(((size_t)T * D + 255) / 256)), dim3(256), 0, stream, (const bf16_t*)(ws + mk::WS_PROJB), TQ, (long)T * D);
            hipLaunchKernelGGL(k_route, dim3(T), dim3(256), 0, stream, TQ, (const float*)d_in[29] + (size_t)l * 2 * 128 * 64, (int*)(ws + mk::WS_EX), (float*)(ws + mk::WS_GW));
            hipLaunchKernelGGL(k_peer, dim3(T), dim3(256), 0, stream, (const bf16_t*)(ws + mk::WS_XNB), (const int*)(ws + mk::WS_EX), (const float*)(ws + mk::WS_GW), (const float*)d_in[30] + (size_t)l * NEXP * D, (const float*)d_in[31] + (size_t)l * NEXP * D, (float*)d_out);
            continue; }
        if (p >= 2 && p < mk::PH_FINAL && k == 14) continue;
#endif
        run(p, p + 1); }
#endif
}
```

```cpp
#include <hip/hip_runtime.h>
#include <cstdint>
#include <cstdio>
#include <cmath>

#ifndef MK_ONE_LAUNCH
#define MK_ONE_LAUNCH 1
#endif
#ifndef MK_DUP
#define MK_DUP 0
#endif
#ifndef MK_NAIVE_PEER
#define MK_NAIVE_PEER 0
#endif
namespace pg8 {
#define PG8_LAS __attribute__((address_space(3)))
#ifndef GAS
#define GAS __attribute__((address_space(1)))
#endif
typedef unsigned short bf16_t;
typedef short bf16x8 __attribute__((ext_vector_type(8)));
typedef float f32x4 __attribute__((ext_vector_type(4)));
typedef unsigned u32x4 __attribute__((ext_vector_type(4)));
typedef unsigned u32x2 __attribute__((ext_vector_type(2)));
constexpr int BM = 256, BK = 64, HALF = 128, HTB = HALF * BK * 2, STAGE_BYTES = 8 * HTB, NXCD = 8, WGM = 8;
__host__ __device__ __forceinline__ int lds_byte(int r, int c) { const int st = (r >> 4) * 2 + (c >> 5), rr = r & 15, cc = c & 31, ob = rr * 64 + cc * 2; return st * 1024 + (ob ^ (((ob >> 9) & 1) << 5)); }
__host__ __device__ __forceinline__ void stage_rc(int b, int& R, int& C) { const int st = b / 1024, sb = b % 1024, swz = sb ^ (((sb >> 9) & 1) << 5); R = (st >> 1) * 16 + swz / 64; C = (st & 1) * 32 + (swz % 64) / 2; }
__host__ __device__ __forceinline__ int perm32(int rho) { const int n = rho >> 4, i = rho & 15; return 8 * (i >> 2) + 4 * n + (i & 3); }
__device__ __forceinline__ int pg8_lane_id() { int l; asm volatile("v_mbcnt_lo_u32_b32 %0, -1, 0\n\tv_mbcnt_hi_u32_b32 %0, -1, %0" : "=v"(l)); return l; }
struct Unit { int pm, pn; };
struct Gemm { const GAS bf16_t* A; const GAS bf16_t* Bt; int M, N, K, lda, ldb; };
struct StaticOrder {
    int nM, nN, nwg, G, c;
    __host__ __device__ void init(int M, int N, int G_, int c_) { nM = M / BM; nN = N / BM; nwg = nM * nN; G = G_; c = c_; }
    __host__ __device__ bool next(int i, Unit& u) const {
        const long L = (long)i * G + c; if (L >= nwg) return false;
        int wgid = (int)L; { const int q = nwg / NXCD, r = nwg % NXCD, xcd = wgid % NXCD, off = wgid / NXCD; wgid = (xcd < r ? xcd * (q + 1) : r * (q + 1) + (xcd - r) * q) + off; }
        const int nig = WGM * nN, gid = wgid / nig, fm = gid * WGM, gsz = (nM - fm) < WGM ? (nM - fm) : WGM;
        u.pm = fm + ((wgid % nig) % gsz); u.pn = (wgid % nig) / gsz; return true;
    }
    __device__ __forceinline__ void a_ready(const Unit&) const {}
    __device__ __forceinline__ void done(const Unit&) const {}
};
__device__ __forceinline__ unsigned cvt_pk_bf16(float lo, float hi) { unsigned r; asm volatile("v_cvt_pk_bf16_f32 %0, %1, %2" : "=v"(r) : "v"(lo), "v"(hi)); return r; }

struct EpiF32 {
    static constexpr bool PERM = false, AFTER_DRAIN = false;
    GAS float* C; int ldc; int nvalid; int accum;
    __device__ __forceinline__ void operator()(const f32x4 (&acc)[2][2][4][2], const Unit& u, int wr, int wc, int fr, int fq) const {
        { const int l_ = pg8_lane_id(); fr = l_ & 15; fq = l_ >> 4; }
#pragma unroll
        for (int ai = 0; ai < 2; ++ai)
#pragma unroll
            for (int m = 0; m < 4; ++m) { const size_t row = (size_t)u.pm * BM + ai * HALF + wr * 64 + m * 16 + fr;
#pragma unroll
                for (int bj = 0; bj < 2; ++bj)
#pragma unroll
                    for (int n = 0; n < 2; ++n) { const int col = u.pn * BM + bj * HALF + wc * 32 + n * 16 + 4 * fq;
                        if (col < nvalid) { GAS float* p = C + row * ldc + col; f32x4 v = acc[ai][bj][m][n]; if (accum) v += *(const GAS f32x4*)p; *(GAS f32x4*)p = v; } } }
    }
};
struct EpiBf16 {
    static constexpr bool PERM = true, AFTER_DRAIN = false;
    GAS bf16_t* O; int ldc; int nvalid; const GAS float* ssq; int np;
    __device__ __forceinline__ void operator()(const f32x4 (&acc)[2][2][4][2], const Unit& u, int wr, int wc, int fr, int fq) const {
        { const int l_ = pg8_lane_id(); fr = l_ & 15; fq = l_ >> 4; }
#pragma unroll
        for (int ai = 0; ai < 2; ++ai)
#pragma unroll
            for (int m = 0; m < 4; ++m) { const size_t row = (size_t)u.pm * BM + ai * HALF + wr * 64 + m * 16 + fr;
                float rs_ = 1.f;
                if (np > 0) { const GAS f32x4* sp = (const GAS f32x4*)(ssq + row * 16); f32x4 t = sp[0] + sp[1]; if (np > 8) t += sp[2] + sp[3]; rs_ = __builtin_amdgcn_rsqf(((t[0] + t[1]) + (t[2] + t[3])) * (1.f / 1024.f) + 1e-6f); }
#pragma unroll
                for (int bj = 0; bj < 2; ++bj) { const int col = u.pn * BM + bj * HALF + wc * 32 + 8 * fq;
                    if (col < nvalid) { const f32x4 v0 = acc[ai][bj][m][0] * rs_, v1 = acc[ai][bj][m][1] * rs_; u32x4 w; w.x = cvt_pk_bf16(v0[0], v0[1]); w.y = cvt_pk_bf16(v0[2], v0[3]); w.z = cvt_pk_bf16(v1[0], v1[1]); w.w = cvt_pk_bf16(v1[2], v1[3]);
                        *(GAS u32x4*)(O + row * ldc + col) = w; } } }
    }
};
struct EpiUp {
    static constexpr bool PERM = true, AFTER_DRAIN = false;
    GAS bf16_t* O; GAS bf16_t* O2; int ldc; int nvalid; const GAS float* rs; int rsi; int mode;
    __device__ __forceinline__ void operator()(const f32x4 (&acc)[2][2][4][2], const Unit& u, int wr, int wc, int fr, int fq) const {
        { const int l_ = pg8_lane_id(); fr = l_ & 15; fq = l_ >> 4; }
#pragma unroll
        for (int ai = 0; ai < 2; ++ai)
#pragma unroll
            for (int m = 0; m < 4; ++m) { const size_t row = (size_t)u.pm * BM + ai * HALF + wr * 64 + m * 16 + fr; const float s = rs[2 * row + rsi];
#pragma unroll
                for (int bj = 0; bj < 2; ++bj) { const int col = u.pn * BM + bj * HALF + wc * 32 + 8 * fq;
                    if (col < nvalid) { const f32x4 v0 = acc[ai][bj][m][0] * s, v1 = acc[ai][bj][m][1] * s; u32x4 w; w.x = cvt_pk_bf16(v0[0], v0[1]); w.y = cvt_pk_bf16(v0[2], v0[3]); w.z = cvt_pk_bf16(v1[0], v1[1]); w.w = cvt_pk_bf16(v1[2], v1[3]);
                        GAS bf16_t* dst;
                        if (mode == 0) dst = O + row * ldc + col;
                        else { const int h = col >> 7, j = col & 127; dst = (j < 64) ? O + row * 384 + h * 96 + j : O2 + row * 256 + h * 64 + (j - 64); }
                        *(GAS u32x4*)dst = w; } } }
    }
};

struct EpiRes {
    static constexpr bool PERM = true, AFTER_DRAIN = false;
    GAS bf16_t* XB; GAS float* SSQ;
    __device__ __forceinline__ void operator()(const f32x4 (&acc)[2][2][4][2], const Unit& u, int wr, int wc, int fr, int fq) const {
        { const int l_ = pg8_lane_id(); fr = l_ & 15; fq = l_ >> 4; }
#pragma unroll
        for (int ai = 0; ai < 2; ++ai)
#pragma unroll
            for (int m = 0; m < 4; ++m) { const size_t row = (size_t)u.pm * BM + ai * HALF + wr * 64 + m * 16 + fr; float ss = 0.f;
#pragma unroll
                for (int bj = 0; bj < 2; ++bj) { GAS u32x4* p = (GAS u32x4*)(XB + row * 1024 + u.pn * BM + bj * HALF + wc * 32 + 8 * fq);
                    const u32x4 o = *p; const f32x4 v0 = acc[ai][bj][m][0], v1 = acc[ai][bj][m][1];
                    u32x4 w;
                    w.x = cvt_pk_bf16(__builtin_bit_cast(float, o.x << 16) + v0[0], __builtin_bit_cast(float, o.x & 0xffff0000u) + v0[1]);
                    w.y = cvt_pk_bf16(__builtin_bit_cast(float, o.y << 16) + v0[2], __builtin_bit_cast(float, o.y & 0xffff0000u) + v0[3]);
                    w.z = cvt_pk_bf16(__builtin_bit_cast(float, o.z << 16) + v1[0], __builtin_bit_cast(float, o.z & 0xffff0000u) + v1[1]);
                    w.w = cvt_pk_bf16(__builtin_bit_cast(float, o.w << 16) + v1[2], __builtin_bit_cast(float, o.w & 0xffff0000u) + v1[3]);
                    *p = w;
#pragma unroll
                    for (int e = 0; e < 4; ++e) { const float a = __builtin_bit_cast(float, w[e] << 16), b = __builtin_bit_cast(float, w[e] & 0xffff0000u); ss += a * a + b * b; } }
                { float a = ss, b = ss; asm volatile("v_nop\n\tv_nop\n\tv_permlane16_swap_b32 %0, %1" : "+v"(a), "+v"(b)); ss = a + b; }
                { float a = ss, b = ss; asm volatile("v_nop\n\tv_nop\n\tv_permlane32_swap_b32 %0, %1" : "+v"(a), "+v"(b)); ss = a + b; }
                if (fq == 0) SSQ[row * 16 + 4 * u.pn + wc] = ss; }
    }
};
template <class Epi, class Sched, bool ALIGN_EPI = false, bool SP2 = false>
__device__ __forceinline__ void gemm_phase(PG8_LAS unsigned char* lds, const Gemm g, const Sched& S, const Epi& E, int wave_id) {
    int tid_ = (wave_id << 6) | pg8_lane_id(); asm volatile("" : "+v"(tid_));
    const int tid = tid_, wid = __builtin_amdgcn_readfirstlane(tid >> 6), lane = tid & 63, wr = wid >> 2, wc = wid & 3, fr = lane & 15, fq = lane >> 4;
    const int K = g.K, nt = K / BK;
    unsigned voffA[2], voffB[2];
#pragma unroll
    for (int i = 0; i < 2; ++i) { int R, C; stage_rc(tid * 16 + i * 8192, R, C); const int Rb = Epi::PERM ? ((R & ~31) + perm32(R & 31)) : R;
        voffA[i] = (unsigned)(R * g.lda + C) * 2u; voffB[i] = (unsigned)(Rb * g.ldb + C) * 2u; }
    const size_t kstep = (size_t)(BK * 2);
    const size_t hstepA = (size_t)HALF * g.lda * 2, hstepB = (size_t)HALF * g.ldb * 2;
    const size_t tstepA = 2 * hstepA, tstepB = 2 * hstepB;
    const unsigned ldsw = (unsigned)wid * 1024u;
    const int aoff = lds_byte(wr * 64 + fr, fq * 8), boff = lds_byte(wc * 32 + fr, fq * 8);
#define PG8_SA(b, h) (((b) * 2 + (h)) * HTB)
#define PG8_SB(b, h) ((4 + (b) * 2 + (h)) * HTB)
#define PG8_STAGE(bufoff, gbase, voff) do { _Pragma("unroll") for (int _i = 0; _i < 2; ++_i) \
        __builtin_amdgcn_global_load_lds((const unsigned*)((const char*)(gbase) + (voff)[_i]), (PG8_LAS unsigned*)(lds + (bufoff) + ldsw + _i * 8192), 16, 0, 0); } while (0)
#define PG8_LDA(dst, b, h) do { _Pragma("unroll") for (int m = 0; m < 4; ++m) _Pragma("unroll") for (int k = 0; k < 2; ++k) dst[m][k] = *(const PG8_LAS bf16x8*)(lds + PG8_SA(b, h) + aoff + m * 2048 + k * 1024); } while (0)
#define PG8_LDB(dst, b, h) do { _Pragma("unroll") for (int n = 0; n < 2; ++n) _Pragma("unroll") for (int k = 0; k < 2; ++k) dst[n][k] = *(const PG8_LAS bf16x8*)(lds + PG8_SB(b, h) + boff + n * 2048 + k * 1024); } while (0)
#define PG8_MMA(ai, bj, At, Bt) do { __builtin_amdgcn_s_setprio(1); _Pragma("unroll") for (int m = 0; m < 4; ++m) _Pragma("unroll") for (int n = 0; n < 2; ++n) _Pragma("unroll") for (int k = 0; k < 2; ++k) \
        acc[ai][bj][m][n] = __builtin_amdgcn_mfma_f32_16x16x32_bf16(Bt[n][k], At[m][k], acc[ai][bj][m][n], 0, 0, 0); __builtin_amdgcn_s_setprio(0); } while (0)
#define PG8_WAIT_V(n) asm volatile("s_waitcnt vmcnt(" #n ")" ::: "memory")
#define PG8_WAIT_L(n) asm volatile("s_waitcnt lgkmcnt(" #n ")" ::: "memory")
#define PG8_BAR __builtin_amdgcn_s_barrier()
#define PG8_SCHED __builtin_amdgcn_sched_barrier(0)
    Unit cur, nxt; int ui = 0;
    if (!S.next(0, cur)) return;
    f32x4 acc[2][2][4][2];
#pragma unroll
    for (int a = 0; a < 2; ++a)
#pragma unroll
        for (int b = 0; b < 2; ++b)
#pragma unroll
            for (int m = 0; m < 4; ++m)
#pragma unroll
                for (int n = 0; n < 2; ++n) acc[a][b][m][n] = (f32x4){0.f, 0.f, 0.f, 0.f};
    bf16x8 At[4][2], B0[2][2], B1[2][2];
    const char* cA = (const char*)g.A + (size_t)cur.pm * tstepA; const char* cB = (const char*)g.Bt + (size_t)cur.pn * tstepB;
    S.a_ready(cur);
    if constexpr (SP2) {
        PG8_STAGE(PG8_SB(0, 0), cB, voffB); PG8_STAGE(PG8_SB(0, 1), cB + hstepB, voffB); PG8_STAGE(PG8_SA(0, 0), cA, voffA); PG8_STAGE(PG8_SA(0, 1), cA + hstepA, voffA);
        if (wr == 1) PG8_BAR;
        PG8_WAIT_V(2); PG8_BAR;
        PG8_STAGE(PG8_SB(1, 0), cB + kstep, voffB); PG8_STAGE(PG8_SA(1, 0), cA + kstep, voffA); PG8_STAGE(PG8_SB(1, 1), cB + hstepB + kstep, voffB);
        PG8_WAIT_V(6); PG8_BAR;
    } else {
        PG8_STAGE(PG8_SB(0, 0), cB, voffB); PG8_STAGE(PG8_SA(0, 0), cA, voffA); PG8_STAGE(PG8_SB(0, 1), cB + hstepB, voffB); PG8_STAGE(PG8_SA(0, 1), cA + hstepA, voffA);
        if (wr == 1) PG8_BAR;
        PG8_WAIT_V(4); PG8_BAR;
        PG8_STAGE(PG8_SB(1, 0), cB + kstep, voffB); PG8_STAGE(PG8_SA(1, 0), cA + kstep, voffA); PG8_STAGE(PG8_SB(1, 1), cB + hstepB + kstep, voffB);
        PG8_WAIT_V(6); PG8_BAR;
    }
    for (;;) {
        const bool has_next = S.next(ui + 1, nxt);
        const char* nA = has_next ? (const char*)g.A + (size_t)nxt.pm * tstepA : cA; const char* nB = has_next ? (const char*)g.Bt + (size_t)nxt.pn * tstepB : cB;
        for (int t = 0; t < nt; t += 2) {
            const bool last = (t == nt - 2);
            const char* a1 = cA + (size_t)(t + 1) * kstep;
            const char* a2 = last ? nA : cA + (size_t)(t + 2) * kstep; const char* b2 = last ? nB : cB + (size_t)(t + 2) * kstep;
            const char* a3 = a2 + kstep; const char* b3 = b2 + kstep;
            if (last && has_next) S.a_ready(nxt);
            if constexpr (SP2) {
            PG8_LDB(B0, 0, 0); PG8_LDB(B1, 0, 1); PG8_SCHED; PG8_LDA(At, 0, 0); PG8_STAGE(PG8_SA(1, 1), a1 + hstepA, voffA);
            PG8_WAIT_V(8); PG8_WAIT_L(0); PG8_BAR; PG8_MMA(0, 0, At, B0); PG8_MMA(0, 1, At, B1); PG8_BAR; PG8_SCHED;
            PG8_LDA(At, 0, 1); PG8_STAGE(PG8_SB(0, 0), b2, voffB); PG8_STAGE(PG8_SB(0, 1), b2 + hstepB, voffB); PG8_STAGE(PG8_SA(0, 0), a2, voffA);
            PG8_WAIT_V(8); PG8_WAIT_L(0); PG8_BAR; PG8_MMA(1, 0, At, B0); PG8_MMA(1, 1, At, B1); PG8_BAR; PG8_SCHED;
            PG8_LDB(B0, 1, 0); PG8_LDB(B1, 1, 1); PG8_SCHED; PG8_LDA(At, 1, 0); PG8_STAGE(PG8_SA(0, 1), a2 + hstepA, voffA);
            PG8_WAIT_V(8); PG8_WAIT_L(0); PG8_BAR; PG8_MMA(0, 0, At, B0); PG8_MMA(0, 1, At, B1); PG8_BAR; PG8_SCHED;
            PG8_LDA(At, 1, 1); PG8_STAGE(PG8_SB(1, 0), b3, voffB); PG8_STAGE(PG8_SB(1, 1), b3 + hstepB, voffB); PG8_STAGE(PG8_SA(1, 0), a3, voffA);
            PG8_WAIT_V(8); PG8_WAIT_L(0); PG8_BAR; PG8_MMA(1, 0, At, B0); PG8_MMA(1, 1, At, B1); PG8_BAR; PG8_SCHED;
            } else {
            PG8_LDB(B0, 0, 0); PG8_SCHED; PG8_LDA(At, 0, 0); PG8_STAGE(PG8_SA(1, 1), a1 + hstepA, voffA);
            PG8_WAIT_L(8); PG8_BAR; PG8_WAIT_L(0); PG8_MMA(0, 0, At, B0); PG8_BAR; PG8_SCHED;
            PG8_LDB(B1, 0, 1); PG8_STAGE(PG8_SB(0, 0), b2, voffB);
            PG8_BAR; PG8_WAIT_L(0); PG8_MMA(0, 1, At, B1); PG8_BAR;
            PG8_LDA(At, 0, 1); PG8_STAGE(PG8_SA(0, 0), a2, voffA);
            PG8_BAR; PG8_WAIT_L(0); PG8_MMA(1, 0, At, B0); PG8_BAR; PG8_SCHED;
            PG8_STAGE(PG8_SB(0, 1), b2 + hstepB, voffB);
            PG8_WAIT_V(6); PG8_BAR; PG8_MMA(1, 1, At, B1); PG8_BAR;
            PG8_LDB(B0, 1, 0); PG8_SCHED; PG8_LDA(At, 1, 0); PG8_STAGE(PG8_SA(0, 1), a2 + hstepA, voffA);
            PG8_WAIT_L(8); PG8_BAR; PG8_WAIT_L(0); PG8_MMA(0, 0, At, B0); PG8_BAR; PG8_SCHED;
            PG8_LDB(B1, 1, 1); PG8_STAGE(PG8_SB(1, 0), b3, voffB);
            PG8_BAR; PG8_WAIT_L(0); PG8_MMA(0, 1, At, B1); PG8_BAR;
            PG8_LDA(At, 1, 1); PG8_STAGE(PG8_SA(1, 0), a3, voffA);
            PG8_BAR; PG8_WAIT_L(0); PG8_MMA(1, 0, At, B0); PG8_BAR; PG8_SCHED;
            PG8_STAGE(PG8_SB(1, 1), b3 + hstepB, voffB);
            PG8_WAIT_V(6); PG8_BAR; PG8_MMA(1, 1, At, B1); PG8_BAR;
            }
        }
        if constexpr (ALIGN_EPI) { if (wr == 0) PG8_BAR; }
        if constexpr (!Epi::AFTER_DRAIN) { E(acc, cur, wr, wc, fr, fq); S.done(cur); }
        if (!has_next) break;
#pragma unroll
        for (int a = 0; a < 2; ++a)
#pragma unroll
            for (int b = 0; b < 2; ++b)
#pragma unroll
                for (int m = 0; m < 4; ++m)
#pragma unroll
                    for (int n = 0; n < 2; ++n) acc[a][b][m][n] = (f32x4){0.f, 0.f, 0.f, 0.f};
        cur = nxt; cA = nA; cB = nB; ++ui;
        if constexpr (ALIGN_EPI) { if (wr == 1) PG8_BAR; }
    }
    PG8_WAIT_V(0);
    if constexpr (!ALIGN_EPI) { if (wr == 0) PG8_BAR; }
    PG8_BAR;
    if constexpr (Epi::AFTER_DRAIN) { E.fused(acc, cur, wr, wc, fr, fq, lds, wid, lane); S.done(cur); }
#undef PG8_SA
#undef PG8_SB
#undef PG8_STAGE
#undef PG8_LDA
#undef PG8_LDB
#undef PG8_MMA
#undef PG8_WAIT_V
#undef PG8_WAIT_L
#undef PG8_BAR
#undef PG8_SCHED
}
}

namespace mk {
#ifndef GAS
#define GAS __attribute__((address_space(1)))
#endif
#define LAS __attribute__((address_space(3)))
typedef unsigned short bf16;
typedef unsigned v4u __attribute__((ext_vector_type(4)));
typedef unsigned v2u __attribute__((ext_vector_type(2)));
typedef float f32x4 __attribute__((ext_vector_type(4)));
typedef GAS unsigned gu32;
#define LDS_WAIT() asm volatile("s_waitcnt lgkmcnt(0)" ::: "memory")
#define VM_WAIT() asm volatile("s_waitcnt vmcnt(0)" ::: "memory")
__device__ __forceinline__ unsigned f2bf_(float f) { unsigned u = __builtin_bit_cast(unsigned, f); return (u + 0x7fffu + ((u >> 16) & 1u)) >> 16; }
__device__ __forceinline__ unsigned pk2(float lo, float hi) { return f2bf_(lo) | (f2bf_(hi) << 16); }
__device__ __forceinline__ float bflo(unsigned w) { return __builtin_bit_cast(float, w << 16); }
__device__ __forceinline__ float bfhi(unsigned w) { return __builtin_bit_cast(float, w & 0xffff0000u); }

template <class P> __device__ __forceinline__ P* opq(P* p) { asm volatile("" : "+s"(p)); return p; }
__device__ __forceinline__ int opqi(int k) { asm volatile("" : "+s"(k)); return k; }
__device__ __forceinline__ float shx(float v, int o, int lane) { return __builtin_bit_cast(float, __builtin_amdgcn_ds_bpermute((lane ^ o) << 2, __builtin_bit_cast(int, v))); }
__device__ __forceinline__ int shxi(int v, int o, int lane) { return __builtin_amdgcn_ds_bpermute((lane ^ o) << 2, v); }
__device__ __forceinline__ int lane_id_v() { int l; asm volatile("v_mbcnt_lo_u32_b32 %0, -1, 0\n\tv_mbcnt_hi_u32_b32 %0, -1, %0" : "=v"(l)); return l; }
constexpr int NWAVES = 8;
constexpr int D = 1024, NB = 4, S = 8192, T = NB * S, L = 4, MEM = 256, INW = 2144, INP = 2304;
constexpr int PC_CQ = 0, PC_CKV = 256, PC_KR = 384, PC_XL = 512, PC_GL = 1024, PC_QD = 1536, PC_KD = 1792, PC_VD = 2048;
constexpr float LOG2E = 1.4426950408889634f;
constexpr size_t MiB = 1u << 20;
constexpr size_t WS_CTL = 0, CTL_ZERO_BYTES = 1 * MiB;
constexpr size_t WS_WIN = 1 * MiB, WS_WOUT = 19 * MiB, WS_WCQ = 27 * MiB, WS_WCO = 35 * MiB, WS_WPQ = 43 * MiB, WS_WCKV = 51 * MiB, WS_WUQ = 67 * MiB, WS_WUKV = 68 * MiB, WS_KEYS = 69 * MiB, WS_ROPE = 70 * MiB;
constexpr size_t WS_XNB = 76 * MiB, WS_YB = 140 * MiB, WS_PROJB = 204 * MiB, WS_QMB = 348 * MiB, WS_KMB = 372 * MiB, WS_VMB = 396 * MiB, WS_RS = 412 * MiB;
constexpr size_t WS_HLB = 413 * MiB, WS_ACB = 445 * MiB, WS_LSUM = 477 * MiB, WS_OMB = 478 * MiB, WS_MNB = 494 * MiB, WS_KVCB = 502 * MiB, WS_EX = 518 * MiB, WS_GW = 534 * MiB;
constexpr size_t WS_U8 = 550 * MiB, WS_V8 = 614 * MiB, WS_SU = 678 * MiB, WS_SV = 679 * MiB;
constexpr size_t WS_HQ = 680 * MiB, WS_P = 712 * MiB, WS_SH = 728 * MiB, WS_W = 729 * MiB, WS_WS = 745 * MiB, WS_SSQ = 746 * MiB, WS_END = 748 * MiB;
constexpr size_t WS_WAT = 74 * MiB;
constexpr size_t WS_BTAB = WS_KEYS + 512 * 1024, WS_LAMS = WS_BTAB + 4096, WS_SP = WS_LAMS + 4096;
constexpr int CW_BAR = 4096, CW_RANK = 8192;
constexpr int RING_OFF = 0, RING_BYTES = 155648, LDSCTL_OFF = RING_BYTES, MISC_OFF = LDSCTL_OFF + 320, LDS_BYTES = 163840;

#define XB_TMO      128
#define XB_XCNT(j)  (256  + 64 * (j))
#define XB_XSUB(j)  (1280 + 64 * (j))
#define XB_XGEN(j)  (2304 + 64 * (j))
#define XB_TOP      3328
#define XB_TOPGEN   3392
#define XCD_BAR_WORDS 3456
#define XB_SPIN_CAP (1u << 18)

__device__ __forceinline__ unsigned xb_ld(unsigned* p)              { return __hip_atomic_load(p, __ATOMIC_RELAXED, __HIP_MEMORY_SCOPE_AGENT); }
__device__ __forceinline__ unsigned xb_add(unsigned* p, unsigned v) { return __hip_atomic_fetch_add(p, v, __ATOMIC_RELAXED, __HIP_MEMORY_SCOPE_AGENT); }
__device__ __forceinline__ unsigned xb_xcc_id() { return (unsigned)__builtin_amdgcn_s_getreg((3 << 11) | 20) & 0xFu; }
#define XB_SPIN(cond, bar) do { unsigned _sp = 0; while (cond) { __builtin_amdgcn_s_sleep(1); \
    if ((++_sp & 255u) == 0u) { if (xb_ld(&(bar)[XB_TMO])) break; if (_sp > XB_SPIN_CAP) { atomicAdd(&(bar)[XB_TMO], 1u); break; } } } } while (0)

struct XcdBarrier {
    unsigned* bar; unsigned x;
    volatile LAS unsigned* st;
};

__device__ __forceinline__ XcdBarrier xcd_barrier_post(unsigned* bar, volatile LAS unsigned* st) {
    XcdBarrier b; b.bar = bar; b.x = xb_xcc_id(); b.st = st;
    if (threadIdx.x == 0) (void)xb_add(&bar[XB_XCNT(b.x)], 1u);
    return b;
}
__device__ __forceinline__ void xcd_barrier_complete(unsigned* bar, unsigned x, unsigned& nloc, unsigned& nx) {
    const unsigned G = gridDim.x * gridDim.y * gridDim.z;
    unsigned sum, cnt, mine, sp = 0u;
    for (;;) {
        sum = 0u; cnt = 0u; mine = 0u;
#pragma unroll
        for (unsigned j = 0; j < 16; ++j) { const unsigned c = xb_ld(&bar[XB_XCNT(j)]); sum += c; cnt += (c > 0u) ? 1u : 0u; mine = (j == x) ? c : mine; }
        if (sum == G) break;
        __builtin_amdgcn_s_sleep(1);
        if ((++sp & 255u) == 0u) { if (xb_ld(&bar[XB_TMO])) break; if (sp > XB_SPIN_CAP) { atomicAdd(&bar[XB_TMO], 1u); break; } }
    }
    nloc = mine > 0u ? mine : 1u; nx = cnt > 0u ? cnt : 1u;
}

__device__ __noinline__ void xcd_barrier_impl(unsigned* bar_, unsigned x_, volatile LAS unsigned* st_, int leader_) {
    XcdBarrier b; b.bar = bar_; b.x = x_; b.st = st_;
    asm volatile("s_waitcnt vmcnt(0)" ::: "memory");
    __syncthreads();
    if (leader_) {
        unsigned* bar = b.bar;
        __builtin_amdgcn_s_waitcnt(0);
        unsigned nloc = b.st[0], nx = b.st[1];
        if (nloc == 0u) { xcd_barrier_complete(bar, b.x, nloc, nx); b.st[0] = nloc; b.st[1] = nx; }
        const unsigned old = xb_add(&bar[XB_XSUB(b.x)], 1u);
        const unsigned gen = old / nloc;
        if (old + 1u == (gen + 1u) * nloc) {
            __builtin_amdgcn_fence(__ATOMIC_RELEASE, "agent");
            asm volatile("s_waitcnt vmcnt(0)" ::: "memory");
            const unsigned og = xb_add(&bar[XB_TOP], 1u);
            const unsigned tg = og / nx;
            if (og + 1u == (tg + 1u) * nx) xb_add(&bar[XB_TOPGEN], 1u);
            else XB_SPIN(xb_ld(&bar[XB_TOPGEN]) == tg, bar);
            __builtin_amdgcn_fence(__ATOMIC_ACQUIRE, "agent");
            xb_add(&bar[XB_XGEN(b.x)], 1u);
            asm volatile("s_waitcnt vmcnt(0)" ::: "memory");
        } else {
            XB_SPIN(xb_ld(&bar[XB_XGEN(b.x)]) == gen, bar);
            __builtin_amdgcn_fence(__ATOMIC_ACQUIRE, "agent");
            asm volatile("s_waitcnt vmcnt(0)" ::: "memory");
        }
    }
    __syncthreads();
}
__device__ __forceinline__ void xcd_barrier(const XcdBarrier& b, int leader) { xcd_barrier_impl(b.bar, b.x, b.st, leader); }


__device__ __forceinline__ float wave_sum(float v, int lane) {
    (void)lane;
    v += __builtin_bit_cast(float, __builtin_amdgcn_update_dpp(0, __builtin_bit_cast(int, v), 0xB1, 0xF, 0xF, true));
    v += __builtin_bit_cast(float, __builtin_amdgcn_update_dpp(0, __builtin_bit_cast(int, v), 0x4E, 0xF, 0xF, true));
    v += __builtin_bit_cast(float, __builtin_amdgcn_update_dpp(0, __builtin_bit_cast(int, v), 0x141, 0xF, 0xF, true));
    v += __builtin_bit_cast(float, __builtin_amdgcn_update_dpp(0, __builtin_bit_cast(int, v), 0x140, 0xF, 0xF, true));
    { float a = v, b = v; asm volatile("v_nop\n\tv_nop\n\tv_permlane16_swap_b32 %0, %1" : "+v"(a), "+v"(b)); v = a + b; }
    { float a = v, b = v; asm volatile("v_nop\n\tv_nop\n\tv_permlane32_swap_b32 %0, %1" : "+v"(a), "+v"(b)); v = a + b; }
    return v;
}
__device__ __forceinline__ float wave_max(float v) {
    v = fmaxf(v, __builtin_bit_cast(float, __builtin_amdgcn_update_dpp(0, __builtin_bit_cast(int, v), 0xB1, 0xF, 0xF, true)));
    v = fmaxf(v, __builtin_bit_cast(float, __builtin_amdgcn_update_dpp(0, __builtin_bit_cast(int, v), 0x4E, 0xF, 0xF, true)));
    v = fmaxf(v, __builtin_bit_cast(float, __builtin_amdgcn_update_dpp(0, __builtin_bit_cast(int, v), 0x141, 0xF, 0xF, true)));
    v = fmaxf(v, __builtin_bit_cast(float, __builtin_amdgcn_update_dpp(0, __builtin_bit_cast(int, v), 0x140, 0xF, 0xF, true)));
    { float a = v, b = v; asm volatile("v_nop\n\tv_nop\n\tv_permlane16_swap_b32 %0, %1" : "+v"(a), "+v"(b)); v = fmaxf(a, b); }
    { float a = v, b = v; asm volatile("v_nop\n\tv_nop\n\tv_permlane32_swap_b32 %0, %1" : "+v"(a), "+v"(b)); v = fmaxf(a, b); }
    return v;
}
__device__ __forceinline__ float gelu_erf(float v) {
    const float av = __builtin_fabsf(v), t = __builtin_amdgcn_rcpf(av * 0.2316418882f + 1.0f);
    float q = t * 0.5307027145f + (-0.7265760135f); q = q * t + 0.7107068705f; q = q * t + (-0.142248368f); q = q * t + 0.127414796f; q = q * t;
    const float e = __builtin_amdgcn_exp2f((v * v) * (-0.72134752044f));
    const float m = v * (q * e);
    return v < 0.f ? m : v - m;
}

__device__ __forceinline__ void norm_phase(const GAS float* X, const GAS float* g, GAS bf16* out, int rows, int gw, int NGW, int lane) {
    asm volatile("" : "+v"(lane));
    f32x4 gv[4];
#pragma unroll
    for (int j = 0; j < 4; ++j) gv[j] = ((const GAS f32x4*)g)[lane + 64 * j];
    for (int m = gw; m < rows; m += NGW) {
        const GAS f32x4* xr = (const GAS f32x4*)(X + (size_t)m * D) + lane;
        f32x4 v[4]; float s = 0.f;
#pragma unroll
        for (int j = 0; j < 4; ++j) { v[j] = xr[64 * j]; s += (v[j].x * v[j].x + v[j].y * v[j].y) + (v[j].z * v[j].z + v[j].w * v[j].w); }
        const float rs = rsqrtf(wave_sum(s, lane) * (1.f / D) + 1e-6f);
        GAS v2u* o8 = (GAS v2u*)(out + (size_t)m * D) + lane;
#pragma unroll
        for (int j = 0; j < 4; ++j) { v2u w; w.x = pk2(v[j].x * rs * gv[j].x, v[j].y * rs * gv[j].y); w.y = pk2(v[j].z * rs * gv[j].z, v[j].w * rs * gv[j].w); o8[64 * j] = w; }
    }
}
__device__ __forceinline__ void hq_phase(const GAS bf16* XB, const GAS float* SSQ, const GAS float* g, GAS unsigned char* HQ, GAS float* SH, GAS int* Pz, int gw, int NGW, int lane) {
    asm volatile("" : "+v"(lane));
    const GAS f32x4* gp = (const GAS f32x4*)g + 4 * lane; const f32x4 g0 = gp[0], g1 = gp[1], g2 = gp[2], g3 = gp[3];
    for (int m = gw; m < T; m += NGW) {
        const GAS f32x4* sp = (const GAS f32x4*)(SSQ + (size_t)m * 16); const f32x4 t = (sp[0] + sp[1]) + (sp[2] + sp[3]);
        const float rs = __builtin_amdgcn_rsqf(((t[0] + t[1]) + (t[2] + t[3])) * (1.f / 1024.f) + 1e-6f);
        const v4u a = *(const GAS v4u*)(XB + (size_t)m * D + 16 * lane), b = *(const GAS v4u*)(XB + (size_t)m * D + 16 * lane + 8);
        float f[16] = {bflo(a.x) * g0[0], bfhi(a.x) * g0[1], bflo(a.y) * g0[2], bfhi(a.y) * g0[3], bflo(a.z) * g1[0], bfhi(a.z) * g1[1], bflo(a.w) * g1[2], bfhi(a.w) * g1[3],
                       bflo(b.x) * g2[0], bfhi(b.x) * g2[1], bflo(b.y) * g2[2], bfhi(b.y) * g2[3], bflo(b.z) * g3[0], bfhi(b.z) * g3[1], bflo(b.w) * g3[2], bfhi(b.w) * g3[3]};
        float mx = 0.f;
#pragma unroll
        for (int i = 0; i < 16; ++i) { f[i] *= rs; mx = fmaxf(mx, __builtin_fabsf(f[i])); }
        mx = wave_max(mx);
        const float inv = mx > 0.f ? 127.f / mx : 0.f;
        v4u q;
#pragma unroll
        for (int i = 0; i < 4; ++i) { const int ia = (int)__builtin_rintf(f[4 * i] * inv), ib = (int)__builtin_rintf(f[4 * i + 1] * inv), ic = (int)__builtin_rintf(f[4 * i + 2] * inv), id = (int)__builtin_rintf(f[4 * i + 3] * inv);
            q[i] = (unsigned)(ia & 255) | ((unsigned)(ib & 255) << 8) | ((unsigned)(ic & 255) << 16) | ((unsigned)(id & 255) << 24); }
        *(GAS v4u*)(HQ + (size_t)m * D + 16 * lane) = q;
        if (lane == 0) SH[m] = mx * (1.f / 127.f);
    }
}
__device__ __forceinline__ void x0_phase(const GAS float* X, GAS bf16* XB, GAS float* SSQ, int gw, int NGW, int lane) {
    asm volatile("" : "+v"(lane));
    for (int m = gw; m < T; m += NGW) {
        const GAS f32x4* xr = (const GAS f32x4*)(X + (size_t)m * D) + lane; GAS v2u* o8 = (GAS v2u*)(XB + (size_t)m * D) + lane;
        float s = 0.f;
#pragma unroll
        for (int j = 0; j < 4; ++j) { const f32x4 v = xr[64 * j]; s += (v.x * v.x + v.y * v.y) + (v.z * v.z + v.w * v.w); v2u w; w.x = pk2(v.x, v.y); w.y = pk2(v.z, v.w); o8[64 * j] = w; }
        s = wave_sum(s, lane);
        if (lane < 8) SSQ[(size_t)m * 16 + lane] = lane == 0 ? s : 0.f;
    }
}
__device__ __forceinline__ void final_norm_phase(const GAS bf16* XB, GAS float* O, const GAS float* g, int rows, int gw, int NGW, int lane) {
    asm volatile("" : "+v"(lane));
    for (int m = gw; m < rows; m += NGW) {
        const GAS v4u* xr = (const GAS v4u*)(XB + (size_t)m * D) + lane;
        v4u v[2]; float s = 0.f;
#pragma unroll
        for (int j = 0; j < 2; ++j) { v[j] = xr[64 * j];
#pragma unroll
            for (int e = 0; e < 4; ++e) { const float a = bflo(v[j][e]), b = bfhi(v[j][e]); s += a * a + b * b; } }
        const float rs = rsqrtf(wave_sum(s, lane) * (1.f / D) + 1e-6f);
#pragma unroll
        for (int j = 0; j < 2; ++j) { const int c = 8 * (lane + 64 * j); const f32x4 g0 = *(const GAS f32x4*)(g + c), g1 = *(const GAS f32x4*)(g + c + 4);
            f32x4 o0, o1; o0.x = bflo(v[j].x) * rs * g0.x; o0.y = bfhi(v[j].x) * rs * g0.y; o0.z = bflo(v[j].y) * rs * g0.z; o0.w = bfhi(v[j].y) * rs * g0.w;
            o1.x = bflo(v[j].z) * rs * g1.x; o1.y = bfhi(v[j].z) * rs * g1.y; o1.z = bflo(v[j].w) * rs * g1.z; o1.w = bfhi(v[j].w) * rs * g1.w;
            *(GAS f32x4*)(O + (size_t)m * D + c) = o0; *(GAS f32x4*)(O + (size_t)m * D + c + 4) = o1; }
    }
}

__device__ __forceinline__ float row16_sum(float v) {
    v += __builtin_bit_cast(float, __builtin_amdgcn_update_dpp(0, __builtin_bit_cast(int, v), 0xB1, 0xF, 0xF, true));
    v += __builtin_bit_cast(float, __builtin_amdgcn_update_dpp(0, __builtin_bit_cast(int, v), 0x4E, 0xF, 0xF, true));
    v += __builtin_bit_cast(float, __builtin_amdgcn_update_dpp(0, __builtin_bit_cast(int, v), 0x141, 0xF, 0xF, true));
    v += __builtin_bit_cast(float, __builtin_amdgcn_update_dpp(0, __builtin_bit_cast(int, v), 0x140, 0xF, 0xF, true));
    return v;
}
__device__ __forceinline__ float sq8(const v4u w) { const float a0 = bflo(w.x), a1 = bfhi(w.x), a2 = bflo(w.y), a3 = bfhi(w.y), a4 = bflo(w.z), a5 = bfhi(w.z), a6 = bflo(w.w), a7 = bfhi(w.w);
    return (a0 * a0 + a1 * a1) + (a2 * a2 + a3 * a3) + (a4 * a4 + a5 * a5) + (a6 * a6 + a7 * a7); }
__device__ __forceinline__ void pre_phase(const GAS bf16* PROJB, const GAS float* ROPE, GAS float* RS, GAS bf16* KMB, int gw, int NGW, int lane) {
    asm volatile("" : "+v"(lane));
    const int q = lane >> 4, sub = lane & 15;
    for (int t0 = gw * 4; t0 < T; t0 += NGW * 4) {
        const size_t t = (size_t)t0 + q;
        const GAS bf16* pr = PROJB + t * INP;
        const v4u w0 = *(const GAS v4u*)(pr + PC_CQ + 8 * sub), w1 = *(const GAS v4u*)(pr + PC_CQ + 8 * (16 + (sub & 7))), w2 = *(const GAS v4u*)(pr + PC_CKV + 8 * sub);
        const float x1 = __builtin_bit_cast(float, (unsigned)pr[PC_KR + sub] << 16), x2 = __builtin_bit_cast(float, (unsigned)pr[PC_KR + 16 + sub] << 16);
        const float c = ROPE[t * 32 + sub], sn = ROPE[t * 32 + 16 + sub];
        const float sq = row16_sum(sq8(w0) + (sub < 8 ? sq8(w1) : 0.f)), skv = row16_sum(sq8(w2));
        if (sub == 0) { RS[2 * t] = rsqrtf(sq * (1.f / 192.f) + 1e-6f); RS[2 * t + 1] = rsqrtf(skv * (1.f / 128.f) + 1e-6f); }
        const bf16 y1 = (bf16)f2bf_(x1 * c - x2 * sn), y2 = (bf16)f2bf_(x1 * sn + x2 * c);
        GAS bf16* kr = KMB + t * 384 + 64 + sub;
#pragma unroll
        for (int h = 0; h < 4; ++h) { kr[h * 96] = y1; kr[h * 96 + 16] = y2; }
    }
}

typedef short lr_bf16x8 __attribute__((ext_vector_type(8)));
typedef float lr_f32x16 __attribute__((ext_vector_type(16)));
__device__ __forceinline__ void lr_swap32(float& a, float& b) { asm volatile("v_nop\n\tv_nop\n\tv_permlane32_swap_b32 %0, %1" : "+v"(a), "+v"(b)); }
constexpr int LR_XR = 0, LR_CW = LR_XR + 37376, LR_XA = LR_CW + 1280, LR_WT = LR_XA + 256 * 144, LR_SUM = LR_WT + 2 * 64 * 144, LR_END = LR_SUM + 4096;
struct LruP { const GAS bf16* PROJB; const GAS float* cw; const GAS float* cb; const GAS bf16* wat; const GAS float* ba; const GAS float* bx; const GAS float* sp; GAS unsigned* HA; GAS float* LSUM; };
__device__ __forceinline__ void lru_phase(const LruP& P, LAS unsigned char* lds, int tid, int wave, int lane, int vcu, int G) {
    asm volatile("" : "+v"(tid), "+v"(lane));
    LAS float* SUM = (LAS float*)(lds + LR_SUM);
    for (int u = vcu; u < (T / 256) * 8; u += G) {
        const int tile = u >> 3, g = u & 7; const int t0 = tile * 256; const bool first = ((tile & 31) == 0);
        __syncthreads();
        float ba_[2], bx_[2], sp_[2];
#pragma unroll
        for (int nt = 0; nt < 2; ++nt) { const int ch = 64 * g + 32 * nt + (lane & 31); ba_[nt] = P.ba[ch]; bx_[nt] = P.bx[ch]; sp_[nt] = P.sp[ch]; }
        { v4u wt_[2], xr_[5];
#pragma unroll
          for (int i = 0; i < 2; ++i) { const int idx = tid + 512 * i; wt_[i] = ((const GAS v4u*)(P.wat + (size_t)g * 2 * 4096))[idx]; }
#pragma unroll
          for (int i = 0; i < 5; ++i) { const int idx = tid + 512 * i, row = idx >> 3, part = idx & 7; const bool ok = (idx < 259 * 8) && !(first && row < 3);
              const int trow = ok ? t0 - 3 + row : t0;
              xr_[i] = *(const GAS v4u*)(P.PROJB + (size_t)trow * INP + PC_XL + 64 * g + 8 * part); if (!ok) xr_[i] = v4u{0u, 0u, 0u, 0u}; }
          float cwv = 0.f; if (tid < 320) cwv = (tid < 256) ? P.cw[(tid >> 6) * 512 + 64 * g + (tid & 63)] : P.cb[64 * g + (tid - 256)];
#pragma unroll
          for (int i = 0; i < 2; ++i) { const int idx = tid + 512 * i; *(LAS v4u*)(lds + LR_WT + (idx >> 9) * 9216 + ((idx >> 3) & 63) * 144 + (idx & 7) * 16) = wt_[i]; }
#pragma unroll
          for (int i = 0; i < 5; ++i) { const int idx = tid + 512 * i, row = idx >> 3, part = idx & 7; if (idx < 259 * 8) *(LAS v4u*)(lds + LR_XR + row * 144 + 16 * part) = xr_[i]; }
          if (tid < 320) ((LAS float*)(lds + LR_CW))[tid] = cwv; }
        __syncthreads();
        { float cwr[4][8], cbr[8];
#pragma unroll
          for (int k = 0; k < 4; ++k) { const f32x4 c0 = *(const LAS f32x4*)(lds + LR_CW + (k * 64 + 8 * wave) * 4), c1 = *(const LAS f32x4*)(lds + LR_CW + (k * 64 + 8 * wave + 4) * 4);
              cwr[k][0] = c0.x; cwr[k][1] = c0.y; cwr[k][2] = c0.z; cwr[k][3] = c0.w; cwr[k][4] = c1.x; cwr[k][5] = c1.y; cwr[k][6] = c1.z; cwr[k][7] = c1.w; }
          { const f32x4 c0 = *(const LAS f32x4*)(lds + LR_CW + (256 + 8 * wave) * 4), c1 = *(const LAS f32x4*)(lds + LR_CW + (256 + 8 * wave + 4) * 4);
            cbr[0] = c0.x; cbr[1] = c0.y; cbr[2] = c0.z; cbr[3] = c0.w; cbr[4] = c1.x; cbr[5] = c1.y; cbr[6] = c1.z; cbr[7] = c1.w; }
#pragma unroll
          for (int it_ = 0; it_ < 4; ++it_) { const int time = lane + 64 * it_;
              float y[8];
#pragma unroll
              for (int e = 0; e < 8; ++e) y[e] = cbr[e];
#pragma unroll
              for (int k = 0; k < 4; ++k) { const v4u w = *(const LAS v4u*)(lds + LR_XR + (time + k) * 144 + 16 * wave);
                  y[0] += bflo(w.x) * cwr[k][0]; y[1] += bfhi(w.x) * cwr[k][1]; y[2] += bflo(w.y) * cwr[k][2]; y[3] += bfhi(w.y) * cwr[k][3];
                  y[4] += bflo(w.z) * cwr[k][4]; y[5] += bfhi(w.z) * cwr[k][5]; y[6] += bflo(w.w) * cwr[k][6]; y[7] += bfhi(w.w) * cwr[k][7]; }
              v4u o; o.x = pk2(y[0], y[1]); o.y = pk2(y[2], y[3]); o.z = pk2(y[4], y[5]); o.w = pk2(y[6], y[7]);
              *(LAS v4u*)(lds + LR_XA + time * 144 + 16 * wave) = o; } }
        __syncthreads();
        const int r32 = lane & 31, hi = lane >> 5;
        lr_f32x16 acc[2][2];
#pragma unroll
        for (int nt = 0; nt < 2; ++nt) { const float b_a = ba_[nt], b_x = bx_[nt];
#pragma unroll
            for (int r = 0; r < 16; ++r) { acc[0][nt][r] = b_a; acc[1][nt][r] = b_x; } }
        { lr_bf16x8 af[4];
#pragma unroll
          for (int s_ = 0; s_ < 4; ++s_) af[s_] = *(const LAS lr_bf16x8*)(lds + LR_XA + (32 * wave + r32) * 144 + (16 * s_ + 8 * hi) * 2);
#pragma unroll
          for (int gt = 0; gt < 2; ++gt)
#pragma unroll
              for (int nt = 0; nt < 2; ++nt)
#pragma unroll
                  for (int s_ = 0; s_ < 4; ++s_) { const lr_bf16x8 bfr = *(const LAS lr_bf16x8*)(lds + LR_WT + gt * 9216 + (32 * nt + r32) * 144 + (16 * s_ + 8 * hi) * 2);
                      acc[gt][nt] = __builtin_amdgcn_mfma_f32_32x32x16_bf16(af[s_], bfr, acc[gt][nt], 0, 0, 0); } }
#pragma unroll
        for (int nt = 0; nt < 2; ++nt) { const float sp = sp_[nt];
            float sa_[4], sh_[4];
#pragma unroll
            for (int q = 0; q < 4; ++q) { float hrun = 0.f, arun = 1.f;
#pragma unroll
                for (int e = 0; e < 4; ++e) { const int r = 4 * q + e, tl = 8 * q + 4 * hi + e;
                    const float xv = __builtin_bit_cast(float, (unsigned)*(const LAS unsigned short*)(lds + LR_XA + (32 * wave + tl) * 144 + (32 * nt + r32) * 2) << 16);
                    const float rg = __builtin_amdgcn_rcpf(1.f + __builtin_amdgcn_exp2f(-LOG2E * acc[0][nt][r])), ig = __builtin_amdgcn_rcpf(1.f + __builtin_amdgcn_exp2f(-LOG2E * acc[1][nt][r]));
                    const float la = -8.0f * rg * sp; const float a_ = __builtin_amdgcn_exp2f(LOG2E * la);
                    const float uu = __builtin_amdgcn_sqrtf(fmaxf(1.f - a_ * a_, 0.f)) * (ig * xv);
                    hrun = a_ * hrun + uu; arun *= a_; acc[0][nt][r] = arun; acc[1][nt][r] = hrun; }
                sa_[q] = arun; sh_[q] = hrun; }
            float runA = 1.f, runH = 0.f;
#pragma unroll
            for (int q = 0; q < 4; ++q) { float a0 = sa_[q], a1 = sa_[q], h0 = sh_[q], h1 = sh_[q]; lr_swap32(a0, a1); lr_swap32(h0, h1);
                const float midA = runA * a0, midH = a0 * runH + h0;
                const float inA = hi ? midA : runA, inH = hi ? midH : runH;
                runA = midA * a1; runH = a1 * midH + h1;
#pragma unroll
                for (int e = 0; e < 4; ++e) { const int r = 4 * q + e; acc[1][nt][r] += acc[0][nt][r] * inH; acc[0][nt][r] *= inA; } }
            if (hi == 0) { SUM[(wave * 64 + 32 * nt + r32) * 2] = runA; SUM[(wave * 64 + 32 * nt + r32) * 2 + 1] = runH; } }
        __syncthreads();
#pragma unroll
        for (int nt = 0; nt < 2; ++nt) { const int cl = 32 * nt + r32;
            float ca = 1.f, chh = 0.f;
            for (int w = 0; w < wave; ++w) { const float aw = SUM[(w * 64 + cl) * 2], hw = SUM[(w * 64 + cl) * 2 + 1]; chh = aw * chh + hw; ca *= aw; }
            GAS unsigned* ha = P.HA + (size_t)(t0 + 32 * wave + 4 * hi) * 512 + 64 * g + cl;
#pragma unroll
            for (int r = 0; r < 16; ++r) { const float hh = acc[1][nt][r] + acc[0][nt][r] * chh, ac_ = acc[0][nt][r] * ca; ha[(size_t)((r & 3) + 8 * (r >> 2)) * 512] = pk2(hh, ac_);
                if (r == 15 && wave == 7 && hi == 1) { P.LSUM[((size_t)tile * 512 + 64 * g + cl) * 2] = ac_; P.LSUM[((size_t)tile * 512 + 64 * g + cl) * 2 + 1] = hh; } } }
    }
}

struct PostP { const GAS bf16* OMB; const GAS unsigned* HA; const GAS float* LSUM; const GAS bf16* PROJB; const GAS float* gm; const GAS float* gl; GAS bf16* Y; };
__device__ __forceinline__ void post_phase(const PostP& P, LAS unsigned char* lds, int tid, int wave, int lane, int vcu, int G) {
    asm volatile("" : "+v"(tid), "+v"(lane));
    LAS float* hin = (LAS float*)lds;
    for (int u = vcu; u < T / 64; u += G) {
        const int t0 = u * 64, tile = t0 >> 8, tb = tile & ~31;
        __syncthreads();
        { float h = 0.f;
          for (int c0 = tb; c0 < tile; c0 += 8) {
              float av_[8], hv_[8];
#pragma unroll
              for (int i = 0; i < 8; ++i) { const int c = (c0 + i < tile) ? (c0 + i) : tb; av_[i] = P.LSUM[((size_t)c * 512 + tid) * 2]; hv_[i] = P.LSUM[((size_t)c * 512 + tid) * 2 + 1]; }
#pragma unroll
              for (int i = 0; i < 8; ++i) { if (c0 + i < tile) h = av_[i] * h + hv_[i]; } }
          hin[tid] = h; }
        __syncthreads();
        f32x4 hi0 = *(const LAS f32x4*)(hin + 8 * lane), hi1 = *(const LAS f32x4*)(hin + 8 * lane + 4);
        const f32x4 g0 = *(const GAS f32x4*)(P.gl + 8 * lane), g1 = *(const GAS f32x4*)(P.gl + 8 * lane + 4), gmv = *(const GAS f32x4*)(P.gm + 4 * lane);
#pragma unroll 2
        for (int i = 0; i < 8; ++i) {
            const size_t t = (size_t)t0 + 8 * wave + i;
            const v4u p0 = *(const GAS v4u*)(P.HA + t * 512 + 8 * lane), p1 = *(const GAS v4u*)(P.HA + t * 512 + 8 * lane + 4), gw_ = *(const GAS v4u*)(P.PROJB + t * INP + PC_GL + 8 * lane);
            const v2u mw = *(const GAS v2u*)(P.OMB + t * 256 + 4 * lane);
            float o[8];
            o[0] = (bflo(p0.x) + bfhi(p0.x) * hi0.x) * gelu_erf(bflo(gw_.x)); o[1] = (bflo(p0.y) + bfhi(p0.y) * hi0.y) * gelu_erf(bfhi(gw_.x));
            o[2] = (bflo(p0.z) + bfhi(p0.z) * hi0.z) * gelu_erf(bflo(gw_.y)); o[3] = (bflo(p0.w) + bfhi(p0.w) * hi0.w) * gelu_erf(bfhi(gw_.y));
            o[4] = (bflo(p1.x) + bfhi(p1.x) * hi1.x) * gelu_erf(bflo(gw_.z)); o[5] = (bflo(p1.y) + bfhi(p1.y) * hi1.y) * gelu_erf(bfhi(gw_.z));
            o[6] = (bflo(p1.z) + bfhi(p1.z) * hi1.z) * gelu_erf(bflo(gw_.w)); o[7] = (bflo(p1.w) + bfhi(p1.w) * hi1.w) * gelu_erf(bfhi(gw_.w));
            float s2 = 0.f;
#pragma unroll
            for (int e = 0; e < 8; ++e) s2 += o[e] * o[e];
            const float m0 = bflo(mw.x), m1 = bfhi(mw.x), m2 = bflo(mw.y), m3 = bfhi(mw.y);
            float s1 = (m0 * m0 + m1 * m1) + (m2 * m2 + m3 * m3);
            s1 = wave_sum(s1, lane); s2 = wave_sum(s2, lane);
            const float r1 = rsqrtf(s1 * (1.f / 256.f) + 1e-6f), r2 = rsqrtf(s2 * (1.f / 512.f) + 1e-6f);
            GAS bf16* yr = P.Y + t * 1024;
            { v2u w; w.x = pk2(m0 * r1 * gmv.x, m1 * r1 * gmv.y); w.y = pk2(m2 * r1 * gmv.z, m3 * r1 * gmv.w); *(GAS v2u*)(yr + 4 * lane) = w; }
            { v4u w; w.x = pk2(o[0] * r2 * g0.x, o[1] * r2 * g0.y); w.y = pk2(o[2] * r2 * g0.z, o[3] * r2 * g0.w); w.z = pk2(o[4] * r2 * g1.x, o[5] * r2 * g1.y); w.w = pk2(o[6] * r2 * g1.z, o[7] * r2 * g1.w);
              *(GAS v4u*)(yr + 256 + 8 * lane) = w; }
        }
    }
}

#define TILE_BAR() asm volatile("s_waitcnt lgkmcnt(0)\n\ts_barrier" ::: "memory")
typedef short bf16x8 __attribute__((ext_vector_type(8)));
typedef short s16x4 __attribute__((ext_vector_type(4)));
typedef float f32x16 __attribute__((ext_vector_type(16)));
typedef unsigned u32x4 __attribute__((ext_vector_type(4)));
__device__ __forceinline__ int crow(int r, int hi) { return (r & 3) + 8 * (r >> 2) + 4 * hi; }
typedef float f32x2_t __attribute__((ext_vector_type(2))); typedef __bf16 bf16x2_c __attribute__((ext_vector_type(2)));
__device__ __forceinline__ unsigned cvtpk(float lo, float hi) { f32x2_t v = {lo, hi}; bf16x2_c b = __builtin_convertvector(v, bf16x2_c); return __builtin_bit_cast(unsigned, b); }
__device__ __forceinline__ float swapmax(float m) { auto rr = __builtin_amdgcn_permlane32_swap(__float_as_uint(m), __float_as_uint(m), false, false); return fmaxf(__uint_as_float(rr[0]), __uint_as_float(rr[1])); }
__device__ __forceinline__ float swapadd(float m) { auto rr = __builtin_amdgcn_permlane32_swap(__float_as_uint(m), __float_as_uint(m), false, false); return __uint_as_float(rr[0]) + __uint_as_float(rr[1]); }
__device__ __forceinline__ s16x4 vtr(const LAS unsigned char* p) { return __builtin_bit_cast(s16x4, __builtin_amdgcn_ds_read_tr16_b64_v4i16((LAS s16x4*)p)); }
__device__ __forceinline__ bf16x8 pack8(const f32x16& p, int b) { u32x4 w; w.x = cvtpk(p[b], p[b + 1]); w.y = cvtpk(p[b + 2], p[b + 3]); w.z = cvtpk(p[b + 4], p[b + 5]); w.w = cvtpk(p[b + 6], p[b + 7]); return __builtin_bit_cast(bf16x8, w); }
__device__ __forceinline__ float vmax3(float a, float b, float c) { float r; asm("v_max3_f32 %0, %1, %2, %3" : "=v"(r) : "v"(a), "v"(b), "v"(c)); return r; }
__device__ __forceinline__ float max32(const f32x16& p, const f32x16& q) {
    float a = vmax3(p[0], p[1], p[2]), b = vmax3(p[3], p[4], p[5]), c = vmax3(p[6], p[7], p[8]), d = vmax3(p[9], p[10], p[11]), e = vmax3(p[12], p[13], p[14]);
    float f = vmax3(q[0], q[1], q[2]), g = vmax3(q[3], q[4], q[5]), h = vmax3(q[6], q[7], q[8]), i = vmax3(q[9], q[10], q[11]), j = vmax3(q[12], q[13], q[14]);
    a = vmax3(a, b, c); d = vmax3(d, e, p[15]); f = vmax3(f, g, h); i = vmax3(i, j, q[15]);
    return vmax3(vmax3(a, d, f), i, i);
}
__device__ __forceinline__ float max16(const f32x16& p) { float a = fmaxf(fmaxf(p[0], p[1]), fmaxf(p[2], p[3])), b = fmaxf(fmaxf(p[4], p[5]), fmaxf(p[6], p[7])), c = fmaxf(fmaxf(p[8], p[9]), fmaxf(p[10], p[11])), d = fmaxf(fmaxf(p[12], p[13]), fmaxf(p[14], p[15])); return fmaxf(fmaxf(a, b), fmaxf(c, d)); }

struct AttnP {
    const GAS bf16* Q; const GAS bf16* K; const GAS bf16* V; int qp, kp, vp;
    GAS bf16* O; int op;
    const GAS float* rope;
    const GAS int* pos; const GAS float* btab; const GAS float* dnorm; const GAS float* lams;
};
template <int KIND> struct AK {
    static constexpr bool DIFF = KIND == 1, CROSS = KIND == 2;
    static constexpr int HW = KIND == 0 ? 96 : KIND == 1 ? 64 : 256;
    static constexpr int NKS = KIND == 0 ? 6 : KIND == 1 ? 2 : 16;
    static constexpr int KP = KIND == 0 ? 208 : KIND == 1 ? 144 : 528;
    static constexpr int ND = CROSS ? 4 : 2;
    static constexpr int CPK = HW / 8, KCH = (64 * CPK + 511) / 512;
    static constexpr int VCH = ND / 2;
    static constexpr int KB = 64 * KP, VB = ND * 4096;
    static constexpr int NBUF = CROSS ? 2 : 3;
    static constexpr int K0 = 0, V0 = NBUF * KB, POS = V0 + NBUF * VB, BT = POS + 1024, DN = BT + 528, END = DN + 256;
};
static_assert(AK<2>::END <= RING_BYTES && AK<0>::END <= RING_BYTES && AK<1>::END + 16 + 8 * 8192 <= RING_BYTES, "attention LDS");

template <int KIND, bool LEAD>
__device__ __forceinline__ void attn_unit(const AttnP& P, int b, int h, int qb, int dhalf, LAS unsigned char* lds, int tid, int wave, int lane) {
    lane = lane_id_v(); tid = (wave << 6) | lane;
    typedef AK<KIND> C;
    constexpr bool DIFF = C::DIFF, CROSS = C::CROSS;
    constexpr int HW = C::HW, NKS = C::NKS, KP = C::KP, ND = C::ND, CPK = C::CPK, KCH = C::KCH, VCH = C::VCH;
    const int r32 = lane & 31, hi = lane >> 5;
    const size_t rowb = (size_t)b * S, rowk = CROSS ? (size_t)b * MEM : rowb;
    const int q0w = qb * 256 + wave * 32, qi = q0w + r32;
    int pq = 0; float bias_far = 0.f;
    __syncthreads();
    if (DIFF) {
        pq = P.pos[rowb + qi];
        if (tid < 129) ((LAS float*)(lds + C::BT))[tid] = P.btab[h * 129 + tid];
        if (tid >= 192 && tid < 256) ((LAS float*)(lds + C::DN))[tid - 192] = P.dnorm[tid - 192];
    }
    int minq = pq;
    if (DIFF) { for (int o = 1; o < 64; o <<= 1) { const int v = shxi(minq, o, lane); minq = v < minq ? v : minq; } }
    const int NT = CROSS ? MEM / 64 : 4 * (qb + 1);
    u32x4 kr[KCH], vr[VCH]; int pkr = 0;
    u32x4 kr2[CROSS ? 1 : KCH], vr2[CROSS ? 1 : VCH]; int pkr2 = 0;
    const GAS bf16* Kb = P.K + rowk * P.kp + h * HW; const GAS bf16* Vb = P.V + rowk * P.vp + (CROSS ? h * 256 + dhalf * 128 : h * 64);
    const __amdgpu_buffer_rsrc_t rK = __builtin_amdgcn_make_buffer_rsrc((void*)Kb, 0, 0x7fffffff, 0x00020000), rV = __builtin_amdgcn_make_buffer_rsrc((void*)Vb, 0, 0x7fffffff, 0x00020000);
    const __amdgpu_buffer_rsrc_t rP = __builtin_amdgcn_make_buffer_rsrc((void*)(DIFF ? P.pos + rowb : (const GAS int*)Kb), 0, 0x7fffffff, 0x00020000);
    int kvo[KCH], vvo[VCH];
#pragma unroll
    for (int i = 0; i < KCH; ++i) { int c = tid + 512 * i; c = c < 64 * CPK ? c : tid; kvo[i] = ((c / CPK) * P.kp + (c % CPK) * 8) * 2; }
#pragma unroll
    for (int i = 0; i < VCH; ++i) { const int c = tid + 512 * i; vvo[i] = ((c / (4 * ND)) * P.vp + (c % (4 * ND)) * 8) * 2; }
    const int pvo = (tid & 63) * 4;
    auto gload = [&](int t) {
        const int ks = __builtin_amdgcn_readfirstlane(64 * t * P.kp * 2), vs = __builtin_amdgcn_readfirstlane(64 * t * P.vp * 2);
#pragma unroll
        for (int i = 0; i < KCH; ++i) kr[i] = __builtin_amdgcn_raw_buffer_load_b128(rK, kvo[i], ks, 0);
#pragma unroll
        for (int i = 0; i < VCH; ++i) vr[i] = __builtin_amdgcn_raw_buffer_load_b128(rV, vvo[i], vs, 0);
        if (DIFF) pkr = __builtin_amdgcn_raw_buffer_load_b32(rP, pvo, __builtin_amdgcn_readfirstlane(64 * t * 4), 0);
    };
    auto lstore = [&](int buf) {
        LAS unsigned char* kb_ = lds + C::K0 + buf * C::KB; LAS unsigned char* vb_ = lds + C::V0 + buf * C::VB;
#pragma unroll
        for (int i = 0; i < KCH; ++i) { int c = tid + 512 * i; c = c < 64 * CPK ? c : tid; const int key = c / CPK, part = c % CPK; *(LAS u32x4*)(kb_ + key * KP + part * 16) = kr[i]; }
#pragma unroll
        for (int i = 0; i < VCH; ++i) { const int c = tid + 512 * i; const int key = c / (4 * ND), part = c % (4 * ND); *(LAS u32x4*)(vb_ + (part >> 2) * 4096 + (key >> 3) * 512 + (key & 7) * 64 + (part & 3) * 16) = vr[i]; }
        if (DIFF) { ((LAS int*)(lds + C::POS + buf * 256))[tid & 63] = pkr; if (tid < 64) { int mk_ = pkr; for (int o = 1; o < 64; o <<= 1) { const int v = shxi(mk_, o, lane); mk_ = v > mk_ ? v : mk_; } if (tid == 0) ((LAS int*)(lds + C::POS + 768))[buf] = mk_; } }
    };
    auto gloadB = [&](int t) {
        const int ks = __builtin_amdgcn_readfirstlane(64 * t * P.kp * 2), vs = __builtin_amdgcn_readfirstlane(64 * t * P.vp * 2);
#pragma unroll
        for (int i = 0; i < (CROSS ? 1 : KCH); ++i) kr2[i] = __builtin_amdgcn_raw_buffer_load_b128(rK, kvo[i], ks, 0);
#pragma unroll
        for (int i = 0; i < (CROSS ? 1 : VCH); ++i) vr2[i] = __builtin_amdgcn_raw_buffer_load_b128(rV, vvo[i], vs, 0);
        if (DIFF) pkr2 = __builtin_amdgcn_raw_buffer_load_b32(rP, pvo, __builtin_amdgcn_readfirstlane(64 * t * 4), 0);
    };
    auto lstoreB = [&](int buf) {
        LAS unsigned char* kb_ = lds + C::K0 + buf * C::KB; LAS unsigned char* vb_ = lds + C::V0 + buf * C::VB;
#pragma unroll
        for (int i = 0; i < (CROSS ? 1 : KCH); ++i) { int c = tid + 512 * i; c = c < 64 * CPK ? c : tid; const int key = c / CPK, part = c % CPK; *(LAS u32x4*)(kb_ + key * KP + part * 16) = kr2[i]; }
#pragma unroll
        for (int i = 0; i < (CROSS ? 1 : VCH); ++i) { const int c = tid + 512 * i; const int key = c / (4 * ND), part = c % (4 * ND); *(LAS u32x4*)(vb_ + (part >> 2) * 4096 + (key >> 3) * 512 + (key & 7) * 64 + (part & 3) * 16) = vr2[i]; }
        if (DIFF) { ((LAS int*)(lds + C::POS + buf * 256))[tid & 63] = pkr2; if (tid < 64) { int mk_ = pkr2; for (int o = 1; o < 64; o <<= 1) { const int v = shxi(mk_, o, lane); mk_ = v > mk_ ? v : mk_; } if (tid == 0) ((LAS int*)(lds + C::POS + 768))[buf] = mk_; } }
    };
    LAS float* osv = (LAS float*)(lds + ((C::END + 15) & ~15)) + wave * 2048 + lane;
    float il = 0.f;
    f32x16 oA[ND];
#pragma unroll 1
    for (int mp = 0; mp < (DIFF ? 2 : 1); ++mp) {
        bf16x8 qf[NKS];
        { const GAS bf16* qrow = P.Q + (rowb + qi) * P.qp + h * HW + mp * 32;
#pragma unroll
          for (int s = 0; s < NKS; ++s) qf[s] = *(const GAS bf16x8*)(qrow + 16 * s + 8 * hi);
          if (KIND == 0) {
              const GAS float* rp = P.rope + (rowb + qi) * 32 + 8 * hi;
              const f32x4 c0 = *(const GAS f32x4*)rp, c1 = *(const GAS f32x4*)(rp + 4), s0 = *(const GAS f32x4*)(rp + 16), s1 = *(const GAS f32x4*)(rp + 20);
              const u32x4 a = __builtin_bit_cast(u32x4, qf[NKS - 2]), bq = __builtin_bit_cast(u32x4, qf[NKS - 1]); u32x4 ra, rb;
#pragma unroll
              for (int w = 0; w < 4; ++w) { const float cl = w < 2 ? c0[2 * w] : c1[2 * w - 4], ch = w < 2 ? c0[2 * w + 1] : c1[2 * w - 3], sl = w < 2 ? s0[2 * w] : s1[2 * w - 4], sh = w < 2 ? s0[2 * w + 1] : s1[2 * w - 3];
                  const float x1l = bflo(a[w]), x1h = bfhi(a[w]), x2l = bflo(bq[w]), x2h = bfhi(bq[w]);
                  ra[w] = cvtpk(x1l * cl - x2l * sl, x1h * ch - x2h * sh); rb[w] = cvtpk(x1l * sl + x2l * cl, x1h * sh + x2h * ch); }
              qf[NKS - 2] = __builtin_bit_cast(bf16x8, ra); qf[NKS - 1] = __builtin_bit_cast(bf16x8, rb);
          } }
        __syncthreads();
        float m1 = -1e30f, l1 = 0.f;
#pragma unroll
        for (int d = 0; d < ND; ++d)
#pragma unroll
            for (int r = 0; r < 16; ++r) oA[d][r] = 0.f;
        auto qk = [&](int sl, f32x16& sa, f32x16& sb, float init) {
            const LAS unsigned char* kb_ = lds + C::K0 + sl * C::KB + r32 * KP + hi * 16 + mp * 64;
#pragma unroll
            for (int r = 0; r < 16; ++r) { sa[r] = init; sb[r] = init; }
            constexpr int HB = CROSS ? 4 : (NKS > 3 ? 3 : NKS);
#pragma unroll
            for (int s0_ = 0; s0_ < NKS; s0_ += HB) {
                bf16x8 kfa[HB], kfb[HB];
#pragma unroll
                for (int s = 0; s < HB; ++s) { kfa[s] = *(const LAS bf16x8*)(kb_ + (s0_ + s) * 32); kfb[s] = *(const LAS bf16x8*)(kb_ + 32 * KP + (s0_ + s) * 32); }
                __builtin_amdgcn_sched_barrier(0);
#pragma unroll
                for (int s = 0; s < HB; ++s) { sa = __builtin_amdgcn_mfma_f32_32x32x16_bf16(kfa[s], qf[s0_ + s], sa, 0, 0, 0); sb = __builtin_amdgcn_mfma_f32_32x32x16_bf16(kfb[s], qf[s0_ + s], sb, 0, 0, 0); }
                __builtin_amdgcn_sched_barrier(0);
            }
        };
        auto isnear = [&](int sl) { bool nb = false;
            if (DIFF) { const int mk_ = __builtin_amdgcn_readfirstlane(((LAS int*)(lds + C::POS + 768))[sl]); nb = (minq - mk_) < 128; }
            return nb; };
        auto sm = [&](int t, int sl, f32x16& pa, f32x16& pb, bool nearb) -> float {
            const int k0 = 64 * t;
            if (DIFF) { if (nearb) {
                const LAS int* pk = (const LAS int*)(lds + C::POS + sl * 256); const LAS float* bt = (const LAS float*)(lds + C::BT);
#pragma unroll
                for (int r = 0; r < 16; ++r) { const int kk = crow(r, hi);
                    int n0 = pq - pk[kk], n1 = pq - pk[kk + 32]; n0 = n0 < 0 ? 0 : (n0 > 128 ? 128 : n0); n1 = n1 < 0 ? 0 : (n1 > 128 ? 128 : n1);
                    pa[r] += bt[n0]; pb[r] += bt[n1]; }
            } }
            if (!CROSS && k0 + 63 > q0w) {
#pragma unroll
                for (int r = 0; r < 16; ++r) { const int kk = k0 + crow(r, hi); if (kk > qi) pa[r] = -1e30f; if (kk + 32 > qi) pb[r] = -1e30f; }
            }
            asm volatile("s_nop 15\n\ts_nop 7" : "+v"(pa), "+v"(pb));
            float mn, al = 1.f;
            if (CROSS) { const float mx = swapmax(max32(pa, pb)); mn = fmaxf(m1, mx); al = __builtin_amdgcn_exp2f(m1 - mn); l1 *= al; }
            else { const float mx = swapmax(max32(pa, pb)); const bool up = mx > m1 + 8.0f; mn = up ? mx : m1;
                   if (__builtin_amdgcn_ballot_w64(up) != 0ull) { al = __builtin_amdgcn_exp2f(m1 - mn); l1 *= al; } }
            m1 = mn;
            float ls = 0.f;
#pragma unroll
            for (int r = 0; r < 16; ++r) { pa[r] = __builtin_amdgcn_exp2f(pa[r] - mn); pb[r] = __builtin_amdgcn_exp2f(pb[r] - mn); ls += pa[r] + pb[r]; }
            l1 += ls;
            return al;
        };
        auto pv = [&](int sl, const f32x16& pa, const f32x16& pb, float al) {
            const LAS unsigned char* vb_ = lds + C::V0 + sl * C::VB + ((lane >> 4) & 1) * 32 + (lane & 3) * 8 + (4 * hi + ((lane & 15) >> 2)) * 64;
            bf16x8 pf[4];
            pf[0] = pack8(pa, 0); pf[1] = pack8(pa, 8); pf[2] = pack8(pb, 0); pf[3] = pack8(pb, 8);
            const bool resc = CROSS ? true : (__builtin_amdgcn_ballot_w64(al != 1.0f) != 0ull);
            if (CROSS) {
#pragma unroll
                for (int d = 0; d < ND; ++d) {
                    __builtin_amdgcn_sched_barrier(0);
#pragma unroll
                    for (int r = 0; r < 16; ++r) oA[d][r] *= al;
                    bf16x8 vf[4];
#pragma unroll
                    for (int s = 0; s < 4; ++s) { const s16x4 lo = vtr(vb_ + d * 4096 + s * 1024), hh = vtr(vb_ + d * 4096 + s * 1024 + 512); vf[s] = (bf16x8){lo[0], lo[1], lo[2], lo[3], hh[0], hh[1], hh[2], hh[3]}; }
#pragma unroll
                    for (int s = 0; s < 4; ++s) oA[d] = __builtin_amdgcn_mfma_f32_32x32x16_bf16(vf[s], pf[s], oA[d], 0, 0, 0);
                }
            } else if (DIFF) {
                if (resc) {
#pragma unroll
                    for (int d = 0; d < 2; ++d)
#pragma unroll
                        for (int r = 0; r < 16; ++r) oA[d][r] *= al;
                }
#pragma unroll
                for (int d = 0; d < 2; ++d) {
                    bf16x8 vf[4];
#pragma unroll
                    for (int s = 0; s < 4; ++s) { const s16x4 lo = vtr(vb_ + d * 4096 + s * 1024), hh = vtr(vb_ + d * 4096 + s * 1024 + 512); vf[s] = (bf16x8){lo[0], lo[1], lo[2], lo[3], hh[0], hh[1], hh[2], hh[3]}; }
                    __builtin_amdgcn_sched_barrier(0);
#pragma unroll
                    for (int s = 0; s < 4; ++s) oA[d] = __builtin_amdgcn_mfma_f32_32x32x16_bf16(vf[s], pf[s], oA[d], 0, 0, 0);
                }
            } else {
                bf16x8 vf[2][4];
#pragma unroll
                for (int d = 0; d < 2; ++d)
#pragma unroll
                    for (int s = 0; s < 4; ++s) { const s16x4 lo = vtr(vb_ + d * 4096 + s * 1024), hh = vtr(vb_ + d * 4096 + s * 1024 + 512); vf[d][s] = (bf16x8){lo[0], lo[1], lo[2], lo[3], hh[0], hh[1], hh[2], hh[3]}; }
                if (resc) {
#pragma unroll
                    for (int d = 0; d < 2; ++d)
#pragma unroll
                        for (int r = 0; r < 16; ++r) oA[d][r] *= al;
                }
                __builtin_amdgcn_sched_barrier(0);
#pragma unroll
                for (int s = 0; s < 4; ++s)
#pragma unroll
                    for (int d = 0; d < 2; ++d) oA[d] = __builtin_amdgcn_mfma_f32_32x32x16_bf16(vf[d][s], pf[s], oA[d], 0, 0, 0);
            }
        };
        if (CROSS) {
            gload(0); lstore(0);
            __syncthreads();
            for (int t = 0; t < NT; ++t) {
                const int buf = t & 1;
                f32x16 pa, pb;
                qk(buf, pa, pb, 0.f);
                const float al = sm(t, buf, pa, pb, false);
                pv(buf, pa, pb, al);
                if (t + 1 < NT) { gload(t + 1); lstore(buf ^ 1); }
                TILE_BAR();
            }
        } else {
            gload(0); lstore(0); gload(1); lstore(1);
            gload(2); gloadB(3);
            __syncthreads();
            if (DIFF) bias_far = ((LAS float*)(lds + C::BT))[128];
            const int NTW = (q0w + 31) / 64 + 1;
            constexpr bool lead = LEAD;
            f32x16 ca, cb, na, nb; bool cnear = isnear(0), nnear = false; float cal = 1.f;
            qk(0, ca, cb, (DIFF && !cnear) ? bias_far : 0.f);
            if (lead) cal = sm(0, 0, ca, cb, cnear);
            int s0 = 0, s1 = 1, s2 = 2;
            auto period = [&](int t, f32x16& xa, f32x16& xb, bool& xnear, f32x16& ya, f32x16& yb, bool& ynear) {
                const bool have_next = (t + 1 < NTW);
                if (lead) {
                    if (have_next) { ynear = isnear(s1); qk(s1, ya, yb, (DIFF && !ynear) ? bias_far : 0.f); }
                    if (t < NTW) pv(s0, xa, xb, cal);
                    if (have_next) cal = sm(t + 1, s1, ya, yb, ynear);
                } else {
                    if (t < NTW) cal = sm(t, s0, xa, xb, xnear);
                    if (have_next) { ynear = isnear(s1); qk(s1, ya, yb, (DIFF && !ynear) ? bias_far : 0.f); }
                    if (t < NTW) pv(s0, xa, xb, cal);
                }
                { const int tmp = s0; s0 = s1; s1 = s2; s2 = tmp; }
            };
            int t = 0;
            for (; t + 5 < NT; t += 2) {
                lstore(s2); gload(t + 4);
                period(t, ca, cb, cnear, na, nb, nnear);
                TILE_BAR();
                lstoreB(s2); gloadB(t + 5);
                period(t + 1, na, nb, nnear, ca, cb, cnear);
                TILE_BAR();
            }
            for (; t < NT; t += 2) {
                if (t + 2 < NT) { lstore(s2); if (t + 4 < NT) gload(t + 4); }
                period(t, ca, cb, cnear, na, nb, nnear);
                TILE_BAR();
                if (t + 3 < NT) { lstoreB(s2); if (t + 5 < NT) gloadB(t + 5); }
                period(t + 1, na, nb, nnear, ca, cb, cnear);
                TILE_BAR();
            }
        }
        il = 1.f / swapadd(l1);
        if (DIFF) { if (mp == 0) {
#pragma unroll
            for (int d = 0; d < 2; ++d)
#pragma unroll
                for (int r = 0; r < 16; ++r) osv[(d * 16 + r) * 64] = oA[d][r] * il; } }
    }
    GAS bf16* orow = P.O + (rowb + qi) * P.op + (CROSS ? h * 256 + dhalf * 128 : h * 64);
    if (!DIFF) {
#pragma unroll
        for (int d = 0; d < ND; ++d)
#pragma unroll
            for (int g = 0; g < 4; ++g) { v2u v; v.x = cvtpk(oA[d][4 * g] * il, oA[d][4 * g + 1] * il); v.y = cvtpk(oA[d][4 * g + 2] * il, oA[d][4 * g + 3] * il); *(GAS v2u*)(orow + 32 * d + 8 * g + 4 * hi) = v; }
    } else {
        const float lam = P.lams[0], lam_init = P.lams[1];
        const float i2 = lam * il;
        float ss = 0.f;
#pragma unroll
        for (int d = 0; d < 2; ++d)
#pragma unroll
            for (int r = 0; r < 16; ++r) { const float v = osv[(d * 16 + r) * 64] - oA[d][r] * i2; oA[d][r] = v; ss += v * v; }
        ss = swapadd(ss);
        const float rs = __builtin_amdgcn_rsqf(ss * (1.f / 64.f) + 1e-6f) * (1.f - lam_init);
        const LAS float* dn = (const LAS float*)(lds + C::DN);
#pragma unroll
        for (int d = 0; d < 2; ++d)
#pragma unroll
            for (int g = 0; g < 4; ++g) { const int c = 32 * d + 8 * g + 4 * hi; const f32x4 gn = *(const LAS f32x4*)(dn + c);
                v2u v; v.x = cvtpk(oA[d][4 * g] * rs * gn[0], oA[d][4 * g + 1] * rs * gn[1]); v.y = cvtpk(oA[d][4 * g + 2] * rs * gn[2], oA[d][4 * g + 3] * rs * gn[3]); *(GAS v2u*)(orow + c) = v; }
    }
}

__device__ __forceinline__ int wave_max_i(int v) {
    { const int o = __builtin_amdgcn_update_dpp(0, v, 0xB1, 0xF, 0xF, true); v = o > v ? o : v; }
    { const int o = __builtin_amdgcn_update_dpp(0, v, 0x4E, 0xF, 0xF, true); v = o > v ? o : v; }
    { const int o = __builtin_amdgcn_update_dpp(0, v, 0x141, 0xF, 0xF, true); v = o > v ? o : v; }
    { const int o = __builtin_amdgcn_update_dpp(0, v, 0x140, 0xF, 0xF, true); v = o > v ? o : v; }
    { int a = v, b = v; asm volatile("v_nop\n\tv_nop\n\tv_permlane16_swap_b32 %0, %1" : "+v"(a), "+v"(b)); v = a > b ? a : b; }
    { int a = v, b = v; asm volatile("v_nop\n\tv_nop\n\tv_permlane32_swap_b32 %0, %1" : "+v"(a), "+v"(b)); v = a > b ? a : b; }
    return v;
}
template <int KIND> struct AK2 {
    static constexpr bool DIFF = KIND == 1;
    static constexpr int HW = KIND == 0 ? 96 : 64, NKS = KIND == 0 ? 6 : 2, KP = KIND == 0 ? 208 : 144;
    static constexpr int CPK = HW / 8, KCH = (128 * CPK) / 512, VCH = 2;
    static constexpr int KB = 128 * KP, VB = 2 * 8192;
    static constexpr int K0 = 0, V0 = 2 * KB, POS = V0 + 2 * VB, PMX = POS + 1024, BT = PMX + 16, DN = BT + 528, OSV = (DN + 256 + 15) & ~15, END = OSV + (DIFF ? 8 * 8192 : 0);
};
static_assert(AK2<0>::END <= RING_BYTES && AK2<1>::END <= RING_BYTES, "attention LDS (128-key tiles)");
template <int KIND>
__device__ __forceinline__ void attn_unit2(const AttnP& P, int b, int h, int qb, LAS unsigned char* lds, int tid, int wave, int lane) {
    lane = lane_id_v(); tid = (wave << 6) | lane;
    typedef AK2<KIND> C;
    constexpr bool DIFF = C::DIFF;
    constexpr int HW = C::HW, NKS = C::NKS, KP = C::KP, CPK = C::CPK, KCH = C::KCH, VCH = C::VCH;
    const int r32 = lane & 31, hi = lane >> 5;
    const size_t rowb = (size_t)b * S;
    const int q0w = qb * 256 + wave * 32, qi = q0w + r32;
    int pq = 0; float bias_far = 0.f;
    __syncthreads();
    if (DIFF) {
        pq = P.pos[rowb + qi];
        if (tid < 129) ((LAS float*)(lds + C::BT))[tid] = P.btab[h * 129 + tid];
        if (tid >= 192 && tid < 256) ((LAS float*)(lds + C::DN))[tid - 192] = P.dnorm[tid - 192];
    }
    int minq = pq;
    if (DIFF) minq = __builtin_amdgcn_readfirstlane(-wave_max_i(-pq));
    const int NT = 2 * (qb + 1);
    const GAS bf16* Kb = P.K + rowb * P.kp + h * HW; const GAS bf16* Vb = P.V + rowb * P.vp + h * 64;
    const __amdgpu_buffer_rsrc_t rK = __builtin_amdgcn_make_buffer_rsrc((void*)Kb, 0, 0x7fffffff, 0x00020000), rV = __builtin_amdgcn_make_buffer_rsrc((void*)Vb, 0, 0x7fffffff, 0x00020000);
    const __amdgpu_buffer_rsrc_t rP = __builtin_amdgcn_make_buffer_rsrc((void*)(DIFF ? P.pos + rowb : (const GAS int*)Kb), 0, 0x7fffffff, 0x00020000);
    int kvo[KCH], vvo[VCH], klo[KCH], vlo[VCH];
#pragma unroll
    for (int i = 0; i < KCH; ++i) { const int c = tid + 512 * i; kvo[i] = ((c / CPK) * P.kp + (c % CPK) * 8) * 2; klo[i] = (c / CPK) * KP + (c % CPK) * 16; }
#pragma unroll
    for (int i = 0; i < VCH; ++i) { const int c = tid + 512 * i; const int key = c >> 3, part = c & 7; vvo[i] = (key * P.vp + part * 8) * 2; vlo[i] = (part >> 2) * 8192 + (key >> 3) * 512 + (key & 7) * 64 + (part & 3) * 16; }
    const int pvo = (tid & 127) * 4;
    u32x4 kr[KCH], vr[VCH]; int pkr = 0;
    auto gload = [&](int t) {
        const int ks = __builtin_amdgcn_readfirstlane(128 * t * P.kp * 2), vs = __builtin_amdgcn_readfirstlane(128 * t * P.vp * 2);
#pragma unroll
        for (int i = 0; i < KCH; ++i) kr[i] = __builtin_amdgcn_raw_buffer_load_b128(rK, kvo[i], ks, 0);
#pragma unroll
        for (int i = 0; i < VCH; ++i) vr[i] = __builtin_amdgcn_raw_buffer_load_b128(rV, vvo[i], vs, 0);
        if (DIFF) pkr = __builtin_amdgcn_raw_buffer_load_b32(rP, pvo, __builtin_amdgcn_readfirstlane(128 * t * 4), 0);
    };
    auto lstore = [&](int buf) {
        LAS unsigned char* kb_ = lds + C::K0 + buf * C::KB; LAS unsigned char* vb_ = lds + C::V0 + buf * C::VB;
#pragma unroll
        for (int i = 0; i < KCH; ++i) *(LAS u32x4*)(kb_ + klo[i]) = kr[i];
#pragma unroll
        for (int i = 0; i < VCH; ++i) *(LAS u32x4*)(vb_ + vlo[i]) = vr[i];
        if (DIFF) { ((LAS int*)(lds + C::POS + buf * 512))[tid & 127] = pkr;
            if (tid < 128) { const int mk_ = wave_max_i(pkr); if (lane == 0) ((LAS int*)(lds + C::PMX))[buf * 2 + wave] = mk_; } }
    };
    LAS float* osv = (LAS float*)(lds + C::OSV) + wave * 2048 + lane;
    float il = 0.f;
    f32x16 oA[2];
#pragma unroll 1
    for (int mp = 0; mp < (DIFF ? 2 : 1); ++mp) {
        bf16x8 qf[NKS];
        { const GAS bf16* qrow = P.Q + (rowb + qi) * P.qp + h * HW + mp * 32;
#pragma unroll
          for (int s = 0; s < NKS; ++s) qf[s] = *(const GAS bf16x8*)(qrow + 16 * s + 8 * hi);
          if (KIND == 0) {
              const GAS float* rp = P.rope + (rowb + qi) * 32 + 8 * hi;
              const f32x4 c0 = *(const GAS f32x4*)rp, c1 = *(const GAS f32x4*)(rp + 4), s0 = *(const GAS f32x4*)(rp + 16), s1 = *(const GAS f32x4*)(rp + 20);
              const u32x4 a = __builtin_bit_cast(u32x4, qf[NKS - 2]), bq = __builtin_bit_cast(u32x4, qf[NKS - 1]); u32x4 ra, rb;
#pragma unroll
              for (int w = 0; w < 4; ++w) { const float cl = w < 2 ? c0[2 * w] : c1[2 * w - 4], ch = w < 2 ? c0[2 * w + 1] : c1[2 * w - 3], sl = w < 2 ? s0[2 * w] : s1[2 * w - 4], sh = w < 2 ? s0[2 * w + 1] : s1[2 * w - 3];
                  const float x1l = bflo(a[w]), x1h = bfhi(a[w]), x2l = bflo(bq[w]), x2h = bfhi(bq[w]);
                  ra[w] = cvtpk(x1l * cl - x2l * sl, x1h * ch - x2h * sh); rb[w] = cvtpk(x1l * sl + x2l * cl, x1h * sh + x2h * ch); }
              qf[NKS - 2] = __builtin_bit_cast(bf16x8, ra); qf[NKS - 1] = __builtin_bit_cast(bf16x8, rb);
          } }
        __syncthreads();
        float m1 = 0.f, l1 = 0.f;
        f32x16 negm;
#pragma unroll
        for (int r = 0; r < 16; ++r) negm[r] = 0.f;
#pragma unroll
        for (int d = 0; d < 2; ++d)
#pragma unroll
            for (int r = 0; r < 16; ++r) oA[d][r] = 0.f;
        gload(0); lstore(0);
        if (NT > 1) gload(1);
        __syncthreads();
        if (DIFF) { bias_far = ((LAS float*)(lds + C::BT))[128];
#pragma unroll
            for (int r = 0; r < 16; ++r) negm[r] = bias_far; }
        const int NTW = (q0w + 31) / 128 + 1;
        auto compute = [&](int t, int buf) {
            const int k0 = 128 * t;
            const LAS unsigned char* kb_ = lds + C::K0 + buf * C::KB + r32 * KP + hi * 16 + mp * 64;
            const LAS unsigned char* vb_ = lds + C::V0 + buf * C::VB + ((lane >> 4) & 1) * 32 + (lane & 3) * 8 + (4 * hi + ((lane & 15) >> 2)) * 64;
            bool nearb = false;
            if (DIFF) { const LAS int* pm = (const LAS int*)(lds + C::PMX) + buf * 2; const int m0 = __builtin_amdgcn_readfirstlane(pm[0]), m1_ = __builtin_amdgcn_readfirstlane(pm[1]); nearb = (minq - (m0 > m1_ ? m0 : m1_)) < 128; }
            f32x16 sc[4];
            if (DIFF) { if (nearb) {
#pragma unroll
                for (int g = 0; g < 4; ++g)
#pragma unroll
                    for (int r = 0; r < 16; ++r) sc[g][r] = -m1; } }
            constexpr int HB = NKS > 3 ? 3 : NKS;
#pragma unroll
            for (int s0_ = 0; s0_ < NKS; s0_ += HB) {
                bf16x8 kf[4][HB];
#pragma unroll
                for (int g = 0; g < 4; ++g)
#pragma unroll
                    for (int s = 0; s < HB; ++s) kf[g][s] = *(const LAS bf16x8*)(kb_ + 32 * g * KP + (s0_ + s) * 32);
                __builtin_amdgcn_sched_barrier(0);
#pragma unroll
                for (int s = 0; s < HB; ++s)
#pragma unroll
                    for (int g = 0; g < 4; ++g) {
                        if (s0_ + s == 0 && !(DIFF && nearb)) sc[g] = __builtin_amdgcn_mfma_f32_32x32x16_bf16(kf[g][s], qf[s0_ + s], negm, 0, 0, 0);
                        else sc[g] = __builtin_amdgcn_mfma_f32_32x32x16_bf16(kf[g][s], qf[s0_ + s], sc[g], 0, 0, 0); }
                __builtin_amdgcn_sched_barrier(0);
            }
            if (DIFF) { if (nearb) {
                const LAS int* pk = (const LAS int*)(lds + C::POS + buf * 512); const LAS float* bt = (const LAS float*)(lds + C::BT);
#pragma unroll
                for (int g = 0; g < 4; ++g)
#pragma unroll
                    for (int r = 0; r < 16; ++r) { int n0 = pq - pk[32 * g + crow(r, hi)]; n0 = n0 < 0 ? 0 : (n0 > 128 ? 128 : n0); sc[g][r] += bt[n0]; }
            } }
            asm volatile("s_nop 15\n\ts_nop 7" : "+v"(sc[0]), "+v"(sc[1]), "+v"(sc[2]), "+v"(sc[3]));
            if (k0 + 127 > q0w) {
#pragma unroll
                for (int g = 0; g < 4; ++g)
#pragma unroll
                    for (int r = 0; r < 16; ++r) { if (k0 + 32 * g + crow(r, hi) > qi) sc[g][r] = -1e30f; }
            }
            const float mx = swapmax(vmax3(max32(sc[0], sc[1]), max32(sc[2], sc[3]), -1e30f));
            const bool up = (t == 0) || mx > 8.0f;
            float al = 1.f;
            if (__builtin_amdgcn_ballot_w64(up) != 0ull) {
                const float dl = up ? mx : 0.f; al = __builtin_amdgcn_exp2f(-dl); l1 *= al; m1 += dl;
#pragma unroll
                for (int r = 0; r < 16; ++r) negm[r] -= dl;
#pragma unroll
                for (int g = 0; g < 4; ++g)
#pragma unroll
                    for (int r = 0; r < 16; ++r) sc[g][r] -= dl;
            }
            float ls = 0.f;
#pragma unroll
            for (int g = 0; g < 4; ++g)
#pragma unroll
                for (int r = 0; r < 16; ++r) { sc[g][r] = __builtin_amdgcn_exp2f(sc[g][r]); ls += sc[g][r]; }
            l1 += ls;
            bf16x8 pf[8];
#pragma unroll
            for (int g = 0; g < 4; ++g) { pf[2 * g] = pack8(sc[g], 0); pf[2 * g + 1] = pack8(sc[g], 8); }
            if (__builtin_amdgcn_ballot_w64(al != 1.0f) != 0ull) {
#pragma unroll
                for (int d = 0; d < 2; ++d)
#pragma unroll
                    for (int r = 0; r < 16; ++r) oA[d][r] *= al;
            }
#pragma unroll
            for (int d = 0; d < 2; ++d) {
                bf16x8 vf[8];
#pragma unroll
                for (int s = 0; s < 8; ++s) { const s16x4 lo = vtr(vb_ + d * 8192 + s * 1024), hh = vtr(vb_ + d * 8192 + s * 1024 + 512); vf[s] = (bf16x8){lo[0], lo[1], lo[2], lo[3], hh[0], hh[1], hh[2], hh[3]}; }
                __builtin_amdgcn_sched_barrier(0);
#pragma unroll
                for (int s = 0; s < 8; ++s) oA[d] = __builtin_amdgcn_mfma_f32_32x32x16_bf16(vf[s], pf[s], oA[d], 0, 0, 0);
                __builtin_amdgcn_sched_barrier(0);
            }
        };
        int t = 0;
        for (; t + 2 < NT; ++t) {
            const int buf = t & 1;
            if (t < NTW) compute(t, buf);
            lstore(buf ^ 1); gload(t + 2);
            TILE_BAR();
        }
        for (; t < NT; ++t) {
            const int buf = t & 1;
            if (t < NTW) compute(t, buf);
            if (t + 1 < NT) lstore(buf ^ 1);
            TILE_BAR();
        }
        il = 1.f / swapadd(l1);
        if (DIFF) { if (mp == 0) {
#pragma unroll
            for (int d = 0; d < 2; ++d)
#pragma unroll
                for (int r = 0; r < 16; ++r) osv[(d * 16 + r) * 64] = oA[d][r] * il; } }
    }
    GAS bf16* orow = P.O + (rowb + qi) * P.op + h * 64;
    if (!DIFF) {
#pragma unroll
        for (int d = 0; d < 2; ++d)
#pragma unroll
            for (int g = 0; g < 4; ++g) { v2u v; v.x = cvtpk(oA[d][4 * g] * il, oA[d][4 * g + 1] * il); v.y = cvtpk(oA[d][4 * g + 2] * il, oA[d][4 * g + 3] * il); *(GAS v2u*)(orow + 32 * d + 8 * g + 4 * hi) = v; }
    } else {
        const float lam = P.lams[0], lam_init = P.lams[1];
        const float i2 = lam * il;
        float ss = 0.f;
#pragma unroll
        for (int d = 0; d < 2; ++d)
#pragma unroll
            for (int r = 0; r < 16; ++r) { const float v = osv[(d * 16 + r) * 64] - oA[d][r] * i2; oA[d][r] = v; ss += v * v; }
        ss = swapadd(ss);
        const float rs = __builtin_amdgcn_rsqf(ss * (1.f / 64.f) + 1e-6f) * (1.f - lam_init);
        const LAS float* dn = (const LAS float*)(lds + C::DN);
#pragma unroll
        for (int d = 0; d < 2; ++d)
#pragma unroll
            for (int g = 0; g < 4; ++g) { const int c = 32 * d + 8 * g + 4 * hi; const f32x4 gn = *(const LAS f32x4*)(dn + c);
                v2u v; v.x = cvtpk(oA[d][4 * g] * rs * gn[0], oA[d][4 * g + 1] * rs * gn[1]); v.y = cvtpk(oA[d][4 * g + 2] * rs * gn[2], oA[d][4 * g + 3] * rs * gn[3]); *(GAS v2u*)(orow + c) = v; }
    }
}

__device__ __forceinline__ void attn_phase(const AttnP& PM, const AttnP& PD, LAS unsigned char* lds, int tid, int wave, int lane, int vcu, int G, int only = -1) {
    for (int i = vcu; i < 512; i += G) {
        if (only >= 0 && (i >> 8) != only) continue;
        const int kind = i >> 8, c = i & 255, bh = c >> 4, s = c & 15;
        if (kind == 0) {
#pragma unroll 1
            for (int k = 0; k < 2; ++k) attn_unit2<0>(PM, bh >> 2, bh & 3, k ? 31 - s : s, lds, tid, wave, lane);
        } else {
#pragma unroll 1
            for (int k = 0; k < 2; ++k) attn_unit2<1>(PD, bh >> 2, bh & 3, k ? 31 - s : s, lds, tid, wave, lane);
        }
    }
}
__device__ __forceinline__ float cx_max16(const f32x16& p) { return fmaxf(fmaxf(fmaxf(fmaxf(p[0], p[1]), fmaxf(p[2], p[3])), fmaxf(fmaxf(p[4], p[5]), fmaxf(p[6], p[7]))), fmaxf(fmaxf(fmaxf(p[8], p[9]), fmaxf(p[10], p[11])), fmaxf(fmaxf(p[12], p[13]), fmaxf(p[14], p[15])))); }
__device__ __forceinline__ void cross_unit2(const AttnP& P, int b, int h, int qb, LAS unsigned char* lds, int wave) {
    const int lane = lane_id_v(), tid = (wave << 6) | lane;
    constexpr int KP = 528;
    const int r32 = lane & 31, hi = lane >> 5;
    const size_t rowb = (size_t)b * S, rowk = (size_t)b * MEM;
    const int qi = qb * 256 + wave * 32 + r32;
    const GAS bf16* Kb = P.K + rowk * P.kp + h * 256; const GAS bf16* Vb = P.V + rowk * P.vp + h * 256;
    const __amdgpu_buffer_rsrc_t rK = __builtin_amdgcn_make_buffer_rsrc((void*)Kb, 0, 0x7fffffff, 0x00020000), rV = __builtin_amdgcn_make_buffer_rsrc((void*)Vb, 0, 0x7fffffff, 0x00020000);
    const GAS bf16* qrow = P.Q + (rowb + qi) * P.qp + h * 256 + 8 * hi;
    bf16x8 qf[4];
#pragma unroll
    for (int s = 0; s < 4; ++s) qf[s] = *(const GAS bf16x8*)(qrow + 16 * s);
    { u32x4 st[16];
#pragma unroll
      for (int i = 0; i < 16; ++i) { const int c = tid + 512 * i; st[i] = __builtin_amdgcn_raw_buffer_load_b128(rK, ((c >> 5) * P.kp + (c & 31) * 8) * 2, 0, 0); }
      TILE_BAR();
#pragma unroll
      for (int i = 0; i < 16; ++i) { const int c = tid + 512 * i; *(LAS u32x4*)(lds + (c >> 5) * KP + (c & 31) * 16) = st[i]; } }
    __syncthreads();
    f32x16 sc[8];
#pragma unroll
    for (int g = 0; g < 8; ++g)
#pragma unroll
        for (int r = 0; r < 16; ++r) sc[g][r] = 0.f;
    const LAS unsigned char* kb_ = lds + r32 * KP + hi * 16;
#pragma unroll
    for (int c = 0; c < 4; ++c) {
        bf16x8 qn[4];
        if (c + 1 < 4) {
#pragma unroll
            for (int s = 0; s < 4; ++s) qn[s] = *(const GAS bf16x8*)(qrow + 64 * (c + 1) + 16 * s); }
#pragma unroll
        for (int g = 0; g < 8; ++g) { bf16x8 kf[4];
#pragma unroll
            for (int s = 0; s < 4; ++s) kf[s] = *(const LAS bf16x8*)(kb_ + 32 * g * KP + (4 * c + s) * 32);
#pragma unroll
            for (int s = 0; s < 4; ++s) sc[g] = __builtin_amdgcn_mfma_f32_32x32x16_bf16(kf[s], qf[s], sc[g], 0, 0, 0); }
        if (c + 1 < 4) {
#pragma unroll
            for (int s = 0; s < 4; ++s) qf[s] = qn[s]; }
    }
    float m = fmaxf(fmaxf(fmaxf(cx_max16(sc[0]), cx_max16(sc[1])), fmaxf(cx_max16(sc[2]), cx_max16(sc[3]))), fmaxf(fmaxf(cx_max16(sc[4]), cx_max16(sc[5])), fmaxf(cx_max16(sc[6]), cx_max16(sc[7]))));
    m = swapmax(m);
    float l = 0.f;
    bf16x8 pf[16];
#pragma unroll
    for (int g = 0; g < 8; ++g) {
#pragma unroll
        for (int r = 0; r < 16; ++r) { sc[g][r] = __builtin_amdgcn_exp2f(sc[g][r] - m); l += sc[g][r]; }
        pf[2 * g] = pack8(sc[g], 0); pf[2 * g + 1] = pack8(sc[g], 8); }
    const float il = 1.f / swapadd(l);
    { u32x4 st[16];
#pragma unroll
      for (int i = 0; i < 16; ++i) { const int c = tid + 512 * i; const int sub = c & 3, key = (c >> 2) & 255, dt = c >> 10; st[i] = __builtin_amdgcn_raw_buffer_load_b128(rV, (key * P.vp + dt * 32 + sub * 8) * 2, 0, 0); }
      TILE_BAR();
#pragma unroll
      for (int i = 0; i < 16; ++i) { const int c = tid + 512 * i; const int sub = c & 3, key = (c >> 2) & 255, dt = c >> 10; *(LAS u32x4*)(lds + dt * 16384 + (key >> 3) * 512 + (key & 7) * 64 + sub * 16) = st[i]; } }
    __syncthreads();
    const LAS unsigned char* vb_ = lds + ((lane >> 4) & 1) * 32 + (lane & 3) * 8 + (4 * hi + ((lane & 15) >> 2)) * 64;
    GAS bf16* orow = P.O + (rowb + qi) * P.op + h * 256;
#pragma unroll 1
    for (int dh = 0; dh < 2; ++dh) {
        f32x16 oA[4];
#pragma unroll
        for (int d = 0; d < 4; ++d)
#pragma unroll
            for (int r = 0; r < 16; ++r) oA[d][r] = 0.f;
#pragma unroll
        for (int d = 0; d < 4; ++d) {
#pragma unroll
            for (int sb = 0; sb < 2; ++sb) { bf16x8 vf[8];
#pragma unroll
                for (int s = 0; s < 8; ++s) { const s16x4 lo = vtr(vb_ + (4 * dh + d) * 16384 + (8 * sb + s) * 1024), hh = vtr(vb_ + (4 * dh + d) * 16384 + (8 * sb + s) * 1024 + 512); vf[s] = (bf16x8){lo[0], lo[1], lo[2], lo[3], hh[0], hh[1], hh[2], hh[3]}; }
#pragma unroll
                for (int s = 0; s < 8; ++s) oA[d] = __builtin_amdgcn_mfma_f32_32x32x16_bf16(vf[s], pf[8 * sb + s], oA[d], 0, 0, 0); } }
#pragma unroll
        for (int d = 0; d < 4; ++d)
#pragma unroll
            for (int g = 0; g < 4; ++g) { v2u v; v.x = cvtpk(oA[d][4 * g] * il, oA[d][4 * g + 1] * il); v.y = cvtpk(oA[d][4 * g + 2] * il, oA[d][4 * g + 3] * il); *(GAS v2u*)(orow + 128 * dh + 32 * d + 8 * g + 4 * hi) = v; }
    }
}
__device__ __forceinline__ void cross_phase(const AttnP& PC, LAS unsigned char* lds, int tid, int wave, int lane, int vcu, int G) {
#pragma unroll 1
    for (int i = vcu; i < 512; i += G) { const int bh = i >> 5; cross_unit2(PC, bh >> 2, bh & 3, i & 31, lds, wave); }
}


__device__ __forceinline__ float vmax2(float a, float b) { float r; asm("v_max_f32_e32 %0, %1, %2" : "=v"(r) : "v"(a), "v"(b)); return r; }
__device__ __forceinline__ float vmin2(float a, float b) { float r; asm("v_min_f32_e32 %0, %1, %2" : "=v"(r) : "v"(a), "v"(b)); return r; }
__device__ __forceinline__ void pad16(float (&a)[16]) {
    asm volatile("s_nop 1" : "+v"(a[0]), "+v"(a[1]), "+v"(a[2]), "+v"(a[3]), "+v"(a[4]), "+v"(a[5]), "+v"(a[6]), "+v"(a[7]), "+v"(a[8]), "+v"(a[9]), "+v"(a[10]), "+v"(a[11]), "+v"(a[12]), "+v"(a[13]), "+v"(a[14]), "+v"(a[15]));
}
__device__ __forceinline__ void sort16_desc(float (&a)[16]) {
#pragma unroll
    for (int k = 2; k <= 16; k <<= 1)
#pragma unroll
        for (int j = k >> 1; j > 0; j >>= 1)
#pragma unroll
            for (int i = 0; i < 16; ++i) { const int l = i ^ j; if (l > i) { const bool desc = ((i & k) == 0); const float hi_ = vmax2(a[i], a[l]), lo_ = vmin2(a[i], a[l]); a[i] = desc ? hi_ : lo_; a[l] = desc ? lo_ : hi_; } }
}
__device__ __forceinline__ void merge16_desc(float (&a)[16], const float (&b)[16]) {
#pragma unroll
    for (int i = 0; i < 16; ++i) a[i] = vmax2(a[i], b[15 - i]);
#pragma unroll
    for (int j = 8; j > 0; j >>= 1)
#pragma unroll
        for (int i = 0; i < 16; ++i) { const int l = i ^ j; if (l > i) { const float hi_ = vmax2(a[i], a[l]), lo_ = vmin2(a[i], a[l]); a[i] = hi_; a[l] = lo_; } }
}
__device__ __forceinline__ void top16_of_64(float (&g0)[16], float (&g1)[16], float (&g2)[16], float (&g3)[16]) {
    sort16_desc(g0); sort16_desc(g1); merge16_desc(g0, g1); sort16_desc(g2); sort16_desc(g3); merge16_desc(g2, g3); merge16_desc(g0, g2);
}
__device__ __forceinline__ float embed(float v, unsigned mask, unsigned id) { return __builtin_bit_cast(float, (__builtin_bit_cast(unsigned, v) & mask) | id); }
__device__ __forceinline__ float mkcand(float x, float y, unsigned id) { return embed(x + y, 0xFFFFFF00u, id); }

__device__ __forceinline__ void swap32(float& a, float& b) { asm volatile("v_nop\n\tv_nop\n\tv_permlane32_swap_b32 %0, %1" : "+v"(a), "+v"(b)); }
struct RouteP { const GAS bf16* QP; const GAS bf16* keys; GAS int* EX; GAS float* GW; };
constexpr int RT_KP = 144, RT_KEYS = 0, RT_SCR = 256 * RT_KP, RT_END = RT_SCR + 8 * 8192;
__device__ __forceinline__ void route_phase(const RouteP& P, LAS unsigned char* lds, int tid, int wave, int lane, int vcu, int G) {
    asm volatile("" : "+v"(tid), "+v"(lane));
    __syncthreads();
    for (int c = tid; c < 256 * 8; c += 512) { const int row = c >> 3, part = c & 7; *(LAS u32x4*)(lds + RT_KEYS + row * RT_KP + part * 16) = *(const u32x4*)(P.keys + row * 64 + part * 8); }
    __syncthreads();
    const int r32 = lane & 31, hi = lane >> 5;
    LAS int* scr = (LAS int*)(lds + RT_SCR + wave * 8192);
    for (int u = vcu; u < T / 32; u += G) {
        const size_t t = (size_t)u * 32 + r32; const int h = wave;
        float T2[2][16];
#pragma unroll
        for (int c = 0; c < 2; ++c) {
            bf16x8 qf[4];
            { const GAS bf16* q = P.QP + t * 1024 + h * 128 + c * 64 + 8 * hi;
#pragma unroll
              for (int s = 0; s < 4; ++s) qf[s] = *(const GAS bf16x8*)(q + 16 * s); }
            f32x16 sc[4];
#pragma unroll
            for (int m = 0; m < 4; ++m) {
#pragma unroll
                for (int r = 0; r < 16; ++r) sc[m][r] = 0.f;
#pragma unroll
                for (int s = 0; s < 4; ++s) { const bf16x8 a = *(const LAS bf16x8*)(lds + RT_KEYS + (c * 128 + 32 * m + r32) * RT_KP + s * 32 + hi * 16);
                    sc[m] = __builtin_amdgcn_mfma_f32_32x32x16_bf16(a, qf[s], sc[m], 0, 0, 0); }
            }
            float g0[16], g1[16], g2[16], g3[16];
            const unsigned h4 = 4u * (unsigned)hi;
#pragma unroll
            for (int r = 0; r < 16; ++r) { const unsigned kr_ = (unsigned)((r & 3) + 8 * (r >> 2));
                g0[r] = embed(sc[0][r], 0xFFFFFF80u, kr_ | h4); g1[r] = embed(sc[1][r], 0xFFFFFF80u, (32u + kr_) | h4); g2[r] = embed(sc[2][r], 0xFFFFFF80u, (64u + kr_) | h4); g3[r] = embed(sc[3][r], 0xFFFFFF80u, (96u + kr_) | h4); }
            top16_of_64(g0, g1, g2, g3);
            pad16(g0);
#pragma unroll
            for (int i = 0; i < 16; ++i) T2[c][i] = g0[i];
        }
        float A[16], Bv[16];
#pragma unroll
        for (int i = 0; i < 16; ++i) { A[i] = T2[0][i]; Bv[i] = T2[1][i]; swap32(A[i], Bv[i]); }
        merge16_desc(A, Bv);
        pad16(A);
        float T0[16], T1[16];
#pragma unroll
        for (int i = 0; i < 16; ++i) { T0[i] = A[i]; T1[i] = A[i]; swap32(T0[i], T1[i]); }
#pragma unroll
        for (int i = 0; i < 16; ++i) { scr[i * 64 + lane] = (int)(__builtin_bit_cast(unsigned, T0[i]) & 127u); scr[(16 + i) * 64 + lane] = (int)(__builtin_bit_cast(unsigned, T1[i]) & 127u);
            T0[i] = embed(T0[i], 0xFFFFFF80u, 0u); T1[i] = embed(T1[i], 0xFFFFFF80u, 0u); }
        float c0[16], c1[16], c2[16], c3[16];
        const float NINF = -__builtin_inff();
#pragma unroll
        for (int b = 0; b < 16; ++b) c0[b] = mkcand(T0[0], T1[b], (unsigned)b);
#pragma unroll
        for (int b = 0; b < 8; ++b) c1[b] = mkcand(T0[1], T1[b], 16u + b);
#pragma unroll
        for (int b = 0; b < 5; ++b) c1[8 + b] = mkcand(T0[2], T1[b], 32u + b);
#pragma unroll
        for (int b = 0; b < 3; ++b) c1[13 + b] = mkcand(T0[4], T1[b], 64u + b);
#pragma unroll
        for (int b = 0; b < 4; ++b) c2[b] = mkcand(T0[3], T1[b], 48u + b);
        c2[4] = mkcand(T0[5], T1[0], 80u); c2[5] = mkcand(T0[5], T1[1], 81u); c2[6] = mkcand(T0[6], T1[0], 96u); c2[7] = mkcand(T0[6], T1[1], 97u); c2[8] = mkcand(T0[7], T1[0], 112u); c2[9] = mkcand(T0[7], T1[1], 113u);
#pragma unroll
        for (int a = 8; a < 14; ++a) c2[10 + a - 8] = mkcand(T0[a], T1[0], 16u * a);
        c3[0] = mkcand(T0[14], T1[0], 224u); c3[1] = mkcand(T0[15], T1[0], 240u);
#pragma unroll
        for (int i = 2; i < 16; ++i) c3[i] = NINF;
        top16_of_64(c0, c1, c2, c3);
        pad16(c0);
        float gsum = 0.f, ge[16]; int ex[16];
        const float mtop = embed(c0[0], 0xFFFFFF00u, 0u);
#pragma unroll
        for (int i = 0; i < 16; ++i) { const unsigned bits = __builtin_bit_cast(unsigned, c0[i]); const int a = (bits >> 4) & 15, b = bits & 15;
            ge[i] = __builtin_amdgcn_exp2f((embed(c0[i], 0xFFFFFF00u, 0u) - mtop) * LOG2E); gsum += ge[i];
            ex[i] = scr[a * 64 + lane] * 128 + scr[(16 + b) * 64 + lane]; }
        const float ginv = __builtin_amdgcn_rcpf(gsum);
        if (hi == 0) { GAS unsigned short* d = (GAS unsigned short*)P.EX + t * 128 + h * 16;
#pragma unroll
            for (int i = 0; i < 16; ++i) d[i] = (unsigned short)ex[i]; }
        else { GAS f32x4* d = (GAS f32x4*)(P.GW + t * 128 + h * 16);
#pragma unroll
            for (int i = 0; i < 4; ++i) d[i] = (f32x4){ge[4 * i] * ginv, ge[4 * i + 1] * ginv, ge[4 * i + 2] * ginv, ge[4 * i + 3] * ginv}; }
    }
}

__device__ __forceinline__ int wave_allsum_i(int v) {
    v += __builtin_amdgcn_update_dpp(0, v, 0xB1, 0xF, 0xF, true);
    v += __builtin_amdgcn_update_dpp(0, v, 0x4E, 0xF, 0xF, true);
    v += __builtin_amdgcn_update_dpp(0, v, 0x141, 0xF, 0xF, true);
    v += __builtin_amdgcn_update_dpp(0, v, 0x140, 0xF, 0xF, true);
    { int a = v, b = v; asm volatile("v_nop\n\tv_nop\n\tv_permlane16_swap_b32 %0, %1" : "+v"(a), "+v"(b)); v = a + b; }
    { int a = v, b = v; asm volatile("v_nop\n\tv_nop\n\tv_permlane32_swap_b32 %0, %1" : "+v"(a), "+v"(b)); v = a + b; }
    return v;
}
__device__ __forceinline__ float wave_allsum(float v) {
    v += __builtin_bit_cast(float, __builtin_amdgcn_update_dpp(0, __builtin_bit_cast(int, v), 0xB1, 0xF, 0xF, true));
    v += __builtin_bit_cast(float, __builtin_amdgcn_update_dpp(0, __builtin_bit_cast(int, v), 0x4E, 0xF, 0xF, true));
    v += __builtin_bit_cast(float, __builtin_amdgcn_update_dpp(0, __builtin_bit_cast(int, v), 0x141, 0xF, 0xF, true));
    v += __builtin_bit_cast(float, __builtin_amdgcn_update_dpp(0, __builtin_bit_cast(int, v), 0x140, 0xF, 0xF, true));
    { float a = v, b = v; asm volatile("v_nop\n\tv_nop\n\tv_permlane16_swap_b32 %0, %1" : "+v"(a), "+v"(b)); v = a + b; }
    { float a = v, b = v; asm volatile("v_nop\n\tv_nop\n\tv_permlane32_swap_b32 %0, %1" : "+v"(a), "+v"(b)); v = a + b; }
    return v;
}
__device__ __forceinline__ float wave_allmax(float v) {
    v = fmaxf(v, __builtin_bit_cast(float, __builtin_amdgcn_update_dpp(0, __builtin_bit_cast(int, v), 0xB1, 0xF, 0xF, true)));
    v = fmaxf(v, __builtin_bit_cast(float, __builtin_amdgcn_update_dpp(0, __builtin_bit_cast(int, v), 0x4E, 0xF, 0xF, true)));
    v = fmaxf(v, __builtin_bit_cast(float, __builtin_amdgcn_update_dpp(0, __builtin_bit_cast(int, v), 0x141, 0xF, 0xF, true)));
    v = fmaxf(v, __builtin_bit_cast(float, __builtin_amdgcn_update_dpp(0, __builtin_bit_cast(int, v), 0x140, 0xF, 0xF, true)));
    { float a = v, b = v; asm volatile("v_nop\n\tv_nop\n\tv_permlane16_swap_b32 %0, %1" : "+v"(a), "+v"(b)); v = fmaxf(a, b); }
    { float a = v, b = v; asm volatile("v_nop\n\tv_nop\n\tv_permlane32_swap_b32 %0, %1" : "+v"(a), "+v"(b)); v = fmaxf(a, b); }
    return v;
}
__device__ __forceinline__ unsigned q4(float a, float b, float c, float d, int off) {
    const int ia = (int)__builtin_rintf(a) + off, ib = (int)__builtin_rintf(b) + off, ic = (int)__builtin_rintf(c) + off, id = (int)__builtin_rintf(d) + off;
    return (unsigned)(ia & 255) | ((unsigned)(ib & 255) << 8) | ((unsigned)(ic & 255) << 16) | ((unsigned)(id & 255) << 24);
}
__device__ __forceinline__ void quant_row(const GAS float* src, GAS unsigned* dst, GAS float* scale, int off, int lane) {
    const GAS f32x4* s = (const GAS f32x4*)src + 4 * lane; f32x4 v[4]; float m = 0.f;
#pragma unroll
    for (int i = 0; i < 4; ++i) { v[i] = s[i]; m = fmaxf(m, fmaxf(fmaxf(__builtin_fabsf(v[i].x), __builtin_fabsf(v[i].y)), fmaxf(__builtin_fabsf(v[i].z), __builtin_fabsf(v[i].w)))); }
    m = wave_allmax(m); const float inv = m > 0.f ? 127.f / m : 0.f;
    v4u w;
    w.x = q4(v[0].x * inv, v[0].y * inv, v[0].z * inv, v[0].w * inv, off); w.y = q4(v[1].x * inv, v[1].y * inv, v[1].z * inv, v[1].w * inv, off);
    w.z = q4(v[2].x * inv, v[2].y * inv, v[2].z * inv, v[2].w * inv, off); w.w = q4(v[3].x * inv, v[3].y * inv, v[3].z * inv, v[3].w * inv, off);
    *((GAS v4u*)dst + lane) = w;
    if (lane == 0) *scale = m * (1.f / 127.f);
}
struct PeerS { int nslices_step, first_slice, nloc, rank; };
__device__ __forceinline__ PeerS peer_sched(const GAS unsigned* rankw, int xcc, int rank) {
    const int lane = lane_id_v();
    const int c = lane < 16 ? (int)__hip_atomic_load(rankw + 64 * lane, __ATOMIC_RELAXED, __HIP_MEMORY_SCOPE_AGENT) : 0;
    const unsigned long long m = __builtin_amdgcn_ballot_w64(c > 0);
    const int nx = __builtin_popcountll(m), myidx = __builtin_popcountll(m & ((1ull << xcc) - 1ull));
    const int cm = __builtin_amdgcn_readlane(c, xcc);
    PeerS s; s.nslices_step = nx > 0 ? nx : 1; s.first_slice = myidx; s.nloc = cm > 0 ? cm : 1; s.rank = rank; return s;
}
struct Peer1P { const GAS unsigned GAS char* HQ; const GAS int* EX; const GAS unsigned GAS char* U8; GAS int* P; };
__device__ __forceinline__ void peer_k1(const Peer1P& Q, const PeerS& sc, int wave, int lane) {
    asm volatile("" : "+v"(lane));
    const int g = lane >> 3, j = lane & 7;
    const __amdgpu_buffer_rsrc_t rU = __builtin_amdgcn_make_buffer_rsrc((void*)Q.U8, 0, 0x7fffffff, 0x00020000);
    for (int s = sc.first_slice; s < 8; s += sc.nslices_step)
        for (int tile = sc.rank; tile < T / 64; tile += sc.nloc) {
            const int soff_ = __builtin_amdgcn_readfirstlane(128 * s);
            const size_t t0 = (size_t)tile * 64 + wave * 8;
            v4u hqn = *(const GAS v4u*)(Q.HQ + t0 * 1024 + 128 * s + 16 * j), exn[2];
#pragma unroll
            for (int i = 0; i < 2; ++i) exn[i] = *(const GAS v4u*)(Q.EX + t0 * 64 + 8 * g + 4 * i);
#pragma unroll 1
            for (int k = 0; k < 8; ++k) {
                const size_t t = t0 + k;
                const v4u hq = hqn; v4u ex[2];
#pragma unroll
                for (int i = 0; i < 2; ++i) ex[i] = exn[i];
                if (k + 1 < 8) {
                    hqn = *(const GAS v4u*)(Q.HQ + (t + 1) * 1024 + 128 * s + 16 * j);
#pragma unroll
                    for (int i = 0; i < 2; ++i) exn[i] = *(const GAS v4u*)(Q.EX + (t + 1) * 64 + 8 * g + 4 * i);
                }
                v4u uu[16];
#pragma unroll
                for (int i = 0; i < 16; ++i) { const unsigned ew = ((i >> 1) & 3) == 0 ? ex[i >> 3].x : ((i >> 1) & 3) == 1 ? ex[i >> 3].y : ((i >> 1) & 3) == 2 ? ex[i >> 3].z : ex[i >> 3].w; unsigned e; if (i & 1) asm("v_lshrrev_b32 %0, 16, %1" : "=v"(e) : "v"(ew)); else asm("v_and_b32 %0, 0xffff, %1" : "=v"(e) : "v"(ew));
                    uu[i] = __builtin_bit_cast(v4u, __builtin_amdgcn_raw_buffer_load_b128(rU, (int)((e << 10) + 16u * (unsigned)j), soff_, 0)); }
                int lo = 0, hi = 0;
#pragma unroll
                for (int i = 0; i < 16; ++i) {
                    int p = __builtin_amdgcn_sdot4((int)uu[i].x, (int)hq.x, 0, false); p = __builtin_amdgcn_sdot4((int)uu[i].y, (int)hq.y, p, false); p = __builtin_amdgcn_sdot4((int)uu[i].z, (int)hq.z, p, false); p = __builtin_amdgcn_sdot4((int)uu[i].w, (int)hq.w, p, false);
                    p += __builtin_amdgcn_update_dpp(0, p, 0xB1, 0xF, 0xF, true); p += __builtin_amdgcn_update_dpp(0, p, 0x4E, 0xF, 0xF, true); p += __builtin_amdgcn_update_dpp(0, p, 0x141, 0xF, 0xF, true);
                    if (i < 8) lo = (j == i) ? p : lo; else hi = (j == i - 8) ? p : hi;
                }
                Q.P[(t * 8 + s) * 64 + 8 * g + j] = (int)__builtin_amdgcn_perm((unsigned)((hi + 32) >> 6), (unsigned)((lo + 32) >> 6), 0x05040100u);
            }
        }
}
__device__ __forceinline__ void peer_w(const GAS int* EX, const GAS float* GW, const GAS int* P, const GAS float* SH, const GAS float* SU, const GAS float* SV, GAS signed char* WQ, GAS float* WSC, int gw, int NGW, int lane,
                                       LAS unsigned char* lds, int tid) {
    asm volatile("" : "+v"(lane), "+v"(tid));
    LAS float* su_l = (LAS float*)lds; LAS float* sv_l = su_l + 16384;
#pragma unroll 4
    for (int i = tid; i < 4096; i += 512) { ((LAS f32x4*)su_l)[i] = ((const GAS f32x4*)SU)[i]; ((LAS f32x4*)sv_l)[i] = ((const GAS f32x4*)SV)[i]; }
    __syncthreads();
    for (int t = gw; t < T; t += NGW) {
        const float sh = SH[t];
#pragma unroll
        for (int q = 0; q < 2; ++q) { const size_t idx = (size_t)t * 128 + lane + 64 * q; const int e = (int)((const GAS unsigned short*)EX)[idx];
            const int slot_ = lane + 64 * q, pix_ = (slot_ >> 4) * 8 + (slot_ & 7), hsel_ = (slot_ >> 3) & 1;
            int pd = 0;
#pragma unroll
            for (int sl = 0; sl < 8; ++sl) { const int pw_ = P[((size_t)t * 8 + sl) * 64 + pix_]; pd += hsel_ ? (pw_ >> 16) : (int)(short)(pw_ & 0xffff); }
            const float w = GW[idx] * gelu_erf((float)pd * (64.f * sh * su_l[e])) * sv_l[e];
            float m = __builtin_fabsf(w);
            m = fmaxf(m, __builtin_bit_cast(float, __builtin_amdgcn_update_dpp(0, __builtin_bit_cast(int, m), 0xB1, 0xF, 0xF, true)));
            m = fmaxf(m, __builtin_bit_cast(float, __builtin_amdgcn_update_dpp(0, __builtin_bit_cast(int, m), 0x4E, 0xF, 0xF, true)));
            m = fmaxf(m, __builtin_bit_cast(float, __builtin_amdgcn_update_dpp(0, __builtin_bit_cast(int, m), 0x141, 0xF, 0xF, true)));
            m = fmaxf(m, __builtin_bit_cast(float, __builtin_amdgcn_update_dpp(0, __builtin_bit_cast(int, m), 0x140, 0xF, 0xF, true)));
            const float inv = m > 0.f ? 127.f / m : 0.f;
            const unsigned wb = (unsigned)((int)__builtin_rintf(w * inv)) & 255u;
            const unsigned b1 = (unsigned)__builtin_amdgcn_update_dpp(0, (int)wb, 0x55, 0xF, 0xF, true), b2 = (unsigned)__builtin_amdgcn_update_dpp(0, (int)wb, 0xAA, 0xF, 0xF, true), b3 = (unsigned)__builtin_amdgcn_update_dpp(0, (int)wb, 0xFF, 0xF, 0xF, true);
            if ((lane & 3) == 0) ((GAS unsigned*)WQ)[idx >> 2] = wb | (b1 << 8) | (b2 << 16) | (b3 << 24);
            if ((lane & 15) == 0) WSC[(size_t)t * 8 + (lane >> 4) + 4 * q] = m * (1.f / 127.f); }
    }
}
__device__ __forceinline__ void tr4x4(unsigned r0, unsigned r1, unsigned r2, unsigned r3, unsigned (&t)[4]) {
    const unsigned x0 = __builtin_amdgcn_perm(r1, r0, 0x05010400u), x1 = __builtin_amdgcn_perm(r1, r0, 0x07030602u), y0 = __builtin_amdgcn_perm(r3, r2, 0x05010400u), y1 = __builtin_amdgcn_perm(r3, r2, 0x07030602u);
    t[0] = __builtin_amdgcn_perm(y0, x0, 0x05040100u); t[1] = __builtin_amdgcn_perm(y0, x0, 0x07060302u); t[2] = __builtin_amdgcn_perm(y1, x1, 0x05040100u); t[3] = __builtin_amdgcn_perm(y1, x1, 0x07060302u);
}
struct Peer2P { const GAS int* EX; const GAS signed char* WQ; const GAS float* WSC; const GAS unsigned char* V8; GAS bf16* XB; GAS float* SSQ; };
__device__ __forceinline__ void peer_k2(const Peer2P& Q, const PeerS& sc, int wave, int lane) {
    asm volatile("" : "+v"(lane));
    const int g = lane >> 3, j = lane & 7, hf = lane >> 5, rp = (lane >> 4) & 1;
    const __amdgpu_buffer_rsrc_t rV = __builtin_amdgcn_make_buffer_rsrc((void*)Q.V8, 0, 0x7fffffff, 0x00020000);
    for (int s = sc.first_slice; s < 8; s += sc.nslices_step)
        for (int tile = sc.rank; tile < T / 64; tile += sc.nloc) {
            const int soff_ = __builtin_amdgcn_readfirstlane(128 * s);
            const size_t t0 = (size_t)tile * 64 + wave * 8;
            v4u exn[2], wqn; float swn;
#pragma unroll
            for (int i = 0; i < 2; ++i) exn[i] = *(const GAS v4u*)(Q.EX + t0 * 64 + 8 * g + 4 * i);
            wqn = *(const GAS v4u*)(Q.WQ + t0 * 128 + 16 * g); swn = Q.WSC[t0 * 8 + g];
#pragma unroll 1
            for (int k = 0; k < 8; ++k) {
                const size_t t = t0 + k;
                v4u ex[2]; const v4u wq = wqn; const float sw = swn;
#pragma unroll
                for (int i = 0; i < 2; ++i) ex[i] = exn[i];
                if (k + 1 < 8) {
#pragma unroll
                    for (int i = 0; i < 2; ++i) exn[i] = *(const GAS v4u*)(Q.EX + (t + 1) * 64 + 8 * g + 4 * i);
                    wqn = *(const GAS v4u*)(Q.WQ + (t + 1) * 128 + 16 * g); swn = Q.WSC[(t + 1) * 8 + g];
                }
                GAS v2u* xp = (GAS v2u*)(Q.XB + t * 1024 + 128 * s + 16 * j + 8 * hf + 4 * rp);
                const v2u xold = *xp;
                v4u vv[16];
#pragma unroll
                for (int i = 0; i < 16; ++i) { const unsigned ew = ((i >> 1) & 3) == 0 ? ex[i >> 3].x : ((i >> 1) & 3) == 1 ? ex[i >> 3].y : ((i >> 1) & 3) == 2 ? ex[i >> 3].z : ex[i >> 3].w; unsigned e; if (i & 1) asm("v_lshrrev_b32 %0, 16, %1" : "=v"(e) : "v"(ew)); else asm("v_and_b32 %0, 0xffff, %1" : "=v"(e) : "v"(ew));
                    vv[i] = __builtin_bit_cast(v4u, __builtin_amdgcn_raw_buffer_load_b128(rV, (int)((e << 10) + 16u * (unsigned)j), soff_, 0)); }
                int ai[16];
#pragma unroll
                for (int i = 0; i < 16; ++i) ai[i] = 0;
#pragma unroll
                for (int q4_ = 0; q4_ < 4; ++q4_) {
                    const unsigned wq4 = q4_ == 0 ? wq.x : q4_ == 1 ? wq.y : q4_ == 2 ? wq.z : wq.w;
#pragma unroll
                    for (int c = 0; c < 4; ++c) { unsigned tt[4];
                        const v4u &a0 = vv[4 * q4_], &a1 = vv[4 * q4_ + 1], &a2 = vv[4 * q4_ + 2], &a3 = vv[4 * q4_ + 3];
                        tr4x4(c == 0 ? a0.x : c == 1 ? a0.y : c == 2 ? a0.z : a0.w, c == 0 ? a1.x : c == 1 ? a1.y : c == 2 ? a1.z : a1.w, c == 0 ? a2.x : c == 1 ? a2.y : c == 2 ? a2.z : a2.w, c == 0 ? a3.x : c == 1 ? a3.y : c == 2 ? a3.z : a3.w, tt);
#pragma unroll
                        for (int b = 0; b < 4; ++b) ai[4 * c + b] = __builtin_amdgcn_sdot4((int)tt[b], (int)wq4, ai[4 * c + b], false); }
                }
                float acc[16];
#pragma unroll
                for (int i = 0; i < 16; ++i) acc[i] = (float)ai[i] * sw;
                float r8[8], r4[4];
#pragma unroll
                for (int m = 0; m < 8; ++m) { float a = acc[m], b = acc[m + 8]; swap32(a, b); r8[m] = a + b; }
#pragma unroll
                for (int n = 0; n < 4; ++n) { float a = r8[n], b = r8[n + 4]; asm volatile("v_nop\n\tv_nop\n\tv_permlane16_swap_b32 %0, %1" : "+v"(a), "+v"(b)); r4[n] = a + b; }
#pragma unroll
                for (int n = 0; n < 4; ++n) r4[n] += __builtin_bit_cast(float, __builtin_amdgcn_update_dpp(0, __builtin_bit_cast(int, r4[n]), 0x128, 0xF, 0xF, true));
                v2u xw; xw.x = pk2(bflo(xold.x) + r4[0], bfhi(xold.x) + r4[1]); xw.y = pk2(bflo(xold.y) + r4[2], bfhi(xold.y) + r4[3]);
                float ss = 0.f;
                if ((lane & 8) == 0) { const float x0 = bflo(xw.x), x1 = bfhi(xw.x), x2 = bflo(xw.y), x3 = bfhi(xw.y); ss = (x0 * x0 + x1 * x1) + (x2 * x2 + x3 * x3); *xp = xw; }
                ss = wave_allsum(ss);
                if (Q.SSQ) { if (lane == 0) Q.SSQ[t * 16 + s] = ss; }
            }
        }
}

struct Args { const float* in[33]; float* out; unsigned char* ws; int ph_lo, ph_hi; };
struct Frame { LAS unsigned char* lds; volatile LAS unsigned* MISC; gu32* ctl; int tid, lane, wave, G, vcu, xcc, xrank; };

__device__ __forceinline__ void transpose_item(const float* W, int ldw, int nsrc0, bf16* WT, int ldt, int rdst0, LAS float* scr, int kb, int nb, int lane, float scale, const float* kgain) {
    const int k0 = 64 * kb, n0 = 32 * nb;
#pragma unroll 8
    for (int i = 0; i < 32; ++i) { const int kk = 2 * i + (lane >> 5); const float gsc = kgain ? kgain[k0 + kk] * scale : scale; scr[kk * 33 + (lane & 31)] = W[(size_t)(k0 + kk) * ldw + nsrc0 + n0 + (lane & 31)] * gsc; }
    LDS_WAIT(); asm volatile("" ::: "memory");
    const int c = lane & 7;
#pragma unroll
    for (int j = 0; j < 4; ++j) { const int n = (lane >> 3) + 8 * j; const LAS float* s = scr + (8 * c) * 33 + n;
        v4u o; o.x = pk2(s[0 * 33], s[1 * 33]); o.y = pk2(s[2 * 33], s[3 * 33]); o.z = pk2(s[4 * 33], s[5 * 33]); o.w = pk2(s[6 * 33], s[7 * 33]);
        *(GAS v4u*)(WT + (size_t)(rdst0 + n0 + n) * ldt + k0 + 8 * c) = o; }
    LDS_WAIT(); asm volatile("" ::: "memory");
}
__device__ __forceinline__ void zero_rect(bf16* base, int ld, int row0, int nrows, int col0, int ncols, int gtid, int gthreads) {
    const int vpr = ncols / 8;
    for (int i = gtid; i < nrows * vpr; i += gthreads) { const int r = i / vpr, c = i % vpr; *(GAS v4u*)(base + (size_t)(row0 + r) * ld + col0 + 8 * c) = (v4u){0u, 0u, 0u, 0u}; }
}

__device__ __forceinline__ void p0_prologue(Frame& F, const Args& a) {
    LAS float* scr = (LAS float*)(F.lds + RING_OFF + F.wave * 16384);
    const int gw = blockIdx.x * NWAVES + F.wave, NGW = F.G * NWAVES;
    const int gtid = blockIdx.x * (NWAVES * 64) + F.tid, gthreads = F.G * NWAVES * 64;
    unsigned char* ws = a.ws;
    x0_phase((const GAS float*)a.in[0], (GAS bf16*)(ws + WS_XNB), (GAS float*)(ws + WS_SSQ), gw, NGW, F.lane);
    constexpr int I_IN = 16 * (INW / 32), I_SQ = 16 * 32, I_CKV = 16 * 64, I_UQ = 3 * 12, I_UKV = 2 * 16, I_L = I_IN + 4 * I_SQ + I_CKV + I_UQ + I_UKV;
    for (int it = gw; it < L * I_L; it += NGW) {
        const int l = it / I_L; int r = it % I_L;
        if (r < I_IN) {
            const int kb = r / 67, nb = r % 67; int src, dst; float sc = 1.f;
            if (nb < 6) { src = 32 * nb; dst = src; } else if (nb < 11) { src = 32 * nb; dst = src + 64; } else { src = 32 * nb; dst = src + 160; if (nb >= 43 && nb < 51) sc = 0.17677669529663687f * LOG2E; }
            transpose_item(a.in[5] + (size_t)l * D * INW, INW, src, (bf16*)(ws + WS_WIN) + (size_t)l * INP * D, D, dst, scr, kb, 0, F.lane, sc, a.in[4] + l * D); continue; } r -= I_IN;
        if (r < I_SQ) { transpose_item(a.in[21] + (size_t)l * D * D, D, 0, (bf16*)(ws + WS_WOUT) + (size_t)l * D * D, D, 0, scr, r / 32, r % 32, F.lane, 1.f, nullptr); continue; } r -= I_SQ;
        if (r < I_SQ) { transpose_item(a.in[24] + (size_t)l * D * D, D, 0, (bf16*)(ws + WS_WCQ) + (size_t)l * D * D, D, 0, scr, r / 32, r % 32, F.lane, 0.0625f * LOG2E, a.in[22] + l * D); continue; } r -= I_SQ;
        if (r < I_SQ) { transpose_item(a.in[26] + (size_t)l * D * D, D, 0, (bf16*)(ws + WS_WCO) + (size_t)l * D * D, D, 0, scr, r / 32, r % 32, F.lane, 1.f, nullptr); continue; } r -= I_SQ;
        if (r < I_SQ) { transpose_item(a.in[28] + (size_t)l * D * D, D, 0, (bf16*)(ws + WS_WPQ) + (size_t)l * D * D, D, 0, scr, r / 32, r % 32, F.lane, 1.f, a.in[27] + l * D); continue; } r -= I_SQ;
        if (r < I_CKV) { transpose_item(a.in[25] + (size_t)l * D * 2 * D, 2 * D, 0, (bf16*)(ws + WS_WCKV) + (size_t)l * 2 * D * D, D, 0, scr, r / 64, r % 64, F.lane, 1.f, nullptr); continue; } r -= I_CKV;
        if (r < I_UQ) { transpose_item(a.in[7] + (size_t)l * 192 * 384, 384, 0, (bf16*)(ws + WS_WUQ) + (size_t)l * 512 * 256, 256, 0, scr, r / 12, r % 12, F.lane, 0.10206207261596575f * LOG2E, a.in[6] + l * 192); continue; } r -= I_UQ;
        transpose_item(a.in[9] + (size_t)l * 128 * 512, 512, 0, (bf16*)(ws + WS_WUKV) + (size_t)l * 512 * 256, 256, 0, scr, r / 16, r % 16, F.lane, 1.f, a.in[8] + l * 128);
    }
    for (int l = 0; l < L; ++l) {
        bf16* win = (bf16*)(ws + WS_WIN) + (size_t)l * INP * D; bf16* wuq = (bf16*)(ws + WS_WUQ) + (size_t)l * 512 * 256; bf16* wukv = (bf16*)(ws + WS_WUKV) + (size_t)l * 512 * 256;
        zero_rect(win, D, 192, 64, 0, D, gtid, gthreads); zero_rect(win, D, 416, 96, 0, D, gtid, gthreads);
        zero_rect(wuq, 256, 0, 384, 192, 64, gtid, gthreads); zero_rect(wuq, 256, 384, 128, 0, 256, gtid, gthreads);
        zero_rect(wukv, 256, 0, 512, 128, 128, gtid, gthreads);
    }
    { float* rope = (float*)(ws + WS_ROPE); const int* pos = (const int*)a.in[2];
      for (int i = gtid; i < T * 16; i += gthreads) { const int t = i >> 4, k = i & 15; const float inv = powf(10000.f, -(float)(2 * k) / 32.f); const float ang = (float)pos[t] * inv;
          rope[(size_t)t * 32 + k] = cosf(ang); rope[(size_t)t * 32 + 16 + k] = sinf(ang); } }
    { const GAS f32x4* ks = (const GAS f32x4*)a.in[29]; GAS v2u* kd = (GAS v2u*)(ws + WS_KEYS);
      for (int i = gtid; i < L * 2 * 128 * 64 / 4; i += gthreads) { const f32x4 v = ks[i]; v2u w; w.x = pk2(v.x, v.y); w.y = pk2(v.z, v.w); kd[i] = w; }
    }
    for (int r = gw; r < 2 * L * 16384; r += NGW) { const int tb = r / (L * 16384), rr = r % (L * 16384);
        quant_row((const GAS float*)a.in[30 + tb] + (size_t)rr * 1024, (GAS unsigned*)(ws + (tb ? WS_V8 : WS_U8) + (size_t)rr * 1024), (GAS float*)(ws + (tb ? WS_SV : WS_SU)) + rr, 0, F.lane); }
    { float* btab = (float*)(ws + WS_BTAB); float* lams = (float*)(ws + WS_LAMS); float* spt = (float*)(ws + WS_SP);
      for (int i = gtid; i < 4 * 129; i += gthreads) { const int h = i / 129, n = i % 129; int bu; if (n < 16) bu = n; else { const int lg = 16 + (int)(logf((float)n / 16.f) / logf(8.f) * 16.f); bu = lg < 31 ? lg : 31; }
          btab[i] = a.in[3][bu * 4 + h] * LOG2E; }
      for (int i = gtid; i < L; i += gthreads) { const float* dl = a.in[17] + i * 128; float s1 = 0.f, s2 = 0.f; for (int j = 0; j < 32; ++j) { s1 += dl[j] * dl[32 + j]; s2 += dl[64 + j] * dl[96 + j]; }
          const float li = 0.8f - 0.6f * expf(-0.3f * (float)i); lams[2 * i] = expf(s1) - expf(s2) + li; lams[2 * i + 1] = li; }
      for (int i = gtid; i < L * 512; i += gthreads) spt[i] = log1pf(expf(-a.in[16][i])); }
    { GAS bf16* wat = (GAS bf16*)(ws + WS_WAT);
      for (int i = gtid; i < L * 8 * 2 * 4096; i += gthreads) { const int in_ = i & 63, out_ = (i >> 6) & 63, gate = (i >> 12) & 1, lg = i >> 13;
          wat[i] = (bf16)f2bf_(a.in[gate ? 14 : 12][(size_t)lg * 4096 + in_ * 64 + out_]); } }
    for (int l = 0; l < L; ++l) norm_phase((const GAS float*)a.in[1], (const GAS float*)a.in[23] + l * D, (GAS bf16*)(ws + WS_MNB) + (size_t)l * NB * MEM * D, NB * MEM, gw, NGW, F.lane);
}

constexpr int NPL = 16, PH_FINAL = 2 + NPL * L;
__global__ void __launch_bounds__(NWAVES * 64, 2) fwd(Args args) {
    extern __shared__ __attribute__((aligned(16))) unsigned char lds[];
    Frame F;
    F.lds = (LAS unsigned char*)lds; F.MISC = (volatile LAS unsigned*)(F.lds + MISC_OFF);
    F.tid = threadIdx.x; F.lane = F.tid & 63; F.wave = __builtin_amdgcn_readfirstlane(F.tid >> 6); F.G = gridDim.x;
    F.vcu = (F.G % 8 == 0) ? ((int)blockIdx.x % 8) * (F.G / 8) + (int)blockIdx.x / 8 : (int)blockIdx.x;
    unsigned char* ws = args.ws;
    F.ctl = (gu32*)(opq(ws) + WS_CTL);
    for (int u = F.tid; u < (LDS_BYTES - LDSCTL_OFF) / 4; u += NWAVES * 64) ((LAS unsigned*)(F.lds + LDSCTL_OFF))[u] = 0u;
    __syncthreads();
    XcdBarrier bar = xcd_barrier_post((unsigned*)(F.ctl + CW_BAR), F.MISC + 8);
    F.xcc = (int)bar.x;
    if (F.tid == 0) F.MISC[12] = __hip_atomic_fetch_add((unsigned*)(F.ctl + CW_RANK) + 64 * bar.x, 1u, __ATOMIC_RELAXED, __HIP_MEMORY_SCOPE_AGENT);
    __syncthreads();
    F.xrank = __builtin_amdgcn_readfirstlane((int)F.MISC[12]);
    const int lo = args.ph_lo, hi = args.ph_hi;
    const int gw = blockIdx.x * NWAVES + F.wave, NGW = F.G * NWAVES;
#define IN(k) (lo <= (k) && (k) < hi)
#define LANE_ (lane_id_v())
#define TID_ ((opqi(F.wave) << 6) | LANE_)
#define SITE() const int G_ = opqi(F.G), wv_ = opqi(F.wave), vcu_ = opqi(F.vcu), gw_ = opqi(gw), NGW_ = opqi(NGW); (void)G_; (void)wv_; (void)vcu_; (void)gw_; (void)NGW_
#if MK_DUP == 99
#define SEAM(k) do { if (IN(k) && IN((k) + 1)) { xcd_barrier(bar, (F.wave == 0 && lane_id_v() == 0) ? 1 : 0); xcd_barrier(bar, (F.wave == 0 && lane_id_v() == 0) ? 1 : 0); } } while (0)
#else
#define SEAM(k) do { if (IN(k) && IN((k) + 1)) xcd_barrier(bar, (F.wave == 0 && lane_id_v() == 0) ? 1 : 0); } while (0)
#endif
#define GEMM_SITE(EPI, Aptr, lda_, Bptr, ldb_, M_, N_, K_, cperm, ...) do { \
        pg8::Gemm g{opq(Aptr), opq(Bptr), M_, N_, K_, lda_, ldb_}; pg8::StaticOrder So; So.init(M_, N_, opqi(F.G), opqi(cperm)); pg8::EPI E{__VA_ARGS__}; \
        pg8::gemm_phase<pg8::EPI, pg8::StaticOrder, true, true>(F.lds + RING_OFF, g, So, E, opqi(F.wave)); } while (0)
    if (IN(0)) { p0_prologue(F, args); }
    SEAM(0);
    if (IN(1)) {
#pragma unroll 1
        for (int l = 0; l < L; ++l)
            GEMM_SITE(EpiBf16, (const GAS bf16*)(opq(ws) + WS_MNB) + (size_t)l * NB * MEM * D, D, (const GAS bf16*)(opq(ws) + WS_WCKV) + (size_t)l * 2 * D * D, D, NB * MEM, 2 * D, D, (int)((blockIdx.x + 64 * l) % F.G),
                      opq((GAS bf16*)(opq(ws) + WS_KVCB) + (size_t)l * NB * MEM * 2 * D), 2 * D, 2 * D, (const GAS float*)nullptr, 0);
    }
    SEAM(1);
    for (int l = 0; l < L; ++l) {
        const int pb = 2 + NPL * l;
        const GAS bf16* XNB = (const GAS bf16*)(opq(ws) + WS_XNB); const GAS bf16* YB = (const GAS bf16*)(opq(ws) + WS_YB); GAS bf16* PROJB = (GAS bf16*)(opq(ws) + WS_PROJB);
        if (IN(pb + 1)) GEMM_SITE(EpiBf16, XNB, D, (const GAS bf16*)(opq(ws) + WS_WIN) + (size_t)l * INP * D, D, T, INP, D, (int)blockIdx.x, opq(PROJB), INP, INP, opq((const GAS float*)(opq(ws) + WS_SSQ)), 8);
#if MK_DUP == 1
        if (IN(pb + 1)) GEMM_SITE(EpiBf16, XNB, D, (const GAS bf16*)(opq(ws) + WS_WIN) + (size_t)l * INP * D, D, T, INP, D, (int)blockIdx.x, opq(PROJB), INP, INP, opq((const GAS float*)(opq(ws) + WS_SSQ)), 8);
#endif
        SEAM(pb + 1);
        if (IN(pb + 2)) {
            SITE();
            pre_phase(opq((const GAS bf16*)PROJB), opq((const GAS float*)(opq(ws) + WS_ROPE)), opq((GAS float*)(opq(ws) + WS_RS)), opq((GAS bf16*)(opq(ws) + WS_KMB)), gw_, NGW_, LANE_);
#if MK_DUP == 21
            pre_phase(opq((const GAS bf16*)PROJB), opq((const GAS float*)(opq(ws) + WS_ROPE)), opq((GAS float*)(opq(ws) + WS_RS)), opq((GAS bf16*)(opq(ws) + WS_KMB)), gw_, NGW_, LANE_);
#endif
            LruP LP{opq((const GAS bf16*)PROJB), (const GAS float*)args.in[opqi(10)] + l * 4 * 512, (const GAS float*)args.in[opqi(11)] + l * 512, opq((const GAS bf16*)(opq(ws) + WS_WAT)) + (size_t)l * 8 * 2 * 4096, (const GAS float*)args.in[opqi(13)] + l * 512, (const GAS float*)args.in[opqi(15)] + l * 512,
                    (const GAS float*)(opq(ws) + WS_SP) + l * 512, opq((GAS unsigned*)(opq(ws) + WS_HLB)), opq((GAS float*)(opq(ws) + WS_LSUM))};
            lru_phase(LP, F.lds, TID_, wv_, LANE_, vcu_, G_);
#if MK_DUP == 2
            lru_phase(LP, F.lds, TID_, wv_, LANE_, vcu_, G_);
#endif
        }
        SEAM(pb + 2);
        if (IN(pb + 3)) {
            GEMM_SITE(EpiUp, (const GAS bf16*)PROJB + PC_CQ, INP, (const GAS bf16*)(opq(ws) + WS_WUQ) + (size_t)l * 512 * 256, 256, T, 512, 256, (int)blockIdx.x,
                      opq((GAS bf16*)(opq(ws) + WS_QMB)), (GAS bf16*)nullptr, 384, 384, opq((const GAS float*)(opq(ws) + WS_RS)), 0, 0);
            GEMM_SITE(EpiUp, (const GAS bf16*)PROJB + PC_CKV, INP, (const GAS bf16*)(opq(ws) + WS_WUKV) + (size_t)l * 512 * 256, 256, T, 512, 256, (int)blockIdx.x,
                      opq((GAS bf16*)(opq(ws) + WS_KMB)), opq((GAS bf16*)(opq(ws) + WS_VMB)), 0, 512, opq((const GAS float*)(opq(ws) + WS_RS)), 1, 1);
#if MK_DUP == 3
            GEMM_SITE(EpiUp, (const GAS bf16*)PROJB + PC_CQ, INP, (const GAS bf16*)(opq(ws) + WS_WUQ) + (size_t)l * 512 * 256, 256, T, 512, 256, (int)blockIdx.x,
                      opq((GAS bf16*)(opq(ws) + WS_QMB)), (GAS bf16*)nullptr, 384, 384, opq((const GAS float*)(opq(ws) + WS_RS)), 0, 0);
            GEMM_SITE(EpiUp, (const GAS bf16*)PROJB + PC_CKV, INP, (const GAS bf16*)(opq(ws) + WS_WUKV) + (size_t)l * 512 * 256, 256, T, 512, 256, (int)blockIdx.x,
                      opq((GAS bf16*)(opq(ws) + WS_KMB)), opq((GAS bf16*)(opq(ws) + WS_VMB)), 0, 512, opq((const GAS float*)(opq(ws) + WS_RS)), 1, 1);
#endif
        }
        SEAM(pb + 3);
        if (IN(pb + 4)) {
            SITE();
            AttnP PM{opq((const GAS bf16*)(opq(ws) + WS_QMB)), opq((const GAS bf16*)(opq(ws) + WS_KMB)), opq((const GAS bf16*)(opq(ws) + WS_VMB)), 384, 384, 256, opq((GAS bf16*)(opq(ws) + WS_OMB)), 256, opq((const GAS float*)(opq(ws) + WS_ROPE)), nullptr, nullptr, nullptr, nullptr};
            AttnP PD{opq((const GAS bf16*)PROJB + PC_QD), opq((const GAS bf16*)PROJB + PC_KD), opq((const GAS bf16*)PROJB + PC_VD), INP, INP, INP, opq((GAS bf16*)(opq(ws) + WS_YB) + 768), 1024, nullptr,
                     (const GAS int*)args.in[opqi(2)], (const GAS float*)(opq(ws) + WS_BTAB), (const GAS float*)args.in[opqi(18)] + l * 64, (const GAS float*)(opq(ws) + WS_LAMS) + 2 * l};
            attn_phase(PM, PD, F.lds, TID_, wv_, LANE_, vcu_, G_);
#if MK_DUP == 4
            __syncthreads(); attn_phase(PM, PD, F.lds, TID_, wv_, LANE_, vcu_, G_);
#elif MK_DUP == 40 || MK_DUP == 41
            __syncthreads(); attn_phase(PM, PD, F.lds, TID_, wv_, LANE_, vcu_, G_, MK_DUP - 40);
#endif
        }
        SEAM(pb + 4);
        if (IN(pb + 5)) {
            SITE();
            PostP PP{opq((const GAS bf16*)(opq(ws) + WS_OMB)), opq((const GAS unsigned*)(opq(ws) + WS_HLB)), opq((const GAS float*)(opq(ws) + WS_LSUM)), opq((const GAS bf16*)PROJB), (const GAS float*)args.in[opqi(19)] + l * 256, (const GAS float*)args.in[opqi(20)] + l * 512, opq((GAS bf16*)(opq(ws) + WS_YB))};
            post_phase(PP, F.lds, TID_, wv_, LANE_, vcu_, G_);
#if MK_DUP == 5
            __syncthreads(); post_phase(PP, F.lds, TID_, wv_, LANE_, vcu_, G_);
#endif
        }
        SEAM(pb + 5);
        if (IN(pb + 6)) GEMM_SITE(EpiRes, YB, D, (const GAS bf16*)(opq(ws) + WS_WOUT) + (size_t)l * D * D, D, T, D, D, (int)blockIdx.x, opq((GAS bf16*)(opq(ws) + WS_XNB)), opq((GAS float*)(opq(ws) + WS_SSQ)));
#if MK_DUP == 6
        if (IN(pb + 6)) GEMM_SITE(EpiRes, YB, D, (const GAS bf16*)(opq(ws) + WS_WOUT) + (size_t)l * D * D, D, T, D, D, (int)blockIdx.x, opq((GAS bf16*)(opq(ws) + WS_HLB)), opq((GAS float*)(opq(ws) + WS_OMB)));
#endif
        SEAM(pb + 6);
        if (IN(pb + 8)) GEMM_SITE(EpiBf16, XNB, D, (const GAS bf16*)(opq(ws) + WS_WCQ) + (size_t)l * D * D, D, T, D, D, (int)blockIdx.x, opq(PROJB), D, D, opq((const GAS float*)(opq(ws) + WS_SSQ)), 16);
#if MK_DUP == 8
        if (IN(pb + 8)) GEMM_SITE(EpiBf16, XNB, D, (const GAS bf16*)(opq(ws) + WS_WCQ) + (size_t)l * D * D, D, T, D, D, (int)blockIdx.x, opq(PROJB), D, D, opq((const GAS float*)(opq(ws) + WS_SSQ)), 16);
#endif
        SEAM(pb + 8);
        if (IN(pb + 9)) {
            SITE();
            const GAS bf16* kv = (const GAS bf16*)(opq(ws) + WS_KVCB) + (size_t)l * NB * MEM * 2 * D;
            AttnP PC{opq((const GAS bf16*)PROJB), opq(kv), opq(kv + D), 1024, 2 * D, 2 * D, opq((GAS bf16*)(opq(ws) + WS_YB)), 1024, nullptr, nullptr, nullptr, nullptr, nullptr};
            cross_phase(PC, F.lds, TID_, wv_, LANE_, vcu_, G_);
#if MK_DUP == 9
            cross_phase(PC, F.lds, TID_, wv_, LANE_, vcu_, G_);
#endif
        }
        SEAM(pb + 9);
        if (IN(pb + 10)) GEMM_SITE(EpiRes, YB, D, (const GAS bf16*)(opq(ws) + WS_WCO) + (size_t)l * D * D, D, T, D, D, (int)blockIdx.x, opq((GAS bf16*)(opq(ws) + WS_XNB)), opq((GAS float*)(opq(ws) + WS_SSQ)));
        SEAM(pb + 10);
        if (IN(pb + 12)) { GEMM_SITE(EpiBf16, XNB, D, (const GAS bf16*)(opq(ws) + WS_WPQ) + (size_t)l * D * D, D, T, D, D, (int)blockIdx.x, opq(PROJB), D, D, opq((const GAS float*)(opq(ws) + WS_SSQ)), 16);
#if MK_DUP == 12
            hq_phase(opq(XNB), opq((const GAS float*)(opq(ws) + WS_SSQ)), (const GAS float*)args.in[opqi(27)] + l * D, opq((GAS unsigned char*)(opq(ws) + WS_HQ)), opq((GAS float*)(opq(ws) + WS_SH)), opq((GAS int*)(opq(ws) + WS_P)), gw_, NGW_, LANE_);
#endif
            }
        SEAM(pb + 12);
        if (IN(pb + 13)) {
            SITE();
            RouteP RP{opq((const GAS bf16*)PROJB), opq((const GAS bf16*)(opq(ws) + WS_KEYS) + (size_t)l * 2 * 128 * 64), opq((GAS int*)(opq(ws) + WS_EX)), opq((GAS float*)(opq(ws) + WS_GW))};
            route_phase(RP, F.lds, TID_, wv_, LANE_, vcu_, G_);
            hq_phase(opq(XNB), opq((const GAS float*)(opq(ws) + WS_SSQ)), (const GAS float*)args.in[opqi(27)] + l * D, opq((GAS unsigned char*)(opq(ws) + WS_HQ)), opq((GAS float*)(opq(ws) + WS_SH)), opq((GAS int*)(opq(ws) + WS_P)), gw_, NGW_, LANE_);
#if MK_DUP == 13
            route_phase(RP, F.lds, TID_, wv_, LANE_, vcu_, G_);
#endif
        }
        SEAM(pb + 13);
        if (IN(pb + 14)) {
            SITE();
            const PeerS ps = peer_sched((const GAS unsigned*)(F.ctl + CW_RANK), opqi(F.xcc), opqi(F.xrank));
            Peer1P Q1{opq((const GAS unsigned char*)(opq(ws) + WS_HQ)), opq((const GAS int*)(opq(ws) + WS_EX)), opq((const GAS unsigned char*)(opq(ws) + WS_U8) + (size_t)l * 16384 * 1024), opq((GAS int*)(opq(ws) + WS_PROJB))};
            peer_k1(Q1, ps, wv_, LANE_);
#if MK_DUP == 141
            { Peer1P Q1b = Q1; Q1b.P = (GAS int*)(opq(ws) + WS_HLB); peer_k1(Q1b, ps, wv_, LANE_); }
#endif
        }
        SEAM(pb + 14);
        if (IN(pb + 15)) {
            SITE();
            peer_w(opq((const GAS int*)(opq(ws) + WS_EX)), opq((const GAS float*)(opq(ws) + WS_GW)), opq((const GAS int*)(opq(ws) + WS_PROJB)), opq((const GAS float*)(opq(ws) + WS_SH)), opq((const GAS float*)(opq(ws) + WS_SU) + l * 16384), opq((const GAS float*)(opq(ws) + WS_SV) + l * 16384),
                   opq((GAS signed char*)(opq(ws) + WS_W)), opq((GAS float*)(opq(ws) + WS_WS)), gw_, NGW_, LANE_, F.lds, TID_);
#if MK_DUP == 150
            peer_w(opq((const GAS int*)(opq(ws) + WS_EX)), opq((const GAS float*)(opq(ws) + WS_GW)), opq((const GAS int*)(opq(ws) + WS_PROJB)), opq((const GAS float*)(opq(ws) + WS_SH)), opq((const GAS float*)(opq(ws) + WS_SU) + l * 16384), opq((const GAS float*)(opq(ws) + WS_SV) + l * 16384),
                   opq((GAS signed char*)(opq(ws) + WS_W)), opq((GAS float*)(opq(ws) + WS_WS)), gw_, NGW_, LANE_, F.lds, TID_);
#endif
            xcd_barrier(bar, (F.wave == 0 && lane_id_v() == 0) ? 1 : 0);
            const PeerS ps = peer_sched((const GAS unsigned*)(F.ctl + CW_RANK), opqi(F.xcc), opqi(F.xrank));
            Peer2P Q2{opq((const GAS int*)(opq(ws) + WS_EX)), opq((const GAS signed char*)(opq(ws) + WS_W)), opq((const GAS float*)(opq(ws) + WS_WS)), opq((const GAS unsigned char*)(opq(ws) + WS_V8) + (size_t)l * 16384 * 1024), opq((GAS bf16*)(opq(ws) + WS_XNB)), opq((GAS float*)(opq(ws) + WS_SSQ))};
            peer_k2(Q2, ps, wv_, LANE_);
#if MK_DUP == 151
            { Peer2P Q2b = Q2; Q2b.XB = (GAS bf16*)(opq(ws) + WS_HLB); Q2b.SSQ = (GAS float*)(opq(ws) + WS_OMB); peer_k2(Q2b, ps, wv_, LANE_); }
#endif
        }
        SEAM(pb + 15);
    }
    if (IN(PH_FINAL)) { SITE(); final_norm_phase(opq((const GAS bf16*)(opq(ws) + WS_XNB)), (GAS float*)args.out, (const GAS float*)args.in[opqi(32)], T, gw_, NGW_, LANE_); }
#undef IN
#undef SEAM
#undef GEMM_SITE
}
}
extern "C" void kernel_launch(void* const* d_in, const int* in_sizes, int n_in, void* d_out, int out_size, void* d_ws, size_t ws_size, hipStream_t stream) {
    (void)in_sizes; (void)out_size;
    static int grid = 0;
    if (grid == 0) {
        int dev = 0, cus = 0, per_cu = 0;
        if (n_in != 33 || ws_size < mk::WS_END) { fprintf(stderr, "kernel_launch: unexpected n_in %d / ws_size %zu\n", n_in, ws_size); grid = -1; return; }
        if (hipGetDevice(&dev) != hipSuccess || hipDeviceGetAttribute(&cus, hipDeviceAttributeMultiprocessorCount, dev) != hipSuccess) { grid = -1; return; }
        if (hipFuncSetAttribute((const void*)mk::fwd, hipFuncAttributeMaxDynamicSharedMemorySize, mk::LDS_BYTES) != hipSuccess) { fprintf(stderr, "kernel_launch: hipFuncSetAttribute failed\n"); grid = -1; return; }
        if (hipOccupancyMaxActiveBlocksPerMultiprocessor(&per_cu, (const void*)mk::fwd, mk::NWAVES * 64, mk::LDS_BYTES) != hipSuccess || per_cu < 1) fprintf(stderr, "kernel_launch: occupancy query says %d\n", per_cu);
        (void)hipGetLastError();
        grid = cus;
    }
    if (grid < 0) return;
    unsigned char* ws = (unsigned char*)d_ws;
    (void)hipMemsetAsync(ws + mk::WS_CTL, 0, mk::CTL_ZERO_BYTES, stream);
    mk::Args a{};
    for (int i = 0; i < 33; ++i) a.in[i] = (const float*)d_in[i];
    a.out = (float*)d_out; a.ws = ws;
    auto run = [&](int lo, int hi) { a.ph_lo = lo; a.ph_hi = hi; hipLaunchKernelGGL(mk::fwd, dim3(grid), dim3(mk::NWAVES * 64), mk::LDS_BYTES, stream, a); };
#if MK_ONE_LAUNCH
    run(0, mk::PH_FINAL + 1);
#else
    for (int p = 0; p <= mk::PH_FINAL; ++p) {
        const int k = (p - 2) % mk::NPL, l = (p - 2) / mk::NPL;
#if MK_NAIVE_PEER == 2
        if (p >= 2 && p < mk::PH_FINAL && k == 14) {
            hipLaunchKernelGGL(k_peer, dim3(T), dim3(256), 0, stream, (const bf16_t*)(ws + mk::WS_XNB), (const int*)(ws + mk::WS_EX), (const float*)(ws + mk::WS_GW), (const float*)d_in[30] + (size_t)l * NEXP * D, (const float*)d_in[31] + (size_t)l * NEXP * D, (float*)d_out);
            continue; }
#elif MK_NAIVE_PEER == 1
        if (p >= 2 && p < mk::PH_FINAL && k == 13) {
            float* TQ = (float*)(ws + (size_t)806 * mk::MiB);
            hipLaunchKernelGGL(k_bf2f, dim3((unsigned)(((size_t)T * D + 255) / 256)), dim3(256), 0, stream, (const bf16_t*)(ws + mk::WS_PROJB), TQ, (long)T * D);
            hipLaunchKernelGGL(k_route, dim3(T), dim3(256), 0, stream, TQ, (const float*)d_in[29] + (size_t)l * 2 * 128 * 64, (int*)(ws + mk::WS_EX), (float*)(ws + mk::WS_GW));
            hipLaunchKernelGGL(k_peer, dim3(T), dim3(256), 0, stream, (const bf16_t*)(ws + mk::WS_XNB), (const int*)(ws + mk::WS_EX), (const float*)(ws + mk::WS_GW), (const float*)d_in[30] + (size_t)l * NEXP * D, (const float*)d_in[31] + (size_t)l * NEXP * D, (float*)d_out);
            continue; }
        if (p >= 2 && p < mk::PH_FINAL && k == 14) continue;
#endif
        run(p, p + 1); }
#endif
}
```

```cpp
#include <hip/hip_runtime.h>
#include <cstdint>
#include <cstdio>
#include <cmath>

#ifndef MK_ONE_LAUNCH
#define MK_ONE_LAUNCH 1
#endif
#ifndef MK_DUP
#define MK_DUP 0
#endif
#ifndef MK_NAIVE_PEER
#define MK_NAIVE_PEER 0
#endif
namespace pg8 {
#define PG8_LAS __attribute__((address_space(3)))
#ifndef GAS
#define GAS __attribute__((address_space(1)))
#endif
typedef unsigned short bf16_t;
typedef short bf16x8 __attribute__((ext_vector_type(8)));
typedef float f32x4 __attribute__((ext_vector_type(4)));
typedef unsigned u32x4 __attribute__((ext_vector_type(4)));
typedef unsigned u32x2 __attribute__((ext_vector_type(2)));
constexpr int BM = 256, BK = 64, HALF = 128, HTB = HALF * BK * 2, STAGE_BYTES = 8 * HTB, NXCD = 8, WGM = 8;
__host__ __device__ __forceinline__ int lds_byte(int r, int c) { const int st = (r >> 4) * 2 + (c >> 5), rr = r & 15, cc = c & 31, ob = rr * 64 + cc * 2; return st * 1024 + (ob ^ (((ob >> 9) & 1) << 5)); }
__host__ __device__ __forceinline__ void stage_rc(int b, int& R, int& C) { const int st = b / 1024, sb = b % 1024, swz = sb ^ (((sb >> 9) & 1) << 5); R = (st >> 1) * 16 + swz / 64; C = (st & 1) * 32 + (swz % 64) / 2; }
__host__ __device__ __forceinline__ int perm32(int rho) { const int n = rho >> 4, i = rho & 15; return 8 * (i >> 2) + 4 * n + (i & 3); }
__device__ __forceinline__ int pg8_lane_id() { int l; asm volatile("v_mbcnt_lo_u32_b32 %0, -1, 0\n\tv_mbcnt_hi_u32_b32 %0, -1, %0" : "=v"(l)); return l; }
struct Unit { int pm, pn; };
struct Gemm { const GAS bf16_t* A; const GAS bf16_t* Bt; int M, N, K, lda, ldb; };
struct StaticOrder {
    int nM, nN, nwg, G, c;
    __host__ __device__ void init(int M, int N, int G_, int c_) { nM = M / BM; nN = N / BM; nwg = nM * nN; G = G_; c = c_; }
    __host__ __device__ bool next(int i, Unit& u) const {
        const long L = (long)i * G + c; if (L >= nwg) return false;
        int wgid = (int)L; { const int q = nwg / NXCD, r = nwg % NXCD, xcd = wgid % NXCD, off = wgid / NXCD; wgid = (xcd < r ? xcd * (q + 1) : r * (q + 1) + (xcd - r) * q) + off; }
        const int nig = WGM * nN, gid = wgid / nig, fm = gid * WGM, gsz = (nM - fm) < WGM ? (nM - fm) : WGM;
        u.pm = fm + ((wgid % nig) % gsz); u.pn = (wgid % nig) / gsz; return true;
    }
    __device__ __forceinline__ void a_ready(const Unit&) const {}
    __device__ __forceinline__ void done(const Unit&) const {}
};
__device__ __forceinline__ unsigned cvt_pk_bf16(float lo, float hi) { unsigned r; asm volatile("v_cvt_pk_bf16_f32 %0, %1, %2" : "=v"(r) : "v"(lo), "v"(hi)); return r; }

struct EpiF32 {
    static constexpr bool PERM = false, AFTER_DRAIN = false;
    GAS float* C; int ldc; int nvalid; int accum;
    __device__ __forceinline__ void operator()(const f32x4 (&acc)[2][2][4][2], const Unit& u, int wr, int wc, int fr, int fq) const {
        { const int l_ = pg8_lane_id(); fr = l_ & 15; fq = l_ >> 4; }
#pragma unroll
        for (int ai = 0; ai < 2; ++ai)
#pragma unroll
            for (int m = 0; m < 4; ++m) { const size_t row = (size_t)u.pm * BM + ai * HALF + wr * 64 + m * 16 + fr;
#pragma unroll
                for (int bj = 0; bj < 2; ++bj)
#pragma unroll
                    for (int n = 0; n < 2; ++n) { const int col = u.pn * BM + bj * HALF + wc * 32 + n * 16 + 4 * fq;
                        if (col < nvalid) { GAS float* p = C + row * ldc + col; f32x4 v = acc[ai][bj][m][n]; if (accum) v += *(const GAS f32x4*)p; *(GAS f32x4*)p = v; } } }
    }
};
struct EpiBf16 {
    static constexpr bool PERM = true, AFTER_DRAIN = false;
    GAS bf16_t* O; int ldc; int nvalid; const GAS float* ssq; int np;
    __device__ __forceinline__ void operator()(const f32x4 (&acc)[2][2][4][2], const Unit& u, int wr, int wc, int fr, int fq) const {
        { const int l_ = pg8_lane_id(); fr = l_ & 15; fq = l_ >> 4; }
#pragma unroll
        for (int ai = 0; ai < 2; ++ai)
#pragma unroll
            for (int m = 0; m < 4; ++m) { const size_t row = (size_t)u.pm * BM + ai * HALF + wr * 64 + m * 16 + fr;
                float rs_ = 1.f;
                if (np > 0) { const GAS f32x4* sp = (const GAS f32x4*)(ssq + row * 16); f32x4 t = sp[0] + sp[1]; if (np > 8) t += sp[2] + sp[3]; rs_ = __builtin_amdgcn_rsqf(((t[0] + t[1]) + (t[2] + t[3])) * (1.f / 1024.f) + 1e-6f); }
#pragma unroll
                for (int bj = 0; bj < 2; ++bj) { const int col = u.pn * BM + bj * HALF + wc * 32 + 8 * fq;
                    if (col < nvalid) { const f32x4 v0 = acc[ai][bj][m][0] * rs_, v1 = acc[ai][bj][m][1] * rs_; u32x4 w; w.x = cvt_pk_bf16(v0[0], v0[1]); w.y = cvt_pk_bf16(v0[2], v0[3]); w.z = cvt_pk_bf16(v1[0], v1[1]); w.w = cvt_pk_bf16(v1[2], v1[3]);
                        *(GAS u32x4*)(O + row * ldc + col) = w; } } }
    }
};
struct EpiUp {
    static constexpr bool PERM = true, AFTER_DRAIN = false;
    GAS bf16_t* O; GAS bf16_t* O2; int ldc; int nvalid; const GAS float* rs; int rsi; int mode;
    __device__ __forceinline__ void operator()(const f32x4 (&acc)[2][2][4][2], const Unit& u, int wr, int wc, int fr, int fq) const {
        { const int l_ = pg8_lane_id(); fr = l_ & 15; fq = l_ >> 4; }
#pragma unroll
        for (int ai = 0; ai < 2; ++ai)
#pragma unroll
            for (int m = 0; m < 4; ++m) { const size_t row = (size_t)u.pm * BM + ai * HALF + wr * 64 + m * 16 + fr; const float s = rs[2 * row + rsi];
#pragma unroll
                for (int bj = 0; bj < 2; ++bj) { const int col = u.pn * BM + bj * HALF + wc * 32 + 8 * fq;
                    if (col < nvalid) { const f32x4 v0 = acc[ai][bj][m][0] * s, v1 = acc[ai][bj][m][1] * s; u32x4 w; w.x = cvt_pk_bf16(v0[0], v0[1]); w.y = cvt_pk_bf16(v0[2], v0[3]); w.z = cvt_pk_bf16(v1[0], v1[1]); w.w = cvt_pk_bf16(v1[2], v1[3]);
                        GAS bf16_t* dst;
                        if (mode == 0) dst = O + row * ldc + col;
                        else { const int h = col >> 7, j = col & 127; dst = (j < 64) ? O + row * 384 + h * 96 + j : O2 + row * 256 + h * 64 + (j - 64); }
                        *(GAS u32x4*)dst = w; } } }
    }
};

struct EpiRes {
    static constexpr bool PERM = true, AFTER_DRAIN = false;
    GAS bf16_t* XB; GAS float* SSQ;
    __device__ __forceinline__ void operator()(const f32x4 (&acc)[2][2][4][2], const Unit& u, int wr, int wc, int fr, int fq) const {
        { const int l_ = pg8_lane_id(); fr = l_ & 15; fq = l_ >> 4; }
#pragma unroll
        for (int ai = 0; ai < 2; ++ai)
#pragma unroll
            for (int m = 0; m < 4; ++m) { const size_t row = (size_t)u.pm * BM + ai * HALF + wr * 64 + m * 16 + fr; float ss = 0.f;
#pragma unroll
                for (int bj = 0; bj < 2; ++bj) { GAS u32x4* p = (GAS u32x4*)(XB + row * 1024 + u.pn * BM + bj * HALF + wc * 32 + 8 * fq);
                    const u32x4 o = *p; const f32x4 v0 = acc[ai][bj][m][0], v1 = acc[ai][bj][m][1];
                    u32x4 w;
                    w.x = cvt_pk_bf16(__builtin_bit_cast(float, o.x << 16) + v0[0], __builtin_bit_cast(float, o.x & 0xffff0000u) + v0[1]);
                    w.y = cvt_pk_bf16(__builtin_bit_cast(float, o.y << 16) + v0[2], __builtin_bit_cast(float, o.y & 0xffff0000u) + v0[3]);
                    w.z = cvt_pk_bf16(__builtin_bit_cast(float, o.z << 16) + v1[0], __builtin_bit_cast(float, o.z & 0xffff0000u) + v1[1]);
                    w.w = cvt_pk_bf16(__builtin_bit_cast(float, o.w << 16) + v1[2], __builtin_bit_cast(float, o.w & 0xffff0000u) + v1[3]);
                    *p = w;
#pragma unroll
                    for (int e = 0; e < 4; ++e) { const float a = __builtin_bit_cast(float, w[e] << 16), b = __builtin_bit_cast(float, w[e] & 0xffff0000u); ss += a * a + b * b; } }
                { float a = ss, b = ss; asm volatile("v_nop\n\tv_nop\n\tv_permlane16_swap_b32 %0, %1" : "+v"(a), "+v"(b)); ss = a + b; }
                { float a = ss, b = ss; asm volatile("v_nop\n\tv_nop\n\tv_permlane32_swap_b32 %0, %1" : "+v"(a), "+v"(b)); ss = a + b; }
                if (fq == 0) SSQ[row * 16 + 4 * u.pn + wc] = ss; }
    }
};
template <class Epi, class Sched, bool ALIGN_EPI = false, bool SP2 = false>
__device__ __forceinline__ void gemm_phase(PG8_LAS unsigned char* lds, const Gemm g, const Sched& S, const Epi& E, int wave_id) {
    int tid_ = (wave_id << 6) | pg8_lane_id(); asm volatile("" : "+v"(tid_));
    const int tid = tid_, wid = __builtin_amdgcn_readfirstlane(tid >> 6), lane = tid & 63, wr = wid >> 2, wc = wid & 3, fr = lane & 15, fq = lane >> 4;
    const int K = g.K, nt = K / BK;
    unsigned voffA[2], voffB[2];
#pragma unroll
    for (int i = 0; i < 2; ++i) { int R, C; stage_rc(tid * 16 + i * 8192, R, C); const int Rb = Epi::PERM ? ((R & ~31) + perm32(R & 31)) : R;
        voffA[i] = (unsigned)(R * g.lda + C) * 2u; voffB[i] = (unsigned)(Rb * g.ldb + C) * 2u; }
    const size_t kstep = (size_t)(BK * 2);
    const size_t hstepA = (size_t)HALF * g.lda * 2, hstepB = (size_t)HALF * g.ldb * 2;
    const size_t tstepA = 2 * hstepA, tstepB = 2 * hstepB;
    const unsigned ldsw = (unsigned)wid * 1024u;
    const int aoff = lds_byte(wr * 64 + fr, fq * 8), boff = lds_byte(wc * 32 + fr, fq * 8);
#define PG8_SA(b, h) (((b) * 2 + (h)) * HTB)
#define PG8_SB(b, h) ((4 + (b) * 2 + (h)) * HTB)
#define PG8_STAGE(bufoff, gbase, voff) do { _Pragma("unroll") for (int _i = 0; _i < 2; ++_i) \
        __builtin_amdgcn_global_load_lds((const unsigned*)((const char*)(gbase) + (voff)[_i]), (PG8_LAS unsigned*)(lds + (bufoff) + ldsw + _i * 8192), 16, 0, 0); } while (0)
#define PG8_LDA(dst, b, h) do { _Pragma("unroll") for (int m = 0; m < 4; ++m) _Pragma("unroll") for (int k = 0; k < 2; ++k) dst[m][k] = *(const PG8_LAS bf16x8*)(lds + PG8_SA(b, h) + aoff + m * 2048 + k * 1024); } while (0)
#define PG8_LDB(dst, b, h) do { _Pragma("unroll") for (int n = 0; n < 2; ++n) _Pragma("unroll") for (int k = 0; k < 2; ++k) dst[n][k] = *(const PG8_LAS bf16x8*)(lds + PG8_SB(b, h) + boff + n * 2048 + k * 1024); } while (0)
#define PG8_MMA(ai, bj, At, Bt) do { __builtin_amdgcn_s_setprio(1); _Pragma("unroll") for (int m = 0; m < 4; ++m) _Pragma("unroll") for (int n = 0; n < 2; ++n) _Pragma("unroll") for (int k = 0; k < 2; ++k) \
        acc[ai][bj][m][n] = __builtin_amdgcn_mfma_f32_16x16x32_bf16(Bt[n][k], At[m][k], acc[ai][bj][m][n], 0, 0, 0); __builtin_amdgcn_s_setprio(0); } while (0)
#define PG8_WAIT_V(n) asm volatile("s_waitcnt vmcnt(" #n ")" ::: "memory")
#define PG8_WAIT_L(n) asm volatile("s_waitcnt lgkmcnt(" #n ")" ::: "memory")
#define PG8_BAR __builtin_amdgcn_s_barrier()
#define PG8_SCHED __builtin_amdgcn_sched_barrier(0)
    Unit cur, nxt; int ui = 0;
    if (!S.next(0, cur)) return;
    f32x4 acc[2][2][4][2];
#pragma unroll
    for (int a = 0; a < 2; ++a)
#pragma unroll
        for (int b = 0; b < 2; ++b)
#pragma unroll
            for (int m = 0; m < 4; ++m)
#pragma unroll
                for (int n = 0; n < 2; ++n) acc[a][b][m][n] = (f32x4){0.f, 0.f, 0.f, 0.f};
    bf16x8 At[4][2], B0[2][2], B1[2][2];
    const char* cA = (const char*)g.A + (size_t)cur.pm * tstepA; const char* cB = (const char*)g.Bt + (size_t)cur.pn * tstepB;
    S.a_ready(cur);
    if constexpr (SP2) {
        PG8_STAGE(PG8_SB(0, 0), cB, voffB); PG8_STAGE(PG8_SB(0, 1), cB + hstepB, voffB); PG8_STAGE(PG8_SA(0, 0), cA, voffA); PG8_STAGE(PG8_SA(0, 1), cA + hstepA, voffA);
        if (wr == 1) PG8_BAR;
        PG8_WAIT_V(2); PG8_BAR;
        PG8_STAGE(PG8_SB(1, 0), cB + kstep, voffB); PG8_STAGE(PG8_SA(1, 0), cA + kstep, voffA); PG8_STAGE(PG8_SB(1, 1), cB + hstepB + kstep, voffB);
        PG8_WAIT_V(6); PG8_BAR;
    } else {
        PG8_STAGE(PG8_SB(0, 0), cB, voffB); PG8_STAGE(PG8_SA(0, 0), cA, voffA); PG8_STAGE(PG8_SB(0, 1), cB + hstepB, voffB); PG8_STAGE(PG8_SA(0, 1), cA + hstepA, voffA);
        if (wr == 1) PG8_BAR;
        PG8_WAIT_V(4); PG8_BAR;
        PG8_STAGE(PG8_SB(1, 0), cB + kstep, voffB); PG8_STAGE(PG8_SA(1, 0), cA + kstep, voffA); PG8_STAGE(PG8_SB(1, 1), cB + hstepB + kstep, voffB);
        PG8_WAIT_V(6); PG8_BAR;
    }
    for (;;) {
        const bool has_next = S.next(ui + 1, nxt);
        const char* nA = has_next ? (const char*)g.A + (size_t)nxt.pm * tstepA : cA; const char* nB = has_next ? (const char*)g.Bt + (size_t)nxt.pn * tstepB : cB;
        for (int t = 0; t < nt; t += 2) {
            const bool last = (t == nt - 2);
            const char* a1 = cA + (size_t)(t + 1) * kstep;
            const char* a2 = last ? nA : cA + (size_t)(t + 2) * kstep; const char* b2 = last ? nB : cB + (size_t)(t + 2) * kstep;
            const char* a3 = a2 + kstep; const char* b3 = b2 + kstep;
            if (last && has_next) S.a_ready(nxt);
            if constexpr (SP2) {
            PG8_LDB(B0, 0, 0); PG8_LDB(B1, 0, 1); PG8_SCHED; PG8_LDA(At, 0, 0); PG8_STAGE(PG8_SA(1, 1), a1 + hstepA, voffA);
            PG8_WAIT_V(8); PG8_WAIT_L(0); PG8_BAR; PG8_MMA(0, 0, At, B0); PG8_MMA(0, 1, At, B1); PG8_BAR; PG8_SCHED;
            PG8_LDA(At, 0, 1); PG8_STAGE(PG8_SB(0, 0), b2, voffB); PG8_STAGE(PG8_SB(0, 1), b2 + hstepB, voffB); PG8_STAGE(PG8_SA(0, 0), a2, voffA);
            PG8_WAIT_V(8); PG8_WAIT_L(0); PG8_BAR; PG8_MMA(1, 0, At, B0); PG8_MMA(1, 1, At, B1); PG8_BAR; PG8_SCHED;
            PG8_LDB(B0, 1, 0); PG8_LDB(B1, 1, 1); PG8_SCHED; PG8_LDA(At, 1, 0); PG8_STAGE(PG8_SA(0, 1), a2 + hstepA, voffA);
            PG8_WAIT_V(8); PG8_WAIT_L(0); PG8_BAR; PG8_MMA(0, 0, At, B0); PG8_MMA(0, 1, At, B1); PG8_BAR; PG8_SCHED;
            PG8_LDA(At, 1, 1); PG8_STAGE(PG8_SB(1, 0), b3, voffB); PG8_STAGE(PG8_SB(1, 1), b3 + hstepB, voffB); PG8_STAGE(PG8_SA(1, 0), a3, voffA);
            PG8_WAIT_V(8); PG8_WAIT_L(0); PG8_BAR; PG8_MMA(1, 0, At, B0); PG8_MMA(1, 1, At, B1); PG8_BAR; PG8_SCHED;
            } else {
            PG8_LDB(B0, 0, 0); PG8_SCHED; PG8_LDA(At, 0, 0); PG8_STAGE(PG8_SA(1, 1), a1 + hstepA, voffA);
            PG8_WAIT_L(8); PG8_BAR; PG8_WAIT_L(0); PG8_MMA(0, 0, At, B0); PG8_BAR; PG8_SCHED;
            PG8_LDB(B1, 0, 1); PG8_STAGE(PG8_SB(0, 0), b2, voffB);
            PG8_BAR; PG8_WAIT_L(0); PG8_MMA(0, 1, At, B1); PG8_BAR;
            PG8_LDA(At, 0, 1); PG8_STAGE(PG8_SA(0, 0), a2, voffA);
            PG8_BAR; PG8_WAIT_L(0); PG8_MMA(1, 0, At, B0); PG8_BAR; PG8_SCHED;
            PG8_STAGE(PG8_SB(0, 1), b2 + hstepB, voffB);
            PG8_WAIT_V(6); PG8_BAR; PG8_MMA(1, 1, At, B1); PG8_BAR;
            PG8_LDB(B0, 1, 0); PG8_SCHED; PG8_LDA(At, 1, 0); PG8_STAGE(PG8_SA(0, 1), a2 + hstepA, voffA);
            PG8_WAIT_L(8); PG8_BAR; PG8_WAIT_L(0); PG8_MMA(0, 0, At, B0); PG8_BAR; PG8_SCHED;
            PG8_LDB(B1, 1, 1); PG8_STAGE(PG8_SB(1, 0), b3, voffB);
            PG8_BAR; PG8_WAIT_L(0); PG8_MMA(0, 1, At, B1); PG8_BAR;
            PG8_LDA(At, 1, 1); PG8_STAGE(PG8_SA(1, 0), a3, voffA);
            PG8_BAR; PG8_WAIT_L(0); PG8_MMA(1, 0, At, B0); PG8_BAR; PG8_SCHED;
            PG8_STAGE(PG8_SB(1, 1), b3 + hstepB, voffB);
            PG8_WAIT_V(6); PG8_BAR; PG8_MMA(1, 1, At, B1); PG8_BAR;
            }
        }
        if constexpr (ALIGN_EPI) { if (wr == 0) PG8_BAR; }
        if constexpr (!Epi::AFTER_DRAIN) { E(acc, cur, wr, wc, fr, fq); S.done(cur); }
        if (!has_next) break;
#pragma unroll
        for (int a = 0; a < 2; ++a)
#pragma unroll
            for (int b = 0; b < 2; ++b)
#pragma unroll
                for (int m = 0; m < 4; ++m)
#pragma unroll
                    for (int n = 0; n < 2; ++n) acc[a][b][m][n] = (f32x4){0.f, 0.f, 0.f, 0.f};
        cur = nxt; cA = nA; cB = nB; ++ui;
        if constexpr (ALIGN_EPI) { if (wr == 1) PG8_BAR; }
    }
    PG8_WAIT_V(0);
    if constexpr (!ALIGN_EPI) { if (wr == 0) PG8_BAR; }
    PG8_BAR;
    if constexpr (Epi::AFTER_DRAIN) { E.fused(acc, cur, wr, wc, fr, fq, lds, wid, lane); S.done(cur); }
#undef PG8_SA
#undef PG8_SB
#undef PG8_STAGE
#undef PG8_LDA
#undef PG8_LDB
#undef PG8_MMA
#undef PG8_WAIT_V
#undef PG8_WAIT_L
#undef PG8_BAR
#undef PG8_SCHED
}
}

namespace mk {
#ifndef GAS
#define GAS __attribute__((address_space(1)))
#endif
#define LAS __attribute__((address_space(3)))
typedef unsigned short bf16;
typedef unsigned v4u __attribute__((ext_vector_type(4)));
typedef unsigned v2u __attribute__((ext_vector_type(2)));
typedef float f32x4 __attribute__((ext_vector_type(4)));
typedef GAS unsigned gu32;
#define LDS_WAIT() asm volatile("s_waitcnt lgkmcnt(0)" ::: "memory")
#define VM_WAIT() asm volatile("s_waitcnt vmcnt(0)" ::: "memory")
__device__ __forceinline__ unsigned f2bf_(float f) { unsigned u = __builtin_bit_cast(unsigned, f); return (u + 0x7fffu + ((u >> 16) & 1u)) >> 16; }
__device__ __forceinline__ unsigned pk2(float lo, float hi) { return f2bf_(lo) | (f2bf_(hi) << 16); }
__device__ __forceinline__ float bflo(unsigned w) { return __builtin_bit_cast(float, w << 16); }
__device__ __forceinline__ float bfhi(unsigned w) { return __builtin_bit_cast(float, w & 0xffff0000u); }

template <class P> __device__ __forceinline__ P* opq(P* p) { asm volatile("" : "+s"(p)); return p; }
__device__ __forceinline__ int opqi(int k) { asm volatile("" : "+s"(k)); return k; }
__device__ __forceinline__ float shx(float v, int o, int lane) { return __builtin_bit_cast(float, __builtin_amdgcn_ds_bpermute((lane ^ o) << 2, __builtin_bit_cast(int, v))); }
__device__ __forceinline__ int shxi(int v, int o, int lane) { return __builtin_amdgcn_ds_bpermute((lane ^ o) << 2, v); }
__device__ __forceinline__ int lane_id_v() { int l; asm volatile("v_mbcnt_lo_u32_b32 %0, -1, 0\n\tv_mbcnt_hi_u32_b32 %0, -1, %0" : "=v"(l)); return l; }
constexpr int NWAVES = 8;
constexpr int D = 1024, NB = 4, S = 8192, T = NB * S, L = 4, MEM = 256, INW = 2144, INP = 2304;
constexpr int PC_CQ = 0, PC_CKV = 256, PC_KR = 384, PC_XL = 512, PC_GL = 1024, PC_QD = 1536, PC_KD = 1792, PC_VD = 2048;
constexpr float LOG2E = 1.4426950408889634f;
constexpr size_t MiB = 1u << 20;
constexpr size_t WS_CTL = 0, CTL_ZERO_BYTES = 1 * MiB;
constexpr size_t WS_WIN = 1 * MiB, WS_WOUT = 19 * MiB, WS_WCQ = 27 * MiB, WS_WCO = 35 * MiB, WS_WPQ = 43 * MiB, WS_WCKV = 51 * MiB, WS_WUQ = 67 * MiB, WS_WUKV = 68 * MiB, WS_KEYS = 69 * MiB, WS_ROPE = 70 * MiB;
constexpr size_t WS_XNB = 76 * MiB, WS_YB = 140 * MiB, WS_PROJB = 204 * MiB, WS_QMB = 348 * MiB, WS_KMB = 372 * MiB, WS_VMB = 396 * MiB, WS_RS = 412 * MiB;
constexpr size_t WS_HLB = 413 * MiB, WS_ACB = 445 * MiB, WS_LSUM = 477 * MiB, WS_OMB = 478 * MiB, WS_MNB = 494 * MiB, WS_KVCB = 502 * MiB, WS_EX = 518 * MiB, WS_GW = 534 * MiB;
constexpr size_t WS_U8 = 550 * MiB, WS_V8 = 614 * MiB, WS_SU = 678 * MiB, WS_SV = 679 * MiB;
constexpr size_t WS_HQ = 680 * MiB, WS_P = 712 * MiB, WS_SH = 728 * MiB, WS_W = 729 * MiB, WS_WS = 745 * MiB, WS_SSQ = 746 * MiB, WS_END = 748 * MiB;
constexpr size_t WS_WAT = 74 * MiB;
constexpr size_t WS_BTAB = WS_KEYS + 512 * 1024, WS_LAMS = WS_BTAB + 4096, WS_SP = WS_LAMS + 4096;
constexpr int CW_BAR = 4096, CW_RANK = 8192;
constexpr int RING_OFF = 0, RING_BYTES = 155648, LDSCTL_OFF = RING_BYTES, MISC_OFF = LDSCTL_OFF + 320, LDS_BYTES = 163840;

#define XB_TMO      128
#define XB_XCNT(j)  (256  + 64 * (j))
#define XB_XSUB(j)  (1280 + 64 * (j))
#define XB_XGEN(j)  (2304 + 64 * (j))
#define XB_TOP      3328
#define XB_TOPGEN   3392
#define XCD_BAR_WORDS 3456
#define XB_SPIN_CAP (1u << 18)

__device__ __forceinline__ unsigned xb_ld(unsigned* p)              { return __hip_atomic_load(p, __ATOMIC_RELAXED, __HIP_MEMORY_SCOPE_AGENT); }
__device__ __forceinline__ unsigned xb_add(unsigned* p, unsigned v) { return __hip_atomic_fetch_add(p, v, __ATOMIC_RELAXED, __HIP_MEMORY_SCOPE_AGENT); }
__device__ __forceinline__ unsigned xb_xcc_id() { return (unsigned)__builtin_amdgcn_s_getreg((3 << 11) | 20) & 0xFu; }
#define XB_SPIN(cond, bar) do { unsigned _sp = 0; while (cond) { __builtin_amdgcn_s_sleep(1); \
    if ((++_sp & 255u) == 0u) { if (xb_ld(&(bar)[XB_TMO])) break; if (_sp > XB_SPIN_CAP) { atomicAdd(&(bar)[XB_TMO], 1u); break; } } } } while (0)

struct XcdBarrier {
    unsigned* bar; unsigned x;
    volatile LAS unsigned* st;
};

__device__ __forceinline__ XcdBarrier xcd_barrier_post(unsigned* bar, volatile LAS unsigned* st) {
    XcdBarrier b; b.bar = bar; b.x = xb_xcc_id(); b.st = st;
    if (threadIdx.x == 0) (void)xb_add(&bar[XB_XCNT(b.x)], 1u);
    return b;
}
__device__ __forceinline__ void xcd_barrier_complete(unsigned* bar, unsigned x, unsigned& nloc, unsigned& nx) {
    const unsigned G = gridDim.x * gridDim.y * gridDim.z;
    unsigned sum, cnt, mine, sp = 0u;
    for (;;) {
        sum = 0u; cnt = 0u; mine = 0u;
#pragma unroll
        for (unsigned j = 0; j < 16; ++j) { const unsigned c = xb_ld(&bar[XB_XCNT(j)]); sum += c; cnt += (c > 0u) ? 1u : 0u; mine = (j == x) ? c : mine; }
        if (sum == G) break;
        __builtin_amdgcn_s_sleep(1);
        if ((++sp & 255u) == 0u) { if (xb_ld(&bar[XB_TMO])) break; if (sp > XB_SPIN_CAP) { atomicAdd(&bar[XB_TMO], 1u); break; } }
    }
    nloc = mine > 0u ? mine : 1u; nx = cnt > 0u ? cnt : 1u;
}

__device__ __noinline__ void xcd_barrier_impl(unsigned* bar_, unsigned x_, volatile LAS unsigned* st_, int leader_) {
    XcdBarrier b; b.bar = bar_; b.x = x_; b.st = st_;
    asm volatile("s_waitcnt vmcnt(0)" ::: "memory");
    __syncthreads();
    if (leader_) {
        unsigned* bar = b.bar;
        __builtin_amdgcn_s_waitcnt(0);
        unsigned nloc = b.st[0], nx = b.st[1];
        if (nloc == 0u) { xcd_barrier_complete(bar, b.x, nloc, nx); b.st[0] = nloc; b.st[1] = nx; }
        const unsigned old = xb_add(&bar[XB_XSUB(b.x)], 1u);
        const unsigned gen = old / nloc;
        if (old + 1u == (gen + 1u) * nloc) {
            __builtin_amdgcn_fence(__ATOMIC_RELEASE, "agent");
            asm volatile("s_waitcnt vmcnt(0)" ::: "memory");
            const unsigned og = xb_add(&bar[XB_TOP], 1u);
            const unsigned tg = og / nx;
            if (og + 1u == (tg + 1u) * nx) xb_add(&bar[XB_TOPGEN], 1u);
            else XB_SPIN(xb_ld(&bar[XB_TOPGEN]) == tg, bar);
            __builtin_amdgcn_fence(__ATOMIC_ACQUIRE, "agent");
            xb_add(&bar[XB_XGEN(b.x)], 1u);
            asm volatile("s_waitcnt vmcnt(0)" ::: "memory");
        } else {
            XB_SPIN(xb_ld(&bar[XB_XGEN(b.x)]) == gen, bar);
            __builtin_amdgcn_fence(__ATOMIC_ACQUIRE, "agent");
            asm volatile("s_waitcnt vmcnt(0)" ::: "memory");
        }
    }
    __syncthreads();
}
__device__ __forceinline__ void xcd_barrier(const XcdBarrier& b, int leader) { xcd_barrier_impl(b.bar, b.x, b.st, leader); }


__device__ __forceinline__ float wave_sum(float v, int lane) {
    (void)lane;
    v += __builtin_bit_cast(float, __builtin_amdgcn_update_dpp(0, __builtin_bit_cast(int, v), 0xB1, 0xF, 0xF, true));
    v += __builtin_bit_cast(float, __builtin_amdgcn_update_dpp(0, __builtin_bit_cast(int, v), 0x4E, 0xF, 0xF, true));
    v += __builtin_bit_cast(float, __builtin_amdgcn_update_dpp(0, __builtin_bit_cast(int, v), 0x141, 0xF, 0xF, true));
    v += __builtin_bit_cast(float, __builtin_amdgcn_update_dpp(0, __builtin_bit_cast(int, v), 0x140, 0xF, 0xF, true));
    { float a = v, b = v; asm volatile("v_nop\n\tv_nop\n\tv_permlane16_swap_b32 %0, %1" : "+v"(a), "+v"(b)); v = a + b; }
    { float a = v, b = v; asm volatile("v_nop\n\tv_nop\n\tv_permlane32_swap_b32 %0, %1" : "+v"(a), "+v"(b)); v = a + b; }
    return v;
}
__device__ __forceinline__ float wave_max(float v) {
    v = fmaxf(v, __builtin_bit_cast(float, __builtin_amdgcn_update_dpp(0, __builtin_bit_cast(int, v), 0xB1, 0xF, 0xF, true)));
    v = fmaxf(v, __builtin_bit_cast(float, __builtin_amdgcn_update_dpp(0, __builtin_bit_cast(int, v), 0x4E, 0xF, 0xF, true)));
    v = fmaxf(v, __builtin_bit_cast(float, __builtin_amdgcn_update_dpp(0, __builtin_bit_cast(int, v), 0x141, 0xF, 0xF, true)));
    v = fmaxf(v, __builtin_bit_cast(float, __builtin_amdgcn_update_dpp(0, __builtin_bit_cast(int, v), 0x140, 0xF, 0xF, true)));
    { float a = v, b = v; asm volatile("v_nop\n\tv_nop\n\tv_permlane16_swap_b32 %0, %1" : "+v"(a), "+v"(b)); v = fmaxf(a, b); }
    { float a = v, b = v; asm volatile("v_nop\n\tv_nop\n\tv_permlane32_swap_b32 %0, %1" : "+v"(a), "+v"(b)); v = fmaxf(a, b); }
    return v;
}
__device__ __forceinline__ float gelu_erf(float v) {
    const float av = __builtin_fabsf(v), t = __builtin_amdgcn_rcpf(av * 0.2316418882f + 1.0f);
    float q = t * 0.5307027145f + (-0.7265760135f); q = q * t + 0.7107068705f; q = q * t + (-0.142248368f); q = q * t + 0.127414796f; q = q * t;
    const float e = __builtin_amdgcn_exp2f((v * v) * (-0.72134752044f));
    const float m = v * (q * e);
    return v < 0.f ? m : v - m;
}

__device__ __forceinline__ void norm_phase(const GAS float* X, const GAS float* g, GAS bf16* out, int rows, int gw, int NGW, int lane) {
    asm volatile("" : "+v"(lane));
    f32x4 gv[4];
#pragma unroll
    for (int j = 0; j < 4; ++j) gv[j] = ((const GAS f32x4*)g)[lane + 64 * j];
    for (int m = gw; m < rows; m += NGW) {
        const GAS f32x4* xr = (const GAS f32x4*)(X + (size_t)m * D) + lane;
        f32x4 v[4]; float s = 0.f;
#pragma unroll
        for (int j = 0; j < 4; ++j) { v[j] = xr[64 * j]; s += (v[j].x * v[j].x + v[j].y * v[j].y) + (v[j].z * v[j].z + v[j].w * v[j].w); }
        const float rs = rsqrtf(wave_sum(s, lane) * (1.f / D) + 1e-6f);
        GAS v2u* o8 = (GAS v2u*)(out + (size_t)m * D) + lane;
#pragma unroll
        for (int j = 0; j < 4; ++j) { v2u w; w.x = pk2(v[j].x * rs * gv[j].x, v[j].y * rs * gv[j].y); w.y = pk2(v[j].z * rs * gv[j].z, v[j].w * rs * gv[j].w); o8[64 * j] = w; }
    }
}
__device__ __forceinline__ void hq_phase(const GAS bf16* XB, const GAS float* SSQ, const GAS float* g, GAS unsigned char* HQ, GAS float* SH, GAS int* Pz, int gw, int NGW, int lane) {
    asm volatile("" : "+v"(lane));
    const GAS f32x4* gp = (const GAS f32x4*)g + 4 * lane; const f32x4 g0 = gp[0], g1 = gp[1], g2 = gp[2], g3 = gp[3];
    for (int m = gw; m < T; m += NGW) {
        const GAS f32x4* sp = (const GAS f32x4*)(SSQ + (size_t)m * 16); const f32x4 t = (sp[0] + sp[1]) + (sp[2] + sp[3]);
        const float rs = __builtin_amdgcn_rsqf(((t[0] + t[1]) + (t[2] + t[3])) * (1.f / 1024.f) + 1e-6f);
        const v4u a = *(const GAS v4u*)(XB + (size_t)m * D + 16 * lane), b = *(const GAS v4u*)(XB + (size_t)m * D + 16 * lane + 8);
        float f[16] = {bflo(a.x) * g0[0], bfhi(a.x) * g0[1], bflo(a.y) * g0[2], bfhi(a.y) * g0[3], bflo(a.z) * g1[0], bfhi(a.z) * g1[1], bflo(a.w) * g1[2], bfhi(a.w) * g1[3],
                       bflo(b.x) * g2[0], bfhi(b.x) * g2[1], bflo(b.y) * g2[2], bfhi(b.y) * g2[3], bflo(b.z) * g3[0], bfhi(b.z) * g3[1], bflo(b.w) * g3[2], bfhi(b.w) * g3[3]};
        float mx = 0.f;
#pragma unroll
        for (int i = 0; i < 16; ++i) { f[i] *= rs; mx = fmaxf(mx, __builtin_fabsf(f[i])); }
        mx = wave_max(mx);
        const float inv = mx > 0.f ? 127.f / mx : 0.f;
        v4u q;
#pragma unroll
        for (int i = 0; i < 4; ++i) { const int ia = (int)__builtin_rintf(f[4 * i] * inv), ib = (int)__builtin_rintf(f[4 * i + 1] * inv), ic = (int)__builtin_rintf(f[4 * i + 2] * inv), id = (int)__builtin_rintf(f[4 * i + 3] * inv);
            q[i] = (unsigned)(ia & 255) | ((unsigned)(ib & 255) << 8) | ((unsigned)(ic & 255) << 16) | ((unsigned)(id & 255) << 24); }
        *(GAS v4u*)(HQ + (size_t)m * D + 16 * lane) = q;
        if (lane == 0) SH[m] = mx * (1.f / 127.f);
    }
}
__device__ __forceinline__ void x0_phase(const GAS float* X, GAS bf16* XB, GAS float* SSQ, int gw, int NGW, int lane) {
    asm volatile("" : "+v"(lane));
    for (int m = gw; m < T; m += NGW) {
        const GAS f32x4* xr = (const GAS f32x4*)(X + (size_t)m * D) + lane; GAS v2u* o8 = (GAS v2u*)(XB + (size_t)m * D) + lane;
        float s = 0.f;
#pragma unroll
        for (int j = 0; j < 4; ++j) { const f32x4 v = xr[64 * j]; s += (v.x * v.x + v.y * v.y) + (v.z * v.z + v.w * v.w); v2u w; w.x = pk2(v.x, v.y); w.y = pk2(v.z, v.w); o8[64 * j] = w; }
        s = wave_sum(s, lane);
        if (lane < 8) SSQ[(size_t)m * 16 + lane] = lane == 0 ? s : 0.f;
    }
}
__device__ __forceinline__ void final_norm_phase(const GAS bf16* XB, GAS float* O, const GAS float* g, int rows, int gw, int NGW, int lane) {
    asm volatile("" : "+v"(lane));
    for (int m = gw; m < rows; m += NGW) {
        const GAS v4u* xr = (const GAS v4u*)(XB + (size_t)m * D) + lane;
        v4u v[2]; float s = 0.f;
#pragma unroll
        for (int j = 0; j < 2; ++j) { v[j] = xr[64 * j];
#pragma unroll
            for (int e = 0; e < 4; ++e) { const float a = bflo(v[j][e]), b = bfhi(v[j][e]); s += a * a + b * b; } }
        const float rs = rsqrtf(wave_sum(s, lane) * (1.f / D) + 1e-6f);
#pragma unroll
        for (int j = 0; j < 2; ++j) { const int c = 8 * (lane + 64 * j); const f32x4 g0 = *(const GAS f32x4*)(g + c), g1 = *(const GAS f32x4*)(g + c + 4);
            f32x4 o0, o1; o0.x = bflo(v[j].x) * rs * g0.x; o0.y = bfhi(v[j].x) * rs * g0.y; o0.z = bflo(v[j].y) * rs * g0.z; o0.w = bfhi(v[j].y) * rs * g0.w;
            o1.x = bflo(v[j].z) * rs * g1.x; o1.y = bfhi(v[j].z) * rs * g1.y; o1.z = bflo(v[j].w) * rs * g1.z; o1.w = bfhi(v[j].w) * rs * g1.w;
            *(GAS f32x4*)(O + (size_t)m * D + c) = o0; *(GAS f32x4*)(O + (size_t)m * D + c + 4) = o1; }
    }
}

__device__ __forceinline__ float row16_sum(float v) {
    v += __builtin_bit_cast(float, __builtin_amdgcn_update_dpp(0, __builtin_bit_cast(int, v), 0xB1, 0xF, 0xF, true));
    v += __builtin_bit_cast(float, __builtin_amdgcn_update_dpp(0, __builtin_bit_cast(int, v), 0x4E, 0xF, 0xF, true));
    v += __builtin_bit_cast(float, __builtin_amdgcn_update_dpp(0, __builtin_bit_cast(int, v), 0x141, 0xF, 0xF, true));
    v += __builtin_bit_cast(float, __builtin_amdgcn_update_dpp(0, __builtin_bit_cast(int, v), 0x140, 0xF, 0xF, true));
    return v;
}
__device__ __forceinline__ float sq8(const v4u w) { const float a0 = bflo(w.x), a1 = bfhi(w.x), a2 = bflo(w.y), a3 = bfhi(w.y), a4 = bflo(w.z), a5 = bfhi(w.z), a6 = bflo(w.w), a7 = bfhi(w.w);
    return (a0 * a0 + a1 * a1) + (a2 * a2 + a3 * a3) + (a4 * a4 + a5 * a5) + (a6 * a6 + a7 * a7); }
__device__ __forceinline__ void pre_phase(const GAS bf16* PROJB, const GAS float* ROPE, GAS float* RS, GAS bf16* KMB, int gw, int NGW, int lane) {
    asm volatile("" : "+v"(lane));
    const int q = lane >> 4, sub = lane & 15;
    for (int t0 = gw * 4; t0 < T; t0 += NGW * 4) {
        const size_t t = (size_t)t0 + q;
        const GAS bf16* pr = PROJB + t * INP;
        const v4u w0 = *(const GAS v4u*)(pr + PC_CQ + 8 * sub), w1 = *(const GAS v4u*)(pr + PC_CQ + 8 * (16 + (sub & 7))), w2 = *(const GAS v4u*)(pr + PC_CKV + 8 * sub);
        const float x1 = __builtin_bit_cast(float, (unsigned)pr[PC_KR + sub] << 16), x2 = __builtin_bit_cast(float, (unsigned)pr[PC_KR + 16 + sub] << 16);
        const float c = ROPE[t * 32 + sub], sn = ROPE[t * 32 + 16 + sub];
        const float sq = row16_sum(sq8(w0) + (sub < 8 ? sq8(w1) : 0.f)), skv = row16_sum(sq8(w2));
        if (sub == 0) { RS[2 * t] = rsqrtf(sq * (1.f / 192.f) + 1e-6f); RS[2 * t + 1] = rsqrtf(skv * (1.f / 128.f) + 1e-6f); }
        const bf16 y1 = (bf16)f2bf_(x1 * c - x2 * sn), y2 = (bf16)f2bf_(x1 * sn + x2 * c);
        GAS bf16* kr = KMB + t * 384 + 64 + sub;
#pragma unroll
        for (int h = 0; h < 4; ++h) { kr[h * 96] = y1; kr[h * 96 + 16] = y2; }
    }
}

typedef short lr_bf16x8 __attribute__((ext_vector_type(8)));
typedef float lr_f32x16 __attribute__((ext_vector_type(16)));
__device__ __forceinline__ void lr_swap32(float& a, float& b) { asm volatile("v_nop\n\tv_nop\n\tv_permlane32_swap_b32 %0, %1" : "+v"(a), "+v"(b)); }
constexpr int LR_XR = 0, LR_CW = LR_XR + 37376, LR_XA = LR_CW + 1280, LR_WT = LR_XA + 256 * 144, LR_SUM = LR_WT + 2 * 64 * 144, LR_END = LR_SUM + 4096;
struct LruP { const GAS bf16* PROJB; const GAS float* cw; const GAS float* cb; const GAS bf16* wat; const GAS float* ba; const GAS float* bx; const GAS float* sp; GAS unsigned* HA; GAS float* LSUM; };
__device__ __forceinline__ void lru_phase(const LruP& P, LAS unsigned char* lds, int tid, int wave, int lane, int vcu, int G) {
    asm volatile("" : "+v"(tid), "+v"(lane));
    LAS float* SUM = (LAS float*)(lds + LR_SUM);
    for (int u = vcu; u < (T / 256) * 8; u += G) {
        const int tile = u >> 3, g = u & 7; const int t0 = tile * 256; const bool first = ((tile & 31) == 0);
        __syncthreads();
        float ba_[2], bx_[2], sp_[2];
#pragma unroll
        for (int nt = 0; nt < 2; ++nt) { const int ch = 64 * g + 32 * nt + (lane & 31); ba_[nt] = P.ba[ch]; bx_[nt] = P.bx[ch]; sp_[nt] = P.sp[ch]; }
        { v4u wt_[2], xr_[5];
#pragma unroll
          for (int i = 0; i < 2; ++i) { const int idx = tid + 512 * i; wt_[i] = ((const GAS v4u*)(P.wat + (size_t)g * 2 * 4096))[idx]; }
#pragma unroll
          for (int i = 0; i < 5; ++i) { const int idx = tid + 512 * i, row = idx >> 3, part = idx & 7; const bool ok = (idx < 259 * 8) && !(first && row < 3);
              const int trow = ok ? t0 - 3 + row : t0;
              xr_[i] = *(const GAS v4u*)(P.PROJB + (size_t)trow * INP + PC_XL + 64 * g + 8 * part); if (!ok) xr_[i] = v4u{0u, 0u, 0u, 0u}; }
          float cwv = 0.f; if (tid < 320) cwv = (tid < 256) ? P.cw[(tid >> 6) * 512 + 64 * g + (tid & 63)] : P.cb[64 * g + (tid - 256)];
#pragma unroll
          for (int i = 0; i < 2; ++i) { const int idx = tid + 512 * i; *(LAS v4u*)(lds + LR_WT + (idx >> 9) * 9216 + ((idx >> 3) & 63) * 144 + (idx & 7) * 16) = wt_[i]; }
#pragma unroll
          for (int i = 0; i < 5; ++i) { const int idx = tid + 512 * i, row = idx >> 3, part = idx & 7; if (idx < 259 * 8) *(LAS v4u*)(lds + LR_XR + row * 144 + 16 * part) = xr_[i]; }
          if (tid < 320) ((LAS float*)(lds + LR_CW))[tid] = cwv; }
        __syncthreads();
        { float cwr[4][8], cbr[8];
#pragma unroll
          for (int k = 0; k < 4; ++k) { const f32x4 c0 = *(const LAS f32x4*)(lds + LR_CW + (k * 64 + 8 * wave) * 4), c1 = *(const LAS f32x4*)(lds + LR_CW + (k * 64 + 8 * wave + 4) * 4);
              cwr[k][0] = c0.x; cwr[k][1] = c0.y; cwr[k][2] = c0.z; cwr[k][3] = c0.w; cwr[k][4] = c1.x; cwr[k][5] = c1.y; cwr[k][6] = c1.z; cwr[k][7] = c1.w; }
          { const f32x4 c0 = *(const LAS f32x4*)(lds + LR_CW + (256 + 8 * wave) * 4), c1 = *(const LAS f32x4*)(lds + LR_CW + (256 + 8 * wave + 4) * 4);
            cbr[0] = c0.x; cbr[1] = c0.y; cbr[2] = c0.z; cbr[3] = c0.w; cbr[4] = c1.x; cbr[5] = c1.y; cbr[6] = c1.z; cbr[7] = c1.w; }
#pragma unroll
          for (int it_ = 0; it_ < 4; ++it_) { const int time = lane + 64 * it_;
              float y[8];
#pragma unroll
              for (int e = 0; e < 8; ++e) y[e] = cbr[e];
#pragma unroll
              for (int k = 0; k < 4; ++k) { const v4u w = *(const LAS v4u*)(lds + LR_XR + (time + k) * 144 + 16 * wave);
                  y[0] += bflo(w.x) * cwr[k][0]; y[1] += bfhi(w.x) * cwr[k][1]; y[2] += bflo(w.y) * cwr[k][2]; y[3] += bfhi(w.y) * cwr[k][3];
                  y[4] += bflo(w.z) * cwr[k][4]; y[5] += bfhi(w.z) * cwr[k][5]; y[6] += bflo(w.w) * cwr[k][6]; y[7] += bfhi(w.w) * cwr[k][7]; }
              v4u o; o.x = pk2(y[0], y[1]); o.y = pk2(y[2], y[3]); o.z = pk2(y[4], y[5]); o.w = pk2(y[6], y[7]);
              *(LAS v4u*)(lds + LR_XA + time * 144 + 16 * wave) = o; } }
        __syncthreads();
        const int r32 = lane & 31, hi = lane >> 5;
        lr_f32x16 acc[2][2];
#pragma unroll
        for (int nt = 0; nt < 2; ++nt) { const float b_a = ba_[nt], b_x = bx_[nt];
#pragma unroll
            for (int r = 0; r < 16; ++r) { acc[0][nt][r] = b_a; acc[1][nt][r] = b_x; } }
        { lr_bf16x8 af[4];
#pragma unroll
          for (int s_ = 0; s_ < 4; ++s_) af[s_] = *(const LAS lr_bf16x8*)(lds + LR_XA + (32 * wave + r32) * 144 + (16 * s_ + 8 * hi) * 2);
#pragma unroll
          for (int gt = 0; gt < 2; ++gt)
#pragma unroll
              for (int nt = 0; nt < 2; ++nt)
#pragma unroll
                  for (int s_ = 0; s_ < 4; ++s_) { const lr_bf16x8 bfr = *(const LAS lr_bf16x8*)(lds + LR_WT + gt * 9216 + (32 * nt + r32) * 144 + (16 * s_ + 8 * hi) * 2);
                      acc[gt][nt] = __builtin_amdgcn_mfma_f32_32x32x16_bf16(af[s_], bfr, acc[gt][nt], 0, 0, 0); } }
#pragma unroll
        for (int nt = 0; nt < 2; ++nt) { const float sp = sp_[nt];
            float sa_[4], sh_[4];
#pragma unroll
            for (int q = 0; q < 4; ++q) { float hrun = 0.f, arun = 1.f;
#pragma unroll
                for (int e = 0; e < 4; ++e) { const int r = 4 * q + e, tl = 8 * q + 4 * hi + e;
                    const float xv = __builtin_bit_cast(float, (unsigned)*(const LAS unsigned short*)(lds + LR_XA + (32 * wave + tl) * 144 + (32 * nt + r32) * 2) << 16);
                    const float rg = __builtin_amdgcn_rcpf(1.f + __builtin_amdgcn_exp2f(-LOG2E * acc[0][nt][r])), ig = __builtin_amdgcn_rcpf(1.f + __builtin_amdgcn_exp2f(-LOG2E * acc[1][nt][r]));
                    const float la = -8.0f * rg * sp; const float a_ = __builtin_amdgcn_exp2f(LOG2E * la);
                    const float uu = __builtin_amdgcn_sqrtf(fmaxf(1.f - a_ * a_, 0.f)) * (ig * xv);
                    hrun = a_ * hrun + uu; arun *= a_; acc[0][nt][r] = arun; acc[1][nt][r] = hrun; }
                sa_[q] = arun; sh_[q] = hrun; }
            float runA = 1.f, runH = 0.f;
#pragma unroll
            for (int q = 0; q < 4; ++q) { float a0 = sa_[q], a1 = sa_[q], h0 = sh_[q], h1 = sh_[q]; lr_swap32(a0, a1); lr_swap32(h0, h1);
                const float midA = runA * a0, midH = a0 * runH + h0;
                const float inA = hi ? midA : runA, inH = hi ? midH : runH;
                runA = midA * a1; runH = a1 * midH + h1;
#pragma unroll
                for (int e = 0; e < 4; ++e) { const int r = 4 * q + e; acc[1][nt][r] += acc[0][nt][r] * inH; acc[0][nt][r] *= inA; } }
            if (hi == 0) { SUM[(wave * 64 + 32 * nt + r32) * 2] = runA; SUM[(wave * 64 + 32 * nt + r32) * 2 + 1] = runH; } }
        __syncthreads();
#pragma unroll
        for (int nt = 0; nt < 2; ++nt) { const int cl = 32 * nt + r32;
            float ca = 1.f, chh = 0.f;
            for (int w = 0; w < wave; ++w) { const float aw = SUM[(w * 64 + cl) * 2], hw = SUM[(w * 64 + cl) * 2 + 1]; chh = aw * chh + hw; ca *= aw; }
            GAS unsigned* ha = P.HA + (size_t)(t0 + 32 * wave + 4 * hi) * 512 + 64 * g + cl;
#pragma unroll
            for (int r = 0; r < 16; ++r) { const float hh = acc[1][nt][r] + acc[0][nt][r] * chh, ac_ = acc[0][nt][r] * ca; ha[(size_t)((r & 3) + 8 * (r >> 2)) * 512] = pk2(hh, ac_);
                if (r == 15 && wave == 7 && hi == 1) { P.LSUM[((size_t)tile * 512 + 64 * g + cl) * 2] = ac_; P.LSUM[((size_t)tile * 512 + 64 * g + cl) * 2 + 1] = hh; } } }
    }
}

struct PostP { const GAS bf16* OMB; const GAS unsigned* HA; const GAS float* LSUM; const GAS bf16* PROJB; const GAS float* gm; const GAS float* gl; GAS bf16* Y; };
__device__ __forceinline__ void post_phase(const PostP& P, LAS unsigned char* lds, int tid, int wave, int lane, int vcu, int G) {
    asm volatile("" : "+v"(tid), "+v"(lane));
    LAS float* hin = (LAS float*)lds;
    for (int u = vcu; u < T / 64; u += G) {
        const int t0 = u * 64, tile = t0 >> 8, tb = tile & ~31;
        __syncthreads();
        { float h = 0.f;
          for (int c0 = tb; c0 < tile; c0 += 8) {
              float av_[8], hv_[8];
#pragma unroll
              for (int i = 0; i < 8; ++i) { const int c = (c0 + i < tile) ? (c0 + i) : tb; av_[i] = P.LSUM[((size_t)c * 512 + tid) * 2]; hv_[i] = P.LSUM[((size_t)c * 512 + tid) * 2 + 1]; }
#pragma unroll
              for (int i = 0; i < 8; ++i) { if (c0 + i < tile) h = av_[i] * h + hv_[i]; } }
          hin[tid] = h; }
        __syncthreads();
        f32x4 hi0 = *(const LAS f32x4*)(hin + 8 * lane), hi1 = *(const LAS f32x4*)(hin + 8 * lane + 4);
        const f32x4 g0 = *(const GAS f32x4*)(P.gl + 8 * lane), g1 = *(const GAS f32x4*)(P.gl + 8 * lane + 4), gmv = *(const GAS f32x4*)(P.gm + 4 * lane);
#pragma unroll 2
        for (int i = 0; i < 8; ++i) {
            const size_t t = (size_t)t0 + 8 * wave + i;
            const v4u p0 = *(const GAS v4u*)(P.HA + t * 512 + 8 * lane), p1 = *(const GAS v4u*)(P.HA + t * 512 + 8 * lane + 4), gw_ = *(const GAS v4u*)(P.PROJB + t * INP + PC_GL + 8 * lane);
            const v2u mw = *(const GAS v2u*)(P.OMB + t * 256 + 4 * lane);
            float o[8];
            o[0] = (bflo(p0.x) + bfhi(p0.x) * hi0.x) * gelu_erf(bflo(gw_.x)); o[1] = (bflo(p0.y) + bfhi(p0.y) * hi0.y) * gelu_erf(bfhi(gw_.x));
            o[2] = (bflo(p0.z) + bfhi(p0.z) * hi0.z) * gelu_erf(bflo(gw_.y)); o[3] = (bflo(p0.w) + bfhi(p0.w) * hi0.w) * gelu_erf(bfhi(gw_.y));
            o[4] = (bflo(p1.x) + bfhi(p1.x) * hi1.x) * gelu_erf(bflo(gw_.z)); o[5] = (bflo(p1.y) + bfhi(p1.y) * hi1.y) * gelu_erf(bfhi(gw_.z));
            o[6] = (bflo(p1.z) + bfhi(p1.z) * hi1.z) * gelu_erf(bflo(gw_.w)); o[7] = (bflo(p1.w) + bfhi(p1.w) * hi1.w) * gelu_erf(bfhi(gw_.w));
            float s2 = 0.f;
#pragma unroll
            for (int e = 0; e < 8; ++e) s2 += o[e] * o[e];
            const float m0 = bflo(mw.x), m1 = bfhi(mw.x), m2 = bflo(mw.y), m3 = bfhi(mw.y);
            float s1 = (m0 * m0 + m1 * m1) + (m2 * m2 + m3 * m3);
            s1 = wave_sum(s1, lane); s2 = wave_sum(s2, lane);
            const float r1 = rsqrtf(s1 * (1.f / 256.f) + 1e-6f), r2 = rsqrtf(s2 * (1.f / 512.f) + 1e-6f);
            GAS bf16* yr = P.Y + t * 1024;
            { v2u w; w.x = pk2(m0 * r1 * gmv.x, m1 * r1 * gmv.y); w.y = pk2(m2 * r1 * gmv.z, m3 * r1 * gmv.w); *(GAS v2u*)(yr + 4 * lane) = w; }
            { v4u w; w.x = pk2(o[0] * r2 * g0.x, o[1] * r2 * g0.y); w.y = pk2(o[2] * r2 * g0.z, o[3] * r2 * g0.w); w.z = pk2(o[4] * r2 * g1.x, o[5] * r2 * g1.y); w.w = pk2(o[6] * r2 * g1.z, o[7] * r2 * g1.w);
              *(GAS v4u*)(yr + 256 + 8 * lane) = w; }
        }
    }
}

#define TILE_BAR() asm volatile("s_waitcnt lgkmcnt(0)\n\ts_barrier" ::: "memory")
typedef short bf16x8 __attribute__((ext_vector_type(8)));
typedef short s16x4 __attribute__((ext_vector_type(4)));
typedef float f32x16 __attribute__((ext_vector_type(16)));
typedef unsigned u32x4 __attribute__((ext_vector_type(4)));
__device__ __forceinline__ int crow(int r, int hi) { return (r & 3) + 8 * (r >> 2) + 4 * hi; }
typedef float f32x2_t __attribute__((ext_vector_type(2))); typedef __bf16 bf16x2_c __attribute__((ext_vector_type(2)));
__device__ __forceinline__ unsigned cvtpk(float lo, float hi) { f32x2_t v = {lo, hi}; bf16x2_c b = __builtin_convertvector(v, bf16x2_c); return __builtin_bit_cast(unsigned, b); }
__device__ __forceinline__ float swapmax(float m) { auto rr = __builtin_amdgcn_permlane32_swap(__float_as_uint(m), __float_as_uint(m), false, false); return fmaxf(__uint_as_float(rr[0]), __uint_as_float(rr[1])); }
__device__ __forceinline__ float swapadd(float m) { auto rr = __builtin_amdgcn_permlane32_swap(__float_as_uint(m), __float_as_uint(m), false, false); return __uint_as_float(rr[0]) + __uint_as_float(rr[1]); }
__device__ __forceinline__ s16x4 vtr(const LAS unsigned char* p) { return __builtin_bit_cast(s16x4, __builtin_amdgcn_ds_read_tr16_b64_v4i16((LAS s16x4*)p)); }
__device__ __forceinline__ bf16x8 pack8(const f32x16& p, int b) { u32x4 w; w.x = cvtpk(p[b], p[b + 1]); w.y = cvtpk(p[b + 2], p[b + 3]); w.z = cvtpk(p[b + 4], p[b + 5]); w.w = cvtpk(p[b + 6], p[b + 7]); return __builtin_bit_cast(bf16x8, w); }
__device__ __forceinline__ float vmax3(float a, float b, float c) { float r; asm("v_max3_f32 %0, %1, %2, %3" : "=v"(r) : "v"(a), "v"(b), "v"(c)); return r; }
__device__ __forceinline__ float max32(const f32x16& p, const f32x16& q) {
    float a = vmax3(p[0], p[1], p[2]), b = vmax3(p[3], p[4], p[5]), c = vmax3(p[6], p[7], p[8]), d = vmax3(p[9], p[10], p[11]), e = vmax3(p[12], p[13], p[14]);
    float f = vmax3(q[0], q[1], q[2]), g = vmax3(q[3], q[4], q[5]), h = vmax3(q[6], q[7], q[8]), i = vmax3(q[9], q[10], q[11]), j = vmax3(q[12], q[13], q[14]);
    a = vmax3(a, b, c); d = vmax3(d, e, p[15]); f = vmax3(f, g, h); i = vmax3(i, j, q[15]);
    return vmax3(vmax3(a, d, f), i, i);
}
__device__ __forceinline__ float max16(const f32x16& p) { float a = fmaxf(fmaxf(p[0], p[1]), fmaxf(p[2], p[3])), b = fmaxf(fmaxf(p[4], p[5]), fmaxf(p[6], p[7])), c = fmaxf(fmaxf(p[8], p[9]), fmaxf(p[10], p[11])), d = fmaxf(fmaxf(p[12], p[13]), fmaxf(p[14], p[15])); return fmaxf(fmaxf(a, b), fmaxf(c, d)); }

struct AttnP {
    const GAS bf16* Q; const GAS bf16* K; const GAS bf16* V; int qp, kp, vp;
    GAS bf16* O; int op;
    const GAS float* rope;
    const GAS int* pos; const GAS float* btab; const GAS float* dnorm; const GAS float* lams;
};
template <int KIND> struct AK {
    static constexpr bool DIFF = KIND == 1, CROSS = KIND == 2;
    static constexpr int HW = KIND == 0 ? 96 : KIND == 1 ? 64 : 256;
    static constexpr int NKS = KIND == 0 ? 6 : KIND == 1 ? 2 : 16;
    static constexpr int KP = KIND == 0 ? 208 : KIND == 1 ? 144 : 528;
    static constexpr int ND = CROSS ? 4 : 2;
    static constexpr int CPK = HW / 8, KCH = (64 * CPK + 511) / 512;
    static constexpr int VCH = ND / 2;
    static constexpr int KB = 64 * KP, VB = ND * 4096;
    static constexpr int NBUF = CROSS ? 2 : 3;
    static constexpr int K0 = 0, V0 = NBUF * KB, POS = V0 + NBUF * VB, BT = POS + 1024, DN = BT + 528, END = DN + 256;
};
static_assert(AK<2>::END <= RING_BYTES && AK<0>::END <= RING_BYTES && AK<1>::END + 16 + 8 * 8192 <= RING_BYTES, "attention LDS");

template <int KIND, bool LEAD>
__device__ __forceinline__ void attn_unit(const AttnP& P, int b, int h, int qb, int dhalf, LAS unsigned char* lds, int tid, int wave, int lane) {
    lane = lane_id_v(); tid = (wave << 6) | lane;
    typedef AK<KIND> C;
    constexpr bool DIFF = C::DIFF, CROSS = C::CROSS;
    constexpr int HW = C::HW, NKS = C::NKS, KP = C::KP, ND = C::ND, CPK = C::CPK, KCH = C::KCH, VCH = C::VCH;
    const int r32 = lane & 31, hi = lane >> 5;
    const size_t rowb = (size_t)b * S, rowk = CROSS ? (size_t)b * MEM : rowb;
    const int q0w = qb * 256 + wave * 32, qi = q0w + r32;
    int pq = 0; float bias_far = 0.f;
    __syncthreads();
    if (DIFF) {
        pq = P.pos[rowb + qi];
        if (tid < 129) ((LAS float*)(lds + C::BT))[tid] = P.btab[h * 129 + tid];
        if (tid >= 192 && tid < 256) ((LAS float*)(lds + C::DN))[tid - 192] = P.dnorm[tid - 192];
    }
    int minq = pq;
    if (DIFF) { for (int o = 1; o < 64; o <<= 1) { const int v = shxi(minq, o, lane); minq = v < minq ? v : minq; } }
    const int NT = CROSS ? MEM / 64 : 4 * (qb + 1);
    u32x4 kr[KCH], vr[VCH]; int pkr = 0;
    u32x4 kr2[CROSS ? 1 : KCH], vr2[CROSS ? 1 : VCH]; int pkr2 = 0;
    const GAS bf16* Kb = P.K + rowk * P.kp + h * HW; const GAS bf16* Vb = P.V + rowk * P.vp + (CROSS ? h * 256 + dhalf * 128 : h * 64);
    const __amdgpu_buffer_rsrc_t rK = __builtin_amdgcn_make_buffer_rsrc((void*)Kb, 0, 0x7fffffff, 0x00020000), rV = __builtin_amdgcn_make_buffer_rsrc((void*)Vb, 0, 0x7fffffff, 0x00020000);
    const __amdgpu_buffer_rsrc_t rP = __builtin_amdgcn_make_buffer_rsrc((void*)(DIFF ? P.pos + rowb : (const GAS int*)Kb), 0, 0x7fffffff, 0x00020000);
    int kvo[KCH], vvo[VCH];
#pragma unroll
    for (int i = 0; i < KCH; ++i) { int c = tid + 512 * i; c = c < 64 * CPK ? c : tid; kvo[i] = ((c / CPK) * P.kp + (c % CPK) * 8) * 2; }
#pragma unroll
    for (int i = 0; i < VCH; ++i) { const int c = tid + 512 * i; vvo[i] = ((c / (4 * ND)) * P.vp + (c % (4 * ND)) * 8) * 2; }
    const int pvo = (tid & 63) * 4;
    auto gload = [&](int t) {
        const int ks = __builtin_amdgcn_readfirstlane(64 * t * P.kp * 2), vs = __builtin_amdgcn_readfirstlane(64 * t * P.vp * 2);
#pragma unroll
        for (int i = 0; i < KCH; ++i) kr[i] = __builtin_amdgcn_raw_buffer_load_b128(rK, kvo[i], ks, 0);
#pragma unroll
        for (int i = 0; i < VCH; ++i) vr[i] = __builtin_amdgcn_raw_buffer_load_b128(rV, vvo[i], vs, 0);
        if (DIFF) pkr = __builtin_amdgcn_raw_buffer_load_b32(rP, pvo, __builtin_amdgcn_readfirstlane(64 * t * 4), 0);
    };
    auto lstore = [&](int buf) {
        LAS unsigned char* kb_ = lds + C::K0 + buf * C::KB; LAS unsigned char* vb_ = lds + C::V0 + buf * C::VB;
#pragma unroll
        for (int i = 0; i < KCH; ++i) { int c = tid + 512 * i; c = c < 64 * CPK ? c : tid; const int key = c / CPK, part = c % CPK; *(LAS u32x4*)(kb_ + key * KP + part * 16) = kr[i]; }
#pragma unroll
        for (int i = 0; i < VCH; ++i) { const int c = tid + 512 * i; const int key = c / (4 * ND), part = c % (4 * ND); *(LAS u32x4*)(vb_ + (part >> 2) * 4096 + (key >> 3) * 512 + (key & 7) * 64 + (part & 3) * 16) = vr[i]; }
        if (DIFF) { ((LAS int*)(lds + C::POS + buf * 256))[tid & 63] = pkr; if (tid < 64) { int mk_ = pkr; for (int o = 1; o < 64; o <<= 1) { const int v = shxi(mk_, o, lane); mk_ = v > mk_ ? v : mk_; } if (tid == 0) ((LAS int*)(lds + C::POS + 768))[buf] = mk_; } }
    };
    auto gloadB = [&](int t) {
        const int ks = __builtin_amdgcn_readfirstlane(64 * t * P.kp * 2), vs = __builtin_amdgcn_readfirstlane(64 * t * P.vp * 2);
#pragma unroll
        for (int i = 0; i < (CROSS ? 1 : KCH); ++i) kr2[i] = __builtin_amdgcn_raw_buffer_load_b128(rK, kvo[i], ks, 0);
#pragma unroll
        for (int i = 0; i < (CROSS ? 1 : VCH); ++i) vr2[i] = __builtin_amdgcn_raw_buffer_load_b128(rV, vvo[i], vs, 0);
        if (DIFF) pkr2 = __builtin_amdgcn_raw_buffer_load_b32(rP, pvo, __builtin_amdgcn_readfirstlane(64 * t * 4), 0);
    };
    auto lstoreB = [&](int buf) {
        LAS unsigned char* kb_ = lds + C::K0 + buf * C::KB; LAS unsigned char* vb_ = lds + C::V0 + buf * C::VB;
#pragma unroll
        for (int i = 0; i < (CROSS ? 1 : KCH); ++i) { int c = tid + 512 * i; c = c < 64 * CPK ? c : tid; const int key = c / CPK, part = c % CPK; *(LAS u32x4*)(kb_ + key * KP + part * 16) = kr2[i]; }
#pragma unroll
        for (int i = 0; i < (CROSS ? 1 : VCH); ++i) { const int c = tid + 512 * i; const int key = c / (4 * ND), part = c % (4 * ND); *(LAS u32x4*)(vb_ + (part >> 2) * 4096 + (key >> 3) * 512 + (key & 7) * 64 + (part & 3) * 16) = vr2[i]; }
        if (DIFF) { ((LAS int*)(lds + C::POS + buf * 256))[tid & 63] = pkr2; if (tid < 64) { int mk_ = pkr2; for (int o = 1; o < 64; o <<= 1) { const int v = shxi(mk_, o, lane); mk_ = v > mk_ ? v : mk_; } if (tid == 0) ((LAS int*)(lds + C::POS + 768))[buf] = mk_; } }
    };
    LAS float* osv = (LAS float*)(lds + ((C::END + 15) & ~15)) + wave * 2048 + lane;
    float il = 0.f;
    f32x16 oA[ND];
#pragma unroll 1
    for (int mp = 0; mp < (DIFF ? 2 : 1); ++mp) {
        bf16x8 qf[NKS];
        { const GAS bf16* qrow = P.Q + (rowb + qi) * P.qp + h * HW + mp * 32;
#pragma unroll
          for (int s = 0; s < NKS; ++s) qf[s] = *(const GAS bf16x8*)(qrow + 16 * s + 8 * hi);
          if (KIND == 0) {
              const GAS float* rp = P.rope + (rowb + qi) * 32 + 8 * hi;
              const f32x4 c0 = *(const GAS f32x4*)rp, c1 = *(const GAS f32x4*)(rp + 4), s0 = *(const GAS f32x4*)(rp + 16), s1 = *(const GAS f32x4*)(rp + 20);
              const u32x4 a = __builtin_bit_cast(u32x4, qf[NKS - 2]), bq = __builtin_bit_cast(u32x4, qf[NKS - 1]); u32x4 ra, rb;
#pragma unroll
              for (int w = 0; w < 4; ++w) { const float cl = w < 2 ? c0[2 * w] : c1[2 * w - 4], ch = w < 2 ? c0[2 * w + 1] : c1[2 * w - 3], sl = w < 2 ? s0[2 * w] : s1[2 * w - 4], sh = w < 2 ? s0[2 * w + 1] : s1[2 * w - 3];
                  const float x1l = bflo(a[w]), x1h = bfhi(a[w]), x2l = bflo(bq[w]), x2h = bfhi(bq[w]);
                  ra[w] = cvtpk(x1l * cl - x2l * sl, x1h * ch - x2h * sh); rb[w] = cvtpk(x1l * sl + x2l * cl, x1h * sh + x2h * ch); }
              qf[NKS - 2] = __builtin_bit_cast(bf16x8, ra); qf[NKS - 1] = __builtin_bit_cast(bf16x8, rb);
          } }
        __syncthreads();
        float m1 = -1e30f, l1 = 0.f;
#pragma unroll
        for (int d = 0; d < ND; ++d)
#pragma unroll
            for (int r = 0; r < 16; ++r) oA[d][r] = 0.f;
        auto qk = [&](int sl, f32x16& sa, f32x16& sb, float init) {
            const LAS unsigned char* kb_ = lds + C::K0 + sl * C::KB + r32 * KP + hi * 16 + mp * 64;
#pragma unroll
            for (int r = 0; r < 16; ++r) { sa[r] = init; sb[r] = init; }
            constexpr int HB = CROSS ? 4 : (NKS > 3 ? 3 : NKS);
#pragma unroll
            for (int s0_ = 0; s0_ < NKS; s0_ += HB) {
                bf16x8 kfa[HB], kfb[HB];
#pragma unroll
                for (int s = 0; s < HB; ++s) { kfa[s] = *(const LAS bf16x8*)(kb_ + (s0_ + s) * 32); kfb[s] = *(const LAS bf16x8*)(kb_ + 32 * KP + (s0_ + s) * 32); }
                __builtin_amdgcn_sched_barrier(0);
#pragma unroll
                for (int s = 0; s < HB; ++s) { sa = __builtin_amdgcn_mfma_f32_32x32x16_bf16(kfa[s], qf[s0_ + s], sa, 0, 0, 0); sb = __builtin_amdgcn_mfma_f32_32x32x16_bf16(kfb[s], qf[s0_ + s], sb, 0, 0, 0); }
                __builtin_amdgcn_sched_barrier(0);
            }
        };
        auto isnear = [&](int sl) { bool nb = false;
            if (DIFF) { const int mk_ = __builtin_amdgcn_readfirstlane(((LAS int*)(lds + C::POS + 768))[sl]); nb = (minq - mk_) < 128; }
            return nb; };
        auto sm = [&](int t, int sl, f32x16& pa, f32x16& pb, bool nearb) -> float {
            const int k0 = 64 * t;
            if (DIFF) { if (nearb) {
                const LAS int* pk = (const LAS int*)(lds + C::POS + sl * 256); const LAS float* bt = (const LAS float*)(lds + C::BT);
#pragma unroll
                for (int r = 0; r < 16; ++r) { const int kk = crow(r, hi);
                    int n0 = pq - pk[kk], n1 = pq - pk[kk + 32]; n0 = n0 < 0 ? 0 : (n0 > 128 ? 128 : n0); n1 = n1 < 0 ? 0 : (n1 > 128 ? 128 : n1);
                    pa[r] += bt[n0]; pb[r] += bt[n1]; }
            } }
            if (!CROSS && k0 + 63 > q0w) {
#pragma unroll
                for (int r = 0; r < 16; ++r) { const int kk = k0 + crow(r, hi); if (kk > qi) pa[r] = -1e30f; if (kk + 32 > qi) pb[r] = -1e30f; }
            }
            asm volatile("s_nop 15\n\ts_nop 7" : "+v"(pa), "+v"(pb));
            float mn, al = 1.f;
            if (CROSS) { const float mx = swapmax(max32(pa, pb)); mn = fmaxf(m1, mx); al = __builtin_amdgcn_exp2f(m1 - mn); l1 *= al; }
            else { const float mx = swapmax(max32(pa, pb)); const bool up = mx > m1 + 8.0f; mn = up ? mx : m1;
                   if (__builtin_amdgcn_ballot_w64(up) != 0ull) { al = __builtin_amdgcn_exp2f(m1 - mn); l1 *= al; } }
            m1 = mn;
            float ls = 0.f;
#pragma unroll
            for (int r = 0; r < 16; ++r) { pa[r] = __builtin_amdgcn_exp2f(pa[r] - mn); pb[r] = __builtin_amdgcn_exp2f(pb[r] - mn); ls += pa[r] + pb[r]; }
            l1 += ls;
            return al;
        };
        auto pv = [&](int sl, const f32x16& pa, const f32x16& pb, float al) {
            const LAS unsigned char* vb_ = lds + C::V0 + sl * C::VB + ((lane >> 4) & 1) * 32 + (lane & 3) * 8 + (4 * hi + ((lane & 15) >> 2)) * 64;
            bf16x8 pf[4];
            pf[0] = pack8(pa, 0); pf[1] = pack8(pa, 8); pf[2] = pack8(pb, 0); pf[3] = pack8(pb, 8);
            const bool resc = CROSS ? true : (__builtin_amdgcn_ballot_w64(al != 1.0f) != 0ull);
            if (CROSS) {
#pragma unroll
                for (int d = 0; d < ND; ++d) {
                    __builtin_amdgcn_sched_barrier(0);
#pragma unroll
                    for (int r = 0; r < 16; ++r) oA[d][r] *= al;
                    bf16x8 vf[4];
#pragma unroll
                    for (int s = 0; s < 4; ++s) { const s16x4 lo = vtr(vb_ + d * 4096 + s * 1024), hh = vtr(vb_ + d * 4096 + s * 1024 + 512); vf[s] = (bf16x8){lo[0], lo[1], lo[2], lo[3], hh[0], hh[1], hh[2], hh[3]}; }
#pragma unroll
                    for (int s = 0; s < 4; ++s) oA[d] = __builtin_amdgcn_mfma_f32_32x32x16_bf16(vf[s], pf[s], oA[d], 0, 0, 0);
                }
            } else if (DIFF) {
                if (resc) {
#pragma unroll
                    for (int d = 0; d < 2; ++d)
#pragma unroll
                        for (int r = 0; r < 16; ++r) oA[d][r] *= al;
                }
#pragma unroll
                for (int d = 0; d < 2; ++d) {
                    bf16x8 vf[4];
#pragma unroll
                    for (int s = 0; s < 4; ++s) { const s16x4 lo = vtr(vb_ + d * 4096 + s * 1024), hh = vtr(vb_ + d * 4096 + s * 1024 + 512); vf[s] = (bf16x8){lo[0], lo[1], lo[2], lo[3], hh[0], hh[1], hh[2], hh[3]}; }
                    __builtin_amdgcn_sched_barrier(0);
#pragma unroll
                    for (int s = 0; s < 4; ++s) oA[d] = __builtin_amdgcn_mfma_f32_32x32x16_bf16(vf[s], pf[s], oA[d], 0, 0, 0);
                }
            } else {
                bf16x8 vf[2][4];
#pragma unroll
                for (int d = 0; d < 2; ++d)
#pragma unroll
                    for (int s = 0; s < 4; ++s) { const s16x4 lo = vtr(vb_ + d * 4096 + s * 1024), hh = vtr(vb_ + d * 4096 + s * 1024 + 512); vf[d][s] = (bf16x8){lo[0], lo[1], lo[2], lo[3], hh[0], hh[1], hh[2], hh[3]}; }
                if (resc) {
#pragma unroll
                    for (int d = 0; d < 2; ++d)
#pragma unroll
                        for (int r = 0; r < 16; ++r) oA[d][r] *= al;
                }
                __builtin_amdgcn_sched_barrier(0);
#pragma unroll
                for (int s = 0; s < 4; ++s)
#pragma unroll
                    for (int d = 0; d < 2; ++d) oA[d] = __builtin_amdgcn_mfma_f32_32x32x16_bf16(vf[d][s], pf[s], oA[d], 0, 0, 0);
            }
        };
        if (CROSS) {
            gload(0); lstore(0);
            __syncthreads();
            for (int t = 0; t < NT; ++t) {
                const int buf = t & 1;
                f32x16 pa, pb;
                qk(buf, pa, pb, 0.f);
                const float al = sm(t, buf, pa, pb, false);
                pv(buf, pa, pb, al);
                if (t + 1 < NT) { gload(t + 1); lstore(buf ^ 1); }
                TILE_BAR();
            }
        } else {
            gload(0); lstore(0); gload(1); lstore(1);
            gload(2); gloadB(3);
            __syncthreads();
            if (DIFF) bias_far = ((LAS float*)(lds + C::BT))[128];
            const int NTW = (q0w + 31) / 64 + 1;
            constexpr bool lead = LEAD;
            f32x16 ca, cb, na, nb; bool cnear = isnear(0), nnear = false; float cal = 1.f;
            qk(0, ca, cb, (DIFF && !cnear) ? bias_far : 0.f);
            if (lead) cal = sm(0, 0, ca, cb, cnear);
            int s0 = 0, s1 = 1, s2 = 2;
            auto period = [&](int t, f32x16& xa, f32x16& xb, bool& xnear, f32x16& ya, f32x16& yb, bool& ynear) {
                const bool have_next = (t + 1 < NTW);
                if (lead) {
                    if (have_next) { ynear = isnear(s1); qk(s1, ya, yb, (DIFF && !ynear) ? bias_far : 0.f); }
                    if (t < NTW) pv(s0, xa, xb, cal);
                    if (have_next) cal = sm(t + 1, s1, ya, yb, ynear);
                } else {
                    if (t < NTW) cal = sm(t, s0, xa, xb, xnear);
                    if (have_next) { ynear = isnear(s1); qk(s1, ya, yb, (DIFF && !ynear) ? bias_far : 0.f); }
                    if (t < NTW) pv(s0, xa, xb, cal);
                }
                { const int tmp = s0; s0 = s1; s1 = s2; s2 = tmp; }
            };
            int t = 0;
            for (; t + 5 < NT; t += 2) {
                lstore(s2); gload(t + 4);
                period(t, ca, cb, cnear, na, nb, nnear);
                TILE_BAR();
                lstoreB(s2); gloadB(t + 5);
                period(t + 1, na, nb, nnear, ca, cb, cnear);
                TILE_BAR();
            }
            for (; t < NT; t += 2) {
                if (t + 2 < NT) { lstore(s2); if (t + 4 < NT) gload(t + 4); }
                period(t, ca, cb, cnear, na, nb, nnear);
                TILE_BAR();
                if (t + 3 < NT) { lstoreB(s2); if (t + 5 < NT) gloadB(t + 5); }
                period(t + 1, na, nb, nnear, ca, cb, cnear);
                TILE_BAR();
            }
        }
        il = 1.f / swapadd(l1);
        if (DIFF) { if (mp == 0) {
#pragma unroll
            for (int d = 0; d < 2; ++d)
#pragma unroll
                for (int r = 0; r < 16; ++r) osv[(d * 16 + r) * 64] = oA[d][r] * il; } }
    }
    GAS bf16* orow = P.O + (rowb + qi) * P.op + (CROSS ? h * 256 + dhalf * 128 : h * 64);
    if (!DIFF) {
#pragma unroll
        for (int d = 0; d < ND; ++d)
#pragma unroll
            for (int g = 0; g < 4; ++g) { v2u v; v.x = cvtpk(oA[d][4 * g] * il, oA[d][4 * g + 1] * il); v.y = cvtpk(oA[d][4 * g + 2] * il, oA[d][4 * g + 3] * il); *(GAS v2u*)(orow + 32 * d + 8 * g + 4 * hi) = v; }
    } else {
        const float lam = P.lams[0], lam_init = P.lams[1];
        const float i2 = lam * il;
        float ss = 0.f;
#pragma unroll
        for (int d = 0; d < 2; ++d)
#pragma unroll
            for (int r = 0; r < 16; ++r) { const float v = osv[(d * 16 + r) * 64] - oA[d][r] * i2; oA[d][r] = v; ss += v * v; }
        ss = swapadd(ss);
        const float rs = __builtin_amdgcn_rsqf(ss * (1.f / 64.f) + 1e-6f) * (1.f - lam_init);
        const LAS float* dn = (const LAS float*)(lds + C::DN);
#pragma unroll
        for (int d = 0; d < 2; ++d)
#pragma unroll
            for (int g = 0; g < 4; ++g) { const int c = 32 * d + 8 * g + 4 * hi; const f32x4 gn = *(const LAS f32x4*)(dn + c);
                v2u v; v.x = cvtpk(oA[d][4 * g] * rs * gn[0], oA[d][4 * g + 1] * rs * gn[1]); v.y = cvtpk(oA[d][4 * g + 2] * rs * gn[2], oA[d][4 * g + 3] * rs * gn[3]); *(GAS v2u*)(orow + c) = v; }
    }
}

__device__ __forceinline__ int wave_max_i(int v) {
    { const int o = __builtin_amdgcn_update_dpp(0, v, 0xB1, 0xF, 0xF, true); v = o > v ? o : v; }
    { const int o = __builtin_amdgcn_update_dpp(0, v, 0x4E, 0xF, 0xF, true); v = o > v ? o : v; }
    { const int o = __builtin_amdgcn_update_dpp(0, v, 0x141, 0xF, 0xF, true); v = o > v ? o : v; }
    { const int o = __builtin_amdgcn_update_dpp(0, v, 0x140, 0xF, 0xF, true); v = o > v ? o : v; }
    { int a = v, b = v; asm volatile("v_nop\n\tv_nop\n\tv_permlane16_swap_b32 %0, %1" : "+v"(a), "+v"(b)); v = a > b ? a : b; }
    { int a = v, b = v; asm volatile("v_nop\n\tv_nop\n\tv_permlane32_swap_b32 %0, %1" : "+v"(a), "+v"(b)); v = a > b ? a : b; }
    return v;
}
template <int KIND> struct AK2 {
    static constexpr bool DIFF = KIND == 1;
    static constexpr int HW = KIND == 0 ? 96 : 64, NKS = KIND == 0 ? 6 : 2, KP = KIND == 0 ? 208 : 144;
    static constexpr int CPK = HW / 8, KCH = (128 * CPK) / 512, VCH = 2;
    static constexpr int KB = 128 * KP, VB = 2 * 8192;
    static constexpr int K0 = 0, V0 = 2 * KB, POS = V0 + 2 * VB, PMX = POS + 1024, BT = PMX + 16, DN = BT + 528, OSV = (DN + 256 + 15) & ~15, END = OSV + (DIFF ? 8 * 8192 : 0);
};
static_assert(AK2<0>::END <= RING_BYTES && AK2<1>::END <= RING_BYTES, "attention LDS (128-key tiles)");
template <int KIND>
__device__ __forceinline__ void attn_unit2(const AttnP& P, int b, int h, int qb, LAS unsigned char* lds, int tid, int wave, int lane) {
    lane = lane_id_v(); tid = (wave << 6) | lane;
    typedef AK2<KIND> C;
    constexpr bool DIFF = C::DIFF;
    constexpr int HW = C::HW, NKS = C::NKS, KP = C::KP, CPK = C::CPK, KCH = C::KCH, VCH = C::VCH;
    const int r32 = lane & 31, hi = lane >> 5;
    const size_t rowb = (size_t)b * S;
    const int q0w = qb * 256 + wave * 32, qi = q0w + r32;
    int pq = 0; float bias_far = 0.f;
    __syncthreads();
    if (DIFF) {
        pq = P.pos[rowb + qi];
        if (tid < 129) ((LAS float*)(lds + C::BT))[tid] = P.btab[h * 129 + tid];
        if (tid >= 192 && tid < 256) ((LAS float*)(lds + C::DN))[tid - 192] = P.dnorm[tid - 192];
    }
    int minq = pq;
    if (DIFF) minq = __builtin_amdgcn_readfirstlane(-wave_max_i(-pq));
    const int NT = 2 * (qb + 1);
    const GAS bf16* Kb = P.K + rowb * P.kp + h * HW; const GAS bf16* Vb = P.V + rowb * P.vp + h * 64;
    const __amdgpu_buffer_rsrc_t rK = __builtin_amdgcn_make_buffer_rsrc((void*)Kb, 0, 0x7fffffff, 0x00020000), rV = __builtin_amdgcn_make_buffer_rsrc((void*)Vb, 0, 0x7fffffff, 0x00020000);
    const __amdgpu_buffer_rsrc_t rP = __builtin_amdgcn_make_buffer_rsrc((void*)(DIFF ? P.pos + rowb : (const GAS int*)Kb), 0, 0x7fffffff, 0x00020000);
    int kvo[KCH], vvo[VCH], klo[KCH], vlo[VCH];
#pragma unroll
    for (int i = 0; i < KCH; ++i) { const int c = tid + 512 * i; kvo[i] = ((c / CPK) * P.kp + (c % CPK) * 8) * 2; klo[i] = (c / CPK) * KP + (c % CPK) * 16; }
#pragma unroll
    for (int i = 0; i < VCH; ++i) { const int c = tid + 512 * i; const int key = c >> 3, part = c & 7; vvo[i] = (key * P.vp + part * 8) * 2; vlo[i] = (part >> 2) * 8192 + (key >> 3) * 512 + (key & 7) * 64 + (part & 3) * 16; }
    const int pvo = (tid & 127) * 4;
    u32x4 kr[KCH], vr[VCH]; int pkr = 0;
    auto gload = [&](int t) {
        const int ks = __builtin_amdgcn_readfirstlane(128 * t * P.kp * 2), vs = __builtin_amdgcn_readfirstlane(128 * t * P.vp * 2);
#pragma unroll
        for (int i = 0; i < KCH; ++i) kr[i] = __builtin_amdgcn_raw_buffer_load_b128(rK, kvo[i], ks, 0);
#pragma unroll
        for (int i = 0; i < VCH; ++i) vr[i] = __builtin_amdgcn_raw_buffer_load_b128(rV, vvo[i], vs, 0);
        if (DIFF) pkr = __builtin_amdgcn_raw_buffer_load_b32(rP, pvo, __builtin_amdgcn_readfirstlane(128 * t * 4), 0);
    };
    auto lstore = [&](int buf) {
        LAS unsigned char* kb_ = lds + C::K0 + buf * C::KB; LAS unsigned char* vb_ = lds + C::V0 + buf * C::VB;
#pragma unroll
        for (int i = 0; i < KCH; ++i) *(LAS u32x4*)(kb_ + klo[i]) = kr[i];
#pragma unroll
        for (int i = 0; i < VCH; ++i) *(LAS u32x4*)(vb_ + vlo[i]) = vr[i];
        if (DIFF) { ((LAS int*)(lds + C::POS + buf * 512))[tid & 127] = pkr;
            if (tid < 128) { const int mk_ = wave_max_i(pkr); if (lane == 0) ((LAS int*)(lds + C::PMX))[buf * 2 + wave] = mk_; } }
    };
    LAS float* osv = (LAS float*)(lds + C::OSV) + wave * 2048 + lane;
    float il = 0.f;
    f32x16 oA[2];
#pragma unroll 1
    for (int mp = 0; mp < (DIFF ? 2 : 1); ++mp) {
        bf16x8 qf[NKS];
        { const GAS bf16* qrow = P.Q + (rowb + qi) * P.qp + h * HW + mp * 32;
#pragma unroll
          for (int s = 0; s < NKS; ++s) qf[s] = *(const GAS bf16x8*)(qrow + 16 * s + 8 * hi);
          if (KIND == 0) {
              const GAS float* rp = P.rope + (rowb + qi) * 32 + 8 * hi;
              const f32x4 c0 = *(const GAS f32x4*)rp, c1 = *(const GAS f32x4*)(rp + 4), s0 = *(const GAS f32x4*)(rp + 16), s1 = *(const GAS f32x4*)(rp + 20);
              const u32x4 a = __builtin_bit_cast(u32x4, qf[NKS - 2]), bq = __builtin_bit_cast(u32x4, qf[NKS - 1]); u32x4 ra, rb;
#pragma unroll
              for (int w = 0; w < 4; ++w) { const float cl = w < 2 ? c0[2 * w] : c1[2 * w - 4], ch = w < 2 ? c0[2 * w + 1] : c1[2 * w - 3], sl = w < 2 ? s0[2 * w] : s1[2 * w - 4], sh = w < 2 ? s0[2 * w + 1] : s1[2 * w - 3];
                  const float x1l = bflo(a[w]), x1h = bfhi(a[w]), x2l = bflo(bq[w]), x2h = bfhi(bq[w]);
                  ra[w] = cvtpk(x1l * cl - x2l * sl, x1h * ch - x2h * sh); rb[w] = cvtpk(x1l * sl + x2l * cl, x1h * sh + x2h * ch); }
              qf[NKS - 2] = __builtin_bit_cast(bf16x8, ra); qf[NKS - 1] = __builtin_bit_cast(bf16x8, rb);
          } }
        __syncthreads();
        float m1 = 0.f, l1 = 0.f;
        f32x16 negm;
#pragma unroll
        for (int r = 0; r < 16; ++r) negm[r] = 0.f;
#pragma unroll
        for (int d = 0; d < 2; ++d)
#pragma unroll
            for (int r = 0; r < 16; ++r) oA[d][r] = 0.f;
        gload(0); lstore(0);
        if (NT > 1) gload(1);
        __syncthreads();
        if (DIFF) { bias_far = ((LAS float*)(lds + C::BT))[128];
#pragma unroll
            for (int r = 0; r < 16; ++r) negm[r] = bias_far; }
        const int NTW = (q0w + 31) / 128 + 1;
        auto compute = [&](int t, int buf) {
            const int k0 = 128 * t;
            const LAS unsigned char* kb_ = lds + C::K0 + buf * C::KB + r32 * KP + hi * 16 + mp * 64;
            const LAS unsigned char* vb_ = lds + C::V0 + buf * C::VB + ((lane >> 4) & 1) * 32 + (lane & 3) * 8 + (4 * hi + ((lane & 15) >> 2)) * 64;
            bool nearb = false;
            if (DIFF) { const LAS int* pm = (const LAS int*)(lds + C::PMX) + buf * 2; const int m0 = __builtin_amdgcn_readfirstlane(pm[0]), m1_ = __builtin_amdgcn_readfirstlane(pm[1]); nearb = (minq - (m0 > m1_ ? m0 : m1_)) < 128; }
            f32x16 sc[4];
            if (DIFF) { if (nearb) {
#pragma unroll
                for (int g = 0; g < 4; ++g)
#pragma unroll
                    for (int r = 0; r < 16; ++r) sc[g][r] = -m1; } }
            constexpr int HB = NKS > 3 ? 3 : NKS;
#pragma unroll
            for (int s0_ = 0; s0_ < NKS; s0_ += HB) {
                bf16x8 kf[4][HB];
#pragma unroll
                for (int g = 0; g < 4; ++g)
#pragma unroll
                    for (int s = 0; s < HB; ++s) kf[g][s] = *(const LAS bf16x8*)(kb_ + 32 * g * KP + (s0_ + s) * 32);
                __builtin_amdgcn_sched_barrier(0);
#pragma unroll
                for (int s = 0; s < HB; ++s)
#pragma unroll
                    for (int g = 0; g < 4; ++g) {
                        if (s0_ + s == 0 && !(DIFF && nearb)) sc[g] = __builtin_amdgcn_mfma_f32_32x32x16_bf16(kf[g][s], qf[s0_ + s], negm, 0, 0, 0);
                        else sc[g] = __builtin_amdgcn_mfma_f32_32x32x16_bf16(kf[g][s], qf[s0_ + s], sc[g], 0, 0, 0); }
                __builtin_amdgcn_sched_barrier(0);
            }
            if (DIFF) { if (nearb) {
                const LAS int* pk = (const LAS int*)(lds + C::POS + buf * 512); const LAS float* bt = (const LAS float*)(lds + C::BT);
#pragma unroll
                for (int g = 0; g < 4; ++g)
#pragma unroll
                    for (int r = 0; r < 16; ++r) { int n0 = pq - pk[32 * g + crow(r, hi)]; n0 = n0 < 0 ? 0 : (n0 > 128 ? 128 : n0); sc[g][r] += bt[n0]; }
            } }
            asm volatile("s_nop 15\n\ts_nop 7" : "+v"(sc[0]), "+v"(sc[1]), "+v"(sc[2]), "+v"(sc[3]));
            if (k0 + 127 > q0w) {
#pragma unroll
                for (int g = 0; g < 4; ++g)
#pragma unroll
                    for (int r = 0; r < 16; ++r) { if (k0 + 32 * g + crow(r, hi) > qi) sc[g][r] = -1e30f; }
            }
            const float mx = swapmax(vmax3(max32(sc[0], sc[1]), max32(sc[2], sc[3]), -1e30f));
            const bool up = (t == 0) || mx > 8.0f;
            float al = 1.f;
            if (__builtin_amdgcn_ballot_w64(up) != 0ull) {
                const float dl = up ? mx : 0.f; al = __builtin_amdgcn_exp2f(-dl); l1 *= al; m1 += dl;
#pragma unroll
                for (int r = 0; r < 16; ++r) negm[r] -= dl;
#pragma unroll
                for (int g = 0; g < 4; ++g)
#pragma unroll
                    for (int r = 0; r < 16; ++r) sc[g][r] -= dl;
            }
            float ls = 0.f;
#pragma unroll
            for (int g = 0; g < 4; ++g)
#pragma unroll
                for (int r = 0; r < 16; ++r) { sc[g][r] = __builtin_amdgcn_exp2f(sc[g][r]); ls += sc[g][r]; }
            l1 += ls;
            bf16x8 pf[8];
#pragma unroll
            for (int g = 0; g < 4; ++g) { pf[2 * g] = pack8(sc[g], 0); pf[2 * g + 1] = pack8(sc[g], 8); }
            if (__builtin_amdgcn_ballot_w64(al != 1.0f) != 0ull) {
#pragma unroll
                for (int d = 0; d < 2; ++d)
#pragma unroll
                    for (int r = 0; r < 16; ++r) oA[d][r] *= al;
            }
#pragma unroll
            for (int d = 0; d < 2; ++d) {
                bf16x8 vf[8];
#pragma unroll
                for (int s = 0; s < 8; ++s) { const s16x4 lo = vtr(vb_ + d * 8192 + s * 1024), hh = vtr(vb_ + d * 8192 + s * 1024 + 512); vf[s] = (bf16x8){lo[0], lo[1], lo[2], lo[3], hh[0], hh[1], hh[2], hh[3]}; }
                __builtin_amdgcn_sched_barrier(0);
#pragma unroll
                for (int s = 0; s < 8; ++s) oA[d] = __builtin_amdgcn_mfma_f32_32x32x16_bf16(vf[s], pf[s], oA[d], 0, 0, 0);
                __builtin_amdgcn_sched_barrier(0);
            }
        };
        int t = 0;
        for (; t + 2 < NT; ++t) {
            const int buf = t & 1;
            if (t < NTW) compute(t, buf);
            lstore(buf ^ 1); gload(t + 2);
            TILE_BAR();
        }
        for (; t < NT; ++t) {
            const int buf = t & 1;
            if (t < NTW) compute(t, buf);
            if (t + 1 < NT) lstore(buf ^ 1);
            TILE_BAR();
        }
        il = 1.f / swapadd(l1);
        if (DIFF) { if (mp == 0) {
#pragma unroll
            for (int d = 0; d < 2; ++d)
#pragma unroll
                for (int r = 0; r < 16; ++r) osv[(d * 16 + r) * 64] = oA[d][r] * il; } }
    }
    GAS bf16* orow = P.O + (rowb + qi) * P.op + h * 64;
    if (!DIFF) {
#pragma unroll
        for (int d = 0; d < 2; ++d)
#pragma unroll
            for (int g = 0; g < 4; ++g) { v2u v; v.x = cvtpk(oA[d][4 * g] * il, oA[d][4 * g + 1] * il); v.y = cvtpk(oA[d][4 * g + 2] * il, oA[d][4 * g + 3] * il); *(GAS v2u*)(orow + 32 * d + 8 * g + 4 * hi) = v; }
    } else {
        const float lam = P.lams[0], lam_init = P.lams[1];
        const float i2 = lam * il;
        float ss = 0.f;
#pragma unroll
        for (int d = 0; d < 2; ++d)
#pragma unroll
            for (int r = 0; r < 16; ++r) { const float v = osv[(d * 16 + r) * 64] - oA[d][r] * i2; oA[d][r] = v; ss += v * v; }
        ss = swapadd(ss);
        const float rs = __builtin_amdgcn_rsqf(ss * (1.f / 64.f) + 1e-6f) * (1.f - lam_init);
        const LAS float* dn = (const LAS float*)(lds + C::DN);
#pragma unroll
        for (int d = 0; d < 2; ++d)
#pragma unroll
            for (int g = 0; g < 4; ++g) { const int c = 32 * d + 8 * g + 4 * hi; const f32x4 gn = *(const LAS f32x4*)(dn + c);
                v2u v; v.x = cvtpk(oA[d][4 * g] * rs * gn[0], oA[d][4 * g + 1] * rs * gn[1]); v.y = cvtpk(oA[d][4 * g + 2] * rs * gn[2], oA[d][4 * g + 3] * rs * gn[3]); *(GAS v2u*)(orow + c) = v; }
    }
}

struct AKD {
    static constexpr int KP = 144, KB = 64 * KP, VB = 2 * 4096;
    static constexpr int K0 = 0, V0 = 2 * KB, POS = V0 + 2 * VB, PMX = POS + 512, BT = PMX + 16, DN = BT + 528, END = DN + 256;
};
static_assert(AKD::END <= RING_BYTES, "attention LDS (merged differential maps)");
__device__ __forceinline__ void attn_diff_unit(const AttnP& P, int b, int h, int qb, LAS unsigned char* lds, int wave) {
    const int lane = lane_id_v(), tid = (wave << 6) | lane;
    typedef AKD C;
    constexpr int KP = C::KP;
    const int r32 = lane & 31, hi = lane >> 5;
    const size_t rowb = (size_t)b * S;
    const int q0w = qb * 256 + wave * 32, qi = q0w + r32;
    __syncthreads();
    const int pq = P.pos[rowb + qi];
    if (tid < 129) ((LAS float*)(lds + C::BT))[tid] = P.btab[h * 129 + tid];
    if (tid >= 192 && tid < 256) ((LAS float*)(lds + C::DN))[tid - 192] = P.dnorm[tid - 192];
    const int minq = __builtin_amdgcn_readfirstlane(-wave_max_i(-pq));
    const int NT = 4 * (qb + 1);
    const GAS bf16* Kb = P.K + rowb * P.kp + h * 64; const GAS bf16* Vb = P.V + rowb * P.vp + h * 64;
    const __amdgpu_buffer_rsrc_t rK = __builtin_amdgcn_make_buffer_rsrc((void*)Kb, 0, 0x7fffffff, 0x00020000), rV = __builtin_amdgcn_make_buffer_rsrc((void*)Vb, 0, 0x7fffffff, 0x00020000);
    const __amdgpu_buffer_rsrc_t rP = __builtin_amdgcn_make_buffer_rsrc((void*)(P.pos + rowb), 0, 0x7fffffff, 0x00020000);
    const int skey = tid >> 3, spart = tid & 7;
    const int kvo = (skey * P.kp + spart * 8) * 2, vvo = (skey * P.vp + spart * 8) * 2, klo = skey * KP + spart * 16, vlo = (spart >> 2) * 4096 + (skey >> 3) * 512 + (skey & 7) * 64 + (spart & 3) * 16;
    const int pvo = (tid & 63) * 4;
    u32x4 kr, vr; int pkr = 0;
    auto gload = [&](int t) {
        kr = __builtin_amdgcn_raw_buffer_load_b128(rK, kvo, __builtin_amdgcn_readfirstlane(64 * t * P.kp * 2), 0);
        vr = __builtin_amdgcn_raw_buffer_load_b128(rV, vvo, __builtin_amdgcn_readfirstlane(64 * t * P.vp * 2), 0);
        pkr = __builtin_amdgcn_raw_buffer_load_b32(rP, pvo, __builtin_amdgcn_readfirstlane(64 * t * 4), 0);
    };
    auto lstore = [&](int buf) {
        *(LAS u32x4*)(lds + C::K0 + buf * C::KB + klo) = kr; *(LAS u32x4*)(lds + C::V0 + buf * C::VB + vlo) = vr;
        if (tid < 64) { ((LAS int*)(lds + C::POS + buf * 256))[tid] = pkr; const int mk_ = wave_max_i(pkr); if (lane == 0) ((LAS int*)(lds + C::PMX))[buf] = mk_; }
    };
    gload(0);
    bf16x8 qf[2][2];
    { const GAS bf16* qrow = P.Q + (rowb + qi) * P.qp + h * 64;
#pragma unroll
      for (int mp = 0; mp < 2; ++mp)
#pragma unroll
          for (int s_ = 0; s_ < 2; ++s_) qf[mp][s_] = *(const GAS bf16x8*)(qrow + 32 * mp + 16 * s_ + 8 * hi); }
    __syncthreads();
    lstore(0);
    if (NT > 1) gload(1);
    __syncthreads();
    const float bias_far = ((LAS float*)(lds + C::BT))[128];
    float m_[2] = {0.f, 0.f}, l_[2] = {0.f, 0.f};
    f32x16 negm[2], oA[2][2];
#pragma unroll
    for (int mp = 0; mp < 2; ++mp) {
#pragma unroll
        for (int r = 0; r < 16; ++r) { negm[mp][r] = bias_far; oA[mp][0][r] = 0.f; oA[mp][1][r] = 0.f; } }
    const int NTW = (q0w + 31) / 64 + 1;
    auto compute = [&](int t, int buf) {
        const int k0 = 64 * t;
        const LAS unsigned char* kb_ = lds + C::K0 + buf * C::KB + r32 * KP + hi * 16;
        const LAS unsigned char* vb_ = lds + C::V0 + buf * C::VB + ((lane >> 4) & 1) * 32 + (lane & 3) * 8 + (4 * hi + ((lane & 15) >> 2)) * 64;
        const bool nearb = (minq - __builtin_amdgcn_readfirstlane(((const LAS int*)(lds + C::PMX))[buf])) < 128;
        const bool diag = k0 + 63 > q0w;
        bf16x8 pf[2][4];
#pragma unroll
        for (int mp = 0; mp < 2; ++mp) {
            f32x16 sc[2];
            bf16x8 kf[2][2];
#pragma unroll
            for (int g = 0; g < 2; ++g)
#pragma unroll
                for (int s_ = 0; s_ < 2; ++s_) kf[g][s_] = *(const LAS bf16x8*)(kb_ + 32 * g * KP + mp * 64 + s_ * 32);
            if (nearb) {
#pragma unroll
                for (int g = 0; g < 2; ++g) {
#pragma unroll
                    for (int r = 0; r < 16; ++r) sc[g][r] = -m_[mp];
#pragma unroll
                    for (int s_ = 0; s_ < 2; ++s_) sc[g] = __builtin_amdgcn_mfma_f32_32x32x16_bf16(kf[g][s_], qf[mp][s_], sc[g], 0, 0, 0); }
                const LAS int* pk = (const LAS int*)(lds + C::POS + buf * 256); const LAS float* bt = (const LAS float*)(lds + C::BT);
#pragma unroll
                for (int g = 0; g < 2; ++g)
#pragma unroll
                    for (int r = 0; r < 16; ++r) { int n0 = pq - pk[32 * g + crow(r, hi)]; n0 = n0 < 0 ? 0 : (n0 > 128 ? 128 : n0); sc[g][r] += bt[n0]; }
            } else {
#pragma unroll
                for (int g = 0; g < 2; ++g) { sc[g] = __builtin_amdgcn_mfma_f32_32x32x16_bf16(kf[g][0], qf[mp][0], negm[mp], 0, 0, 0); sc[g] = __builtin_amdgcn_mfma_f32_32x32x16_bf16(kf[g][1], qf[mp][1], sc[g], 0, 0, 0); }
            }
            asm volatile("s_nop 15\n\ts_nop 7" : "+v"(sc[0]), "+v"(sc[1]));
            if (diag) {
#pragma unroll
                for (int g = 0; g < 2; ++g)
#pragma unroll
                    for (int r = 0; r < 16; ++r) { if (k0 + 32 * g + crow(r, hi) > qi) sc[g][r] = -1e30f; }
            }
            const float mx = swapmax(vmax3(max32(sc[0], sc[1]), -1e30f, -1e30f));
            const bool up = (t == 0) || mx > 8.0f;
            if (__builtin_amdgcn_ballot_w64(up) != 0ull) {
                const float dl = up ? mx : 0.f; const float al = __builtin_amdgcn_exp2f(-dl); l_[mp] *= al; m_[mp] += dl;
#pragma unroll
                for (int r = 0; r < 16; ++r) negm[mp][r] -= dl;
#pragma unroll
                for (int g = 0; g < 2; ++g)
#pragma unroll
                    for (int r = 0; r < 16; ++r) sc[g][r] -= dl;
#pragma unroll
                for (int d = 0; d < 2; ++d)
#pragma unroll
                    for (int r = 0; r < 16; ++r) oA[mp][d][r] *= al;
            }
            float ls = 0.f;
#pragma unroll
            for (int g = 0; g < 2; ++g)
#pragma unroll
                for (int r = 0; r < 16; ++r) { sc[g][r] = __builtin_amdgcn_exp2f(sc[g][r]); ls += sc[g][r]; }
            l_[mp] += ls;
#pragma unroll
            for (int g = 0; g < 2; ++g) { pf[mp][2 * g] = pack8(sc[g], 0); pf[mp][2 * g + 1] = pack8(sc[g], 8); }
        }
#pragma unroll
        for (int d = 0; d < 2; ++d) {
            bf16x8 vf[4];
#pragma unroll
            for (int s_ = 0; s_ < 4; ++s_) { const s16x4 lo = vtr(vb_ + d * 4096 + s_ * 1024), hh = vtr(vb_ + d * 4096 + s_ * 1024 + 512); vf[s_] = (bf16x8){lo[0], lo[1], lo[2], lo[3], hh[0], hh[1], hh[2], hh[3]}; }
#pragma unroll
            for (int s_ = 0; s_ < 4; ++s_) { oA[0][d] = __builtin_amdgcn_mfma_f32_32x32x16_bf16(vf[s_], pf[0][s_], oA[0][d], 0, 0, 0); oA[1][d] = __builtin_amdgcn_mfma_f32_32x32x16_bf16(vf[s_], pf[1][s_], oA[1][d], 0, 0, 0); }
        }
    };
#pragma unroll 1
    for (int t = 0; t < NT; ++t) {
        const int buf = t & 1;
        if (t < NTW) compute(t, buf);
        if (t + 1 < NT) lstore(buf ^ 1);
        if (t + 2 < NT) gload(t + 2);
        TILE_BAR();
    }
    const float il1 = 1.f / swapadd(l_[0]), il2 = 1.f / swapadd(l_[1]);
    const float lam = P.lams[0], lam_init = P.lams[1];
    const float i2 = lam * il2;
    float ss = 0.f;
#pragma unroll
    for (int d = 0; d < 2; ++d)
#pragma unroll
        for (int r = 0; r < 16; ++r) { const float v = oA[0][d][r] * il1 - oA[1][d][r] * i2; oA[0][d][r] = v; ss += v * v; }
    ss = swapadd(ss);
    const float rs = __builtin_amdgcn_rsqf(ss * (1.f / 64.f) + 1e-6f) * (1.f - lam_init);
    const LAS float* dn = (const LAS float*)(lds + C::DN);
    GAS bf16* orow = P.O + (rowb + qi) * P.op + h * 64;
#pragma unroll
    for (int d = 0; d < 2; ++d)
#pragma unroll
        for (int g = 0; g < 4; ++g) { const int c = 32 * d + 8 * g + 4 * hi; const f32x4 gn = *(const LAS f32x4*)(dn + c);
            v2u v; v.x = cvtpk(oA[0][d][4 * g] * rs * gn[0], oA[0][d][4 * g + 1] * rs * gn[1]); v.y = cvtpk(oA[0][d][4 * g + 2] * rs * gn[2], oA[0][d][4 * g + 3] * rs * gn[3]); *(GAS v2u*)(orow + c) = v; }
}

__device__ __forceinline__ void attn_phase(const AttnP& PM, const AttnP& PD, LAS unsigned char* lds, int tid, int wave, int lane, int vcu, int G, int only = -1) {
    for (int i = vcu; i < 512; i += G) {
        if (only >= 0 && (i >> 8) != only) continue;
        const int kind = i >> 8, c = i & 255, bh = c >> 4, s = c & 15;
        if (kind == 0) {
#pragma unroll 1
            for (int k = 0; k < 2; ++k) attn_unit2<0>(PM, bh >> 2, bh & 3, k ? 31 - s : s, lds, tid, wave, lane);
        } else {
#pragma unroll 1
            for (int k = 0; k < 2; ++k) attn_diff_unit(PD, bh >> 2, bh & 3, k ? 31 - s : s, lds, wave);
        }
    }
}
__device__ __forceinline__ float cx_max16(const f32x16& p) { return fmaxf(fmaxf(fmaxf(fmaxf(p[0], p[1]), fmaxf(p[2], p[3])), fmaxf(fmaxf(p[4], p[5]), fmaxf(p[6], p[7]))), fmaxf(fmaxf(fmaxf(p[8], p[9]), fmaxf(p[10], p[11])), fmaxf(fmaxf(p[12], p[13]), fmaxf(p[14], p[15])))); }
__device__ __forceinline__ void cross_unit2(const AttnP& P, int b, int h, int qb, LAS unsigned char* lds, int wave) {
    const int lane = lane_id_v(), tid = (wave << 6) | lane;
    constexpr int KP = 528;
    const int r32 = lane & 31, hi = lane >> 5;
    const size_t rowb = (size_t)b * S, rowk = (size_t)b * MEM;
    const int qi = qb * 256 + wave * 32 + r32;
    const GAS bf16* Kb = P.K + rowk * P.kp + h * 256; const GAS bf16* Vb = P.V + rowk * P.vp + h * 256;
    const __amdgpu_buffer_rsrc_t rK = __builtin_amdgcn_make_buffer_rsrc((void*)Kb, 0, 0x7fffffff, 0x00020000), rV = __builtin_amdgcn_make_buffer_rsrc((void*)Vb, 0, 0x7fffffff, 0x00020000);
    const GAS bf16* qrow = P.Q + (rowb + qi) * P.qp + h * 256 + 8 * hi;
    bf16x8 qf[4];
#pragma unroll
    for (int s = 0; s < 4; ++s) qf[s] = *(const GAS bf16x8*)(qrow + 16 * s);
    { u32x4 st[16];
#pragma unroll
      for (int i = 0; i < 16; ++i) { const int c = tid + 512 * i; st[i] = __builtin_amdgcn_raw_buffer_load_b128(rK, ((c >> 5) * P.kp + (c & 31) * 8) * 2, 0, 0); }
      TILE_BAR();
#pragma unroll
      for (int i = 0; i < 16; ++i) { const int c = tid + 512 * i; *(LAS u32x4*)(lds + (c >> 5) * KP + (c & 31) * 16) = st[i]; } }
    __syncthreads();
    f32x16 sc[8];
#pragma unroll
    for (int g = 0; g < 8; ++g)
#pragma unroll
        for (int r = 0; r < 16; ++r) sc[g][r] = 0.f;
    const LAS unsigned char* kb_ = lds + r32 * KP + hi * 16;
#pragma unroll
    for (int c = 0; c < 4; ++c) {
        bf16x8 qn[4];
        if (c + 1 < 4) {
#pragma unroll
            for (int s = 0; s < 4; ++s) qn[s] = *(const GAS bf16x8*)(qrow + 64 * (c + 1) + 16 * s); }
#pragma unroll
        for (int g = 0; g < 8; ++g) { bf16x8 kf[4];
#pragma unroll
            for (int s = 0; s < 4; ++s) kf[s] = *(const LAS bf16x8*)(kb_ + 32 * g * KP + (4 * c + s) * 32);
#pragma unroll
            for (int s = 0; s < 4; ++s) sc[g] = __builtin_amdgcn_mfma_f32_32x32x16_bf16(kf[s], qf[s], sc[g], 0, 0, 0); }
        if (c + 1 < 4) {
#pragma unroll
            for (int s = 0; s < 4; ++s) qf[s] = qn[s]; }
    }
    float m = fmaxf(fmaxf(fmaxf(cx_max16(sc[0]), cx_max16(sc[1])), fmaxf(cx_max16(sc[2]), cx_max16(sc[3]))), fmaxf(fmaxf(cx_max16(sc[4]), cx_max16(sc[5])), fmaxf(cx_max16(sc[6]), cx_max16(sc[7]))));
    m = swapmax(m);
    float l = 0.f;
    bf16x8 pf[16];
#pragma unroll
    for (int g = 0; g < 8; ++g) {
#pragma unroll
        for (int r = 0; r < 16; ++r) { sc[g][r] = __builtin_amdgcn_exp2f(sc[g][r] - m); l += sc[g][r]; }
        pf[2 * g] = pack8(sc[g], 0); pf[2 * g + 1] = pack8(sc[g], 8); }
    const float il = 1.f / swapadd(l);
    { u32x4 st[16];
#pragma unroll
      for (int i = 0; i < 16; ++i) { const int c = tid + 512 * i; const int sub = c & 3, key = (c >> 2) & 255, dt = c >> 10; st[i] = __builtin_amdgcn_raw_buffer_load_b128(rV, (key * P.vp + dt * 32 + sub * 8) * 2, 0, 0); }
      TILE_BAR();
#pragma unroll
      for (int i = 0; i < 16; ++i) { const int c = tid + 512 * i; const int sub = c & 3, key = (c >> 2) & 255, dt = c >> 10; *(LAS u32x4*)(lds + dt * 16384 + (key >> 3) * 512 + (key & 7) * 64 + sub * 16) = st[i]; } }
    __syncthreads();
    const LAS unsigned char* vb_ = lds + ((lane >> 4) & 1) * 32 + (lane & 3) * 8 + (4 * hi + ((lane & 15) >> 2)) * 64;
    GAS bf16* orow = P.O + (rowb + qi) * P.op + h * 256;
#pragma unroll 1
    for (int dh = 0; dh < 2; ++dh) {
        f32x16 oA[4];
#pragma unroll
        for (int d = 0; d < 4; ++d)
#pragma unroll
            for (int r = 0; r < 16; ++r) oA[d][r] = 0.f;
#pragma unroll
        for (int d = 0; d < 4; ++d) {
#pragma unroll
            for (int sb = 0; sb < 2; ++sb) { bf16x8 vf[8];
#pragma unroll
                for (int s = 0; s < 8; ++s) { const s16x4 lo = vtr(vb_ + (4 * dh + d) * 16384 + (8 * sb + s) * 1024), hh = vtr(vb_ + (4 * dh + d) * 16384 + (8 * sb + s) * 1024 + 512); vf[s] = (bf16x8){lo[0], lo[1], lo[2], lo[3], hh[0], hh[1], hh[2], hh[3]}; }
#pragma unroll
                for (int s = 0; s < 8; ++s) oA[d] = __builtin_amdgcn_mfma_f32_32x32x16_bf16(vf[s], pf[8 * sb + s], oA[d], 0, 0, 0); } }
#pragma unroll
        for (int d = 0; d < 4; ++d)
#pragma unroll
            for (int g = 0; g < 4; ++g) { v2u v; v.x = cvtpk(oA[d][4 * g] * il, oA[d][4 * g + 1] * il); v.y = cvtpk(oA[d][4 * g + 2] * il, oA[d][4 * g + 3] * il); *(GAS v2u*)(orow + 128 * dh + 32 * d + 8 * g + 4 * hi) = v; }
    }
}
__device__ __forceinline__ void cross_phase(const AttnP& PC, LAS unsigned char* lds, int tid, int wave, int lane, int vcu, int G) {
#pragma unroll 1
    for (int i = vcu; i < 512; i += G) { const int bh = i >> 5; cross_unit2(PC, bh >> 2, bh & 3, i & 31, lds, wave); }
}


__device__ __forceinline__ float vmax2(float a, float b) { float r; asm("v_max_f32_e32 %0, %1, %2" : "=v"(r) : "v"(a), "v"(b)); return r; }
__device__ __forceinline__ float vmin2(float a, float b) { float r; asm("v_min_f32_e32 %0, %1, %2" : "=v"(r) : "v"(a), "v"(b)); return r; }
__device__ __forceinline__ void pad16(float (&a)[16]) {
    asm volatile("s_nop 1" : "+v"(a[0]), "+v"(a[1]), "+v"(a[2]), "+v"(a[3]), "+v"(a[4]), "+v"(a[5]), "+v"(a[6]), "+v"(a[7]), "+v"(a[8]), "+v"(a[9]), "+v"(a[10]), "+v"(a[11]), "+v"(a[12]), "+v"(a[13]), "+v"(a[14]), "+v"(a[15]));
}
__device__ __forceinline__ void sort16_desc(float (&a)[16]) {
#pragma unroll
    for (int k = 2; k <= 16; k <<= 1)
#pragma unroll
        for (int j = k >> 1; j > 0; j >>= 1)
#pragma unroll
            for (int i = 0; i < 16; ++i) { const int l = i ^ j; if (l > i) { const bool desc = ((i & k) == 0); const float hi_ = vmax2(a[i], a[l]), lo_ = vmin2(a[i], a[l]); a[i] = desc ? hi_ : lo_; a[l] = desc ? lo_ : hi_; } }
}
__device__ __forceinline__ void merge16_desc(float (&a)[16], const float (&b)[16]) {
#pragma unroll
    for (int i = 0; i < 16; ++i) a[i] = vmax2(a[i], b[15 - i]);
#pragma unroll
    for (int j = 8; j > 0; j >>= 1)
#pragma unroll
        for (int i = 0; i < 16; ++i) { const int l = i ^ j; if (l > i) { const float hi_ = vmax2(a[i], a[l]), lo_ = vmin2(a[i], a[l]); a[i] = hi_; a[l] = lo_; } }
}
__device__ __forceinline__ void top16_of_64(float (&g0)[16], float (&g1)[16], float (&g2)[16], float (&g3)[16]) {
    sort16_desc(g0); sort16_desc(g1); merge16_desc(g0, g1); sort16_desc(g2); sort16_desc(g3); merge16_desc(g2, g3); merge16_desc(g0, g2);
}
__device__ __forceinline__ float embed(float v, unsigned mask, unsigned id) { return __builtin_bit_cast(float, (__builtin_bit_cast(unsigned, v) & mask) | id); }
__device__ __forceinline__ float mkcand(float x, float y, unsigned id) { return embed(x + y, 0xFFFFFF00u, id); }

__device__ __forceinline__ void swap32(float& a, float& b) { asm volatile("v_nop\n\tv_nop\n\tv_permlane32_swap_b32 %0, %1" : "+v"(a), "+v"(b)); }
struct RouteP { const GAS bf16* QP; const GAS bf16* keys; GAS int* EX; GAS float* GW; };
constexpr int RT_KP = 144, RT_KEYS = 0, RT_SCR = 256 * RT_KP, RT_END = RT_SCR + 8 * 8192;
__device__ __forceinline__ void route_phase(const RouteP& P, LAS unsigned char* lds, int tid, int wave, int lane, int vcu, int G) {
    asm volatile("" : "+v"(tid), "+v"(lane));
    __syncthreads();
    for (int c = tid; c < 256 * 8; c += 512) { const int row = c >> 3, part = c & 7; *(LAS u32x4*)(lds + RT_KEYS + row * RT_KP + part * 16) = *(const u32x4*)(P.keys + row * 64 + part * 8); }
    __syncthreads();
    const int r32 = lane & 31, hi = lane >> 5;
    LAS int* scr = (LAS int*)(lds + RT_SCR + wave * 8192);
    for (int u = vcu; u < T / 32; u += G) {
        const size_t t = (size_t)u * 32 + r32; const int h = wave;
        float T2[2][16];
#pragma unroll
        for (int c = 0; c < 2; ++c) {
            bf16x8 qf[4];
            { const GAS bf16* q = P.QP + t * 1024 + h * 128 + c * 64 + 8 * hi;
#pragma unroll
              for (int s = 0; s < 4; ++s) qf[s] = *(const GAS bf16x8*)(q + 16 * s); }
            f32x16 sc[4];
#pragma unroll
            for (int m = 0; m < 4; ++m) {
#pragma unroll
                for (int r = 0; r < 16; ++r) sc[m][r] = 0.f;
#pragma unroll
                for (int s = 0; s < 4; ++s) { const bf16x8 a = *(const LAS bf16x8*)(lds + RT_KEYS + (c * 128 + 32 * m + r32) * RT_KP + s * 32 + hi * 16);
                    sc[m] = __builtin_amdgcn_mfma_f32_32x32x16_bf16(a, qf[s], sc[m], 0, 0, 0); }
            }
            float g0[16], g1[16], g2[16], g3[16];
            const unsigned h4 = 4u * (unsigned)hi;
#pragma unroll
            for (int r = 0; r < 16; ++r) { const unsigned kr_ = (unsigned)((r & 3) + 8 * (r >> 2));
                g0[r] = embed(sc[0][r], 0xFFFFFF80u, kr_ | h4); g1[r] = embed(sc[1][r], 0xFFFFFF80u, (32u + kr_) | h4); g2[r] = embed(sc[2][r], 0xFFFFFF80u, (64u + kr_) | h4); g3[r] = embed(sc[3][r], 0xFFFFFF80u, (96u + kr_) | h4); }
            top16_of_64(g0, g1, g2, g3);
            pad16(g0);
#pragma unroll
            for (int i = 0; i < 16; ++i) T2[c][i] = g0[i];
        }
        float A[16], Bv[16];
#pragma unroll
        for (int i = 0; i < 16; ++i) { A[i] = T2[0][i]; Bv[i] = T2[1][i]; swap32(A[i], Bv[i]); }
        merge16_desc(A, Bv);
        pad16(A);
        float T0[16], T1[16];
#pragma unroll
        for (int i = 0; i < 16; ++i) { T0[i] = A[i]; T1[i] = A[i]; swap32(T0[i], T1[i]); }
#pragma unroll
        for (int i = 0; i < 16; ++i) { scr[i * 64 + lane] = (int)(__builtin_bit_cast(unsigned, T0[i]) & 127u); scr[(16 + i) * 64 + lane] = (int)(__builtin_bit_cast(unsigned, T1[i]) & 127u);
            T0[i] = embed(T0[i], 0xFFFFFF80u, 0u); T1[i] = embed(T1[i], 0xFFFFFF80u, 0u); }
        float c0[16], c1[16], c2[16], c3[16];
        const float NINF = -__builtin_inff();
#pragma unroll
        for (int b = 0; b < 16; ++b) c0[b] = mkcand(T0[0], T1[b], (unsigned)b);
#pragma unroll
        for (int b = 0; b < 8; ++b) c1[b] = mkcand(T0[1], T1[b], 16u + b);
#pragma unroll
        for (int b = 0; b < 5; ++b) c1[8 + b] = mkcand(T0[2], T1[b], 32u + b);
#pragma unroll
        for (int b = 0; b < 3; ++b) c1[13 + b] = mkcand(T0[4], T1[b], 64u + b);
#pragma unroll
        for (int b = 0; b < 4; ++b) c2[b] = mkcand(T0[3], T1[b], 48u + b);
        c2[4] = mkcand(T0[5], T1[0], 80u); c2[5] = mkcand(T0[5], T1[1], 81u); c2[6] = mkcand(T0[6], T1[0], 96u); c2[7] = mkcand(T0[6], T1[1], 97u); c2[8] = mkcand(T0[7], T1[0], 112u); c2[9] = mkcand(T0[7], T1[1], 113u);
#pragma unroll
        for (int a = 8; a < 14; ++a) c2[10 + a - 8] = mkcand(T0[a], T1[0], 16u * a);
        c3[0] = mkcand(T0[14], T1[0], 224u); c3[1] = mkcand(T0[15], T1[0], 240u);
#pragma unroll
        for (int i = 2; i < 16; ++i) c3[i] = NINF;
        top16_of_64(c0, c1, c2, c3);
        pad16(c0);
        float gsum = 0.f, ge[16]; int ex[16];
        const float mtop = embed(c0[0], 0xFFFFFF00u, 0u);
#pragma unroll
        for (int i = 0; i < 16; ++i) { const unsigned bits = __builtin_bit_cast(unsigned, c0[i]); const int a = (bits >> 4) & 15, b = bits & 15;
            ge[i] = __builtin_amdgcn_exp2f((embed(c0[i], 0xFFFFFF00u, 0u) - mtop) * LOG2E); gsum += ge[i];
            ex[i] = scr[a * 64 + lane] * 128 + scr[(16 + b) * 64 + lane]; }
        const float ginv = __builtin_amdgcn_rcpf(gsum);
        if (hi == 0) { GAS unsigned short* d = (GAS unsigned short*)P.EX + t * 128 + h * 16;
#pragma unroll
            for (int i = 0; i < 16; ++i) d[i] = (unsigned short)ex[i]; }
        else { GAS f32x4* d = (GAS f32x4*)(P.GW + t * 128 + h * 16);
#pragma unroll
            for (int i = 0; i < 4; ++i) d[i] = (f32x4){ge[4 * i] * ginv, ge[4 * i + 1] * ginv, ge[4 * i + 2] * ginv, ge[4 * i + 3] * ginv}; }
    }
}

__device__ __forceinline__ int wave_allsum_i(int v) {
    v += __builtin_amdgcn_update_dpp(0, v, 0xB1, 0xF, 0xF, true);
    v += __builtin_amdgcn_update_dpp(0, v, 0x4E, 0xF, 0xF, true);
    v += __builtin_amdgcn_update_dpp(0, v, 0x141, 0xF, 0xF, true);
    v += __builtin_amdgcn_update_dpp(0, v, 0x140, 0xF, 0xF, true);
    { int a = v, b = v; asm volatile("v_nop\n\tv_nop\n\tv_permlane16_swap_b32 %0, %1" : "+v"(a), "+v"(b)); v = a + b; }
    { int a = v, b = v; asm volatile("v_nop\n\tv_nop\n\tv_permlane32_swap_b32 %0, %1" : "+v"(a), "+v"(b)); v = a + b; }
    return v;
}
__device__ __forceinline__ float wave_allsum(float v) {
    v += __builtin_bit_cast(float, __builtin_amdgcn_update_dpp(0, __builtin_bit_cast(int, v), 0xB1, 0xF, 0xF, true));
    v += __builtin_bit_cast(float, __builtin_amdgcn_update_dpp(0, __builtin_bit_cast(int, v), 0x4E, 0xF, 0xF, true));
    v += __builtin_bit_cast(float, __builtin_amdgcn_update_dpp(0, __builtin_bit_cast(int, v), 0x141, 0xF, 0xF, true));
    v += __builtin_bit_cast(float, __builtin_amdgcn_update_dpp(0, __builtin_bit_cast(int, v), 0x140, 0xF, 0xF, true));
    { float a = v, b = v; asm volatile("v_nop\n\tv_nop\n\tv_permlane16_swap_b32 %0, %1" : "+v"(a), "+v"(b)); v = a + b; }
    { float a = v, b = v; asm volatile("v_nop\n\tv_nop\n\tv_permlane32_swap_b32 %0, %1" : "+v"(a), "+v"(b)); v = a + b; }
    return v;
}
__device__ __forceinline__ float wave_allmax(float v) {
    v = fmaxf(v, __builtin_bit_cast(float, __builtin_amdgcn_update_dpp(0, __builtin_bit_cast(int, v), 0xB1, 0xF, 0xF, true)));
    v = fmaxf(v, __builtin_bit_cast(float, __builtin_amdgcn_update_dpp(0, __builtin_bit_cast(int, v), 0x4E, 0xF, 0xF, true)));
    v = fmaxf(v, __builtin_bit_cast(float, __builtin_amdgcn_update_dpp(0, __builtin_bit_cast(int, v), 0x141, 0xF, 0xF, true)));
    v = fmaxf(v, __builtin_bit_cast(float, __builtin_amdgcn_update_dpp(0, __builtin_bit_cast(int, v), 0x140, 0xF, 0xF, true)));
    { float a = v, b = v; asm volatile("v_nop\n\tv_nop\n\tv_permlane16_swap_b32 %0, %1" : "+v"(a), "+v"(b)); v = fmaxf(a, b); }
    { float a = v, b = v; asm volatile("v_nop\n\tv_nop\n\tv_permlane32_swap_b32 %0, %1" : "+v"(a), "+v"(b)); v = fmaxf(a, b); }
    return v;
}
__device__ __forceinline__ unsigned q4(float a, float b, float c, float d, int off) {
    const int ia = (int)__builtin_rintf(a) + off, ib = (int)__builtin_rintf(b) + off, ic = (int)__builtin_rintf(c) + off, id = (int)__builtin_rintf(d) + off;
    return (unsigned)(ia & 255) | ((unsigned)(ib & 255) << 8) | ((unsigned)(ic & 255) << 16) | ((unsigned)(id & 255) << 24);
}
__device__ __forceinline__ void quant_row(const GAS float* src, GAS unsigned* dst, GAS float* scale, int off, int lane) {
    const GAS f32x4* s = (const GAS f32x4*)src + 4 * lane; f32x4 v[4]; float m = 0.f;
#pragma unroll
    for (int i = 0; i < 4; ++i) { v[i] = s[i]; m = fmaxf(m, fmaxf(fmaxf(__builtin_fabsf(v[i].x), __builtin_fabsf(v[i].y)), fmaxf(__builtin_fabsf(v[i].z), __builtin_fabsf(v[i].w)))); }
    m = wave_allmax(m); const float inv = m > 0.f ? 127.f / m : 0.f;
    v4u w;
    w.x = q4(v[0].x * inv, v[0].y * inv, v[0].z * inv, v[0].w * inv, off); w.y = q4(v[1].x * inv, v[1].y * inv, v[1].z * inv, v[1].w * inv, off);
    w.z = q4(v[2].x * inv, v[2].y * inv, v[2].z * inv, v[2].w * inv, off); w.w = q4(v[3].x * inv, v[3].y * inv, v[3].z * inv, v[3].w * inv, off);
    *((GAS v4u*)dst + lane) = w;
    if (lane == 0) *scale = m * (1.f / 127.f);
}
struct PeerS { int nslices_step, first_slice, nloc, rank; };
__device__ __forceinline__ PeerS peer_sched(const GAS unsigned* rankw, int xcc, int rank) {
    const int lane = lane_id_v();
    const int c = lane < 16 ? (int)__hip_atomic_load(rankw + 64 * lane, __ATOMIC_RELAXED, __HIP_MEMORY_SCOPE_AGENT) : 0;
    const unsigned long long m = __builtin_amdgcn_ballot_w64(c > 0);
    const int nx = __builtin_popcountll(m), myidx = __builtin_popcountll(m & ((1ull << xcc) - 1ull));
    const int cm = __builtin_amdgcn_readlane(c, xcc);
    PeerS s; s.nslices_step = nx > 0 ? nx : 1; s.first_slice = myidx; s.nloc = cm > 0 ? cm : 1; s.rank = rank; return s;
}
struct Peer1P { const GAS unsigned GAS char* HQ; const GAS int* EX; const GAS unsigned GAS char* U8; GAS int* P; };
__device__ __forceinline__ void peer_k1(const Peer1P& Q, const PeerS& sc, int wave, int lane) {
    asm volatile("" : "+v"(lane));
    const int g = lane >> 3, j = lane & 7;
    const __amdgpu_buffer_rsrc_t rU = __builtin_amdgcn_make_buffer_rsrc((void*)Q.U8, 0, 0x7fffffff, 0x00020000);
    for (int s = sc.first_slice; s < 8; s += sc.nslices_step)
        for (int tile = sc.rank; tile < T / 64; tile += sc.nloc) {
            const int soff_ = __builtin_amdgcn_readfirstlane(128 * s);
            const size_t t0 = (size_t)tile * 64 + wave * 8;
            v4u hqn = *(const GAS v4u*)(Q.HQ + t0 * 1024 + 128 * s + 16 * j), exn[2];
#pragma unroll
            for (int i = 0; i < 2; ++i) exn[i] = *(const GAS v4u*)(Q.EX + t0 * 64 + 8 * g + 4 * i);
#pragma unroll 1
            for (int k = 0; k < 8; ++k) {
                const size_t t = t0 + k;
                const v4u hq = hqn; v4u ex[2];
#pragma unroll
                for (int i = 0; i < 2; ++i) ex[i] = exn[i];
                if (k + 1 < 8) {
                    hqn = *(const GAS v4u*)(Q.HQ + (t + 1) * 1024 + 128 * s + 16 * j);
#pragma unroll
                    for (int i = 0; i < 2; ++i) exn[i] = *(const GAS v4u*)(Q.EX + (t + 1) * 64 + 8 * g + 4 * i);
                }
                v4u uu[16];
#pragma unroll
                for (int i = 0; i < 16; ++i) { const unsigned ew = ((i >> 1) & 3) == 0 ? ex[i >> 3].x : ((i >> 1) & 3) == 1 ? ex[i >> 3].y : ((i >> 1) & 3) == 2 ? ex[i >> 3].z : ex[i >> 3].w; unsigned e; if (i & 1) asm("v_lshrrev_b32 %0, 16, %1" : "=v"(e) : "v"(ew)); else asm("v_and_b32 %0, 0xffff, %1" : "=v"(e) : "v"(ew));
                    uu[i] = __builtin_bit_cast(v4u, __builtin_amdgcn_raw_buffer_load_b128(rU, (int)((e << 10) + 16u * (unsigned)j), soff_, 0)); }
                int lo = 0, hi = 0;
#pragma unroll
                for (int i = 0; i < 16; ++i) {
                    int p = __builtin_amdgcn_sdot4((int)uu[i].x, (int)hq.x, 0, false); p = __builtin_amdgcn_sdot4((int)uu[i].y, (int)hq.y, p, false); p = __builtin_amdgcn_sdot4((int)uu[i].z, (int)hq.z, p, false); p = __builtin_amdgcn_sdot4((int)uu[i].w, (int)hq.w, p, false);
                    p += __builtin_amdgcn_update_dpp(0, p, 0xB1, 0xF, 0xF, true); p += __builtin_amdgcn_update_dpp(0, p, 0x4E, 0xF, 0xF, true); p += __builtin_amdgcn_update_dpp(0, p, 0x141, 0xF, 0xF, true);
                    if (i < 8) lo = (j == i) ? p : lo; else hi = (j == i - 8) ? p : hi;
                }
                Q.P[(t * 8 + s) * 64 + 8 * g + j] = (int)__builtin_amdgcn_perm((unsigned)((hi + 32) >> 6), (unsigned)((lo + 32) >> 6), 0x05040100u);
            }
        }
}
__device__ __forceinline__ void peer_w(const GAS int* EX, const GAS float* GW, const GAS int* P, const GAS float* SH, const GAS float* SU, const GAS float* SV, GAS signed char* WQ, GAS float* WSC, int gw, int NGW, int lane,
                                       LAS unsigned char* lds, int tid) {
    asm volatile("" : "+v"(lane), "+v"(tid));
    LAS float* su_l = (LAS float*)lds; LAS float* sv_l = su_l + 16384;
#pragma unroll 4
    for (int i = tid; i < 4096; i += 512) { ((LAS f32x4*)su_l)[i] = ((const GAS f32x4*)SU)[i]; ((LAS f32x4*)sv_l)[i] = ((const GAS f32x4*)SV)[i]; }
    __syncthreads();
    for (int t = gw; t < T; t += NGW) {
        const float sh = SH[t];
#pragma unroll
        for (int q = 0; q < 2; ++q) { const size_t idx = (size_t)t * 128 + lane + 64 * q; const int e = (int)((const GAS unsigned short*)EX)[idx];
            const int slot_ = lane + 64 * q, pix_ = (slot_ >> 4) * 8 + (slot_ & 7), hsel_ = (slot_ >> 3) & 1;
            int pd = 0;
#pragma unroll
            for (int sl = 0; sl < 8; ++sl) { const int pw_ = P[((size_t)t * 8 + sl) * 64 + pix_]; pd += hsel_ ? (pw_ >> 16) : (int)(short)(pw_ & 0xffff); }
            const float w = GW[idx] * gelu_erf((float)pd * (64.f * sh * su_l[e])) * sv_l[e];
            float m = __builtin_fabsf(w);
            m = fmaxf(m, __builtin_bit_cast(float, __builtin_amdgcn_update_dpp(0, __builtin_bit_cast(int, m), 0xB1, 0xF, 0xF, true)));
            m = fmaxf(m, __builtin_bit_cast(float, __builtin_amdgcn_update_dpp(0, __builtin_bit_cast(int, m), 0x4E, 0xF, 0xF, true)));
            m = fmaxf(m, __builtin_bit_cast(float, __builtin_amdgcn_update_dpp(0, __builtin_bit_cast(int, m), 0x141, 0xF, 0xF, true)));
            m = fmaxf(m, __builtin_bit_cast(float, __builtin_amdgcn_update_dpp(0, __builtin_bit_cast(int, m), 0x140, 0xF, 0xF, true)));
            const float inv = m > 0.f ? 127.f / m : 0.f;
            const unsigned wb = (unsigned)((int)__builtin_rintf(w * inv)) & 255u;
            const unsigned b1 = (unsigned)__builtin_amdgcn_update_dpp(0, (int)wb, 0x55, 0xF, 0xF, true), b2 = (unsigned)__builtin_amdgcn_update_dpp(0, (int)wb, 0xAA, 0xF, 0xF, true), b3 = (unsigned)__builtin_amdgcn_update_dpp(0, (int)wb, 0xFF, 0xF, 0xF, true);
            if ((lane & 3) == 0) ((GAS unsigned*)WQ)[idx >> 2] = wb | (b1 << 8) | (b2 << 16) | (b3 << 24);
            if ((lane & 15) == 0) WSC[(size_t)t * 8 + (lane >> 4) + 4 * q] = m * (1.f / 127.f); }
    }
}
__device__ __forceinline__ void tr4x4(unsigned r0, unsigned r1, unsigned r2, unsigned r3, unsigned (&t)[4]) {
    const unsigned x0 = __builtin_amdgcn_perm(r1, r0, 0x05010400u), x1 = __builtin_amdgcn_perm(r1, r0, 0x07030602u), y0 = __builtin_amdgcn_perm(r3, r2, 0x05010400u), y1 = __builtin_amdgcn_perm(r3, r2, 0x07030602u);
    t[0] = __builtin_amdgcn_perm(y0, x0, 0x05040100u); t[1] = __builtin_amdgcn_perm(y0, x0, 0x07060302u); t[2] = __builtin_amdgcn_perm(y1, x1, 0x05040100u); t[3] = __builtin_amdgcn_perm(y1, x1, 0x07060302u);
}
struct Peer2P { const GAS int* EX; const GAS signed char* WQ; const GAS float* WSC; const GAS unsigned char* V8; GAS bf16* XB; GAS float* SSQ; };
__device__ __forceinline__ void peer_k2(const Peer2P& Q, const PeerS& sc, int wave, int lane) {
    asm volatile("" : "+v"(lane));
    const int g = lane >> 3, j = lane & 7, hf = lane >> 5, rp = (lane >> 4) & 1;
    const __amdgpu_buffer_rsrc_t rV = __builtin_amdgcn_make_buffer_rsrc((void*)Q.V8, 0, 0x7fffffff, 0x00020000);
    for (int s = sc.first_slice; s < 8; s += sc.nslices_step)
        for (int tile = sc.rank; tile < T / 64; tile += sc.nloc) {
            const int soff_ = __builtin_amdgcn_readfirstlane(128 * s);
            const size_t t0 = (size_t)tile * 64 + wave * 8;
            v4u exn[2], wqn; float swn;
#pragma unroll
            for (int i = 0; i < 2; ++i) exn[i] = *(const GAS v4u*)(Q.EX + t0 * 64 + 8 * g + 4 * i);
            wqn = *(const GAS v4u*)(Q.WQ + t0 * 128 + 16 * g); swn = Q.WSC[t0 * 8 + g];
#pragma unroll 1
            for (int k = 0; k < 8; ++k) {
                const size_t t = t0 + k;
                v4u ex[2]; const v4u wq = wqn; const float sw = swn;
#pragma unroll
                for (int i = 0; i < 2; ++i) ex[i] = exn[i];
                if (k + 1 < 8) {
#pragma unroll
                    for (int i = 0; i < 2; ++i) exn[i] = *(const GAS v4u*)(Q.EX + (t + 1) * 64 + 8 * g + 4 * i);
                    wqn = *(const GAS v4u*)(Q.WQ + (t + 1) * 128 + 16 * g); swn = Q.WSC[(t + 1) * 8 + g];
                }
                GAS v2u* xp = (GAS v2u*)(Q.XB + t * 1024 + 128 * s + 16 * j + 8 * hf + 4 * rp);
                const v2u xold = *xp;
                v4u vv[16];
#pragma unroll
                for (int i = 0; i < 16; ++i) { const unsigned ew = ((i >> 1) & 3) == 0 ? ex[i >> 3].x : ((i >> 1) & 3) == 1 ? ex[i >> 3].y : ((i >> 1) & 3) == 2 ? ex[i >> 3].z : ex[i >> 3].w; unsigned e; if (i & 1) asm("v_lshrrev_b32 %0, 16, %1" : "=v"(e) : "v"(ew)); else asm("v_and_b32 %0, 0xffff, %1" : "=v"(e) : "v"(ew));
                    vv[i] = __builtin_bit_cast(v4u, __builtin_amdgcn_raw_buffer_load_b128(rV, (int)((e << 10) + 16u * (unsigned)j), soff_, 0)); }
                int ai[16];
#pragma unroll
                for (int i = 0; i < 16; ++i) ai[i] = 0;
#pragma unroll
                for (int q4_ = 0; q4_ < 4; ++q4_) {
                    const unsigned wq4 = q4_ == 0 ? wq.x : q4_ == 1 ? wq.y : q4_ == 2 ? wq.z : wq.w;
#pragma unroll
                    for (int c = 0; c < 4; ++c) { unsigned tt[4];
                        const v4u &a0 = vv[4 * q4_], &a1 = vv[4 * q4_ + 1], &a2 = vv[4 * q4_ + 2], &a3 = vv[4 * q4_ + 3];
                        tr4x4(c == 0 ? a0.x : c == 1 ? a0.y : c == 2 ? a0.z : a0.w, c == 0 ? a1.x : c == 1 ? a1.y : c == 2 ? a1.z : a1.w, c == 0 ? a2.x : c == 1 ? a2.y : c == 2 ? a2.z : a2.w, c == 0 ? a3.x : c == 1 ? a3.y : c == 2 ? a3.z : a3.w, tt);
#pragma unroll
                        for (int b = 0; b < 4; ++b) ai[4 * c + b] = __builtin_amdgcn_sdot4((int)tt[b], (int)wq4, ai[4 * c + b], false); }
                }
                float acc[16];
#pragma unroll
                for (int i = 0; i < 16; ++i) acc[i] = (float)ai[i] * sw;
                float r8[8], r4[4];
#pragma unroll
                for (int m = 0; m < 8; ++m) { float a = acc[m], b = acc[m + 8]; swap32(a, b); r8[m] = a + b; }
#pragma unroll
                for (int n = 0; n < 4; ++n) { float a = r8[n], b = r8[n + 4]; asm volatile("v_nop\n\tv_nop\n\tv_permlane16_swap_b32 %0, %1" : "+v"(a), "+v"(b)); r4[n] = a + b; }
#pragma unroll
                for (int n = 0; n < 4; ++n) r4[n] += __builtin_bit_cast(float, __builtin_amdgcn_update_dpp(0, __builtin_bit_cast(int, r4[n]), 0x128, 0xF, 0xF, true));
                v2u xw; xw.x = pk2(bflo(xold.x) + r4[0], bfhi(xold.x) + r4[1]); xw.y = pk2(bflo(xold.y) + r4[2], bfhi(xold.y) + r4[3]);
                float ss = 0.f;
                if ((lane & 8) == 0) { const float x0 = bflo(xw.x), x1 = bfhi(xw.x), x2 = bflo(xw.y), x3 = bfhi(xw.y); ss = (x0 * x0 + x1 * x1) + (x2 * x2 + x3 * x3); *xp = xw; }
                ss = wave_allsum(ss);
                if (Q.SSQ) { if (lane == 0) Q.SSQ[t * 16 + s] = ss; }
            }
        }
}

struct Args { const float* in[33]; float* out; unsigned char* ws; int ph_lo, ph_hi; };
struct Frame { LAS unsigned char* lds; volatile LAS unsigned* MISC; gu32* ctl; int tid, lane, wave, G, vcu, xcc, xrank; };

__device__ __forceinline__ void transpose_item(const float* W, int ldw, int nsrc0, bf16* WT, int ldt, int rdst0, LAS float* scr, int kb, int nb, int lane, float scale, const float* kgain) {
    const int k0 = 64 * kb, n0 = 32 * nb;
#pragma unroll 8
    for (int i = 0; i < 32; ++i) { const int kk = 2 * i + (lane >> 5); const float gsc = kgain ? kgain[k0 + kk] * scale : scale; scr[kk * 33 + (lane & 31)] = W[(size_t)(k0 + kk) * ldw + nsrc0 + n0 + (lane & 31)] * gsc; }
    LDS_WAIT(); asm volatile("" ::: "memory");
    const int c = lane & 7;
#pragma unroll
    for (int j = 0; j < 4; ++j) { const int n = (lane >> 3) + 8 * j; const LAS float* s = scr + (8 * c) * 33 + n;
        v4u o; o.x = pk2(s[0 * 33], s[1 * 33]); o.y = pk2(s[2 * 33], s[3 * 33]); o.z = pk2(s[4 * 33], s[5 * 33]); o.w = pk2(s[6 * 33], s[7 * 33]);
        *(GAS v4u*)(WT + (size_t)(rdst0 + n0 + n) * ldt + k0 + 8 * c) = o; }
    LDS_WAIT(); asm volatile("" ::: "memory");
}
__device__ __forceinline__ void zero_rect(bf16* base, int ld, int row0, int nrows, int col0, int ncols, int gtid, int gthreads) {
    const int vpr = ncols / 8;
    for (int i = gtid; i < nrows * vpr; i += gthreads) { const int r = i / vpr, c = i % vpr; *(GAS v4u*)(base + (size_t)(row0 + r) * ld + col0 + 8 * c) = (v4u){0u, 0u, 0u, 0u}; }
}

__device__ __forceinline__ void p0_prologue(Frame& F, const Args& a) {
    LAS float* scr = (LAS float*)(F.lds + RING_OFF + F.wave * 16384);
    const int gw = blockIdx.x * NWAVES + F.wave, NGW = F.G * NWAVES;
    const int gtid = blockIdx.x * (NWAVES * 64) + F.tid, gthreads = F.G * NWAVES * 64;
    unsigned char* ws = a.ws;
    x0_phase((const GAS float*)a.in[0], (GAS bf16*)(ws + WS_XNB), (GAS float*)(ws + WS_SSQ), gw, NGW, F.lane);
    constexpr int I_IN = 16 * (INW / 32), I_SQ = 16 * 32, I_CKV = 16 * 64, I_UQ = 3 * 12, I_UKV = 2 * 16, I_L = I_IN + 4 * I_SQ + I_CKV + I_UQ + I_UKV;
    for (int it = gw; it < L * I_L; it += NGW) {
        const int l = it / I_L; int r = it % I_L;
        if (r < I_IN) {
            const int kb = r / 67, nb = r % 67; int src, dst; float sc = 1.f;
            if (nb < 6) { src = 32 * nb; dst = src; } else if (nb < 11) { src = 32 * nb; dst = src + 64; } else { src = 32 * nb; dst = src + 160; if (nb >= 43 && nb < 51) sc = 0.17677669529663687f * LOG2E; }
            transpose_item(a.in[5] + (size_t)l * D * INW, INW, src, (bf16*)(ws + WS_WIN) + (size_t)l * INP * D, D, dst, scr, kb, 0, F.lane, sc, a.in[4] + l * D); continue; } r -= I_IN;
        if (r < I_SQ) { transpose_item(a.in[21] + (size_t)l * D * D, D, 0, (bf16*)(ws + WS_WOUT) + (size_t)l * D * D, D, 0, scr, r / 32, r % 32, F.lane, 1.f, nullptr); continue; } r -= I_SQ;
        if (r < I_SQ) { transpose_item(a.in[24] + (size_t)l * D * D, D, 0, (bf16*)(ws + WS_WCQ) + (size_t)l * D * D, D, 0, scr, r / 32, r % 32, F.lane, 0.0625f * LOG2E, a.in[22] + l * D); continue; } r -= I_SQ;
        if (r < I_SQ) { transpose_item(a.in[26] + (size_t)l * D * D, D, 0, (bf16*)(ws + WS_WCO) + (size_t)l * D * D, D, 0, scr, r / 32, r % 32, F.lane, 1.f, nullptr); continue; } r -= I_SQ;
        if (r < I_SQ) { transpose_item(a.in[28] + (size_t)l * D * D, D, 0, (bf16*)(ws + WS_WPQ) + (size_t)l * D * D, D, 0, scr, r / 32, r % 32, F.lane, 1.f, a.in[27] + l * D); continue; } r -= I_SQ;
        if (r < I_CKV) { transpose_item(a.in[25] + (size_t)l * D * 2 * D, 2 * D, 0, (bf16*)(ws + WS_WCKV) + (size_t)l * 2 * D * D, D, 0, scr, r / 64, r % 64, F.lane, 1.f, nullptr); continue; } r -= I_CKV;
        if (r < I_UQ) { transpose_item(a.in[7] + (size_t)l * 192 * 384, 384, 0, (bf16*)(ws + WS_WUQ) + (size_t)l * 512 * 256, 256, 0, scr, r / 12, r % 12, F.lane, 0.10206207261596575f * LOG2E, a.in[6] + l * 192); continue; } r -= I_UQ;
        transpose_item(a.in[9] + (size_t)l * 128 * 512, 512, 0, (bf16*)(ws + WS_WUKV) + (size_t)l * 512 * 256, 256, 0, scr, r / 16, r % 16, F.lane, 1.f, a.in[8] + l * 128);
    }
    for (int l = 0; l < L; ++l) {
        bf16* win = (bf16*)(ws + WS_WIN) + (size_t)l * INP * D; bf16* wuq = (bf16*)(ws + WS_WUQ) + (size_t)l * 512 * 256; bf16* wukv = (bf16*)(ws + WS_WUKV) + (size_t)l * 512 * 256;
        zero_rect(win, D, 192, 64, 0, D, gtid, gthreads); zero_rect(win, D, 416, 96, 0, D, gtid, gthreads);
        zero_rect(wuq, 256, 0, 384, 192, 64, gtid, gthreads); zero_rect(wuq, 256, 384, 128, 0, 256, gtid, gthreads);
        zero_rect(wukv, 256, 0, 512, 128, 128, gtid, gthreads);
    }
    { float* rope = (float*)(ws + WS_ROPE); const int* pos = (const int*)a.in[2];
      for (int i = gtid; i < T * 16; i += gthreads) { const int t = i >> 4, k = i & 15; const float inv = powf(10000.f, -(float)(2 * k) / 32.f); const float ang = (float)pos[t] * inv;
          rope[(size_t)t * 32 + k] = cosf(ang); rope[(size_t)t * 32 + 16 + k] = sinf(ang); } }
    { const GAS f32x4* ks = (const GAS f32x4*)a.in[29]; GAS v2u* kd = (GAS v2u*)(ws + WS_KEYS);
      for (int i = gtid; i < L * 2 * 128 * 64 / 4; i += gthreads) { const f32x4 v = ks[i]; v2u w; w.x = pk2(v.x, v.y); w.y = pk2(v.z, v.w); kd[i] = w; }
    }
    for (int r = gw; r < 2 * L * 16384; r += NGW) { const int tb = r / (L * 16384), rr = r % (L * 16384);
        quant_row((const GAS float*)a.in[30 + tb] + (size_t)rr * 1024, (GAS unsigned*)(ws + (tb ? WS_V8 : WS_U8) + (size_t)rr * 1024), (GAS float*)(ws + (tb ? WS_SV : WS_SU)) + rr, 0, F.lane); }
    { float* btab = (float*)(ws + WS_BTAB); float* lams = (float*)(ws + WS_LAMS); float* spt = (float*)(ws + WS_SP);
      for (int i = gtid; i < 4 * 129; i += gthreads) { const int h = i / 129, n = i % 129; int bu; if (n < 16) bu = n; else { const int lg = 16 + (int)(logf((float)n / 16.f) / logf(8.f) * 16.f); bu = lg < 31 ? lg : 31; }
          btab[i] = a.in[3][bu * 4 + h] * LOG2E; }
      for (int i = gtid; i < L; i += gthreads) { const float* dl = a.in[17] + i * 128; float s1 = 0.f, s2 = 0.f; for (int j = 0; j < 32; ++j) { s1 += dl[j] * dl[32 + j]; s2 += dl[64 + j] * dl[96 + j]; }
          const float li = 0.8f - 0.6f * expf(-0.3f * (float)i); lams[2 * i] = expf(s1) - expf(s2) + li; lams[2 * i + 1] = li; }
      for (int i = gtid; i < L * 512; i += gthreads) spt[i] = log1pf(expf(-a.in[16][i])); }
    { GAS bf16* wat = (GAS bf16*)(ws + WS_WAT);
      for (int i = gtid; i < L * 8 * 2 * 4096; i += gthreads) { const int in_ = i & 63, out_ = (i >> 6) & 63, gate = (i >> 12) & 1, lg = i >> 13;
          wat[i] = (bf16)f2bf_(a.in[gate ? 14 : 12][(size_t)lg * 4096 + in_ * 64 + out_]); } }
    for (int l = 0; l < L; ++l) norm_phase((const GAS float*)a.in[1], (const GAS float*)a.in[23] + l * D, (GAS bf16*)(ws + WS_MNB) + (size_t)l * NB * MEM * D, NB * MEM, gw, NGW, F.lane);
}

constexpr int NPL = 16, PH_FINAL = 2 + NPL * L;
__global__ void __launch_bounds__(NWAVES * 64, 2) fwd(Args args) {
    extern __shared__ __attribute__((aligned(16))) unsigned char lds[];
    Frame F;
    F.lds = (LAS unsigned char*)lds; F.MISC = (volatile LAS unsigned*)(F.lds + MISC_OFF);
    F.tid = threadIdx.x; F.lane = F.tid & 63; F.wave = __builtin_amdgcn_readfirstlane(F.tid >> 6); F.G = gridDim.x;
    F.vcu = (F.G % 8 == 0) ? ((int)blockIdx.x % 8) * (F.G / 8) + (int)blockIdx.x / 8 : (int)blockIdx.x;
    unsigned char* ws = args.ws;
    F.ctl = (gu32*)(opq(ws) + WS_CTL);
    for (int u = F.tid; u < (LDS_BYTES - LDSCTL_OFF) / 4; u += NWAVES * 64) ((LAS unsigned*)(F.lds + LDSCTL_OFF))[u] = 0u;
    __syncthreads();
    XcdBarrier bar = xcd_barrier_post((unsigned*)(F.ctl + CW_BAR), F.MISC + 8);
    F.xcc = (int)bar.x;
    if (F.tid == 0) F.MISC[12] = __hip_atomic_fetch_add((unsigned*)(F.ctl + CW_RANK) + 64 * bar.x, 1u, __ATOMIC_RELAXED, __HIP_MEMORY_SCOPE_AGENT);
    __syncthreads();
    F.xrank = __builtin_amdgcn_readfirstlane((int)F.MISC[12]);
    const int lo = args.ph_lo, hi = args.ph_hi;
    const int gw = blockIdx.x * NWAVES + F.wave, NGW = F.G * NWAVES;
#define IN(k) (lo <= (k) && (k) < hi)
#define LANE_ (lane_id_v())
#define TID_ ((opqi(F.wave) << 6) | LANE_)
#define SITE() const int G_ = opqi(F.G), wv_ = opqi(F.wave), vcu_ = opqi(F.vcu), gw_ = opqi(gw), NGW_ = opqi(NGW); (void)G_; (void)wv_; (void)vcu_; (void)gw_; (void)NGW_
#if MK_DUP == 99
#define SEAM(k) do { if (IN(k) && IN((k) + 1)) { xcd_barrier(bar, (F.wave == 0 && lane_id_v() == 0) ? 1 : 0); xcd_barrier(bar, (F.wave == 0 && lane_id_v() == 0) ? 1 : 0); } } while (0)
#else
#define SEAM(k) do { if (IN(k) && IN((k) + 1)) xcd_barrier(bar, (F.wave == 0 && lane_id_v() == 0) ? 1 : 0); } while (0)
#endif
#define GEMM_SITE(EPI, Aptr, lda_, Bptr, ldb_, M_, N_, K_, cperm, ...) do { \
        pg8::Gemm g{opq(Aptr), opq(Bptr), M_, N_, K_, lda_, ldb_}; pg8::StaticOrder So; So.init(M_, N_, opqi(F.G), opqi(cperm)); pg8::EPI E{__VA_ARGS__}; \
        pg8::gemm_phase<pg8::EPI, pg8::StaticOrder, true, true>(F.lds + RING_OFF, g, So, E, opqi(F.wave)); } while (0)
    if (IN(0)) { p0_prologue(F, args); }
    SEAM(0);
    if (IN(1)) {
#pragma unroll 1
        for (int l = 0; l < L; ++l)
            GEMM_SITE(EpiBf16, (const GAS bf16*)(opq(ws) + WS_MNB) + (size_t)l * NB * MEM * D, D, (const GAS bf16*)(opq(ws) + WS_WCKV) + (size_t)l * 2 * D * D, D, NB * MEM, 2 * D, D, (int)((blockIdx.x + 64 * l) % F.G),
                      opq((GAS bf16*)(opq(ws) + WS_KVCB) + (size_t)l * NB * MEM * 2 * D), 2 * D, 2 * D, (const GAS float*)nullptr, 0);
    }
    SEAM(1);
    for (int l = 0; l < L; ++l) {
        const int pb = 2 + NPL * l;
        const GAS bf16* XNB = (const GAS bf16*)(opq(ws) + WS_XNB); const GAS bf16* YB = (const GAS bf16*)(opq(ws) + WS_YB); GAS bf16* PROJB = (GAS bf16*)(opq(ws) + WS_PROJB);
        if (IN(pb + 1)) GEMM_SITE(EpiBf16, XNB, D, (const GAS bf16*)(opq(ws) + WS_WIN) + (size_t)l * INP * D, D, T, INP, D, (int)blockIdx.x, opq(PROJB), INP, INP, opq((const GAS float*)(opq(ws) + WS_SSQ)), 8);
#if MK_DUP == 1
        if (IN(pb + 1)) GEMM_SITE(EpiBf16, XNB, D, (const GAS bf16*)(opq(ws) + WS_WIN) + (size_t)l * INP * D, D, T, INP, D, (int)blockIdx.x, opq(PROJB), INP, INP, opq((const GAS float*)(opq(ws) + WS_SSQ)), 8);
#endif
        SEAM(pb + 1);
        if (IN(pb + 2)) {
            SITE();
            pre_phase(opq((const GAS bf16*)PROJB), opq((const GAS float*)(opq(ws) + WS_ROPE)), opq((GAS float*)(opq(ws) + WS_RS)), opq((GAS bf16*)(opq(ws) + WS_KMB)), gw_, NGW_, LANE_);
#if MK_DUP == 21
            pre_phase(opq((const GAS bf16*)PROJB), opq((const GAS float*)(opq(ws) + WS_ROPE)), opq((GAS float*)(opq(ws) + WS_RS)), opq((GAS bf16*)(opq(ws) + WS_KMB)), gw_, NGW_, LANE_);
#endif
            LruP LP{opq((const GAS bf16*)PROJB), (const GAS float*)args.in[opqi(10)] + l * 4 * 512, (const GAS float*)args.in[opqi(11)] + l * 512, opq((const GAS bf16*)(opq(ws) + WS_WAT)) + (size_t)l * 8 * 2 * 4096, (const GAS float*)args.in[opqi(13)] + l * 512, (const GAS float*)args.in[opqi(15)] + l * 512,
                    (const GAS float*)(opq(ws) + WS_SP) + l * 512, opq((GAS unsigned*)(opq(ws) + WS_HLB)), opq((GAS float*)(opq(ws) + WS_LSUM))};
            lru_phase(LP, F.lds, TID_, wv_, LANE_, vcu_, G_);
#if MK_DUP == 2
            lru_phase(LP, F.lds, TID_, wv_, LANE_, vcu_, G_);
#endif
        }
        SEAM(pb + 2);
        if (IN(pb + 3)) {
            GEMM_SITE(EpiUp, (const GAS bf16*)PROJB + PC_CQ, INP, (const GAS bf16*)(opq(ws) + WS_WUQ) + (size_t)l * 512 * 256, 256, T, 512, 256, (int)blockIdx.x,
                      opq((GAS bf16*)(opq(ws) + WS_QMB)), (GAS bf16*)nullptr, 384, 384, opq((const GAS float*)(opq(ws) + WS_RS)), 0, 0);
            GEMM_SITE(EpiUp, (const GAS bf16*)PROJB + PC_CKV, INP, (const GAS bf16*)(opq(ws) + WS_WUKV) + (size_t)l * 512 * 256, 256, T, 512, 256, (int)blockIdx.x,
                      opq((GAS bf16*)(opq(ws) + WS_KMB)), opq((GAS bf16*)(opq(ws) + WS_VMB)), 0, 512, opq((const GAS float*)(opq(ws) + WS_RS)), 1, 1);
#if MK_DUP == 3
            GEMM_SITE(EpiUp, (const GAS bf16*)PROJB + PC_CQ, INP, (const GAS bf16*)(opq(ws) + WS_WUQ) + (size_t)l * 512 * 256, 256, T, 512, 256, (int)blockIdx.x,
                      opq((GAS bf16*)(opq(ws) + WS_QMB)), (GAS bf16*)nullptr, 384, 384, opq((const GAS float*)(opq(ws) + WS_RS)), 0, 0);
            GEMM_SITE(EpiUp, (const GAS bf16*)PROJB + PC_CKV, INP, (const GAS bf16*)(opq(ws) + WS_WUKV) + (size_t)l * 512 * 256, 256, T, 512, 256, (int)blockIdx.x,
                      opq((GAS bf16*)(opq(ws) + WS_KMB)), opq((GAS bf16*)(opq(ws) + WS_VMB)), 0, 512, opq((const GAS float*)(opq(ws) + WS_RS)), 1, 1);
#endif
        }
        SEAM(pb + 3);
        if (IN(pb + 4)) {
            SITE();
            AttnP PM{opq((const GAS bf16*)(opq(ws) + WS_QMB)), opq((const GAS bf16*)(opq(ws) + WS_KMB)), opq((const GAS bf16*)(opq(ws) + WS_VMB)), 384, 384, 256, opq((GAS bf16*)(opq(ws) + WS_OMB)), 256, opq((const GAS float*)(opq(ws) + WS_ROPE)), nullptr, nullptr, nullptr, nullptr};
            AttnP PD{opq((const GAS bf16*)PROJB + PC_QD), opq((const GAS bf16*)PROJB + PC_KD), opq((const GAS bf16*)PROJB + PC_VD), INP, INP, INP, opq((GAS bf16*)(opq(ws) + WS_YB) + 768), 1024, nullptr,
                     (const GAS int*)args.in[opqi(2)], (const GAS float*)(opq(ws) + WS_BTAB), (const GAS float*)args.in[opqi(18)] + l * 64, (const GAS float*)(opq(ws) + WS_LAMS) + 2 * l};
            attn_phase(PM, PD, F.lds, TID_, wv_, LANE_, vcu_, G_);
#if MK_DUP == 4
            __syncthreads(); attn_phase(PM, PD, F.lds, TID_, wv_, LANE_, vcu_, G_);
#elif MK_DUP == 40 || MK_DUP == 41
            __syncthreads(); attn_phase(PM, PD, F.lds, TID_, wv_, LANE_, vcu_, G_, MK_DUP - 40);
#endif
        }
        SEAM(pb + 4);
        if (IN(pb + 5)) {
            SITE();
            PostP PP{opq((const GAS bf16*)(opq(ws) + WS_OMB)), opq((const GAS unsigned*)(opq(ws) + WS_HLB)), opq((const GAS float*)(opq(ws) + WS_LSUM)), opq((const GAS bf16*)PROJB), (const GAS float*)args.in[opqi(19)] + l * 256, (const GAS float*)args.in[opqi(20)] + l * 512, opq((GAS bf16*)(opq(ws) + WS_YB))};
            post_phase(PP, F.lds, TID_, wv_, LANE_, vcu_, G_);
#if MK_DUP == 5
            __syncthreads(); post_phase(PP, F.lds, TID_, wv_, LANE_, vcu_, G_);
#endif
        }
        SEAM(pb + 5);
        if (IN(pb + 6)) GEMM_SITE(EpiRes, YB, D, (const GAS bf16*)(opq(ws) + WS_WOUT) + (size_t)l * D * D, D, T, D, D, (int)blockIdx.x, opq((GAS bf16*)(opq(ws) + WS_XNB)), opq((GAS float*)(opq(ws) + WS_SSQ)));
#if MK_DUP == 6
        if (IN(pb + 6)) GEMM_SITE(EpiRes, YB, D, (const GAS bf16*)(opq(ws) + WS_WOUT) + (size_t)l * D * D, D, T, D, D, (int)blockIdx.x, opq((GAS bf16*)(opq(ws) + WS_HLB)), opq((GAS float*)(opq(ws) + WS_OMB)));
#endif
        SEAM(pb + 6);
        if (IN(pb + 8)) GEMM_SITE(EpiBf16, XNB, D, (const GAS bf16*)(opq(ws) + WS_WCQ) + (size_t)l * D * D, D, T, D, D, (int)blockIdx.x, opq(PROJB), D, D, opq((const GAS float*)(opq(ws) + WS_SSQ)), 16);
#if MK_DUP == 8
        if (IN(pb + 8)) GEMM_SITE(EpiBf16, XNB, D, (const GAS bf16*)(opq(ws) + WS_WCQ) + (size_t)l * D * D, D, T, D, D, (int)blockIdx.x, opq(PROJB), D, D, opq((const GAS float*)(opq(ws) + WS_SSQ)), 16);
#endif
        SEAM(pb + 8);
        if (IN(pb + 9)) {
            SITE();
            const GAS bf16* kv = (const GAS bf16*)(opq(ws) + WS_KVCB) + (size_t)l * NB * MEM * 2 * D;
            AttnP PC{opq((const GAS bf16*)PROJB), opq(kv), opq(kv + D), 1024, 2 * D, 2 * D, opq((GAS bf16*)(opq(ws) + WS_YB)), 1024, nullptr, nullptr, nullptr, nullptr, nullptr};
            cross_phase(PC, F.lds, TID_, wv_, LANE_, vcu_, G_);
#if MK_DUP == 9
            cross_phase(PC, F.lds, TID_, wv_, LANE_, vcu_, G_);
#endif
        }
        SEAM(pb + 9);
        if (IN(pb + 10)) GEMM_SITE(EpiRes, YB, D, (const GAS bf16*)(opq(ws) + WS_WCO) + (size_t)l * D * D, D, T, D, D, (int)blockIdx.x, opq((GAS bf16*)(opq(ws) + WS_XNB)), opq((GAS float*)(opq(ws) + WS_SSQ)));
        SEAM(pb + 10);
        if (IN(pb + 12)) { GEMM_SITE(EpiBf16, XNB, D, (const GAS bf16*)(opq(ws) + WS_WPQ) + (size_t)l * D * D, D, T, D, D, (int)blockIdx.x, opq(PROJB), D, D, opq((const GAS float*)(opq(ws) + WS_SSQ)), 16);
#if MK_DUP == 12
            hq_phase(opq(XNB), opq((const GAS float*)(opq(ws) + WS_SSQ)), (const GAS float*)args.in[opqi(27)] + l * D, opq((GAS unsigned char*)(opq(ws) + WS_HQ)), opq((GAS float*)(opq(ws) + WS_SH)), opq((GAS int*)(opq(ws) + WS_P)), gw_, NGW_, LANE_);
#endif
            }
        SEAM(pb + 12);
        if (IN(pb + 13)) {
            SITE();
            RouteP RP{opq((const GAS bf16*)PROJB), opq((const GAS bf16*)(opq(ws) + WS_KEYS) + (size_t)l * 2 * 128 * 64), opq((GAS int*)(opq(ws) + WS_EX)), opq((GAS float*)(opq(ws) + WS_GW))};
            route_phase(RP, F.lds, TID_, wv_, LANE_, vcu_, G_);
            hq_phase(opq(XNB), opq((const GAS float*)(opq(ws) + WS_SSQ)), (const GAS float*)args.in[opqi(27)] + l * D, opq((GAS unsigned char*)(opq(ws) + WS_HQ)), opq((GAS float*)(opq(ws) + WS_SH)), opq((GAS int*)(opq(ws) + WS_P)), gw_, NGW_, LANE_);
#if MK_DUP == 13
            route_phase(RP, F.lds, TID_, wv_, LANE_, vcu_, G_);
#endif
        }
        SEAM(pb + 13);
        if (IN(pb + 14)) {
            SITE();
            const PeerS ps = peer_sched((const GAS unsigned*)(F.ctl + CW_RANK), opqi(F.xcc), opqi(F.xrank));
            Peer1P Q1{opq((const GAS unsigned char*)(opq(ws) + WS_HQ)), opq((const GAS int*)(opq(ws) + WS_EX)), opq((const GAS unsigned char*)(opq(ws) + WS_U8) + (size_t)l * 16384 * 1024), opq((GAS int*)(opq(ws) + WS_PROJB))};
            peer_k1(Q1, ps, wv_, LANE_);
#if MK_DUP == 141
            { Peer1P Q1b = Q1; Q1b.P = (GAS int*)(opq(ws) + WS_HLB); peer_k1(Q1b, ps, wv_, LANE_); }
#endif
        }
        SEAM(pb + 14);
        if (IN(pb + 15)) {
            SITE();
            peer_w(opq((const GAS int*)(opq(ws) + WS_EX)), opq((const GAS float*)(opq(ws) + WS_GW)), opq((const GAS int*)(opq(ws) + WS_PROJB)), opq((const GAS float*)(opq(ws) + WS_SH)), opq((const GAS float*)(opq(ws) + WS_SU) + l * 16384), opq((const GAS float*)(opq(ws) + WS_SV) + l * 16384),
                   opq((GAS signed char*)(opq(ws) + WS_W)), opq((GAS float*)(opq(ws) + WS_WS)), gw_, NGW_, LANE_, F.lds, TID_);
#if MK_DUP == 150
            peer_w(opq((const GAS int*)(opq(ws) + WS_EX)), opq((const GAS float*)(opq(ws) + WS_GW)), opq((const GAS int*)(opq(ws) + WS_PROJB)), opq((const GAS float*)(opq(ws) + WS_SH)), opq((const GAS float*)(opq(ws) + WS_SU) + l * 16384), opq((const GAS float*)(opq(ws) + WS_SV) + l * 16384),
                   opq((GAS signed char*)(opq(ws) + WS_W)), opq((GAS float*)(opq(ws) + WS_WS)), gw_, NGW_, LANE_, F.lds, TID_);
#endif
            xcd_barrier(bar, (F.wave == 0 && lane_id_v() == 0) ? 1 : 0);
            const PeerS ps = peer_sched((const GAS unsigned*)(F.ctl + CW_RANK), opqi(F.xcc), opqi(F.xrank));
            Peer2P Q2{opq((const GAS int*)(opq(ws) + WS_EX)), opq((const GAS signed char*)(opq(ws) + WS_W)), opq((const GAS float*)(opq(ws) + WS_WS)), opq((const GAS unsigned char*)(opq(ws) + WS_V8) + (size_t)l * 16384 * 1024), opq((GAS bf16*)(opq(ws) + WS_XNB)), opq((GAS float*)(opq(ws) + WS_SSQ))};
            peer_k2(Q2, ps, wv_, LANE_);
#if MK_DUP == 151
            { Peer2P Q2b = Q2; Q2b.XB = (GAS bf16*)(opq(ws) + WS_HLB); Q2b.SSQ = (GAS float*)(opq(ws) + WS_OMB); peer_k2(Q2b, ps, wv_, LANE_); }
#endif
        }
        SEAM(pb + 15);
    }
    if (IN(PH_FINAL)) { SITE(); final_norm_phase(opq((const GAS bf16*)(opq(ws) + WS_XNB)), (GAS float*)args.out, (const GAS float*)args.in[opqi(32)], T, gw_, NGW_, LANE_); }
#undef IN
#undef SEAM
#undef GEMM_SITE
}
}
extern "C" void kernel_launch(void* const* d_in, const int* in_sizes, int n_in, void* d_out, int out_size, void* d_ws, size_t ws_size, hipStream_t stream) {
    (void)in_sizes; (void)out_size;
    static int grid = 0;
    if (grid == 0) {
        int dev = 0, cus = 0, per_cu = 0;
        if (n_in != 33 || ws_size < mk::WS_END) { fprintf(stderr, "kernel_launch: unexpected n_in %d / ws_size %zu\n", n_in, ws_size); grid = -1; return; }
        if (hipGetDevice(&dev) != hipSuccess || hipDeviceGetAttribute(&cus, hipDeviceAttributeMultiprocessorCount, dev) != hipSuccess) { grid = -1; return; }
        if (hipFuncSetAttribute((const void*)mk::fwd, hipFuncAttributeMaxDynamicSharedMemorySize, mk::LDS_BYTES) != hipSuccess) { fprintf(stderr, "kernel_launch: hipFuncSetAttribute failed\n"); grid = -1; return; }
        if (hipOccupancyMaxActiveBlocksPerMultiprocessor(&per_cu, (const void*)mk::fwd, mk::NWAVES * 64, mk::LDS_BYTES) != hipSuccess || per_cu < 1) fprintf(stderr, "kernel_launch: occupancy query says %d\n", per_cu);
        (void)hipGetLastError();
        grid = cus;
    }
    if (grid < 0) return;
    unsigned char* ws = (unsigned char*)d_ws;
    (void)hipMemsetAsync(ws + mk::WS_CTL, 0, mk::CTL_ZERO_BYTES, stream);
    mk::Args a{};
    for (int i = 0; i < 33; ++i) a.in[i] = (const float*)d_in[i];
    a.out = (float*)d_out; a.ws = ws;
    auto run = [&](int lo, int hi) { a.ph_lo = lo; a.ph_hi = hi; hipLaunchKernelGGL(mk::fwd, dim3(grid), dim3(mk::NWAVES * 64), mk::LDS_BYTES, stream, a); };
#if MK_ONE_LAUNCH
    run(0, mk::PH_FINAL + 1);
#else
    for (int p = 0; p <= mk::PH_FINAL; ++p) {
        const int k = (p - 2) % mk::NPL, l = (p - 2) / mk::NPL;
#if MK_NAIVE_PEER == 2
        if (p >= 2 && p < mk::PH_FINAL && k == 14) {
            hipLaunchKernelGGL(k_peer, dim3(T), dim3(256), 0, stream, (const bf16_t*)(ws + mk::WS_XNB), (const int*)(ws + mk::WS_EX), (const float*)(ws + mk::WS_GW), (const float*)d_in[30] + (size_t)l * NEXP * D, (const float*)d_in[31] + (size_t)l * NEXP * D, (float*)d_out);
            continue; }
#elif MK_NAIVE_PEER == 1
        if (p >= 2 && p < mk::PH_FINAL && k == 13) {
            float* TQ = (float*)(ws + (size_t)806 * mk::MiB);
            hipLaunchKernelGGL(k_bf2f, dim3((unsigned)(((size_t)T * D + 255) / 256)), dim3(256), 0, stream, (const bf16_t*)(ws + mk::WS_PROJB), TQ, (long)T * D);
            hipLaunchKernelGGL(k_route, dim3(T), dim3(256), 0, stream, TQ, (const float*)d_in[29] + (size_t)l * 2 * 128 * 64, (int*)(ws + mk::WS_EX), (float*)(ws + mk::WS_GW));
            hipLaunchKernelGGL(k_peer, dim3(T), dim3(256), 0, stream, (const bf16_t*)(ws + mk::WS_XNB), (const int*)(ws + mk::WS_EX), (const float*)(ws + mk::WS_GW), (const float*)d_in[30] + (size_t)l * NEXP * D, (const float*)d_in[31] + (size_t)l * NEXP * D, (float*)d_out);
            continue; }
        if (p >= 2 && p < mk::PH_FINAL && k == 14) continue;
#endif
        run(p, p + 1); }
#endif
}
```

```cpp
#include <hip/hip_runtime.h>
#include <cstdint>
#include <cstdio>
#include <cmath>

#ifndef MK_ONE_LAUNCH
#define MK_ONE_LAUNCH 1
#endif
#ifndef MK_DUP
#define MK_DUP 0
#endif
#ifndef MK_NAIVE_PEER
#define MK_NAIVE_PEER 0
#endif
namespace pg8 {
#define PG8_LAS __attribute__((address_space(3)))
#ifndef GAS
#define GAS __attribute__((address_space(1)))
#endif
typedef unsigned short bf16_t;
typedef short bf16x8 __attribute__((ext_vector_type(8)));
typedef float f32x4 __attribute__((ext_vector_type(4)));
typedef unsigned u32x4 __attribute__((ext_vector_type(4)));
typedef unsigned u32x2 __attribute__((ext_vector_type(2)));
constexpr int BM = 256, BK = 64, HALF = 128, HTB = HALF * BK * 2, STAGE_BYTES = 8 * HTB, NXCD = 8, WGM = 8;
__host__ __device__ __forceinline__ int lds_byte(int r, int c) { const int st = (r >> 4) * 2 + (c >> 5), rr = r & 15, cc = c & 31, ob = rr * 64 + cc * 2; return st * 1024 + (ob ^ (((ob >> 9) & 1) << 5)); }
__host__ __device__ __forceinline__ void stage_rc(int b, int& R, int& C) { const int st = b / 1024, sb = b % 1024, swz = sb ^ (((sb >> 9) & 1) << 5); R = (st >> 1) * 16 + swz / 64; C = (st & 1) * 32 + (swz % 64) / 2; }
__host__ __device__ __forceinline__ int perm32(int rho) { const int n = rho >> 4, i = rho & 15; return 8 * (i >> 2) + 4 * n + (i & 3); }
__device__ __forceinline__ int pg8_lane_id() { int l; asm volatile("v_mbcnt_lo_u32_b32 %0, -1, 0\n\tv_mbcnt_hi_u32_b32 %0, -1, %0" : "=v"(l)); return l; }
struct Unit { int pm, pn; };
struct Gemm { const GAS bf16_t* A; const GAS bf16_t* Bt; int M, N, K, lda, ldb; };
struct StaticOrder {
    int nM, nN, nwg, G, c;
    __host__ __device__ void init(int M, int N, int G_, int c_) { nM = M / BM; nN = N / BM; nwg = nM * nN; G = G_; c = c_; }
    __host__ __device__ bool next(int i, Unit& u) const {
        const long L = (long)i * G + c; if (L >= nwg) return false;
        int wgid = (int)L; { const int q = nwg / NXCD, r = nwg % NXCD, xcd = wgid % NXCD, off = wgid / NXCD; wgid = (xcd < r ? xcd * (q + 1) : r * (q + 1) + (xcd - r) * q) + off; }
        const int nig = WGM * nN, gid = wgid / nig, fm = gid * WGM, gsz = (nM - fm) < WGM ? (nM - fm) : WGM;
        u.pm = fm + ((wgid % nig) % gsz); u.pn = (wgid % nig) / gsz; return true;
    }
    __device__ __forceinline__ void a_ready(const Unit&) const {}
    __device__ __forceinline__ void done(const Unit&) const {}
};
__device__ __forceinline__ unsigned cvt_pk_bf16(float lo, float hi) { unsigned r; asm volatile("v_cvt_pk_bf16_f32 %0, %1, %2" : "=v"(r) : "v"(lo), "v"(hi)); return r; }

struct EpiF32 {
    static constexpr bool PERM = false, AFTER_DRAIN = false;
    GAS float* C; int ldc; int nvalid; int accum;
    __device__ __forceinline__ void operator()(const f32x4 (&acc)[2][2][4][2], const Unit& u, int wr, int wc, int fr, int fq) const {
        { const int l_ = pg8_lane_id(); fr = l_ & 15; fq = l_ >> 4; }
#pragma unroll
        for (int ai = 0; ai < 2; ++ai)
#pragma unroll
            for (int m = 0; m < 4; ++m) { const size_t row = (size_t)u.pm * BM + ai * HALF + wr * 64 + m * 16 + fr;
#pragma unroll
                for (int bj = 0; bj < 2; ++bj)
#pragma unroll
                    for (int n = 0; n < 2; ++n) { const int col = u.pn * BM + bj * HALF + wc * 32 + n * 16 + 4 * fq;
                        if (col < nvalid) { GAS float* p = C + row * ldc + col; f32x4 v = acc[ai][bj][m][n]; if (accum) v += *(const GAS f32x4*)p; *(GAS f32x4*)p = v; } } }
    }
};
struct EpiBf16 {
    static constexpr bool PERM = true, AFTER_DRAIN = false;
    GAS bf16_t* O; int ldc; int nvalid; const GAS float* ssq; int np;
    __device__ __forceinline__ void operator()(const f32x4 (&acc)[2][2][4][2], const Unit& u, int wr, int wc, int fr, int fq) const {
        { const int l_ = pg8_lane_id(); fr = l_ & 15; fq = l_ >> 4; }
#pragma unroll
        for (int ai = 0; ai < 2; ++ai)
#pragma unroll
            for (int m = 0; m < 4; ++m) { const size_t row = (size_t)u.pm * BM + ai * HALF + wr * 64 + m * 16 + fr;
                float rs_ = 1.f;
                if (np > 0) { const GAS f32x4* sp = (const GAS f32x4*)(ssq + row * 16); f32x4 t = sp[0] + sp[1]; if (np > 8) t += sp[2] + sp[3]; rs_ = __builtin_amdgcn_rsqf(((t[0] + t[1]) + (t[2] + t[3])) * (1.f / 1024.f) + 1e-6f); }
#pragma unroll
                for (int bj = 0; bj < 2; ++bj) { const int col = u.pn * BM + bj * HALF + wc * 32 + 8 * fq;
                    if (col < nvalid) { const f32x4 v0 = acc[ai][bj][m][0] * rs_, v1 = acc[ai][bj][m][1] * rs_; u32x4 w; w.x = cvt_pk_bf16(v0[0], v0[1]); w.y = cvt_pk_bf16(v0[2], v0[3]); w.z = cvt_pk_bf16(v1[0], v1[1]); w.w = cvt_pk_bf16(v1[2], v1[3]);
                        *(GAS u32x4*)(O + row * ldc + col) = w; } } }
    }
};
struct EpiUp {
    static constexpr bool PERM = true, AFTER_DRAIN = false;
    GAS bf16_t* O; GAS bf16_t* O2; int ldc; int nvalid; const GAS float* rs; int rsi; int mode;
    __device__ __forceinline__ void operator()(const f32x4 (&acc)[2][2][4][2], const Unit& u, int wr, int wc, int fr, int fq) const {
        { const int l_ = pg8_lane_id(); fr = l_ & 15; fq = l_ >> 4; }
#pragma unroll
        for (int ai = 0; ai < 2; ++ai)
#pragma unroll
            for (int m = 0; m < 4; ++m) { const size_t row = (size_t)u.pm * BM + ai * HALF + wr * 64 + m * 16 + fr; const float s = rs[2 * row + rsi];
#pragma unroll
                for (int bj = 0; bj < 2; ++bj) { const int col = u.pn * BM + bj * HALF + wc * 32 + 8 * fq;
                    if (col < nvalid) { const f32x4 v0 = acc[ai][bj][m][0] * s, v1 = acc[ai][bj][m][1] * s; u32x4 w; w.x = cvt_pk_bf16(v0[0], v0[1]); w.y = cvt_pk_bf16(v0[2], v0[3]); w.z = cvt_pk_bf16(v1[0], v1[1]); w.w = cvt_pk_bf16(v1[2], v1[3]);
                        GAS bf16_t* dst;
                        if (mode == 0) dst = O + row * ldc + col;
                        else { const int h = col >> 7, j = col & 127; dst = (j < 64) ? O + row * 384 + h * 96 + j : O2 + row * 256 + h * 64 + (j - 64); }
                        *(GAS u32x4*)dst = w; } } }
    }
};

struct EpiRes {
    static constexpr bool PERM = true, AFTER_DRAIN = false;
    GAS bf16_t* XB; GAS float* SSQ;
    __device__ __forceinline__ void operator()(const f32x4 (&acc)[2][2][4][2], const Unit& u, int wr, int wc, int fr, int fq) const {
        { const int l_ = pg8_lane_id(); fr = l_ & 15; fq = l_ >> 4; }
#pragma unroll
        for (int ai = 0; ai < 2; ++ai)
#pragma unroll
            for (int m = 0; m < 4; ++m) { const size_t row = (size_t)u.pm * BM + ai * HALF + wr * 64 + m * 16 + fr; float ss = 0.f;
#pragma unroll
                for (int bj = 0; bj < 2; ++bj) { GAS u32x4* p = (GAS u32x4*)(XB + row * 1024 + u.pn * BM + bj * HALF + wc * 32 + 8 * fq);
                    const u32x4 o = *p; const f32x4 v0 = acc[ai][bj][m][0], v1 = acc[ai][bj][m][1];
                    u32x4 w;
                    w.x = cvt_pk_bf16(__builtin_bit_cast(float, o.x << 16) + v0[0], __builtin_bit_cast(float, o.x & 0xffff0000u) + v0[1]);
                    w.y = cvt_pk_bf16(__builtin_bit_cast(float, o.y << 16) + v0[2], __builtin_bit_cast(float, o.y & 0xffff0000u) + v0[3]);
                    w.z = cvt_pk_bf16(__builtin_bit_cast(float, o.z << 16) + v1[0], __builtin_bit_cast(float, o.z & 0xffff0000u) + v1[1]);
                    w.w = cvt_pk_bf16(__builtin_bit_cast(float, o.w << 16) + v1[2], __builtin_bit_cast(float, o.w & 0xffff0000u) + v1[3]);
                    *p = w;
#pragma unroll
                    for (int e = 0; e < 4; ++e) { const float a = __builtin_bit_cast(float, w[e] << 16), b = __builtin_bit_cast(float, w[e] & 0xffff0000u); ss += a * a + b * b; } }
                { float a = ss, b = ss; asm volatile("v_nop\n\tv_nop\n\tv_permlane16_swap_b32 %0, %1" : "+v"(a), "+v"(b)); ss = a + b; }
                { float a = ss, b = ss; asm volatile("v_nop\n\tv_nop\n\tv_permlane32_swap_b32 %0, %1" : "+v"(a), "+v"(b)); ss = a + b; }
                if (fq == 0) SSQ[row * 16 + 4 * u.pn + wc] = ss; }
    }
};
template <class Epi, class Sched, bool ALIGN_EPI = false, bool SP2 = false>
__device__ __forceinline__ void gemm_phase(PG8_LAS unsigned char* lds, const Gemm g, const Sched& S, const Epi& E, int wave_id) {
    int tid_ = (wave_id << 6) | pg8_lane_id(); asm volatile("" : "+v"(tid_));
    const int tid = tid_, wid = __builtin_amdgcn_readfirstlane(tid >> 6), lane = tid & 63, wr = wid >> 2, wc = wid & 3, fr = lane & 15, fq = lane >> 4;
    const int K = g.K, nt = K / BK;
    unsigned voffA[2], voffB[2];
#pragma unroll
    for (int i = 0; i < 2; ++i) { int R, C; stage_rc(tid * 16 + i * 8192, R, C); const int Rb = Epi::PERM ? ((R & ~31) + perm32(R & 31)) : R;
        voffA[i] = (unsigned)(R * g.lda + C) * 2u; voffB[i] = (unsigned)(Rb * g.ldb + C) * 2u; }
    const size_t kstep = (size_t)(BK * 2);
    const size_t hstepA = (size_t)HALF * g.lda * 2, hstepB = (size_t)HALF * g.ldb * 2;
    const size_t tstepA = 2 * hstepA, tstepB = 2 * hstepB;
    const unsigned ldsw = (unsigned)wid * 1024u;
    const int aoff = lds_byte(wr * 64 + fr, fq * 8), boff = lds_byte(wc * 32 + fr, fq * 8);
#define PG8_SA(b, h) (((b) * 2 + (h)) * HTB)
#define PG8_SB(b, h) ((4 + (b) * 2 + (h)) * HTB)
#define PG8_STAGE(bufoff, gbase, voff) do { _Pragma("unroll") for (int _i = 0; _i < 2; ++_i) \
        __builtin_amdgcn_global_load_lds((const unsigned*)((const char*)(gbase) + (voff)[_i]), (PG8_LAS unsigned*)(lds + (bufoff) + ldsw + _i * 8192), 16, 0, 0); } while (0)
#define PG8_LDA(dst, b, h) do { _Pragma("unroll") for (int m = 0; m < 4; ++m) _Pragma("unroll") for (int k = 0; k < 2; ++k) dst[m][k] = *(const PG8_LAS bf16x8*)(lds + PG8_SA(b, h) + aoff + m * 2048 + k * 1024); } while (0)
#define PG8_LDB(dst, b, h) do { _Pragma("unroll") for (int n = 0; n < 2; ++n) _Pragma("unroll") for (int k = 0; k < 2; ++k) dst[n][k] = *(const PG8_LAS bf16x8*)(lds + PG8_SB(b, h) + boff + n * 2048 + k * 1024); } while (0)
#define PG8_MMA(ai, bj, At, Bt) do { __builtin_amdgcn_s_setprio(1); _Pragma("unroll") for (int m = 0; m < 4; ++m) _Pragma("unroll") for (int n = 0; n < 2; ++n) _Pragma("unroll") for (int k = 0; k < 2; ++k) \
        acc[ai][bj][m][n] = __builtin_amdgcn_mfma_f32_16x16x32_bf16(Bt[n][k], At[m][k], acc[ai][bj][m][n], 0, 0, 0); __builtin_amdgcn_s_setprio(0); } while (0)
#define PG8_WAIT_V(n) asm volatile("s_waitcnt vmcnt(" #n ")" ::: "memory")
#define PG8_WAIT_L(n) asm volatile("s_waitcnt lgkmcnt(" #n ")" ::: "memory")
#define PG8_BAR __builtin_amdgcn_s_barrier()
#define PG8_SCHED __builtin_amdgcn_sched_barrier(0)
    Unit cur, nxt; int ui = 0;
    if (!S.next(0, cur)) return;
    f32x4 acc[2][2][4][2];
#pragma unroll
    for (int a = 0; a < 2; ++a)
#pragma unroll
        for (int b = 0; b < 2; ++b)
#pragma unroll
            for (int m = 0; m < 4; ++m)
#pragma unroll
                for (int n = 0; n < 2; ++n) acc[a][b][m][n] = (f32x4){0.f, 0.f, 0.f, 0.f};
    bf16x8 At[4][2], B0[2][2], B1[2][2];
    const char* cA = (const char*)g.A + (size_t)cur.pm * tstepA; const char* cB = (const char*)g.Bt + (size_t)cur.pn * tstepB;
    S.a_ready(cur);
    if constexpr (SP2) {
        PG8_STAGE(PG8_SB(0, 0), cB, voffB); PG8_STAGE(PG8_SB(0, 1), cB + hstepB, voffB); PG8_STAGE(PG8_SA(0, 0), cA, voffA); PG8_STAGE(PG8_SA(0, 1), cA + hstepA, voffA);
        if (wr == 1) PG8_BAR;
        PG8_WAIT_V(2); PG8_BAR;
        PG8_STAGE(PG8_SB(1, 0), cB + kstep, voffB); PG8_STAGE(PG8_SA(1, 0), cA + kstep, voffA); PG8_STAGE(PG8_SB(1, 1), cB + hstepB + kstep, voffB);
        PG8_WAIT_V(6); PG8_BAR;
    } else {
        PG8_STAGE(PG8_SB(0, 0), cB, voffB); PG8_STAGE(PG8_SA(0, 0), cA, voffA); PG8_STAGE(PG8_SB(0, 1), cB + hstepB, voffB); PG8_STAGE(PG8_SA(0, 1), cA + hstepA, voffA);
        if (wr == 1) PG8_BAR;
        PG8_WAIT_V(4); PG8_BAR;
        PG8_STAGE(PG8_SB(1, 0), cB + kstep, voffB); PG8_STAGE(PG8_SA(1, 0), cA + kstep, voffA); PG8_STAGE(PG8_SB(1, 1), cB + hstepB + kstep, voffB);
        PG8_WAIT_V(6); PG8_BAR;
    }
    for (;;) {
        const bool has_next = S.next(ui + 1, nxt);
        const char* nA = has_next ? (const char*)g.A + (size_t)nxt.pm * tstepA : cA; const char* nB = has_next ? (const char*)g.Bt + (size_t)nxt.pn * tstepB : cB;
        for (int t = 0; t < nt; t += 2) {
            const bool last = (t == nt - 2);
            const char* a1 = cA + (size_t)(t + 1) * kstep;
            const char* a2 = last ? nA : cA + (size_t)(t + 2) * kstep; const char* b2 = last ? nB : cB + (size_t)(t + 2) * kstep;
            const char* a3 = a2 + kstep; const char* b3 = b2 + kstep;
            if (last && has_next) S.a_ready(nxt);
            if constexpr (SP2) {
            PG8_LDB(B0, 0, 0); PG8_LDB(B1, 0, 1); PG8_SCHED; PG8_LDA(At, 0, 0); PG8_STAGE(PG8_SA(1, 1), a1 + hstepA, voffA);
            PG8_WAIT_V(8); PG8_WAIT_L(0); PG8_BAR; PG8_MMA(0, 0, At, B0); PG8_MMA(0, 1, At, B1); PG8_BAR; PG8_SCHED;
            PG8_LDA(At, 0, 1); PG8_STAGE(PG8_SB(0, 0), b2, voffB); PG8_STAGE(PG8_SB(0, 1), b2 + hstepB, voffB); PG8_STAGE(PG8_SA(0, 0), a2, voffA);
            PG8_WAIT_V(8); PG8_WAIT_L(0); PG8_BAR; PG8_MMA(1, 0, At, B0); PG8_MMA(1, 1, At, B1); PG8_BAR; PG8_SCHED;
            PG8_LDB(B0, 1, 0); PG8_LDB(B1, 1, 1); PG8_SCHED; PG8_LDA(At, 1, 0); PG8_STAGE(PG8_SA(0, 1), a2 + hstepA, voffA);
            PG8_WAIT_V(8); PG8_WAIT_L(0); PG8_BAR; PG8_MMA(0, 0, At, B0); PG8_MMA(0, 1, At, B1); PG8_BAR; PG8_SCHED;
            PG8_LDA(At, 1, 1); PG8_STAGE(PG8_SB(1, 0), b3, voffB); PG8_STAGE(PG8_SB(1, 1), b3 + hstepB, voffB); PG8_STAGE(PG8_SA(1, 0), a3, voffA);
            PG8_WAIT_V(8); PG8_WAIT_L(0); PG8_BAR; PG8_MMA(1, 0, At, B0); PG8_MMA(1, 1, At, B1); PG8_BAR; PG8_SCHED;
            } else {
            PG8_LDB(B0, 0, 0); PG8_SCHED; PG8_LDA(At, 0, 0); PG8_STAGE(PG8_SA(1, 1), a1 + hstepA, voffA);
            PG8_WAIT_L(8); PG8_BAR; PG8_WAIT_L(0); PG8_MMA(0, 0, At, B0); PG8_BAR; PG8_SCHED;
            PG8_LDB(B1, 0, 1); PG8_STAGE(PG8_SB(0, 0), b2, voffB);
            PG8_BAR; PG8_WAIT_L(0); PG8_MMA(0, 1, At, B1); PG8_BAR;
            PG8_LDA(At, 0, 1); PG8_STAGE(PG8_SA(0, 0), a2, voffA);
            PG8_BAR; PG8_WAIT_L(0); PG8_MMA(1, 0, At, B0); PG8_BAR; PG8_SCHED;
            PG8_STAGE(PG8_SB(0, 1), b2 + hstepB, voffB);
            PG8_WAIT_V(6); PG8_BAR; PG8_MMA(1, 1, At, B1); PG8_BAR;
            PG8_LDB(B0, 1, 0); PG8_SCHED; PG8_LDA(At, 1, 0); PG8_STAGE(PG8_SA(0, 1), a2 + hstepA, voffA);
            PG8_WAIT_L(8); PG8_BAR; PG8_WAIT_L(0); PG8_MMA(0, 0, At, B0); PG8_BAR; PG8_SCHED;
            PG8_LDB(B1, 1, 1); PG8_STAGE(PG8_SB(1, 0), b3, voffB);
            PG8_BAR; PG8_WAIT_L(0); PG8_MMA(0, 1, At, B1); PG8_BAR;
            PG8_LDA(At, 1, 1); PG8_STAGE(PG8_SA(1, 0), a3, voffA);
            PG8_BAR; PG8_WAIT_L(0); PG8_MMA(1, 0, At, B0); PG8_BAR; PG8_SCHED;
            PG8_STAGE(PG8_SB(1, 1), b3 + hstepB, voffB);
            PG8_WAIT_V(6); PG8_BAR; PG8_MMA(1, 1, At, B1); PG8_BAR;
            }
        }
        if constexpr (ALIGN_EPI) { if (wr == 0) PG8_BAR; }
        if constexpr (!Epi::AFTER_DRAIN) { E(acc, cur, wr, wc, fr, fq); S.done(cur); }
        if (!has_next) break;
#pragma unroll
        for (int a = 0; a < 2; ++a)
#pragma unroll
            for (int b = 0; b < 2; ++b)
#pragma unroll
                for (int m = 0; m < 4; ++m)
#pragma unroll
                    for (int n = 0; n < 2; ++n) acc[a][b][m][n] = (f32x4){0.f, 0.f, 0.f, 0.f};
        cur = nxt; cA = nA; cB = nB; ++ui;
        if constexpr (ALIGN_EPI) { if (wr == 1) PG8_BAR; }
    }
    PG8_WAIT_V(0);
    if constexpr (!ALIGN_EPI) { if (wr == 0) PG8_BAR; }
    PG8_BAR;
    if constexpr (Epi::AFTER_DRAIN) { E.fused(acc, cur, wr, wc, fr, fq, lds, wid, lane); S.done(cur); }
#undef PG8_SA
#undef PG8_SB
#undef PG8_STAGE
#undef PG8_LDA
#undef PG8_LDB
#undef PG8_MMA
#undef PG8_WAIT_V
#undef PG8_WAIT_L
#undef PG8_BAR
#undef PG8_SCHED
}
}

namespace mk {
#ifndef GAS
#define GAS __attribute__((address_space(1)))
#endif
#define LAS __attribute__((address_space(3)))
typedef unsigned short bf16;
typedef unsigned v4u __attribute__((ext_vector_type(4)));
typedef unsigned v2u __attribute__((ext_vector_type(2)));
typedef float f32x4 __attribute__((ext_vector_type(4)));
typedef GAS unsigned gu32;
#define LDS_WAIT() asm volatile("s_waitcnt lgkmcnt(0)" ::: "memory")
#define VM_WAIT() asm volatile("s_waitcnt vmcnt(0)" ::: "memory")
__device__ __forceinline__ unsigned f2bf_(float f) { unsigned u = __builtin_bit_cast(unsigned, f); return (u + 0x7fffu + ((u >> 16) & 1u)) >> 16; }
__device__ __forceinline__ unsigned pk2(float lo, float hi) { return f2bf_(lo) | (f2bf_(hi) << 16); }
__device__ __forceinline__ float bflo(unsigned w) { return __builtin_bit_cast(float, w << 16); }
__device__ __forceinline__ float bfhi(unsigned w) { return __builtin_bit_cast(float, w & 0xffff0000u); }

template <class P> __device__ __forceinline__ P* opq(P* p) { asm volatile("" : "+s"(p)); return p; }
__device__ __forceinline__ int opqi(int k) { asm volatile("" : "+s"(k)); return k; }
__device__ __forceinline__ float shx(float v, int o, int lane) { return __builtin_bit_cast(float, __builtin_amdgcn_ds_bpermute((lane ^ o) << 2, __builtin_bit_cast(int, v))); }
__device__ __forceinline__ int shxi(int v, int o, int lane) { return __builtin_amdgcn_ds_bpermute((lane ^ o) << 2, v); }
__device__ __forceinline__ int lane_id_v() { int l; asm volatile("v_mbcnt_lo_u32_b32 %0, -1, 0\n\tv_mbcnt_hi_u32_b32 %0, -1, %0" : "=v"(l)); return l; }
constexpr int NWAVES = 8;
constexpr int D = 1024, NB = 4, S = 8192, T = NB * S, L = 4, MEM = 256, INW = 2144, INP = 2304;
constexpr int PC_CQ = 0, PC_CKV = 256, PC_KR = 384, PC_XL = 512, PC_GL = 1024, PC_QD = 1536, PC_KD = 1792, PC_VD = 2048;
constexpr float LOG2E = 1.4426950408889634f;
constexpr size_t MiB = 1u << 20;
constexpr size_t WS_CTL = 0, CTL_ZERO_BYTES = 1 * MiB;
constexpr size_t WS_WIN = 1 * MiB, WS_WOUT = 19 * MiB, WS_WCQ = 27 * MiB, WS_WCO = 35 * MiB, WS_WPQ = 43 * MiB, WS_WCKV = 51 * MiB, WS_WUQ = 67 * MiB, WS_WUKV = 68 * MiB, WS_KEYS = 69 * MiB, WS_ROPE = 70 * MiB;
constexpr size_t WS_XNB = 76 * MiB, WS_YB = 140 * MiB, WS_PROJB = 204 * MiB, WS_QMB = 348 * MiB, WS_KMB = 372 * MiB, WS_VMB = 396 * MiB, WS_RS = 412 * MiB;
constexpr size_t WS_HLB = 413 * MiB, WS_ACB = 445 * MiB, WS_LSUM = 477 * MiB, WS_OMB = 478 * MiB, WS_MNB = 494 * MiB, WS_KVCB = 502 * MiB, WS_EX = 518 * MiB, WS_GW = 534 * MiB;
constexpr size_t WS_U8 = 550 * MiB, WS_V8 = 614 * MiB, WS_SU = 678 * MiB, WS_SV = 679 * MiB;
constexpr size_t WS_HQ = 680 * MiB, WS_P = 712 * MiB, WS_SH = 728 * MiB, WS_W = 729 * MiB, WS_WS = 745 * MiB, WS_SSQ = 746 * MiB, WS_END = 748 * MiB;
constexpr size_t WS_WAT = 74 * MiB;
constexpr size_t WS_BTAB = WS_KEYS + 512 * 1024, WS_LAMS = WS_BTAB + 4096, WS_SP = WS_LAMS + 4096;
constexpr int CW_BAR = 4096, CW_RANK = 8192;
constexpr int RING_OFF = 0, RING_BYTES = 155648, LDSCTL_OFF = RING_BYTES, MISC_OFF = LDSCTL_OFF + 320, LDS_BYTES = 163840;

#define XB_TMO      128
#define XB_XCNT(j)  (256  + 64 * (j))
#define XB_XSUB(j)  (1280 + 64 * (j))
#define XB_XGEN(j)  (2304 + 64 * (j))
#define XB_TOP      3328
#define XB_TOPGEN   3392
#define XCD_BAR_WORDS 3456
#define XB_SPIN_CAP (1u << 18)

__device__ __forceinline__ unsigned xb_ld(unsigned* p)              { return __hip_atomic_load(p, __ATOMIC_RELAXED, __HIP_MEMORY_SCOPE_AGENT); }
__device__ __forceinline__ unsigned xb_add(unsigned* p, unsigned v) { return __hip_atomic_fetch_add(p, v, __ATOMIC_RELAXED, __HIP_MEMORY_SCOPE_AGENT); }
__device__ __forceinline__ unsigned xb_xcc_id() { return (unsigned)__builtin_amdgcn_s_getreg((3 << 11) | 20) & 0xFu; }
#define XB_SPIN(cond, bar) do { unsigned _sp = 0; while (cond) { __builtin_amdgcn_s_sleep(1); \
    if ((++_sp & 255u) == 0u) { if (xb_ld(&(bar)[XB_TMO])) break; if (_sp > XB_SPIN_CAP) { atomicAdd(&(bar)[XB_TMO], 1u); break; } } } } while (0)

struct XcdBarrier {
    unsigned* bar; unsigned x;
    volatile LAS unsigned* st;
};

__device__ __forceinline__ XcdBarrier xcd_barrier_post(unsigned* bar, volatile LAS unsigned* st) {
    XcdBarrier b; b.bar = bar; b.x = xb_xcc_id(); b.st = st;
    if (threadIdx.x == 0) (void)xb_add(&bar[XB_XCNT(b.x)], 1u);
    return b;
}
__device__ __forceinline__ void xcd_barrier_complete(unsigned* bar, unsigned x, unsigned& nloc, unsigned& nx) {
    const unsigned G = gridDim.x * gridDim.y * gridDim.z;
    unsigned sum, cnt, mine, sp = 0u;
    for (;;) {
        sum = 0u; cnt = 0u; mine = 0u;
#pragma unroll
        for (unsigned j = 0; j < 16; ++j) { const unsigned c = xb_ld(&bar[XB_XCNT(j)]); sum += c; cnt += (c > 0u) ? 1u : 0u; mine = (j == x) ? c : mine; }
        if (sum == G) break;
        __builtin_amdgcn_s_sleep(1);
        if ((++sp & 255u) == 0u) { if (xb_ld(&bar[XB_TMO])) break; if (sp > XB_SPIN_CAP) { atomicAdd(&bar[XB_TMO], 1u); break; } }
    }
    nloc = mine > 0u ? mine : 1u; nx = cnt > 0u ? cnt : 1u;
}

__device__ __noinline__ void xcd_barrier_impl(unsigned* bar_, unsigned x_, volatile LAS unsigned* st_, int leader_) {
    XcdBarrier b; b.bar = bar_; b.x = x_; b.st = st_;
    asm volatile("s_waitcnt vmcnt(0)" ::: "memory");
    __syncthreads();
    if (leader_) {
        unsigned* bar = b.bar;
        __builtin_amdgcn_s_waitcnt(0);
        unsigned nloc = b.st[0], nx = b.st[1];
        if (nloc == 0u) { xcd_barrier_complete(bar, b.x, nloc, nx); b.st[0] = nloc; b.st[1] = nx; }
        const unsigned old = xb_add(&bar[XB_XSUB(b.x)], 1u);
        const unsigned gen = old / nloc;
        if (old + 1u == (gen + 1u) * nloc) {
            __builtin_amdgcn_fence(__ATOMIC_RELEASE, "agent");
            asm volatile("s_waitcnt vmcnt(0)" ::: "memory");
            const unsigned og = xb_add(&bar[XB_TOP], 1u);
            const unsigned tg = og / nx;
            if (og + 1u == (tg + 1u) * nx) xb_add(&bar[XB_TOPGEN], 1u);
            else XB_SPIN(xb_ld(&bar[XB_TOPGEN]) == tg, bar);
            __builtin_amdgcn_fence(__ATOMIC_ACQUIRE, "agent");
            xb_add(&bar[XB_XGEN(b.x)], 1u);
            asm volatile("s_waitcnt vmcnt(0)" ::: "memory");
        } else {
            XB_SPIN(xb_ld(&bar[XB_XGEN(b.x)]) == gen, bar);
            __builtin_amdgcn_fence(__ATOMIC_ACQUIRE, "agent");
            asm volatile("s_waitcnt vmcnt(0)" ::: "memory");
        }
    }
    __syncthreads();
}
__device__ __forceinline__ void xcd_barrier(const XcdBarrier& b, int leader) { xcd_barrier_impl(b.bar, b.x, b.st, leader); }


__device__ __forceinline__ float wave_sum(float v, int lane) {
    (void)lane;
    v += __builtin_bit_cast(float, __builtin_amdgcn_update_dpp(0, __builtin_bit_cast(int, v), 0xB1, 0xF, 0xF, true));
    v += __builtin_bit_cast(float, __builtin_amdgcn_update_dpp(0, __builtin_bit_cast(int, v), 0x4E, 0xF, 0xF, true));
    v += __builtin_bit_cast(float, __builtin_amdgcn_update_dpp(0, __builtin_bit_cast(int, v), 0x141, 0xF, 0xF, true));
    v += __builtin_bit_cast(float, __builtin_amdgcn_update_dpp(0, __builtin_bit_cast(int, v), 0x140, 0xF, 0xF, true));
    { float a = v, b = v; asm volatile("v_nop\n\tv_nop\n\tv_permlane16_swap_b32 %0, %1" : "+v"(a), "+v"(b)); v = a + b; }
    { float a = v, b = v; asm volatile("v_nop\n\tv_nop\n\tv_permlane32_swap_b32 %0, %1" : "+v"(a), "+v"(b)); v = a + b; }
    return v;
}
__device__ __forceinline__ float wave_max(float v) {
    v = fmaxf(v, __builtin_bit_cast(float, __builtin_amdgcn_update_dpp(0, __builtin_bit_cast(int, v), 0xB1, 0xF, 0xF, true)));
    v = fmaxf(v, __builtin_bit_cast(float, __builtin_amdgcn_update_dpp(0, __builtin_bit_cast(int, v), 0x4E, 0xF, 0xF, true)));
    v = fmaxf(v, __builtin_bit_cast(float, __builtin_amdgcn_update_dpp(0, __builtin_bit_cast(int, v), 0x141, 0xF, 0xF, true)));
    v = fmaxf(v, __builtin_bit_cast(float, __builtin_amdgcn_update_dpp(0, __builtin_bit_cast(int, v), 0x140, 0xF, 0xF, true)));
    { float a = v, b = v; asm volatile("v_nop\n\tv_nop\n\tv_permlane16_swap_b32 %0, %1" : "+v"(a), "+v"(b)); v = fmaxf(a, b); }
    { float a = v, b = v; asm volatile("v_nop\n\tv_nop\n\tv_permlane32_swap_b32 %0, %1" : "+v"(a), "+v"(b)); v = fmaxf(a, b); }
    return v;
}
__device__ __forceinline__ float gelu_erf(float v) {
    const float av = __builtin_fabsf(v), t = __builtin_amdgcn_rcpf(av * 0.2316418882f + 1.0f);
    float q = t * 0.5307027145f + (-0.7265760135f); q = q * t + 0.7107068705f; q = q * t + (-0.142248368f); q = q * t + 0.127414796f; q = q * t;
    const float e = __builtin_amdgcn_exp2f((v * v) * (-0.72134752044f));
    const float m = v * (q * e);
    return v < 0.f ? m : v - m;
}

__device__ __forceinline__ void norm_phase(const GAS float* X, const GAS float* g, GAS bf16* out, int rows, int gw, int NGW, int lane) {
    asm volatile("" : "+v"(lane));
    f32x4 gv[4];
#pragma unroll
    for (int j = 0; j < 4; ++j) gv[j] = ((const GAS f32x4*)g)[lane + 64 * j];
    for (int m = gw; m < rows; m += NGW) {
        const GAS f32x4* xr = (const GAS f32x4*)(X + (size_t)m * D) + lane;
        f32x4 v[4]; float s = 0.f;
#pragma unroll
        for (int j = 0; j < 4; ++j) { v[j] = xr[64 * j]; s += (v[j].x * v[j].x + v[j].y * v[j].y) + (v[j].z * v[j].z + v[j].w * v[j].w); }
        const float rs = rsqrtf(wave_sum(s, lane) * (1.f / D) + 1e-6f);
        GAS v2u* o8 = (GAS v2u*)(out + (size_t)m * D) + lane;
#pragma unroll
        for (int j = 0; j < 4; ++j) { v2u w; w.x = pk2(v[j].x * rs * gv[j].x, v[j].y * rs * gv[j].y); w.y = pk2(v[j].z * rs * gv[j].z, v[j].w * rs * gv[j].w); o8[64 * j] = w; }
    }
}
__device__ __forceinline__ void hq_phase(const GAS bf16* XB, const GAS float* SSQ, const GAS float* g, GAS unsigned char* HQ, GAS float* SH, GAS int* Pz, int gw, int NGW, int lane) {
    asm volatile("" : "+v"(lane));
    const GAS f32x4* gp = (const GAS f32x4*)g + 4 * lane; const f32x4 g0 = gp[0], g1 = gp[1], g2 = gp[2], g3 = gp[3];
    for (int m = gw; m < T; m += NGW) {
        const GAS f32x4* sp = (const GAS f32x4*)(SSQ + (size_t)m * 16); const f32x4 t = (sp[0] + sp[1]) + (sp[2] + sp[3]);
        const float rs = __builtin_amdgcn_rsqf(((t[0] + t[1]) + (t[2] + t[3])) * (1.f / 1024.f) + 1e-6f);
        const v4u a = *(const GAS v4u*)(XB + (size_t)m * D + 16 * lane), b = *(const GAS v4u*)(XB + (size_t)m * D + 16 * lane + 8);
        float f[16] = {bflo(a.x) * g0[0], bfhi(a.x) * g0[1], bflo(a.y) * g0[2], bfhi(a.y) * g0[3], bflo(a.z) * g1[0], bfhi(a.z) * g1[1], bflo(a.w) * g1[2], bfhi(a.w) * g1[3],
                       bflo(b.x) * g2[0], bfhi(b.x) * g2[1], bflo(b.y) * g2[2], bfhi(b.y) * g2[3], bflo(b.z) * g3[0], bfhi(b.z) * g3[1], bflo(b.w) * g3[2], bfhi(b.w) * g3[3]};
        float mx = 0.f;
#pragma unroll
        for (int i = 0; i < 16; ++i) { f[i] *= rs; mx = fmaxf(mx, __builtin_fabsf(f[i])); }
        mx = wave_max(mx);
        const float inv = mx > 0.f ? 127.f / mx : 0.f;
        v4u q;
#pragma unroll
        for (int i = 0; i < 4; ++i) { const int ia = (int)__builtin_rintf(f[4 * i] * inv), ib = (int)__builtin_rintf(f[4 * i + 1] * inv), ic = (int)__builtin_rintf(f[4 * i + 2] * inv), id = (int)__builtin_rintf(f[4 * i + 3] * inv);
            q[i] = (unsigned)(ia & 255) | ((unsigned)(ib & 255) << 8) | ((unsigned)(ic & 255) << 16) | ((unsigned)(id & 255) << 24); }
        *(GAS v4u*)(HQ + (size_t)m * D + 16 * lane) = q;
        if (lane == 0) SH[m] = mx * (1.f / 127.f);
    }
}
__device__ __forceinline__ void x0_phase(const GAS float* X, GAS bf16* XB, GAS float* SSQ, int gw, int NGW, int lane) {
    asm volatile("" : "+v"(lane));
    for (int m = gw; m < T; m += NGW) {
        const GAS f32x4* xr = (const GAS f32x4*)(X + (size_t)m * D) + lane; GAS v2u* o8 = (GAS v2u*)(XB + (size_t)m * D) + lane;
        float s = 0.f;
#pragma unroll
        for (int j = 0; j < 4; ++j) { const f32x4 v = xr[64 * j]; s += (v.x * v.x + v.y * v.y) + (v.z * v.z + v.w * v.w); v2u w; w.x = pk2(v.x, v.y); w.y = pk2(v.z, v.w); o8[64 * j] = w; }
        s = wave_sum(s, lane);
        if (lane < 8) SSQ[(size_t)m * 16 + lane] = lane == 0 ? s : 0.f;
    }
}
__device__ __forceinline__ void final_norm_phase(const GAS bf16* XB, GAS float* O, const GAS float* g, int rows, int gw, int NGW, int lane) {
    asm volatile("" : "+v"(lane));
    for (int m = gw; m < rows; m += NGW) {
        const GAS v4u* xr = (const GAS v4u*)(XB + (size_t)m * D) + lane;
        v4u v[2]; float s = 0.f;
#pragma unroll
        for (int j = 0; j < 2; ++j) { v[j] = xr[64 * j];
#pragma unroll
            for (int e = 0; e < 4; ++e) { const float a = bflo(v[j][e]), b = bfhi(v[j][e]); s += a * a + b * b; } }
        const float rs = rsqrtf(wave_sum(s, lane) * (1.f / D) + 1e-6f);
#pragma unroll
        for (int j = 0; j < 2; ++j) { const int c = 8 * (lane + 64 * j); const f32x4 g0 = *(const GAS f32x4*)(g + c), g1 = *(const GAS f32x4*)(g + c + 4);
            f32x4 o0, o1; o0.x = bflo(v[j].x) * rs * g0.x; o0.y = bfhi(v[j].x) * rs * g0.y; o0.z = bflo(v[j].y) * rs * g0.z; o0.w = bfhi(v[j].y) * rs * g0.w;
            o1.x = bflo(v[j].z) * rs * g1.x; o1.y = bfhi(v[j].z) * rs * g1.y; o1.z = bflo(v[j].w) * rs * g1.z; o1.w = bfhi(v[j].w) * rs * g1.w;
            *(GAS f32x4*)(O + (size_t)m * D + c) = o0; *(GAS f32x4*)(O + (size_t)m * D + c + 4) = o1; }
    }
}

__device__ __forceinline__ float row16_sum(float v) {
    v += __builtin_bit_cast(float, __builtin_amdgcn_update_dpp(0, __builtin_bit_cast(int, v), 0xB1, 0xF, 0xF, true));
    v += __builtin_bit_cast(float, __builtin_amdgcn_update_dpp(0, __builtin_bit_cast(int, v), 0x4E, 0xF, 0xF, true));
    v += __builtin_bit_cast(float, __builtin_amdgcn_update_dpp(0, __builtin_bit_cast(int, v), 0x141, 0xF, 0xF, true));
    v += __builtin_bit_cast(float, __builtin_amdgcn_update_dpp(0, __builtin_bit_cast(int, v), 0x140, 0xF, 0xF, true));
    return v;
}
__device__ __forceinline__ float sq8(const v4u w) { const float a0 = bflo(w.x), a1 = bfhi(w.x), a2 = bflo(w.y), a3 = bfhi(w.y), a4 = bflo(w.z), a5 = bfhi(w.z), a6 = bflo(w.w), a7 = bfhi(w.w);
    return (a0 * a0 + a1 * a1) + (a2 * a2 + a3 * a3) + (a4 * a4 + a5 * a5) + (a6 * a6 + a7 * a7); }
__device__ __forceinline__ void pre_phase(const GAS bf16* PROJB, const GAS float* ROPE, GAS float* RS, GAS bf16* KMB, int gw, int NGW, int lane) {
    asm volatile("" : "+v"(lane));
    const int q = lane >> 4, sub = lane & 15;
    for (int t0 = gw * 4; t0 < T; t0 += NGW * 4) {
        const size_t t = (size_t)t0 + q;
        const GAS bf16* pr = PROJB + t * INP;
        const v4u w0 = *(const GAS v4u*)(pr + PC_CQ + 8 * sub), w1 = *(const GAS v4u*)(pr + PC_CQ + 8 * (16 + (sub & 7))), w2 = *(const GAS v4u*)(pr + PC_CKV + 8 * sub);
        const float x1 = __builtin_bit_cast(float, (unsigned)pr[PC_KR + sub] << 16), x2 = __builtin_bit_cast(float, (unsigned)pr[PC_KR + 16 + sub] << 16);
        const float c = ROPE[t * 32 + sub], sn = ROPE[t * 32 + 16 + sub];
        const float sq = row16_sum(sq8(w0) + (sub < 8 ? sq8(w1) : 0.f)), skv = row16_sum(sq8(w2));
        if (sub == 0) { RS[2 * t] = rsqrtf(sq * (1.f / 192.f) + 1e-6f); RS[2 * t + 1] = rsqrtf(skv * (1.f / 128.f) + 1e-6f); }
        const bf16 y1 = (bf16)f2bf_(x1 * c - x2 * sn), y2 = (bf16)f2bf_(x1 * sn + x2 * c);
        GAS bf16* kr = KMB + t * 384 + 64 + sub;
#pragma unroll
        for (int h = 0; h < 4; ++h) { kr[h * 96] = y1; kr[h * 96 + 16] = y2; }
    }
}

typedef short lr_bf16x8 __attribute__((ext_vector_type(8)));
typedef float lr_f32x16 __attribute__((ext_vector_type(16)));
__device__ __forceinline__ void lr_swap32(float& a, float& b) { asm volatile("v_nop\n\tv_nop\n\tv_permlane32_swap_b32 %0, %1" : "+v"(a), "+v"(b)); }
constexpr int LR_XR = 0, LR_CW = LR_XR + 37376, LR_XA = LR_CW + 1280, LR_WT = LR_XA + 256 * 144, LR_SUM = LR_WT + 2 * 64 * 144, LR_END = LR_SUM + 4096;
struct LruP { const GAS bf16* PROJB; const GAS float* cw; const GAS float* cb; const GAS bf16* wat; const GAS float* ba; const GAS float* bx; const GAS float* sp; GAS unsigned* HA; GAS float* LSUM; };
__device__ __forceinline__ void lru_phase(const LruP& P, LAS unsigned char* lds, int tid, int wave, int lane, int vcu, int G) {
    asm volatile("" : "+v"(tid), "+v"(lane));
    LAS float* SUM = (LAS float*)(lds + LR_SUM);
    for (int u = vcu; u < (T / 256) * 8; u += G) {
        const int tile = u >> 3, g = u & 7; const int t0 = tile * 256; const bool first = ((tile & 31) == 0);
        __syncthreads();
        float ba_[2], bx_[2], sp_[2];
#pragma unroll
        for (int nt = 0; nt < 2; ++nt) { const int ch = 64 * g + 32 * nt + (lane & 31); ba_[nt] = P.ba[ch]; bx_[nt] = P.bx[ch]; sp_[nt] = P.sp[ch]; }
        { v4u wt_[2], xr_[5];
#pragma unroll
          for (int i = 0; i < 2; ++i) { const int idx = tid + 512 * i; wt_[i] = ((const GAS v4u*)(P.wat + (size_t)g * 2 * 4096))[idx]; }
#pragma unroll
          for (int i = 0; i < 5; ++i) { const int idx = tid + 512 * i, row = idx >> 3, part = idx & 7; const bool ok = (idx < 259 * 8) && !(first && row < 3);
              const int trow = ok ? t0 - 3 + row : t0;
              xr_[i] = *(const GAS v4u*)(P.PROJB + (size_t)trow * INP + PC_XL + 64 * g + 8 * part); if (!ok) xr_[i] = v4u{0u, 0u, 0u, 0u}; }
          float cwv = 0.f; if (tid < 320) cwv = (tid < 256) ? P.cw[(tid >> 6) * 512 + 64 * g + (tid & 63)] : P.cb[64 * g + (tid - 256)];
#pragma unroll
          for (int i = 0; i < 2; ++i) { const int idx = tid + 512 * i; *(LAS v4u*)(lds + LR_WT + (idx >> 9) * 9216 + ((idx >> 3) & 63) * 144 + (idx & 7) * 16) = wt_[i]; }
#pragma unroll
          for (int i = 0; i < 5; ++i) { const int idx = tid + 512 * i, row = idx >> 3, part = idx & 7; if (idx < 259 * 8) *(LAS v4u*)(lds + LR_XR + row * 144 + 16 * part) = xr_[i]; }
          if (tid < 320) ((LAS float*)(lds + LR_CW))[tid] = cwv; }
        __syncthreads();
        { float cwr[4][8], cbr[8];
#pragma unroll
          for (int k = 0; k < 4; ++k) { const f32x4 c0 = *(const LAS f32x4*)(lds + LR_CW + (k * 64 + 8 * wave) * 4), c1 = *(const LAS f32x4*)(lds + LR_CW + (k * 64 + 8 * wave + 4) * 4);
              cwr[k][0] = c0.x; cwr[k][1] = c0.y; cwr[k][2] = c0.z; cwr[k][3] = c0.w; cwr[k][4] = c1.x; cwr[k][5] = c1.y; cwr[k][6] = c1.z; cwr[k][7] = c1.w; }
          { const f32x4 c0 = *(const LAS f32x4*)(lds + LR_CW + (256 + 8 * wave) * 4), c1 = *(const LAS f32x4*)(lds + LR_CW + (256 + 8 * wave + 4) * 4);
            cbr[0] = c0.x; cbr[1] = c0.y; cbr[2] = c0.z; cbr[3] = c0.w; cbr[4] = c1.x; cbr[5] = c1.y; cbr[6] = c1.z; cbr[7] = c1.w; }
#pragma unroll
          for (int it_ = 0; it_ < 4; ++it_) { const int time = lane + 64 * it_;
              float y[8];
#pragma unroll
              for (int e = 0; e < 8; ++e) y[e] = cbr[e];
#pragma unroll
              for (int k = 0; k < 4; ++k) { const v4u w = *(const LAS v4u*)(lds + LR_XR + (time + k) * 144 + 16 * wave);
                  y[0] += bflo(w.x) * cwr[k][0]; y[1] += bfhi(w.x) * cwr[k][1]; y[2] += bflo(w.y) * cwr[k][2]; y[3] += bfhi(w.y) * cwr[k][3];
                  y[4] += bflo(w.z) * cwr[k][4]; y[5] += bfhi(w.z) * cwr[k][5]; y[6] += bflo(w.w) * cwr[k][6]; y[7] += bfhi(w.w) * cwr[k][7]; }
              v4u o; o.x = pk2(y[0], y[1]); o.y = pk2(y[2], y[3]); o.z = pk2(y[4], y[5]); o.w = pk2(y[6], y[7]);
              *(LAS v4u*)(lds + LR_XA + time * 144 + 16 * wave) = o; } }
        __syncthreads();
        const int r32 = lane & 31, hi = lane >> 5;
        lr_f32x16 acc[2][2];
#pragma unroll
        for (int nt = 0; nt < 2; ++nt) { const float b_a = ba_[nt], b_x = bx_[nt];
#pragma unroll
            for (int r = 0; r < 16; ++r) { acc[0][nt][r] = b_a; acc[1][nt][r] = b_x; } }
        { lr_bf16x8 af[4];
#pragma unroll
          for (int s_ = 0; s_ < 4; ++s_) af[s_] = *(const LAS lr_bf16x8*)(lds + LR_XA + (32 * wave + r32) * 144 + (16 * s_ + 8 * hi) * 2);
#pragma unroll
          for (int gt = 0; gt < 2; ++gt)
#pragma unroll
              for (int nt = 0; nt < 2; ++nt)
#pragma unroll
                  for (int s_ = 0; s_ < 4; ++s_) { const lr_bf16x8 bfr = *(const LAS lr_bf16x8*)(lds + LR_WT + gt * 9216 + (32 * nt + r32) * 144 + (16 * s_ + 8 * hi) * 2);
                      acc[gt][nt] = __builtin_amdgcn_mfma_f32_32x32x16_bf16(af[s_], bfr, acc[gt][nt], 0, 0, 0); } }
#pragma unroll
        for (int nt = 0; nt < 2; ++nt) { const float sp = sp_[nt];
            float sa_[4], sh_[4];
#pragma unroll
            for (int q = 0; q < 4; ++q) { float hrun = 0.f, arun = 1.f;
#pragma unroll
                for (int e = 0; e < 4; ++e) { const int r = 4 * q + e, tl = 8 * q + 4 * hi + e;
                    const float xv = __builtin_bit_cast(float, (unsigned)*(const LAS unsigned short*)(lds + LR_XA + (32 * wave + tl) * 144 + (32 * nt + r32) * 2) << 16);
                    const float rg = __builtin_amdgcn_rcpf(1.f + __builtin_amdgcn_exp2f(-LOG2E * acc[0][nt][r])), ig = __builtin_amdgcn_rcpf(1.f + __builtin_amdgcn_exp2f(-LOG2E * acc[1][nt][r]));
                    const float la = -8.0f * rg * sp; const float a_ = __builtin_amdgcn_exp2f(LOG2E * la);
                    const float uu = __builtin_amdgcn_sqrtf(fmaxf(1.f - a_ * a_, 0.f)) * (ig * xv);
                    hrun = a_ * hrun + uu; arun *= a_; acc[0][nt][r] = arun; acc[1][nt][r] = hrun; }
                sa_[q] = arun; sh_[q] = hrun; }
            float runA = 1.f, runH = 0.f;
#pragma unroll
            for (int q = 0; q < 4; ++q) { float a0 = sa_[q], a1 = sa_[q], h0 = sh_[q], h1 = sh_[q]; lr_swap32(a0, a1); lr_swap32(h0, h1);
                const float midA = runA * a0, midH = a0 * runH + h0;
                const float inA = hi ? midA : runA, inH = hi ? midH : runH;
                runA = midA * a1; runH = a1 * midH + h1;
#pragma unroll
                for (int e = 0; e < 4; ++e) { const int r = 4 * q + e; acc[1][nt][r] += acc[0][nt][r] * inH; acc[0][nt][r] *= inA; } }
            if (hi == 0) { SUM[(wave * 64 + 32 * nt + r32) * 2] = runA; SUM[(wave * 64 + 32 * nt + r32) * 2 + 1] = runH; } }
        __syncthreads();
#pragma unroll
        for (int nt = 0; nt < 2; ++nt) { const int cl = 32 * nt + r32;
            float ca = 1.f, chh = 0.f;
            for (int w = 0; w < wave; ++w) { const float aw = SUM[(w * 64 + cl) * 2], hw = SUM[(w * 64 + cl) * 2 + 1]; chh = aw * chh + hw; ca *= aw; }
            GAS unsigned* ha = P.HA + (size_t)(t0 + 32 * wave + 4 * hi) * 512 + 64 * g + cl;
#pragma unroll
            for (int r = 0; r < 16; ++r) { const float hh = acc[1][nt][r] + acc[0][nt][r] * chh, ac_ = acc[0][nt][r] * ca; ha[(size_t)((r & 3) + 8 * (r >> 2)) * 512] = pk2(hh, ac_);
                if (r == 15 && wave == 7 && hi == 1) { P.LSUM[((size_t)tile * 512 + 64 * g + cl) * 2] = ac_; P.LSUM[((size_t)tile * 512 + 64 * g + cl) * 2 + 1] = hh; } } }
    }
}

struct PostP { const GAS bf16* OMB; const GAS unsigned* HA; const GAS float* LSUM; const GAS bf16* PROJB; const GAS float* gm; const GAS float* gl; GAS bf16* Y; };
__device__ __forceinline__ void post_phase(const PostP& P, LAS unsigned char* lds, int tid, int wave, int lane, int vcu, int G) {
    asm volatile("" : "+v"(tid), "+v"(lane));
    LAS float* hin = (LAS float*)lds;
    for (int u = vcu; u < T / 64; u += G) {
        const int t0 = u * 64, tile = t0 >> 8, tb = tile & ~31;
        __syncthreads();
        { float h = 0.f;
          for (int c0 = tb; c0 < tile; c0 += 8) {
              float av_[8], hv_[8];
#pragma unroll
              for (int i = 0; i < 8; ++i) { const int c = (c0 + i < tile) ? (c0 + i) : tb; av_[i] = P.LSUM[((size_t)c * 512 + tid) * 2]; hv_[i] = P.LSUM[((size_t)c * 512 + tid) * 2 + 1]; }
#pragma unroll
              for (int i = 0; i < 8; ++i) { if (c0 + i < tile) h = av_[i] * h + hv_[i]; } }
          hin[tid] = h; }
        __syncthreads();
        f32x4 hi0 = *(const LAS f32x4*)(hin + 8 * lane), hi1 = *(const LAS f32x4*)(hin + 8 * lane + 4);
        const f32x4 g0 = *(const GAS f32x4*)(P.gl + 8 * lane), g1 = *(const GAS f32x4*)(P.gl + 8 * lane + 4), gmv = *(const GAS f32x4*)(P.gm + 4 * lane);
#pragma unroll 2
        for (int i = 0; i < 8; ++i) {
            const size_t t = (size_t)t0 + 8 * wave + i;
            const v4u p0 = *(const GAS v4u*)(P.HA + t * 512 + 8 * lane), p1 = *(const GAS v4u*)(P.HA + t * 512 + 8 * lane + 4), gw_ = *(const GAS v4u*)(P.PROJB + t * INP + PC_GL + 8 * lane);
            const v2u mw = *(const GAS v2u*)(P.OMB + t * 256 + 4 * lane);
            float o[8];
            o[0] = (bflo(p0.x) + bfhi(p0.x) * hi0.x) * gelu_erf(bflo(gw_.x)); o[1] = (bflo(p0.y) + bfhi(p0.y) * hi0.y) * gelu_erf(bfhi(gw_.x));
            o[2] = (bflo(p0.z) + bfhi(p0.z) * hi0.z) * gelu_erf(bflo(gw_.y)); o[3] = (bflo(p0.w) + bfhi(p0.w) * hi0.w) * gelu_erf(bfhi(gw_.y));
            o[4] = (bflo(p1.x) + bfhi(p1.x) * hi1.x) * gelu_erf(bflo(gw_.z)); o[5] = (bflo(p1.y) + bfhi(p1.y) * hi1.y) * gelu_erf(bfhi(gw_.z));
            o[6] = (bflo(p1.z) + bfhi(p1.z) * hi1.z) * gelu_erf(bflo(gw_.w)); o[7] = (bflo(p1.w) + bfhi(p1.w) * hi1.w) * gelu_erf(bfhi(gw_.w));
            float s2 = 0.f;
#pragma unroll
            for (int e = 0; e < 8; ++e) s2 += o[e] * o[e];
            const float m0 = bflo(mw.x), m1 = bfhi(mw.x), m2 = bflo(mw.y), m3 = bfhi(mw.y);
            float s1 = (m0 * m0 + m1 * m1) + (m2 * m2 + m3 * m3);
            s1 = wave_sum(s1, lane); s2 = wave_sum(s2, lane);
            const float r1 = rsqrtf(s1 * (1.f / 256.f) + 1e-6f), r2 = rsqrtf(s2 * (1.f / 512.f) + 1e-6f);
            GAS bf16* yr = P.Y + t * 1024;
            { v2u w; w.x = pk2(m0 * r1 * gmv.x, m1 * r1 * gmv.y); w.y = pk2(m2 * r1 * gmv.z, m3 * r1 * gmv.w); *(GAS v2u*)(yr + 4 * lane) = w; }
            { v4u w; w.x = pk2(o[0] * r2 * g0.x, o[1] * r2 * g0.y); w.y = pk2(o[2] * r2 * g0.z, o[3] * r2 * g0.w); w.z = pk2(o[4] * r2 * g1.x, o[5] * r2 * g1.y); w.w = pk2(o[6] * r2 * g1.z, o[7] * r2 * g1.w);
              *(GAS v4u*)(yr + 256 + 8 * lane) = w; }
        }
    }
}

#define TILE_BAR() asm volatile("s_waitcnt lgkmcnt(0)\n\ts_barrier" ::: "memory")
typedef short bf16x8 __attribute__((ext_vector_type(8)));
typedef short s16x4 __attribute__((ext_vector_type(4)));
typedef float f32x16 __attribute__((ext_vector_type(16)));
typedef unsigned u32x4 __attribute__((ext_vector_type(4)));
__device__ __forceinline__ int crow(int r, int hi) { return (r & 3) + 8 * (r >> 2) + 4 * hi; }
typedef float f32x2_t __attribute__((ext_vector_type(2))); typedef __bf16 bf16x2_c __attribute__((ext_vector_type(2)));
__device__ __forceinline__ unsigned cvtpk(float lo, float hi) { f32x2_t v = {lo, hi}; bf16x2_c b = __builtin_convertvector(v, bf16x2_c); return __builtin_bit_cast(unsigned, b); }
__device__ __forceinline__ float swapmax(float m) { auto rr = __builtin_amdgcn_permlane32_swap(__float_as_uint(m), __float_as_uint(m), false, false); return fmaxf(__uint_as_float(rr[0]), __uint_as_float(rr[1])); }
__device__ __forceinline__ float swapadd(float m) { auto rr = __builtin_amdgcn_permlane32_swap(__float_as_uint(m), __float_as_uint(m), false, false); return __uint_as_float(rr[0]) + __uint_as_float(rr[1]); }
__device__ __forceinline__ s16x4 vtr(const LAS unsigned char* p) { return __builtin_bit_cast(s16x4, __builtin_amdgcn_ds_read_tr16_b64_v4i16((LAS s16x4*)p)); }
__device__ __forceinline__ bf16x8 pack8(const f32x16& p, int b) { u32x4 w; w.x = cvtpk(p[b], p[b + 1]); w.y = cvtpk(p[b + 2], p[b + 3]); w.z = cvtpk(p[b + 4], p[b + 5]); w.w = cvtpk(p[b + 6], p[b + 7]); return __builtin_bit_cast(bf16x8, w); }
__device__ __forceinline__ float vmax3(float a, float b, float c) { float r; asm("v_max3_f32 %0, %1, %2, %3" : "=v"(r) : "v"(a), "v"(b), "v"(c)); return r; }
__device__ __forceinline__ float max32(const f32x16& p, const f32x16& q) {
    float a = vmax3(p[0], p[1], p[2]), b = vmax3(p[3], p[4], p[5]), c = vmax3(p[6], p[7], p[8]), d = vmax3(p[9], p[10], p[11]), e = vmax3(p[12], p[13], p[14]);
    float f = vmax3(q[0], q[1], q[2]), g = vmax3(q[3], q[4], q[5]), h = vmax3(q[6], q[7], q[8]), i = vmax3(q[9], q[10], q[11]), j = vmax3(q[12], q[13], q[14]);
    a = vmax3(a, b, c); d = vmax3(d, e, p[15]); f = vmax3(f, g, h); i = vmax3(i, j, q[15]);
    return vmax3(vmax3(a, d, f), i, i);
}
__device__ __forceinline__ float max16(const f32x16& p) { float a = fmaxf(fmaxf(p[0], p[1]), fmaxf(p[2], p[3])), b = fmaxf(fmaxf(p[4], p[5]), fmaxf(p[6], p[7])), c = fmaxf(fmaxf(p[8], p[9]), fmaxf(p[10], p[11])), d = fmaxf(fmaxf(p[12], p[13]), fmaxf(p[14], p[15])); return fmaxf(fmaxf(a, b), fmaxf(c, d)); }

struct AttnP {
    const GAS bf16* Q; const GAS bf16* K; const GAS bf16* V; int qp, kp, vp;
    GAS bf16* O; int op;
    const GAS float* rope;
    const GAS int* pos; const GAS float* btab; const GAS float* dnorm; const GAS float* lams;
};
template <int KIND> struct AK {
    static constexpr bool DIFF = KIND == 1, CROSS = KIND == 2;
    static constexpr int HW = KIND == 0 ? 96 : KIND == 1 ? 64 : 256;
    static constexpr int NKS = KIND == 0 ? 6 : KIND == 1 ? 2 : 16;
    static constexpr int KP = KIND == 0 ? 208 : KIND == 1 ? 144 : 528;
    static constexpr int ND = CROSS ? 4 : 2;
    static constexpr int CPK = HW / 8, KCH = (64 * CPK + 511) / 512;
    static constexpr int VCH = ND / 2;
    static constexpr int KB = 64 * KP, VB = ND * 4096;
    static constexpr int NBUF = CROSS ? 2 : 3;
    static constexpr int K0 = 0, V0 = NBUF * KB, POS = V0 + NBUF * VB, BT = POS + 1024, DN = BT + 528, END = DN + 256;
};
static_assert(AK<2>::END <= RING_BYTES && AK<0>::END <= RING_BYTES && AK<1>::END + 16 + 8 * 8192 <= RING_BYTES, "attention LDS");

template <int KIND, bool LEAD>
__device__ __forceinline__ void attn_unit(const AttnP& P, int b, int h, int qb, int dhalf, LAS unsigned char* lds, int tid, int wave, int lane) {
    lane = lane_id_v(); tid = (wave << 6) | lane;
    typedef AK<KIND> C;
    constexpr bool DIFF = C::DIFF, CROSS = C::CROSS;
    constexpr int HW = C::HW, NKS = C::NKS, KP = C::KP, ND = C::ND, CPK = C::CPK, KCH = C::KCH, VCH = C::VCH;
    const int r32 = lane & 31, hi = lane >> 5;
    const size_t rowb = (size_t)b * S, rowk = CROSS ? (size_t)b * MEM : rowb;
    const int q0w = qb * 256 + wave * 32, qi = q0w + r32;
    int pq = 0; float bias_far = 0.f;
    __syncthreads();
    if (DIFF) {
        pq = P.pos[rowb + qi];
        if (tid < 129) ((LAS float*)(lds + C::BT))[tid] = P.btab[h * 129 + tid];
        if (tid >= 192 && tid < 256) ((LAS float*)(lds + C::DN))[tid - 192] = P.dnorm[tid - 192];
    }
    int minq = pq;
    if (DIFF) { for (int o = 1; o < 64; o <<= 1) { const int v = shxi(minq, o, lane); minq = v < minq ? v : minq; } }
    const int NT = CROSS ? MEM / 64 : 4 * (qb + 1);
    u32x4 kr[KCH], vr[VCH]; int pkr = 0;
    u32x4 kr2[CROSS ? 1 : KCH], vr2[CROSS ? 1 : VCH]; int pkr2 = 0;
    const GAS bf16* Kb = P.K + rowk * P.kp + h * HW; const GAS bf16* Vb = P.V + rowk * P.vp + (CROSS ? h * 256 + dhalf * 128 : h * 64);
    const __amdgpu_buffer_rsrc_t rK = __builtin_amdgcn_make_buffer_rsrc((void*)Kb, 0, 0x7fffffff, 0x00020000), rV = __builtin_amdgcn_make_buffer_rsrc((void*)Vb, 0, 0x7fffffff, 0x00020000);
    const __amdgpu_buffer_rsrc_t rP = __builtin_amdgcn_make_buffer_rsrc((void*)(DIFF ? P.pos + rowb : (const GAS int*)Kb), 0, 0x7fffffff, 0x00020000);
    int kvo[KCH], vvo[VCH];
#pragma unroll
    for (int i = 0; i < KCH; ++i) { int c = tid + 512 * i; c = c < 64 * CPK ? c : tid; kvo[i] = ((c / CPK) * P.kp + (c % CPK) * 8) * 2; }
#pragma unroll
    for (int i = 0; i < VCH; ++i) { const int c = tid + 512 * i; vvo[i] = ((c / (4 * ND)) * P.vp + (c % (4 * ND)) * 8) * 2; }
    const int pvo = (tid & 63) * 4;
    auto gload = [&](int t) {
        const int ks = __builtin_amdgcn_readfirstlane(64 * t * P.kp * 2), vs = __builtin_amdgcn_readfirstlane(64 * t * P.vp * 2);
#pragma unroll
        for (int i = 0; i < KCH; ++i) kr[i] = __builtin_amdgcn_raw_buffer_load_b128(rK, kvo[i], ks, 0);
#pragma unroll
        for (int i = 0; i < VCH; ++i) vr[i] = __builtin_amdgcn_raw_buffer_load_b128(rV, vvo[i], vs, 0);
        if (DIFF) pkr = __builtin_amdgcn_raw_buffer_load_b32(rP, pvo, __builtin_amdgcn_readfirstlane(64 * t * 4), 0);
    };
    auto lstore = [&](int buf) {
        LAS unsigned char* kb_ = lds + C::K0 + buf * C::KB; LAS unsigned char* vb_ = lds + C::V0 + buf * C::VB;
#pragma unroll
        for (int i = 0; i < KCH; ++i) { int c = tid + 512 * i; c = c < 64 * CPK ? c : tid; const int key = c / CPK, part = c % CPK; *(LAS u32x4*)(kb_ + key * KP + part * 16) = kr[i]; }
#pragma unroll
        for (int i = 0; i < VCH; ++i) { const int c = tid + 512 * i; const int key = c / (4 * ND), part = c % (4 * ND); *(LAS u32x4*)(vb_ + (part >> 2) * 4096 + (key >> 3) * 512 + (key & 7) * 64 + (part & 3) * 16) = vr[i]; }
        if (DIFF) { ((LAS int*)(lds + C::POS + buf * 256))[tid & 63] = pkr; if (tid < 64) { int mk_ = pkr; for (int o = 1; o < 64; o <<= 1) { const int v = shxi(mk_, o, lane); mk_ = v > mk_ ? v : mk_; } if (tid == 0) ((LAS int*)(lds + C::POS + 768))[buf] = mk_; } }
    };
    auto gloadB = [&](int t) {
        const int ks = __builtin_amdgcn_readfirstlane(64 * t * P.kp * 2), vs = __builtin_amdgcn_readfirstlane(64 * t * P.vp * 2);
#pragma unroll
        for (int i = 0; i < (CROSS ? 1 : KCH); ++i) kr2[i] = __builtin_amdgcn_raw_buffer_load_b128(rK, kvo[i], ks, 0);
#pragma unroll
        for (int i = 0; i < (CROSS ? 1 : VCH); ++i) vr2[i] = __builtin_amdgcn_raw_buffer_load_b128(rV, vvo[i], vs, 0);
        if (DIFF) pkr2 = __builtin_amdgcn_raw_buffer_load_b32(rP, pvo, __builtin_amdgcn_readfirstlane(64 * t * 4), 0);
    };
    auto lstoreB = [&](int buf) {
        LAS unsigned char* kb_ = lds + C::K0 + buf * C::KB; LAS unsigned char* vb_ = lds + C::V0 + buf * C::VB;
#pragma unroll
        for (int i = 0; i < (CROSS ? 1 : KCH); ++i) { int c = tid + 512 * i; c = c < 64 * CPK ? c : tid; const int key = c / CPK, part = c % CPK; *(LAS u32x4*)(kb_ + key * KP + part * 16) = kr2[i]; }
#pragma unroll
        for (int i = 0; i < (CROSS ? 1 : VCH); ++i) { const int c = tid + 512 * i; const int key = c / (4 * ND), part = c % (4 * ND); *(LAS u32x4*)(vb_ + (part >> 2) * 4096 + (key >> 3) * 512 + (key & 7) * 64 + (part & 3) * 16) = vr2[i]; }
        if (DIFF) { ((LAS int*)(lds + C::POS + buf * 256))[tid & 63] = pkr2; if (tid < 64) { int mk_ = pkr2; for (int o = 1; o < 64; o <<= 1) { const int v = shxi(mk_, o, lane); mk_ = v > mk_ ? v : mk_; } if (tid == 0) ((LAS int*)(lds + C::POS + 768))[buf] = mk_; } }
    };
    LAS float* osv = (LAS float*)(lds + ((C::END + 15) & ~15)) + wave * 2048 + lane;
    float il = 0.f;
    f32x16 oA[ND];
#pragma unroll 1
    for (int mp = 0; mp < (DIFF ? 2 : 1); ++mp) {
        bf16x8 qf[NKS];
        { const GAS bf16* qrow = P.Q + (rowb + qi) * P.qp + h * HW + mp * 32;
#pragma unroll
          for (int s = 0; s < NKS; ++s) qf[s] = *(const GAS bf16x8*)(qrow + 16 * s + 8 * hi);
          if (KIND == 0) {
              const GAS float* rp = P.rope + (rowb + qi) * 32 + 8 * hi;
              const f32x4 c0 = *(const GAS f32x4*)rp, c1 = *(const GAS f32x4*)(rp + 4), s0 = *(const GAS f32x4*)(rp + 16), s1 = *(const GAS f32x4*)(rp + 20);
              const u32x4 a = __builtin_bit_cast(u32x4, qf[NKS - 2]), bq = __builtin_bit_cast(u32x4, qf[NKS - 1]); u32x4 ra, rb;
#pragma unroll
              for (int w = 0; w < 4; ++w) { const float cl = w < 2 ? c0[2 * w] : c1[2 * w - 4], ch = w < 2 ? c0[2 * w + 1] : c1[2 * w - 3], sl = w < 2 ? s0[2 * w] : s1[2 * w - 4], sh = w < 2 ? s0[2 * w + 1] : s1[2 * w - 3];
                  const float x1l = bflo(a[w]), x1h = bfhi(a[w]), x2l = bflo(bq[w]), x2h = bfhi(bq[w]);
                  ra[w] = cvtpk(x1l * cl - x2l * sl, x1h * ch - x2h * sh); rb[w] = cvtpk(x1l * sl + x2l * cl, x1h * sh + x2h * ch); }
              qf[NKS - 2] = __builtin_bit_cast(bf16x8, ra); qf[NKS - 1] = __builtin_bit_cast(bf16x8, rb);
          } }
        __syncthreads();
        float m1 = -1e30f, l1 = 0.f;
#pragma unroll
        for (int d = 0; d < ND; ++d)
#pragma unroll
            for (int r = 0; r < 16; ++r) oA[d][r] = 0.f;
        auto qk = [&](int sl, f32x16& sa, f32x16& sb, float init) {
            const LAS unsigned char* kb_ = lds + C::K0 + sl * C::KB + r32 * KP + hi * 16 + mp * 64;
#pragma unroll
            for (int r = 0; r < 16; ++r) { sa[r] = init; sb[r] = init; }
            constexpr int HB = CROSS ? 4 : (NKS > 3 ? 3 : NKS);
#pragma unroll
            for (int s0_ = 0; s0_ < NKS; s0_ += HB) {
                bf16x8 kfa[HB], kfb[HB];
#pragma unroll
                for (int s = 0; s < HB; ++s) { kfa[s] = *(const LAS bf16x8*)(kb_ + (s0_ + s) * 32); kfb[s] = *(const LAS bf16x8*)(kb_ + 32 * KP + (s0_ + s) * 32); }
                __builtin_amdgcn_sched_barrier(0);
#pragma unroll
                for (int s = 0; s < HB; ++s) { sa = __builtin_amdgcn_mfma_f32_32x32x16_bf16(kfa[s], qf[s0_ + s], sa, 0, 0, 0); sb = __builtin_amdgcn_mfma_f32_32x32x16_bf16(kfb[s], qf[s0_ + s], sb, 0, 0, 0); }
                __builtin_amdgcn_sched_barrier(0);
            }
        };
        auto isnear = [&](int sl) { bool nb = false;
            if (DIFF) { const int mk_ = __builtin_amdgcn_readfirstlane(((LAS int*)(lds + C::POS + 768))[sl]); nb = (minq - mk_) < 128; }
            return nb; };
        auto sm = [&](int t, int sl, f32x16& pa, f32x16& pb, bool nearb) -> float {
            const int k0 = 64 * t;
            if (DIFF) { if (nearb) {
                const LAS int* pk = (const LAS int*)(lds + C::POS + sl * 256); const LAS float* bt = (const LAS float*)(lds + C::BT);
#pragma unroll
                for (int r = 0; r < 16; ++r) { const int kk = crow(r, hi);
                    int n0 = pq - pk[kk], n1 = pq - pk[kk + 32]; n0 = n0 < 0 ? 0 : (n0 > 128 ? 128 : n0); n1 = n1 < 0 ? 0 : (n1 > 128 ? 128 : n1);
                    pa[r] += bt[n0]; pb[r] += bt[n1]; }
            } }
            if (!CROSS && k0 + 63 > q0w) {
#pragma unroll
                for (int r = 0; r < 16; ++r) { const int kk = k0 + crow(r, hi); if (kk > qi) pa[r] = -1e30f; if (kk + 32 > qi) pb[r] = -1e30f; }
            }
            asm volatile("s_nop 15\n\ts_nop 7" : "+v"(pa), "+v"(pb));
            float mn, al = 1.f;
            if (CROSS) { const float mx = swapmax(max32(pa, pb)); mn = fmaxf(m1, mx); al = __builtin_amdgcn_exp2f(m1 - mn); l1 *= al; }
            else { const float mx = swapmax(max32(pa, pb)); const bool up = mx > m1 + 8.0f; mn = up ? mx : m1;
                   if (__builtin_amdgcn_ballot_w64(up) != 0ull) { al = __builtin_amdgcn_exp2f(m1 - mn); l1 *= al; } }
            m1 = mn;
            float ls = 0.f;
#pragma unroll
            for (int r = 0; r < 16; ++r) { pa[r] = __builtin_amdgcn_exp2f(pa[r] - mn); pb[r] = __builtin_amdgcn_exp2f(pb[r] - mn); ls += pa[r] + pb[r]; }
            l1 += ls;
            return al;
        };
        auto pv = [&](int sl, const f32x16& pa, const f32x16& pb, float al) {
            const LAS unsigned char* vb_ = lds + C::V0 + sl * C::VB + ((lane >> 4) & 1) * 32 + (lane & 3) * 8 + (4 * hi + ((lane & 15) >> 2)) * 64;
            bf16x8 pf[4];
            pf[0] = pack8(pa, 0); pf[1] = pack8(pa, 8); pf[2] = pack8(pb, 0); pf[3] = pack8(pb, 8);
            const bool resc = CROSS ? true : (__builtin_amdgcn_ballot_w64(al != 1.0f) != 0ull);
            if (CROSS) {
#pragma unroll
                for (int d = 0; d < ND; ++d) {
                    __builtin_amdgcn_sched_barrier(0);
#pragma unroll
                    for (int r = 0; r < 16; ++r) oA[d][r] *= al;
                    bf16x8 vf[4];
#pragma unroll
                    for (int s = 0; s < 4; ++s) { const s16x4 lo = vtr(vb_ + d * 4096 + s * 1024), hh = vtr(vb_ + d * 4096 + s * 1024 + 512); vf[s] = (bf16x8){lo[0], lo[1], lo[2], lo[3], hh[0], hh[1], hh[2], hh[3]}; }
#pragma unroll
                    for (int s = 0; s < 4; ++s) oA[d] = __builtin_amdgcn_mfma_f32_32x32x16_bf16(vf[s], pf[s], oA[d], 0, 0, 0);
                }
            } else if (DIFF) {
                if (resc) {
#pragma unroll
                    for (int d = 0; d < 2; ++d)
#pragma unroll
                        for (int r = 0; r < 16; ++r) oA[d][r] *= al;
                }
#pragma unroll
                for (int d = 0; d < 2; ++d) {
                    bf16x8 vf[4];
#pragma unroll
                    for (int s = 0; s < 4; ++s) { const s16x4 lo = vtr(vb_ + d * 4096 + s * 1024), hh = vtr(vb_ + d * 4096 + s * 1024 + 512); vf[s] = (bf16x8){lo[0], lo[1], lo[2], lo[3], hh[0], hh[1], hh[2], hh[3]}; }
                    __builtin_amdgcn_sched_barrier(0);
#pragma unroll
                    for (int s = 0; s < 4; ++s) oA[d] = __builtin_amdgcn_mfma_f32_32x32x16_bf16(vf[s], pf[s], oA[d], 0, 0, 0);
                }
            } else {
                bf16x8 vf[2][4];
#pragma unroll
                for (int d = 0; d < 2; ++d)
#pragma unroll
                    for (int s = 0; s < 4; ++s) { const s16x4 lo = vtr(vb_ + d * 4096 + s * 1024), hh = vtr(vb_ + d * 4096 + s * 1024 + 512); vf[d][s] = (bf16x8){lo[0], lo[1], lo[2], lo[3], hh[0], hh[1], hh[2], hh[3]}; }
                if (resc) {
#pragma unroll
                    for (int d = 0; d < 2; ++d)
#pragma unroll
                        for (int r = 0; r < 16; ++r) oA[d][r] *= al;
                }
                __builtin_amdgcn_sched_barrier(0);
#pragma unroll
                for (int s = 0; s < 4; ++s)
#pragma unroll
                    for (int d = 0; d < 2; ++d) oA[d] = __builtin_amdgcn_mfma_f32_32x32x16_bf16(vf[d][s], pf[s], oA[d], 0, 0, 0);
            }
        };
        if (CROSS) {
            gload(0); lstore(0);
            __syncthreads();
            for (int t = 0; t < NT; ++t) {
                const int buf = t & 1;
                f32x16 pa, pb;
                qk(buf, pa, pb, 0.f);
                const float al = sm(t, buf, pa, pb, false);
                pv(buf, pa, pb, al);
                if (t + 1 < NT) { gload(t + 1); lstore(buf ^ 1); }
                TILE_BAR();
            }
        } else {
            gload(0); lstore(0); gload(1); lstore(1);
            gload(2); gloadB(3);
            __syncthreads();
            if (DIFF) bias_far = ((LAS float*)(lds + C::BT))[128];
            const int NTW = (q0w + 31) / 64 + 1;
            constexpr bool lead = LEAD;
            f32x16 ca, cb, na, nb; bool cnear = isnear(0), nnear = false; float cal = 1.f;
            qk(0, ca, cb, (DIFF && !cnear) ? bias_far : 0.f);
            if (lead) cal = sm(0, 0, ca, cb, cnear);
            int s0 = 0, s1 = 1, s2 = 2;
            auto period = [&](int t, f32x16& xa, f32x16& xb, bool& xnear, f32x16& ya, f32x16& yb, bool& ynear) {
                const bool have_next = (t + 1 < NTW);
                if (lead) {
                    if (have_next) { ynear = isnear(s1); qk(s1, ya, yb, (DIFF && !ynear) ? bias_far : 0.f); }
                    if (t < NTW) pv(s0, xa, xb, cal);
                    if (have_next) cal = sm(t + 1, s1, ya, yb, ynear);
                } else {
                    if (t < NTW) cal = sm(t, s0, xa, xb, xnear);
                    if (have_next) { ynear = isnear(s1); qk(s1, ya, yb, (DIFF && !ynear) ? bias_far : 0.f); }
                    if (t < NTW) pv(s0, xa, xb, cal);
                }
                { const int tmp = s0; s0 = s1; s1 = s2; s2 = tmp; }
            };
            int t = 0;
            for (; t + 5 < NT; t += 2) {
                lstore(s2); gload(t + 4);
                period(t, ca, cb, cnear, na, nb, nnear);
                TILE_BAR();
                lstoreB(s2); gloadB(t + 5);
                period(t + 1, na, nb, nnear, ca, cb, cnear);
                TILE_BAR();
            }
            for (; t < NT; t += 2) {
                if (t + 2 < NT) { lstore(s2); if (t + 4 < NT) gload(t + 4); }
                period(t, ca, cb, cnear, na, nb, nnear);
                TILE_BAR();
                if (t + 3 < NT) { lstoreB(s2); if (t + 5 < NT) gloadB(t + 5); }
                period(t + 1, na, nb, nnear, ca, cb, cnear);
                TILE_BAR();
            }
        }
        il = 1.f / swapadd(l1);
        if (DIFF) { if (mp == 0) {
#pragma unroll
            for (int d = 0; d < 2; ++d)
#pragma unroll
                for (int r = 0; r < 16; ++r) osv[(d * 16 + r) * 64] = oA[d][r] * il; } }
    }
    GAS bf16* orow = P.O + (rowb + qi) * P.op + (CROSS ? h * 256 + dhalf * 128 : h * 64);
    if (!DIFF) {
#pragma unroll
        for (int d = 0; d < ND; ++d)
#pragma unroll
            for (int g = 0; g < 4; ++g) { v2u v; v.x = cvtpk(oA[d][4 * g] * il, oA[d][4 * g + 1] * il); v.y = cvtpk(oA[d][4 * g + 2] * il, oA[d][4 * g + 3] * il); *(GAS v2u*)(orow + 32 * d + 8 * g + 4 * hi) = v; }
    } else {
        const float lam = P.lams[0], lam_init = P.lams[1];
        const float i2 = lam * il;
        float ss = 0.f;
#pragma unroll
        for (int d = 0; d < 2; ++d)
#pragma unroll
            for (int r = 0; r < 16; ++r) { const float v = osv[(d * 16 + r) * 64] - oA[d][r] * i2; oA[d][r] = v; ss += v * v; }
        ss = swapadd(ss);
        const float rs = __builtin_amdgcn_rsqf(ss * (1.f / 64.f) + 1e-6f) * (1.f - lam_init);
        const LAS float* dn = (const LAS float*)(lds + C::DN);
#pragma unroll
        for (int d = 0; d < 2; ++d)
#pragma unroll
            for (int g = 0; g < 4; ++g) { const int c = 32 * d + 8 * g + 4 * hi; const f32x4 gn = *(const LAS f32x4*)(dn + c);
                v2u v; v.x = cvtpk(oA[d][4 * g] * rs * gn[0], oA[d][4 * g + 1] * rs * gn[1]); v.y = cvtpk(oA[d][4 * g + 2] * rs * gn[2], oA[d][4 * g + 3] * rs * gn[3]); *(GAS v2u*)(orow + c) = v; }
    }
}

__device__ __forceinline__ int wave_max_i(int v) {
    { const int o = __builtin_amdgcn_update_dpp(0, v, 0xB1, 0xF, 0xF, true); v = o > v ? o : v; }
    { const int o = __builtin_amdgcn_update_dpp(0, v, 0x4E, 0xF, 0xF, true); v = o > v ? o : v; }
    { const int o = __builtin_amdgcn_update_dpp(0, v, 0x141, 0xF, 0xF, true); v = o > v ? o : v; }
    { const int o = __builtin_amdgcn_update_dpp(0, v, 0x140, 0xF, 0xF, true); v = o > v ? o : v; }
    { int a = v, b = v; asm volatile("v_nop\n\tv_nop\n\tv_permlane16_swap_b32 %0, %1" : "+v"(a), "+v"(b)); v = a > b ? a : b; }
    { int a = v, b = v; asm volatile("v_nop\n\tv_nop\n\tv_permlane32_swap_b32 %0, %1" : "+v"(a), "+v"(b)); v = a > b ? a : b; }
    return v;
}
template <int KIND> struct AK2 {
    static constexpr bool DIFF = KIND == 1;
    static constexpr int HW = KIND == 0 ? 96 : 64, NKS = KIND == 0 ? 6 : 2, KP = KIND == 0 ? 208 : 144;
    static constexpr int CPK = HW / 8, KCH = (128 * CPK) / 512, VCH = 2;
    static constexpr int KB = 128 * KP, VB = 2 * 8192;
    static constexpr int K0 = 0, V0 = 2 * KB, POS = V0 + 2 * VB, PMX = POS + 1024, BT = PMX + 16, DN = BT + 528, OSV = (DN + 256 + 15) & ~15, END = OSV + (DIFF ? 8 * 8192 : 0);
};
static_assert(AK2<0>::END <= RING_BYTES && AK2<1>::END <= RING_BYTES, "attention LDS (128-key tiles)");
template <int KIND>
__device__ __forceinline__ void attn_unit2(const AttnP& P, int b, int h, int qb, LAS unsigned char* lds, int tid, int wave, int lane) {
    lane = lane_id_v(); tid = (wave << 6) | lane;
    typedef AK2<KIND> C;
    constexpr bool DIFF = C::DIFF;
    constexpr int HW = C::HW, NKS = C::NKS, KP = C::KP, CPK = C::CPK, KCH = C::KCH, VCH = C::VCH;
    const int r32 = lane & 31, hi = lane >> 5;
    const size_t rowb = (size_t)b * S;
    const int q0w = qb * 256 + wave * 32, qi = q0w + r32;
    int pq = 0; float bias_far = 0.f;
    __syncthreads();
    if (DIFF) {
        pq = P.pos[rowb + qi];
        if (tid < 129) ((LAS float*)(lds + C::BT))[tid] = P.btab[h * 129 + tid];
        if (tid >= 192 && tid < 256) ((LAS float*)(lds + C::DN))[tid - 192] = P.dnorm[tid - 192];
    }
    int minq = pq;
    if (DIFF) minq = __builtin_amdgcn_readfirstlane(-wave_max_i(-pq));
    const int NT = 2 * (qb + 1);
    const GAS bf16* Kb = P.K + rowb * P.kp + h * HW; const GAS bf16* Vb = P.V + rowb * P.vp + h * 64;
    const __amdgpu_buffer_rsrc_t rK = __builtin_amdgcn_make_buffer_rsrc((void*)Kb, 0, 0x7fffffff, 0x00020000), rV = __builtin_amdgcn_make_buffer_rsrc((void*)Vb, 0, 0x7fffffff, 0x00020000);
    const __amdgpu_buffer_rsrc_t rP = __builtin_amdgcn_make_buffer_rsrc((void*)(DIFF ? P.pos + rowb : (const GAS int*)Kb), 0, 0x7fffffff, 0x00020000);
    int kvo[KCH], vvo[VCH], klo[KCH], vlo[VCH];
#pragma unroll
    for (int i = 0; i < KCH; ++i) { const int c = tid + 512 * i; kvo[i] = ((c / CPK) * P.kp + (c % CPK) * 8) * 2; klo[i] = (c / CPK) * KP + (c % CPK) * 16; }
#pragma unroll
    for (int i = 0; i < VCH; ++i) { const int c = tid + 512 * i; const int key = c >> 3, part = c & 7; vvo[i] = (key * P.vp + part * 8) * 2; vlo[i] = (part >> 2) * 8192 + (key >> 3) * 512 + (key & 7) * 64 + (part & 3) * 16; }
    const int pvo = (tid & 127) * 4;
    u32x4 kr[KCH], vr[VCH]; int pkr = 0;
    auto gload = [&](int t) {
        const int ks = __builtin_amdgcn_readfirstlane(128 * t * P.kp * 2), vs = __builtin_amdgcn_readfirstlane(128 * t * P.vp * 2);
#pragma unroll
        for (int i = 0; i < KCH; ++i) kr[i] = __builtin_amdgcn_raw_buffer_load_b128(rK, kvo[i], ks, 0);
#pragma unroll
        for (int i = 0; i < VCH; ++i) vr[i] = __builtin_amdgcn_raw_buffer_load_b128(rV, vvo[i], vs, 0);
        if (DIFF) pkr = __builtin_amdgcn_raw_buffer_load_b32(rP, pvo, __builtin_amdgcn_readfirstlane(128 * t * 4), 0);
    };
    auto lstore = [&](int buf) {
        LAS unsigned char* kb_ = lds + C::K0 + buf * C::KB; LAS unsigned char* vb_ = lds + C::V0 + buf * C::VB;
#pragma unroll
        for (int i = 0; i < KCH; ++i) *(LAS u32x4*)(kb_ + klo[i]) = kr[i];
#pragma unroll
        for (int i = 0; i < VCH; ++i) *(LAS u32x4*)(vb_ + vlo[i]) = vr[i];
        if (DIFF) { ((LAS int*)(lds + C::POS + buf * 512))[tid & 127] = pkr;
            if (tid < 128) { const int mk_ = wave_max_i(pkr); if (lane == 0) ((LAS int*)(lds + C::PMX))[buf * 2 + wave] = mk_; } }
    };
    LAS float* osv = (LAS float*)(lds + C::OSV) + wave * 2048 + lane;
    float il = 0.f;
    f32x16 oA[2];
#pragma unroll 1
    for (int mp = 0; mp < (DIFF ? 2 : 1); ++mp) {
        bf16x8 qf[NKS];
        { const GAS bf16* qrow = P.Q + (rowb + qi) * P.qp + h * HW + mp * 32;
#pragma unroll
          for (int s = 0; s < NKS; ++s) qf[s] = *(const GAS bf16x8*)(qrow + 16 * s + 8 * hi);
          if (KIND == 0) {
              const GAS float* rp = P.rope + (rowb + qi) * 32 + 8 * hi;
              const f32x4 c0 = *(const GAS f32x4*)rp, c1 = *(const GAS f32x4*)(rp + 4), s0 = *(const GAS f32x4*)(rp + 16), s1 = *(const GAS f32x4*)(rp + 20);
              const u32x4 a = __builtin_bit_cast(u32x4, qf[NKS - 2]), bq = __builtin_bit_cast(u32x4, qf[NKS - 1]); u32x4 ra, rb;
#pragma unroll
              for (int w = 0; w < 4; ++w) { const float cl = w < 2 ? c0[2 * w] : c1[2 * w - 4], ch = w < 2 ? c0[2 * w + 1] : c1[2 * w - 3], sl = w < 2 ? s0[2 * w] : s1[2 * w - 4], sh = w < 2 ? s0[2 * w + 1] : s1[2 * w - 3];
                  const float x1l = bflo(a[w]), x1h = bfhi(a[w]), x2l = bflo(bq[w]), x2h = bfhi(bq[w]);
                  ra[w] = cvtpk(x1l * cl - x2l * sl, x1h * ch - x2h * sh); rb[w] = cvtpk(x1l * sl + x2l * cl, x1h * sh + x2h * ch); }
              qf[NKS - 2] = __builtin_bit_cast(bf16x8, ra); qf[NKS - 1] = __builtin_bit_cast(bf16x8, rb);
          } }
        __syncthreads();
        float m1 = 0.f, l1 = 0.f;
        f32x16 negm;
#pragma unroll
        for (int r = 0; r < 16; ++r) negm[r] = 0.f;
#pragma unroll
        for (int d = 0; d < 2; ++d)
#pragma unroll
            for (int r = 0; r < 16; ++r) oA[d][r] = 0.f;
        gload(0); lstore(0);
        if (NT > 1) gload(1);
        __syncthreads();
        if (DIFF) { bias_far = ((LAS float*)(lds + C::BT))[128];
#pragma unroll
            for (int r = 0; r < 16; ++r) negm[r] = bias_far; }
        const int NTW = (q0w + 31) / 128 + 1;
        auto compute = [&](int t, int buf) {
            const int k0 = 128 * t;
            const LAS unsigned char* kb_ = lds + C::K0 + buf * C::KB + r32 * KP + hi * 16 + mp * 64;
            const LAS unsigned char* vb_ = lds + C::V0 + buf * C::VB + ((lane >> 4) & 1) * 32 + (lane & 3) * 8 + (4 * hi + ((lane & 15) >> 2)) * 64;
            bool nearb = false;
            if (DIFF) { const LAS int* pm = (const LAS int*)(lds + C::PMX) + buf * 2; const int m0 = __builtin_amdgcn_readfirstlane(pm[0]), m1_ = __builtin_amdgcn_readfirstlane(pm[1]); nearb = (minq - (m0 > m1_ ? m0 : m1_)) < 128; }
            f32x16 sc[4];
            if (DIFF) { if (nearb) {
#pragma unroll
                for (int g = 0; g < 4; ++g)
#pragma unroll
                    for (int r = 0; r < 16; ++r) sc[g][r] = -m1; } }
            if (!DIFF) {
                bf16x8 kq[4 * NKS];
#pragma unroll
                for (int i = 0; i < 4 * NKS; ++i) kq[i] = *(const LAS bf16x8*)(kb_ + 32 * (i & 3) * KP + (i >> 2) * 32);
#pragma unroll
                for (int i = 0; i < 4 * NKS; ++i) sc[i & 3] = __builtin_amdgcn_mfma_f32_32x32x16_bf16(kq[i], qf[i >> 2], i < 4 ? negm : sc[i & 3], 0, 0, 0);
                __builtin_amdgcn_sched_group_barrier(0x100, 4, 0);
#pragma unroll
                for (int i = 0; i < 4 * NKS - 4; ++i) { __builtin_amdgcn_sched_group_barrier(0x008, 1, 0); __builtin_amdgcn_sched_group_barrier(0x100, 1, 0); }
                __builtin_amdgcn_sched_group_barrier(0x008, 4, 0);
                __builtin_amdgcn_sched_barrier(0);
            } else {
            constexpr int HB = NKS > 3 ? 3 : NKS;
#pragma unroll
            for (int s0_ = 0; s0_ < NKS; s0_ += HB) {
                bf16x8 kf[4][HB];
#pragma unroll
                for (int g = 0; g < 4; ++g)
#pragma unroll
                    for (int s = 0; s < HB; ++s) kf[g][s] = *(const LAS bf16x8*)(kb_ + 32 * g * KP + (s0_ + s) * 32);
                __builtin_amdgcn_sched_barrier(0);
#pragma unroll
                for (int s = 0; s < HB; ++s)
#pragma unroll
                    for (int g = 0; g < 4; ++g) {
                        if (s0_ + s == 0 && !(DIFF && nearb)) sc[g] = __builtin_amdgcn_mfma_f32_32x32x16_bf16(kf[g][s], qf[s0_ + s], negm, 0, 0, 0);
                        else sc[g] = __builtin_amdgcn_mfma_f32_32x32x16_bf16(kf[g][s], qf[s0_ + s], sc[g], 0, 0, 0); }
                __builtin_amdgcn_sched_barrier(0);
            }
            }
            if (DIFF) { if (nearb) {
                const LAS int* pk = (const LAS int*)(lds + C::POS + buf * 512); const LAS float* bt = (const LAS float*)(lds + C::BT);
#pragma unroll
                for (int g = 0; g < 4; ++g)
#pragma unroll
                    for (int r = 0; r < 16; ++r) { int n0 = pq - pk[32 * g + crow(r, hi)]; n0 = n0 < 0 ? 0 : (n0 > 128 ? 128 : n0); sc[g][r] += bt[n0]; }
            } }
            asm volatile("s_nop 15\n\ts_nop 7" : "+v"(sc[0]), "+v"(sc[1]), "+v"(sc[2]), "+v"(sc[3]));
            if (k0 + 127 > q0w) {
#pragma unroll
                for (int g = 0; g < 4; ++g)
#pragma unroll
                    for (int r = 0; r < 16; ++r) { if (k0 + 32 * g + crow(r, hi) > qi) sc[g][r] = -1e30f; }
            }
            const float mx = swapmax(vmax3(max32(sc[0], sc[1]), max32(sc[2], sc[3]), -1e30f));
            const bool up = (t == 0) || mx > 8.0f;
            float al = 1.f;
            if (__builtin_amdgcn_ballot_w64(up) != 0ull) {
                const float dl = up ? mx : 0.f; al = __builtin_amdgcn_exp2f(-dl); l1 *= al; m1 += dl;
#pragma unroll
                for (int r = 0; r < 16; ++r) negm[r] -= dl;
#pragma unroll
                for (int g = 0; g < 4; ++g)
#pragma unroll
                    for (int r = 0; r < 16; ++r) sc[g][r] -= dl;
            }
            float ls = 0.f;
#pragma unroll
            for (int g = 0; g < 4; ++g)
#pragma unroll
                for (int r = 0; r < 16; ++r) { sc[g][r] = __builtin_amdgcn_exp2f(sc[g][r]); ls += sc[g][r]; }
            l1 += ls;
            bf16x8 pf[8];
#pragma unroll
            for (int g = 0; g < 4; ++g) { pf[2 * g] = pack8(sc[g], 0); pf[2 * g + 1] = pack8(sc[g], 8); }
            if (__builtin_amdgcn_ballot_w64(al != 1.0f) != 0ull) {
#pragma unroll
                for (int d = 0; d < 2; ++d)
#pragma unroll
                    for (int r = 0; r < 16; ++r) oA[d][r] *= al;
            }
            if (!DIFF) {
                bf16x8 vq[16];
#pragma unroll
                for (int i = 0; i < 16; ++i) { const int d = i & 1, s = i >> 1; const s16x4 lo = vtr(vb_ + d * 8192 + s * 1024), hh = vtr(vb_ + d * 8192 + s * 1024 + 512); vq[i] = (bf16x8){lo[0], lo[1], lo[2], lo[3], hh[0], hh[1], hh[2], hh[3]}; }
#pragma unroll
                for (int i = 0; i < 16; ++i) oA[i & 1] = __builtin_amdgcn_mfma_f32_32x32x16_bf16(vq[i], pf[i >> 1], oA[i & 1], 0, 0, 0);
                __builtin_amdgcn_sched_group_barrier(0x100, 4, 0);
#pragma unroll
                for (int i = 0; i < 14; ++i) { __builtin_amdgcn_sched_group_barrier(0x008, 1, 0); __builtin_amdgcn_sched_group_barrier(0x100, 2, 0); }
                __builtin_amdgcn_sched_group_barrier(0x008, 2, 0);
                __builtin_amdgcn_sched_barrier(0);
            } else {
#pragma unroll
            for (int d = 0; d < 2; ++d) {
                bf16x8 vf[8];
#pragma unroll
                for (int s = 0; s < 8; ++s) { const s16x4 lo = vtr(vb_ + d * 8192 + s * 1024), hh = vtr(vb_ + d * 8192 + s * 1024 + 512); vf[s] = (bf16x8){lo[0], lo[1], lo[2], lo[3], hh[0], hh[1], hh[2], hh[3]}; }
                __builtin_amdgcn_sched_barrier(0);
#pragma unroll
                for (int s = 0; s < 8; ++s) oA[d] = __builtin_amdgcn_mfma_f32_32x32x16_bf16(vf[s], pf[s], oA[d], 0, 0, 0);
                __builtin_amdgcn_sched_barrier(0);
            }
            }
        };
        int t = 0;
        for (; t + 2 < NT; ++t) {
            const int buf = t & 1;
            if (t < NTW) compute(t, buf);
            lstore(buf ^ 1); gload(t + 2);
            TILE_BAR();
        }
        for (; t < NT; ++t) {
            const int buf = t & 1;
            if (t < NTW) compute(t, buf);
            if (t + 1 < NT) lstore(buf ^ 1);
            TILE_BAR();
        }
        il = 1.f / swapadd(l1);
        if (DIFF) { if (mp == 0) {
#pragma unroll
            for (int d = 0; d < 2; ++d)
#pragma unroll
                for (int r = 0; r < 16; ++r) osv[(d * 16 + r) * 64] = oA[d][r] * il; } }
    }
    GAS bf16* orow = P.O + (rowb + qi) * P.op + h * 64;
    if (!DIFF) {
#pragma unroll
        for (int d = 0; d < 2; ++d)
#pragma unroll
            for (int g = 0; g < 4; ++g) { v2u v; v.x = cvtpk(oA[d][4 * g] * il, oA[d][4 * g + 1] * il); v.y = cvtpk(oA[d][4 * g + 2] * il, oA[d][4 * g + 3] * il); *(GAS v2u*)(orow + 32 * d + 8 * g + 4 * hi) = v; }
    } else {
        const float lam = P.lams[0], lam_init = P.lams[1];
        const float i2 = lam * il;
        float ss = 0.f;
#pragma unroll
        for (int d = 0; d < 2; ++d)
#pragma unroll
            for (int r = 0; r < 16; ++r) { const float v = osv[(d * 16 + r) * 64] - oA[d][r] * i2; oA[d][r] = v; ss += v * v; }
        ss = swapadd(ss);
        const float rs = __builtin_amdgcn_rsqf(ss * (1.f / 64.f) + 1e-6f) * (1.f - lam_init);
        const LAS float* dn = (const LAS float*)(lds + C::DN);
#pragma unroll
        for (int d = 0; d < 2; ++d)
#pragma unroll
            for (int g = 0; g < 4; ++g) { const int c = 32 * d + 8 * g + 4 * hi; const f32x4 gn = *(const LAS f32x4*)(dn + c);
                v2u v; v.x = cvtpk(oA[d][4 * g] * rs * gn[0], oA[d][4 * g + 1] * rs * gn[1]); v.y = cvtpk(oA[d][4 * g + 2] * rs * gn[2], oA[d][4 * g + 3] * rs * gn[3]); *(GAS v2u*)(orow + c) = v; }
    }
}

struct AKD {
    static constexpr int KP = 144, KB = 64 * KP, VB = 2 * 4096;
    static constexpr int K0 = 0, V0 = 2 * KB, POS = V0 + 2 * VB, PMX = POS + 512, BT = PMX + 16, DN = BT + 528, END = DN + 256;
};
static_assert(AKD::END <= RING_BYTES, "attention LDS (merged differential maps)");
__device__ __forceinline__ void attn_diff_unit(const AttnP& P, int b, int h, int qb, LAS unsigned char* lds, int wave) {
    const int lane = lane_id_v(), tid = (wave << 6) | lane;
    typedef AKD C;
    constexpr int KP = C::KP;
    const int r32 = lane & 31, hi = lane >> 5;
    const size_t rowb = (size_t)b * S;
    const int q0w = qb * 256 + wave * 32, qi = q0w + r32;
    __syncthreads();
    const int pq = P.pos[rowb + qi];
    if (tid < 129) ((LAS float*)(lds + C::BT))[tid] = P.btab[h * 129 + tid];
    if (tid >= 192 && tid < 256) ((LAS float*)(lds + C::DN))[tid - 192] = P.dnorm[tid - 192];
    const int minq = __builtin_amdgcn_readfirstlane(-wave_max_i(-pq));
    const int NT = 4 * (qb + 1);
    const GAS bf16* Kb = P.K + rowb * P.kp + h * 64; const GAS bf16* Vb = P.V + rowb * P.vp + h * 64;
    const __amdgpu_buffer_rsrc_t rK = __builtin_amdgcn_make_buffer_rsrc((void*)Kb, 0, 0x7fffffff, 0x00020000), rV = __builtin_amdgcn_make_buffer_rsrc((void*)Vb, 0, 0x7fffffff, 0x00020000);
    const __amdgpu_buffer_rsrc_t rP = __builtin_amdgcn_make_buffer_rsrc((void*)(P.pos + rowb), 0, 0x7fffffff, 0x00020000);
    const int skey = tid >> 3, spart = tid & 7;
    const int kvo = (skey * P.kp + spart * 8) * 2, vvo = (skey * P.vp + spart * 8) * 2, klo = skey * KP + spart * 16, vlo = (spart >> 2) * 4096 + (skey >> 3) * 512 + (skey & 7) * 64 + (spart & 3) * 16;
    const int pvo = (tid & 63) * 4;
    u32x4 kr, vr; int pkr = 0;
    auto gload = [&](int t) {
        kr = __builtin_amdgcn_raw_buffer_load_b128(rK, kvo, __builtin_amdgcn_readfirstlane(64 * t * P.kp * 2), 0);
        vr = __builtin_amdgcn_raw_buffer_load_b128(rV, vvo, __builtin_amdgcn_readfirstlane(64 * t * P.vp * 2), 0);
        pkr = __builtin_amdgcn_raw_buffer_load_b32(rP, pvo, __builtin_amdgcn_readfirstlane(64 * t * 4), 0);
    };
    auto lstore = [&](int buf) {
        *(LAS u32x4*)(lds + C::K0 + buf * C::KB + klo) = kr; *(LAS u32x4*)(lds + C::V0 + buf * C::VB + vlo) = vr;
        if (tid < 64) { ((LAS int*)(lds + C::POS + buf * 256))[tid] = pkr; const int mk_ = wave_max_i(pkr); if (lane == 0) ((LAS int*)(lds + C::PMX))[buf] = mk_; }
    };
    gload(0);
    bf16x8 qf[2][2];
    { const GAS bf16* qrow = P.Q + (rowb + qi) * P.qp + h * 64;
#pragma unroll
      for (int mp = 0; mp < 2; ++mp)
#pragma unroll
          for (int s_ = 0; s_ < 2; ++s_) qf[mp][s_] = *(const GAS bf16x8*)(qrow + 32 * mp + 16 * s_ + 8 * hi); }
    __syncthreads();
    lstore(0);
    if (NT > 1) gload(1);
    __syncthreads();
    const float bias_far = ((LAS float*)(lds + C::BT))[128];
    float m_[2] = {0.f, 0.f}, l_[2] = {0.f, 0.f};
    f32x16 negm[2], oA[2][2];
#pragma unroll
    for (int mp = 0; mp < 2; ++mp) {
#pragma unroll
        for (int r = 0; r < 16; ++r) { negm[mp][r] = bias_far; oA[mp][0][r] = 0.f; oA[mp][1][r] = 0.f; } }
    const int NTW = (q0w + 31) / 64 + 1;
    auto compute = [&](int t, int buf) {
        const int k0 = 64 * t;
        const LAS unsigned char* kb_ = lds + C::K0 + buf * C::KB + r32 * KP + hi * 16;
        const LAS unsigned char* vb_ = lds + C::V0 + buf * C::VB + ((lane >> 4) & 1) * 32 + (lane & 3) * 8 + (4 * hi + ((lane & 15) >> 2)) * 64;
        const bool nearb = (minq - __builtin_amdgcn_readfirstlane(((const LAS int*)(lds + C::PMX))[buf])) < 128;
        const bool diag = k0 + 63 > q0w;
        bf16x8 pf[2][4];
#pragma unroll
        for (int mp = 0; mp < 2; ++mp) {
            f32x16 sc[2];
            bf16x8 kf[2][2];
#pragma unroll
            for (int g = 0; g < 2; ++g)
#pragma unroll
                for (int s_ = 0; s_ < 2; ++s_) kf[g][s_] = *(const LAS bf16x8*)(kb_ + 32 * g * KP + mp * 64 + s_ * 32);
            if (nearb) {
#pragma unroll
                for (int g = 0; g < 2; ++g) {
#pragma unroll
                    for (int r = 0; r < 16; ++r) sc[g][r] = -m_[mp];
#pragma unroll
                    for (int s_ = 0; s_ < 2; ++s_) sc[g] = __builtin_amdgcn_mfma_f32_32x32x16_bf16(kf[g][s_], qf[mp][s_], sc[g], 0, 0, 0); }
                const LAS int* pk = (const LAS int*)(lds + C::POS + buf * 256); const LAS float* bt = (const LAS float*)(lds + C::BT);
#pragma unroll
                for (int g = 0; g < 2; ++g)
#pragma unroll
                    for (int r = 0; r < 16; ++r) { int n0 = pq - pk[32 * g + crow(r, hi)]; n0 = n0 < 0 ? 0 : (n0 > 128 ? 128 : n0); sc[g][r] += bt[n0]; }
            } else {
#pragma unroll
                for (int g = 0; g < 2; ++g) { sc[g] = __builtin_amdgcn_mfma_f32_32x32x16_bf16(kf[g][0], qf[mp][0], negm[mp], 0, 0, 0); sc[g] = __builtin_amdgcn_mfma_f32_32x32x16_bf16(kf[g][1], qf[mp][1], sc[g], 0, 0, 0); }
            }
            asm volatile("s_nop 15\n\ts_nop 7" : "+v"(sc[0]), "+v"(sc[1]));
            if (diag) {
#pragma unroll
                for (int g = 0; g < 2; ++g)
#pragma unroll
                    for (int r = 0; r < 16; ++r) { if (k0 + 32 * g + crow(r, hi) > qi) sc[g][r] = -1e30f; }
            }
            const float mx = swapmax(vmax3(max32(sc[0], sc[1]), -1e30f, -1e30f));
            const bool up = (t == 0) || mx > 8.0f;
            if (__builtin_amdgcn_ballot_w64(up) != 0ull) {
                const float dl = up ? mx : 0.f; const float al = __builtin_amdgcn_exp2f(-dl); l_[mp] *= al; m_[mp] += dl;
#pragma unroll
                for (int r = 0; r < 16; ++r) negm[mp][r] -= dl;
#pragma unroll
                for (int g = 0; g < 2; ++g)
#pragma unroll
                    for (int r = 0; r < 16; ++r) sc[g][r] -= dl;
#pragma unroll
                for (int d = 0; d < 2; ++d)
#pragma unroll
                    for (int r = 0; r < 16; ++r) oA[mp][d][r] *= al;
            }
            float ls = 0.f;
#pragma unroll
            for (int g = 0; g < 2; ++g)
#pragma unroll
                for (int r = 0; r < 16; ++r) { sc[g][r] = __builtin_amdgcn_exp2f(sc[g][r]); ls += sc[g][r]; }
            l_[mp] += ls;
#pragma unroll
            for (int g = 0; g < 2; ++g) { pf[mp][2 * g] = pack8(sc[g], 0); pf[mp][2 * g + 1] = pack8(sc[g], 8); }
        }
#pragma unroll
        for (int d = 0; d < 2; ++d) {
            bf16x8 vf[4];
#pragma unroll
            for (int s_ = 0; s_ < 4; ++s_) { const s16x4 lo = vtr(vb_ + d * 4096 + s_ * 1024), hh = vtr(vb_ + d * 4096 + s_ * 1024 + 512); vf[s_] = (bf16x8){lo[0], lo[1], lo[2], lo[3], hh[0], hh[1], hh[2], hh[3]}; }
#pragma unroll
            for (int s_ = 0; s_ < 4; ++s_) { oA[0][d] = __builtin_amdgcn_mfma_f32_32x32x16_bf16(vf[s_], pf[0][s_], oA[0][d], 0, 0, 0); oA[1][d] = __builtin_amdgcn_mfma_f32_32x32x16_bf16(vf[s_], pf[1][s_], oA[1][d], 0, 0, 0); }
        }
    };
#pragma unroll 1
    for (int t = 0; t < NT; ++t) {
        const int buf = t & 1;
        if (t < NTW) compute(t, buf);
        if (t + 1 < NT) lstore(buf ^ 1);
        if (t + 2 < NT) gload(t + 2);
        TILE_BAR();
    }
    const float il1 = 1.f / swapadd(l_[0]), il2 = 1.f / swapadd(l_[1]);
    const float lam = P.lams[0], lam_init = P.lams[1];
    const float i2 = lam * il2;
    float ss = 0.f;
#pragma unroll
    for (int d = 0; d < 2; ++d)
#pragma unroll
        for (int r = 0; r < 16; ++r) { const float v = oA[0][d][r] * il1 - oA[1][d][r] * i2; oA[0][d][r] = v; ss += v * v; }
    ss = swapadd(ss);
    const float rs = __builtin_amdgcn_rsqf(ss * (1.f / 64.f) + 1e-6f) * (1.f - lam_init);
    const LAS float* dn = (const LAS float*)(lds + C::DN);
    GAS bf16* orow = P.O + (rowb + qi) * P.op + h * 64;
#pragma unroll
    for (int d = 0; d < 2; ++d)
#pragma unroll
        for (int g = 0; g < 4; ++g) { const int c = 32 * d + 8 * g + 4 * hi; const f32x4 gn = *(const LAS f32x4*)(dn + c);
            v2u v; v.x = cvtpk(oA[0][d][4 * g] * rs * gn[0], oA[0][d][4 * g + 1] * rs * gn[1]); v.y = cvtpk(oA[0][d][4 * g + 2] * rs * gn[2], oA[0][d][4 * g + 3] * rs * gn[3]); *(GAS v2u*)(orow + c) = v; }
}

__device__ __forceinline__ void attn_phase(const AttnP& PM, const AttnP& PD, LAS unsigned char* lds, int tid, int wave, int lane, int vcu, int G, int only = -1) {
    for (int i = vcu; i < 512; i += G) {
        if (only >= 0 && (i >> 8) != only) continue;
        const int kind = i >> 8, c = i & 255, bh = c >> 4, s = c & 15;
        if (kind == 0) {
#pragma unroll 1
            for (int k = 0; k < 2; ++k) attn_unit2<0>(PM, bh >> 2, bh & 3, k ? 31 - s : s, lds, tid, wave, lane);
        } else {
#pragma unroll 1
            for (int k = 0; k < 2; ++k) attn_diff_unit(PD, bh >> 2, bh & 3, k ? 31 - s : s, lds, wave);
        }
    }
}
__device__ __forceinline__ float cx_max16(const f32x16& p) { return fmaxf(fmaxf(fmaxf(fmaxf(p[0], p[1]), fmaxf(p[2], p[3])), fmaxf(fmaxf(p[4], p[5]), fmaxf(p[6], p[7]))), fmaxf(fmaxf(fmaxf(p[8], p[9]), fmaxf(p[10], p[11])), fmaxf(fmaxf(p[12], p[13]), fmaxf(p[14], p[15])))); }
__device__ __forceinline__ void cross_unit2(const AttnP& P, int b, int h, int qb, LAS unsigned char* lds, int wave) {
    const int lane = lane_id_v(), tid = (wave << 6) | lane;
    constexpr int KP = 528;
    const int r32 = lane & 31, hi = lane >> 5;
    const size_t rowb = (size_t)b * S, rowk = (size_t)b * MEM;
    const int qi = qb * 256 + wave * 32 + r32;
    const GAS bf16* Kb = P.K + rowk * P.kp + h * 256; const GAS bf16* Vb = P.V + rowk * P.vp + h * 256;
    const __amdgpu_buffer_rsrc_t rK = __builtin_amdgcn_make_buffer_rsrc((void*)Kb, 0, 0x7fffffff, 0x00020000), rV = __builtin_amdgcn_make_buffer_rsrc((void*)Vb, 0, 0x7fffffff, 0x00020000);
    const GAS bf16* qrow = P.Q + (rowb + qi) * P.qp + h * 256 + 8 * hi;
    bf16x8 qf[4];
#pragma unroll
    for (int s = 0; s < 4; ++s) qf[s] = *(const GAS bf16x8*)(qrow + 16 * s);
    { u32x4 st[16];
#pragma unroll
      for (int i = 0; i < 16; ++i) { const int c = tid + 512 * i; st[i] = __builtin_amdgcn_raw_buffer_load_b128(rK, ((c >> 5) * P.kp + (c & 31) * 8) * 2, 0, 0); }
      TILE_BAR();
#pragma unroll
      for (int i = 0; i < 16; ++i) { const int c = tid + 512 * i; *(LAS u32x4*)(lds + (c >> 5) * KP + (c & 31) * 16) = st[i]; } }
    __syncthreads();
    f32x16 sc[8];
#pragma unroll
    for (int g = 0; g < 8; ++g)
#pragma unroll
        for (int r = 0; r < 16; ++r) sc[g][r] = 0.f;
    const LAS unsigned char* kb_ = lds + r32 * KP + hi * 16;
#pragma unroll
    for (int c = 0; c < 4; ++c) {
        bf16x8 qn[4];
        if (c + 1 < 4) {
#pragma unroll
            for (int s = 0; s < 4; ++s) qn[s] = *(const GAS bf16x8*)(qrow + 64 * (c + 1) + 16 * s); }
#pragma unroll
        for (int g = 0; g < 8; ++g) { bf16x8 kf[4];
#pragma unroll
            for (int s = 0; s < 4; ++s) kf[s] = *(const LAS bf16x8*)(kb_ + 32 * g * KP + (4 * c + s) * 32);
#pragma unroll
            for (int s = 0; s < 4; ++s) sc[g] = __builtin_amdgcn_mfma_f32_32x32x16_bf16(kf[s], qf[s], sc[g], 0, 0, 0); }
        if (c + 1 < 4) {
#pragma unroll
            for (int s = 0; s < 4; ++s) qf[s] = qn[s]; }
    }
    float m = fmaxf(fmaxf(fmaxf(cx_max16(sc[0]), cx_max16(sc[1])), fmaxf(cx_max16(sc[2]), cx_max16(sc[3]))), fmaxf(fmaxf(cx_max16(sc[4]), cx_max16(sc[5])), fmaxf(cx_max16(sc[6]), cx_max16(sc[7]))));
    m = swapmax(m);
    float l = 0.f;
    bf16x8 pf[16];
#pragma unroll
    for (int g = 0; g < 8; ++g) {
#pragma unroll
        for (int r = 0; r < 16; ++r) { sc[g][r] = __builtin_amdgcn_exp2f(sc[g][r] - m); l += sc[g][r]; }
        pf[2 * g] = pack8(sc[g], 0); pf[2 * g + 1] = pack8(sc[g], 8); }
    const float il = 1.f / swapadd(l);
    { u32x4 st[16];
#pragma unroll
      for (int i = 0; i < 16; ++i) { const int c = tid + 512 * i; const int sub = c & 3, key = (c >> 2) & 255, dt = c >> 10; st[i] = __builtin_amdgcn_raw_buffer_load_b128(rV, (key * P.vp + dt * 32 + sub * 8) * 2, 0, 0); }
      TILE_BAR();
#pragma unroll
      for (int i = 0; i < 16; ++i) { const int c = tid + 512 * i; const int sub = c & 3, key = (c >> 2) & 255, dt = c >> 10; *(LAS u32x4*)(lds + dt * 16384 + (key >> 3) * 512 + (key & 7) * 64 + sub * 16) = st[i]; } }
    __syncthreads();
    const LAS unsigned char* vb_ = lds + ((lane >> 4) & 1) * 32 + (lane & 3) * 8 + (4 * hi + ((lane & 15) >> 2)) * 64;
    GAS bf16* orow = P.O + (rowb + qi) * P.op + h * 256;
#pragma unroll 1
    for (int dh = 0; dh < 2; ++dh) {
        f32x16 oA[4];
#pragma unroll
        for (int d = 0; d < 4; ++d)
#pragma unroll
            for (int r = 0; r < 16; ++r) oA[d][r] = 0.f;
#pragma unroll
        for (int d = 0; d < 4; ++d) {
#pragma unroll
            for (int sb = 0; sb < 2; ++sb) { bf16x8 vf[8];
#pragma unroll
                for (int s = 0; s < 8; ++s) { const s16x4 lo = vtr(vb_ + (4 * dh + d) * 16384 + (8 * sb + s) * 1024), hh = vtr(vb_ + (4 * dh + d) * 16384 + (8 * sb + s) * 1024 + 512); vf[s] = (bf16x8){lo[0], lo[1], lo[2], lo[3], hh[0], hh[1], hh[2], hh[3]}; }
#pragma unroll
                for (int s = 0; s < 8; ++s) oA[d] = __builtin_amdgcn_mfma_f32_32x32x16_bf16(vf[s], pf[8 * sb + s], oA[d], 0, 0, 0); } }
#pragma unroll
        for (int d = 0; d < 4; ++d)
#pragma unroll
            for (int g = 0; g < 4; ++g) { v2u v; v.x = cvtpk(oA[d][4 * g] * il, oA[d][4 * g + 1] * il); v.y = cvtpk(oA[d][4 * g + 2] * il, oA[d][4 * g + 3] * il); *(GAS v2u*)(orow + 128 * dh + 32 * d + 8 * g + 4 * hi) = v; }
    }
}
__device__ __forceinline__ void cross_phase(const AttnP& PC, LAS unsigned char* lds, int tid, int wave, int lane, int vcu, int G) {
#pragma unroll 1
    for (int i = vcu; i < 512; i += G) { const int bh = i >> 5; cross_unit2(PC, bh >> 2, bh & 3, i & 31, lds, wave); }
}


__device__ __forceinline__ float vmax2(float a, float b) { float r; asm("v_max_f32_e32 %0, %1, %2" : "=v"(r) : "v"(a), "v"(b)); return r; }
__device__ __forceinline__ float vmin2(float a, float b) { float r; asm("v_min_f32_e32 %0, %1, %2" : "=v"(r) : "v"(a), "v"(b)); return r; }
__device__ __forceinline__ void pad16(float (&a)[16]) {
    asm volatile("s_nop 1" : "+v"(a[0]), "+v"(a[1]), "+v"(a[2]), "+v"(a[3]), "+v"(a[4]), "+v"(a[5]), "+v"(a[6]), "+v"(a[7]), "+v"(a[8]), "+v"(a[9]), "+v"(a[10]), "+v"(a[11]), "+v"(a[12]), "+v"(a[13]), "+v"(a[14]), "+v"(a[15]));
}
__device__ __forceinline__ void sort16_desc(float (&a)[16]) {
#pragma unroll
    for (int k = 2; k <= 16; k <<= 1)
#pragma unroll
        for (int j = k >> 1; j > 0; j >>= 1)
#pragma unroll
            for (int i = 0; i < 16; ++i) { const int l = i ^ j; if (l > i) { const bool desc = ((i & k) == 0); const float hi_ = vmax2(a[i], a[l]), lo_ = vmin2(a[i], a[l]); a[i] = desc ? hi_ : lo_; a[l] = desc ? lo_ : hi_; } }
}
__device__ __forceinline__ void merge16_desc(float (&a)[16], const float (&b)[16]) {
#pragma unroll
    for (int i = 0; i < 16; ++i) a[i] = vmax2(a[i], b[15 - i]);
#pragma unroll
    for (int j = 8; j > 0; j >>= 1)
#pragma unroll
        for (int i = 0; i < 16; ++i) { const int l = i ^ j; if (l > i) { const float hi_ = vmax2(a[i], a[l]), lo_ = vmin2(a[i], a[l]); a[i] = hi_; a[l] = lo_; } }
}
__device__ __forceinline__ void top16_of_64(float (&g0)[16], float (&g1)[16], float (&g2)[16], float (&g3)[16]) {
    sort16_desc(g0); sort16_desc(g1); merge16_desc(g0, g1); sort16_desc(g2); sort16_desc(g3); merge16_desc(g2, g3); merge16_desc(g0, g2);
}
__device__ __forceinline__ float embed(float v, unsigned mask, unsigned id) { return __builtin_bit_cast(float, (__builtin_bit_cast(unsigned, v) & mask) | id); }
__device__ __forceinline__ float mkcand(float x, float y, unsigned id) { return embed(x + y, 0xFFFFFF00u, id); }

__device__ __forceinline__ void swap32(float& a, float& b) { asm volatile("v_nop\n\tv_nop\n\tv_permlane32_swap_b32 %0, %1" : "+v"(a), "+v"(b)); }
struct RouteP { const GAS bf16* QP; const GAS bf16* keys; GAS int* EX; GAS float* GW; };
constexpr int RT_KP = 144, RT_KEYS = 0, RT_SCR = 256 * RT_KP, RT_END = RT_SCR + 8 * 8192;
__device__ __forceinline__ void route_phase(const RouteP& P, LAS unsigned char* lds, int tid, int wave, int lane, int vcu, int G) {
    asm volatile("" : "+v"(tid), "+v"(lane));
    __syncthreads();
    for (int c = tid; c < 256 * 8; c += 512) { const int row = c >> 3, part = c & 7; *(LAS u32x4*)(lds + RT_KEYS + row * RT_KP + part * 16) = *(const u32x4*)(P.keys + row * 64 + part * 8); }
    __syncthreads();
    const int r32 = lane & 31, hi = lane >> 5;
    LAS int* scr = (LAS int*)(lds + RT_SCR + wave * 8192);
    for (int u = vcu; u < T / 32; u += G) {
        const size_t t = (size_t)u * 32 + r32; const int h = wave;
        float T2[2][16];
#pragma unroll
        for (int c = 0; c < 2; ++c) {
            bf16x8 qf[4];
            { const GAS bf16* q = P.QP + t * 1024 + h * 128 + c * 64 + 8 * hi;
#pragma unroll
              for (int s = 0; s < 4; ++s) qf[s] = *(const GAS bf16x8*)(q + 16 * s); }
            f32x16 sc[4];
#pragma unroll
            for (int m = 0; m < 4; ++m) {
#pragma unroll
                for (int r = 0; r < 16; ++r) sc[m][r] = 0.f;
#pragma unroll
                for (int s = 0; s < 4; ++s) { const bf16x8 a = *(const LAS bf16x8*)(lds + RT_KEYS + (c * 128 + 32 * m + r32) * RT_KP + s * 32 + hi * 16);
                    sc[m] = __builtin_amdgcn_mfma_f32_32x32x16_bf16(a, qf[s], sc[m], 0, 0, 0); }
            }
            float g0[16], g1[16], g2[16], g3[16];
            const unsigned h4 = 4u * (unsigned)hi;
#pragma unroll
            for (int r = 0; r < 16; ++r) { const unsigned kr_ = (unsigned)((r & 3) + 8 * (r >> 2));
                g0[r] = embed(sc[0][r], 0xFFFFFF80u, kr_ | h4); g1[r] = embed(sc[1][r], 0xFFFFFF80u, (32u + kr_) | h4); g2[r] = embed(sc[2][r], 0xFFFFFF80u, (64u + kr_) | h4); g3[r] = embed(sc[3][r], 0xFFFFFF80u, (96u + kr_) | h4); }
            top16_of_64(g0, g1, g2, g3);
            pad16(g0);
#pragma unroll
            for (int i = 0; i < 16; ++i) T2[c][i] = g0[i];
        }
        float A[16], Bv[16];
#pragma unroll
        for (int i = 0; i < 16; ++i) { A[i] = T2[0][i]; Bv[i] = T2[1][i]; swap32(A[i], Bv[i]); }
        merge16_desc(A, Bv);
        pad16(A);
        float T0[16], T1[16];
#pragma unroll
        for (int i = 0; i < 16; ++i) { T0[i] = A[i]; T1[i] = A[i]; swap32(T0[i], T1[i]); }
#pragma unroll
        for (int i = 0; i < 16; ++i) { scr[i * 64 + lane] = (int)(__builtin_bit_cast(unsigned, T0[i]) & 127u); scr[(16 + i) * 64 + lane] = (int)(__builtin_bit_cast(unsigned, T1[i]) & 127u);
            T0[i] = embed(T0[i], 0xFFFFFF80u, 0u); T1[i] = embed(T1[i], 0xFFFFFF80u, 0u); }
        float c0[16], c1[16], c2[16], c3[16];
        const float NINF = -__builtin_inff();
#pragma unroll
        for (int b = 0; b < 16; ++b) c0[b] = mkcand(T0[0], T1[b], (unsigned)b);
#pragma unroll
        for (int b = 0; b < 8; ++b) c1[b] = mkcand(T0[1], T1[b], 16u + b);
#pragma unroll
        for (int b = 0; b < 5; ++b) c1[8 + b] = mkcand(T0[2], T1[b], 32u + b);
#pragma unroll
        for (int b = 0; b < 3; ++b) c1[13 + b] = mkcand(T0[4], T1[b], 64u + b);
#pragma unroll
        for (int b = 0; b < 4; ++b) c2[b] = mkcand(T0[3], T1[b], 48u + b);
        c2[4] = mkcand(T0[5], T1[0], 80u); c2[5] = mkcand(T0[5], T1[1], 81u); c2[6] = mkcand(T0[6], T1[0], 96u); c2[7] = mkcand(T0[6], T1[1], 97u); c2[8] = mkcand(T0[7], T1[0], 112u); c2[9] = mkcand(T0[7], T1[1], 113u);
#pragma unroll
        for (int a = 8; a < 14; ++a) c2[10 + a - 8] = mkcand(T0[a], T1[0], 16u * a);
        c3[0] = mkcand(T0[14], T1[0], 224u); c3[1] = mkcand(T0[15], T1[0], 240u);
#pragma unroll
        for (int i = 2; i < 16; ++i) c3[i] = NINF;
        top16_of_64(c0, c1, c2, c3);
        pad16(c0);
        float gsum = 0.f, ge[16]; int ex[16];
        const float mtop = embed(c0[0], 0xFFFFFF00u, 0u);
#pragma unroll
        for (int i = 0; i < 16; ++i) { const unsigned bits = __builtin_bit_cast(unsigned, c0[i]); const int a = (bits >> 4) & 15, b = bits & 15;
            ge[i] = __builtin_amdgcn_exp2f((embed(c0[i], 0xFFFFFF00u, 0u) - mtop) * LOG2E); gsum += ge[i];
            ex[i] = scr[a * 64 + lane] * 128 + scr[(16 + b) * 64 + lane]; }
        const float ginv = __builtin_amdgcn_rcpf(gsum);
        if (hi == 0) { GAS unsigned short* d = (GAS unsigned short*)P.EX + t * 128 + h * 16;
#pragma unroll
            for (int i = 0; i < 16; ++i) d[i] = (unsigned short)ex[i]; }
        else { GAS f32x4* d = (GAS f32x4*)(P.GW + t * 128 + h * 16);
#pragma unroll
            for (int i = 0; i < 4; ++i) d[i] = (f32x4){ge[4 * i] * ginv, ge[4 * i + 1] * ginv, ge[4 * i + 2] * ginv, ge[4 * i + 3] * ginv}; }
    }
}

__device__ __forceinline__ int wave_allsum_i(int v) {
    v += __builtin_amdgcn_update_dpp(0, v, 0xB1, 0xF, 0xF, true);
    v += __builtin_amdgcn_update_dpp(0, v, 0x4E, 0xF, 0xF, true);
    v += __builtin_amdgcn_update_dpp(0, v, 0x141, 0xF, 0xF, true);
    v += __builtin_amdgcn_update_dpp(0, v, 0x140, 0xF, 0xF, true);
    { int a = v, b = v; asm volatile("v_nop\n\tv_nop\n\tv_permlane16_swap_b32 %0, %1" : "+v"(a), "+v"(b)); v = a + b; }
    { int a = v, b = v; asm volatile("v_nop\n\tv_nop\n\tv_permlane32_swap_b32 %0, %1" : "+v"(a), "+v"(b)); v = a + b; }
    return v;
}
__device__ __forceinline__ float wave_allsum(float v) {
    v += __builtin_bit_cast(float, __builtin_amdgcn_update_dpp(0, __builtin_bit_cast(int, v), 0xB1, 0xF, 0xF, true));
    v += __builtin_bit_cast(float, __builtin_amdgcn_update_dpp(0, __builtin_bit_cast(int, v), 0x4E, 0xF, 0xF, true));
    v += __builtin_bit_cast(float, __builtin_amdgcn_update_dpp(0, __builtin_bit_cast(int, v), 0x141, 0xF, 0xF, true));
    v += __builtin_bit_cast(float, __builtin_amdgcn_update_dpp(0, __builtin_bit_cast(int, v), 0x140, 0xF, 0xF, true));
    { float a = v, b = v; asm volatile("v_nop\n\tv_nop\n\tv_permlane16_swap_b32 %0, %1" : "+v"(a), "+v"(b)); v = a + b; }
    { float a = v, b = v; asm volatile("v_nop\n\tv_nop\n\tv_permlane32_swap_b32 %0, %1" : "+v"(a), "+v"(b)); v = a + b; }
    return v;
}
__device__ __forceinline__ float wave_allmax(float v) {
    v = fmaxf(v, __builtin_bit_cast(float, __builtin_amdgcn_update_dpp(0, __builtin_bit_cast(int, v), 0xB1, 0xF, 0xF, true)));
    v = fmaxf(v, __builtin_bit_cast(float, __builtin_amdgcn_update_dpp(0, __builtin_bit_cast(int, v), 0x4E, 0xF, 0xF, true)));
    v = fmaxf(v, __builtin_bit_cast(float, __builtin_amdgcn_update_dpp(0, __builtin_bit_cast(int, v), 0x141, 0xF, 0xF, true)));
    v = fmaxf(v, __builtin_bit_cast(float, __builtin_amdgcn_update_dpp(0, __builtin_bit_cast(int, v), 0x140, 0xF, 0xF, true)));
    { float a = v, b = v; asm volatile("v_nop\n\tv_nop\n\tv_permlane16_swap_b32 %0, %1" : "+v"(a), "+v"(b)); v = fmaxf(a, b); }
    { float a = v, b = v; asm volatile("v_nop\n\tv_nop\n\tv_permlane32_swap_b32 %0, %1" : "+v"(a), "+v"(b)); v = fmaxf(a, b); }
    return v;
}
__device__ __forceinline__ unsigned q4(float a, float b, float c, float d, int off) {
    const int ia = (int)__builtin_rintf(a) + off, ib = (int)__builtin_rintf(b) + off, ic = (int)__builtin_rintf(c) + off, id = (int)__builtin_rintf(d) + off;
    return (unsigned)(ia & 255) | ((unsigned)(ib & 255) << 8) | ((unsigned)(ic & 255) << 16) | ((unsigned)(id & 255) << 24);
}
__device__ __forceinline__ void quant_row(const GAS float* src, GAS unsigned* dst, GAS float* scale, int off, int lane) {
    const GAS f32x4* s = (const GAS f32x4*)src + 4 * lane; f32x4 v[4]; float m = 0.f;
#pragma unroll
    for (int i = 0; i < 4; ++i) { v[i] = s[i]; m = fmaxf(m, fmaxf(fmaxf(__builtin_fabsf(v[i].x), __builtin_fabsf(v[i].y)), fmaxf(__builtin_fabsf(v[i].z), __builtin_fabsf(v[i].w)))); }
    m = wave_allmax(m); const float inv = m > 0.f ? 127.f / m : 0.f;
    v4u w;
    w.x = q4(v[0].x * inv, v[0].y * inv, v[0].z * inv, v[0].w * inv, off); w.y = q4(v[1].x * inv, v[1].y * inv, v[1].z * inv, v[1].w * inv, off);
    w.z = q4(v[2].x * inv, v[2].y * inv, v[2].z * inv, v[2].w * inv, off); w.w = q4(v[3].x * inv, v[3].y * inv, v[3].z * inv, v[3].w * inv, off);
    *((GAS v4u*)dst + lane) = w;
    if (lane == 0) *scale = m * (1.f / 127.f);
}
struct PeerS { int nslices_step, first_slice, nloc, rank; };
__device__ __forceinline__ PeerS peer_sched(const GAS unsigned* rankw, int xcc, int rank) {
    const int lane = lane_id_v();
    const int c = lane < 16 ? (int)__hip_atomic_load(rankw + 64 * lane, __ATOMIC_RELAXED, __HIP_MEMORY_SCOPE_AGENT) : 0;
    const unsigned long long m = __builtin_amdgcn_ballot_w64(c > 0);
    const int nx = __builtin_popcountll(m), myidx = __builtin_popcountll(m & ((1ull << xcc) - 1ull));
    const int cm = __builtin_amdgcn_readlane(c, xcc);
    PeerS s; s.nslices_step = nx > 0 ? nx : 1; s.first_slice = myidx; s.nloc = cm > 0 ? cm : 1; s.rank = rank; return s;
}
struct Peer1P { const GAS unsigned GAS char* HQ; const GAS int* EX; const GAS unsigned GAS char* U8; GAS int* P; };
__device__ __forceinline__ void peer_k1(const Peer1P& Q, const PeerS& sc, int wave, int lane) {
    asm volatile("" : "+v"(lane));
    const int g = lane >> 3, j = lane & 7;
    const __amdgpu_buffer_rsrc_t rU = __builtin_amdgcn_make_buffer_rsrc((void*)Q.U8, 0, 0x7fffffff, 0x00020000);
    for (int s = sc.first_slice; s < 8; s += sc.nslices_step)
        for (int tile = sc.rank; tile < T / 64; tile += sc.nloc) {
            const int soff_ = __builtin_amdgcn_readfirstlane(128 * s);
            const size_t t0 = (size_t)tile * 64 + wave * 8;
            v4u hqn = *(const GAS v4u*)(Q.HQ + t0 * 1024 + 128 * s + 16 * j), exn[2];
#pragma unroll
            for (int i = 0; i < 2; ++i) exn[i] = *(const GAS v4u*)(Q.EX + t0 * 64 + 8 * g + 4 * i);
#pragma unroll 1
            for (int k = 0; k < 8; ++k) {
                const size_t t = t0 + k;
                const v4u hq = hqn; v4u ex[2];
#pragma unroll
                for (int i = 0; i < 2; ++i) ex[i] = exn[i];
                if (k + 1 < 8) {
                    hqn = *(const GAS v4u*)(Q.HQ + (t + 1) * 1024 + 128 * s + 16 * j);
#pragma unroll
                    for (int i = 0; i < 2; ++i) exn[i] = *(const GAS v4u*)(Q.EX + (t + 1) * 64 + 8 * g + 4 * i);
                }
                v4u uu[16];
#pragma unroll
                for (int i = 0; i < 16; ++i) { const unsigned ew = ((i >> 1) & 3) == 0 ? ex[i >> 3].x : ((i >> 1) & 3) == 1 ? ex[i >> 3].y : ((i >> 1) & 3) == 2 ? ex[i >> 3].z : ex[i >> 3].w; unsigned e; if (i & 1) asm("v_lshrrev_b32 %0, 16, %1" : "=v"(e) : "v"(ew)); else asm("v_and_b32 %0, 0xffff, %1" : "=v"(e) : "v"(ew));
                    uu[i] = __builtin_bit_cast(v4u, __builtin_amdgcn_raw_buffer_load_b128(rU, (int)((e << 10) + 16u * (unsigned)j), soff_, 0)); }
                int lo = 0, hi = 0;
#pragma unroll
                for (int i = 0; i < 16; ++i) {
                    int p = __builtin_amdgcn_sdot4((int)uu[i].x, (int)hq.x, 0, false); p = __builtin_amdgcn_sdot4((int)uu[i].y, (int)hq.y, p, false); p = __builtin_amdgcn_sdot4((int)uu[i].z, (int)hq.z, p, false); p = __builtin_amdgcn_sdot4((int)uu[i].w, (int)hq.w, p, false);
                    p += __builtin_amdgcn_update_dpp(0, p, 0xB1, 0xF, 0xF, true); p += __builtin_amdgcn_update_dpp(0, p, 0x4E, 0xF, 0xF, true); p += __builtin_amdgcn_update_dpp(0, p, 0x141, 0xF, 0xF, true);
                    if (i < 8) lo = (j == i) ? p : lo; else hi = (j == i - 8) ? p : hi;
                }
                Q.P[(t * 8 + s) * 64 + 8 * g + j] = (int)__builtin_amdgcn_perm((unsigned)((hi + 32) >> 6), (unsigned)((lo + 32) >> 6), 0x05040100u);
            }
        }
}
__device__ __forceinline__ void peer_w(const GAS int* EX, const GAS float* GW, const GAS int* P, const GAS float* SH, const GAS float* SU, const GAS float* SV, GAS signed char* WQ, GAS float* WSC, int gw, int NGW, int lane,
                                       LAS unsigned char* lds, int tid) {
    asm volatile("" : "+v"(lane), "+v"(tid));
    LAS float* su_l = (LAS float*)lds; LAS float* sv_l = su_l + 16384;
#pragma unroll 4
    for (int i = tid; i < 4096; i += 512) { ((LAS f32x4*)su_l)[i] = ((const GAS f32x4*)SU)[i]; ((LAS f32x4*)sv_l)[i] = ((const GAS f32x4*)SV)[i]; }
    __syncthreads();
    for (int t = gw; t < T; t += NGW) {
        const float sh = SH[t];
#pragma unroll
        for (int q = 0; q < 2; ++q) { const size_t idx = (size_t)t * 128 + lane + 64 * q; const int e = (int)((const GAS unsigned short*)EX)[idx];
            const int slot_ = lane + 64 * q, pix_ = (slot_ >> 4) * 8 + (slot_ & 7), hsel_ = (slot_ >> 3) & 1;
            int pd = 0;
#pragma unroll
            for (int sl = 0; sl < 8; ++sl) { const int pw_ = P[((size_t)t * 8 + sl) * 64 + pix_]; pd += hsel_ ? (pw_ >> 16) : (int)(short)(pw_ & 0xffff); }
            const float w = GW[idx] * gelu_erf((float)pd * (64.f * sh * su_l[e])) * sv_l[e];
            float m = __builtin_fabsf(w);
            m = fmaxf(m, __builtin_bit_cast(float, __builtin_amdgcn_update_dpp(0, __builtin_bit_cast(int, m), 0xB1, 0xF, 0xF, true)));
            m = fmaxf(m, __builtin_bit_cast(float, __builtin_amdgcn_update_dpp(0, __builtin_bit_cast(int, m), 0x4E, 0xF, 0xF, true)));
            m = fmaxf(m, __builtin_bit_cast(float, __builtin_amdgcn_update_dpp(0, __builtin_bit_cast(int, m), 0x141, 0xF, 0xF, true)));
            m = fmaxf(m, __builtin_bit_cast(float, __builtin_amdgcn_update_dpp(0, __builtin_bit_cast(int, m), 0x140, 0xF, 0xF, true)));
            const float inv = m > 0.f ? 127.f / m : 0.f;
            const unsigned wb = (unsigned)((int)__builtin_rintf(w * inv)) & 255u;
            const unsigned b1 = (unsigned)__builtin_amdgcn_update_dpp(0, (int)wb, 0x55, 0xF, 0xF, true), b2 = (unsigned)__builtin_amdgcn_update_dpp(0, (int)wb, 0xAA, 0xF, 0xF, true), b3 = (unsigned)__builtin_amdgcn_update_dpp(0, (int)wb, 0xFF, 0xF, 0xF, true);
            if ((lane & 3) == 0) ((GAS unsigned*)WQ)[idx >> 2] = wb | (b1 << 8) | (b2 << 16) | (b3 << 24);
            if ((lane & 15) == 0) WSC[(size_t)t * 8 + (lane >> 4) + 4 * q] = m * (1.f / 127.f); }
    }
}
__device__ __forceinline__ void tr4x4(unsigned r0, unsigned r1, unsigned r2, unsigned r3, unsigned (&t)[4]) {
    const unsigned x0 = __builtin_amdgcn_perm(r1, r0, 0x05010400u), x1 = __builtin_amdgcn_perm(r1, r0, 0x07030602u), y0 = __builtin_amdgcn_perm(r3, r2, 0x05010400u), y1 = __builtin_amdgcn_perm(r3, r2, 0x07030602u);
    t[0] = __builtin_amdgcn_perm(y0, x0, 0x05040100u); t[1] = __builtin_amdgcn_perm(y0, x0, 0x07060302u); t[2] = __builtin_amdgcn_perm(y1, x1, 0x05040100u); t[3] = __builtin_amdgcn_perm(y1, x1, 0x07060302u);
}
struct Peer2P { const GAS int* EX; const GAS signed char* WQ; const GAS float* WSC; const GAS unsigned char* V8; GAS bf16* XB; GAS float* SSQ; };
__device__ __forceinline__ void peer_k2(const Peer2P& Q, const PeerS& sc, int wave, int lane) {
    asm volatile("" : "+v"(lane));
    const int g = lane >> 3, j = lane & 7, hf = lane >> 5, rp = (lane >> 4) & 1;
    const __amdgpu_buffer_rsrc_t rV = __builtin_amdgcn_make_buffer_rsrc((void*)Q.V8, 0, 0x7fffffff, 0x00020000);
    for (int s = sc.first_slice; s < 8; s += sc.nslices_step)
        for (int tile = sc.rank; tile < T / 64; tile += sc.nloc) {
            const int soff_ = __builtin_amdgcn_readfirstlane(128 * s);
            const size_t t0 = (size_t)tile * 64 + wave * 8;
            v4u exn[2], wqn; float swn;
#pragma unroll
            for (int i = 0; i < 2; ++i) exn[i] = *(const GAS v4u*)(Q.EX + t0 * 64 + 8 * g + 4 * i);
            wqn = *(const GAS v4u*)(Q.WQ + t0 * 128 + 16 * g); swn = Q.WSC[t0 * 8 + g];
#pragma unroll 1
            for (int k = 0; k < 8; ++k) {
                const size_t t = t0 + k;
                v4u ex[2]; const v4u wq = wqn; const float sw = swn;
#pragma unroll
                for (int i = 0; i < 2; ++i) ex[i] = exn[i];
                if (k + 1 < 8) {
#pragma unroll
                    for (int i = 0; i < 2; ++i) exn[i] = *(const GAS v4u*)(Q.EX + (t + 1) * 64 + 8 * g + 4 * i);
                    wqn = *(const GAS v4u*)(Q.WQ + (t + 1) * 128 + 16 * g); swn = Q.WSC[(t + 1) * 8 + g];
                }
                GAS v2u* xp = (GAS v2u*)(Q.XB + t * 1024 + 128 * s + 16 * j + 8 * hf + 4 * rp);
                const v2u xold = *xp;
                v4u vv[16];
#pragma unroll
                for (int i = 0; i < 16; ++i) { const unsigned ew = ((i >> 1) & 3) == 0 ? ex[i >> 3].x : ((i >> 1) & 3) == 1 ? ex[i >> 3].y : ((i >> 1) & 3) == 2 ? ex[i >> 3].z : ex[i >> 3].w; unsigned e; if (i & 1) asm("v_lshrrev_b32 %0, 16, %1" : "=v"(e) : "v"(ew)); else asm("v_and_b32 %0, 0xffff, %1" : "=v"(e) : "v"(ew));
                    vv[i] = __builtin_bit_cast(v4u, __builtin_amdgcn_raw_buffer_load_b128(rV, (int)((e << 10) + 16u * (unsigned)j), soff_, 0)); }
                int ai[16];
#pragma unroll
                for (int i = 0; i < 16; ++i) ai[i] = 0;
#pragma unroll
                for (int q4_ = 0; q4_ < 4; ++q4_) {
                    const unsigned wq4 = q4_ == 0 ? wq.x : q4_ == 1 ? wq.y : q4_ == 2 ? wq.z : wq.w;
#pragma unroll
                    for (int c = 0; c < 4; ++c) { unsigned tt[4];
                        const v4u &a0 = vv[4 * q4_], &a1 = vv[4 * q4_ + 1], &a2 = vv[4 * q4_ + 2], &a3 = vv[4 * q4_ + 3];
                        tr4x4(c == 0 ? a0.x : c == 1 ? a0.y : c == 2 ? a0.z : a0.w, c == 0 ? a1.x : c == 1 ? a1.y : c == 2 ? a1.z : a1.w, c == 0 ? a2.x : c == 1 ? a2.y : c == 2 ? a2.z : a2.w, c == 0 ? a3.x : c == 1 ? a3.y : c == 2 ? a3.z : a3.w, tt);
#pragma unroll
                        for (int b = 0; b < 4; ++b) ai[4 * c + b] = __builtin_amdgcn_sdot4((int)tt[b], (int)wq4, ai[4 * c + b], false); }
                }
                float acc[16];
#pragma unroll
                for (int i = 0; i < 16; ++i) acc[i] = (float)ai[i] * sw;
                float r8[8], r4[4];
#pragma unroll
                for (int m = 0; m < 8; ++m) { float a = acc[m], b = acc[m + 8]; swap32(a, b); r8[m] = a + b; }
#pragma unroll
                for (int n = 0; n < 4; ++n) { float a = r8[n], b = r8[n + 4]; asm volatile("v_nop\n\tv_nop\n\tv_permlane16_swap_b32 %0, %1" : "+v"(a), "+v"(b)); r4[n] = a + b; }
#pragma unroll
                for (int n = 0; n < 4; ++n) r4[n] += __builtin_bit_cast(float, __builtin_amdgcn_update_dpp(0, __builtin_bit_cast(int, r4[n]), 0x128, 0xF, 0xF, true));
                v2u xw; xw.x = pk2(bflo(xold.x) + r4[0], bfhi(xold.x) + r4[1]); xw.y = pk2(bflo(xold.y) + r4[2], bfhi(xold.y) + r4[3]);
                float ss = 0.f;
                if ((lane & 8) == 0) { const float x0 = bflo(xw.x), x1 = bfhi(xw.x), x2 = bflo(xw.y), x3 = bfhi(xw.y); ss = (x0 * x0 + x1 * x1) + (x2 * x2 + x3 * x3); *xp = xw; }
                ss = wave_allsum(ss);
                if (Q.SSQ) { if (lane == 0) Q.SSQ[t * 16 + s] = ss; }
            }
        }
}

struct Args { const float* in[33]; float* out; unsigned char* ws; int ph_lo, ph_hi; };
struct Frame { LAS unsigned char* lds; volatile LAS unsigned* MISC; gu32* ctl; int tid, lane, wave, G, vcu, xcc, xrank; };

__device__ __forceinline__ void transpose_item(const float* W, int ldw, int nsrc0, bf16* WT, int ldt, int rdst0, LAS float* scr, int kb, int nb, int lane, float scale, const float* kgain) {
    const int k0 = 64 * kb, n0 = 32 * nb;
#pragma unroll 8
    for (int i = 0; i < 32; ++i) { const int kk = 2 * i + (lane >> 5); const float gsc = kgain ? kgain[k0 + kk] * scale : scale; scr[kk * 33 + (lane & 31)] = W[(size_t)(k0 + kk) * ldw + nsrc0 + n0 + (lane & 31)] * gsc; }
    LDS_WAIT(); asm volatile("" ::: "memory");
    const int c = lane & 7;
#pragma unroll
    for (int j = 0; j < 4; ++j) { const int n = (lane >> 3) + 8 * j; const LAS float* s = scr + (8 * c) * 33 + n;
        v4u o; o.x = pk2(s[0 * 33], s[1 * 33]); o.y = pk2(s[2 * 33], s[3 * 33]); o.z = pk2(s[4 * 33], s[5 * 33]); o.w = pk2(s[6 * 33], s[7 * 33]);
        *(GAS v4u*)(WT + (size_t)(rdst0 + n0 + n) * ldt + k0 + 8 * c) = o; }
    LDS_WAIT(); asm volatile("" ::: "memory");
}
__device__ __forceinline__ void zero_rect(bf16* base, int ld, int row0, int nrows, int col0, int ncols, int gtid, int gthreads) {
    const int vpr = ncols / 8;
    for (int i = gtid; i < nrows * vpr; i += gthreads) { const int r = i / vpr, c = i % vpr; *(GAS v4u*)(base + (size_t)(row0 + r) * ld + col0 + 8 * c) = (v4u){0u, 0u, 0u, 0u}; }
}

__device__ __forceinline__ void p0_prologue(Frame& F, const Args& a) {
    LAS float* scr = (LAS float*)(F.lds + RING_OFF + F.wave * 16384);
    const int gw = blockIdx.x * NWAVES + F.wave, NGW = F.G * NWAVES;
    const int gtid = blockIdx.x * (NWAVES * 64) + F.tid, gthreads = F.G * NWAVES * 64;
    unsigned char* ws = a.ws;
    x0_phase((const GAS float*)a.in[0], (GAS bf16*)(ws + WS_XNB), (GAS float*)(ws + WS_SSQ), gw, NGW, F.lane);
    constexpr int I_IN = 16 * (INW / 32), I_SQ = 16 * 32, I_CKV = 16 * 64, I_UQ = 3 * 12, I_UKV = 2 * 16, I_L = I_IN + 4 * I_SQ + I_CKV + I_UQ + I_UKV;
    for (int it = gw; it < L * I_L; it += NGW) {
        const int l = it / I_L; int r = it % I_L;
        if (r < I_IN) {
            const int kb = r / 67, nb = r % 67; int src, dst; float sc = 1.f;
            if (nb < 6) { src = 32 * nb; dst = src; } else if (nb < 11) { src = 32 * nb; dst = src + 64; } else { src = 32 * nb; dst = src + 160; if (nb >= 43 && nb < 51) sc = 0.17677669529663687f * LOG2E; }
            transpose_item(a.in[5] + (size_t)l * D * INW, INW, src, (bf16*)(ws + WS_WIN) + (size_t)l * INP * D, D, dst, scr, kb, 0, F.lane, sc, a.in[4] + l * D); continue; } r -= I_IN;
        if (r < I_SQ) { transpose_item(a.in[21] + (size_t)l * D * D, D, 0, (bf16*)(ws + WS_WOUT) + (size_t)l * D * D, D, 0, scr, r / 32, r % 32, F.lane, 1.f, nullptr); continue; } r -= I_SQ;
        if (r < I_SQ) { transpose_item(a.in[24] + (size_t)l * D * D, D, 0, (bf16*)(ws + WS_WCQ) + (size_t)l * D * D, D, 0, scr, r / 32, r % 32, F.lane, 0.0625f * LOG2E, a.in[22] + l * D); continue; } r -= I_SQ;
        if (r < I_SQ) { transpose_item(a.in[26] + (size_t)l * D * D, D, 0, (bf16*)(ws + WS_WCO) + (size_t)l * D * D, D, 0, scr, r / 32, r % 32, F.lane, 1.f, nullptr); continue; } r -= I_SQ;
        if (r < I_SQ) { transpose_item(a.in[28] + (size_t)l * D * D, D, 0, (bf16*)(ws + WS_WPQ) + (size_t)l * D * D, D, 0, scr, r / 32, r % 32, F.lane, 1.f, a.in[27] + l * D); continue; } r -= I_SQ;
        if (r < I_CKV) { transpose_item(a.in[25] + (size_t)l * D * 2 * D, 2 * D, 0, (bf16*)(ws + WS_WCKV) + (size_t)l * 2 * D * D, D, 0, scr, r / 64, r % 64, F.lane, 1.f, nullptr); continue; } r -= I_CKV;
        if (r < I_UQ) { transpose_item(a.in[7] + (size_t)l * 192 * 384, 384, 0, (bf16*)(ws + WS_WUQ) + (size_t)l * 512 * 256, 256, 0, scr, r / 12, r % 12, F.lane, 0.10206207261596575f * LOG2E, a.in[6] + l * 192); continue; } r -= I_UQ;
        transpose_item(a.in[9] + (size_t)l * 128 * 512, 512, 0, (bf16*)(ws + WS_WUKV) + (size_t)l * 512 * 256, 256, 0, scr, r / 16, r % 16, F.lane, 1.f, a.in[8] + l * 128);
    }
    for (int l = 0; l < L; ++l) {
        bf16* win = (bf16*)(ws + WS_WIN) + (size_t)l * INP * D; bf16* wuq = (bf16*)(ws + WS_WUQ) + (size_t)l * 512 * 256; bf16* wukv = (bf16*)(ws + WS_WUKV) + (size_t)l * 512 * 256;
        zero_rect(win, D, 192, 64, 0, D, gtid, gthreads); zero_rect(win, D, 416, 96, 0, D, gtid, gthreads);
        zero_rect(wuq, 256, 0, 384, 192, 64, gtid, gthreads); zero_rect(wuq, 256, 384, 128, 0, 256, gtid, gthreads);
        zero_rect(wukv, 256, 0, 512, 128, 128, gtid, gthreads);
    }
    { float* rope = (float*)(ws + WS_ROPE); const int* pos = (const int*)a.in[2];
      for (int i = gtid; i < T * 16; i += gthreads) { const int t = i >> 4, k = i & 15; const float inv = powf(10000.f, -(float)(2 * k) / 32.f); const float ang = (float)pos[t] * inv;
          rope[(size_t)t * 32 + k] = cosf(ang); rope[(size_t)t * 32 + 16 + k] = sinf(ang); } }
    { const GAS f32x4* ks = (const GAS f32x4*)a.in[29]; GAS v2u* kd = (GAS v2u*)(ws + WS_KEYS);
      for (int i = gtid; i < L * 2 * 128 * 64 / 4; i += gthreads) { const f32x4 v = ks[i]; v2u w; w.x = pk2(v.x, v.y); w.y = pk2(v.z, v.w); kd[i] = w; }
    }
    for (int r = gw; r < 2 * L * 16384; r += NGW) { const int tb = r / (L * 16384), rr = r % (L * 16384);
        quant_row((const GAS float*)a.in[30 + tb] + (size_t)rr * 1024, (GAS unsigned*)(ws + (tb ? WS_V8 : WS_U8) + (size_t)rr * 1024), (GAS float*)(ws + (tb ? WS_SV : WS_SU)) + rr, 0, F.lane); }
    { float* btab = (float*)(ws + WS_BTAB); float* lams = (float*)(ws + WS_LAMS); float* spt = (float*)(ws + WS_SP);
      for (int i = gtid; i < 4 * 129; i += gthreads) { const int h = i / 129, n = i % 129; int bu; if (n < 16) bu = n; else { const int lg = 16 + (int)(logf((float)n / 16.f) / logf(8.f) * 16.f); bu = lg < 31 ? lg : 31; }
          btab[i] = a.in[3][bu * 4 + h] * LOG2E; }
      for (int i = gtid; i < L; i += gthreads) { const float* dl = a.in[17] + i * 128; float s1 = 0.f, s2 = 0.f; for (int j = 0; j < 32; ++j) { s1 += dl[j] * dl[32 + j]; s2 += dl[64 + j] * dl[96 + j]; }
          const float li = 0.8f - 0.6f * expf(-0.3f * (float)i); lams[2 * i] = expf(s1) - expf(s2) + li; lams[2 * i + 1] = li; }
      for (int i = gtid; i < L * 512; i += gthreads) spt[i] = log1pf(expf(-a.in[16][i])); }
    { GAS bf16* wat = (GAS bf16*)(ws + WS_WAT);
      for (int i = gtid; i < L * 8 * 2 * 4096; i += gthreads) { const int in_ = i & 63, out_ = (i >> 6) & 63, gate = (i >> 12) & 1, lg = i >> 13;
          wat[i] = (bf16)f2bf_(a.in[gate ? 14 : 12][(size_t)lg * 4096 + in_ * 64 + out_]); } }
    for (int l = 0; l < L; ++l) norm_phase((const GAS float*)a.in[1], (const GAS float*)a.in[23] + l * D, (GAS bf16*)(ws + WS_MNB) + (size_t)l * NB * MEM * D, NB * MEM, gw, NGW, F.lane);
}

constexpr int NPL = 16, PH_FINAL = 2 + NPL * L;
__global__ void __launch_bounds__(NWAVES * 64, 2) fwd(Args args) {
    extern __shared__ __attribute__((aligned(16))) unsigned char lds[];
    Frame F;
    F.lds = (LAS unsigned char*)lds; F.MISC = (volatile LAS unsigned*)(F.lds + MISC_OFF);
    F.tid = threadIdx.x; F.lane = F.tid & 63; F.wave = __builtin_amdgcn_readfirstlane(F.tid >> 6); F.G = gridDim.x;
    F.vcu = (F.G % 8 == 0) ? ((int)blockIdx.x % 8) * (F.G / 8) + (int)blockIdx.x / 8 : (int)blockIdx.x;
    unsigned char* ws = args.ws;
    F.ctl = (gu32*)(opq(ws) + WS_CTL);
    for (int u = F.tid; u < (LDS_BYTES - LDSCTL_OFF) / 4; u += NWAVES * 64) ((LAS unsigned*)(F.lds + LDSCTL_OFF))[u] = 0u;
    __syncthreads();
    XcdBarrier bar = xcd_barrier_post((unsigned*)(F.ctl + CW_BAR), F.MISC + 8);
    F.xcc = (int)bar.x;
    if (F.tid == 0) F.MISC[12] = __hip_atomic_fetch_add((unsigned*)(F.ctl + CW_RANK) + 64 * bar.x, 1u, __ATOMIC_RELAXED, __HIP_MEMORY_SCOPE_AGENT);
    __syncthreads();
    F.xrank = __builtin_amdgcn_readfirstlane((int)F.MISC[12]);
    const int lo = args.ph_lo, hi = args.ph_hi;
    const int gw = blockIdx.x * NWAVES + F.wave, NGW = F.G * NWAVES;
#define IN(k) (lo <= (k) && (k) < hi)
#define LANE_ (lane_id_v())
#define TID_ ((opqi(F.wave) << 6) | LANE_)
#define SITE() const int G_ = opqi(F.G), wv_ = opqi(F.wave), vcu_ = opqi(F.vcu), gw_ = opqi(gw), NGW_ = opqi(NGW); (void)G_; (void)wv_; (void)vcu_; (void)gw_; (void)NGW_
#if MK_DUP == 99
#define SEAM(k) do { if (IN(k) && IN((k) + 1)) { xcd_barrier(bar, (F.wave == 0 && lane_id_v() == 0) ? 1 : 0); xcd_barrier(bar, (F.wave == 0 && lane_id_v() == 0) ? 1 : 0); } } while (0)
#else
#define SEAM(k) do { if (IN(k) && IN((k) + 1)) xcd_barrier(bar, (F.wave == 0 && lane_id_v() == 0) ? 1 : 0); } while (0)
#endif
#define GEMM_SITE(EPI, Aptr, lda_, Bptr, ldb_, M_, N_, K_, cperm, ...) do { \
        pg8::Gemm g{opq(Aptr), opq(Bptr), M_, N_, K_, lda_, ldb_}; pg8::StaticOrder So; So.init(M_, N_, opqi(F.G), opqi(cperm)); pg8::EPI E{__VA_ARGS__}; \
        pg8::gemm_phase<pg8::EPI, pg8::StaticOrder, true, true>(F.lds + RING_OFF, g, So, E, opqi(F.wave)); } while (0)
    if (IN(0)) { p0_prologue(F, args); }
    SEAM(0);
    if (IN(1)) {
#pragma unroll 1
        for (int l = 0; l < L; ++l)
            GEMM_SITE(EpiBf16, (const GAS bf16*)(opq(ws) + WS_MNB) + (size_t)l * NB * MEM * D, D, (const GAS bf16*)(opq(ws) + WS_WCKV) + (size_t)l * 2 * D * D, D, NB * MEM, 2 * D, D, (int)((blockIdx.x + 64 * l) % F.G),
                      opq((GAS bf16*)(opq(ws) + WS_KVCB) + (size_t)l * NB * MEM * 2 * D), 2 * D, 2 * D, (const GAS float*)nullptr, 0);
    }
    SEAM(1);
    for (int l = 0; l < L; ++l) {
        const int pb = 2 + NPL * l;
        const GAS bf16* XNB = (const GAS bf16*)(opq(ws) + WS_XNB); const GAS bf16* YB = (const GAS bf16*)(opq(ws) + WS_YB); GAS bf16* PROJB = (GAS bf16*)(opq(ws) + WS_PROJB);
        if (IN(pb + 1)) GEMM_SITE(EpiBf16, XNB, D, (const GAS bf16*)(opq(ws) + WS_WIN) + (size_t)l * INP * D, D, T, INP, D, (int)blockIdx.x, opq(PROJB), INP, INP, opq((const GAS float*)(opq(ws) + WS_SSQ)), 8);
#if MK_DUP == 1
        if (IN(pb + 1)) GEMM_SITE(EpiBf16, XNB, D, (const GAS bf16*)(opq(ws) + WS_WIN) + (size_t)l * INP * D, D, T, INP, D, (int)blockIdx.x, opq(PROJB), INP, INP, opq((const GAS float*)(opq(ws) + WS_SSQ)), 8);
#endif
        SEAM(pb + 1);
        if (IN(pb + 2)) {
            SITE();
            pre_phase(opq((const GAS bf16*)PROJB), opq((const GAS float*)(opq(ws) + WS_ROPE)), opq((GAS float*)(opq(ws) + WS_RS)), opq((GAS bf16*)(opq(ws) + WS_KMB)), gw_, NGW_, LANE_);
#if MK_DUP == 21
            pre_phase(opq((const GAS bf16*)PROJB), opq((const GAS float*)(opq(ws) + WS_ROPE)), opq((GAS float*)(opq(ws) + WS_RS)), opq((GAS bf16*)(opq(ws) + WS_KMB)), gw_, NGW_, LANE_);
#endif
            LruP LP{opq((const GAS bf16*)PROJB), (const GAS float*)args.in[opqi(10)] + l * 4 * 512, (const GAS float*)args.in[opqi(11)] + l * 512, opq((const GAS bf16*)(opq(ws) + WS_WAT)) + (size_t)l * 8 * 2 * 4096, (const GAS float*)args.in[opqi(13)] + l * 512, (const GAS float*)args.in[opqi(15)] + l * 512,
                    (const GAS float*)(opq(ws) + WS_SP) + l * 512, opq((GAS unsigned*)(opq(ws) + WS_HLB)), opq((GAS float*)(opq(ws) + WS_LSUM))};
            lru_phase(LP, F.lds, TID_, wv_, LANE_, vcu_, G_);
#if MK_DUP == 2
            lru_phase(LP, F.lds, TID_, wv_, LANE_, vcu_, G_);
#endif
        }
        SEAM(pb + 2);
        if (IN(pb + 3)) {
            GEMM_SITE(EpiUp, (const GAS bf16*)PROJB + PC_CQ, INP, (const GAS bf16*)(opq(ws) + WS_WUQ) + (size_t)l * 512 * 256, 256, T, 512, 256, (int)blockIdx.x,
                      opq((GAS bf16*)(opq(ws) + WS_QMB)), (GAS bf16*)nullptr, 384, 384, opq((const GAS float*)(opq(ws) + WS_RS)), 0, 0);
            GEMM_SITE(EpiUp, (const GAS bf16*)PROJB + PC_CKV, INP, (const GAS bf16*)(opq(ws) + WS_WUKV) + (size_t)l * 512 * 256, 256, T, 512, 256, (int)blockIdx.x,
                      opq((GAS bf16*)(opq(ws) + WS_KMB)), opq((GAS bf16*)(opq(ws) + WS_VMB)), 0, 512, opq((const GAS float*)(opq(ws) + WS_RS)), 1, 1);
#if MK_DUP == 3
            GEMM_SITE(EpiUp, (const GAS bf16*)PROJB + PC_CQ, INP, (const GAS bf16*)(opq(ws) + WS_WUQ) + (size_t)l * 512 * 256, 256, T, 512, 256, (int)blockIdx.x,
                      opq((GAS bf16*)(opq(ws) + WS_QMB)), (GAS bf16*)nullptr, 384, 384, opq((const GAS float*)(opq(ws) + WS_RS)), 0, 0);
            GEMM_SITE(EpiUp, (const GAS bf16*)PROJB + PC_CKV, INP, (const GAS bf16*)(opq(ws) + WS_WUKV) + (size_t)l * 512 * 256, 256, T, 512, 256, (int)blockIdx.x,
                      opq((GAS bf16*)(opq(ws) + WS_KMB)), opq((GAS bf16*)(opq(ws) + WS_VMB)), 0, 512, opq((const GAS float*)(opq(ws) + WS_RS)), 1, 1);
#endif
        }
        SEAM(pb + 3);
        if (IN(pb + 4)) {
            SITE();
            AttnP PM{opq((const GAS bf16*)(opq(ws) + WS_QMB)), opq((const GAS bf16*)(opq(ws) + WS_KMB)), opq((const GAS bf16*)(opq(ws) + WS_VMB)), 384, 384, 256, opq((GAS bf16*)(opq(ws) + WS_OMB)), 256, opq((const GAS float*)(opq(ws) + WS_ROPE)), nullptr, nullptr, nullptr, nullptr};
            AttnP PD{opq((const GAS bf16*)PROJB + PC_QD), opq((const GAS bf16*)PROJB + PC_KD), opq((const GAS bf16*)PROJB + PC_VD), INP, INP, INP, opq((GAS bf16*)(opq(ws) + WS_YB) + 768), 1024, nullptr,
                     (const GAS int*)args.in[opqi(2)], (const GAS float*)(opq(ws) + WS_BTAB), (const GAS float*)args.in[opqi(18)] + l * 64, (const GAS float*)(opq(ws) + WS_LAMS) + 2 * l};
            attn_phase(PM, PD, F.lds, TID_, wv_, LANE_, vcu_, G_);
#if MK_DUP == 4
            __syncthreads(); attn_phase(PM, PD, F.lds, TID_, wv_, LANE_, vcu_, G_);
#elif MK_DUP == 40 || MK_DUP == 41
            __syncthreads(); attn_phase(PM, PD, F.lds, TID_, wv_, LANE_, vcu_, G_, MK_DUP - 40);
#endif
        }
        SEAM(pb + 4);
        if (IN(pb + 5)) {
            SITE();
            PostP PP{opq((const GAS bf16*)(opq(ws) + WS_OMB)), opq((const GAS unsigned*)(opq(ws) + WS_HLB)), opq((const GAS float*)(opq(ws) + WS_LSUM)), opq((const GAS bf16*)PROJB), (const GAS float*)args.in[opqi(19)] + l * 256, (const GAS float*)args.in[opqi(20)] + l * 512, opq((GAS bf16*)(opq(ws) + WS_YB))};
            post_phase(PP, F.lds, TID_, wv_, LANE_, vcu_, G_);
#if MK_DUP == 5
            __syncthreads(); post_phase(PP, F.lds, TID_, wv_, LANE_, vcu_, G_);
#endif
        }
        SEAM(pb + 5);
        if (IN(pb + 6)) GEMM_SITE(EpiRes, YB, D, (const GAS bf16*)(opq(ws) + WS_WOUT) + (size_t)l * D * D, D, T, D, D, (int)blockIdx.x, opq((GAS bf16*)(opq(ws) + WS_XNB)), opq((GAS float*)(opq(ws) + WS_SSQ)));
#if MK_DUP == 6
        if (IN(pb + 6)) GEMM_SITE(EpiRes, YB, D, (const GAS bf16*)(opq(ws) + WS_WOUT) + (size_t)l * D * D, D, T, D, D, (int)blockIdx.x, opq((GAS bf16*)(opq(ws) + WS_HLB)), opq((GAS float*)(opq(ws) + WS_OMB)));
#endif
        SEAM(pb + 6);
        if (IN(pb + 8)) GEMM_SITE(EpiBf16, XNB, D, (const GAS bf16*)(opq(ws) + WS_WCQ) + (size_t)l * D * D, D, T, D, D, (int)blockIdx.x, opq(PROJB), D, D, opq((const GAS float*)(opq(ws) + WS_SSQ)), 16);
#if MK_DUP == 8
        if (IN(pb + 8)) GEMM_SITE(EpiBf16, XNB, D, (const GAS bf16*)(opq(ws) + WS_WCQ) + (size_t)l * D * D, D, T, D, D, (int)blockIdx.x, opq(PROJB), D, D, opq((const GAS float*)(opq(ws) + WS_SSQ)), 16);
#endif
        SEAM(pb + 8);
        if (IN(pb + 9)) {
            SITE();
            const GAS bf16* kv = (const GAS bf16*)(opq(ws) + WS_KVCB) + (size_t)l * NB * MEM * 2 * D;
            AttnP PC{opq((const GAS bf16*)PROJB), opq(kv), opq(kv + D), 1024, 2 * D, 2 * D, opq((GAS bf16*)(opq(ws) + WS_YB)), 1024, nullptr, nullptr, nullptr, nullptr, nullptr};
            cross_phase(PC, F.lds, TID_, wv_, LANE_, vcu_, G_);
#if MK_DUP == 9
            cross_phase(PC, F.lds, TID_, wv_, LANE_, vcu_, G_);
#endif
        }
        SEAM(pb + 9);
        if (IN(pb + 10)) GEMM_SITE(EpiRes, YB, D, (const GAS bf16*)(opq(ws) + WS_WCO) + (size_t)l * D * D, D, T, D, D, (int)blockIdx.x, opq((GAS bf16*)(opq(ws) + WS_XNB)), opq((GAS float*)(opq(ws) + WS_SSQ)));
        SEAM(pb + 10);
        if (IN(pb + 12)) { GEMM_SITE(EpiBf16, XNB, D, (const GAS bf16*)(opq(ws) + WS_WPQ) + (size_t)l * D * D, D, T, D, D, (int)blockIdx.x, opq(PROJB), D, D, opq((const GAS float*)(opq(ws) + WS_SSQ)), 16);
#if MK_DUP == 12
            hq_phase(opq(XNB), opq((const GAS float*)(opq(ws) + WS_SSQ)), (const GAS float*)args.in[opqi(27)] + l * D, opq((GAS unsigned char*)(opq(ws) + WS_HQ)), opq((GAS float*)(opq(ws) + WS_SH)), opq((GAS int*)(opq(ws) + WS_P)), gw_, NGW_, LANE_);
#endif
            }
        SEAM(pb + 12);
        if (IN(pb + 13)) {
            SITE();
            RouteP RP{opq((const GAS bf16*)PROJB), opq((const GAS bf16*)(opq(ws) + WS_KEYS) + (size_t)l * 2 * 128 * 64), opq((GAS int*)(opq(ws) + WS_EX)), opq((GAS float*)(opq(ws) + WS_GW))};
            route_phase(RP, F.lds, TID_, wv_, LANE_, vcu_, G_);
            hq_phase(opq(XNB), opq((const GAS float*)(opq(ws) + WS_SSQ)), (const GAS float*)args.in[opqi(27)] + l * D, opq((GAS unsigned char*)(opq(ws) + WS_HQ)), opq((GAS float*)(opq(ws) + WS_SH)), opq((GAS int*)(opq(ws) + WS_P)), gw_, NGW_, LANE_);
#if MK_DUP == 13
            route_phase(RP, F.lds, TID_, wv_, LANE_, vcu_, G_);
#endif
        }
        SEAM(pb + 13);
        if (IN(pb + 14)) {
            SITE();
            const PeerS ps = peer_sched((const GAS unsigned*)(F.ctl + CW_RANK), opqi(F.xcc), opqi(F.xrank));
            Peer1P Q1{opq((const GAS unsigned char*)(opq(ws) + WS_HQ)), opq((const GAS int*)(opq(ws) + WS_EX)), opq((const GAS unsigned char*)(opq(ws) + WS_U8) + (size_t)l * 16384 * 1024), opq((GAS int*)(opq(ws) + WS_PROJB))};
            peer_k1(Q1, ps, wv_, LANE_);
#if MK_DUP == 141
            { Peer1P Q1b = Q1; Q1b.P = (GAS int*)(opq(ws) + WS_HLB); peer_k1(Q1b, ps, wv_, LANE_); }
#endif
        }
        SEAM(pb + 14);
        if (IN(pb + 15)) {
            SITE();
            peer_w(opq((const GAS int*)(opq(ws) + WS_EX)), opq((const GAS float*)(opq(ws) + WS_GW)), opq((const GAS int*)(opq(ws) + WS_PROJB)), opq((const GAS float*)(opq(ws) + WS_SH)), opq((const GAS float*)(opq(ws) + WS_SU) + l * 16384), opq((const GAS float*)(opq(ws) + WS_SV) + l * 16384),
                   opq((GAS signed char*)(opq(ws) + WS_W)), opq((GAS float*)(opq(ws) + WS_WS)), gw_, NGW_, LANE_, F.lds, TID_);
#if MK_DUP == 150
            peer_w(opq((const GAS int*)(opq(ws) + WS_EX)), opq((const GAS float*)(opq(ws) + WS_GW)), opq((const GAS int*)(opq(ws) + WS_PROJB)), opq((const GAS float*)(opq(ws) + WS_SH)), opq((const GAS float*)(opq(ws) + WS_SU) + l * 16384), opq((const GAS float*)(opq(ws) + WS_SV) + l * 16384),
                   opq((GAS signed char*)(opq(ws) + WS_W)), opq((GAS float*)(opq(ws) + WS_WS)), gw_, NGW_, LANE_, F.lds, TID_);
#endif
            xcd_barrier(bar, (F.wave == 0 && lane_id_v() == 0) ? 1 : 0);
            const PeerS ps = peer_sched((const GAS unsigned*)(F.ctl + CW_RANK), opqi(F.xcc), opqi(F.xrank));
            Peer2P Q2{opq((const GAS int*)(opq(ws) + WS_EX)), opq((const GAS signed char*)(opq(ws) + WS_W)), opq((const GAS float*)(opq(ws) + WS_WS)), opq((const GAS unsigned char*)(opq(ws) + WS_V8) + (size_t)l * 16384 * 1024), opq((GAS bf16*)(opq(ws) + WS_XNB)), opq((GAS float*)(opq(ws) + WS_SSQ))};
            peer_k2(Q2, ps, wv_, LANE_);
#if MK_DUP == 151
            { Peer2P Q2b = Q2; Q2b.XB = (GAS bf16*)(opq(ws) + WS_HLB); Q2b.SSQ = (GAS float*)(opq(ws) + WS_OMB); peer_k2(Q2b, ps, wv_, LANE_); }
#endif
        }
        SEAM(pb + 15);
    }
    if (IN(PH_FINAL)) { SITE(); final_norm_phase(opq((const GAS bf16*)(opq(ws) + WS_XNB)), (GAS float*)args.out, (const GAS float*)args.in[opqi(32)], T, gw_, NGW_, LANE_); }
#undef IN
#undef SEAM
#undef GEMM_SITE
}
}
extern "C" void kernel_launch(void* const* d_in, const int* in_sizes, int n_in, void* d_out, int out_size, void* d_ws, size_t ws_size, hipStream_t stream) {
    (void)in_sizes; (void)out_size;
    static int grid = 0;
    if (grid == 0) {
        int dev = 0, cus = 0, per_cu = 0;
        if (n_in != 33 || ws_size < mk::WS_END) { fprintf(stderr, "kernel_launch: unexpected n_in %d / ws_size %zu\n", n_in, ws_size); grid = -1; return; }
        if (hipGetDevice(&dev) != hipSuccess || hipDeviceGetAttribute(&cus, hipDeviceAttributeMultiprocessorCount, dev) != hipSuccess) { grid = -1; return; }
        if (hipFuncSetAttribute((const void*)mk::fwd, hipFuncAttributeMaxDynamicSharedMemorySize, mk::LDS_BYTES) != hipSuccess) { fprintf(stderr, "kernel_launch: hipFuncSetAttribute failed\n"); grid = -1; return; }
        if (hipOccupancyMaxActiveBlocksPerMultiprocessor(&per_cu, (const void*)mk::fwd, mk::NWAVES * 64, mk::LDS_BYTES) != hipSuccess || per_cu < 1) fprintf(stderr, "kernel_launch: occupancy query says %d\n", per_cu);
        (void)hipGetLastError();
        grid = cus;
    }
    if (grid < 0) return;
    unsigned char* ws = (unsigned char*)d_ws;
    (void)hipMemsetAsync(ws + mk::WS_CTL, 0, mk::CTL_ZERO_BYTES, stream);
    mk::Args a{};
    for (int i = 0; i < 33; ++i) a.in[i] = (const float*)d_in[i];
    a.out = (float*)d_out; a.ws = ws;
    auto run = [&](int lo, int hi) { a.ph_lo = lo; a.ph_hi = hi; hipLaunchKernelGGL(mk::fwd, dim3(grid), dim3(mk::NWAVES * 64), mk::LDS_BYTES, stream, a); };
#if MK_ONE_LAUNCH
    run(0, mk::PH_FINAL + 1);
#else
    for (int p = 0; p <= mk::PH_FINAL; ++p) {
        const int k = (p - 2) % mk::NPL, l = (p - 2) / mk::NPL;
#if MK_NAIVE_PEER == 2
        if (p >= 2 && p < mk::PH_FINAL && k == 14) {
            hipLaunchKernelGGL(k_peer, dim3(T), dim3(256), 0, stream, (const bf16_t*)(ws + mk::WS_XNB), (const int*)(ws + mk::WS_EX), (const float*)(ws + mk::WS_GW), (const float*)d_in[30] + (size_t)l * NEXP * D, (const float*)d_in[31] + (size_t)l * NEXP * D, (float*)d_out);
            continue; }
#elif MK_NAIVE_PEER == 1
        if (p >= 2 && p < mk::PH_FINAL && k == 13) {
            float* TQ = (float*)(ws + (size_t)806 * mk::MiB);
            hipLaunchKernelGGL(k_bf2f, dim3((unsigned)(((size_t)T * D + 255) / 256)), dim3(256), 0, stream, (const bf16_t*)(ws + mk::WS_PROJB), TQ, (long)T * D);
            hipLaunchKernelGGL(k_route, dim3(T), dim3(256), 0, stream, TQ, (const float*)d_in[29] + (size_t)l * 2 * 128 * 64, (int*)(ws + mk::WS_EX), (float*)(ws + mk::WS_GW));
            hipLaunchKernelGGL(k_peer, dim3(T), dim3(256), 0, stream, (const bf16_t*)(ws + mk::WS_XNB), (const int*)(ws + mk::WS_EX), (const float*)(ws + mk::WS_GW), (const float*)d_in[30] + (size_t)l * NEXP * D, (const float*)d_in[31] + (size_t)l * NEXP * D, (float*)d_out);
            continue; }
        if (p >= 2 && p < mk::PH_FINAL && k == 14) continue;
#endif
        run(p, p + 1); }
#endif
}
```

```cpp
#include <hip/hip_runtime.h>
#include <cstdint>
#include <cstdio>
#include <cmath>

#ifndef MK_ONE_LAUNCH
#define MK_ONE_LAUNCH 1
#endif
#ifndef MK_DUP
#define MK_DUP 0
#endif
#ifndef MK_NAIVE_PEER
#define MK_NAIVE_PEER 0
#endif
namespace pg8 {
#define PG8_LAS __attribute__((address_space(3)))
#ifndef GAS
#define GAS __attribute__((address_space(1)))
#endif
typedef unsigned short bf16_t;
typedef short bf16x8 __attribute__((ext_vector_type(8)));
typedef float f32x4 __attribute__((ext_vector_type(4)));
typedef unsigned u32x4 __attribute__((ext_vector_type(4)));
typedef unsigned u32x2 __attribute__((ext_vector_type(2)));
constexpr int BM = 256, BK = 64, HALF = 128, HTB = HALF * BK * 2, STAGE_BYTES = 8 * HTB, NXCD = 8, WGM = 8;
__host__ __device__ __forceinline__ int lds_byte(int r, int c) { const int st = (r >> 4) * 2 + (c >> 5), rr = r & 15, cc = c & 31, ob = rr * 64 + cc * 2; return st * 1024 + (ob ^ (((ob >> 9) & 1) << 5)); }
__host__ __device__ __forceinline__ void stage_rc(int b, int& R, int& C) { const int st = b / 1024, sb = b % 1024, swz = sb ^ (((sb >> 9) & 1) << 5); R = (st >> 1) * 16 + swz / 64; C = (st & 1) * 32 + (swz % 64) / 2; }
__host__ __device__ __forceinline__ int perm32(int rho) { const int n = rho >> 4, i = rho & 15; return 8 * (i >> 2) + 4 * n + (i & 3); }
__device__ __forceinline__ int pg8_lane_id() { int l; asm volatile("v_mbcnt_lo_u32_b32 %0, -1, 0\n\tv_mbcnt_hi_u32_b32 %0, -1, %0" : "=v"(l)); return l; }
struct Unit { int pm, pn; };
struct Gemm { const GAS bf16_t* A; const GAS bf16_t* Bt; int M, N, K, lda, ldb; };
struct StaticOrder {
    int nM, nN, nwg, G, c;
    __host__ __device__ void init(int M, int N, int G_, int c_) { nM = M / BM; nN = N / BM; nwg = nM * nN; G = G_; c = c_; }
    __host__ __device__ bool next(int i, Unit& u) const {
        const long L = (long)i * G + c; if (L >= nwg) return false;
        int wgid = (int)L; { const int q = nwg / NXCD, r = nwg % NXCD, xcd = wgid % NXCD, off = wgid / NXCD; wgid = (xcd < r ? xcd * (q + 1) : r * (q + 1) + (xcd - r) * q) + off; }
        const int nig = WGM * nN, gid = wgid / nig, fm = gid * WGM, gsz = (nM - fm) < WGM ? (nM - fm) : WGM;
        u.pm = fm + ((wgid % nig) % gsz); u.pn = (wgid % nig) / gsz; return true;
    }
    __device__ __forceinline__ void a_ready(const Unit&) const {}
    __device__ __forceinline__ void done(const Unit&) const {}
};
__device__ __forceinline__ unsigned cvt_pk_bf16(float lo, float hi) { unsigned r; asm volatile("v_cvt_pk_bf16_f32 %0, %1, %2" : "=v"(r) : "v"(lo), "v"(hi)); return r; }

struct EpiF32 {
    static constexpr bool PERM = false, AFTER_DRAIN = false;
    GAS float* C; int ldc; int nvalid; int accum;
    __device__ __forceinline__ void operator()(const f32x4 (&acc)[2][2][4][2], const Unit& u, int wr, int wc, int fr, int fq) const {
        { const int l_ = pg8_lane_id(); fr = l_ & 15; fq = l_ >> 4; }
#pragma unroll
        for (int ai = 0; ai < 2; ++ai)
#pragma unroll
            for (int m = 0; m < 4; ++m) { const size_t row = (size_t)u.pm * BM + ai * HALF + wr * 64 + m * 16 + fr;
#pragma unroll
                for (int bj = 0; bj < 2; ++bj)
#pragma unroll
                    for (int n = 0; n < 2; ++n) { const int col = u.pn * BM + bj * HALF + wc * 32 + n * 16 + 4 * fq;
                        if (col < nvalid) { GAS float* p = C + row * ldc + col; f32x4 v = acc[ai][bj][m][n]; if (accum) v += *(const GAS f32x4*)p; *(GAS f32x4*)p = v; } } }
    }
};
struct EpiBf16 {
    static constexpr bool PERM = true, AFTER_DRAIN = false;
    GAS bf16_t* O; int ldc; int nvalid; const GAS float* ssq; int np;
    __device__ __forceinline__ void operator()(const f32x4 (&acc)[2][2][4][2], const Unit& u, int wr, int wc, int fr, int fq) const {
        { const int l_ = pg8_lane_id(); fr = l_ & 15; fq = l_ >> 4; }
#pragma unroll
        for (int ai = 0; ai < 2; ++ai)
#pragma unroll
            for (int m = 0; m < 4; ++m) { const size_t row = (size_t)u.pm * BM + ai * HALF + wr * 64 + m * 16 + fr;
                float rs_ = 1.f;
                if (np > 0) { const GAS f32x4* sp = (const GAS f32x4*)(ssq + row * 16); f32x4 t = sp[0] + sp[1]; if (np > 8) t += sp[2] + sp[3]; rs_ = __builtin_amdgcn_rsqf(((t[0] + t[1]) + (t[2] + t[3])) * (1.f / 1024.f) + 1e-6f); }
#pragma unroll
                for (int bj = 0; bj < 2; ++bj) { const int col = u.pn * BM + bj * HALF + wc * 32 + 8 * fq;
                    if (col < nvalid) { const f32x4 v0 = acc[ai][bj][m][0] * rs_, v1 = acc[ai][bj][m][1] * rs_; u32x4 w; w.x = cvt_pk_bf16(v0[0], v0[1]); w.y = cvt_pk_bf16(v0[2], v0[3]); w.z = cvt_pk_bf16(v1[0], v1[1]); w.w = cvt_pk_bf16(v1[2], v1[3]);
                        *(GAS u32x4*)(O + row * ldc + col) = w; } } }
    }
};
struct EpiUp {
    static constexpr bool PERM = true, AFTER_DRAIN = false;
    GAS bf16_t* O; GAS bf16_t* O2; int ldc; int nvalid; const GAS float* rs; int rsi; int mode;
    __device__ __forceinline__ void operator()(const f32x4 (&acc)[2][2][4][2], const Unit& u, int wr, int wc, int fr, int fq) const {
        { const int l_ = pg8_lane_id(); fr = l_ & 15; fq = l_ >> 4; }
#pragma unroll
        for (int ai = 0; ai < 2; ++ai)
#pragma unroll
            for (int m = 0; m < 4; ++m) { const size_t row = (size_t)u.pm * BM + ai * HALF + wr * 64 + m * 16 + fr; const float s = rs[2 * row + rsi];
#pragma unroll
                for (int bj = 0; bj < 2; ++bj) { const int col = u.pn * BM + bj * HALF + wc * 32 + 8 * fq;
                    if (col < nvalid) { const f32x4 v0 = acc[ai][bj][m][0] * s, v1 = acc[ai][bj][m][1] * s; u32x4 w; w.x = cvt_pk_bf16(v0[0], v0[1]); w.y = cvt_pk_bf16(v0[2], v0[3]); w.z = cvt_pk_bf16(v1[0], v1[1]); w.w = cvt_pk_bf16(v1[2], v1[3]);
                        GAS bf16_t* dst;
                        if (mode == 0) dst = O + row * ldc + col;
                        else { const int h = col >> 7, j = col & 127; dst = (j < 64) ? O + row * 384 + h * 96 + j : O2 + row * 256 + h * 64 + (j - 64); }
                        *(GAS u32x4*)dst = w; } } }
    }
};

struct EpiRes {
    static constexpr bool PERM = true, AFTER_DRAIN = false;
    GAS bf16_t* XB; GAS float* SSQ;
    __device__ __forceinline__ void operator()(const f32x4 (&acc)[2][2][4][2], const Unit& u, int wr, int wc, int fr, int fq) const {
        { const int l_ = pg8_lane_id(); fr = l_ & 15; fq = l_ >> 4; }
#pragma unroll
        for (int ai = 0; ai < 2; ++ai)
#pragma unroll
            for (int m = 0; m < 4; ++m) { const size_t row = (size_t)u.pm * BM + ai * HALF + wr * 64 + m * 16 + fr; float ss = 0.f;
#pragma unroll
                for (int bj = 0; bj < 2; ++bj) { GAS u32x4* p = (GAS u32x4*)(XB + row * 1024 + u.pn * BM + bj * HALF + wc * 32 + 8 * fq);
                    const u32x4 o = *p; const f32x4 v0 = acc[ai][bj][m][0], v1 = acc[ai][bj][m][1];
                    u32x4 w;
                    w.x = cvt_pk_bf16(__builtin_bit_cast(float, o.x << 16) + v0[0], __builtin_bit_cast(float, o.x & 0xffff0000u) + v0[1]);
                    w.y = cvt_pk_bf16(__builtin_bit_cast(float, o.y << 16) + v0[2], __builtin_bit_cast(float, o.y & 0xffff0000u) + v0[3]);
                    w.z = cvt_pk_bf16(__builtin_bit_cast(float, o.z << 16) + v1[0], __builtin_bit_cast(float, o.z & 0xffff0000u) + v1[1]);
                    w.w = cvt_pk_bf16(__builtin_bit_cast(float, o.w << 16) + v1[2], __builtin_bit_cast(float, o.w & 0xffff0000u) + v1[3]);
                    *p = w;
#pragma unroll
                    for (int e = 0; e < 4; ++e) { const float a = __builtin_bit_cast(float, w[e] << 16), b = __builtin_bit_cast(float, w[e] & 0xffff0000u); ss += a * a + b * b; } }
                { float a = ss, b = ss; asm volatile("v_nop\n\tv_nop\n\tv_permlane16_swap_b32 %0, %1" : "+v"(a), "+v"(b)); ss = a + b; }
                { float a = ss, b = ss; asm volatile("v_nop\n\tv_nop\n\tv_permlane32_swap_b32 %0, %1" : "+v"(a), "+v"(b)); ss = a + b; }
                if (fq == 0) SSQ[row * 16 + 4 * u.pn + wc] = ss; }
    }
};
template <class Epi, class Sched, bool ALIGN_EPI = false, bool SP2 = false>
__device__ __forceinline__ void gemm_phase(PG8_LAS unsigned char* lds, const Gemm g, const Sched& S, const Epi& E, int wave_id) {
    int tid_ = (wave_id << 6) | pg8_lane_id(); asm volatile("" : "+v"(tid_));
    const int tid = tid_, wid = __builtin_amdgcn_readfirstlane(tid >> 6), lane = tid & 63, wr = wid >> 2, wc = wid & 3, fr = lane & 15, fq = lane >> 4;
    const int K = g.K, nt = K / BK;
    unsigned voffA[2], voffB[2];
#pragma unroll
    for (int i = 0; i < 2; ++i) { int R, C; stage_rc(tid * 16 + i * 8192, R, C); const int Rb = Epi::PERM ? ((R & ~31) + perm32(R & 31)) : R;
        voffA[i] = (unsigned)(R * g.lda + C) * 2u; voffB[i] = (unsigned)(Rb * g.ldb + C) * 2u; }
    const size_t kstep = (size_t)(BK * 2);
    const size_t hstepA = (size_t)HALF * g.lda * 2, hstepB = (size_t)HALF * g.ldb * 2;
    const size_t tstepA = 2 * hstepA, tstepB = 2 * hstepB;
    const unsigned ldsw = (unsigned)wid * 1024u;
    const int aoff = lds_byte(wr * 64 + fr, fq * 8), boff = lds_byte(wc * 32 + fr, fq * 8);
#define PG8_SA(b, h) (((b) * 2 + (h)) * HTB)
#define PG8_SB(b, h) ((4 + (b) * 2 + (h)) * HTB)
#define PG8_STAGE(bufoff, gbase, voff) do { _Pragma("unroll") for (int _i = 0; _i < 2; ++_i) \
        __builtin_amdgcn_global_load_lds((const unsigned*)((const char*)(gbase) + (voff)[_i]), (PG8_LAS unsigned*)(lds + (bufoff) + ldsw + _i * 8192), 16, 0, 0); } while (0)
#define PG8_LDA(dst, b, h) do { _Pragma("unroll") for (int m = 0; m < 4; ++m) _Pragma("unroll") for (int k = 0; k < 2; ++k) dst[m][k] = *(const PG8_LAS bf16x8*)(lds + PG8_SA(b, h) + aoff + m * 2048 + k * 1024); } while (0)
#define PG8_LDB(dst, b, h) do { _Pragma("unroll") for (int n = 0; n < 2; ++n) _Pragma("unroll") for (int k = 0; k < 2; ++k) dst[n][k] = *(const PG8_LAS bf16x8*)(lds + PG8_SB(b, h) + boff + n * 2048 + k * 1024); } while (0)
#define PG8_MMA(ai, bj, At, Bt) do { __builtin_amdgcn_s_setprio(1); _Pragma("unroll") for (int m = 0; m < 4; ++m) _Pragma("unroll") for (int n = 0; n < 2; ++n) _Pragma("unroll") for (int k = 0; k < 2; ++k) \
        acc[ai][bj][m][n] = __builtin_amdgcn_mfma_f32_16x16x32_bf16(Bt[n][k], At[m][k], acc[ai][bj][m][n], 0, 0, 0); __builtin_amdgcn_s_setprio(0); } while (0)
#define PG8_WAIT_V(n) asm volatile("s_waitcnt vmcnt(" #n ")" ::: "memory")
#define PG8_WAIT_L(n) asm volatile("s_waitcnt lgkmcnt(" #n ")" ::: "memory")
#define PG8_BAR __builtin_amdgcn_s_barrier()
#define PG8_SCHED __builtin_amdgcn_sched_barrier(0)
    Unit cur, nxt; int ui = 0;
    if (!S.next(0, cur)) return;
    f32x4 acc[2][2][4][2];
#pragma unroll
    for (int a = 0; a < 2; ++a)
#pragma unroll
        for (int b = 0; b < 2; ++b)
#pragma unroll
            for (int m = 0; m < 4; ++m)
#pragma unroll
                for (int n = 0; n < 2; ++n) acc[a][b][m][n] = (f32x4){0.f, 0.f, 0.f, 0.f};
    bf16x8 At[4][2], B0[2][2], B1[2][2];
    const char* cA = (const char*)g.A + (size_t)cur.pm * tstepA; const char* cB = (const char*)g.Bt + (size_t)cur.pn * tstepB;
    S.a_ready(cur);
    if constexpr (SP2) {
        PG8_STAGE(PG8_SB(0, 0), cB, voffB); PG8_STAGE(PG8_SB(0, 1), cB + hstepB, voffB); PG8_STAGE(PG8_SA(0, 0), cA, voffA); PG8_STAGE(PG8_SA(0, 1), cA + hstepA, voffA);
        if (wr == 1) PG8_BAR;
        PG8_WAIT_V(2); PG8_BAR;
        PG8_STAGE(PG8_SB(1, 0), cB + kstep, voffB); PG8_STAGE(PG8_SA(1, 0), cA + kstep, voffA); PG8_STAGE(PG8_SB(1, 1), cB + hstepB + kstep, voffB);
        PG8_WAIT_V(6); PG8_BAR;
    } else {
        PG8_STAGE(PG8_SB(0, 0), cB, voffB); PG8_STAGE(PG8_SA(0, 0), cA, voffA); PG8_STAGE(PG8_SB(0, 1), cB + hstepB, voffB); PG8_STAGE(PG8_SA(0, 1), cA + hstepA, voffA);
        if (wr == 1) PG8_BAR;
        PG8_WAIT_V(4); PG8_BAR;
        PG8_STAGE(PG8_SB(1, 0), cB + kstep, voffB); PG8_STAGE(PG8_SA(1, 0), cA + kstep, voffA); PG8_STAGE(PG8_SB(1, 1), cB + hstepB + kstep, voffB);
        PG8_WAIT_V(6); PG8_BAR;
    }
    for (;;) {
        const bool has_next = S.next(ui + 1, nxt);
        const char* nA = has_next ? (const char*)g.A + (size_t)nxt.pm * tstepA : cA; const char* nB = has_next ? (const char*)g.Bt + (size_t)nxt.pn * tstepB : cB;
        for (int t = 0; t < nt; t += 2) {
            const bool last = (t == nt - 2);
            const char* a1 = cA + (size_t)(t + 1) * kstep;
            const char* a2 = last ? nA : cA + (size_t)(t + 2) * kstep; const char* b2 = last ? nB : cB + (size_t)(t + 2) * kstep;
            const char* a3 = a2 + kstep; const char* b3 = b2 + kstep;
            if (last && has_next) S.a_ready(nxt);
            if constexpr (SP2) {
            PG8_LDB(B0, 0, 0); PG8_LDB(B1, 0, 1); PG8_SCHED; PG8_LDA(At, 0, 0); PG8_STAGE(PG8_SA(1, 1), a1 + hstepA, voffA);
            PG8_WAIT_V(8); PG8_WAIT_L(0); PG8_BAR; PG8_MMA(0, 0, At, B0); PG8_MMA(0, 1, At, B1); PG8_BAR; PG8_SCHED;
            PG8_LDA(At, 0, 1); PG8_STAGE(PG8_SB(0, 0), b2, voffB); PG8_STAGE(PG8_SB(0, 1), b2 + hstepB, voffB); PG8_STAGE(PG8_SA(0, 0), a2, voffA);
            PG8_WAIT_V(8); PG8_WAIT_L(0); PG8_BAR; PG8_MMA(1, 0, At, B0); PG8_MMA(1, 1, At, B1); PG8_BAR; PG8_SCHED;
            PG8_LDB(B0, 1, 0); PG8_LDB(B1, 1, 1); PG8_SCHED; PG8_LDA(At, 1, 0); PG8_STAGE(PG8_SA(0, 1), a2 + hstepA, voffA);
            PG8_WAIT_V(8); PG8_WAIT_L(0); PG8_BAR; PG8_MMA(0, 0, At, B0); PG8_MMA(0, 1, At, B1); PG8_BAR; PG8_SCHED;
            PG8_LDA(At, 1, 1); PG8_STAGE(PG8_SB(1, 0), b3, voffB); PG8_STAGE(PG8_SB(1, 1), b3 + hstepB, voffB); PG8_STAGE(PG8_SA(1, 0), a3, voffA);
            PG8_WAIT_V(8); PG8_WAIT_L(0); PG8_BAR; PG8_MMA(1, 0, At, B0); PG8_MMA(1, 1, At, B1); PG8_BAR; PG8_SCHED;
            } else {
            PG8_LDB(B0, 0, 0); PG8_SCHED; PG8_LDA(At, 0, 0); PG8_STAGE(PG8_SA(1, 1), a1 + hstepA, voffA);
            PG8_WAIT_L(8); PG8_BAR; PG8_WAIT_L(0); PG8_MMA(0, 0, At, B0); PG8_BAR; PG8_SCHED;
            PG8_LDB(B1, 0, 1); PG8_STAGE(PG8_SB(0, 0), b2, voffB);
            PG8_BAR; PG8_WAIT_L(0); PG8_MMA(0, 1, At, B1); PG8_BAR;
            PG8_LDA(At, 0, 1); PG8_STAGE(PG8_SA(0, 0), a2, voffA);
            PG8_BAR; PG8_WAIT_L(0); PG8_MMA(1, 0, At, B0); PG8_BAR; PG8_SCHED;
            PG8_STAGE(PG8_SB(0, 1), b2 + hstepB, voffB);
            PG8_WAIT_V(6); PG8_BAR; PG8_MMA(1, 1, At, B1); PG8_BAR;
            PG8_LDB(B0, 1, 0); PG8_SCHED; PG8_LDA(At, 1, 0); PG8_STAGE(PG8_SA(0, 1), a2 + hstepA, voffA);
            PG8_WAIT_L(8); PG8_BAR; PG8_WAIT_L(0); PG8_MMA(0, 0, At, B0); PG8_BAR; PG8_SCHED;
            PG8_LDB(B1, 1, 1); PG8_STAGE(PG8_SB(1, 0), b3, voffB);
            PG8_BAR; PG8_WAIT_L(0); PG8_MMA(0, 1, At, B1); PG8_BAR;
            PG8_LDA(At, 1, 1); PG8_STAGE(PG8_SA(1, 0), a3, voffA);
            PG8_BAR; PG8_WAIT_L(0); PG8_MMA(1, 0, At, B0); PG8_BAR; PG8_SCHED;
            PG8_STAGE(PG8_SB(1, 1), b3 + hstepB, voffB);
            PG8_WAIT_V(6); PG8_BAR; PG8_MMA(1, 1, At, B1); PG8_BAR;
            }
        }
        if constexpr (ALIGN_EPI) { if (wr == 0) PG8_BAR; }
        if constexpr (!Epi::AFTER_DRAIN) { E(acc, cur, wr, wc, fr, fq); S.done(cur); }
        if (!has_next) break;
#pragma unroll
        for (int a = 0; a < 2; ++a)
#pragma unroll
            for (int b = 0; b < 2; ++b)
#pragma unroll
                for (int m = 0; m < 4; ++m)
#pragma unroll
                    for (int n = 0; n < 2; ++n) acc[a][b][m][n] = (f32x4){0.f, 0.f, 0.f, 0.f};
        cur = nxt; cA = nA; cB = nB; ++ui;
        if constexpr (ALIGN_EPI) { if (wr == 1) PG8_BAR; }
    }
    PG8_WAIT_V(0);
    if constexpr (!ALIGN_EPI) { if (wr == 0) PG8_BAR; }
    PG8_BAR;
    if constexpr (Epi::AFTER_DRAIN) { E.fused(acc, cur, wr, wc, fr, fq, lds, wid, lane); S.done(cur); }
#undef PG8_SA
#undef PG8_SB
#undef PG8_STAGE
#undef PG8_LDA
#undef PG8_LDB
#undef PG8_MMA
#undef PG8_WAIT_V
#undef PG8_WAIT_L
#undef PG8_BAR
#undef PG8_SCHED
}
}

namespace mk {
#ifndef GAS
#define GAS __attribute__((address_space(1)))
#endif
#define LAS __attribute__((address_space(3)))
typedef unsigned short bf16;
typedef unsigned v4u __attribute__((ext_vector_type(4)));
typedef unsigned v2u __attribute__((ext_vector_type(2)));
typedef float f32x4 __attribute__((ext_vector_type(4)));
typedef GAS unsigned gu32;
#define LDS_WAIT() asm volatile("s_waitcnt lgkmcnt(0)" ::: "memory")
#define VM_WAIT() asm volatile("s_waitcnt vmcnt(0)" ::: "memory")
__device__ __forceinline__ unsigned f2bf_(float f) { unsigned u = __builtin_bit_cast(unsigned, f); return (u + 0x7fffu + ((u >> 16) & 1u)) >> 16; }
__device__ __forceinline__ unsigned pk2(float lo, float hi) { return f2bf_(lo) | (f2bf_(hi) << 16); }
__device__ __forceinline__ float bflo(unsigned w) { return __builtin_bit_cast(float, w << 16); }
__device__ __forceinline__ float bfhi(unsigned w) { return __builtin_bit_cast(float, w & 0xffff0000u); }

template <class P> __device__ __forceinline__ P* opq(P* p) { asm volatile("" : "+s"(p)); return p; }
__device__ __forceinline__ int opqi(int k) { asm volatile("" : "+s"(k)); return k; }
__device__ __forceinline__ float shx(float v, int o, int lane) { return __builtin_bit_cast(float, __builtin_amdgcn_ds_bpermute((lane ^ o) << 2, __builtin_bit_cast(int, v))); }
__device__ __forceinline__ int shxi(int v, int o, int lane) { return __builtin_amdgcn_ds_bpermute((lane ^ o) << 2, v); }
__device__ __forceinline__ int lane_id_v() { int l; asm volatile("v_mbcnt_lo_u32_b32 %0, -1, 0\n\tv_mbcnt_hi_u32_b32 %0, -1, %0" : "=v"(l)); return l; }
constexpr int NWAVES = 8;
constexpr int D = 1024, NB = 4, S = 8192, T = NB * S, L = 4, MEM = 256, INW = 2144, INP = 2304;
constexpr int PC_CQ = 0, PC_CKV = 256, PC_KR = 384, PC_XL = 512, PC_GL = 1024, PC_QD = 1536, PC_KD = 1792, PC_VD = 2048;
constexpr float LOG2E = 1.4426950408889634f;
constexpr size_t MiB = 1u << 20;
constexpr size_t WS_CTL = 0, CTL_ZERO_BYTES = 1 * MiB;
constexpr size_t WS_WIN = 1 * MiB, WS_WOUT = 19 * MiB, WS_WCQ = 27 * MiB, WS_WCO = 35 * MiB, WS_WPQ = 43 * MiB, WS_WCKV = 51 * MiB, WS_WUQ = 67 * MiB, WS_WUKV = 68 * MiB, WS_KEYS = 69 * MiB, WS_ROPE = 70 * MiB;
constexpr size_t WS_XNB = 76 * MiB, WS_YB = 140 * MiB, WS_PROJB = 204 * MiB, WS_QMB = 348 * MiB, WS_KMB = 372 * MiB, WS_VMB = 396 * MiB, WS_RS = 412 * MiB;
constexpr size_t WS_HLB = 413 * MiB, WS_ACB = 445 * MiB, WS_LSUM = 477 * MiB, WS_OMB = 478 * MiB, WS_MNB = 494 * MiB, WS_KVCB = 502 * MiB, WS_EX = 518 * MiB, WS_GW = 534 * MiB;
constexpr size_t WS_U8 = 550 * MiB, WS_V8 = 614 * MiB, WS_SU = 678 * MiB, WS_SV = 679 * MiB;
constexpr size_t WS_HQ = 680 * MiB, WS_P = 712 * MiB, WS_SH = 728 * MiB, WS_W = 729 * MiB, WS_WS = 745 * MiB, WS_SSQ = 746 * MiB, WS_END = 748 * MiB;
constexpr size_t WS_WAT = 74 * MiB;
constexpr size_t WS_BTAB = WS_KEYS + 512 * 1024, WS_LAMS = WS_BTAB + 4096, WS_SP = WS_LAMS + 4096;
constexpr int CW_BAR = 4096, CW_RANK = 8192;
constexpr int RING_OFF = 0, RING_BYTES = 155648, LDSCTL_OFF = RING_BYTES, MISC_OFF = LDSCTL_OFF + 320, LDS_BYTES = 163840;

#define XB_TMO      128
#define XB_XCNT(j)  (256  + 64 * (j))
#define XB_XSUB(j)  (1280 + 64 * (j))
#define XB_XGEN(j)  (2304 + 64 * (j))
#define XB_TOP      3328
#define XB_TOPGEN   3392
#define XCD_BAR_WORDS 3456
#define XB_SPIN_CAP (1u << 18)

__device__ __forceinline__ unsigned xb_ld(unsigned* p)              { return __hip_atomic_load(p, __ATOMIC_RELAXED, __HIP_MEMORY_SCOPE_AGENT); }
__device__ __forceinline__ unsigned xb_add(unsigned* p, unsigned v) { return __hip_atomic_fetch_add(p, v, __ATOMIC_RELAXED, __HIP_MEMORY_SCOPE_AGENT); }
__device__ __forceinline__ unsigned xb_xcc_id() { return (unsigned)__builtin_amdgcn_s_getreg((3 << 11) | 20) & 0xFu; }
#define XB_SPIN(cond, bar) do { unsigned _sp = 0; while (cond) { __builtin_amdgcn_s_sleep(1); \
    if ((++_sp & 255u) == 0u) { if (xb_ld(&(bar)[XB_TMO])) break; if (_sp > XB_SPIN_CAP) { atomicAdd(&(bar)[XB_TMO], 1u); break; } } } } while (0)

struct XcdBarrier {
    unsigned* bar; unsigned x;
    volatile LAS unsigned* st;
};

__device__ __forceinline__ XcdBarrier xcd_barrier_post(unsigned* bar, volatile LAS unsigned* st) {
    XcdBarrier b; b.bar = bar; b.x = xb_xcc_id(); b.st = st;
    if (threadIdx.x == 0) (void)xb_add(&bar[XB_XCNT(b.x)], 1u);
    return b;
}
__device__ __forceinline__ void xcd_barrier_complete(unsigned* bar, unsigned x, unsigned& nloc, unsigned& nx) {
    const unsigned G = gridDim.x * gridDim.y * gridDim.z;
    unsigned sum, cnt, mine, sp = 0u;
    for (;;) {
        sum = 0u; cnt = 0u; mine = 0u;
#pragma unroll
        for (unsigned j = 0; j < 16; ++j) { const unsigned c = xb_ld(&bar[XB_XCNT(j)]); sum += c; cnt += (c > 0u) ? 1u : 0u; mine = (j == x) ? c : mine; }
        if (sum == G) break;
        __builtin_amdgcn_s_sleep(1);
        if ((++sp & 255u) == 0u) { if (xb_ld(&bar[XB_TMO])) break; if (sp > XB_SPIN_CAP) { atomicAdd(&bar[XB_TMO], 1u); break; } }
    }
    nloc = mine > 0u ? mine : 1u; nx = cnt > 0u ? cnt : 1u;
}

__device__ __noinline__ void xcd_barrier_impl(unsigned* bar_, unsigned x_, volatile LAS unsigned* st_, int leader_) {
    XcdBarrier b; b.bar = bar_; b.x = x_; b.st = st_;
    asm volatile("s_waitcnt vmcnt(0)" ::: "memory");
    __syncthreads();
    if (leader_) {
        unsigned* bar = b.bar;
        __builtin_amdgcn_s_waitcnt(0);
        unsigned nloc = b.st[0], nx = b.st[1];
        if (nloc == 0u) { xcd_barrier_complete(bar, b.x, nloc, nx); b.st[0] = nloc; b.st[1] = nx; }
        const unsigned old = xb_add(&bar[XB_XSUB(b.x)], 1u);
        const unsigned gen = old / nloc;
        if (old + 1u == (gen + 1u) * nloc) {
            __builtin_amdgcn_fence(__ATOMIC_RELEASE, "agent");
            asm volatile("s_waitcnt vmcnt(0)" ::: "memory");
            const unsigned og = xb_add(&bar[XB_TOP], 1u);
            const unsigned tg = og / nx;
            if (og + 1u == (tg + 1u) * nx) xb_add(&bar[XB_TOPGEN], 1u);
            else XB_SPIN(xb_ld(&bar[XB_TOPGEN]) == tg, bar);
            __builtin_amdgcn_fence(__ATOMIC_ACQUIRE, "agent");
            xb_add(&bar[XB_XGEN(b.x)], 1u);
            asm volatile("s_waitcnt vmcnt(0)" ::: "memory");
        } else {
            XB_SPIN(xb_ld(&bar[XB_XGEN(b.x)]) == gen, bar);
            __builtin_amdgcn_fence(__ATOMIC_ACQUIRE, "agent");
            asm volatile("s_waitcnt vmcnt(0)" ::: "memory");
        }
    }
    __syncthreads();
}
__device__ __forceinline__ void xcd_barrier(const XcdBarrier& b, int leader) { xcd_barrier_impl(b.bar, b.x, b.st, leader); }


__device__ __forceinline__ float wave_sum(float v, int lane) {
    (void)lane;
    v += __builtin_bit_cast(float, __builtin_amdgcn_update_dpp(0, __builtin_bit_cast(int, v), 0xB1, 0xF, 0xF, true));
    v += __builtin_bit_cast(float, __builtin_amdgcn_update_dpp(0, __builtin_bit_cast(int, v), 0x4E, 0xF, 0xF, true));
    v += __builtin_bit_cast(float, __builtin_amdgcn_update_dpp(0, __builtin_bit_cast(int, v), 0x141, 0xF, 0xF, true));
    v += __builtin_bit_cast(float, __builtin_amdgcn_update_dpp(0, __builtin_bit_cast(int, v), 0x140, 0xF, 0xF, true));
    { float a = v, b = v; asm volatile("v_nop\n\tv_nop\n\tv_permlane16_swap_b32 %0, %1" : "+v"(a), "+v"(b)); v = a + b; }
    { float a = v, b = v; asm volatile("v_nop\n\tv_nop\n\tv_permlane32_swap_b32 %0, %1" : "+v"(a), "+v"(b)); v = a + b; }
    return v;
}
__device__ __forceinline__ float wave_max(float v) {
    v = fmaxf(v, __builtin_bit_cast(float, __builtin_amdgcn_update_dpp(0, __builtin_bit_cast(int, v), 0xB1, 0xF, 0xF, true)));
    v = fmaxf(v, __builtin_bit_cast(float, __builtin_amdgcn_update_dpp(0, __builtin_bit_cast(int, v), 0x4E, 0xF, 0xF, true)));
    v = fmaxf(v, __builtin_bit_cast(float, __builtin_amdgcn_update_dpp(0, __builtin_bit_cast(int, v), 0x141, 0xF, 0xF, true)));
    v = fmaxf(v, __builtin_bit_cast(float, __builtin_amdgcn_update_dpp(0, __builtin_bit_cast(int, v), 0x140, 0xF, 0xF, true)));
    { float a = v, b = v; asm volatile("v_nop\n\tv_nop\n\tv_permlane16_swap_b32 %0, %1" : "+v"(a), "+v"(b)); v = fmaxf(a, b); }
    { float a = v, b = v; asm volatile("v_nop\n\tv_nop\n\tv_permlane32_swap_b32 %0, %1" : "+v"(a), "+v"(b)); v = fmaxf(a, b); }
    return v;
}
__device__ __forceinline__ float gelu_erf(float v) {
    const float av = __builtin_fabsf(v), t = __builtin_amdgcn_rcpf(av * 0.2316418882f + 1.0f);
    float q = t * 0.5307027145f + (-0.7265760135f); q = q * t + 0.7107068705f; q = q * t + (-0.142248368f); q = q * t + 0.127414796f; q = q * t;
    const float e = __builtin_amdgcn_exp2f((v * v) * (-0.72134752044f));
    const float m = v * (q * e);
    return v < 0.f ? m : v - m;
}

__device__ __forceinline__ void norm_phase(const GAS float* X, const GAS float* g, GAS bf16* out, int rows, int gw, int NGW, int lane) {
    asm volatile("" : "+v"(lane));
    f32x4 gv[4];
#pragma unroll
    for (int j = 0; j < 4; ++j) gv[j] = ((const GAS f32x4*)g)[lane + 64 * j];
    for (int m = gw; m < rows; m += NGW) {
        const GAS f32x4* xr = (const GAS f32x4*)(X + (size_t)m * D) + lane;
        f32x4 v[4]; float s = 0.f;
#pragma unroll
        for (int j = 0; j < 4; ++j) { v[j] = xr[64 * j]; s += (v[j].x * v[j].x + v[j].y * v[j].y) + (v[j].z * v[j].z + v[j].w * v[j].w); }
        const float rs = rsqrtf(wave_sum(s, lane) * (1.f / D) + 1e-6f);
        GAS v2u* o8 = (GAS v2u*)(out + (size_t)m * D) + lane;
#pragma unroll
        for (int j = 0; j < 4; ++j) { v2u w; w.x = pk2(v[j].x * rs * gv[j].x, v[j].y * rs * gv[j].y); w.y = pk2(v[j].z * rs * gv[j].z, v[j].w * rs * gv[j].w); o8[64 * j] = w; }
    }
}
__device__ __forceinline__ void hq_phase(const GAS bf16* XB, const GAS float* SSQ, const GAS float* g, GAS unsigned char* HQ, GAS float* SH, GAS int* Pz, int gw, int NGW, int lane) {
    asm volatile("" : "+v"(lane));
    const GAS f32x4* gp = (const GAS f32x4*)g + 4 * lane; const f32x4 g0 = gp[0], g1 = gp[1], g2 = gp[2], g3 = gp[3];
    for (int m = gw; m < T; m += NGW) {
        const GAS f32x4* sp = (const GAS f32x4*)(SSQ + (size_t)m * 16); const f32x4 t = (sp[0] + sp[1]) + (sp[2] + sp[3]);
        const float rs = __builtin_amdgcn_rsqf(((t[0] + t[1]) + (t[2] + t[3])) * (1.f / 1024.f) + 1e-6f);
        const v4u a = *(const GAS v4u*)(XB + (size_t)m * D + 16 * lane), b = *(const GAS v4u*)(XB + (size_t)m * D + 16 * lane + 8);
        float f[16] = {bflo(a.x) * g0[0], bfhi(a.x) * g0[1], bflo(a.y) * g0[2], bfhi(a.y) * g0[3], bflo(a.z) * g1[0], bfhi(a.z) * g1[1], bflo(a.w) * g1[2], bfhi(a.w) * g1[3],
                       bflo(b.x) * g2[0], bfhi(b.x) * g2[1], bflo(b.y) * g2[2], bfhi(b.y) * g2[3], bflo(b.z) * g3[0], bfhi(b.z) * g3[1], bflo(b.w) * g3[2], bfhi(b.w) * g3[3]};
        float mx = 0.f;
#pragma unroll
        for (int i = 0; i < 16; ++i) { f[i] *= rs; mx = fmaxf(mx, __builtin_fabsf(f[i])); }
        mx = wave_max(mx);
        const float inv = mx > 0.f ? 127.f / mx : 0.f;
        v4u q;
#pragma unroll
        for (int i = 0; i < 4; ++i) { const int ia = (int)__builtin_rintf(f[4 * i] * inv), ib = (int)__builtin_rintf(f[4 * i + 1] * inv), ic = (int)__builtin_rintf(f[4 * i + 2] * inv), id = (int)__builtin_rintf(f[4 * i + 3] * inv);
            q[i] = (unsigned)(ia & 255) | ((unsigned)(ib & 255) << 8) | ((unsigned)(ic & 255) << 16) | ((unsigned)(id & 255) << 24); }
        *(GAS v4u*)(HQ + (size_t)m * D + 16 * lane) = q;
        if (lane == 0) SH[m] = mx * (1.f / 127.f);
    }
}
__device__ __forceinline__ void x0_phase(const GAS float* X, GAS bf16* XB, GAS float* SSQ, int gw, int NGW, int lane) {
    asm volatile("" : "+v"(lane));
    for (int m = gw; m < T; m += NGW) {
        const GAS f32x4* xr = (const GAS f32x4*)(X + (size_t)m * D) + lane; GAS v2u* o8 = (GAS v2u*)(XB + (size_t)m * D) + lane;
        float s = 0.f;
#pragma unroll
        for (int j = 0; j < 4; ++j) { const f32x4 v = xr[64 * j]; s += (v.x * v.x + v.y * v.y) + (v.z * v.z + v.w * v.w); v2u w; w.x = pk2(v.x, v.y); w.y = pk2(v.z, v.w); o8[64 * j] = w; }
        s = wave_sum(s, lane);
        if (lane < 8) SSQ[(size_t)m * 16 + lane] = lane == 0 ? s : 0.f;
    }
}
__device__ __forceinline__ void final_norm_phase(const GAS bf16* XB, GAS float* O, const GAS float* g, int rows, int gw, int NGW, int lane) {
    asm volatile("" : "+v"(lane));
    for (int m = gw; m < rows; m += NGW) {
        const GAS v4u* xr = (const GAS v4u*)(XB + (size_t)m * D) + lane;
        v4u v[2]; float s = 0.f;
#pragma unroll
        for (int j = 0; j < 2; ++j) { v[j] = xr[64 * j];
#pragma unroll
            for (int e = 0; e < 4; ++e) { const float a = bflo(v[j][e]), b = bfhi(v[j][e]); s += a * a + b * b; } }
        const float rs = rsqrtf(wave_sum(s, lane) * (1.f / D) + 1e-6f);
#pragma unroll
        for (int j = 0; j < 2; ++j) { const int c = 8 * (lane + 64 * j); const f32x4 g0 = *(const GAS f32x4*)(g + c), g1 = *(const GAS f32x4*)(g + c + 4);
            f32x4 o0, o1; o0.x = bflo(v[j].x) * rs * g0.x; o0.y = bfhi(v[j].x) * rs * g0.y; o0.z = bflo(v[j].y) * rs * g0.z; o0.w = bfhi(v[j].y) * rs * g0.w;
            o1.x = bflo(v[j].z) * rs * g1.x; o1.y = bfhi(v[j].z) * rs * g1.y; o1.z = bflo(v[j].w) * rs * g1.z; o1.w = bfhi(v[j].w) * rs * g1.w;
            *(GAS f32x4*)(O + (size_t)m * D + c) = o0; *(GAS f32x4*)(O + (size_t)m * D + c + 4) = o1; }
    }
}

__device__ __forceinline__ float row16_sum(float v) {
    v += __builtin_bit_cast(float, __builtin_amdgcn_update_dpp(0, __builtin_bit_cast(int, v), 0xB1, 0xF, 0xF, true));
    v += __builtin_bit_cast(float, __builtin_amdgcn_update_dpp(0, __builtin_bit_cast(int, v), 0x4E, 0xF, 0xF, true));
    v += __builtin_bit_cast(float, __builtin_amdgcn_update_dpp(0, __builtin_bit_cast(int, v), 0x141, 0xF, 0xF, true));
    v += __builtin_bit_cast(float, __builtin_amdgcn_update_dpp(0, __builtin_bit_cast(int, v), 0x140, 0xF, 0xF, true));
    return v;
}
__device__ __forceinline__ float sq8(const v4u w) { const float a0 = bflo(w.x), a1 = bfhi(w.x), a2 = bflo(w.y), a3 = bfhi(w.y), a4 = bflo(w.z), a5 = bfhi(w.z), a6 = bflo(w.w), a7 = bfhi(w.w);
    return (a0 * a0 + a1 * a1) + (a2 * a2 + a3 * a3) + (a4 * a4 + a5 * a5) + (a6 * a6 + a7 * a7); }
__device__ __forceinline__ void pre_phase(const GAS bf16* PROJB, const GAS float* ROPE, GAS float* RS, GAS bf16* KMB, int gw, int NGW, int lane) {
    asm volatile("" : "+v"(lane));
    const int q = lane >> 4, sub = lane & 15;
    for (int t0 = gw * 4; t0 < T; t0 += NGW * 4) {
        const size_t t = (size_t)t0 + q;
        const GAS bf16* pr = PROJB + t * INP;
        const v4u w0 = *(const GAS v4u*)(pr + PC_CQ + 8 * sub), w1 = *(const GAS v4u*)(pr + PC_CQ + 8 * (16 + (sub & 7))), w2 = *(const GAS v4u*)(pr + PC_CKV + 8 * sub);
        const float x1 = __builtin_bit_cast(float, (unsigned)pr[PC_KR + sub] << 16), x2 = __builtin_bit_cast(float, (unsigned)pr[PC_KR + 16 + sub] << 16);
        const float c = ROPE[t * 32 + sub], sn = ROPE[t * 32 + 16 + sub];
        const float sq = row16_sum(sq8(w0) + (sub < 8 ? sq8(w1) : 0.f)), skv = row16_sum(sq8(w2));
        if (sub == 0) { RS[2 * t] = rsqrtf(sq * (1.f / 192.f) + 1e-6f); RS[2 * t + 1] = rsqrtf(skv * (1.f / 128.f) + 1e-6f); }
        const bf16 y1 = (bf16)f2bf_(x1 * c - x2 * sn), y2 = (bf16)f2bf_(x1 * sn + x2 * c);
        GAS bf16* kr = KMB + t * 384 + 64 + sub;
#pragma unroll
        for (int h = 0; h < 4; ++h) { kr[h * 96] = y1; kr[h * 96 + 16] = y2; }
    }
}

typedef short lr_bf16x8 __attribute__((ext_vector_type(8)));
typedef float lr_f32x16 __attribute__((ext_vector_type(16)));
__device__ __forceinline__ void lr_swap32(float& a, float& b) { asm volatile("v_nop\n\tv_nop\n\tv_permlane32_swap_b32 %0, %1" : "+v"(a), "+v"(b)); }
constexpr int LR_XR = 0, LR_CW = LR_XR + 37376, LR_XA = LR_CW + 1280, LR_WT = LR_XA + 256 * 144, LR_SUM = LR_WT + 2 * 64 * 144, LR_END = LR_SUM + 4096;
struct LruP { const GAS bf16* PROJB; const GAS float* cw; const GAS float* cb; const GAS bf16* wat; const GAS float* ba; const GAS float* bx; const GAS float* sp; GAS unsigned* HA; GAS float* LSUM; };
__device__ __forceinline__ void lru_phase(const LruP& P, LAS unsigned char* lds, int tid, int wave, int lane, int vcu, int G) {
    asm volatile("" : "+v"(tid), "+v"(lane));
    LAS float* SUM = (LAS float*)(lds + LR_SUM);
    for (int u = vcu; u < (T / 256) * 8; u += G) {
        const int tile = u >> 3, g = u & 7; const int t0 = tile * 256; const bool first = ((tile & 31) == 0);
        __syncthreads();
        float ba_[2], bx_[2], sp_[2];
#pragma unroll
        for (int nt = 0; nt < 2; ++nt) { const int ch = 64 * g + 32 * nt + (lane & 31); ba_[nt] = P.ba[ch]; bx_[nt] = P.bx[ch]; sp_[nt] = P.sp[ch]; }
        { v4u wt_[2], xr_[5];
#pragma unroll
          for (int i = 0; i < 2; ++i) { const int idx = tid + 512 * i; wt_[i] = ((const GAS v4u*)(P.wat + (size_t)g * 2 * 4096))[idx]; }
#pragma unroll
          for (int i = 0; i < 5; ++i) { const int idx = tid + 512 * i, row = idx >> 3, part = idx & 7; const bool ok = (idx < 259 * 8) && !(first && row < 3);
              const int trow = ok ? t0 - 3 + row : t0;
              xr_[i] = *(const GAS v4u*)(P.PROJB + (size_t)trow * INP + PC_XL + 64 * g + 8 * part); if (!ok) xr_[i] = v4u{0u, 0u, 0u, 0u}; }
          float cwv = 0.f; if (tid < 320) cwv = (tid < 256) ? P.cw[(tid >> 6) * 512 + 64 * g + (tid & 63)] : P.cb[64 * g + (tid - 256)];
#pragma unroll
          for (int i = 0; i < 2; ++i) { const int idx = tid + 512 * i; *(LAS v4u*)(lds + LR_WT + (idx >> 9) * 9216 + ((idx >> 3) & 63) * 144 + (idx & 7) * 16) = wt_[i]; }
#pragma unroll
          for (int i = 0; i < 5; ++i) { const int idx = tid + 512 * i, row = idx >> 3, part = idx & 7; if (idx < 259 * 8) *(LAS v4u*)(lds + LR_XR + row * 144 + 16 * part) = xr_[i]; }
          if (tid < 320) ((LAS float*)(lds + LR_CW))[tid] = cwv; }
        __syncthreads();
        { float cwr[4][8], cbr[8];
#pragma unroll
          for (int k = 0; k < 4; ++k) { const f32x4 c0 = *(const LAS f32x4*)(lds + LR_CW + (k * 64 + 8 * wave) * 4), c1 = *(const LAS f32x4*)(lds + LR_CW + (k * 64 + 8 * wave + 4) * 4);
              cwr[k][0] = c0.x; cwr[k][1] = c0.y; cwr[k][2] = c0.z; cwr[k][3] = c0.w; cwr[k][4] = c1.x; cwr[k][5] = c1.y; cwr[k][6] = c1.z; cwr[k][7] = c1.w; }
          { const f32x4 c0 = *(const LAS f32x4*)(lds + LR_CW + (256 + 8 * wave) * 4), c1 = *(const LAS f32x4*)(lds + LR_CW + (256 + 8 * wave + 4) * 4);
            cbr[0] = c0.x; cbr[1] = c0.y; cbr[2] = c0.z; cbr[3] = c0.w; cbr[4] = c1.x; cbr[5] = c1.y; cbr[6] = c1.z; cbr[7] = c1.w; }
#pragma unroll
          for (int it_ = 0; it_ < 4; ++it_) { const int time = lane + 64 * it_;
              float y[8];
#pragma unroll
              for (int e = 0; e < 8; ++e) y[e] = cbr[e];
#pragma unroll
              for (int k = 0; k < 4; ++k) { const v4u w = *(const LAS v4u*)(lds + LR_XR + (time + k) * 144 + 16 * wave);
                  y[0] += bflo(w.x) * cwr[k][0]; y[1] += bfhi(w.x) * cwr[k][1]; y[2] += bflo(w.y) * cwr[k][2]; y[3] += bfhi(w.y) * cwr[k][3];
                  y[4] += bflo(w.z) * cwr[k][4]; y[5] += bfhi(w.z) * cwr[k][5]; y[6] += bflo(w.w) * cwr[k][6]; y[7] += bfhi(w.w) * cwr[k][7]; }
              v4u o; o.x = pk2(y[0], y[1]); o.y = pk2(y[2], y[3]); o.z = pk2(y[4], y[5]); o.w = pk2(y[6], y[7]);
              *(LAS v4u*)(lds + LR_XA + time * 144 + 16 * wave) = o; } }
        __syncthreads();
        const int r32 = lane & 31, hi = lane >> 5;
        lr_f32x16 acc[2][2];
#pragma unroll
        for (int nt = 0; nt < 2; ++nt) { const float b_a = ba_[nt], b_x = bx_[nt];
#pragma unroll
            for (int r = 0; r < 16; ++r) { acc[0][nt][r] = b_a; acc[1][nt][r] = b_x; } }
        { lr_bf16x8 af[4];
#pragma unroll
          for (int s_ = 0; s_ < 4; ++s_) af[s_] = *(const LAS lr_bf16x8*)(lds + LR_XA + (32 * wave + r32) * 144 + (16 * s_ + 8 * hi) * 2);
#pragma unroll
          for (int gt = 0; gt < 2; ++gt)
#pragma unroll
              for (int nt = 0; nt < 2; ++nt)
#pragma unroll
                  for (int s_ = 0; s_ < 4; ++s_) { const lr_bf16x8 bfr = *(const LAS lr_bf16x8*)(lds + LR_WT + gt * 9216 + (32 * nt + r32) * 144 + (16 * s_ + 8 * hi) * 2);
                      acc[gt][nt] = __builtin_amdgcn_mfma_f32_32x32x16_bf16(af[s_], bfr, acc[gt][nt], 0, 0, 0); } }
#pragma unroll
        for (int nt = 0; nt < 2; ++nt) { const float sp = sp_[nt];
            float sa_[4], sh_[4];
#pragma unroll
            for (int q = 0; q < 4; ++q) { float hrun = 0.f, arun = 1.f;
#pragma unroll
                for (int e = 0; e < 4; ++e) { const int r = 4 * q + e, tl = 8 * q + 4 * hi + e;
                    const float xv = __builtin_bit_cast(float, (unsigned)*(const LAS unsigned short*)(lds + LR_XA + (32 * wave + tl) * 144 + (32 * nt + r32) * 2) << 16);
                    const float rg = __builtin_amdgcn_rcpf(1.f + __builtin_amdgcn_exp2f(-LOG2E * acc[0][nt][r])), ig = __builtin_amdgcn_rcpf(1.f + __builtin_amdgcn_exp2f(-LOG2E * acc[1][nt][r]));
                    const float la = -8.0f * rg * sp; const float a_ = __builtin_amdgcn_exp2f(LOG2E * la);
                    const float uu = __builtin_amdgcn_sqrtf(fmaxf(1.f - a_ * a_, 0.f)) * (ig * xv);
                    hrun = a_ * hrun + uu; arun *= a_; acc[0][nt][r] = arun; acc[1][nt][r] = hrun; }
                sa_[q] = arun; sh_[q] = hrun; }
            float runA = 1.f, runH = 0.f;
#pragma unroll
            for (int q = 0; q < 4; ++q) { float a0 = sa_[q], a1 = sa_[q], h0 = sh_[q], h1 = sh_[q]; lr_swap32(a0, a1); lr_swap32(h0, h1);
                const float midA = runA * a0, midH = a0 * runH + h0;
                const float inA = hi ? midA : runA, inH = hi ? midH : runH;
                runA = midA * a1; runH = a1 * midH + h1;
#pragma unroll
                for (int e = 0; e < 4; ++e) { const int r = 4 * q + e; acc[1][nt][r] += acc[0][nt][r] * inH; acc[0][nt][r] *= inA; } }
            if (hi == 0) { SUM[(wave * 64 + 32 * nt + r32) * 2] = runA; SUM[(wave * 64 + 32 * nt + r32) * 2 + 1] = runH; } }
        __syncthreads();
#pragma unroll
        for (int nt = 0; nt < 2; ++nt) { const int cl = 32 * nt + r32;
            float ca = 1.f, chh = 0.f;
            for (int w = 0; w < wave; ++w) { const float aw = SUM[(w * 64 + cl) * 2], hw = SUM[(w * 64 + cl) * 2 + 1]; chh = aw * chh + hw; ca *= aw; }
            GAS unsigned* ha = P.HA + (size_t)(t0 + 32 * wave + 4 * hi) * 512 + 64 * g + cl;
#pragma unroll
            for (int r = 0; r < 16; ++r) { const float hh = acc[1][nt][r] + acc[0][nt][r] * chh, ac_ = acc[0][nt][r] * ca; ha[(size_t)((r & 3) + 8 * (r >> 2)) * 512] = pk2(hh, ac_);
                if (r == 15 && wave == 7 && hi == 1) { P.LSUM[((size_t)tile * 512 + 64 * g + cl) * 2] = ac_; P.LSUM[((size_t)tile * 512 + 64 * g + cl) * 2 + 1] = hh; } } }
    }
}

struct PostP { const GAS bf16* OMB; const GAS unsigned* HA; const GAS float* LSUM; const GAS bf16* PROJB; const GAS float* gm; const GAS float* gl; GAS bf16* Y; };
__device__ __forceinline__ void post_phase(const PostP& P, LAS unsigned char* lds, int tid, int wave, int lane, int vcu, int G) {
    asm volatile("" : "+v"(tid), "+v"(lane));
    LAS float* hin = (LAS float*)lds;
    for (int u = vcu; u < T / 64; u += G) {
        const int t0 = u * 64, tile = t0 >> 8, tb = tile & ~31;
        __syncthreads();
        { float h = 0.f;
          for (int c0 = tb; c0 < tile; c0 += 8) {
              float av_[8], hv_[8];
#pragma unroll
              for (int i = 0; i < 8; ++i) { const int c = (c0 + i < tile) ? (c0 + i) : tb; av_[i] = P.LSUM[((size_t)c * 512 + tid) * 2]; hv_[i] = P.LSUM[((size_t)c * 512 + tid) * 2 + 1]; }
#pragma unroll
              for (int i = 0; i < 8; ++i) { if (c0 + i < tile) h = av_[i] * h + hv_[i]; } }
          hin[tid] = h; }
        __syncthreads();
        f32x4 hi0 = *(const LAS f32x4*)(hin + 8 * lane), hi1 = *(const LAS f32x4*)(hin + 8 * lane + 4);
        const f32x4 g0 = *(const GAS f32x4*)(P.gl + 8 * lane), g1 = *(const GAS f32x4*)(P.gl + 8 * lane + 4), gmv = *(const GAS f32x4*)(P.gm + 4 * lane);
#pragma unroll 2
        for (int i = 0; i < 8; ++i) {
            const size_t t = (size_t)t0 + 8 * wave + i;
            const v4u p0 = *(const GAS v4u*)(P.HA + t * 512 + 8 * lane), p1 = *(const GAS v4u*)(P.HA + t * 512 + 8 * lane + 4), gw_ = *(const GAS v4u*)(P.PROJB + t * INP + PC_GL + 8 * lane);
            const v2u mw = *(const GAS v2u*)(P.OMB + t * 256 + 4 * lane);
            float o[8];
            o[0] = (bflo(p0.x) + bfhi(p0.x) * hi0.x) * gelu_erf(bflo(gw_.x)); o[1] = (bflo(p0.y) + bfhi(p0.y) * hi0.y) * gelu_erf(bfhi(gw_.x));
            o[2] = (bflo(p0.z) + bfhi(p0.z) * hi0.z) * gelu_erf(bflo(gw_.y)); o[3] = (bflo(p0.w) + bfhi(p0.w) * hi0.w) * gelu_erf(bfhi(gw_.y));
            o[4] = (bflo(p1.x) + bfhi(p1.x) * hi1.x) * gelu_erf(bflo(gw_.z)); o[5] = (bflo(p1.y) + bfhi(p1.y) * hi1.y) * gelu_erf(bfhi(gw_.z));
            o[6] = (bflo(p1.z) + bfhi(p1.z) * hi1.z) * gelu_erf(bflo(gw_.w)); o[7] = (bflo(p1.w) + bfhi(p1.w) * hi1.w) * gelu_erf(bfhi(gw_.w));
            float s2 = 0.f;
#pragma unroll
            for (int e = 0; e < 8; ++e) s2 += o[e] * o[e];
            const float m0 = bflo(mw.x), m1 = bfhi(mw.x), m2 = bflo(mw.y), m3 = bfhi(mw.y);
            float s1 = (m0 * m0 + m1 * m1) + (m2 * m2 + m3 * m3);
            s1 = wave_sum(s1, lane); s2 = wave_sum(s2, lane);
            const float r1 = rsqrtf(s1 * (1.f / 256.f) + 1e-6f), r2 = rsqrtf(s2 * (1.f / 512.f) + 1e-6f);
            GAS bf16* yr = P.Y + t * 1024;
            { v2u w; w.x = pk2(m0 * r1 * gmv.x, m1 * r1 * gmv.y); w.y = pk2(m2 * r1 * gmv.z, m3 * r1 * gmv.w); *(GAS v2u*)(yr + 4 * lane) = w; }
            { v4u w; w.x = pk2(o[0] * r2 * g0.x, o[1] * r2 * g0.y); w.y = pk2(o[2] * r2 * g0.z, o[3] * r2 * g0.w); w.z = pk2(o[4] * r2 * g1.x, o[5] * r2 * g1.y); w.w = pk2(o[6] * r2 * g1.z, o[7] * r2 * g1.w);
              *(GAS v4u*)(yr + 256 + 8 * lane) = w; }
        }
    }
}

#define TILE_BAR() asm volatile("s_waitcnt lgkmcnt(0)\n\ts_barrier" ::: "memory")
typedef short bf16x8 __attribute__((ext_vector_type(8)));
typedef short s16x4 __attribute__((ext_vector_type(4)));
typedef float f32x16 __attribute__((ext_vector_type(16)));
typedef unsigned u32x4 __attribute__((ext_vector_type(4)));
__device__ __forceinline__ int crow(int r, int hi) { return (r & 3) + 8 * (r >> 2) + 4 * hi; }
typedef float f32x2_t __attribute__((ext_vector_type(2))); typedef __bf16 bf16x2_c __attribute__((ext_vector_type(2)));
__device__ __forceinline__ unsigned cvtpk(float lo, float hi) { f32x2_t v = {lo, hi}; bf16x2_c b = __builtin_convertvector(v, bf16x2_c); return __builtin_bit_cast(unsigned, b); }
__device__ __forceinline__ float swapmax(float m) { auto rr = __builtin_amdgcn_permlane32_swap(__float_as_uint(m), __float_as_uint(m), false, false); return fmaxf(__uint_as_float(rr[0]), __uint_as_float(rr[1])); }
__device__ __forceinline__ float swapadd(float m) { auto rr = __builtin_amdgcn_permlane32_swap(__float_as_uint(m), __float_as_uint(m), false, false); return __uint_as_float(rr[0]) + __uint_as_float(rr[1]); }
__device__ __forceinline__ s16x4 vtr(const LAS unsigned char* p) { return __builtin_bit_cast(s16x4, __builtin_amdgcn_ds_read_tr16_b64_v4i16((LAS s16x4*)p)); }
__device__ __forceinline__ bf16x8 pack8(const f32x16& p, int b) { u32x4 w; w.x = cvtpk(p[b], p[b + 1]); w.y = cvtpk(p[b + 2], p[b + 3]); w.z = cvtpk(p[b + 4], p[b + 5]); w.w = cvtpk(p[b + 6], p[b + 7]); return __builtin_bit_cast(bf16x8, w); }
__device__ __forceinline__ float vmax3(float a, float b, float c) { float r; asm("v_max3_f32 %0, %1, %2, %3" : "=v"(r) : "v"(a), "v"(b), "v"(c)); return r; }
__device__ __forceinline__ float max32(const f32x16& p, const f32x16& q) {
    float a = vmax3(p[0], p[1], p[2]), b = vmax3(p[3], p[4], p[5]), c = vmax3(p[6], p[7], p[8]), d = vmax3(p[9], p[10], p[11]), e = vmax3(p[12], p[13], p[14]);
    float f = vmax3(q[0], q[1], q[2]), g = vmax3(q[3], q[4], q[5]), h = vmax3(q[6], q[7], q[8]), i = vmax3(q[9], q[10], q[11]), j = vmax3(q[12], q[13], q[14]);
    a = vmax3(a, b, c); d = vmax3(d, e, p[15]); f = vmax3(f, g, h); i = vmax3(i, j, q[15]);
    return vmax3(vmax3(a, d, f), i, i);
}
__device__ __forceinline__ float max16(const f32x16& p) { float a = fmaxf(fmaxf(p[0], p[1]), fmaxf(p[2], p[3])), b = fmaxf(fmaxf(p[4], p[5]), fmaxf(p[6], p[7])), c = fmaxf(fmaxf(p[8], p[9]), fmaxf(p[10], p[11])), d = fmaxf(fmaxf(p[12], p[13]), fmaxf(p[14], p[15])); return fmaxf(fmaxf(a, b), fmaxf(c, d)); }

struct AttnP {
    const GAS bf16* Q; const GAS bf16* K; const GAS bf16* V; int qp, kp, vp;
    GAS bf16* O; int op;
    const GAS float* rope;
    const GAS int* pos; const GAS float* btab; const GAS float* dnorm; const GAS float* lams;
};
template <int KIND> struct AK {
    static constexpr bool DIFF = KIND == 1, CROSS = KIND == 2;
    static constexpr int HW = KIND == 0 ? 96 : KIND == 1 ? 64 : 256;
    static constexpr int NKS = KIND == 0 ? 6 : KIND == 1 ? 2 : 16;
    static constexpr int KP = KIND == 0 ? 208 : KIND == 1 ? 144 : 528;
    static constexpr int ND = CROSS ? 4 : 2;
    static constexpr int CPK = HW / 8, KCH = (64 * CPK + 511) / 512;
    static constexpr int VCH = ND / 2;
    static constexpr int KB = 64 * KP, VB = ND * 4096;
    static constexpr int NBUF = CROSS ? 2 : 3;
    static constexpr int K0 = 0, V0 = NBUF * KB, POS = V0 + NBUF * VB, BT = POS + 1024, DN = BT + 528, END = DN + 256;
};
static_assert(AK<2>::END <= RING_BYTES && AK<0>::END <= RING_BYTES && AK<1>::END + 16 + 8 * 8192 <= RING_BYTES, "attention LDS");

template <int KIND, bool LEAD>
__device__ __forceinline__ void attn_unit(const AttnP& P, int b, int h, int qb, int dhalf, LAS unsigned char* lds, int tid, int wave, int lane) {
    lane = lane_id_v(); tid = (wave << 6) | lane;
    typedef AK<KIND> C;
    constexpr bool DIFF = C::DIFF, CROSS = C::CROSS;
    constexpr int HW = C::HW, NKS = C::NKS, KP = C::KP, ND = C::ND, CPK = C::CPK, KCH = C::KCH, VCH = C::VCH;
    const int r32 = lane & 31, hi = lane >> 5;
    const size_t rowb = (size_t)b * S, rowk = CROSS ? (size_t)b * MEM : rowb;
    const int q0w = qb * 256 + wave * 32, qi = q0w + r32;
    int pq = 0; float bias_far = 0.f;
    __syncthreads();
    if (DIFF) {
        pq = P.pos[rowb + qi];
        if (tid < 129) ((LAS float*)(lds + C::BT))[tid] = P.btab[h * 129 + tid];
        if (tid >= 192 && tid < 256) ((LAS float*)(lds + C::DN))[tid - 192] = P.dnorm[tid - 192];
    }
    int minq = pq;
    if (DIFF) { for (int o = 1; o < 64; o <<= 1) { const int v = shxi(minq, o, lane); minq = v < minq ? v : minq; } }
    const int NT = CROSS ? MEM / 64 : 4 * (qb + 1);
    u32x4 kr[KCH], vr[VCH]; int pkr = 0;
    u32x4 kr2[CROSS ? 1 : KCH], vr2[CROSS ? 1 : VCH]; int pkr2 = 0;
    const GAS bf16* Kb = P.K + rowk * P.kp + h * HW; const GAS bf16* Vb = P.V + rowk * P.vp + (CROSS ? h * 256 + dhalf * 128 : h * 64);
    const __amdgpu_buffer_rsrc_t rK = __builtin_amdgcn_make_buffer_rsrc((void*)Kb, 0, 0x7fffffff, 0x00020000), rV = __builtin_amdgcn_make_buffer_rsrc((void*)Vb, 0, 0x7fffffff, 0x00020000);
    const __amdgpu_buffer_rsrc_t rP = __builtin_amdgcn_make_buffer_rsrc((void*)(DIFF ? P.pos + rowb : (const GAS int*)Kb), 0, 0x7fffffff, 0x00020000);
    int kvo[KCH], vvo[VCH];
#pragma unroll
    for (int i = 0; i < KCH; ++i) { int c = tid + 512 * i; c = c < 64 * CPK ? c : tid; kvo[i] = ((c / CPK) * P.kp + (c % CPK) * 8) * 2; }
#pragma unroll
    for (int i = 0; i < VCH; ++i) { const int c = tid + 512 * i; vvo[i] = ((c / (4 * ND)) * P.vp + (c % (4 * ND)) * 8) * 2; }
    const int pvo = (tid & 63) * 4;
    auto gload = [&](int t) {
        const int ks = __builtin_amdgcn_readfirstlane(64 * t * P.kp * 2), vs = __builtin_amdgcn_readfirstlane(64 * t * P.vp * 2);
#pragma unroll
        for (int i = 0; i < KCH; ++i) kr[i] = __builtin_amdgcn_raw_buffer_load_b128(rK, kvo[i], ks, 0);
#pragma unroll
        for (int i = 0; i < VCH; ++i) vr[i] = __builtin_amdgcn_raw_buffer_load_b128(rV, vvo[i], vs, 0);
        if (DIFF) pkr = __builtin_amdgcn_raw_buffer_load_b32(rP, pvo, __builtin_amdgcn_readfirstlane(64 * t * 4), 0);
    };
    auto lstore = [&](int buf) {
        LAS unsigned char* kb_ = lds + C::K0 + buf * C::KB; LAS unsigned char* vb_ = lds + C::V0 + buf * C::VB;
#pragma unroll
        for (int i = 0; i < KCH; ++i) { int c = tid + 512 * i; c = c < 64 * CPK ? c : tid; const int key = c / CPK, part = c % CPK; *(LAS u32x4*)(kb_ + key * KP + part * 16) = kr[i]; }
#pragma unroll
        for (int i = 0; i < VCH; ++i) { const int c = tid + 512 * i; const int key = c / (4 * ND), part = c % (4 * ND); *(LAS u32x4*)(vb_ + (part >> 2) * 4096 + (key >> 3) * 512 + (key & 7) * 64 + (part & 3) * 16) = vr[i]; }
        if (DIFF) { ((LAS int*)(lds + C::POS + buf * 256))[tid & 63] = pkr; if (tid < 64) { int mk_ = pkr; for (int o = 1; o < 64; o <<= 1) { const int v = shxi(mk_, o, lane); mk_ = v > mk_ ? v : mk_; } if (tid == 0) ((LAS int*)(lds + C::POS + 768))[buf] = mk_; } }
    };
    auto gloadB = [&](int t) {
        const int ks = __builtin_amdgcn_readfirstlane(64 * t * P.kp * 2), vs = __builtin_amdgcn_readfirstlane(64 * t * P.vp * 2);
#pragma unroll
        for (int i = 0; i < (CROSS ? 1 : KCH); ++i) kr2[i] = __builtin_amdgcn_raw_buffer_load_b128(rK, kvo[i], ks, 0);
#pragma unroll
        for (int i = 0; i < (CROSS ? 1 : VCH); ++i) vr2[i] = __builtin_amdgcn_raw_buffer_load_b128(rV, vvo[i], vs, 0);
        if (DIFF) pkr2 = __builtin_amdgcn_raw_buffer_load_b32(rP, pvo, __builtin_amdgcn_readfirstlane(64 * t * 4), 0);
    };
    auto lstoreB = [&](int buf) {
        LAS unsigned char* kb_ = lds + C::K0 + buf * C::KB; LAS unsigned char* vb_ = lds + C::V0 + buf * C::VB;
#pragma unroll
        for (int i = 0; i < (CROSS ? 1 : KCH); ++i) { int c = tid + 512 * i; c = c < 64 * CPK ? c : tid; const int key = c / CPK, part = c % CPK; *(LAS u32x4*)(kb_ + key * KP + part * 16) = kr2[i]; }
#pragma unroll
        for (int i = 0; i < (CROSS ? 1 : VCH); ++i) { const int c = tid + 512 * i; const int key = c / (4 * ND), part = c % (4 * ND); *(LAS u32x4*)(vb_ + (part >> 2) * 4096 + (key >> 3) * 512 + (key & 7) * 64 + (part & 3) * 16) = vr2[i]; }
        if (DIFF) { ((LAS int*)(lds + C::POS + buf * 256))[tid & 63] = pkr2; if (tid < 64) { int mk_ = pkr2; for (int o = 1; o < 64; o <<= 1) { const int v = shxi(mk_, o, lane); mk_ = v > mk_ ? v : mk_; } if (tid == 0) ((LAS int*)(lds + C::POS + 768))[buf] = mk_; } }
    };
    LAS float* osv = (LAS float*)(lds + ((C::END + 15) & ~15)) + wave * 2048 + lane;
    float il = 0.f;
    f32x16 oA[ND];
#pragma unroll 1
    for (int mp = 0; mp < (DIFF ? 2 : 1); ++mp) {
        bf16x8 qf[NKS];
        { const GAS bf16* qrow = P.Q + (rowb + qi) * P.qp + h * HW + mp * 32;
#pragma unroll
          for (int s = 0; s < NKS; ++s) qf[s] = *(const GAS bf16x8*)(qrow + 16 * s + 8 * hi);
          if (KIND == 0) {
              const GAS float* rp = P.rope + (rowb + qi) * 32 + 8 * hi;
              const f32x4 c0 = *(const GAS f32x4*)rp, c1 = *(const GAS f32x4*)(rp + 4), s0 = *(const GAS f32x4*)(rp + 16), s1 = *(const GAS f32x4*)(rp + 20);
              const u32x4 a = __builtin_bit_cast(u32x4, qf[NKS - 2]), bq = __builtin_bit_cast(u32x4, qf[NKS - 1]); u32x4 ra, rb;
#pragma unroll
              for (int w = 0; w < 4; ++w) { const float cl = w < 2 ? c0[2 * w] : c1[2 * w - 4], ch = w < 2 ? c0[2 * w + 1] : c1[2 * w - 3], sl = w < 2 ? s0[2 * w] : s1[2 * w - 4], sh = w < 2 ? s0[2 * w + 1] : s1[2 * w - 3];
                  const float x1l = bflo(a[w]), x1h = bfhi(a[w]), x2l = bflo(bq[w]), x2h = bfhi(bq[w]);
                  ra[w] = cvtpk(x1l * cl - x2l * sl, x1h * ch - x2h * sh); rb[w] = cvtpk(x1l * sl + x2l * cl, x1h * sh + x2h * ch); }
              qf[NKS - 2] = __builtin_bit_cast(bf16x8, ra); qf[NKS - 1] = __builtin_bit_cast(bf16x8, rb);
          } }
        __syncthreads();
        float m1 = -1e30f, l1 = 0.f;
#pragma unroll
        for (int d = 0; d < ND; ++d)
#pragma unroll
            for (int r = 0; r < 16; ++r) oA[d][r] = 0.f;
        auto qk = [&](int sl, f32x16& sa, f32x16& sb, float init) {
            const LAS unsigned char* kb_ = lds + C::K0 + sl * C::KB + r32 * KP + hi * 16 + mp * 64;
#pragma unroll
            for (int r = 0; r < 16; ++r) { sa[r] = init; sb[r] = init; }
            constexpr int HB = CROSS ? 4 : (NKS > 3 ? 3 : NKS);
#pragma unroll
            for (int s0_ = 0; s0_ < NKS; s0_ += HB) {
                bf16x8 kfa[HB], kfb[HB];
#pragma unroll
                for (int s = 0; s < HB; ++s) { kfa[s] = *(const LAS bf16x8*)(kb_ + (s0_ + s) * 32); kfb[s] = *(const LAS bf16x8*)(kb_ + 32 * KP + (s0_ + s) * 32); }
                __builtin_amdgcn_sched_barrier(0);
#pragma unroll
                for (int s = 0; s < HB; ++s) { sa = __builtin_amdgcn_mfma_f32_32x32x16_bf16(kfa[s], qf[s0_ + s], sa, 0, 0, 0); sb = __builtin_amdgcn_mfma_f32_32x32x16_bf16(kfb[s], qf[s0_ + s], sb, 0, 0, 0); }
                __builtin_amdgcn_sched_barrier(0);
            }
        };
        auto isnear = [&](int sl) { bool nb = false;
            if (DIFF) { const int mk_ = __builtin_amdgcn_readfirstlane(((LAS int*)(lds + C::POS + 768))[sl]); nb = (minq - mk_) < 128; }
            return nb; };
        auto sm = [&](int t, int sl, f32x16& pa, f32x16& pb, bool nearb) -> float {
            const int k0 = 64 * t;
            if (DIFF) { if (nearb) {
                const LAS int* pk = (const LAS int*)(lds + C::POS + sl * 256); const LAS float* bt = (const LAS float*)(lds + C::BT);
#pragma unroll
                for (int r = 0; r < 16; ++r) { const int kk = crow(r, hi);
                    int n0 = pq - pk[kk], n1 = pq - pk[kk + 32]; n0 = n0 < 0 ? 0 : (n0 > 128 ? 128 : n0); n1 = n1 < 0 ? 0 : (n1 > 128 ? 128 : n1);
                    pa[r] += bt[n0]; pb[r] += bt[n1]; }
            } }
            if (!CROSS && k0 + 63 > q0w) {
#pragma unroll
                for (int r = 0; r < 16; ++r) { const int kk = k0 + crow(r, hi); if (kk > qi) pa[r] = -1e30f; if (kk + 32 > qi) pb[r] = -1e30f; }
            }
            asm volatile("s_nop 15\n\ts_nop 7" : "+v"(pa), "+v"(pb));
            float mn, al = 1.f;
            if (CROSS) { const float mx = swapmax(max32(pa, pb)); mn = fmaxf(m1, mx); al = __builtin_amdgcn_exp2f(m1 - mn); l1 *= al; }
            else { const float mx = swapmax(max32(pa, pb)); const bool up = mx > m1 + 8.0f; mn = up ? mx : m1;
                   if (__builtin_amdgcn_ballot_w64(up) != 0ull) { al = __builtin_amdgcn_exp2f(m1 - mn); l1 *= al; } }
            m1 = mn;
            float ls = 0.f;
#pragma unroll
            for (int r = 0; r < 16; ++r) { pa[r] = __builtin_amdgcn_exp2f(pa[r] - mn); pb[r] = __builtin_amdgcn_exp2f(pb[r] - mn); ls += pa[r] + pb[r]; }
            l1 += ls;
            return al;
        };
        auto pv = [&](int sl, const f32x16& pa, const f32x16& pb, float al) {
            const LAS unsigned char* vb_ = lds + C::V0 + sl * C::VB + ((lane >> 4) & 1) * 32 + (lane & 3) * 8 + (4 * hi + ((lane & 15) >> 2)) * 64;
            bf16x8 pf[4];
            pf[0] = pack8(pa, 0); pf[1] = pack8(pa, 8); pf[2] = pack8(pb, 0); pf[3] = pack8(pb, 8);
            const bool resc = CROSS ? true : (__builtin_amdgcn_ballot_w64(al != 1.0f) != 0ull);
            if (CROSS) {
#pragma unroll
                for (int d = 0; d < ND; ++d) {
                    __builtin_amdgcn_sched_barrier(0);
#pragma unroll
                    for (int r = 0; r < 16; ++r) oA[d][r] *= al;
                    bf16x8 vf[4];
#pragma unroll
                    for (int s = 0; s < 4; ++s) { const s16x4 lo = vtr(vb_ + d * 4096 + s * 1024), hh = vtr(vb_ + d * 4096 + s * 1024 + 512); vf[s] = (bf16x8){lo[0], lo[1], lo[2], lo[3], hh[0], hh[1], hh[2], hh[3]}; }
#pragma unroll
                    for (int s = 0; s < 4; ++s) oA[d] = __builtin_amdgcn_mfma_f32_32x32x16_bf16(vf[s], pf[s], oA[d], 0, 0, 0);
                }
            } else if (DIFF) {
                if (resc) {
#pragma unroll
                    for (int d = 0; d < 2; ++d)
#pragma unroll
                        for (int r = 0; r < 16; ++r) oA[d][r] *= al;
                }
#pragma unroll
                for (int d = 0; d < 2; ++d) {
                    bf16x8 vf[4];
#pragma unroll
                    for (int s = 0; s < 4; ++s) { const s16x4 lo = vtr(vb_ + d * 4096 + s * 1024), hh = vtr(vb_ + d * 4096 + s * 1024 + 512); vf[s] = (bf16x8){lo[0], lo[1], lo[2], lo[3], hh[0], hh[1], hh[2], hh[3]}; }
                    __builtin_amdgcn_sched_barrier(0);
#pragma unroll
                    for (int s = 0; s < 4; ++s) oA[d] = __builtin_amdgcn_mfma_f32_32x32x16_bf16(vf[s], pf[s], oA[d], 0, 0, 0);
                }
            } else {
                bf16x8 vf[2][4];
#pragma unroll
                for (int d = 0; d < 2; ++d)
#pragma unroll
                    for (int s = 0; s < 4; ++s) { const s16x4 lo = vtr(vb_ + d * 4096 + s * 1024), hh = vtr(vb_ + d * 4096 + s * 1024 + 512); vf[d][s] = (bf16x8){lo[0], lo[1], lo[2], lo[3], hh[0], hh[1], hh[2], hh[3]}; }
                if (resc) {
#pragma unroll
                    for (int d = 0; d < 2; ++d)
#pragma unroll
                        for (int r = 0; r < 16; ++r) oA[d][r] *= al;
                }
                __builtin_amdgcn_sched_barrier(0);
#pragma unroll
                for (int s = 0; s < 4; ++s)
#pragma unroll
                    for (int d = 0; d < 2; ++d) oA[d] = __builtin_amdgcn_mfma_f32_32x32x16_bf16(vf[d][s], pf[s], oA[d], 0, 0, 0);
            }
        };
        if (CROSS) {
            gload(0); lstore(0);
            __syncthreads();
            for (int t = 0; t < NT; ++t) {
                const int buf = t & 1;
                f32x16 pa, pb;
                qk(buf, pa, pb, 0.f);
                const float al = sm(t, buf, pa, pb, false);
                pv(buf, pa, pb, al);
                if (t + 1 < NT) { gload(t + 1); lstore(buf ^ 1); }
                TILE_BAR();
            }
        } else {
            gload(0); lstore(0); gload(1); lstore(1);
            gload(2); gloadB(3);
            __syncthreads();
            if (DIFF) bias_far = ((LAS float*)(lds + C::BT))[128];
            const int NTW = (q0w + 31) / 64 + 1;
            constexpr bool lead = LEAD;
            f32x16 ca, cb, na, nb; bool cnear = isnear(0), nnear = false; float cal = 1.f;
            qk(0, ca, cb, (DIFF && !cnear) ? bias_far : 0.f);
            if (lead) cal = sm(0, 0, ca, cb, cnear);
            int s0 = 0, s1 = 1, s2 = 2;
            auto period = [&](int t, f32x16& xa, f32x16& xb, bool& xnear, f32x16& ya, f32x16& yb, bool& ynear) {
                const bool have_next = (t + 1 < NTW);
                if (lead) {
                    if (have_next) { ynear = isnear(s1); qk(s1, ya, yb, (DIFF && !ynear) ? bias_far : 0.f); }
                    if (t < NTW) pv(s0, xa, xb, cal);
                    if (have_next) cal = sm(t + 1, s1, ya, yb, ynear);
                } else {
                    if (t < NTW) cal = sm(t, s0, xa, xb, xnear);
                    if (have_next) { ynear = isnear(s1); qk(s1, ya, yb, (DIFF && !ynear) ? bias_far : 0.f); }
                    if (t < NTW) pv(s0, xa, xb, cal);
                }
                { const int tmp = s0; s0 = s1; s1 = s2; s2 = tmp; }
            };
            int t = 0;
            for (; t + 5 < NT; t += 2) {
                lstore(s2); gload(t + 4);
                period(t, ca, cb, cnear, na, nb, nnear);
                TILE_BAR();
                lstoreB(s2); gloadB(t + 5);
                period(t + 1, na, nb, nnear, ca, cb, cnear);
                TILE_BAR();
            }
            for (; t < NT; t += 2) {
                if (t + 2 < NT) { lstore(s2); if (t + 4 < NT) gload(t + 4); }
                period(t, ca, cb, cnear, na, nb, nnear);
                TILE_BAR();
                if (t + 3 < NT) { lstoreB(s2); if (t + 5 < NT) gloadB(t + 5); }
                period(t + 1, na, nb, nnear, ca, cb, cnear);
                TILE_BAR();
            }
        }
        il = 1.f / swapadd(l1);
        if (DIFF) { if (mp == 0) {
#pragma unroll
            for (int d = 0; d < 2; ++d)
#pragma unroll
                for (int r = 0; r < 16; ++r) osv[(d * 16 + r) * 64] = oA[d][r] * il; } }
    }
    GAS bf16* orow = P.O + (rowb + qi) * P.op + (CROSS ? h * 256 + dhalf * 128 : h * 64);
    if (!DIFF) {
#pragma unroll
        for (int d = 0; d < ND; ++d)
#pragma unroll
            for (int g = 0; g < 4; ++g) { v2u v; v.x = cvtpk(oA[d][4 * g] * il, oA[d][4 * g + 1] * il); v.y = cvtpk(oA[d][4 * g + 2] * il, oA[d][4 * g + 3] * il); *(GAS v2u*)(orow + 32 * d + 8 * g + 4 * hi) = v; }
    } else {
        const float lam = P.lams[0], lam_init = P.lams[1];
        const float i2 = lam * il;
        float ss = 0.f;
#pragma unroll
        for (int d = 0; d < 2; ++d)
#pragma unroll
            for (int r = 0; r < 16; ++r) { const float v = osv[(d * 16 + r) * 64] - oA[d][r] * i2; oA[d][r] = v; ss += v * v; }
        ss = swapadd(ss);
        const float rs = __builtin_amdgcn_rsqf(ss * (1.f / 64.f) + 1e-6f) * (1.f - lam_init);
        const LAS float* dn = (const LAS float*)(lds + C::DN);
#pragma unroll
        for (int d = 0; d < 2; ++d)
#pragma unroll
            for (int g = 0; g < 4; ++g) { const int c = 32 * d + 8 * g + 4 * hi; const f32x4 gn = *(const LAS f32x4*)(dn + c);
                v2u v; v.x = cvtpk(oA[d][4 * g] * rs * gn[0], oA[d][4 * g + 1] * rs * gn[1]); v.y = cvtpk(oA[d][4 * g + 2] * rs * gn[2], oA[d][4 * g + 3] * rs * gn[3]); *(GAS v2u*)(orow + c) = v; }
    }
}

__device__ __forceinline__ int wave_max_i(int v) {
    { const int o = __builtin_amdgcn_update_dpp(0, v, 0xB1, 0xF, 0xF, true); v = o > v ? o : v; }
    { const int o = __builtin_amdgcn_update_dpp(0, v, 0x4E, 0xF, 0xF, true); v = o > v ? o : v; }
    { const int o = __builtin_amdgcn_update_dpp(0, v, 0x141, 0xF, 0xF, true); v = o > v ? o : v; }
    { const int o = __builtin_amdgcn_update_dpp(0, v, 0x140, 0xF, 0xF, true); v = o > v ? o : v; }
    { int a = v, b = v; asm volatile("v_nop\n\tv_nop\n\tv_permlane16_swap_b32 %0, %1" : "+v"(a), "+v"(b)); v = a > b ? a : b; }
    { int a = v, b = v; asm volatile("v_nop\n\tv_nop\n\tv_permlane32_swap_b32 %0, %1" : "+v"(a), "+v"(b)); v = a > b ? a : b; }
    return v;
}
template <int KIND> struct AK2 {
    static constexpr bool DIFF = KIND == 1;
    static constexpr int HW = KIND == 0 ? 96 : 64, NKS = KIND == 0 ? 6 : 2, KP = KIND == 0 ? 208 : 144;
    static constexpr int CPK = HW / 8, KCH = (128 * CPK) / 512, VCH = 2;
    static constexpr int KB = 128 * KP, VB = 2 * 8192;
    static constexpr int K0 = 0, V0 = 2 * KB, POS = V0 + 2 * VB, PMX = POS + 1024, BT = PMX + 16, DN = BT + 528, OSV = (DN + 256 + 15) & ~15, END = OSV + (DIFF ? 8 * 8192 : 0);
};
static_assert(AK2<0>::END <= RING_BYTES && AK2<1>::END <= RING_BYTES, "attention LDS (128-key tiles)");
template <int KIND>
__device__ __forceinline__ void attn_unit2(const AttnP& P, int b, int h, int qb, LAS unsigned char* lds, int tid, int wave, int lane) {
    lane = lane_id_v(); tid = (wave << 6) | lane;
    typedef AK2<KIND> C;
    constexpr bool DIFF = C::DIFF;
    constexpr int HW = C::HW, NKS = C::NKS, KP = C::KP, CPK = C::CPK, KCH = C::KCH, VCH = C::VCH;
    const int r32 = lane & 31, hi = lane >> 5;
    const size_t rowb = (size_t)b * S;
    const int q0w = qb * 256 + wave * 32, qi = q0w + r32;
    int pq = 0; float bias_far = 0.f;
    __syncthreads();
    if (DIFF) {
        pq = P.pos[rowb + qi];
        if (tid < 129) ((LAS float*)(lds + C::BT))[tid] = P.btab[h * 129 + tid];
        if (tid >= 192 && tid < 256) ((LAS float*)(lds + C::DN))[tid - 192] = P.dnorm[tid - 192];
    }
    int minq = pq;
    if (DIFF) minq = __builtin_amdgcn_readfirstlane(-wave_max_i(-pq));
    const int NT = 2 * (qb + 1);
    const GAS bf16* Kb = P.K + rowb * P.kp + h * HW; const GAS bf16* Vb = P.V + rowb * P.vp + h * 64;
    const __amdgpu_buffer_rsrc_t rK = __builtin_amdgcn_make_buffer_rsrc((void*)Kb, 0, 0x7fffffff, 0x00020000), rV = __builtin_amdgcn_make_buffer_rsrc((void*)Vb, 0, 0x7fffffff, 0x00020000);
    const __amdgpu_buffer_rsrc_t rP = __builtin_amdgcn_make_buffer_rsrc((void*)(DIFF ? P.pos + rowb : (const GAS int*)Kb), 0, 0x7fffffff, 0x00020000);
    int kvo[KCH], vvo[VCH], klo[KCH], vlo[VCH];
#pragma unroll
    for (int i = 0; i < KCH; ++i) { const int c = tid + 512 * i; kvo[i] = ((c / CPK) * P.kp + (c % CPK) * 8) * 2; klo[i] = (c / CPK) * KP + (c % CPK) * 16; }
#pragma unroll
    for (int i = 0; i < VCH; ++i) { const int c = tid + 512 * i; const int key = c >> 3, part = c & 7; vvo[i] = (key * P.vp + part * 8) * 2; vlo[i] = (part >> 2) * 8192 + (key >> 3) * 512 + (key & 7) * 64 + (part & 3) * 16; }
    const int pvo = (tid & 127) * 4;
    u32x4 kr[KCH], vr[VCH]; int pkr = 0;
    auto gload = [&](int t) {
        const int ks = __builtin_amdgcn_readfirstlane(128 * t * P.kp * 2), vs = __builtin_amdgcn_readfirstlane(128 * t * P.vp * 2);
#pragma unroll
        for (int i = 0; i < KCH; ++i) kr[i] = __builtin_amdgcn_raw_buffer_load_b128(rK, kvo[i], ks, 0);
#pragma unroll
        for (int i = 0; i < VCH; ++i) vr[i] = __builtin_amdgcn_raw_buffer_load_b128(rV, vvo[i], vs, 0);
        if (DIFF) pkr = __builtin_amdgcn_raw_buffer_load_b32(rP, pvo, __builtin_amdgcn_readfirstlane(128 * t * 4), 0);
    };
    auto lstore = [&](int buf) {
        LAS unsigned char* kb_ = lds + C::K0 + buf * C::KB; LAS unsigned char* vb_ = lds + C::V0 + buf * C::VB;
#pragma unroll
        for (int i = 0; i < KCH; ++i) *(LAS u32x4*)(kb_ + klo[i]) = kr[i];
#pragma unroll
        for (int i = 0; i < VCH; ++i) *(LAS u32x4*)(vb_ + vlo[i]) = vr[i];
        if (DIFF) { ((LAS int*)(lds + C::POS + buf * 512))[tid & 127] = pkr;
            if (tid < 128) { const int mk_ = wave_max_i(pkr); if (lane == 0) ((LAS int*)(lds + C::PMX))[buf * 2 + wave] = mk_; } }
    };
    LAS float* osv = (LAS float*)(lds + C::OSV) + wave * 2048 + lane;
    float il = 0.f;
    f32x16 oA[2];
#pragma unroll 1
    for (int mp = 0; mp < (DIFF ? 2 : 1); ++mp) {
        bf16x8 qf[NKS];
        { const GAS bf16* qrow = P.Q + (rowb + qi) * P.qp + h * HW + mp * 32;
#pragma unroll
          for (int s = 0; s < NKS; ++s) qf[s] = *(const GAS bf16x8*)(qrow + 16 * s + 8 * hi);
          if (KIND == 0) {
              const GAS float* rp = P.rope + (rowb + qi) * 32 + 8 * hi;
              const f32x4 c0 = *(const GAS f32x4*)rp, c1 = *(const GAS f32x4*)(rp + 4), s0 = *(const GAS f32x4*)(rp + 16), s1 = *(const GAS f32x4*)(rp + 20);
              const u32x4 a = __builtin_bit_cast(u32x4, qf[NKS - 2]), bq = __builtin_bit_cast(u32x4, qf[NKS - 1]); u32x4 ra, rb;
#pragma unroll
              for (int w = 0; w < 4; ++w) { const float cl = w < 2 ? c0[2 * w] : c1[2 * w - 4], ch = w < 2 ? c0[2 * w + 1] : c1[2 * w - 3], sl = w < 2 ? s0[2 * w] : s1[2 * w - 4], sh = w < 2 ? s0[2 * w + 1] : s1[2 * w - 3];
                  const float x1l = bflo(a[w]), x1h = bfhi(a[w]), x2l = bflo(bq[w]), x2h = bfhi(bq[w]);
                  ra[w] = cvtpk(x1l * cl - x2l * sl, x1h * ch - x2h * sh); rb[w] = cvtpk(x1l * sl + x2l * cl, x1h * sh + x2h * ch); }
              qf[NKS - 2] = __builtin_bit_cast(bf16x8, ra); qf[NKS - 1] = __builtin_bit_cast(bf16x8, rb);
          } }
        __syncthreads();
        float m1 = 0.f, l1 = 0.f;
        f32x16 negm;
#pragma unroll
        for (int r = 0; r < 16; ++r) negm[r] = 0.f;
#pragma unroll
        for (int d = 0; d < 2; ++d)
#pragma unroll
            for (int r = 0; r < 16; ++r) oA[d][r] = 0.f;
        gload(0); lstore(0);
        if (NT > 1) gload(1);
        __syncthreads();
        if (DIFF) { bias_far = ((LAS float*)(lds + C::BT))[128];
#pragma unroll
            for (int r = 0; r < 16; ++r) negm[r] = bias_far; }
        const int NTW = (q0w + 31) / 128 + 1;
        auto compute = [&](int t, int buf) {
            const int k0 = 128 * t;
            const LAS unsigned char* kb_ = lds + C::K0 + buf * C::KB + r32 * KP + hi * 16 + mp * 64;
            const LAS unsigned char* vb_ = lds + C::V0 + buf * C::VB + ((lane >> 4) & 1) * 32 + (lane & 3) * 8 + (4 * hi + ((lane & 15) >> 2)) * 64;
            bool nearb = false;
            if (DIFF) { const LAS int* pm = (const LAS int*)(lds + C::PMX) + buf * 2; const int m0 = __builtin_amdgcn_readfirstlane(pm[0]), m1_ = __builtin_amdgcn_readfirstlane(pm[1]); nearb = (minq - (m0 > m1_ ? m0 : m1_)) < 128; }
            f32x16 sc[4];
            if (DIFF) { if (nearb) {
#pragma unroll
                for (int g = 0; g < 4; ++g)
#pragma unroll
                    for (int r = 0; r < 16; ++r) sc[g][r] = -m1; } }
            if (!DIFF) {
                bf16x8 kq[4 * NKS];
#pragma unroll
                for (int i = 0; i < 4 * NKS; ++i) kq[i] = *(const LAS bf16x8*)(kb_ + 32 * (i & 3) * KP + (i >> 2) * 32);
#pragma unroll
                for (int i = 0; i < 4 * NKS; ++i) sc[i & 3] = __builtin_amdgcn_mfma_f32_32x32x16_bf16(kq[i], qf[i >> 2], i < 4 ? negm : sc[i & 3], 0, 0, 0);
                __builtin_amdgcn_sched_group_barrier(0x100, 4, 0);
#pragma unroll
                for (int i = 0; i < 4 * NKS - 4; ++i) { __builtin_amdgcn_sched_group_barrier(0x008, 1, 0); __builtin_amdgcn_sched_group_barrier(0x100, 1, 0); }
                __builtin_amdgcn_sched_group_barrier(0x008, 4, 0);
                __builtin_amdgcn_sched_barrier(0);
            } else {
            constexpr int HB = NKS > 3 ? 3 : NKS;
#pragma unroll
            for (int s0_ = 0; s0_ < NKS; s0_ += HB) {
                bf16x8 kf[4][HB];
#pragma unroll
                for (int g = 0; g < 4; ++g)
#pragma unroll
                    for (int s = 0; s < HB; ++s) kf[g][s] = *(const LAS bf16x8*)(kb_ + 32 * g * KP + (s0_ + s) * 32);
                __builtin_amdgcn_sched_barrier(0);
#pragma unroll
                for (int s = 0; s < HB; ++s)
#pragma unroll
                    for (int g = 0; g < 4; ++g) {
                        if (s0_ + s == 0 && !(DIFF && nearb)) sc[g] = __builtin_amdgcn_mfma_f32_32x32x16_bf16(kf[g][s], qf[s0_ + s], negm, 0, 0, 0);
                        else sc[g] = __builtin_amdgcn_mfma_f32_32x32x16_bf16(kf[g][s], qf[s0_ + s], sc[g], 0, 0, 0); }
                __builtin_amdgcn_sched_barrier(0);
            }
            }
            if (DIFF) { if (nearb) {
                const LAS int* pk = (const LAS int*)(lds + C::POS + buf * 512); const LAS float* bt = (const LAS float*)(lds + C::BT);
#pragma unroll
                for (int g = 0; g < 4; ++g)
#pragma unroll
                    for (int r = 0; r < 16; ++r) { int n0 = pq - pk[32 * g + crow(r, hi)]; n0 = n0 < 0 ? 0 : (n0 > 128 ? 128 : n0); sc[g][r] += bt[n0]; }
            } }
            asm volatile("s_nop 15\n\ts_nop 7" : "+v"(sc[0]), "+v"(sc[1]), "+v"(sc[2]), "+v"(sc[3]));
            if (k0 + 127 > q0w) {
#pragma unroll
                for (int g = 0; g < 4; ++g)
#pragma unroll
                    for (int r = 0; r < 16; ++r) { if (k0 + 32 * g + crow(r, hi) > qi) sc[g][r] = -1e30f; }
            }
            const float mx = swapmax(vmax3(max32(sc[0], sc[1]), max32(sc[2], sc[3]), -1e30f));
            const bool up = (t == 0) || mx > 8.0f;
            float al = 1.f;
            if (__builtin_amdgcn_ballot_w64(up) != 0ull) {
                const float dl = up ? mx : 0.f; al = __builtin_amdgcn_exp2f(-dl); l1 *= al; m1 += dl;
#pragma unroll
                for (int r = 0; r < 16; ++r) negm[r] -= dl;
#pragma unroll
                for (int g = 0; g < 4; ++g)
#pragma unroll
                    for (int r = 0; r < 16; ++r) sc[g][r] -= dl;
            }
            float ls = 0.f;
#pragma unroll
            for (int g = 0; g < 4; ++g)
#pragma unroll
                for (int r = 0; r < 16; ++r) { sc[g][r] = __builtin_amdgcn_exp2f(sc[g][r]); ls += sc[g][r]; }
            l1 += ls;
            bf16x8 pf[8];
#pragma unroll
            for (int g = 0; g < 4; ++g) { pf[2 * g] = pack8(sc[g], 0); pf[2 * g + 1] = pack8(sc[g], 8); }
            if (__builtin_amdgcn_ballot_w64(al != 1.0f) != 0ull) {
#pragma unroll
                for (int d = 0; d < 2; ++d)
#pragma unroll
                    for (int r = 0; r < 16; ++r) oA[d][r] *= al;
            }
            if (!DIFF) {
                bf16x8 vq[16];
#pragma unroll
                for (int i = 0; i < 16; ++i) { const int d = i & 1, s = i >> 1; const s16x4 lo = vtr(vb_ + d * 8192 + s * 1024), hh = vtr(vb_ + d * 8192 + s * 1024 + 512); vq[i] = (bf16x8){lo[0], lo[1], lo[2], lo[3], hh[0], hh[1], hh[2], hh[3]}; }
#pragma unroll
                for (int i = 0; i < 16; ++i) oA[i & 1] = __builtin_amdgcn_mfma_f32_32x32x16_bf16(vq[i], pf[i >> 1], oA[i & 1], 0, 0, 0);
                __builtin_amdgcn_sched_group_barrier(0x100, 4, 0);
#pragma unroll
                for (int i = 0; i < 14; ++i) { __builtin_amdgcn_sched_group_barrier(0x008, 1, 0); __builtin_amdgcn_sched_group_barrier(0x100, 2, 0); }
                __builtin_amdgcn_sched_group_barrier(0x008, 2, 0);
                __builtin_amdgcn_sched_barrier(0);
            } else {
#pragma unroll
            for (int d = 0; d < 2; ++d) {
                bf16x8 vf[8];
#pragma unroll
                for (int s = 0; s < 8; ++s) { const s16x4 lo = vtr(vb_ + d * 8192 + s * 1024), hh = vtr(vb_ + d * 8192 + s * 1024 + 512); vf[s] = (bf16x8){lo[0], lo[1], lo[2], lo[3], hh[0], hh[1], hh[2], hh[3]}; }
                __builtin_amdgcn_sched_barrier(0);
#pragma unroll
                for (int s = 0; s < 8; ++s) oA[d] = __builtin_amdgcn_mfma_f32_32x32x16_bf16(vf[s], pf[s], oA[d], 0, 0, 0);
                __builtin_amdgcn_sched_barrier(0);
            }
            }
        };
        int t = 0;
        for (; t + 2 < NT; ++t) {
            const int buf = t & 1;
            if (t < NTW) compute(t, buf);
            lstore(buf ^ 1); gload(t + 2);
            TILE_BAR();
        }
        for (; t < NT; ++t) {
            const int buf = t & 1;
            if (t < NTW) compute(t, buf);
            if (t + 1 < NT) lstore(buf ^ 1);
            TILE_BAR();
        }
        il = 1.f / swapadd(l1);
        if (DIFF) { if (mp == 0) {
#pragma unroll
            for (int d = 0; d < 2; ++d)
#pragma unroll
                for (int r = 0; r < 16; ++r) osv[(d * 16 + r) * 64] = oA[d][r] * il; } }
    }
    GAS bf16* orow = P.O + (rowb + qi) * P.op + h * 64;
    if (!DIFF) {
#pragma unroll
        for (int d = 0; d < 2; ++d)
#pragma unroll
            for (int g = 0; g < 4; ++g) { v2u v; v.x = cvtpk(oA[d][4 * g] * il, oA[d][4 * g + 1] * il); v.y = cvtpk(oA[d][4 * g + 2] * il, oA[d][4 * g + 3] * il); *(GAS v2u*)(orow + 32 * d + 8 * g + 4 * hi) = v; }
    } else {
        const float lam = P.lams[0], lam_init = P.lams[1];
        const float i2 = lam * il;
        float ss = 0.f;
#pragma unroll
        for (int d = 0; d < 2; ++d)
#pragma unroll
            for (int r = 0; r < 16; ++r) { const float v = osv[(d * 16 + r) * 64] - oA[d][r] * i2; oA[d][r] = v; ss += v * v; }
        ss = swapadd(ss);
        const float rs = __builtin_amdgcn_rsqf(ss * (1.f / 64.f) + 1e-6f) * (1.f - lam_init);
        const LAS float* dn = (const LAS float*)(lds + C::DN);
#pragma unroll
        for (int d = 0; d < 2; ++d)
#pragma unroll
            for (int g = 0; g < 4; ++g) { const int c = 32 * d + 8 * g + 4 * hi; const f32x4 gn = *(const LAS f32x4*)(dn + c);
                v2u v; v.x = cvtpk(oA[d][4 * g] * rs * gn[0], oA[d][4 * g + 1] * rs * gn[1]); v.y = cvtpk(oA[d][4 * g + 2] * rs * gn[2], oA[d][4 * g + 3] * rs * gn[3]); *(GAS v2u*)(orow + c) = v; }
    }
}

struct AKD {
    static constexpr int KP = 144, KB = 64 * KP, VB = 2 * 4096;
    static constexpr int K0 = 0, V0 = 2 * KB, POS = V0 + 2 * VB, PMX = POS + 512, BT = PMX + 16, DN = BT + 528, END = DN + 256;
};
static_assert(AKD::END <= RING_BYTES, "attention LDS (merged differential maps)");
__device__ __forceinline__ void attn_diff_unit(const AttnP& P, int b, int h, int qb, LAS unsigned char* lds, int wave) {
    const int lane = lane_id_v(), tid = (wave << 6) | lane;
    typedef AKD C;
    constexpr int KP = C::KP;
    const int r32 = lane & 31, hi = lane >> 5;
    const size_t rowb = (size_t)b * S;
    const int q0w = qb * 256 + wave * 32, qi = q0w + r32;
    __syncthreads();
    const int pq = P.pos[rowb + qi];
    if (tid < 129) ((LAS float*)(lds + C::BT))[tid] = P.btab[h * 129 + tid];
    if (tid >= 192 && tid < 256) ((LAS float*)(lds + C::DN))[tid - 192] = P.dnorm[tid - 192];
    const int minq = __builtin_amdgcn_readfirstlane(-wave_max_i(-pq));
    const int NT = 4 * (qb + 1);
    const GAS bf16* Kb = P.K + rowb * P.kp + h * 64; const GAS bf16* Vb = P.V + rowb * P.vp + h * 64;
    const __amdgpu_buffer_rsrc_t rK = __builtin_amdgcn_make_buffer_rsrc((void*)Kb, 0, 0x7fffffff, 0x00020000), rV = __builtin_amdgcn_make_buffer_rsrc((void*)Vb, 0, 0x7fffffff, 0x00020000);
    const __amdgpu_buffer_rsrc_t rP = __builtin_amdgcn_make_buffer_rsrc((void*)(P.pos + rowb), 0, 0x7fffffff, 0x00020000);
    const int skey = tid >> 3, spart = tid & 7;
    const int kvo = (skey * P.kp + spart * 8) * 2, vvo = (skey * P.vp + spart * 8) * 2, klo = skey * KP + spart * 16, vlo = (spart >> 2) * 4096 + (skey >> 3) * 512 + (skey & 7) * 64 + (spart & 3) * 16;
    const int pvo = (tid & 63) * 4;
    u32x4 kr, vr; int pkr = 0;
    auto gload = [&](int t) {
        kr = __builtin_amdgcn_raw_buffer_load_b128(rK, kvo, __builtin_amdgcn_readfirstlane(64 * t * P.kp * 2), 0);
        vr = __builtin_amdgcn_raw_buffer_load_b128(rV, vvo, __builtin_amdgcn_readfirstlane(64 * t * P.vp * 2), 0);
        pkr = __builtin_amdgcn_raw_buffer_load_b32(rP, pvo, __builtin_amdgcn_readfirstlane(64 * t * 4), 0);
    };
    auto lstore = [&](int buf) {
        *(LAS u32x4*)(lds + C::K0 + buf * C::KB + klo) = kr; *(LAS u32x4*)(lds + C::V0 + buf * C::VB + vlo) = vr;
        if (tid < 64) { ((LAS int*)(lds + C::POS + buf * 256))[tid] = pkr; const int mk_ = wave_max_i(pkr); if (lane == 0) ((LAS int*)(lds + C::PMX))[buf] = mk_; }
    };
    gload(0);
    bf16x8 qf[2][2];
    { const GAS bf16* qrow = P.Q + (rowb + qi) * P.qp + h * 64;
#pragma unroll
      for (int mp = 0; mp < 2; ++mp)
#pragma unroll
          for (int s_ = 0; s_ < 2; ++s_) qf[mp][s_] = *(const GAS bf16x8*)(qrow + 32 * mp + 16 * s_ + 8 * hi); }
    __syncthreads();
    lstore(0);
    if (NT > 1) gload(1);
    __syncthreads();
    const float bias_far = ((LAS float*)(lds + C::BT))[128];
    float m_[2] = {0.f, 0.f}, l_[2] = {0.f, 0.f};
    f32x16 negm[2], oA[2][2];
#pragma unroll
    for (int mp = 0; mp < 2; ++mp) {
#pragma unroll
        for (int r = 0; r < 16; ++r) { negm[mp][r] = bias_far; oA[mp][0][r] = 0.f; oA[mp][1][r] = 0.f; } }
    const int NTW = (q0w + 31) / 64 + 1;
    auto compute = [&](int t, int buf) {
        const int k0 = 64 * t;
        const LAS unsigned char* kb_ = lds + C::K0 + buf * C::KB + r32 * KP + hi * 16;
        const LAS unsigned char* vb_ = lds + C::V0 + buf * C::VB + ((lane >> 4) & 1) * 32 + (lane & 3) * 8 + (4 * hi + ((lane & 15) >> 2)) * 64;
        const bool nearb = (minq - __builtin_amdgcn_readfirstlane(((const LAS int*)(lds + C::PMX))[buf])) < 128;
        const bool diag = k0 + 63 > q0w;
        bf16x8 pf[2][4];
#pragma unroll
        for (int mp = 0; mp < 2; ++mp) {
            f32x16 sc[2];
            bf16x8 kf[2][2];
#pragma unroll
            for (int g = 0; g < 2; ++g)
#pragma unroll
                for (int s_ = 0; s_ < 2; ++s_) kf[g][s_] = *(const LAS bf16x8*)(kb_ + 32 * g * KP + mp * 64 + s_ * 32);
            if (nearb) {
#pragma unroll
                for (int g = 0; g < 2; ++g) {
#pragma unroll
                    for (int r = 0; r < 16; ++r) sc[g][r] = -m_[mp];
#pragma unroll
                    for (int s_ = 0; s_ < 2; ++s_) sc[g] = __builtin_amdgcn_mfma_f32_32x32x16_bf16(kf[g][s_], qf[mp][s_], sc[g], 0, 0, 0); }
                const LAS int* pk = (const LAS int*)(lds + C::POS + buf * 256); const LAS float* bt = (const LAS float*)(lds + C::BT);
#pragma unroll
                for (int g = 0; g < 2; ++g)
#pragma unroll
                    for (int r = 0; r < 16; ++r) { int n0 = pq - pk[32 * g + crow(r, hi)]; n0 = n0 < 0 ? 0 : (n0 > 128 ? 128 : n0); sc[g][r] += bt[n0]; }
            } else {
#pragma unroll
                for (int g = 0; g < 2; ++g) { sc[g] = __builtin_amdgcn_mfma_f32_32x32x16_bf16(kf[g][0], qf[mp][0], negm[mp], 0, 0, 0); sc[g] = __builtin_amdgcn_mfma_f32_32x32x16_bf16(kf[g][1], qf[mp][1], sc[g], 0, 0, 0); }
            }
            asm volatile("s_nop 15\n\ts_nop 7" : "+v"(sc[0]), "+v"(sc[1]));
            if (diag) {
#pragma unroll
                for (int g = 0; g < 2; ++g)
#pragma unroll
                    for (int r = 0; r < 16; ++r) { if (k0 + 32 * g + crow(r, hi) > qi) sc[g][r] = -1e30f; }
            }
            const float mx = swapmax(vmax3(max32(sc[0], sc[1]), -1e30f, -1e30f));
            const bool up = (t == 0) || mx > 8.0f;
            if (__builtin_amdgcn_ballot_w64(up) != 0ull) {
                const float dl = up ? mx : 0.f; const float al = __builtin_amdgcn_exp2f(-dl); l_[mp] *= al; m_[mp] += dl;
#pragma unroll
                for (int r = 0; r < 16; ++r) negm[mp][r] -= dl;
#pragma unroll
                for (int g = 0; g < 2; ++g)
#pragma unroll
                    for (int r = 0; r < 16; ++r) sc[g][r] -= dl;
#pragma unroll
                for (int d = 0; d < 2; ++d)
#pragma unroll
                    for (int r = 0; r < 16; ++r) oA[mp][d][r] *= al;
            }
            float ls = 0.f;
#pragma unroll
            for (int g = 0; g < 2; ++g)
#pragma unroll
                for (int r = 0; r < 16; ++r) { sc[g][r] = __builtin_amdgcn_exp2f(sc[g][r]); ls += sc[g][r]; }
            l_[mp] += ls;
#pragma unroll
            for (int g = 0; g < 2; ++g) { pf[mp][2 * g] = pack8(sc[g], 0); pf[mp][2 * g + 1] = pack8(sc[g], 8); }
        }
        { bf16x8 vq[8];
#pragma unroll
          for (int i = 0; i < 8; ++i) { const int d = i & 1, s_ = i >> 1; const s16x4 lo = vtr(vb_ + d * 4096 + s_ * 1024), hh = vtr(vb_ + d * 4096 + s_ * 1024 + 512); vq[i] = (bf16x8){lo[0], lo[1], lo[2], lo[3], hh[0], hh[1], hh[2], hh[3]}; }
#pragma unroll
          for (int i = 0; i < 8; ++i) { const int d = i & 1, s_ = i >> 1; oA[0][d] = __builtin_amdgcn_mfma_f32_32x32x16_bf16(vq[i], pf[0][s_], oA[0][d], 0, 0, 0); oA[1][d] = __builtin_amdgcn_mfma_f32_32x32x16_bf16(vq[i], pf[1][s_], oA[1][d], 0, 0, 0); }
          __builtin_amdgcn_sched_group_barrier(0x100, 4, 0);
#pragma unroll
          for (int i = 0; i < 6; ++i) { __builtin_amdgcn_sched_group_barrier(0x008, 2, 0); __builtin_amdgcn_sched_group_barrier(0x100, 2, 0); }
          __builtin_amdgcn_sched_group_barrier(0x008, 4, 0);
          __builtin_amdgcn_sched_barrier(0); }
    };
#pragma unroll 1
    for (int t = 0; t < NT; ++t) {
        const int buf = t & 1;
        if (t < NTW) compute(t, buf);
        if (t + 1 < NT) lstore(buf ^ 1);
        if (t + 2 < NT) gload(t + 2);
        TILE_BAR();
    }
    const float il1 = 1.f / swapadd(l_[0]), il2 = 1.f / swapadd(l_[1]);
    const float lam = P.lams[0], lam_init = P.lams[1];
    const float i2 = lam * il2;
    float ss = 0.f;
#pragma unroll
    for (int d = 0; d < 2; ++d)
#pragma unroll
        for (int r = 0; r < 16; ++r) { const float v = oA[0][d][r] * il1 - oA[1][d][r] * i2; oA[0][d][r] = v; ss += v * v; }
    ss = swapadd(ss);
    const float rs = __builtin_amdgcn_rsqf(ss * (1.f / 64.f) + 1e-6f) * (1.f - lam_init);
    const LAS float* dn = (const LAS float*)(lds + C::DN);
    GAS bf16* orow = P.O + (rowb + qi) * P.op + h * 64;
#pragma unroll
    for (int d = 0; d < 2; ++d)
#pragma unroll
        for (int g = 0; g < 4; ++g) { const int c = 32 * d + 8 * g + 4 * hi; const f32x4 gn = *(const LAS f32x4*)(dn + c);
            v2u v; v.x = cvtpk(oA[0][d][4 * g] * rs * gn[0], oA[0][d][4 * g + 1] * rs * gn[1]); v.y = cvtpk(oA[0][d][4 * g + 2] * rs * gn[2], oA[0][d][4 * g + 3] * rs * gn[3]); *(GAS v2u*)(orow + c) = v; }
}

__device__ __forceinline__ void attn_phase(const AttnP& PM, const AttnP& PD, LAS unsigned char* lds, int tid, int wave, int lane, int vcu, int G, int only = -1) {
    for (int i = vcu; i < 512; i += G) {
        if (only >= 0 && (i >> 8) != only) continue;
        const int kind = i >> 8, c = i & 255, bh = c >> 4, s = c & 15;
        if (kind == 0) {
#pragma unroll 1
            for (int k = 0; k < 2; ++k) attn_unit2<0>(PM, bh >> 2, bh & 3, k ? 31 - s : s, lds, tid, wave, lane);
        } else {
#pragma unroll 1
            for (int k = 0; k < 2; ++k) attn_diff_unit(PD, bh >> 2, bh & 3, k ? 31 - s : s, lds, wave);
        }
    }
}
__device__ __forceinline__ float cx_max16(const f32x16& p) { return fmaxf(fmaxf(fmaxf(fmaxf(p[0], p[1]), fmaxf(p[2], p[3])), fmaxf(fmaxf(p[4], p[5]), fmaxf(p[6], p[7]))), fmaxf(fmaxf(fmaxf(p[8], p[9]), fmaxf(p[10], p[11])), fmaxf(fmaxf(p[12], p[13]), fmaxf(p[14], p[15])))); }
__device__ __forceinline__ void cross_unit2(const AttnP& P, int b, int h, int qb, LAS unsigned char* lds, int wave) {
    const int lane = lane_id_v(), tid = (wave << 6) | lane;
    constexpr int KP = 528;
    const int r32 = lane & 31, hi = lane >> 5;
    const size_t rowb = (size_t)b * S, rowk = (size_t)b * MEM;
    const int qi = qb * 256 + wave * 32 + r32;
    const GAS bf16* Kb = P.K + rowk * P.kp + h * 256; const GAS bf16* Vb = P.V + rowk * P.vp + h * 256;
    const __amdgpu_buffer_rsrc_t rK = __builtin_amdgcn_make_buffer_rsrc((void*)Kb, 0, 0x7fffffff, 0x00020000), rV = __builtin_amdgcn_make_buffer_rsrc((void*)Vb, 0, 0x7fffffff, 0x00020000);
    const GAS bf16* qrow = P.Q + (rowb + qi) * P.qp + h * 256 + 8 * hi;
    bf16x8 qf[4];
#pragma unroll
    for (int s = 0; s < 4; ++s) qf[s] = *(const GAS bf16x8*)(qrow + 16 * s);
    { u32x4 st[16];
#pragma unroll
      for (int i = 0; i < 16; ++i) { const int c = tid + 512 * i; st[i] = __builtin_amdgcn_raw_buffer_load_b128(rK, ((c >> 5) * P.kp + (c & 31) * 8) * 2, 0, 0); }
      TILE_BAR();
#pragma unroll
      for (int i = 0; i < 16; ++i) { const int c = tid + 512 * i; *(LAS u32x4*)(lds + (c >> 5) * KP + (c & 31) * 16) = st[i]; } }
    __syncthreads();
    f32x16 sc[8];
#pragma unroll
    for (int g = 0; g < 8; ++g)
#pragma unroll
        for (int r = 0; r < 16; ++r) sc[g][r] = 0.f;
    const LAS unsigned char* kb_ = lds + r32 * KP + hi * 16;
#pragma unroll
    for (int c = 0; c < 4; ++c) {
        bf16x8 qn[4];
        if (c + 1 < 4) {
#pragma unroll
            for (int s = 0; s < 4; ++s) qn[s] = *(const GAS bf16x8*)(qrow + 64 * (c + 1) + 16 * s); }
        { bf16x8 kq[32];
#pragma unroll
          for (int i = 0; i < 32; ++i) kq[i] = *(const LAS bf16x8*)(kb_ + 32 * (i & 7) * KP + (4 * c + (i >> 3)) * 32);
#pragma unroll
          for (int i = 0; i < 32; ++i) sc[i & 7] = __builtin_amdgcn_mfma_f32_32x32x16_bf16(kq[i], qf[i >> 3], sc[i & 7], 0, 0, 0);
          __builtin_amdgcn_sched_group_barrier(0x100, 4, 0);
#pragma unroll
          for (int i = 0; i < 28; ++i) { __builtin_amdgcn_sched_group_barrier(0x008, 1, 0); __builtin_amdgcn_sched_group_barrier(0x100, 1, 0); }
          __builtin_amdgcn_sched_group_barrier(0x008, 4, 0);
          __builtin_amdgcn_sched_barrier(0); }
        if (c + 1 < 4) {
#pragma unroll
            for (int s = 0; s < 4; ++s) qf[s] = qn[s]; }
    }
    float m = fmaxf(fmaxf(fmaxf(cx_max16(sc[0]), cx_max16(sc[1])), fmaxf(cx_max16(sc[2]), cx_max16(sc[3]))), fmaxf(fmaxf(cx_max16(sc[4]), cx_max16(sc[5])), fmaxf(cx_max16(sc[6]), cx_max16(sc[7]))));
    m = swapmax(m);
    float l = 0.f;
    bf16x8 pf[16];
#pragma unroll
    for (int g = 0; g < 8; ++g) {
#pragma unroll
        for (int r = 0; r < 16; ++r) { sc[g][r] = __builtin_amdgcn_exp2f(sc[g][r] - m); l += sc[g][r]; }
        pf[2 * g] = pack8(sc[g], 0); pf[2 * g + 1] = pack8(sc[g], 8); }
    const float il = 1.f / swapadd(l);
    { u32x4 st[16];
#pragma unroll
      for (int i = 0; i < 16; ++i) { const int c = tid + 512 * i; const int sub = c & 3, key = (c >> 2) & 255, dt = c >> 10; st[i] = __builtin_amdgcn_raw_buffer_load_b128(rV, (key * P.vp + dt * 32 + sub * 8) * 2, 0, 0); }
      TILE_BAR();
#pragma unroll
      for (int i = 0; i < 16; ++i) { const int c = tid + 512 * i; const int sub = c & 3, key = (c >> 2) & 255, dt = c >> 10; *(LAS u32x4*)(lds + dt * 16384 + (key >> 3) * 512 + (key & 7) * 64 + sub * 16) = st[i]; } }
    __syncthreads();
    const LAS unsigned char* vb_ = lds + ((lane >> 4) & 1) * 32 + (lane & 3) * 8 + (4 * hi + ((lane & 15) >> 2)) * 64;
    GAS bf16* orow = P.O + (rowb + qi) * P.op + h * 256;
#pragma unroll 1
    for (int dh = 0; dh < 2; ++dh) {
        f32x16 oA[4];
#pragma unroll
        for (int d = 0; d < 4; ++d)
#pragma unroll
            for (int r = 0; r < 16; ++r) oA[d][r] = 0.f;
#pragma unroll
        for (int d = 0; d < 4; ++d) {
            { bf16x8 vq[16];
#pragma unroll
              for (int s = 0; s < 16; ++s) { const s16x4 lo = vtr(vb_ + (4 * dh + d) * 16384 + s * 1024), hh = vtr(vb_ + (4 * dh + d) * 16384 + s * 1024 + 512); vq[s] = (bf16x8){lo[0], lo[1], lo[2], lo[3], hh[0], hh[1], hh[2], hh[3]}; }
#pragma unroll
              for (int s = 0; s < 16; ++s) oA[d] = __builtin_amdgcn_mfma_f32_32x32x16_bf16(vq[s], pf[s], oA[d], 0, 0, 0);
              __builtin_amdgcn_sched_group_barrier(0x100, 4, 0);
#pragma unroll
              for (int i = 0; i < 14; ++i) { __builtin_amdgcn_sched_group_barrier(0x008, 1, 0); __builtin_amdgcn_sched_group_barrier(0x100, 2, 0); }
              __builtin_amdgcn_sched_group_barrier(0x008, 2, 0);
              __builtin_amdgcn_sched_barrier(0); } }
#pragma unroll
        for (int d = 0; d < 4; ++d)
#pragma unroll
            for (int g = 0; g < 4; ++g) { v2u v; v.x = cvtpk(oA[d][4 * g] * il, oA[d][4 * g + 1] * il); v.y = cvtpk(oA[d][4 * g + 2] * il, oA[d][4 * g + 3] * il); *(GAS v2u*)(orow + 128 * dh + 32 * d + 8 * g + 4 * hi) = v; }
    }
}
__device__ __forceinline__ void cross_phase(const AttnP& PC, LAS unsigned char* lds, int tid, int wave, int lane, int vcu, int G) {
#pragma unroll 1
    for (int i = vcu; i < 512; i += G) { const int bh = i >> 5; cross_unit2(PC, bh >> 2, bh & 3, i & 31, lds, wave); }
}


__device__ __forceinline__ float vmax2(float a, float b) { float r; asm("v_max_f32_e32 %0, %1, %2" : "=v"(r) : "v"(a), "v"(b)); return r; }
__device__ __forceinline__ float vmin2(float a, float b) { float r; asm("v_min_f32_e32 %0, %1, %2" : "=v"(r) : "v"(a), "v"(b)); return r; }
__device__ __forceinline__ void pad16(float (&a)[16]) {
    asm volatile("s_nop 1" : "+v"(a[0]), "+v"(a[1]), "+v"(a[2]), "+v"(a[3]), "+v"(a[4]), "+v"(a[5]), "+v"(a[6]), "+v"(a[7]), "+v"(a[8]), "+v"(a[9]), "+v"(a[10]), "+v"(a[11]), "+v"(a[12]), "+v"(a[13]), "+v"(a[14]), "+v"(a[15]));
}
__device__ __forceinline__ void sort16_desc(float (&a)[16]) {
#pragma unroll
    for (int k = 2; k <= 16; k <<= 1)
#pragma unroll
        for (int j = k >> 1; j > 0; j >>= 1)
#pragma unroll
            for (int i = 0; i < 16; ++i) { const int l = i ^ j; if (l > i) { const bool desc = ((i & k) == 0); const float hi_ = vmax2(a[i], a[l]), lo_ = vmin2(a[i], a[l]); a[i] = desc ? hi_ : lo_; a[l] = desc ? lo_ : hi_; } }
}
__device__ __forceinline__ void merge16_desc(float (&a)[16], const float (&b)[16]) {
#pragma unroll
    for (int i = 0; i < 16; ++i) a[i] = vmax2(a[i], b[15 - i]);
#pragma unroll
    for (int j = 8; j > 0; j >>= 1)
#pragma unroll
        for (int i = 0; i < 16; ++i) { const int l = i ^ j; if (l > i) { const float hi_ = vmax2(a[i], a[l]), lo_ = vmin2(a[i], a[l]); a[i] = hi_; a[l] = lo_; } }
}
__device__ __forceinline__ void top16_of_64(float (&g0)[16], float (&g1)[16], float (&g2)[16], float (&g3)[16]) {
    sort16_desc(g0); sort16_desc(g1); merge16_desc(g0, g1); sort16_desc(g2); sort16_desc(g3); merge16_desc(g2, g3); merge16_desc(g0, g2);
}
__device__ __forceinline__ float embed(float v, unsigned mask, unsigned id) { return __builtin_bit_cast(float, (__builtin_bit_cast(unsigned, v) & mask) | id); }
__device__ __forceinline__ float mkcand(float x, float y, unsigned id) { return embed(x + y, 0xFFFFFF00u, id); }

__device__ __forceinline__ void swap32(float& a, float& b) { asm volatile("v_nop\n\tv_nop\n\tv_permlane32_swap_b32 %0, %1" : "+v"(a), "+v"(b)); }
struct RouteP { const GAS bf16* QP; const GAS bf16* keys; GAS int* EX; GAS float* GW; };
constexpr int RT_KP = 144, RT_KEYS = 0, RT_SCR = 256 * RT_KP, RT_END = RT_SCR + 8 * 8192;
__device__ __forceinline__ void route_phase(const RouteP& P, LAS unsigned char* lds, int tid, int wave, int lane, int vcu, int G) {
    asm volatile("" : "+v"(tid), "+v"(lane));
    __syncthreads();
    for (int c = tid; c < 256 * 8; c += 512) { const int row = c >> 3, part = c & 7; *(LAS u32x4*)(lds + RT_KEYS + row * RT_KP + part * 16) = *(const u32x4*)(P.keys + row * 64 + part * 8); }
    __syncthreads();
    const int r32 = lane & 31, hi = lane >> 5;
    LAS int* scr = (LAS int*)(lds + RT_SCR + wave * 8192);
    for (int u = vcu; u < T / 32; u += G) {
        const size_t t = (size_t)u * 32 + r32; const int h = wave;
        float T2[2][16];
#pragma unroll
        for (int c = 0; c < 2; ++c) {
            bf16x8 qf[4];
            { const GAS bf16* q = P.QP + t * 1024 + h * 128 + c * 64 + 8 * hi;
#pragma unroll
              for (int s = 0; s < 4; ++s) qf[s] = *(const GAS bf16x8*)(q + 16 * s); }
            f32x16 sc[4];
#pragma unroll
            for (int m = 0; m < 4; ++m) {
#pragma unroll
                for (int r = 0; r < 16; ++r) sc[m][r] = 0.f;
#pragma unroll
                for (int s = 0; s < 4; ++s) { const bf16x8 a = *(const LAS bf16x8*)(lds + RT_KEYS + (c * 128 + 32 * m + r32) * RT_KP + s * 32 + hi * 16);
                    sc[m] = __builtin_amdgcn_mfma_f32_32x32x16_bf16(a, qf[s], sc[m], 0, 0, 0); }
            }
            float g0[16], g1[16], g2[16], g3[16];
            const unsigned h4 = 4u * (unsigned)hi;
#pragma unroll
            for (int r = 0; r < 16; ++r) { const unsigned kr_ = (unsigned)((r & 3) + 8 * (r >> 2));
                g0[r] = embed(sc[0][r], 0xFFFFFF80u, kr_ | h4); g1[r] = embed(sc[1][r], 0xFFFFFF80u, (32u + kr_) | h4); g2[r] = embed(sc[2][r], 0xFFFFFF80u, (64u + kr_) | h4); g3[r] = embed(sc[3][r], 0xFFFFFF80u, (96u + kr_) | h4); }
            top16_of_64(g0, g1, g2, g3);
            pad16(g0);
#pragma unroll
            for (int i = 0; i < 16; ++i) T2[c][i] = g0[i];
        }
        float A[16], Bv[16];
#pragma unroll
        for (int i = 0; i < 16; ++i) { A[i] = T2[0][i]; Bv[i] = T2[1][i]; swap32(A[i], Bv[i]); }
        merge16_desc(A, Bv);
        pad16(A);
        float T0[16], T1[16];
#pragma unroll
        for (int i = 0; i < 16; ++i) { T0[i] = A[i]; T1[i] = A[i]; swap32(T0[i], T1[i]); }
#pragma unroll
        for (int i = 0; i < 16; ++i) { scr[i * 64 + lane] = (int)(__builtin_bit_cast(unsigned, T0[i]) & 127u); scr[(16 + i) * 64 + lane] = (int)(__builtin_bit_cast(unsigned, T1[i]) & 127u);
            T0[i] = embed(T0[i], 0xFFFFFF80u, 0u); T1[i] = embed(T1[i], 0xFFFFFF80u, 0u); }
        float c0[16], c1[16], c2[16], c3[16];
        const float NINF = -__builtin_inff();
#pragma unroll
        for (int b = 0; b < 16; ++b) c0[b] = mkcand(T0[0], T1[b], (unsigned)b);
#pragma unroll
        for (int b = 0; b < 8; ++b) c1[b] = mkcand(T0[1], T1[b], 16u + b);
#pragma unroll
        for (int b = 0; b < 5; ++b) c1[8 + b] = mkcand(T0[2], T1[b], 32u + b);
#pragma unroll
        for (int b = 0; b < 3; ++b) c1[13 + b] = mkcand(T0[4], T1[b], 64u + b);
#pragma unroll
        for (int b = 0; b < 4; ++b) c2[b] = mkcand(T0[3], T1[b], 48u + b);
        c2[4] = mkcand(T0[5], T1[0], 80u); c2[5] = mkcand(T0[5], T1[1], 81u); c2[6] = mkcand(T0[6], T1[0], 96u); c2[7] = mkcand(T0[6], T1[1], 97u); c2[8] = mkcand(T0[7], T1[0], 112u); c2[9] = mkcand(T0[7], T1[1], 113u);
#pragma unroll
        for (int a = 8; a < 14; ++a) c2[10 + a - 8] = mkcand(T0[a], T1[0], 16u * a);
        c3[0] = mkcand(T0[14], T1[0], 224u); c3[1] = mkcand(T0[15], T1[0], 240u);
#pragma unroll
        for (int i = 2; i < 16; ++i) c3[i] = NINF;
        top16_of_64(c0, c1, c2, c3);
        pad16(c0);
        float gsum = 0.f, ge[16]; int ex[16];
        const float mtop = embed(c0[0], 0xFFFFFF00u, 0u);
#pragma unroll
        for (int i = 0; i < 16; ++i) { const unsigned bits = __builtin_bit_cast(unsigned, c0[i]); const int a = (bits >> 4) & 15, b = bits & 15;
            ge[i] = __builtin_amdgcn_exp2f((embed(c0[i], 0xFFFFFF00u, 0u) - mtop) * LOG2E); gsum += ge[i];
            ex[i] = scr[a * 64 + lane] * 128 + scr[(16 + b) * 64 + lane]; }
        const float ginv = __builtin_amdgcn_rcpf(gsum);
        if (hi == 0) { GAS unsigned short* d = (GAS unsigned short*)P.EX + t * 128 + h * 16;
#pragma unroll
            for (int i = 0; i < 16; ++i) d[i] = (unsigned short)ex[i]; }
        else { GAS f32x4* d = (GAS f32x4*)(P.GW + t * 128 + h * 16);
#pragma unroll
            for (int i = 0; i < 4; ++i) d[i] = (f32x4){ge[4 * i] * ginv, ge[4 * i + 1] * ginv, ge[4 * i + 2] * ginv, ge[4 * i + 3] * ginv}; }
    }
}

__device__ __forceinline__ int wave_allsum_i(int v) {
    v += __builtin_amdgcn_update_dpp(0, v, 0xB1, 0xF, 0xF, true);
    v += __builtin_amdgcn_update_dpp(0, v, 0x4E, 0xF, 0xF, true);
    v += __builtin_amdgcn_update_dpp(0, v, 0x141, 0xF, 0xF, true);
    v += __builtin_amdgcn_update_dpp(0, v, 0x140, 0xF, 0xF, true);
    { int a = v, b = v; asm volatile("v_nop\n\tv_nop\n\tv_permlane16_swap_b32 %0, %1" : "+v"(a), "+v"(b)); v = a + b; }
    { int a = v, b = v; asm volatile("v_nop\n\tv_nop\n\tv_permlane32_swap_b32 %0, %1" : "+v"(a), "+v"(b)); v = a + b; }
    return v;
}
__device__ __forceinline__ float wave_allsum(float v) {
    v += __builtin_bit_cast(float, __builtin_amdgcn_update_dpp(0, __builtin_bit_cast(int, v), 0xB1, 0xF, 0xF, true));
    v += __builtin_bit_cast(float, __builtin_amdgcn_update_dpp(0, __builtin_bit_cast(int, v), 0x4E, 0xF, 0xF, true));
    v += __builtin_bit_cast(float, __builtin_amdgcn_update_dpp(0, __builtin_bit_cast(int, v), 0x141, 0xF, 0xF, true));
    v += __builtin_bit_cast(float, __builtin_amdgcn_update_dpp(0, __builtin_bit_cast(int, v), 0x140, 0xF, 0xF, true));
    { float a = v, b = v; asm volatile("v_nop\n\tv_nop\n\tv_permlane16_swap_b32 %0, %1" : "+v"(a), "+v"(b)); v = a + b; }
    { float a = v, b = v; asm volatile("v_nop\n\tv_nop\n\tv_permlane32_swap_b32 %0, %1" : "+v"(a), "+v"(b)); v = a + b; }
    return v;
}
__device__ __forceinline__ float wave_allmax(float v) {
    v = fmaxf(v, __builtin_bit_cast(float, __builtin_amdgcn_update_dpp(0, __builtin_bit_cast(int, v), 0xB1, 0xF, 0xF, true)));
    v = fmaxf(v, __builtin_bit_cast(float, __builtin_amdgcn_update_dpp(0, __builtin_bit_cast(int, v), 0x4E, 0xF, 0xF, true)));
    v = fmaxf(v, __builtin_bit_cast(float, __builtin_amdgcn_update_dpp(0, __builtin_bit_cast(int, v), 0x141, 0xF, 0xF, true)));
    v = fmaxf(v, __builtin_bit_cast(float, __builtin_amdgcn_update_dpp(0, __builtin_bit_cast(int, v), 0x140, 0xF, 0xF, true)));
    { float a = v, b = v; asm volatile("v_nop\n\tv_nop\n\tv_permlane16_swap_b32 %0, %1" : "+v"(a), "+v"(b)); v = fmaxf(a, b); }
    { float a = v, b = v; asm volatile("v_nop\n\tv_nop\n\tv_permlane32_swap_b32 %0, %1" : "+v"(a), "+v"(b)); v = fmaxf(a, b); }
    return v;
}
__device__ __forceinline__ unsigned q4(float a, float b, float c, float d, int off) {
    const int ia = (int)__builtin_rintf(a) + off, ib = (int)__builtin_rintf(b) + off, ic = (int)__builtin_rintf(c) + off, id = (int)__builtin_rintf(d) + off;
    return (unsigned)(ia & 255) | ((unsigned)(ib & 255) << 8) | ((unsigned)(ic & 255) << 16) | ((unsigned)(id & 255) << 24);
}
__device__ __forceinline__ void quant_row(const GAS float* src, GAS unsigned* dst, GAS float* scale, int off, int lane) {
    const GAS f32x4* s = (const GAS f32x4*)src + 4 * lane; f32x4 v[4]; float m = 0.f;
#pragma unroll
    for (int i = 0; i < 4; ++i) { v[i] = s[i]; m = fmaxf(m, fmaxf(fmaxf(__builtin_fabsf(v[i].x), __builtin_fabsf(v[i].y)), fmaxf(__builtin_fabsf(v[i].z), __builtin_fabsf(v[i].w)))); }
    m = wave_allmax(m); const float inv = m > 0.f ? 127.f / m : 0.f;
    v4u w;
    w.x = q4(v[0].x * inv, v[0].y * inv, v[0].z * inv, v[0].w * inv, off); w.y = q4(v[1].x * inv, v[1].y * inv, v[1].z * inv, v[1].w * inv, off);
    w.z = q4(v[2].x * inv, v[2].y * inv, v[2].z * inv, v[2].w * inv, off); w.w = q4(v[3].x * inv, v[3].y * inv, v[3].z * inv, v[3].w * inv, off);
    *((GAS v4u*)dst + lane) = w;
    if (lane == 0) *scale = m * (1.f / 127.f);
}
struct PeerS { int nslices_step, first_slice, nloc, rank; };
__device__ __forceinline__ PeerS peer_sched(const GAS unsigned* rankw, int xcc, int rank) {
    const int lane = lane_id_v();
    const int c = lane < 16 ? (int)__hip_atomic_load(rankw + 64 * lane, __ATOMIC_RELAXED, __HIP_MEMORY_SCOPE_AGENT) : 0;
    const unsigned long long m = __builtin_amdgcn_ballot_w64(c > 0);
    const int nx = __builtin_popcountll(m), myidx = __builtin_popcountll(m & ((1ull << xcc) - 1ull));
    const int cm = __builtin_amdgcn_readlane(c, xcc);
    PeerS s; s.nslices_step = nx > 0 ? nx : 1; s.first_slice = myidx; s.nloc = cm > 0 ? cm : 1; s.rank = rank; return s;
}
struct Peer1P { const GAS unsigned GAS char* HQ; const GAS int* EX; const GAS unsigned GAS char* U8; GAS int* P; };
__device__ __forceinline__ void peer_k1(const Peer1P& Q, const PeerS& sc, int wave, int lane) {
    asm volatile("" : "+v"(lane));
    const int g = lane >> 3, j = lane & 7;
    const __amdgpu_buffer_rsrc_t rU = __builtin_amdgcn_make_buffer_rsrc((void*)Q.U8, 0, 0x7fffffff, 0x00020000);
    for (int s = sc.first_slice; s < 8; s += sc.nslices_step)
        for (int tile = sc.rank; tile < T / 64; tile += sc.nloc) {
            const int soff_ = __builtin_amdgcn_readfirstlane(128 * s);
            const size_t t0 = (size_t)tile * 64 + wave * 8;
            v4u hqn = *(const GAS v4u*)(Q.HQ + t0 * 1024 + 128 * s + 16 * j), exn[2];
#pragma unroll
            for (int i = 0; i < 2; ++i) exn[i] = *(const GAS v4u*)(Q.EX + t0 * 64 + 8 * g + 4 * i);
#pragma unroll 1
            for (int k = 0; k < 8; ++k) {
                const size_t t = t0 + k;
                const v4u hq = hqn; v4u ex[2];
#pragma unroll
                for (int i = 0; i < 2; ++i) ex[i] = exn[i];
                if (k + 1 < 8) {
                    hqn = *(const GAS v4u*)(Q.HQ + (t + 1) * 1024 + 128 * s + 16 * j);
#pragma unroll
                    for (int i = 0; i < 2; ++i) exn[i] = *(const GAS v4u*)(Q.EX + (t + 1) * 64 + 8 * g + 4 * i);
                }
                v4u uu[16];
#pragma unroll
                for (int i = 0; i < 16; ++i) { const unsigned ew = ((i >> 1) & 3) == 0 ? ex[i >> 3].x : ((i >> 1) & 3) == 1 ? ex[i >> 3].y : ((i >> 1) & 3) == 2 ? ex[i >> 3].z : ex[i >> 3].w; unsigned e; if (i & 1) asm("v_lshrrev_b32 %0, 16, %1" : "=v"(e) : "v"(ew)); else asm("v_and_b32 %0, 0xffff, %1" : "=v"(e) : "v"(ew));
                    uu[i] = __builtin_bit_cast(v4u, __builtin_amdgcn_raw_buffer_load_b128(rU, (int)((e << 10) + 16u * (unsigned)j), soff_, 0)); }
                int lo = 0, hi = 0;
#pragma unroll
                for (int i = 0; i < 16; ++i) {
                    int p = __builtin_amdgcn_sdot4((int)uu[i].x, (int)hq.x, 0, false); p = __builtin_amdgcn_sdot4((int)uu[i].y, (int)hq.y, p, false); p = __builtin_amdgcn_sdot4((int)uu[i].z, (int)hq.z, p, false); p = __builtin_amdgcn_sdot4((int)uu[i].w, (int)hq.w, p, false);
                    p += __builtin_amdgcn_update_dpp(0, p, 0xB1, 0xF, 0xF, true); p += __builtin_amdgcn_update_dpp(0, p, 0x4E, 0xF, 0xF, true); p += __builtin_amdgcn_update_dpp(0, p, 0x141, 0xF, 0xF, true);
                    if (i < 8) lo = (j == i) ? p : lo; else hi = (j == i - 8) ? p : hi;
                }
                Q.P[(t * 8 + s) * 64 + 8 * g + j] = (int)__builtin_amdgcn_perm((unsigned)((hi + 32) >> 6), (unsigned)((lo + 32) >> 6), 0x05040100u);
            }
        }
}
__device__ __forceinline__ void peer_w(const GAS int* EX, const GAS float* GW, const GAS int* P, const GAS float* SH, const GAS float* SU, const GAS float* SV, GAS signed char* WQ, GAS float* WSC, int gw, int NGW, int lane,
                                       LAS unsigned char* lds, int tid) {
    asm volatile("" : "+v"(lane), "+v"(tid));
    LAS float* su_l = (LAS float*)lds; LAS float* sv_l = su_l + 16384;
#pragma unroll 4
    for (int i = tid; i < 4096; i += 512) { ((LAS f32x4*)su_l)[i] = ((const GAS f32x4*)SU)[i]; ((LAS f32x4*)sv_l)[i] = ((const GAS f32x4*)SV)[i]; }
    __syncthreads();
    for (int t = gw; t < T; t += NGW) {
        const float sh = SH[t];
#pragma unroll
        for (int q = 0; q < 2; ++q) { const size_t idx = (size_t)t * 128 + lane + 64 * q; const int e = (int)((const GAS unsigned short*)EX)[idx];
            const int slot_ = lane + 64 * q, pix_ = (slot_ >> 4) * 8 + (slot_ & 7), hsel_ = (slot_ >> 3) & 1;
            int pd = 0;
#pragma unroll
            for (int sl = 0; sl < 8; ++sl) { const int pw_ = P[((size_t)t * 8 + sl) * 64 + pix_]; pd += hsel_ ? (pw_ >> 16) : (int)(short)(pw_ & 0xffff); }
            const float w = GW[idx] * gelu_erf((float)pd * (64.f * sh * su_l[e])) * sv_l[e];
            float m = __builtin_fabsf(w);
            m = fmaxf(m, __builtin_bit_cast(float, __builtin_amdgcn_update_dpp(0, __builtin_bit_cast(int, m), 0xB1, 0xF, 0xF, true)));
            m = fmaxf(m, __builtin_bit_cast(float, __builtin_amdgcn_update_dpp(0, __builtin_bit_cast(int, m), 0x4E, 0xF, 0xF, true)));
            m = fmaxf(m, __builtin_bit_cast(float, __builtin_amdgcn_update_dpp(0, __builtin_bit_cast(int, m), 0x141, 0xF, 0xF, true)));
            m = fmaxf(m, __builtin_bit_cast(float, __builtin_amdgcn_update_dpp(0, __builtin_bit_cast(int, m), 0x140, 0xF, 0xF, true)));
            const float inv = m > 0.f ? 127.f / m : 0.f;
            const unsigned wb = (unsigned)((int)__builtin_rintf(w * inv)) & 255u;
            const unsigned b1 = (unsigned)__builtin_amdgcn_update_dpp(0, (int)wb, 0x55, 0xF, 0xF, true), b2 = (unsigned)__builtin_amdgcn_update_dpp(0, (int)wb, 0xAA, 0xF, 0xF, true), b3 = (unsigned)__builtin_amdgcn_update_dpp(0, (int)wb, 0xFF, 0xF, 0xF, true);
            if ((lane & 3) == 0) ((GAS unsigned*)WQ)[idx >> 2] = wb | (b1 << 8) | (b2 << 16) | (b3 << 24);
            if ((lane & 15) == 0) WSC[(size_t)t * 8 + (lane >> 4) + 4 * q] = m * (1.f / 127.f); }
    }
}
__device__ __forceinline__ void tr4x4(unsigned r0, unsigned r1, unsigned r2, unsigned r3, unsigned (&t)[4]) {
    const unsigned x0 = __builtin_amdgcn_perm(r1, r0, 0x05010400u), x1 = __builtin_amdgcn_perm(r1, r0, 0x07030602u), y0 = __builtin_amdgcn_perm(r3, r2, 0x05010400u), y1 = __builtin_amdgcn_perm(r3, r2, 0x07030602u);
    t[0] = __builtin_amdgcn_perm(y0, x0, 0x05040100u); t[1] = __builtin_amdgcn_perm(y0, x0, 0x07060302u); t[2] = __builtin_amdgcn_perm(y1, x1, 0x05040100u); t[3] = __builtin_amdgcn_perm(y1, x1, 0x07060302u);
}
struct Peer2P { const GAS int* EX; const GAS signed char* WQ; const GAS float* WSC; const GAS unsigned char* V8; GAS bf16* XB; GAS float* SSQ; };
__device__ __forceinline__ void peer_k2(const Peer2P& Q, const PeerS& sc, int wave, int lane) {
    asm volatile("" : "+v"(lane));
    const int g = lane >> 3, j = lane & 7, hf = lane >> 5, rp = (lane >> 4) & 1;
    const __amdgpu_buffer_rsrc_t rV = __builtin_amdgcn_make_buffer_rsrc((void*)Q.V8, 0, 0x7fffffff, 0x00020000);
    for (int s = sc.first_slice; s < 8; s += sc.nslices_step)
        for (int tile = sc.rank; tile < T / 64; tile += sc.nloc) {
            const int soff_ = __builtin_amdgcn_readfirstlane(128 * s);
            const size_t t0 = (size_t)tile * 64 + wave * 8;
            v4u exn[2], wqn; float swn;
#pragma unroll
            for (int i = 0; i < 2; ++i) exn[i] = *(const GAS v4u*)(Q.EX + t0 * 64 + 8 * g + 4 * i);
            wqn = *(const GAS v4u*)(Q.WQ + t0 * 128 + 16 * g); swn = Q.WSC[t0 * 8 + g];
#pragma unroll 1
            for (int k = 0; k < 8; ++k) {
                const size_t t = t0 + k;
                v4u ex[2]; const v4u wq = wqn; const float sw = swn;
#pragma unroll
                for (int i = 0; i < 2; ++i) ex[i] = exn[i];
                if (k + 1 < 8) {
#pragma unroll
                    for (int i = 0; i < 2; ++i) exn[i] = *(const GAS v4u*)(Q.EX + (t + 1) * 64 + 8 * g + 4 * i);
                    wqn = *(const GAS v4u*)(Q.WQ + (t + 1) * 128 + 16 * g); swn = Q.WSC[(t + 1) * 8 + g];
                }
                GAS v2u* xp = (GAS v2u*)(Q.XB + t * 1024 + 128 * s + 16 * j + 8 * hf + 4 * rp);
                const v2u xold = *xp;
                v4u vv[16];
#pragma unroll
                for (int i = 0; i < 16; ++i) { const unsigned ew = ((i >> 1) & 3) == 0 ? ex[i >> 3].x : ((i >> 1) & 3) == 1 ? ex[i >> 3].y : ((i >> 1) & 3) == 2 ? ex[i >> 3].z : ex[i >> 3].w; unsigned e; if (i & 1) asm("v_lshrrev_b32 %0, 16, %1" : "=v"(e) : "v"(ew)); else asm("v_and_b32 %0, 0xffff, %1" : "=v"(e) : "v"(ew));
                    vv[i] = __builtin_bit_cast(v4u, __builtin_amdgcn_raw_buffer_load_b128(rV, (int)((e << 10) + 16u * (unsigned)j), soff_, 0)); }
                int ai[16];
#pragma unroll
                for (int i = 0; i < 16; ++i) ai[i] = 0;
#pragma unroll
                for (int q4_ = 0; q4_ < 4; ++q4_) {
                    const unsigned wq4 = q4_ == 0 ? wq.x : q4_ == 1 ? wq.y : q4_ == 2 ? wq.z : wq.w;
#pragma unroll
                    for (int c = 0; c < 4; ++c) { unsigned tt[4];
                        const v4u &a0 = vv[4 * q4_], &a1 = vv[4 * q4_ + 1], &a2 = vv[4 * q4_ + 2], &a3 = vv[4 * q4_ + 3];
                        tr4x4(c == 0 ? a0.x : c == 1 ? a0.y : c == 2 ? a0.z : a0.w, c == 0 ? a1.x : c == 1 ? a1.y : c == 2 ? a1.z : a1.w, c == 0 ? a2.x : c == 1 ? a2.y : c == 2 ? a2.z : a2.w, c == 0 ? a3.x : c == 1 ? a3.y : c == 2 ? a3.z : a3.w, tt);
#pragma unroll
                        for (int b = 0; b < 4; ++b) ai[4 * c + b] = __builtin_amdgcn_sdot4((int)tt[b], (int)wq4, ai[4 * c + b], false); }
                }
                float acc[16];
#pragma unroll
                for (int i = 0; i < 16; ++i) acc[i] = (float)ai[i] * sw;
                float r8[8], r4[4];
#pragma unroll
                for (int m = 0; m < 8; ++m) { float a = acc[m], b = acc[m + 8]; swap32(a, b); r8[m] = a + b; }
#pragma unroll
                for (int n = 0; n < 4; ++n) { float a = r8[n], b = r8[n + 4]; asm volatile("v_nop\n\tv_nop\n\tv_permlane16_swap_b32 %0, %1" : "+v"(a), "+v"(b)); r4[n] = a + b; }
#pragma unroll
                for (int n = 0; n < 4; ++n) r4[n] += __builtin_bit_cast(float, __builtin_amdgcn_update_dpp(0, __builtin_bit_cast(int, r4[n]), 0x128, 0xF, 0xF, true));
                v2u xw; xw.x = pk2(bflo(xold.x) + r4[0], bfhi(xold.x) + r4[1]); xw.y = pk2(bflo(xold.y) + r4[2], bfhi(xold.y) + r4[3]);
                float ss = 0.f;
                if ((lane & 8) == 0) { const float x0 = bflo(xw.x), x1 = bfhi(xw.x), x2 = bflo(xw.y), x3 = bfhi(xw.y); ss = (x0 * x0 + x1 * x1) + (x2 * x2 + x3 * x3); *xp = xw; }
                ss = wave_allsum(ss);
                if (Q.SSQ) { if (lane == 0) Q.SSQ[t * 16 + s] = ss; }
            }
        }
}

struct Args { const float* in[33]; float* out; unsigned char* ws; int ph_lo, ph_hi; };
struct Frame { LAS unsigned char* lds; volatile LAS unsigned* MISC; gu32* ctl; int tid, lane, wave, G, vcu, xcc, xrank; };

__device__ __forceinline__ void transpose_item(const float* W, int ldw, int nsrc0, bf16* WT, int ldt, int rdst0, LAS float* scr, int kb, int nb, int lane, float scale, const float* kgain) {
    const int k0 = 64 * kb, n0 = 32 * nb;
#pragma unroll 8
    for (int i = 0; i < 32; ++i) { const int kk = 2 * i + (lane >> 5); const float gsc = kgain ? kgain[k0 + kk] * scale : scale; scr[kk * 33 + (lane & 31)] = W[(size_t)(k0 + kk) * ldw + nsrc0 + n0 + (lane & 31)] * gsc; }
    LDS_WAIT(); asm volatile("" ::: "memory");
    const int c = lane & 7;
#pragma unroll
    for (int j = 0; j < 4; ++j) { const int n = (lane >> 3) + 8 * j; const LAS float* s = scr + (8 * c) * 33 + n;
        v4u o; o.x = pk2(s[0 * 33], s[1 * 33]); o.y = pk2(s[2 * 33], s[3 * 33]); o.z = pk2(s[4 * 33], s[5 * 33]); o.w = pk2(s[6 * 33], s[7 * 33]);
        *(GAS v4u*)(WT + (size_t)(rdst0 + n0 + n) * ldt + k0 + 8 * c) = o; }
    LDS_WAIT(); asm volatile("" ::: "memory");
}
__device__ __forceinline__ void zero_rect(bf16* base, int ld, int row0, int nrows, int col0, int ncols, int gtid, int gthreads) {
    const int vpr = ncols / 8;
    for (int i = gtid; i < nrows * vpr; i += gthreads) { const int r = i / vpr, c = i % vpr; *(GAS v4u*)(base + (size_t)(row0 + r) * ld + col0 + 8 * c) = (v4u){0u, 0u, 0u, 0u}; }
}

__device__ __forceinline__ void p0_prologue(Frame& F, const Args& a) {
    LAS float* scr = (LAS float*)(F.lds + RING_OFF + F.wave * 16384);
    const int gw = blockIdx.x * NWAVES + F.wave, NGW = F.G * NWAVES;
    const int gtid = blockIdx.x * (NWAVES * 64) + F.tid, gthreads = F.G * NWAVES * 64;
    unsigned char* ws = a.ws;
    x0_phase((const GAS float*)a.in[0], (GAS bf16*)(ws + WS_XNB), (GAS float*)(ws + WS_SSQ), gw, NGW, F.lane);
    constexpr int I_IN = 16 * (INW / 32), I_SQ = 16 * 32, I_CKV = 16 * 64, I_UQ = 3 * 12, I_UKV = 2 * 16, I_L = I_IN + 4 * I_SQ + I_CKV + I_UQ + I_UKV;
    for (int it = gw; it < L * I_L; it += NGW) {
        const int l = it / I_L; int r = it % I_L;
        if (r < I_IN) {
            const int kb = r / 67, nb = r % 67; int src, dst; float sc = 1.f;
            if (nb < 6) { src = 32 * nb; dst = src; } else if (nb < 11) { src = 32 * nb; dst = src + 64; } else { src = 32 * nb; dst = src + 160; if (nb >= 43 && nb < 51) sc = 0.17677669529663687f * LOG2E; }
            transpose_item(a.in[5] + (size_t)l * D * INW, INW, src, (bf16*)(ws + WS_WIN) + (size_t)l * INP * D, D, dst, scr, kb, 0, F.lane, sc, a.in[4] + l * D); continue; } r -= I_IN;
        if (r < I_SQ) { transpose_item(a.in[21] + (size_t)l * D * D, D, 0, (bf16*)(ws + WS_WOUT) + (size_t)l * D * D, D, 0, scr, r / 32, r % 32, F.lane, 1.f, nullptr); continue; } r -= I_SQ;
        if (r < I_SQ) { transpose_item(a.in[24] + (size_t)l * D * D, D, 0, (bf16*)(ws + WS_WCQ) + (size_t)l * D * D, D, 0, scr, r / 32, r % 32, F.lane, 0.0625f * LOG2E, a.in[22] + l * D); continue; } r -= I_SQ;
        if (r < I_SQ) { transpose_item(a.in[26] + (size_t)l * D * D, D, 0, (bf16*)(ws + WS_WCO) + (size_t)l * D * D, D, 0, scr, r / 32, r % 32, F.lane, 1.f, nullptr); continue; } r -= I_SQ;
        if (r < I_SQ) { transpose_item(a.in[28] + (size_t)l * D * D, D, 0, (bf16*)(ws + WS_WPQ) + (size_t)l * D * D, D, 0, scr, r / 32, r % 32, F.lane, 1.f, a.in[27] + l * D); continue; } r -= I_SQ;
        if (r < I_CKV) { transpose_item(a.in[25] + (size_t)l * D * 2 * D, 2 * D, 0, (bf16*)(ws + WS_WCKV) + (size_t)l * 2 * D * D, D, 0, scr, r / 64, r % 64, F.lane, 1.f, nullptr); continue; } r -= I_CKV;
        if (r < I_UQ) { transpose_item(a.in[7] + (size_t)l * 192 * 384, 384, 0, (bf16*)(ws + WS_WUQ) + (size_t)l * 512 * 256, 256, 0, scr, r / 12, r % 12, F.lane, 0.10206207261596575f * LOG2E, a.in[6] + l * 192); continue; } r -= I_UQ;
        transpose_item(a.in[9] + (size_t)l * 128 * 512, 512, 0, (bf16*)(ws + WS_WUKV) + (size_t)l * 512 * 256, 256, 0, scr, r / 16, r % 16, F.lane, 1.f, a.in[8] + l * 128);
    }
    for (int l = 0; l < L; ++l) {
        bf16* win = (bf16*)(ws + WS_WIN) + (size_t)l * INP * D; bf16* wuq = (bf16*)(ws + WS_WUQ) + (size_t)l * 512 * 256; bf16* wukv = (bf16*)(ws + WS_WUKV) + (size_t)l * 512 * 256;
        zero_rect(win, D, 192, 64, 0, D, gtid, gthreads); zero_rect(win, D, 416, 96, 0, D, gtid, gthreads);
        zero_rect(wuq, 256, 0, 384, 192, 64, gtid, gthreads); zero_rect(wuq, 256, 384, 128, 0, 256, gtid, gthreads);
        zero_rect(wukv, 256, 0, 512, 128, 128, gtid, gthreads);
    }
    { float* rope = (float*)(ws + WS_ROPE); const int* pos = (const int*)a.in[2];
      for (int i = gtid; i < T * 16; i += gthreads) { const int t = i >> 4, k = i & 15; const float inv = powf(10000.f, -(float)(2 * k) / 32.f); const float ang = (float)pos[t] * inv;
          rope[(size_t)t * 32 + k] = cosf(ang); rope[(size_t)t * 32 + 16 + k] = sinf(ang); } }
    { const GAS f32x4* ks = (const GAS f32x4*)a.in[29]; GAS v2u* kd = (GAS v2u*)(ws + WS_KEYS);
      for (int i = gtid; i < L * 2 * 128 * 64 / 4; i += gthreads) { const f32x4 v = ks[i]; v2u w; w.x = pk2(v.x, v.y); w.y = pk2(v.z, v.w); kd[i] = w; }
    }
    for (int r = gw; r < 2 * L * 16384; r += NGW) { const int tb = r / (L * 16384), rr = r % (L * 16384);
        quant_row((const GAS float*)a.in[30 + tb] + (size_t)rr * 1024, (GAS unsigned*)(ws + (tb ? WS_V8 : WS_U8) + (size_t)rr * 1024), (GAS float*)(ws + (tb ? WS_SV : WS_SU)) + rr, 0, F.lane); }
    { float* btab = (float*)(ws + WS_BTAB); float* lams = (float*)(ws + WS_LAMS); float* spt = (float*)(ws + WS_SP);
      for (int i = gtid; i < 4 * 129; i += gthreads) { const int h = i / 129, n = i % 129; int bu; if (n < 16) bu = n; else { const int lg = 16 + (int)(logf((float)n / 16.f) / logf(8.f) * 16.f); bu = lg < 31 ? lg : 31; }
          btab[i] = a.in[3][bu * 4 + h] * LOG2E; }
      for (int i = gtid; i < L; i += gthreads) { const float* dl = a.in[17] + i * 128; float s1 = 0.f, s2 = 0.f; for (int j = 0; j < 32; ++j) { s1 += dl[j] * dl[32 + j]; s2 += dl[64 + j] * dl[96 + j]; }
          const float li = 0.8f - 0.6f * expf(-0.3f * (float)i); lams[2 * i] = expf(s1) - expf(s2) + li; lams[2 * i + 1] = li; }
      for (int i = gtid; i < L * 512; i += gthreads) spt[i] = log1pf(expf(-a.in[16][i])); }
    { GAS bf16* wat = (GAS bf16*)(ws + WS_WAT);
      for (int i = gtid; i < L * 8 * 2 * 4096; i += gthreads) { const int in_ = i & 63, out_ = (i >> 6) & 63, gate = (i >> 12) & 1, lg = i >> 13;
          wat[i] = (bf16)f2bf_(a.in[gate ? 14 : 12][(size_t)lg * 4096 + in_ * 64 + out_]); } }
    for (int l = 0; l < L; ++l) norm_phase((const GAS float*)a.in[1], (const GAS float*)a.in[23] + l * D, (GAS bf16*)(ws + WS_MNB) + (size_t)l * NB * MEM * D, NB * MEM, gw, NGW, F.lane);
}

constexpr int NPL = 16, PH_FINAL = 2 + NPL * L;
__global__ void __launch_bounds__(NWAVES * 64, 2) fwd(Args args) {
    extern __shared__ __attribute__((aligned(16))) unsigned char lds[];
    Frame F;
    F.lds = (LAS unsigned char*)lds; F.MISC = (volatile LAS unsigned*)(F.lds + MISC_OFF);
    F.tid = threadIdx.x; F.lane = F.tid & 63; F.wave = __builtin_amdgcn_readfirstlane(F.tid >> 6); F.G = gridDim.x;
    F.vcu = (F.G % 8 == 0) ? ((int)blockIdx.x % 8) * (F.G / 8) + (int)blockIdx.x / 8 : (int)blockIdx.x;
    unsigned char* ws = args.ws;
    F.ctl = (gu32*)(opq(ws) + WS_CTL);
    for (int u = F.tid; u < (LDS_BYTES - LDSCTL_OFF) / 4; u += NWAVES * 64) ((LAS unsigned*)(F.lds + LDSCTL_OFF))[u] = 0u;
    __syncthreads();
    XcdBarrier bar = xcd_barrier_post((unsigned*)(F.ctl + CW_BAR), F.MISC + 8);
    F.xcc = (int)bar.x;
    if (F.tid == 0) F.MISC[12] = __hip_atomic_fetch_add((unsigned*)(F.ctl + CW_RANK) + 64 * bar.x, 1u, __ATOMIC_RELAXED, __HIP_MEMORY_SCOPE_AGENT);
    __syncthreads();
    F.xrank = __builtin_amdgcn_readfirstlane((int)F.MISC[12]);
    const int lo = args.ph_lo, hi = args.ph_hi;
    const int gw = blockIdx.x * NWAVES + F.wave, NGW = F.G * NWAVES;
#define IN(k) (lo <= (k) && (k) < hi)
#define LANE_ (lane_id_v())
#define TID_ ((opqi(F.wave) << 6) | LANE_)
#define SITE() const int G_ = opqi(F.G), wv_ = opqi(F.wave), vcu_ = opqi(F.vcu), gw_ = opqi(gw), NGW_ = opqi(NGW); (void)G_; (void)wv_; (void)vcu_; (void)gw_; (void)NGW_
#if MK_DUP == 99
#define SEAM(k) do { if (IN(k) && IN((k) + 1)) { xcd_barrier(bar, (F.wave == 0 && lane_id_v() == 0) ? 1 : 0); xcd_barrier(bar, (F.wave == 0 && lane_id_v() == 0) ? 1 : 0); } } while (0)
#else
#define SEAM(k) do { if (IN(k) && IN((k) + 1)) xcd_barrier(bar, (F.wave == 0 && lane_id_v() == 0) ? 1 : 0); } while (0)
#endif
#define GEMM_SITE(EPI, Aptr, lda_, Bptr, ldb_, M_, N_, K_, cperm, ...) do { \
        pg8::Gemm g{opq(Aptr), opq(Bptr), M_, N_, K_, lda_, ldb_}; pg8::StaticOrder So; So.init(M_, N_, opqi(F.G), opqi(cperm)); pg8::EPI E{__VA_ARGS__}; \
        pg8::gemm_phase<pg8::EPI, pg8::StaticOrder, true, true>(F.lds + RING_OFF, g, So, E, opqi(F.wave)); } while (0)
    if (IN(0)) { p0_prologue(F, args); }
    SEAM(0);
    if (IN(1)) {
#pragma unroll 1
        for (int l = 0; l < L; ++l)
            GEMM_SITE(EpiBf16, (const GAS bf16*)(opq(ws) + WS_MNB) + (size_t)l * NB * MEM * D, D, (const GAS bf16*)(opq(ws) + WS_WCKV) + (size_t)l * 2 * D * D, D, NB * MEM, 2 * D, D, (int)((blockIdx.x + 64 * l) % F.G),
                      opq((GAS bf16*)(opq(ws) + WS_KVCB) + (size_t)l * NB * MEM * 2 * D), 2 * D, 2 * D, (const GAS float*)nullptr, 0);
    }
    SEAM(1);
    for (int l = 0; l < L; ++l) {
        const int pb = 2 + NPL * l;
        const GAS bf16* XNB = (const GAS bf16*)(opq(ws) + WS_XNB); const GAS bf16* YB = (const GAS bf16*)(opq(ws) + WS_YB); GAS bf16* PROJB = (GAS bf16*)(opq(ws) + WS_PROJB);
        if (IN(pb + 1)) GEMM_SITE(EpiBf16, XNB, D, (const GAS bf16*)(opq(ws) + WS_WIN) + (size_t)l * INP * D, D, T, INP, D, (int)blockIdx.x, opq(PROJB), INP, INP, opq((const GAS float*)(opq(ws) + WS_SSQ)), 8);
#if MK_DUP == 1
        if (IN(pb + 1)) GEMM_SITE(EpiBf16, XNB, D, (const GAS bf16*)(opq(ws) + WS_WIN) + (size_t)l * INP * D, D, T, INP, D, (int)blockIdx.x, opq(PROJB), INP, INP, opq((const GAS float*)(opq(ws) + WS_SSQ)), 8);
#endif
        SEAM(pb + 1);
        if (IN(pb + 2)) {
            SITE();
            pre_phase(opq((const GAS bf16*)PROJB), opq((const GAS float*)(opq(ws) + WS_ROPE)), opq((GAS float*)(opq(ws) + WS_RS)), opq((GAS bf16*)(opq(ws) + WS_KMB)), gw_, NGW_, LANE_);
#if MK_DUP == 21
            pre_phase(opq((const GAS bf16*)PROJB), opq((const GAS float*)(opq(ws) + WS_ROPE)), opq((GAS float*)(opq(ws) + WS_RS)), opq((GAS bf16*)(opq(ws) + WS_KMB)), gw_, NGW_, LANE_);
#endif
            LruP LP{opq((const GAS bf16*)PROJB), (const GAS float*)args.in[opqi(10)] + l * 4 * 512, (const GAS float*)args.in[opqi(11)] + l * 512, opq((const GAS bf16*)(opq(ws) + WS_WAT)) + (size_t)l * 8 * 2 * 4096, (const GAS float*)args.in[opqi(13)] + l * 512, (const GAS float*)args.in[opqi(15)] + l * 512,
                    (const GAS float*)(opq(ws) + WS_SP) + l * 512, opq((GAS unsigned*)(opq(ws) + WS_HLB)), opq((GAS float*)(opq(ws) + WS_LSUM))};
            lru_phase(LP, F.lds, TID_, wv_, LANE_, vcu_, G_);
#if MK_DUP == 2
            lru_phase(LP, F.lds, TID_, wv_, LANE_, vcu_, G_);
#endif
        }
        SEAM(pb + 2);
        if (IN(pb + 3)) {
            GEMM_SITE(EpiUp, (const GAS bf16*)PROJB + PC_CQ, INP, (const GAS bf16*)(opq(ws) + WS_WUQ) + (size_t)l * 512 * 256, 256, T, 512, 256, (int)blockIdx.x,
                      opq((GAS bf16*)(opq(ws) + WS_QMB)), (GAS bf16*)nullptr, 384, 384, opq((const GAS float*)(opq(ws) + WS_RS)), 0, 0);
            GEMM_SITE(EpiUp, (const GAS bf16*)PROJB + PC_CKV, INP, (const GAS bf16*)(opq(ws) + WS_WUKV) + (size_t)l * 512 * 256, 256, T, 512, 256, (int)blockIdx.x,
                      opq((GAS bf16*)(opq(ws) + WS_KMB)), opq((GAS bf16*)(opq(ws) + WS_VMB)), 0, 512, opq((const GAS float*)(opq(ws) + WS_RS)), 1, 1);
#if MK_DUP == 3
            GEMM_SITE(EpiUp, (const GAS bf16*)PROJB + PC_CQ, INP, (const GAS bf16*)(opq(ws) + WS_WUQ) + (size_t)l * 512 * 256, 256, T, 512, 256, (int)blockIdx.x,
                      opq((GAS bf16*)(opq(ws) + WS_QMB)), (GAS bf16*)nullptr, 384, 384, opq((const GAS float*)(opq(ws) + WS_RS)), 0, 0);
            GEMM_SITE(EpiUp, (const GAS bf16*)PROJB + PC_CKV, INP, (const GAS bf16*)(opq(ws) + WS_WUKV) + (size_t)l * 512 * 256, 256, T, 512, 256, (int)blockIdx.x,
                      opq((GAS bf16*)(opq(ws) + WS_KMB)), opq((GAS bf16*)(opq(ws) + WS_VMB)), 0, 512, opq((const GAS float*)(opq(ws) + WS_RS)), 1, 1);
#endif
        }
        SEAM(pb + 3);
        if (IN(pb + 4)) {
            SITE();
            AttnP PM{opq((const GAS bf16*)(opq(ws) + WS_QMB)), opq((const GAS bf16*)(opq(ws) + WS_KMB)), opq((const GAS bf16*)(opq(ws) + WS_VMB)), 384, 384, 256, opq((GAS bf16*)(opq(ws) + WS_OMB)), 256, opq((const GAS float*)(opq(ws) + WS_ROPE)), nullptr, nullptr, nullptr, nullptr};
            AttnP PD{opq((const GAS bf16*)PROJB + PC_QD), opq((const GAS bf16*)PROJB + PC_KD), opq((const GAS bf16*)PROJB + PC_VD), INP, INP, INP, opq((GAS bf16*)(opq(ws) + WS_YB) + 768), 1024, nullptr,
                     (const GAS int*)args.in[opqi(2)], (const GAS float*)(opq(ws) + WS_BTAB), (const GAS float*)args.in[opqi(18)] + l * 64, (const GAS float*)(opq(ws) + WS_LAMS) + 2 * l};
            attn_phase(PM, PD, F.lds, TID_, wv_, LANE_, vcu_, G_);
#if MK_DUP == 4
            __syncthreads(); attn_phase(PM, PD, F.lds, TID_, wv_, LANE_, vcu_, G_);
#elif MK_DUP == 40 || MK_DUP == 41
            __syncthreads(); attn_phase(PM, PD, F.lds, TID_, wv_, LANE_, vcu_, G_, MK_DUP - 40);
#endif
        }
        SEAM(pb + 4);
        if (IN(pb + 5)) {
            SITE();
            PostP PP{opq((const GAS bf16*)(opq(ws) + WS_OMB)), opq((const GAS unsigned*)(opq(ws) + WS_HLB)), opq((const GAS float*)(opq(ws) + WS_LSUM)), opq((const GAS bf16*)PROJB), (const GAS float*)args.in[opqi(19)] + l * 256, (const GAS float*)args.in[opqi(20)] + l * 512, opq((GAS bf16*)(opq(ws) + WS_YB))};
            post_phase(PP, F.lds, TID_, wv_, LANE_, vcu_, G_);
#if MK_DUP == 5
            __syncthreads(); post_phase(PP, F.lds, TID_, wv_, LANE_, vcu_, G_);
#endif
        }
        SEAM(pb + 5);
        if (IN(pb + 6)) GEMM_SITE(EpiRes, YB, D, (const GAS bf16*)(opq(ws) + WS_WOUT) + (size_t)l * D * D, D, T, D, D, (int)blockIdx.x, opq((GAS bf16*)(opq(ws) + WS_XNB)), opq((GAS float*)(opq(ws) + WS_SSQ)));
#if MK_DUP == 6
        if (IN(pb + 6)) GEMM_SITE(EpiRes, YB, D, (const GAS bf16*)(opq(ws) + WS_WOUT) + (size_t)l * D * D, D, T, D, D, (int)blockIdx.x, opq((GAS bf16*)(opq(ws) + WS_HLB)), opq((GAS float*)(opq(ws) + WS_OMB)));
#endif
        SEAM(pb + 6);
        if (IN(pb + 8)) GEMM_SITE(EpiBf16, XNB, D, (const GAS bf16*)(opq(ws) + WS_WCQ) + (size_t)l * D * D, D, T, D, D, (int)blockIdx.x, opq(PROJB), D, D, opq((const GAS float*)(opq(ws) + WS_SSQ)), 16);
#if MK_DUP == 8
        if (IN(pb + 8)) GEMM_SITE(EpiBf16, XNB, D, (const GAS bf16*)(opq(ws) + WS_WCQ) + (size_t)l * D * D, D, T, D, D, (int)blockIdx.x, opq(PROJB), D, D, opq((const GAS float*)(opq(ws) + WS_SSQ)), 16);
#endif
        SEAM(pb + 8);
        if (IN(pb + 9)) {
            SITE();
            const GAS bf16* kv = (const GAS bf16*)(opq(ws) + WS_KVCB) + (size_t)l * NB * MEM * 2 * D;
            AttnP PC{opq((const GAS bf16*)PROJB), opq(kv), opq(kv + D), 1024, 2 * D, 2 * D, opq((GAS bf16*)(opq(ws) + WS_YB)), 1024, nullptr, nullptr, nullptr, nullptr, nullptr};
            cross_phase(PC, F.lds, TID_, wv_, LANE_, vcu_, G_);
#if MK_DUP == 9
            cross_phase(PC, F.lds, TID_, wv_, LANE_, vcu_, G_);
#endif
        }
        SEAM(pb + 9);
        if (IN(pb + 10)) GEMM_SITE(EpiRes, YB, D, (const GAS bf16*)(opq(ws) + WS_WCO) + (size_t)l * D * D, D, T, D, D, (int)blockIdx.x, opq((GAS bf16*)(opq(ws) + WS_XNB)), opq((GAS float*)(opq(ws) + WS_SSQ)));
        SEAM(pb + 10);
        if (IN(pb + 12)) { GEMM_SITE(EpiBf16, XNB, D, (const GAS bf16*)(opq(ws) + WS_WPQ) + (size_t)l * D * D, D, T, D, D, (int)blockIdx.x, opq(PROJB), D, D, opq((const GAS float*)(opq(ws) + WS_SSQ)), 16);
#if MK_DUP == 12
            hq_phase(opq(XNB), opq((const GAS float*)(opq(ws) + WS_SSQ)), (const GAS float*)args.in[opqi(27)] + l * D, opq((GAS unsigned char*)(opq(ws) + WS_HQ)), opq((GAS float*)(opq(ws) + WS_SH)), opq((GAS int*)(opq(ws) + WS_P)), gw_, NGW_, LANE_);
#endif
            }
        SEAM(pb + 12);
        if (IN(pb + 13)) {
            SITE();
            RouteP RP{opq((const GAS bf16*)PROJB), opq((const GAS bf16*)(opq(ws) + WS_KEYS) + (size_t)l * 2 * 128 * 64), opq((GAS int*)(opq(ws) + WS_EX)), opq((GAS float*)(opq(ws) + WS_GW))};
            route_phase(RP, F.lds, TID_, wv_, LANE_, vcu_, G_);
            hq_phase(opq(XNB), opq((const GAS float*)(opq(ws) + WS_SSQ)), (const GAS float*)args.in[opqi(27)] + l * D, opq((GAS unsigned char*)(opq(ws) + WS_HQ)), opq((GAS float*)(opq(ws) + WS_SH)), opq((GAS int*)(opq(ws) + WS_P)), gw_, NGW_, LANE_);
#if MK_DUP == 13
            route_phase(RP, F.lds, TID_, wv_, LANE_, vcu_, G_);
#endif
        }
        SEAM(pb + 13);
        if (IN(pb + 14)) {
            SITE();
            const PeerS ps = peer_sched((const GAS unsigned*)(F.ctl + CW_RANK), opqi(F.xcc), opqi(F.xrank));
            Peer1P Q1{opq((const GAS unsigned char*)(opq(ws) + WS_HQ)), opq((const GAS int*)(opq(ws) + WS_EX)), opq((const GAS unsigned char*)(opq(ws) + WS_U8) + (size_t)l * 16384 * 1024), opq((GAS int*)(opq(ws) + WS_PROJB))};
            peer_k1(Q1, ps, wv_, LANE_);
#if MK_DUP == 141
            { Peer1P Q1b = Q1; Q1b.P = (GAS int*)(opq(ws) + WS_HLB); peer_k1(Q1b, ps, wv_, LANE_); }
#endif
        }
        SEAM(pb + 14);
        if (IN(pb + 15)) {
            SITE();
            peer_w(opq((const GAS int*)(opq(ws) + WS_EX)), opq((const GAS float*)(opq(ws) + WS_GW)), opq((const GAS int*)(opq(ws) + WS_PROJB)), opq((const GAS float*)(opq(ws) + WS_SH)), opq((const GAS float*)(opq(ws) + WS_SU) + l * 16384), opq((const GAS float*)(opq(ws) + WS_SV) + l * 16384),
                   opq((GAS signed char*)(opq(ws) + WS_W)), opq((GAS float*)(opq(ws) + WS_WS)), gw_, NGW_, LANE_, F.lds, TID_);
#if MK_DUP == 150
            peer_w(opq((const GAS int*)(opq(ws) + WS_EX)), opq((const GAS float*)(opq(ws) + WS_GW)), opq((const GAS int*)(opq(ws) + WS_PROJB)), opq((const GAS float*)(opq(ws) + WS_SH)), opq((const GAS float*)(opq(ws) + WS_SU) + l * 16384), opq((const GAS float*)(opq(ws) + WS_SV) + l * 16384),
                   opq((GAS signed char*)(opq(ws) + WS_W)), opq((GAS float*)(opq(ws) + WS_WS)), gw_, NGW_, LANE_, F.lds, TID_);
#endif
            xcd_barrier(bar, (F.wave == 0 && lane_id_v() == 0) ? 1 : 0);
            const PeerS ps = peer_sched((const GAS unsigned*)(F.ctl + CW_RANK), opqi(F.xcc), opqi(F.xrank));
            Peer2P Q2{opq((const GAS int*)(opq(ws) + WS_EX)), opq((const GAS signed char*)(opq(ws) + WS_W)), opq((const GAS float*)(opq(ws) + WS_WS)), opq((const GAS unsigned char*)(opq(ws) + WS_V8) + (size_t)l * 16384 * 1024), opq((GAS bf16*)(opq(ws) + WS_XNB)), opq((GAS float*)(opq(ws) + WS_SSQ))};
            peer_k2(Q2, ps, wv_, LANE_);
#if MK_DUP == 151
            { Peer2P Q2b = Q2; Q2b.XB = (GAS bf16*)(opq(ws) + WS_HLB); Q2b.SSQ = (GAS float*)(opq(ws) + WS_OMB); peer_k2(Q2b, ps, wv_, LANE_); }
#endif
        }
        SEAM(pb + 15);
    }
    if (IN(PH_FINAL)) { SITE(); final_norm_phase(opq((const GAS bf16*)(opq(ws) + WS_XNB)), (GAS float*)args.out, (const GAS float*)args.in[opqi(32)], T, gw_, NGW_, LANE_); }
#undef IN
#undef SEAM
#undef GEMM_SITE
}
}
extern "C" void kernel_launch(void* const* d_in, const int* in_sizes, int n_in, void* d_out, int out_size, void* d_ws, size_t ws_size, hipStream_t stream) {
    (void)in_sizes; (void)out_size;
    static int grid = 0;
    if (grid == 0) {
        int dev = 0, cus = 0, per_cu = 0;
        if (n_in != 33 || ws_size < mk::WS_END) { fprintf(stderr, "kernel_launch: unexpected n_in %d / ws_size %zu\n", n_in, ws_size); grid = -1; return; }
        if (hipGetDevice(&dev) != hipSuccess || hipDeviceGetAttribute(&cus, hipDeviceAttributeMultiprocessorCount, dev) != hipSuccess) { grid = -1; return; }
        if (hipFuncSetAttribute((const void*)mk::fwd, hipFuncAttributeMaxDynamicSharedMemorySize, mk::LDS_BYTES) != hipSuccess) { fprintf(stderr, "kernel_launch: hipFuncSetAttribute failed\n"); grid = -1; return; }
        if (hipOccupancyMaxActiveBlocksPerMultiprocessor(&per_cu, (const void*)mk::fwd, mk::NWAVES * 64, mk::LDS_BYTES) != hipSuccess || per_cu < 1) fprintf(stderr, "kernel_launch: occupancy query says %d\n", per_cu);
        (void)hipGetLastError();
        grid = cus;
    }
    if (grid < 0) return;
    unsigned char* ws = (unsigned char*)d_ws;
    (void)hipMemsetAsync(ws + mk::WS_CTL, 0, mk::CTL_ZERO_BYTES, stream);
    mk::Args a{};
    for (int i = 0; i < 33; ++i) a.in[i] = (const float*)d_in[i];
    a.out = (float*)d_out; a.ws = ws;
    auto run = [&](int lo, int hi) { a.ph_lo = lo; a.ph_hi = hi; hipLaunchKernelGGL(mk::fwd, dim3(grid), dim3(mk::NWAVES * 64), mk::LDS_BYTES, stream, a); };
#if MK_ONE_LAUNCH
    run(0, mk::PH_FINAL + 1);
#else
    for (int p = 0; p <= mk::PH_FINAL; ++p) {
        const int k = (p - 2) % mk::NPL, l = (p - 2) / mk::NPL;
#if MK_NAIVE_PEER == 2
        if (p >= 2 && p < mk::PH_FINAL && k == 14) {
            hipLaunchKernelGGL(k_peer, dim3(T), dim3(256), 0, stream, (const bf16_t*)(ws + mk::WS_XNB), (const int*)(ws + mk::WS_EX), (const float*)(ws + mk::WS_GW), (const float*)d_in[30] + (size_t)l * NEXP * D, (const float*)d_in[31] + (size_t)l * NEXP * D, (float*)d_out);
            continue; }
#elif MK_NAIVE_PEER == 1
        if (p >= 2 && p < mk::PH_FINAL && k == 13) {
            float* TQ = (float*)(ws + (size_t)806 * mk::MiB);
            hipLaunchKernelGGL(k_bf2f, dim3((unsigned)(((size_t)T * D + 255) / 256)), dim3(256), 0, stream, (const bf16_t*)(ws + mk::WS_PROJB), TQ, (long)T * D);
            hipLaunchKernelGGL(k_route, dim3(T), dim3(256), 0, stream, TQ, (const float*)d_in[29] + (size_t)l * 2 * 128 * 64, (int*)(ws + mk::WS_EX), (float*)(ws + mk::WS_GW));
            hipLaunchKernelGGL(k_peer, dim3(T), dim3(256), 0, stream, (const bf16_t*)(ws + mk::WS_XNB), (const int*)(ws + mk::WS_EX), (const float*)(ws + mk::WS_GW), (const float*)d_in[30] + (size_t)l * NEXP * D, (const float*)d_in[31] + (size_t)l * NEXP * D, (float*)d_out);
            continue; }
        if (p >= 2 && p < mk::PH_FINAL && k == 14) continue;
#endif
        run(p, p + 1); }
#endif
}
```

```cpp
#include <hip/hip_runtime.h>
#include <cstdint>
#include <cstdio>
#include <cmath>

#ifndef MK_ONE_LAUNCH
#define MK_ONE_LAUNCH 1
#endif
#ifndef MK_DUP
#define MK_DUP 0
#endif
#ifndef MK_NAIVE_PEER
#define MK_NAIVE_PEER 0
#endif
namespace pg8 {
#define PG8_LAS __attribute__((address_space(3)))
#ifndef GAS
#define GAS __attribute__((address_space(1)))
#endif
typedef unsigned short bf16_t;
typedef short bf16x8 __attribute__((ext_vector_type(8)));
typedef float f32x4 __attribute__((ext_vector_type(4)));
typedef unsigned u32x4 __attribute__((ext_vector_type(4)));
typedef unsigned u32x2 __attribute__((ext_vector_type(2)));
constexpr int BM = 256, BK = 64, HALF = 128, HTB = HALF * BK * 2, STAGE_BYTES = 8 * HTB, NXCD = 8, WGM = 8;
__host__ __device__ __forceinline__ int lds_byte(int r, int c) { const int st = (r >> 4) * 2 + (c >> 5), rr = r & 15, cc = c & 31, ob = rr * 64 + cc * 2; return st * 1024 + (ob ^ (((ob >> 9) & 1) << 5)); }
__host__ __device__ __forceinline__ void stage_rc(int b, int& R, int& C) { const int st = b / 1024, sb = b % 1024, swz = sb ^ (((sb >> 9) & 1) << 5); R = (st >> 1) * 16 + swz / 64; C = (st & 1) * 32 + (swz % 64) / 2; }
__host__ __device__ __forceinline__ int perm32(int rho) { const int n = rho >> 4, i = rho & 15; return 8 * (i >> 2) + 4 * n + (i & 3); }
__device__ __forceinline__ int pg8_lane_id() { int l; asm volatile("v_mbcnt_lo_u32_b32 %0, -1, 0\n\tv_mbcnt_hi_u32_b32 %0, -1, %0" : "=v"(l)); return l; }
struct Unit { int pm, pn; };
struct Gemm { const GAS bf16_t* A; const GAS bf16_t* Bt; int M, N, K, lda, ldb; };
struct StaticOrder {
    int nM, nN, nwg, G, c;
    __host__ __device__ void init(int M, int N, int G_, int c_) { nM = M / BM; nN = N / BM; nwg = nM * nN; G = G_; c = c_; }
    __host__ __device__ bool next(int i, Unit& u) const {
        const long L = (long)i * G + c; if (L >= nwg) return false;
        int wgid = (int)L; { const int q = nwg / NXCD, r = nwg % NXCD, xcd = wgid % NXCD, off = wgid / NXCD; wgid = (xcd < r ? xcd * (q + 1) : r * (q + 1) + (xcd - r) * q) + off; }
        const int nig = WGM * nN, gid = wgid / nig, fm = gid * WGM, gsz = (nM - fm) < WGM ? (nM - fm) : WGM;
        u.pm = fm + ((wgid % nig) % gsz); u.pn = (wgid % nig) / gsz; return true;
    }
    __device__ __forceinline__ void a_ready(const Unit&) const {}
    __device__ __forceinline__ void done(const Unit&) const {}
};
__device__ __forceinline__ unsigned cvt_pk_bf16(float lo, float hi) { unsigned r; asm volatile("v_cvt_pk_bf16_f32 %0, %1, %2" : "=v"(r) : "v"(lo), "v"(hi)); return r; }

struct EpiF32 {
    static constexpr bool PERM = false, AFTER_DRAIN = false;
    GAS float* C; int ldc; int nvalid; int accum;
    __device__ __forceinline__ void operator()(const f32x4 (&acc)[2][2][4][2], const Unit& u, int wr, int wc, int fr, int fq) const {
        { const int l_ = pg8_lane_id(); fr = l_ & 15; fq = l_ >> 4; }
#pragma unroll
        for (int ai = 0; ai < 2; ++ai)
#pragma unroll
            for (int m = 0; m < 4; ++m) { const size_t row = (size_t)u.pm * BM + ai * HALF + wr * 64 + m * 16 + fr;
#pragma unroll
                for (int bj = 0; bj < 2; ++bj)
#pragma unroll
                    for (int n = 0; n < 2; ++n) { const int col = u.pn * BM + bj * HALF + wc * 32 + n * 16 + 4 * fq;
                        if (col < nvalid) { GAS float* p = C + row * ldc + col; f32x4 v = acc[ai][bj][m][n]; if (accum) v += *(const GAS f32x4*)p; *(GAS f32x4*)p = v; } } }
    }
};
struct EpiBf16 {
    static constexpr bool PERM = true, AFTER_DRAIN = false;
    GAS bf16_t* O; int ldc; int nvalid; const GAS float* ssq; int np;
    __device__ __forceinline__ void operator()(const f32x4 (&acc)[2][2][4][2], const Unit& u, int wr, int wc, int fr, int fq) const {
        { const int l_ = pg8_lane_id(); fr = l_ & 15; fq = l_ >> 4; }
#pragma unroll
        for (int ai = 0; ai < 2; ++ai)
#pragma unroll
            for (int m = 0; m < 4; ++m) { const size_t row = (size_t)u.pm * BM + ai * HALF + wr * 64 + m * 16 + fr;
                float rs_ = 1.f;
                if (np > 0) { const GAS f32x4* sp = (const GAS f32x4*)(ssq + row * 16); f32x4 t = sp[0] + sp[1]; if (np > 8) t += sp[2] + sp[3]; rs_ = __builtin_amdgcn_rsqf(((t[0] + t[1]) + (t[2] + t[3])) * (1.f / 1024.f) + 1e-6f); }
#pragma unroll
                for (int bj = 0; bj < 2; ++bj) { const int col = u.pn * BM + bj * HALF + wc * 32 + 8 * fq;
                    if (col < nvalid) { const f32x4 v0 = acc[ai][bj][m][0] * rs_, v1 = acc[ai][bj][m][1] * rs_; u32x4 w; w.x = cvt_pk_bf16(v0[0], v0[1]); w.y = cvt_pk_bf16(v0[2], v0[3]); w.z = cvt_pk_bf16(v1[0], v1[1]); w.w = cvt_pk_bf16(v1[2], v1[3]);
                        *(GAS u32x4*)(O + row * ldc + col) = w; } } }
    }
};
struct EpiUp {
    static constexpr bool PERM = true, AFTER_DRAIN = false;
    GAS bf16_t* O; GAS bf16_t* O2; int ldc; int nvalid; const GAS float* rs; int rsi; int mode;
    __device__ __forceinline__ void operator()(const f32x4 (&acc)[2][2][4][2], const Unit& u, int wr, int wc, int fr, int fq) const {
        { const int l_ = pg8_lane_id(); fr = l_ & 15; fq = l_ >> 4; }
#pragma unroll
        for (int ai = 0; ai < 2; ++ai)
#pragma unroll
            for (int m = 0; m < 4; ++m) { const size_t row = (size_t)u.pm * BM + ai * HALF + wr * 64 + m * 16 + fr; const float s = rs[2 * row + rsi];
#pragma unroll
                for (int bj = 0; bj < 2; ++bj) { const int col = u.pn * BM + bj * HALF + wc * 32 + 8 * fq;
                    if (col < nvalid) { const f32x4 v0 = acc[ai][bj][m][0] * s, v1 = acc[ai][bj][m][1] * s; u32x4 w; w.x = cvt_pk_bf16(v0[0], v0[1]); w.y = cvt_pk_bf16(v0[2], v0[3]); w.z = cvt_pk_bf16(v1[0], v1[1]); w.w = cvt_pk_bf16(v1[2], v1[3]);
                        GAS bf16_t* dst;
                        if (mode == 0) dst = O + row * ldc + col;
                        else { const int h = col >> 7, j = col & 127; dst = (j < 64) ? O + row * 384 + h * 96 + j : O2 + row * 256 + h * 64 + (j - 64); }
                        *(GAS u32x4*)dst = w; } } }
    }
};

struct EpiRes {
    static constexpr bool PERM = true, AFTER_DRAIN = false;
    GAS bf16_t* XB; GAS float* SSQ;
    __device__ __forceinline__ void operator()(const f32x4 (&acc)[2][2][4][2], const Unit& u, int wr, int wc, int fr, int fq) const {
        { const int l_ = pg8_lane_id(); fr = l_ & 15; fq = l_ >> 4; }
#pragma unroll
        for (int ai = 0; ai < 2; ++ai)
#pragma unroll
            for (int m = 0; m < 4; ++m) { const size_t row = (size_t)u.pm * BM + ai * HALF + wr * 64 + m * 16 + fr; float ss = 0.f;
#pragma unroll
                for (int bj = 0; bj < 2; ++bj) { GAS u32x4* p = (GAS u32x4*)(XB + row * 1024 + u.pn * BM + bj * HALF + wc * 32 + 8 * fq);
                    const u32x4 o = *p; const f32x4 v0 = acc[ai][bj][m][0], v1 = acc[ai][bj][m][1];
                    u32x4 w;
                    w.x = cvt_pk_bf16(__builtin_bit_cast(float, o.x << 16) + v0[0], __builtin_bit_cast(float, o.x & 0xffff0000u) + v0[1]);
                    w.y = cvt_pk_bf16(__builtin_bit_cast(float, o.y << 16) + v0[2], __builtin_bit_cast(float, o.y & 0xffff0000u) + v0[3]);
                    w.z = cvt_pk_bf16(__builtin_bit_cast(float, o.z << 16) + v1[0], __builtin_bit_cast(float, o.z & 0xffff0000u) + v1[1]);
                    w.w = cvt_pk_bf16(__builtin_bit_cast(float, o.w << 16) + v1[2], __builtin_bit_cast(float, o.w & 0xffff0000u) + v1[3]);
                    *p = w;
#pragma unroll
                    for (int e = 0; e < 4; ++e) { const float a = __builtin_bit_cast(float, w[e] << 16), b = __builtin_bit_cast(float, w[e] & 0xffff0000u); ss += a * a + b * b; } }
                { float a = ss, b = ss; asm volatile("v_nop\n\tv_nop\n\tv_permlane16_swap_b32 %0, %1" : "+v"(a), "+v"(b)); ss = a + b; }
                { float a = ss, b = ss; asm volatile("v_nop\n\tv_nop\n\tv_permlane32_swap_b32 %0, %1" : "+v"(a), "+v"(b)); ss = a + b; }
                if (fq == 0) SSQ[row * 16 + 4 * u.pn + wc] = ss; }
    }
};
template <class Epi, class Sched, bool ALIGN_EPI = false, bool SP2 = false>
__device__ __forceinline__ void gemm_phase(PG8_LAS unsigned char* lds, const Gemm g, const Sched& S, const Epi& E, int wave_id) {
    int tid_ = (wave_id << 6) | pg8_lane_id(); asm volatile("" : "+v"(tid_));
    const int tid = tid_, wid = __builtin_amdgcn_readfirstlane(tid >> 6), lane = tid & 63, wr = wid >> 2, wc = wid & 3, fr = lane & 15, fq = lane >> 4;
    const int K = g.K, nt = K / BK;
    unsigned voffA[2], voffB[2];
#pragma unroll
    for (int i = 0; i < 2; ++i) { int R, C; stage_rc(tid * 16 + i * 8192, R, C); const int Rb = Epi::PERM ? ((R & ~31) + perm32(R & 31)) : R;
        voffA[i] = (unsigned)(R * g.lda + C) * 2u; voffB[i] = (unsigned)(Rb * g.ldb + C) * 2u; }
    const size_t kstep = (size_t)(BK * 2);
    const size_t hstepA = (size_t)HALF * g.lda * 2, hstepB = (size_t)HALF * g.ldb * 2;
    const size_t tstepA = 2 * hstepA, tstepB = 2 * hstepB;
    const unsigned ldsw = (unsigned)wid * 1024u;
    const int aoff = lds_byte(wr * 64 + fr, fq * 8), boff = lds_byte(wc * 32 + fr, fq * 8);
#define PG8_SA(b, h) (((b) * 2 + (h)) * HTB)
#define PG8_SB(b, h) ((4 + (b) * 2 + (h)) * HTB)
#define PG8_STAGE(bufoff, gbase, voff) do { _Pragma("unroll") for (int _i = 0; _i < 2; ++_i) \
        __builtin_amdgcn_global_load_lds((const unsigned*)((const char*)(gbase) + (voff)[_i]), (PG8_LAS unsigned*)(lds + (bufoff) + ldsw + _i * 8192), 16, 0, 0); } while (0)
#define PG8_LDA(dst, b, h) do { _Pragma("unroll") for (int m = 0; m < 4; ++m) _Pragma("unroll") for (int k = 0; k < 2; ++k) dst[m][k] = *(const PG8_LAS bf16x8*)(lds + PG8_SA(b, h) + aoff + m * 2048 + k * 1024); } while (0)
#define PG8_LDB(dst, b, h) do { _Pragma("unroll") for (int n = 0; n < 2; ++n) _Pragma("unroll") for (int k = 0; k < 2; ++k) dst[n][k] = *(const PG8_LAS bf16x8*)(lds + PG8_SB(b, h) + boff + n * 2048 + k * 1024); } while (0)
#define PG8_MMA(ai, bj, At, Bt) do { __builtin_amdgcn_s_setprio(1); _Pragma("unroll") for (int m = 0; m < 4; ++m) _Pragma("unroll") for (int n = 0; n < 2; ++n) _Pragma("unroll") for (int k = 0; k < 2; ++k) \
        acc[ai][bj][m][n] = __builtin_amdgcn_mfma_f32_16x16x32_bf16(Bt[n][k], At[m][k], acc[ai][bj][m][n], 0, 0, 0); __builtin_amdgcn_s_setprio(0); } while (0)
#define PG8_WAIT_V(n) asm volatile("s_waitcnt vmcnt(" #n ")" ::: "memory")
#define PG8_WAIT_L(n) asm volatile("s_waitcnt lgkmcnt(" #n ")" ::: "memory")
#define PG8_BAR __builtin_amdgcn_s_barrier()
#define PG8_SCHED __builtin_amdgcn_sched_barrier(0)
    Unit cur, nxt; int ui = 0;
    if (!S.next(0, cur)) return;
    f32x4 acc[2][2][4][2];
#pragma unroll
    for (int a = 0; a < 2; ++a)
#pragma unroll
        for (int b = 0; b < 2; ++b)
#pragma unroll
            for (int m = 0; m < 4; ++m)
#pragma unroll
                for (int n = 0; n < 2; ++n) acc[a][b][m][n] = (f32x4){0.f, 0.f, 0.f, 0.f};
    bf16x8 At[4][2], B0[2][2], B1[2][2];
    const char* cA = (const char*)g.A + (size_t)cur.pm * tstepA; const char* cB = (const char*)g.Bt + (size_t)cur.pn * tstepB;
    S.a_ready(cur);
    if constexpr (SP2) {
        PG8_STAGE(PG8_SB(0, 0), cB, voffB); PG8_STAGE(PG8_SB(0, 1), cB + hstepB, voffB); PG8_STAGE(PG8_SA(0, 0), cA, voffA); PG8_STAGE(PG8_SA(0, 1), cA + hstepA, voffA);
        if (wr == 1) PG8_BAR;
        PG8_WAIT_V(2); PG8_BAR;
        PG8_STAGE(PG8_SB(1, 0), cB + kstep, voffB); PG8_STAGE(PG8_SA(1, 0), cA + kstep, voffA); PG8_STAGE(PG8_SB(1, 1), cB + hstepB + kstep, voffB);
        PG8_WAIT_V(6); PG8_BAR;
    } else {
        PG8_STAGE(PG8_SB(0, 0), cB, voffB); PG8_STAGE(PG8_SA(0, 0), cA, voffA); PG8_STAGE(PG8_SB(0, 1), cB + hstepB, voffB); PG8_STAGE(PG8_SA(0, 1), cA + hstepA, voffA);
        if (wr == 1) PG8_BAR;
        PG8_WAIT_V(4); PG8_BAR;
        PG8_STAGE(PG8_SB(1, 0), cB + kstep, voffB); PG8_STAGE(PG8_SA(1, 0), cA + kstep, voffA); PG8_STAGE(PG8_SB(1, 1), cB + hstepB + kstep, voffB);
        PG8_WAIT_V(6); PG8_BAR;
    }
    for (;;) {
        const bool has_next = S.next(ui + 1, nxt);
        const char* nA = has_next ? (const char*)g.A + (size_t)nxt.pm * tstepA : cA; const char* nB = has_next ? (const char*)g.Bt + (size_t)nxt.pn * tstepB : cB;
        for (int t = 0; t < nt; t += 2) {
            const bool last = (t == nt - 2);
            const char* a1 = cA + (size_t)(t + 1) * kstep;
            const char* a2 = last ? nA : cA + (size_t)(t + 2) * kstep; const char* b2 = last ? nB : cB + (size_t)(t + 2) * kstep;
            const char* a3 = a2 + kstep; const char* b3 = b2 + kstep;
            if (last && has_next) S.a_ready(nxt);
            if constexpr (SP2) {
            PG8_LDB(B0, 0, 0); PG8_LDB(B1, 0, 1); PG8_SCHED; PG8_LDA(At, 0, 0); PG8_STAGE(PG8_SA(1, 1), a1 + hstepA, voffA);
            PG8_WAIT_V(8); PG8_WAIT_L(0); PG8_BAR; PG8_MMA(0, 0, At, B0); PG8_MMA(0, 1, At, B1); PG8_BAR; PG8_SCHED;
            PG8_LDA(At, 0, 1); PG8_STAGE(PG8_SB(0, 0), b2, voffB); PG8_STAGE(PG8_SB(0, 1), b2 + hstepB, voffB); PG8_STAGE(PG8_SA(0, 0), a2, voffA);
            PG8_WAIT_V(8); PG8_WAIT_L(0); PG8_BAR; PG8_MMA(1, 0, At, B0); PG8_MMA(1, 1, At, B1); PG8_BAR; PG8_SCHED;
            PG8_LDB(B0, 1, 0); PG8_LDB(B1, 1, 1); PG8_SCHED; PG8_LDA(At, 1, 0); PG8_STAGE(PG8_SA(0, 1), a2 + hstepA, voffA);
            PG8_WAIT_V(8); PG8_WAIT_L(0); PG8_BAR; PG8_MMA(0, 0, At, B0); PG8_MMA(0, 1, At, B1); PG8_BAR; PG8_SCHED;
            PG8_LDA(At, 1, 1); PG8_STAGE(PG8_SB(1, 0), b3, voffB); PG8_STAGE(PG8_SB(1, 1), b3 + hstepB, voffB); PG8_STAGE(PG8_SA(1, 0), a3, voffA);
            PG8_WAIT_V(8); PG8_WAIT_L(0); PG8_BAR; PG8_MMA(1, 0, At, B0); PG8_MMA(1, 1, At, B1); PG8_BAR; PG8_SCHED;
            } else {
            PG8_LDB(B0, 0, 0); PG8_SCHED; PG8_LDA(At, 0, 0); PG8_STAGE(PG8_SA(1, 1), a1 + hstepA, voffA);
            PG8_WAIT_L(8); PG8_BAR; PG8_WAIT_L(0); PG8_MMA(0, 0, At, B0); PG8_BAR; PG8_SCHED;
            PG8_LDB(B1, 0, 1); PG8_STAGE(PG8_SB(0, 0), b2, voffB);
            PG8_BAR; PG8_WAIT_L(0); PG8_MMA(0, 1, At, B1); PG8_BAR;
            PG8_LDA(At, 0, 1); PG8_STAGE(PG8_SA(0, 0), a2, voffA);
            PG8_BAR; PG8_WAIT_L(0); PG8_MMA(1, 0, At, B0); PG8_BAR; PG8_SCHED;
            PG8_STAGE(PG8_SB(0, 1), b2 + hstepB, voffB);
            PG8_WAIT_V(6); PG8_BAR; PG8_MMA(1, 1, At, B1); PG8_BAR;
            PG8_LDB(B0, 1, 0); PG8_SCHED; PG8_LDA(At, 1, 0); PG8_STAGE(PG8_SA(0, 1), a2 + hstepA, voffA);
            PG8_WAIT_L(8); PG8_BAR; PG8_WAIT_L(0); PG8_MMA(0, 0, At, B0); PG8_BAR; PG8_SCHED;
            PG8_LDB(B1, 1, 1); PG8_STAGE(PG8_SB(1, 0), b3, voffB);
            PG8_BAR; PG8_WAIT_L(0); PG8_MMA(0, 1, At, B1); PG8_BAR;
            PG8_LDA(At, 1, 1); PG8_STAGE(PG8_SA(1, 0), a3, voffA);
            PG8_BAR; PG8_WAIT_L(0); PG8_MMA(1, 0, At, B0); PG8_BAR; PG8_SCHED;
            PG8_STAGE(PG8_SB(1, 1), b3 + hstepB, voffB);
            PG8_WAIT_V(6); PG8_BAR; PG8_MMA(1, 1, At, B1); PG8_BAR;
            }
        }
        if constexpr (ALIGN_EPI) { if (wr == 0) PG8_BAR; }
        if constexpr (!Epi::AFTER_DRAIN) { E(acc, cur, wr, wc, fr, fq); S.done(cur); }
        if (!has_next) break;
#pragma unroll
        for (int a = 0; a < 2; ++a)
#pragma unroll
            for (int b = 0; b < 2; ++b)
#pragma unroll
                for (int m = 0; m < 4; ++m)
#pragma unroll
                    for (int n = 0; n < 2; ++n) acc[a][b][m][n] = (f32x4){0.f, 0.f, 0.f, 0.f};
        cur = nxt; cA = nA; cB = nB; ++ui;
        if constexpr (ALIGN_EPI) { if (wr == 1) PG8_BAR; }
    }
    PG8_WAIT_V(0);
    if constexpr (!ALIGN_EPI) { if (wr == 0) PG8_BAR; }
    PG8_BAR;
    if constexpr (Epi::AFTER_DRAIN) { E.fused(acc, cur, wr, wc, fr, fq, lds, wid, lane); S.done(cur); }
#undef PG8_SA
#undef PG8_SB
#undef PG8_STAGE
#undef PG8_LDA
#undef PG8_LDB
#undef PG8_MMA
#undef PG8_WAIT_V
#undef PG8_WAIT_L
#undef PG8_BAR
#undef PG8_SCHED
}
}

namespace mk {
#ifndef GAS
#define GAS __attribute__((address_space(1)))
#endif
#define LAS __attribute__((address_space(3)))
typedef unsigned short bf16;
typedef unsigned v4u __attribute__((ext_vector_type(4)));
typedef unsigned v2u __attribute__((ext_vector_type(2)));
typedef float f32x4 __attribute__((ext_vector_type(4)));
typedef GAS unsigned gu32;
#define LDS_WAIT() asm volatile("s_waitcnt lgkmcnt(0)" ::: "memory")
#define VM_WAIT() asm volatile("s_waitcnt vmcnt(0)" ::: "memory")
__device__ __forceinline__ unsigned f2bf_(float f) { unsigned u = __builtin_bit_cast(unsigned, f); return (u + 0x7fffu + ((u >> 16) & 1u)) >> 16; }
__device__ __forceinline__ unsigned pk2(float lo, float hi) { return f2bf_(lo) | (f2bf_(hi) << 16); }
__device__ __forceinline__ float bflo(unsigned w) { return __builtin_bit_cast(float, w << 16); }
__device__ __forceinline__ float bfhi(unsigned w) { return __builtin_bit_cast(float, w & 0xffff0000u); }

template <class P> __device__ __forceinline__ P* opq(P* p) { asm volatile("" : "+s"(p)); return p; }
__device__ __forceinline__ int opqi(int k) { asm volatile("" : "+s"(k)); return k; }
__device__ __forceinline__ float shx(float v, int o, int lane) { return __builtin_bit_cast(float, __builtin_amdgcn_ds_bpermute((lane ^ o) << 2, __builtin_bit_cast(int, v))); }
__device__ __forceinline__ int shxi(int v, int o, int lane) { return __builtin_amdgcn_ds_bpermute((lane ^ o) << 2, v); }
__device__ __forceinline__ int lane_id_v() { int l; asm volatile("v_mbcnt_lo_u32_b32 %0, -1, 0\n\tv_mbcnt_hi_u32_b32 %0, -1, %0" : "=v"(l)); return l; }
constexpr int NWAVES = 8;
constexpr int D = 1024, NB = 4, S = 8192, T = NB * S, L = 4, MEM = 256, INW = 2144, INP = 2304;
constexpr int PC_CQ = 0, PC_CKV = 256, PC_KR = 384, PC_XL = 512, PC_GL = 1024, PC_QD = 1536, PC_KD = 1792, PC_VD = 2048;
constexpr float LOG2E = 1.4426950408889634f;
constexpr size_t MiB = 1u << 20;
constexpr size_t WS_CTL = 0, CTL_ZERO_BYTES = 1 * MiB;
constexpr size_t WS_WIN = 1 * MiB, WS_WOUT = 19 * MiB, WS_WCQ = 27 * MiB, WS_WCO = 35 * MiB, WS_WPQ = 43 * MiB, WS_WCKV = 51 * MiB, WS_WUQ = 67 * MiB, WS_WUKV = 68 * MiB, WS_KEYS = 69 * MiB, WS_ROPE = 70 * MiB;
constexpr size_t WS_XNB = 76 * MiB, WS_YB = 140 * MiB, WS_PROJB = 204 * MiB, WS_QMB = 348 * MiB, WS_KMB = 372 * MiB, WS_VMB = 396 * MiB, WS_RS = 412 * MiB;
constexpr size_t WS_HLB = 413 * MiB, WS_ACB = 445 * MiB, WS_LSUM = 477 * MiB, WS_OMB = 478 * MiB, WS_MNB = 494 * MiB, WS_KVCB = 502 * MiB, WS_EX = 518 * MiB, WS_GW = 534 * MiB;
constexpr size_t WS_U8 = 550 * MiB, WS_V8 = 614 * MiB, WS_SU = 678 * MiB, WS_SV = 679 * MiB;
constexpr size_t WS_HQ = 680 * MiB, WS_P = 712 * MiB, WS_SH = 728 * MiB, WS_W = 729 * MiB, WS_WS = 745 * MiB, WS_SSQ = 746 * MiB, WS_END = 748 * MiB;
constexpr size_t WS_WAT = 74 * MiB;
constexpr size_t WS_BTAB = WS_KEYS + 512 * 1024, WS_LAMS = WS_BTAB + 4096, WS_SP = WS_LAMS + 4096;
constexpr int CW_BAR = 4096, CW_RANK = 8192;
constexpr int RING_OFF = 0, RING_BYTES = 155648, LDSCTL_OFF = RING_BYTES, MISC_OFF = LDSCTL_OFF + 320, LDS_BYTES = 163840;

#define XB_TMO      128
#define XB_XCNT(j)  (256  + 64 * (j))
#define XB_XSUB(j)  (1280 + 64 * (j))
#define XB_XGEN(j)  (2304 + 64 * (j))
#define XB_TOP      3328
#define XB_TOPGEN   3392
#define XCD_BAR_WORDS 3456
#define XB_SPIN_CAP (1u << 18)

__device__ __forceinline__ unsigned xb_ld(unsigned* p)              { return __hip_atomic_load(p, __ATOMIC_RELAXED, __HIP_MEMORY_SCOPE_AGENT); }
__device__ __forceinline__ unsigned xb_add(unsigned* p, unsigned v) { return __hip_atomic_fetch_add(p, v, __ATOMIC_RELAXED, __HIP_MEMORY_SCOPE_AGENT); }
__device__ __forceinline__ unsigned xb_xcc_id() { return (unsigned)__builtin_amdgcn_s_getreg((3 << 11) | 20) & 0xFu; }
#define XB_SPIN(cond, bar) do { unsigned _sp = 0; while (cond) { __builtin_amdgcn_s_sleep(1); \
    if ((++_sp & 255u) == 0u) { if (xb_ld(&(bar)[XB_TMO])) break; if (_sp > XB_SPIN_CAP) { atomicAdd(&(bar)[XB_TMO], 1u); break; } } } } while (0)

struct XcdBarrier {
    unsigned* bar; unsigned x;
    volatile LAS unsigned* st;
};

__device__ __forceinline__ XcdBarrier xcd_barrier_post(unsigned* bar, volatile LAS unsigned* st) {
    XcdBarrier b; b.bar = bar; b.x = xb_xcc_id(); b.st = st;
    if (threadIdx.x == 0) (void)xb_add(&bar[XB_XCNT(b.x)], 1u);
    return b;
}
__device__ __forceinline__ void xcd_barrier_complete(unsigned* bar, unsigned x, unsigned& nloc, unsigned& nx) {
    const unsigned G = gridDim.x * gridDim.y * gridDim.z;
    unsigned sum, cnt, mine, sp = 0u;
    for (;;) {
        sum = 0u; cnt = 0u; mine = 0u;
#pragma unroll
        for (unsigned j = 0; j < 16; ++j) { const unsigned c = xb_ld(&bar[XB_XCNT(j)]); sum += c; cnt += (c > 0u) ? 1u : 0u; mine = (j == x) ? c : mine; }
        if (sum == G) break;
        __builtin_amdgcn_s_sleep(1);
        if ((++sp & 255u) == 0u) { if (xb_ld(&bar[XB_TMO])) break; if (sp > XB_SPIN_CAP) { atomicAdd(&bar[XB_TMO], 1u); break; } }
    }
    nloc = mine > 0u ? mine : 1u; nx = cnt > 0u ? cnt : 1u;
}

__device__ __noinline__ void xcd_barrier_impl(unsigned* bar_, unsigned x_, volatile LAS unsigned* st_, int leader_) {
    XcdBarrier b; b.bar = bar_; b.x = x_; b.st = st_;
    asm volatile("s_waitcnt vmcnt(0)" ::: "memory");
    __syncthreads();
    if (leader_) {
        unsigned* bar = b.bar;
        __builtin_amdgcn_s_waitcnt(0);
        unsigned nloc = b.st[0], nx = b.st[1];
        if (nloc == 0u) { xcd_barrier_complete(bar, b.x, nloc, nx); b.st[0] = nloc; b.st[1] = nx; }
        const unsigned old = xb_add(&bar[XB_XSUB(b.x)], 1u);
        const unsigned gen = old / nloc;
        if (old + 1u == (gen + 1u) * nloc) {
            __builtin_amdgcn_fence(__ATOMIC_RELEASE, "agent");
            asm volatile("s_waitcnt vmcnt(0)" ::: "memory");
            const unsigned og = xb_add(&bar[XB_TOP], 1u);
            const unsigned tg = og / nx;
            if (og + 1u == (tg + 1u) * nx) xb_add(&bar[XB_TOPGEN], 1u);
            else XB_SPIN(xb_ld(&bar[XB_TOPGEN]) == tg, bar);
            __builtin_amdgcn_fence(__ATOMIC_ACQUIRE, "agent");
            xb_add(&bar[XB_XGEN(b.x)], 1u);
            asm volatile("s_waitcnt vmcnt(0)" ::: "memory");
        } else {
            XB_SPIN(xb_ld(&bar[XB_XGEN(b.x)]) == gen, bar);
            __builtin_amdgcn_fence(__ATOMIC_ACQUIRE, "agent");
            asm volatile("s_waitcnt vmcnt(0)" ::: "memory");
        }
    }
    __syncthreads();
}
__device__ __forceinline__ void xcd_barrier(const XcdBarrier& b, int leader) { xcd_barrier_impl(b.bar, b.x, b.st, leader); }


__device__ __forceinline__ float wave_sum(float v, int lane) {
    (void)lane;
    v += __builtin_bit_cast(float, __builtin_amdgcn_update_dpp(0, __builtin_bit_cast(int, v), 0xB1, 0xF, 0xF, true));
    v += __builtin_bit_cast(float, __builtin_amdgcn_update_dpp(0, __builtin_bit_cast(int, v), 0x4E, 0xF, 0xF, true));
    v += __builtin_bit_cast(float, __builtin_amdgcn_update_dpp(0, __builtin_bit_cast(int, v), 0x141, 0xF, 0xF, true));
    v += __builtin_bit_cast(float, __builtin_amdgcn_update_dpp(0, __builtin_bit_cast(int, v), 0x140, 0xF, 0xF, true));
    { float a = v, b = v; asm volatile("v_nop\n\tv_nop\n\tv_permlane16_swap_b32 %0, %1" : "+v"(a), "+v"(b)); v = a + b; }
    { float a = v, b = v; asm volatile("v_nop\n\tv_nop\n\tv_permlane32_swap_b32 %0, %1" : "+v"(a), "+v"(b)); v = a + b; }
    return v;
}
__device__ __forceinline__ float wave_max(float v) {
    v = fmaxf(v, __builtin_bit_cast(float, __builtin_amdgcn_update_dpp(0, __builtin_bit_cast(int, v), 0xB1, 0xF, 0xF, true)));
    v = fmaxf(v, __builtin_bit_cast(float, __builtin_amdgcn_update_dpp(0, __builtin_bit_cast(int, v), 0x4E, 0xF, 0xF, true)));
    v = fmaxf(v, __builtin_bit_cast(float, __builtin_amdgcn_update_dpp(0, __builtin_bit_cast(int, v), 0x141, 0xF, 0xF, true)));
    v = fmaxf(v, __builtin_bit_cast(float, __builtin_amdgcn_update_dpp(0, __builtin_bit_cast(int, v), 0x140, 0xF, 0xF, true)));
    { float a = v, b = v; asm volatile("v_nop\n\tv_nop\n\tv_permlane16_swap_b32 %0, %1" : "+v"(a), "+v"(b)); v = fmaxf(a, b); }
    { float a = v, b = v; asm volatile("v_nop\n\tv_nop\n\tv_permlane32_swap_b32 %0, %1" : "+v"(a), "+v"(b)); v = fmaxf(a, b); }
    return v;
}
__device__ __forceinline__ float gelu_erf(float v) {
    const float av = __builtin_fabsf(v), t = __builtin_amdgcn_rcpf(av * 0.2316418882f + 1.0f);
    float q = t * 0.5307027145f + (-0.7265760135f); q = q * t + 0.7107068705f; q = q * t + (-0.142248368f); q = q * t + 0.127414796f; q = q * t;
    const float e = __builtin_amdgcn_exp2f((v * v) * (-0.72134752044f));
    const float m = v * (q * e);
    return v < 0.f ? m : v - m;
}

__device__ __forceinline__ void norm_phase(const GAS float* X, const GAS float* g, GAS bf16* out, int rows, int gw, int NGW, int lane) {
    asm volatile("" : "+v"(lane));
    f32x4 gv[4];
#pragma unroll
    for (int j = 0; j < 4; ++j) gv[j] = ((const GAS f32x4*)g)[lane + 64 * j];
    for (int m = gw; m < rows; m += NGW) {
        const GAS f32x4* xr = (const GAS f32x4*)(X + (size_t)m * D) + lane;
        f32x4 v[4]; float s = 0.f;
#pragma unroll
        for (int j = 0; j < 4; ++j) { v[j] = xr[64 * j]; s += (v[j].x * v[j].x + v[j].y * v[j].y) + (v[j].z * v[j].z + v[j].w * v[j].w); }
        const float rs = rsqrtf(wave_sum(s, lane) * (1.f / D) + 1e-6f);
        GAS v2u* o8 = (GAS v2u*)(out + (size_t)m * D) + lane;
#pragma unroll
        for (int j = 0; j < 4; ++j) { v2u w; w.x = pk2(v[j].x * rs * gv[j].x, v[j].y * rs * gv[j].y); w.y = pk2(v[j].z * rs * gv[j].z, v[j].w * rs * gv[j].w); o8[64 * j] = w; }
    }
}
__device__ __forceinline__ void hq_phase(const GAS bf16* XB, const GAS float* SSQ, const GAS float* g, GAS unsigned char* HQ, GAS float* SH, GAS int* Pz, int gw, int NGW, int lane) {
    asm volatile("" : "+v"(lane));
    const GAS f32x4* gp = (const GAS f32x4*)g + 4 * lane; const f32x4 g0 = gp[0], g1 = gp[1], g2 = gp[2], g3 = gp[3];
    for (int m = gw; m < T; m += NGW) {
        const GAS f32x4* sp = (const GAS f32x4*)(SSQ + (size_t)m * 16); const f32x4 t = (sp[0] + sp[1]) + (sp[2] + sp[3]);
        const float rs = __builtin_amdgcn_rsqf(((t[0] + t[1]) + (t[2] + t[3])) * (1.f / 1024.f) + 1e-6f);
        const v4u a = *(const GAS v4u*)(XB + (size_t)m * D + 16 * lane), b = *(const GAS v4u*)(XB + (size_t)m * D + 16 * lane + 8);
        float f[16] = {bflo(a.x) * g0[0], bfhi(a.x) * g0[1], bflo(a.y) * g0[2], bfhi(a.y) * g0[3], bflo(a.z) * g1[0], bfhi(a.z) * g1[1], bflo(a.w) * g1[2], bfhi(a.w) * g1[3],
                       bflo(b.x) * g2[0], bfhi(b.x) * g2[1], bflo(b.y) * g2[2], bfhi(b.y) * g2[3], bflo(b.z) * g3[0], bfhi(b.z) * g3[1], bflo(b.w) * g3[2], bfhi(b.w) * g3[3]};
        float mx = 0.f;
#pragma unroll
        for (int i = 0; i < 16; ++i) { f[i] *= rs; mx = fmaxf(mx, __builtin_fabsf(f[i])); }
        mx = wave_max(mx);
        const float inv = mx > 0.f ? 127.f / mx : 0.f;
        v4u q;
#pragma unroll
        for (int i = 0; i < 4; ++i) { const int ia = (int)__builtin_rintf(f[4 * i] * inv), ib = (int)__builtin_rintf(f[4 * i + 1] * inv), ic = (int)__builtin_rintf(f[4 * i + 2] * inv), id = (int)__builtin_rintf(f[4 * i + 3] * inv);
            q[i] = (unsigned)(ia & 255) | ((unsigned)(ib & 255) << 8) | ((unsigned)(ic & 255) << 16) | ((unsigned)(id & 255) << 24); }
        *(GAS v4u*)(HQ + (size_t)m * D + 16 * lane) = q;
        if (lane == 0) SH[m] = mx * (1.f / 127.f);
    }
}
__device__ __forceinline__ void x0_phase(const GAS float* X, GAS bf16* XB, GAS float* SSQ, int gw, int NGW, int lane) {
    asm volatile("" : "+v"(lane));
    for (int m = gw; m < T; m += NGW) {
        const GAS f32x4* xr = (const GAS f32x4*)(X + (size_t)m * D) + lane; GAS v2u* o8 = (GAS v2u*)(XB + (size_t)m * D) + lane;
        float s = 0.f;
#pragma unroll
        for (int j = 0; j < 4; ++j) { const f32x4 v = xr[64 * j]; s += (v.x * v.x + v.y * v.y) + (v.z * v.z + v.w * v.w); v2u w; w.x = pk2(v.x, v.y); w.y = pk2(v.z, v.w); o8[64 * j] = w; }
        s = wave_sum(s, lane);
        if (lane < 8) SSQ[(size_t)m * 16 + lane] = lane == 0 ? s : 0.f;
    }
}
__device__ __forceinline__ void final_norm_phase(const GAS bf16* XB, GAS float* O, const GAS float* g, int rows, int gw, int NGW, int lane) {
    asm volatile("" : "+v"(lane));
    for (int m = gw; m < rows; m += NGW) {
        const GAS v4u* xr = (const GAS v4u*)(XB + (size_t)m * D) + lane;
        v4u v[2]; float s = 0.f;
#pragma unroll
        for (int j = 0; j < 2; ++j) { v[j] = xr[64 * j];
#pragma unroll
            for (int e = 0; e < 4; ++e) { const float a = bflo(v[j][e]), b = bfhi(v[j][e]); s += a * a + b * b; } }
        const float rs = rsqrtf(wave_sum(s, lane) * (1.f / D) + 1e-6f);
#pragma unroll
        for (int j = 0; j < 2; ++j) { const int c = 8 * (lane + 64 * j); const f32x4 g0 = *(const GAS f32x4*)(g + c), g1 = *(const GAS f32x4*)(g + c + 4);
            f32x4 o0, o1; o0.x = bflo(v[j].x) * rs * g0.x; o0.y = bfhi(v[j].x) * rs * g0.y; o0.z = bflo(v[j].y) * rs * g0.z; o0.w = bfhi(v[j].y) * rs * g0.w;
            o1.x = bflo(v[j].z) * rs * g1.x; o1.y = bfhi(v[j].z) * rs * g1.y; o1.z = bflo(v[j].w) * rs * g1.z; o1.w = bfhi(v[j].w) * rs * g1.w;
            *(GAS f32x4*)(O + (size_t)m * D + c) = o0; *(GAS f32x4*)(O + (size_t)m * D + c + 4) = o1; }
    }
}

__device__ __forceinline__ float row16_sum(float v) {
    v += __builtin_bit_cast(float, __builtin_amdgcn_update_dpp(0, __builtin_bit_cast(int, v), 0xB1, 0xF, 0xF, true));
    v += __builtin_bit_cast(float, __builtin_amdgcn_update_dpp(0, __builtin_bit_cast(int, v), 0x4E, 0xF, 0xF, true));
    v += __builtin_bit_cast(float, __builtin_amdgcn_update_dpp(0, __builtin_bit_cast(int, v), 0x141, 0xF, 0xF, true));
    v += __builtin_bit_cast(float, __builtin_amdgcn_update_dpp(0, __builtin_bit_cast(int, v), 0x140, 0xF, 0xF, true));
    return v;
}
__device__ __forceinline__ float sq8(const v4u w) { const float a0 = bflo(w.x), a1 = bfhi(w.x), a2 = bflo(w.y), a3 = bfhi(w.y), a4 = bflo(w.z), a5 = bfhi(w.z), a6 = bflo(w.w), a7 = bfhi(w.w);
    return (a0 * a0 + a1 * a1) + (a2 * a2 + a3 * a3) + (a4 * a4 + a5 * a5) + (a6 * a6 + a7 * a7); }
__device__ __forceinline__ void pre_phase(const GAS bf16* PROJB, const GAS float* ROPE, GAS float* RS, GAS bf16* KMB, int gw, int NGW, int lane) {
    asm volatile("" : "+v"(lane));
    const int q = lane >> 4, sub = lane & 15;
    for (int t0 = gw * 4; t0 < T; t0 += NGW * 4) {
        const size_t t = (size_t)t0 + q;
        const GAS bf16* pr = PROJB + t * INP;
        const v4u w0 = *(const GAS v4u*)(pr + PC_CQ + 8 * sub), w1 = *(const GAS v4u*)(pr + PC_CQ + 8 * (16 + (sub & 7))), w2 = *(const GAS v4u*)(pr + PC_CKV + 8 * sub);
        const float x1 = __builtin_bit_cast(float, (unsigned)pr[PC_KR + sub] << 16), x2 = __builtin_bit_cast(float, (unsigned)pr[PC_KR + 16 + sub] << 16);
        const float c = ROPE[t * 32 + sub], sn = ROPE[t * 32 + 16 + sub];
        const float sq = row16_sum(sq8(w0) + (sub < 8 ? sq8(w1) : 0.f)), skv = row16_sum(sq8(w2));
        if (sub == 0) { RS[2 * t] = rsqrtf(sq * (1.f / 192.f) + 1e-6f); RS[2 * t + 1] = rsqrtf(skv * (1.f / 128.f) + 1e-6f); }
        const bf16 y1 = (bf16)f2bf_(x1 * c - x2 * sn), y2 = (bf16)f2bf_(x1 * sn + x2 * c);
        GAS bf16* kr = KMB + t * 384 + 64 + sub;
#pragma unroll
        for (int h = 0; h < 4; ++h) { kr[h * 96] = y1; kr[h * 96 + 16] = y2; }
    }
}

typedef short lr_bf16x8 __attribute__((ext_vector_type(8)));
typedef float lr_f32x16 __attribute__((ext_vector_type(16)));
__device__ __forceinline__ void lr_swap32(float& a, float& b) { asm volatile("v_nop\n\tv_nop\n\tv_permlane32_swap_b32 %0, %1" : "+v"(a), "+v"(b)); }
constexpr int LR_XR = 0, LR_CW = LR_XR + 37376, LR_XA = LR_CW + 1280, LR_WT = LR_XA + 256 * 144, LR_SUM = LR_WT + 2 * 64 * 144, LR_END = LR_SUM + 4096;
struct LruP { const GAS bf16* PROJB; const GAS float* cw; const GAS float* cb; const GAS bf16* wat; const GAS float* ba; const GAS float* bx; const GAS float* sp; GAS unsigned* HA; GAS float* LSUM; };
__device__ __forceinline__ void lru_phase(const LruP& P, LAS unsigned char* lds, int tid, int wave, int lane, int vcu, int G) {
    asm volatile("" : "+v"(tid), "+v"(lane));
    LAS float* SUM = (LAS float*)(lds + LR_SUM);
    for (int u = vcu; u < (T / 256) * 8; u += G) {
        const int tile = u >> 3, g = u & 7; const int t0 = tile * 256; const bool first = ((tile & 31) == 0);
        __syncthreads();
        float ba_[2], bx_[2], sp_[2];
#pragma unroll
        for (int nt = 0; nt < 2; ++nt) { const int ch = 64 * g + 32 * nt + (lane & 31); ba_[nt] = P.ba[ch]; bx_[nt] = P.bx[ch]; sp_[nt] = P.sp[ch]; }
        { v4u wt_[2], xr_[5];
#pragma unroll
          for (int i = 0; i < 2; ++i) { const int idx = tid + 512 * i; wt_[i] = ((const GAS v4u*)(P.wat + (size_t)g * 2 * 4096))[idx]; }
#pragma unroll
          for (int i = 0; i < 5; ++i) { const int idx = tid + 512 * i, row = idx >> 3, part = idx & 7; const bool ok = (idx < 259 * 8) && !(first && row < 3);
              const int trow = ok ? t0 - 3 + row : t0;
              xr_[i] = *(const GAS v4u*)(P.PROJB + (size_t)trow * INP + PC_XL + 64 * g + 8 * part); if (!ok) xr_[i] = v4u{0u, 0u, 0u, 0u}; }
          float cwv = 0.f; if (tid < 320) cwv = (tid < 256) ? P.cw[(tid >> 6) * 512 + 64 * g + (tid & 63)] : P.cb[64 * g + (tid - 256)];
#pragma unroll
          for (int i = 0; i < 2; ++i) { const int idx = tid + 512 * i; *(LAS v4u*)(lds + LR_WT + (idx >> 9) * 9216 + ((idx >> 3) & 63) * 144 + (idx & 7) * 16) = wt_[i]; }
#pragma unroll
          for (int i = 0; i < 5; ++i) { const int idx = tid + 512 * i, row = idx >> 3, part = idx & 7; if (idx < 259 * 8) *(LAS v4u*)(lds + LR_XR + row * 144 + 16 * part) = xr_[i]; }
          if (tid < 320) ((LAS float*)(lds + LR_CW))[tid] = cwv; }
        __syncthreads();
        { float cwr[4][8], cbr[8];
#pragma unroll
          for (int k = 0; k < 4; ++k) { const f32x4 c0 = *(const LAS f32x4*)(lds + LR_CW + (k * 64 + 8 * wave) * 4), c1 = *(const LAS f32x4*)(lds + LR_CW + (k * 64 + 8 * wave + 4) * 4);
              cwr[k][0] = c0.x; cwr[k][1] = c0.y; cwr[k][2] = c0.z; cwr[k][3] = c0.w; cwr[k][4] = c1.x; cwr[k][5] = c1.y; cwr[k][6] = c1.z; cwr[k][7] = c1.w; }
          { const f32x4 c0 = *(const LAS f32x4*)(lds + LR_CW + (256 + 8 * wave) * 4), c1 = *(const LAS f32x4*)(lds + LR_CW + (256 + 8 * wave + 4) * 4);
            cbr[0] = c0.x; cbr[1] = c0.y; cbr[2] = c0.z; cbr[3] = c0.w; cbr[4] = c1.x; cbr[5] = c1.y; cbr[6] = c1.z; cbr[7] = c1.w; }
#pragma unroll
          for (int it_ = 0; it_ < 4; ++it_) { const int time = lane + 64 * it_;
              float y[8];
#pragma unroll
              for (int e = 0; e < 8; ++e) y[e] = cbr[e];
#pragma unroll
              for (int k = 0; k < 4; ++k) { const v4u w = *(const LAS v4u*)(lds + LR_XR + (time + k) * 144 + 16 * wave);
                  y[0] += bflo(w.x) * cwr[k][0]; y[1] += bfhi(w.x) * cwr[k][1]; y[2] += bflo(w.y) * cwr[k][2]; y[3] += bfhi(w.y) * cwr[k][3];
                  y[4] += bflo(w.z) * cwr[k][4]; y[5] += bfhi(w.z) * cwr[k][5]; y[6] += bflo(w.w) * cwr[k][6]; y[7] += bfhi(w.w) * cwr[k][7]; }
              v4u o; o.x = pk2(y[0], y[1]); o.y = pk2(y[2], y[3]); o.z = pk2(y[4], y[5]); o.w = pk2(y[6], y[7]);
              *(LAS v4u*)(lds + LR_XA + time * 144 + 16 * wave) = o; } }
        __syncthreads();
        const int r32 = lane & 31, hi = lane >> 5;
        lr_f32x16 acc[2][2];
#pragma unroll
        for (int nt = 0; nt < 2; ++nt) { const float b_a = ba_[nt], b_x = bx_[nt];
#pragma unroll
            for (int r = 0; r < 16; ++r) { acc[0][nt][r] = b_a; acc[1][nt][r] = b_x; } }
        { lr_bf16x8 af[4];
#pragma unroll
          for (int s_ = 0; s_ < 4; ++s_) af[s_] = *(const LAS lr_bf16x8*)(lds + LR_XA + (32 * wave + r32) * 144 + (16 * s_ + 8 * hi) * 2);
#pragma unroll
          for (int gt = 0; gt < 2; ++gt)
#pragma unroll
              for (int nt = 0; nt < 2; ++nt)
#pragma unroll
                  for (int s_ = 0; s_ < 4; ++s_) { const lr_bf16x8 bfr = *(const LAS lr_bf16x8*)(lds + LR_WT + gt * 9216 + (32 * nt + r32) * 144 + (16 * s_ + 8 * hi) * 2);
                      acc[gt][nt] = __builtin_amdgcn_mfma_f32_32x32x16_bf16(af[s_], bfr, acc[gt][nt], 0, 0, 0); } }
#pragma unroll
        for (int nt = 0; nt < 2; ++nt) { const float sp = sp_[nt];
            float sa_[4], sh_[4];
#pragma unroll
            for (int q = 0; q < 4; ++q) { float hrun = 0.f, arun = 1.f;
#pragma unroll
                for (int e = 0; e < 4; ++e) { const int r = 4 * q + e, tl = 8 * q + 4 * hi + e;
                    const float xv = __builtin_bit_cast(float, (unsigned)*(const LAS unsigned short*)(lds + LR_XA + (32 * wave + tl) * 144 + (32 * nt + r32) * 2) << 16);
                    const float rg = __builtin_amdgcn_rcpf(1.f + __builtin_amdgcn_exp2f(-LOG2E * acc[0][nt][r])), ig = __builtin_amdgcn_rcpf(1.f + __builtin_amdgcn_exp2f(-LOG2E * acc[1][nt][r]));
                    const float la = -8.0f * rg * sp; const float a_ = __builtin_amdgcn_exp2f(LOG2E * la);
                    const float uu = __builtin_amdgcn_sqrtf(fmaxf(1.f - a_ * a_, 0.f)) * (ig * xv);
                    hrun = a_ * hrun + uu; arun *= a_; acc[0][nt][r] = arun; acc[1][nt][r] = hrun; }
                sa_[q] = arun; sh_[q] = hrun; }
            float runA = 1.f, runH = 0.f;
#pragma unroll
            for (int q = 0; q < 4; ++q) { float a0 = sa_[q], a1 = sa_[q], h0 = sh_[q], h1 = sh_[q]; lr_swap32(a0, a1); lr_swap32(h0, h1);
                const float midA = runA * a0, midH = a0 * runH + h0;
                const float inA = hi ? midA : runA, inH = hi ? midH : runH;
                runA = midA * a1; runH = a1 * midH + h1;
#pragma unroll
                for (int e = 0; e < 4; ++e) { const int r = 4 * q + e; acc[1][nt][r] += acc[0][nt][r] * inH; acc[0][nt][r] *= inA; } }
            if (hi == 0) { SUM[(wave * 64 + 32 * nt + r32) * 2] = runA; SUM[(wave * 64 + 32 * nt + r32) * 2 + 1] = runH; } }
        __syncthreads();
#pragma unroll
        for (int nt = 0; nt < 2; ++nt) { const int cl = 32 * nt + r32;
            float ca = 1.f, chh = 0.f;
            for (int w = 0; w < wave; ++w) { const float aw = SUM[(w * 64 + cl) * 2], hw = SUM[(w * 64 + cl) * 2 + 1]; chh = aw * chh + hw; ca *= aw; }
            GAS unsigned* ha = P.HA + (size_t)(t0 + 32 * wave + 4 * hi) * 512 + 64 * g + cl;
#pragma unroll
            for (int r = 0; r < 16; ++r) { const float hh = acc[1][nt][r] + acc[0][nt][r] * chh, ac_ = acc[0][nt][r] * ca; ha[(size_t)((r & 3) + 8 * (r >> 2)) * 512] = pk2(hh, ac_);
                if (r == 15 && wave == 7 && hi == 1) { P.LSUM[((size_t)tile * 512 + 64 * g + cl) * 2] = ac_; P.LSUM[((size_t)tile * 512 + 64 * g + cl) * 2 + 1] = hh; } } }
    }
}

struct PostP { const GAS bf16* OMB; const GAS unsigned* HA; const GAS float* LSUM; const GAS bf16* PROJB; const GAS float* gm; const GAS float* gl; GAS bf16* Y; };
__device__ __forceinline__ void post_phase(const PostP& P, LAS unsigned char* lds, int tid, int wave, int lane, int vcu, int G) {
    asm volatile("" : "+v"(tid), "+v"(lane));
    LAS float* hin = (LAS float*)lds;
    for (int u = vcu; u < T / 64; u += G) {
        const int t0 = u * 64, tile = t0 >> 8, tb = tile & ~31;
        __syncthreads();
        { float h = 0.f;
          for (int c0 = tb; c0 < tile; c0 += 8) {
              float av_[8], hv_[8];
#pragma unroll
              for (int i = 0; i < 8; ++i) { const int c = (c0 + i < tile) ? (c0 + i) : tb; av_[i] = P.LSUM[((size_t)c * 512 + tid) * 2]; hv_[i] = P.LSUM[((size_t)c * 512 + tid) * 2 + 1]; }
#pragma unroll
              for (int i = 0; i < 8; ++i) { if (c0 + i < tile) h = av_[i] * h + hv_[i]; } }
          hin[tid] = h; }
        __syncthreads();
        f32x4 hi0 = *(const LAS f32x4*)(hin + 8 * lane), hi1 = *(const LAS f32x4*)(hin + 8 * lane + 4);
        const f32x4 g0 = *(const GAS f32x4*)(P.gl + 8 * lane), g1 = *(const GAS f32x4*)(P.gl + 8 * lane + 4), gmv = *(const GAS f32x4*)(P.gm + 4 * lane);
#pragma unroll 2
        for (int i = 0; i < 8; ++i) {
            const size_t t = (size_t)t0 + 8 * wave + i;
            const v4u p0 = *(const GAS v4u*)(P.HA + t * 512 + 8 * lane), p1 = *(const GAS v4u*)(P.HA + t * 512 + 8 * lane + 4), gw_ = *(const GAS v4u*)(P.PROJB + t * INP + PC_GL + 8 * lane);
            const v2u mw = *(const GAS v2u*)(P.OMB + t * 256 + 4 * lane);
            float o[8];
            o[0] = (bflo(p0.x) + bfhi(p0.x) * hi0.x) * gelu_erf(bflo(gw_.x)); o[1] = (bflo(p0.y) + bfhi(p0.y) * hi0.y) * gelu_erf(bfhi(gw_.x));
            o[2] = (bflo(p0.z) + bfhi(p0.z) * hi0.z) * gelu_erf(bflo(gw_.y)); o[3] = (bflo(p0.w) + bfhi(p0.w) * hi0.w) * gelu_erf(bfhi(gw_.y));
            o[4] = (bflo(p1.x) + bfhi(p1.x) * hi1.x) * gelu_erf(bflo(gw_.z)); o[5] = (bflo(p1.y) + bfhi(p1.y) * hi1.y) * gelu_erf(bfhi(gw_.z));
            o[6] = (bflo(p1.z) + bfhi(p1.z) * hi1.z) * gelu_erf(bflo(gw_.w)); o[7] = (bflo(p1.w) + bfhi(p1.w) * hi1.w) * gelu_erf(bfhi(gw_.w));
            float s2 = 0.f;
#pragma unroll
            for (int e = 0; e < 8; ++e) s2 += o[e] * o[e];
            const float m0 = bflo(mw.x), m1 = bfhi(mw.x), m2 = bflo(mw.y), m3 = bfhi(mw.y);
            float s1 = (m0 * m0 + m1 * m1) + (m2 * m2 + m3 * m3);
            s1 = wave_sum(s1, lane); s2 = wave_sum(s2, lane);
            const float r1 = rsqrtf(s1 * (1.f / 256.f) + 1e-6f), r2 = rsqrtf(s2 * (1.f / 512.f) + 1e-6f);
            GAS bf16* yr = P.Y + t * 1024;
            { v2u w; w.x = pk2(m0 * r1 * gmv.x, m1 * r1 * gmv.y); w.y = pk2(m2 * r1 * gmv.z, m3 * r1 * gmv.w); *(GAS v2u*)(yr + 4 * lane) = w; }
            { v4u w; w.x = pk2(o[0] * r2 * g0.x, o[1] * r2 * g0.y); w.y = pk2(o[2] * r2 * g0.z, o[3] * r2 * g0.w); w.z = pk2(o[4] * r2 * g1.x, o[5] * r2 * g1.y); w.w = pk2(o[6] * r2 * g1.z, o[7] * r2 * g1.w);
              *(GAS v4u*)(yr + 256 + 8 * lane) = w; }
        }
    }
}

#define TILE_BAR() asm volatile("s_waitcnt lgkmcnt(0)\n\ts_barrier" ::: "memory")
typedef short bf16x8 __attribute__((ext_vector_type(8)));
typedef short s16x4 __attribute__((ext_vector_type(4)));
typedef float f32x16 __attribute__((ext_vector_type(16)));
typedef unsigned u32x4 __attribute__((ext_vector_type(4)));
__device__ __forceinline__ int crow(int r, int hi) { return (r & 3) + 8 * (r >> 2) + 4 * hi; }
typedef float f32x2_t __attribute__((ext_vector_type(2))); typedef __bf16 bf16x2_c __attribute__((ext_vector_type(2)));
__device__ __forceinline__ unsigned cvtpk(float lo, float hi) { f32x2_t v = {lo, hi}; bf16x2_c b = __builtin_convertvector(v, bf16x2_c); return __builtin_bit_cast(unsigned, b); }
__device__ __forceinline__ float swapmax(float m) { auto rr = __builtin_amdgcn_permlane32_swap(__float_as_uint(m), __float_as_uint(m), false, false); return fmaxf(__uint_as_float(rr[0]), __uint_as_float(rr[1])); }
__device__ __forceinline__ float swapadd(float m) { auto rr = __builtin_amdgcn_permlane32_swap(__float_as_uint(m), __float_as_uint(m), false, false); return __uint_as_float(rr[0]) + __uint_as_float(rr[1]); }
__device__ __forceinline__ s16x4 vtr(const LAS unsigned char* p) { return __builtin_bit_cast(s16x4, __builtin_amdgcn_ds_read_tr16_b64_v4i16((LAS s16x4*)p)); }
__device__ __forceinline__ bf16x8 pack8(const f32x16& p, int b) { u32x4 w; w.x = cvtpk(p[b], p[b + 1]); w.y = cvtpk(p[b + 2], p[b + 3]); w.z = cvtpk(p[b + 4], p[b + 5]); w.w = cvtpk(p[b + 6], p[b + 7]); return __builtin_bit_cast(bf16x8, w); }
__device__ __forceinline__ float vmax3(float a, float b, float c) { float r; asm("v_max3_f32 %0, %1, %2, %3" : "=v"(r) : "v"(a), "v"(b), "v"(c)); return r; }
__device__ __forceinline__ float max32(const f32x16& p, const f32x16& q) {
    float a = vmax3(p[0], p[1], p[2]), b = vmax3(p[3], p[4], p[5]), c = vmax3(p[6], p[7], p[8]), d = vmax3(p[9], p[10], p[11]), e = vmax3(p[12], p[13], p[14]);
    float f = vmax3(q[0], q[1], q[2]), g = vmax3(q[3], q[4], q[5]), h = vmax3(q[6], q[7], q[8]), i = vmax3(q[9], q[10], q[11]), j = vmax3(q[12], q[13], q[14]);
    a = vmax3(a, b, c); d = vmax3(d, e, p[15]); f = vmax3(f, g, h); i = vmax3(i, j, q[15]);
    return vmax3(vmax3(a, d, f), i, i);
}
__device__ __forceinline__ float max16(const f32x16& p) { float a = fmaxf(fmaxf(p[0], p[1]), fmaxf(p[2], p[3])), b = fmaxf(fmaxf(p[4], p[5]), fmaxf(p[6], p[7])), c = fmaxf(fmaxf(p[8], p[9]), fmaxf(p[10], p[11])), d = fmaxf(fmaxf(p[12], p[13]), fmaxf(p[14], p[15])); return fmaxf(fmaxf(a, b), fmaxf(c, d)); }

struct AttnP {
    const GAS bf16* Q; const GAS bf16* K; const GAS bf16* V; int qp, kp, vp;
    GAS bf16* O; int op;
    const GAS float* rope;
    const GAS int* pos; const GAS float* btab; const GAS float* dnorm; const GAS float* lams;
};
template <int KIND> struct AK {
    static constexpr bool DIFF = KIND == 1, CROSS = KIND == 2;
    static constexpr int HW = KIND == 0 ? 96 : KIND == 1 ? 64 : 256;
    static constexpr int NKS = KIND == 0 ? 6 : KIND == 1 ? 2 : 16;
    static constexpr int KP = KIND == 0 ? 208 : KIND == 1 ? 144 : 528;
    static constexpr int ND = CROSS ? 4 : 2;
    static constexpr int CPK = HW / 8, KCH = (64 * CPK + 511) / 512;
    static constexpr int VCH = ND / 2;
    static constexpr int KB = 64 * KP, VB = ND * 4096;
    static constexpr int NBUF = CROSS ? 2 : 3;
    static constexpr int K0 = 0, V0 = NBUF * KB, POS = V0 + NBUF * VB, BT = POS + 1024, DN = BT + 528, END = DN + 256;
};
static_assert(AK<2>::END <= RING_BYTES && AK<0>::END <= RING_BYTES && AK<1>::END + 16 + 8 * 8192 <= RING_BYTES, "attention LDS");

template <int KIND, bool LEAD>
__device__ __forceinline__ void attn_unit(const AttnP& P, int b, int h, int qb, int dhalf, LAS unsigned char* lds, int tid, int wave, int lane) {
    lane = lane_id_v(); tid = (wave << 6) | lane;
    typedef AK<KIND> C;
    constexpr bool DIFF = C::DIFF, CROSS = C::CROSS;
    constexpr int HW = C::HW, NKS = C::NKS, KP = C::KP, ND = C::ND, CPK = C::CPK, KCH = C::KCH, VCH = C::VCH;
    const int r32 = lane & 31, hi = lane >> 5;
    const size_t rowb = (size_t)b * S, rowk = CROSS ? (size_t)b * MEM : rowb;
    const int q0w = qb * 256 + wave * 32, qi = q0w + r32;
    int pq = 0; float bias_far = 0.f;
    __syncthreads();
    if (DIFF) {
        pq = P.pos[rowb + qi];
        if (tid < 129) ((LAS float*)(lds + C::BT))[tid] = P.btab[h * 129 + tid];
        if (tid >= 192 && tid < 256) ((LAS float*)(lds + C::DN))[tid - 192] = P.dnorm[tid - 192];
    }
    int minq = pq;
    if (DIFF) { for (int o = 1; o < 64; o <<= 1) { const int v = shxi(minq, o, lane); minq = v < minq ? v : minq; } }
    const int NT = CROSS ? MEM / 64 : 4 * (qb + 1);
    u32x4 kr[KCH], vr[VCH]; int pkr = 0;
    u32x4 kr2[CROSS ? 1 : KCH], vr2[CROSS ? 1 : VCH]; int pkr2 = 0;
    const GAS bf16* Kb = P.K + rowk * P.kp + h * HW; const GAS bf16* Vb = P.V + rowk * P.vp + (CROSS ? h * 256 + dhalf * 128 : h * 64);
    const __amdgpu_buffer_rsrc_t rK = __builtin_amdgcn_make_buffer_rsrc((void*)Kb, 0, 0x7fffffff, 0x00020000), rV = __builtin_amdgcn_make_buffer_rsrc((void*)Vb, 0, 0x7fffffff, 0x00020000);
    const __amdgpu_buffer_rsrc_t rP = __builtin_amdgcn_make_buffer_rsrc((void*)(DIFF ? P.pos + rowb : (const GAS int*)Kb), 0, 0x7fffffff, 0x00020000);
    int kvo[KCH], vvo[VCH];
#pragma unroll
    for (int i = 0; i < KCH; ++i) { int c = tid + 512 * i; c = c < 64 * CPK ? c : tid; kvo[i] = ((c / CPK) * P.kp + (c % CPK) * 8) * 2; }
#pragma unroll
    for (int i = 0; i < VCH; ++i) { const int c = tid + 512 * i; vvo[i] = ((c / (4 * ND)) * P.vp + (c % (4 * ND)) * 8) * 2; }
    const int pvo = (tid & 63) * 4;
    auto gload = [&](int t) {
        const int ks = __builtin_amdgcn_readfirstlane(64 * t * P.kp * 2), vs = __builtin_amdgcn_readfirstlane(64 * t * P.vp * 2);
#pragma unroll
        for (int i = 0; i < KCH; ++i) kr[i] = __builtin_amdgcn_raw_buffer_load_b128(rK, kvo[i], ks, 0);
#pragma unroll
        for (int i = 0; i < VCH; ++i) vr[i] = __builtin_amdgcn_raw_buffer_load_b128(rV, vvo[i], vs, 0);
        if (DIFF) pkr = __builtin_amdgcn_raw_buffer_load_b32(rP, pvo, __builtin_amdgcn_readfirstlane(64 * t * 4), 0);
    };
    auto lstore = [&](int buf) {
        LAS unsigned char* kb_ = lds + C::K0 + buf * C::KB; LAS unsigned char* vb_ = lds + C::V0 + buf * C::VB;
#pragma unroll
        for (int i = 0; i < KCH; ++i) { int c = tid + 512 * i; c = c < 64 * CPK ? c : tid; const int key = c / CPK, part = c % CPK; *(LAS u32x4*)(kb_ + key * KP + part * 16) = kr[i]; }
#pragma unroll
        for (int i = 0; i < VCH; ++i) { const int c = tid + 512 * i; const int key = c / (4 * ND), part = c % (4 * ND); *(LAS u32x4*)(vb_ + (part >> 2) * 4096 + (key >> 3) * 512 + (key & 7) * 64 + (part & 3) * 16) = vr[i]; }
        if (DIFF) { ((LAS int*)(lds + C::POS + buf * 256))[tid & 63] = pkr; if (tid < 64) { int mk_ = pkr; for (int o = 1; o < 64; o <<= 1) { const int v = shxi(mk_, o, lane); mk_ = v > mk_ ? v : mk_; } if (tid == 0) ((LAS int*)(lds + C::POS + 768))[buf] = mk_; } }
    };
    auto gloadB = [&](int t) {
        const int ks = __builtin_amdgcn_readfirstlane(64 * t * P.kp * 2), vs = __builtin_amdgcn_readfirstlane(64 * t * P.vp * 2);
#pragma unroll
        for (int i = 0; i < (CROSS ? 1 : KCH); ++i) kr2[i] = __builtin_amdgcn_raw_buffer_load_b128(rK, kvo[i], ks, 0);
#pragma unroll
        for (int i = 0; i < (CROSS ? 1 : VCH); ++i) vr2[i] = __builtin_amdgcn_raw_buffer_load_b128(rV, vvo[i], vs, 0);
        if (DIFF) pkr2 = __builtin_amdgcn_raw_buffer_load_b32(rP, pvo, __builtin_amdgcn_readfirstlane(64 * t * 4), 0);
    };
    auto lstoreB = [&](int buf) {
        LAS unsigned char* kb_ = lds + C::K0 + buf * C::KB; LAS unsigned char* vb_ = lds + C::V0 + buf * C::VB;
#pragma unroll
        for (int i = 0; i < (CROSS ? 1 : KCH); ++i) { int c = tid + 512 * i; c = c < 64 * CPK ? c : tid; const int key = c / CPK, part = c % CPK; *(LAS u32x4*)(kb_ + key * KP + part * 16) = kr2[i]; }
#pragma unroll
        for (int i = 0; i < (CROSS ? 1 : VCH); ++i) { const int c = tid + 512 * i; const int key = c / (4 * ND), part = c % (4 * ND); *(LAS u32x4*)(vb_ + (part >> 2) * 4096 + (key >> 3) * 512 + (key & 7) * 64 + (part & 3) * 16) = vr2[i]; }
        if (DIFF) { ((LAS int*)(lds + C::POS + buf * 256))[tid & 63] = pkr2; if (tid < 64) { int mk_ = pkr2; for (int o = 1; o < 64; o <<= 1) { const int v = shxi(mk_, o, lane); mk_ = v > mk_ ? v : mk_; } if (tid == 0) ((LAS int*)(lds + C::POS + 768))[buf] = mk_; } }
    };
    LAS float* osv = (LAS float*)(lds + ((C::END + 15) & ~15)) + wave * 2048 + lane;
    float il = 0.f;
    f32x16 oA[ND];
#pragma unroll 1
    for (int mp = 0; mp < (DIFF ? 2 : 1); ++mp) {
        bf16x8 qf[NKS];
        { const GAS bf16* qrow = P.Q + (rowb + qi) * P.qp + h * HW + mp * 32;
#pragma unroll
          for (int s = 0; s < NKS; ++s) qf[s] = *(const GAS bf16x8*)(qrow + 16 * s + 8 * hi);
          if (KIND == 0) {
              const GAS float* rp = P.rope + (rowb + qi) * 32 + 8 * hi;
              const f32x4 c0 = *(const GAS f32x4*)rp, c1 = *(const GAS f32x4*)(rp + 4), s0 = *(const GAS f32x4*)(rp + 16), s1 = *(const GAS f32x4*)(rp + 20);
              const u32x4 a = __builtin_bit_cast(u32x4, qf[NKS - 2]), bq = __builtin_bit_cast(u32x4, qf[NKS - 1]); u32x4 ra, rb;
#pragma unroll
              for (int w = 0; w < 4; ++w) { const float cl = w < 2 ? c0[2 * w] : c1[2 * w - 4], ch = w < 2 ? c0[2 * w + 1] : c1[2 * w - 3], sl = w < 2 ? s0[2 * w] : s1[2 * w - 4], sh = w < 2 ? s0[2 * w + 1] : s1[2 * w - 3];
                  const float x1l = bflo(a[w]), x1h = bfhi(a[w]), x2l = bflo(bq[w]), x2h = bfhi(bq[w]);
                  ra[w] = cvtpk(x1l * cl - x2l * sl, x1h * ch - x2h * sh); rb[w] = cvtpk(x1l * sl + x2l * cl, x1h * sh + x2h * ch); }
              qf[NKS - 2] = __builtin_bit_cast(bf16x8, ra); qf[NKS - 1] = __builtin_bit_cast(bf16x8, rb);
          } }
        __syncthreads();
        float m1 = -1e30f, l1 = 0.f;
#pragma unroll
        for (int d = 0; d < ND; ++d)
#pragma unroll
            for (int r = 0; r < 16; ++r) oA[d][r] = 0.f;
        auto qk = [&](int sl, f32x16& sa, f32x16& sb, float init) {
            const LAS unsigned char* kb_ = lds + C::K0 + sl * C::KB + r32 * KP + hi * 16 + mp * 64;
#pragma unroll
            for (int r = 0; r < 16; ++r) { sa[r] = init; sb[r] = init; }
            constexpr int HB = CROSS ? 4 : (NKS > 3 ? 3 : NKS);
#pragma unroll
            for (int s0_ = 0; s0_ < NKS; s0_ += HB) {
                bf16x8 kfa[HB], kfb[HB];
#pragma unroll
                for (int s = 0; s < HB; ++s) { kfa[s] = *(const LAS bf16x8*)(kb_ + (s0_ + s) * 32); kfb[s] = *(const LAS bf16x8*)(kb_ + 32 * KP + (s0_ + s) * 32); }
                __builtin_amdgcn_sched_barrier(0);
#pragma unroll
                for (int s = 0; s < HB; ++s) { sa = __builtin_amdgcn_mfma_f32_32x32x16_bf16(kfa[s], qf[s0_ + s], sa, 0, 0, 0); sb = __builtin_amdgcn_mfma_f32_32x32x16_bf16(kfb[s], qf[s0_ + s], sb, 0, 0, 0); }
                __builtin_amdgcn_sched_barrier(0);
            }
        };
        auto isnear = [&](int sl) { bool nb = false;
            if (DIFF) { const int mk_ = __builtin_amdgcn_readfirstlane(((LAS int*)(lds + C::POS + 768))[sl]); nb = (minq - mk_) < 128; }
            return nb; };
        auto sm = [&](int t, int sl, f32x16& pa, f32x16& pb, bool nearb) -> float {
            const int k0 = 64 * t;
            if (DIFF) { if (nearb) {
                const LAS int* pk = (const LAS int*)(lds + C::POS + sl * 256); const LAS float* bt = (const LAS float*)(lds + C::BT);
#pragma unroll
                for (int r = 0; r < 16; ++r) { const int kk = crow(r, hi);
                    int n0 = pq - pk[kk], n1 = pq - pk[kk + 32]; n0 = n0 < 0 ? 0 : (n0 > 128 ? 128 : n0); n1 = n1 < 0 ? 0 : (n1 > 128 ? 128 : n1);
                    pa[r] += bt[n0]; pb[r] += bt[n1]; }
            } }
            if (!CROSS && k0 + 63 > q0w) {
#pragma unroll
                for (int r = 0; r < 16; ++r) { const int kk = k0 + crow(r, hi); if (kk > qi) pa[r] = -1e30f; if (kk + 32 > qi) pb[r] = -1e30f; }
            }
            asm volatile("s_nop 15\n\ts_nop 7" : "+v"(pa), "+v"(pb));
            float mn, al = 1.f;
            if (CROSS) { const float mx = swapmax(max32(pa, pb)); mn = fmaxf(m1, mx); al = __builtin_amdgcn_exp2f(m1 - mn); l1 *= al; }
            else { const float mx = swapmax(max32(pa, pb)); const bool up = mx > m1 + 8.0f; mn = up ? mx : m1;
                   if (__builtin_amdgcn_ballot_w64(up) != 0ull) { al = __builtin_amdgcn_exp2f(m1 - mn); l1 *= al; } }
            m1 = mn;
            float ls = 0.f;
#pragma unroll
            for (int r = 0; r < 16; ++r) { pa[r] = __builtin_amdgcn_exp2f(pa[r] - mn); pb[r] = __builtin_amdgcn_exp2f(pb[r] - mn); ls += pa[r] + pb[r]; }
            l1 += ls;
            return al;
        };
        auto pv = [&](int sl, const f32x16& pa, const f32x16& pb, float al) {
            const LAS unsigned char* vb_ = lds + C::V0 + sl * C::VB + ((lane >> 4) & 1) * 32 + (lane & 3) * 8 + (4 * hi + ((lane & 15) >> 2)) * 64;
            bf16x8 pf[4];
            pf[0] = pack8(pa, 0); pf[1] = pack8(pa, 8); pf[2] = pack8(pb, 0); pf[3] = pack8(pb, 8);
            const bool resc = CROSS ? true : (__builtin_amdgcn_ballot_w64(al != 1.0f) != 0ull);
            if (CROSS) {
#pragma unroll
                for (int d = 0; d < ND; ++d) {
                    __builtin_amdgcn_sched_barrier(0);
#pragma unroll
                    for (int r = 0; r < 16; ++r) oA[d][r] *= al;
                    bf16x8 vf[4];
#pragma unroll
                    for (int s = 0; s < 4; ++s) { const s16x4 lo = vtr(vb_ + d * 4096 + s * 1024), hh = vtr(vb_ + d * 4096 + s * 1024 + 512); vf[s] = (bf16x8){lo[0], lo[1], lo[2], lo[3], hh[0], hh[1], hh[2], hh[3]}; }
#pragma unroll
                    for (int s = 0; s < 4; ++s) oA[d] = __builtin_amdgcn_mfma_f32_32x32x16_bf16(vf[s], pf[s], oA[d], 0, 0, 0);
                }
            } else if (DIFF) {
                if (resc) {
#pragma unroll
                    for (int d = 0; d < 2; ++d)
#pragma unroll
                        for (int r = 0; r < 16; ++r) oA[d][r] *= al;
                }
#pragma unroll
                for (int d = 0; d < 2; ++d) {
                    bf16x8 vf[4];
#pragma unroll
                    for (int s = 0; s < 4; ++s) { const s16x4 lo = vtr(vb_ + d * 4096 + s * 1024), hh = vtr(vb_ + d * 4096 + s * 1024 + 512); vf[s] = (bf16x8){lo[0], lo[1], lo[2], lo[3], hh[0], hh[1], hh[2], hh[3]}; }
                    __builtin_amdgcn_sched_barrier(0);
#pragma unroll
                    for (int s = 0; s < 4; ++s) oA[d] = __builtin_amdgcn_mfma_f32_32x32x16_bf16(vf[s], pf[s], oA[d], 0, 0, 0);
                }
            } else {
                bf16x8 vf[2][4];
#pragma unroll
                for (int d = 0; d < 2; ++d)
#pragma unroll
                    for (int s = 0; s < 4; ++s) { const s16x4 lo = vtr(vb_ + d * 4096 + s * 1024), hh = vtr(vb_ + d * 4096 + s * 1024 + 512); vf[d][s] = (bf16x8){lo[0], lo[1], lo[2], lo[3], hh[0], hh[1], hh[2], hh[3]}; }
                if (resc) {
#pragma unroll
                    for (int d = 0; d < 2; ++d)
#pragma unroll
                        for (int r = 0; r < 16; ++r) oA[d][r] *= al;
                }
                __builtin_amdgcn_sched_barrier(0);
#pragma unroll
                for (int s = 0; s < 4; ++s)
#pragma unroll
                    for (int d = 0; d < 2; ++d) oA[d] = __builtin_amdgcn_mfma_f32_32x32x16_bf16(vf[d][s], pf[s], oA[d], 0, 0, 0);
            }
        };
        if (CROSS) {
            gload(0); lstore(0);
            __syncthreads();
            for (int t = 0; t < NT; ++t) {
                const int buf = t & 1;
                f32x16 pa, pb;
                qk(buf, pa, pb, 0.f);
                const float al = sm(t, buf, pa, pb, false);
                pv(buf, pa, pb, al);
                if (t + 1 < NT) { gload(t + 1); lstore(buf ^ 1); }
                TILE_BAR();
            }
        } else {
            gload(0); lstore(0); gload(1); lstore(1);
            gload(2); gloadB(3);
            __syncthreads();
            if (DIFF) bias_far = ((LAS float*)(lds + C::BT))[128];
            const int NTW = (q0w + 31) / 64 + 1;
            constexpr bool lead = LEAD;
            f32x16 ca, cb, na, nb; bool cnear = isnear(0), nnear = false; float cal = 1.f;
            qk(0, ca, cb, (DIFF && !cnear) ? bias_far : 0.f);
            if (lead) cal = sm(0, 0, ca, cb, cnear);
            int s0 = 0, s1 = 1, s2 = 2;
            auto period = [&](int t, f32x16& xa, f32x16& xb, bool& xnear, f32x16& ya, f32x16& yb, bool& ynear) {
                const bool have_next = (t + 1 < NTW);
                if (lead) {
                    if (have_next) { ynear = isnear(s1); qk(s1, ya, yb, (DIFF && !ynear) ? bias_far : 0.f); }
                    if (t < NTW) pv(s0, xa, xb, cal);
                    if (have_next) cal = sm(t + 1, s1, ya, yb, ynear);
                } else {
                    if (t < NTW) cal = sm(t, s0, xa, xb, xnear);
                    if (have_next) { ynear = isnear(s1); qk(s1, ya, yb, (DIFF && !ynear) ? bias_far : 0.f); }
                    if (t < NTW) pv(s0, xa, xb, cal);
                }
                { const int tmp = s0; s0 = s1; s1 = s2; s2 = tmp; }
            };
            int t = 0;
            for (; t + 5 < NT; t += 2) {
                lstore(s2); gload(t + 4);
                period(t, ca, cb, cnear, na, nb, nnear);
                TILE_BAR();
                lstoreB(s2); gloadB(t + 5);
                period(t + 1, na, nb, nnear, ca, cb, cnear);
                TILE_BAR();
            }
            for (; t < NT; t += 2) {
                if (t + 2 < NT) { lstore(s2); if (t + 4 < NT) gload(t + 4); }
                period(t, ca, cb, cnear, na, nb, nnear);
                TILE_BAR();
                if (t + 3 < NT) { lstoreB(s2); if (t + 5 < NT) gloadB(t + 5); }
                period(t + 1, na, nb, nnear, ca, cb, cnear);
                TILE_BAR();
            }
        }
        il = 1.f / swapadd(l1);
        if (DIFF) { if (mp == 0) {
#pragma unroll
            for (int d = 0; d < 2; ++d)
#pragma unroll
                for (int r = 0; r < 16; ++r) osv[(d * 16 + r) * 64] = oA[d][r] * il; } }
    }
    GAS bf16* orow = P.O + (rowb + qi) * P.op + (CROSS ? h * 256 + dhalf * 128 : h * 64);
    if (!DIFF) {
#pragma unroll
        for (int d = 0; d < ND; ++d)
#pragma unroll
            for (int g = 0; g < 4; ++g) { v2u v; v.x = cvtpk(oA[d][4 * g] * il, oA[d][4 * g + 1] * il); v.y = cvtpk(oA[d][4 * g + 2] * il, oA[d][4 * g + 3] * il); *(GAS v2u*)(orow + 32 * d + 8 * g + 4 * hi) = v; }
    } else {
        const float lam = P.lams[0], lam_init = P.lams[1];
        const float i2 = lam * il;
        float ss = 0.f;
#pragma unroll
        for (int d = 0; d < 2; ++d)
#pragma unroll
            for (int r = 0; r < 16; ++r) { const float v = osv[(d * 16 + r) * 64] - oA[d][r] * i2; oA[d][r] = v; ss += v * v; }
        ss = swapadd(ss);
        const float rs = __builtin_amdgcn_rsqf(ss * (1.f / 64.f) + 1e-6f) * (1.f - lam_init);
        const LAS float* dn = (const LAS float*)(lds + C::DN);
#pragma unroll
        for (int d = 0; d < 2; ++d)
#pragma unroll
            for (int g = 0; g < 4; ++g) { const int c = 32 * d + 8 * g + 4 * hi; const f32x4 gn = *(const LAS f32x4*)(dn + c);
                v2u v; v.x = cvtpk(oA[d][4 * g] * rs * gn[0], oA[d][4 * g + 1] * rs * gn[1]); v.y = cvtpk(oA[d][4 * g + 2] * rs * gn[2], oA[d][4 * g + 3] * rs * gn[3]); *(GAS v2u*)(orow + c) = v; }
    }
}

__device__ __forceinline__ int wave_max_i(int v) {
    { const int o = __builtin_amdgcn_update_dpp(0, v, 0xB1, 0xF, 0xF, true); v = o > v ? o : v; }
    { const int o = __builtin_amdgcn_update_dpp(0, v, 0x4E, 0xF, 0xF, true); v = o > v ? o : v; }
    { const int o = __builtin_amdgcn_update_dpp(0, v, 0x141, 0xF, 0xF, true); v = o > v ? o : v; }
    { const int o = __builtin_amdgcn_update_dpp(0, v, 0x140, 0xF, 0xF, true); v = o > v ? o : v; }
    { int a = v, b = v; asm volatile("v_nop\n\tv_nop\n\tv_permlane16_swap_b32 %0, %1" : "+v"(a), "+v"(b)); v = a > b ? a : b; }
    { int a = v, b = v; asm volatile("v_nop\n\tv_nop\n\tv_permlane32_swap_b32 %0, %1" : "+v"(a), "+v"(b)); v = a > b ? a : b; }
    return v;
}
template <int KIND> struct AK2 {
    static constexpr bool DIFF = KIND == 1;
    static constexpr int HW = KIND == 0 ? 96 : 64, NKS = KIND == 0 ? 6 : 2, KP = KIND == 0 ? 208 : 144;
    static constexpr int CPK = HW / 8, KCH = (128 * CPK) / 512, VCH = 2;
    static constexpr int KB = 128 * KP, VB = 2 * 8192;
    static constexpr int K0 = 0, V0 = 2 * KB, POS = V0 + 2 * VB, PMX = POS + 1024, BT = PMX + 16, DN = BT + 528, OSV = (DN + 256 + 15) & ~15, END = OSV + (DIFF ? 8 * 8192 : 0);
};
static_assert(AK2<0>::END <= RING_BYTES && AK2<1>::END <= RING_BYTES, "attention LDS (128-key tiles)");
template <int KIND>
__device__ __forceinline__ void attn_unit2(const AttnP& P, int b, int h, int qb, LAS unsigned char* lds, int tid, int wave, int lane) {
    lane = lane_id_v(); tid = (wave << 6) | lane;
    typedef AK2<KIND> C;
    constexpr bool DIFF = C::DIFF;
    constexpr int HW = C::HW, NKS = C::NKS, KP = C::KP, CPK = C::CPK, KCH = C::KCH, VCH = C::VCH;
    const int r32 = lane & 31, hi = lane >> 5;
    const size_t rowb = (size_t)b * S;
    const int q0w = qb * 256 + wave * 32, qi = q0w + r32;
    int pq = 0; float bias_far = 0.f;
    __syncthreads();
    if (DIFF) {
        pq = P.pos[rowb + qi];
        if (tid < 129) ((LAS float*)(lds + C::BT))[tid] = P.btab[h * 129 + tid];
        if (tid >= 192 && tid < 256) ((LAS float*)(lds + C::DN))[tid - 192] = P.dnorm[tid - 192];
    }
    int minq = pq;
    if (DIFF) minq = __builtin_amdgcn_readfirstlane(-wave_max_i(-pq));
    const int NT = 2 * (qb + 1);
    const GAS bf16* Kb = P.K + rowb * P.kp + h * HW; const GAS bf16* Vb = P.V + rowb * P.vp + h * 64;
    const __amdgpu_buffer_rsrc_t rK = __builtin_amdgcn_make_buffer_rsrc((void*)Kb, 0, 0x7fffffff, 0x00020000), rV = __builtin_amdgcn_make_buffer_rsrc((void*)Vb, 0, 0x7fffffff, 0x00020000);
    const __amdgpu_buffer_rsrc_t rP = __builtin_amdgcn_make_buffer_rsrc((void*)(DIFF ? P.pos + rowb : (const GAS int*)Kb), 0, 0x7fffffff, 0x00020000);
    int kvo[KCH], vvo[VCH], klo[KCH], vlo[VCH];
#pragma unroll
    for (int i = 0; i < KCH; ++i) { const int c = tid + 512 * i; kvo[i] = ((c / CPK) * P.kp + (c % CPK) * 8) * 2; klo[i] = (c / CPK) * KP + (c % CPK) * 16; }
#pragma unroll
    for (int i = 0; i < VCH; ++i) { const int c = tid + 512 * i; const int key = c >> 3, part = c & 7; vvo[i] = (key * P.vp + part * 8) * 2; vlo[i] = (part >> 2) * 8192 + (key >> 3) * 512 + (key & 7) * 64 + (part & 3) * 16; }
    const int pvo = (tid & 127) * 4;
    u32x4 kr[KCH], vr[VCH]; int pkr = 0;
    auto gload = [&](int t) {
        const int ks = __builtin_amdgcn_readfirstlane(128 * t * P.kp * 2), vs = __builtin_amdgcn_readfirstlane(128 * t * P.vp * 2);
#pragma unroll
        for (int i = 0; i < KCH; ++i) kr[i] = __builtin_amdgcn_raw_buffer_load_b128(rK, kvo[i], ks, 0);
#pragma unroll
        for (int i = 0; i < VCH; ++i) vr[i] = __builtin_amdgcn_raw_buffer_load_b128(rV, vvo[i], vs, 0);
        if (DIFF) pkr = __builtin_amdgcn_raw_buffer_load_b32(rP, pvo, __builtin_amdgcn_readfirstlane(128 * t * 4), 0);
    };
    auto lstore = [&](int buf) {
        LAS unsigned char* kb_ = lds + C::K0 + buf * C::KB; LAS unsigned char* vb_ = lds + C::V0 + buf * C::VB;
#pragma unroll
        for (int i = 0; i < KCH; ++i) *(LAS u32x4*)(kb_ + klo[i]) = kr[i];
#pragma unroll
        for (int i = 0; i < VCH; ++i) *(LAS u32x4*)(vb_ + vlo[i]) = vr[i];
        if (DIFF) { ((LAS int*)(lds + C::POS + buf * 512))[tid & 127] = pkr;
            if (tid < 128) { const int mk_ = wave_max_i(pkr); if (lane == 0) ((LAS int*)(lds + C::PMX))[buf * 2 + wave] = mk_; } }
    };
    LAS float* osv = (LAS float*)(lds + C::OSV) + wave * 2048 + lane;
    float il = 0.f;
    f32x16 oA[2];
#pragma unroll 1
    for (int mp = 0; mp < (DIFF ? 2 : 1); ++mp) {
        bf16x8 qf[NKS];
        { const GAS bf16* qrow = P.Q + (rowb + qi) * P.qp + h * HW + mp * 32;
#pragma unroll
          for (int s = 0; s < NKS; ++s) qf[s] = *(const GAS bf16x8*)(qrow + 16 * s + 8 * hi);
          if (KIND == 0) {
              const GAS float* rp = P.rope + (rowb + qi) * 32 + 8 * hi;
              const f32x4 c0 = *(const GAS f32x4*)rp, c1 = *(const GAS f32x4*)(rp + 4), s0 = *(const GAS f32x4*)(rp + 16), s1 = *(const GAS f32x4*)(rp + 20);
              const u32x4 a = __builtin_bit_cast(u32x4, qf[NKS - 2]), bq = __builtin_bit_cast(u32x4, qf[NKS - 1]); u32x4 ra, rb;
#pragma unroll
              for (int w = 0; w < 4; ++w) { const float cl = w < 2 ? c0[2 * w] : c1[2 * w - 4], ch = w < 2 ? c0[2 * w + 1] : c1[2 * w - 3], sl = w < 2 ? s0[2 * w] : s1[2 * w - 4], sh = w < 2 ? s0[2 * w + 1] : s1[2 * w - 3];
                  const float x1l = bflo(a[w]), x1h = bfhi(a[w]), x2l = bflo(bq[w]), x2h = bfhi(bq[w]);
                  ra[w] = cvtpk(x1l * cl - x2l * sl, x1h * ch - x2h * sh); rb[w] = cvtpk(x1l * sl + x2l * cl, x1h * sh + x2h * ch); }
              qf[NKS - 2] = __builtin_bit_cast(bf16x8, ra); qf[NKS - 1] = __builtin_bit_cast(bf16x8, rb);
          } }
        __syncthreads();
        float m1 = 0.f, l1 = 0.f;
        f32x16 negm;
#pragma unroll
        for (int r = 0; r < 16; ++r) negm[r] = 0.f;
#pragma unroll
        for (int d = 0; d < 2; ++d)
#pragma unroll
            for (int r = 0; r < 16; ++r) oA[d][r] = 0.f;
        gload(0); lstore(0);
        if (NT > 1) gload(1);
        __syncthreads();
        if (DIFF) { bias_far = ((LAS float*)(lds + C::BT))[128];
#pragma unroll
            for (int r = 0; r < 16; ++r) negm[r] = bias_far; }
        const int NTW = (q0w + 31) / 128 + 1;
        auto compute = [&](int t, int buf) {
            const int k0 = 128 * t;
            const LAS unsigned char* kb_ = lds + C::K0 + buf * C::KB + r32 * KP + hi * 16 + mp * 64;
            const LAS unsigned char* vb_ = lds + C::V0 + buf * C::VB + ((lane >> 4) & 1) * 32 + (lane & 3) * 8 + (4 * hi + ((lane & 15) >> 2)) * 64;
            bool nearb = false;
            if (DIFF) { const LAS int* pm = (const LAS int*)(lds + C::PMX) + buf * 2; const int m0 = __builtin_amdgcn_readfirstlane(pm[0]), m1_ = __builtin_amdgcn_readfirstlane(pm[1]); nearb = (minq - (m0 > m1_ ? m0 : m1_)) < 128; }
            f32x16 sc[4];
            if (DIFF) { if (nearb) {
#pragma unroll
                for (int g = 0; g < 4; ++g)
#pragma unroll
                    for (int r = 0; r < 16; ++r) sc[g][r] = -m1; } }
            if (!DIFF) {
                bf16x8 kq[4 * NKS];
#pragma unroll
                for (int i = 0; i < 4 * NKS; ++i) kq[i] = *(const LAS bf16x8*)(kb_ + 32 * (i & 3) * KP + (i >> 2) * 32);
#pragma unroll
                for (int i = 0; i < 4 * NKS; ++i) sc[i & 3] = __builtin_amdgcn_mfma_f32_32x32x16_bf16(kq[i], qf[i >> 2], i < 4 ? negm : sc[i & 3], 0, 0, 0);
                __builtin_amdgcn_sched_group_barrier(0x100, 12, 0);
#pragma unroll
                for (int i = 0; i < 4 * NKS - 12; ++i) { __builtin_amdgcn_sched_group_barrier(0x008, 1, 0); __builtin_amdgcn_sched_group_barrier(0x100, 1, 0); }
                __builtin_amdgcn_sched_group_barrier(0x008, 12, 0);
                __builtin_amdgcn_sched_barrier(0);
            } else {
            constexpr int HB = NKS > 3 ? 3 : NKS;
#pragma unroll
            for (int s0_ = 0; s0_ < NKS; s0_ += HB) {
                bf16x8 kf[4][HB];
#pragma unroll
                for (int g = 0; g < 4; ++g)
#pragma unroll
                    for (int s = 0; s < HB; ++s) kf[g][s] = *(const LAS bf16x8*)(kb_ + 32 * g * KP + (s0_ + s) * 32);
                __builtin_amdgcn_sched_barrier(0);
#pragma unroll
                for (int s = 0; s < HB; ++s)
#pragma unroll
                    for (int g = 0; g < 4; ++g) {
                        if (s0_ + s == 0 && !(DIFF && nearb)) sc[g] = __builtin_amdgcn_mfma_f32_32x32x16_bf16(kf[g][s], qf[s0_ + s], negm, 0, 0, 0);
                        else sc[g] = __builtin_amdgcn_mfma_f32_32x32x16_bf16(kf[g][s], qf[s0_ + s], sc[g], 0, 0, 0); }
                __builtin_amdgcn_sched_barrier(0);
            }
            }
            if (DIFF) { if (nearb) {
                const LAS int* pk = (const LAS int*)(lds + C::POS + buf * 512); const LAS float* bt = (const LAS float*)(lds + C::BT);
#pragma unroll
                for (int g = 0; g < 4; ++g)
#pragma unroll
                    for (int r = 0; r < 16; ++r) { int n0 = pq - pk[32 * g + crow(r, hi)]; n0 = n0 < 0 ? 0 : (n0 > 128 ? 128 : n0); sc[g][r] += bt[n0]; }
            } }
            asm volatile("s_nop 15\n\ts_nop 7" : "+v"(sc[0]), "+v"(sc[1]), "+v"(sc[2]), "+v"(sc[3]));
            if (k0 + 127 > q0w) {
#pragma unroll
                for (int g = 0; g < 4; ++g)
#pragma unroll
                    for (int r = 0; r < 16; ++r) { if (k0 + 32 * g + crow(r, hi) > qi) sc[g][r] = -1e30f; }
            }
            const float mx = swapmax(vmax3(max32(sc[0], sc[1]), max32(sc[2], sc[3]), -1e30f));
            const bool up = (t == 0) || mx > 8.0f;
            float al = 1.f;
            if (__builtin_amdgcn_ballot_w64(up) != 0ull) {
                const float dl = up ? mx : 0.f; al = __builtin_amdgcn_exp2f(-dl); l1 *= al; m1 += dl;
#pragma unroll
                for (int r = 0; r < 16; ++r) negm[r] -= dl;
#pragma unroll
                for (int g = 0; g < 4; ++g)
#pragma unroll
                    for (int r = 0; r < 16; ++r) sc[g][r] -= dl;
            }
            float ls = 0.f;
#pragma unroll
            for (int g = 0; g < 4; ++g)
#pragma unroll
                for (int r = 0; r < 16; ++r) { sc[g][r] = __builtin_amdgcn_exp2f(sc[g][r]); ls += sc[g][r]; }
            l1 += ls;
            bf16x8 pf[8];
#pragma unroll
            for (int g = 0; g < 4; ++g) { pf[2 * g] = pack8(sc[g], 0); pf[2 * g + 1] = pack8(sc[g], 8); }
            if (__builtin_amdgcn_ballot_w64(al != 1.0f) != 0ull) {
#pragma unroll
                for (int d = 0; d < 2; ++d)
#pragma unroll
                    for (int r = 0; r < 16; ++r) oA[d][r] *= al;
            }
            if (!DIFF) {
                bf16x8 vq[16];
#pragma unroll
                for (int i = 0; i < 16; ++i) { const int d = i & 1, s = i >> 1; const s16x4 lo = vtr(vb_ + d * 8192 + s * 1024), hh = vtr(vb_ + d * 8192 + s * 1024 + 512); vq[i] = (bf16x8){lo[0], lo[1], lo[2], lo[3], hh[0], hh[1], hh[2], hh[3]}; }
#pragma unroll
                for (int i = 0; i < 16; ++i) oA[i & 1] = __builtin_amdgcn_mfma_f32_32x32x16_bf16(vq[i], pf[i >> 1], oA[i & 1], 0, 0, 0);
                __builtin_amdgcn_sched_group_barrier(0x100, 4, 0);
#pragma unroll
                for (int i = 0; i < 14; ++i) { __builtin_amdgcn_sched_group_barrier(0x008, 1, 0); __builtin_amdgcn_sched_group_barrier(0x100, 2, 0); }
                __builtin_amdgcn_sched_group_barrier(0x008, 2, 0);
                __builtin_amdgcn_sched_barrier(0);
            } else {
#pragma unroll
            for (int d = 0; d < 2; ++d) {
                bf16x8 vf[8];
#pragma unroll
                for (int s = 0; s < 8; ++s) { const s16x4 lo = vtr(vb_ + d * 8192 + s * 1024), hh = vtr(vb_ + d * 8192 + s * 1024 + 512); vf[s] = (bf16x8){lo[0], lo[1], lo[2], lo[3], hh[0], hh[1], hh[2], hh[3]}; }
                __builtin_amdgcn_sched_barrier(0);
#pragma unroll
                for (int s = 0; s < 8; ++s) oA[d] = __builtin_amdgcn_mfma_f32_32x32x16_bf16(vf[s], pf[s], oA[d], 0, 0, 0);
                __builtin_amdgcn_sched_barrier(0);
            }
            }
        };
        int t = 0;
        for (; t + 2 < NT; ++t) {
            const int buf = t & 1;
            if (t < NTW) compute(t, buf);
            lstore(buf ^ 1); gload(t + 2);
            TILE_BAR();
        }
        for (; t < NT; ++t) {
            const int buf = t & 1;
            if (t < NTW) compute(t, buf);
            if (t + 1 < NT) lstore(buf ^ 1);
            TILE_BAR();
        }
        il = 1.f / swapadd(l1);
        if (DIFF) { if (mp == 0) {
#pragma unroll
            for (int d = 0; d < 2; ++d)
#pragma unroll
                for (int r = 0; r < 16; ++r) osv[(d * 16 + r) * 64] = oA[d][r] * il; } }
    }
    GAS bf16* orow = P.O + (rowb + qi) * P.op + h * 64;
    if (!DIFF) {
#pragma unroll
        for (int d = 0; d < 2; ++d)
#pragma unroll
            for (int g = 0; g < 4; ++g) { v2u v; v.x = cvtpk(oA[d][4 * g] * il, oA[d][4 * g + 1] * il); v.y = cvtpk(oA[d][4 * g + 2] * il, oA[d][4 * g + 3] * il); *(GAS v2u*)(orow + 32 * d + 8 * g + 4 * hi) = v; }
    } else {
        const float lam = P.lams[0], lam_init = P.lams[1];
        const float i2 = lam * il;
        float ss = 0.f;
#pragma unroll
        for (int d = 0; d < 2; ++d)
#pragma unroll
            for (int r = 0; r < 16; ++r) { const float v = osv[(d * 16 + r) * 64] - oA[d][r] * i2; oA[d][r] = v; ss += v * v; }
        ss = swapadd(ss);
        const float rs = __builtin_amdgcn_rsqf(ss * (1.f / 64.f) + 1e-6f) * (1.f - lam_init);
        const LAS float* dn = (const LAS float*)(lds + C::DN);
#pragma unroll
        for (int d = 0; d < 2; ++d)
#pragma unroll
            for (int g = 0; g < 4; ++g) { const int c = 32 * d + 8 * g + 4 * hi; const f32x4 gn = *(const LAS f32x4*)(dn + c);
                v2u v; v.x = cvtpk(oA[d][4 * g] * rs * gn[0], oA[d][4 * g + 1] * rs * gn[1]); v.y = cvtpk(oA[d][4 * g + 2] * rs * gn[2], oA[d][4 * g + 3] * rs * gn[3]); *(GAS v2u*)(orow + c) = v; }
    }
}

struct AKD {
    static constexpr int KP = 144, KB = 64 * KP, VB = 2 * 4096;
    static constexpr int K0 = 0, V0 = 2 * KB, POS = V0 + 2 * VB, PMX = POS + 512, BT = PMX + 16, DN = BT + 528, END = DN + 256;
};
static_assert(AKD::END <= RING_BYTES, "attention LDS (merged differential maps)");
__device__ __forceinline__ void attn_diff_unit(const AttnP& P, int b, int h, int qb, LAS unsigned char* lds, int wave) {
    const int lane = lane_id_v(), tid = (wave << 6) | lane;
    typedef AKD C;
    constexpr int KP = C::KP;
    const int r32 = lane & 31, hi = lane >> 5;
    const size_t rowb = (size_t)b * S;
    const int q0w = qb * 256 + wave * 32, qi = q0w + r32;
    __syncthreads();
    const int pq = P.pos[rowb + qi];
    if (tid < 129) ((LAS float*)(lds + C::BT))[tid] = P.btab[h * 129 + tid];
    if (tid >= 192 && tid < 256) ((LAS float*)(lds + C::DN))[tid - 192] = P.dnorm[tid - 192];
    const int minq = __builtin_amdgcn_readfirstlane(-wave_max_i(-pq));
    const int NT = 4 * (qb + 1);
    const GAS bf16* Kb = P.K + rowb * P.kp + h * 64; const GAS bf16* Vb = P.V + rowb * P.vp + h * 64;
    const __amdgpu_buffer_rsrc_t rK = __builtin_amdgcn_make_buffer_rsrc((void*)Kb, 0, 0x7fffffff, 0x00020000), rV = __builtin_amdgcn_make_buffer_rsrc((void*)Vb, 0, 0x7fffffff, 0x00020000);
    const __amdgpu_buffer_rsrc_t rP = __builtin_amdgcn_make_buffer_rsrc((void*)(P.pos + rowb), 0, 0x7fffffff, 0x00020000);
    const int skey = tid >> 3, spart = tid & 7;
    const int kvo = (skey * P.kp + spart * 8) * 2, vvo = (skey * P.vp + spart * 8) * 2, klo = skey * KP + spart * 16, vlo = (spart >> 2) * 4096 + (skey >> 3) * 512 + (skey & 7) * 64 + (spart & 3) * 16;
    const int pvo = (tid & 63) * 4;
    u32x4 kr, vr; int pkr = 0;
    auto gload = [&](int t) {
        kr = __builtin_amdgcn_raw_buffer_load_b128(rK, kvo, __builtin_amdgcn_readfirstlane(64 * t * P.kp * 2), 0);
        vr = __builtin_amdgcn_raw_buffer_load_b128(rV, vvo, __builtin_amdgcn_readfirstlane(64 * t * P.vp * 2), 0);
        pkr = __builtin_amdgcn_raw_buffer_load_b32(rP, pvo, __builtin_amdgcn_readfirstlane(64 * t * 4), 0);
    };
    auto lstore = [&](int buf) {
        *(LAS u32x4*)(lds + C::K0 + buf * C::KB + klo) = kr; *(LAS u32x4*)(lds + C::V0 + buf * C::VB + vlo) = vr;
        if (tid < 64) { ((LAS int*)(lds + C::POS + buf * 256))[tid] = pkr; const int mk_ = wave_max_i(pkr); if (lane == 0) ((LAS int*)(lds + C::PMX))[buf] = mk_; }
    };
    gload(0);
    bf16x8 qf[2][2];
    { const GAS bf16* qrow = P.Q + (rowb + qi) * P.qp + h * 64;
#pragma unroll
      for (int mp = 0; mp < 2; ++mp)
#pragma unroll
          for (int s_ = 0; s_ < 2; ++s_) qf[mp][s_] = *(const GAS bf16x8*)(qrow + 32 * mp + 16 * s_ + 8 * hi); }
    __syncthreads();
    lstore(0);
    if (NT > 1) gload(1);
    __syncthreads();
    const float bias_far = ((LAS float*)(lds + C::BT))[128];
    float m_[2] = {0.f, 0.f}, l_[2] = {0.f, 0.f};
    f32x16 negm[2], oA[2][2];
#pragma unroll
    for (int mp = 0; mp < 2; ++mp) {
#pragma unroll
        for (int r = 0; r < 16; ++r) { negm[mp][r] = bias_far; oA[mp][0][r] = 0.f; oA[mp][1][r] = 0.f; } }
    const int NTW = (q0w + 31) / 64 + 1;
    auto compute = [&](int t, int buf) {
        const int k0 = 64 * t;
        const LAS unsigned char* kb_ = lds + C::K0 + buf * C::KB + r32 * KP + hi * 16;
        const LAS unsigned char* vb_ = lds + C::V0 + buf * C::VB + ((lane >> 4) & 1) * 32 + (lane & 3) * 8 + (4 * hi + ((lane & 15) >> 2)) * 64;
        const bool nearb = (minq - __builtin_amdgcn_readfirstlane(((const LAS int*)(lds + C::PMX))[buf])) < 128;
        const bool diag = k0 + 63 > q0w;
        bf16x8 pf[2][4];
#pragma unroll
        for (int mp = 0; mp < 2; ++mp) {
            f32x16 sc[2];
            bf16x8 kf[2][2];
#pragma unroll
            for (int g = 0; g < 2; ++g)
#pragma unroll
                for (int s_ = 0; s_ < 2; ++s_) kf[g][s_] = *(const LAS bf16x8*)(kb_ + 32 * g * KP + mp * 64 + s_ * 32);
            if (nearb) {
#pragma unroll
                for (int g = 0; g < 2; ++g) {
#pragma unroll
                    for (int r = 0; r < 16; ++r) sc[g][r] = -m_[mp];
#pragma unroll
                    for (int s_ = 0; s_ < 2; ++s_) sc[g] = __builtin_amdgcn_mfma_f32_32x32x16_bf16(kf[g][s_], qf[mp][s_], sc[g], 0, 0, 0); }
                const LAS int* pk = (const LAS int*)(lds + C::POS + buf * 256); const LAS float* bt = (const LAS float*)(lds + C::BT);
#pragma unroll
                for (int g = 0; g < 2; ++g)
#pragma unroll
                    for (int r = 0; r < 16; ++r) { int n0 = pq - pk[32 * g + crow(r, hi)]; n0 = n0 < 0 ? 0 : (n0 > 128 ? 128 : n0); sc[g][r] += bt[n0]; }
            } else {
#pragma unroll
                for (int g = 0; g < 2; ++g) { sc[g] = __builtin_amdgcn_mfma_f32_32x32x16_bf16(kf[g][0], qf[mp][0], negm[mp], 0, 0, 0); sc[g] = __builtin_amdgcn_mfma_f32_32x32x16_bf16(kf[g][1], qf[mp][1], sc[g], 0, 0, 0); }
            }
            asm volatile("s_nop 15\n\ts_nop 7" : "+v"(sc[0]), "+v"(sc[1]));
            if (diag) {
#pragma unroll
                for (int g = 0; g < 2; ++g)
#pragma unroll
                    for (int r = 0; r < 16; ++r) { if (k0 + 32 * g + crow(r, hi) > qi) sc[g][r] = -1e30f; }
            }
            const float mx = swapmax(vmax3(max32(sc[0], sc[1]), -1e30f, -1e30f));
            const bool up = (t == 0) || mx > 8.0f;
            if (__builtin_amdgcn_ballot_w64(up) != 0ull) {
                const float dl = up ? mx : 0.f; const float al = __builtin_amdgcn_exp2f(-dl); l_[mp] *= al; m_[mp] += dl;
#pragma unroll
                for (int r = 0; r < 16; ++r) negm[mp][r] -= dl;
#pragma unroll
                for (int g = 0; g < 2; ++g)
#pragma unroll
                    for (int r = 0; r < 16; ++r) sc[g][r] -= dl;
#pragma unroll
                for (int d = 0; d < 2; ++d)
#pragma unroll
                    for (int r = 0; r < 16; ++r) oA[mp][d][r] *= al;
            }
            float ls = 0.f;
#pragma unroll
            for (int g = 0; g < 2; ++g)
#pragma unroll
                for (int r = 0; r < 16; ++r) { sc[g][r] = __builtin_amdgcn_exp2f(sc[g][r]); ls += sc[g][r]; }
            l_[mp] += ls;
#pragma unroll
            for (int g = 0; g < 2; ++g) { pf[mp][2 * g] = pack8(sc[g], 0); pf[mp][2 * g + 1] = pack8(sc[g], 8); }
        }
        { bf16x8 vq[8];
#pragma unroll
          for (int i = 0; i < 8; ++i) { const int d = i & 1, s_ = i >> 1; const s16x4 lo = vtr(vb_ + d * 4096 + s_ * 1024), hh = vtr(vb_ + d * 4096 + s_ * 1024 + 512); vq[i] = (bf16x8){lo[0], lo[1], lo[2], lo[3], hh[0], hh[1], hh[2], hh[3]}; }
#pragma unroll
          for (int i = 0; i < 8; ++i) { const int d = i & 1, s_ = i >> 1; oA[0][d] = __builtin_amdgcn_mfma_f32_32x32x16_bf16(vq[i], pf[0][s_], oA[0][d], 0, 0, 0); oA[1][d] = __builtin_amdgcn_mfma_f32_32x32x16_bf16(vq[i], pf[1][s_], oA[1][d], 0, 0, 0); }
          __builtin_amdgcn_sched_group_barrier(0x100, 4, 0);
#pragma unroll
          for (int i = 0; i < 6; ++i) { __builtin_amdgcn_sched_group_barrier(0x008, 2, 0); __builtin_amdgcn_sched_group_barrier(0x100, 2, 0); }
          __builtin_amdgcn_sched_group_barrier(0x008, 4, 0);
          __builtin_amdgcn_sched_barrier(0); }
    };
#pragma unroll 1
    for (int t = 0; t < NT; ++t) {
        const int buf = t & 1;
        if (t < NTW) compute(t, buf);
        if (t + 1 < NT) lstore(buf ^ 1);
        if (t + 2 < NT) gload(t + 2);
        TILE_BAR();
    }
    const float il1 = 1.f / swapadd(l_[0]), il2 = 1.f / swapadd(l_[1]);
    const float lam = P.lams[0], lam_init = P.lams[1];
    const float i2 = lam * il2;
    float ss = 0.f;
#pragma unroll
    for (int d = 0; d < 2; ++d)
#pragma unroll
        for (int r = 0; r < 16; ++r) { const float v = oA[0][d][r] * il1 - oA[1][d][r] * i2; oA[0][d][r] = v; ss += v * v; }
    ss = swapadd(ss);
    const float rs = __builtin_amdgcn_rsqf(ss * (1.f / 64.f) + 1e-6f) * (1.f - lam_init);
    const LAS float* dn = (const LAS float*)(lds + C::DN);
    GAS bf16* orow = P.O + (rowb + qi) * P.op + h * 64;
#pragma unroll
    for (int d = 0; d < 2; ++d)
#pragma unroll
        for (int g = 0; g < 4; ++g) { const int c = 32 * d + 8 * g + 4 * hi; const f32x4 gn = *(const LAS f32x4*)(dn + c);
            v2u v; v.x = cvtpk(oA[0][d][4 * g] * rs * gn[0], oA[0][d][4 * g + 1] * rs * gn[1]); v.y = cvtpk(oA[0][d][4 * g + 2] * rs * gn[2], oA[0][d][4 * g + 3] * rs * gn[3]); *(GAS v2u*)(orow + c) = v; }
}

__device__ __forceinline__ void attn_phase(const AttnP& PM, const AttnP& PD, LAS unsigned char* lds, int tid, int wave, int lane, int vcu, int G, int only = -1) {
    for (int i = vcu; i < 512; i += G) {
        if (only >= 0 && (i >> 8) != only) continue;
        const int kind = i >> 8, c = i & 255, bh = c >> 4, s = c & 15;
        if (kind == 0) {
#pragma unroll 1
            for (int k = 0; k < 2; ++k) attn_unit2<0>(PM, bh >> 2, bh & 3, k ? 31 - s : s, lds, tid, wave, lane);
        } else {
#pragma unroll 1
            for (int k = 0; k < 2; ++k) attn_diff_unit(PD, bh >> 2, bh & 3, k ? 31 - s : s, lds, wave);
        }
    }
}
__device__ __forceinline__ float cx_max16(const f32x16& p) { return fmaxf(fmaxf(fmaxf(fmaxf(p[0], p[1]), fmaxf(p[2], p[3])), fmaxf(fmaxf(p[4], p[5]), fmaxf(p[6], p[7]))), fmaxf(fmaxf(fmaxf(p[8], p[9]), fmaxf(p[10], p[11])), fmaxf(fmaxf(p[12], p[13]), fmaxf(p[14], p[15])))); }
__device__ __forceinline__ void cross_unit2(const AttnP& P, int b, int h, int qb, LAS unsigned char* lds, int wave) {
    const int lane = lane_id_v(), tid = (wave << 6) | lane;
    constexpr int KP = 528;
    const int r32 = lane & 31, hi = lane >> 5;
    const size_t rowb = (size_t)b * S, rowk = (size_t)b * MEM;
    const int qi = qb * 256 + wave * 32 + r32;
    const GAS bf16* Kb = P.K + rowk * P.kp + h * 256; const GAS bf16* Vb = P.V + rowk * P.vp + h * 256;
    const __amdgpu_buffer_rsrc_t rK = __builtin_amdgcn_make_buffer_rsrc((void*)Kb, 0, 0x7fffffff, 0x00020000), rV = __builtin_amdgcn_make_buffer_rsrc((void*)Vb, 0, 0x7fffffff, 0x00020000);
    const GAS bf16* qrow = P.Q + (rowb + qi) * P.qp + h * 256 + 8 * hi;
    bf16x8 qf[4];
#pragma unroll
    for (int s = 0; s < 4; ++s) qf[s] = *(const GAS bf16x8*)(qrow + 16 * s);
    { u32x4 st[16];
#pragma unroll
      for (int i = 0; i < 16; ++i) { const int c = tid + 512 * i; st[i] = __builtin_amdgcn_raw_buffer_load_b128(rK, ((c >> 5) * P.kp + (c & 31) * 8) * 2, 0, 0); }
      TILE_BAR();
#pragma unroll
      for (int i = 0; i < 16; ++i) { const int c = tid + 512 * i; *(LAS u32x4*)(lds + (c >> 5) * KP + (c & 31) * 16) = st[i]; } }
    __syncthreads();
    f32x16 sc[8];
#pragma unroll
    for (int g = 0; g < 8; ++g)
#pragma unroll
        for (int r = 0; r < 16; ++r) sc[g][r] = 0.f;
    const LAS unsigned char* kb_ = lds + r32 * KP + hi * 16;
#pragma unroll
    for (int c = 0; c < 4; ++c) {
        bf16x8 qn[4];
        if (c + 1 < 4) {
#pragma unroll
            for (int s = 0; s < 4; ++s) qn[s] = *(const GAS bf16x8*)(qrow + 64 * (c + 1) + 16 * s); }
        { bf16x8 kq[32];
#pragma unroll
          for (int i = 0; i < 32; ++i) kq[i] = *(const LAS bf16x8*)(kb_ + 32 * (i & 7) * KP + (4 * c + (i >> 3)) * 32);
#pragma unroll
          for (int i = 0; i < 32; ++i) sc[i & 7] = __builtin_amdgcn_mfma_f32_32x32x16_bf16(kq[i], qf[i >> 3], sc[i & 7], 0, 0, 0);
          __builtin_amdgcn_sched_group_barrier(0x100, 4, 0);
#pragma unroll
          for (int i = 0; i < 28; ++i) { __builtin_amdgcn_sched_group_barrier(0x008, 1, 0); __builtin_amdgcn_sched_group_barrier(0x100, 1, 0); }
          __builtin_amdgcn_sched_group_barrier(0x008, 4, 0);
          __builtin_amdgcn_sched_barrier(0); }
        if (c + 1 < 4) {
#pragma unroll
            for (int s = 0; s < 4; ++s) qf[s] = qn[s]; }
    }
    float m = fmaxf(fmaxf(fmaxf(cx_max16(sc[0]), cx_max16(sc[1])), fmaxf(cx_max16(sc[2]), cx_max16(sc[3]))), fmaxf(fmaxf(cx_max16(sc[4]), cx_max16(sc[5])), fmaxf(cx_max16(sc[6]), cx_max16(sc[7]))));
    m = swapmax(m);
    float l = 0.f;
    bf16x8 pf[16];
#pragma unroll
    for (int g = 0; g < 8; ++g) {
#pragma unroll
        for (int r = 0; r < 16; ++r) { sc[g][r] = __builtin_amdgcn_exp2f(sc[g][r] - m); l += sc[g][r]; }
        pf[2 * g] = pack8(sc[g], 0); pf[2 * g + 1] = pack8(sc[g], 8); }
    const float il = 1.f / swapadd(l);
    { u32x4 st[16];
#pragma unroll
      for (int i = 0; i < 16; ++i) { const int c = tid + 512 * i; const int sub = c & 3, key = (c >> 2) & 255, dt = c >> 10; st[i] = __builtin_amdgcn_raw_buffer_load_b128(rV, (key * P.vp + dt * 32 + sub * 8) * 2, 0, 0); }
      TILE_BAR();
#pragma unroll
      for (int i = 0; i < 16; ++i) { const int c = tid + 512 * i; const int sub = c & 3, key = (c >> 2) & 255, dt = c >> 10; *(LAS u32x4*)(lds + dt * 16384 + (key >> 3) * 512 + (key & 7) * 64 + sub * 16) = st[i]; } }
    __syncthreads();
    const LAS unsigned char* vb_ = lds + ((lane >> 4) & 1) * 32 + (lane & 3) * 8 + (4 * hi + ((lane & 15) >> 2)) * 64;
    GAS bf16* orow = P.O + (rowb + qi) * P.op + h * 256;
#pragma unroll 1
    for (int dh = 0; dh < 2; ++dh) {
        f32x16 oA[4];
#pragma unroll
        for (int d = 0; d < 4; ++d)
#pragma unroll
            for (int r = 0; r < 16; ++r) oA[d][r] = 0.f;
#pragma unroll
        for (int d = 0; d < 4; ++d) {
            { bf16x8 vq[16];
#pragma unroll
              for (int s = 0; s < 16; ++s) { const s16x4 lo = vtr(vb_ + (4 * dh + d) * 16384 + s * 1024), hh = vtr(vb_ + (4 * dh + d) * 16384 + s * 1024 + 512); vq[s] = (bf16x8){lo[0], lo[1], lo[2], lo[3], hh[0], hh[1], hh[2], hh[3]}; }
#pragma unroll
              for (int s = 0; s < 16; ++s) oA[d] = __builtin_amdgcn_mfma_f32_32x32x16_bf16(vq[s], pf[s], oA[d], 0, 0, 0);
              __builtin_amdgcn_sched_group_barrier(0x100, 4, 0);
#pragma unroll
              for (int i = 0; i < 14; ++i) { __builtin_amdgcn_sched_group_barrier(0x008, 1, 0); __builtin_amdgcn_sched_group_barrier(0x100, 2, 0); }
              __builtin_amdgcn_sched_group_barrier(0x008, 2, 0);
              __builtin_amdgcn_sched_barrier(0); } }
#pragma unroll
        for (int d = 0; d < 4; ++d)
#pragma unroll
            for (int g = 0; g < 4; ++g) { v2u v; v.x = cvtpk(oA[d][4 * g] * il, oA[d][4 * g + 1] * il); v.y = cvtpk(oA[d][4 * g + 2] * il, oA[d][4 * g + 3] * il); *(GAS v2u*)(orow + 128 * dh + 32 * d + 8 * g + 4 * hi) = v; }
    }
}
__device__ __forceinline__ void cross_phase(const AttnP& PC, LAS unsigned char* lds, int tid, int wave, int lane, int vcu, int G) {
#pragma unroll 1
    for (int i = vcu; i < 512; i += G) { const int bh = i >> 5; cross_unit2(PC, bh >> 2, bh & 3, i & 31, lds, wave); }
}


__device__ __forceinline__ float vmax2(float a, float b) { float r; asm("v_max_f32_e32 %0, %1, %2" : "=v"(r) : "v"(a), "v"(b)); return r; }
__device__ __forceinline__ float vmin2(float a, float b) { float r; asm("v_min_f32_e32 %0, %1, %2" : "=v"(r) : "v"(a), "v"(b)); return r; }
__device__ __forceinline__ void pad16(float (&a)[16]) {
    asm volatile("s_nop 1" : "+v"(a[0]), "+v"(a[1]), "+v"(a[2]), "+v"(a[3]), "+v"(a[4]), "+v"(a[5]), "+v"(a[6]), "+v"(a[7]), "+v"(a[8]), "+v"(a[9]), "+v"(a[10]), "+v"(a[11]), "+v"(a[12]), "+v"(a[13]), "+v"(a[14]), "+v"(a[15]));
}
__device__ __forceinline__ void sort16_desc(float (&a)[16]) {
#pragma unroll
    for (int k = 2; k <= 16; k <<= 1)
#pragma unroll
        for (int j = k >> 1; j > 0; j >>= 1)
#pragma unroll
            for (int i = 0; i < 16; ++i) { const int l = i ^ j; if (l > i) { const bool desc = ((i & k) == 0); const float hi_ = vmax2(a[i], a[l]), lo_ = vmin2(a[i], a[l]); a[i] = desc ? hi_ : lo_; a[l] = desc ? lo_ : hi_; } }
}
__device__ __forceinline__ void merge16_desc(float (&a)[16], const float (&b)[16]) {
#pragma unroll
    for (int i = 0; i < 16; ++i) a[i] = vmax2(a[i], b[15 - i]);
#pragma unroll
    for (int j = 8; j > 0; j >>= 1)
#pragma unroll
        for (int i = 0; i < 16; ++i) { const int l = i ^ j; if (l > i) { const float hi_ = vmax2(a[i], a[l]), lo_ = vmin2(a[i], a[l]); a[i] = hi_; a[l] = lo_; } }
}
__device__ __forceinline__ void top16_of_64(float (&g0)[16], float (&g1)[16], float (&g2)[16], float (&g3)[16]) {
    sort16_desc(g0); sort16_desc(g1); merge16_desc(g0, g1); sort16_desc(g2); sort16_desc(g3); merge16_desc(g2, g3); merge16_desc(g0, g2);
}
__device__ __forceinline__ float embed(float v, unsigned mask, unsigned id) { return __builtin_bit_cast(float, (__builtin_bit_cast(unsigned, v) & mask) | id); }
__device__ __forceinline__ float mkcand(float x, float y, unsigned id) { return embed(x + y, 0xFFFFFF00u, id); }

__device__ __forceinline__ void swap32(float& a, float& b) { asm volatile("v_nop\n\tv_nop\n\tv_permlane32_swap_b32 %0, %1" : "+v"(a), "+v"(b)); }
struct RouteP { const GAS bf16* QP; const GAS bf16* keys; GAS int* EX; GAS float* GW; };
constexpr int RT_KP = 144, RT_KEYS = 0, RT_SCR = 256 * RT_KP, RT_END = RT_SCR + 8 * 8192;
__device__ __forceinline__ void route_phase(const RouteP& P, LAS unsigned char* lds, int tid, int wave, int lane, int vcu, int G) {
    asm volatile("" : "+v"(tid), "+v"(lane));
    __syncthreads();
    for (int c = tid; c < 256 * 8; c += 512) { const int row = c >> 3, part = c & 7; *(LAS u32x4*)(lds + RT_KEYS + row * RT_KP + part * 16) = *(const u32x4*)(P.keys + row * 64 + part * 8); }
    __syncthreads();
    const int r32 = lane & 31, hi = lane >> 5;
    LAS int* scr = (LAS int*)(lds + RT_SCR + wave * 8192);
    for (int u = vcu; u < T / 32; u += G) {
        const size_t t = (size_t)u * 32 + r32; const int h = wave;
        float T2[2][16];
#pragma unroll
        for (int c = 0; c < 2; ++c) {
            bf16x8 qf[4];
            { const GAS bf16* q = P.QP + t * 1024 + h * 128 + c * 64 + 8 * hi;
#pragma unroll
              for (int s = 0; s < 4; ++s) qf[s] = *(const GAS bf16x8*)(q + 16 * s); }
            f32x16 sc[4];
#pragma unroll
            for (int m = 0; m < 4; ++m) {
#pragma unroll
                for (int r = 0; r < 16; ++r) sc[m][r] = 0.f;
#pragma unroll
                for (int s = 0; s < 4; ++s) { const bf16x8 a = *(const LAS bf16x8*)(lds + RT_KEYS + (c * 128 + 32 * m + r32) * RT_KP + s * 32 + hi * 16);
                    sc[m] = __builtin_amdgcn_mfma_f32_32x32x16_bf16(a, qf[s], sc[m], 0, 0, 0); }
            }
            float g0[16], g1[16], g2[16], g3[16];
            const unsigned h4 = 4u * (unsigned)hi;
#pragma unroll
            for (int r = 0; r < 16; ++r) { const unsigned kr_ = (unsigned)((r & 3) + 8 * (r >> 2));
                g0[r] = embed(sc[0][r], 0xFFFFFF80u, kr_ | h4); g1[r] = embed(sc[1][r], 0xFFFFFF80u, (32u + kr_) | h4); g2[r] = embed(sc[2][r], 0xFFFFFF80u, (64u + kr_) | h4); g3[r] = embed(sc[3][r], 0xFFFFFF80u, (96u + kr_) | h4); }
            top16_of_64(g0, g1, g2, g3);
            pad16(g0);
#pragma unroll
            for (int i = 0; i < 16; ++i) T2[c][i] = g0[i];
        }
        float A[16], Bv[16];
#pragma unroll
        for (int i = 0; i < 16; ++i) { A[i] = T2[0][i]; Bv[i] = T2[1][i]; swap32(A[i], Bv[i]); }
        merge16_desc(A, Bv);
        pad16(A);
        float T0[16], T1[16];
#pragma unroll
        for (int i = 0; i < 16; ++i) { T0[i] = A[i]; T1[i] = A[i]; swap32(T0[i], T1[i]); }
#pragma unroll
        for (int i = 0; i < 16; ++i) { scr[i * 64 + lane] = (int)(__builtin_bit_cast(unsigned, T0[i]) & 127u); scr[(16 + i) * 64 + lane] = (int)(__builtin_bit_cast(unsigned, T1[i]) & 127u);
            T0[i] = embed(T0[i], 0xFFFFFF80u, 0u); T1[i] = embed(T1[i], 0xFFFFFF80u, 0u); }
        float c0[16], c1[16], c2[16], c3[16];
        const float NINF = -__builtin_inff();
#pragma unroll
        for (int b = 0; b < 16; ++b) c0[b] = mkcand(T0[0], T1[b], (unsigned)b);
#pragma unroll
        for (int b = 0; b < 8; ++b) c1[b] = mkcand(T0[1], T1[b], 16u + b);
#pragma unroll
        for (int b = 0; b < 5; ++b) c1[8 + b] = mkcand(T0[2], T1[b], 32u + b);
#pragma unroll
        for (int b = 0; b < 3; ++b) c1[13 + b] = mkcand(T0[4], T1[b], 64u + b);
#pragma unroll
        for (int b = 0; b < 4; ++b) c2[b] = mkcand(T0[3], T1[b], 48u + b);
        c2[4] = mkcand(T0[5], T1[0], 80u); c2[5] = mkcand(T0[5], T1[1], 81u); c2[6] = mkcand(T0[6], T1[0], 96u); c2[7] = mkcand(T0[6], T1[1], 97u); c2[8] = mkcand(T0[7], T1[0], 112u); c2[9] = mkcand(T0[7], T1[1], 113u);
#pragma unroll
        for (int a = 8; a < 14; ++a) c2[10 + a - 8] = mkcand(T0[a], T1[0], 16u * a);
        c3[0] = mkcand(T0[14], T1[0], 224u); c3[1] = mkcand(T0[15], T1[0], 240u);
#pragma unroll
        for (int i = 2; i < 16; ++i) c3[i] = NINF;
        top16_of_64(c0, c1, c2, c3);
        pad16(c0);
        float gsum = 0.f, ge[16]; int ex[16];
        const float mtop = embed(c0[0], 0xFFFFFF00u, 0u);
#pragma unroll
        for (int i = 0; i < 16; ++i) { const unsigned bits = __builtin_bit_cast(unsigned, c0[i]); const int a = (bits >> 4) & 15, b = bits & 15;
            ge[i] = __builtin_amdgcn_exp2f((embed(c0[i], 0xFFFFFF00u, 0u) - mtop) * LOG2E); gsum += ge[i];
            ex[i] = scr[a * 64 + lane] * 128 + scr[(16 + b) * 64 + lane]; }
        const float ginv = __builtin_amdgcn_rcpf(gsum);
        if (hi == 0) { GAS unsigned short* d = (GAS unsigned short*)P.EX + t * 128 + h * 16;
#pragma unroll
            for (int i = 0; i < 16; ++i) d[i] = (unsigned short)ex[i]; }
        else { GAS f32x4* d = (GAS f32x4*)(P.GW + t * 128 + h * 16);
#pragma unroll
            for (int i = 0; i < 4; ++i) d[i] = (f32x4){ge[4 * i] * ginv, ge[4 * i + 1] * ginv, ge[4 * i + 2] * ginv, ge[4 * i + 3] * ginv}; }
    }
}

__device__ __forceinline__ int wave_allsum_i(int v) {
    v += __builtin_amdgcn_update_dpp(0, v, 0xB1, 0xF, 0xF, true);
    v += __builtin_amdgcn_update_dpp(0, v, 0x4E, 0xF, 0xF, true);
    v += __builtin_amdgcn_update_dpp(0, v, 0x141, 0xF, 0xF, true);
    v += __builtin_amdgcn_update_dpp(0, v, 0x140, 0xF, 0xF, true);
    { int a = v, b = v; asm volatile("v_nop\n\tv_nop\n\tv_permlane16_swap_b32 %0, %1" : "+v"(a), "+v"(b)); v = a + b; }
    { int a = v, b = v; asm volatile("v_nop\n\tv_nop\n\tv_permlane32_swap_b32 %0, %1" : "+v"(a), "+v"(b)); v = a + b; }
    return v;
}
__device__ __forceinline__ float wave_allsum(float v) {
    v += __builtin_bit_cast(float, __builtin_amdgcn_update_dpp(0, __builtin_bit_cast(int, v), 0xB1, 0xF, 0xF, true));
    v += __builtin_bit_cast(float, __builtin_amdgcn_update_dpp(0, __builtin_bit_cast(int, v), 0x4E, 0xF, 0xF, true));
    v += __builtin_bit_cast(float, __builtin_amdgcn_update_dpp(0, __builtin_bit_cast(int, v), 0x141, 0xF, 0xF, true));
    v += __builtin_bit_cast(float, __builtin_amdgcn_update_dpp(0, __builtin_bit_cast(int, v), 0x140, 0xF, 0xF, true));
    { float a = v, b = v; asm volatile("v_nop\n\tv_nop\n\tv_permlane16_swap_b32 %0, %1" : "+v"(a), "+v"(b)); v = a + b; }
    { float a = v, b = v; asm volatile("v_nop\n\tv_nop\n\tv_permlane32_swap_b32 %0, %1" : "+v"(a), "+v"(b)); v = a + b; }
    return v;
}
__device__ __forceinline__ float wave_allmax(float v) {
    v = fmaxf(v, __builtin_bit_cast(float, __builtin_amdgcn_update_dpp(0, __builtin_bit_cast(int, v), 0xB1, 0xF, 0xF, true)));
    v = fmaxf(v, __builtin_bit_cast(float, __builtin_amdgcn_update_dpp(0, __builtin_bit_cast(int, v), 0x4E, 0xF, 0xF, true)));
    v = fmaxf(v, __builtin_bit_cast(float, __builtin_amdgcn_update_dpp(0, __builtin_bit_cast(int, v), 0x141, 0xF, 0xF, true)));
    v = fmaxf(v, __builtin_bit_cast(float, __builtin_amdgcn_update_dpp(0, __builtin_bit_cast(int, v), 0x140, 0xF, 0xF, true)));
    { float a = v, b = v; asm volatile("v_nop\n\tv_nop\n\tv_permlane16_swap_b32 %0, %1" : "+v"(a), "+v"(b)); v = fmaxf(a, b); }
    { float a = v, b = v; asm volatile("v_nop\n\tv_nop\n\tv_permlane32_swap_b32 %0, %1" : "+v"(a), "+v"(b)); v = fmaxf(a, b); }
    return v;
}
__device__ __forceinline__ unsigned q4(float a, float b, float c, float d, int off) {
    const int ia = (int)__builtin_rintf(a) + off, ib = (int)__builtin_rintf(b) + off, ic = (int)__builtin_rintf(c) + off, id = (int)__builtin_rintf(d) + off;
    return (unsigned)(ia & 255) | ((unsigned)(ib & 255) << 8) | ((unsigned)(ic & 255) << 16) | ((unsigned)(id & 255) << 24);
}
__device__ __forceinline__ void quant_row(const GAS float* src, GAS unsigned* dst, GAS float* scale, int off, int lane) {
    const GAS f32x4* s = (const GAS f32x4*)src + 4 * lane; f32x4 v[4]; float m = 0.f;
#pragma unroll
    for (int i = 0; i < 4; ++i) { v[i] = s[i]; m = fmaxf(m, fmaxf(fmaxf(__builtin_fabsf(v[i].x), __builtin_fabsf(v[i].y)), fmaxf(__builtin_fabsf(v[i].z), __builtin_fabsf(v[i].w)))); }
    m = wave_allmax(m); const float inv = m > 0.f ? 127.f / m : 0.f;
    v4u w;
    w.x = q4(v[0].x * inv, v[0].y * inv, v[0].z * inv, v[0].w * inv, off); w.y = q4(v[1].x * inv, v[1].y * inv, v[1].z * inv, v[1].w * inv, off);
    w.z = q4(v[2].x * inv, v[2].y * inv, v[2].z * inv, v[2].w * inv, off); w.w = q4(v[3].x * inv, v[3].y * inv, v[3].z * inv, v[3].w * inv, off);
    *((GAS v4u*)dst + lane) = w;
    if (lane == 0) *scale = m * (1.f / 127.f);
}
struct PeerS { int nslices_step, first_slice, nloc, rank; };
__device__ __forceinline__ PeerS peer_sched(const GAS unsigned* rankw, int xcc, int rank) {
    const int lane = lane_id_v();
    const int c = lane < 16 ? (int)__hip_atomic_load(rankw + 64 * lane, __ATOMIC_RELAXED, __HIP_MEMORY_SCOPE_AGENT) : 0;
    const unsigned long long m = __builtin_amdgcn_ballot_w64(c > 0);
    const int nx = __builtin_popcountll(m), myidx = __builtin_popcountll(m & ((1ull << xcc) - 1ull));
    const int cm = __builtin_amdgcn_readlane(c, xcc);
    PeerS s; s.nslices_step = nx > 0 ? nx : 1; s.first_slice = myidx; s.nloc = cm > 0 ? cm : 1; s.rank = rank; return s;
}
struct Peer1P { const GAS unsigned GAS char* HQ; const GAS int* EX; const GAS unsigned GAS char* U8; GAS int* P; };
__device__ __forceinline__ void peer_k1(const Peer1P& Q, const PeerS& sc, int wave, int lane) {
    asm volatile("" : "+v"(lane));
    const int g = lane >> 3, j = lane & 7;
    const __amdgpu_buffer_rsrc_t rU = __builtin_amdgcn_make_buffer_rsrc((void*)Q.U8, 0, 0x7fffffff, 0x00020000);
    for (int s = sc.first_slice; s < 8; s += sc.nslices_step)
        for (int tile = sc.rank; tile < T / 64; tile += sc.nloc) {
            const int soff_ = __builtin_amdgcn_readfirstlane(128 * s);
            const size_t t0 = (size_t)tile * 64 + wave * 8;
            v4u hqn = *(const GAS v4u*)(Q.HQ + t0 * 1024 + 128 * s + 16 * j), exn[2];
#pragma unroll
            for (int i = 0; i < 2; ++i) exn[i] = *(const GAS v4u*)(Q.EX + t0 * 64 + 8 * g + 4 * i);
#pragma unroll 1
            for (int k = 0; k < 8; ++k) {
                const size_t t = t0 + k;
                const v4u hq = hqn; v4u ex[2];
#pragma unroll
                for (int i = 0; i < 2; ++i) ex[i] = exn[i];
                if (k + 1 < 8) {
                    hqn = *(const GAS v4u*)(Q.HQ + (t + 1) * 1024 + 128 * s + 16 * j);
#pragma unroll
                    for (int i = 0; i < 2; ++i) exn[i] = *(const GAS v4u*)(Q.EX + (t + 1) * 64 + 8 * g + 4 * i);
                }
                v4u uu[16];
#pragma unroll
                for (int i = 0; i < 16; ++i) { const unsigned ew = ((i >> 1) & 3) == 0 ? ex[i >> 3].x : ((i >> 1) & 3) == 1 ? ex[i >> 3].y : ((i >> 1) & 3) == 2 ? ex[i >> 3].z : ex[i >> 3].w; unsigned e; if (i & 1) asm("v_lshrrev_b32 %0, 16, %1" : "=v"(e) : "v"(ew)); else asm("v_and_b32 %0, 0xffff, %1" : "=v"(e) : "v"(ew));
                    uu[i] = __builtin_bit_cast(v4u, __builtin_amdgcn_raw_buffer_load_b128(rU, (int)((e << 10) + 16u * (unsigned)j), soff_, 0)); }
                int lo = 0, hi = 0;
#pragma unroll
                for (int i = 0; i < 16; ++i) {
                    int p = __builtin_amdgcn_sdot4((int)uu[i].x, (int)hq.x, 0, false); p = __builtin_amdgcn_sdot4((int)uu[i].y, (int)hq.y, p, false); p = __builtin_amdgcn_sdot4((int)uu[i].z, (int)hq.z, p, false); p = __builtin_amdgcn_sdot4((int)uu[i].w, (int)hq.w, p, false);
                    p += __builtin_amdgcn_update_dpp(0, p, 0xB1, 0xF, 0xF, true); p += __builtin_amdgcn_update_dpp(0, p, 0x4E, 0xF, 0xF, true); p += __builtin_amdgcn_update_dpp(0, p, 0x141, 0xF, 0xF, true);
                    if (i < 8) lo = (j == i) ? p : lo; else hi = (j == i - 8) ? p : hi;
                }
                Q.P[(t * 8 + s) * 64 + 8 * g + j] = (int)__builtin_amdgcn_perm((unsigned)((hi + 32) >> 6), (unsigned)((lo + 32) >> 6), 0x05040100u);
            }
        }
}
__device__ __forceinline__ void peer_w(const GAS int* EX, const GAS float* GW, const GAS int* P, const GAS float* SH, const GAS float* SU, const GAS float* SV, GAS signed char* WQ, GAS float* WSC, int gw, int NGW, int lane,
                                       LAS unsigned char* lds, int tid) {
    asm volatile("" : "+v"(lane), "+v"(tid));
    LAS float* su_l = (LAS float*)lds; LAS float* sv_l = su_l + 16384;
#pragma unroll 4
    for (int i = tid; i < 4096; i += 512) { ((LAS f32x4*)su_l)[i] = ((const GAS f32x4*)SU)[i]; ((LAS f32x4*)sv_l)[i] = ((const GAS f32x4*)SV)[i]; }
    __syncthreads();
    for (int t = gw; t < T; t += NGW) {
        const float sh = SH[t];
#pragma unroll
        for (int q = 0; q < 2; ++q) { const size_t idx = (size_t)t * 128 + lane + 64 * q; const int e = (int)((const GAS unsigned short*)EX)[idx];
            const int slot_ = lane + 64 * q, pix_ = (slot_ >> 4) * 8 + (slot_ & 7), hsel_ = (slot_ >> 3) & 1;
            int pd = 0;
#pragma unroll
            for (int sl = 0; sl < 8; ++sl) { const int pw_ = P[((size_t)t * 8 + sl) * 64 + pix_]; pd += hsel_ ? (pw_ >> 16) : (int)(short)(pw_ & 0xffff); }
            const float w = GW[idx] * gelu_erf((float)pd * (64.f * sh * su_l[e])) * sv_l[e];
            float m = __builtin_fabsf(w);
            m = fmaxf(m, __builtin_bit_cast(float, __builtin_amdgcn_update_dpp(0, __builtin_bit_cast(int, m), 0xB1, 0xF, 0xF, true)));
            m = fmaxf(m, __builtin_bit_cast(float, __builtin_amdgcn_update_dpp(0, __builtin_bit_cast(int, m), 0x4E, 0xF, 0xF, true)));
            m = fmaxf(m, __builtin_bit_cast(float, __builtin_amdgcn_update_dpp(0, __builtin_bit_cast(int, m), 0x141, 0xF, 0xF, true)));
            m = fmaxf(m, __builtin_bit_cast(float, __builtin_amdgcn_update_dpp(0, __builtin_bit_cast(int, m), 0x140, 0xF, 0xF, true)));
            const float inv = m > 0.f ? 127.f / m : 0.f;
            const unsigned wb = (unsigned)((int)__builtin_rintf(w * inv)) & 255u;
            const unsigned b1 = (unsigned)__builtin_amdgcn_update_dpp(0, (int)wb, 0x55, 0xF, 0xF, true), b2 = (unsigned)__builtin_amdgcn_update_dpp(0, (int)wb, 0xAA, 0xF, 0xF, true), b3 = (unsigned)__builtin_amdgcn_update_dpp(0, (int)wb, 0xFF, 0xF, 0xF, true);
            if ((lane & 3) == 0) ((GAS unsigned*)WQ)[idx >> 2] = wb | (b1 << 8) | (b2 << 16) | (b3 << 24);
            if ((lane & 15) == 0) WSC[(size_t)t * 8 + (lane >> 4) + 4 * q] = m * (1.f / 127.f); }
    }
}
__device__ __forceinline__ void tr4x4(unsigned r0, unsigned r1, unsigned r2, unsigned r3, unsigned (&t)[4]) {
    const unsigned x0 = __builtin_amdgcn_perm(r1, r0, 0x05010400u), x1 = __builtin_amdgcn_perm(r1, r0, 0x07030602u), y0 = __builtin_amdgcn_perm(r3, r2, 0x05010400u), y1 = __builtin_amdgcn_perm(r3, r2, 0x07030602u);
    t[0] = __builtin_amdgcn_perm(y0, x0, 0x05040100u); t[1] = __builtin_amdgcn_perm(y0, x0, 0x07060302u); t[2] = __builtin_amdgcn_perm(y1, x1, 0x05040100u); t[3] = __builtin_amdgcn_perm(y1, x1, 0x07060302u);
}
struct Peer2P { const GAS int* EX; const GAS signed char* WQ; const GAS float* WSC; const GAS unsigned char* V8; GAS bf16* XB; GAS float* SSQ; };
__device__ __forceinline__ void peer_k2(const Peer2P& Q, const PeerS& sc, int wave, int lane) {
    asm volatile("" : "+v"(lane));
    const int g = lane >> 3, j = lane & 7, hf = lane >> 5, rp = (lane >> 4) & 1;
    const __amdgpu_buffer_rsrc_t rV = __builtin_amdgcn_make_buffer_rsrc((void*)Q.V8, 0, 0x7fffffff, 0x00020000);
    for (int s = sc.first_slice; s < 8; s += sc.nslices_step)
        for (int tile = sc.rank; tile < T / 64; tile += sc.nloc) {
            const int soff_ = __builtin_amdgcn_readfirstlane(128 * s);
            const size_t t0 = (size_t)tile * 64 + wave * 8;
            v4u exn[2], wqn; float swn;
#pragma unroll
            for (int i = 0; i < 2; ++i) exn[i] = *(const GAS v4u*)(Q.EX + t0 * 64 + 8 * g + 4 * i);
            wqn = *(const GAS v4u*)(Q.WQ + t0 * 128 + 16 * g); swn = Q.WSC[t0 * 8 + g];
#pragma unroll 1
            for (int k = 0; k < 8; ++k) {
                const size_t t = t0 + k;
                v4u ex[2]; const v4u wq = wqn; const float sw = swn;
#pragma unroll
                for (int i = 0; i < 2; ++i) ex[i] = exn[i];
                if (k + 1 < 8) {
#pragma unroll
                    for (int i = 0; i < 2; ++i) exn[i] = *(const GAS v4u*)(Q.EX + (t + 1) * 64 + 8 * g + 4 * i);
                    wqn = *(const GAS v4u*)(Q.WQ + (t + 1) * 128 + 16 * g); swn = Q.WSC[(t + 1) * 8 + g];
                }
                GAS v2u* xp = (GAS v2u*)(Q.XB + t * 1024 + 128 * s + 16 * j + 8 * hf + 4 * rp);
                const v2u xold = *xp;
                v4u vv[16];
#pragma unroll
                for (int i = 0; i < 16; ++i) { const unsigned ew = ((i >> 1) & 3) == 0 ? ex[i >> 3].x : ((i >> 1) & 3) == 1 ? ex[i >> 3].y : ((i >> 1) & 3) == 2 ? ex[i >> 3].z : ex[i >> 3].w; unsigned e; if (i & 1) asm("v_lshrrev_b32 %0, 16, %1" : "=v"(e) : "v"(ew)); else asm("v_and_b32 %0, 0xffff, %1" : "=v"(e) : "v"(ew));
                    vv[i] = __builtin_bit_cast(v4u, __builtin_amdgcn_raw_buffer_load_b128(rV, (int)((e << 10) + 16u * (unsigned)j), soff_, 0)); }
                int ai[16];
#pragma unroll
                for (int i = 0; i < 16; ++i) ai[i] = 0;
#pragma unroll
                for (int q4_ = 0; q4_ < 4; ++q4_) {
                    const unsigned wq4 = q4_ == 0 ? wq.x : q4_ == 1 ? wq.y : q4_ == 2 ? wq.z : wq.w;
#pragma unroll
                    for (int c = 0; c < 4; ++c) { unsigned tt[4];
                        const v4u &a0 = vv[4 * q4_], &a1 = vv[4 * q4_ + 1], &a2 = vv[4 * q4_ + 2], &a3 = vv[4 * q4_ + 3];
                        tr4x4(c == 0 ? a0.x : c == 1 ? a0.y : c == 2 ? a0.z : a0.w, c == 0 ? a1.x : c == 1 ? a1.y : c == 2 ? a1.z : a1.w, c == 0 ? a2.x : c == 1 ? a2.y : c == 2 ? a2.z : a2.w, c == 0 ? a3.x : c == 1 ? a3.y : c == 2 ? a3.z : a3.w, tt);
#pragma unroll
                        for (int b = 0; b < 4; ++b) ai[4 * c + b] = __builtin_amdgcn_sdot4((int)tt[b], (int)wq4, ai[4 * c + b], false); }
                }
                float acc[16];
#pragma unroll
                for (int i = 0; i < 16; ++i) acc[i] = (float)ai[i] * sw;
                float r8[8], r4[4];
#pragma unroll
                for (int m = 0; m < 8; ++m) { float a = acc[m], b = acc[m + 8]; swap32(a, b); r8[m] = a + b; }
#pragma unroll
                for (int n = 0; n < 4; ++n) { float a = r8[n], b = r8[n + 4]; asm volatile("v_nop\n\tv_nop\n\tv_permlane16_swap_b32 %0, %1" : "+v"(a), "+v"(b)); r4[n] = a + b; }
#pragma unroll
                for (int n = 0; n < 4; ++n) r4[n] += __builtin_bit_cast(float, __builtin_amdgcn_update_dpp(0, __builtin_bit_cast(int, r4[n]), 0x128, 0xF, 0xF, true));
                v2u xw; xw.x = pk2(bflo(xold.x) + r4[0], bfhi(xold.x) + r4[1]); xw.y = pk2(bflo(xold.y) + r4[2], bfhi(xold.y) + r4[3]);
                float ss = 0.f;
                if ((lane & 8) == 0) { const float x0 = bflo(xw.x), x1 = bfhi(xw.x), x2 = bflo(xw.y), x3 = bfhi(xw.y); ss = (x0 * x0 + x1 * x1) + (x2 * x2 + x3 * x3); *xp = xw; }
                ss = wave_allsum(ss);
                if (Q.SSQ) { if (lane == 0) Q.SSQ[t * 16 + s] = ss; }
            }
        }
}

struct Args { const float* in[33]; float* out; unsigned char* ws; int ph_lo, ph_hi; };
struct Frame { LAS unsigned char* lds; volatile LAS unsigned* MISC; gu32* ctl; int tid, lane, wave, G, vcu, xcc, xrank; };

__device__ __forceinline__ void transpose_item(const float* W, int ldw, int nsrc0, bf16* WT, int ldt, int rdst0, LAS float* scr, int kb, int nb, int lane, float scale, const float* kgain) {
    const int k0 = 64 * kb, n0 = 32 * nb;
#pragma unroll 8
    for (int i = 0; i < 32; ++i) { const int kk = 2 * i + (lane >> 5); const float gsc = kgain ? kgain[k0 + kk] * scale : scale; scr[kk * 33 + (lane & 31)] = W[(size_t)(k0 + kk) * ldw + nsrc0 + n0 + (lane & 31)] * gsc; }
    LDS_WAIT(); asm volatile("" ::: "memory");
    const int c = lane & 7;
#pragma unroll
    for (int j = 0; j < 4; ++j) { const int n = (lane >> 3) + 8 * j; const LAS float* s = scr + (8 * c) * 33 + n;
        v4u o; o.x = pk2(s[0 * 33], s[1 * 33]); o.y = pk2(s[2 * 33], s[3 * 33]); o.z = pk2(s[4 * 33], s[5 * 33]); o.w = pk2(s[6 * 33], s[7 * 33]);
        *(GAS v4u*)(WT + (size_t)(rdst0 + n0 + n) * ldt + k0 + 8 * c) = o; }
    LDS_WAIT(); asm volatile("" ::: "memory");
}
__device__ __forceinline__ void zero_rect(bf16* base, int ld, int row0, int nrows, int col0, int ncols, int gtid, int gthreads) {
    const int vpr = ncols / 8;
    for (int i = gtid; i < nrows * vpr; i += gthreads) { const int r = i / vpr, c = i % vpr; *(GAS v4u*)(base + (size_t)(row0 + r) * ld + col0 + 8 * c) = (v4u){0u, 0u, 0u, 0u}; }
}

__device__ __forceinline__ void p0_prologue(Frame& F, const Args& a) {
    LAS float* scr = (LAS float*)(F.lds + RING_OFF + F.wave * 16384);
    const int gw = blockIdx.x * NWAVES + F.wave, NGW = F.G * NWAVES;
    const int gtid = blockIdx.x * (NWAVES * 64) + F.tid, gthreads = F.G * NWAVES * 64;
    unsigned char* ws = a.ws;
    x0_phase((const GAS float*)a.in[0], (GAS bf16*)(ws + WS_XNB), (GAS float*)(ws + WS_SSQ), gw, NGW, F.lane);
    constexpr int I_IN = 16 * (INW / 32), I_SQ = 16 * 32, I_CKV = 16 * 64, I_UQ = 3 * 12, I_UKV = 2 * 16, I_L = I_IN + 4 * I_SQ + I_CKV + I_UQ + I_UKV;
    for (int it = gw; it < L * I_L; it += NGW) {
        const int l = it / I_L; int r = it % I_L;
        if (r < I_IN) {
            const int kb = r / 67, nb = r % 67; int src, dst; float sc = 1.f;
            if (nb < 6) { src = 32 * nb; dst = src; } else if (nb < 11) { src = 32 * nb; dst = src + 64; } else { src = 32 * nb; dst = src + 160; if (nb >= 43 && nb < 51) sc = 0.17677669529663687f * LOG2E; }
            transpose_item(a.in[5] + (size_t)l * D * INW, INW, src, (bf16*)(ws + WS_WIN) + (size_t)l * INP * D, D, dst, scr, kb, 0, F.lane, sc, a.in[4] + l * D); continue; } r -= I_IN;
        if (r < I_SQ) { transpose_item(a.in[21] + (size_t)l * D * D, D, 0, (bf16*)(ws + WS_WOUT) + (size_t)l * D * D, D, 0, scr, r / 32, r % 32, F.lane, 1.f, nullptr); continue; } r -= I_SQ;
        if (r < I_SQ) { transpose_item(a.in[24] + (size_t)l * D * D, D, 0, (bf16*)(ws + WS_WCQ) + (size_t)l * D * D, D, 0, scr, r / 32, r % 32, F.lane, 0.0625f * LOG2E, a.in[22] + l * D); continue; } r -= I_SQ;
        if (r < I_SQ) { transpose_item(a.in[26] + (size_t)l * D * D, D, 0, (bf16*)(ws + WS_WCO) + (size_t)l * D * D, D, 0, scr, r / 32, r % 32, F.lane, 1.f, nullptr); continue; } r -= I_SQ;
        if (r < I_SQ) { transpose_item(a.in[28] + (size_t)l * D * D, D, 0, (bf16*)(ws + WS_WPQ) + (size_t)l * D * D, D, 0, scr, r / 32, r % 32, F.lane, 1.f, a.in[27] + l * D); continue; } r -= I_SQ;
        if (r < I_CKV) { transpose_item(a.in[25] + (size_t)l * D * 2 * D, 2 * D, 0, (bf16*)(ws + WS_WCKV) + (size_t)l * 2 * D * D, D, 0, scr, r / 64, r % 64, F.lane, 1.f, nullptr); continue; } r -= I_CKV;
        if (r < I_UQ) { transpose_item(a.in[7] + (size_t)l * 192 * 384, 384, 0, (bf16*)(ws + WS_WUQ) + (size_t)l * 512 * 256, 256, 0, scr, r / 12, r % 12, F.lane, 0.10206207261596575f * LOG2E, a.in[6] + l * 192); continue; } r -= I_UQ;
        transpose_item(a.in[9] + (size_t)l * 128 * 512, 512, 0, (bf16*)(ws + WS_WUKV) + (size_t)l * 512 * 256, 256, 0, scr, r / 16, r % 16, F.lane, 1.f, a.in[8] + l * 128);
    }
    for (int l = 0; l < L; ++l) {
        bf16* win = (bf16*)(ws + WS_WIN) + (size_t)l * INP * D; bf16* wuq = (bf16*)(ws + WS_WUQ) + (size_t)l * 512 * 256; bf16* wukv = (bf16*)(ws + WS_WUKV) + (size_t)l * 512 * 256;
        zero_rect(win, D, 192, 64, 0, D, gtid, gthreads); zero_rect(win, D, 416, 96, 0, D, gtid, gthreads);
        zero_rect(wuq, 256, 0, 384, 192, 64, gtid, gthreads); zero_rect(wuq, 256, 384, 128, 0, 256, gtid, gthreads);
        zero_rect(wukv, 256, 0, 512, 128, 128, gtid, gthreads);
    }
    { float* rope = (float*)(ws + WS_ROPE); const int* pos = (const int*)a.in[2];
      for (int i = gtid; i < T * 16; i += gthreads) { const int t = i >> 4, k = i & 15; const float inv = powf(10000.f, -(float)(2 * k) / 32.f); const float ang = (float)pos[t] * inv;
          rope[(size_t)t * 32 + k] = cosf(ang); rope[(size_t)t * 32 + 16 + k] = sinf(ang); } }
    { const GAS f32x4* ks = (const GAS f32x4*)a.in[29]; GAS v2u* kd = (GAS v2u*)(ws + WS_KEYS);
      for (int i = gtid; i < L * 2 * 128 * 64 / 4; i += gthreads) { const f32x4 v = ks[i]; v2u w; w.x = pk2(v.x, v.y); w.y = pk2(v.z, v.w); kd[i] = w; }
    }
    for (int r = gw; r < 2 * L * 16384; r += NGW) { const int tb = r / (L * 16384), rr = r % (L * 16384);
        quant_row((const GAS float*)a.in[30 + tb] + (size_t)rr * 1024, (GAS unsigned*)(ws + (tb ? WS_V8 : WS_U8) + (size_t)rr * 1024), (GAS float*)(ws + (tb ? WS_SV : WS_SU)) + rr, 0, F.lane); }
    { float* btab = (float*)(ws + WS_BTAB); float* lams = (float*)(ws + WS_LAMS); float* spt = (float*)(ws + WS_SP);
      for (int i = gtid; i < 4 * 129; i += gthreads) { const int h = i / 129, n = i % 129; int bu; if (n < 16) bu = n; else { const int lg = 16 + (int)(logf((float)n / 16.f) / logf(8.f) * 16.f); bu = lg < 31 ? lg : 31; }
          btab[i] = a.in[3][bu * 4 + h] * LOG2E; }
      for (int i = gtid; i < L; i += gthreads) { const float* dl = a.in[17] + i * 128; float s1 = 0.f, s2 = 0.f; for (int j = 0; j < 32; ++j) { s1 += dl[j] * dl[32 + j]; s2 += dl[64 + j] * dl[96 + j]; }
          const float li = 0.8f - 0.6f * expf(-0.3f * (float)i); lams[2 * i] = expf(s1) - expf(s2) + li; lams[2 * i + 1] = li; }
      for (int i = gtid; i < L * 512; i += gthreads) spt[i] = log1pf(expf(-a.in[16][i])); }
    { GAS bf16* wat = (GAS bf16*)(ws + WS_WAT);
      for (int i = gtid; i < L * 8 * 2 * 4096; i += gthreads) { const int in_ = i & 63, out_ = (i >> 6) & 63, gate = (i >> 12) & 1, lg = i >> 13;
          wat[i] = (bf16)f2bf_(a.in[gate ? 14 : 12][(size_t)lg * 4096 + in_ * 64 + out_]); } }
    for (int l = 0; l < L; ++l) norm_phase((const GAS float*)a.in[1], (const GAS float*)a.in[23] + l * D, (GAS bf16*)(ws + WS_MNB) + (size_t)l * NB * MEM * D, NB * MEM, gw, NGW, F.lane);
}

constexpr int NPL = 16, PH_FINAL = 2 + NPL * L;
__global__ void __launch_bounds__(NWAVES * 64, 2) fwd(Args args) {
    extern __shared__ __attribute__((aligned(16))) unsigned char lds[];
    Frame F;
    F.lds = (LAS unsigned char*)lds; F.MISC = (volatile LAS unsigned*)(F.lds + MISC_OFF);
    F.tid = threadIdx.x; F.lane = F.tid & 63; F.wave = __builtin_amdgcn_readfirstlane(F.tid >> 6); F.G = gridDim.x;
    F.vcu = (F.G % 8 == 0) ? ((int)blockIdx.x % 8) * (F.G / 8) + (int)blockIdx.x / 8 : (int)blockIdx.x;
    unsigned char* ws = args.ws;
    F.ctl = (gu32*)(opq(ws) + WS_CTL);
    for (int u = F.tid; u < (LDS_BYTES - LDSCTL_OFF) / 4; u += NWAVES * 64) ((LAS unsigned*)(F.lds + LDSCTL_OFF))[u] = 0u;
    __syncthreads();
    XcdBarrier bar = xcd_barrier_post((unsigned*)(F.ctl + CW_BAR), F.MISC + 8);
    F.xcc = (int)bar.x;
    if (F.tid == 0) F.MISC[12] = __hip_atomic_fetch_add((unsigned*)(F.ctl + CW_RANK) + 64 * bar.x, 1u, __ATOMIC_RELAXED, __HIP_MEMORY_SCOPE_AGENT);
    __syncthreads();
    F.xrank = __builtin_amdgcn_readfirstlane((int)F.MISC[12]);
    const int lo = args.ph_lo, hi = args.ph_hi;
    const int gw = blockIdx.x * NWAVES + F.wave, NGW = F.G * NWAVES;
#define IN(k) (lo <= (k) && (k) < hi)
#define LANE_ (lane_id_v())
#define TID_ ((opqi(F.wave) << 6) | LANE_)
#define SITE() const int G_ = opqi(F.G), wv_ = opqi(F.wave), vcu_ = opqi(F.vcu), gw_ = opqi(gw), NGW_ = opqi(NGW); (void)G_; (void)wv_; (void)vcu_; (void)gw_; (void)NGW_
#if MK_DUP == 99
#define SEAM(k) do { if (IN(k) && IN((k) + 1)) { xcd_barrier(bar, (F.wave == 0 && lane_id_v() == 0) ? 1 : 0); xcd_barrier(bar, (F.wave == 0 && lane_id_v() == 0) ? 1 : 0); } } while (0)
#else
#define SEAM(k) do { if (IN(k) && IN((k) + 1)) xcd_barrier(bar, (F.wave == 0 && lane_id_v() == 0) ? 1 : 0); } while (0)
#endif
#define GEMM_SITE(EPI, Aptr, lda_, Bptr, ldb_, M_, N_, K_, cperm, ...) do { \
        pg8::Gemm g{opq(Aptr), opq(Bptr), M_, N_, K_, lda_, ldb_}; pg8::StaticOrder So; So.init(M_, N_, opqi(F.G), opqi(cperm)); pg8::EPI E{__VA_ARGS__}; \
        pg8::gemm_phase<pg8::EPI, pg8::StaticOrder, true, true>(F.lds + RING_OFF, g, So, E, opqi(F.wave)); } while (0)
    if (IN(0)) { p0_prologue(F, args); }
    SEAM(0);
    if (IN(1)) {
#pragma unroll 1
        for (int l = 0; l < L; ++l)
            GEMM_SITE(EpiBf16, (const GAS bf16*)(opq(ws) + WS_MNB) + (size_t)l * NB * MEM * D, D, (const GAS bf16*)(opq(ws) + WS_WCKV) + (size_t)l * 2 * D * D, D, NB * MEM, 2 * D, D, (int)((blockIdx.x + 64 * l) % F.G),
                      opq((GAS bf16*)(opq(ws) + WS_KVCB) + (size_t)l * NB * MEM * 2 * D), 2 * D, 2 * D, (const GAS float*)nullptr, 0);
    }
    SEAM(1);
    for (int l = 0; l < L; ++l) {
        const int pb = 2 + NPL * l;
        const GAS bf16* XNB = (const GAS bf16*)(opq(ws) + WS_XNB); const GAS bf16* YB = (const GAS bf16*)(opq(ws) + WS_YB); GAS bf16* PROJB = (GAS bf16*)(opq(ws) + WS_PROJB);
        if (IN(pb + 1)) GEMM_SITE(EpiBf16, XNB, D, (const GAS bf16*)(opq(ws) + WS_WIN) + (size_t)l * INP * D, D, T, INP, D, (int)blockIdx.x, opq(PROJB), INP, INP, opq((const GAS float*)(opq(ws) + WS_SSQ)), 8);
#if MK_DUP == 1
        if (IN(pb + 1)) GEMM_SITE(EpiBf16, XNB, D, (const GAS bf16*)(opq(ws) + WS_WIN) + (size_t)l * INP * D, D, T, INP, D, (int)blockIdx.x, opq(PROJB), INP, INP, opq((const GAS float*)(opq(ws) + WS_SSQ)), 8);
#endif
        SEAM(pb + 1);
        if (IN(pb + 2)) {
            SITE();
            pre_phase(opq((const GAS bf16*)PROJB), opq((const GAS float*)(opq(ws) + WS_ROPE)), opq((GAS float*)(opq(ws) + WS_RS)), opq((GAS bf16*)(opq(ws) + WS_KMB)), gw_, NGW_, LANE_);
#if MK_DUP == 21
            pre_phase(opq((const GAS bf16*)PROJB), opq((const GAS float*)(opq(ws) + WS_ROPE)), opq((GAS float*)(opq(ws) + WS_RS)), opq((GAS bf16*)(opq(ws) + WS_KMB)), gw_, NGW_, LANE_);
#endif
            LruP LP{opq((const GAS bf16*)PROJB), (const GAS float*)args.in[opqi(10)] + l * 4 * 512, (const GAS float*)args.in[opqi(11)] + l * 512, opq((const GAS bf16*)(opq(ws) + WS_WAT)) + (size_t)l * 8 * 2 * 4096, (const GAS float*)args.in[opqi(13)] + l * 512, (const GAS float*)args.in[opqi(15)] + l * 512,
                    (const GAS float*)(opq(ws) + WS_SP) + l * 512, opq((GAS unsigned*)(opq(ws) + WS_HLB)), opq((GAS float*)(opq(ws) + WS_LSUM))};
            lru_phase(LP, F.lds, TID_, wv_, LANE_, vcu_, G_);
#if MK_DUP == 2
            lru_phase(LP, F.lds, TID_, wv_, LANE_, vcu_, G_);
#endif
        }
        SEAM(pb + 2);
        if (IN(pb + 3)) {
            GEMM_SITE(EpiUp, (const GAS bf16*)PROJB + PC_CQ, INP, (const GAS bf16*)(opq(ws) + WS_WUQ) + (size_t)l * 512 * 256, 256, T, 512, 256, (int)blockIdx.x,
                      opq((GAS bf16*)(opq(ws) + WS_QMB)), (GAS bf16*)nullptr, 384, 384, opq((const GAS float*)(opq(ws) + WS_RS)), 0, 0);
            GEMM_SITE(EpiUp, (const GAS bf16*)PROJB + PC_CKV, INP, (const GAS bf16*)(opq(ws) + WS_WUKV) + (size_t)l * 512 * 256, 256, T, 512, 256, (int)blockIdx.x,
                      opq((GAS bf16*)(opq(ws) + WS_KMB)), opq((GAS bf16*)(opq(ws) + WS_VMB)), 0, 512, opq((const GAS float*)(opq(ws) + WS_RS)), 1, 1);
#if MK_DUP == 3
            GEMM_SITE(EpiUp, (const GAS bf16*)PROJB + PC_CQ, INP, (const GAS bf16*)(opq(ws) + WS_WUQ) + (size_t)l * 512 * 256, 256, T, 512, 256, (int)blockIdx.x,
                      opq((GAS bf16*)(opq(ws) + WS_QMB)), (GAS bf16*)nullptr, 384, 384, opq((const GAS float*)(opq(ws) + WS_RS)), 0, 0);
            GEMM_SITE(EpiUp, (const GAS bf16*)PROJB + PC_CKV, INP, (const GAS bf16*)(opq(ws) + WS_WUKV) + (size_t)l * 512 * 256, 256, T, 512, 256, (int)blockIdx.x,
                      opq((GAS bf16*)(opq(ws) + WS_KMB)), opq((GAS bf16*)(opq(ws) + WS_VMB)), 0, 512, opq((const GAS float*)(opq(ws) + WS_RS)), 1, 1);
#endif
        }
        SEAM(pb + 3);
        if (IN(pb + 4)) {
            SITE();
            AttnP PM{opq((const GAS bf16*)(opq(ws) + WS_QMB)), opq((const GAS bf16*)(opq(ws) + WS_KMB)), opq((const GAS bf16*)(opq(ws) + WS_VMB)), 384, 384, 256, opq((GAS bf16*)(opq(ws) + WS_OMB)), 256, opq((const GAS float*)(opq(ws) + WS_ROPE)), nullptr, nullptr, nullptr, nullptr};
            AttnP PD{opq((const GAS bf16*)PROJB + PC_QD), opq((const GAS bf16*)PROJB + PC_KD), opq((const GAS bf16*)PROJB + PC_VD), INP, INP, INP, opq((GAS bf16*)(opq(ws) + WS_YB) + 768), 1024, nullptr,
                     (const GAS int*)args.in[opqi(2)], (const GAS float*)(opq(ws) + WS_BTAB), (const GAS float*)args.in[opqi(18)] + l * 64, (const GAS float*)(opq(ws) + WS_LAMS) + 2 * l};
            attn_phase(PM, PD, F.lds, TID_, wv_, LANE_, vcu_, G_);
#if MK_DUP == 4
            __syncthreads(); attn_phase(PM, PD, F.lds, TID_, wv_, LANE_, vcu_, G_);
#elif MK_DUP == 40 || MK_DUP == 41
            __syncthreads(); attn_phase(PM, PD, F.lds, TID_, wv_, LANE_, vcu_, G_, MK_DUP - 40);
#endif
        }
        SEAM(pb + 4);
        if (IN(pb + 5)) {
            SITE();
            PostP PP{opq((const GAS bf16*)(opq(ws) + WS_OMB)), opq((const GAS unsigned*)(opq(ws) + WS_HLB)), opq((const GAS float*)(opq(ws) + WS_LSUM)), opq((const GAS bf16*)PROJB), (const GAS float*)args.in[opqi(19)] + l * 256, (const GAS float*)args.in[opqi(20)] + l * 512, opq((GAS bf16*)(opq(ws) + WS_YB))};
            post_phase(PP, F.lds, TID_, wv_, LANE_, vcu_, G_);
#if MK_DUP == 5
            __syncthreads(); post_phase(PP, F.lds, TID_, wv_, LANE_, vcu_, G_);
#endif
        }
        SEAM(pb + 5);
        if (IN(pb + 6)) GEMM_SITE(EpiRes, YB, D, (const GAS bf16*)(opq(ws) + WS_WOUT) + (size_t)l * D * D, D, T, D, D, (int)blockIdx.x, opq((GAS bf16*)(opq(ws) + WS_XNB)), opq((GAS float*)(opq(ws) + WS_SSQ)));
#if MK_DUP == 6
        if (IN(pb + 6)) GEMM_SITE(EpiRes, YB, D, (const GAS bf16*)(opq(ws) + WS_WOUT) + (size_t)l * D * D, D, T, D, D, (int)blockIdx.x, opq((GAS bf16*)(opq(ws) + WS_HLB)), opq((GAS float*)(opq(ws) + WS_OMB)));
#endif
        SEAM(pb + 6);
        if (IN(pb + 8)) GEMM_SITE(EpiBf16, XNB, D, (const GAS bf16*)(opq(ws) + WS_WCQ) + (size_t)l * D * D, D, T, D, D, (int)blockIdx.x, opq(PROJB), D, D, opq((const GAS float*)(opq(ws) + WS_SSQ)), 16);
#if MK_DUP == 8
        if (IN(pb + 8)) GEMM_SITE(EpiBf16, XNB, D, (const GAS bf16*)(opq(ws) + WS_WCQ) + (size_t)l * D * D, D, T, D, D, (int)blockIdx.x, opq(PROJB), D, D, opq((const GAS float*)(opq(ws) + WS_SSQ)), 16);
#endif
        SEAM(pb + 8);
        if (IN(pb + 9)) {
            SITE();
            const GAS bf16* kv = (const GAS bf16*)(opq(ws) + WS_KVCB) + (size_t)l * NB * MEM * 2 * D;
            AttnP PC{opq((const GAS bf16*)PROJB), opq(kv), opq(kv + D), 1024, 2 * D, 2 * D, opq((GAS bf16*)(opq(ws) + WS_YB)), 1024, nullptr, nullptr, nullptr, nullptr, nullptr};
            cross_phase(PC, F.lds, TID_, wv_, LANE_, vcu_, G_);
#if MK_DUP == 9
            cross_phase(PC, F.lds, TID_, wv_, LANE_, vcu_, G_);
#endif
        }
        SEAM(pb + 9);
        if (IN(pb + 10)) GEMM_SITE(EpiRes, YB, D, (const GAS bf16*)(opq(ws) + WS_WCO) + (size_t)l * D * D, D, T, D, D, (int)blockIdx.x, opq((GAS bf16*)(opq(ws) + WS_XNB)), opq((GAS float*)(opq(ws) + WS_SSQ)));
        SEAM(pb + 10);
        if (IN(pb + 12)) { GEMM_SITE(EpiBf16, XNB, D, (const GAS bf16*)(opq(ws) + WS_WPQ) + (size_t)l * D * D, D, T, D, D, (int)blockIdx.x, opq(PROJB), D, D, opq((const GAS float*)(opq(ws) + WS_SSQ)), 16);
#if MK_DUP == 12
            hq_phase(opq(XNB), opq((const GAS float*)(opq(ws) + WS_SSQ)), (const GAS float*)args.in[opqi(27)] + l * D, opq((GAS unsigned char*)(opq(ws) + WS_HQ)), opq((GAS float*)(opq(ws) + WS_SH)), opq((GAS int*)(opq(ws) + WS_P)), gw_, NGW_, LANE_);
#endif
            }
        SEAM(pb + 12);
        if (IN(pb + 13)) {
            SITE();
            RouteP RP{opq((const GAS bf16*)PROJB), opq((const GAS bf16*)(opq(ws) + WS_KEYS) + (size_t)l * 2 * 128 * 64), opq((GAS int*)(opq(ws) + WS_EX)), opq((GAS float*)(opq(ws) + WS_GW))};
            route_phase(RP, F.lds, TID_, wv_, LANE_, vcu_, G_);
            hq_phase(opq(XNB), opq((const GAS float*)(opq(ws) + WS_SSQ)), (const GAS float*)args.in[opqi(27)] + l * D, opq((GAS unsigned char*)(opq(ws) + WS_HQ)), opq((GAS float*)(opq(ws) + WS_SH)), opq((GAS int*)(opq(ws) + WS_P)), gw_, NGW_, LANE_);
#if MK_DUP == 13
            route_phase(RP, F.lds, TID_, wv_, LANE_, vcu_, G_);
#endif
        }
        SEAM(pb + 13);
        if (IN(pb + 14)) {
            SITE();
            const PeerS ps = peer_sched((const GAS unsigned*)(F.ctl + CW_RANK), opqi(F.xcc), opqi(F.xrank));
            Peer1P Q1{opq((const GAS unsigned char*)(opq(ws) + WS_HQ)), opq((const GAS int*)(opq(ws) + WS_EX)), opq((const GAS unsigned char*)(opq(ws) + WS_U8) + (size_t)l * 16384 * 1024), opq((GAS int*)(opq(ws) + WS_PROJB))};
            peer_k1(Q1, ps, wv_, LANE_);
#if MK_DUP == 141
            { Peer1P Q1b = Q1; Q1b.P = (GAS int*)(opq(ws) + WS_HLB); peer_k1(Q1b, ps, wv_, LANE_); }
#endif
        }
        SEAM(pb + 14);
        if (IN(pb + 15)) {
            SITE();
            peer_w(opq((const GAS int*)(opq(ws) + WS_EX)), opq((const GAS float*)(opq(ws) + WS_GW)), opq((const GAS int*)(opq(ws) + WS_PROJB)), opq((const GAS float*)(opq(ws) + WS_SH)), opq((const GAS float*)(opq(ws) + WS_SU) + l * 16384), opq((const GAS float*)(opq(ws) + WS_SV) + l * 16384),
                   opq((GAS signed char*)(opq(ws) + WS_W)), opq((GAS float*)(opq(ws) + WS_WS)), gw_, NGW_, LANE_, F.lds, TID_);
#if MK_DUP == 150
            peer_w(opq((const GAS int*)(opq(ws) + WS_EX)), opq((const GAS float*)(opq(ws) + WS_GW)), opq((const GAS int*)(opq(ws) + WS_PROJB)), opq((const GAS float*)(opq(ws) + WS_SH)), opq((const GAS float*)(opq(ws) + WS_SU) + l * 16384), opq((const GAS float*)(opq(ws) + WS_SV) + l * 16384),
                   opq((GAS signed char*)(opq(ws) + WS_W)), opq((GAS float*)(opq(ws) + WS_WS)), gw_, NGW_, LANE_, F.lds, TID_);
#endif
            xcd_barrier(bar, (F.wave == 0 && lane_id_v() == 0) ? 1 : 0);
            const PeerS ps = peer_sched((const GAS unsigned*)(F.ctl + CW_RANK), opqi(F.xcc), opqi(F.xrank));
            Peer2P Q2{opq((const GAS int*)(opq(ws) + WS_EX)), opq((const GAS signed char*)(opq(ws) + WS_W)), opq((const GAS float*)(opq(ws) + WS_WS)), opq((const GAS unsigned char*)(opq(ws) + WS_V8) + (size_t)l * 16384 * 1024), opq((GAS bf16*)(opq(ws) + WS_XNB)), opq((GAS float*)(opq(ws) + WS_SSQ))};
            peer_k2(Q2, ps, wv_, LANE_);
#if MK_DUP == 151
            { Peer2P Q2b = Q2; Q2b.XB = (GAS bf16*)(opq(ws) + WS_HLB); Q2b.SSQ = (GAS float*)(opq(ws) + WS_OMB); peer_k2(Q2b, ps, wv_, LANE_); }
#endif
        }
        SEAM(pb + 15);
    }
    if (IN(PH_FINAL)) { SITE(); final_norm_phase(opq((const GAS bf16*)(opq(ws) + WS_XNB)), (GAS float*)args.out, (const GAS float*)args.in[opqi(32)], T, gw_, NGW_, LANE_); }
#undef IN
#undef SEAM
#undef GEMM_SITE
}
}
extern "C" void kernel_launch(void* const* d_in, const int* in_sizes, int n_in, void* d_out, int out_size, void* d_ws, size_t ws_size, hipStream_t stream) {
    (void)in_sizes; (void)out_size;
    static int grid = 0;
    if (grid == 0) {
        int dev = 0, cus = 0, per_cu = 0;
        if (n_in != 33 || ws_size < mk::WS_END) { fprintf(stderr, "kernel_launch: unexpected n_in %d / ws_size %zu\n", n_in, ws_size); grid = -1; return; }
        if (hipGetDevice(&dev) != hipSuccess || hipDeviceGetAttribute(&cus, hipDeviceAttributeMultiprocessorCount, dev) != hipSuccess) { grid = -1; return; }
        if (hipFuncSetAttribute((const void*)mk::fwd, hipFuncAttributeMaxDynamicSharedMemorySize, mk::LDS_BYTES) != hipSuccess) { fprintf(stderr, "kernel_launch: hipFuncSetAttribute failed\n"); grid = -1; return; }
        if (hipOccupancyMaxActiveBlocksPerMultiprocessor(&per_cu, (const void*)mk::fwd, mk::NWAVES * 64, mk::LDS_BYTES) != hipSuccess || per_cu < 1) fprintf(stderr, "kernel_launch: occupancy query says %d\n", per_cu);
        (void)hipGetLastError();
        grid = cus;
    }
    if (grid < 0) return;
    unsigned char* ws = (unsigned char*)d_ws;
    (void)hipMemsetAsync(ws + mk::WS_CTL, 0, mk::CTL_ZERO_BYTES, stream);
    mk::Args a{};
    for (int i = 0; i < 33; ++i) a.in[i] = (const float*)d_in[i];
    a.out = (float*)d_out; a.ws = ws;
    auto run = [&](int lo, int hi) { a.ph_lo = lo; a.ph_hi = hi; hipLaunchKernelGGL(mk::fwd, dim3(grid), dim3(mk::NWAVES * 64), mk::LDS_BYTES, stream, a); };
#if MK_ONE_LAUNCH
    run(0, mk::PH_FINAL + 1);
#else
    for (int p = 0; p <= mk::PH_FINAL; ++p) {
        const int k = (p - 2) % mk::NPL, l = (p - 2) / mk::NPL;
#if MK_NAIVE_PEER == 2
        if (p >= 2 && p < mk::PH_FINAL && k == 14) {
            hipLaunchKernelGGL(k_peer, dim3(T), dim3(256), 0, stream, (const bf16_t*)(ws + mk::WS_XNB), (const int*)(ws + mk::WS_EX), (const float*)(ws + mk::WS_GW), (const float*)d_in[30] + (size_t)l * NEXP * D, (const float*)d_in[31] + (size_t)l * NEXP * D, (float*)d_out);
            continue; }
#elif MK_NAIVE_PEER == 1
        if (p >= 2 && p < mk::PH_FINAL && k == 13) {
            float* TQ = (float*)(ws + (size_t)806 * mk::MiB);
            hipLaunchKernelGGL(k_bf2f, dim3((unsigned)(((size_t)T * D + 255) / 256)), dim3(256), 0, stream, (const bf16_t*)(ws + mk::WS_PROJB), TQ, (long)T * D);
            hipLaunchKernelGGL(k_route, dim3(T), dim3(256), 0, stream, TQ, (const float*)d_in[29] + (size_t)l * 2 * 128 * 64, (int*)(ws + mk::WS_EX), (float*)(ws + mk::WS_GW));
            hipLaunchKernelGGL(k_peer, dim3(T), dim3(256), 0, stream, (const bf16_t*)(ws + mk::WS_XNB), (const int*)(ws + mk::WS_EX), (const float*)(ws + mk::WS_GW), (const float*)d_in[30] + (size_t)l * NEXP * D, (const float*)d_in[31] + (size_t)l * NEXP * D, (float*)d_out);
            continue; }
        if (p >= 2 && p < mk::PH_FINAL && k == 14) continue;
#endif
        run(p, p + 1); }
#endif
}
```

```cpp
#include <hip/hip_runtime.h>
#include <cstdint>
#include <cstdio>
#include <cmath>

#ifndef MK_ONE_LAUNCH
#define MK_ONE_LAUNCH 1
#endif
#ifndef MK_DUP
#define MK_DUP 0
#endif
#ifndef MK_NAIVE_PEER
#define MK_NAIVE_PEER 0
#endif
namespace pg8 {
#define PG8_LAS __attribute__((address_space(3)))
#ifndef GAS
#define GAS __attribute__((address_space(1)))
#endif
typedef unsigned short bf16_t;
typedef short bf16x8 __attribute__((ext_vector_type(8)));
typedef float f32x4 __attribute__((ext_vector_type(4)));
typedef unsigned u32x4 __attribute__((ext_vector_type(4)));
typedef unsigned u32x2 __attribute__((ext_vector_type(2)));
constexpr int BM = 256, BK = 64, HALF = 128, HTB = HALF * BK * 2, STAGE_BYTES = 8 * HTB, NXCD = 8, WGM = 8;
__host__ __device__ __forceinline__ int lds_byte(int r, int c) { const int st = (r >> 4) * 2 + (c >> 5), rr = r & 15, cc = c & 31, ob = rr * 64 + cc * 2; return st * 1024 + (ob ^ (((ob >> 9) & 1) << 5)); }
__host__ __device__ __forceinline__ void stage_rc(int b, int& R, int& C) { const int st = b / 1024, sb = b % 1024, swz = sb ^ (((sb >> 9) & 1) << 5); R = (st >> 1) * 16 + swz / 64; C = (st & 1) * 32 + (swz % 64) / 2; }
__host__ __device__ __forceinline__ int perm32(int rho) { const int n = rho >> 4, i = rho & 15; return 8 * (i >> 2) + 4 * n + (i & 3); }
__device__ __forceinline__ int pg8_lane_id() { int l; asm volatile("v_mbcnt_lo_u32_b32 %0, -1, 0\n\tv_mbcnt_hi_u32_b32 %0, -1, %0" : "=v"(l)); return l; }
struct Unit { int pm, pn; };
struct Gemm { const GAS bf16_t* A; const GAS bf16_t* Bt; int M, N, K, lda, ldb; };
struct StaticOrder {
    int nM, nN, nwg, G, c;
    __host__ __device__ void init(int M, int N, int G_, int c_) { nM = M / BM; nN = N / BM; nwg = nM * nN; G = G_; c = c_; }
    __host__ __device__ bool next(int i, Unit& u) const {
        const long L = (long)i * G + c; if (L >= nwg) return false;
        int wgid = (int)L; { const int q = nwg / NXCD, r = nwg % NXCD, xcd = wgid % NXCD, off = wgid / NXCD; wgid = (xcd < r ? xcd * (q + 1) : r * (q + 1) + (xcd - r) * q) + off; }
        const int nig = WGM * nN, gid = wgid / nig, fm = gid * WGM, gsz = (nM - fm) < WGM ? (nM - fm) : WGM;
        u.pm = fm + ((wgid % nig) % gsz); u.pn = (wgid % nig) / gsz; return true;
    }
    __device__ __forceinline__ void a_ready(const Unit&) const {}
    __device__ __forceinline__ void done(const Unit&) const {}
};
__device__ __forceinline__ unsigned cvt_pk_bf16(float lo, float hi) { unsigned r; asm volatile("v_cvt_pk_bf16_f32 %0, %1, %2" : "=v"(r) : "v"(lo), "v"(hi)); return r; }

struct EpiF32 {
    static constexpr bool PERM = false, AFTER_DRAIN = false;
    GAS float* C; int ldc; int nvalid; int accum;
    __device__ __forceinline__ void operator()(const f32x4 (&acc)[2][2][4][2], const Unit& u, int wr, int wc, int fr, int fq) const {
        { const int l_ = pg8_lane_id(); fr = l_ & 15; fq = l_ >> 4; }
#pragma unroll
        for (int ai = 0; ai < 2; ++ai)
#pragma unroll
            for (int m = 0; m < 4; ++m) { const size_t row = (size_t)u.pm * BM + ai * HALF + wr * 64 + m * 16 + fr;
#pragma unroll
                for (int bj = 0; bj < 2; ++bj)
#pragma unroll
                    for (int n = 0; n < 2; ++n) { const int col = u.pn * BM + bj * HALF + wc * 32 + n * 16 + 4 * fq;
                        if (col < nvalid) { GAS float* p = C + row * ldc + col; f32x4 v = acc[ai][bj][m][n]; if (accum) v += *(const GAS f32x4*)p; *(GAS f32x4*)p = v; } } }
    }
};
struct EpiBf16 {
    static constexpr bool PERM = true, AFTER_DRAIN = false;
    GAS bf16_t* O; int ldc; int nvalid; const GAS float* ssq; int np;
    __device__ __forceinline__ void operator()(const f32x4 (&acc)[2][2][4][2], const Unit& u, int wr, int wc, int fr, int fq) const {
        { const int l_ = pg8_lane_id(); fr = l_ & 15; fq = l_ >> 4; }
#pragma unroll
        for (int ai = 0; ai < 2; ++ai)
#pragma unroll
            for (int m = 0; m < 4; ++m) { const size_t row = (size_t)u.pm * BM + ai * HALF + wr * 64 + m * 16 + fr;
                float rs_ = 1.f;
                if (np > 0) { const GAS f32x4* sp = (const GAS f32x4*)(ssq + row * 16); f32x4 t = sp[0] + sp[1]; if (np > 8) t += sp[2] + sp[3]; rs_ = __builtin_amdgcn_rsqf(((t[0] + t[1]) + (t[2] + t[3])) * (1.f / 1024.f) + 1e-6f); }
#pragma unroll
                for (int bj = 0; bj < 2; ++bj) { const int col = u.pn * BM + bj * HALF + wc * 32 + 8 * fq;
                    if (col < nvalid) { const f32x4 v0 = acc[ai][bj][m][0] * rs_, v1 = acc[ai][bj][m][1] * rs_; u32x4 w; w.x = cvt_pk_bf16(v0[0], v0[1]); w.y = cvt_pk_bf16(v0[2], v0[3]); w.z = cvt_pk_bf16(v1[0], v1[1]); w.w = cvt_pk_bf16(v1[2], v1[3]);
                        *(GAS u32x4*)(O + row * ldc + col) = w; } } }
    }
};
struct EpiUp {
    static constexpr bool PERM = true, AFTER_DRAIN = false;
    GAS bf16_t* O; GAS bf16_t* O2; int ldc; int nvalid; const GAS float* rs; int rsi; int mode;
    __device__ __forceinline__ void operator()(const f32x4 (&acc)[2][2][4][2], const Unit& u, int wr, int wc, int fr, int fq) const {
        { const int l_ = pg8_lane_id(); fr = l_ & 15; fq = l_ >> 4; }
#pragma unroll
        for (int ai = 0; ai < 2; ++ai)
#pragma unroll
            for (int m = 0; m < 4; ++m) { const size_t row = (size_t)u.pm * BM + ai * HALF + wr * 64 + m * 16 + fr; const float s = rs[2 * row + rsi];
#pragma unroll
                for (int bj = 0; bj < 2; ++bj) { const int col = u.pn * BM + bj * HALF + wc * 32 + 8 * fq;
                    if (col < nvalid) { const f32x4 v0 = acc[ai][bj][m][0] * s, v1 = acc[ai][bj][m][1] * s; u32x4 w; w.x = cvt_pk_bf16(v0[0], v0[1]); w.y = cvt_pk_bf16(v0[2], v0[3]); w.z = cvt_pk_bf16(v1[0], v1[1]); w.w = cvt_pk_bf16(v1[2], v1[3]);
                        GAS bf16_t* dst;
                        if (mode == 0) dst = O + row * ldc + col;
                        else { const int h = col >> 7, j = col & 127; dst = (j < 64) ? O + row * 384 + h * 96 + j : O2 + row * 256 + h * 64 + (j - 64); }
                        *(GAS u32x4*)dst = w; } } }
    }
};

struct EpiRes {
    static constexpr bool PERM = true, AFTER_DRAIN = false;
    GAS bf16_t* XB; GAS float* SSQ;
    __device__ __forceinline__ void operator()(const f32x4 (&acc)[2][2][4][2], const Unit& u, int wr, int wc, int fr, int fq) const {
        { const int l_ = pg8_lane_id(); fr = l_ & 15; fq = l_ >> 4; }
#pragma unroll
        for (int ai = 0; ai < 2; ++ai)
#pragma unroll
            for (int m = 0; m < 4; ++m) { const size_t row = (size_t)u.pm * BM + ai * HALF + wr * 64 + m * 16 + fr; float ss = 0.f;
#pragma unroll
                for (int bj = 0; bj < 2; ++bj) { GAS u32x4* p = (GAS u32x4*)(XB + row * 1024 + u.pn * BM + bj * HALF + wc * 32 + 8 * fq);
                    const u32x4 o = *p; const f32x4 v0 = acc[ai][bj][m][0], v1 = acc[ai][bj][m][1];
                    u32x4 w;
                    w.x = cvt_pk_bf16(__builtin_bit_cast(float, o.x << 16) + v0[0], __builtin_bit_cast(float, o.x & 0xffff0000u) + v0[1]);
                    w.y = cvt_pk_bf16(__builtin_bit_cast(float, o.y << 16) + v0[2], __builtin_bit_cast(float, o.y & 0xffff0000u) + v0[3]);
                    w.z = cvt_pk_bf16(__builtin_bit_cast(float, o.z << 16) + v1[0], __builtin_bit_cast(float, o.z & 0xffff0000u) + v1[1]);
                    w.w = cvt_pk_bf16(__builtin_bit_cast(float, o.w << 16) + v1[2], __builtin_bit_cast(float, o.w & 0xffff0000u) + v1[3]);
                    *p = w;
#pragma unroll
                    for (int e = 0; e < 4; ++e) { const float a = __builtin_bit_cast(float, w[e] << 16), b = __builtin_bit_cast(float, w[e] & 0xffff0000u); ss += a * a + b * b; } }
                { float a = ss, b = ss; asm volatile("v_nop\n\tv_nop\n\tv_permlane16_swap_b32 %0, %1" : "+v"(a), "+v"(b)); ss = a + b; }
                { float a = ss, b = ss; asm volatile("v_nop\n\tv_nop\n\tv_permlane32_swap_b32 %0, %1" : "+v"(a), "+v"(b)); ss = a + b; }
                if (fq == 0) SSQ[row * 16 + 4 * u.pn + wc] = ss; }
    }
};
template <class Epi, class Sched, bool ALIGN_EPI = false, bool SP2 = false>
__device__ __forceinline__ void gemm_phase(PG8_LAS unsigned char* lds, const Gemm g, const Sched& S, const Epi& E, int wave_id) {
    int tid_ = (wave_id << 6) | pg8_lane_id(); asm volatile("" : "+v"(tid_));
    const int tid = tid_, wid = __builtin_amdgcn_readfirstlane(tid >> 6), lane = tid & 63, wr = wid >> 2, wc = wid & 3, fr = lane & 15, fq = lane >> 4;
    const int K = g.K, nt = K / BK;
    unsigned voffA[2], voffB[2];
#pragma unroll
    for (int i = 0; i < 2; ++i) { int R, C; stage_rc(tid * 16 + i * 8192, R, C); const int Rb = Epi::PERM ? ((R & ~31) + perm32(R & 31)) : R;
        voffA[i] = (unsigned)(R * g.lda + C) * 2u; voffB[i] = (unsigned)(Rb * g.ldb + C) * 2u; }
    const size_t kstep = (size_t)(BK * 2);
    const size_t hstepA = (size_t)HALF * g.lda * 2, hstepB = (size_t)HALF * g.ldb * 2;
    const size_t tstepA = 2 * hstepA, tstepB = 2 * hstepB;
    const unsigned ldsw = (unsigned)wid * 1024u;
    const int aoff = lds_byte(wr * 64 + fr, fq * 8), boff = lds_byte(wc * 32 + fr, fq * 8);
#define PG8_SA(b, h) (((b) * 2 + (h)) * HTB)
#define PG8_SB(b, h) ((4 + (b) * 2 + (h)) * HTB)
#define PG8_STAGE(bufoff, gbase, voff) do { _Pragma("unroll") for (int _i = 0; _i < 2; ++_i) \
        __builtin_amdgcn_global_load_lds((const unsigned*)((const char*)(gbase) + (voff)[_i]), (PG8_LAS unsigned*)(lds + (bufoff) + ldsw + _i * 8192), 16, 0, 0); } while (0)
#define PG8_LDA(dst, b, h) do { _Pragma("unroll") for (int m = 0; m < 4; ++m) _Pragma("unroll") for (int k = 0; k < 2; ++k) dst[m][k] = *(const PG8_LAS bf16x8*)(lds + PG8_SA(b, h) + aoff + m * 2048 + k * 1024); } while (0)
#define PG8_LDB(dst, b, h) do { _Pragma("unroll") for (int n = 0; n < 2; ++n) _Pragma("unroll") for (int k = 0; k < 2; ++k) dst[n][k] = *(const PG8_LAS bf16x8*)(lds + PG8_SB(b, h) + boff + n * 2048 + k * 1024); } while (0)
#define PG8_MMA(ai, bj, At, Bt) do { __builtin_amdgcn_s_setprio(1); _Pragma("unroll") for (int m = 0; m < 4; ++m) _Pragma("unroll") for (int n = 0; n < 2; ++n) _Pragma("unroll") for (int k = 0; k < 2; ++k) \
        acc[ai][bj][m][n] = __builtin_amdgcn_mfma_f32_16x16x32_bf16(Bt[n][k], At[m][k], acc[ai][bj][m][n], 0, 0, 0); __builtin_amdgcn_s_setprio(0); } while (0)
#define PG8_WAIT_V(n) asm volatile("s_waitcnt vmcnt(" #n ")" ::: "memory")
#define PG8_WAIT_L(n) asm volatile("s_waitcnt lgkmcnt(" #n ")" ::: "memory")
#define PG8_BAR __builtin_amdgcn_s_barrier()
#define PG8_SCHED __builtin_amdgcn_sched_barrier(0)
    Unit cur, nxt; int ui = 0;
    if (!S.next(0, cur)) return;
    f32x4 acc[2][2][4][2];
#pragma unroll
    for (int a = 0; a < 2; ++a)
#pragma unroll
        for (int b = 0; b < 2; ++b)
#pragma unroll
            for (int m = 0; m < 4; ++m)
#pragma unroll
                for (int n = 0; n < 2; ++n) acc[a][b][m][n] = (f32x4){0.f, 0.f, 0.f, 0.f};
    bf16x8 At[4][2], B0[2][2], B1[2][2];
    const char* cA = (const char*)g.A + (size_t)cur.pm * tstepA; const char* cB = (const char*)g.Bt + (size_t)cur.pn * tstepB;
    S.a_ready(cur);
    if constexpr (SP2) {
        PG8_STAGE(PG8_SB(0, 0), cB, voffB); PG8_STAGE(PG8_SB(0, 1), cB + hstepB, voffB); PG8_STAGE(PG8_SA(0, 0), cA, voffA); PG8_STAGE(PG8_SA(0, 1), cA + hstepA, voffA);
        if (wr == 1) PG8_BAR;
        PG8_WAIT_V(2); PG8_BAR;
        PG8_STAGE(PG8_SB(1, 0), cB + kstep, voffB); PG8_STAGE(PG8_SA(1, 0), cA + kstep, voffA); PG8_STAGE(PG8_SB(1, 1), cB + hstepB + kstep, voffB);
        PG8_WAIT_V(6); PG8_BAR;
    } else {
        PG8_STAGE(PG8_SB(0, 0), cB, voffB); PG8_STAGE(PG8_SA(0, 0), cA, voffA); PG8_STAGE(PG8_SB(0, 1), cB + hstepB, voffB); PG8_STAGE(PG8_SA(0, 1), cA + hstepA, voffA);
        if (wr == 1) PG8_BAR;
        PG8_WAIT_V(4); PG8_BAR;
        PG8_STAGE(PG8_SB(1, 0), cB + kstep, voffB); PG8_STAGE(PG8_SA(1, 0), cA + kstep, voffA); PG8_STAGE(PG8_SB(1, 1), cB + hstepB + kstep, voffB);
        PG8_WAIT_V(6); PG8_BAR;
    }
    for (;;) {
        const bool has_next = S.next(ui + 1, nxt);
        const char* nA = has_next ? (const char*)g.A + (size_t)nxt.pm * tstepA : cA; const char* nB = has_next ? (const char*)g.Bt + (size_t)nxt.pn * tstepB : cB;
        for (int t = 0; t < nt; t += 2) {
            const bool last = (t == nt - 2);
            const char* a1 = cA + (size_t)(t + 1) * kstep;
            const char* a2 = last ? nA : cA + (size_t)(t + 2) * kstep; const char* b2 = last ? nB : cB + (size_t)(t + 2) * kstep;
            const char* a3 = a2 + kstep; const char* b3 = b2 + kstep;
            if (last && has_next) S.a_ready(nxt);
            if constexpr (SP2) {
            PG8_LDB(B0, 0, 0); PG8_LDB(B1, 0, 1); PG8_SCHED; PG8_LDA(At, 0, 0); PG8_STAGE(PG8_SA(1, 1), a1 + hstepA, voffA);
            PG8_WAIT_V(8); PG8_WAIT_L(0); PG8_BAR; PG8_MMA(0, 0, At, B0); PG8_MMA(0, 1, At, B1); PG8_BAR; PG8_SCHED;
            PG8_LDA(At, 0, 1); PG8_STAGE(PG8_SB(0, 0), b2, voffB); PG8_STAGE(PG8_SB(0, 1), b2 + hstepB, voffB); PG8_STAGE(PG8_SA(0, 0), a2, voffA);
            PG8_WAIT_V(8); PG8_WAIT_L(0); PG8_BAR; PG8_MMA(1, 0, At, B0); PG8_MMA(1, 1, At, B1); PG8_BAR; PG8_SCHED;
            PG8_LDB(B0, 1, 0); PG8_LDB(B1, 1, 1); PG8_SCHED; PG8_LDA(At, 1, 0); PG8_STAGE(PG8_SA(0, 1), a2 + hstepA, voffA);
            PG8_WAIT_V(8); PG8_WAIT_L(0); PG8_BAR; PG8_MMA(0, 0, At, B0); PG8_MMA(0, 1, At, B1); PG8_BAR; PG8_SCHED;
            PG8_LDA(At, 1, 1); PG8_STAGE(PG8_SB(1, 0), b3, voffB); PG8_STAGE(PG8_SB(1, 1), b3 + hstepB, voffB); PG8_STAGE(PG8_SA(1, 0), a3, voffA);
            PG8_WAIT_V(8); PG8_WAIT_L(0); PG8_BAR; PG8_MMA(1, 0, At, B0); PG8_MMA(1, 1, At, B1); PG8_BAR; PG8_SCHED;
            } else {
            PG8_LDB(B0, 0, 0); PG8_SCHED; PG8_LDA(At, 0, 0); PG8_STAGE(PG8_SA(1, 1), a1 + hstepA, voffA);
            PG8_WAIT_L(8); PG8_BAR; PG8_WAIT_L(0); PG8_MMA(0, 0, At, B0); PG8_BAR; PG8_SCHED;
            PG8_LDB(B1, 0, 1); PG8_STAGE(PG8_SB(0, 0), b2, voffB);
            PG8_BAR; PG8_WAIT_L(0); PG8_MMA(0, 1, At, B1); PG8_BAR;
            PG8_LDA(At, 0, 1); PG8_STAGE(PG8_SA(0, 0), a2, voffA);
            PG8_BAR; PG8_WAIT_L(0); PG8_MMA(1, 0, At, B0); PG8_BAR; PG8_SCHED;
            PG8_STAGE(PG8_SB(0, 1), b2 + hstepB, voffB);
            PG8_WAIT_V(6); PG8_BAR; PG8_MMA(1, 1, At, B1); PG8_BAR;
            PG8_LDB(B0, 1, 0); PG8_SCHED; PG8_LDA(At, 1, 0); PG8_STAGE(PG8_SA(0, 1), a2 + hstepA, voffA);
            PG8_WAIT_L(8); PG8_BAR; PG8_WAIT_L(0); PG8_MMA(0, 0, At, B0); PG8_BAR; PG8_SCHED;
            PG8_LDB(B1, 1, 1); PG8_STAGE(PG8_SB(1, 0), b3, voffB);
            PG8_BAR; PG8_WAIT_L(0); PG8_MMA(0, 1, At, B1); PG8_BAR;
            PG8_LDA(At, 1, 1); PG8_STAGE(PG8_SA(1, 0), a3, voffA);
            PG8_BAR; PG8_WAIT_L(0); PG8_MMA(1, 0, At, B0); PG8_BAR; PG8_SCHED;
            PG8_STAGE(PG8_SB(1, 1), b3 + hstepB, voffB);
            PG8_WAIT_V(6); PG8_BAR; PG8_MMA(1, 1, At, B1); PG8_BAR;
            }
        }
        if constexpr (ALIGN_EPI) { if (wr == 0) PG8_BAR; }
        if constexpr (!Epi::AFTER_DRAIN) { E(acc, cur, wr, wc, fr, fq); S.done(cur); }
        if (!has_next) break;
#pragma unroll
        for (int a = 0; a < 2; ++a)
#pragma unroll
            for (int b = 0; b < 2; ++b)
#pragma unroll
                for (int m = 0; m < 4; ++m)
#pragma unroll
                    for (int n = 0; n < 2; ++n) acc[a][b][m][n] = (f32x4){0.f, 0.f, 0.f, 0.f};
        cur = nxt; cA = nA; cB = nB; ++ui;
        if constexpr (ALIGN_EPI) { if (wr == 1) PG8_BAR; }
    }
    PG8_WAIT_V(0);
    if constexpr (!ALIGN_EPI) { if (wr == 0) PG8_BAR; }
    PG8_BAR;
    if constexpr (Epi::AFTER_DRAIN) { E.fused(acc, cur, wr, wc, fr, fq, lds, wid, lane); S.done(cur); }
#undef PG8_SA
#undef PG8_SB
#undef PG8_STAGE
#undef PG8_LDA
#undef PG8_LDB
#undef PG8_MMA
#undef PG8_WAIT_V
#undef PG8_WAIT_L
#undef PG8_BAR
#undef PG8_SCHED
}
}

namespace mk {
#ifndef GAS
#define GAS __attribute__((address_space(1)))
#endif
#define LAS __attribute__((address_space(3)))
typedef unsigned short bf16;
typedef unsigned v4u __attribute__((ext_vector_type(4)));
typedef unsigned v2u __attribute__((ext_vector_type(2)));
typedef float f32x4 __attribute__((ext_vector_type(4)));
typedef GAS unsigned gu32;
#define LDS_WAIT() asm volatile("s_waitcnt lgkmcnt(0)" ::: "memory")
#define VM_WAIT() asm volatile("s_waitcnt vmcnt(0)" ::: "memory")
__device__ __forceinline__ unsigned f2bf_(float f) { unsigned u = __builtin_bit_cast(unsigned, f); return (u + 0x7fffu + ((u >> 16) & 1u)) >> 16; }
__device__ __forceinline__ unsigned pk2(float lo, float hi) { return f2bf_(lo) | (f2bf_(hi) << 16); }
__device__ __forceinline__ float bflo(unsigned w) { return __builtin_bit_cast(float, w << 16); }
__device__ __forceinline__ float bfhi(unsigned w) { return __builtin_bit_cast(float, w & 0xffff0000u); }

template <class P> __device__ __forceinline__ P* opq(P* p) { asm volatile("" : "+s"(p)); return p; }
__device__ __forceinline__ int opqi(int k) { asm volatile("" : "+s"(k)); return k; }
__device__ __forceinline__ float shx(float v, int o, int lane) { return __builtin_bit_cast(float, __builtin_amdgcn_ds_bpermute((lane ^ o) << 2, __builtin_bit_cast(int, v))); }
__device__ __forceinline__ int shxi(int v, int o, int lane) { return __builtin_amdgcn_ds_bpermute((lane ^ o) << 2, v); }
__device__ __forceinline__ int lane_id_v() { int l; asm volatile("v_mbcnt_lo_u32_b32 %0, -1, 0\n\tv_mbcnt_hi_u32_b32 %0, -1, %0" : "=v"(l)); return l; }
constexpr int NWAVES = 8;
constexpr int D = 1024, NB = 4, S = 8192, T = NB * S, L = 4, MEM = 256, INW = 2144, INP = 2304;
constexpr int PC_CQ = 0, PC_CKV = 256, PC_KR = 384, PC_XL = 512, PC_GL = 1024, PC_QD = 1536, PC_KD = 1792, PC_VD = 2048;
constexpr float LOG2E = 1.4426950408889634f;
constexpr size_t MiB = 1u << 20;
constexpr size_t WS_CTL = 0, CTL_ZERO_BYTES = 1 * MiB;
constexpr size_t WS_WIN = 1 * MiB, WS_WOUT = 19 * MiB, WS_WCQ = 27 * MiB, WS_WCO = 35 * MiB, WS_WPQ = 43 * MiB, WS_WCKV = 51 * MiB, WS_WUQ = 67 * MiB, WS_WUKV = 68 * MiB, WS_KEYS = 69 * MiB, WS_ROPE = 70 * MiB;
constexpr size_t WS_XNB = 76 * MiB, WS_YB = 140 * MiB, WS_PROJB = 204 * MiB, WS_QMB = 348 * MiB, WS_KMB = 372 * MiB, WS_VMB = 396 * MiB, WS_RS = 412 * MiB;
constexpr size_t WS_HLB = 413 * MiB, WS_ACB = 445 * MiB, WS_LSUM = 477 * MiB, WS_OMB = 478 * MiB, WS_MNB = 494 * MiB, WS_KVCB = 502 * MiB, WS_EX = 518 * MiB, WS_GW = 534 * MiB;
constexpr size_t WS_U8 = 550 * MiB, WS_V8 = 614 * MiB, WS_SU = 678 * MiB, WS_SV = 679 * MiB;
constexpr size_t WS_HQ = 680 * MiB, WS_P = 712 * MiB, WS_SH = 728 * MiB, WS_W = 729 * MiB, WS_WS = 745 * MiB, WS_SSQ = 746 * MiB, WS_END = 748 * MiB;
constexpr size_t WS_WAT = 74 * MiB;
constexpr size_t WS_BTAB = WS_KEYS + 512 * 1024, WS_LAMS = WS_BTAB + 4096, WS_SP = WS_LAMS + 4096;
constexpr int CW_BAR = 4096, CW_RANK = 8192;
constexpr int RING_OFF = 0, RING_BYTES = 155648, LDSCTL_OFF = RING_BYTES, MISC_OFF = LDSCTL_OFF + 320, LDS_BYTES = 163840;

#define XB_TMO      128
#define XB_XCNT(j)  (256  + 64 * (j))
#define XB_XSUB(j)  (1280 + 64 * (j))
#define XB_XGEN(j)  (2304 + 64 * (j))
#define XB_TOP      3328
#define XB_TOPGEN   3392
#define XCD_BAR_WORDS 3456
#define XB_SPIN_CAP (1u << 18)

__device__ __forceinline__ unsigned xb_ld(unsigned* p)              { return __hip_atomic_load(p, __ATOMIC_RELAXED, __HIP_MEMORY_SCOPE_AGENT); }
__device__ __forceinline__ unsigned xb_add(unsigned* p, unsigned v) { return __hip_atomic_fetch_add(p, v, __ATOMIC_RELAXED, __HIP_MEMORY_SCOPE_AGENT); }
__device__ __forceinline__ unsigned xb_xcc_id() { return (unsigned)__builtin_amdgcn_s_getreg((3 << 11) | 20) & 0xFu; }
#define XB_SPIN(cond, bar) do { unsigned _sp = 0; while (cond) { __builtin_amdgcn_s_sleep(1); \
    if ((++_sp & 255u) == 0u) { if (xb_ld(&(bar)[XB_TMO])) break; if (_sp > XB_SPIN_CAP) { atomicAdd(&(bar)[XB_TMO], 1u); break; } } } } while (0)

struct XcdBarrier {
    unsigned* bar; unsigned x;
    volatile LAS unsigned* st;
};

__device__ __forceinline__ XcdBarrier xcd_barrier_post(unsigned* bar, volatile LAS unsigned* st) {
    XcdBarrier b; b.bar = bar; b.x = xb_xcc_id(); b.st = st;
    if (threadIdx.x == 0) (void)xb_add(&bar[XB_XCNT(b.x)], 1u);
    return b;
}
__device__ __forceinline__ void xcd_barrier_complete(unsigned* bar, unsigned x, unsigned& nloc, unsigned& nx) {
    const unsigned G = gridDim.x * gridDim.y * gridDim.z;
    unsigned sum, cnt, mine, sp = 0u;
    for (;;) {
        sum = 0u; cnt = 0u; mine = 0u;
#pragma unroll
        for (unsigned j = 0; j < 16; ++j) { const unsigned c = xb_ld(&bar[XB_XCNT(j)]); sum += c; cnt += (c > 0u) ? 1u : 0u; mine = (j == x) ? c : mine; }
        if (sum == G) break;
        __builtin_amdgcn_s_sleep(1);
        if ((++sp & 255u) == 0u) { if (xb_ld(&bar[XB_TMO])) break; if (sp > XB_SPIN_CAP) { atomicAdd(&bar[XB_TMO], 1u); break; } }
    }
    nloc = mine > 0u ? mine : 1u; nx = cnt > 0u ? cnt : 1u;
}

__device__ __noinline__ void xcd_barrier_impl(unsigned* bar_, unsigned x_, volatile LAS unsigned* st_, int leader_) {
    XcdBarrier b; b.bar = bar_; b.x = x_; b.st = st_;
    asm volatile("s_waitcnt vmcnt(0)" ::: "memory");
    __syncthreads();
    if (leader_) {
        unsigned* bar = b.bar;
        __builtin_amdgcn_s_waitcnt(0);
        unsigned nloc = b.st[0], nx = b.st[1];
        if (nloc == 0u) { xcd_barrier_complete(bar, b.x, nloc, nx); b.st[0] = nloc; b.st[1] = nx; }
        const unsigned old = xb_add(&bar[XB_XSUB(b.x)], 1u);
        const unsigned gen = old / nloc;
        if (old + 1u == (gen + 1u) * nloc) {
            __builtin_amdgcn_fence(__ATOMIC_RELEASE, "agent");
            asm volatile("s_waitcnt vmcnt(0)" ::: "memory");
            const unsigned og = xb_add(&bar[XB_TOP], 1u);
            const unsigned tg = og / nx;
            if (og + 1u == (tg + 1u) * nx) xb_add(&bar[XB_TOPGEN], 1u);
            else XB_SPIN(xb_ld(&bar[XB_TOPGEN]) == tg, bar);
            __builtin_amdgcn_fence(__ATOMIC_ACQUIRE, "agent");
            xb_add(&bar[XB_XGEN(b.x)], 1u);
            asm volatile("s_waitcnt vmcnt(0)" ::: "memory");
        } else {
            XB_SPIN(xb_ld(&bar[XB_XGEN(b.x)]) == gen, bar);
            __builtin_amdgcn_fence(__ATOMIC_ACQUIRE, "agent");
            asm volatile("s_waitcnt vmcnt(0)" ::: "memory");
        }
    }
    __syncthreads();
}
__device__ __forceinline__ void xcd_barrier(const XcdBarrier& b, int leader) { xcd_barrier_impl(b.bar, b.x, b.st, leader); }


__device__ __forceinline__ float wave_sum(float v, int lane) {
    (void)lane;
    v += __builtin_bit_cast(float, __builtin_amdgcn_update_dpp(0, __builtin_bit_cast(int, v), 0xB1, 0xF, 0xF, true));
    v += __builtin_bit_cast(float, __builtin_amdgcn_update_dpp(0, __builtin_bit_cast(int, v), 0x4E, 0xF, 0xF, true));
    v += __builtin_bit_cast(float, __builtin_amdgcn_update_dpp(0, __builtin_bit_cast(int, v), 0x141, 0xF, 0xF, true));
    v += __builtin_bit_cast(float, __builtin_amdgcn_update_dpp(0, __builtin_bit_cast(int, v), 0x140, 0xF, 0xF, true));
    { float a = v, b = v; asm volatile("v_nop\n\tv_nop\n\tv_permlane16_swap_b32 %0, %1" : "+v"(a), "+v"(b)); v = a + b; }
    { float a = v, b = v; asm volatile("v_nop\n\tv_nop\n\tv_permlane32_swap_b32 %0, %1" : "+v"(a), "+v"(b)); v = a + b; }
    return v;
}
__device__ __forceinline__ float wave_max(float v) {
    v = fmaxf(v, __builtin_bit_cast(float, __builtin_amdgcn_update_dpp(0, __builtin_bit_cast(int, v), 0xB1, 0xF, 0xF, true)));
    v = fmaxf(v, __builtin_bit_cast(float, __builtin_amdgcn_update_dpp(0, __builtin_bit_cast(int, v), 0x4E, 0xF, 0xF, true)));
    v = fmaxf(v, __builtin_bit_cast(float, __builtin_amdgcn_update_dpp(0, __builtin_bit_cast(int, v), 0x141, 0xF, 0xF, true)));
    v = fmaxf(v, __builtin_bit_cast(float, __builtin_amdgcn_update_dpp(0, __builtin_bit_cast(int, v), 0x140, 0xF, 0xF, true)));
    { float a = v, b = v; asm volatile("v_nop\n\tv_nop\n\tv_permlane16_swap_b32 %0, %1" : "+v"(a), "+v"(b)); v = fmaxf(a, b); }
    { float a = v, b = v; asm volatile("v_nop\n\tv_nop\n\tv_permlane32_swap_b32 %0, %1" : "+v"(a), "+v"(b)); v = fmaxf(a, b); }
    return v;
}
__device__ __forceinline__ float gelu_erf(float v) {
    const float av = __builtin_fabsf(v), t = __builtin_amdgcn_rcpf(av * 0.2316418882f + 1.0f);
    float q = t * 0.5307027145f + (-0.7265760135f); q = q * t + 0.7107068705f; q = q * t + (-0.142248368f); q = q * t + 0.127414796f; q = q * t;
    const float e = __builtin_amdgcn_exp2f((v * v) * (-0.72134752044f));
    const float m = v * (q * e);
    return v < 0.f ? m : v - m;
}

__device__ __forceinline__ void norm_phase(const GAS float* X, const GAS float* g, GAS bf16* out, int rows, int gw, int NGW, int lane) {
    asm volatile("" : "+v"(lane));
    f32x4 gv[4];
#pragma unroll
    for (int j = 0; j < 4; ++j) gv[j] = ((const GAS f32x4*)g)[lane + 64 * j];
    for (int m = gw; m < rows; m += NGW) {
        const GAS f32x4* xr = (const GAS f32x4*)(X + (size_t)m * D) + lane;
        f32x4 v[4]; float s = 0.f;
#pragma unroll
        for (int j = 0; j < 4; ++j) { v[j] = xr[64 * j]; s += (v[j].x * v[j].x + v[j].y * v[j].y) + (v[j].z * v[j].z + v[j].w * v[j].w); }
        const float rs = rsqrtf(wave_sum(s, lane) * (1.f / D) + 1e-6f);
        GAS v2u* o8 = (GAS v2u*)(out + (size_t)m * D) + lane;
#pragma unroll
        for (int j = 0; j < 4; ++j) { v2u w; w.x = pk2(v[j].x * rs * gv[j].x, v[j].y * rs * gv[j].y); w.y = pk2(v[j].z * rs * gv[j].z, v[j].w * rs * gv[j].w); o8[64 * j] = w; }
    }
}
__device__ __forceinline__ void hq_phase(const GAS bf16* XB, const GAS float* SSQ, const GAS float* g, GAS unsigned char* HQ, GAS float* SH, GAS int* Pz, int gw, int NGW, int lane) {
    asm volatile("" : "+v"(lane));
    const GAS f32x4* gp = (const GAS f32x4*)g + 4 * lane; const f32x4 g0 = gp[0], g1 = gp[1], g2 = gp[2], g3 = gp[3];
    for (int m = gw; m < T; m += NGW) {
        const GAS f32x4* sp = (const GAS f32x4*)(SSQ + (size_t)m * 16); const f32x4 t = (sp[0] + sp[1]) + (sp[2] + sp[3]);
        const float rs = __builtin_amdgcn_rsqf(((t[0] + t[1]) + (t[2] + t[3])) * (1.f / 1024.f) + 1e-6f);
        const v4u a = *(const GAS v4u*)(XB + (size_t)m * D + 16 * lane), b = *(const GAS v4u*)(XB + (size_t)m * D + 16 * lane + 8);
        float f[16] = {bflo(a.x) * g0[0], bfhi(a.x) * g0[1], bflo(a.y) * g0[2], bfhi(a.y) * g0[3], bflo(a.z) * g1[0], bfhi(a.z) * g1[1], bflo(a.w) * g1[2], bfhi(a.w) * g1[3],
                       bflo(b.x) * g2[0], bfhi(b.x) * g2[1], bflo(b.y) * g2[2], bfhi(b.y) * g2[3], bflo(b.z) * g3[0], bfhi(b.z) * g3[1], bflo(b.w) * g3[2], bfhi(b.w) * g3[3]};
        float mx = 0.f;
#pragma unroll
        for (int i = 0; i < 16; ++i) { f[i] *= rs; mx = fmaxf(mx, __builtin_fabsf(f[i])); }
        mx = wave_max(mx);
        const float inv = mx > 0.f ? 127.f / mx : 0.f;
        v4u q;
#pragma unroll
        for (int i = 0; i < 4; ++i) { const int ia = (int)__builtin_rintf(f[4 * i] * inv), ib = (int)__builtin_rintf(f[4 * i + 1] * inv), ic = (int)__builtin_rintf(f[4 * i + 2] * inv), id = (int)__builtin_rintf(f[4 * i + 3] * inv);
            q[i] = (unsigned)(ia & 255) | ((unsigned)(ib & 255) << 8) | ((unsigned)(ic & 255) << 16) | ((unsigned)(id & 255) << 24); }
        *(GAS v4u*)(HQ + (size_t)m * D + 16 * lane) = q;
        if (lane == 0) SH[m] = mx * (1.f / 127.f);
    }
}
__device__ __forceinline__ void x0_phase(const GAS float* X, GAS bf16* XB, GAS float* SSQ, int gw, int NGW, int lane) {
    asm volatile("" : "+v"(lane));
    for (int m = gw; m < T; m += NGW) {
        const GAS f32x4* xr = (const GAS f32x4*)(X + (size_t)m * D) + lane; GAS v2u* o8 = (GAS v2u*)(XB + (size_t)m * D) + lane;
        float s = 0.f;
#pragma unroll
        for (int j = 0; j < 4; ++j) { const f32x4 v = xr[64 * j]; s += (v.x * v.x + v.y * v.y) + (v.z * v.z + v.w * v.w); v2u w; w.x = pk2(v.x, v.y); w.y = pk2(v.z, v.w); o8[64 * j] = w; }
        s = wave_sum(s, lane);
        if (lane < 8) SSQ[(size_t)m * 16 + lane] = lane == 0 ? s : 0.f;
    }
}
__device__ __forceinline__ void final_norm_phase(const GAS bf16* XB, GAS float* O, const GAS float* g, int rows, int gw, int NGW, int lane) {
    asm volatile("" : "+v"(lane));
    for (int m = gw; m < rows; m += NGW) {
        const GAS v4u* xr = (const GAS v4u*)(XB + (size_t)m * D) + lane;
        v4u v[2]; float s = 0.f;
#pragma unroll
        for (int j = 0; j < 2; ++j) { v[j] = xr[64 * j];
#pragma unroll
            for (int e = 0; e < 4; ++e) { const float a = bflo(v[j][e]), b = bfhi(v[j][e]); s += a * a + b * b; } }
        const float rs = rsqrtf(wave_sum(s, lane) * (1.f / D) + 1e-6f);
#pragma unroll
        for (int j = 0; j < 2; ++j) { const int c = 8 * (lane + 64 * j); const f32x4 g0 = *(const GAS f32x4*)(g + c), g1 = *(const GAS f32x4*)(g + c + 4);
            f32x4 o0, o1; o0.x = bflo(v[j].x) * rs * g0.x; o0.y = bfhi(v[j].x) * rs * g0.y; o0.z = bflo(v[j].y) * rs * g0.z; o0.w = bfhi(v[j].y) * rs * g0.w;
            o1.x = bflo(v[j].z) * rs * g1.x; o1.y = bfhi(v[j].z) * rs * g1.y; o1.z = bflo(v[j].w) * rs * g1.z; o1.w = bfhi(v[j].w) * rs * g1.w;
            *(GAS f32x4*)(O + (size_t)m * D + c) = o0; *(GAS f32x4*)(O + (size_t)m * D + c + 4) = o1; }
    }
}

__device__ __forceinline__ float row16_sum(float v) {
    v += __builtin_bit_cast(float, __builtin_amdgcn_update_dpp(0, __builtin_bit_cast(int, v), 0xB1, 0xF, 0xF, true));
    v += __builtin_bit_cast(float, __builtin_amdgcn_update_dpp(0, __builtin_bit_cast(int, v), 0x4E, 0xF, 0xF, true));
    v += __builtin_bit_cast(float, __builtin_amdgcn_update_dpp(0, __builtin_bit_cast(int, v), 0x141, 0xF, 0xF, true));
    v += __builtin_bit_cast(float, __builtin_amdgcn_update_dpp(0, __builtin_bit_cast(int, v), 0x140, 0xF, 0xF, true));
    return v;
}
__device__ __forceinline__ float sq8(const v4u w) { const float a0 = bflo(w.x), a1 = bfhi(w.x), a2 = bflo(w.y), a3 = bfhi(w.y), a4 = bflo(w.z), a5 = bfhi(w.z), a6 = bflo(w.w), a7 = bfhi(w.w);
    return (a0 * a0 + a1 * a1) + (a2 * a2 + a3 * a3) + (a4 * a4 + a5 * a5) + (a6 * a6 + a7 * a7); }
__device__ __forceinline__ void pre_phase(const GAS bf16* PROJB, const GAS float* ROPE, GAS float* RS, GAS bf16* KMB, int gw, int NGW, int lane) {
    asm volatile("" : "+v"(lane));
    const int q = lane >> 4, sub = lane & 15;
    for (int t0 = gw * 4; t0 < T; t0 += NGW * 4) {
        const size_t t = (size_t)t0 + q;
        const GAS bf16* pr = PROJB + t * INP;
        const v4u w0 = *(const GAS v4u*)(pr + PC_CQ + 8 * sub), w1 = *(const GAS v4u*)(pr + PC_CQ + 8 * (16 + (sub & 7))), w2 = *(const GAS v4u*)(pr + PC_CKV + 8 * sub);
        const float x1 = __builtin_bit_cast(float, (unsigned)pr[PC_KR + sub] << 16), x2 = __builtin_bit_cast(float, (unsigned)pr[PC_KR + 16 + sub] << 16);
        const float c = ROPE[t * 32 + sub], sn = ROPE[t * 32 + 16 + sub];
        const float sq = row16_sum(sq8(w0) + (sub < 8 ? sq8(w1) : 0.f)), skv = row16_sum(sq8(w2));
        if (sub == 0) { RS[2 * t] = rsqrtf(sq * (1.f / 192.f) + 1e-6f); RS[2 * t + 1] = rsqrtf(skv * (1.f / 128.f) + 1e-6f); }
        const bf16 y1 = (bf16)f2bf_(x1 * c - x2 * sn), y2 = (bf16)f2bf_(x1 * sn + x2 * c);
        GAS bf16* kr = KMB + t * 384 + 64 + sub;
#pragma unroll
        for (int h = 0; h < 4; ++h) { kr[h * 96] = y1; kr[h * 96 + 16] = y2; }
    }
}

typedef short lr_bf16x8 __attribute__((ext_vector_type(8)));
typedef float lr_f32x16 __attribute__((ext_vector_type(16)));
__device__ __forceinline__ void lr_swap32(float& a, float& b) { asm volatile("v_nop\n\tv_nop\n\tv_permlane32_swap_b32 %0, %1" : "+v"(a), "+v"(b)); }
constexpr int LR_XR = 0, LR_CW = LR_XR + 37376, LR_XA = LR_CW + 1280, LR_WT = LR_XA + 256 * 144, LR_SUM = LR_WT + 2 * 64 * 144, LR_END = LR_SUM + 4096;
struct LruP { const GAS bf16* PROJB; const GAS float* cw; const GAS float* cb; const GAS bf16* wat; const GAS float* ba; const GAS float* bx; const GAS float* sp; GAS unsigned* HA; GAS float* LSUM; };
__device__ __forceinline__ void lru_phase(const LruP& P, LAS unsigned char* lds, int tid, int wave, int lane, int vcu, int G) {
    asm volatile("" : "+v"(tid), "+v"(lane));
    LAS float* SUM = (LAS float*)(lds + LR_SUM);
    for (int u = vcu; u < (T / 256) * 8; u += G) {
        const int tile = u >> 3, g = u & 7; const int t0 = tile * 256; const bool first = ((tile & 31) == 0);
        __syncthreads();
        float ba_[2], bx_[2], sp_[2];
#pragma unroll
        for (int nt = 0; nt < 2; ++nt) { const int ch = 64 * g + 32 * nt + (lane & 31); ba_[nt] = P.ba[ch]; bx_[nt] = P.bx[ch]; sp_[nt] = P.sp[ch]; }
        { v4u wt_[2], xr_[5];
#pragma unroll
          for (int i = 0; i < 2; ++i) { const int idx = tid + 512 * i; wt_[i] = ((const GAS v4u*)(P.wat + (size_t)g * 2 * 4096))[idx]; }
#pragma unroll
          for (int i = 0; i < 5; ++i) { const int idx = tid + 512 * i, row = idx >> 3, part = idx & 7; const bool ok = (idx < 259 * 8) && !(first && row < 3);
              const int trow = ok ? t0 - 3 + row : t0;
              xr_[i] = *(const GAS v4u*)(P.PROJB + (size_t)trow * INP + PC_XL + 64 * g + 8 * part); if (!ok) xr_[i] = v4u{0u, 0u, 0u, 0u}; }
          float cwv = 0.f; if (tid < 320) cwv = (tid < 256) ? P.cw[(tid >> 6) * 512 + 64 * g + (tid & 63)] : P.cb[64 * g + (tid - 256)];
#pragma unroll
          for (int i = 0; i < 2; ++i) { const int idx = tid + 512 * i; *(LAS v4u*)(lds + LR_WT + (idx >> 9) * 9216 + ((idx >> 3) & 63) * 144 + (idx & 7) * 16) = wt_[i]; }
#pragma unroll
          for (int i = 0; i < 5; ++i) { const int idx = tid + 512 * i, row = idx >> 3, part = idx & 7; if (idx < 259 * 8) *(LAS v4u*)(lds + LR_XR + row * 144 + 16 * part) = xr_[i]; }
          if (tid < 320) ((LAS float*)(lds + LR_CW))[tid] = cwv; }
        __syncthreads();
        { float cwr[4][8], cbr[8];
#pragma unroll
          for (int k = 0; k < 4; ++k) { const f32x4 c0 = *(const LAS f32x4*)(lds + LR_CW + (k * 64 + 8 * wave) * 4), c1 = *(const LAS f32x4*)(lds + LR_CW + (k * 64 + 8 * wave + 4) * 4);
              cwr[k][0] = c0.x; cwr[k][1] = c0.y; cwr[k][2] = c0.z; cwr[k][3] = c0.w; cwr[k][4] = c1.x; cwr[k][5] = c1.y; cwr[k][6] = c1.z; cwr[k][7] = c1.w; }
          { const f32x4 c0 = *(const LAS f32x4*)(lds + LR_CW + (256 + 8 * wave) * 4), c1 = *(const LAS f32x4*)(lds + LR_CW + (256 + 8 * wave + 4) * 4);
            cbr[0] = c0.x; cbr[1] = c0.y; cbr[2] = c0.z; cbr[3] = c0.w; cbr[4] = c1.x; cbr[5] = c1.y; cbr[6] = c1.z; cbr[7] = c1.w; }
#pragma unroll
          for (int it_ = 0; it_ < 4; ++it_) { const int time = lane + 64 * it_;
              float y[8];
#pragma unroll
              for (int e = 0; e < 8; ++e) y[e] = cbr[e];
#pragma unroll
              for (int k = 0; k < 4; ++k) { const v4u w = *(const LAS v4u*)(lds + LR_XR + (time + k) * 144 + 16 * wave);
                  y[0] += bflo(w.x) * cwr[k][0]; y[1] += bfhi(w.x) * cwr[k][1]; y[2] += bflo(w.y) * cwr[k][2]; y[3] += bfhi(w.y) * cwr[k][3];
                  y[4] += bflo(w.z) * cwr[k][4]; y[5] += bfhi(w.z) * cwr[k][5]; y[6] += bflo(w.w) * cwr[k][6]; y[7] += bfhi(w.w) * cwr[k][7]; }
              v4u o; o.x = pk2(y[0], y[1]); o.y = pk2(y[2], y[3]); o.z = pk2(y[4], y[5]); o.w = pk2(y[6], y[7]);
              *(LAS v4u*)(lds + LR_XA + time * 144 + 16 * wave) = o; } }
        __syncthreads();
        const int r32 = lane & 31, hi = lane >> 5;
        lr_f32x16 acc[2][2];
#pragma unroll
        for (int nt = 0; nt < 2; ++nt) { const float b_a = ba_[nt], b_x = bx_[nt];
#pragma unroll
            for (int r = 0; r < 16; ++r) { acc[0][nt][r] = b_a; acc[1][nt][r] = b_x; } }
        { lr_bf16x8 af[4];
#pragma unroll
          for (int s_ = 0; s_ < 4; ++s_) af[s_] = *(const LAS lr_bf16x8*)(lds + LR_XA + (32 * wave + r32) * 144 + (16 * s_ + 8 * hi) * 2);
#pragma unroll
          for (int gt = 0; gt < 2; ++gt)
#pragma unroll
              for (int nt = 0; nt < 2; ++nt)
#pragma unroll
                  for (int s_ = 0; s_ < 4; ++s_) { const lr_bf16x8 bfr = *(const LAS lr_bf16x8*)(lds + LR_WT + gt * 9216 + (32 * nt + r32) * 144 + (16 * s_ + 8 * hi) * 2);
                      acc[gt][nt] = __builtin_amdgcn_mfma_f32_32x32x16_bf16(af[s_], bfr, acc[gt][nt], 0, 0, 0); } }
#pragma unroll
        for (int nt = 0; nt < 2; ++nt) { const float sp = sp_[nt];
            float sa_[4], sh_[4];
#pragma unroll
            for (int q = 0; q < 4; ++q) { float hrun = 0.f, arun = 1.f;
#pragma unroll
                for (int e = 0; e < 4; ++e) { const int r = 4 * q + e, tl = 8 * q + 4 * hi + e;
                    const float xv = __builtin_bit_cast(float, (unsigned)*(const LAS unsigned short*)(lds + LR_XA + (32 * wave + tl) * 144 + (32 * nt + r32) * 2) << 16);
                    const float rg = __builtin_amdgcn_rcpf(1.f + __builtin_amdgcn_exp2f(-LOG2E * acc[0][nt][r])), ig = __builtin_amdgcn_rcpf(1.f + __builtin_amdgcn_exp2f(-LOG2E * acc[1][nt][r]));
                    const float la = -8.0f * rg * sp; const float a_ = __builtin_amdgcn_exp2f(LOG2E * la);
                    const float uu = __builtin_amdgcn_sqrtf(fmaxf(1.f - a_ * a_, 0.f)) * (ig * xv);
                    hrun = a_ * hrun + uu; arun *= a_; acc[0][nt][r] = arun; acc[1][nt][r] = hrun; }
                sa_[q] = arun; sh_[q] = hrun; }
            float runA = 1.f, runH = 0.f;
#pragma unroll
            for (int q = 0; q < 4; ++q) { float a0 = sa_[q], a1 = sa_[q], h0 = sh_[q], h1 = sh_[q]; lr_swap32(a0, a1); lr_swap32(h0, h1);
                const float midA = runA * a0, midH = a0 * runH + h0;
                const float inA = hi ? midA : runA, inH = hi ? midH : runH;
                runA = midA * a1; runH = a1 * midH + h1;
#pragma unroll
                for (int e = 0; e < 4; ++e) { const int r = 4 * q + e; acc[1][nt][r] += acc[0][nt][r] * inH; acc[0][nt][r] *= inA; } }
            if (hi == 0) { SUM[(wave * 64 + 32 * nt + r32) * 2] = runA; SUM[(wave * 64 + 32 * nt + r32) * 2 + 1] = runH; } }
        __syncthreads();
#pragma unroll
        for (int nt = 0; nt < 2; ++nt) { const int cl = 32 * nt + r32;
            float ca = 1.f, chh = 0.f;
            for (int w = 0; w < wave; ++w) { const float aw = SUM[(w * 64 + cl) * 2], hw = SUM[(w * 64 + cl) * 2 + 1]; chh = aw * chh + hw; ca *= aw; }
            GAS unsigned* ha = P.HA + (size_t)(t0 + 32 * wave + 4 * hi) * 512 + 64 * g + cl;
#pragma unroll
            for (int r = 0; r < 16; ++r) { const float hh = acc[1][nt][r] + acc[0][nt][r] * chh, ac_ = acc[0][nt][r] * ca; ha[(size_t)((r & 3) + 8 * (r >> 2)) * 512] = pk2(hh, ac_);
                if (r == 15 && wave == 7 && hi == 1) { P.LSUM[((size_t)tile * 512 + 64 * g + cl) * 2] = ac_; P.LSUM[((size_t)tile * 512 + 64 * g + cl) * 2 + 1] = hh; } } }
    }
}

struct PostP { const GAS bf16* OMB; const GAS unsigned* HA; const GAS float* LSUM; const GAS bf16* PROJB; const GAS float* gm; const GAS float* gl; GAS bf16* Y; };
__device__ __forceinline__ void post_phase(const PostP& P, LAS unsigned char* lds, int tid, int wave, int lane, int vcu, int G) {
    asm volatile("" : "+v"(tid), "+v"(lane));
    LAS float* hin = (LAS float*)lds;
    for (int u = vcu; u < T / 64; u += G) {
        const int t0 = u * 64, tile = t0 >> 8, tb = tile & ~31;
        __syncthreads();
        { float h = 0.f;
          for (int c0 = tb; c0 < tile; c0 += 8) {
              float av_[8], hv_[8];
#pragma unroll
              for (int i = 0; i < 8; ++i) { const int c = (c0 + i < tile) ? (c0 + i) : tb; av_[i] = P.LSUM[((size_t)c * 512 + tid) * 2]; hv_[i] = P.LSUM[((size_t)c * 512 + tid) * 2 + 1]; }
#pragma unroll
              for (int i = 0; i < 8; ++i) { if (c0 + i < tile) h = av_[i] * h + hv_[i]; } }
          hin[tid] = h; }
        __syncthreads();
        f32x4 hi0 = *(const LAS f32x4*)(hin + 8 * lane), hi1 = *(const LAS f32x4*)(hin + 8 * lane + 4);
        const f32x4 g0 = *(const GAS f32x4*)(P.gl + 8 * lane), g1 = *(const GAS f32x4*)(P.gl + 8 * lane + 4), gmv = *(const GAS f32x4*)(P.gm + 4 * lane);
#pragma unroll 2
        for (int i = 0; i < 8; ++i) {
            const size_t t = (size_t)t0 + 8 * wave + i;
            const v4u p0 = *(const GAS v4u*)(P.HA + t * 512 + 8 * lane), p1 = *(const GAS v4u*)(P.HA + t * 512 + 8 * lane + 4), gw_ = *(const GAS v4u*)(P.PROJB + t * INP + PC_GL + 8 * lane);
            const v2u mw = *(const GAS v2u*)(P.OMB + t * 256 + 4 * lane);
            float o[8];
            o[0] = (bflo(p0.x) + bfhi(p0.x) * hi0.x) * gelu_erf(bflo(gw_.x)); o[1] = (bflo(p0.y) + bfhi(p0.y) * hi0.y) * gelu_erf(bfhi(gw_.x));
            o[2] = (bflo(p0.z) + bfhi(p0.z) * hi0.z) * gelu_erf(bflo(gw_.y)); o[3] = (bflo(p0.w) + bfhi(p0.w) * hi0.w) * gelu_erf(bfhi(gw_.y));
            o[4] = (bflo(p1.x) + bfhi(p1.x) * hi1.x) * gelu_erf(bflo(gw_.z)); o[5] = (bflo(p1.y) + bfhi(p1.y) * hi1.y) * gelu_erf(bfhi(gw_.z));
            o[6] = (bflo(p1.z) + bfhi(p1.z) * hi1.z) * gelu_erf(bflo(gw_.w)); o[7] = (bflo(p1.w) + bfhi(p1.w) * hi1.w) * gelu_erf(bfhi(gw_.w));
            float s2 = 0.f;
#pragma unroll
            for (int e = 0; e < 8; ++e) s2 += o[e] * o[e];
            const float m0 = bflo(mw.x), m1 = bfhi(mw.x), m2 = bflo(mw.y), m3 = bfhi(mw.y);
            float s1 = (m0 * m0 + m1 * m1) + (m2 * m2 + m3 * m3);
            s1 = wave_sum(s1, lane); s2 = wave_sum(s2, lane);
            const float r1 = rsqrtf(s1 * (1.f / 256.f) + 1e-6f), r2 = rsqrtf(s2 * (1.f / 512.f) + 1e-6f);
            GAS bf16* yr = P.Y + t * 1024;
            { v2u w; w.x = pk2(m0 * r1 * gmv.x, m1 * r1 * gmv.y); w.y = pk2(m2 * r1 * gmv.z, m3 * r1 * gmv.w); *(GAS v2u*)(yr + 4 * lane) = w; }
            { v4u w; w.x = pk2(o[0] * r2 * g0.x, o[1] * r2 * g0.y); w.y = pk2(o[2] * r2 * g0.z, o[3] * r2 * g0.w); w.z = pk2(o[4] * r2 * g1.x, o[5] * r2 * g1.y); w.w = pk2(o[6] * r2 * g1.z, o[7] * r2 * g1.w);
              *(GAS v4u*)(yr + 256 + 8 * lane) = w; }
        }
    }
}

#define TILE_BAR() asm volatile("s_waitcnt lgkmcnt(0)\n\ts_barrier" ::: "memory")
typedef short bf16x8 __attribute__((ext_vector_type(8)));
typedef short s16x4 __attribute__((ext_vector_type(4)));
typedef float f32x16 __attribute__((ext_vector_type(16)));
typedef unsigned u32x4 __attribute__((ext_vector_type(4)));
__device__ __forceinline__ int crow(int r, int hi) { return (r & 3) + 8 * (r >> 2) + 4 * hi; }
typedef float f32x2_t __attribute__((ext_vector_type(2))); typedef __bf16 bf16x2_c __attribute__((ext_vector_type(2)));
__device__ __forceinline__ unsigned cvtpk(float lo, float hi) { f32x2_t v = {lo, hi}; bf16x2_c b = __builtin_convertvector(v, bf16x2_c); return __builtin_bit_cast(unsigned, b); }
__device__ __forceinline__ float swapmax(float m) { auto rr = __builtin_amdgcn_permlane32_swap(__float_as_uint(m), __float_as_uint(m), false, false); return fmaxf(__uint_as_float(rr[0]), __uint_as_float(rr[1])); }
__device__ __forceinline__ float swapadd(float m) { auto rr = __builtin_amdgcn_permlane32_swap(__float_as_uint(m), __float_as_uint(m), false, false); return __uint_as_float(rr[0]) + __uint_as_float(rr[1]); }
__device__ __forceinline__ s16x4 vtr(const LAS unsigned char* p) { return __builtin_bit_cast(s16x4, __builtin_amdgcn_ds_read_tr16_b64_v4i16((LAS s16x4*)p)); }
__device__ __forceinline__ bf16x8 pack8(const f32x16& p, int b) { u32x4 w; w.x = cvtpk(p[b], p[b + 1]); w.y = cvtpk(p[b + 2], p[b + 3]); w.z = cvtpk(p[b + 4], p[b + 5]); w.w = cvtpk(p[b + 6], p[b + 7]); return __builtin_bit_cast(bf16x8, w); }
__device__ __forceinline__ float vmax3(float a, float b, float c) { float r; asm("v_max3_f32 %0, %1, %2, %3" : "=v"(r) : "v"(a), "v"(b), "v"(c)); return r; }
__device__ __forceinline__ float max32(const f32x16& p, const f32x16& q) {
    float a = vmax3(p[0], p[1], p[2]), b = vmax3(p[3], p[4], p[5]), c = vmax3(p[6], p[7], p[8]), d = vmax3(p[9], p[10], p[11]), e = vmax3(p[12], p[13], p[14]);
    float f = vmax3(q[0], q[1], q[2]), g = vmax3(q[3], q[4], q[5]), h = vmax3(q[6], q[7], q[8]), i = vmax3(q[9], q[10], q[11]), j = vmax3(q[12], q[13], q[14]);
    a = vmax3(a, b, c); d = vmax3(d, e, p[15]); f = vmax3(f, g, h); i = vmax3(i, j, q[15]);
    return vmax3(vmax3(a, d, f), i, i);
}
__device__ __forceinline__ float max16(const f32x16& p) { float a = fmaxf(fmaxf(p[0], p[1]), fmaxf(p[2], p[3])), b = fmaxf(fmaxf(p[4], p[5]), fmaxf(p[6], p[7])), c = fmaxf(fmaxf(p[8], p[9]), fmaxf(p[10], p[11])), d = fmaxf(fmaxf(p[12], p[13]), fmaxf(p[14], p[15])); return fmaxf(fmaxf(a, b), fmaxf(c, d)); }

struct AttnP {
    const GAS bf16* Q; const GAS bf16* K; const GAS bf16* V; int qp, kp, vp;
    GAS bf16* O; int op;
    const GAS float* rope;
    const GAS int* pos; const GAS float* btab; const GAS float* dnorm; const GAS float* lams;
};
template <int KIND> struct AK {
    static constexpr bool DIFF = KIND == 1, CROSS = KIND == 2;
    static constexpr int HW = KIND == 0 ? 96 : KIND == 1 ? 64 : 256;
    static constexpr int NKS = KIND == 0 ? 6 : KIND == 1 ? 2 : 16;
    static constexpr int KP = KIND == 0 ? 208 : KIND == 1 ? 144 : 528;
    static constexpr int ND = CROSS ? 4 : 2;
    static constexpr int CPK = HW / 8, KCH = (64 * CPK + 511) / 512;
    static constexpr int VCH = ND / 2;
    static constexpr int KB = 64 * KP, VB = ND * 4096;
    static constexpr int NBUF = CROSS ? 2 : 3;
    static constexpr int K0 = 0, V0 = NBUF * KB, POS = V0 + NBUF * VB, BT = POS + 1024, DN = BT + 528, END = DN + 256;
};
static_assert(AK<2>::END <= RING_BYTES && AK<0>::END <= RING_BYTES && AK<1>::END + 16 + 8 * 8192 <= RING_BYTES, "attention LDS");

template <int KIND, bool LEAD>
__device__ __forceinline__ void attn_unit(const AttnP& P, int b, int h, int qb, int dhalf, LAS unsigned char* lds, int tid, int wave, int lane) {
    lane = lane_id_v(); tid = (wave << 6) | lane;
    typedef AK<KIND> C;
    constexpr bool DIFF = C::DIFF, CROSS = C::CROSS;
    constexpr int HW = C::HW, NKS = C::NKS, KP = C::KP, ND = C::ND, CPK = C::CPK, KCH = C::KCH, VCH = C::VCH;
    const int r32 = lane & 31, hi = lane >> 5;
    const size_t rowb = (size_t)b * S, rowk = CROSS ? (size_t)b * MEM : rowb;
    const int q0w = qb * 256 + wave * 32, qi = q0w + r32;
    int pq = 0; float bias_far = 0.f;
    __syncthreads();
    if (DIFF) {
        pq = P.pos[rowb + qi];
        if (tid < 129) ((LAS float*)(lds + C::BT))[tid] = P.btab[h * 129 + tid];
        if (tid >= 192 && tid < 256) ((LAS float*)(lds + C::DN))[tid - 192] = P.dnorm[tid - 192];
    }
    int minq = pq;
    if (DIFF) { for (int o = 1; o < 64; o <<= 1) { const int v = shxi(minq, o, lane); minq = v < minq ? v : minq; } }
    const int NT = CROSS ? MEM / 64 : 4 * (qb + 1);
    u32x4 kr[KCH], vr[VCH]; int pkr = 0;
    u32x4 kr2[CROSS ? 1 : KCH], vr2[CROSS ? 1 : VCH]; int pkr2 = 0;
    const GAS bf16* Kb = P.K + rowk * P.kp + h * HW; const GAS bf16* Vb = P.V + rowk * P.vp + (CROSS ? h * 256 + dhalf * 128 : h * 64);
    const __amdgpu_buffer_rsrc_t rK = __builtin_amdgcn_make_buffer_rsrc((void*)Kb, 0, 0x7fffffff, 0x00020000), rV = __builtin_amdgcn_make_buffer_rsrc((void*)Vb, 0, 0x7fffffff, 0x00020000);
    const __amdgpu_buffer_rsrc_t rP = __builtin_amdgcn_make_buffer_rsrc((void*)(DIFF ? P.pos + rowb : (const GAS int*)Kb), 0, 0x7fffffff, 0x00020000);
    int kvo[KCH], vvo[VCH];
#pragma unroll
    for (int i = 0; i < KCH; ++i) { int c = tid + 512 * i; c = c < 64 * CPK ? c : tid; kvo[i] = ((c / CPK) * P.kp + (c % CPK) * 8) * 2; }
#pragma unroll
    for (int i = 0; i < VCH; ++i) { const int c = tid + 512 * i; vvo[i] = ((c / (4 * ND)) * P.vp + (c % (4 * ND)) * 8) * 2; }
    const int pvo = (tid & 63) * 4;
    auto gload = [&](int t) {
        const int ks = __builtin_amdgcn_readfirstlane(64 * t * P.kp * 2), vs = __builtin_amdgcn_readfirstlane(64 * t * P.vp * 2);
#pragma unroll
        for (int i = 0; i < KCH; ++i) kr[i] = __builtin_amdgcn_raw_buffer_load_b128(rK, kvo[i], ks, 0);
#pragma unroll
        for (int i = 0; i < VCH; ++i) vr[i] = __builtin_amdgcn_raw_buffer_load_b128(rV, vvo[i], vs, 0);
        if (DIFF) pkr = __builtin_amdgcn_raw_buffer_load_b32(rP, pvo, __builtin_amdgcn_readfirstlane(64 * t * 4), 0);
    };
    auto lstore = [&](int buf) {
        LAS unsigned char* kb_ = lds + C::K0 + buf * C::KB; LAS unsigned char* vb_ = lds + C::V0 + buf * C::VB;
#pragma unroll
        for (int i = 0; i < KCH; ++i) { int c = tid + 512 * i; c = c < 64 * CPK ? c : tid; const int key = c / CPK, part = c % CPK; *(LAS u32x4*)(kb_ + key * KP + part * 16) = kr[i]; }
#pragma unroll
        for (int i = 0; i < VCH; ++i) { const int c = tid + 512 * i; const int key = c / (4 * ND), part = c % (4 * ND); *(LAS u32x4*)(vb_ + (part >> 2) * 4096 + (key >> 3) * 512 + (key & 7) * 64 + (part & 3) * 16) = vr[i]; }
        if (DIFF) { ((LAS int*)(lds + C::POS + buf * 256))[tid & 63] = pkr; if (tid < 64) { int mk_ = pkr; for (int o = 1; o < 64; o <<= 1) { const int v = shxi(mk_, o, lane); mk_ = v > mk_ ? v : mk_; } if (tid == 0) ((LAS int*)(lds + C::POS + 768))[buf] = mk_; } }
    };
    auto gloadB = [&](int t) {
        const int ks = __builtin_amdgcn_readfirstlane(64 * t * P.kp * 2), vs = __builtin_amdgcn_readfirstlane(64 * t * P.vp * 2);
#pragma unroll
        for (int i = 0; i < (CROSS ? 1 : KCH); ++i) kr2[i] = __builtin_amdgcn_raw_buffer_load_b128(rK, kvo[i], ks, 0);
#pragma unroll
        for (int i = 0; i < (CROSS ? 1 : VCH); ++i) vr2[i] = __builtin_amdgcn_raw_buffer_load_b128(rV, vvo[i], vs, 0);
        if (DIFF) pkr2 = __builtin_amdgcn_raw_buffer_load_b32(rP, pvo, __builtin_amdgcn_readfirstlane(64 * t * 4), 0);
    };
    auto lstoreB = [&](int buf) {
        LAS unsigned char* kb_ = lds + C::K0 + buf * C::KB; LAS unsigned char* vb_ = lds + C::V0 + buf * C::VB;
#pragma unroll
        for (int i = 0; i < (CROSS ? 1 : KCH); ++i) { int c = tid + 512 * i; c = c < 64 * CPK ? c : tid; const int key = c / CPK, part = c % CPK; *(LAS u32x4*)(kb_ + key * KP + part * 16) = kr2[i]; }
#pragma unroll
        for (int i = 0; i < (CROSS ? 1 : VCH); ++i) { const int c = tid + 512 * i; const int key = c / (4 * ND), part = c % (4 * ND); *(LAS u32x4*)(vb_ + (part >> 2) * 4096 + (key >> 3) * 512 + (key & 7) * 64 + (part & 3) * 16) = vr2[i]; }
        if (DIFF) { ((LAS int*)(lds + C::POS + buf * 256))[tid & 63] = pkr2; if (tid < 64) { int mk_ = pkr2; for (int o = 1; o < 64; o <<= 1) { const int v = shxi(mk_, o, lane); mk_ = v > mk_ ? v : mk_; } if (tid == 0) ((LAS int*)(lds + C::POS + 768))[buf] = mk_; } }
    };
    LAS float* osv = (LAS float*)(lds + ((C::END + 15) & ~15)) + wave * 2048 + lane;
    float il = 0.f;
    f32x16 oA[ND];
#pragma unroll 1
    for (int mp = 0; mp < (DIFF ? 2 : 1); ++mp) {
        bf16x8 qf[NKS];
        { const GAS bf16* qrow = P.Q + (rowb + qi) * P.qp + h * HW + mp * 32;
#pragma unroll
          for (int s = 0; s < NKS; ++s) qf[s] = *(const GAS bf16x8*)(qrow + 16 * s + 8 * hi);
          if (KIND == 0) {
              const GAS float* rp = P.rope + (rowb + qi) * 32 + 8 * hi;
              const f32x4 c0 = *(const GAS f32x4*)rp, c1 = *(const GAS f32x4*)(rp + 4), s0 = *(const GAS f32x4*)(rp + 16), s1 = *(const GAS f32x4*)(rp + 20);
              const u32x4 a = __builtin_bit_cast(u32x4, qf[NKS - 2]), bq = __builtin_bit_cast(u32x4, qf[NKS - 1]); u32x4 ra, rb;
#pragma unroll
              for (int w = 0; w < 4; ++w) { const float cl = w < 2 ? c0[2 * w] : c1[2 * w - 4], ch = w < 2 ? c0[2 * w + 1] : c1[2 * w - 3], sl = w < 2 ? s0[2 * w] : s1[2 * w - 4], sh = w < 2 ? s0[2 * w + 1] : s1[2 * w - 3];
                  const float x1l = bflo(a[w]), x1h = bfhi(a[w]), x2l = bflo(bq[w]), x2h = bfhi(bq[w]);
                  ra[w] = cvtpk(x1l * cl - x2l * sl, x1h * ch - x2h * sh); rb[w] = cvtpk(x1l * sl + x2l * cl, x1h * sh + x2h * ch); }
              qf[NKS - 2] = __builtin_bit_cast(bf16x8, ra); qf[NKS - 1] = __builtin_bit_cast(bf16x8, rb);
          } }
        __syncthreads();
        float m1 = -1e30f, l1 = 0.f;
#pragma unroll
        for (int d = 0; d < ND; ++d)
#pragma unroll
            for (int r = 0; r < 16; ++r) oA[d][r] = 0.f;
        auto qk = [&](int sl, f32x16& sa, f32x16& sb, float init) {
            const LAS unsigned char* kb_ = lds + C::K0 + sl * C::KB + r32 * KP + hi * 16 + mp * 64;
#pragma unroll
            for (int r = 0; r < 16; ++r) { sa[r] = init; sb[r] = init; }
            constexpr int HB = CROSS ? 4 : (NKS > 3 ? 3 : NKS);
#pragma unroll
            for (int s0_ = 0; s0_ < NKS; s0_ += HB) {
                bf16x8 kfa[HB], kfb[HB];
#pragma unroll
                for (int s = 0; s < HB; ++s) { kfa[s] = *(const LAS bf16x8*)(kb_ + (s0_ + s) * 32); kfb[s] = *(const LAS bf16x8*)(kb_ + 32 * KP + (s0_ + s) * 32); }
                __builtin_amdgcn_sched_barrier(0);
#pragma unroll
                for (int s = 0; s < HB; ++s) { sa = __builtin_amdgcn_mfma_f32_32x32x16_bf16(kfa[s], qf[s0_ + s], sa, 0, 0, 0); sb = __builtin_amdgcn_mfma_f32_32x32x16_bf16(kfb[s], qf[s0_ + s], sb, 0, 0, 0); }
                __builtin_amdgcn_sched_barrier(0);
            }
        };
        auto isnear = [&](int sl) { bool nb = false;
            if (DIFF) { const int mk_ = __builtin_amdgcn_readfirstlane(((LAS int*)(lds + C::POS + 768))[sl]); nb = (minq - mk_) < 128; }
            return nb; };
        auto sm = [&](int t, int sl, f32x16& pa, f32x16& pb, bool nearb) -> float {
            const int k0 = 64 * t;
            if (DIFF) { if (nearb) {
                const LAS int* pk = (const LAS int*)(lds + C::POS + sl * 256); const LAS float* bt = (const LAS float*)(lds + C::BT);
#pragma unroll
                for (int r = 0; r < 16; ++r) { const int kk = crow(r, hi);
                    int n0 = pq - pk[kk], n1 = pq - pk[kk + 32]; n0 = n0 < 0 ? 0 : (n0 > 128 ? 128 : n0); n1 = n1 < 0 ? 0 : (n1 > 128 ? 128 : n1);
                    pa[r] += bt[n0]; pb[r] += bt[n1]; }
            } }
            if (!CROSS && k0 + 63 > q0w) {
#pragma unroll
                for (int r = 0; r < 16; ++r) { const int kk = k0 + crow(r, hi); if (kk > qi) pa[r] = -1e30f; if (kk + 32 > qi) pb[r] = -1e30f; }
            }
            asm volatile("s_nop 15\n\ts_nop 7" : "+v"(pa), "+v"(pb));
            float mn, al = 1.f;
            if (CROSS) { const float mx = swapmax(max32(pa, pb)); mn = fmaxf(m1, mx); al = __builtin_amdgcn_exp2f(m1 - mn); l1 *= al; }
            else { const float mx = swapmax(max32(pa, pb)); const bool up = mx > m1 + 8.0f; mn = up ? mx : m1;
                   if (__builtin_amdgcn_ballot_w64(up) != 0ull) { al = __builtin_amdgcn_exp2f(m1 - mn); l1 *= al; } }
            m1 = mn;
            float ls = 0.f;
#pragma unroll
            for (int r = 0; r < 16; ++r) { pa[r] = __builtin_amdgcn_exp2f(pa[r] - mn); pb[r] = __builtin_amdgcn_exp2f(pb[r] - mn); ls += pa[r] + pb[r]; }
            l1 += ls;
            return al;
        };
        auto pv = [&](int sl, const f32x16& pa, const f32x16& pb, float al) {
            const LAS unsigned char* vb_ = lds + C::V0 + sl * C::VB + ((lane >> 4) & 1) * 32 + (lane & 3) * 8 + (4 * hi + ((lane & 15) >> 2)) * 64;
            bf16x8 pf[4];
            pf[0] = pack8(pa, 0); pf[1] = pack8(pa, 8); pf[2] = pack8(pb, 0); pf[3] = pack8(pb, 8);
            const bool resc = CROSS ? true : (__builtin_amdgcn_ballot_w64(al != 1.0f) != 0ull);
            if (CROSS) {
#pragma unroll
                for (int d = 0; d < ND; ++d) {
                    __builtin_amdgcn_sched_barrier(0);
#pragma unroll
                    for (int r = 0; r < 16; ++r) oA[d][r] *= al;
                    bf16x8 vf[4];
#pragma unroll
                    for (int s = 0; s < 4; ++s) { const s16x4 lo = vtr(vb_ + d * 4096 + s * 1024), hh = vtr(vb_ + d * 4096 + s * 1024 + 512); vf[s] = (bf16x8){lo[0], lo[1], lo[2], lo[3], hh[0], hh[1], hh[2], hh[3]}; }
#pragma unroll
                    for (int s = 0; s < 4; ++s) oA[d] = __builtin_amdgcn_mfma_f32_32x32x16_bf16(vf[s], pf[s], oA[d], 0, 0, 0);
                }
            } else if (DIFF) {
                if (resc) {
#pragma unroll
                    for (int d = 0; d < 2; ++d)
#pragma unroll
                        for (int r = 0; r < 16; ++r) oA[d][r] *= al;
                }
#pragma unroll
                for (int d = 0; d < 2; ++d) {
                    bf16x8 vf[4];
#pragma unroll
                    for (int s = 0; s < 4; ++s) { const s16x4 lo = vtr(vb_ + d * 4096 + s * 1024), hh = vtr(vb_ + d * 4096 + s * 1024 + 512); vf[s] = (bf16x8){lo[0], lo[1], lo[2], lo[3], hh[0], hh[1], hh[2], hh[3]}; }
                    __builtin_amdgcn_sched_barrier(0);
#pragma unroll
                    for (int s = 0; s < 4; ++s) oA[d] = __builtin_amdgcn_mfma_f32_32x32x16_bf16(vf[s], pf[s], oA[d], 0, 0, 0);
                }
            } else {
                bf16x8 vf[2][4];
#pragma unroll
                for (int d = 0; d < 2; ++d)
#pragma unroll
                    for (int s = 0; s < 4; ++s) { const s16x4 lo = vtr(vb_ + d * 4096 + s * 1024), hh = vtr(vb_ + d * 4096 + s * 1024 + 512); vf[d][s] = (bf16x8){lo[0], lo[1], lo[2], lo[3], hh[0], hh[1], hh[2], hh[3]}; }
                if (resc) {
#pragma unroll
                    for (int d = 0; d < 2; ++d)
#pragma unroll
                        for (int r = 0; r < 16; ++r) oA[d][r] *= al;
                }
                __builtin_amdgcn_sched_barrier(0);
#pragma unroll
                for (int s = 0; s < 4; ++s)
#pragma unroll
                    for (int d = 0; d < 2; ++d) oA[d] = __builtin_amdgcn_mfma_f32_32x32x16_bf16(vf[d][s], pf[s], oA[d], 0, 0, 0);
            }
        };
        if (CROSS) {
            gload(0); lstore(0);
            __syncthreads();
            for (int t = 0; t < NT; ++t) {
                const int buf = t & 1;
                f32x16 pa, pb;
                qk(buf, pa, pb, 0.f);
                const float al = sm(t, buf, pa, pb, false);
                pv(buf, pa, pb, al);
                if (t + 1 < NT) { gload(t + 1); lstore(buf ^ 1); }
                TILE_BAR();
            }
        } else {
            gload(0); lstore(0); gload(1); lstore(1);
            gload(2); gloadB(3);
            __syncthreads();
            if (DIFF) bias_far = ((LAS float*)(lds + C::BT))[128];
            const int NTW = (q0w + 31) / 64 + 1;
            constexpr bool lead = LEAD;
            f32x16 ca, cb, na, nb; bool cnear = isnear(0), nnear = false; float cal = 1.f;
            qk(0, ca, cb, (DIFF && !cnear) ? bias_far : 0.f);
            if (lead) cal = sm(0, 0, ca, cb, cnear);
            int s0 = 0, s1 = 1, s2 = 2;
            auto period = [&](int t, f32x16& xa, f32x16& xb, bool& xnear, f32x16& ya, f32x16& yb, bool& ynear) {
                const bool have_next = (t + 1 < NTW);
                if (lead) {
                    if (have_next) { ynear = isnear(s1); qk(s1, ya, yb, (DIFF && !ynear) ? bias_far : 0.f); }
                    if (t < NTW) pv(s0, xa, xb, cal);
                    if (have_next) cal = sm(t + 1, s1, ya, yb, ynear);
                } else {
                    if (t < NTW) cal = sm(t, s0, xa, xb, xnear);
                    if (have_next) { ynear = isnear(s1); qk(s1, ya, yb, (DIFF && !ynear) ? bias_far : 0.f); }
                    if (t < NTW) pv(s0, xa, xb, cal);
                }
                { const int tmp = s0; s0 = s1; s1 = s2; s2 = tmp; }
            };
            int t = 0;
            for (; t + 5 < NT; t += 2) {
                lstore(s2); gload(t + 4);
                period(t, ca, cb, cnear, na, nb, nnear);
                TILE_BAR();
                lstoreB(s2); gloadB(t + 5);
                period(t + 1, na, nb, nnear, ca, cb, cnear);
                TILE_BAR();
            }
            for (; t < NT; t += 2) {
                if (t + 2 < NT) { lstore(s2); if (t + 4 < NT) gload(t + 4); }
                period(t, ca, cb, cnear, na, nb, nnear);
                TILE_BAR();
                if (t + 3 < NT) { lstoreB(s2); if (t + 5 < NT) gloadB(t + 5); }
                period(t + 1, na, nb, nnear, ca, cb, cnear);
                TILE_BAR();
            }
        }
        il = 1.f / swapadd(l1);
        if (DIFF) { if (mp == 0) {
#pragma unroll
            for (int d = 0; d < 2; ++d)
#pragma unroll
                for (int r = 0; r < 16; ++r) osv[(d * 16 + r) * 64] = oA[d][r] * il; } }
    }
    GAS bf16* orow = P.O + (rowb + qi) * P.op + (CROSS ? h * 256 + dhalf * 128 : h * 64);
    if (!DIFF) {
#pragma unroll
        for (int d = 0; d < ND; ++d)
#pragma unroll
            for (int g = 0; g < 4; ++g) { v2u v; v.x = cvtpk(oA[d][4 * g] * il, oA[d][4 * g + 1] * il); v.y = cvtpk(oA[d][4 * g + 2] * il, oA[d][4 * g + 3] * il); *(GAS v2u*)(orow + 32 * d + 8 * g + 4 * hi) = v; }
    } else {
        const float lam = P.lams[0], lam_init = P.lams[1];
        const float i2 = lam * il;
        float ss = 0.f;
#pragma unroll
        for (int d = 0; d < 2; ++d)
#pragma unroll
            for (int r = 0; r < 16; ++r) { const float v = osv[(d * 16 + r) * 64] - oA[d][r] * i2; oA[d][r] = v; ss += v * v; }
        ss = swapadd(ss);
        const float rs = __builtin_amdgcn_rsqf(ss * (1.f / 64.f) + 1e-6f) * (1.f - lam_init);
        const LAS float* dn = (const LAS float*)(lds + C::DN);
#pragma unroll
        for (int d = 0; d < 2; ++d)
#pragma unroll
            for (int g = 0; g < 4; ++g) { const int c = 32 * d + 8 * g + 4 * hi; const f32x4 gn = *(const LAS f32x4*)(dn + c);
                v2u v; v.x = cvtpk(oA[d][4 * g] * rs * gn[0], oA[d][4 * g + 1] * rs * gn[1]); v.y = cvtpk(oA[d][4 * g + 2] * rs * gn[2], oA[d][4 * g + 3] * rs * gn[3]); *(GAS v2u*)(orow + c) = v; }
    }
}

__device__ __forceinline__ int wave_max_i(int v) {
    { const int o = __builtin_amdgcn_update_dpp(0, v, 0xB1, 0xF, 0xF, true); v = o > v ? o : v; }
    { const int o = __builtin_amdgcn_update_dpp(0, v, 0x4E, 0xF, 0xF, true); v = o > v ? o : v; }
    { const int o = __builtin_amdgcn_update_dpp(0, v, 0x141, 0xF, 0xF, true); v = o > v ? o : v; }
    { const int o = __builtin_amdgcn_update_dpp(0, v, 0x140, 0xF, 0xF, true); v = o > v ? o : v; }
    { int a = v, b = v; asm volatile("v_nop\n\tv_nop\n\tv_permlane16_swap_b32 %0, %1" : "+v"(a), "+v"(b)); v = a > b ? a : b; }
    { int a = v, b = v; asm volatile("v_nop\n\tv_nop\n\tv_permlane32_swap_b32 %0, %1" : "+v"(a), "+v"(b)); v = a > b ? a : b; }
    return v;
}
template <int KIND> struct AK2 {
    static constexpr bool DIFF = KIND == 1;
    static constexpr int HW = KIND == 0 ? 96 : 64, NKS = KIND == 0 ? 6 : 2, KP = KIND == 0 ? 208 : 144;
    static constexpr int CPK = HW / 8, KCH = (128 * CPK) / 512, VCH = 2;
    static constexpr int KB = 128 * KP, VB = 2 * 8192;
    static constexpr int K0 = 0, V0 = 2 * KB, POS = V0 + 2 * VB, PMX = POS + 1024, BT = PMX + 16, DN = BT + 528, OSV = (DN + 256 + 15) & ~15, END = OSV + (DIFF ? 8 * 8192 : 0);
};
static_assert(AK2<0>::END <= RING_BYTES && AK2<1>::END <= RING_BYTES, "attention LDS (128-key tiles)");
template <int KIND>
__device__ __forceinline__ void attn_unit2(const AttnP& P, int b, int h, int qb, LAS unsigned char* lds, int tid, int wave, int lane) {
    lane = lane_id_v(); tid = (wave << 6) | lane;
    typedef AK2<KIND> C;
    constexpr bool DIFF = C::DIFF;
    constexpr int HW = C::HW, NKS = C::NKS, KP = C::KP, CPK = C::CPK, KCH = C::KCH, VCH = C::VCH;
    const int r32 = lane & 31, hi = lane >> 5;
    const size_t rowb = (size_t)b * S;
    const int q0w = qb * 256 + wave * 32, qi = q0w + r32;
    int pq = 0; float bias_far = 0.f;
    __syncthreads();
    if (DIFF) {
        pq = P.pos[rowb + qi];
        if (tid < 129) ((LAS float*)(lds + C::BT))[tid] = P.btab[h * 129 + tid];
        if (tid >= 192 && tid < 256) ((LAS float*)(lds + C::DN))[tid - 192] = P.dnorm[tid - 192];
    }
    int minq = pq;
    if (DIFF) minq = __builtin_amdgcn_readfirstlane(-wave_max_i(-pq));
    const int NT = 2 * (qb + 1);
    const GAS bf16* Kb = P.K + rowb * P.kp + h * HW; const GAS bf16* Vb = P.V + rowb * P.vp + h * 64;
    const __amdgpu_buffer_rsrc_t rK = __builtin_amdgcn_make_buffer_rsrc((void*)Kb, 0, 0x7fffffff, 0x00020000), rV = __builtin_amdgcn_make_buffer_rsrc((void*)Vb, 0, 0x7fffffff, 0x00020000);
    const __amdgpu_buffer_rsrc_t rP = __builtin_amdgcn_make_buffer_rsrc((void*)(DIFF ? P.pos + rowb : (const GAS int*)Kb), 0, 0x7fffffff, 0x00020000);
    int kvo[KCH], vvo[VCH], klo[KCH], vlo[VCH];
#pragma unroll
    for (int i = 0; i < KCH; ++i) { const int c = tid + 512 * i; kvo[i] = ((c / CPK) * P.kp + (c % CPK) * 8) * 2; klo[i] = (c / CPK) * KP + (c % CPK) * 16; }
#pragma unroll
    for (int i = 0; i < VCH; ++i) { const int c = tid + 512 * i; const int key = c >> 3, part = c & 7; vvo[i] = (key * P.vp + part * 8) * 2; vlo[i] = (part >> 2) * 8192 + (key >> 3) * 512 + (key & 7) * 64 + (part & 3) * 16; }
    const int pvo = (tid & 127) * 4;
    u32x4 kr[KCH], vr[VCH]; int pkr = 0;
    auto gload = [&](int t) {
        const int ks = __builtin_amdgcn_readfirstlane(128 * t * P.kp * 2), vs = __builtin_amdgcn_readfirstlane(128 * t * P.vp * 2);
#pragma unroll
        for (int i = 0; i < KCH; ++i) kr[i] = __builtin_amdgcn_raw_buffer_load_b128(rK, kvo[i], ks, 0);
#pragma unroll
        for (int i = 0; i < VCH; ++i) vr[i] = __builtin_amdgcn_raw_buffer_load_b128(rV, vvo[i], vs, 0);
        if (DIFF) pkr = __builtin_amdgcn_raw_buffer_load_b32(rP, pvo, __builtin_amdgcn_readfirstlane(128 * t * 4), 0);
    };
    auto lstore = [&](int buf) {
        LAS unsigned char* kb_ = lds + C::K0 + buf * C::KB; LAS unsigned char* vb_ = lds + C::V0 + buf * C::VB;
#pragma unroll
        for (int i = 0; i < KCH; ++i) *(LAS u32x4*)(kb_ + klo[i]) = kr[i];
#pragma unroll
        for (int i = 0; i < VCH; ++i) *(LAS u32x4*)(vb_ + vlo[i]) = vr[i];
        if (DIFF) { ((LAS int*)(lds + C::POS + buf * 512))[tid & 127] = pkr;
            if (tid < 128) { const int mk_ = wave_max_i(pkr); if (lane == 0) ((LAS int*)(lds + C::PMX))[buf * 2 + wave] = mk_; } }
    };
    LAS float* osv = (LAS float*)(lds + C::OSV) + wave * 2048 + lane;
    float il = 0.f;
    f32x16 oA[2];
#pragma unroll 1
    for (int mp = 0; mp < (DIFF ? 2 : 1); ++mp) {
        bf16x8 qf[NKS];
        { const GAS bf16* qrow = P.Q + (rowb + qi) * P.qp + h * HW + mp * 32;
#pragma unroll
          for (int s = 0; s < NKS; ++s) qf[s] = *(const GAS bf16x8*)(qrow + 16 * s + 8 * hi);
          if (KIND == 0) {
              const GAS float* rp = P.rope + (rowb + qi) * 32 + 8 * hi;
              const f32x4 c0 = *(const GAS f32x4*)rp, c1 = *(const GAS f32x4*)(rp + 4), s0 = *(const GAS f32x4*)(rp + 16), s1 = *(const GAS f32x4*)(rp + 20);
              const u32x4 a = __builtin_bit_cast(u32x4, qf[NKS - 2]), bq = __builtin_bit_cast(u32x4, qf[NKS - 1]); u32x4 ra, rb;
#pragma unroll
              for (int w = 0; w < 4; ++w) { const float cl = w < 2 ? c0[2 * w] : c1[2 * w - 4], ch = w < 2 ? c0[2 * w + 1] : c1[2 * w - 3], sl = w < 2 ? s0[2 * w] : s1[2 * w - 4], sh = w < 2 ? s0[2 * w + 1] : s1[2 * w - 3];
                  const float x1l = bflo(a[w]), x1h = bfhi(a[w]), x2l = bflo(bq[w]), x2h = bfhi(bq[w]);
                  ra[w] = cvtpk(x1l * cl - x2l * sl, x1h * ch - x2h * sh); rb[w] = cvtpk(x1l * sl + x2l * cl, x1h * sh + x2h * ch); }
              qf[NKS - 2] = __builtin_bit_cast(bf16x8, ra); qf[NKS - 1] = __builtin_bit_cast(bf16x8, rb);
          } }
        __syncthreads();
        float m1 = 0.f, l1 = 0.f;
        f32x16 negm;
#pragma unroll
        for (int r = 0; r < 16; ++r) negm[r] = 0.f;
#pragma unroll
        for (int d = 0; d < 2; ++d)
#pragma unroll
            for (int r = 0; r < 16; ++r) oA[d][r] = 0.f;
        gload(0); lstore(0);
        if (NT > 1) gload(1);
        __syncthreads();
        if (DIFF) { bias_far = ((LAS float*)(lds + C::BT))[128];
#pragma unroll
            for (int r = 0; r < 16; ++r) negm[r] = bias_far; }
        const int NTW = (q0w + 31) / 128 + 1;
        auto compute = [&](int t, int buf) {
            const int k0 = 128 * t;
            const LAS unsigned char* kb_ = lds + C::K0 + buf * C::KB + r32 * KP + hi * 16 + mp * 64;
            const LAS unsigned char* vb_ = lds + C::V0 + buf * C::VB + ((lane >> 4) & 1) * 32 + (lane & 3) * 8 + (4 * hi + ((lane & 15) >> 2)) * 64;
            bool nearb = false;
            if (DIFF) { const LAS int* pm = (const LAS int*)(lds + C::PMX) + buf * 2; const int m0 = __builtin_amdgcn_readfirstlane(pm[0]), m1_ = __builtin_amdgcn_readfirstlane(pm[1]); nearb = (minq - (m0 > m1_ ? m0 : m1_)) < 128; }
            f32x16 sc[4];
            if (DIFF) { if (nearb) {
#pragma unroll
                for (int g = 0; g < 4; ++g)
#pragma unroll
                    for (int r = 0; r < 16; ++r) sc[g][r] = -m1; } }
            if (!DIFF) {
                bf16x8 kq[4 * NKS];
#pragma unroll
                for (int i = 0; i < 4 * NKS; ++i) kq[i] = *(const LAS bf16x8*)(kb_ + 32 * (i & 3) * KP + (i >> 2) * 32);
#pragma unroll
                for (int i = 0; i < 4 * NKS; ++i) sc[i & 3] = __builtin_amdgcn_mfma_f32_32x32x16_bf16(kq[i], qf[i >> 2], i < 4 ? negm : sc[i & 3], 0, 0, 0);
                __builtin_amdgcn_sched_group_barrier(0x100, 4, 0);
#pragma unroll
                for (int i = 0; i < 4 * NKS - 4; ++i) { __builtin_amdgcn_sched_group_barrier(0x008, 1, 0); __builtin_amdgcn_sched_group_barrier(0x100, 1, 0); }
                __builtin_amdgcn_sched_group_barrier(0x008, 4, 0);
                __builtin_amdgcn_sched_barrier(0);
            } else {
            constexpr int HB = NKS > 3 ? 3 : NKS;
#pragma unroll
            for (int s0_ = 0; s0_ < NKS; s0_ += HB) {
                bf16x8 kf[4][HB];
#pragma unroll
                for (int g = 0; g < 4; ++g)
#pragma unroll
                    for (int s = 0; s < HB; ++s) kf[g][s] = *(const LAS bf16x8*)(kb_ + 32 * g * KP + (s0_ + s) * 32);
                __builtin_amdgcn_sched_barrier(0);
#pragma unroll
                for (int s = 0; s < HB; ++s)
#pragma unroll
                    for (int g = 0; g < 4; ++g) {
                        if (s0_ + s == 0 && !(DIFF && nearb)) sc[g] = __builtin_amdgcn_mfma_f32_32x32x16_bf16(kf[g][s], qf[s0_ + s], negm, 0, 0, 0);
                        else sc[g] = __builtin_amdgcn_mfma_f32_32x32x16_bf16(kf[g][s], qf[s0_ + s], sc[g], 0, 0, 0); }
                __builtin_amdgcn_sched_barrier(0);
            }
            }
            if (DIFF) { if (nearb) {
                const LAS int* pk = (const LAS int*)(lds + C::POS + buf * 512); const LAS float* bt = (const LAS float*)(lds + C::BT);
#pragma unroll
                for (int g = 0; g < 4; ++g)
#pragma unroll
                    for (int r = 0; r < 16; ++r) { int n0 = pq - pk[32 * g + crow(r, hi)]; n0 = n0 < 0 ? 0 : (n0 > 128 ? 128 : n0); sc[g][r] += bt[n0]; }
            } }
            asm volatile("s_nop 15\n\ts_nop 7" : "+v"(sc[0]), "+v"(sc[1]), "+v"(sc[2]), "+v"(sc[3]));
            if (k0 + 127 > q0w) {
#pragma unroll
                for (int g = 0; g < 4; ++g)
#pragma unroll
                    for (int r = 0; r < 16; ++r) { if (k0 + 32 * g + crow(r, hi) > qi) sc[g][r] = -1e30f; }
            }
            const float mx = swapmax(vmax3(max32(sc[0], sc[1]), max32(sc[2], sc[3]), -1e30f));
            const bool up = (t == 0) || mx > 8.0f;
            float al = 1.f;
            if (__builtin_amdgcn_ballot_w64(up) != 0ull) {
                const float dl = up ? mx : 0.f; al = __builtin_amdgcn_exp2f(-dl); l1 *= al; m1 += dl;
#pragma unroll
                for (int r = 0; r < 16; ++r) negm[r] -= dl;
#pragma unroll
                for (int g = 0; g < 4; ++g)
#pragma unroll
                    for (int r = 0; r < 16; ++r) sc[g][r] -= dl;
            }
            float ls = 0.f;
#pragma unroll
            for (int g = 0; g < 4; ++g)
#pragma unroll
                for (int r = 0; r < 16; ++r) { sc[g][r] = __builtin_amdgcn_exp2f(sc[g][r]); ls += sc[g][r]; }
            l1 += ls;
            bf16x8 pf[8];
#pragma unroll
            for (int g = 0; g < 4; ++g) { pf[2 * g] = pack8(sc[g], 0); pf[2 * g + 1] = pack8(sc[g], 8); }
            if (__builtin_amdgcn_ballot_w64(al != 1.0f) != 0ull) {
#pragma unroll
                for (int d = 0; d < 2; ++d)
#pragma unroll
                    for (int r = 0; r < 16; ++r) oA[d][r] *= al;
            }
            if (!DIFF) {
                bf16x8 vq[16];
#pragma unroll
                for (int i = 0; i < 16; ++i) { const int d = i & 1, s = i >> 1; const s16x4 lo = vtr(vb_ + d * 8192 + s * 1024), hh = vtr(vb_ + d * 8192 + s * 1024 + 512); vq[i] = (bf16x8){lo[0], lo[1], lo[2], lo[3], hh[0], hh[1], hh[2], hh[3]}; }
#pragma unroll
                for (int i = 0; i < 16; ++i) oA[i & 1] = __builtin_amdgcn_mfma_f32_32x32x16_bf16(vq[i], pf[i >> 1], oA[i & 1], 0, 0, 0);
                __builtin_amdgcn_sched_group_barrier(0x100, 4, 0);
#pragma unroll
                for (int i = 0; i < 14; ++i) { __builtin_amdgcn_sched_group_barrier(0x008, 1, 0); __builtin_amdgcn_sched_group_barrier(0x100, 2, 0); }
                __builtin_amdgcn_sched_group_barrier(0x008, 2, 0);
                __builtin_amdgcn_sched_barrier(0);
            } else {
#pragma unroll
            for (int d = 0; d < 2; ++d) {
                bf16x8 vf[8];
#pragma unroll
                for (int s = 0; s < 8; ++s) { const s16x4 lo = vtr(vb_ + d * 8192 + s * 1024), hh = vtr(vb_ + d * 8192 + s * 1024 + 512); vf[s] = (bf16x8){lo[0], lo[1], lo[2], lo[3], hh[0], hh[1], hh[2], hh[3]}; }
                __builtin_amdgcn_sched_barrier(0);
#pragma unroll
                for (int s = 0; s < 8; ++s) oA[d] = __builtin_amdgcn_mfma_f32_32x32x16_bf16(vf[s], pf[s], oA[d], 0, 0, 0);
                __builtin_amdgcn_sched_barrier(0);
            }
            }
        };
        int t = 0;
        for (; t + 2 < NT; ++t) {
            const int buf = t & 1;
            if (t < NTW) compute(t, buf);
            lstore(buf ^ 1); gload(t + 2);
            TILE_BAR();
        }
        for (; t < NT; ++t) {
            const int buf = t & 1;
            if (t < NTW) compute(t, buf);
            if (t + 1 < NT) lstore(buf ^ 1);
            TILE_BAR();
        }
        il = 1.f / swapadd(l1);
        if (DIFF) { if (mp == 0) {
#pragma unroll
            for (int d = 0; d < 2; ++d)
#pragma unroll
                for (int r = 0; r < 16; ++r) osv[(d * 16 + r) * 64] = oA[d][r] * il; } }
    }
    GAS bf16* orow = P.O + (rowb + qi) * P.op + h * 64;
    if (!DIFF) {
#pragma unroll
        for (int d = 0; d < 2; ++d)
#pragma unroll
            for (int g = 0; g < 4; ++g) { v2u v; v.x = cvtpk(oA[d][4 * g] * il, oA[d][4 * g + 1] * il); v.y = cvtpk(oA[d][4 * g + 2] * il, oA[d][4 * g + 3] * il); *(GAS v2u*)(orow + 32 * d + 8 * g + 4 * hi) = v; }
    } else {
        const float lam = P.lams[0], lam_init = P.lams[1];
        const float i2 = lam * il;
        float ss = 0.f;
#pragma unroll
        for (int d = 0; d < 2; ++d)
#pragma unroll
            for (int r = 0; r < 16; ++r) { const float v = osv[(d * 16 + r) * 64] - oA[d][r] * i2; oA[d][r] = v; ss += v * v; }
        ss = swapadd(ss);
        const float rs = __builtin_amdgcn_rsqf(ss * (1.f / 64.f) + 1e-6f) * (1.f - lam_init);
        const LAS float* dn = (const LAS float*)(lds + C::DN);
#pragma unroll
        for (int d = 0; d < 2; ++d)
#pragma unroll
            for (int g = 0; g < 4; ++g) { const int c = 32 * d + 8 * g + 4 * hi; const f32x4 gn = *(const LAS f32x4*)(dn + c);
                v2u v; v.x = cvtpk(oA[d][4 * g] * rs * gn[0], oA[d][4 * g + 1] * rs * gn[1]); v.y = cvtpk(oA[d][4 * g + 2] * rs * gn[2], oA[d][4 * g + 3] * rs * gn[3]); *(GAS v2u*)(orow + c) = v; }
    }
}

struct AKD {
    static constexpr int KP = 144, KB = 64 * KP, VB = 2 * 4096;
    static constexpr int K0 = 0, V0 = 2 * KB, POS = V0 + 2 * VB, PMX = POS + 512, BT = PMX + 16, DN = BT + 528, END = DN + 256;
};
static_assert(AKD::END <= RING_BYTES, "attention LDS (merged differential maps)");
__device__ __forceinline__ void attn_diff_unit(const AttnP& P, int b, int h, int qb, LAS unsigned char* lds, int wave) {
    const int lane = lane_id_v(), tid = (wave << 6) | lane;
    typedef AKD C;
    constexpr int KP = C::KP;
    const int r32 = lane & 31, hi = lane >> 5;
    const size_t rowb = (size_t)b * S;
    const int q0w = qb * 256 + wave * 32, qi = q0w + r32;
    __syncthreads();
    const int pq = P.pos[rowb + qi];
    if (tid < 129) ((LAS float*)(lds + C::BT))[tid] = P.btab[h * 129 + tid];
    if (tid >= 192 && tid < 256) ((LAS float*)(lds + C::DN))[tid - 192] = P.dnorm[tid - 192];
    const int minq = __builtin_amdgcn_readfirstlane(-wave_max_i(-pq));
    const int NT = 4 * (qb + 1);
    const GAS bf16* Kb = P.K + rowb * P.kp + h * 64; const GAS bf16* Vb = P.V + rowb * P.vp + h * 64;
    const __amdgpu_buffer_rsrc_t rK = __builtin_amdgcn_make_buffer_rsrc((void*)Kb, 0, 0x7fffffff, 0x00020000), rV = __builtin_amdgcn_make_buffer_rsrc((void*)Vb, 0, 0x7fffffff, 0x00020000);
    const __amdgpu_buffer_rsrc_t rP = __builtin_amdgcn_make_buffer_rsrc((void*)(P.pos + rowb), 0, 0x7fffffff, 0x00020000);
    const int skey = tid >> 3, spart = tid & 7;
    const int kvo = (skey * P.kp + spart * 8) * 2, vvo = (skey * P.vp + spart * 8) * 2, klo = skey * KP + spart * 16, vlo = (spart >> 2) * 4096 + (skey >> 3) * 512 + (skey & 7) * 64 + (spart & 3) * 16;
    const int pvo = (tid & 63) * 4;
    u32x4 kr, vr; int pkr = 0;
    auto gload = [&](int t) {
        kr = __builtin_amdgcn_raw_buffer_load_b128(rK, kvo, __builtin_amdgcn_readfirstlane(64 * t * P.kp * 2), 0);
        vr = __builtin_amdgcn_raw_buffer_load_b128(rV, vvo, __builtin_amdgcn_readfirstlane(64 * t * P.vp * 2), 0);
        pkr = __builtin_amdgcn_raw_buffer_load_b32(rP, pvo, __builtin_amdgcn_readfirstlane(64 * t * 4), 0);
    };
    auto lstore = [&](int buf) {
        *(LAS u32x4*)(lds + C::K0 + buf * C::KB + klo) = kr; *(LAS u32x4*)(lds + C::V0 + buf * C::VB + vlo) = vr;
        if (tid < 64) { ((LAS int*)(lds + C::POS + buf * 256))[tid] = pkr; const int mk_ = wave_max_i(pkr); if (lane == 0) ((LAS int*)(lds + C::PMX))[buf] = mk_; }
    };
    gload(0);
    bf16x8 qf[2][2];
    { const GAS bf16* qrow = P.Q + (rowb + qi) * P.qp + h * 64;
#pragma unroll
      for (int mp = 0; mp < 2; ++mp)
#pragma unroll
          for (int s_ = 0; s_ < 2; ++s_) qf[mp][s_] = *(const GAS bf16x8*)(qrow + 32 * mp + 16 * s_ + 8 * hi); }
    __syncthreads();
    lstore(0);
    if (NT > 1) gload(1);
    __syncthreads();
    const float bias_far = ((LAS float*)(lds + C::BT))[128];
    float m_[2] = {0.f, 0.f}, l_[2] = {0.f, 0.f};
    f32x16 negm[2], oA[2][2];
#pragma unroll
    for (int mp = 0; mp < 2; ++mp) {
#pragma unroll
        for (int r = 0; r < 16; ++r) { negm[mp][r] = bias_far; oA[mp][0][r] = 0.f; oA[mp][1][r] = 0.f; } }
    const int NTW = (q0w + 31) / 64 + 1;
    auto compute = [&](int t, int buf) {
        const int k0 = 64 * t;
        const LAS unsigned char* kb_ = lds + C::K0 + buf * C::KB + r32 * KP + hi * 16;
        const LAS unsigned char* vb_ = lds + C::V0 + buf * C::VB + ((lane >> 4) & 1) * 32 + (lane & 3) * 8 + (4 * hi + ((lane & 15) >> 2)) * 64;
        const bool nearb = (minq - __builtin_amdgcn_readfirstlane(((const LAS int*)(lds + C::PMX))[buf])) < 128;
        const bool diag = k0 + 63 > q0w;
        bf16x8 pf[2][4];
#pragma unroll
        for (int mp = 0; mp < 2; ++mp) {
            f32x16 sc[2];
            bf16x8 kf[2][2];
#pragma unroll
            for (int g = 0; g < 2; ++g)
#pragma unroll
                for (int s_ = 0; s_ < 2; ++s_) kf[g][s_] = *(const LAS bf16x8*)(kb_ + 32 * g * KP + mp * 64 + s_ * 32);
            if (nearb) {
#pragma unroll
                for (int g = 0; g < 2; ++g) {
#pragma unroll
                    for (int r = 0; r < 16; ++r) sc[g][r] = -m_[mp];
#pragma unroll
                    for (int s_ = 0; s_ < 2; ++s_) sc[g] = __builtin_amdgcn_mfma_f32_32x32x16_bf16(kf[g][s_], qf[mp][s_], sc[g], 0, 0, 0); }
                const LAS int* pk = (const LAS int*)(lds + C::POS + buf * 256); const LAS float* bt = (const LAS float*)(lds + C::BT);
#pragma unroll
                for (int g = 0; g < 2; ++g)
#pragma unroll
                    for (int r = 0; r < 16; ++r) { int n0 = pq - pk[32 * g + crow(r, hi)]; n0 = n0 < 0 ? 0 : (n0 > 128 ? 128 : n0); sc[g][r] += bt[n0]; }
            } else {
#pragma unroll
                for (int g = 0; g < 2; ++g) { sc[g] = __builtin_amdgcn_mfma_f32_32x32x16_bf16(kf[g][0], qf[mp][0], negm[mp], 0, 0, 0); sc[g] = __builtin_amdgcn_mfma_f32_32x32x16_bf16(kf[g][1], qf[mp][1], sc[g], 0, 0, 0); }
            }
            asm volatile("s_nop 15\n\ts_nop 7" : "+v"(sc[0]), "+v"(sc[1]));
            if (diag) {
#pragma unroll
                for (int g = 0; g < 2; ++g)
#pragma unroll
                    for (int r = 0; r < 16; ++r) { if (k0 + 32 * g + crow(r, hi) > qi) sc[g][r] = -1e30f; }
            }
            const float mx = swapmax(vmax3(max32(sc[0], sc[1]), -1e30f, -1e30f));
            const bool up = (t == 0) || mx > 8.0f;
            if (__builtin_amdgcn_ballot_w64(up) != 0ull) {
                const float dl = up ? mx : 0.f; const float al = __builtin_amdgcn_exp2f(-dl); l_[mp] *= al; m_[mp] += dl;
#pragma unroll
                for (int r = 0; r < 16; ++r) negm[mp][r] -= dl;
#pragma unroll
                for (int g = 0; g < 2; ++g)
#pragma unroll
                    for (int r = 0; r < 16; ++r) sc[g][r] -= dl;
#pragma unroll
                for (int d = 0; d < 2; ++d)
#pragma unroll
                    for (int r = 0; r < 16; ++r) oA[mp][d][r] *= al;
            }
            float ls = 0.f;
#pragma unroll
            for (int g = 0; g < 2; ++g)
#pragma unroll
                for (int r = 0; r < 16; ++r) { sc[g][r] = __builtin_amdgcn_exp2f(sc[g][r]); ls += sc[g][r]; }
            l_[mp] += ls;
#pragma unroll
            for (int g = 0; g < 2; ++g) { pf[mp][2 * g] = pack8(sc[g], 0); pf[mp][2 * g + 1] = pack8(sc[g], 8); }
        }
        { bf16x8 vq[8];
#pragma unroll
          for (int i = 0; i < 8; ++i) { const int d = i & 1, s_ = i >> 1; const s16x4 lo = vtr(vb_ + d * 4096 + s_ * 1024), hh = vtr(vb_ + d * 4096 + s_ * 1024 + 512); vq[i] = (bf16x8){lo[0], lo[1], lo[2], lo[3], hh[0], hh[1], hh[2], hh[3]}; }
#pragma unroll
          for (int i = 0; i < 8; ++i) { const int d = i & 1, s_ = i >> 1; oA[0][d] = __builtin_amdgcn_mfma_f32_32x32x16_bf16(vq[i], pf[0][s_], oA[0][d], 0, 0, 0); oA[1][d] = __builtin_amdgcn_mfma_f32_32x32x16_bf16(vq[i], pf[1][s_], oA[1][d], 0, 0, 0); }
          __builtin_amdgcn_sched_group_barrier(0x100, 4, 0);
#pragma unroll
          for (int i = 0; i < 6; ++i) { __builtin_amdgcn_sched_group_barrier(0x008, 2, 0); __builtin_amdgcn_sched_group_barrier(0x100, 2, 0); }
          __builtin_amdgcn_sched_group_barrier(0x008, 4, 0);
          __builtin_amdgcn_sched_barrier(0); }
    };
#pragma unroll 1
    for (int t = 0; t < NT; ++t) {
        const int buf = t & 1;
        if (t < NTW) compute(t, buf);
        if (t + 1 < NT) lstore(buf ^ 1);
        if (t + 2 < NT) gload(t + 2);
        TILE_BAR();
    }
    const float il1 = 1.f / swapadd(l_[0]), il2 = 1.f / swapadd(l_[1]);
    const float lam = P.lams[0], lam_init = P.lams[1];
    const float i2 = lam * il2;
    float ss = 0.f;
#pragma unroll
    for (int d = 0; d < 2; ++d)
#pragma unroll
        for (int r = 0; r < 16; ++r) { const float v = oA[0][d][r] * il1 - oA[1][d][r] * i2; oA[0][d][r] = v; ss += v * v; }
    ss = swapadd(ss);
    const float rs = __builtin_amdgcn_rsqf(ss * (1.f / 64.f) + 1e-6f) * (1.f - lam_init);
    const LAS float* dn = (const LAS float*)(lds + C::DN);
    GAS bf16* orow = P.O + (rowb + qi) * P.op + h * 64;
#pragma unroll
    for (int d = 0; d < 2; ++d)
#pragma unroll
        for (int g = 0; g < 4; ++g) { const int c = 32 * d + 8 * g + 4 * hi; const f32x4 gn = *(const LAS f32x4*)(dn + c);
            v2u v; v.x = cvtpk(oA[0][d][4 * g] * rs * gn[0], oA[0][d][4 * g + 1] * rs * gn[1]); v.y = cvtpk(oA[0][d][4 * g + 2] * rs * gn[2], oA[0][d][4 * g + 3] * rs * gn[3]); *(GAS v2u*)(orow + c) = v; }
}

__device__ __forceinline__ void attn_phase(const AttnP& PM, const AttnP& PD, LAS unsigned char* lds, int tid, int wave, int lane, int vcu, int G, int only = -1) {
    for (int i = vcu; i < 512; i += G) {
        if (only >= 0 && (i >> 8) != only) continue;
        const int kind = i >> 8, c = i & 255, bh = c >> 4, s = c & 15;
        if (kind == 0) {
#pragma unroll 1
            for (int k = 0; k < 2; ++k) attn_unit2<0>(PM, bh >> 2, bh & 3, k ? 31 - s : s, lds, tid, wave, lane);
        } else {
#pragma unroll 1
            for (int k = 0; k < 2; ++k) attn_diff_unit(PD, bh >> 2, bh & 3, k ? 31 - s : s, lds, wave);
        }
    }
}
__device__ __forceinline__ float cx_max16(const f32x16& p) { return fmaxf(fmaxf(fmaxf(fmaxf(p[0], p[1]), fmaxf(p[2], p[3])), fmaxf(fmaxf(p[4], p[5]), fmaxf(p[6], p[7]))), fmaxf(fmaxf(fmaxf(p[8], p[9]), fmaxf(p[10], p[11])), fmaxf(fmaxf(p[12], p[13]), fmaxf(p[14], p[15])))); }
__device__ __forceinline__ void cross_unit2(const AttnP& P, int b, int h, int qb, LAS unsigned char* lds, int wave) {
    const int lane = lane_id_v(), tid = (wave << 6) | lane;
    constexpr int KP = 528;
    const int r32 = lane & 31, hi = lane >> 5;
    const size_t rowb = (size_t)b * S, rowk = (size_t)b * MEM;
    const int qi = qb * 256 + wave * 32 + r32;
    const GAS bf16* Kb = P.K + rowk * P.kp + h * 256; const GAS bf16* Vb = P.V + rowk * P.vp + h * 256;
    const __amdgpu_buffer_rsrc_t rK = __builtin_amdgcn_make_buffer_rsrc((void*)Kb, 0, 0x7fffffff, 0x00020000), rV = __builtin_amdgcn_make_buffer_rsrc((void*)Vb, 0, 0x7fffffff, 0x00020000);
    const GAS bf16* qrow = P.Q + (rowb + qi) * P.qp + h * 256 + 8 * hi;
    bf16x8 qf[4];
#pragma unroll
    for (int s = 0; s < 4; ++s) qf[s] = *(const GAS bf16x8*)(qrow + 16 * s);
    { u32x4 st[16];
#pragma unroll
      for (int i = 0; i < 16; ++i) { const int c = tid + 512 * i; st[i] = __builtin_amdgcn_raw_buffer_load_b128(rK, ((c >> 5) * P.kp + (c & 31) * 8) * 2, 0, 0); }
      TILE_BAR();
#pragma unroll
      for (int i = 0; i < 16; ++i) { const int c = tid + 512 * i; *(LAS u32x4*)(lds + (c >> 5) * KP + (c & 31) * 16) = st[i]; } }
    __syncthreads();
    f32x16 sc[8];
#pragma unroll
    for (int g = 0; g < 8; ++g)
#pragma unroll
        for (int r = 0; r < 16; ++r) sc[g][r] = 0.f;
    const LAS unsigned char* kb_ = lds + r32 * KP + hi * 16;
#pragma unroll
    for (int c = 0; c < 4; ++c) {
        bf16x8 qn[4];
        if (c + 1 < 4) {
#pragma unroll
            for (int s = 0; s < 4; ++s) qn[s] = *(const GAS bf16x8*)(qrow + 64 * (c + 1) + 16 * s); }
        { bf16x8 kq[32];
#pragma unroll
          for (int i = 0; i < 32; ++i) kq[i] = *(const LAS bf16x8*)(kb_ + 32 * (i & 7) * KP + (4 * c + (i >> 3)) * 32);
#pragma unroll
          for (int i = 0; i < 32; ++i) sc[i & 7] = __builtin_amdgcn_mfma_f32_32x32x16_bf16(kq[i], qf[i >> 3], sc[i & 7], 0, 0, 0);
          __builtin_amdgcn_sched_group_barrier(0x100, 4, 0);
#pragma unroll
          for (int i = 0; i < 28; ++i) { __builtin_amdgcn_sched_group_barrier(0x008, 1, 0); __builtin_amdgcn_sched_group_barrier(0x100, 1, 0); }
          __builtin_amdgcn_sched_group_barrier(0x008, 4, 0);
          __builtin_amdgcn_sched_barrier(0); }
        if (c + 1 < 4) {
#pragma unroll
            for (int s = 0; s < 4; ++s) qf[s] = qn[s]; }
    }
    float m = fmaxf(fmaxf(fmaxf(cx_max16(sc[0]), cx_max16(sc[1])), fmaxf(cx_max16(sc[2]), cx_max16(sc[3]))), fmaxf(fmaxf(cx_max16(sc[4]), cx_max16(sc[5])), fmaxf(cx_max16(sc[6]), cx_max16(sc[7]))));
    m = swapmax(m);
    float l = 0.f;
    bf16x8 pf[16];
#pragma unroll
    for (int g = 0; g < 8; ++g) {
#pragma unroll
        for (int r = 0; r < 16; ++r) { sc[g][r] = __builtin_amdgcn_exp2f(sc[g][r] - m); l += sc[g][r]; }
        pf[2 * g] = pack8(sc[g], 0); pf[2 * g + 1] = pack8(sc[g], 8); }
    const float il = 1.f / swapadd(l);
    { u32x4 st[16];
#pragma unroll
      for (int i = 0; i < 16; ++i) { const int c = tid + 512 * i; const int sub = c & 3, key = (c >> 2) & 255, dt = c >> 10; st[i] = __builtin_amdgcn_raw_buffer_load_b128(rV, (key * P.vp + dt * 32 + sub * 8) * 2, 0, 0); }
      TILE_BAR();
#pragma unroll
      for (int i = 0; i < 16; ++i) { const int c = tid + 512 * i; const int sub = c & 3, key = (c >> 2) & 255, dt = c >> 10; *(LAS u32x4*)(lds + dt * 16384 + (key >> 3) * 512 + (key & 7) * 64 + sub * 16) = st[i]; } }
    __syncthreads();
    const LAS unsigned char* vb_ = lds + ((lane >> 4) & 1) * 32 + (lane & 3) * 8 + (4 * hi + ((lane & 15) >> 2)) * 64;
    GAS bf16* orow = P.O + (rowb + qi) * P.op + h * 256;
#pragma unroll 1
    for (int dh = 0; dh < 2; ++dh) {
        f32x16 oA[4];
#pragma unroll
        for (int d = 0; d < 4; ++d)
#pragma unroll
            for (int r = 0; r < 16; ++r) oA[d][r] = 0.f;
#pragma unroll
        for (int d = 0; d < 4; ++d) {
            { bf16x8 vq[16];
#pragma unroll
              for (int s = 0; s < 16; ++s) { const s16x4 lo = vtr(vb_ + (4 * dh + d) * 16384 + s * 1024), hh = vtr(vb_ + (4 * dh + d) * 16384 + s * 1024 + 512); vq[s] = (bf16x8){lo[0], lo[1], lo[2], lo[3], hh[0], hh[1], hh[2], hh[3]}; }
#pragma unroll
              for (int s = 0; s < 16; ++s) oA[d] = __builtin_amdgcn_mfma_f32_32x32x16_bf16(vq[s], pf[s], oA[d], 0, 0, 0);
              __builtin_amdgcn_sched_group_barrier(0x100, 4, 0);
#pragma unroll
              for (int i = 0; i < 14; ++i) { __builtin_amdgcn_sched_group_barrier(0x008, 1, 0); __builtin_amdgcn_sched_group_barrier(0x100, 2, 0); }
              __builtin_amdgcn_sched_group_barrier(0x008, 2, 0);
              __builtin_amdgcn_sched_barrier(0); } }
#pragma unroll
        for (int d = 0; d < 4; ++d)
#pragma unroll
            for (int g = 0; g < 4; ++g) { v2u v; v.x = cvtpk(oA[d][4 * g] * il, oA[d][4 * g + 1] * il); v.y = cvtpk(oA[d][4 * g + 2] * il, oA[d][4 * g + 3] * il); *(GAS v2u*)(orow + 128 * dh + 32 * d + 8 * g + 4 * hi) = v; }
    }
}
__device__ __forceinline__ void cross_phase(const AttnP& PC, LAS unsigned char* lds, int tid, int wave, int lane, int vcu, int G) {
#pragma unroll 1
    for (int i = vcu; i < 512; i += G) { const int bh = i >> 5; cross_unit2(PC, bh >> 2, bh & 3, i & 31, lds, wave); }
}


__device__ __forceinline__ float vmax2(float a, float b) { float r; asm("v_max_f32_e32 %0, %1, %2" : "=v"(r) : "v"(a), "v"(b)); return r; }
__device__ __forceinline__ float vmin2(float a, float b) { float r; asm("v_min_f32_e32 %0, %1, %2" : "=v"(r) : "v"(a), "v"(b)); return r; }
__device__ __forceinline__ void pad16(float (&a)[16]) {
    asm volatile("s_nop 1" : "+v"(a[0]), "+v"(a[1]), "+v"(a[2]), "+v"(a[3]), "+v"(a[4]), "+v"(a[5]), "+v"(a[6]), "+v"(a[7]), "+v"(a[8]), "+v"(a[9]), "+v"(a[10]), "+v"(a[11]), "+v"(a[12]), "+v"(a[13]), "+v"(a[14]), "+v"(a[15]));
}
__device__ __forceinline__ void sort16_desc(float (&a)[16]) {
#pragma unroll
    for (int k = 2; k <= 16; k <<= 1)
#pragma unroll
        for (int j = k >> 1; j > 0; j >>= 1)
#pragma unroll
            for (int i = 0; i < 16; ++i) { const int l = i ^ j; if (l > i) { const bool desc = ((i & k) == 0); const float hi_ = vmax2(a[i], a[l]), lo_ = vmin2(a[i], a[l]); a[i] = desc ? hi_ : lo_; a[l] = desc ? lo_ : hi_; } }
}
__device__ __forceinline__ void merge16_desc(float (&a)[16], const float (&b)[16]) {
#pragma unroll
    for (int i = 0; i < 16; ++i) a[i] = vmax2(a[i], b[15 - i]);
#pragma unroll
    for (int j = 8; j > 0; j >>= 1)
#pragma unroll
        for (int i = 0; i < 16; ++i) { const int l = i ^ j; if (l > i) { const float hi_ = vmax2(a[i], a[l]), lo_ = vmin2(a[i], a[l]); a[i] = hi_; a[l] = lo_; } }
}
__device__ __forceinline__ void top16_of_64(float (&g0)[16], float (&g1)[16], float (&g2)[16], float (&g3)[16]) {
    sort16_desc(g0); sort16_desc(g1); merge16_desc(g0, g1); sort16_desc(g2); sort16_desc(g3); merge16_desc(g2, g3); merge16_desc(g0, g2);
}
__device__ __forceinline__ float embed(float v, unsigned mask, unsigned id) { return __builtin_bit_cast(float, (__builtin_bit_cast(unsigned, v) & mask) | id); }
__device__ __forceinline__ float mkcand(float x, float y, unsigned id) { return embed(x + y, 0xFFFFFF00u, id); }

__device__ __forceinline__ void swap32(float& a, float& b) { asm volatile("v_nop\n\tv_nop\n\tv_permlane32_swap_b32 %0, %1" : "+v"(a), "+v"(b)); }
struct RouteP { const GAS bf16* QP; const GAS bf16* keys; GAS int* EX; GAS float* GW; };
constexpr int RT_KP = 144, RT_KEYS = 0, RT_SCR = 256 * RT_KP, RT_END = RT_SCR + 8 * 8192;
__device__ __forceinline__ void route_phase(const RouteP& P, LAS unsigned char* lds, int tid, int wave, int lane, int vcu, int G) {
    asm volatile("" : "+v"(tid), "+v"(lane));
    __syncthreads();
    for (int c = tid; c < 256 * 8; c += 512) { const int row = c >> 3, part = c & 7; *(LAS u32x4*)(lds + RT_KEYS + row * RT_KP + part * 16) = *(const u32x4*)(P.keys + row * 64 + part * 8); }
    __syncthreads();
    const int r32 = lane & 31, hi = lane >> 5;
    LAS int* scr = (LAS int*)(lds + RT_SCR + wave * 8192);
    for (int u = vcu; u < T / 32; u += G) {
        const size_t t = (size_t)u * 32 + r32; const int h = wave;
        float T2[2][16];
#pragma unroll
        for (int c = 0; c < 2; ++c) {
            bf16x8 qf[4];
            { const GAS bf16* q = P.QP + t * 1024 + h * 128 + c * 64 + 8 * hi;
#pragma unroll
              for (int s = 0; s < 4; ++s) qf[s] = *(const GAS bf16x8*)(q + 16 * s); }
            f32x16 sc[4];
#pragma unroll
            for (int m = 0; m < 4; ++m) {
#pragma unroll
                for (int r = 0; r < 16; ++r) sc[m][r] = 0.f;
#pragma unroll
                for (int s = 0; s < 4; ++s) { const bf16x8 a = *(const LAS bf16x8*)(lds + RT_KEYS + (c * 128 + 32 * m + r32) * RT_KP + s * 32 + hi * 16);
                    sc[m] = __builtin_amdgcn_mfma_f32_32x32x16_bf16(a, qf[s], sc[m], 0, 0, 0); }
            }
            float g0[16], g1[16], g2[16], g3[16];
            const unsigned h4 = 4u * (unsigned)hi;
#pragma unroll
            for (int r = 0; r < 16; ++r) { const unsigned kr_ = (unsigned)((r & 3) + 8 * (r >> 2));
                g0[r] = embed(sc[0][r], 0xFFFFFF80u, kr_ | h4); g1[r] = embed(sc[1][r], 0xFFFFFF80u, (32u + kr_) | h4); g2[r] = embed(sc[2][r], 0xFFFFFF80u, (64u + kr_) | h4); g3[r] = embed(sc[3][r], 0xFFFFFF80u, (96u + kr_) | h4); }
            top16_of_64(g0, g1, g2, g3);
            pad16(g0);
#pragma unroll
            for (int i = 0; i < 16; ++i) T2[c][i] = g0[i];
        }
        float A[16], Bv[16];
#pragma unroll
        for (int i = 0; i < 16; ++i) { A[i] = T2[0][i]; Bv[i] = T2[1][i]; swap32(A[i], Bv[i]); }
        merge16_desc(A, Bv);
        pad16(A);
        float T0[16], T1[16];
#pragma unroll
        for (int i = 0; i < 16; ++i) { T0[i] = A[i]; T1[i] = A[i]; swap32(T0[i], T1[i]); }
#pragma unroll
        for (int i = 0; i < 16; ++i) { scr[i * 64 + lane] = (int)(__builtin_bit_cast(unsigned, T0[i]) & 127u); scr[(16 + i) * 64 + lane] = (int)(__builtin_bit_cast(unsigned, T1[i]) & 127u);
            T0[i] = embed(T0[i], 0xFFFFFF80u, 0u); T1[i] = embed(T1[i], 0xFFFFFF80u, 0u); }
        float c0[16], c1[16], c2[16], c3[16];
        const float NINF = -__builtin_inff();
#pragma unroll
        for (int b = 0; b < 16; ++b) c0[b] = mkcand(T0[0], T1[b], (unsigned)b);
#pragma unroll
        for (int b = 0; b < 8; ++b) c1[b] = mkcand(T0[1], T1[b], 16u + b);
#pragma unroll
        for (int b = 0; b < 5; ++b) c1[8 + b] = mkcand(T0[2], T1[b], 32u + b);
#pragma unroll
        for (int b = 0; b < 3; ++b) c1[13 + b] = mkcand(T0[4], T1[b], 64u + b);
#pragma unroll
        for (int b = 0; b < 4; ++b) c2[b] = mkcand(T0[3], T1[b], 48u + b);
        c2[4] = mkcand(T0[5], T1[0], 80u); c2[5] = mkcand(T0[5], T1[1], 81u); c2[6] = mkcand(T0[6], T1[0], 96u); c2[7] = mkcand(T0[6], T1[1], 97u); c2[8] = mkcand(T0[7], T1[0], 112u); c2[9] = mkcand(T0[7], T1[1], 113u);
#pragma unroll
        for (int a = 8; a < 14; ++a) c2[10 + a - 8] = mkcand(T0[a], T1[0], 16u * a);
        c3[0] = mkcand(T0[14], T1[0], 224u); c3[1] = mkcand(T0[15], T1[0], 240u);
#pragma unroll
        for (int i = 2; i < 16; ++i) c3[i] = NINF;
        top16_of_64(c0, c1, c2, c3);
        pad16(c0);
        float gsum = 0.f, ge[16]; int ex[16];
        const float mtop = embed(c0[0], 0xFFFFFF00u, 0u);
#pragma unroll
        for (int i = 0; i < 16; ++i) { const unsigned bits = __builtin_bit_cast(unsigned, c0[i]); const int a = (bits >> 4) & 15, b = bits & 15;
            ge[i] = __builtin_amdgcn_exp2f((embed(c0[i], 0xFFFFFF00u, 0u) - mtop) * LOG2E); gsum += ge[i];
            ex[i] = scr[a * 64 + lane] * 128 + scr[(16 + b) * 64 + lane]; }
        const float ginv = __builtin_amdgcn_rcpf(gsum);
        if (hi == 0) { GAS unsigned short* d = (GAS unsigned short*)P.EX + t * 128 + h * 16;
#pragma unroll
            for (int i = 0; i < 16; ++i) d[i] = (unsigned short)ex[i]; }
        else { GAS f32x4* d = (GAS f32x4*)(P.GW + t * 128 + h * 16);
#pragma unroll
            for (int i = 0; i < 4; ++i) d[i] = (f32x4){ge[4 * i] * ginv, ge[4 * i + 1] * ginv, ge[4 * i + 2] * ginv, ge[4 * i + 3] * ginv}; }
    }
}

__device__ __forceinline__ int wave_allsum_i(int v) {
    v += __builtin_amdgcn_update_dpp(0, v, 0xB1, 0xF, 0xF, true);
    v += __builtin_amdgcn_update_dpp(0, v, 0x4E, 0xF, 0xF, true);
    v += __builtin_amdgcn_update_dpp(0, v, 0x141, 0xF, 0xF, true);
    v += __builtin_amdgcn_update_dpp(0, v, 0x140, 0xF, 0xF, true);
    { int a = v, b = v; asm volatile("v_nop\n\tv_nop\n\tv_permlane16_swap_b32 %0, %1" : "+v"(a), "+v"(b)); v = a + b; }
    { int a = v, b = v; asm volatile("v_nop\n\tv_nop\n\tv_permlane32_swap_b32 %0, %1" : "+v"(a), "+v"(b)); v = a + b; }
    return v;
}
__device__ __forceinline__ float wave_allsum(float v) {
    v += __builtin_bit_cast(float, __builtin_amdgcn_update_dpp(0, __builtin_bit_cast(int, v), 0xB1, 0xF, 0xF, true));
    v += __builtin_bit_cast(float, __builtin_amdgcn_update_dpp(0, __builtin_bit_cast(int, v), 0x4E, 0xF, 0xF, true));
    v += __builtin_bit_cast(float, __builtin_amdgcn_update_dpp(0, __builtin_bit_cast(int, v), 0x141, 0xF, 0xF, true));
    v += __builtin_bit_cast(float, __builtin_amdgcn_update_dpp(0, __builtin_bit_cast(int, v), 0x140, 0xF, 0xF, true));
    { float a = v, b = v; asm volatile("v_nop\n\tv_nop\n\tv_permlane16_swap_b32 %0, %1" : "+v"(a), "+v"(b)); v = a + b; }
    { float a = v, b = v; asm volatile("v_nop\n\tv_nop\n\tv_permlane32_swap_b32 %0, %1" : "+v"(a), "+v"(b)); v = a + b; }
    return v;
}
__device__ __forceinline__ float wave_allmax(float v) {
    v = fmaxf(v, __builtin_bit_cast(float, __builtin_amdgcn_update_dpp(0, __builtin_bit_cast(int, v), 0xB1, 0xF, 0xF, true)));
    v = fmaxf(v, __builtin_bit_cast(float, __builtin_amdgcn_update_dpp(0, __builtin_bit_cast(int, v), 0x4E, 0xF, 0xF, true)));
    v = fmaxf(v, __builtin_bit_cast(float, __builtin_amdgcn_update_dpp(0, __builtin_bit_cast(int, v), 0x141, 0xF, 0xF, true)));
    v = fmaxf(v, __builtin_bit_cast(float, __builtin_amdgcn_update_dpp(0, __builtin_bit_cast(int, v), 0x140, 0xF, 0xF, true)));
    { float a = v, b = v; asm volatile("v_nop\n\tv_nop\n\tv_permlane16_swap_b32 %0, %1" : "+v"(a), "+v"(b)); v = fmaxf(a, b); }
    { float a = v, b = v; asm volatile("v_nop\n\tv_nop\n\tv_permlane32_swap_b32 %0, %1" : "+v"(a), "+v"(b)); v = fmaxf(a, b); }
    return v;
}
__device__ __forceinline__ unsigned q4(float a, float b, float c, float d, int off) {
    const int ia = (int)__builtin_rintf(a) + off, ib = (int)__builtin_rintf(b) + off, ic = (int)__builtin_rintf(c) + off, id = (int)__builtin_rintf(d) + off;
    return (unsigned)(ia & 255) | ((unsigned)(ib & 255) << 8) | ((unsigned)(ic & 255) << 16) | ((unsigned)(id & 255) << 24);
}
__device__ __forceinline__ void quant_row(const GAS float* src, GAS unsigned* dst, GAS float* scale, int off, int lane) {
    const GAS f32x4* s = (const GAS f32x4*)src + 4 * lane; f32x4 v[4]; float m = 0.f;
#pragma unroll
    for (int i = 0; i < 4; ++i) { v[i] = s[i]; m = fmaxf(m, fmaxf(fmaxf(__builtin_fabsf(v[i].x), __builtin_fabsf(v[i].y)), fmaxf(__builtin_fabsf(v[i].z), __builtin_fabsf(v[i].w)))); }
    m = wave_allmax(m); const float inv = m > 0.f ? 127.f / m : 0.f;
    v4u w;
    w.x = q4(v[0].x * inv, v[0].y * inv, v[0].z * inv, v[0].w * inv, off); w.y = q4(v[1].x * inv, v[1].y * inv, v[1].z * inv, v[1].w * inv, off);
    w.z = q4(v[2].x * inv, v[2].y * inv, v[2].z * inv, v[2].w * inv, off); w.w = q4(v[3].x * inv, v[3].y * inv, v[3].z * inv, v[3].w * inv, off);
    *((GAS v4u*)dst + lane) = w;
    if (lane == 0) *scale = m * (1.f / 127.f);
}
struct PeerS { int nslices_step, first_slice, nloc, rank; };
__device__ __forceinline__ PeerS peer_sched(const GAS unsigned* rankw, int xcc, int rank) {
    const int lane = lane_id_v();
    const int c = lane < 16 ? (int)__hip_atomic_load(rankw + 64 * lane, __ATOMIC_RELAXED, __HIP_MEMORY_SCOPE_AGENT) : 0;
    const unsigned long long m = __builtin_amdgcn_ballot_w64(c > 0);
    const int nx = __builtin_popcountll(m), myidx = __builtin_popcountll(m & ((1ull << xcc) - 1ull));
    const int cm = __builtin_amdgcn_readlane(c, xcc);
    PeerS s; s.nslices_step = nx > 0 ? nx : 1; s.first_slice = myidx; s.nloc = cm > 0 ? cm : 1; s.rank = rank; return s;
}
struct Peer1P { const GAS unsigned GAS char* HQ; const GAS int* EX; const GAS unsigned GAS char* U8; GAS int* P; };
__device__ __forceinline__ void peer_k1(const Peer1P& Q, const PeerS& sc, int wave, int lane) {
    asm volatile("" : "+v"(lane));
    const int g = lane >> 3, j = lane & 7;
    const __amdgpu_buffer_rsrc_t rU = __builtin_amdgcn_make_buffer_rsrc((void*)Q.U8, 0, 0x7fffffff, 0x00020000);
    for (int s = sc.first_slice; s < 8; s += sc.nslices_step)
        for (int tile = sc.rank; tile < T / 64; tile += sc.nloc) {
            const int soff_ = __builtin_amdgcn_readfirstlane(128 * s);
            const size_t t0 = (size_t)tile * 64 + wave * 8;
            v4u hqn = *(const GAS v4u*)(Q.HQ + t0 * 1024 + 128 * s + 16 * j), exn[2];
#pragma unroll
            for (int i = 0; i < 2; ++i) exn[i] = *(const GAS v4u*)(Q.EX + t0 * 64 + 8 * g + 4 * i);
#pragma unroll 1
            for (int k = 0; k < 8; ++k) {
                const size_t t = t0 + k;
                const v4u hq = hqn; v4u ex[2];
#pragma unroll
                for (int i = 0; i < 2; ++i) ex[i] = exn[i];
                if (k + 1 < 8) {
                    hqn = *(const GAS v4u*)(Q.HQ + (t + 1) * 1024 + 128 * s + 16 * j);
#pragma unroll
                    for (int i = 0; i < 2; ++i) exn[i] = *(const GAS v4u*)(Q.EX + (t + 1) * 64 + 8 * g + 4 * i);
                }
                v4u uu[16];
#pragma unroll
                for (int i = 0; i < 16; ++i) { const unsigned ew = ((i >> 1) & 3) == 0 ? ex[i >> 3].x : ((i >> 1) & 3) == 1 ? ex[i >> 3].y : ((i >> 1) & 3) == 2 ? ex[i >> 3].z : ex[i >> 3].w; unsigned e; if (i & 1) asm("v_lshrrev_b32 %0, 16, %1" : "=v"(e) : "v"(ew)); else asm("v_and_b32 %0, 0xffff, %1" : "=v"(e) : "v"(ew));
                    uu[i] = __builtin_bit_cast(v4u, __builtin_amdgcn_raw_buffer_load_b128(rU, (int)((e << 10) + 16u * (unsigned)j), soff_, 0)); }
                int pd[16];
#pragma unroll
                for (int i = 0; i < 16; ++i) { int q_;
                    asm("v_dot4_i32_i8 %0, %1, %2, 0" : "=v"(q_) : "v"(uu[i].x), "v"(hq.x));
                    q_ = __builtin_amdgcn_sdot4((int)uu[i].y, (int)hq.y, q_, false); q_ = __builtin_amdgcn_sdot4((int)uu[i].z, (int)hq.z, q_, false); pd[i] = __builtin_amdgcn_sdot4((int)uu[i].w, (int)hq.w, q_, false); }
#pragma unroll
                for (int i = 0; i < 16; ++i) pd[i] += __builtin_amdgcn_update_dpp(0, pd[i], 0xB1, 0xF, 0xF, true);
#pragma unroll
                for (int i = 0; i < 16; ++i) pd[i] += __builtin_amdgcn_update_dpp(0, pd[i], 0x4E, 0xF, 0xF, true);
#pragma unroll
                for (int i = 0; i < 16; ++i) pd[i] += __builtin_amdgcn_update_dpp(0, pd[i], 0x141, 0xF, 0xF, true);
                int lo = 0, hi = 0;
#pragma unroll
                for (int i = 0; i < 8; ++i) { lo = (j == i) ? pd[i] : lo; hi = (j == i) ? pd[i + 8] : hi; }
                Q.P[(t * 8 + s) * 64 + 8 * g + j] = (int)__builtin_amdgcn_perm((unsigned)((hi + 32) >> 6), (unsigned)((lo + 32) >> 6), 0x05040100u);
            }
        }
}
__device__ __forceinline__ void peer_w(const GAS int* EX, const GAS float* GW, const GAS int* P, const GAS float* SH, const GAS float* SU, const GAS float* SV, GAS signed char* WQ, GAS float* WSC, int gw, int NGW, int lane,
                                       LAS unsigned char* lds, int tid) {
    asm volatile("" : "+v"(lane), "+v"(tid));
    LAS float* su_l = (LAS float*)lds; LAS float* sv_l = su_l + 16384;
#pragma unroll 4
    for (int i = tid; i < 4096; i += 512) { ((LAS f32x4*)su_l)[i] = ((const GAS f32x4*)SU)[i]; ((LAS f32x4*)sv_l)[i] = ((const GAS f32x4*)SV)[i]; }
    __syncthreads();
    for (int t = gw; t < T; t += NGW) {
        const float sh = SH[t];
#pragma unroll
        for (int q = 0; q < 2; ++q) { const size_t idx = (size_t)t * 128 + lane + 64 * q; const int e = (int)((const GAS unsigned short*)EX)[idx];
            const int slot_ = lane + 64 * q, pix_ = (slot_ >> 4) * 8 + (slot_ & 7), hsel_ = (slot_ >> 3) & 1;
            int pd = 0;
#pragma unroll
            for (int sl = 0; sl < 8; ++sl) { const int pw_ = P[((size_t)t * 8 + sl) * 64 + pix_]; pd += hsel_ ? (pw_ >> 16) : (int)(short)(pw_ & 0xffff); }
            const float w = GW[idx] * gelu_erf((float)pd * (64.f * sh * su_l[e])) * sv_l[e];
            float m = __builtin_fabsf(w);
            m = fmaxf(m, __builtin_bit_cast(float, __builtin_amdgcn_update_dpp(0, __builtin_bit_cast(int, m), 0xB1, 0xF, 0xF, true)));
            m = fmaxf(m, __builtin_bit_cast(float, __builtin_amdgcn_update_dpp(0, __builtin_bit_cast(int, m), 0x4E, 0xF, 0xF, true)));
            m = fmaxf(m, __builtin_bit_cast(float, __builtin_amdgcn_update_dpp(0, __builtin_bit_cast(int, m), 0x141, 0xF, 0xF, true)));
            m = fmaxf(m, __builtin_bit_cast(float, __builtin_amdgcn_update_dpp(0, __builtin_bit_cast(int, m), 0x140, 0xF, 0xF, true)));
            const float inv = m > 0.f ? 127.f / m : 0.f;
            const unsigned wb = (unsigned)((int)__builtin_rintf(w * inv)) & 255u;
            const unsigned b1 = (unsigned)__builtin_amdgcn_update_dpp(0, (int)wb, 0x55, 0xF, 0xF, true), b2 = (unsigned)__builtin_amdgcn_update_dpp(0, (int)wb, 0xAA, 0xF, 0xF, true), b3 = (unsigned)__builtin_amdgcn_update_dpp(0, (int)wb, 0xFF, 0xF, 0xF, true);
            if ((lane & 3) == 0) ((GAS unsigned*)WQ)[idx >> 2] = wb | (b1 << 8) | (b2 << 16) | (b3 << 24);
            if ((lane & 15) == 0) WSC[(size_t)t * 8 + (lane >> 4) + 4 * q] = m * (1.f / 127.f); }
    }
}
__device__ __forceinline__ void tr4x4(unsigned r0, unsigned r1, unsigned r2, unsigned r3, unsigned (&t)[4]) {
    const unsigned x0 = __builtin_amdgcn_perm(r1, r0, 0x05010400u), x1 = __builtin_amdgcn_perm(r1, r0, 0x07030602u), y0 = __builtin_amdgcn_perm(r3, r2, 0x05010400u), y1 = __builtin_amdgcn_perm(r3, r2, 0x07030602u);
    t[0] = __builtin_amdgcn_perm(y0, x0, 0x05040100u); t[1] = __builtin_amdgcn_perm(y0, x0, 0x07060302u); t[2] = __builtin_amdgcn_perm(y1, x1, 0x05040100u); t[3] = __builtin_amdgcn_perm(y1, x1, 0x07060302u);
}
struct Peer2P { const GAS int* EX; const GAS signed char* WQ; const GAS float* WSC; const GAS unsigned char* V8; GAS bf16* XB; GAS float* SSQ; };
__device__ __forceinline__ void peer_k2(const Peer2P& Q, const PeerS& sc, int wave, int lane) {
    asm volatile("" : "+v"(lane));
    const int g = lane >> 3, j = lane & 7, hf = lane >> 5, rp = (lane >> 4) & 1;
    const __amdgpu_buffer_rsrc_t rV = __builtin_amdgcn_make_buffer_rsrc((void*)Q.V8, 0, 0x7fffffff, 0x00020000);
    for (int s = sc.first_slice; s < 8; s += sc.nslices_step)
        for (int tile = sc.rank; tile < T / 64; tile += sc.nloc) {
            const int soff_ = __builtin_amdgcn_readfirstlane(128 * s);
            const size_t t0 = (size_t)tile * 64 + wave * 8;
            struct Small { v4u ex[2]; v4u wq; float sw; };
            v4u vA[16], vB[16]; v2u xA, xB;
            Small sC, sN, sF;
            auto ld_small = [&](size_t t, Small& o) {
#pragma unroll
                for (int i = 0; i < 2; ++i) o.ex[i] = *(const GAS v4u*)(Q.EX + t * 64 + 8 * g + 4 * i);
                o.wq = *(const GAS v4u*)(Q.WQ + t * 128 + 16 * g); o.sw = Q.WSC[t * 8 + g]; };
            auto issue = [&](v4u (&vv)[16], v2u& xold, const Small& sm, size_t t) {
                const v4u (&ex)[2] = sm.ex;
                xold = *(const GAS v2u*)(Q.XB + t * 1024 + 128 * s + 16 * j + 8 * hf + 4 * rp);
#pragma unroll
                for (int i = 0; i < 16; ++i) { const unsigned ew = ((i >> 1) & 3) == 0 ? ex[i >> 3].x : ((i >> 1) & 3) == 1 ? ex[i >> 3].y : ((i >> 1) & 3) == 2 ? ex[i >> 3].z : ex[i >> 3].w; unsigned e; if (i & 1) asm("v_lshrrev_b32 %0, 16, %1" : "=v"(e) : "v"(ew)); else asm("v_and_b32 %0, 0xffff, %1" : "=v"(e) : "v"(ew));
                    vv[i] = __builtin_bit_cast(v4u, __builtin_amdgcn_raw_buffer_load_b128(rV, (int)((e << 10) + 16u * (unsigned)j), soff_, 0)); }
            };
            auto reduce = [&](const v4u (&vv)[16], const v2u xold, const Small& sm, size_t t) {
                const v4u wq = sm.wq; const float sw = sm.sw;
                GAS v2u* xp = (GAS v2u*)(Q.XB + t * 1024 + 128 * s + 16 * j + 8 * hf + 4 * rp);
                int ai[16];
#pragma unroll
                for (int q4_ = 0; q4_ < 4; ++q4_) {
                    const unsigned wq4 = q4_ == 0 ? wq.x : q4_ == 1 ? wq.y : q4_ == 2 ? wq.z : wq.w;
#pragma unroll
                    for (int c = 0; c < 4; ++c) { unsigned tt[4];
                        const v4u &a0 = vv[4 * q4_], &a1 = vv[4 * q4_ + 1], &a2 = vv[4 * q4_ + 2], &a3 = vv[4 * q4_ + 3];
                        tr4x4(c == 0 ? a0.x : c == 1 ? a0.y : c == 2 ? a0.z : a0.w, c == 0 ? a1.x : c == 1 ? a1.y : c == 2 ? a1.z : a1.w, c == 0 ? a2.x : c == 1 ? a2.y : c == 2 ? a2.z : a2.w, c == 0 ? a3.x : c == 1 ? a3.y : c == 2 ? a3.z : a3.w, tt);
#pragma unroll
                        for (int b = 0; b < 4; ++b) {
                            if (q4_ == 0) asm("v_dot4_i32_i8 %0, %1, %2, 0" : "=v"(ai[4 * c + b]) : "v"(tt[b]), "v"(wq4));
                            else ai[4 * c + b] = __builtin_amdgcn_sdot4((int)tt[b], (int)wq4, ai[4 * c + b], false); } }
                }
                float acc[16];
#pragma unroll
                for (int i = 0; i < 16; ++i) acc[i] = (float)ai[i] * sw;
                float r8[8], r4[4];
#pragma unroll
                for (int m = 0; m < 8; ++m) r8[m] = 0.f;
                asm volatile("v_nop\n\tv_nop\n\tv_permlane32_swap_b32 %0, %8\n\tv_permlane32_swap_b32 %1, %9\n\tv_permlane32_swap_b32 %2, %10\n\tv_permlane32_swap_b32 %3, %11\n\tv_permlane32_swap_b32 %4, %12\n\tv_permlane32_swap_b32 %5, %13\n\tv_permlane32_swap_b32 %6, %14\n\tv_permlane32_swap_b32 %7, %15"
                             : "+v"(acc[0]), "+v"(acc[1]), "+v"(acc[2]), "+v"(acc[3]), "+v"(acc[4]), "+v"(acc[5]), "+v"(acc[6]), "+v"(acc[7]), "+v"(acc[8]), "+v"(acc[9]), "+v"(acc[10]), "+v"(acc[11]), "+v"(acc[12]), "+v"(acc[13]), "+v"(acc[14]), "+v"(acc[15]));
#pragma unroll
                for (int m = 0; m < 8; ++m) r8[m] = acc[m] + acc[m + 8];
                asm volatile("v_nop\n\tv_nop\n\tv_permlane16_swap_b32 %0, %4\n\tv_permlane16_swap_b32 %1, %5\n\tv_permlane16_swap_b32 %2, %6\n\tv_permlane16_swap_b32 %3, %7"
                             : "+v"(r8[0]), "+v"(r8[1]), "+v"(r8[2]), "+v"(r8[3]), "+v"(r8[4]), "+v"(r8[5]), "+v"(r8[6]), "+v"(r8[7]));
#pragma unroll
                for (int n = 0; n < 4; ++n) r4[n] = r8[n] + r8[n + 4];
#pragma unroll
                for (int n = 0; n < 4; ++n) r4[n] += __builtin_bit_cast(float, __builtin_amdgcn_update_dpp(0, __builtin_bit_cast(int, r4[n]), 0x128, 0xF, 0xF, true));
                v2u xw; xw.x = cvtpk(bflo(xold.x) + r4[0], bfhi(xold.x) + r4[1]); xw.y = cvtpk(bflo(xold.y) + r4[2], bfhi(xold.y) + r4[3]);
                float ss = 0.f;
                if ((lane & 8) == 0) { const float x0 = bflo(xw.x), x1 = bfhi(xw.x), x2 = bflo(xw.y), x3 = bfhi(xw.y); ss = (x0 * x0 + x1 * x1) + (x2 * x2 + x3 * x3); *xp = xw; }
                ss = wave_allsum(ss);
                if (Q.SSQ) { if (lane == 0) Q.SSQ[t * 16 + s] = ss; }
            };
            ld_small(t0, sC); ld_small(t0 + 1, sN);
            issue(vA, xA, sC, t0);
#pragma unroll 1
            for (int k = 0; k < 8; k += 2) {
                ld_small(t0 + (k + 2 < 8 ? k + 2 : 7), sF);
                issue(vB, xB, sN, t0 + k + 1);
                reduce(vA, xA, sC, t0 + k);
                if (k + 2 < 8) { ld_small(t0 + (k + 3 < 8 ? k + 3 : 7), sC); issue(vA, xA, sF, t0 + k + 2); }
                reduce(vB, xB, sN, t0 + k + 1);
                { const Small tmp = sC; sC = sF; sN = tmp; }
            }
        }
}

struct Args { const float* in[33]; float* out; unsigned char* ws; int ph_lo, ph_hi; };
struct Frame { LAS unsigned char* lds; volatile LAS unsigned* MISC; gu32* ctl; int tid, lane, wave, G, vcu, xcc, xrank; };

__device__ __forceinline__ void transpose_item(const float* W, int ldw, int nsrc0, bf16* WT, int ldt, int rdst0, LAS float* scr, int kb, int nb, int lane, float scale, const float* kgain) {
    const int k0 = 64 * kb, n0 = 32 * nb;
#pragma unroll 8
    for (int i = 0; i < 32; ++i) { const int kk = 2 * i + (lane >> 5); const float gsc = kgain ? kgain[k0 + kk] * scale : scale; scr[kk * 33 + (lane & 31)] = W[(size_t)(k0 + kk) * ldw + nsrc0 + n0 + (lane & 31)] * gsc; }
    LDS_WAIT(); asm volatile("" ::: "memory");
    const int c = lane & 7;
#pragma unroll
    for (int j = 0; j < 4; ++j) { const int n = (lane >> 3) + 8 * j; const LAS float* s = scr + (8 * c) * 33 + n;
        v4u o; o.x = pk2(s[0 * 33], s[1 * 33]); o.y = pk2(s[2 * 33], s[3 * 33]); o.z = pk2(s[4 * 33], s[5 * 33]); o.w = pk2(s[6 * 33], s[7 * 33]);
        *(GAS v4u*)(WT + (size_t)(rdst0 + n0 + n) * ldt + k0 + 8 * c) = o; }
    LDS_WAIT(); asm volatile("" ::: "memory");
}
__device__ __forceinline__ void zero_rect(bf16* base, int ld, int row0, int nrows, int col0, int ncols, int gtid, int gthreads) {
    const int vpr = ncols / 8;
    for (int i = gtid; i < nrows * vpr; i += gthreads) { const int r = i / vpr, c = i % vpr; *(GAS v4u*)(base + (size_t)(row0 + r) * ld + col0 + 8 * c) = (v4u){0u, 0u, 0u, 0u}; }
}

__device__ __forceinline__ void p0_prologue(Frame& F, const Args& a) {
    LAS float* scr = (LAS float*)(F.lds + RING_OFF + F.wave * 16384);
    const int gw = blockIdx.x * NWAVES + F.wave, NGW = F.G * NWAVES;
    const int gtid = blockIdx.x * (NWAVES * 64) + F.tid, gthreads = F.G * NWAVES * 64;
    unsigned char* ws = a.ws;
    x0_phase((const GAS float*)a.in[0], (GAS bf16*)(ws + WS_XNB), (GAS float*)(ws + WS_SSQ), gw, NGW, F.lane);
    constexpr int I_IN = 16 * (INW / 32), I_SQ = 16 * 32, I_CKV = 16 * 64, I_UQ = 3 * 12, I_UKV = 2 * 16, I_L = I_IN + 4 * I_SQ + I_CKV + I_UQ + I_UKV;
    for (int it = gw; it < L * I_L; it += NGW) {
        const int l = it / I_L; int r = it % I_L;
        if (r < I_IN) {
            const int kb = r / 67, nb = r % 67; int src, dst; float sc = 1.f;
            if (nb < 6) { src = 32 * nb; dst = src; } else if (nb < 11) { src = 32 * nb; dst = src + 64; } else { src = 32 * nb; dst = src + 160; if (nb >= 43 && nb < 51) sc = 0.17677669529663687f * LOG2E; }
            transpose_item(a.in[5] + (size_t)l * D * INW, INW, src, (bf16*)(ws + WS_WIN) + (size_t)l * INP * D, D, dst, scr, kb, 0, F.lane, sc, a.in[4] + l * D); continue; } r -= I_IN;
        if (r < I_SQ) { transpose_item(a.in[21] + (size_t)l * D * D, D, 0, (bf16*)(ws + WS_WOUT) + (size_t)l * D * D, D, 0, scr, r / 32, r % 32, F.lane, 1.f, nullptr); continue; } r -= I_SQ;
        if (r < I_SQ) { transpose_item(a.in[24] + (size_t)l * D * D, D, 0, (bf16*)(ws + WS_WCQ) + (size_t)l * D * D, D, 0, scr, r / 32, r % 32, F.lane, 0.0625f * LOG2E, a.in[22] + l * D); continue; } r -= I_SQ;
        if (r < I_SQ) { transpose_item(a.in[26] + (size_t)l * D * D, D, 0, (bf16*)(ws + WS_WCO) + (size_t)l * D * D, D, 0, scr, r / 32, r % 32, F.lane, 1.f, nullptr); continue; } r -= I_SQ;
        if (r < I_SQ) { transpose_item(a.in[28] + (size_t)l * D * D, D, 0, (bf16*)(ws + WS_WPQ) + (size_t)l * D * D, D, 0, scr, r / 32, r % 32, F.lane, 1.f, a.in[27] + l * D); continue; } r -= I_SQ;
        if (r < I_CKV) { transpose_item(a.in[25] + (size_t)l * D * 2 * D, 2 * D, 0, (bf16*)(ws + WS_WCKV) + (size_t)l * 2 * D * D, D, 0, scr, r / 64, r % 64, F.lane, 1.f, nullptr); continue; } r -= I_CKV;
        if (r < I_UQ) { transpose_item(a.in[7] + (size_t)l * 192 * 384, 384, 0, (bf16*)(ws + WS_WUQ) + (size_t)l * 512 * 256, 256, 0, scr, r / 12, r % 12, F.lane, 0.10206207261596575f * LOG2E, a.in[6] + l * 192); continue; } r -= I_UQ;
        transpose_item(a.in[9] + (size_t)l * 128 * 512, 512, 0, (bf16*)(ws + WS_WUKV) + (size_t)l * 512 * 256, 256, 0, scr, r / 16, r % 16, F.lane, 1.f, a.in[8] + l * 128);
    }
    for (int l = 0; l < L; ++l) {
        bf16* win = (bf16*)(ws + WS_WIN) + (size_t)l * INP * D; bf16* wuq = (bf16*)(ws + WS_WUQ) + (size_t)l * 512 * 256; bf16* wukv = (bf16*)(ws + WS_WUKV) + (size_t)l * 512 * 256;
        zero_rect(win, D, 192, 64, 0, D, gtid, gthreads); zero_rect(win, D, 416, 96, 0, D, gtid, gthreads);
        zero_rect(wuq, 256, 0, 384, 192, 64, gtid, gthreads); zero_rect(wuq, 256, 384, 128, 0, 256, gtid, gthreads);
        zero_rect(wukv, 256, 0, 512, 128, 128, gtid, gthreads);
    }
    { float* rope = (float*)(ws + WS_ROPE); const int* pos = (const int*)a.in[2];
      for (int i = gtid; i < T * 16; i += gthreads) { const int t = i >> 4, k = i & 15; const float inv = powf(10000.f, -(float)(2 * k) / 32.f); const float ang = (float)pos[t] * inv;
          rope[(size_t)t * 32 + k] = cosf(ang); rope[(size_t)t * 32 + 16 + k] = sinf(ang); } }
    { const GAS f32x4* ks = (const GAS f32x4*)a.in[29]; GAS v2u* kd = (GAS v2u*)(ws + WS_KEYS);
      for (int i = gtid; i < L * 2 * 128 * 64 / 4; i += gthreads) { const f32x4 v = ks[i]; v2u w; w.x = pk2(v.x, v.y); w.y = pk2(v.z, v.w); kd[i] = w; }
    }
    for (int r = gw; r < 2 * L * 16384; r += NGW) { const int tb = r / (L * 16384), rr = r % (L * 16384);
        quant_row((const GAS float*)a.in[30 + tb] + (size_t)rr * 1024, (GAS unsigned*)(ws + (tb ? WS_V8 : WS_U8) + (size_t)rr * 1024), (GAS float*)(ws + (tb ? WS_SV : WS_SU)) + rr, 0, F.lane); }
    { float* btab = (float*)(ws + WS_BTAB); float* lams = (float*)(ws + WS_LAMS); float* spt = (float*)(ws + WS_SP);
      for (int i = gtid; i < 4 * 129; i += gthreads) { const int h = i / 129, n = i % 129; int bu; if (n < 16) bu = n; else { const int lg = 16 + (int)(logf((float)n / 16.f) / logf(8.f) * 16.f); bu = lg < 31 ? lg : 31; }
          btab[i] = a.in[3][bu * 4 + h] * LOG2E; }
      for (int i = gtid; i < L; i += gthreads) { const float* dl = a.in[17] + i * 128; float s1 = 0.f, s2 = 0.f; for (int j = 0; j < 32; ++j) { s1 += dl[j] * dl[32 + j]; s2 += dl[64 + j] * dl[96 + j]; }
          const float li = 0.8f - 0.6f * expf(-0.3f * (float)i); lams[2 * i] = expf(s1) - expf(s2) + li; lams[2 * i + 1] = li; }
      for (int i = gtid; i < L * 512; i += gthreads) spt[i] = log1pf(expf(-a.in[16][i])); }
    { GAS bf16* wat = (GAS bf16*)(ws + WS_WAT);
      for (int i = gtid; i < L * 8 * 2 * 4096; i += gthreads) { const int in_ = i & 63, out_ = (i >> 6) & 63, gate = (i >> 12) & 1, lg = i >> 13;
          wat[i] = (bf16)f2bf_(a.in[gate ? 14 : 12][(size_t)lg * 4096 + in_ * 64 + out_]); } }
    for (int l = 0; l < L; ++l) norm_phase((const GAS float*)a.in[1], (const GAS float*)a.in[23] + l * D, (GAS bf16*)(ws + WS_MNB) + (size_t)l * NB * MEM * D, NB * MEM, gw, NGW, F.lane);
}

constexpr int NPL = 16, PH_FINAL = 2 + NPL * L;
__global__ void __launch_bounds__(NWAVES * 64, 2) fwd(Args args) {
    extern __shared__ __attribute__((aligned(16))) unsigned char lds[];
    Frame F;
    F.lds = (LAS unsigned char*)lds; F.MISC = (volatile LAS unsigned*)(F.lds + MISC_OFF);
    F.tid = threadIdx.x; F.lane = F.tid & 63; F.wave = __builtin_amdgcn_readfirstlane(F.tid >> 6); F.G = gridDim.x;
    F.vcu = (F.G % 8 == 0) ? ((int)blockIdx.x % 8) * (F.G / 8) + (int)blockIdx.x / 8 : (int)blockIdx.x;
    unsigned char* ws = args.ws;
    F.ctl = (gu32*)(opq(ws) + WS_CTL);
    for (int u = F.tid; u < (LDS_BYTES - LDSCTL_OFF) / 4; u += NWAVES * 64) ((LAS unsigned*)(F.lds + LDSCTL_OFF))[u] = 0u;
    __syncthreads();
    XcdBarrier bar = xcd_barrier_post((unsigned*)(F.ctl + CW_BAR), F.MISC + 8);
    F.xcc = (int)bar.x;
    if (F.tid == 0) F.MISC[12] = __hip_atomic_fetch_add((unsigned*)(F.ctl + CW_RANK) + 64 * bar.x, 1u, __ATOMIC_RELAXED, __HIP_MEMORY_SCOPE_AGENT);
    __syncthreads();
    F.xrank = __builtin_amdgcn_readfirstlane((int)F.MISC[12]);
    const int lo = args.ph_lo, hi = args.ph_hi;
    const int gw = blockIdx.x * NWAVES + F.wave, NGW = F.G * NWAVES;
#define IN(k) (lo <= (k) && (k) < hi)
#define LANE_ (lane_id_v())
#define TID_ ((opqi(F.wave) << 6) | LANE_)
#define SITE() const int G_ = opqi(F.G), wv_ = opqi(F.wave), vcu_ = opqi(F.vcu), gw_ = opqi(gw), NGW_ = opqi(NGW); (void)G_; (void)wv_; (void)vcu_; (void)gw_; (void)NGW_
#if MK_DUP == 99
#define SEAM(k) do { if (IN(k) && IN((k) + 1)) { xcd_barrier(bar, (F.wave == 0 && lane_id_v() == 0) ? 1 : 0); xcd_barrier(bar, (F.wave == 0 && lane_id_v() == 0) ? 1 : 0); } } while (0)
#else
#define SEAM(k) do { if (IN(k) && IN((k) + 1)) xcd_barrier(bar, (F.wave == 0 && lane_id_v() == 0) ? 1 : 0); } while (0)
#endif
#define GEMM_SITE(EPI, Aptr, lda_, Bptr, ldb_, M_, N_, K_, cperm, ...) do { \
        pg8::Gemm g{opq(Aptr), opq(Bptr), M_, N_, K_, lda_, ldb_}; pg8::StaticOrder So; So.init(M_, N_, opqi(F.G), opqi(cperm)); pg8::EPI E{__VA_ARGS__}; \
        pg8::gemm_phase<pg8::EPI, pg8::StaticOrder, true, true>(F.lds + RING_OFF, g, So, E, opqi(F.wave)); } while (0)
    if (IN(0)) { p0_prologue(F, args); }
    SEAM(0);
    if (IN(1)) {
#pragma unroll 1
        for (int l = 0; l < L; ++l)
            GEMM_SITE(EpiBf16, (const GAS bf16*)(opq(ws) + WS_MNB) + (size_t)l * NB * MEM * D, D, (const GAS bf16*)(opq(ws) + WS_WCKV) + (size_t)l * 2 * D * D, D, NB * MEM, 2 * D, D, (int)((blockIdx.x + 64 * l) % F.G),
                      opq((GAS bf16*)(opq(ws) + WS_KVCB) + (size_t)l * NB * MEM * 2 * D), 2 * D, 2 * D, (const GAS float*)nullptr, 0);
    }
    SEAM(1);
    for (int l = 0; l < L; ++l) {
        const int pb = 2 + NPL * l;
        const GAS bf16* XNB = (const GAS bf16*)(opq(ws) + WS_XNB); const GAS bf16* YB = (const GAS bf16*)(opq(ws) + WS_YB); GAS bf16* PROJB = (GAS bf16*)(opq(ws) + WS_PROJB);
        if (IN(pb + 1)) GEMM_SITE(EpiBf16, XNB, D, (const GAS bf16*)(opq(ws) + WS_WIN) + (size_t)l * INP * D, D, T, INP, D, (int)blockIdx.x, opq(PROJB), INP, INP, opq((const GAS float*)(opq(ws) + WS_SSQ)), 8);
#if MK_DUP == 1
        if (IN(pb + 1)) GEMM_SITE(EpiBf16, XNB, D, (const GAS bf16*)(opq(ws) + WS_WIN) + (size_t)l * INP * D, D, T, INP, D, (int)blockIdx.x, opq(PROJB), INP, INP, opq((const GAS float*)(opq(ws) + WS_SSQ)), 8);
#endif
        SEAM(pb + 1);
        if (IN(pb + 2)) {
            SITE();
            pre_phase(opq((const GAS bf16*)PROJB), opq((const GAS float*)(opq(ws) + WS_ROPE)), opq((GAS float*)(opq(ws) + WS_RS)), opq((GAS bf16*)(opq(ws) + WS_KMB)), gw_, NGW_, LANE_);
#if MK_DUP == 21
            pre_phase(opq((const GAS bf16*)PROJB), opq((const GAS float*)(opq(ws) + WS_ROPE)), opq((GAS float*)(opq(ws) + WS_RS)), opq((GAS bf16*)(opq(ws) + WS_KMB)), gw_, NGW_, LANE_);
#endif
            LruP LP{opq((const GAS bf16*)PROJB), (const GAS float*)args.in[opqi(10)] + l * 4 * 512, (const GAS float*)args.in[opqi(11)] + l * 512, opq((const GAS bf16*)(opq(ws) + WS_WAT)) + (size_t)l * 8 * 2 * 4096, (const GAS float*)args.in[opqi(13)] + l * 512, (const GAS float*)args.in[opqi(15)] + l * 512,
                    (const GAS float*)(opq(ws) + WS_SP) + l * 512, opq((GAS unsigned*)(opq(ws) + WS_HLB)), opq((GAS float*)(opq(ws) + WS_LSUM))};
            lru_phase(LP, F.lds, TID_, wv_, LANE_, vcu_, G_);
#if MK_DUP == 2
            lru_phase(LP, F.lds, TID_, wv_, LANE_, vcu_, G_);
#endif
        }
        SEAM(pb + 2);
        if (IN(pb + 3)) {
            GEMM_SITE(EpiUp, (const GAS bf16*)PROJB + PC_CQ, INP, (const GAS bf16*)(opq(ws) + WS_WUQ) + (size_t)l * 512 * 256, 256, T, 512, 256, (int)blockIdx.x,
                      opq((GAS bf16*)(opq(ws) + WS_QMB)), (GAS bf16*)nullptr, 384, 384, opq((const GAS float*)(opq(ws) + WS_RS)), 0, 0);
            GEMM_SITE(EpiUp, (const GAS bf16*)PROJB + PC_CKV, INP, (const GAS bf16*)(opq(ws) + WS_WUKV) + (size_t)l * 512 * 256, 256, T, 512, 256, (int)blockIdx.x,
                      opq((GAS bf16*)(opq(ws) + WS_KMB)), opq((GAS bf16*)(opq(ws) + WS_VMB)), 0, 512, opq((const GAS float*)(opq(ws) + WS_RS)), 1, 1);
#if MK_DUP == 3
            GEMM_SITE(EpiUp, (const GAS bf16*)PROJB + PC_CQ, INP, (const GAS bf16*)(opq(ws) + WS_WUQ) + (size_t)l * 512 * 256, 256, T, 512, 256, (int)blockIdx.x,
                      opq((GAS bf16*)(opq(ws) + WS_QMB)), (GAS bf16*)nullptr, 384, 384, opq((const GAS float*)(opq(ws) + WS_RS)), 0, 0);
            GEMM_SITE(EpiUp, (const GAS bf16*)PROJB + PC_CKV, INP, (const GAS bf16*)(opq(ws) + WS_WUKV) + (size_t)l * 512 * 256, 256, T, 512, 256, (int)blockIdx.x,
                      opq((GAS bf16*)(opq(ws) + WS_KMB)), opq((GAS bf16*)(opq(ws) + WS_VMB)), 0, 512, opq((const GAS float*)(opq(ws) + WS_RS)), 1, 1);
#endif
        }
        SEAM(pb + 3);
        if (IN(pb + 4)) {
            SITE();
            AttnP PM{opq((const GAS bf16*)(opq(ws) + WS_QMB)), opq((const GAS bf16*)(opq(ws) + WS_KMB)), opq((const GAS bf16*)(opq(ws) + WS_VMB)), 384, 384, 256, opq((GAS bf16*)(opq(ws) + WS_OMB)), 256, opq((const GAS float*)(opq(ws) + WS_ROPE)), nullptr, nullptr, nullptr, nullptr};
            AttnP PD{opq((const GAS bf16*)PROJB + PC_QD), opq((const GAS bf16*)PROJB + PC_KD), opq((const GAS bf16*)PROJB + PC_VD), INP, INP, INP, opq((GAS bf16*)(opq(ws) + WS_YB) + 768), 1024, nullptr,
                     (const GAS int*)args.in[opqi(2)], (const GAS float*)(opq(ws) + WS_BTAB), (const GAS float*)args.in[opqi(18)] + l * 64, (const GAS float*)(opq(ws) + WS_LAMS) + 2 * l};
            attn_phase(PM, PD, F.lds, TID_, wv_, LANE_, vcu_, G_);
#if MK_DUP == 4
            __syncthreads(); attn_phase(PM, PD, F.lds, TID_, wv_, LANE_, vcu_, G_);
#elif MK_DUP == 40 || MK_DUP == 41
            __syncthreads(); attn_phase(PM, PD, F.lds, TID_, wv_, LANE_, vcu_, G_, MK_DUP - 40);
#endif
        }
        SEAM(pb + 4);
        if (IN(pb + 5)) {
            SITE();
            PostP PP{opq((const GAS bf16*)(opq(ws) + WS_OMB)), opq((const GAS unsigned*)(opq(ws) + WS_HLB)), opq((const GAS float*)(opq(ws) + WS_LSUM)), opq((const GAS bf16*)PROJB), (const GAS float*)args.in[opqi(19)] + l * 256, (const GAS float*)args.in[opqi(20)] + l * 512, opq((GAS bf16*)(opq(ws) + WS_YB))};
            post_phase(PP, F.lds, TID_, wv_, LANE_, vcu_, G_);
#if MK_DUP == 5
            __syncthreads(); post_phase(PP, F.lds, TID_, wv_, LANE_, vcu_, G_);
#endif
        }
        SEAM(pb + 5);
        if (IN(pb + 6)) GEMM_SITE(EpiRes, YB, D, (const GAS bf16*)(opq(ws) + WS_WOUT) + (size_t)l * D * D, D, T, D, D, (int)blockIdx.x, opq((GAS bf16*)(opq(ws) + WS_XNB)), opq((GAS float*)(opq(ws) + WS_SSQ)));
#if MK_DUP == 6
        if (IN(pb + 6)) GEMM_SITE(EpiRes, YB, D, (const GAS bf16*)(opq(ws) + WS_WOUT) + (size_t)l * D * D, D, T, D, D, (int)blockIdx.x, opq((GAS bf16*)(opq(ws) + WS_HLB)), opq((GAS float*)(opq(ws) + WS_OMB)));
#endif
        SEAM(pb + 6);
        if (IN(pb + 8)) GEMM_SITE(EpiBf16, XNB, D, (const GAS bf16*)(opq(ws) + WS_WCQ) + (size_t)l * D * D, D, T, D, D, (int)blockIdx.x, opq(PROJB), D, D, opq((const GAS float*)(opq(ws) + WS_SSQ)), 16);
#if MK_DUP == 8
        if (IN(pb + 8)) GEMM_SITE(EpiBf16, XNB, D, (const GAS bf16*)(opq(ws) + WS_WCQ) + (size_t)l * D * D, D, T, D, D, (int)blockIdx.x, opq(PROJB), D, D, opq((const GAS float*)(opq(ws) + WS_SSQ)), 16);
#endif
        SEAM(pb + 8);
        if (IN(pb + 9)) {
            SITE();
            const GAS bf16* kv = (const GAS bf16*)(opq(ws) + WS_KVCB) + (size_t)l * NB * MEM * 2 * D;
            AttnP PC{opq((const GAS bf16*)PROJB), opq(kv), opq(kv + D), 1024, 2 * D, 2 * D, opq((GAS bf16*)(opq(ws) + WS_YB)), 1024, nullptr, nullptr, nullptr, nullptr, nullptr};
            cross_phase(PC, F.lds, TID_, wv_, LANE_, vcu_, G_);
#if MK_DUP == 9
            cross_phase(PC, F.lds, TID_, wv_, LANE_, vcu_, G_);
#endif
        }
        SEAM(pb + 9);
        if (IN(pb + 10)) GEMM_SITE(EpiRes, YB, D, (const GAS bf16*)(opq(ws) + WS_WCO) + (size_t)l * D * D, D, T, D, D, (int)blockIdx.x, opq((GAS bf16*)(opq(ws) + WS_XNB)), opq((GAS float*)(opq(ws) + WS_SSQ)));
        SEAM(pb + 10);
        if (IN(pb + 12)) { GEMM_SITE(EpiBf16, XNB, D, (const GAS bf16*)(opq(ws) + WS_WPQ) + (size_t)l * D * D, D, T, D, D, (int)blockIdx.x, opq(PROJB), D, D, opq((const GAS float*)(opq(ws) + WS_SSQ)), 16);
#if MK_DUP == 12
            hq_phase(opq(XNB), opq((const GAS float*)(opq(ws) + WS_SSQ)), (const GAS float*)args.in[opqi(27)] + l * D, opq((GAS unsigned char*)(opq(ws) + WS_HQ)), opq((GAS float*)(opq(ws) + WS_SH)), opq((GAS int*)(opq(ws) + WS_P)), gw_, NGW_, LANE_);
#endif
            }
        SEAM(pb + 12);
        if (IN(pb + 13)) {
            SITE();
            RouteP RP{opq((const GAS bf16*)PROJB), opq((const GAS bf16*)(opq(ws) + WS_KEYS) + (size_t)l * 2 * 128 * 64), opq((GAS int*)(opq(ws) + WS_EX)), opq((GAS float*)(opq(ws) + WS_GW))};
            route_phase(RP, F.lds, TID_, wv_, LANE_, vcu_, G_);
            hq_phase(opq(XNB), opq((const GAS float*)(opq(ws) + WS_SSQ)), (const GAS float*)args.in[opqi(27)] + l * D, opq((GAS unsigned char*)(opq(ws) + WS_HQ)), opq((GAS float*)(opq(ws) + WS_SH)), opq((GAS int*)(opq(ws) + WS_P)), gw_, NGW_, LANE_);
#if MK_DUP == 13
            route_phase(RP, F.lds, TID_, wv_, LANE_, vcu_, G_);
#endif
        }
        SEAM(pb + 13);
        if (IN(pb + 14)) {
            SITE();
            const PeerS ps = peer_sched((const GAS unsigned*)(F.ctl + CW_RANK), opqi(F.xcc), opqi(F.xrank));
            Peer1P Q1{opq((const GAS unsigned char*)(opq(ws) + WS_HQ)), opq((const GAS int*)(opq(ws) + WS_EX)), opq((const GAS unsigned char*)(opq(ws) + WS_U8) + (size_t)l * 16384 * 1024), opq((GAS int*)(opq(ws) + WS_PROJB))};
            peer_k1(Q1, ps, wv_, LANE_);
#if MK_DUP == 141
            { Peer1P Q1b = Q1; Q1b.P = (GAS int*)(opq(ws) + WS_HLB); peer_k1(Q1b, ps, wv_, LANE_); }
#endif
        }
        SEAM(pb + 14);
        if (IN(pb + 15)) {
            SITE();
            peer_w(opq((const GAS int*)(opq(ws) + WS_EX)), opq((const GAS float*)(opq(ws) + WS_GW)), opq((const GAS int*)(opq(ws) + WS_PROJB)), opq((const GAS float*)(opq(ws) + WS_SH)), opq((const GAS float*)(opq(ws) + WS_SU) + l * 16384), opq((const GAS float*)(opq(ws) + WS_SV) + l * 16384),
                   opq((GAS signed char*)(opq(ws) + WS_W)), opq((GAS float*)(opq(ws) + WS_WS)), gw_, NGW_, LANE_, F.lds, TID_);
#if MK_DUP == 150
            peer_w(opq((const GAS int*)(opq(ws) + WS_EX)), opq((const GAS float*)(opq(ws) + WS_GW)), opq((const GAS int*)(opq(ws) + WS_PROJB)), opq((const GAS float*)(opq(ws) + WS_SH)), opq((const GAS float*)(opq(ws) + WS_SU) + l * 16384), opq((const GAS float*)(opq(ws) + WS_SV) + l * 16384),
                   opq((GAS signed char*)(opq(ws) + WS_W)), opq((GAS float*)(opq(ws) + WS_WS)), gw_, NGW_, LANE_, F.lds, TID_);
#endif
            xcd_barrier(bar, (F.wave == 0 && lane_id_v() == 0) ? 1 : 0);
            const PeerS ps = peer_sched((const GAS unsigned*)(F.ctl + CW_RANK), opqi(F.xcc), opqi(F.xrank));
            Peer2P Q2{opq((const GAS int*)(opq(ws) + WS_EX)), opq((const GAS signed char*)(opq(ws) + WS_W)), opq((const GAS float*)(opq(ws) + WS_WS)), opq((const GAS unsigned char*)(opq(ws) + WS_V8) + (size_t)l * 16384 * 1024), opq((GAS bf16*)(opq(ws) + WS_XNB)), opq((GAS float*)(opq(ws) + WS_SSQ))};
            peer_k2(Q2, ps, wv_, LANE_);
#if MK_DUP == 151
            { Peer2P Q2b = Q2; Q2b.XB = (GAS bf16*)(opq(ws) + WS_HLB); Q2b.SSQ = (GAS float*)(opq(ws) + WS_OMB); peer_k2(Q2b, ps, wv_, LANE_); }
#endif
        }
        SEAM(pb + 15);
    }
    if (IN(PH_FINAL)) { SITE(); final_norm_phase(opq((const GAS bf16*)(opq(ws) + WS_XNB)), (GAS float*)args.out, (const GAS float*)args.in[opqi(32)], T, gw_, NGW_, LANE_); }
#undef IN
#undef SEAM
#undef GEMM_SITE
}
}
extern "C" void kernel_launch(void* const* d_in, const int* in_sizes, int n_in, void* d_out, int out_size, void* d_ws, size_t ws_size, hipStream_t stream) {
    (void)in_sizes; (void)out_size;
    static int grid = 0;
    if (grid == 0) {
        int dev = 0, cus = 0, per_cu = 0;
        if (n_in != 33 || ws_size < mk::WS_END) { fprintf(stderr, "kernel_launch: unexpected n_in %d / ws_size %zu\n", n_in, ws_size); grid = -1; return; }
        if (hipGetDevice(&dev) != hipSuccess || hipDeviceGetAttribute(&cus, hipDeviceAttributeMultiprocessorCount, dev) != hipSuccess) { grid = -1; return; }
        if (hipFuncSetAttribute((const void*)mk::fwd, hipFuncAttributeMaxDynamicSharedMemorySize, mk::LDS_BYTES) != hipSuccess) { fprintf(stderr, "kernel_launch: hipFuncSetAttribute failed\n"); grid = -1; return; }
        if (hipOccupancyMaxActiveBlocksPerMultiprocessor(&per_cu, (const void*)mk::fwd, mk::NWAVES * 64, mk::LDS_BYTES) != hipSuccess || per_cu < 1) fprintf(stderr, "kernel_launch: occupancy query says %d\n", per_cu);
        (void)hipGetLastError();
        grid = cus;
    }
    if (grid < 0) return;
    unsigned char* ws = (unsigned char*)d_ws;
    (void)hipMemsetAsync(ws + mk::WS_CTL, 0, mk::CTL_ZERO_BYTES, stream);
    mk::Args a{};
    for (int i = 0; i < 33; ++i) a.in[i] = (const float*)d_in[i];
    a.out = (float*)d_out; a.ws = ws;
    auto run = [&](int lo, int hi) { a.ph_lo = lo; a.ph_hi = hi; hipLaunchKernelGGL(mk::fwd, dim3(grid), dim3(mk::NWAVES * 64), mk::LDS_BYTES, stream, a); };
#if MK_ONE_LAUNCH
    run(0, mk::PH_FINAL + 1);
#else
    for (int p = 0; p <= mk::PH_FINAL; ++p) {
        const int k = (p - 2) % mk::NPL, l = (p - 2) / mk::NPL;
#if MK_NAIVE_PEER == 2
        if (p >= 2 && p < mk::PH_FINAL && k == 14) {
            hipLaunchKernelGGL(k_peer, dim3(T), dim3(256), 0, stream, (const bf16_t*)(ws + mk::WS_XNB), (const int*)(ws + mk::WS_EX), (const float*)(ws + mk::WS_GW), (const float*)d_in[30] + (size_t)l * NEXP * D, (const float*)d_in[31] + (size_t)l * NEXP * D, (float*)d_out);
            continue; }
#elif MK_NAIVE_PEER == 1
        if (p >= 2 && p < mk::PH_FINAL && k == 13) {
            float* TQ = (float*)(ws + (size_t)806 * mk::MiB);
            hipLaunchKernelGGL(k_bf2f, dim3((unsigned)(((size_t)T * D + 255) / 256)), dim3(256), 0, stream, (const bf16_t*)(ws + mk::WS_PROJB), TQ, (long)T * D);
            hipLaunchKernelGGL(k_route, dim3(T), dim3(256), 0, stream, TQ, (const float*)d_in[29] + (size_t)l * 2 * 128 * 64, (int*)(ws + mk::WS_EX), (float*)(ws + mk::WS_GW));
            hipLaunchKernelGGL(k_peer, dim3(T), dim3(256), 0, stream, (const bf16_t*)(ws + mk::WS_XNB), (const int*)(ws + mk::WS_EX), (const float*)(ws + mk::WS_GW), (const float*)d_in[30] + (size_t)l * NEXP * D, (const float*)d_in[31] + (size_t)l * NEXP * D, (float*)d_out);
            continue; }
        if (p >= 2 && p < mk::PH_FINAL && k == 14) continue;
#endif
        run(p, p + 1); }
#endif
}
```

```cpp
#include <hip/hip_runtime.h>
#include <cstdint>
#include <cstdio>
#include <cmath>

#ifndef MK_ONE_LAUNCH
#define MK_ONE_LAUNCH 1
#endif
#ifndef MK_DUP
#define MK_DUP 0
#endif
#ifndef MK_NAIVE_PEER
#define MK_NAIVE_PEER 0
#endif
namespace pg8 {
#define PG8_LAS __attribute__((address_space(3)))
#ifndef GAS
#define GAS __attribute__((address_space(1)))
#endif
typedef unsigned short bf16_t;
typedef short bf16x8 __attribute__((ext_vector_type(8)));
typedef float f32x4 __attribute__((ext_vector_type(4)));
typedef unsigned u32x4 __attribute__((ext_vector_type(4)));
typedef unsigned u32x2 __attribute__((ext_vector_type(2)));
constexpr int BM = 256, BK = 64, HALF = 128, HTB = HALF * BK * 2, STAGE_BYTES = 8 * HTB, NXCD = 8, WGM = 8;
__host__ __device__ __forceinline__ int lds_byte(int r, int c) { const int st = (r >> 4) * 2 + (c >> 5), rr = r & 15, cc = c & 31, ob = rr * 64 + cc * 2; return st * 1024 + (ob ^ (((ob >> 9) & 1) << 5)); }
__host__ __device__ __forceinline__ void stage_rc(int b, int& R, int& C) { const int st = b / 1024, sb = b % 1024, swz = sb ^ (((sb >> 9) & 1) << 5); R = (st >> 1) * 16 + swz / 64; C = (st & 1) * 32 + (swz % 64) / 2; }
__host__ __device__ __forceinline__ int perm32(int rho) { const int n = rho >> 4, i = rho & 15; return 8 * (i >> 2) + 4 * n + (i & 3); }
__device__ __forceinline__ int pg8_lane_id() { int l; asm volatile("v_mbcnt_lo_u32_b32 %0, -1, 0\n\tv_mbcnt_hi_u32_b32 %0, -1, %0" : "=v"(l)); return l; }
struct Unit { int pm, pn; };
struct Gemm { const GAS bf16_t* A; const GAS bf16_t* Bt; int M, N, K, lda, ldb; };
struct StaticOrder {
    int nM, nN, nwg, G, c;
    __host__ __device__ void init(int M, int N, int G_, int c_) { nM = M / BM; nN = N / BM; nwg = nM * nN; G = G_; c = c_; }
    __host__ __device__ bool next(int i, Unit& u) const {
        const long L = (long)i * G + c; if (L >= nwg) return false;
        int wgid = (int)L; { const int q = nwg / NXCD, r = nwg % NXCD, xcd = wgid % NXCD, off = wgid / NXCD; wgid = (xcd < r ? xcd * (q + 1) : r * (q + 1) + (xcd - r) * q) + off; }
        const int nig = WGM * nN, gid = wgid / nig, fm = gid * WGM, gsz = (nM - fm) < WGM ? (nM - fm) : WGM;
        u.pm = fm + ((wgid % nig) % gsz); u.pn = (wgid % nig) / gsz; return true;
    }
    __device__ __forceinline__ void a_ready(const Unit&) const {}
    __device__ __forceinline__ void done(const Unit&) const {}
};
__device__ __forceinline__ unsigned cvt_pk_bf16(float lo, float hi) { unsigned r; asm volatile("v_cvt_pk_bf16_f32 %0, %1, %2" : "=v"(r) : "v"(lo), "v"(hi)); return r; }

struct EpiF32 {
    static constexpr bool PERM = false, AFTER_DRAIN = false;
    GAS float* C; int ldc; int nvalid; int accum;
    __device__ __forceinline__ void operator()(const f32x4 (&acc)[2][2][4][2], const Unit& u, int wr, int wc, int fr, int fq) const {
        { const int l_ = pg8_lane_id(); fr = l_ & 15; fq = l_ >> 4; }
#pragma unroll
        for (int ai = 0; ai < 2; ++ai)
#pragma unroll
            for (int m = 0; m < 4; ++m) { const size_t row = (size_t)u.pm * BM + ai * HALF + wr * 64 + m * 16 + fr;
#pragma unroll
                for (int bj = 0; bj < 2; ++bj)
#pragma unroll
                    for (int n = 0; n < 2; ++n) { const int col = u.pn * BM + bj * HALF + wc * 32 + n * 16 + 4 * fq;
                        if (col < nvalid) { GAS float* p = C + row * ldc + col; f32x4 v = acc[ai][bj][m][n]; if (accum) v += *(const GAS f32x4*)p; *(GAS f32x4*)p = v; } } }
    }
};
struct EpiBf16 {
    static constexpr bool PERM = true, AFTER_DRAIN = false;
    GAS bf16_t* O; int ldc; int nvalid; const GAS float* ssq; int np;
    __device__ __forceinline__ void operator()(const f32x4 (&acc)[2][2][4][2], const Unit& u, int wr, int wc, int fr, int fq) const {
        { const int l_ = pg8_lane_id(); fr = l_ & 15; fq = l_ >> 4; }
#pragma unroll
        for (int ai = 0; ai < 2; ++ai)
#pragma unroll
            for (int m = 0; m < 4; ++m) { const size_t row = (size_t)u.pm * BM + ai * HALF + wr * 64 + m * 16 + fr;
                float rs_ = 1.f;
                if (np > 0) { const GAS f32x4* sp = (const GAS f32x4*)(ssq + row * 16); f32x4 t = sp[0] + sp[1]; if (np > 8) t += sp[2] + sp[3]; rs_ = __builtin_amdgcn_rsqf(((t[0] + t[1]) + (t[2] + t[3])) * (1.f / 1024.f) + 1e-6f); }
#pragma unroll
                for (int bj = 0; bj < 2; ++bj) { const int col = u.pn * BM + bj * HALF + wc * 32 + 8 * fq;
                    if (col < nvalid) { const f32x4 v0 = acc[ai][bj][m][0] * rs_, v1 = acc[ai][bj][m][1] * rs_; u32x4 w; w.x = cvt_pk_bf16(v0[0], v0[1]); w.y = cvt_pk_bf16(v0[2], v0[3]); w.z = cvt_pk_bf16(v1[0], v1[1]); w.w = cvt_pk_bf16(v1[2], v1[3]);
                        *(GAS u32x4*)(O + row * ldc + col) = w; } } }
    }
};
struct EpiUp {
    static constexpr bool PERM = true, AFTER_DRAIN = false;
    GAS bf16_t* O; GAS bf16_t* O2; int ldc; int nvalid; const GAS float* rs; int rsi; int mode;
    __device__ __forceinline__ void operator()(const f32x4 (&acc)[2][2][4][2], const Unit& u, int wr, int wc, int fr, int fq) const {
        { const int l_ = pg8_lane_id(); fr = l_ & 15; fq = l_ >> 4; }
#pragma unroll
        for (int ai = 0; ai < 2; ++ai)
#pragma unroll
            for (int m = 0; m < 4; ++m) { const size_t row = (size_t)u.pm * BM + ai * HALF + wr * 64 + m * 16 + fr; const float s = rs[2 * row + rsi];
#pragma unroll
                for (int bj = 0; bj < 2; ++bj) { const int col = u.pn * BM + bj * HALF + wc * 32 + 8 * fq;
                    if (col < nvalid) { const f32x4 v0 = acc[ai][bj][m][0] * s, v1 = acc[ai][bj][m][1] * s; u32x4 w; w.x = cvt_pk_bf16(v0[0], v0[1]); w.y = cvt_pk_bf16(v0[2], v0[3]); w.z = cvt_pk_bf16(v1[0], v1[1]); w.w = cvt_pk_bf16(v1[2], v1[3]);
                        GAS bf16_t* dst;
                        if (mode == 0) dst = O + row * ldc + col;
                        else { const int h = col >> 7, j = col & 127; dst = (j < 64) ? O + row * 384 + h * 96 + j : O2 + row * 256 + h * 64 + (j - 64); }
                        *(GAS u32x4*)dst = w; } } }
    }
};

struct EpiRes {
    static constexpr bool PERM = true, AFTER_DRAIN = false;
    GAS bf16_t* XB; GAS float* SSQ;
    __device__ __forceinline__ void operator()(const f32x4 (&acc)[2][2][4][2], const Unit& u, int wr, int wc, int fr, int fq) const {
        { const int l_ = pg8_lane_id(); fr = l_ & 15; fq = l_ >> 4; }
#pragma unroll
        for (int ai = 0; ai < 2; ++ai)
#pragma unroll
            for (int m = 0; m < 4; ++m) { const size_t row = (size_t)u.pm * BM + ai * HALF + wr * 64 + m * 16 + fr; float ss = 0.f;
#pragma unroll
                for (int bj = 0; bj < 2; ++bj) { GAS u32x4* p = (GAS u32x4*)(XB + row * 1024 + u.pn * BM + bj * HALF + wc * 32 + 8 * fq);
                    const u32x4 o = *p; const f32x4 v0 = acc[ai][bj][m][0], v1 = acc[ai][bj][m][1];
                    u32x4 w;
                    w.x = cvt_pk_bf16(__builtin_bit_cast(float, o.x << 16) + v0[0], __builtin_bit_cast(float, o.x & 0xffff0000u) + v0[1]);
                    w.y = cvt_pk_bf16(__builtin_bit_cast(float, o.y << 16) + v0[2], __builtin_bit_cast(float, o.y & 0xffff0000u) + v0[3]);
                    w.z = cvt_pk_bf16(__builtin_bit_cast(float, o.z << 16) + v1[0], __builtin_bit_cast(float, o.z & 0xffff0000u) + v1[1]);
                    w.w = cvt_pk_bf16(__builtin_bit_cast(float, o.w << 16) + v1[2], __builtin_bit_cast(float, o.w & 0xffff0000u) + v1[3]);
                    *p = w;
#pragma unroll
                    for (int e = 0; e < 4; ++e) { const float a = __builtin_bit_cast(float, w[e] << 16), b = __builtin_bit_cast(float, w[e] & 0xffff0000u); ss += a * a + b * b; } }
                { float a = ss, b = ss; asm volatile("v_nop\n\tv_nop\n\tv_permlane16_swap_b32 %0, %1" : "+v"(a), "+v"(b)); ss = a + b; }
                { float a = ss, b = ss; asm volatile("v_nop\n\tv_nop\n\tv_permlane32_swap_b32 %0, %1" : "+v"(a), "+v"(b)); ss = a + b; }
                if (fq == 0) SSQ[row * 16 + 4 * u.pn + wc] = ss; }
    }
};
template <class Epi, class Sched, bool ALIGN_EPI = false, bool SP2 = false>
__device__ __forceinline__ void gemm_phase(PG8_LAS unsigned char* lds, const Gemm g, const Sched& S, const Epi& E, int wave_id) {
    int tid_ = (wave_id << 6) | pg8_lane_id(); asm volatile("" : "+v"(tid_));
    const int tid = tid_, wid = __builtin_amdgcn_readfirstlane(tid >> 6), lane = tid & 63, wr = wid >> 2, wc = wid & 3, fr = lane & 15, fq = lane >> 4;
    const int K = g.K, nt = K / BK;
    unsigned voffA[2], voffB[2];
#pragma unroll
    for (int i = 0; i < 2; ++i) { int R, C; stage_rc(tid * 16 + i * 8192, R, C); const int Rb = Epi::PERM ? ((R & ~31) + perm32(R & 31)) : R;
        voffA[i] = (unsigned)(R * g.lda + C) * 2u; voffB[i] = (unsigned)(Rb * g.ldb + C) * 2u; }
    const size_t kstep = (size_t)(BK * 2);
    const size_t hstepA = (size_t)HALF * g.lda * 2, hstepB = (size_t)HALF * g.ldb * 2;
    const size_t tstepA = 2 * hstepA, tstepB = 2 * hstepB;
    const unsigned ldsw = (unsigned)wid * 1024u;
    const int aoff = lds_byte(wr * 64 + fr, fq * 8), boff = lds_byte(wc * 32 + fr, fq * 8);
#define PG8_SA(b, h) (((b) * 2 + (h)) * HTB)
#define PG8_SB(b, h) ((4 + (b) * 2 + (h)) * HTB)
#define PG8_STAGE(bufoff, gbase, voff) do { _Pragma("unroll") for (int _i = 0; _i < 2; ++_i) \
        __builtin_amdgcn_global_load_lds((const unsigned*)((const char*)(gbase) + (voff)[_i]), (PG8_LAS unsigned*)(lds + (bufoff) + ldsw + _i * 8192), 16, 0, 0); } while (0)
#define PG8_LDA(dst, b, h) do { _Pragma("unroll") for (int m = 0; m < 4; ++m) _Pragma("unroll") for (int k = 0; k < 2; ++k) dst[m][k] = *(const PG8_LAS bf16x8*)(lds + PG8_SA(b, h) + aoff + m * 2048 + k * 1024); } while (0)
#define PG8_LDB(dst, b, h) do { _Pragma("unroll") for (int n = 0; n < 2; ++n) _Pragma("unroll") for (int k = 0; k < 2; ++k) dst[n][k] = *(const PG8_LAS bf16x8*)(lds + PG8_SB(b, h) + boff + n * 2048 + k * 1024); } while (0)
#define PG8_MMA(ai, bj, At, Bt) do { __builtin_amdgcn_s_setprio(1); _Pragma("unroll") for (int m = 0; m < 4; ++m) _Pragma("unroll") for (int n = 0; n < 2; ++n) _Pragma("unroll") for (int k = 0; k < 2; ++k) \
        acc[ai][bj][m][n] = __builtin_amdgcn_mfma_f32_16x16x32_bf16(Bt[n][k], At[m][k], acc[ai][bj][m][n], 0, 0, 0); __builtin_amdgcn_s_setprio(0); } while (0)
#define PG8_WAIT_V(n) asm volatile("s_waitcnt vmcnt(" #n ")" ::: "memory")
#define PG8_WAIT_L(n) asm volatile("s_waitcnt lgkmcnt(" #n ")" ::: "memory")
#define PG8_BAR __builtin_amdgcn_s_barrier()
#define PG8_SCHED __builtin_amdgcn_sched_barrier(0)
    Unit cur, nxt; int ui = 0;
    if (!S.next(0, cur)) return;
    f32x4 acc[2][2][4][2];
#pragma unroll
    for (int a = 0; a < 2; ++a)
#pragma unroll
        for (int b = 0; b < 2; ++b)
#pragma unroll
            for (int m = 0; m < 4; ++m)
#pragma unroll
                for (int n = 0; n < 2; ++n) acc[a][b][m][n] = (f32x4){0.f, 0.f, 0.f, 0.f};
    bf16x8 At[4][2], B0[2][2], B1[2][2];
    const char* cA = (const char*)g.A + (size_t)cur.pm * tstepA; const char* cB = (const char*)g.Bt + (size_t)cur.pn * tstepB;
    S.a_ready(cur);
    if constexpr (SP2) {
        PG8_STAGE(PG8_SB(0, 0), cB, voffB); PG8_STAGE(PG8_SB(0, 1), cB + hstepB, voffB); PG8_STAGE(PG8_SA(0, 0), cA, voffA); PG8_STAGE(PG8_SA(0, 1), cA + hstepA, voffA);
        if (wr == 1) PG8_BAR;
        PG8_WAIT_V(2); PG8_BAR;
        PG8_STAGE(PG8_SB(1, 0), cB + kstep, voffB); PG8_STAGE(PG8_SA(1, 0), cA + kstep, voffA); PG8_STAGE(PG8_SB(1, 1), cB + hstepB + kstep, voffB);
        PG8_WAIT_V(6); PG8_BAR;
    } else {
        PG8_STAGE(PG8_SB(0, 0), cB, voffB); PG8_STAGE(PG8_SA(0, 0), cA, voffA); PG8_STAGE(PG8_SB(0, 1), cB + hstepB, voffB); PG8_STAGE(PG8_SA(0, 1), cA + hstepA, voffA);
        if (wr == 1) PG8_BAR;
        PG8_WAIT_V(4); PG8_BAR;
        PG8_STAGE(PG8_SB(1, 0), cB + kstep, voffB); PG8_STAGE(PG8_SA(1, 0), cA + kstep, voffA); PG8_STAGE(PG8_SB(1, 1), cB + hstepB + kstep, voffB);
        PG8_WAIT_V(6); PG8_BAR;
    }
    for (;;) {
        const bool has_next = S.next(ui + 1, nxt);
        const char* nA = has_next ? (const char*)g.A + (size_t)nxt.pm * tstepA : cA; const char* nB = has_next ? (const char*)g.Bt + (size_t)nxt.pn * tstepB : cB;
        for (int t = 0; t < nt; t += 2) {
            const bool last = (t == nt - 2);
            const char* a1 = cA + (size_t)(t + 1) * kstep;
            const char* a2 = last ? nA : cA + (size_t)(t + 2) * kstep; const char* b2 = last ? nB : cB + (size_t)(t + 2) * kstep;
            const char* a3 = a2 + kstep; const char* b3 = b2 + kstep;
            if (last && has_next) S.a_ready(nxt);
            if constexpr (SP2) {
            PG8_LDB(B0, 0, 0); PG8_LDB(B1, 0, 1); PG8_SCHED; PG8_LDA(At, 0, 0); PG8_STAGE(PG8_SA(1, 1), a1 + hstepA, voffA);
            PG8_WAIT_V(8); PG8_WAIT_L(0); PG8_BAR; PG8_MMA(0, 0, At, B0); PG8_MMA(0, 1, At, B1); PG8_BAR; PG8_SCHED;
            PG8_LDA(At, 0, 1); PG8_STAGE(PG8_SB(0, 0), b2, voffB); PG8_STAGE(PG8_SB(0, 1), b2 + hstepB, voffB); PG8_STAGE(PG8_SA(0, 0), a2, voffA);
            PG8_WAIT_V(8); PG8_WAIT_L(0); PG8_BAR; PG8_MMA(1, 0, At, B0); PG8_MMA(1, 1, At, B1); PG8_BAR; PG8_SCHED;
            PG8_LDB(B0, 1, 0); PG8_LDB(B1, 1, 1); PG8_SCHED; PG8_LDA(At, 1, 0); PG8_STAGE(PG8_SA(0, 1), a2 + hstepA, voffA);
            PG8_WAIT_V(8); PG8_WAIT_L(0); PG8_BAR; PG8_MMA(0, 0, At, B0); PG8_MMA(0, 1, At, B1); PG8_BAR; PG8_SCHED;
            PG8_LDA(At, 1, 1); PG8_STAGE(PG8_SB(1, 0), b3, voffB); PG8_STAGE(PG8_SB(1, 1), b3 + hstepB, voffB); PG8_STAGE(PG8_SA(1, 0), a3, voffA);
            PG8_WAIT_V(8); PG8_WAIT_L(0); PG8_BAR; PG8_MMA(1, 0, At, B0); PG8_MMA(1, 1, At, B1); PG8_BAR; PG8_SCHED;
            } else {
            PG8_LDB(B0, 0, 0); PG8_SCHED; PG8_LDA(At, 0, 0); PG8_STAGE(PG8_SA(1, 1), a1 + hstepA, voffA);
            PG8_WAIT_L(8); PG8_BAR; PG8_WAIT_L(0); PG8_MMA(0, 0, At, B0); PG8_BAR; PG8_SCHED;
            PG8_LDB(B1, 0, 1); PG8_STAGE(PG8_SB(0, 0), b2, voffB);
            PG8_BAR; PG8_WAIT_L(0); PG8_MMA(0, 1, At, B1); PG8_BAR;
            PG8_LDA(At, 0, 1); PG8_STAGE(PG8_SA(0, 0), a2, voffA);
            PG8_BAR; PG8_WAIT_L(0); PG8_MMA(1, 0, At, B0); PG8_BAR; PG8_SCHED;
            PG8_STAGE(PG8_SB(0, 1), b2 + hstepB, voffB);
            PG8_WAIT_V(6); PG8_BAR; PG8_MMA(1, 1, At, B1); PG8_BAR;
            PG8_LDB(B0, 1, 0); PG8_SCHED; PG8_LDA(At, 1, 0); PG8_STAGE(PG8_SA(0, 1), a2 + hstepA, voffA);
            PG8_WAIT_L(8); PG8_BAR; PG8_WAIT_L(0); PG8_MMA(0, 0, At, B0); PG8_BAR; PG8_SCHED;
            PG8_LDB(B1, 1, 1); PG8_STAGE(PG8_SB(1, 0), b3, voffB);
            PG8_BAR; PG8_WAIT_L(0); PG8_MMA(0, 1, At, B1); PG8_BAR;
            PG8_LDA(At, 1, 1); PG8_STAGE(PG8_SA(1, 0), a3, voffA);
            PG8_BAR; PG8_WAIT_L(0); PG8_MMA(1, 0, At, B0); PG8_BAR; PG8_SCHED;
            PG8_STAGE(PG8_SB(1, 1), b3 + hstepB, voffB);
            PG8_WAIT_V(6); PG8_BAR; PG8_MMA(1, 1, At, B1); PG8_BAR;
            }
        }
        if constexpr (ALIGN_EPI) { if (wr == 0) PG8_BAR; }
        if constexpr (!Epi::AFTER_DRAIN) { E(acc, cur, wr, wc, fr, fq); S.done(cur); }
        if (!has_next) break;
#pragma unroll
        for (int a = 0; a < 2; ++a)
#pragma unroll
            for (int b = 0; b < 2; ++b)
#pragma unroll
                for (int m = 0; m < 4; ++m)
#pragma unroll
                    for (int n = 0; n < 2; ++n) acc[a][b][m][n] = (f32x4){0.f, 0.f, 0.f, 0.f};
        cur = nxt; cA = nA; cB = nB; ++ui;
        if constexpr (ALIGN_EPI) { if (wr == 1) PG8_BAR; }
    }
    PG8_WAIT_V(0);
    if constexpr (!ALIGN_EPI) { if (wr == 0) PG8_BAR; }
    PG8_BAR;
    if constexpr (Epi::AFTER_DRAIN) { E.fused(acc, cur, wr, wc, fr, fq, lds, wid, lane); S.done(cur); }
#undef PG8_SA
#undef PG8_SB
#undef PG8_STAGE
#undef PG8_LDA
#undef PG8_LDB
#undef PG8_MMA
#undef PG8_WAIT_V
#undef PG8_WAIT_L
#undef PG8_BAR
#undef PG8_SCHED
}
}

namespace mk {
#ifndef GAS
#define GAS __attribute__((address_space(1)))
#endif
#define LAS __attribute__((address_space(3)))
typedef unsigned short bf16;
typedef unsigned v4u __attribute__((ext_vector_type(4)));
typedef unsigned v2u __attribute__((ext_vector_type(2)));
typedef float f32x4 __attribute__((ext_vector_type(4)));
typedef GAS unsigned gu32;
#define LDS_WAIT() asm volatile("s_waitcnt lgkmcnt(0)" ::: "memory")
#define VM_WAIT() asm volatile("s_waitcnt vmcnt(0)" ::: "memory")
__device__ __forceinline__ unsigned f2bf_(float f) { unsigned u = __builtin_bit_cast(unsigned, f); return (u + 0x7fffu + ((u >> 16) & 1u)) >> 16; }
__device__ __forceinline__ unsigned pk2(float lo, float hi) { return f2bf_(lo) | (f2bf_(hi) << 16); }
__device__ __forceinline__ float bflo(unsigned w) { return __builtin_bit_cast(float, w << 16); }
__device__ __forceinline__ float bfhi(unsigned w) { return __builtin_bit_cast(float, w & 0xffff0000u); }

template <class P> __device__ __forceinline__ P* opq(P* p) { asm volatile("" : "+s"(p)); return p; }
__device__ __forceinline__ int opqi(int k) { asm volatile("" : "+s"(k)); return k; }
__device__ __forceinline__ float shx(float v, int o, int lane) { return __builtin_bit_cast(float, __builtin_amdgcn_ds_bpermute((lane ^ o) << 2, __builtin_bit_cast(int, v))); }
__device__ __forceinline__ int shxi(int v, int o, int lane) { return __builtin_amdgcn_ds_bpermute((lane ^ o) << 2, v); }
__device__ __forceinline__ int lane_id_v() { int l; asm volatile("v_mbcnt_lo_u32_b32 %0, -1, 0\n\tv_mbcnt_hi_u32_b32 %0, -1, %0" : "=v"(l)); return l; }
constexpr int NWAVES = 8;
constexpr int D = 1024, NB = 4, S = 8192, T = NB * S, L = 4, MEM = 256, INW = 2144, INP = 2304;
constexpr int PC_CQ = 0, PC_CKV = 256, PC_KR = 384, PC_XL = 512, PC_GL = 1024, PC_QD = 1536, PC_KD = 1792, PC_VD = 2048;
constexpr float LOG2E = 1.4426950408889634f;
constexpr size_t MiB = 1u << 20;
constexpr size_t WS_CTL = 0, CTL_ZERO_BYTES = 1 * MiB;
constexpr size_t WS_WIN = 1 * MiB, WS_WOUT = 19 * MiB, WS_WCQ = 27 * MiB, WS_WCO = 35 * MiB, WS_WPQ = 43 * MiB, WS_WCKV = 51 * MiB, WS_WUQ = 67 * MiB, WS_WUKV = 68 * MiB, WS_KEYS = 69 * MiB, WS_ROPE = 70 * MiB;
constexpr size_t WS_XNB = 76 * MiB, WS_YB = 140 * MiB, WS_PROJB = 204 * MiB, WS_QMB = 348 * MiB, WS_KMB = 372 * MiB, WS_VMB = 396 * MiB, WS_RS = 412 * MiB;
constexpr size_t WS_HLB = 413 * MiB, WS_ACB = 445 * MiB, WS_LSUM = 477 * MiB, WS_OMB = 478 * MiB, WS_MNB = 494 * MiB, WS_KVCB = 502 * MiB, WS_EX = 518 * MiB, WS_GW = 534 * MiB;
constexpr size_t WS_U8 = 550 * MiB, WS_V8 = 614 * MiB, WS_SU = 678 * MiB, WS_SV = 679 * MiB;
constexpr size_t WS_HQ = 680 * MiB, WS_P = 712 * MiB, WS_SH = 728 * MiB, WS_W = 729 * MiB, WS_WS = 745 * MiB, WS_SSQ = 746 * MiB, WS_END = 748 * MiB;
constexpr size_t WS_WAT = 74 * MiB;
constexpr size_t WS_BTAB = WS_KEYS + 512 * 1024, WS_LAMS = WS_BTAB + 4096, WS_SP = WS_LAMS + 4096;
constexpr int CW_BAR = 4096, CW_RANK = 8192;
constexpr int RING_OFF = 0, RING_BYTES = 155648, LDSCTL_OFF = RING_BYTES, MISC_OFF = LDSCTL_OFF + 320, LDS_BYTES = 163840;

#define XB_TMO      128
#define XB_XCNT(j)  (256  + 64 * (j))
#define XB_XSUB(j)  (1280 + 64 * (j))
#define XB_XGEN(j)  (2304 + 64 * (j))
#define XB_TOP      3328
#define XB_TOPGEN   3392
#define XCD_BAR_WORDS 3456
#define XB_SPIN_CAP (1u << 18)

__device__ __forceinline__ unsigned xb_ld(unsigned* p)              { return __hip_atomic_load(p, __ATOMIC_RELAXED, __HIP_MEMORY_SCOPE_AGENT); }
__device__ __forceinline__ unsigned xb_add(unsigned* p, unsigned v) { return __hip_atomic_fetch_add(p, v, __ATOMIC_RELAXED, __HIP_MEMORY_SCOPE_AGENT); }
__device__ __forceinline__ unsigned xb_xcc_id() { return (unsigned)__builtin_amdgcn_s_getreg((3 << 11) | 20) & 0xFu; }
#define XB_SPIN(cond, bar) do { unsigned _sp = 0; while (cond) { __builtin_amdgcn_s_sleep(1); \
    if ((++_sp & 255u) == 0u) { if (xb_ld(&(bar)[XB_TMO])) break; if (_sp > XB_SPIN_CAP) { atomicAdd(&(bar)[XB_TMO], 1u); break; } } } } while (0)

struct XcdBarrier {
    unsigned* bar; unsigned x;
    volatile LAS unsigned* st;
};

__device__ __forceinline__ XcdBarrier xcd_barrier_post(unsigned* bar, volatile LAS unsigned* st) {
    XcdBarrier b; b.bar = bar; b.x = xb_xcc_id(); b.st = st;
    if (threadIdx.x == 0) (void)xb_add(&bar[XB_XCNT(b.x)], 1u);
    return b;
}
__device__ __forceinline__ void xcd_barrier_complete(unsigned* bar, unsigned x, unsigned& nloc, unsigned& nx) {
    const unsigned G = gridDim.x * gridDim.y * gridDim.z;
    unsigned sum, cnt, mine, sp = 0u;
    for (;;) {
        sum = 0u; cnt = 0u; mine = 0u;
#pragma unroll
        for (unsigned j = 0; j < 16; ++j) { const unsigned c = xb_ld(&bar[XB_XCNT(j)]); sum += c; cnt += (c > 0u) ? 1u : 0u; mine = (j == x) ? c : mine; }
        if (sum == G) break;
        __builtin_amdgcn_s_sleep(1);
        if ((++sp & 255u) == 0u) { if (xb_ld(&bar[XB_TMO])) break; if (sp > XB_SPIN_CAP) { atomicAdd(&bar[XB_TMO], 1u); break; } }
    }
    nloc = mine > 0u ? mine : 1u; nx = cnt > 0u ? cnt : 1u;
}

__device__ __noinline__ void xcd_barrier_impl(unsigned* bar_, unsigned x_, volatile LAS unsigned* st_, int leader_) {
    XcdBarrier b; b.bar = bar_; b.x = x_; b.st = st_;
    asm volatile("s_waitcnt vmcnt(0)" ::: "memory");
    __syncthreads();
    if (leader_) {
        unsigned* bar = b.bar;
        __builtin_amdgcn_s_waitcnt(0);
        unsigned nloc = b.st[0], nx = b.st[1];
        if (nloc == 0u) { xcd_barrier_complete(bar, b.x, nloc, nx); b.st[0] = nloc; b.st[1] = nx; }
        const unsigned old = xb_add(&bar[XB_XSUB(b.x)], 1u);
        const unsigned gen = old / nloc;
        if (old + 1u == (gen + 1u) * nloc) {
            __builtin_amdgcn_fence(__ATOMIC_RELEASE, "agent");
            asm volatile("s_waitcnt vmcnt(0)" ::: "memory");
            const unsigned og = xb_add(&bar[XB_TOP], 1u);
            const unsigned tg = og / nx;
            if (og + 1u == (tg + 1u) * nx) xb_add(&bar[XB_TOPGEN], 1u);
            else XB_SPIN(xb_ld(&bar[XB_TOPGEN]) == tg, bar);
            __builtin_amdgcn_fence(__ATOMIC_ACQUIRE, "agent");
            xb_add(&bar[XB_XGEN(b.x)], 1u);
            asm volatile("s_waitcnt vmcnt(0)" ::: "memory");
        } else {
            XB_SPIN(xb_ld(&bar[XB_XGEN(b.x)]) == gen, bar);
            __builtin_amdgcn_fence(__ATOMIC_ACQUIRE, "agent");
            asm volatile("s_waitcnt vmcnt(0)" ::: "memory");
        }
    }
    __syncthreads();
}
__device__ __forceinline__ void xcd_barrier(const XcdBarrier& b, int leader) { xcd_barrier_impl(b.bar, b.x, b.st, leader); }


__device__ __forceinline__ float wave_sum(float v, int lane) {
    (void)lane;
    v += __builtin_bit_cast(float, __builtin_amdgcn_update_dpp(0, __builtin_bit_cast(int, v), 0xB1, 0xF, 0xF, true));
    v += __builtin_bit_cast(float, __builtin_amdgcn_update_dpp(0, __builtin_bit_cast(int, v), 0x4E, 0xF, 0xF, true));
    v += __builtin_bit_cast(float, __builtin_amdgcn_update_dpp(0, __builtin_bit_cast(int, v), 0x141, 0xF, 0xF, true));
    v += __builtin_bit_cast(float, __builtin_amdgcn_update_dpp(0, __builtin_bit_cast(int, v), 0x140, 0xF, 0xF, true));
    { float a = v, b = v; asm volatile("v_nop\n\tv_nop\n\tv_permlane16_swap_b32 %0, %1" : "+v"(a), "+v"(b)); v = a + b; }
    { float a = v, b = v; asm volatile("v_nop\n\tv_nop\n\tv_permlane32_swap_b32 %0, %1" : "+v"(a), "+v"(b)); v = a + b; }
    return v;
}
__device__ __forceinline__ float wave_max(float v) {
    v = fmaxf(v, __builtin_bit_cast(float, __builtin_amdgcn_update_dpp(0, __builtin_bit_cast(int, v), 0xB1, 0xF, 0xF, true)));
    v = fmaxf(v, __builtin_bit_cast(float, __builtin_amdgcn_update_dpp(0, __builtin_bit_cast(int, v), 0x4E, 0xF, 0xF, true)));
    v = fmaxf(v, __builtin_bit_cast(float, __builtin_amdgcn_update_dpp(0, __builtin_bit_cast(int, v), 0x141, 0xF, 0xF, true)));
    v = fmaxf(v, __builtin_bit_cast(float, __builtin_amdgcn_update_dpp(0, __builtin_bit_cast(int, v), 0x140, 0xF, 0xF, true)));
    { float a = v, b = v; asm volatile("v_nop\n\tv_nop\n\tv_permlane16_swap_b32 %0, %1" : "+v"(a), "+v"(b)); v = fmaxf(a, b); }
    { float a = v, b = v; asm volatile("v_nop\n\tv_nop\n\tv_permlane32_swap_b32 %0, %1" : "+v"(a), "+v"(b)); v = fmaxf(a, b); }
    return v;
}
__device__ __forceinline__ float gelu_erf(float v) {
    const float av = __builtin_fabsf(v), t = __builtin_amdgcn_rcpf(av * 0.2316418882f + 1.0f);
    float q = t * 0.5307027145f + (-0.7265760135f); q = q * t + 0.7107068705f; q = q * t + (-0.142248368f); q = q * t + 0.127414796f; q = q * t;
    const float e = __builtin_amdgcn_exp2f((v * v) * (-0.72134752044f));
    const float m = v * (q * e);
    return v < 0.f ? m : v - m;
}

__device__ __forceinline__ void norm_phase(const GAS float* X, const GAS float* g, GAS bf16* out, int rows, int gw, int NGW, int lane) {
    asm volatile("" : "+v"(lane));
    f32x4 gv[4];
#pragma unroll
    for (int j = 0; j < 4; ++j) gv[j] = ((const GAS f32x4*)g)[lane + 64 * j];
    for (int m = gw; m < rows; m += NGW) {
        const GAS f32x4* xr = (const GAS f32x4*)(X + (size_t)m * D) + lane;
        f32x4 v[4]; float s = 0.f;
#pragma unroll
        for (int j = 0; j < 4; ++j) { v[j] = xr[64 * j]; s += (v[j].x * v[j].x + v[j].y * v[j].y) + (v[j].z * v[j].z + v[j].w * v[j].w); }
        const float rs = rsqrtf(wave_sum(s, lane) * (1.f / D) + 1e-6f);
        GAS v2u* o8 = (GAS v2u*)(out + (size_t)m * D) + lane;
#pragma unroll
        for (int j = 0; j < 4; ++j) { v2u w; w.x = pk2(v[j].x * rs * gv[j].x, v[j].y * rs * gv[j].y); w.y = pk2(v[j].z * rs * gv[j].z, v[j].w * rs * gv[j].w); o8[64 * j] = w; }
    }
}
__device__ __forceinline__ void hq_phase(const GAS bf16* XB, const GAS float* SSQ, const GAS float* g, GAS unsigned char* HQ, GAS float* SH, GAS int* Pz, int gw, int NGW, int lane) {
    asm volatile("" : "+v"(lane));
    const GAS f32x4* gp = (const GAS f32x4*)g + 4 * lane; const f32x4 g0 = gp[0], g1 = gp[1], g2 = gp[2], g3 = gp[3];
    for (int m = gw; m < T; m += NGW) {
        const GAS f32x4* sp = (const GAS f32x4*)(SSQ + (size_t)m * 16); const f32x4 t = (sp[0] + sp[1]) + (sp[2] + sp[3]);
        const float rs = __builtin_amdgcn_rsqf(((t[0] + t[1]) + (t[2] + t[3])) * (1.f / 1024.f) + 1e-6f);
        const v4u a = *(const GAS v4u*)(XB + (size_t)m * D + 16 * lane), b = *(const GAS v4u*)(XB + (size_t)m * D + 16 * lane + 8);
        float f[16] = {bflo(a.x) * g0[0], bfhi(a.x) * g0[1], bflo(a.y) * g0[2], bfhi(a.y) * g0[3], bflo(a.z) * g1[0], bfhi(a.z) * g1[1], bflo(a.w) * g1[2], bfhi(a.w) * g1[3],
                       bflo(b.x) * g2[0], bfhi(b.x) * g2[1], bflo(b.y) * g2[2], bfhi(b.y) * g2[3], bflo(b.z) * g3[0], bfhi(b.z) * g3[1], bflo(b.w) * g3[2], bfhi(b.w) * g3[3]};
        float mx = 0.f;
#pragma unroll
        for (int i = 0; i < 16; ++i) { f[i] *= rs; mx = fmaxf(mx, __builtin_fabsf(f[i])); }
        mx = wave_max(mx);
        const float inv = mx > 0.f ? 127.f / mx : 0.f;
        v4u q;
#pragma unroll
        for (int i = 0; i < 4; ++i) { const int ia = (int)__builtin_rintf(f[4 * i] * inv), ib = (int)__builtin_rintf(f[4 * i + 1] * inv), ic = (int)__builtin_rintf(f[4 * i + 2] * inv), id = (int)__builtin_rintf(f[4 * i + 3] * inv);
            q[i] = (unsigned)(ia & 255) | ((unsigned)(ib & 255) << 8) | ((unsigned)(ic & 255) << 16) | ((unsigned)(id & 255) << 24); }
        *(GAS v4u*)(HQ + (size_t)m * D + 16 * lane) = q;
        if (lane == 0) SH[m] = mx * (1.f / 127.f);
    }
}
__device__ __forceinline__ void x0_phase(const GAS float* X, GAS bf16* XB, GAS float* SSQ, int gw, int NGW, int lane) {
    asm volatile("" : "+v"(lane));
    for (int m = gw; m < T; m += NGW) {
        const GAS f32x4* xr = (const GAS f32x4*)(X + (size_t)m * D) + lane; GAS v2u* o8 = (GAS v2u*)(XB + (size_t)m * D) + lane;
        float s = 0.f;
#pragma unroll
        for (int j = 0; j < 4; ++j) { const f32x4 v = xr[64 * j]; s += (v.x * v.x + v.y * v.y) + (v.z * v.z + v.w * v.w); v2u w; w.x = pk2(v.x, v.y); w.y = pk2(v.z, v.w); o8[64 * j] = w; }
        s = wave_sum(s, lane);
        if (lane < 8) SSQ[(size_t)m * 16 + lane] = lane == 0 ? s : 0.f;
    }
}
__device__ __forceinline__ void final_norm_phase(const GAS bf16* XB, GAS float* O, const GAS float* g, int rows, int gw, int NGW, int lane) {
    asm volatile("" : "+v"(lane));
    for (int m = gw; m < rows; m += NGW) {
        const GAS v4u* xr = (const GAS v4u*)(XB + (size_t)m * D) + lane;
        v4u v[2]; float s = 0.f;
#pragma unroll
        for (int j = 0; j < 2; ++j) { v[j] = xr[64 * j];
#pragma unroll
            for (int e = 0; e < 4; ++e) { const float a = bflo(v[j][e]), b = bfhi(v[j][e]); s += a * a + b * b; } }
        const float rs = rsqrtf(wave_sum(s, lane) * (1.f / D) + 1e-6f);
#pragma unroll
        for (int j = 0; j < 2; ++j) { const int c = 8 * (lane + 64 * j); const f32x4 g0 = *(const GAS f32x4*)(g + c), g1 = *(const GAS f32x4*)(g + c + 4);
            f32x4 o0, o1; o0.x = bflo(v[j].x) * rs * g0.x; o0.y = bfhi(v[j].x) * rs * g0.y; o0.z = bflo(v[j].y) * rs * g0.z; o0.w = bfhi(v[j].y) * rs * g0.w;
            o1.x = bflo(v[j].z) * rs * g1.x; o1.y = bfhi(v[j].z) * rs * g1.y; o1.z = bflo(v[j].w) * rs * g1.z; o1.w = bfhi(v[j].w) * rs * g1.w;
            *(GAS f32x4*)(O + (size_t)m * D + c) = o0; *(GAS f32x4*)(O + (size_t)m * D + c + 4) = o1; }
    }
}

__device__ __forceinline__ float row16_sum(float v) {
    v += __builtin_bit_cast(float, __builtin_amdgcn_update_dpp(0, __builtin_bit_cast(int, v), 0xB1, 0xF, 0xF, true));
    v += __builtin_bit_cast(float, __builtin_amdgcn_update_dpp(0, __builtin_bit_cast(int, v), 0x4E, 0xF, 0xF, true));
    v += __builtin_bit_cast(float, __builtin_amdgcn_update_dpp(0, __builtin_bit_cast(int, v), 0x141, 0xF, 0xF, true));
    v += __builtin_bit_cast(float, __builtin_amdgcn_update_dpp(0, __builtin_bit_cast(int, v), 0x140, 0xF, 0xF, true));
    return v;
}
__device__ __forceinline__ float sq8(const v4u w) { const float a0 = bflo(w.x), a1 = bfhi(w.x), a2 = bflo(w.y), a3 = bfhi(w.y), a4 = bflo(w.z), a5 = bfhi(w.z), a6 = bflo(w.w), a7 = bfhi(w.w);
    return (a0 * a0 + a1 * a1) + (a2 * a2 + a3 * a3) + (a4 * a4 + a5 * a5) + (a6 * a6 + a7 * a7); }
__device__ __forceinline__ void pre_phase(const GAS bf16* PROJB, const GAS float* ROPE, GAS float* RS, GAS bf16* KMB, int gw, int NGW, int lane) {
    asm volatile("" : "+v"(lane));
    const int q = lane >> 4, sub = lane & 15;
    for (int t0 = gw * 4; t0 < T; t0 += NGW * 4) {
        const size_t t = (size_t)t0 + q;
        const GAS bf16* pr = PROJB + t * INP;
        const v4u w0 = *(const GAS v4u*)(pr + PC_CQ + 8 * sub), w1 = *(const GAS v4u*)(pr + PC_CQ + 8 * (16 + (sub & 7))), w2 = *(const GAS v4u*)(pr + PC_CKV + 8 * sub);
        const float x1 = __builtin_bit_cast(float, (unsigned)pr[PC_KR + sub] << 16), x2 = __builtin_bit_cast(float, (unsigned)pr[PC_KR + 16 + sub] << 16);
        const float c = ROPE[t * 32 + sub], sn = ROPE[t * 32 + 16 + sub];
        const float sq = row16_sum(sq8(w0) + (sub < 8 ? sq8(w1) : 0.f)), skv = row16_sum(sq8(w2));
        if (sub == 0) { RS[2 * t] = rsqrtf(sq * (1.f / 192.f) + 1e-6f); RS[2 * t + 1] = rsqrtf(skv * (1.f / 128.f) + 1e-6f); }
        const bf16 y1 = (bf16)f2bf_(x1 * c - x2 * sn), y2 = (bf16)f2bf_(x1 * sn + x2 * c);
        GAS bf16* kr = KMB + t * 384 + 64 + sub;
#pragma unroll
        for (int h = 0; h < 4; ++h) { kr[h * 96] = y1; kr[h * 96 + 16] = y2; }
    }
}

typedef short lr_bf16x8 __attribute__((ext_vector_type(8)));
typedef float lr_f32x16 __attribute__((ext_vector_type(16)));
__device__ __forceinline__ void lr_swap32(float& a, float& b) { asm volatile("v_nop\n\tv_nop\n\tv_permlane32_swap_b32 %0, %1" : "+v"(a), "+v"(b)); }
constexpr int LR_XR = 0, LR_CW = LR_XR + 37376, LR_XA = LR_CW + 1280, LR_WT = LR_XA + 256 * 144, LR_SUM = LR_WT + 2 * 64 * 144, LR_END = LR_SUM + 4096;
struct LruP { const GAS bf16* PROJB; const GAS float* cw; const GAS float* cb; const GAS bf16* wat; const GAS float* ba; const GAS float* bx; const GAS float* sp; GAS unsigned* HA; GAS float* LSUM; };
__device__ __forceinline__ void lru_phase(const LruP& P, LAS unsigned char* lds, int tid, int wave, int lane, int vcu, int G) {
    asm volatile("" : "+v"(tid), "+v"(lane));
    LAS float* SUM = (LAS float*)(lds + LR_SUM);
    for (int u = vcu; u < (T / 256) * 8; u += G) {
        const int tile = u >> 3, g = u & 7; const int t0 = tile * 256; const bool first = ((tile & 31) == 0);
        __syncthreads();
        float ba_[2], bx_[2], sp_[2];
#pragma unroll
        for (int nt = 0; nt < 2; ++nt) { const int ch = 64 * g + 32 * nt + (lane & 31); ba_[nt] = P.ba[ch]; bx_[nt] = P.bx[ch]; sp_[nt] = P.sp[ch]; }
        { v4u wt_[2], xr_[5];
#pragma unroll
          for (int i = 0; i < 2; ++i) { const int idx = tid + 512 * i; wt_[i] = ((const GAS v4u*)(P.wat + (size_t)g * 2 * 4096))[idx]; }
#pragma unroll
          for (int i = 0; i < 5; ++i) { const int idx = tid + 512 * i, row = idx >> 3, part = idx & 7; const bool ok = (idx < 259 * 8) && !(first && row < 3);
              const int trow = ok ? t0 - 3 + row : t0;
              xr_[i] = *(const GAS v4u*)(P.PROJB + (size_t)trow * INP + PC_XL + 64 * g + 8 * part); if (!ok) xr_[i] = v4u{0u, 0u, 0u, 0u}; }
          float cwv = 0.f; if (tid < 320) cwv = (tid < 256) ? P.cw[(tid >> 6) * 512 + 64 * g + (tid & 63)] : P.cb[64 * g + (tid - 256)];
#pragma unroll
          for (int i = 0; i < 2; ++i) { const int idx = tid + 512 * i; *(LAS v4u*)(lds + LR_WT + (idx >> 9) * 9216 + ((idx >> 3) & 63) * 144 + (idx & 7) * 16) = wt_[i]; }
#pragma unroll
          for (int i = 0; i < 5; ++i) { const int idx = tid + 512 * i, row = idx >> 3, part = idx & 7; if (idx < 259 * 8) *(LAS v4u*)(lds + LR_XR + row * 144 + 16 * part) = xr_[i]; }
          if (tid < 320) ((LAS float*)(lds + LR_CW))[tid] = cwv; }
        __syncthreads();
        { float cwr[4][8], cbr[8];
#pragma unroll
          for (int k = 0; k < 4; ++k) { const f32x4 c0 = *(const LAS f32x4*)(lds + LR_CW + (k * 64 + 8 * wave) * 4), c1 = *(const LAS f32x4*)(lds + LR_CW + (k * 64 + 8 * wave + 4) * 4);
              cwr[k][0] = c0.x; cwr[k][1] = c0.y; cwr[k][2] = c0.z; cwr[k][3] = c0.w; cwr[k][4] = c1.x; cwr[k][5] = c1.y; cwr[k][6] = c1.z; cwr[k][7] = c1.w; }
          { const f32x4 c0 = *(const LAS f32x4*)(lds + LR_CW + (256 + 8 * wave) * 4), c1 = *(const LAS f32x4*)(lds + LR_CW + (256 + 8 * wave + 4) * 4);
            cbr[0] = c0.x; cbr[1] = c0.y; cbr[2] = c0.z; cbr[3] = c0.w; cbr[4] = c1.x; cbr[5] = c1.y; cbr[6] = c1.z; cbr[7] = c1.w; }
#pragma unroll
          for (int it_ = 0; it_ < 4; ++it_) { const int time = lane + 64 * it_;
              float y[8];
#pragma unroll
              for (int e = 0; e < 8; ++e) y[e] = cbr[e];
#pragma unroll
              for (int k = 0; k < 4; ++k) { const v4u w = *(const LAS v4u*)(lds + LR_XR + (time + k) * 144 + 16 * wave);
                  y[0] += bflo(w.x) * cwr[k][0]; y[1] += bfhi(w.x) * cwr[k][1]; y[2] += bflo(w.y) * cwr[k][2]; y[3] += bfhi(w.y) * cwr[k][3];
                  y[4] += bflo(w.z) * cwr[k][4]; y[5] += bfhi(w.z) * cwr[k][5]; y[6] += bflo(w.w) * cwr[k][6]; y[7] += bfhi(w.w) * cwr[k][7]; }
              v4u o; o.x = pk2(y[0], y[1]); o.y = pk2(y[2], y[3]); o.z = pk2(y[4], y[5]); o.w = pk2(y[6], y[7]);
              *(LAS v4u*)(lds + LR_XA + time * 144 + 16 * wave) = o; } }
        __syncthreads();
        const int r32 = lane & 31, hi = lane >> 5;
        lr_f32x16 acc[2][2];
#pragma unroll
        for (int nt = 0; nt < 2; ++nt) { const float b_a = ba_[nt], b_x = bx_[nt];
#pragma unroll
            for (int r = 0; r < 16; ++r) { acc[0][nt][r] = b_a; acc[1][nt][r] = b_x; } }
        { lr_bf16x8 af[4];
#pragma unroll
          for (int s_ = 0; s_ < 4; ++s_) af[s_] = *(const LAS lr_bf16x8*)(lds + LR_XA + (32 * wave + r32) * 144 + (16 * s_ + 8 * hi) * 2);
#pragma unroll
          for (int gt = 0; gt < 2; ++gt)
#pragma unroll
              for (int nt = 0; nt < 2; ++nt)
#pragma unroll
                  for (int s_ = 0; s_ < 4; ++s_) { const lr_bf16x8 bfr = *(const LAS lr_bf16x8*)(lds + LR_WT + gt * 9216 + (32 * nt + r32) * 144 + (16 * s_ + 8 * hi) * 2);
                      acc[gt][nt] = __builtin_amdgcn_mfma_f32_32x32x16_bf16(af[s_], bfr, acc[gt][nt], 0, 0, 0); } }
#pragma unroll
        for (int nt = 0; nt < 2; ++nt) { const float sp = sp_[nt];
            float sa_[4], sh_[4];
#pragma unroll
            for (int q = 0; q < 4; ++q) { float hrun = 0.f, arun = 1.f;
#pragma unroll
                for (int e = 0; e < 4; ++e) { const int r = 4 * q + e, tl = 8 * q + 4 * hi + e;
                    const float xv = __builtin_bit_cast(float, (unsigned)*(const LAS unsigned short*)(lds + LR_XA + (32 * wave + tl) * 144 + (32 * nt + r32) * 2) << 16);
                    const float rg = __builtin_amdgcn_rcpf(1.f + __builtin_amdgcn_exp2f(-LOG2E * acc[0][nt][r])), ig = __builtin_amdgcn_rcpf(1.f + __builtin_amdgcn_exp2f(-LOG2E * acc[1][nt][r]));
                    const float la = -8.0f * rg * sp; const float a_ = __builtin_amdgcn_exp2f(LOG2E * la);
                    const float uu = __builtin_amdgcn_sqrtf(fmaxf(1.f - a_ * a_, 0.f)) * (ig * xv);
                    hrun = a_ * hrun + uu; arun *= a_; acc[0][nt][r] = arun; acc[1][nt][r] = hrun; }
                sa_[q] = arun; sh_[q] = hrun; }
            float runA = 1.f, runH = 0.f;
#pragma unroll
            for (int q = 0; q < 4; ++q) { float a0 = sa_[q], a1 = sa_[q], h0 = sh_[q], h1 = sh_[q]; lr_swap32(a0, a1); lr_swap32(h0, h1);
                const float midA = runA * a0, midH = a0 * runH + h0;
                const float inA = hi ? midA : runA, inH = hi ? midH : runH;
                runA = midA * a1; runH = a1 * midH + h1;
#pragma unroll
                for (int e = 0; e < 4; ++e) { const int r = 4 * q + e; acc[1][nt][r] += acc[0][nt][r] * inH; acc[0][nt][r] *= inA; } }
            if (hi == 0) { SUM[(wave * 64 + 32 * nt + r32) * 2] = runA; SUM[(wave * 64 + 32 * nt + r32) * 2 + 1] = runH; } }
        __syncthreads();
#pragma unroll
        for (int nt = 0; nt < 2; ++nt) { const int cl = 32 * nt + r32;
            float ca = 1.f, chh = 0.f;
            for (int w = 0; w < wave; ++w) { const float aw = SUM[(w * 64 + cl) * 2], hw = SUM[(w * 64 + cl) * 2 + 1]; chh = aw * chh + hw; ca *= aw; }
            GAS unsigned* ha = P.HA + (size_t)(t0 + 32 * wave + 4 * hi) * 512 + 64 * g + cl;
#pragma unroll
            for (int r = 0; r < 16; ++r) { const float hh = acc[1][nt][r] + acc[0][nt][r] * chh, ac_ = acc[0][nt][r] * ca; ha[(size_t)((r & 3) + 8 * (r >> 2)) * 512] = pk2(hh, ac_);
                if (r == 15 && wave == 7 && hi == 1) { P.LSUM[((size_t)tile * 512 + 64 * g + cl) * 2] = ac_; P.LSUM[((size_t)tile * 512 + 64 * g + cl) * 2 + 1] = hh; } } }
    }
}

struct PostP { const GAS bf16* OMB; const GAS unsigned* HA; const GAS float* LSUM; const GAS bf16* PROJB; const GAS float* gm; const GAS float* gl; GAS bf16* Y; };
__device__ __forceinline__ void post_phase(const PostP& P, LAS unsigned char* lds, int tid, int wave, int lane, int vcu, int G) {
    asm volatile("" : "+v"(tid), "+v"(lane));
    LAS float* hin = (LAS float*)lds;
    for (int u = vcu; u < T / 64; u += G) {
        const int t0 = u * 64, tile = t0 >> 8, tb = tile & ~31;
        __syncthreads();
        { float h = 0.f;
          for (int c0 = tb; c0 < tile; c0 += 8) {
              float av_[8], hv_[8];
#pragma unroll
              for (int i = 0; i < 8; ++i) { const int c = (c0 + i < tile) ? (c0 + i) : tb; av_[i] = P.LSUM[((size_t)c * 512 + tid) * 2]; hv_[i] = P.LSUM[((size_t)c * 512 + tid) * 2 + 1]; }
#pragma unroll
              for (int i = 0; i < 8; ++i) { if (c0 + i < tile) h = av_[i] * h + hv_[i]; } }
          hin[tid] = h; }
        __syncthreads();
        f32x4 hi0 = *(const LAS f32x4*)(hin + 8 * lane), hi1 = *(const LAS f32x4*)(hin + 8 * lane + 4);
        const f32x4 g0 = *(const GAS f32x4*)(P.gl + 8 * lane), g1 = *(const GAS f32x4*)(P.gl + 8 * lane + 4), gmv = *(const GAS f32x4*)(P.gm + 4 * lane);
#pragma unroll 2
        for (int i = 0; i < 8; ++i) {
            const size_t t = (size_t)t0 + 8 * wave + i;
            const v4u p0 = *(const GAS v4u*)(P.HA + t * 512 + 8 * lane), p1 = *(const GAS v4u*)(P.HA + t * 512 + 8 * lane + 4), gw_ = *(const GAS v4u*)(P.PROJB + t * INP + PC_GL + 8 * lane);
            const v2u mw = *(const GAS v2u*)(P.OMB + t * 256 + 4 * lane);
            float o[8];
            o[0] = (bflo(p0.x) + bfhi(p0.x) * hi0.x) * gelu_erf(bflo(gw_.x)); o[1] = (bflo(p0.y) + bfhi(p0.y) * hi0.y) * gelu_erf(bfhi(gw_.x));
            o[2] = (bflo(p0.z) + bfhi(p0.z) * hi0.z) * gelu_erf(bflo(gw_.y)); o[3] = (bflo(p0.w) + bfhi(p0.w) * hi0.w) * gelu_erf(bfhi(gw_.y));
            o[4] = (bflo(p1.x) + bfhi(p1.x) * hi1.x) * gelu_erf(bflo(gw_.z)); o[5] = (bflo(p1.y) + bfhi(p1.y) * hi1.y) * gelu_erf(bfhi(gw_.z));
            o[6] = (bflo(p1.z) + bfhi(p1.z) * hi1.z) * gelu_erf(bflo(gw_.w)); o[7] = (bflo(p1.w) + bfhi(p1.w) * hi1.w) * gelu_erf(bfhi(gw_.w));
            float s2 = 0.f;
#pragma unroll
            for (int e = 0; e < 8; ++e) s2 += o[e] * o[e];
            const float m0 = bflo(mw.x), m1 = bfhi(mw.x), m2 = bflo(mw.y), m3 = bfhi(mw.y);
            float s1 = (m0 * m0 + m1 * m1) + (m2 * m2 + m3 * m3);
            s1 = wave_sum(s1, lane); s2 = wave_sum(s2, lane);
            const float r1 = rsqrtf(s1 * (1.f / 256.f) + 1e-6f), r2 = rsqrtf(s2 * (1.f / 512.f) + 1e-6f);
            GAS bf16* yr = P.Y + t * 1024;
            { v2u w; w.x = pk2(m0 * r1 * gmv.x, m1 * r1 * gmv.y); w.y = pk2(m2 * r1 * gmv.z, m3 * r1 * gmv.w); *(GAS v2u*)(yr + 4 * lane) = w; }
            { v4u w; w.x = pk2(o[0] * r2 * g0.x, o[1] * r2 * g0.y); w.y = pk2(o[2] * r2 * g0.z, o[3] * r2 * g0.w); w.z = pk2(o[4] * r2 * g1.x, o[5] * r2 * g1.y); w.w = pk2(o[6] * r2 * g1.z, o[7] * r2 * g1.w);
              *(GAS v4u*)(yr + 256 + 8 * lane) = w; }
        }
    }
}

#define TILE_BAR() asm volatile("s_waitcnt lgkmcnt(0)\n\ts_barrier" ::: "memory")
typedef short bf16x8 __attribute__((ext_vector_type(8)));
typedef short s16x4 __attribute__((ext_vector_type(4)));
typedef float f32x16 __attribute__((ext_vector_type(16)));
typedef unsigned u32x4 __attribute__((ext_vector_type(4)));
__device__ __forceinline__ int crow(int r, int hi) { return (r & 3) + 8 * (r >> 2) + 4 * hi; }
typedef float f32x2_t __attribute__((ext_vector_type(2))); typedef __bf16 bf16x2_c __attribute__((ext_vector_type(2)));
__device__ __forceinline__ unsigned cvtpk(float lo, float hi) { f32x2_t v = {lo, hi}; bf16x2_c b = __builtin_convertvector(v, bf16x2_c); return __builtin_bit_cast(unsigned, b); }
__device__ __forceinline__ float swapmax(float m) { auto rr = __builtin_amdgcn_permlane32_swap(__float_as_uint(m), __float_as_uint(m), false, false); return fmaxf(__uint_as_float(rr[0]), __uint_as_float(rr[1])); }
__device__ __forceinline__ float swapadd(float m) { auto rr = __builtin_amdgcn_permlane32_swap(__float_as_uint(m), __float_as_uint(m), false, false); return __uint_as_float(rr[0]) + __uint_as_float(rr[1]); }
__device__ __forceinline__ s16x4 vtr(const LAS unsigned char* p) { return __builtin_bit_cast(s16x4, __builtin_amdgcn_ds_read_tr16_b64_v4i16((LAS s16x4*)p)); }
__device__ __forceinline__ bf16x8 pack8(const f32x16& p, int b) { u32x4 w; w.x = cvtpk(p[b], p[b + 1]); w.y = cvtpk(p[b + 2], p[b + 3]); w.z = cvtpk(p[b + 4], p[b + 5]); w.w = cvtpk(p[b + 6], p[b + 7]); return __builtin_bit_cast(bf16x8, w); }
__device__ __forceinline__ float vmax3(float a, float b, float c) { float r; asm("v_max3_f32 %0, %1, %2, %3" : "=v"(r) : "v"(a), "v"(b), "v"(c)); return r; }
__device__ __forceinline__ float max32(const f32x16& p, const f32x16& q) {
    float a = vmax3(p[0], p[1], p[2]), b = vmax3(p[3], p[4], p[5]), c = vmax3(p[6], p[7], p[8]), d = vmax3(p[9], p[10], p[11]), e = vmax3(p[12], p[13], p[14]);
    float f = vmax3(q[0], q[1], q[2]), g = vmax3(q[3], q[4], q[5]), h = vmax3(q[6], q[7], q[8]), i = vmax3(q[9], q[10], q[11]), j = vmax3(q[12], q[13], q[14]);
    a = vmax3(a, b, c); d = vmax3(d, e, p[15]); f = vmax3(f, g, h); i = vmax3(i, j, q[15]);
    return vmax3(vmax3(a, d, f), i, i);
}
__device__ __forceinline__ float max16(const f32x16& p) { float a = fmaxf(fmaxf(p[0], p[1]), fmaxf(p[2], p[3])), b = fmaxf(fmaxf(p[4], p[5]), fmaxf(p[6], p[7])), c = fmaxf(fmaxf(p[8], p[9]), fmaxf(p[10], p[11])), d = fmaxf(fmaxf(p[12], p[13]), fmaxf(p[14], p[15])); return fmaxf(fmaxf(a, b), fmaxf(c, d)); }

struct AttnP {
    const GAS bf16* Q; const GAS bf16* K; const GAS bf16* V; int qp, kp, vp;
    GAS bf16* O; int op;
    const GAS float* rope;
    const GAS int* pos; const GAS float* btab; const GAS float* dnorm; const GAS float* lams;
};
template <int KIND> struct AK {
    static constexpr bool DIFF = KIND == 1, CROSS = KIND == 2;
    static constexpr int HW = KIND == 0 ? 96 : KIND == 1 ? 64 : 256;
    static constexpr int NKS = KIND == 0 ? 6 : KIND == 1 ? 2 : 16;
    static constexpr int KP = KIND == 0 ? 208 : KIND == 1 ? 144 : 528;
    static constexpr int ND = CROSS ? 4 : 2;
    static constexpr int CPK = HW / 8, KCH = (64 * CPK + 511) / 512;
    static constexpr int VCH = ND / 2;
    static constexpr int KB = 64 * KP, VB = ND * 4096;
    static constexpr int NBUF = CROSS ? 2 : 3;
    static constexpr int K0 = 0, V0 = NBUF * KB, POS = V0 + NBUF * VB, BT = POS + 1024, DN = BT + 528, END = DN + 256;
};
static_assert(AK<2>::END <= RING_BYTES && AK<0>::END <= RING_BYTES && AK<1>::END + 16 + 8 * 8192 <= RING_BYTES, "attention LDS");

template <int KIND, bool LEAD>
__device__ __forceinline__ void attn_unit(const AttnP& P, int b, int h, int qb, int dhalf, LAS unsigned char* lds, int tid, int wave, int lane) {
    lane = lane_id_v(); tid = (wave << 6) | lane;
    typedef AK<KIND> C;
    constexpr bool DIFF = C::DIFF, CROSS = C::CROSS;
    constexpr int HW = C::HW, NKS = C::NKS, KP = C::KP, ND = C::ND, CPK = C::CPK, KCH = C::KCH, VCH = C::VCH;
    const int r32 = lane & 31, hi = lane >> 5;
    const size_t rowb = (size_t)b * S, rowk = CROSS ? (size_t)b * MEM : rowb;
    const int q0w = qb * 256 + wave * 32, qi = q0w + r32;
    int pq = 0; float bias_far = 0.f;
    __syncthreads();
    if (DIFF) {
        pq = P.pos[rowb + qi];
        if (tid < 129) ((LAS float*)(lds + C::BT))[tid] = P.btab[h * 129 + tid];
        if (tid >= 192 && tid < 256) ((LAS float*)(lds + C::DN))[tid - 192] = P.dnorm[tid - 192];
    }
    int minq = pq;
    if (DIFF) { for (int o = 1; o < 64; o <<= 1) { const int v = shxi(minq, o, lane); minq = v < minq ? v : minq; } }
    const int NT = CROSS ? MEM / 64 : 4 * (qb + 1);
    u32x4 kr[KCH], vr[VCH]; int pkr = 0;
    u32x4 kr2[CROSS ? 1 : KCH], vr2[CROSS ? 1 : VCH]; int pkr2 = 0;
    const GAS bf16* Kb = P.K + rowk * P.kp + h * HW; const GAS bf16* Vb = P.V + rowk * P.vp + (CROSS ? h * 256 + dhalf * 128 : h * 64);
    const __amdgpu_buffer_rsrc_t rK = __builtin_amdgcn_make_buffer_rsrc((void*)Kb, 0, 0x7fffffff, 0x00020000), rV = __builtin_amdgcn_make_buffer_rsrc((void*)Vb, 0, 0x7fffffff, 0x00020000);
    const __amdgpu_buffer_rsrc_t rP = __builtin_amdgcn_make_buffer_rsrc((void*)(DIFF ? P.pos + rowb : (const GAS int*)Kb), 0, 0x7fffffff, 0x00020000);
    int kvo[KCH], vvo[VCH];
#pragma unroll
    for (int i = 0; i < KCH; ++i) { int c = tid + 512 * i; c = c < 64 * CPK ? c : tid; kvo[i] = ((c / CPK) * P.kp + (c % CPK) * 8) * 2; }
#pragma unroll
    for (int i = 0; i < VCH; ++i) { const int c = tid + 512 * i; vvo[i] = ((c / (4 * ND)) * P.vp + (c % (4 * ND)) * 8) * 2; }
    const int pvo = (tid & 63) * 4;
    auto gload = [&](int t) {
        const int ks = __builtin_amdgcn_readfirstlane(64 * t * P.kp * 2), vs = __builtin_amdgcn_readfirstlane(64 * t * P.vp * 2);
#pragma unroll
        for (int i = 0; i < KCH; ++i) kr[i] = __builtin_amdgcn_raw_buffer_load_b128(rK, kvo[i], ks, 0);
#pragma unroll
        for (int i = 0; i < VCH; ++i) vr[i] = __builtin_amdgcn_raw_buffer_load_b128(rV, vvo[i], vs, 0);
        if (DIFF) pkr = __builtin_amdgcn_raw_buffer_load_b32(rP, pvo, __builtin_amdgcn_readfirstlane(64 * t * 4), 0);
    };
    auto lstore = [&](int buf) {
        LAS unsigned char* kb_ = lds + C::K0 + buf * C::KB; LAS unsigned char* vb_ = lds + C::V0 + buf * C::VB;
#pragma unroll
        for (int i = 0; i < KCH; ++i) { int c = tid + 512 * i; c = c < 64 * CPK ? c : tid; const int key = c / CPK, part = c % CPK; *(LAS u32x4*)(kb_ + key * KP + part * 16) = kr[i]; }
#pragma unroll
        for (int i = 0; i < VCH; ++i) { const int c = tid + 512 * i; const int key = c / (4 * ND), part = c % (4 * ND); *(LAS u32x4*)(vb_ + (part >> 2) * 4096 + (key >> 3) * 512 + (key & 7) * 64 + (part & 3) * 16) = vr[i]; }
        if (DIFF) { ((LAS int*)(lds + C::POS + buf * 256))[tid & 63] = pkr; if (tid < 64) { int mk_ = pkr; for (int o = 1; o < 64; o <<= 1) { const int v = shxi(mk_, o, lane); mk_ = v > mk_ ? v : mk_; } if (tid == 0) ((LAS int*)(lds + C::POS + 768))[buf] = mk_; } }
    };
    auto gloadB = [&](int t) {
        const int ks = __builtin_amdgcn_readfirstlane(64 * t * P.kp * 2), vs = __builtin_amdgcn_readfirstlane(64 * t * P.vp * 2);
#pragma unroll
        for (int i = 0; i < (CROSS ? 1 : KCH); ++i) kr2[i] = __builtin_amdgcn_raw_buffer_load_b128(rK, kvo[i], ks, 0);
#pragma unroll
        for (int i = 0; i < (CROSS ? 1 : VCH); ++i) vr2[i] = __builtin_amdgcn_raw_buffer_load_b128(rV, vvo[i], vs, 0);
        if (DIFF) pkr2 = __builtin_amdgcn_raw_buffer_load_b32(rP, pvo, __builtin_amdgcn_readfirstlane(64 * t * 4), 0);
    };
    auto lstoreB = [&](int buf) {
        LAS unsigned char* kb_ = lds + C::K0 + buf * C::KB; LAS unsigned char* vb_ = lds + C::V0 + buf * C::VB;
#pragma unroll
        for (int i = 0; i < (CROSS ? 1 : KCH); ++i) { int c = tid + 512 * i; c = c < 64 * CPK ? c : tid; const int key = c / CPK, part = c % CPK; *(LAS u32x4*)(kb_ + key * KP + part * 16) = kr2[i]; }
#pragma unroll
        for (int i = 0; i < (CROSS ? 1 : VCH); ++i) { const int c = tid + 512 * i; const int key = c / (4 * ND), part = c % (4 * ND); *(LAS u32x4*)(vb_ + (part >> 2) * 4096 + (key >> 3) * 512 + (key & 7) * 64 + (part & 3) * 16) = vr2[i]; }
        if (DIFF) { ((LAS int*)(lds + C::POS + buf * 256))[tid & 63] = pkr2; if (tid < 64) { int mk_ = pkr2; for (int o = 1; o < 64; o <<= 1) { const int v = shxi(mk_, o, lane); mk_ = v > mk_ ? v : mk_; } if (tid == 0) ((LAS int*)(lds + C::POS + 768))[buf] = mk_; } }
    };
    LAS float* osv = (LAS float*)(lds + ((C::END + 15) & ~15)) + wave * 2048 + lane;
    float il = 0.f;
    f32x16 oA[ND];
#pragma unroll 1
    for (int mp = 0; mp < (DIFF ? 2 : 1); ++mp) {
        bf16x8 qf[NKS];
        { const GAS bf16* qrow = P.Q + (rowb + qi) * P.qp + h * HW + mp * 32;
#pragma unroll
          for (int s = 0; s < NKS; ++s) qf[s] = *(const GAS bf16x8*)(qrow + 16 * s + 8 * hi);
          if (KIND == 0) {
              const GAS float* rp = P.rope + (rowb + qi) * 32 + 8 * hi;
              const f32x4 c0 = *(const GAS f32x4*)rp, c1 = *(const GAS f32x4*)(rp + 4), s0 = *(const GAS f32x4*)(rp + 16), s1 = *(const GAS f32x4*)(rp + 20);
              const u32x4 a = __builtin_bit_cast(u32x4, qf[NKS - 2]), bq = __builtin_bit_cast(u32x4, qf[NKS - 1]); u32x4 ra, rb;
#pragma unroll
              for (int w = 0; w < 4; ++w) { const float cl = w < 2 ? c0[2 * w] : c1[2 * w - 4], ch = w < 2 ? c0[2 * w + 1] : c1[2 * w - 3], sl = w < 2 ? s0[2 * w] : s1[2 * w - 4], sh = w < 2 ? s0[2 * w + 1] : s1[2 * w - 3];
                  const float x1l = bflo(a[w]), x1h = bfhi(a[w]), x2l = bflo(bq[w]), x2h = bfhi(bq[w]);
                  ra[w] = cvtpk(x1l * cl - x2l * sl, x1h * ch - x2h * sh); rb[w] = cvtpk(x1l * sl + x2l * cl, x1h * sh + x2h * ch); }
              qf[NKS - 2] = __builtin_bit_cast(bf16x8, ra); qf[NKS - 1] = __builtin_bit_cast(bf16x8, rb);
          } }
        __syncthreads();
        float m1 = -1e30f, l1 = 0.f;
#pragma unroll
        for (int d = 0; d < ND; ++d)
#pragma unroll
            for (int r = 0; r < 16; ++r) oA[d][r] = 0.f;
        auto qk = [&](int sl, f32x16& sa, f32x16& sb, float init) {
            const LAS unsigned char* kb_ = lds + C::K0 + sl * C::KB + r32 * KP + hi * 16 + mp * 64;
#pragma unroll
            for (int r = 0; r < 16; ++r) { sa[r] = init; sb[r] = init; }
            constexpr int HB = CROSS ? 4 : (NKS > 3 ? 3 : NKS);
#pragma unroll
            for (int s0_ = 0; s0_ < NKS; s0_ += HB) {
                bf16x8 kfa[HB], kfb[HB];
#pragma unroll
                for (int s = 0; s < HB; ++s) { kfa[s] = *(const LAS bf16x8*)(kb_ + (s0_ + s) * 32); kfb[s] = *(const LAS bf16x8*)(kb_ + 32 * KP + (s0_ + s) * 32); }
                __builtin_amdgcn_sched_barrier(0);
#pragma unroll
                for (int s = 0; s < HB; ++s) { sa = __builtin_amdgcn_mfma_f32_32x32x16_bf16(kfa[s], qf[s0_ + s], sa, 0, 0, 0); sb = __builtin_amdgcn_mfma_f32_32x32x16_bf16(kfb[s], qf[s0_ + s], sb, 0, 0, 0); }
                __builtin_amdgcn_sched_barrier(0);
            }
        };
        auto isnear = [&](int sl) { bool nb = false;
            if (DIFF) { const int mk_ = __builtin_amdgcn_readfirstlane(((LAS int*)(lds + C::POS + 768))[sl]); nb = (minq - mk_) < 128; }
            return nb; };
        auto sm = [&](int t, int sl, f32x16& pa, f32x16& pb, bool nearb) -> float {
            const int k0 = 64 * t;
            if (DIFF) { if (nearb) {
                const LAS int* pk = (const LAS int*)(lds + C::POS + sl * 256); const LAS float* bt = (const LAS float*)(lds + C::BT);
#pragma unroll
                for (int r = 0; r < 16; ++r) { const int kk = crow(r, hi);
                    int n0 = pq - pk[kk], n1 = pq - pk[kk + 32]; n0 = n0 < 0 ? 0 : (n0 > 128 ? 128 : n0); n1 = n1 < 0 ? 0 : (n1 > 128 ? 128 : n1);
                    pa[r] += bt[n0]; pb[r] += bt[n1]; }
            } }
            if (!CROSS && k0 + 63 > q0w) {
#pragma unroll
                for (int r = 0; r < 16; ++r) { const int kk = k0 + crow(r, hi); if (kk > qi) pa[r] = -1e30f; if (kk + 32 > qi) pb[r] = -1e30f; }
            }
            asm volatile("s_nop 15\n\ts_nop 7" : "+v"(pa), "+v"(pb));
            float mn, al = 1.f;
            if (CROSS) { const float mx = swapmax(max32(pa, pb)); mn = fmaxf(m1, mx); al = __builtin_amdgcn_exp2f(m1 - mn); l1 *= al; }
            else { const float mx = swapmax(max32(pa, pb)); const bool up = mx > m1 + 8.0f; mn = up ? mx : m1;
                   if (__builtin_amdgcn_ballot_w64(up) != 0ull) { al = __builtin_amdgcn_exp2f(m1 - mn); l1 *= al; } }
            m1 = mn;
            float ls = 0.f;
#pragma unroll
            for (int r = 0; r < 16; ++r) { pa[r] = __builtin_amdgcn_exp2f(pa[r] - mn); pb[r] = __builtin_amdgcn_exp2f(pb[r] - mn); ls += pa[r] + pb[r]; }
            l1 += ls;
            return al;
        };
        auto pv = [&](int sl, const f32x16& pa, const f32x16& pb, float al) {
            const LAS unsigned char* vb_ = lds + C::V0 + sl * C::VB + ((lane >> 4) & 1) * 32 + (lane & 3) * 8 + (4 * hi + ((lane & 15) >> 2)) * 64;
            bf16x8 pf[4];
            pf[0] = pack8(pa, 0); pf[1] = pack8(pa, 8); pf[2] = pack8(pb, 0); pf[3] = pack8(pb, 8);
            const bool resc = CROSS ? true : (__builtin_amdgcn_ballot_w64(al != 1.0f) != 0ull);
            if (CROSS) {
#pragma unroll
                for (int d = 0; d < ND; ++d) {
                    __builtin_amdgcn_sched_barrier(0);
#pragma unroll
                    for (int r = 0; r < 16; ++r) oA[d][r] *= al;
                    bf16x8 vf[4];
#pragma unroll
                    for (int s = 0; s < 4; ++s) { const s16x4 lo = vtr(vb_ + d * 4096 + s * 1024), hh = vtr(vb_ + d * 4096 + s * 1024 + 512); vf[s] = (bf16x8){lo[0], lo[1], lo[2], lo[3], hh[0], hh[1], hh[2], hh[3]}; }
#pragma unroll
                    for (int s = 0; s < 4; ++s) oA[d] = __builtin_amdgcn_mfma_f32_32x32x16_bf16(vf[s], pf[s], oA[d], 0, 0, 0);
                }
            } else if (DIFF) {
                if (resc) {
#pragma unroll
                    for (int d = 0; d < 2; ++d)
#pragma unroll
                        for (int r = 0; r < 16; ++r) oA[d][r] *= al;
                }
#pragma unroll
                for (int d = 0; d < 2; ++d) {
                    bf16x8 vf[4];
#pragma unroll
                    for (int s = 0; s < 4; ++s) { const s16x4 lo = vtr(vb_ + d * 4096 + s * 1024), hh = vtr(vb_ + d * 4096 + s * 1024 + 512); vf[s] = (bf16x8){lo[0], lo[1], lo[2], lo[3], hh[0], hh[1], hh[2], hh[3]}; }
                    __builtin_amdgcn_sched_barrier(0);
#pragma unroll
                    for (int s = 0; s < 4; ++s) oA[d] = __builtin_amdgcn_mfma_f32_32x32x16_bf16(vf[s], pf[s], oA[d], 0, 0, 0);
                }
            } else {
                bf16x8 vf[2][4];
#pragma unroll
                for (int d = 0; d < 2; ++d)
#pragma unroll
                    for (int s = 0; s < 4; ++s) { const s16x4 lo = vtr(vb_ + d * 4096 + s * 1024), hh = vtr(vb_ + d * 4096 + s * 1024 + 512); vf[d][s] = (bf16x8){lo[0], lo[1], lo[2], lo[3], hh[0], hh[1], hh[2], hh[3]}; }
                if (resc) {
#pragma unroll
                    for (int d = 0; d < 2; ++d)
#pragma unroll
                        for (int r = 0; r < 16; ++r) oA[d][r] *= al;
                }
                __builtin_amdgcn_sched_barrier(0);
#pragma unroll
                for (int s = 0; s < 4; ++s)
#pragma unroll
                    for (int d = 0; d < 2; ++d) oA[d] = __builtin_amdgcn_mfma_f32_32x32x16_bf16(vf[d][s], pf[s], oA[d], 0, 0, 0);
            }
        };
        if (CROSS) {
            gload(0); lstore(0);
            __syncthreads();
            for (int t = 0; t < NT; ++t) {
                const int buf = t & 1;
                f32x16 pa, pb;
                qk(buf, pa, pb, 0.f);
                const float al = sm(t, buf, pa, pb, false);
                pv(buf, pa, pb, al);
                if (t + 1 < NT) { gload(t + 1); lstore(buf ^ 1); }
                TILE_BAR();
            }
        } else {
            gload(0); lstore(0); gload(1); lstore(1);
            gload(2); gloadB(3);
            __syncthreads();
            if (DIFF) bias_far = ((LAS float*)(lds + C::BT))[128];
            const int NTW = (q0w + 31) / 64 + 1;
            constexpr bool lead = LEAD;
            f32x16 ca, cb, na, nb; bool cnear = isnear(0), nnear = false; float cal = 1.f;
            qk(0, ca, cb, (DIFF && !cnear) ? bias_far : 0.f);
            if (lead) cal = sm(0, 0, ca, cb, cnear);
            int s0 = 0, s1 = 1, s2 = 2;
            auto period = [&](int t, f32x16& xa, f32x16& xb, bool& xnear, f32x16& ya, f32x16& yb, bool& ynear) {
                const bool have_next = (t + 1 < NTW);
                if (lead) {
                    if (have_next) { ynear = isnear(s1); qk(s1, ya, yb, (DIFF && !ynear) ? bias_far : 0.f); }
                    if (t < NTW) pv(s0, xa, xb, cal);
                    if (have_next) cal = sm(t + 1, s1, ya, yb, ynear);
                } else {
                    if (t < NTW) cal = sm(t, s0, xa, xb, xnear);
                    if (have_next) { ynear = isnear(s1); qk(s1, ya, yb, (DIFF && !ynear) ? bias_far : 0.f); }
                    if (t < NTW) pv(s0, xa, xb, cal);
                }
                { const int tmp = s0; s0 = s1; s1 = s2; s2 = tmp; }
            };
            int t = 0;
            for (; t + 5 < NT; t += 2) {
                lstore(s2); gload(t + 4);
                period(t, ca, cb, cnear, na, nb, nnear);
                TILE_BAR();
                lstoreB(s2); gloadB(t + 5);
                period(t + 1, na, nb, nnear, ca, cb, cnear);
                TILE_BAR();
            }
            for (; t < NT; t += 2) {
                if (t + 2 < NT) { lstore(s2); if (t + 4 < NT) gload(t + 4); }
                period(t, ca, cb, cnear, na, nb, nnear);
                TILE_BAR();
                if (t + 3 < NT) { lstoreB(s2); if (t + 5 < NT) gloadB(t + 5); }
                period(t + 1, na, nb, nnear, ca, cb, cnear);
                TILE_BAR();
            }
        }
        il = 1.f / swapadd(l1);
        if (DIFF) { if (mp == 0) {
#pragma unroll
            for (int d = 0; d < 2; ++d)
#pragma unroll
                for (int r = 0; r < 16; ++r) osv[(d * 16 + r) * 64] = oA[d][r] * il; } }
    }
    GAS bf16* orow = P.O + (rowb + qi) * P.op + (CROSS ? h * 256 + dhalf * 128 : h * 64);
    if (!DIFF) {
#pragma unroll
        for (int d = 0; d < ND; ++d)
#pragma unroll
            for (int g = 0; g < 4; ++g) { v2u v; v.x = cvtpk(oA[d][4 * g] * il, oA[d][4 * g + 1] * il); v.y = cvtpk(oA[d][4 * g + 2] * il, oA[d][4 * g + 3] * il); *(GAS v2u*)(orow + 32 * d + 8 * g + 4 * hi) = v; }
    } else {
        const float lam = P.lams[0], lam_init = P.lams[1];
        const float i2 = lam * il;
        float ss = 0.f;
#pragma unroll
        for (int d = 0; d < 2; ++d)
#pragma unroll
            for (int r = 0; r < 16; ++r) { const float v = osv[(d * 16 + r) * 64] - oA[d][r] * i2; oA[d][r] = v; ss += v * v; }
        ss = swapadd(ss);
        const float rs = __builtin_amdgcn_rsqf(ss * (1.f / 64.f) + 1e-6f) * (1.f - lam_init);
        const LAS float* dn = (const LAS float*)(lds + C::DN);
#pragma unroll
        for (int d = 0; d < 2; ++d)
#pragma unroll
            for (int g = 0; g < 4; ++g) { const int c = 32 * d + 8 * g + 4 * hi; const f32x4 gn = *(const LAS f32x4*)(dn + c);
                v2u v; v.x = cvtpk(oA[d][4 * g] * rs * gn[0], oA[d][4 * g + 1] * rs * gn[1]); v.y = cvtpk(oA[d][4 * g + 2] * rs * gn[2], oA[d][4 * g + 3] * rs * gn[3]); *(GAS v2u*)(orow + c) = v; }
    }
}

__device__ __forceinline__ int wave_max_i(int v) {
    { const int o = __builtin_amdgcn_update_dpp(0, v, 0xB1, 0xF, 0xF, true); v = o > v ? o : v; }
    { const int o = __builtin_amdgcn_update_dpp(0, v, 0x4E, 0xF, 0xF, true); v = o > v ? o : v; }
    { const int o = __builtin_amdgcn_update_dpp(0, v, 0x141, 0xF, 0xF, true); v = o > v ? o : v; }
    { const int o = __builtin_amdgcn_update_dpp(0, v, 0x140, 0xF, 0xF, true); v = o > v ? o : v; }
    { int a = v, b = v; asm volatile("v_nop\n\tv_nop\n\tv_permlane16_swap_b32 %0, %1" : "+v"(a), "+v"(b)); v = a > b ? a : b; }
    { int a = v, b = v; asm volatile("v_nop\n\tv_nop\n\tv_permlane32_swap_b32 %0, %1" : "+v"(a), "+v"(b)); v = a > b ? a : b; }
    return v;
}
template <int KIND> struct AK2 {
    static constexpr bool DIFF = KIND == 1;
    static constexpr int HW = KIND == 0 ? 96 : 64, NKS = KIND == 0 ? 6 : 2, KP = KIND == 0 ? 208 : 144;
    static constexpr int CPK = HW / 8, KCH = (128 * CPK) / 512, VCH = 2;
    static constexpr int KB = 128 * KP, VB = 2 * 8192;
    static constexpr int K0 = 0, V0 = 2 * KB, POS = V0 + 2 * VB, PMX = POS + 1024, BT = PMX + 16, DN = BT + 528, OSV = (DN + 256 + 15) & ~15, END = OSV + (DIFF ? 8 * 8192 : 0);
};
static_assert(AK2<0>::END <= RING_BYTES && AK2<1>::END <= RING_BYTES, "attention LDS (128-key tiles)");
template <int KIND>
__device__ __forceinline__ void attn_unit2(const AttnP& P, int b, int h, int qb, LAS unsigned char* lds, int tid, int wave, int lane) {
    lane = lane_id_v(); tid = (wave << 6) | lane;
    typedef AK2<KIND> C;
    constexpr bool DIFF = C::DIFF;
    constexpr int HW = C::HW, NKS = C::NKS, KP = C::KP, CPK = C::CPK, KCH = C::KCH, VCH = C::VCH;
    const int r32 = lane & 31, hi = lane >> 5;
    const size_t rowb = (size_t)b * S;
    const int q0w = qb * 256 + wave * 32, qi = q0w + r32;
    int pq = 0; float bias_far = 0.f;
    __syncthreads();
    if (DIFF) {
        pq = P.pos[rowb + qi];
        if (tid < 129) ((LAS float*)(lds + C::BT))[tid] = P.btab[h * 129 + tid];
        if (tid >= 192 && tid < 256) ((LAS float*)(lds + C::DN))[tid - 192] = P.dnorm[tid - 192];
    }
    int minq = pq;
    if (DIFF) minq = __builtin_amdgcn_readfirstlane(-wave_max_i(-pq));
    const int NT = 2 * (qb + 1);
    const GAS bf16* Kb = P.K + rowb * P.kp + h * HW; const GAS bf16* Vb = P.V + rowb * P.vp + h * 64;
    const __amdgpu_buffer_rsrc_t rK = __builtin_amdgcn_make_buffer_rsrc((void*)Kb, 0, 0x7fffffff, 0x00020000), rV = __builtin_amdgcn_make_buffer_rsrc((void*)Vb, 0, 0x7fffffff, 0x00020000);
    const __amdgpu_buffer_rsrc_t rP = __builtin_amdgcn_make_buffer_rsrc((void*)(DIFF ? P.pos + rowb : (const GAS int*)Kb), 0, 0x7fffffff, 0x00020000);
    int kvo[KCH], vvo[VCH], klo[KCH], vlo[VCH];
#pragma unroll
    for (int i = 0; i < KCH; ++i) { const int c = tid + 512 * i; kvo[i] = ((c / CPK) * P.kp + (c % CPK) * 8) * 2; klo[i] = (c / CPK) * KP + (c % CPK) * 16; }
#pragma unroll
    for (int i = 0; i < VCH; ++i) { const int c = tid + 512 * i; const int key = c >> 3, part = c & 7; vvo[i] = (key * P.vp + part * 8) * 2; vlo[i] = (part >> 2) * 8192 + (key >> 3) * 512 + (key & 7) * 64 + (part & 3) * 16; }
    const int pvo = (tid & 127) * 4;
    u32x4 kr[KCH], vr[VCH]; int pkr = 0;
    auto gload = [&](int t) {
        const int ks = __builtin_amdgcn_readfirstlane(128 * t * P.kp * 2), vs = __builtin_amdgcn_readfirstlane(128 * t * P.vp * 2);
#pragma unroll
        for (int i = 0; i < KCH; ++i) kr[i] = __builtin_amdgcn_raw_buffer_load_b128(rK, kvo[i], ks, 0);
#pragma unroll
        for (int i = 0; i < VCH; ++i) vr[i] = __builtin_amdgcn_raw_buffer_load_b128(rV, vvo[i], vs, 0);
        if (DIFF) pkr = __builtin_amdgcn_raw_buffer_load_b32(rP, pvo, __builtin_amdgcn_readfirstlane(128 * t * 4), 0);
    };
    auto lstore = [&](int buf) {
        LAS unsigned char* kb_ = lds + C::K0 + buf * C::KB; LAS unsigned char* vb_ = lds + C::V0 + buf * C::VB;
#pragma unroll
        for (int i = 0; i < KCH; ++i) *(LAS u32x4*)(kb_ + klo[i]) = kr[i];
#pragma unroll
        for (int i = 0; i < VCH; ++i) *(LAS u32x4*)(vb_ + vlo[i]) = vr[i];
        if (DIFF) { ((LAS int*)(lds + C::POS + buf * 512))[tid & 127] = pkr;
            if (tid < 128) { const int mk_ = wave_max_i(pkr); if (lane == 0) ((LAS int*)(lds + C::PMX))[buf * 2 + wave] = mk_; } }
    };
    LAS float* osv = (LAS float*)(lds + C::OSV) + wave * 2048 + lane;
    float il = 0.f;
    f32x16 oA[2];
#pragma unroll 1
    for (int mp = 0; mp < (DIFF ? 2 : 1); ++mp) {
        bf16x8 qf[NKS];
        { const GAS bf16* qrow = P.Q + (rowb + qi) * P.qp + h * HW + mp * 32;
#pragma unroll
          for (int s = 0; s < NKS; ++s) qf[s] = *(const GAS bf16x8*)(qrow + 16 * s + 8 * hi);
          if (KIND == 0) {
              const GAS float* rp = P.rope + (rowb + qi) * 32 + 8 * hi;
              const f32x4 c0 = *(const GAS f32x4*)rp, c1 = *(const GAS f32x4*)(rp + 4), s0 = *(const GAS f32x4*)(rp + 16), s1 = *(const GAS f32x4*)(rp + 20);
              const u32x4 a = __builtin_bit_cast(u32x4, qf[NKS - 2]), bq = __builtin_bit_cast(u32x4, qf[NKS - 1]); u32x4 ra, rb;
#pragma unroll
              for (int w = 0; w < 4; ++w) { const float cl = w < 2 ? c0[2 * w] : c1[2 * w - 4], ch = w < 2 ? c0[2 * w + 1] : c1[2 * w - 3], sl = w < 2 ? s0[2 * w] : s1[2 * w - 4], sh = w < 2 ? s0[2 * w + 1] : s1[2 * w - 3];
                  const float x1l = bflo(a[w]), x1h = bfhi(a[w]), x2l = bflo(bq[w]), x2h = bfhi(bq[w]);
                  ra[w] = cvtpk(x1l * cl - x2l * sl, x1h * ch - x2h * sh); rb[w] = cvtpk(x1l * sl + x2l * cl, x1h * sh + x2h * ch); }
              qf[NKS - 2] = __builtin_bit_cast(bf16x8, ra); qf[NKS - 1] = __builtin_bit_cast(bf16x8, rb);
          } }
        __syncthreads();
        float m1 = 0.f, l1 = 0.f;
        f32x16 negm;
#pragma unroll
        for (int r = 0; r < 16; ++r) negm[r] = 0.f;
#pragma unroll
        for (int d = 0; d < 2; ++d)
#pragma unroll
            for (int r = 0; r < 16; ++r) oA[d][r] = 0.f;
        gload(0); lstore(0);
        if (NT > 1) gload(1);
        __syncthreads();
        if (DIFF) { bias_far = ((LAS float*)(lds + C::BT))[128];
#pragma unroll
            for (int r = 0; r < 16; ++r) negm[r] = bias_far; }
        const int NTW = (q0w + 31) / 128 + 1;
        auto compute = [&](int t, int buf) {
            const int k0 = 128 * t;
            const LAS unsigned char* kb_ = lds + C::K0 + buf * C::KB + r32 * KP + hi * 16 + mp * 64;
            const LAS unsigned char* vb_ = lds + C::V0 + buf * C::VB + ((lane >> 4) & 1) * 32 + (lane & 3) * 8 + (4 * hi + ((lane & 15) >> 2)) * 64;
            bool nearb = false;
            if (DIFF) { const LAS int* pm = (const LAS int*)(lds + C::PMX) + buf * 2; const int m0 = __builtin_amdgcn_readfirstlane(pm[0]), m1_ = __builtin_amdgcn_readfirstlane(pm[1]); nearb = (minq - (m0 > m1_ ? m0 : m1_)) < 128; }
            f32x16 sc[4];
            if (DIFF) { if (nearb) {
#pragma unroll
                for (int g = 0; g < 4; ++g)
#pragma unroll
                    for (int r = 0; r < 16; ++r) sc[g][r] = -m1; } }
            if (!DIFF) {
                bf16x8 kq[4 * NKS];
#pragma unroll
                for (int i = 0; i < 4 * NKS; ++i) kq[i] = *(const LAS bf16x8*)(kb_ + 32 * (i & 3) * KP + (i >> 2) * 32);
#pragma unroll
                for (int i = 0; i < 4 * NKS; ++i) sc[i & 3] = __builtin_amdgcn_mfma_f32_32x32x16_bf16(kq[i], qf[i >> 2], i < 4 ? negm : sc[i & 3], 0, 0, 0);
                __builtin_amdgcn_sched_group_barrier(0x100, 4, 0);
#pragma unroll
                for (int i = 0; i < 4 * NKS - 4; ++i) { __builtin_amdgcn_sched_group_barrier(0x008, 1, 0); __builtin_amdgcn_sched_group_barrier(0x100, 1, 0); }
                __builtin_amdgcn_sched_group_barrier(0x008, 4, 0);
                __builtin_amdgcn_sched_barrier(0);
            } else {
            constexpr int HB = NKS > 3 ? 3 : NKS;
#pragma unroll
            for (int s0_ = 0; s0_ < NKS; s0_ += HB) {
                bf16x8 kf[4][HB];
#pragma unroll
                for (int g = 0; g < 4; ++g)
#pragma unroll
                    for (int s = 0; s < HB; ++s) kf[g][s] = *(const LAS bf16x8*)(kb_ + 32 * g * KP + (s0_ + s) * 32);
                __builtin_amdgcn_sched_barrier(0);
#pragma unroll
                for (int s = 0; s < HB; ++s)
#pragma unroll
                    for (int g = 0; g < 4; ++g) {
                        if (s0_ + s == 0 && !(DIFF && nearb)) sc[g] = __builtin_amdgcn_mfma_f32_32x32x16_bf16(kf[g][s], qf[s0_ + s], negm, 0, 0, 0);
                        else sc[g] = __builtin_amdgcn_mfma_f32_32x32x16_bf16(kf[g][s], qf[s0_ + s], sc[g], 0, 0, 0); }
                __builtin_amdgcn_sched_barrier(0);
            }
            }
            if (DIFF) { if (nearb) {
                const LAS int* pk = (const LAS int*)(lds + C::POS + buf * 512); const LAS float* bt = (const LAS float*)(lds + C::BT);
#pragma unroll
                for (int g = 0; g < 4; ++g)
#pragma unroll
                    for (int r = 0; r < 16; ++r) { int n0 = pq - pk[32 * g + crow(r, hi)]; n0 = n0 < 0 ? 0 : (n0 > 128 ? 128 : n0); sc[g][r] += bt[n0]; }
            } }
            asm volatile("s_nop 15\n\ts_nop 7" : "+v"(sc[0]), "+v"(sc[1]), "+v"(sc[2]), "+v"(sc[3]));
            if (k0 + 127 > q0w) {
#pragma unroll
                for (int g = 0; g < 4; ++g)
#pragma unroll
                    for (int r = 0; r < 16; ++r) { if (k0 + 32 * g + crow(r, hi) > qi) sc[g][r] = -1e30f; }
            }
            const float mx = swapmax(vmax3(max32(sc[0], sc[1]), max32(sc[2], sc[3]), -1e30f));
            const bool up = (t == 0) || mx > 8.0f;
            float al = 1.f;
            if (__builtin_amdgcn_ballot_w64(up) != 0ull) {
                const float dl = up ? mx : 0.f; al = __builtin_amdgcn_exp2f(-dl); l1 *= al; m1 += dl;
#pragma unroll
                for (int r = 0; r < 16; ++r) negm[r] -= dl;
#pragma unroll
                for (int g = 0; g < 4; ++g)
#pragma unroll
                    for (int r = 0; r < 16; ++r) sc[g][r] -= dl;
            }
            float ls = 0.f;
#pragma unroll
            for (int g = 0; g < 4; ++g)
#pragma unroll
                for (int r = 0; r < 16; ++r) { sc[g][r] = __builtin_amdgcn_exp2f(sc[g][r]); ls += sc[g][r]; }
            l1 += ls;
            bf16x8 pf[8];
#pragma unroll
            for (int g = 0; g < 4; ++g) { pf[2 * g] = pack8(sc[g], 0); pf[2 * g + 1] = pack8(sc[g], 8); }
            if (__builtin_amdgcn_ballot_w64(al != 1.0f) != 0ull) {
#pragma unroll
                for (int d = 0; d < 2; ++d)
#pragma unroll
                    for (int r = 0; r < 16; ++r) oA[d][r] *= al;
            }
            if (!DIFF) {
                bf16x8 vq[16];
#pragma unroll
                for (int i = 0; i < 16; ++i) { const int d = i & 1, s = i >> 1; const s16x4 lo = vtr(vb_ + d * 8192 + s * 1024), hh = vtr(vb_ + d * 8192 + s * 1024 + 512); vq[i] = (bf16x8){lo[0], lo[1], lo[2], lo[3], hh[0], hh[1], hh[2], hh[3]}; }
#pragma unroll
                for (int i = 0; i < 16; ++i) oA[i & 1] = __builtin_amdgcn_mfma_f32_32x32x16_bf16(vq[i], pf[i >> 1], oA[i & 1], 0, 0, 0);
                __builtin_amdgcn_sched_group_barrier(0x100, 4, 0);
#pragma unroll
                for (int i = 0; i < 14; ++i) { __builtin_amdgcn_sched_group_barrier(0x008, 1, 0); __builtin_amdgcn_sched_group_barrier(0x100, 2, 0); }
                __builtin_amdgcn_sched_group_barrier(0x008, 2, 0);
                __builtin_amdgcn_sched_barrier(0);
            } else {
#pragma unroll
            for (int d = 0; d < 2; ++d) {
                bf16x8 vf[8];
#pragma unroll
                for (int s = 0; s < 8; ++s) { const s16x4 lo = vtr(vb_ + d * 8192 + s * 1024), hh = vtr(vb_ + d * 8192 + s * 1024 + 512); vf[s] = (bf16x8){lo[0], lo[1], lo[2], lo[3], hh[0], hh[1], hh[2], hh[3]}; }
                __builtin_amdgcn_sched_barrier(0);
#pragma unroll
                for (int s = 0; s < 8; ++s) oA[d] = __builtin_amdgcn_mfma_f32_32x32x16_bf16(vf[s], pf[s], oA[d], 0, 0, 0);
                __builtin_amdgcn_sched_barrier(0);
            }
            }
        };
        int t = 0;
        for (; t + 2 < NT; ++t) {
            const int buf = t & 1;
            if (t < NTW) compute(t, buf);
            lstore(buf ^ 1); gload(t + 2);
            TILE_BAR();
        }
        for (; t < NT; ++t) {
            const int buf = t & 1;
            if (t < NTW) compute(t, buf);
            if (t + 1 < NT) lstore(buf ^ 1);
            TILE_BAR();
        }
        il = 1.f / swapadd(l1);
        if (DIFF) { if (mp == 0) {
#pragma unroll
            for (int d = 0; d < 2; ++d)
#pragma unroll
                for (int r = 0; r < 16; ++r) osv[(d * 16 + r) * 64] = oA[d][r] * il; } }
    }
    GAS bf16* orow = P.O + (rowb + qi) * P.op + h * 64;
    if (!DIFF) {
#pragma unroll
        for (int d = 0; d < 2; ++d)
#pragma unroll
            for (int g = 0; g < 4; ++g) { v2u v; v.x = cvtpk(oA[d][4 * g] * il, oA[d][4 * g + 1] * il); v.y = cvtpk(oA[d][4 * g + 2] * il, oA[d][4 * g + 3] * il); *(GAS v2u*)(orow + 32 * d + 8 * g + 4 * hi) = v; }
    } else {
        const float lam = P.lams[0], lam_init = P.lams[1];
        const float i2 = lam * il;
        float ss = 0.f;
#pragma unroll
        for (int d = 0; d < 2; ++d)
#pragma unroll
            for (int r = 0; r < 16; ++r) { const float v = osv[(d * 16 + r) * 64] - oA[d][r] * i2; oA[d][r] = v; ss += v * v; }
        ss = swapadd(ss);
        const float rs = __builtin_amdgcn_rsqf(ss * (1.f / 64.f) + 1e-6f) * (1.f - lam_init);
        const LAS float* dn = (const LAS float*)(lds + C::DN);
#pragma unroll
        for (int d = 0; d < 2; ++d)
#pragma unroll
            for (int g = 0; g < 4; ++g) { const int c = 32 * d + 8 * g + 4 * hi; const f32x4 gn = *(const LAS f32x4*)(dn + c);
                v2u v; v.x = cvtpk(oA[d][4 * g] * rs * gn[0], oA[d][4 * g + 1] * rs * gn[1]); v.y = cvtpk(oA[d][4 * g + 2] * rs * gn[2], oA[d][4 * g + 3] * rs * gn[3]); *(GAS v2u*)(orow + c) = v; }
    }
}

struct AKD {
    static constexpr int KP = 144, KB = 64 * KP, VB = 2 * 4096;
    static constexpr int K0 = 0, V0 = 2 * KB, POS = V0 + 2 * VB, PMX = POS + 512, BT = PMX + 16, DN = BT + 528, END = DN + 256;
};
static_assert(AKD::END <= RING_BYTES, "attention LDS (merged differential maps)");
__device__ __forceinline__ void attn_diff_unit(const AttnP& P, int b, int h, int qb, LAS unsigned char* lds, int wave) {
    const int lane = lane_id_v(), tid = (wave << 6) | lane;
    typedef AKD C;
    constexpr int KP = C::KP;
    const int r32 = lane & 31, hi = lane >> 5;
    const size_t rowb = (size_t)b * S;
    const int q0w = qb * 256 + wave * 32, qi = q0w + r32;
    __syncthreads();
    const int pq = P.pos[rowb + qi];
    if (tid < 129) ((LAS float*)(lds + C::BT))[tid] = P.btab[h * 129 + tid];
    if (tid >= 192 && tid < 256) ((LAS float*)(lds + C::DN))[tid - 192] = P.dnorm[tid - 192];
    const int minq = __builtin_amdgcn_readfirstlane(-wave_max_i(-pq));
    const int NT = 4 * (qb + 1);
    const GAS bf16* Kb = P.K + rowb * P.kp + h * 64; const GAS bf16* Vb = P.V + rowb * P.vp + h * 64;
    const __amdgpu_buffer_rsrc_t rK = __builtin_amdgcn_make_buffer_rsrc((void*)Kb, 0, 0x7fffffff, 0x00020000), rV = __builtin_amdgcn_make_buffer_rsrc((void*)Vb, 0, 0x7fffffff, 0x00020000);
    const __amdgpu_buffer_rsrc_t rP = __builtin_amdgcn_make_buffer_rsrc((void*)(P.pos + rowb), 0, 0x7fffffff, 0x00020000);
    const int skey = tid >> 3, spart = tid & 7;
    const int kvo = (skey * P.kp + spart * 8) * 2, vvo = (skey * P.vp + spart * 8) * 2, klo = skey * KP + spart * 16, vlo = (spart >> 2) * 4096 + (skey >> 3) * 512 + (skey & 7) * 64 + (spart & 3) * 16;
    const int pvo = (tid & 63) * 4;
    u32x4 kr, vr; int pkr = 0;
    auto gload = [&](int t) {
        kr = __builtin_amdgcn_raw_buffer_load_b128(rK, kvo, __builtin_amdgcn_readfirstlane(64 * t * P.kp * 2), 0);
        vr = __builtin_amdgcn_raw_buffer_load_b128(rV, vvo, __builtin_amdgcn_readfirstlane(64 * t * P.vp * 2), 0);
        pkr = __builtin_amdgcn_raw_buffer_load_b32(rP, pvo, __builtin_amdgcn_readfirstlane(64 * t * 4), 0);
    };
    auto lstore = [&](int buf) {
        *(LAS u32x4*)(lds + C::K0 + buf * C::KB + klo) = kr; *(LAS u32x4*)(lds + C::V0 + buf * C::VB + vlo) = vr;
        if (tid < 64) { ((LAS int*)(lds + C::POS + buf * 256))[tid] = pkr; const int mk_ = wave_max_i(pkr); if (lane == 0) ((LAS int*)(lds + C::PMX))[buf] = mk_; }
    };
    gload(0);
    bf16x8 qf[2][2];
    { const GAS bf16* qrow = P.Q + (rowb + qi) * P.qp + h * 64;
#pragma unroll
      for (int mp = 0; mp < 2; ++mp)
#pragma unroll
          for (int s_ = 0; s_ < 2; ++s_) qf[mp][s_] = *(const GAS bf16x8*)(qrow + 32 * mp + 16 * s_ + 8 * hi); }
    __syncthreads();
    lstore(0);
    if (NT > 1) gload(1);
    __syncthreads();
    const float bias_far = ((LAS float*)(lds + C::BT))[128];
    float m_[2] = {0.f, 0.f}, l_[2] = {0.f, 0.f};
    f32x16 negm[2], oA[2][2];
#pragma unroll
    for (int mp = 0; mp < 2; ++mp) {
#pragma unroll
        for (int r = 0; r < 16; ++r) { negm[mp][r] = bias_far; oA[mp][0][r] = 0.f; oA[mp][1][r] = 0.f; } }
    const int NTW = (q0w + 31) / 64 + 1;
    auto compute = [&](int t, int buf) {
        const int k0 = 64 * t;
        const LAS unsigned char* kb_ = lds + C::K0 + buf * C::KB + r32 * KP + hi * 16;
        const LAS unsigned char* vb_ = lds + C::V0 + buf * C::VB + ((lane >> 4) & 1) * 32 + (lane & 3) * 8 + (4 * hi + ((lane & 15) >> 2)) * 64;
        const bool nearb = (minq - __builtin_amdgcn_readfirstlane(((const LAS int*)(lds + C::PMX))[buf])) < 128;
        const bool diag = k0 + 63 > q0w;
        bf16x8 pf[2][4];
#pragma unroll
        for (int mp = 0; mp < 2; ++mp) {
            f32x16 sc[2];
            bf16x8 kf[2][2];
#pragma unroll
            for (int g = 0; g < 2; ++g)
#pragma unroll
                for (int s_ = 0; s_ < 2; ++s_) kf[g][s_] = *(const LAS bf16x8*)(kb_ + 32 * g * KP + mp * 64 + s_ * 32);
            if (nearb) {
#pragma unroll
                for (int g = 0; g < 2; ++g) {
#pragma unroll
                    for (int r = 0; r < 16; ++r) sc[g][r] = -m_[mp];
#pragma unroll
                    for (int s_ = 0; s_ < 2; ++s_) sc[g] = __builtin_amdgcn_mfma_f32_32x32x16_bf16(kf[g][s_], qf[mp][s_], sc[g], 0, 0, 0); }
                const LAS int* pk = (const LAS int*)(lds + C::POS + buf * 256); const LAS float* bt = (const LAS float*)(lds + C::BT);
#pragma unroll
                for (int g = 0; g < 2; ++g)
#pragma unroll
                    for (int r = 0; r < 16; ++r) { int n0 = pq - pk[32 * g + crow(r, hi)]; n0 = n0 < 0 ? 0 : (n0 > 128 ? 128 : n0); sc[g][r] += bt[n0]; }
            } else {
#pragma unroll
                for (int g = 0; g < 2; ++g) { sc[g] = __builtin_amdgcn_mfma_f32_32x32x16_bf16(kf[g][0], qf[mp][0], negm[mp], 0, 0, 0); sc[g] = __builtin_amdgcn_mfma_f32_32x32x16_bf16(kf[g][1], qf[mp][1], sc[g], 0, 0, 0); }
            }
            asm volatile("s_nop 15\n\ts_nop 7" : "+v"(sc[0]), "+v"(sc[1]));
            if (diag) {
#pragma unroll
                for (int g = 0; g < 2; ++g)
#pragma unroll
                    for (int r = 0; r < 16; ++r) { if (k0 + 32 * g + crow(r, hi) > qi) sc[g][r] = -1e30f; }
            }
            const float mx = swapmax(vmax3(max32(sc[0], sc[1]), -1e30f, -1e30f));
            const bool up = (t == 0) || mx > 8.0f;
            if (__builtin_amdgcn_ballot_w64(up) != 0ull) {
                const float dl = up ? mx : 0.f; const float al = __builtin_amdgcn_exp2f(-dl); l_[mp] *= al; m_[mp] += dl;
#pragma unroll
                for (int r = 0; r < 16; ++r) negm[mp][r] -= dl;
#pragma unroll
                for (int g = 0; g < 2; ++g)
#pragma unroll
                    for (int r = 0; r < 16; ++r) sc[g][r] -= dl;
#pragma unroll
                for (int d = 0; d < 2; ++d)
#pragma unroll
                    for (int r = 0; r < 16; ++r) oA[mp][d][r] *= al;
            }
            float ls = 0.f;
#pragma unroll
            for (int g = 0; g < 2; ++g)
#pragma unroll
                for (int r = 0; r < 16; ++r) { sc[g][r] = __builtin_amdgcn_exp2f(sc[g][r]); ls += sc[g][r]; }
            l_[mp] += ls;
#pragma unroll
            for (int g = 0; g < 2; ++g) { pf[mp][2 * g] = pack8(sc[g], 0); pf[mp][2 * g + 1] = pack8(sc[g], 8); }
        }
        { bf16x8 vq[8];
#pragma unroll
          for (int i = 0; i < 8; ++i) { const int d = i & 1, s_ = i >> 1; const s16x4 lo = vtr(vb_ + d * 4096 + s_ * 1024), hh = vtr(vb_ + d * 4096 + s_ * 1024 + 512); vq[i] = (bf16x8){lo[0], lo[1], lo[2], lo[3], hh[0], hh[1], hh[2], hh[3]}; }
#pragma unroll
          for (int i = 0; i < 8; ++i) { const int d = i & 1, s_ = i >> 1; oA[0][d] = __builtin_amdgcn_mfma_f32_32x32x16_bf16(vq[i], pf[0][s_], oA[0][d], 0, 0, 0); oA[1][d] = __builtin_amdgcn_mfma_f32_32x32x16_bf16(vq[i], pf[1][s_], oA[1][d], 0, 0, 0); }
          __builtin_amdgcn_sched_group_barrier(0x100, 4, 0);
#pragma unroll
          for (int i = 0; i < 6; ++i) { __builtin_amdgcn_sched_group_barrier(0x008, 2, 0); __builtin_amdgcn_sched_group_barrier(0x100, 2, 0); }
          __builtin_amdgcn_sched_group_barrier(0x008, 4, 0);
          __builtin_amdgcn_sched_barrier(0); }
    };
#pragma unroll 1
    for (int t = 0; t < NT; ++t) {
        const int buf = t & 1;
        if (t < NTW) compute(t, buf);
        if (t + 1 < NT) lstore(buf ^ 1);
        if (t + 2 < NT) gload(t + 2);
        TILE_BAR();
    }
    const float il1 = 1.f / swapadd(l_[0]), il2 = 1.f / swapadd(l_[1]);
    const float lam = P.lams[0], lam_init = P.lams[1];
    const float i2 = lam * il2;
    float ss = 0.f;
#pragma unroll
    for (int d = 0; d < 2; ++d)
#pragma unroll
        for (int r = 0; r < 16; ++r) { const float v = oA[0][d][r] * il1 - oA[1][d][r] * i2; oA[0][d][r] = v; ss += v * v; }
    ss = swapadd(ss);
    const float rs = __builtin_amdgcn_rsqf(ss * (1.f / 64.f) + 1e-6f) * (1.f - lam_init);
    const LAS float* dn = (const LAS float*)(lds + C::DN);
    GAS bf16* orow = P.O + (rowb + qi) * P.op + h * 64;
#pragma unroll
    for (int d = 0; d < 2; ++d)
#pragma unroll
        for (int g = 0; g < 4; ++g) { const int c = 32 * d + 8 * g + 4 * hi; const f32x4 gn = *(const LAS f32x4*)(dn + c);
            v2u v; v.x = cvtpk(oA[0][d][4 * g] * rs * gn[0], oA[0][d][4 * g + 1] * rs * gn[1]); v.y = cvtpk(oA[0][d][4 * g + 2] * rs * gn[2], oA[0][d][4 * g + 3] * rs * gn[3]); *(GAS v2u*)(orow + c) = v; }
}

__device__ __forceinline__ void attn_phase(const AttnP& PM, const AttnP& PD, LAS unsigned char* lds, int tid, int wave, int lane, int vcu, int G, int only = -1) {
    for (int i = vcu; i < 512; i += G) {
        if (only >= 0 && (i >> 8) != only) continue;
        const int kind = i >> 8, c = i & 255, bh = c >> 4, s = c & 15;
        if (kind == 0) {
#pragma unroll 1
            for (int k = 0; k < 2; ++k) attn_unit2<0>(PM, bh >> 2, bh & 3, k ? 31 - s : s, lds, tid, wave, lane);
        } else {
#pragma unroll 1
            for (int k = 0; k < 2; ++k) attn_diff_unit(PD, bh >> 2, bh & 3, k ? 31 - s : s, lds, wave);
        }
    }
}
__device__ __forceinline__ float cx_max16(const f32x16& p) { return fmaxf(fmaxf(fmaxf(fmaxf(p[0], p[1]), fmaxf(p[2], p[3])), fmaxf(fmaxf(p[4], p[5]), fmaxf(p[6], p[7]))), fmaxf(fmaxf(fmaxf(p[8], p[9]), fmaxf(p[10], p[11])), fmaxf(fmaxf(p[12], p[13]), fmaxf(p[14], p[15])))); }
__device__ __forceinline__ void cross_unit2(const AttnP& P, int b, int h, int qb, LAS unsigned char* lds, int wave) {
    const int lane = lane_id_v(), tid = (wave << 6) | lane;
    constexpr int KP = 528;
    const int r32 = lane & 31, hi = lane >> 5;
    const size_t rowb = (size_t)b * S, rowk = (size_t)b * MEM;
    const int qi = qb * 256 + wave * 32 + r32;
    const GAS bf16* Kb = P.K + rowk * P.kp + h * 256; const GAS bf16* Vb = P.V + rowk * P.vp + h * 256;
    const __amdgpu_buffer_rsrc_t rK = __builtin_amdgcn_make_buffer_rsrc((void*)Kb, 0, 0x7fffffff, 0x00020000), rV = __builtin_amdgcn_make_buffer_rsrc((void*)Vb, 0, 0x7fffffff, 0x00020000);
    const GAS bf16* qrow = P.Q + (rowb + qi) * P.qp + h * 256 + 8 * hi;
    bf16x8 qf[4];
#pragma unroll
    for (int s = 0; s < 4; ++s) qf[s] = *(const GAS bf16x8*)(qrow + 16 * s);
    { u32x4 st[16];
#pragma unroll
      for (int i = 0; i < 16; ++i) { const int c = tid + 512 * i; st[i] = __builtin_amdgcn_raw_buffer_load_b128(rK, ((c >> 5) * P.kp + (c & 31) * 8) * 2, 0, 0); }
      TILE_BAR();
#pragma unroll
      for (int i = 0; i < 16; ++i) { const int c = tid + 512 * i; *(LAS u32x4*)(lds + (c >> 5) * KP + (c & 31) * 16) = st[i]; } }
    __syncthreads();
    f32x16 sc[8];
#pragma unroll
    for (int g = 0; g < 8; ++g)
#pragma unroll
        for (int r = 0; r < 16; ++r) sc[g][r] = 0.f;
    const LAS unsigned char* kb_ = lds + r32 * KP + hi * 16;
#pragma unroll
    for (int c = 0; c < 4; ++c) {
        bf16x8 qn[4];
        if (c + 1 < 4) {
#pragma unroll
            for (int s = 0; s < 4; ++s) qn[s] = *(const GAS bf16x8*)(qrow + 64 * (c + 1) + 16 * s); }
        { bf16x8 kq[32];
#pragma unroll
          for (int i = 0; i < 32; ++i) kq[i] = *(const LAS bf16x8*)(kb_ + 32 * (i & 7) * KP + (4 * c + (i >> 3)) * 32);
#pragma unroll
          for (int i = 0; i < 32; ++i) sc[i & 7] = __builtin_amdgcn_mfma_f32_32x32x16_bf16(kq[i], qf[i >> 3], sc[i & 7], 0, 0, 0);
          __builtin_amdgcn_sched_group_barrier(0x100, 4, 0);
#pragma unroll
          for (int i = 0; i < 28; ++i) { __builtin_amdgcn_sched_group_barrier(0x008, 1, 0); __builtin_amdgcn_sched_group_barrier(0x100, 1, 0); }
          __builtin_amdgcn_sched_group_barrier(0x008, 4, 0);
          __builtin_amdgcn_sched_barrier(0); }
        if (c + 1 < 4) {
#pragma unroll
            for (int s = 0; s < 4; ++s) qf[s] = qn[s]; }
    }
    float m = fmaxf(fmaxf(fmaxf(cx_max16(sc[0]), cx_max16(sc[1])), fmaxf(cx_max16(sc[2]), cx_max16(sc[3]))), fmaxf(fmaxf(cx_max16(sc[4]), cx_max16(sc[5])), fmaxf(cx_max16(sc[6]), cx_max16(sc[7]))));
    m = swapmax(m);
    float l = 0.f;
    bf16x8 pf[16];
#pragma unroll
    for (int g = 0; g < 8; ++g) {
#pragma unroll
        for (int r = 0; r < 16; ++r) { sc[g][r] = __builtin_amdgcn_exp2f(sc[g][r] - m); l += sc[g][r]; }
        pf[2 * g] = pack8(sc[g], 0); pf[2 * g + 1] = pack8(sc[g], 8); }
    const float il = 1.f / swapadd(l);
    { u32x4 st[16];
#pragma unroll
      for (int i = 0; i < 16; ++i) { const int c = tid + 512 * i; const int sub = c & 3, key = (c >> 2) & 255, dt = c >> 10; st[i] = __builtin_amdgcn_raw_buffer_load_b128(rV, (key * P.vp + dt * 32 + sub * 8) * 2, 0, 0); }
      TILE_BAR();
#pragma unroll
      for (int i = 0; i < 16; ++i) { const int c = tid + 512 * i; const int sub = c & 3, key = (c >> 2) & 255, dt = c >> 10; *(LAS u32x4*)(lds + dt * 16384 + (key >> 3) * 512 + (key & 7) * 64 + sub * 16) = st[i]; } }
    __syncthreads();
    const LAS unsigned char* vb_ = lds + ((lane >> 4) & 1) * 32 + (lane & 3) * 8 + (4 * hi + ((lane & 15) >> 2)) * 64;
    GAS bf16* orow = P.O + (rowb + qi) * P.op + h * 256;
#pragma unroll 1
    for (int dh = 0; dh < 2; ++dh) {
        f32x16 oA[4];
#pragma unroll
        for (int d = 0; d < 4; ++d)
#pragma unroll
            for (int r = 0; r < 16; ++r) oA[d][r] = 0.f;
#pragma unroll
        for (int d = 0; d < 4; ++d) {
            { bf16x8 vq[16];
#pragma unroll
              for (int s = 0; s < 16; ++s) { const s16x4 lo = vtr(vb_ + (4 * dh + d) * 16384 + s * 1024), hh = vtr(vb_ + (4 * dh + d) * 16384 + s * 1024 + 512); vq[s] = (bf16x8){lo[0], lo[1], lo[2], lo[3], hh[0], hh[1], hh[2], hh[3]}; }
#pragma unroll
              for (int s = 0; s < 16; ++s) oA[d] = __builtin_amdgcn_mfma_f32_32x32x16_bf16(vq[s], pf[s], oA[d], 0, 0, 0);
              __builtin_amdgcn_sched_group_barrier(0x100, 4, 0);
#pragma unroll
              for (int i = 0; i < 14; ++i) { __builtin_amdgcn_sched_group_barrier(0x008, 1, 0); __builtin_amdgcn_sched_group_barrier(0x100, 2, 0); }
              __builtin_amdgcn_sched_group_barrier(0x008, 2, 0);
              __builtin_amdgcn_sched_barrier(0); } }
#pragma unroll
        for (int d = 0; d < 4; ++d)
#pragma unroll
            for (int g = 0; g < 4; ++g) { v2u v; v.x = cvtpk(oA[d][4 * g] * il, oA[d][4 * g + 1] * il); v.y = cvtpk(oA[d][4 * g + 2] * il, oA[d][4 * g + 3] * il); *(GAS v2u*)(orow + 128 * dh + 32 * d + 8 * g + 4 * hi) = v; }
    }
}
__device__ __forceinline__ void cross_phase(const AttnP& PC, LAS unsigned char* lds, int tid, int wave, int lane, int vcu, int G) {
#pragma unroll 1
    for (int i = vcu; i < 512; i += G) { const int bh = i >> 5; cross_unit2(PC, bh >> 2, bh & 3, i & 31, lds, wave); }
}


__device__ __forceinline__ float vmax2(float a, float b) { float r; asm("v_max_f32_e32 %0, %1, %2" : "=v"(r) : "v"(a), "v"(b)); return r; }
__device__ __forceinline__ float vmin2(float a, float b) { float r; asm("v_min_f32_e32 %0, %1, %2" : "=v"(r) : "v"(a), "v"(b)); return r; }
__device__ __forceinline__ void pad16(float (&a)[16]) {
    asm volatile("s_nop 1" : "+v"(a[0]), "+v"(a[1]), "+v"(a[2]), "+v"(a[3]), "+v"(a[4]), "+v"(a[5]), "+v"(a[6]), "+v"(a[7]), "+v"(a[8]), "+v"(a[9]), "+v"(a[10]), "+v"(a[11]), "+v"(a[12]), "+v"(a[13]), "+v"(a[14]), "+v"(a[15]));
}
__device__ __forceinline__ void sort16_desc(float (&a)[16]) {
#pragma unroll
    for (int k = 2; k <= 16; k <<= 1)
#pragma unroll
        for (int j = k >> 1; j > 0; j >>= 1)
#pragma unroll
            for (int i = 0; i < 16; ++i) { const int l = i ^ j; if (l > i) { const bool desc = ((i & k) == 0); const float hi_ = vmax2(a[i], a[l]), lo_ = vmin2(a[i], a[l]); a[i] = desc ? hi_ : lo_; a[l] = desc ? lo_ : hi_; } }
}
__device__ __forceinline__ void merge16_desc(float (&a)[16], const float (&b)[16]) {
#pragma unroll
    for (int i = 0; i < 16; ++i) a[i] = vmax2(a[i], b[15 - i]);
#pragma unroll
    for (int j = 8; j > 0; j >>= 1)
#pragma unroll
        for (int i = 0; i < 16; ++i) { const int l = i ^ j; if (l > i) { const float hi_ = vmax2(a[i], a[l]), lo_ = vmin2(a[i], a[l]); a[i] = hi_; a[l] = lo_; } }
}
__device__ __forceinline__ void top16_of_64(float (&g0)[16], float (&g1)[16], float (&g2)[16], float (&g3)[16]) {
    sort16_desc(g0); sort16_desc(g1); merge16_desc(g0, g1); sort16_desc(g2); sort16_desc(g3); merge16_desc(g2, g3); merge16_desc(g0, g2);
}
__device__ __forceinline__ float embed(float v, unsigned mask, unsigned id) { return __builtin_bit_cast(float, (__builtin_bit_cast(unsigned, v) & mask) | id); }
__device__ __forceinline__ float mkcand(float x, float y, unsigned id) { return embed(x + y, 0xFFFFFF00u, id); }

__device__ __forceinline__ void swap32(float& a, float& b) { asm volatile("v_nop\n\tv_nop\n\tv_permlane32_swap_b32 %0, %1" : "+v"(a), "+v"(b)); }
struct RouteP { const GAS bf16* QP; const GAS bf16* keys; GAS int* EX; GAS float* GW; };
constexpr int RT_KP = 144, RT_KEYS = 0, RT_SCR = 256 * RT_KP, RT_END = RT_SCR + 8 * 8192;
__device__ __forceinline__ void route_phase(const RouteP& P, LAS unsigned char* lds, int tid, int wave, int lane, int vcu, int G) {
    asm volatile("" : "+v"(tid), "+v"(lane));
    __syncthreads();
    for (int c = tid; c < 256 * 8; c += 512) { const int row = c >> 3, part = c & 7; *(LAS u32x4*)(lds + RT_KEYS + row * RT_KP + part * 16) = *(const u32x4*)(P.keys + row * 64 + part * 8); }
    __syncthreads();
    const int r32 = lane & 31, hi = lane >> 5;
    LAS int* scr = (LAS int*)(lds + RT_SCR + wave * 8192);
    for (int u = vcu; u < T / 32; u += G) {
        const size_t t = (size_t)u * 32 + r32; const int h = wave;
        float T2[2][16];
#pragma unroll
        for (int c = 0; c < 2; ++c) {
            bf16x8 qf[4];
            { const GAS bf16* q = P.QP + t * 1024 + h * 128 + c * 64 + 8 * hi;
#pragma unroll
              for (int s = 0; s < 4; ++s) qf[s] = *(const GAS bf16x8*)(q + 16 * s); }
            f32x16 sc[4];
#pragma unroll
            for (int m = 0; m < 4; ++m) {
#pragma unroll
                for (int r = 0; r < 16; ++r) sc[m][r] = 0.f;
#pragma unroll
                for (int s = 0; s < 4; ++s) { const bf16x8 a = *(const LAS bf16x8*)(lds + RT_KEYS + (c * 128 + 32 * m + r32) * RT_KP + s * 32 + hi * 16);
                    sc[m] = __builtin_amdgcn_mfma_f32_32x32x16_bf16(a, qf[s], sc[m], 0, 0, 0); }
            }
            float g0[16], g1[16], g2[16], g3[16];
            const unsigned h4 = 4u * (unsigned)hi;
#pragma unroll
            for (int r = 0; r < 16; ++r) { const unsigned kr_ = (unsigned)((r & 3) + 8 * (r >> 2));
                g0[r] = embed(sc[0][r], 0xFFFFFF80u, kr_ | h4); g1[r] = embed(sc[1][r], 0xFFFFFF80u, (32u + kr_) | h4); g2[r] = embed(sc[2][r], 0xFFFFFF80u, (64u + kr_) | h4); g3[r] = embed(sc[3][r], 0xFFFFFF80u, (96u + kr_) | h4); }
            top16_of_64(g0, g1, g2, g3);
            pad16(g0);
#pragma unroll
            for (int i = 0; i < 16; ++i) T2[c][i] = g0[i];
        }
        float A[16], Bv[16];
#pragma unroll
        for (int i = 0; i < 16; ++i) { A[i] = T2[0][i]; Bv[i] = T2[1][i]; swap32(A[i], Bv[i]); }
        merge16_desc(A, Bv);
        pad16(A);
        float T0[16], T1[16];
#pragma unroll
        for (int i = 0; i < 16; ++i) { T0[i] = A[i]; T1[i] = A[i]; swap32(T0[i], T1[i]); }
#pragma unroll
        for (int i = 0; i < 16; ++i) { scr[i * 64 + lane] = (int)(__builtin_bit_cast(unsigned, T0[i]) & 127u); scr[(16 + i) * 64 + lane] = (int)(__builtin_bit_cast(unsigned, T1[i]) & 127u);
            T0[i] = embed(T0[i], 0xFFFFFF80u, 0u); T1[i] = embed(T1[i], 0xFFFFFF80u, 0u); }
        float c0[16], c1[16], c2[16], c3[16];
        const float NINF = -__builtin_inff();
#pragma unroll
        for (int b = 0; b < 16; ++b) c0[b] = mkcand(T0[0], T1[b], (unsigned)b);
#pragma unroll
        for (int b = 0; b < 8; ++b) c1[b] = mkcand(T0[1], T1[b], 16u + b);
#pragma unroll
        for (int b = 0; b < 5; ++b) c1[8 + b] = mkcand(T0[2], T1[b], 32u + b);
#pragma unroll
        for (int b = 0; b < 3; ++b) c1[13 + b] = mkcand(T0[4], T1[b], 64u + b);
#pragma unroll
        for (int b = 0; b < 4; ++b) c2[b] = mkcand(T0[3], T1[b], 48u + b);
        c2[4] = mkcand(T0[5], T1[0], 80u); c2[5] = mkcand(T0[5], T1[1], 81u); c2[6] = mkcand(T0[6], T1[0], 96u); c2[7] = mkcand(T0[6], T1[1], 97u); c2[8] = mkcand(T0[7], T1[0], 112u); c2[9] = mkcand(T0[7], T1[1], 113u);
#pragma unroll
        for (int a = 8; a < 14; ++a) c2[10 + a - 8] = mkcand(T0[a], T1[0], 16u * a);
        c3[0] = mkcand(T0[14], T1[0], 224u); c3[1] = mkcand(T0[15], T1[0], 240u);
#pragma unroll
        for (int i = 2; i < 16; ++i) c3[i] = NINF;
        top16_of_64(c0, c1, c2, c3);
        pad16(c0);
        float gsum = 0.f, ge[16]; int ex[16];
        const float mtop = embed(c0[0], 0xFFFFFF00u, 0u);
#pragma unroll
        for (int i = 0; i < 16; ++i) { const unsigned bits = __builtin_bit_cast(unsigned, c0[i]); const int a = (bits >> 4) & 15, b = bits & 15;
            ge[i] = __builtin_amdgcn_exp2f((embed(c0[i], 0xFFFFFF00u, 0u) - mtop) * LOG2E); gsum += ge[i];
            ex[i] = scr[a * 64 + lane] * 128 + scr[(16 + b) * 64 + lane]; }
        const float ginv = __builtin_amdgcn_rcpf(gsum);
        if (hi == 0) { GAS unsigned short* d = (GAS unsigned short*)P.EX + t * 128 + h * 16;
#pragma unroll
            for (int i = 0; i < 16; ++i) d[i] = (unsigned short)ex[i]; }
        else { GAS v4u* d = (GAS v4u*)((GAS bf16*)P.GW + t * 128 + h * 16);
#pragma unroll
            for (int i = 0; i < 2; ++i) d[i] = (v4u){cvtpk(ge[8 * i] * ginv, ge[8 * i + 1] * ginv), cvtpk(ge[8 * i + 2] * ginv, ge[8 * i + 3] * ginv), cvtpk(ge[8 * i + 4] * ginv, ge[8 * i + 5] * ginv), cvtpk(ge[8 * i + 6] * ginv, ge[8 * i + 7] * ginv)}; }
    }
}

__device__ __forceinline__ int wave_allsum_i(int v) {
    v += __builtin_amdgcn_update_dpp(0, v, 0xB1, 0xF, 0xF, true);
    v += __builtin_amdgcn_update_dpp(0, v, 0x4E, 0xF, 0xF, true);
    v += __builtin_amdgcn_update_dpp(0, v, 0x141, 0xF, 0xF, true);
    v += __builtin_amdgcn_update_dpp(0, v, 0x140, 0xF, 0xF, true);
    { int a = v, b = v; asm volatile("v_nop\n\tv_nop\n\tv_permlane16_swap_b32 %0, %1" : "+v"(a), "+v"(b)); v = a + b; }
    { int a = v, b = v; asm volatile("v_nop\n\tv_nop\n\tv_permlane32_swap_b32 %0, %1" : "+v"(a), "+v"(b)); v = a + b; }
    return v;
}
__device__ __forceinline__ float wave_allsum(float v) {
    v += __builtin_bit_cast(float, __builtin_amdgcn_update_dpp(0, __builtin_bit_cast(int, v), 0xB1, 0xF, 0xF, true));
    v += __builtin_bit_cast(float, __builtin_amdgcn_update_dpp(0, __builtin_bit_cast(int, v), 0x4E, 0xF, 0xF, true));
    v += __builtin_bit_cast(float, __builtin_amdgcn_update_dpp(0, __builtin_bit_cast(int, v), 0x141, 0xF, 0xF, true));
    v += __builtin_bit_cast(float, __builtin_amdgcn_update_dpp(0, __builtin_bit_cast(int, v), 0x140, 0xF, 0xF, true));
    { float a = v, b = v; asm volatile("v_nop\n\tv_nop\n\tv_permlane16_swap_b32 %0, %1" : "+v"(a), "+v"(b)); v = a + b; }
    { float a = v, b = v; asm volatile("v_nop\n\tv_nop\n\tv_permlane32_swap_b32 %0, %1" : "+v"(a), "+v"(b)); v = a + b; }
    return v;
}
__device__ __forceinline__ float wave_allmax(float v) {
    v = fmaxf(v, __builtin_bit_cast(float, __builtin_amdgcn_update_dpp(0, __builtin_bit_cast(int, v), 0xB1, 0xF, 0xF, true)));
    v = fmaxf(v, __builtin_bit_cast(float, __builtin_amdgcn_update_dpp(0, __builtin_bit_cast(int, v), 0x4E, 0xF, 0xF, true)));
    v = fmaxf(v, __builtin_bit_cast(float, __builtin_amdgcn_update_dpp(0, __builtin_bit_cast(int, v), 0x141, 0xF, 0xF, true)));
    v = fmaxf(v, __builtin_bit_cast(float, __builtin_amdgcn_update_dpp(0, __builtin_bit_cast(int, v), 0x140, 0xF, 0xF, true)));
    { float a = v, b = v; asm volatile("v_nop\n\tv_nop\n\tv_permlane16_swap_b32 %0, %1" : "+v"(a), "+v"(b)); v = fmaxf(a, b); }
    { float a = v, b = v; asm volatile("v_nop\n\tv_nop\n\tv_permlane32_swap_b32 %0, %1" : "+v"(a), "+v"(b)); v = fmaxf(a, b); }
    return v;
}
__device__ __forceinline__ unsigned q4(float a, float b, float c, float d, int off) {
    const int ia = (int)__builtin_rintf(a) + off, ib = (int)__builtin_rintf(b) + off, ic = (int)__builtin_rintf(c) + off, id = (int)__builtin_rintf(d) + off;
    return (unsigned)(ia & 255) | ((unsigned)(ib & 255) << 8) | ((unsigned)(ic & 255) << 16) | ((unsigned)(id & 255) << 24);
}
__device__ __forceinline__ void quant_row(const GAS float* src, GAS unsigned* dst, GAS float* scale, int off, int lane) {
    const GAS f32x4* s = (const GAS f32x4*)src + 4 * lane; f32x4 v[4]; float m = 0.f;
#pragma unroll
    for (int i = 0; i < 4; ++i) { v[i] = s[i]; m = fmaxf(m, fmaxf(fmaxf(__builtin_fabsf(v[i].x), __builtin_fabsf(v[i].y)), fmaxf(__builtin_fabsf(v[i].z), __builtin_fabsf(v[i].w)))); }
    m = wave_allmax(m); const float inv = m > 0.f ? 127.f / m : 0.f;
    v4u w;
    w.x = q4(v[0].x * inv, v[0].y * inv, v[0].z * inv, v[0].w * inv, off); w.y = q4(v[1].x * inv, v[1].y * inv, v[1].z * inv, v[1].w * inv, off);
    w.z = q4(v[2].x * inv, v[2].y * inv, v[2].z * inv, v[2].w * inv, off); w.w = q4(v[3].x * inv, v[3].y * inv, v[3].z * inv, v[3].w * inv, off);
    *((GAS v4u*)dst + lane) = w;
    if (lane == 0) *scale = m * (1.f / 127.f);
}
struct PeerS { int nslices_step, first_slice, nloc, rank; };
__device__ __forceinline__ PeerS peer_sched(const GAS unsigned* rankw, int xcc, int rank) {
    const int lane = lane_id_v();
    const int c = lane < 16 ? (int)__hip_atomic_load(rankw + 64 * lane, __ATOMIC_RELAXED, __HIP_MEMORY_SCOPE_AGENT) : 0;
    const unsigned long long m = __builtin_amdgcn_ballot_w64(c > 0);
    const int nx = __builtin_popcountll(m), myidx = __builtin_popcountll(m & ((1ull << xcc) - 1ull));
    const int cm = __builtin_amdgcn_readlane(c, xcc);
    PeerS s; s.nslices_step = nx > 0 ? nx : 1; s.first_slice = myidx; s.nloc = cm > 0 ? cm : 1; s.rank = rank; return s;
}
struct Peer1P { const GAS unsigned GAS char* HQ; const GAS int* EX; const GAS unsigned GAS char* U8; GAS int* P; };
__device__ __forceinline__ void peer_k1(const Peer1P& Q, const PeerS& sc, int wave, int lane) {
    asm volatile("" : "+v"(lane));
    const int g = lane >> 3, j = lane & 7;
    const __amdgpu_buffer_rsrc_t rU = __builtin_amdgcn_make_buffer_rsrc((void*)Q.U8, 0, 0x7fffffff, 0x00020000);
    for (int s = sc.first_slice; s < 8; s += sc.nslices_step)
        for (int tile = sc.rank; tile < T / 64; tile += sc.nloc) {
            const int soff_ = __builtin_amdgcn_readfirstlane(128 * s);
            const size_t t0 = (size_t)tile * 64 + wave * 8;
            v4u hqn = *(const GAS v4u*)(Q.HQ + t0 * 1024 + 128 * s + 16 * j), exn[2];
#pragma unroll
            for (int i = 0; i < 2; ++i) exn[i] = *(const GAS v4u*)(Q.EX + t0 * 64 + 8 * g + 4 * i);
#pragma unroll 1
            for (int k = 0; k < 8; ++k) {
                const size_t t = t0 + k;
                const v4u hq = hqn; v4u ex[2];
#pragma unroll
                for (int i = 0; i < 2; ++i) ex[i] = exn[i];
                if (k + 1 < 8) {
                    hqn = *(const GAS v4u*)(Q.HQ + (t + 1) * 1024 + 128 * s + 16 * j);
#pragma unroll
                    for (int i = 0; i < 2; ++i) exn[i] = *(const GAS v4u*)(Q.EX + (t + 1) * 64 + 8 * g + 4 * i);
                }
                v4u uu[16];
#pragma unroll
                for (int i = 0; i < 16; ++i) { const unsigned ew = ((i >> 1) & 3) == 0 ? ex[i >> 3].x : ((i >> 1) & 3) == 1 ? ex[i >> 3].y : ((i >> 1) & 3) == 2 ? ex[i >> 3].z : ex[i >> 3].w; unsigned e; if (i & 1) asm("v_lshrrev_b32 %0, 16, %1" : "=v"(e) : "v"(ew)); else asm("v_and_b32 %0, 0xffff, %1" : "=v"(e) : "v"(ew));
                    uu[i] = __builtin_bit_cast(v4u, __builtin_amdgcn_raw_buffer_load_b128(rU, (int)((e << 10) + 16u * (unsigned)j), soff_, 0)); }
                int pd[16];
#pragma unroll
                for (int i = 0; i < 16; ++i) { int q_;
                    asm("v_dot4_i32_i8 %0, %1, %2, 0" : "=v"(q_) : "v"(uu[i].x), "v"(hq.x));
                    q_ = __builtin_amdgcn_sdot4((int)uu[i].y, (int)hq.y, q_, false); q_ = __builtin_amdgcn_sdot4((int)uu[i].z, (int)hq.z, q_, false); pd[i] = __builtin_amdgcn_sdot4((int)uu[i].w, (int)hq.w, q_, false); }
#pragma unroll
                for (int i = 0; i < 16; ++i) pd[i] += __builtin_amdgcn_update_dpp(0, pd[i], 0xB1, 0xF, 0xF, true);
#pragma unroll
                for (int i = 0; i < 16; ++i) pd[i] += __builtin_amdgcn_update_dpp(0, pd[i], 0x4E, 0xF, 0xF, true);
#pragma unroll
                for (int i = 0; i < 16; ++i) pd[i] += __builtin_amdgcn_update_dpp(0, pd[i], 0x141, 0xF, 0xF, true);
                int lo = 0, hi = 0;
#pragma unroll
                for (int i = 0; i < 8; ++i) { lo = (j == i) ? pd[i] : lo; hi = (j == i) ? pd[i + 8] : hi; }
                Q.P[(t * 8 + s) * 64 + 8 * g + j] = (int)__builtin_amdgcn_perm((unsigned)((hi + 32) >> 6), (unsigned)((lo + 32) >> 6), 0x05040100u);
            }
        }
}
__device__ __forceinline__ void peer_w(const GAS int* EX, const GAS float* GW, const GAS int* P, const GAS float* SH, const GAS float* SU, const GAS float* SV, GAS signed char* WQ, GAS float* WSC, int gw, int NGW, int lane,
                                       LAS unsigned char* lds, int tid) {
    asm volatile("" : "+v"(lane), "+v"(tid));
    LAS float* su_l = (LAS float*)lds; LAS float* sv_l = su_l + 16384;
#pragma unroll 4
    for (int i = tid; i < 4096; i += 512) { ((LAS f32x4*)su_l)[i] = ((const GAS f32x4*)SU)[i]; ((LAS f32x4*)sv_l)[i] = ((const GAS f32x4*)SV)[i]; }
    __syncthreads();
    for (int t = gw; t < T; t += NGW) {
        const float sh = SH[t];
#pragma unroll
        for (int q = 0; q < 2; ++q) { const size_t idx = (size_t)t * 128 + lane + 64 * q; const int e = (int)((const GAS unsigned short*)EX)[idx];
            const int slot_ = lane + 64 * q, pix_ = (slot_ >> 4) * 8 + (slot_ & 7), hsel_ = (slot_ >> 3) & 1;
            int pd = 0;
#pragma unroll
            for (int sl = 0; sl < 8; ++sl) { const int pw_ = P[((size_t)t * 8 + sl) * 64 + pix_]; pd += hsel_ ? (pw_ >> 16) : (int)(short)(pw_ & 0xffff); }
            const float w = __builtin_bit_cast(float, (unsigned)((const GAS bf16*)GW)[idx] << 16) * gelu_erf((float)pd * (64.f * sh * su_l[e])) * sv_l[e];
            float m = __builtin_fabsf(w);
            m = fmaxf(m, __builtin_bit_cast(float, __builtin_amdgcn_update_dpp(0, __builtin_bit_cast(int, m), 0xB1, 0xF, 0xF, true)));
            m = fmaxf(m, __builtin_bit_cast(float, __builtin_amdgcn_update_dpp(0, __builtin_bit_cast(int, m), 0x4E, 0xF, 0xF, true)));
            m = fmaxf(m, __builtin_bit_cast(float, __builtin_amdgcn_update_dpp(0, __builtin_bit_cast(int, m), 0x141, 0xF, 0xF, true)));
            m = fmaxf(m, __builtin_bit_cast(float, __builtin_amdgcn_update_dpp(0, __builtin_bit_cast(int, m), 0x140, 0xF, 0xF, true)));
            const float inv = m > 0.f ? 127.f / m : 0.f;
            const unsigned wb = (unsigned)((int)__builtin_rintf(w * inv)) & 255u;
            const unsigned b1 = (unsigned)__builtin_amdgcn_update_dpp(0, (int)wb, 0x55, 0xF, 0xF, true), b2 = (unsigned)__builtin_amdgcn_update_dpp(0, (int)wb, 0xAA, 0xF, 0xF, true), b3 = (unsigned)__builtin_amdgcn_update_dpp(0, (int)wb, 0xFF, 0xF, 0xF, true);
            if ((lane & 3) == 0) ((GAS unsigned*)WQ)[idx >> 2] = wb | (b1 << 8) | (b2 << 16) | (b3 << 24);
            if ((lane & 15) == 0) WSC[(size_t)t * 8 + (lane >> 4) + 4 * q] = m * (1.f / 127.f); }
    }
}
__device__ __forceinline__ void tr4x4(unsigned r0, unsigned r1, unsigned r2, unsigned r3, unsigned (&t)[4]) {
    const unsigned x0 = __builtin_amdgcn_perm(r1, r0, 0x05010400u), x1 = __builtin_amdgcn_perm(r1, r0, 0x07030602u), y0 = __builtin_amdgcn_perm(r3, r2, 0x05010400u), y1 = __builtin_amdgcn_perm(r3, r2, 0x07030602u);
    t[0] = __builtin_amdgcn_perm(y0, x0, 0x05040100u); t[1] = __builtin_amdgcn_perm(y0, x0, 0x07060302u); t[2] = __builtin_amdgcn_perm(y1, x1, 0x05040100u); t[3] = __builtin_amdgcn_perm(y1, x1, 0x07060302u);
}
struct Peer2P { const GAS int* EX; const GAS signed char* WQ; const GAS float* WSC; const GAS unsigned char* V8; GAS bf16* XB; GAS float* SSQ; };
__device__ __forceinline__ void peer_k2(const Peer2P& Q, const PeerS& sc, int wave, int lane) {
    asm volatile("" : "+v"(lane));
    const int g = lane >> 3, j = lane & 7, hf = lane >> 5, rp = (lane >> 4) & 1;
    const __amdgpu_buffer_rsrc_t rV = __builtin_amdgcn_make_buffer_rsrc((void*)Q.V8, 0, 0x7fffffff, 0x00020000);
    for (int s = sc.first_slice; s < 8; s += sc.nslices_step)
        for (int tile = sc.rank; tile < T / 64; tile += sc.nloc) {
            const int soff_ = __builtin_amdgcn_readfirstlane(128 * s);
            const size_t t0 = (size_t)tile * 64 + wave * 8;
            struct Small { v4u ex[2]; v4u wq; float sw; };
            v4u vA[16], vB[16]; v2u xA, xB;
            Small sC, sN, sF;
            auto ld_small = [&](size_t t, Small& o) {
#pragma unroll
                for (int i = 0; i < 2; ++i) o.ex[i] = *(const GAS v4u*)(Q.EX + t * 64 + 8 * g + 4 * i);
                o.wq = *(const GAS v4u*)(Q.WQ + t * 128 + 16 * g); o.sw = Q.WSC[t * 8 + g]; };
            auto issue = [&](v4u (&vv)[16], v2u& xold, const Small& sm, size_t t) {
                const v4u (&ex)[2] = sm.ex;
                xold = *(const GAS v2u*)(Q.XB + t * 1024 + 128 * s + 16 * j + 8 * hf + 4 * rp);
#pragma unroll
                for (int i = 0; i < 16; ++i) { const unsigned ew = ((i >> 1) & 3) == 0 ? ex[i >> 3].x : ((i >> 1) & 3) == 1 ? ex[i >> 3].y : ((i >> 1) & 3) == 2 ? ex[i >> 3].z : ex[i >> 3].w; unsigned e; if (i & 1) asm("v_lshrrev_b32 %0, 16, %1" : "=v"(e) : "v"(ew)); else asm("v_and_b32 %0, 0xffff, %1" : "=v"(e) : "v"(ew));
                    vv[i] = __builtin_bit_cast(v4u, __builtin_amdgcn_raw_buffer_load_b128(rV, (int)((e << 10) + 16u * (unsigned)j), soff_, 0)); }
            };
            auto reduce = [&](const v4u (&vv)[16], const v2u xold, const Small& sm, size_t t) {
                const v4u wq = sm.wq; const float sw = sm.sw;
                GAS v2u* xp = (GAS v2u*)(Q.XB + t * 1024 + 128 * s + 16 * j + 8 * hf + 4 * rp);
                int ai[16];
#pragma unroll
                for (int q4_ = 0; q4_ < 4; ++q4_) {
                    const unsigned wq4 = q4_ == 0 ? wq.x : q4_ == 1 ? wq.y : q4_ == 2 ? wq.z : wq.w;
#pragma unroll
                    for (int c = 0; c < 4; ++c) { unsigned tt[4];
                        const v4u &a0 = vv[4 * q4_], &a1 = vv[4 * q4_ + 1], &a2 = vv[4 * q4_ + 2], &a3 = vv[4 * q4_ + 3];
                        tr4x4(c == 0 ? a0.x : c == 1 ? a0.y : c == 2 ? a0.z : a0.w, c == 0 ? a1.x : c == 1 ? a1.y : c == 2 ? a1.z : a1.w, c == 0 ? a2.x : c == 1 ? a2.y : c == 2 ? a2.z : a2.w, c == 0 ? a3.x : c == 1 ? a3.y : c == 2 ? a3.z : a3.w, tt);
#pragma unroll
                        for (int b = 0; b < 4; ++b) {
                            if (q4_ == 0) asm("v_dot4_i32_i8 %0, %1, %2, 0" : "=v"(ai[4 * c + b]) : "v"(tt[b]), "v"(wq4));
                            else ai[4 * c + b] = __builtin_amdgcn_sdot4((int)tt[b], (int)wq4, ai[4 * c + b], false); } }
                }
                float acc[16];
#pragma unroll
                for (int i = 0; i < 16; ++i) acc[i] = (float)ai[i] * sw;
                float r8[8], r4[4];
#pragma unroll
                for (int m = 0; m < 8; ++m) r8[m] = 0.f;
                asm volatile("v_nop\n\tv_nop\n\tv_permlane32_swap_b32 %0, %8\n\tv_permlane32_swap_b32 %1, %9\n\tv_permlane32_swap_b32 %2, %10\n\tv_permlane32_swap_b32 %3, %11\n\tv_permlane32_swap_b32 %4, %12\n\tv_permlane32_swap_b32 %5, %13\n\tv_permlane32_swap_b32 %6, %14\n\tv_permlane32_swap_b32 %7, %15"
                             : "+v"(acc[0]), "+v"(acc[1]), "+v"(acc[2]), "+v"(acc[3]), "+v"(acc[4]), "+v"(acc[5]), "+v"(acc[6]), "+v"(acc[7]), "+v"(acc[8]), "+v"(acc[9]), "+v"(acc[10]), "+v"(acc[11]), "+v"(acc[12]), "+v"(acc[13]), "+v"(acc[14]), "+v"(acc[15]));
#pragma unroll
                for (int m = 0; m < 8; ++m) r8[m] = acc[m] + acc[m + 8];
                asm volatile("v_nop\n\tv_nop\n\tv_permlane16_swap_b32 %0, %4\n\tv_permlane16_swap_b32 %1, %5\n\tv_permlane16_swap_b32 %2, %6\n\tv_permlane16_swap_b32 %3, %7"
                             : "+v"(r8[0]), "+v"(r8[1]), "+v"(r8[2]), "+v"(r8[3]), "+v"(r8[4]), "+v"(r8[5]), "+v"(r8[6]), "+v"(r8[7]));
#pragma unroll
                for (int n = 0; n < 4; ++n) r4[n] = r8[n] + r8[n + 4];
#pragma unroll
                for (int n = 0; n < 4; ++n) r4[n] += __builtin_bit_cast(float, __builtin_amdgcn_update_dpp(0, __builtin_bit_cast(int, r4[n]), 0x128, 0xF, 0xF, true));
                v2u xw; xw.x = cvtpk(bflo(xold.x) + r4[0], bfhi(xold.x) + r4[1]); xw.y = cvtpk(bflo(xold.y) + r4[2], bfhi(xold.y) + r4[3]);
                float ss = 0.f;
                if ((lane & 8) == 0) { const float x0 = bflo(xw.x), x1 = bfhi(xw.x), x2 = bflo(xw.y), x3 = bfhi(xw.y); ss = (x0 * x0 + x1 * x1) + (x2 * x2 + x3 * x3); *xp = xw; }
                ss = wave_allsum(ss);
                if (Q.SSQ) { if (lane == 0) Q.SSQ[t * 16 + s] = ss; }
            };
            ld_small(t0, sC); ld_small(t0 + 1, sN);
            issue(vA, xA, sC, t0);
#pragma unroll 1
            for (int k = 0; k < 8; k += 2) {
                ld_small(t0 + (k + 2 < 8 ? k + 2 : 7), sF);
                issue(vB, xB, sN, t0 + k + 1);
                reduce(vA, xA, sC, t0 + k);
                if (k + 2 < 8) { ld_small(t0 + (k + 3 < 8 ? k + 3 : 7), sC); issue(vA, xA, sF, t0 + k + 2); }
                reduce(vB, xB, sN, t0 + k + 1);
                { const Small tmp = sC; sC = sF; sN = tmp; }
            }
        }
}

struct Args { const float* in[33]; float* out; unsigned char* ws; int ph_lo, ph_hi; };
struct Frame { LAS unsigned char* lds; volatile LAS unsigned* MISC; gu32* ctl; int tid, lane, wave, G, vcu, xcc, xrank; };

__device__ __forceinline__ void transpose_item(const float* W, int ldw, int nsrc0, bf16* WT, int ldt, int rdst0, LAS float* scr, int kb, int nb, int lane, float scale, const float* kgain) {
    const int k0 = 64 * kb, n0 = 32 * nb;
#pragma unroll 8
    for (int i = 0; i < 32; ++i) { const int kk = 2 * i + (lane >> 5); const float gsc = kgain ? kgain[k0 + kk] * scale : scale; scr[kk * 33 + (lane & 31)] = W[(size_t)(k0 + kk) * ldw + nsrc0 + n0 + (lane & 31)] * gsc; }
    LDS_WAIT(); asm volatile("" ::: "memory");
    const int c = lane & 7;
#pragma unroll
    for (int j = 0; j < 4; ++j) { const int n = (lane >> 3) + 8 * j; const LAS float* s = scr + (8 * c) * 33 + n;
        v4u o; o.x = pk2(s[0 * 33], s[1 * 33]); o.y = pk2(s[2 * 33], s[3 * 33]); o.z = pk2(s[4 * 33], s[5 * 33]); o.w = pk2(s[6 * 33], s[7 * 33]);
        *(GAS v4u*)(WT + (size_t)(rdst0 + n0 + n) * ldt + k0 + 8 * c) = o; }
    LDS_WAIT(); asm volatile("" ::: "memory");
}
__device__ __forceinline__ void zero_rect(bf16* base, int ld, int row0, int nrows, int col0, int ncols, int gtid, int gthreads) {
    const int vpr = ncols / 8;
    for (int i = gtid; i < nrows * vpr; i += gthreads) { const int r = i / vpr, c = i % vpr; *(GAS v4u*)(base + (size_t)(row0 + r) * ld + col0 + 8 * c) = (v4u){0u, 0u, 0u, 0u}; }
}

__device__ __forceinline__ void p0_prologue(Frame& F, const Args& a) {
    LAS float* scr = (LAS float*)(F.lds + RING_OFF + F.wave * 16384);
    const int gw = blockIdx.x * NWAVES + F.wave, NGW = F.G * NWAVES;
    const int gtid = blockIdx.x * (NWAVES * 64) + F.tid, gthreads = F.G * NWAVES * 64;
    unsigned char* ws = a.ws;
    x0_phase((const GAS float*)a.in[0], (GAS bf16*)(ws + WS_XNB), (GAS float*)(ws + WS_SSQ), gw, NGW, F.lane);
    constexpr int I_IN = 16 * (INW / 32), I_SQ = 16 * 32, I_CKV = 16 * 64, I_UQ = 3 * 12, I_UKV = 2 * 16, I_L = I_IN + 4 * I_SQ + I_CKV + I_UQ + I_UKV;
    for (int it = gw; it < L * I_L; it += NGW) {
        const int l = it / I_L; int r = it % I_L;
        if (r < I_IN) {
            const int kb = r / 67, nb = r % 67; int src, dst; float sc = 1.f;
            if (nb < 6) { src = 32 * nb; dst = src; } else if (nb < 11) { src = 32 * nb; dst = src + 64; } else { src = 32 * nb; dst = src + 160; if (nb >= 43 && nb < 51) sc = 0.17677669529663687f * LOG2E; }
            transpose_item(a.in[5] + (size_t)l * D * INW, INW, src, (bf16*)(ws + WS_WIN) + (size_t)l * INP * D, D, dst, scr, kb, 0, F.lane, sc, a.in[4] + l * D); continue; } r -= I_IN;
        if (r < I_SQ) { transpose_item(a.in[21] + (size_t)l * D * D, D, 0, (bf16*)(ws + WS_WOUT) + (size_t)l * D * D, D, 0, scr, r / 32, r % 32, F.lane, 1.f, nullptr); continue; } r -= I_SQ;
        if (r < I_SQ) { transpose_item(a.in[24] + (size_t)l * D * D, D, 0, (bf16*)(ws + WS_WCQ) + (size_t)l * D * D, D, 0, scr, r / 32, r % 32, F.lane, 0.0625f * LOG2E, a.in[22] + l * D); continue; } r -= I_SQ;
        if (r < I_SQ) { transpose_item(a.in[26] + (size_t)l * D * D, D, 0, (bf16*)(ws + WS_WCO) + (size_t)l * D * D, D, 0, scr, r / 32, r % 32, F.lane, 1.f, nullptr); continue; } r -= I_SQ;
        if (r < I_SQ) { transpose_item(a.in[28] + (size_t)l * D * D, D, 0, (bf16*)(ws + WS_WPQ) + (size_t)l * D * D, D, 0, scr, r / 32, r % 32, F.lane, 1.f, a.in[27] + l * D); continue; } r -= I_SQ;
        if (r < I_CKV) { transpose_item(a.in[25] + (size_t)l * D * 2 * D, 2 * D, 0, (bf16*)(ws + WS_WCKV) + (size_t)l * 2 * D * D, D, 0, scr, r / 64, r % 64, F.lane, 1.f, nullptr); continue; } r -= I_CKV;
        if (r < I_UQ) { transpose_item(a.in[7] + (size_t)l * 192 * 384, 384, 0, (bf16*)(ws + WS_WUQ) + (size_t)l * 512 * 256, 256, 0, scr, r / 12, r % 12, F.lane, 0.10206207261596575f * LOG2E, a.in[6] + l * 192); continue; } r -= I_UQ;
        transpose_item(a.in[9] + (size_t)l * 128 * 512, 512, 0, (bf16*)(ws + WS_WUKV) + (size_t)l * 512 * 256, 256, 0, scr, r / 16, r % 16, F.lane, 1.f, a.in[8] + l * 128);
    }
    for (int l = 0; l < L; ++l) {
        bf16* win = (bf16*)(ws + WS_WIN) + (size_t)l * INP * D; bf16* wuq = (bf16*)(ws + WS_WUQ) + (size_t)l * 512 * 256; bf16* wukv = (bf16*)(ws + WS_WUKV) + (size_t)l * 512 * 256;
        zero_rect(win, D, 192, 64, 0, D, gtid, gthreads); zero_rect(win, D, 416, 96, 0, D, gtid, gthreads);
        zero_rect(wuq, 256, 0, 384, 192, 64, gtid, gthreads); zero_rect(wuq, 256, 384, 128, 0, 256, gtid, gthreads);
        zero_rect(wukv, 256, 0, 512, 128, 128, gtid, gthreads);
    }
    { float* rope = (float*)(ws + WS_ROPE); const int* pos = (const int*)a.in[2];
      for (int i = gtid; i < T * 16; i += gthreads) { const int t = i >> 4, k = i & 15; const float inv = powf(10000.f, -(float)(2 * k) / 32.f); const float ang = (float)pos[t] * inv;
          rope[(size_t)t * 32 + k] = cosf(ang); rope[(size_t)t * 32 + 16 + k] = sinf(ang); } }
    { const GAS f32x4* ks = (const GAS f32x4*)a.in[29]; GAS v2u* kd = (GAS v2u*)(ws + WS_KEYS);
      for (int i = gtid; i < L * 2 * 128 * 64 / 4; i += gthreads) { const f32x4 v = ks[i]; v2u w; w.x = pk2(v.x, v.y); w.y = pk2(v.z, v.w); kd[i] = w; }
    }
    for (int r = gw; r < 2 * L * 16384; r += NGW) { const int tb = r / (L * 16384), rr = r % (L * 16384);
        quant_row((const GAS float*)a.in[30 + tb] + (size_t)rr * 1024, (GAS unsigned*)(ws + (tb ? WS_V8 : WS_U8) + (size_t)rr * 1024), (GAS float*)(ws + (tb ? WS_SV : WS_SU)) + rr, 0, F.lane); }
    { float* btab = (float*)(ws + WS_BTAB); float* lams = (float*)(ws + WS_LAMS); float* spt = (float*)(ws + WS_SP);
      for (int i = gtid; i < 4 * 129; i += gthreads) { const int h = i / 129, n = i % 129; int bu; if (n < 16) bu = n; else { const int lg = 16 + (int)(logf((float)n / 16.f) / logf(8.f) * 16.f); bu = lg < 31 ? lg : 31; }
          btab[i] = a.in[3][bu * 4 + h] * LOG2E; }
      for (int i = gtid; i < L; i += gthreads) { const float* dl = a.in[17] + i * 128; float s1 = 0.f, s2 = 0.f; for (int j = 0; j < 32; ++j) { s1 += dl[j] * dl[32 + j]; s2 += dl[64 + j] * dl[96 + j]; }
          const float li = 0.8f - 0.6f * expf(-0.3f * (float)i); lams[2 * i] = expf(s1) - expf(s2) + li; lams[2 * i + 1] = li; }
      for (int i = gtid; i < L * 512; i += gthreads) spt[i] = log1pf(expf(-a.in[16][i])); }
    { GAS bf16* wat = (GAS bf16*)(ws + WS_WAT);
      for (int i = gtid; i < L * 8 * 2 * 4096; i += gthreads) { const int in_ = i & 63, out_ = (i >> 6) & 63, gate = (i >> 12) & 1, lg = i >> 13;
          wat[i] = (bf16)f2bf_(a.in[gate ? 14 : 12][(size_t)lg * 4096 + in_ * 64 + out_]); } }
    for (int l = 0; l < L; ++l) norm_phase((const GAS float*)a.in[1], (const GAS float*)a.in[23] + l * D, (GAS bf16*)(ws + WS_MNB) + (size_t)l * NB * MEM * D, NB * MEM, gw, NGW, F.lane);
}

constexpr int NPL = 16, PH_FINAL = 2 + NPL * L;
__global__ void __launch_bounds__(NWAVES * 64, 2) fwd(Args args) {
    extern __shared__ __attribute__((aligned(16))) unsigned char lds[];
    Frame F;
    F.lds = (LAS unsigned char*)lds; F.MISC = (volatile LAS unsigned*)(F.lds + MISC_OFF);
    F.tid = threadIdx.x; F.lane = F.tid & 63; F.wave = __builtin_amdgcn_readfirstlane(F.tid >> 6); F.G = gridDim.x;
    F.vcu = (F.G % 8 == 0) ? ((int)blockIdx.x % 8) * (F.G / 8) + (int)blockIdx.x / 8 : (int)blockIdx.x;
    unsigned char* ws = args.ws;
    F.ctl = (gu32*)(opq(ws) + WS_CTL);
    for (int u = F.tid; u < (LDS_BYTES - LDSCTL_OFF) / 4; u += NWAVES * 64) ((LAS unsigned*)(F.lds + LDSCTL_OFF))[u] = 0u;
    __syncthreads();
    XcdBarrier bar = xcd_barrier_post((unsigned*)(F.ctl + CW_BAR), F.MISC + 8);
    F.xcc = (int)bar.x;
    if (F.tid == 0) F.MISC[12] = __hip_atomic_fetch_add((unsigned*)(F.ctl + CW_RANK) + 64 * bar.x, 1u, __ATOMIC_RELAXED, __HIP_MEMORY_SCOPE_AGENT);
    __syncthreads();
    F.xrank = __builtin_amdgcn_readfirstlane((int)F.MISC[12]);
    const int lo = args.ph_lo, hi = args.ph_hi;
    const int gw = blockIdx.x * NWAVES + F.wave, NGW = F.G * NWAVES;
#define IN(k) (lo <= (k) && (k) < hi)
#define LANE_ (lane_id_v())
#define TID_ ((opqi(F.wave) << 6) | LANE_)
#define SITE() const int G_ = opqi(F.G), wv_ = opqi(F.wave), vcu_ = opqi(F.vcu), gw_ = opqi(gw), NGW_ = opqi(NGW); (void)G_; (void)wv_; (void)vcu_; (void)gw_; (void)NGW_
#if MK_DUP == 99
#define SEAM(k) do { if (IN(k) && IN((k) + 1)) { xcd_barrier(bar, (F.wave == 0 && lane_id_v() == 0) ? 1 : 0); xcd_barrier(bar, (F.wave == 0 && lane_id_v() == 0) ? 1 : 0); } } while (0)
#else
#define SEAM(k) do { if (IN(k) && IN((k) + 1)) xcd_barrier(bar, (F.wave == 0 && lane_id_v() == 0) ? 1 : 0); } while (0)
#endif
#define GEMM_SITE(EPI, Aptr, lda_, Bptr, ldb_, M_, N_, K_, cperm, ...) do { \
        pg8::Gemm g{opq(Aptr), opq(Bptr), M_, N_, K_, lda_, ldb_}; pg8::StaticOrder So; So.init(M_, N_, opqi(F.G), opqi(cperm)); pg8::EPI E{__VA_ARGS__}; \
        pg8::gemm_phase<pg8::EPI, pg8::StaticOrder, true, true>(F.lds + RING_OFF, g, So, E, opqi(F.wave)); } while (0)
    if (IN(0)) { p0_prologue(F, args); }
    SEAM(0);
    if (IN(1)) {
#pragma unroll 1
        for (int l = 0; l < L; ++l)
            GEMM_SITE(EpiBf16, (const GAS bf16*)(opq(ws) + WS_MNB) + (size_t)l * NB * MEM * D, D, (const GAS bf16*)(opq(ws) + WS_WCKV) + (size_t)l * 2 * D * D, D, NB * MEM, 2 * D, D, (int)((blockIdx.x + 64 * l) % F.G),
                      opq((GAS bf16*)(opq(ws) + WS_KVCB) + (size_t)l * NB * MEM * 2 * D), 2 * D, 2 * D, (const GAS float*)nullptr, 0);
    }
    SEAM(1);
    for (int l = 0; l < L; ++l) {
        const int pb = 2 + NPL * l;
        const GAS bf16* XNB = (const GAS bf16*)(opq(ws) + WS_XNB); const GAS bf16* YB = (const GAS bf16*)(opq(ws) + WS_YB); GAS bf16* PROJB = (GAS bf16*)(opq(ws) + WS_PROJB);
        if (IN(pb + 1)) GEMM_SITE(EpiBf16, XNB, D, (const GAS bf16*)(opq(ws) + WS_WIN) + (size_t)l * INP * D, D, T, INP, D, (int)blockIdx.x, opq(PROJB), INP, INP, opq((const GAS float*)(opq(ws) + WS_SSQ)), 8);
#if MK_DUP == 1
        if (IN(pb + 1)) GEMM_SITE(EpiBf16, XNB, D, (const GAS bf16*)(opq(ws) + WS_WIN) + (size_t)l * INP * D, D, T, INP, D, (int)blockIdx.x, opq(PROJB), INP, INP, opq((const GAS float*)(opq(ws) + WS_SSQ)), 8);
#endif
        SEAM(pb + 1);
        if (IN(pb + 2)) {
            SITE();
            pre_phase(opq((const GAS bf16*)PROJB), opq((const GAS float*)(opq(ws) + WS_ROPE)), opq((GAS float*)(opq(ws) + WS_RS)), opq((GAS bf16*)(opq(ws) + WS_KMB)), gw_, NGW_, LANE_);
#if MK_DUP == 21
            pre_phase(opq((const GAS bf16*)PROJB), opq((const GAS float*)(opq(ws) + WS_ROPE)), opq((GAS float*)(opq(ws) + WS_RS)), opq((GAS bf16*)(opq(ws) + WS_KMB)), gw_, NGW_, LANE_);
#endif
            LruP LP{opq((const GAS bf16*)PROJB), (const GAS float*)args.in[opqi(10)] + l * 4 * 512, (const GAS float*)args.in[opqi(11)] + l * 512, opq((const GAS bf16*)(opq(ws) + WS_WAT)) + (size_t)l * 8 * 2 * 4096, (const GAS float*)args.in[opqi(13)] + l * 512, (const GAS float*)args.in[opqi(15)] + l * 512,
                    (const GAS float*)(opq(ws) + WS_SP) + l * 512, opq((GAS unsigned*)(opq(ws) + WS_HLB)), opq((GAS float*)(opq(ws) + WS_LSUM))};
            lru_phase(LP, F.lds, TID_, wv_, LANE_, vcu_, G_);
#if MK_DUP == 2
            lru_phase(LP, F.lds, TID_, wv_, LANE_, vcu_, G_);
#endif
        }
        SEAM(pb + 2);
        if (IN(pb + 3)) {
            GEMM_SITE(EpiUp, (const GAS bf16*)PROJB + PC_CQ, INP, (const GAS bf16*)(opq(ws) + WS_WUQ) + (size_t)l * 512 * 256, 256, T, 512, 256, (int)blockIdx.x,
                      opq((GAS bf16*)(opq(ws) + WS_QMB)), (GAS bf16*)nullptr, 384, 384, opq((const GAS float*)(opq(ws) + WS_RS)), 0, 0);
            GEMM_SITE(EpiUp, (const GAS bf16*)PROJB + PC_CKV, INP, (const GAS bf16*)(opq(ws) + WS_WUKV) + (size_t)l * 512 * 256, 256, T, 512, 256, (int)blockIdx.x,
                      opq((GAS bf16*)(opq(ws) + WS_KMB)), opq((GAS bf16*)(opq(ws) + WS_VMB)), 0, 512, opq((const GAS float*)(opq(ws) + WS_RS)), 1, 1);
#if MK_DUP == 3
            GEMM_SITE(EpiUp, (const GAS bf16*)PROJB + PC_CQ, INP, (const GAS bf16*)(opq(ws) + WS_WUQ) + (size_t)l * 512 * 256, 256, T, 512, 256, (int)blockIdx.x,
                      opq((GAS bf16*)(opq(ws) + WS_QMB)), (GAS bf16*)nullptr, 384, 384, opq((const GAS float*)(opq(ws) + WS_RS)), 0, 0);
            GEMM_SITE(EpiUp, (const GAS bf16*)PROJB + PC_CKV, INP, (const GAS bf16*)(opq(ws) + WS_WUKV) + (size_t)l * 512 * 256, 256, T, 512, 256, (int)blockIdx.x,
                      opq((GAS bf16*)(opq(ws) + WS_KMB)), opq((GAS bf16*)(opq(ws) + WS_VMB)), 0, 512, opq((const GAS float*)(opq(ws) + WS_RS)), 1, 1);
#endif
        }
        SEAM(pb + 3);
        if (IN(pb + 4)) {
            SITE();
            AttnP PM{opq((const GAS bf16*)(opq(ws) + WS_QMB)), opq((const GAS bf16*)(opq(ws) + WS_KMB)), opq((const GAS bf16*)(opq(ws) + WS_VMB)), 384, 384, 256, opq((GAS bf16*)(opq(ws) + WS_OMB)), 256, opq((const GAS float*)(opq(ws) + WS_ROPE)), nullptr, nullptr, nullptr, nullptr};
            AttnP PD{opq((const GAS bf16*)PROJB + PC_QD), opq((const GAS bf16*)PROJB + PC_KD), opq((const GAS bf16*)PROJB + PC_VD), INP, INP, INP, opq((GAS bf16*)(opq(ws) + WS_YB) + 768), 1024, nullptr,
                     (const GAS int*)args.in[opqi(2)], (const GAS float*)(opq(ws) + WS_BTAB), (const GAS float*)args.in[opqi(18)] + l * 64, (const GAS float*)(opq(ws) + WS_LAMS) + 2 * l};
            attn_phase(PM, PD, F.lds, TID_, wv_, LANE_, vcu_, G_);
#if MK_DUP == 4
            __syncthreads(); attn_phase(PM, PD, F.lds, TID_, wv_, LANE_, vcu_, G_);
#elif MK_DUP == 40 || MK_DUP == 41
            __syncthreads(); attn_phase(PM, PD, F.lds, TID_, wv_, LANE_, vcu_, G_, MK_DUP - 40);
#endif
        }
        SEAM(pb + 4);
        if (IN(pb + 5)) {
            SITE();
            PostP PP{opq((const GAS bf16*)(opq(ws) + WS_OMB)), opq((const GAS unsigned*)(opq(ws) + WS_HLB)), opq((const GAS float*)(opq(ws) + WS_LSUM)), opq((const GAS bf16*)PROJB), (const GAS float*)args.in[opqi(19)] + l * 256, (const GAS float*)args.in[opqi(20)] + l * 512, opq((GAS bf16*)(opq(ws) + WS_YB))};
            post_phase(PP, F.lds, TID_, wv_, LANE_, vcu_, G_);
#if MK_DUP == 5
            __syncthreads(); post_phase(PP, F.lds, TID_, wv_, LANE_, vcu_, G_);
#endif
        }
        SEAM(pb + 5);
        if (IN(pb + 6)) GEMM_SITE(EpiRes, YB, D, (const GAS bf16*)(opq(ws) + WS_WOUT) + (size_t)l * D * D, D, T, D, D, (int)blockIdx.x, opq((GAS bf16*)(opq(ws) + WS_XNB)), opq((GAS float*)(opq(ws) + WS_SSQ)));
#if MK_DUP == 6
        if (IN(pb + 6)) GEMM_SITE(EpiRes, YB, D, (const GAS bf16*)(opq(ws) + WS_WOUT) + (size_t)l * D * D, D, T, D, D, (int)blockIdx.x, opq((GAS bf16*)(opq(ws) + WS_HLB)), opq((GAS float*)(opq(ws) + WS_OMB)));
#endif
        SEAM(pb + 6);
        if (IN(pb + 8)) GEMM_SITE(EpiBf16, XNB, D, (const GAS bf16*)(opq(ws) + WS_WCQ) + (size_t)l * D * D, D, T, D, D, (int)blockIdx.x, opq(PROJB), D, D, opq((const GAS float*)(opq(ws) + WS_SSQ)), 16);
#if MK_DUP == 8
        if (IN(pb + 8)) GEMM_SITE(EpiBf16, XNB, D, (const GAS bf16*)(opq(ws) + WS_WCQ) + (size_t)l * D * D, D, T, D, D, (int)blockIdx.x, opq(PROJB), D, D, opq((const GAS float*)(opq(ws) + WS_SSQ)), 16);
#endif
        SEAM(pb + 8);
        if (IN(pb + 9)) {
            SITE();
            const GAS bf16* kv = (const GAS bf16*)(opq(ws) + WS_KVCB) + (size_t)l * NB * MEM * 2 * D;
            AttnP PC{opq((const GAS bf16*)PROJB), opq(kv), opq(kv + D), 1024, 2 * D, 2 * D, opq((GAS bf16*)(opq(ws) + WS_YB)), 1024, nullptr, nullptr, nullptr, nullptr, nullptr};
            cross_phase(PC, F.lds, TID_, wv_, LANE_, vcu_, G_);
#if MK_DUP == 9
            cross_phase(PC, F.lds, TID_, wv_, LANE_, vcu_, G_);
#endif
        }
        SEAM(pb + 9);
        if (IN(pb + 10)) GEMM_SITE(EpiRes, YB, D, (const GAS bf16*)(opq(ws) + WS_WCO) + (size_t)l * D * D, D, T, D, D, (int)blockIdx.x, opq((GAS bf16*)(opq(ws) + WS_XNB)), opq((GAS float*)(opq(ws) + WS_SSQ)));
        SEAM(pb + 10);
        if (IN(pb + 12)) { GEMM_SITE(EpiBf16, XNB, D, (const GAS bf16*)(opq(ws) + WS_WPQ) + (size_t)l * D * D, D, T, D, D, (int)blockIdx.x, opq(PROJB), D, D, opq((const GAS float*)(opq(ws) + WS_SSQ)), 16);
#if MK_DUP == 12
            hq_phase(opq(XNB), opq((const GAS float*)(opq(ws) + WS_SSQ)), (const GAS float*)args.in[opqi(27)] + l * D, opq((GAS unsigned char*)(opq(ws) + WS_HQ)), opq((GAS float*)(opq(ws) + WS_SH)), opq((GAS int*)(opq(ws) + WS_P)), gw_, NGW_, LANE_);
#endif
            }
        SEAM(pb + 12);
        if (IN(pb + 13)) {
            SITE();
            RouteP RP{opq((const GAS bf16*)PROJB), opq((const GAS bf16*)(opq(ws) + WS_KEYS) + (size_t)l * 2 * 128 * 64), opq((GAS int*)(opq(ws) + WS_EX)), opq((GAS float*)(opq(ws) + WS_GW))};
            route_phase(RP, F.lds, TID_, wv_, LANE_, vcu_, G_);
            hq_phase(opq(XNB), opq((const GAS float*)(opq(ws) + WS_SSQ)), (const GAS float*)args.in[opqi(27)] + l * D, opq((GAS unsigned char*)(opq(ws) + WS_HQ)), opq((GAS float*)(opq(ws) + WS_SH)), opq((GAS int*)(opq(ws) + WS_P)), gw_, NGW_, LANE_);
#if MK_DUP == 13
            route_phase(RP, F.lds, TID_, wv_, LANE_, vcu_, G_);
#endif
        }
        SEAM(pb + 13);
        if (IN(pb + 14)) {
            SITE();
            const PeerS ps = peer_sched((const GAS unsigned*)(F.ctl + CW_RANK), opqi(F.xcc), opqi(F.xrank));
            Peer1P Q1{opq((const GAS unsigned char*)(opq(ws) + WS_HQ)), opq((const GAS int*)(opq(ws) + WS_EX)), opq((const GAS unsigned char*)(opq(ws) + WS_U8) + (size_t)l * 16384 * 1024), opq((GAS int*)(opq(ws) + WS_PROJB))};
            peer_k1(Q1, ps, wv_, LANE_);
#if MK_DUP == 141
            { Peer1P Q1b = Q1; Q1b.P = (GAS int*)(opq(ws) + WS_HLB); peer_k1(Q1b, ps, wv_, LANE_); }
#endif
        }
        SEAM(pb + 14);
        if (IN(pb + 15)) {
            SITE();
            peer_w(opq((const GAS int*)(opq(ws) + WS_EX)), opq((const GAS float*)(opq(ws) + WS_GW)), opq((const GAS int*)(opq(ws) + WS_PROJB)), opq((const GAS float*)(opq(ws) + WS_SH)), opq((const GAS float*)(opq(ws) + WS_SU) + l * 16384), opq((const GAS float*)(opq(ws) + WS_SV) + l * 16384),
                   opq((GAS signed char*)(opq(ws) + WS_W)), opq((GAS float*)(opq(ws) + WS_WS)), gw_, NGW_, LANE_, F.lds, TID_);
#if MK_DUP == 150
            peer_w(opq((const GAS int*)(opq(ws) + WS_EX)), opq((const GAS float*)(opq(ws) + WS_GW)), opq((const GAS int*)(opq(ws) + WS_PROJB)), opq((const GAS float*)(opq(ws) + WS_SH)), opq((const GAS float*)(opq(ws) + WS_SU) + l * 16384), opq((const GAS float*)(opq(ws) + WS_SV) + l * 16384),
                   opq((GAS signed char*)(opq(ws) + WS_W)), opq((GAS float*)(opq(ws) + WS_WS)), gw_, NGW_, LANE_, F.lds, TID_);
#endif
            xcd_barrier(bar, (F.wave == 0 && lane_id_v() == 0) ? 1 : 0);
            const PeerS ps = peer_sched((const GAS unsigned*)(F.ctl + CW_RANK), opqi(F.xcc), opqi(F.xrank));
            Peer2P Q2{opq((const GAS int*)(opq(ws) + WS_EX)), opq((const GAS signed char*)(opq(ws) + WS_W)), opq((const GAS float*)(opq(ws) + WS_WS)), opq((const GAS unsigned char*)(opq(ws) + WS_V8) + (size_t)l * 16384 * 1024), opq((GAS bf16*)(opq(ws) + WS_XNB)), opq((GAS float*)(opq(ws) + WS_SSQ))};
            peer_k2(Q2, ps, wv_, LANE_);
#if MK_DUP == 151
            { Peer2P Q2b = Q2; Q2b.XB = (GAS bf16*)(opq(ws) + WS_HLB); Q2b.SSQ = (GAS float*)(opq(ws) + WS_OMB); peer_k2(Q2b, ps, wv_, LANE_); }
#endif
        }
        SEAM(pb + 15);
    }
    if (IN(PH_FINAL)) { SITE(); final_norm_phase(opq((const GAS bf16*)(opq(ws) + WS_XNB)), (GAS float*)args.out, (const GAS float*)args.in[opqi(32)], T, gw_, NGW_, LANE_); }
#undef IN
#undef SEAM
#undef GEMM_SITE
}
}
extern "C" void kernel_launch(void* const* d_in, const int* in_sizes, int n_in, void* d_out, int out_size, void* d_ws, size_t ws_size, hipStream_t stream) {
    (void)in_sizes; (void)out_size;
    static int grid = 0;
    if (grid == 0) {
        int dev = 0, cus = 0, per_cu = 0;
        if (n_in != 33 || ws_size < mk::WS_END) { fprintf(stderr, "kernel_launch: unexpected n_in %d / ws_size %zu\n", n_in, ws_size); grid = -1; return; }
        if (hipGetDevice(&dev) != hipSuccess || hipDeviceGetAttribute(&cus, hipDeviceAttributeMultiprocessorCount, dev) != hipSuccess) { grid = -1; return; }
        if (hipFuncSetAttribute((const void*)mk::fwd, hipFuncAttributeMaxDynamicSharedMemorySize, mk::LDS_BYTES) != hipSuccess) { fprintf(stderr, "kernel_launch: hipFuncSetAttribute failed\n"); grid = -1; return; }
        if (hipOccupancyMaxActiveBlocksPerMultiprocessor(&per_cu, (const void*)mk::fwd, mk::NWAVES * 64, mk::LDS_BYTES) != hipSuccess || per_cu < 1) fprintf(stderr, "kernel_launch: occupancy query says %d\n", per_cu);
        (void)hipGetLastError();
        grid = cus;
    }
    if (grid < 0) return;
    unsigned char* ws = (unsigned char*)d_ws;
    (void)hipMemsetAsync(ws + mk::WS_CTL, 0, mk::CTL_ZERO_BYTES, stream);
    mk::Args a{};
    for (int i = 0; i < 33; ++i) a.in[i] = (const float*)d_in[i];
    a.out = (float*)d_out; a.ws = ws;
    auto run = [&](int lo, int hi) { a.ph_lo = lo; a.ph_hi = hi; hipLaunchKernelGGL(mk::fwd, dim3(grid), dim3(mk::NWAVES * 64), mk::LDS_BYTES, stream, a); };
#if MK_ONE_LAUNCH
    run(0, mk::PH_FINAL + 1);
#else
    for (int p = 0; p <= mk::PH_FINAL; ++p) {
        const int k = (p - 2) % mk::NPL, l = (p - 2) / mk::NPL;
#if MK_NAIVE_PEER == 2
        if (p >= 2 && p < mk::PH_FINAL && k == 14) {
            hipLaunchKernelGGL(k_peer, dim3(T), dim3(256), 0, stream, (const bf16_t*)(ws + mk::WS_XNB), (const int*)(ws + mk::WS_EX), (const float*)(ws + mk::WS_GW), (const float*)d_in[30] + (size_t)l * NEXP * D, (const float*)d_in[31] + (size_t)l * NEXP * D, (float*)d_out);
            continue; }
#elif MK_NAIVE_PEER == 1
        if (p >= 2 && p < mk::PH_FINAL && k == 13) {
            float* TQ = (float*)(ws + (size_t)806 * mk::MiB);
            hipLaunchKernelGGL(k_bf2f, dim3((unsigned)(((size_t)T * D + 255) / 256)), dim3(256), 0, stream, (const bf16_t*)(ws + mk::WS_PROJB), TQ, (long)T * D);
            hipLaunchKernelGGL(k_route, dim3(T), dim3(256), 0, stream, TQ, (const float*)d_in[29] + (size_t)l * 2 * 128 * 64, (int*)(ws + mk::WS_EX), (float*)(ws + mk::WS_GW));
            hipLaunchKernelGGL(k_peer, dim3(T), dim3(256), 0, stream, (const bf16_t*)(ws + mk::WS_XNB), (const int*)(ws + mk::WS_EX), (const float*)(ws + mk::WS_GW), (const float*)d_in[30] + (size_t)l * NEXP * D, (const float*)d_in[31] + (size_t)l * NEXP * D, (float*)d_out);
            continue; }
        if (p >= 2 && p < mk::PH_FINAL && k == 14) continue;
#endif
        run(p, p + 1); }
#endif
}
```

```cpp
#include <hip/hip_runtime.h>
#include <cstdint>
#include <cstdio>
#include <cmath>

#ifndef MK_ONE_LAUNCH
#define MK_ONE_LAUNCH 1
#endif
#ifndef MK_DUP
#define MK_DUP 0
#endif
#ifndef MK_NAIVE_PEER
#define MK_NAIVE_PEER 0
#endif
namespace pg8 {
#define PG8_LAS __attribute__((address_space(3)))
#ifndef GAS
#define GAS __attribute__((address_space(1)))
#endif
typedef unsigned short bf16_t;
typedef short bf16x8 __attribute__((ext_vector_type(8)));
typedef float f32x4 __attribute__((ext_vector_type(4)));
typedef unsigned u32x4 __attribute__((ext_vector_type(4)));
typedef unsigned u32x2 __attribute__((ext_vector_type(2)));
constexpr int BM = 256, BK = 64, HALF = 128, HTB = HALF * BK * 2, STAGE_BYTES = 8 * HTB, NXCD = 8, WGM = 8;
__host__ __device__ __forceinline__ int lds_byte(int r, int c) { const int st = (r >> 4) * 2 + (c >> 5), rr = r & 15, cc = c & 31, ob = rr * 64 + cc * 2; return st * 1024 + (ob ^ (((ob >> 9) & 1) << 5)); }
__host__ __device__ __forceinline__ void stage_rc(int b, int& R, int& C) { const int st = b / 1024, sb = b % 1024, swz = sb ^ (((sb >> 9) & 1) << 5); R = (st >> 1) * 16 + swz / 64; C = (st & 1) * 32 + (swz % 64) / 2; }
__host__ __device__ __forceinline__ int perm32(int rho) { const int n = rho >> 4, i = rho & 15; return 8 * (i >> 2) + 4 * n + (i & 3); }
__device__ __forceinline__ int pg8_lane_id() { int l; asm volatile("v_mbcnt_lo_u32_b32 %0, -1, 0\n\tv_mbcnt_hi_u32_b32 %0, -1, %0" : "=v"(l)); return l; }
struct Unit { int pm, pn; };
struct Gemm { const GAS bf16_t* A; const GAS bf16_t* Bt; int M, N, K, lda, ldb; };
struct StaticOrder {
    int nM, nN, nwg, G, c;
    __host__ __device__ void init(int M, int N, int G_, int c_) { nM = M / BM; nN = N / BM; nwg = nM * nN; G = G_; c = c_; }
    __host__ __device__ bool next(int i, Unit& u) const {
        const long L = (long)i * G + c; if (L >= nwg) return false;
        int wgid = (int)L; { const int q = nwg / NXCD, r = nwg % NXCD, xcd = wgid % NXCD, off = wgid / NXCD; wgid = (xcd < r ? xcd * (q + 1) : r * (q + 1) + (xcd - r) * q) + off; }
        const int nig = WGM * nN, gid = wgid / nig, fm = gid * WGM, gsz = (nM - fm) < WGM ? (nM - fm) : WGM;
        u.pm = fm + ((wgid % nig) % gsz); u.pn = (wgid % nig) / gsz; return true;
    }
    __device__ __forceinline__ void a_ready(const Unit&) const {}
    __device__ __forceinline__ void done(const Unit&) const {}
};
__device__ __forceinline__ unsigned cvt_pk_bf16(float lo, float hi) { unsigned r; asm volatile("v_cvt_pk_bf16_f32 %0, %1, %2" : "=v"(r) : "v"(lo), "v"(hi)); return r; }

struct EpiF32 {
    static constexpr bool PERM = false, AFTER_DRAIN = false;
    GAS float* C; int ldc; int nvalid; int accum;
    __device__ __forceinline__ void operator()(const f32x4 (&acc)[2][2][4][2], const Unit& u, int wr, int wc, int fr, int fq) const {
        { const int l_ = pg8_lane_id(); fr = l_ & 15; fq = l_ >> 4; }
#pragma unroll
        for (int ai = 0; ai < 2; ++ai)
#pragma unroll
            for (int m = 0; m < 4; ++m) { const size_t row = (size_t)u.pm * BM + ai * HALF + wr * 64 + m * 16 + fr;
#pragma unroll
                for (int bj = 0; bj < 2; ++bj)
#pragma unroll
                    for (int n = 0; n < 2; ++n) { const int col = u.pn * BM + bj * HALF + wc * 32 + n * 16 + 4 * fq;
                        if (col < nvalid) { GAS float* p = C + row * ldc + col; f32x4 v = acc[ai][bj][m][n]; if (accum) v += *(const GAS f32x4*)p; *(GAS f32x4*)p = v; } } }
    }
};
struct EpiBf16 {
    static constexpr bool PERM = true, AFTER_DRAIN = false;
    GAS bf16_t* O; int ldc; int nvalid; const GAS float* ssq; int np;
    __device__ __forceinline__ void operator()(const f32x4 (&acc)[2][2][4][2], const Unit& u, int wr, int wc, int fr, int fq) const {
        { const int l_ = pg8_lane_id(); fr = l_ & 15; fq = l_ >> 4; }
        float rsv[2][4];
        if (np > 0) { f32x4 pv[2][4];
#pragma unroll
            for (int ai = 0; ai < 2; ++ai)
#pragma unroll
                for (int m = 0; m < 4; ++m) { const size_t row = (size_t)u.pm * BM + ai * HALF + wr * 64 + m * 16 + fr; pv[ai][m] = f32x4{0.f, 0.f, 0.f, 0.f}; if (4 * fq < np) pv[ai][m] = ((const GAS f32x4*)(ssq + row * 16))[fq]; }
#pragma unroll
            for (int ai = 0; ai < 2; ++ai)
#pragma unroll
                for (int m = 0; m < 4; ++m) { float t = (pv[ai][m][0] + pv[ai][m][1]) + (pv[ai][m][2] + pv[ai][m][3]);
                    { float a = t, b = t; asm volatile("v_nop\n\tv_nop\n\tv_permlane16_swap_b32 %0, %1" : "+v"(a), "+v"(b)); t = a + b; }
                    { float a = t, b = t; asm volatile("v_nop\n\tv_nop\n\tv_permlane32_swap_b32 %0, %1" : "+v"(a), "+v"(b)); t = a + b; }
                    rsv[ai][m] = __builtin_amdgcn_rsqf(t * (1.f / 1024.f) + 1e-6f); } }
        else {
#pragma unroll
            for (int ai = 0; ai < 2; ++ai)
#pragma unroll
                for (int m = 0; m < 4; ++m) rsv[ai][m] = 1.f; }
#pragma unroll
        for (int ai = 0; ai < 2; ++ai)
#pragma unroll
            for (int m = 0; m < 4; ++m) { const size_t row = (size_t)u.pm * BM + ai * HALF + wr * 64 + m * 16 + fr;
                const float rs_ = rsv[ai][m];
#pragma unroll
                for (int bj = 0; bj < 2; ++bj) { const int col = u.pn * BM + bj * HALF + wc * 32 + 8 * fq;
                    if (col < nvalid) { const f32x4 v0 = acc[ai][bj][m][0] * rs_, v1 = acc[ai][bj][m][1] * rs_; u32x4 w; w.x = cvt_pk_bf16(v0[0], v0[1]); w.y = cvt_pk_bf16(v0[2], v0[3]); w.z = cvt_pk_bf16(v1[0], v1[1]); w.w = cvt_pk_bf16(v1[2], v1[3]);
                        *(GAS u32x4*)(O + row * ldc + col) = w; } } }
    }
};
struct EpiUp {
    static constexpr bool PERM = true, AFTER_DRAIN = false;
    GAS bf16_t* O; GAS bf16_t* O2; int ldc; int nvalid; const GAS float* rs; int rsi; int mode;
    __device__ __forceinline__ void operator()(const f32x4 (&acc)[2][2][4][2], const Unit& u, int wr, int wc, int fr, int fq) const {
        { const int l_ = pg8_lane_id(); fr = l_ & 15; fq = l_ >> 4; }
        float sv[2][4];
#pragma unroll
        for (int ai = 0; ai < 2; ++ai)
#pragma unroll
            for (int m = 0; m < 4; ++m) { const size_t row = (size_t)u.pm * BM + ai * HALF + wr * 64 + m * 16 + fr; sv[ai][m] = rs[2 * row + rsi]; }
#pragma unroll
        for (int ai = 0; ai < 2; ++ai)
#pragma unroll
            for (int m = 0; m < 4; ++m) { const size_t row = (size_t)u.pm * BM + ai * HALF + wr * 64 + m * 16 + fr; const float s = sv[ai][m];
#pragma unroll
                for (int bj = 0; bj < 2; ++bj) { const int col = u.pn * BM + bj * HALF + wc * 32 + 8 * fq;
                    if (col < nvalid) { const f32x4 v0 = acc[ai][bj][m][0] * s, v1 = acc[ai][bj][m][1] * s; u32x4 w; w.x = cvt_pk_bf16(v0[0], v0[1]); w.y = cvt_pk_bf16(v0[2], v0[3]); w.z = cvt_pk_bf16(v1[0], v1[1]); w.w = cvt_pk_bf16(v1[2], v1[3]);
                        GAS bf16_t* dst;
                        if (mode == 0) dst = O + row * ldc + col;
                        else { const int h = col >> 7, j = col & 127; dst = (j < 64) ? O + row * 384 + h * 96 + j : O2 + row * 256 + h * 64 + (j - 64); }
                        *(GAS u32x4*)dst = w; } } }
    }
};

struct EpiRes {
    static constexpr bool PERM = true, AFTER_DRAIN = false;
    GAS bf16_t* XB; GAS float* SSQ;
    __device__ __forceinline__ void operator()(const f32x4 (&acc)[2][2][4][2], const Unit& u, int wr, int wc, int fr, int fq) const {
        { const int l_ = pg8_lane_id(); fr = l_ & 15; fq = l_ >> 4; }
#pragma unroll
        for (int ai = 0; ai < 2; ++ai) {
            u32x4 ov[4][2];
#pragma unroll
            for (int m = 0; m < 4; ++m) { const size_t row = (size_t)u.pm * BM + ai * HALF + wr * 64 + m * 16 + fr;
#pragma unroll
                for (int bj = 0; bj < 2; ++bj) ov[m][bj] = *(const GAS u32x4*)(XB + row * 1024 + u.pn * BM + bj * HALF + wc * 32 + 8 * fq); }
#pragma unroll
            for (int m = 0; m < 4; ++m) { const size_t row = (size_t)u.pm * BM + ai * HALF + wr * 64 + m * 16 + fr; float ss = 0.f;
#pragma unroll
                for (int bj = 0; bj < 2; ++bj) { GAS u32x4* p = (GAS u32x4*)(XB + row * 1024 + u.pn * BM + bj * HALF + wc * 32 + 8 * fq);
                    const u32x4 o = ov[m][bj]; const f32x4 v0 = acc[ai][bj][m][0], v1 = acc[ai][bj][m][1];
                    u32x4 w;
                    w.x = cvt_pk_bf16(__builtin_bit_cast(float, o.x << 16) + v0[0], __builtin_bit_cast(float, o.x & 0xffff0000u) + v0[1]);
                    w.y = cvt_pk_bf16(__builtin_bit_cast(float, o.y << 16) + v0[2], __builtin_bit_cast(float, o.y & 0xffff0000u) + v0[3]);
                    w.z = cvt_pk_bf16(__builtin_bit_cast(float, o.z << 16) + v1[0], __builtin_bit_cast(float, o.z & 0xffff0000u) + v1[1]);
                    w.w = cvt_pk_bf16(__builtin_bit_cast(float, o.w << 16) + v1[2], __builtin_bit_cast(float, o.w & 0xffff0000u) + v1[3]);
                    *p = w;
#pragma unroll
                    for (int e = 0; e < 4; ++e) { const float a = __builtin_bit_cast(float, w[e] << 16), b = __builtin_bit_cast(float, w[e] & 0xffff0000u); ss += a * a + b * b; } }
                { float a = ss, b = ss; asm volatile("v_nop\n\tv_nop\n\tv_permlane16_swap_b32 %0, %1" : "+v"(a), "+v"(b)); ss = a + b; }
                { float a = ss, b = ss; asm volatile("v_nop\n\tv_nop\n\tv_permlane32_swap_b32 %0, %1" : "+v"(a), "+v"(b)); ss = a + b; }
                if (fq == 0) SSQ[row * 16 + 4 * u.pn + wc] = ss; } }
    }
};
template <class Epi, class Sched, bool ALIGN_EPI = false, bool SP2 = false>
__device__ __forceinline__ void gemm_phase(PG8_LAS unsigned char* lds, const Gemm g, const Sched& S, const Epi& E, int wave_id) {
    int tid_ = (wave_id << 6) | pg8_lane_id(); asm volatile("" : "+v"(tid_));
    const int tid = tid_, wid = __builtin_amdgcn_readfirstlane(tid >> 6), lane = tid & 63, wr = wid >> 2, wc = wid & 3, fr = lane & 15, fq = lane >> 4;
    const int K = g.K, nt = K / BK;
    unsigned voffA[2], voffB[2];
#pragma unroll
    for (int i = 0; i < 2; ++i) { int R, C; stage_rc(tid * 16 + i * 8192, R, C); const int Rb = Epi::PERM ? ((R & ~31) + perm32(R & 31)) : R;
        voffA[i] = (unsigned)(R * g.lda + C) * 2u; voffB[i] = (unsigned)(Rb * g.ldb + C) * 2u; }
    const size_t kstep = (size_t)(BK * 2);
    const size_t hstepA = (size_t)HALF * g.lda * 2, hstepB = (size_t)HALF * g.ldb * 2;
    const size_t tstepA = 2 * hstepA, tstepB = 2 * hstepB;
    const unsigned ldsw = (unsigned)wid * 1024u;
    const int aoff = lds_byte(wr * 64 + fr, fq * 8), boff = lds_byte(wc * 32 + fr, fq * 8);
#define PG8_SA(b, h) (((b) * 2 + (h)) * HTB)
#define PG8_SB(b, h) ((4 + (b) * 2 + (h)) * HTB)
#define PG8_STAGE(bufoff, gbase, voff) do { _Pragma("unroll") for (int _i = 0; _i < 2; ++_i) \
        __builtin_amdgcn_global_load_lds((const unsigned*)((const char*)(gbase) + (voff)[_i]), (PG8_LAS unsigned*)(lds + (bufoff) + ldsw + _i * 8192), 16, 0, 0); } while (0)
#define PG8_LDA(dst, b, h) do { _Pragma("unroll") for (int m = 0; m < 4; ++m) _Pragma("unroll") for (int k = 0; k < 2; ++k) dst[m][k] = *(const PG8_LAS bf16x8*)(lds + PG8_SA(b, h) + aoff + m * 2048 + k * 1024); } while (0)
#define PG8_LDB(dst, b, h) do { _Pragma("unroll") for (int n = 0; n < 2; ++n) _Pragma("unroll") for (int k = 0; k < 2; ++k) dst[n][k] = *(const PG8_LAS bf16x8*)(lds + PG8_SB(b, h) + boff + n * 2048 + k * 1024); } while (0)
#define PG8_MMA(ai, bj, At, Bt) do { __builtin_amdgcn_s_setprio(1); _Pragma("unroll") for (int m = 0; m < 4; ++m) _Pragma("unroll") for (int n = 0; n < 2; ++n) _Pragma("unroll") for (int k = 0; k < 2; ++k) \
        acc[ai][bj][m][n] = __builtin_amdgcn_mfma_f32_16x16x32_bf16(Bt[n][k], At[m][k], acc[ai][bj][m][n], 0, 0, 0); __builtin_amdgcn_s_setprio(0); } while (0)
#define PG8_WAIT_V(n) asm volatile("s_waitcnt vmcnt(" #n ")" ::: "memory")
#define PG8_WAIT_L(n) asm volatile("s_waitcnt lgkmcnt(" #n ")" ::: "memory")
#define PG8_BAR __builtin_amdgcn_s_barrier()
#define PG8_SCHED __builtin_amdgcn_sched_barrier(0)
    Unit cur, nxt; int ui = 0;
    if (!S.next(0, cur)) return;
    f32x4 acc[2][2][4][2];
#pragma unroll
    for (int a = 0; a < 2; ++a)
#pragma unroll
        for (int b = 0; b < 2; ++b)
#pragma unroll
            for (int m = 0; m < 4; ++m)
#pragma unroll
                for (int n = 0; n < 2; ++n) acc[a][b][m][n] = (f32x4){0.f, 0.f, 0.f, 0.f};
    bf16x8 At[4][2], B0[2][2], B1[2][2];
    const char* cA = (const char*)g.A + (size_t)cur.pm * tstepA; const char* cB = (const char*)g.Bt + (size_t)cur.pn * tstepB;
    S.a_ready(cur);
    if constexpr (SP2) {
        PG8_STAGE(PG8_SB(0, 0), cB, voffB); PG8_STAGE(PG8_SB(0, 1), cB + hstepB, voffB); PG8_STAGE(PG8_SA(0, 0), cA, voffA); PG8_STAGE(PG8_SA(0, 1), cA + hstepA, voffA);
        if (wr == 1) PG8_BAR;
        PG8_WAIT_V(2); PG8_BAR;
        PG8_STAGE(PG8_SB(1, 0), cB + kstep, voffB); PG8_STAGE(PG8_SA(1, 0), cA + kstep, voffA); PG8_STAGE(PG8_SB(1, 1), cB + hstepB + kstep, voffB);
        PG8_WAIT_V(6); PG8_BAR;
    } else {
        PG8_STAGE(PG8_SB(0, 0), cB, voffB); PG8_STAGE(PG8_SA(0, 0), cA, voffA); PG8_STAGE(PG8_SB(0, 1), cB + hstepB, voffB); PG8_STAGE(PG8_SA(0, 1), cA + hstepA, voffA);
        if (wr == 1) PG8_BAR;
        PG8_WAIT_V(4); PG8_BAR;
        PG8_STAGE(PG8_SB(1, 0), cB + kstep, voffB); PG8_STAGE(PG8_SA(1, 0), cA + kstep, voffA); PG8_STAGE(PG8_SB(1, 1), cB + hstepB + kstep, voffB);
        PG8_WAIT_V(6); PG8_BAR;
    }
    for (;;) {
        const bool has_next = S.next(ui + 1, nxt);
        const char* nA = has_next ? (const char*)g.A + (size_t)nxt.pm * tstepA : cA; const char* nB = has_next ? (const char*)g.Bt + (size_t)nxt.pn * tstepB : cB;
        for (int t = 0; t < nt; t += 2) {
            const bool last = (t == nt - 2);
            const char* a1 = cA + (size_t)(t + 1) * kstep;
            const char* a2 = last ? nA : cA + (size_t)(t + 2) * kstep; const char* b2 = last ? nB : cB + (size_t)(t + 2) * kstep;
            const char* a3 = a2 + kstep; const char* b3 = b2 + kstep;
            if (last && has_next) S.a_ready(nxt);
            if constexpr (SP2) {
            PG8_LDB(B0, 0, 0); PG8_LDB(B1, 0, 1); PG8_SCHED; PG8_LDA(At, 0, 0); PG8_STAGE(PG8_SA(1, 1), a1 + hstepA, voffA);
            PG8_WAIT_V(8); PG8_WAIT_L(0); PG8_BAR; PG8_MMA(0, 0, At, B0); PG8_MMA(0, 1, At, B1); PG8_BAR; PG8_SCHED;
            PG8_LDA(At, 0, 1); PG8_STAGE(PG8_SB(0, 0), b2, voffB); PG8_STAGE(PG8_SB(0, 1), b2 + hstepB, voffB); PG8_STAGE(PG8_SA(0, 0), a2, voffA);
            PG8_WAIT_V(8); PG8_WAIT_L(0); PG8_BAR; PG8_MMA(1, 0, At, B0); PG8_MMA(1, 1, At, B1); PG8_BAR; PG8_SCHED;
            PG8_LDB(B0, 1, 0); PG8_LDB(B1, 1, 1); PG8_SCHED; PG8_LDA(At, 1, 0); PG8_STAGE(PG8_SA(0, 1), a2 + hstepA, voffA);
            PG8_WAIT_V(8); PG8_WAIT_L(0); PG8_BAR; PG8_MMA(0, 0, At, B0); PG8_MMA(0, 1, At, B1); PG8_BAR; PG8_SCHED;
            PG8_LDA(At, 1, 1); PG8_STAGE(PG8_SB(1, 0), b3, voffB); PG8_STAGE(PG8_SB(1, 1), b3 + hstepB, voffB); PG8_STAGE(PG8_SA(1, 0), a3, voffA);
            PG8_WAIT_V(8); PG8_WAIT_L(0); PG8_BAR; PG8_MMA(1, 0, At, B0); PG8_MMA(1, 1, At, B1); PG8_BAR; PG8_SCHED;
            } else {
            PG8_LDB(B0, 0, 0); PG8_SCHED; PG8_LDA(At, 0, 0); PG8_STAGE(PG8_SA(1, 1), a1 + hstepA, voffA);
            PG8_WAIT_L(8); PG8_BAR; PG8_WAIT_L(0); PG8_MMA(0, 0, At, B0); PG8_BAR; PG8_SCHED;
            PG8_LDB(B1, 0, 1); PG8_STAGE(PG8_SB(0, 0), b2, voffB);
            PG8_BAR; PG8_WAIT_L(0); PG8_MMA(0, 1, At, B1); PG8_BAR;
            PG8_LDA(At, 0, 1); PG8_STAGE(PG8_SA(0, 0), a2, voffA);
            PG8_BAR; PG8_WAIT_L(0); PG8_MMA(1, 0, At, B0); PG8_BAR; PG8_SCHED;
            PG8_STAGE(PG8_SB(0, 1), b2 + hstepB, voffB);
            PG8_WAIT_V(6); PG8_BAR; PG8_MMA(1, 1, At, B1); PG8_BAR;
            PG8_LDB(B0, 1, 0); PG8_SCHED; PG8_LDA(At, 1, 0); PG8_STAGE(PG8_SA(0, 1), a2 + hstepA, voffA);
            PG8_WAIT_L(8); PG8_BAR; PG8_WAIT_L(0); PG8_MMA(0, 0, At, B0); PG8_BAR; PG8_SCHED;
            PG8_LDB(B1, 1, 1); PG8_STAGE(PG8_SB(1, 0), b3, voffB);
            PG8_BAR; PG8_WAIT_L(0); PG8_MMA(0, 1, At, B1); PG8_BAR;
            PG8_LDA(At, 1, 1); PG8_STAGE(PG8_SA(1, 0), a3, voffA);
            PG8_BAR; PG8_WAIT_L(0); PG8_MMA(1, 0, At, B0); PG8_BAR; PG8_SCHED;
            PG8_STAGE(PG8_SB(1, 1), b3 + hstepB, voffB);
            PG8_WAIT_V(6); PG8_BAR; PG8_MMA(1, 1, At, B1); PG8_BAR;
            }
        }
        if constexpr (ALIGN_EPI) { if (wr == 0) PG8_BAR; }
        if constexpr (!Epi::AFTER_DRAIN) { E(acc, cur, wr, wc, fr, fq); S.done(cur); }
        if (!has_next) break;
#pragma unroll
        for (int a = 0; a < 2; ++a)
#pragma unroll
            for (int b = 0; b < 2; ++b)
#pragma unroll
                for (int m = 0; m < 4; ++m)
#pragma unroll
                    for (int n = 0; n < 2; ++n) acc[a][b][m][n] = (f32x4){0.f, 0.f, 0.f, 0.f};
        cur = nxt; cA = nA; cB = nB; ++ui;
        if constexpr (ALIGN_EPI) { if (wr == 1) PG8_BAR; }
    }
    PG8_WAIT_V(0);
    if constexpr (!ALIGN_EPI) { if (wr == 0) PG8_BAR; }
    PG8_BAR;
    if constexpr (Epi::AFTER_DRAIN) { E.fused(acc, cur, wr, wc, fr, fq, lds, wid, lane); S.done(cur); }
#undef PG8_SA
#undef PG8_SB
#undef PG8_STAGE
#undef PG8_LDA
#undef PG8_LDB
#undef PG8_MMA
#undef PG8_WAIT_V
#undef PG8_WAIT_L
#undef PG8_BAR
#undef PG8_SCHED
}
}

namespace mk {
#ifndef GAS
#define GAS __attribute__((address_space(1)))
#endif
#define LAS __attribute__((address_space(3)))
typedef unsigned short bf16;
typedef unsigned v4u __attribute__((ext_vector_type(4)));
typedef unsigned v2u __attribute__((ext_vector_type(2)));
typedef float f32x4 __attribute__((ext_vector_type(4)));
typedef GAS unsigned gu32;
#define LDS_WAIT() asm volatile("s_waitcnt lgkmcnt(0)" ::: "memory")
#define VM_WAIT() asm volatile("s_waitcnt vmcnt(0)" ::: "memory")
__device__ __forceinline__ unsigned f2bf_(float f) { unsigned u = __builtin_bit_cast(unsigned, f); return (u + 0x7fffu + ((u >> 16) & 1u)) >> 16; }
__device__ __forceinline__ unsigned pk2(float lo, float hi) { return f2bf_(lo) | (f2bf_(hi) << 16); }
__device__ __forceinline__ float bflo(unsigned w) { return __builtin_bit_cast(float, w << 16); }
__device__ __forceinline__ float bfhi(unsigned w) { return __builtin_bit_cast(float, w & 0xffff0000u); }

template <class P> __device__ __forceinline__ P* opq(P* p) { asm volatile("" : "+s"(p)); return p; }
__device__ __forceinline__ int opqi(int k) { asm volatile("" : "+s"(k)); return k; }
__device__ __forceinline__ float shx(float v, int o, int lane) { return __builtin_bit_cast(float, __builtin_amdgcn_ds_bpermute((lane ^ o) << 2, __builtin_bit_cast(int, v))); }
__device__ __forceinline__ int shxi(int v, int o, int lane) { return __builtin_amdgcn_ds_bpermute((lane ^ o) << 2, v); }
__device__ __forceinline__ int lane_id_v() { int l; asm volatile("v_mbcnt_lo_u32_b32 %0, -1, 0\n\tv_mbcnt_hi_u32_b32 %0, -1, %0" : "=v"(l)); return l; }
constexpr int NWAVES = 8;
constexpr int D = 1024, NB = 4, S = 8192, T = NB * S, L = 4, MEM = 256, INW = 2144, INP = 2304;
constexpr int PC_CQ = 0, PC_CKV = 256, PC_KR = 384, PC_XL = 512, PC_GL = 1024, PC_QD = 1536, PC_KD = 1792, PC_VD = 2048;
constexpr float LOG2E = 1.4426950408889634f;
constexpr size_t MiB = 1u << 20;
constexpr size_t WS_CTL = 0, CTL_ZERO_BYTES = 1 * MiB;
constexpr size_t WS_WIN = 1 * MiB, WS_WOUT = 19 * MiB, WS_WCQ = 27 * MiB, WS_WCO = 35 * MiB, WS_WPQ = 43 * MiB, WS_WCKV = 51 * MiB, WS_WUQ = 67 * MiB, WS_WUKV = 68 * MiB, WS_KEYS = 69 * MiB, WS_ROPE = 70 * MiB;
constexpr size_t WS_XNB = 76 * MiB, WS_YB = 140 * MiB, WS_PROJB = 204 * MiB, WS_QMB = 348 * MiB, WS_KMB = 372 * MiB, WS_VMB = 396 * MiB, WS_RS = 412 * MiB;
constexpr size_t WS_HLB = 413 * MiB, WS_ACB = 445 * MiB, WS_LSUM = 477 * MiB, WS_OMB = 478 * MiB, WS_MNB = 494 * MiB, WS_KVCB = 502 * MiB, WS_EX = 518 * MiB, WS_GW = 534 * MiB;
constexpr size_t WS_U8 = 550 * MiB, WS_V8 = 614 * MiB, WS_SU = 678 * MiB, WS_SV = 679 * MiB;
constexpr size_t WS_HQ = 680 * MiB, WS_P = 712 * MiB, WS_SH = 728 * MiB, WS_W = 729 * MiB, WS_WS = 745 * MiB, WS_SSQ = 746 * MiB, WS_END = 748 * MiB;
constexpr size_t WS_WAT = 74 * MiB;
constexpr size_t WS_BTAB = WS_KEYS + 512 * 1024, WS_LAMS = WS_BTAB + 4096, WS_SP = WS_LAMS + 4096;
constexpr int CW_BAR = 4096, CW_RANK = 8192;
constexpr int RING_OFF = 0, RING_BYTES = 155648, LDSCTL_OFF = RING_BYTES, MISC_OFF = LDSCTL_OFF + 320, LDS_BYTES = 163840;

#define XB_TMO      128
#define XB_XCNT(j)  (256  + 64 * (j))
#define XB_XSUB(j)  (1280 + 64 * (j))
#define XB_XGEN(j)  (2304 + 64 * (j))
#define XB_TOP      3328
#define XB_TOPGEN   3392
#define XCD_BAR_WORDS 3456
#define XB_SPIN_CAP (1u << 18)

__device__ __forceinline__ unsigned xb_ld(unsigned* p)              { return __hip_atomic_load(p, __ATOMIC_RELAXED, __HIP_MEMORY_SCOPE_AGENT); }
__device__ __forceinline__ unsigned xb_add(unsigned* p, unsigned v) { return __hip_atomic_fetch_add(p, v, __ATOMIC_RELAXED, __HIP_MEMORY_SCOPE_AGENT); }
__device__ __forceinline__ unsigned xb_xcc_id() { return (unsigned)__builtin_amdgcn_s_getreg((3 << 11) | 20) & 0xFu; }
#define XB_SPIN(cond, bar) do { unsigned _sp = 0; while (cond) { __builtin_amdgcn_s_sleep(1); \
    if ((++_sp & 255u) == 0u) { if (xb_ld(&(bar)[XB_TMO])) break; if (_sp > XB_SPIN_CAP) { atomicAdd(&(bar)[XB_TMO], 1u); break; } } } } while (0)

struct XcdBarrier {
    unsigned* bar; unsigned x;
    volatile LAS unsigned* st;
};

__device__ __forceinline__ XcdBarrier xcd_barrier_post(unsigned* bar, volatile LAS unsigned* st) {
    XcdBarrier b; b.bar = bar; b.x = xb_xcc_id(); b.st = st;
    if (threadIdx.x == 0) (void)xb_add(&bar[XB_XCNT(b.x)], 1u);
    return b;
}
__device__ __forceinline__ void xcd_barrier_complete(unsigned* bar, unsigned x, unsigned& nloc, unsigned& nx) {
    const unsigned G = gridDim.x * gridDim.y * gridDim.z;
    unsigned sum, cnt, mine, sp = 0u;
    for (;;) {
        sum = 0u; cnt = 0u; mine = 0u;
#pragma unroll
        for (unsigned j = 0; j < 16; ++j) { const unsigned c = xb_ld(&bar[XB_XCNT(j)]); sum += c; cnt += (c > 0u) ? 1u : 0u; mine = (j == x) ? c : mine; }
        if (sum == G) break;
        __builtin_amdgcn_s_sleep(1);
        if ((++sp & 255u) == 0u) { if (xb_ld(&bar[XB_TMO])) break; if (sp > XB_SPIN_CAP) { atomicAdd(&bar[XB_TMO], 1u); break; } }
    }
    nloc = mine > 0u ? mine : 1u; nx = cnt > 0u ? cnt : 1u;
}

__device__ __noinline__ void xcd_barrier_impl(unsigned* bar_, unsigned x_, volatile LAS unsigned* st_, int leader_) {
    XcdBarrier b; b.bar = bar_; b.x = x_; b.st = st_;
    asm volatile("s_waitcnt vmcnt(0)" ::: "memory");
    __syncthreads();
    if (leader_) {
        unsigned* bar = b.bar;
        __builtin_amdgcn_s_waitcnt(0);
        unsigned nloc = b.st[0], nx = b.st[1];
        if (nloc == 0u) { xcd_barrier_complete(bar, b.x, nloc, nx); b.st[0] = nloc; b.st[1] = nx; }
        const unsigned old = xb_add(&bar[XB_XSUB(b.x)], 1u);
        const unsigned gen = old / nloc;
        if (old + 1u == (gen + 1u) * nloc) {
            __builtin_amdgcn_fence(__ATOMIC_RELEASE, "agent");
            asm volatile("s_waitcnt vmcnt(0)" ::: "memory");
            const unsigned og = xb_add(&bar[XB_TOP], 1u);
            const unsigned tg = og / nx;
            if (og + 1u == (tg + 1u) * nx) xb_add(&bar[XB_TOPGEN], 1u);
            else XB_SPIN(xb_ld(&bar[XB_TOPGEN]) == tg, bar);
            __builtin_amdgcn_fence(__ATOMIC_ACQUIRE, "agent");
            xb_add(&bar[XB_XGEN(b.x)], 1u);
            asm volatile("s_waitcnt vmcnt(0)" ::: "memory");
        } else {
            XB_SPIN(xb_ld(&bar[XB_XGEN(b.x)]) == gen, bar);
            __builtin_amdgcn_fence(__ATOMIC_ACQUIRE, "agent");
            asm volatile("s_waitcnt vmcnt(0)" ::: "memory");
        }
    }
    __syncthreads();
}
__device__ __forceinline__ void xcd_barrier(const XcdBarrier& b, int leader) { xcd_barrier_impl(b.bar, b.x, b.st, leader); }


__device__ __forceinline__ float wave_sum(float v, int lane) {
    (void)lane;
    v += __builtin_bit_cast(float, __builtin_amdgcn_update_dpp(0, __builtin_bit_cast(int, v), 0xB1, 0xF, 0xF, true));
    v += __builtin_bit_cast(float, __builtin_amdgcn_update_dpp(0, __builtin_bit_cast(int, v), 0x4E, 0xF, 0xF, true));
    v += __builtin_bit_cast(float, __builtin_amdgcn_update_dpp(0, __builtin_bit_cast(int, v), 0x141, 0xF, 0xF, true));
    v += __builtin_bit_cast(float, __builtin_amdgcn_update_dpp(0, __builtin_bit_cast(int, v), 0x140, 0xF, 0xF, true));
    { float a = v, b = v; asm volatile("v_nop\n\tv_nop\n\tv_permlane16_swap_b32 %0, %1" : "+v"(a), "+v"(b)); v = a + b; }
    { float a = v, b = v; asm volatile("v_nop\n\tv_nop\n\tv_permlane32_swap_b32 %0, %1" : "+v"(a), "+v"(b)); v = a + b; }
    return v;
}
__device__ __forceinline__ float wave_max(float v) {
    v = fmaxf(v, __builtin_bit_cast(float, __builtin_amdgcn_update_dpp(0, __builtin_bit_cast(int, v), 0xB1, 0xF, 0xF, true)));
    v = fmaxf(v, __builtin_bit_cast(float, __builtin_amdgcn_update_dpp(0, __builtin_bit_cast(int, v), 0x4E, 0xF, 0xF, true)));
    v = fmaxf(v, __builtin_bit_cast(float, __builtin_amdgcn_update_dpp(0, __builtin_bit_cast(int, v), 0x141, 0xF, 0xF, true)));
    v = fmaxf(v, __builtin_bit_cast(float, __builtin_amdgcn_update_dpp(0, __builtin_bit_cast(int, v), 0x140, 0xF, 0xF, true)));
    { float a = v, b = v; asm volatile("v_nop\n\tv_nop\n\tv_permlane16_swap_b32 %0, %1" : "+v"(a), "+v"(b)); v = fmaxf(a, b); }
    { float a = v, b = v; asm volatile("v_nop\n\tv_nop\n\tv_permlane32_swap_b32 %0, %1" : "+v"(a), "+v"(b)); v = fmaxf(a, b); }
    return v;
}
__device__ __forceinline__ float gelu_erf(float v) {
    const float av = __builtin_fabsf(v), t = __builtin_amdgcn_rcpf(av * 0.2316418882f + 1.0f);
    float q = t * 0.5307027145f + (-0.7265760135f); q = q * t + 0.7107068705f; q = q * t + (-0.142248368f); q = q * t + 0.127414796f; q = q * t;
    const float e = __builtin_amdgcn_exp2f((v * v) * (-0.72134752044f));
    const float m = v * (q * e);
    return v < 0.f ? m : v - m;
}

__device__ __forceinline__ void norm_phase(const GAS float* X, const GAS float* g, GAS bf16* out, int rows, int gw, int NGW, int lane) {
    asm volatile("" : "+v"(lane));
    f32x4 gv[4];
#pragma unroll
    for (int j = 0; j < 4; ++j) gv[j] = ((const GAS f32x4*)g)[lane + 64 * j];
    for (int m = gw; m < rows; m += NGW) {
        const GAS f32x4* xr = (const GAS f32x4*)(X + (size_t)m * D) + lane;
        f32x4 v[4]; float s = 0.f;
#pragma unroll
        for (int j = 0; j < 4; ++j) { v[j] = xr[64 * j]; s += (v[j].x * v[j].x + v[j].y * v[j].y) + (v[j].z * v[j].z + v[j].w * v[j].w); }
        const float rs = rsqrtf(wave_sum(s, lane) * (1.f / D) + 1e-6f);
        GAS v2u* o8 = (GAS v2u*)(out + (size_t)m * D) + lane;
#pragma unroll
        for (int j = 0; j < 4; ++j) { v2u w; w.x = pk2(v[j].x * rs * gv[j].x, v[j].y * rs * gv[j].y); w.y = pk2(v[j].z * rs * gv[j].z, v[j].w * rs * gv[j].w); o8[64 * j] = w; }
    }
}
__device__ __forceinline__ void hq_phase(const GAS bf16* XB, const GAS float* SSQ, const GAS float* g, GAS unsigned char* HQ, GAS float* SH, GAS int* Pz, int gw, int NGW, int lane) {
    asm volatile("" : "+v"(lane));
    const GAS f32x4* gp = (const GAS f32x4*)g + 4 * lane; const f32x4 g0 = gp[0], g1 = gp[1], g2 = gp[2], g3 = gp[3];
    for (int m0 = gw; m0 < T; m0 += 2 * NGW) {
        const int mm[2] = {m0, m0 + NGW < T ? m0 + NGW : m0};
        f32x4 tt[2], sq_[2][4]; v4u aa[2], bb[2];
#pragma unroll
        for (int r = 0; r < 2; ++r) { const GAS f32x4* sp = (const GAS f32x4*)(SSQ + (size_t)mm[r] * 16);
#pragma unroll
            for (int i = 0; i < 4; ++i) sq_[r][i] = sp[i];
            aa[r] = *(const GAS v4u*)(XB + (size_t)mm[r] * D + 16 * lane); bb[r] = *(const GAS v4u*)(XB + (size_t)mm[r] * D + 16 * lane + 8); }
        __builtin_amdgcn_sched_barrier(0);
#pragma unroll
        for (int r = 0; r < 2; ++r) tt[r] = (sq_[r][0] + sq_[r][1]) + (sq_[r][2] + sq_[r][3]);
#pragma unroll
        for (int r = 0; r < 2; ++r) { const int m = mm[r]; const f32x4 t = tt[r]; const v4u a = aa[r], b = bb[r];
        const float rs = __builtin_amdgcn_rsqf(((t[0] + t[1]) + (t[2] + t[3])) * (1.f / 1024.f) + 1e-6f);
        float f[16] = {bflo(a.x) * g0[0], bfhi(a.x) * g0[1], bflo(a.y) * g0[2], bfhi(a.y) * g0[3], bflo(a.z) * g1[0], bfhi(a.z) * g1[1], bflo(a.w) * g1[2], bfhi(a.w) * g1[3],
                       bflo(b.x) * g2[0], bfhi(b.x) * g2[1], bflo(b.y) * g2[2], bfhi(b.y) * g2[3], bflo(b.z) * g3[0], bfhi(b.z) * g3[1], bflo(b.w) * g3[2], bfhi(b.w) * g3[3]};
        float mx = 0.f;
#pragma unroll
        for (int i = 0; i < 16; ++i) { f[i] *= rs; mx = fmaxf(mx, __builtin_fabsf(f[i])); }
        mx = wave_max(mx);
        const float inv = mx > 0.f ? 127.f / mx : 0.f;
        v4u q;
#pragma unroll
        for (int i = 0; i < 4; ++i) { const int ia = (int)__builtin_rintf(f[4 * i] * inv), ib = (int)__builtin_rintf(f[4 * i + 1] * inv), ic = (int)__builtin_rintf(f[4 * i + 2] * inv), id = (int)__builtin_rintf(f[4 * i + 3] * inv);
            q[i] = (unsigned)(ia & 255) | ((unsigned)(ib & 255) << 8) | ((unsigned)(ic & 255) << 16) | ((unsigned)(id & 255) << 24); }
        *(GAS v4u*)(HQ + (size_t)m * D + 16 * lane) = q;
        if (lane == 0) SH[m] = mx * (1.f / 127.f); }
    }
}
__device__ __forceinline__ void x0_phase(const GAS float* X, GAS bf16* XB, GAS float* SSQ, int gw, int NGW, int lane) {
    asm volatile("" : "+v"(lane));
    for (int m = gw; m < T; m += 2 * NGW) {
        const int mm[2] = {m, m + NGW < T ? m + NGW : m};
        f32x4 v[2][4];
#pragma unroll
        for (int r = 0; r < 2; ++r) { const GAS f32x4* xr = (const GAS f32x4*)(X + (size_t)mm[r] * D) + lane;
#pragma unroll
            for (int j = 0; j < 4; ++j) v[r][j] = xr[64 * j]; }
#pragma unroll
        for (int r = 0; r < 2; ++r) { GAS v2u* o8 = (GAS v2u*)(XB + (size_t)mm[r] * D) + lane;
            float s = 0.f;
#pragma unroll
            for (int j = 0; j < 4; ++j) { const f32x4 w4 = v[r][j]; s += (w4.x * w4.x + w4.y * w4.y) + (w4.z * w4.z + w4.w * w4.w); v2u w; w.x = pk2(w4.x, w4.y); w.y = pk2(w4.z, w4.w); o8[64 * j] = w; }
            s = wave_sum(s, lane);
            if (lane < 8) SSQ[(size_t)mm[r] * 16 + lane] = lane == 0 ? s : 0.f; }
    }
}
__device__ __forceinline__ void final_norm_phase(const GAS bf16* XB, GAS float* O, const GAS float* g, int rows, int gw, int NGW, int lane) {
    asm volatile("" : "+v"(lane));
    f32x4 gg[2][2];
#pragma unroll
    for (int j = 0; j < 2; ++j) { const int c = 8 * (lane + 64 * j); gg[j][0] = *(const GAS f32x4*)(g + c); gg[j][1] = *(const GAS f32x4*)(g + c + 4); }
    for (int m = gw; m < rows; m += 2 * NGW) {
        const int mm[2] = {m, m + NGW < rows ? m + NGW : m};
        v4u v[2][2];
#pragma unroll
        for (int r = 0; r < 2; ++r) { const GAS v4u* xr = (const GAS v4u*)(XB + (size_t)mm[r] * D) + lane;
#pragma unroll
            for (int j = 0; j < 2; ++j) v[r][j] = xr[64 * j]; }
#pragma unroll
        for (int r = 0; r < 2; ++r) { float s = 0.f;
#pragma unroll
            for (int j = 0; j < 2; ++j) {
#pragma unroll
                for (int e = 0; e < 4; ++e) { const float a = bflo(v[r][j][e]), b = bfhi(v[r][j][e]); s += a * a + b * b; } }
            const float rs = rsqrtf(wave_sum(s, lane) * (1.f / D) + 1e-6f);
#pragma unroll
            for (int j = 0; j < 2; ++j) { const int c = 8 * (lane + 64 * j); const f32x4 g0 = gg[j][0], g1 = gg[j][1];
                f32x4 o0, o1; o0.x = bflo(v[r][j].x) * rs * g0.x; o0.y = bfhi(v[r][j].x) * rs * g0.y; o0.z = bflo(v[r][j].y) * rs * g0.z; o0.w = bfhi(v[r][j].y) * rs * g0.w;
                o1.x = bflo(v[r][j].z) * rs * g1.x; o1.y = bfhi(v[r][j].z) * rs * g1.y; o1.z = bflo(v[r][j].w) * rs * g1.z; o1.w = bfhi(v[r][j].w) * rs * g1.w;
                *(GAS f32x4*)(O + (size_t)mm[r] * D + c) = o0; *(GAS f32x4*)(O + (size_t)mm[r] * D + c + 4) = o1; } }
    }
}

__device__ __forceinline__ float row16_sum(float v) {
    v += __builtin_bit_cast(float, __builtin_amdgcn_update_dpp(0, __builtin_bit_cast(int, v), 0xB1, 0xF, 0xF, true));
    v += __builtin_bit_cast(float, __builtin_amdgcn_update_dpp(0, __builtin_bit_cast(int, v), 0x4E, 0xF, 0xF, true));
    v += __builtin_bit_cast(float, __builtin_amdgcn_update_dpp(0, __builtin_bit_cast(int, v), 0x141, 0xF, 0xF, true));
    v += __builtin_bit_cast(float, __builtin_amdgcn_update_dpp(0, __builtin_bit_cast(int, v), 0x140, 0xF, 0xF, true));
    return v;
}
__device__ __forceinline__ float sq8(const v4u w) { const float a0 = bflo(w.x), a1 = bfhi(w.x), a2 = bflo(w.y), a3 = bfhi(w.y), a4 = bflo(w.z), a5 = bfhi(w.z), a6 = bflo(w.w), a7 = bfhi(w.w);
    return (a0 * a0 + a1 * a1) + (a2 * a2 + a3 * a3) + (a4 * a4 + a5 * a5) + (a6 * a6 + a7 * a7); }
__device__ __forceinline__ void pre_phase(const GAS bf16* PROJB, const GAS float* ROPE, GAS float* RS, GAS bf16* KMB, int gw, int NGW, int lane) {
    asm volatile("" : "+v"(lane));
    const int q = lane >> 4, sub = lane & 15;
    for (int t0 = gw * 4; t0 < T; t0 += NGW * 8) {
        const size_t tt[2] = {(size_t)t0 + q, (size_t)(t0 + NGW * 4 < T ? t0 + NGW * 4 : t0) + q};
        v4u w0[2], w1[2], w2[2]; float x1[2], x2[2], c[2], sn[2];
#pragma unroll
        for (int r = 0; r < 2; ++r) { const GAS bf16* pr = PROJB + tt[r] * INP;
            w0[r] = *(const GAS v4u*)(pr + PC_CQ + 8 * sub); w1[r] = *(const GAS v4u*)(pr + PC_CQ + 8 * (16 + (sub & 7))); w2[r] = *(const GAS v4u*)(pr + PC_CKV + 8 * sub);
            x1[r] = __builtin_bit_cast(float, (unsigned)pr[PC_KR + sub] << 16); x2[r] = __builtin_bit_cast(float, (unsigned)pr[PC_KR + 16 + sub] << 16);
            c[r] = ROPE[tt[r] * 32 + sub]; sn[r] = ROPE[tt[r] * 32 + 16 + sub]; }
#pragma unroll
        for (int r = 0; r < 2; ++r) { const size_t t = tt[r];
            const float sq = row16_sum(sq8(w0[r]) + (sub < 8 ? sq8(w1[r]) : 0.f)), skv = row16_sum(sq8(w2[r]));
            if (sub == 0) { RS[2 * t] = rsqrtf(sq * (1.f / 192.f) + 1e-6f); RS[2 * t + 1] = rsqrtf(skv * (1.f / 128.f) + 1e-6f); }
            const bf16 y1 = (bf16)f2bf_(x1[r] * c[r] - x2[r] * sn[r]), y2 = (bf16)f2bf_(x1[r] * sn[r] + x2[r] * c[r]);
            GAS bf16* kr = KMB + t * 384 + 64 + sub;
#pragma unroll
            for (int h = 0; h < 4; ++h) { kr[h * 96] = y1; kr[h * 96 + 16] = y2; } }
    }
}

typedef short lr_bf16x8 __attribute__((ext_vector_type(8)));
typedef float lr_f32x16 __attribute__((ext_vector_type(16)));
__device__ __forceinline__ void lr_swap32(float& a, float& b) { asm volatile("v_nop\n\tv_nop\n\tv_permlane32_swap_b32 %0, %1" : "+v"(a), "+v"(b)); }
constexpr int LR_XR = 0, LR_CW = LR_XR + 37376, LR_XA = LR_CW + 1280, LR_WT = LR_XA + 256 * 144, LR_SUM = LR_WT + 2 * 64 * 144, LR_END = LR_SUM + 4096;
struct LruP { const GAS bf16* PROJB; const GAS float* cw; const GAS float* cb; const GAS bf16* wat; const GAS float* ba; const GAS float* bx; const GAS float* sp; GAS unsigned* HA; GAS float* LSUM; };
__device__ __forceinline__ void lru_phase(const LruP& P, LAS unsigned char* lds, int tid, int wave, int lane, int vcu, int G) {
    asm volatile("" : "+v"(tid), "+v"(lane));
    LAS float* SUM = (LAS float*)(lds + LR_SUM);
    for (int u = vcu; u < (T / 256) * 8; u += G) {
        const int tile = u >> 3, g = u & 7; const int t0 = tile * 256; const bool first = ((tile & 31) == 0);
        __syncthreads();
        float ba_[2], bx_[2], sp_[2];
#pragma unroll
        for (int nt = 0; nt < 2; ++nt) { const int ch = 64 * g + 32 * nt + (lane & 31); ba_[nt] = P.ba[ch]; bx_[nt] = P.bx[ch]; sp_[nt] = P.sp[ch]; }
        { v4u wt_[2], xr_[5];
#pragma unroll
          for (int i = 0; i < 2; ++i) { const int idx = tid + 512 * i; wt_[i] = ((const GAS v4u*)(P.wat + (size_t)g * 2 * 4096))[idx]; }
#pragma unroll
          for (int i = 0; i < 5; ++i) { const int idx = tid + 512 * i, row = idx >> 3, part = idx & 7; const bool ok = (idx < 259 * 8) && !(first && row < 3);
              const int trow = ok ? t0 - 3 + row : t0;
              xr_[i] = *(const GAS v4u*)(P.PROJB + (size_t)trow * INP + PC_XL + 64 * g + 8 * part); if (!ok) xr_[i] = v4u{0u, 0u, 0u, 0u}; }
          float cwv = 0.f; if (tid < 320) cwv = (tid < 256) ? P.cw[(tid >> 6) * 512 + 64 * g + (tid & 63)] : P.cb[64 * g + (tid - 256)];
#pragma unroll
          for (int i = 0; i < 2; ++i) { const int idx = tid + 512 * i; *(LAS v4u*)(lds + LR_WT + (idx >> 9) * 9216 + ((idx >> 3) & 63) * 144 + (idx & 7) * 16) = wt_[i]; }
#pragma unroll
          for (int i = 0; i < 5; ++i) { const int idx = tid + 512 * i, row = idx >> 3, part = idx & 7; if (idx < 259 * 8) *(LAS v4u*)(lds + LR_XR + row * 144 + 16 * part) = xr_[i]; }
          if (tid < 320) ((LAS float*)(lds + LR_CW))[tid] = cwv; }
        __syncthreads();
        { float cwr[4][8], cbr[8];
#pragma unroll
          for (int k = 0; k < 4; ++k) { const f32x4 c0 = *(const LAS f32x4*)(lds + LR_CW + (k * 64 + 8 * wave) * 4), c1 = *(const LAS f32x4*)(lds + LR_CW + (k * 64 + 8 * wave + 4) * 4);
              cwr[k][0] = c0.x; cwr[k][1] = c0.y; cwr[k][2] = c0.z; cwr[k][3] = c0.w; cwr[k][4] = c1.x; cwr[k][5] = c1.y; cwr[k][6] = c1.z; cwr[k][7] = c1.w; }
          { const f32x4 c0 = *(const LAS f32x4*)(lds + LR_CW + (256 + 8 * wave) * 4), c1 = *(const LAS f32x4*)(lds + LR_CW + (256 + 8 * wave + 4) * 4);
            cbr[0] = c0.x; cbr[1] = c0.y; cbr[2] = c0.z; cbr[3] = c0.w; cbr[4] = c1.x; cbr[5] = c1.y; cbr[6] = c1.z; cbr[7] = c1.w; }
#pragma unroll
          for (int it_ = 0; it_ < 4; ++it_) { const int time = lane + 64 * it_;
              float y[8];
#pragma unroll
              for (int e = 0; e < 8; ++e) y[e] = cbr[e];
#pragma unroll
              for (int k = 0; k < 4; ++k) { const v4u w = *(const LAS v4u*)(lds + LR_XR + (time + k) * 144 + 16 * wave);
                  y[0] += bflo(w.x) * cwr[k][0]; y[1] += bfhi(w.x) * cwr[k][1]; y[2] += bflo(w.y) * cwr[k][2]; y[3] += bfhi(w.y) * cwr[k][3];
                  y[4] += bflo(w.z) * cwr[k][4]; y[5] += bfhi(w.z) * cwr[k][5]; y[6] += bflo(w.w) * cwr[k][6]; y[7] += bfhi(w.w) * cwr[k][7]; }
              v4u o; o.x = pk2(y[0], y[1]); o.y = pk2(y[2], y[3]); o.z = pk2(y[4], y[5]); o.w = pk2(y[6], y[7]);
              *(LAS v4u*)(lds + LR_XA + time * 144 + 16 * wave) = o; } }
        __syncthreads();
        const int r32 = lane & 31, hi = lane >> 5;
        lr_f32x16 acc[2][2];
#pragma unroll
        for (int nt = 0; nt < 2; ++nt) { const float b_a = ba_[nt], b_x = bx_[nt];
#pragma unroll
            for (int r = 0; r < 16; ++r) { acc[0][nt][r] = b_a; acc[1][nt][r] = b_x; } }
        { lr_bf16x8 af[4];
#pragma unroll
          for (int s_ = 0; s_ < 4; ++s_) af[s_] = *(const LAS lr_bf16x8*)(lds + LR_XA + (32 * wave + r32) * 144 + (16 * s_ + 8 * hi) * 2);
#pragma unroll
          for (int gt = 0; gt < 2; ++gt)
#pragma unroll
              for (int nt = 0; nt < 2; ++nt)
#pragma unroll
                  for (int s_ = 0; s_ < 4; ++s_) { const lr_bf16x8 bfr = *(const LAS lr_bf16x8*)(lds + LR_WT + gt * 9216 + (32 * nt + r32) * 144 + (16 * s_ + 8 * hi) * 2);
                      acc[gt][nt] = __builtin_amdgcn_mfma_f32_32x32x16_bf16(af[s_], bfr, acc[gt][nt], 0, 0, 0); } }
#pragma unroll
        for (int nt = 0; nt < 2; ++nt) { const float sp = sp_[nt];
            float sa_[4], sh_[4];
#pragma unroll
            for (int q = 0; q < 4; ++q) { float hrun = 0.f, arun = 1.f;
#pragma unroll
                for (int e = 0; e < 4; ++e) { const int r = 4 * q + e, tl = 8 * q + 4 * hi + e;
                    const float xv = __builtin_bit_cast(float, (unsigned)*(const LAS unsigned short*)(lds + LR_XA + (32 * wave + tl) * 144 + (32 * nt + r32) * 2) << 16);
                    const float rg = __builtin_amdgcn_rcpf(1.f + __builtin_amdgcn_exp2f(-LOG2E * acc[0][nt][r])), ig = __builtin_amdgcn_rcpf(1.f + __builtin_amdgcn_exp2f(-LOG2E * acc[1][nt][r]));
                    const float la = -8.0f * rg * sp; const float a_ = __builtin_amdgcn_exp2f(LOG2E * la);
                    const float uu = __builtin_amdgcn_sqrtf(fmaxf(1.f - a_ * a_, 0.f)) * (ig * xv);
                    hrun = a_ * hrun + uu; arun *= a_; acc[0][nt][r] = arun; acc[1][nt][r] = hrun; }
                sa_[q] = arun; sh_[q] = hrun; }
            float runA = 1.f, runH = 0.f;
#pragma unroll
            for (int q = 0; q < 4; ++q) { float a0 = sa_[q], a1 = sa_[q], h0 = sh_[q], h1 = sh_[q]; lr_swap32(a0, a1); lr_swap32(h0, h1);
                const float midA = runA * a0, midH = a0 * runH + h0;
                const float inA = hi ? midA : runA, inH = hi ? midH : runH;
                runA = midA * a1; runH = a1 * midH + h1;
#pragma unroll
                for (int e = 0; e < 4; ++e) { const int r = 4 * q + e; acc[1][nt][r] += acc[0][nt][r] * inH; acc[0][nt][r] *= inA; } }
            if (hi == 0) { SUM[(wave * 64 + 32 * nt + r32) * 2] = runA; SUM[(wave * 64 + 32 * nt + r32) * 2 + 1] = runH; } }
        __syncthreads();
#pragma unroll
        for (int nt = 0; nt < 2; ++nt) { const int cl = 32 * nt + r32;
            float ca = 1.f, chh = 0.f;
            for (int w = 0; w < wave; ++w) { const float aw = SUM[(w * 64 + cl) * 2], hw = SUM[(w * 64 + cl) * 2 + 1]; chh = aw * chh + hw; ca *= aw; }
            GAS unsigned* ha = P.HA + (size_t)(t0 + 32 * wave + 4 * hi) * 512 + 64 * g + cl;
#pragma unroll
            for (int r = 0; r < 16; ++r) { const float hh = acc[1][nt][r] + acc[0][nt][r] * chh, ac_ = acc[0][nt][r] * ca; ha[(size_t)((r & 3) + 8 * (r >> 2)) * 512] = pk2(hh, ac_);
                if (r == 15 && wave == 7 && hi == 1) { P.LSUM[((size_t)tile * 512 + 64 * g + cl) * 2] = ac_; P.LSUM[((size_t)tile * 512 + 64 * g + cl) * 2 + 1] = hh; } } }
    }
}

struct PostP { const GAS bf16* OMB; const GAS unsigned* HA; const GAS float* LSUM; const GAS bf16* PROJB; const GAS float* gm; const GAS float* gl; GAS bf16* Y; };
__device__ __forceinline__ void post_phase(const PostP& P, LAS unsigned char* lds, int tid, int wave, int lane, int vcu, int G) {
    asm volatile("" : "+v"(tid), "+v"(lane));
    LAS float* hin = (LAS float*)lds;
    for (int u = vcu; u < T / 64; u += G) {
        const int t0 = u * 64, tile = t0 >> 8, tb = tile & ~31;
        __syncthreads();
        { float h = 0.f;
          for (int c0 = tb; c0 < tile; c0 += 16) {
              float av_[16], hv_[16];
#pragma unroll
              for (int i = 0; i < 16; ++i) { const int c = (c0 + i < tile) ? (c0 + i) : tb; av_[i] = P.LSUM[((size_t)c * 512 + tid) * 2]; hv_[i] = P.LSUM[((size_t)c * 512 + tid) * 2 + 1]; }
#pragma unroll
              for (int i = 0; i < 16; ++i) { if (c0 + i < tile) h = av_[i] * h + hv_[i]; } }
          hin[tid] = h; }
        __syncthreads();
        f32x4 hi0 = *(const LAS f32x4*)(hin + 8 * lane), hi1 = *(const LAS f32x4*)(hin + 8 * lane + 4);
        const f32x4 g0 = *(const GAS f32x4*)(P.gl + 8 * lane), g1 = *(const GAS f32x4*)(P.gl + 8 * lane + 4), gmv = *(const GAS f32x4*)(P.gm + 4 * lane);
#pragma unroll 1
        for (int i2 = 0; i2 < 8; i2 += 2) {
            v4u p0v[2], p1v[2], gwv[2]; v2u mwv[2];
#pragma unroll
            for (int r = 0; r < 2; ++r) { const size_t t = (size_t)t0 + 8 * wave + i2 + r;
                p0v[r] = *(const GAS v4u*)(P.HA + t * 512 + 8 * lane); p1v[r] = *(const GAS v4u*)(P.HA + t * 512 + 8 * lane + 4); gwv[r] = *(const GAS v4u*)(P.PROJB + t * INP + PC_GL + 8 * lane);
                mwv[r] = *(const GAS v2u*)(P.OMB + t * 256 + 4 * lane); }
#pragma unroll
          for (int r = 0; r < 2; ++r) {
            const size_t t = (size_t)t0 + 8 * wave + i2 + r;
            const v4u p0 = p0v[r], p1 = p1v[r], gw_ = gwv[r]; const v2u mw = mwv[r];
            float o[8];
            o[0] = (bflo(p0.x) + bfhi(p0.x) * hi0.x) * gelu_erf(bflo(gw_.x)); o[1] = (bflo(p0.y) + bfhi(p0.y) * hi0.y) * gelu_erf(bfhi(gw_.x));
            o[2] = (bflo(p0.z) + bfhi(p0.z) * hi0.z) * gelu_erf(bflo(gw_.y)); o[3] = (bflo(p0.w) + bfhi(p0.w) * hi0.w) * gelu_erf(bfhi(gw_.y));
            o[4] = (bflo(p1.x) + bfhi(p1.x) * hi1.x) * gelu_erf(bflo(gw_.z)); o[5] = (bflo(p1.y) + bfhi(p1.y) * hi1.y) * gelu_erf(bfhi(gw_.z));
            o[6] = (bflo(p1.z) + bfhi(p1.z) * hi1.z) * gelu_erf(bflo(gw_.w)); o[7] = (bflo(p1.w) + bfhi(p1.w) * hi1.w) * gelu_erf(bfhi(gw_.w));
            float s2 = 0.f;
#pragma unroll
            for (int e = 0; e < 8; ++e) s2 += o[e] * o[e];
            const float m0 = bflo(mw.x), m1 = bfhi(mw.x), m2 = bflo(mw.y), m3 = bfhi(mw.y);
            float s1 = (m0 * m0 + m1 * m1) + (m2 * m2 + m3 * m3);
            s1 = wave_sum(s1, lane); s2 = wave_sum(s2, lane);
            const float r1 = rsqrtf(s1 * (1.f / 256.f) + 1e-6f), r2 = rsqrtf(s2 * (1.f / 512.f) + 1e-6f);
            GAS bf16* yr = P.Y + t * 1024;
            { v2u w; w.x = pk2(m0 * r1 * gmv.x, m1 * r1 * gmv.y); w.y = pk2(m2 * r1 * gmv.z, m3 * r1 * gmv.w); *(GAS v2u*)(yr + 4 * lane) = w; }
            { v4u w; w.x = pk2(o[0] * r2 * g0.x, o[1] * r2 * g0.y); w.y = pk2(o[2] * r2 * g0.z, o[3] * r2 * g0.w); w.z = pk2(o[4] * r2 * g1.x, o[5] * r2 * g1.y); w.w = pk2(o[6] * r2 * g1.z, o[7] * r2 * g1.w);
              *(GAS v4u*)(yr + 256 + 8 * lane) = w; }
          }
        }
    }
}

#define TILE_BAR() asm volatile("s_waitcnt lgkmcnt(0)\n\ts_barrier" ::: "memory")
typedef short bf16x8 __attribute__((ext_vector_type(8)));
typedef short s16x4 __attribute__((ext_vector_type(4)));
typedef float f32x16 __attribute__((ext_vector_type(16)));
typedef unsigned u32x4 __attribute__((ext_vector_type(4)));
__device__ __forceinline__ int crow(int r, int hi) { return (r & 3) + 8 * (r >> 2) + 4 * hi; }
typedef float f32x2_t __attribute__((ext_vector_type(2))); typedef __bf16 bf16x2_c __attribute__((ext_vector_type(2)));
__device__ __forceinline__ unsigned cvtpk(float lo, float hi) { f32x2_t v = {lo, hi}; bf16x2_c b = __builtin_convertvector(v, bf16x2_c); return __builtin_bit_cast(unsigned, b); }
__device__ __forceinline__ float swapmax(float m) { auto rr = __builtin_amdgcn_permlane32_swap(__float_as_uint(m), __float_as_uint(m), false, false); return fmaxf(__uint_as_float(rr[0]), __uint_as_float(rr[1])); }
__device__ __forceinline__ float swapadd(float m) { auto rr = __builtin_amdgcn_permlane32_swap(__float_as_uint(m), __float_as_uint(m), false, false); return __uint_as_float(rr[0]) + __uint_as_float(rr[1]); }
__device__ __forceinline__ s16x4 vtr(const LAS unsigned char* p) { return __builtin_bit_cast(s16x4, __builtin_amdgcn_ds_read_tr16_b64_v4i16((LAS s16x4*)p)); }
__device__ __forceinline__ bf16x8 pack8(const f32x16& p, int b) { u32x4 w; w.x = cvtpk(p[b], p[b + 1]); w.y = cvtpk(p[b + 2], p[b + 3]); w.z = cvtpk(p[b + 4], p[b + 5]); w.w = cvtpk(p[b + 6], p[b + 7]); return __builtin_bit_cast(bf16x8, w); }
__device__ __forceinline__ float vmax3(float a, float b, float c) { float r; asm("v_max3_f32 %0, %1, %2, %3" : "=v"(r) : "v"(a), "v"(b), "v"(c)); return r; }
__device__ __forceinline__ float max32(const f32x16& p, const f32x16& q) {
    float a = vmax3(p[0], p[1], p[2]), b = vmax3(p[3], p[4], p[5]), c = vmax3(p[6], p[7], p[8]), d = vmax3(p[9], p[10], p[11]), e = vmax3(p[12], p[13], p[14]);
    float f = vmax3(q[0], q[1], q[2]), g = vmax3(q[3], q[4], q[5]), h = vmax3(q[6], q[7], q[8]), i = vmax3(q[9], q[10], q[11]), j = vmax3(q[12], q[13], q[14]);
    a = vmax3(a, b, c); d = vmax3(d, e, p[15]); f = vmax3(f, g, h); i = vmax3(i, j, q[15]);
    return vmax3(vmax3(a, d, f), i, i);
}
__device__ __forceinline__ float max16(const f32x16& p) { float a = fmaxf(fmaxf(p[0], p[1]), fmaxf(p[2], p[3])), b = fmaxf(fmaxf(p[4], p[5]), fmaxf(p[6], p[7])), c = fmaxf(fmaxf(p[8], p[9]), fmaxf(p[10], p[11])), d = fmaxf(fmaxf(p[12], p[13]), fmaxf(p[14], p[15])); return fmaxf(fmaxf(a, b), fmaxf(c, d)); }

struct AttnP {
    const GAS bf16* Q; const GAS bf16* K; const GAS bf16* V; int qp, kp, vp;
    GAS bf16* O; int op;
    const GAS float* rope;
    const GAS int* pos; const GAS float* btab; const GAS float* dnorm; const GAS float* lams;
};
template <int KIND> struct AK {
    static constexpr bool DIFF = KIND == 1, CROSS = KIND == 2;
    static constexpr int HW = KIND == 0 ? 96 : KIND == 1 ? 64 : 256;
    static constexpr int NKS = KIND == 0 ? 6 : KIND == 1 ? 2 : 16;
    static constexpr int KP = KIND == 0 ? 208 : KIND == 1 ? 144 : 528;
    static constexpr int ND = CROSS ? 4 : 2;
    static constexpr int CPK = HW / 8, KCH = (64 * CPK + 511) / 512;
    static constexpr int VCH = ND / 2;
    static constexpr int KB = 64 * KP, VB = ND * 4096;
    static constexpr int NBUF = CROSS ? 2 : 3;
    static constexpr int K0 = 0, V0 = NBUF * KB, POS = V0 + NBUF * VB, BT = POS + 1024, DN = BT + 528, END = DN + 256;
};
static_assert(AK<2>::END <= RING_BYTES && AK<0>::END <= RING_BYTES && AK<1>::END + 16 + 8 * 8192 <= RING_BYTES, "attention LDS");

template <int KIND, bool LEAD>
__device__ __forceinline__ void attn_unit(const AttnP& P, int b, int h, int qb, int dhalf, LAS unsigned char* lds, int tid, int wave, int lane) {
    lane = lane_id_v(); tid = (wave << 6) | lane;
    typedef AK<KIND> C;
    constexpr bool DIFF = C::DIFF, CROSS = C::CROSS;
    constexpr int HW = C::HW, NKS = C::NKS, KP = C::KP, ND = C::ND, CPK = C::CPK, KCH = C::KCH, VCH = C::VCH;
    const int r32 = lane & 31, hi = lane >> 5;
    const size_t rowb = (size_t)b * S, rowk = CROSS ? (size_t)b * MEM : rowb;
    const int q0w = qb * 256 + wave * 32, qi = q0w + r32;
    int pq = 0; float bias_far = 0.f;
    __syncthreads();
    if (DIFF) {
        pq = P.pos[rowb + qi];
        if (tid < 129) ((LAS float*)(lds + C::BT))[tid] = P.btab[h * 129 + tid];
        if (tid >= 192 && tid < 256) ((LAS float*)(lds + C::DN))[tid - 192] = P.dnorm[tid - 192];
    }
    int minq = pq;
    if (DIFF) { for (int o = 1; o < 64; o <<= 1) { const int v = shxi(minq, o, lane); minq = v < minq ? v : minq; } }
    const int NT = CROSS ? MEM / 64 : 4 * (qb + 1);
    u32x4 kr[KCH], vr[VCH]; int pkr = 0;
    u32x4 kr2[CROSS ? 1 : KCH], vr2[CROSS ? 1 : VCH]; int pkr2 = 0;
    const GAS bf16* Kb = P.K + rowk * P.kp + h * HW; const GAS bf16* Vb = P.V + rowk * P.vp + (CROSS ? h * 256 + dhalf * 128 : h * 64);
    const __amdgpu_buffer_rsrc_t rK = __builtin_amdgcn_make_buffer_rsrc((void*)Kb, 0, 0x7fffffff, 0x00020000), rV = __builtin_amdgcn_make_buffer_rsrc((void*)Vb, 0, 0x7fffffff, 0x00020000);
    const __amdgpu_buffer_rsrc_t rP = __builtin_amdgcn_make_buffer_rsrc((void*)(DIFF ? P.pos + rowb : (const GAS int*)Kb), 0, 0x7fffffff, 0x00020000);
    int kvo[KCH], vvo[VCH];
#pragma unroll
    for (int i = 0; i < KCH; ++i) { int c = tid + 512 * i; c = c < 64 * CPK ? c : tid; kvo[i] = ((c / CPK) * P.kp + (c % CPK) * 8) * 2; }
#pragma unroll
    for (int i = 0; i < VCH; ++i) { const int c = tid + 512 * i; vvo[i] = ((c / (4 * ND)) * P.vp + (c % (4 * ND)) * 8) * 2; }
    const int pvo = (tid & 63) * 4;
    auto gload = [&](int t) {
        const int ks = __builtin_amdgcn_readfirstlane(64 * t * P.kp * 2), vs = __builtin_amdgcn_readfirstlane(64 * t * P.vp * 2);
#pragma unroll
        for (int i = 0; i < KCH; ++i) kr[i] = __builtin_amdgcn_raw_buffer_load_b128(rK, kvo[i], ks, 0);
#pragma unroll
        for (int i = 0; i < VCH; ++i) vr[i] = __builtin_amdgcn_raw_buffer_load_b128(rV, vvo[i], vs, 0);
        if (DIFF) pkr = __builtin_amdgcn_raw_buffer_load_b32(rP, pvo, __builtin_amdgcn_readfirstlane(64 * t * 4), 0);
    };
    auto lstore = [&](int buf) {
        LAS unsigned char* kb_ = lds + C::K0 + buf * C::KB; LAS unsigned char* vb_ = lds + C::V0 + buf * C::VB;
#pragma unroll
        for (int i = 0; i < KCH; ++i) { int c = tid + 512 * i; c = c < 64 * CPK ? c : tid; const int key = c / CPK, part = c % CPK; *(LAS u32x4*)(kb_ + key * KP + part * 16) = kr[i]; }
#pragma unroll
        for (int i = 0; i < VCH; ++i) { const int c = tid + 512 * i; const int key = c / (4 * ND), part = c % (4 * ND); *(LAS u32x4*)(vb_ + (part >> 2) * 4096 + (key >> 3) * 512 + (key & 7) * 64 + (part & 3) * 16) = vr[i]; }
        if (DIFF) { ((LAS int*)(lds + C::POS + buf * 256))[tid & 63] = pkr; if (tid < 64) { int mk_ = pkr; for (int o = 1; o < 64; o <<= 1) { const int v = shxi(mk_, o, lane); mk_ = v > mk_ ? v : mk_; } if (tid == 0) ((LAS int*)(lds + C::POS + 768))[buf] = mk_; } }
    };
    auto gloadB = [&](int t) {
        const int ks = __builtin_amdgcn_readfirstlane(64 * t * P.kp * 2), vs = __builtin_amdgcn_readfirstlane(64 * t * P.vp * 2);
#pragma unroll
        for (int i = 0; i < (CROSS ? 1 : KCH); ++i) kr2[i] = __builtin_amdgcn_raw_buffer_load_b128(rK, kvo[i], ks, 0);
#pragma unroll
        for (int i = 0; i < (CROSS ? 1 : VCH); ++i) vr2[i] = __builtin_amdgcn_raw_buffer_load_b128(rV, vvo[i], vs, 0);
        if (DIFF) pkr2 = __builtin_amdgcn_raw_buffer_load_b32(rP, pvo, __builtin_amdgcn_readfirstlane(64 * t * 4), 0);
    };
    auto lstoreB = [&](int buf) {
        LAS unsigned char* kb_ = lds + C::K0 + buf * C::KB; LAS unsigned char* vb_ = lds + C::V0 + buf * C::VB;
#pragma unroll
        for (int i = 0; i < (CROSS ? 1 : KCH); ++i) { int c = tid + 512 * i; c = c < 64 * CPK ? c : tid; const int key = c / CPK, part = c % CPK; *(LAS u32x4*)(kb_ + key * KP + part * 16) = kr2[i]; }
#pragma unroll
        for (int i = 0; i < (CROSS ? 1 : VCH); ++i) { const int c = tid + 512 * i; const int key = c / (4 * ND), part = c % (4 * ND); *(LAS u32x4*)(vb_ + (part >> 2) * 4096 + (key >> 3) * 512 + (key & 7) * 64 + (part & 3) * 16) = vr2[i]; }
        if (DIFF) { ((LAS int*)(lds + C::POS + buf * 256))[tid & 63] = pkr2; if (tid < 64) { int mk_ = pkr2; for (int o = 1; o < 64; o <<= 1) { const int v = shxi(mk_, o, lane); mk_ = v > mk_ ? v : mk_; } if (tid == 0) ((LAS int*)(lds + C::POS + 768))[buf] = mk_; } }
    };
    LAS float* osv = (LAS float*)(lds + ((C::END + 15) & ~15)) + wave * 2048 + lane;
    float il = 0.f;
    f32x16 oA[ND];
#pragma unroll 1
    for (int mp = 0; mp < (DIFF ? 2 : 1); ++mp) {
        bf16x8 qf[NKS];
        { const GAS bf16* qrow = P.Q + (rowb + qi) * P.qp + h * HW + mp * 32;
#pragma unroll
          for (int s = 0; s < NKS; ++s) qf[s] = *(const GAS bf16x8*)(qrow + 16 * s + 8 * hi);
          if (KIND == 0) {
              const GAS float* rp = P.rope + (rowb + qi) * 32 + 8 * hi;
              const f32x4 c0 = *(const GAS f32x4*)rp, c1 = *(const GAS f32x4*)(rp + 4), s0 = *(const GAS f32x4*)(rp + 16), s1 = *(const GAS f32x4*)(rp + 20);
              const u32x4 a = __builtin_bit_cast(u32x4, qf[NKS - 2]), bq = __builtin_bit_cast(u32x4, qf[NKS - 1]); u32x4 ra, rb;
#pragma unroll
              for (int w = 0; w < 4; ++w) { const float cl = w < 2 ? c0[2 * w] : c1[2 * w - 4], ch = w < 2 ? c0[2 * w + 1] : c1[2 * w - 3], sl = w < 2 ? s0[2 * w] : s1[2 * w - 4], sh = w < 2 ? s0[2 * w + 1] : s1[2 * w - 3];
                  const float x1l = bflo(a[w]), x1h = bfhi(a[w]), x2l = bflo(bq[w]), x2h = bfhi(bq[w]);
                  ra[w] = cvtpk(x1l * cl - x2l * sl, x1h * ch - x2h * sh); rb[w] = cvtpk(x1l * sl + x2l * cl, x1h * sh + x2h * ch); }
              qf[NKS - 2] = __builtin_bit_cast(bf16x8, ra); qf[NKS - 1] = __builtin_bit_cast(bf16x8, rb);
          } }
        __syncthreads();
        float m1 = -1e30f, l1 = 0.f;
#pragma unroll
        for (int d = 0; d < ND; ++d)
#pragma unroll
            for (int r = 0; r < 16; ++r) oA[d][r] = 0.f;
        auto qk = [&](int sl, f32x16& sa, f32x16& sb, float init) {
            const LAS unsigned char* kb_ = lds + C::K0 + sl * C::KB + r32 * KP + hi * 16 + mp * 64;
#pragma unroll
            for (int r = 0; r < 16; ++r) { sa[r] = init; sb[r] = init; }
            constexpr int HB = CROSS ? 4 : (NKS > 3 ? 3 : NKS);
#pragma unroll
            for (int s0_ = 0; s0_ < NKS; s0_ += HB) {
                bf16x8 kfa[HB], kfb[HB];
#pragma unroll
                for (int s = 0; s < HB; ++s) { kfa[s] = *(const LAS bf16x8*)(kb_ + (s0_ + s) * 32); kfb[s] = *(const LAS bf16x8*)(kb_ + 32 * KP + (s0_ + s) * 32); }
                __builtin_amdgcn_sched_barrier(0);
#pragma unroll
                for (int s = 0; s < HB; ++s) { sa = __builtin_amdgcn_mfma_f32_32x32x16_bf16(kfa[s], qf[s0_ + s], sa, 0, 0, 0); sb = __builtin_amdgcn_mfma_f32_32x32x16_bf16(kfb[s], qf[s0_ + s], sb, 0, 0, 0); }
                __builtin_amdgcn_sched_barrier(0);
            }
        };
        auto isnear = [&](int sl) { bool nb = false;
            if (DIFF) { const int mk_ = __builtin_amdgcn_readfirstlane(((LAS int*)(lds + C::POS + 768))[sl]); nb = (minq - mk_) < 128; }
            return nb; };
        auto sm = [&](int t, int sl, f32x16& pa, f32x16& pb, bool nearb) -> float {
            const int k0 = 64 * t;
            if (DIFF) { if (nearb) {
                const LAS int* pk = (const LAS int*)(lds + C::POS + sl * 256); const LAS float* bt = (const LAS float*)(lds + C::BT);
#pragma unroll
                for (int r = 0; r < 16; ++r) { const int kk = crow(r, hi);
                    int n0 = pq - pk[kk], n1 = pq - pk[kk + 32]; n0 = n0 < 0 ? 0 : (n0 > 128 ? 128 : n0); n1 = n1 < 0 ? 0 : (n1 > 128 ? 128 : n1);
                    pa[r] += bt[n0]; pb[r] += bt[n1]; }
            } }
            if (!CROSS && k0 + 63 > q0w) {
#pragma unroll
                for (int r = 0; r < 16; ++r) { const int kk = k0 + crow(r, hi); if (kk > qi) pa[r] = -1e30f; if (kk + 32 > qi) pb[r] = -1e30f; }
            }
            asm volatile("s_nop 15\n\ts_nop 7" : "+v"(pa), "+v"(pb));
            float mn, al = 1.f;
            if (CROSS) { const float mx = swapmax(max32(pa, pb)); mn = fmaxf(m1, mx); al = __builtin_amdgcn_exp2f(m1 - mn); l1 *= al; }
            else { const float mx = swapmax(max32(pa, pb)); const bool up = mx > m1 + 8.0f; mn = up ? mx : m1;
                   if (__builtin_amdgcn_ballot_w64(up) != 0ull) { al = __builtin_amdgcn_exp2f(m1 - mn); l1 *= al; } }
            m1 = mn;
            float ls = 0.f;
#pragma unroll
            for (int r = 0; r < 16; ++r) { pa[r] = __builtin_amdgcn_exp2f(pa[r] - mn); pb[r] = __builtin_amdgcn_exp2f(pb[r] - mn); ls += pa[r] + pb[r]; }
            l1 += ls;
            return al;
        };
        auto pv = [&](int sl, const f32x16& pa, const f32x16& pb, float al) {
            const LAS unsigned char* vb_ = lds + C::V0 + sl * C::VB + ((lane >> 4) & 1) * 32 + (lane & 3) * 8 + (4 * hi + ((lane & 15) >> 2)) * 64;
            bf16x8 pf[4];
            pf[0] = pack8(pa, 0); pf[1] = pack8(pa, 8); pf[2] = pack8(pb, 0); pf[3] = pack8(pb, 8);
            const bool resc = CROSS ? true : (__builtin_amdgcn_ballot_w64(al != 1.0f) != 0ull);
            if (CROSS) {
#pragma unroll
                for (int d = 0; d < ND; ++d) {
                    __builtin_amdgcn_sched_barrier(0);
#pragma unroll
                    for (int r = 0; r < 16; ++r) oA[d][r] *= al;
                    bf16x8 vf[4];
#pragma unroll
                    for (int s = 0; s < 4; ++s) { const s16x4 lo = vtr(vb_ + d * 4096 + s * 1024), hh = vtr(vb_ + d * 4096 + s * 1024 + 512); vf[s] = (bf16x8){lo[0], lo[1], lo[2], lo[3], hh[0], hh[1], hh[2], hh[3]}; }
#pragma unroll
                    for (int s = 0; s < 4; ++s) oA[d] = __builtin_amdgcn_mfma_f32_32x32x16_bf16(vf[s], pf[s], oA[d], 0, 0, 0);
                }
            } else if (DIFF) {
                if (resc) {
#pragma unroll
                    for (int d = 0; d < 2; ++d)
#pragma unroll
                        for (int r = 0; r < 16; ++r) oA[d][r] *= al;
                }
#pragma unroll
                for (int d = 0; d < 2; ++d) {
                    bf16x8 vf[4];
#pragma unroll
                    for (int s = 0; s < 4; ++s) { const s16x4 lo = vtr(vb_ + d * 4096 + s * 1024), hh = vtr(vb_ + d * 4096 + s * 1024 + 512); vf[s] = (bf16x8){lo[0], lo[1], lo[2], lo[3], hh[0], hh[1], hh[2], hh[3]}; }
                    __builtin_amdgcn_sched_barrier(0);
#pragma unroll
                    for (int s = 0; s < 4; ++s) oA[d] = __builtin_amdgcn_mfma_f32_32x32x16_bf16(vf[s], pf[s], oA[d], 0, 0, 0);
                }
            } else {
                bf16x8 vf[2][4];
#pragma unroll
                for (int d = 0; d < 2; ++d)
#pragma unroll
                    for (int s = 0; s < 4; ++s) { const s16x4 lo = vtr(vb_ + d * 4096 + s * 1024), hh = vtr(vb_ + d * 4096 + s * 1024 + 512); vf[d][s] = (bf16x8){lo[0], lo[1], lo[2], lo[3], hh[0], hh[1], hh[2], hh[3]}; }
                if (resc) {
#pragma unroll
                    for (int d = 0; d < 2; ++d)
#pragma unroll
                        for (int r = 0; r < 16; ++r) oA[d][r] *= al;
                }
                __builtin_amdgcn_sched_barrier(0);
#pragma unroll
                for (int s = 0; s < 4; ++s)
#pragma unroll
                    for (int d = 0; d < 2; ++d) oA[d] = __builtin_amdgcn_mfma_f32_32x32x16_bf16(vf[d][s], pf[s], oA[d], 0, 0, 0);
            }
        };
        if (CROSS) {
            gload(0); lstore(0);
            __syncthreads();
            for (int t = 0; t < NT; ++t) {
                const int buf = t & 1;
                f32x16 pa, pb;
                qk(buf, pa, pb, 0.f);
                const float al = sm(t, buf, pa, pb, false);
                pv(buf, pa, pb, al);
                if (t + 1 < NT) { gload(t + 1); lstore(buf ^ 1); }
                TILE_BAR();
            }
        } else {
            gload(0); lstore(0); gload(1); lstore(1);
            gload(2); gloadB(3);
            __syncthreads();
            if (DIFF) bias_far = ((LAS float*)(lds + C::BT))[128];
            const int NTW = (q0w + 31) / 64 + 1;
            constexpr bool lead = LEAD;
            f32x16 ca, cb, na, nb; bool cnear = isnear(0), nnear = false; float cal = 1.f;
            qk(0, ca, cb, (DIFF && !cnear) ? bias_far : 0.f);
            if (lead) cal = sm(0, 0, ca, cb, cnear);
            int s0 = 0, s1 = 1, s2 = 2;
            auto period = [&](int t, f32x16& xa, f32x16& xb, bool& xnear, f32x16& ya, f32x16& yb, bool& ynear) {
                const bool have_next = (t + 1 < NTW);
                if (lead) {
                    if (have_next) { ynear = isnear(s1); qk(s1, ya, yb, (DIFF && !ynear) ? bias_far : 0.f); }
                    if (t < NTW) pv(s0, xa, xb, cal);
                    if (have_next) cal = sm(t + 1, s1, ya, yb, ynear);
                } else {
                    if (t < NTW) cal = sm(t, s0, xa, xb, xnear);
                    if (have_next) { ynear = isnear(s1); qk(s1, ya, yb, (DIFF && !ynear) ? bias_far : 0.f); }
                    if (t < NTW) pv(s0, xa, xb, cal);
                }
                { const int tmp = s0; s0 = s1; s1 = s2; s2 = tmp; }
            };
            int t = 0;
            for (; t + 5 < NT; t += 2) {
                lstore(s2); gload(t + 4);
                period(t, ca, cb, cnear, na, nb, nnear);
                TILE_BAR();
                lstoreB(s2); gloadB(t + 5);
                period(t + 1, na, nb, nnear, ca, cb, cnear);
                TILE_BAR();
            }
            for (; t < NT; t += 2) {
                if (t + 2 < NT) { lstore(s2); if (t + 4 < NT) gload(t + 4); }
                period(t, ca, cb, cnear, na, nb, nnear);
                TILE_BAR();
                if (t + 3 < NT) { lstoreB(s2); if (t + 5 < NT) gloadB(t + 5); }
                period(t + 1, na, nb, nnear, ca, cb, cnear);
                TILE_BAR();
            }
        }
        il = 1.f / swapadd(l1);
        if (DIFF) { if (mp == 0) {
#pragma unroll
            for (int d = 0; d < 2; ++d)
#pragma unroll
                for (int r = 0; r < 16; ++r) osv[(d * 16 + r) * 64] = oA[d][r] * il; } }
    }
    GAS bf16* orow = P.O + (rowb + qi) * P.op + (CROSS ? h * 256 + dhalf * 128 : h * 64);
    if (!DIFF) {
#pragma unroll
        for (int d = 0; d < ND; ++d)
#pragma unroll
            for (int g = 0; g < 4; ++g) { v2u v; v.x = cvtpk(oA[d][4 * g] * il, oA[d][4 * g + 1] * il); v.y = cvtpk(oA[d][4 * g + 2] * il, oA[d][4 * g + 3] * il); *(GAS v2u*)(orow + 32 * d + 8 * g + 4 * hi) = v; }
    } else {
        const float lam = P.lams[0], lam_init = P.lams[1];
        const float i2 = lam * il;
        float ss = 0.f;
#pragma unroll
        for (int d = 0; d < 2; ++d)
#pragma unroll
            for (int r = 0; r < 16; ++r) { const float v = osv[(d * 16 + r) * 64] - oA[d][r] * i2; oA[d][r] = v; ss += v * v; }
        ss = swapadd(ss);
        const float rs = __builtin_amdgcn_rsqf(ss * (1.f / 64.f) + 1e-6f) * (1.f - lam_init);
        const LAS float* dn = (const LAS float*)(lds + C::DN);
#pragma unroll
        for (int d = 0; d < 2; ++d)
#pragma unroll
            for (int g = 0; g < 4; ++g) { const int c = 32 * d + 8 * g + 4 * hi; const f32x4 gn = *(const LAS f32x4*)(dn + c);
                v2u v; v.x = cvtpk(oA[d][4 * g] * rs * gn[0], oA[d][4 * g + 1] * rs * gn[1]); v.y = cvtpk(oA[d][4 * g + 2] * rs * gn[2], oA[d][4 * g + 3] * rs * gn[3]); *(GAS v2u*)(orow + c) = v; }
    }
}

__device__ __forceinline__ int wave_max_i(int v) {
    { const int o = __builtin_amdgcn_update_dpp(0, v, 0xB1, 0xF, 0xF, true); v = o > v ? o : v; }
    { const int o = __builtin_amdgcn_update_dpp(0, v, 0x4E, 0xF, 0xF, true); v = o > v ? o : v; }
    { const int o = __builtin_amdgcn_update_dpp(0, v, 0x141, 0xF, 0xF, true); v = o > v ? o : v; }
    { const int o = __builtin_amdgcn_update_dpp(0, v, 0x140, 0xF, 0xF, true); v = o > v ? o : v; }
    { int a = v, b = v; asm volatile("v_nop\n\tv_nop\n\tv_permlane16_swap_b32 %0, %1" : "+v"(a), "+v"(b)); v = a > b ? a : b; }
    { int a = v, b = v; asm volatile("v_nop\n\tv_nop\n\tv_permlane32_swap_b32 %0, %1" : "+v"(a), "+v"(b)); v = a > b ? a : b; }
    return v;
}
template <int KIND> struct AK2 {
    static constexpr bool DIFF = KIND == 1;
    static constexpr int HW = KIND == 0 ? 96 : 64, NKS = KIND == 0 ? 6 : 2, KP = KIND == 0 ? 208 : 144;
    static constexpr int CPK = HW / 8, KCH = (128 * CPK) / 512, VCH = 2;
    static constexpr int KB = 128 * KP, VB = 2 * 8192;
    static constexpr int K0 = 0, V0 = 2 * KB, POS = V0 + 2 * VB, PMX = POS + 1024, BT = PMX + 16, DN = BT + 528, OSV = (DN + 256 + 15) & ~15, END = OSV + (DIFF ? 8 * 8192 : 0);
};
static_assert(AK2<0>::END <= RING_BYTES && AK2<1>::END <= RING_BYTES, "attention LDS (128-key tiles)");
template <int KIND>
__device__ __forceinline__ void attn_unit2(const AttnP& P, int b, int h, int qb, LAS unsigned char* lds, int tid, int wave, int lane) {
    lane = lane_id_v(); tid = (wave << 6) | lane;
    typedef AK2<KIND> C;
    constexpr bool DIFF = C::DIFF;
    constexpr int HW = C::HW, NKS = C::NKS, KP = C::KP, CPK = C::CPK, KCH = C::KCH, VCH = C::VCH;
    const int r32 = lane & 31, hi = lane >> 5;
    const size_t rowb = (size_t)b * S;
    const int q0w = qb * 256 + wave * 32, qi = q0w + r32;
    int pq = 0; float bias_far = 0.f;
    __syncthreads();
    if (DIFF) {
        pq = P.pos[rowb + qi];
        if (tid < 129) ((LAS float*)(lds + C::BT))[tid] = P.btab[h * 129 + tid];
        if (tid >= 192 && tid < 256) ((LAS float*)(lds + C::DN))[tid - 192] = P.dnorm[tid - 192];
    }
    int minq = pq;
    if (DIFF) minq = __builtin_amdgcn_readfirstlane(-wave_max_i(-pq));
    const int NT = 2 * (qb + 1);
    const GAS bf16* Kb = P.K + rowb * P.kp + h * HW; const GAS bf16* Vb = P.V + rowb * P.vp + h * 64;
    const __amdgpu_buffer_rsrc_t rK = __builtin_amdgcn_make_buffer_rsrc((void*)Kb, 0, 0x7fffffff, 0x00020000), rV = __builtin_amdgcn_make_buffer_rsrc((void*)Vb, 0, 0x7fffffff, 0x00020000);
    const __amdgpu_buffer_rsrc_t rP = __builtin_amdgcn_make_buffer_rsrc((void*)(DIFF ? P.pos + rowb : (const GAS int*)Kb), 0, 0x7fffffff, 0x00020000);
    int kvo[KCH], vvo[VCH], klo[KCH], vlo[VCH];
#pragma unroll
    for (int i = 0; i < KCH; ++i) { const int c = tid + 512 * i; kvo[i] = ((c / CPK) * P.kp + (c % CPK) * 8) * 2; klo[i] = (c / CPK) * KP + (c % CPK) * 16; }
#pragma unroll
    for (int i = 0; i < VCH; ++i) { const int c = tid + 512 * i; const int key = c >> 3, part = c & 7; vvo[i] = (key * P.vp + part * 8) * 2; vlo[i] = (part >> 2) * 8192 + (key >> 3) * 512 + (key & 7) * 64 + (part & 3) * 16; }
    const int pvo = (tid & 127) * 4;
    u32x4 kr[KCH], vr[VCH]; int pkr = 0;
    auto gload = [&](int t) {
        const int ks = __builtin_amdgcn_readfirstlane(128 * t * P.kp * 2), vs = __builtin_amdgcn_readfirstlane(128 * t * P.vp * 2);
#pragma unroll
        for (int i = 0; i < KCH; ++i) kr[i] = __builtin_amdgcn_raw_buffer_load_b128(rK, kvo[i], ks, 0);
#pragma unroll
        for (int i = 0; i < VCH; ++i) vr[i] = __builtin_amdgcn_raw_buffer_load_b128(rV, vvo[i], vs, 0);
        if (DIFF) pkr = __builtin_amdgcn_raw_buffer_load_b32(rP, pvo, __builtin_amdgcn_readfirstlane(128 * t * 4), 0);
    };
    auto lstore = [&](int buf) {
        LAS unsigned char* kb_ = lds + C::K0 + buf * C::KB; LAS unsigned char* vb_ = lds + C::V0 + buf * C::VB;
#pragma unroll
        for (int i = 0; i < KCH; ++i) *(LAS u32x4*)(kb_ + klo[i]) = kr[i];
#pragma unroll
        for (int i = 0; i < VCH; ++i) *(LAS u32x4*)(vb_ + vlo[i]) = vr[i];
        if (DIFF) { ((LAS int*)(lds + C::POS + buf * 512))[tid & 127] = pkr;
            if (tid < 128) { const int mk_ = wave_max_i(pkr); if (lane == 0) ((LAS int*)(lds + C::PMX))[buf * 2 + wave] = mk_; } }
    };
    LAS float* osv = (LAS float*)(lds + C::OSV) + wave * 2048 + lane;
    float il = 0.f;
    f32x16 oA[2];
#pragma unroll 1
    for (int mp = 0; mp < (DIFF ? 2 : 1); ++mp) {
        bf16x8 qf[NKS];
        { const GAS bf16* qrow = P.Q + (rowb + qi) * P.qp + h * HW + mp * 32;
#pragma unroll
          for (int s = 0; s < NKS; ++s) qf[s] = *(const GAS bf16x8*)(qrow + 16 * s + 8 * hi);
          if (KIND == 0) {
              const GAS float* rp = P.rope + (rowb + qi) * 32 + 8 * hi;
              const f32x4 c0 = *(const GAS f32x4*)rp, c1 = *(const GAS f32x4*)(rp + 4), s0 = *(const GAS f32x4*)(rp + 16), s1 = *(const GAS f32x4*)(rp + 20);
              const u32x4 a = __builtin_bit_cast(u32x4, qf[NKS - 2]), bq = __builtin_bit_cast(u32x4, qf[NKS - 1]); u32x4 ra, rb;
#pragma unroll
              for (int w = 0; w < 4; ++w) { const float cl = w < 2 ? c0[2 * w] : c1[2 * w - 4], ch = w < 2 ? c0[2 * w + 1] : c1[2 * w - 3], sl = w < 2 ? s0[2 * w] : s1[2 * w - 4], sh = w < 2 ? s0[2 * w + 1] : s1[2 * w - 3];
                  const float x1l = bflo(a[w]), x1h = bfhi(a[w]), x2l = bflo(bq[w]), x2h = bfhi(bq[w]);
                  ra[w] = cvtpk(x1l * cl - x2l * sl, x1h * ch - x2h * sh); rb[w] = cvtpk(x1l * sl + x2l * cl, x1h * sh + x2h * ch); }
              qf[NKS - 2] = __builtin_bit_cast(bf16x8, ra); qf[NKS - 1] = __builtin_bit_cast(bf16x8, rb);
          } }
        __syncthreads();
        float m1 = 0.f, l1 = 0.f;
        f32x16 negm;
#pragma unroll
        for (int r = 0; r < 16; ++r) negm[r] = 0.f;
#pragma unroll
        for (int d = 0; d < 2; ++d)
#pragma unroll
            for (int r = 0; r < 16; ++r) oA[d][r] = 0.f;
        gload(0); lstore(0);
        if (NT > 1) gload(1);
        __syncthreads();
        if (DIFF) { bias_far = ((LAS float*)(lds + C::BT))[128];
#pragma unroll
            for (int r = 0; r < 16; ++r) negm[r] = bias_far; }
        const int NTW = (q0w + 31) / 128 + 1;
        auto compute = [&](int t, int buf) {
            const int k0 = 128 * t;
            const LAS unsigned char* kb_ = lds + C::K0 + buf * C::KB + r32 * KP + hi * 16 + mp * 64;
            const LAS unsigned char* vb_ = lds + C::V0 + buf * C::VB + ((lane >> 4) & 1) * 32 + (lane & 3) * 8 + (4 * hi + ((lane & 15) >> 2)) * 64;
            bool nearb = false;
            if (DIFF) { const LAS int* pm = (const LAS int*)(lds + C::PMX) + buf * 2; const int m0 = __builtin_amdgcn_readfirstlane(pm[0]), m1_ = __builtin_amdgcn_readfirstlane(pm[1]); nearb = (minq - (m0 > m1_ ? m0 : m1_)) < 128; }
            f32x16 sc[4];
            if (DIFF) { if (nearb) {
#pragma unroll
                for (int g = 0; g < 4; ++g)
#pragma unroll
                    for (int r = 0; r < 16; ++r) sc[g][r] = -m1; } }
            if (!DIFF) {
                bf16x8 kq[4 * NKS];
#pragma unroll
                for (int i = 0; i < 4 * NKS; ++i) kq[i] = *(const LAS bf16x8*)(kb_ + 32 * (i & 3) * KP + (i >> 2) * 32);
#pragma unroll
                for (int i = 0; i < 4 * NKS; ++i) sc[i & 3] = __builtin_amdgcn_mfma_f32_32x32x16_bf16(kq[i], qf[i >> 2], i < 4 ? negm : sc[i & 3], 0, 0, 0);
                __builtin_amdgcn_sched_group_barrier(0x100, 4, 0);
#pragma unroll
                for (int i = 0; i < 4 * NKS - 4; ++i) { __builtin_amdgcn_sched_group_barrier(0x008, 1, 0); __builtin_amdgcn_sched_group_barrier(0x100, 1, 0); }
                __builtin_amdgcn_sched_group_barrier(0x008, 4, 0);
                __builtin_amdgcn_sched_barrier(0);
            } else {
            constexpr int HB = NKS > 3 ? 3 : NKS;
#pragma unroll
            for (int s0_ = 0; s0_ < NKS; s0_ += HB) {
                bf16x8 kf[4][HB];
#pragma unroll
                for (int g = 0; g < 4; ++g)
#pragma unroll
                    for (int s = 0; s < HB; ++s) kf[g][s] = *(const LAS bf16x8*)(kb_ + 32 * g * KP + (s0_ + s) * 32);
                __builtin_amdgcn_sched_barrier(0);
#pragma unroll
                for (int s = 0; s < HB; ++s)
#pragma unroll
                    for (int g = 0; g < 4; ++g) {
                        if (s0_ + s == 0 && !(DIFF && nearb)) sc[g] = __builtin_amdgcn_mfma_f32_32x32x16_bf16(kf[g][s], qf[s0_ + s], negm, 0, 0, 0);
                        else sc[g] = __builtin_amdgcn_mfma_f32_32x32x16_bf16(kf[g][s], qf[s0_ + s], sc[g], 0, 0, 0); }
                __builtin_amdgcn_sched_barrier(0);
            }
            }
            if (DIFF) { if (nearb) {
                const LAS int* pk = (const LAS int*)(lds + C::POS + buf * 512); const LAS float* bt = (const LAS float*)(lds + C::BT);
#pragma unroll
                for (int g = 0; g < 4; ++g)
#pragma unroll
                    for (int r = 0; r < 16; ++r) { int n0 = pq - pk[32 * g + crow(r, hi)]; n0 = n0 < 0 ? 0 : (n0 > 128 ? 128 : n0); sc[g][r] += bt[n0]; }
            } }
            asm volatile("s_nop 15\n\ts_nop 7" : "+v"(sc[0]), "+v"(sc[1]), "+v"(sc[2]), "+v"(sc[3]));
            if (k0 + 127 > q0w) {
#pragma unroll
                for (int g = 0; g < 4; ++g)
#pragma unroll
                    for (int r = 0; r < 16; ++r) { if (k0 + 32 * g + crow(r, hi) > qi) sc[g][r] = -1e30f; }
            }
            const float mx = swapmax(vmax3(max32(sc[0], sc[1]), max32(sc[2], sc[3]), -1e30f));
            const bool up = (t == 0) || mx > 8.0f;
            float al = 1.f;
            if (__builtin_amdgcn_ballot_w64(up) != 0ull) {
                const float dl = up ? mx : 0.f; al = __builtin_amdgcn_exp2f(-dl); l1 *= al; m1 += dl;
#pragma unroll
                for (int r = 0; r < 16; ++r) negm[r] -= dl;
#pragma unroll
                for (int g = 0; g < 4; ++g)
#pragma unroll
                    for (int r = 0; r < 16; ++r) sc[g][r] -= dl;
            }
            float ls = 0.f;
#pragma unroll
            for (int g = 0; g < 4; ++g)
#pragma unroll
                for (int r = 0; r < 16; ++r) { sc[g][r] = __builtin_amdgcn_exp2f(sc[g][r]); ls += sc[g][r]; }
            l1 += ls;
            bf16x8 pf[8];
#pragma unroll
            for (int g = 0; g < 4; ++g) { pf[2 * g] = pack8(sc[g], 0); pf[2 * g + 1] = pack8(sc[g], 8); }
            if (__builtin_amdgcn_ballot_w64(al != 1.0f) != 0ull) {
#pragma unroll
                for (int d = 0; d < 2; ++d)
#pragma unroll
                    for (int r = 0; r < 16; ++r) oA[d][r] *= al;
            }
            if (!DIFF) {
                bf16x8 vq[16];
#pragma unroll
                for (int i = 0; i < 16; ++i) { const int d = i & 1, s = i >> 1; const s16x4 lo = vtr(vb_ + d * 8192 + s * 1024), hh = vtr(vb_ + d * 8192 + s * 1024 + 512); vq[i] = (bf16x8){lo[0], lo[1], lo[2], lo[3], hh[0], hh[1], hh[2], hh[3]}; }
#pragma unroll
                for (int i = 0; i < 16; ++i) oA[i & 1] = __builtin_amdgcn_mfma_f32_32x32x16_bf16(vq[i], pf[i >> 1], oA[i & 1], 0, 0, 0);
                __builtin_amdgcn_sched_group_barrier(0x100, 4, 0);
#pragma unroll
                for (int i = 0; i < 14; ++i) { __builtin_amdgcn_sched_group_barrier(0x008, 1, 0); __builtin_amdgcn_sched_group_barrier(0x100, 2, 0); }
                __builtin_amdgcn_sched_group_barrier(0x008, 2, 0);
                __builtin_amdgcn_sched_barrier(0);
            } else {
#pragma unroll
            for (int d = 0; d < 2; ++d) {
                bf16x8 vf[8];
#pragma unroll
                for (int s = 0; s < 8; ++s) { const s16x4 lo = vtr(vb_ + d * 8192 + s * 1024), hh = vtr(vb_ + d * 8192 + s * 1024 + 512); vf[s] = (bf16x8){lo[0], lo[1], lo[2], lo[3], hh[0], hh[1], hh[2], hh[3]}; }
                __builtin_amdgcn_sched_barrier(0);
#pragma unroll
                for (int s = 0; s < 8; ++s) oA[d] = __builtin_amdgcn_mfma_f32_32x32x16_bf16(vf[s], pf[s], oA[d], 0, 0, 0);
                __builtin_amdgcn_sched_barrier(0);
            }
            }
        };
        int t = 0;
        for (; t + 2 < NT; ++t) {
            const int buf = t & 1;
            if (t < NTW) compute(t, buf);
            lstore(buf ^ 1); gload(t + 2);
            TILE_BAR();
        }
        for (; t < NT; ++t) {
            const int buf = t & 1;
            if (t < NTW) compute(t, buf);
            if (t + 1 < NT) lstore(buf ^ 1);
            TILE_BAR();
        }
        il = 1.f / swapadd(l1);
        if (DIFF) { if (mp == 0) {
#pragma unroll
            for (int d = 0; d < 2; ++d)
#pragma unroll
                for (int r = 0; r < 16; ++r) osv[(d * 16 + r) * 64] = oA[d][r] * il; } }
    }
    GAS bf16* orow = P.O + (rowb + qi) * P.op + h * 64;
    if (!DIFF) {
#pragma unroll
        for (int d = 0; d < 2; ++d)
#pragma unroll
            for (int g = 0; g < 4; ++g) { v2u v; v.x = cvtpk(oA[d][4 * g] * il, oA[d][4 * g + 1] * il); v.y = cvtpk(oA[d][4 * g + 2] * il, oA[d][4 * g + 3] * il); *(GAS v2u*)(orow + 32 * d + 8 * g + 4 * hi) = v; }
    } else {
        const float lam = P.lams[0], lam_init = P.lams[1];
        const float i2 = lam * il;
        float ss = 0.f;
#pragma unroll
        for (int d = 0; d < 2; ++d)
#pragma unroll
            for (int r = 0; r < 16; ++r) { const float v = osv[(d * 16 + r) * 64] - oA[d][r] * i2; oA[d][r] = v; ss += v * v; }
        ss = swapadd(ss);
        const float rs = __builtin_amdgcn_rsqf(ss * (1.f / 64.f) + 1e-6f) * (1.f - lam_init);
        const LAS float* dn = (const LAS float*)(lds + C::DN);
#pragma unroll
        for (int d = 0; d < 2; ++d)
#pragma unroll
            for (int g = 0; g < 4; ++g) { const int c = 32 * d + 8 * g + 4 * hi; const f32x4 gn = *(const LAS f32x4*)(dn + c);
                v2u v; v.x = cvtpk(oA[d][4 * g] * rs * gn[0], oA[d][4 * g + 1] * rs * gn[1]); v.y = cvtpk(oA[d][4 * g + 2] * rs * gn[2], oA[d][4 * g + 3] * rs * gn[3]); *(GAS v2u*)(orow + c) = v; }
    }
}

struct AKD {
    static constexpr int KP = 144, KB = 64 * KP, VB = 2 * 4096;
    static constexpr int K0 = 0, V0 = 2 * KB, POS = V0 + 2 * VB, PMX = POS + 512, BT = PMX + 16, DN = BT + 528, END = DN + 256;
};
static_assert(AKD::END <= RING_BYTES, "attention LDS (merged differential maps)");
__device__ __forceinline__ void attn_diff_unit(const AttnP& P, int b, int h, int qb, LAS unsigned char* lds, int wave) {
    const int lane = lane_id_v(), tid = (wave << 6) | lane;
    typedef AKD C;
    constexpr int KP = C::KP;
    const int r32 = lane & 31, hi = lane >> 5;
    const size_t rowb = (size_t)b * S;
    const int q0w = qb * 256 + wave * 32, qi = q0w + r32;
    __syncthreads();
    const int pq = P.pos[rowb + qi];
    if (tid < 129) ((LAS float*)(lds + C::BT))[tid] = P.btab[h * 129 + tid];
    if (tid >= 192 && tid < 256) ((LAS float*)(lds + C::DN))[tid - 192] = P.dnorm[tid - 192];
    const int minq = __builtin_amdgcn_readfirstlane(-wave_max_i(-pq));
    const int NT = 4 * (qb + 1);
    const GAS bf16* Kb = P.K + rowb * P.kp + h * 64; const GAS bf16* Vb = P.V + rowb * P.vp + h * 64;
    const __amdgpu_buffer_rsrc_t rK = __builtin_amdgcn_make_buffer_rsrc((void*)Kb, 0, 0x7fffffff, 0x00020000), rV = __builtin_amdgcn_make_buffer_rsrc((void*)Vb, 0, 0x7fffffff, 0x00020000);
    const __amdgpu_buffer_rsrc_t rP = __builtin_amdgcn_make_buffer_rsrc((void*)(P.pos + rowb), 0, 0x7fffffff, 0x00020000);
    const int skey = tid >> 3, spart = tid & 7;
    const int kvo = (skey * P.kp + spart * 8) * 2, vvo = (skey * P.vp + spart * 8) * 2, klo = skey * KP + spart * 16, vlo = (spart >> 2) * 4096 + (skey >> 3) * 512 + (skey & 7) * 64 + (spart & 3) * 16;
    const int pvo = (tid & 63) * 4;
    u32x4 kr, vr; int pkr = 0;
    auto gload = [&](int t) {
        kr = __builtin_amdgcn_raw_buffer_load_b128(rK, kvo, __builtin_amdgcn_readfirstlane(64 * t * P.kp * 2), 0);
        vr = __builtin_amdgcn_raw_buffer_load_b128(rV, vvo, __builtin_amdgcn_readfirstlane(64 * t * P.vp * 2), 0);
        pkr = __builtin_amdgcn_raw_buffer_load_b32(rP, pvo, __builtin_amdgcn_readfirstlane(64 * t * 4), 0);
    };
    auto lstore = [&](int buf) {
        *(LAS u32x4*)(lds + C::K0 + buf * C::KB + klo) = kr; *(LAS u32x4*)(lds + C::V0 + buf * C::VB + vlo) = vr;
        if (tid < 64) { ((LAS int*)(lds + C::POS + buf * 256))[tid] = pkr; const int mk_ = wave_max_i(pkr); if (lane == 0) ((LAS int*)(lds + C::PMX))[buf] = mk_; }
    };
    gload(0);
    bf16x8 qf[2][2];
    { const GAS bf16* qrow = P.Q + (rowb + qi) * P.qp + h * 64;
#pragma unroll
      for (int mp = 0; mp < 2; ++mp)
#pragma unroll
          for (int s_ = 0; s_ < 2; ++s_) qf[mp][s_] = *(const GAS bf16x8*)(qrow + 32 * mp + 16 * s_ + 8 * hi); }
    __syncthreads();
    lstore(0);
    if (NT > 1) gload(1);
    __syncthreads();
    const float bias_far = ((LAS float*)(lds + C::BT))[128];
    float m_[2] = {0.f, 0.f}, l_[2] = {0.f, 0.f};
    f32x16 negm[2], oA[2][2];
#pragma unroll
    for (int mp = 0; mp < 2; ++mp) {
#pragma unroll
        for (int r = 0; r < 16; ++r) { negm[mp][r] = bias_far; oA[mp][0][r] = 0.f; oA[mp][1][r] = 0.f; } }
    const int NTW = (q0w + 31) / 64 + 1;
    auto compute = [&](int t, int buf) {
        const int k0 = 64 * t;
        const LAS unsigned char* kb_ = lds + C::K0 + buf * C::KB + r32 * KP + hi * 16;
        const LAS unsigned char* vb_ = lds + C::V0 + buf * C::VB + ((lane >> 4) & 1) * 32 + (lane & 3) * 8 + (4 * hi + ((lane & 15) >> 2)) * 64;
        const bool nearb = (minq - __builtin_amdgcn_readfirstlane(((const LAS int*)(lds + C::PMX))[buf])) < 128;
        const bool diag = k0 + 63 > q0w;
        bf16x8 pf[2][4];
#pragma unroll
        for (int mp = 0; mp < 2; ++mp) {
            f32x16 sc[2];
            bf16x8 kf[2][2];
#pragma unroll
            for (int g = 0; g < 2; ++g)
#pragma unroll
                for (int s_ = 0; s_ < 2; ++s_) kf[g][s_] = *(const LAS bf16x8*)(kb_ + 32 * g * KP + mp * 64 + s_ * 32);
            if (nearb) {
#pragma unroll
                for (int g = 0; g < 2; ++g) {
#pragma unroll
                    for (int r = 0; r < 16; ++r) sc[g][r] = -m_[mp];
#pragma unroll
                    for (int s_ = 0; s_ < 2; ++s_) sc[g] = __builtin_amdgcn_mfma_f32_32x32x16_bf16(kf[g][s_], qf[mp][s_], sc[g], 0, 0, 0); }
                const LAS int* pk = (const LAS int*)(lds + C::POS + buf * 256); const LAS float* bt = (const LAS float*)(lds + C::BT);
#pragma unroll
                for (int g = 0; g < 2; ++g)
#pragma unroll
                    for (int r = 0; r < 16; ++r) { int n0 = pq - pk[32 * g + crow(r, hi)]; n0 = n0 < 0 ? 0 : (n0 > 128 ? 128 : n0); sc[g][r] += bt[n0]; }
            } else {
#pragma unroll
                for (int g = 0; g < 2; ++g) { sc[g] = __builtin_amdgcn_mfma_f32_32x32x16_bf16(kf[g][0], qf[mp][0], negm[mp], 0, 0, 0); sc[g] = __builtin_amdgcn_mfma_f32_32x32x16_bf16(kf[g][1], qf[mp][1], sc[g], 0, 0, 0); }
            }
            asm volatile("s_nop 15\n\ts_nop 7" : "+v"(sc[0]), "+v"(sc[1]));
            if (diag) {
#pragma unroll
                for (int g = 0; g < 2; ++g)
#pragma unroll
                    for (int r = 0; r < 16; ++r) { if (k0 + 32 * g + crow(r, hi) > qi) sc[g][r] = -1e30f; }
            }
            const float mx = swapmax(vmax3(max32(sc[0], sc[1]), -1e30f, -1e30f));
            const bool up = (t == 0) || mx > 8.0f;
            if (__builtin_amdgcn_ballot_w64(up) != 0ull) {
                const float dl = up ? mx : 0.f; const float al = __builtin_amdgcn_exp2f(-dl); l_[mp] *= al; m_[mp] += dl;
#pragma unroll
                for (int r = 0; r < 16; ++r) negm[mp][r] -= dl;
#pragma unroll
                for (int g = 0; g < 2; ++g)
#pragma unroll
                    for (int r = 0; r < 16; ++r) sc[g][r] -= dl;
#pragma unroll
                for (int d = 0; d < 2; ++d)
#pragma unroll
                    for (int r = 0; r < 16; ++r) oA[mp][d][r] *= al;
            }
            float ls = 0.f;
#pragma unroll
            for (int g = 0; g < 2; ++g)
#pragma unroll
                for (int r = 0; r < 16; ++r) { sc[g][r] = __builtin_amdgcn_exp2f(sc[g][r]); ls += sc[g][r]; }
            l_[mp] += ls;
#pragma unroll
            for (int g = 0; g < 2; ++g) { pf[mp][2 * g] = pack8(sc[g], 0); pf[mp][2 * g + 1] = pack8(sc[g], 8); }
        }
        { bf16x8 vq[8];
#pragma unroll
          for (int i = 0; i < 8; ++i) { const int d = i & 1, s_ = i >> 1; const s16x4 lo = vtr(vb_ + d * 4096 + s_ * 1024), hh = vtr(vb_ + d * 4096 + s_ * 1024 + 512); vq[i] = (bf16x8){lo[0], lo[1], lo[2], lo[3], hh[0], hh[1], hh[2], hh[3]}; }
#pragma unroll
          for (int i = 0; i < 8; ++i) { const int d = i & 1, s_ = i >> 1; oA[0][d] = __builtin_amdgcn_mfma_f32_32x32x16_bf16(vq[i], pf[0][s_], oA[0][d], 0, 0, 0); oA[1][d] = __builtin_amdgcn_mfma_f32_32x32x16_bf16(vq[i], pf[1][s_], oA[1][d], 0, 0, 0); }
          __builtin_amdgcn_sched_group_barrier(0x100, 4, 0);
#pragma unroll
          for (int i = 0; i < 6; ++i) { __builtin_amdgcn_sched_group_barrier(0x008, 2, 0); __builtin_amdgcn_sched_group_barrier(0x100, 2, 0); }
          __builtin_amdgcn_sched_group_barrier(0x008, 4, 0);
          __builtin_amdgcn_sched_barrier(0); }
    };
#pragma unroll 1
    for (int t = 0; t < NT; ++t) {
        const int buf = t & 1;
        if (t < NTW) compute(t, buf);
        if (t + 1 < NT) lstore(buf ^ 1);
        if (t + 2 < NT) gload(t + 2);
        TILE_BAR();
    }
    const float il1 = 1.f / swapadd(l_[0]), il2 = 1.f / swapadd(l_[1]);
    const float lam = P.lams[0], lam_init = P.lams[1];
    const float i2 = lam * il2;
    float ss = 0.f;
#pragma unroll
    for (int d = 0; d < 2; ++d)
#pragma unroll
        for (int r = 0; r < 16; ++r) { const float v = oA[0][d][r] * il1 - oA[1][d][r] * i2; oA[0][d][r] = v; ss += v * v; }
    ss = swapadd(ss);
    const float rs = __builtin_amdgcn_rsqf(ss * (1.f / 64.f) + 1e-6f) * (1.f - lam_init);
    const LAS float* dn = (const LAS float*)(lds + C::DN);
    GAS bf16* orow = P.O + (rowb + qi) * P.op + h * 64;
#pragma unroll
    for (int d = 0; d < 2; ++d)
#pragma unroll
        for (int g = 0; g < 4; ++g) { const int c = 32 * d + 8 * g + 4 * hi; const f32x4 gn = *(const LAS f32x4*)(dn + c);
            v2u v; v.x = cvtpk(oA[0][d][4 * g] * rs * gn[0], oA[0][d][4 * g + 1] * rs * gn[1]); v.y = cvtpk(oA[0][d][4 * g + 2] * rs * gn[2], oA[0][d][4 * g + 3] * rs * gn[3]); *(GAS v2u*)(orow + c) = v; }
}

__device__ __forceinline__ void attn_phase(const AttnP& PM, const AttnP& PD, LAS unsigned char* lds, int tid, int wave, int lane, int vcu, int G, int only = -1) {
    for (int i = vcu; i < 512; i += G) {
        if (only >= 0 && (i >> 8) != only) continue;
        const int kind = i >> 8, c = i & 255, bh = c >> 4, s = c & 15;
        if (kind == 0) {
#pragma unroll 1
            for (int k = 0; k < 2; ++k) attn_unit2<0>(PM, bh >> 2, bh & 3, k ? 31 - s : s, lds, tid, wave, lane);
        } else {
#pragma unroll 1
            for (int k = 0; k < 2; ++k) attn_diff_unit(PD, bh >> 2, bh & 3, k ? 31 - s : s, lds, wave);
        }
    }
}
__device__ __forceinline__ float cx_max16(const f32x16& p) { return fmaxf(fmaxf(fmaxf(fmaxf(p[0], p[1]), fmaxf(p[2], p[3])), fmaxf(fmaxf(p[4], p[5]), fmaxf(p[6], p[7]))), fmaxf(fmaxf(fmaxf(p[8], p[9]), fmaxf(p[10], p[11])), fmaxf(fmaxf(p[12], p[13]), fmaxf(p[14], p[15])))); }
__device__ __forceinline__ void cross_unit2(const AttnP& P, int b, int h, int qb, LAS unsigned char* lds, int wave) {
    const int lane = lane_id_v(), tid = (wave << 6) | lane;
    constexpr int KP = 528;
    const int r32 = lane & 31, hi = lane >> 5;
    const size_t rowb = (size_t)b * S, rowk = (size_t)b * MEM;
    const int qi = qb * 256 + wave * 32 + r32;
    const GAS bf16* Kb = P.K + rowk * P.kp + h * 256; const GAS bf16* Vb = P.V + rowk * P.vp + h * 256;
    const __amdgpu_buffer_rsrc_t rK = __builtin_amdgcn_make_buffer_rsrc((void*)Kb, 0, 0x7fffffff, 0x00020000), rV = __builtin_amdgcn_make_buffer_rsrc((void*)Vb, 0, 0x7fffffff, 0x00020000);
    const GAS bf16* qrow = P.Q + (rowb + qi) * P.qp + h * 256 + 8 * hi;
    bf16x8 qf[4];
#pragma unroll
    for (int s = 0; s < 4; ++s) qf[s] = *(const GAS bf16x8*)(qrow + 16 * s);
    { u32x4 st[16];
#pragma unroll
      for (int i = 0; i < 16; ++i) { const int c = tid + 512 * i; st[i] = __builtin_amdgcn_raw_buffer_load_b128(rK, ((c >> 5) * P.kp + (c & 31) * 8) * 2, 0, 0); }
      TILE_BAR();
#pragma unroll
      for (int i = 0; i < 16; ++i) { const int c = tid + 512 * i; *(LAS u32x4*)(lds + (c >> 5) * KP + (c & 31) * 16) = st[i]; } }
    __syncthreads();
    f32x16 sc[8];
#pragma unroll
    for (int g = 0; g < 8; ++g)
#pragma unroll
        for (int r = 0; r < 16; ++r) sc[g][r] = 0.f;
    const LAS unsigned char* kb_ = lds + r32 * KP + hi * 16;
#pragma unroll
    for (int c = 0; c < 4; ++c) {
        bf16x8 qn[4];
        if (c + 1 < 4) {
#pragma unroll
            for (int s = 0; s < 4; ++s) qn[s] = *(const GAS bf16x8*)(qrow + 64 * (c + 1) + 16 * s); }
        { bf16x8 kq[32];
#pragma unroll
          for (int i = 0; i < 32; ++i) kq[i] = *(const LAS bf16x8*)(kb_ + 32 * (i & 7) * KP + (4 * c + (i >> 3)) * 32);
#pragma unroll
          for (int i = 0; i < 32; ++i) sc[i & 7] = __builtin_amdgcn_mfma_f32_32x32x16_bf16(kq[i], qf[i >> 3], sc[i & 7], 0, 0, 0);
          __builtin_amdgcn_sched_group_barrier(0x100, 4, 0);
#pragma unroll
          for (int i = 0; i < 28; ++i) { __builtin_amdgcn_sched_group_barrier(0x008, 1, 0); __builtin_amdgcn_sched_group_barrier(0x100, 1, 0); }
          __builtin_amdgcn_sched_group_barrier(0x008, 4, 0);
          __builtin_amdgcn_sched_barrier(0); }
        if (c + 1 < 4) {
#pragma unroll
            for (int s = 0; s < 4; ++s) qf[s] = qn[s]; }
    }
    float m = fmaxf(fmaxf(fmaxf(cx_max16(sc[0]), cx_max16(sc[1])), fmaxf(cx_max16(sc[2]), cx_max16(sc[3]))), fmaxf(fmaxf(cx_max16(sc[4]), cx_max16(sc[5])), fmaxf(cx_max16(sc[6]), cx_max16(sc[7]))));
    m = swapmax(m);
    float l = 0.f;
    bf16x8 pf[16];
#pragma unroll
    for (int g = 0; g < 8; ++g) {
#pragma unroll
        for (int r = 0; r < 16; ++r) { sc[g][r] = __builtin_amdgcn_exp2f(sc[g][r] - m); l += sc[g][r]; }
        pf[2 * g] = pack8(sc[g], 0); pf[2 * g + 1] = pack8(sc[g], 8); }
    const float il = 1.f / swapadd(l);
    { u32x4 st[16];
#pragma unroll
      for (int i = 0; i < 16; ++i) { const int c = tid + 512 * i; const int sub = c & 3, key = (c >> 2) & 255, dt = c >> 10; st[i] = __builtin_amdgcn_raw_buffer_load_b128(rV, (key * P.vp + dt * 32 + sub * 8) * 2, 0, 0); }
      TILE_BAR();
#pragma unroll
      for (int i = 0; i < 16; ++i) { const int c = tid + 512 * i; const int sub = c & 3, key = (c >> 2) & 255, dt = c >> 10; *(LAS u32x4*)(lds + dt * 16384 + (key >> 3) * 512 + (key & 7) * 64 + sub * 16) = st[i]; } }
    __syncthreads();
    const LAS unsigned char* vb_ = lds + ((lane >> 4) & 1) * 32 + (lane & 3) * 8 + (4 * hi + ((lane & 15) >> 2)) * 64;
    GAS bf16* orow = P.O + (rowb + qi) * P.op + h * 256;
#pragma unroll 1
    for (int dh = 0; dh < 2; ++dh) {
        f32x16 oA[4];
#pragma unroll
        for (int d = 0; d < 4; ++d)
#pragma unroll
            for (int r = 0; r < 16; ++r) oA[d][r] = 0.f;
#pragma unroll
        for (int d = 0; d < 4; ++d) {
            { bf16x8 vq[16];
#pragma unroll
              for (int s = 0; s < 16; ++s) { const s16x4 lo = vtr(vb_ + (4 * dh + d) * 16384 + s * 1024), hh = vtr(vb_ + (4 * dh + d) * 16384 + s * 1024 + 512); vq[s] = (bf16x8){lo[0], lo[1], lo[2], lo[3], hh[0], hh[1], hh[2], hh[3]}; }
#pragma unroll
              for (int s = 0; s < 16; ++s) oA[d] = __builtin_amdgcn_mfma_f32_32x32x16_bf16(vq[s], pf[s], oA[d], 0, 0, 0);
              __builtin_amdgcn_sched_group_barrier(0x100, 4, 0);
#pragma unroll
              for (int i = 0; i < 14; ++i) { __builtin_amdgcn_sched_group_barrier(0x008, 1, 0); __builtin_amdgcn_sched_group_barrier(0x100, 2, 0); }
              __builtin_amdgcn_sched_group_barrier(0x008, 2, 0);
              __builtin_amdgcn_sched_barrier(0); } }
#pragma unroll
        for (int d = 0; d < 4; ++d)
#pragma unroll
            for (int g = 0; g < 4; ++g) { v2u v; v.x = cvtpk(oA[d][4 * g] * il, oA[d][4 * g + 1] * il); v.y = cvtpk(oA[d][4 * g + 2] * il, oA[d][4 * g + 3] * il); *(GAS v2u*)(orow + 128 * dh + 32 * d + 8 * g + 4 * hi) = v; }
    }
}
__device__ __forceinline__ void cross_phase(const AttnP& PC, LAS unsigned char* lds, int tid, int wave, int lane, int vcu, int G) {
#pragma unroll 1
    for (int i = vcu; i < 512; i += G) { const int bh = i >> 5; cross_unit2(PC, bh >> 2, bh & 3, i & 31, lds, wave); }
}


__device__ __forceinline__ float vmax2(float a, float b) { float r; asm("v_max_f32_e32 %0, %1, %2" : "=v"(r) : "v"(a), "v"(b)); return r; }
__device__ __forceinline__ float vmin2(float a, float b) { float r; asm("v_min_f32_e32 %0, %1, %2" : "=v"(r) : "v"(a), "v"(b)); return r; }
__device__ __forceinline__ void pad16(float (&a)[16]) {
    asm volatile("s_nop 1" : "+v"(a[0]), "+v"(a[1]), "+v"(a[2]), "+v"(a[3]), "+v"(a[4]), "+v"(a[5]), "+v"(a[6]), "+v"(a[7]), "+v"(a[8]), "+v"(a[9]), "+v"(a[10]), "+v"(a[11]), "+v"(a[12]), "+v"(a[13]), "+v"(a[14]), "+v"(a[15]));
}
__device__ __forceinline__ void sort16_desc(float (&a)[16]) {
#define CE_(i, j) { const float hi_ = vmax2(a[i], a[j]), lo_ = vmin2(a[i], a[j]); a[i] = hi_; a[j] = lo_; }
    CE_(0, 1); CE_(2, 3); CE_(0, 2); CE_(1, 3); CE_(1, 2); CE_(4, 5); CE_(6, 7); CE_(4, 6); CE_(5, 7); CE_(5, 6); CE_(0, 4); CE_(2, 6); CE_(2, 4); CE_(1, 5); CE_(3, 7); CE_(3, 5); CE_(1, 2); CE_(3, 4); CE_(5, 6); CE_(8, 9); CE_(10, 11); CE_(8, 10); CE_(9, 11); CE_(9, 10); CE_(12, 13); CE_(14, 15); CE_(12, 14); CE_(13, 15); CE_(13, 14); CE_(8, 12); CE_(10, 14); CE_(10, 12); CE_(9, 13); CE_(11, 15); CE_(11, 13); CE_(9, 10); CE_(11, 12); CE_(13, 14); CE_(0, 8); CE_(4, 12); CE_(4, 8); CE_(2, 10); CE_(6, 14); CE_(6, 10); CE_(2, 4); CE_(6, 8); CE_(10, 12); CE_(1, 9); CE_(5, 13); CE_(5, 9); CE_(3, 11); CE_(7, 15); CE_(7, 11); CE_(3, 5); CE_(7, 9); CE_(11, 13); CE_(1, 2); CE_(3, 4); CE_(5, 6); CE_(7, 8); CE_(9, 10); CE_(11, 12); CE_(13, 14);
#undef CE_
}
__device__ __forceinline__ void merge16_desc(float (&a)[16], const float (&b)[16]) {
#pragma unroll
    for (int i = 0; i < 16; ++i) a[i] = vmax2(a[i], b[15 - i]);
#pragma unroll
    for (int j = 8; j > 0; j >>= 1)
#pragma unroll
        for (int i = 0; i < 16; ++i) { const int l = i ^ j; if (l > i) { const float hi_ = vmax2(a[i], a[l]), lo_ = vmin2(a[i], a[l]); a[i] = hi_; a[l] = lo_; } }
}
__device__ __forceinline__ void top16_of_64(float (&g0)[16], float (&g1)[16], float (&g2)[16], float (&g3)[16]) {
    sort16_desc(g0); sort16_desc(g1); merge16_desc(g0, g1); sort16_desc(g2); sort16_desc(g3); merge16_desc(g2, g3); merge16_desc(g0, g2);
}
__device__ __forceinline__ float embed(float v, unsigned mask, unsigned id) { return __builtin_bit_cast(float, (__builtin_bit_cast(unsigned, v) & mask) | id); }
__device__ __forceinline__ float mkcand(float x, float y, unsigned id) { return embed(x + y, 0xFFFFFF00u, id); }

__device__ __forceinline__ void swap32(float& a, float& b) { asm volatile("v_nop\n\tv_nop\n\tv_permlane32_swap_b32 %0, %1" : "+v"(a), "+v"(b)); }
struct RouteP { const GAS bf16* QP; const GAS bf16* keys; GAS int* EX; GAS float* GW; };
constexpr int RT_KP = 144, RT_KEYS = 0, RT_SCR = 256 * RT_KP, RT_END = RT_SCR + 8 * 8192;
template <class FPre>
__device__ __forceinline__ void route_phase(const RouteP& P, LAS unsigned char* lds, int tid, int wave, int lane, int vcu, int G, FPre pre) {
    asm volatile("" : "+v"(tid), "+v"(lane));
    __syncthreads();
    for (int c = tid; c < 256 * 8; c += 512) { const int row = c >> 3, part = c & 7; *(LAS u32x4*)(lds + RT_KEYS + row * RT_KP + part * 16) = *(const u32x4*)(P.keys + row * 64 + part * 8); }
    __syncthreads();
    pre();
    const int r32 = lane & 31, hi = lane >> 5;
    LAS int* scr = (LAS int*)(lds + RT_SCR + wave * 8192);
    bf16x8 qf2[2][4];
    auto ldq = [&](int un) { const size_t tq = (size_t)un * 32 + r32;
#pragma unroll
        for (int c = 0; c < 2; ++c) { const GAS bf16* q = P.QP + tq * 1024 + wave * 128 + c * 64 + 8 * hi;
#pragma unroll
            for (int s = 0; s < 4; ++s) qf2[c][s] = *(const GAS bf16x8*)(q + 16 * s); } };
    if (vcu < T / 32) ldq(vcu);
    for (int u = vcu; u < T / 32; u += G) {
        const size_t t = (size_t)u * 32 + r32; const int h = wave;
        float T2[2][16];
#pragma unroll
        for (int c = 0; c < 2; ++c) {
            const bf16x8 (&qf)[4] = qf2[c];
            f32x16 sc[4];
#pragma unroll
            for (int m = 0; m < 4; ++m) {
#pragma unroll
                for (int r = 0; r < 16; ++r) sc[m][r] = 0.f;
#pragma unroll
                for (int s = 0; s < 4; ++s) { const bf16x8 a = *(const LAS bf16x8*)(lds + RT_KEYS + (c * 128 + 32 * m + r32) * RT_KP + s * 32 + hi * 16);
                    sc[m] = __builtin_amdgcn_mfma_f32_32x32x16_bf16(a, qf[s], sc[m], 0, 0, 0); }
            }
            float g0[16], g1[16], g2[16], g3[16];
            const unsigned h4 = 4u * (unsigned)hi;
#pragma unroll
            for (int r = 0; r < 16; ++r) { const unsigned kr_ = (unsigned)((r & 3) + 8 * (r >> 2));
                g0[r] = embed(sc[0][r], 0xFFFFFF80u, kr_ | h4); g1[r] = embed(sc[1][r], 0xFFFFFF80u, (32u + kr_) | h4); g2[r] = embed(sc[2][r], 0xFFFFFF80u, (64u + kr_) | h4); g3[r] = embed(sc[3][r], 0xFFFFFF80u, (96u + kr_) | h4); }
            top16_of_64(g0, g1, g2, g3);
            pad16(g0);
#pragma unroll
            for (int i = 0; i < 16; ++i) T2[c][i] = g0[i];
        }
        if (u + G < T / 32) ldq(u + G);
        float A[16], Bv[16];
#pragma unroll
        for (int i = 0; i < 16; ++i) { A[i] = T2[0][i]; Bv[i] = T2[1][i]; swap32(A[i], Bv[i]); }
        merge16_desc(A, Bv);
        pad16(A);
        float T0[16], T1[16];
#pragma unroll
        for (int i = 0; i < 16; ++i) { T0[i] = A[i]; T1[i] = A[i]; swap32(T0[i], T1[i]); }
#pragma unroll
        for (int i = 0; i < 16; ++i) { scr[i * 64 + lane] = (int)(__builtin_bit_cast(unsigned, T0[i]) & 127u); scr[(16 + i) * 64 + lane] = (int)(__builtin_bit_cast(unsigned, T1[i]) & 127u);
            T0[i] = embed(T0[i], 0xFFFFFF80u, 0u); T1[i] = embed(T1[i], 0xFFFFFF80u, 0u); }
        float c0[16], c1[16], c2[16], c3[16];
        const float NINF = -__builtin_inff();
#pragma unroll
        for (int b = 0; b < 16; ++b) c0[b] = mkcand(T0[0], T1[b], (unsigned)b);
#pragma unroll
        for (int b = 0; b < 8; ++b) c1[b] = mkcand(T0[1], T1[b], 16u + b);
#pragma unroll
        for (int b = 0; b < 5; ++b) c1[8 + b] = mkcand(T0[2], T1[b], 32u + b);
#pragma unroll
        for (int b = 0; b < 3; ++b) c1[13 + b] = mkcand(T0[4], T1[b], 64u + b);
#pragma unroll
        for (int b = 0; b < 4; ++b) c2[b] = mkcand(T0[3], T1[b], 48u + b);
        c2[4] = mkcand(T0[5], T1[0], 80u); c2[5] = mkcand(T0[5], T1[1], 81u); c2[6] = mkcand(T0[6], T1[0], 96u); c2[7] = mkcand(T0[6], T1[1], 97u); c2[8] = mkcand(T0[7], T1[0], 112u); c2[9] = mkcand(T0[7], T1[1], 113u);
#pragma unroll
        for (int a = 8; a < 14; ++a) c2[10 + a - 8] = mkcand(T0[a], T1[0], 16u * a);
        c3[0] = mkcand(T0[14], T1[0], 224u); c3[1] = mkcand(T0[15], T1[0], 240u);
#pragma unroll
        for (int i = 2; i < 16; ++i) c3[i] = NINF;
        top16_of_64(c0, c1, c2, c3);
        pad16(c0);
        float gsum = 0.f, ge[16]; int ex[16];
        const float mtop = embed(c0[0], 0xFFFFFF00u, 0u);
#pragma unroll
        for (int i = 0; i < 16; ++i) { const unsigned bits = __builtin_bit_cast(unsigned, c0[i]); const int a = (bits >> 4) & 15, b = bits & 15;
            ge[i] = __builtin_amdgcn_exp2f((embed(c0[i], 0xFFFFFF00u, 0u) - mtop) * LOG2E); gsum += ge[i];
            ex[i] = scr[a * 64 + lane] * 128 + scr[(16 + b) * 64 + lane]; }
        const float ginv = __builtin_amdgcn_rcpf(gsum);
        if (hi == 0) { GAS unsigned short* d = (GAS unsigned short*)P.EX + t * 128 + h * 16;
#pragma unroll
            for (int i = 0; i < 16; ++i) d[i] = (unsigned short)ex[i]; }
        else { GAS v4u* d = (GAS v4u*)((GAS bf16*)P.GW + t * 128 + h * 16);
#pragma unroll
            for (int i = 0; i < 2; ++i) d[i] = (v4u){cvtpk(ge[8 * i] * ginv, ge[8 * i + 1] * ginv), cvtpk(ge[8 * i + 2] * ginv, ge[8 * i + 3] * ginv), cvtpk(ge[8 * i + 4] * ginv, ge[8 * i + 5] * ginv), cvtpk(ge[8 * i + 6] * ginv, ge[8 * i + 7] * ginv)}; }
    }
}

__device__ __forceinline__ int wave_allsum_i(int v) {
    v += __builtin_amdgcn_update_dpp(0, v, 0xB1, 0xF, 0xF, true);
    v += __builtin_amdgcn_update_dpp(0, v, 0x4E, 0xF, 0xF, true);
    v += __builtin_amdgcn_update_dpp(0, v, 0x141, 0xF, 0xF, true);
    v += __builtin_amdgcn_update_dpp(0, v, 0x140, 0xF, 0xF, true);
    { int a = v, b = v; asm volatile("v_nop\n\tv_nop\n\tv_permlane16_swap_b32 %0, %1" : "+v"(a), "+v"(b)); v = a + b; }
    { int a = v, b = v; asm volatile("v_nop\n\tv_nop\n\tv_permlane32_swap_b32 %0, %1" : "+v"(a), "+v"(b)); v = a + b; }
    return v;
}
__device__ __forceinline__ float wave_allsum(float v) {
    v += __builtin_bit_cast(float, __builtin_amdgcn_update_dpp(0, __builtin_bit_cast(int, v), 0xB1, 0xF, 0xF, true));
    v += __builtin_bit_cast(float, __builtin_amdgcn_update_dpp(0, __builtin_bit_cast(int, v), 0x4E, 0xF, 0xF, true));
    v += __builtin_bit_cast(float, __builtin_amdgcn_update_dpp(0, __builtin_bit_cast(int, v), 0x141, 0xF, 0xF, true));
    v += __builtin_bit_cast(float, __builtin_amdgcn_update_dpp(0, __builtin_bit_cast(int, v), 0x140, 0xF, 0xF, true));
    { float a = v, b = v; asm volatile("v_nop\n\tv_nop\n\tv_permlane16_swap_b32 %0, %1" : "+v"(a), "+v"(b)); v = a + b; }
    { float a = v, b = v; asm volatile("v_nop\n\tv_nop\n\tv_permlane32_swap_b32 %0, %1" : "+v"(a), "+v"(b)); v = a + b; }
    return v;
}
__device__ __forceinline__ float wave_allmax(float v) {
    v = fmaxf(v, __builtin_bit_cast(float, __builtin_amdgcn_update_dpp(0, __builtin_bit_cast(int, v), 0xB1, 0xF, 0xF, true)));
    v = fmaxf(v, __builtin_bit_cast(float, __builtin_amdgcn_update_dpp(0, __builtin_bit_cast(int, v), 0x4E, 0xF, 0xF, true)));
    v = fmaxf(v, __builtin_bit_cast(float, __builtin_amdgcn_update_dpp(0, __builtin_bit_cast(int, v), 0x141, 0xF, 0xF, true)));
    v = fmaxf(v, __builtin_bit_cast(float, __builtin_amdgcn_update_dpp(0, __builtin_bit_cast(int, v), 0x140, 0xF, 0xF, true)));
    { float a = v, b = v; asm volatile("v_nop\n\tv_nop\n\tv_permlane16_swap_b32 %0, %1" : "+v"(a), "+v"(b)); v = fmaxf(a, b); }
    { float a = v, b = v; asm volatile("v_nop\n\tv_nop\n\tv_permlane32_swap_b32 %0, %1" : "+v"(a), "+v"(b)); v = fmaxf(a, b); }
    return v;
}
__device__ __forceinline__ unsigned q4(float a, float b, float c, float d, int off) {
    const int ia = (int)__builtin_rintf(a) + off, ib = (int)__builtin_rintf(b) + off, ic = (int)__builtin_rintf(c) + off, id = (int)__builtin_rintf(d) + off;
    return (unsigned)(ia & 255) | ((unsigned)(ib & 255) << 8) | ((unsigned)(ic & 255) << 16) | ((unsigned)(id & 255) << 24);
}
__device__ __forceinline__ void quant_row(const GAS float* src, GAS unsigned* dst, GAS float* scale, int off, int lane) {
    const GAS f32x4* s = (const GAS f32x4*)src + 4 * lane; f32x4 v[4]; float m = 0.f;
#pragma unroll
    for (int i = 0; i < 4; ++i) { v[i] = s[i]; m = fmaxf(m, fmaxf(fmaxf(__builtin_fabsf(v[i].x), __builtin_fabsf(v[i].y)), fmaxf(__builtin_fabsf(v[i].z), __builtin_fabsf(v[i].w)))); }
    m = wave_allmax(m); const float inv = m > 0.f ? 127.f / m : 0.f;
    v4u w;
    w.x = q4(v[0].x * inv, v[0].y * inv, v[0].z * inv, v[0].w * inv, off); w.y = q4(v[1].x * inv, v[1].y * inv, v[1].z * inv, v[1].w * inv, off);
    w.z = q4(v[2].x * inv, v[2].y * inv, v[2].z * inv, v[2].w * inv, off); w.w = q4(v[3].x * inv, v[3].y * inv, v[3].z * inv, v[3].w * inv, off);
    *((GAS v4u*)dst + lane) = w;
    if (lane == 0) *scale = m * (1.f / 127.f);
}
__device__ __forceinline__ void quant_rows2(const GAS float* src0, GAS unsigned* dst0, GAS float* scale0, const GAS float* src1, GAS unsigned* dst1, GAS float* scale1, int lane) {
    f32x4 v[2][4];
#pragma unroll
    for (int n = 0; n < 2; ++n) { const GAS f32x4* s = (const GAS f32x4*)(n ? src1 : src0) + 4 * lane;
#pragma unroll
        for (int i = 0; i < 4; ++i) v[n][i] = s[i]; }
#pragma unroll
    for (int n = 0; n < 2; ++n) { float m = 0.f;
#pragma unroll
        for (int i = 0; i < 4; ++i) m = fmaxf(m, fmaxf(fmaxf(__builtin_fabsf(v[n][i].x), __builtin_fabsf(v[n][i].y)), fmaxf(__builtin_fabsf(v[n][i].z), __builtin_fabsf(v[n][i].w))));
        m = wave_allmax(m); const float inv = m > 0.f ? 127.f / m : 0.f;
        v4u w;
        w.x = q4(v[n][0].x * inv, v[n][0].y * inv, v[n][0].z * inv, v[n][0].w * inv, 0); w.y = q4(v[n][1].x * inv, v[n][1].y * inv, v[n][1].z * inv, v[n][1].w * inv, 0);
        w.z = q4(v[n][2].x * inv, v[n][2].y * inv, v[n][2].z * inv, v[n][2].w * inv, 0); w.w = q4(v[n][3].x * inv, v[n][3].y * inv, v[n][3].z * inv, v[n][3].w * inv, 0);
        *((GAS v4u*)(n ? dst1 : dst0) + lane) = w;
        if (lane == 0) *(n ? scale1 : scale0) = m * (1.f / 127.f); }
}
struct PeerS { int nslices_step, first_slice, nloc, rank; };
__device__ __forceinline__ PeerS peer_sched(const GAS unsigned* rankw, int xcc, int rank) {
    const int lane = lane_id_v();
    const int c = lane < 16 ? (int)__hip_atomic_load(rankw + 64 * lane, __ATOMIC_RELAXED, __HIP_MEMORY_SCOPE_AGENT) : 0;
    const unsigned long long m = __builtin_amdgcn_ballot_w64(c > 0);
    const int nx = __builtin_popcountll(m), myidx = __builtin_popcountll(m & ((1ull << xcc) - 1ull));
    const int cm = __builtin_amdgcn_readlane(c, xcc);
    PeerS s; s.nslices_step = nx > 0 ? nx : 1; s.first_slice = myidx; s.nloc = cm > 0 ? cm : 1; s.rank = rank; return s;
}
struct Peer1P { const GAS unsigned GAS char* HQ; const GAS int* EX; const GAS unsigned GAS char* U8; GAS int* P; };
__device__ __forceinline__ void peer_k1(const Peer1P& Q, const PeerS& sc, int wave, int lane) {
    asm volatile("" : "+v"(lane));
    const int g = lane >> 3, j = lane & 7;
    const __amdgpu_buffer_rsrc_t rU = __builtin_amdgcn_make_buffer_rsrc((void*)Q.U8, 0, 0x7fffffff, 0x00020000);
    for (int s = sc.first_slice; s < 8; s += sc.nslices_step) {
        v4u hqr[4], exr[4][2];
        { const size_t tf = (size_t)sc.rank * 64 + wave * 8;
#pragma unroll
          for (int n = 0; n < 2; ++n) { hqr[n] = *(const GAS v4u*)(Q.HQ + (tf + n) * 1024 + 128 * s + 16 * j);
#pragma unroll
              for (int i = 0; i < 2; ++i) exr[n][i] = *(const GAS v4u*)(Q.EX + (tf + n) * 64 + 8 * g + 4 * i); } }
#pragma unroll
        for (int n = 0; n < 2; ++n) asm volatile("" : "+v"(hqr[n].x), "+v"(hqr[n].y), "+v"(hqr[n].z), "+v"(hqr[n].w), "+v"(exr[n][0].x), "+v"(exr[n][0].y), "+v"(exr[n][0].z), "+v"(exr[n][0].w), "+v"(exr[n][1].x), "+v"(exr[n][1].y), "+v"(exr[n][1].z), "+v"(exr[n][1].w));
        for (int tile = sc.rank; tile < T / 64; tile += sc.nloc) {
            const int soff_ = __builtin_amdgcn_readfirstlane(128 * s);
            const size_t t0 = (size_t)tile * 64 + wave * 8;
            const size_t t0n = (size_t)(tile + sc.nloc < T / 64 ? tile + sc.nloc : tile) * 64 + wave * 8;
#pragma unroll
            for (int k = 0; k < 8; ++k) {
                const size_t t = t0 + k;
                const v4u hq = hqr[k % 4]; const v4u (&ex)[2] = exr[k % 4];
                v4u uu[16];
#pragma unroll
                for (int i = 0; i < 16; ++i) { const unsigned ew = ((i >> 1) & 3) == 0 ? ex[i >> 3].x : ((i >> 1) & 3) == 1 ? ex[i >> 3].y : ((i >> 1) & 3) == 2 ? ex[i >> 3].z : ex[i >> 3].w; unsigned e; if (i & 1) asm("v_lshrrev_b32 %0, 16, %1" : "=v"(e) : "v"(ew)); else asm("v_and_b32 %0, 0xffff, %1" : "=v"(e) : "v"(ew));
                    uu[i] = __builtin_bit_cast(v4u, __builtin_amdgcn_raw_buffer_load_b128(rU, (int)((e << 10) + 16u * (unsigned)j), soff_, 0)); }
                asm volatile("" ::: "memory"); __builtin_amdgcn_sched_barrier(0);
                { const size_t tp = k + 2 < 8 ? t + 2 : t0n + (k + 2 - 8);
                    hqr[(k + 2) % 4] = *(const GAS v4u*)(Q.HQ + tp * 1024 + 128 * s + 16 * j);
#pragma unroll
                    for (int i = 0; i < 2; ++i) exr[(k + 2) % 4][i] = *(const GAS v4u*)(Q.EX + tp * 64 + 8 * g + 4 * i);
                }
                asm volatile("" ::: "memory"); __builtin_amdgcn_sched_barrier(0);
                int pd[16];
#pragma unroll
                for (int i = 0; i < 16; ++i) { int q_;
                    asm("v_dot4_i32_i8 %0, %1, %2, 0" : "=v"(q_) : "v"(uu[i].x), "v"(hq.x));
                    q_ = __builtin_amdgcn_sdot4((int)uu[i].y, (int)hq.y, q_, false); q_ = __builtin_amdgcn_sdot4((int)uu[i].z, (int)hq.z, q_, false); pd[i] = __builtin_amdgcn_sdot4((int)uu[i].w, (int)hq.w, q_, false); }
#pragma unroll
                for (int i = 0; i < 16; ++i) pd[i] += __builtin_amdgcn_update_dpp(0, pd[i], 0xB1, 0xF, 0xF, true);
#pragma unroll
                for (int i = 0; i < 16; ++i) pd[i] += __builtin_amdgcn_update_dpp(0, pd[i], 0x4E, 0xF, 0xF, true);
#pragma unroll
                for (int i = 0; i < 16; ++i) pd[i] += __builtin_amdgcn_update_dpp(0, pd[i], 0x141, 0xF, 0xF, true);
                int lo = 0, hi = 0;
#pragma unroll
                for (int i = 0; i < 8; ++i) { lo = (j == i) ? pd[i] : lo; hi = (j == i) ? pd[i + 8] : hi; }
                Q.P[(t * 8 + s) * 64 + 8 * g + j] = (int)__builtin_amdgcn_perm((unsigned)((hi + 32) >> 6), (unsigned)((lo + 32) >> 6), 0x05040100u);
                if (k + 1 < 8) asm volatile("" : "+v"(exr[(k + 1) % 4][0].x), "+v"(exr[(k + 1) % 4][0].y), "+v"(exr[(k + 1) % 4][0].z), "+v"(exr[(k + 1) % 4][0].w), "+v"(exr[(k + 1) % 4][1].x), "+v"(exr[(k + 1) % 4][1].y), "+v"(exr[(k + 1) % 4][1].z), "+v"(exr[(k + 1) % 4][1].w));
            }
        }
    }
}
__device__ __forceinline__ void peer_w(const GAS int* EX, const GAS float* GW, const GAS int* P, const GAS float* SH, const GAS float* SU, const GAS float* SV, GAS signed char* WQ, GAS float* WSC, int gw, int NGW, int lane,
                                       LAS unsigned char* lds, int tid) {
    asm volatile("" : "+v"(lane), "+v"(tid));
    LAS float* su_l = (LAS float*)lds; LAS float* sv_l = su_l + 16384;
    { f32x4 sa[8], sb[8];
#pragma unroll
      for (int i = 0; i < 8; ++i) { sa[i] = ((const GAS f32x4*)SU)[tid + 512 * i]; sb[i] = ((const GAS f32x4*)SV)[tid + 512 * i]; }
      __builtin_amdgcn_sched_barrier(0);
#pragma unroll
      for (int i = 0; i < 8; ++i) { ((LAS f32x4*)su_l)[tid + 512 * i] = sa[i]; ((LAS f32x4*)sv_l)[tid + 512 * i] = sb[i]; } }
    __syncthreads();
    for (int t0 = gw; t0 < T; t0 += 2 * NGW) {
        const int tt[2] = {t0, t0 + NGW < T ? t0 + NGW : t0};
        float shv[2]; int ev[2][2], pwv[2][2][8]; unsigned gv[2][2];
#pragma unroll
        for (int r = 0; r < 2; ++r) { shv[r] = SH[tt[r]];
#pragma unroll
            for (int q = 0; q < 2; ++q) { const size_t idx = (size_t)tt[r] * 128 + lane + 64 * q; ev[r][q] = (int)((const GAS unsigned short*)EX)[idx]; gv[r][q] = (unsigned)((const GAS unsigned short*)GW)[idx];
                const int slot_ = lane + 64 * q, pix_ = (slot_ >> 4) * 8 + (slot_ & 7);
#pragma unroll
                for (int sl = 0; sl < 8; ++sl) pwv[r][q][sl] = P[((size_t)tt[r] * 8 + sl) * 64 + pix_]; } }
#pragma unroll
        for (int r = 0; r < 2; ++r) { const int t = tt[r]; const float sh = shv[r];
#pragma unroll
        for (int q = 0; q < 2; ++q) { const size_t idx = (size_t)t * 128 + lane + 64 * q; const int e = ev[r][q];
            const int slot_ = lane + 64 * q, hsel_ = (slot_ >> 3) & 1;
            int pd = 0;
#pragma unroll
            for (int sl = 0; sl < 8; ++sl) { const int pw_ = pwv[r][q][sl]; pd += hsel_ ? (pw_ >> 16) : (int)(short)(pw_ & 0xffff); }
            const float w = __builtin_bit_cast(float, gv[r][q] << 16) * gelu_erf((float)pd * (64.f * sh * su_l[e])) * sv_l[e];
            float m = __builtin_fabsf(w);
            m = fmaxf(m, __builtin_bit_cast(float, __builtin_amdgcn_update_dpp(0, __builtin_bit_cast(int, m), 0xB1, 0xF, 0xF, true)));
            m = fmaxf(m, __builtin_bit_cast(float, __builtin_amdgcn_update_dpp(0, __builtin_bit_cast(int, m), 0x4E, 0xF, 0xF, true)));
            m = fmaxf(m, __builtin_bit_cast(float, __builtin_amdgcn_update_dpp(0, __builtin_bit_cast(int, m), 0x141, 0xF, 0xF, true)));
            m = fmaxf(m, __builtin_bit_cast(float, __builtin_amdgcn_update_dpp(0, __builtin_bit_cast(int, m), 0x140, 0xF, 0xF, true)));
            const float inv = m > 0.f ? 127.f / m : 0.f;
            const unsigned wb = (unsigned)((int)__builtin_rintf(w * inv)) & 255u;
            const unsigned b1 = (unsigned)__builtin_amdgcn_update_dpp(0, (int)wb, 0x55, 0xF, 0xF, true), b2 = (unsigned)__builtin_amdgcn_update_dpp(0, (int)wb, 0xAA, 0xF, 0xF, true), b3 = (unsigned)__builtin_amdgcn_update_dpp(0, (int)wb, 0xFF, 0xF, 0xF, true);
            if ((lane & 3) == 0) ((GAS unsigned*)WQ)[idx >> 2] = wb | (b1 << 8) | (b2 << 16) | (b3 << 24);
            if ((lane & 15) == 0) WSC[(size_t)t * 8 + (lane >> 4) + 4 * q] = m * (1.f / 127.f); } }
    }
}
__device__ __forceinline__ void tr4x4(unsigned r0, unsigned r1, unsigned r2, unsigned r3, unsigned (&t)[4]) {
    const unsigned x0 = __builtin_amdgcn_perm(r1, r0, 0x05010400u), x1 = __builtin_amdgcn_perm(r1, r0, 0x07030602u), y0 = __builtin_amdgcn_perm(r3, r2, 0x05010400u), y1 = __builtin_amdgcn_perm(r3, r2, 0x07030602u);
    t[0] = __builtin_amdgcn_perm(y0, x0, 0x05040100u); t[1] = __builtin_amdgcn_perm(y0, x0, 0x07060302u); t[2] = __builtin_amdgcn_perm(y1, x1, 0x05040100u); t[3] = __builtin_amdgcn_perm(y1, x1, 0x07060302u);
}
struct Peer2P { const GAS int* EX; const GAS signed char* WQ; const GAS float* WSC; const GAS unsigned char* V8; GAS bf16* XB; GAS float* SSQ; };
__device__ __forceinline__ void peer_k2(const Peer2P& Q, const PeerS& sc, int wave, int lane) {
    asm volatile("" : "+v"(lane));
    const int g = lane >> 3, j = lane & 7, hf = lane >> 5, rp = (lane >> 4) & 1;
    const __amdgpu_buffer_rsrc_t rV = __builtin_amdgcn_make_buffer_rsrc((void*)Q.V8, 0, 0x7fffffff, 0x00020000);
    for (int s = sc.first_slice; s < 8; s += sc.nslices_step)
        for (int tile = sc.rank; tile < T / 64; tile += sc.nloc) {
            const int soff_ = __builtin_amdgcn_readfirstlane(128 * s);
            const size_t t0 = (size_t)tile * 64 + wave * 8;
            struct Small { v4u ex[2]; v4u wq; float sw; };
            v4u vA[16], vB[16]; v2u xA, xB;
            Small sC, sN, sF;
            auto ld_small = [&](size_t t, Small& o) {
#pragma unroll
                for (int i = 0; i < 2; ++i) o.ex[i] = *(const GAS v4u*)(Q.EX + t * 64 + 8 * g + 4 * i);
                o.wq = *(const GAS v4u*)(Q.WQ + t * 128 + 16 * g); o.sw = Q.WSC[t * 8 + g]; };
            auto issue = [&](v4u (&vv)[16], v2u& xold, const Small& sm, size_t t) {
                const v4u (&ex)[2] = sm.ex;
                xold = *(const GAS v2u*)(Q.XB + t * 1024 + 128 * s + 16 * j + 8 * hf + 4 * rp);
#pragma unroll
                for (int i = 0; i < 16; ++i) { const unsigned ew = ((i >> 1) & 3) == 0 ? ex[i >> 3].x : ((i >> 1) & 3) == 1 ? ex[i >> 3].y : ((i >> 1) & 3) == 2 ? ex[i >> 3].z : ex[i >> 3].w; unsigned e; if (i & 1) asm("v_lshrrev_b32 %0, 16, %1" : "=v"(e) : "v"(ew)); else asm("v_and_b32 %0, 0xffff, %1" : "=v"(e) : "v"(ew));
                    vv[i] = __builtin_bit_cast(v4u, __builtin_amdgcn_raw_buffer_load_b128(rV, (int)((e << 10) + 16u * (unsigned)j), soff_, 0)); }
            };
            auto reduce = [&](const v4u (&vv)[16], const v2u xold, const Small& sm, size_t t) {
                const v4u wq = sm.wq; const float sw = sm.sw;
                GAS v2u* xp = (GAS v2u*)(Q.XB + t * 1024 + 128 * s + 16 * j + 8 * hf + 4 * rp);
                int ai[16];
#pragma unroll
                for (int q4_ = 0; q4_ < 4; ++q4_) {
                    const unsigned wq4 = q4_ == 0 ? wq.x : q4_ == 1 ? wq.y : q4_ == 2 ? wq.z : wq.w;
#pragma unroll
                    for (int c = 0; c < 4; ++c) { unsigned tt[4];
                        const v4u &a0 = vv[4 * q4_], &a1 = vv[4 * q4_ + 1], &a2 = vv[4 * q4_ + 2], &a3 = vv[4 * q4_ + 3];
                        tr4x4(c == 0 ? a0.x : c == 1 ? a0.y : c == 2 ? a0.z : a0.w, c == 0 ? a1.x : c == 1 ? a1.y : c == 2 ? a1.z : a1.w, c == 0 ? a2.x : c == 1 ? a2.y : c == 2 ? a2.z : a2.w, c == 0 ? a3.x : c == 1 ? a3.y : c == 2 ? a3.z : a3.w, tt);
#pragma unroll
                        for (int b = 0; b < 4; ++b) {
                            if (q4_ == 0) asm("v_dot4_i32_i8 %0, %1, %2, 0" : "=v"(ai[4 * c + b]) : "v"(tt[b]), "v"(wq4));
                            else ai[4 * c + b] = __builtin_amdgcn_sdot4((int)tt[b], (int)wq4, ai[4 * c + b], false); } }
                }
                float acc[16];
#pragma unroll
                for (int i = 0; i < 16; ++i) acc[i] = (float)ai[i] * sw;
                float r8[8], r4[4];
#pragma unroll
                for (int m = 0; m < 8; ++m) r8[m] = 0.f;
                asm volatile("v_nop\n\tv_nop\n\tv_permlane32_swap_b32 %0, %8\n\tv_permlane32_swap_b32 %1, %9\n\tv_permlane32_swap_b32 %2, %10\n\tv_permlane32_swap_b32 %3, %11\n\tv_permlane32_swap_b32 %4, %12\n\tv_permlane32_swap_b32 %5, %13\n\tv_permlane32_swap_b32 %6, %14\n\tv_permlane32_swap_b32 %7, %15"
                             : "+v"(acc[0]), "+v"(acc[1]), "+v"(acc[2]), "+v"(acc[3]), "+v"(acc[4]), "+v"(acc[5]), "+v"(acc[6]), "+v"(acc[7]), "+v"(acc[8]), "+v"(acc[9]), "+v"(acc[10]), "+v"(acc[11]), "+v"(acc[12]), "+v"(acc[13]), "+v"(acc[14]), "+v"(acc[15]));
#pragma unroll
                for (int m = 0; m < 8; ++m) r8[m] = acc[m] + acc[m + 8];
                asm volatile("v_nop\n\tv_nop\n\tv_permlane16_swap_b32 %0, %4\n\tv_permlane16_swap_b32 %1, %5\n\tv_permlane16_swap_b32 %2, %6\n\tv_permlane16_swap_b32 %3, %7"
                             : "+v"(r8[0]), "+v"(r8[1]), "+v"(r8[2]), "+v"(r8[3]), "+v"(r8[4]), "+v"(r8[5]), "+v"(r8[6]), "+v"(r8[7]));
#pragma unroll
                for (int n = 0; n < 4; ++n) r4[n] = r8[n] + r8[n + 4];
#pragma unroll
                for (int n = 0; n < 4; ++n) r4[n] += __builtin_bit_cast(float, __builtin_amdgcn_update_dpp(0, __builtin_bit_cast(int, r4[n]), 0x128, 0xF, 0xF, true));
                v2u xw; xw.x = cvtpk(bflo(xold.x) + r4[0], bfhi(xold.x) + r4[1]); xw.y = cvtpk(bflo(xold.y) + r4[2], bfhi(xold.y) + r4[3]);
                float ss = 0.f;
                if ((lane & 8) == 0) { const float x0 = bflo(xw.x), x1 = bfhi(xw.x), x2 = bflo(xw.y), x3 = bfhi(xw.y); ss = (x0 * x0 + x1 * x1) + (x2 * x2 + x3 * x3); *xp = xw; }
                ss = wave_allsum(ss);
                if (Q.SSQ) { if (lane == 0) Q.SSQ[t * 16 + s] = ss; }
            };
            ld_small(t0, sC); ld_small(t0 + 1, sN);
            issue(vA, xA, sC, t0);
#pragma unroll 1
            for (int k = 0; k < 8; k += 2) {
                ld_small(t0 + (k + 2 < 8 ? k + 2 : 7), sF);
                issue(vB, xB, sN, t0 + k + 1);
                reduce(vA, xA, sC, t0 + k);
                if (k + 2 < 8) { ld_small(t0 + (k + 3 < 8 ? k + 3 : 7), sC); issue(vA, xA, sF, t0 + k + 2); }
                reduce(vB, xB, sN, t0 + k + 1);
                { const Small tmp = sC; sC = sF; sN = tmp; }
            }
        }
}

struct Args { const float* in[33]; float* out; unsigned char* ws; int ph_lo, ph_hi; };
struct Frame { LAS unsigned char* lds; volatile LAS unsigned* MISC; gu32* ctl; int tid, lane, wave, G, vcu, xcc, xrank; };

__device__ __forceinline__ void transpose_item(const float* W, int ldw, int nsrc0, bf16* WT, int ldt, int rdst0, LAS float* scr, int kb, int nb, int lane, float scale, const float* kgain) {
    const int k0 = 64 * kb, n0 = 32 * nb;
    { float wv_[32], gv_[32];
#pragma unroll
      for (int i = 0; i < 32; ++i) { const int kk = 2 * i + (lane >> 5); wv_[i] = W[(size_t)(k0 + kk) * ldw + nsrc0 + n0 + (lane & 31)]; gv_[i] = kgain ? kgain[k0 + kk] : 1.f; }
      __builtin_amdgcn_sched_barrier(0);
#pragma unroll
      for (int i = 0; i < 32; ++i) { const int kk = 2 * i + (lane >> 5); scr[kk * 33 + (lane & 31)] = wv_[i] * (gv_[i] * scale); } }
    LDS_WAIT(); asm volatile("" ::: "memory");
    const int c = lane & 7;
#pragma unroll
    for (int j = 0; j < 4; ++j) { const int n = (lane >> 3) + 8 * j; const LAS float* s = scr + (8 * c) * 33 + n;
        v4u o; o.x = pk2(s[0 * 33], s[1 * 33]); o.y = pk2(s[2 * 33], s[3 * 33]); o.z = pk2(s[4 * 33], s[5 * 33]); o.w = pk2(s[6 * 33], s[7 * 33]);
        *(GAS v4u*)(WT + (size_t)(rdst0 + n0 + n) * ldt + k0 + 8 * c) = o; }
    LDS_WAIT(); asm volatile("" ::: "memory");
}
__device__ __forceinline__ void zero_rect(bf16* base, int ld, int row0, int nrows, int col0, int ncols, int gtid, int gthreads) {
    const int vpr = ncols / 8;
    for (int i = gtid; i < nrows * vpr; i += gthreads) { const int r = i / vpr, c = i % vpr; *(GAS v4u*)(base + (size_t)(row0 + r) * ld + col0 + 8 * c) = (v4u){0u, 0u, 0u, 0u}; }
}

__device__ __forceinline__ void p0_prologue(Frame& F, const Args& a) {
    LAS float* scr = (LAS float*)(F.lds + RING_OFF + F.wave * 16384);
    const int gw = blockIdx.x * NWAVES + F.wave, NGW = F.G * NWAVES;
    const int gtid = blockIdx.x * (NWAVES * 64) + F.tid, gthreads = F.G * NWAVES * 64;
    unsigned char* ws = a.ws;
    x0_phase((const GAS float*)a.in[0], (GAS bf16*)(ws + WS_XNB), (GAS float*)(ws + WS_SSQ), gw, NGW, F.lane);
    constexpr int I_IN = 16 * (INW / 32), I_SQ = 16 * 32, I_CKV = 16 * 64, I_UQ = 3 * 12, I_UKV = 2 * 16, I_L = I_IN + 4 * I_SQ + I_CKV + I_UQ + I_UKV;
    for (int it = gw; it < L * I_L; it += NGW) {
        const int l = it / I_L; int r = it % I_L;
        if (r < I_IN) {
            const int kb = r / 67, nb = r % 67; int src, dst; float sc = 1.f;
            if (nb < 6) { src = 32 * nb; dst = src; } else if (nb < 11) { src = 32 * nb; dst = src + 64; } else { src = 32 * nb; dst = src + 160; if (nb >= 43 && nb < 51) sc = 0.17677669529663687f * LOG2E; }
            transpose_item(a.in[5] + (size_t)l * D * INW, INW, src, (bf16*)(ws + WS_WIN) + (size_t)l * INP * D, D, dst, scr, kb, 0, F.lane, sc, a.in[4] + l * D); continue; } r -= I_IN;
        if (r < I_SQ) { transpose_item(a.in[21] + (size_t)l * D * D, D, 0, (bf16*)(ws + WS_WOUT) + (size_t)l * D * D, D, 0, scr, r / 32, r % 32, F.lane, 1.f, nullptr); continue; } r -= I_SQ;
        if (r < I_SQ) { transpose_item(a.in[24] + (size_t)l * D * D, D, 0, (bf16*)(ws + WS_WCQ) + (size_t)l * D * D, D, 0, scr, r / 32, r % 32, F.lane, 0.0625f * LOG2E, a.in[22] + l * D); continue; } r -= I_SQ;
        if (r < I_SQ) { transpose_item(a.in[26] + (size_t)l * D * D, D, 0, (bf16*)(ws + WS_WCO) + (size_t)l * D * D, D, 0, scr, r / 32, r % 32, F.lane, 1.f, nullptr); continue; } r -= I_SQ;
        if (r < I_SQ) { transpose_item(a.in[28] + (size_t)l * D * D, D, 0, (bf16*)(ws + WS_WPQ) + (size_t)l * D * D, D, 0, scr, r / 32, r % 32, F.lane, 1.f, a.in[27] + l * D); continue; } r -= I_SQ;
        if (r < I_CKV) { transpose_item(a.in[25] + (size_t)l * D * 2 * D, 2 * D, 0, (bf16*)(ws + WS_WCKV) + (size_t)l * 2 * D * D, D, 0, scr, r / 64, r % 64, F.lane, 1.f, nullptr); continue; } r -= I_CKV;
        if (r < I_UQ) { transpose_item(a.in[7] + (size_t)l * 192 * 384, 384, 0, (bf16*)(ws + WS_WUQ) + (size_t)l * 512 * 256, 256, 0, scr, r / 12, r % 12, F.lane, 0.10206207261596575f * LOG2E, a.in[6] + l * 192); continue; } r -= I_UQ;
        transpose_item(a.in[9] + (size_t)l * 128 * 512, 512, 0, (bf16*)(ws + WS_WUKV) + (size_t)l * 512 * 256, 256, 0, scr, r / 16, r % 16, F.lane, 1.f, a.in[8] + l * 128);
    }
    for (int l = 0; l < L; ++l) {
        bf16* win = (bf16*)(ws + WS_WIN) + (size_t)l * INP * D; bf16* wuq = (bf16*)(ws + WS_WUQ) + (size_t)l * 512 * 256; bf16* wukv = (bf16*)(ws + WS_WUKV) + (size_t)l * 512 * 256;
        zero_rect(win, D, 192, 64, 0, D, gtid, gthreads); zero_rect(win, D, 416, 96, 0, D, gtid, gthreads);
        zero_rect(wuq, 256, 0, 384, 192, 64, gtid, gthreads); zero_rect(wuq, 256, 384, 128, 0, 256, gtid, gthreads);
        zero_rect(wukv, 256, 0, 512, 128, 128, gtid, gthreads);
    }
    { float* rope = (float*)(ws + WS_ROPE); const int* pos = (const int*)a.in[2];
      for (int i = gtid; i < T * 16; i += gthreads) { const int t = i >> 4, k = i & 15; const float inv = powf(10000.f, -(float)(2 * k) / 32.f); const float ang = (float)pos[t] * inv;
          rope[(size_t)t * 32 + k] = cosf(ang); rope[(size_t)t * 32 + 16 + k] = sinf(ang); } }
    { const GAS f32x4* ks = (const GAS f32x4*)a.in[29]; GAS v2u* kd = (GAS v2u*)(ws + WS_KEYS);
      for (int i = gtid; i < L * 2 * 128 * 64 / 4; i += gthreads) { const f32x4 v = ks[i]; v2u w; w.x = pk2(v.x, v.y); w.y = pk2(v.z, v.w); kd[i] = w; }
    }
    for (int r = gw; r < 16384; r += NGW) { const int tb = 0, rr = r;
        quant_row((const GAS float*)a.in[30 + tb] + (size_t)rr * 1024, (GAS unsigned*)(ws + (tb ? WS_V8 : WS_U8) + (size_t)rr * 1024), (GAS float*)(ws + (tb ? WS_SV : WS_SU)) + rr, 0, F.lane); }
    { float* btab = (float*)(ws + WS_BTAB); float* lams = (float*)(ws + WS_LAMS); float* spt = (float*)(ws + WS_SP);
      for (int i = gtid; i < 4 * 129; i += gthreads) { const int h = i / 129, n = i % 129; int bu; if (n < 16) bu = n; else { const int lg = 16 + (int)(logf((float)n / 16.f) / logf(8.f) * 16.f); bu = lg < 31 ? lg : 31; }
          btab[i] = a.in[3][bu * 4 + h] * LOG2E; }
      for (int i = gtid; i < L; i += gthreads) { const float* dl = a.in[17] + i * 128; float s1 = 0.f, s2 = 0.f; for (int j = 0; j < 32; ++j) { s1 += dl[j] * dl[32 + j]; s2 += dl[64 + j] * dl[96 + j]; }
          const float li = 0.8f - 0.6f * expf(-0.3f * (float)i); lams[2 * i] = expf(s1) - expf(s2) + li; lams[2 * i + 1] = li; }
      for (int i = gtid; i < L * 512; i += gthreads) spt[i] = log1pf(expf(-a.in[16][i])); }
    { GAS bf16* wat = (GAS bf16*)(ws + WS_WAT);
      for (int i = gtid; i < L * 8 * 2 * 4096; i += gthreads) { const int in_ = i & 63, out_ = (i >> 6) & 63, gate = (i >> 12) & 1, lg = i >> 13;
          wat[i] = (bf16)f2bf_(a.in[gate ? 14 : 12][(size_t)lg * 4096 + in_ * 64 + out_]); } }
    for (int l = 0; l < L; ++l) norm_phase((const GAS float*)a.in[1], (const GAS float*)a.in[23] + l * D, (GAS bf16*)(ws + WS_MNB) + (size_t)l * NB * MEM * D, NB * MEM, gw, NGW, F.lane);
}

constexpr int NPL = 16, PH_FINAL = 2 + NPL * L;
__global__ void __launch_bounds__(NWAVES * 64, 2) fwd(Args args) {
    extern __shared__ __attribute__((aligned(16))) unsigned char lds[];
    Frame F;
    F.lds = (LAS unsigned char*)lds; F.MISC = (volatile LAS unsigned*)(F.lds + MISC_OFF);
    F.tid = threadIdx.x; F.lane = F.tid & 63; F.wave = __builtin_amdgcn_readfirstlane(F.tid >> 6); F.G = gridDim.x;
    F.vcu = (F.G % 8 == 0) ? ((int)blockIdx.x % 8) * (F.G / 8) + (int)blockIdx.x / 8 : (int)blockIdx.x;
    unsigned char* ws = args.ws;
    F.ctl = (gu32*)(opq(ws) + WS_CTL);
    for (int u = F.tid; u < (LDS_BYTES - LDSCTL_OFF) / 4; u += NWAVES * 64) ((LAS unsigned*)(F.lds + LDSCTL_OFF))[u] = 0u;
    __syncthreads();
    XcdBarrier bar = xcd_barrier_post((unsigned*)(F.ctl + CW_BAR), F.MISC + 8);
    F.xcc = (int)bar.x;
    if (F.tid == 0) F.MISC[12] = __hip_atomic_fetch_add((unsigned*)(F.ctl + CW_RANK) + 64 * bar.x, 1u, __ATOMIC_RELAXED, __HIP_MEMORY_SCOPE_AGENT);
    __syncthreads();
    F.xrank = __builtin_amdgcn_readfirstlane((int)F.MISC[12]);
    const int lo = args.ph_lo, hi = args.ph_hi;
    const int gw = blockIdx.x * NWAVES + F.wave, NGW = F.G * NWAVES;
#define IN(k) (lo <= (k) && (k) < hi)
#define LANE_ (lane_id_v())
#define TID_ ((opqi(F.wave) << 6) | LANE_)
#define SITE() const int G_ = opqi(F.G), wv_ = opqi(F.wave), vcu_ = opqi(F.vcu), gw_ = opqi(gw), NGW_ = opqi(NGW); (void)G_; (void)wv_; (void)vcu_; (void)gw_; (void)NGW_
#if MK_DUP == 99
#define SEAM(k) do { if (IN(k) && IN((k) + 1)) { xcd_barrier(bar, (F.wave == 0 && lane_id_v() == 0) ? 1 : 0); xcd_barrier(bar, (F.wave == 0 && lane_id_v() == 0) ? 1 : 0); } } while (0)
#else
#define SEAM(k) do { if (IN(k) && IN((k) + 1)) xcd_barrier(bar, (F.wave == 0 && lane_id_v() == 0) ? 1 : 0); } while (0)
#endif
#define GEMM_SITE(EPI, Aptr, lda_, Bptr, ldb_, M_, N_, K_, cperm, ...) do { \
        pg8::Gemm g{opq(Aptr), opq(Bptr), M_, N_, K_, lda_, ldb_}; pg8::StaticOrder So; So.init(M_, N_, opqi(F.G), opqi(cperm)); pg8::EPI E{__VA_ARGS__}; \
        pg8::gemm_phase<pg8::EPI, pg8::StaticOrder, true, true>(F.lds + RING_OFF, g, So, E, opqi(F.wave)); } while (0)
    if (IN(0)) { p0_prologue(F, args); }
    SEAM(0);
    if (IN(1)) {
#pragma unroll 1
        for (int l = 0; l < L; ++l)
            GEMM_SITE(EpiBf16, (const GAS bf16*)(opq(ws) + WS_MNB) + (size_t)l * NB * MEM * D, D, (const GAS bf16*)(opq(ws) + WS_WCKV) + (size_t)l * 2 * D * D, D, NB * MEM, 2 * D, D, (int)((blockIdx.x + 64 * l) % F.G),
                      opq((GAS bf16*)(opq(ws) + WS_KVCB) + (size_t)l * NB * MEM * 2 * D), 2 * D, 2 * D, (const GAS float*)nullptr, 0);
    }
    SEAM(1);
    for (int l = 0; l < L; ++l) {
        const int pb = 2 + NPL * l;
        const GAS bf16* XNB = (const GAS bf16*)(opq(ws) + WS_XNB); const GAS bf16* YB = (const GAS bf16*)(opq(ws) + WS_YB); GAS bf16* PROJB = (GAS bf16*)(opq(ws) + WS_PROJB);
        if (IN(pb + 1)) GEMM_SITE(EpiBf16, XNB, D, (const GAS bf16*)(opq(ws) + WS_WIN) + (size_t)l * INP * D, D, T, INP, D, (int)blockIdx.x, opq(PROJB), INP, INP, opq((const GAS float*)(opq(ws) + WS_SSQ)), 8);
#if MK_DUP == 1
        if (IN(pb + 1)) GEMM_SITE(EpiBf16, XNB, D, (const GAS bf16*)(opq(ws) + WS_WIN) + (size_t)l * INP * D, D, T, INP, D, (int)blockIdx.x, opq(PROJB), INP, INP, opq((const GAS float*)(opq(ws) + WS_SSQ)), 8);
#endif
        SEAM(pb + 1);
        if (IN(pb + 2)) {
            SITE();
            pre_phase(opq((const GAS bf16*)PROJB), opq((const GAS float*)(opq(ws) + WS_ROPE)), opq((GAS float*)(opq(ws) + WS_RS)), opq((GAS bf16*)(opq(ws) + WS_KMB)), gw_, NGW_, LANE_);
#if MK_DUP == 21
            pre_phase(opq((const GAS bf16*)PROJB), opq((const GAS float*)(opq(ws) + WS_ROPE)), opq((GAS float*)(opq(ws) + WS_RS)), opq((GAS bf16*)(opq(ws) + WS_KMB)), gw_, NGW_, LANE_);
#endif
            LruP LP{opq((const GAS bf16*)PROJB), (const GAS float*)args.in[opqi(10)] + l * 4 * 512, (const GAS float*)args.in[opqi(11)] + l * 512, opq((const GAS bf16*)(opq(ws) + WS_WAT)) + (size_t)l * 8 * 2 * 4096, (const GAS float*)args.in[opqi(13)] + l * 512, (const GAS float*)args.in[opqi(15)] + l * 512,
                    (const GAS float*)(opq(ws) + WS_SP) + l * 512, opq((GAS unsigned*)(opq(ws) + WS_HLB)), opq((GAS float*)(opq(ws) + WS_LSUM))};
            lru_phase(LP, F.lds, TID_, wv_, LANE_, vcu_, G_);
#if MK_DUP == 2
            lru_phase(LP, F.lds, TID_, wv_, LANE_, vcu_, G_);
#endif
        }
        SEAM(pb + 2);
        if (IN(pb + 3)) {
            GEMM_SITE(EpiUp, (const GAS bf16*)PROJB + PC_CQ, INP, (const GAS bf16*)(opq(ws) + WS_WUQ) + (size_t)l * 512 * 256, 256, T, 512, 256, (int)blockIdx.x,
                      opq((GAS bf16*)(opq(ws) + WS_QMB)), (GAS bf16*)nullptr, 384, 384, opq((const GAS float*)(opq(ws) + WS_RS)), 0, 0);
            GEMM_SITE(EpiUp, (const GAS bf16*)PROJB + PC_CKV, INP, (const GAS bf16*)(opq(ws) + WS_WUKV) + (size_t)l * 512 * 256, 256, T, 512, 256, (int)blockIdx.x,
                      opq((GAS bf16*)(opq(ws) + WS_KMB)), opq((GAS bf16*)(opq(ws) + WS_VMB)), 0, 512, opq((const GAS float*)(opq(ws) + WS_RS)), 1, 1);
#if MK_DUP == 3
            GEMM_SITE(EpiUp, (const GAS bf16*)PROJB + PC_CQ, INP, (const GAS bf16*)(opq(ws) + WS_WUQ) + (size_t)l * 512 * 256, 256, T, 512, 256, (int)blockIdx.x,
                      opq((GAS bf16*)(opq(ws) + WS_QMB)), (GAS bf16*)nullptr, 384, 384, opq((const GAS float*)(opq(ws) + WS_RS)), 0, 0);
            GEMM_SITE(EpiUp, (const GAS bf16*)PROJB + PC_CKV, INP, (const GAS bf16*)(opq(ws) + WS_WUKV) + (size_t)l * 512 * 256, 256, T, 512, 256, (int)blockIdx.x,
                      opq((GAS bf16*)(opq(ws) + WS_KMB)), opq((GAS bf16*)(opq(ws) + WS_VMB)), 0, 512, opq((const GAS float*)(opq(ws) + WS_RS)), 1, 1);
#endif
        }
        SEAM(pb + 3);
        if (IN(pb + 4)) {
            SITE();
            AttnP PM{opq((const GAS bf16*)(opq(ws) + WS_QMB)), opq((const GAS bf16*)(opq(ws) + WS_KMB)), opq((const GAS bf16*)(opq(ws) + WS_VMB)), 384, 384, 256, opq((GAS bf16*)(opq(ws) + WS_OMB)), 256, opq((const GAS float*)(opq(ws) + WS_ROPE)), nullptr, nullptr, nullptr, nullptr};
            AttnP PD{opq((const GAS bf16*)PROJB + PC_QD), opq((const GAS bf16*)PROJB + PC_KD), opq((const GAS bf16*)PROJB + PC_VD), INP, INP, INP, opq((GAS bf16*)(opq(ws) + WS_YB) + 768), 1024, nullptr,
                     (const GAS int*)args.in[opqi(2)], (const GAS float*)(opq(ws) + WS_BTAB), (const GAS float*)args.in[opqi(18)] + l * 64, (const GAS float*)(opq(ws) + WS_LAMS) + 2 * l};
            attn_phase(PM, PD, F.lds, TID_, wv_, LANE_, vcu_, G_);
#if MK_DUP == 4
            __syncthreads(); attn_phase(PM, PD, F.lds, TID_, wv_, LANE_, vcu_, G_);
#elif MK_DUP == 40 || MK_DUP == 41
            __syncthreads(); attn_phase(PM, PD, F.lds, TID_, wv_, LANE_, vcu_, G_, MK_DUP - 40);
#endif
        }
        SEAM(pb + 4);
        if (IN(pb + 5)) {
            SITE();
            PostP PP{opq((const GAS bf16*)(opq(ws) + WS_OMB)), opq((const GAS unsigned*)(opq(ws) + WS_HLB)), opq((const GAS float*)(opq(ws) + WS_LSUM)), opq((const GAS bf16*)PROJB), (const GAS float*)args.in[opqi(19)] + l * 256, (const GAS float*)args.in[opqi(20)] + l * 512, opq((GAS bf16*)(opq(ws) + WS_YB))};
            post_phase(PP, F.lds, TID_, wv_, LANE_, vcu_, G_);
#if MK_DUP == 5
            __syncthreads(); post_phase(PP, F.lds, TID_, wv_, LANE_, vcu_, G_);
#endif
        }
        SEAM(pb + 5);
        if (IN(pb + 6)) GEMM_SITE(EpiRes, YB, D, (const GAS bf16*)(opq(ws) + WS_WOUT) + (size_t)l * D * D, D, T, D, D, (int)blockIdx.x, opq((GAS bf16*)(opq(ws) + WS_XNB)), opq((GAS float*)(opq(ws) + WS_SSQ)));
#if MK_DUP == 6
        if (IN(pb + 6)) GEMM_SITE(EpiRes, YB, D, (const GAS bf16*)(opq(ws) + WS_WOUT) + (size_t)l * D * D, D, T, D, D, (int)blockIdx.x, opq((GAS bf16*)(opq(ws) + WS_HLB)), opq((GAS float*)(opq(ws) + WS_OMB)));
#endif
        SEAM(pb + 6);
        if (IN(pb + 8)) GEMM_SITE(EpiBf16, XNB, D, (const GAS bf16*)(opq(ws) + WS_WCQ) + (size_t)l * D * D, D, T, D, D, (int)blockIdx.x, opq(PROJB), D, D, opq((const GAS float*)(opq(ws) + WS_SSQ)), 16);
#if MK_DUP == 8
        if (IN(pb + 8)) GEMM_SITE(EpiBf16, XNB, D, (const GAS bf16*)(opq(ws) + WS_WCQ) + (size_t)l * D * D, D, T, D, D, (int)blockIdx.x, opq(PROJB), D, D, opq((const GAS float*)(opq(ws) + WS_SSQ)), 16);
#endif
        SEAM(pb + 8);
        if (IN(pb + 9)) {
            SITE();
            const GAS bf16* kv = (const GAS bf16*)(opq(ws) + WS_KVCB) + (size_t)l * NB * MEM * 2 * D;
            AttnP PC{opq((const GAS bf16*)PROJB), opq(kv), opq(kv + D), 1024, 2 * D, 2 * D, opq((GAS bf16*)(opq(ws) + WS_YB)), 1024, nullptr, nullptr, nullptr, nullptr, nullptr};
            cross_phase(PC, F.lds, TID_, wv_, LANE_, vcu_, G_);
#if MK_DUP == 9
            cross_phase(PC, F.lds, TID_, wv_, LANE_, vcu_, G_);
#endif
        }
        SEAM(pb + 9);
        if (IN(pb + 10)) GEMM_SITE(EpiRes, YB, D, (const GAS bf16*)(opq(ws) + WS_WCO) + (size_t)l * D * D, D, T, D, D, (int)blockIdx.x, opq((GAS bf16*)(opq(ws) + WS_XNB)), opq((GAS float*)(opq(ws) + WS_SSQ)));
        SEAM(pb + 10);
        if (IN(pb + 12)) { GEMM_SITE(EpiBf16, XNB, D, (const GAS bf16*)(opq(ws) + WS_WPQ) + (size_t)l * D * D, D, T, D, D, (int)blockIdx.x, opq(PROJB), D, D, opq((const GAS float*)(opq(ws) + WS_SSQ)), 16);
#if MK_DUP == 12
            hq_phase(opq(XNB), opq((const GAS float*)(opq(ws) + WS_SSQ)), (const GAS float*)args.in[opqi(27)] + l * D, opq((GAS unsigned char*)(opq(ws) + WS_HQ)), opq((GAS float*)(opq(ws) + WS_SH)), opq((GAS int*)(opq(ws) + WS_P)), gw_, NGW_, LANE_);
#endif
            }
        SEAM(pb + 12);
        if (IN(pb + 13)) {
            SITE();
            RouteP RP{opq((const GAS bf16*)PROJB), opq((const GAS bf16*)(opq(ws) + WS_KEYS) + (size_t)l * 2 * 128 * 64), opq((GAS int*)(opq(ws) + WS_EX)), opq((GAS float*)(opq(ws) + WS_GW))};
            auto qlay = [&](int r) { return (size_t)((r >> 14) ? l : l + 1) * 16384 + (r & 16383); };
            auto qsrc = [&](int r) { const int tb = r >> 14; return (const GAS float*)args.in[opqi(30) + tb] + qlay(r) * 1024; };
            auto qdst = [&](int r) { const int tb = r >> 14; return (GAS unsigned*)(opq(ws) + (tb ? WS_V8 : WS_U8) + qlay(r) * 1024); };
            auto qscl = [&](int r) { const int tb = r >> 14; return (GAS float*)(opq(ws) + (tb ? WS_SV : WS_SU)) + qlay(r); };
            auto qrows = [&]() { for (int r = (l + 1 < L ? 0 : 16384) + gw_; r < 2 * 16384; r += 2 * NGW_) { const int r1 = r + NGW_;
                if (r1 < 2 * 16384) quant_rows2(qsrc(r), qdst(r), qscl(r), qsrc(r1), qdst(r1), qscl(r1), LANE_);
                else quant_row(qsrc(r), qdst(r), qscl(r), 0, LANE_); } };
            route_phase(RP, F.lds, TID_, wv_, LANE_, vcu_, G_, [&]() { if (wv_ >= 4) qrows(); });
            if (wv_ < 4) qrows();
            hq_phase(opq(XNB), opq((const GAS float*)(opq(ws) + WS_SSQ)), (const GAS float*)args.in[opqi(27)] + l * D, opq((GAS unsigned char*)(opq(ws) + WS_HQ)), opq((GAS float*)(opq(ws) + WS_SH)), opq((GAS int*)(opq(ws) + WS_P)), gw_, NGW_, LANE_);
#if MK_DUP == 13
            route_phase(RP, F.lds, TID_, wv_, LANE_, vcu_, G_, [](){});
#endif
        }
        SEAM(pb + 13);
        if (IN(pb + 14)) {
            SITE();
            const PeerS ps = peer_sched((const GAS unsigned*)(F.ctl + CW_RANK), opqi(F.xcc), opqi(F.xrank));
            Peer1P Q1{opq((const GAS unsigned char*)(opq(ws) + WS_HQ)), opq((const GAS int*)(opq(ws) + WS_EX)), opq((const GAS unsigned char*)(opq(ws) + WS_U8) + (size_t)l * 16384 * 1024), opq((GAS int*)(opq(ws) + WS_PROJB))};
            peer_k1(Q1, ps, wv_, LANE_);
#if MK_DUP == 141
            { Peer1P Q1b = Q1; Q1b.P = (GAS int*)(opq(ws) + WS_HLB); peer_k1(Q1b, ps, wv_, LANE_); }
#endif
        }
        SEAM(pb + 14);
        if (IN(pb + 15)) {
            SITE();
            peer_w(opq((const GAS int*)(opq(ws) + WS_EX)), opq((const GAS float*)(opq(ws) + WS_GW)), opq((const GAS int*)(opq(ws) + WS_PROJB)), opq((const GAS float*)(opq(ws) + WS_SH)), opq((const GAS float*)(opq(ws) + WS_SU) + l * 16384), opq((const GAS float*)(opq(ws) + WS_SV) + l * 16384),
                   opq((GAS signed char*)(opq(ws) + WS_W)), opq((GAS float*)(opq(ws) + WS_WS)), gw_, NGW_, LANE_, F.lds, TID_);
#if MK_DUP == 150
            peer_w(opq((const GAS int*)(opq(ws) + WS_EX)), opq((const GAS float*)(opq(ws) + WS_GW)), opq((const GAS int*)(opq(ws) + WS_PROJB)), opq((const GAS float*)(opq(ws) + WS_SH)), opq((const GAS float*)(opq(ws) + WS_SU) + l * 16384), opq((const GAS float*)(opq(ws) + WS_SV) + l * 16384),
                   opq((GAS signed char*)(opq(ws) + WS_W)), opq((GAS float*)(opq(ws) + WS_WS)), gw_, NGW_, LANE_, F.lds, TID_);
#endif
            xcd_barrier(bar, (F.wave == 0 && lane_id_v() == 0) ? 1 : 0);
            const PeerS ps = peer_sched((const GAS unsigned*)(F.ctl + CW_RANK), opqi(F.xcc), opqi(F.xrank));
            Peer2P Q2{opq((const GAS int*)(opq(ws) + WS_EX)), opq((const GAS signed char*)(opq(ws) + WS_W)), opq((const GAS float*)(opq(ws) + WS_WS)), opq((const GAS unsigned char*)(opq(ws) + WS_V8) + (size_t)l * 16384 * 1024), opq((GAS bf16*)(opq(ws) + WS_XNB)), opq((GAS float*)(opq(ws) + WS_SSQ))};
            peer_k2(Q2, ps, wv_, LANE_);
#if MK_DUP == 151
            { Peer2P Q2b = Q2; Q2b.XB = (GAS bf16*)(opq(ws) + WS_HLB); Q2b.SSQ = (GAS float*)(opq(ws) + WS_OMB); peer_k2(Q2b, ps, wv_, LANE_); }
#endif
        }
        SEAM(pb + 15);
    }
    if (IN(PH_FINAL)) { SITE(); final_norm_phase(opq((const GAS bf16*)(opq(ws) + WS_XNB)), (GAS float*)args.out, (const GAS float*)args.in[opqi(32)], T, gw_, NGW_, LANE_); }
#undef IN
#undef SEAM
#undef GEMM_SITE
}
}
extern "C" void kernel_launch(void* const* d_in, const int* in_sizes, int n_in, void* d_out, int out_size, void* d_ws, size_t ws_size, hipStream_t stream) {
    (void)in_sizes; (void)out_size;
    static int grid = 0;
    if (grid == 0) {
        int dev = 0, cus = 0, per_cu = 0;
        if (n_in != 33 || ws_size < mk::WS_END) { fprintf(stderr, "kernel_launch: unexpected n_in %d / ws_size %zu\n", n_in, ws_size); grid = -1; return; }
        if (hipGetDevice(&dev) != hipSuccess || hipDeviceGetAttribute(&cus, hipDeviceAttributeMultiprocessorCount, dev) != hipSuccess) { grid = -1; return; }
        if (hipFuncSetAttribute((const void*)mk::fwd, hipFuncAttributeMaxDynamicSharedMemorySize, mk::LDS_BYTES) != hipSuccess) { fprintf(stderr, "kernel_launch: hipFuncSetAttribute failed\n"); grid = -1; return; }
        if (hipOccupancyMaxActiveBlocksPerMultiprocessor(&per_cu, (const void*)mk::fwd, mk::NWAVES * 64, mk::LDS_BYTES) != hipSuccess || per_cu < 1) fprintf(stderr, "kernel_launch: occupancy query says %d\n", per_cu);
        (void)hipGetLastError();
        grid = cus;
    }
    if (grid < 0) return;
    unsigned char* ws = (unsigned char*)d_ws;
    (void)hipMemsetAsync(ws + mk::WS_CTL, 0, mk::CTL_ZERO_BYTES, stream);
    mk::Args a{};
    for (int i = 0; i < 33; ++i) a.in[i] = (const float*)d_in[i];
    a.out = (float*)d_out; a.ws = ws;
    auto run = [&](int lo, int hi) { a.ph_lo = lo; a.ph_hi = hi; hipLaunchKernelGGL(mk::fwd, dim3(grid), dim3(mk::NWAVES * 64), mk::LDS_BYTES, stream, a); };
#if MK_ONE_LAUNCH
    run(0, mk::PH_FINAL + 1);
#else
    for (int p = 0; p <= mk::PH_FINAL; ++p) {
        const int k = (p - 2) % mk::NPL, l = (p - 2) / mk::NPL;
#if MK_NAIVE_PEER == 2
        if (p >= 2 && p < mk::PH_FINAL && k == 14) {
            hipLaunchKernelGGL(k_peer, dim3(T), dim3(256), 0, stream, (const bf16_t*)(ws + mk::WS_XNB), (const int*)(ws + mk::WS_EX), (const float*)(ws + mk::WS_GW), (const float*)d_in[30] + (size_t)l * NEXP * D, (const float*)d_in[31] + (size_t)l * NEXP * D, (float*)d_out);
            continue; }
#elif MK_NAIVE_PEER == 1
        if (p >= 2 && p < mk::PH_FINAL && k == 13) {
            float* TQ = (float*)(ws + (size_t)806 * mk::MiB);
            hipLaunchKernelGGL(k_bf2f, dim3((unsigned)(((size_t)T * D + 255) / 256)), dim3(256), 0, stream, (const bf16_t*)(ws + mk::WS_PROJB), TQ, (long)T * D);
            hipLaunchKernelGGL(k_route, dim3(T), dim3(256), 0, stream, TQ, (const float*)d_in[29] + (size_t)l * 2 * 128 * 64, (int*)(ws + mk::WS_EX), (float*)(ws + mk::WS_GW));
            hipLaunchKernelGGL(k_peer, dim3(T), dim3(256), 0, stream, (const bf16_t*)(ws + mk::WS_XNB), (const int*)(ws + mk::WS_EX), (const float*)(ws + mk::WS_GW), (const float*)d_in[30] + (size_t)l * NEXP * D, (const float*)d_in[31] + (size_t)l * NEXP * D, (float*)d_out);
            continue; }
        if (p >= 2 && p < mk::PH_FINAL && k == 14) continue;
#endif
        run(p, p + 1); }
#endif
}
```
